# Optimizing an MI355X kernel written in HIP

```python
import jax
import jax.numpy as jnp
from jax import lax
import numpy as np


D_MODEL = 1024
BATCH = 4
SEQ = 4096
DEPTH = 2

HEAD_DIM = 64
A_HEADS = 4
IDX_HEADS = 8
IDX_DIM = 32
DSA_TOPK_MAX = 256
B_HEADS = 4
B_KV_HEADS = 2
WINDOW = 128
C_HEADS = 4
MOBA_BLOCK = 256
MOBA_TOPK = 3
MOBA_Q_CHUNK = 64
D_HEADS = 4
Q_BLOCK = 128
N_BRANCH = 4
BRANCH_WIDTH = 4 * HEAD_DIM
PEER_HEADS = 8
N_KEYS = 128
N_EXPERTS = N_KEYS * N_KEYS
PEER_QDIM = 128
PEER_TOPK = 16
PEER_CHUNK = 128
LN_EPS = 1e-5
NEG_INF = -1e30
DEEPNORM_ALPHA = (2 * DEPTH) ** 0.25
DEEPNORM_BETA = (8 * DEPTH) ** -0.25

IN_WIDTHS = (
    A_HEADS * HEAD_DIM, HEAD_DIM, HEAD_DIM,
    IDX_HEADS * IDX_DIM, IDX_DIM, IDX_HEADS,
    B_HEADS * HEAD_DIM, B_KV_HEADS * HEAD_DIM, B_KV_HEADS * HEAD_DIM,
    C_HEADS * HEAD_DIM, C_HEADS * HEAD_DIM, C_HEADS * HEAD_DIM,
    D_HEADS * HEAD_DIM, D_HEADS * HEAD_DIM, D_HEADS * HEAD_DIM,
    N_BRANCH * D_MODEL,
)
IN_COLS = sum(IN_WIDTHS)
V_COLUMN_GROUPS = (2, 8, 11, 14)

kernel_name = 'hybrid_dsa_swa_moba_stickbreak_peer'


def layer_norm(x, g, b):
    xf = x.astype(jnp.float32)
    mu = jnp.mean(xf, axis=-1, keepdims=True)
    var = jnp.mean(jnp.square(xf - mu), axis=-1, keepdims=True)
    return ((xf - mu) * lax.rsqrt(var + LN_EPS)).astype(g.dtype) * g + b


def alibi_slopes():
    n = A_HEADS + B_HEADS + C_HEADS
    s = 2.0 ** (-8.0 * jnp.arange(1, n + 1, dtype=jnp.float32) / n)
    return s[0::3], s[1::3], s[2::3]


def dsa_attention(q, k, v, q_idx, k_idx, w_idx, slopes):
    bn, s_len = q.shape[:2]
    n_sel = min(DSA_TOPK_MAX, s_len // 4)
    pos_k = jnp.arange(s_len)
    idx_scale = (IDX_DIM * IDX_HEADS) ** -0.5
    k_idx32 = k_idx.astype(jnp.float32)
    k32 = k.astype(jnp.float32)
    v32 = v.astype(jnp.float32)
    gather = jax.vmap(lambda t, ix: t[ix])

    def block(i):
        t0 = i * Q_BLOCK
        pos_q = t0 + jnp.arange(Q_BLOCK)
        qi = lax.dynamic_slice_in_dim(q_idx, t0, Q_BLOCK, 1).astype(jnp.float32)
        wi = lax.dynamic_slice_in_dim(w_idx, t0, Q_BLOCK, 1).astype(jnp.float32)
        qa = lax.dynamic_slice_in_dim(q, t0, Q_BLOCK, 1).astype(jnp.float32)
        rel = jax.nn.relu(jnp.einsum('bqhd,bsd->bqhs', qi, k_idx32))
        score = jnp.einsum('bqhs,bqh->bqs', rel, wi) * idx_scale
        score = jnp.where(pos_k[None, :] <= pos_q[:, None], score, -jnp.inf)
        _, sel = lax.top_k(score, n_sel)
        valid = sel <= pos_q[None, :, None]
        kg = gather(k32, sel)
        vg = gather(v32, sel)
        logits = jnp.einsum('bqhd,bqnd->bhqn', qa, kg) * (HEAD_DIM ** -0.5)
        dist = (pos_q[None, :, None] - sel).astype(jnp.float32)
        logits = logits - slopes[None, :, None, None] * dist[:, None]
        logits = jnp.where(valid[:, None], logits, NEG_INF)
        p = jax.nn.softmax(logits, axis=-1)
        return jnp.einsum('bhqn,bqnd->bqhd', p, vg)

    out = lax.map(block, jnp.arange(s_len // Q_BLOCK))
    return jnp.moveaxis(out, 0, 1).reshape(bn, s_len, A_HEADS * HEAD_DIM)


def swa_sink_attention(q, k, v, sinks, slopes):
    bn, s_len = q.shape[:2]
    w = WINDOW
    nb = s_len // w
    grp = B_HEADS // B_KV_HEADS
    qb = q.astype(jnp.float32).reshape(bn, nb, w, B_KV_HEADS, grp, HEAD_DIM)
    kb = k.astype(jnp.float32).reshape(bn, nb, w, B_KV_HEADS, HEAD_DIM)
    vb = v.astype(jnp.float32).reshape(bn, nb, w, B_KV_HEADS, HEAD_DIM)
    shift = lambda t: jnp.pad(t, ((0, 0), (1, 0), (0, 0), (0, 0), (0, 0)))[:, :-1]
    kk = jnp.concatenate([shift(kb), kb], axis=2)
    vv = jnp.concatenate([shift(vb), vb], axis=2)
    logits = jnp.einsum('bnqkgd,bnskd->bnkgqs', qb, kk) * (HEAD_DIM ** -0.5)
    i = jnp.arange(w)[:, None]
    j = jnp.arange(2 * w)[None, :]
    dist = w + i - j
    band = (dist >= 0) & (dist < WINDOW)
    has_prev = jnp.arange(nb)[:, None, None] > 0
    valid = band[None] & (has_prev | (j >= w)[None])
    sl = slopes.reshape(B_KV_HEADS, grp)[:, :, None, None]
    logits = logits - sl * dist.astype(jnp.float32)
    logits = jnp.where(valid[None, :, None, None], logits, NEG_INF)
    sink = jnp.broadcast_to(sinks.astype(jnp.float32).reshape(B_KV_HEADS, grp, 1, 1), logits.shape[:-1] + (1,))
    p = jax.nn.softmax(jnp.concatenate([logits, sink], axis=-1), axis=-1)[..., :-1]
    o = jnp.einsum('bnkgqs,bnskd->bnqkgd', p, vv)
    return o.reshape(bn, s_len, B_HEADS * HEAD_DIM)


def moba_attention(q, k, v, slopes):
    bn, s_len, nh, hd = q.shape
    nblk = -(-s_len // MOBA_BLOCK)
    s_pad = nblk * MOBA_BLOCK
    n_top = min(MOBA_TOPK, nblk - 1)
    pad = ((0, 0), (0, s_pad - s_len), (0, 0), (0, 0))
    kp = jnp.pad(k.astype(jnp.float32), pad)
    vp = jnp.pad(v.astype(jnp.float32), pad)
    k_blk = kp.reshape(bn, nblk, MOBA_BLOCK, nh, hd).transpose(0, 3, 1, 2, 4)
    v_blk = vp.reshape(bn, nblk, MOBA_BLOCK, nh, hd).transpose(0, 3, 1, 2, 4)
    k_mean = jnp.mean(k_blk, axis=3)
    scale = hd ** -0.5
    offs = jnp.arange(MOBA_BLOCK)
    gather = jax.vmap(jax.vmap(lambda tb, ix: tb[ix]))

    def chunk(i):
        t0 = i * MOBA_Q_CHUNK
        pos_q = t0 + jnp.arange(MOBA_Q_CHUNK)
        own = t0 // MOBA_BLOCK
        qc = lax.dynamic_slice_in_dim(q, t0, MOBA_Q_CHUNK, 1).astype(jnp.float32)
        k_own = lax.dynamic_slice_in_dim(kp, own * MOBA_BLOCK, MOBA_BLOCK, 1)
        v_own = lax.dynamic_slice_in_dim(vp, own * MOBA_BLOCK, MOBA_BLOCK, 1)
        pos_own = own * MOBA_BLOCK + offs
        lo = jnp.einsum('bqhd,bshd->bhqs', qc, k_own) * scale
        lo = lo - slopes[:, None, None] * (pos_q[:, None] - pos_own[None, :]).astype(jnp.float32)
        lo = jnp.where(pos_own[None, :] <= pos_q[:, None], lo, NEG_INF)
        if n_top == 0:
            p_own = jax.nn.softmax(lo, axis=-1)
            return jnp.einsum('bhqs,bshd->bqhd', p_own, v_own)
        gate = jnp.einsum('bqhd,bhnd->bhqn', qc, k_mean)
        gate = jnp.where(jnp.arange(nblk) < own, gate, -jnp.inf)
        _, sel = lax.top_k(gate, n_top)
        ks = gather(k_blk, sel)
        vs = gather(v_blk, sel)
        pos_sel = sel[..., None] * MOBA_BLOCK + offs
        ls = jnp.einsum('bqhd,bhqnsd->bhqns', qc, ks) * scale
        ls = ls - slopes[None, :, None, None, None] * (pos_q[None, None, :, None, None] - pos_sel).astype(jnp.float32)
        ls = jnp.where((sel < own)[..., None], ls, NEG_INF)
        ls = ls.reshape(bn, nh, MOBA_Q_CHUNK, n_top * MOBA_BLOCK)
        p = jax.nn.softmax(jnp.concatenate([ls, lo], axis=-1), axis=-1)
        p_sel = p[..., :n_top * MOBA_BLOCK].reshape(bn, nh, MOBA_Q_CHUNK, n_top, MOBA_BLOCK)
        p_own = p[..., n_top * MOBA_BLOCK:]
        return (jnp.einsum('bhqns,bhqnsd->bqhd', p_sel, vs)
                + jnp.einsum('bhqs,bshd->bqhd', p_own, v_own))

    out = lax.map(chunk, jnp.arange(s_len // MOBA_Q_CHUNK))
    return jnp.moveaxis(out, 0, 1).reshape(bn, s_len, nh * hd)


def stick_breaking_attention(q, k, v):
    bn, s_len, nh, hd = q.shape
    k32 = k.astype(jnp.float32)
    v32 = v.astype(jnp.float32)
    pos_k = jnp.arange(s_len)
    scale = hd ** -0.5

    def block(i):
        t0 = i * Q_BLOCK
        pos_q = t0 + jnp.arange(Q_BLOCK)
        qb = lax.dynamic_slice_in_dim(q, t0, Q_BLOCK, 1).astype(jnp.float32)
        z = jnp.einsum('bqhd,bshd->bhqs', qb, k32) * scale
        strict = pos_k[None, :] < pos_q[:, None]
        log_keep = jnp.where(strict, jax.nn.log_sigmoid(-z), 0.0)
        log_after = lax.cumsum(log_keep, axis=3, reverse=True) - log_keep
        a = jnp.where(strict, jnp.exp(jax.nn.log_sigmoid(z) + log_after), 0.0)
        return jnp.einsum('bhqs,bshd->bqhd', a, v32)

    out = lax.map(block, jnp.arange(s_len // Q_BLOCK))
    return jnp.moveaxis(out, 0, 1).reshape(bn, s_len, nh * hd)


def token_mixer_sublayer(x, w_in, w_branch, w_out, sinks, slopes_a, slopes_b, slopes_c):
    bn, s_len, _ = x.shape
    proj = x @ w_in
    offsets = [int(o) for o in np.cumsum(IN_WIDTHS)[:-1]]
    (qa, ka, va, qi, ki, wi, qb, kb, vb, qc, kc, vc, qd, kd, vd, g) = jnp.split(proj, offsets, axis=-1)
    hd = lambda t, h: t.reshape(bn, s_len, h, HEAD_DIM)
    y_a = dsa_attention(hd(qa, A_HEADS), ka, va, qi.reshape(bn, s_len, IDX_HEADS, IDX_DIM), ki, wi, slopes_a)
    y_b = swa_sink_attention(hd(qb, B_HEADS), hd(kb, B_KV_HEADS), hd(vb, B_KV_HEADS), sinks, slopes_b)
    y_c = moba_attention(hd(qc, C_HEADS), hd(kc, C_HEADS), hd(vc, C_HEADS), slopes_c)
    y_d = stick_breaking_attention(hd(qd, D_HEADS), hd(kd, D_HEADS), hd(vd, D_HEADS))
    ys = jnp.stack([y_a, y_b, y_c, y_d], axis=2)
    branches = jnp.einsum('bsnc,ncd->bsnd', ys, w_branch)
    gates = jax.nn.sigmoid(g.reshape(bn, s_len, N_BRANCH, D_MODEL).astype(jnp.float32))
    merged = jnp.sum(gates * branches, axis=2)
    return merged @ w_out


def peer_ffn(x, wq, subkeys, u, v):
    bn, s_len, d = x.shape
    t_len = bn * s_len
    xt = x.reshape(t_len, d)
    q = (xt @ wq).astype(jnp.float32).reshape(t_len, PEER_HEADS, 2, PEER_QDIM // 2)
    sub = jnp.einsum('thpd,hpkd->thpk', q, subkeys.astype(jnp.float32))
    s_top, i_top = lax.top_k(sub, PEER_TOPK)
    cand = s_top[:, :, 0, :, None] + s_top[:, :, 1, None, :]
    sc, ci = lax.top_k(cand.reshape(t_len, PEER_HEADS, PEER_TOPK * PEER_TOPK), PEER_TOPK)
    i1 = jnp.take_along_axis(i_top[:, :, 0], ci // PEER_TOPK, axis=-1)
    i2 = jnp.take_along_axis(i_top[:, :, 1], ci % PEER_TOPK, axis=-1)
    eid = (i1 * N_KEYS + i2).reshape(t_len, PEER_HEADS * PEER_TOPK)
    gate = jax.nn.softmax(sc, axis=-1).reshape(t_len, PEER_HEADS * PEER_TOPK)
    n_chunks = t_len // PEER_CHUNK

    def chunk(args):
        xc, ec, gc = args
        ug = u[ec]
        h = jax.nn.gelu(jnp.einsum('cd,ced->ce', xc, ug).astype(jnp.float32), approximate=False)
        return jnp.einsum('ce,ced->cd', gc * h, v[ec])

    out = lax.map(chunk, (xt.reshape(n_chunks, PEER_CHUNK, d),
                          eid.reshape(n_chunks, PEER_CHUNK, -1),
                          gate.reshape(n_chunks, PEER_CHUNK, -1)))
    return out.reshape(bn, s_len, d)


def setup_inputs(seed: int = 0) -> dict:
    key = jax.random.key(seed)
    ks = jax.random.split(key, 13)
    nrm = lambda k, shape: jax.random.normal(k, shape, jnp.float32)
    x = nrm(ks[0], (BATCH, SEQ, D_MODEL))
    bounds = np.concatenate([[0], np.cumsum(IN_WIDTHS)])
    col_scale = np.ones((IN_COLS,), np.float32)
    for gi in V_COLUMN_GROUPS:
        col_scale[bounds[gi]:bounds[gi + 1]] = DEEPNORM_BETA
    w_in = nrm(ks[1], (DEPTH, D_MODEL, IN_COLS)) * (D_MODEL ** -0.5) * jnp.asarray(col_scale)
    w_branch = nrm(ks[2], (DEPTH, N_BRANCH, BRANCH_WIDTH, D_MODEL)) * (BRANCH_WIDTH ** -0.5 * DEEPNORM_BETA)
    w_out = nrm(ks[3], (DEPTH, D_MODEL, D_MODEL)) * (D_MODEL ** -0.5 * DEEPNORM_BETA)
    attn_sinks = 0.5 * nrm(ks[4], (DEPTH, B_HEADS))
    ln1_g = 1.0 + 0.02 * nrm(ks[5], (DEPTH, D_MODEL))
    ln1_b = 0.02 * nrm(ks[6], (DEPTH, D_MODEL))
    peer_wq = nrm(ks[7], (DEPTH, D_MODEL, PEER_HEADS * PEER_QDIM)) * (D_MODEL ** -0.5)
    peer_subkeys = nrm(ks[8], (DEPTH, PEER_HEADS, 2, N_KEYS, PEER_QDIM // 2)) * ((PEER_QDIM // 2) ** -0.5)
    peer_u = nrm(ks[9], (DEPTH, N_EXPERTS, D_MODEL)) * (D_MODEL ** -0.5 * DEEPNORM_BETA)
    peer_v = nrm(ks[10], (DEPTH, N_EXPERTS, D_MODEL)) * ((PEER_HEADS * PEER_TOPK) ** -0.5 * DEEPNORM_BETA)
    ln2_g = 1.0 + 0.02 * nrm(ks[11], (DEPTH, D_MODEL))
    ln2_b = 0.02 * nrm(ks[12], (DEPTH, D_MODEL))
    return {'x': x, 'w_in': w_in, 'w_branch': w_branch, 'w_out': w_out, 'attn_sinks': attn_sinks,
            'ln1_g': ln1_g, 'ln1_b': ln1_b, 'peer_wq': peer_wq, 'peer_subkeys': peer_subkeys,
            'peer_u': peer_u, 'peer_v': peer_v, 'ln2_g': ln2_g, 'ln2_b': ln2_b}


def reference(x, w_in, w_branch, w_out, attn_sinks, ln1_g, ln1_b, peer_wq, peer_subkeys,
              peer_u, peer_v, ln2_g, ln2_b):
    slopes_a, slopes_b, slopes_c = alibi_slopes()
    h = x
    for l in range(DEPTH):
        mix = token_mixer_sublayer(h, w_in[l], w_branch[l], w_out[l], attn_sinks[l],
                                   slopes_a, slopes_b, slopes_c)
        h = layer_norm(DEEPNORM_ALPHA * h + mix, ln1_g[l], ln1_b[l])
        ffn = peer_ffn(h, peer_wq[l], peer_subkeys[l], peer_u[l], peer_v[l])
        h = layer_norm(DEEPNORM_ALPHA * h + ffn, ln2_g[l], ln2_b[l])
    return h
```

```cpp
#include <hip/hip_runtime.h>
#include <cstdio>
#include <cstdint>

constexpr int T_ = 16384, S_ = 4096, NBATCH = 4, D_ = 1024, NCOL = 6824, DEPTH_ = 2;
constexpr int C_QA = 0, C_KA = 256, C_VA = 320, C_QI = 384, C_KI = 640, C_WI = 672, C_QB = 680, C_KB = 936, C_VB = 1064,
              C_QC = 1192, C_KC = 1448, C_VC = 1704, C_QD = 1960, C_KD = 2216, C_VD = 2472, C_G = 2728;
constexpr int NTHR = 512, NWAVE = 8;
constexpr float ALPHA = 1.41421356237309515f;
constexpr float LN_EPS = 1e-5f;
constexpr size_t MiB = 1u << 20;
constexpr size_t WS_P = 0, WS_YS = 107 * MiB, WS_MRG = 171 * MiB, WS_MIX = 235 * MiB, WS_MASK = 299 * MiB, WS_EID = 307 * MiB,
                 WS_GATE = 315 * MiB, WS_KMEAN = 323 * MiB, WS_END = 324 * MiB;
constexpr int LDS_BYTES = 80 * 1024;

struct Params { const float* in[13]; float* out; unsigned char* ws; };

__device__ __forceinline__ float wave_sum(float v) {
#pragma unroll
    for (int o = 32; o > 0; o >>= 1) v += __shfl_xor(v, o);
    return v;
}
__device__ __forceinline__ float wave_max(float v) {
#pragma unroll
    for (int o = 32; o > 0; o >>= 1) v = fmaxf(v, __shfl_xor(v, o));
    return v;
}
__device__ __forceinline__ int wave_sum_i(int v) {
#pragma unroll
    for (int o = 32; o > 0; o >>= 1) v += __shfl_xor(v, o);
    return v;
}
__device__ __forceinline__ float logsig(float x) { return fminf(x, 0.f) - log1pf(expf(-fabsf(x))); }

__device__ void gemm_phase(const float* A, int lda, const float* B, int ldb, float* C, int ldc, int M, int N, int K, float* sm) {
    float (*As)[132] = (float (*)[132])sm;
    float (*Bs)[132] = (float (*)[132])(sm + 16 * 132);
    const int tid = threadIdx.x, ty = tid >> 4, tx = tid & 15;
    const int ntm = M / 128, ntn = (N + 127) / 128;
    const int arow = tid >> 2, akq = (tid & 3) * 4, bk = tid >> 5, bn = (tid & 31) * 4;
    for (int tile = blockIdx.x; tile < ntm * ntn; tile += gridDim.x) {
        const int tm = tile % ntm, tn = tile / ntm, m0 = tm * 128, n0 = tn * 128;
        float acc[4][8];
#pragma unroll
        for (int i = 0; i < 4; ++i)
#pragma unroll
            for (int j = 0; j < 8; ++j) acc[i][j] = 0.f;
        const float* Ap = A + (size_t)(m0 + arow) * lda + akq;
        const bool bok = (n0 + bn) < N;
        const float* Bp = B + (size_t)bk * ldb + n0 + bn;
        float4 ra = *(const float4*)Ap;
        float4 rb = bok ? *(const float4*)Bp : make_float4(0.f, 0.f, 0.f, 0.f);
        for (int k0 = 0; k0 < K; k0 += 16) {
            __syncthreads();
            As[akq + 0][arow] = ra.x; As[akq + 1][arow] = ra.y; As[akq + 2][arow] = ra.z; As[akq + 3][arow] = ra.w;
            *(float4*)&Bs[bk][bn] = rb;
            __syncthreads();
            if (k0 + 16 < K) {
                ra = *(const float4*)(Ap + k0 + 16);
                rb = bok ? *(const float4*)(Bp + (size_t)(k0 + 16) * ldb) : make_float4(0.f, 0.f, 0.f, 0.f);
            }
#pragma unroll 2
            for (int k = 0; k < 16; ++k) {
                const float4 a = *(const float4*)&As[k][ty * 4];
                const float4 b0 = *(const float4*)&Bs[k][tx * 4];
                const float4 b1 = *(const float4*)&Bs[k][64 + tx * 4];
                const float av[4] = {a.x, a.y, a.z, a.w};
                const float bv[8] = {b0.x, b0.y, b0.z, b0.w, b1.x, b1.y, b1.z, b1.w};
#pragma unroll
                for (int i = 0; i < 4; ++i)
#pragma unroll
                    for (int j = 0; j < 8; ++j) acc[i][j] += av[i] * bv[j];
            }
        }
#pragma unroll
        for (int i = 0; i < 4; ++i) {
            float* cr = C + (size_t)(m0 + ty * 4 + i) * ldc + n0;
            if (n0 + tx * 4 < N) *(float4*)(cr + tx * 4) = make_float4(acc[i][0], acc[i][1], acc[i][2], acc[i][3]);
            if (n0 + 64 + tx * 4 < N) *(float4*)(cr + 64 + tx * 4) = make_float4(acc[i][4], acc[i][5], acc[i][6], acc[i][7]);
        }
    }
    __syncthreads();
}

__device__ __forceinline__ int block_sum_i(int v, unsigned* red, int slot) {
    v = wave_sum_i(v);
    if ((threadIdx.x & 63) == 0) red[slot * 8 + (threadIdx.x >> 6)] = (unsigned)v;
    __syncthreads();
    int s = 0;
#pragma unroll
    for (int w = 0; w < 8; ++w) s += (int)red[slot * 8 + w];
    return s;
}
__device__ void index_phase(const float* P, int b, unsigned char* mask, float* kmean, float* sm) {
    float* s_qi = sm;
    float* s_wi = sm + 256;
    unsigned* s_red = (unsigned*)(sm + 272);
    const int tid = threadIdx.x, lane = tid & 63, wave = tid >> 6;
    for (int o = blockIdx.x * NTHR + tid; o < 4 * 16 * 64; o += gridDim.x * NTHR) {
        const int d = o & 63, blk = (o >> 6) & 15, h = o >> 10;
        float s = 0.f;
        for (int j = 0; j < 256; ++j) s += P[(size_t)(blk * 256 + j) * NCOL + C_KC + h * 64 + d];
        kmean[((b * 4 + h) * 16 + blk) * 64 + d] = s * (1.0f / 256.0f);
    }
    int slot = 0;
    for (int q = blockIdx.x; q < S_; q += gridDim.x) {
        __syncthreads();
        if (tid < 256) s_qi[tid] = P[(size_t)q * NCOL + C_QI + tid];
        else if (tid < 264) s_wi[tid - 256] = P[(size_t)q * NCOL + C_WI + tid - 256];
        __syncthreads();
        unsigned* s_key = (unsigned*)(sm + 320);
#pragma unroll 1
        for (int j = 0; j < 8; ++j) {
            const int s = tid * 8 + j;
            unsigned key = 0u;
            if (s <= q) {
                const float4* kr = (const float4*)(P + (size_t)s * NCOL + C_KI);
                float kv[32];
#pragma unroll
                for (int c = 0; c < 8; ++c) { const float4 t4 = kr[c]; kv[4 * c] = t4.x; kv[4 * c + 1] = t4.y; kv[4 * c + 2] = t4.z; kv[4 * c + 3] = t4.w; }
                float sc = 0.f;
#pragma unroll 1
                for (int h = 0; h < 8; ++h) {
                    float d = 0.f;
#pragma unroll
                    for (int dd = 0; dd < 32; ++dd) d += s_qi[h * 32 + dd] * kv[dd];
                    sc += fmaxf(d, 0.f) * s_wi[h];
                }
                sc *= 0.0625f;
                if (sc == 0.f) sc = 0.f;
                const unsigned u = __float_as_uint(sc);
                key = (u & 0x80000000u) ? ~u : (u | 0x80000000u);
            }
            s_key[s] = key;
        }
        unsigned kk[8];
        { const uint4 k0 = *(const uint4*)&s_key[tid * 8], k1 = *(const uint4*)&s_key[tid * 8 + 4];
          kk[0] = k0.x; kk[1] = k0.y; kk[2] = k0.z; kk[3] = k0.w; kk[4] = k1.x; kk[5] = k1.y; kk[6] = k1.z; kk[7] = k1.w; }
        unsigned byte = 0u;
        if (q + 1 > 256) {
            unsigned prefix = 0u;
            for (int bit = 31; bit >= 0; --bit) {
                const unsigned cand = prefix | (1u << bit);
                int c = 0;
#pragma unroll
                for (int j = 0; j < 8; ++j) c += (kk[j] >= cand) ? 1 : 0;
                c = block_sum_i(c, s_red, slot); slot ^= 1;
                if (c >= 256) prefix = cand;
            }
            int cgt = 0, ceq = 0;
#pragma unroll
            for (int j = 0; j < 8; ++j) { cgt += (kk[j] > prefix) ? 1 : 0; ceq += (kk[j] == prefix) ? 1 : 0; }
            const int tot_gt = block_sum_i(cgt, s_red, slot); slot ^= 1;
            const int need = 256 - tot_gt;
            int incl = ceq;
#pragma unroll
            for (int o = 1; o < 64; o <<= 1) { const int t2 = __shfl_up(incl, o); if (lane >= o) incl += t2; }
            if (lane == 63) s_red[16 + wave] = (unsigned)incl;
            __syncthreads();
            int woff = 0;
            for (int w = 0; w < wave; ++w) woff += (int)s_red[16 + w];
            int taken = woff + incl - ceq;
#pragma unroll
            for (int j = 0; j < 8; ++j) {
                bool sel = kk[j] > prefix;
                if (kk[j] == prefix) { if (taken < need) sel = true; ++taken; }
                byte |= (sel ? 1u : 0u) << j;
            }
        } else {
#pragma unroll
            for (int j = 0; j < 8; ++j) byte |= ((tid * 8 + j) <= q ? 1u : 0u) << j;
        }
        mask[(size_t)(b * S_ + q) * 512 + tid] = (unsigned char)byte;
    }
    __syncthreads();
}

__device__ __forceinline__ float attend_list(int n, const int* idx, const float* sq, const float* Kb, const float* Vb, float slope, int qpos,
                                             float sink, bool has_sink, float* lg, int lane) {
    float m = -INFINITY;
    for (int i = lane; i < n; i += 64) {
        const int key = idx[i];
        const float4* kr = (const float4*)(Kb + (size_t)key * NCOL);
        float d = 0.f;
#pragma unroll 4
        for (int c = 0; c < 16; ++c) { const float4 kv = kr[c]; d += kv.x * sq[4 * c] + kv.y * sq[4 * c + 1] + kv.z * sq[4 * c + 2] + kv.w * sq[4 * c + 3]; }
        const float l = d * 0.125f - slope * (float)(qpos - key);
        lg[i] = l; m = fmaxf(m, l);
    }
    m = wave_max(m);
    if (has_sink) m = fmaxf(m, sink);
    float sum = 0.f;
    for (int i = lane; i < n; i += 64) { const float e = expf(lg[i] - m); lg[i] = e; sum += e; }
    sum = wave_sum(sum);
    if (has_sink) sum += expf(sink - m);
    float acc = 0.f;
    for (int i = 0; i < n; ++i) acc += lg[i] * Vb[(size_t)idx[i] * NCOL + lane];
    return acc / sum;
}

__device__ void attn_phase(const float* P, int b, const unsigned char* mask, const float* kmean, const float* sinks, float* ys, float* sm) {
    const int tid = threadIdx.x, lane = tid & 63, wave = tid >> 6;
    float* wsm = sm + wave * 2304;
    int* idx = (int*)wsm; float* lg = wsm + 1024; float* sq = wsm + 2048;
    const int gw = blockIdx.x * NWAVE + wave, NGW = gridDim.x * NWAVE;
    for (int it = gw; it < 13 * S_; it += NGW) {
        const int kind = it / S_, t = it % S_;
        float* yrow = ys + (size_t)(b * S_ + t) * 1024;
        const float* prow = P + (size_t)t * NCOL;
        if (kind == 0) {
            for (int i = lane; i < 256; i += 64) sq[i] = prow[C_QA + i];
            const unsigned long long* mrow = (const unsigned long long*)(mask + (size_t)(b * S_ + t) * 512);
            unsigned long long w = mrow[lane];
            const int c = __popcll(w);
            int incl = c;
#pragma unroll
            for (int o = 1; o < 64; o <<= 1) { const int t2 = __shfl_up(incl, o); if (lane >= o) incl += t2; }
            int pos = incl - c;
            const int ntot = __shfl(incl, 63);
            while (w) { const int bit = __ffsll((long long)w) - 1; w &= w - 1; idx[pos++] = lane * 64 + bit; }
            for (int h = 0; h < 4; ++h) {
                const float slope = exp2f(-8.0f * (float)(3 * h + 1) / 12.0f);
                const float o = attend_list(ntot, idx, sq + h * 64, P + C_KA, P + C_VA, slope, t, 0.f, false, lg, lane);
                yrow[h * 64 + lane] = o;
            }
        } else if (kind <= 4) {
            const int hq = kind - 1, kvh = hq >> 1;
            sq[lane] = prow[C_QB + hq * 64 + lane];
            const int lo = (t - 127 > 0) ? t - 127 : 0, n = t - lo + 1;
            for (int i = lane; i < n; i += 64) idx[i] = lo + i;
            const float slope = exp2f(-8.0f * (float)(3 * hq + 2) / 12.0f);
            const float o = attend_list(n, idx, sq, P + C_KB + kvh * 64, P + C_VB + kvh * 64, slope, t, sinks[hq], true, lg, lane);
            yrow[256 + hq * 64 + lane] = o;
        } else if (kind <= 8) {
            const int h = kind - 5, own = t >> 8;
            sq[lane] = prow[C_QC + h * 64 + lane];
            float g = -INFINITY;
            if (lane < own) {
                const float* km = kmean + ((b * 4 + h) * 16 + lane) * 64;
                float d = 0.f;
                for (int dd = 0; dd < 64; ++dd) d += sq[dd] * km[dd];
                g = d;
            }
            int nb = 0;
            for (int r = 0; r < 3; ++r) {
                const float mx = wave_max(g);
                if (mx == -INFINITY) break;
                const unsigned long long bal = __ballot(g == mx);
                const int wl = __ffsll((long long)bal) - 1;
                for (int i = lane; i < 256; i += 64) idx[nb * 256 + i] = wl * 256 + i;
                ++nb;
                if (lane == wl) g = -INFINITY;
            }
            const int nown = t - own * 256 + 1;
            for (int i = lane; i < nown; i += 64) idx[nb * 256 + i] = own * 256 + i;
            const float slope = exp2f(-8.0f * (float)(3 * h + 3) / 12.0f);
            const float o = attend_list(nb * 256 + nown, idx, sq, P + C_KC + h * 64, P + C_VC + h * 64, slope, t, 0.f, false, lg, lane);
            yrow[512 + h * 64 + lane] = o;
        } else {
            const int h = kind - 9;
            sq[lane] = prow[C_QD + h * 64 + lane];
            const float* Kb = P + C_KD + h * 64; const float* Vb = P + C_VD + h * 64;
            float acc = 0.f, carry = 0.f;
            for (int base = t - 1; base >= 0; base -= 64) {
                const int s = base - lane;
                const bool ok = s >= 0;
                float z = 0.f, lk = 0.f;
                if (ok) {
                    const float4* kr = (const float4*)(Kb + (size_t)s * NCOL);
                    float d = 0.f;
#pragma unroll 4
                    for (int c = 0; c < 16; ++c) { const float4 kv = kr[c]; d += kv.x * sq[4 * c] + kv.y * sq[4 * c + 1] + kv.z * sq[4 * c + 2] + kv.w * sq[4 * c + 3]; }
                    z = d * 0.125f; lk = logsig(-z);
                }
                float incl = lk;
#pragma unroll
                for (int o = 1; o < 64; o <<= 1) { const float t2 = __shfl_up(incl, o); if (lane >= o) incl += t2; }
                const float la = carry + incl - lk;
                const float a = ok ? expf(logsig(z) + la) : 0.f;
                carry += __shfl(incl, 63);
                lg[lane] = a;
                const int cnt = (base + 1 < 64) ? base + 1 : 64;
                for (int j = 0; j < cnt; ++j) acc += lg[j] * Vb[(size_t)(base - j) * NCOL + lane];
            }
            yrow[768 + h * 64 + lane] = acc;
        }
    }
    __syncthreads();
}

__device__ void merge_phase(const float* P, int b, const float* ys, const float* wb, float* merged, float* sm) {
    const int tid = threadIdx.x;
    for (int grp = blockIdx.x; grp < S_ / 8; grp += gridDim.x) {
        const int t0 = grp * 8;
        __syncthreads();
        for (int i = tid; i < 8 * 1024; i += NTHR) sm[i] = ys[(size_t)(b * S_ + t0) * 1024 + i];
        __syncthreads();
        float mer[8][2];
#pragma unroll
        for (int k = 0; k < 8; ++k) { mer[k][0] = 0.f; mer[k][1] = 0.f; }
        for (int n = 0; n < 4; ++n) {
            float acc[8][2];
#pragma unroll
            for (int k = 0; k < 8; ++k) { acc[k][0] = 0.f; acc[k][1] = 0.f; }
            const float* w = wb + (size_t)n * 256 * 1024;
#pragma unroll 2
            for (int c = 0; c < 256; ++c) {
                const float w0 = w[(size_t)c * 1024 + tid], w1 = w[(size_t)c * 1024 + tid + 512];
#pragma unroll
                for (int k = 0; k < 8; ++k) { const float y = sm[k * 1024 + n * 256 + c]; acc[k][0] += y * w0; acc[k][1] += y * w1; }
            }
#pragma unroll
            for (int k = 0; k < 8; ++k) {
                const float* gr = P + (size_t)(t0 + k) * NCOL + C_G + n * 1024;
                const float g0 = gr[tid], g1 = gr[tid + 512];
                mer[k][0] += acc[k][0] / (1.f + expf(-g0));
                mer[k][1] += acc[k][1] / (1.f + expf(-g1));
            }
        }
#pragma unroll
        for (int k = 0; k < 8; ++k) {
            merged[(size_t)(b * S_ + t0 + k) * 1024 + tid] = mer[k][0];
            merged[(size_t)(b * S_ + t0 + k) * 1024 + tid + 512] = mer[k][1];
        }
    }
    __syncthreads();
}

__device__ __forceinline__ void ln_row(float4 (&v)[4], const float* g, const float* bb, float* orow, int lane) {
    float s = 0.f;
#pragma unroll
    for (int j = 0; j < 4; ++j) s += (v[j].x + v[j].y) + (v[j].z + v[j].w);
    const float mean = wave_sum(s) * (1.0f / 1024.0f);
    float s2 = 0.f;
#pragma unroll
    for (int j = 0; j < 4; ++j) { v[j].x -= mean; v[j].y -= mean; v[j].z -= mean; v[j].w -= mean; s2 += (v[j].x * v[j].x + v[j].y * v[j].y) + (v[j].z * v[j].z + v[j].w * v[j].w); }
    const float rstd = 1.0f / sqrtf(wave_sum(s2) * (1.0f / 1024.0f) + LN_EPS);
#pragma unroll
    for (int j = 0; j < 4; ++j) {
        const float4 gg = ((const float4*)g)[j * 64 + lane], b4 = ((const float4*)bb)[j * 64 + lane];
        float4 o; o.x = v[j].x * rstd * gg.x + b4.x; o.y = v[j].y * rstd * gg.y + b4.y; o.z = v[j].z * rstd * gg.z + b4.z; o.w = v[j].w * rstd * gg.w + b4.w;
        ((float4*)orow)[j * 64 + lane] = o;
    }
}
__device__ void ln1_phase(const float* hin, const float* add, const float* g, const float* bb, float* hout) {
    const int lane = threadIdx.x & 63, wave = threadIdx.x >> 6;
    for (int row = blockIdx.x * NWAVE + wave; row < T_; row += gridDim.x * NWAVE) {
        float4 v[4];
#pragma unroll
        for (int j = 0; j < 4; ++j) {
            const float4 a = ((const float4*)(hin + (size_t)row * 1024))[j * 64 + lane], m = ((const float4*)(add + (size_t)row * 1024))[j * 64 + lane];
            v[j].x = ALPHA * a.x + m.x; v[j].y = ALPHA * a.y + m.y; v[j].z = ALPHA * a.z + m.z; v[j].w = ALPHA * a.w + m.w;
        }
        ln_row(v, g, bb, hout + (size_t)row * 1024, lane);
    }
}

__device__ void route_phase(const float* qb, const float* subkeys, int* eid, float* gate) {
    const int lane = threadIdx.x & 63, wave = threadIdx.x >> 6;
    for (int it = blockIdx.x * NWAVE + wave; it < T_ * 8; it += gridDim.x * NWAVE) {
        const int t = it >> 3, h = it & 7;
        float stop[2]; int itop[2];
#pragma unroll
        for (int p = 0; p < 2; ++p) {
            const float* qv = qb + (size_t)t * 1024 + h * 128 + p * 64;
            const float* sk0 = subkeys + ((size_t)(h * 2 + p) * 128 + lane) * 64;
            const float* sk1 = sk0 + 64 * 64;
            float v0 = 0.f, v1 = 0.f;
            for (int d = 0; d < 64; ++d) { const float qd = qv[d]; v0 += qd * sk0[d]; v1 += qd * sk1[d]; }
            float sv = 0.f; int si = 0;
            for (int r = 0; r < 16; ++r) {
                const float loc = fmaxf(v0, v1);
                const float mx = wave_max(loc);
                const unsigned long long b0 = __ballot(v0 == mx), b1 = __ballot(v1 == mx);
                int win;
                if (b0) win = __ffsll((long long)b0) - 1; else win = 64 + __ffsll((long long)b1) - 1;
                if (lane == r) { sv = mx; si = win; }
                if (win < 64) { if (lane == win) v0 = -INFINITY; } else { if (lane == win - 64) v1 = -INFINITY; }
            }
            stop[p] = sv; itop[p] = si;
        }
        float cv[4];
#pragma unroll
        for (int c = 0; c < 4; ++c) { const int ci = lane * 4 + c; cv[c] = __shfl(stop[0], ci >> 4) + __shfl(stop[1], ci & 15); }
        float sc = 0.f; int sci = 0;
        for (int r = 0; r < 16; ++r) {
            const float loc = fmaxf(fmaxf(cv[0], cv[1]), fmaxf(cv[2], cv[3]));
            const float mx = wave_max(loc);
            int mine = 1 << 30;
#pragma unroll
            for (int c = 3; c >= 0; --c) if (cv[c] == mx) mine = lane * 4 + c;
            int win = mine;
#pragma unroll
            for (int o = 32; o > 0; o >>= 1) { const int t2 = __shfl_xor(win, o); win = t2 < win ? t2 : win; }
            if (lane == r) { sc = mx; sci = win; }
#pragma unroll
            for (int c = 0; c < 4; ++c) if (lane * 4 + c == win) cv[c] = -INFINITY;
        }
        const int i1 = __shfl(itop[0], sci >> 4), i2 = __shfl(itop[1], sci & 15);
        const float scm = (lane < 16) ? sc : -INFINITY;
        const float m = wave_max(scm);
        const float e = (lane < 16) ? expf(sc - m) : 0.f;
        const float sum = wave_sum(e);
        if (lane < 16) { eid[(size_t)t * 128 + h * 16 + lane] = i1 * 128 + i2; gate[(size_t)t * 128 + h * 16 + lane] = e / sum; }
    }
}

__device__ void peer_phase(float* h, const int* eid, const float* gate, const float* U, const float* V, const float* g, const float* bb) {
    const int lane = threadIdx.x & 63, wave = threadIdx.x >> 6;
    for (int t = blockIdx.x * NWAVE + wave; t < T_; t += gridDim.x * NWAVE) {
        float4 x[4], acc[4];
#pragma unroll
        for (int j = 0; j < 4; ++j) { x[j] = ((const float4*)(h + (size_t)t * 1024))[j * 64 + lane]; acc[j] = make_float4(0.f, 0.f, 0.f, 0.f); }
        for (int e = 0; e < 128; ++e) {
            const int id = eid[(size_t)t * 128 + e];
            const float gt = gate[(size_t)t * 128 + e];
            const float4* ur = (const float4*)(U + (size_t)id * 1024);
            const float4* vr = (const float4*)(V + (size_t)id * 1024);
            float d = 0.f;
#pragma unroll
            for (int j = 0; j < 4; ++j) { const float4 u4 = ur[j * 64 + lane]; d += (u4.x * x[j].x + u4.y * x[j].y) + (u4.z * x[j].z + u4.w * x[j].w); }
            d = wave_sum(d);
            const float hv = 0.5f * d * (1.0f + erff(d * 0.70710678118654752f)) * gt;
#pragma unroll
            for (int j = 0; j < 4; ++j) { const float4 v4 = vr[j * 64 + lane]; acc[j].x += hv * v4.x; acc[j].y += hv * v4.y; acc[j].z += hv * v4.z; acc[j].w += hv * v4.w; }
        }
        float4 v[4];
#pragma unroll
        for (int j = 0; j < 4; ++j) { v[j].x = ALPHA * x[j].x + acc[j].x; v[j].y = ALPHA * x[j].y + acc[j].y; v[j].z = ALPHA * x[j].z + acc[j].z; v[j].w = ALPHA * x[j].w + acc[j].w; }
        ln_row(v, g, bb, h + (size_t)t * 1024, lane);
    }
}

template <int SUB> __global__ void __launch_bounds__(NTHR) k_phase(Params p, int l, int b) {
    extern __shared__ __attribute__((aligned(16))) unsigned char lds_raw[];
    float* sm = (float*)lds_raw;
    float* hbuf = p.out;
    float* Pb = (float*)(p.ws + WS_P);
    float* ys = (float*)(p.ws + WS_YS);
    float* mrg = (float*)(p.ws + WS_MRG);
    float* mix = (float*)(p.ws + WS_MIX);
    unsigned char* mask = p.ws + WS_MASK;
    int* eid = (int*)(p.ws + WS_EID);
    float* gate = (float*)(p.ws + WS_GATE);
    float* kmean = (float*)(p.ws + WS_KMEAN);
    const float* hin = (l == 0) ? p.in[0] : hbuf;
    if (SUB == 0) gemm_phase(hin + (size_t)b * S_ * 1024, 1024, p.in[1] + (size_t)l * D_ * NCOL, NCOL, Pb, NCOL, S_, NCOL, 1024, sm);
    else if (SUB == 1) index_phase(Pb, b, mask, kmean, sm);
    else if (SUB == 2) attn_phase(Pb, b, mask, kmean, p.in[4] + l * 4, ys, sm);
    else if (SUB == 3) merge_phase(Pb, b, ys, p.in[2] + (size_t)l * 4 * 256 * 1024, mrg, sm);
    else if (SUB == 4) gemm_phase(mrg, 1024, p.in[3] + (size_t)l * 1024 * 1024, 1024, mix, 1024, T_, 1024, 1024, sm);
    else if (SUB == 5) ln1_phase(hin, mix, p.in[5] + l * 1024, p.in[6] + l * 1024, hbuf);
    else if (SUB == 6) gemm_phase(hbuf, 1024, p.in[7] + (size_t)l * 1024 * 1024, 1024, mrg, 1024, T_, 1024, 1024, sm);
    else if (SUB == 7) route_phase(mrg, p.in[8] + (size_t)l * 8 * 2 * 128 * 64, eid, gate);
    else peer_phase(hbuf, eid, gate, p.in[9] + (size_t)l * 16384 * 1024, p.in[10] + (size_t)l * 16384 * 1024, p.in[11] + l * 1024, p.in[12] + l * 1024);
}
template <int SUB> static void launch_phase(const Params& p, int l, int b, hipStream_t stream) {
    static bool init = false;
    if (!init) { (void)hipFuncSetAttribute((const void*)k_phase<SUB>, hipFuncAttributeMaxDynamicSharedMemorySize, LDS_BYTES); init = true; }
    k_phase<SUB><<<dim3(1024), dim3(NTHR), LDS_BYTES, stream>>>(p, l, b);
}

extern "C" void kernel_launch(void* const* d_in, const int* in_sizes, int n_in, void* d_out, int out_size, void* d_ws, size_t ws_size, hipStream_t stream) {
    Params p{};
    for (int i = 0; i < 13; ++i) p.in[i] = (const float*)d_in[i];
    p.out = (float*)d_out; p.ws = (unsigned char*)d_ws;
    for (int l = 0; l < DEPTH_; ++l) {
        for (int b = 0; b < NBATCH; ++b) {
            launch_phase<0>(p, l, b, stream); launch_phase<1>(p, l, b, stream); launch_phase<2>(p, l, b, stream); launch_phase<3>(p, l, b, stream);
        }
        launch_phase<4>(p, l, 0, stream); launch_phase<5>(p, l, 0, stream); launch_phase<6>(p, l, 0, stream); launch_phase<7>(p, l, 0, stream); launch_phase<8>(p, l, 0, stream);
    }
}
```

```cpp
#include <hip/hip_runtime.h>
#include <cstdio>
#include <cstdint>
#include <hip/hip_cooperative_groups.h>
namespace cg = cooperative_groups;

__device__ __forceinline__ int LTID() { int t = threadIdx.x; asm volatile("" : "+v"(t)); return t; }
__device__ __forceinline__ int LBID() { int t = blockIdx.x; asm volatile("" : "+s"(t)); return t; }
__device__ __forceinline__ int LGRID() { int t = gridDim.x; asm volatile("" : "+s"(t)); return t; }
namespace pg8 {
#define PG8_LAS __attribute__((address_space(3)))
typedef unsigned short bf16_t;
typedef short bf16x8 __attribute__((ext_vector_type(8)));
typedef float f32x4 __attribute__((ext_vector_type(4)));
typedef unsigned u32x4 __attribute__((ext_vector_type(4)));
constexpr int BM = 256, BK = 64, HALF = 128, HTB = HALF * BK * 2  , STAGE_BYTES = 8 * HTB, NXCD = 8, WGM = 8;

__host__ __device__ __forceinline__ int lds_byte(int r, int c) { const int st = (r >> 4) * 2 + (c >> 5), rr = r & 15, cc = c & 31, ob = rr * 64 + cc * 2; return st * 1024 + (ob ^ (((ob >> 9) & 1) << 5)); }
__host__ __device__ __forceinline__ void stage_rc(int b, int& R, int& C) { const int st = b / 1024, sb = b % 1024, swz = sb ^ (((sb >> 9) & 1) << 5); R = (st >> 1) * 16 + swz / 64; C = (st & 1) * 32 + (swz % 64) / 2; }
__host__ __device__ __forceinline__ int perm32(int rho) { const int n = rho >> 4, i = rho & 15; return 8 * (i >> 2) + 4 * n + (i & 3); }

struct Unit { int pm, pn; };
struct Gemm { const bf16_t* A; const bf16_t* Bt; int M, N, K; };

struct StaticOrder {
    int nM, nN, nwg, G, c;
    __host__ __device__ void init(int M, int N, int G_, int c_) { nM = M / BM; nN = N / BM; nwg = nM * nN; G = G_; c = c_; }
    __host__ __device__ bool next(int i, Unit& u) const {
        const long L = (long)i * G + c; if (L >= nwg) return false;
        int wgid = (int)L; { const int q = nwg / NXCD, r = nwg % NXCD, xcd = wgid % NXCD, off = wgid / NXCD; wgid = (xcd < r ? xcd * (q + 1) : r * (q + 1) + (xcd - r) * q) + off; }
        const int nig = WGM * nN, gid = wgid / nig, fm = gid * WGM, gsz = (nM - fm) < WGM ? (nM - fm) : WGM;
        u.pm = fm + ((wgid % nig) % gsz); u.pn = (wgid % nig) / gsz; return true;
    }
    __device__ __forceinline__ void a_ready(const Unit&) const {}
    __device__ __forceinline__ void done(const Unit&) const {}
};

__device__ __forceinline__ unsigned cvt_pk_bf16(float lo, float hi) { unsigned r; asm volatile("v_cvt_pk_bf16_f32 %0, %1, %2" : "=v"(r) : "v"(lo), "v"(hi)); return r; }
typedef float f32x2 __attribute__((ext_vector_type(2)));
__device__ __forceinline__ f32x2 gelu_pk(f32x2 v) {
    const f32x2 av = __builtin_elementwise_abs(v), d = av * 0.2316418882f + 1.0f;
    f32x2 t; t.x = __builtin_amdgcn_rcpf(d.x); t.y = __builtin_amdgcn_rcpf(d.y);
    f32x2 q = t * 0.5307027145f + (-0.7265760135f); q = q * t + 0.7107068705f; q = q * t + (-0.142248368f); q = q * t + 0.127414796f; q = q * t;
    const f32x2 s = (v * v) * (-0.72134752044f);
    f32x2 e; e.x = __builtin_amdgcn_exp2f(s.x); e.y = __builtin_amdgcn_exp2f(s.y);
    const f32x2 m = v * (q * e), r = v - m;
    f32x2 o; o.x = v.x < 0.f ? m.x : r.x; o.y = v.y < 0.f ? m.y : r.y; return o;
}

template <int ACT  > struct EpiBf16 {
    static constexpr bool PERM = true, AFTER_DRAIN = false; static_assert(ACT == 0 || ACT == 1, "EpiBf16: ACT is 0 (none) or 1 (gelu_pk)");
    bf16_t* O; int ldc; const float* bias; int split_cols; size_t split_stride; float scale0;
    __device__ __forceinline__ void operator()(const f32x4 (&acc)[2][2][4][2], const Unit& u, int wr, int wc, int fr, int fq) const {
        const int row0 = u.pm * BM + wr * 64 + fr; int colt = u.pn * BM; bf16_t* base = O;
        float sc = 1.f; if (split_cols) { const int t = colt / split_cols; base += (size_t)t * split_stride; colt -= t * split_cols; if (t == 0) sc = scale0; }
        const int col0 = colt + wc * 32 + 8 * fq, bcol0 = u.pn * BM + wc * 32 + 8 * fq;
        f32x4 bv[2][2];
#pragma unroll
        for (int bj = 0; bj < 2; ++bj)
#pragma unroll
            for (int n = 0; n < 2; ++n) bv[bj][n] = bias ? *(const f32x4*)(bias + bcol0 + bj * HALF + 4 * n) : (f32x4){0.f, 0.f, 0.f, 0.f};
#pragma unroll
        for (int ai = 0; ai < 2; ++ai)
#pragma unroll
            for (int m = 0; m < 4; ++m) { bf16_t* rowp = base + (size_t)(row0 + ai * HALF + m * 16) * ldc + col0;
#pragma unroll
                for (int bj = 0; bj < 2; ++bj) { f32x4 v0 = acc[ai][bj][m][0] + bv[bj][0], v1 = acc[ai][bj][m][1] + bv[bj][1];
                    if (ACT == 1) { f32x2 a = gelu_pk((f32x2){v0[0], v0[1]}), b = gelu_pk((f32x2){v0[2], v0[3]}), c = gelu_pk((f32x2){v1[0], v1[1]}), d = gelu_pk((f32x2){v1[2], v1[3]});
                        v0 = (f32x4){a.x, a.y, b.x, b.y}; v1 = (f32x4){c.x, c.y, d.x, d.y}; }
                    v0 = v0 * sc; v1 = v1 * sc; u32x4 w; w.x = cvt_pk_bf16(v0[0], v0[1]); w.y = cvt_pk_bf16(v0[2], v0[3]); w.z = cvt_pk_bf16(v1[0], v1[1]); w.w = cvt_pk_bf16(v1[2], v1[3]);
                    *(u32x4*)(rowp + bj * HALF) = w; } }
    }
};
template <class Epi, class Sched, bool ALIGN_EPI = false, bool SP2 = false>
__device__ __forceinline__ void gemm_phase(PG8_LAS unsigned char* lds, const Gemm g, const Sched& S, const Epi& E) {
    const int tid = LTID(), wid = __builtin_amdgcn_readfirstlane(tid >> 6), lane = tid & 63, wr = wid >> 2, wc = wid & 3, fr = lane & 15, fq = lane >> 4;
    const int K = g.K, nt = K / BK;
    unsigned voffA[2], voffB[2];
#pragma unroll
    for (int i = 0; i < 2; ++i) { int R, C; stage_rc(tid * 16 + i * 8192, R, C); const int Rb = Epi::PERM ? ((R & ~31) + perm32(R & 31)) : R;
        voffA[i] = (unsigned)(R * K + C) * 2u; voffB[i] = (unsigned)(Rb * K + C) * 2u; }
    const size_t kstep = (size_t)(BK * 2);
    const size_t hstep = (size_t)HALF * K * 2;
    const size_t tstep = 2 * hstep;
    const unsigned ldsw = (unsigned)wid * 1024u;
    const int aoff = lds_byte(wr * 64 + fr, fq * 8), boff = lds_byte(wc * 32 + fr, fq * 8);
#define PG8_SA(b, h) (((b) * 2 + (h)) * HTB)
#define PG8_SB(b, h) ((4 + (b) * 2 + (h)) * HTB)
#define PG8_STAGE(bufoff, gbase, voff) do { _Pragma("unroll") for (int _i = 0; _i < 2; ++_i) \
        __builtin_amdgcn_global_load_lds((const unsigned*)((const char*)(gbase) + (voff)[_i]), (PG8_LAS unsigned*)(lds + (bufoff) + ldsw + _i * 8192), 16, 0, 0); } while (0)
#define PG8_LDA(dst, b, h) do { _Pragma("unroll") for (int m = 0; m < 4; ++m) _Pragma("unroll") for (int k = 0; k < 2; ++k) dst[m][k] = *(const PG8_LAS bf16x8*)(lds + PG8_SA(b, h) + aoff + m * 2048 + k * 1024); } while (0)
#define PG8_LDB(dst, b, h) do { _Pragma("unroll") for (int n = 0; n < 2; ++n) _Pragma("unroll") for (int k = 0; k < 2; ++k) dst[n][k] = *(const PG8_LAS bf16x8*)(lds + PG8_SB(b, h) + boff + n * 2048 + k * 1024); } while (0)
#define PG8_MMA(ai, bj, At, Bt) do { __builtin_amdgcn_s_setprio(1); _Pragma("unroll") for (int m = 0; m < 4; ++m) _Pragma("unroll") for (int n = 0; n < 2; ++n) _Pragma("unroll") for (int k = 0; k < 2; ++k) \
        acc[ai][bj][m][n] = __builtin_amdgcn_mfma_f32_16x16x32_bf16(Bt[n][k], At[m][k], acc[ai][bj][m][n], 0, 0, 0); __builtin_amdgcn_s_setprio(0); } while (0)
#define PG8_WAIT_V(n) asm volatile("s_waitcnt vmcnt(" #n ")" ::: "memory")
#define PG8_WAIT_L(n) asm volatile("s_waitcnt lgkmcnt(" #n ")" ::: "memory")
#define PG8_BAR __builtin_amdgcn_s_barrier()
#define PG8_SCHED __builtin_amdgcn_sched_barrier(0)
    Unit cur, nxt; int ui = 0;
    if (!S.next(0, cur)) return;
    f32x4 acc[2][2][4][2];
#pragma unroll
    for (int a = 0; a < 2; ++a)
#pragma unroll
        for (int b = 0; b < 2; ++b)
#pragma unroll
            for (int m = 0; m < 4; ++m)
#pragma unroll
                for (int n = 0; n < 2; ++n) acc[a][b][m][n] = (f32x4){0.f, 0.f, 0.f, 0.f};
    bf16x8 At[4][2], B0[2][2], B1[2][2];
    const char* cA = (const char*)g.A + (size_t)cur.pm * tstep; const char* cB = (const char*)g.Bt + (size_t)cur.pn * tstep;
    S.a_ready(cur);
    if constexpr (SP2) {
        PG8_STAGE(PG8_SB(0, 0), cB, voffB); PG8_STAGE(PG8_SB(0, 1), cB + hstep, voffB); PG8_STAGE(PG8_SA(0, 0), cA, voffA); PG8_STAGE(PG8_SA(0, 1), cA + hstep, voffA);
        if (wr == 1) PG8_BAR;
        PG8_WAIT_V(2); PG8_BAR;
        PG8_STAGE(PG8_SB(1, 0), cB + kstep, voffB); PG8_STAGE(PG8_SA(1, 0), cA + kstep, voffA); PG8_STAGE(PG8_SB(1, 1), cB + hstep + kstep, voffB);
        PG8_WAIT_V(6); PG8_BAR;
    } else {
        PG8_STAGE(PG8_SB(0, 0), cB, voffB); PG8_STAGE(PG8_SA(0, 0), cA, voffA); PG8_STAGE(PG8_SB(0, 1), cB + hstep, voffB); PG8_STAGE(PG8_SA(0, 1), cA + hstep, voffA);
        if (wr == 1) PG8_BAR;
        PG8_WAIT_V(4); PG8_BAR;
        PG8_STAGE(PG8_SB(1, 0), cB + kstep, voffB); PG8_STAGE(PG8_SA(1, 0), cA + kstep, voffA); PG8_STAGE(PG8_SB(1, 1), cB + hstep + kstep, voffB);
        PG8_WAIT_V(6); PG8_BAR;
    }
    for (;;) {
        const bool has_next = S.next(ui + 1, nxt);
        const char* nA = has_next ? (const char*)g.A + (size_t)nxt.pm * tstep : cA; const char* nB = has_next ? (const char*)g.Bt + (size_t)nxt.pn * tstep : cB;
        for (int t = 0; t < nt; t += 2) {
            const bool last = (t == nt - 2);
            const char* a1 = cA + (size_t)(t + 1) * kstep;
            const char* a2 = last ? nA : cA + (size_t)(t + 2) * kstep; const char* b2 = last ? nB : cB + (size_t)(t + 2) * kstep;
            const char* a3 = a2 + kstep; const char* b3 = b2 + kstep;
            if (last && has_next) S.a_ready(nxt);
            if constexpr (SP2) {
            PG8_LDB(B0, 0, 0); PG8_LDB(B1, 0, 1); PG8_SCHED; PG8_LDA(At, 0, 0); PG8_STAGE(PG8_SA(1, 1), a1 + hstep, voffA);
            PG8_WAIT_V(8); PG8_WAIT_L(0); PG8_BAR; PG8_MMA(0, 0, At, B0); PG8_MMA(0, 1, At, B1); PG8_BAR; PG8_SCHED;
            PG8_LDA(At, 0, 1); PG8_STAGE(PG8_SB(0, 0), b2, voffB); PG8_STAGE(PG8_SB(0, 1), b2 + hstep, voffB); PG8_STAGE(PG8_SA(0, 0), a2, voffA);
            PG8_WAIT_V(8); PG8_WAIT_L(0); PG8_BAR; PG8_MMA(1, 0, At, B0); PG8_MMA(1, 1, At, B1); PG8_BAR; PG8_SCHED;
            PG8_LDB(B0, 1, 0); PG8_LDB(B1, 1, 1); PG8_SCHED; PG8_LDA(At, 1, 0); PG8_STAGE(PG8_SA(0, 1), a2 + hstep, voffA);
            PG8_WAIT_V(8); PG8_WAIT_L(0); PG8_BAR; PG8_MMA(0, 0, At, B0); PG8_MMA(0, 1, At, B1); PG8_BAR; PG8_SCHED;
            PG8_LDA(At, 1, 1); PG8_STAGE(PG8_SB(1, 0), b3, voffB); PG8_STAGE(PG8_SB(1, 1), b3 + hstep, voffB); PG8_STAGE(PG8_SA(1, 0), a3, voffA);
            PG8_WAIT_V(8); PG8_WAIT_L(0); PG8_BAR; PG8_MMA(1, 0, At, B0); PG8_MMA(1, 1, At, B1); PG8_BAR; PG8_SCHED;
            } else {
            PG8_LDB(B0, 0, 0); PG8_SCHED; PG8_LDA(At, 0, 0); PG8_STAGE(PG8_SA(1, 1), a1 + hstep, voffA);
            PG8_WAIT_L(8); PG8_BAR; PG8_WAIT_L(0); PG8_MMA(0, 0, At, B0); PG8_BAR; PG8_SCHED;
            PG8_LDB(B1, 0, 1); PG8_STAGE(PG8_SB(0, 0), b2, voffB);
            PG8_BAR; PG8_WAIT_L(0); PG8_MMA(0, 1, At, B1); PG8_BAR;
            PG8_LDA(At, 0, 1); PG8_STAGE(PG8_SA(0, 0), a2, voffA);
            PG8_BAR; PG8_WAIT_L(0); PG8_MMA(1, 0, At, B0); PG8_BAR; PG8_SCHED;
            PG8_STAGE(PG8_SB(0, 1), b2 + hstep, voffB);
            PG8_WAIT_V(6); PG8_BAR; PG8_MMA(1, 1, At, B1); PG8_BAR;
            PG8_LDB(B0, 1, 0); PG8_SCHED; PG8_LDA(At, 1, 0); PG8_STAGE(PG8_SA(0, 1), a2 + hstep, voffA);
            PG8_WAIT_L(8); PG8_BAR; PG8_WAIT_L(0); PG8_MMA(0, 0, At, B0); PG8_BAR; PG8_SCHED;
            PG8_LDB(B1, 1, 1); PG8_STAGE(PG8_SB(1, 0), b3, voffB);
            PG8_BAR; PG8_WAIT_L(0); PG8_MMA(0, 1, At, B1); PG8_BAR;
            PG8_LDA(At, 1, 1); PG8_STAGE(PG8_SA(1, 0), a3, voffA);
            PG8_BAR; PG8_WAIT_L(0); PG8_MMA(1, 0, At, B0); PG8_BAR; PG8_SCHED;
            PG8_STAGE(PG8_SB(1, 1), b3 + hstep, voffB);
            PG8_WAIT_V(6); PG8_BAR; PG8_MMA(1, 1, At, B1); PG8_BAR;
            }
        }
        if constexpr (ALIGN_EPI) { if (wr == 0) PG8_BAR; }
        if constexpr (!Epi::AFTER_DRAIN) { E(acc, cur, wr, wc, fr, fq); S.done(cur); }
        if (!has_next) break;
#pragma unroll
        for (int a = 0; a < 2; ++a)
#pragma unroll
            for (int b = 0; b < 2; ++b)
#pragma unroll
                for (int m = 0; m < 4; ++m)
#pragma unroll
                    for (int n = 0; n < 2; ++n) acc[a][b][m][n] = (f32x4){0.f, 0.f, 0.f, 0.f};
        cur = nxt; cA = nA; cB = nB; ++ui;
        if constexpr (ALIGN_EPI) { if (wr == 1) PG8_BAR; }
    }
    PG8_WAIT_V(0);
    if constexpr (!ALIGN_EPI) { if (wr == 0) PG8_BAR; }
    PG8_BAR;
    if constexpr (Epi::AFTER_DRAIN) { E.fused(acc, cur, wr, wc, fr, fq, lds, wid, lane); S.done(cur); }
#undef PG8_SA
#undef PG8_SB
#undef PG8_STAGE
#undef PG8_LDA
#undef PG8_LDB
#undef PG8_MMA
#undef PG8_WAIT_V
#undef PG8_WAIT_L
#undef PG8_BAR
#undef PG8_SCHED
}
}
namespace pg8 {
struct EpiF32 {
    static constexpr bool PERM = false, AFTER_DRAIN = false;
    float* O; int ldc;
    __device__ __forceinline__ void operator()(const f32x4 (&acc)[2][2][4][2], const Unit& u, int wr, int wc, int fr, int fq) const {
        const int row0 = u.pm * BM + wr * 64 + fr, col0 = u.pn * BM + wc * 32 + 4 * fq;
#pragma unroll
        for (int ai = 0; ai < 2; ++ai)
#pragma unroll
            for (int m = 0; m < 4; ++m) { float* rowp = O + (size_t)(row0 + ai * HALF + m * 16) * ldc + col0;
#pragma unroll
                for (int bj = 0; bj < 2; ++bj)
#pragma unroll
                    for (int n = 0; n < 2; ++n) *(f32x4*)(rowp + bj * HALF + n * 16) = acc[ai][bj][m][n]; }
    }
};
}

typedef unsigned short bf16;
constexpr int T_ = 16384, S_ = 4096, NBATCH = 4, D_ = 1024, NCOL = 6824, NP = 6912, DEPTH_ = 2;
constexpr int C_QA = 0, C_KA = 256, C_VA = 320, C_QI = 384, C_KI = 640, C_WI = 672, C_QB = 680, C_KB = 936, C_VB = 1064,
              C_QC = 1192, C_KC = 1448, C_VC = 1704, C_QD = 1960, C_KD = 2216, C_VD = 2472, C_G = 2728;
constexpr int NTHR = 512, NWAVE = 8;
constexpr float ALPHA = 1.41421356237309515f;
constexpr float LN_EPS = 1e-5f;
constexpr size_t MiB = 1u << 20;
constexpr size_t WS_CTL = 0, WS_WIN_T = 2 * MiB, WS_WOUT_T = 30 * MiB, WS_WQ_T = 34 * MiB, WS_WBR_T = 38 * MiB, WS_HB = 42 * MiB,
                 WS_P = 74 * MiB, WS_MIX = 74 * MiB  , WS_Q = 138 * MiB  , WS_YS = 290 * MiB, WS_MRG = 322 * MiB,
                 WS_MASK = 354 * MiB, WS_EID = 362 * MiB, WS_GATE = 370 * MiB, WS_KMEAN = 378 * MiB, WS_UV = 380 * MiB, WS_END = 508 * MiB;
constexpr size_t WIN_T_BYTES = (size_t)NP * 1024 * 2;
constexpr int LDS_BYTES = 144 * 1024;

struct Params { const float* in[13]; float* out; unsigned char* ws; };

__device__ __forceinline__ float bf2f(bf16 v) { return __uint_as_float((unsigned)v << 16); }
__device__ __forceinline__ unsigned f2bf(float f) { unsigned u = __float_as_uint(f); return (u + 0x7fffu + ((u >> 16) & 1u)) >> 16; }
__device__ __forceinline__ unsigned pk2(float lo, float hi) { return f2bf(lo) | (f2bf(hi) << 16); }
__device__ __forceinline__ void unpack8(const uint4 v, float* o) {
    o[0] = __uint_as_float(v.x << 16); o[1] = __uint_as_float(v.x & 0xffff0000u); o[2] = __uint_as_float(v.y << 16); o[3] = __uint_as_float(v.y & 0xffff0000u);
    o[4] = __uint_as_float(v.z << 16); o[5] = __uint_as_float(v.z & 0xffff0000u); o[6] = __uint_as_float(v.w << 16); o[7] = __uint_as_float(v.w & 0xffff0000u);
}
__device__ __forceinline__ float wave_sum(float v) {
#pragma unroll
    for (int o = 32; o > 0; o >>= 1) v += __shfl_xor(v, o);
    return v;
}
__device__ __forceinline__ float wave_max(float v) {
#pragma unroll
    for (int o = 32; o > 0; o >>= 1) v = fmaxf(v, __shfl_xor(v, o));
    return v;
}
__device__ __forceinline__ int wave_sum_i(int v) {
#pragma unroll
    for (int o = 32; o > 0; o >>= 1) v += __shfl_xor(v, o);
    return v;
}
__device__ __forceinline__ float logsig(float x) { return fminf(x, 0.f) - log1pf(expf(-fabsf(x))); }

__device__ void transpose_items(const float* W, int K, int N, bf16* WT, float* sm, int item0, int nitems_total, int item_stride) {
    const int tid = LTID();
    const int nkb = K / 64, nnb = (N + 63) / 64;
    for (int it = item0; it < nkb * nnb; it += item_stride) {
        const int kb = it % nkb, nb = it / nkb, k0 = kb * 64, n0 = nb * 64;
        __syncthreads();
        for (int e = tid; e < 64 * 64; e += NTHR) { const int kk = e >> 6, nn = e & 63; sm[kk * 65 + nn] = (n0 + nn < N) ? W[(size_t)(k0 + kk) * N + n0 + nn] : 0.f; }
        __syncthreads();
        { const int nn = tid >> 3, c = tid & 7;
          if (n0 + nn < N) { uint4 o; o.x = pk2(sm[(8 * c + 0) * 65 + nn], sm[(8 * c + 1) * 65 + nn]); o.y = pk2(sm[(8 * c + 2) * 65 + nn], sm[(8 * c + 3) * 65 + nn]);
              o.z = pk2(sm[(8 * c + 4) * 65 + nn], sm[(8 * c + 5) * 65 + nn]); o.w = pk2(sm[(8 * c + 6) * 65 + nn], sm[(8 * c + 7) * 65 + nn]);
              *(uint4*)(WT + (size_t)(n0 + nn) * K + k0 + 8 * c) = o; } }
    }
    __syncthreads();
}
__device__ void prologue_phase(const Params& p, float* sm) {
    const int tid = LTID(), B = LBID(), G = LGRID();
    unsigned char* ws = p.ws;
    for (int l = 0; l < DEPTH_; ++l) {
        bf16* win_t = (bf16*)(ws + WS_WIN_T + l * WIN_T_BYTES);
        transpose_items(p.in[1] + (size_t)l * 1024 * NCOL, 1024, NCOL, win_t, sm, B, 0, G);
        for (int i = B * NTHR + tid; i < (NP - NCOL) * 1024 / 8; i += G * NTHR) ((uint4*)(win_t + (size_t)NCOL * 1024))[i] = make_uint4(0u, 0u, 0u, 0u);
        transpose_items(p.in[3] + (size_t)l * 1024 * 1024, 1024, 1024, (bf16*)(ws + WS_WOUT_T) + (size_t)l * 1024 * 1024, sm, B, 0, G);
        transpose_items(p.in[7] + (size_t)l * 1024 * 1024, 1024, 1024, (bf16*)(ws + WS_WQ_T) + (size_t)l * 1024 * 1024, sm, B, 0, G);
        for (int n = 0; n < 4; ++n)
            transpose_items(p.in[2] + ((size_t)l * 4 + n) * 256 * 1024, 256, 1024, (bf16*)(ws + WS_WBR_T) + ((size_t)l * 4 + n) * 1024 * 256, sm, B, 0, G);
    }
    const float4* x4 = (const float4*)p.in[0]; uint2* hb2 = (uint2*)(ws + WS_HB);
    for (size_t i = (size_t)B * NTHR + tid; i < (size_t)T_ * 1024 / 4; i += (size_t)G * NTHR) { const float4 v = x4[i]; hb2[i] = make_uint2(pk2(v.x, v.y), pk2(v.z, v.w)); }
}

__device__ __forceinline__ int block_sum_i(int v, unsigned* red, int slot) {
    v = wave_sum_i(v);
    if ((LTID() & 63) == 0) red[slot * 8 + (LTID() >> 6)] = (unsigned)v;
    __syncthreads();
    int s = 0;
#pragma unroll
    for (int w = 0; w < 8; ++w) s += (int)red[slot * 8 + w];
    return s;
}
__device__ void index_phase(const bf16* P, unsigned char* mask, float* kmean, float* sm) {
    float* s_qi = sm;
    float* s_wi = sm + 256;
    unsigned* s_red = (unsigned*)(sm + 272);
    unsigned* s_key = (unsigned*)(sm + 320);
    const int tid = LTID(), lane = tid & 63, wave = tid >> 6;
    for (int o = LBID() * NTHR + tid; o < 4 * 4 * 16 * 64; o += LGRID() * NTHR) {
        const int d = o & 63, blk = (o >> 6) & 15, h = (o >> 10) & 3, b = o >> 12;
        float s = 0.f;
        for (int j = 0; j < 256; ++j) s += bf2f(P[(size_t)(b * S_ + blk * 256 + j) * NP + C_KC + h * 64 + d]);
        kmean[((b * 4 + h) * 16 + blk) * 64 + d] = s * (1.0f / 256.0f);
    }
    int slot = 0;
    for (int gq = LBID(); gq < T_; gq += LGRID()) {
        const int b = gq >> 12, q = gq & 4095;
        const bf16* Pb = P + (size_t)b * S_ * NP;
        __syncthreads();
        if (tid < 256) s_qi[tid] = bf2f(Pb[(size_t)q * NP + C_QI + tid]);
        else if (tid < 264) s_wi[tid - 256] = bf2f(Pb[(size_t)q * NP + C_WI + tid - 256]);
        __syncthreads();
#pragma unroll 1
        for (int j = 0; j < 8; ++j) {
            const int s = tid * 8 + j;
            unsigned key = 0u;
            if (s <= q) {
                const uint4* kr = (const uint4*)(Pb + (size_t)s * NP + C_KI);
                float kv[32];
#pragma unroll
                for (int c = 0; c < 4; ++c) unpack8(kr[c], kv + 8 * c);
                float sc = 0.f;
#pragma unroll 1
                for (int h = 0; h < 8; ++h) {
                    float d = 0.f;
#pragma unroll
                    for (int dd = 0; dd < 32; ++dd) d += s_qi[h * 32 + dd] * kv[dd];
                    sc += fmaxf(d, 0.f) * s_wi[h];
                }
                sc *= 0.0625f;
                if (sc == 0.f) sc = 0.f;
                const unsigned u = __float_as_uint(sc);
                key = (u & 0x80000000u) ? ~u : (u | 0x80000000u);
            }
            s_key[s] = key;
        }
        unsigned kk[8];
        { const uint4 k0 = *(const uint4*)&s_key[tid * 8], k1 = *(const uint4*)&s_key[tid * 8 + 4];
          kk[0] = k0.x; kk[1] = k0.y; kk[2] = k0.z; kk[3] = k0.w; kk[4] = k1.x; kk[5] = k1.y; kk[6] = k1.z; kk[7] = k1.w; }
        unsigned byte = 0u;
        if (q + 1 > 256) {
            unsigned prefix = 0u;
            for (int bit = 31; bit >= 0; --bit) {
                const unsigned cand = prefix | (1u << bit);
                int c = 0;
#pragma unroll
                for (int j = 0; j < 8; ++j) c += (kk[j] >= cand) ? 1 : 0;
                c = block_sum_i(c, s_red, slot); slot ^= 1;
                if (c >= 256) prefix = cand;
            }
            int cgt = 0, ceq = 0;
#pragma unroll
            for (int j = 0; j < 8; ++j) { cgt += (kk[j] > prefix) ? 1 : 0; ceq += (kk[j] == prefix) ? 1 : 0; }
            const int tot_gt = block_sum_i(cgt, s_red, slot); slot ^= 1;
            const int need = 256 - tot_gt;
            int incl = ceq;
#pragma unroll
            for (int o = 1; o < 64; o <<= 1) { const int t2 = __shfl_up(incl, o); if (lane >= o) incl += t2; }
            if (lane == 63) s_red[16 + wave] = (unsigned)incl;
            __syncthreads();
            int woff = 0;
            for (int w = 0; w < wave; ++w) woff += (int)s_red[16 + w];
            int taken = woff + incl - ceq;
#pragma unroll
            for (int j = 0; j < 8; ++j) {
                bool sel = kk[j] > prefix;
                if (kk[j] == prefix) { if (taken < need) sel = true; ++taken; }
                byte |= (sel ? 1u : 0u) << j;
            }
        } else {
#pragma unroll
            for (int j = 0; j < 8; ++j) byte |= ((tid * 8 + j) <= q ? 1u : 0u) << j;
        }
        mask[(size_t)gq * 512 + tid] = (unsigned char)byte;
    }
    __syncthreads();
}

__device__ __forceinline__ float dot64(const bf16* kr, const float* sq) {
    const uint4* k4 = (const uint4*)kr;
    float d = 0.f;
#pragma unroll 2
    for (int c = 0; c < 8; ++c) { float kv[8]; unpack8(k4[c], kv);
#pragma unroll
        for (int j = 0; j < 8; ++j) d += kv[j] * sq[8 * c + j]; }
    return d;
}
__device__ __forceinline__ float attend_list(int n, const int* idx, const float* sq, const bf16* Kb, const bf16* Vb, float slope, int qpos,
                                             float sink, bool has_sink, float* lg, int lane) {
    float m = -INFINITY;
    for (int i = lane; i < n; i += 64) {
        const int key = idx[i];
        const float d = dot64(Kb + (size_t)key * NP, sq);
        const float l = d * 0.125f - slope * (float)(qpos - key);
        lg[i] = l; m = fmaxf(m, l);
    }
    m = wave_max(m);
    if (has_sink) m = fmaxf(m, sink);
    float sum = 0.f;
    for (int i = lane; i < n; i += 64) { const float e = expf(lg[i] - m); lg[i] = e; sum += e; }
    sum = wave_sum(sum);
    if (has_sink) sum += expf(sink - m);
    float acc = 0.f;
    for (int i = 0; i < n; ++i) acc += lg[i] * bf2f(Vb[(size_t)idx[i] * NP + lane]);
    return acc / sum;
}

__device__ void attn_phase(const bf16* P, const unsigned char* mask, const float* kmean, const float* sinks, bf16* ys, float* sm) {
    const int tid = LTID(), lane = tid & 63, wave = tid >> 6;
    float* wsm = sm + wave * 2304;
    int* idx = (int*)wsm; float* lg = wsm + 1024; float* sq = wsm + 2048;
    const int gw = LBID() * NWAVE + wave, NGW = LGRID() * NWAVE;
    for (int it = gw; it < 13 * T_; it += NGW) {
        const int kind = it / T_, gt = it % T_, b = gt >> 12, t = gt & 4095;
        const bf16* Pb = P + (size_t)b * S_ * NP;
        bf16* yrow = ys + (size_t)gt * 1024;
        const bf16* prow = Pb + (size_t)t * NP;
        if (kind == 0) {
            for (int i = lane; i < 256; i += 64) sq[i] = bf2f(prow[C_QA + i]);
            const unsigned long long* mrow = (const unsigned long long*)(mask + (size_t)gt * 512);
            unsigned long long w = mrow[lane];
            const int c = __popcll(w);
            int incl = c;
#pragma unroll
            for (int o = 1; o < 64; o <<= 1) { const int t2 = __shfl_up(incl, o); if (lane >= o) incl += t2; }
            int pos = incl - c;
            const int ntot = __shfl(incl, 63);
            while (w) { const int bit = __ffsll((long long)w) - 1; w &= w - 1; idx[pos++] = lane * 64 + bit; }
            for (int h = 0; h < 4; ++h) {
                const float slope = exp2f(-8.0f * (float)(3 * h + 1) / 12.0f);
                const float o = attend_list(ntot, idx, sq + h * 64, Pb + C_KA, Pb + C_VA, slope, t, 0.f, false, lg, lane);
                yrow[h * 64 + lane] = (bf16)f2bf(o);
            }
        } else if (kind <= 4) {
            const int hq = kind - 1, kvh = hq >> 1;
            sq[lane] = bf2f(prow[C_QB + hq * 64 + lane]);
            const int lo = (t - 127 > 0) ? t - 127 : 0, n = t - lo + 1;
            for (int i = lane; i < n; i += 64) idx[i] = lo + i;
            const float slope = exp2f(-8.0f * (float)(3 * hq + 2) / 12.0f);
            const float o = attend_list(n, idx, sq, Pb + C_KB + kvh * 64, Pb + C_VB + kvh * 64, slope, t, sinks[hq], true, lg, lane);
            yrow[256 + hq * 64 + lane] = (bf16)f2bf(o);
        } else if (kind <= 8) {
            const int h = kind - 5, own = t >> 8;
            sq[lane] = bf2f(prow[C_QC + h * 64 + lane]);
            float g = -INFINITY;
            if (lane < own) {
                const float* km = kmean + ((b * 4 + h) * 16 + lane) * 64;
                float d = 0.f;
                for (int dd = 0; dd < 64; ++dd) d += sq[dd] * km[dd];
                g = d;
            }
            int nb = 0;
            for (int r = 0; r < 3; ++r) {
                const float mx = wave_max(g);
                if (mx == -INFINITY) break;
                const unsigned long long bal = __ballot(g == mx);
                const int wl = __ffsll((long long)bal) - 1;
                for (int i = lane; i < 256; i += 64) idx[nb * 256 + i] = wl * 256 + i;
                ++nb;
                if (lane == wl) g = -INFINITY;
            }
            const int nown = t - own * 256 + 1;
            for (int i = lane; i < nown; i += 64) idx[nb * 256 + i] = own * 256 + i;
            const float slope = exp2f(-8.0f * (float)(3 * h + 3) / 12.0f);
            const float o = attend_list(nb * 256 + nown, idx, sq, Pb + C_KC + h * 64, Pb + C_VC + h * 64, slope, t, 0.f, false, lg, lane);
            yrow[512 + h * 64 + lane] = (bf16)f2bf(o);
        } else {
            const int h = kind - 9;
            sq[lane] = bf2f(prow[C_QD + h * 64 + lane]);
            const bf16* Kb = Pb + C_KD + h * 64; const bf16* Vb = Pb + C_VD + h * 64;
            float acc = 0.f, carry = 0.f;
            for (int base = t - 1; base >= 0; base -= 64) {
                const int s = base - lane;
                const bool ok = s >= 0;
                float z = 0.f, lk = 0.f;
                if (ok) { z = dot64(Kb + (size_t)s * NP, sq) * 0.125f; lk = logsig(-z); }
                float incl = lk;
#pragma unroll
                for (int o = 1; o < 64; o <<= 1) { const float t2 = __shfl_up(incl, o); if (lane >= o) incl += t2; }
                const float la = carry + incl - lk;
                const float a = ok ? expf(logsig(z) + la) : 0.f;
                carry += __shfl(incl, 63);
                lg[lane] = a;
                const int cnt = (base + 1 < 64) ? base + 1 : 64;
                for (int j = 0; j < cnt; ++j) acc += lg[j] * bf2f(Vb[(size_t)(base - j) * NP + lane]);
            }
            yrow[768 + h * 64 + lane] = (bf16)f2bf(acc);
        }
    }
    __syncthreads();
}

__device__ void merge_phase(const bf16* P, const bf16* ys, const float* wb, bf16* merged, float* sm) {
    const int tid = LTID();
    for (int grp = LBID(); grp < T_ / 8; grp += LGRID()) {
        const int t0 = grp * 8;
        __syncthreads();
        for (int i = tid; i < 8 * 1024; i += NTHR) sm[i] = bf2f(ys[(size_t)t0 * 1024 + i]);
        __syncthreads();
        float mer[8][2];
#pragma unroll
        for (int k = 0; k < 8; ++k) { mer[k][0] = 0.f; mer[k][1] = 0.f; }
        for (int n = 0; n < 4; ++n) {
            float acc[8][2];
#pragma unroll
            for (int k = 0; k < 8; ++k) { acc[k][0] = 0.f; acc[k][1] = 0.f; }
            const float* w = wb + (size_t)n * 256 * 1024;
#pragma unroll 2
            for (int c = 0; c < 256; ++c) {
                const float w0 = w[(size_t)c * 1024 + tid], w1 = w[(size_t)c * 1024 + tid + 512];
#pragma unroll
                for (int k = 0; k < 8; ++k) { const float y = sm[k * 1024 + n * 256 + c]; acc[k][0] += y * w0; acc[k][1] += y * w1; }
            }
#pragma unroll
            for (int k = 0; k < 8; ++k) {
                const bf16* gr = P + (size_t)(t0 + k) * NP + C_G + n * 1024;
                const float g0 = bf2f(gr[tid]), g1 = bf2f(gr[tid + 512]);
                mer[k][0] += acc[k][0] / (1.f + expf(-g0));
                mer[k][1] += acc[k][1] / (1.f + expf(-g1));
            }
        }
#pragma unroll
        for (int k = 0; k < 8; ++k) {
            merged[(size_t)(t0 + k) * 1024 + tid] = (bf16)f2bf(mer[k][0]);
            merged[(size_t)(t0 + k) * 1024 + tid + 512] = (bf16)f2bf(mer[k][1]);
        }
    }
    __syncthreads();
}

__device__ __forceinline__ void ln_row(float4 (&v)[4], const float* g, const float* bb, float* orow, bf16* obrow, int lane) {
    float s = 0.f;
#pragma unroll
    for (int j = 0; j < 4; ++j) s += (v[j].x + v[j].y) + (v[j].z + v[j].w);
    const float mean = wave_sum(s) * (1.0f / 1024.0f);
    float s2 = 0.f;
#pragma unroll
    for (int j = 0; j < 4; ++j) { v[j].x -= mean; v[j].y -= mean; v[j].z -= mean; v[j].w -= mean; s2 += (v[j].x * v[j].x + v[j].y * v[j].y) + (v[j].z * v[j].z + v[j].w * v[j].w); }
    const float rstd = 1.0f / sqrtf(wave_sum(s2) * (1.0f / 1024.0f) + LN_EPS);
#pragma unroll
    for (int j = 0; j < 4; ++j) {
        const float4 gg = ((const float4*)g)[j * 64 + lane], b4 = ((const float4*)bb)[j * 64 + lane];
        float4 o; o.x = v[j].x * rstd * gg.x + b4.x; o.y = v[j].y * rstd * gg.y + b4.y; o.z = v[j].z * rstd * gg.z + b4.z; o.w = v[j].w * rstd * gg.w + b4.w;
        ((float4*)orow)[j * 64 + lane] = o;
        ((uint2*)obrow)[j * 64 + lane] = make_uint2(pk2(o.x, o.y), pk2(o.z, o.w));
    }
}
__device__ void ln1_phase(const float* hin, const float* add, const float* g, const float* bb, float* hout, bf16* hb) {
    const int lane = LTID() & 63, wave = LTID() >> 6;
    for (int row = LBID() * NWAVE + wave; row < T_; row += LGRID() * NWAVE) {
        float4 v[4];
#pragma unroll
        for (int j = 0; j < 4; ++j) {
            const float4 a = ((const float4*)(hin + (size_t)row * 1024))[j * 64 + lane], m = ((const float4*)(add + (size_t)row * 1024))[j * 64 + lane];
            v[j].x = ALPHA * a.x + m.x; v[j].y = ALPHA * a.y + m.y; v[j].z = ALPHA * a.z + m.z; v[j].w = ALPHA * a.w + m.w;
        }
        ln_row(v, g, bb, hout + (size_t)row * 1024, hb + (size_t)row * 1024, lane);
    }
}

__device__ void route_phase(const float* qb, const float* subkeys, int* eid, float* gate) {
    const int lane = LTID() & 63, wave = LTID() >> 6;
    for (int it = LBID() * NWAVE + wave; it < T_ * 8; it += LGRID() * NWAVE) {
        const int t = it >> 3, h = it & 7;
        float stop[2]; int itop[2];
#pragma unroll
        for (int p = 0; p < 2; ++p) {
            const float* qv = qb + (size_t)t * 1024 + h * 128 + p * 64;
            const float* sk0 = subkeys + ((size_t)(h * 2 + p) * 128 + lane) * 64;
            const float* sk1 = sk0 + 64 * 64;
            float v0 = 0.f, v1 = 0.f;
            for (int d = 0; d < 64; ++d) { const float qd = qv[d]; v0 += qd * sk0[d]; v1 += qd * sk1[d]; }
            float sv = 0.f; int si = 0;
            for (int r = 0; r < 16; ++r) {
                const float loc = fmaxf(v0, v1);
                const float mx = wave_max(loc);
                const unsigned long long b0 = __ballot(v0 == mx), b1 = __ballot(v1 == mx);
                int win;
                if (b0) win = __ffsll((long long)b0) - 1; else win = 64 + __ffsll((long long)b1) - 1;
                if (lane == r) { sv = mx; si = win; }
                if (win < 64) { if (lane == win) v0 = -INFINITY; } else { if (lane == win - 64) v1 = -INFINITY; }
            }
            stop[p] = sv; itop[p] = si;
        }
        float cv[4];
#pragma unroll
        for (int c = 0; c < 4; ++c) { const int ci = lane * 4 + c; cv[c] = __shfl(stop[0], ci >> 4) + __shfl(stop[1], ci & 15); }
        float sc = 0.f; int sci = 0;
        for (int r = 0; r < 16; ++r) {
            const float loc = fmaxf(fmaxf(cv[0], cv[1]), fmaxf(cv[2], cv[3]));
            const float mx = wave_max(loc);
            int mine = 1 << 30;
#pragma unroll
            for (int c = 3; c >= 0; --c) if (cv[c] == mx) mine = lane * 4 + c;
            int win = mine;
#pragma unroll
            for (int o = 32; o > 0; o >>= 1) { const int t2 = __shfl_xor(win, o); win = t2 < win ? t2 : win; }
            if (lane == r) { sc = mx; sci = win; }
#pragma unroll
            for (int c = 0; c < 4; ++c) if (lane * 4 + c == win) cv[c] = -INFINITY;
        }
        const int i1 = __shfl(itop[0], sci >> 4), i2 = __shfl(itop[1], sci & 15);
        const float scm = (lane < 16) ? sc : -INFINITY;
        const float m = wave_max(scm);
        const float e = (lane < 16) ? expf(sc - m) : 0.f;
        const float sum = wave_sum(e);
        if (lane < 16) { eid[(size_t)t * 128 + h * 16 + lane] = i1 * 128 + i2; gate[(size_t)t * 128 + h * 16 + lane] = e / sum; }
    }
}

__device__ void peer_phase(float* h, bf16* hb, const int* eid, const float* gate, const float* U, const float* V, const float* g, const float* bb) {
    const int lane = LTID() & 63, wave = LTID() >> 6;
    for (int t = LBID() * NWAVE + wave; t < T_; t += LGRID() * NWAVE) {
        float4 x[4], acc[4];
#pragma unroll
        for (int j = 0; j < 4; ++j) { x[j] = ((const float4*)(h + (size_t)t * 1024))[j * 64 + lane]; acc[j] = make_float4(0.f, 0.f, 0.f, 0.f); }
        for (int e = 0; e < 128; ++e) {
            const int id = eid[(size_t)t * 128 + e];
            const float gt = gate[(size_t)t * 128 + e];
            const float4* ur = (const float4*)(U + (size_t)id * 1024);
            const float4* vr = (const float4*)(V + (size_t)id * 1024);
            float d = 0.f;
#pragma unroll
            for (int j = 0; j < 4; ++j) { const float4 u4 = ur[j * 64 + lane]; d += (u4.x * x[j].x + u4.y * x[j].y) + (u4.z * x[j].z + u4.w * x[j].w); }
            d = wave_sum(d);
            const float hv = 0.5f * d * (1.0f + erff(d * 0.70710678118654752f)) * gt;
#pragma unroll
            for (int j = 0; j < 4; ++j) { const float4 v4 = vr[j * 64 + lane]; acc[j].x += hv * v4.x; acc[j].y += hv * v4.y; acc[j].z += hv * v4.z; acc[j].w += hv * v4.w; }
        }
        float4 v[4];
#pragma unroll
        for (int j = 0; j < 4; ++j) { v[j].x = ALPHA * x[j].x + acc[j].x; v[j].y = ALPHA * x[j].y + acc[j].y; v[j].z = ALPHA * x[j].z + acc[j].z; v[j].w = ALPHA * x[j].w + acc[j].w; }
        ln_row(v, g, bb, h + (size_t)t * 1024, hb + (size_t)t * 1024, lane);
    }
}

typedef short bf16x8_t __attribute__((ext_vector_type(8)));
typedef float f32x16_t __attribute__((ext_vector_type(16)));
typedef float f32x2_t __attribute__((ext_vector_type(2)));
typedef __bf16 bf16x2_t __attribute__((ext_vector_type(2)));
__device__ __forceinline__ unsigned cvtpk(float lo, float hi) { f32x2_t v = {lo, hi}; bf16x2_t b = __builtin_convertvector(v, bf16x2_t); return __builtin_bit_cast(unsigned, b); }
__device__ __forceinline__ int crow(int r, int hi) { return (r & 3) + 8 * (r >> 2) + 4 * hi; }
__device__ __forceinline__ float xlane32(float v) { return __shfl_xor(v, 32); }

constexpr int AT_KP = 72, AT_VP = 68;
constexpr int AT_KS = 0, AT_KS_BYTES = 64 * AT_KP * 2;
constexpr int AT_VT = 2 * AT_KS_BYTES, AT_VT_BYTES = 64 * AT_VP * 2;
constexpr int AT_KM = AT_VT + 2 * AT_VT_BYTES;
constexpr int AT_MISC = AT_KM + 32 * AT_KP * 2;
constexpr float LOG2E = 1.4426950408889634f;

__device__ __forceinline__ unsigned mk_unit(int kind, int b, int x, int y) { return ((unsigned)kind << 30) | ((unsigned)b << 28) | ((unsigned)x << 8) | (unsigned)y; }
__device__ void build_unit_table(unsigned* tab, int i) {
    int n = 0; unsigned res = 0u;
#pragma unroll 1
    for (int c = 64; c >= 1; --c) {
        if (i >= n && i < n + 4) res = mk_unit(0, i - n, 0, c - 1);
        n += 4;
        if ((c & 3) == 0) { if (i >= n && i < n + 16) { const int j = i - n; res = mk_unit(2, j >> 2, j & 3, c / 4 - 1); } n += 16; }
    }
    if (i < 512) tab[i] = res;
}

template <int kind> __device__ __forceinline__ void attn_unit(const bf16* P, const unsigned char* mask, const float* kmean, const float* sinks, bf16* ys,
                                unsigned char* lds, int b, int ux, int uy) {
    int tid_ = LTID(); asm volatile("" : "+v"(tid_));
    const int tid = tid_, lane = tid & 63, wave = __builtin_amdgcn_readfirstlane(tid >> 6), r32 = lane & 31, hi = lane >> 5;
    bf16* s_km = (bf16*)(lds + AT_KM);
    const int skey = tid >> 3, sc = tid & 7;
    {
        const bf16* Pb = P + (size_t)b * S_ * NP;
        int q0w, qcol, kcol, vcol, ycol, kt_hi, kt_lo; float slope2 = 0.f, sink2 = 0.f;
        if (kind == 0) { const int head = wave >> 1; q0w = uy * 64 + (wave & 1) * 32; qcol = C_QA + head * 64; kcol = C_KA; vcol = C_VA; ycol = head * 64;
            slope2 = exp2f(-8.0f * (float)(3 * head + 1) / 12.0f) * LOG2E; kt_hi = uy; kt_lo = 0; }
        else if (kind == 1) { const int hq = ux * 2 + (wave >> 2); q0w = uy * 128 + (wave & 3) * 32; qcol = C_QB + hq * 64; kcol = C_KB + ux * 64; vcol = C_VB + ux * 64; ycol = 256 + hq * 64;
            slope2 = exp2f(-8.0f * (float)(3 * hq + 2) / 12.0f) * LOG2E; sink2 = sinks[hq] * LOG2E; kt_hi = 2 * uy + 1; kt_lo = (2 * uy - 2 > 0) ? 2 * uy - 2 : 0; }
        else if (kind == 2) { q0w = uy * 256 + wave * 32; qcol = C_QC + ux * 64; kcol = C_KC + ux * 64; vcol = C_VC + ux * 64; ycol = 512 + ux * 64;
            slope2 = exp2f(-8.0f * (float)(3 * ux + 3) / 12.0f) * LOG2E; kt_hi = 4 * uy + 3; kt_lo = 0; }
        else { q0w = uy * 256 + wave * 32; qcol = C_QD + ux * 64; kcol = C_KD + ux * 64; vcol = C_VD + ux * 64; ycol = 768 + ux * 64; kt_hi = 4 * uy + 3; kt_lo = 0; }
        const int qpos = q0w + r32;
        bf16x8_t qf[4];
        { const bf16* qp = Pb + (size_t)qpos * NP + qcol + 8 * hi;
#pragma unroll
          for (int ks = 0; ks < 4; ++ks) qf[ks] = *(const bf16x8_t*)(qp + 16 * ks); }
        unsigned bm = 0u;
        if (kind == 2) {
            const int own = uy;
            for (int e = tid; e < 32 * 64; e += NTHR) { const int row = e >> 6, d = e & 63; s_km[row * AT_KP + d] = (row < 16) ? (bf16)f2bf(kmean[((b * 4 + ux) * 16 + row) * 64 + d]) : (bf16)0; }
            __syncthreads();
            f32x16_t gacc;
#pragma unroll
            for (int r = 0; r < 16; ++r) gacc[r] = 0.f;
#pragma unroll
            for (int ks = 0; ks < 4; ++ks) { const bf16x8_t a = *(const bf16x8_t*)(s_km + r32 * AT_KP + 16 * ks + 8 * hi); gacc = __builtin_amdgcn_mfma_f32_32x32x16_bf16(a, qf[ks], gacc, 0, 0, 0); }
            float gt[16];
#pragma unroll
            for (int r = 0; r < 8; ++r) { const float mine = gacc[r], other = xlane32(mine); const int bi = crow(r, 0);
                gt[bi] = hi ? other : mine; gt[bi + 4] = hi ? mine : other; }
#pragma unroll
            for (int n = 0; n < 16; ++n) if (n >= own) gt[n] = -INFINITY;
#pragma unroll
            for (int rep = 0; rep < 3; ++rep) {
                float mx = -INFINITY;
#pragma unroll
                for (int n = 0; n < 16; ++n) mx = fmaxf(mx, gt[n]);
                bool done = !(mx > -INFINITY);
#pragma unroll
                for (int n = 0; n < 16; ++n) { const bool hit = !done && gt[n] == mx; if (hit) { bm |= 1u << n; gt[n] = -INFINITY; done = true; } }
            }
        }
        f32x16_t o0, o1;
#pragma unroll
        for (int r = 0; r < 16; ++r) { o0[r] = 0.f; o1[r] = 0.f; }
        float m_run = -INFINITY, l_run = 0.f, carry = 0.f;
        const bf16* kg = Pb + (size_t)skey * NP + kcol + sc * 8;
        const bf16* vg = Pb + (size_t)skey * NP + vcol + sc * 8;
        uint4 rk = *(const uint4*)(kg + (size_t)kt_hi * 64 * NP), rv = *(const uint4*)(vg + (size_t)kt_hi * 64 * NP);
        int buf = 0;
        { bf16* ks_ = (bf16*)(lds + AT_KS); bf16* vt_ = (bf16*)(lds + AT_VT);
          *(uint4*)(ks_ + skey * AT_KP + sc * 8) = rk;
          const unsigned vw[4] = {rv.x, rv.y, rv.z, rv.w};
#pragma unroll
          for (int j = 0; j < 4; ++j) { vt_[(sc * 8 + 2 * j) * AT_VP + skey] = (bf16)(vw[j] & 0xffffu); vt_[(sc * 8 + 2 * j + 1) * AT_VP + skey] = (bf16)(vw[j] >> 16); } }
        __syncthreads();
        bool wave_done = false;
        for (int kt = kt_hi; kt >= kt_lo; --kt) {
            const bool more = kt > kt_lo;
            if (more) { rk = *(const uint4*)(kg + (size_t)(kt - 1) * 64 * NP); rv = *(const uint4*)(vg + (size_t)(kt - 1) * 64 * NP); }
            const bf16* ks_ = (const bf16*)(lds + AT_KS + buf * AT_KS_BYTES);
            const bf16* vt_ = (const bf16*)(lds + AT_VT + buf * AT_VT_BYTES);
            bool active = (kt * 64 <= q0w + 31) && !wave_done;
            if (kind == 1) active = active && (kt * 64 + 63 >= q0w - 127);
            if (active) {
                f32x16_t p0, p1;
#pragma unroll
                for (int r = 0; r < 16; ++r) { p0[r] = 0.f; p1[r] = 0.f; }
#pragma unroll
                for (int ks = 0; ks < 4; ++ks) {
                    const bf16x8_t a0 = *(const bf16x8_t*)(ks_ + r32 * AT_KP + 16 * ks + 8 * hi);
                    const bf16x8_t a1 = *(const bf16x8_t*)(ks_ + (32 + r32) * AT_KP + 16 * ks + 8 * hi);
                    p0 = __builtin_amdgcn_mfma_f32_32x32x16_bf16(a0, qf[ks], p0, 0, 0, 0);
                    p1 = __builtin_amdgcn_mfma_f32_32x32x16_bf16(a1, qf[ks], p1, 0, 0, 0);
                }
                const int kbase = kt * 64 + 4 * hi;
                if (kind != 3) {
                    unsigned w0 = 0xffffffffu, w1 = 0xffffffffu;
                    bool tile_ok = true;
                    if (kind == 0) { const uint2 mw = *(const uint2*)(mask + (size_t)(b * S_ + qpos) * 512 + kt * 8); w0 = mw.x >> (4 * hi); w1 = mw.y >> (4 * hi); }
                    if (kind == 2) tile_ok = ((kt >> 2) == uy) || (((bm >> (kt >> 2)) & 1u) != 0u);
                    const float cb = slope2 * (float)(kbase - qpos);
                    float mx = -INFINITY;
#pragma unroll
                    for (int r = 0; r < 16; ++r) {
                        const int off = (r & 3) + 8 * (r >> 2);
                        const int kp0 = kbase + off, kp1 = kp0 + 32;
                        bool v0 = tile_ok, v1 = tile_ok;
                        if (kind == 0) { v0 = (w0 >> off) & 1u; v1 = (w1 >> off) & 1u; }
                        else if (kind == 1) { v0 = (kp0 <= qpos) && (qpos - kp0 < 128); v1 = (kp1 <= qpos) && (qpos - kp1 < 128); }
                        else { v0 = v0 && (kp0 <= qpos); v1 = v1 && (kp1 <= qpos); }
                        const float l0 = p0[r] * (0.125f * LOG2E) + (cb + slope2 * (float)off);
                        const float l1 = p1[r] * (0.125f * LOG2E) + (cb + slope2 * (float)(off + 32));
                        p0[r] = v0 ? l0 : -INFINITY; p1[r] = v1 ? l1 : -INFINITY;
                        mx = fmaxf(mx, fmaxf(p0[r], p1[r]));
                    }
                    mx = fmaxf(mx, xlane32(mx));
                    const float m_new = fmaxf(m_run, mx);
                    const float m_safe = (m_new == -INFINITY) ? 0.f : m_new;
                    const float alpha = exp2f(m_run - m_safe);
                    float ls = 0.f;
#pragma unroll
                    for (int r = 0; r < 16; ++r) { p0[r] = exp2f(p0[r] - m_safe); p1[r] = exp2f(p1[r] - m_safe); ls += p0[r] + p1[r]; }
                    l_run = l_run * alpha + ls; m_run = m_new;
#pragma unroll
                    for (int r = 0; r < 16; ++r) { o0[r] *= alpha; o1[r] *= alpha; }
                } else {
                    float lk0[16], lk1[16];
#pragma unroll
                    for (int r = 0; r < 16; ++r) {
                        const int off = (r & 3) + 8 * (r >> 2);
                        const bool v0 = (kbase + off) < qpos, v1 = (kbase + off + 32) < qpos;
                        const float z0 = p0[r] * 0.125f, z1 = p1[r] * 0.125f;
                        const float t0 = log1pf(expf(-fabsf(z0))), t1 = log1pf(expf(-fabsf(z1)));
                        lk0[r] = v0 ? (fminf(-z0, 0.f) - t0) : 0.f; lk1[r] = v1 ? (fminf(-z1, 0.f) - t1) : 0.f;
                        p0[r] = v0 ? (fminf(z0, 0.f) - t0) : -INFINITY; p1[r] = v1 ? (fminf(z1, 0.f) - t1) : -INFINITY;
                    }
                    float G[8], PG[8];
#pragma unroll
                    for (int g = 0; g < 4; ++g) { G[3 - g] = (lk1[4 * g] + lk1[4 * g + 1]) + (lk1[4 * g + 2] + lk1[4 * g + 3]); G[7 - g] = (lk0[4 * g] + lk0[4 * g + 1]) + (lk0[4 * g + 2] + lk0[4 * g + 3]); }
#pragma unroll
                    for (int k = 0; k < 8; ++k) PG[k] = xlane32(G[k]);
                    float run = carry;
#pragma unroll
                    for (int k = 0; k < 8; ++k) {
                        const float E = run + (hi ? 0.f : PG[k]);
                        run += G[k] + PG[k];
                        const int g = (k < 4) ? 3 - k : 7 - k;
                        if (k < 4) { float la = E; p1[4 * g + 3] += la; la += lk1[4 * g + 3]; p1[4 * g + 2] += la; la += lk1[4 * g + 2]; p1[4 * g + 1] += la; la += lk1[4 * g + 1]; p1[4 * g] += la; }
                        else       { float la = E; p0[4 * g + 3] += la; la += lk0[4 * g + 3]; p0[4 * g + 2] += la; la += lk0[4 * g + 2]; p0[4 * g + 1] += la; la += lk0[4 * g + 1]; p0[4 * g] += la; }
                    }
                    carry = run;
#pragma unroll
                    for (int r = 0; r < 16; ++r) { p0[r] = expf(p0[r]); p1[r] = expf(p1[r]); }
                }
                unsigned pw[16];
#pragma unroll
                for (int j = 0; j < 8; ++j) { pw[j] = cvtpk(p0[2 * j], p0[2 * j + 1]); pw[8 + j] = cvtpk(p1[2 * j], p1[2 * j + 1]); }
#pragma unroll
                for (int s = 0; s < 4; ++s) {
                    bf16x8_t pb; { const unsigned* q = pw + 4 * s; typedef unsigned u32x4_t __attribute__((ext_vector_type(4))); u32x4_t t4 = {q[0], q[1], q[2], q[3]}; pb = __builtin_bit_cast(bf16x8_t, t4); }
#pragma unroll
                    for (int dt = 0; dt < 2; ++dt) {
                        const bf16* vp = vt_ + (32 * dt + r32) * AT_VP + 16 * s + 4 * hi;
                        typedef short s16x4_t __attribute__((ext_vector_type(4)));
                        const s16x4_t lo = *(const s16x4_t*)vp, hi4 = *(const s16x4_t*)(vp + 8);
                        const bf16x8_t va = {lo[0], lo[1], lo[2], lo[3], hi4[0], hi4[1], hi4[2], hi4[3]};
                        if (dt == 0) o0 = __builtin_amdgcn_mfma_f32_32x32x16_bf16(va, pb, o0, 0, 0, 0);
                        else         o1 = __builtin_amdgcn_mfma_f32_32x32x16_bf16(va, pb, o1, 0, 0, 0);
                    }
                }
            }
            if (kind == 3) {
                const float cm = carry;
                if (__all(cm < -110.0f) || !(kt * 64 <= q0w + 31) ) { if (__all(cm < -110.0f)) wave_done = true; }
            }
            if (more) {
                bf16* ksn = (bf16*)(lds + AT_KS + (buf ^ 1) * AT_KS_BYTES); bf16* vtn = (bf16*)(lds + AT_VT + (buf ^ 1) * AT_VT_BYTES);
                *(uint4*)(ksn + skey * AT_KP + sc * 8) = rk;
                const unsigned vw[4] = {rv.x, rv.y, rv.z, rv.w};
#pragma unroll
                for (int j = 0; j < 4; ++j) { vtn[(sc * 8 + 2 * j) * AT_VP + skey] = (bf16)(vw[j] & 0xffffu); vtn[(sc * 8 + 2 * j + 1) * AT_VP + skey] = (bf16)(vw[j] >> 16); }
            }
            if (kind == 3) { if (__syncthreads_and(wave_done ? 1 : 0)) break; }
            else __syncthreads();
            buf ^= 1;
        }
        float inv;
        if (kind == 3) inv = 1.0f;
        else {
            float lt = l_run + xlane32(l_run);
            if (kind == 1) { const float mf = fmaxf(m_run, sink2); const float sc2 = exp2f(m_run - mf); lt = lt * sc2 + exp2f(sink2 - mf); inv = sc2 / lt; }
            else inv = 1.0f / lt;
        }
        bf16* yp = ys + (size_t)(b * S_ + qpos) * 1024 + ycol + 4 * hi;
#pragma unroll
        for (int g = 0; g < 4; ++g) {
            *(uint2*)(yp + 8 * g) = make_uint2(cvtpk(o0[4 * g] * inv, o0[4 * g + 1] * inv), cvtpk(o0[4 * g + 2] * inv, o0[4 * g + 3] * inv));
            *(uint2*)(yp + 32 + 8 * g) = make_uint2(cvtpk(o1[4 * g] * inv, o1[4 * g + 1] * inv), cvtpk(o1[4 * g + 2] * inv, o1[4 * g + 3] * inv));
        }
    }
}
__device__ void attn_fast_phase(const bf16* P, const unsigned char* mask, const float* kmean, const float* sinks, bf16* ys,
                                const unsigned* utab, unsigned* counter, unsigned char* lds) {
    volatile unsigned* s_unit = (volatile unsigned*)(lds + AT_MISC);
    for (;;) {
        __syncthreads();
        if (LTID() == 0) s_unit[0] = atomicAdd(counter, 1u);
        __syncthreads();
        const unsigned ui = s_unit[0];
        if (ui >= 512u) break;
        const unsigned ue = utab[ui];
        const int kind = (int)(ue >> 30), b = (int)((ue >> 28) & 3u), ux = (int)((ue >> 8) & 255u), uy = (int)(ue & 255u);
        if (kind == 0) attn_unit<0>(P, mask, kmean, sinks, ys, lds, b, ux, uy);
        else attn_unit<2>(P, mask, kmean, sinks, ys, lds, b, ux, uy);
    }
    for (int u = LBID(); u < 256; u += LGRID()) { __syncthreads(); attn_unit<3>(P, mask, kmean, sinks, ys, lds, u >> 6, (u >> 4) & 3, u & 15); }
    for (int u = LBID(); u < 256; u += LGRID()) { __syncthreads(); attn_unit<1>(P, mask, kmean, sinks, ys, lds, u >> 6, (u >> 5) & 1, u & 31); }
}

enum { PH_PRO = 0, PH_GIN, PH_INDEX, PH_ATTN, PH_MERGE, PH_GOUT, PH_LN1, PH_GQ, PH_ROUTE, PH_PEER };
template <int PH> __device__ __forceinline__ void run_phase(const Params& p, int l, unsigned char* lds_raw) {
    float* sm = (float*)lds_raw;
    unsigned char* ws = p.ws; asm volatile("" : "+s"(ws));
    float* hbuf = p.out;
    bf16* hb = (bf16*)(ws + WS_HB);
    bf16* P = (bf16*)(ws + WS_P);
    bf16* ys = (bf16*)(ws + WS_YS);
    bf16* mrg = (bf16*)(ws + WS_MRG);
    float* mix = (float*)(ws + WS_MIX);
    float* qb = (float*)(ws + WS_Q);
    unsigned char* mask = ws + WS_MASK;
    int* eid = (int*)(ws + WS_EID);
    float* gate = (float*)(ws + WS_GATE);
    float* kmean = (float*)(ws + WS_KMEAN);
    const float* hin = (l == 0) ? p.in[0] : hbuf;
    if (PH == PH_PRO) { prologue_phase(p, sm); if (LBID() < 2) build_unit_table((unsigned*)(ws + WS_CTL) + 1024, LBID() * NTHR + LTID()); }
    else if (PH == PH_GIN) {
        pg8::Gemm g{hb, (const bf16*)(ws + WS_WIN_T + l * WIN_T_BYTES), T_, NP, 1024};
        pg8::StaticOrder S; S.init(T_, NP, (int)LGRID(), (int)LBID());
        pg8::EpiBf16<0> E{P, NP, nullptr, 0, 0, 1.f};
        pg8::gemm_phase<pg8::EpiBf16<0>, pg8::StaticOrder, true, true>((PG8_LAS unsigned char*)lds_raw, g, S, E);
    }
    else if (PH == PH_INDEX) index_phase(P, mask, kmean, sm);
    else if (PH == PH_ATTN) attn_fast_phase(P, mask, kmean, p.in[4] + l * 4, ys, (const unsigned*)(ws + WS_CTL) + 1024, (unsigned*)(ws + WS_CTL) + 64 * l, lds_raw);
    else if (PH == PH_MERGE) merge_phase(P, ys, p.in[2] + (size_t)l * 4 * 256 * 1024, mrg, sm);
    else if (PH == PH_GOUT) {
        pg8::Gemm g{mrg, (const bf16*)(ws + WS_WOUT_T) + (size_t)l * 1024 * 1024, T_, 1024, 1024};
        pg8::StaticOrder S; S.init(T_, 1024, (int)LGRID(), (int)LBID());
        pg8::EpiF32 E{mix, 1024};
        pg8::gemm_phase<pg8::EpiF32, pg8::StaticOrder, true, true>((PG8_LAS unsigned char*)lds_raw, g, S, E);
    }
    else if (PH == PH_LN1) ln1_phase(hin, mix, p.in[5] + l * 1024, p.in[6] + l * 1024, hbuf, hb);
    else if (PH == PH_GQ) {
        pg8::Gemm g{hb, (const bf16*)(ws + WS_WQ_T) + (size_t)l * 1024 * 1024, T_, 1024, 1024};
        pg8::StaticOrder S; S.init(T_, 1024, (int)LGRID(), (int)LBID());
        pg8::EpiF32 E{qb, 1024};
        pg8::gemm_phase<pg8::EpiF32, pg8::StaticOrder, true, true>((PG8_LAS unsigned char*)lds_raw, g, S, E);
    }
    else if (PH == PH_ROUTE) route_phase(qb, p.in[8] + (size_t)l * 8 * 2 * 128 * 64, eid, gate);
    else peer_phase(hbuf, hb, eid, gate, p.in[9] + (size_t)l * 16384 * 1024, p.in[10] + (size_t)l * 16384 * 1024, p.in[11] + l * 1024, p.in[12] + l * 1024);
}

__global__ void __launch_bounds__(NTHR, 2) mk_fwd(Params p) {
    extern __shared__ __attribute__((aligned(16))) unsigned char lds_raw[];
    cg::grid_group grid = cg::this_grid();
    run_phase<PH_PRO>(p, 0, lds_raw);
    grid.sync();
#pragma unroll 1
    for (int l = 0; l < DEPTH_; ++l) {
        run_phase<PH_GIN>(p, l, lds_raw); grid.sync();
        run_phase<PH_INDEX>(p, l, lds_raw); grid.sync();
        run_phase<PH_ATTN>(p, l, lds_raw); grid.sync();
        run_phase<PH_MERGE>(p, l, lds_raw); grid.sync();
        run_phase<PH_GOUT>(p, l, lds_raw); grid.sync();
        run_phase<PH_LN1>(p, l, lds_raw); grid.sync();
        run_phase<PH_GQ>(p, l, lds_raw); grid.sync();
        run_phase<PH_ROUTE>(p, l, lds_raw); grid.sync();
        run_phase<PH_PEER>(p, l, lds_raw); grid.sync();
    }
}

extern "C" void kernel_launch(void* const* d_in, const int* in_sizes, int n_in, void* d_out, int out_size, void* d_ws, size_t ws_size, hipStream_t stream) {
    if (n_in != 13 || ws_size < WS_END) { fprintf(stderr, "kernel_launch: unexpected n_in %d / ws_size %zu; nothing launched\n", n_in, ws_size); return; }
    static int grid_blocks = 0;
    if (grid_blocks == 0) {
        int dev = 0, cus = 0, per_cu = 0;
        (void)hipGetDevice(&dev);
        (void)hipDeviceGetAttribute(&cus, hipDeviceAttributeMultiprocessorCount, dev);
        (void)hipFuncSetAttribute((const void*)mk_fwd, hipFuncAttributeMaxDynamicSharedMemorySize, LDS_BYTES);
        (void)hipOccupancyMaxActiveBlocksPerMultiprocessor(&per_cu, (const void*)mk_fwd, NTHR, LDS_BYTES);
        if (per_cu < 1) fprintf(stderr, "kernel_launch: occupancy query reports %d\n", per_cu);
        grid_blocks = cus;
    }
    Params p{};
    for (int i = 0; i < 13; ++i) p.in[i] = (const float*)d_in[i];
    p.out = (float*)d_out; p.ws = (unsigned char*)d_ws;
    (void)hipMemsetAsync(d_ws, 0, 4096, stream);
    void* args[] = {&p};
    hipError_t e = hipLaunchCooperativeKernel((const void*)mk_fwd, dim3(grid_blocks), dim3(NTHR), args, LDS_BYTES, stream);
    if (e != hipSuccess) fprintf(stderr, "cooperative launch failed: %s (grid %d)\n", hipGetErrorString(e), grid_blocks);
}
```

```cpp
#include <hip/hip_runtime.h>
#include <cstdio>
#include <cstdint>
#include <hip/hip_cooperative_groups.h>
namespace cg = cooperative_groups;

__device__ __forceinline__ int LTID() { int t = threadIdx.x; asm volatile("" : "+v"(t)); return t; }
__device__ __forceinline__ int LBID() { int t = blockIdx.x; asm volatile("" : "+s"(t)); return t; }
__device__ __forceinline__ int LGRID() { int t = gridDim.x; asm volatile("" : "+s"(t)); return t; }
namespace pg8 {
#define PG8_LAS __attribute__((address_space(3)))
typedef unsigned short bf16_t;
typedef short bf16x8 __attribute__((ext_vector_type(8)));
typedef float f32x4 __attribute__((ext_vector_type(4)));
typedef unsigned u32x4 __attribute__((ext_vector_type(4)));
constexpr int BM = 256, BK = 64, HALF = 128, HTB = HALF * BK * 2  , STAGE_BYTES = 8 * HTB, NXCD = 8, WGM = 8;

__host__ __device__ __forceinline__ int lds_byte(int r, int c) { const int st = (r >> 4) * 2 + (c >> 5), rr = r & 15, cc = c & 31, ob = rr * 64 + cc * 2; return st * 1024 + (ob ^ (((ob >> 9) & 1) << 5)); }
__host__ __device__ __forceinline__ void stage_rc(int b, int& R, int& C) { const int st = b / 1024, sb = b % 1024, swz = sb ^ (((sb >> 9) & 1) << 5); R = (st >> 1) * 16 + swz / 64; C = (st & 1) * 32 + (swz % 64) / 2; }
__host__ __device__ __forceinline__ int perm32(int rho) { const int n = rho >> 4, i = rho & 15; return 8 * (i >> 2) + 4 * n + (i & 3); }

struct Unit { int pm, pn; };
struct Gemm { const bf16_t* A; const bf16_t* Bt; int M, N, K; };

struct StaticOrder {
    int nM, nN, nwg, G, c;
    __host__ __device__ void init(int M, int N, int G_, int c_) { nM = M / BM; nN = N / BM; nwg = nM * nN; G = G_; c = c_; }
    __host__ __device__ bool next(int i, Unit& u) const {
        const long L = (long)i * G + c; if (L >= nwg) return false;
        int wgid = (int)L; { const int q = nwg / NXCD, r = nwg % NXCD, xcd = wgid % NXCD, off = wgid / NXCD; wgid = (xcd < r ? xcd * (q + 1) : r * (q + 1) + (xcd - r) * q) + off; }
        const int nig = WGM * nN, gid = wgid / nig, fm = gid * WGM, gsz = (nM - fm) < WGM ? (nM - fm) : WGM;
        u.pm = fm + ((wgid % nig) % gsz); u.pn = (wgid % nig) / gsz; return true;
    }
    __device__ __forceinline__ void a_ready(const Unit&) const {}
    __device__ __forceinline__ void done(const Unit&) const {}
};

__device__ __forceinline__ unsigned cvt_pk_bf16(float lo, float hi) { unsigned r; asm volatile("v_cvt_pk_bf16_f32 %0, %1, %2" : "=v"(r) : "v"(lo), "v"(hi)); return r; }
typedef float f32x2 __attribute__((ext_vector_type(2)));
__device__ __forceinline__ f32x2 gelu_pk(f32x2 v) {
    const f32x2 av = __builtin_elementwise_abs(v), d = av * 0.2316418882f + 1.0f;
    f32x2 t; t.x = __builtin_amdgcn_rcpf(d.x); t.y = __builtin_amdgcn_rcpf(d.y);
    f32x2 q = t * 0.5307027145f + (-0.7265760135f); q = q * t + 0.7107068705f; q = q * t + (-0.142248368f); q = q * t + 0.127414796f; q = q * t;
    const f32x2 s = (v * v) * (-0.72134752044f);
    f32x2 e; e.x = __builtin_amdgcn_exp2f(s.x); e.y = __builtin_amdgcn_exp2f(s.y);
    const f32x2 m = v * (q * e), r = v - m;
    f32x2 o; o.x = v.x < 0.f ? m.x : r.x; o.y = v.y < 0.f ? m.y : r.y; return o;
}

template <int ACT  > struct EpiBf16 {
    static constexpr bool PERM = true, AFTER_DRAIN = false; static_assert(ACT == 0 || ACT == 1, "EpiBf16: ACT is 0 (none) or 1 (gelu_pk)");
    bf16_t* O; int ldc; const float* bias; int split_cols; size_t split_stride; float scale0;
    __device__ __forceinline__ void operator()(const f32x4 (&acc)[2][2][4][2], const Unit& u, int wr, int wc, int fr, int fq) const {
        const int row0 = u.pm * BM + wr * 64 + fr; int colt = u.pn * BM; bf16_t* base = O;
        float sc = 1.f; if (split_cols) { const int t = colt / split_cols; base += (size_t)t * split_stride; colt -= t * split_cols; if (t == 0) sc = scale0; }
        const int col0 = colt + wc * 32 + 8 * fq, bcol0 = u.pn * BM + wc * 32 + 8 * fq;
        f32x4 bv[2][2];
#pragma unroll
        for (int bj = 0; bj < 2; ++bj)
#pragma unroll
            for (int n = 0; n < 2; ++n) bv[bj][n] = bias ? *(const f32x4*)(bias + bcol0 + bj * HALF + 4 * n) : (f32x4){0.f, 0.f, 0.f, 0.f};
#pragma unroll
        for (int ai = 0; ai < 2; ++ai)
#pragma unroll
            for (int m = 0; m < 4; ++m) { bf16_t* rowp = base + (size_t)(row0 + ai * HALF + m * 16) * ldc + col0;
#pragma unroll
                for (int bj = 0; bj < 2; ++bj) { f32x4 v0 = acc[ai][bj][m][0] + bv[bj][0], v1 = acc[ai][bj][m][1] + bv[bj][1];
                    if (ACT == 1) { f32x2 a = gelu_pk((f32x2){v0[0], v0[1]}), b = gelu_pk((f32x2){v0[2], v0[3]}), c = gelu_pk((f32x2){v1[0], v1[1]}), d = gelu_pk((f32x2){v1[2], v1[3]});
                        v0 = (f32x4){a.x, a.y, b.x, b.y}; v1 = (f32x4){c.x, c.y, d.x, d.y}; }
                    v0 = v0 * sc; v1 = v1 * sc; u32x4 w; w.x = cvt_pk_bf16(v0[0], v0[1]); w.y = cvt_pk_bf16(v0[2], v0[3]); w.z = cvt_pk_bf16(v1[0], v1[1]); w.w = cvt_pk_bf16(v1[2], v1[3]);
                    *(u32x4*)(rowp + bj * HALF) = w; } }
    }
};
template <class Epi, class Sched, bool ALIGN_EPI = false, bool SP2 = false>
__device__ __forceinline__ void gemm_phase(PG8_LAS unsigned char* lds, const Gemm g, const Sched& S, const Epi& E) {
    const int tid = LTID(), wid = __builtin_amdgcn_readfirstlane(tid >> 6), lane = tid & 63, wr = wid >> 2, wc = wid & 3, fr = lane & 15, fq = lane >> 4;
    const int K = g.K, nt = K / BK;
    unsigned voffA[2], voffB[2];
#pragma unroll
    for (int i = 0; i < 2; ++i) { int R, C; stage_rc(tid * 16 + i * 8192, R, C); const int Rb = Epi::PERM ? ((R & ~31) + perm32(R & 31)) : R;
        voffA[i] = (unsigned)(R * K + C) * 2u; voffB[i] = (unsigned)(Rb * K + C) * 2u; }
    const size_t kstep = (size_t)(BK * 2);
    const size_t hstep = (size_t)HALF * K * 2;
    const size_t tstep = 2 * hstep;
    const unsigned ldsw = (unsigned)wid * 1024u;
    const int aoff = lds_byte(wr * 64 + fr, fq * 8), boff = lds_byte(wc * 32 + fr, fq * 8);
#define PG8_SA(b, h) (((b) * 2 + (h)) * HTB)
#define PG8_SB(b, h) ((4 + (b) * 2 + (h)) * HTB)
#define PG8_STAGE(bufoff, gbase, voff) do { _Pragma("unroll") for (int _i = 0; _i < 2; ++_i) \
        __builtin_amdgcn_global_load_lds((const unsigned*)((const char*)(gbase) + (voff)[_i]), (PG8_LAS unsigned*)(lds + (bufoff) + ldsw + _i * 8192), 16, 0, 0); } while (0)
#define PG8_LDA(dst, b, h) do { _Pragma("unroll") for (int m = 0; m < 4; ++m) _Pragma("unroll") for (int k = 0; k < 2; ++k) dst[m][k] = *(const PG8_LAS bf16x8*)(lds + PG8_SA(b, h) + aoff + m * 2048 + k * 1024); } while (0)
#define PG8_LDB(dst, b, h) do { _Pragma("unroll") for (int n = 0; n < 2; ++n) _Pragma("unroll") for (int k = 0; k < 2; ++k) dst[n][k] = *(const PG8_LAS bf16x8*)(lds + PG8_SB(b, h) + boff + n * 2048 + k * 1024); } while (0)
#define PG8_MMA(ai, bj, At, Bt) do { __builtin_amdgcn_s_setprio(1); _Pragma("unroll") for (int m = 0; m < 4; ++m) _Pragma("unroll") for (int n = 0; n < 2; ++n) _Pragma("unroll") for (int k = 0; k < 2; ++k) \
        acc[ai][bj][m][n] = __builtin_amdgcn_mfma_f32_16x16x32_bf16(Bt[n][k], At[m][k], acc[ai][bj][m][n], 0, 0, 0); __builtin_amdgcn_s_setprio(0); } while (0)
#define PG8_WAIT_V(n) asm volatile("s_waitcnt vmcnt(" #n ")" ::: "memory")
#define PG8_WAIT_L(n) asm volatile("s_waitcnt lgkmcnt(" #n ")" ::: "memory")
#define PG8_BAR __builtin_amdgcn_s_barrier()
#define PG8_SCHED __builtin_amdgcn_sched_barrier(0)
    Unit cur, nxt; int ui = 0;
    if (!S.next(0, cur)) return;
    f32x4 acc[2][2][4][2];
#pragma unroll
    for (int a = 0; a < 2; ++a)
#pragma unroll
        for (int b = 0; b < 2; ++b)
#pragma unroll
            for (int m = 0; m < 4; ++m)
#pragma unroll
                for (int n = 0; n < 2; ++n) acc[a][b][m][n] = (f32x4){0.f, 0.f, 0.f, 0.f};
    bf16x8 At[4][2], B0[2][2], B1[2][2];
    const char* cA = (const char*)g.A + (size_t)cur.pm * tstep; const char* cB = (const char*)g.Bt + (size_t)cur.pn * tstep;
    S.a_ready(cur);
    if constexpr (SP2) {
        PG8_STAGE(PG8_SB(0, 0), cB, voffB); PG8_STAGE(PG8_SB(0, 1), cB + hstep, voffB); PG8_STAGE(PG8_SA(0, 0), cA, voffA); PG8_STAGE(PG8_SA(0, 1), cA + hstep, voffA);
        if (wr == 1) PG8_BAR;
        PG8_WAIT_V(2); PG8_BAR;
        PG8_STAGE(PG8_SB(1, 0), cB + kstep, voffB); PG8_STAGE(PG8_SA(1, 0), cA + kstep, voffA); PG8_STAGE(PG8_SB(1, 1), cB + hstep + kstep, voffB);
        PG8_WAIT_V(6); PG8_BAR;
    } else {
        PG8_STAGE(PG8_SB(0, 0), cB, voffB); PG8_STAGE(PG8_SA(0, 0), cA, voffA); PG8_STAGE(PG8_SB(0, 1), cB + hstep, voffB); PG8_STAGE(PG8_SA(0, 1), cA + hstep, voffA);
        if (wr == 1) PG8_BAR;
        PG8_WAIT_V(4); PG8_BAR;
        PG8_STAGE(PG8_SB(1, 0), cB + kstep, voffB); PG8_STAGE(PG8_SA(1, 0), cA + kstep, voffA); PG8_STAGE(PG8_SB(1, 1), cB + hstep + kstep, voffB);
        PG8_WAIT_V(6); PG8_BAR;
    }
    for (;;) {
        const bool has_next = S.next(ui + 1, nxt);
        const char* nA = has_next ? (const char*)g.A + (size_t)nxt.pm * tstep : cA; const char* nB = has_next ? (const char*)g.Bt + (size_t)nxt.pn * tstep : cB;
        for (int t = 0; t < nt; t += 2) {
            const bool last = (t == nt - 2);
            const char* a1 = cA + (size_t)(t + 1) * kstep;
            const char* a2 = last ? nA : cA + (size_t)(t + 2) * kstep; const char* b2 = last ? nB : cB + (size_t)(t + 2) * kstep;
            const char* a3 = a2 + kstep; const char* b3 = b2 + kstep;
            if (last && has_next) S.a_ready(nxt);
            if constexpr (SP2) {
            PG8_LDB(B0, 0, 0); PG8_LDB(B1, 0, 1); PG8_SCHED; PG8_LDA(At, 0, 0); PG8_STAGE(PG8_SA(1, 1), a1 + hstep, voffA);
            PG8_WAIT_V(8); PG8_WAIT_L(0); PG8_BAR; PG8_MMA(0, 0, At, B0); PG8_MMA(0, 1, At, B1); PG8_BAR; PG8_SCHED;
            PG8_LDA(At, 0, 1); PG8_STAGE(PG8_SB(0, 0), b2, voffB); PG8_STAGE(PG8_SB(0, 1), b2 + hstep, voffB); PG8_STAGE(PG8_SA(0, 0), a2, voffA);
            PG8_WAIT_V(8); PG8_WAIT_L(0); PG8_BAR; PG8_MMA(1, 0, At, B0); PG8_MMA(1, 1, At, B1); PG8_BAR; PG8_SCHED;
            PG8_LDB(B0, 1, 0); PG8_LDB(B1, 1, 1); PG8_SCHED; PG8_LDA(At, 1, 0); PG8_STAGE(PG8_SA(0, 1), a2 + hstep, voffA);
            PG8_WAIT_V(8); PG8_WAIT_L(0); PG8_BAR; PG8_MMA(0, 0, At, B0); PG8_MMA(0, 1, At, B1); PG8_BAR; PG8_SCHED;
            PG8_LDA(At, 1, 1); PG8_STAGE(PG8_SB(1, 0), b3, voffB); PG8_STAGE(PG8_SB(1, 1), b3 + hstep, voffB); PG8_STAGE(PG8_SA(1, 0), a3, voffA);
            PG8_WAIT_V(8); PG8_WAIT_L(0); PG8_BAR; PG8_MMA(1, 0, At, B0); PG8_MMA(1, 1, At, B1); PG8_BAR; PG8_SCHED;
            } else {
            PG8_LDB(B0, 0, 0); PG8_SCHED; PG8_LDA(At, 0, 0); PG8_STAGE(PG8_SA(1, 1), a1 + hstep, voffA);
            PG8_WAIT_L(8); PG8_BAR; PG8_WAIT_L(0); PG8_MMA(0, 0, At, B0); PG8_BAR; PG8_SCHED;
            PG8_LDB(B1, 0, 1); PG8_STAGE(PG8_SB(0, 0), b2, voffB);
            PG8_BAR; PG8_WAIT_L(0); PG8_MMA(0, 1, At, B1); PG8_BAR;
            PG8_LDA(At, 0, 1); PG8_STAGE(PG8_SA(0, 0), a2, voffA);
            PG8_BAR; PG8_WAIT_L(0); PG8_MMA(1, 0, At, B0); PG8_BAR; PG8_SCHED;
            PG8_STAGE(PG8_SB(0, 1), b2 + hstep, voffB);
            PG8_WAIT_V(6); PG8_BAR; PG8_MMA(1, 1, At, B1); PG8_BAR;
            PG8_LDB(B0, 1, 0); PG8_SCHED; PG8_LDA(At, 1, 0); PG8_STAGE(PG8_SA(0, 1), a2 + hstep, voffA);
            PG8_WAIT_L(8); PG8_BAR; PG8_WAIT_L(0); PG8_MMA(0, 0, At, B0); PG8_BAR; PG8_SCHED;
            PG8_LDB(B1, 1, 1); PG8_STAGE(PG8_SB(1, 0), b3, voffB);
            PG8_BAR; PG8_WAIT_L(0); PG8_MMA(0, 1, At, B1); PG8_BAR;
            PG8_LDA(At, 1, 1); PG8_STAGE(PG8_SA(1, 0), a3, voffA);
            PG8_BAR; PG8_WAIT_L(0); PG8_MMA(1, 0, At, B0); PG8_BAR; PG8_SCHED;
            PG8_STAGE(PG8_SB(1, 1), b3 + hstep, voffB);
            PG8_WAIT_V(6); PG8_BAR; PG8_MMA(1, 1, At, B1); PG8_BAR;
            }
        }
        if constexpr (ALIGN_EPI) { if (wr == 0) PG8_BAR; }
        if constexpr (!Epi::AFTER_DRAIN) { E(acc, cur, wr, wc, fr, fq); S.done(cur); }
        if (!has_next) break;
#pragma unroll
        for (int a = 0; a < 2; ++a)
#pragma unroll
            for (int b = 0; b < 2; ++b)
#pragma unroll
                for (int m = 0; m < 4; ++m)
#pragma unroll
                    for (int n = 0; n < 2; ++n) acc[a][b][m][n] = (f32x4){0.f, 0.f, 0.f, 0.f};
        cur = nxt; cA = nA; cB = nB; ++ui;
        if constexpr (ALIGN_EPI) { if (wr == 1) PG8_BAR; }
    }
    PG8_WAIT_V(0);
    if constexpr (!ALIGN_EPI) { if (wr == 0) PG8_BAR; }
    PG8_BAR;
    if constexpr (Epi::AFTER_DRAIN) { E.fused(acc, cur, wr, wc, fr, fq, lds, wid, lane); S.done(cur); }
#undef PG8_SA
#undef PG8_SB
#undef PG8_STAGE
#undef PG8_LDA
#undef PG8_LDB
#undef PG8_MMA
#undef PG8_WAIT_V
#undef PG8_WAIT_L
#undef PG8_BAR
#undef PG8_SCHED
}
}
namespace pg8 {
struct EpiF32 {
    static constexpr bool PERM = false, AFTER_DRAIN = false;
    float* O; int ldc;
    __device__ __forceinline__ void operator()(const f32x4 (&acc)[2][2][4][2], const Unit& u, int wr, int wc, int fr, int fq) const {
        const int row0 = u.pm * BM + wr * 64 + fr, col0 = u.pn * BM + wc * 32 + 4 * fq;
#pragma unroll
        for (int ai = 0; ai < 2; ++ai)
#pragma unroll
            for (int m = 0; m < 4; ++m) { float* rowp = O + (size_t)(row0 + ai * HALF + m * 16) * ldc + col0;
#pragma unroll
                for (int bj = 0; bj < 2; ++bj)
#pragma unroll
                    for (int n = 0; n < 2; ++n) *(f32x4*)(rowp + bj * HALF + n * 16) = acc[ai][bj][m][n]; }
    }
};
}

typedef unsigned short bf16;
constexpr int T_ = 16384, S_ = 4096, NBATCH = 4, D_ = 1024, NCOL = 6824, NP = 6912, DEPTH_ = 2;
constexpr int C_QA = 0, C_KA = 256, C_VA = 320, C_QI = 384, C_KI = 640, C_WI = 672, C_QB = 680, C_KB = 936, C_VB = 1064,
              C_QC = 1192, C_KC = 1448, C_VC = 1704, C_QD = 1960, C_KD = 2216, C_VD = 2472, C_G = 2728;
constexpr int NTHR = 512, NWAVE = 8;
constexpr float ALPHA = 1.41421356237309515f;
constexpr float LN_EPS = 1e-5f;
constexpr size_t MiB = 1u << 20;
constexpr size_t WS_CTL = 0, WS_WIN_T = 2 * MiB, WS_WOUT_T = 30 * MiB, WS_WQ_T = 34 * MiB, WS_WBR_T = 38 * MiB, WS_HB = 42 * MiB,
                 WS_P = 74 * MiB, WS_MIX = 74 * MiB  , WS_Q = 138 * MiB  , WS_YS = 290 * MiB, WS_MRG = 322 * MiB,
                 WS_MASK = 354 * MiB, WS_EID = 362 * MiB, WS_GATE = 370 * MiB, WS_KMEAN = 378 * MiB, WS_SKB = 379 * MiB, WS_UV = 380 * MiB, WS_END = 508 * MiB;
constexpr size_t WIN_T_BYTES = (size_t)NP * 1024 * 2;
constexpr int LDS_BYTES = 144 * 1024;

struct Params { const float* in[13]; float* out; unsigned char* ws; };

__device__ __forceinline__ float bf2f(bf16 v) { return __uint_as_float((unsigned)v << 16); }
__device__ __forceinline__ unsigned f2bf(float f) { unsigned u = __float_as_uint(f); return (u + 0x7fffu + ((u >> 16) & 1u)) >> 16; }
__device__ __forceinline__ unsigned pk2(float lo, float hi) { return f2bf(lo) | (f2bf(hi) << 16); }
__device__ __forceinline__ void unpack8(const uint4 v, float* o) {
    o[0] = __uint_as_float(v.x << 16); o[1] = __uint_as_float(v.x & 0xffff0000u); o[2] = __uint_as_float(v.y << 16); o[3] = __uint_as_float(v.y & 0xffff0000u);
    o[4] = __uint_as_float(v.z << 16); o[5] = __uint_as_float(v.z & 0xffff0000u); o[6] = __uint_as_float(v.w << 16); o[7] = __uint_as_float(v.w & 0xffff0000u);
}
__device__ __forceinline__ float wave_sum(float v) {
#pragma unroll
    for (int o = 32; o > 0; o >>= 1) v += __shfl_xor(v, o);
    return v;
}
__device__ __forceinline__ float wave_max(float v) {
#pragma unroll
    for (int o = 32; o > 0; o >>= 1) v = fmaxf(v, __shfl_xor(v, o));
    return v;
}
__device__ __forceinline__ int wave_sum_i(int v) {
#pragma unroll
    for (int o = 32; o > 0; o >>= 1) v += __shfl_xor(v, o);
    return v;
}
__device__ __forceinline__ float logsig(float x) { return fminf(x, 0.f) - log1pf(expf(-fabsf(x))); }

__device__ void transpose_items(const float* W, int K, int N, bf16* WT, float* sm, int item0, int nitems_total, int item_stride) {
    const int tid = LTID();
    const int nkb = K / 64, nnb = (N + 63) / 64;
    for (int it = item0; it < nkb * nnb; it += item_stride) {
        const int kb = it % nkb, nb = it / nkb, k0 = kb * 64, n0 = nb * 64;
        __syncthreads();
        for (int e = tid; e < 64 * 64; e += NTHR) { const int kk = e >> 6, nn = e & 63; sm[kk * 65 + nn] = (n0 + nn < N) ? W[(size_t)(k0 + kk) * N + n0 + nn] : 0.f; }
        __syncthreads();
        { const int nn = tid >> 3, c = tid & 7;
          if (n0 + nn < N) { uint4 o; o.x = pk2(sm[(8 * c + 0) * 65 + nn], sm[(8 * c + 1) * 65 + nn]); o.y = pk2(sm[(8 * c + 2) * 65 + nn], sm[(8 * c + 3) * 65 + nn]);
              o.z = pk2(sm[(8 * c + 4) * 65 + nn], sm[(8 * c + 5) * 65 + nn]); o.w = pk2(sm[(8 * c + 6) * 65 + nn], sm[(8 * c + 7) * 65 + nn]);
              *(uint4*)(WT + (size_t)(n0 + nn) * K + k0 + 8 * c) = o; } }
    }
    __syncthreads();
}
__device__ void prologue_phase(const Params& p, float* sm) {
    const int tid = LTID(), B = LBID(), G = LGRID();
    unsigned char* ws = p.ws;
    for (int l = 0; l < DEPTH_; ++l) {
        bf16* win_t = (bf16*)(ws + WS_WIN_T + l * WIN_T_BYTES);
        transpose_items(p.in[1] + (size_t)l * 1024 * NCOL, 1024, NCOL, win_t, sm, B, 0, G);
        for (int i = B * NTHR + tid; i < (NP - NCOL) * 1024 / 8; i += G * NTHR) ((uint4*)(win_t + (size_t)NCOL * 1024))[i] = make_uint4(0u, 0u, 0u, 0u);
        transpose_items(p.in[3] + (size_t)l * 1024 * 1024, 1024, 1024, (bf16*)(ws + WS_WOUT_T) + (size_t)l * 1024 * 1024, sm, B, 0, G);
        transpose_items(p.in[7] + (size_t)l * 1024 * 1024, 1024, 1024, (bf16*)(ws + WS_WQ_T) + (size_t)l * 1024 * 1024, sm, B, 0, G);
        for (int n = 0; n < 4; ++n)
            transpose_items(p.in[2] + ((size_t)l * 4 + n) * 256 * 1024, 256, 1024, (bf16*)(ws + WS_WBR_T) + ((size_t)l * 4 + n) * 1024 * 256, sm, B, 0, G);
    }
    const float4* x4 = (const float4*)p.in[0]; uint2* hb2 = (uint2*)(ws + WS_HB);
    for (size_t i = (size_t)B * NTHR + tid; i < (size_t)T_ * 1024 / 4; i += (size_t)G * NTHR) { const float4 v = x4[i]; hb2[i] = make_uint2(pk2(v.x, v.y), pk2(v.z, v.w)); }
}

__device__ __forceinline__ int block_sum_i(int v, unsigned* red, int slot) {
    v = wave_sum_i(v);
    if ((LTID() & 63) == 0) red[slot * 8 + (LTID() >> 6)] = (unsigned)v;
    __syncthreads();
    int s = 0;
#pragma unroll
    for (int w = 0; w < 8; ++w) s += (int)red[slot * 8 + w];
    return s;
}
__device__ void index_phase(const bf16* P, unsigned char* mask, float* kmean, float* sm) {
    float* s_qi = sm;
    float* s_wi = sm + 256;
    unsigned* s_red = (unsigned*)(sm + 272);
    unsigned* s_key = (unsigned*)(sm + 320);
    const int tid = LTID(), lane = tid & 63, wave = tid >> 6;
    for (int o = LBID() * NTHR + tid; o < 4 * 4 * 16 * 64; o += LGRID() * NTHR) {
        const int d = o & 63, blk = (o >> 6) & 15, h = (o >> 10) & 3, b = o >> 12;
        float s = 0.f;
        for (int j = 0; j < 256; ++j) s += bf2f(P[(size_t)(b * S_ + blk * 256 + j) * NP + C_KC + h * 64 + d]);
        kmean[((b * 4 + h) * 16 + blk) * 64 + d] = s * (1.0f / 256.0f);
    }
    int slot = 0;
    for (int gq = LBID(); gq < T_; gq += LGRID()) {
        const int b = gq >> 12, q = gq & 4095;
        const bf16* Pb = P + (size_t)b * S_ * NP;
        __syncthreads();
        if (tid < 256) s_qi[tid] = bf2f(Pb[(size_t)q * NP + C_QI + tid]);
        else if (tid < 264) s_wi[tid - 256] = bf2f(Pb[(size_t)q * NP + C_WI + tid - 256]);
        __syncthreads();
#pragma unroll 1
        for (int j = 0; j < 8; ++j) {
            const int s = tid * 8 + j;
            unsigned key = 0u;
            if (s <= q) {
                const uint4* kr = (const uint4*)(Pb + (size_t)s * NP + C_KI);
                float kv[32];
#pragma unroll
                for (int c = 0; c < 4; ++c) unpack8(kr[c], kv + 8 * c);
                float sc = 0.f;
#pragma unroll 1
                for (int h = 0; h < 8; ++h) {
                    float d = 0.f;
#pragma unroll
                    for (int dd = 0; dd < 32; ++dd) d += s_qi[h * 32 + dd] * kv[dd];
                    sc += fmaxf(d, 0.f) * s_wi[h];
                }
                sc *= 0.0625f;
                if (sc == 0.f) sc = 0.f;
                const unsigned u = __float_as_uint(sc);
                key = (u & 0x80000000u) ? ~u : (u | 0x80000000u);
            }
            s_key[s] = key;
        }
        unsigned kk[8];
        { const uint4 k0 = *(const uint4*)&s_key[tid * 8], k1 = *(const uint4*)&s_key[tid * 8 + 4];
          kk[0] = k0.x; kk[1] = k0.y; kk[2] = k0.z; kk[3] = k0.w; kk[4] = k1.x; kk[5] = k1.y; kk[6] = k1.z; kk[7] = k1.w; }
        unsigned byte = 0u;
        if (q + 1 > 256) {
            unsigned prefix = 0u;
            for (int bit = 31; bit >= 0; --bit) {
                const unsigned cand = prefix | (1u << bit);
                int c = 0;
#pragma unroll
                for (int j = 0; j < 8; ++j) c += (kk[j] >= cand) ? 1 : 0;
                c = block_sum_i(c, s_red, slot); slot ^= 1;
                if (c >= 256) prefix = cand;
            }
            int cgt = 0, ceq = 0;
#pragma unroll
            for (int j = 0; j < 8; ++j) { cgt += (kk[j] > prefix) ? 1 : 0; ceq += (kk[j] == prefix) ? 1 : 0; }
            const int tot_gt = block_sum_i(cgt, s_red, slot); slot ^= 1;
            const int need = 256 - tot_gt;
            int incl = ceq;
#pragma unroll
            for (int o = 1; o < 64; o <<= 1) { const int t2 = __shfl_up(incl, o); if (lane >= o) incl += t2; }
            if (lane == 63) s_red[16 + wave] = (unsigned)incl;
            __syncthreads();
            int woff = 0;
            for (int w = 0; w < wave; ++w) woff += (int)s_red[16 + w];
            int taken = woff + incl - ceq;
#pragma unroll
            for (int j = 0; j < 8; ++j) {
                bool sel = kk[j] > prefix;
                if (kk[j] == prefix) { if (taken < need) sel = true; ++taken; }
                byte |= (sel ? 1u : 0u) << j;
            }
        } else {
#pragma unroll
            for (int j = 0; j < 8; ++j) byte |= ((tid * 8 + j) <= q ? 1u : 0u) << j;
        }
        mask[(size_t)gq * 512 + tid] = (unsigned char)byte;
    }
    __syncthreads();
}

__device__ __forceinline__ float dot64(const bf16* kr, const float* sq) {
    const uint4* k4 = (const uint4*)kr;
    float d = 0.f;
#pragma unroll 2
    for (int c = 0; c < 8; ++c) { float kv[8]; unpack8(k4[c], kv);
#pragma unroll
        for (int j = 0; j < 8; ++j) d += kv[j] * sq[8 * c + j]; }
    return d;
}
__device__ __forceinline__ float attend_list(int n, const int* idx, const float* sq, const bf16* Kb, const bf16* Vb, float slope, int qpos,
                                             float sink, bool has_sink, float* lg, int lane) {
    float m = -INFINITY;
    for (int i = lane; i < n; i += 64) {
        const int key = idx[i];
        const float d = dot64(Kb + (size_t)key * NP, sq);
        const float l = d * 0.125f - slope * (float)(qpos - key);
        lg[i] = l; m = fmaxf(m, l);
    }
    m = wave_max(m);
    if (has_sink) m = fmaxf(m, sink);
    float sum = 0.f;
    for (int i = lane; i < n; i += 64) { const float e = expf(lg[i] - m); lg[i] = e; sum += e; }
    sum = wave_sum(sum);
    if (has_sink) sum += expf(sink - m);
    float acc = 0.f;
    for (int i = 0; i < n; ++i) acc += lg[i] * bf2f(Vb[(size_t)idx[i] * NP + lane]);
    return acc / sum;
}

__device__ void attn_phase(const bf16* P, const unsigned char* mask, const float* kmean, const float* sinks, bf16* ys, float* sm) {
    const int tid = LTID(), lane = tid & 63, wave = tid >> 6;
    float* wsm = sm + wave * 2304;
    int* idx = (int*)wsm; float* lg = wsm + 1024; float* sq = wsm + 2048;
    const int gw = LBID() * NWAVE + wave, NGW = LGRID() * NWAVE;
    for (int it = gw; it < 13 * T_; it += NGW) {
        const int kind = it / T_, gt = it % T_, b = gt >> 12, t = gt & 4095;
        const bf16* Pb = P + (size_t)b * S_ * NP;
        bf16* yrow = ys + (size_t)gt * 1024;
        const bf16* prow = Pb + (size_t)t * NP;
        if (kind == 0) {
            for (int i = lane; i < 256; i += 64) sq[i] = bf2f(prow[C_QA + i]);
            const unsigned long long* mrow = (const unsigned long long*)(mask + (size_t)gt * 512);
            unsigned long long w = mrow[lane];
            const int c = __popcll(w);
            int incl = c;
#pragma unroll
            for (int o = 1; o < 64; o <<= 1) { const int t2 = __shfl_up(incl, o); if (lane >= o) incl += t2; }
            int pos = incl - c;
            const int ntot = __shfl(incl, 63);
            while (w) { const int bit = __ffsll((long long)w) - 1; w &= w - 1; idx[pos++] = lane * 64 + bit; }
            for (int h = 0; h < 4; ++h) {
                const float slope = exp2f(-8.0f * (float)(3 * h + 1) / 12.0f);
                const float o = attend_list(ntot, idx, sq + h * 64, Pb + C_KA, Pb + C_VA, slope, t, 0.f, false, lg, lane);
                yrow[h * 64 + lane] = (bf16)f2bf(o);
            }
        } else if (kind <= 4) {
            const int hq = kind - 1, kvh = hq >> 1;
            sq[lane] = bf2f(prow[C_QB + hq * 64 + lane]);
            const int lo = (t - 127 > 0) ? t - 127 : 0, n = t - lo + 1;
            for (int i = lane; i < n; i += 64) idx[i] = lo + i;
            const float slope = exp2f(-8.0f * (float)(3 * hq + 2) / 12.0f);
            const float o = attend_list(n, idx, sq, Pb + C_KB + kvh * 64, Pb + C_VB + kvh * 64, slope, t, sinks[hq], true, lg, lane);
            yrow[256 + hq * 64 + lane] = (bf16)f2bf(o);
        } else if (kind <= 8) {
            const int h = kind - 5, own = t >> 8;
            sq[lane] = bf2f(prow[C_QC + h * 64 + lane]);
            float g = -INFINITY;
            if (lane < own) {
                const float* km = kmean + ((b * 4 + h) * 16 + lane) * 64;
                float d = 0.f;
                for (int dd = 0; dd < 64; ++dd) d += sq[dd] * km[dd];
                g = d;
            }
            int nb = 0;
            for (int r = 0; r < 3; ++r) {
                const float mx = wave_max(g);
                if (mx == -INFINITY) break;
                const unsigned long long bal = __ballot(g == mx);
                const int wl = __ffsll((long long)bal) - 1;
                for (int i = lane; i < 256; i += 64) idx[nb * 256 + i] = wl * 256 + i;
                ++nb;
                if (lane == wl) g = -INFINITY;
            }
            const int nown = t - own * 256 + 1;
            for (int i = lane; i < nown; i += 64) idx[nb * 256 + i] = own * 256 + i;
            const float slope = exp2f(-8.0f * (float)(3 * h + 3) / 12.0f);
            const float o = attend_list(nb * 256 + nown, idx, sq, Pb + C_KC + h * 64, Pb + C_VC + h * 64, slope, t, 0.f, false, lg, lane);
            yrow[512 + h * 64 + lane] = (bf16)f2bf(o);
        } else {
            const int h = kind - 9;
            sq[lane] = bf2f(prow[C_QD + h * 64 + lane]);
            const bf16* Kb = Pb + C_KD + h * 64; const bf16* Vb = Pb + C_VD + h * 64;
            float acc = 0.f, carry = 0.f;
            for (int base = t - 1; base >= 0; base -= 64) {
                const int s = base - lane;
                const bool ok = s >= 0;
                float z = 0.f, lk = 0.f;
                if (ok) { z = dot64(Kb + (size_t)s * NP, sq) * 0.125f; lk = logsig(-z); }
                float incl = lk;
#pragma unroll
                for (int o = 1; o < 64; o <<= 1) { const float t2 = __shfl_up(incl, o); if (lane >= o) incl += t2; }
                const float la = carry + incl - lk;
                const float a = ok ? expf(logsig(z) + la) : 0.f;
                carry += __shfl(incl, 63);
                lg[lane] = a;
                const int cnt = (base + 1 < 64) ? base + 1 : 64;
                for (int j = 0; j < cnt; ++j) acc += lg[j] * bf2f(Vb[(size_t)(base - j) * NP + lane]);
            }
            yrow[768 + h * 64 + lane] = (bf16)f2bf(acc);
        }
    }
    __syncthreads();
}

__device__ void merge_phase(const bf16* P, const bf16* ys, const float* wb, bf16* merged, float* sm) {
    const int tid = LTID();
    for (int grp = LBID(); grp < T_ / 8; grp += LGRID()) {
        const int t0 = grp * 8;
        __syncthreads();
        for (int i = tid; i < 8 * 1024; i += NTHR) sm[i] = bf2f(ys[(size_t)t0 * 1024 + i]);
        __syncthreads();
        float mer[8][2];
#pragma unroll
        for (int k = 0; k < 8; ++k) { mer[k][0] = 0.f; mer[k][1] = 0.f; }
        for (int n = 0; n < 4; ++n) {
            float acc[8][2];
#pragma unroll
            for (int k = 0; k < 8; ++k) { acc[k][0] = 0.f; acc[k][1] = 0.f; }
            const float* w = wb + (size_t)n * 256 * 1024;
#pragma unroll 2
            for (int c = 0; c < 256; ++c) {
                const float w0 = w[(size_t)c * 1024 + tid], w1 = w[(size_t)c * 1024 + tid + 512];
#pragma unroll
                for (int k = 0; k < 8; ++k) { const float y = sm[k * 1024 + n * 256 + c]; acc[k][0] += y * w0; acc[k][1] += y * w1; }
            }
#pragma unroll
            for (int k = 0; k < 8; ++k) {
                const bf16* gr = P + (size_t)(t0 + k) * NP + C_G + n * 1024;
                const float g0 = bf2f(gr[tid]), g1 = bf2f(gr[tid + 512]);
                mer[k][0] += acc[k][0] / (1.f + expf(-g0));
                mer[k][1] += acc[k][1] / (1.f + expf(-g1));
            }
        }
#pragma unroll
        for (int k = 0; k < 8; ++k) {
            merged[(size_t)(t0 + k) * 1024 + tid] = (bf16)f2bf(mer[k][0]);
            merged[(size_t)(t0 + k) * 1024 + tid + 512] = (bf16)f2bf(mer[k][1]);
        }
    }
    __syncthreads();
}

__device__ __forceinline__ void ln_row(float4 (&v)[4], const float* g, const float* bb, float* orow, bf16* obrow, int lane) {
    float s = 0.f;
#pragma unroll
    for (int j = 0; j < 4; ++j) s += (v[j].x + v[j].y) + (v[j].z + v[j].w);
    const float mean = wave_sum(s) * (1.0f / 1024.0f);
    float s2 = 0.f;
#pragma unroll
    for (int j = 0; j < 4; ++j) { v[j].x -= mean; v[j].y -= mean; v[j].z -= mean; v[j].w -= mean; s2 += (v[j].x * v[j].x + v[j].y * v[j].y) + (v[j].z * v[j].z + v[j].w * v[j].w); }
    const float rstd = 1.0f / sqrtf(wave_sum(s2) * (1.0f / 1024.0f) + LN_EPS);
#pragma unroll
    for (int j = 0; j < 4; ++j) {
        const float4 gg = ((const float4*)g)[j * 64 + lane], b4 = ((const float4*)bb)[j * 64 + lane];
        float4 o; o.x = v[j].x * rstd * gg.x + b4.x; o.y = v[j].y * rstd * gg.y + b4.y; o.z = v[j].z * rstd * gg.z + b4.z; o.w = v[j].w * rstd * gg.w + b4.w;
        ((float4*)orow)[j * 64 + lane] = o;
        ((uint2*)obrow)[j * 64 + lane] = make_uint2(pk2(o.x, o.y), pk2(o.z, o.w));
    }
}
__device__ void ln1_phase(const float* hin, const float* add, const float* g, const float* bb, float* hout, bf16* hb) {
    const int lane = LTID() & 63, wave = LTID() >> 6;
    for (int row = LBID() * NWAVE + wave; row < T_; row += LGRID() * NWAVE) {
        float4 v[4];
#pragma unroll
        for (int j = 0; j < 4; ++j) {
            const float4 a = ((const float4*)(hin + (size_t)row * 1024))[j * 64 + lane], m = ((const float4*)(add + (size_t)row * 1024))[j * 64 + lane];
            v[j].x = ALPHA * a.x + m.x; v[j].y = ALPHA * a.y + m.y; v[j].z = ALPHA * a.z + m.z; v[j].w = ALPHA * a.w + m.w;
        }
        ln_row(v, g, bb, hout + (size_t)row * 1024, hb + (size_t)row * 1024, lane);
    }
}

__device__ void route_phase(const float* qb, const float* subkeys, int* eid, float* gate) {
    const int lane = LTID() & 63, wave = LTID() >> 6;
    for (int it = LBID() * NWAVE + wave; it < T_ * 8; it += LGRID() * NWAVE) {
        const int t = it >> 3, h = it & 7;
        float stop[2]; int itop[2];
#pragma unroll
        for (int p = 0; p < 2; ++p) {
            const float* qv = qb + (size_t)t * 1024 + h * 128 + p * 64;
            const float* sk0 = subkeys + ((size_t)(h * 2 + p) * 128 + lane) * 64;
            const float* sk1 = sk0 + 64 * 64;
            float v0 = 0.f, v1 = 0.f;
            for (int d = 0; d < 64; ++d) { const float qd = qv[d]; v0 += qd * sk0[d]; v1 += qd * sk1[d]; }
            float sv = 0.f; int si = 0;
            for (int r = 0; r < 16; ++r) {
                const float loc = fmaxf(v0, v1);
                const float mx = wave_max(loc);
                const unsigned long long b0 = __ballot(v0 == mx), b1 = __ballot(v1 == mx);
                int win;
                if (b0) win = __ffsll((long long)b0) - 1; else win = 64 + __ffsll((long long)b1) - 1;
                if (lane == r) { sv = mx; si = win; }
                if (win < 64) { if (lane == win) v0 = -INFINITY; } else { if (lane == win - 64) v1 = -INFINITY; }
            }
            stop[p] = sv; itop[p] = si;
        }
        float cv[4];
#pragma unroll
        for (int c = 0; c < 4; ++c) { const int ci = lane * 4 + c; cv[c] = __shfl(stop[0], ci >> 4) + __shfl(stop[1], ci & 15); }
        float sc = 0.f; int sci = 0;
        for (int r = 0; r < 16; ++r) {
            const float loc = fmaxf(fmaxf(cv[0], cv[1]), fmaxf(cv[2], cv[3]));
            const float mx = wave_max(loc);
            int mine = 1 << 30;
#pragma unroll
            for (int c = 3; c >= 0; --c) if (cv[c] == mx) mine = lane * 4 + c;
            int win = mine;
#pragma unroll
            for (int o = 32; o > 0; o >>= 1) { const int t2 = __shfl_xor(win, o); win = t2 < win ? t2 : win; }
            if (lane == r) { sc = mx; sci = win; }
#pragma unroll
            for (int c = 0; c < 4; ++c) if (lane * 4 + c == win) cv[c] = -INFINITY;
        }
        const int i1 = __shfl(itop[0], sci >> 4), i2 = __shfl(itop[1], sci & 15);
        const float scm = (lane < 16) ? sc : -INFINITY;
        const float m = wave_max(scm);
        const float e = (lane < 16) ? expf(sc - m) : 0.f;
        const float sum = wave_sum(e);
        if (lane < 16) { eid[(size_t)t * 128 + h * 16 + lane] = i1 * 128 + i2; gate[(size_t)t * 128 + h * 16 + lane] = e / sum; }
    }
}

__device__ void peer_phase(float* h, bf16* hb, const int* eid, const float* gate, const float* U, const float* V, const float* g, const float* bb) {
    const int lane = LTID() & 63, wave = LTID() >> 6;
    for (int t = LBID() * NWAVE + wave; t < T_; t += LGRID() * NWAVE) {
        float4 x[4], acc[4];
#pragma unroll
        for (int j = 0; j < 4; ++j) { x[j] = ((const float4*)(h + (size_t)t * 1024))[j * 64 + lane]; acc[j] = make_float4(0.f, 0.f, 0.f, 0.f); }
        for (int e = 0; e < 128; ++e) {
            const int id = eid[(size_t)t * 128 + e];
            const float gt = gate[(size_t)t * 128 + e];
            const float4* ur = (const float4*)(U + (size_t)id * 1024);
            const float4* vr = (const float4*)(V + (size_t)id * 1024);
            float d = 0.f;
#pragma unroll
            for (int j = 0; j < 4; ++j) { const float4 u4 = ur[j * 64 + lane]; d += (u4.x * x[j].x + u4.y * x[j].y) + (u4.z * x[j].z + u4.w * x[j].w); }
            d = wave_sum(d);
            const float hv = 0.5f * d * (1.0f + erff(d * 0.70710678118654752f)) * gt;
#pragma unroll
            for (int j = 0; j < 4; ++j) { const float4 v4 = vr[j * 64 + lane]; acc[j].x += hv * v4.x; acc[j].y += hv * v4.y; acc[j].z += hv * v4.z; acc[j].w += hv * v4.w; }
        }
        float4 v[4];
#pragma unroll
        for (int j = 0; j < 4; ++j) { v[j].x = ALPHA * x[j].x + acc[j].x; v[j].y = ALPHA * x[j].y + acc[j].y; v[j].z = ALPHA * x[j].z + acc[j].z; v[j].w = ALPHA * x[j].w + acc[j].w; }
        ln_row(v, g, bb, h + (size_t)t * 1024, hb + (size_t)t * 1024, lane);
    }
}

typedef short bf16x8_t __attribute__((ext_vector_type(8)));
typedef float f32x16_t __attribute__((ext_vector_type(16)));
typedef float f32x2_t __attribute__((ext_vector_type(2)));
typedef __bf16 bf16x2_t __attribute__((ext_vector_type(2)));
__device__ __forceinline__ unsigned cvtpk(float lo, float hi) { f32x2_t v = {lo, hi}; bf16x2_t b = __builtin_convertvector(v, bf16x2_t); return __builtin_bit_cast(unsigned, b); }
__device__ __forceinline__ int crow(int r, int hi) { return (r & 3) + 8 * (r >> 2) + 4 * hi; }
__device__ __forceinline__ float xlane32(float v) { return __shfl_xor(v, 32); }

constexpr int AT_KP = 72, AT_VP = 68;
constexpr int AT_KS = 0, AT_KS_BYTES = 64 * AT_KP * 2;
constexpr int AT_VT = 2 * AT_KS_BYTES, AT_VT_BYTES = 64 * AT_VP * 2;
constexpr int AT_KM = AT_VT + 2 * AT_VT_BYTES;
constexpr int AT_MISC = AT_KM + 32 * AT_KP * 2;
constexpr float LOG2E = 1.4426950408889634f;

__device__ __forceinline__ unsigned mk_unit(int kind, int b, int x, int y) { return ((unsigned)kind << 30) | ((unsigned)b << 28) | ((unsigned)x << 8) | (unsigned)y; }
__device__ void build_unit_table(unsigned* tab, int i) {
    int n = 0; unsigned res = 0u;
#pragma unroll 1
    for (int c = 64; c >= 1; --c) {
        if (i >= n && i < n + 4) res = mk_unit(0, i - n, 0, c - 1);
        n += 4;
        if ((c & 3) == 0) { if (i >= n && i < n + 16) { const int j = i - n; res = mk_unit(2, j >> 2, j & 3, c / 4 - 1); } n += 16; }
    }
    if (i < 512) tab[i] = res;
}

template <int kind> __device__ __forceinline__ void attn_unit(const bf16* P, const unsigned char* mask, const float* kmean, const float* sinks, bf16* ys,
                                unsigned char* lds, int b, int ux, int uy) {
    int tid_ = LTID(); asm volatile("" : "+v"(tid_));
    const int tid = tid_, lane = tid & 63, wave = __builtin_amdgcn_readfirstlane(tid >> 6), r32 = lane & 31, hi = lane >> 5;
    bf16* s_km = (bf16*)(lds + AT_KM);
    const int skey = tid >> 3, sc = tid & 7;
    {
        const bf16* Pb = P + (size_t)b * S_ * NP;
        int q0w, qcol, kcol, vcol, ycol, kt_hi, kt_lo; float slope2 = 0.f, sink2 = 0.f;
        if (kind == 0) { const int head = wave >> 1; q0w = uy * 64 + (wave & 1) * 32; qcol = C_QA + head * 64; kcol = C_KA; vcol = C_VA; ycol = head * 64;
            slope2 = exp2f(-8.0f * (float)(3 * head + 1) / 12.0f) * LOG2E; kt_hi = uy; kt_lo = 0; }
        else if (kind == 1) { const int hq = ux * 2 + (wave >> 2); q0w = uy * 128 + (wave & 3) * 32; qcol = C_QB + hq * 64; kcol = C_KB + ux * 64; vcol = C_VB + ux * 64; ycol = 256 + hq * 64;
            slope2 = exp2f(-8.0f * (float)(3 * hq + 2) / 12.0f) * LOG2E; sink2 = sinks[hq] * LOG2E; kt_hi = 2 * uy + 1; kt_lo = (2 * uy - 2 > 0) ? 2 * uy - 2 : 0; }
        else if (kind == 2) { q0w = uy * 256 + wave * 32; qcol = C_QC + ux * 64; kcol = C_KC + ux * 64; vcol = C_VC + ux * 64; ycol = 512 + ux * 64;
            slope2 = exp2f(-8.0f * (float)(3 * ux + 3) / 12.0f) * LOG2E; kt_hi = 4 * uy + 3; kt_lo = 0; }
        else { q0w = uy * 256 + wave * 32; qcol = C_QD + ux * 64; kcol = C_KD + ux * 64; vcol = C_VD + ux * 64; ycol = 768 + ux * 64; kt_hi = 4 * uy + 3; kt_lo = 0; }
        const int qpos = q0w + r32;
        bf16x8_t qf[4];
        { const bf16* qp = Pb + (size_t)qpos * NP + qcol + 8 * hi;
#pragma unroll
          for (int ks = 0; ks < 4; ++ks) qf[ks] = *(const bf16x8_t*)(qp + 16 * ks); }
        unsigned bm = 0u;
        if (kind == 2) {
            const int own = uy;
            for (int e = tid; e < 32 * 64; e += NTHR) { const int row = e >> 6, d = e & 63; s_km[row * AT_KP + d] = (row < 16) ? (bf16)f2bf(kmean[((b * 4 + ux) * 16 + row) * 64 + d]) : (bf16)0; }
            __syncthreads();
            f32x16_t gacc;
#pragma unroll
            for (int r = 0; r < 16; ++r) gacc[r] = 0.f;
#pragma unroll
            for (int ks = 0; ks < 4; ++ks) { const bf16x8_t a = *(const bf16x8_t*)(s_km + r32 * AT_KP + 16 * ks + 8 * hi); gacc = __builtin_amdgcn_mfma_f32_32x32x16_bf16(a, qf[ks], gacc, 0, 0, 0); }
            float gt[16];
#pragma unroll
            for (int r = 0; r < 8; ++r) { const float mine = gacc[r], other = xlane32(mine); const int bi = crow(r, 0);
                gt[bi] = hi ? other : mine; gt[bi + 4] = hi ? mine : other; }
#pragma unroll
            for (int n = 0; n < 16; ++n) if (n >= own) gt[n] = -INFINITY;
#pragma unroll
            for (int rep = 0; rep < 3; ++rep) {
                float mx = -INFINITY;
#pragma unroll
                for (int n = 0; n < 16; ++n) mx = fmaxf(mx, gt[n]);
                bool done = !(mx > -INFINITY);
#pragma unroll
                for (int n = 0; n < 16; ++n) { const bool hit = !done && gt[n] == mx; if (hit) { bm |= 1u << n; gt[n] = -INFINITY; done = true; } }
            }
        }
        f32x16_t o0, o1;
#pragma unroll
        for (int r = 0; r < 16; ++r) { o0[r] = 0.f; o1[r] = 0.f; }
        float m_run = -INFINITY, l_run = 0.f, carry = 0.f;
        const bf16* kg = Pb + (size_t)skey * NP + kcol + sc * 8;
        const bf16* vg = Pb + (size_t)skey * NP + vcol + sc * 8;
        uint4 rk = *(const uint4*)(kg + (size_t)kt_hi * 64 * NP), rv = *(const uint4*)(vg + (size_t)kt_hi * 64 * NP);
        int buf = 0;
        { bf16* ks_ = (bf16*)(lds + AT_KS); bf16* vt_ = (bf16*)(lds + AT_VT);
          *(uint4*)(ks_ + skey * AT_KP + sc * 8) = rk;
          const unsigned vw[4] = {rv.x, rv.y, rv.z, rv.w};
#pragma unroll
          for (int j = 0; j < 4; ++j) { vt_[(sc * 8 + 2 * j) * AT_VP + skey] = (bf16)(vw[j] & 0xffffu); vt_[(sc * 8 + 2 * j + 1) * AT_VP + skey] = (bf16)(vw[j] >> 16); } }
        __syncthreads();
        bool wave_done = false;
        for (int kt = kt_hi; kt >= kt_lo; --kt) {
            const bool more = kt > kt_lo;
            if (more) { rk = *(const uint4*)(kg + (size_t)(kt - 1) * 64 * NP); rv = *(const uint4*)(vg + (size_t)(kt - 1) * 64 * NP); }
            const bf16* ks_ = (const bf16*)(lds + AT_KS + buf * AT_KS_BYTES);
            const bf16* vt_ = (const bf16*)(lds + AT_VT + buf * AT_VT_BYTES);
            bool active = (kt * 64 <= q0w + 31) && !wave_done;
            if (kind == 1) active = active && (kt * 64 + 63 >= q0w - 127);
            if (active) {
                f32x16_t p0, p1;
#pragma unroll
                for (int r = 0; r < 16; ++r) { p0[r] = 0.f; p1[r] = 0.f; }
#pragma unroll
                for (int ks = 0; ks < 4; ++ks) {
                    const bf16x8_t a0 = *(const bf16x8_t*)(ks_ + r32 * AT_KP + 16 * ks + 8 * hi);
                    const bf16x8_t a1 = *(const bf16x8_t*)(ks_ + (32 + r32) * AT_KP + 16 * ks + 8 * hi);
                    p0 = __builtin_amdgcn_mfma_f32_32x32x16_bf16(a0, qf[ks], p0, 0, 0, 0);
                    p1 = __builtin_amdgcn_mfma_f32_32x32x16_bf16(a1, qf[ks], p1, 0, 0, 0);
                }
                const int kbase = kt * 64 + 4 * hi;
                if (kind != 3) {
                    unsigned w0 = 0xffffffffu, w1 = 0xffffffffu;
                    bool tile_ok = true;
                    if (kind == 0) { const uint2 mw = *(const uint2*)(mask + (size_t)(b * S_ + qpos) * 512 + kt * 8); w0 = mw.x >> (4 * hi); w1 = mw.y >> (4 * hi); }
                    if (kind == 2) tile_ok = ((kt >> 2) == uy) || (((bm >> (kt >> 2)) & 1u) != 0u);
                    const float cb = slope2 * (float)(kbase - qpos);
                    float mx = -INFINITY;
#pragma unroll
                    for (int r = 0; r < 16; ++r) {
                        const int off = (r & 3) + 8 * (r >> 2);
                        const int kp0 = kbase + off, kp1 = kp0 + 32;
                        bool v0 = tile_ok, v1 = tile_ok;
                        if (kind == 0) { v0 = (w0 >> off) & 1u; v1 = (w1 >> off) & 1u; }
                        else if (kind == 1) { v0 = (kp0 <= qpos) && (qpos - kp0 < 128); v1 = (kp1 <= qpos) && (qpos - kp1 < 128); }
                        else { v0 = v0 && (kp0 <= qpos); v1 = v1 && (kp1 <= qpos); }
                        const float l0 = p0[r] * (0.125f * LOG2E) + (cb + slope2 * (float)off);
                        const float l1 = p1[r] * (0.125f * LOG2E) + (cb + slope2 * (float)(off + 32));
                        p0[r] = v0 ? l0 : -INFINITY; p1[r] = v1 ? l1 : -INFINITY;
                        mx = fmaxf(mx, fmaxf(p0[r], p1[r]));
                    }
                    mx = fmaxf(mx, xlane32(mx));
                    const float m_new = fmaxf(m_run, mx);
                    const float m_safe = (m_new == -INFINITY) ? 0.f : m_new;
                    const float alpha = exp2f(m_run - m_safe);
                    float ls = 0.f;
#pragma unroll
                    for (int r = 0; r < 16; ++r) { p0[r] = exp2f(p0[r] - m_safe); p1[r] = exp2f(p1[r] - m_safe); ls += p0[r] + p1[r]; }
                    l_run = l_run * alpha + ls; m_run = m_new;
#pragma unroll
                    for (int r = 0; r < 16; ++r) { o0[r] *= alpha; o1[r] *= alpha; }
                } else {
                    float lk0[16], lk1[16];
#pragma unroll
                    for (int r = 0; r < 16; ++r) {
                        const int off = (r & 3) + 8 * (r >> 2);
                        const bool v0 = (kbase + off) < qpos, v1 = (kbase + off + 32) < qpos;
                        const float z0 = p0[r] * 0.125f, z1 = p1[r] * 0.125f;
                        const float t0 = log1pf(expf(-fabsf(z0))), t1 = log1pf(expf(-fabsf(z1)));
                        lk0[r] = v0 ? (fminf(-z0, 0.f) - t0) : 0.f; lk1[r] = v1 ? (fminf(-z1, 0.f) - t1) : 0.f;
                        p0[r] = v0 ? (fminf(z0, 0.f) - t0) : -INFINITY; p1[r] = v1 ? (fminf(z1, 0.f) - t1) : -INFINITY;
                    }
                    float G[8], PG[8];
#pragma unroll
                    for (int g = 0; g < 4; ++g) { G[3 - g] = (lk1[4 * g] + lk1[4 * g + 1]) + (lk1[4 * g + 2] + lk1[4 * g + 3]); G[7 - g] = (lk0[4 * g] + lk0[4 * g + 1]) + (lk0[4 * g + 2] + lk0[4 * g + 3]); }
#pragma unroll
                    for (int k = 0; k < 8; ++k) PG[k] = xlane32(G[k]);
                    float run = carry;
#pragma unroll
                    for (int k = 0; k < 8; ++k) {
                        const float E = run + (hi ? 0.f : PG[k]);
                        run += G[k] + PG[k];
                        const int g = (k < 4) ? 3 - k : 7 - k;
                        if (k < 4) { float la = E; p1[4 * g + 3] += la; la += lk1[4 * g + 3]; p1[4 * g + 2] += la; la += lk1[4 * g + 2]; p1[4 * g + 1] += la; la += lk1[4 * g + 1]; p1[4 * g] += la; }
                        else       { float la = E; p0[4 * g + 3] += la; la += lk0[4 * g + 3]; p0[4 * g + 2] += la; la += lk0[4 * g + 2]; p0[4 * g + 1] += la; la += lk0[4 * g + 1]; p0[4 * g] += la; }
                    }
                    carry = run;
#pragma unroll
                    for (int r = 0; r < 16; ++r) { p0[r] = expf(p0[r]); p1[r] = expf(p1[r]); }
                }
                unsigned pw[16];
#pragma unroll
                for (int j = 0; j < 8; ++j) { pw[j] = cvtpk(p0[2 * j], p0[2 * j + 1]); pw[8 + j] = cvtpk(p1[2 * j], p1[2 * j + 1]); }
#pragma unroll
                for (int s = 0; s < 4; ++s) {
                    bf16x8_t pb; { const unsigned* q = pw + 4 * s; typedef unsigned u32x4_t __attribute__((ext_vector_type(4))); u32x4_t t4 = {q[0], q[1], q[2], q[3]}; pb = __builtin_bit_cast(bf16x8_t, t4); }
#pragma unroll
                    for (int dt = 0; dt < 2; ++dt) {
                        const bf16* vp = vt_ + (32 * dt + r32) * AT_VP + 16 * s + 4 * hi;
                        typedef short s16x4_t __attribute__((ext_vector_type(4)));
                        const s16x4_t lo = *(const s16x4_t*)vp, hi4 = *(const s16x4_t*)(vp + 8);
                        const bf16x8_t va = {lo[0], lo[1], lo[2], lo[3], hi4[0], hi4[1], hi4[2], hi4[3]};
                        if (dt == 0) o0 = __builtin_amdgcn_mfma_f32_32x32x16_bf16(va, pb, o0, 0, 0, 0);
                        else         o1 = __builtin_amdgcn_mfma_f32_32x32x16_bf16(va, pb, o1, 0, 0, 0);
                    }
                }
            }
            if (kind == 3) {
                const float cm = carry;
                if (__all(cm < -110.0f) || !(kt * 64 <= q0w + 31) ) { if (__all(cm < -110.0f)) wave_done = true; }
            }
            if (more) {
                bf16* ksn = (bf16*)(lds + AT_KS + (buf ^ 1) * AT_KS_BYTES); bf16* vtn = (bf16*)(lds + AT_VT + (buf ^ 1) * AT_VT_BYTES);
                *(uint4*)(ksn + skey * AT_KP + sc * 8) = rk;
                const unsigned vw[4] = {rv.x, rv.y, rv.z, rv.w};
#pragma unroll
                for (int j = 0; j < 4; ++j) { vtn[(sc * 8 + 2 * j) * AT_VP + skey] = (bf16)(vw[j] & 0xffffu); vtn[(sc * 8 + 2 * j + 1) * AT_VP + skey] = (bf16)(vw[j] >> 16); }
            }
            if (kind == 3) { if (__syncthreads_and(wave_done ? 1 : 0)) break; }
            else __syncthreads();
            buf ^= 1;
        }
        float inv;
        if (kind == 3) inv = 1.0f;
        else {
            float lt = l_run + xlane32(l_run);
            if (kind == 1) { const float mf = fmaxf(m_run, sink2); const float sc2 = exp2f(m_run - mf); lt = lt * sc2 + exp2f(sink2 - mf); inv = sc2 / lt; }
            else inv = 1.0f / lt;
        }
        bf16* yp = ys + (size_t)(b * S_ + qpos) * 1024 + ycol + 4 * hi;
#pragma unroll
        for (int g = 0; g < 4; ++g) {
            *(uint2*)(yp + 8 * g) = make_uint2(cvtpk(o0[4 * g] * inv, o0[4 * g + 1] * inv), cvtpk(o0[4 * g + 2] * inv, o0[4 * g + 3] * inv));
            *(uint2*)(yp + 32 + 8 * g) = make_uint2(cvtpk(o1[4 * g] * inv, o1[4 * g + 1] * inv), cvtpk(o1[4 * g + 2] * inv, o1[4 * g + 3] * inv));
        }
    }
}
__device__ void attn_fast_phase(const bf16* P, const unsigned char* mask, const float* kmean, const float* sinks, bf16* ys,
                                const unsigned* utab, unsigned* counter, unsigned char* lds) {
    volatile unsigned* s_unit = (volatile unsigned*)(lds + AT_MISC);
    for (;;) {
        __syncthreads();
        if (LTID() == 0) s_unit[0] = atomicAdd(counter, 1u);
        __syncthreads();
        const unsigned ui = s_unit[0];
        if (ui >= 512u) break;
        const unsigned ue = utab[ui];
        const int kind = (int)(ue >> 30), b = (int)((ue >> 28) & 3u), ux = (int)((ue >> 8) & 255u), uy = (int)(ue & 255u);
        if (kind == 0) attn_unit<0>(P, mask, kmean, sinks, ys, lds, b, ux, uy);
        else attn_unit<2>(P, mask, kmean, sinks, ys, lds, b, ux, uy);
    }
    for (int u = LBID(); u < 256; u += LGRID()) { __syncthreads(); attn_unit<3>(P, mask, kmean, sinks, ys, lds, u >> 6, (u >> 4) & 3, u & 15); }
    for (int u = LBID(); u < 256; u += LGRID()) { __syncthreads(); attn_unit<1>(P, mask, kmean, sinks, ys, lds, u >> 6, (u >> 5) & 1, u & 31); }
}

typedef __bf16 bf16x2v __attribute__((ext_vector_type(2)));
__device__ __forceinline__ float dot2bf(unsigned a, unsigned b, float c) { return __builtin_amdgcn_fdot2_f32_bf16(__builtin_bit_cast(bf16x2v, a), __builtin_bit_cast(bf16x2v, b), c, false); }
__device__ __forceinline__ float rdlane_f(float v, int l) { return __builtin_bit_cast(float, __builtin_amdgcn_readlane(__builtin_bit_cast(int, v), l)); }
__device__ void convert_tables(const Params& p) {
    const size_t nchunk = (size_t)DEPTH_ * 16384 * 2 * 128;
    for (size_t i = (size_t)LBID() * NTHR + LTID(); i < nchunk; i += (size_t)LGRID() * NTHR) {
        const int c = (int)(i & 127), uvsel = (int)((i >> 7) & 1); const size_t le = i >> 8;
        const float* src = (uvsel ? p.in[10] : p.in[9]) + le * 1024 + c * 8;
        const float4 a = ((const float4*)src)[0], b = ((const float4*)src)[1];
        *(uint4*)(p.ws + WS_UV + le * 4096 + uvsel * 2048 + c * 16) = make_uint4(pk2(a.x, a.y), pk2(a.z, a.w), pk2(b.x, b.y), pk2(b.z, b.w));
    }
}
__device__ void peer_fast_phase(float* h, bf16* hb, const int* eid, const float* gate, const unsigned char* uv, const float* g, const float* bb) {
    const int tid = LTID(), lane = tid & 63, wave = tid >> 6;
    for (int t = LBID() * NWAVE + wave; t < T_; t += LGRID() * NWAVE) {
        const uint4 xa = *(const uint4*)(hb + (size_t)t * 1024 + lane * 8), xb = *(const uint4*)(hb + (size_t)t * 1024 + 512 + lane * 8);
        float acc[16];
#pragma unroll
        for (int i = 0; i < 16; ++i) acc[i] = 0.f;
#pragma unroll 1
        for (int batch = 0; batch < 4; ++batch) {
            const int my_eid = eid[(size_t)t * 128 + batch * 32 + (lane & 31)];
            const float my_gate = gate[(size_t)t * 128 + batch * 32 + (lane & 31)];
            float part[32];
#pragma unroll
            for (int grp = 0; grp < 8; ++grp) {
                uint4 ua[4], ub[4];
#pragma unroll
                for (int i = 0; i < 4; ++i) {
                    const int id = __builtin_amdgcn_readlane(my_eid, grp * 4 + i);
                    const unsigned char* row = uv + (size_t)id * 4096 + lane * 16;
                    ua[i] = *(const uint4*)row; ub[i] = *(const uint4*)(row + 1024);
                }
#pragma unroll
                for (int i = 0; i < 4; ++i) {
                    float d = dot2bf(ua[i].x, xa.x, 0.f); d = dot2bf(ua[i].y, xa.y, d); d = dot2bf(ua[i].z, xa.z, d); d = dot2bf(ua[i].w, xa.w, d);
                    d = dot2bf(ub[i].x, xb.x, d); d = dot2bf(ub[i].y, xb.y, d); d = dot2bf(ub[i].z, xb.z, d); d = dot2bf(ub[i].w, xb.w, d);
                    part[grp * 4 + i] = d;
                }
                asm volatile("" ::: "memory"); __builtin_amdgcn_sched_barrier(0);
            }
#pragma unroll
            for (int off = 16; off >= 1; off >>= 1) {
                const bool up = (lane & off) != 0;
#pragma unroll
                for (int i = 0; i < off; ++i) {
                    const float keep = up ? part[i + off] : part[i], send = up ? part[i] : part[i + off];
                    part[i] = keep + __shfl_xor(send, off);
                }
            }
            const float d = part[0] + __shfl_xor(part[0], 32);
            const float hv = 0.5f * d * (1.0f + erff(d * 0.70710678118654752f)) * my_gate;
#pragma unroll
            for (int grp = 0; grp < 8; ++grp) {
                uint4 va[4], vb[4];
#pragma unroll
                for (int i = 0; i < 4; ++i) {
                    const int id = __builtin_amdgcn_readlane(my_eid, grp * 4 + i);
                    const unsigned char* row = uv + (size_t)id * 4096 + 2048 + lane * 16;
                    va[i] = *(const uint4*)row; vb[i] = *(const uint4*)(row + 1024);
                }
#pragma unroll
                for (int i = 0; i < 4; ++i) {
                    const float c = rdlane_f(hv, grp * 4 + i);
                    float f[8];
                    unpack8(va[i], f);
#pragma unroll
                    for (int j = 0; j < 8; ++j) acc[j] += c * f[j];
                    unpack8(vb[i], f);
#pragma unroll
                    for (int j = 0; j < 8; ++j) acc[8 + j] += c * f[j];
                }
                asm volatile("" ::: "memory"); __builtin_amdgcn_sched_barrier(0);
            }
        }
        float* hr = h + (size_t)t * 1024;
        float y[16];
        { const float4 a0 = *(const float4*)(hr + lane * 8), a1 = *(const float4*)(hr + lane * 8 + 4), b0 = *(const float4*)(hr + 512 + lane * 8), b1 = *(const float4*)(hr + 512 + lane * 8 + 4);
          const float hv16[16] = {a0.x, a0.y, a0.z, a0.w, a1.x, a1.y, a1.z, a1.w, b0.x, b0.y, b0.z, b0.w, b1.x, b1.y, b1.z, b1.w};
#pragma unroll
          for (int i = 0; i < 16; ++i) y[i] = ALPHA * hv16[i] + acc[i]; }
        float s = 0.f;
#pragma unroll
        for (int i = 0; i < 16; ++i) s += y[i];
        const float mean = wave_sum(s) * (1.0f / 1024.0f);
        float s2 = 0.f;
#pragma unroll
        for (int i = 0; i < 16; ++i) { y[i] -= mean; s2 += y[i] * y[i]; }
        const float rstd = 1.0f / sqrtf(wave_sum(s2) * (1.0f / 1024.0f) + LN_EPS);
#pragma unroll
        for (int half = 0; half < 2; ++half) {
            const int d0 = half * 512 + lane * 8;
            const float4 g0 = *(const float4*)(g + d0), g1 = *(const float4*)(g + d0 + 4), c0 = *(const float4*)(bb + d0), c1 = *(const float4*)(bb + d0 + 4);
            const float gg[8] = {g0.x, g0.y, g0.z, g0.w, g1.x, g1.y, g1.z, g1.w}, cc[8] = {c0.x, c0.y, c0.z, c0.w, c1.x, c1.y, c1.z, c1.w};
            float o[8];
#pragma unroll
            for (int j = 0; j < 8; ++j) o[j] = y[half * 8 + j] * rstd * gg[j] + cc[j];
            *(float4*)(hr + d0) = make_float4(o[0], o[1], o[2], o[3]); *(float4*)(hr + d0 + 4) = make_float4(o[4], o[5], o[6], o[7]);
            *(uint4*)(hb + (size_t)t * 1024 + d0) = make_uint4(pk2(o[0], o[1]), pk2(o[2], o[3]), pk2(o[4], o[5]), pk2(o[6], o[7]));
        }
    }
}

__device__ __forceinline__ float pack_pl(float v, unsigned pl) { return __uint_as_float((__float_as_uint(v) & ~127u) | pl); }
__device__ __forceinline__ void ins16(float (&s)[16], float x) {
#pragma unroll
    for (int k = 15; k >= 1; --k) s[k] = __builtin_amdgcn_fmed3f(s[k - 1], x, s[k]);
    s[0] = fmaxf(s[0], x);
}
template <int D> __device__ __forceinline__ void bitonic_stage(float (&c)[16]) {
#pragma unroll
    for (int i = 0; i < 16; ++i) if ((i & D) == 0) { const float a = fmaxf(c[i], c[i + D]), b = fminf(c[i], c[i + D]); c[i] = a; c[i + D] = b; }
}
__device__ __forceinline__ int decode_key(unsigned pl) { return (int)(32u * ((pl >> 4) & 3u) + (pl & 3u) + 8u * ((pl >> 2) & 3u) + 4u * ((pl >> 6) & 1u)); }
__device__ void route_fast_phase(const bf16* qb, const bf16* skb  , int* eid, float* gate, unsigned char* lds) {
    const int tid = LTID(), lane = tid & 63, wave = tid >> 6, r32 = lane & 31, hi = lane >> 5;
    unsigned* lidx = (unsigned*)lds + wave * (64 * 33) + lane * 33;
    for (int unit = LBID() * NWAVE + wave; unit < (T_ / 32) * 8; unit += LGRID() * NWAVE) {
        const int h = unit & 7, t = (unit >> 3) * 32 + r32;
        float sl[2][16];
#pragma unroll
        for (int p = 0; p < 2; ++p) {
            bf16x8_t qf[4];
            { const bf16* qp = qb + (size_t)t * 1024 + h * 128 + p * 64 + 8 * hi;
#pragma unroll
              for (int ks = 0; ks < 4; ++ks) qf[ks] = *(const bf16x8_t*)(qp + 16 * ks); }
            float s[16];
#pragma unroll
            for (int k = 0; k < 16; ++k) s[k] = -INFINITY;
            const bf16* skp = skb + ((size_t)(h * 2 + p) * 128 + r32) * 64 + 8 * hi;
#pragma unroll
            for (int kt = 0; kt < 4; ++kt) {
                f32x16_t acc;
#pragma unroll
                for (int r = 0; r < 16; ++r) acc[r] = 0.f;
#pragma unroll
                for (int ks = 0; ks < 4; ++ks) { const bf16x8_t a = *(const bf16x8_t*)(skp + (size_t)kt * 32 * 64 + 16 * ks); acc = __builtin_amdgcn_mfma_f32_32x32x16_bf16(a, qf[ks], acc, 0, 0, 0); }
#pragma unroll
                for (int r = 0; r < 16; ++r) ins16(s, pack_pl(acc[r], (unsigned)(kt * 16 + r)));
            }
            const unsigned hb = (unsigned)hi << 6;
#pragma unroll
            for (int k = 0; k < 16; ++k) s[k] = __uint_as_float(__float_as_uint(s[k]) | hb);
            float c[16];
#pragma unroll
            for (int k = 0; k < 16; ++k) c[k] = fmaxf(s[k], __shfl_xor(s[15 - k], 32));
            bitonic_stage<8>(c); bitonic_stage<4>(c); bitonic_stage<2>(c); bitonic_stage<1>(c);
#pragma unroll
            for (int k = 0; k < 16; ++k) { sl[p][k] = c[k]; lidx[p * 16 + k] = (unsigned)decode_key(__float_as_uint(c[k]) & 127u); }
        }
        float w[16];
#pragma unroll
        for (int k = 0; k < 16; ++k) w[k] = -INFINITY;
#pragma unroll
        for (int i = 0; i < 16; ++i)
#pragma unroll
            for (int j = 0; j < 16; ++j)
                if ((i + 1) * (j + 1) <= 16) { const float v = sl[0][i] + sl[1][j]; ins16(w, __uint_as_float((__float_as_uint(v) & ~255u) | (unsigned)(i * 16 + j))); }
        float e[16], sum = 0.f;
#pragma unroll
        for (int k = 0; k < 16; ++k) { e[k] = expf(w[k] - w[0]); sum += e[k]; }
        const float inv = 1.0f / sum;
        int ide[8]; float gte[8];
#pragma unroll
        for (int k = 0; k < 8; ++k) {
            float wa = w[k], wb = w[8 + k], ea = e[k], eb = e[8 + k];
            asm volatile("" : "+v"(wa), "+v"(wb), "+v"(ea), "+v"(eb));
            const float wv = hi ? wb : wa;
            const unsigned pl = __float_as_uint(wv) & 255u;
            ide[k] = (int)(lidx[pl >> 4] * 128u + lidx[16 + (pl & 15u)]);
            gte[k] = (hi ? eb : ea) * inv;
        }
        int* ep = eid + (size_t)t * 128 + h * 16 + hi * 8; float* gp = gate + (size_t)t * 128 + h * 16 + hi * 8;
        *(int4*)ep = make_int4(ide[0], ide[1], ide[2], ide[3]); *(int4*)(ep + 4) = make_int4(ide[4], ide[5], ide[6], ide[7]);
        *(float4*)gp = make_float4(gte[0], gte[1], gte[2], gte[3]); *(float4*)(gp + 4) = make_float4(gte[4], gte[5], gte[6], gte[7]);
    }
}

typedef float f32x4_t __attribute__((ext_vector_type(4)));
__device__ void index_fast_phase(const bf16* P, unsigned char* mask, float* kmean, float* scratch_all, unsigned char* lds) {
    const int tid = LTID(), lane = tid & 63, wave = tid >> 6, bid = LBID(), G = LGRID();
    float* s_part = (float*)lds;
    for (int k = bid; k < 256; k += G) {
        const int b = k >> 6, h = (k >> 4) & 3, blk = k & 15;
        const bf16* kp = P + (size_t)(b * S_ + blk * 256 + wave * 32) * NP + C_KC + h * 64 + lane;
        float a = 0.f;
#pragma unroll 8
        for (int j = 0; j < 32; ++j) a += bf2f(kp[(size_t)j * NP]);
        __syncthreads();
        s_part[wave * 64 + lane] = a;
        __syncthreads();
        if (tid < 64) { float s = 0.f;
#pragma unroll
            for (int w = 0; w < 8; ++w) s += s_part[w * 64 + tid];
            kmean[((b * 4 + h) * 16 + blk) * 64 + tid] = s * (1.0f / 256.0f); }
    }
    float* scr = scratch_all + (size_t)bid * (16 * 4096);
    const int lq = lane & 15, g4 = lane >> 4;
    for (int ui = bid; ui < 1024; ui += G) {
        const int b = ui >> 8, k = ui & 255, tile = (b & 1) ? 255 - k : k, q0 = tile * 16;
        const bf16* Pb = P + (size_t)b * S_ * NP;
        const int ntiles = tile + 1;
        bf16x8_t qf[8]; float wi[8];
        { const bf16* qp = Pb + (size_t)(q0 + lq) * NP + C_QI + 8 * g4;
#pragma unroll
          for (int h = 0; h < 8; ++h) qf[h] = *(const bf16x8_t*)(qp + 32 * h);
          const uint4 wv = *(const uint4*)(Pb + (size_t)(q0 + lq) * NP + C_WI); unpack8(wv, wi); }
        for (int kt = wave; kt < ntiles; kt += NWAVE) {
            const bf16x8_t af = *(const bf16x8_t*)(Pb + (size_t)(kt * 16 + lq) * NP + C_KI + 8 * g4);
            f32x4_t sc = {0.f, 0.f, 0.f, 0.f};
#pragma unroll
            for (int h = 0; h < 8; ++h) {
                const f32x4_t z = {0.f, 0.f, 0.f, 0.f};
                const f32x4_t a = __builtin_amdgcn_mfma_f32_16x16x32_bf16(af, qf[h], z, 0, 0, 0);
#pragma unroll
                for (int r = 0; r < 4; ++r) sc[r] += fmaxf(a[r], 0.f) * wi[h];
            }
#pragma unroll
            for (int r = 0; r < 4; ++r) { sc[r] *= 0.0625f; if (sc[r] == 0.f) sc[r] = 0.f; }
            *(f32x4_t*)(scr + (size_t)lq * 4096 + kt * 16 + 4 * g4) = sc;
        }
        __threadfence_block();
        __syncthreads();
        __threadfence_block();
#pragma unroll 1
        for (int qi = 0; qi < 2; ++qi) {
            const int ql = 2 * wave + qi, q = q0 + ql;
            const float* row = scr + (size_t)ql * 4096;
            unsigned key[64];
#pragma unroll
            for (int j = 0; j < 64; ++j) {
                unsigned kk = 0u;
                if (j * 64 <= q) {
                    const float v = row[j * 64 + lane];
                    const unsigned u = __float_as_uint(v);
                    kk = (u & 0x80000000u) ? ~u : (u | 0x80000000u);
                    if (j * 64 + lane > q) kk = 0u;
                }
                key[j] = kk;
            }
            unsigned long long myword = 0ull;
            if (q + 1 > 256) {
                unsigned prefix = 0u;
#pragma unroll 1
                for (int bit = 31; bit >= 0; --bit) {
                    const unsigned cand = prefix | (1u << bit);
                    int cnt = 0;
#pragma unroll
                    for (int j = 0; j < 64; ++j) cnt += __popcll(__ballot(key[j] >= cand));
                    if (cnt >= 256) prefix = cand;
                }
                int cgt = 0;
#pragma unroll
                for (int j = 0; j < 64; ++j) cgt += __popcll(__ballot(key[j] > prefix));
                int need = 256 - cgt;
#pragma unroll
                for (int j = 0; j < 64; ++j) {
                    unsigned long long m = __ballot(key[j] == prefix);
                    int c = __popcll(m);
                    while (c > need) { m &= ~(1ull << (63 - __clzll((long long)m))); --c; }
                    need -= c;
                    const unsigned long long wj = __ballot(key[j] > prefix) | m;
                    if (lane == j) myword = wj;
                }
            } else {
#pragma unroll
                for (int j = 0; j < 4; ++j) { const unsigned long long wj = __ballot(j * 64 + lane <= q); if (lane == j) myword = wj; }
            }
            ((unsigned long long*)(mask + (size_t)(b * S_ + q) * 512))[lane] = myword;
        }
        __syncthreads();
    }
}

enum { PH_PRO = 0, PH_GIN, PH_INDEX, PH_ATTN, PH_MERGE, PH_GOUT, PH_LN1, PH_GQ, PH_ROUTE, PH_PEER };
template <int PH> __device__ __forceinline__ void run_phase(const Params& p, int l, unsigned char* lds_raw) {
    float* sm = (float*)lds_raw;
    unsigned char* ws = p.ws; asm volatile("" : "+s"(ws));
    float* hbuf = p.out;
    bf16* hb = (bf16*)(ws + WS_HB);
    bf16* P = (bf16*)(ws + WS_P);
    bf16* ys = (bf16*)(ws + WS_YS);
    bf16* mrg = (bf16*)(ws + WS_MRG);
    float* mix = (float*)(ws + WS_MIX);
    float* qb = (float*)(ws + WS_Q);
    unsigned char* mask = ws + WS_MASK;
    int* eid = (int*)(ws + WS_EID);
    float* gate = (float*)(ws + WS_GATE);
    float* kmean = (float*)(ws + WS_KMEAN);
    const float* hin = (l == 0) ? p.in[0] : hbuf;
    if (PH == PH_PRO) { prologue_phase(p, sm); convert_tables(p);
        for (int i = LBID() * NTHR + LTID(); i < DEPTH_ * 8 * 2 * 128 * 64 / 4; i += LGRID() * NTHR) { const float4 v = ((const float4*)p.in[8])[i]; ((uint2*)(ws + WS_SKB))[i] = make_uint2(pk2(v.x, v.y), pk2(v.z, v.w)); } if (LBID() < 2) build_unit_table((unsigned*)(ws + WS_CTL) + 1024, LBID() * NTHR + LTID()); }
    else if (PH == PH_GIN) {
        pg8::Gemm g{hb, (const bf16*)(ws + WS_WIN_T + l * WIN_T_BYTES), T_, NP, 1024};
        pg8::StaticOrder S; S.init(T_, NP, (int)LGRID(), (int)LBID());
        pg8::EpiBf16<0> E{P, NP, nullptr, 0, 0, 1.f};
        pg8::gemm_phase<pg8::EpiBf16<0>, pg8::StaticOrder, true, true>((PG8_LAS unsigned char*)lds_raw, g, S, E);
    }
    else if (PH == PH_INDEX) index_fast_phase(P, mask, kmean, (float*)(ws + WS_YS), lds_raw);
    else if (PH == PH_ATTN) attn_fast_phase(P, mask, kmean, p.in[4] + l * 4, ys, (const unsigned*)(ws + WS_CTL) + 1024, (unsigned*)(ws + WS_CTL) + 64 * l, lds_raw);
    else if (PH == PH_MERGE) merge_phase(P, ys, p.in[2] + (size_t)l * 4 * 256 * 1024, mrg, sm);
    else if (PH == PH_GOUT) {
        pg8::Gemm g{mrg, (const bf16*)(ws + WS_WOUT_T) + (size_t)l * 1024 * 1024, T_, 1024, 1024};
        pg8::StaticOrder S; S.init(T_, 1024, (int)LGRID(), (int)LBID());
        pg8::EpiF32 E{mix, 1024};
        pg8::gemm_phase<pg8::EpiF32, pg8::StaticOrder, true, true>((PG8_LAS unsigned char*)lds_raw, g, S, E);
    }
    else if (PH == PH_LN1) ln1_phase(hin, mix, p.in[5] + l * 1024, p.in[6] + l * 1024, hbuf, hb);
    else if (PH == PH_GQ) {
        pg8::Gemm g{hb, (const bf16*)(ws + WS_WQ_T) + (size_t)l * 1024 * 1024, T_, 1024, 1024};
        pg8::StaticOrder S; S.init(T_, 1024, (int)LGRID(), (int)LBID());
        pg8::EpiBf16<0> E{(bf16*)qb, 1024, nullptr, 0, 0, 1.f};
        pg8::gemm_phase<pg8::EpiBf16<0>, pg8::StaticOrder, true, true>((PG8_LAS unsigned char*)lds_raw, g, S, E);
    }
    else if (PH == PH_ROUTE) route_fast_phase((const bf16*)qb, (const bf16*)(ws + WS_SKB) + (size_t)l * 8 * 2 * 128 * 64, eid, gate, lds_raw);
    else peer_fast_phase(hbuf, hb, eid, gate, ws + WS_UV + (size_t)l * 64 * MiB, p.in[11] + l * 1024, p.in[12] + l * 1024);
}

__global__ void __launch_bounds__(NTHR, 2) mk_fwd(Params p) {
    extern __shared__ __attribute__((aligned(16))) unsigned char lds_raw[];
    cg::grid_group grid = cg::this_grid();
    run_phase<PH_PRO>(p, 0, lds_raw);
    grid.sync();
#pragma unroll 1
    for (int l = 0; l < DEPTH_; ++l) {
        run_phase<PH_GIN>(p, l, lds_raw); grid.sync();
        run_phase<PH_INDEX>(p, l, lds_raw); grid.sync();
        run_phase<PH_ATTN>(p, l, lds_raw); grid.sync();
        run_phase<PH_MERGE>(p, l, lds_raw); grid.sync();
        run_phase<PH_GOUT>(p, l, lds_raw); grid.sync();
        run_phase<PH_LN1>(p, l, lds_raw); grid.sync();
        run_phase<PH_GQ>(p, l, lds_raw); grid.sync();
        run_phase<PH_ROUTE>(p, l, lds_raw); grid.sync();
        run_phase<PH_PEER>(p, l, lds_raw); grid.sync();
    }
}

extern "C" void kernel_launch(void* const* d_in, const int* in_sizes, int n_in, void* d_out, int out_size, void* d_ws, size_t ws_size, hipStream_t stream) {
    if (n_in != 13 || ws_size < WS_END) { fprintf(stderr, "kernel_launch: unexpected n_in %d / ws_size %zu; nothing launched\n", n_in, ws_size); return; }
    static int grid_blocks = 0;
    if (grid_blocks == 0) {
        int dev = 0, cus = 0, per_cu = 0;
        (void)hipGetDevice(&dev);
        (void)hipDeviceGetAttribute(&cus, hipDeviceAttributeMultiprocessorCount, dev);
        (void)hipFuncSetAttribute((const void*)mk_fwd, hipFuncAttributeMaxDynamicSharedMemorySize, LDS_BYTES);
        (void)hipOccupancyMaxActiveBlocksPerMultiprocessor(&per_cu, (const void*)mk_fwd, NTHR, LDS_BYTES);
        if (per_cu < 1) fprintf(stderr, "kernel_launch: occupancy query reports %d\n", per_cu);
        grid_blocks = cus;
    }
    Params p{};
    for (int i = 0; i < 13; ++i) p.in[i] = (const float*)d_in[i];
    p.out = (float*)d_out; p.ws = (unsigned char*)d_ws;
    (void)hipMemsetAsync(d_ws, 0, 4096, stream);
    void* args[] = {&p};
    hipError_t e = hipLaunchCooperativeKernel((const void*)mk_fwd, dim3(grid_blocks), dim3(NTHR), args, LDS_BYTES, stream);
    if (e != hipSuccess) fprintf(stderr, "cooperative launch failed: %s (grid %d)\n", hipGetErrorString(e), grid_blocks);
}
```

```cpp
#include <hip/hip_runtime.h>
#include <cstdio>
#include <cstdint>
#include <hip/hip_cooperative_groups.h>
namespace cg = cooperative_groups;

__device__ __forceinline__ int LTID() { int t = threadIdx.x; asm volatile("" : "+v"(t)); return t; }
__device__ __forceinline__ int LBID() { int t = blockIdx.x; asm volatile("" : "+s"(t)); return t; }
__device__ __forceinline__ int LGRID() { int t = gridDim.x; asm volatile("" : "+s"(t)); return t; }
namespace pg8 {
#define PG8_LAS __attribute__((address_space(3)))
typedef unsigned short bf16_t;
typedef short bf16x8 __attribute__((ext_vector_type(8)));
typedef float f32x4 __attribute__((ext_vector_type(4)));
typedef unsigned u32x4 __attribute__((ext_vector_type(4)));
constexpr int BM = 256, BK = 64, HALF = 128, HTB = HALF * BK * 2  , STAGE_BYTES = 8 * HTB, NXCD = 8, WGM = 8;

__host__ __device__ __forceinline__ int lds_byte(int r, int c) { const int st = (r >> 4) * 2 + (c >> 5), rr = r & 15, cc = c & 31, ob = rr * 64 + cc * 2; return st * 1024 + (ob ^ (((ob >> 9) & 1) << 5)); }
__host__ __device__ __forceinline__ void stage_rc(int b, int& R, int& C) { const int st = b / 1024, sb = b % 1024, swz = sb ^ (((sb >> 9) & 1) << 5); R = (st >> 1) * 16 + swz / 64; C = (st & 1) * 32 + (swz % 64) / 2; }
__host__ __device__ __forceinline__ int perm32(int rho) { const int n = rho >> 4, i = rho & 15; return 8 * (i >> 2) + 4 * n + (i & 3); }

struct Unit { int pm, pn; };
struct Gemm { const bf16_t* A; const bf16_t* Bt; int M, N, K; };

struct StaticOrder {
    int nM, nN, nwg, G, c;
    __host__ __device__ void init(int M, int N, int G_, int c_) { nM = M / BM; nN = N / BM; nwg = nM * nN; G = G_; c = c_; }
    __host__ __device__ bool next(int i, Unit& u) const {
        const long L = (long)i * G + c; if (L >= nwg) return false;
        int wgid = (int)L; { const int q = nwg / NXCD, r = nwg % NXCD, xcd = wgid % NXCD, off = wgid / NXCD; wgid = (xcd < r ? xcd * (q + 1) : r * (q + 1) + (xcd - r) * q) + off; }
        const int nig = WGM * nN, gid = wgid / nig, fm = gid * WGM, gsz = (nM - fm) < WGM ? (nM - fm) : WGM;
        u.pm = fm + ((wgid % nig) % gsz); u.pn = (wgid % nig) / gsz; return true;
    }
    __device__ __forceinline__ void a_ready(const Unit&) const {}
    __device__ __forceinline__ void done(const Unit&) const {}
};

__device__ __forceinline__ unsigned cvt_pk_bf16(float lo, float hi) { unsigned r; asm volatile("v_cvt_pk_bf16_f32 %0, %1, %2" : "=v"(r) : "v"(lo), "v"(hi)); return r; }
typedef float f32x2 __attribute__((ext_vector_type(2)));
__device__ __forceinline__ f32x2 gelu_pk(f32x2 v) {
    const f32x2 av = __builtin_elementwise_abs(v), d = av * 0.2316418882f + 1.0f;
    f32x2 t; t.x = __builtin_amdgcn_rcpf(d.x); t.y = __builtin_amdgcn_rcpf(d.y);
    f32x2 q = t * 0.5307027145f + (-0.7265760135f); q = q * t + 0.7107068705f; q = q * t + (-0.142248368f); q = q * t + 0.127414796f; q = q * t;
    const f32x2 s = (v * v) * (-0.72134752044f);
    f32x2 e; e.x = __builtin_amdgcn_exp2f(s.x); e.y = __builtin_amdgcn_exp2f(s.y);
    const f32x2 m = v * (q * e), r = v - m;
    f32x2 o; o.x = v.x < 0.f ? m.x : r.x; o.y = v.y < 0.f ? m.y : r.y; return o;
}

template <int ACT  > struct EpiBf16 {
    static constexpr bool PERM = true, AFTER_DRAIN = false; static_assert(ACT == 0 || ACT == 1, "EpiBf16: ACT is 0 (none) or 1 (gelu_pk)");
    bf16_t* O; int ldc; const float* bias; int split_cols; size_t split_stride; float scale0;
    __device__ __forceinline__ void operator()(const f32x4 (&acc)[2][2][4][2], const Unit& u, int wr, int wc, int fr, int fq) const {
        const int row0 = u.pm * BM + wr * 64 + fr; int colt = u.pn * BM; bf16_t* base = O;
        float sc = 1.f; if (split_cols) { const int t = colt / split_cols; base += (size_t)t * split_stride; colt -= t * split_cols; if (t == 0) sc = scale0; }
        const int col0 = colt + wc * 32 + 8 * fq, bcol0 = u.pn * BM + wc * 32 + 8 * fq;
        f32x4 bv[2][2];
#pragma unroll
        for (int bj = 0; bj < 2; ++bj)
#pragma unroll
            for (int n = 0; n < 2; ++n) bv[bj][n] = bias ? *(const f32x4*)(bias + bcol0 + bj * HALF + 4 * n) : (f32x4){0.f, 0.f, 0.f, 0.f};
#pragma unroll
        for (int ai = 0; ai < 2; ++ai)
#pragma unroll
            for (int m = 0; m < 4; ++m) { bf16_t* rowp = base + (size_t)(row0 + ai * HALF + m * 16) * ldc + col0;
#pragma unroll
                for (int bj = 0; bj < 2; ++bj) { f32x4 v0 = acc[ai][bj][m][0] + bv[bj][0], v1 = acc[ai][bj][m][1] + bv[bj][1];
                    if (ACT == 1) { f32x2 a = gelu_pk((f32x2){v0[0], v0[1]}), b = gelu_pk((f32x2){v0[2], v0[3]}), c = gelu_pk((f32x2){v1[0], v1[1]}), d = gelu_pk((f32x2){v1[2], v1[3]});
                        v0 = (f32x4){a.x, a.y, b.x, b.y}; v1 = (f32x4){c.x, c.y, d.x, d.y}; }
                    v0 = v0 * sc; v1 = v1 * sc; u32x4 w; w.x = cvt_pk_bf16(v0[0], v0[1]); w.y = cvt_pk_bf16(v0[2], v0[3]); w.z = cvt_pk_bf16(v1[0], v1[1]); w.w = cvt_pk_bf16(v1[2], v1[3]);
                    *(u32x4*)(rowp + bj * HALF) = w; } }
    }
};
template <class Epi, class Sched, bool ALIGN_EPI = false, bool SP2 = false>
__device__ __forceinline__ void gemm_phase(PG8_LAS unsigned char* lds, const Gemm g, const Sched& S, const Epi& E) {
    const int tid = LTID(), wid = __builtin_amdgcn_readfirstlane(tid >> 6), lane = tid & 63, wr = wid >> 2, wc = wid & 3, fr = lane & 15, fq = lane >> 4;
    const int K = g.K, nt = K / BK;
    unsigned voffA[2], voffB[2];
#pragma unroll
    for (int i = 0; i < 2; ++i) { int R, C; stage_rc(tid * 16 + i * 8192, R, C); const int Rb = Epi::PERM ? ((R & ~31) + perm32(R & 31)) : R;
        voffA[i] = (unsigned)(R * K + C) * 2u; voffB[i] = (unsigned)(Rb * K + C) * 2u; }
    const size_t kstep = (size_t)(BK * 2);
    const size_t hstep = (size_t)HALF * K * 2;
    const size_t tstep = 2 * hstep;
    const unsigned ldsw = (unsigned)wid * 1024u;
    const int aoff = lds_byte(wr * 64 + fr, fq * 8), boff = lds_byte(wc * 32 + fr, fq * 8);
#define PG8_SA(b, h) (((b) * 2 + (h)) * HTB)
#define PG8_SB(b, h) ((4 + (b) * 2 + (h)) * HTB)
#define PG8_STAGE(bufoff, gbase, voff) do { _Pragma("unroll") for (int _i = 0; _i < 2; ++_i) \
        __builtin_amdgcn_global_load_lds((const unsigned*)((const char*)(gbase) + (voff)[_i]), (PG8_LAS unsigned*)(lds + (bufoff) + ldsw + _i * 8192), 16, 0, 0); } while (0)
#define PG8_LDA(dst, b, h) do { _Pragma("unroll") for (int m = 0; m < 4; ++m) _Pragma("unroll") for (int k = 0; k < 2; ++k) dst[m][k] = *(const PG8_LAS bf16x8*)(lds + PG8_SA(b, h) + aoff + m * 2048 + k * 1024); } while (0)
#define PG8_LDB(dst, b, h) do { _Pragma("unroll") for (int n = 0; n < 2; ++n) _Pragma("unroll") for (int k = 0; k < 2; ++k) dst[n][k] = *(const PG8_LAS bf16x8*)(lds + PG8_SB(b, h) + boff + n * 2048 + k * 1024); } while (0)
#define PG8_MMA(ai, bj, At, Bt) do { __builtin_amdgcn_s_setprio(1); _Pragma("unroll") for (int m = 0; m < 4; ++m) _Pragma("unroll") for (int n = 0; n < 2; ++n) _Pragma("unroll") for (int k = 0; k < 2; ++k) \
        acc[ai][bj][m][n] = __builtin_amdgcn_mfma_f32_16x16x32_bf16(Bt[n][k], At[m][k], acc[ai][bj][m][n], 0, 0, 0); __builtin_amdgcn_s_setprio(0); } while (0)
#define PG8_WAIT_V(n) asm volatile("s_waitcnt vmcnt(" #n ")" ::: "memory")
#define PG8_WAIT_L(n) asm volatile("s_waitcnt lgkmcnt(" #n ")" ::: "memory")
#define PG8_BAR __builtin_amdgcn_s_barrier()
#define PG8_SCHED __builtin_amdgcn_sched_barrier(0)
    Unit cur, nxt; int ui = 0;
    if (!S.next(0, cur)) return;
    f32x4 acc[2][2][4][2];
#pragma unroll
    for (int a = 0; a < 2; ++a)
#pragma unroll
        for (int b = 0; b < 2; ++b)
#pragma unroll
            for (int m = 0; m < 4; ++m)
#pragma unroll
                for (int n = 0; n < 2; ++n) acc[a][b][m][n] = (f32x4){0.f, 0.f, 0.f, 0.f};
    bf16x8 At[4][2], B0[2][2], B1[2][2];
    const char* cA = (const char*)g.A + (size_t)cur.pm * tstep; const char* cB = (const char*)g.Bt + (size_t)cur.pn * tstep;
    S.a_ready(cur);
    if constexpr (SP2) {
        PG8_STAGE(PG8_SB(0, 0), cB, voffB); PG8_STAGE(PG8_SB(0, 1), cB + hstep, voffB); PG8_STAGE(PG8_SA(0, 0), cA, voffA); PG8_STAGE(PG8_SA(0, 1), cA + hstep, voffA);
        if (wr == 1) PG8_BAR;
        PG8_WAIT_V(2); PG8_BAR;
        PG8_STAGE(PG8_SB(1, 0), cB + kstep, voffB); PG8_STAGE(PG8_SA(1, 0), cA + kstep, voffA); PG8_STAGE(PG8_SB(1, 1), cB + hstep + kstep, voffB);
        PG8_WAIT_V(6); PG8_BAR;
    } else {
        PG8_STAGE(PG8_SB(0, 0), cB, voffB); PG8_STAGE(PG8_SA(0, 0), cA, voffA); PG8_STAGE(PG8_SB(0, 1), cB + hstep, voffB); PG8_STAGE(PG8_SA(0, 1), cA + hstep, voffA);
        if (wr == 1) PG8_BAR;
        PG8_WAIT_V(4); PG8_BAR;
        PG8_STAGE(PG8_SB(1, 0), cB + kstep, voffB); PG8_STAGE(PG8_SA(1, 0), cA + kstep, voffA); PG8_STAGE(PG8_SB(1, 1), cB + hstep + kstep, voffB);
        PG8_WAIT_V(6); PG8_BAR;
    }
    for (;;) {
        const bool has_next = S.next(ui + 1, nxt);
        const char* nA = has_next ? (const char*)g.A + (size_t)nxt.pm * tstep : cA; const char* nB = has_next ? (const char*)g.Bt + (size_t)nxt.pn * tstep : cB;
        for (int t = 0; t < nt; t += 2) {
            const bool last = (t == nt - 2);
            const char* a1 = cA + (size_t)(t + 1) * kstep;
            const char* a2 = last ? nA : cA + (size_t)(t + 2) * kstep; const char* b2 = last ? nB : cB + (size_t)(t + 2) * kstep;
            const char* a3 = a2 + kstep; const char* b3 = b2 + kstep;
            if (last && has_next) S.a_ready(nxt);
            if constexpr (SP2) {
            PG8_LDB(B0, 0, 0); PG8_LDB(B1, 0, 1); PG8_SCHED; PG8_LDA(At, 0, 0); PG8_STAGE(PG8_SA(1, 1), a1 + hstep, voffA);
            PG8_WAIT_V(8); PG8_WAIT_L(0); PG8_BAR; PG8_MMA(0, 0, At, B0); PG8_MMA(0, 1, At, B1); PG8_BAR; PG8_SCHED;
            PG8_LDA(At, 0, 1); PG8_STAGE(PG8_SB(0, 0), b2, voffB); PG8_STAGE(PG8_SB(0, 1), b2 + hstep, voffB); PG8_STAGE(PG8_SA(0, 0), a2, voffA);
            PG8_WAIT_V(8); PG8_WAIT_L(0); PG8_BAR; PG8_MMA(1, 0, At, B0); PG8_MMA(1, 1, At, B1); PG8_BAR; PG8_SCHED;
            PG8_LDB(B0, 1, 0); PG8_LDB(B1, 1, 1); PG8_SCHED; PG8_LDA(At, 1, 0); PG8_STAGE(PG8_SA(0, 1), a2 + hstep, voffA);
            PG8_WAIT_V(8); PG8_WAIT_L(0); PG8_BAR; PG8_MMA(0, 0, At, B0); PG8_MMA(0, 1, At, B1); PG8_BAR; PG8_SCHED;
            PG8_LDA(At, 1, 1); PG8_STAGE(PG8_SB(1, 0), b3, voffB); PG8_STAGE(PG8_SB(1, 1), b3 + hstep, voffB); PG8_STAGE(PG8_SA(1, 0), a3, voffA);
            PG8_WAIT_V(8); PG8_WAIT_L(0); PG8_BAR; PG8_MMA(1, 0, At, B0); PG8_MMA(1, 1, At, B1); PG8_BAR; PG8_SCHED;
            } else {
            PG8_LDB(B0, 0, 0); PG8_SCHED; PG8_LDA(At, 0, 0); PG8_STAGE(PG8_SA(1, 1), a1 + hstep, voffA);
            PG8_WAIT_L(8); PG8_BAR; PG8_WAIT_L(0); PG8_MMA(0, 0, At, B0); PG8_BAR; PG8_SCHED;
            PG8_LDB(B1, 0, 1); PG8_STAGE(PG8_SB(0, 0), b2, voffB);
            PG8_BAR; PG8_WAIT_L(0); PG8_MMA(0, 1, At, B1); PG8_BAR;
            PG8_LDA(At, 0, 1); PG8_STAGE(PG8_SA(0, 0), a2, voffA);
            PG8_BAR; PG8_WAIT_L(0); PG8_MMA(1, 0, At, B0); PG8_BAR; PG8_SCHED;
            PG8_STAGE(PG8_SB(0, 1), b2 + hstep, voffB);
            PG8_WAIT_V(6); PG8_BAR; PG8_MMA(1, 1, At, B1); PG8_BAR;
            PG8_LDB(B0, 1, 0); PG8_SCHED; PG8_LDA(At, 1, 0); PG8_STAGE(PG8_SA(0, 1), a2 + hstep, voffA);
            PG8_WAIT_L(8); PG8_BAR; PG8_WAIT_L(0); PG8_MMA(0, 0, At, B0); PG8_BAR; PG8_SCHED;
            PG8_LDB(B1, 1, 1); PG8_STAGE(PG8_SB(1, 0), b3, voffB);
            PG8_BAR; PG8_WAIT_L(0); PG8_MMA(0, 1, At, B1); PG8_BAR;
            PG8_LDA(At, 1, 1); PG8_STAGE(PG8_SA(1, 0), a3, voffA);
            PG8_BAR; PG8_WAIT_L(0); PG8_MMA(1, 0, At, B0); PG8_BAR; PG8_SCHED;
            PG8_STAGE(PG8_SB(1, 1), b3 + hstep, voffB);
            PG8_WAIT_V(6); PG8_BAR; PG8_MMA(1, 1, At, B1); PG8_BAR;
            }
        }
        if constexpr (ALIGN_EPI) { if (wr == 0) PG8_BAR; }
        if constexpr (!Epi::AFTER_DRAIN) { E(acc, cur, wr, wc, fr, fq); S.done(cur); }
        if (!has_next) break;
#pragma unroll
        for (int a = 0; a < 2; ++a)
#pragma unroll
            for (int b = 0; b < 2; ++b)
#pragma unroll
                for (int m = 0; m < 4; ++m)
#pragma unroll
                    for (int n = 0; n < 2; ++n) acc[a][b][m][n] = (f32x4){0.f, 0.f, 0.f, 0.f};
        cur = nxt; cA = nA; cB = nB; ++ui;
        if constexpr (ALIGN_EPI) { if (wr == 1) PG8_BAR; }
    }
    PG8_WAIT_V(0);
    if constexpr (!ALIGN_EPI) { if (wr == 0) PG8_BAR; }
    PG8_BAR;
    if constexpr (Epi::AFTER_DRAIN) { E.fused(acc, cur, wr, wc, fr, fq, lds, wid, lane); S.done(cur); }
#undef PG8_SA
#undef PG8_SB
#undef PG8_STAGE
#undef PG8_LDA
#undef PG8_LDB
#undef PG8_MMA
#undef PG8_WAIT_V
#undef PG8_WAIT_L
#undef PG8_BAR
#undef PG8_SCHED
}
}
namespace pg8 {
struct EpiF32 {
    static constexpr bool PERM = false, AFTER_DRAIN = false;
    float* O; int ldc;
    __device__ __forceinline__ void operator()(const f32x4 (&acc)[2][2][4][2], const Unit& u, int wr, int wc, int fr, int fq) const {
        const int row0 = u.pm * BM + wr * 64 + fr, col0 = u.pn * BM + wc * 32 + 4 * fq;
#pragma unroll
        for (int ai = 0; ai < 2; ++ai)
#pragma unroll
            for (int m = 0; m < 4; ++m) { float* rowp = O + (size_t)(row0 + ai * HALF + m * 16) * ldc + col0;
#pragma unroll
                for (int bj = 0; bj < 2; ++bj)
#pragma unroll
                    for (int n = 0; n < 2; ++n) *(f32x4*)(rowp + bj * HALF + n * 16) = acc[ai][bj][m][n]; }
    }
};
}

typedef unsigned short bf16;
constexpr int T_ = 16384, S_ = 4096, NBATCH = 4, D_ = 1024, NCOL = 6824, NP = 6912, DEPTH_ = 2;
constexpr int C_QA = 0, C_KA = 256, C_VA = 320, C_QI = 384, C_KI = 640, C_WI = 672, C_QB = 680, C_KB = 936, C_VB = 1064,
              C_QC = 1192, C_KC = 1448, C_VC = 1704, C_QD = 1960, C_KD = 2216, C_VD = 2472, C_G = 2728;
constexpr int NTHR = 512, NWAVE = 8;
constexpr float ALPHA = 1.41421356237309515f;
constexpr float LN_EPS = 1e-5f;
constexpr size_t MiB = 1u << 20;
constexpr size_t WS_CTL = 0, WS_WIN_T = 2 * MiB, WS_WOUT_T = 30 * MiB, WS_WQ_T = 34 * MiB, WS_WBR_T = 38 * MiB, WS_HB = 42 * MiB,
                 WS_P = 74 * MiB, WS_MIX = 74 * MiB  , WS_Q = 138 * MiB  , WS_YS = 290 * MiB, WS_MRG = 322 * MiB,
                 WS_MASK = 354 * MiB, WS_EID = 362 * MiB, WS_GATE = 370 * MiB, WS_KMEAN = 378 * MiB, WS_SKB = 379 * MiB, WS_UV = 380 * MiB, WS_END = 508 * MiB;
constexpr size_t WIN_T_BYTES = (size_t)NP * 1024 * 2;
constexpr int LDS_BYTES = 144 * 1024;

struct Params { const float* in[13]; float* out; unsigned char* ws; };

__device__ __forceinline__ float bf2f(bf16 v) { return __uint_as_float((unsigned)v << 16); }
__device__ __forceinline__ unsigned f2bf(float f) { unsigned u = __float_as_uint(f); return (u + 0x7fffu + ((u >> 16) & 1u)) >> 16; }
__device__ __forceinline__ unsigned pk2(float lo, float hi) { return f2bf(lo) | (f2bf(hi) << 16); }
__device__ __forceinline__ void unpack8(const uint4 v, float* o) {
    o[0] = __uint_as_float(v.x << 16); o[1] = __uint_as_float(v.x & 0xffff0000u); o[2] = __uint_as_float(v.y << 16); o[3] = __uint_as_float(v.y & 0xffff0000u);
    o[4] = __uint_as_float(v.z << 16); o[5] = __uint_as_float(v.z & 0xffff0000u); o[6] = __uint_as_float(v.w << 16); o[7] = __uint_as_float(v.w & 0xffff0000u);
}
__device__ __forceinline__ float wave_sum(float v) {
#pragma unroll
    for (int o = 32; o > 0; o >>= 1) v += __shfl_xor(v, o);
    return v;
}
__device__ __forceinline__ float wave_max(float v) {
#pragma unroll
    for (int o = 32; o > 0; o >>= 1) v = fmaxf(v, __shfl_xor(v, o));
    return v;
}
__device__ __forceinline__ int wave_sum_i(int v) {
#pragma unroll
    for (int o = 32; o > 0; o >>= 1) v += __shfl_xor(v, o);
    return v;
}
__device__ __forceinline__ float logsig(float x) { return fminf(x, 0.f) - log1pf(expf(-fabsf(x))); }

__device__ void transpose_items(const float* W, int K, int N, bf16* WT, float* sm, int item0, int nitems_total, int item_stride) {
    const int tid = LTID();
    const int nkb = K / 64, nnb = (N + 63) / 64;
    for (int it = item0; it < nkb * nnb; it += item_stride) {
        const int kb = it % nkb, nb = it / nkb, k0 = kb * 64, n0 = nb * 64;
        __syncthreads();
        for (int e = tid; e < 64 * 64; e += NTHR) { const int kk = e >> 6, nn = e & 63; sm[kk * 65 + nn] = (n0 + nn < N) ? W[(size_t)(k0 + kk) * N + n0 + nn] : 0.f; }
        __syncthreads();
        { const int nn = tid >> 3, c = tid & 7;
          if (n0 + nn < N) { uint4 o; o.x = pk2(sm[(8 * c + 0) * 65 + nn], sm[(8 * c + 1) * 65 + nn]); o.y = pk2(sm[(8 * c + 2) * 65 + nn], sm[(8 * c + 3) * 65 + nn]);
              o.z = pk2(sm[(8 * c + 4) * 65 + nn], sm[(8 * c + 5) * 65 + nn]); o.w = pk2(sm[(8 * c + 6) * 65 + nn], sm[(8 * c + 7) * 65 + nn]);
              *(uint4*)(WT + (size_t)(n0 + nn) * K + k0 + 8 * c) = o; } }
    }
    __syncthreads();
}
__device__ void prologue_phase(const Params& p, float* sm) {
    const int tid = LTID(), B = LBID(), G = LGRID();
    unsigned char* ws = p.ws;
    for (int l = 0; l < DEPTH_; ++l) {
        bf16* win_t = (bf16*)(ws + WS_WIN_T + l * WIN_T_BYTES);
        transpose_items(p.in[1] + (size_t)l * 1024 * NCOL, 1024, NCOL, win_t, sm, B, 0, G);
        for (int i = B * NTHR + tid; i < (NP - NCOL) * 1024 / 8; i += G * NTHR) ((uint4*)(win_t + (size_t)NCOL * 1024))[i] = make_uint4(0u, 0u, 0u, 0u);
        transpose_items(p.in[3] + (size_t)l * 1024 * 1024, 1024, 1024, (bf16*)(ws + WS_WOUT_T) + (size_t)l * 1024 * 1024, sm, B, 0, G);
        transpose_items(p.in[7] + (size_t)l * 1024 * 1024, 1024, 1024, (bf16*)(ws + WS_WQ_T) + (size_t)l * 1024 * 1024, sm, B, 0, G);
        for (int n = 0; n < 4; ++n)
            transpose_items(p.in[2] + ((size_t)l * 4 + n) * 256 * 1024, 256, 1024, (bf16*)(ws + WS_WBR_T) + ((size_t)l * 4 + n) * 1024 * 256, sm, B, 0, G);
    }
    const float4* x4 = (const float4*)p.in[0]; uint2* hb2 = (uint2*)(ws + WS_HB);
    for (size_t i = (size_t)B * NTHR + tid; i < (size_t)T_ * 1024 / 4; i += (size_t)G * NTHR) { const float4 v = x4[i]; hb2[i] = make_uint2(pk2(v.x, v.y), pk2(v.z, v.w)); }
}

__device__ __forceinline__ int block_sum_i(int v, unsigned* red, int slot) {
    v = wave_sum_i(v);
    if ((LTID() & 63) == 0) red[slot * 8 + (LTID() >> 6)] = (unsigned)v;
    __syncthreads();
    int s = 0;
#pragma unroll
    for (int w = 0; w < 8; ++w) s += (int)red[slot * 8 + w];
    return s;
}
__device__ void index_phase(const bf16* P, unsigned char* mask, float* kmean, float* sm) {
    float* s_qi = sm;
    float* s_wi = sm + 256;
    unsigned* s_red = (unsigned*)(sm + 272);
    unsigned* s_key = (unsigned*)(sm + 320);
    const int tid = LTID(), lane = tid & 63, wave = tid >> 6;
    for (int o = LBID() * NTHR + tid; o < 4 * 4 * 16 * 64; o += LGRID() * NTHR) {
        const int d = o & 63, blk = (o >> 6) & 15, h = (o >> 10) & 3, b = o >> 12;
        float s = 0.f;
        for (int j = 0; j < 256; ++j) s += bf2f(P[(size_t)(b * S_ + blk * 256 + j) * NP + C_KC + h * 64 + d]);
        kmean[((b * 4 + h) * 16 + blk) * 64 + d] = s * (1.0f / 256.0f);
    }
    int slot = 0;
    for (int gq = LBID(); gq < T_; gq += LGRID()) {
        const int b = gq >> 12, q = gq & 4095;
        const bf16* Pb = P + (size_t)b * S_ * NP;
        __syncthreads();
        if (tid < 256) s_qi[tid] = bf2f(Pb[(size_t)q * NP + C_QI + tid]);
        else if (tid < 264) s_wi[tid - 256] = bf2f(Pb[(size_t)q * NP + C_WI + tid - 256]);
        __syncthreads();
#pragma unroll 1
        for (int j = 0; j < 8; ++j) {
            const int s = tid * 8 + j;
            unsigned key = 0u;
            if (s <= q) {
                const uint4* kr = (const uint4*)(Pb + (size_t)s * NP + C_KI);
                float kv[32];
#pragma unroll
                for (int c = 0; c < 4; ++c) unpack8(kr[c], kv + 8 * c);
                float sc = 0.f;
#pragma unroll 1
                for (int h = 0; h < 8; ++h) {
                    float d = 0.f;
#pragma unroll
                    for (int dd = 0; dd < 32; ++dd) d += s_qi[h * 32 + dd] * kv[dd];
                    sc += fmaxf(d, 0.f) * s_wi[h];
                }
                sc *= 0.0625f;
                if (sc == 0.f) sc = 0.f;
                const unsigned u = __float_as_uint(sc);
                key = (u & 0x80000000u) ? ~u : (u | 0x80000000u);
            }
            s_key[s] = key;
        }
        unsigned kk[8];
        { const uint4 k0 = *(const uint4*)&s_key[tid * 8], k1 = *(const uint4*)&s_key[tid * 8 + 4];
          kk[0] = k0.x; kk[1] = k0.y; kk[2] = k0.z; kk[3] = k0.w; kk[4] = k1.x; kk[5] = k1.y; kk[6] = k1.z; kk[7] = k1.w; }
        unsigned byte = 0u;
        if (q + 1 > 256) {
            unsigned prefix = 0u;
            for (int bit = 31; bit >= 0; --bit) {
                const unsigned cand = prefix | (1u << bit);
                int c = 0;
#pragma unroll
                for (int j = 0; j < 8; ++j) c += (kk[j] >= cand) ? 1 : 0;
                c = block_sum_i(c, s_red, slot); slot ^= 1;
                if (c >= 256) prefix = cand;
            }
            int cgt = 0, ceq = 0;
#pragma unroll
            for (int j = 0; j < 8; ++j) { cgt += (kk[j] > prefix) ? 1 : 0; ceq += (kk[j] == prefix) ? 1 : 0; }
            const int tot_gt = block_sum_i(cgt, s_red, slot); slot ^= 1;
            const int need = 256 - tot_gt;
            int incl = ceq;
#pragma unroll
            for (int o = 1; o < 64; o <<= 1) { const int t2 = __shfl_up(incl, o); if (lane >= o) incl += t2; }
            if (lane == 63) s_red[16 + wave] = (unsigned)incl;
            __syncthreads();
            int woff = 0;
            for (int w = 0; w < wave; ++w) woff += (int)s_red[16 + w];
            int taken = woff + incl - ceq;
#pragma unroll
            for (int j = 0; j < 8; ++j) {
                bool sel = kk[j] > prefix;
                if (kk[j] == prefix) { if (taken < need) sel = true; ++taken; }
                byte |= (sel ? 1u : 0u) << j;
            }
        } else {
#pragma unroll
            for (int j = 0; j < 8; ++j) byte |= ((tid * 8 + j) <= q ? 1u : 0u) << j;
        }
        mask[(size_t)gq * 512 + tid] = (unsigned char)byte;
    }
    __syncthreads();
}

__device__ __forceinline__ float dot64(const bf16* kr, const float* sq) {
    const uint4* k4 = (const uint4*)kr;
    float d = 0.f;
#pragma unroll 2
    for (int c = 0; c < 8; ++c) { float kv[8]; unpack8(k4[c], kv);
#pragma unroll
        for (int j = 0; j < 8; ++j) d += kv[j] * sq[8 * c + j]; }
    return d;
}
__device__ __forceinline__ float attend_list(int n, const int* idx, const float* sq, const bf16* Kb, const bf16* Vb, float slope, int qpos,
                                             float sink, bool has_sink, float* lg, int lane) {
    float m = -INFINITY;
    for (int i = lane; i < n; i += 64) {
        const int key = idx[i];
        const float d = dot64(Kb + (size_t)key * NP, sq);
        const float l = d * 0.125f - slope * (float)(qpos - key);
        lg[i] = l; m = fmaxf(m, l);
    }
    m = wave_max(m);
    if (has_sink) m = fmaxf(m, sink);
    float sum = 0.f;
    for (int i = lane; i < n; i += 64) { const float e = expf(lg[i] - m); lg[i] = e; sum += e; }
    sum = wave_sum(sum);
    if (has_sink) sum += expf(sink - m);
    float acc = 0.f;
    for (int i = 0; i < n; ++i) acc += lg[i] * bf2f(Vb[(size_t)idx[i] * NP + lane]);
    return acc / sum;
}

__device__ void attn_phase(const bf16* P, const unsigned char* mask, const float* kmean, const float* sinks, bf16* ys, float* sm) {
    const int tid = LTID(), lane = tid & 63, wave = tid >> 6;
    float* wsm = sm + wave * 2304;
    int* idx = (int*)wsm; float* lg = wsm + 1024; float* sq = wsm + 2048;
    const int gw = LBID() * NWAVE + wave, NGW = LGRID() * NWAVE;
    for (int it = gw; it < 13 * T_; it += NGW) {
        const int kind = it / T_, gt = it % T_, b = gt >> 12, t = gt & 4095;
        const bf16* Pb = P + (size_t)b * S_ * NP;
        bf16* yrow = ys + (size_t)gt * 1024;
        const bf16* prow = Pb + (size_t)t * NP;
        if (kind == 0) {
            for (int i = lane; i < 256; i += 64) sq[i] = bf2f(prow[C_QA + i]);
            const unsigned long long* mrow = (const unsigned long long*)(mask + (size_t)gt * 512);
            unsigned long long w = mrow[lane];
            const int c = __popcll(w);
            int incl = c;
#pragma unroll
            for (int o = 1; o < 64; o <<= 1) { const int t2 = __shfl_up(incl, o); if (lane >= o) incl += t2; }
            int pos = incl - c;
            const int ntot = __shfl(incl, 63);
            while (w) { const int bit = __ffsll((long long)w) - 1; w &= w - 1; idx[pos++] = lane * 64 + bit; }
            for (int h = 0; h < 4; ++h) {
                const float slope = exp2f(-8.0f * (float)(3 * h + 1) / 12.0f);
                const float o = attend_list(ntot, idx, sq + h * 64, Pb + C_KA, Pb + C_VA, slope, t, 0.f, false, lg, lane);
                yrow[h * 64 + lane] = (bf16)f2bf(o);
            }
        } else if (kind <= 4) {
            const int hq = kind - 1, kvh = hq >> 1;
            sq[lane] = bf2f(prow[C_QB + hq * 64 + lane]);
            const int lo = (t - 127 > 0) ? t - 127 : 0, n = t - lo + 1;
            for (int i = lane; i < n; i += 64) idx[i] = lo + i;
            const float slope = exp2f(-8.0f * (float)(3 * hq + 2) / 12.0f);
            const float o = attend_list(n, idx, sq, Pb + C_KB + kvh * 64, Pb + C_VB + kvh * 64, slope, t, sinks[hq], true, lg, lane);
            yrow[256 + hq * 64 + lane] = (bf16)f2bf(o);
        } else if (kind <= 8) {
            const int h = kind - 5, own = t >> 8;
            sq[lane] = bf2f(prow[C_QC + h * 64 + lane]);
            float g = -INFINITY;
            if (lane < own) {
                const float* km = kmean + ((b * 4 + h) * 16 + lane) * 64;
                float d = 0.f;
                for (int dd = 0; dd < 64; ++dd) d += sq[dd] * km[dd];
                g = d;
            }
            int nb = 0;
            for (int r = 0; r < 3; ++r) {
                const float mx = wave_max(g);
                if (mx == -INFINITY) break;
                const unsigned long long bal = __ballot(g == mx);
                const int wl = __ffsll((long long)bal) - 1;
                for (int i = lane; i < 256; i += 64) idx[nb * 256 + i] = wl * 256 + i;
                ++nb;
                if (lane == wl) g = -INFINITY;
            }
            const int nown = t - own * 256 + 1;
            for (int i = lane; i < nown; i += 64) idx[nb * 256 + i] = own * 256 + i;
            const float slope = exp2f(-8.0f * (float)(3 * h + 3) / 12.0f);
            const float o = attend_list(nb * 256 + nown, idx, sq, Pb + C_KC + h * 64, Pb + C_VC + h * 64, slope, t, 0.f, false, lg, lane);
            yrow[512 + h * 64 + lane] = (bf16)f2bf(o);
        } else {
            const int h = kind - 9;
            sq[lane] = bf2f(prow[C_QD + h * 64 + lane]);
            const bf16* Kb = Pb + C_KD + h * 64; const bf16* Vb = Pb + C_VD + h * 64;
            float acc = 0.f, carry = 0.f;
            for (int base = t - 1; base >= 0; base -= 64) {
                const int s = base - lane;
                const bool ok = s >= 0;
                float z = 0.f, lk = 0.f;
                if (ok) { z = dot64(Kb + (size_t)s * NP, sq) * 0.125f; lk = logsig(-z); }
                float incl = lk;
#pragma unroll
                for (int o = 1; o < 64; o <<= 1) { const float t2 = __shfl_up(incl, o); if (lane >= o) incl += t2; }
                const float la = carry + incl - lk;
                const float a = ok ? expf(logsig(z) + la) : 0.f;
                carry += __shfl(incl, 63);
                lg[lane] = a;
                const int cnt = (base + 1 < 64) ? base + 1 : 64;
                for (int j = 0; j < cnt; ++j) acc += lg[j] * bf2f(Vb[(size_t)(base - j) * NP + lane]);
            }
            yrow[768 + h * 64 + lane] = (bf16)f2bf(acc);
        }
    }
    __syncthreads();
}

__device__ void merge_phase(const bf16* P, const bf16* ys, const float* wb, bf16* merged, float* sm) {
    const int tid = LTID();
    for (int grp = LBID(); grp < T_ / 8; grp += LGRID()) {
        const int t0 = grp * 8;
        __syncthreads();
        for (int i = tid; i < 8 * 1024; i += NTHR) sm[i] = bf2f(ys[(size_t)t0 * 1024 + i]);
        __syncthreads();
        float mer[8][2];
#pragma unroll
        for (int k = 0; k < 8; ++k) { mer[k][0] = 0.f; mer[k][1] = 0.f; }
        for (int n = 0; n < 4; ++n) {
            float acc[8][2];
#pragma unroll
            for (int k = 0; k < 8; ++k) { acc[k][0] = 0.f; acc[k][1] = 0.f; }
            const float* w = wb + (size_t)n * 256 * 1024;
#pragma unroll 2
            for (int c = 0; c < 256; ++c) {
                const float w0 = w[(size_t)c * 1024 + tid], w1 = w[(size_t)c * 1024 + tid + 512];
#pragma unroll
                for (int k = 0; k < 8; ++k) { const float y = sm[k * 1024 + n * 256 + c]; acc[k][0] += y * w0; acc[k][1] += y * w1; }
            }
#pragma unroll
            for (int k = 0; k < 8; ++k) {
                const bf16* gr = P + (size_t)(t0 + k) * NP + C_G + n * 1024;
                const float g0 = bf2f(gr[tid]), g1 = bf2f(gr[tid + 512]);
                mer[k][0] += acc[k][0] / (1.f + expf(-g0));
                mer[k][1] += acc[k][1] / (1.f + expf(-g1));
            }
        }
#pragma unroll
        for (int k = 0; k < 8; ++k) {
            merged[(size_t)(t0 + k) * 1024 + tid] = (bf16)f2bf(mer[k][0]);
            merged[(size_t)(t0 + k) * 1024 + tid + 512] = (bf16)f2bf(mer[k][1]);
        }
    }
    __syncthreads();
}

__device__ __forceinline__ void ln_row(float4 (&v)[4], const float* g, const float* bb, float* orow, bf16* obrow, int lane) {
    float s = 0.f;
#pragma unroll
    for (int j = 0; j < 4; ++j) s += (v[j].x + v[j].y) + (v[j].z + v[j].w);
    const float mean = wave_sum(s) * (1.0f / 1024.0f);
    float s2 = 0.f;
#pragma unroll
    for (int j = 0; j < 4; ++j) { v[j].x -= mean; v[j].y -= mean; v[j].z -= mean; v[j].w -= mean; s2 += (v[j].x * v[j].x + v[j].y * v[j].y) + (v[j].z * v[j].z + v[j].w * v[j].w); }
    const float rstd = 1.0f / sqrtf(wave_sum(s2) * (1.0f / 1024.0f) + LN_EPS);
#pragma unroll
    for (int j = 0; j < 4; ++j) {
        const float4 gg = ((const float4*)g)[j * 64 + lane], b4 = ((const float4*)bb)[j * 64 + lane];
        float4 o; o.x = v[j].x * rstd * gg.x + b4.x; o.y = v[j].y * rstd * gg.y + b4.y; o.z = v[j].z * rstd * gg.z + b4.z; o.w = v[j].w * rstd * gg.w + b4.w;
        ((float4*)orow)[j * 64 + lane] = o;
        ((uint2*)obrow)[j * 64 + lane] = make_uint2(pk2(o.x, o.y), pk2(o.z, o.w));
    }
}
__device__ void ln1_phase(const float* hin, const float* add, const float* g, const float* bb, float* hout, bf16* hb) {
    const int lane = LTID() & 63, wave = LTID() >> 6;
    for (int row = LBID() * NWAVE + wave; row < T_; row += LGRID() * NWAVE) {
        float4 v[4];
#pragma unroll
        for (int j = 0; j < 4; ++j) {
            const float4 a = ((const float4*)(hin + (size_t)row * 1024))[j * 64 + lane], m = ((const float4*)(add + (size_t)row * 1024))[j * 64 + lane];
            v[j].x = ALPHA * a.x + m.x; v[j].y = ALPHA * a.y + m.y; v[j].z = ALPHA * a.z + m.z; v[j].w = ALPHA * a.w + m.w;
        }
        ln_row(v, g, bb, hout + (size_t)row * 1024, hb + (size_t)row * 1024, lane);
    }
}

__device__ void route_phase(const float* qb, const float* subkeys, int* eid, float* gate) {
    const int lane = LTID() & 63, wave = LTID() >> 6;
    for (int it = LBID() * NWAVE + wave; it < T_ * 8; it += LGRID() * NWAVE) {
        const int t = it >> 3, h = it & 7;
        float stop[2]; int itop[2];
#pragma unroll
        for (int p = 0; p < 2; ++p) {
            const float* qv = qb + (size_t)t * 1024 + h * 128 + p * 64;
            const float* sk0 = subkeys + ((size_t)(h * 2 + p) * 128 + lane) * 64;
            const float* sk1 = sk0 + 64 * 64;
            float v0 = 0.f, v1 = 0.f;
            for (int d = 0; d < 64; ++d) { const float qd = qv[d]; v0 += qd * sk0[d]; v1 += qd * sk1[d]; }
            float sv = 0.f; int si = 0;
            for (int r = 0; r < 16; ++r) {
                const float loc = fmaxf(v0, v1);
                const float mx = wave_max(loc);
                const unsigned long long b0 = __ballot(v0 == mx), b1 = __ballot(v1 == mx);
                int win;
                if (b0) win = __ffsll((long long)b0) - 1; else win = 64 + __ffsll((long long)b1) - 1;
                if (lane == r) { sv = mx; si = win; }
                if (win < 64) { if (lane == win) v0 = -INFINITY; } else { if (lane == win - 64) v1 = -INFINITY; }
            }
            stop[p] = sv; itop[p] = si;
        }
        float cv[4];
#pragma unroll
        for (int c = 0; c < 4; ++c) { const int ci = lane * 4 + c; cv[c] = __shfl(stop[0], ci >> 4) + __shfl(stop[1], ci & 15); }
        float sc = 0.f; int sci = 0;
        for (int r = 0; r < 16; ++r) {
            const float loc = fmaxf(fmaxf(cv[0], cv[1]), fmaxf(cv[2], cv[3]));
            const float mx = wave_max(loc);
            int mine = 1 << 30;
#pragma unroll
            for (int c = 3; c >= 0; --c) if (cv[c] == mx) mine = lane * 4 + c;
            int win = mine;
#pragma unroll
            for (int o = 32; o > 0; o >>= 1) { const int t2 = __shfl_xor(win, o); win = t2 < win ? t2 : win; }
            if (lane == r) { sc = mx; sci = win; }
#pragma unroll
            for (int c = 0; c < 4; ++c) if (lane * 4 + c == win) cv[c] = -INFINITY;
        }
        const int i1 = __shfl(itop[0], sci >> 4), i2 = __shfl(itop[1], sci & 15);
        const float scm = (lane < 16) ? sc : -INFINITY;
        const float m = wave_max(scm);
        const float e = (lane < 16) ? expf(sc - m) : 0.f;
        const float sum = wave_sum(e);
        if (lane < 16) { eid[(size_t)t * 128 + h * 16 + lane] = i1 * 128 + i2; gate[(size_t)t * 128 + h * 16 + lane] = e / sum; }
    }
}

__device__ void peer_phase(float* h, bf16* hb, const int* eid, const float* gate, const float* U, const float* V, const float* g, const float* bb) {
    const int lane = LTID() & 63, wave = LTID() >> 6;
    for (int t = LBID() * NWAVE + wave; t < T_; t += LGRID() * NWAVE) {
        float4 x[4], acc[4];
#pragma unroll
        for (int j = 0; j < 4; ++j) { x[j] = ((const float4*)(h + (size_t)t * 1024))[j * 64 + lane]; acc[j] = make_float4(0.f, 0.f, 0.f, 0.f); }
        for (int e = 0; e < 128; ++e) {
            const int id = eid[(size_t)t * 128 + e];
            const float gt = gate[(size_t)t * 128 + e];
            const float4* ur = (const float4*)(U + (size_t)id * 1024);
            const float4* vr = (const float4*)(V + (size_t)id * 1024);
            float d = 0.f;
#pragma unroll
            for (int j = 0; j < 4; ++j) { const float4 u4 = ur[j * 64 + lane]; d += (u4.x * x[j].x + u4.y * x[j].y) + (u4.z * x[j].z + u4.w * x[j].w); }
            d = wave_sum(d);
            const float hv = 0.5f * d * (1.0f + erff(d * 0.70710678118654752f)) * gt;
#pragma unroll
            for (int j = 0; j < 4; ++j) { const float4 v4 = vr[j * 64 + lane]; acc[j].x += hv * v4.x; acc[j].y += hv * v4.y; acc[j].z += hv * v4.z; acc[j].w += hv * v4.w; }
        }
        float4 v[4];
#pragma unroll
        for (int j = 0; j < 4; ++j) { v[j].x = ALPHA * x[j].x + acc[j].x; v[j].y = ALPHA * x[j].y + acc[j].y; v[j].z = ALPHA * x[j].z + acc[j].z; v[j].w = ALPHA * x[j].w + acc[j].w; }
        ln_row(v, g, bb, h + (size_t)t * 1024, hb + (size_t)t * 1024, lane);
    }
}

typedef short bf16x8_t __attribute__((ext_vector_type(8)));
typedef float f32x16_t __attribute__((ext_vector_type(16)));
typedef float f32x2_t __attribute__((ext_vector_type(2)));
typedef __bf16 bf16x2_t __attribute__((ext_vector_type(2)));
__device__ __forceinline__ unsigned cvtpk(float lo, float hi) { f32x2_t v = {lo, hi}; bf16x2_t b = __builtin_convertvector(v, bf16x2_t); return __builtin_bit_cast(unsigned, b); }
__device__ __forceinline__ int crow(int r, int hi) { return (r & 3) + 8 * (r >> 2) + 4 * hi; }
__device__ __forceinline__ float xlane32(float v) { return __shfl_xor(v, 32); }

constexpr int AT_KP = 72, AT_VP = 68;
constexpr int AT_KS = 0, AT_KS_BYTES = 64 * AT_KP * 2;
constexpr int AT_VT = 2 * AT_KS_BYTES, AT_VT_BYTES = 64 * AT_VP * 2;
constexpr int AT_KM = AT_VT + 2 * AT_VT_BYTES;
constexpr int AT_MISC = AT_KM + 32 * AT_KP * 2;
constexpr float LOG2E = 1.4426950408889634f;

__device__ __forceinline__ unsigned mk_unit(int kind, int b, int x, int y) { return ((unsigned)kind << 30) | ((unsigned)b << 28) | ((unsigned)x << 8) | (unsigned)y; }
__device__ void build_unit_table(unsigned* tab, int i) {
    int n = 0; unsigned res = 0u;
#pragma unroll 1
    for (int c = 64; c >= 1; --c) {
        if (i >= n && i < n + 4) res = mk_unit(0, i - n, 0, c - 1);
        n += 4;
        if ((c & 3) == 0) { if (i >= n && i < n + 16) { const int j = i - n; res = mk_unit(2, j >> 2, j & 3, c / 4 - 1); } n += 16; }
    }
    if (i < 512) tab[i] = res;
}

template <int kind> __device__ __forceinline__ void attn_unit(const bf16* P, const unsigned char* mask, const float* kmean, const float* sinks, bf16* ys,
                                unsigned char* lds, int b, int ux, int uy) {
    int tid_ = LTID(); asm volatile("" : "+v"(tid_));
    const int tid = tid_, lane = tid & 63, wave = __builtin_amdgcn_readfirstlane(tid >> 6), r32 = lane & 31, hi = lane >> 5;
    bf16* s_km = (bf16*)(lds + AT_KM);
    const int skey = tid >> 3, sc = tid & 7;
    {
        const bf16* Pb = P + (size_t)b * S_ * NP;
        int q0w, qcol, kcol, vcol, ycol, kt_hi, kt_lo; float slope2 = 0.f, sink2 = 0.f;
        if (kind == 0) { const int head = wave >> 1; q0w = uy * 64 + (wave & 1) * 32; qcol = C_QA + head * 64; kcol = C_KA; vcol = C_VA; ycol = head * 64;
            slope2 = exp2f(-8.0f * (float)(3 * head + 1) / 12.0f) * LOG2E; kt_hi = uy; kt_lo = 0; }
        else if (kind == 1) { const int hq = ux * 2 + (wave >> 2); q0w = uy * 128 + (wave & 3) * 32; qcol = C_QB + hq * 64; kcol = C_KB + ux * 64; vcol = C_VB + ux * 64; ycol = 256 + hq * 64;
            slope2 = exp2f(-8.0f * (float)(3 * hq + 2) / 12.0f) * LOG2E; sink2 = sinks[hq] * LOG2E; kt_hi = 2 * uy + 1; kt_lo = (2 * uy - 2 > 0) ? 2 * uy - 2 : 0; }
        else if (kind == 2) { q0w = uy * 256 + wave * 32; qcol = C_QC + ux * 64; kcol = C_KC + ux * 64; vcol = C_VC + ux * 64; ycol = 512 + ux * 64;
            slope2 = exp2f(-8.0f * (float)(3 * ux + 3) / 12.0f) * LOG2E; kt_hi = 4 * uy + 3; kt_lo = 0; }
        else { q0w = uy * 256 + wave * 32; qcol = C_QD + ux * 64; kcol = C_KD + ux * 64; vcol = C_VD + ux * 64; ycol = 768 + ux * 64; kt_hi = 4 * uy + 3; kt_lo = 0; }
        const int qpos = q0w + r32;
        bf16x8_t qf[4];
        { const bf16* qp = Pb + (size_t)qpos * NP + qcol + 8 * hi;
#pragma unroll
          for (int ks = 0; ks < 4; ++ks) qf[ks] = *(const bf16x8_t*)(qp + 16 * ks); }
        unsigned bm = 0u;
        if (kind == 2) {
            const int own = uy;
            for (int e = tid; e < 32 * 64; e += NTHR) { const int row = e >> 6, d = e & 63; s_km[row * AT_KP + d] = (row < 16) ? (bf16)f2bf(kmean[((b * 4 + ux) * 16 + row) * 64 + d]) : (bf16)0; }
            __syncthreads();
            f32x16_t gacc;
#pragma unroll
            for (int r = 0; r < 16; ++r) gacc[r] = 0.f;
#pragma unroll
            for (int ks = 0; ks < 4; ++ks) { const bf16x8_t a = *(const bf16x8_t*)(s_km + r32 * AT_KP + 16 * ks + 8 * hi); gacc = __builtin_amdgcn_mfma_f32_32x32x16_bf16(a, qf[ks], gacc, 0, 0, 0); }
            float gt[16];
#pragma unroll
            for (int r = 0; r < 8; ++r) { const float mine = gacc[r], other = xlane32(mine); const int bi = crow(r, 0);
                gt[bi] = hi ? other : mine; gt[bi + 4] = hi ? mine : other; }
#pragma unroll
            for (int n = 0; n < 16; ++n) if (n >= own) gt[n] = -INFINITY;
#pragma unroll
            for (int rep = 0; rep < 3; ++rep) {
                float mx = -INFINITY;
#pragma unroll
                for (int n = 0; n < 16; ++n) mx = fmaxf(mx, gt[n]);
                bool done = !(mx > -INFINITY);
#pragma unroll
                for (int n = 0; n < 16; ++n) { const bool hit = !done && gt[n] == mx; if (hit) { bm |= 1u << n; gt[n] = -INFINITY; done = true; } }
            }
        }
        f32x16_t o0, o1;
#pragma unroll
        for (int r = 0; r < 16; ++r) { o0[r] = 0.f; o1[r] = 0.f; }
        float m_run = -INFINITY, l_run = 0.f, carry = 0.f;
        const bf16* kg = Pb + (size_t)skey * NP + kcol + sc * 8;
        const bf16* vg = Pb + (size_t)skey * NP + vcol + sc * 8;
        uint4 rk = *(const uint4*)(kg + (size_t)kt_hi * 64 * NP), rv = *(const uint4*)(vg + (size_t)kt_hi * 64 * NP);
        int buf = 0;
        { bf16* ks_ = (bf16*)(lds + AT_KS); bf16* vt_ = (bf16*)(lds + AT_VT);
          *(uint4*)(ks_ + skey * AT_KP + sc * 8) = rk;
          const unsigned vw[4] = {rv.x, rv.y, rv.z, rv.w};
#pragma unroll
          for (int j = 0; j < 4; ++j) { vt_[(sc * 8 + 2 * j) * AT_VP + skey] = (bf16)(vw[j] & 0xffffu); vt_[(sc * 8 + 2 * j + 1) * AT_VP + skey] = (bf16)(vw[j] >> 16); } }
        __syncthreads();
        bool wave_done = false;
        for (int kt = kt_hi; kt >= kt_lo; --kt) {
            const bool more = kt > kt_lo;
            if (more) { rk = *(const uint4*)(kg + (size_t)(kt - 1) * 64 * NP); rv = *(const uint4*)(vg + (size_t)(kt - 1) * 64 * NP); }
            const bf16* ks_ = (const bf16*)(lds + AT_KS + buf * AT_KS_BYTES);
            const bf16* vt_ = (const bf16*)(lds + AT_VT + buf * AT_VT_BYTES);
            bool active = (kt * 64 <= q0w + 31) && !wave_done;
            if (kind == 1) active = active && (kt * 64 + 63 >= q0w - 127);
            if (active) {
                f32x16_t p0, p1;
#pragma unroll
                for (int r = 0; r < 16; ++r) { p0[r] = 0.f; p1[r] = 0.f; }
#pragma unroll
                for (int ks = 0; ks < 4; ++ks) {
                    const bf16x8_t a0 = *(const bf16x8_t*)(ks_ + r32 * AT_KP + 16 * ks + 8 * hi);
                    const bf16x8_t a1 = *(const bf16x8_t*)(ks_ + (32 + r32) * AT_KP + 16 * ks + 8 * hi);
                    p0 = __builtin_amdgcn_mfma_f32_32x32x16_bf16(a0, qf[ks], p0, 0, 0, 0);
                    p1 = __builtin_amdgcn_mfma_f32_32x32x16_bf16(a1, qf[ks], p1, 0, 0, 0);
                }
                const int kbase = kt * 64 + 4 * hi;
                if (kind != 3) {
                    unsigned w0 = 0xffffffffu, w1 = 0xffffffffu;
                    bool tile_ok = true;
                    if (kind == 0) { const uint2 mw = *(const uint2*)(mask + (size_t)(b * S_ + qpos) * 512 + kt * 8); w0 = mw.x >> (4 * hi); w1 = mw.y >> (4 * hi); }
                    if (kind == 2) tile_ok = ((kt >> 2) == uy) || (((bm >> (kt >> 2)) & 1u) != 0u);
                    const float cb = slope2 * (float)(kbase - qpos);
                    float mx = -INFINITY;
#pragma unroll
                    for (int r = 0; r < 16; ++r) {
                        const int off = (r & 3) + 8 * (r >> 2);
                        const int kp0 = kbase + off, kp1 = kp0 + 32;
                        bool v0 = tile_ok, v1 = tile_ok;
                        if (kind == 0) { v0 = (w0 >> off) & 1u; v1 = (w1 >> off) & 1u; }
                        else if (kind == 1) { v0 = (kp0 <= qpos) && (qpos - kp0 < 128); v1 = (kp1 <= qpos) && (qpos - kp1 < 128); }
                        else { v0 = v0 && (kp0 <= qpos); v1 = v1 && (kp1 <= qpos); }
                        const float l0 = p0[r] * (0.125f * LOG2E) + (cb + slope2 * (float)off);
                        const float l1 = p1[r] * (0.125f * LOG2E) + (cb + slope2 * (float)(off + 32));
                        p0[r] = v0 ? l0 : -INFINITY; p1[r] = v1 ? l1 : -INFINITY;
                        mx = fmaxf(mx, fmaxf(p0[r], p1[r]));
                    }
                    mx = fmaxf(mx, xlane32(mx));
                    const float m_new = fmaxf(m_run, mx);
                    const float m_safe = (m_new == -INFINITY) ? 0.f : m_new;
                    const float alpha = exp2f(m_run - m_safe);
                    float ls = 0.f;
#pragma unroll
                    for (int r = 0; r < 16; ++r) { p0[r] = exp2f(p0[r] - m_safe); p1[r] = exp2f(p1[r] - m_safe); ls += p0[r] + p1[r]; }
                    l_run = l_run * alpha + ls; m_run = m_new;
#pragma unroll
                    for (int r = 0; r < 16; ++r) { o0[r] *= alpha; o1[r] *= alpha; }
                } else {
                    float lk0[16], lk1[16];
#pragma unroll
                    for (int r = 0; r < 16; ++r) {
                        const int off = (r & 3) + 8 * (r >> 2);
                        const bool v0 = (kbase + off) < qpos, v1 = (kbase + off + 32) < qpos;
                        const float z0 = p0[r] * 0.125f, z1 = p1[r] * 0.125f;
                        const float t0 = log1pf(expf(-fabsf(z0))), t1 = log1pf(expf(-fabsf(z1)));
                        lk0[r] = v0 ? (fminf(-z0, 0.f) - t0) : 0.f; lk1[r] = v1 ? (fminf(-z1, 0.f) - t1) : 0.f;
                        p0[r] = v0 ? (fminf(z0, 0.f) - t0) : -INFINITY; p1[r] = v1 ? (fminf(z1, 0.f) - t1) : -INFINITY;
                    }
                    float G[8], PG[8];
#pragma unroll
                    for (int g = 0; g < 4; ++g) { G[3 - g] = (lk1[4 * g] + lk1[4 * g + 1]) + (lk1[4 * g + 2] + lk1[4 * g + 3]); G[7 - g] = (lk0[4 * g] + lk0[4 * g + 1]) + (lk0[4 * g + 2] + lk0[4 * g + 3]); }
#pragma unroll
                    for (int k = 0; k < 8; ++k) PG[k] = xlane32(G[k]);
                    float run = carry;
#pragma unroll
                    for (int k = 0; k < 8; ++k) {
                        const float E = run + (hi ? 0.f : PG[k]);
                        run += G[k] + PG[k];
                        const int g = (k < 4) ? 3 - k : 7 - k;
                        if (k < 4) { float la = E; p1[4 * g + 3] += la; la += lk1[4 * g + 3]; p1[4 * g + 2] += la; la += lk1[4 * g + 2]; p1[4 * g + 1] += la; la += lk1[4 * g + 1]; p1[4 * g] += la; }
                        else       { float la = E; p0[4 * g + 3] += la; la += lk0[4 * g + 3]; p0[4 * g + 2] += la; la += lk0[4 * g + 2]; p0[4 * g + 1] += la; la += lk0[4 * g + 1]; p0[4 * g] += la; }
                    }
                    carry = run;
#pragma unroll
                    for (int r = 0; r < 16; ++r) { p0[r] = expf(p0[r]); p1[r] = expf(p1[r]); }
                }
                unsigned pw[16];
#pragma unroll
                for (int j = 0; j < 8; ++j) { pw[j] = cvtpk(p0[2 * j], p0[2 * j + 1]); pw[8 + j] = cvtpk(p1[2 * j], p1[2 * j + 1]); }
#pragma unroll
                for (int s = 0; s < 4; ++s) {
                    bf16x8_t pb; { const unsigned* q = pw + 4 * s; typedef unsigned u32x4_t __attribute__((ext_vector_type(4))); u32x4_t t4 = {q[0], q[1], q[2], q[3]}; pb = __builtin_bit_cast(bf16x8_t, t4); }
#pragma unroll
                    for (int dt = 0; dt < 2; ++dt) {
                        const bf16* vp = vt_ + (32 * dt + r32) * AT_VP + 16 * s + 4 * hi;
                        typedef short s16x4_t __attribute__((ext_vector_type(4)));
                        const s16x4_t lo = *(const s16x4_t*)vp, hi4 = *(const s16x4_t*)(vp + 8);
                        const bf16x8_t va = {lo[0], lo[1], lo[2], lo[3], hi4[0], hi4[1], hi4[2], hi4[3]};
                        if (dt == 0) o0 = __builtin_amdgcn_mfma_f32_32x32x16_bf16(va, pb, o0, 0, 0, 0);
                        else         o1 = __builtin_amdgcn_mfma_f32_32x32x16_bf16(va, pb, o1, 0, 0, 0);
                    }
                }
            }
            if (kind == 3) {
                const float cm = carry;
                if (__all(cm < -110.0f) || !(kt * 64 <= q0w + 31) ) { if (__all(cm < -110.0f)) wave_done = true; }
            }
            if (more) {
                bf16* ksn = (bf16*)(lds + AT_KS + (buf ^ 1) * AT_KS_BYTES); bf16* vtn = (bf16*)(lds + AT_VT + (buf ^ 1) * AT_VT_BYTES);
                *(uint4*)(ksn + skey * AT_KP + sc * 8) = rk;
                const unsigned vw[4] = {rv.x, rv.y, rv.z, rv.w};
#pragma unroll
                for (int j = 0; j < 4; ++j) { vtn[(sc * 8 + 2 * j) * AT_VP + skey] = (bf16)(vw[j] & 0xffffu); vtn[(sc * 8 + 2 * j + 1) * AT_VP + skey] = (bf16)(vw[j] >> 16); }
            }
            if (kind == 3) { if (__syncthreads_and(wave_done ? 1 : 0)) break; }
            else __syncthreads();
            buf ^= 1;
        }
        float inv;
        if (kind == 3) inv = 1.0f;
        else {
            float lt = l_run + xlane32(l_run);
            if (kind == 1) { const float mf = fmaxf(m_run, sink2); const float sc2 = exp2f(m_run - mf); lt = lt * sc2 + exp2f(sink2 - mf); inv = sc2 / lt; }
            else inv = 1.0f / lt;
        }
        bf16* yp = ys + (size_t)(b * S_ + qpos) * 1024 + ycol + 4 * hi;
#pragma unroll
        for (int g = 0; g < 4; ++g) {
            *(uint2*)(yp + 8 * g) = make_uint2(cvtpk(o0[4 * g] * inv, o0[4 * g + 1] * inv), cvtpk(o0[4 * g + 2] * inv, o0[4 * g + 3] * inv));
            *(uint2*)(yp + 32 + 8 * g) = make_uint2(cvtpk(o1[4 * g] * inv, o1[4 * g + 1] * inv), cvtpk(o1[4 * g + 2] * inv, o1[4 * g + 3] * inv));
        }
    }
}
__device__ void attn_fast_phase(const bf16* P, const unsigned char* mask, const float* kmean, const float* sinks, bf16* ys,
                                const unsigned* utab, unsigned* counter, unsigned char* lds) {
    volatile unsigned* s_unit = (volatile unsigned*)(lds + AT_MISC);
    for (;;) {
        __syncthreads();
        if (LTID() == 0) s_unit[0] = atomicAdd(counter, 1u);
        __syncthreads();
        const unsigned ui = s_unit[0];
        if (ui >= 512u) break;
        const unsigned ue = utab[ui];
        const int kind = (int)(ue >> 30), b = (int)((ue >> 28) & 3u), ux = (int)((ue >> 8) & 255u), uy = (int)(ue & 255u);
        if (kind == 0) attn_unit<0>(P, mask, kmean, sinks, ys, lds, b, ux, uy);
        else attn_unit<2>(P, mask, kmean, sinks, ys, lds, b, ux, uy);
    }
    for (int u = LBID(); u < 256; u += LGRID()) { __syncthreads(); attn_unit<3>(P, mask, kmean, sinks, ys, lds, u >> 6, (u >> 4) & 3, u & 15); }
    for (int u = LBID(); u < 256; u += LGRID()) { __syncthreads(); attn_unit<1>(P, mask, kmean, sinks, ys, lds, u >> 6, (u >> 5) & 1, u & 31); }
}

constexpr float U_SCALE = 64.0f, V_SCALE = 16.0f;
__device__ __forceinline__ float rdlane_f(float v, int l) { return __builtin_bit_cast(float, __builtin_amdgcn_readlane(__builtin_bit_cast(int, v), l)); }
__device__ __forceinline__ unsigned pk4_fp8(float a, float b, float c, float d) { int v = 0; v = __builtin_amdgcn_cvt_pk_fp8_f32(a, b, v, false); v = __builtin_amdgcn_cvt_pk_fp8_f32(c, d, v, true); return (unsigned)v; }
__device__ __forceinline__ void unpack16_fp8(const uint4 v, float* o) {
    const unsigned w[4] = {v.x, v.y, v.z, v.w};
#pragma unroll
    for (int i = 0; i < 4; ++i) { const f32x2_t lo = __builtin_amdgcn_cvt_pk_f32_fp8((int)w[i], false), hi2 = __builtin_amdgcn_cvt_pk_f32_fp8((int)w[i], true);
        o[4 * i] = lo.x; o[4 * i + 1] = lo.y; o[4 * i + 2] = hi2.x; o[4 * i + 3] = hi2.y; }
}
__device__ void convert_tables(const Params& p) {
    const size_t nchunk = (size_t)DEPTH_ * 16384 * 2 * 64;
    for (size_t i = (size_t)LBID() * NTHR + LTID(); i < nchunk; i += (size_t)LGRID() * NTHR) {
        const int c = (int)(i & 63), uvsel = (int)((i >> 6) & 1); const size_t le = i >> 7;
        const float* src = (uvsel ? p.in[10] : p.in[9]) + le * 1024 + c * 16;
        const float sc = uvsel ? V_SCALE : U_SCALE;
        const float4 a = ((const float4*)src)[0], b = ((const float4*)src)[1], cc = ((const float4*)src)[2], d = ((const float4*)src)[3];
        *(uint4*)(p.ws + WS_UV + le * 2048 + uvsel * 1024 + c * 16) = make_uint4(pk4_fp8(a.x * sc, a.y * sc, a.z * sc, a.w * sc), pk4_fp8(b.x * sc, b.y * sc, b.z * sc, b.w * sc),
                                                                               pk4_fp8(cc.x * sc, cc.y * sc, cc.z * sc, cc.w * sc), pk4_fp8(d.x * sc, d.y * sc, d.z * sc, d.w * sc));
    }
}
__device__ void peer_fast_phase(float* h, bf16* hb, const int* eid, const float* gate, const unsigned char* uv, const float* g, const float* bb, unsigned char* lds) {
    const int tid = LTID(), lane = tid & 63, wave = tid >> 6;
    for (int t = LBID() * NWAVE + wave; t < T_; t += LGRID() * NWAVE) {
        float* hr = h + (size_t)t * 1024 + lane * 16;
        float x[16], acc[16];
        { const float4 a0 = ((const float4*)hr)[0], a1 = ((const float4*)hr)[1], a2 = ((const float4*)hr)[2], a3 = ((const float4*)hr)[3];
          x[0] = a0.x; x[1] = a0.y; x[2] = a0.z; x[3] = a0.w; x[4] = a1.x; x[5] = a1.y; x[6] = a1.z; x[7] = a1.w;
          x[8] = a2.x; x[9] = a2.y; x[10] = a2.z; x[11] = a2.w; x[12] = a3.x; x[13] = a3.y; x[14] = a3.z; x[15] = a3.w; }
#pragma unroll
        for (int i = 0; i < 16; ++i) acc[i] = 0.f;
#pragma unroll 1
        for (int batch = 0; batch < 4; ++batch) {
            const int my_eid = eid[(size_t)t * 128 + batch * 32 + (lane & 31)];
            const float my_gate = gate[(size_t)t * 128 + batch * 32 + (lane & 31)];
            float* pl = (float*)lds + wave * 2048;
#pragma unroll 1
            for (int grp = 0; grp < 4; ++grp) {
                uint4 ua[8];
#pragma unroll
                for (int i = 0; i < 8; ++i) { const int id = __shfl(my_eid, grp * 8 + i); ua[i] = *(const uint4*)(uv + (size_t)id * 2048 + lane * 16); }
#pragma unroll
                for (int i = 0; i < 8; ++i) {
                    float f[16]; unpack16_fp8(ua[i], f);
                    float d0 = 0.f, d1 = 0.f;
#pragma unroll
                    for (int j = 0; j < 8; ++j) { d0 += f[j] * x[j]; d1 += f[8 + j] * x[8 + j]; }
                    pl[(grp * 8 + i) * 64 + lane] = d0 + d1;
                }
            }
            float d;
            { const float4* pr = (const float4*)(pl + (lane & 31) * 64); float4 s4 = pr[0];
#pragma unroll
              for (int i = 1; i < 16; ++i) { const float4 v = pr[i]; s4.x += v.x; s4.y += v.y; s4.z += v.z; s4.w += v.w; }
              d = ((s4.x + s4.y) + (s4.z + s4.w)) * (1.0f / U_SCALE); }
            const float hv = 0.5f * d * (1.0f + erff(d * 0.70710678118654752f)) * my_gate * (1.0f / V_SCALE);
#pragma unroll 1
            for (int grp = 0; grp < 4; ++grp) {
                uint4 va[8];
#pragma unroll
                for (int i = 0; i < 8; ++i) { const int id = __shfl(my_eid, grp * 8 + i); va[i] = *(const uint4*)(uv + (size_t)id * 2048 + 1024 + lane * 16); }
#pragma unroll
                for (int i = 0; i < 8; ++i) {
                    const float c = __shfl(hv, grp * 8 + i);
                    float f[16]; unpack16_fp8(va[i], f);
#pragma unroll
                    for (int j = 0; j < 16; ++j) acc[j] += c * f[j];
                }
            }
        }
        float y[16], s = 0.f;
#pragma unroll
        for (int i = 0; i < 16; ++i) { y[i] = ALPHA * x[i] + acc[i]; s += y[i]; }
        const float mean = wave_sum(s) * (1.0f / 1024.0f);
        float s2 = 0.f;
#pragma unroll
        for (int i = 0; i < 16; ++i) { y[i] -= mean; s2 += y[i] * y[i]; }
        const float rstd = 1.0f / sqrtf(wave_sum(s2) * (1.0f / 1024.0f) + LN_EPS);
        float o[16];
#pragma unroll
        for (int q4 = 0; q4 < 4; ++q4) {
            const float4 gg = ((const float4*)(g + lane * 16))[q4], cc = ((const float4*)(bb + lane * 16))[q4];
            o[4 * q4] = y[4 * q4] * rstd * gg.x + cc.x; o[4 * q4 + 1] = y[4 * q4 + 1] * rstd * gg.y + cc.y; o[4 * q4 + 2] = y[4 * q4 + 2] * rstd * gg.z + cc.z; o[4 * q4 + 3] = y[4 * q4 + 3] * rstd * gg.w + cc.w;
            ((float4*)hr)[q4] = make_float4(o[4 * q4], o[4 * q4 + 1], o[4 * q4 + 2], o[4 * q4 + 3]);
        }
        uint4* hbp = (uint4*)(hb + (size_t)t * 1024 + lane * 16);
        hbp[0] = make_uint4(pk2(o[0], o[1]), pk2(o[2], o[3]), pk2(o[4], o[5]), pk2(o[6], o[7]));
        hbp[1] = make_uint4(pk2(o[8], o[9]), pk2(o[10], o[11]), pk2(o[12], o[13]), pk2(o[14], o[15]));
    }
}

__device__ __forceinline__ float pack_pl(float v, unsigned pl) { return __uint_as_float((__float_as_uint(v) & ~127u) | pl); }
__device__ __forceinline__ void ins16(float (&s)[16], float x) {
#pragma unroll
    for (int k = 15; k >= 1; --k) s[k] = __builtin_amdgcn_fmed3f(s[k - 1], x, s[k]);
    s[0] = fmaxf(s[0], x);
}
template <int D> __device__ __forceinline__ void bitonic_stage(float (&c)[16]) {
#pragma unroll
    for (int i = 0; i < 16; ++i) if ((i & D) == 0) { const float a = fmaxf(c[i], c[i + D]), b = fminf(c[i], c[i + D]); c[i] = a; c[i + D] = b; }
}
__device__ __forceinline__ int decode_key(unsigned pl) { return (int)(32u * ((pl >> 4) & 3u) + (pl & 3u) + 8u * ((pl >> 2) & 3u) + 4u * ((pl >> 6) & 1u)); }
__device__ void route_fast_phase(const bf16* qb, const bf16* skb  , int* eid, float* gate, unsigned char* lds) {
    const int tid = LTID(), lane = tid & 63, wave = tid >> 6, r32 = lane & 31, hi = lane >> 5;
    unsigned* lidx = (unsigned*)lds + wave * (64 * 33) + lane * 33;
    for (int unit = LBID() * NWAVE + wave; unit < (T_ / 32) * 8; unit += LGRID() * NWAVE) {
        const int h = unit & 7, t = (unit >> 3) * 32 + r32;
        float sl[2][16];
#pragma unroll
        for (int p = 0; p < 2; ++p) {
            bf16x8_t qf[4];
            { const bf16* qp = qb + (size_t)t * 1024 + h * 128 + p * 64 + 8 * hi;
#pragma unroll
              for (int ks = 0; ks < 4; ++ks) qf[ks] = *(const bf16x8_t*)(qp + 16 * ks); }
            float s[16];
#pragma unroll
            for (int k = 0; k < 16; ++k) s[k] = -INFINITY;
            const bf16* skp = skb + ((size_t)(h * 2 + p) * 128 + r32) * 64 + 8 * hi;
#pragma unroll
            for (int kt = 0; kt < 4; ++kt) {
                f32x16_t acc;
#pragma unroll
                for (int r = 0; r < 16; ++r) acc[r] = 0.f;
#pragma unroll
                for (int ks = 0; ks < 4; ++ks) { const bf16x8_t a = *(const bf16x8_t*)(skp + (size_t)kt * 32 * 64 + 16 * ks); acc = __builtin_amdgcn_mfma_f32_32x32x16_bf16(a, qf[ks], acc, 0, 0, 0); }
#pragma unroll
                for (int r = 0; r < 16; ++r) ins16(s, pack_pl(acc[r], (unsigned)(kt * 16 + r)));
            }
            const unsigned hb = (unsigned)hi << 6;
#pragma unroll
            for (int k = 0; k < 16; ++k) s[k] = __uint_as_float(__float_as_uint(s[k]) | hb);
            float c[16];
#pragma unroll
            for (int k = 0; k < 16; ++k) c[k] = fmaxf(s[k], __shfl_xor(s[15 - k], 32));
            bitonic_stage<8>(c); bitonic_stage<4>(c); bitonic_stage<2>(c); bitonic_stage<1>(c);
#pragma unroll
            for (int k = 0; k < 16; ++k) { sl[p][k] = c[k]; lidx[p * 16 + k] = (unsigned)decode_key(__float_as_uint(c[k]) & 127u); }
        }
        float w[16];
#pragma unroll
        for (int k = 0; k < 16; ++k) w[k] = -INFINITY;
#pragma unroll
        for (int i = 0; i < 16; ++i)
#pragma unroll
            for (int j = 0; j < 16; ++j)
                if ((i + 1) * (j + 1) <= 16) { const float v = sl[0][i] + sl[1][j]; ins16(w, __uint_as_float((__float_as_uint(v) & ~255u) | (unsigned)(i * 16 + j))); }
        float e[16], sum = 0.f;
#pragma unroll
        for (int k = 0; k < 16; ++k) { e[k] = expf(w[k] - w[0]); sum += e[k]; }
        const float inv = 1.0f / sum;
        int ide[8]; float gte[8];
#pragma unroll
        for (int k = 0; k < 8; ++k) {
            float wa = w[k], wb = w[8 + k], ea = e[k], eb = e[8 + k];
            asm volatile("" : "+v"(wa), "+v"(wb), "+v"(ea), "+v"(eb));
            const float wv = hi ? wb : wa;
            const unsigned pl = __float_as_uint(wv) & 255u;
            ide[k] = (int)(lidx[pl >> 4] * 128u + lidx[16 + (pl & 15u)]);
            gte[k] = (hi ? eb : ea) * inv;
        }
        int* ep = eid + (size_t)t * 128 + h * 16 + hi * 8; float* gp = gate + (size_t)t * 128 + h * 16 + hi * 8;
        *(int4*)ep = make_int4(ide[0], ide[1], ide[2], ide[3]); *(int4*)(ep + 4) = make_int4(ide[4], ide[5], ide[6], ide[7]);
        *(float4*)gp = make_float4(gte[0], gte[1], gte[2], gte[3]); *(float4*)(gp + 4) = make_float4(gte[4], gte[5], gte[6], gte[7]);
    }
}

typedef float f32x4_t __attribute__((ext_vector_type(4)));
__device__ void index_fast_phase(const bf16* P, unsigned char* mask, float* kmean, float* scratch_all, unsigned char* lds) {
    const int tid = LTID(), lane = tid & 63, wave = tid >> 6, bid = LBID(), G = LGRID();
    float* s_part = (float*)lds;
    for (int k = bid; k < 256; k += G) {
        const int b = k >> 6, h = (k >> 4) & 3, blk = k & 15;
        const bf16* kp = P + (size_t)(b * S_ + blk * 256 + wave * 32) * NP + C_KC + h * 64 + lane;
        float a = 0.f;
#pragma unroll 8
        for (int j = 0; j < 32; ++j) a += bf2f(kp[(size_t)j * NP]);
        __syncthreads();
        s_part[wave * 64 + lane] = a;
        __syncthreads();
        if (tid < 64) { float s = 0.f;
#pragma unroll
            for (int w = 0; w < 8; ++w) s += s_part[w * 64 + tid];
            kmean[((b * 4 + h) * 16 + blk) * 64 + tid] = s * (1.0f / 256.0f); }
    }
    float* scr = scratch_all + (size_t)bid * (16 * 4096);
    const int lq = lane & 15, g4 = lane >> 4;
    for (int ui = bid; ui < 1024; ui += G) {
        const int b = ui >> 8, k = ui & 255, tile = (b & 1) ? 255 - k : k, q0 = tile * 16;
        const bf16* Pb = P + (size_t)b * S_ * NP;
        const int ntiles = tile + 1;
        bf16x8_t qf[8]; float wi[8];
        { const bf16* qp = Pb + (size_t)(q0 + lq) * NP + C_QI + 8 * g4;
#pragma unroll
          for (int h = 0; h < 8; ++h) qf[h] = *(const bf16x8_t*)(qp + 32 * h);
          const uint4 wv = *(const uint4*)(Pb + (size_t)(q0 + lq) * NP + C_WI); unpack8(wv, wi); }
        for (int kt = wave; kt < ntiles; kt += NWAVE) {
            const bf16x8_t af = *(const bf16x8_t*)(Pb + (size_t)(kt * 16 + lq) * NP + C_KI + 8 * g4);
            f32x4_t sc = {0.f, 0.f, 0.f, 0.f};
#pragma unroll
            for (int h = 0; h < 8; ++h) {
                const f32x4_t z = {0.f, 0.f, 0.f, 0.f};
                const f32x4_t a = __builtin_amdgcn_mfma_f32_16x16x32_bf16(af, qf[h], z, 0, 0, 0);
#pragma unroll
                for (int r = 0; r < 4; ++r) sc[r] += fmaxf(a[r], 0.f) * wi[h];
            }
#pragma unroll
            for (int r = 0; r < 4; ++r) { sc[r] *= 0.0625f; if (sc[r] == 0.f) sc[r] = 0.f; }
            *(f32x4_t*)(scr + (size_t)lq * 4096 + kt * 16 + 4 * g4) = sc;
        }
        __threadfence_block();
        __syncthreads();
        __threadfence_block();
#pragma unroll 1
        for (int qi = 0; qi < 2; ++qi) {
            const int ql = 2 * wave + qi, q = q0 + ql;
            const float* row = scr + (size_t)ql * 4096;
            unsigned key[64];
#pragma unroll
            for (int j = 0; j < 64; ++j) {
                unsigned kk = 0u;
                if (j * 64 <= q) {
                    const float v = row[j * 64 + lane];
                    const unsigned u = __float_as_uint(v);
                    kk = (u & 0x80000000u) ? ~u : (u | 0x80000000u);
                    if (j * 64 + lane > q) kk = 0u;
                }
                key[j] = kk;
            }
            unsigned long long myword = 0ull;
            if (q + 1 > 256) {
                unsigned prefix = 0u;
#pragma unroll 1
                for (int bit = 31; bit >= 0; --bit) {
                    const unsigned cand = prefix | (1u << bit);
                    int cnt = 0;
#pragma unroll
                    for (int j = 0; j < 64; ++j) cnt += __popcll(__ballot(key[j] >= cand));
                    if (cnt >= 256) prefix = cand;
                }
                int cgt = 0;
#pragma unroll
                for (int j = 0; j < 64; ++j) cgt += __popcll(__ballot(key[j] > prefix));
                int need = 256 - cgt;
#pragma unroll
                for (int j = 0; j < 64; ++j) {
                    unsigned long long m = __ballot(key[j] == prefix);
                    int c = __popcll(m);
                    while (c > need) { m &= ~(1ull << (63 - __clzll((long long)m))); --c; }
                    need -= c;
                    const unsigned long long wj = __ballot(key[j] > prefix) | m;
                    if (lane == j) myword = wj;
                }
            } else {
#pragma unroll
                for (int j = 0; j < 4; ++j) { const unsigned long long wj = __ballot(j * 64 + lane <= q); if (lane == j) myword = wj; }
            }
            ((unsigned long long*)(mask + (size_t)(b * S_ + q) * 512))[lane] = myword;
        }
        __syncthreads();
    }
}

constexpr int MG_P = 72;
constexpr int MG_TILE_BYTES = 128 * MG_P * 2;
__device__ void merge_fast_phase(const bf16* P, const bf16* ys, const bf16* wbt  , bf16* merged, unsigned char* lds) {
    const int tid = LTID(), lane = tid & 63, wave = tid >> 6, r32 = lane & 31, hi = lane >> 5, wt = wave & 3, wd = wave >> 2;
    for (int tile = LBID(); tile < 1024; tile += LGRID()) {
        const int tok0 = (tile >> 3) * 128, d0 = (tile & 7) * 128;
        f32x16_t mer[2], acc[2];
#pragma unroll
        for (int r = 0; r < 16; ++r) { mer[0][r] = 0.f; mer[1][r] = 0.f; acc[0][r] = 0.f; acc[1][r] = 0.f; }
        const int srow0 = tid >> 3, sch = tid & 7;
        uint4 rw0, rw1, ry0, ry1;
#define MG_GLOAD(st_) do { const int n_ = (st_) >> 2, kc_ = (st_) & 3; \
            rw0 = *(const uint4*)(wbt + ((size_t)n_ * 1024 + d0 + srow0) * 256 + kc_ * 64 + sch * 8); \
            rw1 = *(const uint4*)(wbt + ((size_t)n_ * 1024 + d0 + srow0 + 64) * 256 + kc_ * 64 + sch * 8); \
            ry0 = *(const uint4*)(ys + (size_t)(tok0 + srow0) * 1024 + n_ * 256 + kc_ * 64 + sch * 8); \
            ry1 = *(const uint4*)(ys + (size_t)(tok0 + srow0 + 64) * 1024 + n_ * 256 + kc_ * 64 + sch * 8); } while (0)
#define MG_SSTORE(buf_) do { bf16* wl_ = (bf16*)(lds + (buf_) * 2 * MG_TILE_BYTES); bf16* yl_ = (bf16*)(lds + (buf_) * 2 * MG_TILE_BYTES + MG_TILE_BYTES); \
            *(uint4*)(wl_ + srow0 * MG_P + sch * 8) = rw0; *(uint4*)(wl_ + (srow0 + 64) * MG_P + sch * 8) = rw1; \
            *(uint4*)(yl_ + srow0 * MG_P + sch * 8) = ry0; *(uint4*)(yl_ + (srow0 + 64) * MG_P + sch * 8) = ry1; } while (0)
        __syncthreads();
        MG_GLOAD(0); MG_SSTORE(0);
        __syncthreads();
#pragma unroll 1
        for (int st = 0; st < 16; ++st) {
            const int buf = st & 1;
            if (st + 1 < 16) MG_GLOAD(st + 1);
            const bf16* wl = (const bf16*)(lds + buf * 2 * MG_TILE_BYTES); const bf16* yl = (const bf16*)(lds + buf * 2 * MG_TILE_BYTES + MG_TILE_BYTES);
#pragma unroll
            for (int ks = 0; ks < 4; ++ks) {
                const bf16x8_t bq = *(const bf16x8_t*)(yl + (32 * wt + r32) * MG_P + 16 * ks + 8 * hi);
                const bf16x8_t a0 = *(const bf16x8_t*)(wl + (64 * wd + r32) * MG_P + 16 * ks + 8 * hi);
                const bf16x8_t a1 = *(const bf16x8_t*)(wl + (64 * wd + 32 + r32) * MG_P + 16 * ks + 8 * hi);
                acc[0] = __builtin_amdgcn_mfma_f32_32x32x16_bf16(a0, bq, acc[0], 0, 0, 0);
                acc[1] = __builtin_amdgcn_mfma_f32_32x32x16_bf16(a1, bq, acc[1], 0, 0, 0);
            }
            if ((st & 3) == 3) {
                const int n = st >> 2;
                const bf16* gp = P + (size_t)(tok0 + 32 * wt + r32) * NP + C_G + n * 1024 + d0 + 64 * wd + 4 * hi;
#pragma unroll
                for (int dt = 0; dt < 2; ++dt)
#pragma unroll
                    for (int g = 0; g < 4; ++g) {
                        const uint2 gv = *(const uint2*)(gp + 32 * dt + 8 * g);
                        const float g0 = __uint_as_float(gv.x << 16), g1 = __uint_as_float(gv.x & 0xffff0000u), g2 = __uint_as_float(gv.y << 16), g3 = __uint_as_float(gv.y & 0xffff0000u);
                        mer[dt][4 * g + 0] += acc[dt][4 * g + 0] / (1.f + __expf(-g0)); mer[dt][4 * g + 1] += acc[dt][4 * g + 1] / (1.f + __expf(-g1));
                        mer[dt][4 * g + 2] += acc[dt][4 * g + 2] / (1.f + __expf(-g2)); mer[dt][4 * g + 3] += acc[dt][4 * g + 3] / (1.f + __expf(-g3));
                    }
#pragma unroll
                for (int r = 0; r < 16; ++r) { acc[0][r] = 0.f; acc[1][r] = 0.f; }
            }
            if (st + 1 < 16) MG_SSTORE(buf ^ 1);
            __syncthreads();
        }
        bf16* mp = merged + (size_t)(tok0 + 32 * wt + r32) * 1024 + d0 + 64 * wd + 4 * hi;
#pragma unroll
        for (int dt = 0; dt < 2; ++dt)
#pragma unroll
            for (int g = 0; g < 4; ++g)
                *(uint2*)(mp + 32 * dt + 8 * g) = make_uint2(cvtpk(mer[dt][4 * g], mer[dt][4 * g + 1]), cvtpk(mer[dt][4 * g + 2], mer[dt][4 * g + 3]));
    }
}
#define LAS __attribute__((address_space(3)))
#define XB_TMO      128
#define XB_XCNT(j)  (256  + 64 * (j))
#define XB_XSUB(j)  (1280 + 64 * (j))
#define XB_XGEN(j)  (2304 + 64 * (j))
#define XB_TOP      3328
#define XB_TOPGEN   3392
#define XCD_BAR_WORDS 3456
#define XB_SPIN_CAP (1u << 18)

__device__ __forceinline__ unsigned xb_ld(unsigned* p)              { return __hip_atomic_load(p, __ATOMIC_RELAXED, __HIP_MEMORY_SCOPE_AGENT); }
__device__ __forceinline__ unsigned xb_add(unsigned* p, unsigned v) { return __hip_atomic_fetch_add(p, v, __ATOMIC_RELAXED, __HIP_MEMORY_SCOPE_AGENT); }
__device__ __forceinline__ unsigned xb_xcc_id() { return (unsigned)__builtin_amdgcn_s_getreg((3 << 11) | 20) & 0xFu; }
#define XB_SPIN(cond, bar) do { unsigned _sp = 0; while (cond) { __builtin_amdgcn_s_sleep(1); \
    if ((++_sp & 255u) == 0u) { if (xb_ld(&(bar)[XB_TMO])) break; if (_sp > XB_SPIN_CAP) { atomicAdd(&(bar)[XB_TMO], 1u); break; } } } } while (0)

struct XcdBarrier {
    unsigned* bar; unsigned x;
    volatile LAS unsigned* st;
};

__device__ __forceinline__ XcdBarrier xcd_barrier_post(unsigned* bar, volatile LAS unsigned* st) {
    XcdBarrier b; b.bar = bar; b.x = xb_xcc_id(); b.st = st;
    if (threadIdx.x == 0) (void)xb_add(&bar[XB_XCNT(b.x)], 1u);
    return b;
}
__device__ __forceinline__ void xcd_barrier_complete(unsigned* bar, unsigned x, unsigned& nloc, unsigned& nx) {
    const unsigned G = gridDim.x * gridDim.y * gridDim.z;
    unsigned sum, cnt, mine, sp = 0u;
    for (;;) {
        sum = 0u; cnt = 0u; mine = 0u;
#pragma unroll
        for (unsigned j = 0; j < 16; ++j) { const unsigned c = xb_ld(&bar[XB_XCNT(j)]); sum += c; cnt += (c > 0u) ? 1u : 0u; mine = (j == x) ? c : mine; }
        if (sum == G) break;
        __builtin_amdgcn_s_sleep(1);
        if ((++sp & 255u) == 0u) { if (xb_ld(&bar[XB_TMO])) break; if (sp > XB_SPIN_CAP) { atomicAdd(&bar[XB_TMO], 1u); break; } }
    }
    nloc = mine > 0u ? mine : 1u; nx = cnt > 0u ? cnt : 1u;
}

__device__ __forceinline__ void xcd_barrier(const XcdBarrier& b) {
    asm volatile("s_waitcnt vmcnt(0)" ::: "memory");
    __syncthreads();
    if (threadIdx.x == 0) {
        unsigned* bar = b.bar;
        __builtin_amdgcn_s_waitcnt(0);
        unsigned nloc = b.st[0], nx = b.st[1];
        if (nloc == 0u) { xcd_barrier_complete(bar, b.x, nloc, nx); b.st[0] = nloc; b.st[1] = nx; }
        const unsigned old = xb_add(&bar[XB_XSUB(b.x)], 1u);
        const unsigned gen = old / nloc;
        if (old + 1u == (gen + 1u) * nloc) {
            __builtin_amdgcn_fence(__ATOMIC_RELEASE, "agent");
            asm volatile("s_waitcnt vmcnt(0)" ::: "memory");
            const unsigned og = xb_add(&bar[XB_TOP], 1u);
            const unsigned tg = og / nx;
            if (og + 1u == (tg + 1u) * nx) xb_add(&bar[XB_TOPGEN], 1u);
            else XB_SPIN(xb_ld(&bar[XB_TOPGEN]) == tg, bar);
            __builtin_amdgcn_fence(__ATOMIC_ACQUIRE, "agent");
            xb_add(&bar[XB_XGEN(b.x)], 1u);
            asm volatile("s_waitcnt vmcnt(0)" ::: "memory");
        } else {
            XB_SPIN(xb_ld(&bar[XB_XGEN(b.x)]) == gen, bar);
            __builtin_amdgcn_fence(__ATOMIC_ACQUIRE, "agent");
            asm volatile("s_waitcnt vmcnt(0)" ::: "memory");
        }
    }
    __syncthreads();
}

enum { PH_PRO = 0, PH_GIN, PH_INDEX, PH_ATTN, PH_MERGE, PH_GOUT, PH_LN1, PH_GQ, PH_ROUTE, PH_PEER };
template <int PH> __device__ __forceinline__ void run_phase(const Params& p, int l, unsigned char* lds_raw) {
    float* sm = (float*)lds_raw;
    unsigned char* ws = p.ws; asm volatile("" : "+s"(ws));
    float* hbuf = p.out;
    bf16* hb = (bf16*)(ws + WS_HB);
    bf16* P = (bf16*)(ws + WS_P);
    bf16* ys = (bf16*)(ws + WS_YS);
    bf16* mrg = (bf16*)(ws + WS_MRG);
    float* mix = (float*)(ws + WS_MIX);
    float* qb = (float*)(ws + WS_Q);
    unsigned char* mask = ws + WS_MASK;
    int* eid = (int*)(ws + WS_EID);
    float* gate = (float*)(ws + WS_GATE);
    float* kmean = (float*)(ws + WS_KMEAN);
    const float* hin = (l == 0) ? p.in[0] : hbuf;
    if (PH == PH_PRO) { prologue_phase(p, sm); convert_tables(p);
        for (int i = LBID() * NTHR + LTID(); i < DEPTH_ * 8 * 2 * 128 * 64 / 4; i += LGRID() * NTHR) { const float4 v = ((const float4*)p.in[8])[i]; ((uint2*)(ws + WS_SKB))[i] = make_uint2(pk2(v.x, v.y), pk2(v.z, v.w)); } if (LBID() < 2) build_unit_table((unsigned*)(ws + WS_CTL) + 1024, LBID() * NTHR + LTID()); }
    else if (PH == PH_GIN) {
        pg8::Gemm g{hb, (const bf16*)(ws + WS_WIN_T + l * WIN_T_BYTES), T_, NP, 1024};
        pg8::StaticOrder S; S.init(T_, NP, (int)LGRID(), (int)LBID());
        pg8::EpiBf16<0> E{P, NP, nullptr, 0, 0, 1.f};
        pg8::gemm_phase<pg8::EpiBf16<0>, pg8::StaticOrder, true, true>((PG8_LAS unsigned char*)lds_raw, g, S, E);
    }
    else if (PH == PH_INDEX) index_fast_phase(P, mask, kmean, (float*)(ws + WS_YS), lds_raw);
    else if (PH == PH_ATTN) attn_fast_phase(P, mask, kmean, p.in[4] + l * 4, ys, (const unsigned*)(ws + WS_CTL) + 1024, (unsigned*)(ws + WS_CTL) + 64 * l, lds_raw);
    else if (PH == PH_MERGE) merge_fast_phase(P, ys, (const bf16*)(ws + WS_WBR_T) + (size_t)l * 4 * 1024 * 256, mrg, lds_raw);
    else if (PH == PH_GOUT) {
        pg8::Gemm g{mrg, (const bf16*)(ws + WS_WOUT_T) + (size_t)l * 1024 * 1024, T_, 1024, 1024};
        pg8::StaticOrder S; S.init(T_, 1024, (int)LGRID(), (int)LBID());
        pg8::EpiF32 E{mix, 1024};
        pg8::gemm_phase<pg8::EpiF32, pg8::StaticOrder, true, true>((PG8_LAS unsigned char*)lds_raw, g, S, E);
    }
    else if (PH == PH_LN1) ln1_phase(hin, mix, p.in[5] + l * 1024, p.in[6] + l * 1024, hbuf, hb);
    else if (PH == PH_GQ) {
        pg8::Gemm g{hb, (const bf16*)(ws + WS_WQ_T) + (size_t)l * 1024 * 1024, T_, 1024, 1024};
        pg8::StaticOrder S; S.init(T_, 1024, (int)LGRID(), (int)LBID());
        pg8::EpiBf16<0> E{(bf16*)qb, 1024, nullptr, 0, 0, 1.f};
        pg8::gemm_phase<pg8::EpiBf16<0>, pg8::StaticOrder, true, true>((PG8_LAS unsigned char*)lds_raw, g, S, E);
    }
    else if (PH == PH_ROUTE) route_fast_phase((const bf16*)qb, (const bf16*)(ws + WS_SKB) + (size_t)l * 8 * 2 * 128 * 64, eid, gate, lds_raw);
    else peer_fast_phase(hbuf, hb, eid, gate, ws + WS_UV + (size_t)l * 32 * MiB, p.in[11] + l * 1024, p.in[12] + l * 1024, lds_raw);
}

constexpr int CW_BAR = 4096;
constexpr int LDS_BARST = LDS_BYTES - 16;
__global__ void __launch_bounds__(NTHR, 2) mk_fwd(Params p) {
    extern __shared__ __attribute__((aligned(16))) unsigned char lds_raw[];
    cg::grid_group grid = cg::this_grid();
    volatile LAS unsigned* bst = (volatile LAS unsigned*)((LAS unsigned char*)lds_raw + LDS_BARST);
    if (threadIdx.x < 4) bst[threadIdx.x] = 0u;
    __syncthreads();
    XcdBarrier bar = xcd_barrier_post((unsigned*)(p.ws + WS_CTL) + CW_BAR, bst);
    run_phase<PH_PRO>(p, 0, lds_raw);
    grid.sync();
#pragma unroll 1
    for (int l = 0; l < DEPTH_; ++l) {
        run_phase<PH_GIN>(p, l, lds_raw); xcd_barrier(bar);
        run_phase<PH_INDEX>(p, l, lds_raw); xcd_barrier(bar);
        run_phase<PH_ATTN>(p, l, lds_raw); xcd_barrier(bar);
        run_phase<PH_MERGE>(p, l, lds_raw); xcd_barrier(bar);
        run_phase<PH_GOUT>(p, l, lds_raw); xcd_barrier(bar);
        run_phase<PH_LN1>(p, l, lds_raw); xcd_barrier(bar);
        run_phase<PH_GQ>(p, l, lds_raw); xcd_barrier(bar);
        run_phase<PH_ROUTE>(p, l, lds_raw); xcd_barrier(bar);
        run_phase<PH_PEER>(p, l, lds_raw); if (l + 1 < DEPTH_) xcd_barrier(bar);
    }
}

extern "C" void kernel_launch(void* const* d_in, const int* in_sizes, int n_in, void* d_out, int out_size, void* d_ws, size_t ws_size, hipStream_t stream) {
    if (n_in != 13 || ws_size < WS_END) { fprintf(stderr, "kernel_launch: unexpected n_in %d / ws_size %zu; nothing launched\n", n_in, ws_size); return; }
    static int grid_blocks = 0;
    if (grid_blocks == 0) {
        int dev = 0, cus = 0, per_cu = 0;
        (void)hipGetDevice(&dev);
        (void)hipDeviceGetAttribute(&cus, hipDeviceAttributeMultiprocessorCount, dev);
        (void)hipFuncSetAttribute((const void*)mk_fwd, hipFuncAttributeMaxDynamicSharedMemorySize, LDS_BYTES);
        (void)hipOccupancyMaxActiveBlocksPerMultiprocessor(&per_cu, (const void*)mk_fwd, NTHR, LDS_BYTES);
        if (per_cu < 1) fprintf(stderr, "kernel_launch: occupancy query reports %d\n", per_cu);
        grid_blocks = cus;
    }
    Params p{};
    for (int i = 0; i < 13; ++i) p.in[i] = (const float*)d_in[i];
    p.out = (float*)d_out; p.ws = (unsigned char*)d_ws;
    (void)hipMemsetAsync(d_ws, 0, 65536, stream);
    void* args[] = {&p};
    hipError_t e = hipLaunchCooperativeKernel((const void*)mk_fwd, dim3(grid_blocks), dim3(NTHR), args, LDS_BYTES, stream);
    if (e != hipSuccess) fprintf(stderr, "cooperative launch failed: %s (grid %d)\n", hipGetErrorString(e), grid_blocks);
}
```

```cpp
#include <hip/hip_runtime.h>
#include <cstdio>
#include <cstdint>
#include <hip/hip_cooperative_groups.h>
namespace cg = cooperative_groups;

__device__ __forceinline__ int LANEID() { int l; asm volatile("v_mbcnt_lo_u32_b32 %0, -1, 0\n\tv_mbcnt_hi_u32_b32 %0, -1, %0" : "=v"(l)); return l; }
__device__ __forceinline__ int LTID(int wv) { return (wv << 6) | LANEID(); }
__device__ __forceinline__ int LBID() { int t = blockIdx.x; asm volatile("" : "+s"(t)); return t; }
__device__ __forceinline__ int LGRID() { int t = gridDim.x; asm volatile("" : "+s"(t)); return t; }
namespace pg8 {
#define PG8_LAS __attribute__((address_space(3)))
typedef unsigned short bf16_t;
typedef short bf16x8 __attribute__((ext_vector_type(8)));
typedef float f32x4 __attribute__((ext_vector_type(4)));
typedef unsigned u32x4 __attribute__((ext_vector_type(4)));
constexpr int BM = 256, BK = 64, HALF = 128, HTB = HALF * BK * 2  , STAGE_BYTES = 8 * HTB, NXCD = 8, WGM = 8;

__host__ __device__ __forceinline__ int lds_byte(int r, int c) { const int st = (r >> 4) * 2 + (c >> 5), rr = r & 15, cc = c & 31, ob = rr * 64 + cc * 2; return st * 1024 + (ob ^ (((ob >> 9) & 1) << 5)); }
__host__ __device__ __forceinline__ void stage_rc(int b, int& R, int& C) { const int st = b / 1024, sb = b % 1024, swz = sb ^ (((sb >> 9) & 1) << 5); R = (st >> 1) * 16 + swz / 64; C = (st & 1) * 32 + (swz % 64) / 2; }
__host__ __device__ __forceinline__ int perm32(int rho) { const int n = rho >> 4, i = rho & 15; return 8 * (i >> 2) + 4 * n + (i & 3); }

struct Unit { int pm, pn; };
struct Gemm { const bf16_t* A; const bf16_t* Bt; int M, N, K; };

struct StaticOrder {
    int nM, nN, nwg, G, c;
    __host__ __device__ void init(int M, int N, int G_, int c_) { nM = M / BM; nN = N / BM; nwg = nM * nN; G = G_; c = c_; }
    __host__ __device__ bool next(int i, Unit& u) const {
        const long L = (long)i * G + c; if (L >= nwg) return false;
        int wgid = (int)L; { const int q = nwg / NXCD, r = nwg % NXCD, xcd = wgid % NXCD, off = wgid / NXCD; wgid = (xcd < r ? xcd * (q + 1) : r * (q + 1) + (xcd - r) * q) + off; }
        const int nig = WGM * nN, gid = wgid / nig, fm = gid * WGM, gsz = (nM - fm) < WGM ? (nM - fm) : WGM;
        u.pm = fm + ((wgid % nig) % gsz); u.pn = (wgid % nig) / gsz; return true;
    }
    __device__ __forceinline__ void a_ready(const Unit&) const {}
    __device__ __forceinline__ void done(const Unit&) const {}
};

__device__ __forceinline__ unsigned cvt_pk_bf16(float lo, float hi) { unsigned r; asm volatile("v_cvt_pk_bf16_f32 %0, %1, %2" : "=v"(r) : "v"(lo), "v"(hi)); return r; }
typedef float f32x2 __attribute__((ext_vector_type(2)));
__device__ __forceinline__ f32x2 gelu_pk(f32x2 v) {
    const f32x2 av = __builtin_elementwise_abs(v), d = av * 0.2316418882f + 1.0f;
    f32x2 t; t.x = __builtin_amdgcn_rcpf(d.x); t.y = __builtin_amdgcn_rcpf(d.y);
    f32x2 q = t * 0.5307027145f + (-0.7265760135f); q = q * t + 0.7107068705f; q = q * t + (-0.142248368f); q = q * t + 0.127414796f; q = q * t;
    const f32x2 s = (v * v) * (-0.72134752044f);
    f32x2 e; e.x = __builtin_amdgcn_exp2f(s.x); e.y = __builtin_amdgcn_exp2f(s.y);
    const f32x2 m = v * (q * e), r = v - m;
    f32x2 o; o.x = v.x < 0.f ? m.x : r.x; o.y = v.y < 0.f ? m.y : r.y; return o;
}

template <int ACT  > struct EpiBf16 {
    static constexpr bool PERM = true, AFTER_DRAIN = false; static_assert(ACT == 0 || ACT == 1, "EpiBf16: ACT is 0 (none) or 1 (gelu_pk)");
    bf16_t* O; int ldc; const float* bias; int split_cols; size_t split_stride; float scale0;
    __device__ __forceinline__ void operator()(const f32x4 (&acc)[2][2][4][2], const Unit& u, int wr, int wc, int fr, int fq) const {
        { int ln_ = LANEID(); asm volatile("" : "+v"(ln_)); fr = ln_ & 15; fq = ln_ >> 4; }
        const int row0 = u.pm * BM + wr * 64 + fr; int colt = u.pn * BM; bf16_t* base = O;
        float sc = 1.f; if (split_cols) { const int t = colt / split_cols; base += (size_t)t * split_stride; colt -= t * split_cols; if (t == 0) sc = scale0; }
        const int col0 = colt + wc * 32 + 8 * fq, bcol0 = u.pn * BM + wc * 32 + 8 * fq;
        f32x4 bv[2][2];
#pragma unroll
        for (int bj = 0; bj < 2; ++bj)
#pragma unroll
            for (int n = 0; n < 2; ++n) bv[bj][n] = bias ? *(const f32x4*)(bias + bcol0 + bj * HALF + 4 * n) : (f32x4){0.f, 0.f, 0.f, 0.f};
#pragma unroll
        for (int ai = 0; ai < 2; ++ai)
#pragma unroll
            for (int m = 0; m < 4; ++m) { bf16_t* rowp = base + (size_t)(row0 + ai * HALF + m * 16) * ldc + col0;
#pragma unroll
                for (int bj = 0; bj < 2; ++bj) { f32x4 v0 = acc[ai][bj][m][0] + bv[bj][0], v1 = acc[ai][bj][m][1] + bv[bj][1];
                    if (ACT == 1) { f32x2 a = gelu_pk((f32x2){v0[0], v0[1]}), b = gelu_pk((f32x2){v0[2], v0[3]}), c = gelu_pk((f32x2){v1[0], v1[1]}), d = gelu_pk((f32x2){v1[2], v1[3]});
                        v0 = (f32x4){a.x, a.y, b.x, b.y}; v1 = (f32x4){c.x, c.y, d.x, d.y}; }
                    v0 = v0 * sc; v1 = v1 * sc; u32x4 w; w.x = cvt_pk_bf16(v0[0], v0[1]); w.y = cvt_pk_bf16(v0[2], v0[3]); w.z = cvt_pk_bf16(v1[0], v1[1]); w.w = cvt_pk_bf16(v1[2], v1[3]);
                    *(u32x4*)(rowp + bj * HALF) = w; } }
    }
};
template <class Epi, class Sched, bool ALIGN_EPI = false, bool SP2 = false>
__device__ __forceinline__ void gemm_phase(int WV_, PG8_LAS unsigned char* lds, const Gemm g, const Sched& S, const Epi& E) {
    const int tid = LTID(WV_), wid = __builtin_amdgcn_readfirstlane(tid >> 6), lane = tid & 63, wr = wid >> 2, wc = wid & 3, fr = lane & 15, fq = lane >> 4;
    const int K = g.K, nt = K / BK;
    unsigned voffA[2], voffB[2];
#pragma unroll
    for (int i = 0; i < 2; ++i) { int R, C; stage_rc(tid * 16 + i * 8192, R, C); const int Rb = Epi::PERM ? ((R & ~31) + perm32(R & 31)) : R;
        voffA[i] = (unsigned)(R * K + C) * 2u; voffB[i] = (unsigned)(Rb * K + C) * 2u; }
    const size_t kstep = (size_t)(BK * 2);
    const size_t hstep = (size_t)HALF * K * 2;
    const size_t tstep = 2 * hstep;
    const unsigned ldsw = (unsigned)wid * 1024u;
    const int aoff = lds_byte(wr * 64 + fr, fq * 8), boff = lds_byte(wc * 32 + fr, fq * 8);
#define PG8_SA(b, h) (((b) * 2 + (h)) * HTB)
#define PG8_SB(b, h) ((4 + (b) * 2 + (h)) * HTB)
#define PG8_STAGE(bufoff, gbase, voff) do { _Pragma("unroll") for (int _i = 0; _i < 2; ++_i) \
        __builtin_amdgcn_global_load_lds((const unsigned*)((const char*)(gbase) + (voff)[_i]), (PG8_LAS unsigned*)(lds + (bufoff) + ldsw + _i * 8192), 16, 0, 0); } while (0)
#define PG8_LDA(dst, b, h) do { _Pragma("unroll") for (int m = 0; m < 4; ++m) _Pragma("unroll") for (int k = 0; k < 2; ++k) dst[m][k] = *(const PG8_LAS bf16x8*)(lds + PG8_SA(b, h) + aoff + m * 2048 + k * 1024); } while (0)
#define PG8_LDB(dst, b, h) do { _Pragma("unroll") for (int n = 0; n < 2; ++n) _Pragma("unroll") for (int k = 0; k < 2; ++k) dst[n][k] = *(const PG8_LAS bf16x8*)(lds + PG8_SB(b, h) + boff + n * 2048 + k * 1024); } while (0)
#define PG8_MMA(ai, bj, At, Bt) do { __builtin_amdgcn_s_setprio(1); _Pragma("unroll") for (int m = 0; m < 4; ++m) _Pragma("unroll") for (int n = 0; n < 2; ++n) _Pragma("unroll") for (int k = 0; k < 2; ++k) \
        acc[ai][bj][m][n] = __builtin_amdgcn_mfma_f32_16x16x32_bf16(Bt[n][k], At[m][k], acc[ai][bj][m][n], 0, 0, 0); __builtin_amdgcn_s_setprio(0); } while (0)
#define PG8_WAIT_V(n) asm volatile("s_waitcnt vmcnt(" #n ")" ::: "memory")
#define PG8_WAIT_L(n) asm volatile("s_waitcnt lgkmcnt(" #n ")" ::: "memory")
#define PG8_BAR __builtin_amdgcn_s_barrier()
#define PG8_SCHED __builtin_amdgcn_sched_barrier(0)
    Unit cur, nxt; int ui = 0;
    if (!S.next(0, cur)) return;
    f32x4 acc[2][2][4][2];
#pragma unroll
    for (int a = 0; a < 2; ++a)
#pragma unroll
        for (int b = 0; b < 2; ++b)
#pragma unroll
            for (int m = 0; m < 4; ++m)
#pragma unroll
                for (int n = 0; n < 2; ++n) acc[a][b][m][n] = (f32x4){0.f, 0.f, 0.f, 0.f};
    bf16x8 At[4][2], B0[2][2], B1[2][2];
    const char* cA = (const char*)g.A + (size_t)cur.pm * tstep; const char* cB = (const char*)g.Bt + (size_t)cur.pn * tstep;
    S.a_ready(cur);
    if constexpr (SP2) {
        PG8_STAGE(PG8_SB(0, 0), cB, voffB); PG8_STAGE(PG8_SB(0, 1), cB + hstep, voffB); PG8_STAGE(PG8_SA(0, 0), cA, voffA); PG8_STAGE(PG8_SA(0, 1), cA + hstep, voffA);
        if (wr == 1) PG8_BAR;
        PG8_WAIT_V(2); PG8_BAR;
        PG8_STAGE(PG8_SB(1, 0), cB + kstep, voffB); PG8_STAGE(PG8_SA(1, 0), cA + kstep, voffA); PG8_STAGE(PG8_SB(1, 1), cB + hstep + kstep, voffB);
        PG8_WAIT_V(6); PG8_BAR;
    } else {
        PG8_STAGE(PG8_SB(0, 0), cB, voffB); PG8_STAGE(PG8_SA(0, 0), cA, voffA); PG8_STAGE(PG8_SB(0, 1), cB + hstep, voffB); PG8_STAGE(PG8_SA(0, 1), cA + hstep, voffA);
        if (wr == 1) PG8_BAR;
        PG8_WAIT_V(4); PG8_BAR;
        PG8_STAGE(PG8_SB(1, 0), cB + kstep, voffB); PG8_STAGE(PG8_SA(1, 0), cA + kstep, voffA); PG8_STAGE(PG8_SB(1, 1), cB + hstep + kstep, voffB);
        PG8_WAIT_V(6); PG8_BAR;
    }
    for (;;) {
        const bool has_next = S.next(ui + 1, nxt);
        const char* nA = has_next ? (const char*)g.A + (size_t)nxt.pm * tstep : cA; const char* nB = has_next ? (const char*)g.Bt + (size_t)nxt.pn * tstep : cB;
        for (int t = 0; t < nt; t += 2) {
            const bool last = (t == nt - 2);
            const char* a1 = cA + (size_t)(t + 1) * kstep;
            const char* a2 = last ? nA : cA + (size_t)(t + 2) * kstep; const char* b2 = last ? nB : cB + (size_t)(t + 2) * kstep;
            const char* a3 = a2 + kstep; const char* b3 = b2 + kstep;
            if (last && has_next) S.a_ready(nxt);
            if constexpr (SP2) {
            PG8_LDB(B0, 0, 0); PG8_LDB(B1, 0, 1); PG8_SCHED; PG8_LDA(At, 0, 0); PG8_STAGE(PG8_SA(1, 1), a1 + hstep, voffA);
            PG8_WAIT_V(8); PG8_WAIT_L(0); PG8_BAR; PG8_MMA(0, 0, At, B0); PG8_MMA(0, 1, At, B1); PG8_BAR; PG8_SCHED;
            PG8_LDA(At, 0, 1); PG8_STAGE(PG8_SB(0, 0), b2, voffB); PG8_STAGE(PG8_SB(0, 1), b2 + hstep, voffB); PG8_STAGE(PG8_SA(0, 0), a2, voffA);
            PG8_WAIT_V(8); PG8_WAIT_L(0); PG8_BAR; PG8_MMA(1, 0, At, B0); PG8_MMA(1, 1, At, B1); PG8_BAR; PG8_SCHED;
            PG8_LDB(B0, 1, 0); PG8_LDB(B1, 1, 1); PG8_SCHED; PG8_LDA(At, 1, 0); PG8_STAGE(PG8_SA(0, 1), a2 + hstep, voffA);
            PG8_WAIT_V(8); PG8_WAIT_L(0); PG8_BAR; PG8_MMA(0, 0, At, B0); PG8_MMA(0, 1, At, B1); PG8_BAR; PG8_SCHED;
            PG8_LDA(At, 1, 1); PG8_STAGE(PG8_SB(1, 0), b3, voffB); PG8_STAGE(PG8_SB(1, 1), b3 + hstep, voffB); PG8_STAGE(PG8_SA(1, 0), a3, voffA);
            PG8_WAIT_V(8); PG8_WAIT_L(0); PG8_BAR; PG8_MMA(1, 0, At, B0); PG8_MMA(1, 1, At, B1); PG8_BAR; PG8_SCHED;
            } else {
            PG8_LDB(B0, 0, 0); PG8_SCHED; PG8_LDA(At, 0, 0); PG8_STAGE(PG8_SA(1, 1), a1 + hstep, voffA);
            PG8_WAIT_L(8); PG8_BAR; PG8_WAIT_L(0); PG8_MMA(0, 0, At, B0); PG8_BAR; PG8_SCHED;
            PG8_LDB(B1, 0, 1); PG8_STAGE(PG8_SB(0, 0), b2, voffB);
            PG8_BAR; PG8_WAIT_L(0); PG8_MMA(0, 1, At, B1); PG8_BAR;
            PG8_LDA(At, 0, 1); PG8_STAGE(PG8_SA(0, 0), a2, voffA);
            PG8_BAR; PG8_WAIT_L(0); PG8_MMA(1, 0, At, B0); PG8_BAR; PG8_SCHED;
            PG8_STAGE(PG8_SB(0, 1), b2 + hstep, voffB);
            PG8_WAIT_V(6); PG8_BAR; PG8_MMA(1, 1, At, B1); PG8_BAR;
            PG8_LDB(B0, 1, 0); PG8_SCHED; PG8_LDA(At, 1, 0); PG8_STAGE(PG8_SA(0, 1), a2 + hstep, voffA);
            PG8_WAIT_L(8); PG8_BAR; PG8_WAIT_L(0); PG8_MMA(0, 0, At, B0); PG8_BAR; PG8_SCHED;
            PG8_LDB(B1, 1, 1); PG8_STAGE(PG8_SB(1, 0), b3, voffB);
            PG8_BAR; PG8_WAIT_L(0); PG8_MMA(0, 1, At, B1); PG8_BAR;
            PG8_LDA(At, 1, 1); PG8_STAGE(PG8_SA(1, 0), a3, voffA);
            PG8_BAR; PG8_WAIT_L(0); PG8_MMA(1, 0, At, B0); PG8_BAR; PG8_SCHED;
            PG8_STAGE(PG8_SB(1, 1), b3 + hstep, voffB);
            PG8_WAIT_V(6); PG8_BAR; PG8_MMA(1, 1, At, B1); PG8_BAR;
            }
        }
        if constexpr (ALIGN_EPI) { if (wr == 0) PG8_BAR; }
        if constexpr (!Epi::AFTER_DRAIN) { E(acc, cur, wr, wc, fr, fq); S.done(cur); }
        if (!has_next) break;
#pragma unroll
        for (int a = 0; a < 2; ++a)
#pragma unroll
            for (int b = 0; b < 2; ++b)
#pragma unroll
                for (int m = 0; m < 4; ++m)
#pragma unroll
                    for (int n = 0; n < 2; ++n) acc[a][b][m][n] = (f32x4){0.f, 0.f, 0.f, 0.f};
        cur = nxt; cA = nA; cB = nB; ++ui;
        if constexpr (ALIGN_EPI) { if (wr == 1) PG8_BAR; }
    }
    PG8_WAIT_V(0);
    if constexpr (!ALIGN_EPI) { if (wr == 0) PG8_BAR; }
    PG8_BAR;
    if constexpr (Epi::AFTER_DRAIN) { E.fused(acc, cur, wr, wc, fr, fq, lds, wid, lane); S.done(cur); }
#undef PG8_SA
#undef PG8_SB
#undef PG8_STAGE
#undef PG8_LDA
#undef PG8_LDB
#undef PG8_MMA
#undef PG8_WAIT_V
#undef PG8_WAIT_L
#undef PG8_BAR
#undef PG8_SCHED
}
}
namespace pg8 {
struct EpiF32 {
    static constexpr bool PERM = false, AFTER_DRAIN = false;
    float* O; int ldc;
    __device__ __forceinline__ void operator()(const f32x4 (&acc)[2][2][4][2], const Unit& u, int wr, int wc, int fr, int fq) const {
        { int ln_ = LANEID(); asm volatile("" : "+v"(ln_)); fr = ln_ & 15; fq = ln_ >> 4; }
        const int row0 = u.pm * BM + wr * 64 + fr, col0 = u.pn * BM + wc * 32 + 4 * fq;
#pragma unroll
        for (int ai = 0; ai < 2; ++ai)
#pragma unroll
            for (int m = 0; m < 4; ++m) { float* rowp = O + (size_t)(row0 + ai * HALF + m * 16) * ldc + col0;
#pragma unroll
                for (int bj = 0; bj < 2; ++bj)
#pragma unroll
                    for (int n = 0; n < 2; ++n) *(f32x4*)(rowp + bj * HALF + n * 16) = acc[ai][bj][m][n]; }
    }
};
}

typedef unsigned short bf16;
constexpr int T_ = 16384, S_ = 4096, NBATCH = 4, D_ = 1024, NCOL = 6824, NP = 6912, DEPTH_ = 2;
constexpr int C_QA = 0, C_KA = 256, C_VA = 320, C_QI = 384, C_KI = 640, C_WI = 672, C_QB = 680, C_KB = 936, C_VB = 1064,
              C_QC = 1192, C_KC = 1448, C_VC = 1704, C_QD = 1960, C_KD = 2216, C_VD = 2472, C_G = 2728;
constexpr int NTHR = 512, NWAVE = 8;
constexpr float ALPHA = 1.41421356237309515f;
constexpr float LN_EPS = 1e-5f;
constexpr size_t MiB = 1u << 20;
constexpr size_t WS_CTL = 0, WS_WIN_T = 2 * MiB, WS_WOUT_T = 30 * MiB, WS_WQ_T = 34 * MiB, WS_WBR_T = 38 * MiB, WS_HB = 42 * MiB,
                 WS_P = 74 * MiB, WS_MIX = 74 * MiB  , WS_Q = 138 * MiB  , WS_YS = 290 * MiB, WS_MRG = 322 * MiB,
                 WS_MASK = 354 * MiB, WS_EID = 362 * MiB, WS_GATE = 370 * MiB, WS_KMEAN = 378 * MiB, WS_SKB = 379 * MiB, WS_UV = 380 * MiB, WS_END = 508 * MiB;
constexpr size_t WIN_T_BYTES = (size_t)NP * 1024 * 2;
constexpr int LDS_BYTES = 144 * 1024;

struct Params { const float* in[13]; float* out; unsigned char* ws; };

__device__ __forceinline__ float bf2f(bf16 v) { return __uint_as_float((unsigned)v << 16); }
__device__ __forceinline__ unsigned f2bf(float f) { unsigned u = __float_as_uint(f); return (u + 0x7fffu + ((u >> 16) & 1u)) >> 16; }
__device__ __forceinline__ unsigned pk2(float lo, float hi) { return f2bf(lo) | (f2bf(hi) << 16); }
__device__ __forceinline__ void unpack8(const uint4 v, float* o) {
    o[0] = __uint_as_float(v.x << 16); o[1] = __uint_as_float(v.x & 0xffff0000u); o[2] = __uint_as_float(v.y << 16); o[3] = __uint_as_float(v.y & 0xffff0000u);
    o[4] = __uint_as_float(v.z << 16); o[5] = __uint_as_float(v.z & 0xffff0000u); o[6] = __uint_as_float(v.w << 16); o[7] = __uint_as_float(v.w & 0xffff0000u);
}
__device__ __forceinline__ float wave_sum(float v) {
#pragma unroll
    for (int o = 32; o > 0; o >>= 1) v += __shfl_xor(v, o);
    return v;
}
__device__ __forceinline__ float wave_max(float v) {
#pragma unroll
    for (int o = 32; o > 0; o >>= 1) v = fmaxf(v, __shfl_xor(v, o));
    return v;
}
__device__ __forceinline__ int wave_sum_i(int v) {
#pragma unroll
    for (int o = 32; o > 0; o >>= 1) v += __shfl_xor(v, o);
    return v;
}
__device__ __forceinline__ float logsig(float x) { return fminf(x, 0.f) - log1pf(expf(-fabsf(x))); }

__device__ void transpose_items(int WV_, const float* W, int K, int N, bf16* WT, float* sm, int item0, int nitems_total, int item_stride) {
    const int tid = LTID(WV_);
    const int nkb = K / 64, nnb = (N + 63) / 64;
    for (int it = item0; it < nkb * nnb; it += item_stride) {
        const int kb = it % nkb, nb = it / nkb, k0 = kb * 64, n0 = nb * 64;
        __syncthreads();
        for (int e = tid; e < 64 * 64; e += NTHR) { const int kk = e >> 6, nn = e & 63; sm[kk * 65 + nn] = (n0 + nn < N) ? W[(size_t)(k0 + kk) * N + n0 + nn] : 0.f; }
        __syncthreads();
        { const int nn = tid >> 3, c = tid & 7;
          if (n0 + nn < N) { uint4 o; o.x = pk2(sm[(8 * c + 0) * 65 + nn], sm[(8 * c + 1) * 65 + nn]); o.y = pk2(sm[(8 * c + 2) * 65 + nn], sm[(8 * c + 3) * 65 + nn]);
              o.z = pk2(sm[(8 * c + 4) * 65 + nn], sm[(8 * c + 5) * 65 + nn]); o.w = pk2(sm[(8 * c + 6) * 65 + nn], sm[(8 * c + 7) * 65 + nn]);
              *(uint4*)(WT + (size_t)(n0 + nn) * K + k0 + 8 * c) = o; } }
    }
    __syncthreads();
}
__device__ void prologue_phase(int WV_, const Params& p, float* sm) {
    const int tid = LTID(WV_), B = LBID(), G = LGRID();
    unsigned char* ws = p.ws;
    for (int l = 0; l < DEPTH_; ++l) {
        bf16* win_t = (bf16*)(ws + WS_WIN_T + l * WIN_T_BYTES);
        transpose_items(WV_, p.in[1] + (size_t)l * 1024 * NCOL, 1024, NCOL, win_t, sm, B, 0, G);
        for (int i = B * NTHR + tid; i < (NP - NCOL) * 1024 / 8; i += G * NTHR) ((uint4*)(win_t + (size_t)NCOL * 1024))[i] = make_uint4(0u, 0u, 0u, 0u);
        transpose_items(WV_, p.in[3] + (size_t)l * 1024 * 1024, 1024, 1024, (bf16*)(ws + WS_WOUT_T) + (size_t)l * 1024 * 1024, sm, B, 0, G);
        transpose_items(WV_, p.in[7] + (size_t)l * 1024 * 1024, 1024, 1024, (bf16*)(ws + WS_WQ_T) + (size_t)l * 1024 * 1024, sm, B, 0, G);
        for (int n = 0; n < 4; ++n)
            transpose_items(WV_, p.in[2] + ((size_t)l * 4 + n) * 256 * 1024, 256, 1024, (bf16*)(ws + WS_WBR_T) + ((size_t)l * 4 + n) * 1024 * 256, sm, B, 0, G);
    }
    const float4* x4 = (const float4*)p.in[0]; uint2* hb2 = (uint2*)(ws + WS_HB);
    for (size_t i = (size_t)B * NTHR + tid; i < (size_t)T_ * 1024 / 4; i += (size_t)G * NTHR) { const float4 v = x4[i]; hb2[i] = make_uint2(pk2(v.x, v.y), pk2(v.z, v.w)); }
}

__device__ __forceinline__ void ln_row(float4 (&v)[4], const float* g, const float* bb, float* orow, bf16* obrow, int lane) {
    float s = 0.f;
#pragma unroll
    for (int j = 0; j < 4; ++j) s += (v[j].x + v[j].y) + (v[j].z + v[j].w);
    const float mean = wave_sum(s) * (1.0f / 1024.0f);
    float s2 = 0.f;
#pragma unroll
    for (int j = 0; j < 4; ++j) { v[j].x -= mean; v[j].y -= mean; v[j].z -= mean; v[j].w -= mean; s2 += (v[j].x * v[j].x + v[j].y * v[j].y) + (v[j].z * v[j].z + v[j].w * v[j].w); }
    const float rstd = 1.0f / sqrtf(wave_sum(s2) * (1.0f / 1024.0f) + LN_EPS);
#pragma unroll
    for (int j = 0; j < 4; ++j) {
        const float4 gg = ((const float4*)g)[j * 64 + lane], b4 = ((const float4*)bb)[j * 64 + lane];
        float4 o; o.x = v[j].x * rstd * gg.x + b4.x; o.y = v[j].y * rstd * gg.y + b4.y; o.z = v[j].z * rstd * gg.z + b4.z; o.w = v[j].w * rstd * gg.w + b4.w;
        ((float4*)orow)[j * 64 + lane] = o;
        ((uint2*)obrow)[j * 64 + lane] = make_uint2(pk2(o.x, o.y), pk2(o.z, o.w));
    }
}
__device__ void ln1_phase(int WV_, const float* hin, const float* add, const float* g, const float* bb, float* hout, bf16* hb) {
    const int lane = LTID(WV_) & 63, wave = LTID(WV_) >> 6;
    for (int row = LBID() * NWAVE + wave; row < T_; row += LGRID() * NWAVE) {
        float4 v[4];
#pragma unroll
        for (int j = 0; j < 4; ++j) {
            const float4 a = ((const float4*)(hin + (size_t)row * 1024))[j * 64 + lane], m = ((const float4*)(add + (size_t)row * 1024))[j * 64 + lane];
            v[j].x = ALPHA * a.x + m.x; v[j].y = ALPHA * a.y + m.y; v[j].z = ALPHA * a.z + m.z; v[j].w = ALPHA * a.w + m.w;
        }
        ln_row(v, g, bb, hout + (size_t)row * 1024, hb + (size_t)row * 1024, lane);
    }
}


typedef short bf16x8_t __attribute__((ext_vector_type(8)));
typedef float f32x16_t __attribute__((ext_vector_type(16)));
typedef float f32x2_t __attribute__((ext_vector_type(2)));
typedef __bf16 bf16x2_t __attribute__((ext_vector_type(2)));
__device__ __forceinline__ unsigned cvtpk(float lo, float hi) { f32x2_t v = {lo, hi}; bf16x2_t b = __builtin_convertvector(v, bf16x2_t); return __builtin_bit_cast(unsigned, b); }
__device__ __forceinline__ int crow(int r, int hi) { return (r & 3) + 8 * (r >> 2) + 4 * hi; }
__device__ __forceinline__ float xlane32(float v) { return __shfl_xor(v, 32); }

constexpr int AT_KP = 72, AT_VP = 68;
constexpr int AT_KS = 0, AT_KS_BYTES = 64 * AT_KP * 2;
constexpr int AT_VT = 2 * AT_KS_BYTES, AT_VT_BYTES = 64 * AT_VP * 2;
constexpr int AT_KM = AT_VT + 2 * AT_VT_BYTES;
constexpr int AT_MISC = AT_KM + 32 * AT_KP * 2;
constexpr float LOG2E = 1.4426950408889634f;

__device__ __forceinline__ unsigned mk_unit(int kind, int b, int x, int y) { return ((unsigned)kind << 30) | ((unsigned)b << 28) | ((unsigned)x << 8) | (unsigned)y; }
__device__ void build_unit_table(unsigned* tab, int i) {
    int n = 0; unsigned res = 0u;
#pragma unroll 1
    for (int c = 64; c >= 1; --c) {
        if (i >= n && i < n + 4) res = mk_unit(0, i - n, 0, c - 1);
        n += 4;
        if ((c & 3) == 0) { if (i >= n && i < n + 16) { const int j = i - n; res = mk_unit(2, j >> 2, j & 3, c / 4 - 1); } n += 16; }
    }
    if (i < 512) tab[i] = res;
}

template <int kind> __device__ __forceinline__ void attn_unit(int WV_, const bf16* P, const unsigned char* mask, const float* kmean, const float* sinks, bf16* ys,
                                unsigned char* lds, int b, int ux, int uy) {
    int tid_ = LTID(WV_); asm volatile("" : "+v"(tid_));
    const int tid = tid_, lane = tid & 63, wave = __builtin_amdgcn_readfirstlane(tid >> 6), r32 = lane & 31, hi = lane >> 5;
    bf16* s_km = (bf16*)(lds + AT_KM);
    const int skey = tid >> 3, sc = tid & 7;
    {
        const bf16* Pb = P + (size_t)b * S_ * NP;
        int q0w, qcol, kcol, vcol, ycol, kt_hi, kt_lo; float slope2 = 0.f, sink2 = 0.f;
        if (kind == 0) { const int head = wave >> 1; q0w = uy * 64 + (wave & 1) * 32; qcol = C_QA + head * 64; kcol = C_KA; vcol = C_VA; ycol = head * 64;
            slope2 = exp2f(-8.0f * (float)(3 * head + 1) / 12.0f) * LOG2E; kt_hi = uy; kt_lo = 0; }
        else if (kind == 1) { const int hq = ux * 2 + (wave >> 2); q0w = uy * 128 + (wave & 3) * 32; qcol = C_QB + hq * 64; kcol = C_KB + ux * 64; vcol = C_VB + ux * 64; ycol = 256 + hq * 64;
            slope2 = exp2f(-8.0f * (float)(3 * hq + 2) / 12.0f) * LOG2E; sink2 = sinks[hq] * LOG2E; kt_hi = 2 * uy + 1; kt_lo = (2 * uy - 2 > 0) ? 2 * uy - 2 : 0; }
        else if (kind == 2) { q0w = uy * 256 + wave * 32; qcol = C_QC + ux * 64; kcol = C_KC + ux * 64; vcol = C_VC + ux * 64; ycol = 512 + ux * 64;
            slope2 = exp2f(-8.0f * (float)(3 * ux + 3) / 12.0f) * LOG2E; kt_hi = 4 * uy + 3; kt_lo = 0; }
        else { q0w = uy * 256 + wave * 32; qcol = C_QD + ux * 64; kcol = C_KD + ux * 64; vcol = C_VD + ux * 64; ycol = 768 + ux * 64; kt_hi = 4 * uy + 3; kt_lo = 0; }
        const int qpos = q0w + r32;
        bf16x8_t qf[4];
        { const bf16* qp = Pb + (size_t)qpos * NP + qcol + 8 * hi;
#pragma unroll
          for (int ks = 0; ks < 4; ++ks) qf[ks] = *(const bf16x8_t*)(qp + 16 * ks); }
        unsigned bm = 0u;
        if (kind == 2) {
            const int own = uy;
            for (int e = tid; e < 32 * 64; e += NTHR) { const int row = e >> 6, d = e & 63; s_km[row * AT_KP + d] = (row < 16) ? (bf16)f2bf(kmean[((b * 4 + ux) * 16 + row) * 64 + d]) : (bf16)0; }
            __syncthreads();
            f32x16_t gacc;
#pragma unroll
            for (int r = 0; r < 16; ++r) gacc[r] = 0.f;
#pragma unroll
            for (int ks = 0; ks < 4; ++ks) { const bf16x8_t a = *(const bf16x8_t*)(s_km + r32 * AT_KP + 16 * ks + 8 * hi); gacc = __builtin_amdgcn_mfma_f32_32x32x16_bf16(a, qf[ks], gacc, 0, 0, 0); }
            float gt[16];
#pragma unroll
            for (int r = 0; r < 8; ++r) { const float mine = gacc[r], other = xlane32(mine); const int bi = crow(r, 0);
                gt[bi] = hi ? other : mine; gt[bi + 4] = hi ? mine : other; }
#pragma unroll
            for (int n = 0; n < 16; ++n) if (n >= own) gt[n] = -INFINITY;
#pragma unroll
            for (int rep = 0; rep < 3; ++rep) {
                float mx = -INFINITY;
#pragma unroll
                for (int n = 0; n < 16; ++n) mx = fmaxf(mx, gt[n]);
                bool done = !(mx > -INFINITY);
#pragma unroll
                for (int n = 0; n < 16; ++n) { const bool hit = !done && gt[n] == mx; if (hit) { bm |= 1u << n; gt[n] = -INFINITY; done = true; } }
            }
        }
        f32x16_t o0, o1;
#pragma unroll
        for (int r = 0; r < 16; ++r) { o0[r] = 0.f; o1[r] = 0.f; }
        float m_run = -INFINITY, l_run = 0.f, carry = 0.f;
        const bf16* kg = Pb + (size_t)skey * NP + kcol + sc * 8;
        const bf16* vg = Pb + (size_t)skey * NP + vcol + sc * 8;
        uint4 rk = *(const uint4*)(kg + (size_t)kt_hi * 64 * NP), rv = *(const uint4*)(vg + (size_t)kt_hi * 64 * NP);
        int buf = 0;
        { bf16* ks_ = (bf16*)(lds + AT_KS); bf16* vt_ = (bf16*)(lds + AT_VT);
          *(uint4*)(ks_ + skey * AT_KP + sc * 8) = rk;
          const unsigned vw[4] = {rv.x, rv.y, rv.z, rv.w};
#pragma unroll
          for (int j = 0; j < 4; ++j) { vt_[(sc * 8 + 2 * j) * AT_VP + skey] = (bf16)(vw[j] & 0xffffu); vt_[(sc * 8 + 2 * j + 1) * AT_VP + skey] = (bf16)(vw[j] >> 16); } }
        __syncthreads();
        bool wave_done = false;
        for (int kt = kt_hi; kt >= kt_lo; --kt) {
            const bool more = kt > kt_lo;
            if (more) { rk = *(const uint4*)(kg + (size_t)(kt - 1) * 64 * NP); rv = *(const uint4*)(vg + (size_t)(kt - 1) * 64 * NP); }
            const bf16* ks_ = (const bf16*)(lds + AT_KS + buf * AT_KS_BYTES);
            const bf16* vt_ = (const bf16*)(lds + AT_VT + buf * AT_VT_BYTES);
            bool active = (kt * 64 <= q0w + 31) && !wave_done;
            if (kind == 1) active = active && (kt * 64 + 63 >= q0w - 127);
            if (active) {
                f32x16_t p0, p1;
#pragma unroll
                for (int r = 0; r < 16; ++r) { p0[r] = 0.f; p1[r] = 0.f; }
#pragma unroll
                for (int ks = 0; ks < 4; ++ks) {
                    const bf16x8_t a0 = *(const bf16x8_t*)(ks_ + r32 * AT_KP + 16 * ks + 8 * hi);
                    const bf16x8_t a1 = *(const bf16x8_t*)(ks_ + (32 + r32) * AT_KP + 16 * ks + 8 * hi);
                    p0 = __builtin_amdgcn_mfma_f32_32x32x16_bf16(a0, qf[ks], p0, 0, 0, 0);
                    p1 = __builtin_amdgcn_mfma_f32_32x32x16_bf16(a1, qf[ks], p1, 0, 0, 0);
                }
                const int kbase = kt * 64 + 4 * hi;
                if (kind != 3) {
                    unsigned w0 = 0xffffffffu, w1 = 0xffffffffu;
                    bool tile_ok = true;
                    if (kind == 0) { const uint2 mw = *(const uint2*)(mask + (size_t)(b * S_ + qpos) * 512 + kt * 8); w0 = mw.x >> (4 * hi); w1 = mw.y >> (4 * hi); }
                    if (kind == 2) tile_ok = ((kt >> 2) == uy) || (((bm >> (kt >> 2)) & 1u) != 0u);
                    const float cb = slope2 * (float)(kbase - qpos);
                    float mx = -INFINITY;
#pragma unroll
                    for (int r = 0; r < 16; ++r) {
                        const int off = (r & 3) + 8 * (r >> 2);
                        const int kp0 = kbase + off, kp1 = kp0 + 32;
                        bool v0 = tile_ok, v1 = tile_ok;
                        if (kind == 0) { v0 = (w0 >> off) & 1u; v1 = (w1 >> off) & 1u; }
                        else if (kind == 1) { v0 = (kp0 <= qpos) && (qpos - kp0 < 128); v1 = (kp1 <= qpos) && (qpos - kp1 < 128); }
                        else { v0 = v0 && (kp0 <= qpos); v1 = v1 && (kp1 <= qpos); }
                        const float l0 = p0[r] * (0.125f * LOG2E) + (cb + slope2 * (float)off);
                        const float l1 = p1[r] * (0.125f * LOG2E) + (cb + slope2 * (float)(off + 32));
                        p0[r] = v0 ? l0 : -INFINITY; p1[r] = v1 ? l1 : -INFINITY;
                        mx = fmaxf(mx, fmaxf(p0[r], p1[r]));
                    }
                    mx = fmaxf(mx, xlane32(mx));
                    const float m_new = fmaxf(m_run, mx);
                    const float m_safe = (m_new == -INFINITY) ? 0.f : m_new;
                    const float alpha = exp2f(m_run - m_safe);
                    float ls = 0.f;
#pragma unroll
                    for (int r = 0; r < 16; ++r) { p0[r] = exp2f(p0[r] - m_safe); p1[r] = exp2f(p1[r] - m_safe); ls += p0[r] + p1[r]; }
                    l_run = l_run * alpha + ls; m_run = m_new;
#pragma unroll
                    for (int r = 0; r < 16; ++r) { o0[r] *= alpha; o1[r] *= alpha; }
                } else {
                    float run = carry;
#define SB_HALF(PX, KOFF) do { \
                    float lk[16]; \
                    _Pragma("unroll") for (int r = 0; r < 16; ++r) { \
                        const int off = (r & 3) + 8 * (r >> 2); \
                        const bool v = (kbase + off + (KOFF)) < qpos; \
                        const float z = PX[r] * 0.125f; \
                        const float t = log1pf(expf(-fabsf(z))); \
                        lk[r] = v ? (fminf(-z, 0.f) - t) : 0.f; \
                        PX[r] = v ? (fminf(z, 0.f) - t) : -INFINITY; } \
                    _Pragma("unroll") for (int g = 3; g >= 0; --g) { \
                        const float G = (lk[4 * g] + lk[4 * g + 1]) + (lk[4 * g + 2] + lk[4 * g + 3]); \
                        const float PG = xlane32(G); \
                        float la = run + (hi ? 0.f : PG); \
                        run += G + PG; \
                        PX[4 * g + 3] += la; la += lk[4 * g + 3]; PX[4 * g + 2] += la; la += lk[4 * g + 2]; PX[4 * g + 1] += la; la += lk[4 * g + 1]; PX[4 * g] += la; } \
                    _Pragma("unroll") for (int r = 0; r < 16; ++r) PX[r] = expf(PX[r]); } while (0)
                    SB_HALF(p1, 32);
                    SB_HALF(p0, 0);
#undef SB_HALF
                    carry = run;
                }
                unsigned pw[16];
#pragma unroll
                for (int j = 0; j < 8; ++j) { pw[j] = cvtpk(p0[2 * j], p0[2 * j + 1]); pw[8 + j] = cvtpk(p1[2 * j], p1[2 * j + 1]); }
#pragma unroll
                for (int s = 0; s < 4; ++s) {
                    bf16x8_t pb; { const unsigned* q = pw + 4 * s; typedef unsigned u32x4_t __attribute__((ext_vector_type(4))); u32x4_t t4 = {q[0], q[1], q[2], q[3]}; pb = __builtin_bit_cast(bf16x8_t, t4); }
#pragma unroll
                    for (int dt = 0; dt < 2; ++dt) {
                        const bf16* vp = vt_ + (32 * dt + r32) * AT_VP + 16 * s + 4 * hi;
                        typedef short s16x4_t __attribute__((ext_vector_type(4)));
                        const s16x4_t lo = *(const s16x4_t*)vp, hi4 = *(const s16x4_t*)(vp + 8);
                        const bf16x8_t va = {lo[0], lo[1], lo[2], lo[3], hi4[0], hi4[1], hi4[2], hi4[3]};
                        if (dt == 0) o0 = __builtin_amdgcn_mfma_f32_32x32x16_bf16(va, pb, o0, 0, 0, 0);
                        else         o1 = __builtin_amdgcn_mfma_f32_32x32x16_bf16(va, pb, o1, 0, 0, 0);
                    }
                }
            }
            if (kind == 3) {
                const float cm = carry;
                if (__all(cm < -110.0f) || !(kt * 64 <= q0w + 31) ) { if (__all(cm < -110.0f)) wave_done = true; }
            }
            if (more) {
                bf16* ksn = (bf16*)(lds + AT_KS + (buf ^ 1) * AT_KS_BYTES); bf16* vtn = (bf16*)(lds + AT_VT + (buf ^ 1) * AT_VT_BYTES);
                *(uint4*)(ksn + skey * AT_KP + sc * 8) = rk;
                const unsigned vw[4] = {rv.x, rv.y, rv.z, rv.w};
#pragma unroll
                for (int j = 0; j < 4; ++j) { vtn[(sc * 8 + 2 * j) * AT_VP + skey] = (bf16)(vw[j] & 0xffffu); vtn[(sc * 8 + 2 * j + 1) * AT_VP + skey] = (bf16)(vw[j] >> 16); }
            }
            if (kind == 3) { if (__syncthreads_and(wave_done ? 1 : 0)) break; }
            else __syncthreads();
            buf ^= 1;
        }
        float inv;
        if (kind == 3) inv = 1.0f;
        else {
            float lt = l_run + xlane32(l_run);
            if (kind == 1) { const float mf = fmaxf(m_run, sink2); const float sc2 = exp2f(m_run - mf); lt = lt * sc2 + exp2f(sink2 - mf); inv = sc2 / lt; }
            else inv = 1.0f / lt;
        }
        bf16* yp = ys + (size_t)(b * S_ + qpos) * 1024 + ycol + 4 * hi;
#pragma unroll
        for (int g = 0; g < 4; ++g) {
            *(uint2*)(yp + 8 * g) = make_uint2(cvtpk(o0[4 * g] * inv, o0[4 * g + 1] * inv), cvtpk(o0[4 * g + 2] * inv, o0[4 * g + 3] * inv));
            *(uint2*)(yp + 32 + 8 * g) = make_uint2(cvtpk(o1[4 * g] * inv, o1[4 * g + 1] * inv), cvtpk(o1[4 * g + 2] * inv, o1[4 * g + 3] * inv));
        }
    }
}
__device__ void attn_fast_phase(int WV_, const bf16* P, const unsigned char* mask, const float* kmean, const float* sinks, bf16* ys,
                                const unsigned* utab, unsigned* counter, unsigned char* lds) {
    volatile unsigned* s_unit = (volatile unsigned*)(lds + AT_MISC);
    for (;;) {
        __syncthreads();
        if (LTID(WV_) == 0) s_unit[0] = atomicAdd(counter, 1u);
        __syncthreads();
        const unsigned ui = s_unit[0];
        if (ui >= 512u) break;
        const unsigned ue = utab[ui];
        const int kind = (int)(ue >> 30), b = (int)((ue >> 28) & 3u), ux = (int)((ue >> 8) & 255u), uy = (int)(ue & 255u);
        if (kind == 0) attn_unit<0>(WV_, P, mask, kmean, sinks, ys, lds, b, ux, uy);
        else attn_unit<2>(WV_, P, mask, kmean, sinks, ys, lds, b, ux, uy);
    }
    for (int u = LBID(); u < 256; u += LGRID()) { __syncthreads(); attn_unit<3>(WV_, P, mask, kmean, sinks, ys, lds, u >> 6, (u >> 4) & 3, u & 15); }
    for (int u = LBID(); u < 256; u += LGRID()) { __syncthreads(); attn_unit<1>(WV_, P, mask, kmean, sinks, ys, lds, u >> 6, (u >> 5) & 1, u & 31); }
}

constexpr float U_SCALE = 64.0f, V_SCALE = 16.0f;
__device__ __forceinline__ float rdlane_f(float v, int l) { return __builtin_bit_cast(float, __builtin_amdgcn_readlane(__builtin_bit_cast(int, v), l)); }
__device__ __forceinline__ unsigned pk4_fp8(float a, float b, float c, float d) { int v = 0; v = __builtin_amdgcn_cvt_pk_fp8_f32(a, b, v, false); v = __builtin_amdgcn_cvt_pk_fp8_f32(c, d, v, true); return (unsigned)v; }
__device__ __forceinline__ void unpack16_fp8(const uint4 v, float* o) {
    const unsigned w[4] = {v.x, v.y, v.z, v.w};
#pragma unroll
    for (int i = 0; i < 4; ++i) { const f32x2_t lo = __builtin_amdgcn_cvt_pk_f32_fp8((int)w[i], false), hi2 = __builtin_amdgcn_cvt_pk_f32_fp8((int)w[i], true);
        o[4 * i] = lo.x; o[4 * i + 1] = lo.y; o[4 * i + 2] = hi2.x; o[4 * i + 3] = hi2.y; }
}
__device__ void convert_tables(int WV_, const Params& p) {
    const size_t nchunk = (size_t)DEPTH_ * 16384 * 2 * 64;
    for (size_t i = (size_t)LBID() * NTHR + LTID(WV_); i < nchunk; i += (size_t)LGRID() * NTHR) {
        const int c = (int)(i & 63), uvsel = (int)((i >> 6) & 1); const size_t le = i >> 7;
        const float* src = (uvsel ? p.in[10] : p.in[9]) + le * 1024 + c * 16;
        const float sc = uvsel ? V_SCALE : U_SCALE;
        const float4 a = ((const float4*)src)[0], b = ((const float4*)src)[1], cc = ((const float4*)src)[2], d = ((const float4*)src)[3];
        *(uint4*)(p.ws + WS_UV + le * 2048 + uvsel * 1024 + c * 16) = make_uint4(pk4_fp8(a.x * sc, a.y * sc, a.z * sc, a.w * sc), pk4_fp8(b.x * sc, b.y * sc, b.z * sc, b.w * sc),
                                                                               pk4_fp8(cc.x * sc, cc.y * sc, cc.z * sc, cc.w * sc), pk4_fp8(d.x * sc, d.y * sc, d.z * sc, d.w * sc));
    }
}
__device__ void peer_fast_phase(int WV_, float* h, bf16* hb, const int* eid, const float* gate, const unsigned char* uv, const float* g, const float* bb, unsigned char* lds) {
    const int tid = LTID(WV_), lane = tid & 63, wave = tid >> 6;
    for (int t = LBID() * NWAVE + wave; t < T_; t += LGRID() * NWAVE) {
        float* hr = h + (size_t)t * 1024 + lane * 16;
        float x[16], acc[16];
        { const float4 a0 = ((const float4*)hr)[0], a1 = ((const float4*)hr)[1], a2 = ((const float4*)hr)[2], a3 = ((const float4*)hr)[3];
          x[0] = a0.x; x[1] = a0.y; x[2] = a0.z; x[3] = a0.w; x[4] = a1.x; x[5] = a1.y; x[6] = a1.z; x[7] = a1.w;
          x[8] = a2.x; x[9] = a2.y; x[10] = a2.z; x[11] = a2.w; x[12] = a3.x; x[13] = a3.y; x[14] = a3.z; x[15] = a3.w; }
#pragma unroll
        for (int i = 0; i < 16; ++i) acc[i] = 0.f;
#pragma unroll 1
        for (int batch = 0; batch < 4; ++batch) {
            const int my_eid = eid[(size_t)t * 128 + batch * 32 + (lane & 31)];
            const float my_gate = gate[(size_t)t * 128 + batch * 32 + (lane & 31)];
            float* pl = (float*)lds + wave * 2048;
#pragma unroll 1
            for (int grp = 0; grp < 4; ++grp) {
                uint4 ua[8];
#pragma unroll
                for (int i = 0; i < 8; ++i) { const int id = __shfl(my_eid, grp * 8 + i); ua[i] = *(const uint4*)(uv + (size_t)id * 2048 + lane * 16); }
#pragma unroll
                for (int i = 0; i < 8; ++i) {
                    float f[16]; unpack16_fp8(ua[i], f);
                    float d0 = 0.f, d1 = 0.f;
#pragma unroll
                    for (int j = 0; j < 8; ++j) { d0 += f[j] * x[j]; d1 += f[8 + j] * x[8 + j]; }
                    pl[(grp * 8 + i) * 64 + lane] = d0 + d1;
                }
            }
            float d;
            { const float4* pr = (const float4*)(pl + (lane & 31) * 64); float4 s4 = pr[0];
#pragma unroll
              for (int i = 1; i < 16; ++i) { const float4 v = pr[i]; s4.x += v.x; s4.y += v.y; s4.z += v.z; s4.w += v.w; }
              d = ((s4.x + s4.y) + (s4.z + s4.w)) * (1.0f / U_SCALE); }
            const float hv = 0.5f * d * (1.0f + erff(d * 0.70710678118654752f)) * my_gate * (1.0f / V_SCALE);
#pragma unroll 1
            for (int grp = 0; grp < 4; ++grp) {
                uint4 va[8];
#pragma unroll
                for (int i = 0; i < 8; ++i) { const int id = __shfl(my_eid, grp * 8 + i); va[i] = *(const uint4*)(uv + (size_t)id * 2048 + 1024 + lane * 16); }
#pragma unroll
                for (int i = 0; i < 8; ++i) {
                    const float c = __shfl(hv, grp * 8 + i);
                    float f[16]; unpack16_fp8(va[i], f);
#pragma unroll
                    for (int j = 0; j < 16; ++j) acc[j] += c * f[j];
                }
            }
        }
        float y[16], s = 0.f;
#pragma unroll
        for (int i = 0; i < 16; ++i) { y[i] = ALPHA * x[i] + acc[i]; s += y[i]; }
        const float mean = wave_sum(s) * (1.0f / 1024.0f);
        float s2 = 0.f;
#pragma unroll
        for (int i = 0; i < 16; ++i) { y[i] -= mean; s2 += y[i] * y[i]; }
        const float rstd = 1.0f / sqrtf(wave_sum(s2) * (1.0f / 1024.0f) + LN_EPS);
        float o[16];
#pragma unroll
        for (int q4 = 0; q4 < 4; ++q4) {
            const float4 gg = ((const float4*)(g + lane * 16))[q4], cc = ((const float4*)(bb + lane * 16))[q4];
            o[4 * q4] = y[4 * q4] * rstd * gg.x + cc.x; o[4 * q4 + 1] = y[4 * q4 + 1] * rstd * gg.y + cc.y; o[4 * q4 + 2] = y[4 * q4 + 2] * rstd * gg.z + cc.z; o[4 * q4 + 3] = y[4 * q4 + 3] * rstd * gg.w + cc.w;
            ((float4*)hr)[q4] = make_float4(o[4 * q4], o[4 * q4 + 1], o[4 * q4 + 2], o[4 * q4 + 3]);
        }
        uint4* hbp = (uint4*)(hb + (size_t)t * 1024 + lane * 16);
        hbp[0] = make_uint4(pk2(o[0], o[1]), pk2(o[2], o[3]), pk2(o[4], o[5]), pk2(o[6], o[7]));
        hbp[1] = make_uint4(pk2(o[8], o[9]), pk2(o[10], o[11]), pk2(o[12], o[13]), pk2(o[14], o[15]));
    }
}

__device__ __forceinline__ float pack_pl(float v, unsigned pl) { return __uint_as_float((__float_as_uint(v) & ~127u) | pl); }
__device__ __forceinline__ void ins16(float (&s)[16], float x) {
#pragma unroll
    for (int k = 15; k >= 1; --k) s[k] = __builtin_amdgcn_fmed3f(s[k - 1], x, s[k]);
    s[0] = fmaxf(s[0], x);
}
template <int D> __device__ __forceinline__ void bitonic_stage(float (&c)[16]) {
#pragma unroll
    for (int i = 0; i < 16; ++i) if ((i & D) == 0) { const float a = fmaxf(c[i], c[i + D]), b = fminf(c[i], c[i + D]); c[i] = a; c[i + D] = b; }
}
__device__ __forceinline__ int decode_key(unsigned pl) { return (int)(32u * ((pl >> 4) & 3u) + (pl & 3u) + 8u * ((pl >> 2) & 3u) + 4u * ((pl >> 6) & 1u)); }
__device__ void route_fast_phase(int WV_, const bf16* qb, const bf16* skb  , int* eid, float* gate, unsigned char* lds) {
    const int tid = LTID(WV_), lane = tid & 63, wave = tid >> 6, r32 = lane & 31, hi = lane >> 5;
    unsigned* lidx = (unsigned*)lds + wave * (64 * 33) + lane * 33;
    for (int unit = LBID() * NWAVE + wave; unit < (T_ / 32) * 8; unit += LGRID() * NWAVE) {
        const int h = unit & 7, t = (unit >> 3) * 32 + r32;
        float sl[2][16];
#pragma unroll
        for (int p = 0; p < 2; ++p) {
            bf16x8_t qf[4];
            { const bf16* qp = qb + (size_t)t * 1024 + h * 128 + p * 64 + 8 * hi;
#pragma unroll
              for (int ks = 0; ks < 4; ++ks) qf[ks] = *(const bf16x8_t*)(qp + 16 * ks); }
            float s[16];
#pragma unroll
            for (int k = 0; k < 16; ++k) s[k] = -INFINITY;
            const bf16* skp = skb + ((size_t)(h * 2 + p) * 128 + r32) * 64 + 8 * hi;
#pragma unroll
            for (int kt = 0; kt < 4; ++kt) {
                f32x16_t acc;
#pragma unroll
                for (int r = 0; r < 16; ++r) acc[r] = 0.f;
#pragma unroll
                for (int ks = 0; ks < 4; ++ks) { const bf16x8_t a = *(const bf16x8_t*)(skp + (size_t)kt * 32 * 64 + 16 * ks); acc = __builtin_amdgcn_mfma_f32_32x32x16_bf16(a, qf[ks], acc, 0, 0, 0); }
#pragma unroll
                for (int r = 0; r < 16; ++r) ins16(s, pack_pl(acc[r], (unsigned)(kt * 16 + r)));
            }
            const unsigned hb = (unsigned)hi << 6;
#pragma unroll
            for (int k = 0; k < 16; ++k) s[k] = __uint_as_float(__float_as_uint(s[k]) | hb);
            float c[16];
#pragma unroll
            for (int k = 0; k < 16; ++k) c[k] = fmaxf(s[k], __shfl_xor(s[15 - k], 32));
            bitonic_stage<8>(c); bitonic_stage<4>(c); bitonic_stage<2>(c); bitonic_stage<1>(c);
#pragma unroll
            for (int k = 0; k < 16; ++k) { sl[p][k] = c[k]; lidx[p * 16 + k] = (unsigned)decode_key(__float_as_uint(c[k]) & 127u); }
        }
        float w[16];
#pragma unroll
        for (int k = 0; k < 16; ++k) w[k] = -INFINITY;
#pragma unroll
        for (int i = 0; i < 16; ++i)
#pragma unroll
            for (int j = 0; j < 16; ++j)
                if ((i + 1) * (j + 1) <= 16) { const float v = sl[0][i] + sl[1][j]; ins16(w, __uint_as_float((__float_as_uint(v) & ~255u) | (unsigned)(i * 16 + j))); }
        float e[16], sum = 0.f;
#pragma unroll
        for (int k = 0; k < 16; ++k) { e[k] = expf(w[k] - w[0]); sum += e[k]; }
        const float inv = 1.0f / sum;
        int ide[8]; float gte[8];
#pragma unroll
        for (int k = 0; k < 8; ++k) {
            float wa = w[k], wb = w[8 + k], ea = e[k], eb = e[8 + k];
            asm volatile("" : "+v"(wa), "+v"(wb), "+v"(ea), "+v"(eb));
            const float wv = hi ? wb : wa;
            const unsigned pl = __float_as_uint(wv) & 255u;
            ide[k] = (int)(lidx[pl >> 4] * 128u + lidx[16 + (pl & 15u)]);
            gte[k] = (hi ? eb : ea) * inv;
        }
        int* ep = eid + (size_t)t * 128 + h * 16 + hi * 8; float* gp = gate + (size_t)t * 128 + h * 16 + hi * 8;
        *(int4*)ep = make_int4(ide[0], ide[1], ide[2], ide[3]); *(int4*)(ep + 4) = make_int4(ide[4], ide[5], ide[6], ide[7]);
        *(float4*)gp = make_float4(gte[0], gte[1], gte[2], gte[3]); *(float4*)(gp + 4) = make_float4(gte[4], gte[5], gte[6], gte[7]);
    }
}

typedef float f32x4_t __attribute__((ext_vector_type(4)));
__device__ __forceinline__ void cnt_gt(int& cnt, unsigned a, unsigned b) { asm("v_cmp_gt_u32_e32 vcc, %1, %2\n\tv_addc_co_u32_e32 %0, vcc, 0, %0, vcc" : "+v"(cnt) : "v"(a), "v"(b) : "vcc"); }
__device__ __forceinline__ void cnt_eq(int& cnt, unsigned a, unsigned b) { asm("v_cmp_eq_u32_e32 vcc, %1, %2\n\tv_addc_co_u32_e32 %0, vcc, 0, %0, vcc" : "+v"(cnt) : "v"(a), "v"(b) : "vcc"); }
__device__ __forceinline__ unsigned flag_gt(unsigned a, unsigned b) { unsigned r; asm("v_cmp_gt_u32_e32 vcc, %1, %2\n\tv_cndmask_b32_e64 %0, 0, 1, vcc" : "=v"(r) : "v"(a), "v"(b) : "vcc"); return r; }
__device__ __forceinline__ unsigned flag_eq(unsigned a, unsigned b) { unsigned r; asm("v_cmp_eq_u32_e32 vcc, %1, %2\n\tv_cndmask_b32_e64 %0, 0, 1, vcc" : "=v"(r) : "v"(a), "v"(b) : "vcc"); return r; }
__device__ __forceinline__ void cnt_ge(int& cnt, unsigned key, unsigned cand) { asm("v_cmp_ge_u32_e32 vcc, %1, %2\n\tv_addc_co_u32_e32 %0, vcc, 0, %0, vcc" : "+v"(cnt) : "v"(key), "v"(cand) : "vcc"); }

typedef __attribute__((address_space(3))) unsigned lds_u32;
template <int SHIFT> __device__ __forceinline__ unsigned radix_pass(const unsigned (&key)[64], unsigned pre, lds_u32* hist, int lane, int& need) {
    typedef unsigned u32x4v __attribute__((ext_vector_type(4)));
    typedef __attribute__((address_space(3))) u32x4v lds_u32x4;
    { const u32x4v z4 = {0u, 0u, 0u, 0u};
#pragma unroll
      for (int i = 0; i < 8; ++i) ((lds_u32x4*)(hist + lane * 32))[i] = z4; }
    const unsigned cp = (unsigned)(lane & 7);
#pragma unroll
    for (int j = 0; j < 64; ++j) {
        const unsigned d = (key[j] >> SHIFT) & 255u;
        bool m;
        if (SHIFT == 24) m = key[j] != 0u; else m = (key[j] >> ((SHIFT + 8) & 31)) == pre;
        if (m) __hip_atomic_fetch_add(hist + ((d << 3) | cp), 1u, __ATOMIC_RELAXED, __HIP_MEMORY_SCOPE_WORKGROUP);
    }
    unsigned dsum[4]; unsigned sumL = 0u;
#pragma unroll
    for (int i = 0; i < 4; ++i) { const u32x4v v0 = ((const lds_u32x4*)(hist + lane * 32))[2 * i], v1 = ((const lds_u32x4*)(hist + lane * 32))[2 * i + 1];
        dsum[i] = ((v0.x + v0.y) + (v0.z + v0.w)) + ((v1.x + v1.y) + (v1.z + v1.w)); sumL += dsum[i]; }
    unsigned incl = sumL;
#pragma unroll
    for (int o = 1; o < 64; o <<= 1) { const unsigned t = (unsigned)__shfl_down((int)incl, o); if (lane + o < 64) incl += t; }
    const unsigned above = incl - sumL;
    const bool own = (above < (unsigned)need) && ((unsigned)need <= above + sumL);
    const int owner = __ffsll((long long)__ballot(own)) - 1;
    unsigned acc = above; int sel = -1; unsigned cab = 0u;
#pragma unroll
    for (int i = 3; i >= 0; --i) { const unsigned c = dsum[i]; const bool hit = (sel < 0) && (acc + c >= (unsigned)need); cab = hit ? acc : cab; sel = hit ? i : sel; acc += c; }
    const int ow = owner < 0 ? 0 : owner;
    const unsigned digit = (unsigned)__builtin_amdgcn_readlane(sel, ow) + (unsigned)(4 * ow);
    need -= (int)__builtin_amdgcn_readlane((int)cab, ow);
    return digit;
}
#ifndef TS_SEL
#define TS_SEL 0
#endif
#define ITS_B() do { if (TS_SEL >= 20 && TS_SEL <= 25 && WV_ == 0 && LANEID() == 0) ((volatile __attribute__((address_space(3))) unsigned long long*)((__attribute__((address_space(3))) unsigned char*)lds + 147456 - 16 - 32))[0] = __builtin_amdgcn_s_memrealtime(); } while (0)
#define ITS_E(k) do { if ((k) == TS_SEL && WV_ == 0 && LANEID() == 0) { volatile __attribute__((address_space(3))) unsigned long long* w_ = (volatile __attribute__((address_space(3))) unsigned long long*)((__attribute__((address_space(3))) unsigned char*)lds + 147456 - 16 - 32); w_[1] += __builtin_amdgcn_s_memrealtime() - w_[0]; } } while (0)
__device__ void index_fast_phase(int WV_, const bf16* P, unsigned char* mask, float* kmean, float* scratch_all, unsigned char* lds) {
    const int tid = LTID(WV_), lane = tid & 63, wave = tid >> 6, bid = LBID(), G = LGRID();
    float* s_part = (float*)lds;
    ITS_B();
    for (int k = bid; k < 256; k += G) {
        const int b = k >> 6, h = (k >> 4) & 3, blk = k & 15;
        const bf16* kp = P + (size_t)(b * S_ + blk * 256 + wave * 32) * NP + C_KC + h * 64 + lane;
        float a = 0.f;
#pragma unroll 8
        for (int j = 0; j < 32; ++j) a += bf2f(kp[(size_t)j * NP]);
        __syncthreads();
        s_part[wave * 64 + lane] = a;
        __syncthreads();
        if (tid < 64) { float s = 0.f;
#pragma unroll
            for (int w = 0; w < 8; ++w) s += s_part[w * 64 + tid];
            kmean[((b * 4 + h) * 16 + blk) * 64 + tid] = s * (1.0f / 256.0f); }
    }
    ITS_E(22);
    float* scr = scratch_all + (size_t)bid * (16 * 4096);
    const int lq = lane & 15, g4 = lane >> 4;
    for (int ui = bid; ui < 1024; ui += G) {
        const int b = ui >> 8, k = ui & 255, tile = (b & 1) ? 255 - k : k, q0 = tile * 16;
        const bf16* Pb = P + (size_t)b * S_ * NP;
        const int ntiles = tile + 1;
        ITS_B();
        bf16x8_t qf[8]; float wi[8];
        { const bf16* qp = Pb + (size_t)(q0 + lq) * NP + C_QI + 8 * g4;
#pragma unroll
          for (int h = 0; h < 8; ++h) qf[h] = *(const bf16x8_t*)(qp + 32 * h);
          const uint4 wv = *(const uint4*)(Pb + (size_t)(q0 + lq) * NP + C_WI); unpack8(wv, wi); }
        for (int kt = wave; kt < ntiles; kt += NWAVE) {
            const bf16x8_t af = *(const bf16x8_t*)(Pb + (size_t)(kt * 16 + lq) * NP + C_KI + 8 * g4);
            f32x4_t sc = {0.f, 0.f, 0.f, 0.f};
#pragma unroll
            for (int h = 0; h < 8; ++h) {
                const f32x4_t z = {0.f, 0.f, 0.f, 0.f};
                const f32x4_t a = __builtin_amdgcn_mfma_f32_16x16x32_bf16(af, qf[h], z, 0, 0, 0);
#pragma unroll
                for (int r = 0; r < 4; ++r) sc[r] += fmaxf(a[r], 0.f) * wi[h];
            }
#pragma unroll
            for (int r = 0; r < 4; ++r) { sc[r] *= 0.0625f; if (sc[r] == 0.f) sc[r] = 0.f; }
            *(f32x4_t*)(scr + (size_t)lq * 4096 + kt * 16 + 4 * g4) = sc;
        }
        __threadfence_block();
        __syncthreads();
        __threadfence_block();
        ITS_E(20); ITS_B();
        lds_u32* hist = (lds_u32*)((__attribute__((address_space(3))) unsigned char*)lds + 2048) + wave * 2048;
#pragma unroll 1
        for (int qi = 0; qi < 2; ++qi) {
            const int ql = 2 * wave + qi, q = q0 + ql;
            const float* row = scr + (size_t)ql * 4096 + lane * 64;
            const int qrel = q - lane * 64;
            unsigned key[64];
            if (qrel >= 0) {
#pragma unroll
                for (int j4 = 0; j4 < 16; ++j4) {
                    const float4 v = ((const float4*)row)[j4];
                    const unsigned u[4] = {__float_as_uint(v.x), __float_as_uint(v.y), __float_as_uint(v.z), __float_as_uint(v.w)};
#pragma unroll
                    for (int e = 0; e < 4; ++e) { const unsigned t = u[e] ^ ((unsigned)((int)u[e] >> 31) | 0x80000000u); const unsigned inval = (unsigned)((qrel - (j4 * 4 + e)) >> 31); key[j4 * 4 + e] = t & ~inval; }
                    if ((j4 & 3) == 3) asm volatile("" ::: "memory");
                }
            } else {
#pragma unroll
                for (int j = 0; j < 64; ++j) key[j] = 0u;
            }
            ITS_E(23); ITS_B();
            unsigned wlo = 0u, whi = 0u;
            if (q + 1 > 256) {
                int need = 256;
                const unsigned d1 = radix_pass<24>(key, 0u, hist, lane, need);
                const unsigned d2 = radix_pass<16>(key, d1, hist, lane, need);
                const unsigned d3 = radix_pass<8>(key, (d1 << 8) | d2, hist, lane, need);
                const unsigned d4 = radix_pass<0>(key, (d1 << 16) | (d2 << 8) | d3, hist, lane, need);
                const unsigned prefix = (d1 << 24) | (d2 << 16) | (d3 << 8) | d4;
                ITS_E(24); ITS_B();
                int ceq = 0;
#pragma unroll
                for (int j = 0; j < 64; ++j) cnt_eq(ceq, key[j], prefix);
                ceq = wave_sum_i(ceq);
                int X = 4096;
                if (ceq != need) {
                    int X0 = 0;
#pragma unroll 1
                    for (int bit = 11; bit >= 0; --bit) {
                        const int c = X0 | (1 << bit);
                        int cnt = 0; const int crel = c - lane * 64;
#pragma unroll
                        for (int j = 0; j < 64; ++j) cnt_eq(cnt, (key[j] ^ prefix) | ~(unsigned)((j - crel) >> 31), 0u);
                        cnt = wave_sum_i(cnt);
                        if (cnt < need) X0 = c;
                    }
                    X = X0 + 1;
                }
                const int xrel = X - lane * 64;
#pragma unroll
                for (int j = 0; j < 32; ++j) {
                    const unsigned s0 = flag_gt(key[j], prefix) | flag_eq((key[j] ^ prefix) | ~(unsigned)((j - xrel) >> 31), 0u);
                    const unsigned s1 = flag_gt(key[32 + j], prefix) | flag_eq((key[32 + j] ^ prefix) | ~(unsigned)((32 + j - xrel) >> 31), 0u);
                    wlo |= s0 << j; whi |= s1 << j;
                }
            } else {
#pragma unroll
                for (int j = 0; j < 32; ++j) { wlo |= (~(unsigned)((qrel - j) >> 31) & 1u) << j; whi |= (~(unsigned)((qrel - 32 - j) >> 31) & 1u) << j; }
            }
            ((uint2*)(mask + (size_t)(b * S_ + q) * 512))[lane] = make_uint2(wlo, whi);
            ITS_E(25); ITS_B();
        }
        ITS_E(21);
        __syncthreads();
    }
}

constexpr int MG_P = 72;
constexpr int MG_TILE_BYTES = 128 * MG_P * 2;
__device__ void merge_fast_phase(int WV_, const bf16* P, const bf16* ys, const bf16* wbt  , bf16* merged, unsigned char* lds) {
    const int tid = LTID(WV_), lane = tid & 63, wave = tid >> 6, r32 = lane & 31, hi = lane >> 5, wt = wave & 3, wd = wave >> 2;
    for (int tile = LBID(); tile < 1024; tile += LGRID()) {
        const int tok0 = (tile >> 3) * 128, d0 = (tile & 7) * 128;
        f32x16_t mer[2], acc[2];
#pragma unroll
        for (int r = 0; r < 16; ++r) { mer[0][r] = 0.f; mer[1][r] = 0.f; acc[0][r] = 0.f; acc[1][r] = 0.f; }
        const int srow0 = tid >> 3, sch = tid & 7;
        uint4 rw0, rw1, ry0, ry1;
#define MG_GLOAD(st_) do { const int n_ = (st_) >> 2, kc_ = (st_) & 3; \
            rw0 = *(const uint4*)(wbt + ((size_t)n_ * 1024 + d0 + srow0) * 256 + kc_ * 64 + sch * 8); \
            rw1 = *(const uint4*)(wbt + ((size_t)n_ * 1024 + d0 + srow0 + 64) * 256 + kc_ * 64 + sch * 8); \
            ry0 = *(const uint4*)(ys + (size_t)(tok0 + srow0) * 1024 + n_ * 256 + kc_ * 64 + sch * 8); \
            ry1 = *(const uint4*)(ys + (size_t)(tok0 + srow0 + 64) * 1024 + n_ * 256 + kc_ * 64 + sch * 8); } while (0)
#define MG_SSTORE(buf_) do { bf16* wl_ = (bf16*)(lds + (buf_) * 2 * MG_TILE_BYTES); bf16* yl_ = (bf16*)(lds + (buf_) * 2 * MG_TILE_BYTES + MG_TILE_BYTES); \
            *(uint4*)(wl_ + srow0 * MG_P + sch * 8) = rw0; *(uint4*)(wl_ + (srow0 + 64) * MG_P + sch * 8) = rw1; \
            *(uint4*)(yl_ + srow0 * MG_P + sch * 8) = ry0; *(uint4*)(yl_ + (srow0 + 64) * MG_P + sch * 8) = ry1; } while (0)
        __syncthreads();
        MG_GLOAD(0); MG_SSTORE(0);
        __syncthreads();
#pragma unroll 1
        for (int st = 0; st < 16; ++st) {
            const int buf = st & 1;
            if (st + 1 < 16) MG_GLOAD(st + 1);
            const bf16* wl = (const bf16*)(lds + buf * 2 * MG_TILE_BYTES); const bf16* yl = (const bf16*)(lds + buf * 2 * MG_TILE_BYTES + MG_TILE_BYTES);
#pragma unroll
            for (int ks = 0; ks < 4; ++ks) {
                const bf16x8_t bq = *(const bf16x8_t*)(yl + (32 * wt + r32) * MG_P + 16 * ks + 8 * hi);
                const bf16x8_t a0 = *(const bf16x8_t*)(wl + (64 * wd + r32) * MG_P + 16 * ks + 8 * hi);
                const bf16x8_t a1 = *(const bf16x8_t*)(wl + (64 * wd + 32 + r32) * MG_P + 16 * ks + 8 * hi);
                acc[0] = __builtin_amdgcn_mfma_f32_32x32x16_bf16(a0, bq, acc[0], 0, 0, 0);
                acc[1] = __builtin_amdgcn_mfma_f32_32x32x16_bf16(a1, bq, acc[1], 0, 0, 0);
            }
            if ((st & 3) == 3) {
                const int n = st >> 2;
                const bf16* gp = P + (size_t)(tok0 + 32 * wt + r32) * NP + C_G + n * 1024 + d0 + 64 * wd + 4 * hi;
#pragma unroll
                for (int dt = 0; dt < 2; ++dt)
#pragma unroll
                    for (int g = 0; g < 4; ++g) {
                        const uint2 gv = *(const uint2*)(gp + 32 * dt + 8 * g);
                        const float g0 = __uint_as_float(gv.x << 16), g1 = __uint_as_float(gv.x & 0xffff0000u), g2 = __uint_as_float(gv.y << 16), g3 = __uint_as_float(gv.y & 0xffff0000u);
                        mer[dt][4 * g + 0] += acc[dt][4 * g + 0] / (1.f + __expf(-g0)); mer[dt][4 * g + 1] += acc[dt][4 * g + 1] / (1.f + __expf(-g1));
                        mer[dt][4 * g + 2] += acc[dt][4 * g + 2] / (1.f + __expf(-g2)); mer[dt][4 * g + 3] += acc[dt][4 * g + 3] / (1.f + __expf(-g3));
                    }
#pragma unroll
                for (int r = 0; r < 16; ++r) { acc[0][r] = 0.f; acc[1][r] = 0.f; }
            }
            if (st + 1 < 16) MG_SSTORE(buf ^ 1);
            __syncthreads();
        }
        bf16* mp = merged + (size_t)(tok0 + 32 * wt + r32) * 1024 + d0 + 64 * wd + 4 * hi;
#pragma unroll
        for (int dt = 0; dt < 2; ++dt)
#pragma unroll
            for (int g = 0; g < 4; ++g)
                *(uint2*)(mp + 32 * dt + 8 * g) = make_uint2(cvtpk(mer[dt][4 * g], mer[dt][4 * g + 1]), cvtpk(mer[dt][4 * g + 2], mer[dt][4 * g + 3]));
    }
}
#define LAS __attribute__((address_space(3)))
#define XB_TMO      128
#define XB_XCNT(j)  (256  + 64 * (j))
#define XB_XSUB(j)  (1280 + 64 * (j))
#define XB_XGEN(j)  (2304 + 64 * (j))
#define XB_TOP      3328
#define XB_TOPGEN   3392
#define XCD_BAR_WORDS 3456
#define XB_SPIN_CAP (1u << 18)

__device__ __forceinline__ unsigned xb_ld(unsigned* p)              { return __hip_atomic_load(p, __ATOMIC_RELAXED, __HIP_MEMORY_SCOPE_AGENT); }
__device__ __forceinline__ unsigned xb_add(unsigned* p, unsigned v) { return __hip_atomic_fetch_add(p, v, __ATOMIC_RELAXED, __HIP_MEMORY_SCOPE_AGENT); }
__device__ __forceinline__ unsigned xb_xcc_id() { return (unsigned)__builtin_amdgcn_s_getreg((3 << 11) | 20) & 0xFu; }
#define XB_SPIN(cond, bar) do { unsigned _sp = 0; while (cond) { __builtin_amdgcn_s_sleep(1); \
    if ((++_sp & 255u) == 0u) { if (xb_ld(&(bar)[XB_TMO])) break; if (_sp > XB_SPIN_CAP) { atomicAdd(&(bar)[XB_TMO], 1u); break; } } } } while (0)

struct XcdBarrier {
    unsigned* bar; unsigned x;
    volatile LAS unsigned* st;
};

__device__ __forceinline__ XcdBarrier xcd_barrier_post(unsigned* bar, volatile LAS unsigned* st) {
    XcdBarrier b; b.bar = bar; b.x = xb_xcc_id(); b.st = st;
    if (threadIdx.x == 0) (void)xb_add(&bar[XB_XCNT(b.x)], 1u);
    return b;
}
__device__ __forceinline__ void xcd_barrier_complete(unsigned* bar, unsigned x, unsigned& nloc, unsigned& nx) {
    const unsigned G = gridDim.x * gridDim.y * gridDim.z;
    unsigned sum, cnt, mine, sp = 0u;
    for (;;) {
        sum = 0u; cnt = 0u; mine = 0u;
#pragma unroll
        for (unsigned j = 0; j < 16; ++j) { const unsigned c = xb_ld(&bar[XB_XCNT(j)]); sum += c; cnt += (c > 0u) ? 1u : 0u; mine = (j == x) ? c : mine; }
        if (sum == G) break;
        __builtin_amdgcn_s_sleep(1);
        if ((++sp & 255u) == 0u) { if (xb_ld(&bar[XB_TMO])) break; if (sp > XB_SPIN_CAP) { atomicAdd(&bar[XB_TMO], 1u); break; } }
    }
    nloc = mine > 0u ? mine : 1u; nx = cnt > 0u ? cnt : 1u;
}

__device__ __forceinline__ void xcd_barrier(const XcdBarrier& b, int wv_) {
    asm volatile("s_waitcnt vmcnt(0)" ::: "memory");
    __syncthreads();
    if (wv_ == 0 && LANEID() == 0) {
        unsigned* bar = b.bar;
        __builtin_amdgcn_s_waitcnt(0);
        unsigned nloc = b.st[0], nx = b.st[1];
        if (nloc == 0u) { xcd_barrier_complete(bar, b.x, nloc, nx); b.st[0] = nloc; b.st[1] = nx; }
        const unsigned old = xb_add(&bar[XB_XSUB(b.x)], 1u);
        const unsigned gen = old / nloc;
        if (old + 1u == (gen + 1u) * nloc) {
            __builtin_amdgcn_fence(__ATOMIC_RELEASE, "agent");
            asm volatile("s_waitcnt vmcnt(0)" ::: "memory");
            const unsigned og = xb_add(&bar[XB_TOP], 1u);
            const unsigned tg = og / nx;
            if (og + 1u == (tg + 1u) * nx) xb_add(&bar[XB_TOPGEN], 1u);
            else XB_SPIN(xb_ld(&bar[XB_TOPGEN]) == tg, bar);
            __builtin_amdgcn_fence(__ATOMIC_ACQUIRE, "agent");
            xb_add(&bar[XB_XGEN(b.x)], 1u);
            asm volatile("s_waitcnt vmcnt(0)" ::: "memory");
        } else {
            XB_SPIN(xb_ld(&bar[XB_XGEN(b.x)]) == gen, bar);
            __builtin_amdgcn_fence(__ATOMIC_ACQUIRE, "agent");
            asm volatile("s_waitcnt vmcnt(0)" ::: "memory");
        }
    }
    __syncthreads();
}

enum { PH_PRO = 0, PH_GIN, PH_INDEX, PH_ATTN, PH_MERGE, PH_GOUT, PH_LN1, PH_GQ, PH_ROUTE, PH_PEER };
template <int PH> __device__ __forceinline__ void run_phase(int WV_, const Params& p_unused, int l, unsigned char* lds_raw) {
    size_t kaoff_ = 0; asm volatile("" : "+s"(kaoff_));
    typedef const __attribute__((address_space(4))) char* kaptr_t;
    const __attribute__((address_space(4))) Params& p = *(const __attribute__((address_space(4))) Params*)((kaptr_t)__builtin_amdgcn_kernarg_segment_ptr() + kaoff_);
    float* sm = (float*)lds_raw;
    size_t wsoff_ = 0; asm volatile("" : "+s"(wsoff_));
    unsigned char* ws = p.ws + wsoff_;
    float* hbuf = p.out;
    bf16* hb = (bf16*)(ws + WS_HB);
    bf16* P = (bf16*)(ws + WS_P);
    bf16* ys = (bf16*)(ws + WS_YS);
    bf16* mrg = (bf16*)(ws + WS_MRG);
    float* mix = (float*)(ws + WS_MIX);
    float* qb = (float*)(ws + WS_Q);
    unsigned char* mask = ws + WS_MASK;
    int* eid = (int*)(ws + WS_EID);
    float* gate = (float*)(ws + WS_GATE);
    float* kmean = (float*)(ws + WS_KMEAN);
    const float* hin = (l == 0) ? p.in[0] : hbuf;
    if (PH == PH_PRO) { Params pc; for (int i = 0; i < 13; ++i) pc.in[i] = p.in[i]; pc.out = p.out; pc.ws = ws;
        prologue_phase(WV_, pc, sm); convert_tables(WV_, pc);
        for (int i = LBID() * NTHR + LTID(WV_); i < DEPTH_ * 8 * 2 * 128 * 64 / 4; i += LGRID() * NTHR) { const float4 v = ((const float4*)p.in[8])[i]; ((uint2*)(ws + WS_SKB))[i] = make_uint2(pk2(v.x, v.y), pk2(v.z, v.w)); } if (LBID() < 2) build_unit_table((unsigned*)(ws + WS_CTL) + 1024, LBID() * NTHR + LTID(WV_)); }
    else if (PH == PH_GIN) {
        pg8::Gemm g{hb, (const bf16*)(ws + WS_WIN_T + l * WIN_T_BYTES), T_, NP, 1024};
        pg8::StaticOrder S; S.init(T_, NP, (int)LGRID(), (int)LBID());
        pg8::EpiBf16<0> E{P, NP, nullptr, 0, 0, 1.f};
        pg8::gemm_phase<pg8::EpiBf16<0>, pg8::StaticOrder, true, true>(WV_, (PG8_LAS unsigned char*)lds_raw, g, S, E);
    }
    else if (PH == PH_INDEX) index_fast_phase(WV_, P, mask, kmean, (float*)(ws + WS_YS), lds_raw);
    else if (PH == PH_ATTN) attn_fast_phase(WV_, P, mask, kmean, p.in[4] + l * 4, ys, (const unsigned*)(ws + WS_CTL) + 1024, (unsigned*)(ws + WS_CTL) + 64 * l, lds_raw);
    else if (PH == PH_MERGE) merge_fast_phase(WV_, P, ys, (const bf16*)(ws + WS_WBR_T) + (size_t)l * 4 * 1024 * 256, mrg, lds_raw);
    else if (PH == PH_GOUT) {
        pg8::Gemm g{mrg, (const bf16*)(ws + WS_WOUT_T) + (size_t)l * 1024 * 1024, T_, 1024, 1024};
        pg8::StaticOrder S; S.init(T_, 1024, (int)LGRID(), (int)LBID());
        pg8::EpiF32 E{mix, 1024};
        pg8::gemm_phase<pg8::EpiF32, pg8::StaticOrder, true, true>(WV_, (PG8_LAS unsigned char*)lds_raw, g, S, E);
    }
    else if (PH == PH_LN1) ln1_phase(WV_, hin, mix, p.in[5] + l * 1024, p.in[6] + l * 1024, hbuf, hb);
    else if (PH == PH_GQ) {
        pg8::Gemm g{hb, (const bf16*)(ws + WS_WQ_T) + (size_t)l * 1024 * 1024, T_, 1024, 1024};
        pg8::StaticOrder S; S.init(T_, 1024, (int)LGRID(), (int)LBID());
        pg8::EpiBf16<0> E{(bf16*)qb, 1024, nullptr, 0, 0, 1.f};
        pg8::gemm_phase<pg8::EpiBf16<0>, pg8::StaticOrder, true, true>(WV_, (PG8_LAS unsigned char*)lds_raw, g, S, E);
    }
    else if (PH == PH_ROUTE) route_fast_phase(WV_, (const bf16*)qb, (const bf16*)(ws + WS_SKB) + (size_t)l * 8 * 2 * 128 * 64, eid, gate, lds_raw);
    else peer_fast_phase(WV_, hbuf, hb, eid, gate, ws + WS_UV + (size_t)l * 32 * MiB, p.in[11] + l * 1024, p.in[12] + l * 1024, lds_raw);
}

constexpr int CW_BAR = 4096;
constexpr int LDS_BARST = LDS_BYTES - 16;
__global__ void __launch_bounds__(NTHR, 2) mk_fwd(Params p) {
    extern __shared__ __attribute__((aligned(16))) unsigned char lds_raw[];
    cg::grid_group grid = cg::this_grid();
    const int WV_ = __builtin_amdgcn_readfirstlane((int)threadIdx.x >> 6);
    { volatile LAS unsigned* bst0 = (volatile LAS unsigned*)((LAS unsigned char*)lds_raw + LDS_BARST); if (threadIdx.x < 4) bst0[threadIdx.x] = 0u; }
    __syncthreads();
    volatile LAS unsigned* bst = (volatile LAS unsigned*)((LAS unsigned char*)lds_raw + LDS_BARST);
    (void)xcd_barrier_post((unsigned*)(p.ws + WS_CTL) + CW_BAR, bst);
#define GRID_BAR() do { XcdBarrier b_; b_.bar = (unsigned*)(p.ws + WS_CTL) + CW_BAR; b_.x = xb_xcc_id(); b_.st = (volatile LAS unsigned*)((LAS unsigned char*)lds_raw + LDS_BARST); xcd_barrier(b_, WV_); } while (0)
    run_phase<PH_PRO>(WV_, p, 0, lds_raw);
    grid.sync();
#pragma unroll 1
    for (int l = 0; l < DEPTH_; ++l) {
        run_phase<PH_GIN>(WV_, p, l, lds_raw); GRID_BAR();
        run_phase<PH_INDEX>(WV_, p, l, lds_raw); GRID_BAR();
        run_phase<PH_ATTN>(WV_, p, l, lds_raw); GRID_BAR();
        run_phase<PH_MERGE>(WV_, p, l, lds_raw); GRID_BAR();
        run_phase<PH_GOUT>(WV_, p, l, lds_raw); GRID_BAR();
        run_phase<PH_LN1>(WV_, p, l, lds_raw); GRID_BAR();
        run_phase<PH_GQ>(WV_, p, l, lds_raw); GRID_BAR();
        run_phase<PH_ROUTE>(WV_, p, l, lds_raw); GRID_BAR();
        run_phase<PH_PEER>(WV_, p, l, lds_raw); if (l + 1 < DEPTH_) GRID_BAR();
    }
}

extern "C" void kernel_launch(void* const* d_in, const int* in_sizes, int n_in, void* d_out, int out_size, void* d_ws, size_t ws_size, hipStream_t stream) {
    if (n_in != 13 || ws_size < WS_END) { fprintf(stderr, "kernel_launch: unexpected n_in %d / ws_size %zu; nothing launched\n", n_in, ws_size); return; }
    static int grid_blocks = 0;
    if (grid_blocks == 0) {
        int dev = 0, cus = 0, per_cu = 0;
        (void)hipGetDevice(&dev);
        (void)hipDeviceGetAttribute(&cus, hipDeviceAttributeMultiprocessorCount, dev);
        (void)hipFuncSetAttribute((const void*)mk_fwd, hipFuncAttributeMaxDynamicSharedMemorySize, LDS_BYTES);
        (void)hipOccupancyMaxActiveBlocksPerMultiprocessor(&per_cu, (const void*)mk_fwd, NTHR, LDS_BYTES);
        if (per_cu < 1) fprintf(stderr, "kernel_launch: occupancy query reports %d\n", per_cu);
        grid_blocks = cus;
    }
    Params p{};
    for (int i = 0; i < 13; ++i) p.in[i] = (const float*)d_in[i];
    p.out = (float*)d_out; p.ws = (unsigned char*)d_ws;
    (void)hipMemsetAsync(d_ws, 0, 65536, stream);
    void* args[] = {&p};
    hipError_t e = hipLaunchCooperativeKernel((const void*)mk_fwd, dim3(grid_blocks), dim3(NTHR), args, LDS_BYTES, stream);
    if (e != hipSuccess) fprintf(stderr, "cooperative launch failed: %s (grid %d)\n", hipGetErrorString(e), grid_blocks);
}
```

```cpp
#include <hip/hip_runtime.h>
#include <cstdio>
#include <cstdint>
#include <hip/hip_cooperative_groups.h>
namespace cg = cooperative_groups;

__device__ __forceinline__ int LANEID() { int l; asm volatile("v_mbcnt_lo_u32_b32 %0, -1, 0\n\tv_mbcnt_hi_u32_b32 %0, -1, %0" : "=v"(l)); return l; }
__device__ __forceinline__ int LTID(int wv) { return (wv << 6) | LANEID(); }
__device__ __forceinline__ int LBID() { int t = blockIdx.x; asm volatile("" : "+s"(t)); return t; }
__device__ __forceinline__ int LGRID() { int t = gridDim.x; asm volatile("" : "+s"(t)); return t; }
namespace pg8 {
#define PG8_LAS __attribute__((address_space(3)))
typedef unsigned short bf16_t;
typedef short bf16x8 __attribute__((ext_vector_type(8)));
typedef float f32x4 __attribute__((ext_vector_type(4)));
typedef unsigned u32x4 __attribute__((ext_vector_type(4)));
constexpr int BM = 256, BK = 64, HALF = 128, HTB = HALF * BK * 2  , STAGE_BYTES = 8 * HTB, NXCD = 8, WGM = 8;

__host__ __device__ __forceinline__ int lds_byte(int r, int c) { const int st = (r >> 4) * 2 + (c >> 5), rr = r & 15, cc = c & 31, ob = rr * 64 + cc * 2; return st * 1024 + (ob ^ (((ob >> 9) & 1) << 5)); }
__host__ __device__ __forceinline__ void stage_rc(int b, int& R, int& C) { const int st = b / 1024, sb = b % 1024, swz = sb ^ (((sb >> 9) & 1) << 5); R = (st >> 1) * 16 + swz / 64; C = (st & 1) * 32 + (swz % 64) / 2; }
__host__ __device__ __forceinline__ int perm32(int rho) { const int n = rho >> 4, i = rho & 15; return 8 * (i >> 2) + 4 * n + (i & 3); }

struct Unit { int pm, pn; };
struct Gemm { const bf16_t* A; const bf16_t* Bt; int M, N, K; };

struct StaticOrder {
    int nM, nN, nwg, G, c;
    __host__ __device__ void init(int M, int N, int G_, int c_) { nM = M / BM; nN = N / BM; nwg = nM * nN; G = G_; c = c_; }
    __host__ __device__ bool next(int i, Unit& u) const {
        const long L = (long)i * G + c; if (L >= nwg) return false;
        int wgid = (int)L; { const int q = nwg / NXCD, r = nwg % NXCD, xcd = wgid % NXCD, off = wgid / NXCD; wgid = (xcd < r ? xcd * (q + 1) : r * (q + 1) + (xcd - r) * q) + off; }
        const int nig = WGM * nN, gid = wgid / nig, fm = gid * WGM, gsz = (nM - fm) < WGM ? (nM - fm) : WGM;
        u.pm = fm + ((wgid % nig) % gsz); u.pn = (wgid % nig) / gsz; return true;
    }
    __device__ __forceinline__ void a_ready(const Unit&) const {}
    __device__ __forceinline__ void done(const Unit&) const {}
};

__device__ __forceinline__ unsigned cvt_pk_bf16(float lo, float hi) { unsigned r; asm volatile("v_cvt_pk_bf16_f32 %0, %1, %2" : "=v"(r) : "v"(lo), "v"(hi)); return r; }
typedef float f32x2 __attribute__((ext_vector_type(2)));
__device__ __forceinline__ f32x2 gelu_pk(f32x2 v) {
    const f32x2 av = __builtin_elementwise_abs(v), d = av * 0.2316418882f + 1.0f;
    f32x2 t; t.x = __builtin_amdgcn_rcpf(d.x); t.y = __builtin_amdgcn_rcpf(d.y);
    f32x2 q = t * 0.5307027145f + (-0.7265760135f); q = q * t + 0.7107068705f; q = q * t + (-0.142248368f); q = q * t + 0.127414796f; q = q * t;
    const f32x2 s = (v * v) * (-0.72134752044f);
    f32x2 e; e.x = __builtin_amdgcn_exp2f(s.x); e.y = __builtin_amdgcn_exp2f(s.y);
    const f32x2 m = v * (q * e), r = v - m;
    f32x2 o; o.x = v.x < 0.f ? m.x : r.x; o.y = v.y < 0.f ? m.y : r.y; return o;
}

template <int ACT  > struct EpiBf16 {
    static constexpr bool PERM = true, AFTER_DRAIN = false; static_assert(ACT == 0 || ACT == 1, "EpiBf16: ACT is 0 (none) or 1 (gelu_pk)");
    bf16_t* O; int ldc; const float* bias; int split_cols; size_t split_stride; float scale0;
    __device__ __forceinline__ void operator()(const f32x4 (&acc)[2][2][4][2], const Unit& u, int wr, int wc, int fr, int fq) const {
        { int ln_ = LANEID(); asm volatile("" : "+v"(ln_)); fr = ln_ & 15; fq = ln_ >> 4; }
        const int row0 = u.pm * BM + wr * 64 + fr; int colt = u.pn * BM; bf16_t* base = O;
        float sc = 1.f; if (split_cols) { const int t = colt / split_cols; base += (size_t)t * split_stride; colt -= t * split_cols; if (t == 0) sc = scale0; }
        const int col0 = colt + wc * 32 + 8 * fq, bcol0 = u.pn * BM + wc * 32 + 8 * fq;
        f32x4 bv[2][2];
#pragma unroll
        for (int bj = 0; bj < 2; ++bj)
#pragma unroll
            for (int n = 0; n < 2; ++n) bv[bj][n] = bias ? *(const f32x4*)(bias + bcol0 + bj * HALF + 4 * n) : (f32x4){0.f, 0.f, 0.f, 0.f};
#pragma unroll
        for (int ai = 0; ai < 2; ++ai)
#pragma unroll
            for (int m = 0; m < 4; ++m) { bf16_t* rowp = base + (size_t)(row0 + ai * HALF + m * 16) * ldc + col0;
#pragma unroll
                for (int bj = 0; bj < 2; ++bj) { f32x4 v0 = acc[ai][bj][m][0] + bv[bj][0], v1 = acc[ai][bj][m][1] + bv[bj][1];
                    if (ACT == 1) { f32x2 a = gelu_pk((f32x2){v0[0], v0[1]}), b = gelu_pk((f32x2){v0[2], v0[3]}), c = gelu_pk((f32x2){v1[0], v1[1]}), d = gelu_pk((f32x2){v1[2], v1[3]});
                        v0 = (f32x4){a.x, a.y, b.x, b.y}; v1 = (f32x4){c.x, c.y, d.x, d.y}; }
                    v0 = v0 * sc; v1 = v1 * sc; u32x4 w; w.x = cvt_pk_bf16(v0[0], v0[1]); w.y = cvt_pk_bf16(v0[2], v0[3]); w.z = cvt_pk_bf16(v1[0], v1[1]); w.w = cvt_pk_bf16(v1[2], v1[3]);
                    *(u32x4*)(rowp + bj * HALF) = w; } }
    }
};
template <class Epi, class Sched, bool ALIGN_EPI = false, bool SP2 = false>
__device__ __forceinline__ void gemm_phase(int WV_, PG8_LAS unsigned char* lds, const Gemm g, const Sched& S, const Epi& E) {
    const int tid = LTID(WV_), wid = __builtin_amdgcn_readfirstlane(tid >> 6), lane = tid & 63, wr = wid >> 2, wc = wid & 3, fr = lane & 15, fq = lane >> 4;
    const int K = g.K, nt = K / BK;
    unsigned voffA[2], voffB[2];
#pragma unroll
    for (int i = 0; i < 2; ++i) { int R, C; stage_rc(tid * 16 + i * 8192, R, C); const int Rb = Epi::PERM ? ((R & ~31) + perm32(R & 31)) : R;
        voffA[i] = (unsigned)(R * K + C) * 2u; voffB[i] = (unsigned)(Rb * K + C) * 2u; }
    const size_t kstep = (size_t)(BK * 2);
    const size_t hstep = (size_t)HALF * K * 2;
    const size_t tstep = 2 * hstep;
    const unsigned ldsw = (unsigned)wid * 1024u;
    const int aoff = lds_byte(wr * 64 + fr, fq * 8), boff = lds_byte(wc * 32 + fr, fq * 8);
#define PG8_SA(b, h) (((b) * 2 + (h)) * HTB)
#define PG8_SB(b, h) ((4 + (b) * 2 + (h)) * HTB)
#define PG8_STAGE(bufoff, gbase, voff) do { _Pragma("unroll") for (int _i = 0; _i < 2; ++_i) \
        __builtin_amdgcn_global_load_lds((const unsigned*)((const char*)(gbase) + (voff)[_i]), (PG8_LAS unsigned*)(lds + (bufoff) + ldsw + _i * 8192), 16, 0, 0); } while (0)
#define PG8_LDA(dst, b, h) do { _Pragma("unroll") for (int m = 0; m < 4; ++m) _Pragma("unroll") for (int k = 0; k < 2; ++k) dst[m][k] = *(const PG8_LAS bf16x8*)(lds + PG8_SA(b, h) + aoff + m * 2048 + k * 1024); } while (0)
#define PG8_LDB(dst, b, h) do { _Pragma("unroll") for (int n = 0; n < 2; ++n) _Pragma("unroll") for (int k = 0; k < 2; ++k) dst[n][k] = *(const PG8_LAS bf16x8*)(lds + PG8_SB(b, h) + boff + n * 2048 + k * 1024); } while (0)
#define PG8_MMA(ai, bj, At, Bt) do { __builtin_amdgcn_s_setprio(1); _Pragma("unroll") for (int m = 0; m < 4; ++m) _Pragma("unroll") for (int n = 0; n < 2; ++n) _Pragma("unroll") for (int k = 0; k < 2; ++k) \
        acc[ai][bj][m][n] = __builtin_amdgcn_mfma_f32_16x16x32_bf16(Bt[n][k], At[m][k], acc[ai][bj][m][n], 0, 0, 0); __builtin_amdgcn_s_setprio(0); } while (0)
#define PG8_WAIT_V(n) asm volatile("s_waitcnt vmcnt(" #n ")" ::: "memory")
#define PG8_WAIT_L(n) asm volatile("s_waitcnt lgkmcnt(" #n ")" ::: "memory")
#define PG8_BAR __builtin_amdgcn_s_barrier()
#define PG8_SCHED __builtin_amdgcn_sched_barrier(0)
    Unit cur, nxt; int ui = 0;
    if (!S.next(0, cur)) return;
    f32x4 acc[2][2][4][2];
#pragma unroll
    for (int a = 0; a < 2; ++a)
#pragma unroll
        for (int b = 0; b < 2; ++b)
#pragma unroll
            for (int m = 0; m < 4; ++m)
#pragma unroll
                for (int n = 0; n < 2; ++n) acc[a][b][m][n] = (f32x4){0.f, 0.f, 0.f, 0.f};
    bf16x8 At[4][2], B0[2][2], B1[2][2];
    const char* cA = (const char*)g.A + (size_t)cur.pm * tstep; const char* cB = (const char*)g.Bt + (size_t)cur.pn * tstep;
    S.a_ready(cur);
    if constexpr (SP2) {
        PG8_STAGE(PG8_SB(0, 0), cB, voffB); PG8_STAGE(PG8_SB(0, 1), cB + hstep, voffB); PG8_STAGE(PG8_SA(0, 0), cA, voffA); PG8_STAGE(PG8_SA(0, 1), cA + hstep, voffA);
        if (wr == 1) PG8_BAR;
        PG8_WAIT_V(2); PG8_BAR;
        PG8_STAGE(PG8_SB(1, 0), cB + kstep, voffB); PG8_STAGE(PG8_SA(1, 0), cA + kstep, voffA); PG8_STAGE(PG8_SB(1, 1), cB + hstep + kstep, voffB);
        PG8_WAIT_V(6); PG8_BAR;
    } else {
        PG8_STAGE(PG8_SB(0, 0), cB, voffB); PG8_STAGE(PG8_SA(0, 0), cA, voffA); PG8_STAGE(PG8_SB(0, 1), cB + hstep, voffB); PG8_STAGE(PG8_SA(0, 1), cA + hstep, voffA);
        if (wr == 1) PG8_BAR;
        PG8_WAIT_V(4); PG8_BAR;
        PG8_STAGE(PG8_SB(1, 0), cB + kstep, voffB); PG8_STAGE(PG8_SA(1, 0), cA + kstep, voffA); PG8_STAGE(PG8_SB(1, 1), cB + hstep + kstep, voffB);
        PG8_WAIT_V(6); PG8_BAR;
    }
    for (;;) {
        const bool has_next = S.next(ui + 1, nxt);
        const char* nA = has_next ? (const char*)g.A + (size_t)nxt.pm * tstep : cA; const char* nB = has_next ? (const char*)g.Bt + (size_t)nxt.pn * tstep : cB;
        for (int t = 0; t < nt; t += 2) {
            const bool last = (t == nt - 2);
            const char* a1 = cA + (size_t)(t + 1) * kstep;
            const char* a2 = last ? nA : cA + (size_t)(t + 2) * kstep; const char* b2 = last ? nB : cB + (size_t)(t + 2) * kstep;
            const char* a3 = a2 + kstep; const char* b3 = b2 + kstep;
            if (last && has_next) S.a_ready(nxt);
            if constexpr (SP2) {
            PG8_LDB(B0, 0, 0); PG8_LDB(B1, 0, 1); PG8_SCHED; PG8_LDA(At, 0, 0); PG8_STAGE(PG8_SA(1, 1), a1 + hstep, voffA);
            PG8_WAIT_V(8); PG8_WAIT_L(0); PG8_BAR; PG8_MMA(0, 0, At, B0); PG8_MMA(0, 1, At, B1); PG8_BAR; PG8_SCHED;
            PG8_LDA(At, 0, 1); PG8_STAGE(PG8_SB(0, 0), b2, voffB); PG8_STAGE(PG8_SB(0, 1), b2 + hstep, voffB); PG8_STAGE(PG8_SA(0, 0), a2, voffA);
            PG8_WAIT_V(8); PG8_WAIT_L(0); PG8_BAR; PG8_MMA(1, 0, At, B0); PG8_MMA(1, 1, At, B1); PG8_BAR; PG8_SCHED;
            PG8_LDB(B0, 1, 0); PG8_LDB(B1, 1, 1); PG8_SCHED; PG8_LDA(At, 1, 0); PG8_STAGE(PG8_SA(0, 1), a2 + hstep, voffA);
            PG8_WAIT_V(8); PG8_WAIT_L(0); PG8_BAR; PG8_MMA(0, 0, At, B0); PG8_MMA(0, 1, At, B1); PG8_BAR; PG8_SCHED;
            PG8_LDA(At, 1, 1); PG8_STAGE(PG8_SB(1, 0), b3, voffB); PG8_STAGE(PG8_SB(1, 1), b3 + hstep, voffB); PG8_STAGE(PG8_SA(1, 0), a3, voffA);
            PG8_WAIT_V(8); PG8_WAIT_L(0); PG8_BAR; PG8_MMA(1, 0, At, B0); PG8_MMA(1, 1, At, B1); PG8_BAR; PG8_SCHED;
            } else {
            PG8_LDB(B0, 0, 0); PG8_SCHED; PG8_LDA(At, 0, 0); PG8_STAGE(PG8_SA(1, 1), a1 + hstep, voffA);
            PG8_WAIT_L(8); PG8_BAR; PG8_WAIT_L(0); PG8_MMA(0, 0, At, B0); PG8_BAR; PG8_SCHED;
            PG8_LDB(B1, 0, 1); PG8_STAGE(PG8_SB(0, 0), b2, voffB);
            PG8_BAR; PG8_WAIT_L(0); PG8_MMA(0, 1, At, B1); PG8_BAR;
            PG8_LDA(At, 0, 1); PG8_STAGE(PG8_SA(0, 0), a2, voffA);
            PG8_BAR; PG8_WAIT_L(0); PG8_MMA(1, 0, At, B0); PG8_BAR; PG8_SCHED;
            PG8_STAGE(PG8_SB(0, 1), b2 + hstep, voffB);
            PG8_WAIT_V(6); PG8_BAR; PG8_MMA(1, 1, At, B1); PG8_BAR;
            PG8_LDB(B0, 1, 0); PG8_SCHED; PG8_LDA(At, 1, 0); PG8_STAGE(PG8_SA(0, 1), a2 + hstep, voffA);
            PG8_WAIT_L(8); PG8_BAR; PG8_WAIT_L(0); PG8_MMA(0, 0, At, B0); PG8_BAR; PG8_SCHED;
            PG8_LDB(B1, 1, 1); PG8_STAGE(PG8_SB(1, 0), b3, voffB);
            PG8_BAR; PG8_WAIT_L(0); PG8_MMA(0, 1, At, B1); PG8_BAR;
            PG8_LDA(At, 1, 1); PG8_STAGE(PG8_SA(1, 0), a3, voffA);
            PG8_BAR; PG8_WAIT_L(0); PG8_MMA(1, 0, At, B0); PG8_BAR; PG8_SCHED;
            PG8_STAGE(PG8_SB(1, 1), b3 + hstep, voffB);
            PG8_WAIT_V(6); PG8_BAR; PG8_MMA(1, 1, At, B1); PG8_BAR;
            }
        }
        if constexpr (ALIGN_EPI) { if (wr == 0) PG8_BAR; }
        if constexpr (!Epi::AFTER_DRAIN) { E(acc, cur, wr, wc, fr, fq); S.done(cur); }
        if (!has_next) break;
#pragma unroll
        for (int a = 0; a < 2; ++a)
#pragma unroll
            for (int b = 0; b < 2; ++b)
#pragma unroll
                for (int m = 0; m < 4; ++m)
#pragma unroll
                    for (int n = 0; n < 2; ++n) acc[a][b][m][n] = (f32x4){0.f, 0.f, 0.f, 0.f};
        cur = nxt; cA = nA; cB = nB; ++ui;
        if constexpr (ALIGN_EPI) { if (wr == 1) PG8_BAR; }
    }
    PG8_WAIT_V(0);
    if constexpr (!ALIGN_EPI) { if (wr == 0) PG8_BAR; }
    PG8_BAR;
    if constexpr (Epi::AFTER_DRAIN) { E.fused(acc, cur, wr, wc, fr, fq, lds, wid, lane); S.done(cur); }
#undef PG8_SA
#undef PG8_SB
#undef PG8_STAGE
#undef PG8_LDA
#undef PG8_LDB
#undef PG8_MMA
#undef PG8_WAIT_V
#undef PG8_WAIT_L
#undef PG8_BAR
#undef PG8_SCHED
}
}
namespace pg8 {
struct EpiF32 {
    static constexpr bool PERM = false, AFTER_DRAIN = false;
    float* O; int ldc;
    __device__ __forceinline__ void operator()(const f32x4 (&acc)[2][2][4][2], const Unit& u, int wr, int wc, int fr, int fq) const {
        { int ln_ = LANEID(); asm volatile("" : "+v"(ln_)); fr = ln_ & 15; fq = ln_ >> 4; }
        const int row0 = u.pm * BM + wr * 64 + fr, col0 = u.pn * BM + wc * 32 + 4 * fq;
#pragma unroll
        for (int ai = 0; ai < 2; ++ai)
#pragma unroll
            for (int m = 0; m < 4; ++m) { float* rowp = O + (size_t)(row0 + ai * HALF + m * 16) * ldc + col0;
#pragma unroll
                for (int bj = 0; bj < 2; ++bj)
#pragma unroll
                    for (int n = 0; n < 2; ++n) *(f32x4*)(rowp + bj * HALF + n * 16) = acc[ai][bj][m][n]; }
    }
};
}

typedef unsigned short bf16;
constexpr int T_ = 16384, S_ = 4096, NBATCH = 4, D_ = 1024, NCOL = 6824, NP = 6912, DEPTH_ = 2;
constexpr int C_QA = 0, C_KA = 256, C_VA = 320, C_QI = 384, C_KI = 640, C_WI = 672, C_QB = 680, C_KB = 936, C_VB = 1064,
              C_QC = 1192, C_KC = 1448, C_VC = 1704, C_QD = 1960, C_KD = 2216, C_VD = 2472, C_G = 2728;
constexpr int NTHR = 512, NWAVE = 8;
constexpr float ALPHA = 1.41421356237309515f;
constexpr float LN_EPS = 1e-5f;
constexpr size_t MiB = 1u << 20;
constexpr size_t WS_CTL = 0, WS_WIN_T = 2 * MiB, WS_WOUT_T = 30 * MiB, WS_WQ_T = 34 * MiB, WS_WBR_T = 38 * MiB, WS_HB = 42 * MiB,
                 WS_P = 74 * MiB, WS_MIX = 74 * MiB  , WS_Q = 138 * MiB  , WS_YS = 290 * MiB, WS_MRG = 322 * MiB,
                 WS_MASK = 354 * MiB, WS_EID = 362 * MiB, WS_GATE = 370 * MiB, WS_KMEAN = 378 * MiB, WS_SKB = 379 * MiB, WS_UV = 380 * MiB, WS_END = 508 * MiB;
constexpr size_t WIN_T_BYTES = (size_t)NP * 1024 * 2;
constexpr int LDS_BYTES = 144 * 1024;

struct Params { const float* in[13]; float* out; unsigned char* ws; };

__device__ __forceinline__ float bf2f(bf16 v) { return __uint_as_float((unsigned)v << 16); }
__device__ __forceinline__ unsigned f2bf(float f) { unsigned u = __float_as_uint(f); return (u + 0x7fffu + ((u >> 16) & 1u)) >> 16; }
__device__ __forceinline__ unsigned pk2(float lo, float hi) { return f2bf(lo) | (f2bf(hi) << 16); }
__device__ __forceinline__ void unpack8(const uint4 v, float* o) {
    o[0] = __uint_as_float(v.x << 16); o[1] = __uint_as_float(v.x & 0xffff0000u); o[2] = __uint_as_float(v.y << 16); o[3] = __uint_as_float(v.y & 0xffff0000u);
    o[4] = __uint_as_float(v.z << 16); o[5] = __uint_as_float(v.z & 0xffff0000u); o[6] = __uint_as_float(v.w << 16); o[7] = __uint_as_float(v.w & 0xffff0000u);
}
__device__ __forceinline__ float wave_sum(float v) {
#pragma unroll
    for (int o = 32; o > 0; o >>= 1) v += __shfl_xor(v, o);
    return v;
}
__device__ __forceinline__ float wave_max(float v) {
#pragma unroll
    for (int o = 32; o > 0; o >>= 1) v = fmaxf(v, __shfl_xor(v, o));
    return v;
}
__device__ __forceinline__ int wave_sum_i(int v) {
#pragma unroll
    for (int o = 32; o > 0; o >>= 1) v += __shfl_xor(v, o);
    return v;
}
__device__ __forceinline__ float logsig(float x) { return fminf(x, 0.f) - log1pf(expf(-fabsf(x))); }

__device__ void transpose_items(int WV_, const float* W, int K, int N, bf16* WT, float* sm, int item0, int nitems_total, int item_stride) {
    const int tid = LTID(WV_);
    const int nkb = K / 64, nnb = (N + 63) / 64;
    for (int it = item0; it < nkb * nnb; it += item_stride) {
        const int kb = it % nkb, nb = it / nkb, k0 = kb * 64, n0 = nb * 64;
        __syncthreads();
        for (int e = tid; e < 64 * 64; e += NTHR) { const int kk = e >> 6, nn = e & 63; sm[kk * 65 + nn] = (n0 + nn < N) ? W[(size_t)(k0 + kk) * N + n0 + nn] : 0.f; }
        __syncthreads();
        { const int nn = tid >> 3, c = tid & 7;
          if (n0 + nn < N) { uint4 o; o.x = pk2(sm[(8 * c + 0) * 65 + nn], sm[(8 * c + 1) * 65 + nn]); o.y = pk2(sm[(8 * c + 2) * 65 + nn], sm[(8 * c + 3) * 65 + nn]);
              o.z = pk2(sm[(8 * c + 4) * 65 + nn], sm[(8 * c + 5) * 65 + nn]); o.w = pk2(sm[(8 * c + 6) * 65 + nn], sm[(8 * c + 7) * 65 + nn]);
              *(uint4*)(WT + (size_t)(n0 + nn) * K + k0 + 8 * c) = o; } }
    }
    __syncthreads();
}
__device__ void prologue_phase(int WV_, const Params& p, float* sm) {
    const int tid = LTID(WV_), B = LBID(), G = LGRID();
    unsigned char* ws = p.ws;
    for (int l = 0; l < DEPTH_; ++l) {
        bf16* win_t = (bf16*)(ws + WS_WIN_T + l * WIN_T_BYTES);
        transpose_items(WV_, p.in[1] + (size_t)l * 1024 * NCOL, 1024, NCOL, win_t, sm, B, 0, G);
        for (int i = B * NTHR + tid; i < (NP - NCOL) * 1024 / 8; i += G * NTHR) ((uint4*)(win_t + (size_t)NCOL * 1024))[i] = make_uint4(0u, 0u, 0u, 0u);
        transpose_items(WV_, p.in[3] + (size_t)l * 1024 * 1024, 1024, 1024, (bf16*)(ws + WS_WOUT_T) + (size_t)l * 1024 * 1024, sm, B, 0, G);
        transpose_items(WV_, p.in[7] + (size_t)l * 1024 * 1024, 1024, 1024, (bf16*)(ws + WS_WQ_T) + (size_t)l * 1024 * 1024, sm, B, 0, G);
        for (int n = 0; n < 4; ++n)
            transpose_items(WV_, p.in[2] + ((size_t)l * 4 + n) * 256 * 1024, 256, 1024, (bf16*)(ws + WS_WBR_T) + ((size_t)l * 4 + n) * 1024 * 256, sm, B, 0, G);
    }
    const float4* x4 = (const float4*)p.in[0]; uint2* hb2 = (uint2*)(ws + WS_HB);
    for (size_t i = (size_t)B * NTHR + tid; i < (size_t)T_ * 1024 / 4; i += (size_t)G * NTHR) { const float4 v = x4[i]; hb2[i] = make_uint2(pk2(v.x, v.y), pk2(v.z, v.w)); }
}

__device__ __forceinline__ void ln_row(float4 (&v)[4], const float* g, const float* bb, float* orow, bf16* obrow, int lane) {
    float s = 0.f;
#pragma unroll
    for (int j = 0; j < 4; ++j) s += (v[j].x + v[j].y) + (v[j].z + v[j].w);
    const float mean = wave_sum(s) * (1.0f / 1024.0f);
    float s2 = 0.f;
#pragma unroll
    for (int j = 0; j < 4; ++j) { v[j].x -= mean; v[j].y -= mean; v[j].z -= mean; v[j].w -= mean; s2 += (v[j].x * v[j].x + v[j].y * v[j].y) + (v[j].z * v[j].z + v[j].w * v[j].w); }
    const float rstd = 1.0f / sqrtf(wave_sum(s2) * (1.0f / 1024.0f) + LN_EPS);
#pragma unroll
    for (int j = 0; j < 4; ++j) {
        const float4 gg = ((const float4*)g)[j * 64 + lane], b4 = ((const float4*)bb)[j * 64 + lane];
        float4 o; o.x = v[j].x * rstd * gg.x + b4.x; o.y = v[j].y * rstd * gg.y + b4.y; o.z = v[j].z * rstd * gg.z + b4.z; o.w = v[j].w * rstd * gg.w + b4.w;
        ((float4*)orow)[j * 64 + lane] = o;
        ((uint2*)obrow)[j * 64 + lane] = make_uint2(pk2(o.x, o.y), pk2(o.z, o.w));
    }
}
__device__ void ln1_phase(int WV_, const float* hin, const float* add, const float* g, const float* bb, float* hout, bf16* hb) {
    const int lane = LTID(WV_) & 63, wave = LTID(WV_) >> 6;
    for (int row = LBID() * NWAVE + wave; row < T_; row += LGRID() * NWAVE) {
        float4 v[4];
#pragma unroll
        for (int j = 0; j < 4; ++j) {
            const float4 a = ((const float4*)(hin + (size_t)row * 1024))[j * 64 + lane], m = ((const float4*)(add + (size_t)row * 1024))[j * 64 + lane];
            v[j].x = ALPHA * a.x + m.x; v[j].y = ALPHA * a.y + m.y; v[j].z = ALPHA * a.z + m.z; v[j].w = ALPHA * a.w + m.w;
        }
        ln_row(v, g, bb, hout + (size_t)row * 1024, hb + (size_t)row * 1024, lane);
    }
}


typedef short bf16x8_t __attribute__((ext_vector_type(8)));
typedef float f32x16_t __attribute__((ext_vector_type(16)));
typedef float f32x2_t __attribute__((ext_vector_type(2)));
typedef __bf16 bf16x2_t __attribute__((ext_vector_type(2)));
__device__ __forceinline__ unsigned cvtpk(float lo, float hi) { f32x2_t v = {lo, hi}; bf16x2_t b = __builtin_convertvector(v, bf16x2_t); return __builtin_bit_cast(unsigned, b); }
__device__ __forceinline__ int crow(int r, int hi) { return (r & 3) + 8 * (r >> 2) + 4 * hi; }
__device__ __forceinline__ float xlane32(float v) { return __shfl_xor(v, 32); }

constexpr int AT_KP = 72, AT_VP = 68;
constexpr int AT_KS = 0, AT_KS_BYTES = 64 * AT_KP * 2;
constexpr int AT_VT = 2 * AT_KS_BYTES, AT_VT_BYTES = 64 * AT_VP * 2;
constexpr int AT_KM = AT_VT + 2 * AT_VT_BYTES;
constexpr int AT_MISC = AT_KM + 32 * AT_KP * 2;
constexpr float LOG2E = 1.4426950408889634f;

__device__ __forceinline__ unsigned mk_unit(int kind, int b, int x, int y) { return ((unsigned)kind << 30) | ((unsigned)b << 28) | ((unsigned)x << 8) | (unsigned)y; }
__device__ void build_unit_table(unsigned* tab, int i) {
    int n = 0; unsigned res = 0u;
#pragma unroll 1
    for (int c = 64; c >= 1; --c) {
        if (i >= n && i < n + 4) res = mk_unit(0, i - n, 0, c - 1);
        n += 4;
        if ((c & 3) == 0) { if (i >= n && i < n + 16) { const int j = i - n; res = mk_unit(2, j >> 2, j & 3, c / 4 - 1); } n += 16; }
    }
    if (i < 512) tab[i] = res;
}

template <int kind> __device__ __forceinline__ void attn_unit(int WV_, const bf16* P, const unsigned char* mask, const float* kmean, const float* sinks, bf16* ys,
                                unsigned char* lds, int b, int ux, int uy) {
    int tid_ = LTID(WV_); asm volatile("" : "+v"(tid_));
    const int tid = tid_, lane = tid & 63, wave = __builtin_amdgcn_readfirstlane(tid >> 6), r32 = lane & 31, hi = lane >> 5;
    bf16* s_km = (bf16*)(lds + AT_KM);
    const int skey = tid >> 3, sc = tid & 7;
    {
        const bf16* Pb = P + (size_t)b * S_ * NP;
        int q0w, qcol, kcol, vcol, ycol, kt_hi, kt_lo; float slope2 = 0.f, sink2 = 0.f;
        if (kind == 0) { const int head = wave >> 1; q0w = uy * 64 + (wave & 1) * 32; qcol = C_QA + head * 64; kcol = C_KA; vcol = C_VA; ycol = head * 64;
            slope2 = exp2f(-8.0f * (float)(3 * head + 1) / 12.0f) * LOG2E; kt_hi = uy; kt_lo = 0; }
        else if (kind == 1) { const int hq = ux * 2 + (wave >> 2); q0w = uy * 128 + (wave & 3) * 32; qcol = C_QB + hq * 64; kcol = C_KB + ux * 64; vcol = C_VB + ux * 64; ycol = 256 + hq * 64;
            slope2 = exp2f(-8.0f * (float)(3 * hq + 2) / 12.0f) * LOG2E; sink2 = sinks[hq] * LOG2E; kt_hi = 2 * uy + 1; kt_lo = (2 * uy - 2 > 0) ? 2 * uy - 2 : 0; }
        else if (kind == 2) { q0w = uy * 256 + wave * 32; qcol = C_QC + ux * 64; kcol = C_KC + ux * 64; vcol = C_VC + ux * 64; ycol = 512 + ux * 64;
            slope2 = exp2f(-8.0f * (float)(3 * ux + 3) / 12.0f) * LOG2E; kt_hi = 4 * uy + 3; kt_lo = 0; }
        else { q0w = uy * 256 + wave * 32; qcol = C_QD + ux * 64; kcol = C_KD + ux * 64; vcol = C_VD + ux * 64; ycol = 768 + ux * 64; kt_hi = 4 * uy + 3; kt_lo = 0; }
        const int qpos = q0w + r32;
        bf16x8_t qf[4];
        { const bf16* qp = Pb + (size_t)qpos * NP + qcol + 8 * hi;
#pragma unroll
          for (int ks = 0; ks < 4; ++ks) qf[ks] = *(const bf16x8_t*)(qp + 16 * ks); }
        {
            const float qs = (kind == 3) ? 0.125f : 0.125f * LOG2E;
            typedef unsigned u32x4_t __attribute__((ext_vector_type(4)));
#pragma unroll
            for (int ks = 0; ks < 4; ++ks) { u32x4_t w = __builtin_bit_cast(u32x4_t, qf[ks]);
#pragma unroll
                for (int i = 0; i < 4; ++i) w[i] = cvtpk(__uint_as_float(w[i] << 16) * qs, __uint_as_float(w[i] & 0xffff0000u) * qs);
                qf[ks] = __builtin_bit_cast(bf16x8_t, w); }
        }
        float sb[16];
#pragma unroll
        for (int r = 0; r < 16; ++r) sb[r] = slope2 * (float)((r & 3) + 8 * (r >> 2));
        unsigned bm = 0u;
        if (kind == 2) {
            const int own = uy;
            for (int e = tid; e < 32 * 64; e += NTHR) { const int row = e >> 6, d = e & 63; s_km[row * AT_KP + d] = (row < 16) ? (bf16)f2bf(kmean[((b * 4 + ux) * 16 + row) * 64 + d]) : (bf16)0; }
            __syncthreads();
            f32x16_t gacc;
#pragma unroll
            for (int r = 0; r < 16; ++r) gacc[r] = 0.f;
#pragma unroll
            for (int ks = 0; ks < 4; ++ks) { const bf16x8_t a = *(const bf16x8_t*)(s_km + r32 * AT_KP + 16 * ks + 8 * hi); gacc = __builtin_amdgcn_mfma_f32_32x32x16_bf16(a, qf[ks], gacc, 0, 0, 0); }
            float gt[16];
#pragma unroll
            for (int r = 0; r < 8; ++r) { const float mine = gacc[r], other = xlane32(mine); const int bi = crow(r, 0);
                gt[bi] = hi ? other : mine; gt[bi + 4] = hi ? mine : other; }
#pragma unroll
            for (int n = 0; n < 16; ++n) if (n >= own) gt[n] = -INFINITY;
#pragma unroll
            for (int rep = 0; rep < 3; ++rep) {
                float mx = -INFINITY;
#pragma unroll
                for (int n = 0; n < 16; ++n) mx = fmaxf(mx, gt[n]);
                bool done = !(mx > -INFINITY);
#pragma unroll
                for (int n = 0; n < 16; ++n) { const bool hit = !done && gt[n] == mx; if (hit) { bm |= 1u << n; gt[n] = -INFINITY; done = true; } }
            }
        }
        f32x16_t o0, o1;
#pragma unroll
        for (int r = 0; r < 16; ++r) { o0[r] = 0.f; o1[r] = 0.f; }
        float m_run = -INFINITY, l_run = 0.f, carry = 0.f;
        const bf16* kg = Pb + (size_t)skey * NP + kcol + sc * 8;
        const bf16* vg = Pb + (size_t)skey * NP + vcol + sc * 8;
        uint4 rk = *(const uint4*)(kg + (size_t)kt_hi * 64 * NP), rv = *(const uint4*)(vg + (size_t)kt_hi * 64 * NP);
        int buf = 0;
        { bf16* ks_ = (bf16*)(lds + AT_KS); bf16* vt_ = (bf16*)(lds + AT_VT);
          *(uint4*)(ks_ + skey * AT_KP + sc * 8) = rk;
          const unsigned vw[4] = {rv.x, rv.y, rv.z, rv.w};
#pragma unroll
          for (int j = 0; j < 4; ++j) { vt_[(sc * 8 + 2 * j) * AT_VP + skey] = (bf16)(vw[j] & 0xffffu); vt_[(sc * 8 + 2 * j + 1) * AT_VP + skey] = (bf16)(vw[j] >> 16); } }
        __syncthreads();
        bool wave_done = false;
        for (int kt = kt_hi; kt >= kt_lo; --kt) {
            const bool more = kt > kt_lo;
            if (more) { rk = *(const uint4*)(kg + (size_t)(kt - 1) * 64 * NP); rv = *(const uint4*)(vg + (size_t)(kt - 1) * 64 * NP); }
            const bf16* ks_ = (const bf16*)(lds + AT_KS + buf * AT_KS_BYTES);
            const bf16* vt_ = (const bf16*)(lds + AT_VT + buf * AT_VT_BYTES);
            bool active = (kt * 64 <= q0w + 31) && !wave_done;
            if (kind == 1) active = active && (kt * 64 + 63 >= q0w - 127);
            if (active) {
                const int kbase = kt * 64 + 4 * hi;
                f32x16_t p0, p1;
                if (kind != 3) {
                    const float cb = slope2 * (float)(kbase - qpos), cb1 = cb + 32.0f * slope2;
#pragma unroll
                    for (int r = 0; r < 16; ++r) { p0[r] = cb + sb[r]; p1[r] = cb1 + sb[r]; }
                } else {
#pragma unroll
                    for (int r = 0; r < 16; ++r) { p0[r] = 0.f; p1[r] = 0.f; }
                }
#pragma unroll
                for (int ks = 0; ks < 4; ++ks) {
                    const bf16x8_t a0 = *(const bf16x8_t*)(ks_ + r32 * AT_KP + 16 * ks + 8 * hi);
                    const bf16x8_t a1 = *(const bf16x8_t*)(ks_ + (32 + r32) * AT_KP + 16 * ks + 8 * hi);
                    p0 = __builtin_amdgcn_mfma_f32_32x32x16_bf16(a0, qf[ks], p0, 0, 0, 0);
                    p1 = __builtin_amdgcn_mfma_f32_32x32x16_bf16(a1, qf[ks], p1, 0, 0, 0);
                }
                if (kind != 3) {
                    float mx = -INFINITY;
                    if (kind == 0) {
                        const uint2 mw = *(const uint2*)(mask + (size_t)(b * S_ + qpos) * 512 + kt * 8);
                        const unsigned w0 = mw.x >> (4 * hi), w1 = mw.y >> (4 * hi);
#pragma unroll
                        for (int r = 0; r < 16; ++r) { const int off = (r & 3) + 8 * (r >> 2);
                            p0[r] = (w0 & (1u << off)) ? p0[r] : -INFINITY; p1[r] = (w1 & (1u << off)) ? p1[r] : -INFINITY; mx = fmaxf(mx, fmaxf(p0[r], p1[r])); }
                    } else if (kind == 1) {
                        const int rel = qpos - kbase;
#pragma unroll
                        for (int r = 0; r < 16; ++r) { const int off = (r & 3) + 8 * (r >> 2);
                            p0[r] = ((unsigned)(rel - off) < 128u) ? p0[r] : -INFINITY; p1[r] = ((unsigned)(rel - off - 32) < 128u) ? p1[r] : -INFINITY; mx = fmaxf(mx, fmaxf(p0[r], p1[r])); }
                    } else {
                        if ((kt >> 2) == uy) {
                            const int rel = qpos - kbase;
#pragma unroll
                            for (int r = 0; r < 16; ++r) { const int off = (r & 3) + 8 * (r >> 2);
                                p0[r] = (off <= rel) ? p0[r] : -INFINITY; p1[r] = (off + 32 <= rel) ? p1[r] : -INFINITY; mx = fmaxf(mx, fmaxf(p0[r], p1[r])); }
                        } else {
                            const bool tile_ok = ((bm >> (kt >> 2)) & 1u) != 0u;
#pragma unroll
                            for (int r = 0; r < 16; ++r) { p0[r] = tile_ok ? p0[r] : -INFINITY; p1[r] = tile_ok ? p1[r] : -INFINITY; mx = fmaxf(mx, fmaxf(p0[r], p1[r])); }
                        }
                    }
                    mx = fmaxf(mx, xlane32(mx));
                    const float m_new = fmaxf(m_run, mx);
                    const float m_safe = (m_new == -INFINITY) ? 0.f : m_new;
                    float ls = 0.f;
#pragma unroll
                    for (int r = 0; r < 16; ++r) { p0[r] = __builtin_amdgcn_exp2f(p0[r] - m_safe); p1[r] = __builtin_amdgcn_exp2f(p1[r] - m_safe); ls += p0[r] + p1[r]; }
                    if (__any(m_new > m_run)) {
                        const float alpha = __builtin_amdgcn_exp2f(m_run - m_safe);
                        l_run *= alpha;
#pragma unroll
                        for (int r = 0; r < 16; ++r) { o0[r] *= alpha; o1[r] *= alpha; }
                    }
                    l_run += ls; m_run = m_new;
                } else {
                    float run = carry;
#define SB_HALF(PX, KOFF) do { \
                    float lk[16]; \
                    _Pragma("unroll") for (int r = 0; r < 16; ++r) { \
                        const int off = (r & 3) + 8 * (r >> 2); \
                        const bool v = (kbase + off + (KOFF)) < qpos; \
                        const float z = PX[r]; \
                        const float t = log1pf(expf(-fabsf(z))); \
                        lk[r] = v ? (fminf(-z, 0.f) - t) : 0.f; \
                        PX[r] = v ? (fminf(z, 0.f) - t) : -INFINITY; } \
                    _Pragma("unroll") for (int g = 3; g >= 0; --g) { \
                        const float G = (lk[4 * g] + lk[4 * g + 1]) + (lk[4 * g + 2] + lk[4 * g + 3]); \
                        const float PG = xlane32(G); \
                        float la = run + (hi ? 0.f : PG); \
                        run += G + PG; \
                        PX[4 * g + 3] += la; la += lk[4 * g + 3]; PX[4 * g + 2] += la; la += lk[4 * g + 2]; PX[4 * g + 1] += la; la += lk[4 * g + 1]; PX[4 * g] += la; } \
                    _Pragma("unroll") for (int r = 0; r < 16; ++r) PX[r] = expf(PX[r]); } while (0)
                    SB_HALF(p1, 32);
                    SB_HALF(p0, 0);
#undef SB_HALF
                    carry = run;
                }
                unsigned pw[16];
#pragma unroll
                for (int j = 0; j < 8; ++j) { pw[j] = cvtpk(p0[2 * j], p0[2 * j + 1]); pw[8 + j] = cvtpk(p1[2 * j], p1[2 * j + 1]); }
#pragma unroll
                for (int s = 0; s < 4; ++s) {
                    bf16x8_t pb; { const unsigned* q = pw + 4 * s; typedef unsigned u32x4_t __attribute__((ext_vector_type(4))); u32x4_t t4 = {q[0], q[1], q[2], q[3]}; pb = __builtin_bit_cast(bf16x8_t, t4); }
#pragma unroll
                    for (int dt = 0; dt < 2; ++dt) {
                        const bf16* vp = vt_ + (32 * dt + r32) * AT_VP + 16 * s + 4 * hi;
                        typedef short s16x4_t __attribute__((ext_vector_type(4)));
                        const s16x4_t lo = *(const s16x4_t*)vp, hi4 = *(const s16x4_t*)(vp + 8);
                        const bf16x8_t va = {lo[0], lo[1], lo[2], lo[3], hi4[0], hi4[1], hi4[2], hi4[3]};
                        if (dt == 0) o0 = __builtin_amdgcn_mfma_f32_32x32x16_bf16(va, pb, o0, 0, 0, 0);
                        else         o1 = __builtin_amdgcn_mfma_f32_32x32x16_bf16(va, pb, o1, 0, 0, 0);
                    }
                }
            }
            if (kind == 3) {
                const float cm = carry;
                if (__all(cm < -110.0f) || !(kt * 64 <= q0w + 31) ) { if (__all(cm < -110.0f)) wave_done = true; }
            }
            if (more) {
                bf16* ksn = (bf16*)(lds + AT_KS + (buf ^ 1) * AT_KS_BYTES); bf16* vtn = (bf16*)(lds + AT_VT + (buf ^ 1) * AT_VT_BYTES);
                *(uint4*)(ksn + skey * AT_KP + sc * 8) = rk;
                const unsigned vw[4] = {rv.x, rv.y, rv.z, rv.w};
#pragma unroll
                for (int j = 0; j < 4; ++j) { vtn[(sc * 8 + 2 * j) * AT_VP + skey] = (bf16)(vw[j] & 0xffffu); vtn[(sc * 8 + 2 * j + 1) * AT_VP + skey] = (bf16)(vw[j] >> 16); }
            }
            if (kind == 3) { if (__syncthreads_and(wave_done ? 1 : 0)) break; }
            else __syncthreads();
            buf ^= 1;
        }
        float inv;
        if (kind == 3) inv = 1.0f;
        else {
            float lt = l_run + xlane32(l_run);
            if (kind == 1) { const float mf = fmaxf(m_run, sink2); const float sc2 = exp2f(m_run - mf); lt = lt * sc2 + exp2f(sink2 - mf); inv = sc2 / lt; }
            else inv = 1.0f / lt;
        }
        bf16* yp = ys + (size_t)(b * S_ + qpos) * 1024 + ycol + 4 * hi;
#pragma unroll
        for (int g = 0; g < 4; ++g) {
            *(uint2*)(yp + 8 * g) = make_uint2(cvtpk(o0[4 * g] * inv, o0[4 * g + 1] * inv), cvtpk(o0[4 * g + 2] * inv, o0[4 * g + 3] * inv));
            *(uint2*)(yp + 32 + 8 * g) = make_uint2(cvtpk(o1[4 * g] * inv, o1[4 * g + 1] * inv), cvtpk(o1[4 * g + 2] * inv, o1[4 * g + 3] * inv));
        }
    }
}
__device__ void attn_fast_phase(int WV_, const bf16* P, const unsigned char* mask, const float* kmean, const float* sinks, bf16* ys,
                                const unsigned* utab, unsigned* counter, unsigned char* lds) {
    volatile unsigned* s_unit = (volatile unsigned*)(lds + AT_MISC);
    for (;;) {
        __syncthreads();
        if (LTID(WV_) == 0) s_unit[0] = atomicAdd(counter, 1u);
        __syncthreads();
        const unsigned ui = s_unit[0];
        if (ui >= 512u) break;
        const unsigned ue = utab[ui];
        const int kind = (int)(ue >> 30), b = (int)((ue >> 28) & 3u), ux = (int)((ue >> 8) & 255u), uy = (int)(ue & 255u);
        if (kind == 0) attn_unit<0>(WV_, P, mask, kmean, sinks, ys, lds, b, ux, uy);
        else attn_unit<2>(WV_, P, mask, kmean, sinks, ys, lds, b, ux, uy);
    }
    for (int u = LBID(); u < 256; u += LGRID()) { __syncthreads(); attn_unit<3>(WV_, P, mask, kmean, sinks, ys, lds, u >> 6, (u >> 4) & 3, u & 15); }
    for (int u = LBID(); u < 256; u += LGRID()) { __syncthreads(); attn_unit<1>(WV_, P, mask, kmean, sinks, ys, lds, u >> 6, (u >> 5) & 1, u & 31); }
}

constexpr float U_SCALE = 64.0f, V_SCALE = 16.0f;
__device__ __forceinline__ float rdlane_f(float v, int l) { return __builtin_bit_cast(float, __builtin_amdgcn_readlane(__builtin_bit_cast(int, v), l)); }
__device__ __forceinline__ unsigned pk4_fp8(float a, float b, float c, float d) { int v = 0; v = __builtin_amdgcn_cvt_pk_fp8_f32(a, b, v, false); v = __builtin_amdgcn_cvt_pk_fp8_f32(c, d, v, true); return (unsigned)v; }
__device__ __forceinline__ void unpack16_fp8(const uint4 v, float* o) {
    const unsigned w[4] = {v.x, v.y, v.z, v.w};
#pragma unroll
    for (int i = 0; i < 4; ++i) { const f32x2_t lo = __builtin_amdgcn_cvt_pk_f32_fp8((int)w[i], false), hi2 = __builtin_amdgcn_cvt_pk_f32_fp8((int)w[i], true);
        o[4 * i] = lo.x; o[4 * i + 1] = lo.y; o[4 * i + 2] = hi2.x; o[4 * i + 3] = hi2.y; }
}
__device__ void convert_tables(int WV_, const Params& p) {
    const size_t nchunk = (size_t)DEPTH_ * 16384 * 2 * 64;
    for (size_t i = (size_t)LBID() * NTHR + LTID(WV_); i < nchunk; i += (size_t)LGRID() * NTHR) {
        const int c = (int)(i & 63), uvsel = (int)((i >> 6) & 1); const size_t le = i >> 7;
        const float* src = (uvsel ? p.in[10] : p.in[9]) + le * 1024 + c * 16;
        const float sc = uvsel ? V_SCALE : U_SCALE;
        const float4 a = ((const float4*)src)[0], b = ((const float4*)src)[1], cc = ((const float4*)src)[2], d = ((const float4*)src)[3];
        *(uint4*)(p.ws + WS_UV + le * 2048 + uvsel * 1024 + c * 16) = make_uint4(pk4_fp8(a.x * sc, a.y * sc, a.z * sc, a.w * sc), pk4_fp8(b.x * sc, b.y * sc, b.z * sc, b.w * sc),
                                                                               pk4_fp8(cc.x * sc, cc.y * sc, cc.z * sc, cc.w * sc), pk4_fp8(d.x * sc, d.y * sc, d.z * sc, d.w * sc));
    }
}
__device__ void peer_fast_phase(int WV_, float* h, bf16* hb, const int* eid, const float* gate, const unsigned char* uv, const float* g, const float* bb, unsigned char* lds) {
    const int tid = LTID(WV_), lane = tid & 63, wave = tid >> 6;
    for (int t = LBID() * NWAVE + wave; t < T_; t += LGRID() * NWAVE) {
        float* hr = h + (size_t)t * 1024 + lane * 16;
        float x[16], acc[16];
        { const float4 a0 = ((const float4*)hr)[0], a1 = ((const float4*)hr)[1], a2 = ((const float4*)hr)[2], a3 = ((const float4*)hr)[3];
          x[0] = a0.x; x[1] = a0.y; x[2] = a0.z; x[3] = a0.w; x[4] = a1.x; x[5] = a1.y; x[6] = a1.z; x[7] = a1.w;
          x[8] = a2.x; x[9] = a2.y; x[10] = a2.z; x[11] = a2.w; x[12] = a3.x; x[13] = a3.y; x[14] = a3.z; x[15] = a3.w; }
#pragma unroll
        for (int i = 0; i < 16; ++i) acc[i] = 0.f;
#pragma unroll 1
        for (int batch = 0; batch < 4; ++batch) {
            const int my_eid = eid[(size_t)t * 128 + batch * 32 + (lane & 31)];
            const float my_gate = gate[(size_t)t * 128 + batch * 32 + (lane & 31)];
            float* pl = (float*)lds + wave * 2048;
#pragma unroll 1
            for (int grp = 0; grp < 4; ++grp) {
                uint4 ua[8];
#pragma unroll
                for (int i = 0; i < 8; ++i) { const int id = __shfl(my_eid, grp * 8 + i); ua[i] = *(const uint4*)(uv + (size_t)id * 2048 + lane * 16); }
#pragma unroll
                for (int i = 0; i < 8; ++i) {
                    float f[16]; unpack16_fp8(ua[i], f);
                    float d0 = 0.f, d1 = 0.f;
#pragma unroll
                    for (int j = 0; j < 8; ++j) { d0 += f[j] * x[j]; d1 += f[8 + j] * x[8 + j]; }
                    pl[(grp * 8 + i) * 64 + lane] = d0 + d1;
                }
            }
            float d;
            { const float4* pr = (const float4*)(pl + (lane & 31) * 64); float4 s4 = pr[0];
#pragma unroll
              for (int i = 1; i < 16; ++i) { const float4 v = pr[i]; s4.x += v.x; s4.y += v.y; s4.z += v.z; s4.w += v.w; }
              d = ((s4.x + s4.y) + (s4.z + s4.w)) * (1.0f / U_SCALE); }
            const float hv = 0.5f * d * (1.0f + erff(d * 0.70710678118654752f)) * my_gate * (1.0f / V_SCALE);
#pragma unroll 1
            for (int grp = 0; grp < 4; ++grp) {
                uint4 va[8];
#pragma unroll
                for (int i = 0; i < 8; ++i) { const int id = __shfl(my_eid, grp * 8 + i); va[i] = *(const uint4*)(uv + (size_t)id * 2048 + 1024 + lane * 16); }
#pragma unroll
                for (int i = 0; i < 8; ++i) {
                    const float c = __shfl(hv, grp * 8 + i);
                    float f[16]; unpack16_fp8(va[i], f);
#pragma unroll
                    for (int j = 0; j < 16; ++j) acc[j] += c * f[j];
                }
            }
        }
        float y[16], s = 0.f;
#pragma unroll
        for (int i = 0; i < 16; ++i) { y[i] = ALPHA * x[i] + acc[i]; s += y[i]; }
        const float mean = wave_sum(s) * (1.0f / 1024.0f);
        float s2 = 0.f;
#pragma unroll
        for (int i = 0; i < 16; ++i) { y[i] -= mean; s2 += y[i] * y[i]; }
        const float rstd = 1.0f / sqrtf(wave_sum(s2) * (1.0f / 1024.0f) + LN_EPS);
        float o[16];
#pragma unroll
        for (int q4 = 0; q4 < 4; ++q4) {
            const float4 gg = ((const float4*)(g + lane * 16))[q4], cc = ((const float4*)(bb + lane * 16))[q4];
            o[4 * q4] = y[4 * q4] * rstd * gg.x + cc.x; o[4 * q4 + 1] = y[4 * q4 + 1] * rstd * gg.y + cc.y; o[4 * q4 + 2] = y[4 * q4 + 2] * rstd * gg.z + cc.z; o[4 * q4 + 3] = y[4 * q4 + 3] * rstd * gg.w + cc.w;
            ((float4*)hr)[q4] = make_float4(o[4 * q4], o[4 * q4 + 1], o[4 * q4 + 2], o[4 * q4 + 3]);
        }
        uint4* hbp = (uint4*)(hb + (size_t)t * 1024 + lane * 16);
        hbp[0] = make_uint4(pk2(o[0], o[1]), pk2(o[2], o[3]), pk2(o[4], o[5]), pk2(o[6], o[7]));
        hbp[1] = make_uint4(pk2(o[8], o[9]), pk2(o[10], o[11]), pk2(o[12], o[13]), pk2(o[14], o[15]));
    }
}

__device__ __forceinline__ float pack_pl(float v, unsigned pl) { return __uint_as_float((__float_as_uint(v) & ~127u) | pl); }
__device__ __forceinline__ void ins16(float (&s)[16], float x) {
#pragma unroll
    for (int k = 15; k >= 1; --k) s[k] = __builtin_amdgcn_fmed3f(s[k - 1], x, s[k]);
    s[0] = fmaxf(s[0], x);
}
template <int D> __device__ __forceinline__ void bitonic_stage(float (&c)[16]) {
#pragma unroll
    for (int i = 0; i < 16; ++i) if ((i & D) == 0) { const float a = fmaxf(c[i], c[i + D]), b = fminf(c[i], c[i + D]); c[i] = a; c[i + D] = b; }
}
__device__ __forceinline__ int decode_key(unsigned pl) { return (int)(32u * ((pl >> 4) & 3u) + (pl & 3u) + 8u * ((pl >> 2) & 3u) + 4u * ((pl >> 6) & 1u)); }
__device__ void route_fast_phase(int WV_, const bf16* qb, const bf16* skb  , int* eid, float* gate, unsigned char* lds) {
    const int tid = LTID(WV_), lane = tid & 63, wave = tid >> 6, r32 = lane & 31, hi = lane >> 5;
    unsigned* lidx = (unsigned*)lds + wave * (64 * 33) + lane * 33;
    for (int unit = LBID() * NWAVE + wave; unit < (T_ / 32) * 8; unit += LGRID() * NWAVE) {
        const int h = unit & 7, t = (unit >> 3) * 32 + r32;
        float sl[2][16];
#pragma unroll
        for (int p = 0; p < 2; ++p) {
            bf16x8_t qf[4];
            { const bf16* qp = qb + (size_t)t * 1024 + h * 128 + p * 64 + 8 * hi;
#pragma unroll
              for (int ks = 0; ks < 4; ++ks) qf[ks] = *(const bf16x8_t*)(qp + 16 * ks); }
            float s[16];
#pragma unroll
            for (int k = 0; k < 16; ++k) s[k] = -INFINITY;
            const bf16* skp = skb + ((size_t)(h * 2 + p) * 128 + r32) * 64 + 8 * hi;
#pragma unroll
            for (int kt = 0; kt < 4; ++kt) {
                f32x16_t acc;
#pragma unroll
                for (int r = 0; r < 16; ++r) acc[r] = 0.f;
#pragma unroll
                for (int ks = 0; ks < 4; ++ks) { const bf16x8_t a = *(const bf16x8_t*)(skp + (size_t)kt * 32 * 64 + 16 * ks); acc = __builtin_amdgcn_mfma_f32_32x32x16_bf16(a, qf[ks], acc, 0, 0, 0); }
#pragma unroll
                for (int r = 0; r < 16; ++r) ins16(s, pack_pl(acc[r], (unsigned)(kt * 16 + r)));
            }
            const unsigned hb = (unsigned)hi << 6;
#pragma unroll
            for (int k = 0; k < 16; ++k) s[k] = __uint_as_float(__float_as_uint(s[k]) | hb);
            float c[16];
#pragma unroll
            for (int k = 0; k < 16; ++k) c[k] = fmaxf(s[k], __shfl_xor(s[15 - k], 32));
            bitonic_stage<8>(c); bitonic_stage<4>(c); bitonic_stage<2>(c); bitonic_stage<1>(c);
#pragma unroll
            for (int k = 0; k < 16; ++k) { sl[p][k] = c[k]; lidx[p * 16 + k] = (unsigned)decode_key(__float_as_uint(c[k]) & 127u); }
        }
        float w[16];
#pragma unroll
        for (int k = 0; k < 16; ++k) w[k] = -INFINITY;
#pragma unroll
        for (int i = 0; i < 16; ++i)
#pragma unroll
            for (int j = 0; j < 16; ++j)
                if ((i + 1) * (j + 1) <= 16) { const float v = sl[0][i] + sl[1][j]; ins16(w, __uint_as_float((__float_as_uint(v) & ~255u) | (unsigned)(i * 16 + j))); }
        float e[16], sum = 0.f;
#pragma unroll
        for (int k = 0; k < 16; ++k) { e[k] = expf(w[k] - w[0]); sum += e[k]; }
        const float inv = 1.0f / sum;
        int ide[8]; float gte[8];
#pragma unroll
        for (int k = 0; k < 8; ++k) {
            float wa = w[k], wb = w[8 + k], ea = e[k], eb = e[8 + k];
            asm volatile("" : "+v"(wa), "+v"(wb), "+v"(ea), "+v"(eb));
            const float wv = hi ? wb : wa;
            const unsigned pl = __float_as_uint(wv) & 255u;
            ide[k] = (int)(lidx[pl >> 4] * 128u + lidx[16 + (pl & 15u)]);
            gte[k] = (hi ? eb : ea) * inv;
        }
        int* ep = eid + (size_t)t * 128 + h * 16 + hi * 8; float* gp = gate + (size_t)t * 128 + h * 16 + hi * 8;
        *(int4*)ep = make_int4(ide[0], ide[1], ide[2], ide[3]); *(int4*)(ep + 4) = make_int4(ide[4], ide[5], ide[6], ide[7]);
        *(float4*)gp = make_float4(gte[0], gte[1], gte[2], gte[3]); *(float4*)(gp + 4) = make_float4(gte[4], gte[5], gte[6], gte[7]);
    }
}

typedef float f32x4_t __attribute__((ext_vector_type(4)));
__device__ __forceinline__ void cnt_gt(int& cnt, unsigned a, unsigned b) { asm("v_cmp_gt_u32_e32 vcc, %1, %2\n\tv_addc_co_u32_e32 %0, vcc, 0, %0, vcc" : "+v"(cnt) : "v"(a), "v"(b) : "vcc"); }
__device__ __forceinline__ void cnt_eq(int& cnt, unsigned a, unsigned b) { asm("v_cmp_eq_u32_e32 vcc, %1, %2\n\tv_addc_co_u32_e32 %0, vcc, 0, %0, vcc" : "+v"(cnt) : "v"(a), "v"(b) : "vcc"); }
__device__ __forceinline__ unsigned flag_gt(unsigned a, unsigned b) { unsigned r; asm("v_cmp_gt_u32_e32 vcc, %1, %2\n\tv_cndmask_b32_e64 %0, 0, 1, vcc" : "=v"(r) : "v"(a), "v"(b) : "vcc"); return r; }
__device__ __forceinline__ unsigned flag_eq(unsigned a, unsigned b) { unsigned r; asm("v_cmp_eq_u32_e32 vcc, %1, %2\n\tv_cndmask_b32_e64 %0, 0, 1, vcc" : "=v"(r) : "v"(a), "v"(b) : "vcc"); return r; }
__device__ __forceinline__ void cnt_ge(int& cnt, unsigned key, unsigned cand) { asm("v_cmp_ge_u32_e32 vcc, %1, %2\n\tv_addc_co_u32_e32 %0, vcc, 0, %0, vcc" : "+v"(cnt) : "v"(key), "v"(cand) : "vcc"); }

typedef __attribute__((address_space(3))) unsigned lds_u32;
template <int SHIFT> __device__ __forceinline__ unsigned radix_pass(const unsigned (&key)[64], unsigned pre, lds_u32* hist, int lane, int& need) {
    typedef unsigned u32x4v __attribute__((ext_vector_type(4)));
    typedef __attribute__((address_space(3))) u32x4v lds_u32x4;
    { const u32x4v z4 = {0u, 0u, 0u, 0u};
#pragma unroll
      for (int i = 0; i < 8; ++i) ((lds_u32x4*)(hist + lane * 32))[i] = z4; }
    const unsigned cp = (unsigned)(lane & 7);
#pragma unroll
    for (int j = 0; j < 64; ++j) {
        const unsigned d = (key[j] >> SHIFT) & 255u;
        bool m;
        if (SHIFT == 24) m = key[j] != 0u; else m = (key[j] >> ((SHIFT + 8) & 31)) == pre;
        if (m) __hip_atomic_fetch_add(hist + ((d << 3) | cp), 1u, __ATOMIC_RELAXED, __HIP_MEMORY_SCOPE_WORKGROUP);
    }
    unsigned dsum[4]; unsigned sumL = 0u;
#pragma unroll
    for (int i = 0; i < 4; ++i) { const u32x4v v0 = ((const lds_u32x4*)(hist + lane * 32))[2 * i], v1 = ((const lds_u32x4*)(hist + lane * 32))[2 * i + 1];
        dsum[i] = ((v0.x + v0.y) + (v0.z + v0.w)) + ((v1.x + v1.y) + (v1.z + v1.w)); sumL += dsum[i]; }
    unsigned incl = sumL;
#pragma unroll
    for (int o = 1; o < 64; o <<= 1) { const unsigned t = (unsigned)__shfl_down((int)incl, o); if (lane + o < 64) incl += t; }
    const unsigned above = incl - sumL;
    const bool own = (above < (unsigned)need) && ((unsigned)need <= above + sumL);
    const int owner = __ffsll((long long)__ballot(own)) - 1;
    unsigned acc = above; int sel = -1; unsigned cab = 0u;
#pragma unroll
    for (int i = 3; i >= 0; --i) { const unsigned c = dsum[i]; const bool hit = (sel < 0) && (acc + c >= (unsigned)need); cab = hit ? acc : cab; sel = hit ? i : sel; acc += c; }
    const int ow = owner < 0 ? 0 : owner;
    const unsigned digit = (unsigned)__builtin_amdgcn_readlane(sel, ow) + (unsigned)(4 * ow);
    need -= (int)__builtin_amdgcn_readlane((int)cab, ow);
    return digit;
}
#ifndef TS_SEL
#define TS_SEL 0
#endif
#define ITS_B() do { if (TS_SEL >= 20 && TS_SEL <= 25 && WV_ == 0 && LANEID() == 0) ((volatile __attribute__((address_space(3))) unsigned long long*)((__attribute__((address_space(3))) unsigned char*)lds + 147456 - 16 - 32))[0] = __builtin_amdgcn_s_memrealtime(); } while (0)
#define ITS_E(k) do { if ((k) == TS_SEL && WV_ == 0 && LANEID() == 0) { volatile __attribute__((address_space(3))) unsigned long long* w_ = (volatile __attribute__((address_space(3))) unsigned long long*)((__attribute__((address_space(3))) unsigned char*)lds + 147456 - 16 - 32); w_[1] += __builtin_amdgcn_s_memrealtime() - w_[0]; } } while (0)
__device__ void index_fast_phase(int WV_, const bf16* P, unsigned char* mask, float* kmean, float* scratch_all, unsigned char* lds) {
    const int tid = LTID(WV_), lane = tid & 63, wave = tid >> 6, bid = LBID(), G = LGRID();
    float* s_part = (float*)lds;
    ITS_B();
    for (int k = bid; k < 256; k += G) {
        const int b = k >> 6, h = (k >> 4) & 3, blk = k & 15;
        const bf16* kp = P + (size_t)(b * S_ + blk * 256 + wave * 32) * NP + C_KC + h * 64 + lane;
        float a = 0.f;
#pragma unroll 8
        for (int j = 0; j < 32; ++j) a += bf2f(kp[(size_t)j * NP]);
        __syncthreads();
        s_part[wave * 64 + lane] = a;
        __syncthreads();
        if (tid < 64) { float s = 0.f;
#pragma unroll
            for (int w = 0; w < 8; ++w) s += s_part[w * 64 + tid];
            kmean[((b * 4 + h) * 16 + blk) * 64 + tid] = s * (1.0f / 256.0f); }
    }
    ITS_E(22);
    float* scr = scratch_all + (size_t)bid * (16 * 4096);
    const int lq = lane & 15, g4 = lane >> 4;
    for (int ui = bid; ui < 1024; ui += G) {
        const int b = ui >> 8, k = ui & 255, tile = (b & 1) ? 255 - k : k, q0 = tile * 16;
        const bf16* Pb = P + (size_t)b * S_ * NP;
        const int ntiles = tile + 1;
        ITS_B();
        bf16x8_t qf[8]; float wi[8];
        { const bf16* qp = Pb + (size_t)(q0 + lq) * NP + C_QI + 8 * g4;
#pragma unroll
          for (int h = 0; h < 8; ++h) qf[h] = *(const bf16x8_t*)(qp + 32 * h);
          const uint4 wv = *(const uint4*)(Pb + (size_t)(q0 + lq) * NP + C_WI); unpack8(wv, wi); }
        for (int kt = wave; kt < ntiles; kt += NWAVE) {
            const bf16x8_t af = *(const bf16x8_t*)(Pb + (size_t)(kt * 16 + lq) * NP + C_KI + 8 * g4);
            f32x4_t sc = {0.f, 0.f, 0.f, 0.f};
#pragma unroll
            for (int h = 0; h < 8; ++h) {
                const f32x4_t z = {0.f, 0.f, 0.f, 0.f};
                const f32x4_t a = __builtin_amdgcn_mfma_f32_16x16x32_bf16(af, qf[h], z, 0, 0, 0);
#pragma unroll
                for (int r = 0; r < 4; ++r) sc[r] += fmaxf(a[r], 0.f) * wi[h];
            }
#pragma unroll
            for (int r = 0; r < 4; ++r) { sc[r] *= 0.0625f; if (sc[r] == 0.f) sc[r] = 0.f; }
            *(f32x4_t*)(scr + (size_t)lq * 4096 + kt * 16 + 4 * g4) = sc;
        }
        __threadfence_block();
        __syncthreads();
        __threadfence_block();
        ITS_E(20); ITS_B();
        lds_u32* hist = (lds_u32*)((__attribute__((address_space(3))) unsigned char*)lds + 2048) + wave * 2048;
#pragma unroll 1
        for (int qi = 0; qi < 2; ++qi) {
            const int ql = 2 * wave + qi, q = q0 + ql;
            const float* row = scr + (size_t)ql * 4096 + lane * 64;
            const int qrel = q - lane * 64;
            unsigned key[64];
            if (qrel >= 0) {
#pragma unroll
                for (int j4 = 0; j4 < 16; ++j4) {
                    const float4 v = ((const float4*)row)[j4];
                    const unsigned u[4] = {__float_as_uint(v.x), __float_as_uint(v.y), __float_as_uint(v.z), __float_as_uint(v.w)};
#pragma unroll
                    for (int e = 0; e < 4; ++e) { const unsigned t = u[e] ^ ((unsigned)((int)u[e] >> 31) | 0x80000000u); const unsigned inval = (unsigned)((qrel - (j4 * 4 + e)) >> 31); key[j4 * 4 + e] = t & ~inval; }
                    if ((j4 & 3) == 3) asm volatile("" ::: "memory");
                }
            } else {
#pragma unroll
                for (int j = 0; j < 64; ++j) key[j] = 0u;
            }
            ITS_E(23); ITS_B();
            unsigned wlo = 0u, whi = 0u;
            if (q + 1 > 256) {
                int need = 256;
                const unsigned d1 = radix_pass<24>(key, 0u, hist, lane, need);
                const unsigned d2 = radix_pass<16>(key, d1, hist, lane, need);
                const unsigned d3 = radix_pass<8>(key, (d1 << 8) | d2, hist, lane, need);
                const unsigned d4 = radix_pass<0>(key, (d1 << 16) | (d2 << 8) | d3, hist, lane, need);
                const unsigned prefix = (d1 << 24) | (d2 << 16) | (d3 << 8) | d4;
                ITS_E(24); ITS_B();
                int ceq = 0;
#pragma unroll
                for (int j = 0; j < 64; ++j) cnt_eq(ceq, key[j], prefix);
                ceq = wave_sum_i(ceq);
                int X = 4096;
                if (ceq != need) {
                    int X0 = 0;
#pragma unroll 1
                    for (int bit = 11; bit >= 0; --bit) {
                        const int c = X0 | (1 << bit);
                        int cnt = 0; const int crel = c - lane * 64;
#pragma unroll
                        for (int j = 0; j < 64; ++j) cnt_eq(cnt, (key[j] ^ prefix) | ~(unsigned)((j - crel) >> 31), 0u);
                        cnt = wave_sum_i(cnt);
                        if (cnt < need) X0 = c;
                    }
                    X = X0 + 1;
                }
                const int xrel = X - lane * 64;
#pragma unroll
                for (int j = 0; j < 32; ++j) {
                    const unsigned s0 = flag_gt(key[j], prefix) | flag_eq((key[j] ^ prefix) | ~(unsigned)((j - xrel) >> 31), 0u);
                    const unsigned s1 = flag_gt(key[32 + j], prefix) | flag_eq((key[32 + j] ^ prefix) | ~(unsigned)((32 + j - xrel) >> 31), 0u);
                    wlo |= s0 << j; whi |= s1 << j;
                }
            } else {
#pragma unroll
                for (int j = 0; j < 32; ++j) { wlo |= (~(unsigned)((qrel - j) >> 31) & 1u) << j; whi |= (~(unsigned)((qrel - 32 - j) >> 31) & 1u) << j; }
            }
            ((uint2*)(mask + (size_t)(b * S_ + q) * 512))[lane] = make_uint2(wlo, whi);
            ITS_E(25); ITS_B();
        }
        ITS_E(21);
        __syncthreads();
    }
}

constexpr int MG_P = 72;
constexpr int MG_TILE_BYTES = 128 * MG_P * 2;
__device__ void merge_fast_phase(int WV_, const bf16* P, const bf16* ys, const bf16* wbt  , bf16* merged, unsigned char* lds) {
    const int tid = LTID(WV_), lane = tid & 63, wave = tid >> 6, r32 = lane & 31, hi = lane >> 5, wt = wave & 3, wd = wave >> 2;
    for (int tile = LBID(); tile < 1024; tile += LGRID()) {
        const int tok0 = (tile >> 3) * 128, d0 = (tile & 7) * 128;
        f32x16_t mer[2], acc[2];
#pragma unroll
        for (int r = 0; r < 16; ++r) { mer[0][r] = 0.f; mer[1][r] = 0.f; acc[0][r] = 0.f; acc[1][r] = 0.f; }
        const int srow0 = tid >> 3, sch = tid & 7;
        uint4 rw0, rw1, ry0, ry1;
#define MG_GLOAD(st_) do { const int n_ = (st_) >> 2, kc_ = (st_) & 3; \
            rw0 = *(const uint4*)(wbt + ((size_t)n_ * 1024 + d0 + srow0) * 256 + kc_ * 64 + sch * 8); \
            rw1 = *(const uint4*)(wbt + ((size_t)n_ * 1024 + d0 + srow0 + 64) * 256 + kc_ * 64 + sch * 8); \
            ry0 = *(const uint4*)(ys + (size_t)(tok0 + srow0) * 1024 + n_ * 256 + kc_ * 64 + sch * 8); \
            ry1 = *(const uint4*)(ys + (size_t)(tok0 + srow0 + 64) * 1024 + n_ * 256 + kc_ * 64 + sch * 8); } while (0)
#define MG_SSTORE(buf_) do { bf16* wl_ = (bf16*)(lds + (buf_) * 2 * MG_TILE_BYTES); bf16* yl_ = (bf16*)(lds + (buf_) * 2 * MG_TILE_BYTES + MG_TILE_BYTES); \
            *(uint4*)(wl_ + srow0 * MG_P + sch * 8) = rw0; *(uint4*)(wl_ + (srow0 + 64) * MG_P + sch * 8) = rw1; \
            *(uint4*)(yl_ + srow0 * MG_P + sch * 8) = ry0; *(uint4*)(yl_ + (srow0 + 64) * MG_P + sch * 8) = ry1; } while (0)
        __syncthreads();
        MG_GLOAD(0); MG_SSTORE(0);
        __syncthreads();
#pragma unroll 1
        for (int st = 0; st < 16; ++st) {
            const int buf = st & 1;
            if (st + 1 < 16) MG_GLOAD(st + 1);
            const bf16* wl = (const bf16*)(lds + buf * 2 * MG_TILE_BYTES); const bf16* yl = (const bf16*)(lds + buf * 2 * MG_TILE_BYTES + MG_TILE_BYTES);
#pragma unroll
            for (int ks = 0; ks < 4; ++ks) {
                const bf16x8_t bq = *(const bf16x8_t*)(yl + (32 * wt + r32) * MG_P + 16 * ks + 8 * hi);
                const bf16x8_t a0 = *(const bf16x8_t*)(wl + (64 * wd + r32) * MG_P + 16 * ks + 8 * hi);
                const bf16x8_t a1 = *(const bf16x8_t*)(wl + (64 * wd + 32 + r32) * MG_P + 16 * ks + 8 * hi);
                acc[0] = __builtin_amdgcn_mfma_f32_32x32x16_bf16(a0, bq, acc[0], 0, 0, 0);
                acc[1] = __builtin_amdgcn_mfma_f32_32x32x16_bf16(a1, bq, acc[1], 0, 0, 0);
            }
            if ((st & 3) == 3) {
                const int n = st >> 2;
                const bf16* gp = P + (size_t)(tok0 + 32 * wt + r32) * NP + C_G + n * 1024 + d0 + 64 * wd + 4 * hi;
#pragma unroll
                for (int dt = 0; dt < 2; ++dt)
#pragma unroll
                    for (int g = 0; g < 4; ++g) {
                        const uint2 gv = *(const uint2*)(gp + 32 * dt + 8 * g);
                        const float g0 = __uint_as_float(gv.x << 16), g1 = __uint_as_float(gv.x & 0xffff0000u), g2 = __uint_as_float(gv.y << 16), g3 = __uint_as_float(gv.y & 0xffff0000u);
                        mer[dt][4 * g + 0] += acc[dt][4 * g + 0] / (1.f + __expf(-g0)); mer[dt][4 * g + 1] += acc[dt][4 * g + 1] / (1.f + __expf(-g1));
                        mer[dt][4 * g + 2] += acc[dt][4 * g + 2] / (1.f + __expf(-g2)); mer[dt][4 * g + 3] += acc[dt][4 * g + 3] / (1.f + __expf(-g3));
                    }
#pragma unroll
                for (int r = 0; r < 16; ++r) { acc[0][r] = 0.f; acc[1][r] = 0.f; }
            }
            if (st + 1 < 16) MG_SSTORE(buf ^ 1);
            __syncthreads();
        }
        bf16* mp = merged + (size_t)(tok0 + 32 * wt + r32) * 1024 + d0 + 64 * wd + 4 * hi;
#pragma unroll
        for (int dt = 0; dt < 2; ++dt)
#pragma unroll
            for (int g = 0; g < 4; ++g)
                *(uint2*)(mp + 32 * dt + 8 * g) = make_uint2(cvtpk(mer[dt][4 * g], mer[dt][4 * g + 1]), cvtpk(mer[dt][4 * g + 2], mer[dt][4 * g + 3]));
    }
}
#define LAS __attribute__((address_space(3)))
#define XB_TMO      128
#define XB_XCNT(j)  (256  + 64 * (j))
#define XB_XSUB(j)  (1280 + 64 * (j))
#define XB_XGEN(j)  (2304 + 64 * (j))
#define XB_TOP      3328
#define XB_TOPGEN   3392
#define XCD_BAR_WORDS 3456
#define XB_SPIN_CAP (1u << 18)

__device__ __forceinline__ unsigned xb_ld(unsigned* p)              { return __hip_atomic_load(p, __ATOMIC_RELAXED, __HIP_MEMORY_SCOPE_AGENT); }
__device__ __forceinline__ unsigned xb_add(unsigned* p, unsigned v) { return __hip_atomic_fetch_add(p, v, __ATOMIC_RELAXED, __HIP_MEMORY_SCOPE_AGENT); }
__device__ __forceinline__ unsigned xb_xcc_id() { return (unsigned)__builtin_amdgcn_s_getreg((3 << 11) | 20) & 0xFu; }
#define XB_SPIN(cond, bar) do { unsigned _sp = 0; while (cond) { __builtin_amdgcn_s_sleep(1); \
    if ((++_sp & 255u) == 0u) { if (xb_ld(&(bar)[XB_TMO])) break; if (_sp > XB_SPIN_CAP) { atomicAdd(&(bar)[XB_TMO], 1u); break; } } } } while (0)

struct XcdBarrier {
    unsigned* bar; unsigned x;
    volatile LAS unsigned* st;
};

__device__ __forceinline__ XcdBarrier xcd_barrier_post(unsigned* bar, volatile LAS unsigned* st) {
    XcdBarrier b; b.bar = bar; b.x = xb_xcc_id(); b.st = st;
    if (threadIdx.x == 0) (void)xb_add(&bar[XB_XCNT(b.x)], 1u);
    return b;
}
__device__ __forceinline__ void xcd_barrier_complete(unsigned* bar, unsigned x, unsigned& nloc, unsigned& nx) {
    const unsigned G = gridDim.x * gridDim.y * gridDim.z;
    unsigned sum, cnt, mine, sp = 0u;
    for (;;) {
        sum = 0u; cnt = 0u; mine = 0u;
#pragma unroll
        for (unsigned j = 0; j < 16; ++j) { const unsigned c = xb_ld(&bar[XB_XCNT(j)]); sum += c; cnt += (c > 0u) ? 1u : 0u; mine = (j == x) ? c : mine; }
        if (sum == G) break;
        __builtin_amdgcn_s_sleep(1);
        if ((++sp & 255u) == 0u) { if (xb_ld(&bar[XB_TMO])) break; if (sp > XB_SPIN_CAP) { atomicAdd(&bar[XB_TMO], 1u); break; } }
    }
    nloc = mine > 0u ? mine : 1u; nx = cnt > 0u ? cnt : 1u;
}

__device__ __forceinline__ void xcd_barrier(const XcdBarrier& b, int wv_) {
    asm volatile("s_waitcnt vmcnt(0)" ::: "memory");
    __syncthreads();
    if (wv_ == 0 && LANEID() == 0) {
        unsigned* bar = b.bar;
        __builtin_amdgcn_s_waitcnt(0);
        unsigned nloc = b.st[0], nx = b.st[1];
        if (nloc == 0u) { xcd_barrier_complete(bar, b.x, nloc, nx); b.st[0] = nloc; b.st[1] = nx; }
        const unsigned old = xb_add(&bar[XB_XSUB(b.x)], 1u);
        const unsigned gen = old / nloc;
        if (old + 1u == (gen + 1u) * nloc) {
            __builtin_amdgcn_fence(__ATOMIC_RELEASE, "agent");
            asm volatile("s_waitcnt vmcnt(0)" ::: "memory");
            const unsigned og = xb_add(&bar[XB_TOP], 1u);
            const unsigned tg = og / nx;
            if (og + 1u == (tg + 1u) * nx) xb_add(&bar[XB_TOPGEN], 1u);
            else XB_SPIN(xb_ld(&bar[XB_TOPGEN]) == tg, bar);
            __builtin_amdgcn_fence(__ATOMIC_ACQUIRE, "agent");
            xb_add(&bar[XB_XGEN(b.x)], 1u);
            asm volatile("s_waitcnt vmcnt(0)" ::: "memory");
        } else {
            XB_SPIN(xb_ld(&bar[XB_XGEN(b.x)]) == gen, bar);
            __builtin_amdgcn_fence(__ATOMIC_ACQUIRE, "agent");
            asm volatile("s_waitcnt vmcnt(0)" ::: "memory");
        }
    }
    __syncthreads();
}

enum { PH_PRO = 0, PH_GIN, PH_INDEX, PH_ATTN, PH_MERGE, PH_GOUT, PH_LN1, PH_GQ, PH_ROUTE, PH_PEER };
template <int PH> __device__ __forceinline__ void run_phase(int WV_, const Params& p_unused, int l, unsigned char* lds_raw) {
    size_t kaoff_ = 0; asm volatile("" : "+s"(kaoff_));
    typedef const __attribute__((address_space(4))) char* kaptr_t;
    const __attribute__((address_space(4))) Params& p = *(const __attribute__((address_space(4))) Params*)((kaptr_t)__builtin_amdgcn_kernarg_segment_ptr() + kaoff_);
    float* sm = (float*)lds_raw;
    size_t wsoff_ = 0; asm volatile("" : "+s"(wsoff_));
    unsigned char* ws = p.ws + wsoff_;
    float* hbuf = p.out;
    bf16* hb = (bf16*)(ws + WS_HB);
    bf16* P = (bf16*)(ws + WS_P);
    bf16* ys = (bf16*)(ws + WS_YS);
    bf16* mrg = (bf16*)(ws + WS_MRG);
    float* mix = (float*)(ws + WS_MIX);
    float* qb = (float*)(ws + WS_Q);
    unsigned char* mask = ws + WS_MASK;
    int* eid = (int*)(ws + WS_EID);
    float* gate = (float*)(ws + WS_GATE);
    float* kmean = (float*)(ws + WS_KMEAN);
    const float* hin = (l == 0) ? p.in[0] : hbuf;
    if (PH == PH_PRO) { Params pc; for (int i = 0; i < 13; ++i) pc.in[i] = p.in[i]; pc.out = p.out; pc.ws = ws;
        prologue_phase(WV_, pc, sm); convert_tables(WV_, pc);
        for (int i = LBID() * NTHR + LTID(WV_); i < DEPTH_ * 8 * 2 * 128 * 64 / 4; i += LGRID() * NTHR) { const float4 v = ((const float4*)p.in[8])[i]; ((uint2*)(ws + WS_SKB))[i] = make_uint2(pk2(v.x, v.y), pk2(v.z, v.w)); } if (LBID() < 2) build_unit_table((unsigned*)(ws + WS_CTL) + 1024, LBID() * NTHR + LTID(WV_)); }
    else if (PH == PH_GIN) {
        pg8::Gemm g{hb, (const bf16*)(ws + WS_WIN_T + l * WIN_T_BYTES), T_, NP, 1024};
        pg8::StaticOrder S; S.init(T_, NP, (int)LGRID(), (int)LBID());
        pg8::EpiBf16<0> E{P, NP, nullptr, 0, 0, 1.f};
        pg8::gemm_phase<pg8::EpiBf16<0>, pg8::StaticOrder, true, true>(WV_, (PG8_LAS unsigned char*)lds_raw, g, S, E);
    }
    else if (PH == PH_INDEX) index_fast_phase(WV_, P, mask, kmean, (float*)(ws + WS_YS), lds_raw);
    else if (PH == PH_ATTN) attn_fast_phase(WV_, P, mask, kmean, p.in[4] + l * 4, ys, (const unsigned*)(ws + WS_CTL) + 1024, (unsigned*)(ws + WS_CTL) + 64 * l, lds_raw);
    else if (PH == PH_MERGE) merge_fast_phase(WV_, P, ys, (const bf16*)(ws + WS_WBR_T) + (size_t)l * 4 * 1024 * 256, mrg, lds_raw);
    else if (PH == PH_GOUT) {
        pg8::Gemm g{mrg, (const bf16*)(ws + WS_WOUT_T) + (size_t)l * 1024 * 1024, T_, 1024, 1024};
        pg8::StaticOrder S; S.init(T_, 1024, (int)LGRID(), (int)LBID());
        pg8::EpiF32 E{mix, 1024};
        pg8::gemm_phase<pg8::EpiF32, pg8::StaticOrder, true, true>(WV_, (PG8_LAS unsigned char*)lds_raw, g, S, E);
    }
    else if (PH == PH_LN1) ln1_phase(WV_, hin, mix, p.in[5] + l * 1024, p.in[6] + l * 1024, hbuf, hb);
    else if (PH == PH_GQ) {
        pg8::Gemm g{hb, (const bf16*)(ws + WS_WQ_T) + (size_t)l * 1024 * 1024, T_, 1024, 1024};
        pg8::StaticOrder S; S.init(T_, 1024, (int)LGRID(), (int)LBID());
        pg8::EpiBf16<0> E{(bf16*)qb, 1024, nullptr, 0, 0, 1.f};
        pg8::gemm_phase<pg8::EpiBf16<0>, pg8::StaticOrder, true, true>(WV_, (PG8_LAS unsigned char*)lds_raw, g, S, E);
    }
    else if (PH == PH_ROUTE) route_fast_phase(WV_, (const bf16*)qb, (const bf16*)(ws + WS_SKB) + (size_t)l * 8 * 2 * 128 * 64, eid, gate, lds_raw);
    else peer_fast_phase(WV_, hbuf, hb, eid, gate, ws + WS_UV + (size_t)l * 32 * MiB, p.in[11] + l * 1024, p.in[12] + l * 1024, lds_raw);
}

constexpr int CW_BAR = 4096;
constexpr int LDS_BARST = LDS_BYTES - 16;
__global__ void __launch_bounds__(NTHR, 2) mk_fwd(Params p) {
    extern __shared__ __attribute__((aligned(16))) unsigned char lds_raw[];
    cg::grid_group grid = cg::this_grid();
    const int WV_ = __builtin_amdgcn_readfirstlane((int)threadIdx.x >> 6);
    { volatile LAS unsigned* bst0 = (volatile LAS unsigned*)((LAS unsigned char*)lds_raw + LDS_BARST); if (threadIdx.x < 4) bst0[threadIdx.x] = 0u; }
    __syncthreads();
    volatile LAS unsigned* bst = (volatile LAS unsigned*)((LAS unsigned char*)lds_raw + LDS_BARST);
    (void)xcd_barrier_post((unsigned*)(p.ws + WS_CTL) + CW_BAR, bst);
#define GRID_BAR() do { XcdBarrier b_; b_.bar = (unsigned*)(p.ws + WS_CTL) + CW_BAR; b_.x = xb_xcc_id(); b_.st = (volatile LAS unsigned*)((LAS unsigned char*)lds_raw + LDS_BARST); xcd_barrier(b_, WV_); } while (0)
    run_phase<PH_PRO>(WV_, p, 0, lds_raw);
    grid.sync();
#pragma unroll 1
    for (int l = 0; l < DEPTH_; ++l) {
        run_phase<PH_GIN>(WV_, p, l, lds_raw); GRID_BAR();
        run_phase<PH_INDEX>(WV_, p, l, lds_raw); GRID_BAR();
        run_phase<PH_ATTN>(WV_, p, l, lds_raw); GRID_BAR();
        run_phase<PH_MERGE>(WV_, p, l, lds_raw); GRID_BAR();
        run_phase<PH_GOUT>(WV_, p, l, lds_raw); GRID_BAR();
        run_phase<PH_LN1>(WV_, p, l, lds_raw); GRID_BAR();
        run_phase<PH_GQ>(WV_, p, l, lds_raw); GRID_BAR();
        run_phase<PH_ROUTE>(WV_, p, l, lds_raw); GRID_BAR();
        run_phase<PH_PEER>(WV_, p, l, lds_raw); if (l + 1 < DEPTH_) GRID_BAR();
    }
}

extern "C" void kernel_launch(void* const* d_in, const int* in_sizes, int n_in, void* d_out, int out_size, void* d_ws, size_t ws_size, hipStream_t stream) {
    if (n_in != 13 || ws_size < WS_END) { fprintf(stderr, "kernel_launch: unexpected n_in %d / ws_size %zu; nothing launched\n", n_in, ws_size); return; }
    static int grid_blocks = 0;
    if (grid_blocks == 0) {
        int dev = 0, cus = 0, per_cu = 0;
        (void)hipGetDevice(&dev);
        (void)hipDeviceGetAttribute(&cus, hipDeviceAttributeMultiprocessorCount, dev);
        (void)hipFuncSetAttribute((const void*)mk_fwd, hipFuncAttributeMaxDynamicSharedMemorySize, LDS_BYTES);
        (void)hipOccupancyMaxActiveBlocksPerMultiprocessor(&per_cu, (const void*)mk_fwd, NTHR, LDS_BYTES);
        if (per_cu < 1) fprintf(stderr, "kernel_launch: occupancy query reports %d\n", per_cu);
        grid_blocks = cus;
    }
    Params p{};
    for (int i = 0; i < 13; ++i) p.in[i] = (const float*)d_in[i];
    p.out = (float*)d_out; p.ws = (unsigned char*)d_ws;
    (void)hipMemsetAsync(d_ws, 0, 65536, stream);
    void* args[] = {&p};
    hipError_t e = hipLaunchCooperativeKernel((const void*)mk_fwd, dim3(grid_blocks), dim3(NTHR), args, LDS_BYTES, stream);
    if (e != hipSuccess) fprintf(stderr, "cooperative launch failed: %s (grid %d)\n", hipGetErrorString(e), grid_blocks);
}
```

```cpp
#include <hip/hip_runtime.h>
#include <cstdio>
#include <cstdint>
#include <hip/hip_cooperative_groups.h>
namespace cg = cooperative_groups;

__device__ __forceinline__ int LANEID() { int l; asm volatile("v_mbcnt_lo_u32_b32 %0, -1, 0\n\tv_mbcnt_hi_u32_b32 %0, -1, %0" : "=v"(l)); return l; }
__device__ __forceinline__ int LTID(int wv) { return (wv << 6) | LANEID(); }
__device__ __forceinline__ int LBID() { int t = blockIdx.x; asm volatile("" : "+s"(t)); return t; }
__device__ __forceinline__ int LGRID() { int t = gridDim.x; asm volatile("" : "+s"(t)); return t; }
namespace pg8 {
#define PG8_LAS __attribute__((address_space(3)))
typedef unsigned short bf16_t;
typedef short bf16x8 __attribute__((ext_vector_type(8)));
typedef float f32x4 __attribute__((ext_vector_type(4)));
typedef unsigned u32x4 __attribute__((ext_vector_type(4)));
constexpr int BM = 256, BK = 64, HALF = 128, HTB = HALF * BK * 2  , STAGE_BYTES = 8 * HTB, NXCD = 8, WGM = 8;

__host__ __device__ __forceinline__ int lds_byte(int r, int c) { const int st = (r >> 4) * 2 + (c >> 5), rr = r & 15, cc = c & 31, ob = rr * 64 + cc * 2; return st * 1024 + (ob ^ (((ob >> 9) & 1) << 5)); }
__host__ __device__ __forceinline__ void stage_rc(int b, int& R, int& C) { const int st = b / 1024, sb = b % 1024, swz = sb ^ (((sb >> 9) & 1) << 5); R = (st >> 1) * 16 + swz / 64; C = (st & 1) * 32 + (swz % 64) / 2; }
__host__ __device__ __forceinline__ int perm32(int rho) { const int n = rho >> 4, i = rho & 15; return 8 * (i >> 2) + 4 * n + (i & 3); }

struct Unit { int pm, pn; };
struct Gemm { const bf16_t* A; const bf16_t* Bt; int M, N, K; };

struct StaticOrder {
    int nM, nN, nwg, G, c;
    __host__ __device__ void init(int M, int N, int G_, int c_) { nM = M / BM; nN = N / BM; nwg = nM * nN; G = G_; c = c_; }
    __host__ __device__ bool next(int i, Unit& u) const {
        const long L = (long)i * G + c; if (L >= nwg) return false;
        int wgid = (int)L; { const int q = nwg / NXCD, r = nwg % NXCD, xcd = wgid % NXCD, off = wgid / NXCD; wgid = (xcd < r ? xcd * (q + 1) : r * (q + 1) + (xcd - r) * q) + off; }
        const int nig = WGM * nN, gid = wgid / nig, fm = gid * WGM, gsz = (nM - fm) < WGM ? (nM - fm) : WGM;
        u.pm = fm + ((wgid % nig) % gsz); u.pn = (wgid % nig) / gsz; return true;
    }
    __device__ __forceinline__ void a_ready(const Unit&) const {}
    __device__ __forceinline__ void done(const Unit&) const {}
};

__device__ __forceinline__ unsigned cvt_pk_bf16(float lo, float hi) { unsigned r; asm volatile("v_cvt_pk_bf16_f32 %0, %1, %2" : "=v"(r) : "v"(lo), "v"(hi)); return r; }
typedef float f32x2 __attribute__((ext_vector_type(2)));
__device__ __forceinline__ f32x2 gelu_pk(f32x2 v) {
    const f32x2 av = __builtin_elementwise_abs(v), d = av * 0.2316418882f + 1.0f;
    f32x2 t; t.x = __builtin_amdgcn_rcpf(d.x); t.y = __builtin_amdgcn_rcpf(d.y);
    f32x2 q = t * 0.5307027145f + (-0.7265760135f); q = q * t + 0.7107068705f; q = q * t + (-0.142248368f); q = q * t + 0.127414796f; q = q * t;
    const f32x2 s = (v * v) * (-0.72134752044f);
    f32x2 e; e.x = __builtin_amdgcn_exp2f(s.x); e.y = __builtin_amdgcn_exp2f(s.y);
    const f32x2 m = v * (q * e), r = v - m;
    f32x2 o; o.x = v.x < 0.f ? m.x : r.x; o.y = v.y < 0.f ? m.y : r.y; return o;
}

template <int ACT  > struct EpiBf16 {
    static constexpr bool PERM = true, AFTER_DRAIN = false; static_assert(ACT == 0 || ACT == 1, "EpiBf16: ACT is 0 (none) or 1 (gelu_pk)");
    bf16_t* O; int ldc; const float* bias; int split_cols; size_t split_stride; float scale0;
    __device__ __forceinline__ void operator()(const f32x4 (&acc)[2][2][4][2], const Unit& u, int wr, int wc, int fr, int fq) const {
        { int ln_ = LANEID(); asm volatile("" : "+v"(ln_)); fr = ln_ & 15; fq = ln_ >> 4; }
        const int row0 = u.pm * BM + wr * 64 + fr; int colt = u.pn * BM; bf16_t* base = O;
        float sc = 1.f; if (split_cols) { const int t = colt / split_cols; base += (size_t)t * split_stride; colt -= t * split_cols; if (t == 0) sc = scale0; }
        const int col0 = colt + wc * 32 + 8 * fq, bcol0 = u.pn * BM + wc * 32 + 8 * fq;
        f32x4 bv[2][2];
#pragma unroll
        for (int bj = 0; bj < 2; ++bj)
#pragma unroll
            for (int n = 0; n < 2; ++n) bv[bj][n] = bias ? *(const f32x4*)(bias + bcol0 + bj * HALF + 4 * n) : (f32x4){0.f, 0.f, 0.f, 0.f};
#pragma unroll
        for (int ai = 0; ai < 2; ++ai)
#pragma unroll
            for (int m = 0; m < 4; ++m) { bf16_t* rowp = base + (size_t)(row0 + ai * HALF + m * 16) * ldc + col0;
#pragma unroll
                for (int bj = 0; bj < 2; ++bj) { f32x4 v0 = acc[ai][bj][m][0] + bv[bj][0], v1 = acc[ai][bj][m][1] + bv[bj][1];
                    if (ACT == 1) { f32x2 a = gelu_pk((f32x2){v0[0], v0[1]}), b = gelu_pk((f32x2){v0[2], v0[3]}), c = gelu_pk((f32x2){v1[0], v1[1]}), d = gelu_pk((f32x2){v1[2], v1[3]});
                        v0 = (f32x4){a.x, a.y, b.x, b.y}; v1 = (f32x4){c.x, c.y, d.x, d.y}; }
                    v0 = v0 * sc; v1 = v1 * sc; u32x4 w; w.x = cvt_pk_bf16(v0[0], v0[1]); w.y = cvt_pk_bf16(v0[2], v0[3]); w.z = cvt_pk_bf16(v1[0], v1[1]); w.w = cvt_pk_bf16(v1[2], v1[3]);
                    *(u32x4*)(rowp + bj * HALF) = w; } }
    }
};
template <class Epi, class Sched, bool ALIGN_EPI = false, bool SP2 = false>
__device__ __forceinline__ void gemm_phase(int WV_, PG8_LAS unsigned char* lds, const Gemm g, const Sched& S, const Epi& E) {
    const int tid = LTID(WV_), wid = __builtin_amdgcn_readfirstlane(tid >> 6), lane = tid & 63, wr = wid >> 2, wc = wid & 3, fr = lane & 15, fq = lane >> 4;
    const int K = g.K, nt = K / BK;
    unsigned voffA[2], voffB[2];
#pragma unroll
    for (int i = 0; i < 2; ++i) { int R, C; stage_rc(tid * 16 + i * 8192, R, C); const int Rb = Epi::PERM ? ((R & ~31) + perm32(R & 31)) : R;
        voffA[i] = (unsigned)(R * K + C) * 2u; voffB[i] = (unsigned)(Rb * K + C) * 2u; }
    const size_t kstep = (size_t)(BK * 2);
    const size_t hstep = (size_t)HALF * K * 2;
    const size_t tstep = 2 * hstep;
    const unsigned ldsw = (unsigned)wid * 1024u;
    const int aoff = lds_byte(wr * 64 + fr, fq * 8), boff = lds_byte(wc * 32 + fr, fq * 8);
#define PG8_SA(b, h) (((b) * 2 + (h)) * HTB)
#define PG8_SB(b, h) ((4 + (b) * 2 + (h)) * HTB)
#define PG8_STAGE(bufoff, gbase, voff) do { _Pragma("unroll") for (int _i = 0; _i < 2; ++_i) \
        __builtin_amdgcn_global_load_lds((const unsigned*)((const char*)(gbase) + (voff)[_i]), (PG8_LAS unsigned*)(lds + (bufoff) + ldsw + _i * 8192), 16, 0, 0); } while (0)
#define PG8_LDA(dst, b, h) do { _Pragma("unroll") for (int m = 0; m < 4; ++m) _Pragma("unroll") for (int k = 0; k < 2; ++k) dst[m][k] = *(const PG8_LAS bf16x8*)(lds + PG8_SA(b, h) + aoff + m * 2048 + k * 1024); } while (0)
#define PG8_LDB(dst, b, h) do { _Pragma("unroll") for (int n = 0; n < 2; ++n) _Pragma("unroll") for (int k = 0; k < 2; ++k) dst[n][k] = *(const PG8_LAS bf16x8*)(lds + PG8_SB(b, h) + boff + n * 2048 + k * 1024); } while (0)
#define PG8_MMA(ai, bj, At, Bt) do { __builtin_amdgcn_s_setprio(1); _Pragma("unroll") for (int m = 0; m < 4; ++m) _Pragma("unroll") for (int n = 0; n < 2; ++n) _Pragma("unroll") for (int k = 0; k < 2; ++k) \
        acc[ai][bj][m][n] = __builtin_amdgcn_mfma_f32_16x16x32_bf16(Bt[n][k], At[m][k], acc[ai][bj][m][n], 0, 0, 0); __builtin_amdgcn_s_setprio(0); } while (0)
#define PG8_WAIT_V(n) asm volatile("s_waitcnt vmcnt(" #n ")" ::: "memory")
#define PG8_WAIT_L(n) asm volatile("s_waitcnt lgkmcnt(" #n ")" ::: "memory")
#define PG8_BAR __builtin_amdgcn_s_barrier()
#define PG8_SCHED __builtin_amdgcn_sched_barrier(0)
    Unit cur, nxt; int ui = 0;
    if (!S.next(0, cur)) return;
    f32x4 acc[2][2][4][2];
#pragma unroll
    for (int a = 0; a < 2; ++a)
#pragma unroll
        for (int b = 0; b < 2; ++b)
#pragma unroll
            for (int m = 0; m < 4; ++m)
#pragma unroll
                for (int n = 0; n < 2; ++n) acc[a][b][m][n] = (f32x4){0.f, 0.f, 0.f, 0.f};
    bf16x8 At[4][2], B0[2][2], B1[2][2];
    const char* cA = (const char*)g.A + (size_t)cur.pm * tstep; const char* cB = (const char*)g.Bt + (size_t)cur.pn * tstep;
    S.a_ready(cur);
    if constexpr (SP2) {
        PG8_STAGE(PG8_SB(0, 0), cB, voffB); PG8_STAGE(PG8_SB(0, 1), cB + hstep, voffB); PG8_STAGE(PG8_SA(0, 0), cA, voffA); PG8_STAGE(PG8_SA(0, 1), cA + hstep, voffA);
        if (wr == 1) PG8_BAR;
        PG8_WAIT_V(2); PG8_BAR;
        PG8_STAGE(PG8_SB(1, 0), cB + kstep, voffB); PG8_STAGE(PG8_SA(1, 0), cA + kstep, voffA); PG8_STAGE(PG8_SB(1, 1), cB + hstep + kstep, voffB);
        PG8_WAIT_V(6); PG8_BAR;
    } else {
        PG8_STAGE(PG8_SB(0, 0), cB, voffB); PG8_STAGE(PG8_SA(0, 0), cA, voffA); PG8_STAGE(PG8_SB(0, 1), cB + hstep, voffB); PG8_STAGE(PG8_SA(0, 1), cA + hstep, voffA);
        if (wr == 1) PG8_BAR;
        PG8_WAIT_V(4); PG8_BAR;
        PG8_STAGE(PG8_SB(1, 0), cB + kstep, voffB); PG8_STAGE(PG8_SA(1, 0), cA + kstep, voffA); PG8_STAGE(PG8_SB(1, 1), cB + hstep + kstep, voffB);
        PG8_WAIT_V(6); PG8_BAR;
    }
    for (;;) {
        const bool has_next = S.next(ui + 1, nxt);
        const char* nA = has_next ? (const char*)g.A + (size_t)nxt.pm * tstep : cA; const char* nB = has_next ? (const char*)g.Bt + (size_t)nxt.pn * tstep : cB;
        for (int t = 0; t < nt; t += 2) {
            const bool last = (t == nt - 2);
            const char* a1 = cA + (size_t)(t + 1) * kstep;
            const char* a2 = last ? nA : cA + (size_t)(t + 2) * kstep; const char* b2 = last ? nB : cB + (size_t)(t + 2) * kstep;
            const char* a3 = a2 + kstep; const char* b3 = b2 + kstep;
            if (last && has_next) S.a_ready(nxt);
            if constexpr (SP2) {
            PG8_LDB(B0, 0, 0); PG8_LDB(B1, 0, 1); PG8_SCHED; PG8_LDA(At, 0, 0); PG8_STAGE(PG8_SA(1, 1), a1 + hstep, voffA);
            PG8_WAIT_V(8); PG8_WAIT_L(0); PG8_BAR; PG8_MMA(0, 0, At, B0); PG8_MMA(0, 1, At, B1); PG8_BAR; PG8_SCHED;
            PG8_LDA(At, 0, 1); PG8_STAGE(PG8_SB(0, 0), b2, voffB); PG8_STAGE(PG8_SB(0, 1), b2 + hstep, voffB); PG8_STAGE(PG8_SA(0, 0), a2, voffA);
            PG8_WAIT_V(8); PG8_WAIT_L(0); PG8_BAR; PG8_MMA(1, 0, At, B0); PG8_MMA(1, 1, At, B1); PG8_BAR; PG8_SCHED;
            PG8_LDB(B0, 1, 0); PG8_LDB(B1, 1, 1); PG8_SCHED; PG8_LDA(At, 1, 0); PG8_STAGE(PG8_SA(0, 1), a2 + hstep, voffA);
            PG8_WAIT_V(8); PG8_WAIT_L(0); PG8_BAR; PG8_MMA(0, 0, At, B0); PG8_MMA(0, 1, At, B1); PG8_BAR; PG8_SCHED;
            PG8_LDA(At, 1, 1); PG8_STAGE(PG8_SB(1, 0), b3, voffB); PG8_STAGE(PG8_SB(1, 1), b3 + hstep, voffB); PG8_STAGE(PG8_SA(1, 0), a3, voffA);
            PG8_WAIT_V(8); PG8_WAIT_L(0); PG8_BAR; PG8_MMA(1, 0, At, B0); PG8_MMA(1, 1, At, B1); PG8_BAR; PG8_SCHED;
            } else {
            PG8_LDB(B0, 0, 0); PG8_SCHED; PG8_LDA(At, 0, 0); PG8_STAGE(PG8_SA(1, 1), a1 + hstep, voffA);
            PG8_WAIT_L(8); PG8_BAR; PG8_WAIT_L(0); PG8_MMA(0, 0, At, B0); PG8_BAR; PG8_SCHED;
            PG8_LDB(B1, 0, 1); PG8_STAGE(PG8_SB(0, 0), b2, voffB);
            PG8_BAR; PG8_WAIT_L(0); PG8_MMA(0, 1, At, B1); PG8_BAR;
            PG8_LDA(At, 0, 1); PG8_STAGE(PG8_SA(0, 0), a2, voffA);
            PG8_BAR; PG8_WAIT_L(0); PG8_MMA(1, 0, At, B0); PG8_BAR; PG8_SCHED;
            PG8_STAGE(PG8_SB(0, 1), b2 + hstep, voffB);
            PG8_WAIT_V(6); PG8_BAR; PG8_MMA(1, 1, At, B1); PG8_BAR;
            PG8_LDB(B0, 1, 0); PG8_SCHED; PG8_LDA(At, 1, 0); PG8_STAGE(PG8_SA(0, 1), a2 + hstep, voffA);
            PG8_WAIT_L(8); PG8_BAR; PG8_WAIT_L(0); PG8_MMA(0, 0, At, B0); PG8_BAR; PG8_SCHED;
            PG8_LDB(B1, 1, 1); PG8_STAGE(PG8_SB(1, 0), b3, voffB);
            PG8_BAR; PG8_WAIT_L(0); PG8_MMA(0, 1, At, B1); PG8_BAR;
            PG8_LDA(At, 1, 1); PG8_STAGE(PG8_SA(1, 0), a3, voffA);
            PG8_BAR; PG8_WAIT_L(0); PG8_MMA(1, 0, At, B0); PG8_BAR; PG8_SCHED;
            PG8_STAGE(PG8_SB(1, 1), b3 + hstep, voffB);
            PG8_WAIT_V(6); PG8_BAR; PG8_MMA(1, 1, At, B1); PG8_BAR;
            }
        }
        if constexpr (ALIGN_EPI) { if (wr == 0) PG8_BAR; }
        if constexpr (!Epi::AFTER_DRAIN) { E(acc, cur, wr, wc, fr, fq); S.done(cur); }
        if (!has_next) break;
#pragma unroll
        for (int a = 0; a < 2; ++a)
#pragma unroll
            for (int b = 0; b < 2; ++b)
#pragma unroll
                for (int m = 0; m < 4; ++m)
#pragma unroll
                    for (int n = 0; n < 2; ++n) acc[a][b][m][n] = (f32x4){0.f, 0.f, 0.f, 0.f};
        cur = nxt; cA = nA; cB = nB; ++ui;
        if constexpr (ALIGN_EPI) { if (wr == 1) PG8_BAR; }
    }
    PG8_WAIT_V(0);
    if constexpr (!ALIGN_EPI) { if (wr == 0) PG8_BAR; }
    PG8_BAR;
    if constexpr (Epi::AFTER_DRAIN) { E.fused(acc, cur, wr, wc, fr, fq, lds, wid, lane); S.done(cur); }
#undef PG8_SA
#undef PG8_SB
#undef PG8_STAGE
#undef PG8_LDA
#undef PG8_LDB
#undef PG8_MMA
#undef PG8_WAIT_V
#undef PG8_WAIT_L
#undef PG8_BAR
#undef PG8_SCHED
}
}
namespace pg8 {
struct EpiF32 {
    static constexpr bool PERM = false, AFTER_DRAIN = false;
    float* O; int ldc;
    __device__ __forceinline__ void operator()(const f32x4 (&acc)[2][2][4][2], const Unit& u, int wr, int wc, int fr, int fq) const {
        { int ln_ = LANEID(); asm volatile("" : "+v"(ln_)); fr = ln_ & 15; fq = ln_ >> 4; }
        const int row0 = u.pm * BM + wr * 64 + fr, col0 = u.pn * BM + wc * 32 + 4 * fq;
#pragma unroll
        for (int ai = 0; ai < 2; ++ai)
#pragma unroll
            for (int m = 0; m < 4; ++m) { float* rowp = O + (size_t)(row0 + ai * HALF + m * 16) * ldc + col0;
#pragma unroll
                for (int bj = 0; bj < 2; ++bj)
#pragma unroll
                    for (int n = 0; n < 2; ++n) *(f32x4*)(rowp + bj * HALF + n * 16) = acc[ai][bj][m][n]; }
    }
};
struct EpiResY {
    static constexpr bool PERM = false, AFTER_DRAIN = false;
    const float* hin; float* yout; bf16_t* yb; float* stats; float alpha;
    __device__ __forceinline__ void operator()(const f32x4 (&acc)[2][2][4][2], const Unit& u, int wr, int wc, int fr, int fq) const {
        { int ln_ = LANEID(); asm volatile("" : "+v"(ln_)); fr = ln_ & 15; fq = ln_ >> 4; }
        const int row0 = u.pm * BM + wr * 64 + fr, col0 = u.pn * BM + wc * 32 + 4 * fq;
#pragma unroll
        for (int ai = 0; ai < 2; ++ai)
#pragma unroll
            for (int m = 0; m < 4; ++m) {
                const int row = row0 + ai * HALF + m * 16;
                float s = 0.f, s2 = 0.f;
#pragma unroll
                for (int bj = 0; bj < 2; ++bj)
#pragma unroll
                    for (int n = 0; n < 2; ++n) {
                        const size_t off = (size_t)row * 1024 + col0 + bj * HALF + n * 16;
                        const f32x4 hv = *(const f32x4*)(hin + off);
                        const f32x4 y = hv * alpha + acc[ai][bj][m][n];
                        *(f32x4*)(yout + off) = y;
                        typedef unsigned u32x2v __attribute__((ext_vector_type(2)));
                        u32x2v w; w.x = cvt_pk_bf16(y[0], y[1]); w.y = cvt_pk_bf16(y[2], y[3]);
                        *(u32x2v*)(yb + off) = w;
                        s += (y[0] + y[1]) + (y[2] + y[3]); s2 += (y[0] * y[0] + y[1] * y[1]) + (y[2] * y[2] + y[3] * y[3]);
                    }
                s += __shfl_xor(s, 16); s += __shfl_xor(s, 32); s2 += __shfl_xor(s2, 16); s2 += __shfl_xor(s2, 32);
                if (fq == 0) { atomicAdd(stats + 2 * (size_t)row, s); atomicAdd(stats + 2 * (size_t)row + 1, s2); }
            }
    }
};
struct EpiLnFold {
    static constexpr bool PERM = true, AFTER_DRAIN = false;
    bf16_t* O; const float* stats; const float* colsum; const float* colbias; float eps;
    __device__ __forceinline__ void operator()(const f32x4 (&acc)[2][2][4][2], const Unit& u, int wr, int wc, int fr, int fq) const {
        { int ln_ = LANEID(); asm volatile("" : "+v"(ln_)); fr = ln_ & 15; fq = ln_ >> 4; }
        const int row0 = u.pm * BM + wr * 64 + fr, col0 = u.pn * BM + wc * 32 + 8 * fq;
        f32x4 cs[2][2], cb[2][2];
#pragma unroll
        for (int bj = 0; bj < 2; ++bj)
#pragma unroll
            for (int n = 0; n < 2; ++n) { cs[bj][n] = *(const f32x4*)(colsum + col0 + bj * HALF + 4 * n); cb[bj][n] = *(const f32x4*)(colbias + col0 + bj * HALF + 4 * n); }
#pragma unroll
        for (int ai = 0; ai < 2; ++ai)
#pragma unroll
            for (int m = 0; m < 4; ++m) {
                const int row = row0 + ai * HALF + m * 16;
                const float sm_ = stats[2 * (size_t)row], sq_ = stats[2 * (size_t)row + 1];
                const float mean = sm_ * (1.0f / 1024.0f);
                const float rstd = 1.0f / sqrtf(fmaxf(sq_ * (1.0f / 1024.0f) - mean * mean, 0.f) + eps);
                bf16_t* rowp = O + (size_t)row * 1024 + col0;
#pragma unroll
                for (int bj = 0; bj < 2; ++bj) {
                    const f32x4 v0 = (acc[ai][bj][m][0] - cs[bj][0] * mean) * rstd + cb[bj][0], v1 = (acc[ai][bj][m][1] - cs[bj][1] * mean) * rstd + cb[bj][1];
                    u32x4 w; w.x = cvt_pk_bf16(v0[0], v0[1]); w.y = cvt_pk_bf16(v0[2], v0[3]); w.z = cvt_pk_bf16(v1[0], v1[1]); w.w = cvt_pk_bf16(v1[2], v1[3]);
                    *(u32x4*)(rowp + bj * HALF) = w;
                }
            }
    }
};
}

typedef unsigned short bf16;
constexpr int T_ = 16384, S_ = 4096, NBATCH = 4, D_ = 1024, NCOL = 6824, NP = 6912, DEPTH_ = 2;
constexpr int C_QA = 0, C_KA = 256, C_VA = 320, C_QI = 384, C_KI = 640, C_WI = 672, C_QB = 680, C_KB = 936, C_VB = 1064,
              C_QC = 1192, C_KC = 1448, C_VC = 1704, C_QD = 1960, C_KD = 2216, C_VD = 2472, C_G = 2728;
constexpr int NTHR = 512, NWAVE = 8;
constexpr float ALPHA = 1.41421356237309515f;
constexpr float LN_EPS = 1e-5f;
constexpr size_t MiB = 1u << 20;
constexpr size_t WS_STATS = 1 * MiB  , WS_COLS = 1 * MiB + 512 * 1024  ;
constexpr size_t WS_CTL = 0, WS_WIN_T = 2 * MiB, WS_WOUT_T = 30 * MiB, WS_WQ_T = 34 * MiB, WS_WBR_T = 38 * MiB, WS_HB = 42 * MiB,
                 WS_P = 74 * MiB, WS_MIX = 74 * MiB  , WS_Q = 138 * MiB  , WS_YS = 290 * MiB, WS_MRG = 322 * MiB,
                 WS_MASK = 354 * MiB, WS_EID = 362 * MiB, WS_GATE = 370 * MiB, WS_KMEAN = 378 * MiB, WS_SKB = 379 * MiB, WS_UV = 380 * MiB, WS_END = 508 * MiB;
constexpr size_t WIN_T_BYTES = (size_t)NP * 1024 * 2;
constexpr int LDS_BYTES = 144 * 1024;

struct Params { const float* in[13]; float* out; unsigned char* ws; };

__device__ __forceinline__ float bf2f(bf16 v) { return __uint_as_float((unsigned)v << 16); }
__device__ __forceinline__ unsigned f2bf(float f) { unsigned u = __float_as_uint(f); return (u + 0x7fffu + ((u >> 16) & 1u)) >> 16; }
__device__ __forceinline__ unsigned pk2(float lo, float hi) { return f2bf(lo) | (f2bf(hi) << 16); }
__device__ __forceinline__ void unpack8(const uint4 v, float* o) {
    o[0] = __uint_as_float(v.x << 16); o[1] = __uint_as_float(v.x & 0xffff0000u); o[2] = __uint_as_float(v.y << 16); o[3] = __uint_as_float(v.y & 0xffff0000u);
    o[4] = __uint_as_float(v.z << 16); o[5] = __uint_as_float(v.z & 0xffff0000u); o[6] = __uint_as_float(v.w << 16); o[7] = __uint_as_float(v.w & 0xffff0000u);
}
__device__ __forceinline__ float wave_sum(float v) {
#pragma unroll
    for (int o = 32; o > 0; o >>= 1) v += __shfl_xor(v, o);
    return v;
}
__device__ __forceinline__ float wave_max(float v) {
#pragma unroll
    for (int o = 32; o > 0; o >>= 1) v = fmaxf(v, __shfl_xor(v, o));
    return v;
}
__device__ __forceinline__ int wave_sum_i(int v) {
#pragma unroll
    for (int o = 32; o > 0; o >>= 1) v += __shfl_xor(v, o);
    return v;
}
__device__ __forceinline__ float logsig(float x) { return fminf(x, 0.f) - log1pf(expf(-fabsf(x))); }

__device__ void transpose_items(int WV_, const float* W, int K, int N, bf16* WT, float* sm, int item0, int nitems_total, int item_stride,
                                const float* rs_g = nullptr, const float* rs_b = nullptr, float* colsum = nullptr, float* colbias = nullptr) {
    const int tid = LTID(WV_);
    const int nkb = K / 64, nnb = (N + 63) / 64;
    for (int it = item0; it < nkb * nnb; it += item_stride) {
        const int kb = it % nkb, nb = it / nkb, k0 = kb * 64, n0 = nb * 64;
        __syncthreads();
        for (int e = tid; e < 64 * 64; e += NTHR) { const int kk = e >> 6, nn = e & 63; sm[kk * 65 + nn] = (n0 + nn < N) ? W[(size_t)(k0 + kk) * N + n0 + nn] : 0.f; }
        __syncthreads();
        if (rs_g) {
            if (tid < 64) { float cs = 0.f, cb = 0.f;
                for (int kk = 0; kk < 64; ++kk) { const float w = sm[kk * 65 + tid]; cs += w * rs_g[k0 + kk]; cb += w * rs_b[k0 + kk]; }
                atomicAdd(colsum + n0 + tid, cs); atomicAdd(colbias + n0 + tid, cb); }
            __syncthreads();
            for (int e = tid; e < 64 * 64; e += NTHR) { const int kk = e >> 6, nn = e & 63; sm[kk * 65 + nn] *= rs_g[k0 + kk]; }
            __syncthreads();
        }
        { const int nn = tid >> 3, c = tid & 7;
          if (n0 + nn < N) { uint4 o; o.x = pk2(sm[(8 * c + 0) * 65 + nn], sm[(8 * c + 1) * 65 + nn]); o.y = pk2(sm[(8 * c + 2) * 65 + nn], sm[(8 * c + 3) * 65 + nn]);
              o.z = pk2(sm[(8 * c + 4) * 65 + nn], sm[(8 * c + 5) * 65 + nn]); o.w = pk2(sm[(8 * c + 6) * 65 + nn], sm[(8 * c + 7) * 65 + nn]);
              *(uint4*)(WT + (size_t)(n0 + nn) * K + k0 + 8 * c) = o; } }
    }
    __syncthreads();
}
__device__ void prologue_phase(int WV_, const Params& p, float* sm) {
    const int tid = LTID(WV_), B = LBID(), G = LGRID();
    unsigned char* ws = p.ws;
    for (int l = 0; l < DEPTH_; ++l) {
        bf16* win_t = (bf16*)(ws + WS_WIN_T + l * WIN_T_BYTES);
        transpose_items(WV_, p.in[1] + (size_t)l * 1024 * NCOL, 1024, NCOL, win_t, sm, B, 0, G);
        for (int i = B * NTHR + tid; i < (NP - NCOL) * 1024 / 8; i += G * NTHR) ((uint4*)(win_t + (size_t)NCOL * 1024))[i] = make_uint4(0u, 0u, 0u, 0u);
        transpose_items(WV_, p.in[3] + (size_t)l * 1024 * 1024, 1024, 1024, (bf16*)(ws + WS_WOUT_T) + (size_t)l * 1024 * 1024, sm, B, 0, G);
        transpose_items(WV_, p.in[7] + (size_t)l * 1024 * 1024, 1024, 1024, (bf16*)(ws + WS_WQ_T) + (size_t)l * 1024 * 1024, sm, B, 0, G,
                        p.in[5] + l * 1024, p.in[6] + l * 1024, (float*)(ws + WS_COLS) + l * 2048, (float*)(ws + WS_COLS) + l * 2048 + 1024);
        for (int n = 0; n < 4; ++n)
            transpose_items(WV_, p.in[2] + ((size_t)l * 4 + n) * 256 * 1024, 256, 1024, (bf16*)(ws + WS_WBR_T) + ((size_t)l * 4 + n) * 1024 * 256, sm, B, 0, G);
    }
    const float4* x4 = (const float4*)p.in[0]; uint2* hb2 = (uint2*)(ws + WS_HB);
    for (size_t i = (size_t)B * NTHR + tid; i < (size_t)T_ * 1024 / 4; i += (size_t)G * NTHR) { const float4 v = x4[i]; hb2[i] = make_uint2(pk2(v.x, v.y), pk2(v.z, v.w)); }
}

__device__ __forceinline__ void ln_row(float4 (&v)[4], const float* g, const float* bb, float* orow, bf16* obrow, int lane) {
    float s = 0.f;
#pragma unroll
    for (int j = 0; j < 4; ++j) s += (v[j].x + v[j].y) + (v[j].z + v[j].w);
    const float mean = wave_sum(s) * (1.0f / 1024.0f);
    float s2 = 0.f;
#pragma unroll
    for (int j = 0; j < 4; ++j) { v[j].x -= mean; v[j].y -= mean; v[j].z -= mean; v[j].w -= mean; s2 += (v[j].x * v[j].x + v[j].y * v[j].y) + (v[j].z * v[j].z + v[j].w * v[j].w); }
    const float rstd = 1.0f / sqrtf(wave_sum(s2) * (1.0f / 1024.0f) + LN_EPS);
#pragma unroll
    for (int j = 0; j < 4; ++j) {
        const float4 gg = ((const float4*)g)[j * 64 + lane], b4 = ((const float4*)bb)[j * 64 + lane];
        float4 o; o.x = v[j].x * rstd * gg.x + b4.x; o.y = v[j].y * rstd * gg.y + b4.y; o.z = v[j].z * rstd * gg.z + b4.z; o.w = v[j].w * rstd * gg.w + b4.w;
        ((float4*)orow)[j * 64 + lane] = o;
        ((uint2*)obrow)[j * 64 + lane] = make_uint2(pk2(o.x, o.y), pk2(o.z, o.w));
    }
}
__device__ void ln1_phase(int WV_, const float* hin, const float* add, const float* g, const float* bb, float* hout, bf16* hb) {
    const int lane = LTID(WV_) & 63, wave = LTID(WV_) >> 6;
    for (int row = LBID() * NWAVE + wave; row < T_; row += LGRID() * NWAVE) {
        float4 v[4];
#pragma unroll
        for (int j = 0; j < 4; ++j) {
            const float4 a = ((const float4*)(hin + (size_t)row * 1024))[j * 64 + lane], m = ((const float4*)(add + (size_t)row * 1024))[j * 64 + lane];
            v[j].x = ALPHA * a.x + m.x; v[j].y = ALPHA * a.y + m.y; v[j].z = ALPHA * a.z + m.z; v[j].w = ALPHA * a.w + m.w;
        }
        ln_row(v, g, bb, hout + (size_t)row * 1024, hb + (size_t)row * 1024, lane);
    }
}


typedef short bf16x8_t __attribute__((ext_vector_type(8)));
typedef float f32x16_t __attribute__((ext_vector_type(16)));
typedef float f32x2_t __attribute__((ext_vector_type(2)));
typedef __bf16 bf16x2_t __attribute__((ext_vector_type(2)));
__device__ __forceinline__ unsigned cvtpk(float lo, float hi) { f32x2_t v = {lo, hi}; bf16x2_t b = __builtin_convertvector(v, bf16x2_t); return __builtin_bit_cast(unsigned, b); }
__device__ __forceinline__ int crow(int r, int hi) { return (r & 3) + 8 * (r >> 2) + 4 * hi; }
__device__ __forceinline__ float xlane32(float v) { return __shfl_xor(v, 32); }

constexpr int AT_KP = 72, AT_VP = 68;
constexpr int AT_KS = 0, AT_KS_BYTES = 64 * AT_KP * 2;
constexpr int AT_VT = 2 * AT_KS_BYTES, AT_VT_BYTES = 64 * AT_VP * 2;
constexpr int AT_KM = AT_VT + 2 * AT_VT_BYTES;
constexpr int AT_MISC = AT_KM + 32 * AT_KP * 2;
constexpr float LOG2E = 1.4426950408889634f;

__device__ __forceinline__ unsigned mk_unit(int kind, int b, int x, int y) { return ((unsigned)kind << 30) | ((unsigned)b << 28) | ((unsigned)x << 8) | (unsigned)y; }
__device__ void build_unit_table(unsigned* tab, int i) {
    int n = 0; unsigned res = 0u;
#pragma unroll 1
    for (int c = 64; c >= 1; --c) {
        if (i >= n && i < n + 4) res = mk_unit(0, i - n, 0, c - 1);
        n += 4;
        if ((c & 3) == 0) { if (i >= n && i < n + 16) { const int j = i - n; res = mk_unit(2, j >> 2, j & 3, c / 4 - 1); } n += 16; }
    }
    if (i < 512) tab[i] = res;
}

template <int kind> __device__ __forceinline__ void attn_unit(int WV_, const bf16* P, const unsigned char* mask, const float* kmean, const float* sinks, bf16* ys,
                                unsigned char* lds, int b, int ux, int uy) {
    int tid_ = LTID(WV_); asm volatile("" : "+v"(tid_));
    const int tid = tid_, lane = tid & 63, wave = __builtin_amdgcn_readfirstlane(tid >> 6), r32 = lane & 31, hi = lane >> 5;
    bf16* s_km = (bf16*)(lds + AT_KM);
    const int skey = tid >> 3, sc = tid & 7;
    {
        const bf16* Pb = P + (size_t)b * S_ * NP;
        int q0w, qcol, kcol, vcol, ycol, kt_hi, kt_lo; float slope2 = 0.f, sink2 = 0.f;
        if (kind == 0) { const int head = wave >> 1; q0w = uy * 64 + (wave & 1) * 32; qcol = C_QA + head * 64; kcol = C_KA; vcol = C_VA; ycol = head * 64;
            slope2 = exp2f(-8.0f * (float)(3 * head + 1) / 12.0f) * LOG2E; kt_hi = uy; kt_lo = 0; }
        else if (kind == 1) { const int hq = ux * 2 + (wave >> 2); q0w = uy * 128 + (wave & 3) * 32; qcol = C_QB + hq * 64; kcol = C_KB + ux * 64; vcol = C_VB + ux * 64; ycol = 256 + hq * 64;
            slope2 = exp2f(-8.0f * (float)(3 * hq + 2) / 12.0f) * LOG2E; sink2 = sinks[hq] * LOG2E; kt_hi = 2 * uy + 1; kt_lo = (2 * uy - 2 > 0) ? 2 * uy - 2 : 0; }
        else if (kind == 2) { q0w = uy * 256 + wave * 32; qcol = C_QC + ux * 64; kcol = C_KC + ux * 64; vcol = C_VC + ux * 64; ycol = 512 + ux * 64;
            slope2 = exp2f(-8.0f * (float)(3 * ux + 3) / 12.0f) * LOG2E; kt_hi = 4 * uy + 3; kt_lo = 0; }
        else { q0w = uy * 256 + wave * 32; qcol = C_QD + ux * 64; kcol = C_KD + ux * 64; vcol = C_VD + ux * 64; ycol = 768 + ux * 64; kt_hi = 4 * uy + 3; kt_lo = 0; }
        const int qpos = q0w + r32;
        bf16x8_t qf[4];
        { const bf16* qp = Pb + (size_t)qpos * NP + qcol + 8 * hi;
#pragma unroll
          for (int ks = 0; ks < 4; ++ks) qf[ks] = *(const bf16x8_t*)(qp + 16 * ks); }
        {
            const float qs = (kind == 3) ? 0.125f : 0.125f * LOG2E;
            typedef unsigned u32x4_t __attribute__((ext_vector_type(4)));
#pragma unroll
            for (int ks = 0; ks < 4; ++ks) { u32x4_t w = __builtin_bit_cast(u32x4_t, qf[ks]);
#pragma unroll
                for (int i = 0; i < 4; ++i) w[i] = cvtpk(__uint_as_float(w[i] << 16) * qs, __uint_as_float(w[i] & 0xffff0000u) * qs);
                qf[ks] = __builtin_bit_cast(bf16x8_t, w); }
        }
        float sb[16];
#pragma unroll
        for (int r = 0; r < 16; ++r) sb[r] = slope2 * (float)((r & 3) + 8 * (r >> 2));
        unsigned bm = 0u;
        if (kind == 2) {
            const int own = uy;
            for (int e = tid; e < 32 * 64; e += NTHR) { const int row = e >> 6, d = e & 63; s_km[row * AT_KP + d] = (row < 16) ? (bf16)f2bf(kmean[((b * 4 + ux) * 16 + row) * 64 + d]) : (bf16)0; }
            __syncthreads();
            f32x16_t gacc;
#pragma unroll
            for (int r = 0; r < 16; ++r) gacc[r] = 0.f;
#pragma unroll
            for (int ks = 0; ks < 4; ++ks) { const bf16x8_t a = *(const bf16x8_t*)(s_km + r32 * AT_KP + 16 * ks + 8 * hi); gacc = __builtin_amdgcn_mfma_f32_32x32x16_bf16(a, qf[ks], gacc, 0, 0, 0); }
            float gt[16];
#pragma unroll
            for (int r = 0; r < 8; ++r) { const float mine = gacc[r], other = xlane32(mine); const int bi = crow(r, 0);
                gt[bi] = hi ? other : mine; gt[bi + 4] = hi ? mine : other; }
#pragma unroll
            for (int n = 0; n < 16; ++n) if (n >= own) gt[n] = -INFINITY;
#pragma unroll
            for (int rep = 0; rep < 3; ++rep) {
                float mx = -INFINITY;
#pragma unroll
                for (int n = 0; n < 16; ++n) mx = fmaxf(mx, gt[n]);
                bool done = !(mx > -INFINITY);
#pragma unroll
                for (int n = 0; n < 16; ++n) { const bool hit = !done && gt[n] == mx; if (hit) { bm |= 1u << n; gt[n] = -INFINITY; done = true; } }
            }
        }
        f32x16_t o0, o1;
#pragma unroll
        for (int r = 0; r < 16; ++r) { o0[r] = 0.f; o1[r] = 0.f; }
        float m_run = -INFINITY, l_run = 0.f, carry = 0.f;
        const bf16* kg = Pb + (size_t)skey * NP + kcol + sc * 8;
        const bf16* vg = Pb + (size_t)skey * NP + vcol + sc * 8;
        uint4 rk = *(const uint4*)(kg + (size_t)kt_hi * 64 * NP), rv = *(const uint4*)(vg + (size_t)kt_hi * 64 * NP);
        int buf = 0;
        { bf16* ks_ = (bf16*)(lds + AT_KS); bf16* vt_ = (bf16*)(lds + AT_VT);
          *(uint4*)(ks_ + skey * AT_KP + sc * 8) = rk;
          const unsigned vw[4] = {rv.x, rv.y, rv.z, rv.w};
#pragma unroll
          for (int j = 0; j < 4; ++j) { vt_[(sc * 8 + 2 * j) * AT_VP + skey] = (bf16)(vw[j] & 0xffffu); vt_[(sc * 8 + 2 * j + 1) * AT_VP + skey] = (bf16)(vw[j] >> 16); } }
        __syncthreads();
        bool wave_done = false;
        for (int kt = kt_hi; kt >= kt_lo; --kt) {
            const bool more = kt > kt_lo;
            if (more) { rk = *(const uint4*)(kg + (size_t)(kt - 1) * 64 * NP); rv = *(const uint4*)(vg + (size_t)(kt - 1) * 64 * NP); }
            const bf16* ks_ = (const bf16*)(lds + AT_KS + buf * AT_KS_BYTES);
            const bf16* vt_ = (const bf16*)(lds + AT_VT + buf * AT_VT_BYTES);
            bool active = (kt * 64 <= q0w + 31) && !wave_done;
            if (kind == 1) active = active && (kt * 64 + 63 >= q0w - 127);
            if (active) {
                const int kbase = kt * 64 + 4 * hi;
                f32x16_t p0, p1;
                if (kind != 3) {
                    const float cb = slope2 * (float)(kbase - qpos), cb1 = cb + 32.0f * slope2;
#pragma unroll
                    for (int r = 0; r < 16; ++r) { p0[r] = cb + sb[r]; p1[r] = cb1 + sb[r]; }
                } else {
#pragma unroll
                    for (int r = 0; r < 16; ++r) { p0[r] = 0.f; p1[r] = 0.f; }
                }
#pragma unroll
                for (int ks = 0; ks < 4; ++ks) {
                    const bf16x8_t a0 = *(const bf16x8_t*)(ks_ + r32 * AT_KP + 16 * ks + 8 * hi);
                    const bf16x8_t a1 = *(const bf16x8_t*)(ks_ + (32 + r32) * AT_KP + 16 * ks + 8 * hi);
                    p0 = __builtin_amdgcn_mfma_f32_32x32x16_bf16(a0, qf[ks], p0, 0, 0, 0);
                    p1 = __builtin_amdgcn_mfma_f32_32x32x16_bf16(a1, qf[ks], p1, 0, 0, 0);
                }
                if (kind != 3) {
                    float mx = -INFINITY;
                    if (kind == 0) {
                        const uint2 mw = *(const uint2*)(mask + (size_t)(b * S_ + qpos) * 512 + kt * 8);
                        const unsigned w0 = mw.x >> (4 * hi), w1 = mw.y >> (4 * hi);
#pragma unroll
                        for (int r = 0; r < 16; ++r) { const int off = (r & 3) + 8 * (r >> 2);
                            p0[r] = (w0 & (1u << off)) ? p0[r] : -INFINITY; p1[r] = (w1 & (1u << off)) ? p1[r] : -INFINITY; mx = fmaxf(mx, fmaxf(p0[r], p1[r])); }
                    } else if (kind == 1) {
                        const int rel = qpos - kbase;
#pragma unroll
                        for (int r = 0; r < 16; ++r) { const int off = (r & 3) + 8 * (r >> 2);
                            p0[r] = ((unsigned)(rel - off) < 128u) ? p0[r] : -INFINITY; p1[r] = ((unsigned)(rel - off - 32) < 128u) ? p1[r] : -INFINITY; mx = fmaxf(mx, fmaxf(p0[r], p1[r])); }
                    } else {
                        if ((kt >> 2) == uy) {
                            const int rel = qpos - kbase;
#pragma unroll
                            for (int r = 0; r < 16; ++r) { const int off = (r & 3) + 8 * (r >> 2);
                                p0[r] = (off <= rel) ? p0[r] : -INFINITY; p1[r] = (off + 32 <= rel) ? p1[r] : -INFINITY; mx = fmaxf(mx, fmaxf(p0[r], p1[r])); }
                        } else {
                            const bool tile_ok = ((bm >> (kt >> 2)) & 1u) != 0u;
#pragma unroll
                            for (int r = 0; r < 16; ++r) { p0[r] = tile_ok ? p0[r] : -INFINITY; p1[r] = tile_ok ? p1[r] : -INFINITY; mx = fmaxf(mx, fmaxf(p0[r], p1[r])); }
                        }
                    }
                    mx = fmaxf(mx, xlane32(mx));
                    const float m_new = fmaxf(m_run, mx);
                    const float m_safe = (m_new == -INFINITY) ? 0.f : m_new;
                    float ls = 0.f;
#pragma unroll
                    for (int r = 0; r < 16; ++r) { p0[r] = __builtin_amdgcn_exp2f(p0[r] - m_safe); p1[r] = __builtin_amdgcn_exp2f(p1[r] - m_safe); ls += p0[r] + p1[r]; }
                    if (__any(m_new > m_run)) {
                        const float alpha = __builtin_amdgcn_exp2f(m_run - m_safe);
                        l_run *= alpha;
#pragma unroll
                        for (int r = 0; r < 16; ++r) { o0[r] *= alpha; o1[r] *= alpha; }
                    }
                    l_run += ls; m_run = m_new;
                } else {
                    float run = carry;
#define SB_HALF(PX, KOFF) do { \
                    float lk[16]; \
                    _Pragma("unroll") for (int r = 0; r < 16; ++r) { \
                        const int off = (r & 3) + 8 * (r >> 2); \
                        const bool v = (kbase + off + (KOFF)) < qpos; \
                        const float z = PX[r]; \
                        const float t = log1pf(expf(-fabsf(z))); \
                        lk[r] = v ? (fminf(-z, 0.f) - t) : 0.f; \
                        PX[r] = v ? (fminf(z, 0.f) - t) : -INFINITY; } \
                    _Pragma("unroll") for (int g = 3; g >= 0; --g) { \
                        const float G = (lk[4 * g] + lk[4 * g + 1]) + (lk[4 * g + 2] + lk[4 * g + 3]); \
                        const float PG = xlane32(G); \
                        float la = run + (hi ? 0.f : PG); \
                        run += G + PG; \
                        PX[4 * g + 3] += la; la += lk[4 * g + 3]; PX[4 * g + 2] += la; la += lk[4 * g + 2]; PX[4 * g + 1] += la; la += lk[4 * g + 1]; PX[4 * g] += la; } \
                    _Pragma("unroll") for (int r = 0; r < 16; ++r) PX[r] = expf(PX[r]); } while (0)
                    SB_HALF(p1, 32);
                    SB_HALF(p0, 0);
#undef SB_HALF
                    carry = run;
                }
                unsigned pw[16];
#pragma unroll
                for (int j = 0; j < 8; ++j) { pw[j] = cvtpk(p0[2 * j], p0[2 * j + 1]); pw[8 + j] = cvtpk(p1[2 * j], p1[2 * j + 1]); }
#pragma unroll
                for (int s = 0; s < 4; ++s) {
                    bf16x8_t pb; { const unsigned* q = pw + 4 * s; typedef unsigned u32x4_t __attribute__((ext_vector_type(4))); u32x4_t t4 = {q[0], q[1], q[2], q[3]}; pb = __builtin_bit_cast(bf16x8_t, t4); }
#pragma unroll
                    for (int dt = 0; dt < 2; ++dt) {
                        const bf16* vp = vt_ + (32 * dt + r32) * AT_VP + 16 * s + 4 * hi;
                        typedef short s16x4_t __attribute__((ext_vector_type(4)));
                        const s16x4_t lo = *(const s16x4_t*)vp, hi4 = *(const s16x4_t*)(vp + 8);
                        const bf16x8_t va = {lo[0], lo[1], lo[2], lo[3], hi4[0], hi4[1], hi4[2], hi4[3]};
                        if (dt == 0) o0 = __builtin_amdgcn_mfma_f32_32x32x16_bf16(va, pb, o0, 0, 0, 0);
                        else         o1 = __builtin_amdgcn_mfma_f32_32x32x16_bf16(va, pb, o1, 0, 0, 0);
                    }
                }
            }
            if (kind == 3) {
                const float cm = carry;
                if (__all(cm < -110.0f) || !(kt * 64 <= q0w + 31) ) { if (__all(cm < -110.0f)) wave_done = true; }
            }
            if (more) {
                bf16* ksn = (bf16*)(lds + AT_KS + (buf ^ 1) * AT_KS_BYTES); bf16* vtn = (bf16*)(lds + AT_VT + (buf ^ 1) * AT_VT_BYTES);
                *(uint4*)(ksn + skey * AT_KP + sc * 8) = rk;
                const unsigned vw[4] = {rv.x, rv.y, rv.z, rv.w};
#pragma unroll
                for (int j = 0; j < 4; ++j) { vtn[(sc * 8 + 2 * j) * AT_VP + skey] = (bf16)(vw[j] & 0xffffu); vtn[(sc * 8 + 2 * j + 1) * AT_VP + skey] = (bf16)(vw[j] >> 16); }
            }
            if (kind == 3) { if (__syncthreads_and(wave_done ? 1 : 0)) break; }
            else __syncthreads();
            buf ^= 1;
        }
        float inv;
        if (kind == 3) inv = 1.0f;
        else {
            float lt = l_run + xlane32(l_run);
            if (kind == 1) { const float mf = fmaxf(m_run, sink2); const float sc2 = exp2f(m_run - mf); lt = lt * sc2 + exp2f(sink2 - mf); inv = sc2 / lt; }
            else inv = 1.0f / lt;
        }
        bf16* yp = ys + (size_t)(b * S_ + qpos) * 1024 + ycol + 4 * hi;
#pragma unroll
        for (int g = 0; g < 4; ++g) {
            *(uint2*)(yp + 8 * g) = make_uint2(cvtpk(o0[4 * g] * inv, o0[4 * g + 1] * inv), cvtpk(o0[4 * g + 2] * inv, o0[4 * g + 3] * inv));
            *(uint2*)(yp + 32 + 8 * g) = make_uint2(cvtpk(o1[4 * g] * inv, o1[4 * g + 1] * inv), cvtpk(o1[4 * g + 2] * inv, o1[4 * g + 3] * inv));
        }
    }
}
__device__ void attn_fast_phase(int WV_, const bf16* P, const unsigned char* mask, const float* kmean, const float* sinks, bf16* ys,
                                const unsigned* utab, unsigned* counter, unsigned char* lds) {
    volatile unsigned* s_unit = (volatile unsigned*)(lds + AT_MISC);
    for (;;) {
        __syncthreads();
        if (LTID(WV_) == 0) s_unit[0] = atomicAdd(counter, 1u);
        __syncthreads();
        const unsigned ui = s_unit[0];
        if (ui >= 512u) break;
        const unsigned ue = utab[ui];
        const int kind = (int)(ue >> 30), b = (int)((ue >> 28) & 3u), ux = (int)((ue >> 8) & 255u), uy = (int)(ue & 255u);
        if (kind == 0) attn_unit<0>(WV_, P, mask, kmean, sinks, ys, lds, b, ux, uy);
        else attn_unit<2>(WV_, P, mask, kmean, sinks, ys, lds, b, ux, uy);
    }
    for (int u = LBID(); u < 256; u += LGRID()) { __syncthreads(); attn_unit<3>(WV_, P, mask, kmean, sinks, ys, lds, u >> 6, (u >> 4) & 3, u & 15); }
    for (int u = LBID(); u < 256; u += LGRID()) { __syncthreads(); attn_unit<1>(WV_, P, mask, kmean, sinks, ys, lds, u >> 6, (u >> 5) & 1, u & 31); }
}

constexpr float U_SCALE = 64.0f, V_SCALE = 16.0f;
__device__ __forceinline__ float rdlane_f(float v, int l) { return __builtin_bit_cast(float, __builtin_amdgcn_readlane(__builtin_bit_cast(int, v), l)); }
__device__ __forceinline__ unsigned pk4_fp8(float a, float b, float c, float d) { int v = 0; v = __builtin_amdgcn_cvt_pk_fp8_f32(a, b, v, false); v = __builtin_amdgcn_cvt_pk_fp8_f32(c, d, v, true); return (unsigned)v; }
__device__ __forceinline__ void unpack16_fp8(const uint4 v, float* o) {
    const unsigned w[4] = {v.x, v.y, v.z, v.w};
#pragma unroll
    for (int i = 0; i < 4; ++i) { const f32x2_t lo = __builtin_amdgcn_cvt_pk_f32_fp8((int)w[i], false), hi2 = __builtin_amdgcn_cvt_pk_f32_fp8((int)w[i], true);
        o[4 * i] = lo.x; o[4 * i + 1] = lo.y; o[4 * i + 2] = hi2.x; o[4 * i + 3] = hi2.y; }
}
__device__ void convert_tables(int WV_, const Params& p) {
    const size_t nchunk = (size_t)DEPTH_ * 16384 * 2 * 64;
    for (size_t i = (size_t)LBID() * NTHR + LTID(WV_); i < nchunk; i += (size_t)LGRID() * NTHR) {
        const int c = (int)(i & 63), uvsel = (int)((i >> 6) & 1); const size_t le = i >> 7;
        const float* src = (uvsel ? p.in[10] : p.in[9]) + le * 1024 + c * 16;
        const float sc = uvsel ? V_SCALE : U_SCALE;
        const float4 a = ((const float4*)src)[0], b = ((const float4*)src)[1], cc = ((const float4*)src)[2], d = ((const float4*)src)[3];
        *(uint4*)(p.ws + WS_UV + le * 2048 + uvsel * 1024 + c * 16) = make_uint4(pk4_fp8(a.x * sc, a.y * sc, a.z * sc, a.w * sc), pk4_fp8(b.x * sc, b.y * sc, b.z * sc, b.w * sc),
                                                                               pk4_fp8(cc.x * sc, cc.y * sc, cc.z * sc, cc.w * sc), pk4_fp8(d.x * sc, d.y * sc, d.z * sc, d.w * sc));
    }
}
__device__ void peer_fast_phase(int WV_, float* h, bf16* hb, const int* eid, const float* gate, const unsigned char* uv, const float* g1, const float* b1, const float* g, const float* bb, unsigned char* lds) {
    const int tid = LTID(WV_), lane = tid & 63, wave = tid >> 6;
    for (int t = LBID() * NWAVE + wave; t < T_; t += LGRID() * NWAVE) {
        float* hr = h + (size_t)t * 1024 + lane * 16;
        float x[16], acc[16];
        { const float4 a0 = ((const float4*)hr)[0], a1 = ((const float4*)hr)[1], a2 = ((const float4*)hr)[2], a3 = ((const float4*)hr)[3];
          x[0] = a0.x; x[1] = a0.y; x[2] = a0.z; x[3] = a0.w; x[4] = a1.x; x[5] = a1.y; x[6] = a1.z; x[7] = a1.w;
          x[8] = a2.x; x[9] = a2.y; x[10] = a2.z; x[11] = a2.w; x[12] = a3.x; x[13] = a3.y; x[14] = a3.z; x[15] = a3.w; }
        {
            float s = 0.f;
#pragma unroll
            for (int i = 0; i < 16; ++i) s += x[i];
            const float mean = wave_sum(s) * (1.0f / 1024.0f);
            float s2 = 0.f;
#pragma unroll
            for (int i = 0; i < 16; ++i) { x[i] -= mean; s2 += x[i] * x[i]; }
            const float rstd = 1.0f / sqrtf(wave_sum(s2) * (1.0f / 1024.0f) + LN_EPS);
#pragma unroll
            for (int q4 = 0; q4 < 4; ++q4) { const float4 gg = ((const float4*)(g1 + lane * 16))[q4], cc = ((const float4*)(b1 + lane * 16))[q4];
                x[4 * q4] = x[4 * q4] * rstd * gg.x + cc.x; x[4 * q4 + 1] = x[4 * q4 + 1] * rstd * gg.y + cc.y; x[4 * q4 + 2] = x[4 * q4 + 2] * rstd * gg.z + cc.z; x[4 * q4 + 3] = x[4 * q4 + 3] * rstd * gg.w + cc.w; }
        }
#pragma unroll
        for (int i = 0; i < 16; ++i) acc[i] = 0.f;
#pragma unroll 1
        for (int batch = 0; batch < 4; ++batch) {
            const int my_eid = eid[(size_t)t * 128 + batch * 32 + (lane & 31)];
            const float my_gate = gate[(size_t)t * 128 + batch * 32 + (lane & 31)];
            float* pl = (float*)lds + wave * 2048;
#pragma unroll 1
            for (int grp = 0; grp < 4; ++grp) {
                uint4 ua[8];
#pragma unroll
                for (int i = 0; i < 8; ++i) { const int id = __shfl(my_eid, grp * 8 + i); ua[i] = *(const uint4*)(uv + (size_t)id * 2048 + lane * 16); }
#pragma unroll
                for (int i = 0; i < 8; ++i) {
                    float f[16]; unpack16_fp8(ua[i], f);
                    float d0 = 0.f, d1 = 0.f;
#pragma unroll
                    for (int j = 0; j < 8; ++j) { d0 += f[j] * x[j]; d1 += f[8 + j] * x[8 + j]; }
                    pl[(grp * 8 + i) * 64 + lane] = d0 + d1;
                }
            }
            float d;
            { const float4* pr = (const float4*)(pl + (lane & 31) * 64); float4 s4 = pr[0];
#pragma unroll
              for (int i = 1; i < 16; ++i) { const float4 v = pr[i]; s4.x += v.x; s4.y += v.y; s4.z += v.z; s4.w += v.w; }
              d = ((s4.x + s4.y) + (s4.z + s4.w)) * (1.0f / U_SCALE); }
            const float hv = 0.5f * d * (1.0f + erff(d * 0.70710678118654752f)) * my_gate * (1.0f / V_SCALE);
#pragma unroll 1
            for (int grp = 0; grp < 4; ++grp) {
                uint4 va[8];
#pragma unroll
                for (int i = 0; i < 8; ++i) { const int id = __shfl(my_eid, grp * 8 + i); va[i] = *(const uint4*)(uv + (size_t)id * 2048 + 1024 + lane * 16); }
#pragma unroll
                for (int i = 0; i < 8; ++i) {
                    const float c = __shfl(hv, grp * 8 + i);
                    float f[16]; unpack16_fp8(va[i], f);
#pragma unroll
                    for (int j = 0; j < 16; ++j) acc[j] += c * f[j];
                }
            }
        }
        float y[16], s = 0.f;
#pragma unroll
        for (int i = 0; i < 16; ++i) { y[i] = ALPHA * x[i] + acc[i]; s += y[i]; }
        const float mean = wave_sum(s) * (1.0f / 1024.0f);
        float s2 = 0.f;
#pragma unroll
        for (int i = 0; i < 16; ++i) { y[i] -= mean; s2 += y[i] * y[i]; }
        const float rstd = 1.0f / sqrtf(wave_sum(s2) * (1.0f / 1024.0f) + LN_EPS);
        float o[16];
#pragma unroll
        for (int q4 = 0; q4 < 4; ++q4) {
            const float4 gg = ((const float4*)(g + lane * 16))[q4], cc = ((const float4*)(bb + lane * 16))[q4];
            o[4 * q4] = y[4 * q4] * rstd * gg.x + cc.x; o[4 * q4 + 1] = y[4 * q4 + 1] * rstd * gg.y + cc.y; o[4 * q4 + 2] = y[4 * q4 + 2] * rstd * gg.z + cc.z; o[4 * q4 + 3] = y[4 * q4 + 3] * rstd * gg.w + cc.w;
            ((float4*)hr)[q4] = make_float4(o[4 * q4], o[4 * q4 + 1], o[4 * q4 + 2], o[4 * q4 + 3]);
        }
        uint4* hbp = (uint4*)(hb + (size_t)t * 1024 + lane * 16);
        hbp[0] = make_uint4(pk2(o[0], o[1]), pk2(o[2], o[3]), pk2(o[4], o[5]), pk2(o[6], o[7]));
        hbp[1] = make_uint4(pk2(o[8], o[9]), pk2(o[10], o[11]), pk2(o[12], o[13]), pk2(o[14], o[15]));
    }
}

__device__ __forceinline__ float pack_pl(float v, unsigned pl) { return __uint_as_float((__float_as_uint(v) & ~127u) | pl); }
__device__ __forceinline__ void ins16(float (&s)[16], float x) {
#pragma unroll
    for (int k = 15; k >= 1; --k) s[k] = __builtin_amdgcn_fmed3f(s[k - 1], x, s[k]);
    s[0] = fmaxf(s[0], x);
}
template <int D> __device__ __forceinline__ void bitonic_stage(float (&c)[16]) {
#pragma unroll
    for (int i = 0; i < 16; ++i) if ((i & D) == 0) { const float a = fmaxf(c[i], c[i + D]), b = fminf(c[i], c[i + D]); c[i] = a; c[i + D] = b; }
}
__device__ __forceinline__ int decode_key(unsigned pl) { return (int)(32u * ((pl >> 4) & 3u) + (pl & 3u) + 8u * ((pl >> 2) & 3u) + 4u * ((pl >> 6) & 1u)); }
__device__ void route_fast_phase(int WV_, const bf16* qb, const bf16* skb  , int* eid, float* gate, unsigned char* lds) {
    const int tid = LTID(WV_), lane = tid & 63, wave = tid >> 6, r32 = lane & 31, hi = lane >> 5;
    unsigned* lidx = (unsigned*)lds + wave * (64 * 33) + lane * 33;
    for (int unit = LBID() * NWAVE + wave; unit < (T_ / 32) * 8; unit += LGRID() * NWAVE) {
        const int h = unit & 7, t = (unit >> 3) * 32 + r32;
        float sl[2][16];
#pragma unroll
        for (int p = 0; p < 2; ++p) {
            bf16x8_t qf[4];
            { const bf16* qp = qb + (size_t)t * 1024 + h * 128 + p * 64 + 8 * hi;
#pragma unroll
              for (int ks = 0; ks < 4; ++ks) qf[ks] = *(const bf16x8_t*)(qp + 16 * ks); }
            float s[16];
#pragma unroll
            for (int k = 0; k < 16; ++k) s[k] = -INFINITY;
            const bf16* skp = skb + ((size_t)(h * 2 + p) * 128 + r32) * 64 + 8 * hi;
#pragma unroll
            for (int kt = 0; kt < 4; ++kt) {
                f32x16_t acc;
#pragma unroll
                for (int r = 0; r < 16; ++r) acc[r] = 0.f;
#pragma unroll
                for (int ks = 0; ks < 4; ++ks) { const bf16x8_t a = *(const bf16x8_t*)(skp + (size_t)kt * 32 * 64 + 16 * ks); acc = __builtin_amdgcn_mfma_f32_32x32x16_bf16(a, qf[ks], acc, 0, 0, 0); }
#pragma unroll
                for (int r = 0; r < 16; ++r) ins16(s, pack_pl(acc[r], (unsigned)(kt * 16 + r)));
            }
            const unsigned hb = (unsigned)hi << 6;
#pragma unroll
            for (int k = 0; k < 16; ++k) s[k] = __uint_as_float(__float_as_uint(s[k]) | hb);
            float c[16];
#pragma unroll
            for (int k = 0; k < 16; ++k) c[k] = fmaxf(s[k], __shfl_xor(s[15 - k], 32));
            bitonic_stage<8>(c); bitonic_stage<4>(c); bitonic_stage<2>(c); bitonic_stage<1>(c);
#pragma unroll
            for (int k = 0; k < 16; ++k) { sl[p][k] = c[k]; lidx[p * 16 + k] = (unsigned)decode_key(__float_as_uint(c[k]) & 127u); }
        }
        float w[16];
#pragma unroll
        for (int k = 0; k < 16; ++k) w[k] = -INFINITY;
#pragma unroll
        for (int i = 0; i < 16; ++i)
#pragma unroll
            for (int j = 0; j < 16; ++j)
                if ((i + 1) * (j + 1) <= 16) { const float v = sl[0][i] + sl[1][j]; ins16(w, __uint_as_float((__float_as_uint(v) & ~255u) | (unsigned)(i * 16 + j))); }
        float e[16], sum = 0.f;
#pragma unroll
        for (int k = 0; k < 16; ++k) { e[k] = expf(w[k] - w[0]); sum += e[k]; }
        const float inv = 1.0f / sum;
        int ide[8]; float gte[8];
#pragma unroll
        for (int k = 0; k < 8; ++k) {
            float wa = w[k], wb = w[8 + k], ea = e[k], eb = e[8 + k];
            asm volatile("" : "+v"(wa), "+v"(wb), "+v"(ea), "+v"(eb));
            const float wv = hi ? wb : wa;
            const unsigned pl = __float_as_uint(wv) & 255u;
            ide[k] = (int)(lidx[pl >> 4] * 128u + lidx[16 + (pl & 15u)]);
            gte[k] = (hi ? eb : ea) * inv;
        }
        int* ep = eid + (size_t)t * 128 + h * 16 + hi * 8; float* gp = gate + (size_t)t * 128 + h * 16 + hi * 8;
        *(int4*)ep = make_int4(ide[0], ide[1], ide[2], ide[3]); *(int4*)(ep + 4) = make_int4(ide[4], ide[5], ide[6], ide[7]);
        *(float4*)gp = make_float4(gte[0], gte[1], gte[2], gte[3]); *(float4*)(gp + 4) = make_float4(gte[4], gte[5], gte[6], gte[7]);
    }
}

typedef float f32x4_t __attribute__((ext_vector_type(4)));
__device__ __forceinline__ void cnt_gt(int& cnt, unsigned a, unsigned b) { asm("v_cmp_gt_u32_e32 vcc, %1, %2\n\tv_addc_co_u32_e32 %0, vcc, 0, %0, vcc" : "+v"(cnt) : "v"(a), "v"(b) : "vcc"); }
__device__ __forceinline__ void cnt_eq(int& cnt, unsigned a, unsigned b) { asm("v_cmp_eq_u32_e32 vcc, %1, %2\n\tv_addc_co_u32_e32 %0, vcc, 0, %0, vcc" : "+v"(cnt) : "v"(a), "v"(b) : "vcc"); }
__device__ __forceinline__ unsigned flag_gt(unsigned a, unsigned b) { unsigned r; asm("v_cmp_gt_u32_e32 vcc, %1, %2\n\tv_cndmask_b32_e64 %0, 0, 1, vcc" : "=v"(r) : "v"(a), "v"(b) : "vcc"); return r; }
__device__ __forceinline__ unsigned flag_eq(unsigned a, unsigned b) { unsigned r; asm("v_cmp_eq_u32_e32 vcc, %1, %2\n\tv_cndmask_b32_e64 %0, 0, 1, vcc" : "=v"(r) : "v"(a), "v"(b) : "vcc"); return r; }
__device__ __forceinline__ void cnt_ge(int& cnt, unsigned key, unsigned cand) { asm("v_cmp_ge_u32_e32 vcc, %1, %2\n\tv_addc_co_u32_e32 %0, vcc, 0, %0, vcc" : "+v"(cnt) : "v"(key), "v"(cand) : "vcc"); }

typedef __attribute__((address_space(3))) unsigned lds_u32;
template <int SHIFT> __device__ __forceinline__ unsigned radix_pass(const unsigned (&key)[64], unsigned pre, lds_u32* hist, int lane, int& need) {
    typedef unsigned u32x4v __attribute__((ext_vector_type(4)));
    typedef __attribute__((address_space(3))) u32x4v lds_u32x4;
    { const u32x4v z4 = {0u, 0u, 0u, 0u};
#pragma unroll
      for (int i = 0; i < 8; ++i) ((lds_u32x4*)(hist + lane * 32))[i] = z4; }
    const unsigned cp = (unsigned)(lane & 7);
#pragma unroll
    for (int j = 0; j < 64; ++j) {
        const unsigned d = (key[j] >> SHIFT) & 255u;
        bool m;
        if (SHIFT == 24) m = key[j] != 0u; else m = (key[j] >> ((SHIFT + 8) & 31)) == pre;
        if (m) __hip_atomic_fetch_add(hist + ((d << 3) | cp), 1u, __ATOMIC_RELAXED, __HIP_MEMORY_SCOPE_WORKGROUP);
    }
    unsigned dsum[4]; unsigned sumL = 0u;
#pragma unroll
    for (int i = 0; i < 4; ++i) { const u32x4v v0 = ((const lds_u32x4*)(hist + lane * 32))[2 * i], v1 = ((const lds_u32x4*)(hist + lane * 32))[2 * i + 1];
        dsum[i] = ((v0.x + v0.y) + (v0.z + v0.w)) + ((v1.x + v1.y) + (v1.z + v1.w)); sumL += dsum[i]; }
    unsigned incl = sumL;
#pragma unroll
    for (int o = 1; o < 64; o <<= 1) { const unsigned t = (unsigned)__shfl_down((int)incl, o); if (lane + o < 64) incl += t; }
    const unsigned above = incl - sumL;
    const bool own = (above < (unsigned)need) && ((unsigned)need <= above + sumL);
    const int owner = __ffsll((long long)__ballot(own)) - 1;
    unsigned acc = above; int sel = -1; unsigned cab = 0u;
#pragma unroll
    for (int i = 3; i >= 0; --i) { const unsigned c = dsum[i]; const bool hit = (sel < 0) && (acc + c >= (unsigned)need); cab = hit ? acc : cab; sel = hit ? i : sel; acc += c; }
    const int ow = owner < 0 ? 0 : owner;
    const unsigned digit = (unsigned)__builtin_amdgcn_readlane(sel, ow) + (unsigned)(4 * ow);
    need -= (int)__builtin_amdgcn_readlane((int)cab, ow);
    return digit;
}
#ifndef TS_SEL
#define TS_SEL 0
#endif
#define ITS_B() do { if (TS_SEL >= 20 && TS_SEL <= 25 && WV_ == 0 && LANEID() == 0) ((volatile __attribute__((address_space(3))) unsigned long long*)((__attribute__((address_space(3))) unsigned char*)lds + 147456 - 16 - 32))[0] = __builtin_amdgcn_s_memrealtime(); } while (0)
#define ITS_E(k) do { if ((k) == TS_SEL && WV_ == 0 && LANEID() == 0) { volatile __attribute__((address_space(3))) unsigned long long* w_ = (volatile __attribute__((address_space(3))) unsigned long long*)((__attribute__((address_space(3))) unsigned char*)lds + 147456 - 16 - 32); w_[1] += __builtin_amdgcn_s_memrealtime() - w_[0]; } } while (0)
__device__ void index_fast_phase(int WV_, const bf16* P, unsigned char* mask, float* kmean, float* scratch_all, unsigned char* lds) {
    const int tid = LTID(WV_), lane = tid & 63, wave = tid >> 6, bid = LBID(), G = LGRID();
    float* s_part = (float*)lds;
    ITS_B();
    for (int k = bid; k < 256; k += G) {
        const int b = k >> 6, h = (k >> 4) & 3, blk = k & 15;
        const bf16* kp = P + (size_t)(b * S_ + blk * 256 + wave * 32) * NP + C_KC + h * 64 + lane;
        float a = 0.f;
#pragma unroll 8
        for (int j = 0; j < 32; ++j) a += bf2f(kp[(size_t)j * NP]);
        __syncthreads();
        s_part[wave * 64 + lane] = a;
        __syncthreads();
        if (tid < 64) { float s = 0.f;
#pragma unroll
            for (int w = 0; w < 8; ++w) s += s_part[w * 64 + tid];
            kmean[((b * 4 + h) * 16 + blk) * 64 + tid] = s * (1.0f / 256.0f); }
    }
    ITS_E(22);
    float* scr = scratch_all + (size_t)bid * (16 * 4096);
    const int lq = lane & 15, g4 = lane >> 4;
    for (int ui = bid; ui < 1024; ui += G) {
        const int b = ui >> 8, k = ui & 255, tile = (b & 1) ? 255 - k : k, q0 = tile * 16;
        const bf16* Pb = P + (size_t)b * S_ * NP;
        const int ntiles = tile + 1;
        ITS_B();
        bf16x8_t qf[8]; float wi[8];
        { const bf16* qp = Pb + (size_t)(q0 + lq) * NP + C_QI + 8 * g4;
#pragma unroll
          for (int h = 0; h < 8; ++h) qf[h] = *(const bf16x8_t*)(qp + 32 * h);
          const uint4 wv = *(const uint4*)(Pb + (size_t)(q0 + lq) * NP + C_WI); unpack8(wv, wi); }
        for (int kt0 = wave; kt0 < ntiles; kt0 += 4 * NWAVE) {
            bf16x8_t af[4];
#pragma unroll
            for (int u = 0; u < 4; ++u) { const int kt = kt0 + u * NWAVE; if (kt < ntiles) af[u] = *(const bf16x8_t*)(Pb + (size_t)(kt * 16 + lq) * NP + C_KI + 8 * g4); }
#pragma unroll
            for (int u = 0; u < 4; ++u) {
                const int kt = kt0 + u * NWAVE;
                if (kt < ntiles) {
                    f32x4_t sc = {0.f, 0.f, 0.f, 0.f};
#pragma unroll
                    for (int h = 0; h < 8; ++h) {
                        const f32x4_t z = {0.f, 0.f, 0.f, 0.f};
                        const f32x4_t a = __builtin_amdgcn_mfma_f32_16x16x32_bf16(af[u], qf[h], z, 0, 0, 0);
#pragma unroll
                        for (int r = 0; r < 4; ++r) sc[r] += fmaxf(a[r], 0.f) * wi[h];
                    }
#pragma unroll
                    for (int r = 0; r < 4; ++r) { sc[r] *= 0.0625f; if (sc[r] == 0.f) sc[r] = 0.f; }
                    *(f32x4_t*)(scr + (size_t)lq * 4096 + kt * 16 + 4 * g4) = sc;
                }
            }
        }
        __threadfence_block();
        __syncthreads();
        __threadfence_block();
        ITS_E(20); ITS_B();
        lds_u32* hist = (lds_u32*)((__attribute__((address_space(3))) unsigned char*)lds + 2048) + wave * 2048;
#pragma unroll 1
        for (int qi = 0; qi < 2; ++qi) {
            const int ql = 2 * wave + qi, q = q0 + ql;
            const float* row = scr + (size_t)ql * 4096 + lane * 64;
            const int qrel = q - lane * 64;
            unsigned key[64];
            if (qrel >= 0) {
#pragma unroll
                for (int j4 = 0; j4 < 16; ++j4) {
                    const float4 v = ((const float4*)row)[j4];
                    const unsigned u[4] = {__float_as_uint(v.x), __float_as_uint(v.y), __float_as_uint(v.z), __float_as_uint(v.w)};
#pragma unroll
                    for (int e = 0; e < 4; ++e) { const unsigned t = u[e] ^ ((unsigned)((int)u[e] >> 31) | 0x80000000u); const unsigned inval = (unsigned)((qrel - (j4 * 4 + e)) >> 31); key[j4 * 4 + e] = t & ~inval; }
                    if ((j4 & 3) == 3) asm volatile("" ::: "memory");
                }
            } else {
#pragma unroll
                for (int j = 0; j < 64; ++j) key[j] = 0u;
            }
            ITS_E(23); ITS_B();
            unsigned wlo = 0u, whi = 0u;
            if (q + 1 > 256) {
                int need = 256;
                const unsigned d1 = radix_pass<24>(key, 0u, hist, lane, need);
                const unsigned d2 = radix_pass<16>(key, d1, hist, lane, need);
                const unsigned d3 = radix_pass<8>(key, (d1 << 8) | d2, hist, lane, need);
                const unsigned d4 = radix_pass<0>(key, (d1 << 16) | (d2 << 8) | d3, hist, lane, need);
                const unsigned prefix = (d1 << 24) | (d2 << 16) | (d3 << 8) | d4;
                ITS_E(24); ITS_B();
                int ceq = 0;
#pragma unroll
                for (int j = 0; j < 64; ++j) cnt_eq(ceq, key[j], prefix);
                ceq = wave_sum_i(ceq);
                int X = 4096;
                if (ceq != need) {
                    int X0 = 0;
#pragma unroll 1
                    for (int bit = 11; bit >= 0; --bit) {
                        const int c = X0 | (1 << bit);
                        int cnt = 0; const int crel = c - lane * 64;
#pragma unroll
                        for (int j = 0; j < 64; ++j) cnt_eq(cnt, (key[j] ^ prefix) | ~(unsigned)((j - crel) >> 31), 0u);
                        cnt = wave_sum_i(cnt);
                        if (cnt < need) X0 = c;
                    }
                    X = X0 + 1;
                }
                const int xrel = X - lane * 64;
#pragma unroll
                for (int j = 0; j < 32; ++j) {
                    const unsigned s0 = flag_gt(key[j], prefix) | flag_eq((key[j] ^ prefix) | ~(unsigned)((j - xrel) >> 31), 0u);
                    const unsigned s1 = flag_gt(key[32 + j], prefix) | flag_eq((key[32 + j] ^ prefix) | ~(unsigned)((32 + j - xrel) >> 31), 0u);
                    wlo |= s0 << j; whi |= s1 << j;
                }
            } else {
#pragma unroll
                for (int j = 0; j < 32; ++j) { wlo |= (~(unsigned)((qrel - j) >> 31) & 1u) << j; whi |= (~(unsigned)((qrel - 32 - j) >> 31) & 1u) << j; }
            }
            ((uint2*)(mask + (size_t)(b * S_ + q) * 512))[lane] = make_uint2(wlo, whi);
            ITS_E(25); ITS_B();
        }
        ITS_E(21);
        __syncthreads();
    }
}

constexpr int MG_P = 72;
constexpr int MG_TILE_BYTES = 128 * MG_P * 2;
__device__ void merge_fast_phase(int WV_, const bf16* P, const bf16* ys, const bf16* wbt  , bf16* merged, unsigned char* lds) {
    const int tid = LTID(WV_), lane = tid & 63, wave = tid >> 6, r32 = lane & 31, hi = lane >> 5, wt = wave & 3, wd = wave >> 2;
    const int srow0 = tid >> 3, sch = tid & 7;
    for (int tile = LBID(); tile < 1024; tile += LGRID()) {
        const int tok0 = (tile >> 3) * 128, d0 = (tile & 7) * 128;
        f32x16_t mer[2], acc[2];
#pragma unroll
        for (int r = 0; r < 16; ++r) { mer[0][r] = 0.f; mer[1][r] = 0.f; acc[0][r] = 0.f; acc[1][r] = 0.f; }
        uint4 RW00, RW01, RW10, RW11, RY00, RY01, RY10, RY11;
#define MG_GLOAD(st_, R_) do { const int n_ = (st_) >> 2, kc_ = (st_) & 3; \
            RW##R_##0 = *(const uint4*)(wbt + ((size_t)n_ * 1024 + d0 + srow0) * 256 + kc_ * 64 + sch * 8); \
            RW##R_##1 = *(const uint4*)(wbt + ((size_t)n_ * 1024 + d0 + srow0 + 64) * 256 + kc_ * 64 + sch * 8); \
            RY##R_##0 = *(const uint4*)(ys + (size_t)(tok0 + srow0) * 1024 + n_ * 256 + kc_ * 64 + sch * 8); \
            RY##R_##1 = *(const uint4*)(ys + (size_t)(tok0 + srow0 + 64) * 1024 + n_ * 256 + kc_ * 64 + sch * 8); } while (0)
#define MG_SSTORE(buf_, R_) do { bf16* wl_ = (bf16*)(lds + (buf_) * 2 * MG_TILE_BYTES); bf16* yl_ = (bf16*)(lds + (buf_) * 2 * MG_TILE_BYTES + MG_TILE_BYTES); \
            *(uint4*)(wl_ + srow0 * MG_P + sch * 8) = RW##R_##0; *(uint4*)(wl_ + (srow0 + 64) * MG_P + sch * 8) = RW##R_##1; \
            *(uint4*)(yl_ + srow0 * MG_P + sch * 8) = RY##R_##0; *(uint4*)(yl_ + (srow0 + 64) * MG_P + sch * 8) = RY##R_##1; } while (0)
        __syncthreads();
        MG_GLOAD(0, 0); MG_GLOAD(1, 1);
        MG_SSTORE(0, 0);
        __syncthreads();
#define MG_STAGE(PAR_, OTH_) do { const int buf = PAR_; \
            if (st + 2 < 16) MG_GLOAD(st + 2, PAR_); \
            const bf16* wl = (const bf16*)(lds + buf * 2 * MG_TILE_BYTES); const bf16* yl = (const bf16*)(lds + buf * 2 * MG_TILE_BYTES + MG_TILE_BYTES); \
            _Pragma("unroll") for (int ks = 0; ks < 4; ++ks) { \
                const bf16x8_t bq = *(const bf16x8_t*)(yl + (32 * wt + r32) * MG_P + 16 * ks + 8 * hi); \
                const bf16x8_t a0 = *(const bf16x8_t*)(wl + (64 * wd + r32) * MG_P + 16 * ks + 8 * hi); \
                const bf16x8_t a1 = *(const bf16x8_t*)(wl + (64 * wd + 32 + r32) * MG_P + 16 * ks + 8 * hi); \
                acc[0] = __builtin_amdgcn_mfma_f32_32x32x16_bf16(a0, bq, acc[0], 0, 0, 0); \
                acc[1] = __builtin_amdgcn_mfma_f32_32x32x16_bf16(a1, bq, acc[1], 0, 0, 0); } \
            if ((st & 3) == 3) { \
                const int n = st >> 2; \
                const bf16* gp = P + (size_t)(tok0 + 32 * wt + r32) * NP + C_G + n * 1024 + d0 + 64 * wd + 4 * hi; \
                _Pragma("unroll") for (int dt = 0; dt < 2; ++dt) \
                _Pragma("unroll") for (int g = 0; g < 4; ++g) { \
                        const uint2 gv = *(const uint2*)(gp + 32 * dt + 8 * g); \
                        const float g0 = __uint_as_float(gv.x << 16), g1 = __uint_as_float(gv.x & 0xffff0000u), g2 = __uint_as_float(gv.y << 16), g3 = __uint_as_float(gv.y & 0xffff0000u); \
                        mer[dt][4 * g + 0] += acc[dt][4 * g + 0] * __builtin_amdgcn_rcpf(1.f + __builtin_amdgcn_exp2f(-LOG2E * g0)); \
                        mer[dt][4 * g + 1] += acc[dt][4 * g + 1] * __builtin_amdgcn_rcpf(1.f + __builtin_amdgcn_exp2f(-LOG2E * g1)); \
                        mer[dt][4 * g + 2] += acc[dt][4 * g + 2] * __builtin_amdgcn_rcpf(1.f + __builtin_amdgcn_exp2f(-LOG2E * g2)); \
                        mer[dt][4 * g + 3] += acc[dt][4 * g + 3] * __builtin_amdgcn_rcpf(1.f + __builtin_amdgcn_exp2f(-LOG2E * g3)); } \
                _Pragma("unroll") for (int r = 0; r < 16; ++r) { acc[0][r] = 0.f; acc[1][r] = 0.f; } } \
            if (st + 1 < 16) MG_SSTORE(OTH_, OTH_); \
            __syncthreads(); } while (0)
#pragma unroll 1
        for (int st2 = 0; st2 < 16; st2 += 2) { { const int st = st2; MG_STAGE(0, 1); } { const int st = st2 + 1; MG_STAGE(1, 0); } }
#undef MG_STAGE
#undef MG_GLOAD
#undef MG_SSTORE
        bf16* mp = merged + (size_t)(tok0 + 32 * wt + r32) * 1024 + d0 + 64 * wd + 4 * hi;
#pragma unroll
        for (int dt = 0; dt < 2; ++dt)
#pragma unroll
            for (int g = 0; g < 4; ++g)
                *(uint2*)(mp + 32 * dt + 8 * g) = make_uint2(cvtpk(mer[dt][4 * g], mer[dt][4 * g + 1]), cvtpk(mer[dt][4 * g + 2], mer[dt][4 * g + 3]));
    }
}
#define LAS __attribute__((address_space(3)))
#define XB_TMO      128
#define XB_XCNT(j)  (256  + 64 * (j))
#define XB_XSUB(j)  (1280 + 64 * (j))
#define XB_XGEN(j)  (2304 + 64 * (j))
#define XB_TOP      3328
#define XB_TOPGEN   3392
#define XCD_BAR_WORDS 3456
#define XB_SPIN_CAP (1u << 18)

__device__ __forceinline__ unsigned xb_ld(unsigned* p)              { return __hip_atomic_load(p, __ATOMIC_RELAXED, __HIP_MEMORY_SCOPE_AGENT); }
__device__ __forceinline__ unsigned xb_add(unsigned* p, unsigned v) { return __hip_atomic_fetch_add(p, v, __ATOMIC_RELAXED, __HIP_MEMORY_SCOPE_AGENT); }
__device__ __forceinline__ unsigned xb_xcc_id() { return (unsigned)__builtin_amdgcn_s_getreg((3 << 11) | 20) & 0xFu; }
#define XB_SPIN(cond, bar) do { unsigned _sp = 0; while (cond) { __builtin_amdgcn_s_sleep(1); \
    if ((++_sp & 255u) == 0u) { if (xb_ld(&(bar)[XB_TMO])) break; if (_sp > XB_SPIN_CAP) { atomicAdd(&(bar)[XB_TMO], 1u); break; } } } } while (0)

struct XcdBarrier {
    unsigned* bar; unsigned x;
    volatile LAS unsigned* st;
};

__device__ __forceinline__ XcdBarrier xcd_barrier_post(unsigned* bar, volatile LAS unsigned* st) {
    XcdBarrier b; b.bar = bar; b.x = xb_xcc_id(); b.st = st;
    if (threadIdx.x == 0) (void)xb_add(&bar[XB_XCNT(b.x)], 1u);
    return b;
}
__device__ __forceinline__ void xcd_barrier_complete(unsigned* bar, unsigned x, unsigned& nloc, unsigned& nx) {
    const unsigned G = gridDim.x * gridDim.y * gridDim.z;
    unsigned sum, cnt, mine, sp = 0u;
    for (;;) {
        sum = 0u; cnt = 0u; mine = 0u;
#pragma unroll
        for (unsigned j = 0; j < 16; ++j) { const unsigned c = xb_ld(&bar[XB_XCNT(j)]); sum += c; cnt += (c > 0u) ? 1u : 0u; mine = (j == x) ? c : mine; }
        if (sum == G) break;
        __builtin_amdgcn_s_sleep(1);
        if ((++sp & 255u) == 0u) { if (xb_ld(&bar[XB_TMO])) break; if (sp > XB_SPIN_CAP) { atomicAdd(&bar[XB_TMO], 1u); break; } }
    }
    nloc = mine > 0u ? mine : 1u; nx = cnt > 0u ? cnt : 1u;
}

__device__ __forceinline__ void xcd_barrier(const XcdBarrier& b, int wv_) {
    asm volatile("s_waitcnt vmcnt(0)" ::: "memory");
    __syncthreads();
    if (wv_ == 0 && LANEID() == 0) {
        unsigned* bar = b.bar;
        __builtin_amdgcn_s_waitcnt(0);
        unsigned nloc = b.st[0], nx = b.st[1];
        if (nloc == 0u) { xcd_barrier_complete(bar, b.x, nloc, nx); b.st[0] = nloc; b.st[1] = nx; }
        const unsigned old = xb_add(&bar[XB_XSUB(b.x)], 1u);
        const unsigned gen = old / nloc;
        if (old + 1u == (gen + 1u) * nloc) {
            __builtin_amdgcn_fence(__ATOMIC_RELEASE, "agent");
            asm volatile("s_waitcnt vmcnt(0)" ::: "memory");
            const unsigned og = xb_add(&bar[XB_TOP], 1u);
            const unsigned tg = og / nx;
            if (og + 1u == (tg + 1u) * nx) xb_add(&bar[XB_TOPGEN], 1u);
            else XB_SPIN(xb_ld(&bar[XB_TOPGEN]) == tg, bar);
            __builtin_amdgcn_fence(__ATOMIC_ACQUIRE, "agent");
            xb_add(&bar[XB_XGEN(b.x)], 1u);
            asm volatile("s_waitcnt vmcnt(0)" ::: "memory");
        } else {
            XB_SPIN(xb_ld(&bar[XB_XGEN(b.x)]) == gen, bar);
            __builtin_amdgcn_fence(__ATOMIC_ACQUIRE, "agent");
            asm volatile("s_waitcnt vmcnt(0)" ::: "memory");
        }
    }
    __syncthreads();
}

enum { PH_PRO = 0, PH_GIN, PH_INDEX, PH_ATTN, PH_MERGE, PH_GOUT, PH_LN1, PH_GQ, PH_ROUTE, PH_PEER };
template <int PH> __device__ __forceinline__ void run_phase(int WV_, const Params& p_unused, int l, unsigned char* lds_raw) {
    size_t kaoff_ = 0; asm volatile("" : "+s"(kaoff_));
    typedef const __attribute__((address_space(4))) char* kaptr_t;
    const __attribute__((address_space(4))) Params& p = *(const __attribute__((address_space(4))) Params*)((kaptr_t)__builtin_amdgcn_kernarg_segment_ptr() + kaoff_);
    float* sm = (float*)lds_raw;
    size_t wsoff_ = 0; asm volatile("" : "+s"(wsoff_));
    unsigned char* ws = p.ws + wsoff_;
    float* hbuf = p.out;
    bf16* hb = (bf16*)(ws + WS_HB);
    bf16* P = (bf16*)(ws + WS_P);
    bf16* ys = (bf16*)(ws + WS_YS);
    bf16* mrg = (bf16*)(ws + WS_MRG);
    float* mix = (float*)(ws + WS_MIX);
    float* qb = (float*)(ws + WS_Q);
    unsigned char* mask = ws + WS_MASK;
    int* eid = (int*)(ws + WS_EID);
    float* gate = (float*)(ws + WS_GATE);
    float* kmean = (float*)(ws + WS_KMEAN);
    const float* hin = (l == 0) ? p.in[0] : hbuf;
    if (PH == PH_PRO) { Params pc; for (int i = 0; i < 13; ++i) pc.in[i] = p.in[i]; pc.out = p.out; pc.ws = ws;
        prologue_phase(WV_, pc, sm); convert_tables(WV_, pc);
        for (int i = LBID() * NTHR + LTID(WV_); i < DEPTH_ * 8 * 2 * 128 * 64 / 4; i += LGRID() * NTHR) { const float4 v = ((const float4*)p.in[8])[i]; ((uint2*)(ws + WS_SKB))[i] = make_uint2(pk2(v.x, v.y), pk2(v.z, v.w)); } if (LBID() < 2) build_unit_table((unsigned*)(ws + WS_CTL) + 1024, LBID() * NTHR + LTID(WV_)); }
    else if (PH == PH_GIN) {
        pg8::Gemm g{hb, (const bf16*)(ws + WS_WIN_T + l * WIN_T_BYTES), T_, NP, 1024};
        pg8::StaticOrder S; S.init(T_, NP, (int)LGRID(), (int)LBID());
        pg8::EpiBf16<0> E{P, NP, nullptr, 0, 0, 1.f};
        pg8::gemm_phase<pg8::EpiBf16<0>, pg8::StaticOrder, true, true>(WV_, (PG8_LAS unsigned char*)lds_raw, g, S, E);
    }
    else if (PH == PH_INDEX) index_fast_phase(WV_, P, mask, kmean, (float*)(ws + WS_YS), lds_raw);
    else if (PH == PH_ATTN) attn_fast_phase(WV_, P, mask, kmean, p.in[4] + l * 4, ys, (const unsigned*)(ws + WS_CTL) + 1024, (unsigned*)(ws + WS_CTL) + 64 * l, lds_raw);
    else if (PH == PH_MERGE) merge_fast_phase(WV_, P, ys, (const bf16*)(ws + WS_WBR_T) + (size_t)l * 4 * 1024 * 256, mrg, lds_raw);
    else if (PH == PH_GOUT) {
        pg8::Gemm g{mrg, (const bf16*)(ws + WS_WOUT_T) + (size_t)l * 1024 * 1024, T_, 1024, 1024};
        pg8::StaticOrder S; S.init(T_, 1024, (int)LGRID(), (int)LBID());
        pg8::EpiResY E{hin, hbuf, hb, (float*)(ws + WS_STATS) + (size_t)l * T_ * 2, ALPHA};
        pg8::gemm_phase<pg8::EpiResY, pg8::StaticOrder, true, true>(WV_, (PG8_LAS unsigned char*)lds_raw, g, S, E);
    }
    else if (PH == PH_GQ) {
        pg8::Gemm g{hb, (const bf16*)(ws + WS_WQ_T) + (size_t)l * 1024 * 1024, T_, 1024, 1024};
        pg8::StaticOrder S; S.init(T_, 1024, (int)LGRID(), (int)LBID());
        pg8::EpiLnFold E{(bf16*)qb, (const float*)(ws + WS_STATS) + (size_t)l * T_ * 2, (const float*)(ws + WS_COLS) + l * 2048, (const float*)(ws + WS_COLS) + l * 2048 + 1024, LN_EPS};
        pg8::gemm_phase<pg8::EpiLnFold, pg8::StaticOrder, true, true>(WV_, (PG8_LAS unsigned char*)lds_raw, g, S, E);
    }
    else if (PH == PH_ROUTE) route_fast_phase(WV_, (const bf16*)qb, (const bf16*)(ws + WS_SKB) + (size_t)l * 8 * 2 * 128 * 64, eid, gate, lds_raw);
    else peer_fast_phase(WV_, hbuf, hb, eid, gate, ws + WS_UV + (size_t)l * 32 * MiB, p.in[5] + l * 1024, p.in[6] + l * 1024, p.in[11] + l * 1024, p.in[12] + l * 1024, lds_raw);
}

constexpr int CW_BAR = 4096;
constexpr int LDS_BARST = LDS_BYTES - 16;
__global__ void __launch_bounds__(NTHR, 2) mk_fwd(Params p) {
    extern __shared__ __attribute__((aligned(16))) unsigned char lds_raw[];
    cg::grid_group grid = cg::this_grid();
    const int WV_ = __builtin_amdgcn_readfirstlane((int)threadIdx.x >> 6);
    { volatile LAS unsigned* bst0 = (volatile LAS unsigned*)((LAS unsigned char*)lds_raw + LDS_BARST); if (threadIdx.x < 4) bst0[threadIdx.x] = 0u; }
    __syncthreads();
    volatile LAS unsigned* bst = (volatile LAS unsigned*)((LAS unsigned char*)lds_raw + LDS_BARST);
    (void)xcd_barrier_post((unsigned*)(p.ws + WS_CTL) + CW_BAR, bst);
#define GRID_BAR() do { XcdBarrier b_; b_.bar = (unsigned*)(p.ws + WS_CTL) + CW_BAR; b_.x = xb_xcc_id(); b_.st = (volatile LAS unsigned*)((LAS unsigned char*)lds_raw + LDS_BARST); xcd_barrier(b_, WV_); } while (0)
    run_phase<PH_PRO>(WV_, p, 0, lds_raw);
    grid.sync();
#pragma unroll 1
    for (int l = 0; l < DEPTH_; ++l) {
        run_phase<PH_GIN>(WV_, p, l, lds_raw); GRID_BAR();
        run_phase<PH_INDEX>(WV_, p, l, lds_raw); GRID_BAR();
        run_phase<PH_ATTN>(WV_, p, l, lds_raw); GRID_BAR();
        run_phase<PH_MERGE>(WV_, p, l, lds_raw); GRID_BAR();
        run_phase<PH_GOUT>(WV_, p, l, lds_raw); GRID_BAR();
        run_phase<PH_GQ>(WV_, p, l, lds_raw); GRID_BAR();
        run_phase<PH_ROUTE>(WV_, p, l, lds_raw); GRID_BAR();
        run_phase<PH_PEER>(WV_, p, l, lds_raw); if (l + 1 < DEPTH_) GRID_BAR();
    }
}

extern "C" void kernel_launch(void* const* d_in, const int* in_sizes, int n_in, void* d_out, int out_size, void* d_ws, size_t ws_size, hipStream_t stream) {
    if (n_in != 13 || ws_size < WS_END) { fprintf(stderr, "kernel_launch: unexpected n_in %d / ws_size %zu; nothing launched\n", n_in, ws_size); return; }
    static int grid_blocks = 0;
    if (grid_blocks == 0) {
        int dev = 0, cus = 0, per_cu = 0;
        (void)hipGetDevice(&dev);
        (void)hipDeviceGetAttribute(&cus, hipDeviceAttributeMultiprocessorCount, dev);
        (void)hipFuncSetAttribute((const void*)mk_fwd, hipFuncAttributeMaxDynamicSharedMemorySize, LDS_BYTES);
        (void)hipOccupancyMaxActiveBlocksPerMultiprocessor(&per_cu, (const void*)mk_fwd, NTHR, LDS_BYTES);
        if (per_cu < 1) fprintf(stderr, "kernel_launch: occupancy query reports %d\n", per_cu);
        grid_blocks = cus;
    }
    Params p{};
    for (int i = 0; i < 13; ++i) p.in[i] = (const float*)d_in[i];
    p.out = (float*)d_out; p.ws = (unsigned char*)d_ws;
    (void)hipMemsetAsync(d_ws, 0, 2 * MiB, stream);
    void* args[] = {&p};
    hipError_t e = hipLaunchCooperativeKernel((const void*)mk_fwd, dim3(grid_blocks), dim3(NTHR), args, LDS_BYTES, stream);
    if (e != hipSuccess) fprintf(stderr, "cooperative launch failed: %s (grid %d)\n", hipGetErrorString(e), grid_blocks);
}
```

```cpp
#include <hip/hip_runtime.h>
#include <cstdio>
#include <cstdint>
#include <hip/hip_cooperative_groups.h>
namespace cg = cooperative_groups;

__device__ __forceinline__ int LANEID() { int l; asm volatile("v_mbcnt_lo_u32_b32 %0, -1, 0\n\tv_mbcnt_hi_u32_b32 %0, -1, %0" : "=v"(l)); return l; }
__device__ __forceinline__ int LTID(int wv) { return (wv << 6) | LANEID(); }
__device__ __forceinline__ int LBID() { int t = blockIdx.x; asm volatile("" : "+s"(t)); return t; }
__device__ __forceinline__ int LGRID() { int t = gridDim.x; asm volatile("" : "+s"(t)); return t; }
namespace pg8 {
#define PG8_LAS __attribute__((address_space(3)))
typedef unsigned short bf16_t;
typedef short bf16x8 __attribute__((ext_vector_type(8)));
typedef float f32x4 __attribute__((ext_vector_type(4)));
typedef unsigned u32x4 __attribute__((ext_vector_type(4)));
constexpr int BM = 256, BK = 64, HALF = 128, HTB = HALF * BK * 2  , STAGE_BYTES = 8 * HTB, NXCD = 8, WGM = 8;

__host__ __device__ __forceinline__ int lds_byte(int r, int c) { const int st = (r >> 4) * 2 + (c >> 5), rr = r & 15, cc = c & 31, ob = rr * 64 + cc * 2; return st * 1024 + (ob ^ (((ob >> 9) & 1) << 5)); }
__host__ __device__ __forceinline__ void stage_rc(int b, int& R, int& C) { const int st = b / 1024, sb = b % 1024, swz = sb ^ (((sb >> 9) & 1) << 5); R = (st >> 1) * 16 + swz / 64; C = (st & 1) * 32 + (swz % 64) / 2; }
__host__ __device__ __forceinline__ int perm32(int rho) { const int n = rho >> 4, i = rho & 15; return 8 * (i >> 2) + 4 * n + (i & 3); }

struct Unit { int pm, pn; };
struct Gemm { const bf16_t* A; const bf16_t* Bt; int M, N, K; };

struct StaticOrder {
    int nM, nN, nwg, G, c;
    __host__ __device__ void init(int M, int N, int G_, int c_) { nM = M / BM; nN = N / BM; nwg = nM * nN; G = G_; c = c_; }
    __host__ __device__ bool next(int i, Unit& u) const {
        const long L = (long)i * G + c; if (L >= nwg) return false;
        int wgid = (int)L; { const int q = nwg / NXCD, r = nwg % NXCD, xcd = wgid % NXCD, off = wgid / NXCD; wgid = (xcd < r ? xcd * (q + 1) : r * (q + 1) + (xcd - r) * q) + off; }
        const int nig = WGM * nN, gid = wgid / nig, fm = gid * WGM, gsz = (nM - fm) < WGM ? (nM - fm) : WGM;
        u.pm = fm + ((wgid % nig) % gsz); u.pn = (wgid % nig) / gsz; return true;
    }
    __device__ __forceinline__ void a_ready(const Unit&) const {}
    __device__ __forceinline__ void done(const Unit&) const {}
};

__device__ __forceinline__ unsigned cvt_pk_bf16(float lo, float hi) { unsigned r; asm volatile("v_cvt_pk_bf16_f32 %0, %1, %2" : "=v"(r) : "v"(lo), "v"(hi)); return r; }
typedef float f32x2 __attribute__((ext_vector_type(2)));
__device__ __forceinline__ f32x2 gelu_pk(f32x2 v) {
    const f32x2 av = __builtin_elementwise_abs(v), d = av * 0.2316418882f + 1.0f;
    f32x2 t; t.x = __builtin_amdgcn_rcpf(d.x); t.y = __builtin_amdgcn_rcpf(d.y);
    f32x2 q = t * 0.5307027145f + (-0.7265760135f); q = q * t + 0.7107068705f; q = q * t + (-0.142248368f); q = q * t + 0.127414796f; q = q * t;
    const f32x2 s = (v * v) * (-0.72134752044f);
    f32x2 e; e.x = __builtin_amdgcn_exp2f(s.x); e.y = __builtin_amdgcn_exp2f(s.y);
    const f32x2 m = v * (q * e), r = v - m;
    f32x2 o; o.x = v.x < 0.f ? m.x : r.x; o.y = v.y < 0.f ? m.y : r.y; return o;
}

template <int ACT  > struct EpiBf16 {
    static constexpr bool PERM = true, AFTER_DRAIN = false; static_assert(ACT == 0 || ACT == 1, "EpiBf16: ACT is 0 (none) or 1 (gelu_pk)");
    bf16_t* O; int ldc; const float* bias; int split_cols; size_t split_stride; float scale0;
    __device__ __forceinline__ void operator()(const f32x4 (&acc)[2][2][4][2], const Unit& u, int wr, int wc, int fr, int fq) const {
        { int ln_ = LANEID(); asm volatile("" : "+v"(ln_)); fr = ln_ & 15; fq = ln_ >> 4; }
        const int row0 = u.pm * BM + wr * 64 + fr; int colt = u.pn * BM; bf16_t* base = O;
        float sc = 1.f; if (split_cols) { const int t = colt / split_cols; base += (size_t)t * split_stride; colt -= t * split_cols; if (t == 0) sc = scale0; }
        const int col0 = colt + wc * 32 + 8 * fq, bcol0 = u.pn * BM + wc * 32 + 8 * fq;
        f32x4 bv[2][2];
#pragma unroll
        for (int bj = 0; bj < 2; ++bj)
#pragma unroll
            for (int n = 0; n < 2; ++n) bv[bj][n] = bias ? *(const f32x4*)(bias + bcol0 + bj * HALF + 4 * n) : (f32x4){0.f, 0.f, 0.f, 0.f};
#pragma unroll
        for (int ai = 0; ai < 2; ++ai)
#pragma unroll
            for (int m = 0; m < 4; ++m) { bf16_t* rowp = base + (size_t)(row0 + ai * HALF + m * 16) * ldc + col0;
#pragma unroll
                for (int bj = 0; bj < 2; ++bj) { f32x4 v0 = acc[ai][bj][m][0] + bv[bj][0], v1 = acc[ai][bj][m][1] + bv[bj][1];
                    if (ACT == 1) { f32x2 a = gelu_pk((f32x2){v0[0], v0[1]}), b = gelu_pk((f32x2){v0[2], v0[3]}), c = gelu_pk((f32x2){v1[0], v1[1]}), d = gelu_pk((f32x2){v1[2], v1[3]});
                        v0 = (f32x4){a.x, a.y, b.x, b.y}; v1 = (f32x4){c.x, c.y, d.x, d.y}; }
                    v0 = v0 * sc; v1 = v1 * sc; u32x4 w; w.x = cvt_pk_bf16(v0[0], v0[1]); w.y = cvt_pk_bf16(v0[2], v0[3]); w.z = cvt_pk_bf16(v1[0], v1[1]); w.w = cvt_pk_bf16(v1[2], v1[3]);
                    *(u32x4*)(rowp + bj * HALF) = w; } }
    }
};
template <class Epi, class Sched, bool ALIGN_EPI = false, bool SP2 = false>
__device__ __forceinline__ void gemm_phase(int WV_, PG8_LAS unsigned char* lds, const Gemm g, const Sched& S, const Epi& E) {
    const int tid = LTID(WV_), wid = __builtin_amdgcn_readfirstlane(tid >> 6), lane = tid & 63, wr = wid >> 2, wc = wid & 3, fr = lane & 15, fq = lane >> 4;
    const int K = g.K, nt = K / BK;
    unsigned voffA[2], voffB[2];
#pragma unroll
    for (int i = 0; i < 2; ++i) { int R, C; stage_rc(tid * 16 + i * 8192, R, C); const int Rb = Epi::PERM ? ((R & ~31) + perm32(R & 31)) : R;
        voffA[i] = (unsigned)(R * K + C) * 2u; voffB[i] = (unsigned)(Rb * K + C) * 2u; }
    const size_t kstep = (size_t)(BK * 2);
    const size_t hstep = (size_t)HALF * K * 2;
    const size_t tstep = 2 * hstep;
    const unsigned ldsw = (unsigned)wid * 1024u;
    const int aoff = lds_byte(wr * 64 + fr, fq * 8), boff = lds_byte(wc * 32 + fr, fq * 8);
#define PG8_SA(b, h) (((b) * 2 + (h)) * HTB)
#define PG8_SB(b, h) ((4 + (b) * 2 + (h)) * HTB)
#define PG8_STAGE(bufoff, gbase, voff) do { _Pragma("unroll") for (int _i = 0; _i < 2; ++_i) \
        __builtin_amdgcn_global_load_lds((const unsigned*)((const char*)(gbase) + (voff)[_i]), (PG8_LAS unsigned*)(lds + (bufoff) + ldsw + _i * 8192), 16, 0, 0); } while (0)
#define PG8_LDA(dst, b, h) do { _Pragma("unroll") for (int m = 0; m < 4; ++m) _Pragma("unroll") for (int k = 0; k < 2; ++k) dst[m][k] = *(const PG8_LAS bf16x8*)(lds + PG8_SA(b, h) + aoff + m * 2048 + k * 1024); } while (0)
#define PG8_LDB(dst, b, h) do { _Pragma("unroll") for (int n = 0; n < 2; ++n) _Pragma("unroll") for (int k = 0; k < 2; ++k) dst[n][k] = *(const PG8_LAS bf16x8*)(lds + PG8_SB(b, h) + boff + n * 2048 + k * 1024); } while (0)
#define PG8_MMA(ai, bj, At, Bt) do { __builtin_amdgcn_s_setprio(1); _Pragma("unroll") for (int m = 0; m < 4; ++m) _Pragma("unroll") for (int n = 0; n < 2; ++n) _Pragma("unroll") for (int k = 0; k < 2; ++k) \
        acc[ai][bj][m][n] = __builtin_amdgcn_mfma_f32_16x16x32_bf16(Bt[n][k], At[m][k], acc[ai][bj][m][n], 0, 0, 0); __builtin_amdgcn_s_setprio(0); } while (0)
#define PG8_WAIT_V(n) asm volatile("s_waitcnt vmcnt(" #n ")" ::: "memory")
#define PG8_WAIT_L(n) asm volatile("s_waitcnt lgkmcnt(" #n ")" ::: "memory")
#define PG8_BAR __builtin_amdgcn_s_barrier()
#define PG8_SCHED __builtin_amdgcn_sched_barrier(0)
    Unit cur, nxt; int ui = 0;
    if (!S.next(0, cur)) return;
    f32x4 acc[2][2][4][2];
#pragma unroll
    for (int a = 0; a < 2; ++a)
#pragma unroll
        for (int b = 0; b < 2; ++b)
#pragma unroll
            for (int m = 0; m < 4; ++m)
#pragma unroll
                for (int n = 0; n < 2; ++n) acc[a][b][m][n] = (f32x4){0.f, 0.f, 0.f, 0.f};
    bf16x8 At[4][2], B0[2][2], B1[2][2];
    const char* cA = (const char*)g.A + (size_t)cur.pm * tstep; const char* cB = (const char*)g.Bt + (size_t)cur.pn * tstep;
    S.a_ready(cur);
    if constexpr (SP2) {
        PG8_STAGE(PG8_SB(0, 0), cB, voffB); PG8_STAGE(PG8_SB(0, 1), cB + hstep, voffB); PG8_STAGE(PG8_SA(0, 0), cA, voffA); PG8_STAGE(PG8_SA(0, 1), cA + hstep, voffA);
        if (wr == 1) PG8_BAR;
        PG8_WAIT_V(2); PG8_BAR;
        PG8_STAGE(PG8_SB(1, 0), cB + kstep, voffB); PG8_STAGE(PG8_SA(1, 0), cA + kstep, voffA); PG8_STAGE(PG8_SB(1, 1), cB + hstep + kstep, voffB);
        PG8_WAIT_V(6); PG8_BAR;
    } else {
        PG8_STAGE(PG8_SB(0, 0), cB, voffB); PG8_STAGE(PG8_SA(0, 0), cA, voffA); PG8_STAGE(PG8_SB(0, 1), cB + hstep, voffB); PG8_STAGE(PG8_SA(0, 1), cA + hstep, voffA);
        if (wr == 1) PG8_BAR;
        PG8_WAIT_V(4); PG8_BAR;
        PG8_STAGE(PG8_SB(1, 0), cB + kstep, voffB); PG8_STAGE(PG8_SA(1, 0), cA + kstep, voffA); PG8_STAGE(PG8_SB(1, 1), cB + hstep + kstep, voffB);
        PG8_WAIT_V(6); PG8_BAR;
    }
    for (;;) {
        const bool has_next = S.next(ui + 1, nxt);
        const char* nA = has_next ? (const char*)g.A + (size_t)nxt.pm * tstep : cA; const char* nB = has_next ? (const char*)g.Bt + (size_t)nxt.pn * tstep : cB;
        for (int t = 0; t < nt; t += 2) {
            const bool last = (t == nt - 2);
            const char* a1 = cA + (size_t)(t + 1) * kstep;
            const char* a2 = last ? nA : cA + (size_t)(t + 2) * kstep; const char* b2 = last ? nB : cB + (size_t)(t + 2) * kstep;
            const char* a3 = a2 + kstep; const char* b3 = b2 + kstep;
            if (last && has_next) S.a_ready(nxt);
            if constexpr (SP2) {
            PG8_LDB(B0, 0, 0); PG8_LDB(B1, 0, 1); PG8_SCHED; PG8_LDA(At, 0, 0); PG8_STAGE(PG8_SA(1, 1), a1 + hstep, voffA);
            PG8_WAIT_V(8); PG8_WAIT_L(0); PG8_BAR; PG8_MMA(0, 0, At, B0); PG8_MMA(0, 1, At, B1); PG8_BAR; PG8_SCHED;
            PG8_LDA(At, 0, 1); PG8_STAGE(PG8_SB(0, 0), b2, voffB); PG8_STAGE(PG8_SB(0, 1), b2 + hstep, voffB); PG8_STAGE(PG8_SA(0, 0), a2, voffA);
            PG8_WAIT_V(8); PG8_WAIT_L(0); PG8_BAR; PG8_MMA(1, 0, At, B0); PG8_MMA(1, 1, At, B1); PG8_BAR; PG8_SCHED;
            PG8_LDB(B0, 1, 0); PG8_LDB(B1, 1, 1); PG8_SCHED; PG8_LDA(At, 1, 0); PG8_STAGE(PG8_SA(0, 1), a2 + hstep, voffA);
            PG8_WAIT_V(8); PG8_WAIT_L(0); PG8_BAR; PG8_MMA(0, 0, At, B0); PG8_MMA(0, 1, At, B1); PG8_BAR; PG8_SCHED;
            PG8_LDA(At, 1, 1); PG8_STAGE(PG8_SB(1, 0), b3, voffB); PG8_STAGE(PG8_SB(1, 1), b3 + hstep, voffB); PG8_STAGE(PG8_SA(1, 0), a3, voffA);
            PG8_WAIT_V(8); PG8_WAIT_L(0); PG8_BAR; PG8_MMA(1, 0, At, B0); PG8_MMA(1, 1, At, B1); PG8_BAR; PG8_SCHED;
            } else {
            PG8_LDB(B0, 0, 0); PG8_SCHED; PG8_LDA(At, 0, 0); PG8_STAGE(PG8_SA(1, 1), a1 + hstep, voffA);
            PG8_WAIT_L(8); PG8_BAR; PG8_WAIT_L(0); PG8_MMA(0, 0, At, B0); PG8_BAR; PG8_SCHED;
            PG8_LDB(B1, 0, 1); PG8_STAGE(PG8_SB(0, 0), b2, voffB);
            PG8_BAR; PG8_WAIT_L(0); PG8_MMA(0, 1, At, B1); PG8_BAR;
            PG8_LDA(At, 0, 1); PG8_STAGE(PG8_SA(0, 0), a2, voffA);
            PG8_BAR; PG8_WAIT_L(0); PG8_MMA(1, 0, At, B0); PG8_BAR; PG8_SCHED;
            PG8_STAGE(PG8_SB(0, 1), b2 + hstep, voffB);
            PG8_WAIT_V(6); PG8_BAR; PG8_MMA(1, 1, At, B1); PG8_BAR;
            PG8_LDB(B0, 1, 0); PG8_SCHED; PG8_LDA(At, 1, 0); PG8_STAGE(PG8_SA(0, 1), a2 + hstep, voffA);
            PG8_WAIT_L(8); PG8_BAR; PG8_WAIT_L(0); PG8_MMA(0, 0, At, B0); PG8_BAR; PG8_SCHED;
            PG8_LDB(B1, 1, 1); PG8_STAGE(PG8_SB(1, 0), b3, voffB);
            PG8_BAR; PG8_WAIT_L(0); PG8_MMA(0, 1, At, B1); PG8_BAR;
            PG8_LDA(At, 1, 1); PG8_STAGE(PG8_SA(1, 0), a3, voffA);
            PG8_BAR; PG8_WAIT_L(0); PG8_MMA(1, 0, At, B0); PG8_BAR; PG8_SCHED;
            PG8_STAGE(PG8_SB(1, 1), b3 + hstep, voffB);
            PG8_WAIT_V(6); PG8_BAR; PG8_MMA(1, 1, At, B1); PG8_BAR;
            }
        }
        if constexpr (ALIGN_EPI) { if (wr == 0) PG8_BAR; }
        if constexpr (!Epi::AFTER_DRAIN) { E(acc, cur, wr, wc, fr, fq); S.done(cur); }
        if (!has_next) break;
#pragma unroll
        for (int a = 0; a < 2; ++a)
#pragma unroll
            for (int b = 0; b < 2; ++b)
#pragma unroll
                for (int m = 0; m < 4; ++m)
#pragma unroll
                    for (int n = 0; n < 2; ++n) acc[a][b][m][n] = (f32x4){0.f, 0.f, 0.f, 0.f};
        cur = nxt; cA = nA; cB = nB; ++ui;
        if constexpr (ALIGN_EPI) { if (wr == 1) PG8_BAR; }
    }
    PG8_WAIT_V(0);
    if constexpr (!ALIGN_EPI) { if (wr == 0) PG8_BAR; }
    PG8_BAR;
    if constexpr (Epi::AFTER_DRAIN) { E.fused(acc, cur, wr, wc, fr, fq, lds, wid, lane); S.done(cur); }
#undef PG8_SA
#undef PG8_SB
#undef PG8_STAGE
#undef PG8_LDA
#undef PG8_LDB
#undef PG8_MMA
#undef PG8_WAIT_V
#undef PG8_WAIT_L
#undef PG8_BAR
#undef PG8_SCHED
}
}
namespace pg8 {
struct EpiF32 {
    static constexpr bool PERM = false, AFTER_DRAIN = false;
    float* O; int ldc;
    __device__ __forceinline__ void operator()(const f32x4 (&acc)[2][2][4][2], const Unit& u, int wr, int wc, int fr, int fq) const {
        { int ln_ = LANEID(); asm volatile("" : "+v"(ln_)); fr = ln_ & 15; fq = ln_ >> 4; }
        const int row0 = u.pm * BM + wr * 64 + fr, col0 = u.pn * BM + wc * 32 + 4 * fq;
#pragma unroll
        for (int ai = 0; ai < 2; ++ai)
#pragma unroll
            for (int m = 0; m < 4; ++m) { float* rowp = O + (size_t)(row0 + ai * HALF + m * 16) * ldc + col0;
#pragma unroll
                for (int bj = 0; bj < 2; ++bj)
#pragma unroll
                    for (int n = 0; n < 2; ++n) *(f32x4*)(rowp + bj * HALF + n * 16) = acc[ai][bj][m][n]; }
    }
};
struct EpiResY {
    static constexpr bool PERM = false, AFTER_DRAIN = false;
    const float* hin; float* yout; bf16_t* yb; float* stats; float alpha;
    __device__ __forceinline__ void operator()(const f32x4 (&acc)[2][2][4][2], const Unit& u, int wr, int wc, int fr, int fq) const {
        { int ln_ = LANEID(); asm volatile("" : "+v"(ln_)); fr = ln_ & 15; fq = ln_ >> 4; }
        const int row0 = u.pm * BM + wr * 64 + fr, col0 = u.pn * BM + wc * 32 + 4 * fq;
#pragma unroll
        for (int ai = 0; ai < 2; ++ai)
#pragma unroll
            for (int m = 0; m < 4; ++m) {
                const int row = row0 + ai * HALF + m * 16;
                float s = 0.f, s2 = 0.f;
#pragma unroll
                for (int bj = 0; bj < 2; ++bj)
#pragma unroll
                    for (int n = 0; n < 2; ++n) {
                        const size_t off = (size_t)row * 1024 + col0 + bj * HALF + n * 16;
                        const f32x4 hv = *(const f32x4*)(hin + off);
                        const f32x4 y = hv * alpha + acc[ai][bj][m][n];
                        *(f32x4*)(yout + off) = y;
                        typedef unsigned u32x2v __attribute__((ext_vector_type(2)));
                        u32x2v w; w.x = cvt_pk_bf16(y[0], y[1]); w.y = cvt_pk_bf16(y[2], y[3]);
                        *(u32x2v*)(yb + off) = w;
                        s += (y[0] + y[1]) + (y[2] + y[3]); s2 += (y[0] * y[0] + y[1] * y[1]) + (y[2] * y[2] + y[3] * y[3]);
                    }
                s += __shfl_xor(s, 16); s += __shfl_xor(s, 32); s2 += __shfl_xor(s2, 16); s2 += __shfl_xor(s2, 32);
                if (fq == 0) { atomicAdd(stats + 2 * (size_t)row, s); atomicAdd(stats + 2 * (size_t)row + 1, s2); }
            }
    }
};
struct EpiLnFold {
    static constexpr bool PERM = true, AFTER_DRAIN = false;
    bf16_t* O; const float* stats; const float* colsum; const float* colbias; float eps;
    __device__ __forceinline__ void operator()(const f32x4 (&acc)[2][2][4][2], const Unit& u, int wr, int wc, int fr, int fq) const {
        { int ln_ = LANEID(); asm volatile("" : "+v"(ln_)); fr = ln_ & 15; fq = ln_ >> 4; }
        const int row0 = u.pm * BM + wr * 64 + fr, col0 = u.pn * BM + wc * 32 + 8 * fq;
        f32x4 cs[2][2], cb[2][2];
#pragma unroll
        for (int bj = 0; bj < 2; ++bj)
#pragma unroll
            for (int n = 0; n < 2; ++n) { cs[bj][n] = *(const f32x4*)(colsum + col0 + bj * HALF + 4 * n); cb[bj][n] = *(const f32x4*)(colbias + col0 + bj * HALF + 4 * n); }
#pragma unroll
        for (int ai = 0; ai < 2; ++ai)
#pragma unroll
            for (int m = 0; m < 4; ++m) {
                const int row = row0 + ai * HALF + m * 16;
                const float sm_ = stats[2 * (size_t)row], sq_ = stats[2 * (size_t)row + 1];
                const float mean = sm_ * (1.0f / 1024.0f);
                const float rstd = 1.0f / sqrtf(fmaxf(sq_ * (1.0f / 1024.0f) - mean * mean, 0.f) + eps);
                bf16_t* rowp = O + (size_t)row * 1024 + col0;
#pragma unroll
                for (int bj = 0; bj < 2; ++bj) {
                    const f32x4 v0 = (acc[ai][bj][m][0] - cs[bj][0] * mean) * rstd + cb[bj][0], v1 = (acc[ai][bj][m][1] - cs[bj][1] * mean) * rstd + cb[bj][1];
                    u32x4 w; w.x = cvt_pk_bf16(v0[0], v0[1]); w.y = cvt_pk_bf16(v0[2], v0[3]); w.z = cvt_pk_bf16(v1[0], v1[1]); w.w = cvt_pk_bf16(v1[2], v1[3]);
                    *(u32x4*)(rowp + bj * HALF) = w;
                }
            }
    }
};
}

typedef unsigned short bf16;
constexpr int T_ = 16384, S_ = 4096, NBATCH = 4, D_ = 1024, NCOL = 6824, NP = 6912, DEPTH_ = 2;
constexpr int C_QA = 0, C_KA = 256, C_VA = 320, C_QI = 384, C_KI = 640, C_WI = 672, C_QB = 680, C_KB = 936, C_VB = 1064,
              C_QC = 1192, C_KC = 1448, C_VC = 1704, C_QD = 1960, C_KD = 2216, C_VD = 2472, C_G = 2728;
constexpr int NTHR = 512, NWAVE = 8;
constexpr float ALPHA = 1.41421356237309515f;
constexpr float LN_EPS = 1e-5f;
constexpr size_t MiB = 1u << 20;
constexpr size_t WS_STATS = 1 * MiB  , WS_COLS = 1 * MiB + 512 * 1024  ;
constexpr size_t WS_CTL = 0, WS_WIN_T = 2 * MiB, WS_WOUT_T = 30 * MiB, WS_WQ_T = 34 * MiB, WS_WBR_T = 38 * MiB, WS_HB = 42 * MiB,
                 WS_P = 74 * MiB, WS_MIX = 74 * MiB  , WS_Q = 138 * MiB  , WS_YS = 290 * MiB, WS_MRG = 322 * MiB,
                 WS_MASK = 354 * MiB, WS_EID = 362 * MiB, WS_GATE = 370 * MiB, WS_KMEAN = 378 * MiB, WS_SKB = 379 * MiB, WS_UV = 380 * MiB, WS_END = 508 * MiB;
constexpr size_t WIN_T_BYTES = (size_t)NP * 1024 * 2;
constexpr int LDS_BYTES = 144 * 1024;

struct Params { const float* in[13]; float* out; unsigned char* ws; };

__device__ __forceinline__ float bf2f(bf16 v) { return __uint_as_float((unsigned)v << 16); }
__device__ __forceinline__ unsigned f2bf(float f) { unsigned u = __float_as_uint(f); return (u + 0x7fffu + ((u >> 16) & 1u)) >> 16; }
__device__ __forceinline__ unsigned pk2(float lo, float hi) { return f2bf(lo) | (f2bf(hi) << 16); }
__device__ __forceinline__ void unpack8(const uint4 v, float* o) {
    o[0] = __uint_as_float(v.x << 16); o[1] = __uint_as_float(v.x & 0xffff0000u); o[2] = __uint_as_float(v.y << 16); o[3] = __uint_as_float(v.y & 0xffff0000u);
    o[4] = __uint_as_float(v.z << 16); o[5] = __uint_as_float(v.z & 0xffff0000u); o[6] = __uint_as_float(v.w << 16); o[7] = __uint_as_float(v.w & 0xffff0000u);
}
__device__ __forceinline__ float wave_sum(float v) {
#pragma unroll
    for (int o = 32; o > 0; o >>= 1) v += __shfl_xor(v, o);
    return v;
}
__device__ __forceinline__ float wave_max(float v) {
#pragma unroll
    for (int o = 32; o > 0; o >>= 1) v = fmaxf(v, __shfl_xor(v, o));
    return v;
}
__device__ __forceinline__ int wave_sum_i(int v) {
#pragma unroll
    for (int o = 32; o > 0; o >>= 1) v += __shfl_xor(v, o);
    return v;
}
__device__ __forceinline__ float logsig(float x) { return fminf(x, 0.f) - log1pf(expf(-fabsf(x))); }

__device__ void transpose_items(int WV_, const float* W, int K, int N, bf16* WT, float* sm, int item0, int nitems_total, int item_stride,
                                const float* rs_g = nullptr, const float* rs_b = nullptr, float* colsum = nullptr, float* colbias = nullptr) {
    const int tid = LTID(WV_);
    const int nkb = K / 64, nnb = (N + 63) / 64;
    for (int it = item0; it < nkb * nnb; it += item_stride) {
        const int kb = it % nkb, nb = it / nkb, k0 = kb * 64, n0 = nb * 64;
        __syncthreads();
        for (int e = tid; e < 64 * 64; e += NTHR) { const int kk = e >> 6, nn = e & 63; sm[kk * 65 + nn] = (n0 + nn < N) ? W[(size_t)(k0 + kk) * N + n0 + nn] : 0.f; }
        __syncthreads();
        if (rs_g) {
            if (tid < 64) { float cs = 0.f, cb = 0.f;
                for (int kk = 0; kk < 64; ++kk) { const float w = sm[kk * 65 + tid]; cs += w * rs_g[k0 + kk]; cb += w * rs_b[k0 + kk]; }
                atomicAdd(colsum + n0 + tid, cs); atomicAdd(colbias + n0 + tid, cb); }
            __syncthreads();
            for (int e = tid; e < 64 * 64; e += NTHR) { const int kk = e >> 6, nn = e & 63; sm[kk * 65 + nn] *= rs_g[k0 + kk]; }
            __syncthreads();
        }
        { const int nn = tid >> 3, c = tid & 7;
          if (n0 + nn < N) { uint4 o; o.x = pk2(sm[(8 * c + 0) * 65 + nn], sm[(8 * c + 1) * 65 + nn]); o.y = pk2(sm[(8 * c + 2) * 65 + nn], sm[(8 * c + 3) * 65 + nn]);
              o.z = pk2(sm[(8 * c + 4) * 65 + nn], sm[(8 * c + 5) * 65 + nn]); o.w = pk2(sm[(8 * c + 6) * 65 + nn], sm[(8 * c + 7) * 65 + nn]);
              *(uint4*)(WT + (size_t)(n0 + nn) * K + k0 + 8 * c) = o; } }
    }
    __syncthreads();
}
__device__ void prologue_phase(int WV_, const Params& p, float* sm) {
    const int tid = LTID(WV_), B = LBID(), G = LGRID();
    unsigned char* ws = p.ws;
    for (int l = 0; l < DEPTH_; ++l) {
        bf16* win_t = (bf16*)(ws + WS_WIN_T + l * WIN_T_BYTES);
        transpose_items(WV_, p.in[1] + (size_t)l * 1024 * NCOL, 1024, NCOL, win_t, sm, B, 0, G);
        for (int i = B * NTHR + tid; i < (NP - NCOL) * 1024 / 8; i += G * NTHR) ((uint4*)(win_t + (size_t)NCOL * 1024))[i] = make_uint4(0u, 0u, 0u, 0u);
        transpose_items(WV_, p.in[3] + (size_t)l * 1024 * 1024, 1024, 1024, (bf16*)(ws + WS_WOUT_T) + (size_t)l * 1024 * 1024, sm, B, 0, G);
        transpose_items(WV_, p.in[7] + (size_t)l * 1024 * 1024, 1024, 1024, (bf16*)(ws + WS_WQ_T) + (size_t)l * 1024 * 1024, sm, B, 0, G,
                        p.in[5] + l * 1024, p.in[6] + l * 1024, (float*)(ws + WS_COLS) + l * 2048, (float*)(ws + WS_COLS) + l * 2048 + 1024);
        for (int n = 0; n < 4; ++n)
            transpose_items(WV_, p.in[2] + ((size_t)l * 4 + n) * 256 * 1024, 256, 1024, (bf16*)(ws + WS_WBR_T) + ((size_t)l * 4 + n) * 1024 * 256, sm, B, 0, G);
    }
    const float4* x4 = (const float4*)p.in[0]; uint2* hb2 = (uint2*)(ws + WS_HB);
    for (size_t i = (size_t)B * NTHR + tid; i < (size_t)T_ * 1024 / 4; i += (size_t)G * NTHR) { const float4 v = x4[i]; hb2[i] = make_uint2(pk2(v.x, v.y), pk2(v.z, v.w)); }
}

__device__ __forceinline__ void ln_row(float4 (&v)[4], const float* g, const float* bb, float* orow, bf16* obrow, int lane) {
    float s = 0.f;
#pragma unroll
    for (int j = 0; j < 4; ++j) s += (v[j].x + v[j].y) + (v[j].z + v[j].w);
    const float mean = wave_sum(s) * (1.0f / 1024.0f);
    float s2 = 0.f;
#pragma unroll
    for (int j = 0; j < 4; ++j) { v[j].x -= mean; v[j].y -= mean; v[j].z -= mean; v[j].w -= mean; s2 += (v[j].x * v[j].x + v[j].y * v[j].y) + (v[j].z * v[j].z + v[j].w * v[j].w); }
    const float rstd = 1.0f / sqrtf(wave_sum(s2) * (1.0f / 1024.0f) + LN_EPS);
#pragma unroll
    for (int j = 0; j < 4; ++j) {
        const float4 gg = ((const float4*)g)[j * 64 + lane], b4 = ((const float4*)bb)[j * 64 + lane];
        float4 o; o.x = v[j].x * rstd * gg.x + b4.x; o.y = v[j].y * rstd * gg.y + b4.y; o.z = v[j].z * rstd * gg.z + b4.z; o.w = v[j].w * rstd * gg.w + b4.w;
        ((float4*)orow)[j * 64 + lane] = o;
        ((uint2*)obrow)[j * 64 + lane] = make_uint2(pk2(o.x, o.y), pk2(o.z, o.w));
    }
}
__device__ void ln1_phase(int WV_, const float* hin, const float* add, const float* g, const float* bb, float* hout, bf16* hb) {
    const int lane = LTID(WV_) & 63, wave = LTID(WV_) >> 6;
    for (int row = LBID() * NWAVE + wave; row < T_; row += LGRID() * NWAVE) {
        float4 v[4];
#pragma unroll
        for (int j = 0; j < 4; ++j) {
            const float4 a = ((const float4*)(hin + (size_t)row * 1024))[j * 64 + lane], m = ((const float4*)(add + (size_t)row * 1024))[j * 64 + lane];
            v[j].x = ALPHA * a.x + m.x; v[j].y = ALPHA * a.y + m.y; v[j].z = ALPHA * a.z + m.z; v[j].w = ALPHA * a.w + m.w;
        }
        ln_row(v, g, bb, hout + (size_t)row * 1024, hb + (size_t)row * 1024, lane);
    }
}


typedef short bf16x8_t __attribute__((ext_vector_type(8)));
typedef float f32x16_t __attribute__((ext_vector_type(16)));
typedef float f32x2_t __attribute__((ext_vector_type(2)));
typedef __bf16 bf16x2_t __attribute__((ext_vector_type(2)));
__device__ __forceinline__ unsigned cvtpk(float lo, float hi) { f32x2_t v = {lo, hi}; bf16x2_t b = __builtin_convertvector(v, bf16x2_t); return __builtin_bit_cast(unsigned, b); }
__device__ __forceinline__ int crow(int r, int hi) { return (r & 3) + 8 * (r >> 2) + 4 * hi; }
__device__ __forceinline__ float xlane32(float v) { return __shfl_xor(v, 32); }

constexpr int AT_KP = 72, AT_VP = 68;
constexpr int AT_KS = 0, AT_KS_BYTES = 64 * AT_KP * 2;
constexpr int AT_VT = 2 * AT_KS_BYTES, AT_VT_BYTES = 64 * AT_VP * 2;
constexpr int AT_KM = AT_VT + 2 * AT_VT_BYTES;
constexpr int AT_MISC = AT_KM + 32 * AT_KP * 2;
constexpr float LOG2E = 1.4426950408889634f;

__device__ __forceinline__ unsigned mk_unit(int kind, int b, int x, int y) { return ((unsigned)kind << 30) | ((unsigned)b << 28) | ((unsigned)x << 8) | (unsigned)y; }
__device__ void build_unit_table(unsigned* tab, int i) {
    int n = 0; unsigned res = 0u;
#pragma unroll 1
    for (int c = 64; c >= 1; --c) {
        if (i >= n && i < n + 4) res = mk_unit(0, i - n, 0, c - 1);
        n += 4;
        if ((c & 3) == 0) { if (i >= n && i < n + 16) { const int j = i - n; res = mk_unit(2, j >> 2, j & 3, c / 4 - 1); } n += 16; }
    }
    if (i < 512) tab[i] = res;
}

template <int kind> __device__ __forceinline__ void attn_unit(int WV_, const bf16* P, const unsigned char* mask, const float* kmean, const float* sinks, bf16* ys,
                                unsigned char* lds, int b, int ux, int uy) {
    int tid_ = LTID(WV_); asm volatile("" : "+v"(tid_));
    const int tid = tid_, lane = tid & 63, wave = __builtin_amdgcn_readfirstlane(tid >> 6), r32 = lane & 31, hi = lane >> 5;
    bf16* s_km = (bf16*)(lds + AT_KM);
    const int skey = tid >> 3, sc = tid & 7;
    {
        const bf16* Pb = P + (size_t)b * S_ * NP;
        int q0w, qcol, kcol, vcol, ycol, kt_hi, kt_lo; float slope2 = 0.f, sink2 = 0.f;
        if (kind == 0) { const int head = wave >> 1; q0w = uy * 64 + (wave & 1) * 32; qcol = C_QA + head * 64; kcol = C_KA; vcol = C_VA; ycol = head * 64;
            slope2 = exp2f(-8.0f * (float)(3 * head + 1) / 12.0f) * LOG2E; kt_hi = uy; kt_lo = 0; }
        else if (kind == 1) { const int hq = ux * 2 + (wave >> 2); q0w = uy * 128 + (wave & 3) * 32; qcol = C_QB + hq * 64; kcol = C_KB + ux * 64; vcol = C_VB + ux * 64; ycol = 256 + hq * 64;
            slope2 = exp2f(-8.0f * (float)(3 * hq + 2) / 12.0f) * LOG2E; sink2 = sinks[hq] * LOG2E; kt_hi = 2 * uy + 1; kt_lo = (2 * uy - 2 > 0) ? 2 * uy - 2 : 0; }
        else if (kind == 2) { q0w = uy * 256 + wave * 32; qcol = C_QC + ux * 64; kcol = C_KC + ux * 64; vcol = C_VC + ux * 64; ycol = 512 + ux * 64;
            slope2 = exp2f(-8.0f * (float)(3 * ux + 3) / 12.0f) * LOG2E; kt_hi = 4 * uy + 3; kt_lo = 0; }
        else { q0w = uy * 256 + wave * 32; qcol = C_QD + ux * 64; kcol = C_KD + ux * 64; vcol = C_VD + ux * 64; ycol = 768 + ux * 64; kt_hi = 4 * uy + 3; kt_lo = 0; }
        const int qpos = q0w + r32;
        bf16x8_t qf[4];
        { const bf16* qp = Pb + (size_t)qpos * NP + qcol + 8 * hi;
#pragma unroll
          for (int ks = 0; ks < 4; ++ks) qf[ks] = *(const bf16x8_t*)(qp + 16 * ks); }
        {
            const float qs = (kind == 3) ? 0.125f : 0.125f * LOG2E;
            typedef unsigned u32x4_t __attribute__((ext_vector_type(4)));
#pragma unroll
            for (int ks = 0; ks < 4; ++ks) { u32x4_t w = __builtin_bit_cast(u32x4_t, qf[ks]);
#pragma unroll
                for (int i = 0; i < 4; ++i) w[i] = cvtpk(__uint_as_float(w[i] << 16) * qs, __uint_as_float(w[i] & 0xffff0000u) * qs);
                qf[ks] = __builtin_bit_cast(bf16x8_t, w); }
        }
        float sb[16];
#pragma unroll
        for (int r = 0; r < 16; ++r) sb[r] = slope2 * (float)((r & 3) + 8 * (r >> 2));
        unsigned bm = 0u;
        if (kind == 2) {
            const int own = uy;
            for (int e = tid; e < 32 * 64; e += NTHR) { const int row = e >> 6, d = e & 63; s_km[row * AT_KP + d] = (row < 16) ? (bf16)f2bf(kmean[((b * 4 + ux) * 16 + row) * 64 + d]) : (bf16)0; }
            __syncthreads();
            f32x16_t gacc;
#pragma unroll
            for (int r = 0; r < 16; ++r) gacc[r] = 0.f;
#pragma unroll
            for (int ks = 0; ks < 4; ++ks) { const bf16x8_t a = *(const bf16x8_t*)(s_km + r32 * AT_KP + 16 * ks + 8 * hi); gacc = __builtin_amdgcn_mfma_f32_32x32x16_bf16(a, qf[ks], gacc, 0, 0, 0); }
            float gt[16];
#pragma unroll
            for (int r = 0; r < 8; ++r) { const float mine = gacc[r], other = xlane32(mine); const int bi = crow(r, 0);
                gt[bi] = hi ? other : mine; gt[bi + 4] = hi ? mine : other; }
#pragma unroll
            for (int n = 0; n < 16; ++n) if (n >= own) gt[n] = -INFINITY;
#pragma unroll
            for (int rep = 0; rep < 3; ++rep) {
                float mx = -INFINITY;
#pragma unroll
                for (int n = 0; n < 16; ++n) mx = fmaxf(mx, gt[n]);
                bool done = !(mx > -INFINITY);
#pragma unroll
                for (int n = 0; n < 16; ++n) { const bool hit = !done && gt[n] == mx; if (hit) { bm |= 1u << n; gt[n] = -INFINITY; done = true; } }
            }
        }
        f32x16_t o0, o1;
#pragma unroll
        for (int r = 0; r < 16; ++r) { o0[r] = 0.f; o1[r] = 0.f; }
        float m_run = -INFINITY, l_run = 0.f, carry = 0.f;
        const bf16* kg = Pb + (size_t)skey * NP + kcol + sc * 8;
        const bf16* vg = Pb + (size_t)skey * NP + vcol + sc * 8;
        uint4 rk = *(const uint4*)(kg + (size_t)kt_hi * 64 * NP), rv = *(const uint4*)(vg + (size_t)kt_hi * 64 * NP);
        int buf = 0;
        { bf16* ks_ = (bf16*)(lds + AT_KS); bf16* vt_ = (bf16*)(lds + AT_VT);
          *(uint4*)(ks_ + skey * AT_KP + sc * 8) = rk;
          const unsigned vw[4] = {rv.x, rv.y, rv.z, rv.w};
#pragma unroll
          for (int j = 0; j < 4; ++j) { vt_[(sc * 8 + 2 * j) * AT_VP + skey] = (bf16)(vw[j] & 0xffffu); vt_[(sc * 8 + 2 * j + 1) * AT_VP + skey] = (bf16)(vw[j] >> 16); } }
        __syncthreads();
        bool wave_done = false;
        for (int kt = kt_hi; kt >= kt_lo; --kt) {
            const bool more = kt > kt_lo;
            if (more) { rk = *(const uint4*)(kg + (size_t)(kt - 1) * 64 * NP); rv = *(const uint4*)(vg + (size_t)(kt - 1) * 64 * NP); }
            const bf16* ks_ = (const bf16*)(lds + AT_KS + buf * AT_KS_BYTES);
            const bf16* vt_ = (const bf16*)(lds + AT_VT + buf * AT_VT_BYTES);
            bool active = (kt * 64 <= q0w + 31) && !wave_done;
            if (kind == 1) active = active && (kt * 64 + 63 >= q0w - 127);
            if (active) {
                const int kbase = kt * 64 + 4 * hi;
                f32x16_t p0, p1;
                if (kind != 3) {
                    const float cb = slope2 * (float)(kbase - qpos), cb1 = cb + 32.0f * slope2;
#pragma unroll
                    for (int r = 0; r < 16; ++r) { p0[r] = cb + sb[r]; p1[r] = cb1 + sb[r]; }
                } else {
#pragma unroll
                    for (int r = 0; r < 16; ++r) { p0[r] = 0.f; p1[r] = 0.f; }
                }
#pragma unroll
                for (int ks = 0; ks < 4; ++ks) {
                    const bf16x8_t a0 = *(const bf16x8_t*)(ks_ + r32 * AT_KP + 16 * ks + 8 * hi);
                    const bf16x8_t a1 = *(const bf16x8_t*)(ks_ + (32 + r32) * AT_KP + 16 * ks + 8 * hi);
                    p0 = __builtin_amdgcn_mfma_f32_32x32x16_bf16(a0, qf[ks], p0, 0, 0, 0);
                    p1 = __builtin_amdgcn_mfma_f32_32x32x16_bf16(a1, qf[ks], p1, 0, 0, 0);
                }
                if (kind != 3) {
                    float mx = -INFINITY;
                    if (kind == 0) {
                        const uint2 mw = *(const uint2*)(mask + (size_t)(b * S_ + qpos) * 512 + kt * 8);
                        const unsigned w0 = mw.x >> (4 * hi), w1 = mw.y >> (4 * hi);
#pragma unroll
                        for (int r = 0; r < 16; ++r) { const int off = (r & 3) + 8 * (r >> 2);
                            p0[r] = (w0 & (1u << off)) ? p0[r] : -INFINITY; p1[r] = (w1 & (1u << off)) ? p1[r] : -INFINITY; mx = fmaxf(mx, fmaxf(p0[r], p1[r])); }
                    } else if (kind == 1) {
                        const int rel = qpos - kbase;
#pragma unroll
                        for (int r = 0; r < 16; ++r) { const int off = (r & 3) + 8 * (r >> 2);
                            p0[r] = ((unsigned)(rel - off) < 128u) ? p0[r] : -INFINITY; p1[r] = ((unsigned)(rel - off - 32) < 128u) ? p1[r] : -INFINITY; mx = fmaxf(mx, fmaxf(p0[r], p1[r])); }
                    } else {
                        if ((kt >> 2) == uy) {
                            const int rel = qpos - kbase;
#pragma unroll
                            for (int r = 0; r < 16; ++r) { const int off = (r & 3) + 8 * (r >> 2);
                                p0[r] = (off <= rel) ? p0[r] : -INFINITY; p1[r] = (off + 32 <= rel) ? p1[r] : -INFINITY; mx = fmaxf(mx, fmaxf(p0[r], p1[r])); }
                        } else {
                            const bool tile_ok = ((bm >> (kt >> 2)) & 1u) != 0u;
#pragma unroll
                            for (int r = 0; r < 16; ++r) { p0[r] = tile_ok ? p0[r] : -INFINITY; p1[r] = tile_ok ? p1[r] : -INFINITY; mx = fmaxf(mx, fmaxf(p0[r], p1[r])); }
                        }
                    }
                    mx = fmaxf(mx, xlane32(mx));
                    const float m_new = fmaxf(m_run, mx);
                    const float m_safe = (m_new == -INFINITY) ? 0.f : m_new;
                    float ls = 0.f;
#pragma unroll
                    for (int r = 0; r < 16; ++r) { p0[r] = __builtin_amdgcn_exp2f(p0[r] - m_safe); p1[r] = __builtin_amdgcn_exp2f(p1[r] - m_safe); ls += p0[r] + p1[r]; }
                    if (__any(m_new > m_run)) {
                        const float alpha = __builtin_amdgcn_exp2f(m_run - m_safe);
                        l_run *= alpha;
#pragma unroll
                        for (int r = 0; r < 16; ++r) { o0[r] *= alpha; o1[r] *= alpha; }
                    }
                    l_run += ls; m_run = m_new;
                } else {
                    float run = carry;
#define SB_HALF(PX, KOFF) do { \
                    float lk[16]; \
                    _Pragma("unroll") for (int r = 0; r < 16; ++r) { \
                        const int off = (r & 3) + 8 * (r >> 2); \
                        const bool v = (kbase + off + (KOFF)) < qpos; \
                        const float z = PX[r]; \
                        const float t = 0.6931471805599453f * __builtin_amdgcn_logf(1.0f + __builtin_amdgcn_exp2f(-LOG2E * fabsf(z))); \
                        lk[r] = v ? (fminf(-z, 0.f) - t) : 0.f; \
                        PX[r] = v ? (fminf(z, 0.f) - t) : -INFINITY; } \
                    _Pragma("unroll") for (int g = 3; g >= 0; --g) { \
                        const float G = (lk[4 * g] + lk[4 * g + 1]) + (lk[4 * g + 2] + lk[4 * g + 3]); \
                        const float PG = xlane32(G); \
                        float la = run + (hi ? 0.f : PG); \
                        run += G + PG; \
                        PX[4 * g + 3] += la; la += lk[4 * g + 3]; PX[4 * g + 2] += la; la += lk[4 * g + 2]; PX[4 * g + 1] += la; la += lk[4 * g + 1]; PX[4 * g] += la; } \
                    _Pragma("unroll") for (int r = 0; r < 16; ++r) PX[r] = __builtin_amdgcn_exp2f(LOG2E * PX[r]); } while (0)
                    SB_HALF(p1, 32);
                    SB_HALF(p0, 0);
#undef SB_HALF
                    carry = run;
                }
                unsigned pw[16];
#pragma unroll
                for (int j = 0; j < 8; ++j) { pw[j] = cvtpk(p0[2 * j], p0[2 * j + 1]); pw[8 + j] = cvtpk(p1[2 * j], p1[2 * j + 1]); }
#pragma unroll
                for (int s = 0; s < 4; ++s) {
                    bf16x8_t pb; { const unsigned* q = pw + 4 * s; typedef unsigned u32x4_t __attribute__((ext_vector_type(4))); u32x4_t t4 = {q[0], q[1], q[2], q[3]}; pb = __builtin_bit_cast(bf16x8_t, t4); }
#pragma unroll
                    for (int dt = 0; dt < 2; ++dt) {
                        const bf16* vp = vt_ + (32 * dt + r32) * AT_VP + 16 * s + 4 * hi;
                        typedef short s16x4_t __attribute__((ext_vector_type(4)));
                        const s16x4_t lo = *(const s16x4_t*)vp, hi4 = *(const s16x4_t*)(vp + 8);
                        const bf16x8_t va = {lo[0], lo[1], lo[2], lo[3], hi4[0], hi4[1], hi4[2], hi4[3]};
                        if (dt == 0) o0 = __builtin_amdgcn_mfma_f32_32x32x16_bf16(va, pb, o0, 0, 0, 0);
                        else         o1 = __builtin_amdgcn_mfma_f32_32x32x16_bf16(va, pb, o1, 0, 0, 0);
                    }
                }
            }
            if (kind == 3) {
                const float cm = carry;
                if (__all(cm < -110.0f) || !(kt * 64 <= q0w + 31) ) { if (__all(cm < -110.0f)) wave_done = true; }
            }
            if (more) {
                bf16* ksn = (bf16*)(lds + AT_KS + (buf ^ 1) * AT_KS_BYTES); bf16* vtn = (bf16*)(lds + AT_VT + (buf ^ 1) * AT_VT_BYTES);
                *(uint4*)(ksn + skey * AT_KP + sc * 8) = rk;
                const unsigned vw[4] = {rv.x, rv.y, rv.z, rv.w};
#pragma unroll
                for (int j = 0; j < 4; ++j) { vtn[(sc * 8 + 2 * j) * AT_VP + skey] = (bf16)(vw[j] & 0xffffu); vtn[(sc * 8 + 2 * j + 1) * AT_VP + skey] = (bf16)(vw[j] >> 16); }
            }
            if (kind == 3) { if (__syncthreads_and(wave_done ? 1 : 0)) break; }
            else __syncthreads();
            buf ^= 1;
        }
        float inv;
        if (kind == 3) inv = 1.0f;
        else {
            float lt = l_run + xlane32(l_run);
            if (kind == 1) { const float mf = fmaxf(m_run, sink2); const float sc2 = exp2f(m_run - mf); lt = lt * sc2 + exp2f(sink2 - mf); inv = sc2 / lt; }
            else inv = 1.0f / lt;
        }
        bf16* yp = ys + (size_t)(b * S_ + qpos) * 1024 + ycol + 4 * hi;
#pragma unroll
        for (int g = 0; g < 4; ++g) {
            *(uint2*)(yp + 8 * g) = make_uint2(cvtpk(o0[4 * g] * inv, o0[4 * g + 1] * inv), cvtpk(o0[4 * g + 2] * inv, o0[4 * g + 3] * inv));
            *(uint2*)(yp + 32 + 8 * g) = make_uint2(cvtpk(o1[4 * g] * inv, o1[4 * g + 1] * inv), cvtpk(o1[4 * g + 2] * inv, o1[4 * g + 3] * inv));
        }
    }
}
__device__ void attn_fast_phase(int WV_, const bf16* P, const unsigned char* mask, const float* kmean, const float* sinks, bf16* ys,
                                const unsigned* utab, unsigned* counter, unsigned char* lds) {
    volatile unsigned* s_unit = (volatile unsigned*)(lds + AT_MISC);
    for (;;) {
        __syncthreads();
        if (LTID(WV_) == 0) s_unit[0] = atomicAdd(counter, 1u);
        __syncthreads();
        const unsigned ui = s_unit[0];
        if (ui >= 512u) break;
        const unsigned ue = utab[ui];
        const int kind = (int)(ue >> 30), b = (int)((ue >> 28) & 3u), ux = (int)((ue >> 8) & 255u), uy = (int)(ue & 255u);
        if (kind == 0) attn_unit<0>(WV_, P, mask, kmean, sinks, ys, lds, b, ux, uy);
        else attn_unit<2>(WV_, P, mask, kmean, sinks, ys, lds, b, ux, uy);
    }
    for (int u = LBID(); u < 256; u += LGRID()) { __syncthreads(); attn_unit<3>(WV_, P, mask, kmean, sinks, ys, lds, u >> 6, (u >> 4) & 3, u & 15); }
    for (int u = LBID(); u < 256; u += LGRID()) { __syncthreads(); attn_unit<1>(WV_, P, mask, kmean, sinks, ys, lds, u >> 6, (u >> 5) & 1, u & 31); }
}

constexpr float U_SCALE = 64.0f, V_SCALE = 16.0f;
__device__ __forceinline__ float rdlane_f(float v, int l) { return __builtin_bit_cast(float, __builtin_amdgcn_readlane(__builtin_bit_cast(int, v), l)); }
__device__ __forceinline__ unsigned pk4_fp8(float a, float b, float c, float d) { int v = 0; v = __builtin_amdgcn_cvt_pk_fp8_f32(a, b, v, false); v = __builtin_amdgcn_cvt_pk_fp8_f32(c, d, v, true); return (unsigned)v; }
__device__ __forceinline__ void unpack16_fp8(const uint4 v, float* o) {
    const unsigned w[4] = {v.x, v.y, v.z, v.w};
#pragma unroll
    for (int i = 0; i < 4; ++i) { const f32x2_t lo = __builtin_amdgcn_cvt_pk_f32_fp8((int)w[i], false), hi2 = __builtin_amdgcn_cvt_pk_f32_fp8((int)w[i], true);
        o[4 * i] = lo.x; o[4 * i + 1] = lo.y; o[4 * i + 2] = hi2.x; o[4 * i + 3] = hi2.y; }
}
__device__ void convert_tables(int WV_, const Params& p) {
    const size_t nchunk = (size_t)DEPTH_ * 16384 * 2 * 64;
    for (size_t i = (size_t)LBID() * NTHR + LTID(WV_); i < nchunk; i += (size_t)LGRID() * NTHR) {
        const int c = (int)(i & 63), uvsel = (int)((i >> 6) & 1); const size_t le = i >> 7;
        const float* src = (uvsel ? p.in[10] : p.in[9]) + le * 1024 + c * 16;
        const float sc = uvsel ? V_SCALE : U_SCALE;
        const float4 a = ((const float4*)src)[0], b = ((const float4*)src)[1], cc = ((const float4*)src)[2], d = ((const float4*)src)[3];
        *(uint4*)(p.ws + WS_UV + le * 2048 + uvsel * 1024 + c * 16) = make_uint4(pk4_fp8(a.x * sc, a.y * sc, a.z * sc, a.w * sc), pk4_fp8(b.x * sc, b.y * sc, b.z * sc, b.w * sc),
                                                                               pk4_fp8(cc.x * sc, cc.y * sc, cc.z * sc, cc.w * sc), pk4_fp8(d.x * sc, d.y * sc, d.z * sc, d.w * sc));
    }
}
__device__ void peer_fast_phase(int WV_, float* h, bf16* hb, const int* eid, const float* gate, const unsigned char* uv, const float* g1, const float* b1, const float* g, const float* bb, unsigned char* lds) {
    const int tid = LTID(WV_), lane = tid & 63, wave = tid >> 6;
    for (int t = LBID() * NWAVE + wave; t < T_; t += LGRID() * NWAVE) {
        float* hr = h + (size_t)t * 1024 + lane * 16;
        float x[16], acc[16];
        { const float4 a0 = ((const float4*)hr)[0], a1 = ((const float4*)hr)[1], a2 = ((const float4*)hr)[2], a3 = ((const float4*)hr)[3];
          x[0] = a0.x; x[1] = a0.y; x[2] = a0.z; x[3] = a0.w; x[4] = a1.x; x[5] = a1.y; x[6] = a1.z; x[7] = a1.w;
          x[8] = a2.x; x[9] = a2.y; x[10] = a2.z; x[11] = a2.w; x[12] = a3.x; x[13] = a3.y; x[14] = a3.z; x[15] = a3.w; }
        {
            float s = 0.f;
#pragma unroll
            for (int i = 0; i < 16; ++i) s += x[i];
            const float mean = wave_sum(s) * (1.0f / 1024.0f);
            float s2 = 0.f;
#pragma unroll
            for (int i = 0; i < 16; ++i) { x[i] -= mean; s2 += x[i] * x[i]; }
            const float rstd = 1.0f / sqrtf(wave_sum(s2) * (1.0f / 1024.0f) + LN_EPS);
#pragma unroll
            for (int q4 = 0; q4 < 4; ++q4) { const float4 gg = ((const float4*)(g1 + lane * 16))[q4], cc = ((const float4*)(b1 + lane * 16))[q4];
                x[4 * q4] = x[4 * q4] * rstd * gg.x + cc.x; x[4 * q4 + 1] = x[4 * q4 + 1] * rstd * gg.y + cc.y; x[4 * q4 + 2] = x[4 * q4 + 2] * rstd * gg.z + cc.z; x[4 * q4 + 3] = x[4 * q4 + 3] * rstd * gg.w + cc.w; }
        }
#pragma unroll
        for (int i = 0; i < 16; ++i) acc[i] = 0.f;
#pragma unroll 1
        for (int batch = 0; batch < 4; ++batch) {
            const int my_eid = eid[(size_t)t * 128 + batch * 32 + (lane & 31)];
            const float my_gate = gate[(size_t)t * 128 + batch * 32 + (lane & 31)];
            float* pl = (float*)lds + wave * 2048;
#pragma unroll 1
            for (int grp = 0; grp < 4; ++grp) {
                uint4 ua[8];
#pragma unroll
                for (int i = 0; i < 8; ++i) { const int id = __shfl(my_eid, grp * 8 + i); ua[i] = *(const uint4*)(uv + (size_t)id * 2048 + lane * 16); }
#pragma unroll
                for (int i = 0; i < 8; ++i) {
                    float f[16]; unpack16_fp8(ua[i], f);
                    float d0 = 0.f, d1 = 0.f;
#pragma unroll
                    for (int j = 0; j < 8; ++j) { d0 += f[j] * x[j]; d1 += f[8 + j] * x[8 + j]; }
                    pl[(grp * 8 + i) * 64 + lane] = d0 + d1;
                }
            }
            float d;
            { const float4* pr = (const float4*)(pl + (lane & 31) * 64); float4 s4 = pr[0];
#pragma unroll
              for (int i = 1; i < 16; ++i) { const float4 v = pr[i]; s4.x += v.x; s4.y += v.y; s4.z += v.z; s4.w += v.w; }
              d = ((s4.x + s4.y) + (s4.z + s4.w)) * (1.0f / U_SCALE); }
            const float hv = 0.5f * d * (1.0f + erff(d * 0.70710678118654752f)) * my_gate * (1.0f / V_SCALE);
#pragma unroll 1
            for (int grp = 0; grp < 4; ++grp) {
                uint4 va[8];
#pragma unroll
                for (int i = 0; i < 8; ++i) { const int id = __shfl(my_eid, grp * 8 + i); va[i] = *(const uint4*)(uv + (size_t)id * 2048 + 1024 + lane * 16); }
#pragma unroll
                for (int i = 0; i < 8; ++i) {
                    const float c = __shfl(hv, grp * 8 + i);
                    float f[16]; unpack16_fp8(va[i], f);
#pragma unroll
                    for (int j = 0; j < 16; ++j) acc[j] += c * f[j];
                }
            }
        }
        float y[16], s = 0.f;
#pragma unroll
        for (int i = 0; i < 16; ++i) { y[i] = ALPHA * x[i] + acc[i]; s += y[i]; }
        const float mean = wave_sum(s) * (1.0f / 1024.0f);
        float s2 = 0.f;
#pragma unroll
        for (int i = 0; i < 16; ++i) { y[i] -= mean; s2 += y[i] * y[i]; }
        const float rstd = 1.0f / sqrtf(wave_sum(s2) * (1.0f / 1024.0f) + LN_EPS);
        float o[16];
#pragma unroll
        for (int q4 = 0; q4 < 4; ++q4) {
            const float4 gg = ((const float4*)(g + lane * 16))[q4], cc = ((const float4*)(bb + lane * 16))[q4];
            o[4 * q4] = y[4 * q4] * rstd * gg.x + cc.x; o[4 * q4 + 1] = y[4 * q4 + 1] * rstd * gg.y + cc.y; o[4 * q4 + 2] = y[4 * q4 + 2] * rstd * gg.z + cc.z; o[4 * q4 + 3] = y[4 * q4 + 3] * rstd * gg.w + cc.w;
            ((float4*)hr)[q4] = make_float4(o[4 * q4], o[4 * q4 + 1], o[4 * q4 + 2], o[4 * q4 + 3]);
        }
        uint4* hbp = (uint4*)(hb + (size_t)t * 1024 + lane * 16);
        hbp[0] = make_uint4(pk2(o[0], o[1]), pk2(o[2], o[3]), pk2(o[4], o[5]), pk2(o[6], o[7]));
        hbp[1] = make_uint4(pk2(o[8], o[9]), pk2(o[10], o[11]), pk2(o[12], o[13]), pk2(o[14], o[15]));
    }
}

__device__ __forceinline__ float pack_pl(float v, unsigned pl) { return __uint_as_float((__float_as_uint(v) & ~127u) | pl); }
__device__ __forceinline__ void ins16(float (&s)[16], float x) {
#pragma unroll
    for (int k = 15; k >= 1; --k) s[k] = __builtin_amdgcn_fmed3f(s[k - 1], x, s[k]);
    s[0] = fmaxf(s[0], x);
}
template <int D> __device__ __forceinline__ void bitonic_stage(float (&c)[16]) {
#pragma unroll
    for (int i = 0; i < 16; ++i) if ((i & D) == 0) { const float a = fmaxf(c[i], c[i + D]), b = fminf(c[i], c[i + D]); c[i] = a; c[i + D] = b; }
}
__device__ __forceinline__ int decode_key(unsigned pl) { return (int)(32u * ((pl >> 4) & 3u) + (pl & 3u) + 8u * ((pl >> 2) & 3u) + 4u * ((pl >> 6) & 1u)); }
__device__ void route_fast_phase(int WV_, const bf16* qb, const bf16* skb  , int* eid, float* gate, unsigned char* lds) {
    const int tid = LTID(WV_), lane = tid & 63, wave = tid >> 6, r32 = lane & 31, hi = lane >> 5;
    unsigned* lidx = (unsigned*)lds + wave * (64 * 33) + lane * 33;
    for (int unit = LBID() * NWAVE + wave; unit < (T_ / 32) * 8; unit += LGRID() * NWAVE) {
        const int h = unit & 7, t = (unit >> 3) * 32 + r32;
        float sl[2][16];
#pragma unroll
        for (int p = 0; p < 2; ++p) {
            bf16x8_t qf[4];
            { const bf16* qp = qb + (size_t)t * 1024 + h * 128 + p * 64 + 8 * hi;
#pragma unroll
              for (int ks = 0; ks < 4; ++ks) qf[ks] = *(const bf16x8_t*)(qp + 16 * ks); }
            float s[16];
#pragma unroll
            for (int k = 0; k < 16; ++k) s[k] = -INFINITY;
            const bf16* skp = skb + ((size_t)(h * 2 + p) * 128 + r32) * 64 + 8 * hi;
#pragma unroll
            for (int kt = 0; kt < 4; ++kt) {
                f32x16_t acc;
#pragma unroll
                for (int r = 0; r < 16; ++r) acc[r] = 0.f;
#pragma unroll
                for (int ks = 0; ks < 4; ++ks) { const bf16x8_t a = *(const bf16x8_t*)(skp + (size_t)kt * 32 * 64 + 16 * ks); acc = __builtin_amdgcn_mfma_f32_32x32x16_bf16(a, qf[ks], acc, 0, 0, 0); }
#pragma unroll
                for (int r = 0; r < 16; ++r) ins16(s, pack_pl(acc[r], (unsigned)(kt * 16 + r)));
            }
            const unsigned hb = (unsigned)hi << 6;
#pragma unroll
            for (int k = 0; k < 16; ++k) s[k] = __uint_as_float(__float_as_uint(s[k]) | hb);
            float c[16];
#pragma unroll
            for (int k = 0; k < 16; ++k) c[k] = fmaxf(s[k], __shfl_xor(s[15 - k], 32));
            bitonic_stage<8>(c); bitonic_stage<4>(c); bitonic_stage<2>(c); bitonic_stage<1>(c);
#pragma unroll
            for (int k = 0; k < 16; ++k) { sl[p][k] = c[k]; lidx[p * 16 + k] = (unsigned)decode_key(__float_as_uint(c[k]) & 127u); }
        }
        float w[16];
#pragma unroll
        for (int k = 0; k < 16; ++k) w[k] = -INFINITY;
#pragma unroll
        for (int i = 0; i < 16; ++i)
#pragma unroll
            for (int j = 0; j < 16; ++j)
                if ((i + 1) * (j + 1) <= 16) { const float v = sl[0][i] + sl[1][j]; ins16(w, __uint_as_float((__float_as_uint(v) & ~255u) | (unsigned)(i * 16 + j))); }
        float e[16], sum = 0.f;
#pragma unroll
        for (int k = 0; k < 16; ++k) { e[k] = expf(w[k] - w[0]); sum += e[k]; }
        const float inv = 1.0f / sum;
        int ide[8]; float gte[8];
#pragma unroll
        for (int k = 0; k < 8; ++k) {
            float wa = w[k], wb = w[8 + k], ea = e[k], eb = e[8 + k];
            asm volatile("" : "+v"(wa), "+v"(wb), "+v"(ea), "+v"(eb));
            const float wv = hi ? wb : wa;
            const unsigned pl = __float_as_uint(wv) & 255u;
            ide[k] = (int)(lidx[pl >> 4] * 128u + lidx[16 + (pl & 15u)]);
            gte[k] = (hi ? eb : ea) * inv;
        }
        int* ep = eid + (size_t)t * 128 + h * 16 + hi * 8; float* gp = gate + (size_t)t * 128 + h * 16 + hi * 8;
        *(int4*)ep = make_int4(ide[0], ide[1], ide[2], ide[3]); *(int4*)(ep + 4) = make_int4(ide[4], ide[5], ide[6], ide[7]);
        *(float4*)gp = make_float4(gte[0], gte[1], gte[2], gte[3]); *(float4*)(gp + 4) = make_float4(gte[4], gte[5], gte[6], gte[7]);
    }
}

typedef float f32x4_t __attribute__((ext_vector_type(4)));
typedef __bf16 bf16x2v __attribute__((ext_vector_type(2)));
__device__ __forceinline__ float dot2bf(unsigned a, unsigned b, float c) { return __builtin_amdgcn_fdot2_f32_bf16(__builtin_bit_cast(bf16x2v, a), __builtin_bit_cast(bf16x2v, b), c, false); }
__device__ __forceinline__ void cnt_gt(int& cnt, unsigned a, unsigned b) { asm("v_cmp_gt_u32_e32 vcc, %1, %2\n\tv_addc_co_u32_e32 %0, vcc, 0, %0, vcc" : "+v"(cnt) : "v"(a), "v"(b) : "vcc"); }
__device__ __forceinline__ void cnt_eq(int& cnt, unsigned a, unsigned b) { asm("v_cmp_eq_u32_e32 vcc, %1, %2\n\tv_addc_co_u32_e32 %0, vcc, 0, %0, vcc" : "+v"(cnt) : "v"(a), "v"(b) : "vcc"); }
__device__ __forceinline__ unsigned flag_gt(unsigned a, unsigned b) { unsigned r; asm("v_cmp_gt_u32_e32 vcc, %1, %2\n\tv_cndmask_b32_e64 %0, 0, 1, vcc" : "=v"(r) : "v"(a), "v"(b) : "vcc"); return r; }
__device__ __forceinline__ unsigned flag_eq(unsigned a, unsigned b) { unsigned r; asm("v_cmp_eq_u32_e32 vcc, %1, %2\n\tv_cndmask_b32_e64 %0, 0, 1, vcc" : "=v"(r) : "v"(a), "v"(b) : "vcc"); return r; }
__device__ __forceinline__ void cnt_ge(int& cnt, unsigned key, unsigned cand) { asm("v_cmp_ge_u32_e32 vcc, %1, %2\n\tv_addc_co_u32_e32 %0, vcc, 0, %0, vcc" : "+v"(cnt) : "v"(key), "v"(cand) : "vcc"); }

typedef __attribute__((address_space(3))) unsigned lds_u32;
template <int SHIFT> __device__ __forceinline__ unsigned radix_pass(const unsigned (&key)[64], unsigned pre, lds_u32* hist, int lane, int& need) {
    typedef unsigned u32x4v __attribute__((ext_vector_type(4)));
    typedef __attribute__((address_space(3))) u32x4v lds_u32x4;
    { const u32x4v z4 = {0u, 0u, 0u, 0u};
#pragma unroll
      for (int i = 0; i < 8; ++i) ((lds_u32x4*)(hist + lane * 32))[i] = z4; }
    const unsigned cp = (unsigned)(lane & 7);
#pragma unroll
    for (int j = 0; j < 64; ++j) {
        const unsigned d = (key[j] >> SHIFT) & 255u;
        bool m;
        if (SHIFT == 24) m = key[j] != 0u; else m = (key[j] >> ((SHIFT + 8) & 31)) == pre;
        if (m) __hip_atomic_fetch_add(hist + ((d << 3) | cp), 1u, __ATOMIC_RELAXED, __HIP_MEMORY_SCOPE_WORKGROUP);
    }
    unsigned dsum[4]; unsigned sumL = 0u;
#pragma unroll
    for (int i = 0; i < 4; ++i) { const u32x4v v0 = ((const lds_u32x4*)(hist + lane * 32))[2 * i], v1 = ((const lds_u32x4*)(hist + lane * 32))[2 * i + 1];
        dsum[i] = ((v0.x + v0.y) + (v0.z + v0.w)) + ((v1.x + v1.y) + (v1.z + v1.w)); sumL += dsum[i]; }
    unsigned incl = sumL;
#pragma unroll
    for (int o = 1; o < 64; o <<= 1) { const unsigned t = (unsigned)__shfl_down((int)incl, o); if (lane + o < 64) incl += t; }
    const unsigned above = incl - sumL;
    const bool own = (above < (unsigned)need) && ((unsigned)need <= above + sumL);
    const int owner = __ffsll((long long)__ballot(own)) - 1;
    unsigned acc = above; int sel = -1; unsigned cab = 0u;
#pragma unroll
    for (int i = 3; i >= 0; --i) { const unsigned c = dsum[i]; const bool hit = (sel < 0) && (acc + c >= (unsigned)need); cab = hit ? acc : cab; sel = hit ? i : sel; acc += c; }
    const int ow = owner < 0 ? 0 : owner;
    const unsigned digit = (unsigned)__builtin_amdgcn_readlane(sel, ow) + (unsigned)(4 * ow);
    need -= (int)__builtin_amdgcn_readlane((int)cab, ow);
    return digit;
}
#ifndef TS_SEL
#define TS_SEL 0
#endif
#define ITS_B() do { if (TS_SEL >= 20 && TS_SEL <= 25 && WV_ == 0 && LANEID() == 0) ((volatile __attribute__((address_space(3))) unsigned long long*)((__attribute__((address_space(3))) unsigned char*)lds + 147456 - 16 - 32))[0] = __builtin_amdgcn_s_memrealtime(); } while (0)
#define ITS_E(k) do { if ((k) == TS_SEL && WV_ == 0 && LANEID() == 0) { volatile __attribute__((address_space(3))) unsigned long long* w_ = (volatile __attribute__((address_space(3))) unsigned long long*)((__attribute__((address_space(3))) unsigned char*)lds + 147456 - 16 - 32); w_[1] += __builtin_amdgcn_s_memrealtime() - w_[0]; } } while (0)
__device__ void index_fast_phase(int WV_, const bf16* P, unsigned char* mask, float* kmean, float* scratch_all, unsigned char* lds) {
    const int tid = LTID(WV_), lane = tid & 63, wave = tid >> 6, bid = LBID(), G = LGRID();
    float* s_part = (float*)lds;
    ITS_B();
    for (int k = bid; k < 256; k += G) {
        const int b = k >> 6, h = (k >> 4) & 3, blk = k & 15;
        const bf16* kp = P + (size_t)(b * S_ + blk * 256 + wave * 32) * NP + C_KC + h * 64 + lane;
        float a = 0.f;
#pragma unroll 8
        for (int j = 0; j < 32; ++j) a += bf2f(kp[(size_t)j * NP]);
        __syncthreads();
        s_part[wave * 64 + lane] = a;
        __syncthreads();
        if (tid < 64) { float s = 0.f;
#pragma unroll
            for (int w = 0; w < 8; ++w) s += s_part[w * 64 + tid];
            kmean[((b * 4 + h) * 16 + blk) * 64 + tid] = s * (1.0f / 256.0f); }
    }
    ITS_E(22);
    float* scr = scratch_all + (size_t)bid * (16 * 4096);
    const int lq = lane & 15, g4 = lane >> 4;
    for (int ui = bid; ui < 1024; ui += G) {
        const int b = ui >> 8, k = ui & 255, tile = (b & 1) ? 255 - k : k, q0 = tile * 16;
        const bf16* Pb = P + (size_t)b * S_ * NP;
        const int ntiles = tile + 1;
        ITS_B();
        bf16x8_t qf[8]; float wi[8];
        { const bf16* qp = Pb + (size_t)(q0 + lq) * NP + C_QI + 8 * g4;
#pragma unroll
          for (int h = 0; h < 8; ++h) qf[h] = *(const bf16x8_t*)(qp + 32 * h);
          const uint4 wv = *(const uint4*)(Pb + (size_t)(q0 + lq) * NP + C_WI); unpack8(wv, wi); }
        for (int kt = wave; kt < ntiles; kt += NWAVE) {
            const bf16x8_t af = *(const bf16x8_t*)(Pb + (size_t)(kt * 16 + lq) * NP + C_KI + 8 * g4);
            f32x4_t sc = {0.f, 0.f, 0.f, 0.f};
#pragma unroll
            for (int h = 0; h < 8; ++h) {
                const f32x4_t z = {0.f, 0.f, 0.f, 0.f};
                const f32x4_t a = __builtin_amdgcn_mfma_f32_16x16x32_bf16(af, qf[h], z, 0, 0, 0);
#pragma unroll
                for (int r = 0; r < 4; ++r) sc[r] += fmaxf(a[r], 0.f) * wi[h];
            }
#pragma unroll
            for (int r = 0; r < 4; ++r) { sc[r] *= 0.0625f; if (sc[r] == 0.f) sc[r] = 0.f; }
            *(f32x4_t*)(scr + (size_t)lq * 4096 + kt * 16 + 4 * g4) = sc;
        }
        __threadfence_block();
        __syncthreads();
        __threadfence_block();
        ITS_E(20); ITS_B();
        lds_u32* hist = (lds_u32*)((__attribute__((address_space(3))) unsigned char*)lds + 2048) + wave * 2048;
#pragma unroll 1
        for (int qi = 0; qi < 2; ++qi) {
            const int ql = 2 * wave + qi, q = q0 + ql;
            const float* row = scr + (size_t)ql * 4096 + lane * 64;
            const int qrel = q - lane * 64;
            unsigned key[64];
            if (qrel >= 0) {
#pragma unroll
                for (int j4 = 0; j4 < 16; ++j4) {
                    const float4 v = ((const float4*)row)[j4];
                    const unsigned u[4] = {__float_as_uint(v.x), __float_as_uint(v.y), __float_as_uint(v.z), __float_as_uint(v.w)};
#pragma unroll
                    for (int e = 0; e < 4; ++e) { const unsigned t = u[e] ^ ((unsigned)((int)u[e] >> 31) | 0x80000000u); const unsigned inval = (unsigned)((qrel - (j4 * 4 + e)) >> 31); key[j4 * 4 + e] = t & ~inval; }
                    if ((j4 & 3) == 3) asm volatile("" ::: "memory");
                }
            } else {
#pragma unroll
                for (int j = 0; j < 64; ++j) key[j] = 0u;
            }
            ITS_E(23); ITS_B();
            unsigned wlo = 0u, whi = 0u;
            if (q + 1 > 256) {
                int need = 256;
                const unsigned d1 = radix_pass<24>(key, 0u, hist, lane, need);
                const unsigned d2 = radix_pass<16>(key, d1, hist, lane, need);
                const unsigned d3 = radix_pass<8>(key, (d1 << 8) | d2, hist, lane, need);
                const unsigned d4 = radix_pass<0>(key, (d1 << 16) | (d2 << 8) | d3, hist, lane, need);
                const unsigned prefix = (d1 << 24) | (d2 << 16) | (d3 << 8) | d4;
                ITS_E(24); ITS_B();
                int ceq = 0;
#pragma unroll
                for (int j = 0; j < 64; ++j) cnt_eq(ceq, key[j], prefix);
                ceq = wave_sum_i(ceq);
                int X = 4096;
                if (ceq != need) {
                    int X0 = 0;
#pragma unroll 1
                    for (int bit = 11; bit >= 0; --bit) {
                        const int c = X0 | (1 << bit);
                        int cnt = 0; const int crel = c - lane * 64;
#pragma unroll
                        for (int j = 0; j < 64; ++j) cnt_eq(cnt, (key[j] ^ prefix) | ~(unsigned)((j - crel) >> 31), 0u);
                        cnt = wave_sum_i(cnt);
                        if (cnt < need) X0 = c;
                    }
                    X = X0 + 1;
                }
                const int xrel = X - lane * 64;
#pragma unroll
                for (int j = 0; j < 32; ++j) {
                    const unsigned s0 = flag_gt(key[j], prefix) | flag_eq((key[j] ^ prefix) | ~(unsigned)((j - xrel) >> 31), 0u);
                    const unsigned s1 = flag_gt(key[32 + j], prefix) | flag_eq((key[32 + j] ^ prefix) | ~(unsigned)((32 + j - xrel) >> 31), 0u);
                    wlo |= s0 << j; whi |= s1 << j;
                }
            } else {
#pragma unroll
                for (int j = 0; j < 32; ++j) { wlo |= (~(unsigned)((qrel - j) >> 31) & 1u) << j; whi |= (~(unsigned)((qrel - 32 - j) >> 31) & 1u) << j; }
            }
            ((uint2*)(mask + (size_t)(b * S_ + q) * 512))[lane] = make_uint2(wlo, whi);
            ITS_E(25); ITS_B();
        }
        ITS_E(21);
        __syncthreads();
    }
}

constexpr int MG_P = 72;
constexpr int MG_TILE_BYTES = 128 * MG_P * 2;
__device__ void merge_fast_phase(int WV_, const bf16* P, const bf16* ys, const bf16* wbt  , bf16* merged, unsigned char* lds) {
    const int tid = LTID(WV_), lane = tid & 63, wave = tid >> 6, r32 = lane & 31, hi = lane >> 5, wt = wave & 3, wd = wave >> 2;
    const int srow0 = tid >> 3, sch = tid & 7;
    for (int tile = LBID(); tile < 1024; tile += LGRID()) {
        const int tok0 = (tile >> 3) * 128, d0 = (tile & 7) * 128;
        f32x16_t mer[2], acc[2];
#pragma unroll
        for (int r = 0; r < 16; ++r) { mer[0][r] = 0.f; mer[1][r] = 0.f; acc[0][r] = 0.f; acc[1][r] = 0.f; }
        uint4 RW00, RW01, RW10, RW11, RY00, RY01, RY10, RY11;
#define MG_GLOAD(st_, R_) do { const int n_ = (st_) >> 2, kc_ = (st_) & 3; \
            RW##R_##0 = *(const uint4*)(wbt + ((size_t)n_ * 1024 + d0 + srow0) * 256 + kc_ * 64 + sch * 8); \
            RW##R_##1 = *(const uint4*)(wbt + ((size_t)n_ * 1024 + d0 + srow0 + 64) * 256 + kc_ * 64 + sch * 8); \
            RY##R_##0 = *(const uint4*)(ys + (size_t)(tok0 + srow0) * 1024 + n_ * 256 + kc_ * 64 + sch * 8); \
            RY##R_##1 = *(const uint4*)(ys + (size_t)(tok0 + srow0 + 64) * 1024 + n_ * 256 + kc_ * 64 + sch * 8); } while (0)
#define MG_SSTORE(buf_, R_) do { bf16* wl_ = (bf16*)(lds + (buf_) * 2 * MG_TILE_BYTES); bf16* yl_ = (bf16*)(lds + (buf_) * 2 * MG_TILE_BYTES + MG_TILE_BYTES); \
            *(uint4*)(wl_ + srow0 * MG_P + sch * 8) = RW##R_##0; *(uint4*)(wl_ + (srow0 + 64) * MG_P + sch * 8) = RW##R_##1; \
            *(uint4*)(yl_ + srow0 * MG_P + sch * 8) = RY##R_##0; *(uint4*)(yl_ + (srow0 + 64) * MG_P + sch * 8) = RY##R_##1; } while (0)
        __syncthreads();
        MG_GLOAD(0, 0); MG_GLOAD(1, 1);
        MG_SSTORE(0, 0);
        __syncthreads();
#define MG_STAGE(PAR_, OTH_) do { const int buf = PAR_; \
            if (st + 2 < 16) MG_GLOAD(st + 2, PAR_); \
            const bf16* wl = (const bf16*)(lds + buf * 2 * MG_TILE_BYTES); const bf16* yl = (const bf16*)(lds + buf * 2 * MG_TILE_BYTES + MG_TILE_BYTES); \
            _Pragma("unroll") for (int ks = 0; ks < 4; ++ks) { \
                const bf16x8_t bq = *(const bf16x8_t*)(yl + (32 * wt + r32) * MG_P + 16 * ks + 8 * hi); \
                const bf16x8_t a0 = *(const bf16x8_t*)(wl + (64 * wd + r32) * MG_P + 16 * ks + 8 * hi); \
                const bf16x8_t a1 = *(const bf16x8_t*)(wl + (64 * wd + 32 + r32) * MG_P + 16 * ks + 8 * hi); \
                acc[0] = __builtin_amdgcn_mfma_f32_32x32x16_bf16(a0, bq, acc[0], 0, 0, 0); \
                acc[1] = __builtin_amdgcn_mfma_f32_32x32x16_bf16(a1, bq, acc[1], 0, 0, 0); } \
            if ((st & 3) == 3) { \
                const int n = st >> 2; \
                const bf16* gp = P + (size_t)(tok0 + 32 * wt + r32) * NP + C_G + n * 1024 + d0 + 64 * wd + 4 * hi; \
                _Pragma("unroll") for (int dt = 0; dt < 2; ++dt) \
                _Pragma("unroll") for (int g = 0; g < 4; ++g) { \
                        const uint2 gv = *(const uint2*)(gp + 32 * dt + 8 * g); \
                        const float g0 = __uint_as_float(gv.x << 16), g1 = __uint_as_float(gv.x & 0xffff0000u), g2 = __uint_as_float(gv.y << 16), g3 = __uint_as_float(gv.y & 0xffff0000u); \
                        mer[dt][4 * g + 0] += acc[dt][4 * g + 0] * __builtin_amdgcn_rcpf(1.f + __builtin_amdgcn_exp2f(-LOG2E * g0)); \
                        mer[dt][4 * g + 1] += acc[dt][4 * g + 1] * __builtin_amdgcn_rcpf(1.f + __builtin_amdgcn_exp2f(-LOG2E * g1)); \
                        mer[dt][4 * g + 2] += acc[dt][4 * g + 2] * __builtin_amdgcn_rcpf(1.f + __builtin_amdgcn_exp2f(-LOG2E * g2)); \
                        mer[dt][4 * g + 3] += acc[dt][4 * g + 3] * __builtin_amdgcn_rcpf(1.f + __builtin_amdgcn_exp2f(-LOG2E * g3)); } \
                _Pragma("unroll") for (int r = 0; r < 16; ++r) { acc[0][r] = 0.f; acc[1][r] = 0.f; } } \
            if (st + 1 < 16) MG_SSTORE(OTH_, OTH_); \
            __syncthreads(); } while (0)
#pragma unroll 1
        for (int st2 = 0; st2 < 16; st2 += 2) { { const int st = st2; MG_STAGE(0, 1); } { const int st = st2 + 1; MG_STAGE(1, 0); } }
#undef MG_STAGE
#undef MG_GLOAD
#undef MG_SSTORE
        bf16* mp = merged + (size_t)(tok0 + 32 * wt + r32) * 1024 + d0 + 64 * wd + 4 * hi;
#pragma unroll
        for (int dt = 0; dt < 2; ++dt)
#pragma unroll
            for (int g = 0; g < 4; ++g)
                *(uint2*)(mp + 32 * dt + 8 * g) = make_uint2(cvtpk(mer[dt][4 * g], mer[dt][4 * g + 1]), cvtpk(mer[dt][4 * g + 2], mer[dt][4 * g + 3]));
    }
}
#define LAS __attribute__((address_space(3)))
#define XB_TMO      128
#define XB_XCNT(j)  (256  + 64 * (j))
#define XB_XSUB(j)  (1280 + 64 * (j))
#define XB_XGEN(j)  (2304 + 64 * (j))
#define XB_TOP      3328
#define XB_TOPGEN   3392
#define XCD_BAR_WORDS 3456
#define XB_SPIN_CAP (1u << 18)

__device__ __forceinline__ unsigned xb_ld(unsigned* p)              { return __hip_atomic_load(p, __ATOMIC_RELAXED, __HIP_MEMORY_SCOPE_AGENT); }
__device__ __forceinline__ unsigned xb_add(unsigned* p, unsigned v) { return __hip_atomic_fetch_add(p, v, __ATOMIC_RELAXED, __HIP_MEMORY_SCOPE_AGENT); }
__device__ __forceinline__ unsigned xb_xcc_id() { return (unsigned)__builtin_amdgcn_s_getreg((3 << 11) | 20) & 0xFu; }
#define XB_SPIN(cond, bar) do { unsigned _sp = 0; while (cond) { __builtin_amdgcn_s_sleep(1); \
    if ((++_sp & 255u) == 0u) { if (xb_ld(&(bar)[XB_TMO])) break; if (_sp > XB_SPIN_CAP) { atomicAdd(&(bar)[XB_TMO], 1u); break; } } } } while (0)

struct XcdBarrier {
    unsigned* bar; unsigned x;
    volatile LAS unsigned* st;
};

__device__ __forceinline__ XcdBarrier xcd_barrier_post(unsigned* bar, volatile LAS unsigned* st) {
    XcdBarrier b; b.bar = bar; b.x = xb_xcc_id(); b.st = st;
    if (threadIdx.x == 0) (void)xb_add(&bar[XB_XCNT(b.x)], 1u);
    return b;
}
__device__ __forceinline__ void xcd_barrier_complete(unsigned* bar, unsigned x, unsigned& nloc, unsigned& nx) {
    const unsigned G = gridDim.x * gridDim.y * gridDim.z;
    unsigned sum, cnt, mine, sp = 0u;
    for (;;) {
        sum = 0u; cnt = 0u; mine = 0u;
#pragma unroll
        for (unsigned j = 0; j < 16; ++j) { const unsigned c = xb_ld(&bar[XB_XCNT(j)]); sum += c; cnt += (c > 0u) ? 1u : 0u; mine = (j == x) ? c : mine; }
        if (sum == G) break;
        __builtin_amdgcn_s_sleep(1);
        if ((++sp & 255u) == 0u) { if (xb_ld(&bar[XB_TMO])) break; if (sp > XB_SPIN_CAP) { atomicAdd(&bar[XB_TMO], 1u); break; } }
    }
    nloc = mine > 0u ? mine : 1u; nx = cnt > 0u ? cnt : 1u;
}

__device__ __forceinline__ void xcd_barrier(const XcdBarrier& b, int wv_) {
    asm volatile("s_waitcnt vmcnt(0)" ::: "memory");
    __syncthreads();
    if (wv_ == 0 && LANEID() == 0) {
        unsigned* bar = b.bar;
        __builtin_amdgcn_s_waitcnt(0);
        unsigned nloc = b.st[0], nx = b.st[1];
        if (nloc == 0u) { xcd_barrier_complete(bar, b.x, nloc, nx); b.st[0] = nloc; b.st[1] = nx; }
        const unsigned old = xb_add(&bar[XB_XSUB(b.x)], 1u);
        const unsigned gen = old / nloc;
        if (old + 1u == (gen + 1u) * nloc) {
            __builtin_amdgcn_fence(__ATOMIC_RELEASE, "agent");
            asm volatile("s_waitcnt vmcnt(0)" ::: "memory");
            const unsigned og = xb_add(&bar[XB_TOP], 1u);
            const unsigned tg = og / nx;
            if (og + 1u == (tg + 1u) * nx) xb_add(&bar[XB_TOPGEN], 1u);
            else XB_SPIN(xb_ld(&bar[XB_TOPGEN]) == tg, bar);
            __builtin_amdgcn_fence(__ATOMIC_ACQUIRE, "agent");
            xb_add(&bar[XB_XGEN(b.x)], 1u);
            asm volatile("s_waitcnt vmcnt(0)" ::: "memory");
        } else {
            XB_SPIN(xb_ld(&bar[XB_XGEN(b.x)]) == gen, bar);
            __builtin_amdgcn_fence(__ATOMIC_ACQUIRE, "agent");
            asm volatile("s_waitcnt vmcnt(0)" ::: "memory");
        }
    }
    __syncthreads();
}

enum { PH_PRO = 0, PH_GIN, PH_INDEX, PH_ATTN, PH_MERGE, PH_GOUT, PH_LN1, PH_GQ, PH_ROUTE, PH_PEER };
template <int PH> __device__ __forceinline__ void run_phase(int WV_, const Params& p_unused, int l, unsigned char* lds_raw) {
    size_t kaoff_ = 0; asm volatile("" : "+s"(kaoff_));
    typedef const __attribute__((address_space(4))) char* kaptr_t;
    const __attribute__((address_space(4))) Params& p = *(const __attribute__((address_space(4))) Params*)((kaptr_t)__builtin_amdgcn_kernarg_segment_ptr() + kaoff_);
    float* sm = (float*)lds_raw;
    size_t wsoff_ = 0; asm volatile("" : "+s"(wsoff_));
    unsigned char* ws = p.ws + wsoff_;
    float* hbuf = p.out;
    bf16* hb = (bf16*)(ws + WS_HB);
    bf16* P = (bf16*)(ws + WS_P);
    bf16* ys = (bf16*)(ws + WS_YS);
    bf16* mrg = (bf16*)(ws + WS_MRG);
    float* mix = (float*)(ws + WS_MIX);
    float* qb = (float*)(ws + WS_Q);
    unsigned char* mask = ws + WS_MASK;
    int* eid = (int*)(ws + WS_EID);
    float* gate = (float*)(ws + WS_GATE);
    float* kmean = (float*)(ws + WS_KMEAN);
    const float* hin = (l == 0) ? p.in[0] : hbuf;
    if (PH == PH_PRO) { Params pc; for (int i = 0; i < 13; ++i) pc.in[i] = p.in[i]; pc.out = p.out; pc.ws = ws;
        prologue_phase(WV_, pc, sm); convert_tables(WV_, pc);
        for (int i = LBID() * NTHR + LTID(WV_); i < DEPTH_ * 8 * 2 * 128 * 64 / 4; i += LGRID() * NTHR) { const float4 v = ((const float4*)p.in[8])[i]; ((uint2*)(ws + WS_SKB))[i] = make_uint2(pk2(v.x, v.y), pk2(v.z, v.w)); } if (LBID() < 2) build_unit_table((unsigned*)(ws + WS_CTL) + 1024, LBID() * NTHR + LTID(WV_)); }
    else if (PH == PH_GIN) {
        pg8::Gemm g{hb, (const bf16*)(ws + WS_WIN_T + l * WIN_T_BYTES), T_, NP, 1024};
        pg8::StaticOrder S; S.init(T_, NP, (int)LGRID(), (int)LBID());
        pg8::EpiBf16<0> E{P, NP, nullptr, 0, 0, 1.f};
        pg8::gemm_phase<pg8::EpiBf16<0>, pg8::StaticOrder, true, true>(WV_, (PG8_LAS unsigned char*)lds_raw, g, S, E);
    }
    else if (PH == PH_INDEX) index_fast_phase(WV_, P, mask, kmean, (float*)(ws + WS_YS), lds_raw);
    else if (PH == PH_ATTN) attn_fast_phase(WV_, P, mask, kmean, p.in[4] + l * 4, ys, (const unsigned*)(ws + WS_CTL) + 1024, (unsigned*)(ws + WS_CTL) + 64 * l, lds_raw);
    else if (PH == PH_MERGE) merge_fast_phase(WV_, P, ys, (const bf16*)(ws + WS_WBR_T) + (size_t)l * 4 * 1024 * 256, mrg, lds_raw);
    else if (PH == PH_GOUT) {
        pg8::Gemm g{mrg, (const bf16*)(ws + WS_WOUT_T) + (size_t)l * 1024 * 1024, T_, 1024, 1024};
        pg8::StaticOrder S; S.init(T_, 1024, (int)LGRID(), (int)LBID());
        pg8::EpiResY E{hin, hbuf, hb, (float*)(ws + WS_STATS) + (size_t)l * T_ * 2, ALPHA};
        pg8::gemm_phase<pg8::EpiResY, pg8::StaticOrder, true, true>(WV_, (PG8_LAS unsigned char*)lds_raw, g, S, E);
    }
    else if (PH == PH_GQ) {
        pg8::Gemm g{hb, (const bf16*)(ws + WS_WQ_T) + (size_t)l * 1024 * 1024, T_, 1024, 1024};
        pg8::StaticOrder S; S.init(T_, 1024, (int)LGRID(), (int)LBID());
        pg8::EpiLnFold E{(bf16*)qb, (const float*)(ws + WS_STATS) + (size_t)l * T_ * 2, (const float*)(ws + WS_COLS) + l * 2048, (const float*)(ws + WS_COLS) + l * 2048 + 1024, LN_EPS};
        pg8::gemm_phase<pg8::EpiLnFold, pg8::StaticOrder, true, true>(WV_, (PG8_LAS unsigned char*)lds_raw, g, S, E);
    }
    else if (PH == PH_ROUTE) route_fast_phase(WV_, (const bf16*)qb, (const bf16*)(ws + WS_SKB) + (size_t)l * 8 * 2 * 128 * 64, eid, gate, lds_raw);
    else peer_fast_phase(WV_, hbuf, hb, eid, gate, ws + WS_UV + (size_t)l * 32 * MiB, p.in[5] + l * 1024, p.in[6] + l * 1024, p.in[11] + l * 1024, p.in[12] + l * 1024, lds_raw);
}

constexpr int CW_BAR = 4096;
constexpr int LDS_BARST = LDS_BYTES - 16;
__global__ void __launch_bounds__(NTHR, 2) mk_fwd(Params p) {
    extern __shared__ __attribute__((aligned(16))) unsigned char lds_raw[];
    cg::grid_group grid = cg::this_grid();
    const int WV_ = __builtin_amdgcn_readfirstlane((int)threadIdx.x >> 6);
    { volatile LAS unsigned* bst0 = (volatile LAS unsigned*)((LAS unsigned char*)lds_raw + LDS_BARST); if (threadIdx.x < 4) bst0[threadIdx.x] = 0u; }
    __syncthreads();
    volatile LAS unsigned* bst = (volatile LAS unsigned*)((LAS unsigned char*)lds_raw + LDS_BARST);
    (void)xcd_barrier_post((unsigned*)(p.ws + WS_CTL) + CW_BAR, bst);
#define GRID_BAR() do { XcdBarrier b_; b_.bar = (unsigned*)(p.ws + WS_CTL) + CW_BAR; b_.x = xb_xcc_id(); b_.st = (volatile LAS unsigned*)((LAS unsigned char*)lds_raw + LDS_BARST); xcd_barrier(b_, WV_); } while (0)
    run_phase<PH_PRO>(WV_, p, 0, lds_raw);
    grid.sync();
#pragma unroll 1
    for (int l = 0; l < DEPTH_; ++l) {
        run_phase<PH_GIN>(WV_, p, l, lds_raw); GRID_BAR();
        run_phase<PH_INDEX>(WV_, p, l, lds_raw); GRID_BAR();
        run_phase<PH_ATTN>(WV_, p, l, lds_raw); GRID_BAR();
        run_phase<PH_MERGE>(WV_, p, l, lds_raw); GRID_BAR();
        run_phase<PH_GOUT>(WV_, p, l, lds_raw); GRID_BAR();
        run_phase<PH_GQ>(WV_, p, l, lds_raw); GRID_BAR();
        run_phase<PH_ROUTE>(WV_, p, l, lds_raw); GRID_BAR();
        run_phase<PH_PEER>(WV_, p, l, lds_raw); if (l + 1 < DEPTH_) GRID_BAR();
    }
}

extern "C" void kernel_launch(void* const* d_in, const int* in_sizes, int n_in, void* d_out, int out_size, void* d_ws, size_t ws_size, hipStream_t stream) {
    if (n_in != 13 || ws_size < WS_END) { fprintf(stderr, "kernel_launch: unexpected n_in %d / ws_size %zu; nothing launched\n", n_in, ws_size); return; }
    static int grid_blocks = 0;
    if (grid_blocks == 0) {
        int dev = 0, cus = 0, per_cu = 0;
        (void)hipGetDevice(&dev);
        (void)hipDeviceGetAttribute(&cus, hipDeviceAttributeMultiprocessorCount, dev);
        (void)hipFuncSetAttribute((const void*)mk_fwd, hipFuncAttributeMaxDynamicSharedMemorySize, LDS_BYTES);
        (void)hipOccupancyMaxActiveBlocksPerMultiprocessor(&per_cu, (const void*)mk_fwd, NTHR, LDS_BYTES);
        if (per_cu < 1) fprintf(stderr, "kernel_launch: occupancy query reports %d\n", per_cu);
        grid_blocks = cus;
    }
    Params p{};
    for (int i = 0; i < 13; ++i) p.in[i] = (const float*)d_in[i];
    p.out = (float*)d_out; p.ws = (unsigned char*)d_ws;
    (void)hipMemsetAsync(d_ws, 0, 2 * MiB, stream);
    void* args[] = {&p};
    hipError_t e = hipLaunchCooperativeKernel((const void*)mk_fwd, dim3(grid_blocks), dim3(NTHR), args, LDS_BYTES, stream);
    if (e != hipSuccess) fprintf(stderr, "cooperative launch failed: %s (grid %d)\n", hipGetErrorString(e), grid_blocks);
}
```

```cpp
#include <hip/hip_runtime.h>
#include <cstdio>
#include <cstdint>
#include <hip/hip_cooperative_groups.h>
namespace cg = cooperative_groups;

__device__ __forceinline__ int LANEID() { int l; asm volatile("v_mbcnt_lo_u32_b32 %0, -1, 0\n\tv_mbcnt_hi_u32_b32 %0, -1, %0" : "=v"(l)); return l; }
__device__ __forceinline__ int LTID(int wv) { return (wv << 6) | LANEID(); }
__device__ __forceinline__ int LBID() { int t = blockIdx.x; asm volatile("" : "+s"(t)); return t; }
__device__ __forceinline__ int LGRID() { int t = gridDim.x; asm volatile("" : "+s"(t)); return t; }
namespace pg8 {
#define PG8_LAS __attribute__((address_space(3)))
typedef unsigned short bf16_t;
typedef short bf16x8 __attribute__((ext_vector_type(8)));
typedef float f32x4 __attribute__((ext_vector_type(4)));
typedef unsigned u32x4 __attribute__((ext_vector_type(4)));
constexpr int BM = 256, BK = 64, HALF = 128, HTB = HALF * BK * 2  , STAGE_BYTES = 8 * HTB, NXCD = 8, WGM = 8;

__host__ __device__ __forceinline__ int lds_byte(int r, int c) { const int st = (r >> 4) * 2 + (c >> 5), rr = r & 15, cc = c & 31, ob = rr * 64 + cc * 2; return st * 1024 + (ob ^ (((ob >> 9) & 1) << 5)); }
__host__ __device__ __forceinline__ void stage_rc(int b, int& R, int& C) { const int st = b / 1024, sb = b % 1024, swz = sb ^ (((sb >> 9) & 1) << 5); R = (st >> 1) * 16 + swz / 64; C = (st & 1) * 32 + (swz % 64) / 2; }
__host__ __device__ __forceinline__ int perm32(int rho) { const int n = rho >> 4, i = rho & 15; return 8 * (i >> 2) + 4 * n + (i & 3); }

struct Unit { int pm, pn; };
struct Gemm { const bf16_t* A; const bf16_t* Bt; int M, N, K; };

struct StaticOrder {
    int nM, nN, nwg, G, c;
    __host__ __device__ void init(int M, int N, int G_, int c_) { nM = M / BM; nN = N / BM; nwg = nM * nN; G = G_; c = c_; }
    __host__ __device__ bool next(int i, Unit& u) const {
        const long L = (long)i * G + c; if (L >= nwg) return false;
        int wgid = (int)L; { const int q = nwg / NXCD, r = nwg % NXCD, xcd = wgid % NXCD, off = wgid / NXCD; wgid = (xcd < r ? xcd * (q + 1) : r * (q + 1) + (xcd - r) * q) + off; }
        const int nig = WGM * nN, gid = wgid / nig, fm = gid * WGM, gsz = (nM - fm) < WGM ? (nM - fm) : WGM;
        u.pm = fm + ((wgid % nig) % gsz); u.pn = (wgid % nig) / gsz; return true;
    }
    __device__ __forceinline__ void a_ready(const Unit&) const {}
    __device__ __forceinline__ void done(const Unit&) const {}
};

__device__ __forceinline__ unsigned cvt_pk_bf16(float lo, float hi) { unsigned r; asm volatile("v_cvt_pk_bf16_f32 %0, %1, %2" : "=v"(r) : "v"(lo), "v"(hi)); return r; }
typedef float f32x2 __attribute__((ext_vector_type(2)));
__device__ __forceinline__ f32x2 gelu_pk(f32x2 v) {
    const f32x2 av = __builtin_elementwise_abs(v), d = av * 0.2316418882f + 1.0f;
    f32x2 t; t.x = __builtin_amdgcn_rcpf(d.x); t.y = __builtin_amdgcn_rcpf(d.y);
    f32x2 q = t * 0.5307027145f + (-0.7265760135f); q = q * t + 0.7107068705f; q = q * t + (-0.142248368f); q = q * t + 0.127414796f; q = q * t;
    const f32x2 s = (v * v) * (-0.72134752044f);
    f32x2 e; e.x = __builtin_amdgcn_exp2f(s.x); e.y = __builtin_amdgcn_exp2f(s.y);
    const f32x2 m = v * (q * e), r = v - m;
    f32x2 o; o.x = v.x < 0.f ? m.x : r.x; o.y = v.y < 0.f ? m.y : r.y; return o;
}

template <int ACT  > struct EpiBf16 {
    static constexpr bool PERM = true, AFTER_DRAIN = false; static_assert(ACT == 0 || ACT == 1, "EpiBf16: ACT is 0 (none) or 1 (gelu_pk)");
    bf16_t* O; int ldc; const float* bias; int split_cols; size_t split_stride; float scale0;
    __device__ __forceinline__ void operator()(const f32x4 (&acc)[2][2][4][2], const Unit& u, int wr, int wc, int fr, int fq) const {
        { int ln_ = LANEID(); asm volatile("" : "+v"(ln_)); fr = ln_ & 15; fq = ln_ >> 4; }
        const int row0 = u.pm * BM + wr * 64 + fr; int colt = u.pn * BM; bf16_t* base = O;
        float sc = 1.f; if (split_cols) { const int t = colt / split_cols; base += (size_t)t * split_stride; colt -= t * split_cols; if (t == 0) sc = scale0; }
        const int col0 = colt + wc * 32 + 8 * fq, bcol0 = u.pn * BM + wc * 32 + 8 * fq;
        f32x4 bv[2][2];
#pragma unroll
        for (int bj = 0; bj < 2; ++bj)
#pragma unroll
            for (int n = 0; n < 2; ++n) bv[bj][n] = bias ? *(const f32x4*)(bias + bcol0 + bj * HALF + 4 * n) : (f32x4){0.f, 0.f, 0.f, 0.f};
#pragma unroll
        for (int ai = 0; ai < 2; ++ai)
#pragma unroll
            for (int m = 0; m < 4; ++m) { bf16_t* rowp = base + (size_t)(row0 + ai * HALF + m * 16) * ldc + col0;
#pragma unroll
                for (int bj = 0; bj < 2; ++bj) { f32x4 v0 = acc[ai][bj][m][0] + bv[bj][0], v1 = acc[ai][bj][m][1] + bv[bj][1];
                    if (ACT == 1) { f32x2 a = gelu_pk((f32x2){v0[0], v0[1]}), b = gelu_pk((f32x2){v0[2], v0[3]}), c = gelu_pk((f32x2){v1[0], v1[1]}), d = gelu_pk((f32x2){v1[2], v1[3]});
                        v0 = (f32x4){a.x, a.y, b.x, b.y}; v1 = (f32x4){c.x, c.y, d.x, d.y}; }
                    v0 = v0 * sc; v1 = v1 * sc; u32x4 w; w.x = cvt_pk_bf16(v0[0], v0[1]); w.y = cvt_pk_bf16(v0[2], v0[3]); w.z = cvt_pk_bf16(v1[0], v1[1]); w.w = cvt_pk_bf16(v1[2], v1[3]);
                    *(u32x4*)(rowp + bj * HALF) = w; } }
    }
};
template <class Epi, class Sched, bool ALIGN_EPI = false, bool SP2 = false>
__device__ __forceinline__ void gemm_phase(int WV_, PG8_LAS unsigned char* lds, const Gemm g, const Sched& S, const Epi& E) {
    const int tid = LTID(WV_), wid = __builtin_amdgcn_readfirstlane(tid >> 6), lane = tid & 63, wr = wid >> 2, wc = wid & 3, fr = lane & 15, fq = lane >> 4;
    const int K = g.K, nt = K / BK;
    unsigned voffA[2], voffB[2];
#pragma unroll
    for (int i = 0; i < 2; ++i) { int R, C; stage_rc(tid * 16 + i * 8192, R, C); const int Rb = Epi::PERM ? ((R & ~31) + perm32(R & 31)) : R;
        voffA[i] = (unsigned)(R * K + C) * 2u; voffB[i] = (unsigned)(Rb * K + C) * 2u; }
    const size_t kstep = (size_t)(BK * 2);
    const size_t hstep = (size_t)HALF * K * 2;
    const size_t tstep = 2 * hstep;
    const unsigned ldsw = (unsigned)wid * 1024u;
    const int aoff = lds_byte(wr * 64 + fr, fq * 8), boff = lds_byte(wc * 32 + fr, fq * 8);
#define PG8_SA(b, h) (((b) * 2 + (h)) * HTB)
#define PG8_SB(b, h) ((4 + (b) * 2 + (h)) * HTB)
#define PG8_STAGE(bufoff, gbase, voff) do { _Pragma("unroll") for (int _i = 0; _i < 2; ++_i) \
        __builtin_amdgcn_global_load_lds((const unsigned*)((const char*)(gbase) + (voff)[_i]), (PG8_LAS unsigned*)(lds + (bufoff) + ldsw + _i * 8192), 16, 0, 0); } while (0)
#define PG8_LDA(dst, b, h) do { _Pragma("unroll") for (int m = 0; m < 4; ++m) _Pragma("unroll") for (int k = 0; k < 2; ++k) dst[m][k] = *(const PG8_LAS bf16x8*)(lds + PG8_SA(b, h) + aoff + m * 2048 + k * 1024); } while (0)
#define PG8_LDB(dst, b, h) do { _Pragma("unroll") for (int n = 0; n < 2; ++n) _Pragma("unroll") for (int k = 0; k < 2; ++k) dst[n][k] = *(const PG8_LAS bf16x8*)(lds + PG8_SB(b, h) + boff + n * 2048 + k * 1024); } while (0)
#define PG8_MMA(ai, bj, At, Bt) do { __builtin_amdgcn_s_setprio(1); _Pragma("unroll") for (int m = 0; m < 4; ++m) _Pragma("unroll") for (int n = 0; n < 2; ++n) _Pragma("unroll") for (int k = 0; k < 2; ++k) \
        acc[ai][bj][m][n] = __builtin_amdgcn_mfma_f32_16x16x32_bf16(Bt[n][k], At[m][k], acc[ai][bj][m][n], 0, 0, 0); __builtin_amdgcn_s_setprio(0); } while (0)
#define PG8_WAIT_V(n) asm volatile("s_waitcnt vmcnt(" #n ")" ::: "memory")
#define PG8_WAIT_L(n) asm volatile("s_waitcnt lgkmcnt(" #n ")" ::: "memory")
#define PG8_BAR __builtin_amdgcn_s_barrier()
#define PG8_SCHED __builtin_amdgcn_sched_barrier(0)
    Unit cur, nxt; int ui = 0;
    if (!S.next(0, cur)) return;
    f32x4 acc[2][2][4][2];
#pragma unroll
    for (int a = 0; a < 2; ++a)
#pragma unroll
        for (int b = 0; b < 2; ++b)
#pragma unroll
            for (int m = 0; m < 4; ++m)
#pragma unroll
                for (int n = 0; n < 2; ++n) acc[a][b][m][n] = (f32x4){0.f, 0.f, 0.f, 0.f};
    bf16x8 At[4][2], B0[2][2], B1[2][2];
    const char* cA = (const char*)g.A + (size_t)cur.pm * tstep; const char* cB = (const char*)g.Bt + (size_t)cur.pn * tstep;
    S.a_ready(cur);
    if constexpr (SP2) {
        PG8_STAGE(PG8_SB(0, 0), cB, voffB); PG8_STAGE(PG8_SB(0, 1), cB + hstep, voffB); PG8_STAGE(PG8_SA(0, 0), cA, voffA); PG8_STAGE(PG8_SA(0, 1), cA + hstep, voffA);
        if (wr == 1) PG8_BAR;
        PG8_WAIT_V(2); PG8_BAR;
        PG8_STAGE(PG8_SB(1, 0), cB + kstep, voffB); PG8_STAGE(PG8_SA(1, 0), cA + kstep, voffA); PG8_STAGE(PG8_SB(1, 1), cB + hstep + kstep, voffB);
        PG8_WAIT_V(6); PG8_BAR;
    } else {
        PG8_STAGE(PG8_SB(0, 0), cB, voffB); PG8_STAGE(PG8_SA(0, 0), cA, voffA); PG8_STAGE(PG8_SB(0, 1), cB + hstep, voffB); PG8_STAGE(PG8_SA(0, 1), cA + hstep, voffA);
        if (wr == 1) PG8_BAR;
        PG8_WAIT_V(4); PG8_BAR;
        PG8_STAGE(PG8_SB(1, 0), cB + kstep, voffB); PG8_STAGE(PG8_SA(1, 0), cA + kstep, voffA); PG8_STAGE(PG8_SB(1, 1), cB + hstep + kstep, voffB);
        PG8_WAIT_V(6); PG8_BAR;
    }
    for (;;) {
        const bool has_next = S.next(ui + 1, nxt);
        const char* nA = has_next ? (const char*)g.A + (size_t)nxt.pm * tstep : cA; const char* nB = has_next ? (const char*)g.Bt + (size_t)nxt.pn * tstep : cB;
        for (int t = 0; t < nt; t += 2) {
            const bool last = (t == nt - 2);
            const char* a1 = cA + (size_t)(t + 1) * kstep;
            const char* a2 = last ? nA : cA + (size_t)(t + 2) * kstep; const char* b2 = last ? nB : cB + (size_t)(t + 2) * kstep;
            const char* a3 = a2 + kstep; const char* b3 = b2 + kstep;
            if (last && has_next) S.a_ready(nxt);
            if constexpr (SP2) {
            PG8_LDB(B0, 0, 0); PG8_LDB(B1, 0, 1); PG8_SCHED; PG8_LDA(At, 0, 0); PG8_STAGE(PG8_SA(1, 1), a1 + hstep, voffA);
            PG8_WAIT_V(8); PG8_WAIT_L(0); PG8_BAR; PG8_MMA(0, 0, At, B0); PG8_MMA(0, 1, At, B1); PG8_BAR; PG8_SCHED;
            PG8_LDA(At, 0, 1); PG8_STAGE(PG8_SB(0, 0), b2, voffB); PG8_STAGE(PG8_SB(0, 1), b2 + hstep, voffB); PG8_STAGE(PG8_SA(0, 0), a2, voffA);
            PG8_WAIT_V(8); PG8_WAIT_L(0); PG8_BAR; PG8_MMA(1, 0, At, B0); PG8_MMA(1, 1, At, B1); PG8_BAR; PG8_SCHED;
            PG8_LDB(B0, 1, 0); PG8_LDB(B1, 1, 1); PG8_SCHED; PG8_LDA(At, 1, 0); PG8_STAGE(PG8_SA(0, 1), a2 + hstep, voffA);
            PG8_WAIT_V(8); PG8_WAIT_L(0); PG8_BAR; PG8_MMA(0, 0, At, B0); PG8_MMA(0, 1, At, B1); PG8_BAR; PG8_SCHED;
            PG8_LDA(At, 1, 1); PG8_STAGE(PG8_SB(1, 0), b3, voffB); PG8_STAGE(PG8_SB(1, 1), b3 + hstep, voffB); PG8_STAGE(PG8_SA(1, 0), a3, voffA);
            PG8_WAIT_V(8); PG8_WAIT_L(0); PG8_BAR; PG8_MMA(1, 0, At, B0); PG8_MMA(1, 1, At, B1); PG8_BAR; PG8_SCHED;
            } else {
            PG8_LDB(B0, 0, 0); PG8_SCHED; PG8_LDA(At, 0, 0); PG8_STAGE(PG8_SA(1, 1), a1 + hstep, voffA);
            PG8_WAIT_L(8); PG8_BAR; PG8_WAIT_L(0); PG8_MMA(0, 0, At, B0); PG8_BAR; PG8_SCHED;
            PG8_LDB(B1, 0, 1); PG8_STAGE(PG8_SB(0, 0), b2, voffB);
            PG8_BAR; PG8_WAIT_L(0); PG8_MMA(0, 1, At, B1); PG8_BAR;
            PG8_LDA(At, 0, 1); PG8_STAGE(PG8_SA(0, 0), a2, voffA);
            PG8_BAR; PG8_WAIT_L(0); PG8_MMA(1, 0, At, B0); PG8_BAR; PG8_SCHED;
            PG8_STAGE(PG8_SB(0, 1), b2 + hstep, voffB);
            PG8_WAIT_V(6); PG8_BAR; PG8_MMA(1, 1, At, B1); PG8_BAR;
            PG8_LDB(B0, 1, 0); PG8_SCHED; PG8_LDA(At, 1, 0); PG8_STAGE(PG8_SA(0, 1), a2 + hstep, voffA);
            PG8_WAIT_L(8); PG8_BAR; PG8_WAIT_L(0); PG8_MMA(0, 0, At, B0); PG8_BAR; PG8_SCHED;
            PG8_LDB(B1, 1, 1); PG8_STAGE(PG8_SB(1, 0), b3, voffB);
            PG8_BAR; PG8_WAIT_L(0); PG8_MMA(0, 1, At, B1); PG8_BAR;
            PG8_LDA(At, 1, 1); PG8_STAGE(PG8_SA(1, 0), a3, voffA);
            PG8_BAR; PG8_WAIT_L(0); PG8_MMA(1, 0, At, B0); PG8_BAR; PG8_SCHED;
            PG8_STAGE(PG8_SB(1, 1), b3 + hstep, voffB);
            PG8_WAIT_V(6); PG8_BAR; PG8_MMA(1, 1, At, B1); PG8_BAR;
            }
        }
        if constexpr (ALIGN_EPI) { if (wr == 0) PG8_BAR; }
        if constexpr (!Epi::AFTER_DRAIN) { E(acc, cur, wr, wc, fr, fq); S.done(cur); }
        if (!has_next) break;
#pragma unroll
        for (int a = 0; a < 2; ++a)
#pragma unroll
            for (int b = 0; b < 2; ++b)
#pragma unroll
                for (int m = 0; m < 4; ++m)
#pragma unroll
                    for (int n = 0; n < 2; ++n) acc[a][b][m][n] = (f32x4){0.f, 0.f, 0.f, 0.f};
        cur = nxt; cA = nA; cB = nB; ++ui;
        if constexpr (ALIGN_EPI) { if (wr == 1) PG8_BAR; }
    }
    PG8_WAIT_V(0);
    if constexpr (!ALIGN_EPI) { if (wr == 0) PG8_BAR; }
    PG8_BAR;
    if constexpr (Epi::AFTER_DRAIN) { E.fused(acc, cur, wr, wc, fr, fq, lds, wid, lane); S.done(cur); }
#undef PG8_SA
#undef PG8_SB
#undef PG8_STAGE
#undef PG8_LDA
#undef PG8_LDB
#undef PG8_MMA
#undef PG8_WAIT_V
#undef PG8_WAIT_L
#undef PG8_BAR
#undef PG8_SCHED
}
}
namespace pg8 {
struct EpiF32 {
    static constexpr bool PERM = false, AFTER_DRAIN = false;
    float* O; int ldc;
    __device__ __forceinline__ void operator()(const f32x4 (&acc)[2][2][4][2], const Unit& u, int wr, int wc, int fr, int fq) const {
        { int ln_ = LANEID(); asm volatile("" : "+v"(ln_)); fr = ln_ & 15; fq = ln_ >> 4; }
        const int row0 = u.pm * BM + wr * 64 + fr, col0 = u.pn * BM + wc * 32 + 4 * fq;
#pragma unroll
        for (int ai = 0; ai < 2; ++ai)
#pragma unroll
            for (int m = 0; m < 4; ++m) { float* rowp = O + (size_t)(row0 + ai * HALF + m * 16) * ldc + col0;
#pragma unroll
                for (int bj = 0; bj < 2; ++bj)
#pragma unroll
                    for (int n = 0; n < 2; ++n) *(f32x4*)(rowp + bj * HALF + n * 16) = acc[ai][bj][m][n]; }
    }
};
struct EpiResY {
    static constexpr bool PERM = false, AFTER_DRAIN = false;
    const float* hin; float* yout; bf16_t* yb; float* stats; float alpha;
    __device__ __forceinline__ void operator()(const f32x4 (&acc)[2][2][4][2], const Unit& u, int wr, int wc, int fr, int fq) const {
        { int ln_ = LANEID(); asm volatile("" : "+v"(ln_)); fr = ln_ & 15; fq = ln_ >> 4; }
        const int row0 = u.pm * BM + wr * 64 + fr, col0 = u.pn * BM + wc * 32 + 4 * fq;
#pragma unroll
        for (int ai = 0; ai < 2; ++ai)
#pragma unroll
            for (int m = 0; m < 4; ++m) {
                const int row = row0 + ai * HALF + m * 16;
                float s = 0.f, s2 = 0.f;
#pragma unroll
                for (int bj = 0; bj < 2; ++bj)
#pragma unroll
                    for (int n = 0; n < 2; ++n) {
                        const size_t off = (size_t)row * 1024 + col0 + bj * HALF + n * 16;
                        const f32x4 hv = *(const f32x4*)(hin + off);
                        const f32x4 y = hv * alpha + acc[ai][bj][m][n];
                        *(f32x4*)(yout + off) = y;
                        typedef unsigned u32x2v __attribute__((ext_vector_type(2)));
                        u32x2v w; w.x = cvt_pk_bf16(y[0], y[1]); w.y = cvt_pk_bf16(y[2], y[3]);
                        *(u32x2v*)(yb + off) = w;
                        s += (y[0] + y[1]) + (y[2] + y[3]); s2 += (y[0] * y[0] + y[1] * y[1]) + (y[2] * y[2] + y[3] * y[3]);
                    }
                s += __shfl_xor(s, 16); s += __shfl_xor(s, 32); s2 += __shfl_xor(s2, 16); s2 += __shfl_xor(s2, 32);
                if (fq == 0) { atomicAdd(stats + 2 * (size_t)row, s); atomicAdd(stats + 2 * (size_t)row + 1, s2); }
            }
    }
};
struct EpiLnFold {
    static constexpr bool PERM = true, AFTER_DRAIN = false;
    bf16_t* O; const float* stats; const float* colsum; const float* colbias; float eps;
    __device__ __forceinline__ void operator()(const f32x4 (&acc)[2][2][4][2], const Unit& u, int wr, int wc, int fr, int fq) const {
        { int ln_ = LANEID(); asm volatile("" : "+v"(ln_)); fr = ln_ & 15; fq = ln_ >> 4; }
        const int row0 = u.pm * BM + wr * 64 + fr, col0 = u.pn * BM + wc * 32 + 8 * fq;
        f32x4 cs[2][2], cb[2][2];
#pragma unroll
        for (int bj = 0; bj < 2; ++bj)
#pragma unroll
            for (int n = 0; n < 2; ++n) { cs[bj][n] = *(const f32x4*)(colsum + col0 + bj * HALF + 4 * n); cb[bj][n] = *(const f32x4*)(colbias + col0 + bj * HALF + 4 * n); }
#pragma unroll
        for (int ai = 0; ai < 2; ++ai)
#pragma unroll
            for (int m = 0; m < 4; ++m) {
                const int row = row0 + ai * HALF + m * 16;
                const float sm_ = stats[2 * (size_t)row], sq_ = stats[2 * (size_t)row + 1];
                const float mean = sm_ * (1.0f / 1024.0f);
                const float rstd = 1.0f / sqrtf(fmaxf(sq_ * (1.0f / 1024.0f) - mean * mean, 0.f) + eps);
                bf16_t* rowp = O + (size_t)row * 1024 + col0;
#pragma unroll
                for (int bj = 0; bj < 2; ++bj) {
                    const f32x4 v0 = (acc[ai][bj][m][0] - cs[bj][0] * mean) * rstd + cb[bj][0], v1 = (acc[ai][bj][m][1] - cs[bj][1] * mean) * rstd + cb[bj][1];
                    u32x4 w; w.x = cvt_pk_bf16(v0[0], v0[1]); w.y = cvt_pk_bf16(v0[2], v0[3]); w.z = cvt_pk_bf16(v1[0], v1[1]); w.w = cvt_pk_bf16(v1[2], v1[3]);
                    *(u32x4*)(rowp + bj * HALF) = w;
                }
            }
    }
};
}

typedef unsigned short bf16;
constexpr int T_ = 16384, S_ = 4096, NBATCH = 4, D_ = 1024, NCOL = 6824, NP = 6912, DEPTH_ = 2;
constexpr int C_QA = 0, C_KA = 256, C_VA = 320, C_QI = 384, C_KI = 640, C_WI = 672, C_QB = 680, C_KB = 936, C_VB = 1064,
              C_QC = 1192, C_KC = 1448, C_VC = 1704, C_QD = 1960, C_KD = 2216, C_VD = 2472, C_G = 2728;
constexpr int NTHR = 512, NWAVE = 8;
constexpr float ALPHA = 1.41421356237309515f;
constexpr float LN_EPS = 1e-5f;
constexpr size_t MiB = 1u << 20;
constexpr size_t WS_STATS = 1 * MiB  , WS_COLS = 1 * MiB + 512 * 1024  ;
constexpr size_t WS_CTL = 0, WS_WIN_T = 2 * MiB, WS_WOUT_T = 30 * MiB, WS_WQ_T = 34 * MiB, WS_WBR_T = 38 * MiB, WS_HB = 42 * MiB,
                 WS_P = 74 * MiB, WS_MIX = 74 * MiB  , WS_Q = 138 * MiB  , WS_YS = 290 * MiB, WS_MRG = 322 * MiB,
                 WS_MASK = 354 * MiB, WS_EID = 362 * MiB, WS_GATE = 370 * MiB, WS_KMEAN = 378 * MiB, WS_SKB = 379 * MiB, WS_UV = 380 * MiB, WS_END = 508 * MiB;
constexpr size_t WIN_T_BYTES = (size_t)NP * 1024 * 2;
constexpr int LDS_BYTES = 144 * 1024;

struct Params { const float* in[13]; float* out; unsigned char* ws; };

__device__ __forceinline__ float bf2f(bf16 v) { return __uint_as_float((unsigned)v << 16); }
__device__ __forceinline__ unsigned f2bf(float f) { unsigned u = __float_as_uint(f); return (u + 0x7fffu + ((u >> 16) & 1u)) >> 16; }
__device__ __forceinline__ unsigned pk2(float lo, float hi) { return f2bf(lo) | (f2bf(hi) << 16); }
__device__ __forceinline__ void unpack8(const uint4 v, float* o) {
    o[0] = __uint_as_float(v.x << 16); o[1] = __uint_as_float(v.x & 0xffff0000u); o[2] = __uint_as_float(v.y << 16); o[3] = __uint_as_float(v.y & 0xffff0000u);
    o[4] = __uint_as_float(v.z << 16); o[5] = __uint_as_float(v.z & 0xffff0000u); o[6] = __uint_as_float(v.w << 16); o[7] = __uint_as_float(v.w & 0xffff0000u);
}
__device__ __forceinline__ float wave_sum(float v) {
#pragma unroll
    for (int o = 32; o > 0; o >>= 1) v += __shfl_xor(v, o);
    return v;
}
__device__ __forceinline__ float wave_max(float v) {
#pragma unroll
    for (int o = 32; o > 0; o >>= 1) v = fmaxf(v, __shfl_xor(v, o));
    return v;
}
__device__ __forceinline__ int wave_sum_i(int v) {
#pragma unroll
    for (int o = 32; o > 0; o >>= 1) v += __shfl_xor(v, o);
    return v;
}
__device__ __forceinline__ float logsig(float x) { return fminf(x, 0.f) - log1pf(expf(-fabsf(x))); }

__device__ void transpose_items(int WV_, const float* W, int K, int N, bf16* WT, float* sm, int item0, int nitems_total, int item_stride,
                                const float* rs_g = nullptr, const float* rs_b = nullptr, float* colsum = nullptr, float* colbias = nullptr) {
    const int tid = LTID(WV_);
    const int nkb = K / 64, nnb = (N + 63) / 64;
    for (int it = item0; it < nkb * nnb; it += item_stride) {
        const int kb = it % nkb, nb = it / nkb, k0 = kb * 64, n0 = nb * 64;
        __syncthreads();
        for (int e = tid; e < 64 * 64; e += NTHR) { const int kk = e >> 6, nn = e & 63; sm[kk * 65 + nn] = (n0 + nn < N) ? W[(size_t)(k0 + kk) * N + n0 + nn] : 0.f; }
        __syncthreads();
        if (rs_g) {
            if (tid < 64) { float cs = 0.f, cb = 0.f;
                for (int kk = 0; kk < 64; ++kk) { const float w = sm[kk * 65 + tid]; cs += w * rs_g[k0 + kk]; cb += w * rs_b[k0 + kk]; }
                atomicAdd(colsum + n0 + tid, cs); atomicAdd(colbias + n0 + tid, cb); }
            __syncthreads();
            for (int e = tid; e < 64 * 64; e += NTHR) { const int kk = e >> 6, nn = e & 63; sm[kk * 65 + nn] *= rs_g[k0 + kk]; }
            __syncthreads();
        }
        { const int nn = tid >> 3, c = tid & 7;
          if (n0 + nn < N) { uint4 o; o.x = pk2(sm[(8 * c + 0) * 65 + nn], sm[(8 * c + 1) * 65 + nn]); o.y = pk2(sm[(8 * c + 2) * 65 + nn], sm[(8 * c + 3) * 65 + nn]);
              o.z = pk2(sm[(8 * c + 4) * 65 + nn], sm[(8 * c + 5) * 65 + nn]); o.w = pk2(sm[(8 * c + 6) * 65 + nn], sm[(8 * c + 7) * 65 + nn]);
              *(uint4*)(WT + (size_t)(n0 + nn) * K + k0 + 8 * c) = o; } }
    }
    __syncthreads();
}
__device__ void prologue_phase(int WV_, const Params& p, float* sm) {
    const int tid = LTID(WV_), B = LBID(), G = LGRID();
    unsigned char* ws = p.ws;
    for (int l = 0; l < DEPTH_; ++l) {
        bf16* win_t = (bf16*)(ws + WS_WIN_T + l * WIN_T_BYTES);
        transpose_items(WV_, p.in[1] + (size_t)l * 1024 * NCOL, 1024, NCOL, win_t, sm, B, 0, G);
        for (int i = B * NTHR + tid; i < (NP - NCOL) * 1024 / 8; i += G * NTHR) ((uint4*)(win_t + (size_t)NCOL * 1024))[i] = make_uint4(0u, 0u, 0u, 0u);
        transpose_items(WV_, p.in[3] + (size_t)l * 1024 * 1024, 1024, 1024, (bf16*)(ws + WS_WOUT_T) + (size_t)l * 1024 * 1024, sm, B, 0, G);
        transpose_items(WV_, p.in[7] + (size_t)l * 1024 * 1024, 1024, 1024, (bf16*)(ws + WS_WQ_T) + (size_t)l * 1024 * 1024, sm, B, 0, G,
                        p.in[5] + l * 1024, p.in[6] + l * 1024, (float*)(ws + WS_COLS) + l * 2048, (float*)(ws + WS_COLS) + l * 2048 + 1024);
        for (int n = 0; n < 4; ++n)
            transpose_items(WV_, p.in[2] + ((size_t)l * 4 + n) * 256 * 1024, 256, 1024, (bf16*)(ws + WS_WBR_T) + ((size_t)l * 4 + n) * 1024 * 256, sm, B, 0, G);
    }
    const float4* x4 = (const float4*)p.in[0]; uint2* hb2 = (uint2*)(ws + WS_HB);
    for (size_t i = (size_t)B * NTHR + tid; i < (size_t)T_ * 1024 / 4; i += (size_t)G * NTHR) { const float4 v = x4[i]; hb2[i] = make_uint2(pk2(v.x, v.y), pk2(v.z, v.w)); }
}

__device__ __forceinline__ void ln_row(float4 (&v)[4], const float* g, const float* bb, float* orow, bf16* obrow, int lane) {
    float s = 0.f;
#pragma unroll
    for (int j = 0; j < 4; ++j) s += (v[j].x + v[j].y) + (v[j].z + v[j].w);
    const float mean = wave_sum(s) * (1.0f / 1024.0f);
    float s2 = 0.f;
#pragma unroll
    for (int j = 0; j < 4; ++j) { v[j].x -= mean; v[j].y -= mean; v[j].z -= mean; v[j].w -= mean; s2 += (v[j].x * v[j].x + v[j].y * v[j].y) + (v[j].z * v[j].z + v[j].w * v[j].w); }
    const float rstd = 1.0f / sqrtf(wave_sum(s2) * (1.0f / 1024.0f) + LN_EPS);
#pragma unroll
    for (int j = 0; j < 4; ++j) {
        const float4 gg = ((const float4*)g)[j * 64 + lane], b4 = ((const float4*)bb)[j * 64 + lane];
        float4 o; o.x = v[j].x * rstd * gg.x + b4.x; o.y = v[j].y * rstd * gg.y + b4.y; o.z = v[j].z * rstd * gg.z + b4.z; o.w = v[j].w * rstd * gg.w + b4.w;
        ((float4*)orow)[j * 64 + lane] = o;
        ((uint2*)obrow)[j * 64 + lane] = make_uint2(pk2(o.x, o.y), pk2(o.z, o.w));
    }
}
__device__ void ln1_phase(int WV_, const float* hin, const float* add, const float* g, const float* bb, float* hout, bf16* hb) {
    const int lane = LTID(WV_) & 63, wave = LTID(WV_) >> 6;
    for (int row = LBID() * NWAVE + wave; row < T_; row += LGRID() * NWAVE) {
        float4 v[4];
#pragma unroll
        for (int j = 0; j < 4; ++j) {
            const float4 a = ((const float4*)(hin + (size_t)row * 1024))[j * 64 + lane], m = ((const float4*)(add + (size_t)row * 1024))[j * 64 + lane];
            v[j].x = ALPHA * a.x + m.x; v[j].y = ALPHA * a.y + m.y; v[j].z = ALPHA * a.z + m.z; v[j].w = ALPHA * a.w + m.w;
        }
        ln_row(v, g, bb, hout + (size_t)row * 1024, hb + (size_t)row * 1024, lane);
    }
}


typedef short bf16x8_t __attribute__((ext_vector_type(8)));
typedef float f32x16_t __attribute__((ext_vector_type(16)));
typedef float f32x2_t __attribute__((ext_vector_type(2)));
typedef __bf16 bf16x2_t __attribute__((ext_vector_type(2)));
__device__ __forceinline__ unsigned cvtpk(float lo, float hi) { f32x2_t v = {lo, hi}; bf16x2_t b = __builtin_convertvector(v, bf16x2_t); return __builtin_bit_cast(unsigned, b); }
__device__ __forceinline__ int crow(int r, int hi) { return (r & 3) + 8 * (r >> 2) + 4 * hi; }
__device__ __forceinline__ float xlane32(float v) { return __shfl_xor(v, 32); }

constexpr int AT_KP = 72, AT_VP = 68;
constexpr int AT_KS = 0, AT_KS_BYTES = 64 * AT_KP * 2;
constexpr int AT_VT = 2 * AT_KS_BYTES, AT_VT_BYTES = 64 * AT_VP * 2;
constexpr int AT_KM = AT_VT + 2 * AT_VT_BYTES;
constexpr int AT_MISC = AT_KM + 32 * AT_KP * 2;
constexpr float LOG2E = 1.4426950408889634f;

__device__ __forceinline__ unsigned mk_unit(int kind, int b, int x, int y) { return ((unsigned)kind << 30) | ((unsigned)b << 28) | ((unsigned)x << 8) | (unsigned)y; }
__device__ void build_unit_table(unsigned* tab, int i) {
    int n = 0; unsigned res = 0u;
#pragma unroll 1
    for (int c = 64; c >= 1; --c) {
        if (i >= n && i < n + 4) res = mk_unit(0, i - n, 0, c - 1);
        n += 4;
        if ((c & 3) == 0) { if (i >= n && i < n + 16) { const int j = i - n; res = mk_unit(2, j >> 2, j & 3, c / 4 - 1); } n += 16; }
    }
    if (i < 512) tab[i] = res;
}

template <int kind> __device__ __forceinline__ void attn_unit(int WV_, const bf16* P, const unsigned char* mask, const float* kmean, const float* sinks, bf16* ys,
                                unsigned char* lds, int b, int ux, int uy) {
    int tid_ = LTID(WV_); asm volatile("" : "+v"(tid_));
    const int tid = tid_, lane = tid & 63, wave = __builtin_amdgcn_readfirstlane(tid >> 6), r32 = lane & 31, hi = lane >> 5;
    bf16* s_km = (bf16*)(lds + AT_KM);
    const int skey = tid >> 3, sc = tid & 7;
    {
        const bf16* Pb = P + (size_t)b * S_ * NP;
        int q0w, qcol, kcol, vcol, ycol, kt_hi, kt_lo; float slope2 = 0.f, sink2 = 0.f;
        if (kind == 0) { const int head = wave >> 1; q0w = uy * 64 + (wave & 1) * 32; qcol = C_QA + head * 64; kcol = C_KA; vcol = C_VA; ycol = head * 64;
            slope2 = exp2f(-8.0f * (float)(3 * head + 1) / 12.0f) * LOG2E; kt_hi = uy; kt_lo = 0; }
        else if (kind == 1) { const int hq = ux * 2 + (wave >> 2); q0w = uy * 128 + (wave & 3) * 32; qcol = C_QB + hq * 64; kcol = C_KB + ux * 64; vcol = C_VB + ux * 64; ycol = 256 + hq * 64;
            slope2 = exp2f(-8.0f * (float)(3 * hq + 2) / 12.0f) * LOG2E; sink2 = sinks[hq] * LOG2E; kt_hi = 2 * uy + 1; kt_lo = (2 * uy - 2 > 0) ? 2 * uy - 2 : 0; }
        else if (kind == 2) { q0w = uy * 256 + wave * 32; qcol = C_QC + ux * 64; kcol = C_KC + ux * 64; vcol = C_VC + ux * 64; ycol = 512 + ux * 64;
            slope2 = exp2f(-8.0f * (float)(3 * ux + 3) / 12.0f) * LOG2E; kt_hi = 4 * uy + 3; kt_lo = 0; }
        else { q0w = uy * 256 + wave * 32; qcol = C_QD + ux * 64; kcol = C_KD + ux * 64; vcol = C_VD + ux * 64; ycol = 768 + ux * 64; kt_hi = 4 * uy + 3; kt_lo = 0; }
        const int qpos = q0w + r32;
        bf16x8_t qf[4];
        { const bf16* qp = Pb + (size_t)qpos * NP + qcol + 8 * hi;
#pragma unroll
          for (int ks = 0; ks < 4; ++ks) qf[ks] = *(const bf16x8_t*)(qp + 16 * ks); }
        {
            const float qs = (kind == 3) ? 0.125f : 0.125f * LOG2E;
            typedef unsigned u32x4_t __attribute__((ext_vector_type(4)));
#pragma unroll
            for (int ks = 0; ks < 4; ++ks) { u32x4_t w = __builtin_bit_cast(u32x4_t, qf[ks]);
#pragma unroll
                for (int i = 0; i < 4; ++i) w[i] = cvtpk(__uint_as_float(w[i] << 16) * qs, __uint_as_float(w[i] & 0xffff0000u) * qs);
                qf[ks] = __builtin_bit_cast(bf16x8_t, w); }
        }
        float sb[16];
#pragma unroll
        for (int r = 0; r < 16; ++r) sb[r] = slope2 * (float)((r & 3) + 8 * (r >> 2));
        unsigned bm = 0u;
        if (kind == 2) {
            const int own = uy;
            for (int e = tid; e < 32 * 64; e += NTHR) { const int row = e >> 6, d = e & 63; s_km[row * AT_KP + d] = (row < 16) ? (bf16)f2bf(kmean[((b * 4 + ux) * 16 + row) * 64 + d]) : (bf16)0; }
            __syncthreads();
            f32x16_t gacc;
#pragma unroll
            for (int r = 0; r < 16; ++r) gacc[r] = 0.f;
#pragma unroll
            for (int ks = 0; ks < 4; ++ks) { const bf16x8_t a = *(const bf16x8_t*)(s_km + r32 * AT_KP + 16 * ks + 8 * hi); gacc = __builtin_amdgcn_mfma_f32_32x32x16_bf16(a, qf[ks], gacc, 0, 0, 0); }
            float gt[16];
#pragma unroll
            for (int r = 0; r < 8; ++r) { const float mine = gacc[r], other = xlane32(mine); const int bi = crow(r, 0);
                gt[bi] = hi ? other : mine; gt[bi + 4] = hi ? mine : other; }
#pragma unroll
            for (int n = 0; n < 16; ++n) if (n >= own) gt[n] = -INFINITY;
#pragma unroll
            for (int rep = 0; rep < 3; ++rep) {
                float mx = -INFINITY;
#pragma unroll
                for (int n = 0; n < 16; ++n) mx = fmaxf(mx, gt[n]);
                bool done = !(mx > -INFINITY);
#pragma unroll
                for (int n = 0; n < 16; ++n) { const bool hit = !done && gt[n] == mx; if (hit) { bm |= 1u << n; gt[n] = -INFINITY; done = true; } }
            }
        }
        f32x16_t o0, o1;
#pragma unroll
        for (int r = 0; r < 16; ++r) { o0[r] = 0.f; o1[r] = 0.f; }
        float m_run = -INFINITY, l_run = 0.f, carry = 0.f;
        const bf16* kg = Pb + (size_t)skey * NP + kcol + sc * 8;
        const bf16* vg = Pb + (size_t)skey * NP + vcol + sc * 8;
        uint4 rk = *(const uint4*)(kg + (size_t)kt_hi * 64 * NP), rv = *(const uint4*)(vg + (size_t)kt_hi * 64 * NP);
        int buf = 0;
        { bf16* ks_ = (bf16*)(lds + AT_KS); bf16* vt_ = (bf16*)(lds + AT_VT);
          *(uint4*)(ks_ + skey * AT_KP + sc * 8) = rk;
          const unsigned vw[4] = {rv.x, rv.y, rv.z, rv.w};
#pragma unroll
          for (int j = 0; j < 4; ++j) { vt_[(sc * 8 + 2 * j) * AT_VP + skey] = (bf16)(vw[j] & 0xffffu); vt_[(sc * 8 + 2 * j + 1) * AT_VP + skey] = (bf16)(vw[j] >> 16); } }
        __syncthreads();
        bool wave_done = false;
        uint2 mw_next = make_uint2(0u, 0u);
        if (kind == 0) mw_next = *(const uint2*)(mask + (size_t)(b * S_ + qpos) * 512 + kt_hi * 8);
        for (int kt = kt_hi; kt >= kt_lo; --kt) {
            const bool more = kt > kt_lo;
            const uint2 mw = mw_next;
            if (kind == 0 && more) mw_next = *(const uint2*)(mask + (size_t)(b * S_ + qpos) * 512 + (kt - 1) * 8);
            if (more) { rk = *(const uint4*)(kg + (size_t)(kt - 1) * 64 * NP); rv = *(const uint4*)(vg + (size_t)(kt - 1) * 64 * NP); }
            const bf16* ks_ = (const bf16*)(lds + AT_KS + buf * AT_KS_BYTES);
            const bf16* vt_ = (const bf16*)(lds + AT_VT + buf * AT_VT_BYTES);
            bool active = (kt * 64 <= q0w + 31) && !wave_done;
            if (kind == 1) active = active && (kt * 64 + 63 >= q0w - 127);
            if (active) {
                const int kbase = kt * 64 + 4 * hi;
                f32x16_t p0, p1;
                if (kind != 3) {
                    const float cb = slope2 * (float)(kbase - qpos), cb1 = cb + 32.0f * slope2;
#pragma unroll
                    for (int r = 0; r < 16; ++r) { p0[r] = cb + sb[r]; p1[r] = cb1 + sb[r]; }
                } else {
#pragma unroll
                    for (int r = 0; r < 16; ++r) { p0[r] = 0.f; p1[r] = 0.f; }
                }
#pragma unroll
                for (int ks = 0; ks < 4; ++ks) {
                    const bf16x8_t a0 = *(const bf16x8_t*)(ks_ + r32 * AT_KP + 16 * ks + 8 * hi);
                    const bf16x8_t a1 = *(const bf16x8_t*)(ks_ + (32 + r32) * AT_KP + 16 * ks + 8 * hi);
                    p0 = __builtin_amdgcn_mfma_f32_32x32x16_bf16(a0, qf[ks], p0, 0, 0, 0);
                    p1 = __builtin_amdgcn_mfma_f32_32x32x16_bf16(a1, qf[ks], p1, 0, 0, 0);
                }
                if (kind != 3) {
                    float mx = -INFINITY;
                    if (kind == 0) {
                        const unsigned w0 = mw.x >> (4 * hi), w1 = mw.y >> (4 * hi);
#pragma unroll
                        for (int r = 0; r < 16; ++r) { const int off = (r & 3) + 8 * (r >> 2);
                            p0[r] = (w0 & (1u << off)) ? p0[r] : -INFINITY; p1[r] = (w1 & (1u << off)) ? p1[r] : -INFINITY; mx = fmaxf(mx, fmaxf(p0[r], p1[r])); }
                    } else if (kind == 1) {
                        const int rel = qpos - kbase;
#pragma unroll
                        for (int r = 0; r < 16; ++r) { const int off = (r & 3) + 8 * (r >> 2);
                            p0[r] = ((unsigned)(rel - off) < 128u) ? p0[r] : -INFINITY; p1[r] = ((unsigned)(rel - off - 32) < 128u) ? p1[r] : -INFINITY; mx = fmaxf(mx, fmaxf(p0[r], p1[r])); }
                    } else {
                        if ((kt >> 2) == uy) {
                            const int rel = qpos - kbase;
#pragma unroll
                            for (int r = 0; r < 16; ++r) { const int off = (r & 3) + 8 * (r >> 2);
                                p0[r] = (off <= rel) ? p0[r] : -INFINITY; p1[r] = (off + 32 <= rel) ? p1[r] : -INFINITY; mx = fmaxf(mx, fmaxf(p0[r], p1[r])); }
                        } else {
                            const bool tile_ok = ((bm >> (kt >> 2)) & 1u) != 0u;
#pragma unroll
                            for (int r = 0; r < 16; ++r) { p0[r] = tile_ok ? p0[r] : -INFINITY; p1[r] = tile_ok ? p1[r] : -INFINITY; mx = fmaxf(mx, fmaxf(p0[r], p1[r])); }
                        }
                    }
                    mx = fmaxf(mx, xlane32(mx));
                    const float m_new = fmaxf(m_run, mx);
                    const float m_safe = (m_new == -INFINITY) ? 0.f : m_new;
                    p0 = p0 - m_safe; p1 = p1 - m_safe;
#pragma unroll
                    for (int r = 0; r < 16; ++r) { p0[r] = __builtin_amdgcn_exp2f(p0[r]); p1[r] = __builtin_amdgcn_exp2f(p1[r]); }
                    float ls;
                    { typedef float f32x8_t __attribute__((ext_vector_type(8))); typedef float f32x4v_t __attribute__((ext_vector_type(4)));
                      const f32x16_t t16 = p0 + p1; const f32x8_t t8 = t16.lo + t16.hi; const f32x4v_t t4 = t8.lo + t8.hi; const f32x2_t t2 = t4.lo + t4.hi; ls = t2.x + t2.y; }
                    if (__any(m_new > m_run)) {
                        const float alpha = __builtin_amdgcn_exp2f(m_run - m_safe);
                        l_run *= alpha;
                        o0 = o0 * alpha; o1 = o1 * alpha;
                    }
                    l_run += ls; m_run = m_new;
                } else {
                    float run = carry;
#define SB_HALF(PX, KOFF) do { \
                    float lk[16]; \
                    _Pragma("unroll") for (int r = 0; r < 16; ++r) { \
                        const int off = (r & 3) + 8 * (r >> 2); \
                        const bool v = (kbase + off + (KOFF)) < qpos; \
                        const float z = PX[r]; \
                        const float t = 0.6931471805599453f * __builtin_amdgcn_logf(1.0f + __builtin_amdgcn_exp2f(-LOG2E * fabsf(z))); \
                        lk[r] = v ? (fminf(-z, 0.f) - t) : 0.f; \
                        PX[r] = v ? (fminf(z, 0.f) - t) : -INFINITY; } \
                    _Pragma("unroll") for (int g = 3; g >= 0; --g) { \
                        const float G = (lk[4 * g] + lk[4 * g + 1]) + (lk[4 * g + 2] + lk[4 * g + 3]); \
                        const float PG = xlane32(G); \
                        float la = run + (hi ? 0.f : PG); \
                        run += G + PG; \
                        PX[4 * g + 3] += la; la += lk[4 * g + 3]; PX[4 * g + 2] += la; la += lk[4 * g + 2]; PX[4 * g + 1] += la; la += lk[4 * g + 1]; PX[4 * g] += la; } \
                    _Pragma("unroll") for (int r = 0; r < 16; ++r) PX[r] = __builtin_amdgcn_exp2f(LOG2E * PX[r]); } while (0)
                    SB_HALF(p1, 32);
                    SB_HALF(p0, 0);
#undef SB_HALF
                    carry = run;
                }
                unsigned pw[16];
#pragma unroll
                for (int j = 0; j < 8; ++j) { pw[j] = cvtpk(p0[2 * j], p0[2 * j + 1]); pw[8 + j] = cvtpk(p1[2 * j], p1[2 * j + 1]); }
#pragma unroll
                for (int s = 0; s < 4; ++s) {
                    bf16x8_t pb; { const unsigned* q = pw + 4 * s; typedef unsigned u32x4_t __attribute__((ext_vector_type(4))); u32x4_t t4 = {q[0], q[1], q[2], q[3]}; pb = __builtin_bit_cast(bf16x8_t, t4); }
#pragma unroll
                    for (int dt = 0; dt < 2; ++dt) {
                        const bf16* vp = vt_ + (32 * dt + r32) * AT_VP + 16 * s + 4 * hi;
                        typedef short s16x4_t __attribute__((ext_vector_type(4)));
                        const s16x4_t lo = *(const s16x4_t*)vp, hi4 = *(const s16x4_t*)(vp + 8);
                        const bf16x8_t va = {lo[0], lo[1], lo[2], lo[3], hi4[0], hi4[1], hi4[2], hi4[3]};
                        if (dt == 0) o0 = __builtin_amdgcn_mfma_f32_32x32x16_bf16(va, pb, o0, 0, 0, 0);
                        else         o1 = __builtin_amdgcn_mfma_f32_32x32x16_bf16(va, pb, o1, 0, 0, 0);
                    }
                }
            }
            if (kind == 3) {
                const float cm = carry;
                if (__all(cm < -110.0f) || !(kt * 64 <= q0w + 31) ) { if (__all(cm < -110.0f)) wave_done = true; }
            }
            if (more) {
                bf16* ksn = (bf16*)(lds + AT_KS + (buf ^ 1) * AT_KS_BYTES); bf16* vtn = (bf16*)(lds + AT_VT + (buf ^ 1) * AT_VT_BYTES);
                *(uint4*)(ksn + skey * AT_KP + sc * 8) = rk;
                const unsigned vw[4] = {rv.x, rv.y, rv.z, rv.w};
#pragma unroll
                for (int j = 0; j < 4; ++j) { vtn[(sc * 8 + 2 * j) * AT_VP + skey] = (bf16)(vw[j] & 0xffffu); vtn[(sc * 8 + 2 * j + 1) * AT_VP + skey] = (bf16)(vw[j] >> 16); }
            }
            if (kind == 3) { if (__syncthreads_and(wave_done ? 1 : 0)) break; }
            else __syncthreads();
            buf ^= 1;
        }
        float inv;
        if (kind == 3) inv = 1.0f;
        else {
            float lt = l_run + xlane32(l_run);
            if (kind == 1) { const float mf = fmaxf(m_run, sink2); const float sc2 = exp2f(m_run - mf); lt = lt * sc2 + exp2f(sink2 - mf); inv = sc2 / lt; }
            else inv = 1.0f / lt;
        }
        bf16* yp = ys + (size_t)(b * S_ + qpos) * 1024 + ycol + 4 * hi;
#pragma unroll
        for (int g = 0; g < 4; ++g) {
            *(uint2*)(yp + 8 * g) = make_uint2(cvtpk(o0[4 * g] * inv, o0[4 * g + 1] * inv), cvtpk(o0[4 * g + 2] * inv, o0[4 * g + 3] * inv));
            *(uint2*)(yp + 32 + 8 * g) = make_uint2(cvtpk(o1[4 * g] * inv, o1[4 * g + 1] * inv), cvtpk(o1[4 * g + 2] * inv, o1[4 * g + 3] * inv));
        }
    }
}
__device__ void attn_fast_phase(int WV_, const bf16* P, const unsigned char* mask, const float* kmean, const float* sinks, bf16* ys,
                                const unsigned* utab, unsigned* counter, unsigned char* lds) {
    volatile unsigned* s_unit = (volatile unsigned*)(lds + AT_MISC);
    for (;;) {
        __syncthreads();
        if (LTID(WV_) == 0) s_unit[0] = atomicAdd(counter, 1u);
        __syncthreads();
        const unsigned ui = s_unit[0];
        if (ui >= 512u) break;
        const unsigned ue = utab[ui];
        const int kind = (int)(ue >> 30), b = (int)((ue >> 28) & 3u), ux = (int)((ue >> 8) & 255u), uy = (int)(ue & 255u);
        if (kind == 0) attn_unit<0>(WV_, P, mask, kmean, sinks, ys, lds, b, ux, uy);
        else attn_unit<2>(WV_, P, mask, kmean, sinks, ys, lds, b, ux, uy);
    }
    for (int u = LBID(); u < 256; u += LGRID()) { __syncthreads(); attn_unit<3>(WV_, P, mask, kmean, sinks, ys, lds, u >> 6, (u >> 4) & 3, u & 15); }
    for (int u = LBID(); u < 256; u += LGRID()) { __syncthreads(); attn_unit<1>(WV_, P, mask, kmean, sinks, ys, lds, u >> 6, (u >> 5) & 1, u & 31); }
}

constexpr float U_SCALE = 64.0f, V_SCALE = 16.0f;
__device__ __forceinline__ float rdlane_f(float v, int l) { return __builtin_bit_cast(float, __builtin_amdgcn_readlane(__builtin_bit_cast(int, v), l)); }
__device__ __forceinline__ unsigned pk4_fp8(float a, float b, float c, float d) { int v = 0; v = __builtin_amdgcn_cvt_pk_fp8_f32(a, b, v, false); v = __builtin_amdgcn_cvt_pk_fp8_f32(c, d, v, true); return (unsigned)v; }
__device__ __forceinline__ void unpack16_fp8(const uint4 v, float* o) {
    const unsigned w[4] = {v.x, v.y, v.z, v.w};
#pragma unroll
    for (int i = 0; i < 4; ++i) { const f32x2_t lo = __builtin_amdgcn_cvt_pk_f32_fp8((int)w[i], false), hi2 = __builtin_amdgcn_cvt_pk_f32_fp8((int)w[i], true);
        o[4 * i] = lo.x; o[4 * i + 1] = lo.y; o[4 * i + 2] = hi2.x; o[4 * i + 3] = hi2.y; }
}
__device__ void convert_tables(int WV_, const Params& p) {
    const size_t nchunk = (size_t)DEPTH_ * 16384 * 2 * 64;
    for (size_t i = (size_t)LBID() * NTHR + LTID(WV_); i < nchunk; i += (size_t)LGRID() * NTHR) {
        const int c = (int)(i & 63), uvsel = (int)((i >> 6) & 1); const size_t le = i >> 7;
        const float* src = (uvsel ? p.in[10] : p.in[9]) + le * 1024 + c * 16;
        const float sc = uvsel ? V_SCALE : U_SCALE;
        const float4 a = ((const float4*)src)[0], b = ((const float4*)src)[1], cc = ((const float4*)src)[2], d = ((const float4*)src)[3];
        *(uint4*)(p.ws + WS_UV + le * 2048 + uvsel * 1024 + c * 16) = make_uint4(pk4_fp8(a.x * sc, a.y * sc, a.z * sc, a.w * sc), pk4_fp8(b.x * sc, b.y * sc, b.z * sc, b.w * sc),
                                                                               pk4_fp8(cc.x * sc, cc.y * sc, cc.z * sc, cc.w * sc), pk4_fp8(d.x * sc, d.y * sc, d.z * sc, d.w * sc));
    }
}
__device__ void peer_fast_phase(int WV_, float* h, bf16* hb, const int* eid, const float* gate, const unsigned char* uv, const float* g1, const float* b1, const float* g, const float* bb, unsigned char* lds) {
    const int tid = LTID(WV_), lane = tid & 63, wave = tid >> 6;
    for (int t = LBID() * NWAVE + wave; t < T_; t += LGRID() * NWAVE) {
        float* hr = h + (size_t)t * 1024 + lane * 16;
        float x[16], acc[16];
        { const float4 a0 = ((const float4*)hr)[0], a1 = ((const float4*)hr)[1], a2 = ((const float4*)hr)[2], a3 = ((const float4*)hr)[3];
          x[0] = a0.x; x[1] = a0.y; x[2] = a0.z; x[3] = a0.w; x[4] = a1.x; x[5] = a1.y; x[6] = a1.z; x[7] = a1.w;
          x[8] = a2.x; x[9] = a2.y; x[10] = a2.z; x[11] = a2.w; x[12] = a3.x; x[13] = a3.y; x[14] = a3.z; x[15] = a3.w; }
        {
            float s = 0.f;
#pragma unroll
            for (int i = 0; i < 16; ++i) s += x[i];
            const float mean = wave_sum(s) * (1.0f / 1024.0f);
            float s2 = 0.f;
#pragma unroll
            for (int i = 0; i < 16; ++i) { x[i] -= mean; s2 += x[i] * x[i]; }
            const float rstd = 1.0f / sqrtf(wave_sum(s2) * (1.0f / 1024.0f) + LN_EPS);
#pragma unroll
            for (int q4 = 0; q4 < 4; ++q4) { const float4 gg = ((const float4*)(g1 + lane * 16))[q4], cc = ((const float4*)(b1 + lane * 16))[q4];
                x[4 * q4] = x[4 * q4] * rstd * gg.x + cc.x; x[4 * q4 + 1] = x[4 * q4 + 1] * rstd * gg.y + cc.y; x[4 * q4 + 2] = x[4 * q4 + 2] * rstd * gg.z + cc.z; x[4 * q4 + 3] = x[4 * q4 + 3] * rstd * gg.w + cc.w; }
        }
#pragma unroll
        for (int i = 0; i < 16; ++i) acc[i] = 0.f;
#pragma unroll 1
        for (int batch = 0; batch < 4; ++batch) {
            const int my_eid = eid[(size_t)t * 128 + batch * 32 + (lane & 31)];
            const float my_gate = gate[(size_t)t * 128 + batch * 32 + (lane & 31)];
            float* pl = (float*)lds + wave * 2048;
#pragma unroll 1
            for (int grp = 0; grp < 4; ++grp) {
                uint4 ua[8];
#pragma unroll
                for (int i = 0; i < 8; ++i) { const int id = __shfl(my_eid, grp * 8 + i); ua[i] = *(const uint4*)(uv + (size_t)id * 2048 + lane * 16); }
#pragma unroll
                for (int i = 0; i < 8; ++i) {
                    float f[16]; unpack16_fp8(ua[i], f);
                    float d0 = 0.f, d1 = 0.f;
#pragma unroll
                    for (int j = 0; j < 8; ++j) { d0 += f[j] * x[j]; d1 += f[8 + j] * x[8 + j]; }
                    pl[(grp * 8 + i) * 64 + lane] = d0 + d1;
                }
            }
            float d;
            { const float4* pr = (const float4*)(pl + (lane & 31) * 64); float4 s4 = pr[0];
#pragma unroll
              for (int i = 1; i < 16; ++i) { const float4 v = pr[i]; s4.x += v.x; s4.y += v.y; s4.z += v.z; s4.w += v.w; }
              d = ((s4.x + s4.y) + (s4.z + s4.w)) * (1.0f / U_SCALE); }
            const float hv = 0.5f * d * (1.0f + erff(d * 0.70710678118654752f)) * my_gate * (1.0f / V_SCALE);
#pragma unroll 1
            for (int grp = 0; grp < 4; ++grp) {
                uint4 va[8];
#pragma unroll
                for (int i = 0; i < 8; ++i) { const int id = __shfl(my_eid, grp * 8 + i); va[i] = *(const uint4*)(uv + (size_t)id * 2048 + 1024 + lane * 16); }
#pragma unroll
                for (int i = 0; i < 8; ++i) {
                    const float c = __shfl(hv, grp * 8 + i);
                    float f[16]; unpack16_fp8(va[i], f);
#pragma unroll
                    for (int j = 0; j < 16; ++j) acc[j] += c * f[j];
                }
            }
        }
        float y[16], s = 0.f;
#pragma unroll
        for (int i = 0; i < 16; ++i) { y[i] = ALPHA * x[i] + acc[i]; s += y[i]; }
        const float mean = wave_sum(s) * (1.0f / 1024.0f);
        float s2 = 0.f;
#pragma unroll
        for (int i = 0; i < 16; ++i) { y[i] -= mean; s2 += y[i] * y[i]; }
        const float rstd = 1.0f / sqrtf(wave_sum(s2) * (1.0f / 1024.0f) + LN_EPS);
        float o[16];
#pragma unroll
        for (int q4 = 0; q4 < 4; ++q4) {
            const float4 gg = ((const float4*)(g + lane * 16))[q4], cc = ((const float4*)(bb + lane * 16))[q4];
            o[4 * q4] = y[4 * q4] * rstd * gg.x + cc.x; o[4 * q4 + 1] = y[4 * q4 + 1] * rstd * gg.y + cc.y; o[4 * q4 + 2] = y[4 * q4 + 2] * rstd * gg.z + cc.z; o[4 * q4 + 3] = y[4 * q4 + 3] * rstd * gg.w + cc.w;
            ((float4*)hr)[q4] = make_float4(o[4 * q4], o[4 * q4 + 1], o[4 * q4 + 2], o[4 * q4 + 3]);
        }
        uint4* hbp = (uint4*)(hb + (size_t)t * 1024 + lane * 16);
        hbp[0] = make_uint4(pk2(o[0], o[1]), pk2(o[2], o[3]), pk2(o[4], o[5]), pk2(o[6], o[7]));
        hbp[1] = make_uint4(pk2(o[8], o[9]), pk2(o[10], o[11]), pk2(o[12], o[13]), pk2(o[14], o[15]));
    }
}

__device__ __forceinline__ float pack_pl(float v, unsigned pl) { return __uint_as_float((__float_as_uint(v) & ~127u) | pl); }
__device__ __forceinline__ void ins16(float (&s)[16], float x) {
#pragma unroll
    for (int k = 15; k >= 1; --k) s[k] = __builtin_amdgcn_fmed3f(s[k - 1], x, s[k]);
    s[0] = fmaxf(s[0], x);
}
template <int D> __device__ __forceinline__ void bitonic_stage(float (&c)[16]) {
#pragma unroll
    for (int i = 0; i < 16; ++i) if ((i & D) == 0) { const float a = fmaxf(c[i], c[i + D]), b = fminf(c[i], c[i + D]); c[i] = a; c[i + D] = b; }
}
__device__ __forceinline__ int decode_key(unsigned pl) { return (int)(32u * ((pl >> 4) & 3u) + (pl & 3u) + 8u * ((pl >> 2) & 3u) + 4u * ((pl >> 6) & 1u)); }
__device__ void route_fast_phase(int WV_, const bf16* qb, const bf16* skb  , int* eid, float* gate, unsigned char* lds) {
    const int tid = LTID(WV_), lane = tid & 63, wave = tid >> 6, r32 = lane & 31, hi = lane >> 5;
    unsigned* lidx = (unsigned*)lds + wave * (64 * 33) + lane * 33;
    for (int unit = LBID() * NWAVE + wave; unit < (T_ / 32) * 8; unit += LGRID() * NWAVE) {
        const int h = unit & 7, t = (unit >> 3) * 32 + r32;
        float sl[2][16];
#pragma unroll
        for (int p = 0; p < 2; ++p) {
            bf16x8_t qf[4];
            { const bf16* qp = qb + (size_t)t * 1024 + h * 128 + p * 64 + 8 * hi;
#pragma unroll
              for (int ks = 0; ks < 4; ++ks) qf[ks] = *(const bf16x8_t*)(qp + 16 * ks); }
            float s[16];
#pragma unroll
            for (int k = 0; k < 16; ++k) s[k] = -INFINITY;
            const bf16* skp = skb + ((size_t)(h * 2 + p) * 128 + r32) * 64 + 8 * hi;
#pragma unroll
            for (int kt = 0; kt < 4; ++kt) {
                f32x16_t acc;
#pragma unroll
                for (int r = 0; r < 16; ++r) acc[r] = 0.f;
#pragma unroll
                for (int ks = 0; ks < 4; ++ks) { const bf16x8_t a = *(const bf16x8_t*)(skp + (size_t)kt * 32 * 64 + 16 * ks); acc = __builtin_amdgcn_mfma_f32_32x32x16_bf16(a, qf[ks], acc, 0, 0, 0); }
#pragma unroll
                for (int r = 0; r < 16; ++r) ins16(s, pack_pl(acc[r], (unsigned)(kt * 16 + r)));
            }
            const unsigned hb = (unsigned)hi << 6;
#pragma unroll
            for (int k = 0; k < 16; ++k) s[k] = __uint_as_float(__float_as_uint(s[k]) | hb);
            float c[16];
#pragma unroll
            for (int k = 0; k < 16; ++k) c[k] = fmaxf(s[k], __shfl_xor(s[15 - k], 32));
            bitonic_stage<8>(c); bitonic_stage<4>(c); bitonic_stage<2>(c); bitonic_stage<1>(c);
#pragma unroll
            for (int k = 0; k < 16; ++k) { sl[p][k] = c[k]; lidx[p * 16 + k] = (unsigned)decode_key(__float_as_uint(c[k]) & 127u); }
        }
        float w[16];
#pragma unroll
        for (int k = 0; k < 16; ++k) w[k] = -INFINITY;
#pragma unroll
        for (int i = 0; i < 16; ++i)
#pragma unroll
            for (int j = 0; j < 16; ++j)
                if ((i + 1) * (j + 1) <= 16) { const float v = sl[0][i] + sl[1][j]; ins16(w, __uint_as_float((__float_as_uint(v) & ~255u) | (unsigned)(i * 16 + j))); }
        float e[16], sum = 0.f;
#pragma unroll
        for (int k = 0; k < 16; ++k) { e[k] = expf(w[k] - w[0]); sum += e[k]; }
        const float inv = 1.0f / sum;
        int ide[8]; float gte[8];
#pragma unroll
        for (int k = 0; k < 8; ++k) {
            float wa = w[k], wb = w[8 + k], ea = e[k], eb = e[8 + k];
            asm volatile("" : "+v"(wa), "+v"(wb), "+v"(ea), "+v"(eb));
            const float wv = hi ? wb : wa;
            const unsigned pl = __float_as_uint(wv) & 255u;
            ide[k] = (int)(lidx[pl >> 4] * 128u + lidx[16 + (pl & 15u)]);
            gte[k] = (hi ? eb : ea) * inv;
        }
        int* ep = eid + (size_t)t * 128 + h * 16 + hi * 8; float* gp = gate + (size_t)t * 128 + h * 16 + hi * 8;
        *(int4*)ep = make_int4(ide[0], ide[1], ide[2], ide[3]); *(int4*)(ep + 4) = make_int4(ide[4], ide[5], ide[6], ide[7]);
        *(float4*)gp = make_float4(gte[0], gte[1], gte[2], gte[3]); *(float4*)(gp + 4) = make_float4(gte[4], gte[5], gte[6], gte[7]);
    }
}

typedef float f32x4_t __attribute__((ext_vector_type(4)));
typedef __bf16 bf16x2v __attribute__((ext_vector_type(2)));
__device__ __forceinline__ float dot2bf(unsigned a, unsigned b, float c) { return __builtin_amdgcn_fdot2_f32_bf16(__builtin_bit_cast(bf16x2v, a), __builtin_bit_cast(bf16x2v, b), c, false); }
__device__ __forceinline__ void cnt_gt(int& cnt, unsigned a, unsigned b) { asm("v_cmp_gt_u32_e32 vcc, %1, %2\n\tv_addc_co_u32_e32 %0, vcc, 0, %0, vcc" : "+v"(cnt) : "v"(a), "v"(b) : "vcc"); }
__device__ __forceinline__ void cnt_eq(int& cnt, unsigned a, unsigned b) { asm("v_cmp_eq_u32_e32 vcc, %1, %2\n\tv_addc_co_u32_e32 %0, vcc, 0, %0, vcc" : "+v"(cnt) : "v"(a), "v"(b) : "vcc"); }
__device__ __forceinline__ unsigned flag_gt(unsigned a, unsigned b) { unsigned r; asm("v_cmp_gt_u32_e32 vcc, %1, %2\n\tv_cndmask_b32_e64 %0, 0, 1, vcc" : "=v"(r) : "v"(a), "v"(b) : "vcc"); return r; }
__device__ __forceinline__ unsigned flag_eq(unsigned a, unsigned b) { unsigned r; asm("v_cmp_eq_u32_e32 vcc, %1, %2\n\tv_cndmask_b32_e64 %0, 0, 1, vcc" : "=v"(r) : "v"(a), "v"(b) : "vcc"); return r; }
__device__ __forceinline__ void cnt_ge(int& cnt, unsigned key, unsigned cand) { asm("v_cmp_ge_u32_e32 vcc, %1, %2\n\tv_addc_co_u32_e32 %0, vcc, 0, %0, vcc" : "+v"(cnt) : "v"(key), "v"(cand) : "vcc"); }

typedef __attribute__((address_space(3))) unsigned lds_u32;
template <int SHIFT> __device__ __forceinline__ unsigned radix_pass(const unsigned (&key)[64], unsigned pre, lds_u32* hist, int lane, int& need) {
    typedef unsigned u32x4v __attribute__((ext_vector_type(4)));
    typedef __attribute__((address_space(3))) u32x4v lds_u32x4;
    { const u32x4v z4 = {0u, 0u, 0u, 0u};
#pragma unroll
      for (int i = 0; i < 8; ++i) ((lds_u32x4*)(hist + lane * 32))[i] = z4; }
    const unsigned cp = (unsigned)(lane & 7);
#pragma unroll
    for (int j = 0; j < 64; ++j) {
        const unsigned d = (key[j] >> SHIFT) & 255u;
        bool m;
        if (SHIFT == 24) m = key[j] != 0u; else m = (key[j] >> ((SHIFT + 8) & 31)) == pre;
        if (m) __hip_atomic_fetch_add(hist + ((d << 3) | cp), 1u, __ATOMIC_RELAXED, __HIP_MEMORY_SCOPE_WORKGROUP);
    }
    unsigned dsum[4]; unsigned sumL = 0u;
#pragma unroll
    for (int i = 0; i < 4; ++i) { const u32x4v v0 = ((const lds_u32x4*)(hist + lane * 32))[2 * i], v1 = ((const lds_u32x4*)(hist + lane * 32))[2 * i + 1];
        dsum[i] = ((v0.x + v0.y) + (v0.z + v0.w)) + ((v1.x + v1.y) + (v1.z + v1.w)); sumL += dsum[i]; }
    unsigned incl = sumL;
#pragma unroll
    for (int o = 1; o < 64; o <<= 1) { const unsigned t = (unsigned)__shfl_down((int)incl, o); if (lane + o < 64) incl += t; }
    const unsigned above = incl - sumL;
    const bool own = (above < (unsigned)need) && ((unsigned)need <= above + sumL);
    const int owner = __ffsll((long long)__ballot(own)) - 1;
    unsigned acc = above; int sel = -1; unsigned cab = 0u;
#pragma unroll
    for (int i = 3; i >= 0; --i) { const unsigned c = dsum[i]; const bool hit = (sel < 0) && (acc + c >= (unsigned)need); cab = hit ? acc : cab; sel = hit ? i : sel; acc += c; }
    const int ow = owner < 0 ? 0 : owner;
    const unsigned digit = (unsigned)__builtin_amdgcn_readlane(sel, ow) + (unsigned)(4 * ow);
    need -= (int)__builtin_amdgcn_readlane((int)cab, ow);
    return digit;
}
#ifndef TS_SEL
#define TS_SEL 0
#endif
#define ITS_B() do { if (TS_SEL >= 20 && TS_SEL <= 25 && WV_ == 0 && LANEID() == 0) ((volatile __attribute__((address_space(3))) unsigned long long*)((__attribute__((address_space(3))) unsigned char*)lds + 147456 - 16 - 32))[0] = __builtin_amdgcn_s_memrealtime(); } while (0)
#define ITS_E(k) do { if ((k) == TS_SEL && WV_ == 0 && LANEID() == 0) { volatile __attribute__((address_space(3))) unsigned long long* w_ = (volatile __attribute__((address_space(3))) unsigned long long*)((__attribute__((address_space(3))) unsigned char*)lds + 147456 - 16 - 32); w_[1] += __builtin_amdgcn_s_memrealtime() - w_[0]; } } while (0)
__device__ void index_fast_phase(int WV_, const bf16* P, unsigned char* mask, float* kmean, float* scratch_all, unsigned char* lds) {
    const int tid = LTID(WV_), lane = tid & 63, wave = tid >> 6, bid = LBID(), G = LGRID();
    float* s_part = (float*)lds;
    ITS_B();
    for (int k = bid; k < 256; k += G) {
        const int b = k >> 6, h = (k >> 4) & 3, blk = k & 15;
        const bf16* kp = P + (size_t)(b * S_ + blk * 256 + wave * 32) * NP + C_KC + h * 64 + lane;
        float a = 0.f;
#pragma unroll 8
        for (int j = 0; j < 32; ++j) a += bf2f(kp[(size_t)j * NP]);
        __syncthreads();
        s_part[wave * 64 + lane] = a;
        __syncthreads();
        if (tid < 64) { float s = 0.f;
#pragma unroll
            for (int w = 0; w < 8; ++w) s += s_part[w * 64 + tid];
            kmean[((b * 4 + h) * 16 + blk) * 64 + tid] = s * (1.0f / 256.0f); }
    }
    ITS_E(22);
    float* scr = scratch_all + (size_t)bid * (16 * 4096);
    const int lq = lane & 15, g4 = lane >> 4;
    for (int ui = bid; ui < 1024; ui += G) {
        const int b = ui >> 8, k = ui & 255, tile = (b & 1) ? 255 - k : k, q0 = tile * 16;
        const bf16* Pb = P + (size_t)b * S_ * NP;
        const int ntiles = tile + 1;
        ITS_B();
        bf16x8_t qf[8]; float wi[8];
        { const bf16* qp = Pb + (size_t)(q0 + lq) * NP + C_QI + 8 * g4;
#pragma unroll
          for (int h = 0; h < 8; ++h) qf[h] = *(const bf16x8_t*)(qp + 32 * h);
          const uint4 wv = *(const uint4*)(Pb + (size_t)(q0 + lq) * NP + C_WI); unpack8(wv, wi); }
        for (int kt = wave; kt < ntiles; kt += NWAVE) {
            const bf16x8_t af = *(const bf16x8_t*)(Pb + (size_t)(kt * 16 + lq) * NP + C_KI + 8 * g4);
            f32x4_t sc = {0.f, 0.f, 0.f, 0.f};
#pragma unroll
            for (int h = 0; h < 8; ++h) {
                const f32x4_t z = {0.f, 0.f, 0.f, 0.f};
                const f32x4_t a = __builtin_amdgcn_mfma_f32_16x16x32_bf16(af, qf[h], z, 0, 0, 0);
#pragma unroll
                for (int r = 0; r < 4; ++r) sc[r] += fmaxf(a[r], 0.f) * wi[h];
            }
#pragma unroll
            for (int r = 0; r < 4; ++r) { sc[r] *= 0.0625f; if (sc[r] == 0.f) sc[r] = 0.f; }
            *(f32x4_t*)(scr + (size_t)lq * 4096 + kt * 16 + 4 * g4) = sc;
        }
        __threadfence_block();
        __syncthreads();
        __threadfence_block();
        ITS_E(20); ITS_B();
        lds_u32* hist = (lds_u32*)((__attribute__((address_space(3))) unsigned char*)lds + 2048) + wave * 2048;
#pragma unroll 1
        for (int qi = 0; qi < 2; ++qi) {
            const int ql = 2 * wave + qi, q = q0 + ql;
            const float* row = scr + (size_t)ql * 4096 + lane * 64;
            const int qrel = q - lane * 64;
            unsigned key[64];
            if (qrel >= 0) {
#pragma unroll
                for (int j4 = 0; j4 < 16; ++j4) {
                    const float4 v = ((const float4*)row)[j4];
                    const unsigned u[4] = {__float_as_uint(v.x), __float_as_uint(v.y), __float_as_uint(v.z), __float_as_uint(v.w)};
#pragma unroll
                    for (int e = 0; e < 4; ++e) { const unsigned t = u[e] ^ ((unsigned)((int)u[e] >> 31) | 0x80000000u); const unsigned inval = (unsigned)((qrel - (j4 * 4 + e)) >> 31); key[j4 * 4 + e] = t & ~inval; }
                    if ((j4 & 3) == 3) asm volatile("" ::: "memory");
                }
            } else {
#pragma unroll
                for (int j = 0; j < 64; ++j) key[j] = 0u;
            }
            ITS_E(23); ITS_B();
            unsigned wlo = 0u, whi = 0u;
            if (q + 1 > 256) {
                int need = 256;
                const unsigned d1 = radix_pass<24>(key, 0u, hist, lane, need);
                const unsigned d2 = radix_pass<16>(key, d1, hist, lane, need);
                const unsigned d3 = radix_pass<8>(key, (d1 << 8) | d2, hist, lane, need);
                const unsigned d4 = radix_pass<0>(key, (d1 << 16) | (d2 << 8) | d3, hist, lane, need);
                const unsigned prefix = (d1 << 24) | (d2 << 16) | (d3 << 8) | d4;
                ITS_E(24); ITS_B();
                int ceq = 0;
#pragma unroll
                for (int j = 0; j < 64; ++j) cnt_eq(ceq, key[j], prefix);
                ceq = wave_sum_i(ceq);
                int X = 4096;
                if (ceq != need) {
                    int X0 = 0;
#pragma unroll 1
                    for (int bit = 11; bit >= 0; --bit) {
                        const int c = X0 | (1 << bit);
                        int cnt = 0; const int crel = c - lane * 64;
#pragma unroll
                        for (int j = 0; j < 64; ++j) cnt_eq(cnt, (key[j] ^ prefix) | ~(unsigned)((j - crel) >> 31), 0u);
                        cnt = wave_sum_i(cnt);
                        if (cnt < need) X0 = c;
                    }
                    X = X0 + 1;
                }
                const int xrel = X - lane * 64;
#pragma unroll
                for (int j = 0; j < 32; ++j) {
                    const unsigned s0 = flag_gt(key[j], prefix) | flag_eq((key[j] ^ prefix) | ~(unsigned)((j - xrel) >> 31), 0u);
                    const unsigned s1 = flag_gt(key[32 + j], prefix) | flag_eq((key[32 + j] ^ prefix) | ~(unsigned)((32 + j - xrel) >> 31), 0u);
                    wlo |= s0 << j; whi |= s1 << j;
                }
            } else {
#pragma unroll
                for (int j = 0; j < 32; ++j) { wlo |= (~(unsigned)((qrel - j) >> 31) & 1u) << j; whi |= (~(unsigned)((qrel - 32 - j) >> 31) & 1u) << j; }
            }
            ((uint2*)(mask + (size_t)(b * S_ + q) * 512))[lane] = make_uint2(wlo, whi);
            ITS_E(25); ITS_B();
        }
        ITS_E(21);
        __syncthreads();
    }
}

constexpr int MG_P = 72;
constexpr int MG_TILE_BYTES = 128 * MG_P * 2;
__device__ void merge_fast_phase(int WV_, const bf16* P, const bf16* ys, const bf16* wbt  , bf16* merged, unsigned char* lds) {
    const int tid = LTID(WV_), lane = tid & 63, wave = tid >> 6, r32 = lane & 31, hi = lane >> 5, wt = wave & 3, wd = wave >> 2;
    const int srow0 = tid >> 3, sch = tid & 7;
    for (int tile = LBID(); tile < 1024; tile += LGRID()) {
        const int tok0 = (tile >> 3) * 128, d0 = (tile & 7) * 128;
        f32x16_t mer[2], acc[2];
#pragma unroll
        for (int r = 0; r < 16; ++r) { mer[0][r] = 0.f; mer[1][r] = 0.f; acc[0][r] = 0.f; acc[1][r] = 0.f; }
        uint4 RW00, RW01, RW10, RW11, RY00, RY01, RY10, RY11, RG0, RG1, RG2, RG3;
        bf16* gl = (bf16*)(lds + 4 * MG_TILE_BYTES);
        const int grow = tid >> 4, gch = tid & 15;
#define MG_GLOAD(st_, R_) do { const int n_ = (st_) >> 2, kc_ = (st_) & 3; \
            RW##R_##0 = *(const uint4*)(wbt + ((size_t)n_ * 1024 + d0 + srow0) * 256 + kc_ * 64 + sch * 8); \
            RW##R_##1 = *(const uint4*)(wbt + ((size_t)n_ * 1024 + d0 + srow0 + 64) * 256 + kc_ * 64 + sch * 8); \
            RY##R_##0 = *(const uint4*)(ys + (size_t)(tok0 + srow0) * 1024 + n_ * 256 + kc_ * 64 + sch * 8); \
            RY##R_##1 = *(const uint4*)(ys + (size_t)(tok0 + srow0 + 64) * 1024 + n_ * 256 + kc_ * 64 + sch * 8); } while (0)
#define MG_SSTORE(buf_, R_) do { bf16* wl_ = (bf16*)(lds + (buf_) * 2 * MG_TILE_BYTES); bf16* yl_ = (bf16*)(lds + (buf_) * 2 * MG_TILE_BYTES + MG_TILE_BYTES); \
            *(uint4*)(wl_ + srow0 * MG_P + sch * 8) = RW##R_##0; *(uint4*)(wl_ + (srow0 + 64) * MG_P + sch * 8) = RW##R_##1; \
            *(uint4*)(yl_ + srow0 * MG_P + sch * 8) = RY##R_##0; *(uint4*)(yl_ + (srow0 + 64) * MG_P + sch * 8) = RY##R_##1; } while (0)
        __syncthreads();
        MG_GLOAD(0, 0); MG_GLOAD(1, 1);
        MG_SSTORE(0, 0);
        __syncthreads();
#define MG_STAGE(PAR_, OTH_) do { const int buf = PAR_; \
            if (st + 2 < 16) MG_GLOAD(st + 2, PAR_); \
            if ((st & 3) == 1) { const bf16* gsrc = P + (size_t)(tok0 + grow) * NP + C_G + (st >> 2) * 1024 + d0 + gch * 8; \
                RG0 = *(const uint4*)gsrc; RG1 = *(const uint4*)(gsrc + (size_t)32 * NP); RG2 = *(const uint4*)(gsrc + (size_t)64 * NP); RG3 = *(const uint4*)(gsrc + (size_t)96 * NP); } \
            const bf16* wl = (const bf16*)(lds + buf * 2 * MG_TILE_BYTES); const bf16* yl = (const bf16*)(lds + buf * 2 * MG_TILE_BYTES + MG_TILE_BYTES); \
            _Pragma("unroll") for (int ks = 0; ks < 4; ++ks) { \
                const bf16x8_t bq = *(const bf16x8_t*)(yl + (32 * wt + r32) * MG_P + 16 * ks + 8 * hi); \
                const bf16x8_t a0 = *(const bf16x8_t*)(wl + (64 * wd + r32) * MG_P + 16 * ks + 8 * hi); \
                const bf16x8_t a1 = *(const bf16x8_t*)(wl + (64 * wd + 32 + r32) * MG_P + 16 * ks + 8 * hi); \
                acc[0] = __builtin_amdgcn_mfma_f32_32x32x16_bf16(a0, bq, acc[0], 0, 0, 0); \
                acc[1] = __builtin_amdgcn_mfma_f32_32x32x16_bf16(a1, bq, acc[1], 0, 0, 0); } \
            if ((st & 3) == 3) { \
                const int n = st >> 2; \
                const bf16* gp = gl + (32 * wt + r32) * 136 + 64 * wd + 4 * hi; (void)n; \
                _Pragma("unroll") for (int dt = 0; dt < 2; ++dt) \
                _Pragma("unroll") for (int g = 0; g < 4; ++g) { \
                        const uint2 gv = *(const uint2*)(gp + 32 * dt + 8 * g); \
                        const float g0 = __uint_as_float(gv.x << 16), g1 = __uint_as_float(gv.x & 0xffff0000u), g2 = __uint_as_float(gv.y << 16), g3 = __uint_as_float(gv.y & 0xffff0000u); \
                        mer[dt][4 * g + 0] += acc[dt][4 * g + 0] * __builtin_amdgcn_rcpf(1.f + __builtin_amdgcn_exp2f(-LOG2E * g0)); \
                        mer[dt][4 * g + 1] += acc[dt][4 * g + 1] * __builtin_amdgcn_rcpf(1.f + __builtin_amdgcn_exp2f(-LOG2E * g1)); \
                        mer[dt][4 * g + 2] += acc[dt][4 * g + 2] * __builtin_amdgcn_rcpf(1.f + __builtin_amdgcn_exp2f(-LOG2E * g2)); \
                        mer[dt][4 * g + 3] += acc[dt][4 * g + 3] * __builtin_amdgcn_rcpf(1.f + __builtin_amdgcn_exp2f(-LOG2E * g3)); } \
                _Pragma("unroll") for (int r = 0; r < 16; ++r) { acc[0][r] = 0.f; acc[1][r] = 0.f; } } \
            if (st + 1 < 16) MG_SSTORE(OTH_, OTH_); \
            if ((st & 3) == 2) { *(uint4*)(gl + grow * 136 + gch * 8) = RG0; *(uint4*)(gl + (grow + 32) * 136 + gch * 8) = RG1; *(uint4*)(gl + (grow + 64) * 136 + gch * 8) = RG2; *(uint4*)(gl + (grow + 96) * 136 + gch * 8) = RG3; } \
            __syncthreads(); } while (0)
#pragma unroll 1
        for (int st2 = 0; st2 < 16; st2 += 2) { { const int st = st2; MG_STAGE(0, 1); } { const int st = st2 + 1; MG_STAGE(1, 0); } }
#undef MG_STAGE
#undef MG_GLOAD
#undef MG_SSTORE
        bf16* mp = merged + (size_t)(tok0 + 32 * wt + r32) * 1024 + d0 + 64 * wd + 4 * hi;
#pragma unroll
        for (int dt = 0; dt < 2; ++dt)
#pragma unroll
            for (int g = 0; g < 4; ++g)
                *(uint2*)(mp + 32 * dt + 8 * g) = make_uint2(cvtpk(mer[dt][4 * g], mer[dt][4 * g + 1]), cvtpk(mer[dt][4 * g + 2], mer[dt][4 * g + 3]));
    }
}
#define LAS __attribute__((address_space(3)))
#define XB_TMO      128
#define XB_XCNT(j)  (256  + 64 * (j))
#define XB_XSUB(j)  (1280 + 64 * (j))
#define XB_XGEN(j)  (2304 + 64 * (j))
#define XB_TOP      3328
#define XB_TOPGEN   3392
#define XCD_BAR_WORDS 3456
#define XB_SPIN_CAP (1u << 18)

__device__ __forceinline__ unsigned xb_ld(unsigned* p)              { return __hip_atomic_load(p, __ATOMIC_RELAXED, __HIP_MEMORY_SCOPE_AGENT); }
__device__ __forceinline__ unsigned xb_add(unsigned* p, unsigned v) { return __hip_atomic_fetch_add(p, v, __ATOMIC_RELAXED, __HIP_MEMORY_SCOPE_AGENT); }
__device__ __forceinline__ unsigned xb_xcc_id() { return (unsigned)__builtin_amdgcn_s_getreg((3 << 11) | 20) & 0xFu; }
#define XB_SPIN(cond, bar) do { unsigned _sp = 0; while (cond) { __builtin_amdgcn_s_sleep(1); \
    if ((++_sp & 255u) == 0u) { if (xb_ld(&(bar)[XB_TMO])) break; if (_sp > XB_SPIN_CAP) { atomicAdd(&(bar)[XB_TMO], 1u); break; } } } } while (0)

struct XcdBarrier {
    unsigned* bar; unsigned x;
    volatile LAS unsigned* st;
};

__device__ __forceinline__ XcdBarrier xcd_barrier_post(unsigned* bar, volatile LAS unsigned* st) {
    XcdBarrier b; b.bar = bar; b.x = xb_xcc_id(); b.st = st;
    if (threadIdx.x == 0) (void)xb_add(&bar[XB_XCNT(b.x)], 1u);
    return b;
}
__device__ __forceinline__ void xcd_barrier_complete(unsigned* bar, unsigned x, unsigned& nloc, unsigned& nx) {
    const unsigned G = gridDim.x * gridDim.y * gridDim.z;
    unsigned sum, cnt, mine, sp = 0u;
    for (;;) {
        sum = 0u; cnt = 0u; mine = 0u;
#pragma unroll
        for (unsigned j = 0; j < 16; ++j) { const unsigned c = xb_ld(&bar[XB_XCNT(j)]); sum += c; cnt += (c > 0u) ? 1u : 0u; mine = (j == x) ? c : mine; }
        if (sum == G) break;
        __builtin_amdgcn_s_sleep(1);
        if ((++sp & 255u) == 0u) { if (xb_ld(&bar[XB_TMO])) break; if (sp > XB_SPIN_CAP) { atomicAdd(&bar[XB_TMO], 1u); break; } }
    }
    nloc = mine > 0u ? mine : 1u; nx = cnt > 0u ? cnt : 1u;
}

__device__ __forceinline__ void xcd_barrier(const XcdBarrier& b, int wv_) {
    asm volatile("s_waitcnt vmcnt(0)" ::: "memory");
    __syncthreads();
    if (wv_ == 0 && LANEID() == 0) {
        unsigned* bar = b.bar;
        __builtin_amdgcn_s_waitcnt(0);
        unsigned nloc = b.st[0], nx = b.st[1];
        if (nloc == 0u) { xcd_barrier_complete(bar, b.x, nloc, nx); b.st[0] = nloc; b.st[1] = nx; }
        const unsigned old = xb_add(&bar[XB_XSUB(b.x)], 1u);
        const unsigned gen = old / nloc;
        if (old + 1u == (gen + 1u) * nloc) {
            __builtin_amdgcn_fence(__ATOMIC_RELEASE, "agent");
            asm volatile("s_waitcnt vmcnt(0)" ::: "memory");
            const unsigned og = xb_add(&bar[XB_TOP], 1u);
            const unsigned tg = og / nx;
            if (og + 1u == (tg + 1u) * nx) xb_add(&bar[XB_TOPGEN], 1u);
            else XB_SPIN(xb_ld(&bar[XB_TOPGEN]) == tg, bar);
            __builtin_amdgcn_fence(__ATOMIC_ACQUIRE, "agent");
            xb_add(&bar[XB_XGEN(b.x)], 1u);
            asm volatile("s_waitcnt vmcnt(0)" ::: "memory");
        } else {
            XB_SPIN(xb_ld(&bar[XB_XGEN(b.x)]) == gen, bar);
            __builtin_amdgcn_fence(__ATOMIC_ACQUIRE, "agent");
            asm volatile("s_waitcnt vmcnt(0)" ::: "memory");
        }
    }
    __syncthreads();
}

enum { PH_PRO = 0, PH_GIN, PH_INDEX, PH_ATTN, PH_MERGE, PH_GOUT, PH_LN1, PH_GQ, PH_ROUTE, PH_PEER };
template <int PH> __device__ __forceinline__ void run_phase(int WV_, const Params& p_unused, int l, unsigned char* lds_raw) {
    size_t kaoff_ = 0; asm volatile("" : "+s"(kaoff_));
    typedef const __attribute__((address_space(4))) char* kaptr_t;
    const __attribute__((address_space(4))) Params& p = *(const __attribute__((address_space(4))) Params*)((kaptr_t)__builtin_amdgcn_kernarg_segment_ptr() + kaoff_);
    float* sm = (float*)lds_raw;
    size_t wsoff_ = 0; asm volatile("" : "+s"(wsoff_));
    unsigned char* ws = p.ws + wsoff_;
    float* hbuf = p.out;
    bf16* hb = (bf16*)(ws + WS_HB);
    bf16* P = (bf16*)(ws + WS_P);
    bf16* ys = (bf16*)(ws + WS_YS);
    bf16* mrg = (bf16*)(ws + WS_MRG);
    float* mix = (float*)(ws + WS_MIX);
    float* qb = (float*)(ws + WS_Q);
    unsigned char* mask = ws + WS_MASK;
    int* eid = (int*)(ws + WS_EID);
    float* gate = (float*)(ws + WS_GATE);
    float* kmean = (float*)(ws + WS_KMEAN);
    const float* hin = (l == 0) ? p.in[0] : hbuf;
    if (PH == PH_PRO) { Params pc; for (int i = 0; i < 13; ++i) pc.in[i] = p.in[i]; pc.out = p.out; pc.ws = ws;
        prologue_phase(WV_, pc, sm); convert_tables(WV_, pc);
        for (int i = LBID() * NTHR + LTID(WV_); i < DEPTH_ * 8 * 2 * 128 * 64 / 4; i += LGRID() * NTHR) { const float4 v = ((const float4*)p.in[8])[i]; ((uint2*)(ws + WS_SKB))[i] = make_uint2(pk2(v.x, v.y), pk2(v.z, v.w)); } if (LBID() < 2) build_unit_table((unsigned*)(ws + WS_CTL) + 1024, LBID() * NTHR + LTID(WV_)); }
    else if (PH == PH_GIN) {
        pg8::Gemm g{hb, (const bf16*)(ws + WS_WIN_T + l * WIN_T_BYTES), T_, NP, 1024};
        pg8::StaticOrder S; S.init(T_, NP, (int)LGRID(), (int)LBID());
        pg8::EpiBf16<0> E{P, NP, nullptr, 0, 0, 1.f};
        pg8::gemm_phase<pg8::EpiBf16<0>, pg8::StaticOrder, true, true>(WV_, (PG8_LAS unsigned char*)lds_raw, g, S, E);
    }
    else if (PH == PH_INDEX) index_fast_phase(WV_, P, mask, kmean, (float*)(ws + WS_YS), lds_raw);
    else if (PH == PH_ATTN) attn_fast_phase(WV_, P, mask, kmean, p.in[4] + l * 4, ys, (const unsigned*)(ws + WS_CTL) + 1024, (unsigned*)(ws + WS_CTL) + 64 * l, lds_raw);
    else if (PH == PH_MERGE) merge_fast_phase(WV_, P, ys, (const bf16*)(ws + WS_WBR_T) + (size_t)l * 4 * 1024 * 256, mrg, lds_raw);
    else if (PH == PH_GOUT) {
        pg8::Gemm g{mrg, (const bf16*)(ws + WS_WOUT_T) + (size_t)l * 1024 * 1024, T_, 1024, 1024};
        pg8::StaticOrder S; S.init(T_, 1024, (int)LGRID(), (int)LBID());
        pg8::EpiResY E{hin, hbuf, hb, (float*)(ws + WS_STATS) + (size_t)l * T_ * 2, ALPHA};
        pg8::gemm_phase<pg8::EpiResY, pg8::StaticOrder, true, true>(WV_, (PG8_LAS unsigned char*)lds_raw, g, S, E);
    }
    else if (PH == PH_GQ) {
        pg8::Gemm g{hb, (const bf16*)(ws + WS_WQ_T) + (size_t)l * 1024 * 1024, T_, 1024, 1024};
        pg8::StaticOrder S; S.init(T_, 1024, (int)LGRID(), (int)LBID());
        pg8::EpiLnFold E{(bf16*)qb, (const float*)(ws + WS_STATS) + (size_t)l * T_ * 2, (const float*)(ws + WS_COLS) + l * 2048, (const float*)(ws + WS_COLS) + l * 2048 + 1024, LN_EPS};
        pg8::gemm_phase<pg8::EpiLnFold, pg8::StaticOrder, true, true>(WV_, (PG8_LAS unsigned char*)lds_raw, g, S, E);
    }
    else if (PH == PH_ROUTE) route_fast_phase(WV_, (const bf16*)qb, (const bf16*)(ws + WS_SKB) + (size_t)l * 8 * 2 * 128 * 64, eid, gate, lds_raw);
    else peer_fast_phase(WV_, hbuf, hb, eid, gate, ws + WS_UV + (size_t)l * 32 * MiB, p.in[5] + l * 1024, p.in[6] + l * 1024, p.in[11] + l * 1024, p.in[12] + l * 1024, lds_raw);
}

constexpr int CW_BAR = 4096;
constexpr int LDS_BARST = LDS_BYTES - 16;
__global__ void __launch_bounds__(NTHR, 2) mk_fwd(Params p) {
    extern __shared__ __attribute__((aligned(16))) unsigned char lds_raw[];
    cg::grid_group grid = cg::this_grid();
    const int WV_ = __builtin_amdgcn_readfirstlane((int)threadIdx.x >> 6);
    { volatile LAS unsigned* bst0 = (volatile LAS unsigned*)((LAS unsigned char*)lds_raw + LDS_BARST); if (threadIdx.x < 4) bst0[threadIdx.x] = 0u; }
    __syncthreads();
    volatile LAS unsigned* bst = (volatile LAS unsigned*)((LAS unsigned char*)lds_raw + LDS_BARST);
    (void)xcd_barrier_post((unsigned*)(p.ws + WS_CTL) + CW_BAR, bst);
#define GRID_BAR() do { XcdBarrier b_; b_.bar = (unsigned*)(p.ws + WS_CTL) + CW_BAR; b_.x = xb_xcc_id(); b_.st = (volatile LAS unsigned*)((LAS unsigned char*)lds_raw + LDS_BARST); xcd_barrier(b_, WV_); } while (0)
    run_phase<PH_PRO>(WV_, p, 0, lds_raw);
    grid.sync();
#pragma unroll 1
    for (int l = 0; l < DEPTH_; ++l) {
        run_phase<PH_GIN>(WV_, p, l, lds_raw); GRID_BAR();
        run_phase<PH_INDEX>(WV_, p, l, lds_raw); GRID_BAR();
        run_phase<PH_ATTN>(WV_, p, l, lds_raw); GRID_BAR();
        run_phase<PH_MERGE>(WV_, p, l, lds_raw); GRID_BAR();
        run_phase<PH_GOUT>(WV_, p, l, lds_raw); GRID_BAR();
        run_phase<PH_GQ>(WV_, p, l, lds_raw); GRID_BAR();
        run_phase<PH_ROUTE>(WV_, p, l, lds_raw); GRID_BAR();
        run_phase<PH_PEER>(WV_, p, l, lds_raw); if (l + 1 < DEPTH_) GRID_BAR();
    }
}

extern "C" void kernel_launch(void* const* d_in, const int* in_sizes, int n_in, void* d_out, int out_size, void* d_ws, size_t ws_size, hipStream_t stream) {
    if (n_in != 13 || ws_size < WS_END) { fprintf(stderr, "kernel_launch: unexpected n_in %d / ws_size %zu; nothing launched\n", n_in, ws_size); return; }
    static int grid_blocks = 0;
    if (grid_blocks == 0) {
        int dev = 0, cus = 0, per_cu = 0;
        (void)hipGetDevice(&dev);
        (void)hipDeviceGetAttribute(&cus, hipDeviceAttributeMultiprocessorCount, dev);
        (void)hipFuncSetAttribute((const void*)mk_fwd, hipFuncAttributeMaxDynamicSharedMemorySize, LDS_BYTES);
        (void)hipOccupancyMaxActiveBlocksPerMultiprocessor(&per_cu, (const void*)mk_fwd, NTHR, LDS_BYTES);
        if (per_cu < 1) fprintf(stderr, "kernel_launch: occupancy query reports %d\n", per_cu);
        grid_blocks = cus;
    }
    Params p{};
    for (int i = 0; i < 13; ++i) p.in[i] = (const float*)d_in[i];
    p.out = (float*)d_out; p.ws = (unsigned char*)d_ws;
    (void)hipMemsetAsync(d_ws, 0, 2 * MiB, stream);
    void* args[] = {&p};
    hipError_t e = hipLaunchCooperativeKernel((const void*)mk_fwd, dim3(grid_blocks), dim3(NTHR), args, LDS_BYTES, stream);
    if (e != hipSuccess) fprintf(stderr, "cooperative launch failed: %s (grid %d)\n", hipGetErrorString(e), grid_blocks);
}
```

```cpp
#include <hip/hip_runtime.h>
#include <cstdio>
#include <cstdint>
#include <hip/hip_cooperative_groups.h>
namespace cg = cooperative_groups;

__device__ __forceinline__ int LANEID() { int l; asm volatile("v_mbcnt_lo_u32_b32 %0, -1, 0\n\tv_mbcnt_hi_u32_b32 %0, -1, %0" : "=v"(l)); return l; }
__device__ __forceinline__ int LTID(int wv) { return (wv << 6) | LANEID(); }
__device__ __forceinline__ int LBID() { int t = blockIdx.x; asm volatile("" : "+s"(t)); return t; }
__device__ __forceinline__ int LGRID() { int t = gridDim.x; asm volatile("" : "+s"(t)); return t; }
namespace pg8 {
#define PG8_LAS __attribute__((address_space(3)))
typedef unsigned short bf16_t;
typedef short bf16x8 __attribute__((ext_vector_type(8)));
typedef float f32x4 __attribute__((ext_vector_type(4)));
typedef unsigned u32x4 __attribute__((ext_vector_type(4)));
constexpr int BM = 256, BK = 64, HALF = 128, HTB = HALF * BK * 2  , STAGE_BYTES = 8 * HTB, NXCD = 8, WGM = 8;

__host__ __device__ __forceinline__ int lds_byte(int r, int c) { const int st = (r >> 4) * 2 + (c >> 5), rr = r & 15, cc = c & 31, ob = rr * 64 + cc * 2; return st * 1024 + (ob ^ (((ob >> 9) & 1) << 5)); }
__host__ __device__ __forceinline__ void stage_rc(int b, int& R, int& C) { const int st = b / 1024, sb = b % 1024, swz = sb ^ (((sb >> 9) & 1) << 5); R = (st >> 1) * 16 + swz / 64; C = (st & 1) * 32 + (swz % 64) / 2; }
__host__ __device__ __forceinline__ int perm32(int rho) { const int n = rho >> 4, i = rho & 15; return 8 * (i >> 2) + 4 * n + (i & 3); }

struct Unit { int pm, pn; };
struct Gemm { const bf16_t* A; const bf16_t* Bt; int M, N, K; };

struct StaticOrder {
    int nM, nN, nwg, G, c;
    __host__ __device__ void init(int M, int N, int G_, int c_) { nM = M / BM; nN = N / BM; nwg = nM * nN; G = G_; c = c_; }
    __host__ __device__ bool next(int i, Unit& u) const {
        const long L = (long)i * G + c; if (L >= nwg) return false;
        int wgid = (int)L; { const int q = nwg / NXCD, r = nwg % NXCD, xcd = wgid % NXCD, off = wgid / NXCD; wgid = (xcd < r ? xcd * (q + 1) : r * (q + 1) + (xcd - r) * q) + off; }
        const int nig = WGM * nN, gid = wgid / nig, fm = gid * WGM, gsz = (nM - fm) < WGM ? (nM - fm) : WGM;
        u.pm = fm + ((wgid % nig) % gsz); u.pn = (wgid % nig) / gsz; return true;
    }
    __device__ __forceinline__ void a_ready(const Unit&) const {}
    __device__ __forceinline__ void done(const Unit&) const {}
};

__device__ __forceinline__ unsigned cvt_pk_bf16(float lo, float hi) { unsigned r; asm volatile("v_cvt_pk_bf16_f32 %0, %1, %2" : "=v"(r) : "v"(lo), "v"(hi)); return r; }
typedef float f32x2 __attribute__((ext_vector_type(2)));
__device__ __forceinline__ f32x2 gelu_pk(f32x2 v) {
    const f32x2 av = __builtin_elementwise_abs(v), d = av * 0.2316418882f + 1.0f;
    f32x2 t; t.x = __builtin_amdgcn_rcpf(d.x); t.y = __builtin_amdgcn_rcpf(d.y);
    f32x2 q = t * 0.5307027145f + (-0.7265760135f); q = q * t + 0.7107068705f; q = q * t + (-0.142248368f); q = q * t + 0.127414796f; q = q * t;
    const f32x2 s = (v * v) * (-0.72134752044f);
    f32x2 e; e.x = __builtin_amdgcn_exp2f(s.x); e.y = __builtin_amdgcn_exp2f(s.y);
    const f32x2 m = v * (q * e), r = v - m;
    f32x2 o; o.x = v.x < 0.f ? m.x : r.x; o.y = v.y < 0.f ? m.y : r.y; return o;
}

template <int ACT  > struct EpiBf16 {
    static constexpr bool PERM = true, AFTER_DRAIN = false; static_assert(ACT == 0 || ACT == 1, "EpiBf16: ACT is 0 (none) or 1 (gelu_pk)");
    bf16_t* O; int ldc; const float* bias; int split_cols; size_t split_stride; float scale0;
    __device__ __forceinline__ void operator()(const f32x4 (&acc)[2][2][4][2], const Unit& u, int wr, int wc, int fr, int fq) const {
        { int ln_ = LANEID(); asm volatile("" : "+v"(ln_)); fr = ln_ & 15; fq = ln_ >> 4; }
        const int row0 = u.pm * BM + wr * 64 + fr; int colt = u.pn * BM; bf16_t* base = O;
        float sc = 1.f; if (split_cols) { const int t = colt / split_cols; base += (size_t)t * split_stride; colt -= t * split_cols; if (t == 0) sc = scale0; }
        const int col0 = colt + wc * 32 + 8 * fq, bcol0 = u.pn * BM + wc * 32 + 8 * fq;
        f32x4 bv[2][2];
#pragma unroll
        for (int bj = 0; bj < 2; ++bj)
#pragma unroll
            for (int n = 0; n < 2; ++n) bv[bj][n] = bias ? *(const f32x4*)(bias + bcol0 + bj * HALF + 4 * n) : (f32x4){0.f, 0.f, 0.f, 0.f};
#pragma unroll
        for (int ai = 0; ai < 2; ++ai)
#pragma unroll
            for (int m = 0; m < 4; ++m) { bf16_t* rowp = base + (size_t)(row0 + ai * HALF + m * 16) * ldc + col0;
#pragma unroll
                for (int bj = 0; bj < 2; ++bj) { f32x4 v0 = acc[ai][bj][m][0] + bv[bj][0], v1 = acc[ai][bj][m][1] + bv[bj][1];
                    if (ACT == 1) { f32x2 a = gelu_pk((f32x2){v0[0], v0[1]}), b = gelu_pk((f32x2){v0[2], v0[3]}), c = gelu_pk((f32x2){v1[0], v1[1]}), d = gelu_pk((f32x2){v1[2], v1[3]});
                        v0 = (f32x4){a.x, a.y, b.x, b.y}; v1 = (f32x4){c.x, c.y, d.x, d.y}; }
                    v0 = v0 * sc; v1 = v1 * sc; u32x4 w; w.x = cvt_pk_bf16(v0[0], v0[1]); w.y = cvt_pk_bf16(v0[2], v0[3]); w.z = cvt_pk_bf16(v1[0], v1[1]); w.w = cvt_pk_bf16(v1[2], v1[3]);
                    *(u32x4*)(rowp + bj * HALF) = w; } }
    }
};
template <class Epi, class Sched, bool ALIGN_EPI = false, bool SP2 = false>
__device__ __forceinline__ void gemm_phase(int WV_, PG8_LAS unsigned char* lds, const Gemm g, const Sched& S, const Epi& E) {
    const int tid = LTID(WV_), wid = __builtin_amdgcn_readfirstlane(tid >> 6), lane = tid & 63, wr = wid >> 2, wc = wid & 3, fr = lane & 15, fq = lane >> 4;
    const int K = g.K, nt = K / BK;
    unsigned voffA[2], voffB[2];
#pragma unroll
    for (int i = 0; i < 2; ++i) { int R, C; stage_rc(tid * 16 + i * 8192, R, C); const int Rb = Epi::PERM ? ((R & ~31) + perm32(R & 31)) : R;
        voffA[i] = (unsigned)(R * K + C) * 2u; voffB[i] = (unsigned)(Rb * K + C) * 2u; }
    const size_t kstep = (size_t)(BK * 2);
    const size_t hstep = (size_t)HALF * K * 2;
    const size_t tstep = 2 * hstep;
    const unsigned ldsw = (unsigned)wid * 1024u;
    const int aoff = lds_byte(wr * 64 + fr, fq * 8), boff = lds_byte(wc * 32 + fr, fq * 8);
#define PG8_SA(b, h) (((b) * 2 + (h)) * HTB)
#define PG8_SB(b, h) ((4 + (b) * 2 + (h)) * HTB)
#define PG8_STAGE(bufoff, gbase, voff) do { _Pragma("unroll") for (int _i = 0; _i < 2; ++_i) \
        __builtin_amdgcn_global_load_lds((const unsigned*)((const char*)(gbase) + (voff)[_i]), (PG8_LAS unsigned*)(lds + (bufoff) + ldsw + _i * 8192), 16, 0, 0); } while (0)
#define PG8_LDA(dst, b, h) do { _Pragma("unroll") for (int m = 0; m < 4; ++m) _Pragma("unroll") for (int k = 0; k < 2; ++k) dst[m][k] = *(const PG8_LAS bf16x8*)(lds + PG8_SA(b, h) + aoff + m * 2048 + k * 1024); } while (0)
#define PG8_LDB(dst, b, h) do { _Pragma("unroll") for (int n = 0; n < 2; ++n) _Pragma("unroll") for (int k = 0; k < 2; ++k) dst[n][k] = *(const PG8_LAS bf16x8*)(lds + PG8_SB(b, h) + boff + n * 2048 + k * 1024); } while (0)
#define PG8_MMA(ai, bj, At, Bt) do { __builtin_amdgcn_s_setprio(1); _Pragma("unroll") for (int m = 0; m < 4; ++m) _Pragma("unroll") for (int n = 0; n < 2; ++n) _Pragma("unroll") for (int k = 0; k < 2; ++k) \
        acc[ai][bj][m][n] = __builtin_amdgcn_mfma_f32_16x16x32_bf16(Bt[n][k], At[m][k], acc[ai][bj][m][n], 0, 0, 0); __builtin_amdgcn_s_setprio(0); } while (0)
#define PG8_WAIT_V(n) asm volatile("s_waitcnt vmcnt(" #n ")" ::: "memory")
#define PG8_WAIT_L(n) asm volatile("s_waitcnt lgkmcnt(" #n ")" ::: "memory")
#define PG8_BAR __builtin_amdgcn_s_barrier()
#define PG8_SCHED __builtin_amdgcn_sched_barrier(0)
    Unit cur, nxt; int ui = 0;
    if (!S.next(0, cur)) return;
    f32x4 acc[2][2][4][2];
#pragma unroll
    for (int a = 0; a < 2; ++a)
#pragma unroll
        for (int b = 0; b < 2; ++b)
#pragma unroll
            for (int m = 0; m < 4; ++m)
#pragma unroll
                for (int n = 0; n < 2; ++n) acc[a][b][m][n] = (f32x4){0.f, 0.f, 0.f, 0.f};
    bf16x8 At[4][2], B0[2][2], B1[2][2];
    const char* cA = (const char*)g.A + (size_t)cur.pm * tstep; const char* cB = (const char*)g.Bt + (size_t)cur.pn * tstep;
    S.a_ready(cur);
    if constexpr (SP2) {
        PG8_STAGE(PG8_SB(0, 0), cB, voffB); PG8_STAGE(PG8_SB(0, 1), cB + hstep, voffB); PG8_STAGE(PG8_SA(0, 0), cA, voffA); PG8_STAGE(PG8_SA(0, 1), cA + hstep, voffA);
        if (wr == 1) PG8_BAR;
        PG8_WAIT_V(2); PG8_BAR;
        PG8_STAGE(PG8_SB(1, 0), cB + kstep, voffB); PG8_STAGE(PG8_SA(1, 0), cA + kstep, voffA); PG8_STAGE(PG8_SB(1, 1), cB + hstep + kstep, voffB);
        PG8_WAIT_V(6); PG8_BAR;
    } else {
        PG8_STAGE(PG8_SB(0, 0), cB, voffB); PG8_STAGE(PG8_SA(0, 0), cA, voffA); PG8_STAGE(PG8_SB(0, 1), cB + hstep, voffB); PG8_STAGE(PG8_SA(0, 1), cA + hstep, voffA);
        if (wr == 1) PG8_BAR;
        PG8_WAIT_V(4); PG8_BAR;
        PG8_STAGE(PG8_SB(1, 0), cB + kstep, voffB); PG8_STAGE(PG8_SA(1, 0), cA + kstep, voffA); PG8_STAGE(PG8_SB(1, 1), cB + hstep + kstep, voffB);
        PG8_WAIT_V(6); PG8_BAR;
    }
    for (;;) {
        const bool has_next = S.next(ui + 1, nxt);
        const char* nA = has_next ? (const char*)g.A + (size_t)nxt.pm * tstep : cA; const char* nB = has_next ? (const char*)g.Bt + (size_t)nxt.pn * tstep : cB;
        for (int t = 0; t < nt; t += 2) {
            const bool last = (t == nt - 2);
            const char* a1 = cA + (size_t)(t + 1) * kstep;
            const char* a2 = last ? nA : cA + (size_t)(t + 2) * kstep; const char* b2 = last ? nB : cB + (size_t)(t + 2) * kstep;
            const char* a3 = a2 + kstep; const char* b3 = b2 + kstep;
            if (last && has_next) S.a_ready(nxt);
            if constexpr (SP2) {
            PG8_LDB(B0, 0, 0); PG8_LDB(B1, 0, 1); PG8_SCHED; PG8_LDA(At, 0, 0); PG8_STAGE(PG8_SA(1, 1), a1 + hstep, voffA);
            PG8_WAIT_V(8); PG8_WAIT_L(0); PG8_BAR; PG8_MMA(0, 0, At, B0); PG8_MMA(0, 1, At, B1); PG8_BAR; PG8_SCHED;
            PG8_LDA(At, 0, 1); PG8_STAGE(PG8_SB(0, 0), b2, voffB); PG8_STAGE(PG8_SB(0, 1), b2 + hstep, voffB); PG8_STAGE(PG8_SA(0, 0), a2, voffA);
            PG8_WAIT_V(8); PG8_WAIT_L(0); PG8_BAR; PG8_MMA(1, 0, At, B0); PG8_MMA(1, 1, At, B1); PG8_BAR; PG8_SCHED;
            PG8_LDB(B0, 1, 0); PG8_LDB(B1, 1, 1); PG8_SCHED; PG8_LDA(At, 1, 0); PG8_STAGE(PG8_SA(0, 1), a2 + hstep, voffA);
            PG8_WAIT_V(8); PG8_WAIT_L(0); PG8_BAR; PG8_MMA(0, 0, At, B0); PG8_MMA(0, 1, At, B1); PG8_BAR; PG8_SCHED;
            PG8_LDA(At, 1, 1); PG8_STAGE(PG8_SB(1, 0), b3, voffB); PG8_STAGE(PG8_SB(1, 1), b3 + hstep, voffB); PG8_STAGE(PG8_SA(1, 0), a3, voffA);
            PG8_WAIT_V(8); PG8_WAIT_L(0); PG8_BAR; PG8_MMA(1, 0, At, B0); PG8_MMA(1, 1, At, B1); PG8_BAR; PG8_SCHED;
            } else {
            PG8_LDB(B0, 0, 0); PG8_SCHED; PG8_LDA(At, 0, 0); PG8_STAGE(PG8_SA(1, 1), a1 + hstep, voffA);
            PG8_WAIT_L(8); PG8_BAR; PG8_WAIT_L(0); PG8_MMA(0, 0, At, B0); PG8_BAR; PG8_SCHED;
            PG8_LDB(B1, 0, 1); PG8_STAGE(PG8_SB(0, 0), b2, voffB);
            PG8_BAR; PG8_WAIT_L(0); PG8_MMA(0, 1, At, B1); PG8_BAR;
            PG8_LDA(At, 0, 1); PG8_STAGE(PG8_SA(0, 0), a2, voffA);
            PG8_BAR; PG8_WAIT_L(0); PG8_MMA(1, 0, At, B0); PG8_BAR; PG8_SCHED;
            PG8_STAGE(PG8_SB(0, 1), b2 + hstep, voffB);
            PG8_WAIT_V(6); PG8_BAR; PG8_MMA(1, 1, At, B1); PG8_BAR;
            PG8_LDB(B0, 1, 0); PG8_SCHED; PG8_LDA(At, 1, 0); PG8_STAGE(PG8_SA(0, 1), a2 + hstep, voffA);
            PG8_WAIT_L(8); PG8_BAR; PG8_WAIT_L(0); PG8_MMA(0, 0, At, B0); PG8_BAR; PG8_SCHED;
            PG8_LDB(B1, 1, 1); PG8_STAGE(PG8_SB(1, 0), b3, voffB);
            PG8_BAR; PG8_WAIT_L(0); PG8_MMA(0, 1, At, B1); PG8_BAR;
            PG8_LDA(At, 1, 1); PG8_STAGE(PG8_SA(1, 0), a3, voffA);
            PG8_BAR; PG8_WAIT_L(0); PG8_MMA(1, 0, At, B0); PG8_BAR; PG8_SCHED;
            PG8_STAGE(PG8_SB(1, 1), b3 + hstep, voffB);
            PG8_WAIT_V(6); PG8_BAR; PG8_MMA(1, 1, At, B1); PG8_BAR;
            }
        }
        if constexpr (ALIGN_EPI) { if (wr == 0) PG8_BAR; }
        if constexpr (!Epi::AFTER_DRAIN) { E(acc, cur, wr, wc, fr, fq); S.done(cur); }
        if (!has_next) break;
#pragma unroll
        for (int a = 0; a < 2; ++a)
#pragma unroll
            for (int b = 0; b < 2; ++b)
#pragma unroll
                for (int m = 0; m < 4; ++m)
#pragma unroll
                    for (int n = 0; n < 2; ++n) acc[a][b][m][n] = (f32x4){0.f, 0.f, 0.f, 0.f};
        cur = nxt; cA = nA; cB = nB; ++ui;
        if constexpr (ALIGN_EPI) { if (wr == 1) PG8_BAR; }
    }
    PG8_WAIT_V(0);
    if constexpr (!ALIGN_EPI) { if (wr == 0) PG8_BAR; }
    PG8_BAR;
    if constexpr (Epi::AFTER_DRAIN) { E.fused(acc, cur, wr, wc, fr, fq, lds, wid, lane); S.done(cur); }
#undef PG8_SA
#undef PG8_SB
#undef PG8_STAGE
#undef PG8_LDA
#undef PG8_LDB
#undef PG8_MMA
#undef PG8_WAIT_V
#undef PG8_WAIT_L
#undef PG8_BAR
#undef PG8_SCHED
}
}
namespace pg8 {
struct EpiF32 {
    static constexpr bool PERM = false, AFTER_DRAIN = false;
    float* O; int ldc;
    __device__ __forceinline__ void operator()(const f32x4 (&acc)[2][2][4][2], const Unit& u, int wr, int wc, int fr, int fq) const {
        { int ln_ = LANEID(); asm volatile("" : "+v"(ln_)); fr = ln_ & 15; fq = ln_ >> 4; }
        const int row0 = u.pm * BM + wr * 64 + fr, col0 = u.pn * BM + wc * 32 + 4 * fq;
#pragma unroll
        for (int ai = 0; ai < 2; ++ai)
#pragma unroll
            for (int m = 0; m < 4; ++m) { float* rowp = O + (size_t)(row0 + ai * HALF + m * 16) * ldc + col0;
#pragma unroll
                for (int bj = 0; bj < 2; ++bj)
#pragma unroll
                    for (int n = 0; n < 2; ++n) *(f32x4*)(rowp + bj * HALF + n * 16) = acc[ai][bj][m][n]; }
    }
};
struct EpiResY {
    static constexpr bool PERM = false, AFTER_DRAIN = false;
    const float* hin; float* yout; bf16_t* yb; float* stats; float alpha;
    __device__ __forceinline__ void operator()(const f32x4 (&acc)[2][2][4][2], const Unit& u, int wr, int wc, int fr, int fq) const {
        { int ln_ = LANEID(); asm volatile("" : "+v"(ln_)); fr = ln_ & 15; fq = ln_ >> 4; }
        const int row0 = u.pm * BM + wr * 64 + fr, col0 = u.pn * BM + wc * 32 + 4 * fq;
#pragma unroll
        for (int ai = 0; ai < 2; ++ai)
#pragma unroll
            for (int m = 0; m < 4; ++m) {
                const int row = row0 + ai * HALF + m * 16;
                float s = 0.f, s2 = 0.f;
#pragma unroll
                for (int bj = 0; bj < 2; ++bj)
#pragma unroll
                    for (int n = 0; n < 2; ++n) {
                        const size_t off = (size_t)row * 1024 + col0 + bj * HALF + n * 16;
                        const f32x4 hv = *(const f32x4*)(hin + off);
                        const f32x4 y = hv * alpha + acc[ai][bj][m][n];
                        *(f32x4*)(yout + off) = y;
                        typedef unsigned u32x2v __attribute__((ext_vector_type(2)));
                        u32x2v w; w.x = cvt_pk_bf16(y[0], y[1]); w.y = cvt_pk_bf16(y[2], y[3]);
                        *(u32x2v*)(yb + off) = w;
                        s += (y[0] + y[1]) + (y[2] + y[3]); s2 += (y[0] * y[0] + y[1] * y[1]) + (y[2] * y[2] + y[3] * y[3]);
                    }
                s += __shfl_xor(s, 16); s += __shfl_xor(s, 32); s2 += __shfl_xor(s2, 16); s2 += __shfl_xor(s2, 32);
                if (fq == 0) { atomicAdd(stats + 2 * (size_t)row, s); atomicAdd(stats + 2 * (size_t)row + 1, s2); }
            }
    }
};
struct EpiLnFold {
    static constexpr bool PERM = true, AFTER_DRAIN = false;
    bf16_t* O; const float* stats; const float* colsum; const float* colbias; float eps;
    __device__ __forceinline__ void operator()(const f32x4 (&acc)[2][2][4][2], const Unit& u, int wr, int wc, int fr, int fq) const {
        { int ln_ = LANEID(); asm volatile("" : "+v"(ln_)); fr = ln_ & 15; fq = ln_ >> 4; }
        const int row0 = u.pm * BM + wr * 64 + fr, col0 = u.pn * BM + wc * 32 + 8 * fq;
        f32x4 cs[2][2], cb[2][2];
#pragma unroll
        for (int bj = 0; bj < 2; ++bj)
#pragma unroll
            for (int n = 0; n < 2; ++n) { cs[bj][n] = *(const f32x4*)(colsum + col0 + bj * HALF + 4 * n); cb[bj][n] = *(const f32x4*)(colbias + col0 + bj * HALF + 4 * n); }
#pragma unroll
        for (int ai = 0; ai < 2; ++ai)
#pragma unroll
            for (int m = 0; m < 4; ++m) {
                const int row = row0 + ai * HALF + m * 16;
                const float sm_ = stats[2 * (size_t)row], sq_ = stats[2 * (size_t)row + 1];
                const float mean = sm_ * (1.0f / 1024.0f);
                const float rstd = 1.0f / sqrtf(fmaxf(sq_ * (1.0f / 1024.0f) - mean * mean, 0.f) + eps);
                bf16_t* rowp = O + (size_t)row * 1024 + col0;
#pragma unroll
                for (int bj = 0; bj < 2; ++bj) {
                    const f32x4 v0 = (acc[ai][bj][m][0] - cs[bj][0] * mean) * rstd + cb[bj][0], v1 = (acc[ai][bj][m][1] - cs[bj][1] * mean) * rstd + cb[bj][1];
                    u32x4 w; w.x = cvt_pk_bf16(v0[0], v0[1]); w.y = cvt_pk_bf16(v0[2], v0[3]); w.z = cvt_pk_bf16(v1[0], v1[1]); w.w = cvt_pk_bf16(v1[2], v1[3]);
                    *(u32x4*)(rowp + bj * HALF) = w;
                }
            }
    }
};
}

typedef unsigned short bf16;
constexpr int T_ = 16384, S_ = 4096, NBATCH = 4, D_ = 1024, NCOL = 6824, NP = 6912, DEPTH_ = 2;
constexpr int C_QA = 0, C_KA = 256, C_VA = 320, C_QI = 384, C_KI = 640, C_WI = 672, C_QB = 680, C_KB = 936, C_VB = 1064,
              C_QC = 1192, C_KC = 1448, C_VC = 1704, C_QD = 1960, C_KD = 2216, C_VD = 2472, C_G = 2728;
constexpr int NTHR = 512, NWAVE = 8;
constexpr float ALPHA = 1.41421356237309515f;
constexpr float LN_EPS = 1e-5f;
constexpr size_t MiB = 1u << 20;
constexpr size_t WS_STATS = 1 * MiB  , WS_COLS = 1 * MiB + 512 * 1024  ;
constexpr size_t WS_CTL = 0, WS_WIN_T = 2 * MiB, WS_WOUT_T = 30 * MiB, WS_WQ_T = 34 * MiB, WS_WBR_T = 38 * MiB, WS_HB = 42 * MiB,
                 WS_P = 74 * MiB, WS_MIX = 74 * MiB  , WS_Q = 138 * MiB  , WS_YS = 290 * MiB, WS_MRG = 322 * MiB,
                 WS_MASK = 354 * MiB, WS_EID = 362 * MiB, WS_GATE = 370 * MiB, WS_KMEAN = 378 * MiB, WS_SKB = 379 * MiB, WS_UV = 380 * MiB, WS_END = 508 * MiB;
constexpr size_t WIN_T_BYTES = (size_t)NP * 1024 * 2;
constexpr int LDS_BYTES = 144 * 1024;

struct Params { const float* in[13]; float* out; unsigned char* ws; };

__device__ __forceinline__ float bf2f(bf16 v) { return __uint_as_float((unsigned)v << 16); }
__device__ __forceinline__ unsigned f2bf(float f) { unsigned u = __float_as_uint(f); return (u + 0x7fffu + ((u >> 16) & 1u)) >> 16; }
__device__ __forceinline__ unsigned pk2(float lo, float hi) { return f2bf(lo) | (f2bf(hi) << 16); }
__device__ __forceinline__ void unpack8(const uint4 v, float* o) {
    o[0] = __uint_as_float(v.x << 16); o[1] = __uint_as_float(v.x & 0xffff0000u); o[2] = __uint_as_float(v.y << 16); o[3] = __uint_as_float(v.y & 0xffff0000u);
    o[4] = __uint_as_float(v.z << 16); o[5] = __uint_as_float(v.z & 0xffff0000u); o[6] = __uint_as_float(v.w << 16); o[7] = __uint_as_float(v.w & 0xffff0000u);
}
__device__ __forceinline__ float wave_sum(float v) {
#pragma unroll
    for (int o = 32; o > 0; o >>= 1) v += __shfl_xor(v, o);
    return v;
}
__device__ __forceinline__ float wave_max(float v) {
#pragma unroll
    for (int o = 32; o > 0; o >>= 1) v = fmaxf(v, __shfl_xor(v, o));
    return v;
}
__device__ __forceinline__ int wave_sum_i(int v) {
#pragma unroll
    for (int o = 32; o > 0; o >>= 1) v += __shfl_xor(v, o);
    return v;
}
__device__ __forceinline__ float logsig(float x) { return fminf(x, 0.f) - log1pf(expf(-fabsf(x))); }

__device__ void transpose_items(int WV_, const float* W, int K, int N, bf16* WT, float* sm, int item0, int nitems_total, int item_stride,
                                const float* rs_g = nullptr, const float* rs_b = nullptr, float* colsum = nullptr, float* colbias = nullptr) {
    const int tid = LTID(WV_);
    const int nkb = K / 64, nnb = (N + 63) / 64;
    for (int it = item0; it < nkb * nnb; it += item_stride) {
        const int kb = it % nkb, nb = it / nkb, k0 = kb * 64, n0 = nb * 64;
        __syncthreads();
        for (int e = tid; e < 64 * 64; e += NTHR) { const int kk = e >> 6, nn = e & 63; sm[kk * 65 + nn] = (n0 + nn < N) ? W[(size_t)(k0 + kk) * N + n0 + nn] : 0.f; }
        __syncthreads();
        if (rs_g) {
            if (tid < 64) { float cs = 0.f, cb = 0.f;
                for (int kk = 0; kk < 64; ++kk) { const float w = sm[kk * 65 + tid]; cs += w * rs_g[k0 + kk]; cb += w * rs_b[k0 + kk]; }
                atomicAdd(colsum + n0 + tid, cs); atomicAdd(colbias + n0 + tid, cb); }
            __syncthreads();
            for (int e = tid; e < 64 * 64; e += NTHR) { const int kk = e >> 6, nn = e & 63; sm[kk * 65 + nn] *= rs_g[k0 + kk]; }
            __syncthreads();
        }
        { const int nn = tid >> 3, c = tid & 7;
          if (n0 + nn < N) { uint4 o; o.x = pk2(sm[(8 * c + 0) * 65 + nn], sm[(8 * c + 1) * 65 + nn]); o.y = pk2(sm[(8 * c + 2) * 65 + nn], sm[(8 * c + 3) * 65 + nn]);
              o.z = pk2(sm[(8 * c + 4) * 65 + nn], sm[(8 * c + 5) * 65 + nn]); o.w = pk2(sm[(8 * c + 6) * 65 + nn], sm[(8 * c + 7) * 65 + nn]);
              *(uint4*)(WT + (size_t)(n0 + nn) * K + k0 + 8 * c) = o; } }
    }
    __syncthreads();
}
__device__ void prologue_phase(int WV_, const Params& p, float* sm) {
    const int tid = LTID(WV_), B = LBID(), G = LGRID();
    unsigned char* ws = p.ws;
    for (int l = 0; l < DEPTH_; ++l) {
        bf16* win_t = (bf16*)(ws + WS_WIN_T + l * WIN_T_BYTES);
        transpose_items(WV_, p.in[1] + (size_t)l * 1024 * NCOL, 1024, NCOL, win_t, sm, B, 0, G);
        for (int i = B * NTHR + tid; i < (NP - NCOL) * 1024 / 8; i += G * NTHR) ((uint4*)(win_t + (size_t)NCOL * 1024))[i] = make_uint4(0u, 0u, 0u, 0u);
        transpose_items(WV_, p.in[3] + (size_t)l * 1024 * 1024, 1024, 1024, (bf16*)(ws + WS_WOUT_T) + (size_t)l * 1024 * 1024, sm, B, 0, G);
        transpose_items(WV_, p.in[7] + (size_t)l * 1024 * 1024, 1024, 1024, (bf16*)(ws + WS_WQ_T) + (size_t)l * 1024 * 1024, sm, B, 0, G,
                        p.in[5] + l * 1024, p.in[6] + l * 1024, (float*)(ws + WS_COLS) + l * 2048, (float*)(ws + WS_COLS) + l * 2048 + 1024);
        for (int n = 0; n < 4; ++n)
            transpose_items(WV_, p.in[2] + ((size_t)l * 4 + n) * 256 * 1024, 256, 1024, (bf16*)(ws + WS_WBR_T) + ((size_t)l * 4 + n) * 1024 * 256, sm, B, 0, G);
    }
    const float4* x4 = (const float4*)p.in[0]; uint2* hb2 = (uint2*)(ws + WS_HB);
    for (size_t i = (size_t)B * NTHR + tid; i < (size_t)T_ * 1024 / 4; i += (size_t)G * NTHR) { const float4 v = x4[i]; hb2[i] = make_uint2(pk2(v.x, v.y), pk2(v.z, v.w)); }
}

__device__ __forceinline__ void ln_row(float4 (&v)[4], const float* g, const float* bb, float* orow, bf16* obrow, int lane) {
    float s = 0.f;
#pragma unroll
    for (int j = 0; j < 4; ++j) s += (v[j].x + v[j].y) + (v[j].z + v[j].w);
    const float mean = wave_sum(s) * (1.0f / 1024.0f);
    float s2 = 0.f;
#pragma unroll
    for (int j = 0; j < 4; ++j) { v[j].x -= mean; v[j].y -= mean; v[j].z -= mean; v[j].w -= mean; s2 += (v[j].x * v[j].x + v[j].y * v[j].y) + (v[j].z * v[j].z + v[j].w * v[j].w); }
    const float rstd = 1.0f / sqrtf(wave_sum(s2) * (1.0f / 1024.0f) + LN_EPS);
#pragma unroll
    for (int j = 0; j < 4; ++j) {
        const float4 gg = ((const float4*)g)[j * 64 + lane], b4 = ((const float4*)bb)[j * 64 + lane];
        float4 o; o.x = v[j].x * rstd * gg.x + b4.x; o.y = v[j].y * rstd * gg.y + b4.y; o.z = v[j].z * rstd * gg.z + b4.z; o.w = v[j].w * rstd * gg.w + b4.w;
        ((float4*)orow)[j * 64 + lane] = o;
        ((uint2*)obrow)[j * 64 + lane] = make_uint2(pk2(o.x, o.y), pk2(o.z, o.w));
    }
}
__device__ void ln1_phase(int WV_, const float* hin, const float* add, const float* g, const float* bb, float* hout, bf16* hb) {
    const int lane = LTID(WV_) & 63, wave = LTID(WV_) >> 6;
    for (int row = LBID() * NWAVE + wave; row < T_; row += LGRID() * NWAVE) {
        float4 v[4];
#pragma unroll
        for (int j = 0; j < 4; ++j) {
            const float4 a = ((const float4*)(hin + (size_t)row * 1024))[j * 64 + lane], m = ((const float4*)(add + (size_t)row * 1024))[j * 64 + lane];
            v[j].x = ALPHA * a.x + m.x; v[j].y = ALPHA * a.y + m.y; v[j].z = ALPHA * a.z + m.z; v[j].w = ALPHA * a.w + m.w;
        }
        ln_row(v, g, bb, hout + (size_t)row * 1024, hb + (size_t)row * 1024, lane);
    }
}


typedef short bf16x8_t __attribute__((ext_vector_type(8)));
typedef float f32x16_t __attribute__((ext_vector_type(16)));
typedef float f32x2_t __attribute__((ext_vector_type(2)));
typedef __bf16 bf16x2_t __attribute__((ext_vector_type(2)));
__device__ __forceinline__ unsigned cvtpk(float lo, float hi) { f32x2_t v = {lo, hi}; bf16x2_t b = __builtin_convertvector(v, bf16x2_t); return __builtin_bit_cast(unsigned, b); }
__device__ __forceinline__ int crow(int r, int hi) { return (r & 3) + 8 * (r >> 2) + 4 * hi; }
__device__ __forceinline__ float xlane32(float v) { return __shfl_xor(v, 32); }

constexpr int AT_KP = 72, AT_VP = 68;
constexpr int AT_KS = 0, AT_KS_BYTES = 64 * AT_KP * 2;
constexpr int AT_VT = 2 * AT_KS_BYTES, AT_VT_BYTES = 64 * AT_VP * 2;
constexpr int AT_KM = AT_VT + 2 * AT_VT_BYTES;
constexpr int AT_MISC = AT_KM + 32 * AT_KP * 2;
constexpr float LOG2E = 1.4426950408889634f;

__device__ __forceinline__ unsigned mk_unit(int kind, int b, int x, int y) { return ((unsigned)kind << 30) | ((unsigned)b << 28) | ((unsigned)x << 8) | (unsigned)y; }
__device__ void build_unit_table(unsigned* tab, int i) {
    int n = 0; unsigned res = 0u;
#pragma unroll 1
    for (int c = 64; c >= 1; --c) {
        if (i >= n && i < n + 4) res = mk_unit(0, i - n, 0, c - 1);
        n += 4;
        if ((c & 3) == 0) { if (i >= n && i < n + 16) { const int j = i - n; res = mk_unit(2, j >> 2, j & 3, c / 4 - 1); } n += 16; }
    }
    if (i < 512) tab[i] = res;
}

template <int kind> __device__ __forceinline__ void attn_unit(int WV_, const bf16* P, const unsigned char* mask, const float* kmean, const float* sinks, bf16* ys,
                                unsigned char* lds, int b, int ux, int uy) {
    int tid_ = LTID(WV_); asm volatile("" : "+v"(tid_));
    const int tid = tid_, lane = tid & 63, wave = __builtin_amdgcn_readfirstlane(tid >> 6), r32 = lane & 31, hi = lane >> 5;
    bf16* s_km = (bf16*)(lds + AT_KM);
    const int skey = tid >> 3, sc = tid & 7;
    {
        const bf16* Pb = P + (size_t)b * S_ * NP;
        int q0w, qcol, kcol, vcol, ycol, kt_hi, kt_lo; float slope2 = 0.f, sink2 = 0.f;
        if (kind == 0) { const int head = wave >> 1; q0w = uy * 64 + (wave & 1) * 32; qcol = C_QA + head * 64; kcol = C_KA; vcol = C_VA; ycol = head * 64;
            slope2 = exp2f(-8.0f * (float)(3 * head + 1) / 12.0f) * LOG2E; kt_hi = uy; kt_lo = 0; }
        else if (kind == 1) { const int hq = ux * 2 + (wave >> 2); q0w = uy * 128 + (wave & 3) * 32; qcol = C_QB + hq * 64; kcol = C_KB + ux * 64; vcol = C_VB + ux * 64; ycol = 256 + hq * 64;
            slope2 = exp2f(-8.0f * (float)(3 * hq + 2) / 12.0f) * LOG2E; sink2 = sinks[hq] * LOG2E; kt_hi = 2 * uy + 1; kt_lo = (2 * uy - 2 > 0) ? 2 * uy - 2 : 0; }
        else if (kind == 2) { q0w = uy * 256 + wave * 32; qcol = C_QC + ux * 64; kcol = C_KC + ux * 64; vcol = C_VC + ux * 64; ycol = 512 + ux * 64;
            slope2 = exp2f(-8.0f * (float)(3 * ux + 3) / 12.0f) * LOG2E; kt_hi = 4 * uy + 3; kt_lo = 0; }
        else { q0w = uy * 256 + wave * 32; qcol = C_QD + ux * 64; kcol = C_KD + ux * 64; vcol = C_VD + ux * 64; ycol = 768 + ux * 64; kt_hi = 4 * uy + 3; kt_lo = 0; }
        const int qpos = q0w + r32;
        bf16x8_t qf[4];
        { const bf16* qp = Pb + (size_t)qpos * NP + qcol + 8 * hi;
#pragma unroll
          for (int ks = 0; ks < 4; ++ks) qf[ks] = *(const bf16x8_t*)(qp + 16 * ks); }
        {
            const float qs = (kind == 3) ? 0.125f : 0.125f * LOG2E;
            typedef unsigned u32x4_t __attribute__((ext_vector_type(4)));
#pragma unroll
            for (int ks = 0; ks < 4; ++ks) { u32x4_t w = __builtin_bit_cast(u32x4_t, qf[ks]);
#pragma unroll
                for (int i = 0; i < 4; ++i) w[i] = cvtpk(__uint_as_float(w[i] << 16) * qs, __uint_as_float(w[i] & 0xffff0000u) * qs);
                qf[ks] = __builtin_bit_cast(bf16x8_t, w); }
        }
        float sb[16];
#pragma unroll
        for (int r = 0; r < 16; ++r) sb[r] = slope2 * (float)((r & 3) + 8 * (r >> 2));
        unsigned bm = 0u;
        if (kind == 2) {
            const int own = uy;
            for (int e = tid; e < 32 * 64; e += NTHR) { const int row = e >> 6, d = e & 63; s_km[row * AT_KP + d] = (row < 16) ? (bf16)f2bf(kmean[((b * 4 + ux) * 16 + row) * 64 + d]) : (bf16)0; }
            __syncthreads();
            f32x16_t gacc;
#pragma unroll
            for (int r = 0; r < 16; ++r) gacc[r] = 0.f;
#pragma unroll
            for (int ks = 0; ks < 4; ++ks) { const bf16x8_t a = *(const bf16x8_t*)(s_km + r32 * AT_KP + 16 * ks + 8 * hi); gacc = __builtin_amdgcn_mfma_f32_32x32x16_bf16(a, qf[ks], gacc, 0, 0, 0); }
            float gt[16];
#pragma unroll
            for (int r = 0; r < 8; ++r) { const float mine = gacc[r], other = xlane32(mine); const int bi = crow(r, 0);
                gt[bi] = hi ? other : mine; gt[bi + 4] = hi ? mine : other; }
#pragma unroll
            for (int n = 0; n < 16; ++n) if (n >= own) gt[n] = -INFINITY;
#pragma unroll
            for (int rep = 0; rep < 3; ++rep) {
                float mx = -INFINITY;
#pragma unroll
                for (int n = 0; n < 16; ++n) mx = fmaxf(mx, gt[n]);
                bool done = !(mx > -INFINITY);
#pragma unroll
                for (int n = 0; n < 16; ++n) { const bool hit = !done && gt[n] == mx; if (hit) { bm |= 1u << n; gt[n] = -INFINITY; done = true; } }
            }
        }
        f32x16_t o0, o1;
#pragma unroll
        for (int r = 0; r < 16; ++r) { o0[r] = 0.f; o1[r] = 0.f; }
        float m_run = -INFINITY, l_run = 0.f, carry = 0.f;
        const bf16* kg = Pb + (size_t)skey * NP + kcol + sc * 8;
        const bf16* vg = Pb + (size_t)skey * NP + vcol + sc * 8;
        uint4 rk = *(const uint4*)(kg + (size_t)kt_hi * 64 * NP), rv = *(const uint4*)(vg + (size_t)kt_hi * 64 * NP);
        int buf = 0;
        { bf16* ks_ = (bf16*)(lds + AT_KS); bf16* vt_ = (bf16*)(lds + AT_VT);
          *(uint4*)(ks_ + skey * AT_KP + sc * 8) = rk;
          const unsigned vw[4] = {rv.x, rv.y, rv.z, rv.w};
#pragma unroll
          for (int j = 0; j < 4; ++j) { vt_[(sc * 8 + 2 * j) * AT_VP + skey] = (bf16)(vw[j] & 0xffffu); vt_[(sc * 8 + 2 * j + 1) * AT_VP + skey] = (bf16)(vw[j] >> 16); } }
        __syncthreads();
        bool wave_done = false;
        uint2 mw_next = make_uint2(0u, 0u);
        if (kind == 0) mw_next = *(const uint2*)(mask + (size_t)(b * S_ + qpos) * 512 + kt_hi * 8);
        for (int kt = kt_hi; kt >= kt_lo; --kt) {
            const bool more = kt > kt_lo;
            const uint2 mw = mw_next;
            if (kind == 0 && more) mw_next = *(const uint2*)(mask + (size_t)(b * S_ + qpos) * 512 + (kt - 1) * 8);
            if (more) { rk = *(const uint4*)(kg + (size_t)(kt - 1) * 64 * NP); rv = *(const uint4*)(vg + (size_t)(kt - 1) * 64 * NP); }
            const bf16* ks_ = (const bf16*)(lds + AT_KS + buf * AT_KS_BYTES);
            const bf16* vt_ = (const bf16*)(lds + AT_VT + buf * AT_VT_BYTES);
            bool active = (kt * 64 <= q0w + 31) && !wave_done;
            if (kind == 1) active = active && (kt * 64 + 63 >= q0w - 127);
            if (active) {
                const int kbase = kt * 64 + 4 * hi;
                f32x16_t p0, p1;
                if (kind != 3) {
                    const float cb = slope2 * (float)(kbase - qpos), cb1 = cb + 32.0f * slope2;
#pragma unroll
                    for (int r = 0; r < 16; ++r) { p0[r] = cb + sb[r]; p1[r] = cb1 + sb[r]; }
                } else {
#pragma unroll
                    for (int r = 0; r < 16; ++r) { p0[r] = 0.f; p1[r] = 0.f; }
                }
#pragma unroll
                for (int ks = 0; ks < 4; ++ks) {
                    const bf16x8_t a0 = *(const bf16x8_t*)(ks_ + r32 * AT_KP + 16 * ks + 8 * hi);
                    const bf16x8_t a1 = *(const bf16x8_t*)(ks_ + (32 + r32) * AT_KP + 16 * ks + 8 * hi);
                    p0 = __builtin_amdgcn_mfma_f32_32x32x16_bf16(a0, qf[ks], p0, 0, 0, 0);
                    p1 = __builtin_amdgcn_mfma_f32_32x32x16_bf16(a1, qf[ks], p1, 0, 0, 0);
                }
                if (kind != 3) {
                    float mx = -INFINITY;
                    if (kind == 0) {
                        const unsigned w0 = mw.x >> (4 * hi), w1 = mw.y >> (4 * hi);
#pragma unroll
                        for (int r = 0; r < 16; ++r) { const int off = (r & 3) + 8 * (r >> 2);
                            p0[r] = (w0 & (1u << off)) ? p0[r] : -INFINITY; p1[r] = (w1 & (1u << off)) ? p1[r] : -INFINITY; mx = fmaxf(mx, fmaxf(p0[r], p1[r])); }
                    } else if (kind == 1) {
                        const int rel = qpos - kbase;
#pragma unroll
                        for (int r = 0; r < 16; ++r) { const int off = (r & 3) + 8 * (r >> 2);
                            p0[r] = ((unsigned)(rel - off) < 128u) ? p0[r] : -INFINITY; p1[r] = ((unsigned)(rel - off - 32) < 128u) ? p1[r] : -INFINITY; mx = fmaxf(mx, fmaxf(p0[r], p1[r])); }
                    } else {
                        if ((kt >> 2) == uy) {
                            const int rel = qpos - kbase;
#pragma unroll
                            for (int r = 0; r < 16; ++r) { const int off = (r & 3) + 8 * (r >> 2);
                                p0[r] = (off <= rel) ? p0[r] : -INFINITY; p1[r] = (off + 32 <= rel) ? p1[r] : -INFINITY; mx = fmaxf(mx, fmaxf(p0[r], p1[r])); }
                        } else {
                            const bool tile_ok = ((bm >> (kt >> 2)) & 1u) != 0u;
#pragma unroll
                            for (int r = 0; r < 16; ++r) { p0[r] = tile_ok ? p0[r] : -INFINITY; p1[r] = tile_ok ? p1[r] : -INFINITY; mx = fmaxf(mx, fmaxf(p0[r], p1[r])); }
                        }
                    }
                    mx = fmaxf(mx, xlane32(mx));
                    const float m_new = fmaxf(m_run, mx);
                    const float m_safe = (m_new == -INFINITY) ? 0.f : m_new;
                    p0 = p0 - m_safe; p1 = p1 - m_safe;
#pragma unroll
                    for (int r = 0; r < 16; ++r) { p0[r] = __builtin_amdgcn_exp2f(p0[r]); p1[r] = __builtin_amdgcn_exp2f(p1[r]); }
                    float ls;
                    { typedef float f32x8_t __attribute__((ext_vector_type(8))); typedef float f32x4v_t __attribute__((ext_vector_type(4)));
                      const f32x16_t t16 = p0 + p1; const f32x8_t t8 = t16.lo + t16.hi; const f32x4v_t t4 = t8.lo + t8.hi; const f32x2_t t2 = t4.lo + t4.hi; ls = t2.x + t2.y; }
                    if (__any(m_new > m_run)) {
                        const float alpha = __builtin_amdgcn_exp2f(m_run - m_safe);
                        l_run *= alpha;
                        o0 = o0 * alpha; o1 = o1 * alpha;
                    }
                    l_run += ls; m_run = m_new;
                } else {
                    float run = carry;
#define SB_HALF(PX, KOFF) do { \
                    float lk[16]; \
                    _Pragma("unroll") for (int r = 0; r < 16; ++r) { \
                        const int off = (r & 3) + 8 * (r >> 2); \
                        const bool v = (kbase + off + (KOFF)) < qpos; \
                        const float z = PX[r]; \
                        const float t = 0.6931471805599453f * __builtin_amdgcn_logf(1.0f + __builtin_amdgcn_exp2f(-LOG2E * fabsf(z))); \
                        lk[r] = v ? (fminf(-z, 0.f) - t) : 0.f; \
                        PX[r] = v ? (fminf(z, 0.f) - t) : -INFINITY; } \
                    _Pragma("unroll") for (int g = 3; g >= 0; --g) { \
                        const float G = (lk[4 * g] + lk[4 * g + 1]) + (lk[4 * g + 2] + lk[4 * g + 3]); \
                        const float PG = xlane32(G); \
                        float la = run + (hi ? 0.f : PG); \
                        run += G + PG; \
                        PX[4 * g + 3] += la; la += lk[4 * g + 3]; PX[4 * g + 2] += la; la += lk[4 * g + 2]; PX[4 * g + 1] += la; la += lk[4 * g + 1]; PX[4 * g] += la; } \
                    _Pragma("unroll") for (int r = 0; r < 16; ++r) PX[r] = __builtin_amdgcn_exp2f(LOG2E * PX[r]); } while (0)
                    SB_HALF(p1, 32);
                    SB_HALF(p0, 0);
#undef SB_HALF
                    carry = run;
                }
                unsigned pw[16];
#pragma unroll
                for (int j = 0; j < 8; ++j) { pw[j] = cvtpk(p0[2 * j], p0[2 * j + 1]); pw[8 + j] = cvtpk(p1[2 * j], p1[2 * j + 1]); }
#pragma unroll
                for (int s = 0; s < 4; ++s) {
                    bf16x8_t pb; { const unsigned* q = pw + 4 * s; typedef unsigned u32x4_t __attribute__((ext_vector_type(4))); u32x4_t t4 = {q[0], q[1], q[2], q[3]}; pb = __builtin_bit_cast(bf16x8_t, t4); }
#pragma unroll
                    for (int dt = 0; dt < 2; ++dt) {
                        const bf16* vp = vt_ + (32 * dt + r32) * AT_VP + 16 * s + 4 * hi;
                        typedef short s16x4_t __attribute__((ext_vector_type(4)));
                        const s16x4_t lo = *(const s16x4_t*)vp, hi4 = *(const s16x4_t*)(vp + 8);
                        const bf16x8_t va = {lo[0], lo[1], lo[2], lo[3], hi4[0], hi4[1], hi4[2], hi4[3]};
                        if (dt == 0) o0 = __builtin_amdgcn_mfma_f32_32x32x16_bf16(va, pb, o0, 0, 0, 0);
                        else         o1 = __builtin_amdgcn_mfma_f32_32x32x16_bf16(va, pb, o1, 0, 0, 0);
                    }
                }
            }
            if (kind == 3) {
                const float cm = carry;
                if (__all(cm < -110.0f) || !(kt * 64 <= q0w + 31) ) { if (__all(cm < -110.0f)) wave_done = true; }
            }
            if (more) {
                bf16* ksn = (bf16*)(lds + AT_KS + (buf ^ 1) * AT_KS_BYTES); bf16* vtn = (bf16*)(lds + AT_VT + (buf ^ 1) * AT_VT_BYTES);
                *(uint4*)(ksn + skey * AT_KP + sc * 8) = rk;
                const unsigned vw[4] = {rv.x, rv.y, rv.z, rv.w};
#pragma unroll
                for (int j = 0; j < 4; ++j) { vtn[(sc * 8 + 2 * j) * AT_VP + skey] = (bf16)(vw[j] & 0xffffu); vtn[(sc * 8 + 2 * j + 1) * AT_VP + skey] = (bf16)(vw[j] >> 16); }
            }
            if (kind == 3) { if (__syncthreads_and(wave_done ? 1 : 0)) break; }
            else __syncthreads();
            buf ^= 1;
        }
        float inv;
        if (kind == 3) inv = 1.0f;
        else {
            float lt = l_run + xlane32(l_run);
            if (kind == 1) { const float mf = fmaxf(m_run, sink2); const float sc2 = exp2f(m_run - mf); lt = lt * sc2 + exp2f(sink2 - mf); inv = sc2 / lt; }
            else inv = 1.0f / lt;
        }
        bf16* yp = ys + (size_t)(b * S_ + qpos) * 1024 + ycol + 4 * hi;
#pragma unroll
        for (int g = 0; g < 4; ++g) {
            *(uint2*)(yp + 8 * g) = make_uint2(cvtpk(o0[4 * g] * inv, o0[4 * g + 1] * inv), cvtpk(o0[4 * g + 2] * inv, o0[4 * g + 3] * inv));
            *(uint2*)(yp + 32 + 8 * g) = make_uint2(cvtpk(o1[4 * g] * inv, o1[4 * g + 1] * inv), cvtpk(o1[4 * g + 2] * inv, o1[4 * g + 3] * inv));
        }
    }
}
__device__ void attn_fast_phase(int WV_, const bf16* P, const unsigned char* mask, const float* kmean, const float* sinks, bf16* ys,
                                const unsigned* utab, unsigned* counter, unsigned char* lds) {
    volatile unsigned* s_unit = (volatile unsigned*)(lds + AT_MISC);
    for (;;) {
        __syncthreads();
        if (LTID(WV_) == 0) s_unit[0] = atomicAdd(counter, 1u);
        __syncthreads();
        const unsigned ui = s_unit[0];
        if (ui >= 512u) break;
        const unsigned ue = utab[ui];
        const int kind = (int)(ue >> 30), b = (int)((ue >> 28) & 3u), ux = (int)((ue >> 8) & 255u), uy = (int)(ue & 255u);
        if (kind == 0) attn_unit<0>(WV_, P, mask, kmean, sinks, ys, lds, b, ux, uy);
        else attn_unit<2>(WV_, P, mask, kmean, sinks, ys, lds, b, ux, uy);
    }
    for (int u = LBID(); u < 256; u += LGRID()) { __syncthreads(); attn_unit<3>(WV_, P, mask, kmean, sinks, ys, lds, u >> 6, (u >> 4) & 3, u & 15); }
    for (int u = LBID(); u < 256; u += LGRID()) { __syncthreads(); attn_unit<1>(WV_, P, mask, kmean, sinks, ys, lds, u >> 6, (u >> 5) & 1, u & 31); }
}

constexpr float U_SCALE = 64.0f, V_SCALE = 16.0f;
__device__ __forceinline__ float rdlane_f(float v, int l) { return __builtin_bit_cast(float, __builtin_amdgcn_readlane(__builtin_bit_cast(int, v), l)); }
__device__ __forceinline__ unsigned pk4_fp8(float a, float b, float c, float d) { int v = 0; v = __builtin_amdgcn_cvt_pk_fp8_f32(a, b, v, false); v = __builtin_amdgcn_cvt_pk_fp8_f32(c, d, v, true); return (unsigned)v; }
__device__ __forceinline__ void unpack16_fp8(const uint4 v, float* o) {
    const unsigned w[4] = {v.x, v.y, v.z, v.w};
#pragma unroll
    for (int i = 0; i < 4; ++i) { const f32x2_t lo = __builtin_amdgcn_cvt_pk_f32_fp8((int)w[i], false), hi2 = __builtin_amdgcn_cvt_pk_f32_fp8((int)w[i], true);
        o[4 * i] = lo.x; o[4 * i + 1] = lo.y; o[4 * i + 2] = hi2.x; o[4 * i + 3] = hi2.y; }
}
__device__ void convert_tables(int WV_, const Params& p) {
    const size_t nchunk = (size_t)DEPTH_ * 16384 * 2 * 64;
    for (size_t i = (size_t)LBID() * NTHR + LTID(WV_); i < nchunk; i += (size_t)LGRID() * NTHR) {
        const int c = (int)(i & 63), uvsel = (int)((i >> 6) & 1); const size_t le = i >> 7;
        const float* src = (uvsel ? p.in[10] : p.in[9]) + le * 1024 + c * 16;
        const float sc = uvsel ? V_SCALE : U_SCALE;
        const float4 a = ((const float4*)src)[0], b = ((const float4*)src)[1], cc = ((const float4*)src)[2], d = ((const float4*)src)[3];
        *(uint4*)(p.ws + WS_UV + le * 2048 + uvsel * 1024 + c * 16) = make_uint4(pk4_fp8(a.x * sc, a.y * sc, a.z * sc, a.w * sc), pk4_fp8(b.x * sc, b.y * sc, b.z * sc, b.w * sc),
                                                                               pk4_fp8(cc.x * sc, cc.y * sc, cc.z * sc, cc.w * sc), pk4_fp8(d.x * sc, d.y * sc, d.z * sc, d.w * sc));
    }
}
__device__ void peer_fast_phase(int WV_, float* h, bf16* hb, const int* eid, const float* gate, const unsigned char* uv, const float* g1, const float* b1, const float* g, const float* bb, unsigned char* lds) {
    const int tid = LTID(WV_), lane = tid & 63, wave = tid >> 6;
    for (int t = LBID() * NWAVE + wave; t < T_; t += LGRID() * NWAVE) {
        float* hr = h + (size_t)t * 1024 + lane * 16;
        float x[16], acc[16];
        { const float4 a0 = ((const float4*)hr)[0], a1 = ((const float4*)hr)[1], a2 = ((const float4*)hr)[2], a3 = ((const float4*)hr)[3];
          x[0] = a0.x; x[1] = a0.y; x[2] = a0.z; x[3] = a0.w; x[4] = a1.x; x[5] = a1.y; x[6] = a1.z; x[7] = a1.w;
          x[8] = a2.x; x[9] = a2.y; x[10] = a2.z; x[11] = a2.w; x[12] = a3.x; x[13] = a3.y; x[14] = a3.z; x[15] = a3.w; }
        {
            float s = 0.f;
#pragma unroll
            for (int i = 0; i < 16; ++i) s += x[i];
            const float mean = wave_sum(s) * (1.0f / 1024.0f);
            float s2 = 0.f;
#pragma unroll
            for (int i = 0; i < 16; ++i) { x[i] -= mean; s2 += x[i] * x[i]; }
            const float rstd = 1.0f / sqrtf(wave_sum(s2) * (1.0f / 1024.0f) + LN_EPS);
#pragma unroll
            for (int q4 = 0; q4 < 4; ++q4) { const float4 gg = ((const float4*)(g1 + lane * 16))[q4], cc = ((const float4*)(b1 + lane * 16))[q4];
                x[4 * q4] = x[4 * q4] * rstd * gg.x + cc.x; x[4 * q4 + 1] = x[4 * q4 + 1] * rstd * gg.y + cc.y; x[4 * q4 + 2] = x[4 * q4 + 2] * rstd * gg.z + cc.z; x[4 * q4 + 3] = x[4 * q4 + 3] * rstd * gg.w + cc.w; }
        }
#pragma unroll
        for (int i = 0; i < 16; ++i) acc[i] = 0.f;
#pragma unroll 1
        for (int batch = 0; batch < 4; ++batch) {
            const int my_eid = eid[(size_t)t * 128 + batch * 32 + (lane & 31)];
            const float my_gate = gate[(size_t)t * 128 + batch * 32 + (lane & 31)];
            float* pl = (float*)lds + wave * 2048;
#pragma unroll 1
            for (int grp = 0; grp < 4; ++grp) {
                uint4 ua[8];
#pragma unroll
                for (int i = 0; i < 8; ++i) { const int id = __shfl(my_eid, grp * 8 + i); ua[i] = *(const uint4*)(uv + (size_t)id * 2048 + lane * 16); }
#pragma unroll
                for (int i = 0; i < 8; ++i) {
                    float f[16]; unpack16_fp8(ua[i], f);
                    float d0 = 0.f, d1 = 0.f;
#pragma unroll
                    for (int j = 0; j < 8; ++j) { d0 += f[j] * x[j]; d1 += f[8 + j] * x[8 + j]; }
                    pl[(grp * 8 + i) * 64 + lane] = d0 + d1;
                }
            }
            float d;
            { const float4* pr = (const float4*)(pl + (lane & 31) * 64); float4 s4 = pr[0];
#pragma unroll
              for (int i = 1; i < 16; ++i) { const float4 v = pr[i]; s4.x += v.x; s4.y += v.y; s4.z += v.z; s4.w += v.w; }
              d = ((s4.x + s4.y) + (s4.z + s4.w)) * (1.0f / U_SCALE); }
            const float hv = 0.5f * d * (1.0f + erff(d * 0.70710678118654752f)) * my_gate * (1.0f / V_SCALE);
#pragma unroll 1
            for (int grp = 0; grp < 4; ++grp) {
                uint4 va[8];
#pragma unroll
                for (int i = 0; i < 8; ++i) { const int id = __shfl(my_eid, grp * 8 + i); va[i] = *(const uint4*)(uv + (size_t)id * 2048 + 1024 + lane * 16); }
#pragma unroll
                for (int i = 0; i < 8; ++i) {
                    const float c = __shfl(hv, grp * 8 + i);
                    float f[16]; unpack16_fp8(va[i], f);
#pragma unroll
                    for (int j = 0; j < 16; ++j) acc[j] += c * f[j];
                }
            }
        }
        float y[16], s = 0.f;
#pragma unroll
        for (int i = 0; i < 16; ++i) { y[i] = ALPHA * x[i] + acc[i]; s += y[i]; }
        const float mean = wave_sum(s) * (1.0f / 1024.0f);
        float s2 = 0.f;
#pragma unroll
        for (int i = 0; i < 16; ++i) { y[i] -= mean; s2 += y[i] * y[i]; }
        const float rstd = 1.0f / sqrtf(wave_sum(s2) * (1.0f / 1024.0f) + LN_EPS);
        float o[16];
#pragma unroll
        for (int q4 = 0; q4 < 4; ++q4) {
            const float4 gg = ((const float4*)(g + lane * 16))[q4], cc = ((const float4*)(bb + lane * 16))[q4];
            o[4 * q4] = y[4 * q4] * rstd * gg.x + cc.x; o[4 * q4 + 1] = y[4 * q4 + 1] * rstd * gg.y + cc.y; o[4 * q4 + 2] = y[4 * q4 + 2] * rstd * gg.z + cc.z; o[4 * q4 + 3] = y[4 * q4 + 3] * rstd * gg.w + cc.w;
            ((float4*)hr)[q4] = make_float4(o[4 * q4], o[4 * q4 + 1], o[4 * q4 + 2], o[4 * q4 + 3]);
        }
        uint4* hbp = (uint4*)(hb + (size_t)t * 1024 + lane * 16);
        hbp[0] = make_uint4(pk2(o[0], o[1]), pk2(o[2], o[3]), pk2(o[4], o[5]), pk2(o[6], o[7]));
        hbp[1] = make_uint4(pk2(o[8], o[9]), pk2(o[10], o[11]), pk2(o[12], o[13]), pk2(o[14], o[15]));
    }
}


__device__ __forceinline__ float pack_pl(float v, unsigned pl) { return __uint_as_float((__float_as_uint(v) & ~127u) | pl); }
__device__ __forceinline__ void ins16(float (&s)[16], float x) {
#pragma unroll
    for (int k = 15; k >= 1; --k) s[k] = __builtin_amdgcn_fmed3f(s[k - 1], x, s[k]);
    s[0] = fmaxf(s[0], x);
}
template <int D> __device__ __forceinline__ void bitonic_stage(float (&c)[16]) {
#pragma unroll
    for (int i = 0; i < 16; ++i) if ((i & D) == 0) { const float a = fmaxf(c[i], c[i + D]), b = fminf(c[i], c[i + D]); c[i] = a; c[i + D] = b; }
}
__device__ __forceinline__ int decode_key(unsigned pl) { return (int)(32u * ((pl >> 4) & 3u) + (pl & 3u) + 8u * ((pl >> 2) & 3u) + 4u * ((pl >> 6) & 1u)); }
__device__ void route_fast_phase(int WV_, const bf16* qb, const bf16* skb  , int* eid, float* gate, unsigned char* lds) {
    const int tid = LTID(WV_), lane = tid & 63, wave = tid >> 6, r32 = lane & 31, hi = lane >> 5;
    unsigned* lidx = (unsigned*)lds + wave * (64 * 33) + lane * 33;
    for (int unit = LBID() * NWAVE + wave; unit < (T_ / 32) * 8; unit += LGRID() * NWAVE) {
        const int h = unit & 7, t = (unit >> 3) * 32 + r32;
        float sl[2][16];
#pragma unroll
        for (int p = 0; p < 2; ++p) {
            bf16x8_t qf[4];
            { const bf16* qp = qb + (size_t)t * 1024 + h * 128 + p * 64 + 8 * hi;
#pragma unroll
              for (int ks = 0; ks < 4; ++ks) qf[ks] = *(const bf16x8_t*)(qp + 16 * ks); }
            float s[16];
#pragma unroll
            for (int k = 0; k < 16; ++k) s[k] = -INFINITY;
            const bf16* skp = skb + ((size_t)(h * 2 + p) * 128 + r32) * 64 + 8 * hi;
#pragma unroll
            for (int kt = 0; kt < 4; ++kt) {
                f32x16_t acc;
#pragma unroll
                for (int r = 0; r < 16; ++r) acc[r] = 0.f;
#pragma unroll
                for (int ks = 0; ks < 4; ++ks) { const bf16x8_t a = *(const bf16x8_t*)(skp + (size_t)kt * 32 * 64 + 16 * ks); acc = __builtin_amdgcn_mfma_f32_32x32x16_bf16(a, qf[ks], acc, 0, 0, 0); }
#pragma unroll
                for (int r = 0; r < 16; ++r) ins16(s, pack_pl(acc[r], (unsigned)(kt * 16 + r)));
            }
            const unsigned hb = (unsigned)hi << 6;
#pragma unroll
            for (int k = 0; k < 16; ++k) s[k] = __uint_as_float(__float_as_uint(s[k]) | hb);
            float c[16];
#pragma unroll
            for (int k = 0; k < 16; ++k) c[k] = fmaxf(s[k], __shfl_xor(s[15 - k], 32));
            bitonic_stage<8>(c); bitonic_stage<4>(c); bitonic_stage<2>(c); bitonic_stage<1>(c);
#pragma unroll
            for (int k = 0; k < 16; ++k) { sl[p][k] = c[k]; lidx[p * 16 + k] = (unsigned)decode_key(__float_as_uint(c[k]) & 127u); }
        }
        float w[16];
#pragma unroll
        for (int k = 0; k < 16; ++k) w[k] = -INFINITY;
#pragma unroll
        for (int i = 0; i < 16; ++i)
#pragma unroll
            for (int j = 0; j < 16; ++j)
                if ((i + 1) * (j + 1) <= 16) { const float v = sl[0][i] + sl[1][j]; ins16(w, __uint_as_float((__float_as_uint(v) & ~255u) | (unsigned)(i * 16 + j))); }
        float e[16], sum = 0.f;
#pragma unroll
        for (int k = 0; k < 16; ++k) { e[k] = expf(w[k] - w[0]); sum += e[k]; }
        const float inv = 1.0f / sum;
        int ide[8]; float gte[8];
#pragma unroll
        for (int k = 0; k < 8; ++k) {
            float wa = w[k], wb = w[8 + k], ea = e[k], eb = e[8 + k];
            asm volatile("" : "+v"(wa), "+v"(wb), "+v"(ea), "+v"(eb));
            const float wv = hi ? wb : wa;
            const unsigned pl = __float_as_uint(wv) & 255u;
            ide[k] = (int)(lidx[pl >> 4] * 128u + lidx[16 + (pl & 15u)]);
            gte[k] = (hi ? eb : ea) * inv;
        }
        int* ep = eid + (size_t)t * 128 + h * 16 + hi * 8; float* gp = gate + (size_t)t * 128 + h * 16 + hi * 8;
        *(int4*)ep = make_int4(ide[0], ide[1], ide[2], ide[3]); *(int4*)(ep + 4) = make_int4(ide[4], ide[5], ide[6], ide[7]);
        *(float4*)gp = make_float4(gte[0], gte[1], gte[2], gte[3]); *(float4*)(gp + 4) = make_float4(gte[4], gte[5], gte[6], gte[7]);
    }
}

typedef float f32x4_t __attribute__((ext_vector_type(4)));
typedef __bf16 bf16x2v __attribute__((ext_vector_type(2)));
__device__ __forceinline__ float dot2bf(unsigned a, unsigned b, float c) { return __builtin_amdgcn_fdot2_f32_bf16(__builtin_bit_cast(bf16x2v, a), __builtin_bit_cast(bf16x2v, b), c, false); }
__device__ __forceinline__ void cnt_gt(int& cnt, unsigned a, unsigned b) { asm("v_cmp_gt_u32_e32 vcc, %1, %2\n\tv_addc_co_u32_e32 %0, vcc, 0, %0, vcc" : "+v"(cnt) : "v"(a), "v"(b) : "vcc"); }
__device__ __forceinline__ void cnt_eq(int& cnt, unsigned a, unsigned b) { asm("v_cmp_eq_u32_e32 vcc, %1, %2\n\tv_addc_co_u32_e32 %0, vcc, 0, %0, vcc" : "+v"(cnt) : "v"(a), "v"(b) : "vcc"); }
__device__ __forceinline__ unsigned flag_gt(unsigned a, unsigned b) { unsigned r; asm("v_cmp_gt_u32_e32 vcc, %1, %2\n\tv_cndmask_b32_e64 %0, 0, 1, vcc" : "=v"(r) : "v"(a), "v"(b) : "vcc"); return r; }
__device__ __forceinline__ unsigned flag_eq(unsigned a, unsigned b) { unsigned r; asm("v_cmp_eq_u32_e32 vcc, %1, %2\n\tv_cndmask_b32_e64 %0, 0, 1, vcc" : "=v"(r) : "v"(a), "v"(b) : "vcc"); return r; }
__device__ __forceinline__ void cnt_ge(int& cnt, unsigned key, unsigned cand) { asm("v_cmp_ge_u32_e32 vcc, %1, %2\n\tv_addc_co_u32_e32 %0, vcc, 0, %0, vcc" : "+v"(cnt) : "v"(key), "v"(cand) : "vcc"); }

typedef __attribute__((address_space(3))) unsigned lds_u32;
template <int SHIFT> __device__ __forceinline__ unsigned radix_pass(const unsigned (&key)[64], unsigned pre, lds_u32* hist, int lane, int& need) {
    typedef unsigned u32x4v __attribute__((ext_vector_type(4)));
    typedef __attribute__((address_space(3))) u32x4v lds_u32x4;
    { const u32x4v z4 = {0u, 0u, 0u, 0u};
#pragma unroll
      for (int i = 0; i < 8; ++i) ((lds_u32x4*)(hist + lane * 32))[i] = z4; }
    const unsigned cp = (unsigned)(lane & 7);
#pragma unroll
    for (int j = 0; j < 64; ++j) {
        const unsigned d = (key[j] >> SHIFT) & 255u;
        bool m;
        if (SHIFT == 24) m = key[j] != 0u; else m = (key[j] >> ((SHIFT + 8) & 31)) == pre;
        if (m) __hip_atomic_fetch_add(hist + ((d << 3) | cp), 1u, __ATOMIC_RELAXED, __HIP_MEMORY_SCOPE_WORKGROUP);
    }
    unsigned dsum[4]; unsigned sumL = 0u;
#pragma unroll
    for (int i = 0; i < 4; ++i) { const u32x4v v0 = ((const lds_u32x4*)(hist + lane * 32))[2 * i], v1 = ((const lds_u32x4*)(hist + lane * 32))[2 * i + 1];
        dsum[i] = ((v0.x + v0.y) + (v0.z + v0.w)) + ((v1.x + v1.y) + (v1.z + v1.w)); sumL += dsum[i]; }
    unsigned incl = sumL;
#pragma unroll
    for (int o = 1; o < 64; o <<= 1) { const unsigned t = (unsigned)__shfl_down((int)incl, o); if (lane + o < 64) incl += t; }
    const unsigned above = incl - sumL;
    const bool own = (above < (unsigned)need) && ((unsigned)need <= above + sumL);
    const int owner = __ffsll((long long)__ballot(own)) - 1;
    unsigned acc = above; int sel = -1; unsigned cab = 0u;
#pragma unroll
    for (int i = 3; i >= 0; --i) { const unsigned c = dsum[i]; const bool hit = (sel < 0) && (acc + c >= (unsigned)need); cab = hit ? acc : cab; sel = hit ? i : sel; acc += c; }
    const int ow = owner < 0 ? 0 : owner;
    const unsigned digit = (unsigned)__builtin_amdgcn_readlane(sel, ow) + (unsigned)(4 * ow);
    need -= (int)__builtin_amdgcn_readlane((int)cab, ow);
    return digit;
}
#ifndef TS_SEL
#define TS_SEL 0
#endif
#define ITS_B() do { if (TS_SEL >= 20 && TS_SEL <= 25 && WV_ == 0 && LANEID() == 0) ((volatile __attribute__((address_space(3))) unsigned long long*)((__attribute__((address_space(3))) unsigned char*)lds + 147456 - 16 - 32))[0] = __builtin_amdgcn_s_memrealtime(); } while (0)
#define ITS_E(k) do { if ((k) == TS_SEL && WV_ == 0 && LANEID() == 0) { volatile __attribute__((address_space(3))) unsigned long long* w_ = (volatile __attribute__((address_space(3))) unsigned long long*)((__attribute__((address_space(3))) unsigned char*)lds + 147456 - 16 - 32); w_[1] += __builtin_amdgcn_s_memrealtime() - w_[0]; } } while (0)
__device__ void index_fast_phase(int WV_, const bf16* P, unsigned char* mask, float* kmean, float* scratch_all, unsigned char* lds) {
    const int tid = LTID(WV_), lane = tid & 63, wave = tid >> 6, bid = LBID(), G = LGRID();
    float* s_part = (float*)lds;
    ITS_B();
    for (int k = bid; k < 256; k += G) {
        const int b = k >> 6, h = (k >> 4) & 3, blk = k & 15;
        const bf16* kp = P + (size_t)(b * S_ + blk * 256 + wave * 32) * NP + C_KC + h * 64 + lane;
        float a = 0.f;
#pragma unroll 8
        for (int j = 0; j < 32; ++j) a += bf2f(kp[(size_t)j * NP]);
        __syncthreads();
        s_part[wave * 64 + lane] = a;
        __syncthreads();
        if (tid < 64) { float s = 0.f;
#pragma unroll
            for (int w = 0; w < 8; ++w) s += s_part[w * 64 + tid];
            kmean[((b * 4 + h) * 16 + blk) * 64 + tid] = s * (1.0f / 256.0f); }
    }
    ITS_E(22);
    float* scr = scratch_all + (size_t)bid * (16 * 4096);
    const int lq = lane & 15, g4 = lane >> 4;
    for (int ui = bid; ui < 1024; ui += G) {
        const int b = ui >> 8, k = ui & 255, tile = (b & 1) ? 255 - k : k, q0 = tile * 16;
        const bf16* Pb = P + (size_t)b * S_ * NP;
        const int ntiles = tile + 1;
        ITS_B();
        bf16x8_t qf[8]; float wi[8];
        { const bf16* qp = Pb + (size_t)(q0 + lq) * NP + C_QI + 8 * g4;
#pragma unroll
          for (int h = 0; h < 8; ++h) qf[h] = *(const bf16x8_t*)(qp + 32 * h);
          const uint4 wv = *(const uint4*)(Pb + (size_t)(q0 + lq) * NP + C_WI); unpack8(wv, wi); }
        for (int kt = wave; kt < ntiles; kt += NWAVE) {
            const bf16x8_t af = *(const bf16x8_t*)(Pb + (size_t)(kt * 16 + lq) * NP + C_KI + 8 * g4);
            f32x4_t sc = {0.f, 0.f, 0.f, 0.f};
#pragma unroll
            for (int h = 0; h < 8; ++h) {
                const f32x4_t z = {0.f, 0.f, 0.f, 0.f};
                const f32x4_t a = __builtin_amdgcn_mfma_f32_16x16x32_bf16(af, qf[h], z, 0, 0, 0);
#pragma unroll
                for (int r = 0; r < 4; ++r) sc[r] += fmaxf(a[r], 0.f) * wi[h];
            }
#pragma unroll
            for (int r = 0; r < 4; ++r) { sc[r] *= 0.0625f; if (sc[r] == 0.f) sc[r] = 0.f; }
            *(f32x4_t*)(scr + (size_t)lq * 4096 + kt * 16 + 4 * g4) = sc;
        }
        __threadfence_block();
        __syncthreads();
        __threadfence_block();
        ITS_E(20); ITS_B();
        lds_u32* hist = (lds_u32*)((__attribute__((address_space(3))) unsigned char*)lds + 2048) + wave * 2048;
#pragma unroll 1
        for (int qi = 0; qi < 2; ++qi) {
            const int ql = 2 * wave + qi, q = q0 + ql;
            const float* row = scr + (size_t)ql * 4096 + lane * 64;
            const int qrel = q - lane * 64;
            unsigned key[64];
            if (qrel >= 0) {
#pragma unroll
                for (int j4 = 0; j4 < 16; ++j4) {
                    const float4 v = ((const float4*)row)[j4];
                    const unsigned u[4] = {__float_as_uint(v.x), __float_as_uint(v.y), __float_as_uint(v.z), __float_as_uint(v.w)};
#pragma unroll
                    for (int e = 0; e < 4; ++e) { const unsigned t = u[e] ^ ((unsigned)((int)u[e] >> 31) | 0x80000000u); const unsigned inval = (unsigned)((qrel - (j4 * 4 + e)) >> 31); key[j4 * 4 + e] = t & ~inval; }
                    if ((j4 & 3) == 3) asm volatile("" ::: "memory");
                }
            } else {
#pragma unroll
                for (int j = 0; j < 64; ++j) key[j] = 0u;
            }
            ITS_E(23); ITS_B();
            unsigned wlo = 0u, whi = 0u;
            if (q + 1 > 256) {
                int need = 256;
                const unsigned d1 = radix_pass<24>(key, 0u, hist, lane, need);
                const unsigned d2 = radix_pass<16>(key, d1, hist, lane, need);
                const unsigned d3 = radix_pass<8>(key, (d1 << 8) | d2, hist, lane, need);
                const unsigned d4 = radix_pass<0>(key, (d1 << 16) | (d2 << 8) | d3, hist, lane, need);
                const unsigned prefix = (d1 << 24) | (d2 << 16) | (d3 << 8) | d4;
                ITS_E(24); ITS_B();
                int ceq = 0;
#pragma unroll
                for (int j = 0; j < 64; ++j) cnt_eq(ceq, key[j], prefix);
                ceq = wave_sum_i(ceq);
                int X = 4096;
                if (ceq != need) {
                    int X0 = 0;
#pragma unroll 1
                    for (int bit = 11; bit >= 0; --bit) {
                        const int c = X0 | (1 << bit);
                        int cnt = 0; const int crel = c - lane * 64;
#pragma unroll
                        for (int j = 0; j < 64; ++j) cnt_eq(cnt, (key[j] ^ prefix) | ~(unsigned)((j - crel) >> 31), 0u);
                        cnt = wave_sum_i(cnt);
                        if (cnt < need) X0 = c;
                    }
                    X = X0 + 1;
                }
                const int xrel = X - lane * 64;
#pragma unroll
                for (int j = 0; j < 32; ++j) {
                    const unsigned s0 = flag_gt(key[j], prefix) | flag_eq((key[j] ^ prefix) | ~(unsigned)((j - xrel) >> 31), 0u);
                    const unsigned s1 = flag_gt(key[32 + j], prefix) | flag_eq((key[32 + j] ^ prefix) | ~(unsigned)((32 + j - xrel) >> 31), 0u);
                    wlo |= s0 << j; whi |= s1 << j;
                }
            } else {
#pragma unroll
                for (int j = 0; j < 32; ++j) { wlo |= (~(unsigned)((qrel - j) >> 31) & 1u) << j; whi |= (~(unsigned)((qrel - 32 - j) >> 31) & 1u) << j; }
            }
            ((uint2*)(mask + (size_t)(b * S_ + q) * 512))[lane] = make_uint2(wlo, whi);
            ITS_E(25); ITS_B();
        }
        ITS_E(21);
        __syncthreads();
    }
}

constexpr int MG_P = 72;
constexpr int MG_TILE_BYTES = 128 * MG_P * 2;
__device__ void merge_fast_phase(int WV_, const bf16* P, const bf16* ys, const bf16* wbt  , bf16* merged, unsigned char* lds) {
    const int tid = LTID(WV_), lane = tid & 63, wave = tid >> 6, r32 = lane & 31, hi = lane >> 5, wt = wave & 3, wd = wave >> 2;
    const int srow0 = tid >> 3, sch = tid & 7;
    for (int tile = LBID(); tile < 1024; tile += LGRID()) {
        const int tok0 = (tile >> 3) * 128, d0 = (tile & 7) * 128;
        f32x16_t mer[2], acc[2];
#pragma unroll
        for (int r = 0; r < 16; ++r) { mer[0][r] = 0.f; mer[1][r] = 0.f; acc[0][r] = 0.f; acc[1][r] = 0.f; }
        uint4 RW00, RW01, RW10, RW11, RY00, RY01, RY10, RY11, RG0, RG1, RG2, RG3;
        bf16* gl = (bf16*)(lds + 4 * MG_TILE_BYTES);
        const int grow = tid >> 4, gch = tid & 15;
#define MG_GLOAD(st_, R_) do { const int n_ = (st_) >> 2, kc_ = (st_) & 3; \
            RW##R_##0 = *(const uint4*)(wbt + ((size_t)n_ * 1024 + d0 + srow0) * 256 + kc_ * 64 + sch * 8); \
            RW##R_##1 = *(const uint4*)(wbt + ((size_t)n_ * 1024 + d0 + srow0 + 64) * 256 + kc_ * 64 + sch * 8); \
            RY##R_##0 = *(const uint4*)(ys + (size_t)(tok0 + srow0) * 1024 + n_ * 256 + kc_ * 64 + sch * 8); \
            RY##R_##1 = *(const uint4*)(ys + (size_t)(tok0 + srow0 + 64) * 1024 + n_ * 256 + kc_ * 64 + sch * 8); } while (0)
#define MG_SSTORE(buf_, R_) do { bf16* wl_ = (bf16*)(lds + (buf_) * 2 * MG_TILE_BYTES); bf16* yl_ = (bf16*)(lds + (buf_) * 2 * MG_TILE_BYTES + MG_TILE_BYTES); \
            *(uint4*)(wl_ + srow0 * MG_P + sch * 8) = RW##R_##0; *(uint4*)(wl_ + (srow0 + 64) * MG_P + sch * 8) = RW##R_##1; \
            *(uint4*)(yl_ + srow0 * MG_P + sch * 8) = RY##R_##0; *(uint4*)(yl_ + (srow0 + 64) * MG_P + sch * 8) = RY##R_##1; } while (0)
        __syncthreads();
        MG_GLOAD(0, 0); MG_GLOAD(1, 1);
        MG_SSTORE(0, 0);
        __syncthreads();
#define MG_STAGE(PAR_, OTH_) do { const int buf = PAR_; \
            if (st + 2 < 16) MG_GLOAD(st + 2, PAR_); \
            if ((st & 3) == 1) { const bf16* gsrc = P + (size_t)(tok0 + grow) * NP + C_G + (st >> 2) * 1024 + d0 + gch * 8; \
                RG0 = *(const uint4*)gsrc; RG1 = *(const uint4*)(gsrc + (size_t)32 * NP); RG2 = *(const uint4*)(gsrc + (size_t)64 * NP); RG3 = *(const uint4*)(gsrc + (size_t)96 * NP); } \
            const bf16* wl = (const bf16*)(lds + buf * 2 * MG_TILE_BYTES); const bf16* yl = (const bf16*)(lds + buf * 2 * MG_TILE_BYTES + MG_TILE_BYTES); \
            _Pragma("unroll") for (int ks = 0; ks < 4; ++ks) { \
                const bf16x8_t bq = *(const bf16x8_t*)(yl + (32 * wt + r32) * MG_P + 16 * ks + 8 * hi); \
                const bf16x8_t a0 = *(const bf16x8_t*)(wl + (64 * wd + r32) * MG_P + 16 * ks + 8 * hi); \
                const bf16x8_t a1 = *(const bf16x8_t*)(wl + (64 * wd + 32 + r32) * MG_P + 16 * ks + 8 * hi); \
                acc[0] = __builtin_amdgcn_mfma_f32_32x32x16_bf16(a0, bq, acc[0], 0, 0, 0); \
                acc[1] = __builtin_amdgcn_mfma_f32_32x32x16_bf16(a1, bq, acc[1], 0, 0, 0); } \
            if ((st & 3) == 3) { \
                const int n = st >> 2; \
                const bf16* gp = gl + (32 * wt + r32) * 136 + 64 * wd + 4 * hi; (void)n; \
                _Pragma("unroll") for (int dt = 0; dt < 2; ++dt) \
                _Pragma("unroll") for (int g = 0; g < 4; ++g) { \
                        const uint2 gv = *(const uint2*)(gp + 32 * dt + 8 * g); \
                        const float g0 = __uint_as_float(gv.x << 16), g1 = __uint_as_float(gv.x & 0xffff0000u), g2 = __uint_as_float(gv.y << 16), g3 = __uint_as_float(gv.y & 0xffff0000u); \
                        mer[dt][4 * g + 0] += acc[dt][4 * g + 0] * __builtin_amdgcn_rcpf(1.f + __builtin_amdgcn_exp2f(-LOG2E * g0)); \
                        mer[dt][4 * g + 1] += acc[dt][4 * g + 1] * __builtin_amdgcn_rcpf(1.f + __builtin_amdgcn_exp2f(-LOG2E * g1)); \
                        mer[dt][4 * g + 2] += acc[dt][4 * g + 2] * __builtin_amdgcn_rcpf(1.f + __builtin_amdgcn_exp2f(-LOG2E * g2)); \
                        mer[dt][4 * g + 3] += acc[dt][4 * g + 3] * __builtin_amdgcn_rcpf(1.f + __builtin_amdgcn_exp2f(-LOG2E * g3)); } \
                _Pragma("unroll") for (int r = 0; r < 16; ++r) { acc[0][r] = 0.f; acc[1][r] = 0.f; } } \
            if (st + 1 < 16) MG_SSTORE(OTH_, OTH_); \
            if ((st & 3) == 2) { *(uint4*)(gl + grow * 136 + gch * 8) = RG0; *(uint4*)(gl + (grow + 32) * 136 + gch * 8) = RG1; *(uint4*)(gl + (grow + 64) * 136 + gch * 8) = RG2; *(uint4*)(gl + (grow + 96) * 136 + gch * 8) = RG3; } \
            __syncthreads(); } while (0)
#pragma unroll 1
        for (int st2 = 0; st2 < 16; st2 += 2) { { const int st = st2; MG_STAGE(0, 1); } { const int st = st2 + 1; MG_STAGE(1, 0); } }
#undef MG_STAGE
#undef MG_GLOAD
#undef MG_SSTORE
        bf16* mp = merged + (size_t)(tok0 + 32 * wt + r32) * 1024 + d0 + 64 * wd + 4 * hi;
#pragma unroll
        for (int dt = 0; dt < 2; ++dt)
#pragma unroll
            for (int g = 0; g < 4; ++g)
                *(uint2*)(mp + 32 * dt + 8 * g) = make_uint2(cvtpk(mer[dt][4 * g], mer[dt][4 * g + 1]), cvtpk(mer[dt][4 * g + 2], mer[dt][4 * g + 3]));
    }
}
#define LAS __attribute__((address_space(3)))
#define XB_TMO      128
#define XB_XCNT(j)  (256  + 64 * (j))
#define XB_XSUB(j)  (1280 + 64 * (j))
#define XB_XGEN(j)  (2304 + 64 * (j))
#define XB_TOP      3328
#define XB_TOPGEN   3392
#define XCD_BAR_WORDS 3456
#define XB_SPIN_CAP (1u << 18)

__device__ __forceinline__ unsigned xb_ld(unsigned* p)              { return __hip_atomic_load(p, __ATOMIC_RELAXED, __HIP_MEMORY_SCOPE_AGENT); }
__device__ __forceinline__ unsigned xb_add(unsigned* p, unsigned v) { return __hip_atomic_fetch_add(p, v, __ATOMIC_RELAXED, __HIP_MEMORY_SCOPE_AGENT); }
__device__ __forceinline__ unsigned xb_xcc_id() { return (unsigned)__builtin_amdgcn_s_getreg((3 << 11) | 20) & 0xFu; }
#define XB_SPIN(cond, bar) do { unsigned _sp = 0; while (cond) { __builtin_amdgcn_s_sleep(1); \
    if ((++_sp & 255u) == 0u) { if (xb_ld(&(bar)[XB_TMO])) break; if (_sp > XB_SPIN_CAP) { atomicAdd(&(bar)[XB_TMO], 1u); break; } } } } while (0)

struct XcdBarrier {
    unsigned* bar; unsigned x;
    volatile LAS unsigned* st;
};

__device__ __forceinline__ XcdBarrier xcd_barrier_post(unsigned* bar, volatile LAS unsigned* st) {
    XcdBarrier b; b.bar = bar; b.x = xb_xcc_id(); b.st = st;
    if (threadIdx.x == 0) (void)xb_add(&bar[XB_XCNT(b.x)], 1u);
    return b;
}
__device__ __forceinline__ void xcd_barrier_complete(unsigned* bar, unsigned x, unsigned& nloc, unsigned& nx) {
    const unsigned G = gridDim.x * gridDim.y * gridDim.z;
    unsigned sum, cnt, mine, sp = 0u;
    for (;;) {
        sum = 0u; cnt = 0u; mine = 0u;
#pragma unroll
        for (unsigned j = 0; j < 16; ++j) { const unsigned c = xb_ld(&bar[XB_XCNT(j)]); sum += c; cnt += (c > 0u) ? 1u : 0u; mine = (j == x) ? c : mine; }
        if (sum == G) break;
        __builtin_amdgcn_s_sleep(1);
        if ((++sp & 255u) == 0u) { if (xb_ld(&bar[XB_TMO])) break; if (sp > XB_SPIN_CAP) { atomicAdd(&bar[XB_TMO], 1u); break; } }
    }
    nloc = mine > 0u ? mine : 1u; nx = cnt > 0u ? cnt : 1u;
}

__device__ __forceinline__ void xcd_barrier(const XcdBarrier& b, int wv_) {
    asm volatile("s_waitcnt vmcnt(0)" ::: "memory");
    __syncthreads();
    if (wv_ == 0 && LANEID() == 0) {
        unsigned* bar = b.bar;
        __builtin_amdgcn_s_waitcnt(0);
        unsigned nloc = b.st[0], nx = b.st[1];
        if (nloc == 0u) { xcd_barrier_complete(bar, b.x, nloc, nx); b.st[0] = nloc; b.st[1] = nx; }
        const unsigned old = xb_add(&bar[XB_XSUB(b.x)], 1u);
        const unsigned gen = old / nloc;
        if (old + 1u == (gen + 1u) * nloc) {
            __builtin_amdgcn_fence(__ATOMIC_RELEASE, "agent");
            asm volatile("s_waitcnt vmcnt(0)" ::: "memory");
            const unsigned og = xb_add(&bar[XB_TOP], 1u);
            const unsigned tg = og / nx;
            if (og + 1u == (tg + 1u) * nx) xb_add(&bar[XB_TOPGEN], 1u);
            else XB_SPIN(xb_ld(&bar[XB_TOPGEN]) == tg, bar);
            __builtin_amdgcn_fence(__ATOMIC_ACQUIRE, "agent");
            xb_add(&bar[XB_XGEN(b.x)], 1u);
            asm volatile("s_waitcnt vmcnt(0)" ::: "memory");
        } else {
            XB_SPIN(xb_ld(&bar[XB_XGEN(b.x)]) == gen, bar);
            __builtin_amdgcn_fence(__ATOMIC_ACQUIRE, "agent");
            asm volatile("s_waitcnt vmcnt(0)" ::: "memory");
        }
    }
    __syncthreads();
}

enum { PH_PRO = 0, PH_GIN, PH_INDEX, PH_ATTN, PH_MERGE, PH_GOUT, PH_LN1, PH_GQ, PH_ROUTE, PH_PEER };
template <int PH> __device__ __forceinline__ void run_phase(int WV_, const Params& p_unused, int l, unsigned char* lds_raw) {
    size_t kaoff_ = 0; asm volatile("" : "+s"(kaoff_));
    typedef const __attribute__((address_space(4))) char* kaptr_t;
    const __attribute__((address_space(4))) Params& p = *(const __attribute__((address_space(4))) Params*)((kaptr_t)__builtin_amdgcn_kernarg_segment_ptr() + kaoff_);
    float* sm = (float*)lds_raw;
    size_t wsoff_ = 0; asm volatile("" : "+s"(wsoff_));
    unsigned char* ws = p.ws + wsoff_;
    float* hbuf = p.out;
    bf16* hb = (bf16*)(ws + WS_HB);
    bf16* P = (bf16*)(ws + WS_P);
    bf16* ys = (bf16*)(ws + WS_YS);
    bf16* mrg = (bf16*)(ws + WS_MRG);
    float* mix = (float*)(ws + WS_MIX);
    float* qb = (float*)(ws + WS_Q);
    unsigned char* mask = ws + WS_MASK;
    int* eid = (int*)(ws + WS_EID);
    float* gate = (float*)(ws + WS_GATE);
    float* kmean = (float*)(ws + WS_KMEAN);
    const float* hin = (l == 0) ? p.in[0] : hbuf;
    if (PH == PH_PRO) { Params pc; for (int i = 0; i < 13; ++i) pc.in[i] = p.in[i]; pc.out = p.out; pc.ws = ws;
        prologue_phase(WV_, pc, sm); convert_tables(WV_, pc);
        for (int i = LBID() * NTHR + LTID(WV_); i < DEPTH_ * 8 * 2 * 128 * 64 / 4; i += LGRID() * NTHR) { const float4 v = ((const float4*)p.in[8])[i]; ((uint2*)(ws + WS_SKB))[i] = make_uint2(pk2(v.x, v.y), pk2(v.z, v.w)); } if (LBID() < 2) build_unit_table((unsigned*)(ws + WS_CTL) + 1024, LBID() * NTHR + LTID(WV_)); }
    else if (PH == PH_GIN) {
        pg8::Gemm g{hb, (const bf16*)(ws + WS_WIN_T + l * WIN_T_BYTES), T_, NP, 1024};
        pg8::StaticOrder S; S.init(T_, NP, (int)LGRID(), (int)LBID());
        pg8::EpiBf16<0> E{P, NP, nullptr, 0, 0, 1.f};
        pg8::gemm_phase<pg8::EpiBf16<0>, pg8::StaticOrder, true, true>(WV_, (PG8_LAS unsigned char*)lds_raw, g, S, E);
    }
    else if (PH == PH_INDEX) index_fast_phase(WV_, P, mask, kmean, (float*)(ws + WS_YS), lds_raw);
    else if (PH == PH_ATTN) attn_fast_phase(WV_, P, mask, kmean, p.in[4] + l * 4, ys, (const unsigned*)(ws + WS_CTL) + 1024, (unsigned*)(ws + WS_CTL) + 64 * l, lds_raw);
    else if (PH == PH_MERGE) merge_fast_phase(WV_, P, ys, (const bf16*)(ws + WS_WBR_T) + (size_t)l * 4 * 1024 * 256, mrg, lds_raw);
    else if (PH == PH_GOUT) {
        pg8::Gemm g{mrg, (const bf16*)(ws + WS_WOUT_T) + (size_t)l * 1024 * 1024, T_, 1024, 1024};
        pg8::StaticOrder S; S.init(T_, 1024, (int)LGRID(), (int)LBID());
        pg8::EpiResY E{hin, hbuf, hb, (float*)(ws + WS_STATS) + (size_t)l * T_ * 2, ALPHA};
        pg8::gemm_phase<pg8::EpiResY, pg8::StaticOrder, true, true>(WV_, (PG8_LAS unsigned char*)lds_raw, g, S, E);
    }
    else if (PH == PH_GQ) {
        pg8::Gemm g{hb, (const bf16*)(ws + WS_WQ_T) + (size_t)l * 1024 * 1024, T_, 1024, 1024};
        pg8::StaticOrder S; S.init(T_, 1024, (int)LGRID(), (int)LBID());
        pg8::EpiLnFold E{(bf16*)qb, (const float*)(ws + WS_STATS) + (size_t)l * T_ * 2, (const float*)(ws + WS_COLS) + l * 2048, (const float*)(ws + WS_COLS) + l * 2048 + 1024, LN_EPS};
        pg8::gemm_phase<pg8::EpiLnFold, pg8::StaticOrder, true, true>(WV_, (PG8_LAS unsigned char*)lds_raw, g, S, E);
    }
    else if (PH == PH_ROUTE) route_fast_phase(WV_, (const bf16*)qb, (const bf16*)(ws + WS_SKB) + (size_t)l * 8 * 2 * 128 * 64, eid, gate, lds_raw);
    else peer_fast_phase(WV_, hbuf, hb, eid, gate, ws + WS_UV + (size_t)l * 32 * MiB, p.in[5] + l * 1024, p.in[6] + l * 1024, p.in[11] + l * 1024, p.in[12] + l * 1024, lds_raw);
}

constexpr int CW_BAR = 4096;
constexpr int LDS_BARST = LDS_BYTES - 16;
__global__ void __launch_bounds__(NTHR, 2) mk_fwd(Params p) {
    extern __shared__ __attribute__((aligned(16))) unsigned char lds_raw[];
    cg::grid_group grid = cg::this_grid();
    const int WV_ = __builtin_amdgcn_readfirstlane((int)threadIdx.x >> 6);
    { volatile LAS unsigned* bst0 = (volatile LAS unsigned*)((LAS unsigned char*)lds_raw + LDS_BARST); if (threadIdx.x < 4) bst0[threadIdx.x] = 0u; }
    __syncthreads();
    volatile LAS unsigned* bst = (volatile LAS unsigned*)((LAS unsigned char*)lds_raw + LDS_BARST);
    (void)xcd_barrier_post((unsigned*)(p.ws + WS_CTL) + CW_BAR, bst);
#define GRID_BAR() do { XcdBarrier b_; b_.bar = (unsigned*)(p.ws + WS_CTL) + CW_BAR; b_.x = xb_xcc_id(); b_.st = (volatile LAS unsigned*)((LAS unsigned char*)lds_raw + LDS_BARST); xcd_barrier(b_, WV_); } while (0)
    run_phase<PH_PRO>(WV_, p, 0, lds_raw);
    grid.sync();
#pragma unroll 1
    for (int l = 0; l < DEPTH_; ++l) {
        run_phase<PH_GIN>(WV_, p, l, lds_raw); GRID_BAR();
        run_phase<PH_INDEX>(WV_, p, l, lds_raw); GRID_BAR();
        run_phase<PH_ATTN>(WV_, p, l, lds_raw); GRID_BAR();
        run_phase<PH_MERGE>(WV_, p, l, lds_raw); GRID_BAR();
        run_phase<PH_GOUT>(WV_, p, l, lds_raw); GRID_BAR();
        run_phase<PH_GQ>(WV_, p, l, lds_raw); GRID_BAR();
        run_phase<PH_ROUTE>(WV_, p, l, lds_raw); GRID_BAR();
        run_phase<PH_PEER>(WV_, p, l, lds_raw); if (l + 1 < DEPTH_) GRID_BAR();
    }
}

extern "C" void kernel_launch(void* const* d_in, const int* in_sizes, int n_in, void* d_out, int out_size, void* d_ws, size_t ws_size, hipStream_t stream) {
    if (n_in != 13 || ws_size < WS_END) { fprintf(stderr, "kernel_launch: unexpected n_in %d / ws_size %zu; nothing launched\n", n_in, ws_size); return; }
    static int grid_blocks = 0;
    if (grid_blocks == 0) {
        int dev = 0, cus = 0, per_cu = 0;
        (void)hipGetDevice(&dev);
        (void)hipDeviceGetAttribute(&cus, hipDeviceAttributeMultiprocessorCount, dev);
        (void)hipFuncSetAttribute((const void*)mk_fwd, hipFuncAttributeMaxDynamicSharedMemorySize, LDS_BYTES);
        (void)hipOccupancyMaxActiveBlocksPerMultiprocessor(&per_cu, (const void*)mk_fwd, NTHR, LDS_BYTES);
        if (per_cu < 1) fprintf(stderr, "kernel_launch: occupancy query reports %d\n", per_cu);
        grid_blocks = cus;
    }
    Params p{};
    for (int i = 0; i < 13; ++i) p.in[i] = (const float*)d_in[i];
    p.out = (float*)d_out; p.ws = (unsigned char*)d_ws;
    (void)hipMemsetAsync(d_ws, 0, 2 * MiB, stream);
    void* args[] = {&p};
    hipError_t e = hipLaunchCooperativeKernel((const void*)mk_fwd, dim3(grid_blocks), dim3(NTHR), args, LDS_BYTES, stream);
    if (e != hipSuccess) fprintf(stderr, "cooperative launch failed: %s (grid %d)\n", hipGetErrorString(e), grid_blocks);
}
```

```cpp
#include <hip/hip_runtime.h>
#include <cstdio>
#include <cstdint>
#include <hip/hip_cooperative_groups.h>
namespace cg = cooperative_groups;

__device__ __forceinline__ int LANEID() { int l; asm volatile("v_mbcnt_lo_u32_b32 %0, -1, 0\n\tv_mbcnt_hi_u32_b32 %0, -1, %0" : "=v"(l)); return l; }
__device__ __forceinline__ int LTID(int wv) { return (wv << 6) | LANEID(); }
__device__ __forceinline__ int LBID() { int t = blockIdx.x; asm volatile("" : "+s"(t)); return t; }
__device__ __forceinline__ int LGRID() { int t = gridDim.x; asm volatile("" : "+s"(t)); return t; }
namespace pg8 {
#define PG8_LAS __attribute__((address_space(3)))
typedef unsigned short bf16_t;
typedef short bf16x8 __attribute__((ext_vector_type(8)));
typedef float f32x4 __attribute__((ext_vector_type(4)));
typedef unsigned u32x4 __attribute__((ext_vector_type(4)));
constexpr int BM = 256, BK = 64, HALF = 128, HTB = HALF * BK * 2  , STAGE_BYTES = 8 * HTB, NXCD = 8, WGM = 8;

__host__ __device__ __forceinline__ int lds_byte(int r, int c) { const int st = (r >> 4) * 2 + (c >> 5), rr = r & 15, cc = c & 31, ob = rr * 64 + cc * 2; return st * 1024 + (ob ^ (((ob >> 9) & 1) << 5)); }
__host__ __device__ __forceinline__ void stage_rc(int b, int& R, int& C) { const int st = b / 1024, sb = b % 1024, swz = sb ^ (((sb >> 9) & 1) << 5); R = (st >> 1) * 16 + swz / 64; C = (st & 1) * 32 + (swz % 64) / 2; }
__host__ __device__ __forceinline__ int perm32(int rho) { const int n = rho >> 4, i = rho & 15; return 8 * (i >> 2) + 4 * n + (i & 3); }

struct Unit { int pm, pn; };
struct Gemm { const bf16_t* A; const bf16_t* Bt; int M, N, K; };

struct StaticOrder {
    int nM, nN, nwg, G, c;
    __host__ __device__ void init(int M, int N, int G_, int c_) { nM = M / BM; nN = N / BM; nwg = nM * nN; G = G_; c = c_; }
    __host__ __device__ bool next(int i, Unit& u) const {
        const long L = (long)i * G + c; if (L >= nwg) return false;
        int wgid = (int)L; { const int q = nwg / NXCD, r = nwg % NXCD, xcd = wgid % NXCD, off = wgid / NXCD; wgid = (xcd < r ? xcd * (q + 1) : r * (q + 1) + (xcd - r) * q) + off; }
        const int nig = WGM * nN, gid = wgid / nig, fm = gid * WGM, gsz = (nM - fm) < WGM ? (nM - fm) : WGM;
        u.pm = fm + ((wgid % nig) % gsz); u.pn = (wgid % nig) / gsz; return true;
    }
    __device__ __forceinline__ void a_ready(const Unit&) const {}
    __device__ __forceinline__ void done(const Unit&) const {}
};

__device__ __forceinline__ unsigned cvt_pk_bf16(float lo, float hi) { unsigned r; asm volatile("v_cvt_pk_bf16_f32 %0, %1, %2" : "=v"(r) : "v"(lo), "v"(hi)); return r; }
typedef float f32x2 __attribute__((ext_vector_type(2)));
__device__ __forceinline__ f32x2 gelu_pk(f32x2 v) {
    const f32x2 av = __builtin_elementwise_abs(v), d = av * 0.2316418882f + 1.0f;
    f32x2 t; t.x = __builtin_amdgcn_rcpf(d.x); t.y = __builtin_amdgcn_rcpf(d.y);
    f32x2 q = t * 0.5307027145f + (-0.7265760135f); q = q * t + 0.7107068705f; q = q * t + (-0.142248368f); q = q * t + 0.127414796f; q = q * t;
    const f32x2 s = (v * v) * (-0.72134752044f);
    f32x2 e; e.x = __builtin_amdgcn_exp2f(s.x); e.y = __builtin_amdgcn_exp2f(s.y);
    const f32x2 m = v * (q * e), r = v - m;
    f32x2 o; o.x = v.x < 0.f ? m.x : r.x; o.y = v.y < 0.f ? m.y : r.y; return o;
}

template <int ACT  > struct EpiBf16 {
    static constexpr bool PERM = true, AFTER_DRAIN = false; static_assert(ACT == 0 || ACT == 1, "EpiBf16: ACT is 0 (none) or 1 (gelu_pk)");
    bf16_t* O; int ldc; const float* bias; int split_cols; size_t split_stride; float scale0;
    __device__ __forceinline__ void operator()(const f32x4 (&acc)[2][2][4][2], const Unit& u, int wr, int wc, int fr, int fq) const {
        { int ln_ = LANEID(); asm volatile("" : "+v"(ln_)); fr = ln_ & 15; fq = ln_ >> 4; }
        const int row0 = u.pm * BM + wr * 64 + fr; int colt = u.pn * BM; bf16_t* base = O;
        float sc = 1.f; if (split_cols) { const int t = colt / split_cols; base += (size_t)t * split_stride; colt -= t * split_cols; if (t == 0) sc = scale0; }
        const int col0 = colt + wc * 32 + 8 * fq, bcol0 = u.pn * BM + wc * 32 + 8 * fq;
        f32x4 bv[2][2];
#pragma unroll
        for (int bj = 0; bj < 2; ++bj)
#pragma unroll
            for (int n = 0; n < 2; ++n) bv[bj][n] = bias ? *(const f32x4*)(bias + bcol0 + bj * HALF + 4 * n) : (f32x4){0.f, 0.f, 0.f, 0.f};
#pragma unroll
        for (int ai = 0; ai < 2; ++ai)
#pragma unroll
            for (int m = 0; m < 4; ++m) { bf16_t* rowp = base + (size_t)(row0 + ai * HALF + m * 16) * ldc + col0;
#pragma unroll
                for (int bj = 0; bj < 2; ++bj) { f32x4 v0 = acc[ai][bj][m][0] + bv[bj][0], v1 = acc[ai][bj][m][1] + bv[bj][1];
                    if (ACT == 1) { f32x2 a = gelu_pk((f32x2){v0[0], v0[1]}), b = gelu_pk((f32x2){v0[2], v0[3]}), c = gelu_pk((f32x2){v1[0], v1[1]}), d = gelu_pk((f32x2){v1[2], v1[3]});
                        v0 = (f32x4){a.x, a.y, b.x, b.y}; v1 = (f32x4){c.x, c.y, d.x, d.y}; }
                    v0 = v0 * sc; v1 = v1 * sc; u32x4 w; w.x = cvt_pk_bf16(v0[0], v0[1]); w.y = cvt_pk_bf16(v0[2], v0[3]); w.z = cvt_pk_bf16(v1[0], v1[1]); w.w = cvt_pk_bf16(v1[2], v1[3]);
                    *(u32x4*)(rowp + bj * HALF) = w; } }
    }
};
template <class Epi, class Sched, bool ALIGN_EPI = false, bool SP2 = false>
__device__ __forceinline__ void gemm_phase(int WV_, PG8_LAS unsigned char* lds, const Gemm g, const Sched& S, const Epi& E) {
    const int tid = LTID(WV_), wid = __builtin_amdgcn_readfirstlane(tid >> 6), lane = tid & 63, wr = wid >> 2, wc = wid & 3, fr = lane & 15, fq = lane >> 4;
    const int K = g.K, nt = K / BK;
    unsigned voffA[2], voffB[2];
#pragma unroll
    for (int i = 0; i < 2; ++i) { int R, C; stage_rc(tid * 16 + i * 8192, R, C); const int Rb = Epi::PERM ? ((R & ~31) + perm32(R & 31)) : R;
        voffA[i] = (unsigned)(R * K + C) * 2u; voffB[i] = (unsigned)(Rb * K + C) * 2u; }
    const size_t kstep = (size_t)(BK * 2);
    const size_t hstep = (size_t)HALF * K * 2;
    const size_t tstep = 2 * hstep;
    const unsigned ldsw = (unsigned)wid * 1024u;
    const int aoff = lds_byte(wr * 64 + fr, fq * 8), boff = lds_byte(wc * 32 + fr, fq * 8);
#define PG8_SA(b, h) (((b) * 2 + (h)) * HTB)
#define PG8_SB(b, h) ((4 + (b) * 2 + (h)) * HTB)
#define PG8_STAGE(bufoff, gbase, voff) do { _Pragma("unroll") for (int _i = 0; _i < 2; ++_i) \
        __builtin_amdgcn_global_load_lds((const unsigned*)((const char*)(gbase) + (voff)[_i]), (PG8_LAS unsigned*)(lds + (bufoff) + ldsw + _i * 8192), 16, 0, 0); } while (0)
#define PG8_LDA(dst, b, h) do { _Pragma("unroll") for (int m = 0; m < 4; ++m) _Pragma("unroll") for (int k = 0; k < 2; ++k) dst[m][k] = *(const PG8_LAS bf16x8*)(lds + PG8_SA(b, h) + aoff + m * 2048 + k * 1024); } while (0)
#define PG8_LDB(dst, b, h) do { _Pragma("unroll") for (int n = 0; n < 2; ++n) _Pragma("unroll") for (int k = 0; k < 2; ++k) dst[n][k] = *(const PG8_LAS bf16x8*)(lds + PG8_SB(b, h) + boff + n * 2048 + k * 1024); } while (0)
#define PG8_MMA(ai, bj, At, Bt) do { __builtin_amdgcn_s_setprio(1); _Pragma("unroll") for (int m = 0; m < 4; ++m) _Pragma("unroll") for (int n = 0; n < 2; ++n) _Pragma("unroll") for (int k = 0; k < 2; ++k) \
        acc[ai][bj][m][n] = __builtin_amdgcn_mfma_f32_16x16x32_bf16(Bt[n][k], At[m][k], acc[ai][bj][m][n], 0, 0, 0); __builtin_amdgcn_s_setprio(0); } while (0)
#define PG8_WAIT_V(n) asm volatile("s_waitcnt vmcnt(" #n ")" ::: "memory")
#define PG8_WAIT_L(n) asm volatile("s_waitcnt lgkmcnt(" #n ")" ::: "memory")
#define PG8_BAR __builtin_amdgcn_s_barrier()
#define PG8_SCHED __builtin_amdgcn_sched_barrier(0)
    Unit cur, nxt; int ui = 0;
    if (!S.next(0, cur)) return;
    f32x4 acc[2][2][4][2];
#pragma unroll
    for (int a = 0; a < 2; ++a)
#pragma unroll
        for (int b = 0; b < 2; ++b)
#pragma unroll
            for (int m = 0; m < 4; ++m)
#pragma unroll
                for (int n = 0; n < 2; ++n) acc[a][b][m][n] = (f32x4){0.f, 0.f, 0.f, 0.f};
    bf16x8 At[4][2], B0[2][2], B1[2][2];
    const char* cA = (const char*)g.A + (size_t)cur.pm * tstep; const char* cB = (const char*)g.Bt + (size_t)cur.pn * tstep;
    S.a_ready(cur);
    if constexpr (SP2) {
        PG8_STAGE(PG8_SB(0, 0), cB, voffB); PG8_STAGE(PG8_SB(0, 1), cB + hstep, voffB); PG8_STAGE(PG8_SA(0, 0), cA, voffA); PG8_STAGE(PG8_SA(0, 1), cA + hstep, voffA);
        if (wr == 1) PG8_BAR;
        PG8_WAIT_V(2); PG8_BAR;
        PG8_STAGE(PG8_SB(1, 0), cB + kstep, voffB); PG8_STAGE(PG8_SA(1, 0), cA + kstep, voffA); PG8_STAGE(PG8_SB(1, 1), cB + hstep + kstep, voffB);
        PG8_WAIT_V(6); PG8_BAR;
    } else {
        PG8_STAGE(PG8_SB(0, 0), cB, voffB); PG8_STAGE(PG8_SA(0, 0), cA, voffA); PG8_STAGE(PG8_SB(0, 1), cB + hstep, voffB); PG8_STAGE(PG8_SA(0, 1), cA + hstep, voffA);
        if (wr == 1) PG8_BAR;
        PG8_WAIT_V(4); PG8_BAR;
        PG8_STAGE(PG8_SB(1, 0), cB + kstep, voffB); PG8_STAGE(PG8_SA(1, 0), cA + kstep, voffA); PG8_STAGE(PG8_SB(1, 1), cB + hstep + kstep, voffB);
        PG8_WAIT_V(6); PG8_BAR;
    }
    for (;;) {
        const bool has_next = S.next(ui + 1, nxt);
        const char* nA = has_next ? (const char*)g.A + (size_t)nxt.pm * tstep : cA; const char* nB = has_next ? (const char*)g.Bt + (size_t)nxt.pn * tstep : cB;
        for (int t = 0; t < nt; t += 2) {
            const bool last = (t == nt - 2);
            const char* a1 = cA + (size_t)(t + 1) * kstep;
            const char* a2 = last ? nA : cA + (size_t)(t + 2) * kstep; const char* b2 = last ? nB : cB + (size_t)(t + 2) * kstep;
            const char* a3 = a2 + kstep; const char* b3 = b2 + kstep;
            if (last && has_next) S.a_ready(nxt);
            if constexpr (SP2) {
            PG8_LDB(B0, 0, 0); PG8_LDB(B1, 0, 1); PG8_SCHED; PG8_LDA(At, 0, 0); PG8_STAGE(PG8_SA(1, 1), a1 + hstep, voffA);
            PG8_WAIT_V(8); PG8_WAIT_L(0); PG8_BAR; PG8_MMA(0, 0, At, B0); PG8_MMA(0, 1, At, B1); PG8_BAR; PG8_SCHED;
            PG8_LDA(At, 0, 1); PG8_STAGE(PG8_SB(0, 0), b2, voffB); PG8_STAGE(PG8_SB(0, 1), b2 + hstep, voffB); PG8_STAGE(PG8_SA(0, 0), a2, voffA);
            PG8_WAIT_V(8); PG8_WAIT_L(0); PG8_BAR; PG8_MMA(1, 0, At, B0); PG8_MMA(1, 1, At, B1); PG8_BAR; PG8_SCHED;
            PG8_LDB(B0, 1, 0); PG8_LDB(B1, 1, 1); PG8_SCHED; PG8_LDA(At, 1, 0); PG8_STAGE(PG8_SA(0, 1), a2 + hstep, voffA);
            PG8_WAIT_V(8); PG8_WAIT_L(0); PG8_BAR; PG8_MMA(0, 0, At, B0); PG8_MMA(0, 1, At, B1); PG8_BAR; PG8_SCHED;
            PG8_LDA(At, 1, 1); PG8_STAGE(PG8_SB(1, 0), b3, voffB); PG8_STAGE(PG8_SB(1, 1), b3 + hstep, voffB); PG8_STAGE(PG8_SA(1, 0), a3, voffA);
            PG8_WAIT_V(8); PG8_WAIT_L(0); PG8_BAR; PG8_MMA(1, 0, At, B0); PG8_MMA(1, 1, At, B1); PG8_BAR; PG8_SCHED;
            } else {
            PG8_LDB(B0, 0, 0); PG8_SCHED; PG8_LDA(At, 0, 0); PG8_STAGE(PG8_SA(1, 1), a1 + hstep, voffA);
            PG8_WAIT_L(8); PG8_BAR; PG8_WAIT_L(0); PG8_MMA(0, 0, At, B0); PG8_BAR; PG8_SCHED;
            PG8_LDB(B1, 0, 1); PG8_STAGE(PG8_SB(0, 0), b2, voffB);
            PG8_BAR; PG8_WAIT_L(0); PG8_MMA(0, 1, At, B1); PG8_BAR;
            PG8_LDA(At, 0, 1); PG8_STAGE(PG8_SA(0, 0), a2, voffA);
            PG8_BAR; PG8_WAIT_L(0); PG8_MMA(1, 0, At, B0); PG8_BAR; PG8_SCHED;
            PG8_STAGE(PG8_SB(0, 1), b2 + hstep, voffB);
            PG8_WAIT_V(6); PG8_BAR; PG8_MMA(1, 1, At, B1); PG8_BAR;
            PG8_LDB(B0, 1, 0); PG8_SCHED; PG8_LDA(At, 1, 0); PG8_STAGE(PG8_SA(0, 1), a2 + hstep, voffA);
            PG8_WAIT_L(8); PG8_BAR; PG8_WAIT_L(0); PG8_MMA(0, 0, At, B0); PG8_BAR; PG8_SCHED;
            PG8_LDB(B1, 1, 1); PG8_STAGE(PG8_SB(1, 0), b3, voffB);
            PG8_BAR; PG8_WAIT_L(0); PG8_MMA(0, 1, At, B1); PG8_BAR;
            PG8_LDA(At, 1, 1); PG8_STAGE(PG8_SA(1, 0), a3, voffA);
            PG8_BAR; PG8_WAIT_L(0); PG8_MMA(1, 0, At, B0); PG8_BAR; PG8_SCHED;
            PG8_STAGE(PG8_SB(1, 1), b3 + hstep, voffB);
            PG8_WAIT_V(6); PG8_BAR; PG8_MMA(1, 1, At, B1); PG8_BAR;
            }
        }
        if constexpr (ALIGN_EPI) { if (wr == 0) PG8_BAR; }
        if constexpr (!Epi::AFTER_DRAIN) { E(acc, cur, wr, wc, fr, fq); S.done(cur); }
        if (!has_next) break;
#pragma unroll
        for (int a = 0; a < 2; ++a)
#pragma unroll
            for (int b = 0; b < 2; ++b)
#pragma unroll
                for (int m = 0; m < 4; ++m)
#pragma unroll
                    for (int n = 0; n < 2; ++n) acc[a][b][m][n] = (f32x4){0.f, 0.f, 0.f, 0.f};
        cur = nxt; cA = nA; cB = nB; ++ui;
        if constexpr (ALIGN_EPI) { if (wr == 1) PG8_BAR; }
    }
    PG8_WAIT_V(0);
    if constexpr (!ALIGN_EPI) { if (wr == 0) PG8_BAR; }
    PG8_BAR;
    if constexpr (Epi::AFTER_DRAIN) { E.fused(acc, cur, wr, wc, fr, fq, lds, wid, lane); S.done(cur); }
#undef PG8_SA
#undef PG8_SB
#undef PG8_STAGE
#undef PG8_LDA
#undef PG8_LDB
#undef PG8_MMA
#undef PG8_WAIT_V
#undef PG8_WAIT_L
#undef PG8_BAR
#undef PG8_SCHED
}
}
namespace pg8 {
struct EpiF32 {
    static constexpr bool PERM = false, AFTER_DRAIN = false;
    float* O; int ldc;
    __device__ __forceinline__ void operator()(const f32x4 (&acc)[2][2][4][2], const Unit& u, int wr, int wc, int fr, int fq) const {
        { int ln_ = LANEID(); asm volatile("" : "+v"(ln_)); fr = ln_ & 15; fq = ln_ >> 4; }
        const int row0 = u.pm * BM + wr * 64 + fr, col0 = u.pn * BM + wc * 32 + 4 * fq;
#pragma unroll
        for (int ai = 0; ai < 2; ++ai)
#pragma unroll
            for (int m = 0; m < 4; ++m) { float* rowp = O + (size_t)(row0 + ai * HALF + m * 16) * ldc + col0;
#pragma unroll
                for (int bj = 0; bj < 2; ++bj)
#pragma unroll
                    for (int n = 0; n < 2; ++n) *(f32x4*)(rowp + bj * HALF + n * 16) = acc[ai][bj][m][n]; }
    }
};
struct EpiResY {
    static constexpr bool PERM = false, AFTER_DRAIN = false;
    const float* hin; float* yout; bf16_t* yb; float* stats; float alpha;
    __device__ __forceinline__ void operator()(const f32x4 (&acc)[2][2][4][2], const Unit& u, int wr, int wc, int fr, int fq) const {
        { int ln_ = LANEID(); asm volatile("" : "+v"(ln_)); fr = ln_ & 15; fq = ln_ >> 4; }
        const int row0 = u.pm * BM + wr * 64 + fr, col0 = u.pn * BM + wc * 32 + 4 * fq;
#pragma unroll
        for (int ai = 0; ai < 2; ++ai)
#pragma unroll
            for (int m = 0; m < 4; ++m) {
                const int row = row0 + ai * HALF + m * 16;
                float s = 0.f, s2 = 0.f;
#pragma unroll
                for (int bj = 0; bj < 2; ++bj)
#pragma unroll
                    for (int n = 0; n < 2; ++n) {
                        const size_t off = (size_t)row * 1024 + col0 + bj * HALF + n * 16;
                        const f32x4 hv = *(const f32x4*)(hin + off);
                        const f32x4 y = hv * alpha + acc[ai][bj][m][n];
                        *(f32x4*)(yout + off) = y;
                        typedef unsigned u32x2v __attribute__((ext_vector_type(2)));
                        u32x2v w; w.x = cvt_pk_bf16(y[0], y[1]); w.y = cvt_pk_bf16(y[2], y[3]);
                        *(u32x2v*)(yb + off) = w;
                        s += (y[0] + y[1]) + (y[2] + y[3]); s2 += (y[0] * y[0] + y[1] * y[1]) + (y[2] * y[2] + y[3] * y[3]);
                    }
                s += __shfl_xor(s, 16); s += __shfl_xor(s, 32); s2 += __shfl_xor(s2, 16); s2 += __shfl_xor(s2, 32);
                if (fq == 0) { atomicAdd(stats + 2 * (size_t)row, s); atomicAdd(stats + 2 * (size_t)row + 1, s2); }
            }
    }
};
struct EpiLnFold {
    static constexpr bool PERM = true, AFTER_DRAIN = false;
    bf16_t* O; const float* stats; const float* colsum; const float* colbias; float eps;
    __device__ __forceinline__ void operator()(const f32x4 (&acc)[2][2][4][2], const Unit& u, int wr, int wc, int fr, int fq) const {
        { int ln_ = LANEID(); asm volatile("" : "+v"(ln_)); fr = ln_ & 15; fq = ln_ >> 4; }
        const int row0 = u.pm * BM + wr * 64 + fr, col0 = u.pn * BM + wc * 32 + 8 * fq;
        f32x4 cs[2][2], cb[2][2];
#pragma unroll
        for (int bj = 0; bj < 2; ++bj)
#pragma unroll
            for (int n = 0; n < 2; ++n) { cs[bj][n] = *(const f32x4*)(colsum + col0 + bj * HALF + 4 * n); cb[bj][n] = *(const f32x4*)(colbias + col0 + bj * HALF + 4 * n); }
#pragma unroll
        for (int ai = 0; ai < 2; ++ai)
#pragma unroll
            for (int m = 0; m < 4; ++m) {
                const int row = row0 + ai * HALF + m * 16;
                const float sm_ = stats[2 * (size_t)row], sq_ = stats[2 * (size_t)row + 1];
                const float mean = sm_ * (1.0f / 1024.0f);
                const float rstd = 1.0f / sqrtf(fmaxf(sq_ * (1.0f / 1024.0f) - mean * mean, 0.f) + eps);
                bf16_t* rowp = O + (size_t)row * 1024 + col0;
#pragma unroll
                for (int bj = 0; bj < 2; ++bj) {
                    const f32x4 v0 = (acc[ai][bj][m][0] - cs[bj][0] * mean) * rstd + cb[bj][0], v1 = (acc[ai][bj][m][1] - cs[bj][1] * mean) * rstd + cb[bj][1];
                    u32x4 w; w.x = cvt_pk_bf16(v0[0], v0[1]); w.y = cvt_pk_bf16(v0[2], v0[3]); w.z = cvt_pk_bf16(v1[0], v1[1]); w.w = cvt_pk_bf16(v1[2], v1[3]);
                    *(u32x4*)(rowp + bj * HALF) = w;
                }
            }
    }
};
}

typedef unsigned short bf16;
constexpr int T_ = 16384, S_ = 4096, NBATCH = 4, D_ = 1024, NCOL = 6824, NP = 6912, DEPTH_ = 2;
constexpr int C_QA = 0, C_KA = 256, C_VA = 320, C_QI = 384, C_KI = 640, C_WI = 672, C_QB = 680, C_KB = 936, C_VB = 1064,
              C_QC = 1192, C_KC = 1448, C_VC = 1704, C_QD = 1960, C_KD = 2216, C_VD = 2472, C_G = 2728;
constexpr int NTHR = 512, NWAVE = 8;
constexpr float ALPHA = 1.41421356237309515f;
constexpr float LN_EPS = 1e-5f;
constexpr size_t MiB = 1u << 20;
constexpr size_t WS_STATS = 1 * MiB  , WS_COLS = 1 * MiB + 512 * 1024  ;
constexpr size_t WS_CTL = 0, WS_WIN_T = 2 * MiB, WS_WOUT_T = 30 * MiB, WS_WQ_T = 34 * MiB, WS_WBR_T = 38 * MiB, WS_HB = 42 * MiB,
                 WS_P = 74 * MiB, WS_MIX = 74 * MiB  , WS_Q = 138 * MiB  , WS_YS = 290 * MiB, WS_MRG = 322 * MiB,
                 WS_MASK = 354 * MiB, WS_EID = 362 * MiB, WS_GATE = 370 * MiB, WS_KMEAN = 378 * MiB, WS_SKB = 379 * MiB, WS_UV = 380 * MiB, WS_END = 508 * MiB;
constexpr size_t WIN_T_BYTES = (size_t)NP * 1024 * 2;
constexpr int LDS_BYTES = 144 * 1024;

struct Params { const float* in[13]; float* out; unsigned char* ws; };

__device__ __forceinline__ float bf2f(bf16 v) { return __uint_as_float((unsigned)v << 16); }
__device__ __forceinline__ unsigned f2bf(float f) { unsigned u = __float_as_uint(f); return (u + 0x7fffu + ((u >> 16) & 1u)) >> 16; }
__device__ __forceinline__ unsigned pk2(float lo, float hi) { return f2bf(lo) | (f2bf(hi) << 16); }
__device__ __forceinline__ void unpack8(const uint4 v, float* o) {
    o[0] = __uint_as_float(v.x << 16); o[1] = __uint_as_float(v.x & 0xffff0000u); o[2] = __uint_as_float(v.y << 16); o[3] = __uint_as_float(v.y & 0xffff0000u);
    o[4] = __uint_as_float(v.z << 16); o[5] = __uint_as_float(v.z & 0xffff0000u); o[6] = __uint_as_float(v.w << 16); o[7] = __uint_as_float(v.w & 0xffff0000u);
}
__device__ __forceinline__ float wave_sum(float v) {
#pragma unroll
    for (int o = 32; o > 0; o >>= 1) v += __shfl_xor(v, o);
    return v;
}
__device__ __forceinline__ float wave_max(float v) {
#pragma unroll
    for (int o = 32; o > 0; o >>= 1) v = fmaxf(v, __shfl_xor(v, o));
    return v;
}
__device__ __forceinline__ int wave_sum_i(int v) {
#pragma unroll
    for (int o = 32; o > 0; o >>= 1) v += __shfl_xor(v, o);
    return v;
}
__device__ __forceinline__ float logsig(float x) { return fminf(x, 0.f) - log1pf(expf(-fabsf(x))); }

__device__ void transpose_items(int WV_, const float* W, int K, int N, bf16* WT, float* sm, int item0, int nitems_total, int item_stride,
                                const float* rs_g = nullptr, const float* rs_b = nullptr, float* colsum = nullptr, float* colbias = nullptr) {
    const int tid = LTID(WV_);
    const int nkb = K / 64, nnb = (N + 63) / 64;
    for (int it = item0; it < nkb * nnb; it += item_stride) {
        const int kb = it % nkb, nb = it / nkb, k0 = kb * 64, n0 = nb * 64;
        __syncthreads();
        for (int e = tid; e < 64 * 64; e += NTHR) { const int kk = e >> 6, nn = e & 63; sm[kk * 65 + nn] = (n0 + nn < N) ? W[(size_t)(k0 + kk) * N + n0 + nn] : 0.f; }
        __syncthreads();
        if (rs_g) {
            if (tid < 64) { float cs = 0.f, cb = 0.f;
                for (int kk = 0; kk < 64; ++kk) { const float w = sm[kk * 65 + tid]; cs += w * rs_g[k0 + kk]; cb += w * rs_b[k0 + kk]; }
                atomicAdd(colsum + n0 + tid, cs); atomicAdd(colbias + n0 + tid, cb); }
            __syncthreads();
            for (int e = tid; e < 64 * 64; e += NTHR) { const int kk = e >> 6, nn = e & 63; sm[kk * 65 + nn] *= rs_g[k0 + kk]; }
            __syncthreads();
        }
        { const int nn = tid >> 3, c = tid & 7;
          if (n0 + nn < N) { uint4 o; o.x = pk2(sm[(8 * c + 0) * 65 + nn], sm[(8 * c + 1) * 65 + nn]); o.y = pk2(sm[(8 * c + 2) * 65 + nn], sm[(8 * c + 3) * 65 + nn]);
              o.z = pk2(sm[(8 * c + 4) * 65 + nn], sm[(8 * c + 5) * 65 + nn]); o.w = pk2(sm[(8 * c + 6) * 65 + nn], sm[(8 * c + 7) * 65 + nn]);
              *(uint4*)(WT + (size_t)(n0 + nn) * K + k0 + 8 * c) = o; } }
    }
    __syncthreads();
}
__device__ void prologue_phase(int WV_, const Params& p, float* sm) {
    const int tid = LTID(WV_), B = LBID(), G = LGRID();
    unsigned char* ws = p.ws;
    for (int l = 0; l < DEPTH_; ++l) {
        bf16* win_t = (bf16*)(ws + WS_WIN_T + l * WIN_T_BYTES);
        transpose_items(WV_, p.in[1] + (size_t)l * 1024 * NCOL, 1024, NCOL, win_t, sm, B, 0, G);
        for (int i = B * NTHR + tid; i < (NP - NCOL) * 1024 / 8; i += G * NTHR) ((uint4*)(win_t + (size_t)NCOL * 1024))[i] = make_uint4(0u, 0u, 0u, 0u);
        transpose_items(WV_, p.in[3] + (size_t)l * 1024 * 1024, 1024, 1024, (bf16*)(ws + WS_WOUT_T) + (size_t)l * 1024 * 1024, sm, B, 0, G);
        transpose_items(WV_, p.in[7] + (size_t)l * 1024 * 1024, 1024, 1024, (bf16*)(ws + WS_WQ_T) + (size_t)l * 1024 * 1024, sm, B, 0, G,
                        p.in[5] + l * 1024, p.in[6] + l * 1024, (float*)(ws + WS_COLS) + l * 2048, (float*)(ws + WS_COLS) + l * 2048 + 1024);
        for (int n = 0; n < 4; ++n)
            transpose_items(WV_, p.in[2] + ((size_t)l * 4 + n) * 256 * 1024, 256, 1024, (bf16*)(ws + WS_WBR_T) + ((size_t)l * 4 + n) * 1024 * 256, sm, B, 0, G);
    }
    const float4* x4 = (const float4*)p.in[0]; uint2* hb2 = (uint2*)(ws + WS_HB);
    for (size_t i = (size_t)B * NTHR + tid; i < (size_t)T_ * 1024 / 4; i += (size_t)G * NTHR) { const float4 v = x4[i]; hb2[i] = make_uint2(pk2(v.x, v.y), pk2(v.z, v.w)); }
}

__device__ __forceinline__ void ln_row(float4 (&v)[4], const float* g, const float* bb, float* orow, bf16* obrow, int lane) {
    float s = 0.f;
#pragma unroll
    for (int j = 0; j < 4; ++j) s += (v[j].x + v[j].y) + (v[j].z + v[j].w);
    const float mean = wave_sum(s) * (1.0f / 1024.0f);
    float s2 = 0.f;
#pragma unroll
    for (int j = 0; j < 4; ++j) { v[j].x -= mean; v[j].y -= mean; v[j].z -= mean; v[j].w -= mean; s2 += (v[j].x * v[j].x + v[j].y * v[j].y) + (v[j].z * v[j].z + v[j].w * v[j].w); }
    const float rstd = 1.0f / sqrtf(wave_sum(s2) * (1.0f / 1024.0f) + LN_EPS);
#pragma unroll
    for (int j = 0; j < 4; ++j) {
        const float4 gg = ((const float4*)g)[j * 64 + lane], b4 = ((const float4*)bb)[j * 64 + lane];
        float4 o; o.x = v[j].x * rstd * gg.x + b4.x; o.y = v[j].y * rstd * gg.y + b4.y; o.z = v[j].z * rstd * gg.z + b4.z; o.w = v[j].w * rstd * gg.w + b4.w;
        ((float4*)orow)[j * 64 + lane] = o;
        ((uint2*)obrow)[j * 64 + lane] = make_uint2(pk2(o.x, o.y), pk2(o.z, o.w));
    }
}
__device__ void ln1_phase(int WV_, const float* hin, const float* add, const float* g, const float* bb, float* hout, bf16* hb) {
    const int lane = LTID(WV_) & 63, wave = LTID(WV_) >> 6;
    for (int row = LBID() * NWAVE + wave; row < T_; row += LGRID() * NWAVE) {
        float4 v[4];
#pragma unroll
        for (int j = 0; j < 4; ++j) {
            const float4 a = ((const float4*)(hin + (size_t)row * 1024))[j * 64 + lane], m = ((const float4*)(add + (size_t)row * 1024))[j * 64 + lane];
            v[j].x = ALPHA * a.x + m.x; v[j].y = ALPHA * a.y + m.y; v[j].z = ALPHA * a.z + m.z; v[j].w = ALPHA * a.w + m.w;
        }
        ln_row(v, g, bb, hout + (size_t)row * 1024, hb + (size_t)row * 1024, lane);
    }
}


typedef short bf16x8_t __attribute__((ext_vector_type(8)));
typedef float f32x16_t __attribute__((ext_vector_type(16)));
typedef float f32x2_t __attribute__((ext_vector_type(2)));
typedef __bf16 bf16x2_t __attribute__((ext_vector_type(2)));
__device__ __forceinline__ unsigned cvtpk(float lo, float hi) { f32x2_t v = {lo, hi}; bf16x2_t b = __builtin_convertvector(v, bf16x2_t); return __builtin_bit_cast(unsigned, b); }
__device__ __forceinline__ int crow(int r, int hi) { return (r & 3) + 8 * (r >> 2) + 4 * hi; }
__device__ __forceinline__ float xlane32(float v) { return __shfl_xor(v, 32); }
__device__ __forceinline__ float vmax(float a, float b) { float r; asm("v_max_f32_e32 %0, %1, %2" : "=v"(r) : "v"(a), "v"(b)); return r; }
__device__ __forceinline__ float vmin(float a, float b) { float r; asm("v_min_f32_e32 %0, %1, %2" : "=v"(r) : "v"(a), "v"(b)); return r; }
__device__ __forceinline__ float vmax3(float a, float b, float c) { float r; asm("v_max3_f32 %0, %1, %2, %3" : "=v"(r) : "v"(a), "v"(b), "v"(c)); return r; }

constexpr int AT_KP = 72, AT_VP = 68;
constexpr int AT_KS = 0, AT_KS_BYTES = 64 * AT_KP * 2;
constexpr int AT_VT = 2 * AT_KS_BYTES, AT_VT_BYTES = 64 * AT_VP * 2;
constexpr int AT_KM = AT_VT + 2 * AT_VT_BYTES;
constexpr int AT_MISC = AT_KM + 32 * AT_KP * 2;
constexpr float LOG2E = 1.4426950408889634f;

__device__ __forceinline__ unsigned mk_unit(int kind, int b, int x, int y) { return ((unsigned)kind << 30) | ((unsigned)b << 28) | ((unsigned)x << 8) | (unsigned)y; }
__device__ void build_unit_table(unsigned* tab, int i) {
    int n = 0; unsigned res = 0u;
#pragma unroll 1
    for (int c = 64; c >= 1; --c) {
        if (i >= n && i < n + 4) res = mk_unit(0, i - n, 0, c - 1);
        n += 4;
        if ((c & 3) == 0) { if (i >= n && i < n + 16) { const int j = i - n; res = mk_unit(2, j >> 2, j & 3, c / 4 - 1); } n += 16; }
    }
    if (i < 512) tab[i] = res;
}

template <int kind> __device__ __forceinline__ void attn_unit(int WV_, const bf16* P, const unsigned char* mask, const float* kmean, const float* sinks, bf16* ys,
                                unsigned char* lds, int b, int ux, int uy) {
    int tid_ = LTID(WV_); asm volatile("" : "+v"(tid_));
    const int tid = tid_, lane = tid & 63, wave = __builtin_amdgcn_readfirstlane(tid >> 6), r32 = lane & 31, hi = lane >> 5;
    bf16* s_km = (bf16*)(lds + AT_KM);
    const int skey = tid >> 3, sc = tid & 7;
    {
        const bf16* Pb = P + (size_t)b * S_ * NP;
        int q0w, qcol, kcol, vcol, ycol, kt_hi, kt_lo; float slope2 = 0.f, sink2 = 0.f;
        if (kind == 0) { const int head = wave >> 1; q0w = uy * 64 + (wave & 1) * 32; qcol = C_QA + head * 64; kcol = C_KA; vcol = C_VA; ycol = head * 64;
            slope2 = exp2f(-8.0f * (float)(3 * head + 1) / 12.0f) * LOG2E; kt_hi = uy; kt_lo = 0; }
        else if (kind == 1) { const int hq = ux * 2 + (wave >> 2); q0w = uy * 128 + (wave & 3) * 32; qcol = C_QB + hq * 64; kcol = C_KB + ux * 64; vcol = C_VB + ux * 64; ycol = 256 + hq * 64;
            slope2 = exp2f(-8.0f * (float)(3 * hq + 2) / 12.0f) * LOG2E; sink2 = sinks[hq] * LOG2E; kt_hi = 2 * uy + 1; kt_lo = (2 * uy - 2 > 0) ? 2 * uy - 2 : 0; }
        else if (kind == 2) { q0w = uy * 256 + wave * 32; qcol = C_QC + ux * 64; kcol = C_KC + ux * 64; vcol = C_VC + ux * 64; ycol = 512 + ux * 64;
            slope2 = exp2f(-8.0f * (float)(3 * ux + 3) / 12.0f) * LOG2E; kt_hi = 4 * uy + 3; kt_lo = 0; }
        else { q0w = uy * 256 + wave * 32; qcol = C_QD + ux * 64; kcol = C_KD + ux * 64; vcol = C_VD + ux * 64; ycol = 768 + ux * 64; kt_hi = 4 * uy + 3; kt_lo = 0; }
        const int qpos = q0w + r32;
        bf16x8_t qf[4];
        { const bf16* qp = Pb + (size_t)qpos * NP + qcol + 8 * hi;
#pragma unroll
          for (int ks = 0; ks < 4; ++ks) qf[ks] = *(const bf16x8_t*)(qp + 16 * ks); }
        {
            const float qs = (kind == 3) ? 0.125f : 0.125f * LOG2E;
            typedef unsigned u32x4_t __attribute__((ext_vector_type(4)));
#pragma unroll
            for (int ks = 0; ks < 4; ++ks) { u32x4_t w = __builtin_bit_cast(u32x4_t, qf[ks]);
#pragma unroll
                for (int i = 0; i < 4; ++i) w[i] = cvtpk(__uint_as_float(w[i] << 16) * qs, __uint_as_float(w[i] & 0xffff0000u) * qs);
                qf[ks] = __builtin_bit_cast(bf16x8_t, w); }
        }
        float sb[16];
#pragma unroll
        for (int r = 0; r < 16; ++r) sb[r] = slope2 * (float)((r & 3) + 8 * (r >> 2));
        unsigned bm = 0u;
        if (kind == 2) {
            const int own = uy;
            for (int e = tid; e < 32 * 64; e += NTHR) { const int row = e >> 6, d = e & 63; s_km[row * AT_KP + d] = (row < 16) ? (bf16)f2bf(kmean[((b * 4 + ux) * 16 + row) * 64 + d]) : (bf16)0; }
            __syncthreads();
            f32x16_t gacc;
#pragma unroll
            for (int r = 0; r < 16; ++r) gacc[r] = 0.f;
#pragma unroll
            for (int ks = 0; ks < 4; ++ks) { const bf16x8_t a = *(const bf16x8_t*)(s_km + r32 * AT_KP + 16 * ks + 8 * hi); gacc = __builtin_amdgcn_mfma_f32_32x32x16_bf16(a, qf[ks], gacc, 0, 0, 0); }
            float gt[16];
#pragma unroll
            for (int r = 0; r < 8; ++r) { const float mine = gacc[r], other = xlane32(mine); const int bi = crow(r, 0);
                gt[bi] = hi ? other : mine; gt[bi + 4] = hi ? mine : other; }
#pragma unroll
            for (int n = 0; n < 16; ++n) if (n >= own) gt[n] = -INFINITY;
#pragma unroll
            for (int rep = 0; rep < 3; ++rep) {
                float mx = -INFINITY;
#pragma unroll
                for (int n = 0; n < 16; ++n) mx = fmaxf(mx, gt[n]);
                bool done = !(mx > -INFINITY);
#pragma unroll
                for (int n = 0; n < 16; ++n) { const bool hit = !done && gt[n] == mx; if (hit) { bm |= 1u << n; gt[n] = -INFINITY; done = true; } }
            }
        }
        f32x16_t o0, o1;
#pragma unroll
        for (int r = 0; r < 16; ++r) { o0[r] = 0.f; o1[r] = 0.f; }
        float m_run = -INFINITY, l_run = 0.f, carry = 0.f;
        const bf16* kg = Pb + (size_t)skey * NP + kcol + sc * 8;
        const bf16* vg = Pb + (size_t)skey * NP + vcol + sc * 8;
        uint4 rk = *(const uint4*)(kg + (size_t)kt_hi * 64 * NP), rv = *(const uint4*)(vg + (size_t)kt_hi * 64 * NP);
        int buf = 0;
        { bf16* ks_ = (bf16*)(lds + AT_KS); bf16* vt_ = (bf16*)(lds + AT_VT);
          *(uint4*)(ks_ + skey * AT_KP + sc * 8) = rk;
          const unsigned vw[4] = {rv.x, rv.y, rv.z, rv.w};
#pragma unroll
          for (int j = 0; j < 4; ++j) { vt_[(sc * 8 + 2 * j) * AT_VP + skey] = (bf16)(vw[j] & 0xffffu); vt_[(sc * 8 + 2 * j + 1) * AT_VP + skey] = (bf16)(vw[j] >> 16); } }
        __syncthreads();
        bool wave_done = false;
        uint2 mw_next = make_uint2(0u, 0u);
        if (kind == 0) mw_next = *(const uint2*)(mask + (size_t)(b * S_ + qpos) * 512 + kt_hi * 8);
        for (int kt = kt_hi; kt >= kt_lo; --kt) {
            const bool more = kt > kt_lo;
            const uint2 mw = mw_next;
            if (kind == 0 && more) mw_next = *(const uint2*)(mask + (size_t)(b * S_ + qpos) * 512 + (kt - 1) * 8);
            if (more) { rk = *(const uint4*)(kg + (size_t)(kt - 1) * 64 * NP); rv = *(const uint4*)(vg + (size_t)(kt - 1) * 64 * NP); }
            const bf16* ks_ = (const bf16*)(lds + AT_KS + buf * AT_KS_BYTES);
            const bf16* vt_ = (const bf16*)(lds + AT_VT + buf * AT_VT_BYTES);
            bool active = (kt * 64 <= q0w + 31) && !wave_done;
            if (kind == 1) active = active && (kt * 64 + 63 >= q0w - 127);
            if (active) {
                const int kbase = kt * 64 + 4 * hi;
                f32x16_t p0, p1;
                if (kind != 3) {
                    const float cb = slope2 * (float)(kbase - qpos), cb1 = cb + 32.0f * slope2;
#pragma unroll
                    for (int r = 0; r < 16; ++r) { p0[r] = cb + sb[r]; p1[r] = cb1 + sb[r]; }
                } else {
#pragma unroll
                    for (int r = 0; r < 16; ++r) { p0[r] = 0.f; p1[r] = 0.f; }
                }
#pragma unroll
                for (int ks = 0; ks < 4; ++ks) {
                    const bf16x8_t a0 = *(const bf16x8_t*)(ks_ + r32 * AT_KP + 16 * ks + 8 * hi);
                    const bf16x8_t a1 = *(const bf16x8_t*)(ks_ + (32 + r32) * AT_KP + 16 * ks + 8 * hi);
                    p0 = __builtin_amdgcn_mfma_f32_32x32x16_bf16(a0, qf[ks], p0, 0, 0, 0);
                    p1 = __builtin_amdgcn_mfma_f32_32x32x16_bf16(a1, qf[ks], p1, 0, 0, 0);
                }
                if (kind != 3) {
                    float mx = -INFINITY;
                    if (kind == 0) {
                        const unsigned w0 = mw.x >> (4 * hi), w1 = mw.y >> (4 * hi);
#pragma unroll
                        for (int r = 0; r < 16; ++r) { const int off = (r & 3) + 8 * (r >> 2);
                            p0[r] = (w0 & (1u << off)) ? p0[r] : -INFINITY; p1[r] = (w1 & (1u << off)) ? p1[r] : -INFINITY; mx = vmax3(mx, p0[r], p1[r]); }
                    } else if (kind == 1) {
                        const int rel = qpos - kbase;
#pragma unroll
                        for (int r = 0; r < 16; ++r) { const int off = (r & 3) + 8 * (r >> 2);
                            p0[r] = ((unsigned)(rel - off) < 128u) ? p0[r] : -INFINITY; p1[r] = ((unsigned)(rel - off - 32) < 128u) ? p1[r] : -INFINITY; mx = vmax3(mx, p0[r], p1[r]); }
                    } else {
                        if ((kt >> 2) == uy) {
                            const int rel = qpos - kbase;
#pragma unroll
                            for (int r = 0; r < 16; ++r) { const int off = (r & 3) + 8 * (r >> 2);
                                p0[r] = (off <= rel) ? p0[r] : -INFINITY; p1[r] = (off + 32 <= rel) ? p1[r] : -INFINITY; mx = vmax3(mx, p0[r], p1[r]); }
                        } else {
                            const bool tile_ok = ((bm >> (kt >> 2)) & 1u) != 0u;
#pragma unroll
                            for (int r = 0; r < 16; ++r) { p0[r] = tile_ok ? p0[r] : -INFINITY; p1[r] = tile_ok ? p1[r] : -INFINITY; mx = vmax3(mx, p0[r], p1[r]); }
                        }
                    }
                    mx = vmax(mx, xlane32(mx));
                    const float m_new = vmax(m_run, mx);
                    const float m_safe = (m_new == -INFINITY) ? 0.f : m_new;
                    p0 = p0 - m_safe; p1 = p1 - m_safe;
#pragma unroll
                    for (int r = 0; r < 16; ++r) { p0[r] = __builtin_amdgcn_exp2f(p0[r]); p1[r] = __builtin_amdgcn_exp2f(p1[r]); }
                    float ls;
                    { typedef float f32x8_t __attribute__((ext_vector_type(8))); typedef float f32x4v_t __attribute__((ext_vector_type(4)));
                      const f32x16_t t16 = p0 + p1; const f32x8_t t8 = t16.lo + t16.hi; const f32x4v_t t4 = t8.lo + t8.hi; const f32x2_t t2 = t4.lo + t4.hi; ls = t2.x + t2.y; }
                    if (__any(m_new > m_run)) {
                        const float alpha = __builtin_amdgcn_exp2f(m_run - m_safe);
                        l_run *= alpha;
                        o0 = o0 * alpha; o1 = o1 * alpha;
                    }
                    l_run += ls; m_run = m_new;
                } else {
                    float run = carry;
#define SB_HALF(PX, KOFF) do { \
                    float lk[16]; \
                    _Pragma("unroll") for (int r = 0; r < 16; ++r) { \
                        const int off = (r & 3) + 8 * (r >> 2); \
                        const bool v = (kbase + off + (KOFF)) < qpos; \
                        const float z = PX[r]; \
                        const float t = 0.6931471805599453f * __builtin_amdgcn_logf(1.0f + __builtin_amdgcn_exp2f(-LOG2E * fabsf(z))); \
                        lk[r] = v ? (fminf(-z, 0.f) - t) : 0.f; \
                        PX[r] = v ? (fminf(z, 0.f) - t) : -INFINITY; } \
                    _Pragma("unroll") for (int g = 3; g >= 0; --g) { \
                        const float G = (lk[4 * g] + lk[4 * g + 1]) + (lk[4 * g + 2] + lk[4 * g + 3]); \
                        const float PG = xlane32(G); \
                        float la = run + (hi ? 0.f : PG); \
                        run += G + PG; \
                        PX[4 * g + 3] += la; la += lk[4 * g + 3]; PX[4 * g + 2] += la; la += lk[4 * g + 2]; PX[4 * g + 1] += la; la += lk[4 * g + 1]; PX[4 * g] += la; } \
                    _Pragma("unroll") for (int r = 0; r < 16; ++r) PX[r] = __builtin_amdgcn_exp2f(LOG2E * PX[r]); } while (0)
                    SB_HALF(p1, 32);
                    SB_HALF(p0, 0);
#undef SB_HALF
                    carry = run;
                }
                unsigned pw[16];
#pragma unroll
                for (int j = 0; j < 8; ++j) { pw[j] = cvtpk(p0[2 * j], p0[2 * j + 1]); pw[8 + j] = cvtpk(p1[2 * j], p1[2 * j + 1]); }
#pragma unroll
                for (int s = 0; s < 4; ++s) {
                    bf16x8_t pb; { const unsigned* q = pw + 4 * s; typedef unsigned u32x4_t __attribute__((ext_vector_type(4))); u32x4_t t4 = {q[0], q[1], q[2], q[3]}; pb = __builtin_bit_cast(bf16x8_t, t4); }
#pragma unroll
                    for (int dt = 0; dt < 2; ++dt) {
                        const bf16* vp = vt_ + (32 * dt + r32) * AT_VP + 16 * s + 4 * hi;
                        typedef short s16x4_t __attribute__((ext_vector_type(4)));
                        const s16x4_t lo = *(const s16x4_t*)vp, hi4 = *(const s16x4_t*)(vp + 8);
                        const bf16x8_t va = {lo[0], lo[1], lo[2], lo[3], hi4[0], hi4[1], hi4[2], hi4[3]};
                        if (dt == 0) o0 = __builtin_amdgcn_mfma_f32_32x32x16_bf16(va, pb, o0, 0, 0, 0);
                        else         o1 = __builtin_amdgcn_mfma_f32_32x32x16_bf16(va, pb, o1, 0, 0, 0);
                    }
                }
            }
            if (kind == 3) {
                const float cm = carry;
                if (__all(cm < -110.0f) || !(kt * 64 <= q0w + 31) ) { if (__all(cm < -110.0f)) wave_done = true; }
            }
            if (more) {
                bf16* ksn = (bf16*)(lds + AT_KS + (buf ^ 1) * AT_KS_BYTES); bf16* vtn = (bf16*)(lds + AT_VT + (buf ^ 1) * AT_VT_BYTES);
                *(uint4*)(ksn + skey * AT_KP + sc * 8) = rk;
                const unsigned vw[4] = {rv.x, rv.y, rv.z, rv.w};
#pragma unroll
                for (int j = 0; j < 4; ++j) { vtn[(sc * 8 + 2 * j) * AT_VP + skey] = (bf16)(vw[j] & 0xffffu); vtn[(sc * 8 + 2 * j + 1) * AT_VP + skey] = (bf16)(vw[j] >> 16); }
            }
            if (kind == 3) { if (__syncthreads_and(wave_done ? 1 : 0)) break; }
            else __syncthreads();
            buf ^= 1;
        }
        float inv;
        if (kind == 3) inv = 1.0f;
        else {
            float lt = l_run + xlane32(l_run);
            if (kind == 1) { const float mf = fmaxf(m_run, sink2); const float sc2 = exp2f(m_run - mf); lt = lt * sc2 + exp2f(sink2 - mf); inv = sc2 / lt; }
            else inv = 1.0f / lt;
        }
        bf16* yp = ys + (size_t)(b * S_ + qpos) * 1024 + ycol + 4 * hi;
#pragma unroll
        for (int g = 0; g < 4; ++g) {
            *(uint2*)(yp + 8 * g) = make_uint2(cvtpk(o0[4 * g] * inv, o0[4 * g + 1] * inv), cvtpk(o0[4 * g + 2] * inv, o0[4 * g + 3] * inv));
            *(uint2*)(yp + 32 + 8 * g) = make_uint2(cvtpk(o1[4 * g] * inv, o1[4 * g + 1] * inv), cvtpk(o1[4 * g + 2] * inv, o1[4 * g + 3] * inv));
        }
    }
}
__device__ void attn_fast_phase(int WV_, const bf16* P, const unsigned char* mask, const float* kmean, const float* sinks, bf16* ys,
                                const unsigned* utab, unsigned* counter, unsigned char* lds) {
    volatile unsigned* s_unit = (volatile unsigned*)(lds + AT_MISC);
    for (;;) {
        __syncthreads();
        if (LTID(WV_) == 0) s_unit[0] = atomicAdd(counter, 1u);
        __syncthreads();
        const unsigned ui = s_unit[0];
        if (ui >= 512u) break;
        const unsigned ue = utab[ui];
        const int kind = (int)(ue >> 30), b = (int)((ue >> 28) & 3u), ux = (int)((ue >> 8) & 255u), uy = (int)(ue & 255u);
        if (kind == 0) attn_unit<0>(WV_, P, mask, kmean, sinks, ys, lds, b, ux, uy);
        else attn_unit<2>(WV_, P, mask, kmean, sinks, ys, lds, b, ux, uy);
    }
    for (int u = LBID(); u < 256; u += LGRID()) { __syncthreads(); attn_unit<3>(WV_, P, mask, kmean, sinks, ys, lds, u >> 6, (u >> 4) & 3, u & 15); }
    for (int u = LBID(); u < 256; u += LGRID()) { __syncthreads(); attn_unit<1>(WV_, P, mask, kmean, sinks, ys, lds, u >> 6, (u >> 5) & 1, u & 31); }
}

constexpr float U_SCALE = 64.0f, V_SCALE = 16.0f;
__device__ __forceinline__ float rdlane_f(float v, int l) { return __builtin_bit_cast(float, __builtin_amdgcn_readlane(__builtin_bit_cast(int, v), l)); }
__device__ __forceinline__ unsigned pk4_fp8(float a, float b, float c, float d) { int v = 0; v = __builtin_amdgcn_cvt_pk_fp8_f32(a, b, v, false); v = __builtin_amdgcn_cvt_pk_fp8_f32(c, d, v, true); return (unsigned)v; }
__device__ __forceinline__ void unpack16_fp8(const uint4 v, float* o) {
    const unsigned w[4] = {v.x, v.y, v.z, v.w};
#pragma unroll
    for (int i = 0; i < 4; ++i) { const f32x2_t lo = __builtin_amdgcn_cvt_pk_f32_fp8((int)w[i], false), hi2 = __builtin_amdgcn_cvt_pk_f32_fp8((int)w[i], true);
        o[4 * i] = lo.x; o[4 * i + 1] = lo.y; o[4 * i + 2] = hi2.x; o[4 * i + 3] = hi2.y; }
}
__device__ void convert_tables(int WV_, const Params& p) {
    const size_t nchunk = (size_t)DEPTH_ * 16384 * 2 * 64;
    for (size_t i = (size_t)LBID() * NTHR + LTID(WV_); i < nchunk; i += (size_t)LGRID() * NTHR) {
        const int c = (int)(i & 63), uvsel = (int)((i >> 6) & 1); const size_t le = i >> 7;
        const float* src = (uvsel ? p.in[10] : p.in[9]) + le * 1024 + c * 16;
        const float sc = uvsel ? V_SCALE : U_SCALE;
        const float4 a = ((const float4*)src)[0], b = ((const float4*)src)[1], cc = ((const float4*)src)[2], d = ((const float4*)src)[3];
        *(uint4*)(p.ws + WS_UV + le * 2048 + uvsel * 1024 + c * 16) = make_uint4(pk4_fp8(a.x * sc, a.y * sc, a.z * sc, a.w * sc), pk4_fp8(b.x * sc, b.y * sc, b.z * sc, b.w * sc),
                                                                               pk4_fp8(cc.x * sc, cc.y * sc, cc.z * sc, cc.w * sc), pk4_fp8(d.x * sc, d.y * sc, d.z * sc, d.w * sc));
    }
}
__device__ void peer_fast_phase(int WV_, float* h, bf16* hb, const int* eid, const float* gate, const unsigned char* uv, const float* g1, const float* b1, const float* g, const float* bb, unsigned char* lds) {
    const int tid = LTID(WV_), lane = tid & 63, wave = tid >> 6;
    for (int t = LBID() * NWAVE + wave; t < T_; t += LGRID() * NWAVE) {
        float* hr = h + (size_t)t * 1024 + lane * 16;
        float x[16], acc[16];
        { const float4 a0 = ((const float4*)hr)[0], a1 = ((const float4*)hr)[1], a2 = ((const float4*)hr)[2], a3 = ((const float4*)hr)[3];
          x[0] = a0.x; x[1] = a0.y; x[2] = a0.z; x[3] = a0.w; x[4] = a1.x; x[5] = a1.y; x[6] = a1.z; x[7] = a1.w;
          x[8] = a2.x; x[9] = a2.y; x[10] = a2.z; x[11] = a2.w; x[12] = a3.x; x[13] = a3.y; x[14] = a3.z; x[15] = a3.w; }
        {
            float s = 0.f;
#pragma unroll
            for (int i = 0; i < 16; ++i) s += x[i];
            const float mean = wave_sum(s) * (1.0f / 1024.0f);
            float s2 = 0.f;
#pragma unroll
            for (int i = 0; i < 16; ++i) { x[i] -= mean; s2 += x[i] * x[i]; }
            const float rstd = 1.0f / sqrtf(wave_sum(s2) * (1.0f / 1024.0f) + LN_EPS);
#pragma unroll
            for (int q4 = 0; q4 < 4; ++q4) { const float4 gg = ((const float4*)(g1 + lane * 16))[q4], cc = ((const float4*)(b1 + lane * 16))[q4];
                x[4 * q4] = x[4 * q4] * rstd * gg.x + cc.x; x[4 * q4 + 1] = x[4 * q4 + 1] * rstd * gg.y + cc.y; x[4 * q4 + 2] = x[4 * q4 + 2] * rstd * gg.z + cc.z; x[4 * q4 + 3] = x[4 * q4 + 3] * rstd * gg.w + cc.w; }
        }
#pragma unroll
        for (int i = 0; i < 16; ++i) acc[i] = 0.f;
#pragma unroll 1
        for (int batch = 0; batch < 4; ++batch) {
            const int my_eid = eid[(size_t)t * 128 + batch * 32 + (lane & 31)];
            const float my_gate = gate[(size_t)t * 128 + batch * 32 + (lane & 31)];
            float* pl = (float*)lds + wave * 2048;
#pragma unroll 1
            for (int grp = 0; grp < 4; ++grp) {
                uint4 ua[8];
#pragma unroll
                for (int i = 0; i < 8; ++i) { const int id = __shfl(my_eid, grp * 8 + i); ua[i] = *(const uint4*)(uv + (size_t)id * 2048 + lane * 16); }
#pragma unroll
                for (int i = 0; i < 8; ++i) {
                    float f[16]; unpack16_fp8(ua[i], f);
                    float d0 = 0.f, d1 = 0.f;
#pragma unroll
                    for (int j = 0; j < 8; ++j) { d0 += f[j] * x[j]; d1 += f[8 + j] * x[8 + j]; }
                    pl[(grp * 8 + i) * 64 + lane] = d0 + d1;
                }
            }
            float d;
            { const float4* pr = (const float4*)(pl + (lane & 31) * 64); float4 s4 = pr[0];
#pragma unroll
              for (int i = 1; i < 16; ++i) { const float4 v = pr[i]; s4.x += v.x; s4.y += v.y; s4.z += v.z; s4.w += v.w; }
              d = ((s4.x + s4.y) + (s4.z + s4.w)) * (1.0f / U_SCALE); }
            const float hv = 0.5f * d * (1.0f + erff(d * 0.70710678118654752f)) * my_gate * (1.0f / V_SCALE);
#pragma unroll 1
            for (int grp = 0; grp < 4; ++grp) {
                uint4 va[8];
#pragma unroll
                for (int i = 0; i < 8; ++i) { const int id = __shfl(my_eid, grp * 8 + i); va[i] = *(const uint4*)(uv + (size_t)id * 2048 + 1024 + lane * 16); }
#pragma unroll
                for (int i = 0; i < 8; ++i) {
                    const float c = __shfl(hv, grp * 8 + i);
                    float f[16]; unpack16_fp8(va[i], f);
#pragma unroll
                    for (int j = 0; j < 16; ++j) acc[j] += c * f[j];
                }
            }
        }
        float y[16], s = 0.f;
#pragma unroll
        for (int i = 0; i < 16; ++i) { y[i] = ALPHA * x[i] + acc[i]; s += y[i]; }
        const float mean = wave_sum(s) * (1.0f / 1024.0f);
        float s2 = 0.f;
#pragma unroll
        for (int i = 0; i < 16; ++i) { y[i] -= mean; s2 += y[i] * y[i]; }
        const float rstd = 1.0f / sqrtf(wave_sum(s2) * (1.0f / 1024.0f) + LN_EPS);
        float o[16];
#pragma unroll
        for (int q4 = 0; q4 < 4; ++q4) {
            const float4 gg = ((const float4*)(g + lane * 16))[q4], cc = ((const float4*)(bb + lane * 16))[q4];
            o[4 * q4] = y[4 * q4] * rstd * gg.x + cc.x; o[4 * q4 + 1] = y[4 * q4 + 1] * rstd * gg.y + cc.y; o[4 * q4 + 2] = y[4 * q4 + 2] * rstd * gg.z + cc.z; o[4 * q4 + 3] = y[4 * q4 + 3] * rstd * gg.w + cc.w;
            ((float4*)hr)[q4] = make_float4(o[4 * q4], o[4 * q4 + 1], o[4 * q4 + 2], o[4 * q4 + 3]);
        }
        uint4* hbp = (uint4*)(hb + (size_t)t * 1024 + lane * 16);
        hbp[0] = make_uint4(pk2(o[0], o[1]), pk2(o[2], o[3]), pk2(o[4], o[5]), pk2(o[6], o[7]));
        hbp[1] = make_uint4(pk2(o[8], o[9]), pk2(o[10], o[11]), pk2(o[12], o[13]), pk2(o[14], o[15]));
    }
}


__device__ __forceinline__ float pack_pl(float v, unsigned pl) { return __uint_as_float((__float_as_uint(v) & ~127u) | pl); }
__device__ __forceinline__ void ins16(float (&s)[16], float x) {
#pragma unroll
    for (int k = 15; k >= 1; --k) s[k] = __builtin_amdgcn_fmed3f(s[k - 1], x, s[k]);
    s[0] = vmax(s[0], x);
}
template <int D> __device__ __forceinline__ void bitonic_stage(float (&c)[16]) {
#pragma unroll
    for (int i = 0; i < 16; ++i) if ((i & D) == 0) { const float a = vmax(c[i], c[i + D]), b = vmin(c[i], c[i + D]); c[i] = a; c[i + D] = b; }
}
__device__ __forceinline__ int decode_key(unsigned pl) { return (int)(32u * ((pl >> 4) & 3u) + (pl & 3u) + 8u * ((pl >> 2) & 3u) + 4u * ((pl >> 6) & 1u)); }
__device__ void route_fast_phase(int WV_, const bf16* qb, const bf16* skb  , int* eid, float* gate, unsigned char* lds) {
    const int tid = LTID(WV_), lane = tid & 63, wave = tid >> 6, r32 = lane & 31, hi = lane >> 5;
    unsigned* lidx = (unsigned*)lds + wave * (64 * 33) + lane * 33;
    for (int unit = LBID() * NWAVE + wave; unit < (T_ / 32) * 8; unit += LGRID() * NWAVE) {
        const int h = unit & 7, t = (unit >> 3) * 32 + r32;
        float sl[2][16];
#pragma unroll
        for (int p = 0; p < 2; ++p) {
            bf16x8_t qf[4];
            { const bf16* qp = qb + (size_t)t * 1024 + h * 128 + p * 64 + 8 * hi;
#pragma unroll
              for (int ks = 0; ks < 4; ++ks) qf[ks] = *(const bf16x8_t*)(qp + 16 * ks); }
            float s[16];
#pragma unroll
            for (int k = 0; k < 16; ++k) s[k] = -INFINITY;
            const bf16* skp = skb + ((size_t)(h * 2 + p) * 128 + r32) * 64 + 8 * hi;
#pragma unroll
            for (int kt = 0; kt < 4; ++kt) {
                f32x16_t acc;
#pragma unroll
                for (int r = 0; r < 16; ++r) acc[r] = 0.f;
#pragma unroll
                for (int ks = 0; ks < 4; ++ks) { const bf16x8_t a = *(const bf16x8_t*)(skp + (size_t)kt * 32 * 64 + 16 * ks); acc = __builtin_amdgcn_mfma_f32_32x32x16_bf16(a, qf[ks], acc, 0, 0, 0); }
#pragma unroll
                for (int r = 0; r < 16; ++r) ins16(s, pack_pl(acc[r], (unsigned)(kt * 16 + r)));
            }
            const unsigned hb = (unsigned)hi << 6;
#pragma unroll
            for (int k = 0; k < 16; ++k) s[k] = __uint_as_float(__float_as_uint(s[k]) | hb);
            float c[16];
#pragma unroll
            for (int k = 0; k < 16; ++k) c[k] = vmax(s[k], __shfl_xor(s[15 - k], 32));
            bitonic_stage<8>(c); bitonic_stage<4>(c); bitonic_stage<2>(c); bitonic_stage<1>(c);
#pragma unroll
            for (int k = 0; k < 16; ++k) { sl[p][k] = c[k]; lidx[p * 16 + k] = (unsigned)decode_key(__float_as_uint(c[k]) & 127u); }
        }
        float w[16];
#pragma unroll
        for (int k = 0; k < 16; ++k) w[k] = -INFINITY;
#pragma unroll
        for (int i = 0; i < 16; ++i)
#pragma unroll
            for (int j = 0; j < 16; ++j)
                if ((i + 1) * (j + 1) <= 16) { const float v = sl[0][i] + sl[1][j]; ins16(w, __uint_as_float((__float_as_uint(v) & ~255u) | (unsigned)(i * 16 + j))); }
        float e[16], sum = 0.f;
#pragma unroll
        for (int k = 0; k < 16; ++k) { e[k] = expf(w[k] - w[0]); sum += e[k]; }
        const float inv = 1.0f / sum;
        int ide[8]; float gte[8];
#pragma unroll
        for (int k = 0; k < 8; ++k) {
            float wa = w[k], wb = w[8 + k], ea = e[k], eb = e[8 + k];
            asm volatile("" : "+v"(wa), "+v"(wb), "+v"(ea), "+v"(eb));
            const float wv = hi ? wb : wa;
            const unsigned pl = __float_as_uint(wv) & 255u;
            ide[k] = (int)(lidx[pl >> 4] * 128u + lidx[16 + (pl & 15u)]);
            gte[k] = (hi ? eb : ea) * inv;
        }
        int* ep = eid + (size_t)t * 128 + h * 16 + hi * 8; float* gp = gate + (size_t)t * 128 + h * 16 + hi * 8;
        *(int4*)ep = make_int4(ide[0], ide[1], ide[2], ide[3]); *(int4*)(ep + 4) = make_int4(ide[4], ide[5], ide[6], ide[7]);
        *(float4*)gp = make_float4(gte[0], gte[1], gte[2], gte[3]); *(float4*)(gp + 4) = make_float4(gte[4], gte[5], gte[6], gte[7]);
    }
}

typedef float f32x4_t __attribute__((ext_vector_type(4)));
typedef __bf16 bf16x2v __attribute__((ext_vector_type(2)));
__device__ __forceinline__ float dot2bf(unsigned a, unsigned b, float c) { return __builtin_amdgcn_fdot2_f32_bf16(__builtin_bit_cast(bf16x2v, a), __builtin_bit_cast(bf16x2v, b), c, false); }
__device__ __forceinline__ void cnt_gt(int& cnt, unsigned a, unsigned b) { asm("v_cmp_gt_u32_e32 vcc, %1, %2\n\tv_addc_co_u32_e32 %0, vcc, 0, %0, vcc" : "+v"(cnt) : "v"(a), "v"(b) : "vcc"); }
__device__ __forceinline__ void cnt_eq(int& cnt, unsigned a, unsigned b) { asm("v_cmp_eq_u32_e32 vcc, %1, %2\n\tv_addc_co_u32_e32 %0, vcc, 0, %0, vcc" : "+v"(cnt) : "v"(a), "v"(b) : "vcc"); }
__device__ __forceinline__ unsigned flag_gt(unsigned a, unsigned b) { unsigned r; asm("v_cmp_gt_u32_e32 vcc, %1, %2\n\tv_cndmask_b32_e64 %0, 0, 1, vcc" : "=v"(r) : "v"(a), "v"(b) : "vcc"); return r; }
__device__ __forceinline__ unsigned flag_eq(unsigned a, unsigned b) { unsigned r; asm("v_cmp_eq_u32_e32 vcc, %1, %2\n\tv_cndmask_b32_e64 %0, 0, 1, vcc" : "=v"(r) : "v"(a), "v"(b) : "vcc"); return r; }
__device__ __forceinline__ void cnt_ge(int& cnt, unsigned key, unsigned cand) { asm("v_cmp_ge_u32_e32 vcc, %1, %2\n\tv_addc_co_u32_e32 %0, vcc, 0, %0, vcc" : "+v"(cnt) : "v"(key), "v"(cand) : "vcc"); }

typedef __attribute__((address_space(3))) unsigned lds_u32;
template <int SHIFT> __device__ __forceinline__ unsigned radix_pass(const unsigned (&key)[64], unsigned pre, lds_u32* hist, int lane, int& need) {
    typedef unsigned u32x4v __attribute__((ext_vector_type(4)));
    typedef __attribute__((address_space(3))) u32x4v lds_u32x4;
    { const u32x4v z4 = {0u, 0u, 0u, 0u};
#pragma unroll
      for (int i = 0; i < 8; ++i) ((lds_u32x4*)(hist + lane * 32))[i] = z4; }
    const unsigned cp = (unsigned)(lane & 7);
#pragma unroll
    for (int j = 0; j < 64; ++j) {
        const unsigned d = (key[j] >> SHIFT) & 255u;
        bool m;
        if (SHIFT == 24) m = key[j] != 0u; else m = (key[j] >> ((SHIFT + 8) & 31)) == pre;
        if (m) __hip_atomic_fetch_add(hist + ((d << 3) | cp), 1u, __ATOMIC_RELAXED, __HIP_MEMORY_SCOPE_WORKGROUP);
    }
    unsigned dsum[4]; unsigned sumL = 0u;
#pragma unroll
    for (int i = 0; i < 4; ++i) { const u32x4v v0 = ((const lds_u32x4*)(hist + lane * 32))[2 * i], v1 = ((const lds_u32x4*)(hist + lane * 32))[2 * i + 1];
        dsum[i] = ((v0.x + v0.y) + (v0.z + v0.w)) + ((v1.x + v1.y) + (v1.z + v1.w)); sumL += dsum[i]; }
    unsigned incl = sumL;
#pragma unroll
    for (int o = 1; o < 64; o <<= 1) { const unsigned t = (unsigned)__shfl_down((int)incl, o); if (lane + o < 64) incl += t; }
    const unsigned above = incl - sumL;
    const bool own = (above < (unsigned)need) && ((unsigned)need <= above + sumL);
    const int owner = __ffsll((long long)__ballot(own)) - 1;
    unsigned acc = above; int sel = -1; unsigned cab = 0u;
#pragma unroll
    for (int i = 3; i >= 0; --i) { const unsigned c = dsum[i]; const bool hit = (sel < 0) && (acc + c >= (unsigned)need); cab = hit ? acc : cab; sel = hit ? i : sel; acc += c; }
    const int ow = owner < 0 ? 0 : owner;
    const unsigned digit = (unsigned)__builtin_amdgcn_readlane(sel, ow) + (unsigned)(4 * ow);
    need -= (int)__builtin_amdgcn_readlane((int)cab, ow);
    return digit;
}
#ifndef TS_SEL
#define TS_SEL 0
#endif
#define ITS_B() do { if (TS_SEL >= 20 && TS_SEL <= 25 && WV_ == 0 && LANEID() == 0) ((volatile __attribute__((address_space(3))) unsigned long long*)((__attribute__((address_space(3))) unsigned char*)lds + 147456 - 16 - 32))[0] = __builtin_amdgcn_s_memrealtime(); } while (0)
#define ITS_E(k) do { if ((k) == TS_SEL && WV_ == 0 && LANEID() == 0) { volatile __attribute__((address_space(3))) unsigned long long* w_ = (volatile __attribute__((address_space(3))) unsigned long long*)((__attribute__((address_space(3))) unsigned char*)lds + 147456 - 16 - 32); w_[1] += __builtin_amdgcn_s_memrealtime() - w_[0]; } } while (0)
__device__ void index_fast_phase(int WV_, const bf16* P, unsigned char* mask, float* kmean, float* scratch_all, unsigned char* lds) {
    const int tid = LTID(WV_), lane = tid & 63, wave = tid >> 6, bid = LBID(), G = LGRID();
    float* s_part = (float*)lds;
    ITS_B();
    for (int k = bid; k < 256; k += G) {
        const int b = k >> 6, h = (k >> 4) & 3, blk = k & 15;
        const bf16* kp = P + (size_t)(b * S_ + blk * 256 + wave * 32) * NP + C_KC + h * 64 + lane;
        float a = 0.f;
#pragma unroll 8
        for (int j = 0; j < 32; ++j) a += bf2f(kp[(size_t)j * NP]);
        __syncthreads();
        s_part[wave * 64 + lane] = a;
        __syncthreads();
        if (tid < 64) { float s = 0.f;
#pragma unroll
            for (int w = 0; w < 8; ++w) s += s_part[w * 64 + tid];
            kmean[((b * 4 + h) * 16 + blk) * 64 + tid] = s * (1.0f / 256.0f); }
    }
    ITS_E(22);
    float* scr = scratch_all + (size_t)bid * (16 * 4096);
    const int lq = lane & 15, g4 = lane >> 4;
    for (int ui = bid; ui < 1024; ui += G) {
        const int b = ui >> 8, k = ui & 255, tile = (b & 1) ? 255 - k : k, q0 = tile * 16;
        const bf16* Pb = P + (size_t)b * S_ * NP;
        const int ntiles = tile + 1;
        ITS_B();
        bf16x8_t qf[8]; float wi[8];
        { const bf16* qp = Pb + (size_t)(q0 + lq) * NP + C_QI + 8 * g4;
#pragma unroll
          for (int h = 0; h < 8; ++h) qf[h] = *(const bf16x8_t*)(qp + 32 * h);
          const uint4 wv = *(const uint4*)(Pb + (size_t)(q0 + lq) * NP + C_WI); unpack8(wv, wi); }
        {
            bf16x8_t afn = *(const bf16x8_t*)(Pb + (size_t)((wave < ntiles ? wave : 0) * 16 + lq) * NP + C_KI + 8 * g4);
            for (int kt = wave; kt < ntiles; kt += NWAVE) {
                const bf16x8_t af = afn;
                { const int ktn = (kt + NWAVE < ntiles) ? kt + NWAVE : kt; afn = *(const bf16x8_t*)(Pb + (size_t)(ktn * 16 + lq) * NP + C_KI + 8 * g4); }
                f32x4_t a[8];
                const f32x4_t z = {0.f, 0.f, 0.f, 0.f};
#pragma unroll
                for (int h = 0; h < 8; ++h) a[h] = __builtin_amdgcn_mfma_f32_16x16x32_bf16(af, qf[h], z, 0, 0, 0);
                __builtin_amdgcn_sched_barrier(0);
                f32x4_t sc = {0.f, 0.f, 0.f, 0.f};
#pragma unroll
                for (int h = 0; h < 8; ++h)
#pragma unroll
                    for (int r = 0; r < 4; ++r) { float rl; asm("v_max_f32_e32 %0, 0, %1" : "=v"(rl) : "v"(a[h][r])); sc[r] += rl * wi[h]; }
#pragma unroll
                for (int r = 0; r < 4; ++r) { sc[r] *= 0.0625f; if (sc[r] == 0.f) sc[r] = 0.f; }
                *(f32x4_t*)(scr + (size_t)lq * 4096 + kt * 16 + 4 * g4) = sc;
            }
        }
        __threadfence_block();
        __syncthreads();
        __threadfence_block();
        ITS_E(20); ITS_B();
        lds_u32* hist = (lds_u32*)((__attribute__((address_space(3))) unsigned char*)lds + 2048) + wave * 2048;
#pragma unroll 1
        for (int qi = 0; qi < 2; ++qi) {
            const int ql = 2 * wave + qi, q = q0 + ql;
            const float* row = scr + (size_t)ql * 4096 + lane * 64;
            const int qrel = q - lane * 64;
            unsigned key[64];
            if (qrel >= 0) {
#pragma unroll
                for (int j4 = 0; j4 < 16; ++j4) {
                    const float4 v = ((const float4*)row)[j4];
                    const unsigned u[4] = {__float_as_uint(v.x), __float_as_uint(v.y), __float_as_uint(v.z), __float_as_uint(v.w)};
#pragma unroll
                    for (int e = 0; e < 4; ++e) { const unsigned t = u[e] ^ ((unsigned)((int)u[e] >> 31) | 0x80000000u); const unsigned inval = (unsigned)((qrel - (j4 * 4 + e)) >> 31); key[j4 * 4 + e] = t & ~inval; }
                    if ((j4 & 3) == 3) asm volatile("" ::: "memory");
                }
            } else {
#pragma unroll
                for (int j = 0; j < 64; ++j) key[j] = 0u;
            }
            ITS_E(23); ITS_B();
            unsigned wlo = 0u, whi = 0u;
            if (q + 1 > 256) {
                int need = 256;
                const unsigned d1 = radix_pass<24>(key, 0u, hist, lane, need);
                const unsigned d2 = radix_pass<16>(key, d1, hist, lane, need);
                const unsigned d3 = radix_pass<8>(key, (d1 << 8) | d2, hist, lane, need);
                const unsigned d4 = radix_pass<0>(key, (d1 << 16) | (d2 << 8) | d3, hist, lane, need);
                const unsigned prefix = (d1 << 24) | (d2 << 16) | (d3 << 8) | d4;
                ITS_E(24); ITS_B();
                int ceq = 0;
#pragma unroll
                for (int j = 0; j < 64; ++j) cnt_eq(ceq, key[j], prefix);
                ceq = wave_sum_i(ceq);
                int X = 4096;
                if (ceq != need) {
                    int X0 = 0;
#pragma unroll 1
                    for (int bit = 11; bit >= 0; --bit) {
                        const int c = X0 | (1 << bit);
                        int cnt = 0; const int crel = c - lane * 64;
#pragma unroll
                        for (int j = 0; j < 64; ++j) cnt_eq(cnt, (key[j] ^ prefix) | ~(unsigned)((j - crel) >> 31), 0u);
                        cnt = wave_sum_i(cnt);
                        if (cnt < need) X0 = c;
                    }
                    X = X0 + 1;
                }
                const int xrel = X - lane * 64;
#pragma unroll
                for (int j = 0; j < 32; ++j) {
                    const unsigned s0 = flag_gt(key[j], prefix) | flag_eq((key[j] ^ prefix) | ~(unsigned)((j - xrel) >> 31), 0u);
                    const unsigned s1 = flag_gt(key[32 + j], prefix) | flag_eq((key[32 + j] ^ prefix) | ~(unsigned)((32 + j - xrel) >> 31), 0u);
                    wlo |= s0 << j; whi |= s1 << j;
                }
            } else {
#pragma unroll
                for (int j = 0; j < 32; ++j) { wlo |= (~(unsigned)((qrel - j) >> 31) & 1u) << j; whi |= (~(unsigned)((qrel - 32 - j) >> 31) & 1u) << j; }
            }
            ((uint2*)(mask + (size_t)(b * S_ + q) * 512))[lane] = make_uint2(wlo, whi);
            ITS_E(25); ITS_B();
        }
        ITS_E(21);
        __syncthreads();
    }
}

constexpr int MG_P = 72;
constexpr int MG_TILE_BYTES = 128 * MG_P * 2;
__device__ void merge_fast_phase(int WV_, const bf16* P, const bf16* ys, const bf16* wbt  , bf16* merged, unsigned char* lds) {
    const int tid = LTID(WV_), lane = tid & 63, wave = tid >> 6, r32 = lane & 31, hi = lane >> 5, wt = wave & 3, wd = wave >> 2;
    const int srow0 = tid >> 3, sch = tid & 7;
    for (int tile = LBID(); tile < 1024; tile += LGRID()) {
        const int tok0 = (tile >> 3) * 128, d0 = (tile & 7) * 128;
        f32x16_t mer[2], acc[2];
#pragma unroll
        for (int r = 0; r < 16; ++r) { mer[0][r] = 0.f; mer[1][r] = 0.f; acc[0][r] = 0.f; acc[1][r] = 0.f; }
        uint4 RW00, RW01, RW10, RW11, RY00, RY01, RY10, RY11, RG0, RG1, RG2, RG3;
        bf16* gl = (bf16*)(lds + 4 * MG_TILE_BYTES);
        const int grow = tid >> 4, gch = tid & 15;
#define MG_GLOAD(st_, R_) do { const int n_ = (st_) >> 2, kc_ = (st_) & 3; \
            RW##R_##0 = *(const uint4*)(wbt + ((size_t)n_ * 1024 + d0 + srow0) * 256 + kc_ * 64 + sch * 8); \
            RW##R_##1 = *(const uint4*)(wbt + ((size_t)n_ * 1024 + d0 + srow0 + 64) * 256 + kc_ * 64 + sch * 8); \
            RY##R_##0 = *(const uint4*)(ys + (size_t)(tok0 + srow0) * 1024 + n_ * 256 + kc_ * 64 + sch * 8); \
            RY##R_##1 = *(const uint4*)(ys + (size_t)(tok0 + srow0 + 64) * 1024 + n_ * 256 + kc_ * 64 + sch * 8); } while (0)
#define MG_SSTORE(buf_, R_) do { bf16* wl_ = (bf16*)(lds + (buf_) * 2 * MG_TILE_BYTES); bf16* yl_ = (bf16*)(lds + (buf_) * 2 * MG_TILE_BYTES + MG_TILE_BYTES); \
            *(uint4*)(wl_ + srow0 * MG_P + sch * 8) = RW##R_##0; *(uint4*)(wl_ + (srow0 + 64) * MG_P + sch * 8) = RW##R_##1; \
            *(uint4*)(yl_ + srow0 * MG_P + sch * 8) = RY##R_##0; *(uint4*)(yl_ + (srow0 + 64) * MG_P + sch * 8) = RY##R_##1; } while (0)
        __syncthreads();
        MG_GLOAD(0, 0); MG_GLOAD(1, 1);
        MG_SSTORE(0, 0);
        __syncthreads();
#define MG_STAGE(PAR_, OTH_) do { const int buf = PAR_; \
            if (st + 2 < 16) MG_GLOAD(st + 2, PAR_); \
            if ((st & 3) == 1) { const bf16* gsrc = P + (size_t)(tok0 + grow) * NP + C_G + (st >> 2) * 1024 + d0 + gch * 8; \
                RG0 = *(const uint4*)gsrc; RG1 = *(const uint4*)(gsrc + (size_t)32 * NP); RG2 = *(const uint4*)(gsrc + (size_t)64 * NP); RG3 = *(const uint4*)(gsrc + (size_t)96 * NP); } \
            const bf16* wl = (const bf16*)(lds + buf * 2 * MG_TILE_BYTES); const bf16* yl = (const bf16*)(lds + buf * 2 * MG_TILE_BYTES + MG_TILE_BYTES); \
            _Pragma("unroll") for (int ks = 0; ks < 4; ++ks) { \
                const bf16x8_t bq = *(const bf16x8_t*)(yl + (32 * wt + r32) * MG_P + 16 * ks + 8 * hi); \
                const bf16x8_t a0 = *(const bf16x8_t*)(wl + (64 * wd + r32) * MG_P + 16 * ks + 8 * hi); \
                const bf16x8_t a1 = *(const bf16x8_t*)(wl + (64 * wd + 32 + r32) * MG_P + 16 * ks + 8 * hi); \
                acc[0] = __builtin_amdgcn_mfma_f32_32x32x16_bf16(a0, bq, acc[0], 0, 0, 0); \
                acc[1] = __builtin_amdgcn_mfma_f32_32x32x16_bf16(a1, bq, acc[1], 0, 0, 0); } \
            if ((st & 3) == 3) { \
                const int n = st >> 2; \
                const bf16* gp = gl + (32 * wt + r32) * 136 + 64 * wd + 4 * hi; (void)n; \
                _Pragma("unroll") for (int dt = 0; dt < 2; ++dt) \
                _Pragma("unroll") for (int g = 0; g < 4; ++g) { \
                        const uint2 gv = *(const uint2*)(gp + 32 * dt + 8 * g); \
                        const float g0 = __uint_as_float(gv.x << 16), g1 = __uint_as_float(gv.x & 0xffff0000u), g2 = __uint_as_float(gv.y << 16), g3 = __uint_as_float(gv.y & 0xffff0000u); \
                        mer[dt][4 * g + 0] += acc[dt][4 * g + 0] * __builtin_amdgcn_rcpf(1.f + __builtin_amdgcn_exp2f(-LOG2E * g0)); \
                        mer[dt][4 * g + 1] += acc[dt][4 * g + 1] * __builtin_amdgcn_rcpf(1.f + __builtin_amdgcn_exp2f(-LOG2E * g1)); \
                        mer[dt][4 * g + 2] += acc[dt][4 * g + 2] * __builtin_amdgcn_rcpf(1.f + __builtin_amdgcn_exp2f(-LOG2E * g2)); \
                        mer[dt][4 * g + 3] += acc[dt][4 * g + 3] * __builtin_amdgcn_rcpf(1.f + __builtin_amdgcn_exp2f(-LOG2E * g3)); } \
                _Pragma("unroll") for (int r = 0; r < 16; ++r) { acc[0][r] = 0.f; acc[1][r] = 0.f; } } \
            if (st + 1 < 16) MG_SSTORE(OTH_, OTH_); \
            if ((st & 3) == 2) { *(uint4*)(gl + grow * 136 + gch * 8) = RG0; *(uint4*)(gl + (grow + 32) * 136 + gch * 8) = RG1; *(uint4*)(gl + (grow + 64) * 136 + gch * 8) = RG2; *(uint4*)(gl + (grow + 96) * 136 + gch * 8) = RG3; } \
            __syncthreads(); } while (0)
#pragma unroll 1
        for (int st2 = 0; st2 < 16; st2 += 2) { { const int st = st2; MG_STAGE(0, 1); } { const int st = st2 + 1; MG_STAGE(1, 0); } }
#undef MG_STAGE
#undef MG_GLOAD
#undef MG_SSTORE
        bf16* mp = merged + (size_t)(tok0 + 32 * wt + r32) * 1024 + d0 + 64 * wd + 4 * hi;
#pragma unroll
        for (int dt = 0; dt < 2; ++dt)
#pragma unroll
            for (int g = 0; g < 4; ++g)
                *(uint2*)(mp + 32 * dt + 8 * g) = make_uint2(cvtpk(mer[dt][4 * g], mer[dt][4 * g + 1]), cvtpk(mer[dt][4 * g + 2], mer[dt][4 * g + 3]));
    }
}
#define LAS __attribute__((address_space(3)))
#define XB_TMO      128
#define XB_XCNT(j)  (256  + 64 * (j))
#define XB_XSUB(j)  (1280 + 64 * (j))
#define XB_XGEN(j)  (2304 + 64 * (j))
#define XB_TOP      3328
#define XB_TOPGEN   3392
#define XCD_BAR_WORDS 3456
#define XB_SPIN_CAP (1u << 18)

__device__ __forceinline__ unsigned xb_ld(unsigned* p)              { return __hip_atomic_load(p, __ATOMIC_RELAXED, __HIP_MEMORY_SCOPE_AGENT); }
__device__ __forceinline__ unsigned xb_add(unsigned* p, unsigned v) { return __hip_atomic_fetch_add(p, v, __ATOMIC_RELAXED, __HIP_MEMORY_SCOPE_AGENT); }
__device__ __forceinline__ unsigned xb_xcc_id() { return (unsigned)__builtin_amdgcn_s_getreg((3 << 11) | 20) & 0xFu; }
#define XB_SPIN(cond, bar) do { unsigned _sp = 0; while (cond) { __builtin_amdgcn_s_sleep(1); \
    if ((++_sp & 255u) == 0u) { if (xb_ld(&(bar)[XB_TMO])) break; if (_sp > XB_SPIN_CAP) { atomicAdd(&(bar)[XB_TMO], 1u); break; } } } } while (0)

struct XcdBarrier {
    unsigned* bar; unsigned x;
    volatile LAS unsigned* st;
};

__device__ __forceinline__ XcdBarrier xcd_barrier_post(unsigned* bar, volatile LAS unsigned* st) {
    XcdBarrier b; b.bar = bar; b.x = xb_xcc_id(); b.st = st;
    if (threadIdx.x == 0) (void)xb_add(&bar[XB_XCNT(b.x)], 1u);
    return b;
}
__device__ __forceinline__ void xcd_barrier_complete(unsigned* bar, unsigned x, unsigned& nloc, unsigned& nx) {
    const unsigned G = gridDim.x * gridDim.y * gridDim.z;
    unsigned sum, cnt, mine, sp = 0u;
    for (;;) {
        sum = 0u; cnt = 0u; mine = 0u;
#pragma unroll
        for (unsigned j = 0; j < 16; ++j) { const unsigned c = xb_ld(&bar[XB_XCNT(j)]); sum += c; cnt += (c > 0u) ? 1u : 0u; mine = (j == x) ? c : mine; }
        if (sum == G) break;
        __builtin_amdgcn_s_sleep(1);
        if ((++sp & 255u) == 0u) { if (xb_ld(&bar[XB_TMO])) break; if (sp > XB_SPIN_CAP) { atomicAdd(&bar[XB_TMO], 1u); break; } }
    }
    nloc = mine > 0u ? mine : 1u; nx = cnt > 0u ? cnt : 1u;
}

__device__ __forceinline__ void xcd_barrier(const XcdBarrier& b, int wv_) {
    asm volatile("s_waitcnt vmcnt(0)" ::: "memory");
    __syncthreads();
    if (wv_ == 0 && LANEID() == 0) {
        unsigned* bar = b.bar;
        __builtin_amdgcn_s_waitcnt(0);
        unsigned nloc = b.st[0], nx = b.st[1];
        if (nloc == 0u) { xcd_barrier_complete(bar, b.x, nloc, nx); b.st[0] = nloc; b.st[1] = nx; }
        const unsigned old = xb_add(&bar[XB_XSUB(b.x)], 1u);
        const unsigned gen = old / nloc;
        if (old + 1u == (gen + 1u) * nloc) {
            __builtin_amdgcn_fence(__ATOMIC_RELEASE, "agent");
            asm volatile("s_waitcnt vmcnt(0)" ::: "memory");
            const unsigned og = xb_add(&bar[XB_TOP], 1u);
            const unsigned tg = og / nx;
            if (og + 1u == (tg + 1u) * nx) xb_add(&bar[XB_TOPGEN], 1u);
            else XB_SPIN(xb_ld(&bar[XB_TOPGEN]) == tg, bar);
            __builtin_amdgcn_fence(__ATOMIC_ACQUIRE, "agent");
            xb_add(&bar[XB_XGEN(b.x)], 1u);
            asm volatile("s_waitcnt vmcnt(0)" ::: "memory");
        } else {
            XB_SPIN(xb_ld(&bar[XB_XGEN(b.x)]) == gen, bar);
            __builtin_amdgcn_fence(__ATOMIC_ACQUIRE, "agent");
            asm volatile("s_waitcnt vmcnt(0)" ::: "memory");
        }
    }
    __syncthreads();
}

enum { PH_PRO = 0, PH_GIN, PH_INDEX, PH_ATTN, PH_MERGE, PH_GOUT, PH_LN1, PH_GQ, PH_ROUTE, PH_PEER };
template <int PH> __device__ __forceinline__ void run_phase(int WV_, const Params& p_unused, int l, unsigned char* lds_raw) {
    size_t kaoff_ = 0; asm volatile("" : "+s"(kaoff_));
    typedef const __attribute__((address_space(4))) char* kaptr_t;
    const __attribute__((address_space(4))) Params& p = *(const __attribute__((address_space(4))) Params*)((kaptr_t)__builtin_amdgcn_kernarg_segment_ptr() + kaoff_);
    float* sm = (float*)lds_raw;
    size_t wsoff_ = 0; asm volatile("" : "+s"(wsoff_));
    unsigned char* ws = p.ws + wsoff_;
    float* hbuf = p.out;
    bf16* hb = (bf16*)(ws + WS_HB);
    bf16* P = (bf16*)(ws + WS_P);
    bf16* ys = (bf16*)(ws + WS_YS);
    bf16* mrg = (bf16*)(ws + WS_MRG);
    float* mix = (float*)(ws + WS_MIX);
    float* qb = (float*)(ws + WS_Q);
    unsigned char* mask = ws + WS_MASK;
    int* eid = (int*)(ws + WS_EID);
    float* gate = (float*)(ws + WS_GATE);
    float* kmean = (float*)(ws + WS_KMEAN);
    const float* hin = (l == 0) ? p.in[0] : hbuf;
    if (PH == PH_PRO) { Params pc; for (int i = 0; i < 13; ++i) pc.in[i] = p.in[i]; pc.out = p.out; pc.ws = ws;
        prologue_phase(WV_, pc, sm); convert_tables(WV_, pc);
        for (int i = LBID() * NTHR + LTID(WV_); i < DEPTH_ * 8 * 2 * 128 * 64 / 4; i += LGRID() * NTHR) { const float4 v = ((const float4*)p.in[8])[i]; ((uint2*)(ws + WS_SKB))[i] = make_uint2(pk2(v.x, v.y), pk2(v.z, v.w)); } if (LBID() < 2) build_unit_table((unsigned*)(ws + WS_CTL) + 1024, LBID() * NTHR + LTID(WV_)); }
    else if (PH == PH_GIN) {
        pg8::Gemm g{hb, (const bf16*)(ws + WS_WIN_T + l * WIN_T_BYTES), T_, NP, 1024};
        pg8::StaticOrder S; S.init(T_, NP, (int)LGRID(), (int)LBID());
        pg8::EpiBf16<0> E{P, NP, nullptr, 0, 0, 1.f};
        pg8::gemm_phase<pg8::EpiBf16<0>, pg8::StaticOrder, true, true>(WV_, (PG8_LAS unsigned char*)lds_raw, g, S, E);
    }
    else if (PH == PH_INDEX) index_fast_phase(WV_, P, mask, kmean, (float*)(ws + WS_YS), lds_raw);
    else if (PH == PH_ATTN) attn_fast_phase(WV_, P, mask, kmean, p.in[4] + l * 4, ys, (const unsigned*)(ws + WS_CTL) + 1024, (unsigned*)(ws + WS_CTL) + 64 * l, lds_raw);
    else if (PH == PH_MERGE) merge_fast_phase(WV_, P, ys, (const bf16*)(ws + WS_WBR_T) + (size_t)l * 4 * 1024 * 256, mrg, lds_raw);
    else if (PH == PH_GOUT) {
        pg8::Gemm g{mrg, (const bf16*)(ws + WS_WOUT_T) + (size_t)l * 1024 * 1024, T_, 1024, 1024};
        pg8::StaticOrder S; S.init(T_, 1024, (int)LGRID(), (int)LBID());
        pg8::EpiResY E{hin, hbuf, hb, (float*)(ws + WS_STATS) + (size_t)l * T_ * 2, ALPHA};
        pg8::gemm_phase<pg8::EpiResY, pg8::StaticOrder, true, true>(WV_, (PG8_LAS unsigned char*)lds_raw, g, S, E);
    }
    else if (PH == PH_GQ) {
        pg8::Gemm g{hb, (const bf16*)(ws + WS_WQ_T) + (size_t)l * 1024 * 1024, T_, 1024, 1024};
        pg8::StaticOrder S; S.init(T_, 1024, (int)LGRID(), (int)LBID());
        pg8::EpiLnFold E{(bf16*)qb, (const float*)(ws + WS_STATS) + (size_t)l * T_ * 2, (const float*)(ws + WS_COLS) + l * 2048, (const float*)(ws + WS_COLS) + l * 2048 + 1024, LN_EPS};
        pg8::gemm_phase<pg8::EpiLnFold, pg8::StaticOrder, true, true>(WV_, (PG8_LAS unsigned char*)lds_raw, g, S, E);
    }
    else if (PH == PH_ROUTE) route_fast_phase(WV_, (const bf16*)qb, (const bf16*)(ws + WS_SKB) + (size_t)l * 8 * 2 * 128 * 64, eid, gate, lds_raw);
    else peer_fast_phase(WV_, hbuf, hb, eid, gate, ws + WS_UV + (size_t)l * 32 * MiB, p.in[5] + l * 1024, p.in[6] + l * 1024, p.in[11] + l * 1024, p.in[12] + l * 1024, lds_raw);
}

constexpr int CW_BAR = 4096;
constexpr int LDS_BARST = LDS_BYTES - 16;
__global__ void __launch_bounds__(NTHR, 2) mk_fwd(Params p) {
    extern __shared__ __attribute__((aligned(16))) unsigned char lds_raw[];
    cg::grid_group grid = cg::this_grid();
    const int WV_ = __builtin_amdgcn_readfirstlane((int)threadIdx.x >> 6);
    { volatile LAS unsigned* bst0 = (volatile LAS unsigned*)((LAS unsigned char*)lds_raw + LDS_BARST); if (threadIdx.x < 4) bst0[threadIdx.x] = 0u; }
    __syncthreads();
    volatile LAS unsigned* bst = (volatile LAS unsigned*)((LAS unsigned char*)lds_raw + LDS_BARST);
    (void)xcd_barrier_post((unsigned*)(p.ws + WS_CTL) + CW_BAR, bst);
#define GRID_BAR() do { XcdBarrier b_; b_.bar = (unsigned*)(p.ws + WS_CTL) + CW_BAR; b_.x = xb_xcc_id(); b_.st = (volatile LAS unsigned*)((LAS unsigned char*)lds_raw + LDS_BARST); xcd_barrier(b_, WV_); } while (0)
    run_phase<PH_PRO>(WV_, p, 0, lds_raw);
    grid.sync();
#pragma unroll 1
    for (int l = 0; l < DEPTH_; ++l) {
        run_phase<PH_GIN>(WV_, p, l, lds_raw); GRID_BAR();
        run_phase<PH_INDEX>(WV_, p, l, lds_raw); GRID_BAR();
        run_phase<PH_ATTN>(WV_, p, l, lds_raw); GRID_BAR();
        run_phase<PH_MERGE>(WV_, p, l, lds_raw); GRID_BAR();
        run_phase<PH_GOUT>(WV_, p, l, lds_raw); GRID_BAR();
        run_phase<PH_GQ>(WV_, p, l, lds_raw); GRID_BAR();
        run_phase<PH_ROUTE>(WV_, p, l, lds_raw); GRID_BAR();
        run_phase<PH_PEER>(WV_, p, l, lds_raw); if (l + 1 < DEPTH_) GRID_BAR();
    }
}

extern "C" void kernel_launch(void* const* d_in, const int* in_sizes, int n_in, void* d_out, int out_size, void* d_ws, size_t ws_size, hipStream_t stream) {
    if (n_in != 13 || ws_size < WS_END) { fprintf(stderr, "kernel_launch: unexpected n_in %d / ws_size %zu; nothing launched\n", n_in, ws_size); return; }
    static int grid_blocks = 0;
    if (grid_blocks == 0) {
        int dev = 0, cus = 0, per_cu = 0;
        (void)hipGetDevice(&dev);
        (void)hipDeviceGetAttribute(&cus, hipDeviceAttributeMultiprocessorCount, dev);
        (void)hipFuncSetAttribute((const void*)mk_fwd, hipFuncAttributeMaxDynamicSharedMemorySize, LDS_BYTES);
        (void)hipOccupancyMaxActiveBlocksPerMultiprocessor(&per_cu, (const void*)mk_fwd, NTHR, LDS_BYTES);
        if (per_cu < 1) fprintf(stderr, "kernel_launch: occupancy query reports %d\n", per_cu);
        grid_blocks = cus;
    }
    Params p{};
    for (int i = 0; i < 13; ++i) p.in[i] = (const float*)d_in[i];
    p.out = (float*)d_out; p.ws = (unsigned char*)d_ws;
    (void)hipMemsetAsync(d_ws, 0, 2 * MiB, stream);
    void* args[] = {&p};
    hipError_t e = hipLaunchCooperativeKernel((const void*)mk_fwd, dim3(grid_blocks), dim3(NTHR), args, LDS_BYTES, stream);
    if (e != hipSuccess) fprintf(stderr, "cooperative launch failed: %s (grid %d)\n", hipGetErrorString(e), grid_blocks);
}
```

```cpp
#include <hip/hip_runtime.h>
#include <cstdio>
#include <cstdint>
#include <hip/hip_cooperative_groups.h>
namespace cg = cooperative_groups;

__device__ __forceinline__ int LANEID() { int l; asm volatile("v_mbcnt_lo_u32_b32 %0, -1, 0\n\tv_mbcnt_hi_u32_b32 %0, -1, %0" : "=v"(l)); return l; }
__device__ __forceinline__ int LTID(int wv) { return (wv << 6) | LANEID(); }
__device__ __forceinline__ int LBID() { int t = blockIdx.x; asm volatile("" : "+s"(t)); return t; }
__device__ __forceinline__ int LGRID() { int t = gridDim.x; asm volatile("" : "+s"(t)); return t; }
namespace pg8 {
#define PG8_LAS __attribute__((address_space(3)))
typedef unsigned short bf16_t;
typedef short bf16x8 __attribute__((ext_vector_type(8)));
typedef float f32x4 __attribute__((ext_vector_type(4)));
typedef unsigned u32x4 __attribute__((ext_vector_type(4)));
constexpr int BM = 256, BK = 64, HALF = 128, HTB = HALF * BK * 2  , STAGE_BYTES = 8 * HTB, NXCD = 8, WGM = 8;

__host__ __device__ __forceinline__ int lds_byte(int r, int c) { const int st = (r >> 4) * 2 + (c >> 5), rr = r & 15, cc = c & 31, ob = rr * 64 + cc * 2; return st * 1024 + (ob ^ (((ob >> 9) & 1) << 5)); }
__host__ __device__ __forceinline__ void stage_rc(int b, int& R, int& C) { const int st = b / 1024, sb = b % 1024, swz = sb ^ (((sb >> 9) & 1) << 5); R = (st >> 1) * 16 + swz / 64; C = (st & 1) * 32 + (swz % 64) / 2; }
__host__ __device__ __forceinline__ int perm32(int rho) { const int n = rho >> 4, i = rho & 15; return 8 * (i >> 2) + 4 * n + (i & 3); }

struct Unit { int pm, pn; };
struct Gemm { const bf16_t* A; const bf16_t* Bt; int M, N, K; };

struct StaticOrder {
    int nM, nN, nwg, G, c;
    __host__ __device__ void init(int M, int N, int G_, int c_) { nM = M / BM; nN = N / BM; nwg = nM * nN; G = G_; c = c_; }
    __host__ __device__ bool next(int i, Unit& u) const {
        const long L = (long)i * G + c; if (L >= nwg) return false;
        int wgid = (int)L; { const int q = nwg / NXCD, r = nwg % NXCD, xcd = wgid % NXCD, off = wgid / NXCD; wgid = (xcd < r ? xcd * (q + 1) : r * (q + 1) + (xcd - r) * q) + off; }
        const int nig = WGM * nN, gid = wgid / nig, fm = gid * WGM, gsz = (nM - fm) < WGM ? (nM - fm) : WGM;
        u.pm = fm + ((wgid % nig) % gsz); u.pn = (wgid % nig) / gsz; return true;
    }
    __device__ __forceinline__ void a_ready(const Unit&) const {}
    __device__ __forceinline__ void done(const Unit&) const {}
};

__device__ __forceinline__ unsigned cvt_pk_bf16(float lo, float hi) { unsigned r; asm volatile("v_cvt_pk_bf16_f32 %0, %1, %2" : "=v"(r) : "v"(lo), "v"(hi)); return r; }
typedef float f32x2 __attribute__((ext_vector_type(2)));
__device__ __forceinline__ f32x2 gelu_pk(f32x2 v) {
    const f32x2 av = __builtin_elementwise_abs(v), d = av * 0.2316418882f + 1.0f;
    f32x2 t; t.x = __builtin_amdgcn_rcpf(d.x); t.y = __builtin_amdgcn_rcpf(d.y);
    f32x2 q = t * 0.5307027145f + (-0.7265760135f); q = q * t + 0.7107068705f; q = q * t + (-0.142248368f); q = q * t + 0.127414796f; q = q * t;
    const f32x2 s = (v * v) * (-0.72134752044f);
    f32x2 e; e.x = __builtin_amdgcn_exp2f(s.x); e.y = __builtin_amdgcn_exp2f(s.y);
    const f32x2 m = v * (q * e), r = v - m;
    f32x2 o; o.x = v.x < 0.f ? m.x : r.x; o.y = v.y < 0.f ? m.y : r.y; return o;
}

template <int ACT  > struct EpiBf16 {
    static constexpr bool PERM = true, AFTER_DRAIN = false; static_assert(ACT == 0 || ACT == 1, "EpiBf16: ACT is 0 (none) or 1 (gelu_pk)");
    bf16_t* O; int ldc; const float* bias; int split_cols; size_t split_stride; float scale0;
    __device__ __forceinline__ void operator()(const f32x4 (&acc)[2][2][4][2], const Unit& u, int wr, int wc, int fr, int fq) const {
        { int ln_ = LANEID(); asm volatile("" : "+v"(ln_)); fr = ln_ & 15; fq = ln_ >> 4; }
        const int row0 = u.pm * BM + wr * 64 + fr; int colt = u.pn * BM; bf16_t* base = O;
        float sc = 1.f; if (split_cols) { const int t = colt / split_cols; base += (size_t)t * split_stride; colt -= t * split_cols; if (t == 0) sc = scale0; }
        const int col0 = colt + wc * 32 + 8 * fq, bcol0 = u.pn * BM + wc * 32 + 8 * fq;
        f32x4 bv[2][2];
#pragma unroll
        for (int bj = 0; bj < 2; ++bj)
#pragma unroll
            for (int n = 0; n < 2; ++n) bv[bj][n] = bias ? *(const f32x4*)(bias + bcol0 + bj * HALF + 4 * n) : (f32x4){0.f, 0.f, 0.f, 0.f};
#pragma unroll
        for (int ai = 0; ai < 2; ++ai)
#pragma unroll
            for (int m = 0; m < 4; ++m) { bf16_t* rowp = base + (size_t)(row0 + ai * HALF + m * 16) * ldc + col0;
#pragma unroll
                for (int bj = 0; bj < 2; ++bj) { f32x4 v0 = acc[ai][bj][m][0] + bv[bj][0], v1 = acc[ai][bj][m][1] + bv[bj][1];
                    if (ACT == 1) { f32x2 a = gelu_pk((f32x2){v0[0], v0[1]}), b = gelu_pk((f32x2){v0[2], v0[3]}), c = gelu_pk((f32x2){v1[0], v1[1]}), d = gelu_pk((f32x2){v1[2], v1[3]});
                        v0 = (f32x4){a.x, a.y, b.x, b.y}; v1 = (f32x4){c.x, c.y, d.x, d.y}; }
                    v0 = v0 * sc; v1 = v1 * sc; u32x4 w; w.x = cvt_pk_bf16(v0[0], v0[1]); w.y = cvt_pk_bf16(v0[2], v0[3]); w.z = cvt_pk_bf16(v1[0], v1[1]); w.w = cvt_pk_bf16(v1[2], v1[3]);
                    *(u32x4*)(rowp + bj * HALF) = w; } }
    }
};
template <class Epi, class Sched, bool ALIGN_EPI = false, bool SP2 = false>
__device__ __forceinline__ void gemm_phase(int WV_, PG8_LAS unsigned char* lds, const Gemm g, const Sched& S, const Epi& E) {
    const int tid = LTID(WV_), wid = __builtin_amdgcn_readfirstlane(tid >> 6), lane = tid & 63, wr = wid >> 2, wc = wid & 3, fr = lane & 15, fq = lane >> 4;
    const int K = g.K, nt = K / BK;
    unsigned voffA[2], voffB[2];
#pragma unroll
    for (int i = 0; i < 2; ++i) { int R, C; stage_rc(tid * 16 + i * 8192, R, C); const int Rb = Epi::PERM ? ((R & ~31) + perm32(R & 31)) : R;
        voffA[i] = (unsigned)(R * K + C) * 2u; voffB[i] = (unsigned)(Rb * K + C) * 2u; }
    const size_t kstep = (size_t)(BK * 2);
    const size_t hstep = (size_t)HALF * K * 2;
    const size_t tstep = 2 * hstep;
    const unsigned ldsw = (unsigned)wid * 1024u;
    const int aoff = lds_byte(wr * 64 + fr, fq * 8), boff = lds_byte(wc * 32 + fr, fq * 8);
#define PG8_SA(b, h) (((b) * 2 + (h)) * HTB)
#define PG8_SB(b, h) ((4 + (b) * 2 + (h)) * HTB)
#define PG8_STAGE(bufoff, gbase, voff) do { _Pragma("unroll") for (int _i = 0; _i < 2; ++_i) \
        __builtin_amdgcn_global_load_lds((const unsigned*)((const char*)(gbase) + (voff)[_i]), (PG8_LAS unsigned*)(lds + (bufoff) + ldsw + _i * 8192), 16, 0, 0); } while (0)
#define PG8_LDA(dst, b, h) do { _Pragma("unroll") for (int m = 0; m < 4; ++m) _Pragma("unroll") for (int k = 0; k < 2; ++k) dst[m][k] = *(const PG8_LAS bf16x8*)(lds + PG8_SA(b, h) + aoff + m * 2048 + k * 1024); } while (0)
#define PG8_LDB(dst, b, h) do { _Pragma("unroll") for (int n = 0; n < 2; ++n) _Pragma("unroll") for (int k = 0; k < 2; ++k) dst[n][k] = *(const PG8_LAS bf16x8*)(lds + PG8_SB(b, h) + boff + n * 2048 + k * 1024); } while (0)
#define PG8_MMA(ai, bj, At, Bt) do { __builtin_amdgcn_s_setprio(1); _Pragma("unroll") for (int m = 0; m < 4; ++m) _Pragma("unroll") for (int n = 0; n < 2; ++n) _Pragma("unroll") for (int k = 0; k < 2; ++k) \
        acc[ai][bj][m][n] = __builtin_amdgcn_mfma_f32_16x16x32_bf16(Bt[n][k], At[m][k], acc[ai][bj][m][n], 0, 0, 0); __builtin_amdgcn_s_setprio(0); } while (0)
#define PG8_WAIT_V(n) asm volatile("s_waitcnt vmcnt(" #n ")" ::: "memory")
#define PG8_WAIT_L(n) asm volatile("s_waitcnt lgkmcnt(" #n ")" ::: "memory")
#define PG8_BAR __builtin_amdgcn_s_barrier()
#define PG8_SCHED __builtin_amdgcn_sched_barrier(0)
    Unit cur, nxt; int ui = 0;
    if (!S.next(0, cur)) return;
    f32x4 acc[2][2][4][2];
#pragma unroll
    for (int a = 0; a < 2; ++a)
#pragma unroll
        for (int b = 0; b < 2; ++b)
#pragma unroll
            for (int m = 0; m < 4; ++m)
#pragma unroll
                for (int n = 0; n < 2; ++n) acc[a][b][m][n] = (f32x4){0.f, 0.f, 0.f, 0.f};
    bf16x8 At[4][2], B0[2][2], B1[2][2];
    const char* cA = (const char*)g.A + (size_t)cur.pm * tstep; const char* cB = (const char*)g.Bt + (size_t)cur.pn * tstep;
    S.a_ready(cur);
    if constexpr (SP2) {
        PG8_STAGE(PG8_SB(0, 0), cB, voffB); PG8_STAGE(PG8_SB(0, 1), cB + hstep, voffB); PG8_STAGE(PG8_SA(0, 0), cA, voffA); PG8_STAGE(PG8_SA(0, 1), cA + hstep, voffA);
        if (wr == 1) PG8_BAR;
        PG8_WAIT_V(2); PG8_BAR;
        PG8_STAGE(PG8_SB(1, 0), cB + kstep, voffB); PG8_STAGE(PG8_SA(1, 0), cA + kstep, voffA); PG8_STAGE(PG8_SB(1, 1), cB + hstep + kstep, voffB);
        PG8_WAIT_V(6); PG8_BAR;
    } else {
        PG8_STAGE(PG8_SB(0, 0), cB, voffB); PG8_STAGE(PG8_SA(0, 0), cA, voffA); PG8_STAGE(PG8_SB(0, 1), cB + hstep, voffB); PG8_STAGE(PG8_SA(0, 1), cA + hstep, voffA);
        if (wr == 1) PG8_BAR;
        PG8_WAIT_V(4); PG8_BAR;
        PG8_STAGE(PG8_SB(1, 0), cB + kstep, voffB); PG8_STAGE(PG8_SA(1, 0), cA + kstep, voffA); PG8_STAGE(PG8_SB(1, 1), cB + hstep + kstep, voffB);
        PG8_WAIT_V(6); PG8_BAR;
    }
    for (;;) {
        const bool has_next = S.next(ui + 1, nxt);
        const char* nA = has_next ? (const char*)g.A + (size_t)nxt.pm * tstep : cA; const char* nB = has_next ? (const char*)g.Bt + (size_t)nxt.pn * tstep : cB;
        for (int t = 0; t < nt; t += 2) {
            const bool last = (t == nt - 2);
            const char* a1 = cA + (size_t)(t + 1) * kstep;
            const char* a2 = last ? nA : cA + (size_t)(t + 2) * kstep; const char* b2 = last ? nB : cB + (size_t)(t + 2) * kstep;
            const char* a3 = a2 + kstep; const char* b3 = b2 + kstep;
            if (last && has_next) S.a_ready(nxt);
            if constexpr (SP2) {
            PG8_LDB(B0, 0, 0); PG8_LDB(B1, 0, 1); PG8_SCHED; PG8_LDA(At, 0, 0); PG8_STAGE(PG8_SA(1, 1), a1 + hstep, voffA);
            PG8_WAIT_V(8); PG8_WAIT_L(0); PG8_BAR; PG8_MMA(0, 0, At, B0); PG8_MMA(0, 1, At, B1); PG8_BAR; PG8_SCHED;
            PG8_LDA(At, 0, 1); PG8_STAGE(PG8_SB(0, 0), b2, voffB); PG8_STAGE(PG8_SB(0, 1), b2 + hstep, voffB); PG8_STAGE(PG8_SA(0, 0), a2, voffA);
            PG8_WAIT_V(8); PG8_WAIT_L(0); PG8_BAR; PG8_MMA(1, 0, At, B0); PG8_MMA(1, 1, At, B1); PG8_BAR; PG8_SCHED;
            PG8_LDB(B0, 1, 0); PG8_LDB(B1, 1, 1); PG8_SCHED; PG8_LDA(At, 1, 0); PG8_STAGE(PG8_SA(0, 1), a2 + hstep, voffA);
            PG8_WAIT_V(8); PG8_WAIT_L(0); PG8_BAR; PG8_MMA(0, 0, At, B0); PG8_MMA(0, 1, At, B1); PG8_BAR; PG8_SCHED;
            PG8_LDA(At, 1, 1); PG8_STAGE(PG8_SB(1, 0), b3, voffB); PG8_STAGE(PG8_SB(1, 1), b3 + hstep, voffB); PG8_STAGE(PG8_SA(1, 0), a3, voffA);
            PG8_WAIT_V(8); PG8_WAIT_L(0); PG8_BAR; PG8_MMA(1, 0, At, B0); PG8_MMA(1, 1, At, B1); PG8_BAR; PG8_SCHED;
            } else {
            PG8_LDB(B0, 0, 0); PG8_SCHED; PG8_LDA(At, 0, 0); PG8_STAGE(PG8_SA(1, 1), a1 + hstep, voffA);
            PG8_WAIT_L(8); PG8_BAR; PG8_WAIT_L(0); PG8_MMA(0, 0, At, B0); PG8_BAR; PG8_SCHED;
            PG8_LDB(B1, 0, 1); PG8_STAGE(PG8_SB(0, 0), b2, voffB);
            PG8_BAR; PG8_WAIT_L(0); PG8_MMA(0, 1, At, B1); PG8_BAR;
            PG8_LDA(At, 0, 1); PG8_STAGE(PG8_SA(0, 0), a2, voffA);
            PG8_BAR; PG8_WAIT_L(0); PG8_MMA(1, 0, At, B0); PG8_BAR; PG8_SCHED;
            PG8_STAGE(PG8_SB(0, 1), b2 + hstep, voffB);
            PG8_WAIT_V(6); PG8_BAR; PG8_MMA(1, 1, At, B1); PG8_BAR;
            PG8_LDB(B0, 1, 0); PG8_SCHED; PG8_LDA(At, 1, 0); PG8_STAGE(PG8_SA(0, 1), a2 + hstep, voffA);
            PG8_WAIT_L(8); PG8_BAR; PG8_WAIT_L(0); PG8_MMA(0, 0, At, B0); PG8_BAR; PG8_SCHED;
            PG8_LDB(B1, 1, 1); PG8_STAGE(PG8_SB(1, 0), b3, voffB);
            PG8_BAR; PG8_WAIT_L(0); PG8_MMA(0, 1, At, B1); PG8_BAR;
            PG8_LDA(At, 1, 1); PG8_STAGE(PG8_SA(1, 0), a3, voffA);
            PG8_BAR; PG8_WAIT_L(0); PG8_MMA(1, 0, At, B0); PG8_BAR; PG8_SCHED;
            PG8_STAGE(PG8_SB(1, 1), b3 + hstep, voffB);
            PG8_WAIT_V(6); PG8_BAR; PG8_MMA(1, 1, At, B1); PG8_BAR;
            }
        }
        if constexpr (ALIGN_EPI) { if (wr == 0) PG8_BAR; }
        if constexpr (!Epi::AFTER_DRAIN) { E(acc, cur, wr, wc, fr, fq); S.done(cur); }
        if (!has_next) break;
#pragma unroll
        for (int a = 0; a < 2; ++a)
#pragma unroll
            for (int b = 0; b < 2; ++b)
#pragma unroll
                for (int m = 0; m < 4; ++m)
#pragma unroll
                    for (int n = 0; n < 2; ++n) acc[a][b][m][n] = (f32x4){0.f, 0.f, 0.f, 0.f};
        cur = nxt; cA = nA; cB = nB; ++ui;
        if constexpr (ALIGN_EPI) { if (wr == 1) PG8_BAR; }
    }
    PG8_WAIT_V(0);
    if constexpr (!ALIGN_EPI) { if (wr == 0) PG8_BAR; }
    PG8_BAR;
    if constexpr (Epi::AFTER_DRAIN) { E.fused(acc, cur, wr, wc, fr, fq, lds, wid, lane); S.done(cur); }
#undef PG8_SA
#undef PG8_SB
#undef PG8_STAGE
#undef PG8_LDA
#undef PG8_LDB
#undef PG8_MMA
#undef PG8_WAIT_V
#undef PG8_WAIT_L
#undef PG8_BAR
#undef PG8_SCHED
}
}
namespace pg8 {
struct EpiF32 {
    static constexpr bool PERM = false, AFTER_DRAIN = false;
    float* O; int ldc;
    __device__ __forceinline__ void operator()(const f32x4 (&acc)[2][2][4][2], const Unit& u, int wr, int wc, int fr, int fq) const {
        { int ln_ = LANEID(); asm volatile("" : "+v"(ln_)); fr = ln_ & 15; fq = ln_ >> 4; }
        const int row0 = u.pm * BM + wr * 64 + fr, col0 = u.pn * BM + wc * 32 + 4 * fq;
#pragma unroll
        for (int ai = 0; ai < 2; ++ai)
#pragma unroll
            for (int m = 0; m < 4; ++m) { float* rowp = O + (size_t)(row0 + ai * HALF + m * 16) * ldc + col0;
#pragma unroll
                for (int bj = 0; bj < 2; ++bj)
#pragma unroll
                    for (int n = 0; n < 2; ++n) *(f32x4*)(rowp + bj * HALF + n * 16) = acc[ai][bj][m][n]; }
    }
};
struct EpiResY {
    static constexpr bool PERM = false, AFTER_DRAIN = false;
    const float* hin; float* yout; bf16_t* yb; float* stats; float alpha;
    __device__ __forceinline__ void operator()(const f32x4 (&acc)[2][2][4][2], const Unit& u, int wr, int wc, int fr, int fq) const {
        { int ln_ = LANEID(); asm volatile("" : "+v"(ln_)); fr = ln_ & 15; fq = ln_ >> 4; }
        const int row0 = u.pm * BM + wr * 64 + fr, col0 = u.pn * BM + wc * 32 + 4 * fq;
#pragma unroll
        for (int ai = 0; ai < 2; ++ai)
#pragma unroll
            for (int m = 0; m < 4; ++m) {
                const int row = row0 + ai * HALF + m * 16;
                float s = 0.f, s2 = 0.f;
#pragma unroll
                for (int bj = 0; bj < 2; ++bj)
#pragma unroll
                    for (int n = 0; n < 2; ++n) {
                        const size_t off = (size_t)row * 1024 + col0 + bj * HALF + n * 16;
                        const f32x4 hv = *(const f32x4*)(hin + off);
                        const f32x4 y = hv * alpha + acc[ai][bj][m][n];
                        *(f32x4*)(yout + off) = y;
                        typedef unsigned u32x2v __attribute__((ext_vector_type(2)));
                        u32x2v w; w.x = cvt_pk_bf16(y[0], y[1]); w.y = cvt_pk_bf16(y[2], y[3]);
                        *(u32x2v*)(yb + off) = w;
                        s += (y[0] + y[1]) + (y[2] + y[3]); s2 += (y[0] * y[0] + y[1] * y[1]) + (y[2] * y[2] + y[3] * y[3]);
                    }
                s += __shfl_xor(s, 16); s += __shfl_xor(s, 32); s2 += __shfl_xor(s2, 16); s2 += __shfl_xor(s2, 32);
                if (fq == 0) { atomicAdd(stats + 2 * (size_t)row, s); atomicAdd(stats + 2 * (size_t)row + 1, s2); }
            }
    }
};
struct EpiLnFold {
    static constexpr bool PERM = true, AFTER_DRAIN = false;
    bf16_t* O; const float* stats; const float* colsum; const float* colbias; float eps;
    __device__ __forceinline__ void operator()(const f32x4 (&acc)[2][2][4][2], const Unit& u, int wr, int wc, int fr, int fq) const {
        { int ln_ = LANEID(); asm volatile("" : "+v"(ln_)); fr = ln_ & 15; fq = ln_ >> 4; }
        const int row0 = u.pm * BM + wr * 64 + fr, col0 = u.pn * BM + wc * 32 + 8 * fq;
        f32x4 cs[2][2], cb[2][2];
#pragma unroll
        for (int bj = 0; bj < 2; ++bj)
#pragma unroll
            for (int n = 0; n < 2; ++n) { cs[bj][n] = *(const f32x4*)(colsum + col0 + bj * HALF + 4 * n); cb[bj][n] = *(const f32x4*)(colbias + col0 + bj * HALF + 4 * n); }
#pragma unroll
        for (int ai = 0; ai < 2; ++ai)
#pragma unroll
            for (int m = 0; m < 4; ++m) {
                const int row = row0 + ai * HALF + m * 16;
                const float sm_ = stats[2 * (size_t)row], sq_ = stats[2 * (size_t)row + 1];
                const float mean = sm_ * (1.0f / 1024.0f);
                const float rstd = 1.0f / sqrtf(fmaxf(sq_ * (1.0f / 1024.0f) - mean * mean, 0.f) + eps);
                bf16_t* rowp = O + (size_t)row * 1024 + col0;
#pragma unroll
                for (int bj = 0; bj < 2; ++bj) {
                    const f32x4 v0 = (acc[ai][bj][m][0] - cs[bj][0] * mean) * rstd + cb[bj][0], v1 = (acc[ai][bj][m][1] - cs[bj][1] * mean) * rstd + cb[bj][1];
                    u32x4 w; w.x = cvt_pk_bf16(v0[0], v0[1]); w.y = cvt_pk_bf16(v0[2], v0[3]); w.z = cvt_pk_bf16(v1[0], v1[1]); w.w = cvt_pk_bf16(v1[2], v1[3]);
                    *(u32x4*)(rowp + bj * HALF) = w;
                }
            }
    }
};
}

typedef unsigned short bf16;
constexpr int T_ = 16384, S_ = 4096, NBATCH = 4, D_ = 1024, NCOL = 6824, NP = 6912, DEPTH_ = 2;
constexpr int C_QA = 0, C_KA = 256, C_VA = 320, C_QI = 384, C_KI = 640, C_WI = 672, C_QB = 680, C_KB = 936, C_VB = 1064,
              C_QC = 1192, C_KC = 1448, C_VC = 1704, C_QD = 1960, C_KD = 2216, C_VD = 2472, C_G = 2728;
constexpr int NTHR = 512, NWAVE = 8;
constexpr float ALPHA = 1.41421356237309515f;
constexpr float LN_EPS = 1e-5f;
constexpr size_t MiB = 1u << 20;
constexpr size_t WS_STATS = 1 * MiB  , WS_COLS = 1 * MiB + 512 * 1024  ;
constexpr size_t WS_CTL = 0, WS_WIN_T = 2 * MiB, WS_WOUT_T = 30 * MiB, WS_WQ_T = 34 * MiB, WS_WBR_T = 38 * MiB, WS_HB = 42 * MiB,
                 WS_P = 74 * MiB, WS_MIX = 74 * MiB  , WS_Q = 138 * MiB  , WS_YS = 290 * MiB, WS_MRG = 322 * MiB,
                 WS_MASK = 354 * MiB, WS_EID = 362 * MiB, WS_GATE = 370 * MiB, WS_KMEAN = 378 * MiB, WS_SKB = 379 * MiB, WS_UV = 380 * MiB, WS_END = 508 * MiB;
constexpr size_t WIN_T_BYTES = (size_t)NP * 1024 * 2;
constexpr int LDS_BYTES = 144 * 1024;

struct Params { const float* in[13]; float* out; unsigned char* ws; };

__device__ __forceinline__ float bf2f(bf16 v) { return __uint_as_float((unsigned)v << 16); }
__device__ __forceinline__ unsigned f2bf(float f) { unsigned u = __float_as_uint(f); return (u + 0x7fffu + ((u >> 16) & 1u)) >> 16; }
__device__ __forceinline__ unsigned pk2(float lo, float hi) { return f2bf(lo) | (f2bf(hi) << 16); }
__device__ __forceinline__ void unpack8(const uint4 v, float* o) {
    o[0] = __uint_as_float(v.x << 16); o[1] = __uint_as_float(v.x & 0xffff0000u); o[2] = __uint_as_float(v.y << 16); o[3] = __uint_as_float(v.y & 0xffff0000u);
    o[4] = __uint_as_float(v.z << 16); o[5] = __uint_as_float(v.z & 0xffff0000u); o[6] = __uint_as_float(v.w << 16); o[7] = __uint_as_float(v.w & 0xffff0000u);
}
__device__ __forceinline__ float wave_sum(float v) {
#pragma unroll
    for (int o = 32; o > 0; o >>= 1) v += __shfl_xor(v, o);
    return v;
}
__device__ __forceinline__ float wave_max(float v) {
#pragma unroll
    for (int o = 32; o > 0; o >>= 1) v = fmaxf(v, __shfl_xor(v, o));
    return v;
}
__device__ __forceinline__ int wave_sum_i(int v) {
#pragma unroll
    for (int o = 32; o > 0; o >>= 1) v += __shfl_xor(v, o);
    return v;
}
__device__ __forceinline__ float logsig(float x) { return fminf(x, 0.f) - log1pf(expf(-fabsf(x))); }

__device__ void transpose_items(int WV_, const float* W, int K, int N, bf16* WT, float* sm, int item0, int nitems_total, int item_stride,
                                const float* rs_g = nullptr, const float* rs_b = nullptr, float* colsum = nullptr, float* colbias = nullptr) {
    const int tid = LTID(WV_);
    const int nkb = K / 64, nnb = (N + 63) / 64;
    for (int it = item0; it < nkb * nnb; it += item_stride) {
        const int kb = it % nkb, nb = it / nkb, k0 = kb * 64, n0 = nb * 64;
        __syncthreads();
        for (int e = tid; e < 64 * 64; e += NTHR) { const int kk = e >> 6, nn = e & 63; sm[kk * 65 + nn] = (n0 + nn < N) ? W[(size_t)(k0 + kk) * N + n0 + nn] : 0.f; }
        __syncthreads();
        if (rs_g) {
            if (tid < 64) { float cs = 0.f, cb = 0.f;
                for (int kk = 0; kk < 64; ++kk) { const float w = sm[kk * 65 + tid]; cs += w * rs_g[k0 + kk]; cb += w * rs_b[k0 + kk]; }
                atomicAdd(colsum + n0 + tid, cs); atomicAdd(colbias + n0 + tid, cb); }
            __syncthreads();
            for (int e = tid; e < 64 * 64; e += NTHR) { const int kk = e >> 6, nn = e & 63; sm[kk * 65 + nn] *= rs_g[k0 + kk]; }
            __syncthreads();
        }
        { const int nn = tid >> 3, c = tid & 7;
          if (n0 + nn < N) { uint4 o; o.x = pk2(sm[(8 * c + 0) * 65 + nn], sm[(8 * c + 1) * 65 + nn]); o.y = pk2(sm[(8 * c + 2) * 65 + nn], sm[(8 * c + 3) * 65 + nn]);
              o.z = pk2(sm[(8 * c + 4) * 65 + nn], sm[(8 * c + 5) * 65 + nn]); o.w = pk2(sm[(8 * c + 6) * 65 + nn], sm[(8 * c + 7) * 65 + nn]);
              *(uint4*)(WT + (size_t)(n0 + nn) * K + k0 + 8 * c) = o; } }
    }
    __syncthreads();
}
__device__ void prologue_phase(int WV_, const Params& p, float* sm) {
    const int tid = LTID(WV_), B = LBID(), G = LGRID();
    unsigned char* ws = p.ws;
    for (int l = 0; l < DEPTH_; ++l) {
        bf16* win_t = (bf16*)(ws + WS_WIN_T + l * WIN_T_BYTES);
        transpose_items(WV_, p.in[1] + (size_t)l * 1024 * NCOL, 1024, NCOL, win_t, sm, B, 0, G);
        for (int i = B * NTHR + tid; i < (NP - NCOL) * 1024 / 8; i += G * NTHR) ((uint4*)(win_t + (size_t)NCOL * 1024))[i] = make_uint4(0u, 0u, 0u, 0u);
        transpose_items(WV_, p.in[3] + (size_t)l * 1024 * 1024, 1024, 1024, (bf16*)(ws + WS_WOUT_T) + (size_t)l * 1024 * 1024, sm, B, 0, G);
        transpose_items(WV_, p.in[7] + (size_t)l * 1024 * 1024, 1024, 1024, (bf16*)(ws + WS_WQ_T) + (size_t)l * 1024 * 1024, sm, B, 0, G,
                        p.in[5] + l * 1024, p.in[6] + l * 1024, (float*)(ws + WS_COLS) + l * 2048, (float*)(ws + WS_COLS) + l * 2048 + 1024);
        for (int n = 0; n < 4; ++n)
            transpose_items(WV_, p.in[2] + ((size_t)l * 4 + n) * 256 * 1024, 256, 1024, (bf16*)(ws + WS_WBR_T) + ((size_t)l * 4 + n) * 1024 * 256, sm, B, 0, G);
    }
    const float4* x4 = (const float4*)p.in[0]; uint2* hb2 = (uint2*)(ws + WS_HB);
    for (size_t i = (size_t)B * NTHR + tid; i < (size_t)T_ * 1024 / 4; i += (size_t)G * NTHR) { const float4 v = x4[i]; hb2[i] = make_uint2(pk2(v.x, v.y), pk2(v.z, v.w)); }
}

__device__ __forceinline__ void ln_row(float4 (&v)[4], const float* g, const float* bb, float* orow, bf16* obrow, int lane) {
    float s = 0.f;
#pragma unroll
    for (int j = 0; j < 4; ++j) s += (v[j].x + v[j].y) + (v[j].z + v[j].w);
    const float mean = wave_sum(s) * (1.0f / 1024.0f);
    float s2 = 0.f;
#pragma unroll
    for (int j = 0; j < 4; ++j) { v[j].x -= mean; v[j].y -= mean; v[j].z -= mean; v[j].w -= mean; s2 += (v[j].x * v[j].x + v[j].y * v[j].y) + (v[j].z * v[j].z + v[j].w * v[j].w); }
    const float rstd = 1.0f / sqrtf(wave_sum(s2) * (1.0f / 1024.0f) + LN_EPS);
#pragma unroll
    for (int j = 0; j < 4; ++j) {
        const float4 gg = ((const float4*)g)[j * 64 + lane], b4 = ((const float4*)bb)[j * 64 + lane];
        float4 o; o.x = v[j].x * rstd * gg.x + b4.x; o.y = v[j].y * rstd * gg.y + b4.y; o.z = v[j].z * rstd * gg.z + b4.z; o.w = v[j].w * rstd * gg.w + b4.w;
        ((float4*)orow)[j * 64 + lane] = o;
        ((uint2*)obrow)[j * 64 + lane] = make_uint2(pk2(o.x, o.y), pk2(o.z, o.w));
    }
}
__device__ void ln1_phase(int WV_, const float* hin, const float* add, const float* g, const float* bb, float* hout, bf16* hb) {
    const int lane = LTID(WV_) & 63, wave = LTID(WV_) >> 6;
    for (int row = LBID() * NWAVE + wave; row < T_; row += LGRID() * NWAVE) {
        float4 v[4];
#pragma unroll
        for (int j = 0; j < 4; ++j) {
            const float4 a = ((const float4*)(hin + (size_t)row * 1024))[j * 64 + lane], m = ((const float4*)(add + (size_t)row * 1024))[j * 64 + lane];
            v[j].x = ALPHA * a.x + m.x; v[j].y = ALPHA * a.y + m.y; v[j].z = ALPHA * a.z + m.z; v[j].w = ALPHA * a.w + m.w;
        }
        ln_row(v, g, bb, hout + (size_t)row * 1024, hb + (size_t)row * 1024, lane);
    }
}


typedef short bf16x8_t __attribute__((ext_vector_type(8)));
typedef float f32x16_t __attribute__((ext_vector_type(16)));
typedef float f32x2_t __attribute__((ext_vector_type(2)));
typedef __bf16 bf16x2_t __attribute__((ext_vector_type(2)));
__device__ __forceinline__ unsigned cvtpk(float lo, float hi) { f32x2_t v = {lo, hi}; bf16x2_t b = __builtin_convertvector(v, bf16x2_t); return __builtin_bit_cast(unsigned, b); }
__device__ __forceinline__ int crow(int r, int hi) { return (r & 3) + 8 * (r >> 2) + 4 * hi; }
__device__ __forceinline__ float xlane32(float v) { return __shfl_xor(v, 32); }
__device__ __forceinline__ float vmax(float a, float b) { float r; asm("v_max_f32_e32 %0, %1, %2" : "=v"(r) : "v"(a), "v"(b)); return r; }
__device__ __forceinline__ float vmin(float a, float b) { float r; asm("v_min_f32_e32 %0, %1, %2" : "=v"(r) : "v"(a), "v"(b)); return r; }
__device__ __forceinline__ float vmax3(float a, float b, float c) { float r; asm("v_max3_f32 %0, %1, %2, %3" : "=v"(r) : "v"(a), "v"(b), "v"(c)); return r; }

constexpr int AT_KP = 72, AT_VP = 68;
constexpr int AT_KS = 0, AT_KS_BYTES = 64 * AT_KP * 2;
constexpr int AT_VT = 2 * AT_KS_BYTES, AT_VT_BYTES = 64 * AT_VP * 2;
constexpr int AT_KM = AT_VT + 2 * AT_VT_BYTES;
constexpr int AT_MISC = AT_KM + 32 * AT_KP * 2;
constexpr float LOG2E = 1.4426950408889634f;

__device__ __forceinline__ unsigned mk_unit(int kind, int b, int x, int y) { return ((unsigned)kind << 30) | ((unsigned)b << 28) | ((unsigned)x << 8) | (unsigned)y; }
__device__ void build_unit_table(unsigned* tab, int i) {
    int n = 0; unsigned res = 0u;
#pragma unroll 1
    for (int c = 64; c >= 1; --c) {
        if (i >= n && i < n + 4) res = mk_unit(0, i - n, 0, c - 1);
        n += 4;
        if ((c & 3) == 0) { if (i >= n && i < n + 16) { const int j = i - n; res = mk_unit(2, j >> 2, j & 3, c / 4 - 1); } n += 16; }
    }
    if (i < 512) tab[i] = res;
}

template <int kind> __device__ __forceinline__ void attn_unit(int WV_, const bf16* P, const unsigned char* mask, const float* kmean, const float* sinks, bf16* ys,
                                unsigned char* lds, int b, int ux, int uy) {
    int tid_ = LTID(WV_); asm volatile("" : "+v"(tid_));
    const int tid = tid_, lane = tid & 63, wave = __builtin_amdgcn_readfirstlane(tid >> 6), r32 = lane & 31, hi = lane >> 5;
    bf16* s_km = (bf16*)(lds + AT_KM);
    const int skey = tid >> 3, sc = tid & 7;
    {
        const bf16* Pb = P + (size_t)b * S_ * NP;
        int q0w, qcol, kcol, vcol, ycol, kt_hi, kt_lo; float slope2 = 0.f, sink2 = 0.f;
        if (kind == 0) { const int head = wave >> 1; q0w = uy * 64 + (wave & 1) * 32; qcol = C_QA + head * 64; kcol = C_KA; vcol = C_VA; ycol = head * 64;
            slope2 = exp2f(-8.0f * (float)(3 * head + 1) / 12.0f) * LOG2E; kt_hi = uy; kt_lo = 0; }
        else if (kind == 1) { const int hq = ux * 2 + (wave >> 2); q0w = uy * 128 + (wave & 3) * 32; qcol = C_QB + hq * 64; kcol = C_KB + ux * 64; vcol = C_VB + ux * 64; ycol = 256 + hq * 64;
            slope2 = exp2f(-8.0f * (float)(3 * hq + 2) / 12.0f) * LOG2E; sink2 = sinks[hq] * LOG2E; kt_hi = 2 * uy + 1; kt_lo = (2 * uy - 2 > 0) ? 2 * uy - 2 : 0; }
        else if (kind == 2) { q0w = uy * 256 + wave * 32; qcol = C_QC + ux * 64; kcol = C_KC + ux * 64; vcol = C_VC + ux * 64; ycol = 512 + ux * 64;
            slope2 = exp2f(-8.0f * (float)(3 * ux + 3) / 12.0f) * LOG2E; kt_hi = 4 * uy + 3; kt_lo = 0; }
        else { q0w = uy * 256 + wave * 32; qcol = C_QD + ux * 64; kcol = C_KD + ux * 64; vcol = C_VD + ux * 64; ycol = 768 + ux * 64; kt_hi = 4 * uy + 3; kt_lo = 0; }
        const int qpos = q0w + r32;
        bf16x8_t qf[4];
        { const bf16* qp = Pb + (size_t)qpos * NP + qcol + 8 * hi;
#pragma unroll
          for (int ks = 0; ks < 4; ++ks) qf[ks] = *(const bf16x8_t*)(qp + 16 * ks); }
        {
            const float qs = (kind == 3) ? 0.125f : 0.125f * LOG2E;
            typedef unsigned u32x4_t __attribute__((ext_vector_type(4)));
#pragma unroll
            for (int ks = 0; ks < 4; ++ks) { u32x4_t w = __builtin_bit_cast(u32x4_t, qf[ks]);
#pragma unroll
                for (int i = 0; i < 4; ++i) w[i] = cvtpk(__uint_as_float(w[i] << 16) * qs, __uint_as_float(w[i] & 0xffff0000u) * qs);
                qf[ks] = __builtin_bit_cast(bf16x8_t, w); }
        }
        float sb[16];
#pragma unroll
        for (int r = 0; r < 16; ++r) sb[r] = slope2 * (float)((r & 3) + 8 * (r >> 2));
        unsigned bm = 0u;
        if (kind == 2) {
            const int own = uy;
            for (int e = tid; e < 32 * 64; e += NTHR) { const int row = e >> 6, d = e & 63; s_km[row * AT_KP + d] = (row < 16) ? (bf16)f2bf(kmean[((b * 4 + ux) * 16 + row) * 64 + d]) : (bf16)0; }
            __syncthreads();
            f32x16_t gacc;
#pragma unroll
            for (int r = 0; r < 16; ++r) gacc[r] = 0.f;
#pragma unroll
            for (int ks = 0; ks < 4; ++ks) { const bf16x8_t a = *(const bf16x8_t*)(s_km + r32 * AT_KP + 16 * ks + 8 * hi); gacc = __builtin_amdgcn_mfma_f32_32x32x16_bf16(a, qf[ks], gacc, 0, 0, 0); }
            float gt[16];
#pragma unroll
            for (int r = 0; r < 8; ++r) { const float mine = gacc[r], other = xlane32(mine); const int bi = crow(r, 0);
                gt[bi] = hi ? other : mine; gt[bi + 4] = hi ? mine : other; }
#pragma unroll
            for (int n = 0; n < 16; ++n) if (n >= own) gt[n] = -INFINITY;
#pragma unroll
            for (int rep = 0; rep < 3; ++rep) {
                float mx = -INFINITY;
#pragma unroll
                for (int n = 0; n < 16; ++n) mx = fmaxf(mx, gt[n]);
                bool done = !(mx > -INFINITY);
#pragma unroll
                for (int n = 0; n < 16; ++n) { const bool hit = !done && gt[n] == mx; if (hit) { bm |= 1u << n; gt[n] = -INFINITY; done = true; } }
            }
        }
        f32x16_t o0, o1;
#pragma unroll
        for (int r = 0; r < 16; ++r) { o0[r] = 0.f; o1[r] = 0.f; }
        float m_run = -INFINITY, l_run = 0.f, carry = 0.f;
        const bf16* kg = Pb + (size_t)skey * NP + kcol + sc * 8;
        const bf16* vg = Pb + (size_t)skey * NP + vcol + sc * 8;
        uint4 rk = *(const uint4*)(kg + (size_t)kt_hi * 64 * NP), rv = *(const uint4*)(vg + (size_t)kt_hi * 64 * NP);
        int buf = 0;
        { bf16* ks_ = (bf16*)(lds + AT_KS); bf16* vt_ = (bf16*)(lds + AT_VT);
          *(uint4*)(ks_ + skey * AT_KP + sc * 8) = rk;
          const unsigned vw[4] = {rv.x, rv.y, rv.z, rv.w};
#pragma unroll
          for (int j = 0; j < 4; ++j) { vt_[(sc * 8 + 2 * j) * AT_VP + skey] = (bf16)(vw[j] & 0xffffu); vt_[(sc * 8 + 2 * j + 1) * AT_VP + skey] = (bf16)(vw[j] >> 16); } }
        __syncthreads();
        bool wave_done = false;
        uint2 mw_next = make_uint2(0u, 0u);
        if (kind == 0) mw_next = *(const uint2*)(mask + (size_t)(b * S_ + qpos) * 512 + kt_hi * 8);
        for (int kt = kt_hi; kt >= kt_lo; --kt) {
            const bool more = kt > kt_lo;
            const uint2 mw = mw_next;
            if (kind == 0 && more) mw_next = *(const uint2*)(mask + (size_t)(b * S_ + qpos) * 512 + (kt - 1) * 8);
            if (more) { rk = *(const uint4*)(kg + (size_t)(kt - 1) * 64 * NP); rv = *(const uint4*)(vg + (size_t)(kt - 1) * 64 * NP); }
            const bf16* ks_ = (const bf16*)(lds + AT_KS + buf * AT_KS_BYTES);
            const bf16* vt_ = (const bf16*)(lds + AT_VT + buf * AT_VT_BYTES);
            bool active = (kt * 64 <= q0w + 31) && !wave_done;
            if (kind == 1) active = active && (kt * 64 + 63 >= q0w - 127);
            if (active) {
                const int kbase = kt * 64 + 4 * hi;
                f32x16_t p0, p1;
                if (kind != 3) {
                    const float cb = slope2 * (float)(kbase - qpos), cb1 = cb + 32.0f * slope2;
#pragma unroll
                    for (int r = 0; r < 16; ++r) { p0[r] = cb + sb[r]; p1[r] = cb1 + sb[r]; }
                } else {
#pragma unroll
                    for (int r = 0; r < 16; ++r) { p0[r] = 0.f; p1[r] = 0.f; }
                }
#pragma unroll
                for (int ks = 0; ks < 4; ++ks) {
                    const bf16x8_t a0 = *(const bf16x8_t*)(ks_ + r32 * AT_KP + 16 * ks + 8 * hi);
                    const bf16x8_t a1 = *(const bf16x8_t*)(ks_ + (32 + r32) * AT_KP + 16 * ks + 8 * hi);
                    p0 = __builtin_amdgcn_mfma_f32_32x32x16_bf16(a0, qf[ks], p0, 0, 0, 0);
                    p1 = __builtin_amdgcn_mfma_f32_32x32x16_bf16(a1, qf[ks], p1, 0, 0, 0);
                }
                if (kind != 3) {
                    float mx = -INFINITY;
                    if (kind == 0) {
                        const unsigned w0 = mw.x >> (4 * hi), w1 = mw.y >> (4 * hi);
#pragma unroll
                        for (int r = 0; r < 16; ++r) { const int off = (r & 3) + 8 * (r >> 2);
                            p0[r] = (w0 & (1u << off)) ? p0[r] : -INFINITY; p1[r] = (w1 & (1u << off)) ? p1[r] : -INFINITY; mx = vmax3(mx, p0[r], p1[r]); }
                    } else if (kind == 1) {
                        const int rel = qpos - kbase;
#pragma unroll
                        for (int r = 0; r < 16; ++r) { const int off = (r & 3) + 8 * (r >> 2);
                            p0[r] = ((unsigned)(rel - off) < 128u) ? p0[r] : -INFINITY; p1[r] = ((unsigned)(rel - off - 32) < 128u) ? p1[r] : -INFINITY; mx = vmax3(mx, p0[r], p1[r]); }
                    } else {
                        if ((kt >> 2) == uy) {
                            const int rel = qpos - kbase;
#pragma unroll
                            for (int r = 0; r < 16; ++r) { const int off = (r & 3) + 8 * (r >> 2);
                                p0[r] = (off <= rel) ? p0[r] : -INFINITY; p1[r] = (off + 32 <= rel) ? p1[r] : -INFINITY; mx = vmax3(mx, p0[r], p1[r]); }
                        } else {
                            const bool tile_ok = ((bm >> (kt >> 2)) & 1u) != 0u;
#pragma unroll
                            for (int r = 0; r < 16; ++r) { p0[r] = tile_ok ? p0[r] : -INFINITY; p1[r] = tile_ok ? p1[r] : -INFINITY; mx = vmax3(mx, p0[r], p1[r]); }
                        }
                    }
                    mx = vmax(mx, xlane32(mx));
                    const float m_new = vmax(m_run, mx);
                    const float m_safe = (m_new == -INFINITY) ? 0.f : m_new;
                    p0 = p0 - m_safe; p1 = p1 - m_safe;
#pragma unroll
                    for (int r = 0; r < 16; ++r) { p0[r] = __builtin_amdgcn_exp2f(p0[r]); p1[r] = __builtin_amdgcn_exp2f(p1[r]); }
                    float ls;
                    { typedef float f32x8_t __attribute__((ext_vector_type(8))); typedef float f32x4v_t __attribute__((ext_vector_type(4)));
                      const f32x16_t t16 = p0 + p1; const f32x8_t t8 = t16.lo + t16.hi; const f32x4v_t t4 = t8.lo + t8.hi; const f32x2_t t2 = t4.lo + t4.hi; ls = t2.x + t2.y; }
                    if (__any(m_new > m_run)) {
                        const float alpha = __builtin_amdgcn_exp2f(m_run - m_safe);
                        l_run *= alpha;
                        o0 = o0 * alpha; o1 = o1 * alpha;
                    }
                    l_run += ls; m_run = m_new;
                } else {
                    float run = carry;
#define SB_HALF(PX, KOFF) do { \
                    float lk[16]; \
                    _Pragma("unroll") for (int r = 0; r < 16; ++r) { \
                        const int off = (r & 3) + 8 * (r >> 2); \
                        const bool v = (kbase + off + (KOFF)) < qpos; \
                        const float z = PX[r]; \
                        const float t = 0.6931471805599453f * __builtin_amdgcn_logf(1.0f + __builtin_amdgcn_exp2f(-LOG2E * fabsf(z))); \
                        lk[r] = v ? (fminf(-z, 0.f) - t) : 0.f; \
                        PX[r] = v ? (fminf(z, 0.f) - t) : -INFINITY; } \
                    _Pragma("unroll") for (int g = 3; g >= 0; --g) { \
                        const float G = (lk[4 * g] + lk[4 * g + 1]) + (lk[4 * g + 2] + lk[4 * g + 3]); \
                        const float PG = xlane32(G); \
                        float la = run + (hi ? 0.f : PG); \
                        run += G + PG; \
                        PX[4 * g + 3] += la; la += lk[4 * g + 3]; PX[4 * g + 2] += la; la += lk[4 * g + 2]; PX[4 * g + 1] += la; la += lk[4 * g + 1]; PX[4 * g] += la; } \
                    _Pragma("unroll") for (int r = 0; r < 16; ++r) PX[r] = __builtin_amdgcn_exp2f(LOG2E * PX[r]); } while (0)
                    SB_HALF(p1, 32);
                    SB_HALF(p0, 0);
#undef SB_HALF
                    carry = run;
                }
                unsigned pw[16];
#pragma unroll
                for (int j = 0; j < 8; ++j) { pw[j] = cvtpk(p0[2 * j], p0[2 * j + 1]); pw[8 + j] = cvtpk(p1[2 * j], p1[2 * j + 1]); }
#pragma unroll
                for (int s = 0; s < 4; ++s) {
                    bf16x8_t pb; { const unsigned* q = pw + 4 * s; typedef unsigned u32x4_t __attribute__((ext_vector_type(4))); u32x4_t t4 = {q[0], q[1], q[2], q[3]}; pb = __builtin_bit_cast(bf16x8_t, t4); }
#pragma unroll
                    for (int dt = 0; dt < 2; ++dt) {
                        const bf16* vp = vt_ + (32 * dt + r32) * AT_VP + 16 * s + 4 * hi;
                        typedef short s16x4_t __attribute__((ext_vector_type(4)));
                        const s16x4_t lo = *(const s16x4_t*)vp, hi4 = *(const s16x4_t*)(vp + 8);
                        const bf16x8_t va = {lo[0], lo[1], lo[2], lo[3], hi4[0], hi4[1], hi4[2], hi4[3]};
                        if (dt == 0) o0 = __builtin_amdgcn_mfma_f32_32x32x16_bf16(va, pb, o0, 0, 0, 0);
                        else         o1 = __builtin_amdgcn_mfma_f32_32x32x16_bf16(va, pb, o1, 0, 0, 0);
                    }
                }
            }
            if (kind == 3) {
                const float cm = carry;
                if (__all(cm < -110.0f) || !(kt * 64 <= q0w + 31) ) { if (__all(cm < -110.0f)) wave_done = true; }
            }
            if (more) {
                bf16* ksn = (bf16*)(lds + AT_KS + (buf ^ 1) * AT_KS_BYTES); bf16* vtn = (bf16*)(lds + AT_VT + (buf ^ 1) * AT_VT_BYTES);
                *(uint4*)(ksn + skey * AT_KP + sc * 8) = rk;
                const unsigned vw[4] = {rv.x, rv.y, rv.z, rv.w};
#pragma unroll
                for (int j = 0; j < 4; ++j) { vtn[(sc * 8 + 2 * j) * AT_VP + skey] = (bf16)(vw[j] & 0xffffu); vtn[(sc * 8 + 2 * j + 1) * AT_VP + skey] = (bf16)(vw[j] >> 16); }
            }
            if (kind == 3) { if (__syncthreads_and(wave_done ? 1 : 0)) break; }
            else __syncthreads();
            buf ^= 1;
        }
        float inv;
        if (kind == 3) inv = 1.0f;
        else {
            float lt = l_run + xlane32(l_run);
            if (kind == 1) { const float mf = fmaxf(m_run, sink2); const float sc2 = exp2f(m_run - mf); lt = lt * sc2 + exp2f(sink2 - mf); inv = sc2 / lt; }
            else inv = 1.0f / lt;
        }
        bf16* yp = ys + (size_t)(b * S_ + qpos) * 1024 + ycol + 4 * hi;
#pragma unroll
        for (int g = 0; g < 4; ++g) {
            *(uint2*)(yp + 8 * g) = make_uint2(cvtpk(o0[4 * g] * inv, o0[4 * g + 1] * inv), cvtpk(o0[4 * g + 2] * inv, o0[4 * g + 3] * inv));
            *(uint2*)(yp + 32 + 8 * g) = make_uint2(cvtpk(o1[4 * g] * inv, o1[4 * g + 1] * inv), cvtpk(o1[4 * g + 2] * inv, o1[4 * g + 3] * inv));
        }
    }
}
__device__ void attn_fast_phase(int WV_, const bf16* P, const unsigned char* mask, const float* kmean, const float* sinks, bf16* ys,
                                const unsigned* utab, unsigned* counter, unsigned char* lds) {
    volatile unsigned* s_unit = (volatile unsigned*)(lds + AT_MISC);
    for (;;) {
        __syncthreads();
        if (LTID(WV_) == 0) s_unit[0] = atomicAdd(counter, 1u);
        __syncthreads();
        const unsigned ui = s_unit[0];
        if (ui >= 512u) break;
        const unsigned ue = utab[ui];
        const int kind = (int)(ue >> 30), b = (int)((ue >> 28) & 3u), ux = (int)((ue >> 8) & 255u), uy = (int)(ue & 255u);
        if (kind == 0) attn_unit<0>(WV_, P, mask, kmean, sinks, ys, lds, b, ux, uy);
        else attn_unit<2>(WV_, P, mask, kmean, sinks, ys, lds, b, ux, uy);
    }
    for (int u = LBID(); u < 256; u += LGRID()) { __syncthreads(); attn_unit<3>(WV_, P, mask, kmean, sinks, ys, lds, u >> 6, (u >> 4) & 3, u & 15); }
    for (int u = LBID(); u < 256; u += LGRID()) { __syncthreads(); attn_unit<1>(WV_, P, mask, kmean, sinks, ys, lds, u >> 6, (u >> 5) & 1, u & 31); }
}

constexpr float U_SCALE = 64.0f, V_SCALE = 16.0f;
__device__ __forceinline__ float rdlane_f(float v, int l) { return __builtin_bit_cast(float, __builtin_amdgcn_readlane(__builtin_bit_cast(int, v), l)); }
__device__ __forceinline__ unsigned pk4_fp8(float a, float b, float c, float d) { int v = 0; v = __builtin_amdgcn_cvt_pk_fp8_f32(a, b, v, false); v = __builtin_amdgcn_cvt_pk_fp8_f32(c, d, v, true); return (unsigned)v; }
__device__ __forceinline__ void unpack16_fp8(const uint4 v, float* o) {
    const unsigned w[4] = {v.x, v.y, v.z, v.w};
#pragma unroll
    for (int i = 0; i < 4; ++i) { const f32x2_t lo = __builtin_amdgcn_cvt_pk_f32_fp8((int)w[i], false), hi2 = __builtin_amdgcn_cvt_pk_f32_fp8((int)w[i], true);
        o[4 * i] = lo.x; o[4 * i + 1] = lo.y; o[4 * i + 2] = hi2.x; o[4 * i + 3] = hi2.y; }
}
__device__ void convert_tables(int WV_, const Params& p) {
    const size_t nchunk = (size_t)DEPTH_ * 16384 * 2 * 64;
    for (size_t i = (size_t)LBID() * NTHR + LTID(WV_); i < nchunk; i += (size_t)LGRID() * NTHR) {
        const int c = (int)(i & 63), uvsel = (int)((i >> 6) & 1); const size_t le = i >> 7;
        const float* src = (uvsel ? p.in[10] : p.in[9]) + le * 1024 + c * 16;
        const float sc = uvsel ? V_SCALE : U_SCALE;
        const float4 a = ((const float4*)src)[0], b = ((const float4*)src)[1], cc = ((const float4*)src)[2], d = ((const float4*)src)[3];
        *(uint4*)(p.ws + WS_UV + le * 2048 + uvsel * 1024 + c * 16) = make_uint4(pk4_fp8(a.x * sc, a.y * sc, a.z * sc, a.w * sc), pk4_fp8(b.x * sc, b.y * sc, b.z * sc, b.w * sc),
                                                                               pk4_fp8(cc.x * sc, cc.y * sc, cc.z * sc, cc.w * sc), pk4_fp8(d.x * sc, d.y * sc, d.z * sc, d.w * sc));
    }
}
__device__ void peer_fast_phase(int WV_, float* h, bf16* hb, const int* eid, const float* gate, const unsigned char* uv, const float* g1, const float* b1, const float* g, const float* bb, unsigned char* lds) {
    const int tid = LTID(WV_), lane = tid & 63, wave = tid >> 6;
    for (int t = LBID() * NWAVE + wave; t < T_; t += LGRID() * NWAVE) {
        float* hr = h + (size_t)t * 1024 + lane * 16;
        float x[16], acc[16];
        { const float4 a0 = ((const float4*)hr)[0], a1 = ((const float4*)hr)[1], a2 = ((const float4*)hr)[2], a3 = ((const float4*)hr)[3];
          x[0] = a0.x; x[1] = a0.y; x[2] = a0.z; x[3] = a0.w; x[4] = a1.x; x[5] = a1.y; x[6] = a1.z; x[7] = a1.w;
          x[8] = a2.x; x[9] = a2.y; x[10] = a2.z; x[11] = a2.w; x[12] = a3.x; x[13] = a3.y; x[14] = a3.z; x[15] = a3.w; }
        {
            float s = 0.f;
#pragma unroll
            for (int i = 0; i < 16; ++i) s += x[i];
            const float mean = wave_sum(s) * (1.0f / 1024.0f);
            float s2 = 0.f;
#pragma unroll
            for (int i = 0; i < 16; ++i) { x[i] -= mean; s2 += x[i] * x[i]; }
            const float rstd = 1.0f / sqrtf(wave_sum(s2) * (1.0f / 1024.0f) + LN_EPS);
#pragma unroll
            for (int q4 = 0; q4 < 4; ++q4) { const float4 gg = ((const float4*)(g1 + lane * 16))[q4], cc = ((const float4*)(b1 + lane * 16))[q4];
                x[4 * q4] = x[4 * q4] * rstd * gg.x + cc.x; x[4 * q4 + 1] = x[4 * q4 + 1] * rstd * gg.y + cc.y; x[4 * q4 + 2] = x[4 * q4 + 2] * rstd * gg.z + cc.z; x[4 * q4 + 3] = x[4 * q4 + 3] * rstd * gg.w + cc.w; }
        }
#pragma unroll
        for (int i = 0; i < 16; ++i) acc[i] = 0.f;
#pragma unroll 1
        for (int batch = 0; batch < 4; ++batch) {
            const int my_eid = eid[(size_t)t * 128 + batch * 32 + (lane & 31)];
            const float my_gate = gate[(size_t)t * 128 + batch * 32 + (lane & 31)];
            float* pl = (float*)lds + wave * 2048;
#pragma unroll 1
            for (int grp = 0; grp < 4; ++grp) {
                uint4 ua[8];
#pragma unroll
                for (int i = 0; i < 8; ++i) { const int id = __shfl(my_eid, grp * 8 + i); ua[i] = *(const uint4*)(uv + (size_t)id * 2048 + lane * 16); }
#pragma unroll
                for (int i = 0; i < 8; ++i) {
                    float f[16]; unpack16_fp8(ua[i], f);
                    float d0 = 0.f, d1 = 0.f;
#pragma unroll
                    for (int j = 0; j < 8; ++j) { d0 += f[j] * x[j]; d1 += f[8 + j] * x[8 + j]; }
                    pl[(grp * 8 + i) * 64 + lane] = d0 + d1;
                }
            }
            float d;
            { const float4* pr = (const float4*)(pl + (lane & 31) * 64); float4 s4 = pr[0];
#pragma unroll
              for (int i = 1; i < 16; ++i) { const float4 v = pr[i]; s4.x += v.x; s4.y += v.y; s4.z += v.z; s4.w += v.w; }
              d = ((s4.x + s4.y) + (s4.z + s4.w)) * (1.0f / U_SCALE); }
            const float hv = 0.5f * d * (1.0f + erff(d * 0.70710678118654752f)) * my_gate * (1.0f / V_SCALE);
#pragma unroll 1
            for (int grp = 0; grp < 4; ++grp) {
                uint4 va[8];
#pragma unroll
                for (int i = 0; i < 8; ++i) { const int id = __shfl(my_eid, grp * 8 + i); va[i] = *(const uint4*)(uv + (size_t)id * 2048 + 1024 + lane * 16); }
#pragma unroll
                for (int i = 0; i < 8; ++i) {
                    const float c = __shfl(hv, grp * 8 + i);
                    float f[16]; unpack16_fp8(va[i], f);
#pragma unroll
                    for (int j = 0; j < 16; ++j) acc[j] += c * f[j];
                }
            }
        }
        float y[16], s = 0.f;
#pragma unroll
        for (int i = 0; i < 16; ++i) { y[i] = ALPHA * x[i] + acc[i]; s += y[i]; }
        const float mean = wave_sum(s) * (1.0f / 1024.0f);
        float s2 = 0.f;
#pragma unroll
        for (int i = 0; i < 16; ++i) { y[i] -= mean; s2 += y[i] * y[i]; }
        const float rstd = 1.0f / sqrtf(wave_sum(s2) * (1.0f / 1024.0f) + LN_EPS);
        float o[16];
#pragma unroll
        for (int q4 = 0; q4 < 4; ++q4) {
            const float4 gg = ((const float4*)(g + lane * 16))[q4], cc = ((const float4*)(bb + lane * 16))[q4];
            o[4 * q4] = y[4 * q4] * rstd * gg.x + cc.x; o[4 * q4 + 1] = y[4 * q4 + 1] * rstd * gg.y + cc.y; o[4 * q4 + 2] = y[4 * q4 + 2] * rstd * gg.z + cc.z; o[4 * q4 + 3] = y[4 * q4 + 3] * rstd * gg.w + cc.w;
            ((float4*)hr)[q4] = make_float4(o[4 * q4], o[4 * q4 + 1], o[4 * q4 + 2], o[4 * q4 + 3]);
        }
        uint4* hbp = (uint4*)(hb + (size_t)t * 1024 + lane * 16);
        hbp[0] = make_uint4(pk2(o[0], o[1]), pk2(o[2], o[3]), pk2(o[4], o[5]), pk2(o[6], o[7]));
        hbp[1] = make_uint4(pk2(o[8], o[9]), pk2(o[10], o[11]), pk2(o[12], o[13]), pk2(o[14], o[15]));
    }
}


__device__ __forceinline__ float pack_pl(float v, unsigned pl) { return __uint_as_float((__float_as_uint(v) & ~127u) | pl); }
__device__ __forceinline__ void ins16(float (&s)[16], float x) {
#pragma unroll
    for (int k = 15; k >= 1; --k) s[k] = __builtin_amdgcn_fmed3f(s[k - 1], x, s[k]);
    s[0] = vmax(s[0], x);
}
template <int D> __device__ __forceinline__ void bitonic_stage(float (&c)[16]) {
#pragma unroll
    for (int i = 0; i < 16; ++i) if ((i & D) == 0) { const float a = vmax(c[i], c[i + D]), b = vmin(c[i], c[i + D]); c[i] = a; c[i + D] = b; }
}
__device__ __forceinline__ int decode_key(unsigned pl) { return (int)(32u * ((pl >> 4) & 3u) + (pl & 3u) + 8u * ((pl >> 2) & 3u) + 4u * ((pl >> 6) & 1u)); }
__device__ void route_fast_phase(int WV_, const bf16* qb, const bf16* skb  , int* eid, float* gate, unsigned char* lds, int pm = -1, int pn = 0) {
    const int tid = LTID(WV_), lane = tid & 63, wave = tid >> 6, r32 = lane & 31, hi = lane >> 5;
    unsigned* lidx = (unsigned*)lds + wave * (64 * 33) + lane * 33;
    const int u_first = (pm >= 0) ? 0 : LBID() * NWAVE + wave, u_end = (pm >= 0) ? 2 : (T_ / 32) * 8, u_step = (pm >= 0) ? 1 : LGRID() * NWAVE;
    for (int unit = u_first; unit < u_end; unit += u_step) {
        const int h = (pm >= 0) ? 2 * pn + unit : (unit & 7), t = ((pm >= 0) ? 8 * pm + wave : (unit >> 3)) * 32 + r32;
        float sl[2][16];
#pragma unroll
        for (int p = 0; p < 2; ++p) {
            bf16x8_t qf[4];
            { const bf16* qp = qb + (size_t)t * 1024 + h * 128 + p * 64 + 8 * hi;
#pragma unroll
              for (int ks = 0; ks < 4; ++ks) qf[ks] = *(const bf16x8_t*)(qp + 16 * ks); }
            float s[16];
#pragma unroll
            for (int k = 0; k < 16; ++k) s[k] = -INFINITY;
            const bf16* skp = skb + ((size_t)(h * 2 + p) * 128 + r32) * 64 + 8 * hi;
#pragma unroll
            for (int kt = 0; kt < 4; ++kt) {
                f32x16_t acc;
#pragma unroll
                for (int r = 0; r < 16; ++r) acc[r] = 0.f;
#pragma unroll
                for (int ks = 0; ks < 4; ++ks) { const bf16x8_t a = *(const bf16x8_t*)(skp + (size_t)kt * 32 * 64 + 16 * ks); acc = __builtin_amdgcn_mfma_f32_32x32x16_bf16(a, qf[ks], acc, 0, 0, 0); }
#pragma unroll
                for (int r = 0; r < 16; ++r) ins16(s, pack_pl(acc[r], (unsigned)(kt * 16 + r)));
            }
            const unsigned hb = (unsigned)hi << 6;
#pragma unroll
            for (int k = 0; k < 16; ++k) s[k] = __uint_as_float(__float_as_uint(s[k]) | hb);
            float c[16];
#pragma unroll
            for (int k = 0; k < 16; ++k) c[k] = vmax(s[k], __shfl_xor(s[15 - k], 32));
            bitonic_stage<8>(c); bitonic_stage<4>(c); bitonic_stage<2>(c); bitonic_stage<1>(c);
#pragma unroll
            for (int k = 0; k < 16; ++k) { sl[p][k] = c[k]; lidx[p * 16 + k] = (unsigned)decode_key(__float_as_uint(c[k]) & 127u); }
        }
        float w[16];
#pragma unroll
        for (int k = 0; k < 16; ++k) w[k] = -INFINITY;
#pragma unroll
        for (int i = 0; i < 16; ++i)
#pragma unroll
            for (int j = 0; j < 16; ++j)
                if ((i + 1) * (j + 1) <= 16) { const float v = sl[0][i] + sl[1][j]; ins16(w, __uint_as_float((__float_as_uint(v) & ~255u) | (unsigned)(i * 16 + j))); }
        float e[16], sum = 0.f;
#pragma unroll
        for (int k = 0; k < 16; ++k) { e[k] = expf(w[k] - w[0]); sum += e[k]; }
        const float inv = 1.0f / sum;
        int ide[8]; float gte[8];
#pragma unroll
        for (int k = 0; k < 8; ++k) {
            float wa = w[k], wb = w[8 + k], ea = e[k], eb = e[8 + k];
            asm volatile("" : "+v"(wa), "+v"(wb), "+v"(ea), "+v"(eb));
            const float wv = hi ? wb : wa;
            const unsigned pl = __float_as_uint(wv) & 255u;
            ide[k] = (int)(lidx[pl >> 4] * 128u + lidx[16 + (pl & 15u)]);
            gte[k] = (hi ? eb : ea) * inv;
        }
        int* ep = eid + (size_t)t * 128 + h * 16 + hi * 8; float* gp = gate + (size_t)t * 128 + h * 16 + hi * 8;
        *(int4*)ep = make_int4(ide[0], ide[1], ide[2], ide[3]); *(int4*)(ep + 4) = make_int4(ide[4], ide[5], ide[6], ide[7]);
        *(float4*)gp = make_float4(gte[0], gte[1], gte[2], gte[3]); *(float4*)(gp + 4) = make_float4(gte[4], gte[5], gte[6], gte[7]);
    }
}

typedef float f32x4_t __attribute__((ext_vector_type(4)));
typedef __bf16 bf16x2v __attribute__((ext_vector_type(2)));
__device__ __forceinline__ float dot2bf(unsigned a, unsigned b, float c) { return __builtin_amdgcn_fdot2_f32_bf16(__builtin_bit_cast(bf16x2v, a), __builtin_bit_cast(bf16x2v, b), c, false); }
__device__ __forceinline__ void cnt_gt(int& cnt, unsigned a, unsigned b) { asm("v_cmp_gt_u32_e32 vcc, %1, %2\n\tv_addc_co_u32_e32 %0, vcc, 0, %0, vcc" : "+v"(cnt) : "v"(a), "v"(b) : "vcc"); }
__device__ __forceinline__ void cnt_eq(int& cnt, unsigned a, unsigned b) { asm("v_cmp_eq_u32_e32 vcc, %1, %2\n\tv_addc_co_u32_e32 %0, vcc, 0, %0, vcc" : "+v"(cnt) : "v"(a), "v"(b) : "vcc"); }
__device__ __forceinline__ unsigned flag_gt(unsigned a, unsigned b) { unsigned r; asm("v_cmp_gt_u32_e32 vcc, %1, %2\n\tv_cndmask_b32_e64 %0, 0, 1, vcc" : "=v"(r) : "v"(a), "v"(b) : "vcc"); return r; }
__device__ __forceinline__ unsigned flag_eq(unsigned a, unsigned b) { unsigned r; asm("v_cmp_eq_u32_e32 vcc, %1, %2\n\tv_cndmask_b32_e64 %0, 0, 1, vcc" : "=v"(r) : "v"(a), "v"(b) : "vcc"); return r; }
__device__ __forceinline__ void cnt_ge(int& cnt, unsigned key, unsigned cand) { asm("v_cmp_ge_u32_e32 vcc, %1, %2\n\tv_addc_co_u32_e32 %0, vcc, 0, %0, vcc" : "+v"(cnt) : "v"(key), "v"(cand) : "vcc"); }

typedef __attribute__((address_space(3))) unsigned lds_u32;
template <int SHIFT> __device__ __forceinline__ unsigned radix_pass(const unsigned (&key)[64], unsigned pre, lds_u32* hist, int lane, int& need) {
    typedef unsigned u32x4v __attribute__((ext_vector_type(4)));
    typedef __attribute__((address_space(3))) u32x4v lds_u32x4;
    { const u32x4v z4 = {0u, 0u, 0u, 0u};
#pragma unroll
      for (int i = 0; i < 8; ++i) ((lds_u32x4*)(hist + lane * 32))[i] = z4; }
    const unsigned cp = (unsigned)(lane & 7);
#pragma unroll
    for (int j = 0; j < 64; ++j) {
        const unsigned d = (key[j] >> SHIFT) & 255u;
        bool m;
        if (SHIFT == 24) m = key[j] != 0u; else m = (key[j] >> ((SHIFT + 8) & 31)) == pre;
        if (m) __hip_atomic_fetch_add(hist + ((d << 3) | cp), 1u, __ATOMIC_RELAXED, __HIP_MEMORY_SCOPE_WORKGROUP);
    }
    unsigned dsum[4]; unsigned sumL = 0u;
#pragma unroll
    for (int i = 0; i < 4; ++i) { const u32x4v v0 = ((const lds_u32x4*)(hist + lane * 32))[2 * i], v1 = ((const lds_u32x4*)(hist + lane * 32))[2 * i + 1];
        dsum[i] = ((v0.x + v0.y) + (v0.z + v0.w)) + ((v1.x + v1.y) + (v1.z + v1.w)); sumL += dsum[i]; }
    unsigned incl = sumL;
#pragma unroll
    for (int o = 1; o < 64; o <<= 1) { const unsigned t = (unsigned)__shfl_down((int)incl, o); if (lane + o < 64) incl += t; }
    const unsigned above = incl - sumL;
    const bool own = (above < (unsigned)need) && ((unsigned)need <= above + sumL);
    const int owner = __ffsll((long long)__ballot(own)) - 1;
    unsigned acc = above; int sel = -1; unsigned cab = 0u;
#pragma unroll
    for (int i = 3; i >= 0; --i) { const unsigned c = dsum[i]; const bool hit = (sel < 0) && (acc + c >= (unsigned)need); cab = hit ? acc : cab; sel = hit ? i : sel; acc += c; }
    const int ow = owner < 0 ? 0 : owner;
    const unsigned digit = (unsigned)__builtin_amdgcn_readlane(sel, ow) + (unsigned)(4 * ow);
    need -= (int)__builtin_amdgcn_readlane((int)cab, ow);
    return digit;
}
#ifndef TS_SEL
#define TS_SEL 0
#endif
#define ITS_B() do { if (TS_SEL >= 20 && TS_SEL <= 25 && WV_ == 0 && LANEID() == 0) ((volatile __attribute__((address_space(3))) unsigned long long*)((__attribute__((address_space(3))) unsigned char*)lds + 147456 - 16 - 32))[0] = __builtin_amdgcn_s_memrealtime(); } while (0)
#define ITS_E(k) do { if ((k) == TS_SEL && WV_ == 0 && LANEID() == 0) { volatile __attribute__((address_space(3))) unsigned long long* w_ = (volatile __attribute__((address_space(3))) unsigned long long*)((__attribute__((address_space(3))) unsigned char*)lds + 147456 - 16 - 32); w_[1] += __builtin_amdgcn_s_memrealtime() - w_[0]; } } while (0)
__device__ void index_fast_phase(int WV_, const bf16* P, unsigned char* mask, float* kmean, float* scratch_all, unsigned char* lds) {
    const int tid = LTID(WV_), lane = tid & 63, wave = tid >> 6, bid = LBID(), G = LGRID();
    float* s_part = (float*)lds;
    ITS_B();
    for (int k = bid; k < 256; k += G) {
        const int b = k >> 6, h = (k >> 4) & 3, blk = k & 15;
        const bf16* kp = P + (size_t)(b * S_ + blk * 256 + wave * 32) * NP + C_KC + h * 64 + lane;
        float a = 0.f;
#pragma unroll 8
        for (int j = 0; j < 32; ++j) a += bf2f(kp[(size_t)j * NP]);
        __syncthreads();
        s_part[wave * 64 + lane] = a;
        __syncthreads();
        if (tid < 64) { float s = 0.f;
#pragma unroll
            for (int w = 0; w < 8; ++w) s += s_part[w * 64 + tid];
            kmean[((b * 4 + h) * 16 + blk) * 64 + tid] = s * (1.0f / 256.0f); }
    }
    ITS_E(22);
    float* scr = scratch_all + (size_t)bid * (16 * 4096);
    const int lq = lane & 15, g4 = lane >> 4;
    for (int ui = bid; ui < 1024; ui += G) {
        const int b = ui >> 8, k = ui & 255, tile = (b & 1) ? 255 - k : k, q0 = tile * 16;
        const bf16* Pb = P + (size_t)b * S_ * NP;
        const int ntiles = tile + 1;
        ITS_B();
        bf16x8_t qf[8]; float wi[8];
        { const bf16* qp = Pb + (size_t)(q0 + lq) * NP + C_QI + 8 * g4;
#pragma unroll
          for (int h = 0; h < 8; ++h) qf[h] = *(const bf16x8_t*)(qp + 32 * h);
          const uint4 wv = *(const uint4*)(Pb + (size_t)(q0 + lq) * NP + C_WI); unpack8(wv, wi); }
        {
            bf16x8_t afn = *(const bf16x8_t*)(Pb + (size_t)((wave < ntiles ? wave : 0) * 16 + lq) * NP + C_KI + 8 * g4);
            for (int kt = wave; kt < ntiles; kt += NWAVE) {
                const bf16x8_t af = afn;
                { const int ktn = (kt + NWAVE < ntiles) ? kt + NWAVE : kt; afn = *(const bf16x8_t*)(Pb + (size_t)(ktn * 16 + lq) * NP + C_KI + 8 * g4); }
                f32x4_t a[8];
                const f32x4_t z = {0.f, 0.f, 0.f, 0.f};
#pragma unroll
                for (int h = 0; h < 8; ++h) a[h] = __builtin_amdgcn_mfma_f32_16x16x32_bf16(af, qf[h], z, 0, 0, 0);
                __builtin_amdgcn_sched_barrier(0);
                f32x4_t sc = {0.f, 0.f, 0.f, 0.f};
#pragma unroll
                for (int h = 0; h < 8; ++h)
#pragma unroll
                    for (int r = 0; r < 4; ++r) { float rl; asm("v_max_f32_e32 %0, 0, %1" : "=v"(rl) : "v"(a[h][r])); sc[r] += rl * wi[h]; }
#pragma unroll
                for (int r = 0; r < 4; ++r) { sc[r] *= 0.0625f; if (sc[r] == 0.f) sc[r] = 0.f; }
                *(f32x4_t*)(scr + (size_t)lq * 4096 + kt * 16 + 4 * g4) = sc;
            }
        }
        __threadfence_block();
        __syncthreads();
        __threadfence_block();
        ITS_E(20); ITS_B();
        lds_u32* hist = (lds_u32*)((__attribute__((address_space(3))) unsigned char*)lds + 2048) + wave * 2048;
#pragma unroll 1
        for (int qi = 0; qi < 2; ++qi) {
            const int ql = 2 * wave + qi, q = q0 + ql;
            const float* row = scr + (size_t)ql * 4096 + lane * 64;
            const int qrel = q - lane * 64;
            unsigned key[64];
            if (qrel >= 0) {
#pragma unroll
                for (int j4 = 0; j4 < 16; ++j4) {
                    const float4 v = ((const float4*)row)[j4];
                    const unsigned u[4] = {__float_as_uint(v.x), __float_as_uint(v.y), __float_as_uint(v.z), __float_as_uint(v.w)};
#pragma unroll
                    for (int e = 0; e < 4; ++e) { const unsigned t = u[e] ^ ((unsigned)((int)u[e] >> 31) | 0x80000000u); const unsigned inval = (unsigned)((qrel - (j4 * 4 + e)) >> 31); key[j4 * 4 + e] = t & ~inval; }
                    if ((j4 & 3) == 3) asm volatile("" ::: "memory");
                }
            } else {
#pragma unroll
                for (int j = 0; j < 64; ++j) key[j] = 0u;
            }
            ITS_E(23); ITS_B();
            unsigned wlo = 0u, whi = 0u;
            if (q + 1 > 256) {
                int need = 256;
                const unsigned d1 = radix_pass<24>(key, 0u, hist, lane, need);
                const unsigned d2 = radix_pass<16>(key, d1, hist, lane, need);
                const unsigned d3 = radix_pass<8>(key, (d1 << 8) | d2, hist, lane, need);
                const unsigned d4 = radix_pass<0>(key, (d1 << 16) | (d2 << 8) | d3, hist, lane, need);
                const unsigned prefix = (d1 << 24) | (d2 << 16) | (d3 << 8) | d4;
                ITS_E(24); ITS_B();
                int ceq = 0;
#pragma unroll
                for (int j = 0; j < 64; ++j) cnt_eq(ceq, key[j], prefix);
                ceq = wave_sum_i(ceq);
                int X = 4096;
                if (ceq != need) {
                    int X0 = 0;
#pragma unroll 1
                    for (int bit = 11; bit >= 0; --bit) {
                        const int c = X0 | (1 << bit);
                        int cnt = 0; const int crel = c - lane * 64;
#pragma unroll
                        for (int j = 0; j < 64; ++j) cnt_eq(cnt, (key[j] ^ prefix) | ~(unsigned)((j - crel) >> 31), 0u);
                        cnt = wave_sum_i(cnt);
                        if (cnt < need) X0 = c;
                    }
                    X = X0 + 1;
                }
                const int xrel = X - lane * 64;
#pragma unroll
                for (int j = 0; j < 32; ++j) {
                    const unsigned s0 = flag_gt(key[j], prefix) | flag_eq((key[j] ^ prefix) | ~(unsigned)((j - xrel) >> 31), 0u);
                    const unsigned s1 = flag_gt(key[32 + j], prefix) | flag_eq((key[32 + j] ^ prefix) | ~(unsigned)((32 + j - xrel) >> 31), 0u);
                    wlo |= s0 << j; whi |= s1 << j;
                }
            } else {
#pragma unroll
                for (int j = 0; j < 32; ++j) { wlo |= (~(unsigned)((qrel - j) >> 31) & 1u) << j; whi |= (~(unsigned)((qrel - 32 - j) >> 31) & 1u) << j; }
            }
            ((uint2*)(mask + (size_t)(b * S_ + q) * 512))[lane] = make_uint2(wlo, whi);
            ITS_E(25); ITS_B();
        }
        ITS_E(21);
        __syncthreads();
    }
}

constexpr int MG_P = 72;
constexpr int MG_TILE_BYTES = 128 * MG_P * 2;
__device__ void merge_fast_phase(int WV_, const bf16* P, const bf16* ys, const bf16* wbt  , bf16* merged, unsigned char* lds) {
    const int tid = LTID(WV_), lane = tid & 63, wave = tid >> 6, r32 = lane & 31, hi = lane >> 5, wt = wave & 3, wd = wave >> 2;
    const int srow0 = tid >> 3, sch = tid & 7;
    for (int tile = LBID(); tile < 1024; tile += LGRID()) {
        const int tok0 = (tile >> 3) * 128, d0 = (tile & 7) * 128;
        f32x16_t mer[2], acc[2];
#pragma unroll
        for (int r = 0; r < 16; ++r) { mer[0][r] = 0.f; mer[1][r] = 0.f; acc[0][r] = 0.f; acc[1][r] = 0.f; }
        uint4 RW00, RW01, RW10, RW11, RY00, RY01, RY10, RY11, RG0, RG1, RG2, RG3;
        bf16* gl = (bf16*)(lds + 4 * MG_TILE_BYTES);
        const int grow = tid >> 4, gch = tid & 15;
#define MG_GLOAD(st_, R_) do { const int n_ = (st_) >> 2, kc_ = (st_) & 3; \
            RW##R_##0 = *(const uint4*)(wbt + ((size_t)n_ * 1024 + d0 + srow0) * 256 + kc_ * 64 + sch * 8); \
            RW##R_##1 = *(const uint4*)(wbt + ((size_t)n_ * 1024 + d0 + srow0 + 64) * 256 + kc_ * 64 + sch * 8); \
            RY##R_##0 = *(const uint4*)(ys + (size_t)(tok0 + srow0) * 1024 + n_ * 256 + kc_ * 64 + sch * 8); \
            RY##R_##1 = *(const uint4*)(ys + (size_t)(tok0 + srow0 + 64) * 1024 + n_ * 256 + kc_ * 64 + sch * 8); } while (0)
#define MG_SSTORE(buf_, R_) do { bf16* wl_ = (bf16*)(lds + (buf_) * 2 * MG_TILE_BYTES); bf16* yl_ = (bf16*)(lds + (buf_) * 2 * MG_TILE_BYTES + MG_TILE_BYTES); \
            *(uint4*)(wl_ + srow0 * MG_P + sch * 8) = RW##R_##0; *(uint4*)(wl_ + (srow0 + 64) * MG_P + sch * 8) = RW##R_##1; \
            *(uint4*)(yl_ + srow0 * MG_P + sch * 8) = RY##R_##0; *(uint4*)(yl_ + (srow0 + 64) * MG_P + sch * 8) = RY##R_##1; } while (0)
        __syncthreads();
        MG_GLOAD(0, 0); MG_GLOAD(1, 1);
        MG_SSTORE(0, 0);
        __syncthreads();
#define MG_STAGE(PAR_, OTH_) do { const int buf = PAR_; \
            if (st + 2 < 16) MG_GLOAD(st + 2, PAR_); \
            if ((st & 3) == 1) { const bf16* gsrc = P + (size_t)(tok0 + grow) * NP + C_G + (st >> 2) * 1024 + d0 + gch * 8; \
                RG0 = *(const uint4*)gsrc; RG1 = *(const uint4*)(gsrc + (size_t)32 * NP); RG2 = *(const uint4*)(gsrc + (size_t)64 * NP); RG3 = *(const uint4*)(gsrc + (size_t)96 * NP); } \
            const bf16* wl = (const bf16*)(lds + buf * 2 * MG_TILE_BYTES); const bf16* yl = (const bf16*)(lds + buf * 2 * MG_TILE_BYTES + MG_TILE_BYTES); \
            _Pragma("unroll") for (int ks = 0; ks < 4; ++ks) { \
                const bf16x8_t bq = *(const bf16x8_t*)(yl + (32 * wt + r32) * MG_P + 16 * ks + 8 * hi); \
                const bf16x8_t a0 = *(const bf16x8_t*)(wl + (64 * wd + r32) * MG_P + 16 * ks + 8 * hi); \
                const bf16x8_t a1 = *(const bf16x8_t*)(wl + (64 * wd + 32 + r32) * MG_P + 16 * ks + 8 * hi); \
                acc[0] = __builtin_amdgcn_mfma_f32_32x32x16_bf16(a0, bq, acc[0], 0, 0, 0); \
                acc[1] = __builtin_amdgcn_mfma_f32_32x32x16_bf16(a1, bq, acc[1], 0, 0, 0); } \
            if ((st & 3) == 3) { \
                const int n = st >> 2; \
                const bf16* gp = gl + (32 * wt + r32) * 136 + 64 * wd + 4 * hi; (void)n; \
                _Pragma("unroll") for (int dt = 0; dt < 2; ++dt) \
                _Pragma("unroll") for (int g = 0; g < 4; ++g) { \
                        const uint2 gv = *(const uint2*)(gp + 32 * dt + 8 * g); \
                        const float g0 = __uint_as_float(gv.x << 16), g1 = __uint_as_float(gv.x & 0xffff0000u), g2 = __uint_as_float(gv.y << 16), g3 = __uint_as_float(gv.y & 0xffff0000u); \
                        mer[dt][4 * g + 0] += acc[dt][4 * g + 0] * __builtin_amdgcn_rcpf(1.f + __builtin_amdgcn_exp2f(-LOG2E * g0)); \
                        mer[dt][4 * g + 1] += acc[dt][4 * g + 1] * __builtin_amdgcn_rcpf(1.f + __builtin_amdgcn_exp2f(-LOG2E * g1)); \
                        mer[dt][4 * g + 2] += acc[dt][4 * g + 2] * __builtin_amdgcn_rcpf(1.f + __builtin_amdgcn_exp2f(-LOG2E * g2)); \
                        mer[dt][4 * g + 3] += acc[dt][4 * g + 3] * __builtin_amdgcn_rcpf(1.f + __builtin_amdgcn_exp2f(-LOG2E * g3)); } \
                _Pragma("unroll") for (int r = 0; r < 16; ++r) { acc[0][r] = 0.f; acc[1][r] = 0.f; } } \
            if (st + 1 < 16) MG_SSTORE(OTH_, OTH_); \
            if ((st & 3) == 2) { *(uint4*)(gl + grow * 136 + gch * 8) = RG0; *(uint4*)(gl + (grow + 32) * 136 + gch * 8) = RG1; *(uint4*)(gl + (grow + 64) * 136 + gch * 8) = RG2; *(uint4*)(gl + (grow + 96) * 136 + gch * 8) = RG3; } \
            __syncthreads(); } while (0)
#pragma unroll 1
        for (int st2 = 0; st2 < 16; st2 += 2) { { const int st = st2; MG_STAGE(0, 1); } { const int st = st2 + 1; MG_STAGE(1, 0); } }
#undef MG_STAGE
#undef MG_GLOAD
#undef MG_SSTORE
        bf16* mp = merged + (size_t)(tok0 + 32 * wt + r32) * 1024 + d0 + 64 * wd + 4 * hi;
#pragma unroll
        for (int dt = 0; dt < 2; ++dt)
#pragma unroll
            for (int g = 0; g < 4; ++g)
                *(uint2*)(mp + 32 * dt + 8 * g) = make_uint2(cvtpk(mer[dt][4 * g], mer[dt][4 * g + 1]), cvtpk(mer[dt][4 * g + 2], mer[dt][4 * g + 3]));
    }
}
#define LAS __attribute__((address_space(3)))
#define XB_TMO      128
#define XB_XCNT(j)  (256  + 64 * (j))
#define XB_XSUB(j)  (1280 + 64 * (j))
#define XB_XGEN(j)  (2304 + 64 * (j))
#define XB_TOP      3328
#define XB_TOPGEN   3392
#define XCD_BAR_WORDS 3456
#define XB_SPIN_CAP (1u << 18)

__device__ __forceinline__ unsigned xb_ld(unsigned* p)              { return __hip_atomic_load(p, __ATOMIC_RELAXED, __HIP_MEMORY_SCOPE_AGENT); }
__device__ __forceinline__ unsigned xb_add(unsigned* p, unsigned v) { return __hip_atomic_fetch_add(p, v, __ATOMIC_RELAXED, __HIP_MEMORY_SCOPE_AGENT); }
__device__ __forceinline__ unsigned xb_xcc_id() { return (unsigned)__builtin_amdgcn_s_getreg((3 << 11) | 20) & 0xFu; }
#define XB_SPIN(cond, bar) do { unsigned _sp = 0; while (cond) { __builtin_amdgcn_s_sleep(1); \
    if ((++_sp & 255u) == 0u) { if (xb_ld(&(bar)[XB_TMO])) break; if (_sp > XB_SPIN_CAP) { atomicAdd(&(bar)[XB_TMO], 1u); break; } } } } while (0)

struct XcdBarrier {
    unsigned* bar; unsigned x;
    volatile LAS unsigned* st;
};

__device__ __forceinline__ XcdBarrier xcd_barrier_post(unsigned* bar, volatile LAS unsigned* st) {
    XcdBarrier b; b.bar = bar; b.x = xb_xcc_id(); b.st = st;
    if (threadIdx.x == 0) (void)xb_add(&bar[XB_XCNT(b.x)], 1u);
    return b;
}
__device__ __forceinline__ void xcd_barrier_complete(unsigned* bar, unsigned x, unsigned& nloc, unsigned& nx) {
    const unsigned G = gridDim.x * gridDim.y * gridDim.z;
    unsigned sum, cnt, mine, sp = 0u;
    for (;;) {
        sum = 0u; cnt = 0u; mine = 0u;
#pragma unroll
        for (unsigned j = 0; j < 16; ++j) { const unsigned c = xb_ld(&bar[XB_XCNT(j)]); sum += c; cnt += (c > 0u) ? 1u : 0u; mine = (j == x) ? c : mine; }
        if (sum == G) break;
        __builtin_amdgcn_s_sleep(1);
        if ((++sp & 255u) == 0u) { if (xb_ld(&bar[XB_TMO])) break; if (sp > XB_SPIN_CAP) { atomicAdd(&bar[XB_TMO], 1u); break; } }
    }
    nloc = mine > 0u ? mine : 1u; nx = cnt > 0u ? cnt : 1u;
}

__device__ __forceinline__ void xcd_barrier(const XcdBarrier& b, int wv_) {
    asm volatile("s_waitcnt vmcnt(0)" ::: "memory");
    __syncthreads();
    if (wv_ == 0 && LANEID() == 0) {
        unsigned* bar = b.bar;
        __builtin_amdgcn_s_waitcnt(0);
        unsigned nloc = b.st[0], nx = b.st[1];
        if (nloc == 0u) { xcd_barrier_complete(bar, b.x, nloc, nx); b.st[0] = nloc; b.st[1] = nx; }
        const unsigned old = xb_add(&bar[XB_XSUB(b.x)], 1u);
        const unsigned gen = old / nloc;
        if (old + 1u == (gen + 1u) * nloc) {
            __builtin_amdgcn_fence(__ATOMIC_RELEASE, "agent");
            asm volatile("s_waitcnt vmcnt(0)" ::: "memory");
            const unsigned og = xb_add(&bar[XB_TOP], 1u);
            const unsigned tg = og / nx;
            if (og + 1u == (tg + 1u) * nx) xb_add(&bar[XB_TOPGEN], 1u);
            else XB_SPIN(xb_ld(&bar[XB_TOPGEN]) == tg, bar);
            __builtin_amdgcn_fence(__ATOMIC_ACQUIRE, "agent");
            xb_add(&bar[XB_XGEN(b.x)], 1u);
            asm volatile("s_waitcnt vmcnt(0)" ::: "memory");
        } else {
            XB_SPIN(xb_ld(&bar[XB_XGEN(b.x)]) == gen, bar);
            __builtin_amdgcn_fence(__ATOMIC_ACQUIRE, "agent");
            asm volatile("s_waitcnt vmcnt(0)" ::: "memory");
        }
    }
    __syncthreads();
}

enum { PH_PRO = 0, PH_GIN, PH_INDEX, PH_ATTN, PH_MERGE, PH_GOUT, PH_LN1, PH_GQ, PH_ROUTE, PH_PEER };
template <int PH> __device__ __forceinline__ void run_phase(int WV_, const Params& p_unused, int l, unsigned char* lds_raw) {
    size_t kaoff_ = 0; asm volatile("" : "+s"(kaoff_));
    typedef const __attribute__((address_space(4))) char* kaptr_t;
    const __attribute__((address_space(4))) Params& p = *(const __attribute__((address_space(4))) Params*)((kaptr_t)__builtin_amdgcn_kernarg_segment_ptr() + kaoff_);
    float* sm = (float*)lds_raw;
    size_t wsoff_ = 0; asm volatile("" : "+s"(wsoff_));
    unsigned char* ws = p.ws + wsoff_;
    float* hbuf = p.out;
    bf16* hb = (bf16*)(ws + WS_HB);
    bf16* P = (bf16*)(ws + WS_P);
    bf16* ys = (bf16*)(ws + WS_YS);
    bf16* mrg = (bf16*)(ws + WS_MRG);
    float* mix = (float*)(ws + WS_MIX);
    float* qb = (float*)(ws + WS_Q);
    unsigned char* mask = ws + WS_MASK;
    int* eid = (int*)(ws + WS_EID);
    float* gate = (float*)(ws + WS_GATE);
    float* kmean = (float*)(ws + WS_KMEAN);
    const float* hin = (l == 0) ? p.in[0] : hbuf;
    if (PH == PH_PRO) { Params pc; for (int i = 0; i < 13; ++i) pc.in[i] = p.in[i]; pc.out = p.out; pc.ws = ws;
        prologue_phase(WV_, pc, sm); convert_tables(WV_, pc);
        for (int i = LBID() * NTHR + LTID(WV_); i < DEPTH_ * 8 * 2 * 128 * 64 / 4; i += LGRID() * NTHR) { const float4 v = ((const float4*)p.in[8])[i]; ((uint2*)(ws + WS_SKB))[i] = make_uint2(pk2(v.x, v.y), pk2(v.z, v.w)); } if (LBID() < 2) build_unit_table((unsigned*)(ws + WS_CTL) + 1024, LBID() * NTHR + LTID(WV_)); }
    else if (PH == PH_GIN) {
        pg8::Gemm g{hb, (const bf16*)(ws + WS_WIN_T + l * WIN_T_BYTES), T_, NP, 1024};
        pg8::StaticOrder S; S.init(T_, NP, (int)LGRID(), (int)LBID());
        pg8::EpiBf16<0> E{P, NP, nullptr, 0, 0, 1.f};
        pg8::gemm_phase<pg8::EpiBf16<0>, pg8::StaticOrder, true, true>(WV_, (PG8_LAS unsigned char*)lds_raw, g, S, E);
    }
    else if (PH == PH_INDEX) index_fast_phase(WV_, P, mask, kmean, (float*)(ws + WS_YS), lds_raw);
    else if (PH == PH_ATTN) attn_fast_phase(WV_, P, mask, kmean, p.in[4] + l * 4, ys, (const unsigned*)(ws + WS_CTL) + 1024, (unsigned*)(ws + WS_CTL) + 64 * l, lds_raw);
    else if (PH == PH_MERGE) merge_fast_phase(WV_, P, ys, (const bf16*)(ws + WS_WBR_T) + (size_t)l * 4 * 1024 * 256, mrg, lds_raw);
    else if (PH == PH_GOUT) {
        pg8::Gemm g{mrg, (const bf16*)(ws + WS_WOUT_T) + (size_t)l * 1024 * 1024, T_, 1024, 1024};
        pg8::StaticOrder S; S.init(T_, 1024, (int)LGRID(), (int)LBID());
        pg8::EpiResY E{hin, hbuf, hb, (float*)(ws + WS_STATS) + (size_t)l * T_ * 2, ALPHA};
        pg8::gemm_phase<pg8::EpiResY, pg8::StaticOrder, true, true>(WV_, (PG8_LAS unsigned char*)lds_raw, g, S, E);
    }
    else if (PH == PH_GQ) {
        pg8::Gemm g{hb, (const bf16*)(ws + WS_WQ_T) + (size_t)l * 1024 * 1024, T_, 1024, 1024};
        pg8::StaticOrder S; S.init(T_, 1024, (int)LGRID(), (int)LBID());
        pg8::EpiLnFold E{(bf16*)qb, (const float*)(ws + WS_STATS) + (size_t)l * T_ * 2, (const float*)(ws + WS_COLS) + l * 2048, (const float*)(ws + WS_COLS) + l * 2048 + 1024, LN_EPS};
        pg8::gemm_phase<pg8::EpiLnFold, pg8::StaticOrder, true, true>(WV_, (PG8_LAS unsigned char*)lds_raw, g, S, E);
        pg8::Unit u0;
        if (LGRID() == 256 && S.next(0, u0)) {
            asm volatile("s_waitcnt vmcnt(0)" ::: "memory"); __syncthreads();
            route_fast_phase(WV_, (const bf16*)qb, (const bf16*)(ws + WS_SKB) + (size_t)l * 8 * 2 * 128 * 64, eid, gate, lds_raw, u0.pm, u0.pn);
        }
    }
    else if (PH == PH_ROUTE) { if (LGRID() != 256) route_fast_phase(WV_, (const bf16*)qb, (const bf16*)(ws + WS_SKB) + (size_t)l * 8 * 2 * 128 * 64, eid, gate, lds_raw); }
    else peer_fast_phase(WV_, hbuf, hb, eid, gate, ws + WS_UV + (size_t)l * 32 * MiB, p.in[5] + l * 1024, p.in[6] + l * 1024, p.in[11] + l * 1024, p.in[12] + l * 1024, lds_raw);
}

constexpr int CW_BAR = 4096;
constexpr int LDS_BARST = LDS_BYTES - 16;
__global__ void __launch_bounds__(NTHR, 2) mk_fwd(Params p) {
    extern __shared__ __attribute__((aligned(16))) unsigned char lds_raw[];
    cg::grid_group grid = cg::this_grid();
    const int WV_ = __builtin_amdgcn_readfirstlane((int)threadIdx.x >> 6);
    { volatile LAS unsigned* bst0 = (volatile LAS unsigned*)((LAS unsigned char*)lds_raw + LDS_BARST); if (threadIdx.x < 4) bst0[threadIdx.x] = 0u; }
    __syncthreads();
    volatile LAS unsigned* bst = (volatile LAS unsigned*)((LAS unsigned char*)lds_raw + LDS_BARST);
    (void)xcd_barrier_post((unsigned*)(p.ws + WS_CTL) + CW_BAR, bst);
#define GRID_BAR() do { XcdBarrier b_; b_.bar = (unsigned*)(p.ws + WS_CTL) + CW_BAR; b_.x = xb_xcc_id(); b_.st = (volatile LAS unsigned*)((LAS unsigned char*)lds_raw + LDS_BARST); xcd_barrier(b_, WV_); } while (0)
    run_phase<PH_PRO>(WV_, p, 0, lds_raw);
    grid.sync();
#pragma unroll 1
    for (int l = 0; l < DEPTH_; ++l) {
        run_phase<PH_GIN>(WV_, p, l, lds_raw); GRID_BAR();
        run_phase<PH_INDEX>(WV_, p, l, lds_raw); GRID_BAR();
        run_phase<PH_ATTN>(WV_, p, l, lds_raw); GRID_BAR();
        run_phase<PH_MERGE>(WV_, p, l, lds_raw); GRID_BAR();
        run_phase<PH_GOUT>(WV_, p, l, lds_raw); GRID_BAR();
        run_phase<PH_GQ>(WV_, p, l, lds_raw); if (LGRID() != 256) { GRID_BAR(); run_phase<PH_ROUTE>(WV_, p, l, lds_raw); } GRID_BAR();
        run_phase<PH_PEER>(WV_, p, l, lds_raw); if (l + 1 < DEPTH_) GRID_BAR();
    }
}

extern "C" void kernel_launch(void* const* d_in, const int* in_sizes, int n_in, void* d_out, int out_size, void* d_ws, size_t ws_size, hipStream_t stream) {
    if (n_in != 13 || ws_size < WS_END) { fprintf(stderr, "kernel_launch: unexpected n_in %d / ws_size %zu; nothing launched\n", n_in, ws_size); return; }
    static int grid_blocks = 0;
    if (grid_blocks == 0) {
        int dev = 0, cus = 0, per_cu = 0;
        (void)hipGetDevice(&dev);
        (void)hipDeviceGetAttribute(&cus, hipDeviceAttributeMultiprocessorCount, dev);
        (void)hipFuncSetAttribute((const void*)mk_fwd, hipFuncAttributeMaxDynamicSharedMemorySize, LDS_BYTES);
        (void)hipOccupancyMaxActiveBlocksPerMultiprocessor(&per_cu, (const void*)mk_fwd, NTHR, LDS_BYTES);
        if (per_cu < 1) fprintf(stderr, "kernel_launch: occupancy query reports %d\n", per_cu);
        grid_blocks = cus;
    }
    Params p{};
    for (int i = 0; i < 13; ++i) p.in[i] = (const float*)d_in[i];
    p.out = (float*)d_out; p.ws = (unsigned char*)d_ws;
    (void)hipMemsetAsync(d_ws, 0, 2 * MiB, stream);
    void* args[] = {&p};
    hipError_t e = hipLaunchCooperativeKernel((const void*)mk_fwd, dim3(grid_blocks), dim3(NTHR), args, LDS_BYTES, stream);
    if (e != hipSuccess) fprintf(stderr, "cooperative launch failed: %s (grid %d)\n", hipGetErrorString(e), grid_blocks);
}
```

```cpp
#include <hip/hip_runtime.h>
#include <cstdio>
#include <cstdint>
#include <hip/hip_cooperative_groups.h>
namespace cg = cooperative_groups;

__device__ __forceinline__ int LANEID() { int l; asm volatile("v_mbcnt_lo_u32_b32 %0, -1, 0\n\tv_mbcnt_hi_u32_b32 %0, -1, %0" : "=v"(l)); return l; }
__device__ __forceinline__ int LTID(int wv) { return (wv << 6) | LANEID(); }
__device__ __forceinline__ int LBID() { int t = blockIdx.x; asm volatile("" : "+s"(t)); return t; }
__device__ __forceinline__ int LGRID() { int t = gridDim.x; asm volatile("" : "+s"(t)); return t; }
namespace pg8 {
#define PG8_LAS __attribute__((address_space(3)))
typedef unsigned short bf16_t;
typedef short bf16x8 __attribute__((ext_vector_type(8)));
typedef float f32x4 __attribute__((ext_vector_type(4)));
typedef unsigned u32x4 __attribute__((ext_vector_type(4)));
constexpr int BM = 256, BK = 64, HALF = 128, HTB = HALF * BK * 2  , STAGE_BYTES = 8 * HTB, NXCD = 8, WGM = 8;

__host__ __device__ __forceinline__ int lds_byte(int r, int c) { const int st = (r >> 4) * 2 + (c >> 5), rr = r & 15, cc = c & 31, ob = rr * 64 + cc * 2; return st * 1024 + (ob ^ (((ob >> 9) & 1) << 5)); }
__host__ __device__ __forceinline__ void stage_rc(int b, int& R, int& C) { const int st = b / 1024, sb = b % 1024, swz = sb ^ (((sb >> 9) & 1) << 5); R = (st >> 1) * 16 + swz / 64; C = (st & 1) * 32 + (swz % 64) / 2; }
__host__ __device__ __forceinline__ int perm32(int rho) { const int n = rho >> 4, i = rho & 15; return 8 * (i >> 2) + 4 * n + (i & 3); }

struct Unit { int pm, pn; };
struct Gemm { const bf16_t* A; const bf16_t* Bt; int M, N, K; };

struct StaticOrder {
    int nM, nN, nwg, G, c;
    __host__ __device__ void init(int M, int N, int G_, int c_) { nM = M / BM; nN = N / BM; nwg = nM * nN; G = G_; c = c_; }
    __host__ __device__ bool next(int i, Unit& u) const {
        const long L = (long)i * G + c; if (L >= nwg) return false;
        int wgid = (int)L; { const int q = nwg / NXCD, r = nwg % NXCD, xcd = wgid % NXCD, off = wgid / NXCD; wgid = (xcd < r ? xcd * (q + 1) : r * (q + 1) + (xcd - r) * q) + off; }
        const int nig = WGM * nN, gid = wgid / nig, fm = gid * WGM, gsz = (nM - fm) < WGM ? (nM - fm) : WGM;
        u.pm = fm + ((wgid % nig) % gsz); u.pn = (wgid % nig) / gsz; return true;
    }
    __device__ __forceinline__ void a_ready(const Unit&) const {}
    __device__ __forceinline__ void done(const Unit&) const {}
};

__device__ __forceinline__ unsigned cvt_pk_bf16(float lo, float hi) { unsigned r; asm volatile("v_cvt_pk_bf16_f32 %0, %1, %2" : "=v"(r) : "v"(lo), "v"(hi)); return r; }
typedef float f32x2 __attribute__((ext_vector_type(2)));
__device__ __forceinline__ f32x2 gelu_pk(f32x2 v) {
    const f32x2 av = __builtin_elementwise_abs(v), d = av * 0.2316418882f + 1.0f;
    f32x2 t; t.x = __builtin_amdgcn_rcpf(d.x); t.y = __builtin_amdgcn_rcpf(d.y);
    f32x2 q = t * 0.5307027145f + (-0.7265760135f); q = q * t + 0.7107068705f; q = q * t + (-0.142248368f); q = q * t + 0.127414796f; q = q * t;
    const f32x2 s = (v * v) * (-0.72134752044f);
    f32x2 e; e.x = __builtin_amdgcn_exp2f(s.x); e.y = __builtin_amdgcn_exp2f(s.y);
    const f32x2 m = v * (q * e), r = v - m;
    f32x2 o; o.x = v.x < 0.f ? m.x : r.x; o.y = v.y < 0.f ? m.y : r.y; return o;
}

template <int ACT  > struct EpiBf16 {
    static constexpr bool PERM = true, AFTER_DRAIN = false; static_assert(ACT == 0 || ACT == 1, "EpiBf16: ACT is 0 (none) or 1 (gelu_pk)");
    bf16_t* O; int ldc; const float* bias; int split_cols; size_t split_stride; float scale0;
    __device__ __forceinline__ void operator()(const f32x4 (&acc)[2][2][4][2], const Unit& u, int wr, int wc, int fr, int fq) const {
        { int ln_ = LANEID(); asm volatile("" : "+v"(ln_)); fr = ln_ & 15; fq = ln_ >> 4; }
        const int row0 = u.pm * BM + wr * 64 + fr; int colt = u.pn * BM; bf16_t* base = O;
        float sc = 1.f; if (split_cols) { const int t = colt / split_cols; base += (size_t)t * split_stride; colt -= t * split_cols; if (t == 0) sc = scale0; }
        const int col0 = colt + wc * 32 + 8 * fq, bcol0 = u.pn * BM + wc * 32 + 8 * fq;
        f32x4 bv[2][2];
#pragma unroll
        for (int bj = 0; bj < 2; ++bj)
#pragma unroll
            for (int n = 0; n < 2; ++n) bv[bj][n] = bias ? *(const f32x4*)(bias + bcol0 + bj * HALF + 4 * n) : (f32x4){0.f, 0.f, 0.f, 0.f};
#pragma unroll
        for (int ai = 0; ai < 2; ++ai)
#pragma unroll
            for (int m = 0; m < 4; ++m) { bf16_t* rowp = base + (size_t)(row0 + ai * HALF + m * 16) * ldc + col0;
#pragma unroll
                for (int bj = 0; bj < 2; ++bj) { f32x4 v0 = acc[ai][bj][m][0] + bv[bj][0], v1 = acc[ai][bj][m][1] + bv[bj][1];
                    if (ACT == 1) { f32x2 a = gelu_pk((f32x2){v0[0], v0[1]}), b = gelu_pk((f32x2){v0[2], v0[3]}), c = gelu_pk((f32x2){v1[0], v1[1]}), d = gelu_pk((f32x2){v1[2], v1[3]});
                        v0 = (f32x4){a.x, a.y, b.x, b.y}; v1 = (f32x4){c.x, c.y, d.x, d.y}; }
                    v0 = v0 * sc; v1 = v1 * sc; u32x4 w; w.x = cvt_pk_bf16(v0[0], v0[1]); w.y = cvt_pk_bf16(v0[2], v0[3]); w.z = cvt_pk_bf16(v1[0], v1[1]); w.w = cvt_pk_bf16(v1[2], v1[3]);
                    *(u32x4*)(rowp + bj * HALF) = w; } }
    }
};
template <class Epi, class Sched, bool ALIGN_EPI = false, bool SP2 = false>
__device__ __forceinline__ void gemm_phase(int WV_, PG8_LAS unsigned char* lds, const Gemm g, const Sched& S, const Epi& E) {
    const int tid = LTID(WV_), wid = __builtin_amdgcn_readfirstlane(tid >> 6), lane = tid & 63, wr = wid >> 2, wc = wid & 3, fr = lane & 15, fq = lane >> 4;
    const int K = g.K, nt = K / BK;
    unsigned voffA[2], voffB[2];
#pragma unroll
    for (int i = 0; i < 2; ++i) { int R, C; stage_rc(tid * 16 + i * 8192, R, C); const int Rb = Epi::PERM ? ((R & ~31) + perm32(R & 31)) : R;
        voffA[i] = (unsigned)(R * K + C) * 2u; voffB[i] = (unsigned)(Rb * K + C) * 2u; }
    const size_t kstep = (size_t)(BK * 2);
    const size_t hstep = (size_t)HALF * K * 2;
    const size_t tstep = 2 * hstep;
    const unsigned ldsw = (unsigned)wid * 1024u;
    const int aoff = lds_byte(wr * 64 + fr, fq * 8), boff = lds_byte(wc * 32 + fr, fq * 8);
#define PG8_SA(b, h) (((b) * 2 + (h)) * HTB)
#define PG8_SB(b, h) ((4 + (b) * 2 + (h)) * HTB)
#define PG8_STAGE(bufoff, gbase, voff) do { _Pragma("unroll") for (int _i = 0; _i < 2; ++_i) \
        __builtin_amdgcn_global_load_lds((const unsigned*)((const char*)(gbase) + (voff)[_i]), (PG8_LAS unsigned*)(lds + (bufoff) + ldsw + _i * 8192), 16, 0, 0); } while (0)
#define PG8_LDA(dst, b, h) do { _Pragma("unroll") for (int m = 0; m < 4; ++m) _Pragma("unroll") for (int k = 0; k < 2; ++k) dst[m][k] = *(const PG8_LAS bf16x8*)(lds + PG8_SA(b, h) + aoff + m * 2048 + k * 1024); } while (0)
#define PG8_LDB(dst, b, h) do { _Pragma("unroll") for (int n = 0; n < 2; ++n) _Pragma("unroll") for (int k = 0; k < 2; ++k) dst[n][k] = *(const PG8_LAS bf16x8*)(lds + PG8_SB(b, h) + boff + n * 2048 + k * 1024); } while (0)
#define PG8_MMA(ai, bj, At, Bt) do { __builtin_amdgcn_s_setprio(1); _Pragma("unroll") for (int m = 0; m < 4; ++m) _Pragma("unroll") for (int n = 0; n < 2; ++n) _Pragma("unroll") for (int k = 0; k < 2; ++k) \
        acc[ai][bj][m][n] = __builtin_amdgcn_mfma_f32_16x16x32_bf16(Bt[n][k], At[m][k], acc[ai][bj][m][n], 0, 0, 0); __builtin_amdgcn_s_setprio(0); } while (0)
#define PG8_WAIT_V(n) asm volatile("s_waitcnt vmcnt(" #n ")" ::: "memory")
#define PG8_WAIT_L(n) asm volatile("s_waitcnt lgkmcnt(" #n ")" ::: "memory")
#define PG8_BAR __builtin_amdgcn_s_barrier()
#define PG8_SCHED __builtin_amdgcn_sched_barrier(0)
    Unit cur, nxt; int ui = 0;
    if (!S.next(0, cur)) return;
    f32x4 acc[2][2][4][2];
#pragma unroll
    for (int a = 0; a < 2; ++a)
#pragma unroll
        for (int b = 0; b < 2; ++b)
#pragma unroll
            for (int m = 0; m < 4; ++m)
#pragma unroll
                for (int n = 0; n < 2; ++n) acc[a][b][m][n] = (f32x4){0.f, 0.f, 0.f, 0.f};
    bf16x8 At[4][2], B0[2][2], B1[2][2];
    const char* cA = (const char*)g.A + (size_t)cur.pm * tstep; const char* cB = (const char*)g.Bt + (size_t)cur.pn * tstep;
    S.a_ready(cur);
    if constexpr (SP2) {
        PG8_STAGE(PG8_SB(0, 0), cB, voffB); PG8_STAGE(PG8_SB(0, 1), cB + hstep, voffB); PG8_STAGE(PG8_SA(0, 0), cA, voffA); PG8_STAGE(PG8_SA(0, 1), cA + hstep, voffA);
        if (wr == 1) PG8_BAR;
        PG8_WAIT_V(2); PG8_BAR;
        PG8_STAGE(PG8_SB(1, 0), cB + kstep, voffB); PG8_STAGE(PG8_SA(1, 0), cA + kstep, voffA); PG8_STAGE(PG8_SB(1, 1), cB + hstep + kstep, voffB);
        PG8_WAIT_V(6); PG8_BAR;
    } else {
        PG8_STAGE(PG8_SB(0, 0), cB, voffB); PG8_STAGE(PG8_SA(0, 0), cA, voffA); PG8_STAGE(PG8_SB(0, 1), cB + hstep, voffB); PG8_STAGE(PG8_SA(0, 1), cA + hstep, voffA);
        if (wr == 1) PG8_BAR;
        PG8_WAIT_V(4); PG8_BAR;
        PG8_STAGE(PG8_SB(1, 0), cB + kstep, voffB); PG8_STAGE(PG8_SA(1, 0), cA + kstep, voffA); PG8_STAGE(PG8_SB(1, 1), cB + hstep + kstep, voffB);
        PG8_WAIT_V(6); PG8_BAR;
    }
    for (;;) {
        const bool has_next = S.next(ui + 1, nxt);
        const char* nA = has_next ? (const char*)g.A + (size_t)nxt.pm * tstep : cA; const char* nB = has_next ? (const char*)g.Bt + (size_t)nxt.pn * tstep : cB;
        for (int t = 0; t < nt; t += 2) {
            const bool last = (t == nt - 2);
            const char* a1 = cA + (size_t)(t + 1) * kstep;
            const char* a2 = last ? nA : cA + (size_t)(t + 2) * kstep; const char* b2 = last ? nB : cB + (size_t)(t + 2) * kstep;
            const char* a3 = a2 + kstep; const char* b3 = b2 + kstep;
            if (last && has_next) S.a_ready(nxt);
            if constexpr (SP2) {
            PG8_LDB(B0, 0, 0); PG8_LDB(B1, 0, 1); PG8_SCHED; PG8_LDA(At, 0, 0); PG8_STAGE(PG8_SA(1, 1), a1 + hstep, voffA);
            PG8_WAIT_V(8); PG8_WAIT_L(0); PG8_BAR; PG8_MMA(0, 0, At, B0); PG8_MMA(0, 1, At, B1); PG8_BAR; PG8_SCHED;
            PG8_LDA(At, 0, 1); PG8_STAGE(PG8_SB(0, 0), b2, voffB); PG8_STAGE(PG8_SB(0, 1), b2 + hstep, voffB); PG8_STAGE(PG8_SA(0, 0), a2, voffA);
            PG8_WAIT_V(8); PG8_WAIT_L(0); PG8_BAR; PG8_MMA(1, 0, At, B0); PG8_MMA(1, 1, At, B1); PG8_BAR; PG8_SCHED;
            PG8_LDB(B0, 1, 0); PG8_LDB(B1, 1, 1); PG8_SCHED; PG8_LDA(At, 1, 0); PG8_STAGE(PG8_SA(0, 1), a2 + hstep, voffA);
            PG8_WAIT_V(8); PG8_WAIT_L(0); PG8_BAR; PG8_MMA(0, 0, At, B0); PG8_MMA(0, 1, At, B1); PG8_BAR; PG8_SCHED;
            PG8_LDA(At, 1, 1); PG8_STAGE(PG8_SB(1, 0), b3, voffB); PG8_STAGE(PG8_SB(1, 1), b3 + hstep, voffB); PG8_STAGE(PG8_SA(1, 0), a3, voffA);
            PG8_WAIT_V(8); PG8_WAIT_L(0); PG8_BAR; PG8_MMA(1, 0, At, B0); PG8_MMA(1, 1, At, B1); PG8_BAR; PG8_SCHED;
            } else {
            PG8_LDB(B0, 0, 0); PG8_SCHED; PG8_LDA(At, 0, 0); PG8_STAGE(PG8_SA(1, 1), a1 + hstep, voffA);
            PG8_WAIT_L(8); PG8_BAR; PG8_WAIT_L(0); PG8_MMA(0, 0, At, B0); PG8_BAR; PG8_SCHED;
            PG8_LDB(B1, 0, 1); PG8_STAGE(PG8_SB(0, 0), b2, voffB);
            PG8_BAR; PG8_WAIT_L(0); PG8_MMA(0, 1, At, B1); PG8_BAR;
            PG8_LDA(At, 0, 1); PG8_STAGE(PG8_SA(0, 0), a2, voffA);
            PG8_BAR; PG8_WAIT_L(0); PG8_MMA(1, 0, At, B0); PG8_BAR; PG8_SCHED;
            PG8_STAGE(PG8_SB(0, 1), b2 + hstep, voffB);
            PG8_WAIT_V(6); PG8_BAR; PG8_MMA(1, 1, At, B1); PG8_BAR;
            PG8_LDB(B0, 1, 0); PG8_SCHED; PG8_LDA(At, 1, 0); PG8_STAGE(PG8_SA(0, 1), a2 + hstep, voffA);
            PG8_WAIT_L(8); PG8_BAR; PG8_WAIT_L(0); PG8_MMA(0, 0, At, B0); PG8_BAR; PG8_SCHED;
            PG8_LDB(B1, 1, 1); PG8_STAGE(PG8_SB(1, 0), b3, voffB);
            PG8_BAR; PG8_WAIT_L(0); PG8_MMA(0, 1, At, B1); PG8_BAR;
            PG8_LDA(At, 1, 1); PG8_STAGE(PG8_SA(1, 0), a3, voffA);
            PG8_BAR; PG8_WAIT_L(0); PG8_MMA(1, 0, At, B0); PG8_BAR; PG8_SCHED;
            PG8_STAGE(PG8_SB(1, 1), b3 + hstep, voffB);
            PG8_WAIT_V(6); PG8_BAR; PG8_MMA(1, 1, At, B1); PG8_BAR;
            }
        }
        if constexpr (ALIGN_EPI) { if (wr == 0) PG8_BAR; }
        if constexpr (!Epi::AFTER_DRAIN) { E(acc, cur, wr, wc, fr, fq); S.done(cur); }
        if (!has_next) break;
#pragma unroll
        for (int a = 0; a < 2; ++a)
#pragma unroll
            for (int b = 0; b < 2; ++b)
#pragma unroll
                for (int m = 0; m < 4; ++m)
#pragma unroll
                    for (int n = 0; n < 2; ++n) acc[a][b][m][n] = (f32x4){0.f, 0.f, 0.f, 0.f};
        cur = nxt; cA = nA; cB = nB; ++ui;
        if constexpr (ALIGN_EPI) { if (wr == 1) PG8_BAR; }
    }
    PG8_WAIT_V(0);
    if constexpr (!ALIGN_EPI) { if (wr == 0) PG8_BAR; }
    PG8_BAR;
    if constexpr (Epi::AFTER_DRAIN) { E.fused(acc, cur, wr, wc, fr, fq, lds, wid, lane); S.done(cur); }
#undef PG8_SA
#undef PG8_SB
#undef PG8_STAGE
#undef PG8_LDA
#undef PG8_LDB
#undef PG8_MMA
#undef PG8_WAIT_V
#undef PG8_WAIT_L
#undef PG8_BAR
#undef PG8_SCHED
}
}
namespace pg8 {
struct EpiF32 {
    static constexpr bool PERM = false, AFTER_DRAIN = false;
    float* O; int ldc;
    __device__ __forceinline__ void operator()(const f32x4 (&acc)[2][2][4][2], const Unit& u, int wr, int wc, int fr, int fq) const {
        { int ln_ = LANEID(); asm volatile("" : "+v"(ln_)); fr = ln_ & 15; fq = ln_ >> 4; }
        const int row0 = u.pm * BM + wr * 64 + fr, col0 = u.pn * BM + wc * 32 + 4 * fq;
#pragma unroll
        for (int ai = 0; ai < 2; ++ai)
#pragma unroll
            for (int m = 0; m < 4; ++m) { float* rowp = O + (size_t)(row0 + ai * HALF + m * 16) * ldc + col0;
#pragma unroll
                for (int bj = 0; bj < 2; ++bj)
#pragma unroll
                    for (int n = 0; n < 2; ++n) *(f32x4*)(rowp + bj * HALF + n * 16) = acc[ai][bj][m][n]; }
    }
};
struct EpiResY {
    static constexpr bool PERM = false, AFTER_DRAIN = false;
    const float* hin; float* yout; bf16_t* yb; float* stats; float alpha;
    __device__ __forceinline__ void operator()(const f32x4 (&acc)[2][2][4][2], const Unit& u, int wr, int wc, int fr, int fq) const {
        { int ln_ = LANEID(); asm volatile("" : "+v"(ln_)); fr = ln_ & 15; fq = ln_ >> 4; }
        const int row0 = u.pm * BM + wr * 64 + fr, col0 = u.pn * BM + wc * 32 + 4 * fq;
#pragma unroll
        for (int ai = 0; ai < 2; ++ai)
#pragma unroll
            for (int m = 0; m < 4; ++m) {
                const int row = row0 + ai * HALF + m * 16;
                float s = 0.f, s2 = 0.f;
#pragma unroll
                for (int bj = 0; bj < 2; ++bj)
#pragma unroll
                    for (int n = 0; n < 2; ++n) {
                        const size_t off = (size_t)row * 1024 + col0 + bj * HALF + n * 16;
                        const f32x4 hv = *(const f32x4*)(hin + off);
                        const f32x4 y = hv * alpha + acc[ai][bj][m][n];
                        *(f32x4*)(yout + off) = y;
                        typedef unsigned u32x2v __attribute__((ext_vector_type(2)));
                        u32x2v w; w.x = cvt_pk_bf16(y[0], y[1]); w.y = cvt_pk_bf16(y[2], y[3]);
                        *(u32x2v*)(yb + off) = w;
                        s += (y[0] + y[1]) + (y[2] + y[3]); s2 += (y[0] * y[0] + y[1] * y[1]) + (y[2] * y[2] + y[3] * y[3]);
                    }
                s += __shfl_xor(s, 16); s += __shfl_xor(s, 32); s2 += __shfl_xor(s2, 16); s2 += __shfl_xor(s2, 32);
                if (fq == 0) { atomicAdd(stats + 2 * (size_t)row, s); atomicAdd(stats + 2 * (size_t)row + 1, s2); }
            }
    }
};
struct EpiLnFold {
    static constexpr bool PERM = true, AFTER_DRAIN = false;
    bf16_t* O; const float* stats; const float* colsum; const float* colbias; float eps;
    __device__ __forceinline__ void operator()(const f32x4 (&acc)[2][2][4][2], const Unit& u, int wr, int wc, int fr, int fq) const {
        { int ln_ = LANEID(); asm volatile("" : "+v"(ln_)); fr = ln_ & 15; fq = ln_ >> 4; }
        const int row0 = u.pm * BM + wr * 64 + fr, col0 = u.pn * BM + wc * 32 + 8 * fq;
        f32x4 cs[2][2], cb[2][2];
#pragma unroll
        for (int bj = 0; bj < 2; ++bj)
#pragma unroll
            for (int n = 0; n < 2; ++n) { cs[bj][n] = *(const f32x4*)(colsum + col0 + bj * HALF + 4 * n); cb[bj][n] = *(const f32x4*)(colbias + col0 + bj * HALF + 4 * n); }
#pragma unroll
        for (int ai = 0; ai < 2; ++ai)
#pragma unroll
            for (int m = 0; m < 4; ++m) {
                const int row = row0 + ai * HALF + m * 16;
                const float sm_ = stats[2 * (size_t)row], sq_ = stats[2 * (size_t)row + 1];
                const float mean = sm_ * (1.0f / 1024.0f);
                const float rstd = 1.0f / sqrtf(fmaxf(sq_ * (1.0f / 1024.0f) - mean * mean, 0.f) + eps);
                bf16_t* rowp = O + (size_t)row * 1024 + col0;
#pragma unroll
                for (int bj = 0; bj < 2; ++bj) {
                    const f32x4 v0 = (acc[ai][bj][m][0] - cs[bj][0] * mean) * rstd + cb[bj][0], v1 = (acc[ai][bj][m][1] - cs[bj][1] * mean) * rstd + cb[bj][1];
                    u32x4 w; w.x = cvt_pk_bf16(v0[0], v0[1]); w.y = cvt_pk_bf16(v0[2], v0[3]); w.z = cvt_pk_bf16(v1[0], v1[1]); w.w = cvt_pk_bf16(v1[2], v1[3]);
                    *(u32x4*)(rowp + bj * HALF) = w;
                }
            }
    }
};
}

typedef unsigned short bf16;
constexpr int T_ = 16384, S_ = 4096, NBATCH = 4, D_ = 1024, NCOL = 6824, NP = 6912, DEPTH_ = 2;
constexpr int C_QA = 0, C_KA = 256, C_VA = 320, C_QI = 384, C_KI = 640, C_WI = 672, C_QB = 680, C_KB = 936, C_VB = 1064,
              C_QC = 1192, C_KC = 1448, C_VC = 1704, C_QD = 1960, C_KD = 2216, C_VD = 2472, C_G = 2728;
constexpr int NTHR = 512, NWAVE = 8;
constexpr float ALPHA = 1.41421356237309515f;
constexpr float LN_EPS = 1e-5f;
constexpr size_t MiB = 1u << 20;
constexpr size_t WS_STATS = 1 * MiB  , WS_COLS = 1 * MiB + 512 * 1024  ;
constexpr size_t WS_CTL = 0, WS_WIN_T = 2 * MiB, WS_WOUT_T = 30 * MiB, WS_WQ_T = 34 * MiB, WS_WBR_T = 38 * MiB, WS_HB = 42 * MiB,
                 WS_P = 74 * MiB, WS_MIX = 74 * MiB  , WS_Q = 138 * MiB  , WS_YS = 290 * MiB, WS_MRG = 322 * MiB,
                 WS_MASK = 354 * MiB, WS_EID = 362 * MiB, WS_GATE = 370 * MiB, WS_KMEAN = 378 * MiB, WS_SKB = 379 * MiB, WS_UV = 380 * MiB, WS_END = 508 * MiB;
constexpr size_t WIN_T_BYTES = (size_t)NP * 1024 * 2;
constexpr int LDS_BYTES = 144 * 1024;

struct Params { const float* in[13]; float* out; unsigned char* ws; };

__device__ __forceinline__ float bf2f(bf16 v) { return __uint_as_float((unsigned)v << 16); }
__device__ __forceinline__ unsigned f2bf(float f) { unsigned u = __float_as_uint(f); return (u + 0x7fffu + ((u >> 16) & 1u)) >> 16; }
__device__ __forceinline__ unsigned pk2(float lo, float hi) { return f2bf(lo) | (f2bf(hi) << 16); }
__device__ __forceinline__ void unpack8(const uint4 v, float* o) {
    o[0] = __uint_as_float(v.x << 16); o[1] = __uint_as_float(v.x & 0xffff0000u); o[2] = __uint_as_float(v.y << 16); o[3] = __uint_as_float(v.y & 0xffff0000u);
    o[4] = __uint_as_float(v.z << 16); o[5] = __uint_as_float(v.z & 0xffff0000u); o[6] = __uint_as_float(v.w << 16); o[7] = __uint_as_float(v.w & 0xffff0000u);
}
__device__ __forceinline__ float wave_sum(float v) {
#pragma unroll
    for (int o = 32; o > 0; o >>= 1) v += __shfl_xor(v, o);
    return v;
}
__device__ __forceinline__ float wave_max(float v) {
#pragma unroll
    for (int o = 32; o > 0; o >>= 1) v = fmaxf(v, __shfl_xor(v, o));
    return v;
}
__device__ __forceinline__ int wave_sum_i(int v) {
#pragma unroll
    for (int o = 32; o > 0; o >>= 1) v += __shfl_xor(v, o);
    return v;
}
__device__ __forceinline__ float logsig(float x) { return fminf(x, 0.f) - log1pf(expf(-fabsf(x))); }

__device__ void transpose_items(int WV_, const float* W, int K, int N, bf16* WT, float* sm, int item0, int nitems_total, int item_stride,
                                const float* rs_g = nullptr, const float* rs_b = nullptr, float* colsum = nullptr, float* colbias = nullptr) {
    const int tid = LTID(WV_);
    const int nkb = K / 64, nnb = (N + 63) / 64;
    for (int it = item0; it < nkb * nnb; it += item_stride) {
        const int kb = it % nkb, nb = it / nkb, k0 = kb * 64, n0 = nb * 64;
        __syncthreads();
        for (int e = tid; e < 64 * 64; e += NTHR) { const int kk = e >> 6, nn = e & 63; sm[kk * 65 + nn] = (n0 + nn < N) ? W[(size_t)(k0 + kk) * N + n0 + nn] : 0.f; }
        __syncthreads();
        if (rs_g) {
            if (tid < 64) { float cs = 0.f, cb = 0.f;
                for (int kk = 0; kk < 64; ++kk) { const float w = sm[kk * 65 + tid]; cs += w * rs_g[k0 + kk]; cb += w * rs_b[k0 + kk]; }
                atomicAdd(colsum + n0 + tid, cs); atomicAdd(colbias + n0 + tid, cb); }
            __syncthreads();
            for (int e = tid; e < 64 * 64; e += NTHR) { const int kk = e >> 6, nn = e & 63; sm[kk * 65 + nn] *= rs_g[k0 + kk]; }
            __syncthreads();
        }
        { const int nn = tid >> 3, c = tid & 7;
          if (n0 + nn < N) { uint4 o; o.x = pk2(sm[(8 * c + 0) * 65 + nn], sm[(8 * c + 1) * 65 + nn]); o.y = pk2(sm[(8 * c + 2) * 65 + nn], sm[(8 * c + 3) * 65 + nn]);
              o.z = pk2(sm[(8 * c + 4) * 65 + nn], sm[(8 * c + 5) * 65 + nn]); o.w = pk2(sm[(8 * c + 6) * 65 + nn], sm[(8 * c + 7) * 65 + nn]);
              *(uint4*)(WT + (size_t)(n0 + nn) * K + k0 + 8 * c) = o; } }
    }
    __syncthreads();
}
__device__ void prologue_phase(int WV_, const Params& p, float* sm) {
    const int tid = LTID(WV_), B = LBID(), G = LGRID();
    unsigned char* ws = p.ws;
    for (int l = 0; l < DEPTH_; ++l) {
        bf16* win_t = (bf16*)(ws + WS_WIN_T + l * WIN_T_BYTES);
        transpose_items(WV_, p.in[1] + (size_t)l * 1024 * NCOL, 1024, NCOL, win_t, sm, B, 0, G);
        for (int i = B * NTHR + tid; i < (NP - NCOL) * 1024 / 8; i += G * NTHR) ((uint4*)(win_t + (size_t)NCOL * 1024))[i] = make_uint4(0u, 0u, 0u, 0u);
        transpose_items(WV_, p.in[3] + (size_t)l * 1024 * 1024, 1024, 1024, (bf16*)(ws + WS_WOUT_T) + (size_t)l * 1024 * 1024, sm, B, 0, G);
        transpose_items(WV_, p.in[7] + (size_t)l * 1024 * 1024, 1024, 1024, (bf16*)(ws + WS_WQ_T) + (size_t)l * 1024 * 1024, sm, B, 0, G,
                        p.in[5] + l * 1024, p.in[6] + l * 1024, (float*)(ws + WS_COLS) + l * 2048, (float*)(ws + WS_COLS) + l * 2048 + 1024);
        for (int n = 0; n < 4; ++n)
            transpose_items(WV_, p.in[2] + ((size_t)l * 4 + n) * 256 * 1024, 256, 1024, (bf16*)(ws + WS_WBR_T) + ((size_t)l * 4 + n) * 1024 * 256, sm, B, 0, G);
    }
    const float4* x4 = (const float4*)p.in[0]; uint2* hb2 = (uint2*)(ws + WS_HB);
    for (size_t i = (size_t)B * NTHR + tid; i < (size_t)T_ * 1024 / 4; i += (size_t)G * NTHR) { const float4 v = x4[i]; hb2[i] = make_uint2(pk2(v.x, v.y), pk2(v.z, v.w)); }
}

__device__ __forceinline__ void ln_row(float4 (&v)[4], const float* g, const float* bb, float* orow, bf16* obrow, int lane) {
    float s = 0.f;
#pragma unroll
    for (int j = 0; j < 4; ++j) s += (v[j].x + v[j].y) + (v[j].z + v[j].w);
    const float mean = wave_sum(s) * (1.0f / 1024.0f);
    float s2 = 0.f;
#pragma unroll
    for (int j = 0; j < 4; ++j) { v[j].x -= mean; v[j].y -= mean; v[j].z -= mean; v[j].w -= mean; s2 += (v[j].x * v[j].x + v[j].y * v[j].y) + (v[j].z * v[j].z + v[j].w * v[j].w); }
    const float rstd = 1.0f / sqrtf(wave_sum(s2) * (1.0f / 1024.0f) + LN_EPS);
#pragma unroll
    for (int j = 0; j < 4; ++j) {
        const float4 gg = ((const float4*)g)[j * 64 + lane], b4 = ((const float4*)bb)[j * 64 + lane];
        float4 o; o.x = v[j].x * rstd * gg.x + b4.x; o.y = v[j].y * rstd * gg.y + b4.y; o.z = v[j].z * rstd * gg.z + b4.z; o.w = v[j].w * rstd * gg.w + b4.w;
        ((float4*)orow)[j * 64 + lane] = o;
        ((uint2*)obrow)[j * 64 + lane] = make_uint2(pk2(o.x, o.y), pk2(o.z, o.w));
    }
}
__device__ void ln1_phase(int WV_, const float* hin, const float* add, const float* g, const float* bb, float* hout, bf16* hb) {
    const int lane = LTID(WV_) & 63, wave = LTID(WV_) >> 6;
    for (int row = LBID() * NWAVE + wave; row < T_; row += LGRID() * NWAVE) {
        float4 v[4];
#pragma unroll
        for (int j = 0; j < 4; ++j) {
            const float4 a = ((const float4*)(hin + (size_t)row * 1024))[j * 64 + lane], m = ((const float4*)(add + (size_t)row * 1024))[j * 64 + lane];
            v[j].x = ALPHA * a.x + m.x; v[j].y = ALPHA * a.y + m.y; v[j].z = ALPHA * a.z + m.z; v[j].w = ALPHA * a.w + m.w;
        }
        ln_row(v, g, bb, hout + (size_t)row * 1024, hb + (size_t)row * 1024, lane);
    }
}


typedef short bf16x8_t __attribute__((ext_vector_type(8)));
typedef float f32x16_t __attribute__((ext_vector_type(16)));
typedef float f32x2_t __attribute__((ext_vector_type(2)));
typedef __bf16 bf16x2_t __attribute__((ext_vector_type(2)));
__device__ __forceinline__ unsigned cvtpk(float lo, float hi) { f32x2_t v = {lo, hi}; bf16x2_t b = __builtin_convertvector(v, bf16x2_t); return __builtin_bit_cast(unsigned, b); }
__device__ __forceinline__ int crow(int r, int hi) { return (r & 3) + 8 * (r >> 2) + 4 * hi; }
__device__ __forceinline__ float xlane32(float v) { return __shfl_xor(v, 32); }
__device__ __forceinline__ float vmax(float a, float b) { float r; asm("v_max_f32_e32 %0, %1, %2" : "=v"(r) : "v"(a), "v"(b)); return r; }
__device__ __forceinline__ float vmin(float a, float b) { float r; asm("v_min_f32_e32 %0, %1, %2" : "=v"(r) : "v"(a), "v"(b)); return r; }
__device__ __forceinline__ float vmax3(float a, float b, float c) { float r; asm("v_max3_f32 %0, %1, %2, %3" : "=v"(r) : "v"(a), "v"(b), "v"(c)); return r; }

constexpr int AT_KP = 72, AT_VP = 68;
constexpr int AT_KS = 0, AT_KS_BYTES = 64 * AT_KP * 2;
constexpr int AT_VT = 2 * AT_KS_BYTES, AT_VT_BYTES = 64 * AT_VP * 2;
constexpr int AT_KM = AT_VT + 2 * AT_VT_BYTES;
constexpr int AT_MISC = AT_KM + 32 * AT_KP * 2;
constexpr float LOG2E = 1.4426950408889634f;

__device__ __forceinline__ unsigned mk_unit(int kind, int b, int x, int y) { return ((unsigned)kind << 30) | ((unsigned)b << 28) | ((unsigned)x << 8) | (unsigned)y; }
__device__ void build_unit_table(unsigned* tab, int i) {
    int n = 0; unsigned res = 0u;
#pragma unroll 1
    for (int c = 64; c >= 1; --c) {
        if (i >= n && i < n + 4) res = mk_unit(0, i - n, 0, c - 1);
        n += 4;
        if ((c & 3) == 0) { if (i >= n && i < n + 16) { const int j = i - n; res = mk_unit(2, j >> 2, j & 3, c / 4 - 1); } n += 16; }
    }
    if (i < 512) tab[i] = res;
}

template <int kind> __device__ __forceinline__ void attn_unit(int WV_, const bf16* P, const unsigned char* mask, const float* kmean, const float* sinks, bf16* ys,
                                unsigned char* lds, int b, int ux, int uy) {
    int tid_ = LTID(WV_); asm volatile("" : "+v"(tid_));
    const int tid = tid_, lane = tid & 63, wave = __builtin_amdgcn_readfirstlane(tid >> 6), r32 = lane & 31, hi = lane >> 5;
    bf16* s_km = (bf16*)(lds + AT_KM);
    const int skey = tid >> 3, sc = tid & 7;
    {
        const bf16* Pb = P + (size_t)b * S_ * NP;
        int q0w, qcol, kcol, vcol, ycol, kt_hi, kt_lo; float slope2 = 0.f, sink2 = 0.f;
        if (kind == 0) { const int head = wave >> 1; q0w = uy * 64 + (wave & 1) * 32; qcol = C_QA + head * 64; kcol = C_KA; vcol = C_VA; ycol = head * 64;
            slope2 = exp2f(-8.0f * (float)(3 * head + 1) / 12.0f) * LOG2E; kt_hi = uy; kt_lo = 0; }
        else if (kind == 1) { const int hq = ux * 2 + (wave >> 2); q0w = uy * 128 + (wave & 3) * 32; qcol = C_QB + hq * 64; kcol = C_KB + ux * 64; vcol = C_VB + ux * 64; ycol = 256 + hq * 64;
            slope2 = exp2f(-8.0f * (float)(3 * hq + 2) / 12.0f) * LOG2E; sink2 = sinks[hq] * LOG2E; kt_hi = 2 * uy + 1; kt_lo = (2 * uy - 2 > 0) ? 2 * uy - 2 : 0; }
        else if (kind == 2) { q0w = uy * 256 + wave * 32; qcol = C_QC + ux * 64; kcol = C_KC + ux * 64; vcol = C_VC + ux * 64; ycol = 512 + ux * 64;
            slope2 = exp2f(-8.0f * (float)(3 * ux + 3) / 12.0f) * LOG2E; kt_hi = 4 * uy + 3; kt_lo = 0; }
        else { q0w = uy * 256 + wave * 32; qcol = C_QD + ux * 64; kcol = C_KD + ux * 64; vcol = C_VD + ux * 64; ycol = 768 + ux * 64; kt_hi = 4 * uy + 3; kt_lo = 0; }
        const int qpos = q0w + r32;
        bf16x8_t qf[4];
        { const bf16* qp = Pb + (size_t)qpos * NP + qcol + 8 * hi;
#pragma unroll
          for (int ks = 0; ks < 4; ++ks) qf[ks] = *(const bf16x8_t*)(qp + 16 * ks); }
        {
            const float qs = (kind == 3) ? 0.125f : 0.125f * LOG2E;
            typedef unsigned u32x4_t __attribute__((ext_vector_type(4)));
#pragma unroll
            for (int ks = 0; ks < 4; ++ks) { u32x4_t w = __builtin_bit_cast(u32x4_t, qf[ks]);
#pragma unroll
                for (int i = 0; i < 4; ++i) w[i] = cvtpk(__uint_as_float(w[i] << 16) * qs, __uint_as_float(w[i] & 0xffff0000u) * qs);
                qf[ks] = __builtin_bit_cast(bf16x8_t, w); }
        }
        float sb[16];
#pragma unroll
        for (int r = 0; r < 16; ++r) sb[r] = slope2 * (float)((r & 3) + 8 * (r >> 2));
        unsigned bm = 0u;
        if (kind == 2) {
            const int own = uy;
            for (int e = tid; e < 32 * 64; e += NTHR) { const int row = e >> 6, d = e & 63; s_km[row * AT_KP + d] = (row < 16) ? (bf16)f2bf(kmean[((b * 4 + ux) * 16 + row) * 64 + d]) : (bf16)0; }
            __syncthreads();
            f32x16_t gacc;
#pragma unroll
            for (int r = 0; r < 16; ++r) gacc[r] = 0.f;
#pragma unroll
            for (int ks = 0; ks < 4; ++ks) { const bf16x8_t a = *(const bf16x8_t*)(s_km + r32 * AT_KP + 16 * ks + 8 * hi); gacc = __builtin_amdgcn_mfma_f32_32x32x16_bf16(a, qf[ks], gacc, 0, 0, 0); }
            float gt[16];
#pragma unroll
            for (int r = 0; r < 8; ++r) { const float mine = gacc[r], other = xlane32(mine); const int bi = crow(r, 0);
                gt[bi] = hi ? other : mine; gt[bi + 4] = hi ? mine : other; }
#pragma unroll
            for (int n = 0; n < 16; ++n) if (n >= own) gt[n] = -INFINITY;
#pragma unroll
            for (int rep = 0; rep < 3; ++rep) {
                float mx = -INFINITY;
#pragma unroll
                for (int n = 0; n < 16; ++n) mx = fmaxf(mx, gt[n]);
                bool done = !(mx > -INFINITY);
#pragma unroll
                for (int n = 0; n < 16; ++n) { const bool hit = !done && gt[n] == mx; if (hit) { bm |= 1u << n; gt[n] = -INFINITY; done = true; } }
            }
        }
        f32x16_t o0, o1;
#pragma unroll
        for (int r = 0; r < 16; ++r) { o0[r] = 0.f; o1[r] = 0.f; }
        float m_run = -INFINITY, l_run = 0.f, carry = 0.f;
        const bf16* kg = Pb + (size_t)skey * NP + kcol + sc * 8;
        const bf16* vg = Pb + (size_t)skey * NP + vcol + sc * 8;
        uint4 rk = *(const uint4*)(kg + (size_t)kt_hi * 64 * NP), rv = *(const uint4*)(vg + (size_t)kt_hi * 64 * NP);
        int buf = 0;
        { bf16* ks_ = (bf16*)(lds + AT_KS); bf16* vt_ = (bf16*)(lds + AT_VT);
          *(uint4*)(ks_ + skey * AT_KP + sc * 8) = rk;
          const unsigned vw[4] = {rv.x, rv.y, rv.z, rv.w};
#pragma unroll
          for (int j = 0; j < 4; ++j) { vt_[(sc * 8 + 2 * j) * AT_VP + skey] = (bf16)(vw[j] & 0xffffu); vt_[(sc * 8 + 2 * j + 1) * AT_VP + skey] = (bf16)(vw[j] >> 16); } }
        __syncthreads();
        bool wave_done = false;
        uint2 mw_next = make_uint2(0u, 0u);
        if (kind == 0) mw_next = *(const uint2*)(mask + (size_t)(b * S_ + qpos) * 512 + kt_hi * 8);
        for (int kt = kt_hi; kt >= kt_lo; --kt) {
            const bool more = kt > kt_lo;
            const uint2 mw = mw_next;
            if (kind == 0 && more) mw_next = *(const uint2*)(mask + (size_t)(b * S_ + qpos) * 512 + (kt - 1) * 8);
            if (more) { rk = *(const uint4*)(kg + (size_t)(kt - 1) * 64 * NP); rv = *(const uint4*)(vg + (size_t)(kt - 1) * 64 * NP); }
            const bf16* ks_ = (const bf16*)(lds + AT_KS + buf * AT_KS_BYTES);
            const bf16* vt_ = (const bf16*)(lds + AT_VT + buf * AT_VT_BYTES);
            bool active = (kt * 64 <= q0w + 31) && !wave_done;
            if (kind == 1) active = active && (kt * 64 + 63 >= q0w - 127);
            if (active) {
                const int kbase = kt * 64 + 4 * hi;
                f32x16_t p0, p1;
                if (kind != 3) {
                    const float cb = slope2 * (float)(kbase - qpos), cb1 = cb + 32.0f * slope2;
#pragma unroll
                    for (int r = 0; r < 16; ++r) { p0[r] = cb + sb[r]; p1[r] = cb1 + sb[r]; }
                } else {
#pragma unroll
                    for (int r = 0; r < 16; ++r) { p0[r] = 0.f; p1[r] = 0.f; }
                }
#pragma unroll
                for (int ks = 0; ks < 4; ++ks) {
                    const bf16x8_t a0 = *(const bf16x8_t*)(ks_ + r32 * AT_KP + 16 * ks + 8 * hi);
                    const bf16x8_t a1 = *(const bf16x8_t*)(ks_ + (32 + r32) * AT_KP + 16 * ks + 8 * hi);
                    p0 = __builtin_amdgcn_mfma_f32_32x32x16_bf16(a0, qf[ks], p0, 0, 0, 0);
                    p1 = __builtin_amdgcn_mfma_f32_32x32x16_bf16(a1, qf[ks], p1, 0, 0, 0);
                }
                if (kind != 3) {
                    float mx = -INFINITY;
                    if (kind == 0) {
                        const unsigned w0 = mw.x >> (4 * hi), w1 = mw.y >> (4 * hi);
#pragma unroll
                        for (int r = 0; r < 16; ++r) { const int off = (r & 3) + 8 * (r >> 2);
                            p0[r] = (w0 & (1u << off)) ? p0[r] : -INFINITY; p1[r] = (w1 & (1u << off)) ? p1[r] : -INFINITY; mx = vmax3(mx, p0[r], p1[r]); }
                    } else if (kind == 1) {
                        const int rel = qpos - kbase;
#pragma unroll
                        for (int r = 0; r < 16; ++r) { const int off = (r & 3) + 8 * (r >> 2);
                            p0[r] = ((unsigned)(rel - off) < 128u) ? p0[r] : -INFINITY; p1[r] = ((unsigned)(rel - off - 32) < 128u) ? p1[r] : -INFINITY; mx = vmax3(mx, p0[r], p1[r]); }
                    } else {
                        if ((kt >> 2) == uy) {
                            const int rel = qpos - kbase;
#pragma unroll
                            for (int r = 0; r < 16; ++r) { const int off = (r & 3) + 8 * (r >> 2);
                                p0[r] = (off <= rel) ? p0[r] : -INFINITY; p1[r] = (off + 32 <= rel) ? p1[r] : -INFINITY; mx = vmax3(mx, p0[r], p1[r]); }
                        } else {
                            const bool tile_ok = ((bm >> (kt >> 2)) & 1u) != 0u;
#pragma unroll
                            for (int r = 0; r < 16; ++r) { p0[r] = tile_ok ? p0[r] : -INFINITY; p1[r] = tile_ok ? p1[r] : -INFINITY; mx = vmax3(mx, p0[r], p1[r]); }
                        }
                    }
                    mx = vmax(mx, xlane32(mx));
                    const float m_new = vmax(m_run, mx);
                    const float m_safe = (m_new == -INFINITY) ? 0.f : m_new;
                    p0 = p0 - m_safe; p1 = p1 - m_safe;
#pragma unroll
                    for (int r = 0; r < 16; ++r) { p0[r] = __builtin_amdgcn_exp2f(p0[r]); p1[r] = __builtin_amdgcn_exp2f(p1[r]); }
                    float ls;
                    { typedef float f32x8_t __attribute__((ext_vector_type(8))); typedef float f32x4v_t __attribute__((ext_vector_type(4)));
                      const f32x16_t t16 = p0 + p1; const f32x8_t t8 = t16.lo + t16.hi; const f32x4v_t t4 = t8.lo + t8.hi; const f32x2_t t2 = t4.lo + t4.hi; ls = t2.x + t2.y; }
                    if (__any(m_new > m_run)) {
                        const float alpha = __builtin_amdgcn_exp2f(m_run - m_safe);
                        l_run *= alpha;
                        o0 = o0 * alpha; o1 = o1 * alpha;
                    }
                    l_run += ls; m_run = m_new;
                } else {
                    float run = carry;
#define SB_HALF(PX, KOFF) do { \
                    float lk[16]; \
                    _Pragma("unroll") for (int r = 0; r < 16; ++r) { \
                        const int off = (r & 3) + 8 * (r >> 2); \
                        const bool v = (kbase + off + (KOFF)) < qpos; \
                        const float z = PX[r]; \
                        const float t = 0.6931471805599453f * __builtin_amdgcn_logf(1.0f + __builtin_amdgcn_exp2f(-LOG2E * fabsf(z))); \
                        lk[r] = v ? (fminf(-z, 0.f) - t) : 0.f; \
                        PX[r] = v ? (fminf(z, 0.f) - t) : -INFINITY; } \
                    _Pragma("unroll") for (int g = 3; g >= 0; --g) { \
                        const float G = (lk[4 * g] + lk[4 * g + 1]) + (lk[4 * g + 2] + lk[4 * g + 3]); \
                        const float PG = xlane32(G); \
                        float la = run + (hi ? 0.f : PG); \
                        run += G + PG; \
                        PX[4 * g + 3] += la; la += lk[4 * g + 3]; PX[4 * g + 2] += la; la += lk[4 * g + 2]; PX[4 * g + 1] += la; la += lk[4 * g + 1]; PX[4 * g] += la; } \
                    _Pragma("unroll") for (int r = 0; r < 16; ++r) PX[r] = __builtin_amdgcn_exp2f(LOG2E * PX[r]); } while (0)
                    SB_HALF(p1, 32);
                    SB_HALF(p0, 0);
#undef SB_HALF
                    carry = run;
                }
                unsigned pw[16];
#pragma unroll
                for (int j = 0; j < 8; ++j) { pw[j] = cvtpk(p0[2 * j], p0[2 * j + 1]); pw[8 + j] = cvtpk(p1[2 * j], p1[2 * j + 1]); }
#pragma unroll
                for (int s = 0; s < 4; ++s) {
                    bf16x8_t pb; { const unsigned* q = pw + 4 * s; typedef unsigned u32x4_t __attribute__((ext_vector_type(4))); u32x4_t t4 = {q[0], q[1], q[2], q[3]}; pb = __builtin_bit_cast(bf16x8_t, t4); }
#pragma unroll
                    for (int dt = 0; dt < 2; ++dt) {
                        const bf16* vp = vt_ + (32 * dt + r32) * AT_VP + 16 * s + 4 * hi;
                        typedef short s16x4_t __attribute__((ext_vector_type(4)));
                        const s16x4_t lo = *(const s16x4_t*)vp, hi4 = *(const s16x4_t*)(vp + 8);
                        const bf16x8_t va = {lo[0], lo[1], lo[2], lo[3], hi4[0], hi4[1], hi4[2], hi4[3]};
                        if (dt == 0) o0 = __builtin_amdgcn_mfma_f32_32x32x16_bf16(va, pb, o0, 0, 0, 0);
                        else         o1 = __builtin_amdgcn_mfma_f32_32x32x16_bf16(va, pb, o1, 0, 0, 0);
                    }
                }
            }
            if (kind == 3) {
                const float cm = carry;
                if (__all(cm < -110.0f) || !(kt * 64 <= q0w + 31) ) { if (__all(cm < -110.0f)) wave_done = true; }
            }
            if (more) {
                bf16* ksn = (bf16*)(lds + AT_KS + (buf ^ 1) * AT_KS_BYTES); bf16* vtn = (bf16*)(lds + AT_VT + (buf ^ 1) * AT_VT_BYTES);
                *(uint4*)(ksn + skey * AT_KP + sc * 8) = rk;
                const unsigned vw[4] = {rv.x, rv.y, rv.z, rv.w};
#pragma unroll
                for (int j = 0; j < 4; ++j) { vtn[(sc * 8 + 2 * j) * AT_VP + skey] = (bf16)(vw[j] & 0xffffu); vtn[(sc * 8 + 2 * j + 1) * AT_VP + skey] = (bf16)(vw[j] >> 16); }
            }
            if (kind == 3) { if (__syncthreads_and(wave_done ? 1 : 0)) break; }
            else __syncthreads();
            buf ^= 1;
        }
        float inv;
        if (kind == 3) inv = 1.0f;
        else {
            float lt = l_run + xlane32(l_run);
            if (kind == 1) { const float mf = fmaxf(m_run, sink2); const float sc2 = exp2f(m_run - mf); lt = lt * sc2 + exp2f(sink2 - mf); inv = sc2 / lt; }
            else inv = 1.0f / lt;
        }
        bf16* yp = ys + (size_t)(b * S_ + qpos) * 1024 + ycol + 4 * hi;
#pragma unroll
        for (int g = 0; g < 4; ++g) {
            *(uint2*)(yp + 8 * g) = make_uint2(cvtpk(o0[4 * g] * inv, o0[4 * g + 1] * inv), cvtpk(o0[4 * g + 2] * inv, o0[4 * g + 3] * inv));
            *(uint2*)(yp + 32 + 8 * g) = make_uint2(cvtpk(o1[4 * g] * inv, o1[4 * g + 1] * inv), cvtpk(o1[4 * g + 2] * inv, o1[4 * g + 3] * inv));
        }
    }
}
__device__ void attn_fast_phase(int WV_, const bf16* P, const unsigned char* mask, const float* kmean, const float* sinks, bf16* ys,
                                const unsigned* utab, unsigned* counter, unsigned char* lds) {
    volatile unsigned* s_unit = (volatile unsigned*)(lds + AT_MISC);
    for (;;) {
        __syncthreads();
        if (LTID(WV_) == 0) s_unit[0] = atomicAdd(counter, 1u);
        __syncthreads();
        const unsigned ui = s_unit[0];
        if (ui >= 512u) break;
        const unsigned ue = utab[ui];
        const int kind = (int)(ue >> 30), b = (int)((ue >> 28) & 3u), ux = (int)((ue >> 8) & 255u), uy = (int)(ue & 255u);
        if (kind == 0) attn_unit<0>(WV_, P, mask, kmean, sinks, ys, lds, b, ux, uy);
        else attn_unit<2>(WV_, P, mask, kmean, sinks, ys, lds, b, ux, uy);
    }
    for (int u = LBID(); u < 256; u += LGRID()) { __syncthreads(); attn_unit<3>(WV_, P, mask, kmean, sinks, ys, lds, u >> 6, (u >> 4) & 3, u & 15); }
    for (int u = LBID(); u < 256; u += LGRID()) { __syncthreads(); attn_unit<1>(WV_, P, mask, kmean, sinks, ys, lds, u >> 6, (u >> 5) & 1, u & 31); }
}

constexpr float U_SCALE = 128.0f, V_SCALE = 48.0f;
constexpr int ROW6 = 1536;
typedef float v32f_t __attribute__((ext_vector_type(32)));
typedef unsigned v6u_t __attribute__((ext_vector_type(6)));
__device__ __forceinline__ float rdlane_f(float v, int l) { return __builtin_bit_cast(float, __builtin_amdgcn_readlane(__builtin_bit_cast(int, v), l)); }
__device__ __forceinline__ unsigned q_e2m3(float v) {
    const float a = fminf(fabsf(v), 7.5f);
    unsigned code;
    if (a < 1.0f) code = (unsigned)rintf(a * 8.0f);
    else if (a < 2.0f) code = 8u + (unsigned)rintf((a - 1.0f) * 8.0f);
    else if (a < 4.0f) code = 16u + (unsigned)rintf((a - 2.0f) * 4.0f);
    else code = 24u + (unsigned)rintf((a - 4.0f) * 2.0f);
    return code | (v < 0.f ? 32u : 0u);
}
__device__ void convert_tables(int WV_, const Params& p) {
    const size_t nchunk = (size_t)DEPTH_ * 16384 * 2 * 32;
    for (size_t i = (size_t)LBID() * NTHR + LTID(WV_); i < nchunk; i += (size_t)LGRID() * NTHR) {
        const int c = (int)(i & 31), uvsel = (int)((i >> 5) & 1); const size_t le = i >> 6;
        const float* src = (uvsel ? p.in[10] : p.in[9]) + le * 1024 + c * 32;
        const float sc = uvsel ? V_SCALE : U_SCALE;
        unsigned w[6] = {0u, 0u, 0u, 0u, 0u, 0u};
#pragma unroll
        for (int q4 = 0; q4 < 8; ++q4) {
            const float4 a = ((const float4*)src)[q4];
            const float av[4] = {a.x, a.y, a.z, a.w};
#pragma unroll
            for (int e = 0; e < 4; ++e) { const int idx = q4 * 4 + e, bit = 6 * idx, d = bit >> 5, s = bit & 31; const unsigned code = q_e2m3(av[e] * sc);
                w[d] |= code << s; if (s > 26) w[d + 1] |= code >> (32 - s); }
        }
        uint2* dst = (uint2*)(p.ws + WS_UV + le * ROW6 + uvsel * 768 + c * 24);
        dst[0] = make_uint2(w[0], w[1]); dst[1] = make_uint2(w[2], w[3]); dst[2] = make_uint2(w[4], w[5]);
    }
}
__device__ __forceinline__ v6u_t ld_pk6(const unsigned char* ptr) {
    const uint2 a = ((const uint2*)ptr)[0], b = ((const uint2*)ptr)[1], c = ((const uint2*)ptr)[2];
    const v6u_t pk = {a.x, a.y, b.x, b.y, c.x, c.y};
    return pk;
}
__device__ void peer_fast_phase(int WV_, float* h, bf16* hb, const int* eid, const float* gate, const unsigned char* uv, const float* g1, const float* b1, const float* g, const float* bb, unsigned char* lds) {
    const int tid = LTID(WV_), lane = tid & 63, wave = tid >> 6, l32 = lane & 31, hi = lane >> 5;
    float* pl = (float*)(lds + wave * 16384);
    unsigned char* raw = lds + wave * 16384 + 4096 + lane * 24;
    for (int t = LBID() * NWAVE + wave; t < T_; t += LGRID() * NWAVE) {
        float* hr = h + (size_t)t * 1024 + l32 * 32;
        float x[32], acc[32];
#pragma unroll
        for (int q4 = 0; q4 < 8; ++q4) { const float4 a = ((const float4*)hr)[q4]; x[4 * q4] = a.x; x[4 * q4 + 1] = a.y; x[4 * q4 + 2] = a.z; x[4 * q4 + 3] = a.w; }
        {
            float s = 0.f;
#pragma unroll
            for (int i = 0; i < 32; ++i) s += x[i];
#pragma unroll
            for (int o = 16; o > 0; o >>= 1) s += __shfl_xor(s, o);
            const float mean = s * (1.0f / 1024.0f);
            float s2 = 0.f;
#pragma unroll
            for (int i = 0; i < 32; ++i) { x[i] -= mean; s2 += x[i] * x[i]; }
#pragma unroll
            for (int o = 16; o > 0; o >>= 1) s2 += __shfl_xor(s2, o);
            const float rstd = 1.0f / sqrtf(s2 * (1.0f / 1024.0f) + LN_EPS);
#pragma unroll
            for (int q4 = 0; q4 < 8; ++q4) { const float4 gg = ((const float4*)(g1 + l32 * 32))[q4], cc = ((const float4*)(b1 + l32 * 32))[q4];
                x[4 * q4] = x[4 * q4] * rstd * gg.x + cc.x; x[4 * q4 + 1] = x[4 * q4 + 1] * rstd * gg.y + cc.y; x[4 * q4 + 2] = x[4 * q4 + 2] * rstd * gg.z + cc.z; x[4 * q4 + 3] = x[4 * q4 + 3] * rstd * gg.w + cc.w; }
        }
#pragma unroll
        for (int i = 0; i < 32; ++i) acc[i] = 0.f;
#pragma unroll 1
        for (int batch = 0; batch < 4; ++batch) {
            const int my_eid = eid[(size_t)t * 128 + batch * 32 + l32];
            const float my_gate = gate[(size_t)t * 128 + batch * 32 + l32];
#pragma unroll 1
            for (int grp = 0; grp < 2; ++grp) {
                { uint2 pa[8], pb[8], pc[8];
#pragma unroll
                  for (int i = 0; i < 8; ++i) { const int id = __shfl(my_eid, 2 * (grp * 8 + i) + hi); const uint2* rp = (const uint2*)(uv + (size_t)id * ROW6 + l32 * 24); pa[i] = rp[0]; pb[i] = rp[1]; pc[i] = rp[2]; }
#pragma unroll
                  for (int i = 0; i < 8; ++i) { uint2* wp = (uint2*)(raw + i * 1536); wp[0] = pa[i]; wp[1] = pb[i]; wp[2] = pc[i]; } }
#pragma unroll 1
                for (int i = 0; i < 8; ++i) {
                    const uint2* rp = (const uint2*)(raw + i * 1536); const uint2 a = rp[0], b = rp[1], c = rp[2];
                    const v6u_t pk6 = {a.x, a.y, b.x, b.y, c.x, c.y}; const v32f_t f = __builtin_amdgcn_cvt_scalef32_pk32_f32_fp6(pk6, 1.0f);
                    float d0 = 0.f, d1 = 0.f;
#pragma unroll
                    for (int j = 0; j < 16; ++j) { d0 += f[j] * x[j]; d1 += f[16 + j] * x[16 + j]; }
                    pl[(2 * (grp * 8 + i) + hi) * 32 + l32] = d0 + d1;
                }
            }
            float d;
            { const float4* pr = (const float4*)(pl + l32 * 32); float4 s4 = pr[0];
#pragma unroll
              for (int i = 1; i < 8; ++i) { const float4 v = pr[i]; s4.x += v.x; s4.y += v.y; s4.z += v.z; s4.w += v.w; }
              d = ((s4.x + s4.y) + (s4.z + s4.w)) * (1.0f / U_SCALE); }
            const float hv = 0.5f * d * (1.0f + erff(d * 0.70710678118654752f)) * my_gate * (1.0f / V_SCALE);
#pragma unroll 1
            for (int grp = 0; grp < 2; ++grp) {
                { uint2 pa[8], pb[8], pc[8];
#pragma unroll
                  for (int i = 0; i < 8; ++i) { const int id = __shfl(my_eid, 2 * (grp * 8 + i) + hi); const uint2* rp = (const uint2*)(uv + (size_t)id * ROW6 + 768 + l32 * 24); pa[i] = rp[0]; pb[i] = rp[1]; pc[i] = rp[2]; }
#pragma unroll
                  for (int i = 0; i < 8; ++i) { uint2* wp = (uint2*)(raw + i * 1536); wp[0] = pa[i]; wp[1] = pb[i]; wp[2] = pc[i]; } }
#pragma unroll 1
                for (int i = 0; i < 8; ++i) {
                    const float c = __shfl(hv, 2 * (grp * 8 + i) + hi);
                    const uint2* rp = (const uint2*)(raw + i * 1536); const uint2 a = rp[0], b = rp[1], cc = rp[2];
                    const v6u_t pk6 = {a.x, a.y, b.x, b.y, cc.x, cc.y}; const v32f_t f = __builtin_amdgcn_cvt_scalef32_pk32_f32_fp6(pk6, 1.0f);
#pragma unroll
                    for (int j = 0; j < 32; ++j) acc[j] += c * f[j];
                }
            }
        }
        float y[32], s = 0.f;
#pragma unroll
        for (int i = 0; i < 32; ++i) { acc[i] += __shfl_xor(acc[i], 32); y[i] = ALPHA * x[i] + acc[i]; s += y[i]; }
#pragma unroll
        for (int o = 16; o > 0; o >>= 1) s += __shfl_xor(s, o);
        const float mean = s * (1.0f / 1024.0f);
        float s2 = 0.f;
#pragma unroll
        for (int i = 0; i < 32; ++i) { y[i] -= mean; s2 += y[i] * y[i]; }
#pragma unroll
        for (int o = 16; o > 0; o >>= 1) s2 += __shfl_xor(s2, o);
        const float rstd = 1.0f / sqrtf(s2 * (1.0f / 1024.0f) + LN_EPS);
        float o[16];
#pragma unroll
        for (int q4 = 0; q4 < 4; ++q4) {
            const float4 gg = ((const float4*)(g + l32 * 32 + hi * 16))[q4], cc = ((const float4*)(bb + l32 * 32 + hi * 16))[q4];
            float ya[4], yb2[4];
#pragma unroll
            for (int e = 0; e < 4; ++e) { ya[e] = y[4 * q4 + e]; yb2[e] = y[16 + 4 * q4 + e]; }
            asm volatile("" : "+v"(ya[0]), "+v"(ya[1]), "+v"(ya[2]), "+v"(ya[3]), "+v"(yb2[0]), "+v"(yb2[1]), "+v"(yb2[2]), "+v"(yb2[3]));
            const float y0 = hi ? yb2[0] : ya[0], y1 = hi ? yb2[1] : ya[1], y2 = hi ? yb2[2] : ya[2], y3 = hi ? yb2[3] : ya[3];
            o[4 * q4] = y0 * rstd * gg.x + cc.x; o[4 * q4 + 1] = y1 * rstd * gg.y + cc.y; o[4 * q4 + 2] = y2 * rstd * gg.z + cc.z; o[4 * q4 + 3] = y3 * rstd * gg.w + cc.w;
            ((float4*)(hr + hi * 16))[q4] = make_float4(o[4 * q4], o[4 * q4 + 1], o[4 * q4 + 2], o[4 * q4 + 3]);
        }
        uint4* hbp = (uint4*)(hb + (size_t)t * 1024 + l32 * 32 + hi * 16);
        hbp[0] = make_uint4(pk2(o[0], o[1]), pk2(o[2], o[3]), pk2(o[4], o[5]), pk2(o[6], o[7]));
        hbp[1] = make_uint4(pk2(o[8], o[9]), pk2(o[10], o[11]), pk2(o[12], o[13]), pk2(o[14], o[15]));
    }
}

__device__ __forceinline__ float pack_pl(float v, unsigned pl) { return __uint_as_float((__float_as_uint(v) & ~127u) | pl); }
__device__ __forceinline__ void ins16(float (&s)[16], float x) {
#pragma unroll
    for (int k = 15; k >= 1; --k) s[k] = __builtin_amdgcn_fmed3f(s[k - 1], x, s[k]);
    s[0] = vmax(s[0], x);
}
template <int D> __device__ __forceinline__ void bitonic_stage(float (&c)[16]) {
#pragma unroll
    for (int i = 0; i < 16; ++i) if ((i & D) == 0) { const float a = vmax(c[i], c[i + D]), b = vmin(c[i], c[i + D]); c[i] = a; c[i + D] = b; }
}
__device__ __forceinline__ int decode_key(unsigned pl) { return (int)(32u * ((pl >> 4) & 3u) + (pl & 3u) + 8u * ((pl >> 2) & 3u) + 4u * ((pl >> 6) & 1u)); }
__device__ void route_fast_phase(int WV_, const bf16* qb, const bf16* skb  , int* eid, float* gate, unsigned char* lds, int pm = -1, int pn = 0) {
    const int tid = LTID(WV_), lane = tid & 63, wave = tid >> 6, r32 = lane & 31, hi = lane >> 5;
    unsigned* lidx = (unsigned*)lds + wave * (64 * 33) + lane * 33;
    const int u_first = (pm >= 0) ? 0 : LBID() * NWAVE + wave, u_end = (pm >= 0) ? 2 : (T_ / 32) * 8, u_step = (pm >= 0) ? 1 : LGRID() * NWAVE;
    for (int unit = u_first; unit < u_end; unit += u_step) {
        const int h = (pm >= 0) ? 2 * pn + unit : (unit & 7), t = ((pm >= 0) ? 8 * pm + wave : (unit >> 3)) * 32 + r32;
        float sl[2][16];
#pragma unroll
        for (int p = 0; p < 2; ++p) {
            bf16x8_t qf[4];
            { const bf16* qp = qb + (size_t)t * 1024 + h * 128 + p * 64 + 8 * hi;
#pragma unroll
              for (int ks = 0; ks < 4; ++ks) qf[ks] = *(const bf16x8_t*)(qp + 16 * ks); }
            float s[16];
#pragma unroll
            for (int k = 0; k < 16; ++k) s[k] = -INFINITY;
            const bf16* skp = skb + ((size_t)(h * 2 + p) * 128 + r32) * 64 + 8 * hi;
#pragma unroll
            for (int kt = 0; kt < 4; ++kt) {
                f32x16_t acc;
#pragma unroll
                for (int r = 0; r < 16; ++r) acc[r] = 0.f;
#pragma unroll
                for (int ks = 0; ks < 4; ++ks) { const bf16x8_t a = *(const bf16x8_t*)(skp + (size_t)kt * 32 * 64 + 16 * ks); acc = __builtin_amdgcn_mfma_f32_32x32x16_bf16(a, qf[ks], acc, 0, 0, 0); }
#pragma unroll
                for (int r = 0; r < 16; ++r) ins16(s, pack_pl(acc[r], (unsigned)(kt * 16 + r)));
            }
            const unsigned hb = (unsigned)hi << 6;
#pragma unroll
            for (int k = 0; k < 16; ++k) s[k] = __uint_as_float(__float_as_uint(s[k]) | hb);
            float c[16];
#pragma unroll
            for (int k = 0; k < 16; ++k) c[k] = vmax(s[k], __shfl_xor(s[15 - k], 32));
            bitonic_stage<8>(c); bitonic_stage<4>(c); bitonic_stage<2>(c); bitonic_stage<1>(c);
#pragma unroll
            for (int k = 0; k < 16; ++k) { sl[p][k] = c[k]; lidx[p * 16 + k] = (unsigned)decode_key(__float_as_uint(c[k]) & 127u); }
        }
        float w[16];
#pragma unroll
        for (int k = 0; k < 16; ++k) w[k] = -INFINITY;
#pragma unroll
        for (int i = 0; i < 16; ++i)
#pragma unroll
            for (int j = 0; j < 16; ++j)
                if ((i + 1) * (j + 1) <= 16) { const float v = sl[0][i] + sl[1][j]; ins16(w, __uint_as_float((__float_as_uint(v) & ~255u) | (unsigned)(i * 16 + j))); }
        float e[16], sum = 0.f;
#pragma unroll
        for (int k = 0; k < 16; ++k) { e[k] = expf(w[k] - w[0]); sum += e[k]; }
        const float inv = 1.0f / sum;
        int ide[8]; float gte[8];
#pragma unroll
        for (int k = 0; k < 8; ++k) {
            float wa = w[k], wb = w[8 + k], ea = e[k], eb = e[8 + k];
            asm volatile("" : "+v"(wa), "+v"(wb), "+v"(ea), "+v"(eb));
            const float wv = hi ? wb : wa;
            const unsigned pl = __float_as_uint(wv) & 255u;
            ide[k] = (int)(lidx[pl >> 4] * 128u + lidx[16 + (pl & 15u)]);
            gte[k] = (hi ? eb : ea) * inv;
        }
        int* ep = eid + (size_t)t * 128 + h * 16 + hi * 8; float* gp = gate + (size_t)t * 128 + h * 16 + hi * 8;
        *(int4*)ep = make_int4(ide[0], ide[1], ide[2], ide[3]); *(int4*)(ep + 4) = make_int4(ide[4], ide[5], ide[6], ide[7]);
        *(float4*)gp = make_float4(gte[0], gte[1], gte[2], gte[3]); *(float4*)(gp + 4) = make_float4(gte[4], gte[5], gte[6], gte[7]);
    }
}

typedef float f32x4_t __attribute__((ext_vector_type(4)));
typedef __bf16 bf16x2v __attribute__((ext_vector_type(2)));
__device__ __forceinline__ float dot2bf(unsigned a, unsigned b, float c) { return __builtin_amdgcn_fdot2_f32_bf16(__builtin_bit_cast(bf16x2v, a), __builtin_bit_cast(bf16x2v, b), c, false); }
__device__ __forceinline__ void cnt_gt(int& cnt, unsigned a, unsigned b) { asm("v_cmp_gt_u32_e32 vcc, %1, %2\n\tv_addc_co_u32_e32 %0, vcc, 0, %0, vcc" : "+v"(cnt) : "v"(a), "v"(b) : "vcc"); }
__device__ __forceinline__ void cnt_eq(int& cnt, unsigned a, unsigned b) { asm("v_cmp_eq_u32_e32 vcc, %1, %2\n\tv_addc_co_u32_e32 %0, vcc, 0, %0, vcc" : "+v"(cnt) : "v"(a), "v"(b) : "vcc"); }
__device__ __forceinline__ unsigned flag_gt(unsigned a, unsigned b) { unsigned r; asm("v_cmp_gt_u32_e32 vcc, %1, %2\n\tv_cndmask_b32_e64 %0, 0, 1, vcc" : "=v"(r) : "v"(a), "v"(b) : "vcc"); return r; }
__device__ __forceinline__ unsigned flag_eq(unsigned a, unsigned b) { unsigned r; asm("v_cmp_eq_u32_e32 vcc, %1, %2\n\tv_cndmask_b32_e64 %0, 0, 1, vcc" : "=v"(r) : "v"(a), "v"(b) : "vcc"); return r; }
__device__ __forceinline__ void cnt_ge(int& cnt, unsigned key, unsigned cand) { asm("v_cmp_ge_u32_e32 vcc, %1, %2\n\tv_addc_co_u32_e32 %0, vcc, 0, %0, vcc" : "+v"(cnt) : "v"(key), "v"(cand) : "vcc"); }

typedef __attribute__((address_space(3))) unsigned lds_u32;
template <int SHIFT> __device__ __forceinline__ unsigned radix_pass(const unsigned (&key)[64], unsigned pre, lds_u32* hist, int lane, int& need) {
    typedef unsigned u32x4v __attribute__((ext_vector_type(4)));
    typedef __attribute__((address_space(3))) u32x4v lds_u32x4;
    { const u32x4v z4 = {0u, 0u, 0u, 0u};
#pragma unroll
      for (int i = 0; i < 8; ++i) ((lds_u32x4*)(hist + lane * 32))[i] = z4; }
    const unsigned cp = (unsigned)(lane & 7);
#pragma unroll
    for (int j = 0; j < 64; ++j) {
        const unsigned d = (key[j] >> SHIFT) & 255u;
        bool m;
        if (SHIFT == 24) m = key[j] != 0u; else m = (key[j] >> ((SHIFT + 8) & 31)) == pre;
        if (m) __hip_atomic_fetch_add(hist + ((d << 3) | cp), 1u, __ATOMIC_RELAXED, __HIP_MEMORY_SCOPE_WORKGROUP);
    }
    unsigned dsum[4]; unsigned sumL = 0u;
#pragma unroll
    for (int i = 0; i < 4; ++i) { const u32x4v v0 = ((const lds_u32x4*)(hist + lane * 32))[2 * i], v1 = ((const lds_u32x4*)(hist + lane * 32))[2 * i + 1];
        dsum[i] = ((v0.x + v0.y) + (v0.z + v0.w)) + ((v1.x + v1.y) + (v1.z + v1.w)); sumL += dsum[i]; }
    unsigned incl = sumL;
#pragma unroll
    for (int o = 1; o < 64; o <<= 1) { const unsigned t = (unsigned)__shfl_down((int)incl, o); if (lane + o < 64) incl += t; }
    const unsigned above = incl - sumL;
    const bool own = (above < (unsigned)need) && ((unsigned)need <= above + sumL);
    const int owner = __ffsll((long long)__ballot(own)) - 1;
    unsigned acc = above; int sel = -1; unsigned cab = 0u;
#pragma unroll
    for (int i = 3; i >= 0; --i) { const unsigned c = dsum[i]; const bool hit = (sel < 0) && (acc + c >= (unsigned)need); cab = hit ? acc : cab; sel = hit ? i : sel; acc += c; }
    const int ow = owner < 0 ? 0 : owner;
    const unsigned digit = (unsigned)__builtin_amdgcn_readlane(sel, ow) + (unsigned)(4 * ow);
    need -= (int)__builtin_amdgcn_readlane((int)cab, ow);
    return digit;
}
#ifndef TS_SEL
#define TS_SEL 0
#endif
#define ITS_B() do { if (TS_SEL >= 20 && TS_SEL <= 25 && WV_ == 0 && LANEID() == 0) ((volatile __attribute__((address_space(3))) unsigned long long*)((__attribute__((address_space(3))) unsigned char*)lds + 147456 - 16 - 32))[0] = __builtin_amdgcn_s_memrealtime(); } while (0)
#define ITS_E(k) do { if ((k) == TS_SEL && WV_ == 0 && LANEID() == 0) { volatile __attribute__((address_space(3))) unsigned long long* w_ = (volatile __attribute__((address_space(3))) unsigned long long*)((__attribute__((address_space(3))) unsigned char*)lds + 147456 - 16 - 32); w_[1] += __builtin_amdgcn_s_memrealtime() - w_[0]; } } while (0)
__device__ void index_fast_phase(int WV_, const bf16* P, unsigned char* mask, float* kmean, float* scratch_all, unsigned char* lds) {
    const int tid = LTID(WV_), lane = tid & 63, wave = tid >> 6, bid = LBID(), G = LGRID();
    float* s_part = (float*)lds;
    ITS_B();
    for (int k = bid; k < 256; k += G) {
        const int b = k >> 6, h = (k >> 4) & 3, blk = k & 15;
        const bf16* kp = P + (size_t)(b * S_ + blk * 256 + wave * 32) * NP + C_KC + h * 64 + lane;
        float a = 0.f;
#pragma unroll 8
        for (int j = 0; j < 32; ++j) a += bf2f(kp[(size_t)j * NP]);
        __syncthreads();
        s_part[wave * 64 + lane] = a;
        __syncthreads();
        if (tid < 64) { float s = 0.f;
#pragma unroll
            for (int w = 0; w < 8; ++w) s += s_part[w * 64 + tid];
            kmean[((b * 4 + h) * 16 + blk) * 64 + tid] = s * (1.0f / 256.0f); }
    }
    ITS_E(22);
    float* scr = scratch_all + (size_t)bid * (16 * 4096);
    const int lq = lane & 15, g4 = lane >> 4;
    for (int ui = bid; ui < 1024; ui += G) {
        const int b = ui >> 8, k = ui & 255, tile = (b & 1) ? 255 - k : k, q0 = tile * 16;
        const bf16* Pb = P + (size_t)b * S_ * NP;
        const int ntiles = tile + 1;
        ITS_B();
        bf16x8_t qf[8]; float wi[8];
        { const bf16* qp = Pb + (size_t)(q0 + lq) * NP + C_QI + 8 * g4;
#pragma unroll
          for (int h = 0; h < 8; ++h) qf[h] = *(const bf16x8_t*)(qp + 32 * h);
          const uint4 wv = *(const uint4*)(Pb + (size_t)(q0 + lq) * NP + C_WI); unpack8(wv, wi); }
        {
            bf16x8_t afn = *(const bf16x8_t*)(Pb + (size_t)((wave < ntiles ? wave : 0) * 16 + lq) * NP + C_KI + 8 * g4);
            for (int kt = wave; kt < ntiles; kt += NWAVE) {
                const bf16x8_t af = afn;
                { const int ktn = (kt + NWAVE < ntiles) ? kt + NWAVE : kt; afn = *(const bf16x8_t*)(Pb + (size_t)(ktn * 16 + lq) * NP + C_KI + 8 * g4); }
                f32x4_t a[8];
                const f32x4_t z = {0.f, 0.f, 0.f, 0.f};
#pragma unroll
                for (int h = 0; h < 8; ++h) a[h] = __builtin_amdgcn_mfma_f32_16x16x32_bf16(af, qf[h], z, 0, 0, 0);
                __builtin_amdgcn_sched_barrier(0);
                f32x4_t sc = {0.f, 0.f, 0.f, 0.f};
#pragma unroll
                for (int h = 0; h < 8; ++h)
#pragma unroll
                    for (int r = 0; r < 4; ++r) { float rl; asm("v_max_f32_e32 %0, 0, %1" : "=v"(rl) : "v"(a[h][r])); sc[r] += rl * wi[h]; }
#pragma unroll
                for (int r = 0; r < 4; ++r) { sc[r] *= 0.0625f; if (sc[r] == 0.f) sc[r] = 0.f; }
                *(f32x4_t*)(scr + (size_t)lq * 4096 + kt * 16 + 4 * g4) = sc;
            }
        }
        __threadfence_block();
        __syncthreads();
        __threadfence_block();
        ITS_E(20); ITS_B();
        lds_u32* hist = (lds_u32*)((__attribute__((address_space(3))) unsigned char*)lds + 2048) + wave * 2048;
#pragma unroll 1
        for (int qi = 0; qi < 2; ++qi) {
            const int ql = 2 * wave + qi, q = q0 + ql;
            const float* row = scr + (size_t)ql * 4096 + lane * 64;
            const int qrel = q - lane * 64;
            unsigned key[64];
            if (qrel >= 0) {
#pragma unroll
                for (int j4 = 0; j4 < 16; ++j4) {
                    const float4 v = ((const float4*)row)[j4];
                    const unsigned u[4] = {__float_as_uint(v.x), __float_as_uint(v.y), __float_as_uint(v.z), __float_as_uint(v.w)};
#pragma unroll
                    for (int e = 0; e < 4; ++e) { const unsigned t = u[e] ^ ((unsigned)((int)u[e] >> 31) | 0x80000000u); const unsigned inval = (unsigned)((qrel - (j4 * 4 + e)) >> 31); key[j4 * 4 + e] = t & ~inval; }
                    if ((j4 & 3) == 3) asm volatile("" ::: "memory");
                }
            } else {
#pragma unroll
                for (int j = 0; j < 64; ++j) key[j] = 0u;
            }
            ITS_E(23); ITS_B();
            unsigned wlo = 0u, whi = 0u;
            if (q + 1 > 256) {
                int need = 256;
                const unsigned d1 = radix_pass<24>(key, 0u, hist, lane, need);
                const unsigned d2 = radix_pass<16>(key, d1, hist, lane, need);
                const unsigned d3 = radix_pass<8>(key, (d1 << 8) | d2, hist, lane, need);
                const unsigned d4 = radix_pass<0>(key, (d1 << 16) | (d2 << 8) | d3, hist, lane, need);
                const unsigned prefix = (d1 << 24) | (d2 << 16) | (d3 << 8) | d4;
                ITS_E(24); ITS_B();
                int ceq = 0;
#pragma unroll
                for (int j = 0; j < 64; ++j) cnt_eq(ceq, key[j], prefix);
                ceq = wave_sum_i(ceq);
                int X = 4096;
                if (ceq != need) {
                    int X0 = 0;
#pragma unroll 1
                    for (int bit = 11; bit >= 0; --bit) {
                        const int c = X0 | (1 << bit);
                        int cnt = 0; const int crel = c - lane * 64;
#pragma unroll
                        for (int j = 0; j < 64; ++j) cnt_eq(cnt, (key[j] ^ prefix) | ~(unsigned)((j - crel) >> 31), 0u);
                        cnt = wave_sum_i(cnt);
                        if (cnt < need) X0 = c;
                    }
                    X = X0 + 1;
                }
                const int xrel = X - lane * 64;
#pragma unroll
                for (int j = 0; j < 32; ++j) {
                    const unsigned s0 = flag_gt(key[j], prefix) | flag_eq((key[j] ^ prefix) | ~(unsigned)((j - xrel) >> 31), 0u);
                    const unsigned s1 = flag_gt(key[32 + j], prefix) | flag_eq((key[32 + j] ^ prefix) | ~(unsigned)((32 + j - xrel) >> 31), 0u);
                    wlo |= s0 << j; whi |= s1 << j;
                }
            } else {
#pragma unroll
                for (int j = 0; j < 32; ++j) { wlo |= (~(unsigned)((qrel - j) >> 31) & 1u) << j; whi |= (~(unsigned)((qrel - 32 - j) >> 31) & 1u) << j; }
            }
            ((uint2*)(mask + (size_t)(b * S_ + q) * 512))[lane] = make_uint2(wlo, whi);
            ITS_E(25); ITS_B();
        }
        ITS_E(21);
        __syncthreads();
    }
}

constexpr int MG_P = 72;
constexpr int MG_TILE_BYTES = 128 * MG_P * 2;
__device__ void merge_fast_phase(int WV_, const bf16* P, const bf16* ys, const bf16* wbt  , bf16* merged, unsigned char* lds) {
    const int tid = LTID(WV_), lane = tid & 63, wave = tid >> 6, r32 = lane & 31, hi = lane >> 5, wt = wave & 3, wd = wave >> 2;
    const int srow0 = tid >> 3, sch = tid & 7;
    for (int tile = LBID(); tile < 1024; tile += LGRID()) {
        const int tok0 = (tile >> 3) * 128, d0 = (tile & 7) * 128;
        f32x16_t mer[2], acc[2];
#pragma unroll
        for (int r = 0; r < 16; ++r) { mer[0][r] = 0.f; mer[1][r] = 0.f; acc[0][r] = 0.f; acc[1][r] = 0.f; }
        uint4 RW00, RW01, RW10, RW11, RY00, RY01, RY10, RY11, RG0, RG1, RG2, RG3;
        bf16* gl = (bf16*)(lds + 4 * MG_TILE_BYTES);
        const int grow = tid >> 4, gch = tid & 15;
#define MG_GLOAD(st_, R_) do { const int n_ = (st_) >> 2, kc_ = (st_) & 3; \
            RW##R_##0 = *(const uint4*)(wbt + ((size_t)n_ * 1024 + d0 + srow0) * 256 + kc_ * 64 + sch * 8); \
            RW##R_##1 = *(const uint4*)(wbt + ((size_t)n_ * 1024 + d0 + srow0 + 64) * 256 + kc_ * 64 + sch * 8); \
            RY##R_##0 = *(const uint4*)(ys + (size_t)(tok0 + srow0) * 1024 + n_ * 256 + kc_ * 64 + sch * 8); \
            RY##R_##1 = *(const uint4*)(ys + (size_t)(tok0 + srow0 + 64) * 1024 + n_ * 256 + kc_ * 64 + sch * 8); } while (0)
#define MG_SSTORE(buf_, R_) do { bf16* wl_ = (bf16*)(lds + (buf_) * 2 * MG_TILE_BYTES); bf16* yl_ = (bf16*)(lds + (buf_) * 2 * MG_TILE_BYTES + MG_TILE_BYTES); \
            *(uint4*)(wl_ + srow0 * MG_P + sch * 8) = RW##R_##0; *(uint4*)(wl_ + (srow0 + 64) * MG_P + sch * 8) = RW##R_##1; \
            *(uint4*)(yl_ + srow0 * MG_P + sch * 8) = RY##R_##0; *(uint4*)(yl_ + (srow0 + 64) * MG_P + sch * 8) = RY##R_##1; } while (0)
        __syncthreads();
        MG_GLOAD(0, 0); MG_GLOAD(1, 1);
        MG_SSTORE(0, 0);
        __syncthreads();
#define MG_STAGE(PAR_, OTH_) do { const int buf = PAR_; \
            if (st + 2 < 16) MG_GLOAD(st + 2, PAR_); \
            if ((st & 3) == 1) { const bf16* gsrc = P + (size_t)(tok0 + grow) * NP + C_G + (st >> 2) * 1024 + d0 + gch * 8; \
                RG0 = *(const uint4*)gsrc; RG1 = *(const uint4*)(gsrc + (size_t)32 * NP); RG2 = *(const uint4*)(gsrc + (size_t)64 * NP); RG3 = *(const uint4*)(gsrc + (size_t)96 * NP); } \
            const bf16* wl = (const bf16*)(lds + buf * 2 * MG_TILE_BYTES); const bf16* yl = (const bf16*)(lds + buf * 2 * MG_TILE_BYTES + MG_TILE_BYTES); \
            _Pragma("unroll") for (int ks = 0; ks < 4; ++ks) { \
                const bf16x8_t bq = *(const bf16x8_t*)(yl + (32 * wt + r32) * MG_P + 16 * ks + 8 * hi); \
                const bf16x8_t a0 = *(const bf16x8_t*)(wl + (64 * wd + r32) * MG_P + 16 * ks + 8 * hi); \
                const bf16x8_t a1 = *(const bf16x8_t*)(wl + (64 * wd + 32 + r32) * MG_P + 16 * ks + 8 * hi); \
                acc[0] = __builtin_amdgcn_mfma_f32_32x32x16_bf16(a0, bq, acc[0], 0, 0, 0); \
                acc[1] = __builtin_amdgcn_mfma_f32_32x32x16_bf16(a1, bq, acc[1], 0, 0, 0); } \
            if ((st & 3) == 3) { \
                const int n = st >> 2; \
                const bf16* gp = gl + (32 * wt + r32) * 136 + 64 * wd + 4 * hi; (void)n; \
                _Pragma("unroll") for (int dt = 0; dt < 2; ++dt) \
                _Pragma("unroll") for (int g = 0; g < 4; ++g) { \
                        const uint2 gv = *(const uint2*)(gp + 32 * dt + 8 * g); \
                        const float g0 = __uint_as_float(gv.x << 16), g1 = __uint_as_float(gv.x & 0xffff0000u), g2 = __uint_as_float(gv.y << 16), g3 = __uint_as_float(gv.y & 0xffff0000u); \
                        mer[dt][4 * g + 0] += acc[dt][4 * g + 0] * __builtin_amdgcn_rcpf(1.f + __builtin_amdgcn_exp2f(-LOG2E * g0)); \
                        mer[dt][4 * g + 1] += acc[dt][4 * g + 1] * __builtin_amdgcn_rcpf(1.f + __builtin_amdgcn_exp2f(-LOG2E * g1)); \
                        mer[dt][4 * g + 2] += acc[dt][4 * g + 2] * __builtin_amdgcn_rcpf(1.f + __builtin_amdgcn_exp2f(-LOG2E * g2)); \
                        mer[dt][4 * g + 3] += acc[dt][4 * g + 3] * __builtin_amdgcn_rcpf(1.f + __builtin_amdgcn_exp2f(-LOG2E * g3)); } \
                _Pragma("unroll") for (int r = 0; r < 16; ++r) { acc[0][r] = 0.f; acc[1][r] = 0.f; } } \
            if (st + 1 < 16) MG_SSTORE(OTH_, OTH_); \
            if ((st & 3) == 2) { *(uint4*)(gl + grow * 136 + gch * 8) = RG0; *(uint4*)(gl + (grow + 32) * 136 + gch * 8) = RG1; *(uint4*)(gl + (grow + 64) * 136 + gch * 8) = RG2; *(uint4*)(gl + (grow + 96) * 136 + gch * 8) = RG3; } \
            __syncthreads(); } while (0)
#pragma unroll 1
        for (int st2 = 0; st2 < 16; st2 += 2) { { const int st = st2; MG_STAGE(0, 1); } { const int st = st2 + 1; MG_STAGE(1, 0); } }
#undef MG_STAGE
#undef MG_GLOAD
#undef MG_SSTORE
        bf16* mp = merged + (size_t)(tok0 + 32 * wt + r32) * 1024 + d0 + 64 * wd + 4 * hi;
#pragma unroll
        for (int dt = 0; dt < 2; ++dt)
#pragma unroll
            for (int g = 0; g < 4; ++g)
                *(uint2*)(mp + 32 * dt + 8 * g) = make_uint2(cvtpk(mer[dt][4 * g], mer[dt][4 * g + 1]), cvtpk(mer[dt][4 * g + 2], mer[dt][4 * g + 3]));
    }
}
#define LAS __attribute__((address_space(3)))
#define XB_TMO      128
#define XB_XCNT(j)  (256  + 64 * (j))
#define XB_XSUB(j)  (1280 + 64 * (j))
#define XB_XGEN(j)  (2304 + 64 * (j))
#define XB_TOP      3328
#define XB_TOPGEN   3392
#define XCD_BAR_WORDS 3456
#define XB_SPIN_CAP (1u << 18)

__device__ __forceinline__ unsigned xb_ld(unsigned* p)              { return __hip_atomic_load(p, __ATOMIC_RELAXED, __HIP_MEMORY_SCOPE_AGENT); }
__device__ __forceinline__ unsigned xb_add(unsigned* p, unsigned v) { return __hip_atomic_fetch_add(p, v, __ATOMIC_RELAXED, __HIP_MEMORY_SCOPE_AGENT); }
__device__ __forceinline__ unsigned xb_xcc_id() { return (unsigned)__builtin_amdgcn_s_getreg((3 << 11) | 20) & 0xFu; }
#define XB_SPIN(cond, bar) do { unsigned _sp = 0; while (cond) { __builtin_amdgcn_s_sleep(1); \
    if ((++_sp & 255u) == 0u) { if (xb_ld(&(bar)[XB_TMO])) break; if (_sp > XB_SPIN_CAP) { atomicAdd(&(bar)[XB_TMO], 1u); break; } } } } while (0)

struct XcdBarrier {
    unsigned* bar; unsigned x;
    volatile LAS unsigned* st;
};

__device__ __forceinline__ XcdBarrier xcd_barrier_post(unsigned* bar, volatile LAS unsigned* st) {
    XcdBarrier b; b.bar = bar; b.x = xb_xcc_id(); b.st = st;
    if (threadIdx.x == 0) (void)xb_add(&bar[XB_XCNT(b.x)], 1u);
    return b;
}
__device__ __forceinline__ void xcd_barrier_complete(unsigned* bar, unsigned x, unsigned& nloc, unsigned& nx) {
    const unsigned G = gridDim.x * gridDim.y * gridDim.z;
    unsigned sum, cnt, mine, sp = 0u;
    for (;;) {
        sum = 0u; cnt = 0u; mine = 0u;
#pragma unroll
        for (unsigned j = 0; j < 16; ++j) { const unsigned c = xb_ld(&bar[XB_XCNT(j)]); sum += c; cnt += (c > 0u) ? 1u : 0u; mine = (j == x) ? c : mine; }
        if (sum == G) break;
        __builtin_amdgcn_s_sleep(1);
        if ((++sp & 255u) == 0u) { if (xb_ld(&bar[XB_TMO])) break; if (sp > XB_SPIN_CAP) { atomicAdd(&bar[XB_TMO], 1u); break; } }
    }
    nloc = mine > 0u ? mine : 1u; nx = cnt > 0u ? cnt : 1u;
}

__device__ __forceinline__ void xcd_barrier(const XcdBarrier& b, int wv_) {
    asm volatile("s_waitcnt vmcnt(0)" ::: "memory");
    __syncthreads();
    if (wv_ == 0 && LANEID() == 0) {
        unsigned* bar = b.bar;
        __builtin_amdgcn_s_waitcnt(0);
        unsigned nloc = b.st[0], nx = b.st[1];
        if (nloc == 0u) { xcd_barrier_complete(bar, b.x, nloc, nx); b.st[0] = nloc; b.st[1] = nx; }
        const unsigned old = xb_add(&bar[XB_XSUB(b.x)], 1u);
        const unsigned gen = old / nloc;
        if (old + 1u == (gen + 1u) * nloc) {
            __builtin_amdgcn_fence(__ATOMIC_RELEASE, "agent");
            asm volatile("s_waitcnt vmcnt(0)" ::: "memory");
            const unsigned og = xb_add(&bar[XB_TOP], 1u);
            const unsigned tg = og / nx;
            if (og + 1u == (tg + 1u) * nx) xb_add(&bar[XB_TOPGEN], 1u);
            else XB_SPIN(xb_ld(&bar[XB_TOPGEN]) == tg, bar);
            __builtin_amdgcn_fence(__ATOMIC_ACQUIRE, "agent");
            xb_add(&bar[XB_XGEN(b.x)], 1u);
            asm volatile("s_waitcnt vmcnt(0)" ::: "memory");
        } else {
            XB_SPIN(xb_ld(&bar[XB_XGEN(b.x)]) == gen, bar);
            __builtin_amdgcn_fence(__ATOMIC_ACQUIRE, "agent");
            asm volatile("s_waitcnt vmcnt(0)" ::: "memory");
        }
    }
    __syncthreads();
}

enum { PH_PRO = 0, PH_GIN, PH_INDEX, PH_ATTN, PH_MERGE, PH_GOUT, PH_LN1, PH_GQ, PH_ROUTE, PH_PEER };
template <int PH> __device__ __forceinline__ void run_phase(int WV_, const Params& p_unused, int l, unsigned char* lds_raw) {
    size_t kaoff_ = 0; asm volatile("" : "+s"(kaoff_));
    typedef const __attribute__((address_space(4))) char* kaptr_t;
    const __attribute__((address_space(4))) Params& p = *(const __attribute__((address_space(4))) Params*)((kaptr_t)__builtin_amdgcn_kernarg_segment_ptr() + kaoff_);
    float* sm = (float*)lds_raw;
    size_t wsoff_ = 0; asm volatile("" : "+s"(wsoff_));
    unsigned char* ws = p.ws + wsoff_;
    float* hbuf = p.out;
    bf16* hb = (bf16*)(ws + WS_HB);
    bf16* P = (bf16*)(ws + WS_P);
    bf16* ys = (bf16*)(ws + WS_YS);
    bf16* mrg = (bf16*)(ws + WS_MRG);
    float* mix = (float*)(ws + WS_MIX);
    float* qb = (float*)(ws + WS_Q);
    unsigned char* mask = ws + WS_MASK;
    int* eid = (int*)(ws + WS_EID);
    float* gate = (float*)(ws + WS_GATE);
    float* kmean = (float*)(ws + WS_KMEAN);
    const float* hin = (l == 0) ? p.in[0] : hbuf;
    if (PH == PH_PRO) { Params pc; for (int i = 0; i < 13; ++i) pc.in[i] = p.in[i]; pc.out = p.out; pc.ws = ws;
        prologue_phase(WV_, pc, sm); convert_tables(WV_, pc);
        for (int i = LBID() * NTHR + LTID(WV_); i < DEPTH_ * 8 * 2 * 128 * 64 / 4; i += LGRID() * NTHR) { const float4 v = ((const float4*)p.in[8])[i]; ((uint2*)(ws + WS_SKB))[i] = make_uint2(pk2(v.x, v.y), pk2(v.z, v.w)); } if (LBID() < 2) build_unit_table((unsigned*)(ws + WS_CTL) + 1024, LBID() * NTHR + LTID(WV_)); }
    else if (PH == PH_GIN) {
        pg8::Gemm g{hb, (const bf16*)(ws + WS_WIN_T + l * WIN_T_BYTES), T_, NP, 1024};
        pg8::StaticOrder S; S.init(T_, NP, (int)LGRID(), (int)LBID());
        pg8::EpiBf16<0> E{P, NP, nullptr, 0, 0, 1.f};
        pg8::gemm_phase<pg8::EpiBf16<0>, pg8::StaticOrder, true, true>(WV_, (PG8_LAS unsigned char*)lds_raw, g, S, E);
    }
    else if (PH == PH_INDEX) index_fast_phase(WV_, P, mask, kmean, (float*)(ws + WS_YS), lds_raw);
    else if (PH == PH_ATTN) attn_fast_phase(WV_, P, mask, kmean, p.in[4] + l * 4, ys, (const unsigned*)(ws + WS_CTL) + 1024, (unsigned*)(ws + WS_CTL) + 64 * l, lds_raw);
    else if (PH == PH_MERGE) merge_fast_phase(WV_, P, ys, (const bf16*)(ws + WS_WBR_T) + (size_t)l * 4 * 1024 * 256, mrg, lds_raw);
    else if (PH == PH_GOUT) {
        pg8::Gemm g{mrg, (const bf16*)(ws + WS_WOUT_T) + (size_t)l * 1024 * 1024, T_, 1024, 1024};
        pg8::StaticOrder S; S.init(T_, 1024, (int)LGRID(), (int)LBID());
        pg8::EpiResY E{hin, hbuf, hb, (float*)(ws + WS_STATS) + (size_t)l * T_ * 2, ALPHA};
        pg8::gemm_phase<pg8::EpiResY, pg8::StaticOrder, true, true>(WV_, (PG8_LAS unsigned char*)lds_raw, g, S, E);
    }
    else if (PH == PH_GQ) {
        pg8::Gemm g{hb, (const bf16*)(ws + WS_WQ_T) + (size_t)l * 1024 * 1024, T_, 1024, 1024};
        pg8::StaticOrder S; S.init(T_, 1024, (int)LGRID(), (int)LBID());
        pg8::EpiLnFold E{(bf16*)qb, (const float*)(ws + WS_STATS) + (size_t)l * T_ * 2, (const float*)(ws + WS_COLS) + l * 2048, (const float*)(ws + WS_COLS) + l * 2048 + 1024, LN_EPS};
        pg8::gemm_phase<pg8::EpiLnFold, pg8::StaticOrder, true, true>(WV_, (PG8_LAS unsigned char*)lds_raw, g, S, E);
        pg8::Unit u0;
        if (LGRID() == 256 && S.next(0, u0)) {
            asm volatile("s_waitcnt vmcnt(0)" ::: "memory"); __syncthreads();
            route_fast_phase(WV_, (const bf16*)qb, (const bf16*)(ws + WS_SKB) + (size_t)l * 8 * 2 * 128 * 64, eid, gate, lds_raw, u0.pm, u0.pn);
        }
    }
    else if (PH == PH_ROUTE) { if (LGRID() != 256) route_fast_phase(WV_, (const bf16*)qb, (const bf16*)(ws + WS_SKB) + (size_t)l * 8 * 2 * 128 * 64, eid, gate, lds_raw); }
    else peer_fast_phase(WV_, hbuf, hb, eid, gate, ws + WS_UV + (size_t)l * 24 * MiB, p.in[5] + l * 1024, p.in[6] + l * 1024, p.in[11] + l * 1024, p.in[12] + l * 1024, lds_raw);
}

constexpr int CW_BAR = 4096;
constexpr int LDS_BARST = LDS_BYTES - 16;
__global__ void __launch_bounds__(NTHR, 2) mk_fwd(Params p) {
    extern __shared__ __attribute__((aligned(16))) unsigned char lds_raw[];
    cg::grid_group grid = cg::this_grid();
    const int WV_ = __builtin_amdgcn_readfirstlane((int)threadIdx.x >> 6);
    { volatile LAS unsigned* bst0 = (volatile LAS unsigned*)((LAS unsigned char*)lds_raw + LDS_BARST); if (threadIdx.x < 4) bst0[threadIdx.x] = 0u; }
    __syncthreads();
    volatile LAS unsigned* bst = (volatile LAS unsigned*)((LAS unsigned char*)lds_raw + LDS_BARST);
    (void)xcd_barrier_post((unsigned*)(p.ws + WS_CTL) + CW_BAR, bst);
#define GRID_BAR() do { XcdBarrier b_; b_.bar = (unsigned*)(p.ws + WS_CTL) + CW_BAR; b_.x = xb_xcc_id(); b_.st = (volatile LAS unsigned*)((LAS unsigned char*)lds_raw + LDS_BARST); xcd_barrier(b_, WV_); } while (0)
    run_phase<PH_PRO>(WV_, p, 0, lds_raw);
    grid.sync();
#pragma unroll 1
    for (int l = 0; l < DEPTH_; ++l) {
        run_phase<PH_GIN>(WV_, p, l, lds_raw); GRID_BAR();
        run_phase<PH_INDEX>(WV_, p, l, lds_raw); GRID_BAR();
        run_phase<PH_ATTN>(WV_, p, l, lds_raw); GRID_BAR();
        run_phase<PH_MERGE>(WV_, p, l, lds_raw); GRID_BAR();
        run_phase<PH_GOUT>(WV_, p, l, lds_raw); GRID_BAR();
        run_phase<PH_GQ>(WV_, p, l, lds_raw); if (LGRID() != 256) { GRID_BAR(); run_phase<PH_ROUTE>(WV_, p, l, lds_raw); } GRID_BAR();
        run_phase<PH_PEER>(WV_, p, l, lds_raw); if (l + 1 < DEPTH_) GRID_BAR();
    }
}

extern "C" void kernel_launch(void* const* d_in, const int* in_sizes, int n_in, void* d_out, int out_size, void* d_ws, size_t ws_size, hipStream_t stream) {
    if (n_in != 13 || ws_size < WS_END) { fprintf(stderr, "kernel_launch: unexpected n_in %d / ws_size %zu; nothing launched\n", n_in, ws_size); return; }
    static int grid_blocks = 0;
    if (grid_blocks == 0) {
        int dev = 0, cus = 0, per_cu = 0;
        (void)hipGetDevice(&dev);
        (void)hipDeviceGetAttribute(&cus, hipDeviceAttributeMultiprocessorCount, dev);
        (void)hipFuncSetAttribute((const void*)mk_fwd, hipFuncAttributeMaxDynamicSharedMemorySize, LDS_BYTES);
        (void)hipOccupancyMaxActiveBlocksPerMultiprocessor(&per_cu, (const void*)mk_fwd, NTHR, LDS_BYTES);
        if (per_cu < 1) fprintf(stderr, "kernel_launch: occupancy query reports %d\n", per_cu);
        grid_blocks = cus;
    }
    Params p{};
    for (int i = 0; i < 13; ++i) p.in[i] = (const float*)d_in[i];
    p.out = (float*)d_out; p.ws = (unsigned char*)d_ws;
    (void)hipMemsetAsync(d_ws, 0, 2 * MiB, stream);
    void* args[] = {&p};
    hipError_t e = hipLaunchCooperativeKernel((const void*)mk_fwd, dim3(grid_blocks), dim3(NTHR), args, LDS_BYTES, stream);
    if (e != hipSuccess) fprintf(stderr, "cooperative launch failed: %s (grid %d)\n", hipGetErrorString(e), grid_blocks);
}
```

```cpp
#include <hip/hip_runtime.h>
#include <cstdio>
#include <cstdint>
#include <hip/hip_cooperative_groups.h>
namespace cg = cooperative_groups;

__device__ __forceinline__ int LANEID() { int l; asm volatile("v_mbcnt_lo_u32_b32 %0, -1, 0\n\tv_mbcnt_hi_u32_b32 %0, -1, %0" : "=v"(l)); return l; }
__device__ __forceinline__ int LTID(int wv) { return (wv << 6) | LANEID(); }
__device__ __forceinline__ int LBID() { int t = blockIdx.x; asm volatile("" : "+s"(t)); return t; }
__device__ __forceinline__ int LGRID() { int t = gridDim.x; asm volatile("" : "+s"(t)); return t; }
namespace pg8 {
#define PG8_LAS __attribute__((address_space(3)))
typedef unsigned short bf16_t;
typedef short bf16x8 __attribute__((ext_vector_type(8)));
typedef float f32x4 __attribute__((ext_vector_type(4)));
typedef unsigned u32x4 __attribute__((ext_vector_type(4)));
constexpr int BM = 256, BK = 64, HALF = 128, HTB = HALF * BK * 2  , STAGE_BYTES = 8 * HTB, NXCD = 8, WGM = 8;

__host__ __device__ __forceinline__ int lds_byte(int r, int c) { const int st = (r >> 4) * 2 + (c >> 5), rr = r & 15, cc = c & 31, ob = rr * 64 + cc * 2; return st * 1024 + (ob ^ (((ob >> 9) & 1) << 5)); }
__host__ __device__ __forceinline__ void stage_rc(int b, int& R, int& C) { const int st = b / 1024, sb = b % 1024, swz = sb ^ (((sb >> 9) & 1) << 5); R = (st >> 1) * 16 + swz / 64; C = (st & 1) * 32 + (swz % 64) / 2; }
__host__ __device__ __forceinline__ int perm32(int rho) { const int n = rho >> 4, i = rho & 15; return 8 * (i >> 2) + 4 * n + (i & 3); }

struct Unit { int pm, pn; };
struct Gemm { const bf16_t* A; const bf16_t* Bt; int M, N, K; };

struct StaticOrder {
    int nM, nN, nwg, G, c;
    __host__ __device__ void init(int M, int N, int G_, int c_) { nM = M / BM; nN = N / BM; nwg = nM * nN; G = G_; c = c_; }
    __host__ __device__ bool next(int i, Unit& u) const {
        const long L = (long)i * G + c; if (L >= nwg) return false;
        int wgid = (int)L; { const int q = nwg / NXCD, r = nwg % NXCD, xcd = wgid % NXCD, off = wgid / NXCD; wgid = (xcd < r ? xcd * (q + 1) : r * (q + 1) + (xcd - r) * q) + off; }
        const int nig = WGM * nN, gid = wgid / nig, fm = gid * WGM, gsz = (nM - fm) < WGM ? (nM - fm) : WGM;
        u.pm = fm + ((wgid % nig) % gsz); u.pn = (wgid % nig) / gsz; return true;
    }
    __device__ __forceinline__ void a_ready(const Unit&) const {}
    __device__ __forceinline__ void done(const Unit&) const {}
};

__device__ __forceinline__ unsigned cvt_pk_bf16(float lo, float hi) { unsigned r; asm volatile("v_cvt_pk_bf16_f32 %0, %1, %2" : "=v"(r) : "v"(lo), "v"(hi)); return r; }
typedef float f32x2 __attribute__((ext_vector_type(2)));
__device__ __forceinline__ f32x2 gelu_pk(f32x2 v) {
    const f32x2 av = __builtin_elementwise_abs(v), d = av * 0.2316418882f + 1.0f;
    f32x2 t; t.x = __builtin_amdgcn_rcpf(d.x); t.y = __builtin_amdgcn_rcpf(d.y);
    f32x2 q = t * 0.5307027145f + (-0.7265760135f); q = q * t + 0.7107068705f; q = q * t + (-0.142248368f); q = q * t + 0.127414796f; q = q * t;
    const f32x2 s = (v * v) * (-0.72134752044f);
    f32x2 e; e.x = __builtin_amdgcn_exp2f(s.x); e.y = __builtin_amdgcn_exp2f(s.y);
    const f32x2 m = v * (q * e), r = v - m;
    f32x2 o; o.x = v.x < 0.f ? m.x : r.x; o.y = v.y < 0.f ? m.y : r.y; return o;
}

template <int ACT  > struct EpiBf16 {
    static constexpr bool PERM = true, AFTER_DRAIN = false; static_assert(ACT == 0 || ACT == 1, "EpiBf16: ACT is 0 (none) or 1 (gelu_pk)");
    bf16_t* O; int ldc; const float* bias; int split_cols; size_t split_stride; float scale0;
    __device__ __forceinline__ void operator()(const f32x4 (&acc)[2][2][4][2], const Unit& u, int wr, int wc, int fr, int fq) const {
        { int ln_ = LANEID(); asm volatile("" : "+v"(ln_)); fr = ln_ & 15; fq = ln_ >> 4; }
        const int row0 = u.pm * BM + wr * 64 + fr; int colt = u.pn * BM; bf16_t* base = O;
        float sc = 1.f; if (split_cols) { const int t = colt / split_cols; base += (size_t)t * split_stride; colt -= t * split_cols; if (t == 0) sc = scale0; }
        const int col0 = colt + wc * 32 + 8 * fq, bcol0 = u.pn * BM + wc * 32 + 8 * fq;
        f32x4 bv[2][2];
#pragma unroll
        for (int bj = 0; bj < 2; ++bj)
#pragma unroll
            for (int n = 0; n < 2; ++n) bv[bj][n] = bias ? *(const f32x4*)(bias + bcol0 + bj * HALF + 4 * n) : (f32x4){0.f, 0.f, 0.f, 0.f};
#pragma unroll
        for (int ai = 0; ai < 2; ++ai)
#pragma unroll
            for (int m = 0; m < 4; ++m) { bf16_t* rowp = base + (size_t)(row0 + ai * HALF + m * 16) * ldc + col0;
#pragma unroll
                for (int bj = 0; bj < 2; ++bj) { f32x4 v0 = acc[ai][bj][m][0] + bv[bj][0], v1 = acc[ai][bj][m][1] + bv[bj][1];
                    if (ACT == 1) { f32x2 a = gelu_pk((f32x2){v0[0], v0[1]}), b = gelu_pk((f32x2){v0[2], v0[3]}), c = gelu_pk((f32x2){v1[0], v1[1]}), d = gelu_pk((f32x2){v1[2], v1[3]});
                        v0 = (f32x4){a.x, a.y, b.x, b.y}; v1 = (f32x4){c.x, c.y, d.x, d.y}; }
                    v0 = v0 * sc; v1 = v1 * sc; u32x4 w; w.x = cvt_pk_bf16(v0[0], v0[1]); w.y = cvt_pk_bf16(v0[2], v0[3]); w.z = cvt_pk_bf16(v1[0], v1[1]); w.w = cvt_pk_bf16(v1[2], v1[3]);
                    *(u32x4*)(rowp + bj * HALF) = w; } }
    }
};
template <class Epi, class Sched, bool ALIGN_EPI = false, bool SP2 = false>
__device__ __forceinline__ void gemm_phase(int WV_, PG8_LAS unsigned char* lds, const Gemm g, const Sched& S, const Epi& E) {
    const int tid = LTID(WV_), wid = __builtin_amdgcn_readfirstlane(tid >> 6), lane = tid & 63, wr = wid >> 2, wc = wid & 3, fr = lane & 15, fq = lane >> 4;
    const int K = g.K, nt = K / BK;
    unsigned voffA[2], voffB[2];
#pragma unroll
    for (int i = 0; i < 2; ++i) { int R, C; stage_rc(tid * 16 + i * 8192, R, C); const int Rb = Epi::PERM ? ((R & ~31) + perm32(R & 31)) : R;
        voffA[i] = (unsigned)(R * K + C) * 2u; voffB[i] = (unsigned)(Rb * K + C) * 2u; }
    const size_t kstep = (size_t)(BK * 2);
    const size_t hstep = (size_t)HALF * K * 2;
    const size_t tstep = 2 * hstep;
    const unsigned ldsw = (unsigned)wid * 1024u;
    const int aoff = lds_byte(wr * 64 + fr, fq * 8), boff = lds_byte(wc * 32 + fr, fq * 8);
#define PG8_SA(b, h) (((b) * 2 + (h)) * HTB)
#define PG8_SB(b, h) ((4 + (b) * 2 + (h)) * HTB)
#define PG8_STAGE(bufoff, gbase, voff) do { _Pragma("unroll") for (int _i = 0; _i < 2; ++_i) \
        __builtin_amdgcn_global_load_lds((const unsigned*)((const char*)(gbase) + (voff)[_i]), (PG8_LAS unsigned*)(lds + (bufoff) + ldsw + _i * 8192), 16, 0, 0); } while (0)
#define PG8_LDA(dst, b, h) do { _Pragma("unroll") for (int m = 0; m < 4; ++m) _Pragma("unroll") for (int k = 0; k < 2; ++k) dst[m][k] = *(const PG8_LAS bf16x8*)(lds + PG8_SA(b, h) + aoff + m * 2048 + k * 1024); } while (0)
#define PG8_LDB(dst, b, h) do { _Pragma("unroll") for (int n = 0; n < 2; ++n) _Pragma("unroll") for (int k = 0; k < 2; ++k) dst[n][k] = *(const PG8_LAS bf16x8*)(lds + PG8_SB(b, h) + boff + n * 2048 + k * 1024); } while (0)
#define PG8_MMA(ai, bj, At, Bt) do { __builtin_amdgcn_s_setprio(1); _Pragma("unroll") for (int m = 0; m < 4; ++m) _Pragma("unroll") for (int n = 0; n < 2; ++n) _Pragma("unroll") for (int k = 0; k < 2; ++k) \
        acc[ai][bj][m][n] = __builtin_amdgcn_mfma_f32_16x16x32_bf16(Bt[n][k], At[m][k], acc[ai][bj][m][n], 0, 0, 0); __builtin_amdgcn_s_setprio(0); } while (0)
#define PG8_WAIT_V(n) asm volatile("s_waitcnt vmcnt(" #n ")" ::: "memory")
#define PG8_WAIT_L(n) asm volatile("s_waitcnt lgkmcnt(" #n ")" ::: "memory")
#define PG8_BAR __builtin_amdgcn_s_barrier()
#define PG8_SCHED __builtin_amdgcn_sched_barrier(0)
    Unit cur, nxt; int ui = 0;
    if (!S.next(0, cur)) return;
    f32x4 acc[2][2][4][2];
#pragma unroll
    for (int a = 0; a < 2; ++a)
#pragma unroll
        for (int b = 0; b < 2; ++b)
#pragma unroll
            for (int m = 0; m < 4; ++m)
#pragma unroll
                for (int n = 0; n < 2; ++n) acc[a][b][m][n] = (f32x4){0.f, 0.f, 0.f, 0.f};
    bf16x8 At[4][2], B0[2][2], B1[2][2];
    const char* cA = (const char*)g.A + (size_t)cur.pm * tstep; const char* cB = (const char*)g.Bt + (size_t)cur.pn * tstep;
    S.a_ready(cur);
    if constexpr (SP2) {
        PG8_STAGE(PG8_SB(0, 0), cB, voffB); PG8_STAGE(PG8_SB(0, 1), cB + hstep, voffB); PG8_STAGE(PG8_SA(0, 0), cA, voffA); PG8_STAGE(PG8_SA(0, 1), cA + hstep, voffA);
        if (wr == 1) PG8_BAR;
        PG8_WAIT_V(2); PG8_BAR;
        PG8_STAGE(PG8_SB(1, 0), cB + kstep, voffB); PG8_STAGE(PG8_SA(1, 0), cA + kstep, voffA); PG8_STAGE(PG8_SB(1, 1), cB + hstep + kstep, voffB);
        PG8_WAIT_V(6); PG8_BAR;
    } else {
        PG8_STAGE(PG8_SB(0, 0), cB, voffB); PG8_STAGE(PG8_SA(0, 0), cA, voffA); PG8_STAGE(PG8_SB(0, 1), cB + hstep, voffB); PG8_STAGE(PG8_SA(0, 1), cA + hstep, voffA);
        if (wr == 1) PG8_BAR;
        PG8_WAIT_V(4); PG8_BAR;
        PG8_STAGE(PG8_SB(1, 0), cB + kstep, voffB); PG8_STAGE(PG8_SA(1, 0), cA + kstep, voffA); PG8_STAGE(PG8_SB(1, 1), cB + hstep + kstep, voffB);
        PG8_WAIT_V(6); PG8_BAR;
    }
    for (;;) {
        const bool has_next = S.next(ui + 1, nxt);
        const char* nA = has_next ? (const char*)g.A + (size_t)nxt.pm * tstep : cA; const char* nB = has_next ? (const char*)g.Bt + (size_t)nxt.pn * tstep : cB;
        for (int t = 0; t < nt; t += 2) {
            const bool last = (t == nt - 2);
            const char* a1 = cA + (size_t)(t + 1) * kstep;
            const char* a2 = last ? nA : cA + (size_t)(t + 2) * kstep; const char* b2 = last ? nB : cB + (size_t)(t + 2) * kstep;
            const char* a3 = a2 + kstep; const char* b3 = b2 + kstep;
            if (last && has_next) S.a_ready(nxt);
            if constexpr (SP2) {
            PG8_LDB(B0, 0, 0); PG8_LDB(B1, 0, 1); PG8_SCHED; PG8_LDA(At, 0, 0); PG8_STAGE(PG8_SA(1, 1), a1 + hstep, voffA);
            PG8_WAIT_V(8); PG8_WAIT_L(0); PG8_BAR; PG8_MMA(0, 0, At, B0); PG8_MMA(0, 1, At, B1); PG8_BAR; PG8_SCHED;
            PG8_LDA(At, 0, 1); PG8_STAGE(PG8_SB(0, 0), b2, voffB); PG8_STAGE(PG8_SB(0, 1), b2 + hstep, voffB); PG8_STAGE(PG8_SA(0, 0), a2, voffA);
            PG8_WAIT_V(8); PG8_WAIT_L(0); PG8_BAR; PG8_MMA(1, 0, At, B0); PG8_MMA(1, 1, At, B1); PG8_BAR; PG8_SCHED;
            PG8_LDB(B0, 1, 0); PG8_LDB(B1, 1, 1); PG8_SCHED; PG8_LDA(At, 1, 0); PG8_STAGE(PG8_SA(0, 1), a2 + hstep, voffA);
            PG8_WAIT_V(8); PG8_WAIT_L(0); PG8_BAR; PG8_MMA(0, 0, At, B0); PG8_MMA(0, 1, At, B1); PG8_BAR; PG8_SCHED;
            PG8_LDA(At, 1, 1); PG8_STAGE(PG8_SB(1, 0), b3, voffB); PG8_STAGE(PG8_SB(1, 1), b3 + hstep, voffB); PG8_STAGE(PG8_SA(1, 0), a3, voffA);
            PG8_WAIT_V(8); PG8_WAIT_L(0); PG8_BAR; PG8_MMA(1, 0, At, B0); PG8_MMA(1, 1, At, B1); PG8_BAR; PG8_SCHED;
            } else {
            PG8_LDB(B0, 0, 0); PG8_SCHED; PG8_LDA(At, 0, 0); PG8_STAGE(PG8_SA(1, 1), a1 + hstep, voffA);
            PG8_WAIT_L(8); PG8_BAR; PG8_WAIT_L(0); PG8_MMA(0, 0, At, B0); PG8_BAR; PG8_SCHED;
            PG8_LDB(B1, 0, 1); PG8_STAGE(PG8_SB(0, 0), b2, voffB);
            PG8_BAR; PG8_WAIT_L(0); PG8_MMA(0, 1, At, B1); PG8_BAR;
            PG8_LDA(At, 0, 1); PG8_STAGE(PG8_SA(0, 0), a2, voffA);
            PG8_BAR; PG8_WAIT_L(0); PG8_MMA(1, 0, At, B0); PG8_BAR; PG8_SCHED;
            PG8_STAGE(PG8_SB(0, 1), b2 + hstep, voffB);
            PG8_WAIT_V(6); PG8_BAR; PG8_MMA(1, 1, At, B1); PG8_BAR;
            PG8_LDB(B0, 1, 0); PG8_SCHED; PG8_LDA(At, 1, 0); PG8_STAGE(PG8_SA(0, 1), a2 + hstep, voffA);
            PG8_WAIT_L(8); PG8_BAR; PG8_WAIT_L(0); PG8_MMA(0, 0, At, B0); PG8_BAR; PG8_SCHED;
            PG8_LDB(B1, 1, 1); PG8_STAGE(PG8_SB(1, 0), b3, voffB);
            PG8_BAR; PG8_WAIT_L(0); PG8_MMA(0, 1, At, B1); PG8_BAR;
            PG8_LDA(At, 1, 1); PG8_STAGE(PG8_SA(1, 0), a3, voffA);
            PG8_BAR; PG8_WAIT_L(0); PG8_MMA(1, 0, At, B0); PG8_BAR; PG8_SCHED;
            PG8_STAGE(PG8_SB(1, 1), b3 + hstep, voffB);
            PG8_WAIT_V(6); PG8_BAR; PG8_MMA(1, 1, At, B1); PG8_BAR;
            }
        }
        if constexpr (ALIGN_EPI) { if (wr == 0) PG8_BAR; }
        if constexpr (!Epi::AFTER_DRAIN) { E(acc, cur, wr, wc, fr, fq); S.done(cur); }
        if (!has_next) break;
#pragma unroll
        for (int a = 0; a < 2; ++a)
#pragma unroll
            for (int b = 0; b < 2; ++b)
#pragma unroll
                for (int m = 0; m < 4; ++m)
#pragma unroll
                    for (int n = 0; n < 2; ++n) acc[a][b][m][n] = (f32x4){0.f, 0.f, 0.f, 0.f};
        cur = nxt; cA = nA; cB = nB; ++ui;
        if constexpr (ALIGN_EPI) { if (wr == 1) PG8_BAR; }
    }
    PG8_WAIT_V(0);
    if constexpr (!ALIGN_EPI) { if (wr == 0) PG8_BAR; }
    PG8_BAR;
    if constexpr (Epi::AFTER_DRAIN) { E.fused(acc, cur, wr, wc, fr, fq, lds, wid, lane); S.done(cur); }
#undef PG8_SA
#undef PG8_SB
#undef PG8_STAGE
#undef PG8_LDA
#undef PG8_LDB
#undef PG8_MMA
#undef PG8_WAIT_V
#undef PG8_WAIT_L
#undef PG8_BAR
#undef PG8_SCHED
}
}
namespace pg8 {
struct EpiF32 {
    static constexpr bool PERM = false, AFTER_DRAIN = false;
    float* O; int ldc;
    __device__ __forceinline__ void operator()(const f32x4 (&acc)[2][2][4][2], const Unit& u, int wr, int wc, int fr, int fq) const {
        { int ln_ = LANEID(); asm volatile("" : "+v"(ln_)); fr = ln_ & 15; fq = ln_ >> 4; }
        const int row0 = u.pm * BM + wr * 64 + fr, col0 = u.pn * BM + wc * 32 + 4 * fq;
#pragma unroll
        for (int ai = 0; ai < 2; ++ai)
#pragma unroll
            for (int m = 0; m < 4; ++m) { float* rowp = O + (size_t)(row0 + ai * HALF + m * 16) * ldc + col0;
#pragma unroll
                for (int bj = 0; bj < 2; ++bj)
#pragma unroll
                    for (int n = 0; n < 2; ++n) *(f32x4*)(rowp + bj * HALF + n * 16) = acc[ai][bj][m][n]; }
    }
};
struct EpiResY {
    static constexpr bool PERM = false, AFTER_DRAIN = false;
    const float* hin; float* yout; bf16_t* yb; float* stats; float alpha;
    __device__ __forceinline__ void operator()(const f32x4 (&acc)[2][2][4][2], const Unit& u, int wr, int wc, int fr, int fq) const {
        { int ln_ = LANEID(); asm volatile("" : "+v"(ln_)); fr = ln_ & 15; fq = ln_ >> 4; }
        const int row0 = u.pm * BM + wr * 64 + fr, col0 = u.pn * BM + wc * 32 + 4 * fq;
#pragma unroll
        for (int ai = 0; ai < 2; ++ai)
#pragma unroll
            for (int m = 0; m < 4; ++m) {
                const int row = row0 + ai * HALF + m * 16;
                float s = 0.f, s2 = 0.f;
#pragma unroll
                for (int bj = 0; bj < 2; ++bj)
#pragma unroll
                    for (int n = 0; n < 2; ++n) {
                        const size_t off = (size_t)row * 1024 + col0 + bj * HALF + n * 16;
                        const f32x4 hv = *(const f32x4*)(hin + off);
                        const f32x4 y = hv * alpha + acc[ai][bj][m][n];
                        *(f32x4*)(yout + off) = y;
                        typedef unsigned u32x2v __attribute__((ext_vector_type(2)));
                        u32x2v w; w.x = cvt_pk_bf16(y[0], y[1]); w.y = cvt_pk_bf16(y[2], y[3]);
                        *(u32x2v*)(yb + off) = w;
                        s += (y[0] + y[1]) + (y[2] + y[3]); s2 += (y[0] * y[0] + y[1] * y[1]) + (y[2] * y[2] + y[3] * y[3]);
                    }
                s += __shfl_xor(s, 16); s += __shfl_xor(s, 32); s2 += __shfl_xor(s2, 16); s2 += __shfl_xor(s2, 32);
                if (fq == 0) { atomicAdd(stats + 2 * (size_t)row, s); atomicAdd(stats + 2 * (size_t)row + 1, s2); }
            }
    }
};
struct EpiLnFold {
    static constexpr bool PERM = true, AFTER_DRAIN = false;
    bf16_t* O; const float* stats; const float* colsum; const float* colbias; float eps;
    __device__ __forceinline__ void operator()(const f32x4 (&acc)[2][2][4][2], const Unit& u, int wr, int wc, int fr, int fq) const {
        { int ln_ = LANEID(); asm volatile("" : "+v"(ln_)); fr = ln_ & 15; fq = ln_ >> 4; }
        const int row0 = u.pm * BM + wr * 64 + fr, col0 = u.pn * BM + wc * 32 + 8 * fq;
        f32x4 cs[2][2], cb[2][2];
#pragma unroll
        for (int bj = 0; bj < 2; ++bj)
#pragma unroll
            for (int n = 0; n < 2; ++n) { cs[bj][n] = *(const f32x4*)(colsum + col0 + bj * HALF + 4 * n); cb[bj][n] = *(const f32x4*)(colbias + col0 + bj * HALF + 4 * n); }
#pragma unroll
        for (int ai = 0; ai < 2; ++ai)
#pragma unroll
            for (int m = 0; m < 4; ++m) {
                const int row = row0 + ai * HALF + m * 16;
                const float sm_ = stats[2 * (size_t)row], sq_ = stats[2 * (size_t)row + 1];
                const float mean = sm_ * (1.0f / 1024.0f);
                const float rstd = 1.0f / sqrtf(fmaxf(sq_ * (1.0f / 1024.0f) - mean * mean, 0.f) + eps);
                bf16_t* rowp = O + (size_t)row * 1024 + col0;
#pragma unroll
                for (int bj = 0; bj < 2; ++bj) {
                    const f32x4 v0 = (acc[ai][bj][m][0] - cs[bj][0] * mean) * rstd + cb[bj][0], v1 = (acc[ai][bj][m][1] - cs[bj][1] * mean) * rstd + cb[bj][1];
                    u32x4 w; w.x = cvt_pk_bf16(v0[0], v0[1]); w.y = cvt_pk_bf16(v0[2], v0[3]); w.z = cvt_pk_bf16(v1[0], v1[1]); w.w = cvt_pk_bf16(v1[2], v1[3]);
                    *(u32x4*)(rowp + bj * HALF) = w;
                }
            }
    }
};
}

typedef unsigned short bf16;
constexpr int T_ = 16384, S_ = 4096, NBATCH = 4, D_ = 1024, NCOL = 6824, NP = 6912, DEPTH_ = 2;
constexpr int C_QA = 0, C_KA = 256, C_VA = 320, C_QI = 384, C_KI = 640, C_WI = 672, C_QB = 680, C_KB = 936, C_VB = 1064,
              C_QC = 1192, C_KC = 1448, C_VC = 1704, C_QD = 1960, C_KD = 2216, C_VD = 2472, C_G = 2728;
constexpr int NTHR = 512, NWAVE = 8;
constexpr float ALPHA = 1.41421356237309515f;
constexpr float LN_EPS = 1e-5f;
constexpr size_t MiB = 1u << 20;
constexpr size_t WS_STATS = 1 * MiB  , WS_COLS = 1 * MiB + 512 * 1024  ;
constexpr size_t WS_CTL = 0, WS_WIN_T = 2 * MiB, WS_WOUT_T = 30 * MiB, WS_WQ_T = 34 * MiB, WS_WBR_T = 38 * MiB, WS_HB = 42 * MiB,
                 WS_P = 74 * MiB, WS_MIX = 74 * MiB  , WS_Q = 138 * MiB  , WS_YS = 290 * MiB, WS_MRG = 322 * MiB,
                 WS_MASK = 354 * MiB, WS_EID = 362 * MiB, WS_GATE = 370 * MiB, WS_KMEAN = 378 * MiB, WS_SKB = 379 * MiB, WS_UV = 380 * MiB, WS_END = 508 * MiB;
constexpr size_t WIN_T_BYTES = (size_t)NP * 1024 * 2;
constexpr int LDS_BYTES = 144 * 1024;

struct Params { const float* in[13]; float* out; unsigned char* ws; };

__device__ __forceinline__ float bf2f(bf16 v) { return __uint_as_float((unsigned)v << 16); }
__device__ __forceinline__ unsigned f2bf(float f) { unsigned u = __float_as_uint(f); return (u + 0x7fffu + ((u >> 16) & 1u)) >> 16; }
__device__ __forceinline__ unsigned pk2(float lo, float hi) { return f2bf(lo) | (f2bf(hi) << 16); }
__device__ __forceinline__ void unpack8(const uint4 v, float* o) {
    o[0] = __uint_as_float(v.x << 16); o[1] = __uint_as_float(v.x & 0xffff0000u); o[2] = __uint_as_float(v.y << 16); o[3] = __uint_as_float(v.y & 0xffff0000u);
    o[4] = __uint_as_float(v.z << 16); o[5] = __uint_as_float(v.z & 0xffff0000u); o[6] = __uint_as_float(v.w << 16); o[7] = __uint_as_float(v.w & 0xffff0000u);
}
__device__ __forceinline__ float wave_sum(float v) {
#pragma unroll
    for (int o = 32; o > 0; o >>= 1) v += __shfl_xor(v, o);
    return v;
}
__device__ __forceinline__ float wave_max(float v) {
#pragma unroll
    for (int o = 32; o > 0; o >>= 1) v = fmaxf(v, __shfl_xor(v, o));
    return v;
}
__device__ __forceinline__ int wave_sum_i(int v) {
#pragma unroll
    for (int o = 32; o > 0; o >>= 1) v += __shfl_xor(v, o);
    return v;
}
__device__ __forceinline__ float logsig(float x) { return fminf(x, 0.f) - log1pf(expf(-fabsf(x))); }

__device__ void transpose_items(int WV_, const float* W, int K, int N, bf16* WT, float* sm, int item0, int nitems_total, int item_stride,
                                const float* rs_g = nullptr, const float* rs_b = nullptr, float* colsum = nullptr, float* colbias = nullptr) {
    const int tid = LTID(WV_);
    const int nkb = K / 64, nnb = (N + 63) / 64;
    for (int it = item0; it < nkb * nnb; it += item_stride) {
        const int kb = it % nkb, nb = it / nkb, k0 = kb * 64, n0 = nb * 64;
        __syncthreads();
        for (int e = tid; e < 64 * 64; e += NTHR) { const int kk = e >> 6, nn = e & 63; sm[kk * 65 + nn] = (n0 + nn < N) ? W[(size_t)(k0 + kk) * N + n0 + nn] : 0.f; }
        __syncthreads();
        if (rs_g) {
            if (tid < 64) { float cs = 0.f, cb = 0.f;
                for (int kk = 0; kk < 64; ++kk) { const float w = sm[kk * 65 + tid]; cs += w * rs_g[k0 + kk]; cb += w * rs_b[k0 + kk]; }
                atomicAdd(colsum + n0 + tid, cs); atomicAdd(colbias + n0 + tid, cb); }
            __syncthreads();
            for (int e = tid; e < 64 * 64; e += NTHR) { const int kk = e >> 6, nn = e & 63; sm[kk * 65 + nn] *= rs_g[k0 + kk]; }
            __syncthreads();
        }
        { const int nn = tid >> 3, c = tid & 7;
          if (n0 + nn < N) { uint4 o; o.x = pk2(sm[(8 * c + 0) * 65 + nn], sm[(8 * c + 1) * 65 + nn]); o.y = pk2(sm[(8 * c + 2) * 65 + nn], sm[(8 * c + 3) * 65 + nn]);
              o.z = pk2(sm[(8 * c + 4) * 65 + nn], sm[(8 * c + 5) * 65 + nn]); o.w = pk2(sm[(8 * c + 6) * 65 + nn], sm[(8 * c + 7) * 65 + nn]);
              *(uint4*)(WT + (size_t)(n0 + nn) * K + k0 + 8 * c) = o; } }
    }
    __syncthreads();
}
__device__ void prologue_phase(int WV_, const Params& p, float* sm) {
    const int tid = LTID(WV_), B = LBID(), G = LGRID();
    unsigned char* ws = p.ws;
    for (int l = 0; l < DEPTH_; ++l) {
        bf16* win_t = (bf16*)(ws + WS_WIN_T + l * WIN_T_BYTES);
        transpose_items(WV_, p.in[1] + (size_t)l * 1024 * NCOL, 1024, NCOL, win_t, sm, B, 0, G);
        for (int i = B * NTHR + tid; i < (NP - NCOL) * 1024 / 8; i += G * NTHR) ((uint4*)(win_t + (size_t)NCOL * 1024))[i] = make_uint4(0u, 0u, 0u, 0u);
        transpose_items(WV_, p.in[3] + (size_t)l * 1024 * 1024, 1024, 1024, (bf16*)(ws + WS_WOUT_T) + (size_t)l * 1024 * 1024, sm, B, 0, G);
        transpose_items(WV_, p.in[7] + (size_t)l * 1024 * 1024, 1024, 1024, (bf16*)(ws + WS_WQ_T) + (size_t)l * 1024 * 1024, sm, B, 0, G,
                        p.in[5] + l * 1024, p.in[6] + l * 1024, (float*)(ws + WS_COLS) + l * 2048, (float*)(ws + WS_COLS) + l * 2048 + 1024);
        for (int n = 0; n < 4; ++n)
            transpose_items(WV_, p.in[2] + ((size_t)l * 4 + n) * 256 * 1024, 256, 1024, (bf16*)(ws + WS_WBR_T) + ((size_t)l * 4 + n) * 1024 * 256, sm, B, 0, G);
    }
    const float4* x4 = (const float4*)p.in[0]; uint2* hb2 = (uint2*)(ws + WS_HB);
    for (size_t i = (size_t)B * NTHR + tid; i < (size_t)T_ * 1024 / 4; i += (size_t)G * NTHR) { const float4 v = x4[i]; hb2[i] = make_uint2(pk2(v.x, v.y), pk2(v.z, v.w)); }
}

__device__ __forceinline__ void ln_row(float4 (&v)[4], const float* g, const float* bb, float* orow, bf16* obrow, int lane) {
    float s = 0.f;
#pragma unroll
    for (int j = 0; j < 4; ++j) s += (v[j].x + v[j].y) + (v[j].z + v[j].w);
    const float mean = wave_sum(s) * (1.0f / 1024.0f);
    float s2 = 0.f;
#pragma unroll
    for (int j = 0; j < 4; ++j) { v[j].x -= mean; v[j].y -= mean; v[j].z -= mean; v[j].w -= mean; s2 += (v[j].x * v[j].x + v[j].y * v[j].y) + (v[j].z * v[j].z + v[j].w * v[j].w); }
    const float rstd = 1.0f / sqrtf(wave_sum(s2) * (1.0f / 1024.0f) + LN_EPS);
#pragma unroll
    for (int j = 0; j < 4; ++j) {
        const float4 gg = ((const float4*)g)[j * 64 + lane], b4 = ((const float4*)bb)[j * 64 + lane];
        float4 o; o.x = v[j].x * rstd * gg.x + b4.x; o.y = v[j].y * rstd * gg.y + b4.y; o.z = v[j].z * rstd * gg.z + b4.z; o.w = v[j].w * rstd * gg.w + b4.w;
        ((float4*)orow)[j * 64 + lane] = o;
        ((uint2*)obrow)[j * 64 + lane] = make_uint2(pk2(o.x, o.y), pk2(o.z, o.w));
    }
}
__device__ void ln1_phase(int WV_, const float* hin, const float* add, const float* g, const float* bb, float* hout, bf16* hb) {
    const int lane = LTID(WV_) & 63, wave = LTID(WV_) >> 6;
    for (int row = LBID() * NWAVE + wave; row < T_; row += LGRID() * NWAVE) {
        float4 v[4];
#pragma unroll
        for (int j = 0; j < 4; ++j) {
            const float4 a = ((const float4*)(hin + (size_t)row * 1024))[j * 64 + lane], m = ((const float4*)(add + (size_t)row * 1024))[j * 64 + lane];
            v[j].x = ALPHA * a.x + m.x; v[j].y = ALPHA * a.y + m.y; v[j].z = ALPHA * a.z + m.z; v[j].w = ALPHA * a.w + m.w;
        }
        ln_row(v, g, bb, hout + (size_t)row * 1024, hb + (size_t)row * 1024, lane);
    }
}


typedef short bf16x8_t __attribute__((ext_vector_type(8)));
typedef float f32x16_t __attribute__((ext_vector_type(16)));
typedef float f32x2_t __attribute__((ext_vector_type(2)));
typedef __bf16 bf16x2_t __attribute__((ext_vector_type(2)));
__device__ __forceinline__ unsigned cvtpk(float lo, float hi) { f32x2_t v = {lo, hi}; bf16x2_t b = __builtin_convertvector(v, bf16x2_t); return __builtin_bit_cast(unsigned, b); }
__device__ __forceinline__ int crow(int r, int hi) { return (r & 3) + 8 * (r >> 2) + 4 * hi; }
__device__ __forceinline__ float xlane32(float v) { return __shfl_xor(v, 32); }
__device__ __forceinline__ float vmax(float a, float b) { float r; asm("v_max_f32_e32 %0, %1, %2" : "=v"(r) : "v"(a), "v"(b)); return r; }
__device__ __forceinline__ float vmin(float a, float b) { float r; asm("v_min_f32_e32 %0, %1, %2" : "=v"(r) : "v"(a), "v"(b)); return r; }
__device__ __forceinline__ float vmax3(float a, float b, float c) { float r; asm("v_max3_f32 %0, %1, %2, %3" : "=v"(r) : "v"(a), "v"(b), "v"(c)); return r; }

constexpr int AT_KP = 72, AT_VP = 68;
constexpr int AT_KS = 0, AT_KS_BYTES = 64 * AT_KP * 2;
constexpr int AT_VT = 2 * AT_KS_BYTES, AT_VT_BYTES = 64 * AT_VP * 2;
constexpr int AT_KM = AT_VT + 2 * AT_VT_BYTES;
constexpr int AT_MISC = AT_KM + 32 * AT_KP * 2;
constexpr float LOG2E = 1.4426950408889634f;

__device__ __forceinline__ unsigned mk_unit(int kind, int b, int x, int y) { return ((unsigned)kind << 30) | ((unsigned)b << 28) | ((unsigned)x << 8) | (unsigned)y; }
__device__ void build_unit_table(unsigned* tab, int i) {
    int n = 0; unsigned res = 0u;
#pragma unroll 1
    for (int c = 64; c >= 1; --c) {
        if (i >= n && i < n + 4) res = mk_unit(0, i - n, 0, c - 1);
        n += 4;
        if ((c & 3) == 0) { if (i >= n && i < n + 16) { const int j = i - n; res = mk_unit(2, j >> 2, j & 3, c / 4 - 1); } n += 16; }
    }
    if (i < 512) tab[i] = res;
}

template <int kind> __device__ __forceinline__ void attn_unit(int WV_, const bf16* P, const unsigned char* mask, const float* kmean, const float* sinks, bf16* ys,
                                unsigned char* lds, int b, int ux, int uy) {
    int tid_ = LTID(WV_); asm volatile("" : "+v"(tid_));
    const int tid = tid_, lane = tid & 63, wave = __builtin_amdgcn_readfirstlane(tid >> 6), r32 = lane & 31, hi = lane >> 5;
    bf16* s_km = (bf16*)(lds + AT_KM);
    const int skey = tid >> 3, sc = tid & 7;
    {
        const bf16* Pb = P + (size_t)b * S_ * NP;
        int q0w, qcol, kcol, vcol, ycol, kt_hi, kt_lo; float slope2 = 0.f, sink2 = 0.f;
        if (kind == 0) { const int head = wave >> 1; q0w = uy * 64 + (wave & 1) * 32; qcol = C_QA + head * 64; kcol = C_KA; vcol = C_VA; ycol = head * 64;
            slope2 = exp2f(-8.0f * (float)(3 * head + 1) / 12.0f) * LOG2E; kt_hi = uy; kt_lo = 0; }
        else if (kind == 1) { const int hq = ux * 2 + (wave >> 2); q0w = uy * 128 + (wave & 3) * 32; qcol = C_QB + hq * 64; kcol = C_KB + ux * 64; vcol = C_VB + ux * 64; ycol = 256 + hq * 64;
            slope2 = exp2f(-8.0f * (float)(3 * hq + 2) / 12.0f) * LOG2E; sink2 = sinks[hq] * LOG2E; kt_hi = 2 * uy + 1; kt_lo = (2 * uy - 2 > 0) ? 2 * uy - 2 : 0; }
        else if (kind == 2) { q0w = uy * 256 + wave * 32; qcol = C_QC + ux * 64; kcol = C_KC + ux * 64; vcol = C_VC + ux * 64; ycol = 512 + ux * 64;
            slope2 = exp2f(-8.0f * (float)(3 * ux + 3) / 12.0f) * LOG2E; kt_hi = 4 * uy + 3; kt_lo = 0; }
        else { q0w = uy * 256 + wave * 32; qcol = C_QD + ux * 64; kcol = C_KD + ux * 64; vcol = C_VD + ux * 64; ycol = 768 + ux * 64; kt_hi = 4 * uy + 3; kt_lo = 0; }
        const int qpos = q0w + r32;
        bf16x8_t qf[4];
        { const bf16* qp = Pb + (size_t)qpos * NP + qcol + 8 * hi;
#pragma unroll
          for (int ks = 0; ks < 4; ++ks) qf[ks] = *(const bf16x8_t*)(qp + 16 * ks); }
        {
            const float qs = (kind == 3) ? 0.125f : 0.125f * LOG2E;
            typedef unsigned u32x4_t __attribute__((ext_vector_type(4)));
#pragma unroll
            for (int ks = 0; ks < 4; ++ks) { u32x4_t w = __builtin_bit_cast(u32x4_t, qf[ks]);
#pragma unroll
                for (int i = 0; i < 4; ++i) w[i] = cvtpk(__uint_as_float(w[i] << 16) * qs, __uint_as_float(w[i] & 0xffff0000u) * qs);
                qf[ks] = __builtin_bit_cast(bf16x8_t, w); }
        }
        float sb[16];
#pragma unroll
        for (int r = 0; r < 16; ++r) sb[r] = slope2 * (float)((r & 3) + 8 * (r >> 2));
        unsigned bm = 0u;
        if (kind == 2) {
            const int own = uy;
            for (int e = tid; e < 32 * 64; e += NTHR) { const int row = e >> 6, d = e & 63; s_km[row * AT_KP + d] = (row < 16) ? (bf16)f2bf(kmean[((b * 4 + ux) * 16 + row) * 64 + d]) : (bf16)0; }
            __syncthreads();
            f32x16_t gacc;
#pragma unroll
            for (int r = 0; r < 16; ++r) gacc[r] = 0.f;
#pragma unroll
            for (int ks = 0; ks < 4; ++ks) { const bf16x8_t a = *(const bf16x8_t*)(s_km + r32 * AT_KP + 16 * ks + 8 * hi); gacc = __builtin_amdgcn_mfma_f32_32x32x16_bf16(a, qf[ks], gacc, 0, 0, 0); }
            float gt[16];
#pragma unroll
            for (int r = 0; r < 8; ++r) { const float mine = gacc[r], other = xlane32(mine); const int bi = crow(r, 0);
                gt[bi] = hi ? other : mine; gt[bi + 4] = hi ? mine : other; }
#pragma unroll
            for (int n = 0; n < 16; ++n) if (n >= own) gt[n] = -INFINITY;
#pragma unroll
            for (int rep = 0; rep < 3; ++rep) {
                float mx = -INFINITY;
#pragma unroll
                for (int n = 0; n < 16; ++n) mx = fmaxf(mx, gt[n]);
                bool done = !(mx > -INFINITY);
#pragma unroll
                for (int n = 0; n < 16; ++n) { const bool hit = !done && gt[n] == mx; if (hit) { bm |= 1u << n; gt[n] = -INFINITY; done = true; } }
            }
        }
        f32x16_t o0, o1;
#pragma unroll
        for (int r = 0; r < 16; ++r) { o0[r] = 0.f; o1[r] = 0.f; }
        float m_run = -INFINITY, l_run = 0.f, carry = 0.f;
        const bf16* kg = Pb + (size_t)skey * NP + kcol + sc * 8;
        const bf16* vg = Pb + (size_t)skey * NP + vcol + sc * 8;
        uint4 rk = *(const uint4*)(kg + (size_t)kt_hi * 64 * NP), rv = *(const uint4*)(vg + (size_t)kt_hi * 64 * NP);
        int buf = 0;
        { bf16* ks_ = (bf16*)(lds + AT_KS); bf16* vt_ = (bf16*)(lds + AT_VT);
          *(uint4*)(ks_ + skey * AT_KP + sc * 8) = rk;
          const unsigned vw[4] = {rv.x, rv.y, rv.z, rv.w};
#pragma unroll
          for (int j = 0; j < 4; ++j) { vt_[(sc * 8 + 2 * j) * AT_VP + skey] = (bf16)(vw[j] & 0xffffu); vt_[(sc * 8 + 2 * j + 1) * AT_VP + skey] = (bf16)(vw[j] >> 16); } }
        __syncthreads();
        bool wave_done = false;
        uint2 mw_next = make_uint2(0u, 0u);
        if (kind == 0) mw_next = *(const uint2*)(mask + (size_t)(b * S_ + qpos) * 512 + kt_hi * 8);
        for (int kt = kt_hi; kt >= kt_lo; --kt) {
            const bool more = kt > kt_lo;
            const uint2 mw = mw_next;
            if (kind == 0 && more) mw_next = *(const uint2*)(mask + (size_t)(b * S_ + qpos) * 512 + (kt - 1) * 8);
            if (more) { rk = *(const uint4*)(kg + (size_t)(kt - 1) * 64 * NP); rv = *(const uint4*)(vg + (size_t)(kt - 1) * 64 * NP); }
            const bf16* ks_ = (const bf16*)(lds + AT_KS + buf * AT_KS_BYTES);
            const bf16* vt_ = (const bf16*)(lds + AT_VT + buf * AT_VT_BYTES);
            bool active = (kt * 64 <= q0w + 31) && !wave_done;
            if (kind == 1) active = active && (kt * 64 + 63 >= q0w - 127);
            if (active) {
                const int kbase = kt * 64 + 4 * hi;
                f32x16_t p0, p1;
                if (kind != 3) {
                    const float cb = slope2 * (float)(kbase - qpos), cb1 = cb + 32.0f * slope2;
#pragma unroll
                    for (int r = 0; r < 16; ++r) { p0[r] = cb + sb[r]; p1[r] = cb1 + sb[r]; }
                } else {
#pragma unroll
                    for (int r = 0; r < 16; ++r) { p0[r] = 0.f; p1[r] = 0.f; }
                }
#pragma unroll
                for (int ks = 0; ks < 4; ++ks) {
                    const bf16x8_t a0 = *(const bf16x8_t*)(ks_ + r32 * AT_KP + 16 * ks + 8 * hi);
                    const bf16x8_t a1 = *(const bf16x8_t*)(ks_ + (32 + r32) * AT_KP + 16 * ks + 8 * hi);
                    p0 = __builtin_amdgcn_mfma_f32_32x32x16_bf16(a0, qf[ks], p0, 0, 0, 0);
                    p1 = __builtin_amdgcn_mfma_f32_32x32x16_bf16(a1, qf[ks], p1, 0, 0, 0);
                }
                if (kind != 3) {
                    float mx = -INFINITY;
                    if (kind == 0) {
                        const unsigned w0 = mw.x >> (4 * hi), w1 = mw.y >> (4 * hi);
#pragma unroll
                        for (int r = 0; r < 16; ++r) { const int off = (r & 3) + 8 * (r >> 2);
                            p0[r] = (w0 & (1u << off)) ? p0[r] : -INFINITY; p1[r] = (w1 & (1u << off)) ? p1[r] : -INFINITY; mx = vmax3(mx, p0[r], p1[r]); }
                    } else if (kind == 1) {
                        const int rel = qpos - kbase;
#pragma unroll
                        for (int r = 0; r < 16; ++r) { const int off = (r & 3) + 8 * (r >> 2);
                            p0[r] = ((unsigned)(rel - off) < 128u) ? p0[r] : -INFINITY; p1[r] = ((unsigned)(rel - off - 32) < 128u) ? p1[r] : -INFINITY; mx = vmax3(mx, p0[r], p1[r]); }
                    } else {
                        if ((kt >> 2) == uy) {
                            const int rel = qpos - kbase;
#pragma unroll
                            for (int r = 0; r < 16; ++r) { const int off = (r & 3) + 8 * (r >> 2);
                                p0[r] = (off <= rel) ? p0[r] : -INFINITY; p1[r] = (off + 32 <= rel) ? p1[r] : -INFINITY; mx = vmax3(mx, p0[r], p1[r]); }
                        } else {
                            const bool tile_ok = ((bm >> (kt >> 2)) & 1u) != 0u;
#pragma unroll
                            for (int r = 0; r < 16; ++r) { p0[r] = tile_ok ? p0[r] : -INFINITY; p1[r] = tile_ok ? p1[r] : -INFINITY; mx = vmax3(mx, p0[r], p1[r]); }
                        }
                    }
                    mx = vmax(mx, xlane32(mx));
                    const float m_new = vmax(m_run, mx);
                    const float m_safe = (m_new == -INFINITY) ? 0.f : m_new;
                    p0 = p0 - m_safe; p1 = p1 - m_safe;
#pragma unroll
                    for (int r = 0; r < 16; ++r) { p0[r] = __builtin_amdgcn_exp2f(p0[r]); p1[r] = __builtin_amdgcn_exp2f(p1[r]); }
                    float ls;
                    { typedef float f32x8_t __attribute__((ext_vector_type(8))); typedef float f32x4v_t __attribute__((ext_vector_type(4)));
                      const f32x16_t t16 = p0 + p1; const f32x8_t t8 = t16.lo + t16.hi; const f32x4v_t t4 = t8.lo + t8.hi; const f32x2_t t2 = t4.lo + t4.hi; ls = t2.x + t2.y; }
                    if (__any(m_new > m_run)) {
                        const float alpha = __builtin_amdgcn_exp2f(m_run - m_safe);
                        l_run *= alpha;
                        o0 = o0 * alpha; o1 = o1 * alpha;
                    }
                    l_run += ls; m_run = m_new;
                } else {
                    float run = carry;
#define SB_HALF(PX, KOFF) do { \
                    float lk[16]; \
                    _Pragma("unroll") for (int r = 0; r < 16; ++r) { \
                        const int off = (r & 3) + 8 * (r >> 2); \
                        const bool v = (kbase + off + (KOFF)) < qpos; \
                        const float z = PX[r]; \
                        const float t = 0.6931471805599453f * __builtin_amdgcn_logf(1.0f + __builtin_amdgcn_exp2f(-LOG2E * fabsf(z))); \
                        lk[r] = v ? (fminf(-z, 0.f) - t) : 0.f; \
                        PX[r] = v ? (fminf(z, 0.f) - t) : -INFINITY; } \
                    _Pragma("unroll") for (int g = 3; g >= 0; --g) { \
                        const float G = (lk[4 * g] + lk[4 * g + 1]) + (lk[4 * g + 2] + lk[4 * g + 3]); \
                        const float PG = xlane32(G); \
                        float la = run + (hi ? 0.f : PG); \
                        run += G + PG; \
                        PX[4 * g + 3] += la; la += lk[4 * g + 3]; PX[4 * g + 2] += la; la += lk[4 * g + 2]; PX[4 * g + 1] += la; la += lk[4 * g + 1]; PX[4 * g] += la; } \
                    _Pragma("unroll") for (int r = 0; r < 16; ++r) PX[r] = __builtin_amdgcn_exp2f(LOG2E * PX[r]); } while (0)
                    SB_HALF(p1, 32);
                    SB_HALF(p0, 0);
#undef SB_HALF
                    carry = run;
                }
                unsigned pw[16];
#pragma unroll
                for (int j = 0; j < 8; ++j) { pw[j] = cvtpk(p0[2 * j], p0[2 * j + 1]); pw[8 + j] = cvtpk(p1[2 * j], p1[2 * j + 1]); }
#pragma unroll
                for (int s = 0; s < 4; ++s) {
                    bf16x8_t pb; { const unsigned* q = pw + 4 * s; typedef unsigned u32x4_t __attribute__((ext_vector_type(4))); u32x4_t t4 = {q[0], q[1], q[2], q[3]}; pb = __builtin_bit_cast(bf16x8_t, t4); }
#pragma unroll
                    for (int dt = 0; dt < 2; ++dt) {
                        const bf16* vp = vt_ + (32 * dt + r32) * AT_VP + 16 * s + 4 * hi;
                        typedef short s16x4_t __attribute__((ext_vector_type(4)));
                        const s16x4_t lo = *(const s16x4_t*)vp, hi4 = *(const s16x4_t*)(vp + 8);
                        const bf16x8_t va = {lo[0], lo[1], lo[2], lo[3], hi4[0], hi4[1], hi4[2], hi4[3]};
                        if (dt == 0) o0 = __builtin_amdgcn_mfma_f32_32x32x16_bf16(va, pb, o0, 0, 0, 0);
                        else         o1 = __builtin_amdgcn_mfma_f32_32x32x16_bf16(va, pb, o1, 0, 0, 0);
                    }
                }
            }
            if (kind == 3) {
                const float cm = carry;
                if (__all(cm < -110.0f) || !(kt * 64 <= q0w + 31) ) { if (__all(cm < -110.0f)) wave_done = true; }
            }
            if (more) {
                bf16* ksn = (bf16*)(lds + AT_KS + (buf ^ 1) * AT_KS_BYTES); bf16* vtn = (bf16*)(lds + AT_VT + (buf ^ 1) * AT_VT_BYTES);
                *(uint4*)(ksn + skey * AT_KP + sc * 8) = rk;
                const unsigned vw[4] = {rv.x, rv.y, rv.z, rv.w};
#pragma unroll
                for (int j = 0; j < 4; ++j) { vtn[(sc * 8 + 2 * j) * AT_VP + skey] = (bf16)(vw[j] & 0xffffu); vtn[(sc * 8 + 2 * j + 1) * AT_VP + skey] = (bf16)(vw[j] >> 16); }
            }
            if (kind == 3) { if (__syncthreads_and(wave_done ? 1 : 0)) break; }
            else __syncthreads();
            buf ^= 1;
        }
        float inv;
        if (kind == 3) inv = 1.0f;
        else {
            float lt = l_run + xlane32(l_run);
            if (kind == 1) { const float mf = fmaxf(m_run, sink2); const float sc2 = exp2f(m_run - mf); lt = lt * sc2 + exp2f(sink2 - mf); inv = sc2 / lt; }
            else inv = 1.0f / lt;
        }
        bf16* yp = ys + (size_t)(b * S_ + qpos) * 1024 + ycol + 4 * hi;
#pragma unroll
        for (int g = 0; g < 4; ++g) {
            *(uint2*)(yp + 8 * g) = make_uint2(cvtpk(o0[4 * g] * inv, o0[4 * g + 1] * inv), cvtpk(o0[4 * g + 2] * inv, o0[4 * g + 3] * inv));
            *(uint2*)(yp + 32 + 8 * g) = make_uint2(cvtpk(o1[4 * g] * inv, o1[4 * g + 1] * inv), cvtpk(o1[4 * g + 2] * inv, o1[4 * g + 3] * inv));
        }
    }
}
__device__ void attn_fast_phase(int WV_, const bf16* P, const unsigned char* mask, const float* kmean, const float* sinks, bf16* ys,
                                const unsigned* utab, unsigned* counter, unsigned char* lds) {
    volatile unsigned* s_unit = (volatile unsigned*)(lds + AT_MISC);
    for (;;) {
        __syncthreads();
        if (LTID(WV_) == 0) s_unit[0] = atomicAdd(counter, 1u);
        __syncthreads();
        const unsigned ui = s_unit[0];
        if (ui >= 512u) break;
        const unsigned ue = utab[ui];
        const int kind = (int)(ue >> 30), b = (int)((ue >> 28) & 3u), ux = (int)((ue >> 8) & 255u), uy = (int)(ue & 255u);
        if (kind == 0) attn_unit<0>(WV_, P, mask, kmean, sinks, ys, lds, b, ux, uy);
        else attn_unit<2>(WV_, P, mask, kmean, sinks, ys, lds, b, ux, uy);
    }
    for (int u = LBID(); u < 256; u += LGRID()) { __syncthreads(); attn_unit<3>(WV_, P, mask, kmean, sinks, ys, lds, u >> 6, (u >> 4) & 3, u & 15); }
    for (int u = LBID(); u < 256; u += LGRID()) { __syncthreads(); attn_unit<1>(WV_, P, mask, kmean, sinks, ys, lds, u >> 6, (u >> 5) & 1, u & 31); }
}

constexpr float U_SCALE = 128.0f, V_SCALE = 48.0f;
constexpr int ROW6 = 1536;
typedef float v32f_t __attribute__((ext_vector_type(32)));
typedef unsigned v6u_t __attribute__((ext_vector_type(6)));
typedef unsigned u32x4a8_t __attribute__((ext_vector_type(4), aligned(8)));
__device__ __forceinline__ float rdlane_f(float v, int l) { return __builtin_bit_cast(float, __builtin_amdgcn_readlane(__builtin_bit_cast(int, v), l)); }
__device__ __forceinline__ unsigned q_e2m3(float v) {
    const float a = fminf(fabsf(v), 7.5f);
    unsigned code;
    if (a < 1.0f) code = (unsigned)rintf(a * 8.0f);
    else if (a < 2.0f) code = 8u + (unsigned)rintf((a - 1.0f) * 8.0f);
    else if (a < 4.0f) code = 16u + (unsigned)rintf((a - 2.0f) * 4.0f);
    else code = 24u + (unsigned)rintf((a - 4.0f) * 2.0f);
    return code | (v < 0.f ? 32u : 0u);
}
__device__ void convert_tables(int WV_, const Params& p) {
    const size_t nchunk = (size_t)DEPTH_ * 16384 * 2 * 32;
    for (size_t i = (size_t)LBID() * NTHR + LTID(WV_); i < nchunk; i += (size_t)LGRID() * NTHR) {
        const int c = (int)(i & 31), uvsel = (int)((i >> 5) & 1); const size_t le = i >> 6;
        const float* src = (uvsel ? p.in[10] : p.in[9]) + le * 1024 + c * 32;
        const float sc = uvsel ? V_SCALE : U_SCALE;
        unsigned w[6] = {0u, 0u, 0u, 0u, 0u, 0u};
#pragma unroll
        for (int q4 = 0; q4 < 8; ++q4) {
            const float4 a = ((const float4*)src)[q4];
            const float av[4] = {a.x, a.y, a.z, a.w};
#pragma unroll
            for (int e = 0; e < 4; ++e) { const int idx = q4 * 4 + e, bit = 6 * idx, d = bit >> 5, s = bit & 31; const unsigned code = q_e2m3(av[e] * sc);
                w[d] |= code << s; if (s > 26) w[d + 1] |= code >> (32 - s); }
        }
        uint2* dst = (uint2*)(p.ws + WS_UV + le * ROW6 + uvsel * 768 + c * 24);
        dst[0] = make_uint2(w[0], w[1]); dst[1] = make_uint2(w[2], w[3]); dst[2] = make_uint2(w[4], w[5]);
    }
}
__device__ __forceinline__ v6u_t ld_pk6(const unsigned char* ptr) {
    const uint2 a = ((const uint2*)ptr)[0], b = ((const uint2*)ptr)[1], c = ((const uint2*)ptr)[2];
    const v6u_t pk = {a.x, a.y, b.x, b.y, c.x, c.y};
    return pk;
}
__device__ void peer_fast_phase(int WV_, float* h, bf16* hb, const int* eid, const float* gate, const unsigned char* uv, const float* g1, const float* b1, const float* g, const float* bb, unsigned char* lds) {
    const int tid = LTID(WV_), lane = tid & 63, wave = tid >> 6, l32 = lane & 31, hi = lane >> 5;
    float* pl = (float*)(lds + wave * 16384);
    unsigned char* raw = lds + wave * 16384 + 4096 + lane * 24;
    for (int t = LBID() * NWAVE + wave; t < T_; t += LGRID() * NWAVE) {
        float* hr = h + (size_t)t * 1024 + l32 * 32;
        float x[32], acc[32];
#pragma unroll
        for (int q4 = 0; q4 < 8; ++q4) { const float4 a = ((const float4*)hr)[q4]; x[4 * q4] = a.x; x[4 * q4 + 1] = a.y; x[4 * q4 + 2] = a.z; x[4 * q4 + 3] = a.w; }
        {
            float s = 0.f;
#pragma unroll
            for (int i = 0; i < 32; ++i) s += x[i];
#pragma unroll
            for (int o = 16; o > 0; o >>= 1) s += __shfl_xor(s, o);
            const float mean = s * (1.0f / 1024.0f);
            float s2 = 0.f;
#pragma unroll
            for (int i = 0; i < 32; ++i) { x[i] -= mean; s2 += x[i] * x[i]; }
#pragma unroll
            for (int o = 16; o > 0; o >>= 1) s2 += __shfl_xor(s2, o);
            const float rstd = 1.0f / sqrtf(s2 * (1.0f / 1024.0f) + LN_EPS);
#pragma unroll
            for (int q4 = 0; q4 < 8; ++q4) { const float4 gg = ((const float4*)(g1 + l32 * 32))[q4], cc = ((const float4*)(b1 + l32 * 32))[q4];
                x[4 * q4] = x[4 * q4] * rstd * gg.x + cc.x; x[4 * q4 + 1] = x[4 * q4 + 1] * rstd * gg.y + cc.y; x[4 * q4 + 2] = x[4 * q4 + 2] * rstd * gg.z + cc.z; x[4 * q4 + 3] = x[4 * q4 + 3] * rstd * gg.w + cc.w; }
        }
#pragma unroll
        for (int i = 0; i < 32; ++i) acc[i] = 0.f;
#pragma unroll 1
        for (int batch = 0; batch < 4; ++batch) {
            const int my_eid = eid[(size_t)t * 128 + batch * 32 + l32];
            const float my_gate = gate[(size_t)t * 128 + batch * 32 + l32];
#pragma unroll 1
            for (int grp = 0; grp < 2; ++grp) {
                { u32x4a8_t pa[8]; uint2 pc[8];
#pragma unroll
                  for (int i = 0; i < 8; ++i) { const int id = __shfl(my_eid, 2 * (grp * 8 + i) + hi); const unsigned char* rp = uv + (size_t)id * ROW6 + l32 * 24; pa[i] = *(const u32x4a8_t*)rp; pc[i] = *(const uint2*)(rp + 16); }
#pragma unroll
                  for (int i = 0; i < 8; ++i) { uint2* wp = (uint2*)(raw + i * 1536); wp[0] = make_uint2(pa[i].x, pa[i].y); wp[1] = make_uint2(pa[i].z, pa[i].w); wp[2] = pc[i]; } }
#pragma unroll 1
                for (int i = 0; i < 8; ++i) {
                    const uint2* rp = (const uint2*)(raw + i * 1536); const uint2 a = rp[0], b = rp[1], c = rp[2];
                    const v6u_t pk6 = {a.x, a.y, b.x, b.y, c.x, c.y}; const v32f_t f = __builtin_amdgcn_cvt_scalef32_pk32_f32_fp6(pk6, 1.0f);
                    f32x2_t dv0 = {0.f, 0.f}, dv1 = {0.f, 0.f};
#pragma unroll
                    for (int j = 0; j < 8; ++j) { const f32x2_t fa = {f[2 * j], f[2 * j + 1]}, fb = {f[16 + 2 * j], f[17 + 2 * j]}, xa = {x[2 * j], x[2 * j + 1]}, xb = {x[16 + 2 * j], x[17 + 2 * j]};
                        dv0 = fa * xa + dv0; dv1 = fb * xb + dv1; }
                    pl[(2 * (grp * 8 + i) + hi) * 32 + l32] = (dv0.x + dv0.y) + (dv1.x + dv1.y);
                }
            }
            float d;
            { const float4* pr = (const float4*)(pl + l32 * 32); float4 s4 = pr[0];
#pragma unroll
              for (int i = 1; i < 8; ++i) { const float4 v = pr[i]; s4.x += v.x; s4.y += v.y; s4.z += v.z; s4.w += v.w; }
              d = ((s4.x + s4.y) + (s4.z + s4.w)) * (1.0f / U_SCALE); }
            const float hv = 0.5f * d * (1.0f + erff(d * 0.70710678118654752f)) * my_gate * (1.0f / V_SCALE);
#pragma unroll 1
            for (int grp = 0; grp < 2; ++grp) {
                { u32x4a8_t pa[8]; uint2 pc[8];
#pragma unroll
                  for (int i = 0; i < 8; ++i) { const int id = __shfl(my_eid, 2 * (grp * 8 + i) + hi); const unsigned char* rp = uv + (size_t)id * ROW6 + 768 + l32 * 24; pa[i] = *(const u32x4a8_t*)rp; pc[i] = *(const uint2*)(rp + 16); }
#pragma unroll
                  for (int i = 0; i < 8; ++i) { uint2* wp = (uint2*)(raw + i * 1536); wp[0] = make_uint2(pa[i].x, pa[i].y); wp[1] = make_uint2(pa[i].z, pa[i].w); wp[2] = pc[i]; } }
#pragma unroll 1
                for (int i = 0; i < 8; ++i) {
                    const float c = __shfl(hv, 2 * (grp * 8 + i) + hi);
                    const uint2* rp = (const uint2*)(raw + i * 1536); const uint2 a = rp[0], b = rp[1], cc = rp[2];
                    const v6u_t pk6 = {a.x, a.y, b.x, b.y, cc.x, cc.y}; const v32f_t f = __builtin_amdgcn_cvt_scalef32_pk32_f32_fp6(pk6, 1.0f);
                    const f32x2_t c2 = {c, c};
#pragma unroll
                    for (int j = 0; j < 16; ++j) { const f32x2_t fj = {f[2 * j], f[2 * j + 1]}; f32x2_t aj = {acc[2 * j], acc[2 * j + 1]}; aj = fj * c2 + aj; acc[2 * j] = aj.x; acc[2 * j + 1] = aj.y; }
                }
            }
        }
        float y[32], s = 0.f;
#pragma unroll
        for (int i = 0; i < 32; ++i) { acc[i] += __shfl_xor(acc[i], 32); y[i] = ALPHA * x[i] + acc[i]; s += y[i]; }
#pragma unroll
        for (int o = 16; o > 0; o >>= 1) s += __shfl_xor(s, o);
        const float mean = s * (1.0f / 1024.0f);
        float s2 = 0.f;
#pragma unroll
        for (int i = 0; i < 32; ++i) { y[i] -= mean; s2 += y[i] * y[i]; }
#pragma unroll
        for (int o = 16; o > 0; o >>= 1) s2 += __shfl_xor(s2, o);
        const float rstd = 1.0f / sqrtf(s2 * (1.0f / 1024.0f) + LN_EPS);
        float o[16];
#pragma unroll
        for (int q4 = 0; q4 < 4; ++q4) {
            const float4 gg = ((const float4*)(g + l32 * 32 + hi * 16))[q4], cc = ((const float4*)(bb + l32 * 32 + hi * 16))[q4];
            float ya[4], yb2[4];
#pragma unroll
            for (int e = 0; e < 4; ++e) { ya[e] = y[4 * q4 + e]; yb2[e] = y[16 + 4 * q4 + e]; }
            asm volatile("" : "+v"(ya[0]), "+v"(ya[1]), "+v"(ya[2]), "+v"(ya[3]), "+v"(yb2[0]), "+v"(yb2[1]), "+v"(yb2[2]), "+v"(yb2[3]));
            const float y0 = hi ? yb2[0] : ya[0], y1 = hi ? yb2[1] : ya[1], y2 = hi ? yb2[2] : ya[2], y3 = hi ? yb2[3] : ya[3];
            o[4 * q4] = y0 * rstd * gg.x + cc.x; o[4 * q4 + 1] = y1 * rstd * gg.y + cc.y; o[4 * q4 + 2] = y2 * rstd * gg.z + cc.z; o[4 * q4 + 3] = y3 * rstd * gg.w + cc.w;
            ((float4*)(hr + hi * 16))[q4] = make_float4(o[4 * q4], o[4 * q4 + 1], o[4 * q4 + 2], o[4 * q4 + 3]);
        }
        uint4* hbp = (uint4*)(hb + (size_t)t * 1024 + l32 * 32 + hi * 16);
        hbp[0] = make_uint4(pk2(o[0], o[1]), pk2(o[2], o[3]), pk2(o[4], o[5]), pk2(o[6], o[7]));
        hbp[1] = make_uint4(pk2(o[8], o[9]), pk2(o[10], o[11]), pk2(o[12], o[13]), pk2(o[14], o[15]));
    }
}

__device__ __forceinline__ float pack_pl(float v, unsigned pl) { return __uint_as_float((__float_as_uint(v) & ~127u) | pl); }
__device__ __forceinline__ void ins16(float (&s)[16], float x) {
#pragma unroll
    for (int k = 15; k >= 1; --k) s[k] = __builtin_amdgcn_fmed3f(s[k - 1], x, s[k]);
    s[0] = vmax(s[0], x);
}
template <int D> __device__ __forceinline__ void bitonic_stage(float (&c)[16]) {
#pragma unroll
    for (int i = 0; i < 16; ++i) if ((i & D) == 0) { const float a = vmax(c[i], c[i + D]), b = vmin(c[i], c[i + D]); c[i] = a; c[i + D] = b; }
}
__device__ __forceinline__ int decode_key(unsigned pl) { return (int)(32u * ((pl >> 4) & 3u) + (pl & 3u) + 8u * ((pl >> 2) & 3u) + 4u * ((pl >> 6) & 1u)); }
__device__ void route_fast_phase(int WV_, const bf16* qb, const bf16* skb  , int* eid, float* gate, unsigned char* lds, int pm = -1, int pn = 0) {
    const int tid = LTID(WV_), lane = tid & 63, wave = tid >> 6, r32 = lane & 31, hi = lane >> 5;
    unsigned* lidx = (unsigned*)lds + wave * (64 * 33) + lane * 33;
    const int u_first = (pm >= 0) ? 0 : LBID() * NWAVE + wave, u_end = (pm >= 0) ? 2 : (T_ / 32) * 8, u_step = (pm >= 0) ? 1 : LGRID() * NWAVE;
    for (int unit = u_first; unit < u_end; unit += u_step) {
        const int h = (pm >= 0) ? 2 * pn + unit : (unit & 7), t = ((pm >= 0) ? 8 * pm + wave : (unit >> 3)) * 32 + r32;
        float sl[2][16];
#pragma unroll
        for (int p = 0; p < 2; ++p) {
            bf16x8_t qf[4];
            { const bf16* qp = qb + (size_t)t * 1024 + h * 128 + p * 64 + 8 * hi;
#pragma unroll
              for (int ks = 0; ks < 4; ++ks) qf[ks] = *(const bf16x8_t*)(qp + 16 * ks); }
            float s[16];
#pragma unroll
            for (int k = 0; k < 16; ++k) s[k] = -INFINITY;
            const bf16* skp = skb + ((size_t)(h * 2 + p) * 128 + r32) * 64 + 8 * hi;
#pragma unroll
            for (int kt = 0; kt < 4; ++kt) {
                f32x16_t acc;
#pragma unroll
                for (int r = 0; r < 16; ++r) acc[r] = 0.f;
#pragma unroll
                for (int ks = 0; ks < 4; ++ks) { const bf16x8_t a = *(const bf16x8_t*)(skp + (size_t)kt * 32 * 64 + 16 * ks); acc = __builtin_amdgcn_mfma_f32_32x32x16_bf16(a, qf[ks], acc, 0, 0, 0); }
#pragma unroll
                for (int r = 0; r < 16; ++r) ins16(s, pack_pl(acc[r], (unsigned)(kt * 16 + r)));
            }
            const unsigned hb = (unsigned)hi << 6;
#pragma unroll
            for (int k = 0; k < 16; ++k) s[k] = __uint_as_float(__float_as_uint(s[k]) | hb);
            float c[16];
#pragma unroll
            for (int k = 0; k < 16; ++k) c[k] = vmax(s[k], __shfl_xor(s[15 - k], 32));
            bitonic_stage<8>(c); bitonic_stage<4>(c); bitonic_stage<2>(c); bitonic_stage<1>(c);
#pragma unroll
            for (int k = 0; k < 16; ++k) { sl[p][k] = c[k]; lidx[p * 16 + k] = (unsigned)decode_key(__float_as_uint(c[k]) & 127u); }
        }
        float w[16];
#pragma unroll
        for (int k = 0; k < 16; ++k) w[k] = -INFINITY;
#pragma unroll
        for (int i = 0; i < 16; ++i)
#pragma unroll
            for (int j = 0; j < 16; ++j)
                if ((i + 1) * (j + 1) <= 16) { const float v = sl[0][i] + sl[1][j]; ins16(w, __uint_as_float((__float_as_uint(v) & ~255u) | (unsigned)(i * 16 + j))); }
        float e[16], sum = 0.f;
#pragma unroll
        for (int k = 0; k < 16; ++k) { e[k] = expf(w[k] - w[0]); sum += e[k]; }
        const float inv = 1.0f / sum;
        int ide[8]; float gte[8];
#pragma unroll
        for (int k = 0; k < 8; ++k) {
            float wa = w[k], wb = w[8 + k], ea = e[k], eb = e[8 + k];
            asm volatile("" : "+v"(wa), "+v"(wb), "+v"(ea), "+v"(eb));
            const float wv = hi ? wb : wa;
            const unsigned pl = __float_as_uint(wv) & 255u;
            ide[k] = (int)(lidx[pl >> 4] * 128u + lidx[16 + (pl & 15u)]);
            gte[k] = (hi ? eb : ea) * inv;
        }
        int* ep = eid + (size_t)t * 128 + h * 16 + hi * 8; float* gp = gate + (size_t)t * 128 + h * 16 + hi * 8;
        *(int4*)ep = make_int4(ide[0], ide[1], ide[2], ide[3]); *(int4*)(ep + 4) = make_int4(ide[4], ide[5], ide[6], ide[7]);
        *(float4*)gp = make_float4(gte[0], gte[1], gte[2], gte[3]); *(float4*)(gp + 4) = make_float4(gte[4], gte[5], gte[6], gte[7]);
    }
}

typedef float f32x4_t __attribute__((ext_vector_type(4)));
typedef __bf16 bf16x2v __attribute__((ext_vector_type(2)));
__device__ __forceinline__ float dot2bf(unsigned a, unsigned b, float c) { return __builtin_amdgcn_fdot2_f32_bf16(__builtin_bit_cast(bf16x2v, a), __builtin_bit_cast(bf16x2v, b), c, false); }
__device__ __forceinline__ void cnt_gt(int& cnt, unsigned a, unsigned b) { asm("v_cmp_gt_u32_e32 vcc, %1, %2\n\tv_addc_co_u32_e32 %0, vcc, 0, %0, vcc" : "+v"(cnt) : "v"(a), "v"(b) : "vcc"); }
__device__ __forceinline__ void cnt_eq(int& cnt, unsigned a, unsigned b) { asm("v_cmp_eq_u32_e32 vcc, %1, %2\n\tv_addc_co_u32_e32 %0, vcc, 0, %0, vcc" : "+v"(cnt) : "v"(a), "v"(b) : "vcc"); }
__device__ __forceinline__ unsigned flag_gt(unsigned a, unsigned b) { unsigned r; asm("v_cmp_gt_u32_e32 vcc, %1, %2\n\tv_cndmask_b32_e64 %0, 0, 1, vcc" : "=v"(r) : "v"(a), "v"(b) : "vcc"); return r; }
__device__ __forceinline__ unsigned flag_eq(unsigned a, unsigned b) { unsigned r; asm("v_cmp_eq_u32_e32 vcc, %1, %2\n\tv_cndmask_b32_e64 %0, 0, 1, vcc" : "=v"(r) : "v"(a), "v"(b) : "vcc"); return r; }
__device__ __forceinline__ void cnt_ge(int& cnt, unsigned key, unsigned cand) { asm("v_cmp_ge_u32_e32 vcc, %1, %2\n\tv_addc_co_u32_e32 %0, vcc, 0, %0, vcc" : "+v"(cnt) : "v"(key), "v"(cand) : "vcc"); }

typedef __attribute__((address_space(3))) unsigned lds_u32;
template <int SHIFT> __device__ __forceinline__ unsigned radix_pass(const unsigned (&key)[64], unsigned pre, lds_u32* hist, int lane, int& need) {
    typedef unsigned u32x4v __attribute__((ext_vector_type(4)));
    typedef __attribute__((address_space(3))) u32x4v lds_u32x4;
    { const u32x4v z4 = {0u, 0u, 0u, 0u};
#pragma unroll
      for (int i = 0; i < 8; ++i) ((lds_u32x4*)(hist + lane * 32))[i] = z4; }
    const unsigned cp = (unsigned)(lane & 7);
#pragma unroll
    for (int j = 0; j < 64; ++j) {
        const unsigned d = (key[j] >> SHIFT) & 255u;
        bool m;
        if (SHIFT == 24) m = key[j] != 0u; else m = (key[j] >> ((SHIFT + 8) & 31)) == pre;
        if (m) __hip_atomic_fetch_add(hist + ((d << 3) | cp), 1u, __ATOMIC_RELAXED, __HIP_MEMORY_SCOPE_WORKGROUP);
    }
    unsigned dsum[4]; unsigned sumL = 0u;
#pragma unroll
    for (int i = 0; i < 4; ++i) { const u32x4v v0 = ((const lds_u32x4*)(hist + lane * 32))[2 * i], v1 = ((const lds_u32x4*)(hist + lane * 32))[2 * i + 1];
        dsum[i] = ((v0.x + v0.y) + (v0.z + v0.w)) + ((v1.x + v1.y) + (v1.z + v1.w)); sumL += dsum[i]; }
    unsigned incl = sumL;
#pragma unroll
    for (int o = 1; o < 64; o <<= 1) { const unsigned t = (unsigned)__shfl_down((int)incl, o); if (lane + o < 64) incl += t; }
    const unsigned above = incl - sumL;
    const bool own = (above < (unsigned)need) && ((unsigned)need <= above + sumL);
    const int owner = __ffsll((long long)__ballot(own)) - 1;
    unsigned acc = above; int sel = -1; unsigned cab = 0u;
#pragma unroll
    for (int i = 3; i >= 0; --i) { const unsigned c = dsum[i]; const bool hit = (sel < 0) && (acc + c >= (unsigned)need); cab = hit ? acc : cab; sel = hit ? i : sel; acc += c; }
    const int ow = owner < 0 ? 0 : owner;
    const unsigned digit = (unsigned)__builtin_amdgcn_readlane(sel, ow) + (unsigned)(4 * ow);
    need -= (int)__builtin_amdgcn_readlane((int)cab, ow);
    return digit;
}
#ifndef TS_SEL
#define TS_SEL 0
#endif
#define ITS_B() do { if (TS_SEL >= 20 && TS_SEL <= 25 && WV_ == 0 && LANEID() == 0) ((volatile __attribute__((address_space(3))) unsigned long long*)((__attribute__((address_space(3))) unsigned char*)lds + 147456 - 16 - 32))[0] = __builtin_amdgcn_s_memrealtime(); } while (0)
#define ITS_E(k) do { if ((k) == TS_SEL && WV_ == 0 && LANEID() == 0) { volatile __attribute__((address_space(3))) unsigned long long* w_ = (volatile __attribute__((address_space(3))) unsigned long long*)((__attribute__((address_space(3))) unsigned char*)lds + 147456 - 16 - 32); w_[1] += __builtin_amdgcn_s_memrealtime() - w_[0]; } } while (0)
__device__ void index_fast_phase(int WV_, const bf16* P, unsigned char* mask, float* kmean, float* scratch_all, unsigned char* lds) {
    const int tid = LTID(WV_), lane = tid & 63, wave = tid >> 6, bid = LBID(), G = LGRID();
    float* s_part = (float*)lds;
    ITS_B();
    for (int k = bid; k < 256; k += G) {
        const int b = k >> 6, h = (k >> 4) & 3, blk = k & 15;
        const bf16* kp = P + (size_t)(b * S_ + blk * 256 + wave * 32) * NP + C_KC + h * 64 + lane;
        float a = 0.f;
#pragma unroll 8
        for (int j = 0; j < 32; ++j) a += bf2f(kp[(size_t)j * NP]);
        __syncthreads();
        s_part[wave * 64 + lane] = a;
        __syncthreads();
        if (tid < 64) { float s = 0.f;
#pragma unroll
            for (int w = 0; w < 8; ++w) s += s_part[w * 64 + tid];
            kmean[((b * 4 + h) * 16 + blk) * 64 + tid] = s * (1.0f / 256.0f); }
    }
    ITS_E(22);
    float* scr = scratch_all + (size_t)bid * (16 * 4096);
    const int lq = lane & 15, g4 = lane >> 4;
    for (int ui = bid; ui < 1024; ui += G) {
        const int b = ui >> 8, k = ui & 255, tile = (b & 1) ? 255 - k : k, q0 = tile * 16;
        const bf16* Pb = P + (size_t)b * S_ * NP;
        const int ntiles = tile + 1;
        ITS_B();
        bf16x8_t qf[8]; float wi[8];
        { const bf16* qp = Pb + (size_t)(q0 + lq) * NP + C_QI + 8 * g4;
#pragma unroll
          for (int h = 0; h < 8; ++h) qf[h] = *(const bf16x8_t*)(qp + 32 * h);
          const uint4 wv = *(const uint4*)(Pb + (size_t)(q0 + lq) * NP + C_WI); unpack8(wv, wi); }
        {
            bf16x8_t afn = *(const bf16x8_t*)(Pb + (size_t)((wave < ntiles ? wave : 0) * 16 + lq) * NP + C_KI + 8 * g4);
            for (int kt = wave; kt < ntiles; kt += NWAVE) {
                const bf16x8_t af = afn;
                { const int ktn = (kt + NWAVE < ntiles) ? kt + NWAVE : kt; afn = *(const bf16x8_t*)(Pb + (size_t)(ktn * 16 + lq) * NP + C_KI + 8 * g4); }
                f32x4_t a[8];
                const f32x4_t z = {0.f, 0.f, 0.f, 0.f};
#pragma unroll
                for (int h = 0; h < 8; ++h) a[h] = __builtin_amdgcn_mfma_f32_16x16x32_bf16(af, qf[h], z, 0, 0, 0);
                __builtin_amdgcn_sched_barrier(0);
                f32x4_t sc = {0.f, 0.f, 0.f, 0.f};
#pragma unroll
                for (int h = 0; h < 8; ++h)
#pragma unroll
                    for (int r = 0; r < 4; ++r) { float rl; asm("v_max_f32_e32 %0, 0, %1" : "=v"(rl) : "v"(a[h][r])); sc[r] += rl * wi[h]; }
#pragma unroll
                for (int r = 0; r < 4; ++r) { sc[r] *= 0.0625f; if (sc[r] == 0.f) sc[r] = 0.f; }
                *(f32x4_t*)(scr + (size_t)lq * 4096 + kt * 16 + 4 * g4) = sc;
            }
        }
        __threadfence_block();
        __syncthreads();
        __threadfence_block();
        ITS_E(20); ITS_B();
        lds_u32* hist = (lds_u32*)((__attribute__((address_space(3))) unsigned char*)lds + 2048) + wave * 2048;
#pragma unroll 1
        for (int qi = 0; qi < 2; ++qi) {
            const int ql = 2 * wave + qi, q = q0 + ql;
            const float* row = scr + (size_t)ql * 4096 + lane * 64;
            const int qrel = q - lane * 64;
            unsigned key[64];
            if (qrel >= 0) {
#pragma unroll
                for (int j4 = 0; j4 < 16; ++j4) {
                    const float4 v = ((const float4*)row)[j4];
                    const unsigned u[4] = {__float_as_uint(v.x), __float_as_uint(v.y), __float_as_uint(v.z), __float_as_uint(v.w)};
#pragma unroll
                    for (int e = 0; e < 4; ++e) { const unsigned t = u[e] ^ ((unsigned)((int)u[e] >> 31) | 0x80000000u); const unsigned inval = (unsigned)((qrel - (j4 * 4 + e)) >> 31); key[j4 * 4 + e] = t & ~inval; }
                    if ((j4 & 3) == 3) asm volatile("" ::: "memory");
                }
            } else {
#pragma unroll
                for (int j = 0; j < 64; ++j) key[j] = 0u;
            }
            ITS_E(23); ITS_B();
            unsigned wlo = 0u, whi = 0u;
            if (q + 1 > 256) {
                int need = 256;
                const unsigned d1 = radix_pass<24>(key, 0u, hist, lane, need);
                const unsigned d2 = radix_pass<16>(key, d1, hist, lane, need);
                const unsigned d3 = radix_pass<8>(key, (d1 << 8) | d2, hist, lane, need);
                const unsigned d4 = radix_pass<0>(key, (d1 << 16) | (d2 << 8) | d3, hist, lane, need);
                const unsigned prefix = (d1 << 24) | (d2 << 16) | (d3 << 8) | d4;
                ITS_E(24); ITS_B();
                int ceq = 0;
#pragma unroll
                for (int j = 0; j < 64; ++j) cnt_eq(ceq, key[j], prefix);
                ceq = wave_sum_i(ceq);
                int X = 4096;
                if (ceq != need) {
                    int X0 = 0;
#pragma unroll 1
                    for (int bit = 11; bit >= 0; --bit) {
                        const int c = X0 | (1 << bit);
                        int cnt = 0; const int crel = c - lane * 64;
#pragma unroll
                        for (int j = 0; j < 64; ++j) cnt_eq(cnt, (key[j] ^ prefix) | ~(unsigned)((j - crel) >> 31), 0u);
                        cnt = wave_sum_i(cnt);
                        if (cnt < need) X0 = c;
                    }
                    X = X0 + 1;
                }
                const int xrel = X - lane * 64;
#pragma unroll
                for (int j = 0; j < 32; ++j) {
                    const unsigned s0 = flag_gt(key[j], prefix) | flag_eq((key[j] ^ prefix) | ~(unsigned)((j - xrel) >> 31), 0u);
                    const unsigned s1 = flag_gt(key[32 + j], prefix) | flag_eq((key[32 + j] ^ prefix) | ~(unsigned)((32 + j - xrel) >> 31), 0u);
                    wlo |= s0 << j; whi |= s1 << j;
                }
            } else {
#pragma unroll
                for (int j = 0; j < 32; ++j) { wlo |= (~(unsigned)((qrel - j) >> 31) & 1u) << j; whi |= (~(unsigned)((qrel - 32 - j) >> 31) & 1u) << j; }
            }
            ((uint2*)(mask + (size_t)(b * S_ + q) * 512))[lane] = make_uint2(wlo, whi);
            ITS_E(25); ITS_B();
        }
        ITS_E(21);
        __syncthreads();
    }
}

constexpr int MG_P = 72;
constexpr int MG_TILE_BYTES = 128 * MG_P * 2;
__device__ void merge_fast_phase(int WV_, const bf16* P, const bf16* ys, const bf16* wbt  , bf16* merged, unsigned char* lds) {
    const int tid = LTID(WV_), lane = tid & 63, wave = tid >> 6, r32 = lane & 31, hi = lane >> 5, wt = wave & 3, wd = wave >> 2;
    const int srow0 = tid >> 3, sch = tid & 7;
    for (int tile = LBID(); tile < 1024; tile += LGRID()) {
        const int tok0 = (tile >> 3) * 128, d0 = (tile & 7) * 128;
        f32x16_t mer[2], acc[2];
#pragma unroll
        for (int r = 0; r < 16; ++r) { mer[0][r] = 0.f; mer[1][r] = 0.f; acc[0][r] = 0.f; acc[1][r] = 0.f; }
        uint4 RW00, RW01, RW10, RW11, RY00, RY01, RY10, RY11, RG0, RG1, RG2, RG3;
        bf16* gl = (bf16*)(lds + 4 * MG_TILE_BYTES);
        const int grow = tid >> 4, gch = tid & 15;
#define MG_GLOAD(st_, R_) do { const int n_ = (st_) >> 2, kc_ = (st_) & 3; \
            RW##R_##0 = *(const uint4*)(wbt + ((size_t)n_ * 1024 + d0 + srow0) * 256 + kc_ * 64 + sch * 8); \
            RW##R_##1 = *(const uint4*)(wbt + ((size_t)n_ * 1024 + d0 + srow0 + 64) * 256 + kc_ * 64 + sch * 8); \
            RY##R_##0 = *(const uint4*)(ys + (size_t)(tok0 + srow0) * 1024 + n_ * 256 + kc_ * 64 + sch * 8); \
            RY##R_##1 = *(const uint4*)(ys + (size_t)(tok0 + srow0 + 64) * 1024 + n_ * 256 + kc_ * 64 + sch * 8); } while (0)
#define MG_SSTORE(buf_, R_) do { bf16* wl_ = (bf16*)(lds + (buf_) * 2 * MG_TILE_BYTES); bf16* yl_ = (bf16*)(lds + (buf_) * 2 * MG_TILE_BYTES + MG_TILE_BYTES); \
            *(uint4*)(wl_ + srow0 * MG_P + sch * 8) = RW##R_##0; *(uint4*)(wl_ + (srow0 + 64) * MG_P + sch * 8) = RW##R_##1; \
            *(uint4*)(yl_ + srow0 * MG_P + sch * 8) = RY##R_##0; *(uint4*)(yl_ + (srow0 + 64) * MG_P + sch * 8) = RY##R_##1; } while (0)
        __syncthreads();
        MG_GLOAD(0, 0); MG_GLOAD(1, 1);
        MG_SSTORE(0, 0);
        __syncthreads();
#define MG_STAGE(PAR_, OTH_) do { const int buf = PAR_; \
            if (st + 2 < 16) MG_GLOAD(st + 2, PAR_); \
            if ((st & 3) == 1) { const bf16* gsrc = P + (size_t)(tok0 + grow) * NP + C_G + (st >> 2) * 1024 + d0 + gch * 8; \
                RG0 = *(const uint4*)gsrc; RG1 = *(const uint4*)(gsrc + (size_t)32 * NP); RG2 = *(const uint4*)(gsrc + (size_t)64 * NP); RG3 = *(const uint4*)(gsrc + (size_t)96 * NP); } \
            const bf16* wl = (const bf16*)(lds + buf * 2 * MG_TILE_BYTES); const bf16* yl = (const bf16*)(lds + buf * 2 * MG_TILE_BYTES + MG_TILE_BYTES); \
            _Pragma("unroll") for (int ks = 0; ks < 4; ++ks) { \
                const bf16x8_t bq = *(const bf16x8_t*)(yl + (32 * wt + r32) * MG_P + 16 * ks + 8 * hi); \
                const bf16x8_t a0 = *(const bf16x8_t*)(wl + (64 * wd + r32) * MG_P + 16 * ks + 8 * hi); \
                const bf16x8_t a1 = *(const bf16x8_t*)(wl + (64 * wd + 32 + r32) * MG_P + 16 * ks + 8 * hi); \
                acc[0] = __builtin_amdgcn_mfma_f32_32x32x16_bf16(a0, bq, acc[0], 0, 0, 0); \
                acc[1] = __builtin_amdgcn_mfma_f32_32x32x16_bf16(a1, bq, acc[1], 0, 0, 0); } \
            if ((st & 3) == 3) { \
                const int n = st >> 2; \
                const bf16* gp = gl + (32 * wt + r32) * 136 + 64 * wd + 4 * hi; (void)n; \
                _Pragma("unroll") for (int dt = 0; dt < 2; ++dt) \
                _Pragma("unroll") for (int g = 0; g < 4; ++g) { \
                        const uint2 gv = *(const uint2*)(gp + 32 * dt + 8 * g); \
                        const float g0 = __uint_as_float(gv.x << 16), g1 = __uint_as_float(gv.x & 0xffff0000u), g2 = __uint_as_float(gv.y << 16), g3 = __uint_as_float(gv.y & 0xffff0000u); \
                        mer[dt][4 * g + 0] += acc[dt][4 * g + 0] * __builtin_amdgcn_rcpf(1.f + __builtin_amdgcn_exp2f(-LOG2E * g0)); \
                        mer[dt][4 * g + 1] += acc[dt][4 * g + 1] * __builtin_amdgcn_rcpf(1.f + __builtin_amdgcn_exp2f(-LOG2E * g1)); \
                        mer[dt][4 * g + 2] += acc[dt][4 * g + 2] * __builtin_amdgcn_rcpf(1.f + __builtin_amdgcn_exp2f(-LOG2E * g2)); \
                        mer[dt][4 * g + 3] += acc[dt][4 * g + 3] * __builtin_amdgcn_rcpf(1.f + __builtin_amdgcn_exp2f(-LOG2E * g3)); } \
                _Pragma("unroll") for (int r = 0; r < 16; ++r) { acc[0][r] = 0.f; acc[1][r] = 0.f; } } \
            if (st + 1 < 16) MG_SSTORE(OTH_, OTH_); \
            if ((st & 3) == 2) { *(uint4*)(gl + grow * 136 + gch * 8) = RG0; *(uint4*)(gl + (grow + 32) * 136 + gch * 8) = RG1; *(uint4*)(gl + (grow + 64) * 136 + gch * 8) = RG2; *(uint4*)(gl + (grow + 96) * 136 + gch * 8) = RG3; } \
            __syncthreads(); } while (0)
#pragma unroll 1
        for (int st2 = 0; st2 < 16; st2 += 2) { { const int st = st2; MG_STAGE(0, 1); } { const int st = st2 + 1; MG_STAGE(1, 0); } }
#undef MG_STAGE
#undef MG_GLOAD
#undef MG_SSTORE
        bf16* mp = merged + (size_t)(tok0 + 32 * wt + r32) * 1024 + d0 + 64 * wd + 4 * hi;
#pragma unroll
        for (int dt = 0; dt < 2; ++dt)
#pragma unroll
            for (int g = 0; g < 4; ++g)
                *(uint2*)(mp + 32 * dt + 8 * g) = make_uint2(cvtpk(mer[dt][4 * g], mer[dt][4 * g + 1]), cvtpk(mer[dt][4 * g + 2], mer[dt][4 * g + 3]));
    }
}
#define LAS __attribute__((address_space(3)))
#define XB_TMO      128
#define XB_XCNT(j)  (256  + 64 * (j))
#define XB_XSUB(j)  (1280 + 64 * (j))
#define XB_XGEN(j)  (2304 + 64 * (j))
#define XB_TOP      3328
#define XB_TOPGEN   3392
#define XCD_BAR_WORDS 3456
#define XB_SPIN_CAP (1u << 18)

__device__ __forceinline__ unsigned xb_ld(unsigned* p)              { return __hip_atomic_load(p, __ATOMIC_RELAXED, __HIP_MEMORY_SCOPE_AGENT); }
__device__ __forceinline__ unsigned xb_add(unsigned* p, unsigned v) { return __hip_atomic_fetch_add(p, v, __ATOMIC_RELAXED, __HIP_MEMORY_SCOPE_AGENT); }
__device__ __forceinline__ unsigned xb_xcc_id() { return (unsigned)__builtin_amdgcn_s_getreg((3 << 11) | 20) & 0xFu; }
#define XB_SPIN(cond, bar) do { unsigned _sp = 0; while (cond) { __builtin_amdgcn_s_sleep(1); \
    if ((++_sp & 255u) == 0u) { if (xb_ld(&(bar)[XB_TMO])) break; if (_sp > XB_SPIN_CAP) { atomicAdd(&(bar)[XB_TMO], 1u); break; } } } } while (0)

struct XcdBarrier {
    unsigned* bar; unsigned x;
    volatile LAS unsigned* st;
};

__device__ __forceinline__ XcdBarrier xcd_barrier_post(unsigned* bar, volatile LAS unsigned* st) {
    XcdBarrier b; b.bar = bar; b.x = xb_xcc_id(); b.st = st;
    if (threadIdx.x == 0) (void)xb_add(&bar[XB_XCNT(b.x)], 1u);
    return b;
}
__device__ __forceinline__ void xcd_barrier_complete(unsigned* bar, unsigned x, unsigned& nloc, unsigned& nx) {
    const unsigned G = gridDim.x * gridDim.y * gridDim.z;
    unsigned sum, cnt, mine, sp = 0u;
    for (;;) {
        sum = 0u; cnt = 0u; mine = 0u;
#pragma unroll
        for (unsigned j = 0; j < 16; ++j) { const unsigned c = xb_ld(&bar[XB_XCNT(j)]); sum += c; cnt += (c > 0u) ? 1u : 0u; mine = (j == x) ? c : mine; }
        if (sum == G) break;
        __builtin_amdgcn_s_sleep(1);
        if ((++sp & 255u) == 0u) { if (xb_ld(&bar[XB_TMO])) break; if (sp > XB_SPIN_CAP) { atomicAdd(&bar[XB_TMO], 1u); break; } }
    }
    nloc = mine > 0u ? mine : 1u; nx = cnt > 0u ? cnt : 1u;
}

__device__ __forceinline__ void xcd_barrier(const XcdBarrier& b, int wv_) {
    asm volatile("s_waitcnt vmcnt(0)" ::: "memory");
    __syncthreads();
    if (wv_ == 0 && LANEID() == 0) {
        unsigned* bar = b.bar;
        __builtin_amdgcn_s_waitcnt(0);
        unsigned nloc = b.st[0], nx = b.st[1];
        if (nloc == 0u) { xcd_barrier_complete(bar, b.x, nloc, nx); b.st[0] = nloc; b.st[1] = nx; }
        const unsigned old = xb_add(&bar[XB_XSUB(b.x)], 1u);
        const unsigned gen = old / nloc;
        if (old + 1u == (gen + 1u) * nloc) {
            __builtin_amdgcn_fence(__ATOMIC_RELEASE, "agent");
            asm volatile("s_waitcnt vmcnt(0)" ::: "memory");
            const unsigned og = xb_add(&bar[XB_TOP], 1u);
            const unsigned tg = og / nx;
            if (og + 1u == (tg + 1u) * nx) xb_add(&bar[XB_TOPGEN], 1u);
            else XB_SPIN(xb_ld(&bar[XB_TOPGEN]) == tg, bar);
            __builtin_amdgcn_fence(__ATOMIC_ACQUIRE, "agent");
            xb_add(&bar[XB_XGEN(b.x)], 1u);
            asm volatile("s_waitcnt vmcnt(0)" ::: "memory");
        } else {
            XB_SPIN(xb_ld(&bar[XB_XGEN(b.x)]) == gen, bar);
            __builtin_amdgcn_fence(__ATOMIC_ACQUIRE, "agent");
            asm volatile("s_waitcnt vmcnt(0)" ::: "memory");
        }
    }
    __syncthreads();
}

enum { PH_PRO = 0, PH_GIN, PH_INDEX, PH_ATTN, PH_MERGE, PH_GOUT, PH_LN1, PH_GQ, PH_ROUTE, PH_PEER };
template <int PH> __device__ __forceinline__ void run_phase(int WV_, const Params& p_unused, int l, unsigned char* lds_raw) {
    size_t kaoff_ = 0; asm volatile("" : "+s"(kaoff_));
    typedef const __attribute__((address_space(4))) char* kaptr_t;
    const __attribute__((address_space(4))) Params& p = *(const __attribute__((address_space(4))) Params*)((kaptr_t)__builtin_amdgcn_kernarg_segment_ptr() + kaoff_);
    float* sm = (float*)lds_raw;
    size_t wsoff_ = 0; asm volatile("" : "+s"(wsoff_));
    unsigned char* ws = p.ws + wsoff_;
    float* hbuf = p.out;
    bf16* hb = (bf16*)(ws + WS_HB);
    bf16* P = (bf16*)(ws + WS_P);
    bf16* ys = (bf16*)(ws + WS_YS);
    bf16* mrg = (bf16*)(ws + WS_MRG);
    float* mix = (float*)(ws + WS_MIX);
    float* qb = (float*)(ws + WS_Q);
    unsigned char* mask = ws + WS_MASK;
    int* eid = (int*)(ws + WS_EID);
    float* gate = (float*)(ws + WS_GATE);
    float* kmean = (float*)(ws + WS_KMEAN);
    const float* hin = (l == 0) ? p.in[0] : hbuf;
    if (PH == PH_PRO) { Params pc; for (int i = 0; i < 13; ++i) pc.in[i] = p.in[i]; pc.out = p.out; pc.ws = ws;
        prologue_phase(WV_, pc, sm); convert_tables(WV_, pc);
        for (int i = LBID() * NTHR + LTID(WV_); i < DEPTH_ * 8 * 2 * 128 * 64 / 4; i += LGRID() * NTHR) { const float4 v = ((const float4*)p.in[8])[i]; ((uint2*)(ws + WS_SKB))[i] = make_uint2(pk2(v.x, v.y), pk2(v.z, v.w)); } if (LBID() < 2) build_unit_table((unsigned*)(ws + WS_CTL) + 1024, LBID() * NTHR + LTID(WV_)); }
    else if (PH == PH_GIN) {
        pg8::Gemm g{hb, (const bf16*)(ws + WS_WIN_T + l * WIN_T_BYTES), T_, NP, 1024};
        pg8::StaticOrder S; S.init(T_, NP, (int)LGRID(), (int)LBID());
        pg8::EpiBf16<0> E{P, NP, nullptr, 0, 0, 1.f};
        pg8::gemm_phase<pg8::EpiBf16<0>, pg8::StaticOrder, true, true>(WV_, (PG8_LAS unsigned char*)lds_raw, g, S, E);
    }
    else if (PH == PH_INDEX) index_fast_phase(WV_, P, mask, kmean, (float*)(ws + WS_YS), lds_raw);
    else if (PH == PH_ATTN) attn_fast_phase(WV_, P, mask, kmean, p.in[4] + l * 4, ys, (const unsigned*)(ws + WS_CTL) + 1024, (unsigned*)(ws + WS_CTL) + 64 * l, lds_raw);
    else if (PH == PH_MERGE) merge_fast_phase(WV_, P, ys, (const bf16*)(ws + WS_WBR_T) + (size_t)l * 4 * 1024 * 256, mrg, lds_raw);
    else if (PH == PH_GOUT) {
        pg8::Gemm g{mrg, (const bf16*)(ws + WS_WOUT_T) + (size_t)l * 1024 * 1024, T_, 1024, 1024};
        pg8::StaticOrder S; S.init(T_, 1024, (int)LGRID(), (int)LBID());
        pg8::EpiResY E{hin, hbuf, hb, (float*)(ws + WS_STATS) + (size_t)l * T_ * 2, ALPHA};
        pg8::gemm_phase<pg8::EpiResY, pg8::StaticOrder, true, true>(WV_, (PG8_LAS unsigned char*)lds_raw, g, S, E);
    }
    else if (PH == PH_GQ) {
        pg8::Gemm g{hb, (const bf16*)(ws + WS_WQ_T) + (size_t)l * 1024 * 1024, T_, 1024, 1024};
        pg8::StaticOrder S; S.init(T_, 1024, (int)LGRID(), (int)LBID());
        pg8::EpiLnFold E{(bf16*)qb, (const float*)(ws + WS_STATS) + (size_t)l * T_ * 2, (const float*)(ws + WS_COLS) + l * 2048, (const float*)(ws + WS_COLS) + l * 2048 + 1024, LN_EPS};
        pg8::gemm_phase<pg8::EpiLnFold, pg8::StaticOrder, true, true>(WV_, (PG8_LAS unsigned char*)lds_raw, g, S, E);
        pg8::Unit u0;
        if (LGRID() == 256 && S.next(0, u0)) {
            asm volatile("s_waitcnt vmcnt(0)" ::: "memory"); __syncthreads();
            route_fast_phase(WV_, (const bf16*)qb, (const bf16*)(ws + WS_SKB) + (size_t)l * 8 * 2 * 128 * 64, eid, gate, lds_raw, u0.pm, u0.pn);
        }
    }
    else if (PH == PH_ROUTE) { if (LGRID() != 256) route_fast_phase(WV_, (const bf16*)qb, (const bf16*)(ws + WS_SKB) + (size_t)l * 8 * 2 * 128 * 64, eid, gate, lds_raw); }
    else peer_fast_phase(WV_, hbuf, hb, eid, gate, ws + WS_UV + (size_t)l * 24 * MiB, p.in[5] + l * 1024, p.in[6] + l * 1024, p.in[11] + l * 1024, p.in[12] + l * 1024, lds_raw);
}

constexpr int CW_BAR = 4096;
constexpr int LDS_BARST = LDS_BYTES - 16;
__global__ void __launch_bounds__(NTHR, 2) mk_fwd(Params p) {
    extern __shared__ __attribute__((aligned(16))) unsigned char lds_raw[];
    cg::grid_group grid = cg::this_grid();
    const int WV_ = __builtin_amdgcn_readfirstlane((int)threadIdx.x >> 6);
    { volatile LAS unsigned* bst0 = (volatile LAS unsigned*)((LAS unsigned char*)lds_raw + LDS_BARST); if (threadIdx.x < 4) bst0[threadIdx.x] = 0u; }
    __syncthreads();
    volatile LAS unsigned* bst = (volatile LAS unsigned*)((LAS unsigned char*)lds_raw + LDS_BARST);
    (void)xcd_barrier_post((unsigned*)(p.ws + WS_CTL) + CW_BAR, bst);
#define GRID_BAR() do { XcdBarrier b_; b_.bar = (unsigned*)(p.ws + WS_CTL) + CW_BAR; b_.x = xb_xcc_id(); b_.st = (volatile LAS unsigned*)((LAS unsigned char*)lds_raw + LDS_BARST); xcd_barrier(b_, WV_); } while (0)
    run_phase<PH_PRO>(WV_, p, 0, lds_raw);
    grid.sync();
#pragma unroll 1
    for (int l = 0; l < DEPTH_; ++l) {
        run_phase<PH_GIN>(WV_, p, l, lds_raw); GRID_BAR();
        run_phase<PH_INDEX>(WV_, p, l, lds_raw); GRID_BAR();
        run_phase<PH_ATTN>(WV_, p, l, lds_raw); GRID_BAR();
        run_phase<PH_MERGE>(WV_, p, l, lds_raw); GRID_BAR();
        run_phase<PH_GOUT>(WV_, p, l, lds_raw); GRID_BAR();
        run_phase<PH_GQ>(WV_, p, l, lds_raw); if (LGRID() != 256) { GRID_BAR(); run_phase<PH_ROUTE>(WV_, p, l, lds_raw); } GRID_BAR();
        run_phase<PH_PEER>(WV_, p, l, lds_raw); if (l + 1 < DEPTH_) GRID_BAR();
    }
}

extern "C" void kernel_launch(void* const* d_in, const int* in_sizes, int n_in, void* d_out, int out_size, void* d_ws, size_t ws_size, hipStream_t stream) {
    if (n_in != 13 || ws_size < WS_END) { fprintf(stderr, "kernel_launch: unexpected n_in %d / ws_size %zu; nothing launched\n", n_in, ws_size); return; }
    static int grid_blocks = 0;
    if (grid_blocks == 0) {
        int dev = 0, cus = 0, per_cu = 0;
        (void)hipGetDevice(&dev);
        (void)hipDeviceGetAttribute(&cus, hipDeviceAttributeMultiprocessorCount, dev);
        (void)hipFuncSetAttribute((const void*)mk_fwd, hipFuncAttributeMaxDynamicSharedMemorySize, LDS_BYTES);
        (void)hipOccupancyMaxActiveBlocksPerMultiprocessor(&per_cu, (const void*)mk_fwd, NTHR, LDS_BYTES);
        if (per_cu < 1) fprintf(stderr, "kernel_launch: occupancy query reports %d\n", per_cu);
        grid_blocks = cus;
    }
    Params p{};
    for (int i = 0; i < 13; ++i) p.in[i] = (const float*)d_in[i];
    p.out = (float*)d_out; p.ws = (unsigned char*)d_ws;
    (void)hipMemsetAsync(d_ws, 0, 2 * MiB, stream);
    void* args[] = {&p};
    hipError_t e = hipLaunchCooperativeKernel((const void*)mk_fwd, dim3(grid_blocks), dim3(NTHR), args, LDS_BYTES, stream);
    if (e != hipSuccess) fprintf(stderr, "cooperative launch failed: %s (grid %d)\n", hipGetErrorString(e), grid_blocks);
}
```

```cpp
#include <hip/hip_runtime.h>
#include <cstdio>
#include <cstdint>
#include <hip/hip_cooperative_groups.h>
namespace cg = cooperative_groups;

__device__ __forceinline__ int LANEID() { int l; asm volatile("v_mbcnt_lo_u32_b32 %0, -1, 0\n\tv_mbcnt_hi_u32_b32 %0, -1, %0" : "=v"(l)); return l; }
__device__ __forceinline__ int LTID(int wv) { return (wv << 6) | LANEID(); }
__device__ __forceinline__ int LBID() { int t = blockIdx.x; asm volatile("" : "+s"(t)); return t; }
__device__ __forceinline__ int LGRID() { int t = gridDim.x; asm volatile("" : "+s"(t)); return t; }
namespace pg8 {
#define PG8_LAS __attribute__((address_space(3)))
typedef unsigned short bf16_t;
typedef short bf16x8 __attribute__((ext_vector_type(8)));
typedef float f32x4 __attribute__((ext_vector_type(4)));
typedef unsigned u32x4 __attribute__((ext_vector_type(4)));
constexpr int BM = 256, BK = 64, HALF = 128, HTB = HALF * BK * 2  , STAGE_BYTES = 8 * HTB, NXCD = 8, WGM = 8;

__host__ __device__ __forceinline__ int lds_byte(int r, int c) { const int st = (r >> 4) * 2 + (c >> 5), rr = r & 15, cc = c & 31, ob = rr * 64 + cc * 2; return st * 1024 + (ob ^ (((ob >> 9) & 1) << 5)); }
__host__ __device__ __forceinline__ void stage_rc(int b, int& R, int& C) { const int st = b / 1024, sb = b % 1024, swz = sb ^ (((sb >> 9) & 1) << 5); R = (st >> 1) * 16 + swz / 64; C = (st & 1) * 32 + (swz % 64) / 2; }
__host__ __device__ __forceinline__ int perm32(int rho) { const int n = rho >> 4, i = rho & 15; return 8 * (i >> 2) + 4 * n + (i & 3); }

struct Unit { int pm, pn; };
struct Gemm { const bf16_t* A; const bf16_t* Bt; int M, N, K; };

struct StaticOrder {
    int nM, nN, nwg, G, c;
    __host__ __device__ void init(int M, int N, int G_, int c_) { nM = M / BM; nN = N / BM; nwg = nM * nN; G = G_; c = c_; }
    __host__ __device__ bool next(int i, Unit& u) const {
        const long L = (long)i * G + c; if (L >= nwg) return false;
        int wgid = (int)L; { const int q = nwg / NXCD, r = nwg % NXCD, xcd = wgid % NXCD, off = wgid / NXCD; wgid = (xcd < r ? xcd * (q + 1) : r * (q + 1) + (xcd - r) * q) + off; }
        const int nig = WGM * nN, gid = wgid / nig, fm = gid * WGM, gsz = (nM - fm) < WGM ? (nM - fm) : WGM;
        u.pm = fm + ((wgid % nig) % gsz); u.pn = (wgid % nig) / gsz; return true;
    }
    __device__ __forceinline__ void a_ready(const Unit&) const {}
    __device__ __forceinline__ void done(const Unit&) const {}
};

__device__ __forceinline__ unsigned cvt_pk_bf16(float lo, float hi) { unsigned r; asm volatile("v_cvt_pk_bf16_f32 %0, %1, %2" : "=v"(r) : "v"(lo), "v"(hi)); return r; }
typedef float f32x2 __attribute__((ext_vector_type(2)));
__device__ __forceinline__ f32x2 gelu_pk(f32x2 v) {
    const f32x2 av = __builtin_elementwise_abs(v), d = av * 0.2316418882f + 1.0f;
    f32x2 t; t.x = __builtin_amdgcn_rcpf(d.x); t.y = __builtin_amdgcn_rcpf(d.y);
    f32x2 q = t * 0.5307027145f + (-0.7265760135f); q = q * t + 0.7107068705f; q = q * t + (-0.142248368f); q = q * t + 0.127414796f; q = q * t;
    const f32x2 s = (v * v) * (-0.72134752044f);
    f32x2 e; e.x = __builtin_amdgcn_exp2f(s.x); e.y = __builtin_amdgcn_exp2f(s.y);
    const f32x2 m = v * (q * e), r = v - m;
    f32x2 o; o.x = v.x < 0.f ? m.x : r.x; o.y = v.y < 0.f ? m.y : r.y; return o;
}

template <int ACT  > struct EpiBf16 {
    static constexpr bool PERM = true, AFTER_DRAIN = false; static_assert(ACT == 0 || ACT == 1, "EpiBf16: ACT is 0 (none) or 1 (gelu_pk)");
    bf16_t* O; int ldc; const float* bias; int split_cols; size_t split_stride; float scale0;
    __device__ __forceinline__ void operator()(const f32x4 (&acc)[2][2][4][2], const Unit& u, int wr, int wc, int fr, int fq) const {
        { int ln_ = LANEID(); asm volatile("" : "+v"(ln_)); fr = ln_ & 15; fq = ln_ >> 4; }
        const int row0 = u.pm * BM + wr * 64 + fr; int colt = u.pn * BM; bf16_t* base = O;
        float sc = 1.f; if (split_cols) { const int t = colt / split_cols; base += (size_t)t * split_stride; colt -= t * split_cols; if (t == 0) sc = scale0; }
        const int col0 = colt + wc * 32 + 8 * fq, bcol0 = u.pn * BM + wc * 32 + 8 * fq;
        f32x4 bv[2][2];
#pragma unroll
        for (int bj = 0; bj < 2; ++bj)
#pragma unroll
            for (int n = 0; n < 2; ++n) bv[bj][n] = bias ? *(const f32x4*)(bias + bcol0 + bj * HALF + 4 * n) : (f32x4){0.f, 0.f, 0.f, 0.f};
#pragma unroll
        for (int ai = 0; ai < 2; ++ai)
#pragma unroll
            for (int m = 0; m < 4; ++m) { bf16_t* rowp = base + (size_t)(row0 + ai * HALF + m * 16) * ldc + col0;
#pragma unroll
                for (int bj = 0; bj < 2; ++bj) { f32x4 v0 = acc[ai][bj][m][0] + bv[bj][0], v1 = acc[ai][bj][m][1] + bv[bj][1];
                    if (ACT == 1) { f32x2 a = gelu_pk((f32x2){v0[0], v0[1]}), b = gelu_pk((f32x2){v0[2], v0[3]}), c = gelu_pk((f32x2){v1[0], v1[1]}), d = gelu_pk((f32x2){v1[2], v1[3]});
                        v0 = (f32x4){a.x, a.y, b.x, b.y}; v1 = (f32x4){c.x, c.y, d.x, d.y}; }
                    v0 = v0 * sc; v1 = v1 * sc; u32x4 w; w.x = cvt_pk_bf16(v0[0], v0[1]); w.y = cvt_pk_bf16(v0[2], v0[3]); w.z = cvt_pk_bf16(v1[0], v1[1]); w.w = cvt_pk_bf16(v1[2], v1[3]);
                    *(u32x4*)(rowp + bj * HALF) = w; } }
    }
};
template <class Epi, class Sched, bool ALIGN_EPI = false, bool SP2 = false>
__device__ __forceinline__ void gemm_phase(int WV_, PG8_LAS unsigned char* lds, const Gemm g, const Sched& S, const Epi& E) {
    const int tid = LTID(WV_), wid = __builtin_amdgcn_readfirstlane(tid >> 6), lane = tid & 63, wr = wid >> 2, wc = wid & 3, fr = lane & 15, fq = lane >> 4;
    const int K = g.K, nt = K / BK;
    unsigned voffA[2], voffB[2];
#pragma unroll
    for (int i = 0; i < 2; ++i) { int R, C; stage_rc(tid * 16 + i * 8192, R, C); const int Rb = Epi::PERM ? ((R & ~31) + perm32(R & 31)) : R;
        voffA[i] = (unsigned)(R * K + C) * 2u; voffB[i] = (unsigned)(Rb * K + C) * 2u; }
    const size_t kstep = (size_t)(BK * 2);
    const size_t hstep = (size_t)HALF * K * 2;
    const size_t tstep = 2 * hstep;
    const unsigned ldsw = (unsigned)wid * 1024u;
    const int aoff = lds_byte(wr * 64 + fr, fq * 8), boff = lds_byte(wc * 32 + fr, fq * 8);
#define PG8_SA(b, h) (((b) * 2 + (h)) * HTB)
#define PG8_SB(b, h) ((4 + (b) * 2 + (h)) * HTB)
#define PG8_STAGE(bufoff, gbase, voff) do { _Pragma("unroll") for (int _i = 0; _i < 2; ++_i) \
        __builtin_amdgcn_global_load_lds((const unsigned*)((const char*)(gbase) + (voff)[_i]), (PG8_LAS unsigned*)(lds + (bufoff) + ldsw + _i * 8192), 16, 0, 0); } while (0)
#define PG8_LDA(dst, b, h) do { _Pragma("unroll") for (int m = 0; m < 4; ++m) _Pragma("unroll") for (int k = 0; k < 2; ++k) dst[m][k] = *(const PG8_LAS bf16x8*)(lds + PG8_SA(b, h) + aoff + m * 2048 + k * 1024); } while (0)
#define PG8_LDB(dst, b, h) do { _Pragma("unroll") for (int n = 0; n < 2; ++n) _Pragma("unroll") for (int k = 0; k < 2; ++k) dst[n][k] = *(const PG8_LAS bf16x8*)(lds + PG8_SB(b, h) + boff + n * 2048 + k * 1024); } while (0)
#define PG8_MMA(ai, bj, At, Bt) do { __builtin_amdgcn_s_setprio(1); _Pragma("unroll") for (int m = 0; m < 4; ++m) _Pragma("unroll") for (int n = 0; n < 2; ++n) _Pragma("unroll") for (int k = 0; k < 2; ++k) \
        acc[ai][bj][m][n] = __builtin_amdgcn_mfma_f32_16x16x32_bf16(Bt[n][k], At[m][k], acc[ai][bj][m][n], 0, 0, 0); __builtin_amdgcn_s_setprio(0); } while (0)
#define PG8_WAIT_V(n) asm volatile("s_waitcnt vmcnt(" #n ")" ::: "memory")
#define PG8_WAIT_L(n) asm volatile("s_waitcnt lgkmcnt(" #n ")" ::: "memory")
#define PG8_BAR __builtin_amdgcn_s_barrier()
#define PG8_SCHED __builtin_amdgcn_sched_barrier(0)
    Unit cur, nxt; int ui = 0;
    if (!S.next(0, cur)) return;
    f32x4 acc[2][2][4][2];
#pragma unroll
    for (int a = 0; a < 2; ++a)
#pragma unroll
        for (int b = 0; b < 2; ++b)
#pragma unroll
            for (int m = 0; m < 4; ++m)
#pragma unroll
                for (int n = 0; n < 2; ++n) acc[a][b][m][n] = (f32x4){0.f, 0.f, 0.f, 0.f};
    bf16x8 At[4][2], B0[2][2], B1[2][2];
    const char* cA = (const char*)g.A + (size_t)cur.pm * tstep; const char* cB = (const char*)g.Bt + (size_t)cur.pn * tstep;
    S.a_ready(cur);
    if constexpr (SP2) {
        PG8_STAGE(PG8_SB(0, 0), cB, voffB); PG8_STAGE(PG8_SB(0, 1), cB + hstep, voffB); PG8_STAGE(PG8_SA(0, 0), cA, voffA); PG8_STAGE(PG8_SA(0, 1), cA + hstep, voffA);
        if (wr == 1) PG8_BAR;
        PG8_WAIT_V(2); PG8_BAR;
        PG8_STAGE(PG8_SB(1, 0), cB + kstep, voffB); PG8_STAGE(PG8_SA(1, 0), cA + kstep, voffA); PG8_STAGE(PG8_SB(1, 1), cB + hstep + kstep, voffB);
        PG8_WAIT_V(6); PG8_BAR;
    } else {
        PG8_STAGE(PG8_SB(0, 0), cB, voffB); PG8_STAGE(PG8_SA(0, 0), cA, voffA); PG8_STAGE(PG8_SB(0, 1), cB + hstep, voffB); PG8_STAGE(PG8_SA(0, 1), cA + hstep, voffA);
        if (wr == 1) PG8_BAR;
        PG8_WAIT_V(4); PG8_BAR;
        PG8_STAGE(PG8_SB(1, 0), cB + kstep, voffB); PG8_STAGE(PG8_SA(1, 0), cA + kstep, voffA); PG8_STAGE(PG8_SB(1, 1), cB + hstep + kstep, voffB);
        PG8_WAIT_V(6); PG8_BAR;
    }
    for (;;) {
        const bool has_next = S.next(ui + 1, nxt);
        const char* nA = has_next ? (const char*)g.A + (size_t)nxt.pm * tstep : cA; const char* nB = has_next ? (const char*)g.Bt + (size_t)nxt.pn * tstep : cB;
        for (int t = 0; t < nt; t += 2) {
            const bool last = (t == nt - 2);
            const char* a1 = cA + (size_t)(t + 1) * kstep;
            const char* a2 = last ? nA : cA + (size_t)(t + 2) * kstep; const char* b2 = last ? nB : cB + (size_t)(t + 2) * kstep;
            const char* a3 = a2 + kstep; const char* b3 = b2 + kstep;
            if (last && has_next) S.a_ready(nxt);
            if constexpr (SP2) {
            PG8_LDB(B0, 0, 0); PG8_LDB(B1, 0, 1); PG8_SCHED; PG8_LDA(At, 0, 0); PG8_STAGE(PG8_SA(1, 1), a1 + hstep, voffA);
            PG8_WAIT_V(8); PG8_WAIT_L(0); PG8_BAR; PG8_MMA(0, 0, At, B0); PG8_MMA(0, 1, At, B1); PG8_BAR; PG8_SCHED;
            PG8_LDA(At, 0, 1); PG8_STAGE(PG8_SB(0, 0), b2, voffB); PG8_STAGE(PG8_SB(0, 1), b2 + hstep, voffB); PG8_STAGE(PG8_SA(0, 0), a2, voffA);
            PG8_WAIT_V(8); PG8_WAIT_L(0); PG8_BAR; PG8_MMA(1, 0, At, B0); PG8_MMA(1, 1, At, B1); PG8_BAR; PG8_SCHED;
            PG8_LDB(B0, 1, 0); PG8_LDB(B1, 1, 1); PG8_SCHED; PG8_LDA(At, 1, 0); PG8_STAGE(PG8_SA(0, 1), a2 + hstep, voffA);
            PG8_WAIT_V(8); PG8_WAIT_L(0); PG8_BAR; PG8_MMA(0, 0, At, B0); PG8_MMA(0, 1, At, B1); PG8_BAR; PG8_SCHED;
            PG8_LDA(At, 1, 1); PG8_STAGE(PG8_SB(1, 0), b3, voffB); PG8_STAGE(PG8_SB(1, 1), b3 + hstep, voffB); PG8_STAGE(PG8_SA(1, 0), a3, voffA);
            PG8_WAIT_V(8); PG8_WAIT_L(0); PG8_BAR; PG8_MMA(1, 0, At, B0); PG8_MMA(1, 1, At, B1); PG8_BAR; PG8_SCHED;
            } else {
            PG8_LDB(B0, 0, 0); PG8_SCHED; PG8_LDA(At, 0, 0); PG8_STAGE(PG8_SA(1, 1), a1 + hstep, voffA);
            PG8_WAIT_L(8); PG8_BAR; PG8_WAIT_L(0); PG8_MMA(0, 0, At, B0); PG8_BAR; PG8_SCHED;
            PG8_LDB(B1, 0, 1); PG8_STAGE(PG8_SB(0, 0), b2, voffB);
            PG8_BAR; PG8_WAIT_L(0); PG8_MMA(0, 1, At, B1); PG8_BAR;
            PG8_LDA(At, 0, 1); PG8_STAGE(PG8_SA(0, 0), a2, voffA);
            PG8_BAR; PG8_WAIT_L(0); PG8_MMA(1, 0, At, B0); PG8_BAR; PG8_SCHED;
            PG8_STAGE(PG8_SB(0, 1), b2 + hstep, voffB);
            PG8_WAIT_V(6); PG8_BAR; PG8_MMA(1, 1, At, B1); PG8_BAR;
            PG8_LDB(B0, 1, 0); PG8_SCHED; PG8_LDA(At, 1, 0); PG8_STAGE(PG8_SA(0, 1), a2 + hstep, voffA);
            PG8_WAIT_L(8); PG8_BAR; PG8_WAIT_L(0); PG8_MMA(0, 0, At, B0); PG8_BAR; PG8_SCHED;
            PG8_LDB(B1, 1, 1); PG8_STAGE(PG8_SB(1, 0), b3, voffB);
            PG8_BAR; PG8_WAIT_L(0); PG8_MMA(0, 1, At, B1); PG8_BAR;
            PG8_LDA(At, 1, 1); PG8_STAGE(PG8_SA(1, 0), a3, voffA);
            PG8_BAR; PG8_WAIT_L(0); PG8_MMA(1, 0, At, B0); PG8_BAR; PG8_SCHED;
            PG8_STAGE(PG8_SB(1, 1), b3 + hstep, voffB);
            PG8_WAIT_V(6); PG8_BAR; PG8_MMA(1, 1, At, B1); PG8_BAR;
            }
        }
        if constexpr (ALIGN_EPI) { if (wr == 0) PG8_BAR; }
        if constexpr (!Epi::AFTER_DRAIN) { E(acc, cur, wr, wc, fr, fq); S.done(cur); }
        if (!has_next) break;
#pragma unroll
        for (int a = 0; a < 2; ++a)
#pragma unroll
            for (int b = 0; b < 2; ++b)
#pragma unroll
                for (int m = 0; m < 4; ++m)
#pragma unroll
                    for (int n = 0; n < 2; ++n) acc[a][b][m][n] = (f32x4){0.f, 0.f, 0.f, 0.f};
        cur = nxt; cA = nA; cB = nB; ++ui;
        if constexpr (ALIGN_EPI) { if (wr == 1) PG8_BAR; }
    }
    PG8_WAIT_V(0);
    if constexpr (!ALIGN_EPI) { if (wr == 0) PG8_BAR; }
    PG8_BAR;
    if constexpr (Epi::AFTER_DRAIN) { E.fused(acc, cur, wr, wc, fr, fq, lds, wid, lane); S.done(cur); }
#undef PG8_SA
#undef PG8_SB
#undef PG8_STAGE
#undef PG8_LDA
#undef PG8_LDB
#undef PG8_MMA
#undef PG8_WAIT_V
#undef PG8_WAIT_L
#undef PG8_BAR
#undef PG8_SCHED
}
}
namespace pg8 {
struct EpiF32 {
    static constexpr bool PERM = false, AFTER_DRAIN = false;
    float* O; int ldc;
    __device__ __forceinline__ void operator()(const f32x4 (&acc)[2][2][4][2], const Unit& u, int wr, int wc, int fr, int fq) const {
        { int ln_ = LANEID(); asm volatile("" : "+v"(ln_)); fr = ln_ & 15; fq = ln_ >> 4; }
        const int row0 = u.pm * BM + wr * 64 + fr, col0 = u.pn * BM + wc * 32 + 4 * fq;
#pragma unroll
        for (int ai = 0; ai < 2; ++ai)
#pragma unroll
            for (int m = 0; m < 4; ++m) { float* rowp = O + (size_t)(row0 + ai * HALF + m * 16) * ldc + col0;
#pragma unroll
                for (int bj = 0; bj < 2; ++bj)
#pragma unroll
                    for (int n = 0; n < 2; ++n) *(f32x4*)(rowp + bj * HALF + n * 16) = acc[ai][bj][m][n]; }
    }
};
struct EpiResY {
    static constexpr bool PERM = false, AFTER_DRAIN = false;
    const float* hin; float* yout; bf16_t* yb; float* stats; float alpha;
    __device__ __forceinline__ void operator()(const f32x4 (&acc)[2][2][4][2], const Unit& u, int wr, int wc, int fr, int fq) const {
        { int ln_ = LANEID(); asm volatile("" : "+v"(ln_)); fr = ln_ & 15; fq = ln_ >> 4; }
        const int row0 = u.pm * BM + wr * 64 + fr, col0 = u.pn * BM + wc * 32 + 4 * fq;
#pragma unroll
        for (int ai = 0; ai < 2; ++ai)
#pragma unroll
            for (int m = 0; m < 4; ++m) {
                const int row = row0 + ai * HALF + m * 16;
                float s = 0.f, s2 = 0.f;
#pragma unroll
                for (int bj = 0; bj < 2; ++bj)
#pragma unroll
                    for (int n = 0; n < 2; ++n) {
                        const size_t off = (size_t)row * 1024 + col0 + bj * HALF + n * 16;
                        const f32x4 hv = *(const f32x4*)(hin + off);
                        const f32x4 y = hv * alpha + acc[ai][bj][m][n];
                        *(f32x4*)(yout + off) = y;
                        typedef unsigned u32x2v __attribute__((ext_vector_type(2)));
                        u32x2v w; w.x = cvt_pk_bf16(y[0], y[1]); w.y = cvt_pk_bf16(y[2], y[3]);
                        *(u32x2v*)(yb + off) = w;
                        s += (y[0] + y[1]) + (y[2] + y[3]); s2 += (y[0] * y[0] + y[1] * y[1]) + (y[2] * y[2] + y[3] * y[3]);
                    }
                s += __shfl_xor(s, 16); s += __shfl_xor(s, 32); s2 += __shfl_xor(s2, 16); s2 += __shfl_xor(s2, 32);
                if (fq == 0) { atomicAdd(stats + 2 * (size_t)row, s); atomicAdd(stats + 2 * (size_t)row + 1, s2); }
            }
    }
};
struct EpiLnFold {
    static constexpr bool PERM = true, AFTER_DRAIN = false;
    bf16_t* O; const float* stats; const float* colsum; const float* colbias; float eps;
    __device__ __forceinline__ void operator()(const f32x4 (&acc)[2][2][4][2], const Unit& u, int wr, int wc, int fr, int fq) const {
        { int ln_ = LANEID(); asm volatile("" : "+v"(ln_)); fr = ln_ & 15; fq = ln_ >> 4; }
        const int row0 = u.pm * BM + wr * 64 + fr, col0 = u.pn * BM + wc * 32 + 8 * fq;
        f32x4 cs[2][2], cb[2][2];
#pragma unroll
        for (int bj = 0; bj < 2; ++bj)
#pragma unroll
            for (int n = 0; n < 2; ++n) { cs[bj][n] = *(const f32x4*)(colsum + col0 + bj * HALF + 4 * n); cb[bj][n] = *(const f32x4*)(colbias + col0 + bj * HALF + 4 * n); }
#pragma unroll
        for (int ai = 0; ai < 2; ++ai)
#pragma unroll
            for (int m = 0; m < 4; ++m) {
                const int row = row0 + ai * HALF + m * 16;
                const float sm_ = stats[2 * (size_t)row], sq_ = stats[2 * (size_t)row + 1];
                const float mean = sm_ * (1.0f / 1024.0f);
                const float rstd = 1.0f / sqrtf(fmaxf(sq_ * (1.0f / 1024.0f) - mean * mean, 0.f) + eps);
                bf16_t* rowp = O + (size_t)row * 1024 + col0;
#pragma unroll
                for (int bj = 0; bj < 2; ++bj) {
                    const f32x4 v0 = (acc[ai][bj][m][0] - cs[bj][0] * mean) * rstd + cb[bj][0], v1 = (acc[ai][bj][m][1] - cs[bj][1] * mean) * rstd + cb[bj][1];
                    u32x4 w; w.x = cvt_pk_bf16(v0[0], v0[1]); w.y = cvt_pk_bf16(v0[2], v0[3]); w.z = cvt_pk_bf16(v1[0], v1[1]); w.w = cvt_pk_bf16(v1[2], v1[3]);
                    *(u32x4*)(rowp + bj * HALF) = w;
                }
            }
    }
};
}

typedef unsigned short bf16;
constexpr int T_ = 16384, S_ = 4096, NBATCH = 4, D_ = 1024, NCOL = 6824, NP = 6912, DEPTH_ = 2;
constexpr int C_QA = 0, C_KA = 256, C_VA = 320, C_QI = 384, C_KI = 640, C_WI = 672, C_QB = 680, C_KB = 936, C_VB = 1064,
              C_QC = 1192, C_KC = 1448, C_VC = 1704, C_QD = 1960, C_KD = 2216, C_VD = 2472, C_G = 2728;
constexpr int NTHR = 512, NWAVE = 8;
constexpr float ALPHA = 1.41421356237309515f;
constexpr float LN_EPS = 1e-5f;
constexpr size_t MiB = 1u << 20;
constexpr size_t WS_STATS = 1 * MiB  , WS_COLS = 1 * MiB + 512 * 1024  ;
constexpr size_t WS_CTL = 0, WS_WIN_T = 2 * MiB, WS_WOUT_T = 30 * MiB, WS_WQ_T = 34 * MiB, WS_WBR_T = 38 * MiB, WS_HB = 42 * MiB,
                 WS_P = 74 * MiB, WS_MIX = 74 * MiB  , WS_Q = 138 * MiB  , WS_YS = 290 * MiB, WS_MRG = 322 * MiB,
                 WS_MASK = 354 * MiB, WS_EID = 362 * MiB, WS_GATE = 370 * MiB, WS_KMEAN = 378 * MiB, WS_SKB = 379 * MiB, WS_UV = 380 * MiB, WS_END = 508 * MiB;
constexpr size_t WIN_T_BYTES = (size_t)NP * 1024 * 2;
constexpr int LDS_BYTES = 144 * 1024;

struct Params { const float* in[13]; float* out; unsigned char* ws; };

__device__ __forceinline__ float bf2f(bf16 v) { return __uint_as_float((unsigned)v << 16); }
__device__ __forceinline__ unsigned f2bf(float f) { unsigned u = __float_as_uint(f); return (u + 0x7fffu + ((u >> 16) & 1u)) >> 16; }
__device__ __forceinline__ unsigned pk2(float lo, float hi) { return f2bf(lo) | (f2bf(hi) << 16); }
__device__ __forceinline__ void unpack8(const uint4 v, float* o) {
    o[0] = __uint_as_float(v.x << 16); o[1] = __uint_as_float(v.x & 0xffff0000u); o[2] = __uint_as_float(v.y << 16); o[3] = __uint_as_float(v.y & 0xffff0000u);
    o[4] = __uint_as_float(v.z << 16); o[5] = __uint_as_float(v.z & 0xffff0000u); o[6] = __uint_as_float(v.w << 16); o[7] = __uint_as_float(v.w & 0xffff0000u);
}
__device__ __forceinline__ float wave_sum(float v) {
#pragma unroll
    for (int o = 32; o > 0; o >>= 1) v += __shfl_xor(v, o);
    return v;
}
__device__ __forceinline__ float wave_max(float v) {
#pragma unroll
    for (int o = 32; o > 0; o >>= 1) v = fmaxf(v, __shfl_xor(v, o));
    return v;
}
__device__ __forceinline__ int wave_sum_i(int v) {
#pragma unroll
    for (int o = 32; o > 0; o >>= 1) v += __shfl_xor(v, o);
    return v;
}
__device__ __forceinline__ float logsig(float x) { return fminf(x, 0.f) - log1pf(expf(-fabsf(x))); }

__device__ void transpose_items(int WV_, const float* W, int K, int N, bf16* WT, float* sm, int item0, int nitems_total, int item_stride,
                                const float* rs_g = nullptr, const float* rs_b = nullptr, float* colsum = nullptr, float* colbias = nullptr) {
    const int tid = LTID(WV_);
    const int nkb = K / 64, nnb = (N + 63) / 64;
    for (int it = item0; it < nkb * nnb; it += item_stride) {
        const int kb = it % nkb, nb = it / nkb, k0 = kb * 64, n0 = nb * 64;
        __syncthreads();
        for (int e = tid; e < 64 * 64; e += NTHR) { const int kk = e >> 6, nn = e & 63; sm[kk * 65 + nn] = (n0 + nn < N) ? W[(size_t)(k0 + kk) * N + n0 + nn] : 0.f; }
        __syncthreads();
        if (rs_g) {
            if (tid < 64) { float cs = 0.f, cb = 0.f;
                for (int kk = 0; kk < 64; ++kk) { const float w = sm[kk * 65 + tid]; cs += w * rs_g[k0 + kk]; cb += w * rs_b[k0 + kk]; }
                atomicAdd(colsum + n0 + tid, cs); atomicAdd(colbias + n0 + tid, cb); }
            __syncthreads();
            for (int e = tid; e < 64 * 64; e += NTHR) { const int kk = e >> 6, nn = e & 63; sm[kk * 65 + nn] *= rs_g[k0 + kk]; }
            __syncthreads();
        }
        { const int nn = tid >> 3, c = tid & 7;
          if (n0 + nn < N) { uint4 o; o.x = pk2(sm[(8 * c + 0) * 65 + nn], sm[(8 * c + 1) * 65 + nn]); o.y = pk2(sm[(8 * c + 2) * 65 + nn], sm[(8 * c + 3) * 65 + nn]);
              o.z = pk2(sm[(8 * c + 4) * 65 + nn], sm[(8 * c + 5) * 65 + nn]); o.w = pk2(sm[(8 * c + 6) * 65 + nn], sm[(8 * c + 7) * 65 + nn]);
              *(uint4*)(WT + (size_t)(n0 + nn) * K + k0 + 8 * c) = o; } }
    }
    __syncthreads();
}
__device__ void prologue_phase(int WV_, const Params& p, float* sm) {
    const int tid = LTID(WV_), B = LBID(), G = LGRID();
    unsigned char* ws = p.ws;
    for (int l = 0; l < DEPTH_; ++l) {
        bf16* win_t = (bf16*)(ws + WS_WIN_T + l * WIN_T_BYTES);
        transpose_items(WV_, p.in[1] + (size_t)l * 1024 * NCOL, 1024, NCOL, win_t, sm, B, 0, G);
        for (int i = B * NTHR + tid; i < (NP - NCOL) * 1024 / 8; i += G * NTHR) ((uint4*)(win_t + (size_t)NCOL * 1024))[i] = make_uint4(0u, 0u, 0u, 0u);
        transpose_items(WV_, p.in[3] + (size_t)l * 1024 * 1024, 1024, 1024, (bf16*)(ws + WS_WOUT_T) + (size_t)l * 1024 * 1024, sm, B, 0, G);
        transpose_items(WV_, p.in[7] + (size_t)l * 1024 * 1024, 1024, 1024, (bf16*)(ws + WS_WQ_T) + (size_t)l * 1024 * 1024, sm, B, 0, G,
                        p.in[5] + l * 1024, p.in[6] + l * 1024, (float*)(ws + WS_COLS) + l * 2048, (float*)(ws + WS_COLS) + l * 2048 + 1024);
        for (int n = 0; n < 4; ++n)
            transpose_items(WV_, p.in[2] + ((size_t)l * 4 + n) * 256 * 1024, 256, 1024, (bf16*)(ws + WS_WBR_T) + ((size_t)l * 4 + n) * 1024 * 256, sm, B, 0, G);
    }
    const float4* x4 = (const float4*)p.in[0]; uint2* hb2 = (uint2*)(ws + WS_HB);
    for (size_t i = (size_t)B * NTHR + tid; i < (size_t)T_ * 1024 / 4; i += (size_t)G * NTHR) { const float4 v = x4[i]; hb2[i] = make_uint2(pk2(v.x, v.y), pk2(v.z, v.w)); }
}

__device__ __forceinline__ void ln_row(float4 (&v)[4], const float* g, const float* bb, float* orow, bf16* obrow, int lane) {
    float s = 0.f;
#pragma unroll
    for (int j = 0; j < 4; ++j) s += (v[j].x + v[j].y) + (v[j].z + v[j].w);
    const float mean = wave_sum(s) * (1.0f / 1024.0f);
    float s2 = 0.f;
#pragma unroll
    for (int j = 0; j < 4; ++j) { v[j].x -= mean; v[j].y -= mean; v[j].z -= mean; v[j].w -= mean; s2 += (v[j].x * v[j].x + v[j].y * v[j].y) + (v[j].z * v[j].z + v[j].w * v[j].w); }
    const float rstd = 1.0f / sqrtf(wave_sum(s2) * (1.0f / 1024.0f) + LN_EPS);
#pragma unroll
    for (int j = 0; j < 4; ++j) {
        const float4 gg = ((const float4*)g)[j * 64 + lane], b4 = ((const float4*)bb)[j * 64 + lane];
        float4 o; o.x = v[j].x * rstd * gg.x + b4.x; o.y = v[j].y * rstd * gg.y + b4.y; o.z = v[j].z * rstd * gg.z + b4.z; o.w = v[j].w * rstd * gg.w + b4.w;
        ((float4*)orow)[j * 64 + lane] = o;
        ((uint2*)obrow)[j * 64 + lane] = make_uint2(pk2(o.x, o.y), pk2(o.z, o.w));
    }
}
__device__ void ln1_phase(int WV_, const float* hin, const float* add, const float* g, const float* bb, float* hout, bf16* hb) {
    const int lane = LTID(WV_) & 63, wave = LTID(WV_) >> 6;
    for (int row = LBID() * NWAVE + wave; row < T_; row += LGRID() * NWAVE) {
        float4 v[4];
#pragma unroll
        for (int j = 0; j < 4; ++j) {
            const float4 a = ((const float4*)(hin + (size_t)row * 1024))[j * 64 + lane], m = ((const float4*)(add + (size_t)row * 1024))[j * 64 + lane];
            v[j].x = ALPHA * a.x + m.x; v[j].y = ALPHA * a.y + m.y; v[j].z = ALPHA * a.z + m.z; v[j].w = ALPHA * a.w + m.w;
        }
        ln_row(v, g, bb, hout + (size_t)row * 1024, hb + (size_t)row * 1024, lane);
    }
}


typedef short bf16x8_t __attribute__((ext_vector_type(8)));
typedef float f32x16_t __attribute__((ext_vector_type(16)));
typedef float f32x2_t __attribute__((ext_vector_type(2)));
typedef __bf16 bf16x2_t __attribute__((ext_vector_type(2)));
__device__ __forceinline__ unsigned cvtpk(float lo, float hi) { f32x2_t v = {lo, hi}; bf16x2_t b = __builtin_convertvector(v, bf16x2_t); return __builtin_bit_cast(unsigned, b); }
__device__ __forceinline__ int crow(int r, int hi) { return (r & 3) + 8 * (r >> 2) + 4 * hi; }
__device__ __forceinline__ float xlane32(float v) { return __shfl_xor(v, 32); }
__device__ __forceinline__ float vmax(float a, float b) { float r; asm("v_max_f32_e32 %0, %1, %2" : "=v"(r) : "v"(a), "v"(b)); return r; }
__device__ __forceinline__ float vmin(float a, float b) { float r; asm("v_min_f32_e32 %0, %1, %2" : "=v"(r) : "v"(a), "v"(b)); return r; }
__device__ __forceinline__ float vmax3(float a, float b, float c) { float r; asm("v_max3_f32 %0, %1, %2, %3" : "=v"(r) : "v"(a), "v"(b), "v"(c)); return r; }

constexpr int AT_KP = 72, AT_VP = 96;
constexpr int AT_KS = 0, AT_KS_BYTES = 64 * AT_KP * 2;
constexpr int AT_VT = 2 * AT_KS_BYTES, AT_VT_BYTES = 64 * AT_VP * 2;
constexpr int AT_KM = AT_VT + 2 * AT_VT_BYTES;
constexpr int AT_MISC = AT_KM + 32 * AT_KP * 2;
constexpr float LOG2E = 1.4426950408889634f;

__device__ __forceinline__ unsigned mk_unit(int kind, int b, int x, int y) { return ((unsigned)kind << 30) | ((unsigned)b << 28) | ((unsigned)x << 8) | (unsigned)y; }
__device__ void build_unit_table(unsigned* tab, int i) {
    int n = 0; unsigned res = 0u;
#pragma unroll 1
    for (int c = 64; c >= 1; --c) {
        if (i >= n && i < n + 4) res = mk_unit(0, i - n, 0, c - 1);
        n += 4;
        if ((c & 3) == 0) { if (i >= n && i < n + 16) { const int j = i - n; res = mk_unit(2, j >> 2, j & 3, c / 4 - 1); } n += 16; }
    }
    if (i < 512) tab[i] = res;
}

template <int kind> __device__ __forceinline__ void attn_unit(int WV_, const bf16* P, const unsigned char* mask, const float* kmean, const float* sinks, bf16* ys,
                                unsigned char* lds, int b, int ux, int uy) {
    int tid_ = LTID(WV_); asm volatile("" : "+v"(tid_));
    const int tid = tid_, lane = tid & 63, wave = __builtin_amdgcn_readfirstlane(tid >> 6), r32 = lane & 31, hi = lane >> 5;
    bf16* s_km = (bf16*)(lds + AT_KM);
    const int skey = tid >> 3, sc = tid & 7;
    {
        const bf16* Pb = P + (size_t)b * S_ * NP;
        int q0w, qcol, kcol, vcol, ycol, kt_hi, kt_lo; float slope2 = 0.f, sink2 = 0.f;
        if (kind == 0) { const int head = wave >> 1; q0w = uy * 64 + (wave & 1) * 32; qcol = C_QA + head * 64; kcol = C_KA; vcol = C_VA; ycol = head * 64;
            slope2 = exp2f(-8.0f * (float)(3 * head + 1) / 12.0f) * LOG2E; kt_hi = uy; kt_lo = 0; }
        else if (kind == 1) { const int hq = ux * 2 + (wave >> 2); q0w = uy * 128 + (wave & 3) * 32; qcol = C_QB + hq * 64; kcol = C_KB + ux * 64; vcol = C_VB + ux * 64; ycol = 256 + hq * 64;
            slope2 = exp2f(-8.0f * (float)(3 * hq + 2) / 12.0f) * LOG2E; sink2 = sinks[hq] * LOG2E; kt_hi = 2 * uy + 1; kt_lo = (2 * uy - 2 > 0) ? 2 * uy - 2 : 0; }
        else if (kind == 2) { q0w = uy * 256 + wave * 32; qcol = C_QC + ux * 64; kcol = C_KC + ux * 64; vcol = C_VC + ux * 64; ycol = 512 + ux * 64;
            slope2 = exp2f(-8.0f * (float)(3 * ux + 3) / 12.0f) * LOG2E; kt_hi = 4 * uy + 3; kt_lo = 0; }
        else { q0w = uy * 256 + wave * 32; qcol = C_QD + ux * 64; kcol = C_KD + ux * 64; vcol = C_VD + ux * 64; ycol = 768 + ux * 64; kt_hi = 4 * uy + 3; kt_lo = 0; }
        const int qpos = q0w + r32;
        bf16x8_t qf[4];
        { const bf16* qp = Pb + (size_t)qpos * NP + qcol + 8 * hi;
#pragma unroll
          for (int ks = 0; ks < 4; ++ks) qf[ks] = *(const bf16x8_t*)(qp + 16 * ks); }
        {
            const float qs = (kind == 3) ? 0.125f : 0.125f * LOG2E;
            typedef unsigned u32x4_t __attribute__((ext_vector_type(4)));
#pragma unroll
            for (int ks = 0; ks < 4; ++ks) { u32x4_t w = __builtin_bit_cast(u32x4_t, qf[ks]);
#pragma unroll
                for (int i = 0; i < 4; ++i) w[i] = cvtpk(__uint_as_float(w[i] << 16) * qs, __uint_as_float(w[i] & 0xffff0000u) * qs);
                qf[ks] = __builtin_bit_cast(bf16x8_t, w); }
        }
        float sb[16];
#pragma unroll
        for (int r = 0; r < 16; ++r) sb[r] = slope2 * (float)((r & 3) + 8 * (r >> 2));
        unsigned bm = 0u;
        if (kind == 2) {
            const int own = uy;
            for (int e = tid; e < 32 * 64; e += NTHR) { const int row = e >> 6, d = e & 63; s_km[row * AT_KP + d] = (row < 16) ? (bf16)f2bf(kmean[((b * 4 + ux) * 16 + row) * 64 + d]) : (bf16)0; }
            __syncthreads();
            f32x16_t gacc;
#pragma unroll
            for (int r = 0; r < 16; ++r) gacc[r] = 0.f;
#pragma unroll
            for (int ks = 0; ks < 4; ++ks) { const bf16x8_t a = *(const bf16x8_t*)(s_km + r32 * AT_KP + 16 * ks + 8 * hi); gacc = __builtin_amdgcn_mfma_f32_32x32x16_bf16(a, qf[ks], gacc, 0, 0, 0); }
            float gt[16];
#pragma unroll
            for (int r = 0; r < 8; ++r) { const float mine = gacc[r], other = xlane32(mine); const int bi = crow(r, 0);
                gt[bi] = hi ? other : mine; gt[bi + 4] = hi ? mine : other; }
#pragma unroll
            for (int n = 0; n < 16; ++n) if (n >= own) gt[n] = -INFINITY;
#pragma unroll
            for (int rep = 0; rep < 3; ++rep) {
                float mx = -INFINITY;
#pragma unroll
                for (int n = 0; n < 16; ++n) mx = fmaxf(mx, gt[n]);
                bool done = !(mx > -INFINITY);
#pragma unroll
                for (int n = 0; n < 16; ++n) { const bool hit = !done && gt[n] == mx; if (hit) { bm |= 1u << n; gt[n] = -INFINITY; done = true; } }
            }
        }
        f32x16_t o0, o1;
#pragma unroll
        for (int r = 0; r < 16; ++r) { o0[r] = 0.f; o1[r] = 0.f; }
        float m_run = -INFINITY, l_run = 0.f, carry = 0.f;
        const bf16* kg = Pb + (size_t)skey * NP + kcol + sc * 8;
        const bf16* vg = Pb + (size_t)skey * NP + vcol + sc * 8;
        uint4 rk = *(const uint4*)(kg + (size_t)kt_hi * 64 * NP), rv = *(const uint4*)(vg + (size_t)kt_hi * 64 * NP);
        int buf = 0;
        { bf16* ks_ = (bf16*)(lds + AT_KS); bf16* vt_ = (bf16*)(lds + AT_VT);
          *(uint4*)(ks_ + skey * AT_KP + sc * 8) = rk;
          *(uint4*)(vt_ + skey * AT_VP + sc * 8) = rv; }
        __syncthreads();
        bool wave_done = false;
        uint2 mw_next = make_uint2(0u, 0u);
        if (kind == 0) mw_next = *(const uint2*)(mask + (size_t)(b * S_ + qpos) * 512 + kt_hi * 8);
        for (int kt = kt_hi; kt >= kt_lo; --kt) {
            const bool more = kt > kt_lo;
            const uint2 mw = mw_next;
            if (kind == 0 && more) mw_next = *(const uint2*)(mask + (size_t)(b * S_ + qpos) * 512 + (kt - 1) * 8);
            if (more) { rk = *(const uint4*)(kg + (size_t)(kt - 1) * 64 * NP); rv = *(const uint4*)(vg + (size_t)(kt - 1) * 64 * NP); }
            const bf16* ks_ = (const bf16*)(lds + AT_KS + buf * AT_KS_BYTES);
            const bf16* vt_ = (const bf16*)(lds + AT_VT + buf * AT_VT_BYTES);
            bool active = (kt * 64 <= q0w + 31) && !wave_done;
            if (kind == 1) active = active && (kt * 64 + 63 >= q0w - 127);
            if (active) {
                const int kbase = kt * 64 + 4 * hi;
                f32x16_t p0, p1;
                if (kind != 3) {
                    const float cb = slope2 * (float)(kbase - qpos), cb1 = cb + 32.0f * slope2;
#pragma unroll
                    for (int r = 0; r < 16; ++r) { p0[r] = cb + sb[r]; p1[r] = cb1 + sb[r]; }
                } else {
#pragma unroll
                    for (int r = 0; r < 16; ++r) { p0[r] = 0.f; p1[r] = 0.f; }
                }
#pragma unroll
                for (int ks = 0; ks < 4; ++ks) {
                    const bf16x8_t a0 = *(const bf16x8_t*)(ks_ + r32 * AT_KP + 16 * ks + 8 * hi);
                    const bf16x8_t a1 = *(const bf16x8_t*)(ks_ + (32 + r32) * AT_KP + 16 * ks + 8 * hi);
                    p0 = __builtin_amdgcn_mfma_f32_32x32x16_bf16(a0, qf[ks], p0, 0, 0, 0);
                    p1 = __builtin_amdgcn_mfma_f32_32x32x16_bf16(a1, qf[ks], p1, 0, 0, 0);
                }
                if (kind != 3) {
                    float mx = -INFINITY;
                    if (kind == 0) {
                        const unsigned w0 = mw.x >> (4 * hi), w1 = mw.y >> (4 * hi);
#pragma unroll
                        for (int r = 0; r < 16; ++r) { const int off = (r & 3) + 8 * (r >> 2);
                            p0[r] = (w0 & (1u << off)) ? p0[r] : -INFINITY; p1[r] = (w1 & (1u << off)) ? p1[r] : -INFINITY; mx = vmax3(mx, p0[r], p1[r]); }
                    } else if (kind == 1) {
                        const int rel = qpos - kbase;
#pragma unroll
                        for (int r = 0; r < 16; ++r) { const int off = (r & 3) + 8 * (r >> 2);
                            p0[r] = ((unsigned)(rel - off) < 128u) ? p0[r] : -INFINITY; p1[r] = ((unsigned)(rel - off - 32) < 128u) ? p1[r] : -INFINITY; mx = vmax3(mx, p0[r], p1[r]); }
                    } else {
                        if ((kt >> 2) == uy) {
                            const int rel = qpos - kbase;
#pragma unroll
                            for (int r = 0; r < 16; ++r) { const int off = (r & 3) + 8 * (r >> 2);
                                p0[r] = (off <= rel) ? p0[r] : -INFINITY; p1[r] = (off + 32 <= rel) ? p1[r] : -INFINITY; mx = vmax3(mx, p0[r], p1[r]); }
                        } else {
                            const bool tile_ok = ((bm >> (kt >> 2)) & 1u) != 0u;
#pragma unroll
                            for (int r = 0; r < 16; ++r) { p0[r] = tile_ok ? p0[r] : -INFINITY; p1[r] = tile_ok ? p1[r] : -INFINITY; mx = vmax3(mx, p0[r], p1[r]); }
                        }
                    }
                    mx = vmax(mx, xlane32(mx));
                    const float m_new = vmax(m_run, mx);
                    const float m_safe = (m_new == -INFINITY) ? 0.f : m_new;
                    p0 = p0 - m_safe; p1 = p1 - m_safe;
#pragma unroll
                    for (int r = 0; r < 16; ++r) { p0[r] = __builtin_amdgcn_exp2f(p0[r]); p1[r] = __builtin_amdgcn_exp2f(p1[r]); }
                    float ls;
                    { typedef float f32x8_t __attribute__((ext_vector_type(8))); typedef float f32x4v_t __attribute__((ext_vector_type(4)));
                      const f32x16_t t16 = p0 + p1; const f32x8_t t8 = t16.lo + t16.hi; const f32x4v_t t4 = t8.lo + t8.hi; const f32x2_t t2 = t4.lo + t4.hi; ls = t2.x + t2.y; }
                    if (__any(m_new > m_run)) {
                        const float alpha = __builtin_amdgcn_exp2f(m_run - m_safe);
                        l_run *= alpha;
                        o0 = o0 * alpha; o1 = o1 * alpha;
                    }
                    l_run += ls; m_run = m_new;
                } else {
                    float run = carry;
#define SB_HALF(PX, KOFF) do { \
                    float lk[16]; \
                    _Pragma("unroll") for (int r = 0; r < 16; ++r) { \
                        const int off = (r & 3) + 8 * (r >> 2); \
                        const bool v = (kbase + off + (KOFF)) < qpos; \
                        const float z = PX[r]; \
                        const float t = 0.6931471805599453f * __builtin_amdgcn_logf(1.0f + __builtin_amdgcn_exp2f(-LOG2E * fabsf(z))); \
                        lk[r] = v ? (fminf(-z, 0.f) - t) : 0.f; \
                        PX[r] = v ? (fminf(z, 0.f) - t) : -INFINITY; } \
                    _Pragma("unroll") for (int g = 3; g >= 0; --g) { \
                        const float G = (lk[4 * g] + lk[4 * g + 1]) + (lk[4 * g + 2] + lk[4 * g + 3]); \
                        const float PG = xlane32(G); \
                        float la = run + (hi ? 0.f : PG); \
                        run += G + PG; \
                        PX[4 * g + 3] += la; la += lk[4 * g + 3]; PX[4 * g + 2] += la; la += lk[4 * g + 2]; PX[4 * g + 1] += la; la += lk[4 * g + 1]; PX[4 * g] += la; } \
                    _Pragma("unroll") for (int r = 0; r < 16; ++r) PX[r] = __builtin_amdgcn_exp2f(LOG2E * PX[r]); } while (0)
                    SB_HALF(p1, 32);
                    SB_HALF(p0, 0);
#undef SB_HALF
                    carry = run;
                }
                unsigned pw[16];
#pragma unroll
                for (int j = 0; j < 8; ++j) { pw[j] = cvtpk(p0[2 * j], p0[2 * j + 1]); pw[8 + j] = cvtpk(p1[2 * j], p1[2 * j + 1]); }
#pragma unroll
                for (int s = 0; s < 4; ++s) {
                    bf16x8_t pb; { const unsigned* q = pw + 4 * s; typedef unsigned u32x4_t __attribute__((ext_vector_type(4))); u32x4_t t4 = {q[0], q[1], q[2], q[3]}; pb = __builtin_bit_cast(bf16x8_t, t4); }
#pragma unroll
                    for (int dt = 0; dt < 2; ++dt) {
                        typedef short s16x4_t __attribute__((ext_vector_type(4)));
                        typedef __attribute__((address_space(3))) s16x4_t lds_s16x4;
                        const int gi_ = lane & 15;
                        const bf16* vp = vt_ + (16 * s + 4 * hi + (gi_ >> 2)) * AT_VP + 32 * dt + 16 * ((lane >> 4) & 1) + 4 * (gi_ & 3);
                        const s16x4_t lo = __builtin_amdgcn_ds_read_tr16_b64_v4i16((lds_s16x4*)vp), hi4 = __builtin_amdgcn_ds_read_tr16_b64_v4i16((lds_s16x4*)(vp + 8 * AT_VP));
                        const bf16x8_t va = {lo[0], lo[1], lo[2], lo[3], hi4[0], hi4[1], hi4[2], hi4[3]};
                        if (dt == 0) o0 = __builtin_amdgcn_mfma_f32_32x32x16_bf16(va, pb, o0, 0, 0, 0);
                        else         o1 = __builtin_amdgcn_mfma_f32_32x32x16_bf16(va, pb, o1, 0, 0, 0);
                    }
                }
            }
            if (kind == 3) {
                const float cm = carry;
                if (__all(cm < -110.0f) || !(kt * 64 <= q0w + 31) ) { if (__all(cm < -110.0f)) wave_done = true; }
            }
            if (more) {
                bf16* ksn = (bf16*)(lds + AT_KS + (buf ^ 1) * AT_KS_BYTES); bf16* vtn = (bf16*)(lds + AT_VT + (buf ^ 1) * AT_VT_BYTES);
                *(uint4*)(ksn + skey * AT_KP + sc * 8) = rk;
                *(uint4*)(vtn + skey * AT_VP + sc * 8) = rv;
            }
            if (kind == 3) { if (__syncthreads_and(wave_done ? 1 : 0)) break; }
            else __syncthreads();
            buf ^= 1;
        }
        float inv;
        if (kind == 3) inv = 1.0f;
        else {
            float lt = l_run + xlane32(l_run);
            if (kind == 1) { const float mf = fmaxf(m_run, sink2); const float sc2 = exp2f(m_run - mf); lt = lt * sc2 + exp2f(sink2 - mf); inv = sc2 / lt; }
            else inv = 1.0f / lt;
        }
        bf16* yp = ys + (size_t)(b * S_ + qpos) * 1024 + ycol + 4 * hi;
#pragma unroll
        for (int g = 0; g < 4; ++g) {
            *(uint2*)(yp + 8 * g) = make_uint2(cvtpk(o0[4 * g] * inv, o0[4 * g + 1] * inv), cvtpk(o0[4 * g + 2] * inv, o0[4 * g + 3] * inv));
            *(uint2*)(yp + 32 + 8 * g) = make_uint2(cvtpk(o1[4 * g] * inv, o1[4 * g + 1] * inv), cvtpk(o1[4 * g + 2] * inv, o1[4 * g + 3] * inv));
        }
    }
}
__device__ void attn_fast_phase(int WV_, const bf16* P, const unsigned char* mask, const float* kmean, const float* sinks, bf16* ys,
                                const unsigned* utab, unsigned* counter, unsigned char* lds) {
    volatile unsigned* s_unit = (volatile unsigned*)(lds + AT_MISC);
    for (;;) {
        __syncthreads();
        if (LTID(WV_) == 0) s_unit[0] = atomicAdd(counter, 1u);
        __syncthreads();
        const unsigned ui = s_unit[0];
        if (ui >= 512u) break;
        const unsigned ue = utab[ui];
        const int kind = (int)(ue >> 30), b = (int)((ue >> 28) & 3u), ux = (int)((ue >> 8) & 255u), uy = (int)(ue & 255u);
        if (kind == 0) attn_unit<0>(WV_, P, mask, kmean, sinks, ys, lds, b, ux, uy);
        else attn_unit<2>(WV_, P, mask, kmean, sinks, ys, lds, b, ux, uy);
    }
    for (int u = LBID(); u < 256; u += LGRID()) { __syncthreads(); attn_unit<3>(WV_, P, mask, kmean, sinks, ys, lds, u >> 6, (u >> 4) & 3, u & 15); }
    for (int u = LBID(); u < 256; u += LGRID()) { __syncthreads(); attn_unit<1>(WV_, P, mask, kmean, sinks, ys, lds, u >> 6, (u >> 5) & 1, u & 31); }
}

constexpr float U_SCALE = 128.0f, V_SCALE = 48.0f;
constexpr int ROW6 = 1536;
typedef float v32f_t __attribute__((ext_vector_type(32)));
typedef unsigned v6u_t __attribute__((ext_vector_type(6)));
typedef unsigned u32x4a8_t __attribute__((ext_vector_type(4), aligned(8)));
__device__ __forceinline__ float rdlane_f(float v, int l) { return __builtin_bit_cast(float, __builtin_amdgcn_readlane(__builtin_bit_cast(int, v), l)); }
__device__ __forceinline__ unsigned q_e2m3(float v) {
    const float a = fminf(fabsf(v), 7.5f);
    unsigned code;
    if (a < 1.0f) code = (unsigned)rintf(a * 8.0f);
    else if (a < 2.0f) code = 8u + (unsigned)rintf((a - 1.0f) * 8.0f);
    else if (a < 4.0f) code = 16u + (unsigned)rintf((a - 2.0f) * 4.0f);
    else code = 24u + (unsigned)rintf((a - 4.0f) * 2.0f);
    return code | (v < 0.f ? 32u : 0u);
}
__device__ void convert_tables(int WV_, const Params& p) {
    const size_t nchunk = (size_t)DEPTH_ * 16384 * 2 * 32;
    for (size_t i = (size_t)LBID() * NTHR + LTID(WV_); i < nchunk; i += (size_t)LGRID() * NTHR) {
        const int c = (int)(i & 31), uvsel = (int)((i >> 5) & 1); const size_t le = i >> 6;
        const float* src = (uvsel ? p.in[10] : p.in[9]) + le * 1024 + c * 32;
        const float sc = uvsel ? V_SCALE : U_SCALE;
        unsigned w[6] = {0u, 0u, 0u, 0u, 0u, 0u};
#pragma unroll
        for (int q4 = 0; q4 < 8; ++q4) {
            const float4 a = ((const float4*)src)[q4];
            const float av[4] = {a.x, a.y, a.z, a.w};
#pragma unroll
            for (int e = 0; e < 4; ++e) { const int idx = q4 * 4 + e, bit = 6 * idx, d = bit >> 5, s = bit & 31; const unsigned code = q_e2m3(av[e] * sc);
                w[d] |= code << s; if (s > 26) w[d + 1] |= code >> (32 - s); }
        }
        uint2* dst = (uint2*)(p.ws + WS_UV + le * ROW6 + uvsel * 768 + c * 24);
        dst[0] = make_uint2(w[0], w[1]); dst[1] = make_uint2(w[2], w[3]); dst[2] = make_uint2(w[4], w[5]);
    }
}
__device__ __forceinline__ v6u_t ld_pk6(const unsigned char* ptr) {
    const uint2 a = ((const uint2*)ptr)[0], b = ((const uint2*)ptr)[1], c = ((const uint2*)ptr)[2];
    const v6u_t pk = {a.x, a.y, b.x, b.y, c.x, c.y};
    return pk;
}
__device__ void peer_fast_phase(int WV_, float* h, bf16* hb, const int* eid, const float* gate, const unsigned char* uv, const float* g1, const float* b1, const float* g, const float* bb, unsigned char* lds) {
    const int tid = LTID(WV_), lane = tid & 63, wave = tid >> 6, l32 = lane & 31, hi = lane >> 5;
    float* pl = (float*)(lds + wave * 16384);
    unsigned char* raw = lds + wave * 16384 + 4096 + lane * 24;
    for (int t = LBID() * NWAVE + wave; t < T_; t += LGRID() * NWAVE) {
        float* hr = h + (size_t)t * 1024 + l32 * 32;
        float x[32], acc[32];
#pragma unroll
        for (int q4 = 0; q4 < 8; ++q4) { const float4 a = ((const float4*)hr)[q4]; x[4 * q4] = a.x; x[4 * q4 + 1] = a.y; x[4 * q4 + 2] = a.z; x[4 * q4 + 3] = a.w; }
        {
            float s = 0.f;
#pragma unroll
            for (int i = 0; i < 32; ++i) s += x[i];
#pragma unroll
            for (int o = 16; o > 0; o >>= 1) s += __shfl_xor(s, o);
            const float mean = s * (1.0f / 1024.0f);
            float s2 = 0.f;
#pragma unroll
            for (int i = 0; i < 32; ++i) { x[i] -= mean; s2 += x[i] * x[i]; }
#pragma unroll
            for (int o = 16; o > 0; o >>= 1) s2 += __shfl_xor(s2, o);
            const float rstd = 1.0f / sqrtf(s2 * (1.0f / 1024.0f) + LN_EPS);
#pragma unroll
            for (int q4 = 0; q4 < 8; ++q4) { const float4 gg = ((const float4*)(g1 + l32 * 32))[q4], cc = ((const float4*)(b1 + l32 * 32))[q4];
                x[4 * q4] = x[4 * q4] * rstd * gg.x + cc.x; x[4 * q4 + 1] = x[4 * q4 + 1] * rstd * gg.y + cc.y; x[4 * q4 + 2] = x[4 * q4 + 2] * rstd * gg.z + cc.z; x[4 * q4 + 3] = x[4 * q4 + 3] * rstd * gg.w + cc.w; }
        }
#pragma unroll
        for (int i = 0; i < 32; ++i) acc[i] = 0.f;
#pragma unroll 1
        for (int batch = 0; batch < 4; ++batch) {
            const int my_eid = eid[(size_t)t * 128 + batch * 32 + l32];
            const float my_gate = gate[(size_t)t * 128 + batch * 32 + l32];
#pragma unroll 1
            for (int grp = 0; grp < 2; ++grp) {
                { u32x4a8_t pa[8]; uint2 pc[8];
#pragma unroll
                  for (int i = 0; i < 8; ++i) { const int id = __shfl(my_eid, 2 * (grp * 8 + i) + hi); const unsigned char* rp = uv + (size_t)id * ROW6 + l32 * 24; pa[i] = *(const u32x4a8_t*)rp; pc[i] = *(const uint2*)(rp + 16); }
#pragma unroll
                  for (int i = 0; i < 8; ++i) { uint2* wp = (uint2*)(raw + i * 1536); wp[0] = make_uint2(pa[i].x, pa[i].y); wp[1] = make_uint2(pa[i].z, pa[i].w); wp[2] = pc[i]; } }
#pragma unroll 1
                for (int i = 0; i < 8; ++i) {
                    const uint2* rp = (const uint2*)(raw + i * 1536); const uint2 a = rp[0], b = rp[1], c = rp[2];
                    const v6u_t pk6 = {a.x, a.y, b.x, b.y, c.x, c.y}; const v32f_t f = __builtin_amdgcn_cvt_scalef32_pk32_f32_fp6(pk6, 1.0f);
                    f32x2_t dv0 = {0.f, 0.f}, dv1 = {0.f, 0.f};
#pragma unroll
                    for (int j = 0; j < 8; ++j) { const f32x2_t fa = {f[2 * j], f[2 * j + 1]}, fb = {f[16 + 2 * j], f[17 + 2 * j]}, xa = {x[2 * j], x[2 * j + 1]}, xb = {x[16 + 2 * j], x[17 + 2 * j]};
                        dv0 = fa * xa + dv0; dv1 = fb * xb + dv1; }
                    pl[(2 * (grp * 8 + i) + hi) * 32 + l32] = (dv0.x + dv0.y) + (dv1.x + dv1.y);
                }
            }
            float d;
            { const float4* pr = (const float4*)(pl + l32 * 32); float4 s4 = pr[0];
#pragma unroll
              for (int i = 1; i < 8; ++i) { const float4 v = pr[i]; s4.x += v.x; s4.y += v.y; s4.z += v.z; s4.w += v.w; }
              d = ((s4.x + s4.y) + (s4.z + s4.w)) * (1.0f / U_SCALE); }
            const float hv = 0.5f * d * (1.0f + erff(d * 0.70710678118654752f)) * my_gate * (1.0f / V_SCALE);
#pragma unroll 1
            for (int grp = 0; grp < 2; ++grp) {
                { u32x4a8_t pa[8]; uint2 pc[8];
#pragma unroll
                  for (int i = 0; i < 8; ++i) { const int id = __shfl(my_eid, 2 * (grp * 8 + i) + hi); const unsigned char* rp = uv + (size_t)id * ROW6 + 768 + l32 * 24; pa[i] = *(const u32x4a8_t*)rp; pc[i] = *(const uint2*)(rp + 16); }
#pragma unroll
                  for (int i = 0; i < 8; ++i) { uint2* wp = (uint2*)(raw + i * 1536); wp[0] = make_uint2(pa[i].x, pa[i].y); wp[1] = make_uint2(pa[i].z, pa[i].w); wp[2] = pc[i]; } }
#pragma unroll 1
                for (int i = 0; i < 8; ++i) {
                    const float c = __shfl(hv, 2 * (grp * 8 + i) + hi);
                    const uint2* rp = (const uint2*)(raw + i * 1536); const uint2 a = rp[0], b = rp[1], cc = rp[2];
                    const v6u_t pk6 = {a.x, a.y, b.x, b.y, cc.x, cc.y}; const v32f_t f = __builtin_amdgcn_cvt_scalef32_pk32_f32_fp6(pk6, 1.0f);
                    const f32x2_t c2 = {c, c};
#pragma unroll
                    for (int j = 0; j < 16; ++j) { const f32x2_t fj = {f[2 * j], f[2 * j + 1]}; f32x2_t aj = {acc[2 * j], acc[2 * j + 1]}; aj = fj * c2 + aj; acc[2 * j] = aj.x; acc[2 * j + 1] = aj.y; }
                }
            }
        }
        float y[32], s = 0.f;
#pragma unroll
        for (int i = 0; i < 32; ++i) { acc[i] += __shfl_xor(acc[i], 32); y[i] = ALPHA * x[i] + acc[i]; s += y[i]; }
#pragma unroll
        for (int o = 16; o > 0; o >>= 1) s += __shfl_xor(s, o);
        const float mean = s * (1.0f / 1024.0f);
        float s2 = 0.f;
#pragma unroll
        for (int i = 0; i < 32; ++i) { y[i] -= mean; s2 += y[i] * y[i]; }
#pragma unroll
        for (int o = 16; o > 0; o >>= 1) s2 += __shfl_xor(s2, o);
        const float rstd = 1.0f / sqrtf(s2 * (1.0f / 1024.0f) + LN_EPS);
        float o[16];
#pragma unroll
        for (int q4 = 0; q4 < 4; ++q4) {
            const float4 gg = ((const float4*)(g + l32 * 32 + hi * 16))[q4], cc = ((const float4*)(bb + l32 * 32 + hi * 16))[q4];
            float ya[4], yb2[4];
#pragma unroll
            for (int e = 0; e < 4; ++e) { ya[e] = y[4 * q4 + e]; yb2[e] = y[16 + 4 * q4 + e]; }
            asm volatile("" : "+v"(ya[0]), "+v"(ya[1]), "+v"(ya[2]), "+v"(ya[3]), "+v"(yb2[0]), "+v"(yb2[1]), "+v"(yb2[2]), "+v"(yb2[3]));
            const float y0 = hi ? yb2[0] : ya[0], y1 = hi ? yb2[1] : ya[1], y2 = hi ? yb2[2] : ya[2], y3 = hi ? yb2[3] : ya[3];
            o[4 * q4] = y0 * rstd * gg.x + cc.x; o[4 * q4 + 1] = y1 * rstd * gg.y + cc.y; o[4 * q4 + 2] = y2 * rstd * gg.z + cc.z; o[4 * q4 + 3] = y3 * rstd * gg.w + cc.w;
            ((float4*)(hr + hi * 16))[q4] = make_float4(o[4 * q4], o[4 * q4 + 1], o[4 * q4 + 2], o[4 * q4 + 3]);
        }
        uint4* hbp = (uint4*)(hb + (size_t)t * 1024 + l32 * 32 + hi * 16);
        hbp[0] = make_uint4(pk2(o[0], o[1]), pk2(o[2], o[3]), pk2(o[4], o[5]), pk2(o[6], o[7]));
        hbp[1] = make_uint4(pk2(o[8], o[9]), pk2(o[10], o[11]), pk2(o[12], o[13]), pk2(o[14], o[15]));
    }
}

__device__ __forceinline__ float pack_pl(float v, unsigned pl) { return __uint_as_float((__float_as_uint(v) & ~127u) | pl); }
__device__ __forceinline__ void ins16(float (&s)[16], float x) {
#pragma unroll
    for (int k = 15; k >= 1; --k) s[k] = __builtin_amdgcn_fmed3f(s[k - 1], x, s[k]);
    s[0] = vmax(s[0], x);
}
template <int D> __device__ __forceinline__ void bitonic_stage(float (&c)[16]) {
#pragma unroll
    for (int i = 0; i < 16; ++i) if ((i & D) == 0) { const float a = vmax(c[i], c[i + D]), b = vmin(c[i], c[i + D]); c[i] = a; c[i + D] = b; }
}
__device__ __forceinline__ int decode_key(unsigned pl) { return (int)(32u * ((pl >> 4) & 3u) + (pl & 3u) + 8u * ((pl >> 2) & 3u) + 4u * ((pl >> 6) & 1u)); }
__device__ void route_fast_phase(int WV_, const bf16* qb, const bf16* skb  , int* eid, float* gate, unsigned char* lds, int pm = -1, int pn = 0) {
    const int tid = LTID(WV_), lane = tid & 63, wave = tid >> 6, r32 = lane & 31, hi = lane >> 5;
    unsigned* lidx = (unsigned*)lds + wave * (64 * 33) + lane * 33;
    const int u_first = (pm >= 0) ? 0 : LBID() * NWAVE + wave, u_end = (pm >= 0) ? 2 : (T_ / 32) * 8, u_step = (pm >= 0) ? 1 : LGRID() * NWAVE;
    for (int unit = u_first; unit < u_end; unit += u_step) {
        const int h = (pm >= 0) ? 2 * pn + unit : (unit & 7), t = ((pm >= 0) ? 8 * pm + wave : (unit >> 3)) * 32 + r32;
        float sl[2][16];
#pragma unroll
        for (int p = 0; p < 2; ++p) {
            bf16x8_t qf[4];
            { const bf16* qp = qb + (size_t)t * 1024 + h * 128 + p * 64 + 8 * hi;
#pragma unroll
              for (int ks = 0; ks < 4; ++ks) qf[ks] = *(const bf16x8_t*)(qp + 16 * ks); }
            float s[16];
#pragma unroll
            for (int k = 0; k < 16; ++k) s[k] = -INFINITY;
            const bf16* skp = skb + ((size_t)(h * 2 + p) * 128 + r32) * 64 + 8 * hi;
#pragma unroll
            for (int kt = 0; kt < 4; ++kt) {
                f32x16_t acc;
#pragma unroll
                for (int r = 0; r < 16; ++r) acc[r] = 0.f;
#pragma unroll
                for (int ks = 0; ks < 4; ++ks) { const bf16x8_t a = *(const bf16x8_t*)(skp + (size_t)kt * 32 * 64 + 16 * ks); acc = __builtin_amdgcn_mfma_f32_32x32x16_bf16(a, qf[ks], acc, 0, 0, 0); }
#pragma unroll
                for (int r = 0; r < 16; ++r) ins16(s, pack_pl(acc[r], (unsigned)(kt * 16 + r)));
            }
            const unsigned hb = (unsigned)hi << 6;
#pragma unroll
            for (int k = 0; k < 16; ++k) s[k] = __uint_as_float(__float_as_uint(s[k]) | hb);
            float c[16];
#pragma unroll
            for (int k = 0; k < 16; ++k) c[k] = vmax(s[k], __shfl_xor(s[15 - k], 32));
            bitonic_stage<8>(c); bitonic_stage<4>(c); bitonic_stage<2>(c); bitonic_stage<1>(c);
#pragma unroll
            for (int k = 0; k < 16; ++k) { sl[p][k] = c[k]; lidx[p * 16 + k] = (unsigned)decode_key(__float_as_uint(c[k]) & 127u); }
        }
        float w[16];
#pragma unroll
        for (int k = 0; k < 16; ++k) w[k] = -INFINITY;
#pragma unroll
        for (int i = 0; i < 16; ++i)
#pragma unroll
            for (int j = 0; j < 16; ++j)
                if ((i + 1) * (j + 1) <= 16) { const float v = sl[0][i] + sl[1][j]; ins16(w, __uint_as_float((__float_as_uint(v) & ~255u) | (unsigned)(i * 16 + j))); }
        float e[16], sum = 0.f;
#pragma unroll
        for (int k = 0; k < 16; ++k) { e[k] = expf(w[k] - w[0]); sum += e[k]; }
        const float inv = 1.0f / sum;
        int ide[8]; float gte[8];
#pragma unroll
        for (int k = 0; k < 8; ++k) {
            float wa = w[k], wb = w[8 + k], ea = e[k], eb = e[8 + k];
            asm volatile("" : "+v"(wa), "+v"(wb), "+v"(ea), "+v"(eb));
            const float wv = hi ? wb : wa;
            const unsigned pl = __float_as_uint(wv) & 255u;
            ide[k] = (int)(lidx[pl >> 4] * 128u + lidx[16 + (pl & 15u)]);
            gte[k] = (hi ? eb : ea) * inv;
        }
        int* ep = eid + (size_t)t * 128 + h * 16 + hi * 8; float* gp = gate + (size_t)t * 128 + h * 16 + hi * 8;
        *(int4*)ep = make_int4(ide[0], ide[1], ide[2], ide[3]); *(int4*)(ep + 4) = make_int4(ide[4], ide[5], ide[6], ide[7]);
        *(float4*)gp = make_float4(gte[0], gte[1], gte[2], gte[3]); *(float4*)(gp + 4) = make_float4(gte[4], gte[5], gte[6], gte[7]);
    }
}

typedef float f32x4_t __attribute__((ext_vector_type(4)));
typedef __bf16 bf16x2v __attribute__((ext_vector_type(2)));
__device__ __forceinline__ float dot2bf(unsigned a, unsigned b, float c) { return __builtin_amdgcn_fdot2_f32_bf16(__builtin_bit_cast(bf16x2v, a), __builtin_bit_cast(bf16x2v, b), c, false); }
__device__ __forceinline__ void cnt_gt(int& cnt, unsigned a, unsigned b) { asm("v_cmp_gt_u32_e32 vcc, %1, %2\n\tv_addc_co_u32_e32 %0, vcc, 0, %0, vcc" : "+v"(cnt) : "v"(a), "v"(b) : "vcc"); }
__device__ __forceinline__ void cnt_eq(int& cnt, unsigned a, unsigned b) { asm("v_cmp_eq_u32_e32 vcc, %1, %2\n\tv_addc_co_u32_e32 %0, vcc, 0, %0, vcc" : "+v"(cnt) : "v"(a), "v"(b) : "vcc"); }
__device__ __forceinline__ unsigned flag_gt(unsigned a, unsigned b) { unsigned r; asm("v_cmp_gt_u32_e32 vcc, %1, %2\n\tv_cndmask_b32_e64 %0, 0, 1, vcc" : "=v"(r) : "v"(a), "v"(b) : "vcc"); return r; }
__device__ __forceinline__ unsigned flag_eq(unsigned a, unsigned b) { unsigned r; asm("v_cmp_eq_u32_e32 vcc, %1, %2\n\tv_cndmask_b32_e64 %0, 0, 1, vcc" : "=v"(r) : "v"(a), "v"(b) : "vcc"); return r; }
__device__ __forceinline__ void cnt_ge(int& cnt, unsigned key, unsigned cand) { asm("v_cmp_ge_u32_e32 vcc, %1, %2\n\tv_addc_co_u32_e32 %0, vcc, 0, %0, vcc" : "+v"(cnt) : "v"(key), "v"(cand) : "vcc"); }

typedef __attribute__((address_space(3))) unsigned lds_u32;
template <int SHIFT> __device__ __forceinline__ unsigned radix_pass(const unsigned (&key)[64], unsigned pre, lds_u32* hist, int lane, int& need) {
    typedef unsigned u32x4v __attribute__((ext_vector_type(4)));
    typedef __attribute__((address_space(3))) u32x4v lds_u32x4;
    { const u32x4v z4 = {0u, 0u, 0u, 0u};
#pragma unroll
      for (int i = 0; i < 8; ++i) ((lds_u32x4*)(hist + lane * 32))[i] = z4; }
    const unsigned cp = (unsigned)(lane & 7);
#pragma unroll
    for (int j = 0; j < 64; ++j) {
        const unsigned d = (key[j] >> SHIFT) & 255u;
        bool m;
        if (SHIFT == 24) m = key[j] != 0u; else m = (key[j] >> ((SHIFT + 8) & 31)) == pre;
        if (m) __hip_atomic_fetch_add(hist + ((d << 3) | cp), 1u, __ATOMIC_RELAXED, __HIP_MEMORY_SCOPE_WORKGROUP);
    }
    unsigned dsum[4]; unsigned sumL = 0u;
#pragma unroll
    for (int i = 0; i < 4; ++i) { const u32x4v v0 = ((const lds_u32x4*)(hist + lane * 32))[2 * i], v1 = ((const lds_u32x4*)(hist + lane * 32))[2 * i + 1];
        dsum[i] = ((v0.x + v0.y) + (v0.z + v0.w)) + ((v1.x + v1.y) + (v1.z + v1.w)); sumL += dsum[i]; }
    unsigned incl = sumL;
#pragma unroll
    for (int o = 1; o < 64; o <<= 1) { const unsigned t = (unsigned)__shfl_down((int)incl, o); if (lane + o < 64) incl += t; }
    const unsigned above = incl - sumL;
    const bool own = (above < (unsigned)need) && ((unsigned)need <= above + sumL);
    const int owner = __ffsll((long long)__ballot(own)) - 1;
    unsigned acc = above; int sel = -1; unsigned cab = 0u;
#pragma unroll
    for (int i = 3; i >= 0; --i) { const unsigned c = dsum[i]; const bool hit = (sel < 0) && (acc + c >= (unsigned)need); cab = hit ? acc : cab; sel = hit ? i : sel; acc += c; }
    const int ow = owner < 0 ? 0 : owner;
    const unsigned digit = (unsigned)__builtin_amdgcn_readlane(sel, ow) + (unsigned)(4 * ow);
    need -= (int)__builtin_amdgcn_readlane((int)cab, ow);
    return digit;
}
#ifndef TS_SEL
#define TS_SEL 0
#endif
#define ITS_B() do { if (TS_SEL >= 20 && TS_SEL <= 25 && WV_ == 0 && LANEID() == 0) ((volatile __attribute__((address_space(3))) unsigned long long*)((__attribute__((address_space(3))) unsigned char*)lds + 147456 - 16 - 32))[0] = __builtin_amdgcn_s_memrealtime(); } while (0)
#define ITS_E(k) do { if ((k) == TS_SEL && WV_ == 0 && LANEID() == 0) { volatile __attribute__((address_space(3))) unsigned long long* w_ = (volatile __attribute__((address_space(3))) unsigned long long*)((__attribute__((address_space(3))) unsigned char*)lds + 147456 - 16 - 32); w_[1] += __builtin_amdgcn_s_memrealtime() - w_[0]; } } while (0)
__device__ void index_fast_phase(int WV_, const bf16* P, unsigned char* mask, float* kmean, float* scratch_all, unsigned char* lds) {
    const int tid = LTID(WV_), lane = tid & 63, wave = tid >> 6, bid = LBID(), G = LGRID();
    float* s_part = (float*)lds;
    ITS_B();
    for (int k = bid; k < 256; k += G) {
        const int b = k >> 6, h = (k >> 4) & 3, blk = k & 15;
        const bf16* kp = P + (size_t)(b * S_ + blk * 256 + wave * 32) * NP + C_KC + h * 64 + lane;
        float a = 0.f;
#pragma unroll 8
        for (int j = 0; j < 32; ++j) a += bf2f(kp[(size_t)j * NP]);
        __syncthreads();
        s_part[wave * 64 + lane] = a;
        __syncthreads();
        if (tid < 64) { float s = 0.f;
#pragma unroll
            for (int w = 0; w < 8; ++w) s += s_part[w * 64 + tid];
            kmean[((b * 4 + h) * 16 + blk) * 64 + tid] = s * (1.0f / 256.0f); }
    }
    ITS_E(22);
    float* scr = scratch_all + (size_t)bid * (16 * 4096);
    const int lq = lane & 15, g4 = lane >> 4;
    for (int ui = bid; ui < 1024; ui += G) {
        const int b = ui >> 8, k = ui & 255, tile = (b & 1) ? 255 - k : k, q0 = tile * 16;
        const bf16* Pb = P + (size_t)b * S_ * NP;
        const int ntiles = tile + 1;
        ITS_B();
        bf16x8_t qf[8]; float wi[8];
        { const bf16* qp = Pb + (size_t)(q0 + lq) * NP + C_QI + 8 * g4;
#pragma unroll
          for (int h = 0; h < 8; ++h) qf[h] = *(const bf16x8_t*)(qp + 32 * h);
          const uint4 wv = *(const uint4*)(Pb + (size_t)(q0 + lq) * NP + C_WI); unpack8(wv, wi); }
        {
            bf16x8_t afn = *(const bf16x8_t*)(Pb + (size_t)((wave < ntiles ? wave : 0) * 16 + lq) * NP + C_KI + 8 * g4);
            for (int kt = wave; kt < ntiles; kt += NWAVE) {
                const bf16x8_t af = afn;
                { const int ktn = (kt + NWAVE < ntiles) ? kt + NWAVE : kt; afn = *(const bf16x8_t*)(Pb + (size_t)(ktn * 16 + lq) * NP + C_KI + 8 * g4); }
                f32x4_t a[8];
                const f32x4_t z = {0.f, 0.f, 0.f, 0.f};
#pragma unroll
                for (int h = 0; h < 8; ++h) a[h] = __builtin_amdgcn_mfma_f32_16x16x32_bf16(af, qf[h], z, 0, 0, 0);
                __builtin_amdgcn_sched_barrier(0);
                f32x4_t sc = {0.f, 0.f, 0.f, 0.f};
#pragma unroll
                for (int h = 0; h < 8; ++h)
#pragma unroll
                    for (int r = 0; r < 4; ++r) { float rl; asm("v_max_f32_e32 %0, 0, %1" : "=v"(rl) : "v"(a[h][r])); sc[r] += rl * wi[h]; }
#pragma unroll
                for (int r = 0; r < 4; ++r) { sc[r] *= 0.0625f; if (sc[r] == 0.f) sc[r] = 0.f; }
                *(f32x4_t*)(scr + (size_t)lq * 4096 + kt * 16 + 4 * g4) = sc;
            }
        }
        __threadfence_block();
        __syncthreads();
        __threadfence_block();
        ITS_E(20); ITS_B();
        lds_u32* hist = (lds_u32*)((__attribute__((address_space(3))) unsigned char*)lds + 2048) + wave * 2048;
#pragma unroll 1
        for (int qi = 0; qi < 2; ++qi) {
            const int ql = 2 * wave + qi, q = q0 + ql;
            const float* row = scr + (size_t)ql * 4096 + lane * 64;
            const int qrel = q - lane * 64;
            unsigned key[64];
            if (qrel >= 0) {
#pragma unroll
                for (int j4 = 0; j4 < 16; ++j4) {
                    const float4 v = ((const float4*)row)[j4];
                    const unsigned u[4] = {__float_as_uint(v.x), __float_as_uint(v.y), __float_as_uint(v.z), __float_as_uint(v.w)};
#pragma unroll
                    for (int e = 0; e < 4; ++e) { const unsigned t = u[e] ^ ((unsigned)((int)u[e] >> 31) | 0x80000000u); const unsigned inval = (unsigned)((qrel - (j4 * 4 + e)) >> 31); key[j4 * 4 + e] = t & ~inval; }
                    if ((j4 & 3) == 3) asm volatile("" ::: "memory");
                }
            } else {
#pragma unroll
                for (int j = 0; j < 64; ++j) key[j] = 0u;
            }
            ITS_E(23); ITS_B();
            unsigned wlo = 0u, whi = 0u;
            if (q + 1 > 256) {
                int need = 256;
                const unsigned d1 = radix_pass<24>(key, 0u, hist, lane, need);
                const unsigned d2 = radix_pass<16>(key, d1, hist, lane, need);
                const unsigned d3 = radix_pass<8>(key, (d1 << 8) | d2, hist, lane, need);
                const unsigned d4 = radix_pass<0>(key, (d1 << 16) | (d2 << 8) | d3, hist, lane, need);
                const unsigned prefix = (d1 << 24) | (d2 << 16) | (d3 << 8) | d4;
                ITS_E(24); ITS_B();
                int ceq = 0;
#pragma unroll
                for (int j = 0; j < 64; ++j) cnt_eq(ceq, key[j], prefix);
                ceq = wave_sum_i(ceq);
                int X = 4096;
                if (ceq != need) {
                    int X0 = 0;
#pragma unroll 1
                    for (int bit = 11; bit >= 0; --bit) {
                        const int c = X0 | (1 << bit);
                        int cnt = 0; const int crel = c - lane * 64;
#pragma unroll
                        for (int j = 0; j < 64; ++j) cnt_eq(cnt, (key[j] ^ prefix) | ~(unsigned)((j - crel) >> 31), 0u);
                        cnt = wave_sum_i(cnt);
                        if (cnt < need) X0 = c;
                    }
                    X = X0 + 1;
                }
                const int xrel = X - lane * 64;
#pragma unroll
                for (int j = 0; j < 32; ++j) {
                    const unsigned s0 = flag_gt(key[j], prefix) | flag_eq((key[j] ^ prefix) | ~(unsigned)((j - xrel) >> 31), 0u);
                    const unsigned s1 = flag_gt(key[32 + j], prefix) | flag_eq((key[32 + j] ^ prefix) | ~(unsigned)((32 + j - xrel) >> 31), 0u);
                    wlo |= s0 << j; whi |= s1 << j;
                }
            } else {
#pragma unroll
                for (int j = 0; j < 32; ++j) { wlo |= (~(unsigned)((qrel - j) >> 31) & 1u) << j; whi |= (~(unsigned)((qrel - 32 - j) >> 31) & 1u) << j; }
            }
            ((uint2*)(mask + (size_t)(b * S_ + q) * 512))[lane] = make_uint2(wlo, whi);
            ITS_E(25); ITS_B();
        }
        ITS_E(21);
        __syncthreads();
    }
}

constexpr int MG_P = 72;
constexpr int MG_TILE_BYTES = 128 * MG_P * 2;
__device__ void merge_fast_phase(int WV_, const bf16* P, const bf16* ys, const bf16* wbt  , bf16* merged, unsigned char* lds) {
    const int tid = LTID(WV_), lane = tid & 63, wave = tid >> 6, r32 = lane & 31, hi = lane >> 5, wt = wave & 3, wd = wave >> 2;
    const int srow0 = tid >> 3, sch = tid & 7;
    for (int tile = LBID(); tile < 1024; tile += LGRID()) {
        const int tok0 = (tile >> 3) * 128, d0 = (tile & 7) * 128;
        f32x16_t mer[2], acc[2];
#pragma unroll
        for (int r = 0; r < 16; ++r) { mer[0][r] = 0.f; mer[1][r] = 0.f; acc[0][r] = 0.f; acc[1][r] = 0.f; }
        uint4 RW00, RW01, RW10, RW11, RY00, RY01, RY10, RY11, RG0, RG1, RG2, RG3;
        bf16* gl = (bf16*)(lds + 4 * MG_TILE_BYTES);
        const int grow = tid >> 4, gch = tid & 15;
#define MG_GLOAD(st_, R_) do { const int n_ = (st_) >> 2, kc_ = (st_) & 3; \
            RW##R_##0 = *(const uint4*)(wbt + ((size_t)n_ * 1024 + d0 + srow0) * 256 + kc_ * 64 + sch * 8); \
            RW##R_##1 = *(const uint4*)(wbt + ((size_t)n_ * 1024 + d0 + srow0 + 64) * 256 + kc_ * 64 + sch * 8); \
            RY##R_##0 = *(const uint4*)(ys + (size_t)(tok0 + srow0) * 1024 + n_ * 256 + kc_ * 64 + sch * 8); \
            RY##R_##1 = *(const uint4*)(ys + (size_t)(tok0 + srow0 + 64) * 1024 + n_ * 256 + kc_ * 64 + sch * 8); } while (0)
#define MG_SSTORE(buf_, R_) do { bf16* wl_ = (bf16*)(lds + (buf_) * 2 * MG_TILE_BYTES); bf16* yl_ = (bf16*)(lds + (buf_) * 2 * MG_TILE_BYTES + MG_TILE_BYTES); \
            *(uint4*)(wl_ + srow0 * MG_P + sch * 8) = RW##R_##0; *(uint4*)(wl_ + (srow0 + 64) * MG_P + sch * 8) = RW##R_##1; \
            *(uint4*)(yl_ + srow0 * MG_P + sch * 8) = RY##R_##0; *(uint4*)(yl_ + (srow0 + 64) * MG_P + sch * 8) = RY##R_##1; } while (0)
        __syncthreads();
        MG_GLOAD(0, 0); MG_GLOAD(1, 1);
        MG_SSTORE(0, 0);
        __syncthreads();
#define MG_STAGE(PAR_, OTH_) do { const int buf = PAR_; \
            if (st + 2 < 16) MG_GLOAD(st + 2, PAR_); \
            if ((st & 3) == 1) { const bf16* gsrc = P + (size_t)(tok0 + grow) * NP + C_G + (st >> 2) * 1024 + d0 + gch * 8; \
                RG0 = *(const uint4*)gsrc; RG1 = *(const uint4*)(gsrc + (size_t)32 * NP); RG2 = *(const uint4*)(gsrc + (size_t)64 * NP); RG3 = *(const uint4*)(gsrc + (size_t)96 * NP); } \
            const bf16* wl = (const bf16*)(lds + buf * 2 * MG_TILE_BYTES); const bf16* yl = (const bf16*)(lds + buf * 2 * MG_TILE_BYTES + MG_TILE_BYTES); \
            _Pragma("unroll") for (int ks = 0; ks < 4; ++ks) { \
                const bf16x8_t bq = *(const bf16x8_t*)(yl + (32 * wt + r32) * MG_P + 16 * ks + 8 * hi); \
                const bf16x8_t a0 = *(const bf16x8_t*)(wl + (64 * wd + r32) * MG_P + 16 * ks + 8 * hi); \
                const bf16x8_t a1 = *(const bf16x8_t*)(wl + (64 * wd + 32 + r32) * MG_P + 16 * ks + 8 * hi); \
                acc[0] = __builtin_amdgcn_mfma_f32_32x32x16_bf16(a0, bq, acc[0], 0, 0, 0); \
                acc[1] = __builtin_amdgcn_mfma_f32_32x32x16_bf16(a1, bq, acc[1], 0, 0, 0); } \
            if ((st & 3) == 3) { \
                const int n = st >> 2; \
                const bf16* gp = gl + (32 * wt + r32) * 136 + 64 * wd + 4 * hi; (void)n; \
                _Pragma("unroll") for (int dt = 0; dt < 2; ++dt) \
                _Pragma("unroll") for (int g = 0; g < 4; ++g) { \
                        const uint2 gv = *(const uint2*)(gp + 32 * dt + 8 * g); \
                        const float g0 = __uint_as_float(gv.x << 16), g1 = __uint_as_float(gv.x & 0xffff0000u), g2 = __uint_as_float(gv.y << 16), g3 = __uint_as_float(gv.y & 0xffff0000u); \
                        mer[dt][4 * g + 0] += acc[dt][4 * g + 0] * __builtin_amdgcn_rcpf(1.f + __builtin_amdgcn_exp2f(-LOG2E * g0)); \
                        mer[dt][4 * g + 1] += acc[dt][4 * g + 1] * __builtin_amdgcn_rcpf(1.f + __builtin_amdgcn_exp2f(-LOG2E * g1)); \
                        mer[dt][4 * g + 2] += acc[dt][4 * g + 2] * __builtin_amdgcn_rcpf(1.f + __builtin_amdgcn_exp2f(-LOG2E * g2)); \
                        mer[dt][4 * g + 3] += acc[dt][4 * g + 3] * __builtin_amdgcn_rcpf(1.f + __builtin_amdgcn_exp2f(-LOG2E * g3)); } \
                _Pragma("unroll") for (int r = 0; r < 16; ++r) { acc[0][r] = 0.f; acc[1][r] = 0.f; } } \
            if (st + 1 < 16) MG_SSTORE(OTH_, OTH_); \
            if ((st & 3) == 2) { *(uint4*)(gl + grow * 136 + gch * 8) = RG0; *(uint4*)(gl + (grow + 32) * 136 + gch * 8) = RG1; *(uint4*)(gl + (grow + 64) * 136 + gch * 8) = RG2; *(uint4*)(gl + (grow + 96) * 136 + gch * 8) = RG3; } \
            __syncthreads(); } while (0)
#pragma unroll 1
        for (int st2 = 0; st2 < 16; st2 += 2) { { const int st = st2; MG_STAGE(0, 1); } { const int st = st2 + 1; MG_STAGE(1, 0); } }
#undef MG_STAGE
#undef MG_GLOAD
#undef MG_SSTORE
        bf16* mp = merged + (size_t)(tok0 + 32 * wt + r32) * 1024 + d0 + 64 * wd + 4 * hi;
#pragma unroll
        for (int dt = 0; dt < 2; ++dt)
#pragma unroll
            for (int g = 0; g < 4; ++g)
                *(uint2*)(mp + 32 * dt + 8 * g) = make_uint2(cvtpk(mer[dt][4 * g], mer[dt][4 * g + 1]), cvtpk(mer[dt][4 * g + 2], mer[dt][4 * g + 3]));
    }
}
#define LAS __attribute__((address_space(3)))
#define XB_TMO      128
#define XB_XCNT(j)  (256  + 64 * (j))
#define XB_XSUB(j)  (1280 + 64 * (j))
#define XB_XGEN(j)  (2304 + 64 * (j))
#define XB_TOP      3328
#define XB_TOPGEN   3392
#define XCD_BAR_WORDS 3456
#define XB_SPIN_CAP (1u << 18)

__device__ __forceinline__ unsigned xb_ld(unsigned* p)              { return __hip_atomic_load(p, __ATOMIC_RELAXED, __HIP_MEMORY_SCOPE_AGENT); }
__device__ __forceinline__ unsigned xb_add(unsigned* p, unsigned v) { return __hip_atomic_fetch_add(p, v, __ATOMIC_RELAXED, __HIP_MEMORY_SCOPE_AGENT); }
__device__ __forceinline__ unsigned xb_xcc_id() { return (unsigned)__builtin_amdgcn_s_getreg((3 << 11) | 20) & 0xFu; }
#define XB_SPIN(cond, bar) do { unsigned _sp = 0; while (cond) { __builtin_amdgcn_s_sleep(1); \
    if ((++_sp & 255u) == 0u) { if (xb_ld(&(bar)[XB_TMO])) break; if (_sp > XB_SPIN_CAP) { atomicAdd(&(bar)[XB_TMO], 1u); break; } } } } while (0)

struct XcdBarrier {
    unsigned* bar; unsigned x;
    volatile LAS unsigned* st;
};

__device__ __forceinline__ XcdBarrier xcd_barrier_post(unsigned* bar, volatile LAS unsigned* st) {
    XcdBarrier b; b.bar = bar; b.x = xb_xcc_id(); b.st = st;
    if (threadIdx.x == 0) (void)xb_add(&bar[XB_XCNT(b.x)], 1u);
    return b;
}
__device__ __forceinline__ void xcd_barrier_complete(unsigned* bar, unsigned x, unsigned& nloc, unsigned& nx) {
    const unsigned G = gridDim.x * gridDim.y * gridDim.z;
    unsigned sum, cnt, mine, sp = 0u;
    for (;;) {
        sum = 0u; cnt = 0u; mine = 0u;
#pragma unroll
        for (unsigned j = 0; j < 16; ++j) { const unsigned c = xb_ld(&bar[XB_XCNT(j)]); sum += c; cnt += (c > 0u) ? 1u : 0u; mine = (j == x) ? c : mine; }
        if (sum == G) break;
        __builtin_amdgcn_s_sleep(1);
        if ((++sp & 255u) == 0u) { if (xb_ld(&bar[XB_TMO])) break; if (sp > XB_SPIN_CAP) { atomicAdd(&bar[XB_TMO], 1u); break; } }
    }
    nloc = mine > 0u ? mine : 1u; nx = cnt > 0u ? cnt : 1u;
}

__device__ __forceinline__ void xcd_barrier(const XcdBarrier& b, int wv_) {
    asm volatile("s_waitcnt vmcnt(0)" ::: "memory");
    __syncthreads();
    if (wv_ == 0 && LANEID() == 0) {
        unsigned* bar = b.bar;
        __builtin_amdgcn_s_waitcnt(0);
        unsigned nloc = b.st[0], nx = b.st[1];
        if (nloc == 0u) { xcd_barrier_complete(bar, b.x, nloc, nx); b.st[0] = nloc; b.st[1] = nx; }
        const unsigned old = xb_add(&bar[XB_XSUB(b.x)], 1u);
        const unsigned gen = old / nloc;
        if (old + 1u == (gen + 1u) * nloc) {
            __builtin_amdgcn_fence(__ATOMIC_RELEASE, "agent");
            asm volatile("s_waitcnt vmcnt(0)" ::: "memory");
            const unsigned og = xb_add(&bar[XB_TOP], 1u);
            const unsigned tg = og / nx;
            if (og + 1u == (tg + 1u) * nx) xb_add(&bar[XB_TOPGEN], 1u);
            else XB_SPIN(xb_ld(&bar[XB_TOPGEN]) == tg, bar);
            __builtin_amdgcn_fence(__ATOMIC_ACQUIRE, "agent");
            xb_add(&bar[XB_XGEN(b.x)], 1u);
            asm volatile("s_waitcnt vmcnt(0)" ::: "memory");
        } else {
            XB_SPIN(xb_ld(&bar[XB_XGEN(b.x)]) == gen, bar);
            __builtin_amdgcn_fence(__ATOMIC_ACQUIRE, "agent");
            asm volatile("s_waitcnt vmcnt(0)" ::: "memory");
        }
    }
    __syncthreads();
}

enum { PH_PRO = 0, PH_GIN, PH_INDEX, PH_ATTN, PH_MERGE, PH_GOUT, PH_LN1, PH_GQ, PH_ROUTE, PH_PEER };
template <int PH> __device__ __forceinline__ void run_phase(int WV_, const Params& p_unused, int l, unsigned char* lds_raw) {
    size_t kaoff_ = 0; asm volatile("" : "+s"(kaoff_));
    typedef const __attribute__((address_space(4))) char* kaptr_t;
    const __attribute__((address_space(4))) Params& p = *(const __attribute__((address_space(4))) Params*)((kaptr_t)__builtin_amdgcn_kernarg_segment_ptr() + kaoff_);
    float* sm = (float*)lds_raw;
    size_t wsoff_ = 0; asm volatile("" : "+s"(wsoff_));
    unsigned char* ws = p.ws + wsoff_;
    float* hbuf = p.out;
    bf16* hb = (bf16*)(ws + WS_HB);
    bf16* P = (bf16*)(ws + WS_P);
    bf16* ys = (bf16*)(ws + WS_YS);
    bf16* mrg = (bf16*)(ws + WS_MRG);
    float* mix = (float*)(ws + WS_MIX);
    float* qb = (float*)(ws + WS_Q);
    unsigned char* mask = ws + WS_MASK;
    int* eid = (int*)(ws + WS_EID);
    float* gate = (float*)(ws + WS_GATE);
    float* kmean = (float*)(ws + WS_KMEAN);
    const float* hin = (l == 0) ? p.in[0] : hbuf;
    if (PH == PH_PRO) { Params pc; for (int i = 0; i < 13; ++i) pc.in[i] = p.in[i]; pc.out = p.out; pc.ws = ws;
        prologue_phase(WV_, pc, sm); convert_tables(WV_, pc);
        for (int i = LBID() * NTHR + LTID(WV_); i < DEPTH_ * 8 * 2 * 128 * 64 / 4; i += LGRID() * NTHR) { const float4 v = ((const float4*)p.in[8])[i]; ((uint2*)(ws + WS_SKB))[i] = make_uint2(pk2(v.x, v.y), pk2(v.z, v.w)); } if (LBID() < 2) build_unit_table((unsigned*)(ws + WS_CTL) + 1024, LBID() * NTHR + LTID(WV_)); }
    else if (PH == PH_GIN) {
        pg8::Gemm g{hb, (const bf16*)(ws + WS_WIN_T + l * WIN_T_BYTES), T_, NP, 1024};
        pg8::StaticOrder S; S.init(T_, NP, (int)LGRID(), (int)LBID());
        pg8::EpiBf16<0> E{P, NP, nullptr, 0, 0, 1.f};
        pg8::gemm_phase<pg8::EpiBf16<0>, pg8::StaticOrder, true, true>(WV_, (PG8_LAS unsigned char*)lds_raw, g, S, E);
    }
    else if (PH == PH_INDEX) index_fast_phase(WV_, P, mask, kmean, (float*)(ws + WS_YS), lds_raw);
    else if (PH == PH_ATTN) attn_fast_phase(WV_, P, mask, kmean, p.in[4] + l * 4, ys, (const unsigned*)(ws + WS_CTL) + 1024, (unsigned*)(ws + WS_CTL) + 64 * l, lds_raw);
    else if (PH == PH_MERGE) merge_fast_phase(WV_, P, ys, (const bf16*)(ws + WS_WBR_T) + (size_t)l * 4 * 1024 * 256, mrg, lds_raw);
    else if (PH == PH_GOUT) {
        pg8::Gemm g{mrg, (const bf16*)(ws + WS_WOUT_T) + (size_t)l * 1024 * 1024, T_, 1024, 1024};
        pg8::StaticOrder S; S.init(T_, 1024, (int)LGRID(), (int)LBID());
        pg8::EpiResY E{hin, hbuf, hb, (float*)(ws + WS_STATS) + (size_t)l * T_ * 2, ALPHA};
        pg8::gemm_phase<pg8::EpiResY, pg8::StaticOrder, true, true>(WV_, (PG8_LAS unsigned char*)lds_raw, g, S, E);
    }
    else if (PH == PH_GQ) {
        pg8::Gemm g{hb, (const bf16*)(ws + WS_WQ_T) + (size_t)l * 1024 * 1024, T_, 1024, 1024};
        pg8::StaticOrder S; S.init(T_, 1024, (int)LGRID(), (int)LBID());
        pg8::EpiLnFold E{(bf16*)qb, (const float*)(ws + WS_STATS) + (size_t)l * T_ * 2, (const float*)(ws + WS_COLS) + l * 2048, (const float*)(ws + WS_COLS) + l * 2048 + 1024, LN_EPS};
        pg8::gemm_phase<pg8::EpiLnFold, pg8::StaticOrder, true, true>(WV_, (PG8_LAS unsigned char*)lds_raw, g, S, E);
        pg8::Unit u0;
        if (LGRID() == 256 && S.next(0, u0)) {
            asm volatile("s_waitcnt vmcnt(0)" ::: "memory"); __syncthreads();
            route_fast_phase(WV_, (const bf16*)qb, (const bf16*)(ws + WS_SKB) + (size_t)l * 8 * 2 * 128 * 64, eid, gate, lds_raw, u0.pm, u0.pn);
        }
    }
    else if (PH == PH_ROUTE) { if (LGRID() != 256) route_fast_phase(WV_, (const bf16*)qb, (const bf16*)(ws + WS_SKB) + (size_t)l * 8 * 2 * 128 * 64, eid, gate, lds_raw); }
    else peer_fast_phase(WV_, hbuf, hb, eid, gate, ws + WS_UV + (size_t)l * 24 * MiB, p.in[5] + l * 1024, p.in[6] + l * 1024, p.in[11] + l * 1024, p.in[12] + l * 1024, lds_raw);
}

constexpr int CW_BAR = 4096;
constexpr int LDS_BARST = LDS_BYTES - 16;
__global__ void __launch_bounds__(NTHR, 2) mk_fwd(Params p) {
    extern __shared__ __attribute__((aligned(16))) unsigned char lds_raw[];
    cg::grid_group grid = cg::this_grid();
    const int WV_ = __builtin_amdgcn_readfirstlane((int)threadIdx.x >> 6);
    { volatile LAS unsigned* bst0 = (volatile LAS unsigned*)((LAS unsigned char*)lds_raw + LDS_BARST); if (threadIdx.x < 4) bst0[threadIdx.x] = 0u; }
    __syncthreads();
    volatile LAS unsigned* bst = (volatile LAS unsigned*)((LAS unsigned char*)lds_raw + LDS_BARST);
    (void)xcd_barrier_post((unsigned*)(p.ws + WS_CTL) + CW_BAR, bst);
#define GRID_BAR() do { XcdBarrier b_; b_.bar = (unsigned*)(p.ws + WS_CTL) + CW_BAR; b_.x = xb_xcc_id(); b_.st = (volatile LAS unsigned*)((LAS unsigned char*)lds_raw + LDS_BARST); xcd_barrier(b_, WV_); } while (0)
    run_phase<PH_PRO>(WV_, p, 0, lds_raw);
    grid.sync();
#pragma unroll 1
    for (int l = 0; l < DEPTH_; ++l) {
        run_phase<PH_GIN>(WV_, p, l, lds_raw); GRID_BAR();
        run_phase<PH_INDEX>(WV_, p, l, lds_raw); GRID_BAR();
        run_phase<PH_ATTN>(WV_, p, l, lds_raw); GRID_BAR();
        run_phase<PH_MERGE>(WV_, p, l, lds_raw); GRID_BAR();
        run_phase<PH_GOUT>(WV_, p, l, lds_raw); GRID_BAR();
        run_phase<PH_GQ>(WV_, p, l, lds_raw); if (LGRID() != 256) { GRID_BAR(); run_phase<PH_ROUTE>(WV_, p, l, lds_raw); } GRID_BAR();
        run_phase<PH_PEER>(WV_, p, l, lds_raw); if (l + 1 < DEPTH_) GRID_BAR();
    }
}

extern "C" void kernel_launch(void* const* d_in, const int* in_sizes, int n_in, void* d_out, int out_size, void* d_ws, size_t ws_size, hipStream_t stream) {
    if (n_in != 13 || ws_size < WS_END) { fprintf(stderr, "kernel_launch: unexpected n_in %d / ws_size %zu; nothing launched\n", n_in, ws_size); return; }
    static int grid_blocks = 0;
    if (grid_blocks == 0) {
        int dev = 0, cus = 0, per_cu = 0;
        (void)hipGetDevice(&dev);
        (void)hipDeviceGetAttribute(&cus, hipDeviceAttributeMultiprocessorCount, dev);
        (void)hipFuncSetAttribute((const void*)mk_fwd, hipFuncAttributeMaxDynamicSharedMemorySize, LDS_BYTES);
        (void)hipOccupancyMaxActiveBlocksPerMultiprocessor(&per_cu, (const void*)mk_fwd, NTHR, LDS_BYTES);
        if (per_cu < 1) fprintf(stderr, "kernel_launch: occupancy query reports %d\n", per_cu);
        grid_blocks = cus;
    }
    Params p{};
    for (int i = 0; i < 13; ++i) p.in[i] = (const float*)d_in[i];
    p.out = (float*)d_out; p.ws = (unsigned char*)d_ws;
    (void)hipMemsetAsync(d_ws, 0, 2 * MiB, stream);
    void* args[] = {&p};
    hipError_t e = hipLaunchCooperativeKernel((const void*)mk_fwd, dim3(grid_blocks), dim3(NTHR), args, LDS_BYTES, stream);
    if (e != hipSuccess) fprintf(stderr, "cooperative launch failed: %s (grid %d)\n", hipGetErrorString(e), grid_blocks);
}
```

```cpp
#include <hip/hip_runtime.h>
#include <cstdio>
#include <cstdint>
#include <hip/hip_cooperative_groups.h>
namespace cg = cooperative_groups;

__device__ __forceinline__ int LANEID() { int l; asm volatile("v_mbcnt_lo_u32_b32 %0, -1, 0\n\tv_mbcnt_hi_u32_b32 %0, -1, %0" : "=v"(l)); return l; }
__device__ __forceinline__ int LTID(int wv) { return (wv << 6) | LANEID(); }
__device__ __forceinline__ int LBID() { int t = blockIdx.x; asm volatile("" : "+s"(t)); return t; }
__device__ __forceinline__ int LGRID() { int t = gridDim.x; asm volatile("" : "+s"(t)); return t; }
namespace pg8 {
#define PG8_LAS __attribute__((address_space(3)))
typedef unsigned short bf16_t;
typedef short bf16x8 __attribute__((ext_vector_type(8)));
typedef float f32x4 __attribute__((ext_vector_type(4)));
typedef unsigned u32x4 __attribute__((ext_vector_type(4)));
constexpr int BM = 256, BK = 64, HALF = 128, HTB = HALF * BK * 2  , STAGE_BYTES = 8 * HTB, NXCD = 8, WGM = 8;

__host__ __device__ __forceinline__ int lds_byte(int r, int c) { const int st = (r >> 4) * 2 + (c >> 5), rr = r & 15, cc = c & 31, ob = rr * 64 + cc * 2; return st * 1024 + (ob ^ (((ob >> 9) & 1) << 5)); }
__host__ __device__ __forceinline__ void stage_rc(int b, int& R, int& C) { const int st = b / 1024, sb = b % 1024, swz = sb ^ (((sb >> 9) & 1) << 5); R = (st >> 1) * 16 + swz / 64; C = (st & 1) * 32 + (swz % 64) / 2; }
__host__ __device__ __forceinline__ int perm32(int rho) { const int n = rho >> 4, i = rho & 15; return 8 * (i >> 2) + 4 * n + (i & 3); }

struct Unit { int pm, pn; };
struct Gemm { const bf16_t* A; const bf16_t* Bt; int M, N, K; };

struct StaticOrder {
    int nM, nN, nwg, G, c;
    __host__ __device__ void init(int M, int N, int G_, int c_) { nM = M / BM; nN = N / BM; nwg = nM * nN; G = G_; c = c_; }
    __host__ __device__ bool next(int i, Unit& u) const {
        const long L = (long)i * G + c; if (L >= nwg) return false;
        int wgid = (int)L; { const int q = nwg / NXCD, r = nwg % NXCD, xcd = wgid % NXCD, off = wgid / NXCD; wgid = (xcd < r ? xcd * (q + 1) : r * (q + 1) + (xcd - r) * q) + off; }
        const int nig = WGM * nN, gid = wgid / nig, fm = gid * WGM, gsz = (nM - fm) < WGM ? (nM - fm) : WGM;
        u.pm = fm + ((wgid % nig) % gsz); u.pn = (wgid % nig) / gsz; return true;
    }
    __device__ __forceinline__ void a_ready(const Unit&) const {}
    __device__ __forceinline__ void done(const Unit&) const {}
};

__device__ __forceinline__ unsigned cvt_pk_bf16(float lo, float hi) { unsigned r; asm volatile("v_cvt_pk_bf16_f32 %0, %1, %2" : "=v"(r) : "v"(lo), "v"(hi)); return r; }
typedef float f32x2 __attribute__((ext_vector_type(2)));
__device__ __forceinline__ f32x2 gelu_pk(f32x2 v) {
    const f32x2 av = __builtin_elementwise_abs(v), d = av * 0.2316418882f + 1.0f;
    f32x2 t; t.x = __builtin_amdgcn_rcpf(d.x); t.y = __builtin_amdgcn_rcpf(d.y);
    f32x2 q = t * 0.5307027145f + (-0.7265760135f); q = q * t + 0.7107068705f; q = q * t + (-0.142248368f); q = q * t + 0.127414796f; q = q * t;
    const f32x2 s = (v * v) * (-0.72134752044f);
    f32x2 e; e.x = __builtin_amdgcn_exp2f(s.x); e.y = __builtin_amdgcn_exp2f(s.y);
    const f32x2 m = v * (q * e), r = v - m;
    f32x2 o; o.x = v.x < 0.f ? m.x : r.x; o.y = v.y < 0.f ? m.y : r.y; return o;
}

template <int ACT  > struct EpiBf16 {
    static constexpr bool PERM = true, AFTER_DRAIN = false; static_assert(ACT == 0 || ACT == 1, "EpiBf16: ACT is 0 (none) or 1 (gelu_pk)");
    bf16_t* O; int ldc; const float* bias; int split_cols; size_t split_stride; float scale0;
    __device__ __forceinline__ void operator()(const f32x4 (&acc)[2][2][4][2], const Unit& u, int wr, int wc, int fr, int fq) const {
        { int ln_ = LANEID(); asm volatile("" : "+v"(ln_)); fr = ln_ & 15; fq = ln_ >> 4; }
        const int row0 = u.pm * BM + wr * 64 + fr; int colt = u.pn * BM; bf16_t* base = O;
        float sc = 1.f; if (split_cols) { const int t = colt / split_cols; base += (size_t)t * split_stride; colt -= t * split_cols; if (t == 0) sc = scale0; }
        const int col0 = colt + wc * 32 + 8 * fq, bcol0 = u.pn * BM + wc * 32 + 8 * fq;
        f32x4 bv[2][2];
#pragma unroll
        for (int bj = 0; bj < 2; ++bj)
#pragma unroll
            for (int n = 0; n < 2; ++n) bv[bj][n] = bias ? *(const f32x4*)(bias + bcol0 + bj * HALF + 4 * n) : (f32x4){0.f, 0.f, 0.f, 0.f};
#pragma unroll
        for (int ai = 0; ai < 2; ++ai)
#pragma unroll
            for (int m = 0; m < 4; ++m) { bf16_t* rowp = base + (size_t)(row0 + ai * HALF + m * 16) * ldc + col0;
#pragma unroll
                for (int bj = 0; bj < 2; ++bj) { f32x4 v0 = acc[ai][bj][m][0] + bv[bj][0], v1 = acc[ai][bj][m][1] + bv[bj][1];
                    if (ACT == 1) { f32x2 a = gelu_pk((f32x2){v0[0], v0[1]}), b = gelu_pk((f32x2){v0[2], v0[3]}), c = gelu_pk((f32x2){v1[0], v1[1]}), d = gelu_pk((f32x2){v1[2], v1[3]});
                        v0 = (f32x4){a.x, a.y, b.x, b.y}; v1 = (f32x4){c.x, c.y, d.x, d.y}; }
                    v0 = v0 * sc; v1 = v1 * sc; u32x4 w; w.x = cvt_pk_bf16(v0[0], v0[1]); w.y = cvt_pk_bf16(v0[2], v0[3]); w.z = cvt_pk_bf16(v1[0], v1[1]); w.w = cvt_pk_bf16(v1[2], v1[3]);
                    *(u32x4*)(rowp + bj * HALF) = w; } }
    }
};
template <class Epi, class Sched, bool ALIGN_EPI = false, bool SP2 = false>
__device__ __forceinline__ void gemm_phase(int WV_, PG8_LAS unsigned char* lds, const Gemm g, const Sched& S, const Epi& E) {
    const int tid = LTID(WV_), wid = __builtin_amdgcn_readfirstlane(tid >> 6), lane = tid & 63, wr = wid >> 2, wc = wid & 3, fr = lane & 15, fq = lane >> 4;
    const int K = g.K, nt = K / BK;
    unsigned voffA[2], voffB[2];
#pragma unroll
    for (int i = 0; i < 2; ++i) { int R, C; stage_rc(tid * 16 + i * 8192, R, C); const int Rb = Epi::PERM ? ((R & ~31) + perm32(R & 31)) : R;
        voffA[i] = (unsigned)(R * K + C) * 2u; voffB[i] = (unsigned)(Rb * K + C) * 2u; }
    const size_t kstep = (size_t)(BK * 2);
    const size_t hstep = (size_t)HALF * K * 2;
    const size_t tstep = 2 * hstep;
    const unsigned ldsw = (unsigned)wid * 1024u;
    const int aoff = lds_byte(wr * 64 + fr, fq * 8), boff = lds_byte(wc * 32 + fr, fq * 8);
#define PG8_SA(b, h) (((b) * 2 + (h)) * HTB)
#define PG8_SB(b, h) ((4 + (b) * 2 + (h)) * HTB)
#define PG8_STAGE(bufoff, gbase, voff) do { _Pragma("unroll") for (int _i = 0; _i < 2; ++_i) \
        __builtin_amdgcn_global_load_lds((const unsigned*)((const char*)(gbase) + (voff)[_i]), (PG8_LAS unsigned*)(lds + (bufoff) + ldsw + _i * 8192), 16, 0, 0); } while (0)
#define PG8_LDA(dst, b, h) do { _Pragma("unroll") for (int m = 0; m < 4; ++m) _Pragma("unroll") for (int k = 0; k < 2; ++k) dst[m][k] = *(const PG8_LAS bf16x8*)(lds + PG8_SA(b, h) + aoff + m * 2048 + k * 1024); } while (0)
#define PG8_LDB(dst, b, h) do { _Pragma("unroll") for (int n = 0; n < 2; ++n) _Pragma("unroll") for (int k = 0; k < 2; ++k) dst[n][k] = *(const PG8_LAS bf16x8*)(lds + PG8_SB(b, h) + boff + n * 2048 + k * 1024); } while (0)
#define PG8_MMA(ai, bj, At, Bt) do { __builtin_amdgcn_s_setprio(1); _Pragma("unroll") for (int m = 0; m < 4; ++m) _Pragma("unroll") for (int n = 0; n < 2; ++n) _Pragma("unroll") for (int k = 0; k < 2; ++k) \
        acc[ai][bj][m][n] = __builtin_amdgcn_mfma_f32_16x16x32_bf16(Bt[n][k], At[m][k], acc[ai][bj][m][n], 0, 0, 0); __builtin_amdgcn_s_setprio(0); } while (0)
#define PG8_WAIT_V(n) asm volatile("s_waitcnt vmcnt(" #n ")" ::: "memory")
#define PG8_WAIT_L(n) asm volatile("s_waitcnt lgkmcnt(" #n ")" ::: "memory")
#define PG8_BAR __builtin_amdgcn_s_barrier()
#define PG8_SCHED __builtin_amdgcn_sched_barrier(0)
    Unit cur, nxt; int ui = 0;
    if (!S.next(0, cur)) return;
    f32x4 acc[2][2][4][2];
#pragma unroll
    for (int a = 0; a < 2; ++a)
#pragma unroll
        for (int b = 0; b < 2; ++b)
#pragma unroll
            for (int m = 0; m < 4; ++m)
#pragma unroll
                for (int n = 0; n < 2; ++n) acc[a][b][m][n] = (f32x4){0.f, 0.f, 0.f, 0.f};
    bf16x8 At[4][2], B0[2][2], B1[2][2];
    const char* cA = (const char*)g.A + (size_t)cur.pm * tstep; const char* cB = (const char*)g.Bt + (size_t)cur.pn * tstep;
    S.a_ready(cur);
    if constexpr (SP2) {
        PG8_STAGE(PG8_SB(0, 0), cB, voffB); PG8_STAGE(PG8_SB(0, 1), cB + hstep, voffB); PG8_STAGE(PG8_SA(0, 0), cA, voffA); PG8_STAGE(PG8_SA(0, 1), cA + hstep, voffA);
        if (wr == 1) PG8_BAR;
        PG8_WAIT_V(2); PG8_BAR;
        PG8_STAGE(PG8_SB(1, 0), cB + kstep, voffB); PG8_STAGE(PG8_SA(1, 0), cA + kstep, voffA); PG8_STAGE(PG8_SB(1, 1), cB + hstep + kstep, voffB);
        PG8_WAIT_V(6); PG8_BAR;
    } else {
        PG8_STAGE(PG8_SB(0, 0), cB, voffB); PG8_STAGE(PG8_SA(0, 0), cA, voffA); PG8_STAGE(PG8_SB(0, 1), cB + hstep, voffB); PG8_STAGE(PG8_SA(0, 1), cA + hstep, voffA);
        if (wr == 1) PG8_BAR;
        PG8_WAIT_V(4); PG8_BAR;
        PG8_STAGE(PG8_SB(1, 0), cB + kstep, voffB); PG8_STAGE(PG8_SA(1, 0), cA + kstep, voffA); PG8_STAGE(PG8_SB(1, 1), cB + hstep + kstep, voffB);
        PG8_WAIT_V(6); PG8_BAR;
    }
    for (;;) {
        const bool has_next = S.next(ui + 1, nxt);
        const char* nA = has_next ? (const char*)g.A + (size_t)nxt.pm * tstep : cA; const char* nB = has_next ? (const char*)g.Bt + (size_t)nxt.pn * tstep : cB;
        for (int t = 0; t < nt; t += 2) {
            const bool last = (t == nt - 2);
            const char* a1 = cA + (size_t)(t + 1) * kstep;
            const char* a2 = last ? nA : cA + (size_t)(t + 2) * kstep; const char* b2 = last ? nB : cB + (size_t)(t + 2) * kstep;
            const char* a3 = a2 + kstep; const char* b3 = b2 + kstep;
            if (last && has_next) S.a_ready(nxt);
            if constexpr (SP2) {
            PG8_LDB(B0, 0, 0); PG8_LDB(B1, 0, 1); PG8_SCHED; PG8_LDA(At, 0, 0); PG8_STAGE(PG8_SA(1, 1), a1 + hstep, voffA);
            PG8_WAIT_V(8); PG8_WAIT_L(0); PG8_BAR; PG8_MMA(0, 0, At, B0); PG8_MMA(0, 1, At, B1); PG8_BAR; PG8_SCHED;
            PG8_LDA(At, 0, 1); PG8_STAGE(PG8_SB(0, 0), b2, voffB); PG8_STAGE(PG8_SB(0, 1), b2 + hstep, voffB); PG8_STAGE(PG8_SA(0, 0), a2, voffA);
            PG8_WAIT_V(8); PG8_WAIT_L(0); PG8_BAR; PG8_MMA(1, 0, At, B0); PG8_MMA(1, 1, At, B1); PG8_BAR; PG8_SCHED;
            PG8_LDB(B0, 1, 0); PG8_LDB(B1, 1, 1); PG8_SCHED; PG8_LDA(At, 1, 0); PG8_STAGE(PG8_SA(0, 1), a2 + hstep, voffA);
            PG8_WAIT_V(8); PG8_WAIT_L(0); PG8_BAR; PG8_MMA(0, 0, At, B0); PG8_MMA(0, 1, At, B1); PG8_BAR; PG8_SCHED;
            PG8_LDA(At, 1, 1); PG8_STAGE(PG8_SB(1, 0), b3, voffB); PG8_STAGE(PG8_SB(1, 1), b3 + hstep, voffB); PG8_STAGE(PG8_SA(1, 0), a3, voffA);
            PG8_WAIT_V(8); PG8_WAIT_L(0); PG8_BAR; PG8_MMA(1, 0, At, B0); PG8_MMA(1, 1, At, B1); PG8_BAR; PG8_SCHED;
            } else {
            PG8_LDB(B0, 0, 0); PG8_SCHED; PG8_LDA(At, 0, 0); PG8_STAGE(PG8_SA(1, 1), a1 + hstep, voffA);
            PG8_WAIT_L(8); PG8_BAR; PG8_WAIT_L(0); PG8_MMA(0, 0, At, B0); PG8_BAR; PG8_SCHED;
            PG8_LDB(B1, 0, 1); PG8_STAGE(PG8_SB(0, 0), b2, voffB);
            PG8_BAR; PG8_WAIT_L(0); PG8_MMA(0, 1, At, B1); PG8_BAR;
            PG8_LDA(At, 0, 1); PG8_STAGE(PG8_SA(0, 0), a2, voffA);
            PG8_BAR; PG8_WAIT_L(0); PG8_MMA(1, 0, At, B0); PG8_BAR; PG8_SCHED;
            PG8_STAGE(PG8_SB(0, 1), b2 + hstep, voffB);
            PG8_WAIT_V(6); PG8_BAR; PG8_MMA(1, 1, At, B1); PG8_BAR;
            PG8_LDB(B0, 1, 0); PG8_SCHED; PG8_LDA(At, 1, 0); PG8_STAGE(PG8_SA(0, 1), a2 + hstep, voffA);
            PG8_WAIT_L(8); PG8_BAR; PG8_WAIT_L(0); PG8_MMA(0, 0, At, B0); PG8_BAR; PG8_SCHED;
            PG8_LDB(B1, 1, 1); PG8_STAGE(PG8_SB(1, 0), b3, voffB);
            PG8_BAR; PG8_WAIT_L(0); PG8_MMA(0, 1, At, B1); PG8_BAR;
            PG8_LDA(At, 1, 1); PG8_STAGE(PG8_SA(1, 0), a3, voffA);
            PG8_BAR; PG8_WAIT_L(0); PG8_MMA(1, 0, At, B0); PG8_BAR; PG8_SCHED;
            PG8_STAGE(PG8_SB(1, 1), b3 + hstep, voffB);
            PG8_WAIT_V(6); PG8_BAR; PG8_MMA(1, 1, At, B1); PG8_BAR;
            }
        }
        if constexpr (ALIGN_EPI) { if (wr == 0) PG8_BAR; }
        if constexpr (!Epi::AFTER_DRAIN) { E(acc, cur, wr, wc, fr, fq); S.done(cur); }
        if (!has_next) break;
#pragma unroll
        for (int a = 0; a < 2; ++a)
#pragma unroll
            for (int b = 0; b < 2; ++b)
#pragma unroll
                for (int m = 0; m < 4; ++m)
#pragma unroll
                    for (int n = 0; n < 2; ++n) acc[a][b][m][n] = (f32x4){0.f, 0.f, 0.f, 0.f};
        cur = nxt; cA = nA; cB = nB; ++ui;
        if constexpr (ALIGN_EPI) { if (wr == 1) PG8_BAR; }
    }
    PG8_WAIT_V(0);
    if constexpr (!ALIGN_EPI) { if (wr == 0) PG8_BAR; }
    PG8_BAR;
    if constexpr (Epi::AFTER_DRAIN) { E.fused(acc, cur, wr, wc, fr, fq, lds, wid, lane); S.done(cur); }
#undef PG8_SA
#undef PG8_SB
#undef PG8_STAGE
#undef PG8_LDA
#undef PG8_LDB
#undef PG8_MMA
#undef PG8_WAIT_V
#undef PG8_WAIT_L
#undef PG8_BAR
#undef PG8_SCHED
}
}
namespace pg8 {
struct EpiF32 {
    static constexpr bool PERM = false, AFTER_DRAIN = false;
    float* O; int ldc;
    __device__ __forceinline__ void operator()(const f32x4 (&acc)[2][2][4][2], const Unit& u, int wr, int wc, int fr, int fq) const {
        { int ln_ = LANEID(); asm volatile("" : "+v"(ln_)); fr = ln_ & 15; fq = ln_ >> 4; }
        const int row0 = u.pm * BM + wr * 64 + fr, col0 = u.pn * BM + wc * 32 + 4 * fq;
#pragma unroll
        for (int ai = 0; ai < 2; ++ai)
#pragma unroll
            for (int m = 0; m < 4; ++m) { float* rowp = O + (size_t)(row0 + ai * HALF + m * 16) * ldc + col0;
#pragma unroll
                for (int bj = 0; bj < 2; ++bj)
#pragma unroll
                    for (int n = 0; n < 2; ++n) *(f32x4*)(rowp + bj * HALF + n * 16) = acc[ai][bj][m][n]; }
    }
};
struct EpiResY {
    static constexpr bool PERM = false, AFTER_DRAIN = false;
    const float* hin; float* yout; bf16_t* yb; float* stats; float alpha;
    __device__ __forceinline__ void operator()(const f32x4 (&acc)[2][2][4][2], const Unit& u, int wr, int wc, int fr, int fq) const {
        { int ln_ = LANEID(); asm volatile("" : "+v"(ln_)); fr = ln_ & 15; fq = ln_ >> 4; }
        const int row0 = u.pm * BM + wr * 64 + fr, col0 = u.pn * BM + wc * 32 + 4 * fq;
#pragma unroll
        for (int ai = 0; ai < 2; ++ai)
#pragma unroll
            for (int m = 0; m < 4; ++m) {
                const int row = row0 + ai * HALF + m * 16;
                float s = 0.f, s2 = 0.f;
#pragma unroll
                for (int bj = 0; bj < 2; ++bj)
#pragma unroll
                    for (int n = 0; n < 2; ++n) {
                        const size_t off = (size_t)row * 1024 + col0 + bj * HALF + n * 16;
                        const f32x4 hv = *(const f32x4*)(hin + off);
                        const f32x4 y = hv * alpha + acc[ai][bj][m][n];
                        *(f32x4*)(yout + off) = y;
                        typedef unsigned u32x2v __attribute__((ext_vector_type(2)));
                        u32x2v w; w.x = cvt_pk_bf16(y[0], y[1]); w.y = cvt_pk_bf16(y[2], y[3]);
                        *(u32x2v*)(yb + off) = w;
                        s += (y[0] + y[1]) + (y[2] + y[3]); s2 += (y[0] * y[0] + y[1] * y[1]) + (y[2] * y[2] + y[3] * y[3]);
                    }
                s += __shfl_xor(s, 16); s += __shfl_xor(s, 32); s2 += __shfl_xor(s2, 16); s2 += __shfl_xor(s2, 32);
                if (fq == 0) { atomicAdd(stats + 2 * (size_t)row, s); atomicAdd(stats + 2 * (size_t)row + 1, s2); }
            }
    }
};
struct EpiLnFold {
    static constexpr bool PERM = true, AFTER_DRAIN = false;
    bf16_t* O; const float* stats; const float* colsum; const float* colbias; float eps;
    __device__ __forceinline__ void operator()(const f32x4 (&acc)[2][2][4][2], const Unit& u, int wr, int wc, int fr, int fq) const {
        { int ln_ = LANEID(); asm volatile("" : "+v"(ln_)); fr = ln_ & 15; fq = ln_ >> 4; }
        const int row0 = u.pm * BM + wr * 64 + fr, col0 = u.pn * BM + wc * 32 + 8 * fq;
        f32x4 cs[2][2], cb[2][2];
#pragma unroll
        for (int bj = 0; bj < 2; ++bj)
#pragma unroll
            for (int n = 0; n < 2; ++n) { cs[bj][n] = *(const f32x4*)(colsum + col0 + bj * HALF + 4 * n); cb[bj][n] = *(const f32x4*)(colbias + col0 + bj * HALF + 4 * n); }
#pragma unroll
        for (int ai = 0; ai < 2; ++ai)
#pragma unroll
            for (int m = 0; m < 4; ++m) {
                const int row = row0 + ai * HALF + m * 16;
                const float sm_ = stats[2 * (size_t)row], sq_ = stats[2 * (size_t)row + 1];
                const float mean = sm_ * (1.0f / 1024.0f);
                const float rstd = 1.0f / sqrtf(fmaxf(sq_ * (1.0f / 1024.0f) - mean * mean, 0.f) + eps);
                bf16_t* rowp = O + (size_t)row * 1024 + col0;
#pragma unroll
                for (int bj = 0; bj < 2; ++bj) {
                    const f32x4 v0 = (acc[ai][bj][m][0] - cs[bj][0] * mean) * rstd + cb[bj][0], v1 = (acc[ai][bj][m][1] - cs[bj][1] * mean) * rstd + cb[bj][1];
                    u32x4 w; w.x = cvt_pk_bf16(v0[0], v0[1]); w.y = cvt_pk_bf16(v0[2], v0[3]); w.z = cvt_pk_bf16(v1[0], v1[1]); w.w = cvt_pk_bf16(v1[2], v1[3]);
                    *(u32x4*)(rowp + bj * HALF) = w;
                }
            }
    }
};
__device__ __forceinline__ unsigned cvt_pk_bf16_t(float lo, float hi) { unsigned r; asm volatile("s_nop 0\n\tv_cvt_pk_bf16_f32 %0, %1, %2" : "=v"(r) : "v"(lo), "v"(hi)); return r; }
struct EpiBf16Sig {
    static constexpr bool PERM = true, AFTER_DRAIN = false;
    bf16_t* O; int ldc; int sig_col0;
    __device__ __forceinline__ void operator()(const f32x4 (&acc)[2][2][4][2], const Unit& u, int wr, int wc, int fr, int fq) const {
        { int ln_ = LANEID(); asm volatile("" : "+v"(ln_)); fr = ln_ & 15; fq = ln_ >> 4; }
        const int row0 = u.pm * BM + wr * 64 + fr; const int col0 = u.pn * BM + wc * 32 + 8 * fq;
#pragma unroll
        for (int bj = 0; bj < 2; ++bj) {
            if (col0 + bj * HALF >= sig_col0) {
#pragma unroll
                for (int ai = 0; ai < 2; ++ai)
#pragma unroll
                    for (int m = 0; m < 4; ++m) { bf16_t* rowp = O + (size_t)(row0 + ai * HALF + m * 16) * ldc + col0;
                        f32x4 v0 = acc[ai][bj][m][0], v1 = acc[ai][bj][m][1];
#pragma unroll
                        for (int e = 0; e < 4; ++e) { v0[e] = __builtin_amdgcn_rcpf(1.f + __builtin_amdgcn_exp2f(-1.44269504f * v0[e])); v1[e] = __builtin_amdgcn_rcpf(1.f + __builtin_amdgcn_exp2f(-1.44269504f * v1[e])); }
                        u32x4 w; w.x = cvt_pk_bf16_t(v0[0], v0[1]); w.y = cvt_pk_bf16_t(v0[2], v0[3]); w.z = cvt_pk_bf16_t(v1[0], v1[1]); w.w = cvt_pk_bf16_t(v1[2], v1[3]);
                        *(u32x4*)(rowp + bj * HALF) = w; }
            } else {
#pragma unroll
                for (int ai = 0; ai < 2; ++ai)
#pragma unroll
                    for (int m = 0; m < 4; ++m) { bf16_t* rowp = O + (size_t)(row0 + ai * HALF + m * 16) * ldc + col0;
                        const f32x4 v0 = acc[ai][bj][m][0], v1 = acc[ai][bj][m][1];
                        u32x4 w; w.x = cvt_pk_bf16(v0[0], v0[1]); w.y = cvt_pk_bf16(v0[2], v0[3]); w.z = cvt_pk_bf16(v1[0], v1[1]); w.w = cvt_pk_bf16(v1[2], v1[3]);
                        *(u32x4*)(rowp + bj * HALF) = w; }
            }
        }
    }
};
}

typedef unsigned short bf16;
constexpr int T_ = 16384, S_ = 4096, NBATCH = 4, D_ = 1024, NCOL = 6824, NP = 6912, DEPTH_ = 2;
constexpr int C_QA = 0, C_KA = 256, C_VA = 320, C_QI = 384, C_KI = 640, C_WI = 672, C_QB = 680, C_KB = 936, C_VB = 1064,
              C_QC = 1192, C_KC = 1448, C_VC = 1704, C_QD = 1960, C_KD = 2216, C_VD = 2472, C_G = 2728;
constexpr int NTHR = 512, NWAVE = 8;
constexpr float ALPHA = 1.41421356237309515f;
constexpr float LN_EPS = 1e-5f;
constexpr size_t MiB = 1u << 20;
constexpr size_t WS_STATS = 1 * MiB  , WS_COLS = 1 * MiB + 512 * 1024  ;
constexpr size_t WS_CTL = 0, WS_WIN_T = 2 * MiB, WS_WOUT_T = 30 * MiB, WS_WQ_T = 34 * MiB, WS_WBR_T = 38 * MiB, WS_HB = 42 * MiB,
                 WS_P = 74 * MiB, WS_MIX = 74 * MiB  , WS_Q = 138 * MiB  , WS_YS = 290 * MiB, WS_MRG = 322 * MiB,
                 WS_MASK = 354 * MiB, WS_EID = 362 * MiB, WS_GATE = 370 * MiB, WS_KMEAN = 378 * MiB, WS_SKB = 379 * MiB, WS_UV = 380 * MiB, WS_END = 508 * MiB;
constexpr size_t WIN_T_BYTES = (size_t)NP * 1024 * 2;
constexpr int LDS_BYTES = 144 * 1024;

struct Params { const float* in[13]; float* out; unsigned char* ws; };

__device__ __forceinline__ float bf2f(bf16 v) { return __uint_as_float((unsigned)v << 16); }
__device__ __forceinline__ unsigned f2bf(float f) { unsigned u = __float_as_uint(f); return (u + 0x7fffu + ((u >> 16) & 1u)) >> 16; }
__device__ __forceinline__ unsigned pk2(float lo, float hi) { return f2bf(lo) | (f2bf(hi) << 16); }
__device__ __forceinline__ void unpack8(const uint4 v, float* o) {
    o[0] = __uint_as_float(v.x << 16); o[1] = __uint_as_float(v.x & 0xffff0000u); o[2] = __uint_as_float(v.y << 16); o[3] = __uint_as_float(v.y & 0xffff0000u);
    o[4] = __uint_as_float(v.z << 16); o[5] = __uint_as_float(v.z & 0xffff0000u); o[6] = __uint_as_float(v.w << 16); o[7] = __uint_as_float(v.w & 0xffff0000u);
}
__device__ __forceinline__ float wave_sum(float v) {
#pragma unroll
    for (int o = 32; o > 0; o >>= 1) v += __shfl_xor(v, o);
    return v;
}
__device__ __forceinline__ float wave_max(float v) {
#pragma unroll
    for (int o = 32; o > 0; o >>= 1) v = fmaxf(v, __shfl_xor(v, o));
    return v;
}
__device__ __forceinline__ int wave_sum_i(int v) {
#pragma unroll
    for (int o = 32; o > 0; o >>= 1) v += __shfl_xor(v, o);
    return v;
}
__device__ __forceinline__ float logsig(float x) { return fminf(x, 0.f) - log1pf(expf(-fabsf(x))); }

__device__ void transpose_items(int WV_, const float* W, int K, int N, bf16* WT, float* sm, int item0, int nitems_total, int item_stride,
                                const float* rs_g = nullptr, const float* rs_b = nullptr, float* colsum = nullptr, float* colbias = nullptr) {
    const int tid = LTID(WV_);
    const int nkb = K / 64, nnb = (N + 63) / 64;
    for (int it = item0; it < nkb * nnb; it += item_stride) {
        const int kb = it % nkb, nb = it / nkb, k0 = kb * 64, n0 = nb * 64;
        __syncthreads();
        for (int e = tid; e < 64 * 64; e += NTHR) { const int kk = e >> 6, nn = e & 63; sm[kk * 65 + nn] = (n0 + nn < N) ? W[(size_t)(k0 + kk) * N + n0 + nn] : 0.f; }
        __syncthreads();
        if (rs_g) {
            if (tid < 64) { float cs = 0.f, cb = 0.f;
                for (int kk = 0; kk < 64; ++kk) { const float w = sm[kk * 65 + tid]; cs += w * rs_g[k0 + kk]; cb += w * rs_b[k0 + kk]; }
                atomicAdd(colsum + n0 + tid, cs); atomicAdd(colbias + n0 + tid, cb); }
            __syncthreads();
            for (int e = tid; e < 64 * 64; e += NTHR) { const int kk = e >> 6, nn = e & 63; sm[kk * 65 + nn] *= rs_g[k0 + kk]; }
            __syncthreads();
        }
        { const int nn = tid >> 3, c = tid & 7;
          if (n0 + nn < N) { uint4 o; o.x = pk2(sm[(8 * c + 0) * 65 + nn], sm[(8 * c + 1) * 65 + nn]); o.y = pk2(sm[(8 * c + 2) * 65 + nn], sm[(8 * c + 3) * 65 + nn]);
              o.z = pk2(sm[(8 * c + 4) * 65 + nn], sm[(8 * c + 5) * 65 + nn]); o.w = pk2(sm[(8 * c + 6) * 65 + nn], sm[(8 * c + 7) * 65 + nn]);
              *(uint4*)(WT + (size_t)(n0 + nn) * K + k0 + 8 * c) = o; } }
    }
    __syncthreads();
}
__device__ void prologue_phase(int WV_, const Params& p, float* sm) {
    const int tid = LTID(WV_), B = LBID(), G = LGRID();
    unsigned char* ws = p.ws;
    for (int l = 0; l < DEPTH_; ++l) {
        bf16* win_t = (bf16*)(ws + WS_WIN_T + l * WIN_T_BYTES);
        transpose_items(WV_, p.in[1] + (size_t)l * 1024 * NCOL, 1024, NCOL, win_t, sm, B, 0, G);
        for (int i = B * NTHR + tid; i < (NP - NCOL) * 1024 / 8; i += G * NTHR) ((uint4*)(win_t + (size_t)NCOL * 1024))[i] = make_uint4(0u, 0u, 0u, 0u);
        transpose_items(WV_, p.in[3] + (size_t)l * 1024 * 1024, 1024, 1024, (bf16*)(ws + WS_WOUT_T) + (size_t)l * 1024 * 1024, sm, B, 0, G);
        transpose_items(WV_, p.in[7] + (size_t)l * 1024 * 1024, 1024, 1024, (bf16*)(ws + WS_WQ_T) + (size_t)l * 1024 * 1024, sm, B, 0, G,
                        p.in[5] + l * 1024, p.in[6] + l * 1024, (float*)(ws + WS_COLS) + l * 2048, (float*)(ws + WS_COLS) + l * 2048 + 1024);
        for (int n = 0; n < 4; ++n)
            transpose_items(WV_, p.in[2] + ((size_t)l * 4 + n) * 256 * 1024, 256, 1024, (bf16*)(ws + WS_WBR_T) + ((size_t)l * 4 + n) * 1024 * 256, sm, B, 0, G);
    }
    const float4* x4 = (const float4*)p.in[0]; uint2* hb2 = (uint2*)(ws + WS_HB);
    for (size_t i = (size_t)B * NTHR + tid; i < (size_t)T_ * 1024 / 4; i += (size_t)G * NTHR) { const float4 v = x4[i]; hb2[i] = make_uint2(pk2(v.x, v.y), pk2(v.z, v.w)); }
}

__device__ __forceinline__ void ln_row(float4 (&v)[4], const float* g, const float* bb, float* orow, bf16* obrow, int lane) {
    float s = 0.f;
#pragma unroll
    for (int j = 0; j < 4; ++j) s += (v[j].x + v[j].y) + (v[j].z + v[j].w);
    const float mean = wave_sum(s) * (1.0f / 1024.0f);
    float s2 = 0.f;
#pragma unroll
    for (int j = 0; j < 4; ++j) { v[j].x -= mean; v[j].y -= mean; v[j].z -= mean; v[j].w -= mean; s2 += (v[j].x * v[j].x + v[j].y * v[j].y) + (v[j].z * v[j].z + v[j].w * v[j].w); }
    const float rstd = 1.0f / sqrtf(wave_sum(s2) * (1.0f / 1024.0f) + LN_EPS);
#pragma unroll
    for (int j = 0; j < 4; ++j) {
        const float4 gg = ((const float4*)g)[j * 64 + lane], b4 = ((const float4*)bb)[j * 64 + lane];
        float4 o; o.x = v[j].x * rstd * gg.x + b4.x; o.y = v[j].y * rstd * gg.y + b4.y; o.z = v[j].z * rstd * gg.z + b4.z; o.w = v[j].w * rstd * gg.w + b4.w;
        ((float4*)orow)[j * 64 + lane] = o;
        ((uint2*)obrow)[j * 64 + lane] = make_uint2(pk2(o.x, o.y), pk2(o.z, o.w));
    }
}
__device__ void ln1_phase(int WV_, const float* hin, const float* add, const float* g, const float* bb, float* hout, bf16* hb) {
    const int lane = LTID(WV_) & 63, wave = LTID(WV_) >> 6;
    for (int row = LBID() * NWAVE + wave; row < T_; row += LGRID() * NWAVE) {
        float4 v[4];
#pragma unroll
        for (int j = 0; j < 4; ++j) {
            const float4 a = ((const float4*)(hin + (size_t)row * 1024))[j * 64 + lane], m = ((const float4*)(add + (size_t)row * 1024))[j * 64 + lane];
            v[j].x = ALPHA * a.x + m.x; v[j].y = ALPHA * a.y + m.y; v[j].z = ALPHA * a.z + m.z; v[j].w = ALPHA * a.w + m.w;
        }
        ln_row(v, g, bb, hout + (size_t)row * 1024, hb + (size_t)row * 1024, lane);
    }
}


typedef short bf16x8_t __attribute__((ext_vector_type(8)));
typedef float f32x16_t __attribute__((ext_vector_type(16)));
typedef float f32x2_t __attribute__((ext_vector_type(2)));
typedef __bf16 bf16x2_t __attribute__((ext_vector_type(2)));
__device__ __forceinline__ unsigned cvtpk(float lo, float hi) { f32x2_t v = {lo, hi}; bf16x2_t b = __builtin_convertvector(v, bf16x2_t); return __builtin_bit_cast(unsigned, b); }
__device__ __forceinline__ int crow(int r, int hi) { return (r & 3) + 8 * (r >> 2) + 4 * hi; }
__device__ __forceinline__ float xlane32(float v) { return __shfl_xor(v, 32); }
__device__ __forceinline__ float vmax(float a, float b) { float r; asm("v_max_f32_e32 %0, %1, %2" : "=v"(r) : "v"(a), "v"(b)); return r; }
__device__ __forceinline__ float vmin(float a, float b) { float r; asm("v_min_f32_e32 %0, %1, %2" : "=v"(r) : "v"(a), "v"(b)); return r; }
__device__ __forceinline__ float vmax3(float a, float b, float c) { float r; asm("v_max3_f32 %0, %1, %2, %3" : "=v"(r) : "v"(a), "v"(b), "v"(c)); return r; }

constexpr int AT_KP = 72, AT_VP = 96;
constexpr int AT_KS = 0, AT_KS_BYTES = 64 * AT_KP * 2;
constexpr int AT_VT = 2 * AT_KS_BYTES, AT_VT_BYTES = 64 * AT_VP * 2;
constexpr int AT_KM = AT_VT + 2 * AT_VT_BYTES;
constexpr int AT_MISC = AT_KM + 32 * AT_KP * 2;
constexpr float LOG2E = 1.4426950408889634f;

__device__ __forceinline__ unsigned mk_unit(int kind, int b, int x, int y) { return ((unsigned)kind << 30) | ((unsigned)b << 28) | ((unsigned)x << 8) | (unsigned)y; }
__device__ void build_unit_table(unsigned* tab, int i) {
    int n = 0; unsigned res = 0u;
#pragma unroll 1
    for (int c = 64; c >= 1; --c) {
        if (i >= n && i < n + 4) res = mk_unit(0, i - n, 0, c - 1);
        n += 4;
        if ((c & 3) == 0) { if (i >= n && i < n + 16) { const int j = i - n; res = mk_unit(2, j >> 2, j & 3, c / 4 - 1); } n += 16; }
    }
    if (i < 512) tab[i] = res;
}

template <int kind> __device__ __forceinline__ void attn_unit(int WV_, const bf16* P, const unsigned char* mask, const float* kmean, const float* sinks, bf16* ys,
                                unsigned char* lds, int b, int ux, int uy) {
    int tid_ = LTID(WV_); asm volatile("" : "+v"(tid_));
    const int tid = tid_, lane = tid & 63, wave = __builtin_amdgcn_readfirstlane(tid >> 6), r32 = lane & 31, hi = lane >> 5;
    bf16* s_km = (bf16*)(lds + AT_KM);
    const int skey = tid >> 3, sc = tid & 7;
    {
        const bf16* Pb = P + (size_t)b * S_ * NP;
        int q0w, qcol, kcol, vcol, ycol, kt_hi, kt_lo; float slope2 = 0.f, sink2 = 0.f;
        if (kind == 0) { const int head = wave >> 1; q0w = uy * 64 + (wave & 1) * 32; qcol = C_QA + head * 64; kcol = C_KA; vcol = C_VA; ycol = head * 64;
            slope2 = exp2f(-8.0f * (float)(3 * head + 1) / 12.0f) * LOG2E; kt_hi = uy; kt_lo = 0; }
        else if (kind == 1) { const int hq = ux * 2 + (wave >> 2); q0w = uy * 128 + (wave & 3) * 32; qcol = C_QB + hq * 64; kcol = C_KB + ux * 64; vcol = C_VB + ux * 64; ycol = 256 + hq * 64;
            slope2 = exp2f(-8.0f * (float)(3 * hq + 2) / 12.0f) * LOG2E; sink2 = sinks[hq] * LOG2E; kt_hi = 2 * uy + 1; kt_lo = (2 * uy - 2 > 0) ? 2 * uy - 2 : 0; }
        else if (kind == 2) { q0w = uy * 256 + wave * 32; qcol = C_QC + ux * 64; kcol = C_KC + ux * 64; vcol = C_VC + ux * 64; ycol = 512 + ux * 64;
            slope2 = exp2f(-8.0f * (float)(3 * ux + 3) / 12.0f) * LOG2E; kt_hi = 4 * uy + 3; kt_lo = 0; }
        else { q0w = uy * 256 + wave * 32; qcol = C_QD + ux * 64; kcol = C_KD + ux * 64; vcol = C_VD + ux * 64; ycol = 768 + ux * 64; kt_hi = 4 * uy + 3; kt_lo = 0; }
        const int qpos = q0w + r32;
        bf16x8_t qf[4];
        { const bf16* qp = Pb + (size_t)qpos * NP + qcol + 8 * hi;
#pragma unroll
          for (int ks = 0; ks < 4; ++ks) qf[ks] = *(const bf16x8_t*)(qp + 16 * ks); }
        {
            const float qs = (kind == 3) ? 0.125f : 0.125f * LOG2E;
            typedef unsigned u32x4_t __attribute__((ext_vector_type(4)));
#pragma unroll
            for (int ks = 0; ks < 4; ++ks) { u32x4_t w = __builtin_bit_cast(u32x4_t, qf[ks]);
#pragma unroll
                for (int i = 0; i < 4; ++i) w[i] = cvtpk(__uint_as_float(w[i] << 16) * qs, __uint_as_float(w[i] & 0xffff0000u) * qs);
                qf[ks] = __builtin_bit_cast(bf16x8_t, w); }
        }
        float sb[16];
#pragma unroll
        for (int r = 0; r < 16; ++r) sb[r] = slope2 * (float)((r & 3) + 8 * (r >> 2));
        unsigned bm = 0u;
        if (kind == 2) {
            const int own = uy;
            for (int e = tid; e < 32 * 64; e += NTHR) { const int row = e >> 6, d = e & 63; s_km[row * AT_KP + d] = (row < 16) ? (bf16)f2bf(kmean[((b * 4 + ux) * 16 + row) * 64 + d]) : (bf16)0; }
            __syncthreads();
            f32x16_t gacc;
#pragma unroll
            for (int r = 0; r < 16; ++r) gacc[r] = 0.f;
#pragma unroll
            for (int ks = 0; ks < 4; ++ks) { const bf16x8_t a = *(const bf16x8_t*)(s_km + r32 * AT_KP + 16 * ks + 8 * hi); gacc = __builtin_amdgcn_mfma_f32_32x32x16_bf16(a, qf[ks], gacc, 0, 0, 0); }
            float gt[16];
#pragma unroll
            for (int r = 0; r < 8; ++r) { const float mine = gacc[r], other = xlane32(mine); const int bi = crow(r, 0);
                gt[bi] = hi ? other : mine; gt[bi + 4] = hi ? mine : other; }
#pragma unroll
            for (int n = 0; n < 16; ++n) if (n >= own) gt[n] = -INFINITY;
#pragma unroll
            for (int rep = 0; rep < 3; ++rep) {
                float mx = -INFINITY;
#pragma unroll
                for (int n = 0; n < 16; ++n) mx = fmaxf(mx, gt[n]);
                bool done = !(mx > -INFINITY);
#pragma unroll
                for (int n = 0; n < 16; ++n) { const bool hit = !done && gt[n] == mx; if (hit) { bm |= 1u << n; gt[n] = -INFINITY; done = true; } }
            }
        }
        f32x16_t o0, o1;
#pragma unroll
        for (int r = 0; r < 16; ++r) { o0[r] = 0.f; o1[r] = 0.f; }
        float m_run = -INFINITY, l_run = 0.f, carry = 0.f;
        const bf16* kg = Pb + (size_t)skey * NP + kcol + sc * 8;
        const bf16* vg = Pb + (size_t)skey * NP + vcol + sc * 8;
        uint4 rk = *(const uint4*)(kg + (size_t)kt_hi * 64 * NP), rv = *(const uint4*)(vg + (size_t)kt_hi * 64 * NP);
        int buf = 0;
        { bf16* ks_ = (bf16*)(lds + AT_KS); bf16* vt_ = (bf16*)(lds + AT_VT);
          *(uint4*)(ks_ + skey * AT_KP + sc * 8) = rk;
          *(uint4*)(vt_ + skey * AT_VP + sc * 8) = rv; }
        __syncthreads();
        bool wave_done = false;
        uint2 mw_next = make_uint2(0u, 0u);
        if (kind == 0) mw_next = *(const uint2*)(mask + (size_t)(b * S_ + qpos) * 512 + kt_hi * 8);
        for (int kt = kt_hi; kt >= kt_lo; --kt) {
            const bool more = kt > kt_lo;
            const uint2 mw = mw_next;
            if (kind == 0 && more) mw_next = *(const uint2*)(mask + (size_t)(b * S_ + qpos) * 512 + (kt - 1) * 8);
            if (more) { rk = *(const uint4*)(kg + (size_t)(kt - 1) * 64 * NP); rv = *(const uint4*)(vg + (size_t)(kt - 1) * 64 * NP); }
            const bf16* ks_ = (const bf16*)(lds + AT_KS + buf * AT_KS_BYTES);
            const bf16* vt_ = (const bf16*)(lds + AT_VT + buf * AT_VT_BYTES);
            bool active = (kt * 64 <= q0w + 31) && !wave_done;
            if (kind == 1) active = active && (kt * 64 + 63 >= q0w - 127);
            if (active) {
                const int kbase = kt * 64 + 4 * hi;
                f32x16_t p0, p1;
                if (kind != 3) {
                    const float cb = slope2 * (float)(kbase - qpos), cb1 = cb + 32.0f * slope2;
#pragma unroll
                    for (int r = 0; r < 16; ++r) { p0[r] = cb + sb[r]; p1[r] = cb1 + sb[r]; }
                } else {
#pragma unroll
                    for (int r = 0; r < 16; ++r) { p0[r] = 0.f; p1[r] = 0.f; }
                }
#pragma unroll
                for (int ks = 0; ks < 4; ++ks) {
                    const bf16x8_t a0 = *(const bf16x8_t*)(ks_ + r32 * AT_KP + 16 * ks + 8 * hi);
                    const bf16x8_t a1 = *(const bf16x8_t*)(ks_ + (32 + r32) * AT_KP + 16 * ks + 8 * hi);
                    p0 = __builtin_amdgcn_mfma_f32_32x32x16_bf16(a0, qf[ks], p0, 0, 0, 0);
                    p1 = __builtin_amdgcn_mfma_f32_32x32x16_bf16(a1, qf[ks], p1, 0, 0, 0);
                }
                if (kind != 3) {
                    float mx = -INFINITY;
                    if (kind == 0) {
                        const unsigned w0 = mw.x >> (4 * hi), w1 = mw.y >> (4 * hi);
#pragma unroll
                        for (int r = 0; r < 16; ++r) { const int off = (r & 3) + 8 * (r >> 2);
                            p0[r] = (w0 & (1u << off)) ? p0[r] : -INFINITY; p1[r] = (w1 & (1u << off)) ? p1[r] : -INFINITY; mx = vmax3(mx, p0[r], p1[r]); }
                    } else if (kind == 1) {
                        const int rel = qpos - kbase;
#pragma unroll
                        for (int r = 0; r < 16; ++r) { const int off = (r & 3) + 8 * (r >> 2);
                            p0[r] = ((unsigned)(rel - off) < 128u) ? p0[r] : -INFINITY; p1[r] = ((unsigned)(rel - off - 32) < 128u) ? p1[r] : -INFINITY; mx = vmax3(mx, p0[r], p1[r]); }
                    } else {
                        if ((kt >> 2) == uy) {
                            const int rel = qpos - kbase;
#pragma unroll
                            for (int r = 0; r < 16; ++r) { const int off = (r & 3) + 8 * (r >> 2);
                                p0[r] = (off <= rel) ? p0[r] : -INFINITY; p1[r] = (off + 32 <= rel) ? p1[r] : -INFINITY; mx = vmax3(mx, p0[r], p1[r]); }
                        } else {
                            const bool tile_ok = ((bm >> (kt >> 2)) & 1u) != 0u;
#pragma unroll
                            for (int r = 0; r < 16; ++r) { p0[r] = tile_ok ? p0[r] : -INFINITY; p1[r] = tile_ok ? p1[r] : -INFINITY; mx = vmax3(mx, p0[r], p1[r]); }
                        }
                    }
                    mx = vmax(mx, xlane32(mx));
                    const float m_new = vmax(m_run, mx);
                    const float m_safe = (m_new == -INFINITY) ? 0.f : m_new;
                    p0 = p0 - m_safe; p1 = p1 - m_safe;
#pragma unroll
                    for (int r = 0; r < 16; ++r) { p0[r] = __builtin_amdgcn_exp2f(p0[r]); p1[r] = __builtin_amdgcn_exp2f(p1[r]); }
                    float ls;
                    { typedef float f32x8_t __attribute__((ext_vector_type(8))); typedef float f32x4v_t __attribute__((ext_vector_type(4)));
                      const f32x16_t t16 = p0 + p1; const f32x8_t t8 = t16.lo + t16.hi; const f32x4v_t t4 = t8.lo + t8.hi; const f32x2_t t2 = t4.lo + t4.hi; ls = t2.x + t2.y; }
                    if (__any(m_new > m_run)) {
                        const float alpha = __builtin_amdgcn_exp2f(m_run - m_safe);
                        l_run *= alpha;
                        o0 = o0 * alpha; o1 = o1 * alpha;
                    }
                    l_run += ls; m_run = m_new;
                } else {
                    float run = carry;
#define SB_HALF(PX, KOFF) do { \
                    float lk[16]; \
                    _Pragma("unroll") for (int r = 0; r < 16; ++r) { \
                        const int off = (r & 3) + 8 * (r >> 2); \
                        const bool v = (kbase + off + (KOFF)) < qpos; \
                        const float z = PX[r]; \
                        const float t = 0.6931471805599453f * __builtin_amdgcn_logf(1.0f + __builtin_amdgcn_exp2f(-LOG2E * fabsf(z))); \
                        lk[r] = v ? (fminf(-z, 0.f) - t) : 0.f; \
                        PX[r] = v ? (fminf(z, 0.f) - t) : -INFINITY; } \
                    _Pragma("unroll") for (int g = 3; g >= 0; --g) { \
                        const float G = (lk[4 * g] + lk[4 * g + 1]) + (lk[4 * g + 2] + lk[4 * g + 3]); \
                        const float PG = xlane32(G); \
                        float la = run + (hi ? 0.f : PG); \
                        run += G + PG; \
                        PX[4 * g + 3] += la; la += lk[4 * g + 3]; PX[4 * g + 2] += la; la += lk[4 * g + 2]; PX[4 * g + 1] += la; la += lk[4 * g + 1]; PX[4 * g] += la; } \
                    _Pragma("unroll") for (int r = 0; r < 16; ++r) PX[r] = __builtin_amdgcn_exp2f(LOG2E * PX[r]); } while (0)
                    SB_HALF(p1, 32);
                    SB_HALF(p0, 0);
#undef SB_HALF
                    carry = run;
                }
                unsigned pw[16];
#pragma unroll
                for (int j = 0; j < 8; ++j) { pw[j] = cvtpk(p0[2 * j], p0[2 * j + 1]); pw[8 + j] = cvtpk(p1[2 * j], p1[2 * j + 1]); }
#pragma unroll
                for (int s = 0; s < 4; ++s) {
                    bf16x8_t pb; { const unsigned* q = pw + 4 * s; typedef unsigned u32x4_t __attribute__((ext_vector_type(4))); u32x4_t t4 = {q[0], q[1], q[2], q[3]}; pb = __builtin_bit_cast(bf16x8_t, t4); }
#pragma unroll
                    for (int dt = 0; dt < 2; ++dt) {
                        typedef short s16x4_t __attribute__((ext_vector_type(4)));
                        typedef __attribute__((address_space(3))) s16x4_t lds_s16x4;
                        const int gi_ = lane & 15;
                        const bf16* vp = vt_ + (16 * s + 4 * hi + (gi_ >> 2)) * AT_VP + 32 * dt + 16 * ((lane >> 4) & 1) + 4 * (gi_ & 3);
                        const s16x4_t lo = __builtin_amdgcn_ds_read_tr16_b64_v4i16((lds_s16x4*)vp), hi4 = __builtin_amdgcn_ds_read_tr16_b64_v4i16((lds_s16x4*)(vp + 8 * AT_VP));
                        const bf16x8_t va = {lo[0], lo[1], lo[2], lo[3], hi4[0], hi4[1], hi4[2], hi4[3]};
                        if (dt == 0) o0 = __builtin_amdgcn_mfma_f32_32x32x16_bf16(va, pb, o0, 0, 0, 0);
                        else         o1 = __builtin_amdgcn_mfma_f32_32x32x16_bf16(va, pb, o1, 0, 0, 0);
                    }
                }
            }
            if (kind == 3) {
                const float cm = carry;
                if (__all(cm < -110.0f) || !(kt * 64 <= q0w + 31) ) { if (__all(cm < -110.0f)) wave_done = true; }
            }
            if (more) {
                bf16* ksn = (bf16*)(lds + AT_KS + (buf ^ 1) * AT_KS_BYTES); bf16* vtn = (bf16*)(lds + AT_VT + (buf ^ 1) * AT_VT_BYTES);
                *(uint4*)(ksn + skey * AT_KP + sc * 8) = rk;
                *(uint4*)(vtn + skey * AT_VP + sc * 8) = rv;
            }
            if (kind == 3) { if (__syncthreads_and(wave_done ? 1 : 0)) break; }
            else __syncthreads();
            buf ^= 1;
        }
        float inv;
        if (kind == 3) inv = 1.0f;
        else {
            float lt = l_run + xlane32(l_run);
            if (kind == 1) { const float mf = fmaxf(m_run, sink2); const float sc2 = exp2f(m_run - mf); lt = lt * sc2 + exp2f(sink2 - mf); inv = sc2 / lt; }
            else inv = 1.0f / lt;
        }
        bf16* yp = ys + (size_t)(b * S_ + qpos) * 1024 + ycol + 4 * hi;
#pragma unroll
        for (int g = 0; g < 4; ++g) {
            *(uint2*)(yp + 8 * g) = make_uint2(cvtpk(o0[4 * g] * inv, o0[4 * g + 1] * inv), cvtpk(o0[4 * g + 2] * inv, o0[4 * g + 3] * inv));
            *(uint2*)(yp + 32 + 8 * g) = make_uint2(cvtpk(o1[4 * g] * inv, o1[4 * g + 1] * inv), cvtpk(o1[4 * g + 2] * inv, o1[4 * g + 3] * inv));
        }
    }
}
__device__ void attn_fast_phase(int WV_, const bf16* P, const unsigned char* mask, const float* kmean, const float* sinks, bf16* ys,
                                const unsigned* utab, unsigned* counter, unsigned char* lds) {
    volatile unsigned* s_unit = (volatile unsigned*)(lds + AT_MISC);
    for (;;) {
        __syncthreads();
        if (LTID(WV_) == 0) s_unit[0] = atomicAdd(counter, 1u);
        __syncthreads();
        const unsigned ui = s_unit[0];
        if (ui >= 512u) break;
        const unsigned ue = utab[ui];
        const int kind = (int)(ue >> 30), b = (int)((ue >> 28) & 3u), ux = (int)((ue >> 8) & 255u), uy = (int)(ue & 255u);
        if (kind == 0) attn_unit<0>(WV_, P, mask, kmean, sinks, ys, lds, b, ux, uy);
        else attn_unit<2>(WV_, P, mask, kmean, sinks, ys, lds, b, ux, uy);
    }
    for (int u = LBID(); u < 256; u += LGRID()) { __syncthreads(); attn_unit<3>(WV_, P, mask, kmean, sinks, ys, lds, u >> 6, (u >> 4) & 3, u & 15); }
    for (int u = LBID(); u < 256; u += LGRID()) { __syncthreads(); attn_unit<1>(WV_, P, mask, kmean, sinks, ys, lds, u >> 6, (u >> 5) & 1, u & 31); }
}

constexpr float U_SCALE = 128.0f, V_SCALE = 48.0f;
constexpr int ROW6 = 1536;
typedef float v32f_t __attribute__((ext_vector_type(32)));
typedef unsigned v6u_t __attribute__((ext_vector_type(6)));
typedef unsigned u32x4a8_t __attribute__((ext_vector_type(4), aligned(8)));
__device__ __forceinline__ float rdlane_f(float v, int l) { return __builtin_bit_cast(float, __builtin_amdgcn_readlane(__builtin_bit_cast(int, v), l)); }
__device__ __forceinline__ unsigned q_e2m3(float v) {
    const float a = fminf(fabsf(v), 7.5f);
    unsigned code;
    if (a < 1.0f) code = (unsigned)rintf(a * 8.0f);
    else if (a < 2.0f) code = 8u + (unsigned)rintf((a - 1.0f) * 8.0f);
    else if (a < 4.0f) code = 16u + (unsigned)rintf((a - 2.0f) * 4.0f);
    else code = 24u + (unsigned)rintf((a - 4.0f) * 2.0f);
    return code | (v < 0.f ? 32u : 0u);
}
__device__ void convert_tables(int WV_, const Params& p) {
    const size_t nchunk = (size_t)DEPTH_ * 16384 * 2 * 32;
    for (size_t i = (size_t)LBID() * NTHR + LTID(WV_); i < nchunk; i += (size_t)LGRID() * NTHR) {
        const int c = (int)(i & 31), uvsel = (int)((i >> 5) & 1); const size_t le = i >> 6;
        const float* src = (uvsel ? p.in[10] : p.in[9]) + le * 1024 + c * 32;
        const float sc = uvsel ? V_SCALE : U_SCALE;
        unsigned w[6] = {0u, 0u, 0u, 0u, 0u, 0u};
#pragma unroll
        for (int q4 = 0; q4 < 8; ++q4) {
            const float4 a = ((const float4*)src)[q4];
            const float av[4] = {a.x, a.y, a.z, a.w};
#pragma unroll
            for (int e = 0; e < 4; ++e) { const int idx = q4 * 4 + e, bit = 6 * idx, d = bit >> 5, s = bit & 31; const unsigned code = q_e2m3(av[e] * sc);
                w[d] |= code << s; if (s > 26) w[d + 1] |= code >> (32 - s); }
        }
        uint2* dst = (uint2*)(p.ws + WS_UV + le * ROW6 + uvsel * 768 + c * 24);
        dst[0] = make_uint2(w[0], w[1]); dst[1] = make_uint2(w[2], w[3]); dst[2] = make_uint2(w[4], w[5]);
    }
}
__device__ __forceinline__ v6u_t ld_pk6(const unsigned char* ptr) {
    const uint2 a = ((const uint2*)ptr)[0], b = ((const uint2*)ptr)[1], c = ((const uint2*)ptr)[2];
    const v6u_t pk = {a.x, a.y, b.x, b.y, c.x, c.y};
    return pk;
}
__device__ void peer_fast_phase(int WV_, float* h, bf16* hb, const int* eid, const float* gate, const unsigned char* uv, const float* g1, const float* b1, const float* g, const float* bb, unsigned char* lds) {
    const int tid = LTID(WV_), lane = tid & 63, wave = tid >> 6, l32 = lane & 31, hi = lane >> 5;
    float* pl = (float*)(lds + wave * 16384);
    unsigned char* raw = lds + wave * 16384 + 4096 + lane * 24;
    for (int t = LBID() * NWAVE + wave; t < T_; t += LGRID() * NWAVE) {
        float* hr = h + (size_t)t * 1024 + l32 * 32;
        float x[32], acc[32];
#pragma unroll
        for (int q4 = 0; q4 < 8; ++q4) { const float4 a = ((const float4*)hr)[q4]; x[4 * q4] = a.x; x[4 * q4 + 1] = a.y; x[4 * q4 + 2] = a.z; x[4 * q4 + 3] = a.w; }
        {
            float s = 0.f;
#pragma unroll
            for (int i = 0; i < 32; ++i) s += x[i];
#pragma unroll
            for (int o = 16; o > 0; o >>= 1) s += __shfl_xor(s, o);
            const float mean = s * (1.0f / 1024.0f);
            float s2 = 0.f;
#pragma unroll
            for (int i = 0; i < 32; ++i) { x[i] -= mean; s2 += x[i] * x[i]; }
#pragma unroll
            for (int o = 16; o > 0; o >>= 1) s2 += __shfl_xor(s2, o);
            const float rstd = 1.0f / sqrtf(s2 * (1.0f / 1024.0f) + LN_EPS);
#pragma unroll
            for (int q4 = 0; q4 < 8; ++q4) { const float4 gg = ((const float4*)(g1 + l32 * 32))[q4], cc = ((const float4*)(b1 + l32 * 32))[q4];
                x[4 * q4] = x[4 * q4] * rstd * gg.x + cc.x; x[4 * q4 + 1] = x[4 * q4 + 1] * rstd * gg.y + cc.y; x[4 * q4 + 2] = x[4 * q4 + 2] * rstd * gg.z + cc.z; x[4 * q4 + 3] = x[4 * q4 + 3] * rstd * gg.w + cc.w; }
        }
#pragma unroll
        for (int i = 0; i < 32; ++i) acc[i] = 0.f;
#pragma unroll 1
        for (int batch = 0; batch < 4; ++batch) {
            const int my_eid = eid[(size_t)t * 128 + batch * 32 + l32];
            const float my_gate = gate[(size_t)t * 128 + batch * 32 + l32];
#pragma unroll 1
            for (int grp = 0; grp < 2; ++grp) {
                { u32x4a8_t pa[8]; uint2 pc[8];
#pragma unroll
                  for (int i = 0; i < 8; ++i) { const int id = __shfl(my_eid, 2 * (grp * 8 + i) + hi); const unsigned char* rp = uv + (size_t)id * ROW6 + l32 * 24; pa[i] = *(const u32x4a8_t*)rp; pc[i] = *(const uint2*)(rp + 16); }
#pragma unroll
                  for (int i = 0; i < 8; ++i) { uint2* wp = (uint2*)(raw + i * 1536); wp[0] = make_uint2(pa[i].x, pa[i].y); wp[1] = make_uint2(pa[i].z, pa[i].w); wp[2] = pc[i]; } }
#pragma unroll 1
                for (int i = 0; i < 8; ++i) {
                    const uint2* rp = (const uint2*)(raw + i * 1536); const uint2 a = rp[0], b = rp[1], c = rp[2];
                    const v6u_t pk6 = {a.x, a.y, b.x, b.y, c.x, c.y}; const v32f_t f = __builtin_amdgcn_cvt_scalef32_pk32_f32_fp6(pk6, 1.0f);
                    f32x2_t dv0 = {0.f, 0.f}, dv1 = {0.f, 0.f};
#pragma unroll
                    for (int j = 0; j < 8; ++j) { const f32x2_t fa = {f[2 * j], f[2 * j + 1]}, fb = {f[16 + 2 * j], f[17 + 2 * j]}, xa = {x[2 * j], x[2 * j + 1]}, xb = {x[16 + 2 * j], x[17 + 2 * j]};
                        dv0 = fa * xa + dv0; dv1 = fb * xb + dv1; }
                    pl[(2 * (grp * 8 + i) + hi) * 32 + l32] = (dv0.x + dv0.y) + (dv1.x + dv1.y);
                }
            }
            float d;
            { const float4* pr = (const float4*)(pl + l32 * 32); float4 s4 = pr[0];
#pragma unroll
              for (int i = 1; i < 8; ++i) { const float4 v = pr[i]; s4.x += v.x; s4.y += v.y; s4.z += v.z; s4.w += v.w; }
              d = ((s4.x + s4.y) + (s4.z + s4.w)) * (1.0f / U_SCALE); }
            const float hv = 0.5f * d * (1.0f + erff(d * 0.70710678118654752f)) * my_gate * (1.0f / V_SCALE);
#pragma unroll 1
            for (int grp = 0; grp < 2; ++grp) {
                { u32x4a8_t pa[8]; uint2 pc[8];
#pragma unroll
                  for (int i = 0; i < 8; ++i) { const int id = __shfl(my_eid, 2 * (grp * 8 + i) + hi); const unsigned char* rp = uv + (size_t)id * ROW6 + 768 + l32 * 24; pa[i] = *(const u32x4a8_t*)rp; pc[i] = *(const uint2*)(rp + 16); }
#pragma unroll
                  for (int i = 0; i < 8; ++i) { uint2* wp = (uint2*)(raw + i * 1536); wp[0] = make_uint2(pa[i].x, pa[i].y); wp[1] = make_uint2(pa[i].z, pa[i].w); wp[2] = pc[i]; } }
#pragma unroll 1
                for (int i = 0; i < 8; ++i) {
                    const float c = __shfl(hv, 2 * (grp * 8 + i) + hi);
                    const uint2* rp = (const uint2*)(raw + i * 1536); const uint2 a = rp[0], b = rp[1], cc = rp[2];
                    const v6u_t pk6 = {a.x, a.y, b.x, b.y, cc.x, cc.y}; const v32f_t f = __builtin_amdgcn_cvt_scalef32_pk32_f32_fp6(pk6, 1.0f);
                    const f32x2_t c2 = {c, c};
#pragma unroll
                    for (int j = 0; j < 16; ++j) { const f32x2_t fj = {f[2 * j], f[2 * j + 1]}; f32x2_t aj = {acc[2 * j], acc[2 * j + 1]}; aj = fj * c2 + aj; acc[2 * j] = aj.x; acc[2 * j + 1] = aj.y; }
                }
            }
        }
        float y[32], s = 0.f;
#pragma unroll
        for (int i = 0; i < 32; ++i) { acc[i] += __shfl_xor(acc[i], 32); y[i] = ALPHA * x[i] + acc[i]; s += y[i]; }
#pragma unroll
        for (int o = 16; o > 0; o >>= 1) s += __shfl_xor(s, o);
        const float mean = s * (1.0f / 1024.0f);
        float s2 = 0.f;
#pragma unroll
        for (int i = 0; i < 32; ++i) { y[i] -= mean; s2 += y[i] * y[i]; }
#pragma unroll
        for (int o = 16; o > 0; o >>= 1) s2 += __shfl_xor(s2, o);
        const float rstd = 1.0f / sqrtf(s2 * (1.0f / 1024.0f) + LN_EPS);
        float o[16];
#pragma unroll
        for (int q4 = 0; q4 < 4; ++q4) {
            const float4 gg = ((const float4*)(g + l32 * 32 + hi * 16))[q4], cc = ((const float4*)(bb + l32 * 32 + hi * 16))[q4];
            float ya[4], yb2[4];
#pragma unroll
            for (int e = 0; e < 4; ++e) { ya[e] = y[4 * q4 + e]; yb2[e] = y[16 + 4 * q4 + e]; }
            asm volatile("" : "+v"(ya[0]), "+v"(ya[1]), "+v"(ya[2]), "+v"(ya[3]), "+v"(yb2[0]), "+v"(yb2[1]), "+v"(yb2[2]), "+v"(yb2[3]));
            const float y0 = hi ? yb2[0] : ya[0], y1 = hi ? yb2[1] : ya[1], y2 = hi ? yb2[2] : ya[2], y3 = hi ? yb2[3] : ya[3];
            o[4 * q4] = y0 * rstd * gg.x + cc.x; o[4 * q4 + 1] = y1 * rstd * gg.y + cc.y; o[4 * q4 + 2] = y2 * rstd * gg.z + cc.z; o[4 * q4 + 3] = y3 * rstd * gg.w + cc.w;
            ((float4*)(hr + hi * 16))[q4] = make_float4(o[4 * q4], o[4 * q4 + 1], o[4 * q4 + 2], o[4 * q4 + 3]);
        }
        uint4* hbp = (uint4*)(hb + (size_t)t * 1024 + l32 * 32 + hi * 16);
        hbp[0] = make_uint4(pk2(o[0], o[1]), pk2(o[2], o[3]), pk2(o[4], o[5]), pk2(o[6], o[7]));
        hbp[1] = make_uint4(pk2(o[8], o[9]), pk2(o[10], o[11]), pk2(o[12], o[13]), pk2(o[14], o[15]));
    }
}

__device__ __forceinline__ float pack_pl(float v, unsigned pl) { return __uint_as_float((__float_as_uint(v) & ~127u) | pl); }
__device__ __forceinline__ void ins16(float (&s)[16], float x) {
#pragma unroll
    for (int k = 15; k >= 1; --k) s[k] = __builtin_amdgcn_fmed3f(s[k - 1], x, s[k]);
    s[0] = vmax(s[0], x);
}
template <int D> __device__ __forceinline__ void bitonic_stage(float (&c)[16]) {
#pragma unroll
    for (int i = 0; i < 16; ++i) if ((i & D) == 0) { const float a = vmax(c[i], c[i + D]), b = vmin(c[i], c[i + D]); c[i] = a; c[i + D] = b; }
}
__device__ __forceinline__ int decode_key(unsigned pl) { return (int)(32u * ((pl >> 4) & 3u) + (pl & 3u) + 8u * ((pl >> 2) & 3u) + 4u * ((pl >> 6) & 1u)); }
__device__ void route_fast_phase(int WV_, const bf16* qb, const bf16* skb  , int* eid, float* gate, unsigned char* lds, int pm = -1, int pn = 0) {
    const int tid = LTID(WV_), lane = tid & 63, wave = tid >> 6, r32 = lane & 31, hi = lane >> 5;
    unsigned* lidx = (unsigned*)lds + wave * (64 * 33) + lane * 33;
    const int u_first = (pm >= 0) ? 0 : LBID() * NWAVE + wave, u_end = (pm >= 0) ? 2 : (T_ / 32) * 8, u_step = (pm >= 0) ? 1 : LGRID() * NWAVE;
    for (int unit = u_first; unit < u_end; unit += u_step) {
        const int h = (pm >= 0) ? 2 * pn + unit : (unit & 7), t = ((pm >= 0) ? 8 * pm + wave : (unit >> 3)) * 32 + r32;
        float sl[2][16];
#pragma unroll
        for (int p = 0; p < 2; ++p) {
            bf16x8_t qf[4];
            { const bf16* qp = qb + (size_t)t * 1024 + h * 128 + p * 64 + 8 * hi;
#pragma unroll
              for (int ks = 0; ks < 4; ++ks) qf[ks] = *(const bf16x8_t*)(qp + 16 * ks); }
            float s[16];
#pragma unroll
            for (int k = 0; k < 16; ++k) s[k] = -INFINITY;
            const bf16* skp = skb + ((size_t)(h * 2 + p) * 128 + r32) * 64 + 8 * hi;
#pragma unroll
            for (int kt = 0; kt < 4; ++kt) {
                f32x16_t acc;
#pragma unroll
                for (int r = 0; r < 16; ++r) acc[r] = 0.f;
#pragma unroll
                for (int ks = 0; ks < 4; ++ks) { const bf16x8_t a = *(const bf16x8_t*)(skp + (size_t)kt * 32 * 64 + 16 * ks); acc = __builtin_amdgcn_mfma_f32_32x32x16_bf16(a, qf[ks], acc, 0, 0, 0); }
#pragma unroll
                for (int r = 0; r < 16; ++r) ins16(s, pack_pl(acc[r], (unsigned)(kt * 16 + r)));
            }
            const unsigned hb = (unsigned)hi << 6;
#pragma unroll
            for (int k = 0; k < 16; ++k) s[k] = __uint_as_float(__float_as_uint(s[k]) | hb);
            float c[16];
#pragma unroll
            for (int k = 0; k < 16; ++k) c[k] = vmax(s[k], __shfl_xor(s[15 - k], 32));
            bitonic_stage<8>(c); bitonic_stage<4>(c); bitonic_stage<2>(c); bitonic_stage<1>(c);
#pragma unroll
            for (int k = 0; k < 16; ++k) { sl[p][k] = c[k]; lidx[p * 16 + k] = (unsigned)decode_key(__float_as_uint(c[k]) & 127u); }
        }
        float w[16];
#pragma unroll
        for (int k = 0; k < 16; ++k) w[k] = -INFINITY;
#pragma unroll
        for (int i = 0; i < 16; ++i)
#pragma unroll
            for (int j = 0; j < 16; ++j)
                if ((i + 1) * (j + 1) <= 16) { const float v = sl[0][i] + sl[1][j]; ins16(w, __uint_as_float((__float_as_uint(v) & ~255u) | (unsigned)(i * 16 + j))); }
        float e[16], sum = 0.f;
#pragma unroll
        for (int k = 0; k < 16; ++k) { e[k] = expf(w[k] - w[0]); sum += e[k]; }
        const float inv = 1.0f / sum;
        int ide[8]; float gte[8];
#pragma unroll
        for (int k = 0; k < 8; ++k) {
            float wa = w[k], wb = w[8 + k], ea = e[k], eb = e[8 + k];
            asm volatile("" : "+v"(wa), "+v"(wb), "+v"(ea), "+v"(eb));
            const float wv = hi ? wb : wa;
            const unsigned pl = __float_as_uint(wv) & 255u;
            ide[k] = (int)(lidx[pl >> 4] * 128u + lidx[16 + (pl & 15u)]);
            gte[k] = (hi ? eb : ea) * inv;
        }
        int* ep = eid + (size_t)t * 128 + h * 16 + hi * 8; float* gp = gate + (size_t)t * 128 + h * 16 + hi * 8;
        *(int4*)ep = make_int4(ide[0], ide[1], ide[2], ide[3]); *(int4*)(ep + 4) = make_int4(ide[4], ide[5], ide[6], ide[7]);
        *(float4*)gp = make_float4(gte[0], gte[1], gte[2], gte[3]); *(float4*)(gp + 4) = make_float4(gte[4], gte[5], gte[6], gte[7]);
    }
}

typedef float f32x4_t __attribute__((ext_vector_type(4)));
typedef __bf16 bf16x2v __attribute__((ext_vector_type(2)));
__device__ __forceinline__ float dot2bf(unsigned a, unsigned b, float c) { return __builtin_amdgcn_fdot2_f32_bf16(__builtin_bit_cast(bf16x2v, a), __builtin_bit_cast(bf16x2v, b), c, false); }
__device__ __forceinline__ void cnt_gt(int& cnt, unsigned a, unsigned b) { asm("v_cmp_gt_u32_e32 vcc, %1, %2\n\tv_addc_co_u32_e32 %0, vcc, 0, %0, vcc" : "+v"(cnt) : "v"(a), "v"(b) : "vcc"); }
__device__ __forceinline__ void cnt_eq(int& cnt, unsigned a, unsigned b) { asm("v_cmp_eq_u32_e32 vcc, %1, %2\n\tv_addc_co_u32_e32 %0, vcc, 0, %0, vcc" : "+v"(cnt) : "v"(a), "v"(b) : "vcc"); }
__device__ __forceinline__ unsigned flag_gt(unsigned a, unsigned b) { unsigned r; asm("v_cmp_gt_u32_e32 vcc, %1, %2\n\tv_cndmask_b32_e64 %0, 0, 1, vcc" : "=v"(r) : "v"(a), "v"(b) : "vcc"); return r; }
__device__ __forceinline__ unsigned flag_eq(unsigned a, unsigned b) { unsigned r; asm("v_cmp_eq_u32_e32 vcc, %1, %2\n\tv_cndmask_b32_e64 %0, 0, 1, vcc" : "=v"(r) : "v"(a), "v"(b) : "vcc"); return r; }
__device__ __forceinline__ void cnt_ge(int& cnt, unsigned key, unsigned cand) { asm("v_cmp_ge_u32_e32 vcc, %1, %2\n\tv_addc_co_u32_e32 %0, vcc, 0, %0, vcc" : "+v"(cnt) : "v"(key), "v"(cand) : "vcc"); }

typedef __attribute__((address_space(3))) unsigned lds_u32;
template <int SHIFT> __device__ __forceinline__ unsigned radix_pass(const unsigned (&key)[64], unsigned pre, lds_u32* hist, int lane, int& need) {
    typedef unsigned u32x4v __attribute__((ext_vector_type(4)));
    typedef __attribute__((address_space(3))) u32x4v lds_u32x4;
    { const u32x4v z4 = {0u, 0u, 0u, 0u};
#pragma unroll
      for (int i = 0; i < 8; ++i) ((lds_u32x4*)(hist + lane * 32))[i] = z4; }
    const unsigned cp = (unsigned)(lane & 7);
#pragma unroll
    for (int j = 0; j < 64; ++j) {
        const unsigned d = (key[j] >> SHIFT) & 255u;
        bool m;
        if (SHIFT == 24) m = key[j] != 0u; else m = (key[j] >> ((SHIFT + 8) & 31)) == pre;
        if (m) __hip_atomic_fetch_add(hist + ((d << 3) | cp), 1u, __ATOMIC_RELAXED, __HIP_MEMORY_SCOPE_WORKGROUP);
    }
    unsigned dsum[4]; unsigned sumL = 0u;
#pragma unroll
    for (int i = 0; i < 4; ++i) { const u32x4v v0 = ((const lds_u32x4*)(hist + lane * 32))[2 * i], v1 = ((const lds_u32x4*)(hist + lane * 32))[2 * i + 1];
        dsum[i] = ((v0.x + v0.y) + (v0.z + v0.w)) + ((v1.x + v1.y) + (v1.z + v1.w)); sumL += dsum[i]; }
    unsigned incl = sumL;
#pragma unroll
    for (int o = 1; o < 64; o <<= 1) { const unsigned t = (unsigned)__shfl_down((int)incl, o); if (lane + o < 64) incl += t; }
    const unsigned above = incl - sumL;
    const bool own = (above < (unsigned)need) && ((unsigned)need <= above + sumL);
    const int owner = __ffsll((long long)__ballot(own)) - 1;
    unsigned acc = above; int sel = -1; unsigned cab = 0u;
#pragma unroll
    for (int i = 3; i >= 0; --i) { const unsigned c = dsum[i]; const bool hit = (sel < 0) && (acc + c >= (unsigned)need); cab = hit ? acc : cab; sel = hit ? i : sel; acc += c; }
    const int ow = owner < 0 ? 0 : owner;
    const unsigned digit = (unsigned)__builtin_amdgcn_readlane(sel, ow) + (unsigned)(4 * ow);
    need -= (int)__builtin_amdgcn_readlane((int)cab, ow);
    return digit;
}
#ifndef TS_SEL
#define TS_SEL 0
#endif
#define ITS_B() do { if (TS_SEL >= 20 && TS_SEL <= 25 && WV_ == 0 && LANEID() == 0) ((volatile __attribute__((address_space(3))) unsigned long long*)((__attribute__((address_space(3))) unsigned char*)lds + 147456 - 16 - 32))[0] = __builtin_amdgcn_s_memrealtime(); } while (0)
#define ITS_E(k) do { if ((k) == TS_SEL && WV_ == 0 && LANEID() == 0) { volatile __attribute__((address_space(3))) unsigned long long* w_ = (volatile __attribute__((address_space(3))) unsigned long long*)((__attribute__((address_space(3))) unsigned char*)lds + 147456 - 16 - 32); w_[1] += __builtin_amdgcn_s_memrealtime() - w_[0]; } } while (0)
__device__ void index_fast_phase(int WV_, const bf16* P, unsigned char* mask, float* kmean, float* scratch_all, unsigned char* lds) {
    const int tid = LTID(WV_), lane = tid & 63, wave = tid >> 6, bid = LBID(), G = LGRID();
    float* s_part = (float*)lds;
    ITS_B();
    for (int k = bid; k < 256; k += G) {
        const int b = k >> 6, h = (k >> 4) & 3, blk = k & 15;
        const bf16* kp = P + (size_t)(b * S_ + blk * 256 + wave * 32) * NP + C_KC + h * 64 + lane;
        float a = 0.f;
#pragma unroll 8
        for (int j = 0; j < 32; ++j) a += bf2f(kp[(size_t)j * NP]);
        __syncthreads();
        s_part[wave * 64 + lane] = a;
        __syncthreads();
        if (tid < 64) { float s = 0.f;
#pragma unroll
            for (int w = 0; w < 8; ++w) s += s_part[w * 64 + tid];
            kmean[((b * 4 + h) * 16 + blk) * 64 + tid] = s * (1.0f / 256.0f); }
    }
    ITS_E(22);
    float* scr = scratch_all + (size_t)bid * (16 * 4096);
    const int lq = lane & 15, g4 = lane >> 4;
    for (int ui = bid; ui < 1024; ui += G) {
        const int b = ui >> 8, k = ui & 255, tile = (b & 1) ? 255 - k : k, q0 = tile * 16;
        const bf16* Pb = P + (size_t)b * S_ * NP;
        const int ntiles = tile + 1;
        ITS_B();
        bf16x8_t qf[8]; float wi[8];
        { const bf16* qp = Pb + (size_t)(q0 + lq) * NP + C_QI + 8 * g4;
#pragma unroll
          for (int h = 0; h < 8; ++h) qf[h] = *(const bf16x8_t*)(qp + 32 * h);
          const uint4 wv = *(const uint4*)(Pb + (size_t)(q0 + lq) * NP + C_WI); unpack8(wv, wi); }
        {
            bf16x8_t afn = *(const bf16x8_t*)(Pb + (size_t)((wave < ntiles ? wave : 0) * 16 + lq) * NP + C_KI + 8 * g4);
            for (int kt = wave; kt < ntiles; kt += NWAVE) {
                const bf16x8_t af = afn;
                { const int ktn = (kt + NWAVE < ntiles) ? kt + NWAVE : kt; afn = *(const bf16x8_t*)(Pb + (size_t)(ktn * 16 + lq) * NP + C_KI + 8 * g4); }
                f32x4_t a[8];
                const f32x4_t z = {0.f, 0.f, 0.f, 0.f};
#pragma unroll
                for (int h = 0; h < 8; ++h) a[h] = __builtin_amdgcn_mfma_f32_16x16x32_bf16(af, qf[h], z, 0, 0, 0);
                __builtin_amdgcn_sched_barrier(0);
                f32x4_t sc = {0.f, 0.f, 0.f, 0.f};
#pragma unroll
                for (int h = 0; h < 8; ++h)
#pragma unroll
                    for (int r = 0; r < 4; ++r) { float rl; asm("v_max_f32_e32 %0, 0, %1" : "=v"(rl) : "v"(a[h][r])); sc[r] += rl * wi[h]; }
#pragma unroll
                for (int r = 0; r < 4; ++r) { sc[r] *= 0.0625f; if (sc[r] == 0.f) sc[r] = 0.f; }
                *(f32x4_t*)(scr + (size_t)lq * 4096 + kt * 16 + 4 * g4) = sc;
            }
        }
        __threadfence_block();
        __syncthreads();
        __threadfence_block();
        ITS_E(20); ITS_B();
        lds_u32* hist = (lds_u32*)((__attribute__((address_space(3))) unsigned char*)lds + 2048) + wave * 2048;
#pragma unroll 1
        for (int qi = 0; qi < 2; ++qi) {
            const int ql = 2 * wave + qi, q = q0 + ql;
            const float* row = scr + (size_t)ql * 4096 + lane * 64;
            const int qrel = q - lane * 64;
            unsigned key[64];
            if (qrel >= 0) {
#pragma unroll
                for (int j4 = 0; j4 < 16; ++j4) {
                    const float4 v = ((const float4*)row)[j4];
                    const unsigned u[4] = {__float_as_uint(v.x), __float_as_uint(v.y), __float_as_uint(v.z), __float_as_uint(v.w)};
#pragma unroll
                    for (int e = 0; e < 4; ++e) { const unsigned t = u[e] ^ ((unsigned)((int)u[e] >> 31) | 0x80000000u); const unsigned inval = (unsigned)((qrel - (j4 * 4 + e)) >> 31); key[j4 * 4 + e] = t & ~inval; }
                    if ((j4 & 3) == 3) asm volatile("" ::: "memory");
                }
            } else {
#pragma unroll
                for (int j = 0; j < 64; ++j) key[j] = 0u;
            }
            ITS_E(23); ITS_B();
            unsigned wlo = 0u, whi = 0u;
            if (q + 1 > 256) {
                int need = 256;
                const unsigned d1 = radix_pass<24>(key, 0u, hist, lane, need);
                const unsigned d2 = radix_pass<16>(key, d1, hist, lane, need);
                const unsigned d3 = radix_pass<8>(key, (d1 << 8) | d2, hist, lane, need);
                const unsigned d4 = radix_pass<0>(key, (d1 << 16) | (d2 << 8) | d3, hist, lane, need);
                const unsigned prefix = (d1 << 24) | (d2 << 16) | (d3 << 8) | d4;
                ITS_E(24); ITS_B();
                int ceq = 0;
#pragma unroll
                for (int j = 0; j < 64; ++j) cnt_eq(ceq, key[j], prefix);
                ceq = wave_sum_i(ceq);
                int X = 4096;
                if (ceq != need) {
                    int X0 = 0;
#pragma unroll 1
                    for (int bit = 11; bit >= 0; --bit) {
                        const int c = X0 | (1 << bit);
                        int cnt = 0; const int crel = c - lane * 64;
#pragma unroll
                        for (int j = 0; j < 64; ++j) cnt_eq(cnt, (key[j] ^ prefix) | ~(unsigned)((j - crel) >> 31), 0u);
                        cnt = wave_sum_i(cnt);
                        if (cnt < need) X0 = c;
                    }
                    X = X0 + 1;
                }
                const int xrel = X - lane * 64;
#pragma unroll
                for (int j = 0; j < 32; ++j) {
                    const unsigned s0 = flag_gt(key[j], prefix) | flag_eq((key[j] ^ prefix) | ~(unsigned)((j - xrel) >> 31), 0u);
                    const unsigned s1 = flag_gt(key[32 + j], prefix) | flag_eq((key[32 + j] ^ prefix) | ~(unsigned)((32 + j - xrel) >> 31), 0u);
                    wlo |= s0 << j; whi |= s1 << j;
                }
            } else {
#pragma unroll
                for (int j = 0; j < 32; ++j) { wlo |= (~(unsigned)((qrel - j) >> 31) & 1u) << j; whi |= (~(unsigned)((qrel - 32 - j) >> 31) & 1u) << j; }
            }
            ((uint2*)(mask + (size_t)(b * S_ + q) * 512))[lane] = make_uint2(wlo, whi);
            ITS_E(25); ITS_B();
        }
        ITS_E(21);
        __syncthreads();
    }
}

constexpr int MG_P = 72;
constexpr int MG_TILE_BYTES = 128 * MG_P * 2;
__device__ void merge_fast_phase(int WV_, const bf16* P, const bf16* ys, const bf16* wbt  , bf16* merged, unsigned char* lds) {
    const int tid = LTID(WV_), lane = tid & 63, wave = tid >> 6, r32 = lane & 31, hi = lane >> 5, wt = wave & 3, wd = wave >> 2;
    const int srow0 = tid >> 3, sch = tid & 7;
    for (int tile = LBID(); tile < 1024; tile += LGRID()) {
        const int tok0 = (tile >> 3) * 128, d0 = (tile & 7) * 128;
        f32x16_t mer[2], acc[2];
#pragma unroll
        for (int r = 0; r < 16; ++r) { mer[0][r] = 0.f; mer[1][r] = 0.f; acc[0][r] = 0.f; acc[1][r] = 0.f; }
        uint4 RW00, RW01, RW10, RW11, RY00, RY01, RY10, RY11, RG0, RG1, RG2, RG3;
        bf16* gl = (bf16*)(lds + 4 * MG_TILE_BYTES);
        const int grow = tid >> 4, gch = tid & 15;
#define MG_GLOAD(st_, R_) do { const int n_ = (st_) >> 2, kc_ = (st_) & 3; \
            RW##R_##0 = *(const uint4*)(wbt + ((size_t)n_ * 1024 + d0 + srow0) * 256 + kc_ * 64 + sch * 8); \
            RW##R_##1 = *(const uint4*)(wbt + ((size_t)n_ * 1024 + d0 + srow0 + 64) * 256 + kc_ * 64 + sch * 8); \
            RY##R_##0 = *(const uint4*)(ys + (size_t)(tok0 + srow0) * 1024 + n_ * 256 + kc_ * 64 + sch * 8); \
            RY##R_##1 = *(const uint4*)(ys + (size_t)(tok0 + srow0 + 64) * 1024 + n_ * 256 + kc_ * 64 + sch * 8); } while (0)
#define MG_SSTORE(buf_, R_) do { bf16* wl_ = (bf16*)(lds + (buf_) * 2 * MG_TILE_BYTES); bf16* yl_ = (bf16*)(lds + (buf_) * 2 * MG_TILE_BYTES + MG_TILE_BYTES); \
            *(uint4*)(wl_ + srow0 * MG_P + sch * 8) = RW##R_##0; *(uint4*)(wl_ + (srow0 + 64) * MG_P + sch * 8) = RW##R_##1; \
            *(uint4*)(yl_ + srow0 * MG_P + sch * 8) = RY##R_##0; *(uint4*)(yl_ + (srow0 + 64) * MG_P + sch * 8) = RY##R_##1; } while (0)
        __syncthreads();
        MG_GLOAD(0, 0); MG_GLOAD(1, 1);
        MG_SSTORE(0, 0);
        __syncthreads();
#define MG_STAGE(PAR_, OTH_) do { const int buf = PAR_; \
            if (st + 2 < 16) MG_GLOAD(st + 2, PAR_); \
            if ((st & 3) == 1) { const bf16* gsrc = P + (size_t)(tok0 + grow) * NP + C_G + (st >> 2) * 1024 + d0 + gch * 8; \
                RG0 = *(const uint4*)gsrc; RG1 = *(const uint4*)(gsrc + (size_t)32 * NP); RG2 = *(const uint4*)(gsrc + (size_t)64 * NP); RG3 = *(const uint4*)(gsrc + (size_t)96 * NP); } \
            const bf16* wl = (const bf16*)(lds + buf * 2 * MG_TILE_BYTES); const bf16* yl = (const bf16*)(lds + buf * 2 * MG_TILE_BYTES + MG_TILE_BYTES); \
            _Pragma("unroll") for (int ks = 0; ks < 4; ++ks) { \
                const bf16x8_t bq = *(const bf16x8_t*)(yl + (32 * wt + r32) * MG_P + 16 * ks + 8 * hi); \
                const bf16x8_t a0 = *(const bf16x8_t*)(wl + (64 * wd + r32) * MG_P + 16 * ks + 8 * hi); \
                const bf16x8_t a1 = *(const bf16x8_t*)(wl + (64 * wd + 32 + r32) * MG_P + 16 * ks + 8 * hi); \
                acc[0] = __builtin_amdgcn_mfma_f32_32x32x16_bf16(a0, bq, acc[0], 0, 0, 0); \
                acc[1] = __builtin_amdgcn_mfma_f32_32x32x16_bf16(a1, bq, acc[1], 0, 0, 0); } \
            if ((st & 3) == 3) { \
                const int n = st >> 2; \
                const bf16* gp = gl + (32 * wt + r32) * 136 + 64 * wd + 4 * hi; (void)n; \
                _Pragma("unroll") for (int dt = 0; dt < 2; ++dt) \
                _Pragma("unroll") for (int g = 0; g < 4; ++g) { \
                        const uint2 gv = *(const uint2*)(gp + 32 * dt + 8 * g); \
                        const float g0 = __uint_as_float(gv.x << 16), g1 = __uint_as_float(gv.x & 0xffff0000u), g2 = __uint_as_float(gv.y << 16), g3 = __uint_as_float(gv.y & 0xffff0000u); \
                        mer[dt][4 * g + 0] += acc[dt][4 * g + 0] * g0; \
                        mer[dt][4 * g + 1] += acc[dt][4 * g + 1] * g1; \
                        mer[dt][4 * g + 2] += acc[dt][4 * g + 2] * g2; \
                        mer[dt][4 * g + 3] += acc[dt][4 * g + 3] * g3; } \
                _Pragma("unroll") for (int r = 0; r < 16; ++r) { acc[0][r] = 0.f; acc[1][r] = 0.f; } } \
            if (st + 1 < 16) MG_SSTORE(OTH_, OTH_); \
            if ((st & 3) == 2) { *(uint4*)(gl + grow * 136 + gch * 8) = RG0; *(uint4*)(gl + (grow + 32) * 136 + gch * 8) = RG1; *(uint4*)(gl + (grow + 64) * 136 + gch * 8) = RG2; *(uint4*)(gl + (grow + 96) * 136 + gch * 8) = RG3; } \
            __syncthreads(); } while (0)
#pragma unroll 1
        for (int st2 = 0; st2 < 16; st2 += 2) { { const int st = st2; MG_STAGE(0, 1); } { const int st = st2 + 1; MG_STAGE(1, 0); } }
#undef MG_STAGE
#undef MG_GLOAD
#undef MG_SSTORE
        bf16* mp = merged + (size_t)(tok0 + 32 * wt + r32) * 1024 + d0 + 64 * wd + 4 * hi;
#pragma unroll
        for (int dt = 0; dt < 2; ++dt)
#pragma unroll
            for (int g = 0; g < 4; ++g)
                *(uint2*)(mp + 32 * dt + 8 * g) = make_uint2(cvtpk(mer[dt][4 * g], mer[dt][4 * g + 1]), cvtpk(mer[dt][4 * g + 2], mer[dt][4 * g + 3]));
    }
}
#define LAS __attribute__((address_space(3)))
#define XB_TMO      128
#define XB_XCNT(j)  (256  + 64 * (j))
#define XB_XSUB(j)  (1280 + 64 * (j))
#define XB_XGEN(j)  (2304 + 64 * (j))
#define XB_TOP      3328
#define XB_TOPGEN   3392
#define XCD_BAR_WORDS 3456
#define XB_SPIN_CAP (1u << 18)

__device__ __forceinline__ unsigned xb_ld(unsigned* p)              { return __hip_atomic_load(p, __ATOMIC_RELAXED, __HIP_MEMORY_SCOPE_AGENT); }
__device__ __forceinline__ unsigned xb_add(unsigned* p, unsigned v) { return __hip_atomic_fetch_add(p, v, __ATOMIC_RELAXED, __HIP_MEMORY_SCOPE_AGENT); }
__device__ __forceinline__ unsigned xb_xcc_id() { return (unsigned)__builtin_amdgcn_s_getreg((3 << 11) | 20) & 0xFu; }
#define XB_SPIN(cond, bar) do { unsigned _sp = 0; while (cond) { __builtin_amdgcn_s_sleep(1); \
    if ((++_sp & 255u) == 0u) { if (xb_ld(&(bar)[XB_TMO])) break; if (_sp > XB_SPIN_CAP) { atomicAdd(&(bar)[XB_TMO], 1u); break; } } } } while (0)

struct XcdBarrier {
    unsigned* bar; unsigned x;
    volatile LAS unsigned* st;
};

__device__ __forceinline__ XcdBarrier xcd_barrier_post(unsigned* bar, volatile LAS unsigned* st) {
    XcdBarrier b; b.bar = bar; b.x = xb_xcc_id(); b.st = st;
    if (threadIdx.x == 0) (void)xb_add(&bar[XB_XCNT(b.x)], 1u);
    return b;
}
__device__ __forceinline__ void xcd_barrier_complete(unsigned* bar, unsigned x, unsigned& nloc, unsigned& nx) {
    const unsigned G = gridDim.x * gridDim.y * gridDim.z;
    unsigned sum, cnt, mine, sp = 0u;
    for (;;) {
        sum = 0u; cnt = 0u; mine = 0u;
#pragma unroll
        for (unsigned j = 0; j < 16; ++j) { const unsigned c = xb_ld(&bar[XB_XCNT(j)]); sum += c; cnt += (c > 0u) ? 1u : 0u; mine = (j == x) ? c : mine; }
        if (sum == G) break;
        __builtin_amdgcn_s_sleep(1);
        if ((++sp & 255u) == 0u) { if (xb_ld(&bar[XB_TMO])) break; if (sp > XB_SPIN_CAP) { atomicAdd(&bar[XB_TMO], 1u); break; } }
    }
    nloc = mine > 0u ? mine : 1u; nx = cnt > 0u ? cnt : 1u;
}

__device__ __forceinline__ void xcd_barrier(const XcdBarrier& b, int wv_) {
    asm volatile("s_waitcnt vmcnt(0)" ::: "memory");
    __syncthreads();
    if (wv_ == 0 && LANEID() == 0) {
        unsigned* bar = b.bar;
        __builtin_amdgcn_s_waitcnt(0);
        unsigned nloc = b.st[0], nx = b.st[1];
        if (nloc == 0u) { xcd_barrier_complete(bar, b.x, nloc, nx); b.st[0] = nloc; b.st[1] = nx; }
        const unsigned old = xb_add(&bar[XB_XSUB(b.x)], 1u);
        const unsigned gen = old / nloc;
        if (old + 1u == (gen + 1u) * nloc) {
            __builtin_amdgcn_fence(__ATOMIC_RELEASE, "agent");
            asm volatile("s_waitcnt vmcnt(0)" ::: "memory");
            const unsigned og = xb_add(&bar[XB_TOP], 1u);
            const unsigned tg = og / nx;
            if (og + 1u == (tg + 1u) * nx) xb_add(&bar[XB_TOPGEN], 1u);
            else XB_SPIN(xb_ld(&bar[XB_TOPGEN]) == tg, bar);
            __builtin_amdgcn_fence(__ATOMIC_ACQUIRE, "agent");
            xb_add(&bar[XB_XGEN(b.x)], 1u);
            asm volatile("s_waitcnt vmcnt(0)" ::: "memory");
        } else {
            XB_SPIN(xb_ld(&bar[XB_XGEN(b.x)]) == gen, bar);
            __builtin_amdgcn_fence(__ATOMIC_ACQUIRE, "agent");
            asm volatile("s_waitcnt vmcnt(0)" ::: "memory");
        }
    }
    __syncthreads();
}

enum { PH_PRO = 0, PH_GIN, PH_INDEX, PH_ATTN, PH_MERGE, PH_GOUT, PH_LN1, PH_GQ, PH_ROUTE, PH_PEER };
template <int PH> __device__ __forceinline__ void run_phase(int WV_, const Params& p_unused, int l, unsigned char* lds_raw) {
    size_t kaoff_ = 0; asm volatile("" : "+s"(kaoff_));
    typedef const __attribute__((address_space(4))) char* kaptr_t;
    const __attribute__((address_space(4))) Params& p = *(const __attribute__((address_space(4))) Params*)((kaptr_t)__builtin_amdgcn_kernarg_segment_ptr() + kaoff_);
    float* sm = (float*)lds_raw;
    size_t wsoff_ = 0; asm volatile("" : "+s"(wsoff_));
    unsigned char* ws = p.ws + wsoff_;
    float* hbuf = p.out;
    bf16* hb = (bf16*)(ws + WS_HB);
    bf16* P = (bf16*)(ws + WS_P);
    bf16* ys = (bf16*)(ws + WS_YS);
    bf16* mrg = (bf16*)(ws + WS_MRG);
    float* mix = (float*)(ws + WS_MIX);
    float* qb = (float*)(ws + WS_Q);
    unsigned char* mask = ws + WS_MASK;
    int* eid = (int*)(ws + WS_EID);
    float* gate = (float*)(ws + WS_GATE);
    float* kmean = (float*)(ws + WS_KMEAN);
    const float* hin = (l == 0) ? p.in[0] : hbuf;
    if (PH == PH_PRO) { Params pc; for (int i = 0; i < 13; ++i) pc.in[i] = p.in[i]; pc.out = p.out; pc.ws = ws;
        prologue_phase(WV_, pc, sm); convert_tables(WV_, pc);
        for (int i = LBID() * NTHR + LTID(WV_); i < DEPTH_ * 8 * 2 * 128 * 64 / 4; i += LGRID() * NTHR) { const float4 v = ((const float4*)p.in[8])[i]; ((uint2*)(ws + WS_SKB))[i] = make_uint2(pk2(v.x, v.y), pk2(v.z, v.w)); } if (LBID() < 2) build_unit_table((unsigned*)(ws + WS_CTL) + 1024, LBID() * NTHR + LTID(WV_)); }
    else if (PH == PH_GIN) {
        pg8::Gemm g{hb, (const bf16*)(ws + WS_WIN_T + l * WIN_T_BYTES), T_, NP, 1024};
        pg8::StaticOrder S; S.init(T_, NP, (int)LGRID(), (int)LBID());
        pg8::EpiBf16Sig E{P, NP, C_G};
        pg8::gemm_phase<pg8::EpiBf16Sig, pg8::StaticOrder, true, true>(WV_, (PG8_LAS unsigned char*)lds_raw, g, S, E);
    }
    else if (PH == PH_INDEX) index_fast_phase(WV_, P, mask, kmean, (float*)(ws + WS_YS), lds_raw);
    else if (PH == PH_ATTN) attn_fast_phase(WV_, P, mask, kmean, p.in[4] + l * 4, ys, (const unsigned*)(ws + WS_CTL) + 1024, (unsigned*)(ws + WS_CTL) + 64 * l, lds_raw);
    else if (PH == PH_MERGE) merge_fast_phase(WV_, P, ys, (const bf16*)(ws + WS_WBR_T) + (size_t)l * 4 * 1024 * 256, mrg, lds_raw);
    else if (PH == PH_GOUT) {
        pg8::Gemm g{mrg, (const bf16*)(ws + WS_WOUT_T) + (size_t)l * 1024 * 1024, T_, 1024, 1024};
        pg8::StaticOrder S; S.init(T_, 1024, (int)LGRID(), (int)LBID());
        pg8::EpiResY E{hin, hbuf, hb, (float*)(ws + WS_STATS) + (size_t)l * T_ * 2, ALPHA};
        pg8::gemm_phase<pg8::EpiResY, pg8::StaticOrder, true, true>(WV_, (PG8_LAS unsigned char*)lds_raw, g, S, E);
    }
    else if (PH == PH_GQ) {
        pg8::Gemm g{hb, (const bf16*)(ws + WS_WQ_T) + (size_t)l * 1024 * 1024, T_, 1024, 1024};
        pg8::StaticOrder S; S.init(T_, 1024, (int)LGRID(), (int)LBID());
        pg8::EpiLnFold E{(bf16*)qb, (const float*)(ws + WS_STATS) + (size_t)l * T_ * 2, (const float*)(ws + WS_COLS) + l * 2048, (const float*)(ws + WS_COLS) + l * 2048 + 1024, LN_EPS};
        pg8::gemm_phase<pg8::EpiLnFold, pg8::StaticOrder, true, true>(WV_, (PG8_LAS unsigned char*)lds_raw, g, S, E);
        pg8::Unit u0;
        if (LGRID() == 256 && S.next(0, u0)) {
            asm volatile("s_waitcnt vmcnt(0)" ::: "memory"); __syncthreads();
            route_fast_phase(WV_, (const bf16*)qb, (const bf16*)(ws + WS_SKB) + (size_t)l * 8 * 2 * 128 * 64, eid, gate, lds_raw, u0.pm, u0.pn);
        }
    }
    else if (PH == PH_ROUTE) { if (LGRID() != 256) route_fast_phase(WV_, (const bf16*)qb, (const bf16*)(ws + WS_SKB) + (size_t)l * 8 * 2 * 128 * 64, eid, gate, lds_raw); }
    else peer_fast_phase(WV_, hbuf, hb, eid, gate, ws + WS_UV + (size_t)l * 24 * MiB, p.in[5] + l * 1024, p.in[6] + l * 1024, p.in[11] + l * 1024, p.in[12] + l * 1024, lds_raw);
}

constexpr int CW_BAR = 4096;
constexpr int LDS_BARST = LDS_BYTES - 16;
__global__ void __launch_bounds__(NTHR, 2) mk_fwd(Params p) {
    extern __shared__ __attribute__((aligned(16))) unsigned char lds_raw[];
    cg::grid_group grid = cg::this_grid();
    const int WV_ = __builtin_amdgcn_readfirstlane((int)threadIdx.x >> 6);
    { volatile LAS unsigned* bst0 = (volatile LAS unsigned*)((LAS unsigned char*)lds_raw + LDS_BARST); if (threadIdx.x < 4) bst0[threadIdx.x] = 0u; }
    __syncthreads();
    volatile LAS unsigned* bst = (volatile LAS unsigned*)((LAS unsigned char*)lds_raw + LDS_BARST);
    (void)xcd_barrier_post((unsigned*)(p.ws + WS_CTL) + CW_BAR, bst);
#define GRID_BAR() do { XcdBarrier b_; b_.bar = (unsigned*)(p.ws + WS_CTL) + CW_BAR; b_.x = xb_xcc_id(); b_.st = (volatile LAS unsigned*)((LAS unsigned char*)lds_raw + LDS_BARST); xcd_barrier(b_, WV_); } while (0)
    run_phase<PH_PRO>(WV_, p, 0, lds_raw);
    grid.sync();
#pragma unroll 1
    for (int l = 0; l < DEPTH_; ++l) {
        run_phase<PH_GIN>(WV_, p, l, lds_raw); GRID_BAR();
        run_phase<PH_INDEX>(WV_, p, l, lds_raw); GRID_BAR();
        run_phase<PH_ATTN>(WV_, p, l, lds_raw); GRID_BAR();
        run_phase<PH_MERGE>(WV_, p, l, lds_raw); GRID_BAR();
        run_phase<PH_GOUT>(WV_, p, l, lds_raw); GRID_BAR();
        run_phase<PH_GQ>(WV_, p, l, lds_raw); if (LGRID() != 256) { GRID_BAR(); run_phase<PH_ROUTE>(WV_, p, l, lds_raw); } GRID_BAR();
        run_phase<PH_PEER>(WV_, p, l, lds_raw); if (l + 1 < DEPTH_) GRID_BAR();
    }
}

extern "C" void kernel_launch(void* const* d_in, const int* in_sizes, int n_in, void* d_out, int out_size, void* d_ws, size_t ws_size, hipStream_t stream) {
    if (n_in != 13 || ws_size < WS_END) { fprintf(stderr, "kernel_launch: unexpected n_in %d / ws_size %zu; nothing launched\n", n_in, ws_size); return; }
    static int grid_blocks = 0;
    if (grid_blocks == 0) {
        int dev = 0, cus = 0, per_cu = 0;
        (void)hipGetDevice(&dev);
        (void)hipDeviceGetAttribute(&cus, hipDeviceAttributeMultiprocessorCount, dev);
        (void)hipFuncSetAttribute((const void*)mk_fwd, hipFuncAttributeMaxDynamicSharedMemorySize, LDS_BYTES);
        (void)hipOccupancyMaxActiveBlocksPerMultiprocessor(&per_cu, (const void*)mk_fwd, NTHR, LDS_BYTES);
        if (per_cu < 1) fprintf(stderr, "kernel_launch: occupancy query reports %d\n", per_cu);
        grid_blocks = cus;
    }
    Params p{};
    for (int i = 0; i < 13; ++i) p.in[i] = (const float*)d_in[i];
    p.out = (float*)d_out; p.ws = (unsigned char*)d_ws;
    (void)hipMemsetAsync(d_ws, 0, 2 * MiB, stream);
    void* args[] = {&p};
    hipError_t e = hipLaunchCooperativeKernel((const void*)mk_fwd, dim3(grid_blocks), dim3(NTHR), args, LDS_BYTES, stream);
    if (e != hipSuccess) fprintf(stderr, "cooperative launch failed: %s (grid %d)\n", hipGetErrorString(e), grid_blocks);
}
```

```cpp
#include <hip/hip_runtime.h>
#include <cstdio>
#include <cstdint>
#include <hip/hip_cooperative_groups.h>
namespace cg = cooperative_groups;

__device__ __forceinline__ int LANEID() { int l; asm volatile("v_mbcnt_lo_u32_b32 %0, -1, 0\n\tv_mbcnt_hi_u32_b32 %0, -1, %0" : "=v"(l)); return l; }
__device__ __forceinline__ int LTID(int wv) { return (wv << 6) | LANEID(); }
__device__ __forceinline__ int LBID() { int t = blockIdx.x; asm volatile("" : "+s"(t)); return t; }
__device__ __forceinline__ int LGRID() { int t = gridDim.x; asm volatile("" : "+s"(t)); return t; }
namespace pg8 {
#define PG8_LAS __attribute__((address_space(3)))
typedef unsigned short bf16_t;
typedef short bf16x8 __attribute__((ext_vector_type(8)));
typedef float f32x4 __attribute__((ext_vector_type(4)));
typedef unsigned u32x4 __attribute__((ext_vector_type(4)));
constexpr int BM = 256, BK = 64, HALF = 128, HTB = HALF * BK * 2  , STAGE_BYTES = 8 * HTB, NXCD = 8, WGM = 8;

__host__ __device__ __forceinline__ int lds_byte(int r, int c) { const int st = (r >> 4) * 2 + (c >> 5), rr = r & 15, cc = c & 31, ob = rr * 64 + cc * 2; return st * 1024 + (ob ^ (((ob >> 9) & 1) << 5)); }
__host__ __device__ __forceinline__ void stage_rc(int b, int& R, int& C) { const int st = b / 1024, sb = b % 1024, swz = sb ^ (((sb >> 9) & 1) << 5); R = (st >> 1) * 16 + swz / 64; C = (st & 1) * 32 + (swz % 64) / 2; }
__host__ __device__ __forceinline__ int perm32(int rho) { const int n = rho >> 4, i = rho & 15; return 8 * (i >> 2) + 4 * n + (i & 3); }

struct Unit { int pm, pn; };
struct Gemm { const bf16_t* A; const bf16_t* Bt; int M, N, K; };

struct StaticOrder {
    int nM, nN, nwg, G, c;
    __host__ __device__ void init(int M, int N, int G_, int c_) { nM = M / BM; nN = N / BM; nwg = nM * nN; G = G_; c = c_; }
    __host__ __device__ bool next(int i, Unit& u) const {
        const long L = (long)i * G + c; if (L >= nwg) return false;
        int wgid = (int)L; { const int q = nwg / NXCD, r = nwg % NXCD, xcd = wgid % NXCD, off = wgid / NXCD; wgid = (xcd < r ? xcd * (q + 1) : r * (q + 1) + (xcd - r) * q) + off; }
        const int nig = WGM * nN, gid = wgid / nig, fm = gid * WGM, gsz = (nM - fm) < WGM ? (nM - fm) : WGM;
        u.pm = fm + ((wgid % nig) % gsz); u.pn = (wgid % nig) / gsz; return true;
    }
    __device__ __forceinline__ void a_ready(const Unit&) const {}
    __device__ __forceinline__ void done(const Unit&) const {}
};

__device__ __forceinline__ unsigned cvt_pk_bf16(float lo, float hi) { unsigned r; asm volatile("v_cvt_pk_bf16_f32 %0, %1, %2" : "=v"(r) : "v"(lo), "v"(hi)); return r; }
typedef float f32x2 __attribute__((ext_vector_type(2)));
__device__ __forceinline__ f32x2 gelu_pk(f32x2 v) {
    const f32x2 av = __builtin_elementwise_abs(v), d = av * 0.2316418882f + 1.0f;
    f32x2 t; t.x = __builtin_amdgcn_rcpf(d.x); t.y = __builtin_amdgcn_rcpf(d.y);
    f32x2 q = t * 0.5307027145f + (-0.7265760135f); q = q * t + 0.7107068705f; q = q * t + (-0.142248368f); q = q * t + 0.127414796f; q = q * t;
    const f32x2 s = (v * v) * (-0.72134752044f);
    f32x2 e; e.x = __builtin_amdgcn_exp2f(s.x); e.y = __builtin_amdgcn_exp2f(s.y);
    const f32x2 m = v * (q * e), r = v - m;
    f32x2 o; o.x = v.x < 0.f ? m.x : r.x; o.y = v.y < 0.f ? m.y : r.y; return o;
}

template <int ACT  > struct EpiBf16 {
    static constexpr bool PERM = true, AFTER_DRAIN = false; static_assert(ACT == 0 || ACT == 1, "EpiBf16: ACT is 0 (none) or 1 (gelu_pk)");
    bf16_t* O; int ldc; const float* bias; int split_cols; size_t split_stride; float scale0;
    __device__ __forceinline__ void operator()(const f32x4 (&acc)[2][2][4][2], const Unit& u, int wr, int wc, int fr, int fq) const {
        { int ln_ = LANEID(); asm volatile("" : "+v"(ln_)); fr = ln_ & 15; fq = ln_ >> 4; }
        const int row0 = u.pm * BM + wr * 64 + fr; int colt = u.pn * BM; bf16_t* base = O;
        float sc = 1.f; if (split_cols) { const int t = colt / split_cols; base += (size_t)t * split_stride; colt -= t * split_cols; if (t == 0) sc = scale0; }
        const int col0 = colt + wc * 32 + 8 * fq, bcol0 = u.pn * BM + wc * 32 + 8 * fq;
        f32x4 bv[2][2];
#pragma unroll
        for (int bj = 0; bj < 2; ++bj)
#pragma unroll
            for (int n = 0; n < 2; ++n) bv[bj][n] = bias ? *(const f32x4*)(bias + bcol0 + bj * HALF + 4 * n) : (f32x4){0.f, 0.f, 0.f, 0.f};
#pragma unroll
        for (int ai = 0; ai < 2; ++ai)
#pragma unroll
            for (int m = 0; m < 4; ++m) { bf16_t* rowp = base + (size_t)(row0 + ai * HALF + m * 16) * ldc + col0;
#pragma unroll
                for (int bj = 0; bj < 2; ++bj) { f32x4 v0 = acc[ai][bj][m][0] + bv[bj][0], v1 = acc[ai][bj][m][1] + bv[bj][1];
                    if (ACT == 1) { f32x2 a = gelu_pk((f32x2){v0[0], v0[1]}), b = gelu_pk((f32x2){v0[2], v0[3]}), c = gelu_pk((f32x2){v1[0], v1[1]}), d = gelu_pk((f32x2){v1[2], v1[3]});
                        v0 = (f32x4){a.x, a.y, b.x, b.y}; v1 = (f32x4){c.x, c.y, d.x, d.y}; }
                    v0 = v0 * sc; v1 = v1 * sc; u32x4 w; w.x = cvt_pk_bf16(v0[0], v0[1]); w.y = cvt_pk_bf16(v0[2], v0[3]); w.z = cvt_pk_bf16(v1[0], v1[1]); w.w = cvt_pk_bf16(v1[2], v1[3]);
                    *(u32x4*)(rowp + bj * HALF) = w; } }
    }
};
template <class Epi, class Sched, bool ALIGN_EPI = false, bool SP2 = false>
__device__ __forceinline__ void gemm_phase(int WV_, PG8_LAS unsigned char* lds, const Gemm g, const Sched& S, const Epi& E) {
    const int tid = LTID(WV_), wid = __builtin_amdgcn_readfirstlane(tid >> 6), lane = tid & 63, wr = wid >> 2, wc = wid & 3, fr = lane & 15, fq = lane >> 4;
    const int K = g.K, nt = K / BK;
    unsigned voffA[2], voffB[2];
#pragma unroll
    for (int i = 0; i < 2; ++i) { int R, C; stage_rc(tid * 16 + i * 8192, R, C); const int Rb = Epi::PERM ? ((R & ~31) + perm32(R & 31)) : R;
        voffA[i] = (unsigned)(R * K + C) * 2u; voffB[i] = (unsigned)(Rb * K + C) * 2u; }
    const size_t kstep = (size_t)(BK * 2);
    const size_t hstep = (size_t)HALF * K * 2;
    const size_t tstep = 2 * hstep;
    const unsigned ldsw = (unsigned)wid * 1024u;
    const int aoff = lds_byte(wr * 64 + fr, fq * 8), boff = lds_byte(wc * 32 + fr, fq * 8);
#define PG8_SA(b, h) (((b) * 2 + (h)) * HTB)
#define PG8_SB(b, h) ((4 + (b) * 2 + (h)) * HTB)
#define PG8_STAGE(bufoff, gbase, voff) do { _Pragma("unroll") for (int _i = 0; _i < 2; ++_i) \
        __builtin_amdgcn_global_load_lds((const unsigned*)((const char*)(gbase) + (voff)[_i]), (PG8_LAS unsigned*)(lds + (bufoff) + ldsw + _i * 8192), 16, 0, 0); } while (0)
#define PG8_LDA(dst, b, h) do { _Pragma("unroll") for (int m = 0; m < 4; ++m) _Pragma("unroll") for (int k = 0; k < 2; ++k) dst[m][k] = *(const PG8_LAS bf16x8*)(lds + PG8_SA(b, h) + aoff + m * 2048 + k * 1024); } while (0)
#define PG8_LDB(dst, b, h) do { _Pragma("unroll") for (int n = 0; n < 2; ++n) _Pragma("unroll") for (int k = 0; k < 2; ++k) dst[n][k] = *(const PG8_LAS bf16x8*)(lds + PG8_SB(b, h) + boff + n * 2048 + k * 1024); } while (0)
#define PG8_MMA(ai, bj, At, Bt) do { __builtin_amdgcn_s_setprio(1); _Pragma("unroll") for (int m = 0; m < 4; ++m) _Pragma("unroll") for (int n = 0; n < 2; ++n) _Pragma("unroll") for (int k = 0; k < 2; ++k) \
        acc[ai][bj][m][n] = __builtin_amdgcn_mfma_f32_16x16x32_bf16(Bt[n][k], At[m][k], acc[ai][bj][m][n], 0, 0, 0); __builtin_amdgcn_s_setprio(0); } while (0)
#define PG8_WAIT_V(n) asm volatile("s_waitcnt vmcnt(" #n ")" ::: "memory")
#define PG8_WAIT_L(n) asm volatile("s_waitcnt lgkmcnt(" #n ")" ::: "memory")
#define PG8_BAR __builtin_amdgcn_s_barrier()
#define PG8_SCHED __builtin_amdgcn_sched_barrier(0)
    Unit cur, nxt; int ui = 0;
    if (!S.next(0, cur)) return;
    f32x4 acc[2][2][4][2];
#pragma unroll
    for (int a = 0; a < 2; ++a)
#pragma unroll
        for (int b = 0; b < 2; ++b)
#pragma unroll
            for (int m = 0; m < 4; ++m)
#pragma unroll
                for (int n = 0; n < 2; ++n) acc[a][b][m][n] = (f32x4){0.f, 0.f, 0.f, 0.f};
    bf16x8 At[4][2], B0[2][2], B1[2][2];
    const char* cA = (const char*)g.A + (size_t)cur.pm * tstep; const char* cB = (const char*)g.Bt + (size_t)cur.pn * tstep;
    S.a_ready(cur);
    if constexpr (SP2) {
        PG8_STAGE(PG8_SB(0, 0), cB, voffB); PG8_STAGE(PG8_SB(0, 1), cB + hstep, voffB); PG8_STAGE(PG8_SA(0, 0), cA, voffA); PG8_STAGE(PG8_SA(0, 1), cA + hstep, voffA);
        if (wr == 1) PG8_BAR;
        PG8_WAIT_V(2); PG8_BAR;
        PG8_STAGE(PG8_SB(1, 0), cB + kstep, voffB); PG8_STAGE(PG8_SA(1, 0), cA + kstep, voffA); PG8_STAGE(PG8_SB(1, 1), cB + hstep + kstep, voffB);
        PG8_WAIT_V(6); PG8_BAR;
    } else {
        PG8_STAGE(PG8_SB(0, 0), cB, voffB); PG8_STAGE(PG8_SA(0, 0), cA, voffA); PG8_STAGE(PG8_SB(0, 1), cB + hstep, voffB); PG8_STAGE(PG8_SA(0, 1), cA + hstep, voffA);
        if (wr == 1) PG8_BAR;
        PG8_WAIT_V(4); PG8_BAR;
        PG8_STAGE(PG8_SB(1, 0), cB + kstep, voffB); PG8_STAGE(PG8_SA(1, 0), cA + kstep, voffA); PG8_STAGE(PG8_SB(1, 1), cB + hstep + kstep, voffB);
        PG8_WAIT_V(6); PG8_BAR;
    }
    for (;;) {
        const bool has_next = S.next(ui + 1, nxt);
        const char* nA = has_next ? (const char*)g.A + (size_t)nxt.pm * tstep : cA; const char* nB = has_next ? (const char*)g.Bt + (size_t)nxt.pn * tstep : cB;
        for (int t = 0; t < nt; t += 2) {
            const bool last = (t == nt - 2);
            const char* a1 = cA + (size_t)(t + 1) * kstep;
            const char* a2 = last ? nA : cA + (size_t)(t + 2) * kstep; const char* b2 = last ? nB : cB + (size_t)(t + 2) * kstep;
            const char* a3 = a2 + kstep; const char* b3 = b2 + kstep;
            if (last && has_next) S.a_ready(nxt);
            if constexpr (SP2) {
            PG8_LDB(B0, 0, 0); PG8_LDB(B1, 0, 1); PG8_SCHED; PG8_LDA(At, 0, 0); PG8_STAGE(PG8_SA(1, 1), a1 + hstep, voffA);
            PG8_WAIT_V(8); PG8_WAIT_L(0); PG8_BAR; PG8_MMA(0, 0, At, B0); PG8_MMA(0, 1, At, B1); PG8_BAR; PG8_SCHED;
            PG8_LDA(At, 0, 1); PG8_STAGE(PG8_SB(0, 0), b2, voffB); PG8_STAGE(PG8_SB(0, 1), b2 + hstep, voffB); PG8_STAGE(PG8_SA(0, 0), a2, voffA);
            PG8_WAIT_V(8); PG8_WAIT_L(0); PG8_BAR; PG8_MMA(1, 0, At, B0); PG8_MMA(1, 1, At, B1); PG8_BAR; PG8_SCHED;
            PG8_LDB(B0, 1, 0); PG8_LDB(B1, 1, 1); PG8_SCHED; PG8_LDA(At, 1, 0); PG8_STAGE(PG8_SA(0, 1), a2 + hstep, voffA);
            PG8_WAIT_V(8); PG8_WAIT_L(0); PG8_BAR; PG8_MMA(0, 0, At, B0); PG8_MMA(0, 1, At, B1); PG8_BAR; PG8_SCHED;
            PG8_LDA(At, 1, 1); PG8_STAGE(PG8_SB(1, 0), b3, voffB); PG8_STAGE(PG8_SB(1, 1), b3 + hstep, voffB); PG8_STAGE(PG8_SA(1, 0), a3, voffA);
            PG8_WAIT_V(8); PG8_WAIT_L(0); PG8_BAR; PG8_MMA(1, 0, At, B0); PG8_MMA(1, 1, At, B1); PG8_BAR; PG8_SCHED;
            } else {
            PG8_LDB(B0, 0, 0); PG8_SCHED; PG8_LDA(At, 0, 0); PG8_STAGE(PG8_SA(1, 1), a1 + hstep, voffA);
            PG8_WAIT_L(8); PG8_BAR; PG8_WAIT_L(0); PG8_MMA(0, 0, At, B0); PG8_BAR; PG8_SCHED;
            PG8_LDB(B1, 0, 1); PG8_STAGE(PG8_SB(0, 0), b2, voffB);
            PG8_BAR; PG8_WAIT_L(0); PG8_MMA(0, 1, At, B1); PG8_BAR;
            PG8_LDA(At, 0, 1); PG8_STAGE(PG8_SA(0, 0), a2, voffA);
            PG8_BAR; PG8_WAIT_L(0); PG8_MMA(1, 0, At, B0); PG8_BAR; PG8_SCHED;
            PG8_STAGE(PG8_SB(0, 1), b2 + hstep, voffB);
            PG8_WAIT_V(6); PG8_BAR; PG8_MMA(1, 1, At, B1); PG8_BAR;
            PG8_LDB(B0, 1, 0); PG8_SCHED; PG8_LDA(At, 1, 0); PG8_STAGE(PG8_SA(0, 1), a2 + hstep, voffA);
            PG8_WAIT_L(8); PG8_BAR; PG8_WAIT_L(0); PG8_MMA(0, 0, At, B0); PG8_BAR; PG8_SCHED;
            PG8_LDB(B1, 1, 1); PG8_STAGE(PG8_SB(1, 0), b3, voffB);
            PG8_BAR; PG8_WAIT_L(0); PG8_MMA(0, 1, At, B1); PG8_BAR;
            PG8_LDA(At, 1, 1); PG8_STAGE(PG8_SA(1, 0), a3, voffA);
            PG8_BAR; PG8_WAIT_L(0); PG8_MMA(1, 0, At, B0); PG8_BAR; PG8_SCHED;
            PG8_STAGE(PG8_SB(1, 1), b3 + hstep, voffB);
            PG8_WAIT_V(6); PG8_BAR; PG8_MMA(1, 1, At, B1); PG8_BAR;
            }
        }
        if constexpr (ALIGN_EPI) { if (wr == 0) PG8_BAR; }
        if constexpr (!Epi::AFTER_DRAIN) { E(acc, cur, wr, wc, fr, fq); S.done(cur); }
        if (!has_next) break;
#pragma unroll
        for (int a = 0; a < 2; ++a)
#pragma unroll
            for (int b = 0; b < 2; ++b)
#pragma unroll
                for (int m = 0; m < 4; ++m)
#pragma unroll
                    for (int n = 0; n < 2; ++n) acc[a][b][m][n] = (f32x4){0.f, 0.f, 0.f, 0.f};
        cur = nxt; cA = nA; cB = nB; ++ui;
        if constexpr (ALIGN_EPI) { if (wr == 1) PG8_BAR; }
    }
    PG8_WAIT_V(0);
    if constexpr (!ALIGN_EPI) { if (wr == 0) PG8_BAR; }
    PG8_BAR;
    if constexpr (Epi::AFTER_DRAIN) { E.fused(acc, cur, wr, wc, fr, fq, lds, wid, lane); S.done(cur); }
#undef PG8_SA
#undef PG8_SB
#undef PG8_STAGE
#undef PG8_LDA
#undef PG8_LDB
#undef PG8_MMA
#undef PG8_WAIT_V
#undef PG8_WAIT_L
#undef PG8_BAR
#undef PG8_SCHED
}
}
namespace pg8 {
struct EpiF32 {
    static constexpr bool PERM = false, AFTER_DRAIN = false;
    float* O; int ldc;
    __device__ __forceinline__ void operator()(const f32x4 (&acc)[2][2][4][2], const Unit& u, int wr, int wc, int fr, int fq) const {
        { int ln_ = LANEID(); asm volatile("" : "+v"(ln_)); fr = ln_ & 15; fq = ln_ >> 4; }
        const int row0 = u.pm * BM + wr * 64 + fr, col0 = u.pn * BM + wc * 32 + 4 * fq;
#pragma unroll
        for (int ai = 0; ai < 2; ++ai)
#pragma unroll
            for (int m = 0; m < 4; ++m) { float* rowp = O + (size_t)(row0 + ai * HALF + m * 16) * ldc + col0;
#pragma unroll
                for (int bj = 0; bj < 2; ++bj)
#pragma unroll
                    for (int n = 0; n < 2; ++n) *(f32x4*)(rowp + bj * HALF + n * 16) = acc[ai][bj][m][n]; }
    }
};
struct EpiResY {
    static constexpr bool PERM = false, AFTER_DRAIN = false;
    const float* hin; float* yout; bf16_t* yb; float* stats; float alpha;
    __device__ __forceinline__ void operator()(const f32x4 (&acc)[2][2][4][2], const Unit& u, int wr, int wc, int fr, int fq) const {
        { int ln_ = LANEID(); asm volatile("" : "+v"(ln_)); fr = ln_ & 15; fq = ln_ >> 4; }
        const int row0 = u.pm * BM + wr * 64 + fr, col0 = u.pn * BM + wc * 32 + 4 * fq;
#pragma unroll
        for (int ai = 0; ai < 2; ++ai)
#pragma unroll
            for (int m = 0; m < 4; ++m) {
                const int row = row0 + ai * HALF + m * 16;
                float s = 0.f, s2 = 0.f;
#pragma unroll
                for (int bj = 0; bj < 2; ++bj)
#pragma unroll
                    for (int n = 0; n < 2; ++n) {
                        const size_t off = (size_t)row * 1024 + col0 + bj * HALF + n * 16;
                        const f32x4 hv = *(const f32x4*)(hin + off);
                        const f32x4 y = hv * alpha + acc[ai][bj][m][n];
                        *(f32x4*)(yout + off) = y;
                        typedef unsigned u32x2v __attribute__((ext_vector_type(2)));
                        u32x2v w; w.x = cvt_pk_bf16(y[0], y[1]); w.y = cvt_pk_bf16(y[2], y[3]);
                        *(u32x2v*)(yb + off) = w;
                        s += (y[0] + y[1]) + (y[2] + y[3]); s2 += (y[0] * y[0] + y[1] * y[1]) + (y[2] * y[2] + y[3] * y[3]);
                    }
                s += __shfl_xor(s, 16); s += __shfl_xor(s, 32); s2 += __shfl_xor(s2, 16); s2 += __shfl_xor(s2, 32);
                if (fq == 0) { atomicAdd(stats + 2 * (size_t)row, s); atomicAdd(stats + 2 * (size_t)row + 1, s2); }
            }
    }
};
struct EpiLnFold {
    static constexpr bool PERM = true, AFTER_DRAIN = false;
    bf16_t* O; const float* stats; const float* colsum; const float* colbias; float eps;
    __device__ __forceinline__ void operator()(const f32x4 (&acc)[2][2][4][2], const Unit& u, int wr, int wc, int fr, int fq) const {
        { int ln_ = LANEID(); asm volatile("" : "+v"(ln_)); fr = ln_ & 15; fq = ln_ >> 4; }
        const int row0 = u.pm * BM + wr * 64 + fr, col0 = u.pn * BM + wc * 32 + 8 * fq;
        f32x4 cs[2][2], cb[2][2];
#pragma unroll
        for (int bj = 0; bj < 2; ++bj)
#pragma unroll
            for (int n = 0; n < 2; ++n) { cs[bj][n] = *(const f32x4*)(colsum + col0 + bj * HALF + 4 * n); cb[bj][n] = *(const f32x4*)(colbias + col0 + bj * HALF + 4 * n); }
#pragma unroll
        for (int ai = 0; ai < 2; ++ai)
#pragma unroll
            for (int m = 0; m < 4; ++m) {
                const int row = row0 + ai * HALF + m * 16;
                const float sm_ = stats[2 * (size_t)row], sq_ = stats[2 * (size_t)row + 1];
                const float mean = sm_ * (1.0f / 1024.0f);
                const float rstd = 1.0f / sqrtf(fmaxf(sq_ * (1.0f / 1024.0f) - mean * mean, 0.f) + eps);
                bf16_t* rowp = O + (size_t)row * 1024 + col0;
#pragma unroll
                for (int bj = 0; bj < 2; ++bj) {
                    const f32x4 v0 = (acc[ai][bj][m][0] - cs[bj][0] * mean) * rstd + cb[bj][0], v1 = (acc[ai][bj][m][1] - cs[bj][1] * mean) * rstd + cb[bj][1];
                    u32x4 w; w.x = cvt_pk_bf16(v0[0], v0[1]); w.y = cvt_pk_bf16(v0[2], v0[3]); w.z = cvt_pk_bf16(v1[0], v1[1]); w.w = cvt_pk_bf16(v1[2], v1[3]);
                    *(u32x4*)(rowp + bj * HALF) = w;
                }
            }
    }
};
__device__ __forceinline__ unsigned cvt_pk_bf16_t(float lo, float hi) { unsigned r; asm volatile("s_nop 0\n\tv_cvt_pk_bf16_f32 %0, %1, %2" : "=v"(r) : "v"(lo), "v"(hi)); return r; }
struct EpiBf16Sig {
    static constexpr bool PERM = true, AFTER_DRAIN = false;
    bf16_t* O; int ldc; int sig_col0;
    __device__ __forceinline__ void operator()(const f32x4 (&acc)[2][2][4][2], const Unit& u, int wr, int wc, int fr, int fq) const {
        { int ln_ = LANEID(); asm volatile("" : "+v"(ln_)); fr = ln_ & 15; fq = ln_ >> 4; }
        const int row0 = u.pm * BM + wr * 64 + fr; const int col0 = u.pn * BM + wc * 32 + 8 * fq;
#pragma unroll
        for (int bj = 0; bj < 2; ++bj) {
            if (col0 + bj * HALF >= sig_col0) {
#pragma unroll
                for (int ai = 0; ai < 2; ++ai)
#pragma unroll
                    for (int m = 0; m < 4; ++m) { bf16_t* rowp = O + (size_t)(row0 + ai * HALF + m * 16) * ldc + col0;
                        f32x4 v0 = acc[ai][bj][m][0], v1 = acc[ai][bj][m][1];
#pragma unroll
                        for (int e = 0; e < 4; ++e) { v0[e] = __builtin_amdgcn_rcpf(1.f + __builtin_amdgcn_exp2f(-1.44269504f * v0[e])); v1[e] = __builtin_amdgcn_rcpf(1.f + __builtin_amdgcn_exp2f(-1.44269504f * v1[e])); }
                        u32x4 w; w.x = cvt_pk_bf16_t(v0[0], v0[1]); w.y = cvt_pk_bf16_t(v0[2], v0[3]); w.z = cvt_pk_bf16_t(v1[0], v1[1]); w.w = cvt_pk_bf16_t(v1[2], v1[3]);
                        *(u32x4*)(rowp + bj * HALF) = w; }
            } else {
#pragma unroll
                for (int ai = 0; ai < 2; ++ai)
#pragma unroll
                    for (int m = 0; m < 4; ++m) { bf16_t* rowp = O + (size_t)(row0 + ai * HALF + m * 16) * ldc + col0;
                        const f32x4 v0 = acc[ai][bj][m][0], v1 = acc[ai][bj][m][1];
                        u32x4 w; w.x = cvt_pk_bf16(v0[0], v0[1]); w.y = cvt_pk_bf16(v0[2], v0[3]); w.z = cvt_pk_bf16(v1[0], v1[1]); w.w = cvt_pk_bf16(v1[2], v1[3]);
                        *(u32x4*)(rowp + bj * HALF) = w; }
            }
        }
    }
};
}

typedef unsigned short bf16;
constexpr int T_ = 16384, S_ = 4096, NBATCH = 4, D_ = 1024, NCOL = 6824, NP = 6912, DEPTH_ = 2;
constexpr int C_QA = 0, C_KA = 256, C_VA = 320, C_QI = 384, C_KI = 640, C_WI = 672, C_QB = 680, C_KB = 936, C_VB = 1064,
              C_QC = 1192, C_KC = 1448, C_VC = 1704, C_QD = 1960, C_KD = 2216, C_VD = 2472, C_G = 2728;
constexpr int NTHR = 512, NWAVE = 8;
constexpr float ALPHA = 1.41421356237309515f;
constexpr float LN_EPS = 1e-5f;
constexpr size_t MiB = 1u << 20;
constexpr size_t WS_STATS = 1 * MiB  , WS_COLS = 1 * MiB + 512 * 1024  ;
constexpr size_t WS_CTL = 0, WS_WIN_T = 2 * MiB, WS_WOUT_T = 30 * MiB, WS_WQ_T = 34 * MiB, WS_WBR_T = 38 * MiB, WS_HB = 42 * MiB,
                 WS_P = 74 * MiB, WS_MIX = 74 * MiB  , WS_Q = 138 * MiB  , WS_YS = 290 * MiB, WS_MRG = 322 * MiB,
                 WS_MASK = 354 * MiB, WS_EID = 362 * MiB, WS_GATE = 370 * MiB, WS_KMEAN = 378 * MiB, WS_SKB = 379 * MiB, WS_UV = 380 * MiB, WS_END = 508 * MiB;
constexpr size_t WIN_T_BYTES = (size_t)NP * 1024 * 2;
constexpr int LDS_BYTES = 144 * 1024;

struct Params { const float* in[13]; float* out; unsigned char* ws; };

__device__ __forceinline__ float bf2f(bf16 v) { return __uint_as_float((unsigned)v << 16); }
__device__ __forceinline__ unsigned f2bf(float f) { unsigned u = __float_as_uint(f); return (u + 0x7fffu + ((u >> 16) & 1u)) >> 16; }
__device__ __forceinline__ unsigned pk2(float lo, float hi) { return f2bf(lo) | (f2bf(hi) << 16); }
__device__ __forceinline__ void unpack8(const uint4 v, float* o) {
    o[0] = __uint_as_float(v.x << 16); o[1] = __uint_as_float(v.x & 0xffff0000u); o[2] = __uint_as_float(v.y << 16); o[3] = __uint_as_float(v.y & 0xffff0000u);
    o[4] = __uint_as_float(v.z << 16); o[5] = __uint_as_float(v.z & 0xffff0000u); o[6] = __uint_as_float(v.w << 16); o[7] = __uint_as_float(v.w & 0xffff0000u);
}
__device__ __forceinline__ float wave_sum(float v) {
#pragma unroll
    for (int o = 32; o > 0; o >>= 1) v += __shfl_xor(v, o);
    return v;
}
__device__ __forceinline__ float wave_max(float v) {
#pragma unroll
    for (int o = 32; o > 0; o >>= 1) v = fmaxf(v, __shfl_xor(v, o));
    return v;
}
__device__ __forceinline__ int wave_sum_i(int v) {
#pragma unroll
    for (int o = 32; o > 0; o >>= 1) v += __shfl_xor(v, o);
    return v;
}
__device__ __forceinline__ float logsig(float x) { return fminf(x, 0.f) - log1pf(expf(-fabsf(x))); }

__device__ void transpose_items(int WV_, const float* W, int K, int N, bf16* WT, float* sm, int item0, int nitems_total, int item_stride,
                                const float* rs_g = nullptr, const float* rs_b = nullptr, float* colsum = nullptr, float* colbias = nullptr) {
    const int tid = LTID(WV_);
    const int nkb = K / 64, nnb = (N + 63) / 64;
    for (int it = item0; it < nkb * nnb; it += item_stride) {
        const int kb = it % nkb, nb = it / nkb, k0 = kb * 64, n0 = nb * 64;
        __syncthreads();
        for (int e = tid; e < 64 * 64; e += NTHR) { const int kk = e >> 6, nn = e & 63; sm[kk * 65 + nn] = (n0 + nn < N) ? W[(size_t)(k0 + kk) * N + n0 + nn] : 0.f; }
        __syncthreads();
        if (rs_g) {
            if (tid < 64) { float cs = 0.f, cb = 0.f;
                for (int kk = 0; kk < 64; ++kk) { const float w = sm[kk * 65 + tid]; cs += w * rs_g[k0 + kk]; cb += w * rs_b[k0 + kk]; }
                atomicAdd(colsum + n0 + tid, cs); atomicAdd(colbias + n0 + tid, cb); }
            __syncthreads();
            for (int e = tid; e < 64 * 64; e += NTHR) { const int kk = e >> 6, nn = e & 63; sm[kk * 65 + nn] *= rs_g[k0 + kk]; }
            __syncthreads();
        }
        { const int nn = tid >> 3, c = tid & 7;
          if (n0 + nn < N) { uint4 o; o.x = pk2(sm[(8 * c + 0) * 65 + nn], sm[(8 * c + 1) * 65 + nn]); o.y = pk2(sm[(8 * c + 2) * 65 + nn], sm[(8 * c + 3) * 65 + nn]);
              o.z = pk2(sm[(8 * c + 4) * 65 + nn], sm[(8 * c + 5) * 65 + nn]); o.w = pk2(sm[(8 * c + 6) * 65 + nn], sm[(8 * c + 7) * 65 + nn]);
              *(uint4*)(WT + (size_t)(n0 + nn) * K + k0 + 8 * c) = o; } }
    }
    __syncthreads();
}
__device__ void prologue_phase(int WV_, const Params& p, float* sm) {
    const int tid = LTID(WV_), B = LBID(), G = LGRID();
    unsigned char* ws = p.ws;
    for (int l = 0; l < DEPTH_; ++l) {
        bf16* win_t = (bf16*)(ws + WS_WIN_T + l * WIN_T_BYTES);
        transpose_items(WV_, p.in[1] + (size_t)l * 1024 * NCOL, 1024, NCOL, win_t, sm, B, 0, G);
        for (int i = B * NTHR + tid; i < (NP - NCOL) * 1024 / 8; i += G * NTHR) ((uint4*)(win_t + (size_t)NCOL * 1024))[i] = make_uint4(0u, 0u, 0u, 0u);
        transpose_items(WV_, p.in[3] + (size_t)l * 1024 * 1024, 1024, 1024, (bf16*)(ws + WS_WOUT_T) + (size_t)l * 1024 * 1024, sm, B, 0, G);
        transpose_items(WV_, p.in[7] + (size_t)l * 1024 * 1024, 1024, 1024, (bf16*)(ws + WS_WQ_T) + (size_t)l * 1024 * 1024, sm, B, 0, G,
                        p.in[5] + l * 1024, p.in[6] + l * 1024, (float*)(ws + WS_COLS) + l * 2048, (float*)(ws + WS_COLS) + l * 2048 + 1024);
        for (int n = 0; n < 4; ++n)
            transpose_items(WV_, p.in[2] + ((size_t)l * 4 + n) * 256 * 1024, 256, 1024, (bf16*)(ws + WS_WBR_T) + ((size_t)l * 4 + n) * 1024 * 256, sm, B, 0, G);
    }
    const float4* x4 = (const float4*)p.in[0]; uint2* hb2 = (uint2*)(ws + WS_HB);
    for (size_t i = (size_t)B * NTHR + tid; i < (size_t)T_ * 1024 / 4; i += (size_t)G * NTHR) { const float4 v = x4[i]; hb2[i] = make_uint2(pk2(v.x, v.y), pk2(v.z, v.w)); }
}

__device__ __forceinline__ void ln_row(float4 (&v)[4], const float* g, const float* bb, float* orow, bf16* obrow, int lane) {
    float s = 0.f;
#pragma unroll
    for (int j = 0; j < 4; ++j) s += (v[j].x + v[j].y) + (v[j].z + v[j].w);
    const float mean = wave_sum(s) * (1.0f / 1024.0f);
    float s2 = 0.f;
#pragma unroll
    for (int j = 0; j < 4; ++j) { v[j].x -= mean; v[j].y -= mean; v[j].z -= mean; v[j].w -= mean; s2 += (v[j].x * v[j].x + v[j].y * v[j].y) + (v[j].z * v[j].z + v[j].w * v[j].w); }
    const float rstd = 1.0f / sqrtf(wave_sum(s2) * (1.0f / 1024.0f) + LN_EPS);
#pragma unroll
    for (int j = 0; j < 4; ++j) {
        const float4 gg = ((const float4*)g)[j * 64 + lane], b4 = ((const float4*)bb)[j * 64 + lane];
        float4 o; o.x = v[j].x * rstd * gg.x + b4.x; o.y = v[j].y * rstd * gg.y + b4.y; o.z = v[j].z * rstd * gg.z + b4.z; o.w = v[j].w * rstd * gg.w + b4.w;
        ((float4*)orow)[j * 64 + lane] = o;
        ((uint2*)obrow)[j * 64 + lane] = make_uint2(pk2(o.x, o.y), pk2(o.z, o.w));
    }
}
__device__ void ln1_phase(int WV_, const float* hin, const float* add, const float* g, const float* bb, float* hout, bf16* hb) {
    const int lane = LTID(WV_) & 63, wave = LTID(WV_) >> 6;
    for (int row = LBID() * NWAVE + wave; row < T_; row += LGRID() * NWAVE) {
        float4 v[4];
#pragma unroll
        for (int j = 0; j < 4; ++j) {
            const float4 a = ((const float4*)(hin + (size_t)row * 1024))[j * 64 + lane], m = ((const float4*)(add + (size_t)row * 1024))[j * 64 + lane];
            v[j].x = ALPHA * a.x + m.x; v[j].y = ALPHA * a.y + m.y; v[j].z = ALPHA * a.z + m.z; v[j].w = ALPHA * a.w + m.w;
        }
        ln_row(v, g, bb, hout + (size_t)row * 1024, hb + (size_t)row * 1024, lane);
    }
}


typedef short bf16x8_t __attribute__((ext_vector_type(8)));
typedef float f32x16_t __attribute__((ext_vector_type(16)));
typedef float f32x2_t __attribute__((ext_vector_type(2)));
typedef __bf16 bf16x2_t __attribute__((ext_vector_type(2)));
__device__ __forceinline__ unsigned cvtpk(float lo, float hi) { f32x2_t v = {lo, hi}; bf16x2_t b = __builtin_convertvector(v, bf16x2_t); return __builtin_bit_cast(unsigned, b); }
__device__ __forceinline__ int crow(int r, int hi) { return (r & 3) + 8 * (r >> 2) + 4 * hi; }
__device__ __forceinline__ float xlane32(float v) { return __shfl_xor(v, 32); }
__device__ __forceinline__ float vmax(float a, float b) { float r; asm("v_max_f32_e32 %0, %1, %2" : "=v"(r) : "v"(a), "v"(b)); return r; }
__device__ __forceinline__ float vmin(float a, float b) { float r; asm("v_min_f32_e32 %0, %1, %2" : "=v"(r) : "v"(a), "v"(b)); return r; }
__device__ __forceinline__ float vmax3(float a, float b, float c) { float r; asm("v_max3_f32 %0, %1, %2, %3" : "=v"(r) : "v"(a), "v"(b), "v"(c)); return r; }

constexpr int AT_KP = 72, AT_VP = 96;
constexpr int AT_KS = 0, AT_KS_BYTES = 64 * AT_KP * 2;
constexpr int AT_VT = 2 * AT_KS_BYTES, AT_VT_BYTES = 64 * AT_VP * 2;
constexpr int AT_KM = AT_VT + 2 * AT_VT_BYTES;
constexpr int AT_MISC = AT_KM + 32 * AT_KP * 2;
constexpr float LOG2E = 1.4426950408889634f;

__device__ __forceinline__ unsigned mk_unit(int kind, int b, int x, int y) { return ((unsigned)kind << 30) | ((unsigned)b << 28) | ((unsigned)x << 8) | (unsigned)y; }
__device__ void build_unit_table(unsigned* tab, int i) {
    int n = 0; unsigned res = 0u;
#pragma unroll 1
    for (int c = 64; c >= 1; --c) {
        if (i >= n && i < n + 4) res = mk_unit(0, i - n, 0, c - 1);
        n += 4;
        if ((c & 3) == 0) { if (i >= n && i < n + 16) { const int j = i - n; res = mk_unit(2, j >> 2, j & 3, c / 4 - 1); } n += 16; }
    }
    if (i < 512) tab[i] = res;
}

template <int kind> __device__ __forceinline__ void attn_unit(int WV_, const bf16* P, const unsigned char* mask, const float* kmean, const float* sinks, bf16* ys,
                                unsigned char* lds, int b, int ux, int uy) {
    int tid_ = LTID(WV_); asm volatile("" : "+v"(tid_));
    const int tid = tid_, lane = tid & 63, wave = __builtin_amdgcn_readfirstlane(tid >> 6), r32 = lane & 31, hi = lane >> 5;
    bf16* s_km = (bf16*)(lds + AT_KM);
    const int skey = tid >> 3, sc = tid & 7;
    {
        const bf16* Pb = P + (size_t)b * S_ * NP;
        int q0w, qcol, kcol, vcol, ycol, kt_hi, kt_lo; float slope2 = 0.f, sink2 = 0.f;
        if (kind == 0) { const int head = wave >> 1; q0w = uy * 64 + (wave & 1) * 32; qcol = C_QA + head * 64; kcol = C_KA; vcol = C_VA; ycol = head * 64;
            slope2 = exp2f(-8.0f * (float)(3 * head + 1) / 12.0f) * LOG2E; kt_hi = uy; kt_lo = 0; }
        else if (kind == 1) { const int hq = ux * 2 + (wave >> 2); q0w = uy * 128 + (wave & 3) * 32; qcol = C_QB + hq * 64; kcol = C_KB + ux * 64; vcol = C_VB + ux * 64; ycol = 256 + hq * 64;
            slope2 = exp2f(-8.0f * (float)(3 * hq + 2) / 12.0f) * LOG2E; sink2 = sinks[hq] * LOG2E; kt_hi = 2 * uy + 1; kt_lo = (2 * uy - 2 > 0) ? 2 * uy - 2 : 0; }
        else if (kind == 2) { q0w = uy * 256 + wave * 32; qcol = C_QC + ux * 64; kcol = C_KC + ux * 64; vcol = C_VC + ux * 64; ycol = 512 + ux * 64;
            slope2 = exp2f(-8.0f * (float)(3 * ux + 3) / 12.0f) * LOG2E; kt_hi = 4 * uy + 3; kt_lo = 0; }
        else { q0w = uy * 256 + wave * 32; qcol = C_QD + ux * 64; kcol = C_KD + ux * 64; vcol = C_VD + ux * 64; ycol = 768 + ux * 64; kt_hi = 4 * uy + 3; kt_lo = 0; }
        const int qpos = q0w + r32;
        bf16x8_t qf[4];
        { const bf16* qp = Pb + (size_t)qpos * NP + qcol + 8 * hi;
#pragma unroll
          for (int ks = 0; ks < 4; ++ks) qf[ks] = *(const bf16x8_t*)(qp + 16 * ks); }
        {
            const float qs = (kind == 3) ? 0.125f : 0.125f * LOG2E;
            typedef unsigned u32x4_t __attribute__((ext_vector_type(4)));
#pragma unroll
            for (int ks = 0; ks < 4; ++ks) { u32x4_t w = __builtin_bit_cast(u32x4_t, qf[ks]);
#pragma unroll
                for (int i = 0; i < 4; ++i) w[i] = cvtpk(__uint_as_float(w[i] << 16) * qs, __uint_as_float(w[i] & 0xffff0000u) * qs);
                qf[ks] = __builtin_bit_cast(bf16x8_t, w); }
        }
        float sb[16];
#pragma unroll
        for (int r = 0; r < 16; ++r) sb[r] = slope2 * (float)((r & 3) + 8 * (r >> 2));
        unsigned bm = 0u;
        if (kind == 2) {
            const int own = uy;
            for (int e = tid; e < 32 * 64; e += NTHR) { const int row = e >> 6, d = e & 63; s_km[row * AT_KP + d] = (row < 16) ? (bf16)f2bf(kmean[((b * 4 + ux) * 16 + row) * 64 + d]) : (bf16)0; }
            __syncthreads();
            f32x16_t gacc;
#pragma unroll
            for (int r = 0; r < 16; ++r) gacc[r] = 0.f;
#pragma unroll
            for (int ks = 0; ks < 4; ++ks) { const bf16x8_t a = *(const bf16x8_t*)(s_km + r32 * AT_KP + 16 * ks + 8 * hi); gacc = __builtin_amdgcn_mfma_f32_32x32x16_bf16(a, qf[ks], gacc, 0, 0, 0); }
            float gt[16];
#pragma unroll
            for (int r = 0; r < 8; ++r) { const float mine = gacc[r], other = xlane32(mine); const int bi = crow(r, 0);
                gt[bi] = hi ? other : mine; gt[bi + 4] = hi ? mine : other; }
#pragma unroll
            for (int n = 0; n < 16; ++n) if (n >= own) gt[n] = -INFINITY;
#pragma unroll
            for (int rep = 0; rep < 3; ++rep) {
                float mx = -INFINITY;
#pragma unroll
                for (int n = 0; n < 16; ++n) mx = fmaxf(mx, gt[n]);
                bool done = !(mx > -INFINITY);
#pragma unroll
                for (int n = 0; n < 16; ++n) { const bool hit = !done && gt[n] == mx; if (hit) { bm |= 1u << n; gt[n] = -INFINITY; done = true; } }
            }
        }
        f32x16_t o0, o1;
#pragma unroll
        for (int r = 0; r < 16; ++r) { o0[r] = 0.f; o1[r] = 0.f; }
        float m_run = -INFINITY, l_run = 0.f, carry = 0.f;
        const bf16* kg = Pb + (size_t)skey * NP + kcol + sc * 8;
        const bf16* vg = Pb + (size_t)skey * NP + vcol + sc * 8;
        uint4 rk = *(const uint4*)(kg + (size_t)kt_hi * 64 * NP), rv = *(const uint4*)(vg + (size_t)kt_hi * 64 * NP);
        int buf = 0;
        { bf16* ks_ = (bf16*)(lds + AT_KS); bf16* vt_ = (bf16*)(lds + AT_VT);
          *(uint4*)(ks_ + skey * AT_KP + sc * 8) = rk;
          *(uint4*)(vt_ + skey * AT_VP + sc * 8) = rv; }
        __syncthreads();
        bool wave_done = false;
        uint2 mw_next = make_uint2(0u, 0u);
        if (kind == 0) mw_next = *(const uint2*)(mask + (size_t)(b * S_ + qpos) * 512 + kt_hi * 8);
        for (int kt = kt_hi; kt >= kt_lo; --kt) {
            const bool more = kt > kt_lo;
            const uint2 mw = mw_next;
            if (kind == 0 && more) mw_next = *(const uint2*)(mask + (size_t)(b * S_ + qpos) * 512 + (kt - 1) * 8);
            if (more) { rk = *(const uint4*)(kg + (size_t)(kt - 1) * 64 * NP); rv = *(const uint4*)(vg + (size_t)(kt - 1) * 64 * NP); }
            const bf16* ks_ = (const bf16*)(lds + AT_KS + buf * AT_KS_BYTES);
            const bf16* vt_ = (const bf16*)(lds + AT_VT + buf * AT_VT_BYTES);
            bool active = (kt * 64 <= q0w + 31) && !wave_done;
            if (kind == 1) active = active && (kt * 64 + 63 >= q0w - 127);
            if (active) {
                const int kbase = kt * 64 + 4 * hi;
                f32x16_t p0, p1;
                if (kind != 3) {
                    const float cb = slope2 * (float)(kbase - qpos), cb1 = cb + 32.0f * slope2;
#pragma unroll
                    for (int r = 0; r < 16; ++r) { p0[r] = cb + sb[r]; p1[r] = cb1 + sb[r]; }
                } else {
#pragma unroll
                    for (int r = 0; r < 16; ++r) { p0[r] = 0.f; p1[r] = 0.f; }
                }
#pragma unroll
                for (int ks = 0; ks < 4; ++ks) {
                    const bf16x8_t a0 = *(const bf16x8_t*)(ks_ + r32 * AT_KP + 16 * ks + 8 * hi);
                    const bf16x8_t a1 = *(const bf16x8_t*)(ks_ + (32 + r32) * AT_KP + 16 * ks + 8 * hi);
                    p0 = __builtin_amdgcn_mfma_f32_32x32x16_bf16(a0, qf[ks], p0, 0, 0, 0);
                    p1 = __builtin_amdgcn_mfma_f32_32x32x16_bf16(a1, qf[ks], p1, 0, 0, 0);
                }
                if (kind != 3) {
                    float mx = -INFINITY;
                    if (kind == 0) {
                        const unsigned w0 = mw.x >> (4 * hi), w1 = mw.y >> (4 * hi);
#pragma unroll
                        for (int r = 0; r < 16; ++r) { const int off = (r & 3) + 8 * (r >> 2);
                            p0[r] = (w0 & (1u << off)) ? p0[r] : -INFINITY; p1[r] = (w1 & (1u << off)) ? p1[r] : -INFINITY; mx = vmax3(mx, p0[r], p1[r]); }
                    } else if (kind == 1) {
                        const int rel = qpos - kbase;
#pragma unroll
                        for (int r = 0; r < 16; ++r) { const int off = (r & 3) + 8 * (r >> 2);
                            p0[r] = ((unsigned)(rel - off) < 128u) ? p0[r] : -INFINITY; p1[r] = ((unsigned)(rel - off - 32) < 128u) ? p1[r] : -INFINITY; mx = vmax3(mx, p0[r], p1[r]); }
                    } else {
                        if ((kt >> 2) == uy) {
                            const int rel = qpos - kbase;
#pragma unroll
                            for (int r = 0; r < 16; ++r) { const int off = (r & 3) + 8 * (r >> 2);
                                p0[r] = (off <= rel) ? p0[r] : -INFINITY; p1[r] = (off + 32 <= rel) ? p1[r] : -INFINITY; mx = vmax3(mx, p0[r], p1[r]); }
                        } else {
                            const bool tile_ok = ((bm >> (kt >> 2)) & 1u) != 0u;
#pragma unroll
                            for (int r = 0; r < 16; ++r) { p0[r] = tile_ok ? p0[r] : -INFINITY; p1[r] = tile_ok ? p1[r] : -INFINITY; mx = vmax3(mx, p0[r], p1[r]); }
                        }
                    }
                    mx = vmax(mx, xlane32(mx));
                    const float m_new = vmax(m_run, mx);
                    const float m_safe = (m_new == -INFINITY) ? 0.f : m_new;
                    p0 = p0 - m_safe; p1 = p1 - m_safe;
#pragma unroll
                    for (int r = 0; r < 16; ++r) { p0[r] = __builtin_amdgcn_exp2f(p0[r]); p1[r] = __builtin_amdgcn_exp2f(p1[r]); }
                    float ls;
                    { typedef float f32x8_t __attribute__((ext_vector_type(8))); typedef float f32x4v_t __attribute__((ext_vector_type(4)));
                      const f32x16_t t16 = p0 + p1; const f32x8_t t8 = t16.lo + t16.hi; const f32x4v_t t4 = t8.lo + t8.hi; const f32x2_t t2 = t4.lo + t4.hi; ls = t2.x + t2.y; }
                    if (__any(m_new > m_run)) {
                        const float alpha = __builtin_amdgcn_exp2f(m_run - m_safe);
                        l_run *= alpha;
                        o0 = o0 * alpha; o1 = o1 * alpha;
                    }
                    l_run += ls; m_run = m_new;
                } else {
                    float run = carry;
#define SB_HALF(PX, KOFF) do { \
                    float lk[16]; \
                    _Pragma("unroll") for (int r = 0; r < 16; ++r) { \
                        const int off = (r & 3) + 8 * (r >> 2); \
                        const bool v = (kbase + off + (KOFF)) < qpos; \
                        const float z = PX[r]; \
                        const float t = 0.6931471805599453f * __builtin_amdgcn_logf(1.0f + __builtin_amdgcn_exp2f(-LOG2E * fabsf(z))); \
                        lk[r] = v ? (fminf(-z, 0.f) - t) : 0.f; \
                        PX[r] = v ? (fminf(z, 0.f) - t) : -INFINITY; } \
                    _Pragma("unroll") for (int g = 3; g >= 0; --g) { \
                        const float G = (lk[4 * g] + lk[4 * g + 1]) + (lk[4 * g + 2] + lk[4 * g + 3]); \
                        const float PG = xlane32(G); \
                        float la = run + (hi ? 0.f : PG); \
                        run += G + PG; \
                        PX[4 * g + 3] += la; la += lk[4 * g + 3]; PX[4 * g + 2] += la; la += lk[4 * g + 2]; PX[4 * g + 1] += la; la += lk[4 * g + 1]; PX[4 * g] += la; } \
                    _Pragma("unroll") for (int r = 0; r < 16; ++r) PX[r] = __builtin_amdgcn_exp2f(LOG2E * PX[r]); } while (0)
                    SB_HALF(p1, 32);
                    SB_HALF(p0, 0);
#undef SB_HALF
                    carry = run;
                }
                unsigned pw[16];
#pragma unroll
                for (int j = 0; j < 8; ++j) { pw[j] = cvtpk(p0[2 * j], p0[2 * j + 1]); pw[8 + j] = cvtpk(p1[2 * j], p1[2 * j + 1]); }
#pragma unroll
                for (int s = 0; s < 4; ++s) {
                    bf16x8_t pb; { const unsigned* q = pw + 4 * s; typedef unsigned u32x4_t __attribute__((ext_vector_type(4))); u32x4_t t4 = {q[0], q[1], q[2], q[3]}; pb = __builtin_bit_cast(bf16x8_t, t4); }
#pragma unroll
                    for (int dt = 0; dt < 2; ++dt) {
                        typedef short s16x4_t __attribute__((ext_vector_type(4)));
                        typedef __attribute__((address_space(3))) s16x4_t lds_s16x4;
                        const int gi_ = lane & 15;
                        const bf16* vp = vt_ + (16 * s + 4 * hi + (gi_ >> 2)) * AT_VP + 32 * dt + 16 * ((lane >> 4) & 1) + 4 * (gi_ & 3);
                        const s16x4_t lo = __builtin_amdgcn_ds_read_tr16_b64_v4i16((lds_s16x4*)vp), hi4 = __builtin_amdgcn_ds_read_tr16_b64_v4i16((lds_s16x4*)(vp + 8 * AT_VP));
                        const bf16x8_t va = {lo[0], lo[1], lo[2], lo[3], hi4[0], hi4[1], hi4[2], hi4[3]};
                        if (dt == 0) o0 = __builtin_amdgcn_mfma_f32_32x32x16_bf16(va, pb, o0, 0, 0, 0);
                        else         o1 = __builtin_amdgcn_mfma_f32_32x32x16_bf16(va, pb, o1, 0, 0, 0);
                    }
                }
            }
            if (kind == 3) {
                const float cm = carry;
                if (__all(cm < -110.0f) || !(kt * 64 <= q0w + 31) ) { if (__all(cm < -110.0f)) wave_done = true; }
            }
            if (more) {
                bf16* ksn = (bf16*)(lds + AT_KS + (buf ^ 1) * AT_KS_BYTES); bf16* vtn = (bf16*)(lds + AT_VT + (buf ^ 1) * AT_VT_BYTES);
                *(uint4*)(ksn + skey * AT_KP + sc * 8) = rk;
                *(uint4*)(vtn + skey * AT_VP + sc * 8) = rv;
            }
            if (kind == 3) { if (__syncthreads_and(wave_done ? 1 : 0)) break; }
            else __syncthreads();
            buf ^= 1;
        }
        float inv;
        if (kind == 3) inv = 1.0f;
        else {
            float lt = l_run + xlane32(l_run);
            if (kind == 1) { const float mf = fmaxf(m_run, sink2); const float sc2 = exp2f(m_run - mf); lt = lt * sc2 + exp2f(sink2 - mf); inv = sc2 / lt; }
            else inv = 1.0f / lt;
        }
        bf16* yp = ys + (size_t)(b * S_ + qpos) * 1024 + ycol + 4 * hi;
#pragma unroll
        for (int g = 0; g < 4; ++g) {
            *(uint2*)(yp + 8 * g) = make_uint2(cvtpk(o0[4 * g] * inv, o0[4 * g + 1] * inv), cvtpk(o0[4 * g + 2] * inv, o0[4 * g + 3] * inv));
            *(uint2*)(yp + 32 + 8 * g) = make_uint2(cvtpk(o1[4 * g] * inv, o1[4 * g + 1] * inv), cvtpk(o1[4 * g + 2] * inv, o1[4 * g + 3] * inv));
        }
    }
}
__device__ void attn_fast_phase(int WV_, const bf16* P, const unsigned char* mask, const float* kmean, const float* sinks, bf16* ys,
                                const unsigned* utab, unsigned* counter, unsigned char* lds) {
    volatile unsigned* s_unit = (volatile unsigned*)(lds + AT_MISC);
    for (;;) {
        __syncthreads();
        if (LTID(WV_) == 0) s_unit[0] = atomicAdd(counter, 1u);
        __syncthreads();
        const unsigned ui = s_unit[0];
        if (ui >= 512u) break;
        const unsigned ue = utab[ui];
        const int kind = (int)(ue >> 30), b = (int)((ue >> 28) & 3u), ux = (int)((ue >> 8) & 255u), uy = (int)(ue & 255u);
        if (kind == 0) attn_unit<0>(WV_, P, mask, kmean, sinks, ys, lds, b, ux, uy);
        else attn_unit<2>(WV_, P, mask, kmean, sinks, ys, lds, b, ux, uy);
    }
    for (int u = LBID(); u < 256; u += LGRID()) { __syncthreads(); attn_unit<3>(WV_, P, mask, kmean, sinks, ys, lds, u >> 6, (u >> 4) & 3, u & 15); }
    for (int u = LBID(); u < 256; u += LGRID()) { __syncthreads(); attn_unit<1>(WV_, P, mask, kmean, sinks, ys, lds, u >> 6, (u >> 5) & 1, u & 31); }
}

constexpr float U_SCALE = 128.0f, V_SCALE = 48.0f;
constexpr int ROW6 = 1536;
typedef float v32f_t __attribute__((ext_vector_type(32)));
typedef unsigned v6u_t __attribute__((ext_vector_type(6)));
typedef unsigned u32x4a8_t __attribute__((ext_vector_type(4), aligned(8)));
__device__ __forceinline__ float rdlane_f(float v, int l) { return __builtin_bit_cast(float, __builtin_amdgcn_readlane(__builtin_bit_cast(int, v), l)); }
__device__ __forceinline__ unsigned q_e2m3(float v) {
    const float a = fminf(fabsf(v), 7.5f);
    unsigned code;
    if (a < 1.0f) code = (unsigned)rintf(a * 8.0f);
    else if (a < 2.0f) code = 8u + (unsigned)rintf((a - 1.0f) * 8.0f);
    else if (a < 4.0f) code = 16u + (unsigned)rintf((a - 2.0f) * 4.0f);
    else code = 24u + (unsigned)rintf((a - 4.0f) * 2.0f);
    return code | (v < 0.f ? 32u : 0u);
}
__device__ void convert_tables(int WV_, const Params& p) {
    const size_t nchunk = (size_t)DEPTH_ * 16384 * 2 * 32;
    for (size_t i = (size_t)LBID() * NTHR + LTID(WV_); i < nchunk; i += (size_t)LGRID() * NTHR) {
        const int c = (int)(i & 31), uvsel = (int)((i >> 5) & 1); const size_t le = i >> 6;
        const float* src = (uvsel ? p.in[10] : p.in[9]) + le * 1024 + c * 32;
        const float sc = uvsel ? V_SCALE : U_SCALE;
        unsigned w[6] = {0u, 0u, 0u, 0u, 0u, 0u};
#pragma unroll
        for (int q4 = 0; q4 < 8; ++q4) {
            const float4 a = ((const float4*)src)[q4];
            const float av[4] = {a.x, a.y, a.z, a.w};
#pragma unroll
            for (int e = 0; e < 4; ++e) { const int idx = q4 * 4 + e, bit = 6 * idx, d = bit >> 5, s = bit & 31; const unsigned code = q_e2m3(av[e] * sc);
                w[d] |= code << s; if (s > 26) w[d + 1] |= code >> (32 - s); }
        }
        uint2* dst = (uint2*)(p.ws + WS_UV + le * ROW6 + uvsel * 768 + c * 24);
        dst[0] = make_uint2(w[0], w[1]); dst[1] = make_uint2(w[2], w[3]); dst[2] = make_uint2(w[4], w[5]);
    }
}
__device__ __forceinline__ v6u_t ld_pk6(const unsigned char* ptr) {
    const uint2 a = ((const uint2*)ptr)[0], b = ((const uint2*)ptr)[1], c = ((const uint2*)ptr)[2];
    const v6u_t pk = {a.x, a.y, b.x, b.y, c.x, c.y};
    return pk;
}
__device__ void peer_fast_phase(int WV_, float* h, bf16* hb, const int* eid, const float* gate, const unsigned char* uv, const float* g1, const float* b1, const float* g, const float* bb, unsigned char* lds) {
    const int tid = LTID(WV_), lane = tid & 63, wave = tid >> 6, l32 = lane & 31, hi = lane >> 5;
    float* pl = (float*)(lds + wave * 16384);
    unsigned char* raw = lds + wave * 16384 + 4096 + lane * 24;
    for (int t = LBID() * NWAVE + wave; t < T_; t += LGRID() * NWAVE) {
        float* hr = h + (size_t)t * 1024 + l32 * 32;
        float x[32], acc[32];
#pragma unroll
        for (int q4 = 0; q4 < 8; ++q4) { const float4 a = ((const float4*)hr)[q4]; x[4 * q4] = a.x; x[4 * q4 + 1] = a.y; x[4 * q4 + 2] = a.z; x[4 * q4 + 3] = a.w; }
        {
            float s = 0.f;
#pragma unroll
            for (int i = 0; i < 32; ++i) s += x[i];
#pragma unroll
            for (int o = 16; o > 0; o >>= 1) s += __shfl_xor(s, o);
            const float mean = s * (1.0f / 1024.0f);
            float s2 = 0.f;
#pragma unroll
            for (int i = 0; i < 32; ++i) { x[i] -= mean; s2 += x[i] * x[i]; }
#pragma unroll
            for (int o = 16; o > 0; o >>= 1) s2 += __shfl_xor(s2, o);
            const float rstd = 1.0f / sqrtf(s2 * (1.0f / 1024.0f) + LN_EPS);
#pragma unroll
            for (int q4 = 0; q4 < 8; ++q4) { const float4 gg = ((const float4*)(g1 + l32 * 32))[q4], cc = ((const float4*)(b1 + l32 * 32))[q4];
                x[4 * q4] = x[4 * q4] * rstd * gg.x + cc.x; x[4 * q4 + 1] = x[4 * q4 + 1] * rstd * gg.y + cc.y; x[4 * q4 + 2] = x[4 * q4 + 2] * rstd * gg.z + cc.z; x[4 * q4 + 3] = x[4 * q4 + 3] * rstd * gg.w + cc.w; }
        }
#pragma unroll
        for (int i = 0; i < 32; ++i) acc[i] = 0.f;
#pragma unroll 1
        for (int batch = 0; batch < 4; ++batch) {
            const int my_eid = eid[(size_t)t * 128 + batch * 32 + l32];
            const float my_gate = gate[(size_t)t * 128 + batch * 32 + l32];
#pragma unroll 1
            for (int grp = 0; grp < 2; ++grp) {
                { u32x4a8_t pa[8]; uint2 pc[8];
#pragma unroll
                  for (int i = 0; i < 8; ++i) { const int id = __shfl(my_eid, 2 * (grp * 8 + i) + hi); const unsigned char* rp = uv + (size_t)id * ROW6 + l32 * 24; pa[i] = *(const u32x4a8_t*)rp; pc[i] = *(const uint2*)(rp + 16); }
#pragma unroll
                  for (int i = 0; i < 8; ++i) { uint2* wp = (uint2*)(raw + i * 1536); wp[0] = make_uint2(pa[i].x, pa[i].y); wp[1] = make_uint2(pa[i].z, pa[i].w); wp[2] = pc[i]; } }
#pragma unroll 1
                for (int i = 0; i < 8; ++i) {
                    const uint2* rp = (const uint2*)(raw + i * 1536); const uint2 a = rp[0], b = rp[1], c = rp[2];
                    const v6u_t pk6 = {a.x, a.y, b.x, b.y, c.x, c.y}; const v32f_t f = __builtin_amdgcn_cvt_scalef32_pk32_f32_fp6(pk6, 1.0f);
                    f32x2_t dv0 = {0.f, 0.f}, dv1 = {0.f, 0.f};
#pragma unroll
                    for (int j = 0; j < 8; ++j) { const f32x2_t fa = {f[2 * j], f[2 * j + 1]}, fb = {f[16 + 2 * j], f[17 + 2 * j]}, xa = {x[2 * j], x[2 * j + 1]}, xb = {x[16 + 2 * j], x[17 + 2 * j]};
                        dv0 = fa * xa + dv0; dv1 = fb * xb + dv1; }
                    pl[(2 * (grp * 8 + i) + hi) * 32 + l32] = (dv0.x + dv0.y) + (dv1.x + dv1.y);
                }
            }
            float d;
            { const float4* pr = (const float4*)(pl + l32 * 32); float4 s4 = pr[0];
#pragma unroll
              for (int i = 1; i < 8; ++i) { const float4 v = pr[i]; s4.x += v.x; s4.y += v.y; s4.z += v.z; s4.w += v.w; }
              d = ((s4.x + s4.y) + (s4.z + s4.w)) * (1.0f / U_SCALE); }
            const float hv = 0.5f * d * (1.0f + erff(d * 0.70710678118654752f)) * my_gate * (1.0f / V_SCALE);
#pragma unroll 1
            for (int grp = 0; grp < 2; ++grp) {
                { u32x4a8_t pa[8]; uint2 pc[8];
#pragma unroll
                  for (int i = 0; i < 8; ++i) { const int id = __shfl(my_eid, 2 * (grp * 8 + i) + hi); const unsigned char* rp = uv + (size_t)id * ROW6 + 768 + l32 * 24; pa[i] = *(const u32x4a8_t*)rp; pc[i] = *(const uint2*)(rp + 16); }
#pragma unroll
                  for (int i = 0; i < 8; ++i) { uint2* wp = (uint2*)(raw + i * 1536); wp[0] = make_uint2(pa[i].x, pa[i].y); wp[1] = make_uint2(pa[i].z, pa[i].w); wp[2] = pc[i]; } }
#pragma unroll 1
                for (int i = 0; i < 8; ++i) {
                    const float c = __shfl(hv, 2 * (grp * 8 + i) + hi);
                    const uint2* rp = (const uint2*)(raw + i * 1536); const uint2 a = rp[0], b = rp[1], cc = rp[2];
                    const v6u_t pk6 = {a.x, a.y, b.x, b.y, cc.x, cc.y}; const v32f_t f = __builtin_amdgcn_cvt_scalef32_pk32_f32_fp6(pk6, 1.0f);
                    const f32x2_t c2 = {c, c};
#pragma unroll
                    for (int j = 0; j < 16; ++j) { const f32x2_t fj = {f[2 * j], f[2 * j + 1]}; f32x2_t aj = {acc[2 * j], acc[2 * j + 1]}; aj = fj * c2 + aj; acc[2 * j] = aj.x; acc[2 * j + 1] = aj.y; }
                }
            }
        }
        float y[32], s = 0.f;
#pragma unroll
        for (int i = 0; i < 32; ++i) { acc[i] += __shfl_xor(acc[i], 32); y[i] = ALPHA * x[i] + acc[i]; s += y[i]; }
#pragma unroll
        for (int o = 16; o > 0; o >>= 1) s += __shfl_xor(s, o);
        const float mean = s * (1.0f / 1024.0f);
        float s2 = 0.f;
#pragma unroll
        for (int i = 0; i < 32; ++i) { y[i] -= mean; s2 += y[i] * y[i]; }
#pragma unroll
        for (int o = 16; o > 0; o >>= 1) s2 += __shfl_xor(s2, o);
        const float rstd = 1.0f / sqrtf(s2 * (1.0f / 1024.0f) + LN_EPS);
        float o[16];
#pragma unroll
        for (int q4 = 0; q4 < 4; ++q4) {
            const float4 gg = ((const float4*)(g + l32 * 32 + hi * 16))[q4], cc = ((const float4*)(bb + l32 * 32 + hi * 16))[q4];
            float ya[4], yb2[4];
#pragma unroll
            for (int e = 0; e < 4; ++e) { ya[e] = y[4 * q4 + e]; yb2[e] = y[16 + 4 * q4 + e]; }
            asm volatile("" : "+v"(ya[0]), "+v"(ya[1]), "+v"(ya[2]), "+v"(ya[3]), "+v"(yb2[0]), "+v"(yb2[1]), "+v"(yb2[2]), "+v"(yb2[3]));
            const float y0 = hi ? yb2[0] : ya[0], y1 = hi ? yb2[1] : ya[1], y2 = hi ? yb2[2] : ya[2], y3 = hi ? yb2[3] : ya[3];
            o[4 * q4] = y0 * rstd * gg.x + cc.x; o[4 * q4 + 1] = y1 * rstd * gg.y + cc.y; o[4 * q4 + 2] = y2 * rstd * gg.z + cc.z; o[4 * q4 + 3] = y3 * rstd * gg.w + cc.w;
            ((float4*)(hr + hi * 16))[q4] = make_float4(o[4 * q4], o[4 * q4 + 1], o[4 * q4 + 2], o[4 * q4 + 3]);
        }
        uint4* hbp = (uint4*)(hb + (size_t)t * 1024 + l32 * 32 + hi * 16);
        hbp[0] = make_uint4(pk2(o[0], o[1]), pk2(o[2], o[3]), pk2(o[4], o[5]), pk2(o[6], o[7]));
        hbp[1] = make_uint4(pk2(o[8], o[9]), pk2(o[10], o[11]), pk2(o[12], o[13]), pk2(o[14], o[15]));
    }
}

__device__ __forceinline__ float pack_pl(float v, unsigned pl) { return __uint_as_float((__float_as_uint(v) & ~127u) | pl); }
__device__ __forceinline__ void ins16(float (&s)[16], float x) {
#pragma unroll
    for (int k = 15; k >= 1; --k) s[k] = __builtin_amdgcn_fmed3f(s[k - 1], x, s[k]);
    s[0] = vmax(s[0], x);
}
template <int D> __device__ __forceinline__ void bitonic_stage(float (&c)[16]) {
#pragma unroll
    for (int i = 0; i < 16; ++i) if ((i & D) == 0) { const float a = vmax(c[i], c[i + D]), b = vmin(c[i], c[i + D]); c[i] = a; c[i + D] = b; }
}
__device__ __forceinline__ int decode_key(unsigned pl) { return (int)(32u * ((pl >> 4) & 3u) + (pl & 3u) + 8u * ((pl >> 2) & 3u) + 4u * ((pl >> 6) & 1u)); }
__device__ void route_fast_phase(int WV_, const bf16* qb, const bf16* skb  , int* eid, float* gate, unsigned char* lds, int pm = -1, int pn = 0) {
    const int tid = LTID(WV_), lane = tid & 63, wave = tid >> 6, r32 = lane & 31, hi = lane >> 5;
    unsigned* lidx = (unsigned*)lds + wave * (64 * 33) + lane * 33;
    const int u_first = (pm >= 0) ? 0 : LBID() * NWAVE + wave, u_end = (pm >= 0) ? 2 : (T_ / 32) * 8, u_step = (pm >= 0) ? 1 : LGRID() * NWAVE;
    for (int unit = u_first; unit < u_end; unit += u_step) {
        const int h = (pm >= 0) ? 2 * pn + unit : (unit & 7), t = ((pm >= 0) ? 8 * pm + wave : (unit >> 3)) * 32 + r32;
        float sl[2][16];
#pragma unroll
        for (int p = 0; p < 2; ++p) {
            bf16x8_t qf[4];
            { const bf16* qp = qb + (size_t)t * 1024 + h * 128 + p * 64 + 8 * hi;
#pragma unroll
              for (int ks = 0; ks < 4; ++ks) qf[ks] = *(const bf16x8_t*)(qp + 16 * ks); }
            float s[16];
#pragma unroll
            for (int k = 0; k < 16; ++k) s[k] = -INFINITY;
            const bf16* skp = skb + ((size_t)(h * 2 + p) * 128 + r32) * 64 + 8 * hi;
#pragma unroll
            for (int kt = 0; kt < 4; ++kt) {
                f32x16_t acc;
#pragma unroll
                for (int r = 0; r < 16; ++r) acc[r] = 0.f;
#pragma unroll
                for (int ks = 0; ks < 4; ++ks) { const bf16x8_t a = *(const bf16x8_t*)(skp + (size_t)kt * 32 * 64 + 16 * ks); acc = __builtin_amdgcn_mfma_f32_32x32x16_bf16(a, qf[ks], acc, 0, 0, 0); }
#pragma unroll
                for (int r = 0; r < 16; ++r) ins16(s, pack_pl(acc[r], (unsigned)(kt * 16 + r)));
            }
            const unsigned hb = (unsigned)hi << 6;
#pragma unroll
            for (int k = 0; k < 16; ++k) s[k] = __uint_as_float(__float_as_uint(s[k]) | hb);
            float c[16];
#pragma unroll
            for (int k = 0; k < 16; ++k) c[k] = vmax(s[k], __shfl_xor(s[15 - k], 32));
            bitonic_stage<8>(c); bitonic_stage<4>(c); bitonic_stage<2>(c); bitonic_stage<1>(c);
#pragma unroll
            for (int k = 0; k < 16; ++k) { sl[p][k] = c[k]; lidx[p * 16 + k] = (unsigned)decode_key(__float_as_uint(c[k]) & 127u); }
        }
        float w[16];
#pragma unroll
        for (int k = 0; k < 16; ++k) w[k] = -INFINITY;
#pragma unroll
        for (int i = 0; i < 16; ++i)
#pragma unroll
            for (int j = 0; j < 16; ++j)
                if ((i + 1) * (j + 1) <= 16) { const float v = sl[0][i] + sl[1][j]; ins16(w, __uint_as_float((__float_as_uint(v) & ~255u) | (unsigned)(i * 16 + j))); }
        float e[16], sum = 0.f;
#pragma unroll
        for (int k = 0; k < 16; ++k) { e[k] = expf(w[k] - w[0]); sum += e[k]; }
        const float inv = 1.0f / sum;
        int ide[8]; float gte[8];
#pragma unroll
        for (int k = 0; k < 8; ++k) {
            float wa = w[k], wb = w[8 + k], ea = e[k], eb = e[8 + k];
            asm volatile("" : "+v"(wa), "+v"(wb), "+v"(ea), "+v"(eb));
            const float wv = hi ? wb : wa;
            const unsigned pl = __float_as_uint(wv) & 255u;
            ide[k] = (int)(lidx[pl >> 4] * 128u + lidx[16 + (pl & 15u)]);
            gte[k] = (hi ? eb : ea) * inv;
        }
        int* ep = eid + (size_t)t * 128 + h * 16 + hi * 8; float* gp = gate + (size_t)t * 128 + h * 16 + hi * 8;
        *(int4*)ep = make_int4(ide[0], ide[1], ide[2], ide[3]); *(int4*)(ep + 4) = make_int4(ide[4], ide[5], ide[6], ide[7]);
        *(float4*)gp = make_float4(gte[0], gte[1], gte[2], gte[3]); *(float4*)(gp + 4) = make_float4(gte[4], gte[5], gte[6], gte[7]);
    }
}

typedef float f32x4_t __attribute__((ext_vector_type(4)));
typedef __bf16 bf16x2v __attribute__((ext_vector_type(2)));
__device__ __forceinline__ float dot2bf(unsigned a, unsigned b, float c) { return __builtin_amdgcn_fdot2_f32_bf16(__builtin_bit_cast(bf16x2v, a), __builtin_bit_cast(bf16x2v, b), c, false); }
__device__ __forceinline__ void cnt_gt(int& cnt, unsigned a, unsigned b) { asm("v_cmp_gt_u32_e32 vcc, %1, %2\n\tv_addc_co_u32_e32 %0, vcc, 0, %0, vcc" : "+v"(cnt) : "v"(a), "v"(b) : "vcc"); }
__device__ __forceinline__ void cnt_eq(int& cnt, unsigned a, unsigned b) { asm("v_cmp_eq_u32_e32 vcc, %1, %2\n\tv_addc_co_u32_e32 %0, vcc, 0, %0, vcc" : "+v"(cnt) : "v"(a), "v"(b) : "vcc"); }
__device__ __forceinline__ unsigned flag_gt(unsigned a, unsigned b) { unsigned r; asm("v_cmp_gt_u32_e32 vcc, %1, %2\n\tv_cndmask_b32_e64 %0, 0, 1, vcc" : "=v"(r) : "v"(a), "v"(b) : "vcc"); return r; }
__device__ __forceinline__ unsigned flag_eq(unsigned a, unsigned b) { unsigned r; asm("v_cmp_eq_u32_e32 vcc, %1, %2\n\tv_cndmask_b32_e64 %0, 0, 1, vcc" : "=v"(r) : "v"(a), "v"(b) : "vcc"); return r; }
__device__ __forceinline__ void cnt_ge(int& cnt, unsigned key, unsigned cand) { asm("v_cmp_ge_u32_e32 vcc, %1, %2\n\tv_addc_co_u32_e32 %0, vcc, 0, %0, vcc" : "+v"(cnt) : "v"(key), "v"(cand) : "vcc"); }

typedef __attribute__((address_space(3))) unsigned lds_u32;
template <int SHIFT> __device__ __forceinline__ unsigned radix_pass(const unsigned (&key)[64], unsigned pre, lds_u32* hist, int lane, int& need, int jlim, unsigned L) {
    typedef unsigned u32x4v __attribute__((ext_vector_type(4)));
    typedef __attribute__((address_space(3))) u32x4v lds_u32x4;
    { const u32x4v z4 = {0u, 0u, 0u, 0u};
#pragma unroll
      for (int i = 0; i < 8; ++i) ((lds_u32x4*)(hist + lane * 32))[i] = z4; }
    const unsigned cp = (unsigned)(lane & 7);
#pragma unroll
    for (int j4 = 0; j4 < 16; ++j4) {
        if (4 * j4 <= jlim) {
#pragma unroll
            for (int e = 0; e < 4; ++e) { const int j = 4 * j4 + e;
                const unsigned d = (key[j] >> SHIFT) & 255u;
                bool m;
                if (SHIFT == 24) m = key[j] >= L; else m = (key[j] >> ((SHIFT + 8) & 31)) == pre;
                if (m) __hip_atomic_fetch_add(hist + ((d << 3) | cp), 1u, __ATOMIC_RELAXED, __HIP_MEMORY_SCOPE_WORKGROUP); }
        }
    }
    unsigned dsum[4]; unsigned sumL = 0u;
#pragma unroll
    for (int i = 0; i < 4; ++i) { const u32x4v v0 = ((const lds_u32x4*)(hist + lane * 32))[2 * i], v1 = ((const lds_u32x4*)(hist + lane * 32))[2 * i + 1];
        dsum[i] = ((v0.x + v0.y) + (v0.z + v0.w)) + ((v1.x + v1.y) + (v1.z + v1.w)); sumL += dsum[i]; }
    unsigned incl = sumL;
#pragma unroll
    for (int o = 1; o < 64; o <<= 1) { const unsigned t = (unsigned)__shfl_down((int)incl, o); if (lane + o < 64) incl += t; }
    const unsigned above = incl - sumL;
    const bool own = (above < (unsigned)need) && ((unsigned)need <= above + sumL);
    const int owner = __ffsll((long long)__ballot(own)) - 1;
    unsigned acc = above; int sel = -1; unsigned cab = 0u;
#pragma unroll
    for (int i = 3; i >= 0; --i) { const unsigned c = dsum[i]; const bool hit = (sel < 0) && (acc + c >= (unsigned)need); cab = hit ? acc : cab; sel = hit ? i : sel; acc += c; }
    const int ow = owner < 0 ? 0 : owner;
    const unsigned digit = (unsigned)__builtin_amdgcn_readlane(sel, ow) + (unsigned)(4 * ow);
    need -= (int)__builtin_amdgcn_readlane((int)cab, ow);
    return digit;
}
#ifndef TS_SEL
#define TS_SEL 0
#endif
#define ITS_B() do { if (TS_SEL >= 20 && TS_SEL <= 25 && WV_ == 0 && LANEID() == 0) ((volatile __attribute__((address_space(3))) unsigned long long*)((__attribute__((address_space(3))) unsigned char*)lds + 147456 - 16 - 32))[0] = __builtin_amdgcn_s_memrealtime(); } while (0)
#define ITS_E(k) do { if ((k) == TS_SEL && WV_ == 0 && LANEID() == 0) { volatile __attribute__((address_space(3))) unsigned long long* w_ = (volatile __attribute__((address_space(3))) unsigned long long*)((__attribute__((address_space(3))) unsigned char*)lds + 147456 - 16 - 32); w_[1] += __builtin_amdgcn_s_memrealtime() - w_[0]; } } while (0)
__device__ void index_fast_phase(int WV_, const bf16* P, unsigned char* mask, float* kmean, float* scratch_all, unsigned char* lds) {
    const int tid = LTID(WV_), lane = tid & 63, wave = tid >> 6, bid = LBID(), G = LGRID();
    float* s_part = (float*)lds;
    ITS_B();
    for (int k = bid; k < 256; k += G) {
        const int b = k >> 6, h = (k >> 4) & 3, blk = k & 15;
        const bf16* kp = P + (size_t)(b * S_ + blk * 256 + wave * 32) * NP + C_KC + h * 64 + lane;
        float a = 0.f;
#pragma unroll 8
        for (int j = 0; j < 32; ++j) a += bf2f(kp[(size_t)j * NP]);
        __syncthreads();
        s_part[wave * 64 + lane] = a;
        __syncthreads();
        if (tid < 64) { float s = 0.f;
#pragma unroll
            for (int w = 0; w < 8; ++w) s += s_part[w * 64 + tid];
            kmean[((b * 4 + h) * 16 + blk) * 64 + tid] = s * (1.0f / 256.0f); }
    }
    ITS_E(22);
    float* scr = scratch_all + (size_t)bid * (16 * 4096);
    const int lq = lane & 15, g4 = lane >> 4;
    for (int ui = bid; ui < 1024; ui += G) {
        const int b = ui >> 8, k = ui & 255, tile = (b & 1) ? 255 - k : k, q0 = tile * 16;
        const bf16* Pb = P + (size_t)b * S_ * NP;
        const int ntiles = tile + 1;
        ITS_B();
        bf16x8_t qf[8]; float wi[8];
        { const bf16* qp = Pb + (size_t)(q0 + lq) * NP + C_QI + 8 * g4;
#pragma unroll
          for (int h = 0; h < 8; ++h) qf[h] = *(const bf16x8_t*)(qp + 32 * h);
          const uint4 wv = *(const uint4*)(Pb + (size_t)(q0 + lq) * NP + C_WI); unpack8(wv, wi); }
        {
            bf16x8_t afn = *(const bf16x8_t*)(Pb + (size_t)((wave < ntiles ? wave : 0) * 16 + lq) * NP + C_KI + 8 * g4);
            for (int kt = wave; kt < ntiles; kt += NWAVE) {
                const bf16x8_t af = afn;
                { const int ktn = (kt + NWAVE < ntiles) ? kt + NWAVE : kt; afn = *(const bf16x8_t*)(Pb + (size_t)(ktn * 16 + lq) * NP + C_KI + 8 * g4); }
                f32x4_t a[8];
                const f32x4_t z = {0.f, 0.f, 0.f, 0.f};
#pragma unroll
                for (int h = 0; h < 8; ++h) a[h] = __builtin_amdgcn_mfma_f32_16x16x32_bf16(af, qf[h], z, 0, 0, 0);
                __builtin_amdgcn_sched_barrier(0);
                f32x4_t sc = {0.f, 0.f, 0.f, 0.f};
#pragma unroll
                for (int h = 0; h < 8; ++h)
#pragma unroll
                    for (int r = 0; r < 4; ++r) { float rl; asm("v_max_f32_e32 %0, 0, %1" : "=v"(rl) : "v"(a[h][r])); sc[r] += rl * wi[h]; }
#pragma unroll
                for (int r = 0; r < 4; ++r) { sc[r] *= 0.0625f; if (sc[r] == 0.f) sc[r] = 0.f; }
                *(f32x4_t*)(scr + (size_t)lq * 4096 + kt * 16 + 4 * g4) = sc;
            }
        }
        __threadfence_block();
        __syncthreads();
        __threadfence_block();
        ITS_E(20); ITS_B();
        lds_u32* hist = (lds_u32*)((__attribute__((address_space(3))) unsigned char*)lds + 2048) + wave * 2048;
#pragma unroll 1
        for (int qi = 0; qi < 2; ++qi) {
            const int ql = 2 * wave + qi, q = q0 + ql;
            const float* row = scr + (size_t)ql * 4096 + lane;
            const int qrel = q - lane * 64;
            const int jlim = __builtin_amdgcn_readfirstlane(q >> 6);
            const int jmax = (q - lane) >> 6;
            unsigned wlo = 0u, whi = 0u;
            if (q + 1 > 256) {
                unsigned key[64];
#pragma unroll
                for (int j4 = 0; j4 < 16; ++j4) {
                    if (4 * j4 <= jlim) {
#pragma unroll
                        for (int e = 0; e < 4; ++e) key[4 * j4 + e] = __float_as_uint(row[64 * (4 * j4 + e)]);
                    } else {
#pragma unroll
                        for (int e = 0; e < 4; ++e) key[4 * j4 + e] = 0x7fffffffu;
                    }
                }
                unsigned t0 = 0u, t1 = 0u, t2 = 0u, t3 = 0u;
#pragma unroll
                for (int j4 = 0; j4 < 16; ++j4) {
                    if (4 * j4 <= jlim) {
#pragma unroll
                        for (int e = 0; e < 4; ++e) { const int j = 4 * j4 + e; const unsigned u = key[j];
                            const unsigned t = u ^ ((unsigned)((int)u >> 31) | 0x80000000u); const unsigned inval = (unsigned)((jmax - j) >> 31); const unsigned x = t & ~inval; key[j] = x;
                            unsigned n1, n2, n3;
                            asm("v_med3_u32 %0, %1, %2, %3" : "=v"(n3) : "v"(t2), "v"(t3), "v"(x));
                            asm("v_med3_u32 %0, %1, %2, %3" : "=v"(n2) : "v"(t1), "v"(t2), "v"(x));
                            asm("v_med3_u32 %0, %1, %2, %3" : "=v"(n1) : "v"(t0), "v"(t1), "v"(x));
                            t0 = t0 > x ? t0 : x; t1 = n1; t2 = n2; t3 = n3; }
                    } else {
#pragma unroll
                        for (int e = 0; e < 4; ++e) key[4 * j4 + e] = 0u;
                    }
                }
                unsigned L = t3;
#pragma unroll
                for (int o = 32; o > 0; o >>= 1) { const unsigned v = (unsigned)__shfl_xor((int)L, o); L = v < L ? v : L; }
                L = L > 1u ? L : 1u;
                int need = 256;
                const unsigned d1 = radix_pass<24>(key, 0u, hist, lane, need, jlim, L);
                const unsigned d2 = radix_pass<16>(key, d1, hist, lane, need, jlim, L);
                const unsigned d3 = radix_pass<8>(key, (d1 << 8) | d2, hist, lane, need, jlim, L);
                const unsigned d4 = radix_pass<0>(key, (d1 << 16) | (d2 << 8) | d3, hist, lane, need, jlim, L);
                const unsigned prefix = (d1 << 24) | (d2 << 16) | (d3 << 8) | d4;
                int ceq = 0;
#pragma unroll
                for (int j = 0; j < 64; ++j) cnt_eq(ceq, key[j], prefix);
                ceq = wave_sum_i(ceq);
                int X = 4096;
                if (ceq != need) {
                    int X0 = 0;
#pragma unroll 1
                    for (int bit = 11; bit >= 0; --bit) {
                        const int c = X0 | (1 << bit);
                        int cnt = 0; const int crel = (c - lane + 63) >> 6;
#pragma unroll
                        for (int j = 0; j < 64; ++j) cnt_eq(cnt, (key[j] ^ prefix) | ~(unsigned)((j - crel) >> 31), 0u);
                        cnt = wave_sum_i(cnt);
                        if (cnt < need) X0 = c;
                    }
                    X = X0 + 1;
                }
                const int xrel = (X - lane + 63) >> 6;
#pragma unroll
                for (int j4 = 0; j4 < 16; ++j4) {
                    if (4 * j4 <= jlim) {
#pragma unroll
                        for (int e = 0; e < 4; ++e) { const int j = 4 * j4 + e;
                            const bool sel = (key[j] > prefix) || (key[j] == prefix && j < xrel);
                            const unsigned long long bm = __ballot(sel);
                            asm("v_writelane_b32 %0, %1, %2" : "+v"(wlo) : "s"((unsigned)bm), "n"(j));
                            asm("v_writelane_b32 %0, %1, %2" : "+v"(whi) : "s"((unsigned)(bm >> 32)), "n"(j)); }
                    }
                }
            } else {
#pragma unroll
                for (int j = 0; j < 32; ++j) { wlo |= (~(unsigned)((qrel - j) >> 31) & 1u) << j; whi |= (~(unsigned)((qrel - 32 - j) >> 31) & 1u) << j; }
            }
            ((uint2*)(mask + (size_t)(b * S_ + q) * 512))[lane] = make_uint2(wlo, whi);
            ITS_E(25); ITS_B();
        }
        ITS_E(21);
        __syncthreads();
    }
}

constexpr int MG_P = 72;
constexpr int MG_TILE_BYTES = 128 * MG_P * 2;
__device__ void merge_fast_phase(int WV_, const bf16* P, const bf16* ys, const bf16* wbt  , bf16* merged, unsigned char* lds) {
    const int tid = LTID(WV_), lane = tid & 63, wave = tid >> 6, r32 = lane & 31, hi = lane >> 5, wt = wave & 3, wd = wave >> 2;
    const int srow0 = tid >> 3, sch = tid & 7;
    for (int tile = LBID(); tile < 1024; tile += LGRID()) {
        const int tok0 = (tile >> 3) * 128, d0 = (tile & 7) * 128;
        f32x16_t mer[2], acc[2];
#pragma unroll
        for (int r = 0; r < 16; ++r) { mer[0][r] = 0.f; mer[1][r] = 0.f; acc[0][r] = 0.f; acc[1][r] = 0.f; }
        uint4 RW00, RW01, RW10, RW11, RY00, RY01, RY10, RY11, RG0, RG1, RG2, RG3;
        bf16* gl = (bf16*)(lds + 4 * MG_TILE_BYTES);
        const int grow = tid >> 4, gch = tid & 15;
#define MG_GLOAD(st_, R_) do { const int n_ = (st_) >> 2, kc_ = (st_) & 3; \
            RW##R_##0 = *(const uint4*)(wbt + ((size_t)n_ * 1024 + d0 + srow0) * 256 + kc_ * 64 + sch * 8); \
            RW##R_##1 = *(const uint4*)(wbt + ((size_t)n_ * 1024 + d0 + srow0 + 64) * 256 + kc_ * 64 + sch * 8); \
            RY##R_##0 = *(const uint4*)(ys + (size_t)(tok0 + srow0) * 1024 + n_ * 256 + kc_ * 64 + sch * 8); \
            RY##R_##1 = *(const uint4*)(ys + (size_t)(tok0 + srow0 + 64) * 1024 + n_ * 256 + kc_ * 64 + sch * 8); } while (0)
#define MG_SSTORE(buf_, R_) do { bf16* wl_ = (bf16*)(lds + (buf_) * 2 * MG_TILE_BYTES); bf16* yl_ = (bf16*)(lds + (buf_) * 2 * MG_TILE_BYTES + MG_TILE_BYTES); \
            *(uint4*)(wl_ + srow0 * MG_P + sch * 8) = RW##R_##0; *(uint4*)(wl_ + (srow0 + 64) * MG_P + sch * 8) = RW##R_##1; \
            *(uint4*)(yl_ + srow0 * MG_P + sch * 8) = RY##R_##0; *(uint4*)(yl_ + (srow0 + 64) * MG_P + sch * 8) = RY##R_##1; } while (0)
        __syncthreads();
        MG_GLOAD(0, 0); MG_GLOAD(1, 1);
        MG_SSTORE(0, 0);
        __syncthreads();
#define MG_STAGE(PAR_, OTH_) do { const int buf = PAR_; \
            if (st + 2 < 16) MG_GLOAD(st + 2, PAR_); \
            if ((st & 3) == 1) { const bf16* gsrc = P + (size_t)(tok0 + grow) * NP + C_G + (st >> 2) * 1024 + d0 + gch * 8; \
                RG0 = *(const uint4*)gsrc; RG1 = *(const uint4*)(gsrc + (size_t)32 * NP); RG2 = *(const uint4*)(gsrc + (size_t)64 * NP); RG3 = *(const uint4*)(gsrc + (size_t)96 * NP); } \
            const bf16* wl = (const bf16*)(lds + buf * 2 * MG_TILE_BYTES); const bf16* yl = (const bf16*)(lds + buf * 2 * MG_TILE_BYTES + MG_TILE_BYTES); \
            _Pragma("unroll") for (int ks = 0; ks < 4; ++ks) { \
                const bf16x8_t bq = *(const bf16x8_t*)(yl + (32 * wt + r32) * MG_P + 16 * ks + 8 * hi); \
                const bf16x8_t a0 = *(const bf16x8_t*)(wl + (64 * wd + r32) * MG_P + 16 * ks + 8 * hi); \
                const bf16x8_t a1 = *(const bf16x8_t*)(wl + (64 * wd + 32 + r32) * MG_P + 16 * ks + 8 * hi); \
                acc[0] = __builtin_amdgcn_mfma_f32_32x32x16_bf16(a0, bq, acc[0], 0, 0, 0); \
                acc[1] = __builtin_amdgcn_mfma_f32_32x32x16_bf16(a1, bq, acc[1], 0, 0, 0); } \
            if ((st & 3) == 3) { \
                const int n = st >> 2; \
                const bf16* gp = gl + (32 * wt + r32) * 136 + 64 * wd + 4 * hi; (void)n; \
                _Pragma("unroll") for (int dt = 0; dt < 2; ++dt) \
                _Pragma("unroll") for (int g = 0; g < 4; ++g) { \
                        const uint2 gv = *(const uint2*)(gp + 32 * dt + 8 * g); \
                        const float g0 = __uint_as_float(gv.x << 16), g1 = __uint_as_float(gv.x & 0xffff0000u), g2 = __uint_as_float(gv.y << 16), g3 = __uint_as_float(gv.y & 0xffff0000u); \
                        mer[dt][4 * g + 0] += acc[dt][4 * g + 0] * g0; \
                        mer[dt][4 * g + 1] += acc[dt][4 * g + 1] * g1; \
                        mer[dt][4 * g + 2] += acc[dt][4 * g + 2] * g2; \
                        mer[dt][4 * g + 3] += acc[dt][4 * g + 3] * g3; } \
                _Pragma("unroll") for (int r = 0; r < 16; ++r) { acc[0][r] = 0.f; acc[1][r] = 0.f; } } \
            if (st + 1 < 16) MG_SSTORE(OTH_, OTH_); \
            if ((st & 3) == 2) { *(uint4*)(gl + grow * 136 + gch * 8) = RG0; *(uint4*)(gl + (grow + 32) * 136 + gch * 8) = RG1; *(uint4*)(gl + (grow + 64) * 136 + gch * 8) = RG2; *(uint4*)(gl + (grow + 96) * 136 + gch * 8) = RG3; } \
            __syncthreads(); } while (0)
#pragma unroll 1
        for (int st2 = 0; st2 < 16; st2 += 2) { { const int st = st2; MG_STAGE(0, 1); } { const int st = st2 + 1; MG_STAGE(1, 0); } }
#undef MG_STAGE
#undef MG_GLOAD
#undef MG_SSTORE
        bf16* mp = merged + (size_t)(tok0 + 32 * wt + r32) * 1024 + d0 + 64 * wd + 4 * hi;
#pragma unroll
        for (int dt = 0; dt < 2; ++dt)
#pragma unroll
            for (int g = 0; g < 4; ++g)
                *(uint2*)(mp + 32 * dt + 8 * g) = make_uint2(cvtpk(mer[dt][4 * g], mer[dt][4 * g + 1]), cvtpk(mer[dt][4 * g + 2], mer[dt][4 * g + 3]));
    }
}
#define LAS __attribute__((address_space(3)))
#define XB_TMO      128
#define XB_XCNT(j)  (256  + 64 * (j))
#define XB_XSUB(j)  (1280 + 64 * (j))
#define XB_XGEN(j)  (2304 + 64 * (j))
#define XB_TOP      3328
#define XB_TOPGEN   3392
#define XCD_BAR_WORDS 3456
#define XB_SPIN_CAP (1u << 18)

__device__ __forceinline__ unsigned xb_ld(unsigned* p)              { return __hip_atomic_load(p, __ATOMIC_RELAXED, __HIP_MEMORY_SCOPE_AGENT); }
__device__ __forceinline__ unsigned xb_add(unsigned* p, unsigned v) { return __hip_atomic_fetch_add(p, v, __ATOMIC_RELAXED, __HIP_MEMORY_SCOPE_AGENT); }
__device__ __forceinline__ unsigned xb_xcc_id() { return (unsigned)__builtin_amdgcn_s_getreg((3 << 11) | 20) & 0xFu; }
#define XB_SPIN(cond, bar) do { unsigned _sp = 0; while (cond) { __builtin_amdgcn_s_sleep(1); \
    if ((++_sp & 255u) == 0u) { if (xb_ld(&(bar)[XB_TMO])) break; if (_sp > XB_SPIN_CAP) { atomicAdd(&(bar)[XB_TMO], 1u); break; } } } } while (0)

struct XcdBarrier {
    unsigned* bar; unsigned x;
    volatile LAS unsigned* st;
};

__device__ __forceinline__ XcdBarrier xcd_barrier_post(unsigned* bar, volatile LAS unsigned* st) {
    XcdBarrier b; b.bar = bar; b.x = xb_xcc_id(); b.st = st;
    if (threadIdx.x == 0) (void)xb_add(&bar[XB_XCNT(b.x)], 1u);
    return b;
}
__device__ __forceinline__ void xcd_barrier_complete(unsigned* bar, unsigned x, unsigned& nloc, unsigned& nx) {
    const unsigned G = gridDim.x * gridDim.y * gridDim.z;
    unsigned sum, cnt, mine, sp = 0u;
    for (;;) {
        sum = 0u; cnt = 0u; mine = 0u;
#pragma unroll
        for (unsigned j = 0; j < 16; ++j) { const unsigned c = xb_ld(&bar[XB_XCNT(j)]); sum += c; cnt += (c > 0u) ? 1u : 0u; mine = (j == x) ? c : mine; }
        if (sum == G) break;
        __builtin_amdgcn_s_sleep(1);
        if ((++sp & 255u) == 0u) { if (xb_ld(&bar[XB_TMO])) break; if (sp > XB_SPIN_CAP) { atomicAdd(&bar[XB_TMO], 1u); break; } }
    }
    nloc = mine > 0u ? mine : 1u; nx = cnt > 0u ? cnt : 1u;
}

__device__ __forceinline__ void xcd_barrier(const XcdBarrier& b, int wv_) {
    asm volatile("s_waitcnt vmcnt(0)" ::: "memory");
    __syncthreads();
    if (wv_ == 0 && LANEID() == 0) {
        unsigned* bar = b.bar;
        __builtin_amdgcn_s_waitcnt(0);
        unsigned nloc = b.st[0], nx = b.st[1];
        if (nloc == 0u) { xcd_barrier_complete(bar, b.x, nloc, nx); b.st[0] = nloc; b.st[1] = nx; }
        const unsigned old = xb_add(&bar[XB_XSUB(b.x)], 1u);
        const unsigned gen = old / nloc;
        if (old + 1u == (gen + 1u) * nloc) {
            __builtin_amdgcn_fence(__ATOMIC_RELEASE, "agent");
            asm volatile("s_waitcnt vmcnt(0)" ::: "memory");
            const unsigned og = xb_add(&bar[XB_TOP], 1u);
            const unsigned tg = og / nx;
            if (og + 1u == (tg + 1u) * nx) xb_add(&bar[XB_TOPGEN], 1u);
            else XB_SPIN(xb_ld(&bar[XB_TOPGEN]) == tg, bar);
            __builtin_amdgcn_fence(__ATOMIC_ACQUIRE, "agent");
            xb_add(&bar[XB_XGEN(b.x)], 1u);
            asm volatile("s_waitcnt vmcnt(0)" ::: "memory");
        } else {
            XB_SPIN(xb_ld(&bar[XB_XGEN(b.x)]) == gen, bar);
            __builtin_amdgcn_fence(__ATOMIC_ACQUIRE, "agent");
            asm volatile("s_waitcnt vmcnt(0)" ::: "memory");
        }
    }
    __syncthreads();
}

enum { PH_PRO = 0, PH_GIN, PH_INDEX, PH_ATTN, PH_MERGE, PH_GOUT, PH_LN1, PH_GQ, PH_ROUTE, PH_PEER };
template <int PH> __device__ __forceinline__ void run_phase(int WV_, const Params& p_unused, int l, unsigned char* lds_raw) {
    size_t kaoff_ = 0; asm volatile("" : "+s"(kaoff_));
    typedef const __attribute__((address_space(4))) char* kaptr_t;
    const __attribute__((address_space(4))) Params& p = *(const __attribute__((address_space(4))) Params*)((kaptr_t)__builtin_amdgcn_kernarg_segment_ptr() + kaoff_);
    float* sm = (float*)lds_raw;
    size_t wsoff_ = 0; asm volatile("" : "+s"(wsoff_));
    unsigned char* ws = p.ws + wsoff_;
    float* hbuf = p.out;
    bf16* hb = (bf16*)(ws + WS_HB);
    bf16* P = (bf16*)(ws + WS_P);
    bf16* ys = (bf16*)(ws + WS_YS);
    bf16* mrg = (bf16*)(ws + WS_MRG);
    float* mix = (float*)(ws + WS_MIX);
    float* qb = (float*)(ws + WS_Q);
    unsigned char* mask = ws + WS_MASK;
    int* eid = (int*)(ws + WS_EID);
    float* gate = (float*)(ws + WS_GATE);
    float* kmean = (float*)(ws + WS_KMEAN);
    const float* hin = (l == 0) ? p.in[0] : hbuf;
    if (PH == PH_PRO) { Params pc; for (int i = 0; i < 13; ++i) pc.in[i] = p.in[i]; pc.out = p.out; pc.ws = ws;
        prologue_phase(WV_, pc, sm); convert_tables(WV_, pc);
        for (int i = LBID() * NTHR + LTID(WV_); i < DEPTH_ * 8 * 2 * 128 * 64 / 4; i += LGRID() * NTHR) { const float4 v = ((const float4*)p.in[8])[i]; ((uint2*)(ws + WS_SKB))[i] = make_uint2(pk2(v.x, v.y), pk2(v.z, v.w)); } if (LBID() < 2) build_unit_table((unsigned*)(ws + WS_CTL) + 1024, LBID() * NTHR + LTID(WV_)); }
    else if (PH == PH_GIN) {
        pg8::Gemm g{hb, (const bf16*)(ws + WS_WIN_T + l * WIN_T_BYTES), T_, NP, 1024};
        pg8::StaticOrder S; S.init(T_, NP, (int)LGRID(), (int)LBID());
        pg8::EpiBf16Sig E{P, NP, C_G};
        pg8::gemm_phase<pg8::EpiBf16Sig, pg8::StaticOrder, true, true>(WV_, (PG8_LAS unsigned char*)lds_raw, g, S, E);
    }
    else if (PH == PH_INDEX) index_fast_phase(WV_, P, mask, kmean, (float*)(ws + WS_YS), lds_raw);
    else if (PH == PH_ATTN) attn_fast_phase(WV_, P, mask, kmean, p.in[4] + l * 4, ys, (const unsigned*)(ws + WS_CTL) + 1024, (unsigned*)(ws + WS_CTL) + 64 * l, lds_raw);
    else if (PH == PH_MERGE) merge_fast_phase(WV_, P, ys, (const bf16*)(ws + WS_WBR_T) + (size_t)l * 4 * 1024 * 256, mrg, lds_raw);
    else if (PH == PH_GOUT) {
        pg8::Gemm g{mrg, (const bf16*)(ws + WS_WOUT_T) + (size_t)l * 1024 * 1024, T_, 1024, 1024};
        pg8::StaticOrder S; S.init(T_, 1024, (int)LGRID(), (int)LBID());
        pg8::EpiResY E{hin, hbuf, hb, (float*)(ws + WS_STATS) + (size_t)l * T_ * 2, ALPHA};
        pg8::gemm_phase<pg8::EpiResY, pg8::StaticOrder, true, true>(WV_, (PG8_LAS unsigned char*)lds_raw, g, S, E);
    }
    else if (PH == PH_GQ) {
        pg8::Gemm g{hb, (const bf16*)(ws + WS_WQ_T) + (size_t)l * 1024 * 1024, T_, 1024, 1024};
        pg8::StaticOrder S; S.init(T_, 1024, (int)LGRID(), (int)LBID());
        pg8::EpiLnFold E{(bf16*)qb, (const float*)(ws + WS_STATS) + (size_t)l * T_ * 2, (const float*)(ws + WS_COLS) + l * 2048, (const float*)(ws + WS_COLS) + l * 2048 + 1024, LN_EPS};
        pg8::gemm_phase<pg8::EpiLnFold, pg8::StaticOrder, true, true>(WV_, (PG8_LAS unsigned char*)lds_raw, g, S, E);
        pg8::Unit u0;
        if (LGRID() == 256 && S.next(0, u0)) {
            asm volatile("s_waitcnt vmcnt(0)" ::: "memory"); __syncthreads();
            route_fast_phase(WV_, (const bf16*)qb, (const bf16*)(ws + WS_SKB) + (size_t)l * 8 * 2 * 128 * 64, eid, gate, lds_raw, u0.pm, u0.pn);
        }
    }
    else if (PH == PH_ROUTE) { if (LGRID() != 256) route_fast_phase(WV_, (const bf16*)qb, (const bf16*)(ws + WS_SKB) + (size_t)l * 8 * 2 * 128 * 64, eid, gate, lds_raw); }
    else peer_fast_phase(WV_, hbuf, hb, eid, gate, ws + WS_UV + (size_t)l * 24 * MiB, p.in[5] + l * 1024, p.in[6] + l * 1024, p.in[11] + l * 1024, p.in[12] + l * 1024, lds_raw);
}

constexpr int CW_BAR = 4096;
constexpr int LDS_BARST = LDS_BYTES - 16;
__global__ void __launch_bounds__(NTHR, 2) mk_fwd(Params p) {
    extern __shared__ __attribute__((aligned(16))) unsigned char lds_raw[];
    cg::grid_group grid = cg::this_grid();
    const int WV_ = __builtin_amdgcn_readfirstlane((int)threadIdx.x >> 6);
    { volatile LAS unsigned* bst0 = (volatile LAS unsigned*)((LAS unsigned char*)lds_raw + LDS_BARST); if (threadIdx.x < 4) bst0[threadIdx.x] = 0u; }
    __syncthreads();
    volatile LAS unsigned* bst = (volatile LAS unsigned*)((LAS unsigned char*)lds_raw + LDS_BARST);
    (void)xcd_barrier_post((unsigned*)(p.ws + WS_CTL) + CW_BAR, bst);
#define GRID_BAR() do { XcdBarrier b_; b_.bar = (unsigned*)(p.ws + WS_CTL) + CW_BAR; b_.x = xb_xcc_id(); b_.st = (volatile LAS unsigned*)((LAS unsigned char*)lds_raw + LDS_BARST); xcd_barrier(b_, WV_); } while (0)
    run_phase<PH_PRO>(WV_, p, 0, lds_raw);
    grid.sync();
#pragma unroll 1
    for (int l = 0; l < DEPTH_; ++l) {
        run_phase<PH_GIN>(WV_, p, l, lds_raw); GRID_BAR();
        run_phase<PH_INDEX>(WV_, p, l, lds_raw); GRID_BAR();
        run_phase<PH_ATTN>(WV_, p, l, lds_raw); GRID_BAR();
        run_phase<PH_MERGE>(WV_, p, l, lds_raw); GRID_BAR();
        run_phase<PH_GOUT>(WV_, p, l, lds_raw); GRID_BAR();
        run_phase<PH_GQ>(WV_, p, l, lds_raw); if (LGRID() != 256) { GRID_BAR(); run_phase<PH_ROUTE>(WV_, p, l, lds_raw); } GRID_BAR();
        run_phase<PH_PEER>(WV_, p, l, lds_raw); if (l + 1 < DEPTH_) GRID_BAR();
    }
}

extern "C" void kernel_launch(void* const* d_in, const int* in_sizes, int n_in, void* d_out, int out_size, void* d_ws, size_t ws_size, hipStream_t stream) {
    if (n_in != 13 || ws_size < WS_END) { fprintf(stderr, "kernel_launch: unexpected n_in %d / ws_size %zu; nothing launched\n", n_in, ws_size); return; }
    static int grid_blocks = 0;
    if (grid_blocks == 0) {
        int dev = 0, cus = 0, per_cu = 0;
        (void)hipGetDevice(&dev);
        (void)hipDeviceGetAttribute(&cus, hipDeviceAttributeMultiprocessorCount, dev);
        (void)hipFuncSetAttribute((const void*)mk_fwd, hipFuncAttributeMaxDynamicSharedMemorySize, LDS_BYTES);
        (void)hipOccupancyMaxActiveBlocksPerMultiprocessor(&per_cu, (const void*)mk_fwd, NTHR, LDS_BYTES);
        if (per_cu < 1) fprintf(stderr, "kernel_launch: occupancy query reports %d\n", per_cu);
        grid_blocks = cus;
    }
    Params p{};
    for (int i = 0; i < 13; ++i) p.in[i] = (const float*)d_in[i];
    p.out = (float*)d_out; p.ws = (unsigned char*)d_ws;
    (void)hipMemsetAsync(d_ws, 0, 2 * MiB, stream);
    void* args[] = {&p};
    hipError_t e = hipLaunchCooperativeKernel((const void*)mk_fwd, dim3(grid_blocks), dim3(NTHR), args, LDS_BYTES, stream);
    if (e != hipSuccess) fprintf(stderr, "cooperative launch failed: %s (grid %d)\n", hipGetErrorString(e), grid_blocks);
}
```

```cpp
#include <hip/hip_runtime.h>
#include <cstdio>
#include <cstdint>
#include <hip/hip_cooperative_groups.h>
namespace cg = cooperative_groups;

__device__ __forceinline__ int LANEID() { int l; asm volatile("v_mbcnt_lo_u32_b32 %0, -1, 0\n\tv_mbcnt_hi_u32_b32 %0, -1, %0" : "=v"(l)); return l; }
__device__ __forceinline__ int LTID(int wv) { return (wv << 6) | LANEID(); }
__device__ __forceinline__ int LBID() { int t = blockIdx.x; asm volatile("" : "+s"(t)); return t; }
__device__ __forceinline__ int LGRID() { int t = gridDim.x; asm volatile("" : "+s"(t)); return t; }
namespace pg8 {
#define PG8_LAS __attribute__((address_space(3)))
typedef unsigned short bf16_t;
typedef short bf16x8 __attribute__((ext_vector_type(8)));
typedef float f32x4 __attribute__((ext_vector_type(4)));
typedef unsigned u32x4 __attribute__((ext_vector_type(4)));
constexpr int BM = 256, BK = 64, HALF = 128, HTB = HALF * BK * 2  , STAGE_BYTES = 8 * HTB, NXCD = 8, WGM = 8;

__host__ __device__ __forceinline__ int lds_byte(int r, int c) { const int st = (r >> 4) * 2 + (c >> 5), rr = r & 15, cc = c & 31, ob = rr * 64 + cc * 2; return st * 1024 + (ob ^ (((ob >> 9) & 1) << 5)); }
__host__ __device__ __forceinline__ void stage_rc(int b, int& R, int& C) { const int st = b / 1024, sb = b % 1024, swz = sb ^ (((sb >> 9) & 1) << 5); R = (st >> 1) * 16 + swz / 64; C = (st & 1) * 32 + (swz % 64) / 2; }
__host__ __device__ __forceinline__ int perm32(int rho) { const int n = rho >> 4, i = rho & 15; return 8 * (i >> 2) + 4 * n + (i & 3); }

struct Unit { int pm, pn; };
struct Gemm { const bf16_t* A; const bf16_t* Bt; int M, N, K; };

struct StaticOrder {
    int nM, nN, nwg, G, c;
    __host__ __device__ void init(int M, int N, int G_, int c_) { nM = M / BM; nN = N / BM; nwg = nM * nN; G = G_; c = c_; }
    __host__ __device__ bool next(int i, Unit& u) const {
        const long L = (long)i * G + c; if (L >= nwg) return false;
        int wgid = (int)L; { const int q = nwg / NXCD, r = nwg % NXCD, xcd = wgid % NXCD, off = wgid / NXCD; wgid = (xcd < r ? xcd * (q + 1) : r * (q + 1) + (xcd - r) * q) + off; }
        const int nig = WGM * nN, gid = wgid / nig, fm = gid * WGM, gsz = (nM - fm) < WGM ? (nM - fm) : WGM;
        u.pm = fm + ((wgid % nig) % gsz); u.pn = (wgid % nig) / gsz; return true;
    }
    __device__ __forceinline__ void a_ready(const Unit&) const {}
    __device__ __forceinline__ void done(const Unit&) const {}
};

__device__ __forceinline__ unsigned cvt_pk_bf16(float lo, float hi) { unsigned r; asm volatile("v_cvt_pk_bf16_f32 %0, %1, %2" : "=v"(r) : "v"(lo), "v"(hi)); return r; }
typedef float f32x2 __attribute__((ext_vector_type(2)));
__device__ __forceinline__ f32x2 gelu_pk(f32x2 v) {
    const f32x2 av = __builtin_elementwise_abs(v), d = av * 0.2316418882f + 1.0f;
    f32x2 t; t.x = __builtin_amdgcn_rcpf(d.x); t.y = __builtin_amdgcn_rcpf(d.y);
    f32x2 q = t * 0.5307027145f + (-0.7265760135f); q = q * t + 0.7107068705f; q = q * t + (-0.142248368f); q = q * t + 0.127414796f; q = q * t;
    const f32x2 s = (v * v) * (-0.72134752044f);
    f32x2 e; e.x = __builtin_amdgcn_exp2f(s.x); e.y = __builtin_amdgcn_exp2f(s.y);
    const f32x2 m = v * (q * e), r = v - m;
    f32x2 o; o.x = v.x < 0.f ? m.x : r.x; o.y = v.y < 0.f ? m.y : r.y; return o;
}

template <int ACT  > struct EpiBf16 {
    static constexpr bool PERM = true, AFTER_DRAIN = false; static_assert(ACT == 0 || ACT == 1, "EpiBf16: ACT is 0 (none) or 1 (gelu_pk)");
    bf16_t* O; int ldc; const float* bias; int split_cols; size_t split_stride; float scale0;
    __device__ __forceinline__ void operator()(const f32x4 (&acc)[2][2][4][2], const Unit& u, int wr, int wc, int fr, int fq) const {
        { int ln_ = LANEID(); asm volatile("" : "+v"(ln_)); fr = ln_ & 15; fq = ln_ >> 4; }
        const int row0 = u.pm * BM + wr * 64 + fr; int colt = u.pn * BM; bf16_t* base = O;
        float sc = 1.f; if (split_cols) { const int t = colt / split_cols; base += (size_t)t * split_stride; colt -= t * split_cols; if (t == 0) sc = scale0; }
        const int col0 = colt + wc * 32 + 8 * fq, bcol0 = u.pn * BM + wc * 32 + 8 * fq;
        f32x4 bv[2][2];
#pragma unroll
        for (int bj = 0; bj < 2; ++bj)
#pragma unroll
            for (int n = 0; n < 2; ++n) bv[bj][n] = bias ? *(const f32x4*)(bias + bcol0 + bj * HALF + 4 * n) : (f32x4){0.f, 0.f, 0.f, 0.f};
#pragma unroll
        for (int ai = 0; ai < 2; ++ai)
#pragma unroll
            for (int m = 0; m < 4; ++m) { bf16_t* rowp = base + (size_t)(row0 + ai * HALF + m * 16) * ldc + col0;
#pragma unroll
                for (int bj = 0; bj < 2; ++bj) { f32x4 v0 = acc[ai][bj][m][0] + bv[bj][0], v1 = acc[ai][bj][m][1] + bv[bj][1];
                    if (ACT == 1) { f32x2 a = gelu_pk((f32x2){v0[0], v0[1]}), b = gelu_pk((f32x2){v0[2], v0[3]}), c = gelu_pk((f32x2){v1[0], v1[1]}), d = gelu_pk((f32x2){v1[2], v1[3]});
                        v0 = (f32x4){a.x, a.y, b.x, b.y}; v1 = (f32x4){c.x, c.y, d.x, d.y}; }
                    v0 = v0 * sc; v1 = v1 * sc; u32x4 w; w.x = cvt_pk_bf16(v0[0], v0[1]); w.y = cvt_pk_bf16(v0[2], v0[3]); w.z = cvt_pk_bf16(v1[0], v1[1]); w.w = cvt_pk_bf16(v1[2], v1[3]);
                    *(u32x4*)(rowp + bj * HALF) = w; } }
    }
};
template <class Epi, class Sched, bool ALIGN_EPI = false, bool SP2 = false>
__device__ __forceinline__ void gemm_phase(int WV_, PG8_LAS unsigned char* lds, const Gemm g, const Sched& S, const Epi& E) {
    const int tid = LTID(WV_), wid = __builtin_amdgcn_readfirstlane(tid >> 6), lane = tid & 63, wr = wid >> 2, wc = wid & 3, fr = lane & 15, fq = lane >> 4;
    const int K = g.K, nt = K / BK;
    unsigned voffA[2], voffB[2];
#pragma unroll
    for (int i = 0; i < 2; ++i) { int R, C; stage_rc(tid * 16 + i * 8192, R, C); const int Rb = Epi::PERM ? ((R & ~31) + perm32(R & 31)) : R;
        voffA[i] = (unsigned)(R * K + C) * 2u; voffB[i] = (unsigned)(Rb * K + C) * 2u; }
    const size_t kstep = (size_t)(BK * 2);
    const size_t hstep = (size_t)HALF * K * 2;
    const size_t tstep = 2 * hstep;
    const unsigned ldsw = (unsigned)wid * 1024u;
    const int aoff = lds_byte(wr * 64 + fr, fq * 8), boff = lds_byte(wc * 32 + fr, fq * 8);
#define PG8_SA(b, h) (((b) * 2 + (h)) * HTB)
#define PG8_SB(b, h) ((4 + (b) * 2 + (h)) * HTB)
#define PG8_STAGE(bufoff, gbase, voff) do { _Pragma("unroll") for (int _i = 0; _i < 2; ++_i) \
        __builtin_amdgcn_global_load_lds((const unsigned*)((const char*)(gbase) + (voff)[_i]), (PG8_LAS unsigned*)(lds + (bufoff) + ldsw + _i * 8192), 16, 0, 0); } while (0)
#define PG8_LDA(dst, b, h) do { _Pragma("unroll") for (int m = 0; m < 4; ++m) _Pragma("unroll") for (int k = 0; k < 2; ++k) dst[m][k] = *(const PG8_LAS bf16x8*)(lds + PG8_SA(b, h) + aoff + m * 2048 + k * 1024); } while (0)
#define PG8_LDB(dst, b, h) do { _Pragma("unroll") for (int n = 0; n < 2; ++n) _Pragma("unroll") for (int k = 0; k < 2; ++k) dst[n][k] = *(const PG8_LAS bf16x8*)(lds + PG8_SB(b, h) + boff + n * 2048 + k * 1024); } while (0)
#define PG8_MMA(ai, bj, At, Bt) do { __builtin_amdgcn_s_setprio(1); _Pragma("unroll") for (int m = 0; m < 4; ++m) _Pragma("unroll") for (int n = 0; n < 2; ++n) _Pragma("unroll") for (int k = 0; k < 2; ++k) \
        acc[ai][bj][m][n] = __builtin_amdgcn_mfma_f32_16x16x32_bf16(Bt[n][k], At[m][k], acc[ai][bj][m][n], 0, 0, 0); __builtin_amdgcn_s_setprio(0); } while (0)
#define PG8_WAIT_V(n) asm volatile("s_waitcnt vmcnt(" #n ")" ::: "memory")
#define PG8_WAIT_L(n) asm volatile("s_waitcnt lgkmcnt(" #n ")" ::: "memory")
#define PG8_BAR __builtin_amdgcn_s_barrier()
#define PG8_SCHED __builtin_amdgcn_sched_barrier(0)
    Unit cur, nxt; int ui = 0;
    if (!S.next(0, cur)) return;
    f32x4 acc[2][2][4][2];
#pragma unroll
    for (int a = 0; a < 2; ++a)
#pragma unroll
        for (int b = 0; b < 2; ++b)
#pragma unroll
            for (int m = 0; m < 4; ++m)
#pragma unroll
                for (int n = 0; n < 2; ++n) acc[a][b][m][n] = (f32x4){0.f, 0.f, 0.f, 0.f};
    bf16x8 At[4][2], B0[2][2], B1[2][2];
    const char* cA = (const char*)g.A + (size_t)cur.pm * tstep; const char* cB = (const char*)g.Bt + (size_t)cur.pn * tstep;
    S.a_ready(cur);
    if constexpr (SP2) {
        PG8_STAGE(PG8_SB(0, 0), cB, voffB); PG8_STAGE(PG8_SB(0, 1), cB + hstep, voffB); PG8_STAGE(PG8_SA(0, 0), cA, voffA); PG8_STAGE(PG8_SA(0, 1), cA + hstep, voffA);
        if (wr == 1) PG8_BAR;
        PG8_WAIT_V(2); PG8_BAR;
        PG8_STAGE(PG8_SB(1, 0), cB + kstep, voffB); PG8_STAGE(PG8_SA(1, 0), cA + kstep, voffA); PG8_STAGE(PG8_SB(1, 1), cB + hstep + kstep, voffB);
        PG8_WAIT_V(6); PG8_BAR;
    } else {
        PG8_STAGE(PG8_SB(0, 0), cB, voffB); PG8_STAGE(PG8_SA(0, 0), cA, voffA); PG8_STAGE(PG8_SB(0, 1), cB + hstep, voffB); PG8_STAGE(PG8_SA(0, 1), cA + hstep, voffA);
        if (wr == 1) PG8_BAR;
        PG8_WAIT_V(4); PG8_BAR;
        PG8_STAGE(PG8_SB(1, 0), cB + kstep, voffB); PG8_STAGE(PG8_SA(1, 0), cA + kstep, voffA); PG8_STAGE(PG8_SB(1, 1), cB + hstep + kstep, voffB);
        PG8_WAIT_V(6); PG8_BAR;
    }
    for (;;) {
        const bool has_next = S.next(ui + 1, nxt);
        const char* nA = has_next ? (const char*)g.A + (size_t)nxt.pm * tstep : cA; const char* nB = has_next ? (const char*)g.Bt + (size_t)nxt.pn * tstep : cB;
        for (int t = 0; t < nt; t += 2) {
            const bool last = (t == nt - 2);
            const char* a1 = cA + (size_t)(t + 1) * kstep;
            const char* a2 = last ? nA : cA + (size_t)(t + 2) * kstep; const char* b2 = last ? nB : cB + (size_t)(t + 2) * kstep;
            const char* a3 = a2 + kstep; const char* b3 = b2 + kstep;
            if (last && has_next) S.a_ready(nxt);
            if constexpr (SP2) {
            PG8_LDB(B0, 0, 0); PG8_LDB(B1, 0, 1); PG8_SCHED; PG8_LDA(At, 0, 0); PG8_STAGE(PG8_SA(1, 1), a1 + hstep, voffA);
            PG8_WAIT_V(8); PG8_WAIT_L(0); PG8_BAR; PG8_MMA(0, 0, At, B0); PG8_MMA(0, 1, At, B1); PG8_BAR; PG8_SCHED;
            PG8_LDA(At, 0, 1); PG8_STAGE(PG8_SB(0, 0), b2, voffB); PG8_STAGE(PG8_SB(0, 1), b2 + hstep, voffB); PG8_STAGE(PG8_SA(0, 0), a2, voffA);
            PG8_WAIT_V(8); PG8_WAIT_L(0); PG8_BAR; PG8_MMA(1, 0, At, B0); PG8_MMA(1, 1, At, B1); PG8_BAR; PG8_SCHED;
            PG8_LDB(B0, 1, 0); PG8_LDB(B1, 1, 1); PG8_SCHED; PG8_LDA(At, 1, 0); PG8_STAGE(PG8_SA(0, 1), a2 + hstep, voffA);
            PG8_WAIT_V(8); PG8_WAIT_L(0); PG8_BAR; PG8_MMA(0, 0, At, B0); PG8_MMA(0, 1, At, B1); PG8_BAR; PG8_SCHED;
            PG8_LDA(At, 1, 1); PG8_STAGE(PG8_SB(1, 0), b3, voffB); PG8_STAGE(PG8_SB(1, 1), b3 + hstep, voffB); PG8_STAGE(PG8_SA(1, 0), a3, voffA);
            PG8_WAIT_V(8); PG8_WAIT_L(0); PG8_BAR; PG8_MMA(1, 0, At, B0); PG8_MMA(1, 1, At, B1); PG8_BAR; PG8_SCHED;
            } else {
            PG8_LDB(B0, 0, 0); PG8_SCHED; PG8_LDA(At, 0, 0); PG8_STAGE(PG8_SA(1, 1), a1 + hstep, voffA);
            PG8_WAIT_L(8); PG8_BAR; PG8_WAIT_L(0); PG8_MMA(0, 0, At, B0); PG8_BAR; PG8_SCHED;
            PG8_LDB(B1, 0, 1); PG8_STAGE(PG8_SB(0, 0), b2, voffB);
            PG8_BAR; PG8_WAIT_L(0); PG8_MMA(0, 1, At, B1); PG8_BAR;
            PG8_LDA(At, 0, 1); PG8_STAGE(PG8_SA(0, 0), a2, voffA);
            PG8_BAR; PG8_WAIT_L(0); PG8_MMA(1, 0, At, B0); PG8_BAR; PG8_SCHED;
            PG8_STAGE(PG8_SB(0, 1), b2 + hstep, voffB);
            PG8_WAIT_V(6); PG8_BAR; PG8_MMA(1, 1, At, B1); PG8_BAR;
            PG8_LDB(B0, 1, 0); PG8_SCHED; PG8_LDA(At, 1, 0); PG8_STAGE(PG8_SA(0, 1), a2 + hstep, voffA);
            PG8_WAIT_L(8); PG8_BAR; PG8_WAIT_L(0); PG8_MMA(0, 0, At, B0); PG8_BAR; PG8_SCHED;
            PG8_LDB(B1, 1, 1); PG8_STAGE(PG8_SB(1, 0), b3, voffB);
            PG8_BAR; PG8_WAIT_L(0); PG8_MMA(0, 1, At, B1); PG8_BAR;
            PG8_LDA(At, 1, 1); PG8_STAGE(PG8_SA(1, 0), a3, voffA);
            PG8_BAR; PG8_WAIT_L(0); PG8_MMA(1, 0, At, B0); PG8_BAR; PG8_SCHED;
            PG8_STAGE(PG8_SB(1, 1), b3 + hstep, voffB);
            PG8_WAIT_V(6); PG8_BAR; PG8_MMA(1, 1, At, B1); PG8_BAR;
            }
        }
        if constexpr (ALIGN_EPI) { if (wr == 0) PG8_BAR; }
        if constexpr (!Epi::AFTER_DRAIN) { E(acc, cur, wr, wc, fr, fq); S.done(cur); }
        if (!has_next) break;
#pragma unroll
        for (int a = 0; a < 2; ++a)
#pragma unroll
            for (int b = 0; b < 2; ++b)
#pragma unroll
                for (int m = 0; m < 4; ++m)
#pragma unroll
                    for (int n = 0; n < 2; ++n) acc[a][b][m][n] = (f32x4){0.f, 0.f, 0.f, 0.f};
        cur = nxt; cA = nA; cB = nB; ++ui;
        if constexpr (ALIGN_EPI) { if (wr == 1) PG8_BAR; }
    }
    PG8_WAIT_V(0);
    if constexpr (!ALIGN_EPI) { if (wr == 0) PG8_BAR; }
    PG8_BAR;
    if constexpr (Epi::AFTER_DRAIN) { E.fused(acc, cur, wr, wc, fr, fq, lds, wid, lane); S.done(cur); }
#undef PG8_SA
#undef PG8_SB
#undef PG8_STAGE
#undef PG8_LDA
#undef PG8_LDB
#undef PG8_MMA
#undef PG8_WAIT_V
#undef PG8_WAIT_L
#undef PG8_BAR
#undef PG8_SCHED
}
}
namespace pg8 {
struct EpiF32 {
    static constexpr bool PERM = false, AFTER_DRAIN = false;
    float* O; int ldc;
    __device__ __forceinline__ void operator()(const f32x4 (&acc)[2][2][4][2], const Unit& u, int wr, int wc, int fr, int fq) const {
        { int ln_ = LANEID(); asm volatile("" : "+v"(ln_)); fr = ln_ & 15; fq = ln_ >> 4; }
        const int row0 = u.pm * BM + wr * 64 + fr, col0 = u.pn * BM + wc * 32 + 4 * fq;
#pragma unroll
        for (int ai = 0; ai < 2; ++ai)
#pragma unroll
            for (int m = 0; m < 4; ++m) { float* rowp = O + (size_t)(row0 + ai * HALF + m * 16) * ldc + col0;
#pragma unroll
                for (int bj = 0; bj < 2; ++bj)
#pragma unroll
                    for (int n = 0; n < 2; ++n) *(f32x4*)(rowp + bj * HALF + n * 16) = acc[ai][bj][m][n]; }
    }
};
struct EpiResY {
    static constexpr bool PERM = false, AFTER_DRAIN = false;
    const float* hin; float* yout; bf16_t* yb; float* stats; float alpha;
    __device__ __forceinline__ void operator()(const f32x4 (&acc)[2][2][4][2], const Unit& u, int wr, int wc, int fr, int fq) const {
        { int ln_ = LANEID(); asm volatile("" : "+v"(ln_)); fr = ln_ & 15; fq = ln_ >> 4; }
        const int row0 = u.pm * BM + wr * 64 + fr, col0 = u.pn * BM + wc * 32 + 4 * fq;
#pragma unroll
        for (int ai = 0; ai < 2; ++ai)
#pragma unroll
            for (int m = 0; m < 4; ++m) {
                const int row = row0 + ai * HALF + m * 16;
                float s = 0.f, s2 = 0.f;
#pragma unroll
                for (int bj = 0; bj < 2; ++bj)
#pragma unroll
                    for (int n = 0; n < 2; ++n) {
                        const size_t off = (size_t)row * 1024 + col0 + bj * HALF + n * 16;
                        const f32x4 hv = *(const f32x4*)(hin + off);
                        const f32x4 y = hv * alpha + acc[ai][bj][m][n];
                        *(f32x4*)(yout + off) = y;
                        typedef unsigned u32x2v __attribute__((ext_vector_type(2)));
                        u32x2v w; w.x = cvt_pk_bf16(y[0], y[1]); w.y = cvt_pk_bf16(y[2], y[3]);
                        *(u32x2v*)(yb + off) = w;
                        s += (y[0] + y[1]) + (y[2] + y[3]); s2 += (y[0] * y[0] + y[1] * y[1]) + (y[2] * y[2] + y[3] * y[3]);
                    }
                s += __shfl_xor(s, 16); s += __shfl_xor(s, 32); s2 += __shfl_xor(s2, 16); s2 += __shfl_xor(s2, 32);
                if (fq == 0) { atomicAdd(stats + 2 * (size_t)row, s); atomicAdd(stats + 2 * (size_t)row + 1, s2); }
            }
    }
};
struct EpiLnFold {
    static constexpr bool PERM = true, AFTER_DRAIN = false;
    bf16_t* O; const float* stats; const float* colsum; const float* colbias; float eps;
    __device__ __forceinline__ void operator()(const f32x4 (&acc)[2][2][4][2], const Unit& u, int wr, int wc, int fr, int fq) const {
        { int ln_ = LANEID(); asm volatile("" : "+v"(ln_)); fr = ln_ & 15; fq = ln_ >> 4; }
        const int row0 = u.pm * BM + wr * 64 + fr, col0 = u.pn * BM + wc * 32 + 8 * fq;
        f32x4 cs[2][2], cb[2][2];
#pragma unroll
        for (int bj = 0; bj < 2; ++bj)
#pragma unroll
            for (int n = 0; n < 2; ++n) { cs[bj][n] = *(const f32x4*)(colsum + col0 + bj * HALF + 4 * n); cb[bj][n] = *(const f32x4*)(colbias + col0 + bj * HALF + 4 * n); }
#pragma unroll
        for (int ai = 0; ai < 2; ++ai)
#pragma unroll
            for (int m = 0; m < 4; ++m) {
                const int row = row0 + ai * HALF + m * 16;
                const float sm_ = stats[2 * (size_t)row], sq_ = stats[2 * (size_t)row + 1];
                const float mean = sm_ * (1.0f / 1024.0f);
                const float rstd = 1.0f / sqrtf(fmaxf(sq_ * (1.0f / 1024.0f) - mean * mean, 0.f) + eps);
                bf16_t* rowp = O + (size_t)row * 1024 + col0;
#pragma unroll
                for (int bj = 0; bj < 2; ++bj) {
                    const f32x4 v0 = (acc[ai][bj][m][0] - cs[bj][0] * mean) * rstd + cb[bj][0], v1 = (acc[ai][bj][m][1] - cs[bj][1] * mean) * rstd + cb[bj][1];
                    u32x4 w; w.x = cvt_pk_bf16(v0[0], v0[1]); w.y = cvt_pk_bf16(v0[2], v0[3]); w.z = cvt_pk_bf16(v1[0], v1[1]); w.w = cvt_pk_bf16(v1[2], v1[3]);
                    *(u32x4*)(rowp + bj * HALF) = w;
                }
            }
    }
};
__device__ __forceinline__ unsigned cvt_pk_bf16_t(float lo, float hi) { unsigned r; asm volatile("s_nop 0\n\tv_cvt_pk_bf16_f32 %0, %1, %2" : "=v"(r) : "v"(lo), "v"(hi)); return r; }
struct EpiBf16Sig {
    static constexpr bool PERM = true, AFTER_DRAIN = false;
    bf16_t* O; int ldc; int sig_col0;
    __device__ __forceinline__ void operator()(const f32x4 (&acc)[2][2][4][2], const Unit& u, int wr, int wc, int fr, int fq) const {
        { int ln_ = LANEID(); asm volatile("" : "+v"(ln_)); fr = ln_ & 15; fq = ln_ >> 4; }
        const int row0 = u.pm * BM + wr * 64 + fr; const int col0 = u.pn * BM + wc * 32 + 8 * fq;
#pragma unroll
        for (int bj = 0; bj < 2; ++bj) {
            if (col0 + bj * HALF >= sig_col0) {
#pragma unroll
                for (int ai = 0; ai < 2; ++ai)
#pragma unroll
                    for (int m = 0; m < 4; ++m) { bf16_t* rowp = O + (size_t)(row0 + ai * HALF + m * 16) * ldc + col0;
                        f32x4 v0 = acc[ai][bj][m][0], v1 = acc[ai][bj][m][1];
#pragma unroll
                        for (int e = 0; e < 4; ++e) { v0[e] = __builtin_amdgcn_rcpf(1.f + __builtin_amdgcn_exp2f(-1.44269504f * v0[e])); v1[e] = __builtin_amdgcn_rcpf(1.f + __builtin_amdgcn_exp2f(-1.44269504f * v1[e])); }
                        u32x4 w; w.x = cvt_pk_bf16_t(v0[0], v0[1]); w.y = cvt_pk_bf16_t(v0[2], v0[3]); w.z = cvt_pk_bf16_t(v1[0], v1[1]); w.w = cvt_pk_bf16_t(v1[2], v1[3]);
                        *(u32x4*)(rowp + bj * HALF) = w; }
            } else {
#pragma unroll
                for (int ai = 0; ai < 2; ++ai)
#pragma unroll
                    for (int m = 0; m < 4; ++m) { bf16_t* rowp = O + (size_t)(row0 + ai * HALF + m * 16) * ldc + col0;
                        const f32x4 v0 = acc[ai][bj][m][0], v1 = acc[ai][bj][m][1];
                        u32x4 w; w.x = cvt_pk_bf16(v0[0], v0[1]); w.y = cvt_pk_bf16(v0[2], v0[3]); w.z = cvt_pk_bf16(v1[0], v1[1]); w.w = cvt_pk_bf16(v1[2], v1[3]);
                        *(u32x4*)(rowp + bj * HALF) = w; }
            }
        }
    }
};
}

typedef unsigned short bf16;
constexpr int T_ = 16384, S_ = 4096, NBATCH = 4, D_ = 1024, NCOL = 6824, NP = 6912, DEPTH_ = 2;
constexpr int C_QA = 0, C_KA = 256, C_VA = 320, C_QI = 384, C_KI = 640, C_WI = 672, C_QB = 680, C_KB = 936, C_VB = 1064,
              C_QC = 1192, C_KC = 1448, C_VC = 1704, C_QD = 1960, C_KD = 2216, C_VD = 2472, C_G = 2728;
constexpr int NTHR = 512, NWAVE = 8;
constexpr float ALPHA = 1.41421356237309515f;
constexpr float LN_EPS = 1e-5f;
constexpr size_t MiB = 1u << 20;
constexpr size_t WS_STATS = 1 * MiB  , WS_COLS = 1 * MiB + 512 * 1024  ;
constexpr size_t WS_CTL = 0, WS_WIN_T = 2 * MiB, WS_WOUT_T = 30 * MiB, WS_WQ_T = 34 * MiB, WS_WBR_T = 38 * MiB, WS_HB = 42 * MiB,
                 WS_P = 74 * MiB, WS_MIX = 74 * MiB  , WS_Q = 138 * MiB  , WS_YS = 290 * MiB, WS_MRG = 322 * MiB,
                 WS_MASK = 354 * MiB, WS_EID = 362 * MiB, WS_GATE = 370 * MiB, WS_KMEAN = 378 * MiB, WS_SKB = 379 * MiB, WS_UV = 380 * MiB, WS_END = 508 * MiB;
constexpr size_t WIN_T_BYTES = (size_t)NP * 1024 * 2;
constexpr int LDS_BYTES = 144 * 1024;

struct Params { const float* in[13]; float* out; unsigned char* ws; };

__device__ __forceinline__ float bf2f(bf16 v) { return __uint_as_float((unsigned)v << 16); }
__device__ __forceinline__ unsigned f2bf(float f) { unsigned u = __float_as_uint(f); return (u + 0x7fffu + ((u >> 16) & 1u)) >> 16; }
__device__ __forceinline__ unsigned pk2(float lo, float hi) { return f2bf(lo) | (f2bf(hi) << 16); }
__device__ __forceinline__ void unpack8(const uint4 v, float* o) {
    o[0] = __uint_as_float(v.x << 16); o[1] = __uint_as_float(v.x & 0xffff0000u); o[2] = __uint_as_float(v.y << 16); o[3] = __uint_as_float(v.y & 0xffff0000u);
    o[4] = __uint_as_float(v.z << 16); o[5] = __uint_as_float(v.z & 0xffff0000u); o[6] = __uint_as_float(v.w << 16); o[7] = __uint_as_float(v.w & 0xffff0000u);
}
__device__ __forceinline__ float wave_sum(float v) {
#pragma unroll
    for (int o = 32; o > 0; o >>= 1) v += __shfl_xor(v, o);
    return v;
}
__device__ __forceinline__ float wave_max(float v) {
#pragma unroll
    for (int o = 32; o > 0; o >>= 1) v = fmaxf(v, __shfl_xor(v, o));
    return v;
}
__device__ __forceinline__ int wave_sum_i(int v) {
#pragma unroll
    for (int o = 32; o > 0; o >>= 1) v += __shfl_xor(v, o);
    return v;
}
__device__ __forceinline__ float logsig(float x) { return fminf(x, 0.f) - log1pf(expf(-fabsf(x))); }

__device__ void transpose_items(int WV_, const float* W, int K, int N, bf16* WT, float* sm, int item0, int nitems_total, int item_stride,
                                const float* rs_g = nullptr, const float* rs_b = nullptr, float* colsum = nullptr, float* colbias = nullptr) {
    const int tid = LTID(WV_);
    const int nkb = K / 64, nnb = (N + 63) / 64;
    for (int it = item0; it < nkb * nnb; it += item_stride) {
        const int kb = it % nkb, nb = it / nkb, k0 = kb * 64, n0 = nb * 64;
        __syncthreads();
        for (int e = tid; e < 64 * 64; e += NTHR) { const int kk = e >> 6, nn = e & 63; sm[kk * 65 + nn] = (n0 + nn < N) ? W[(size_t)(k0 + kk) * N + n0 + nn] : 0.f; }
        __syncthreads();
        if (rs_g) {
            if (tid < 64) { float cs = 0.f, cb = 0.f;
                for (int kk = 0; kk < 64; ++kk) { const float w = sm[kk * 65 + tid]; cs += w * rs_g[k0 + kk]; cb += w * rs_b[k0 + kk]; }
                atomicAdd(colsum + n0 + tid, cs); atomicAdd(colbias + n0 + tid, cb); }
            __syncthreads();
            for (int e = tid; e < 64 * 64; e += NTHR) { const int kk = e >> 6, nn = e & 63; sm[kk * 65 + nn] *= rs_g[k0 + kk]; }
            __syncthreads();
        }
        { const int nn = tid >> 3, c = tid & 7;
          if (n0 + nn < N) { uint4 o; o.x = pk2(sm[(8 * c + 0) * 65 + nn], sm[(8 * c + 1) * 65 + nn]); o.y = pk2(sm[(8 * c + 2) * 65 + nn], sm[(8 * c + 3) * 65 + nn]);
              o.z = pk2(sm[(8 * c + 4) * 65 + nn], sm[(8 * c + 5) * 65 + nn]); o.w = pk2(sm[(8 * c + 6) * 65 + nn], sm[(8 * c + 7) * 65 + nn]);
              *(uint4*)(WT + (size_t)(n0 + nn) * K + k0 + 8 * c) = o; } }
    }
    __syncthreads();
}
__device__ void prologue_phase(int WV_, const Params& p, float* sm) {
    const int tid = LTID(WV_), B = LBID(), G = LGRID();
    unsigned char* ws = p.ws;
    for (int l = 0; l < DEPTH_; ++l) {
        bf16* win_t = (bf16*)(ws + WS_WIN_T + l * WIN_T_BYTES);
        transpose_items(WV_, p.in[1] + (size_t)l * 1024 * NCOL, 1024, NCOL, win_t, sm, B, 0, G);
        for (int i = B * NTHR + tid; i < (NP - NCOL) * 1024 / 8; i += G * NTHR) ((uint4*)(win_t + (size_t)NCOL * 1024))[i] = make_uint4(0u, 0u, 0u, 0u);
        transpose_items(WV_, p.in[3] + (size_t)l * 1024 * 1024, 1024, 1024, (bf16*)(ws + WS_WOUT_T) + (size_t)l * 1024 * 1024, sm, B, 0, G);
        transpose_items(WV_, p.in[7] + (size_t)l * 1024 * 1024, 1024, 1024, (bf16*)(ws + WS_WQ_T) + (size_t)l * 1024 * 1024, sm, B, 0, G,
                        p.in[5] + l * 1024, p.in[6] + l * 1024, (float*)(ws + WS_COLS) + l * 2048, (float*)(ws + WS_COLS) + l * 2048 + 1024);
        for (int n = 0; n < 4; ++n)
            transpose_items(WV_, p.in[2] + ((size_t)l * 4 + n) * 256 * 1024, 256, 1024, (bf16*)(ws + WS_WBR_T) + ((size_t)l * 4 + n) * 1024 * 256, sm, B, 0, G);
    }
    const float4* x4 = (const float4*)p.in[0]; uint2* hb2 = (uint2*)(ws + WS_HB);
    for (size_t i = (size_t)B * NTHR + tid; i < (size_t)T_ * 1024 / 4; i += (size_t)G * NTHR) { const float4 v = x4[i]; hb2[i] = make_uint2(pk2(v.x, v.y), pk2(v.z, v.w)); }
}

__device__ __forceinline__ void ln_row(float4 (&v)[4], const float* g, const float* bb, float* orow, bf16* obrow, int lane) {
    float s = 0.f;
#pragma unroll
    for (int j = 0; j < 4; ++j) s += (v[j].x + v[j].y) + (v[j].z + v[j].w);
    const float mean = wave_sum(s) * (1.0f / 1024.0f);
    float s2 = 0.f;
#pragma unroll
    for (int j = 0; j < 4; ++j) { v[j].x -= mean; v[j].y -= mean; v[j].z -= mean; v[j].w -= mean; s2 += (v[j].x * v[j].x + v[j].y * v[j].y) + (v[j].z * v[j].z + v[j].w * v[j].w); }
    const float rstd = 1.0f / sqrtf(wave_sum(s2) * (1.0f / 1024.0f) + LN_EPS);
#pragma unroll
    for (int j = 0; j < 4; ++j) {
        const float4 gg = ((const float4*)g)[j * 64 + lane], b4 = ((const float4*)bb)[j * 64 + lane];
        float4 o; o.x = v[j].x * rstd * gg.x + b4.x; o.y = v[j].y * rstd * gg.y + b4.y; o.z = v[j].z * rstd * gg.z + b4.z; o.w = v[j].w * rstd * gg.w + b4.w;
        ((float4*)orow)[j * 64 + lane] = o;
        ((uint2*)obrow)[j * 64 + lane] = make_uint2(pk2(o.x, o.y), pk2(o.z, o.w));
    }
}
__device__ void ln1_phase(int WV_, const float* hin, const float* add, const float* g, const float* bb, float* hout, bf16* hb) {
    const int lane = LTID(WV_) & 63, wave = LTID(WV_) >> 6;
    for (int row = LBID() * NWAVE + wave; row < T_; row += LGRID() * NWAVE) {
        float4 v[4];
#pragma unroll
        for (int j = 0; j < 4; ++j) {
            const float4 a = ((const float4*)(hin + (size_t)row * 1024))[j * 64 + lane], m = ((const float4*)(add + (size_t)row * 1024))[j * 64 + lane];
            v[j].x = ALPHA * a.x + m.x; v[j].y = ALPHA * a.y + m.y; v[j].z = ALPHA * a.z + m.z; v[j].w = ALPHA * a.w + m.w;
        }
        ln_row(v, g, bb, hout + (size_t)row * 1024, hb + (size_t)row * 1024, lane);
    }
}


typedef short bf16x8_t __attribute__((ext_vector_type(8)));
typedef float f32x16_t __attribute__((ext_vector_type(16)));
typedef float f32x2_t __attribute__((ext_vector_type(2)));
typedef __bf16 bf16x2_t __attribute__((ext_vector_type(2)));
__device__ __forceinline__ unsigned cvtpk(float lo, float hi) { f32x2_t v = {lo, hi}; bf16x2_t b = __builtin_convertvector(v, bf16x2_t); return __builtin_bit_cast(unsigned, b); }
__device__ __forceinline__ int crow(int r, int hi) { return (r & 3) + 8 * (r >> 2) + 4 * hi; }
__device__ __forceinline__ float xlane32(float v) { return __shfl_xor(v, 32); }
__device__ __forceinline__ float vmax(float a, float b) { float r; asm("v_max_f32_e32 %0, %1, %2" : "=v"(r) : "v"(a), "v"(b)); return r; }
__device__ __forceinline__ float vmin(float a, float b) { float r; asm("v_min_f32_e32 %0, %1, %2" : "=v"(r) : "v"(a), "v"(b)); return r; }
__device__ __forceinline__ float vmax3(float a, float b, float c) { float r; asm("v_max3_f32 %0, %1, %2, %3" : "=v"(r) : "v"(a), "v"(b), "v"(c)); return r; }

constexpr int AT_KP = 72, AT_VP = 96;
constexpr int AT_KS = 0, AT_KS_BYTES = 64 * AT_KP * 2;
constexpr int AT_VT = 2 * AT_KS_BYTES, AT_VT_BYTES = 64 * AT_VP * 2;
constexpr int AT_KM = AT_VT + 2 * AT_VT_BYTES;
constexpr int AT_MISC = AT_KM + 32 * AT_KP * 2;
constexpr float LOG2E = 1.4426950408889634f;

__device__ __forceinline__ unsigned mk_unit(int kind, int b, int x, int y) { return ((unsigned)kind << 30) | ((unsigned)b << 28) | ((unsigned)x << 8) | (unsigned)y; }
__device__ void build_unit_table(unsigned* tab, int i) {
    int n = 0; unsigned res = 0u;
#pragma unroll 1
    for (int c = 64; c >= 1; --c) {
        if (i >= n && i < n + 4) res = mk_unit(0, i - n, 0, c - 1);
        n += 4;
        if ((c & 3) == 0) { if (i >= n && i < n + 16) { const int j = i - n; res = mk_unit(2, j >> 2, j & 3, c / 4 - 1); } n += 16; }
    }
    if (i < 512) tab[i] = res;
}

template <int kind> __device__ __forceinline__ void attn_unit(int WV_, const bf16* P, const unsigned char* mask, const float* kmean, const float* sinks, bf16* ys,
                                unsigned char* lds, int b, int ux, int uy) {
    int tid_ = LTID(WV_); asm volatile("" : "+v"(tid_));
    const int tid = tid_, lane = tid & 63, wave = __builtin_amdgcn_readfirstlane(tid >> 6), r32 = lane & 31, hi = lane >> 5;
    bf16* s_km = (bf16*)(lds + AT_KM);
    const int skey = tid >> 3, sc = tid & 7;
    {
        const bf16* Pb = P + (size_t)b * S_ * NP;
        int q0w, qcol, kcol, vcol, ycol, kt_hi, kt_lo; float slope2 = 0.f, sink2 = 0.f;
        if (kind == 0) { const int head = wave >> 1; q0w = uy * 64 + (wave & 1) * 32; qcol = C_QA + head * 64; kcol = C_KA; vcol = C_VA; ycol = head * 64;
            slope2 = exp2f(-8.0f * (float)(3 * head + 1) / 12.0f) * LOG2E; kt_hi = uy; kt_lo = 0; }
        else if (kind == 1) { const int hq = ux * 2 + (wave >> 2); q0w = uy * 128 + (wave & 3) * 32; qcol = C_QB + hq * 64; kcol = C_KB + ux * 64; vcol = C_VB + ux * 64; ycol = 256 + hq * 64;
            slope2 = exp2f(-8.0f * (float)(3 * hq + 2) / 12.0f) * LOG2E; sink2 = sinks[hq] * LOG2E; kt_hi = 2 * uy + 1; kt_lo = (2 * uy - 2 > 0) ? 2 * uy - 2 : 0; }
        else if (kind == 2) { q0w = uy * 256 + wave * 32; qcol = C_QC + ux * 64; kcol = C_KC + ux * 64; vcol = C_VC + ux * 64; ycol = 512 + ux * 64;
            slope2 = exp2f(-8.0f * (float)(3 * ux + 3) / 12.0f) * LOG2E; kt_hi = 4 * uy + 3; kt_lo = 0; }
        else { q0w = uy * 256 + wave * 32; qcol = C_QD + ux * 64; kcol = C_KD + ux * 64; vcol = C_VD + ux * 64; ycol = 768 + ux * 64; kt_hi = 4 * uy + 3; kt_lo = 0; }
        const int qpos = q0w + r32;
        bf16x8_t qf[4];
        { const bf16* qp = Pb + (size_t)qpos * NP + qcol + 8 * hi;
#pragma unroll
          for (int ks = 0; ks < 4; ++ks) qf[ks] = *(const bf16x8_t*)(qp + 16 * ks); }
        {
            const float qs = (kind == 3) ? 0.125f : 0.125f * LOG2E;
            typedef unsigned u32x4_t __attribute__((ext_vector_type(4)));
#pragma unroll
            for (int ks = 0; ks < 4; ++ks) { u32x4_t w = __builtin_bit_cast(u32x4_t, qf[ks]);
#pragma unroll
                for (int i = 0; i < 4; ++i) w[i] = cvtpk(__uint_as_float(w[i] << 16) * qs, __uint_as_float(w[i] & 0xffff0000u) * qs);
                qf[ks] = __builtin_bit_cast(bf16x8_t, w); }
        }
        float sb[16];
#pragma unroll
        for (int r = 0; r < 16; ++r) sb[r] = slope2 * (float)((r & 3) + 8 * (r >> 2));
        unsigned bm = 0u;
        if (kind == 2) {
            const int own = uy;
            for (int e = tid; e < 32 * 64; e += NTHR) { const int row = e >> 6, d = e & 63; s_km[row * AT_KP + d] = (row < 16) ? (bf16)f2bf(kmean[((b * 4 + ux) * 16 + row) * 64 + d]) : (bf16)0; }
            __syncthreads();
            f32x16_t gacc;
#pragma unroll
            for (int r = 0; r < 16; ++r) gacc[r] = 0.f;
#pragma unroll
            for (int ks = 0; ks < 4; ++ks) { const bf16x8_t a = *(const bf16x8_t*)(s_km + r32 * AT_KP + 16 * ks + 8 * hi); gacc = __builtin_amdgcn_mfma_f32_32x32x16_bf16(a, qf[ks], gacc, 0, 0, 0); }
            float gt[16];
#pragma unroll
            for (int r = 0; r < 8; ++r) { const float mine = gacc[r], other = xlane32(mine); const int bi = crow(r, 0);
                gt[bi] = hi ? other : mine; gt[bi + 4] = hi ? mine : other; }
#pragma unroll
            for (int n = 0; n < 16; ++n) if (n >= own) gt[n] = -INFINITY;
#pragma unroll
            for (int rep = 0; rep < 3; ++rep) {
                float mx = -INFINITY;
#pragma unroll
                for (int n = 0; n < 16; ++n) mx = fmaxf(mx, gt[n]);
                bool done = !(mx > -INFINITY);
#pragma unroll
                for (int n = 0; n < 16; ++n) { const bool hit = !done && gt[n] == mx; if (hit) { bm |= 1u << n; gt[n] = -INFINITY; done = true; } }
            }
        }
        f32x16_t o0, o1;
#pragma unroll
        for (int r = 0; r < 16; ++r) { o0[r] = 0.f; o1[r] = 0.f; }
        float m_run = -INFINITY, l_run = 0.f, carry = 0.f;
        const bf16* kg = Pb + (size_t)skey * NP + kcol + sc * 8;
        const bf16* vg = Pb + (size_t)skey * NP + vcol + sc * 8;
        uint4 rk = *(const uint4*)(kg + (size_t)kt_hi * 64 * NP), rv = *(const uint4*)(vg + (size_t)kt_hi * 64 * NP);
        int buf = 0;
        { bf16* ks_ = (bf16*)(lds + AT_KS); bf16* vt_ = (bf16*)(lds + AT_VT);
          *(uint4*)(ks_ + skey * AT_KP + sc * 8) = rk;
          *(uint4*)(vt_ + skey * AT_VP + sc * 8) = rv; }
        __syncthreads();
        bool wave_done = false;
        uint2 mw_next = make_uint2(0u, 0u);
        if (kind == 0) mw_next = *(const uint2*)(mask + (size_t)(b * S_ + qpos) * 512 + kt_hi * 8);
        for (int kt = kt_hi; kt >= kt_lo; --kt) {
            const bool more = kt > kt_lo;
            const uint2 mw = mw_next;
            if (kind == 0 && more) mw_next = *(const uint2*)(mask + (size_t)(b * S_ + qpos) * 512 + (kt - 1) * 8);
            if (more) { rk = *(const uint4*)(kg + (size_t)(kt - 1) * 64 * NP); rv = *(const uint4*)(vg + (size_t)(kt - 1) * 64 * NP); }
            const bf16* ks_ = (const bf16*)(lds + AT_KS + buf * AT_KS_BYTES);
            const bf16* vt_ = (const bf16*)(lds + AT_VT + buf * AT_VT_BYTES);
            bool active = (kt * 64 <= q0w + 31) && !wave_done;
            if (kind == 1) active = active && (kt * 64 + 63 >= q0w - 127);
            if (active) {
                const int kbase = kt * 64 + 4 * hi;
                f32x16_t p0, p1;
                if (kind != 3) {
                    const float cb = slope2 * (float)(kbase - qpos), cb1 = cb + 32.0f * slope2;
#pragma unroll
                    for (int r = 0; r < 16; ++r) { p0[r] = cb + sb[r]; p1[r] = cb1 + sb[r]; }
                } else {
#pragma unroll
                    for (int r = 0; r < 16; ++r) { p0[r] = 0.f; p1[r] = 0.f; }
                }
#pragma unroll
                for (int ks = 0; ks < 4; ++ks) {
                    const bf16x8_t a0 = *(const bf16x8_t*)(ks_ + r32 * AT_KP + 16 * ks + 8 * hi);
                    const bf16x8_t a1 = *(const bf16x8_t*)(ks_ + (32 + r32) * AT_KP + 16 * ks + 8 * hi);
                    p0 = __builtin_amdgcn_mfma_f32_32x32x16_bf16(a0, qf[ks], p0, 0, 0, 0);
                    p1 = __builtin_amdgcn_mfma_f32_32x32x16_bf16(a1, qf[ks], p1, 0, 0, 0);
                }
                if (kind != 3) {
                    float mx = -INFINITY;
                    if (kind == 0) {
                        const unsigned w0 = mw.x >> (4 * hi), w1 = mw.y >> (4 * hi);
#pragma unroll
                        for (int r = 0; r < 16; ++r) { const int off = (r & 3) + 8 * (r >> 2);
                            p0[r] = (w0 & (1u << off)) ? p0[r] : -INFINITY; p1[r] = (w1 & (1u << off)) ? p1[r] : -INFINITY; mx = vmax3(mx, p0[r], p1[r]); }
                    } else if (kind == 1) {
                        const int rel = qpos - kbase;
#pragma unroll
                        for (int r = 0; r < 16; ++r) { const int off = (r & 3) + 8 * (r >> 2);
                            p0[r] = ((unsigned)(rel - off) < 128u) ? p0[r] : -INFINITY; p1[r] = ((unsigned)(rel - off - 32) < 128u) ? p1[r] : -INFINITY; mx = vmax3(mx, p0[r], p1[r]); }
                    } else {
                        if ((kt >> 2) == uy) {
                            const int rel = qpos - kbase;
#pragma unroll
                            for (int r = 0; r < 16; ++r) { const int off = (r & 3) + 8 * (r >> 2);
                                p0[r] = (off <= rel) ? p0[r] : -INFINITY; p1[r] = (off + 32 <= rel) ? p1[r] : -INFINITY; mx = vmax3(mx, p0[r], p1[r]); }
                        } else {
                            const bool tile_ok = ((bm >> (kt >> 2)) & 1u) != 0u;
#pragma unroll
                            for (int r = 0; r < 16; ++r) { p0[r] = tile_ok ? p0[r] : -INFINITY; p1[r] = tile_ok ? p1[r] : -INFINITY; mx = vmax3(mx, p0[r], p1[r]); }
                        }
                    }
                    mx = vmax(mx, xlane32(mx));
                    const float m_new = vmax(m_run, mx);
                    const float m_safe = (m_new == -INFINITY) ? 0.f : m_new;
                    p0 = p0 - m_safe; p1 = p1 - m_safe;
#pragma unroll
                    for (int r = 0; r < 16; ++r) { p0[r] = __builtin_amdgcn_exp2f(p0[r]); p1[r] = __builtin_amdgcn_exp2f(p1[r]); }
                    float ls;
                    { typedef float f32x8_t __attribute__((ext_vector_type(8))); typedef float f32x4v_t __attribute__((ext_vector_type(4)));
                      const f32x16_t t16 = p0 + p1; const f32x8_t t8 = t16.lo + t16.hi; const f32x4v_t t4 = t8.lo + t8.hi; const f32x2_t t2 = t4.lo + t4.hi; ls = t2.x + t2.y; }
                    if (__any(m_new > m_run)) {
                        const float alpha = __builtin_amdgcn_exp2f(m_run - m_safe);
                        l_run *= alpha;
                        o0 = o0 * alpha; o1 = o1 * alpha;
                    }
                    l_run += ls; m_run = m_new;
                } else {
                    float run = carry;
#define SB_HALF(PX, KOFF) do { \
                    float lk[16]; \
                    _Pragma("unroll") for (int r = 0; r < 16; ++r) { \
                        const int off = (r & 3) + 8 * (r >> 2); \
                        const bool v = (kbase + off + (KOFF)) < qpos; \
                        const float z = PX[r]; \
                        const float t = 0.6931471805599453f * __builtin_amdgcn_logf(1.0f + __builtin_amdgcn_exp2f(-LOG2E * fabsf(z))); \
                        lk[r] = v ? (fminf(-z, 0.f) - t) : 0.f; \
                        PX[r] = v ? (fminf(z, 0.f) - t) : -INFINITY; } \
                    _Pragma("unroll") for (int g = 3; g >= 0; --g) { \
                        const float G = (lk[4 * g] + lk[4 * g + 1]) + (lk[4 * g + 2] + lk[4 * g + 3]); \
                        const float PG = xlane32(G); \
                        float la = run + (hi ? 0.f : PG); \
                        run += G + PG; \
                        PX[4 * g + 3] += la; la += lk[4 * g + 3]; PX[4 * g + 2] += la; la += lk[4 * g + 2]; PX[4 * g + 1] += la; la += lk[4 * g + 1]; PX[4 * g] += la; } \
                    _Pragma("unroll") for (int r = 0; r < 16; ++r) PX[r] = __builtin_amdgcn_exp2f(LOG2E * PX[r]); } while (0)
                    SB_HALF(p1, 32);
                    SB_HALF(p0, 0);
#undef SB_HALF
                    carry = run;
                }
                unsigned pw[16];
#pragma unroll
                for (int j = 0; j < 8; ++j) { pw[j] = cvtpk(p0[2 * j], p0[2 * j + 1]); pw[8 + j] = cvtpk(p1[2 * j], p1[2 * j + 1]); }
#pragma unroll
                for (int s = 0; s < 4; ++s) {
                    bf16x8_t pb; { const unsigned* q = pw + 4 * s; typedef unsigned u32x4_t __attribute__((ext_vector_type(4))); u32x4_t t4 = {q[0], q[1], q[2], q[3]}; pb = __builtin_bit_cast(bf16x8_t, t4); }
#pragma unroll
                    for (int dt = 0; dt < 2; ++dt) {
                        typedef short s16x4_t __attribute__((ext_vector_type(4)));
                        typedef __attribute__((address_space(3))) s16x4_t lds_s16x4;
                        const int gi_ = lane & 15;
                        const bf16* vp = vt_ + (16 * s + 4 * hi + (gi_ >> 2)) * AT_VP + 32 * dt + 16 * ((lane >> 4) & 1) + 4 * (gi_ & 3);
                        const s16x4_t lo = __builtin_amdgcn_ds_read_tr16_b64_v4i16((lds_s16x4*)vp), hi4 = __builtin_amdgcn_ds_read_tr16_b64_v4i16((lds_s16x4*)(vp + 8 * AT_VP));
                        const bf16x8_t va = {lo[0], lo[1], lo[2], lo[3], hi4[0], hi4[1], hi4[2], hi4[3]};
                        if (dt == 0) o0 = __builtin_amdgcn_mfma_f32_32x32x16_bf16(va, pb, o0, 0, 0, 0);
                        else         o1 = __builtin_amdgcn_mfma_f32_32x32x16_bf16(va, pb, o1, 0, 0, 0);
                    }
                }
            }
            if (kind == 3) {
                const float cm = carry;
                if (__all(cm < -110.0f) || !(kt * 64 <= q0w + 31) ) { if (__all(cm < -110.0f)) wave_done = true; }
            }
            if (more) {
                bf16* ksn = (bf16*)(lds + AT_KS + (buf ^ 1) * AT_KS_BYTES); bf16* vtn = (bf16*)(lds + AT_VT + (buf ^ 1) * AT_VT_BYTES);
                *(uint4*)(ksn + skey * AT_KP + sc * 8) = rk;
                *(uint4*)(vtn + skey * AT_VP + sc * 8) = rv;
            }
            if (kind == 3) { if (__syncthreads_and(wave_done ? 1 : 0)) break; }
            else __syncthreads();
            buf ^= 1;
        }
        float inv;
        if (kind == 3) inv = 1.0f;
        else {
            float lt = l_run + xlane32(l_run);
            if (kind == 1) { const float mf = fmaxf(m_run, sink2); const float sc2 = exp2f(m_run - mf); lt = lt * sc2 + exp2f(sink2 - mf); inv = sc2 / lt; }
            else inv = 1.0f / lt;
        }
        bf16* yp = ys + (size_t)(b * S_ + qpos) * 1024 + ycol + 4 * hi;
#pragma unroll
        for (int g = 0; g < 4; ++g) {
            *(uint2*)(yp + 8 * g) = make_uint2(cvtpk(o0[4 * g] * inv, o0[4 * g + 1] * inv), cvtpk(o0[4 * g + 2] * inv, o0[4 * g + 3] * inv));
            *(uint2*)(yp + 32 + 8 * g) = make_uint2(cvtpk(o1[4 * g] * inv, o1[4 * g + 1] * inv), cvtpk(o1[4 * g + 2] * inv, o1[4 * g + 3] * inv));
        }
    }
}
__device__ void attn_fast_phase(int WV_, const bf16* P, const unsigned char* mask, const float* kmean, const float* sinks, bf16* ys,
                                const unsigned* utab, unsigned* counter, unsigned char* lds) {
    volatile unsigned* s_unit = (volatile unsigned*)(lds + AT_MISC);
    for (;;) {
        __syncthreads();
        if (LTID(WV_) == 0) s_unit[0] = atomicAdd(counter, 1u);
        __syncthreads();
        const unsigned ui = s_unit[0];
        if (ui >= 512u) break;
        const unsigned ue = utab[ui];
        const int kind = (int)(ue >> 30), b = (int)((ue >> 28) & 3u), ux = (int)((ue >> 8) & 255u), uy = (int)(ue & 255u);
        if (kind == 0) attn_unit<0>(WV_, P, mask, kmean, sinks, ys, lds, b, ux, uy);
        else attn_unit<2>(WV_, P, mask, kmean, sinks, ys, lds, b, ux, uy);
    }
    for (int u = LBID(); u < 256; u += LGRID()) { __syncthreads(); attn_unit<3>(WV_, P, mask, kmean, sinks, ys, lds, u >> 6, (u >> 4) & 3, u & 15); }
    for (int u = LBID(); u < 256; u += LGRID()) { __syncthreads(); attn_unit<1>(WV_, P, mask, kmean, sinks, ys, lds, u >> 6, (u >> 5) & 1, u & 31); }
}

constexpr float U_SCALE = 128.0f, V_SCALE = 48.0f;
constexpr int ROW6 = 1536;
typedef float v32f_t __attribute__((ext_vector_type(32)));
typedef unsigned v6u_t __attribute__((ext_vector_type(6)));
typedef unsigned u32x4a8_t __attribute__((ext_vector_type(4), aligned(8)));
__device__ __forceinline__ float rdlane_f(float v, int l) { return __builtin_bit_cast(float, __builtin_amdgcn_readlane(__builtin_bit_cast(int, v), l)); }
__device__ __forceinline__ unsigned q_e2m3(float v) {
    const float a = fminf(fabsf(v), 7.5f);
    unsigned code;
    if (a < 1.0f) code = (unsigned)rintf(a * 8.0f);
    else if (a < 2.0f) code = 8u + (unsigned)rintf((a - 1.0f) * 8.0f);
    else if (a < 4.0f) code = 16u + (unsigned)rintf((a - 2.0f) * 4.0f);
    else code = 24u + (unsigned)rintf((a - 4.0f) * 2.0f);
    return code | (v < 0.f ? 32u : 0u);
}
__device__ void convert_tables(int WV_, const Params& p) {
    const size_t nchunk = (size_t)DEPTH_ * 16384 * 2 * 32;
    for (size_t i = (size_t)LBID() * NTHR + LTID(WV_); i < nchunk; i += (size_t)LGRID() * NTHR) {
        const int c = (int)(i & 31), uvsel = (int)((i >> 5) & 1); const size_t le = i >> 6;
        const float* src = (uvsel ? p.in[10] : p.in[9]) + le * 1024 + c * 32;
        const float sc = uvsel ? V_SCALE : U_SCALE;
        unsigned w[6] = {0u, 0u, 0u, 0u, 0u, 0u};
#pragma unroll
        for (int q4 = 0; q4 < 8; ++q4) {
            const float4 a = ((const float4*)src)[q4];
            const float av[4] = {a.x, a.y, a.z, a.w};
#pragma unroll
            for (int e = 0; e < 4; ++e) { const int idx = q4 * 4 + e, bit = 6 * idx, d = bit >> 5, s = bit & 31; const unsigned code = q_e2m3(av[e] * sc);
                w[d] |= code << s; if (s > 26) w[d + 1] |= code >> (32 - s); }
        }
        uint2* dst = (uint2*)(p.ws + WS_UV + le * ROW6 + uvsel * 768 + c * 24);
        dst[0] = make_uint2(w[0], w[1]); dst[1] = make_uint2(w[2], w[3]); dst[2] = make_uint2(w[4], w[5]);
    }
}
__device__ __forceinline__ v6u_t ld_pk6(const unsigned char* ptr) {
    const uint2 a = ((const uint2*)ptr)[0], b = ((const uint2*)ptr)[1], c = ((const uint2*)ptr)[2];
    const v6u_t pk = {a.x, a.y, b.x, b.y, c.x, c.y};
    return pk;
}
__device__ void peer_fast_phase(int WV_, float* h, bf16* hb, const int* eid, const float* gate, const unsigned char* uv, const float* g1, const float* b1, const float* g, const float* bb, unsigned char* lds) {
    const int tid = LTID(WV_), lane = tid & 63, wave = tid >> 6, l32 = lane & 31, hi = lane >> 5;
    float* pl = (float*)(lds + wave * 16384);
    unsigned char* raw = lds + wave * 16384 + 4096 + lane * 24;
    for (int t = LBID() * NWAVE + wave; t < T_; t += LGRID() * NWAVE) {
        float* hr = h + (size_t)t * 1024 + l32 * 32;
        float x[32], acc[32];
#pragma unroll
        for (int q4 = 0; q4 < 8; ++q4) { const float4 a = ((const float4*)hr)[q4]; x[4 * q4] = a.x; x[4 * q4 + 1] = a.y; x[4 * q4 + 2] = a.z; x[4 * q4 + 3] = a.w; }
        {
            float s = 0.f;
#pragma unroll
            for (int i = 0; i < 32; ++i) s += x[i];
#pragma unroll
            for (int o = 16; o > 0; o >>= 1) s += __shfl_xor(s, o);
            const float mean = s * (1.0f / 1024.0f);
            float s2 = 0.f;
#pragma unroll
            for (int i = 0; i < 32; ++i) { x[i] -= mean; s2 += x[i] * x[i]; }
#pragma unroll
            for (int o = 16; o > 0; o >>= 1) s2 += __shfl_xor(s2, o);
            const float rstd = 1.0f / sqrtf(s2 * (1.0f / 1024.0f) + LN_EPS);
#pragma unroll
            for (int q4 = 0; q4 < 8; ++q4) { const float4 gg = ((const float4*)(g1 + l32 * 32))[q4], cc = ((const float4*)(b1 + l32 * 32))[q4];
                x[4 * q4] = x[4 * q4] * rstd * gg.x + cc.x; x[4 * q4 + 1] = x[4 * q4 + 1] * rstd * gg.y + cc.y; x[4 * q4 + 2] = x[4 * q4 + 2] * rstd * gg.z + cc.z; x[4 * q4 + 3] = x[4 * q4 + 3] * rstd * gg.w + cc.w; }
        }
#pragma unroll
        for (int i = 0; i < 32; ++i) acc[i] = 0.f;
#pragma unroll 1
        for (int batch = 0; batch < 4; ++batch) {
            const int my_eid = eid[(size_t)t * 128 + batch * 32 + l32];
            const float my_gate = gate[(size_t)t * 128 + batch * 32 + l32];
#pragma unroll 1
            for (int grp = 0; grp < 2; ++grp) {
                { u32x4a8_t pa[8]; uint2 pc[8];
#pragma unroll
                  for (int i = 0; i < 8; ++i) { const int id = __shfl(my_eid, 2 * (grp * 8 + i) + hi); const unsigned char* rp = uv + (size_t)id * ROW6 + l32 * 24; pa[i] = *(const u32x4a8_t*)rp; pc[i] = *(const uint2*)(rp + 16); }
#pragma unroll
                  for (int i = 0; i < 8; ++i) { uint2* wp = (uint2*)(raw + i * 1536); wp[0] = make_uint2(pa[i].x, pa[i].y); wp[1] = make_uint2(pa[i].z, pa[i].w); wp[2] = pc[i]; } }
#pragma unroll 1
                for (int i = 0; i < 8; ++i) {
                    const uint2* rp = (const uint2*)(raw + i * 1536); const uint2 a = rp[0], b = rp[1], c = rp[2];
                    const v6u_t pk6 = {a.x, a.y, b.x, b.y, c.x, c.y}; const v32f_t f = __builtin_amdgcn_cvt_scalef32_pk32_f32_fp6(pk6, 1.0f);
                    f32x2_t dv0 = {0.f, 0.f}, dv1 = {0.f, 0.f};
#pragma unroll
                    for (int j = 0; j < 8; ++j) { const f32x2_t fa = {f[2 * j], f[2 * j + 1]}, fb = {f[16 + 2 * j], f[17 + 2 * j]}, xa = {x[2 * j], x[2 * j + 1]}, xb = {x[16 + 2 * j], x[17 + 2 * j]};
                        dv0 = fa * xa + dv0; dv1 = fb * xb + dv1; }
                    pl[(2 * (grp * 8 + i) + hi) * 32 + l32] = (dv0.x + dv0.y) + (dv1.x + dv1.y);
                }
            }
            float d;
            { const float4* pr = (const float4*)(pl + l32 * 32); float4 s4 = pr[0];
#pragma unroll
              for (int i = 1; i < 8; ++i) { const float4 v = pr[i]; s4.x += v.x; s4.y += v.y; s4.z += v.z; s4.w += v.w; }
              d = ((s4.x + s4.y) + (s4.z + s4.w)) * (1.0f / U_SCALE); }
            const float hv = 0.5f * d * (1.0f + erff(d * 0.70710678118654752f)) * my_gate * (1.0f / V_SCALE);
#pragma unroll 1
            for (int grp = 0; grp < 2; ++grp) {
                { u32x4a8_t pa[8]; uint2 pc[8];
#pragma unroll
                  for (int i = 0; i < 8; ++i) { const int id = __shfl(my_eid, 2 * (grp * 8 + i) + hi); const unsigned char* rp = uv + (size_t)id * ROW6 + 768 + l32 * 24; pa[i] = *(const u32x4a8_t*)rp; pc[i] = *(const uint2*)(rp + 16); }
#pragma unroll
                  for (int i = 0; i < 8; ++i) { uint2* wp = (uint2*)(raw + i * 1536); wp[0] = make_uint2(pa[i].x, pa[i].y); wp[1] = make_uint2(pa[i].z, pa[i].w); wp[2] = pc[i]; } }
#pragma unroll 1
                for (int i = 0; i < 8; ++i) {
                    const float c = __shfl(hv, 2 * (grp * 8 + i) + hi);
                    const uint2* rp = (const uint2*)(raw + i * 1536); const uint2 a = rp[0], b = rp[1], cc = rp[2];
                    const v6u_t pk6 = {a.x, a.y, b.x, b.y, cc.x, cc.y}; const v32f_t f = __builtin_amdgcn_cvt_scalef32_pk32_f32_fp6(pk6, 1.0f);
                    const f32x2_t c2 = {c, c};
#pragma unroll
                    for (int j = 0; j < 16; ++j) { const f32x2_t fj = {f[2 * j], f[2 * j + 1]}; f32x2_t aj = {acc[2 * j], acc[2 * j + 1]}; aj = fj * c2 + aj; acc[2 * j] = aj.x; acc[2 * j + 1] = aj.y; }
                }
            }
        }
        float y[32], s = 0.f;
#pragma unroll
        for (int i = 0; i < 32; ++i) { acc[i] += __shfl_xor(acc[i], 32); y[i] = ALPHA * x[i] + acc[i]; s += y[i]; }
#pragma unroll
        for (int o = 16; o > 0; o >>= 1) s += __shfl_xor(s, o);
        const float mean = s * (1.0f / 1024.0f);
        float s2 = 0.f;
#pragma unroll
        for (int i = 0; i < 32; ++i) { y[i] -= mean; s2 += y[i] * y[i]; }
#pragma unroll
        for (int o = 16; o > 0; o >>= 1) s2 += __shfl_xor(s2, o);
        const float rstd = 1.0f / sqrtf(s2 * (1.0f / 1024.0f) + LN_EPS);
        float o[16];
#pragma unroll
        for (int q4 = 0; q4 < 4; ++q4) {
            const float4 gg = ((const float4*)(g + l32 * 32 + hi * 16))[q4], cc = ((const float4*)(bb + l32 * 32 + hi * 16))[q4];
            float ya[4], yb2[4];
#pragma unroll
            for (int e = 0; e < 4; ++e) { ya[e] = y[4 * q4 + e]; yb2[e] = y[16 + 4 * q4 + e]; }
            asm volatile("" : "+v"(ya[0]), "+v"(ya[1]), "+v"(ya[2]), "+v"(ya[3]), "+v"(yb2[0]), "+v"(yb2[1]), "+v"(yb2[2]), "+v"(yb2[3]));
            const float y0 = hi ? yb2[0] : ya[0], y1 = hi ? yb2[1] : ya[1], y2 = hi ? yb2[2] : ya[2], y3 = hi ? yb2[3] : ya[3];
            o[4 * q4] = y0 * rstd * gg.x + cc.x; o[4 * q4 + 1] = y1 * rstd * gg.y + cc.y; o[4 * q4 + 2] = y2 * rstd * gg.z + cc.z; o[4 * q4 + 3] = y3 * rstd * gg.w + cc.w;
            ((float4*)(hr + hi * 16))[q4] = make_float4(o[4 * q4], o[4 * q4 + 1], o[4 * q4 + 2], o[4 * q4 + 3]);
        }
        uint4* hbp = (uint4*)(hb + (size_t)t * 1024 + l32 * 32 + hi * 16);
        hbp[0] = make_uint4(pk2(o[0], o[1]), pk2(o[2], o[3]), pk2(o[4], o[5]), pk2(o[6], o[7]));
        hbp[1] = make_uint4(pk2(o[8], o[9]), pk2(o[10], o[11]), pk2(o[12], o[13]), pk2(o[14], o[15]));
    }
}

__device__ __forceinline__ float pack_pl(float v, unsigned pl) { return __uint_as_float((__float_as_uint(v) & ~127u) | pl); }
__device__ __forceinline__ void ins16(float (&s)[16], float x) {
#pragma unroll
    for (int k = 15; k >= 1; --k) s[k] = __builtin_amdgcn_fmed3f(s[k - 1], x, s[k]);
    s[0] = vmax(s[0], x);
}
template <int D> __device__ __forceinline__ void bitonic_stage(float (&c)[16]) {
#pragma unroll
    for (int i = 0; i < 16; ++i) if ((i & D) == 0) { const float a = vmax(c[i], c[i + D]), b = vmin(c[i], c[i + D]); c[i] = a; c[i + D] = b; }
}
__device__ __forceinline__ int decode_key(unsigned pl) { return (int)(32u * ((pl >> 4) & 3u) + (pl & 3u) + 8u * ((pl >> 2) & 3u) + 4u * ((pl >> 6) & 1u)); }
__device__ void route_fast_phase(int WV_, const bf16* qb, const bf16* skb  , int* eid, float* gate, unsigned char* lds, int pm = -1, int pn = 0) {
    const int tid = LTID(WV_), lane = tid & 63, wave = tid >> 6, r32 = lane & 31, hi = lane >> 5;
    unsigned* lidx = (unsigned*)lds + wave * (64 * 33) + lane * 33;
    const int u_first = (pm >= 0) ? 0 : LBID() * NWAVE + wave, u_end = (pm >= 0) ? 2 : (T_ / 32) * 8, u_step = (pm >= 0) ? 1 : LGRID() * NWAVE;
    for (int unit = u_first; unit < u_end; unit += u_step) {
        const int h = (pm >= 0) ? 2 * pn + unit : (unit & 7), t = ((pm >= 0) ? 8 * pm + wave : (unit >> 3)) * 32 + r32;
        float sl[2][16];
#pragma unroll
        for (int p = 0; p < 2; ++p) {
            bf16x8_t qf[4];
            { const bf16* qp = qb + (size_t)t * 1024 + h * 128 + p * 64 + 8 * hi;
#pragma unroll
              for (int ks = 0; ks < 4; ++ks) qf[ks] = *(const bf16x8_t*)(qp + 16 * ks); }
            float s[16];
#pragma unroll
            for (int k = 0; k < 16; ++k) s[k] = -INFINITY;
            const bf16* skp = skb + ((size_t)(h * 2 + p) * 128 + r32) * 64 + 8 * hi;
#pragma unroll
            for (int kt = 0; kt < 4; ++kt) {
                f32x16_t acc;
#pragma unroll
                for (int r = 0; r < 16; ++r) acc[r] = 0.f;
#pragma unroll
                for (int ks = 0; ks < 4; ++ks) { const bf16x8_t a = *(const bf16x8_t*)(skp + (size_t)kt * 32 * 64 + 16 * ks); acc = __builtin_amdgcn_mfma_f32_32x32x16_bf16(a, qf[ks], acc, 0, 0, 0); }
#pragma unroll
                for (int r = 0; r < 16; ++r) ins16(s, pack_pl(acc[r], (unsigned)(kt * 16 + r)));
            }
            const unsigned hb = (unsigned)hi << 6;
#pragma unroll
            for (int k = 0; k < 16; ++k) s[k] = __uint_as_float(__float_as_uint(s[k]) | hb);
            float c[16];
#pragma unroll
            for (int k = 0; k < 16; ++k) c[k] = vmax(s[k], __shfl_xor(s[15 - k], 32));
            bitonic_stage<8>(c); bitonic_stage<4>(c); bitonic_stage<2>(c); bitonic_stage<1>(c);
#pragma unroll
            for (int k = 0; k < 16; ++k) { sl[p][k] = c[k]; lidx[p * 16 + k] = (unsigned)decode_key(__float_as_uint(c[k]) & 127u); }
        }
        float w[16];
#pragma unroll
        for (int k = 0; k < 16; ++k) w[k] = -INFINITY;
#pragma unroll
        for (int i = 0; i < 16; ++i)
#pragma unroll
            for (int j = 0; j < 16; ++j)
                if ((i + 1) * (j + 1) <= 16) { const float v = sl[0][i] + sl[1][j]; ins16(w, __uint_as_float((__float_as_uint(v) & ~255u) | (unsigned)(i * 16 + j))); }
        float e[16], sum = 0.f;
#pragma unroll
        for (int k = 0; k < 16; ++k) { e[k] = expf(w[k] - w[0]); sum += e[k]; }
        const float inv = 1.0f / sum;
        int ide[8]; float gte[8];
#pragma unroll
        for (int k = 0; k < 8; ++k) {
            float wa = w[k], wb = w[8 + k], ea = e[k], eb = e[8 + k];
            asm volatile("" : "+v"(wa), "+v"(wb), "+v"(ea), "+v"(eb));
            const float wv = hi ? wb : wa;
            const unsigned pl = __float_as_uint(wv) & 255u;
            ide[k] = (int)(lidx[pl >> 4] * 128u + lidx[16 + (pl & 15u)]);
            gte[k] = (hi ? eb : ea) * inv;
        }
        int* ep = eid + (size_t)t * 128 + h * 16 + hi * 8; float* gp = gate + (size_t)t * 128 + h * 16 + hi * 8;
        *(int4*)ep = make_int4(ide[0], ide[1], ide[2], ide[3]); *(int4*)(ep + 4) = make_int4(ide[4], ide[5], ide[6], ide[7]);
        *(float4*)gp = make_float4(gte[0], gte[1], gte[2], gte[3]); *(float4*)(gp + 4) = make_float4(gte[4], gte[5], gte[6], gte[7]);
    }
}

typedef float f32x4_t __attribute__((ext_vector_type(4)));
typedef __bf16 bf16x2v __attribute__((ext_vector_type(2)));
__device__ __forceinline__ float dot2bf(unsigned a, unsigned b, float c) { return __builtin_amdgcn_fdot2_f32_bf16(__builtin_bit_cast(bf16x2v, a), __builtin_bit_cast(bf16x2v, b), c, false); }
__device__ __forceinline__ void cnt_gt(int& cnt, unsigned a, unsigned b) { asm("v_cmp_gt_u32_e32 vcc, %1, %2\n\tv_addc_co_u32_e32 %0, vcc, 0, %0, vcc" : "+v"(cnt) : "v"(a), "v"(b) : "vcc"); }
__device__ __forceinline__ void cnt_eq(int& cnt, unsigned a, unsigned b) { asm("v_cmp_eq_u32_e32 vcc, %1, %2\n\tv_addc_co_u32_e32 %0, vcc, 0, %0, vcc" : "+v"(cnt) : "v"(a), "v"(b) : "vcc"); }
__device__ __forceinline__ unsigned flag_gt(unsigned a, unsigned b) { unsigned r; asm("v_cmp_gt_u32_e32 vcc, %1, %2\n\tv_cndmask_b32_e64 %0, 0, 1, vcc" : "=v"(r) : "v"(a), "v"(b) : "vcc"); return r; }
__device__ __forceinline__ unsigned flag_eq(unsigned a, unsigned b) { unsigned r; asm("v_cmp_eq_u32_e32 vcc, %1, %2\n\tv_cndmask_b32_e64 %0, 0, 1, vcc" : "=v"(r) : "v"(a), "v"(b) : "vcc"); return r; }
__device__ __forceinline__ void cnt_ge(int& cnt, unsigned key, unsigned cand) { asm("v_cmp_ge_u32_e32 vcc, %1, %2\n\tv_addc_co_u32_e32 %0, vcc, 0, %0, vcc" : "+v"(cnt) : "v"(key), "v"(cand) : "vcc"); }

typedef __attribute__((address_space(3))) unsigned lds_u32;
template <int SHIFT> __device__ __forceinline__ unsigned radix_pass(const unsigned (&key)[64], unsigned pre, lds_u32* hist, int lane, int& need, int jlim, unsigned L) {
    typedef unsigned u32x4v __attribute__((ext_vector_type(4)));
    typedef __attribute__((address_space(3))) u32x4v lds_u32x4;
    { const u32x4v z4 = {0u, 0u, 0u, 0u};
#pragma unroll
      for (int i = 0; i < 8; ++i) ((lds_u32x4*)(hist + lane * 32))[i] = z4; }
    const unsigned hb = (unsigned)(size_t)hist + 4u * (unsigned)(lane & 7);
    const unsigned one = 1u;
    asm volatile("" ::: "memory");
#pragma unroll
    for (int j4 = 0; j4 < 16; ++j4) {
        if (4 * j4 <= jlim) {
            bool grp = true;
            if (SHIFT <= 8) {
                const bool any = ((key[4 * j4] >> (SHIFT + 8)) == pre) | ((key[4 * j4 + 1] >> (SHIFT + 8)) == pre) | ((key[4 * j4 + 2] >> (SHIFT + 8)) == pre) | ((key[4 * j4 + 3] >> (SHIFT + 8)) == pre);
                grp = __ballot(any) != 0ull;
            }
            if (grp) {
#pragma unroll
                for (int e = 0; e < 4; ++e) { const int j = 4 * j4 + e;
                    const unsigned addr = hb + (((key[j] >> SHIFT) & 255u) << 5);
                    unsigned long long sv;
                    if (SHIFT == 24) asm volatile("v_cmp_ge_u32_e32 vcc, %1, %2\n\ts_and_saveexec_b64 %0, vcc\n\tds_add_u32 %3, %4\n\ts_mov_b64 exec, %0" : "=&s"(sv) : "v"(key[j]), "v"(L), "v"(addr), "v"(one) : "vcc", "memory");
                    else { const unsigned t = key[j] >> ((SHIFT + 8) & 31);
                        asm volatile("v_cmp_eq_u32_e32 vcc, %1, %2\n\ts_and_saveexec_b64 %0, vcc\n\tds_add_u32 %3, %4\n\ts_mov_b64 exec, %0" : "=&s"(sv) : "v"(t), "v"(pre), "v"(addr), "v"(one) : "vcc", "memory"); }
                }
            }
        }
    }
    asm volatile("s_waitcnt lgkmcnt(0)" ::: "memory");
    unsigned dsum[4]; unsigned sumL = 0u;
#pragma unroll
    for (int i = 0; i < 4; ++i) { const u32x4v v0 = ((const lds_u32x4*)(hist + lane * 32))[2 * i], v1 = ((const lds_u32x4*)(hist + lane * 32))[2 * i + 1];
        dsum[i] = ((v0.x + v0.y) + (v0.z + v0.w)) + ((v1.x + v1.y) + (v1.z + v1.w)); sumL += dsum[i]; }
    unsigned incl = sumL;
#pragma unroll
    for (int o = 1; o < 64; o <<= 1) { const unsigned t = (unsigned)__shfl_down((int)incl, o); if (lane + o < 64) incl += t; }
    const unsigned above = incl - sumL;
    const bool own = (above < (unsigned)need) && ((unsigned)need <= above + sumL);
    const int owner = __ffsll((long long)__ballot(own)) - 1;
    unsigned acc = above; int sel = -1; unsigned cab = 0u;
#pragma unroll
    for (int i = 3; i >= 0; --i) { const unsigned c = dsum[i]; const bool hit = (sel < 0) && (acc + c >= (unsigned)need); cab = hit ? acc : cab; sel = hit ? i : sel; acc += c; }
    const int ow = owner < 0 ? 0 : owner;
    const unsigned digit = (unsigned)__builtin_amdgcn_readlane(sel, ow) + (unsigned)(4 * ow);
    need -= (int)__builtin_amdgcn_readlane((int)cab, ow);
    return digit;
}
#ifndef TS_SEL
#define TS_SEL 0
#endif
#define ITS_B() do { if (TS_SEL >= 20 && TS_SEL <= 25 && WV_ == 0 && LANEID() == 0) ((volatile __attribute__((address_space(3))) unsigned long long*)((__attribute__((address_space(3))) unsigned char*)lds + 147456 - 16 - 32))[0] = __builtin_amdgcn_s_memrealtime(); } while (0)
#define ITS_E(k) do { if ((k) == TS_SEL && WV_ == 0 && LANEID() == 0) { volatile __attribute__((address_space(3))) unsigned long long* w_ = (volatile __attribute__((address_space(3))) unsigned long long*)((__attribute__((address_space(3))) unsigned char*)lds + 147456 - 16 - 32); w_[1] += __builtin_amdgcn_s_memrealtime() - w_[0]; } } while (0)
__device__ void index_fast_phase(int WV_, const bf16* P, unsigned char* mask, float* kmean, float* scratch_all, unsigned* qctr, unsigned char* lds) {
    const int tid = LTID(WV_), lane = tid & 63, wave = tid >> 6, bid = LBID(), G = LGRID();
    float* s_part = (float*)lds;
    ITS_B();
    for (int k = bid; k < 256; k += G) {
        const int b = k >> 6, h = (k >> 4) & 3, blk = k & 15;
        const bf16* kp = P + (size_t)(b * S_ + blk * 256 + wave * 32) * NP + C_KC + h * 64 + lane;
        float a = 0.f;
#pragma unroll 8
        for (int j = 0; j < 32; ++j) a += bf2f(kp[(size_t)j * NP]);
        __syncthreads();
        s_part[wave * 64 + lane] = a;
        __syncthreads();
        if (tid < 64) { float s = 0.f;
#pragma unroll
            for (int w = 0; w < 8; ++w) s += s_part[w * 64 + tid];
            kmean[((b * 4 + h) * 16 + blk) * 64 + tid] = s * (1.0f / 256.0f); }
    }
    ITS_E(22);
    float* scr = scratch_all + (size_t)bid * (16 * 4096);
    const int lq = lane & 15, g4 = lane >> 4;
    for (int ui = bid; ui < 1024; ui += G) {
        const int b = ui >> 8, k = ui & 255, tile = (b & 1) ? 255 - k : k, q0 = tile * 16;
        const bf16* Pb = P + (size_t)b * S_ * NP;
        const int ntiles = tile + 1;
        ITS_B();
        bf16x8_t qf[8]; float wi[8];
        { const bf16* qp = Pb + (size_t)(q0 + lq) * NP + C_QI + 8 * g4;
#pragma unroll
          for (int h = 0; h < 8; ++h) qf[h] = *(const bf16x8_t*)(qp + 32 * h);
          const uint4 wv = *(const uint4*)(Pb + (size_t)(q0 + lq) * NP + C_WI); unpack8(wv, wi); }
        {
            bf16x8_t afn = *(const bf16x8_t*)(Pb + (size_t)((wave < ntiles ? wave : 0) * 16 + lq) * NP + C_KI + 8 * g4);
            for (int kt = wave; kt < ntiles; kt += NWAVE) {
                const bf16x8_t af = afn;
                { const int ktn = (kt + NWAVE < ntiles) ? kt + NWAVE : kt; afn = *(const bf16x8_t*)(Pb + (size_t)(ktn * 16 + lq) * NP + C_KI + 8 * g4); }
                f32x4_t a[8];
                const f32x4_t z = {0.f, 0.f, 0.f, 0.f};
#pragma unroll
                for (int h = 0; h < 8; ++h) a[h] = __builtin_amdgcn_mfma_f32_16x16x32_bf16(af, qf[h], z, 0, 0, 0);
                __builtin_amdgcn_sched_barrier(0);
                f32x4_t sc = {0.f, 0.f, 0.f, 0.f};
#pragma unroll
                for (int h = 0; h < 8; ++h)
#pragma unroll
                    for (int r = 0; r < 4; ++r) { float rl; asm("v_max_f32_e32 %0, 0, %1" : "=v"(rl) : "v"(a[h][r])); sc[r] += rl * wi[h]; }
#pragma unroll
                for (int r = 0; r < 4; ++r) { sc[r] *= 0.0625f; if (sc[r] == 0.f) sc[r] = 0.f; }
                *(f32x4_t*)(scr + (size_t)lq * 4096 + kt * 16 + 4 * g4) = sc;
            }
        }
        __threadfence_block();
        __syncthreads();
        __threadfence_block();
        ITS_E(20); ITS_B();
        lds_u32* hist = (lds_u32*)((__attribute__((address_space(3))) unsigned char*)lds + 2048) + wave * 2048;
#pragma unroll 1
        for (int qi = 0; qi < 2; ++qi) {
            const int ql = 2 * wave + qi, q = q0 + ql;
            const float* row = scr + (size_t)ql * 4096 + lane;
            const int qrel = q - lane * 64;
            const int jlim = __builtin_amdgcn_readfirstlane(q >> 6);
            const int jmax = (q - lane) >> 6;
            unsigned wlo = 0u, whi = 0u;
            if (q + 1 > 256) {
                unsigned key[64];
#pragma unroll
                for (int j4 = 0; j4 < 16; ++j4) {
                    if (4 * j4 <= jlim) {
#pragma unroll
                        for (int e = 0; e < 4; ++e) key[4 * j4 + e] = __float_as_uint(row[64 * (4 * j4 + e)]);
                    } else {
#pragma unroll
                        for (int e = 0; e < 4; ++e) key[4 * j4 + e] = 0x7fffffffu;
                    }
                }
                unsigned t0 = 0u, t1 = 0u, t2 = 0u, t3 = 0u;
#pragma unroll
                for (int j4 = 0; j4 < 16; ++j4) {
                    if (4 * j4 <= jlim) {
#pragma unroll
                        for (int e = 0; e < 4; ++e) { const int j = 4 * j4 + e; const unsigned u = key[j];
                            const unsigned t = u ^ ((unsigned)((int)u >> 31) | 0x80000000u); const unsigned inval = (unsigned)((jmax - j) >> 31); const unsigned x = t & ~inval; key[j] = x;
                            unsigned n1, n2, n3;
                            asm("v_med3_u32 %0, %1, %2, %3" : "=v"(n3) : "v"(t2), "v"(t3), "v"(x));
                            asm("v_med3_u32 %0, %1, %2, %3" : "=v"(n2) : "v"(t1), "v"(t2), "v"(x));
                            asm("v_med3_u32 %0, %1, %2, %3" : "=v"(n1) : "v"(t0), "v"(t1), "v"(x));
                            t0 = t0 > x ? t0 : x; t1 = n1; t2 = n2; t3 = n3; }
                    } else {
#pragma unroll
                        for (int e = 0; e < 4; ++e) key[4 * j4 + e] = 0u;
                    }
                }
                unsigned L = t3;
#pragma unroll
                for (int o = 32; o > 0; o >>= 1) { const unsigned v = (unsigned)__shfl_xor((int)L, o); L = v < L ? v : L; }
                L = L > 1u ? L : 1u;
                ITS_E(23); ITS_B();
                int need = 256;
                const unsigned d1 = radix_pass<24>(key, 0u, hist, lane, need, jlim, L);
                const unsigned d2 = radix_pass<16>(key, d1, hist, lane, need, jlim, L);
                const unsigned d3 = radix_pass<8>(key, (d1 << 8) | d2, hist, lane, need, jlim, L);
                const unsigned d4 = radix_pass<0>(key, (d1 << 16) | (d2 << 8) | d3, hist, lane, need, jlim, L);
                const unsigned prefix = (d1 << 24) | (d2 << 16) | (d3 << 8) | d4;
                ITS_E(24); ITS_B();
                int ceq = 0;
#pragma unroll
                for (int j = 0; j < 64; ++j) cnt_eq(ceq, key[j], prefix);
                ceq = wave_sum_i(ceq);
                int X = 4096;
                if (ceq != need) {
                    int X0 = 0;
#pragma unroll 1
                    for (int bit = 11; bit >= 0; --bit) {
                        const int c = X0 | (1 << bit);
                        int cnt = 0; const int crel = (c - lane + 63) >> 6;
#pragma unroll
                        for (int j = 0; j < 64; ++j) cnt_eq(cnt, (key[j] ^ prefix) | ~(unsigned)((j - crel) >> 31), 0u);
                        cnt = wave_sum_i(cnt);
                        if (cnt < need) X0 = c;
                    }
                    X = X0 + 1;
                }
                const int xrel = (X - lane + 63) >> 6;
#pragma unroll
                for (int j4 = 0; j4 < 16; ++j4) {
                    if (4 * j4 <= jlim) {
#pragma unroll
                        for (int e = 0; e < 4; ++e) { const int j = 4 * j4 + e;
                            const bool sel = (key[j] > prefix) || (key[j] == prefix && j < xrel);
                            const unsigned long long bm = __ballot(sel);
                            asm("v_writelane_b32 %0, %1, %2" : "+v"(wlo) : "s"((unsigned)bm), "n"(j));
                            asm("v_writelane_b32 %0, %1, %2" : "+v"(whi) : "s"((unsigned)(bm >> 32)), "n"(j)); }
                    }
                }
            } else {
#pragma unroll
                for (int j = 0; j < 32; ++j) { wlo |= (~(unsigned)((qrel - j) >> 31) & 1u) << j; whi |= (~(unsigned)((qrel - 32 - j) >> 31) & 1u) << j; }
            }
            ((uint2*)(mask + (size_t)(b * S_ + q) * 512))[lane] = make_uint2(wlo, whi);
            ITS_E(25); ITS_B();
        }
        ITS_E(21);
        __syncthreads();
    }
}

constexpr int MG_P = 72;
constexpr int MG_TILE_BYTES = 128 * MG_P * 2;
__device__ void merge_fast_phase(int WV_, const bf16* P, const bf16* ys, const bf16* wbt  , bf16* merged, unsigned char* lds) {
    const int tid = LTID(WV_), lane = tid & 63, wave = tid >> 6, r32 = lane & 31, hi = lane >> 5, wt = wave & 3, wd = wave >> 2;
    const int srow0 = tid >> 3, sch = tid & 7;
    for (int tile = LBID(); tile < 1024; tile += LGRID()) {
        const int tok0 = (tile >> 3) * 128, d0 = (tile & 7) * 128;
        f32x16_t mer[2], acc[2];
#pragma unroll
        for (int r = 0; r < 16; ++r) { mer[0][r] = 0.f; mer[1][r] = 0.f; acc[0][r] = 0.f; acc[1][r] = 0.f; }
        uint4 RW00, RW01, RW10, RW11, RY00, RY01, RY10, RY11, RG0, RG1, RG2, RG3;
        bf16* gl = (bf16*)(lds + 4 * MG_TILE_BYTES);
        const int grow = tid >> 4, gch = tid & 15;
#define MG_GLOAD(st_, R_) do { const int n_ = (st_) >> 2, kc_ = (st_) & 3; \
            RW##R_##0 = *(const uint4*)(wbt + ((size_t)n_ * 1024 + d0 + srow0) * 256 + kc_ * 64 + sch * 8); \
            RW##R_##1 = *(const uint4*)(wbt + ((size_t)n_ * 1024 + d0 + srow0 + 64) * 256 + kc_ * 64 + sch * 8); \
            RY##R_##0 = *(const uint4*)(ys + (size_t)(tok0 + srow0) * 1024 + n_ * 256 + kc_ * 64 + sch * 8); \
            RY##R_##1 = *(const uint4*)(ys + (size_t)(tok0 + srow0 + 64) * 1024 + n_ * 256 + kc_ * 64 + sch * 8); } while (0)
#define MG_SSTORE(buf_, R_) do { bf16* wl_ = (bf16*)(lds + (buf_) * 2 * MG_TILE_BYTES); bf16* yl_ = (bf16*)(lds + (buf_) * 2 * MG_TILE_BYTES + MG_TILE_BYTES); \
            *(uint4*)(wl_ + srow0 * MG_P + sch * 8) = RW##R_##0; *(uint4*)(wl_ + (srow0 + 64) * MG_P + sch * 8) = RW##R_##1; \
            *(uint4*)(yl_ + srow0 * MG_P + sch * 8) = RY##R_##0; *(uint4*)(yl_ + (srow0 + 64) * MG_P + sch * 8) = RY##R_##1; } while (0)
        __syncthreads();
        MG_GLOAD(0, 0); MG_GLOAD(1, 1);
        MG_SSTORE(0, 0);
        __syncthreads();
#define MG_STAGE(PAR_, OTH_) do { const int buf = PAR_; \
            if (st + 2 < 16) MG_GLOAD(st + 2, PAR_); \
            if ((st & 3) == 1) { const bf16* gsrc = P + (size_t)(tok0 + grow) * NP + C_G + (st >> 2) * 1024 + d0 + gch * 8; \
                RG0 = *(const uint4*)gsrc; RG1 = *(const uint4*)(gsrc + (size_t)32 * NP); RG2 = *(const uint4*)(gsrc + (size_t)64 * NP); RG3 = *(const uint4*)(gsrc + (size_t)96 * NP); } \
            const bf16* wl = (const bf16*)(lds + buf * 2 * MG_TILE_BYTES); const bf16* yl = (const bf16*)(lds + buf * 2 * MG_TILE_BYTES + MG_TILE_BYTES); \
            _Pragma("unroll") for (int ks = 0; ks < 4; ++ks) { \
                const bf16x8_t bq = *(const bf16x8_t*)(yl + (32 * wt + r32) * MG_P + 16 * ks + 8 * hi); \
                const bf16x8_t a0 = *(const bf16x8_t*)(wl + (64 * wd + r32) * MG_P + 16 * ks + 8 * hi); \
                const bf16x8_t a1 = *(const bf16x8_t*)(wl + (64 * wd + 32 + r32) * MG_P + 16 * ks + 8 * hi); \
                acc[0] = __builtin_amdgcn_mfma_f32_32x32x16_bf16(a0, bq, acc[0], 0, 0, 0); \
                acc[1] = __builtin_amdgcn_mfma_f32_32x32x16_bf16(a1, bq, acc[1], 0, 0, 0); } \
            if ((st & 3) == 3) { \
                const int n = st >> 2; \
                const bf16* gp = gl + (32 * wt + r32) * 136 + 64 * wd + 4 * hi; (void)n; \
                _Pragma("unroll") for (int dt = 0; dt < 2; ++dt) \
                _Pragma("unroll") for (int g = 0; g < 4; ++g) { \
                        const uint2 gv = *(const uint2*)(gp + 32 * dt + 8 * g); \
                        const float g0 = __uint_as_float(gv.x << 16), g1 = __uint_as_float(gv.x & 0xffff0000u), g2 = __uint_as_float(gv.y << 16), g3 = __uint_as_float(gv.y & 0xffff0000u); \
                        mer[dt][4 * g + 0] += acc[dt][4 * g + 0] * g0; \
                        mer[dt][4 * g + 1] += acc[dt][4 * g + 1] * g1; \
                        mer[dt][4 * g + 2] += acc[dt][4 * g + 2] * g2; \
                        mer[dt][4 * g + 3] += acc[dt][4 * g + 3] * g3; } \
                _Pragma("unroll") for (int r = 0; r < 16; ++r) { acc[0][r] = 0.f; acc[1][r] = 0.f; } } \
            if (st + 1 < 16) MG_SSTORE(OTH_, OTH_); \
            if ((st & 3) == 2) { *(uint4*)(gl + grow * 136 + gch * 8) = RG0; *(uint4*)(gl + (grow + 32) * 136 + gch * 8) = RG1; *(uint4*)(gl + (grow + 64) * 136 + gch * 8) = RG2; *(uint4*)(gl + (grow + 96) * 136 + gch * 8) = RG3; } \
            __syncthreads(); } while (0)
#pragma unroll 1
        for (int st2 = 0; st2 < 16; st2 += 2) { { const int st = st2; MG_STAGE(0, 1); } { const int st = st2 + 1; MG_STAGE(1, 0); } }
#undef MG_STAGE
#undef MG_GLOAD
#undef MG_SSTORE
        bf16* mp = merged + (size_t)(tok0 + 32 * wt + r32) * 1024 + d0 + 64 * wd + 4 * hi;
#pragma unroll
        for (int dt = 0; dt < 2; ++dt)
#pragma unroll
            for (int g = 0; g < 4; ++g)
                *(uint2*)(mp + 32 * dt + 8 * g) = make_uint2(cvtpk(mer[dt][4 * g], mer[dt][4 * g + 1]), cvtpk(mer[dt][4 * g + 2], mer[dt][4 * g + 3]));
    }
}
#define LAS __attribute__((address_space(3)))
#define XB_TMO      128
#define XB_XCNT(j)  (256  + 64 * (j))
#define XB_XSUB(j)  (1280 + 64 * (j))
#define XB_XGEN(j)  (2304 + 64 * (j))
#define XB_TOP      3328
#define XB_TOPGEN   3392
#define XCD_BAR_WORDS 3456
#define XB_SPIN_CAP (1u << 18)

__device__ __forceinline__ unsigned xb_ld(unsigned* p)              { return __hip_atomic_load(p, __ATOMIC_RELAXED, __HIP_MEMORY_SCOPE_AGENT); }
__device__ __forceinline__ unsigned xb_add(unsigned* p, unsigned v) { return __hip_atomic_fetch_add(p, v, __ATOMIC_RELAXED, __HIP_MEMORY_SCOPE_AGENT); }
__device__ __forceinline__ unsigned xb_xcc_id() { return (unsigned)__builtin_amdgcn_s_getreg((3 << 11) | 20) & 0xFu; }
#define XB_SPIN(cond, bar) do { unsigned _sp = 0; while (cond) { __builtin_amdgcn_s_sleep(1); \
    if ((++_sp & 255u) == 0u) { if (xb_ld(&(bar)[XB_TMO])) break; if (_sp > XB_SPIN_CAP) { atomicAdd(&(bar)[XB_TMO], 1u); break; } } } } while (0)

struct XcdBarrier {
    unsigned* bar; unsigned x;
    volatile LAS unsigned* st;
};

__device__ __forceinline__ XcdBarrier xcd_barrier_post(unsigned* bar, volatile LAS unsigned* st) {
    XcdBarrier b; b.bar = bar; b.x = xb_xcc_id(); b.st = st;
    if (threadIdx.x == 0) (void)xb_add(&bar[XB_XCNT(b.x)], 1u);
    return b;
}
__device__ __forceinline__ void xcd_barrier_complete(unsigned* bar, unsigned x, unsigned& nloc, unsigned& nx) {
    const unsigned G = gridDim.x * gridDim.y * gridDim.z;
    unsigned sum, cnt, mine, sp = 0u;
    for (;;) {
        sum = 0u; cnt = 0u; mine = 0u;
#pragma unroll
        for (unsigned j = 0; j < 16; ++j) { const unsigned c = xb_ld(&bar[XB_XCNT(j)]); sum += c; cnt += (c > 0u) ? 1u : 0u; mine = (j == x) ? c : mine; }
        if (sum == G) break;
        __builtin_amdgcn_s_sleep(1);
        if ((++sp & 255u) == 0u) { if (xb_ld(&bar[XB_TMO])) break; if (sp > XB_SPIN_CAP) { atomicAdd(&bar[XB_TMO], 1u); break; } }
    }
    nloc = mine > 0u ? mine : 1u; nx = cnt > 0u ? cnt : 1u;
}

__device__ __forceinline__ void xcd_barrier(const XcdBarrier& b, int wv_) {
    asm volatile("s_waitcnt vmcnt(0)" ::: "memory");
    __syncthreads();
    if (wv_ == 0 && LANEID() == 0) {
        unsigned* bar = b.bar;
        __builtin_amdgcn_s_waitcnt(0);
        unsigned nloc = b.st[0], nx = b.st[1];
        if (nloc == 0u) { xcd_barrier_complete(bar, b.x, nloc, nx); b.st[0] = nloc; b.st[1] = nx; }
        const unsigned old = xb_add(&bar[XB_XSUB(b.x)], 1u);
        const unsigned gen = old / nloc;
        if (old + 1u == (gen + 1u) * nloc) {
            __builtin_amdgcn_fence(__ATOMIC_RELEASE, "agent");
            asm volatile("s_waitcnt vmcnt(0)" ::: "memory");
            const unsigned og = xb_add(&bar[XB_TOP], 1u);
            const unsigned tg = og / nx;
            if (og + 1u == (tg + 1u) * nx) xb_add(&bar[XB_TOPGEN], 1u);
            else XB_SPIN(xb_ld(&bar[XB_TOPGEN]) == tg, bar);
            __builtin_amdgcn_fence(__ATOMIC_ACQUIRE, "agent");
            xb_add(&bar[XB_XGEN(b.x)], 1u);
            asm volatile("s_waitcnt vmcnt(0)" ::: "memory");
        } else {
            XB_SPIN(xb_ld(&bar[XB_XGEN(b.x)]) == gen, bar);
            __builtin_amdgcn_fence(__ATOMIC_ACQUIRE, "agent");
            asm volatile("s_waitcnt vmcnt(0)" ::: "memory");
        }
    }
    __syncthreads();
}

enum { PH_PRO = 0, PH_GIN, PH_INDEX, PH_ATTN, PH_MERGE, PH_GOUT, PH_LN1, PH_GQ, PH_ROUTE, PH_PEER };
template <int PH> __device__ __forceinline__ void run_phase(int WV_, const Params& p_unused, int l, unsigned char* lds_raw) {
    size_t kaoff_ = 0; asm volatile("" : "+s"(kaoff_));
    typedef const __attribute__((address_space(4))) char* kaptr_t;
    const __attribute__((address_space(4))) Params& p = *(const __attribute__((address_space(4))) Params*)((kaptr_t)__builtin_amdgcn_kernarg_segment_ptr() + kaoff_);
    float* sm = (float*)lds_raw;
    size_t wsoff_ = 0; asm volatile("" : "+s"(wsoff_));
    unsigned char* ws = p.ws + wsoff_;
    float* hbuf = p.out;
    bf16* hb = (bf16*)(ws + WS_HB);
    bf16* P = (bf16*)(ws + WS_P);
    bf16* ys = (bf16*)(ws + WS_YS);
    bf16* mrg = (bf16*)(ws + WS_MRG);
    float* mix = (float*)(ws + WS_MIX);
    float* qb = (float*)(ws + WS_Q);
    unsigned char* mask = ws + WS_MASK;
    int* eid = (int*)(ws + WS_EID);
    float* gate = (float*)(ws + WS_GATE);
    float* kmean = (float*)(ws + WS_KMEAN);
    const float* hin = (l == 0) ? p.in[0] : hbuf;
    if (PH == PH_PRO) { Params pc; for (int i = 0; i < 13; ++i) pc.in[i] = p.in[i]; pc.out = p.out; pc.ws = ws;
        prologue_phase(WV_, pc, sm); convert_tables(WV_, pc);
        for (int i = LBID() * NTHR + LTID(WV_); i < DEPTH_ * 8 * 2 * 128 * 64 / 4; i += LGRID() * NTHR) { const float4 v = ((const float4*)p.in[8])[i]; ((uint2*)(ws + WS_SKB))[i] = make_uint2(pk2(v.x, v.y), pk2(v.z, v.w)); } if (LBID() < 2) build_unit_table((unsigned*)(ws + WS_CTL) + 1024, LBID() * NTHR + LTID(WV_)); }
    else if (PH == PH_GIN) {
        pg8::Gemm g{hb, (const bf16*)(ws + WS_WIN_T + l * WIN_T_BYTES), T_, NP, 1024};
        pg8::StaticOrder S; S.init(T_, NP, (int)LGRID(), (int)LBID());
        pg8::EpiBf16Sig E{P, NP, C_G};
        pg8::gemm_phase<pg8::EpiBf16Sig, pg8::StaticOrder, true, true>(WV_, (PG8_LAS unsigned char*)lds_raw, g, S, E);
    }
    else if (PH == PH_INDEX) index_fast_phase(WV_, P, mask, kmean, (float*)(ws + WS_YS), (unsigned*)(ws + WS_CTL) + 64 * l + 16, lds_raw);
    else if (PH == PH_ATTN) attn_fast_phase(WV_, P, mask, kmean, p.in[4] + l * 4, ys, (const unsigned*)(ws + WS_CTL) + 1024, (unsigned*)(ws + WS_CTL) + 64 * l, lds_raw);
    else if (PH == PH_MERGE) merge_fast_phase(WV_, P, ys, (const bf16*)(ws + WS_WBR_T) + (size_t)l * 4 * 1024 * 256, mrg, lds_raw);
    else if (PH == PH_GOUT) {
        pg8::Gemm g{mrg, (const bf16*)(ws + WS_WOUT_T) + (size_t)l * 1024 * 1024, T_, 1024, 1024};
        pg8::StaticOrder S; S.init(T_, 1024, (int)LGRID(), (int)LBID());
        pg8::EpiResY E{hin, hbuf, hb, (float*)(ws + WS_STATS) + (size_t)l * T_ * 2, ALPHA};
        pg8::gemm_phase<pg8::EpiResY, pg8::StaticOrder, true, true>(WV_, (PG8_LAS unsigned char*)lds_raw, g, S, E);
    }
    else if (PH == PH_GQ) {
        pg8::Gemm g{hb, (const bf16*)(ws + WS_WQ_T) + (size_t)l * 1024 * 1024, T_, 1024, 1024};
        pg8::StaticOrder S; S.init(T_, 1024, (int)LGRID(), (int)LBID());
        pg8::EpiLnFold E{(bf16*)qb, (const float*)(ws + WS_STATS) + (size_t)l * T_ * 2, (const float*)(ws + WS_COLS) + l * 2048, (const float*)(ws + WS_COLS) + l * 2048 + 1024, LN_EPS};
        pg8::gemm_phase<pg8::EpiLnFold, pg8::StaticOrder, true, true>(WV_, (PG8_LAS unsigned char*)lds_raw, g, S, E);
        pg8::Unit u0;
        if (LGRID() == 256 && S.next(0, u0)) {
            asm volatile("s_waitcnt vmcnt(0)" ::: "memory"); __syncthreads();
            route_fast_phase(WV_, (const bf16*)qb, (const bf16*)(ws + WS_SKB) + (size_t)l * 8 * 2 * 128 * 64, eid, gate, lds_raw, u0.pm, u0.pn);
        }
    }
    else if (PH == PH_ROUTE) { if (LGRID() != 256) route_fast_phase(WV_, (const bf16*)qb, (const bf16*)(ws + WS_SKB) + (size_t)l * 8 * 2 * 128 * 64, eid, gate, lds_raw); }
    else peer_fast_phase(WV_, hbuf, hb, eid, gate, ws + WS_UV + (size_t)l * 24 * MiB, p.in[5] + l * 1024, p.in[6] + l * 1024, p.in[11] + l * 1024, p.in[12] + l * 1024, lds_raw);
}

constexpr int CW_BAR = 4096;
constexpr int LDS_BARST = LDS_BYTES - 16;
__global__ void __launch_bounds__(NTHR, 2) mk_fwd(Params p) {
    extern __shared__ __attribute__((aligned(16))) unsigned char lds_raw[];
    cg::grid_group grid = cg::this_grid();
    const int WV_ = __builtin_amdgcn_readfirstlane((int)threadIdx.x >> 6);
    { volatile LAS unsigned* bst0 = (volatile LAS unsigned*)((LAS unsigned char*)lds_raw + LDS_BARST); if (threadIdx.x < 4) bst0[threadIdx.x] = 0u; }
    __syncthreads();
    volatile LAS unsigned* bst = (volatile LAS unsigned*)((LAS unsigned char*)lds_raw + LDS_BARST);
    (void)xcd_barrier_post((unsigned*)(p.ws + WS_CTL) + CW_BAR, bst);
#define GRID_BAR() do { XcdBarrier b_; b_.bar = (unsigned*)(p.ws + WS_CTL) + CW_BAR; b_.x = xb_xcc_id(); b_.st = (volatile LAS unsigned*)((LAS unsigned char*)lds_raw + LDS_BARST); xcd_barrier(b_, WV_); } while (0)
    run_phase<PH_PRO>(WV_, p, 0, lds_raw);
    grid.sync();
#pragma unroll 1
    for (int l = 0; l < DEPTH_; ++l) {
        run_phase<PH_GIN>(WV_, p, l, lds_raw); GRID_BAR();
        run_phase<PH_INDEX>(WV_, p, l, lds_raw); GRID_BAR();
        run_phase<PH_ATTN>(WV_, p, l, lds_raw); GRID_BAR();
        run_phase<PH_MERGE>(WV_, p, l, lds_raw); GRID_BAR();
        run_phase<PH_GOUT>(WV_, p, l, lds_raw); GRID_BAR();
        run_phase<PH_GQ>(WV_, p, l, lds_raw); if (LGRID() != 256) { GRID_BAR(); run_phase<PH_ROUTE>(WV_, p, l, lds_raw); } GRID_BAR();
        run_phase<PH_PEER>(WV_, p, l, lds_raw); if (l + 1 < DEPTH_) GRID_BAR();
    }
}

extern "C" void kernel_launch(void* const* d_in, const int* in_sizes, int n_in, void* d_out, int out_size, void* d_ws, size_t ws_size, hipStream_t stream) {
    if (n_in != 13 || ws_size < WS_END) { fprintf(stderr, "kernel_launch: unexpected n_in %d / ws_size %zu; nothing launched\n", n_in, ws_size); return; }
    static int grid_blocks = 0;
    if (grid_blocks == 0) {
        int dev = 0, cus = 0, per_cu = 0;
        (void)hipGetDevice(&dev);
        (void)hipDeviceGetAttribute(&cus, hipDeviceAttributeMultiprocessorCount, dev);
        (void)hipFuncSetAttribute((const void*)mk_fwd, hipFuncAttributeMaxDynamicSharedMemorySize, LDS_BYTES);
        (void)hipOccupancyMaxActiveBlocksPerMultiprocessor(&per_cu, (const void*)mk_fwd, NTHR, LDS_BYTES);
        if (per_cu < 1) fprintf(stderr, "kernel_launch: occupancy query reports %d\n", per_cu);
        grid_blocks = cus;
    }
    Params p{};
    for (int i = 0; i < 13; ++i) p.in[i] = (const float*)d_in[i];
    p.out = (float*)d_out; p.ws = (unsigned char*)d_ws;
    (void)hipMemsetAsync(d_ws, 0, 2 * MiB, stream);
    void* args[] = {&p};
    hipError_t e = hipLaunchCooperativeKernel((const void*)mk_fwd, dim3(grid_blocks), dim3(NTHR), args, LDS_BYTES, stream);
    if (e != hipSuccess) fprintf(stderr, "cooperative launch failed: %s (grid %d)\n", hipGetErrorString(e), grid_blocks);
}
```

```cpp
#include <hip/hip_runtime.h>
#include <cstdio>
#include <cstdint>
#include <hip/hip_cooperative_groups.h>
namespace cg = cooperative_groups;

__device__ __forceinline__ int LANEID() { int l; asm volatile("v_mbcnt_lo_u32_b32 %0, -1, 0\n\tv_mbcnt_hi_u32_b32 %0, -1, %0" : "=v"(l)); return l; }
__device__ __forceinline__ int LTID(int wv) { return (wv << 6) | LANEID(); }
__device__ __forceinline__ int LBID() { int t = blockIdx.x; asm volatile("" : "+s"(t)); return t; }
__device__ __forceinline__ int LGRID() { int t = gridDim.x; asm volatile("" : "+s"(t)); return t; }
namespace pg8 {
#define PG8_LAS __attribute__((address_space(3)))
typedef unsigned short bf16_t;
typedef short bf16x8 __attribute__((ext_vector_type(8)));
typedef float f32x4 __attribute__((ext_vector_type(4)));
typedef unsigned u32x4 __attribute__((ext_vector_type(4)));
constexpr int BM = 256, BK = 64, HALF = 128, HTB = HALF * BK * 2  , STAGE_BYTES = 8 * HTB, NXCD = 8, WGM = 8;

__host__ __device__ __forceinline__ int lds_byte(int r, int c) { const int st = (r >> 4) * 2 + (c >> 5), rr = r & 15, cc = c & 31, ob = rr * 64 + cc * 2; return st * 1024 + (ob ^ (((ob >> 9) & 1) << 5)); }
__host__ __device__ __forceinline__ void stage_rc(int b, int& R, int& C) { const int st = b / 1024, sb = b % 1024, swz = sb ^ (((sb >> 9) & 1) << 5); R = (st >> 1) * 16 + swz / 64; C = (st & 1) * 32 + (swz % 64) / 2; }
__host__ __device__ __forceinline__ int perm32(int rho) { const int n = rho >> 4, i = rho & 15; return 8 * (i >> 2) + 4 * n + (i & 3); }

struct Unit { int pm, pn; };
struct Gemm { const bf16_t* A; const bf16_t* Bt; int M, N, K; };

struct StaticOrder {
    int nM, nN, nwg, G, c;
    __host__ __device__ void init(int M, int N, int G_, int c_) { nM = M / BM; nN = N / BM; nwg = nM * nN; G = G_; c = c_; }
    __host__ __device__ bool next(int i, Unit& u) const {
        const long L = (long)i * G + c; if (L >= nwg) return false;
        int wgid = (int)L; { const int q = nwg / NXCD, r = nwg % NXCD, xcd = wgid % NXCD, off = wgid / NXCD; wgid = (xcd < r ? xcd * (q + 1) : r * (q + 1) + (xcd - r) * q) + off; }
        const int nig = WGM * nN, gid = wgid / nig, fm = gid * WGM, gsz = (nM - fm) < WGM ? (nM - fm) : WGM;
        u.pm = fm + ((wgid % nig) % gsz); u.pn = (wgid % nig) / gsz; return true;
    }
    __device__ __forceinline__ void a_ready(const Unit&) const {}
    __device__ __forceinline__ void done(const Unit&) const {}
};

__device__ __forceinline__ unsigned cvt_pk_bf16(float lo, float hi) { unsigned r; asm volatile("v_cvt_pk_bf16_f32 %0, %1, %2" : "=v"(r) : "v"(lo), "v"(hi)); return r; }
typedef float f32x2 __attribute__((ext_vector_type(2)));
__device__ __forceinline__ f32x2 gelu_pk(f32x2 v) {
    const f32x2 av = __builtin_elementwise_abs(v), d = av * 0.2316418882f + 1.0f;
    f32x2 t; t.x = __builtin_amdgcn_rcpf(d.x); t.y = __builtin_amdgcn_rcpf(d.y);
    f32x2 q = t * 0.5307027145f + (-0.7265760135f); q = q * t + 0.7107068705f; q = q * t + (-0.142248368f); q = q * t + 0.127414796f; q = q * t;
    const f32x2 s = (v * v) * (-0.72134752044f);
    f32x2 e; e.x = __builtin_amdgcn_exp2f(s.x); e.y = __builtin_amdgcn_exp2f(s.y);
    const f32x2 m = v * (q * e), r = v - m;
    f32x2 o; o.x = v.x < 0.f ? m.x : r.x; o.y = v.y < 0.f ? m.y : r.y; return o;
}

template <int ACT  > struct EpiBf16 {
    static constexpr bool PERM = true, AFTER_DRAIN = false; static_assert(ACT == 0 || ACT == 1, "EpiBf16: ACT is 0 (none) or 1 (gelu_pk)");
    bf16_t* O; int ldc; const float* bias; int split_cols; size_t split_stride; float scale0;
    __device__ __forceinline__ void operator()(const f32x4 (&acc)[2][2][4][2], const Unit& u, int wr, int wc, int fr, int fq) const {
        { int ln_ = LANEID(); asm volatile("" : "+v"(ln_)); fr = ln_ & 15; fq = ln_ >> 4; }
        const int row0 = u.pm * BM + wr * 64 + fr; int colt = u.pn * BM; bf16_t* base = O;
        float sc = 1.f; if (split_cols) { const int t = colt / split_cols; base += (size_t)t * split_stride; colt -= t * split_cols; if (t == 0) sc = scale0; }
        const int col0 = colt + wc * 32 + 8 * fq, bcol0 = u.pn * BM + wc * 32 + 8 * fq;
        f32x4 bv[2][2];
#pragma unroll
        for (int bj = 0; bj < 2; ++bj)
#pragma unroll
            for (int n = 0; n < 2; ++n) bv[bj][n] = bias ? *(const f32x4*)(bias + bcol0 + bj * HALF + 4 * n) : (f32x4){0.f, 0.f, 0.f, 0.f};
#pragma unroll
        for (int ai = 0; ai < 2; ++ai)
#pragma unroll
            for (int m = 0; m < 4; ++m) { bf16_t* rowp = base + (size_t)(row0 + ai * HALF + m * 16) * ldc + col0;
#pragma unroll
                for (int bj = 0; bj < 2; ++bj) { f32x4 v0 = acc[ai][bj][m][0] + bv[bj][0], v1 = acc[ai][bj][m][1] + bv[bj][1];
                    if (ACT == 1) { f32x2 a = gelu_pk((f32x2){v0[0], v0[1]}), b = gelu_pk((f32x2){v0[2], v0[3]}), c = gelu_pk((f32x2){v1[0], v1[1]}), d = gelu_pk((f32x2){v1[2], v1[3]});
                        v0 = (f32x4){a.x, a.y, b.x, b.y}; v1 = (f32x4){c.x, c.y, d.x, d.y}; }
                    v0 = v0 * sc; v1 = v1 * sc; u32x4 w; w.x = cvt_pk_bf16(v0[0], v0[1]); w.y = cvt_pk_bf16(v0[2], v0[3]); w.z = cvt_pk_bf16(v1[0], v1[1]); w.w = cvt_pk_bf16(v1[2], v1[3]);
                    *(u32x4*)(rowp + bj * HALF) = w; } }
    }
};
template <class Epi, class Sched, bool ALIGN_EPI = false, bool SP2 = false>
__device__ __forceinline__ void gemm_phase(int WV_, PG8_LAS unsigned char* lds, const Gemm g, const Sched& S, const Epi& E) {
    const int tid = LTID(WV_), wid = __builtin_amdgcn_readfirstlane(tid >> 6), lane = tid & 63, wr = wid >> 2, wc = wid & 3, fr = lane & 15, fq = lane >> 4;
    const int K = g.K, nt = K / BK;
    unsigned voffA[2], voffB[2];
#pragma unroll
    for (int i = 0; i < 2; ++i) { int R, C; stage_rc(tid * 16 + i * 8192, R, C); const int Rb = Epi::PERM ? ((R & ~31) + perm32(R & 31)) : R;
        voffA[i] = (unsigned)(R * K + C) * 2u; voffB[i] = (unsigned)(Rb * K + C) * 2u; }
    const size_t kstep = (size_t)(BK * 2);
    const size_t hstep = (size_t)HALF * K * 2;
    const size_t tstep = 2 * hstep;
    const unsigned ldsw = (unsigned)wid * 1024u;
    const int aoff = lds_byte(wr * 64 + fr, fq * 8), boff = lds_byte(wc * 32 + fr, fq * 8);
#define PG8_SA(b, h) (((b) * 2 + (h)) * HTB)
#define PG8_SB(b, h) ((4 + (b) * 2 + (h)) * HTB)
#define PG8_STAGE(bufoff, gbase, voff) do { _Pragma("unroll") for (int _i = 0; _i < 2; ++_i) \
        __builtin_amdgcn_global_load_lds((const unsigned*)((const char*)(gbase) + (voff)[_i]), (PG8_LAS unsigned*)(lds + (bufoff) + ldsw + _i * 8192), 16, 0, 0); } while (0)
#define PG8_LDA(dst, b, h) do { _Pragma("unroll") for (int m = 0; m < 4; ++m) _Pragma("unroll") for (int k = 0; k < 2; ++k) dst[m][k] = *(const PG8_LAS bf16x8*)(lds + PG8_SA(b, h) + aoff + m * 2048 + k * 1024); } while (0)
#define PG8_LDB(dst, b, h) do { _Pragma("unroll") for (int n = 0; n < 2; ++n) _Pragma("unroll") for (int k = 0; k < 2; ++k) dst[n][k] = *(const PG8_LAS bf16x8*)(lds + PG8_SB(b, h) + boff + n * 2048 + k * 1024); } while (0)
#define PG8_MMA(ai, bj, At, Bt) do { __builtin_amdgcn_s_setprio(1); _Pragma("unroll") for (int m = 0; m < 4; ++m) _Pragma("unroll") for (int n = 0; n < 2; ++n) _Pragma("unroll") for (int k = 0; k < 2; ++k) \
        acc[ai][bj][m][n] = __builtin_amdgcn_mfma_f32_16x16x32_bf16(Bt[n][k], At[m][k], acc[ai][bj][m][n], 0, 0, 0); __builtin_amdgcn_s_setprio(0); } while (0)
#define PG8_WAIT_V(n) asm volatile("s_waitcnt vmcnt(" #n ")" ::: "memory")
#define PG8_WAIT_L(n) asm volatile("s_waitcnt lgkmcnt(" #n ")" ::: "memory")
#define PG8_BAR __builtin_amdgcn_s_barrier()
#define PG8_SCHED __builtin_amdgcn_sched_barrier(0)
    Unit cur, nxt; int ui = 0;
    if (!S.next(0, cur)) return;
    f32x4 acc[2][2][4][2];
#pragma unroll
    for (int a = 0; a < 2; ++a)
#pragma unroll
        for (int b = 0; b < 2; ++b)
#pragma unroll
            for (int m = 0; m < 4; ++m)
#pragma unroll
                for (int n = 0; n < 2; ++n) acc[a][b][m][n] = (f32x4){0.f, 0.f, 0.f, 0.f};
    bf16x8 At[4][2], B0[2][2], B1[2][2];
    const char* cA = (const char*)g.A + (size_t)cur.pm * tstep; const char* cB = (const char*)g.Bt + (size_t)cur.pn * tstep;
    S.a_ready(cur);
    if constexpr (SP2) {
        PG8_STAGE(PG8_SB(0, 0), cB, voffB); PG8_STAGE(PG8_SB(0, 1), cB + hstep, voffB); PG8_STAGE(PG8_SA(0, 0), cA, voffA); PG8_STAGE(PG8_SA(0, 1), cA + hstep, voffA);
        if (wr == 1) PG8_BAR;
        PG8_WAIT_V(2); PG8_BAR;
        PG8_STAGE(PG8_SB(1, 0), cB + kstep, voffB); PG8_STAGE(PG8_SA(1, 0), cA + kstep, voffA); PG8_STAGE(PG8_SB(1, 1), cB + hstep + kstep, voffB);
        PG8_WAIT_V(6); PG8_BAR;
    } else {
        PG8_STAGE(PG8_SB(0, 0), cB, voffB); PG8_STAGE(PG8_SA(0, 0), cA, voffA); PG8_STAGE(PG8_SB(0, 1), cB + hstep, voffB); PG8_STAGE(PG8_SA(0, 1), cA + hstep, voffA);
        if (wr == 1) PG8_BAR;
        PG8_WAIT_V(4); PG8_BAR;
        PG8_STAGE(PG8_SB(1, 0), cB + kstep, voffB); PG8_STAGE(PG8_SA(1, 0), cA + kstep, voffA); PG8_STAGE(PG8_SB(1, 1), cB + hstep + kstep, voffB);
        PG8_WAIT_V(6); PG8_BAR;
    }
    for (;;) {
        const bool has_next = S.next(ui + 1, nxt);
        const char* nA = has_next ? (const char*)g.A + (size_t)nxt.pm * tstep : cA; const char* nB = has_next ? (const char*)g.Bt + (size_t)nxt.pn * tstep : cB;
        for (int t = 0; t < nt; t += 2) {
            const bool last = (t == nt - 2);
            const char* a1 = cA + (size_t)(t + 1) * kstep;
            const char* a2 = last ? nA : cA + (size_t)(t + 2) * kstep; const char* b2 = last ? nB : cB + (size_t)(t + 2) * kstep;
            const char* a3 = a2 + kstep; const char* b3 = b2 + kstep;
            if (last && has_next) S.a_ready(nxt);
            if constexpr (SP2) {
            PG8_LDB(B0, 0, 0); PG8_LDB(B1, 0, 1); PG8_SCHED; PG8_LDA(At, 0, 0); PG8_STAGE(PG8_SA(1, 1), a1 + hstep, voffA);
            PG8_WAIT_V(8); PG8_WAIT_L(0); PG8_BAR; PG8_MMA(0, 0, At, B0); PG8_MMA(0, 1, At, B1); PG8_BAR; PG8_SCHED;
            PG8_LDA(At, 0, 1); PG8_STAGE(PG8_SB(0, 0), b2, voffB); PG8_STAGE(PG8_SB(0, 1), b2 + hstep, voffB); PG8_STAGE(PG8_SA(0, 0), a2, voffA);
            PG8_WAIT_V(8); PG8_WAIT_L(0); PG8_BAR; PG8_MMA(1, 0, At, B0); PG8_MMA(1, 1, At, B1); PG8_BAR; PG8_SCHED;
            PG8_LDB(B0, 1, 0); PG8_LDB(B1, 1, 1); PG8_SCHED; PG8_LDA(At, 1, 0); PG8_STAGE(PG8_SA(0, 1), a2 + hstep, voffA);
            PG8_WAIT_V(8); PG8_WAIT_L(0); PG8_BAR; PG8_MMA(0, 0, At, B0); PG8_MMA(0, 1, At, B1); PG8_BAR; PG8_SCHED;
            PG8_LDA(At, 1, 1); PG8_STAGE(PG8_SB(1, 0), b3, voffB); PG8_STAGE(PG8_SB(1, 1), b3 + hstep, voffB); PG8_STAGE(PG8_SA(1, 0), a3, voffA);
            PG8_WAIT_V(8); PG8_WAIT_L(0); PG8_BAR; PG8_MMA(1, 0, At, B0); PG8_MMA(1, 1, At, B1); PG8_BAR; PG8_SCHED;
            } else {
            PG8_LDB(B0, 0, 0); PG8_SCHED; PG8_LDA(At, 0, 0); PG8_STAGE(PG8_SA(1, 1), a1 + hstep, voffA);
            PG8_WAIT_L(8); PG8_BAR; PG8_WAIT_L(0); PG8_MMA(0, 0, At, B0); PG8_BAR; PG8_SCHED;
            PG8_LDB(B1, 0, 1); PG8_STAGE(PG8_SB(0, 0), b2, voffB);
            PG8_BAR; PG8_WAIT_L(0); PG8_MMA(0, 1, At, B1); PG8_BAR;
            PG8_LDA(At, 0, 1); PG8_STAGE(PG8_SA(0, 0), a2, voffA);
            PG8_BAR; PG8_WAIT_L(0); PG8_MMA(1, 0, At, B0); PG8_BAR; PG8_SCHED;
            PG8_STAGE(PG8_SB(0, 1), b2 + hstep, voffB);
            PG8_WAIT_V(6); PG8_BAR; PG8_MMA(1, 1, At, B1); PG8_BAR;
            PG8_LDB(B0, 1, 0); PG8_SCHED; PG8_LDA(At, 1, 0); PG8_STAGE(PG8_SA(0, 1), a2 + hstep, voffA);
            PG8_WAIT_L(8); PG8_BAR; PG8_WAIT_L(0); PG8_MMA(0, 0, At, B0); PG8_BAR; PG8_SCHED;
            PG8_LDB(B1, 1, 1); PG8_STAGE(PG8_SB(1, 0), b3, voffB);
            PG8_BAR; PG8_WAIT_L(0); PG8_MMA(0, 1, At, B1); PG8_BAR;
            PG8_LDA(At, 1, 1); PG8_STAGE(PG8_SA(1, 0), a3, voffA);
            PG8_BAR; PG8_WAIT_L(0); PG8_MMA(1, 0, At, B0); PG8_BAR; PG8_SCHED;
            PG8_STAGE(PG8_SB(1, 1), b3 + hstep, voffB);
            PG8_WAIT_V(6); PG8_BAR; PG8_MMA(1, 1, At, B1); PG8_BAR;
            }
        }
        if constexpr (ALIGN_EPI) { if (wr == 0) PG8_BAR; }
        if constexpr (!Epi::AFTER_DRAIN) { E(acc, cur, wr, wc, fr, fq); S.done(cur); }
        if (!has_next) break;
#pragma unroll
        for (int a = 0; a < 2; ++a)
#pragma unroll
            for (int b = 0; b < 2; ++b)
#pragma unroll
                for (int m = 0; m < 4; ++m)
#pragma unroll
                    for (int n = 0; n < 2; ++n) acc[a][b][m][n] = (f32x4){0.f, 0.f, 0.f, 0.f};
        cur = nxt; cA = nA; cB = nB; ++ui;
        if constexpr (ALIGN_EPI) { if (wr == 1) PG8_BAR; }
    }
    PG8_WAIT_V(0);
    if constexpr (!ALIGN_EPI) { if (wr == 0) PG8_BAR; }
    PG8_BAR;
    if constexpr (Epi::AFTER_DRAIN) { E.fused(acc, cur, wr, wc, fr, fq, lds, wid, lane); S.done(cur); }
#undef PG8_SA
#undef PG8_SB
#undef PG8_STAGE
#undef PG8_LDA
#undef PG8_LDB
#undef PG8_MMA
#undef PG8_WAIT_V
#undef PG8_WAIT_L
#undef PG8_BAR
#undef PG8_SCHED
}
}
namespace pg8 {
struct EpiF32 {
    static constexpr bool PERM = false, AFTER_DRAIN = false;
    float* O; int ldc;
    __device__ __forceinline__ void operator()(const f32x4 (&acc)[2][2][4][2], const Unit& u, int wr, int wc, int fr, int fq) const {
        { int ln_ = LANEID(); asm volatile("" : "+v"(ln_)); fr = ln_ & 15; fq = ln_ >> 4; }
        const int row0 = u.pm * BM + wr * 64 + fr, col0 = u.pn * BM + wc * 32 + 4 * fq;
#pragma unroll
        for (int ai = 0; ai < 2; ++ai)
#pragma unroll
            for (int m = 0; m < 4; ++m) { float* rowp = O + (size_t)(row0 + ai * HALF + m * 16) * ldc + col0;
#pragma unroll
                for (int bj = 0; bj < 2; ++bj)
#pragma unroll
                    for (int n = 0; n < 2; ++n) *(f32x4*)(rowp + bj * HALF + n * 16) = acc[ai][bj][m][n]; }
    }
};
struct EpiResY {
    static constexpr bool PERM = false, AFTER_DRAIN = false;
    const float* hin; float* yout; bf16_t* yb; float* stats; float alpha;
    __device__ __forceinline__ void operator()(const f32x4 (&acc)[2][2][4][2], const Unit& u, int wr, int wc, int fr, int fq) const {
        { int ln_ = LANEID(); asm volatile("" : "+v"(ln_)); fr = ln_ & 15; fq = ln_ >> 4; }
        const int row0 = u.pm * BM + wr * 64 + fr, col0 = u.pn * BM + wc * 32 + 4 * fq;
#pragma unroll
        for (int ai = 0; ai < 2; ++ai)
#pragma unroll
            for (int m = 0; m < 4; ++m) {
                const int row = row0 + ai * HALF + m * 16;
                float s = 0.f, s2 = 0.f;
#pragma unroll
                for (int bj = 0; bj < 2; ++bj)
#pragma unroll
                    for (int n = 0; n < 2; ++n) {
                        const size_t off = (size_t)row * 1024 + col0 + bj * HALF + n * 16;
                        const f32x4 hv = *(const f32x4*)(hin + off);
                        const f32x4 y = hv * alpha + acc[ai][bj][m][n];
                        *(f32x4*)(yout + off) = y;
                        typedef unsigned u32x2v __attribute__((ext_vector_type(2)));
                        u32x2v w; w.x = cvt_pk_bf16(y[0], y[1]); w.y = cvt_pk_bf16(y[2], y[3]);
                        *(u32x2v*)(yb + off) = w;
                        s += (y[0] + y[1]) + (y[2] + y[3]); s2 += (y[0] * y[0] + y[1] * y[1]) + (y[2] * y[2] + y[3] * y[3]);
                    }
                s += __shfl_xor(s, 16); s += __shfl_xor(s, 32); s2 += __shfl_xor(s2, 16); s2 += __shfl_xor(s2, 32);
                if (fq == 0) { atomicAdd(stats + 2 * (size_t)row, s); atomicAdd(stats + 2 * (size_t)row + 1, s2); }
            }
    }
};
struct EpiLnFold {
    static constexpr bool PERM = true, AFTER_DRAIN = false;
    bf16_t* O; const float* stats; const float* colsum; const float* colbias; float eps;
    __device__ __forceinline__ void operator()(const f32x4 (&acc)[2][2][4][2], const Unit& u, int wr, int wc, int fr, int fq) const {
        { int ln_ = LANEID(); asm volatile("" : "+v"(ln_)); fr = ln_ & 15; fq = ln_ >> 4; }
        const int row0 = u.pm * BM + wr * 64 + fr, col0 = u.pn * BM + wc * 32 + 8 * fq;
        f32x4 cs[2][2], cb[2][2];
#pragma unroll
        for (int bj = 0; bj < 2; ++bj)
#pragma unroll
            for (int n = 0; n < 2; ++n) { cs[bj][n] = *(const f32x4*)(colsum + col0 + bj * HALF + 4 * n); cb[bj][n] = *(const f32x4*)(colbias + col0 + bj * HALF + 4 * n); }
#pragma unroll
        for (int ai = 0; ai < 2; ++ai)
#pragma unroll
            for (int m = 0; m < 4; ++m) {
                const int row = row0 + ai * HALF + m * 16;
                const float sm_ = stats[2 * (size_t)row], sq_ = stats[2 * (size_t)row + 1];
                const float mean = sm_ * (1.0f / 1024.0f);
                const float rstd = 1.0f / sqrtf(fmaxf(sq_ * (1.0f / 1024.0f) - mean * mean, 0.f) + eps);
                bf16_t* rowp = O + (size_t)row * 1024 + col0;
#pragma unroll
                for (int bj = 0; bj < 2; ++bj) {
                    const f32x4 v0 = (acc[ai][bj][m][0] - cs[bj][0] * mean) * rstd + cb[bj][0], v1 = (acc[ai][bj][m][1] - cs[bj][1] * mean) * rstd + cb[bj][1];
                    u32x4 w; w.x = cvt_pk_bf16(v0[0], v0[1]); w.y = cvt_pk_bf16(v0[2], v0[3]); w.z = cvt_pk_bf16(v1[0], v1[1]); w.w = cvt_pk_bf16(v1[2], v1[3]);
                    *(u32x4*)(rowp + bj * HALF) = w;
                }
            }
    }
};
__device__ __forceinline__ unsigned cvt_pk_bf16_t(float lo, float hi) { unsigned r; asm volatile("s_nop 0\n\tv_cvt_pk_bf16_f32 %0, %1, %2" : "=v"(r) : "v"(lo), "v"(hi)); return r; }
struct EpiBf16Sig {
    static constexpr bool PERM = true, AFTER_DRAIN = false;
    bf16_t* O; int ldc; int sig_col0;
    __device__ __forceinline__ void operator()(const f32x4 (&acc)[2][2][4][2], const Unit& u, int wr, int wc, int fr, int fq) const {
        { int ln_ = LANEID(); asm volatile("" : "+v"(ln_)); fr = ln_ & 15; fq = ln_ >> 4; }
        const int row0 = u.pm * BM + wr * 64 + fr; const int col0 = u.pn * BM + wc * 32 + 8 * fq;
#pragma unroll
        for (int bj = 0; bj < 2; ++bj) {
            if (col0 + bj * HALF >= sig_col0) {
#pragma unroll
                for (int ai = 0; ai < 2; ++ai)
#pragma unroll
                    for (int m = 0; m < 4; ++m) { bf16_t* rowp = O + (size_t)(row0 + ai * HALF + m * 16) * ldc + col0;
                        f32x4 v0 = acc[ai][bj][m][0], v1 = acc[ai][bj][m][1];
#pragma unroll
                        for (int e = 0; e < 4; ++e) { v0[e] = __builtin_amdgcn_rcpf(1.f + __builtin_amdgcn_exp2f(-1.44269504f * v0[e])); v1[e] = __builtin_amdgcn_rcpf(1.f + __builtin_amdgcn_exp2f(-1.44269504f * v1[e])); }
                        u32x4 w; w.x = cvt_pk_bf16_t(v0[0], v0[1]); w.y = cvt_pk_bf16_t(v0[2], v0[3]); w.z = cvt_pk_bf16_t(v1[0], v1[1]); w.w = cvt_pk_bf16_t(v1[2], v1[3]);
                        *(u32x4*)(rowp + bj * HALF) = w; }
            } else {
#pragma unroll
                for (int ai = 0; ai < 2; ++ai)
#pragma unroll
                    for (int m = 0; m < 4; ++m) { bf16_t* rowp = O + (size_t)(row0 + ai * HALF + m * 16) * ldc + col0;
                        const f32x4 v0 = acc[ai][bj][m][0], v1 = acc[ai][bj][m][1];
                        u32x4 w; w.x = cvt_pk_bf16(v0[0], v0[1]); w.y = cvt_pk_bf16(v0[2], v0[3]); w.z = cvt_pk_bf16(v1[0], v1[1]); w.w = cvt_pk_bf16(v1[2], v1[3]);
                        *(u32x4*)(rowp + bj * HALF) = w; }
            }
        }
    }
};
}

typedef unsigned short bf16;
constexpr int T_ = 16384, S_ = 4096, NBATCH = 4, D_ = 1024, NCOL = 6824, NP = 6912, DEPTH_ = 2;
constexpr int C_QA = 0, C_KA = 256, C_VA = 320, C_QI = 384, C_KI = 640, C_WI = 672, C_QB = 680, C_KB = 936, C_VB = 1064,
              C_QC = 1192, C_KC = 1448, C_VC = 1704, C_QD = 1960, C_KD = 2216, C_VD = 2472, C_G = 2728;
constexpr int NTHR = 512, NWAVE = 8;
constexpr float ALPHA = 1.41421356237309515f;
constexpr float LN_EPS = 1e-5f;
constexpr size_t MiB = 1u << 20;
constexpr size_t WS_STATS = 1 * MiB  , WS_COLS = 1 * MiB + 512 * 1024  ;
constexpr size_t WS_CTL = 0, WS_WIN_T = 2 * MiB, WS_WOUT_T = 30 * MiB, WS_WQ_T = 34 * MiB, WS_WBR_T = 38 * MiB, WS_HB = 42 * MiB,
                 WS_P = 74 * MiB, WS_MIX = 74 * MiB  , WS_Q = 138 * MiB  , WS_YS = 290 * MiB, WS_MRG = 322 * MiB,
                 WS_MASK = 354 * MiB, WS_EID = 362 * MiB, WS_GATE = 370 * MiB, WS_KMEAN = 378 * MiB, WS_SKB = 379 * MiB, WS_UV = 380 * MiB, WS_END = 508 * MiB;
constexpr size_t WIN_T_BYTES = (size_t)NP * 1024 * 2;
constexpr int LDS_BYTES = 144 * 1024;

struct Params { const float* in[13]; float* out; unsigned char* ws; };

__device__ __forceinline__ float bf2f(bf16 v) { return __uint_as_float((unsigned)v << 16); }
__device__ __forceinline__ unsigned f2bf(float f) { unsigned u = __float_as_uint(f); return (u + 0x7fffu + ((u >> 16) & 1u)) >> 16; }
__device__ __forceinline__ unsigned pk2(float lo, float hi) { return f2bf(lo) | (f2bf(hi) << 16); }
__device__ __forceinline__ void unpack8(const uint4 v, float* o) {
    o[0] = __uint_as_float(v.x << 16); o[1] = __uint_as_float(v.x & 0xffff0000u); o[2] = __uint_as_float(v.y << 16); o[3] = __uint_as_float(v.y & 0xffff0000u);
    o[4] = __uint_as_float(v.z << 16); o[5] = __uint_as_float(v.z & 0xffff0000u); o[6] = __uint_as_float(v.w << 16); o[7] = __uint_as_float(v.w & 0xffff0000u);
}
__device__ __forceinline__ float wave_sum(float v) {
#pragma unroll
    for (int o = 32; o > 0; o >>= 1) v += __shfl_xor(v, o);
    return v;
}
__device__ __forceinline__ float wave_max(float v) {
#pragma unroll
    for (int o = 32; o > 0; o >>= 1) v = fmaxf(v, __shfl_xor(v, o));
    return v;
}
__device__ __forceinline__ int wave_sum_i(int v) {
#pragma unroll
    for (int o = 32; o > 0; o >>= 1) v += __shfl_xor(v, o);
    return v;
}
__device__ __forceinline__ float logsig(float x) { return fminf(x, 0.f) - log1pf(expf(-fabsf(x))); }

__device__ void transpose_items(int WV_, const float* W, int K, int N, bf16* WT, float* sm, int item0, int nitems_total, int item_stride,
                                const float* rs_g = nullptr, const float* rs_b = nullptr, float* colsum = nullptr, float* colbias = nullptr) {
    const int tid = LTID(WV_);
    const int nkb = K / 64, nnb = (N + 63) / 64;
    for (int it = item0; it < nkb * nnb; it += item_stride) {
        const int kb = it % nkb, nb = it / nkb, k0 = kb * 64, n0 = nb * 64;
        __syncthreads();
        for (int e = tid; e < 64 * 64; e += NTHR) { const int kk = e >> 6, nn = e & 63; sm[kk * 65 + nn] = (n0 + nn < N) ? W[(size_t)(k0 + kk) * N + n0 + nn] : 0.f; }
        __syncthreads();
        if (rs_g) {
            if (tid < 64) { float cs = 0.f, cb = 0.f;
                for (int kk = 0; kk < 64; ++kk) { const float w = sm[kk * 65 + tid]; cs += w * rs_g[k0 + kk]; cb += w * rs_b[k0 + kk]; }
                atomicAdd(colsum + n0 + tid, cs); atomicAdd(colbias + n0 + tid, cb); }
            __syncthreads();
            for (int e = tid; e < 64 * 64; e += NTHR) { const int kk = e >> 6, nn = e & 63; sm[kk * 65 + nn] *= rs_g[k0 + kk]; }
            __syncthreads();
        }
        { const int nn = tid >> 3, c = tid & 7;
          if (n0 + nn < N) { uint4 o; o.x = pk2(sm[(8 * c + 0) * 65 + nn], sm[(8 * c + 1) * 65 + nn]); o.y = pk2(sm[(8 * c + 2) * 65 + nn], sm[(8 * c + 3) * 65 + nn]);
              o.z = pk2(sm[(8 * c + 4) * 65 + nn], sm[(8 * c + 5) * 65 + nn]); o.w = pk2(sm[(8 * c + 6) * 65 + nn], sm[(8 * c + 7) * 65 + nn]);
              *(uint4*)(WT + (size_t)(n0 + nn) * K + k0 + 8 * c) = o; } }
    }
    __syncthreads();
}
__device__ void prologue_phase(int WV_, const Params& p, float* sm) {
    const int tid = LTID(WV_), B = LBID(), G = LGRID();
    unsigned char* ws = p.ws;
    for (int l = 0; l < DEPTH_; ++l) {
        bf16* win_t = (bf16*)(ws + WS_WIN_T + l * WIN_T_BYTES);
        transpose_items(WV_, p.in[1] + (size_t)l * 1024 * NCOL, 1024, NCOL, win_t, sm, B, 0, G);
        for (int i = B * NTHR + tid; i < (NP - NCOL) * 1024 / 8; i += G * NTHR) ((uint4*)(win_t + (size_t)NCOL * 1024))[i] = make_uint4(0u, 0u, 0u, 0u);
        transpose_items(WV_, p.in[3] + (size_t)l * 1024 * 1024, 1024, 1024, (bf16*)(ws + WS_WOUT_T) + (size_t)l * 1024 * 1024, sm, B, 0, G);
        transpose_items(WV_, p.in[7] + (size_t)l * 1024 * 1024, 1024, 1024, (bf16*)(ws + WS_WQ_T) + (size_t)l * 1024 * 1024, sm, B, 0, G,
                        p.in[5] + l * 1024, p.in[6] + l * 1024, (float*)(ws + WS_COLS) + l * 2048, (float*)(ws + WS_COLS) + l * 2048 + 1024);
        for (int n = 0; n < 4; ++n)
            transpose_items(WV_, p.in[2] + ((size_t)l * 4 + n) * 256 * 1024, 256, 1024, (bf16*)(ws + WS_WBR_T) + ((size_t)l * 4 + n) * 1024 * 256, sm, B, 0, G);
    }
    const float4* x4 = (const float4*)p.in[0]; uint2* hb2 = (uint2*)(ws + WS_HB);
    for (size_t i = (size_t)B * NTHR + tid; i < (size_t)T_ * 1024 / 4; i += (size_t)G * NTHR) { const float4 v = x4[i]; hb2[i] = make_uint2(pk2(v.x, v.y), pk2(v.z, v.w)); }
}

__device__ __forceinline__ void ln_row(float4 (&v)[4], const float* g, const float* bb, float* orow, bf16* obrow, int lane) {
    float s = 0.f;
#pragma unroll
    for (int j = 0; j < 4; ++j) s += (v[j].x + v[j].y) + (v[j].z + v[j].w);
    const float mean = wave_sum(s) * (1.0f / 1024.0f);
    float s2 = 0.f;
#pragma unroll
    for (int j = 0; j < 4; ++j) { v[j].x -= mean; v[j].y -= mean; v[j].z -= mean; v[j].w -= mean; s2 += (v[j].x * v[j].x + v[j].y * v[j].y) + (v[j].z * v[j].z + v[j].w * v[j].w); }
    const float rstd = 1.0f / sqrtf(wave_sum(s2) * (1.0f / 1024.0f) + LN_EPS);
#pragma unroll
    for (int j = 0; j < 4; ++j) {
        const float4 gg = ((const float4*)g)[j * 64 + lane], b4 = ((const float4*)bb)[j * 64 + lane];
        float4 o; o.x = v[j].x * rstd * gg.x + b4.x; o.y = v[j].y * rstd * gg.y + b4.y; o.z = v[j].z * rstd * gg.z + b4.z; o.w = v[j].w * rstd * gg.w + b4.w;
        ((float4*)orow)[j * 64 + lane] = o;
        ((uint2*)obrow)[j * 64 + lane] = make_uint2(pk2(o.x, o.y), pk2(o.z, o.w));
    }
}
__device__ void ln1_phase(int WV_, const float* hin, const float* add, const float* g, const float* bb, float* hout, bf16* hb) {
    const int lane = LTID(WV_) & 63, wave = LTID(WV_) >> 6;
    for (int row = LBID() * NWAVE + wave; row < T_; row += LGRID() * NWAVE) {
        float4 v[4];
#pragma unroll
        for (int j = 0; j < 4; ++j) {
            const float4 a = ((const float4*)(hin + (size_t)row * 1024))[j * 64 + lane], m = ((const float4*)(add + (size_t)row * 1024))[j * 64 + lane];
            v[j].x = ALPHA * a.x + m.x; v[j].y = ALPHA * a.y + m.y; v[j].z = ALPHA * a.z + m.z; v[j].w = ALPHA * a.w + m.w;
        }
        ln_row(v, g, bb, hout + (size_t)row * 1024, hb + (size_t)row * 1024, lane);
    }
}


typedef short bf16x8_t __attribute__((ext_vector_type(8)));
typedef float f32x16_t __attribute__((ext_vector_type(16)));
typedef float f32x2_t __attribute__((ext_vector_type(2)));
typedef __bf16 bf16x2_t __attribute__((ext_vector_type(2)));
__device__ __forceinline__ unsigned cvtpk(float lo, float hi) { f32x2_t v = {lo, hi}; bf16x2_t b = __builtin_convertvector(v, bf16x2_t); return __builtin_bit_cast(unsigned, b); }
__device__ __forceinline__ int crow(int r, int hi) { return (r & 3) + 8 * (r >> 2) + 4 * hi; }
__device__ __forceinline__ float xlane32(float v) { return __shfl_xor(v, 32); }
__device__ __forceinline__ float vmax(float a, float b) { float r; asm("v_max_f32_e32 %0, %1, %2" : "=v"(r) : "v"(a), "v"(b)); return r; }
__device__ __forceinline__ float vmin(float a, float b) { float r; asm("v_min_f32_e32 %0, %1, %2" : "=v"(r) : "v"(a), "v"(b)); return r; }
__device__ __forceinline__ float vmax3(float a, float b, float c) { float r; asm("v_max3_f32 %0, %1, %2, %3" : "=v"(r) : "v"(a), "v"(b), "v"(c)); return r; }

constexpr int AT_KP = 72, AT_VP = 96;
constexpr int AT_KS = 0, AT_KS_BYTES = 64 * AT_KP * 2;
constexpr int AT_VT = 2 * AT_KS_BYTES, AT_VT_BYTES = 64 * AT_VP * 2;
constexpr int AT_KM = AT_VT + 2 * AT_VT_BYTES;
constexpr int AT_MISC = AT_KM + 32 * AT_KP * 2;
constexpr float LOG2E = 1.4426950408889634f;

__device__ __forceinline__ unsigned mk_unit(int kind, int b, int x, int y) { return ((unsigned)kind << 30) | ((unsigned)b << 28) | ((unsigned)x << 8) | (unsigned)y; }
__device__ void build_unit_table(unsigned* tab, int i) {
    int n = 0; unsigned res = 0u;
#pragma unroll 1
    for (int c = 64; c >= 1; --c) {
        if (i >= n && i < n + 4) res = mk_unit(0, i - n, 0, c - 1);
        n += 4;
        if ((c & 3) == 0) { if (i >= n && i < n + 16) { const int j = i - n; res = mk_unit(2, j >> 2, j & 3, c / 4 - 1); } n += 16; }
    }
    if (i < 512) tab[i] = res;
}

template <int kind> __device__ __forceinline__ void attn_unit(int WV_, const bf16* P, const unsigned char* mask, const float* kmean, const float* sinks, bf16* ys,
                                unsigned char* lds, int b, int ux, int uy) {
    int tid_ = LTID(WV_); asm volatile("" : "+v"(tid_));
    const int tid = tid_, lane = tid & 63, wave = __builtin_amdgcn_readfirstlane(tid >> 6), r32 = lane & 31, hi = lane >> 5;
    bf16* s_km = (bf16*)(lds + AT_KM);
    const int skey = tid >> 3, sc = tid & 7;
    {
        const bf16* Pb = P + (size_t)b * S_ * NP;
        int q0w, qcol, kcol, vcol, ycol, kt_hi, kt_lo; float slope2 = 0.f, sink2 = 0.f;
        if (kind == 0) { const int head = wave >> 1; q0w = uy * 64 + (wave & 1) * 32; qcol = C_QA + head * 64; kcol = C_KA; vcol = C_VA; ycol = head * 64;
            slope2 = exp2f(-8.0f * (float)(3 * head + 1) / 12.0f) * LOG2E; kt_hi = uy; kt_lo = 0; }
        else if (kind == 1) { const int hq = ux * 2 + (wave >> 2); q0w = uy * 128 + (wave & 3) * 32; qcol = C_QB + hq * 64; kcol = C_KB + ux * 64; vcol = C_VB + ux * 64; ycol = 256 + hq * 64;
            slope2 = exp2f(-8.0f * (float)(3 * hq + 2) / 12.0f) * LOG2E; sink2 = sinks[hq] * LOG2E; kt_hi = 2 * uy + 1; kt_lo = (2 * uy - 2 > 0) ? 2 * uy - 2 : 0; }
        else if (kind == 2) { q0w = uy * 256 + wave * 32; qcol = C_QC + ux * 64; kcol = C_KC + ux * 64; vcol = C_VC + ux * 64; ycol = 512 + ux * 64;
            slope2 = exp2f(-8.0f * (float)(3 * ux + 3) / 12.0f) * LOG2E; kt_hi = 4 * uy + 3; kt_lo = 0; }
        else { q0w = uy * 256 + wave * 32; qcol = C_QD + ux * 64; kcol = C_KD + ux * 64; vcol = C_VD + ux * 64; ycol = 768 + ux * 64; kt_hi = 4 * uy + 3; kt_lo = 0; }
        const int qpos = q0w + r32;
        bf16x8_t qf[4];
        { const bf16* qp = Pb + (size_t)qpos * NP + qcol + 8 * hi;
#pragma unroll
          for (int ks = 0; ks < 4; ++ks) qf[ks] = *(const bf16x8_t*)(qp + 16 * ks); }
        {
            const float qs = (kind == 3) ? 0.125f : 0.125f * LOG2E;
            typedef unsigned u32x4_t __attribute__((ext_vector_type(4)));
#pragma unroll
            for (int ks = 0; ks < 4; ++ks) { u32x4_t w = __builtin_bit_cast(u32x4_t, qf[ks]);
#pragma unroll
                for (int i = 0; i < 4; ++i) w[i] = cvtpk(__uint_as_float(w[i] << 16) * qs, __uint_as_float(w[i] & 0xffff0000u) * qs);
                qf[ks] = __builtin_bit_cast(bf16x8_t, w); }
        }
        float sb[16];
#pragma unroll
        for (int r = 0; r < 16; ++r) sb[r] = slope2 * (float)((r & 3) + 8 * (r >> 2));
        unsigned bm = 0u;
        if (kind == 2) {
            const int own = uy;
            for (int e = tid; e < 32 * 64; e += NTHR) { const int row = e >> 6, d = e & 63; s_km[row * AT_KP + d] = (row < 16) ? (bf16)f2bf(kmean[((b * 4 + ux) * 16 + row) * 64 + d]) : (bf16)0; }
            __syncthreads();
            f32x16_t gacc;
#pragma unroll
            for (int r = 0; r < 16; ++r) gacc[r] = 0.f;
#pragma unroll
            for (int ks = 0; ks < 4; ++ks) { const bf16x8_t a = *(const bf16x8_t*)(s_km + r32 * AT_KP + 16 * ks + 8 * hi); gacc = __builtin_amdgcn_mfma_f32_32x32x16_bf16(a, qf[ks], gacc, 0, 0, 0); }
            float gt[16];
#pragma unroll
            for (int r = 0; r < 8; ++r) { const float mine = gacc[r], other = xlane32(mine); const int bi = crow(r, 0);
                gt[bi] = hi ? other : mine; gt[bi + 4] = hi ? mine : other; }
#pragma unroll
            for (int n = 0; n < 16; ++n) if (n >= own) gt[n] = -INFINITY;
#pragma unroll
            for (int rep = 0; rep < 3; ++rep) {
                float mx = -INFINITY;
#pragma unroll
                for (int n = 0; n < 16; ++n) mx = fmaxf(mx, gt[n]);
                bool done = !(mx > -INFINITY);
#pragma unroll
                for (int n = 0; n < 16; ++n) { const bool hit = !done && gt[n] == mx; if (hit) { bm |= 1u << n; gt[n] = -INFINITY; done = true; } }
            }
        }
        f32x16_t o0, o1;
#pragma unroll
        for (int r = 0; r < 16; ++r) { o0[r] = 0.f; o1[r] = 0.f; }
        float m_run = -INFINITY, l_run = 0.f, carry = 0.f;
        const bf16* kg = Pb + (size_t)skey * NP + kcol + sc * 8;
        const bf16* vg = Pb + (size_t)skey * NP + vcol + sc * 8;
        uint4 rk = *(const uint4*)(kg + (size_t)kt_hi * 64 * NP), rv = *(const uint4*)(vg + (size_t)kt_hi * 64 * NP);
        int buf = 0;
        { bf16* ks_ = (bf16*)(lds + AT_KS); bf16* vt_ = (bf16*)(lds + AT_VT);
          *(uint4*)(ks_ + skey * AT_KP + sc * 8) = rk;
          *(uint4*)(vt_ + skey * AT_VP + sc * 8) = rv; }
        __syncthreads();
        bool wave_done = false;
        uint2 mw_next = make_uint2(0u, 0u);
        if (kind == 0) mw_next = *(const uint2*)(mask + (size_t)(b * S_ + qpos) * 512 + kt_hi * 8);
        for (int kt = kt_hi; kt >= kt_lo; --kt) {
            const bool more = kt > kt_lo;
            const uint2 mw = mw_next;
            if (kind == 0 && more) mw_next = *(const uint2*)(mask + (size_t)(b * S_ + qpos) * 512 + (kt - 1) * 8);
            if (more) { rk = *(const uint4*)(kg + (size_t)(kt - 1) * 64 * NP); rv = *(const uint4*)(vg + (size_t)(kt - 1) * 64 * NP); }
            const bf16* ks_ = (const bf16*)(lds + AT_KS + buf * AT_KS_BYTES);
            const bf16* vt_ = (const bf16*)(lds + AT_VT + buf * AT_VT_BYTES);
            bool active = (kt * 64 <= q0w + 31) && !wave_done;
            if (kind == 1) active = active && (kt * 64 + 63 >= q0w - 127);
            if (active) {
                const int kbase = kt * 64 + 4 * hi;
                f32x16_t p0, p1;
                if (kind != 3) {
                    const float cb = slope2 * (float)(kbase - qpos), cb1 = cb + 32.0f * slope2;
#pragma unroll
                    for (int r = 0; r < 16; ++r) { p0[r] = cb + sb[r]; p1[r] = cb1 + sb[r]; }
                } else {
#pragma unroll
                    for (int r = 0; r < 16; ++r) { p0[r] = 0.f; p1[r] = 0.f; }
                }
#pragma unroll
                for (int ks = 0; ks < 4; ++ks) {
                    const bf16x8_t a0 = *(const bf16x8_t*)(ks_ + r32 * AT_KP + 16 * ks + 8 * hi);
                    const bf16x8_t a1 = *(const bf16x8_t*)(ks_ + (32 + r32) * AT_KP + 16 * ks + 8 * hi);
                    p0 = __builtin_amdgcn_mfma_f32_32x32x16_bf16(a0, qf[ks], p0, 0, 0, 0);
                    p1 = __builtin_amdgcn_mfma_f32_32x32x16_bf16(a1, qf[ks], p1, 0, 0, 0);
                }
                if (kind != 3) {
                    float mx = -INFINITY;
                    if (kind == 0) {
                        const unsigned w0 = mw.x >> (4 * hi), w1 = mw.y >> (4 * hi);
#pragma unroll
                        for (int r = 0; r < 16; ++r) { const int off = (r & 3) + 8 * (r >> 2);
                            p0[r] = (w0 & (1u << off)) ? p0[r] : -INFINITY; p1[r] = (w1 & (1u << off)) ? p1[r] : -INFINITY; mx = vmax3(mx, p0[r], p1[r]); }
                    } else if (kind == 1) {
                        const int rel = qpos - kbase;
#pragma unroll
                        for (int r = 0; r < 16; ++r) { const int off = (r & 3) + 8 * (r >> 2);
                            p0[r] = ((unsigned)(rel - off) < 128u) ? p0[r] : -INFINITY; p1[r] = ((unsigned)(rel - off - 32) < 128u) ? p1[r] : -INFINITY; mx = vmax3(mx, p0[r], p1[r]); }
                    } else {
                        if ((kt >> 2) == uy) {
                            const int rel = qpos - kbase;
#pragma unroll
                            for (int r = 0; r < 16; ++r) { const int off = (r & 3) + 8 * (r >> 2);
                                p0[r] = (off <= rel) ? p0[r] : -INFINITY; p1[r] = (off + 32 <= rel) ? p1[r] : -INFINITY; mx = vmax3(mx, p0[r], p1[r]); }
                        } else {
                            const bool tile_ok = ((bm >> (kt >> 2)) & 1u) != 0u;
#pragma unroll
                            for (int r = 0; r < 16; ++r) { p0[r] = tile_ok ? p0[r] : -INFINITY; p1[r] = tile_ok ? p1[r] : -INFINITY; mx = vmax3(mx, p0[r], p1[r]); }
                        }
                    }
                    mx = vmax(mx, xlane32(mx));
                    const float m_new = vmax(m_run, mx);
                    const float m_safe = (m_new == -INFINITY) ? 0.f : m_new;
                    p0 = p0 - m_safe; p1 = p1 - m_safe;
#pragma unroll
                    for (int r = 0; r < 16; ++r) { p0[r] = __builtin_amdgcn_exp2f(p0[r]); p1[r] = __builtin_amdgcn_exp2f(p1[r]); }
                    float ls;
                    { typedef float f32x8_t __attribute__((ext_vector_type(8))); typedef float f32x4v_t __attribute__((ext_vector_type(4)));
                      const f32x16_t t16 = p0 + p1; const f32x8_t t8 = t16.lo + t16.hi; const f32x4v_t t4 = t8.lo + t8.hi; const f32x2_t t2 = t4.lo + t4.hi; ls = t2.x + t2.y; }
                    if (__any(m_new > m_run)) {
                        const float alpha = __builtin_amdgcn_exp2f(m_run - m_safe);
                        l_run *= alpha;
                        o0 = o0 * alpha; o1 = o1 * alpha;
                    }
                    l_run += ls; m_run = m_new;
                } else {
                    float run = carry;
#define SB_HALF(PX, KOFF) do { \
                    float lk[16]; \
                    _Pragma("unroll") for (int r = 0; r < 16; ++r) { \
                        const int off = (r & 3) + 8 * (r >> 2); \
                        const bool v = (kbase + off + (KOFF)) < qpos; \
                        const float z = PX[r]; \
                        const float t = 0.6931471805599453f * __builtin_amdgcn_logf(1.0f + __builtin_amdgcn_exp2f(-LOG2E * fabsf(z))); \
                        lk[r] = v ? (fminf(-z, 0.f) - t) : 0.f; \
                        PX[r] = v ? (fminf(z, 0.f) - t) : -INFINITY; } \
                    _Pragma("unroll") for (int g = 3; g >= 0; --g) { \
                        const float G = (lk[4 * g] + lk[4 * g + 1]) + (lk[4 * g + 2] + lk[4 * g + 3]); \
                        const float PG = xlane32(G); \
                        float la = run + (hi ? 0.f : PG); \
                        run += G + PG; \
                        PX[4 * g + 3] += la; la += lk[4 * g + 3]; PX[4 * g + 2] += la; la += lk[4 * g + 2]; PX[4 * g + 1] += la; la += lk[4 * g + 1]; PX[4 * g] += la; } \
                    _Pragma("unroll") for (int r = 0; r < 16; ++r) PX[r] = __builtin_amdgcn_exp2f(LOG2E * PX[r]); } while (0)
                    SB_HALF(p1, 32);
                    SB_HALF(p0, 0);
#undef SB_HALF
                    carry = run;
                }
                unsigned pw[16];
#pragma unroll
                for (int j = 0; j < 8; ++j) { pw[j] = cvtpk(p0[2 * j], p0[2 * j + 1]); pw[8 + j] = cvtpk(p1[2 * j], p1[2 * j + 1]); }
#pragma unroll
                for (int s = 0; s < 4; ++s) {
                    bf16x8_t pb; { const unsigned* q = pw + 4 * s; typedef unsigned u32x4_t __attribute__((ext_vector_type(4))); u32x4_t t4 = {q[0], q[1], q[2], q[3]}; pb = __builtin_bit_cast(bf16x8_t, t4); }
#pragma unroll
                    for (int dt = 0; dt < 2; ++dt) {
                        typedef short s16x4_t __attribute__((ext_vector_type(4)));
                        typedef __attribute__((address_space(3))) s16x4_t lds_s16x4;
                        const int gi_ = lane & 15;
                        const bf16* vp = vt_ + (16 * s + 4 * hi + (gi_ >> 2)) * AT_VP + 32 * dt + 16 * ((lane >> 4) & 1) + 4 * (gi_ & 3);
                        const s16x4_t lo = __builtin_amdgcn_ds_read_tr16_b64_v4i16((lds_s16x4*)vp), hi4 = __builtin_amdgcn_ds_read_tr16_b64_v4i16((lds_s16x4*)(vp + 8 * AT_VP));
                        const bf16x8_t va = {lo[0], lo[1], lo[2], lo[3], hi4[0], hi4[1], hi4[2], hi4[3]};
                        if (dt == 0) o0 = __builtin_amdgcn_mfma_f32_32x32x16_bf16(va, pb, o0, 0, 0, 0);
                        else         o1 = __builtin_amdgcn_mfma_f32_32x32x16_bf16(va, pb, o1, 0, 0, 0);
                    }
                }
            }
            if (kind == 3) {
                const float cm = carry;
                if (__all(cm < -110.0f) || !(kt * 64 <= q0w + 31) ) { if (__all(cm < -110.0f)) wave_done = true; }
            }
            if (more) {
                bf16* ksn = (bf16*)(lds + AT_KS + (buf ^ 1) * AT_KS_BYTES); bf16* vtn = (bf16*)(lds + AT_VT + (buf ^ 1) * AT_VT_BYTES);
                *(uint4*)(ksn + skey * AT_KP + sc * 8) = rk;
                *(uint4*)(vtn + skey * AT_VP + sc * 8) = rv;
            }
            if (kind == 3) { if (__syncthreads_and(wave_done ? 1 : 0)) break; }
            else __syncthreads();
            buf ^= 1;
        }
        float inv;
        if (kind == 3) inv = 1.0f;
        else {
            float lt = l_run + xlane32(l_run);
            if (kind == 1) { const float mf = fmaxf(m_run, sink2); const float sc2 = exp2f(m_run - mf); lt = lt * sc2 + exp2f(sink2 - mf); inv = sc2 / lt; }
            else inv = 1.0f / lt;
        }
        bf16* yp = ys + (size_t)(b * S_ + qpos) * 1024 + ycol + 4 * hi;
#pragma unroll
        for (int g = 0; g < 4; ++g) {
            *(uint2*)(yp + 8 * g) = make_uint2(cvtpk(o0[4 * g] * inv, o0[4 * g + 1] * inv), cvtpk(o0[4 * g + 2] * inv, o0[4 * g + 3] * inv));
            *(uint2*)(yp + 32 + 8 * g) = make_uint2(cvtpk(o1[4 * g] * inv, o1[4 * g + 1] * inv), cvtpk(o1[4 * g + 2] * inv, o1[4 * g + 3] * inv));
        }
    }
}
__device__ void attn_fast_phase(int WV_, const bf16* P, const unsigned char* mask, const float* kmean, const float* sinks, bf16* ys,
                                const unsigned* utab, unsigned* counter, unsigned char* lds) {
    volatile unsigned* s_unit = (volatile unsigned*)(lds + AT_MISC);
    for (;;) {
        __syncthreads();
        if (LTID(WV_) == 0) s_unit[0] = atomicAdd(counter, 1u);
        __syncthreads();
        const unsigned ui = s_unit[0];
        if (ui >= 512u) break;
        const unsigned ue = utab[ui];
        const int kind = (int)(ue >> 30), b = (int)((ue >> 28) & 3u), ux = (int)((ue >> 8) & 255u), uy = (int)(ue & 255u);
        if (kind == 0) attn_unit<0>(WV_, P, mask, kmean, sinks, ys, lds, b, ux, uy);
        else attn_unit<2>(WV_, P, mask, kmean, sinks, ys, lds, b, ux, uy);
    }
    for (int u = LBID(); u < 256; u += LGRID()) { __syncthreads(); attn_unit<3>(WV_, P, mask, kmean, sinks, ys, lds, u >> 6, (u >> 4) & 3, u & 15); }
    for (int u = LBID(); u < 256; u += LGRID()) { __syncthreads(); attn_unit<1>(WV_, P, mask, kmean, sinks, ys, lds, u >> 6, (u >> 5) & 1, u & 31); }
}

constexpr float U_SCALE = 128.0f, V_SCALE = 48.0f;
constexpr int ROW6 = 1536;
typedef float v32f_t __attribute__((ext_vector_type(32)));
typedef unsigned v6u_t __attribute__((ext_vector_type(6)));
typedef unsigned u32x4a8_t __attribute__((ext_vector_type(4), aligned(8)));
__device__ __forceinline__ float rdlane_f(float v, int l) { return __builtin_bit_cast(float, __builtin_amdgcn_readlane(__builtin_bit_cast(int, v), l)); }
__device__ __forceinline__ unsigned q_e2m3(float v) {
    const float a = fminf(fabsf(v), 7.5f);
    unsigned code;
    if (a < 1.0f) code = (unsigned)rintf(a * 8.0f);
    else if (a < 2.0f) code = 8u + (unsigned)rintf((a - 1.0f) * 8.0f);
    else if (a < 4.0f) code = 16u + (unsigned)rintf((a - 2.0f) * 4.0f);
    else code = 24u + (unsigned)rintf((a - 4.0f) * 2.0f);
    return code | (v < 0.f ? 32u : 0u);
}
__device__ void convert_tables(int WV_, const Params& p) {
    const size_t nchunk = (size_t)DEPTH_ * 16384 * 2 * 32;
    for (size_t i = (size_t)LBID() * NTHR + LTID(WV_); i < nchunk; i += (size_t)LGRID() * NTHR) {
        const int c = (int)(i & 31), uvsel = (int)((i >> 5) & 1); const size_t le = i >> 6;
        const float* src = (uvsel ? p.in[10] : p.in[9]) + le * 1024 + c * 32;
        const float sc = uvsel ? V_SCALE : U_SCALE;
        unsigned w[6] = {0u, 0u, 0u, 0u, 0u, 0u};
#pragma unroll
        for (int q4 = 0; q4 < 8; ++q4) {
            const float4 a = ((const float4*)src)[q4];
            const float av[4] = {a.x, a.y, a.z, a.w};
#pragma unroll
            for (int e = 0; e < 4; ++e) { const int idx = q4 * 4 + e, bit = 6 * idx, d = bit >> 5, s = bit & 31; const unsigned code = q_e2m3(av[e] * sc);
                w[d] |= code << s; if (s > 26) w[d + 1] |= code >> (32 - s); }
        }
        uint2* dst = (uint2*)(p.ws + WS_UV + le * ROW6 + uvsel * 768 + c * 24);
        dst[0] = make_uint2(w[0], w[1]); dst[1] = make_uint2(w[2], w[3]); dst[2] = make_uint2(w[4], w[5]);
    }
}
__device__ __forceinline__ v6u_t ld_pk6(const unsigned char* ptr) {
    const uint2 a = ((const uint2*)ptr)[0], b = ((const uint2*)ptr)[1], c = ((const uint2*)ptr)[2];
    const v6u_t pk = {a.x, a.y, b.x, b.y, c.x, c.y};
    return pk;
}
__device__ void peer_fast_phase(int WV_, float* h, bf16* hb, const int* eid, const float* gate, const unsigned char* uv, const float* g1, const float* b1, const float* g, const float* bb, unsigned char* lds) {
    const int tid = LTID(WV_), lane = tid & 63, wave = tid >> 6, l32 = lane & 31, hi = lane >> 5;
    float* pl = (float*)(lds + wave * 16384);
    unsigned char* raw = lds + wave * 16384 + 4096 + lane * 24;
    for (int t = LBID() * NWAVE + wave; t < T_; t += LGRID() * NWAVE) {
        float* hr = h + (size_t)t * 1024 + l32 * 32;
        float x[32], acc[32];
#pragma unroll
        for (int q4 = 0; q4 < 8; ++q4) { const float4 a = ((const float4*)hr)[q4]; x[4 * q4] = a.x; x[4 * q4 + 1] = a.y; x[4 * q4 + 2] = a.z; x[4 * q4 + 3] = a.w; }
        {
            float s = 0.f;
#pragma unroll
            for (int i = 0; i < 32; ++i) s += x[i];
#pragma unroll
            for (int o = 16; o > 0; o >>= 1) s += __shfl_xor(s, o);
            const float mean = s * (1.0f / 1024.0f);
            float s2 = 0.f;
#pragma unroll
            for (int i = 0; i < 32; ++i) { x[i] -= mean; s2 += x[i] * x[i]; }
#pragma unroll
            for (int o = 16; o > 0; o >>= 1) s2 += __shfl_xor(s2, o);
            const float rstd = 1.0f / sqrtf(s2 * (1.0f / 1024.0f) + LN_EPS);
#pragma unroll
            for (int q4 = 0; q4 < 8; ++q4) { const float4 gg = ((const float4*)(g1 + l32 * 32))[q4], cc = ((const float4*)(b1 + l32 * 32))[q4];
                x[4 * q4] = x[4 * q4] * rstd * gg.x + cc.x; x[4 * q4 + 1] = x[4 * q4 + 1] * rstd * gg.y + cc.y; x[4 * q4 + 2] = x[4 * q4 + 2] * rstd * gg.z + cc.z; x[4 * q4 + 3] = x[4 * q4 + 3] * rstd * gg.w + cc.w; }
        }
#pragma unroll
        for (int i = 0; i < 32; ++i) acc[i] = 0.f;
#pragma unroll 1
        for (int batch = 0; batch < 4; ++batch) {
            const int my_eid = eid[(size_t)t * 128 + batch * 32 + l32];
            const float my_gate = gate[(size_t)t * 128 + batch * 32 + l32];
#pragma unroll 1
            for (int grp = 0; grp < 2; ++grp) {
                { u32x4a8_t pa[8]; uint2 pc[8];
#pragma unroll
                  for (int i = 0; i < 8; ++i) { const int id = __shfl(my_eid, 2 * (grp * 8 + i) + hi); const unsigned char* rp = uv + (size_t)id * ROW6 + l32 * 24; pa[i] = *(const u32x4a8_t*)rp; pc[i] = *(const uint2*)(rp + 16); }
#pragma unroll
                  for (int i = 0; i < 8; ++i) { uint2* wp = (uint2*)(raw + i * 1536); wp[0] = make_uint2(pa[i].x, pa[i].y); wp[1] = make_uint2(pa[i].z, pa[i].w); wp[2] = pc[i]; } }
#pragma unroll 1
                for (int i = 0; i < 8; ++i) {
                    const uint2* rp = (const uint2*)(raw + i * 1536); const uint2 a = rp[0], b = rp[1], c = rp[2];
                    const v6u_t pk6 = {a.x, a.y, b.x, b.y, c.x, c.y}; const v32f_t f = __builtin_amdgcn_cvt_scalef32_pk32_f32_fp6(pk6, 1.0f);
                    f32x2_t dv0 = {0.f, 0.f}, dv1 = {0.f, 0.f};
#pragma unroll
                    for (int j = 0; j < 8; ++j) { const f32x2_t fa = {f[2 * j], f[2 * j + 1]}, fb = {f[16 + 2 * j], f[17 + 2 * j]}, xa = {x[2 * j], x[2 * j + 1]}, xb = {x[16 + 2 * j], x[17 + 2 * j]};
                        dv0 = fa * xa + dv0; dv1 = fb * xb + dv1; }
                    pl[(2 * (grp * 8 + i) + hi) * 32 + l32] = (dv0.x + dv0.y) + (dv1.x + dv1.y);
                }
            }
            float d;
            { const float4* pr = (const float4*)(pl + l32 * 32); float4 s4 = pr[0];
#pragma unroll
              for (int i = 1; i < 8; ++i) { const float4 v = pr[i]; s4.x += v.x; s4.y += v.y; s4.z += v.z; s4.w += v.w; }
              d = ((s4.x + s4.y) + (s4.z + s4.w)) * (1.0f / U_SCALE); }
            const float hv = 0.5f * d * (1.0f + erff(d * 0.70710678118654752f)) * my_gate * (1.0f / V_SCALE);
#pragma unroll 1
            for (int grp = 0; grp < 2; ++grp) {
                { u32x4a8_t pa[8]; uint2 pc[8];
#pragma unroll
                  for (int i = 0; i < 8; ++i) { const int id = __shfl(my_eid, 2 * (grp * 8 + i) + hi); const unsigned char* rp = uv + (size_t)id * ROW6 + 768 + l32 * 24; pa[i] = *(const u32x4a8_t*)rp; pc[i] = *(const uint2*)(rp + 16); }
#pragma unroll
                  for (int i = 0; i < 8; ++i) { uint2* wp = (uint2*)(raw + i * 1536); wp[0] = make_uint2(pa[i].x, pa[i].y); wp[1] = make_uint2(pa[i].z, pa[i].w); wp[2] = pc[i]; } }
#pragma unroll 1
                for (int i = 0; i < 8; ++i) {
                    const float c = __shfl(hv, 2 * (grp * 8 + i) + hi);
                    const uint2* rp = (const uint2*)(raw + i * 1536); const uint2 a = rp[0], b = rp[1], cc = rp[2];
                    const v6u_t pk6 = {a.x, a.y, b.x, b.y, cc.x, cc.y}; const v32f_t f = __builtin_amdgcn_cvt_scalef32_pk32_f32_fp6(pk6, 1.0f);
                    const f32x2_t c2 = {c, c};
#pragma unroll
                    for (int j = 0; j < 16; ++j) { const f32x2_t fj = {f[2 * j], f[2 * j + 1]}; f32x2_t aj = {acc[2 * j], acc[2 * j + 1]}; aj = fj * c2 + aj; acc[2 * j] = aj.x; acc[2 * j + 1] = aj.y; }
                }
            }
        }
        float y[32], s = 0.f;
#pragma unroll
        for (int i = 0; i < 32; ++i) { acc[i] += __shfl_xor(acc[i], 32); y[i] = ALPHA * x[i] + acc[i]; s += y[i]; }
#pragma unroll
        for (int o = 16; o > 0; o >>= 1) s += __shfl_xor(s, o);
        const float mean = s * (1.0f / 1024.0f);
        float s2 = 0.f;
#pragma unroll
        for (int i = 0; i < 32; ++i) { y[i] -= mean; s2 += y[i] * y[i]; }
#pragma unroll
        for (int o = 16; o > 0; o >>= 1) s2 += __shfl_xor(s2, o);
        const float rstd = 1.0f / sqrtf(s2 * (1.0f / 1024.0f) + LN_EPS);
        float o[16];
#pragma unroll
        for (int q4 = 0; q4 < 4; ++q4) {
            const float4 gg = ((const float4*)(g + l32 * 32 + hi * 16))[q4], cc = ((const float4*)(bb + l32 * 32 + hi * 16))[q4];
            float ya[4], yb2[4];
#pragma unroll
            for (int e = 0; e < 4; ++e) { ya[e] = y[4 * q4 + e]; yb2[e] = y[16 + 4 * q4 + e]; }
            asm volatile("" : "+v"(ya[0]), "+v"(ya[1]), "+v"(ya[2]), "+v"(ya[3]), "+v"(yb2[0]), "+v"(yb2[1]), "+v"(yb2[2]), "+v"(yb2[3]));
            const float y0 = hi ? yb2[0] : ya[0], y1 = hi ? yb2[1] : ya[1], y2 = hi ? yb2[2] : ya[2], y3 = hi ? yb2[3] : ya[3];
            o[4 * q4] = y0 * rstd * gg.x + cc.x; o[4 * q4 + 1] = y1 * rstd * gg.y + cc.y; o[4 * q4 + 2] = y2 * rstd * gg.z + cc.z; o[4 * q4 + 3] = y3 * rstd * gg.w + cc.w;
            ((float4*)(hr + hi * 16))[q4] = make_float4(o[4 * q4], o[4 * q4 + 1], o[4 * q4 + 2], o[4 * q4 + 3]);
        }
        uint4* hbp = (uint4*)(hb + (size_t)t * 1024 + l32 * 32 + hi * 16);
        hbp[0] = make_uint4(pk2(o[0], o[1]), pk2(o[2], o[3]), pk2(o[4], o[5]), pk2(o[6], o[7]));
        hbp[1] = make_uint4(pk2(o[8], o[9]), pk2(o[10], o[11]), pk2(o[12], o[13]), pk2(o[14], o[15]));
    }
}

__device__ __forceinline__ float pack_pl(float v, unsigned pl) { return __uint_as_float((__float_as_uint(v) & ~127u) | pl); }
__device__ __forceinline__ void ins16(float (&s)[16], float x) {
#pragma unroll
    for (int k = 15; k >= 1; --k) s[k] = __builtin_amdgcn_fmed3f(s[k - 1], x, s[k]);
    s[0] = vmax(s[0], x);
}
template <int D> __device__ __forceinline__ void bitonic_stage(float (&c)[16]) {
#pragma unroll
    for (int i = 0; i < 16; ++i) if ((i & D) == 0) { const float a = vmax(c[i], c[i + D]), b = vmin(c[i], c[i + D]); c[i] = a; c[i + D] = b; }
}
__device__ __forceinline__ int decode_key(unsigned pl) { return (int)(32u * ((pl >> 4) & 3u) + (pl & 3u) + 8u * ((pl >> 2) & 3u) + 4u * ((pl >> 6) & 1u)); }
__device__ void route_fast_phase(int WV_, const bf16* qb, const bf16* skb  , int* eid, float* gate, unsigned char* lds, int pm = -1, int pn = 0) {
    const int tid = LTID(WV_), lane = tid & 63, wave = tid >> 6, r32 = lane & 31, hi = lane >> 5;
    unsigned* lidx = (unsigned*)lds + wave * (64 * 33) + lane * 33;
    const int u_first = (pm >= 0) ? 0 : LBID() * NWAVE + wave, u_end = (pm >= 0) ? 2 : (T_ / 32) * 8, u_step = (pm >= 0) ? 1 : LGRID() * NWAVE;
    for (int unit = u_first; unit < u_end; unit += u_step) {
        const int h = (pm >= 0) ? 2 * pn + unit : (unit & 7), t = ((pm >= 0) ? 8 * pm + wave : (unit >> 3)) * 32 + r32;
        float sl[2][16];
#pragma unroll
        for (int p = 0; p < 2; ++p) {
            bf16x8_t qf[4];
            { const bf16* qp = qb + (size_t)t * 1024 + h * 128 + p * 64 + 8 * hi;
#pragma unroll
              for (int ks = 0; ks < 4; ++ks) qf[ks] = *(const bf16x8_t*)(qp + 16 * ks); }
            float s[16];
#pragma unroll
            for (int k = 0; k < 16; ++k) s[k] = -INFINITY;
            const bf16* skp = skb + ((size_t)(h * 2 + p) * 128 + r32) * 64 + 8 * hi;
#pragma unroll
            for (int kt = 0; kt < 4; ++kt) {
                f32x16_t acc;
#pragma unroll
                for (int r = 0; r < 16; ++r) acc[r] = 0.f;
#pragma unroll
                for (int ks = 0; ks < 4; ++ks) { const bf16x8_t a = *(const bf16x8_t*)(skp + (size_t)kt * 32 * 64 + 16 * ks); acc = __builtin_amdgcn_mfma_f32_32x32x16_bf16(a, qf[ks], acc, 0, 0, 0); }
#pragma unroll
                for (int r = 0; r < 16; ++r) ins16(s, pack_pl(acc[r], (unsigned)(kt * 16 + r)));
            }
            const unsigned hb = (unsigned)hi << 6;
#pragma unroll
            for (int k = 0; k < 16; ++k) s[k] = __uint_as_float(__float_as_uint(s[k]) | hb);
            float c[16];
#pragma unroll
            for (int k = 0; k < 16; ++k) c[k] = vmax(s[k], __shfl_xor(s[15 - k], 32));
            bitonic_stage<8>(c); bitonic_stage<4>(c); bitonic_stage<2>(c); bitonic_stage<1>(c);
#pragma unroll
            for (int k = 0; k < 16; ++k) { sl[p][k] = c[k]; lidx[p * 16 + k] = (unsigned)decode_key(__float_as_uint(c[k]) & 127u); }
        }
        float w[16];
#pragma unroll
        for (int k = 0; k < 16; ++k) w[k] = -INFINITY;
#pragma unroll
        for (int i = 0; i < 16; ++i)
#pragma unroll
            for (int j = 0; j < 16; ++j)
                if ((i + 1) * (j + 1) <= 16) { const float v = sl[0][i] + sl[1][j]; ins16(w, __uint_as_float((__float_as_uint(v) & ~255u) | (unsigned)(i * 16 + j))); }
        float e[16], sum = 0.f;
#pragma unroll
        for (int k = 0; k < 16; ++k) { e[k] = expf(w[k] - w[0]); sum += e[k]; }
        const float inv = 1.0f / sum;
        int ide[8]; float gte[8];
#pragma unroll
        for (int k = 0; k < 8; ++k) {
            float wa = w[k], wb = w[8 + k], ea = e[k], eb = e[8 + k];
            asm volatile("" : "+v"(wa), "+v"(wb), "+v"(ea), "+v"(eb));
            const float wv = hi ? wb : wa;
            const unsigned pl = __float_as_uint(wv) & 255u;
            ide[k] = (int)(lidx[pl >> 4] * 128u + lidx[16 + (pl & 15u)]);
            gte[k] = (hi ? eb : ea) * inv;
        }
        int* ep = eid + (size_t)t * 128 + h * 16 + hi * 8; float* gp = gate + (size_t)t * 128 + h * 16 + hi * 8;
        *(int4*)ep = make_int4(ide[0], ide[1], ide[2], ide[3]); *(int4*)(ep + 4) = make_int4(ide[4], ide[5], ide[6], ide[7]);
        *(float4*)gp = make_float4(gte[0], gte[1], gte[2], gte[3]); *(float4*)(gp + 4) = make_float4(gte[4], gte[5], gte[6], gte[7]);
    }
}

typedef float f32x4_t __attribute__((ext_vector_type(4)));
typedef __bf16 bf16x2v __attribute__((ext_vector_type(2)));
__device__ __forceinline__ float dot2bf(unsigned a, unsigned b, float c) { return __builtin_amdgcn_fdot2_f32_bf16(__builtin_bit_cast(bf16x2v, a), __builtin_bit_cast(bf16x2v, b), c, false); }
__device__ __forceinline__ void cnt_gt(int& cnt, unsigned a, unsigned b) { asm("v_cmp_gt_u32_e32 vcc, %1, %2\n\tv_addc_co_u32_e32 %0, vcc, 0, %0, vcc" : "+v"(cnt) : "v"(a), "v"(b) : "vcc"); }
__device__ __forceinline__ void cnt_eq(int& cnt, unsigned a, unsigned b) { asm("v_cmp_eq_u32_e32 vcc, %1, %2\n\tv_addc_co_u32_e32 %0, vcc, 0, %0, vcc" : "+v"(cnt) : "v"(a), "v"(b) : "vcc"); }
__device__ __forceinline__ unsigned flag_gt(unsigned a, unsigned b) { unsigned r; asm("v_cmp_gt_u32_e32 vcc, %1, %2\n\tv_cndmask_b32_e64 %0, 0, 1, vcc" : "=v"(r) : "v"(a), "v"(b) : "vcc"); return r; }
__device__ __forceinline__ unsigned flag_eq(unsigned a, unsigned b) { unsigned r; asm("v_cmp_eq_u32_e32 vcc, %1, %2\n\tv_cndmask_b32_e64 %0, 0, 1, vcc" : "=v"(r) : "v"(a), "v"(b) : "vcc"); return r; }
__device__ __forceinline__ void cnt_ge(int& cnt, unsigned key, unsigned cand) { asm("v_cmp_ge_u32_e32 vcc, %1, %2\n\tv_addc_co_u32_e32 %0, vcc, 0, %0, vcc" : "+v"(cnt) : "v"(key), "v"(cand) : "vcc"); }

typedef __attribute__((address_space(3))) unsigned lds_u32;
template <int SHIFT> __device__ __forceinline__ unsigned radix_pass(const unsigned (&key)[64], unsigned pre, lds_u32* hist, int lane, int& need, int jlim, unsigned L) {
    typedef unsigned u32x4v __attribute__((ext_vector_type(4)));
    typedef __attribute__((address_space(3))) u32x4v lds_u32x4;
    { const u32x4v z4 = {0u, 0u, 0u, 0u};
#pragma unroll
      for (int i = 0; i < 8; ++i) ((lds_u32x4*)(hist + lane * 32))[i] = z4; }
    const unsigned hb = (unsigned)(size_t)hist + 4u * (unsigned)(lane & 7);
    const unsigned one = 1u;
    asm volatile("" ::: "memory");
#pragma unroll
    for (int j4 = 0; j4 < 16; ++j4) {
        if (4 * j4 <= jlim) {
            bool grp = true;
            if (SHIFT <= 8) {
                const bool any = ((key[4 * j4] >> (SHIFT + 8)) == pre) | ((key[4 * j4 + 1] >> (SHIFT + 8)) == pre) | ((key[4 * j4 + 2] >> (SHIFT + 8)) == pre) | ((key[4 * j4 + 3] >> (SHIFT + 8)) == pre);
                grp = __ballot(any) != 0ull;
            }
            if (grp) {
#pragma unroll
                for (int e = 0; e < 4; ++e) { const int j = 4 * j4 + e;
                    const unsigned addr = hb + (((key[j] >> SHIFT) & 255u) << 5);
                    unsigned long long sv;
                    if (SHIFT == 24) asm volatile("v_cmp_ge_u32_e32 vcc, %1, %2\n\ts_and_saveexec_b64 %0, vcc\n\tds_add_u32 %3, %4\n\ts_mov_b64 exec, %0" : "=&s"(sv) : "v"(key[j]), "v"(L), "v"(addr), "v"(one) : "vcc", "memory");
                    else { const unsigned t = key[j] >> ((SHIFT + 8) & 31);
                        asm volatile("v_cmp_eq_u32_e32 vcc, %1, %2\n\ts_and_saveexec_b64 %0, vcc\n\tds_add_u32 %3, %4\n\ts_mov_b64 exec, %0" : "=&s"(sv) : "v"(t), "v"(pre), "v"(addr), "v"(one) : "vcc", "memory"); }
                }
            }
        }
    }
    asm volatile("s_waitcnt lgkmcnt(0)" ::: "memory");
    unsigned dsum[4]; unsigned sumL = 0u;
#pragma unroll
    for (int i = 0; i < 4; ++i) { const u32x4v v0 = ((const lds_u32x4*)(hist + lane * 32))[2 * i], v1 = ((const lds_u32x4*)(hist + lane * 32))[2 * i + 1];
        dsum[i] = ((v0.x + v0.y) + (v0.z + v0.w)) + ((v1.x + v1.y) + (v1.z + v1.w)); sumL += dsum[i]; }
    unsigned incl = sumL;
#pragma unroll
    for (int o = 1; o < 64; o <<= 1) { const unsigned t = (unsigned)__shfl_down((int)incl, o); if (lane + o < 64) incl += t; }
    const unsigned above = incl - sumL;
    const bool own = (above < (unsigned)need) && ((unsigned)need <= above + sumL);
    const int owner = __ffsll((long long)__ballot(own)) - 1;
    unsigned acc = above; int sel = -1; unsigned cab = 0u;
#pragma unroll
    for (int i = 3; i >= 0; --i) { const unsigned c = dsum[i]; const bool hit = (sel < 0) && (acc + c >= (unsigned)need); cab = hit ? acc : cab; sel = hit ? i : sel; acc += c; }
    const int ow = owner < 0 ? 0 : owner;
    const unsigned digit = (unsigned)__builtin_amdgcn_readlane(sel, ow) + (unsigned)(4 * ow);
    need -= (int)__builtin_amdgcn_readlane((int)cab, ow);
    return digit;
}
#ifndef TS_SEL
#define TS_SEL 0
#endif
#define ITS_B() do { if (TS_SEL >= 20 && TS_SEL <= 25 && WV_ == 0 && LANEID() == 0) ((volatile __attribute__((address_space(3))) unsigned long long*)((__attribute__((address_space(3))) unsigned char*)lds + 147456 - 16 - 32))[0] = __builtin_amdgcn_s_memrealtime(); } while (0)
#define ITS_E(k) do { if ((k) == TS_SEL && WV_ == 0 && LANEID() == 0) { volatile __attribute__((address_space(3))) unsigned long long* w_ = (volatile __attribute__((address_space(3))) unsigned long long*)((__attribute__((address_space(3))) unsigned char*)lds + 147456 - 16 - 32); w_[1] += __builtin_amdgcn_s_memrealtime() - w_[0]; } } while (0)
__device__ void index_fast_phase(int WV_, const bf16* P, unsigned char* mask, float* kmean, float* scratch_all, unsigned* qctr, unsigned char* lds) {
    const int tid = LTID(WV_), lane = tid & 63, wave = tid >> 6, bid = LBID(), G = LGRID();
    float* s_part = (float*)lds;
    ITS_B();
    for (int k = bid; k < 256; k += G) {
        const int b = k >> 6, h = (k >> 4) & 3, blk = k & 15;
        const bf16* kp = P + (size_t)(b * S_ + blk * 256 + wave * 32) * NP + C_KC + h * 64 + lane;
        float a = 0.f;
#pragma unroll 8
        for (int j = 0; j < 32; ++j) a += bf2f(kp[(size_t)j * NP]);
        __syncthreads();
        s_part[wave * 64 + lane] = a;
        __syncthreads();
        if (tid < 64) { float s = 0.f;
#pragma unroll
            for (int w = 0; w < 8; ++w) s += s_part[w * 64 + tid];
            kmean[((b * 4 + h) * 16 + blk) * 64 + tid] = s * (1.0f / 256.0f); }
    }
    ITS_E(22);
    float* scr = scratch_all + (size_t)bid * (16 * 4096);
    const int lq = lane & 15, g4 = lane >> 4;
    volatile __attribute__((address_space(3))) unsigned* qslot = (volatile __attribute__((address_space(3))) unsigned*)((__attribute__((address_space(3))) unsigned char*)lds + 69632);
    unsigned ticket = (unsigned)bid;
    for (;;) {
        if (ticket >= 1024u) break;
        const int ui = (int)ticket;
        unsigned nticket = 0u;
        if (tid == 0) nticket = (unsigned)G + __hip_atomic_fetch_add(qctr, 1u, __ATOMIC_RELAXED, __HIP_MEMORY_SCOPE_AGENT);
        const int b = ui >> 8, k = ui & 255, tile = (b & 1) ? 255 - k : k, q0 = tile * 16;
        const bf16* Pb = P + (size_t)b * S_ * NP;
        const int ntiles = tile + 1;
        ITS_B();
        bf16x8_t qf[8]; float wi[8];
        { const bf16* qp = Pb + (size_t)(q0 + lq) * NP + C_QI + 8 * g4;
#pragma unroll
          for (int h = 0; h < 8; ++h) qf[h] = *(const bf16x8_t*)(qp + 32 * h);
          const uint4 wv = *(const uint4*)(Pb + (size_t)(q0 + lq) * NP + C_WI); unpack8(wv, wi); }
        bf16x8_t qch, qcl;
        { typedef unsigned u32x4_t __attribute__((ext_vector_type(4)));
          float qc[8];
#pragma unroll
          for (int i = 0; i < 8; ++i) qc[i] = 0.f;
#pragma unroll
          for (int h = 0; h < 8; ++h) { const u32x4_t w4 = __builtin_bit_cast(u32x4_t, qf[h]);
#pragma unroll
              for (int i = 0; i < 4; ++i) { qc[2 * i] += wi[h] * __uint_as_float(w4[i] << 16); qc[2 * i + 1] += wi[h] * __uint_as_float(w4[i] & 0xffff0000u); } }
          u32x4_t hi4, lo4;
#pragma unroll
          for (int i = 0; i < 4; ++i) { const unsigned hw = cvtpk(qc[2 * i], qc[2 * i + 1]); hi4[i] = hw;
              lo4[i] = cvtpk(qc[2 * i] - __uint_as_float(hw << 16), qc[2 * i + 1] - __uint_as_float(hw & 0xffff0000u)); }
          qch = __builtin_bit_cast(bf16x8_t, hi4); qcl = __builtin_bit_cast(bf16x8_t, lo4); }
        {
            bf16x8_t afn = *(const bf16x8_t*)(Pb + (size_t)((wave < ntiles ? wave : 0) * 16 + lq) * NP + C_KI + 8 * g4);
            for (int kt = wave; kt < ntiles; kt += NWAVE) {
                const bf16x8_t af = afn;
                { const int ktn = (kt + NWAVE < ntiles) ? kt + NWAVE : kt; afn = *(const bf16x8_t*)(Pb + (size_t)(ktn * 16 + lq) * NP + C_KI + 8 * g4); }
                f32x4_t a[8];
                const f32x4_t z = {0.f, 0.f, 0.f, 0.f};
#pragma unroll
                for (int h = 0; h < 8; ++h) a[h] = __builtin_amdgcn_mfma_f32_16x16x32_bf16(af, qf[h], z, 0, 0, 0);
                f32x4_t sc = __builtin_amdgcn_mfma_f32_16x16x32_bf16(af, qch, z, 0, 0, 0);
                sc = __builtin_amdgcn_mfma_f32_16x16x32_bf16(af, qcl, sc, 0, 0, 0);
                __builtin_amdgcn_sched_barrier(0);
#pragma unroll
                for (int h = 0; h < 8; ++h)
#pragma unroll
                    for (int r = 0; r < 4; ++r) sc[r] = __builtin_fmaf(__builtin_fabsf(a[h][r]), wi[h], sc[r]);
#pragma unroll
                for (int r = 0; r < 4; ++r) { sc[r] *= 0.03125f; if (sc[r] == 0.f) sc[r] = 0.f; }
                *(f32x4_t*)(scr + (size_t)lq * 4096 + kt * 16 + 4 * g4) = sc;
            }
        }
        __threadfence_block();
        __syncthreads();
        __threadfence_block();
        ITS_E(20); ITS_B();
        lds_u32* hist = (lds_u32*)((__attribute__((address_space(3))) unsigned char*)lds + 2048) + wave * 2048;
#pragma unroll 1
        for (int qi = 0; qi < 2; ++qi) {
            const int ql = 2 * wave + qi, q = q0 + ql;
            const float* row = scr + (size_t)ql * 4096 + lane;
            const int qrel = q - lane * 64;
            const int jlim = __builtin_amdgcn_readfirstlane(q >> 6);
            const int jmax = (q - lane) >> 6;
            unsigned wlo = 0u, whi = 0u;
            if (q + 1 > 256) {
                unsigned key[64];
#pragma unroll
                for (int j4 = 0; j4 < 16; ++j4) {
                    if (4 * j4 <= jlim) {
#pragma unroll
                        for (int e = 0; e < 4; ++e) key[4 * j4 + e] = __float_as_uint(row[64 * (4 * j4 + e)]);
                    } else {
#pragma unroll
                        for (int e = 0; e < 4; ++e) key[4 * j4 + e] = 0x7fffffffu;
                    }
                }
                unsigned t0 = 0u, t1 = 0u, t2 = 0u, t3 = 0u;
#pragma unroll
                for (int j4 = 0; j4 < 16; ++j4) {
                    if (4 * j4 <= jlim) {
#pragma unroll
                        for (int e = 0; e < 4; ++e) { const int j = 4 * j4 + e; const unsigned u = key[j];
                            const unsigned t = u ^ ((unsigned)((int)u >> 31) | 0x80000000u); const unsigned inval = (unsigned)((jmax - j) >> 31); const unsigned x = t & ~inval; key[j] = x;
                            unsigned n1, n2, n3;
                            asm("v_med3_u32 %0, %1, %2, %3" : "=v"(n3) : "v"(t2), "v"(t3), "v"(x));
                            asm("v_med3_u32 %0, %1, %2, %3" : "=v"(n2) : "v"(t1), "v"(t2), "v"(x));
                            asm("v_med3_u32 %0, %1, %2, %3" : "=v"(n1) : "v"(t0), "v"(t1), "v"(x));
                            t0 = t0 > x ? t0 : x; t1 = n1; t2 = n2; t3 = n3; }
                    } else {
#pragma unroll
                        for (int e = 0; e < 4; ++e) key[4 * j4 + e] = 0u;
                    }
                }
                unsigned L = t3;
#pragma unroll
                for (int o = 32; o > 0; o >>= 1) { const unsigned v = (unsigned)__shfl_xor((int)L, o); L = v < L ? v : L; }
                L = L > 1u ? L : 1u;
                ITS_E(23); ITS_B();
                int need = 256;
                const unsigned d1 = radix_pass<24>(key, 0u, hist, lane, need, jlim, L);
                const unsigned d2 = radix_pass<16>(key, d1, hist, lane, need, jlim, L);
                const unsigned d3 = radix_pass<8>(key, (d1 << 8) | d2, hist, lane, need, jlim, L);
                const unsigned d4 = radix_pass<0>(key, (d1 << 16) | (d2 << 8) | d3, hist, lane, need, jlim, L);
                const unsigned prefix = (d1 << 24) | (d2 << 16) | (d3 << 8) | d4;
                ITS_E(24); ITS_B();
                int ceq = 0;
#pragma unroll
                for (int j = 0; j < 64; ++j) cnt_eq(ceq, key[j], prefix);
                ceq = wave_sum_i(ceq);
                int X = 4096;
                if (ceq != need) {
                    int X0 = 0;
#pragma unroll 1
                    for (int bit = 11; bit >= 0; --bit) {
                        const int c = X0 | (1 << bit);
                        int cnt = 0; const int crel = (c - lane + 63) >> 6;
#pragma unroll
                        for (int j = 0; j < 64; ++j) cnt_eq(cnt, (key[j] ^ prefix) | ~(unsigned)((j - crel) >> 31), 0u);
                        cnt = wave_sum_i(cnt);
                        if (cnt < need) X0 = c;
                    }
                    X = X0 + 1;
                }
                const int xrel = (X - lane + 63) >> 6;
#pragma unroll
                for (int j4 = 0; j4 < 16; ++j4) {
                    if (4 * j4 <= jlim) {
#pragma unroll
                        for (int e = 0; e < 4; ++e) { const int j = 4 * j4 + e;
                            const bool sel = (key[j] > prefix) || (key[j] == prefix && j < xrel);
                            const unsigned long long bm = __ballot(sel);
                            asm("v_writelane_b32 %0, %1, %2" : "+v"(wlo) : "s"((unsigned)bm), "n"(j));
                            asm("v_writelane_b32 %0, %1, %2" : "+v"(whi) : "s"((unsigned)(bm >> 32)), "n"(j)); }
                    }
                }
            } else {
#pragma unroll
                for (int j = 0; j < 32; ++j) { wlo |= (~(unsigned)((qrel - j) >> 31) & 1u) << j; whi |= (~(unsigned)((qrel - 32 - j) >> 31) & 1u) << j; }
            }
            ((uint2*)(mask + (size_t)(b * S_ + q) * 512))[lane] = make_uint2(wlo, whi);
            ITS_E(25); ITS_B();
        }
        ITS_E(21);
        if (tid == 0) qslot[0] = nticket;
        __syncthreads();
        ticket = qslot[0];
    }
}

constexpr int MG_P = 72;
constexpr int MG_TILE_BYTES = 128 * MG_P * 2;
__device__ void merge_fast_phase(int WV_, const bf16* P, const bf16* ys, const bf16* wbt  , bf16* merged, unsigned char* lds) {
    const int tid = LTID(WV_), lane = tid & 63, wave = tid >> 6, r32 = lane & 31, hi = lane >> 5, wt = wave & 3, wd = wave >> 2;
    const int srow0 = tid >> 3, sch = tid & 7;
    for (int tile = LBID(); tile < 1024; tile += LGRID()) {
        const int tok0 = (tile >> 3) * 128, d0 = (tile & 7) * 128;
        f32x16_t mer[2], acc[2];
#pragma unroll
        for (int r = 0; r < 16; ++r) { mer[0][r] = 0.f; mer[1][r] = 0.f; acc[0][r] = 0.f; acc[1][r] = 0.f; }
        uint4 RW00, RW01, RW10, RW11, RY00, RY01, RY10, RY11, RG0, RG1, RG2, RG3;
        bf16* gl = (bf16*)(lds + 4 * MG_TILE_BYTES);
        const int grow = tid >> 4, gch = tid & 15;
#define MG_GLOAD(st_, R_) do { const int n_ = (st_) >> 2, kc_ = (st_) & 3; \
            RW##R_##0 = *(const uint4*)(wbt + ((size_t)n_ * 1024 + d0 + srow0) * 256 + kc_ * 64 + sch * 8); \
            RW##R_##1 = *(const uint4*)(wbt + ((size_t)n_ * 1024 + d0 + srow0 + 64) * 256 + kc_ * 64 + sch * 8); \
            RY##R_##0 = *(const uint4*)(ys + (size_t)(tok0 + srow0) * 1024 + n_ * 256 + kc_ * 64 + sch * 8); \
            RY##R_##1 = *(const uint4*)(ys + (size_t)(tok0 + srow0 + 64) * 1024 + n_ * 256 + kc_ * 64 + sch * 8); } while (0)
#define MG_SSTORE(buf_, R_) do { bf16* wl_ = (bf16*)(lds + (buf_) * 2 * MG_TILE_BYTES); bf16* yl_ = (bf16*)(lds + (buf_) * 2 * MG_TILE_BYTES + MG_TILE_BYTES); \
            *(uint4*)(wl_ + srow0 * MG_P + sch * 8) = RW##R_##0; *(uint4*)(wl_ + (srow0 + 64) * MG_P + sch * 8) = RW##R_##1; \
            *(uint4*)(yl_ + srow0 * MG_P + sch * 8) = RY##R_##0; *(uint4*)(yl_ + (srow0 + 64) * MG_P + sch * 8) = RY##R_##1; } while (0)
        __syncthreads();
        MG_GLOAD(0, 0); MG_GLOAD(1, 1);
        MG_SSTORE(0, 0);
        __syncthreads();
#define MG_STAGE(PAR_, OTH_) do { const int buf = PAR_; \
            if (st + 2 < 16) MG_GLOAD(st + 2, PAR_); \
            if ((st & 3) == 1) { const bf16* gsrc = P + (size_t)(tok0 + grow) * NP + C_G + (st >> 2) * 1024 + d0 + gch * 8; \
                RG0 = *(const uint4*)gsrc; RG1 = *(const uint4*)(gsrc + (size_t)32 * NP); RG2 = *(const uint4*)(gsrc + (size_t)64 * NP); RG3 = *(const uint4*)(gsrc + (size_t)96 * NP); } \
            const bf16* wl = (const bf16*)(lds + buf * 2 * MG_TILE_BYTES); const bf16* yl = (const bf16*)(lds + buf * 2 * MG_TILE_BYTES + MG_TILE_BYTES); \
            _Pragma("unroll") for (int ks = 0; ks < 4; ++ks) { \
                const bf16x8_t bq = *(const bf16x8_t*)(yl + (32 * wt + r32) * MG_P + 16 * ks + 8 * hi); \
                const bf16x8_t a0 = *(const bf16x8_t*)(wl + (64 * wd + r32) * MG_P + 16 * ks + 8 * hi); \
                const bf16x8_t a1 = *(const bf16x8_t*)(wl + (64 * wd + 32 + r32) * MG_P + 16 * ks + 8 * hi); \
                acc[0] = __builtin_amdgcn_mfma_f32_32x32x16_bf16(a0, bq, acc[0], 0, 0, 0); \
                acc[1] = __builtin_amdgcn_mfma_f32_32x32x16_bf16(a1, bq, acc[1], 0, 0, 0); } \
            if ((st & 3) == 3) { \
                const int n = st >> 2; \
                const bf16* gp = gl + (32 * wt + r32) * 136 + 64 * wd + 4 * hi; (void)n; \
                _Pragma("unroll") for (int dt = 0; dt < 2; ++dt) \
                _Pragma("unroll") for (int g = 0; g < 4; ++g) { \
                        const uint2 gv = *(const uint2*)(gp + 32 * dt + 8 * g); \
                        const float g0 = __uint_as_float(gv.x << 16), g1 = __uint_as_float(gv.x & 0xffff0000u), g2 = __uint_as_float(gv.y << 16), g3 = __uint_as_float(gv.y & 0xffff0000u); \
                        mer[dt][4 * g + 0] += acc[dt][4 * g + 0] * g0; \
                        mer[dt][4 * g + 1] += acc[dt][4 * g + 1] * g1; \
                        mer[dt][4 * g + 2] += acc[dt][4 * g + 2] * g2; \
                        mer[dt][4 * g + 3] += acc[dt][4 * g + 3] * g3; } \
                _Pragma("unroll") for (int r = 0; r < 16; ++r) { acc[0][r] = 0.f; acc[1][r] = 0.f; } } \
            if (st + 1 < 16) MG_SSTORE(OTH_, OTH_); \
            if ((st & 3) == 2) { *(uint4*)(gl + grow * 136 + gch * 8) = RG0; *(uint4*)(gl + (grow + 32) * 136 + gch * 8) = RG1; *(uint4*)(gl + (grow + 64) * 136 + gch * 8) = RG2; *(uint4*)(gl + (grow + 96) * 136 + gch * 8) = RG3; } \
            __syncthreads(); } while (0)
#pragma unroll 1
        for (int st2 = 0; st2 < 16; st2 += 2) { { const int st = st2; MG_STAGE(0, 1); } { const int st = st2 + 1; MG_STAGE(1, 0); } }
#undef MG_STAGE
#undef MG_GLOAD
#undef MG_SSTORE
        bf16* mp = merged + (size_t)(tok0 + 32 * wt + r32) * 1024 + d0 + 64 * wd + 4 * hi;
#pragma unroll
        for (int dt = 0; dt < 2; ++dt)
#pragma unroll
            for (int g = 0; g < 4; ++g)
                *(uint2*)(mp + 32 * dt + 8 * g) = make_uint2(cvtpk(mer[dt][4 * g], mer[dt][4 * g + 1]), cvtpk(mer[dt][4 * g + 2], mer[dt][4 * g + 3]));
    }
}
#define LAS __attribute__((address_space(3)))
#define XB_TMO      128
#define XB_XCNT(j)  (256  + 64 * (j))
#define XB_XSUB(j)  (1280 + 64 * (j))
#define XB_XGEN(j)  (2304 + 64 * (j))
#define XB_TOP      3328
#define XB_TOPGEN   3392
#define XCD_BAR_WORDS 3456
#define XB_SPIN_CAP (1u << 18)

__device__ __forceinline__ unsigned xb_ld(unsigned* p)              { return __hip_atomic_load(p, __ATOMIC_RELAXED, __HIP_MEMORY_SCOPE_AGENT); }
__device__ __forceinline__ unsigned xb_add(unsigned* p, unsigned v) { return __hip_atomic_fetch_add(p, v, __ATOMIC_RELAXED, __HIP_MEMORY_SCOPE_AGENT); }
__device__ __forceinline__ unsigned xb_xcc_id() { return (unsigned)__builtin_amdgcn_s_getreg((3 << 11) | 20) & 0xFu; }
#define XB_SPIN(cond, bar) do { unsigned _sp = 0; while (cond) { __builtin_amdgcn_s_sleep(1); \
    if ((++_sp & 255u) == 0u) { if (xb_ld(&(bar)[XB_TMO])) break; if (_sp > XB_SPIN_CAP) { atomicAdd(&(bar)[XB_TMO], 1u); break; } } } } while (0)

struct XcdBarrier {
    unsigned* bar; unsigned x;
    volatile LAS unsigned* st;
};

__device__ __forceinline__ XcdBarrier xcd_barrier_post(unsigned* bar, volatile LAS unsigned* st) {
    XcdBarrier b; b.bar = bar; b.x = xb_xcc_id(); b.st = st;
    if (threadIdx.x == 0) (void)xb_add(&bar[XB_XCNT(b.x)], 1u);
    return b;
}
__device__ __forceinline__ void xcd_barrier_complete(unsigned* bar, unsigned x, unsigned& nloc, unsigned& nx) {
    const unsigned G = gridDim.x * gridDim.y * gridDim.z;
    unsigned sum, cnt, mine, sp = 0u;
    for (;;) {
        sum = 0u; cnt = 0u; mine = 0u;
#pragma unroll
        for (unsigned j = 0; j < 16; ++j) { const unsigned c = xb_ld(&bar[XB_XCNT(j)]); sum += c; cnt += (c > 0u) ? 1u : 0u; mine = (j == x) ? c : mine; }
        if (sum == G) break;
        __builtin_amdgcn_s_sleep(1);
        if ((++sp & 255u) == 0u) { if (xb_ld(&bar[XB_TMO])) break; if (sp > XB_SPIN_CAP) { atomicAdd(&bar[XB_TMO], 1u); break; } }
    }
    nloc = mine > 0u ? mine : 1u; nx = cnt > 0u ? cnt : 1u;
}

__device__ __forceinline__ void xcd_barrier(const XcdBarrier& b, int wv_) {
    asm volatile("s_waitcnt vmcnt(0)" ::: "memory");
    __syncthreads();
    if (wv_ == 0 && LANEID() == 0) {
        unsigned* bar = b.bar;
        __builtin_amdgcn_s_waitcnt(0);
        unsigned nloc = b.st[0], nx = b.st[1];
        if (nloc == 0u) { xcd_barrier_complete(bar, b.x, nloc, nx); b.st[0] = nloc; b.st[1] = nx; }
        const unsigned old = xb_add(&bar[XB_XSUB(b.x)], 1u);
        const unsigned gen = old / nloc;
        if (old + 1u == (gen + 1u) * nloc) {
            __builtin_amdgcn_fence(__ATOMIC_RELEASE, "agent");
            asm volatile("s_waitcnt vmcnt(0)" ::: "memory");
            const unsigned og = xb_add(&bar[XB_TOP], 1u);
            const unsigned tg = og / nx;
            if (og + 1u == (tg + 1u) * nx) xb_add(&bar[XB_TOPGEN], 1u);
            else XB_SPIN(xb_ld(&bar[XB_TOPGEN]) == tg, bar);
            __builtin_amdgcn_fence(__ATOMIC_ACQUIRE, "agent");
            xb_add(&bar[XB_XGEN(b.x)], 1u);
            asm volatile("s_waitcnt vmcnt(0)" ::: "memory");
        } else {
            XB_SPIN(xb_ld(&bar[XB_XGEN(b.x)]) == gen, bar);
            __builtin_amdgcn_fence(__ATOMIC_ACQUIRE, "agent");
            asm volatile("s_waitcnt vmcnt(0)" ::: "memory");
        }
    }
    __syncthreads();
}

enum { PH_PRO = 0, PH_GIN, PH_INDEX, PH_ATTN, PH_MERGE, PH_GOUT, PH_LN1, PH_GQ, PH_ROUTE, PH_PEER };
template <int PH> __device__ __forceinline__ void run_phase(int WV_, const Params& p_unused, int l, unsigned char* lds_raw) {
    size_t kaoff_ = 0; asm volatile("" : "+s"(kaoff_));
    typedef const __attribute__((address_space(4))) char* kaptr_t;
    const __attribute__((address_space(4))) Params& p = *(const __attribute__((address_space(4))) Params*)((kaptr_t)__builtin_amdgcn_kernarg_segment_ptr() + kaoff_);
    float* sm = (float*)lds_raw;
    size_t wsoff_ = 0; asm volatile("" : "+s"(wsoff_));
    unsigned char* ws = p.ws + wsoff_;
    float* hbuf = p.out;
    bf16* hb = (bf16*)(ws + WS_HB);
    bf16* P = (bf16*)(ws + WS_P);
    bf16* ys = (bf16*)(ws + WS_YS);
    bf16* mrg = (bf16*)(ws + WS_MRG);
    float* mix = (float*)(ws + WS_MIX);
    float* qb = (float*)(ws + WS_Q);
    unsigned char* mask = ws + WS_MASK;
    int* eid = (int*)(ws + WS_EID);
    float* gate = (float*)(ws + WS_GATE);
    float* kmean = (float*)(ws + WS_KMEAN);
    const float* hin = (l == 0) ? p.in[0] : hbuf;
    if (PH == PH_PRO) { Params pc; for (int i = 0; i < 13; ++i) pc.in[i] = p.in[i]; pc.out = p.out; pc.ws = ws;
        prologue_phase(WV_, pc, sm); convert_tables(WV_, pc);
        for (int i = LBID() * NTHR + LTID(WV_); i < DEPTH_ * 8 * 2 * 128 * 64 / 4; i += LGRID() * NTHR) { const float4 v = ((const float4*)p.in[8])[i]; ((uint2*)(ws + WS_SKB))[i] = make_uint2(pk2(v.x, v.y), pk2(v.z, v.w)); } if (LBID() < 2) build_unit_table((unsigned*)(ws + WS_CTL) + 1024, LBID() * NTHR + LTID(WV_)); }
    else if (PH == PH_GIN) {
        pg8::Gemm g{hb, (const bf16*)(ws + WS_WIN_T + l * WIN_T_BYTES), T_, NP, 1024};
        pg8::StaticOrder S; S.init(T_, NP, (int)LGRID(), (int)LBID());
        pg8::EpiBf16Sig E{P, NP, C_G};
        pg8::gemm_phase<pg8::EpiBf16Sig, pg8::StaticOrder, true, true>(WV_, (PG8_LAS unsigned char*)lds_raw, g, S, E);
    }
    else if (PH == PH_INDEX) index_fast_phase(WV_, P, mask, kmean, (float*)(ws + WS_YS), (unsigned*)(ws + WS_CTL) + 64 * l + 16, lds_raw);
    else if (PH == PH_ATTN) attn_fast_phase(WV_, P, mask, kmean, p.in[4] + l * 4, ys, (const unsigned*)(ws + WS_CTL) + 1024, (unsigned*)(ws + WS_CTL) + 64 * l, lds_raw);
    else if (PH == PH_MERGE) merge_fast_phase(WV_, P, ys, (const bf16*)(ws + WS_WBR_T) + (size_t)l * 4 * 1024 * 256, mrg, lds_raw);
    else if (PH == PH_GOUT) {
        pg8::Gemm g{mrg, (const bf16*)(ws + WS_WOUT_T) + (size_t)l * 1024 * 1024, T_, 1024, 1024};
        pg8::StaticOrder S; S.init(T_, 1024, (int)LGRID(), (int)LBID());
        pg8::EpiResY E{hin, hbuf, hb, (float*)(ws + WS_STATS) + (size_t)l * T_ * 2, ALPHA};
        pg8::gemm_phase<pg8::EpiResY, pg8::StaticOrder, true, true>(WV_, (PG8_LAS unsigned char*)lds_raw, g, S, E);
    }
    else if (PH == PH_GQ) {
        pg8::Gemm g{hb, (const bf16*)(ws + WS_WQ_T) + (size_t)l * 1024 * 1024, T_, 1024, 1024};
        pg8::StaticOrder S; S.init(T_, 1024, (int)LGRID(), (int)LBID());
        pg8::EpiLnFold E{(bf16*)qb, (const float*)(ws + WS_STATS) + (size_t)l * T_ * 2, (const float*)(ws + WS_COLS) + l * 2048, (const float*)(ws + WS_COLS) + l * 2048 + 1024, LN_EPS};
        pg8::gemm_phase<pg8::EpiLnFold, pg8::StaticOrder, true, true>(WV_, (PG8_LAS unsigned char*)lds_raw, g, S, E);
        pg8::Unit u0;
        if (LGRID() == 256 && S.next(0, u0)) {
            asm volatile("s_waitcnt vmcnt(0)" ::: "memory"); __syncthreads();
            route_fast_phase(WV_, (const bf16*)qb, (const bf16*)(ws + WS_SKB) + (size_t)l * 8 * 2 * 128 * 64, eid, gate, lds_raw, u0.pm, u0.pn);
        }
    }
    else if (PH == PH_ROUTE) { if (LGRID() != 256) route_fast_phase(WV_, (const bf16*)qb, (const bf16*)(ws + WS_SKB) + (size_t)l * 8 * 2 * 128 * 64, eid, gate, lds_raw); }
    else peer_fast_phase(WV_, hbuf, hb, eid, gate, ws + WS_UV + (size_t)l * 24 * MiB, p.in[5] + l * 1024, p.in[6] + l * 1024, p.in[11] + l * 1024, p.in[12] + l * 1024, lds_raw);
}

constexpr int CW_BAR = 4096;
constexpr int LDS_BARST = LDS_BYTES - 16;
__global__ void __launch_bounds__(NTHR, 2) mk_fwd(Params p) {
    extern __shared__ __attribute__((aligned(16))) unsigned char lds_raw[];
    cg::grid_group grid = cg::this_grid();
    const int WV_ = __builtin_amdgcn_readfirstlane((int)threadIdx.x >> 6);
    { volatile LAS unsigned* bst0 = (volatile LAS unsigned*)((LAS unsigned char*)lds_raw + LDS_BARST); if (threadIdx.x < 4) bst0[threadIdx.x] = 0u; }
    __syncthreads();
    volatile LAS unsigned* bst = (volatile LAS unsigned*)((LAS unsigned char*)lds_raw + LDS_BARST);
    (void)xcd_barrier_post((unsigned*)(p.ws + WS_CTL) + CW_BAR, bst);
#define GRID_BAR() do { XcdBarrier b_; b_.bar = (unsigned*)(p.ws + WS_CTL) + CW_BAR; b_.x = xb_xcc_id(); b_.st = (volatile LAS unsigned*)((LAS unsigned char*)lds_raw + LDS_BARST); xcd_barrier(b_, WV_); } while (0)
    run_phase<PH_PRO>(WV_, p, 0, lds_raw);
    grid.sync();
#pragma unroll 1
    for (int l = 0; l < DEPTH_; ++l) {
        run_phase<PH_GIN>(WV_, p, l, lds_raw); GRID_BAR();
        run_phase<PH_INDEX>(WV_, p, l, lds_raw); GRID_BAR();
        run_phase<PH_ATTN>(WV_, p, l, lds_raw); GRID_BAR();
        run_phase<PH_MERGE>(WV_, p, l, lds_raw); GRID_BAR();
        run_phase<PH_GOUT>(WV_, p, l, lds_raw); GRID_BAR();
        run_phase<PH_GQ>(WV_, p, l, lds_raw); if (LGRID() != 256) { GRID_BAR(); run_phase<PH_ROUTE>(WV_, p, l, lds_raw); } GRID_BAR();
        run_phase<PH_PEER>(WV_, p, l, lds_raw); if (l + 1 < DEPTH_) GRID_BAR();
    }
}

extern "C" void kernel_launch(void* const* d_in, const int* in_sizes, int n_in, void* d_out, int out_size, void* d_ws, size_t ws_size, hipStream_t stream) {
    if (n_in != 13 || ws_size < WS_END) { fprintf(stderr, "kernel_launch: unexpected n_in %d / ws_size %zu; nothing launched\n", n_in, ws_size); return; }
    static int grid_blocks = 0;
    if (grid_blocks == 0) {
        int dev = 0, cus = 0, per_cu = 0;
        (void)hipGetDevice(&dev);
        (void)hipDeviceGetAttribute(&cus, hipDeviceAttributeMultiprocessorCount, dev);
        (void)hipFuncSetAttribute((const void*)mk_fwd, hipFuncAttributeMaxDynamicSharedMemorySize, LDS_BYTES);
        (void)hipOccupancyMaxActiveBlocksPerMultiprocessor(&per_cu, (const void*)mk_fwd, NTHR, LDS_BYTES);
        if (per_cu < 1) fprintf(stderr, "kernel_launch: occupancy query reports %d\n", per_cu);
        grid_blocks = cus;
    }
    Params p{};
    for (int i = 0; i < 13; ++i) p.in[i] = (const float*)d_in[i];
    p.out = (float*)d_out; p.ws = (unsigned char*)d_ws;
    (void)hipMemsetAsync(d_ws, 0, 2 * MiB, stream);
    void* args[] = {&p};
    hipError_t e = hipLaunchCooperativeKernel((const void*)mk_fwd, dim3(grid_blocks), dim3(NTHR), args, LDS_BYTES, stream);
    if (e != hipSuccess) fprintf(stderr, "cooperative launch failed: %s (grid %d)\n", hipGetErrorString(e), grid_blocks);
}
```

```cpp
#include <hip/hip_runtime.h>
#include <cstdio>
#include <cstdint>
#include <hip/hip_cooperative_groups.h>
namespace cg = cooperative_groups;

__device__ __forceinline__ int LANEID() { int l; asm volatile("v_mbcnt_lo_u32_b32 %0, -1, 0\n\tv_mbcnt_hi_u32_b32 %0, -1, %0" : "=v"(l)); return l; }
__device__ __forceinline__ int LTID(int wv) { return (wv << 6) | LANEID(); }
__device__ __forceinline__ int LBID() { int t = blockIdx.x; asm volatile("" : "+s"(t)); return t; }
__device__ __forceinline__ int LGRID() { int t = gridDim.x; asm volatile("" : "+s"(t)); return t; }
namespace pg8 {
#define PG8_LAS __attribute__((address_space(3)))
typedef unsigned short bf16_t;
typedef short bf16x8 __attribute__((ext_vector_type(8)));
typedef float f32x4 __attribute__((ext_vector_type(4)));
typedef unsigned u32x4 __attribute__((ext_vector_type(4)));
constexpr int BM = 256, BK = 64, HALF = 128, HTB = HALF * BK * 2  , STAGE_BYTES = 8 * HTB, NXCD = 8, WGM = 8;

__host__ __device__ __forceinline__ int lds_byte(int r, int c) { const int st = (r >> 4) * 2 + (c >> 5), rr = r & 15, cc = c & 31, ob = rr * 64 + cc * 2; return st * 1024 + (ob ^ (((ob >> 9) & 1) << 5)); }
__host__ __device__ __forceinline__ void stage_rc(int b, int& R, int& C) { const int st = b / 1024, sb = b % 1024, swz = sb ^ (((sb >> 9) & 1) << 5); R = (st >> 1) * 16 + swz / 64; C = (st & 1) * 32 + (swz % 64) / 2; }
__host__ __device__ __forceinline__ int perm32(int rho) { const int n = rho >> 4, i = rho & 15; return 8 * (i >> 2) + 4 * n + (i & 3); }

struct Unit { int pm, pn; };
struct Gemm { const bf16_t* A; const bf16_t* Bt; int M, N, K; };

struct StaticOrder {
    int nM, nN, nwg, G, c;
    __host__ __device__ void init(int M, int N, int G_, int c_) { nM = M / BM; nN = N / BM; nwg = nM * nN; G = G_; c = c_; }
    __host__ __device__ bool next(int i, Unit& u) const {
        const long L = (long)i * G + c; if (L >= nwg) return false;
        int wgid = (int)L; { const int q = nwg / NXCD, r = nwg % NXCD, xcd = wgid % NXCD, off = wgid / NXCD; wgid = (xcd < r ? xcd * (q + 1) : r * (q + 1) + (xcd - r) * q) + off; }
        const int nig = WGM * nN, gid = wgid / nig, fm = gid * WGM, gsz = (nM - fm) < WGM ? (nM - fm) : WGM;
        u.pm = fm + ((wgid % nig) % gsz); u.pn = (wgid % nig) / gsz; return true;
    }
    __device__ __forceinline__ void a_ready(const Unit&) const {}
    __device__ __forceinline__ void done(const Unit&) const {}
};

__device__ __forceinline__ unsigned cvt_pk_bf16(float lo, float hi) { unsigned r; asm volatile("v_cvt_pk_bf16_f32 %0, %1, %2" : "=v"(r) : "v"(lo), "v"(hi)); return r; }
typedef float f32x2 __attribute__((ext_vector_type(2)));
__device__ __forceinline__ f32x2 gelu_pk(f32x2 v) {
    const f32x2 av = __builtin_elementwise_abs(v), d = av * 0.2316418882f + 1.0f;
    f32x2 t; t.x = __builtin_amdgcn_rcpf(d.x); t.y = __builtin_amdgcn_rcpf(d.y);
    f32x2 q = t * 0.5307027145f + (-0.7265760135f); q = q * t + 0.7107068705f; q = q * t + (-0.142248368f); q = q * t + 0.127414796f; q = q * t;
    const f32x2 s = (v * v) * (-0.72134752044f);
    f32x2 e; e.x = __builtin_amdgcn_exp2f(s.x); e.y = __builtin_amdgcn_exp2f(s.y);
    const f32x2 m = v * (q * e), r = v - m;
    f32x2 o; o.x = v.x < 0.f ? m.x : r.x; o.y = v.y < 0.f ? m.y : r.y; return o;
}

template <int ACT  > struct EpiBf16 {
    static constexpr bool PERM = true, AFTER_DRAIN = false; static_assert(ACT == 0 || ACT == 1, "EpiBf16: ACT is 0 (none) or 1 (gelu_pk)");
    bf16_t* O; int ldc; const float* bias; int split_cols; size_t split_stride; float scale0;
    __device__ __forceinline__ void operator()(const f32x4 (&acc)[2][2][4][2], const Unit& u, int wr, int wc, int fr, int fq) const {
        { int ln_ = LANEID(); asm volatile("" : "+v"(ln_)); fr = ln_ & 15; fq = ln_ >> 4; }
        const int row0 = u.pm * BM + wr * 64 + fr; int colt = u.pn * BM; bf16_t* base = O;
        float sc = 1.f; if (split_cols) { const int t = colt / split_cols; base += (size_t)t * split_stride; colt -= t * split_cols; if (t == 0) sc = scale0; }
        const int col0 = colt + wc * 32 + 8 * fq, bcol0 = u.pn * BM + wc * 32 + 8 * fq;
        f32x4 bv[2][2];
#pragma unroll
        for (int bj = 0; bj < 2; ++bj)
#pragma unroll
            for (int n = 0; n < 2; ++n) bv[bj][n] = bias ? *(const f32x4*)(bias + bcol0 + bj * HALF + 4 * n) : (f32x4){0.f, 0.f, 0.f, 0.f};
#pragma unroll
        for (int ai = 0; ai < 2; ++ai)
#pragma unroll
            for (int m = 0; m < 4; ++m) { bf16_t* rowp = base + (size_t)(row0 + ai * HALF + m * 16) * ldc + col0;
#pragma unroll
                for (int bj = 0; bj < 2; ++bj) { f32x4 v0 = acc[ai][bj][m][0] + bv[bj][0], v1 = acc[ai][bj][m][1] + bv[bj][1];
                    if (ACT == 1) { f32x2 a = gelu_pk((f32x2){v0[0], v0[1]}), b = gelu_pk((f32x2){v0[2], v0[3]}), c = gelu_pk((f32x2){v1[0], v1[1]}), d = gelu_pk((f32x2){v1[2], v1[3]});
                        v0 = (f32x4){a.x, a.y, b.x, b.y}; v1 = (f32x4){c.x, c.y, d.x, d.y}; }
                    v0 = v0 * sc; v1 = v1 * sc; u32x4 w; w.x = cvt_pk_bf16(v0[0], v0[1]); w.y = cvt_pk_bf16(v0[2], v0[3]); w.z = cvt_pk_bf16(v1[0], v1[1]); w.w = cvt_pk_bf16(v1[2], v1[3]);
                    *(u32x4*)(rowp + bj * HALF) = w; } }
    }
};
template <class Epi, class Sched, bool ALIGN_EPI = false, bool SP2 = false>
__device__ __forceinline__ void gemm_phase(int WV_, PG8_LAS unsigned char* lds, const Gemm g, const Sched& S, const Epi& E) {
    const int tid = LTID(WV_), wid = __builtin_amdgcn_readfirstlane(tid >> 6), lane = tid & 63, wr = wid >> 2, wc = wid & 3, fr = lane & 15, fq = lane >> 4;
    const int K = g.K, nt = K / BK;
    unsigned voffA[2], voffB[2];
#pragma unroll
    for (int i = 0; i < 2; ++i) { int R, C; stage_rc(tid * 16 + i * 8192, R, C); const int Rb = Epi::PERM ? ((R & ~31) + perm32(R & 31)) : R;
        voffA[i] = (unsigned)(R * K + C) * 2u; voffB[i] = (unsigned)(Rb * K + C) * 2u; }
    const size_t kstep = (size_t)(BK * 2);
    const size_t hstep = (size_t)HALF * K * 2;
    const size_t tstep = 2 * hstep;
    const unsigned ldsw = (unsigned)wid * 1024u;
    const int aoff = lds_byte(wr * 64 + fr, fq * 8), boff = lds_byte(wc * 32 + fr, fq * 8);
#define PG8_SA(b, h) (((b) * 2 + (h)) * HTB)
#define PG8_SB(b, h) ((4 + (b) * 2 + (h)) * HTB)
#define PG8_STAGE(bufoff, gbase, voff) do { _Pragma("unroll") for (int _i = 0; _i < 2; ++_i) \
        __builtin_amdgcn_global_load_lds((const unsigned*)((const char*)(gbase) + (voff)[_i]), (PG8_LAS unsigned*)(lds + (bufoff) + ldsw + _i * 8192), 16, 0, 0); } while (0)
#define PG8_LDA(dst, b, h) do { _Pragma("unroll") for (int m = 0; m < 4; ++m) _Pragma("unroll") for (int k = 0; k < 2; ++k) dst[m][k] = *(const PG8_LAS bf16x8*)(lds + PG8_SA(b, h) + aoff + m * 2048 + k * 1024); } while (0)
#define PG8_LDB(dst, b, h) do { _Pragma("unroll") for (int n = 0; n < 2; ++n) _Pragma("unroll") for (int k = 0; k < 2; ++k) dst[n][k] = *(const PG8_LAS bf16x8*)(lds + PG8_SB(b, h) + boff + n * 2048 + k * 1024); } while (0)
#define PG8_MMA(ai, bj, At, Bt) do { __builtin_amdgcn_s_setprio(1); _Pragma("unroll") for (int m = 0; m < 4; ++m) _Pragma("unroll") for (int n = 0; n < 2; ++n) _Pragma("unroll") for (int k = 0; k < 2; ++k) \
        acc[ai][bj][m][n] = __builtin_amdgcn_mfma_f32_16x16x32_bf16(Bt[n][k], At[m][k], acc[ai][bj][m][n], 0, 0, 0); __builtin_amdgcn_s_setprio(0); } while (0)
#define PG8_WAIT_V(n) asm volatile("s_waitcnt vmcnt(" #n ")" ::: "memory")
#define PG8_WAIT_L(n) asm volatile("s_waitcnt lgkmcnt(" #n ")" ::: "memory")
#define PG8_BAR __builtin_amdgcn_s_barrier()
#define PG8_SCHED __builtin_amdgcn_sched_barrier(0)
    Unit cur, nxt; int ui = 0;
    if (!S.next(0, cur)) return;
    f32x4 acc[2][2][4][2];
#pragma unroll
    for (int a = 0; a < 2; ++a)
#pragma unroll
        for (int b = 0; b < 2; ++b)
#pragma unroll
            for (int m = 0; m < 4; ++m)
#pragma unroll
                for (int n = 0; n < 2; ++n) acc[a][b][m][n] = (f32x4){0.f, 0.f, 0.f, 0.f};
    bf16x8 At[4][2], B0[2][2], B1[2][2];
    const char* cA = (const char*)g.A + (size_t)cur.pm * tstep; const char* cB = (const char*)g.Bt + (size_t)cur.pn * tstep;
    S.a_ready(cur);
    if constexpr (SP2) {
        PG8_STAGE(PG8_SB(0, 0), cB, voffB); PG8_STAGE(PG8_SB(0, 1), cB + hstep, voffB); PG8_STAGE(PG8_SA(0, 0), cA, voffA); PG8_STAGE(PG8_SA(0, 1), cA + hstep, voffA);
        if (wr == 1) PG8_BAR;
        PG8_WAIT_V(2); PG8_BAR;
        PG8_STAGE(PG8_SB(1, 0), cB + kstep, voffB); PG8_STAGE(PG8_SA(1, 0), cA + kstep, voffA); PG8_STAGE(PG8_SB(1, 1), cB + hstep + kstep, voffB);
        PG8_WAIT_V(6); PG8_BAR;
    } else {
        PG8_STAGE(PG8_SB(0, 0), cB, voffB); PG8_STAGE(PG8_SA(0, 0), cA, voffA); PG8_STAGE(PG8_SB(0, 1), cB + hstep, voffB); PG8_STAGE(PG8_SA(0, 1), cA + hstep, voffA);
        if (wr == 1) PG8_BAR;
        PG8_WAIT_V(4); PG8_BAR;
        PG8_STAGE(PG8_SB(1, 0), cB + kstep, voffB); PG8_STAGE(PG8_SA(1, 0), cA + kstep, voffA); PG8_STAGE(PG8_SB(1, 1), cB + hstep + kstep, voffB);
        PG8_WAIT_V(6); PG8_BAR;
    }
    for (;;) {
        const bool has_next = S.next(ui + 1, nxt);
        const char* nA = has_next ? (const char*)g.A + (size_t)nxt.pm * tstep : cA; const char* nB = has_next ? (const char*)g.Bt + (size_t)nxt.pn * tstep : cB;
        for (int t = 0; t < nt; t += 2) {
            const bool last = (t == nt - 2);
            const char* a1 = cA + (size_t)(t + 1) * kstep;
            const char* a2 = last ? nA : cA + (size_t)(t + 2) * kstep; const char* b2 = last ? nB : cB + (size_t)(t + 2) * kstep;
            const char* a3 = a2 + kstep; const char* b3 = b2 + kstep;
            if (last && has_next) S.a_ready(nxt);
            if constexpr (SP2) {
            PG8_LDB(B0, 0, 0); PG8_LDB(B1, 0, 1); PG8_SCHED; PG8_LDA(At, 0, 0); PG8_STAGE(PG8_SA(1, 1), a1 + hstep, voffA);
            PG8_WAIT_V(8); PG8_WAIT_L(0); PG8_BAR; PG8_MMA(0, 0, At, B0); PG8_MMA(0, 1, At, B1); PG8_BAR; PG8_SCHED;
            PG8_LDA(At, 0, 1); PG8_STAGE(PG8_SB(0, 0), b2, voffB); PG8_STAGE(PG8_SB(0, 1), b2 + hstep, voffB); PG8_STAGE(PG8_SA(0, 0), a2, voffA);
            PG8_WAIT_V(8); PG8_WAIT_L(0); PG8_BAR; PG8_MMA(1, 0, At, B0); PG8_MMA(1, 1, At, B1); PG8_BAR; PG8_SCHED;
            PG8_LDB(B0, 1, 0); PG8_LDB(B1, 1, 1); PG8_SCHED; PG8_LDA(At, 1, 0); PG8_STAGE(PG8_SA(0, 1), a2 + hstep, voffA);
            PG8_WAIT_V(8); PG8_WAIT_L(0); PG8_BAR; PG8_MMA(0, 0, At, B0); PG8_MMA(0, 1, At, B1); PG8_BAR; PG8_SCHED;
            PG8_LDA(At, 1, 1); PG8_STAGE(PG8_SB(1, 0), b3, voffB); PG8_STAGE(PG8_SB(1, 1), b3 + hstep, voffB); PG8_STAGE(PG8_SA(1, 0), a3, voffA);
            PG8_WAIT_V(8); PG8_WAIT_L(0); PG8_BAR; PG8_MMA(1, 0, At, B0); PG8_MMA(1, 1, At, B1); PG8_BAR; PG8_SCHED;
            } else {
            PG8_LDB(B0, 0, 0); PG8_SCHED; PG8_LDA(At, 0, 0); PG8_STAGE(PG8_SA(1, 1), a1 + hstep, voffA);
            PG8_WAIT_L(8); PG8_BAR; PG8_WAIT_L(0); PG8_MMA(0, 0, At, B0); PG8_BAR; PG8_SCHED;
            PG8_LDB(B1, 0, 1); PG8_STAGE(PG8_SB(0, 0), b2, voffB);
            PG8_BAR; PG8_WAIT_L(0); PG8_MMA(0, 1, At, B1); PG8_BAR;
            PG8_LDA(At, 0, 1); PG8_STAGE(PG8_SA(0, 0), a2, voffA);
            PG8_BAR; PG8_WAIT_L(0); PG8_MMA(1, 0, At, B0); PG8_BAR; PG8_SCHED;
            PG8_STAGE(PG8_SB(0, 1), b2 + hstep, voffB);
            PG8_WAIT_V(6); PG8_BAR; PG8_MMA(1, 1, At, B1); PG8_BAR;
            PG8_LDB(B0, 1, 0); PG8_SCHED; PG8_LDA(At, 1, 0); PG8_STAGE(PG8_SA(0, 1), a2 + hstep, voffA);
            PG8_WAIT_L(8); PG8_BAR; PG8_WAIT_L(0); PG8_MMA(0, 0, At, B0); PG8_BAR; PG8_SCHED;
            PG8_LDB(B1, 1, 1); PG8_STAGE(PG8_SB(1, 0), b3, voffB);
            PG8_BAR; PG8_WAIT_L(0); PG8_MMA(0, 1, At, B1); PG8_BAR;
            PG8_LDA(At, 1, 1); PG8_STAGE(PG8_SA(1, 0), a3, voffA);
            PG8_BAR; PG8_WAIT_L(0); PG8_MMA(1, 0, At, B0); PG8_BAR; PG8_SCHED;
            PG8_STAGE(PG8_SB(1, 1), b3 + hstep, voffB);
            PG8_WAIT_V(6); PG8_BAR; PG8_MMA(1, 1, At, B1); PG8_BAR;
            }
        }
        if constexpr (ALIGN_EPI) { if (wr == 0) PG8_BAR; }
        if constexpr (!Epi::AFTER_DRAIN) { E(acc, cur, wr, wc, fr, fq); S.done(cur); }
        if (!has_next) break;
#pragma unroll
        for (int a = 0; a < 2; ++a)
#pragma unroll
            for (int b = 0; b < 2; ++b)
#pragma unroll
                for (int m = 0; m < 4; ++m)
#pragma unroll
                    for (int n = 0; n < 2; ++n) acc[a][b][m][n] = (f32x4){0.f, 0.f, 0.f, 0.f};
        cur = nxt; cA = nA; cB = nB; ++ui;
        if constexpr (ALIGN_EPI) { if (wr == 1) PG8_BAR; }
    }
    PG8_WAIT_V(0);
    if constexpr (!ALIGN_EPI) { if (wr == 0) PG8_BAR; }
    PG8_BAR;
    if constexpr (Epi::AFTER_DRAIN) { E.fused(acc, cur, wr, wc, fr, fq, lds, wid, lane); S.done(cur); }
#undef PG8_SA
#undef PG8_SB
#undef PG8_STAGE
#undef PG8_LDA
#undef PG8_LDB
#undef PG8_MMA
#undef PG8_WAIT_V
#undef PG8_WAIT_L
#undef PG8_BAR
#undef PG8_SCHED
}
}
namespace pg8 {
struct EpiF32 {
    static constexpr bool PERM = false, AFTER_DRAIN = false;
    float* O; int ldc;
    __device__ __forceinline__ void operator()(const f32x4 (&acc)[2][2][4][2], const Unit& u, int wr, int wc, int fr, int fq) const {
        { int ln_ = LANEID(); asm volatile("" : "+v"(ln_)); fr = ln_ & 15; fq = ln_ >> 4; }
        const int row0 = u.pm * BM + wr * 64 + fr, col0 = u.pn * BM + wc * 32 + 4 * fq;
#pragma unroll
        for (int ai = 0; ai < 2; ++ai)
#pragma unroll
            for (int m = 0; m < 4; ++m) { float* rowp = O + (size_t)(row0 + ai * HALF + m * 16) * ldc + col0;
#pragma unroll
                for (int bj = 0; bj < 2; ++bj)
#pragma unroll
                    for (int n = 0; n < 2; ++n) *(f32x4*)(rowp + bj * HALF + n * 16) = acc[ai][bj][m][n]; }
    }
};
struct EpiResY {
    static constexpr bool PERM = false, AFTER_DRAIN = false;
    const float* hin; float* yout; bf16_t* yb; float* stats; float alpha;
    __device__ __forceinline__ void operator()(const f32x4 (&acc)[2][2][4][2], const Unit& u, int wr, int wc, int fr, int fq) const {
        { int ln_ = LANEID(); asm volatile("" : "+v"(ln_)); fr = ln_ & 15; fq = ln_ >> 4; }
        const int row0 = u.pm * BM + wr * 64 + fr, col0 = u.pn * BM + wc * 32 + 4 * fq;
#pragma unroll
        for (int ai = 0; ai < 2; ++ai)
#pragma unroll
            for (int m = 0; m < 4; ++m) {
                const int row = row0 + ai * HALF + m * 16;
                float s = 0.f, s2 = 0.f;
#pragma unroll
                for (int bj = 0; bj < 2; ++bj)
#pragma unroll
                    for (int n = 0; n < 2; ++n) {
                        const size_t off = (size_t)row * 1024 + col0 + bj * HALF + n * 16;
                        const f32x4 hv = *(const f32x4*)(hin + off);
                        const f32x4 y = hv * alpha + acc[ai][bj][m][n];
                        *(f32x4*)(yout + off) = y;
                        typedef unsigned u32x2v __attribute__((ext_vector_type(2)));
                        u32x2v w; w.x = cvt_pk_bf16(y[0], y[1]); w.y = cvt_pk_bf16(y[2], y[3]);
                        *(u32x2v*)(yb + off) = w;
                        s += (y[0] + y[1]) + (y[2] + y[3]); s2 += (y[0] * y[0] + y[1] * y[1]) + (y[2] * y[2] + y[3] * y[3]);
                    }
                s += __shfl_xor(s, 16); s += __shfl_xor(s, 32); s2 += __shfl_xor(s2, 16); s2 += __shfl_xor(s2, 32);
                if (fq == 0) { atomicAdd(stats + 2 * (size_t)row, s); atomicAdd(stats + 2 * (size_t)row + 1, s2); }
            }
    }
};
struct EpiLnFold {
    static constexpr bool PERM = true, AFTER_DRAIN = false;
    bf16_t* O; const float* stats; const float* colsum; const float* colbias; float eps;
    __device__ __forceinline__ void operator()(const f32x4 (&acc)[2][2][4][2], const Unit& u, int wr, int wc, int fr, int fq) const {
        { int ln_ = LANEID(); asm volatile("" : "+v"(ln_)); fr = ln_ & 15; fq = ln_ >> 4; }
        const int row0 = u.pm * BM + wr * 64 + fr, col0 = u.pn * BM + wc * 32 + 8 * fq;
        f32x4 cs[2][2], cb[2][2];
#pragma unroll
        for (int bj = 0; bj < 2; ++bj)
#pragma unroll
            for (int n = 0; n < 2; ++n) { cs[bj][n] = *(const f32x4*)(colsum + col0 + bj * HALF + 4 * n); cb[bj][n] = *(const f32x4*)(colbias + col0 + bj * HALF + 4 * n); }
#pragma unroll
        for (int ai = 0; ai < 2; ++ai)
#pragma unroll
            for (int m = 0; m < 4; ++m) {
                const int row = row0 + ai * HALF + m * 16;
                const float sm_ = stats[2 * (size_t)row], sq_ = stats[2 * (size_t)row + 1];
                const float mean = sm_ * (1.0f / 1024.0f);
                const float rstd = 1.0f / sqrtf(fmaxf(sq_ * (1.0f / 1024.0f) - mean * mean, 0.f) + eps);
                bf16_t* rowp = O + (size_t)row * 1024 + col0;
#pragma unroll
                for (int bj = 0; bj < 2; ++bj) {
                    const f32x4 v0 = (acc[ai][bj][m][0] - cs[bj][0] * mean) * rstd + cb[bj][0], v1 = (acc[ai][bj][m][1] - cs[bj][1] * mean) * rstd + cb[bj][1];
                    u32x4 w; w.x = cvt_pk_bf16(v0[0], v0[1]); w.y = cvt_pk_bf16(v0[2], v0[3]); w.z = cvt_pk_bf16(v1[0], v1[1]); w.w = cvt_pk_bf16(v1[2], v1[3]);
                    *(u32x4*)(rowp + bj * HALF) = w;
                }
            }
    }
};
__device__ __forceinline__ unsigned cvt_pk_bf16_t(float lo, float hi) { unsigned r; asm volatile("s_nop 0\n\tv_cvt_pk_bf16_f32 %0, %1, %2" : "=v"(r) : "v"(lo), "v"(hi)); return r; }
struct EpiBf16Sig {
    static constexpr bool PERM = true, AFTER_DRAIN = false;
    bf16_t* O; int ldc; int sig_col0;
    __device__ __forceinline__ void operator()(const f32x4 (&acc)[2][2][4][2], const Unit& u, int wr, int wc, int fr, int fq) const {
        { int ln_ = LANEID(); asm volatile("" : "+v"(ln_)); fr = ln_ & 15; fq = ln_ >> 4; }
        const int row0 = u.pm * BM + wr * 64 + fr; const int col0 = u.pn * BM + wc * 32 + 8 * fq;
#pragma unroll
        for (int bj = 0; bj < 2; ++bj) {
            if (col0 + bj * HALF >= sig_col0) {
#pragma unroll
                for (int ai = 0; ai < 2; ++ai)
#pragma unroll
                    for (int m = 0; m < 4; ++m) { bf16_t* rowp = O + (size_t)(row0 + ai * HALF + m * 16) * ldc + col0;
                        f32x4 v0 = acc[ai][bj][m][0], v1 = acc[ai][bj][m][1];
#pragma unroll
                        for (int e = 0; e < 4; ++e) { v0[e] = __builtin_amdgcn_rcpf(1.f + __builtin_amdgcn_exp2f(-1.44269504f * v0[e])); v1[e] = __builtin_amdgcn_rcpf(1.f + __builtin_amdgcn_exp2f(-1.44269504f * v1[e])); }
                        u32x4 w; w.x = cvt_pk_bf16_t(v0[0], v0[1]); w.y = cvt_pk_bf16_t(v0[2], v0[3]); w.z = cvt_pk_bf16_t(v1[0], v1[1]); w.w = cvt_pk_bf16_t(v1[2], v1[3]);
                        *(u32x4*)(rowp + bj * HALF) = w; }
            } else {
#pragma unroll
                for (int ai = 0; ai < 2; ++ai)
#pragma unroll
                    for (int m = 0; m < 4; ++m) { bf16_t* rowp = O + (size_t)(row0 + ai * HALF + m * 16) * ldc + col0;
                        const f32x4 v0 = acc[ai][bj][m][0], v1 = acc[ai][bj][m][1];
                        u32x4 w; w.x = cvt_pk_bf16(v0[0], v0[1]); w.y = cvt_pk_bf16(v0[2], v0[3]); w.z = cvt_pk_bf16(v1[0], v1[1]); w.w = cvt_pk_bf16(v1[2], v1[3]);
                        *(u32x4*)(rowp + bj * HALF) = w; }
            }
        }
    }
};
}

typedef unsigned short bf16;
constexpr int T_ = 16384, S_ = 4096, NBATCH = 4, D_ = 1024, NCOL = 6824, NP = 6912, DEPTH_ = 2;
constexpr int C_QA = 0, C_KA = 256, C_VA = 320, C_QI = 384, C_KI = 640, C_WI = 672, C_QB = 680, C_KB = 936, C_VB = 1064,
              C_QC = 1192, C_KC = 1448, C_VC = 1704, C_QD = 1960, C_KD = 2216, C_VD = 2472, C_G = 2728;
constexpr int NTHR = 512, NWAVE = 8;
constexpr float ALPHA = 1.41421356237309515f;
constexpr float LN_EPS = 1e-5f;
constexpr size_t MiB = 1u << 20;
constexpr size_t WS_STATS = 1 * MiB  , WS_COLS = 1 * MiB + 512 * 1024  ;
constexpr size_t WS_CTL = 0, WS_WIN_T = 2 * MiB, WS_WOUT_T = 30 * MiB, WS_WQ_T = 34 * MiB, WS_WBR_T = 38 * MiB, WS_HB = 42 * MiB,
                 WS_P = 74 * MiB, WS_MIX = 74 * MiB  , WS_Q = 138 * MiB  , WS_YS = 290 * MiB, WS_MRG = 322 * MiB,
                 WS_MASK = 354 * MiB, WS_EID = 362 * MiB, WS_GATE = 370 * MiB, WS_KMEAN = 378 * MiB, WS_SKB = 379 * MiB, WS_UV = 380 * MiB, WS_END = 508 * MiB;
constexpr size_t WIN_T_BYTES = (size_t)NP * 1024 * 2;
constexpr int LDS_BYTES = 144 * 1024;

struct Params { const float* in[13]; float* out; unsigned char* ws; };

__device__ __forceinline__ float bf2f(bf16 v) { return __uint_as_float((unsigned)v << 16); }
__device__ __forceinline__ unsigned f2bf(float f) { unsigned u = __float_as_uint(f); return (u + 0x7fffu + ((u >> 16) & 1u)) >> 16; }
__device__ __forceinline__ unsigned pk2(float lo, float hi) { return f2bf(lo) | (f2bf(hi) << 16); }
__device__ __forceinline__ void unpack8(const uint4 v, float* o) {
    o[0] = __uint_as_float(v.x << 16); o[1] = __uint_as_float(v.x & 0xffff0000u); o[2] = __uint_as_float(v.y << 16); o[3] = __uint_as_float(v.y & 0xffff0000u);
    o[4] = __uint_as_float(v.z << 16); o[5] = __uint_as_float(v.z & 0xffff0000u); o[6] = __uint_as_float(v.w << 16); o[7] = __uint_as_float(v.w & 0xffff0000u);
}
__device__ __forceinline__ float wave_sum(float v) {
#pragma unroll
    for (int o = 32; o > 0; o >>= 1) v += __shfl_xor(v, o);
    return v;
}
__device__ __forceinline__ float wave_max(float v) {
#pragma unroll
    for (int o = 32; o > 0; o >>= 1) v = fmaxf(v, __shfl_xor(v, o));
    return v;
}
__device__ __forceinline__ int wave_sum_i(int v) {
#pragma unroll
    for (int o = 32; o > 0; o >>= 1) v += __shfl_xor(v, o);
    return v;
}
__device__ __forceinline__ float logsig(float x) { return fminf(x, 0.f) - log1pf(expf(-fabsf(x))); }

__device__ void transpose_items(int WV_, const float* W, int K, int N, bf16* WT, float* sm, int item0, int nitems_total, int item_stride,
                                const float* rs_g = nullptr, const float* rs_b = nullptr, float* colsum = nullptr, float* colbias = nullptr) {
    const int tid = LTID(WV_);
    const int nkb = K / 64, nnb = (N + 63) / 64;
    for (int it = item0; it < nkb * nnb; it += item_stride) {
        const int kb = it % nkb, nb = it / nkb, k0 = kb * 64, n0 = nb * 64;
        __syncthreads();
        for (int e = tid; e < 64 * 64; e += NTHR) { const int kk = e >> 6, nn = e & 63; sm[kk * 65 + nn] = (n0 + nn < N) ? W[(size_t)(k0 + kk) * N + n0 + nn] : 0.f; }
        __syncthreads();
        if (rs_g) {
            if (tid < 64) { float cs = 0.f, cb = 0.f;
                for (int kk = 0; kk < 64; ++kk) { const float w = sm[kk * 65 + tid]; cs += w * rs_g[k0 + kk]; cb += w * rs_b[k0 + kk]; }
                atomicAdd(colsum + n0 + tid, cs); atomicAdd(colbias + n0 + tid, cb); }
            __syncthreads();
            for (int e = tid; e < 64 * 64; e += NTHR) { const int kk = e >> 6, nn = e & 63; sm[kk * 65 + nn] *= rs_g[k0 + kk]; }
            __syncthreads();
        }
        { const int nn = tid >> 3, c = tid & 7;
          if (n0 + nn < N) { uint4 o; o.x = pk2(sm[(8 * c + 0) * 65 + nn], sm[(8 * c + 1) * 65 + nn]); o.y = pk2(sm[(8 * c + 2) * 65 + nn], sm[(8 * c + 3) * 65 + nn]);
              o.z = pk2(sm[(8 * c + 4) * 65 + nn], sm[(8 * c + 5) * 65 + nn]); o.w = pk2(sm[(8 * c + 6) * 65 + nn], sm[(8 * c + 7) * 65 + nn]);
              *(uint4*)(WT + (size_t)(n0 + nn) * K + k0 + 8 * c) = o; } }
    }
    __syncthreads();
}
__device__ void prologue_phase(int WV_, const Params& p, float* sm) {
    const int tid = LTID(WV_), B = LBID(), G = LGRID();
    unsigned char* ws = p.ws;
    for (int l = 0; l < DEPTH_; ++l) {
        bf16* win_t = (bf16*)(ws + WS_WIN_T + l * WIN_T_BYTES);
        transpose_items(WV_, p.in[1] + (size_t)l * 1024 * NCOL, 1024, NCOL, win_t, sm, B, 0, G);
        for (int i = B * NTHR + tid; i < (NP - NCOL) * 1024 / 8; i += G * NTHR) ((uint4*)(win_t + (size_t)NCOL * 1024))[i] = make_uint4(0u, 0u, 0u, 0u);
        transpose_items(WV_, p.in[3] + (size_t)l * 1024 * 1024, 1024, 1024, (bf16*)(ws + WS_WOUT_T) + (size_t)l * 1024 * 1024, sm, B, 0, G);
        transpose_items(WV_, p.in[7] + (size_t)l * 1024 * 1024, 1024, 1024, (bf16*)(ws + WS_WQ_T) + (size_t)l * 1024 * 1024, sm, B, 0, G,
                        p.in[5] + l * 1024, p.in[6] + l * 1024, (float*)(ws + WS_COLS) + l * 2048, (float*)(ws + WS_COLS) + l * 2048 + 1024);
        for (int n = 0; n < 4; ++n)
            transpose_items(WV_, p.in[2] + ((size_t)l * 4 + n) * 256 * 1024, 256, 1024, (bf16*)(ws + WS_WBR_T) + ((size_t)l * 4 + n) * 1024 * 256, sm, B, 0, G);
    }
    const float4* x4 = (const float4*)p.in[0]; uint2* hb2 = (uint2*)(ws + WS_HB);
    for (size_t i = (size_t)B * NTHR + tid; i < (size_t)T_ * 1024 / 4; i += (size_t)G * NTHR) { const float4 v = x4[i]; hb2[i] = make_uint2(pk2(v.x, v.y), pk2(v.z, v.w)); }
}

__device__ __forceinline__ void ln_row(float4 (&v)[4], const float* g, const float* bb, float* orow, bf16* obrow, int lane) {
    float s = 0.f;
#pragma unroll
    for (int j = 0; j < 4; ++j) s += (v[j].x + v[j].y) + (v[j].z + v[j].w);
    const float mean = wave_sum(s) * (1.0f / 1024.0f);
    float s2 = 0.f;
#pragma unroll
    for (int j = 0; j < 4; ++j) { v[j].x -= mean; v[j].y -= mean; v[j].z -= mean; v[j].w -= mean; s2 += (v[j].x * v[j].x + v[j].y * v[j].y) + (v[j].z * v[j].z + v[j].w * v[j].w); }
    const float rstd = 1.0f / sqrtf(wave_sum(s2) * (1.0f / 1024.0f) + LN_EPS);
#pragma unroll
    for (int j = 0; j < 4; ++j) {
        const float4 gg = ((const float4*)g)[j * 64 + lane], b4 = ((const float4*)bb)[j * 64 + lane];
        float4 o; o.x = v[j].x * rstd * gg.x + b4.x; o.y = v[j].y * rstd * gg.y + b4.y; o.z = v[j].z * rstd * gg.z + b4.z; o.w = v[j].w * rstd * gg.w + b4.w;
        ((float4*)orow)[j * 64 + lane] = o;
        ((uint2*)obrow)[j * 64 + lane] = make_uint2(pk2(o.x, o.y), pk2(o.z, o.w));
    }
}
__device__ void ln1_phase(int WV_, const float* hin, const float* add, const float* g, const float* bb, float* hout, bf16* hb) {
    const int lane = LTID(WV_) & 63, wave = LTID(WV_) >> 6;
    for (int row = LBID() * NWAVE + wave; row < T_; row += LGRID() * NWAVE) {
        float4 v[4];
#pragma unroll
        for (int j = 0; j < 4; ++j) {
            const float4 a = ((const float4*)(hin + (size_t)row * 1024))[j * 64 + lane], m = ((const float4*)(add + (size_t)row * 1024))[j * 64 + lane];
            v[j].x = ALPHA * a.x + m.x; v[j].y = ALPHA * a.y + m.y; v[j].z = ALPHA * a.z + m.z; v[j].w = ALPHA * a.w + m.w;
        }
        ln_row(v, g, bb, hout + (size_t)row * 1024, hb + (size_t)row * 1024, lane);
    }
}


typedef short bf16x8_t __attribute__((ext_vector_type(8)));
typedef float f32x16_t __attribute__((ext_vector_type(16)));
typedef float f32x2_t __attribute__((ext_vector_type(2)));
typedef __bf16 bf16x2_t __attribute__((ext_vector_type(2)));
__device__ __forceinline__ unsigned cvtpk(float lo, float hi) { f32x2_t v = {lo, hi}; bf16x2_t b = __builtin_convertvector(v, bf16x2_t); return __builtin_bit_cast(unsigned, b); }
__device__ __forceinline__ int crow(int r, int hi) { return (r & 3) + 8 * (r >> 2) + 4 * hi; }
__device__ __forceinline__ float xlane32(float v) { return __shfl_xor(v, 32); }
__device__ __forceinline__ float vmax(float a, float b) { float r; asm("v_max_f32_e32 %0, %1, %2" : "=v"(r) : "v"(a), "v"(b)); return r; }
__device__ __forceinline__ float vmin(float a, float b) { float r; asm("v_min_f32_e32 %0, %1, %2" : "=v"(r) : "v"(a), "v"(b)); return r; }
__device__ __forceinline__ float vmax3(float a, float b, float c) { float r; asm("v_max3_f32 %0, %1, %2, %3" : "=v"(r) : "v"(a), "v"(b), "v"(c)); return r; }

constexpr int AT_KP = 72, AT_VP = 96;
constexpr int AT_KS = 0, AT_KS_BYTES = 64 * AT_KP * 2;
constexpr int AT_VT = 2 * AT_KS_BYTES, AT_VT_BYTES = 64 * AT_VP * 2;
constexpr int AT_KM = AT_VT + 2 * AT_VT_BYTES;
constexpr int AT_MISC = AT_KM + 32 * AT_KP * 2;
constexpr float LOG2E = 1.4426950408889634f;

__device__ __forceinline__ unsigned mk_unit(int kind, int b, int x, int y) { return ((unsigned)kind << 30) | ((unsigned)b << 28) | ((unsigned)x << 8) | (unsigned)y; }
__device__ void build_unit_table(unsigned* tab, int i) {
    int n = 0; unsigned res = 0u;
#pragma unroll 1
    for (int c = 64; c >= 1; --c) {
        if (i >= n && i < n + 4) res = mk_unit(0, i - n, 0, c - 1);
        n += 4;
        if ((c & 3) == 0) { if (i >= n && i < n + 16) { const int j = i - n; res = mk_unit(2, j >> 2, j & 3, c / 4 - 1); } n += 16; }
    }
    if (i < 512) tab[i] = res;
}

template <int kind> __device__ __forceinline__ void attn_unit(int WV_, const bf16* P, const unsigned char* mask, const float* kmean, const float* sinks, bf16* ys,
                                unsigned char* lds, int b, int ux, int uy) {
    int tid_ = LTID(WV_); asm volatile("" : "+v"(tid_));
    const int tid = tid_, lane = tid & 63, wave = __builtin_amdgcn_readfirstlane(tid >> 6), r32 = lane & 31, hi = lane >> 5;
    bf16* s_km = (bf16*)(lds + AT_KM);
    const int skey = tid >> 3, sc = tid & 7;
    {
        const bf16* Pb = P + (size_t)b * S_ * NP;
        int q0w, qcol, kcol, vcol, ycol, kt_hi, kt_lo; float slope2 = 0.f, sink2 = 0.f;
        if (kind == 0) { const int head = wave >> 1; q0w = uy * 64 + (wave & 1) * 32; qcol = C_QA + head * 64; kcol = C_KA; vcol = C_VA; ycol = head * 64;
            slope2 = exp2f(-8.0f * (float)(3 * head + 1) / 12.0f) * LOG2E; kt_hi = uy; kt_lo = 0; }
        else if (kind == 1) { const int hq = ux * 2 + (wave >> 2); q0w = uy * 128 + (wave & 3) * 32; qcol = C_QB + hq * 64; kcol = C_KB + ux * 64; vcol = C_VB + ux * 64; ycol = 256 + hq * 64;
            slope2 = exp2f(-8.0f * (float)(3 * hq + 2) / 12.0f) * LOG2E; sink2 = sinks[hq] * LOG2E; kt_hi = 2 * uy + 1; kt_lo = (2 * uy - 2 > 0) ? 2 * uy - 2 : 0; }
        else if (kind == 2) { q0w = uy * 256 + wave * 32; qcol = C_QC + ux * 64; kcol = C_KC + ux * 64; vcol = C_VC + ux * 64; ycol = 512 + ux * 64;
            slope2 = exp2f(-8.0f * (float)(3 * ux + 3) / 12.0f) * LOG2E; kt_hi = 4 * uy + 3; kt_lo = 0; }
        else { q0w = uy * 256 + wave * 32; qcol = C_QD + ux * 64; kcol = C_KD + ux * 64; vcol = C_VD + ux * 64; ycol = 768 + ux * 64; kt_hi = 4 * uy + 3; kt_lo = 0; }
        const int qpos = q0w + r32;
        bf16x8_t qf[4];
        { const bf16* qp = Pb + (size_t)qpos * NP + qcol + 8 * hi;
#pragma unroll
          for (int ks = 0; ks < 4; ++ks) qf[ks] = *(const bf16x8_t*)(qp + 16 * ks); }
        {
            const float qs = (kind == 3) ? 0.125f : 0.125f * LOG2E;
            typedef unsigned u32x4_t __attribute__((ext_vector_type(4)));
#pragma unroll
            for (int ks = 0; ks < 4; ++ks) { u32x4_t w = __builtin_bit_cast(u32x4_t, qf[ks]);
#pragma unroll
                for (int i = 0; i < 4; ++i) w[i] = cvtpk(__uint_as_float(w[i] << 16) * qs, __uint_as_float(w[i] & 0xffff0000u) * qs);
                qf[ks] = __builtin_bit_cast(bf16x8_t, w); }
        }
        float sb[16];
#pragma unroll
        for (int r = 0; r < 16; ++r) sb[r] = slope2 * (float)((r & 3) + 8 * (r >> 2));
        unsigned bm = 0u;
        if (kind == 2) {
            const int own = uy;
            for (int e = tid; e < 32 * 64; e += NTHR) { const int row = e >> 6, d = e & 63; s_km[row * AT_KP + d] = (row < 16) ? (bf16)f2bf(kmean[((b * 4 + ux) * 16 + row) * 64 + d]) : (bf16)0; }
            __syncthreads();
            f32x16_t gacc;
#pragma unroll
            for (int r = 0; r < 16; ++r) gacc[r] = 0.f;
#pragma unroll
            for (int ks = 0; ks < 4; ++ks) { const bf16x8_t a = *(const bf16x8_t*)(s_km + r32 * AT_KP + 16 * ks + 8 * hi); gacc = __builtin_amdgcn_mfma_f32_32x32x16_bf16(a, qf[ks], gacc, 0, 0, 0); }
            float gt[16];
#pragma unroll
            for (int r = 0; r < 8; ++r) { const float mine = gacc[r], other = xlane32(mine); const int bi = crow(r, 0);
                gt[bi] = hi ? other : mine; gt[bi + 4] = hi ? mine : other; }
#pragma unroll
            for (int n = 0; n < 16; ++n) if (n >= own) gt[n] = -INFINITY;
#pragma unroll
            for (int rep = 0; rep < 3; ++rep) {
                float mx = -INFINITY;
#pragma unroll
                for (int n = 0; n < 16; ++n) mx = fmaxf(mx, gt[n]);
                bool done = !(mx > -INFINITY);
#pragma unroll
                for (int n = 0; n < 16; ++n) { const bool hit = !done && gt[n] == mx; if (hit) { bm |= 1u << n; gt[n] = -INFINITY; done = true; } }
            }
        }
        f32x16_t o0, o1;
#pragma unroll
        for (int r = 0; r < 16; ++r) { o0[r] = 0.f; o1[r] = 0.f; }
        float m_run = -INFINITY, l_run = 0.f, carry = 0.f;
        const bf16* kg = Pb + (size_t)skey * NP + kcol + sc * 8;
        const bf16* vg = Pb + (size_t)skey * NP + vcol + sc * 8;
        uint4 rk = *(const uint4*)(kg + (size_t)kt_hi * 64 * NP), rv = *(const uint4*)(vg + (size_t)kt_hi * 64 * NP);
        int buf = 0;
        { bf16* ks_ = (bf16*)(lds + AT_KS); bf16* vt_ = (bf16*)(lds + AT_VT);
          *(uint4*)(ks_ + skey * AT_KP + sc * 8) = rk;
          *(uint4*)(vt_ + skey * AT_VP + sc * 8) = rv; }
        __syncthreads();
        bool wave_done = false;
        uint2 mw_next = make_uint2(0u, 0u);
        if (kind == 0) mw_next = *(const uint2*)(mask + (size_t)(b * S_ + qpos) * 512 + kt_hi * 8);
        for (int kt = kt_hi; kt >= kt_lo; --kt) {
            const bool more = kt > kt_lo;
            const uint2 mw = mw_next;
            if (kind == 0 && more) mw_next = *(const uint2*)(mask + (size_t)(b * S_ + qpos) * 512 + (kt - 1) * 8);
            if (more) { rk = *(const uint4*)(kg + (size_t)(kt - 1) * 64 * NP); rv = *(const uint4*)(vg + (size_t)(kt - 1) * 64 * NP); }
            const bf16* ks_ = (const bf16*)(lds + AT_KS + buf * AT_KS_BYTES);
            const bf16* vt_ = (const bf16*)(lds + AT_VT + buf * AT_VT_BYTES);
            bool active = (kt * 64 <= q0w + 31) && !wave_done;
            if (kind == 1) active = active && (kt * 64 + 63 >= q0w - 127);
            if (active) {
                const int kbase = kt * 64 + 4 * hi;
                f32x16_t p0, p1;
                if (kind != 3) {
                    const float cb = slope2 * (float)(kbase - qpos), cb1 = cb + 32.0f * slope2;
#pragma unroll
                    for (int r = 0; r < 16; ++r) { p0[r] = cb + sb[r]; p1[r] = cb1 + sb[r]; }
                } else {
#pragma unroll
                    for (int r = 0; r < 16; ++r) { p0[r] = 0.f; p1[r] = 0.f; }
                }
#pragma unroll
                for (int ks = 0; ks < 4; ++ks) {
                    const bf16x8_t a0 = *(const bf16x8_t*)(ks_ + r32 * AT_KP + 16 * ks + 8 * hi);
                    const bf16x8_t a1 = *(const bf16x8_t*)(ks_ + (32 + r32) * AT_KP + 16 * ks + 8 * hi);
                    p0 = __builtin_amdgcn_mfma_f32_32x32x16_bf16(a0, qf[ks], p0, 0, 0, 0);
                    p1 = __builtin_amdgcn_mfma_f32_32x32x16_bf16(a1, qf[ks], p1, 0, 0, 0);
                }
                if (kind != 3) {
                    float mx = -INFINITY;
                    if (kind == 0) {
                        const unsigned w0 = mw.x >> (4 * hi), w1 = mw.y >> (4 * hi);
#pragma unroll
                        for (int r = 0; r < 16; ++r) { const int off = (r & 3) + 8 * (r >> 2);
                            p0[r] = (w0 & (1u << off)) ? p0[r] : -INFINITY; p1[r] = (w1 & (1u << off)) ? p1[r] : -INFINITY; mx = vmax3(mx, p0[r], p1[r]); }
                    } else if (kind == 1) {
                        const int rel = qpos - kbase;
#pragma unroll
                        for (int r = 0; r < 16; ++r) { const int off = (r & 3) + 8 * (r >> 2);
                            p0[r] = ((unsigned)(rel - off) < 128u) ? p0[r] : -INFINITY; p1[r] = ((unsigned)(rel - off - 32) < 128u) ? p1[r] : -INFINITY; mx = vmax3(mx, p0[r], p1[r]); }
                    } else {
                        if ((kt >> 2) == uy) {
                            const int rel = qpos - kbase;
#pragma unroll
                            for (int r = 0; r < 16; ++r) { const int off = (r & 3) + 8 * (r >> 2);
                                p0[r] = (off <= rel) ? p0[r] : -INFINITY; p1[r] = (off + 32 <= rel) ? p1[r] : -INFINITY; mx = vmax3(mx, p0[r], p1[r]); }
                        } else {
                            const bool tile_ok = ((bm >> (kt >> 2)) & 1u) != 0u;
#pragma unroll
                            for (int r = 0; r < 16; ++r) { p0[r] = tile_ok ? p0[r] : -INFINITY; p1[r] = tile_ok ? p1[r] : -INFINITY; mx = vmax3(mx, p0[r], p1[r]); }
                        }
                    }
                    mx = vmax(mx, xlane32(mx));
                    const float m_new = vmax(m_run, mx);
                    const float m_safe = (m_new == -INFINITY) ? 0.f : m_new;
                    p0 = p0 - m_safe; p1 = p1 - m_safe;
#pragma unroll
                    for (int r = 0; r < 16; ++r) { p0[r] = __builtin_amdgcn_exp2f(p0[r]); p1[r] = __builtin_amdgcn_exp2f(p1[r]); }
                    float ls;
                    { typedef float f32x8_t __attribute__((ext_vector_type(8))); typedef float f32x4v_t __attribute__((ext_vector_type(4)));
                      const f32x16_t t16 = p0 + p1; const f32x8_t t8 = t16.lo + t16.hi; const f32x4v_t t4 = t8.lo + t8.hi; const f32x2_t t2 = t4.lo + t4.hi; ls = t2.x + t2.y; }
                    if (__any(m_new > m_run)) {
                        const float alpha = __builtin_amdgcn_exp2f(m_run - m_safe);
                        l_run *= alpha;
                        o0 = o0 * alpha; o1 = o1 * alpha;
                    }
                    l_run += ls; m_run = m_new;
                } else {
                    float run = carry;
#define SB_HALF(PX, KOFF) do { \
                    float lk[16]; \
                    _Pragma("unroll") for (int r = 0; r < 16; ++r) { \
                        const int off = (r & 3) + 8 * (r >> 2); \
                        const bool v = (kbase + off + (KOFF)) < qpos; \
                        const float z = PX[r]; \
                        const float t = 0.6931471805599453f * __builtin_amdgcn_logf(1.0f + __builtin_amdgcn_exp2f(-LOG2E * fabsf(z))); \
                        lk[r] = v ? (fminf(-z, 0.f) - t) : 0.f; \
                        PX[r] = v ? (fminf(z, 0.f) - t) : -INFINITY; } \
                    _Pragma("unroll") for (int g = 3; g >= 0; --g) { \
                        const float G = (lk[4 * g] + lk[4 * g + 1]) + (lk[4 * g + 2] + lk[4 * g + 3]); \
                        const float PG = xlane32(G); \
                        float la = run + (hi ? 0.f : PG); \
                        run += G + PG; \
                        PX[4 * g + 3] += la; la += lk[4 * g + 3]; PX[4 * g + 2] += la; la += lk[4 * g + 2]; PX[4 * g + 1] += la; la += lk[4 * g + 1]; PX[4 * g] += la; } \
                    _Pragma("unroll") for (int r = 0; r < 16; ++r) PX[r] = __builtin_amdgcn_exp2f(LOG2E * PX[r]); } while (0)
                    SB_HALF(p1, 32);
                    SB_HALF(p0, 0);
#undef SB_HALF
                    carry = run;
                }
                unsigned pw[16];
#pragma unroll
                for (int j = 0; j < 8; ++j) { pw[j] = cvtpk(p0[2 * j], p0[2 * j + 1]); pw[8 + j] = cvtpk(p1[2 * j], p1[2 * j + 1]); }
#pragma unroll
                for (int s = 0; s < 4; ++s) {
                    bf16x8_t pb; { const unsigned* q = pw + 4 * s; typedef unsigned u32x4_t __attribute__((ext_vector_type(4))); u32x4_t t4 = {q[0], q[1], q[2], q[3]}; pb = __builtin_bit_cast(bf16x8_t, t4); }
#pragma unroll
                    for (int dt = 0; dt < 2; ++dt) {
                        typedef short s16x4_t __attribute__((ext_vector_type(4)));
                        typedef __attribute__((address_space(3))) s16x4_t lds_s16x4;
                        const int gi_ = lane & 15;
                        const bf16* vp = vt_ + (16 * s + 4 * hi + (gi_ >> 2)) * AT_VP + 32 * dt + 16 * ((lane >> 4) & 1) + 4 * (gi_ & 3);
                        const s16x4_t lo = __builtin_amdgcn_ds_read_tr16_b64_v4i16((lds_s16x4*)vp), hi4 = __builtin_amdgcn_ds_read_tr16_b64_v4i16((lds_s16x4*)(vp + 8 * AT_VP));
                        const bf16x8_t va = {lo[0], lo[1], lo[2], lo[3], hi4[0], hi4[1], hi4[2], hi4[3]};
                        if (dt == 0) o0 = __builtin_amdgcn_mfma_f32_32x32x16_bf16(va, pb, o0, 0, 0, 0);
                        else         o1 = __builtin_amdgcn_mfma_f32_32x32x16_bf16(va, pb, o1, 0, 0, 0);
                    }
                }
            }
            if (kind == 3) {
                const float cm = carry;
                if (__all(cm < -110.0f) || !(kt * 64 <= q0w + 31) ) { if (__all(cm < -110.0f)) wave_done = true; }
            }
            if (more) {
                bf16* ksn = (bf16*)(lds + AT_KS + (buf ^ 1) * AT_KS_BYTES); bf16* vtn = (bf16*)(lds + AT_VT + (buf ^ 1) * AT_VT_BYTES);
                *(uint4*)(ksn + skey * AT_KP + sc * 8) = rk;
                *(uint4*)(vtn + skey * AT_VP + sc * 8) = rv;
            }
            if (kind == 3) { if (__syncthreads_and(wave_done ? 1 : 0)) break; }
            else __syncthreads();
            buf ^= 1;
        }
        float inv;
        if (kind == 3) inv = 1.0f;
        else {
            float lt = l_run + xlane32(l_run);
            if (kind == 1) { const float mf = fmaxf(m_run, sink2); const float sc2 = exp2f(m_run - mf); lt = lt * sc2 + exp2f(sink2 - mf); inv = sc2 / lt; }
            else inv = 1.0f / lt;
        }
        bf16* yp = ys + (size_t)(b * S_ + qpos) * 1024 + ycol + 4 * hi;
#pragma unroll
        for (int g = 0; g < 4; ++g) {
            *(uint2*)(yp + 8 * g) = make_uint2(cvtpk(o0[4 * g] * inv, o0[4 * g + 1] * inv), cvtpk(o0[4 * g + 2] * inv, o0[4 * g + 3] * inv));
            *(uint2*)(yp + 32 + 8 * g) = make_uint2(cvtpk(o1[4 * g] * inv, o1[4 * g + 1] * inv), cvtpk(o1[4 * g + 2] * inv, o1[4 * g + 3] * inv));
        }
    }
}
__device__ void attn_fast_phase(int WV_, const bf16* P, const unsigned char* mask, const float* kmean, const float* sinks, bf16* ys,
                                const unsigned* utab, unsigned* counter, unsigned char* lds) {
    volatile unsigned* s_unit = (volatile unsigned*)(lds + AT_MISC);
    for (;;) {
        __syncthreads();
        if (LTID(WV_) == 0) s_unit[0] = atomicAdd(counter, 1u);
        __syncthreads();
        const unsigned ui = s_unit[0];
        if (ui >= 512u) break;
        const unsigned ue = utab[ui];
        const int kind = (int)(ue >> 30), b = (int)((ue >> 28) & 3u), ux = (int)((ue >> 8) & 255u), uy = (int)(ue & 255u);
        if (kind == 0) attn_unit<0>(WV_, P, mask, kmean, sinks, ys, lds, b, ux, uy);
        else attn_unit<2>(WV_, P, mask, kmean, sinks, ys, lds, b, ux, uy);
    }
    for (int u = LBID(); u < 256; u += LGRID()) { __syncthreads(); attn_unit<3>(WV_, P, mask, kmean, sinks, ys, lds, u >> 6, (u >> 4) & 3, u & 15); }
    for (int u = LBID(); u < 256; u += LGRID()) { __syncthreads(); attn_unit<1>(WV_, P, mask, kmean, sinks, ys, lds, u >> 6, (u >> 5) & 1, u & 31); }
}

constexpr float U_SCALE = 128.0f, V_SCALE = 48.0f;
constexpr int ROW6 = 1536;
typedef float v32f_t __attribute__((ext_vector_type(32)));
typedef unsigned v6u_t __attribute__((ext_vector_type(6)));
typedef unsigned u32x4a8_t __attribute__((ext_vector_type(4), aligned(8)));
__device__ __forceinline__ float rdlane_f(float v, int l) { return __builtin_bit_cast(float, __builtin_amdgcn_readlane(__builtin_bit_cast(int, v), l)); }
__device__ __forceinline__ unsigned q_e2m3(float v) {
    const float a = fminf(fabsf(v), 7.5f);
    unsigned code;
    if (a < 1.0f) code = (unsigned)rintf(a * 8.0f);
    else if (a < 2.0f) code = 8u + (unsigned)rintf((a - 1.0f) * 8.0f);
    else if (a < 4.0f) code = 16u + (unsigned)rintf((a - 2.0f) * 4.0f);
    else code = 24u + (unsigned)rintf((a - 4.0f) * 2.0f);
    return code | (v < 0.f ? 32u : 0u);
}
__device__ void convert_tables(int WV_, const Params& p) {
    const size_t nchunk = (size_t)DEPTH_ * 16384 * 2 * 32;
    for (size_t i = (size_t)LBID() * NTHR + LTID(WV_); i < nchunk; i += (size_t)LGRID() * NTHR) {
        const int c = (int)(i & 31), uvsel = (int)((i >> 5) & 1); const size_t le = i >> 6;
        const float* src = (uvsel ? p.in[10] : p.in[9]) + le * 1024 + c * 32;
        const float sc = uvsel ? V_SCALE : U_SCALE;
        unsigned w[6] = {0u, 0u, 0u, 0u, 0u, 0u};
#pragma unroll
        for (int q4 = 0; q4 < 8; ++q4) {
            const float4 a = ((const float4*)src)[q4];
            const float av[4] = {a.x, a.y, a.z, a.w};
#pragma unroll
            for (int e = 0; e < 4; ++e) { const int idx = q4 * 4 + e, bit = 6 * idx, d = bit >> 5, s = bit & 31; const unsigned code = q_e2m3(av[e] * sc);
                w[d] |= code << s; if (s > 26) w[d + 1] |= code >> (32 - s); }
        }
        uint2* dst = (uint2*)(p.ws + WS_UV + le * ROW6 + uvsel * 768 + c * 24);
        dst[0] = make_uint2(w[0], w[1]); dst[1] = make_uint2(w[2], w[3]); dst[2] = make_uint2(w[4], w[5]);
    }
}
__device__ __forceinline__ v6u_t ld_pk6(const unsigned char* ptr) {
    const uint2 a = ((const uint2*)ptr)[0], b = ((const uint2*)ptr)[1], c = ((const uint2*)ptr)[2];
    const v6u_t pk = {a.x, a.y, b.x, b.y, c.x, c.y};
    return pk;
}
__device__ void peer_fast_phase(int WV_, float* h, bf16* hb, const int* eid, const float* gate, const unsigned char* uv, const float* g1, const float* b1, const float* g, const float* bb, unsigned char* lds) {
    const int tid = LTID(WV_), lane = tid & 63, wave = tid >> 6, l32 = lane & 31, hi = lane >> 5;
    float* pl = (float*)(lds + wave * 16384);
    unsigned char* raw = lds + wave * 16384 + 4096 + lane * 24;
    for (int t = LBID() * NWAVE + wave; t < T_; t += LGRID() * NWAVE) {
        float* hr = h + (size_t)t * 1024 + l32 * 32;
        float x[32], acc[32];
#pragma unroll
        for (int q4 = 0; q4 < 8; ++q4) { const float4 a = ((const float4*)hr)[q4]; x[4 * q4] = a.x; x[4 * q4 + 1] = a.y; x[4 * q4 + 2] = a.z; x[4 * q4 + 3] = a.w; }
        {
            float s = 0.f;
#pragma unroll
            for (int i = 0; i < 32; ++i) s += x[i];
#pragma unroll
            for (int o = 16; o > 0; o >>= 1) s += __shfl_xor(s, o);
            const float mean = s * (1.0f / 1024.0f);
            float s2 = 0.f;
#pragma unroll
            for (int i = 0; i < 32; ++i) { x[i] -= mean; s2 += x[i] * x[i]; }
#pragma unroll
            for (int o = 16; o > 0; o >>= 1) s2 += __shfl_xor(s2, o);
            const float rstd = 1.0f / sqrtf(s2 * (1.0f / 1024.0f) + LN_EPS);
#pragma unroll
            for (int q4 = 0; q4 < 8; ++q4) { const float4 gg = ((const float4*)(g1 + l32 * 32))[q4], cc = ((const float4*)(b1 + l32 * 32))[q4];
                x[4 * q4] = x[4 * q4] * rstd * gg.x + cc.x; x[4 * q4 + 1] = x[4 * q4 + 1] * rstd * gg.y + cc.y; x[4 * q4 + 2] = x[4 * q4 + 2] * rstd * gg.z + cc.z; x[4 * q4 + 3] = x[4 * q4 + 3] * rstd * gg.w + cc.w; }
        }
#pragma unroll
        for (int i = 0; i < 32; ++i) acc[i] = 0.f;
#pragma unroll 1
        for (int batch = 0; batch < 4; ++batch) {
            const int my_eid = eid[(size_t)t * 128 + batch * 32 + l32];
            const float my_gate = gate[(size_t)t * 128 + batch * 32 + l32];
#pragma unroll 1
            for (int grp = 0; grp < 2; ++grp) {
                { u32x4a8_t pa[8]; uint2 pc[8];
#pragma unroll
                  for (int i = 0; i < 8; ++i) { const int id = __shfl(my_eid, 2 * (grp * 8 + i) + hi); const unsigned char* rp = uv + (size_t)id * ROW6 + l32 * 24; pa[i] = *(const u32x4a8_t*)rp; pc[i] = *(const uint2*)(rp + 16); }
#pragma unroll
                  for (int i = 0; i < 8; ++i) { uint2* wp = (uint2*)(raw + i * 1536); wp[0] = make_uint2(pa[i].x, pa[i].y); wp[1] = make_uint2(pa[i].z, pa[i].w); wp[2] = pc[i]; } }
#pragma unroll 1
                for (int i = 0; i < 8; ++i) {
                    const uint2* rp = (const uint2*)(raw + i * 1536); const uint2 a = rp[0], b = rp[1], c = rp[2];
                    const v6u_t pk6 = {a.x, a.y, b.x, b.y, c.x, c.y}; const v32f_t f = __builtin_amdgcn_cvt_scalef32_pk32_f32_fp6(pk6, 1.0f);
                    f32x2_t dv0 = {0.f, 0.f}, dv1 = {0.f, 0.f};
#pragma unroll
                    for (int j = 0; j < 8; ++j) { const f32x2_t fa = {f[2 * j], f[2 * j + 1]}, fb = {f[16 + 2 * j], f[17 + 2 * j]}, xa = {x[2 * j], x[2 * j + 1]}, xb = {x[16 + 2 * j], x[17 + 2 * j]};
                        dv0 = fa * xa + dv0; dv1 = fb * xb + dv1; }
                    pl[(2 * (grp * 8 + i) + hi) * 32 + l32] = (dv0.x + dv0.y) + (dv1.x + dv1.y);
                }
            }
            float d;
            { const float4* pr = (const float4*)(pl + l32 * 32); float4 s4 = pr[0];
#pragma unroll
              for (int i = 1; i < 8; ++i) { const float4 v = pr[i]; s4.x += v.x; s4.y += v.y; s4.z += v.z; s4.w += v.w; }
              d = ((s4.x + s4.y) + (s4.z + s4.w)) * (1.0f / U_SCALE); }
            const float hv = 0.5f * d * (1.0f + erff(d * 0.70710678118654752f)) * my_gate * (1.0f / V_SCALE);
#pragma unroll 1
            for (int grp = 0; grp < 2; ++grp) {
                { u32x4a8_t pa[8]; uint2 pc[8];
#pragma unroll
                  for (int i = 0; i < 8; ++i) { const int id = __shfl(my_eid, 2 * (grp * 8 + i) + hi); const unsigned char* rp = uv + (size_t)id * ROW6 + 768 + l32 * 24; pa[i] = *(const u32x4a8_t*)rp; pc[i] = *(const uint2*)(rp + 16); }
#pragma unroll
                  for (int i = 0; i < 8; ++i) { uint2* wp = (uint2*)(raw + i * 1536); wp[0] = make_uint2(pa[i].x, pa[i].y); wp[1] = make_uint2(pa[i].z, pa[i].w); wp[2] = pc[i]; } }
#pragma unroll 1
                for (int i = 0; i < 8; ++i) {
                    const float c = __shfl(hv, 2 * (grp * 8 + i) + hi);
                    const uint2* rp = (const uint2*)(raw + i * 1536); const uint2 a = rp[0], b = rp[1], cc = rp[2];
                    const v6u_t pk6 = {a.x, a.y, b.x, b.y, cc.x, cc.y}; const v32f_t f = __builtin_amdgcn_cvt_scalef32_pk32_f32_fp6(pk6, 1.0f);
                    const f32x2_t c2 = {c, c};
#pragma unroll
                    for (int j = 0; j < 16; ++j) { const f32x2_t fj = {f[2 * j], f[2 * j + 1]}; f32x2_t aj = {acc[2 * j], acc[2 * j + 1]}; aj = fj * c2 + aj; acc[2 * j] = aj.x; acc[2 * j + 1] = aj.y; }
                }
            }
        }
        float y[32], s = 0.f;
#pragma unroll
        for (int i = 0; i < 32; ++i) { acc[i] += __shfl_xor(acc[i], 32); y[i] = ALPHA * x[i] + acc[i]; s += y[i]; }
#pragma unroll
        for (int o = 16; o > 0; o >>= 1) s += __shfl_xor(s, o);
        const float mean = s * (1.0f / 1024.0f);
        float s2 = 0.f;
#pragma unroll
        for (int i = 0; i < 32; ++i) { y[i] -= mean; s2 += y[i] * y[i]; }
#pragma unroll
        for (int o = 16; o > 0; o >>= 1) s2 += __shfl_xor(s2, o);
        const float rstd = 1.0f / sqrtf(s2 * (1.0f / 1024.0f) + LN_EPS);
        float o[16];
#pragma unroll
        for (int q4 = 0; q4 < 4; ++q4) {
            const float4 gg = ((const float4*)(g + l32 * 32 + hi * 16))[q4], cc = ((const float4*)(bb + l32 * 32 + hi * 16))[q4];
            float ya[4], yb2[4];
#pragma unroll
            for (int e = 0; e < 4; ++e) { ya[e] = y[4 * q4 + e]; yb2[e] = y[16 + 4 * q4 + e]; }
            asm volatile("" : "+v"(ya[0]), "+v"(ya[1]), "+v"(ya[2]), "+v"(ya[3]), "+v"(yb2[0]), "+v"(yb2[1]), "+v"(yb2[2]), "+v"(yb2[3]));
            const float y0 = hi ? yb2[0] : ya[0], y1 = hi ? yb2[1] : ya[1], y2 = hi ? yb2[2] : ya[2], y3 = hi ? yb2[3] : ya[3];
            o[4 * q4] = y0 * rstd * gg.x + cc.x; o[4 * q4 + 1] = y1 * rstd * gg.y + cc.y; o[4 * q4 + 2] = y2 * rstd * gg.z + cc.z; o[4 * q4 + 3] = y3 * rstd * gg.w + cc.w;
            ((float4*)(hr + hi * 16))[q4] = make_float4(o[4 * q4], o[4 * q4 + 1], o[4 * q4 + 2], o[4 * q4 + 3]);
        }
        uint4* hbp = (uint4*)(hb + (size_t)t * 1024 + l32 * 32 + hi * 16);
        hbp[0] = make_uint4(pk2(o[0], o[1]), pk2(o[2], o[3]), pk2(o[4], o[5]), pk2(o[6], o[7]));
        hbp[1] = make_uint4(pk2(o[8], o[9]), pk2(o[10], o[11]), pk2(o[12], o[13]), pk2(o[14], o[15]));
    }
}

__device__ __forceinline__ float pack_pl(float v, unsigned pl) { return __uint_as_float((__float_as_uint(v) & ~127u) | pl); }
__device__ __forceinline__ void ins16(float (&s)[16], float x) {
#pragma unroll
    for (int k = 15; k >= 1; --k) s[k] = __builtin_amdgcn_fmed3f(s[k - 1], x, s[k]);
    s[0] = vmax(s[0], x);
}
template <int D> __device__ __forceinline__ void bitonic_stage(float (&c)[16]) {
#pragma unroll
    for (int i = 0; i < 16; ++i) if ((i & D) == 0) { const float a = vmax(c[i], c[i + D]), b = vmin(c[i], c[i + D]); c[i] = a; c[i + D] = b; }
}
__device__ __forceinline__ int decode_key(unsigned pl) { return (int)(32u * ((pl >> 4) & 3u) + (pl & 3u) + 8u * ((pl >> 2) & 3u) + 4u * ((pl >> 6) & 1u)); }
__device__ void route_fast_phase(int WV_, const bf16* qb, const bf16* skb  , int* eid, float* gate, unsigned char* lds, int pm = -1, int pn = 0) {
    const int tid = LTID(WV_), lane = tid & 63, wave = tid >> 6, r32 = lane & 31, hi = lane >> 5;
    unsigned* lidx = (unsigned*)lds + wave * (64 * 33) + lane * 33;
    const int u_first = (pm >= 0) ? 0 : LBID() * NWAVE + wave, u_end = (pm >= 0) ? 2 : (T_ / 32) * 8, u_step = (pm >= 0) ? 1 : LGRID() * NWAVE;
    for (int unit = u_first; unit < u_end; unit += u_step) {
        const int h = (pm >= 0) ? 2 * pn + unit : (unit & 7), t = ((pm >= 0) ? 8 * pm + wave : (unit >> 3)) * 32 + r32;
        float sl[2][16];
#pragma unroll
        for (int p = 0; p < 2; ++p) {
            bf16x8_t qf[4];
            { const bf16* qp = qb + (size_t)t * 1024 + h * 128 + p * 64 + 8 * hi;
#pragma unroll
              for (int ks = 0; ks < 4; ++ks) qf[ks] = *(const bf16x8_t*)(qp + 16 * ks); }
            float s[16];
#pragma unroll
            for (int k = 0; k < 16; ++k) s[k] = -INFINITY;
            const bf16* skp = skb + ((size_t)(h * 2 + p) * 128 + r32) * 64 + 8 * hi;
#pragma unroll
            for (int kt = 0; kt < 4; ++kt) {
                f32x16_t acc;
#pragma unroll
                for (int r = 0; r < 16; ++r) acc[r] = 0.f;
#pragma unroll
                for (int ks = 0; ks < 4; ++ks) { const bf16x8_t a = *(const bf16x8_t*)(skp + (size_t)kt * 32 * 64 + 16 * ks); acc = __builtin_amdgcn_mfma_f32_32x32x16_bf16(a, qf[ks], acc, 0, 0, 0); }
#pragma unroll
                for (int r = 0; r < 16; ++r) ins16(s, pack_pl(acc[r], (unsigned)(kt * 16 + r)));
            }
            const unsigned hb = (unsigned)hi << 6;
#pragma unroll
            for (int k = 0; k < 16; ++k) s[k] = __uint_as_float(__float_as_uint(s[k]) | hb);
            float c[16];
#pragma unroll
            for (int k = 0; k < 16; ++k) c[k] = vmax(s[k], __shfl_xor(s[15 - k], 32));
            bitonic_stage<8>(c); bitonic_stage<4>(c); bitonic_stage<2>(c); bitonic_stage<1>(c);
#pragma unroll
            for (int k = 0; k < 16; ++k) { sl[p][k] = c[k]; lidx[p * 16 + k] = (unsigned)decode_key(__float_as_uint(c[k]) & 127u); }
        }
        float w[16];
#pragma unroll
        for (int k = 0; k < 16; ++k) w[k] = -INFINITY;
#pragma unroll
        for (int i = 0; i < 16; ++i)
#pragma unroll
            for (int j = 0; j < 16; ++j)
                if ((i + 1) * (j + 1) <= 16) { const float v = sl[0][i] + sl[1][j]; ins16(w, __uint_as_float((__float_as_uint(v) & ~255u) | (unsigned)(i * 16 + j))); }
        float e[16], sum = 0.f;
#pragma unroll
        for (int k = 0; k < 16; ++k) { e[k] = expf(w[k] - w[0]); sum += e[k]; }
        const float inv = 1.0f / sum;
        int ide[8]; float gte[8];
#pragma unroll
        for (int k = 0; k < 8; ++k) {
            float wa = w[k], wb = w[8 + k], ea = e[k], eb = e[8 + k];
            asm volatile("" : "+v"(wa), "+v"(wb), "+v"(ea), "+v"(eb));
            const float wv = hi ? wb : wa;
            const unsigned pl = __float_as_uint(wv) & 255u;
            ide[k] = (int)(lidx[pl >> 4] * 128u + lidx[16 + (pl & 15u)]);
            gte[k] = (hi ? eb : ea) * inv;
        }
        int* ep = eid + (size_t)t * 128 + h * 16 + hi * 8; float* gp = gate + (size_t)t * 128 + h * 16 + hi * 8;
        *(int4*)ep = make_int4(ide[0], ide[1], ide[2], ide[3]); *(int4*)(ep + 4) = make_int4(ide[4], ide[5], ide[6], ide[7]);
        *(float4*)gp = make_float4(gte[0], gte[1], gte[2], gte[3]); *(float4*)(gp + 4) = make_float4(gte[4], gte[5], gte[6], gte[7]);
    }
}

typedef float f32x4_t __attribute__((ext_vector_type(4)));
typedef __bf16 bf16x2v __attribute__((ext_vector_type(2)));
__device__ __forceinline__ float dot2bf(unsigned a, unsigned b, float c) { return __builtin_amdgcn_fdot2_f32_bf16(__builtin_bit_cast(bf16x2v, a), __builtin_bit_cast(bf16x2v, b), c, false); }
__device__ __forceinline__ void cnt_gt(int& cnt, unsigned a, unsigned b) { asm("v_cmp_gt_u32_e32 vcc, %1, %2\n\tv_addc_co_u32_e32 %0, vcc, 0, %0, vcc" : "+v"(cnt) : "v"(a), "v"(b) : "vcc"); }
__device__ __forceinline__ void cnt_eq(int& cnt, unsigned a, unsigned b) { asm("v_cmp_eq_u32_e32 vcc, %1, %2\n\tv_addc_co_u32_e32 %0, vcc, 0, %0, vcc" : "+v"(cnt) : "v"(a), "v"(b) : "vcc"); }
__device__ __forceinline__ unsigned flag_gt(unsigned a, unsigned b) { unsigned r; asm("v_cmp_gt_u32_e32 vcc, %1, %2\n\tv_cndmask_b32_e64 %0, 0, 1, vcc" : "=v"(r) : "v"(a), "v"(b) : "vcc"); return r; }
__device__ __forceinline__ unsigned flag_eq(unsigned a, unsigned b) { unsigned r; asm("v_cmp_eq_u32_e32 vcc, %1, %2\n\tv_cndmask_b32_e64 %0, 0, 1, vcc" : "=v"(r) : "v"(a), "v"(b) : "vcc"); return r; }
__device__ __forceinline__ void cnt_ge(int& cnt, unsigned key, unsigned cand) { asm("v_cmp_ge_u32_e32 vcc, %1, %2\n\tv_addc_co_u32_e32 %0, vcc, 0, %0, vcc" : "+v"(cnt) : "v"(key), "v"(cand) : "vcc"); }

template <int CTRL, int RM> __device__ __forceinline__ unsigned dpp0(unsigned v) { return (unsigned)__builtin_amdgcn_update_dpp(0, (int)v, CTRL, RM, 0xf, false); }
template <int CTRL> __device__ __forceinline__ unsigned dppf(unsigned v) { return (unsigned)__builtin_amdgcn_update_dpp(-1, (int)v, CTRL, 0xf, 0xf, false); }
__device__ __forceinline__ unsigned wave_sum_u_dpp(unsigned v) {
    v += dpp0<0xB1, 0xf>(v); v += dpp0<0x4E, 0xf>(v); v += dpp0<0x141, 0xf>(v); v += dpp0<0x140, 0xf>(v);
    return (unsigned)__builtin_amdgcn_readlane((int)v, 0) + (unsigned)__builtin_amdgcn_readlane((int)v, 16) + (unsigned)__builtin_amdgcn_readlane((int)v, 32) + (unsigned)__builtin_amdgcn_readlane((int)v, 48);
}
__device__ __forceinline__ unsigned wave_min_u_dpp(unsigned v) {
    unsigned t;
    t = dppf<0xB1>(v); v = t < v ? t : v; t = dppf<0x4E>(v); v = t < v ? t : v; t = dppf<0x141>(v); v = t < v ? t : v; t = dppf<0x140>(v); v = t < v ? t : v;
    const unsigned a = (unsigned)__builtin_amdgcn_readlane((int)v, 0), b = (unsigned)__builtin_amdgcn_readlane((int)v, 16), c = (unsigned)__builtin_amdgcn_readlane((int)v, 32), d = (unsigned)__builtin_amdgcn_readlane((int)v, 48);
    const unsigned ab = a < b ? a : b, cd = c < d ? c : d; return ab < cd ? ab : cd;
}
__device__ __forceinline__ unsigned wave_incl_scan_u_dpp(unsigned v) {
    v += dpp0<0x111, 0xf>(v); v += dpp0<0x112, 0xf>(v); v += dpp0<0x114, 0xf>(v); v += dpp0<0x118, 0xf>(v);
    v += dpp0<0x142, 0xa>(v);
    v += dpp0<0x143, 0xc>(v);
    return v;
}
typedef __attribute__((address_space(3))) unsigned lds_u32;
template <int SHIFT> __device__ __forceinline__ unsigned radix_pass(const unsigned (&key)[64], unsigned pre, lds_u32* hist, int lane, int& need, int jlim, unsigned L) {
    typedef unsigned u32x4v __attribute__((ext_vector_type(4)));
    typedef __attribute__((address_space(3))) u32x4v lds_u32x4;
    const int fl = 63 - lane;
    { const u32x4v z4 = {0u, 0u, 0u, 0u};
#pragma unroll
      for (int i = 0; i < 8; ++i) ((lds_u32x4*)(hist + fl * 32))[i] = z4; }
    const unsigned hb = (unsigned)(size_t)hist + 4u * (unsigned)(lane & 7);
    const unsigned one = 1u;
    asm volatile("" ::: "memory");
#pragma unroll
    for (int j4 = 0; j4 < 16; ++j4) {
        if (4 * j4 <= jlim) {
            bool grp = true;
            if (SHIFT <= 8) {
                const bool any = ((key[4 * j4] >> (SHIFT + 8)) == pre) | ((key[4 * j4 + 1] >> (SHIFT + 8)) == pre) | ((key[4 * j4 + 2] >> (SHIFT + 8)) == pre) | ((key[4 * j4 + 3] >> (SHIFT + 8)) == pre);
                grp = __ballot(any) != 0ull;
            }
            if (grp) {
#pragma unroll
                for (int e = 0; e < 4; ++e) { const int j = 4 * j4 + e;
                    const unsigned addr = hb + (((key[j] >> SHIFT) & 255u) << 5);
                    unsigned long long sv;
                    if (SHIFT == 24) asm volatile("v_cmp_ge_u32_e32 vcc, %1, %2\n\ts_and_saveexec_b64 %0, vcc\n\tds_add_u32 %3, %4\n\ts_mov_b64 exec, %0" : "=&s"(sv) : "v"(key[j]), "v"(L), "v"(addr), "v"(one) : "vcc", "memory");
                    else { const unsigned t = key[j] >> ((SHIFT + 8) & 31);
                        asm volatile("v_cmp_eq_u32_e32 vcc, %1, %2\n\ts_and_saveexec_b64 %0, vcc\n\tds_add_u32 %3, %4\n\ts_mov_b64 exec, %0" : "=&s"(sv) : "v"(t), "v"(pre), "v"(addr), "v"(one) : "vcc", "memory"); }
                }
            }
        }
    }
    asm volatile("s_waitcnt lgkmcnt(0)" ::: "memory");
    unsigned dsum[4]; unsigned sumL = 0u;
#pragma unroll
    for (int i = 0; i < 4; ++i) { const u32x4v v0 = ((const lds_u32x4*)(hist + fl * 32))[2 * i], v1 = ((const lds_u32x4*)(hist + fl * 32))[2 * i + 1];
        dsum[i] = ((v0.x + v0.y) + (v0.z + v0.w)) + ((v1.x + v1.y) + (v1.z + v1.w)); sumL += dsum[i]; }
    const unsigned incl = wave_incl_scan_u_dpp(sumL);
    const unsigned above = incl - sumL;
    const bool own = (above < (unsigned)need) && ((unsigned)need <= above + sumL);
    const int owner = __ffsll((long long)__ballot(own)) - 1;
    unsigned acc = above; int sel = -1; unsigned cab = 0u;
#pragma unroll
    for (int i = 3; i >= 0; --i) { const unsigned c = dsum[i]; const bool hit = (sel < 0) && (acc + c >= (unsigned)need); cab = hit ? acc : cab; sel = hit ? i : sel; acc += c; }
    const int ow = owner < 0 ? 0 : owner;
    const unsigned digit = (unsigned)__builtin_amdgcn_readlane(sel, ow) + (unsigned)(4 * (63 - ow));
    need -= (int)__builtin_amdgcn_readlane((int)cab, ow);
    return digit;
}
#ifndef TS_SEL
#define TS_SEL 0
#endif
#define ITS_B() do { if (TS_SEL >= 20 && TS_SEL <= 25 && WV_ == 0 && LANEID() == 0) ((volatile __attribute__((address_space(3))) unsigned long long*)((__attribute__((address_space(3))) unsigned char*)lds + 147456 - 16 - 32))[0] = __builtin_amdgcn_s_memrealtime(); } while (0)
#define ITS_E(k) do { if ((k) == TS_SEL && WV_ == 0 && LANEID() == 0) { volatile __attribute__((address_space(3))) unsigned long long* w_ = (volatile __attribute__((address_space(3))) unsigned long long*)((__attribute__((address_space(3))) unsigned char*)lds + 147456 - 16 - 32); w_[1] += __builtin_amdgcn_s_memrealtime() - w_[0]; } } while (0)
__device__ void index_fast_phase(int WV_, const bf16* P, unsigned char* mask, float* kmean, float* scratch_all, unsigned* qctr, unsigned char* lds) {
    const int tid = LTID(WV_), lane = tid & 63, wave = tid >> 6, bid = LBID(), G = LGRID();
    float* s_part = (float*)lds;
    ITS_B();
    for (int k = bid; k < 256; k += G) {
        const int b = k >> 6, h = (k >> 4) & 3, blk = k & 15;
        const bf16* kp = P + (size_t)(b * S_ + blk * 256 + wave * 32) * NP + C_KC + h * 64 + lane;
        float a = 0.f;
#pragma unroll 8
        for (int j = 0; j < 32; ++j) a += bf2f(kp[(size_t)j * NP]);
        __syncthreads();
        s_part[wave * 64 + lane] = a;
        __syncthreads();
        if (tid < 64) { float s = 0.f;
#pragma unroll
            for (int w = 0; w < 8; ++w) s += s_part[w * 64 + tid];
            kmean[((b * 4 + h) * 16 + blk) * 64 + tid] = s * (1.0f / 256.0f); }
    }
    ITS_E(22);
    float* scr = scratch_all + (size_t)bid * (16 * 4096);
    const int lq = lane & 15, g4 = lane >> 4;
    volatile __attribute__((address_space(3))) unsigned* qslot = (volatile __attribute__((address_space(3))) unsigned*)((__attribute__((address_space(3))) unsigned char*)lds + 69632);
    unsigned ticket = (unsigned)bid;
    for (;;) {
        if (ticket >= 1024u) break;
        const int ui = (int)ticket;
        unsigned nticket = 0u;
        if (tid == 0) nticket = (unsigned)G + __hip_atomic_fetch_add(qctr, 1u, __ATOMIC_RELAXED, __HIP_MEMORY_SCOPE_AGENT);
        const int b = ui >> 8, k = ui & 255, tile = (b & 1) ? 255 - k : k, q0 = tile * 16;
        const bf16* Pb = P + (size_t)b * S_ * NP;
        const int ntiles = tile + 1;
        ITS_B();
        bf16x8_t qf[8]; float wi[8];
        { const bf16* qp = Pb + (size_t)(q0 + lq) * NP + C_QI + 8 * g4;
#pragma unroll
          for (int h = 0; h < 8; ++h) qf[h] = *(const bf16x8_t*)(qp + 32 * h);
          const uint4 wv = *(const uint4*)(Pb + (size_t)(q0 + lq) * NP + C_WI); unpack8(wv, wi); }
        bf16x8_t qch, qcl;
        { typedef unsigned u32x4_t __attribute__((ext_vector_type(4)));
          float qc[8];
#pragma unroll
          for (int i = 0; i < 8; ++i) qc[i] = 0.f;
#pragma unroll
          for (int h = 0; h < 8; ++h) { const u32x4_t w4 = __builtin_bit_cast(u32x4_t, qf[h]);
#pragma unroll
              for (int i = 0; i < 4; ++i) { qc[2 * i] += wi[h] * __uint_as_float(w4[i] << 16); qc[2 * i + 1] += wi[h] * __uint_as_float(w4[i] & 0xffff0000u); } }
          u32x4_t hi4, lo4;
#pragma unroll
          for (int i = 0; i < 4; ++i) { const unsigned hw = cvtpk(qc[2 * i], qc[2 * i + 1]); hi4[i] = hw;
              lo4[i] = cvtpk(qc[2 * i] - __uint_as_float(hw << 16), qc[2 * i + 1] - __uint_as_float(hw & 0xffff0000u)); }
          qch = __builtin_bit_cast(bf16x8_t, hi4); qcl = __builtin_bit_cast(bf16x8_t, lo4); }
        {
            bf16x8_t afn = *(const bf16x8_t*)(Pb + (size_t)((wave < ntiles ? wave : 0) * 16 + lq) * NP + C_KI + 8 * g4);
            for (int kt = wave; kt < ntiles; kt += NWAVE) {
                const bf16x8_t af = afn;
                { const int ktn = (kt + NWAVE < ntiles) ? kt + NWAVE : kt; afn = *(const bf16x8_t*)(Pb + (size_t)(ktn * 16 + lq) * NP + C_KI + 8 * g4); }
                f32x4_t a[8];
                const f32x4_t z = {0.f, 0.f, 0.f, 0.f};
#pragma unroll
                for (int h = 0; h < 8; ++h) a[h] = __builtin_amdgcn_mfma_f32_16x16x32_bf16(af, qf[h], z, 0, 0, 0);
                f32x4_t sc = __builtin_amdgcn_mfma_f32_16x16x32_bf16(af, qch, z, 0, 0, 0);
                sc = __builtin_amdgcn_mfma_f32_16x16x32_bf16(af, qcl, sc, 0, 0, 0);
                __builtin_amdgcn_sched_barrier(0);
#pragma unroll
                for (int h = 0; h < 8; ++h)
#pragma unroll
                    for (int r = 0; r < 4; ++r) sc[r] = __builtin_fmaf(__builtin_fabsf(a[h][r]), wi[h], sc[r]);
#pragma unroll
                for (int r = 0; r < 4; ++r) { sc[r] *= 0.03125f; if (sc[r] == 0.f) sc[r] = 0.f; }
                *(f32x4_t*)(scr + (size_t)lq * 4096 + kt * 16 + 4 * g4) = sc;
            }
        }
        __threadfence_block();
        __syncthreads();
        __threadfence_block();
        ITS_E(20); ITS_B();
        lds_u32* hist = (lds_u32*)((__attribute__((address_space(3))) unsigned char*)lds + 2048) + wave * 2048;
#pragma unroll 1
        for (int qi = 0; qi < 2; ++qi) {
            const int ql = 2 * wave + qi, q = q0 + ql;
            const float* row = scr + (size_t)ql * 4096 + lane;
            const int qrel = q - lane * 64;
            const int jlim = __builtin_amdgcn_readfirstlane(q >> 6);
            const int jmax = (q - lane) >> 6;
            unsigned wlo = 0u, whi = 0u;
            if (q + 1 > 256) {
                unsigned key[64];
#pragma unroll
                for (int j4 = 0; j4 < 16; ++j4) {
                    if (4 * j4 <= jlim) {
#pragma unroll
                        for (int e = 0; e < 4; ++e) key[4 * j4 + e] = __float_as_uint(row[64 * (4 * j4 + e)]);
                    } else {
#pragma unroll
                        for (int e = 0; e < 4; ++e) key[4 * j4 + e] = 0x7fffffffu;
                    }
                }
                unsigned t0 = 0u, t1 = 0u, t2 = 0u, t3 = 0u;
#pragma unroll
                for (int j4 = 0; j4 < 16; ++j4) {
                    if (4 * j4 <= jlim) {
#pragma unroll
                        for (int e = 0; e < 4; ++e) { const int j = 4 * j4 + e; const unsigned u = key[j];
                            const unsigned t = u ^ ((unsigned)((int)u >> 31) | 0x80000000u); const unsigned inval = (unsigned)((jmax - j) >> 31); const unsigned x = t & ~inval; key[j] = x;
                            unsigned n1, n2, n3;
                            asm("v_med3_u32 %0, %1, %2, %3" : "=v"(n3) : "v"(t2), "v"(t3), "v"(x));
                            asm("v_med3_u32 %0, %1, %2, %3" : "=v"(n2) : "v"(t1), "v"(t2), "v"(x));
                            asm("v_med3_u32 %0, %1, %2, %3" : "=v"(n1) : "v"(t0), "v"(t1), "v"(x));
                            t0 = t0 > x ? t0 : x; t1 = n1; t2 = n2; t3 = n3; }
                    } else {
#pragma unroll
                        for (int e = 0; e < 4; ++e) key[4 * j4 + e] = 0u;
                    }
                }
                unsigned L = wave_min_u_dpp(t3);
                L = L > 1u ? L : 1u;
                ITS_E(23); ITS_B();
                int need = 256;
                const unsigned d1 = radix_pass<24>(key, 0u, hist, lane, need, jlim, L);
                const unsigned d2 = radix_pass<16>(key, d1, hist, lane, need, jlim, L);
                const unsigned d3 = radix_pass<8>(key, (d1 << 8) | d2, hist, lane, need, jlim, L);
                const unsigned d4 = radix_pass<0>(key, (d1 << 16) | (d2 << 8) | d3, hist, lane, need, jlim, L);
                const unsigned prefix = (d1 << 24) | (d2 << 16) | (d3 << 8) | d4;
                ITS_E(24); ITS_B();
                int ceq = 0;
#pragma unroll
                for (int j = 0; j < 64; ++j) cnt_eq(ceq, key[j], prefix);
                ceq = (int)wave_sum_u_dpp((unsigned)ceq);
                int X = 4096;
                if (ceq != need) {
                    int X0 = 0;
#pragma unroll 1
                    for (int bit = 11; bit >= 0; --bit) {
                        const int c = X0 | (1 << bit);
                        int cnt = 0; const int crel = (c - lane + 63) >> 6;
#pragma unroll
                        for (int j = 0; j < 64; ++j) cnt_eq(cnt, (key[j] ^ prefix) | ~(unsigned)((j - crel) >> 31), 0u);
                        cnt = wave_sum_i(cnt);
                        if (cnt < need) X0 = c;
                    }
                    X = X0 + 1;
                }
                const int xrel = (X - lane + 63) >> 6;
#pragma unroll
                for (int j4 = 0; j4 < 16; ++j4) {
                    if (4 * j4 <= jlim) {
#pragma unroll
                        for (int e = 0; e < 4; ++e) { const int j = 4 * j4 + e;
                            const bool sel = (key[j] > prefix) || (key[j] == prefix && j < xrel);
                            const unsigned long long bm = __ballot(sel);
                            asm("v_writelane_b32 %0, %1, %2" : "+v"(wlo) : "s"((unsigned)bm), "n"(j));
                            asm("v_writelane_b32 %0, %1, %2" : "+v"(whi) : "s"((unsigned)(bm >> 32)), "n"(j)); }
                    }
                }
            } else {
#pragma unroll
                for (int j = 0; j < 32; ++j) { wlo |= (~(unsigned)((qrel - j) >> 31) & 1u) << j; whi |= (~(unsigned)((qrel - 32 - j) >> 31) & 1u) << j; }
            }
            ((uint2*)(mask + (size_t)(b * S_ + q) * 512))[lane] = make_uint2(wlo, whi);
            ITS_E(25); ITS_B();
        }
        ITS_E(21);
        if (tid == 0) qslot[0] = nticket;
        __syncthreads();
        ticket = qslot[0];
    }
}

constexpr int MG_P = 72;
constexpr int MG_TILE_BYTES = 128 * MG_P * 2;
__device__ void merge_fast_phase(int WV_, const bf16* P, const bf16* ys, const bf16* wbt  , bf16* merged, unsigned char* lds) {
    const int tid = LTID(WV_), lane = tid & 63, wave = tid >> 6, r32 = lane & 31, hi = lane >> 5, wt = wave & 3, wd = wave >> 2;
    const int srow0 = tid >> 3, sch = tid & 7;
    for (int tile = LBID(); tile < 1024; tile += LGRID()) {
        const int tok0 = (tile >> 3) * 128, d0 = (tile & 7) * 128;
        f32x16_t mer[2], acc[2];
#pragma unroll
        for (int r = 0; r < 16; ++r) { mer[0][r] = 0.f; mer[1][r] = 0.f; acc[0][r] = 0.f; acc[1][r] = 0.f; }
        uint4 RW00, RW01, RW10, RW11, RY00, RY01, RY10, RY11, RG0, RG1, RG2, RG3;
        bf16* gl = (bf16*)(lds + 4 * MG_TILE_BYTES);
        const int grow = tid >> 4, gch = tid & 15;
#define MG_GLOAD(st_, R_) do { const int n_ = (st_) >> 2, kc_ = (st_) & 3; \
            RW##R_##0 = *(const uint4*)(wbt + ((size_t)n_ * 1024 + d0 + srow0) * 256 + kc_ * 64 + sch * 8); \
            RW##R_##1 = *(const uint4*)(wbt + ((size_t)n_ * 1024 + d0 + srow0 + 64) * 256 + kc_ * 64 + sch * 8); \
            RY##R_##0 = *(const uint4*)(ys + (size_t)(tok0 + srow0) * 1024 + n_ * 256 + kc_ * 64 + sch * 8); \
            RY##R_##1 = *(const uint4*)(ys + (size_t)(tok0 + srow0 + 64) * 1024 + n_ * 256 + kc_ * 64 + sch * 8); } while (0)
#define MG_SSTORE(buf_, R_) do { bf16* wl_ = (bf16*)(lds + (buf_) * 2 * MG_TILE_BYTES); bf16* yl_ = (bf16*)(lds + (buf_) * 2 * MG_TILE_BYTES + MG_TILE_BYTES); \
            *(uint4*)(wl_ + srow0 * MG_P + sch * 8) = RW##R_##0; *(uint4*)(wl_ + (srow0 + 64) * MG_P + sch * 8) = RW##R_##1; \
            *(uint4*)(yl_ + srow0 * MG_P + sch * 8) = RY##R_##0; *(uint4*)(yl_ + (srow0 + 64) * MG_P + sch * 8) = RY##R_##1; } while (0)
        __syncthreads();
        MG_GLOAD(0, 0); MG_GLOAD(1, 1);
        MG_SSTORE(0, 0);
        __syncthreads();
#define MG_STAGE(PAR_, OTH_) do { const int buf = PAR_; \
            if (st + 2 < 16) MG_GLOAD(st + 2, PAR_); \
            if ((st & 3) == 1) { const bf16* gsrc = P + (size_t)(tok0 + grow) * NP + C_G + (st >> 2) * 1024 + d0 + gch * 8; \
                RG0 = *(const uint4*)gsrc; RG1 = *(const uint4*)(gsrc + (size_t)32 * NP); RG2 = *(const uint4*)(gsrc + (size_t)64 * NP); RG3 = *(const uint4*)(gsrc + (size_t)96 * NP); } \
            const bf16* wl = (const bf16*)(lds + buf * 2 * MG_TILE_BYTES); const bf16* yl = (const bf16*)(lds + buf * 2 * MG_TILE_BYTES + MG_TILE_BYTES); \
            _Pragma("unroll") for (int ks = 0; ks < 4; ++ks) { \
                const bf16x8_t bq = *(const bf16x8_t*)(yl + (32 * wt + r32) * MG_P + 16 * ks + 8 * hi); \
                const bf16x8_t a0 = *(const bf16x8_t*)(wl + (64 * wd + r32) * MG_P + 16 * ks + 8 * hi); \
                const bf16x8_t a1 = *(const bf16x8_t*)(wl + (64 * wd + 32 + r32) * MG_P + 16 * ks + 8 * hi); \
                acc[0] = __builtin_amdgcn_mfma_f32_32x32x16_bf16(a0, bq, acc[0], 0, 0, 0); \
                acc[1] = __builtin_amdgcn_mfma_f32_32x32x16_bf16(a1, bq, acc[1], 0, 0, 0); } \
            if ((st & 3) == 3) { \
                const int n = st >> 2; \
                const bf16* gp = gl + (32 * wt + r32) * 136 + 64 * wd + 4 * hi; (void)n; \
                _Pragma("unroll") for (int dt = 0; dt < 2; ++dt) \
                _Pragma("unroll") for (int g = 0; g < 4; ++g) { \
                        const uint2 gv = *(const uint2*)(gp + 32 * dt + 8 * g); \
                        const float g0 = __uint_as_float(gv.x << 16), g1 = __uint_as_float(gv.x & 0xffff0000u), g2 = __uint_as_float(gv.y << 16), g3 = __uint_as_float(gv.y & 0xffff0000u); \
                        mer[dt][4 * g + 0] += acc[dt][4 * g + 0] * g0; \
                        mer[dt][4 * g + 1] += acc[dt][4 * g + 1] * g1; \
                        mer[dt][4 * g + 2] += acc[dt][4 * g + 2] * g2; \
                        mer[dt][4 * g + 3] += acc[dt][4 * g + 3] * g3; } \
                _Pragma("unroll") for (int r = 0; r < 16; ++r) { acc[0][r] = 0.f; acc[1][r] = 0.f; } } \
            if (st + 1 < 16) MG_SSTORE(OTH_, OTH_); \
            if ((st & 3) == 2) { *(uint4*)(gl + grow * 136 + gch * 8) = RG0; *(uint4*)(gl + (grow + 32) * 136 + gch * 8) = RG1; *(uint4*)(gl + (grow + 64) * 136 + gch * 8) = RG2; *(uint4*)(gl + (grow + 96) * 136 + gch * 8) = RG3; } \
            __syncthreads(); } while (0)
#pragma unroll 1
        for (int st2 = 0; st2 < 16; st2 += 2) { { const int st = st2; MG_STAGE(0, 1); } { const int st = st2 + 1; MG_STAGE(1, 0); } }
#undef MG_STAGE
#undef MG_GLOAD
#undef MG_SSTORE
        bf16* mp = merged + (size_t)(tok0 + 32 * wt + r32) * 1024 + d0 + 64 * wd + 4 * hi;
#pragma unroll
        for (int dt = 0; dt < 2; ++dt)
#pragma unroll
            for (int g = 0; g < 4; ++g)
                *(uint2*)(mp + 32 * dt + 8 * g) = make_uint2(cvtpk(mer[dt][4 * g], mer[dt][4 * g + 1]), cvtpk(mer[dt][4 * g + 2], mer[dt][4 * g + 3]));
    }
}
#define LAS __attribute__((address_space(3)))
#define XB_TMO      128
#define XB_XCNT(j)  (256  + 64 * (j))
#define XB_XSUB(j)  (1280 + 64 * (j))
#define XB_XGEN(j)  (2304 + 64 * (j))
#define XB_TOP      3328
#define XB_TOPGEN   3392
#define XCD_BAR_WORDS 3456
#define XB_SPIN_CAP (1u << 18)

__device__ __forceinline__ unsigned xb_ld(unsigned* p)              { return __hip_atomic_load(p, __ATOMIC_RELAXED, __HIP_MEMORY_SCOPE_AGENT); }
__device__ __forceinline__ unsigned xb_add(unsigned* p, unsigned v) { return __hip_atomic_fetch_add(p, v, __ATOMIC_RELAXED, __HIP_MEMORY_SCOPE_AGENT); }
__device__ __forceinline__ unsigned xb_xcc_id() { return (unsigned)__builtin_amdgcn_s_getreg((3 << 11) | 20) & 0xFu; }
#define XB_SPIN(cond, bar) do { unsigned _sp = 0; while (cond) { __builtin_amdgcn_s_sleep(1); \
    if ((++_sp & 255u) == 0u) { if (xb_ld(&(bar)[XB_TMO])) break; if (_sp > XB_SPIN_CAP) { atomicAdd(&(bar)[XB_TMO], 1u); break; } } } } while (0)

struct XcdBarrier {
    unsigned* bar; unsigned x;
    volatile LAS unsigned* st;
};

__device__ __forceinline__ XcdBarrier xcd_barrier_post(unsigned* bar, volatile LAS unsigned* st) {
    XcdBarrier b; b.bar = bar; b.x = xb_xcc_id(); b.st = st;
    if (threadIdx.x == 0) (void)xb_add(&bar[XB_XCNT(b.x)], 1u);
    return b;
}
__device__ __forceinline__ void xcd_barrier_complete(unsigned* bar, unsigned x, unsigned& nloc, unsigned& nx) {
    const unsigned G = gridDim.x * gridDim.y * gridDim.z;
    unsigned sum, cnt, mine, sp = 0u;
    for (;;) {
        sum = 0u; cnt = 0u; mine = 0u;
#pragma unroll
        for (unsigned j = 0; j < 16; ++j) { const unsigned c = xb_ld(&bar[XB_XCNT(j)]); sum += c; cnt += (c > 0u) ? 1u : 0u; mine = (j == x) ? c : mine; }
        if (sum == G) break;
        __builtin_amdgcn_s_sleep(1);
        if ((++sp & 255u) == 0u) { if (xb_ld(&bar[XB_TMO])) break; if (sp > XB_SPIN_CAP) { atomicAdd(&bar[XB_TMO], 1u); break; } }
    }
    nloc = mine > 0u ? mine : 1u; nx = cnt > 0u ? cnt : 1u;
}

__device__ __forceinline__ void xcd_barrier(const XcdBarrier& b, int wv_) {
    asm volatile("s_waitcnt vmcnt(0)" ::: "memory");
    __syncthreads();
    if (wv_ == 0 && LANEID() == 0) {
        unsigned* bar = b.bar;
        __builtin_amdgcn_s_waitcnt(0);
        unsigned nloc = b.st[0], nx = b.st[1];
        if (nloc == 0u) { xcd_barrier_complete(bar, b.x, nloc, nx); b.st[0] = nloc; b.st[1] = nx; }
        const unsigned old = xb_add(&bar[XB_XSUB(b.x)], 1u);
        const unsigned gen = old / nloc;
        if (old + 1u == (gen + 1u) * nloc) {
            __builtin_amdgcn_fence(__ATOMIC_RELEASE, "agent");
            asm volatile("s_waitcnt vmcnt(0)" ::: "memory");
            const unsigned og = xb_add(&bar[XB_TOP], 1u);
            const unsigned tg = og / nx;
            if (og + 1u == (tg + 1u) * nx) xb_add(&bar[XB_TOPGEN], 1u);
            else XB_SPIN(xb_ld(&bar[XB_TOPGEN]) == tg, bar);
            __builtin_amdgcn_fence(__ATOMIC_ACQUIRE, "agent");
            xb_add(&bar[XB_XGEN(b.x)], 1u);
            asm volatile("s_waitcnt vmcnt(0)" ::: "memory");
        } else {
            XB_SPIN(xb_ld(&bar[XB_XGEN(b.x)]) == gen, bar);
            __builtin_amdgcn_fence(__ATOMIC_ACQUIRE, "agent");
            asm volatile("s_waitcnt vmcnt(0)" ::: "memory");
        }
    }
    __syncthreads();
}

enum { PH_PRO = 0, PH_GIN, PH_INDEX, PH_ATTN, PH_MERGE, PH_GOUT, PH_LN1, PH_GQ, PH_ROUTE, PH_PEER };
template <int PH> __device__ __forceinline__ void run_phase(int WV_, const Params& p_unused, int l, unsigned char* lds_raw) {
    size_t kaoff_ = 0; asm volatile("" : "+s"(kaoff_));
    typedef const __attribute__((address_space(4))) char* kaptr_t;
    const __attribute__((address_space(4))) Params& p = *(const __attribute__((address_space(4))) Params*)((kaptr_t)__builtin_amdgcn_kernarg_segment_ptr() + kaoff_);
    float* sm = (float*)lds_raw;
    size_t wsoff_ = 0; asm volatile("" : "+s"(wsoff_));
    unsigned char* ws = p.ws + wsoff_;
    float* hbuf = p.out;
    bf16* hb = (bf16*)(ws + WS_HB);
    bf16* P = (bf16*)(ws + WS_P);
    bf16* ys = (bf16*)(ws + WS_YS);
    bf16* mrg = (bf16*)(ws + WS_MRG);
    float* mix = (float*)(ws + WS_MIX);
    float* qb = (float*)(ws + WS_Q);
    unsigned char* mask = ws + WS_MASK;
    int* eid = (int*)(ws + WS_EID);
    float* gate = (float*)(ws + WS_GATE);
    float* kmean = (float*)(ws + WS_KMEAN);
    const float* hin = (l == 0) ? p.in[0] : hbuf;
    if (PH == PH_PRO) { Params pc; for (int i = 0; i < 13; ++i) pc.in[i] = p.in[i]; pc.out = p.out; pc.ws = ws;
        prologue_phase(WV_, pc, sm); convert_tables(WV_, pc);
        for (int i = LBID() * NTHR + LTID(WV_); i < DEPTH_ * 8 * 2 * 128 * 64 / 4; i += LGRID() * NTHR) { const float4 v = ((const float4*)p.in[8])[i]; ((uint2*)(ws + WS_SKB))[i] = make_uint2(pk2(v.x, v.y), pk2(v.z, v.w)); } if (LBID() < 2) build_unit_table((unsigned*)(ws + WS_CTL) + 1024, LBID() * NTHR + LTID(WV_)); }
    else if (PH == PH_GIN) {
        pg8::Gemm g{hb, (const bf16*)(ws + WS_WIN_T + l * WIN_T_BYTES), T_, NP, 1024};
        pg8::StaticOrder S; S.init(T_, NP, (int)LGRID(), (int)LBID());
        pg8::EpiBf16Sig E{P, NP, C_G};
        pg8::gemm_phase<pg8::EpiBf16Sig, pg8::StaticOrder, true, true>(WV_, (PG8_LAS unsigned char*)lds_raw, g, S, E);
    }
    else if (PH == PH_INDEX) index_fast_phase(WV_, P, mask, kmean, (float*)(ws + WS_YS), (unsigned*)(ws + WS_CTL) + 64 * l + 16, lds_raw);
    else if (PH == PH_ATTN) attn_fast_phase(WV_, P, mask, kmean, p.in[4] + l * 4, ys, (const unsigned*)(ws + WS_CTL) + 1024, (unsigned*)(ws + WS_CTL) + 64 * l, lds_raw);
    else if (PH == PH_MERGE) merge_fast_phase(WV_, P, ys, (const bf16*)(ws + WS_WBR_T) + (size_t)l * 4 * 1024 * 256, mrg, lds_raw);
    else if (PH == PH_GOUT) {
        pg8::Gemm g{mrg, (const bf16*)(ws + WS_WOUT_T) + (size_t)l * 1024 * 1024, T_, 1024, 1024};
        pg8::StaticOrder S; S.init(T_, 1024, (int)LGRID(), (int)LBID());
        pg8::EpiResY E{hin, hbuf, hb, (float*)(ws + WS_STATS) + (size_t)l * T_ * 2, ALPHA};
        pg8::gemm_phase<pg8::EpiResY, pg8::StaticOrder, true, true>(WV_, (PG8_LAS unsigned char*)lds_raw, g, S, E);
    }
    else if (PH == PH_GQ) {
        pg8::Gemm g{hb, (const bf16*)(ws + WS_WQ_T) + (size_t)l * 1024 * 1024, T_, 1024, 1024};
        pg8::StaticOrder S; S.init(T_, 1024, (int)LGRID(), (int)LBID());
        pg8::EpiLnFold E{(bf16*)qb, (const float*)(ws + WS_STATS) + (size_t)l * T_ * 2, (const float*)(ws + WS_COLS) + l * 2048, (const float*)(ws + WS_COLS) + l * 2048 + 1024, LN_EPS};
        pg8::gemm_phase<pg8::EpiLnFold, pg8::StaticOrder, true, true>(WV_, (PG8_LAS unsigned char*)lds_raw, g, S, E);
        pg8::Unit u0;
        if (LGRID() == 256 && S.next(0, u0)) {
            asm volatile("s_waitcnt vmcnt(0)" ::: "memory"); __syncthreads();
            route_fast_phase(WV_, (const bf16*)qb, (const bf16*)(ws + WS_SKB) + (size_t)l * 8 * 2 * 128 * 64, eid, gate, lds_raw, u0.pm, u0.pn);
        }
    }
    else if (PH == PH_ROUTE) { if (LGRID() != 256) route_fast_phase(WV_, (const bf16*)qb, (const bf16*)(ws + WS_SKB) + (size_t)l * 8 * 2 * 128 * 64, eid, gate, lds_raw); }
    else peer_fast_phase(WV_, hbuf, hb, eid, gate, ws + WS_UV + (size_t)l * 24 * MiB, p.in[5] + l * 1024, p.in[6] + l * 1024, p.in[11] + l * 1024, p.in[12] + l * 1024, lds_raw);
}

constexpr int CW_BAR = 4096;
constexpr int LDS_BARST = LDS_BYTES - 16;
__global__ void __launch_bounds__(NTHR, 2) mk_fwd(Params p) {
    extern __shared__ __attribute__((aligned(16))) unsigned char lds_raw[];
    cg::grid_group grid = cg::this_grid();
    const int WV_ = __builtin_amdgcn_readfirstlane((int)threadIdx.x >> 6);
    { volatile LAS unsigned* bst0 = (volatile LAS unsigned*)((LAS unsigned char*)lds_raw + LDS_BARST); if (threadIdx.x < 4) bst0[threadIdx.x] = 0u; }
    __syncthreads();
    volatile LAS unsigned* bst = (volatile LAS unsigned*)((LAS unsigned char*)lds_raw + LDS_BARST);
    (void)xcd_barrier_post((unsigned*)(p.ws + WS_CTL) + CW_BAR, bst);
#define GRID_BAR() do { XcdBarrier b_; b_.bar = (unsigned*)(p.ws + WS_CTL) + CW_BAR; b_.x = xb_xcc_id(); b_.st = (volatile LAS unsigned*)((LAS unsigned char*)lds_raw + LDS_BARST); xcd_barrier(b_, WV_); } while (0)
    run_phase<PH_PRO>(WV_, p, 0, lds_raw);
    grid.sync();
#pragma unroll 1
    for (int l = 0; l < DEPTH_; ++l) {
        run_phase<PH_GIN>(WV_, p, l, lds_raw); GRID_BAR();
        run_phase<PH_INDEX>(WV_, p, l, lds_raw); GRID_BAR();
        run_phase<PH_ATTN>(WV_, p, l, lds_raw); GRID_BAR();
        run_phase<PH_MERGE>(WV_, p, l, lds_raw); GRID_BAR();
        run_phase<PH_GOUT>(WV_, p, l, lds_raw); GRID_BAR();
        run_phase<PH_GQ>(WV_, p, l, lds_raw); if (LGRID() != 256) { GRID_BAR(); run_phase<PH_ROUTE>(WV_, p, l, lds_raw); } GRID_BAR();
        run_phase<PH_PEER>(WV_, p, l, lds_raw); if (l + 1 < DEPTH_) GRID_BAR();
    }
}

extern "C" void kernel_launch(void* const* d_in, const int* in_sizes, int n_in, void* d_out, int out_size, void* d_ws, size_t ws_size, hipStream_t stream) {
    if (n_in != 13 || ws_size < WS_END) { fprintf(stderr, "kernel_launch: unexpected n_in %d / ws_size %zu; nothing launched\n", n_in, ws_size); return; }
    static int grid_blocks = 0;
    if (grid_blocks == 0) {
        int dev = 0, cus = 0, per_cu = 0;
        (void)hipGetDevice(&dev);
        (void)hipDeviceGetAttribute(&cus, hipDeviceAttributeMultiprocessorCount, dev);
        (void)hipFuncSetAttribute((const void*)mk_fwd, hipFuncAttributeMaxDynamicSharedMemorySize, LDS_BYTES);
        (void)hipOccupancyMaxActiveBlocksPerMultiprocessor(&per_cu, (const void*)mk_fwd, NTHR, LDS_BYTES);
        if (per_cu < 1) fprintf(stderr, "kernel_launch: occupancy query reports %d\n", per_cu);
        grid_blocks = cus;
    }
    Params p{};
    for (int i = 0; i < 13; ++i) p.in[i] = (const float*)d_in[i];
    p.out = (float*)d_out; p.ws = (unsigned char*)d_ws;
    (void)hipMemsetAsync(d_ws, 0, 2 * MiB, stream);
    void* args[] = {&p};
    hipError_t e = hipLaunchCooperativeKernel((const void*)mk_fwd, dim3(grid_blocks), dim3(NTHR), args, LDS_BYTES, stream);
    if (e != hipSuccess) fprintf(stderr, "cooperative launch failed: %s (grid %d)\n", hipGetErrorString(e), grid_blocks);
}
```

```cpp
#include <hip/hip_runtime.h>
#include <cstdio>
#include <cstdint>
#include <hip/hip_cooperative_groups.h>
namespace cg = cooperative_groups;

__device__ __forceinline__ int LANEID() { int l; asm volatile("v_mbcnt_lo_u32_b32 %0, -1, 0\n\tv_mbcnt_hi_u32_b32 %0, -1, %0" : "=v"(l)); return l; }
__device__ __forceinline__ int LTID(int wv) { return (wv << 6) | LANEID(); }
__device__ __forceinline__ int LBID() { int t = blockIdx.x; asm volatile("" : "+s"(t)); return t; }
__device__ __forceinline__ int LGRID() { int t = gridDim.x; asm volatile("" : "+s"(t)); return t; }
namespace pg8 {
#define PG8_LAS __attribute__((address_space(3)))
typedef unsigned short bf16_t;
typedef short bf16x8 __attribute__((ext_vector_type(8)));
typedef float f32x4 __attribute__((ext_vector_type(4)));
typedef unsigned u32x4 __attribute__((ext_vector_type(4)));
constexpr int BM = 256, BK = 64, HALF = 128, HTB = HALF * BK * 2  , STAGE_BYTES = 8 * HTB, NXCD = 8, WGM = 8;

__host__ __device__ __forceinline__ int lds_byte(int r, int c) { const int st = (r >> 4) * 2 + (c >> 5), rr = r & 15, cc = c & 31, ob = rr * 64 + cc * 2; return st * 1024 + (ob ^ (((ob >> 9) & 1) << 5)); }
__host__ __device__ __forceinline__ void stage_rc(int b, int& R, int& C) { const int st = b / 1024, sb = b % 1024, swz = sb ^ (((sb >> 9) & 1) << 5); R = (st >> 1) * 16 + swz / 64; C = (st & 1) * 32 + (swz % 64) / 2; }
__host__ __device__ __forceinline__ int perm32(int rho) { const int n = rho >> 4, i = rho & 15; return 8 * (i >> 2) + 4 * n + (i & 3); }

struct Unit { int pm, pn; };
struct Gemm { const bf16_t* A; const bf16_t* Bt; int M, N, K; };

struct StaticOrder {
    int nM, nN, nwg, G, c;
    __host__ __device__ void init(int M, int N, int G_, int c_) { nM = M / BM; nN = N / BM; nwg = nM * nN; G = G_; c = c_; }
    __host__ __device__ bool next(int i, Unit& u) const {
        const long L = (long)i * G + c; if (L >= nwg) return false;
        int wgid = (int)L; { const int q = nwg / NXCD, r = nwg % NXCD, xcd = wgid % NXCD, off = wgid / NXCD; wgid = (xcd < r ? xcd * (q + 1) : r * (q + 1) + (xcd - r) * q) + off; }
        const int nig = WGM * nN, gid = wgid / nig, fm = gid * WGM, gsz = (nM - fm) < WGM ? (nM - fm) : WGM;
        u.pm = fm + ((wgid % nig) % gsz); u.pn = (wgid % nig) / gsz; return true;
    }
    __device__ __forceinline__ void a_ready(const Unit&) const {}
    __device__ __forceinline__ void done(const Unit&) const {}
};

__device__ __forceinline__ unsigned cvt_pk_bf16(float lo, float hi) { unsigned r; asm volatile("v_cvt_pk_bf16_f32 %0, %1, %2" : "=v"(r) : "v"(lo), "v"(hi)); return r; }
typedef float f32x2 __attribute__((ext_vector_type(2)));
__device__ __forceinline__ f32x2 gelu_pk(f32x2 v) {
    const f32x2 av = __builtin_elementwise_abs(v), d = av * 0.2316418882f + 1.0f;
    f32x2 t; t.x = __builtin_amdgcn_rcpf(d.x); t.y = __builtin_amdgcn_rcpf(d.y);
    f32x2 q = t * 0.5307027145f + (-0.7265760135f); q = q * t + 0.7107068705f; q = q * t + (-0.142248368f); q = q * t + 0.127414796f; q = q * t;
    const f32x2 s = (v * v) * (-0.72134752044f);
    f32x2 e; e.x = __builtin_amdgcn_exp2f(s.x); e.y = __builtin_amdgcn_exp2f(s.y);
    const f32x2 m = v * (q * e), r = v - m;
    f32x2 o; o.x = v.x < 0.f ? m.x : r.x; o.y = v.y < 0.f ? m.y : r.y; return o;
}

template <int ACT  > struct EpiBf16 {
    static constexpr bool PERM = true, AFTER_DRAIN = false; static_assert(ACT == 0 || ACT == 1, "EpiBf16: ACT is 0 (none) or 1 (gelu_pk)");
    bf16_t* O; int ldc; const float* bias; int split_cols; size_t split_stride; float scale0;
    __device__ __forceinline__ void operator()(const f32x4 (&acc)[2][2][4][2], const Unit& u, int wr, int wc, int fr, int fq) const {
        { int ln_ = LANEID(); asm volatile("" : "+v"(ln_)); fr = ln_ & 15; fq = ln_ >> 4; }
        const int row0 = u.pm * BM + wr * 64 + fr; int colt = u.pn * BM; bf16_t* base = O;
        float sc = 1.f; if (split_cols) { const int t = colt / split_cols; base += (size_t)t * split_stride; colt -= t * split_cols; if (t == 0) sc = scale0; }
        const int col0 = colt + wc * 32 + 8 * fq, bcol0 = u.pn * BM + wc * 32 + 8 * fq;
        f32x4 bv[2][2];
#pragma unroll
        for (int bj = 0; bj < 2; ++bj)
#pragma unroll
            for (int n = 0; n < 2; ++n) bv[bj][n] = bias ? *(const f32x4*)(bias + bcol0 + bj * HALF + 4 * n) : (f32x4){0.f, 0.f, 0.f, 0.f};
#pragma unroll
        for (int ai = 0; ai < 2; ++ai)
#pragma unroll
            for (int m = 0; m < 4; ++m) { bf16_t* rowp = base + (size_t)(row0 + ai * HALF + m * 16) * ldc + col0;
#pragma unroll
                for (int bj = 0; bj < 2; ++bj) { f32x4 v0 = acc[ai][bj][m][0] + bv[bj][0], v1 = acc[ai][bj][m][1] + bv[bj][1];
                    if (ACT == 1) { f32x2 a = gelu_pk((f32x2){v0[0], v0[1]}), b = gelu_pk((f32x2){v0[2], v0[3]}), c = gelu_pk((f32x2){v1[0], v1[1]}), d = gelu_pk((f32x2){v1[2], v1[3]});
                        v0 = (f32x4){a.x, a.y, b.x, b.y}; v1 = (f32x4){c.x, c.y, d.x, d.y}; }
                    v0 = v0 * sc; v1 = v1 * sc; u32x4 w; w.x = cvt_pk_bf16(v0[0], v0[1]); w.y = cvt_pk_bf16(v0[2], v0[3]); w.z = cvt_pk_bf16(v1[0], v1[1]); w.w = cvt_pk_bf16(v1[2], v1[3]);
                    *(u32x4*)(rowp + bj * HALF) = w; } }
    }
};
template <class Epi, class Sched, bool ALIGN_EPI = false, bool SP2 = false>
__device__ __forceinline__ void gemm_phase(int WV_, PG8_LAS unsigned char* lds, const Gemm g, const Sched& S, const Epi& E) {
    const int tid = LTID(WV_), wid = __builtin_amdgcn_readfirstlane(tid >> 6), lane = tid & 63, wr = wid >> 2, wc = wid & 3, fr = lane & 15, fq = lane >> 4;
    const int K = g.K, nt = K / BK;
    unsigned voffA[2], voffB[2];
#pragma unroll
    for (int i = 0; i < 2; ++i) { int R, C; stage_rc(tid * 16 + i * 8192, R, C); const int Rb = Epi::PERM ? ((R & ~31) + perm32(R & 31)) : R;
        voffA[i] = (unsigned)(R * K + C) * 2u; voffB[i] = (unsigned)(Rb * K + C) * 2u; }
    const size_t kstep = (size_t)(BK * 2);
    const size_t hstep = (size_t)HALF * K * 2;
    const size_t tstep = 2 * hstep;
    const unsigned ldsw = (unsigned)wid * 1024u;
    const int aoff = lds_byte(wr * 64 + fr, fq * 8), boff = lds_byte(wc * 32 + fr, fq * 8);
#define PG8_SA(b, h) (((b) * 2 + (h)) * HTB)
#define PG8_SB(b, h) ((4 + (b) * 2 + (h)) * HTB)
#define PG8_STAGE(bufoff, gbase, voff) do { _Pragma("unroll") for (int _i = 0; _i < 2; ++_i) \
        __builtin_amdgcn_global_load_lds((const unsigned*)((const char*)(gbase) + (voff)[_i]), (PG8_LAS unsigned*)(lds + (bufoff) + ldsw + _i * 8192), 16, 0, 0); } while (0)
#define PG8_LDA(dst, b, h) do { _Pragma("unroll") for (int m = 0; m < 4; ++m) _Pragma("unroll") for (int k = 0; k < 2; ++k) dst[m][k] = *(const PG8_LAS bf16x8*)(lds + PG8_SA(b, h) + aoff + m * 2048 + k * 1024); } while (0)
#define PG8_LDB(dst, b, h) do { _Pragma("unroll") for (int n = 0; n < 2; ++n) _Pragma("unroll") for (int k = 0; k < 2; ++k) dst[n][k] = *(const PG8_LAS bf16x8*)(lds + PG8_SB(b, h) + boff + n * 2048 + k * 1024); } while (0)
#define PG8_MMA(ai, bj, At, Bt) do { __builtin_amdgcn_s_setprio(1); _Pragma("unroll") for (int m = 0; m < 4; ++m) _Pragma("unroll") for (int n = 0; n < 2; ++n) _Pragma("unroll") for (int k = 0; k < 2; ++k) \
        acc[ai][bj][m][n] = __builtin_amdgcn_mfma_f32_16x16x32_bf16(Bt[n][k], At[m][k], acc[ai][bj][m][n], 0, 0, 0); __builtin_amdgcn_s_setprio(0); } while (0)
#define PG8_WAIT_V(n) asm volatile("s_waitcnt vmcnt(" #n ")" ::: "memory")
#define PG8_WAIT_L(n) asm volatile("s_waitcnt lgkmcnt(" #n ")" ::: "memory")
#define PG8_BAR __builtin_amdgcn_s_barrier()
#define PG8_SCHED __builtin_amdgcn_sched_barrier(0)
    Unit cur, nxt; int ui = 0;
    if (!S.next(0, cur)) return;
    f32x4 acc[2][2][4][2];
#pragma unroll
    for (int a = 0; a < 2; ++a)
#pragma unroll
        for (int b = 0; b < 2; ++b)
#pragma unroll
            for (int m = 0; m < 4; ++m)
#pragma unroll
                for (int n = 0; n < 2; ++n) acc[a][b][m][n] = (f32x4){0.f, 0.f, 0.f, 0.f};
    bf16x8 At[4][2], B0[2][2], B1[2][2];
    const char* cA = (const char*)g.A + (size_t)cur.pm * tstep; const char* cB = (const char*)g.Bt + (size_t)cur.pn * tstep;
    S.a_ready(cur);
    if constexpr (SP2) {
        PG8_STAGE(PG8_SB(0, 0), cB, voffB); PG8_STAGE(PG8_SB(0, 1), cB + hstep, voffB); PG8_STAGE(PG8_SA(0, 0), cA, voffA); PG8_STAGE(PG8_SA(0, 1), cA + hstep, voffA);
        if (wr == 1) PG8_BAR;
        PG8_WAIT_V(2); PG8_BAR;
        PG8_STAGE(PG8_SB(1, 0), cB + kstep, voffB); PG8_STAGE(PG8_SA(1, 0), cA + kstep, voffA); PG8_STAGE(PG8_SB(1, 1), cB + hstep + kstep, voffB);
        PG8_WAIT_V(6); PG8_BAR;
    } else {
        PG8_STAGE(PG8_SB(0, 0), cB, voffB); PG8_STAGE(PG8_SA(0, 0), cA, voffA); PG8_STAGE(PG8_SB(0, 1), cB + hstep, voffB); PG8_STAGE(PG8_SA(0, 1), cA + hstep, voffA);
        if (wr == 1) PG8_BAR;
        PG8_WAIT_V(4); PG8_BAR;
        PG8_STAGE(PG8_SB(1, 0), cB + kstep, voffB); PG8_STAGE(PG8_SA(1, 0), cA + kstep, voffA); PG8_STAGE(PG8_SB(1, 1), cB + hstep + kstep, voffB);
        PG8_WAIT_V(6); PG8_BAR;
    }
    for (;;) {
        const bool has_next = S.next(ui + 1, nxt);
        const char* nA = has_next ? (const char*)g.A + (size_t)nxt.pm * tstep : cA; const char* nB = has_next ? (const char*)g.Bt + (size_t)nxt.pn * tstep : cB;
        for (int t = 0; t < nt; t += 2) {
            const bool last = (t == nt - 2);
            const char* a1 = cA + (size_t)(t + 1) * kstep;
            const char* a2 = last ? nA : cA + (size_t)(t + 2) * kstep; const char* b2 = last ? nB : cB + (size_t)(t + 2) * kstep;
            const char* a3 = a2 + kstep; const char* b3 = b2 + kstep;
            if (last && has_next) S.a_ready(nxt);
            if constexpr (SP2) {
            PG8_LDB(B0, 0, 0); PG8_LDB(B1, 0, 1); PG8_SCHED; PG8_LDA(At, 0, 0); PG8_STAGE(PG8_SA(1, 1), a1 + hstep, voffA);
            PG8_WAIT_V(8); PG8_WAIT_L(0); PG8_BAR; PG8_MMA(0, 0, At, B0); PG8_MMA(0, 1, At, B1); PG8_BAR; PG8_SCHED;
            PG8_LDA(At, 0, 1); PG8_STAGE(PG8_SB(0, 0), b2, voffB); PG8_STAGE(PG8_SB(0, 1), b2 + hstep, voffB); PG8_STAGE(PG8_SA(0, 0), a2, voffA);
            PG8_WAIT_V(8); PG8_WAIT_L(0); PG8_BAR; PG8_MMA(1, 0, At, B0); PG8_MMA(1, 1, At, B1); PG8_BAR; PG8_SCHED;
            PG8_LDB(B0, 1, 0); PG8_LDB(B1, 1, 1); PG8_SCHED; PG8_LDA(At, 1, 0); PG8_STAGE(PG8_SA(0, 1), a2 + hstep, voffA);
            PG8_WAIT_V(8); PG8_WAIT_L(0); PG8_BAR; PG8_MMA(0, 0, At, B0); PG8_MMA(0, 1, At, B1); PG8_BAR; PG8_SCHED;
            PG8_LDA(At, 1, 1); PG8_STAGE(PG8_SB(1, 0), b3, voffB); PG8_STAGE(PG8_SB(1, 1), b3 + hstep, voffB); PG8_STAGE(PG8_SA(1, 0), a3, voffA);
            PG8_WAIT_V(8); PG8_WAIT_L(0); PG8_BAR; PG8_MMA(1, 0, At, B0); PG8_MMA(1, 1, At, B1); PG8_BAR; PG8_SCHED;
            } else {
            PG8_LDB(B0, 0, 0); PG8_SCHED; PG8_LDA(At, 0, 0); PG8_STAGE(PG8_SA(1, 1), a1 + hstep, voffA);
            PG8_WAIT_L(8); PG8_BAR; PG8_WAIT_L(0); PG8_MMA(0, 0, At, B0); PG8_BAR; PG8_SCHED;
            PG8_LDB(B1, 0, 1); PG8_STAGE(PG8_SB(0, 0), b2, voffB);
            PG8_BAR; PG8_WAIT_L(0); PG8_MMA(0, 1, At, B1); PG8_BAR;
            PG8_LDA(At, 0, 1); PG8_STAGE(PG8_SA(0, 0), a2, voffA);
            PG8_BAR; PG8_WAIT_L(0); PG8_MMA(1, 0, At, B0); PG8_BAR; PG8_SCHED;
            PG8_STAGE(PG8_SB(0, 1), b2 + hstep, voffB);
            PG8_WAIT_V(6); PG8_BAR; PG8_MMA(1, 1, At, B1); PG8_BAR;
            PG8_LDB(B0, 1, 0); PG8_SCHED; PG8_LDA(At, 1, 0); PG8_STAGE(PG8_SA(0, 1), a2 + hstep, voffA);
            PG8_WAIT_L(8); PG8_BAR; PG8_WAIT_L(0); PG8_MMA(0, 0, At, B0); PG8_BAR; PG8_SCHED;
            PG8_LDB(B1, 1, 1); PG8_STAGE(PG8_SB(1, 0), b3, voffB);
            PG8_BAR; PG8_WAIT_L(0); PG8_MMA(0, 1, At, B1); PG8_BAR;
            PG8_LDA(At, 1, 1); PG8_STAGE(PG8_SA(1, 0), a3, voffA);
            PG8_BAR; PG8_WAIT_L(0); PG8_MMA(1, 0, At, B0); PG8_BAR; PG8_SCHED;
            PG8_STAGE(PG8_SB(1, 1), b3 + hstep, voffB);
            PG8_WAIT_V(6); PG8_BAR; PG8_MMA(1, 1, At, B1); PG8_BAR;
            }
        }
        if constexpr (ALIGN_EPI) { if (wr == 0) PG8_BAR; }
        if constexpr (!Epi::AFTER_DRAIN) { E(acc, cur, wr, wc, fr, fq); S.done(cur); }
        if (!has_next) break;
#pragma unroll
        for (int a = 0; a < 2; ++a)
#pragma unroll
            for (int b = 0; b < 2; ++b)
#pragma unroll
                for (int m = 0; m < 4; ++m)
#pragma unroll
                    for (int n = 0; n < 2; ++n) acc[a][b][m][n] = (f32x4){0.f, 0.f, 0.f, 0.f};
        cur = nxt; cA = nA; cB = nB; ++ui;
        if constexpr (ALIGN_EPI) { if (wr == 1) PG8_BAR; }
    }
    PG8_WAIT_V(0);
    if constexpr (!ALIGN_EPI) { if (wr == 0) PG8_BAR; }
    PG8_BAR;
    if constexpr (Epi::AFTER_DRAIN) { E.fused(acc, cur, wr, wc, fr, fq, lds, wid, lane); S.done(cur); }
#undef PG8_SA
#undef PG8_SB
#undef PG8_STAGE
#undef PG8_LDA
#undef PG8_LDB
#undef PG8_MMA
#undef PG8_WAIT_V
#undef PG8_WAIT_L
#undef PG8_BAR
#undef PG8_SCHED
}
}
namespace pg8 {
struct EpiF32 {
    static constexpr bool PERM = false, AFTER_DRAIN = false;
    float* O; int ldc;
    __device__ __forceinline__ void operator()(const f32x4 (&acc)[2][2][4][2], const Unit& u, int wr, int wc, int fr, int fq) const {
        { int ln_ = LANEID(); asm volatile("" : "+v"(ln_)); fr = ln_ & 15; fq = ln_ >> 4; }
        const int row0 = u.pm * BM + wr * 64 + fr, col0 = u.pn * BM + wc * 32 + 4 * fq;
#pragma unroll
        for (int ai = 0; ai < 2; ++ai)
#pragma unroll
            for (int m = 0; m < 4; ++m) { float* rowp = O + (size_t)(row0 + ai * HALF + m * 16) * ldc + col0;
#pragma unroll
                for (int bj = 0; bj < 2; ++bj)
#pragma unroll
                    for (int n = 0; n < 2; ++n) *(f32x4*)(rowp + bj * HALF + n * 16) = acc[ai][bj][m][n]; }
    }
};
struct EpiResY {
    static constexpr bool PERM = false, AFTER_DRAIN = false;
    const float* hin; float* yout; bf16_t* yb; float* stats; float alpha;
    __device__ __forceinline__ void operator()(const f32x4 (&acc)[2][2][4][2], const Unit& u, int wr, int wc, int fr, int fq) const {
        { int ln_ = LANEID(); asm volatile("" : "+v"(ln_)); fr = ln_ & 15; fq = ln_ >> 4; }
        const int row0 = u.pm * BM + wr * 64 + fr, col0 = u.pn * BM + wc * 32 + 4 * fq;
#pragma unroll
        for (int ai = 0; ai < 2; ++ai)
#pragma unroll
            for (int m = 0; m < 4; ++m) {
                const int row = row0 + ai * HALF + m * 16;
                float s = 0.f, s2 = 0.f;
#pragma unroll
                for (int bj = 0; bj < 2; ++bj)
#pragma unroll
                    for (int n = 0; n < 2; ++n) {
                        const size_t off = (size_t)row * 1024 + col0 + bj * HALF + n * 16;
                        const f32x4 hv = *(const f32x4*)(hin + off);
                        const f32x4 y = hv * alpha + acc[ai][bj][m][n];
                        *(f32x4*)(yout + off) = y;
                        typedef unsigned u32x2v __attribute__((ext_vector_type(2)));
                        u32x2v w; w.x = cvt_pk_bf16(y[0], y[1]); w.y = cvt_pk_bf16(y[2], y[3]);
                        *(u32x2v*)(yb + off) = w;
                        s += (y[0] + y[1]) + (y[2] + y[3]); s2 += (y[0] * y[0] + y[1] * y[1]) + (y[2] * y[2] + y[3] * y[3]);
                    }
                s += __shfl_xor(s, 16); s += __shfl_xor(s, 32); s2 += __shfl_xor(s2, 16); s2 += __shfl_xor(s2, 32);
                if (fq == 0) { atomicAdd(stats + 2 * (size_t)row, s); atomicAdd(stats + 2 * (size_t)row + 1, s2); }
            }
    }
};
struct EpiLnFold {
    static constexpr bool PERM = true, AFTER_DRAIN = false;
    bf16_t* O; const float* stats; const float* colsum; const float* colbias; float eps;
    __device__ __forceinline__ void operator()(const f32x4 (&acc)[2][2][4][2], const Unit& u, int wr, int wc, int fr, int fq) const {
        { int ln_ = LANEID(); asm volatile("" : "+v"(ln_)); fr = ln_ & 15; fq = ln_ >> 4; }
        const int row0 = u.pm * BM + wr * 64 + fr, col0 = u.pn * BM + wc * 32 + 8 * fq;
        f32x4 cs[2][2], cb[2][2];
#pragma unroll
        for (int bj = 0; bj < 2; ++bj)
#pragma unroll
            for (int n = 0; n < 2; ++n) { cs[bj][n] = *(const f32x4*)(colsum + col0 + bj * HALF + 4 * n); cb[bj][n] = *(const f32x4*)(colbias + col0 + bj * HALF + 4 * n); }
#pragma unroll
        for (int ai = 0; ai < 2; ++ai)
#pragma unroll
            for (int m = 0; m < 4; ++m) {
                const int row = row0 + ai * HALF + m * 16;
                const float sm_ = stats[2 * (size_t)row], sq_ = stats[2 * (size_t)row + 1];
                const float mean = sm_ * (1.0f / 1024.0f);
                const float rstd = 1.0f / sqrtf(fmaxf(sq_ * (1.0f / 1024.0f) - mean * mean, 0.f) + eps);
                bf16_t* rowp = O + (size_t)row * 1024 + col0;
#pragma unroll
                for (int bj = 0; bj < 2; ++bj) {
                    const f32x4 v0 = (acc[ai][bj][m][0] - cs[bj][0] * mean) * rstd + cb[bj][0], v1 = (acc[ai][bj][m][1] - cs[bj][1] * mean) * rstd + cb[bj][1];
                    u32x4 w; w.x = cvt_pk_bf16(v0[0], v0[1]); w.y = cvt_pk_bf16(v0[2], v0[3]); w.z = cvt_pk_bf16(v1[0], v1[1]); w.w = cvt_pk_bf16(v1[2], v1[3]);
                    *(u32x4*)(rowp + bj * HALF) = w;
                }
            }
    }
};
__device__ __forceinline__ unsigned cvt_pk_bf16_t(float lo, float hi) { unsigned r; asm volatile("s_nop 0\n\tv_cvt_pk_bf16_f32 %0, %1, %2" : "=v"(r) : "v"(lo), "v"(hi)); return r; }
struct EpiBf16Sig {
    static constexpr bool PERM = true, AFTER_DRAIN = false;
    bf16_t* O; int ldc; int sig_col0;
    __device__ __forceinline__ void operator()(const f32x4 (&acc)[2][2][4][2], const Unit& u, int wr, int wc, int fr, int fq) const {
        { int ln_ = LANEID(); asm volatile("" : "+v"(ln_)); fr = ln_ & 15; fq = ln_ >> 4; }
        const int row0 = u.pm * BM + wr * 64 + fr; const int col0 = u.pn * BM + wc * 32 + 8 * fq;
#pragma unroll
        for (int bj = 0; bj < 2; ++bj) {
            if (col0 + bj * HALF >= sig_col0) {
#pragma unroll
                for (int ai = 0; ai < 2; ++ai)
#pragma unroll
                    for (int m = 0; m < 4; ++m) { bf16_t* rowp = O + (size_t)(row0 + ai * HALF + m * 16) * ldc + col0;
                        f32x4 v0 = acc[ai][bj][m][0], v1 = acc[ai][bj][m][1];
#pragma unroll
                        for (int e = 0; e < 4; ++e) { v0[e] = __builtin_amdgcn_rcpf(1.f + __builtin_amdgcn_exp2f(-1.44269504f * v0[e])); v1[e] = __builtin_amdgcn_rcpf(1.f + __builtin_amdgcn_exp2f(-1.44269504f * v1[e])); }
                        u32x4 w; w.x = cvt_pk_bf16_t(v0[0], v0[1]); w.y = cvt_pk_bf16_t(v0[2], v0[3]); w.z = cvt_pk_bf16_t(v1[0], v1[1]); w.w = cvt_pk_bf16_t(v1[2], v1[3]);
                        *(u32x4*)(rowp + bj * HALF) = w; }
            } else {
#pragma unroll
                for (int ai = 0; ai < 2; ++ai)
#pragma unroll
                    for (int m = 0; m < 4; ++m) { bf16_t* rowp = O + (size_t)(row0 + ai * HALF + m * 16) * ldc + col0;
                        const f32x4 v0 = acc[ai][bj][m][0], v1 = acc[ai][bj][m][1];
                        u32x4 w; w.x = cvt_pk_bf16(v0[0], v0[1]); w.y = cvt_pk_bf16(v0[2], v0[3]); w.z = cvt_pk_bf16(v1[0], v1[1]); w.w = cvt_pk_bf16(v1[2], v1[3]);
                        *(u32x4*)(rowp + bj * HALF) = w; }
            }
        }
    }
};
}

typedef unsigned short bf16;
constexpr int T_ = 16384, S_ = 4096, NBATCH = 4, D_ = 1024, NCOL = 6824, NP = 6912, DEPTH_ = 2;
constexpr int C_QA = 0, C_KA = 256, C_VA = 320, C_QI = 384, C_KI = 640, C_WI = 672, C_QB = 680, C_KB = 936, C_VB = 1064,
              C_QC = 1192, C_KC = 1448, C_VC = 1704, C_QD = 1960, C_KD = 2216, C_VD = 2472, C_G = 2728;
constexpr int NTHR = 512, NWAVE = 8;
constexpr float ALPHA = 1.41421356237309515f;
constexpr float LN_EPS = 1e-5f;
constexpr size_t MiB = 1u << 20;
constexpr size_t WS_STATS = 1 * MiB  , WS_COLS = 1 * MiB + 512 * 1024  ;
constexpr size_t WS_CTL = 0, WS_WIN_T = 2 * MiB, WS_WOUT_T = 30 * MiB, WS_WQ_T = 34 * MiB, WS_WBR_T = 38 * MiB, WS_HB = 42 * MiB,
                 WS_P = 74 * MiB, WS_MIX = 74 * MiB  , WS_Q = 138 * MiB  , WS_YS = 290 * MiB, WS_MRG = 322 * MiB,
                 WS_MASK = 354 * MiB, WS_EID = 362 * MiB, WS_GATE = 370 * MiB, WS_KMEAN = 378 * MiB, WS_SKB = 379 * MiB, WS_UV = 380 * MiB, WS_END = 508 * MiB;
constexpr size_t WIN_T_BYTES = (size_t)NP * 1024 * 2;
constexpr int LDS_BYTES = 144 * 1024;

struct Params { const float* in[13]; float* out; unsigned char* ws; };

__device__ __forceinline__ float bf2f(bf16 v) { return __uint_as_float((unsigned)v << 16); }
__device__ __forceinline__ unsigned f2bf(float f) { unsigned u = __float_as_uint(f); return (u + 0x7fffu + ((u >> 16) & 1u)) >> 16; }
__device__ __forceinline__ unsigned pk2(float lo, float hi) { return f2bf(lo) | (f2bf(hi) << 16); }
__device__ __forceinline__ void unpack8(const uint4 v, float* o) {
    o[0] = __uint_as_float(v.x << 16); o[1] = __uint_as_float(v.x & 0xffff0000u); o[2] = __uint_as_float(v.y << 16); o[3] = __uint_as_float(v.y & 0xffff0000u);
    o[4] = __uint_as_float(v.z << 16); o[5] = __uint_as_float(v.z & 0xffff0000u); o[6] = __uint_as_float(v.w << 16); o[7] = __uint_as_float(v.w & 0xffff0000u);
}
__device__ __forceinline__ float wave_sum(float v) {
#pragma unroll
    for (int o = 32; o > 0; o >>= 1) v += __shfl_xor(v, o);
    return v;
}
__device__ __forceinline__ float wave_max(float v) {
#pragma unroll
    for (int o = 32; o > 0; o >>= 1) v = fmaxf(v, __shfl_xor(v, o));
    return v;
}
__device__ __forceinline__ int wave_sum_i(int v) {
#pragma unroll
    for (int o = 32; o > 0; o >>= 1) v += __shfl_xor(v, o);
    return v;
}
__device__ __forceinline__ float logsig(float x) { return fminf(x, 0.f) - log1pf(expf(-fabsf(x))); }

__device__ void transpose_items(int WV_, const float* W, int K, int N, bf16* WT, float* sm, int item0, int nitems_total, int item_stride,
                                const float* rs_g = nullptr, const float* rs_b = nullptr, float* colsum = nullptr, float* colbias = nullptr) {
    const int tid = LTID(WV_);
    const int nkb = K / 64, nnb = (N + 63) / 64;
    for (int it = item0; it < nkb * nnb; it += item_stride) {
        const int kb = it % nkb, nb = it / nkb, k0 = kb * 64, n0 = nb * 64;
        __syncthreads();
        for (int e = tid; e < 64 * 64; e += NTHR) { const int kk = e >> 6, nn = e & 63; sm[kk * 65 + nn] = (n0 + nn < N) ? W[(size_t)(k0 + kk) * N + n0 + nn] : 0.f; }
        __syncthreads();
        if (rs_g) {
            if (tid < 64) { float cs = 0.f, cb = 0.f;
                for (int kk = 0; kk < 64; ++kk) { const float w = sm[kk * 65 + tid]; cs += w * rs_g[k0 + kk]; cb += w * rs_b[k0 + kk]; }
                atomicAdd(colsum + n0 + tid, cs); atomicAdd(colbias + n0 + tid, cb); }
            __syncthreads();
            for (int e = tid; e < 64 * 64; e += NTHR) { const int kk = e >> 6, nn = e & 63; sm[kk * 65 + nn] *= rs_g[k0 + kk]; }
            __syncthreads();
        }
        { const int nn = tid >> 3, c = tid & 7;
          if (n0 + nn < N) { uint4 o; o.x = pk2(sm[(8 * c + 0) * 65 + nn], sm[(8 * c + 1) * 65 + nn]); o.y = pk2(sm[(8 * c + 2) * 65 + nn], sm[(8 * c + 3) * 65 + nn]);
              o.z = pk2(sm[(8 * c + 4) * 65 + nn], sm[(8 * c + 5) * 65 + nn]); o.w = pk2(sm[(8 * c + 6) * 65 + nn], sm[(8 * c + 7) * 65 + nn]);
              *(uint4*)(WT + (size_t)(n0 + nn) * K + k0 + 8 * c) = o; } }
    }
    __syncthreads();
}
__device__ void prologue_phase(int WV_, const Params& p, float* sm) {
    const int tid = LTID(WV_), B = LBID(), G = LGRID();
    unsigned char* ws = p.ws;
    for (int l = 0; l < DEPTH_; ++l) {
        bf16* win_t = (bf16*)(ws + WS_WIN_T + l * WIN_T_BYTES);
        transpose_items(WV_, p.in[1] + (size_t)l * 1024 * NCOL, 1024, NCOL, win_t, sm, B, 0, G);
        for (int i = B * NTHR + tid; i < (NP - NCOL) * 1024 / 8; i += G * NTHR) ((uint4*)(win_t + (size_t)NCOL * 1024))[i] = make_uint4(0u, 0u, 0u, 0u);
        transpose_items(WV_, p.in[3] + (size_t)l * 1024 * 1024, 1024, 1024, (bf16*)(ws + WS_WOUT_T) + (size_t)l * 1024 * 1024, sm, B, 0, G);
        transpose_items(WV_, p.in[7] + (size_t)l * 1024 * 1024, 1024, 1024, (bf16*)(ws + WS_WQ_T) + (size_t)l * 1024 * 1024, sm, B, 0, G,
                        p.in[5] + l * 1024, p.in[6] + l * 1024, (float*)(ws + WS_COLS) + l * 2048, (float*)(ws + WS_COLS) + l * 2048 + 1024);
        for (int n = 0; n < 4; ++n)
            transpose_items(WV_, p.in[2] + ((size_t)l * 4 + n) * 256 * 1024, 256, 1024, (bf16*)(ws + WS_WBR_T) + ((size_t)l * 4 + n) * 1024 * 256, sm, B, 0, G);
    }
    const float4* x4 = (const float4*)p.in[0]; uint2* hb2 = (uint2*)(ws + WS_HB);
    for (size_t i = (size_t)B * NTHR + tid; i < (size_t)T_ * 1024 / 4; i += (size_t)G * NTHR) { const float4 v = x4[i]; hb2[i] = make_uint2(pk2(v.x, v.y), pk2(v.z, v.w)); }
}

__device__ __forceinline__ void ln_row(float4 (&v)[4], const float* g, const float* bb, float* orow, bf16* obrow, int lane) {
    float s = 0.f;
#pragma unroll
    for (int j = 0; j < 4; ++j) s += (v[j].x + v[j].y) + (v[j].z + v[j].w);
    const float mean = wave_sum(s) * (1.0f / 1024.0f);
    float s2 = 0.f;
#pragma unroll
    for (int j = 0; j < 4; ++j) { v[j].x -= mean; v[j].y -= mean; v[j].z -= mean; v[j].w -= mean; s2 += (v[j].x * v[j].x + v[j].y * v[j].y) + (v[j].z * v[j].z + v[j].w * v[j].w); }
    const float rstd = 1.0f / sqrtf(wave_sum(s2) * (1.0f / 1024.0f) + LN_EPS);
#pragma unroll
    for (int j = 0; j < 4; ++j) {
        const float4 gg = ((const float4*)g)[j * 64 + lane], b4 = ((const float4*)bb)[j * 64 + lane];
        float4 o; o.x = v[j].x * rstd * gg.x + b4.x; o.y = v[j].y * rstd * gg.y + b4.y; o.z = v[j].z * rstd * gg.z + b4.z; o.w = v[j].w * rstd * gg.w + b4.w;
        ((float4*)orow)[j * 64 + lane] = o;
        ((uint2*)obrow)[j * 64 + lane] = make_uint2(pk2(o.x, o.y), pk2(o.z, o.w));
    }
}
__device__ void ln1_phase(int WV_, const float* hin, const float* add, const float* g, const float* bb, float* hout, bf16* hb) {
    const int lane = LTID(WV_) & 63, wave = LTID(WV_) >> 6;
    for (int row = LBID() * NWAVE + wave; row < T_; row += LGRID() * NWAVE) {
        float4 v[4];
#pragma unroll
        for (int j = 0; j < 4; ++j) {
            const float4 a = ((const float4*)(hin + (size_t)row * 1024))[j * 64 + lane], m = ((const float4*)(add + (size_t)row * 1024))[j * 64 + lane];
            v[j].x = ALPHA * a.x + m.x; v[j].y = ALPHA * a.y + m.y; v[j].z = ALPHA * a.z + m.z; v[j].w = ALPHA * a.w + m.w;
        }
        ln_row(v, g, bb, hout + (size_t)row * 1024, hb + (size_t)row * 1024, lane);
    }
}


typedef short bf16x8_t __attribute__((ext_vector_type(8)));
typedef float f32x16_t __attribute__((ext_vector_type(16)));
typedef float f32x2_t __attribute__((ext_vector_type(2)));
typedef __bf16 bf16x2_t __attribute__((ext_vector_type(2)));
__device__ __forceinline__ unsigned cvtpk(float lo, float hi) { f32x2_t v = {lo, hi}; bf16x2_t b = __builtin_convertvector(v, bf16x2_t); return __builtin_bit_cast(unsigned, b); }
__device__ __forceinline__ int crow(int r, int hi) { return (r & 3) + 8 * (r >> 2) + 4 * hi; }
__device__ __forceinline__ float xlane32(float v) { return __shfl_xor(v, 32); }
__device__ __forceinline__ float vmax(float a, float b) { float r; asm("v_max_f32_e32 %0, %1, %2" : "=v"(r) : "v"(a), "v"(b)); return r; }
__device__ __forceinline__ float vmin(float a, float b) { float r; asm("v_min_f32_e32 %0, %1, %2" : "=v"(r) : "v"(a), "v"(b)); return r; }
__device__ __forceinline__ float vmax3(float a, float b, float c) { float r; asm("v_max3_f32 %0, %1, %2, %3" : "=v"(r) : "v"(a), "v"(b), "v"(c)); return r; }

constexpr int AT_KP = 72, AT_VP = 96;
constexpr int AT_KS = 0, AT_KS_BYTES = 64 * AT_KP * 2;
constexpr int AT_VT = 2 * AT_KS_BYTES, AT_VT_BYTES = 64 * AT_VP * 2;
constexpr int AT_KM = AT_VT + 2 * AT_VT_BYTES;
constexpr int AT_MISC = AT_KM + 32 * AT_KP * 2;
constexpr float LOG2E = 1.4426950408889634f;

__device__ __forceinline__ unsigned mk_unit(int kind, int b, int x, int y) { return ((unsigned)kind << 30) | ((unsigned)b << 28) | ((unsigned)x << 8) | (unsigned)y; }
__device__ void build_unit_table(unsigned* tab, int i) {
    int n = 0; unsigned res = 0u;
#pragma unroll 1
    for (int c = 64; c >= 1; --c) {
        if (i >= n && i < n + 4) res = mk_unit(0, i - n, 0, c - 1);
        n += 4;
        if ((c & 3) == 0) { if (i >= n && i < n + 16) { const int j = i - n; res = mk_unit(2, j >> 2, j & 3, c / 4 - 1); } n += 16; }
    }
    if (i < 512) tab[i] = res;
}

template <int kind> __device__ __forceinline__ void attn_unit(int WV_, const bf16* P, const unsigned char* mask, const float* kmean, const float* sinks, bf16* ys,
                                unsigned char* lds, int b, int ux, int uy) {
    int tid_ = LTID(WV_); asm volatile("" : "+v"(tid_));
    const int tid = tid_, lane = tid & 63, wave = __builtin_amdgcn_readfirstlane(tid >> 6), r32 = lane & 31, hi = lane >> 5;
    bf16* s_km = (bf16*)(lds + AT_KM);
    const int skey = tid >> 3, sc = tid & 7;
    {
        const bf16* Pb = P + (size_t)b * S_ * NP;
        int q0w, qcol, kcol, vcol, ycol, kt_hi, kt_lo; float slope2 = 0.f, sink2 = 0.f;
        if (kind == 0) { const int head = wave >> 1; q0w = uy * 64 + (wave & 1) * 32; qcol = C_QA + head * 64; kcol = C_KA; vcol = C_VA; ycol = head * 64;
            slope2 = exp2f(-8.0f * (float)(3 * head + 1) / 12.0f) * LOG2E; kt_hi = uy; kt_lo = 0; }
        else if (kind == 1) { const int hq = ux * 2 + (wave >> 2); q0w = uy * 128 + (wave & 3) * 32; qcol = C_QB + hq * 64; kcol = C_KB + ux * 64; vcol = C_VB + ux * 64; ycol = 256 + hq * 64;
            slope2 = exp2f(-8.0f * (float)(3 * hq + 2) / 12.0f) * LOG2E; sink2 = sinks[hq] * LOG2E; kt_hi = 2 * uy + 1; kt_lo = (2 * uy - 2 > 0) ? 2 * uy - 2 : 0; }
        else if (kind == 2) { q0w = uy * 256 + wave * 32; qcol = C_QC + ux * 64; kcol = C_KC + ux * 64; vcol = C_VC + ux * 64; ycol = 512 + ux * 64;
            slope2 = exp2f(-8.0f * (float)(3 * ux + 3) / 12.0f) * LOG2E; kt_hi = 4 * uy + 3; kt_lo = 0; }
        else { q0w = uy * 256 + wave * 32; qcol = C_QD + ux * 64; kcol = C_KD + ux * 64; vcol = C_VD + ux * 64; ycol = 768 + ux * 64; kt_hi = 4 * uy + 3; kt_lo = 0; }
        const int qpos = q0w + r32;
        bf16x8_t qf[4];
        { const bf16* qp = Pb + (size_t)qpos * NP + qcol + 8 * hi;
#pragma unroll
          for (int ks = 0; ks < 4; ++ks) qf[ks] = *(const bf16x8_t*)(qp + 16 * ks); }
        {
            const float qs = (kind == 3) ? 0.125f : 0.125f * LOG2E;
            typedef unsigned u32x4_t __attribute__((ext_vector_type(4)));
#pragma unroll
            for (int ks = 0; ks < 4; ++ks) { u32x4_t w = __builtin_bit_cast(u32x4_t, qf[ks]);
#pragma unroll
                for (int i = 0; i < 4; ++i) w[i] = cvtpk(__uint_as_float(w[i] << 16) * qs, __uint_as_float(w[i] & 0xffff0000u) * qs);
                qf[ks] = __builtin_bit_cast(bf16x8_t, w); }
        }
        float sb[16];
#pragma unroll
        for (int r = 0; r < 16; ++r) sb[r] = slope2 * (float)((r & 3) + 8 * (r >> 2));
        unsigned bm = 0u;
        if (kind == 2) {
            const int own = uy;
            for (int e = tid; e < 32 * 64; e += NTHR) { const int row = e >> 6, d = e & 63; s_km[row * AT_KP + d] = (row < 16) ? (bf16)f2bf(kmean[((b * 4 + ux) * 16 + row) * 64 + d]) : (bf16)0; }
            __syncthreads();
            f32x16_t gacc;
#pragma unroll
            for (int r = 0; r < 16; ++r) gacc[r] = 0.f;
#pragma unroll
            for (int ks = 0; ks < 4; ++ks) { const bf16x8_t a = *(const bf16x8_t*)(s_km + r32 * AT_KP + 16 * ks + 8 * hi); gacc = __builtin_amdgcn_mfma_f32_32x32x16_bf16(a, qf[ks], gacc, 0, 0, 0); }
            float gt[16];
#pragma unroll
            for (int r = 0; r < 8; ++r) { const float mine = gacc[r], other = xlane32(mine); const int bi = crow(r, 0);
                gt[bi] = hi ? other : mine; gt[bi + 4] = hi ? mine : other; }
#pragma unroll
            for (int n = 0; n < 16; ++n) if (n >= own) gt[n] = -INFINITY;
#pragma unroll
            for (int rep = 0; rep < 3; ++rep) {
                float mx = -INFINITY;
#pragma unroll
                for (int n = 0; n < 16; ++n) mx = fmaxf(mx, gt[n]);
                bool done = !(mx > -INFINITY);
#pragma unroll
                for (int n = 0; n < 16; ++n) { const bool hit = !done && gt[n] == mx; if (hit) { bm |= 1u << n; gt[n] = -INFINITY; done = true; } }
            }
        }
        f32x16_t o0, o1;
#pragma unroll
        for (int r = 0; r < 16; ++r) { o0[r] = 0.f; o1[r] = 0.f; }
        float m_run = -INFINITY, l_run = 0.f, carry = 0.f;
        const bf16* kg = Pb + (size_t)skey * NP + kcol + sc * 8;
        const bf16* vg = Pb + (size_t)skey * NP + vcol + sc * 8;
        uint4 rk = *(const uint4*)(kg + (size_t)kt_hi * 64 * NP), rv = *(const uint4*)(vg + (size_t)kt_hi * 64 * NP);
        int buf = 0;
        { bf16* ks_ = (bf16*)(lds + AT_KS); bf16* vt_ = (bf16*)(lds + AT_VT);
          *(uint4*)(ks_ + skey * AT_KP + sc * 8) = rk;
          *(uint4*)(vt_ + skey * AT_VP + sc * 8) = rv; }
        __syncthreads();
        bool wave_done = false;
        uint2 mw_next = make_uint2(0u, 0u);
        if (kind == 0) mw_next = *(const uint2*)(mask + (size_t)(b * S_ + qpos) * 512 + kt_hi * 8);
        for (int kt = kt_hi; kt >= kt_lo; --kt) {
            const bool more = kt > kt_lo;
            const uint2 mw = mw_next;
            if (kind == 0 && more) mw_next = *(const uint2*)(mask + (size_t)(b * S_ + qpos) * 512 + (kt - 1) * 8);
            if (more) { rk = *(const uint4*)(kg + (size_t)(kt - 1) * 64 * NP); rv = *(const uint4*)(vg + (size_t)(kt - 1) * 64 * NP); }
            const bf16* ks_ = (const bf16*)(lds + AT_KS + buf * AT_KS_BYTES);
            const bf16* vt_ = (const bf16*)(lds + AT_VT + buf * AT_VT_BYTES);
            bool active = (kt * 64 <= q0w + 31) && !wave_done;
            if (kind == 1) active = active && (kt * 64 + 63 >= q0w - 127);
            if (active) {
                const int kbase = kt * 64 + 4 * hi;
                f32x16_t p0, p1;
                if (kind != 3) {
                    const float cb = slope2 * (float)(kbase - qpos), cb1 = cb + 32.0f * slope2;
#pragma unroll
                    for (int r = 0; r < 16; ++r) { p0[r] = cb + sb[r]; p1[r] = cb1 + sb[r]; }
                } else {
#pragma unroll
                    for (int r = 0; r < 16; ++r) { p0[r] = 0.f; p1[r] = 0.f; }
                }
#pragma unroll
                for (int ks = 0; ks < 4; ++ks) {
                    const bf16x8_t a0 = *(const bf16x8_t*)(ks_ + r32 * AT_KP + 16 * ks + 8 * hi);
                    const bf16x8_t a1 = *(const bf16x8_t*)(ks_ + (32 + r32) * AT_KP + 16 * ks + 8 * hi);
                    p0 = __builtin_amdgcn_mfma_f32_32x32x16_bf16(a0, qf[ks], p0, 0, 0, 0);
                    p1 = __builtin_amdgcn_mfma_f32_32x32x16_bf16(a1, qf[ks], p1, 0, 0, 0);
                }
                if (kind != 3) {
                    float mx = -INFINITY;
                    if (kind == 0) {
                        const unsigned w0 = mw.x >> (4 * hi), w1 = mw.y >> (4 * hi);
#pragma unroll
                        for (int r = 0; r < 16; ++r) { const int off = (r & 3) + 8 * (r >> 2);
                            p0[r] = (w0 & (1u << off)) ? p0[r] : -INFINITY; p1[r] = (w1 & (1u << off)) ? p1[r] : -INFINITY; mx = vmax3(mx, p0[r], p1[r]); }
                    } else if (kind == 1) {
                        const int rel = qpos - kbase;
#pragma unroll
                        for (int r = 0; r < 16; ++r) { const int off = (r & 3) + 8 * (r >> 2);
                            p0[r] = ((unsigned)(rel - off) < 128u) ? p0[r] : -INFINITY; p1[r] = ((unsigned)(rel - off - 32) < 128u) ? p1[r] : -INFINITY; mx = vmax3(mx, p0[r], p1[r]); }
                    } else {
                        if ((kt >> 2) == uy) {
                            const int rel = qpos - kbase;
#pragma unroll
                            for (int r = 0; r < 16; ++r) { const int off = (r & 3) + 8 * (r >> 2);
                                p0[r] = (off <= rel) ? p0[r] : -INFINITY; p1[r] = (off + 32 <= rel) ? p1[r] : -INFINITY; mx = vmax3(mx, p0[r], p1[r]); }
                        } else {
                            const bool tile_ok = ((bm >> (kt >> 2)) & 1u) != 0u;
#pragma unroll
                            for (int r = 0; r < 16; ++r) { p0[r] = tile_ok ? p0[r] : -INFINITY; p1[r] = tile_ok ? p1[r] : -INFINITY; mx = vmax3(mx, p0[r], p1[r]); }
                        }
                    }
                    mx = vmax(mx, xlane32(mx));
                    const float m_new = vmax(m_run, mx);
                    const float m_safe = (m_new == -INFINITY) ? 0.f : m_new;
                    p0 = p0 - m_safe; p1 = p1 - m_safe;
#pragma unroll
                    for (int r = 0; r < 16; ++r) { p0[r] = __builtin_amdgcn_exp2f(p0[r]); p1[r] = __builtin_amdgcn_exp2f(p1[r]); }
                    float ls;
                    { typedef float f32x8_t __attribute__((ext_vector_type(8))); typedef float f32x4v_t __attribute__((ext_vector_type(4)));
                      const f32x16_t t16 = p0 + p1; const f32x8_t t8 = t16.lo + t16.hi; const f32x4v_t t4 = t8.lo + t8.hi; const f32x2_t t2 = t4.lo + t4.hi; ls = t2.x + t2.y; }
                    if (__any(m_new > m_run)) {
                        const float alpha = __builtin_amdgcn_exp2f(m_run - m_safe);
                        l_run *= alpha;
                        o0 = o0 * alpha; o1 = o1 * alpha;
                    }
                    l_run += ls; m_run = m_new;
                } else {
                    float run = carry;
#define SB_HALF(PX, KOFF) do { \
                    float lk[16]; \
                    _Pragma("unroll") for (int r = 0; r < 16; ++r) { \
                        const int off = (r & 3) + 8 * (r >> 2); \
                        const bool v = (kbase + off + (KOFF)) < qpos; \
                        const float z = PX[r]; \
                        const float t = 0.6931471805599453f * __builtin_amdgcn_logf(1.0f + __builtin_amdgcn_exp2f(-LOG2E * fabsf(z))); \
                        lk[r] = v ? (fminf(-z, 0.f) - t) : 0.f; \
                        PX[r] = v ? (fminf(z, 0.f) - t) : -INFINITY; } \
                    _Pragma("unroll") for (int g = 3; g >= 0; --g) { \
                        const float G = (lk[4 * g] + lk[4 * g + 1]) + (lk[4 * g + 2] + lk[4 * g + 3]); \
                        const float PG = xlane32(G); \
                        float la = run + (hi ? 0.f : PG); \
                        run += G + PG; \
                        PX[4 * g + 3] += la; la += lk[4 * g + 3]; PX[4 * g + 2] += la; la += lk[4 * g + 2]; PX[4 * g + 1] += la; la += lk[4 * g + 1]; PX[4 * g] += la; } \
                    _Pragma("unroll") for (int r = 0; r < 16; ++r) PX[r] = __builtin_amdgcn_exp2f(LOG2E * PX[r]); } while (0)
                    SB_HALF(p1, 32);
                    SB_HALF(p0, 0);
#undef SB_HALF
                    carry = run;
                }
                unsigned pw[16];
#pragma unroll
                for (int j = 0; j < 8; ++j) { pw[j] = cvtpk(p0[2 * j], p0[2 * j + 1]); pw[8 + j] = cvtpk(p1[2 * j], p1[2 * j + 1]); }
#pragma unroll
                for (int s = 0; s < 4; ++s) {
                    bf16x8_t pb; { const unsigned* q = pw + 4 * s; typedef unsigned u32x4_t __attribute__((ext_vector_type(4))); u32x4_t t4 = {q[0], q[1], q[2], q[3]}; pb = __builtin_bit_cast(bf16x8_t, t4); }
#pragma unroll
                    for (int dt = 0; dt < 2; ++dt) {
                        typedef short s16x4_t __attribute__((ext_vector_type(4)));
                        typedef __attribute__((address_space(3))) s16x4_t lds_s16x4;
                        const int gi_ = lane & 15;
                        const bf16* vp = vt_ + (16 * s + 4 * hi + (gi_ >> 2)) * AT_VP + 32 * dt + 16 * ((lane >> 4) & 1) + 4 * (gi_ & 3);
                        const s16x4_t lo = __builtin_amdgcn_ds_read_tr16_b64_v4i16((lds_s16x4*)vp), hi4 = __builtin_amdgcn_ds_read_tr16_b64_v4i16((lds_s16x4*)(vp + 8 * AT_VP));
                        const bf16x8_t va = {lo[0], lo[1], lo[2], lo[3], hi4[0], hi4[1], hi4[2], hi4[3]};
                        if (dt == 0) o0 = __builtin_amdgcn_mfma_f32_32x32x16_bf16(va, pb, o0, 0, 0, 0);
                        else         o1 = __builtin_amdgcn_mfma_f32_32x32x16_bf16(va, pb, o1, 0, 0, 0);
                    }
                }
            }
            if (kind == 3) {
                const float cm = carry;
                if (__all(cm < -110.0f) || !(kt * 64 <= q0w + 31) ) { if (__all(cm < -110.0f)) wave_done = true; }
            }
            if (more) {
                bf16* ksn = (bf16*)(lds + AT_KS + (buf ^ 1) * AT_KS_BYTES); bf16* vtn = (bf16*)(lds + AT_VT + (buf ^ 1) * AT_VT_BYTES);
                *(uint4*)(ksn + skey * AT_KP + sc * 8) = rk;
                *(uint4*)(vtn + skey * AT_VP + sc * 8) = rv;
            }
            if (kind == 3) { if (__syncthreads_and(wave_done ? 1 : 0)) break; }
            else __syncthreads();
            buf ^= 1;
        }
        float inv;
        if (kind == 3) inv = 1.0f;
        else {
            float lt = l_run + xlane32(l_run);
            if (kind == 1) { const float mf = fmaxf(m_run, sink2); const float sc2 = exp2f(m_run - mf); lt = lt * sc2 + exp2f(sink2 - mf); inv = sc2 / lt; }
            else inv = 1.0f / lt;
        }
        bf16* yp = ys + (size_t)(b * S_ + qpos) * 1024 + ycol + 4 * hi;
#pragma unroll
        for (int g = 0; g < 4; ++g) {
            *(uint2*)(yp + 8 * g) = make_uint2(cvtpk(o0[4 * g] * inv, o0[4 * g + 1] * inv), cvtpk(o0[4 * g + 2] * inv, o0[4 * g + 3] * inv));
            *(uint2*)(yp + 32 + 8 * g) = make_uint2(cvtpk(o1[4 * g] * inv, o1[4 * g + 1] * inv), cvtpk(o1[4 * g + 2] * inv, o1[4 * g + 3] * inv));
        }
    }
}
__device__ void attn_fast_phase(int WV_, const bf16* P, const unsigned char* mask, const float* kmean, const float* sinks, bf16* ys,
                                const unsigned* utab, unsigned* counter, unsigned char* lds) {
    volatile unsigned* s_unit = (volatile unsigned*)(lds + AT_MISC);
    for (;;) {
        __syncthreads();
        if (LTID(WV_) == 0) s_unit[0] = atomicAdd(counter, 1u);
        __syncthreads();
        const unsigned ui = s_unit[0];
        if (ui >= 512u) break;
        const unsigned ue = utab[ui];
        const int kind = (int)(ue >> 30), b = (int)((ue >> 28) & 3u), ux = (int)((ue >> 8) & 255u), uy = (int)(ue & 255u);
        if (kind == 0) attn_unit<0>(WV_, P, mask, kmean, sinks, ys, lds, b, ux, uy);
        else attn_unit<2>(WV_, P, mask, kmean, sinks, ys, lds, b, ux, uy);
    }
    for (int u = LBID(); u < 256; u += LGRID()) { __syncthreads(); attn_unit<3>(WV_, P, mask, kmean, sinks, ys, lds, u >> 6, (u >> 4) & 3, u & 15); }
    for (int u = LBID(); u < 256; u += LGRID()) { __syncthreads(); attn_unit<1>(WV_, P, mask, kmean, sinks, ys, lds, u >> 6, (u >> 5) & 1, u & 31); }
}

constexpr float U_SCALE = 128.0f, V_SCALE = 48.0f;
constexpr int ROW6 = 1536;
typedef float v32f_t __attribute__((ext_vector_type(32)));
typedef unsigned v6u_t __attribute__((ext_vector_type(6)));
typedef unsigned u32x4a8_t __attribute__((ext_vector_type(4), aligned(8)));
__device__ __forceinline__ float rdlane_f(float v, int l) { return __builtin_bit_cast(float, __builtin_amdgcn_readlane(__builtin_bit_cast(int, v), l)); }
__device__ __forceinline__ unsigned q_e2m3(float v) {
    const float a = fminf(fabsf(v), 7.5f);
    unsigned code;
    if (a < 1.0f) code = (unsigned)rintf(a * 8.0f);
    else if (a < 2.0f) code = 8u + (unsigned)rintf((a - 1.0f) * 8.0f);
    else if (a < 4.0f) code = 16u + (unsigned)rintf((a - 2.0f) * 4.0f);
    else code = 24u + (unsigned)rintf((a - 4.0f) * 2.0f);
    return code | (v < 0.f ? 32u : 0u);
}
__device__ void convert_tables(int WV_, const Params& p) {
    const size_t nchunk = (size_t)DEPTH_ * 16384 * 2 * 32;
    for (size_t i = (size_t)LBID() * NTHR + LTID(WV_); i < nchunk; i += (size_t)LGRID() * NTHR) {
        const int c = (int)(i & 31), uvsel = (int)((i >> 5) & 1); const size_t le = i >> 6;
        const float* src = (uvsel ? p.in[10] : p.in[9]) + le * 1024 + c * 32;
        const float sc = uvsel ? V_SCALE : U_SCALE;
        unsigned w[6] = {0u, 0u, 0u, 0u, 0u, 0u};
#pragma unroll
        for (int q4 = 0; q4 < 8; ++q4) {
            const float4 a = ((const float4*)src)[q4];
            const float av[4] = {a.x, a.y, a.z, a.w};
#pragma unroll
            for (int e = 0; e < 4; ++e) { const int idx = q4 * 4 + e, bit = 6 * idx, d = bit >> 5, s = bit & 31; const unsigned code = q_e2m3(av[e] * sc);
                w[d] |= code << s; if (s > 26) w[d + 1] |= code >> (32 - s); }
        }
        uint2* dst = (uint2*)(p.ws + WS_UV + le * ROW6 + uvsel * 768 + c * 24);
        dst[0] = make_uint2(w[0], w[1]); dst[1] = make_uint2(w[2], w[3]); dst[2] = make_uint2(w[4], w[5]);
    }
}
__device__ __forceinline__ v6u_t ld_pk6(const unsigned char* ptr) {
    const uint2 a = ((const uint2*)ptr)[0], b = ((const uint2*)ptr)[1], c = ((const uint2*)ptr)[2];
    const v6u_t pk = {a.x, a.y, b.x, b.y, c.x, c.y};
    return pk;
}
__device__ void peer_fast_phase(int WV_, float* h, bf16* hb, const int* eid, const float* gate, const unsigned char* uv, const float* g1, const float* b1, const float* g, const float* bb, unsigned char* lds) {
    const int tid = LTID(WV_), lane = tid & 63, wave = tid >> 6, l32 = lane & 31, hi = lane >> 5;
    float* pl = (float*)(lds + wave * 16384);
    unsigned char* raw = lds + wave * 16384 + 4096 + lane * 24;
    for (int t = LBID() * NWAVE + wave; t < T_; t += LGRID() * NWAVE) {
        float* hr = h + (size_t)t * 1024 + l32 * 32;
        float x[32], acc[32];
#pragma unroll
        for (int q4 = 0; q4 < 8; ++q4) { const float4 a = ((const float4*)hr)[q4]; x[4 * q4] = a.x; x[4 * q4 + 1] = a.y; x[4 * q4 + 2] = a.z; x[4 * q4 + 3] = a.w; }
        {
            float s = 0.f;
#pragma unroll
            for (int i = 0; i < 32; ++i) s += x[i];
#pragma unroll
            for (int o = 16; o > 0; o >>= 1) s += __shfl_xor(s, o);
            const float mean = s * (1.0f / 1024.0f);
            float s2 = 0.f;
#pragma unroll
            for (int i = 0; i < 32; ++i) { x[i] -= mean; s2 += x[i] * x[i]; }
#pragma unroll
            for (int o = 16; o > 0; o >>= 1) s2 += __shfl_xor(s2, o);
            const float rstd = 1.0f / sqrtf(s2 * (1.0f / 1024.0f) + LN_EPS);
#pragma unroll
            for (int q4 = 0; q4 < 8; ++q4) { const float4 gg = ((const float4*)(g1 + l32 * 32))[q4], cc = ((const float4*)(b1 + l32 * 32))[q4];
                x[4 * q4] = x[4 * q4] * rstd * gg.x + cc.x; x[4 * q4 + 1] = x[4 * q4 + 1] * rstd * gg.y + cc.y; x[4 * q4 + 2] = x[4 * q4 + 2] * rstd * gg.z + cc.z; x[4 * q4 + 3] = x[4 * q4 + 3] * rstd * gg.w + cc.w; }
        }
#pragma unroll
        for (int i = 0; i < 32; ++i) acc[i] = 0.f;
#pragma unroll 1
        for (int batch = 0; batch < 4; ++batch) {
            const int my_eid = eid[(size_t)t * 128 + batch * 32 + l32];
            const float my_gate = gate[(size_t)t * 128 + batch * 32 + l32];
#pragma unroll 1
            for (int grp = 0; grp < 2; ++grp) {
                { u32x4a8_t pa[8]; uint2 pc[8];
#pragma unroll
                  for (int i = 0; i < 8; ++i) { const int id = __shfl(my_eid, 2 * (grp * 8 + i) + hi); const unsigned char* rp = uv + (size_t)id * ROW6 + l32 * 24; pa[i] = *(const u32x4a8_t*)rp; pc[i] = *(const uint2*)(rp + 16); }
#pragma unroll
                  for (int i = 0; i < 8; ++i) { uint2* wp = (uint2*)(raw + i * 1536); wp[0] = make_uint2(pa[i].x, pa[i].y); wp[1] = make_uint2(pa[i].z, pa[i].w); wp[2] = pc[i]; } }
#pragma unroll 1
                for (int i = 0; i < 8; ++i) {
                    const uint2* rp = (const uint2*)(raw + i * 1536); const uint2 a = rp[0], b = rp[1], c = rp[2];
                    const v6u_t pk6 = {a.x, a.y, b.x, b.y, c.x, c.y}; const v32f_t f = __builtin_amdgcn_cvt_scalef32_pk32_f32_fp6(pk6, 1.0f);
                    f32x2_t dv0 = {0.f, 0.f}, dv1 = {0.f, 0.f};
#pragma unroll
                    for (int j = 0; j < 8; ++j) { const f32x2_t fa = {f[2 * j], f[2 * j + 1]}, fb = {f[16 + 2 * j], f[17 + 2 * j]}, xa = {x[2 * j], x[2 * j + 1]}, xb = {x[16 + 2 * j], x[17 + 2 * j]};
                        dv0 = fa * xa + dv0; dv1 = fb * xb + dv1; }
                    pl[(2 * (grp * 8 + i) + hi) * 32 + l32] = (dv0.x + dv0.y) + (dv1.x + dv1.y);
                }
            }
            float d;
            { const float4* pr = (const float4*)(pl + l32 * 32); float4 s4 = pr[0];
#pragma unroll
              for (int i = 1; i < 8; ++i) { const float4 v = pr[i]; s4.x += v.x; s4.y += v.y; s4.z += v.z; s4.w += v.w; }
              d = ((s4.x + s4.y) + (s4.z + s4.w)) * (1.0f / U_SCALE); }
            const float hv = 0.5f * d * (1.0f + erff(d * 0.70710678118654752f)) * my_gate * (1.0f / V_SCALE);
#pragma unroll 1
            for (int grp = 0; grp < 2; ++grp) {
                { u32x4a8_t pa[8]; uint2 pc[8];
#pragma unroll
                  for (int i = 0; i < 8; ++i) { const int id = __shfl(my_eid, 2 * (grp * 8 + i) + hi); const unsigned char* rp = uv + (size_t)id * ROW6 + 768 + l32 * 24; pa[i] = *(const u32x4a8_t*)rp; pc[i] = *(const uint2*)(rp + 16); }
#pragma unroll
                  for (int i = 0; i < 8; ++i) { uint2* wp = (uint2*)(raw + i * 1536); wp[0] = make_uint2(pa[i].x, pa[i].y); wp[1] = make_uint2(pa[i].z, pa[i].w); wp[2] = pc[i]; } }
#pragma unroll 1
                for (int i = 0; i < 8; ++i) {
                    const float c = __shfl(hv, 2 * (grp * 8 + i) + hi);
                    const uint2* rp = (const uint2*)(raw + i * 1536); const uint2 a = rp[0], b = rp[1], cc = rp[2];
                    const v6u_t pk6 = {a.x, a.y, b.x, b.y, cc.x, cc.y}; const v32f_t f = __builtin_amdgcn_cvt_scalef32_pk32_f32_fp6(pk6, 1.0f);
                    const f32x2_t c2 = {c, c};
#pragma unroll
                    for (int j = 0; j < 16; ++j) { const f32x2_t fj = {f[2 * j], f[2 * j + 1]}; f32x2_t aj = {acc[2 * j], acc[2 * j + 1]}; aj = fj * c2 + aj; acc[2 * j] = aj.x; acc[2 * j + 1] = aj.y; }
                }
            }
        }
        float y[32], s = 0.f;
#pragma unroll
        for (int i = 0; i < 32; ++i) { acc[i] += __shfl_xor(acc[i], 32); y[i] = ALPHA * x[i] + acc[i]; s += y[i]; }
#pragma unroll
        for (int o = 16; o > 0; o >>= 1) s += __shfl_xor(s, o);
        const float mean = s * (1.0f / 1024.0f);
        float s2 = 0.f;
#pragma unroll
        for (int i = 0; i < 32; ++i) { y[i] -= mean; s2 += y[i] * y[i]; }
#pragma unroll
        for (int o = 16; o > 0; o >>= 1) s2 += __shfl_xor(s2, o);
        const float rstd = 1.0f / sqrtf(s2 * (1.0f / 1024.0f) + LN_EPS);
        float o[16];
#pragma unroll
        for (int q4 = 0; q4 < 4; ++q4) {
            const float4 gg = ((const float4*)(g + l32 * 32 + hi * 16))[q4], cc = ((const float4*)(bb + l32 * 32 + hi * 16))[q4];
            float ya[4], yb2[4];
#pragma unroll
            for (int e = 0; e < 4; ++e) { ya[e] = y[4 * q4 + e]; yb2[e] = y[16 + 4 * q4 + e]; }
            asm volatile("" : "+v"(ya[0]), "+v"(ya[1]), "+v"(ya[2]), "+v"(ya[3]), "+v"(yb2[0]), "+v"(yb2[1]), "+v"(yb2[2]), "+v"(yb2[3]));
            const float y0 = hi ? yb2[0] : ya[0], y1 = hi ? yb2[1] : ya[1], y2 = hi ? yb2[2] : ya[2], y3 = hi ? yb2[3] : ya[3];
            o[4 * q4] = y0 * rstd * gg.x + cc.x; o[4 * q4 + 1] = y1 * rstd * gg.y + cc.y; o[4 * q4 + 2] = y2 * rstd * gg.z + cc.z; o[4 * q4 + 3] = y3 * rstd * gg.w + cc.w;
            ((float4*)(hr + hi * 16))[q4] = make_float4(o[4 * q4], o[4 * q4 + 1], o[4 * q4 + 2], o[4 * q4 + 3]);
        }
        uint4* hbp = (uint4*)(hb + (size_t)t * 1024 + l32 * 32 + hi * 16);
        hbp[0] = make_uint4(pk2(o[0], o[1]), pk2(o[2], o[3]), pk2(o[4], o[5]), pk2(o[6], o[7]));
        hbp[1] = make_uint4(pk2(o[8], o[9]), pk2(o[10], o[11]), pk2(o[12], o[13]), pk2(o[14], o[15]));
    }
}

__device__ __forceinline__ float pack_pl(float v, unsigned pl) { return __uint_as_float((__float_as_uint(v) & ~127u) | pl); }
__device__ __forceinline__ void ins16(float (&s)[16], float x) {
#pragma unroll
    for (int k = 15; k >= 1; --k) s[k] = __builtin_amdgcn_fmed3f(s[k - 1], x, s[k]);
    s[0] = vmax(s[0], x);
}
template <int D> __device__ __forceinline__ void bitonic_stage(float (&c)[16]) {
#pragma unroll
    for (int i = 0; i < 16; ++i) if ((i & D) == 0) { const float a = vmax(c[i], c[i + D]), b = vmin(c[i], c[i + D]); c[i] = a; c[i + D] = b; }
}
__device__ __forceinline__ int decode_key(unsigned pl) { return (int)(32u * ((pl >> 4) & 3u) + (pl & 3u) + 8u * ((pl >> 2) & 3u) + 4u * ((pl >> 6) & 1u)); }
__device__ void route_fast_phase(int WV_, const bf16* qb, const bf16* skb  , int* eid, float* gate, unsigned char* lds, int pm = -1, int pn = 0) {
    const int tid = LTID(WV_), lane = tid & 63, wave = tid >> 6, r32 = lane & 31, hi = lane >> 5;
    unsigned* lidx = (unsigned*)lds + wave * (64 * 33) + lane * 33;
    const int u_first = (pm >= 0) ? 0 : LBID() * NWAVE + wave, u_end = (pm >= 0) ? 2 : (T_ / 32) * 8, u_step = (pm >= 0) ? 1 : LGRID() * NWAVE;
    for (int unit = u_first; unit < u_end; unit += u_step) {
        const int h = (pm >= 0) ? 2 * pn + unit : (unit & 7), t = ((pm >= 0) ? 8 * pm + wave : (unit >> 3)) * 32 + r32;
        float sl[2][16];
#pragma unroll
        for (int p = 0; p < 2; ++p) {
            bf16x8_t qf[4];
            { const bf16* qp = qb + (size_t)t * 1024 + h * 128 + p * 64 + 8 * hi;
#pragma unroll
              for (int ks = 0; ks < 4; ++ks) qf[ks] = *(const bf16x8_t*)(qp + 16 * ks); }
            float s[16];
#pragma unroll
            for (int k = 0; k < 16; ++k) s[k] = -INFINITY;
            const bf16* skp = skb + ((size_t)(h * 2 + p) * 128 + r32) * 64 + 8 * hi;
#pragma unroll
            for (int kt = 0; kt < 4; ++kt) {
                f32x16_t acc;
#pragma unroll
                for (int r = 0; r < 16; ++r) acc[r] = 0.f;
#pragma unroll
                for (int ks = 0; ks < 4; ++ks) { const bf16x8_t a = *(const bf16x8_t*)(skp + (size_t)kt * 32 * 64 + 16 * ks); acc = __builtin_amdgcn_mfma_f32_32x32x16_bf16(a, qf[ks], acc, 0, 0, 0); }
#pragma unroll
                for (int r = 0; r < 16; ++r) ins16(s, pack_pl(acc[r], (unsigned)(kt * 16 + r)));
            }
            const unsigned hb = (unsigned)hi << 6;
#pragma unroll
            for (int k = 0; k < 16; ++k) s[k] = __uint_as_float(__float_as_uint(s[k]) | hb);
            float c[16];
#pragma unroll
            for (int k = 0; k < 16; ++k) c[k] = vmax(s[k], __shfl_xor(s[15 - k], 32));
            bitonic_stage<8>(c); bitonic_stage<4>(c); bitonic_stage<2>(c); bitonic_stage<1>(c);
#pragma unroll
            for (int k = 0; k < 16; ++k) { sl[p][k] = c[k]; lidx[p * 16 + k] = (unsigned)decode_key(__float_as_uint(c[k]) & 127u); }
        }
        float w[16];
#pragma unroll
        for (int k = 0; k < 16; ++k) w[k] = -INFINITY;
#pragma unroll
        for (int i = 0; i < 16; ++i)
#pragma unroll
            for (int j = 0; j < 16; ++j)
                if ((i + 1) * (j + 1) <= 16) { const float v = sl[0][i] + sl[1][j]; ins16(w, __uint_as_float((__float_as_uint(v) & ~255u) | (unsigned)(i * 16 + j))); }
        float e[16], sum = 0.f;
#pragma unroll
        for (int k = 0; k < 16; ++k) { e[k] = expf(w[k] - w[0]); sum += e[k]; }
        const float inv = 1.0f / sum;
        int ide[8]; float gte[8];
#pragma unroll
        for (int k = 0; k < 8; ++k) {
            float wa = w[k], wb = w[8 + k], ea = e[k], eb = e[8 + k];
            asm volatile("" : "+v"(wa), "+v"(wb), "+v"(ea), "+v"(eb));
            const float wv = hi ? wb : wa;
            const unsigned pl = __float_as_uint(wv) & 255u;
            ide[k] = (int)(lidx[pl >> 4] * 128u + lidx[16 + (pl & 15u)]);
            gte[k] = (hi ? eb : ea) * inv;
        }
        int* ep = eid + (size_t)t * 128 + h * 16 + hi * 8; float* gp = gate + (size_t)t * 128 + h * 16 + hi * 8;
        *(int4*)ep = make_int4(ide[0], ide[1], ide[2], ide[3]); *(int4*)(ep + 4) = make_int4(ide[4], ide[5], ide[6], ide[7]);
        *(float4*)gp = make_float4(gte[0], gte[1], gte[2], gte[3]); *(float4*)(gp + 4) = make_float4(gte[4], gte[5], gte[6], gte[7]);
    }
}

typedef float f32x4_t __attribute__((ext_vector_type(4)));
typedef __bf16 bf16x2v __attribute__((ext_vector_type(2)));
__device__ __forceinline__ float dot2bf(unsigned a, unsigned b, float c) { return __builtin_amdgcn_fdot2_f32_bf16(__builtin_bit_cast(bf16x2v, a), __builtin_bit_cast(bf16x2v, b), c, false); }
__device__ __forceinline__ void cnt_gt(int& cnt, unsigned a, unsigned b) { asm("v_cmp_gt_u32_e32 vcc, %1, %2\n\tv_addc_co_u32_e32 %0, vcc, 0, %0, vcc" : "+v"(cnt) : "v"(a), "v"(b) : "vcc"); }
__device__ __forceinline__ void cnt_eq(int& cnt, unsigned a, unsigned b) { asm("v_cmp_eq_u32_e32 vcc, %1, %2\n\tv_addc_co_u32_e32 %0, vcc, 0, %0, vcc" : "+v"(cnt) : "v"(a), "v"(b) : "vcc"); }
__device__ __forceinline__ unsigned flag_gt(unsigned a, unsigned b) { unsigned r; asm("v_cmp_gt_u32_e32 vcc, %1, %2\n\tv_cndmask_b32_e64 %0, 0, 1, vcc" : "=v"(r) : "v"(a), "v"(b) : "vcc"); return r; }
__device__ __forceinline__ unsigned flag_eq(unsigned a, unsigned b) { unsigned r; asm("v_cmp_eq_u32_e32 vcc, %1, %2\n\tv_cndmask_b32_e64 %0, 0, 1, vcc" : "=v"(r) : "v"(a), "v"(b) : "vcc"); return r; }
__device__ __forceinline__ void cnt_ge(int& cnt, unsigned key, unsigned cand) { asm("v_cmp_ge_u32_e32 vcc, %1, %2\n\tv_addc_co_u32_e32 %0, vcc, 0, %0, vcc" : "+v"(cnt) : "v"(key), "v"(cand) : "vcc"); }

template <int CTRL, int RM> __device__ __forceinline__ unsigned dpp0(unsigned v) { return (unsigned)__builtin_amdgcn_update_dpp(0, (int)v, CTRL, RM, 0xf, false); }
template <int CTRL> __device__ __forceinline__ unsigned dppf(unsigned v) { return (unsigned)__builtin_amdgcn_update_dpp(-1, (int)v, CTRL, 0xf, 0xf, false); }
__device__ __forceinline__ unsigned wave_sum_u_dpp(unsigned v) {
    v += dpp0<0xB1, 0xf>(v); v += dpp0<0x4E, 0xf>(v); v += dpp0<0x141, 0xf>(v); v += dpp0<0x140, 0xf>(v);
    return (unsigned)__builtin_amdgcn_readlane((int)v, 0) + (unsigned)__builtin_amdgcn_readlane((int)v, 16) + (unsigned)__builtin_amdgcn_readlane((int)v, 32) + (unsigned)__builtin_amdgcn_readlane((int)v, 48);
}
__device__ __forceinline__ unsigned wave_min_u_dpp(unsigned v) {
    unsigned t;
    t = dppf<0xB1>(v); v = t < v ? t : v; t = dppf<0x4E>(v); v = t < v ? t : v; t = dppf<0x141>(v); v = t < v ? t : v; t = dppf<0x140>(v); v = t < v ? t : v;
    const unsigned a = (unsigned)__builtin_amdgcn_readlane((int)v, 0), b = (unsigned)__builtin_amdgcn_readlane((int)v, 16), c = (unsigned)__builtin_amdgcn_readlane((int)v, 32), d = (unsigned)__builtin_amdgcn_readlane((int)v, 48);
    const unsigned ab = a < b ? a : b, cd = c < d ? c : d; return ab < cd ? ab : cd;
}
__device__ __forceinline__ unsigned wave_incl_scan_u_dpp(unsigned v) {
    v += dpp0<0x111, 0xf>(v); v += dpp0<0x112, 0xf>(v); v += dpp0<0x114, 0xf>(v); v += dpp0<0x118, 0xf>(v);
    v += dpp0<0x142, 0xa>(v);
    v += dpp0<0x143, 0xc>(v);
    return v;
}
typedef __attribute__((address_space(3))) unsigned lds_u32;
template <int SHIFT> __device__ __forceinline__ unsigned radix_pass(const unsigned (&key)[64], unsigned pre, lds_u32* hist, int lane, int& need, int jlim, unsigned L) {
    typedef unsigned u32x4v __attribute__((ext_vector_type(4)));
    typedef __attribute__((address_space(3))) u32x4v lds_u32x4;
    const int fl = 63 - lane;
    { const u32x4v z4 = {0u, 0u, 0u, 0u};
#pragma unroll
      for (int i = 0; i < 8; ++i) ((lds_u32x4*)(hist + fl * 32))[i] = z4; }
    const unsigned hb = (unsigned)(size_t)hist + 4u * (unsigned)(lane & 7);
    const unsigned one = 1u;
    asm volatile("" ::: "memory");
#pragma unroll
    for (int j4 = 0; j4 < 16; ++j4) {
        if (4 * j4 <= jlim) {
            bool grp = true;
            if (SHIFT <= 8) {
                const bool any = ((key[4 * j4] >> (SHIFT + 8)) == pre) | ((key[4 * j4 + 1] >> (SHIFT + 8)) == pre) | ((key[4 * j4 + 2] >> (SHIFT + 8)) == pre) | ((key[4 * j4 + 3] >> (SHIFT + 8)) == pre);
                grp = __ballot(any) != 0ull;
            }
            if (grp) {
#pragma unroll
                for (int e = 0; e < 4; ++e) { const int j = 4 * j4 + e;
                    const unsigned addr = hb + (((key[j] >> SHIFT) & 255u) << 5);
                    unsigned long long sv;
                    if (SHIFT == 24) asm volatile("v_cmp_ge_u32_e32 vcc, %1, %2\n\ts_and_saveexec_b64 %0, vcc\n\tds_add_u32 %3, %4\n\ts_mov_b64 exec, %0" : "=&s"(sv) : "v"(key[j]), "v"(L), "v"(addr), "v"(one) : "vcc", "memory");
                    else { const unsigned t = key[j] >> ((SHIFT + 8) & 31);
                        asm volatile("v_cmp_eq_u32_e32 vcc, %1, %2\n\ts_and_saveexec_b64 %0, vcc\n\tds_add_u32 %3, %4\n\ts_mov_b64 exec, %0" : "=&s"(sv) : "v"(t), "v"(pre), "v"(addr), "v"(one) : "vcc", "memory"); }
                }
            }
        }
    }
    asm volatile("s_waitcnt lgkmcnt(0)" ::: "memory");
    unsigned dsum[4]; unsigned sumL = 0u;
#pragma unroll
    for (int i = 0; i < 4; ++i) { const u32x4v v0 = ((const lds_u32x4*)(hist + fl * 32))[2 * i], v1 = ((const lds_u32x4*)(hist + fl * 32))[2 * i + 1];
        dsum[i] = ((v0.x + v0.y) + (v0.z + v0.w)) + ((v1.x + v1.y) + (v1.z + v1.w)); sumL += dsum[i]; }
    const unsigned incl = wave_incl_scan_u_dpp(sumL);
    const unsigned above = incl - sumL;
    const bool own = (above < (unsigned)need) && ((unsigned)need <= above + sumL);
    const int owner = __ffsll((long long)__ballot(own)) - 1;
    unsigned acc = above; int sel = -1; unsigned cab = 0u;
#pragma unroll
    for (int i = 3; i >= 0; --i) { const unsigned c = dsum[i]; const bool hit = (sel < 0) && (acc + c >= (unsigned)need); cab = hit ? acc : cab; sel = hit ? i : sel; acc += c; }
    const int ow = owner < 0 ? 0 : owner;
    const unsigned digit = (unsigned)__builtin_amdgcn_readlane(sel, ow) + (unsigned)(4 * (63 - ow));
    need -= (int)__builtin_amdgcn_readlane((int)cab, ow);
    return digit;
}
#ifndef TS_SEL
#define TS_SEL 0
#endif
#define ITS_B() do { if (TS_SEL >= 20 && TS_SEL <= 25 && WV_ == 0 && LANEID() == 0) ((volatile __attribute__((address_space(3))) unsigned long long*)((__attribute__((address_space(3))) unsigned char*)lds + 147456 - 16 - 32))[0] = __builtin_amdgcn_s_memrealtime(); } while (0)
#define ITS_E(k) do { if ((k) == TS_SEL && WV_ == 0 && LANEID() == 0) { volatile __attribute__((address_space(3))) unsigned long long* w_ = (volatile __attribute__((address_space(3))) unsigned long long*)((__attribute__((address_space(3))) unsigned char*)lds + 147456 - 16 - 32); w_[1] += __builtin_amdgcn_s_memrealtime() - w_[0]; } } while (0)
__device__ void index_fast_phase(int WV_, const bf16* P, unsigned char* mask, float* kmean, float* scratch_all, unsigned* qctr, unsigned char* lds) {
    const int tid = LTID(WV_), lane = tid & 63, wave = tid >> 6, bid = LBID(), G = LGRID();
    float* s_part = (float*)lds;
    ITS_B();
    for (int k = bid; k < 256; k += G) {
        const int b = k >> 6, h = (k >> 4) & 3, blk = k & 15;
        const bf16* kp = P + (size_t)(b * S_ + blk * 256 + wave * 32) * NP + C_KC + h * 64 + lane;
        float a = 0.f;
#pragma unroll 8
        for (int j = 0; j < 32; ++j) a += bf2f(kp[(size_t)j * NP]);
        __syncthreads();
        s_part[wave * 64 + lane] = a;
        __syncthreads();
        if (tid < 64) { float s = 0.f;
#pragma unroll
            for (int w = 0; w < 8; ++w) s += s_part[w * 64 + tid];
            kmean[((b * 4 + h) * 16 + blk) * 64 + tid] = s * (1.0f / 256.0f); }
    }
    ITS_E(22);
    float* scr = scratch_all + (size_t)bid * (16 * 4096);
    const int lq = lane & 15, g4 = lane >> 4;
    volatile __attribute__((address_space(3))) unsigned* qslot = (volatile __attribute__((address_space(3))) unsigned*)((__attribute__((address_space(3))) unsigned char*)lds + 69632);
    unsigned ticket = (unsigned)bid;
    for (;;) {
        if (ticket >= 1024u) break;
        const int ui = (int)ticket;
        unsigned nticket = 0u;
        if (tid == 0) nticket = (unsigned)G + __hip_atomic_fetch_add(qctr, 1u, __ATOMIC_RELAXED, __HIP_MEMORY_SCOPE_AGENT);
        const int b = ui >> 8, k = ui & 255, tile = (b & 1) ? 255 - k : k, q0 = tile * 16;
        const bf16* Pb = P + (size_t)b * S_ * NP;
        const int ntiles = tile + 1;
        ITS_B();
        bf16x8_t qf[8]; float wi[8];
        { const bf16* qp = Pb + (size_t)(q0 + lq) * NP + C_QI + 8 * g4;
#pragma unroll
          for (int h = 0; h < 8; ++h) qf[h] = *(const bf16x8_t*)(qp + 32 * h);
          const uint4 wv = *(const uint4*)(Pb + (size_t)(q0 + lq) * NP + C_WI); unpack8(wv, wi); }
        bf16x8_t qch, qcl;
        { typedef unsigned u32x4_t __attribute__((ext_vector_type(4)));
          float qc[8];
#pragma unroll
          for (int i = 0; i < 8; ++i) qc[i] = 0.f;
#pragma unroll
          for (int h = 0; h < 8; ++h) { const u32x4_t w4 = __builtin_bit_cast(u32x4_t, qf[h]);
#pragma unroll
              for (int i = 0; i < 4; ++i) { qc[2 * i] += wi[h] * __uint_as_float(w4[i] << 16); qc[2 * i + 1] += wi[h] * __uint_as_float(w4[i] & 0xffff0000u); } }
          u32x4_t hi4, lo4;
#pragma unroll
          for (int i = 0; i < 4; ++i) { const unsigned hw = cvtpk(qc[2 * i], qc[2 * i + 1]); hi4[i] = hw;
              lo4[i] = cvtpk(qc[2 * i] - __uint_as_float(hw << 16), qc[2 * i + 1] - __uint_as_float(hw & 0xffff0000u)); }
          qch = __builtin_bit_cast(bf16x8_t, hi4); qcl = __builtin_bit_cast(bf16x8_t, lo4); }
        {
            bf16x8_t afn = *(const bf16x8_t*)(Pb + (size_t)((wave < ntiles ? wave : 0) * 16 + lq) * NP + C_KI + 8 * g4);
            for (int kt = wave; kt < ntiles; kt += NWAVE) {
                const bf16x8_t af = afn;
                { const int ktn = (kt + NWAVE < ntiles) ? kt + NWAVE : kt; afn = *(const bf16x8_t*)(Pb + (size_t)(ktn * 16 + lq) * NP + C_KI + 8 * g4); }
                f32x4_t a[8];
                const f32x4_t z = {0.f, 0.f, 0.f, 0.f};
#pragma unroll
                for (int h = 0; h < 8; ++h) a[h] = __builtin_amdgcn_mfma_f32_16x16x32_bf16(af, qf[h], z, 0, 0, 0);
                f32x4_t sc = __builtin_amdgcn_mfma_f32_16x16x32_bf16(af, qch, z, 0, 0, 0);
                sc = __builtin_amdgcn_mfma_f32_16x16x32_bf16(af, qcl, sc, 0, 0, 0);
                __builtin_amdgcn_sched_barrier(0);
#pragma unroll
                for (int h = 0; h < 8; ++h)
#pragma unroll
                    for (int r = 0; r < 4; ++r) sc[r] = __builtin_fmaf(__builtin_fabsf(a[h][r]), wi[h], sc[r]);
#pragma unroll
                for (int r = 0; r < 4; ++r) { sc[r] *= 0.03125f; if (sc[r] == 0.f) sc[r] = 0.f; }
                *(f32x4_t*)(scr + (size_t)lq * 4096 + kt * 16 + 4 * g4) = sc;
            }
        }
        __threadfence_block();
        __syncthreads();
        __threadfence_block();
        ITS_E(20); ITS_B();
        lds_u32* hist = (lds_u32*)((__attribute__((address_space(3))) unsigned char*)lds + 2048) + wave * 2048;
#pragma unroll 1
        for (int qi = 0; qi < 2; ++qi) {
            const int ql = 2 * wave + qi, q = q0 + ql;
            const float* row = scr + (size_t)ql * 4096 + lane;
            const int qrel = q - lane * 64;
            const int jlim = __builtin_amdgcn_readfirstlane(q >> 6);
            const int jmax = (q - lane) >> 6;
            unsigned wlo = 0u, whi = 0u;
            if (q + 1 > 256) {
                unsigned key[64];
#pragma unroll
                for (int j4 = 0; j4 < 16; ++j4) {
                    if (4 * j4 <= jlim) {
#pragma unroll
                        for (int e = 0; e < 4; ++e) key[4 * j4 + e] = __float_as_uint(row[64 * (4 * j4 + e)]);
                    } else {
#pragma unroll
                        for (int e = 0; e < 4; ++e) key[4 * j4 + e] = 0x7fffffffu;
                    }
                }
                unsigned t0 = 0u, t1 = 0u, t2 = 0u, t3 = 0u;
#pragma unroll
                for (int j4 = 0; j4 < 16; ++j4) {
                    if (4 * j4 <= jlim) {
#pragma unroll
                        for (int e = 0; e < 4; ++e) { const int j = 4 * j4 + e; const unsigned u = key[j];
                            const unsigned t = u ^ ((unsigned)((int)u >> 31) | 0x80000000u); const unsigned inval = (unsigned)((jmax - j) >> 31); const unsigned x = t & ~inval; key[j] = x;
                            unsigned n1, n2, n3;
                            asm("v_med3_u32 %0, %1, %2, %3" : "=v"(n3) : "v"(t2), "v"(t3), "v"(x));
                            asm("v_med3_u32 %0, %1, %2, %3" : "=v"(n2) : "v"(t1), "v"(t2), "v"(x));
                            asm("v_med3_u32 %0, %1, %2, %3" : "=v"(n1) : "v"(t0), "v"(t1), "v"(x));
                            t0 = t0 > x ? t0 : x; t1 = n1; t2 = n2; t3 = n3; }
                    } else {
#pragma unroll
                        for (int e = 0; e < 4; ++e) key[4 * j4 + e] = 0u;
                    }
                }
                unsigned L = wave_min_u_dpp(t3);
                L = L > 1u ? L : 1u;
                ITS_E(23); ITS_B();
                int need = 256;
                const unsigned d1 = radix_pass<24>(key, 0u, hist, lane, need, jlim, L);
                const unsigned d2 = radix_pass<16>(key, d1, hist, lane, need, jlim, L);
                const unsigned d3 = radix_pass<8>(key, (d1 << 8) | d2, hist, lane, need, jlim, L);
                const unsigned d4 = radix_pass<0>(key, (d1 << 16) | (d2 << 8) | d3, hist, lane, need, jlim, L);
                const unsigned prefix = (d1 << 24) | (d2 << 16) | (d3 << 8) | d4;
                ITS_E(24); ITS_B();
                int ceq = 0;
#pragma unroll
                for (int j = 0; j < 64; ++j) cnt_eq(ceq, key[j], prefix);
                ceq = (int)wave_sum_u_dpp((unsigned)ceq);
                int X = 4096;
                if (ceq != need) {
                    int X0 = 0;
#pragma unroll 1
                    for (int bit = 11; bit >= 0; --bit) {
                        const int c = X0 | (1 << bit);
                        int cnt = 0; const int crel = (c - lane + 63) >> 6;
#pragma unroll
                        for (int j = 0; j < 64; ++j) cnt_eq(cnt, (key[j] ^ prefix) | ~(unsigned)((j - crel) >> 31), 0u);
                        cnt = wave_sum_i(cnt);
                        if (cnt < need) X0 = c;
                    }
                    X = X0 + 1;
                }
                const int xrel = (X - lane + 63) >> 6;
#pragma unroll
                for (int j4 = 0; j4 < 16; ++j4) {
                    if (4 * j4 <= jlim) {
#pragma unroll
                        for (int e = 0; e < 4; ++e) { const int j = 4 * j4 + e;
                            const bool sel = (key[j] > prefix) || (key[j] == prefix && j < xrel);
                            const unsigned long long bm = __ballot(sel);
                            asm("v_writelane_b32 %0, %1, %2" : "+v"(wlo) : "s"((unsigned)bm), "n"(j));
                            asm("v_writelane_b32 %0, %1, %2" : "+v"(whi) : "s"((unsigned)(bm >> 32)), "n"(j)); }
                    }
                }
            } else {
#pragma unroll
                for (int j = 0; j < 32; ++j) { wlo |= (~(unsigned)((qrel - j) >> 31) & 1u) << j; whi |= (~(unsigned)((qrel - 32 - j) >> 31) & 1u) << j; }
            }
            ((uint2*)(mask + (size_t)(b * S_ + q) * 512))[lane] = make_uint2(wlo, whi);
            ITS_E(25); ITS_B();
        }
        ITS_E(21);
        if (tid == 0) qslot[0] = nticket;
        __syncthreads();
        ticket = qslot[0];
    }
}

constexpr int MG_P = 72;
constexpr int MG_TILE_BYTES = 128 * MG_P * 2;
__device__ void merge_fast_phase(int WV_, const bf16* P, const bf16* ys, const bf16* wbt  , bf16* merged, unsigned char* lds) {
    const int tid = LTID(WV_), lane = tid & 63, wave = tid >> 6, r32 = lane & 31, hi = lane >> 5, wt = wave & 3, wd = wave >> 2;
    const int srow0 = tid >> 3, sch = tid & 7;
    for (int tile = LBID(); tile < 1024; tile += LGRID()) {
        const int tok0 = (tile >> 3) * 128, d0 = (tile & 7) * 128;
        f32x16_t mer[2], acc[2];
#pragma unroll
        for (int r = 0; r < 16; ++r) { mer[0][r] = 0.f; mer[1][r] = 0.f; acc[0][r] = 0.f; acc[1][r] = 0.f; }
        uint4 RW00, RW01, RW10, RW11, RY00, RY01, RY10, RY11, RG0, RG1, RG2, RG3;
        bf16* gl = (bf16*)(lds + 4 * MG_TILE_BYTES);
        const int grow = tid >> 4, gch = tid & 15;
#define MG_GLOAD(st_, R_) do { const int n_ = (st_) >> 2, kc_ = (st_) & 3; \
            RW##R_##0 = *(const uint4*)(wbt + ((size_t)n_ * 1024 + d0 + srow0) * 256 + kc_ * 64 + sch * 8); \
            RW##R_##1 = *(const uint4*)(wbt + ((size_t)n_ * 1024 + d0 + srow0 + 64) * 256 + kc_ * 64 + sch * 8); \
            RY##R_##0 = *(const uint4*)(ys + (size_t)(tok0 + srow0) * 1024 + n_ * 256 + kc_ * 64 + sch * 8); \
            RY##R_##1 = *(const uint4*)(ys + (size_t)(tok0 + srow0 + 64) * 1024 + n_ * 256 + kc_ * 64 + sch * 8); } while (0)
#define MG_SSTORE(buf_, R_) do { bf16* wl_ = (bf16*)(lds + (buf_) * 2 * MG_TILE_BYTES); bf16* yl_ = (bf16*)(lds + (buf_) * 2 * MG_TILE_BYTES + MG_TILE_BYTES); \
            *(uint4*)(wl_ + srow0 * MG_P + sch * 8) = RW##R_##0; *(uint4*)(wl_ + (srow0 + 64) * MG_P + sch * 8) = RW##R_##1; \
            *(uint4*)(yl_ + srow0 * MG_P + sch * 8) = RY##R_##0; *(uint4*)(yl_ + (srow0 + 64) * MG_P + sch * 8) = RY##R_##1; } while (0)
        __syncthreads();
        MG_GLOAD(0, 0); MG_GLOAD(1, 1);
        MG_SSTORE(0, 0);
        __syncthreads();
#define MG_STAGE(PAR_, OTH_) do { const int buf = PAR_; \
            if (st + 2 < 16) MG_GLOAD(st + 2, PAR_); \
            if ((st & 3) == 1) { const bf16* gsrc = P + (size_t)(tok0 + grow) * NP + C_G + (st >> 2) * 1024 + d0 + gch * 8; \
                RG0 = *(const uint4*)gsrc; RG1 = *(const uint4*)(gsrc + (size_t)32 * NP); RG2 = *(const uint4*)(gsrc + (size_t)64 * NP); RG3 = *(const uint4*)(gsrc + (size_t)96 * NP); } \
            const bf16* wl = (const bf16*)(lds + buf * 2 * MG_TILE_BYTES); const bf16* yl = (const bf16*)(lds + buf * 2 * MG_TILE_BYTES + MG_TILE_BYTES); \
            _Pragma("unroll") for (int ks = 0; ks < 4; ++ks) { \
                const bf16x8_t bq = *(const bf16x8_t*)(yl + (32 * wt + r32) * MG_P + 16 * ks + 8 * hi); \
                const bf16x8_t a0 = *(const bf16x8_t*)(wl + (64 * wd + r32) * MG_P + 16 * ks + 8 * hi); \
                const bf16x8_t a1 = *(const bf16x8_t*)(wl + (64 * wd + 32 + r32) * MG_P + 16 * ks + 8 * hi); \
                acc[0] = __builtin_amdgcn_mfma_f32_32x32x16_bf16(a0, bq, acc[0], 0, 0, 0); \
                acc[1] = __builtin_amdgcn_mfma_f32_32x32x16_bf16(a1, bq, acc[1], 0, 0, 0); } \
            if ((st & 3) == 3) { \
                const int n = st >> 2; \
                const bf16* gp = gl + (32 * wt + r32) * 136 + 64 * wd + 4 * hi; (void)n; \
                _Pragma("unroll") for (int dt = 0; dt < 2; ++dt) \
                _Pragma("unroll") for (int g = 0; g < 4; ++g) { \
                        const uint2 gv = *(const uint2*)(gp + 32 * dt + 8 * g); \
                        const float g0 = __uint_as_float(gv.x << 16), g1 = __uint_as_float(gv.x & 0xffff0000u), g2 = __uint_as_float(gv.y << 16), g3 = __uint_as_float(gv.y & 0xffff0000u); \
                        mer[dt][4 * g + 0] += acc[dt][4 * g + 0] * g0; \
                        mer[dt][4 * g + 1] += acc[dt][4 * g + 1] * g1; \
                        mer[dt][4 * g + 2] += acc[dt][4 * g + 2] * g2; \
                        mer[dt][4 * g + 3] += acc[dt][4 * g + 3] * g3; } \
                _Pragma("unroll") for (int r = 0; r < 16; ++r) { acc[0][r] = 0.f; acc[1][r] = 0.f; } } \
            if (st + 1 < 16) MG_SSTORE(OTH_, OTH_); \
            if ((st & 3) == 2) { *(uint4*)(gl + grow * 136 + gch * 8) = RG0; *(uint4*)(gl + (grow + 32) * 136 + gch * 8) = RG1; *(uint4*)(gl + (grow + 64) * 136 + gch * 8) = RG2; *(uint4*)(gl + (grow + 96) * 136 + gch * 8) = RG3; } \
            __syncthreads(); } while (0)
#pragma unroll 1
        for (int st2 = 0; st2 < 16; st2 += 2) { { const int st = st2; MG_STAGE(0, 1); } { const int st = st2 + 1; MG_STAGE(1, 0); } }
#undef MG_STAGE
#undef MG_GLOAD
#undef MG_SSTORE
        bf16* mp = merged + (size_t)(tok0 + 32 * wt + r32) * 1024 + d0 + 64 * wd + 4 * hi;
#pragma unroll
        for (int dt = 0; dt < 2; ++dt)
#pragma unroll
            for (int g = 0; g < 4; ++g)
                *(uint2*)(mp + 32 * dt + 8 * g) = make_uint2(cvtpk(mer[dt][4 * g], mer[dt][4 * g + 1]), cvtpk(mer[dt][4 * g + 2], mer[dt][4 * g + 3]));
    }
}
#define LAS __attribute__((address_space(3)))
#define XB_TMO      128
#define XB_XCNT(j)  (256  + 64 * (j))
#define XB_XSUB(j)  (1280 + 64 * (j))
#define XB_XGEN(j)  (2304 + 64 * (j))
#define XB_TOP      3328
#define XB_TOPGEN   3392
#define XCD_BAR_WORDS 3456
#define XB_SPIN_CAP (1u << 18)

__device__ __forceinline__ unsigned xb_ld(unsigned* p)              { return __hip_atomic_load(p, __ATOMIC_RELAXED, __HIP_MEMORY_SCOPE_AGENT); }
__device__ __forceinline__ unsigned xb_add(unsigned* p, unsigned v) { return __hip_atomic_fetch_add(p, v, __ATOMIC_RELAXED, __HIP_MEMORY_SCOPE_AGENT); }
__device__ __forceinline__ unsigned xb_xcc_id() { return (unsigned)__builtin_amdgcn_s_getreg((3 << 11) | 20) & 0xFu; }
#define XB_SPIN(cond, bar) do { unsigned _sp = 0; while (cond) { __builtin_amdgcn_s_sleep(1); \
    if ((++_sp & 255u) == 0u) { if (xb_ld(&(bar)[XB_TMO])) break; if (_sp > XB_SPIN_CAP) { atomicAdd(&(bar)[XB_TMO], 1u); break; } } } } while (0)

struct XcdBarrier {
    unsigned* bar; unsigned x;
    volatile LAS unsigned* st;
};

__device__ __forceinline__ XcdBarrier xcd_barrier_post(unsigned* bar, volatile LAS unsigned* st) {
    XcdBarrier b; b.bar = bar; b.x = xb_xcc_id(); b.st = st;
    if (threadIdx.x == 0) (void)xb_add(&bar[XB_XCNT(b.x)], 1u);
    return b;
}
__device__ __forceinline__ void xcd_barrier_complete(unsigned* bar, unsigned x, unsigned& nloc, unsigned& nx) {
    const unsigned G = gridDim.x * gridDim.y * gridDim.z;
    unsigned sum, cnt, mine, sp = 0u;
    for (;;) {
        sum = 0u; cnt = 0u; mine = 0u;
#pragma unroll
        for (unsigned j = 0; j < 16; ++j) { const unsigned c = xb_ld(&bar[XB_XCNT(j)]); sum += c; cnt += (c > 0u) ? 1u : 0u; mine = (j == x) ? c : mine; }
        if (sum == G) break;
        __builtin_amdgcn_s_sleep(1);
        if ((++sp & 255u) == 0u) { if (xb_ld(&bar[XB_TMO])) break; if (sp > XB_SPIN_CAP) { atomicAdd(&bar[XB_TMO], 1u); break; } }
    }
    nloc = mine > 0u ? mine : 1u; nx = cnt > 0u ? cnt : 1u;
}

__device__ __forceinline__ void xcd_barrier(const XcdBarrier& b, int wv_) {
    asm volatile("s_waitcnt vmcnt(0)" ::: "memory");
    __syncthreads();
    if (wv_ == 0 && LANEID() == 0) {
        unsigned* bar = b.bar;
        __builtin_amdgcn_s_waitcnt(0);
        unsigned nloc = b.st[0], nx = b.st[1];
        if (nloc == 0u) { xcd_barrier_complete(bar, b.x, nloc, nx); b.st[0] = nloc; b.st[1] = nx; }
        const unsigned old = xb_add(&bar[XB_XSUB(b.x)], 1u);
        const unsigned gen = old / nloc;
        if (old + 1u == (gen + 1u) * nloc) {
            __builtin_amdgcn_fence(__ATOMIC_RELEASE, "agent");
            asm volatile("s_waitcnt vmcnt(0)" ::: "memory");
            const unsigned og = xb_add(&bar[XB_TOP], 1u);
            const unsigned tg = og / nx;
            if (og + 1u == (tg + 1u) * nx) xb_add(&bar[XB_TOPGEN], 1u);
            else XB_SPIN(xb_ld(&bar[XB_TOPGEN]) == tg, bar);
            __builtin_amdgcn_fence(__ATOMIC_ACQUIRE, "agent");
            xb_add(&bar[XB_XGEN(b.x)], 1u);
            asm volatile("s_waitcnt vmcnt(0)" ::: "memory");
        } else {
            XB_SPIN(xb_ld(&bar[XB_XGEN(b.x)]) == gen, bar);
            __builtin_amdgcn_fence(__ATOMIC_ACQUIRE, "agent");
            asm volatile("s_waitcnt vmcnt(0)" ::: "memory");
        }
    }
    __syncthreads();
}

enum { PH_PRO = 0, PH_GIN, PH_INDEX, PH_ATTN, PH_MERGE, PH_GOUT, PH_LN1, PH_GQ, PH_ROUTE, PH_PEER };
template <int PH> __device__ __forceinline__ void run_phase(int WV_, const Params& p_unused, int l, unsigned char* lds_raw) {
    size_t kaoff_ = 0; asm volatile("" : "+s"(kaoff_));
    typedef const __attribute__((address_space(4))) char* kaptr_t;
    const __attribute__((address_space(4))) Params& p = *(const __attribute__((address_space(4))) Params*)((kaptr_t)__builtin_amdgcn_kernarg_segment_ptr() + kaoff_);
    float* sm = (float*)lds_raw;
    size_t wsoff_ = 0; asm volatile("" : "+s"(wsoff_));
    unsigned char* ws = p.ws + wsoff_;
    float* hbuf = p.out;
    bf16* hb = (bf16*)(ws + WS_HB);
    bf16* P = (bf16*)(ws + WS_P);
    bf16* ys = (bf16*)(ws + WS_YS);
    bf16* mrg = (bf16*)(ws + WS_MRG);
    float* mix = (float*)(ws + WS_MIX);
    float* qb = (float*)(ws + WS_Q);
    unsigned char* mask = ws + WS_MASK;
    int* eid = (int*)(ws + WS_EID);
    float* gate = (float*)(ws + WS_GATE);
    float* kmean = (float*)(ws + WS_KMEAN);
    const float* hin = (l == 0) ? p.in[0] : hbuf;
    if (PH == PH_PRO) { Params pc; for (int i = 0; i < 13; ++i) pc.in[i] = p.in[i]; pc.out = p.out; pc.ws = ws;
        prologue_phase(WV_, pc, sm); convert_tables(WV_, pc);
        for (int i = LBID() * NTHR + LTID(WV_); i < DEPTH_ * 8 * 2 * 128 * 64 / 4; i += LGRID() * NTHR) { const float4 v = ((const float4*)p.in[8])[i]; ((uint2*)(ws + WS_SKB))[i] = make_uint2(pk2(v.x, v.y), pk2(v.z, v.w)); } if (LBID() < 2) build_unit_table((unsigned*)(ws + WS_CTL) + 1024, LBID() * NTHR + LTID(WV_)); }
    else if (PH == PH_GIN) {
        pg8::Gemm g{hb, (const bf16*)(ws + WS_WIN_T + l * WIN_T_BYTES), T_, NP, 1024};
        pg8::StaticOrder S; S.init(T_, NP, (int)LGRID(), (int)LBID());
        pg8::EpiBf16Sig E{P, NP, C_G};
        pg8::gemm_phase<pg8::EpiBf16Sig, pg8::StaticOrder, true, true>(WV_, (PG8_LAS unsigned char*)lds_raw, g, S, E);
    }
    else if (PH == PH_INDEX) index_fast_phase(WV_, P, mask, kmean, (float*)(ws + WS_YS), (unsigned*)(ws + WS_CTL) + 64 * l + 16, lds_raw);
    else if (PH == PH_ATTN) attn_fast_phase(WV_, P, mask, kmean, p.in[4] + l * 4, ys, (const unsigned*)(ws + WS_CTL) + 1024, (unsigned*)(ws + WS_CTL) + 64 * l, lds_raw);
    else if (PH == PH_MERGE) merge_fast_phase(WV_, P, ys, (const bf16*)(ws + WS_WBR_T) + (size_t)l * 4 * 1024 * 256, mrg, lds_raw);
    else if (PH == PH_GOUT) {
        pg8::Gemm g{mrg, (const bf16*)(ws + WS_WOUT_T) + (size_t)l * 1024 * 1024, T_, 1024, 1024};
        pg8::StaticOrder S; S.init(T_, 1024, (int)LGRID(), (int)LBID());
        pg8::EpiResY E{hin, hbuf, hb, (float*)(ws + WS_STATS) + (size_t)l * T_ * 2, ALPHA};
        pg8::gemm_phase<pg8::EpiResY, pg8::StaticOrder, true, true>(WV_, (PG8_LAS unsigned char*)lds_raw, g, S, E);
    }
    else if (PH == PH_GQ) {
        pg8::Gemm g{hb, (const bf16*)(ws + WS_WQ_T) + (size_t)l * 1024 * 1024, T_, 1024, 1024};
        pg8::StaticOrder S; S.init(T_, 1024, (int)LGRID(), (int)LBID());
        pg8::EpiLnFold E{(bf16*)qb, (const float*)(ws + WS_STATS) + (size_t)l * T_ * 2, (const float*)(ws + WS_COLS) + l * 2048, (const float*)(ws + WS_COLS) + l * 2048 + 1024, LN_EPS};
        pg8::gemm_phase<pg8::EpiLnFold, pg8::StaticOrder, true, true>(WV_, (PG8_LAS unsigned char*)lds_raw, g, S, E);
        pg8::Unit u0;
        if (LGRID() == 256 && S.next(0, u0)) {
            asm volatile("s_waitcnt vmcnt(0)" ::: "memory"); __syncthreads();
            route_fast_phase(WV_, (const bf16*)qb, (const bf16*)(ws + WS_SKB) + (size_t)l * 8 * 2 * 128 * 64, eid, gate, lds_raw, u0.pm, u0.pn);
        }
    }
    else if (PH == PH_ROUTE) { if (LGRID() != 256) route_fast_phase(WV_, (const bf16*)qb, (const bf16*)(ws + WS_SKB) + (size_t)l * 8 * 2 * 128 * 64, eid, gate, lds_raw); }
    else peer_fast_phase(WV_, hbuf, hb, eid, gate, ws + WS_UV + (size_t)l * 24 * MiB, p.in[5] + l * 1024, p.in[6] + l * 1024, p.in[11] + l * 1024, p.in[12] + l * 1024, lds_raw);
}

constexpr int CW_BAR = 4096;
constexpr int LDS_BARST = LDS_BYTES - 16;
__global__ void __launch_bounds__(NTHR, 2) mk_fwd(Params p) {
    extern __shared__ __attribute__((aligned(16))) unsigned char lds_raw[];
    cg::grid_group grid = cg::this_grid();
    const int WV_ = __builtin_amdgcn_readfirstlane((int)threadIdx.x >> 6);
    { volatile LAS unsigned* bst0 = (volatile LAS unsigned*)((LAS unsigned char*)lds_raw + LDS_BARST); if (threadIdx.x < 4) bst0[threadIdx.x] = 0u; }
    __syncthreads();
    volatile LAS unsigned* bst = (volatile LAS unsigned*)((LAS unsigned char*)lds_raw + LDS_BARST);
    { uint4* z = (uint4*)p.ws; const uint4 z4 = make_uint4(0u, 0u, 0u, 0u);
      for (unsigned i = (unsigned)LBID() * NTHR + (unsigned)LTID(WV_); i < (unsigned)(2 * MiB / 16); i += (unsigned)LGRID() * NTHR) z[i] = z4; }
    grid.sync();
    (void)xcd_barrier_post((unsigned*)(p.ws + WS_CTL) + CW_BAR, bst);
#define GRID_BAR() do { XcdBarrier b_; b_.bar = (unsigned*)(p.ws + WS_CTL) + CW_BAR; b_.x = xb_xcc_id(); b_.st = (volatile LAS unsigned*)((LAS unsigned char*)lds_raw + LDS_BARST); xcd_barrier(b_, WV_); } while (0)
    run_phase<PH_PRO>(WV_, p, 0, lds_raw);
    GRID_BAR();
#pragma unroll 1
    for (int l = 0; l < DEPTH_; ++l) {
        run_phase<PH_GIN>(WV_, p, l, lds_raw); GRID_BAR();
        run_phase<PH_INDEX>(WV_, p, l, lds_raw); GRID_BAR();
        run_phase<PH_ATTN>(WV_, p, l, lds_raw); GRID_BAR();
        run_phase<PH_MERGE>(WV_, p, l, lds_raw); GRID_BAR();
        run_phase<PH_GOUT>(WV_, p, l, lds_raw); GRID_BAR();
        run_phase<PH_GQ>(WV_, p, l, lds_raw); if (LGRID() != 256) { GRID_BAR(); run_phase<PH_ROUTE>(WV_, p, l, lds_raw); } GRID_BAR();
        run_phase<PH_PEER>(WV_, p, l, lds_raw); if (l + 1 < DEPTH_) GRID_BAR();
    }
}

extern "C" void kernel_launch(void* const* d_in, const int* in_sizes, int n_in, void* d_out, int out_size, void* d_ws, size_t ws_size, hipStream_t stream) {
    if (n_in != 13 || ws_size < WS_END) { fprintf(stderr, "kernel_launch: unexpected n_in %d / ws_size %zu; nothing launched\n", n_in, ws_size); return; }
    static int grid_blocks = 0;
    if (grid_blocks == 0) {
        int dev = 0, cus = 0, per_cu = 0;
        (void)hipGetDevice(&dev);
        (void)hipDeviceGetAttribute(&cus, hipDeviceAttributeMultiprocessorCount, dev);
        (void)hipFuncSetAttribute((const void*)mk_fwd, hipFuncAttributeMaxDynamicSharedMemorySize, LDS_BYTES);
        (void)hipOccupancyMaxActiveBlocksPerMultiprocessor(&per_cu, (const void*)mk_fwd, NTHR, LDS_BYTES);
        if (per_cu < 1) fprintf(stderr, "kernel_launch: occupancy query reports %d\n", per_cu);
        grid_blocks = cus;
    }
    Params p{};
    for (int i = 0; i < 13; ++i) p.in[i] = (const float*)d_in[i];
    p.out = (float*)d_out; p.ws = (unsigned char*)d_ws;
    void* args[] = {&p};
    hipError_t e = hipLaunchCooperativeKernel((const void*)mk_fwd, dim3(grid_blocks), dim3(NTHR), args, LDS_BYTES, stream);
    if (e != hipSuccess) fprintf(stderr, "cooperative launch failed: %s (grid %d)\n", hipGetErrorString(e), grid_blocks);
}
```

```cpp
#include <hip/hip_runtime.h>
#include <cstdio>
#include <cstdint>
#include <hip/hip_cooperative_groups.h>
namespace cg = cooperative_groups;

__device__ __forceinline__ int LANEID() { int l; asm volatile("v_mbcnt_lo_u32_b32 %0, -1, 0\n\tv_mbcnt_hi_u32_b32 %0, -1, %0" : "=v"(l)); return l; }
__device__ __forceinline__ int LTID(int wv) { return (wv << 6) | LANEID(); }
__device__ __forceinline__ int LBID() { int t = blockIdx.x; asm volatile("" : "+s"(t)); return t; }
__device__ __forceinline__ int LGRID() { int t = gridDim.x; asm volatile("" : "+s"(t)); return t; }
namespace pg8 {
#define PG8_LAS __attribute__((address_space(3)))
typedef unsigned short bf16_t;
typedef short bf16x8 __attribute__((ext_vector_type(8)));
typedef float f32x4 __attribute__((ext_vector_type(4)));
typedef unsigned u32x4 __attribute__((ext_vector_type(4)));
constexpr int BM = 256, BK = 64, HALF = 128, HTB = HALF * BK * 2  , STAGE_BYTES = 8 * HTB, NXCD = 8, WGM = 8;

__host__ __device__ __forceinline__ int lds_byte(int r, int c) { const int st = (r >> 4) * 2 + (c >> 5), rr = r & 15, cc = c & 31, ob = rr * 64 + cc * 2; return st * 1024 + (ob ^ (((ob >> 9) & 1) << 5)); }
__host__ __device__ __forceinline__ void stage_rc(int b, int& R, int& C) { const int st = b / 1024, sb = b % 1024, swz = sb ^ (((sb >> 9) & 1) << 5); R = (st >> 1) * 16 + swz / 64; C = (st & 1) * 32 + (swz % 64) / 2; }
__host__ __device__ __forceinline__ int perm32(int rho) { const int n = rho >> 4, i = rho & 15; return 8 * (i >> 2) + 4 * n + (i & 3); }

struct Unit { int pm, pn; };
struct Gemm { const bf16_t* A; const bf16_t* Bt; int M, N, K; };

struct StaticOrder {
    int nM, nN, nwg, G, c;
    __host__ __device__ void init(int M, int N, int G_, int c_) { nM = M / BM; nN = N / BM; nwg = nM * nN; G = G_; c = c_; }
    __host__ __device__ bool next(int i, Unit& u) const {
        const long L = (long)i * G + c; if (L >= nwg) return false;
        int wgid = (int)L; { const int q = nwg / NXCD, r = nwg % NXCD, xcd = wgid % NXCD, off = wgid / NXCD; wgid = (xcd < r ? xcd * (q + 1) : r * (q + 1) + (xcd - r) * q) + off; }
        const int nig = WGM * nN, gid = wgid / nig, fm = gid * WGM, gsz = (nM - fm) < WGM ? (nM - fm) : WGM;
        u.pm = fm + ((wgid % nig) % gsz); u.pn = (wgid % nig) / gsz; return true;
    }
    __device__ __forceinline__ void a_ready(const Unit&) const {}
    __device__ __forceinline__ void done(const Unit&) const {}
};

__device__ __forceinline__ unsigned cvt_pk_bf16(float lo, float hi) { unsigned r; asm volatile("v_cvt_pk_bf16_f32 %0, %1, %2" : "=v"(r) : "v"(lo), "v"(hi)); return r; }
typedef float f32x2 __attribute__((ext_vector_type(2)));
__device__ __forceinline__ f32x2 gelu_pk(f32x2 v) {
    const f32x2 av = __builtin_elementwise_abs(v), d = av * 0.2316418882f + 1.0f;
    f32x2 t; t.x = __builtin_amdgcn_rcpf(d.x); t.y = __builtin_amdgcn_rcpf(d.y);
    f32x2 q = t * 0.5307027145f + (-0.7265760135f); q = q * t + 0.7107068705f; q = q * t + (-0.142248368f); q = q * t + 0.127414796f; q = q * t;
    const f32x2 s = (v * v) * (-0.72134752044f);
    f32x2 e; e.x = __builtin_amdgcn_exp2f(s.x); e.y = __builtin_amdgcn_exp2f(s.y);
    const f32x2 m = v * (q * e), r = v - m;
    f32x2 o; o.x = v.x < 0.f ? m.x : r.x; o.y = v.y < 0.f ? m.y : r.y; return o;
}

template <int ACT  > struct EpiBf16 {
    static constexpr bool PERM = true, AFTER_DRAIN = false; static_assert(ACT == 0 || ACT == 1, "EpiBf16: ACT is 0 (none) or 1 (gelu_pk)");
    bf16_t* O; int ldc; const float* bias; int split_cols; size_t split_stride; float scale0;
    __device__ __forceinline__ void operator()(const f32x4 (&acc)[2][2][4][2], const Unit& u, int wr, int wc, int fr, int fq) const {
        { int ln_ = LANEID(); asm volatile("" : "+v"(ln_)); fr = ln_ & 15; fq = ln_ >> 4; }
        const int row0 = u.pm * BM + wr * 64 + fr; int colt = u.pn * BM; bf16_t* base = O;
        float sc = 1.f; if (split_cols) { const int t = colt / split_cols; base += (size_t)t * split_stride; colt -= t * split_cols; if (t == 0) sc = scale0; }
        const int col0 = colt + wc * 32 + 8 * fq, bcol0 = u.pn * BM + wc * 32 + 8 * fq;
        f32x4 bv[2][2];
#pragma unroll
        for (int bj = 0; bj < 2; ++bj)
#pragma unroll
            for (int n = 0; n < 2; ++n) bv[bj][n] = bias ? *(const f32x4*)(bias + bcol0 + bj * HALF + 4 * n) : (f32x4){0.f, 0.f, 0.f, 0.f};
#pragma unroll
        for (int ai = 0; ai < 2; ++ai)
#pragma unroll
            for (int m = 0; m < 4; ++m) { bf16_t* rowp = base + (size_t)(row0 + ai * HALF + m * 16) * ldc + col0;
#pragma unroll
                for (int bj = 0; bj < 2; ++bj) { f32x4 v0 = acc[ai][bj][m][0] + bv[bj][0], v1 = acc[ai][bj][m][1] + bv[bj][1];
                    if (ACT == 1) { f32x2 a = gelu_pk((f32x2){v0[0], v0[1]}), b = gelu_pk((f32x2){v0[2], v0[3]}), c = gelu_pk((f32x2){v1[0], v1[1]}), d = gelu_pk((f32x2){v1[2], v1[3]});
                        v0 = (f32x4){a.x, a.y, b.x, b.y}; v1 = (f32x4){c.x, c.y, d.x, d.y}; }
                    v0 = v0 * sc; v1 = v1 * sc; u32x4 w; w.x = cvt_pk_bf16(v0[0], v0[1]); w.y = cvt_pk_bf16(v0[2], v0[3]); w.z = cvt_pk_bf16(v1[0], v1[1]); w.w = cvt_pk_bf16(v1[2], v1[3]);
                    *(u32x4*)(rowp + bj * HALF) = w; } }
    }
};
template <class Epi, class Sched, bool ALIGN_EPI = false, bool SP2 = false>
__device__ __forceinline__ void gemm_phase(int WV_, PG8_LAS unsigned char* lds, const Gemm g, const Sched& S, const Epi& E) {
    const int tid = LTID(WV_), wid = __builtin_amdgcn_readfirstlane(tid >> 6), lane = tid & 63, wr = wid >> 2, wc = wid & 3, fr = lane & 15, fq = lane >> 4;
    const int K = g.K, nt = K / BK;
    unsigned voffA[2], voffB[2];
#pragma unroll
    for (int i = 0; i < 2; ++i) { int R, C; stage_rc(tid * 16 + i * 8192, R, C); const int Rb = Epi::PERM ? ((R & ~31) + perm32(R & 31)) : R;
        voffA[i] = (unsigned)(R * K + C) * 2u; voffB[i] = (unsigned)(Rb * K + C) * 2u; }
    const size_t kstep = (size_t)(BK * 2);
    const size_t hstep = (size_t)HALF * K * 2;
    const size_t tstep = 2 * hstep;
    const unsigned ldsw = (unsigned)wid * 1024u;
    const int aoff = lds_byte(wr * 64 + fr, fq * 8), boff = lds_byte(wc * 32 + fr, fq * 8);
#define PG8_SA(b, h) (((b) * 2 + (h)) * HTB)
#define PG8_SB(b, h) ((4 + (b) * 2 + (h)) * HTB)
#define PG8_STAGE(bufoff, gbase, voff) do { _Pragma("unroll") for (int _i = 0; _i < 2; ++_i) \
        __builtin_amdgcn_global_load_lds((const unsigned*)((const char*)(gbase) + (voff)[_i]), (PG8_LAS unsigned*)(lds + (bufoff) + ldsw + _i * 8192), 16, 0, 0); } while (0)
#define PG8_LDA(dst, b, h) do { _Pragma("unroll") for (int m = 0; m < 4; ++m) _Pragma("unroll") for (int k = 0; k < 2; ++k) dst[m][k] = *(const PG8_LAS bf16x8*)(lds + PG8_SA(b, h) + aoff + m * 2048 + k * 1024); } while (0)
#define PG8_LDB(dst, b, h) do { _Pragma("unroll") for (int n = 0; n < 2; ++n) _Pragma("unroll") for (int k = 0; k < 2; ++k) dst[n][k] = *(const PG8_LAS bf16x8*)(lds + PG8_SB(b, h) + boff + n * 2048 + k * 1024); } while (0)
#define PG8_MMA(ai, bj, At, Bt) do { __builtin_amdgcn_s_setprio(1); _Pragma("unroll") for (int m = 0; m < 4; ++m) _Pragma("unroll") for (int n = 0; n < 2; ++n) _Pragma("unroll") for (int k = 0; k < 2; ++k) \
        acc[ai][bj][m][n] = __builtin_amdgcn_mfma_f32_16x16x32_bf16(Bt[n][k], At[m][k], acc[ai][bj][m][n], 0, 0, 0); __builtin_amdgcn_s_setprio(0); } while (0)
#define PG8_WAIT_V(n) asm volatile("s_waitcnt vmcnt(" #n ")" ::: "memory")
#define PG8_WAIT_L(n) asm volatile("s_waitcnt lgkmcnt(" #n ")" ::: "memory")
#define PG8_BAR __builtin_amdgcn_s_barrier()
#define PG8_SCHED __builtin_amdgcn_sched_barrier(0)
    Unit cur, nxt; int ui = 0;
    if (!S.next(0, cur)) return;
    f32x4 acc[2][2][4][2];
#pragma unroll
    for (int a = 0; a < 2; ++a)
#pragma unroll
        for (int b = 0; b < 2; ++b)
#pragma unroll
            for (int m = 0; m < 4; ++m)
#pragma unroll
                for (int n = 0; n < 2; ++n) acc[a][b][m][n] = (f32x4){0.f, 0.f, 0.f, 0.f};
    bf16x8 At[4][2], B0[2][2], B1[2][2];
    const char* cA = (const char*)g.A + (size_t)cur.pm * tstep; const char* cB = (const char*)g.Bt + (size_t)cur.pn * tstep;
    S.a_ready(cur);
    if constexpr (SP2) {
        PG8_STAGE(PG8_SB(0, 0), cB, voffB); PG8_STAGE(PG8_SB(0, 1), cB + hstep, voffB); PG8_STAGE(PG8_SA(0, 0), cA, voffA); PG8_STAGE(PG8_SA(0, 1), cA + hstep, voffA);
        if (wr == 1) PG8_BAR;
        PG8_WAIT_V(2); PG8_BAR;
        PG8_STAGE(PG8_SB(1, 0), cB + kstep, voffB); PG8_STAGE(PG8_SA(1, 0), cA + kstep, voffA); PG8_STAGE(PG8_SB(1, 1), cB + hstep + kstep, voffB);
        PG8_WAIT_V(6); PG8_BAR;
    } else {
        PG8_STAGE(PG8_SB(0, 0), cB, voffB); PG8_STAGE(PG8_SA(0, 0), cA, voffA); PG8_STAGE(PG8_SB(0, 1), cB + hstep, voffB); PG8_STAGE(PG8_SA(0, 1), cA + hstep, voffA);
        if (wr == 1) PG8_BAR;
        PG8_WAIT_V(4); PG8_BAR;
        PG8_STAGE(PG8_SB(1, 0), cB + kstep, voffB); PG8_STAGE(PG8_SA(1, 0), cA + kstep, voffA); PG8_STAGE(PG8_SB(1, 1), cB + hstep + kstep, voffB);
        PG8_WAIT_V(6); PG8_BAR;
    }
    for (;;) {
        const bool has_next = S.next(ui + 1, nxt);
        const char* nA = has_next ? (const char*)g.A + (size_t)nxt.pm * tstep : cA; const char* nB = has_next ? (const char*)g.Bt + (size_t)nxt.pn * tstep : cB;
        for (int t = 0; t < nt; t += 2) {
            const bool last = (t == nt - 2);
            const char* a1 = cA + (size_t)(t + 1) * kstep;
            const char* a2 = last ? nA : cA + (size_t)(t + 2) * kstep; const char* b2 = last ? nB : cB + (size_t)(t + 2) * kstep;
            const char* a3 = a2 + kstep; const char* b3 = b2 + kstep;
            if (last && has_next) S.a_ready(nxt);
            if constexpr (SP2) {
            PG8_LDB(B0, 0, 0); PG8_LDB(B1, 0, 1); PG8_SCHED; PG8_LDA(At, 0, 0); PG8_STAGE(PG8_SA(1, 1), a1 + hstep, voffA);
            PG8_WAIT_V(8); PG8_WAIT_L(0); PG8_BAR; PG8_MMA(0, 0, At, B0); PG8_MMA(0, 1, At, B1); PG8_BAR; PG8_SCHED;
            PG8_LDA(At, 0, 1); PG8_STAGE(PG8_SB(0, 0), b2, voffB); PG8_STAGE(PG8_SB(0, 1), b2 + hstep, voffB); PG8_STAGE(PG8_SA(0, 0), a2, voffA);
            PG8_WAIT_V(8); PG8_WAIT_L(0); PG8_BAR; PG8_MMA(1, 0, At, B0); PG8_MMA(1, 1, At, B1); PG8_BAR; PG8_SCHED;
            PG8_LDB(B0, 1, 0); PG8_LDB(B1, 1, 1); PG8_SCHED; PG8_LDA(At, 1, 0); PG8_STAGE(PG8_SA(0, 1), a2 + hstep, voffA);
            PG8_WAIT_V(8); PG8_WAIT_L(0); PG8_BAR; PG8_MMA(0, 0, At, B0); PG8_MMA(0, 1, At, B1); PG8_BAR; PG8_SCHED;
            PG8_LDA(At, 1, 1); PG8_STAGE(PG8_SB(1, 0), b3, voffB); PG8_STAGE(PG8_SB(1, 1), b3 + hstep, voffB); PG8_STAGE(PG8_SA(1, 0), a3, voffA);
            PG8_WAIT_V(8); PG8_WAIT_L(0); PG8_BAR; PG8_MMA(1, 0, At, B0); PG8_MMA(1, 1, At, B1); PG8_BAR; PG8_SCHED;
            } else {
            PG8_LDB(B0, 0, 0); PG8_SCHED; PG8_LDA(At, 0, 0); PG8_STAGE(PG8_SA(1, 1), a1 + hstep, voffA);
            PG8_WAIT_L(8); PG8_BAR; PG8_WAIT_L(0); PG8_MMA(0, 0, At, B0); PG8_BAR; PG8_SCHED;
            PG8_LDB(B1, 0, 1); PG8_STAGE(PG8_SB(0, 0), b2, voffB);
            PG8_BAR; PG8_WAIT_L(0); PG8_MMA(0, 1, At, B1); PG8_BAR;
            PG8_LDA(At, 0, 1); PG8_STAGE(PG8_SA(0, 0), a2, voffA);
            PG8_BAR; PG8_WAIT_L(0); PG8_MMA(1, 0, At, B0); PG8_BAR; PG8_SCHED;
            PG8_STAGE(PG8_SB(0, 1), b2 + hstep, voffB);
            PG8_WAIT_V(6); PG8_BAR; PG8_MMA(1, 1, At, B1); PG8_BAR;
            PG8_LDB(B0, 1, 0); PG8_SCHED; PG8_LDA(At, 1, 0); PG8_STAGE(PG8_SA(0, 1), a2 + hstep, voffA);
            PG8_WAIT_L(8); PG8_BAR; PG8_WAIT_L(0); PG8_MMA(0, 0, At, B0); PG8_BAR; PG8_SCHED;
            PG8_LDB(B1, 1, 1); PG8_STAGE(PG8_SB(1, 0), b3, voffB);
            PG8_BAR; PG8_WAIT_L(0); PG8_MMA(0, 1, At, B1); PG8_BAR;
            PG8_LDA(At, 1, 1); PG8_STAGE(PG8_SA(1, 0), a3, voffA);
            PG8_BAR; PG8_WAIT_L(0); PG8_MMA(1, 0, At, B0); PG8_BAR; PG8_SCHED;
            PG8_STAGE(PG8_SB(1, 1), b3 + hstep, voffB);
            PG8_WAIT_V(6); PG8_BAR; PG8_MMA(1, 1, At, B1); PG8_BAR;
            }
        }
        if constexpr (ALIGN_EPI) { if (wr == 0) PG8_BAR; }
        if constexpr (!Epi::AFTER_DRAIN) { E(acc, cur, wr, wc, fr, fq); S.done(cur); }
        if (!has_next) break;
#pragma unroll
        for (int a = 0; a < 2; ++a)
#pragma unroll
            for (int b = 0; b < 2; ++b)
#pragma unroll
                for (int m = 0; m < 4; ++m)
#pragma unroll
                    for (int n = 0; n < 2; ++n) acc[a][b][m][n] = (f32x4){0.f, 0.f, 0.f, 0.f};
        cur = nxt; cA = nA; cB = nB; ++ui;
        if constexpr (ALIGN_EPI) { if (wr == 1) PG8_BAR; }
    }
    PG8_WAIT_V(0);
    if constexpr (!ALIGN_EPI) { if (wr == 0) PG8_BAR; }
    PG8_BAR;
    if constexpr (Epi::AFTER_DRAIN) { E.fused(acc, cur, wr, wc, fr, fq, lds, wid, lane); S.done(cur); }
#undef PG8_SA
#undef PG8_SB
#undef PG8_STAGE
#undef PG8_LDA
#undef PG8_LDB
#undef PG8_MMA
#undef PG8_WAIT_V
#undef PG8_WAIT_L
#undef PG8_BAR
#undef PG8_SCHED
}
}
namespace pg8 {
struct EpiF32 {
    static constexpr bool PERM = false, AFTER_DRAIN = false;
    float* O; int ldc;
    __device__ __forceinline__ void operator()(const f32x4 (&acc)[2][2][4][2], const Unit& u, int wr, int wc, int fr, int fq) const {
        { int ln_ = LANEID(); asm volatile("" : "+v"(ln_)); fr = ln_ & 15; fq = ln_ >> 4; }
        const int row0 = u.pm * BM + wr * 64 + fr, col0 = u.pn * BM + wc * 32 + 4 * fq;
#pragma unroll
        for (int ai = 0; ai < 2; ++ai)
#pragma unroll
            for (int m = 0; m < 4; ++m) { float* rowp = O + (size_t)(row0 + ai * HALF + m * 16) * ldc + col0;
#pragma unroll
                for (int bj = 0; bj < 2; ++bj)
#pragma unroll
                    for (int n = 0; n < 2; ++n) *(f32x4*)(rowp + bj * HALF + n * 16) = acc[ai][bj][m][n]; }
    }
};
struct EpiResY {
    static constexpr bool PERM = false, AFTER_DRAIN = false;
    const float* hin; float* yout; bf16_t* yb; float* stats; float alpha;
    __device__ __forceinline__ void operator()(const f32x4 (&acc)[2][2][4][2], const Unit& u, int wr, int wc, int fr, int fq) const {
        { int ln_ = LANEID(); asm volatile("" : "+v"(ln_)); fr = ln_ & 15; fq = ln_ >> 4; }
        const int row0 = u.pm * BM + wr * 64 + fr, col0 = u.pn * BM + wc * 32 + 4 * fq;
#pragma unroll
        for (int ai = 0; ai < 2; ++ai)
#pragma unroll
            for (int m = 0; m < 4; ++m) {
                const int row = row0 + ai * HALF + m * 16;
                float s = 0.f, s2 = 0.f;
#pragma unroll
                for (int bj = 0; bj < 2; ++bj)
#pragma unroll
                    for (int n = 0; n < 2; ++n) {
                        const size_t off = (size_t)row * 1024 + col0 + bj * HALF + n * 16;
                        const f32x4 hv = *(const f32x4*)(hin + off);
                        const f32x4 y = hv * alpha + acc[ai][bj][m][n];
                        *(f32x4*)(yout + off) = y;
                        typedef unsigned u32x2v __attribute__((ext_vector_type(2)));
                        u32x2v w; w.x = cvt_pk_bf16(y[0], y[1]); w.y = cvt_pk_bf16(y[2], y[3]);
                        *(u32x2v*)(yb + off) = w;
                        s += (y[0] + y[1]) + (y[2] + y[3]); s2 += (y[0] * y[0] + y[1] * y[1]) + (y[2] * y[2] + y[3] * y[3]);
                    }
                s += __shfl_xor(s, 16); s += __shfl_xor(s, 32); s2 += __shfl_xor(s2, 16); s2 += __shfl_xor(s2, 32);
                if (fq == 0) { atomicAdd(stats + 2 * (size_t)row, s); atomicAdd(stats + 2 * (size_t)row + 1, s2); }
            }
    }
};
struct EpiLnFold {
    static constexpr bool PERM = true, AFTER_DRAIN = false;
    bf16_t* O; const float* stats; const float* colsum; const float* colbias; float eps;
    __device__ __forceinline__ void operator()(const f32x4 (&acc)[2][2][4][2], const Unit& u, int wr, int wc, int fr, int fq) const {
        { int ln_ = LANEID(); asm volatile("" : "+v"(ln_)); fr = ln_ & 15; fq = ln_ >> 4; }
        const int row0 = u.pm * BM + wr * 64 + fr, col0 = u.pn * BM + wc * 32 + 8 * fq;
        f32x4 cs[2][2], cb[2][2];
#pragma unroll
        for (int bj = 0; bj < 2; ++bj)
#pragma unroll
            for (int n = 0; n < 2; ++n) { cs[bj][n] = *(const f32x4*)(colsum + col0 + bj * HALF + 4 * n); cb[bj][n] = *(const f32x4*)(colbias + col0 + bj * HALF + 4 * n); }
#pragma unroll
        for (int ai = 0; ai < 2; ++ai)
#pragma unroll
            for (int m = 0; m < 4; ++m) {
                const int row = row0 + ai * HALF + m * 16;
                const float sm_ = stats[2 * (size_t)row], sq_ = stats[2 * (size_t)row + 1];
                const float mean = sm_ * (1.0f / 1024.0f);
                const float rstd = 1.0f / sqrtf(fmaxf(sq_ * (1.0f / 1024.0f) - mean * mean, 0.f) + eps);
                bf16_t* rowp = O + (size_t)row * 1024 + col0;
#pragma unroll
                for (int bj = 0; bj < 2; ++bj) {
                    const f32x4 v0 = (acc[ai][bj][m][0] - cs[bj][0] * mean) * rstd + cb[bj][0], v1 = (acc[ai][bj][m][1] - cs[bj][1] * mean) * rstd + cb[bj][1];
                    u32x4 w; w.x = cvt_pk_bf16(v0[0], v0[1]); w.y = cvt_pk_bf16(v0[2], v0[3]); w.z = cvt_pk_bf16(v1[0], v1[1]); w.w = cvt_pk_bf16(v1[2], v1[3]);
                    *(u32x4*)(rowp + bj * HALF) = w;
                }
            }
    }
};
__device__ __forceinline__ unsigned cvt_pk_bf16_t(float lo, float hi) { unsigned r; asm volatile("s_nop 0\n\tv_cvt_pk_bf16_f32 %0, %1, %2" : "=v"(r) : "v"(lo), "v"(hi)); return r; }
struct EpiBf16Sig {
    static constexpr bool PERM = true, AFTER_DRAIN = false;
    bf16_t* O; int ldc; int sig_col0;
    __device__ __forceinline__ void operator()(const f32x4 (&acc)[2][2][4][2], const Unit& u, int wr, int wc, int fr, int fq) const {
        { int ln_ = LANEID(); asm volatile("" : "+v"(ln_)); fr = ln_ & 15; fq = ln_ >> 4; }
        const int row0 = u.pm * BM + wr * 64 + fr; const int col0 = u.pn * BM + wc * 32 + 8 * fq;
#pragma unroll
        for (int bj = 0; bj < 2; ++bj) {
            if (col0 + bj * HALF >= sig_col0) {
#pragma unroll
                for (int ai = 0; ai < 2; ++ai)
#pragma unroll
                    for (int m = 0; m < 4; ++m) { bf16_t* rowp = O + (size_t)(row0 + ai * HALF + m * 16) * ldc + col0;
                        f32x4 v0 = acc[ai][bj][m][0], v1 = acc[ai][bj][m][1];
#pragma unroll
                        for (int e = 0; e < 4; ++e) { v0[e] = __builtin_amdgcn_rcpf(1.f + __builtin_amdgcn_exp2f(-1.44269504f * v0[e])); v1[e] = __builtin_amdgcn_rcpf(1.f + __builtin_amdgcn_exp2f(-1.44269504f * v1[e])); }
                        u32x4 w; w.x = cvt_pk_bf16_t(v0[0], v0[1]); w.y = cvt_pk_bf16_t(v0[2], v0[3]); w.z = cvt_pk_bf16_t(v1[0], v1[1]); w.w = cvt_pk_bf16_t(v1[2], v1[3]);
                        *(u32x4*)(rowp + bj * HALF) = w; }
            } else {
#pragma unroll
                for (int ai = 0; ai < 2; ++ai)
#pragma unroll
                    for (int m = 0; m < 4; ++m) { bf16_t* rowp = O + (size_t)(row0 + ai * HALF + m * 16) * ldc + col0;
                        const f32x4 v0 = acc[ai][bj][m][0], v1 = acc[ai][bj][m][1];
                        u32x4 w; w.x = cvt_pk_bf16(v0[0], v0[1]); w.y = cvt_pk_bf16(v0[2], v0[3]); w.z = cvt_pk_bf16(v1[0], v1[1]); w.w = cvt_pk_bf16(v1[2], v1[3]);
                        *(u32x4*)(rowp + bj * HALF) = w; }
            }
        }
    }
};
}

typedef unsigned short bf16;
constexpr int T_ = 16384, S_ = 4096, NBATCH = 4, D_ = 1024, NCOL = 6824, NP = 6912, DEPTH_ = 2;
constexpr int C_QA = 0, C_KA = 256, C_VA = 320, C_QI = 384, C_KI = 640, C_WI = 672, C_QB = 680, C_KB = 936, C_VB = 1064,
              C_QC = 1192, C_KC = 1448, C_VC = 1704, C_QD = 1960, C_KD = 2216, C_VD = 2472, C_G = 2728;
constexpr int NTHR = 512, NWAVE = 8;
constexpr float ALPHA = 1.41421356237309515f;
constexpr float LN_EPS = 1e-5f;
constexpr size_t MiB = 1u << 20;
constexpr size_t WS_STATS = 1 * MiB  , WS_COLS = 1 * MiB + 512 * 1024  ;
constexpr size_t WS_CTL = 0, WS_WIN_T = 2 * MiB, WS_WOUT_T = 30 * MiB, WS_WQ_T = 34 * MiB, WS_WBR_T = 38 * MiB, WS_HB = 42 * MiB,
                 WS_P = 74 * MiB, WS_MIX = 74 * MiB  , WS_Q = 138 * MiB  , WS_YS = 290 * MiB, WS_MRG = 322 * MiB,
                 WS_MASK = 354 * MiB, WS_EID = 362 * MiB, WS_GATE = 370 * MiB, WS_KMEAN = 378 * MiB, WS_SKB = 379 * MiB, WS_UV = 380 * MiB, WS_END = 508 * MiB;
constexpr size_t WIN_T_BYTES = (size_t)NP * 1024 * 2;
constexpr int LDS_BYTES = 144 * 1024;

struct Params { const float* in[13]; float* out; unsigned char* ws; };

__device__ __forceinline__ float bf2f(bf16 v) { return __uint_as_float((unsigned)v << 16); }
__device__ __forceinline__ unsigned f2bf(float f) { unsigned u = __float_as_uint(f); return (u + 0x7fffu + ((u >> 16) & 1u)) >> 16; }
__device__ __forceinline__ unsigned pk2(float lo, float hi) { return f2bf(lo) | (f2bf(hi) << 16); }
__device__ __forceinline__ void unpack8(const uint4 v, float* o) {
    o[0] = __uint_as_float(v.x << 16); o[1] = __uint_as_float(v.x & 0xffff0000u); o[2] = __uint_as_float(v.y << 16); o[3] = __uint_as_float(v.y & 0xffff0000u);
    o[4] = __uint_as_float(v.z << 16); o[5] = __uint_as_float(v.z & 0xffff0000u); o[6] = __uint_as_float(v.w << 16); o[7] = __uint_as_float(v.w & 0xffff0000u);
}
__device__ __forceinline__ float wave_sum(float v) {
#pragma unroll
    for (int o = 32; o > 0; o >>= 1) v += __shfl_xor(v, o);
    return v;
}
__device__ __forceinline__ float wave_max(float v) {
#pragma unroll
    for (int o = 32; o > 0; o >>= 1) v = fmaxf(v, __shfl_xor(v, o));
    return v;
}
__device__ __forceinline__ int wave_sum_i(int v) {
#pragma unroll
    for (int o = 32; o > 0; o >>= 1) v += __shfl_xor(v, o);
    return v;
}
__device__ __forceinline__ float logsig(float x) { return fminf(x, 0.f) - log1pf(expf(-fabsf(x))); }

__device__ void transpose_items(int WV_, const float* W, int K, int N, bf16* WT, float* sm, int item0, int nitems_total, int item_stride,
                                const float* rs_g = nullptr, const float* rs_b = nullptr, float* colsum = nullptr, float* colbias = nullptr) {
    const int tid = LTID(WV_);
    const int nkb = K / 64, nnb = (N + 63) / 64;
    for (int it = item0; it < nkb * nnb; it += item_stride) {
        const int kb = it % nkb, nb = it / nkb, k0 = kb * 64, n0 = nb * 64;
        __syncthreads();
        for (int e = tid; e < 64 * 64; e += NTHR) { const int kk = e >> 6, nn = e & 63; sm[kk * 65 + nn] = (n0 + nn < N) ? W[(size_t)(k0 + kk) * N + n0 + nn] : 0.f; }
        __syncthreads();
        if (rs_g) {
            if (tid < 64) { float cs = 0.f, cb = 0.f;
                for (int kk = 0; kk < 64; ++kk) { const float w = sm[kk * 65 + tid]; cs += w * rs_g[k0 + kk]; cb += w * rs_b[k0 + kk]; }
                atomicAdd(colsum + n0 + tid, cs); atomicAdd(colbias + n0 + tid, cb); }
            __syncthreads();
            for (int e = tid; e < 64 * 64; e += NTHR) { const int kk = e >> 6, nn = e & 63; sm[kk * 65 + nn] *= rs_g[k0 + kk]; }
            __syncthreads();
        }
        { const int nn = tid >> 3, c = tid & 7;
          if (n0 + nn < N) { uint4 o; o.x = pk2(sm[(8 * c + 0) * 65 + nn], sm[(8 * c + 1) * 65 + nn]); o.y = pk2(sm[(8 * c + 2) * 65 + nn], sm[(8 * c + 3) * 65 + nn]);
              o.z = pk2(sm[(8 * c + 4) * 65 + nn], sm[(8 * c + 5) * 65 + nn]); o.w = pk2(sm[(8 * c + 6) * 65 + nn], sm[(8 * c + 7) * 65 + nn]);
              *(uint4*)(WT + (size_t)(n0 + nn) * K + k0 + 8 * c) = o; } }
    }
    __syncthreads();
}
constexpr int TI_WIN = 16 * ((NCOL + 63) / 64), TI_SQ = 256, TI_LAYER = TI_WIN + 3 * TI_SQ;
#define TITEM_DECODE(it_, W_, WT_, K_, N_, k0_, n0_, fold_, l_) do { \
        l_ = (it_) / TI_LAYER; const int r_ = (it_) - l_ * TI_LAYER; \
        const int kind_ = r_ < TI_WIN ? 0 : (r_ < TI_WIN + TI_SQ ? 1 : (r_ < TI_WIN + 2 * TI_SQ ? 2 : 3)); \
        const int q_ = r_ - (kind_ == 0 ? 0 : TI_WIN + (kind_ - 1) * TI_SQ); \
        fold_ = kind_ == 2; K_ = kind_ == 3 ? 256 : 1024; N_ = kind_ == 0 ? NCOL : 1024; \
        k0_ = kind_ == 3 ? (q_ & 3) * 64 : (q_ & 15) * 64; n0_ = kind_ == 3 ? ((q_ & 63) >> 2) * 64 : (q_ >> 4) * 64; \
        const int nbr_ = q_ >> 6; \
        W_ = kind_ == 0 ? pin1 + (size_t)l_ * 1024 * NCOL : kind_ == 1 ? pin3 + (size_t)l_ * 1024 * 1024 : kind_ == 2 ? pin7 + (size_t)l_ * 1024 * 1024 : pin2 + ((size_t)l_ * 4 + nbr_) * 256 * 1024; \
        WT_ = kind_ == 0 ? (bf16*)(ws + WS_WIN_T + l_ * WIN_T_BYTES) : kind_ == 1 ? (bf16*)(ws + WS_WOUT_T) + (size_t)l_ * 1024 * 1024 : kind_ == 2 ? (bf16*)(ws + WS_WQ_T) + (size_t)l_ * 1024 * 1024 \
              : (bf16*)(ws + WS_WBR_T) + ((size_t)l_ * 4 + nbr_) * 1024 * 256; } while (0)
__device__ __forceinline__ void titem_finish(bf16* WT, int K, int N, int k0, int n0, const float* rs_g, const float* rs_b, float* colsum, float* colbias, float* sm, int tid) {
    if (rs_g) {
        if (tid < 64) { float cs = 0.f, cb = 0.f;
            for (int kk = 0; kk < 64; ++kk) { const float w = sm[kk * 65 + tid]; cs += w * rs_g[k0 + kk]; cb += w * rs_b[k0 + kk]; }
            atomicAdd(colsum + n0 + tid, cs); atomicAdd(colbias + n0 + tid, cb); }
        __syncthreads();
        for (int e = tid; e < 64 * 64; e += NTHR) { const int kk = e >> 6, nn = e & 63; sm[kk * 65 + nn] *= rs_g[k0 + kk]; }
        __syncthreads();
    }
    { const int nn = tid >> 3, c = tid & 7;
      if (n0 + nn < N) { uint4 o; o.x = pk2(sm[(8 * c + 0) * 65 + nn], sm[(8 * c + 1) * 65 + nn]); o.y = pk2(sm[(8 * c + 2) * 65 + nn], sm[(8 * c + 3) * 65 + nn]);
          o.z = pk2(sm[(8 * c + 4) * 65 + nn], sm[(8 * c + 5) * 65 + nn]); o.w = pk2(sm[(8 * c + 6) * 65 + nn], sm[(8 * c + 7) * 65 + nn]);
          *(uint4*)(WT + (size_t)(n0 + nn) * K + k0 + 8 * c) = o; } }
}
__device__ void prologue_phase(int WV_, const Params& p, float* sm) {
    const int tid = LTID(WV_), B = LBID(), G = LGRID();
    unsigned char* ws = p.ws;
    float* sm1 = sm + 64 * 65;
    const float* pin1 = p.in[1]; const float* pin2 = p.in[2]; const float* pin3 = p.in[3]; const float* pin7 = p.in[7]; const float* pin5 = p.in[5]; const float* pin6 = p.in[6];
    asm volatile("" : "+s"(pin1), "+s"(pin2), "+s"(pin3), "+s"(pin7), "+s"(pin5), "+s"(pin6));
    const int kk0 = tid >> 4, c4 = tid & 15;
    for (int it = B; it < DEPTH_ * TI_LAYER; it += 2 * G) {
        const int it2 = it + G; const bool has2 = it2 < DEPTH_ * TI_LAYER;
        const float* Wa; const float* Wb; bf16* WTa; bf16* WTb; int Ka, Na, k0a, n0a, la, Kb, Nb, k0b, n0b, lb; bool fa, fb;
        TITEM_DECODE(it, Wa, WTa, Ka, Na, k0a, n0a, fa, la);
        { const int itb = has2 ? it2 : it; TITEM_DECODE(itb, Wb, WTb, Kb, Nb, k0b, n0b, fb, lb); }
        const float4 z4 = make_float4(0.f, 0.f, 0.f, 0.f);
        const bool ina = n0a + 4 * c4 < Na, inb = n0b + 4 * c4 < Nb;
        float4 a0 = z4, a1 = z4, b0 = z4, b1 = z4;
        if (ina) { a0 = *(const float4*)(Wa + (size_t)(k0a + kk0) * Na + n0a + 4 * c4); a1 = *(const float4*)(Wa + (size_t)(k0a + kk0 + 32) * Na + n0a + 4 * c4); }
        if (inb) { b0 = *(const float4*)(Wb + (size_t)(k0b + kk0) * Nb + n0b + 4 * c4); b1 = *(const float4*)(Wb + (size_t)(k0b + kk0 + 32) * Nb + n0b + 4 * c4); }
        __syncthreads();
        { float* d = sm + kk0 * 65 + 4 * c4; d[0] = a0.x; d[1] = a0.y; d[2] = a0.z; d[3] = a0.w; d += 32 * 65; d[0] = a1.x; d[1] = a1.y; d[2] = a1.z; d[3] = a1.w; }
        { float* d = sm1 + kk0 * 65 + 4 * c4; d[0] = b0.x; d[1] = b0.y; d[2] = b0.z; d[3] = b0.w; d += 32 * 65; d[0] = b1.x; d[1] = b1.y; d[2] = b1.z; d[3] = b1.w; }
        __syncthreads();
        titem_finish(WTa, Ka, Na, k0a, n0a, fa ? pin5 + la * 1024 : nullptr, pin6 + la * 1024, (float*)(ws + WS_COLS) + la * 2048, (float*)(ws + WS_COLS) + la * 2048 + 1024, sm, tid);
        if (has2) titem_finish(WTb, Kb, Nb, k0b, n0b, fb ? pin5 + lb * 1024 : nullptr, pin6 + lb * 1024, (float*)(ws + WS_COLS) + lb * 2048, (float*)(ws + WS_COLS) + lb * 2048 + 1024, sm1, tid);
    }
    __syncthreads();
    for (int l = 0; l < DEPTH_; ++l) {
        bf16* win_t = (bf16*)(ws + WS_WIN_T + l * WIN_T_BYTES);
        for (int i = B * NTHR + tid; i < (NP - NCOL) * 1024 / 8; i += G * NTHR) ((uint4*)(win_t + (size_t)NCOL * 1024))[i] = make_uint4(0u, 0u, 0u, 0u);
    }
    const float4* x4 = (const float4*)p.in[0]; uint2* hb2 = (uint2*)(ws + WS_HB);
    for (size_t i = (size_t)B * NTHR + tid; i < (size_t)T_ * 1024 / 4; i += (size_t)G * NTHR) { const float4 v = x4[i]; hb2[i] = make_uint2(pk2(v.x, v.y), pk2(v.z, v.w)); }
}

__device__ __forceinline__ void ln_row(float4 (&v)[4], const float* g, const float* bb, float* orow, bf16* obrow, int lane) {
    float s = 0.f;
#pragma unroll
    for (int j = 0; j < 4; ++j) s += (v[j].x + v[j].y) + (v[j].z + v[j].w);
    const float mean = wave_sum(s) * (1.0f / 1024.0f);
    float s2 = 0.f;
#pragma unroll
    for (int j = 0; j < 4; ++j) { v[j].x -= mean; v[j].y -= mean; v[j].z -= mean; v[j].w -= mean; s2 += (v[j].x * v[j].x + v[j].y * v[j].y) + (v[j].z * v[j].z + v[j].w * v[j].w); }
    const float rstd = 1.0f / sqrtf(wave_sum(s2) * (1.0f / 1024.0f) + LN_EPS);
#pragma unroll
    for (int j = 0; j < 4; ++j) {
        const float4 gg = ((const float4*)g)[j * 64 + lane], b4 = ((const float4*)bb)[j * 64 + lane];
        float4 o; o.x = v[j].x * rstd * gg.x + b4.x; o.y = v[j].y * rstd * gg.y + b4.y; o.z = v[j].z * rstd * gg.z + b4.z; o.w = v[j].w * rstd * gg.w + b4.w;
        ((float4*)orow)[j * 64 + lane] = o;
        ((uint2*)obrow)[j * 64 + lane] = make_uint2(pk2(o.x, o.y), pk2(o.z, o.w));
    }
}
__device__ void ln1_phase(int WV_, const float* hin, const float* add, const float* g, const float* bb, float* hout, bf16* hb) {
    const int lane = LTID(WV_) & 63, wave = LTID(WV_) >> 6;
    for (int row = LBID() * NWAVE + wave; row < T_; row += LGRID() * NWAVE) {
        float4 v[4];
#pragma unroll
        for (int j = 0; j < 4; ++j) {
            const float4 a = ((const float4*)(hin + (size_t)row * 1024))[j * 64 + lane], m = ((const float4*)(add + (size_t)row * 1024))[j * 64 + lane];
            v[j].x = ALPHA * a.x + m.x; v[j].y = ALPHA * a.y + m.y; v[j].z = ALPHA * a.z + m.z; v[j].w = ALPHA * a.w + m.w;
        }
        ln_row(v, g, bb, hout + (size_t)row * 1024, hb + (size_t)row * 1024, lane);
    }
}


typedef short bf16x8_t __attribute__((ext_vector_type(8)));
typedef float f32x16_t __attribute__((ext_vector_type(16)));
typedef float f32x2_t __attribute__((ext_vector_type(2)));
typedef __bf16 bf16x2_t __attribute__((ext_vector_type(2)));
__device__ __forceinline__ unsigned cvtpk(float lo, float hi) { f32x2_t v = {lo, hi}; bf16x2_t b = __builtin_convertvector(v, bf16x2_t); return __builtin_bit_cast(unsigned, b); }
__device__ __forceinline__ int crow(int r, int hi) { return (r & 3) + 8 * (r >> 2) + 4 * hi; }
__device__ __forceinline__ float xlane32(float v) { return __shfl_xor(v, 32); }
__device__ __forceinline__ float vmax(float a, float b) { float r; asm("v_max_f32_e32 %0, %1, %2" : "=v"(r) : "v"(a), "v"(b)); return r; }
__device__ __forceinline__ float vmin(float a, float b) { float r; asm("v_min_f32_e32 %0, %1, %2" : "=v"(r) : "v"(a), "v"(b)); return r; }
__device__ __forceinline__ float vmax3(float a, float b, float c) { float r; asm("v_max3_f32 %0, %1, %2, %3" : "=v"(r) : "v"(a), "v"(b), "v"(c)); return r; }

constexpr int AT_KP = 72, AT_VP = 96;
constexpr int AT_KS = 0, AT_KS_BYTES = 64 * AT_KP * 2;
constexpr int AT_VT = 2 * AT_KS_BYTES, AT_VT_BYTES = 64 * AT_VP * 2;
constexpr int AT_KM = AT_VT + 2 * AT_VT_BYTES;
constexpr int AT_MISC = AT_KM + 32 * AT_KP * 2;
constexpr float LOG2E = 1.4426950408889634f;

__device__ __forceinline__ unsigned mk_unit(int kind, int b, int x, int y) { return ((unsigned)kind << 30) | ((unsigned)b << 28) | ((unsigned)x << 8) | (unsigned)y; }
__device__ void build_unit_table(unsigned* tab, int i) {
    int n = 0; unsigned res = 0u;
#pragma unroll 1
    for (int c = 64; c >= 1; --c) {
        if (i >= n && i < n + 4) res = mk_unit(0, i - n, 0, c - 1);
        n += 4;
        if ((c & 3) == 0) { if (i >= n && i < n + 16) { const int j = i - n; res = mk_unit(2, j >> 2, j & 3, c / 4 - 1); } n += 16; }
    }
    if (i < 512) tab[i] = res;
}

template <int kind> __device__ __forceinline__ void attn_unit(int WV_, const bf16* P, const unsigned char* mask, const float* kmean, const float* sinks, bf16* ys,
                                unsigned char* lds, int b, int ux, int uy) {
    int tid_ = LTID(WV_); asm volatile("" : "+v"(tid_));
    const int tid = tid_, lane = tid & 63, wave = __builtin_amdgcn_readfirstlane(tid >> 6), r32 = lane & 31, hi = lane >> 5;
    bf16* s_km = (bf16*)(lds + AT_KM);
    const int skey = tid >> 3, sc = tid & 7;
    {
        const bf16* Pb = P + (size_t)b * S_ * NP;
        int q0w, qcol, kcol, vcol, ycol, kt_hi, kt_lo; float slope2 = 0.f, sink2 = 0.f;
        if (kind == 0) { const int head = wave >> 1; q0w = uy * 64 + (wave & 1) * 32; qcol = C_QA + head * 64; kcol = C_KA; vcol = C_VA; ycol = head * 64;
            slope2 = exp2f(-8.0f * (float)(3 * head + 1) / 12.0f) * LOG2E; kt_hi = uy; kt_lo = 0; }
        else if (kind == 1) { const int hq = ux * 2 + (wave >> 2); q0w = uy * 128 + (wave & 3) * 32; qcol = C_QB + hq * 64; kcol = C_KB + ux * 64; vcol = C_VB + ux * 64; ycol = 256 + hq * 64;
            slope2 = exp2f(-8.0f * (float)(3 * hq + 2) / 12.0f) * LOG2E; sink2 = sinks[hq] * LOG2E; kt_hi = 2 * uy + 1; kt_lo = (2 * uy - 2 > 0) ? 2 * uy - 2 : 0; }
        else if (kind == 2) { q0w = uy * 256 + wave * 32; qcol = C_QC + ux * 64; kcol = C_KC + ux * 64; vcol = C_VC + ux * 64; ycol = 512 + ux * 64;
            slope2 = exp2f(-8.0f * (float)(3 * ux + 3) / 12.0f) * LOG2E; kt_hi = 4 * uy + 3; kt_lo = 0; }
        else { q0w = uy * 256 + wave * 32; qcol = C_QD + ux * 64; kcol = C_KD + ux * 64; vcol = C_VD + ux * 64; ycol = 768 + ux * 64; kt_hi = 4 * uy + 3; kt_lo = 0; }
        const int qpos = q0w + r32;
        bf16x8_t qf[4];
        { const bf16* qp = Pb + (size_t)qpos * NP + qcol + 8 * hi;
#pragma unroll
          for (int ks = 0; ks < 4; ++ks) qf[ks] = *(const bf16x8_t*)(qp + 16 * ks); }
        {
            const float qs = (kind == 3) ? 0.125f : 0.125f * LOG2E;
            typedef unsigned u32x4_t __attribute__((ext_vector_type(4)));
#pragma unroll
            for (int ks = 0; ks < 4; ++ks) { u32x4_t w = __builtin_bit_cast(u32x4_t, qf[ks]);
#pragma unroll
                for (int i = 0; i < 4; ++i) w[i] = cvtpk(__uint_as_float(w[i] << 16) * qs, __uint_as_float(w[i] & 0xffff0000u) * qs);
                qf[ks] = __builtin_bit_cast(bf16x8_t, w); }
        }
        float sb[16];
#pragma unroll
        for (int r = 0; r < 16; ++r) sb[r] = slope2 * (float)((r & 3) + 8 * (r >> 2));
        unsigned bm = 0u;
        if (kind == 2) {
            const int own = uy;
            for (int e = tid; e < 32 * 64; e += NTHR) { const int row = e >> 6, d = e & 63; s_km[row * AT_KP + d] = (row < 16) ? (bf16)f2bf(kmean[((b * 4 + ux) * 16 + row) * 64 + d]) : (bf16)0; }
            __syncthreads();
            f32x16_t gacc;
#pragma unroll
            for (int r = 0; r < 16; ++r) gacc[r] = 0.f;
#pragma unroll
            for (int ks = 0; ks < 4; ++ks) { const bf16x8_t a = *(const bf16x8_t*)(s_km + r32 * AT_KP + 16 * ks + 8 * hi); gacc = __builtin_amdgcn_mfma_f32_32x32x16_bf16(a, qf[ks], gacc, 0, 0, 0); }
            float gt[16];
#pragma unroll
            for (int r = 0; r < 8; ++r) { const float mine = gacc[r], other = xlane32(mine); const int bi = crow(r, 0);
                gt[bi] = hi ? other : mine; gt[bi + 4] = hi ? mine : other; }
#pragma unroll
            for (int n = 0; n < 16; ++n) if (n >= own) gt[n] = -INFINITY;
#pragma unroll
            for (int rep = 0; rep < 3; ++rep) {
                float mx = -INFINITY;
#pragma unroll
                for (int n = 0; n < 16; ++n) mx = fmaxf(mx, gt[n]);
                bool done = !(mx > -INFINITY);
#pragma unroll
                for (int n = 0; n < 16; ++n) { const bool hit = !done && gt[n] == mx; if (hit) { bm |= 1u << n; gt[n] = -INFINITY; done = true; } }
            }
        }
        f32x16_t o0, o1;
#pragma unroll
        for (int r = 0; r < 16; ++r) { o0[r] = 0.f; o1[r] = 0.f; }
        float m_run = -INFINITY, l_run = 0.f, carry = 0.f;
        const bf16* kg = Pb + (size_t)skey * NP + kcol + sc * 8;
        const bf16* vg = Pb + (size_t)skey * NP + vcol + sc * 8;
        uint4 rk = *(const uint4*)(kg + (size_t)kt_hi * 64 * NP), rv = *(const uint4*)(vg + (size_t)kt_hi * 64 * NP);
        int buf = 0;
        { bf16* ks_ = (bf16*)(lds + AT_KS); bf16* vt_ = (bf16*)(lds + AT_VT);
          *(uint4*)(ks_ + skey * AT_KP + sc * 8) = rk;
          *(uint4*)(vt_ + skey * AT_VP + sc * 8) = rv; }
        __syncthreads();
        bool wave_done = false;
        uint2 mw_next = make_uint2(0u, 0u);
        if (kind == 0) mw_next = *(const uint2*)(mask + (size_t)(b * S_ + qpos) * 512 + kt_hi * 8);
        for (int kt = kt_hi; kt >= kt_lo; --kt) {
            const bool more = kt > kt_lo;
            const uint2 mw = mw_next;
            if (kind == 0 && more) mw_next = *(const uint2*)(mask + (size_t)(b * S_ + qpos) * 512 + (kt - 1) * 8);
            if (more) { rk = *(const uint4*)(kg + (size_t)(kt - 1) * 64 * NP); rv = *(const uint4*)(vg + (size_t)(kt - 1) * 64 * NP); }
            const bf16* ks_ = (const bf16*)(lds + AT_KS + buf * AT_KS_BYTES);
            const bf16* vt_ = (const bf16*)(lds + AT_VT + buf * AT_VT_BYTES);
            bool active = (kt * 64 <= q0w + 31) && !wave_done;
            if (kind == 1) active = active && (kt * 64 + 63 >= q0w - 127);
            if (active) {
                const int kbase = kt * 64 + 4 * hi;
                f32x16_t p0, p1;
                if (kind != 3) {
                    const float cb = slope2 * (float)(kbase - qpos), cb1 = cb + 32.0f * slope2;
#pragma unroll
                    for (int r = 0; r < 16; ++r) { p0[r] = cb + sb[r]; p1[r] = cb1 + sb[r]; }
                } else {
#pragma unroll
                    for (int r = 0; r < 16; ++r) { p0[r] = 0.f; p1[r] = 0.f; }
                }
#pragma unroll
                for (int ks = 0; ks < 4; ++ks) {
                    const bf16x8_t a0 = *(const bf16x8_t*)(ks_ + r32 * AT_KP + 16 * ks + 8 * hi);
                    const bf16x8_t a1 = *(const bf16x8_t*)(ks_ + (32 + r32) * AT_KP + 16 * ks + 8 * hi);
                    p0 = __builtin_amdgcn_mfma_f32_32x32x16_bf16(a0, qf[ks], p0, 0, 0, 0);
                    p1 = __builtin_amdgcn_mfma_f32_32x32x16_bf16(a1, qf[ks], p1, 0, 0, 0);
                }
                if (kind != 3) {
                    float mx = -INFINITY;
                    if (kind == 0) {
                        const unsigned w0 = mw.x >> (4 * hi), w1 = mw.y >> (4 * hi);
#pragma unroll
                        for (int r = 0; r < 16; ++r) { const int off = (r & 3) + 8 * (r >> 2);
                            p0[r] = (w0 & (1u << off)) ? p0[r] : -INFINITY; p1[r] = (w1 & (1u << off)) ? p1[r] : -INFINITY; mx = vmax3(mx, p0[r], p1[r]); }
                    } else if (kind == 1) {
                        const int rel = qpos - kbase;
#pragma unroll
                        for (int r = 0; r < 16; ++r) { const int off = (r & 3) + 8 * (r >> 2);
                            p0[r] = ((unsigned)(rel - off) < 128u) ? p0[r] : -INFINITY; p1[r] = ((unsigned)(rel - off - 32) < 128u) ? p1[r] : -INFINITY; mx = vmax3(mx, p0[r], p1[r]); }
                    } else {
                        if ((kt >> 2) == uy) {
                            const int rel = qpos - kbase;
#pragma unroll
                            for (int r = 0; r < 16; ++r) { const int off = (r & 3) + 8 * (r >> 2);
                                p0[r] = (off <= rel) ? p0[r] : -INFINITY; p1[r] = (off + 32 <= rel) ? p1[r] : -INFINITY; mx = vmax3(mx, p0[r], p1[r]); }
                        } else {
                            const bool tile_ok = ((bm >> (kt >> 2)) & 1u) != 0u;
#pragma unroll
                            for (int r = 0; r < 16; ++r) { p0[r] = tile_ok ? p0[r] : -INFINITY; p1[r] = tile_ok ? p1[r] : -INFINITY; mx = vmax3(mx, p0[r], p1[r]); }
                        }
                    }
                    mx = vmax(mx, xlane32(mx));
                    const float m_new = vmax(m_run, mx);
                    const float m_safe = (m_new == -INFINITY) ? 0.f : m_new;
                    p0 = p0 - m_safe; p1 = p1 - m_safe;
#pragma unroll
                    for (int r = 0; r < 16; ++r) { p0[r] = __builtin_amdgcn_exp2f(p0[r]); p1[r] = __builtin_amdgcn_exp2f(p1[r]); }
                    float ls;
                    { typedef float f32x8_t __attribute__((ext_vector_type(8))); typedef float f32x4v_t __attribute__((ext_vector_type(4)));
                      const f32x16_t t16 = p0 + p1; const f32x8_t t8 = t16.lo + t16.hi; const f32x4v_t t4 = t8.lo + t8.hi; const f32x2_t t2 = t4.lo + t4.hi; ls = t2.x + t2.y; }
                    if (__any(m_new > m_run)) {
                        const float alpha = __builtin_amdgcn_exp2f(m_run - m_safe);
                        l_run *= alpha;
                        o0 = o0 * alpha; o1 = o1 * alpha;
                    }
                    l_run += ls; m_run = m_new;
                } else {
                    float run = carry;
#define SB_HALF(PX, KOFF) do { \
                    float lk[16]; \
                    _Pragma("unroll") for (int r = 0; r < 16; ++r) { \
                        const int off = (r & 3) + 8 * (r >> 2); \
                        const bool v = (kbase + off + (KOFF)) < qpos; \
                        const float z = PX[r]; \
                        const float t = 0.6931471805599453f * __builtin_amdgcn_logf(1.0f + __builtin_amdgcn_exp2f(-LOG2E * fabsf(z))); \
                        lk[r] = v ? (fminf(-z, 0.f) - t) : 0.f; \
                        PX[r] = v ? (fminf(z, 0.f) - t) : -INFINITY; } \
                    _Pragma("unroll") for (int g = 3; g >= 0; --g) { \
                        const float G = (lk[4 * g] + lk[4 * g + 1]) + (lk[4 * g + 2] + lk[4 * g + 3]); \
                        const float PG = xlane32(G); \
                        float la = run + (hi ? 0.f : PG); \
                        run += G + PG; \
                        PX[4 * g + 3] += la; la += lk[4 * g + 3]; PX[4 * g + 2] += la; la += lk[4 * g + 2]; PX[4 * g + 1] += la; la += lk[4 * g + 1]; PX[4 * g] += la; } \
                    _Pragma("unroll") for (int r = 0; r < 16; ++r) PX[r] = __builtin_amdgcn_exp2f(LOG2E * PX[r]); } while (0)
                    SB_HALF(p1, 32);
                    SB_HALF(p0, 0);
#undef SB_HALF
                    carry = run;
                }
                unsigned pw[16];
#pragma unroll
                for (int j = 0; j < 8; ++j) { pw[j] = cvtpk(p0[2 * j], p0[2 * j + 1]); pw[8 + j] = cvtpk(p1[2 * j], p1[2 * j + 1]); }
#pragma unroll
                for (int s = 0; s < 4; ++s) {
                    bf16x8_t pb; { const unsigned* q = pw + 4 * s; typedef unsigned u32x4_t __attribute__((ext_vector_type(4))); u32x4_t t4 = {q[0], q[1], q[2], q[3]}; pb = __builtin_bit_cast(bf16x8_t, t4); }
#pragma unroll
                    for (int dt = 0; dt < 2; ++dt) {
                        typedef short s16x4_t __attribute__((ext_vector_type(4)));
                        typedef __attribute__((address_space(3))) s16x4_t lds_s16x4;
                        const int gi_ = lane & 15;
                        const bf16* vp = vt_ + (16 * s + 4 * hi + (gi_ >> 2)) * AT_VP + 32 * dt + 16 * ((lane >> 4) & 1) + 4 * (gi_ & 3);
                        const s16x4_t lo = __builtin_amdgcn_ds_read_tr16_b64_v4i16((lds_s16x4*)vp), hi4 = __builtin_amdgcn_ds_read_tr16_b64_v4i16((lds_s16x4*)(vp + 8 * AT_VP));
                        const bf16x8_t va = {lo[0], lo[1], lo[2], lo[3], hi4[0], hi4[1], hi4[2], hi4[3]};
                        if (dt == 0) o0 = __builtin_amdgcn_mfma_f32_32x32x16_bf16(va, pb, o0, 0, 0, 0);
                        else         o1 = __builtin_amdgcn_mfma_f32_32x32x16_bf16(va, pb, o1, 0, 0, 0);
                    }
                }
            }
            if (kind == 3) {
                const float cm = carry;
                if (__all(cm < -110.0f) || !(kt * 64 <= q0w + 31) ) { if (__all(cm < -110.0f)) wave_done = true; }
            }
            if (more) {
                bf16* ksn = (bf16*)(lds + AT_KS + (buf ^ 1) * AT_KS_BYTES); bf16* vtn = (bf16*)(lds + AT_VT + (buf ^ 1) * AT_VT_BYTES);
                *(uint4*)(ksn + skey * AT_KP + sc * 8) = rk;
                *(uint4*)(vtn + skey * AT_VP + sc * 8) = rv;
            }
            if (kind == 3) { if (__syncthreads_and(wave_done ? 1 : 0)) break; }
            else __syncthreads();
            buf ^= 1;
        }
        float inv;
        if (kind == 3) inv = 1.0f;
        else {
            float lt = l_run + xlane32(l_run);
            if (kind == 1) { const float mf = fmaxf(m_run, sink2); const float sc2 = exp2f(m_run - mf); lt = lt * sc2 + exp2f(sink2 - mf); inv = sc2 / lt; }
            else inv = 1.0f / lt;
        }
        bf16* yp = ys + (size_t)(b * S_ + qpos) * 1024 + ycol + 4 * hi;
#pragma unroll
        for (int g = 0; g < 4; ++g) {
            *(uint2*)(yp + 8 * g) = make_uint2(cvtpk(o0[4 * g] * inv, o0[4 * g + 1] * inv), cvtpk(o0[4 * g + 2] * inv, o0[4 * g + 3] * inv));
            *(uint2*)(yp + 32 + 8 * g) = make_uint2(cvtpk(o1[4 * g] * inv, o1[4 * g + 1] * inv), cvtpk(o1[4 * g + 2] * inv, o1[4 * g + 3] * inv));
        }
    }
}
__device__ void attn_fast_phase(int WV_, const bf16* P, const unsigned char* mask, const float* kmean, const float* sinks, bf16* ys,
                                const unsigned* utab, unsigned* counter, unsigned char* lds) {
    volatile unsigned* s_unit = (volatile unsigned*)(lds + AT_MISC);
    for (;;) {
        __syncthreads();
        if (LTID(WV_) == 0) s_unit[0] = atomicAdd(counter, 1u);
        __syncthreads();
        const unsigned ui = s_unit[0];
        if (ui >= 512u) break;
        const unsigned ue = utab[ui];
        const int kind = (int)(ue >> 30), b = (int)((ue >> 28) & 3u), ux = (int)((ue >> 8) & 255u), uy = (int)(ue & 255u);
        if (kind == 0) attn_unit<0>(WV_, P, mask, kmean, sinks, ys, lds, b, ux, uy);
        else attn_unit<2>(WV_, P, mask, kmean, sinks, ys, lds, b, ux, uy);
    }
    for (int u = LBID(); u < 256; u += LGRID()) { __syncthreads(); attn_unit<3>(WV_, P, mask, kmean, sinks, ys, lds, u >> 6, (u >> 4) & 3, u & 15); }
    for (int u = LBID(); u < 256; u += LGRID()) { __syncthreads(); attn_unit<1>(WV_, P, mask, kmean, sinks, ys, lds, u >> 6, (u >> 5) & 1, u & 31); }
}

constexpr float U_SCALE = 128.0f, V_SCALE = 48.0f;
constexpr int ROW6 = 1536;
typedef float v32f_t __attribute__((ext_vector_type(32)));
typedef unsigned v6u_t __attribute__((ext_vector_type(6)));
typedef unsigned u32x4a8_t __attribute__((ext_vector_type(4), aligned(8)));
__device__ __forceinline__ float rdlane_f(float v, int l) { return __builtin_bit_cast(float, __builtin_amdgcn_readlane(__builtin_bit_cast(int, v), l)); }
__device__ __forceinline__ unsigned q_e2m3(float v) {
    const float a = fminf(fabsf(v), 7.5f);
    unsigned code;
    if (a < 1.0f) code = (unsigned)rintf(a * 8.0f);
    else if (a < 2.0f) code = 8u + (unsigned)rintf((a - 1.0f) * 8.0f);
    else if (a < 4.0f) code = 16u + (unsigned)rintf((a - 2.0f) * 4.0f);
    else code = 24u + (unsigned)rintf((a - 4.0f) * 2.0f);
    return code | (v < 0.f ? 32u : 0u);
}
__device__ __forceinline__ void cvt_chunk6(const float4 (&a)[8], float sc, unsigned (&w)[6]) {
#pragma unroll
    for (int d = 0; d < 6; ++d) w[d] = 0u;
#pragma unroll
    for (int q4 = 0; q4 < 8; ++q4) {
        const float av[4] = {a[q4].x, a[q4].y, a[q4].z, a[q4].w};
#pragma unroll
        for (int e = 0; e < 4; ++e) { const int idx = q4 * 4 + e, bit = 6 * idx, d = bit >> 5, sft = bit & 31; const unsigned code = q_e2m3(av[e] * sc);
            w[d] |= code << sft; if (sft > 26) w[d + 1] |= code >> (32 - sft); }
    }
}
__device__ void convert_tables(int WV_, const Params& p) {
    const size_t nchunk = (size_t)DEPTH_ * 16384 * 2 * 32;
    const size_t stride = (size_t)LGRID() * NTHR;
    for (size_t i = (size_t)LBID() * NTHR + LTID(WV_); i < nchunk; i += 2 * stride) {
        const size_t i2 = i + stride; const bool has2 = i2 < nchunk; const size_t j2 = has2 ? i2 : i;
        const int c0 = (int)(i & 31), uv0 = (int)((i >> 5) & 1); const size_t le0 = i >> 6;
        const int c1 = (int)(j2 & 31), uv1 = (int)((j2 >> 5) & 1); const size_t le1 = j2 >> 6;
        const float* src0 = (uv0 ? p.in[10] : p.in[9]) + le0 * 1024 + c0 * 32;
        const float* src1 = (uv1 ? p.in[10] : p.in[9]) + le1 * 1024 + c1 * 32;
        float4 a0[8], a1[8];
#pragma unroll
        for (int q4 = 0; q4 < 8; ++q4) a0[q4] = ((const float4*)src0)[q4];
#pragma unroll
        for (int q4 = 0; q4 < 8; ++q4) a1[q4] = ((const float4*)src1)[q4];
        unsigned w0[6], w1[6];
        cvt_chunk6(a0, uv0 ? V_SCALE : U_SCALE, w0);
        cvt_chunk6(a1, uv1 ? V_SCALE : U_SCALE, w1);
        uint2* dst0 = (uint2*)(p.ws + WS_UV + le0 * ROW6 + uv0 * 768 + c0 * 24);
        dst0[0] = make_uint2(w0[0], w0[1]); dst0[1] = make_uint2(w0[2], w0[3]); dst0[2] = make_uint2(w0[4], w0[5]);
        if (has2) { uint2* dst1 = (uint2*)(p.ws + WS_UV + le1 * ROW6 + uv1 * 768 + c1 * 24);
            dst1[0] = make_uint2(w1[0], w1[1]); dst1[1] = make_uint2(w1[2], w1[3]); dst1[2] = make_uint2(w1[4], w1[5]); }
    }
}
__device__ __forceinline__ v6u_t ld_pk6(const unsigned char* ptr) {
    const uint2 a = ((const uint2*)ptr)[0], b = ((const uint2*)ptr)[1], c = ((const uint2*)ptr)[2];
    const v6u_t pk = {a.x, a.y, b.x, b.y, c.x, c.y};
    return pk;
}
__device__ void peer_fast_phase(int WV_, float* h, bf16* hb, const int* eid, const float* gate, const unsigned char* uv, const float* g1, const float* b1, const float* g, const float* bb, unsigned char* lds) {
    const int tid = LTID(WV_), lane = tid & 63, wave = tid >> 6, l32 = lane & 31, hi = lane >> 5;
    float* pl = (float*)(lds + wave * 16384);
    unsigned char* raw = lds + wave * 16384 + 4096 + lane * 24;
    for (int t = LBID() * NWAVE + wave; t < T_; t += LGRID() * NWAVE) {
        float* hr = h + (size_t)t * 1024 + l32 * 32;
        float x[32], acc[32];
#pragma unroll
        for (int q4 = 0; q4 < 8; ++q4) { const float4 a = ((const float4*)hr)[q4]; x[4 * q4] = a.x; x[4 * q4 + 1] = a.y; x[4 * q4 + 2] = a.z; x[4 * q4 + 3] = a.w; }
        {
            float s = 0.f;
#pragma unroll
            for (int i = 0; i < 32; ++i) s += x[i];
#pragma unroll
            for (int o = 16; o > 0; o >>= 1) s += __shfl_xor(s, o);
            const float mean = s * (1.0f / 1024.0f);
            float s2 = 0.f;
#pragma unroll
            for (int i = 0; i < 32; ++i) { x[i] -= mean; s2 += x[i] * x[i]; }
#pragma unroll
            for (int o = 16; o > 0; o >>= 1) s2 += __shfl_xor(s2, o);
            const float rstd = 1.0f / sqrtf(s2 * (1.0f / 1024.0f) + LN_EPS);
#pragma unroll
            for (int q4 = 0; q4 < 8; ++q4) { const float4 gg = ((const float4*)(g1 + l32 * 32))[q4], cc = ((const float4*)(b1 + l32 * 32))[q4];
                x[4 * q4] = x[4 * q4] * rstd * gg.x + cc.x; x[4 * q4 + 1] = x[4 * q4 + 1] * rstd * gg.y + cc.y; x[4 * q4 + 2] = x[4 * q4 + 2] * rstd * gg.z + cc.z; x[4 * q4 + 3] = x[4 * q4 + 3] * rstd * gg.w + cc.w; }
        }
#pragma unroll
        for (int i = 0; i < 32; ++i) acc[i] = 0.f;
#pragma unroll 1
        for (int batch = 0; batch < 4; ++batch) {
            const int my_eid = eid[(size_t)t * 128 + batch * 32 + l32];
            const float my_gate = gate[(size_t)t * 128 + batch * 32 + l32];
#pragma unroll 1
            for (int grp = 0; grp < 2; ++grp) {
                { u32x4a8_t pa[8]; uint2 pc[8];
#pragma unroll
                  for (int i = 0; i < 8; ++i) { const int id = __shfl(my_eid, 2 * (grp * 8 + i) + hi); const unsigned char* rp = uv + (size_t)id * ROW6 + l32 * 24; pa[i] = *(const u32x4a8_t*)rp; pc[i] = *(const uint2*)(rp + 16); }
#pragma unroll
                  for (int i = 0; i < 8; ++i) { uint2* wp = (uint2*)(raw + i * 1536); wp[0] = make_uint2(pa[i].x, pa[i].y); wp[1] = make_uint2(pa[i].z, pa[i].w); wp[2] = pc[i]; } }
#pragma unroll 1
                for (int i = 0; i < 8; ++i) {
                    const uint2* rp = (const uint2*)(raw + i * 1536); const uint2 a = rp[0], b = rp[1], c = rp[2];
                    const v6u_t pk6 = {a.x, a.y, b.x, b.y, c.x, c.y}; const v32f_t f = __builtin_amdgcn_cvt_scalef32_pk32_f32_fp6(pk6, 1.0f);
                    f32x2_t dv0 = {0.f, 0.f}, dv1 = {0.f, 0.f};
#pragma unroll
                    for (int j = 0; j < 8; ++j) { const f32x2_t fa = {f[2 * j], f[2 * j + 1]}, fb = {f[16 + 2 * j], f[17 + 2 * j]}, xa = {x[2 * j], x[2 * j + 1]}, xb = {x[16 + 2 * j], x[17 + 2 * j]};
                        dv0 = fa * xa + dv0; dv1 = fb * xb + dv1; }
                    pl[(2 * (grp * 8 + i) + hi) * 32 + l32] = (dv0.x + dv0.y) + (dv1.x + dv1.y);
                }
            }
            float d;
            { const float4* pr = (const float4*)(pl + l32 * 32); float4 s4 = pr[0];
#pragma unroll
              for (int i = 1; i < 8; ++i) { const float4 v = pr[i]; s4.x += v.x; s4.y += v.y; s4.z += v.z; s4.w += v.w; }
              d = ((s4.x + s4.y) + (s4.z + s4.w)) * (1.0f / U_SCALE); }
            const float hv = 0.5f * d * (1.0f + erff(d * 0.70710678118654752f)) * my_gate * (1.0f / V_SCALE);
#pragma unroll 1
            for (int grp = 0; grp < 2; ++grp) {
                { u32x4a8_t pa[8]; uint2 pc[8];
#pragma unroll
                  for (int i = 0; i < 8; ++i) { const int id = __shfl(my_eid, 2 * (grp * 8 + i) + hi); const unsigned char* rp = uv + (size_t)id * ROW6 + 768 + l32 * 24; pa[i] = *(const u32x4a8_t*)rp; pc[i] = *(const uint2*)(rp + 16); }
#pragma unroll
                  for (int i = 0; i < 8; ++i) { uint2* wp = (uint2*)(raw + i * 1536); wp[0] = make_uint2(pa[i].x, pa[i].y); wp[1] = make_uint2(pa[i].z, pa[i].w); wp[2] = pc[i]; } }
#pragma unroll 1
                for (int i = 0; i < 8; ++i) {
                    const float c = __shfl(hv, 2 * (grp * 8 + i) + hi);
                    const uint2* rp = (const uint2*)(raw + i * 1536); const uint2 a = rp[0], b = rp[1], cc = rp[2];
                    const v6u_t pk6 = {a.x, a.y, b.x, b.y, cc.x, cc.y}; const v32f_t f = __builtin_amdgcn_cvt_scalef32_pk32_f32_fp6(pk6, 1.0f);
                    const f32x2_t c2 = {c, c};
#pragma unroll
                    for (int j = 0; j < 16; ++j) { const f32x2_t fj = {f[2 * j], f[2 * j + 1]}; f32x2_t aj = {acc[2 * j], acc[2 * j + 1]}; aj = fj * c2 + aj; acc[2 * j] = aj.x; acc[2 * j + 1] = aj.y; }
                }
            }
        }
        float y[32], s = 0.f;
#pragma unroll
        for (int i = 0; i < 32; ++i) { acc[i] += __shfl_xor(acc[i], 32); y[i] = ALPHA * x[i] + acc[i]; s += y[i]; }
#pragma unroll
        for (int o = 16; o > 0; o >>= 1) s += __shfl_xor(s, o);
        const float mean = s * (1.0f / 1024.0f);
        float s2 = 0.f;
#pragma unroll
        for (int i = 0; i < 32; ++i) { y[i] -= mean; s2 += y[i] * y[i]; }
#pragma unroll
        for (int o = 16; o > 0; o >>= 1) s2 += __shfl_xor(s2, o);
        const float rstd = 1.0f / sqrtf(s2 * (1.0f / 1024.0f) + LN_EPS);
        float o[16];
#pragma unroll
        for (int q4 = 0; q4 < 4; ++q4) {
            const float4 gg = ((const float4*)(g + l32 * 32 + hi * 16))[q4], cc = ((const float4*)(bb + l32 * 32 + hi * 16))[q4];
            float ya[4], yb2[4];
#pragma unroll
            for (int e = 0; e < 4; ++e) { ya[e] = y[4 * q4 + e]; yb2[e] = y[16 + 4 * q4 + e]; }
            asm volatile("" : "+v"(ya[0]), "+v"(ya[1]), "+v"(ya[2]), "+v"(ya[3]), "+v"(yb2[0]), "+v"(yb2[1]), "+v"(yb2[2]), "+v"(yb2[3]));
            const float y0 = hi ? yb2[0] : ya[0], y1 = hi ? yb2[1] : ya[1], y2 = hi ? yb2[2] : ya[2], y3 = hi ? yb2[3] : ya[3];
            o[4 * q4] = y0 * rstd * gg.x + cc.x; o[4 * q4 + 1] = y1 * rstd * gg.y + cc.y; o[4 * q4 + 2] = y2 * rstd * gg.z + cc.z; o[4 * q4 + 3] = y3 * rstd * gg.w + cc.w;
            ((float4*)(hr + hi * 16))[q4] = make_float4(o[4 * q4], o[4 * q4 + 1], o[4 * q4 + 2], o[4 * q4 + 3]);
        }
        uint4* hbp = (uint4*)(hb + (size_t)t * 1024 + l32 * 32 + hi * 16);
        hbp[0] = make_uint4(pk2(o[0], o[1]), pk2(o[2], o[3]), pk2(o[4], o[5]), pk2(o[6], o[7]));
        hbp[1] = make_uint4(pk2(o[8], o[9]), pk2(o[10], o[11]), pk2(o[12], o[13]), pk2(o[14], o[15]));
    }
}

__device__ __forceinline__ float pack_pl(float v, unsigned pl) { return __uint_as_float((__float_as_uint(v) & ~127u) | pl); }
__device__ __forceinline__ void ins16(float (&s)[16], float x) {
#pragma unroll
    for (int k = 15; k >= 1; --k) s[k] = __builtin_amdgcn_fmed3f(s[k - 1], x, s[k]);
    s[0] = vmax(s[0], x);
}
template <int D> __device__ __forceinline__ void bitonic_stage(float (&c)[16]) {
#pragma unroll
    for (int i = 0; i < 16; ++i) if ((i & D) == 0) { const float a = vmax(c[i], c[i + D]), b = vmin(c[i], c[i + D]); c[i] = a; c[i + D] = b; }
}
__device__ __forceinline__ int decode_key(unsigned pl) { return (int)(32u * ((pl >> 4) & 3u) + (pl & 3u) + 8u * ((pl >> 2) & 3u) + 4u * ((pl >> 6) & 1u)); }
__device__ void route_fast_phase(int WV_, const bf16* qb, const bf16* skb  , int* eid, float* gate, unsigned char* lds, int pm = -1, int pn = 0) {
    const int tid = LTID(WV_), lane = tid & 63, wave = tid >> 6, r32 = lane & 31, hi = lane >> 5;
    unsigned* lidx = (unsigned*)lds + wave * (64 * 33) + lane * 33;
    const int u_first = (pm >= 0) ? 0 : LBID() * NWAVE + wave, u_end = (pm >= 0) ? 2 : (T_ / 32) * 8, u_step = (pm >= 0) ? 1 : LGRID() * NWAVE;
    for (int unit = u_first; unit < u_end; unit += u_step) {
        const int h = (pm >= 0) ? 2 * pn + unit : (unit & 7), t = ((pm >= 0) ? 8 * pm + wave : (unit >> 3)) * 32 + r32;
        float sl[2][16];
#pragma unroll
        for (int p = 0; p < 2; ++p) {
            bf16x8_t qf[4];
            { const bf16* qp = qb + (size_t)t * 1024 + h * 128 + p * 64 + 8 * hi;
#pragma unroll
              for (int ks = 0; ks < 4; ++ks) qf[ks] = *(const bf16x8_t*)(qp + 16 * ks); }
            float s[16];
#pragma unroll
            for (int k = 0; k < 16; ++k) s[k] = -INFINITY;
            const bf16* skp = skb + ((size_t)(h * 2 + p) * 128 + r32) * 64 + 8 * hi;
#pragma unroll
            for (int kt = 0; kt < 4; ++kt) {
                f32x16_t acc;
#pragma unroll
                for (int r = 0; r < 16; ++r) acc[r] = 0.f;
#pragma unroll
                for (int ks = 0; ks < 4; ++ks) { const bf16x8_t a = *(const bf16x8_t*)(skp + (size_t)kt * 32 * 64 + 16 * ks); acc = __builtin_amdgcn_mfma_f32_32x32x16_bf16(a, qf[ks], acc, 0, 0, 0); }
#pragma unroll
                for (int r = 0; r < 16; ++r) ins16(s, pack_pl(acc[r], (unsigned)(kt * 16 + r)));
            }
            const unsigned hb = (unsigned)hi << 6;
#pragma unroll
            for (int k = 0; k < 16; ++k) s[k] = __uint_as_float(__float_as_uint(s[k]) | hb);
            float c[16];
#pragma unroll
            for (int k = 0; k < 16; ++k) c[k] = vmax(s[k], __shfl_xor(s[15 - k], 32));
            bitonic_stage<8>(c); bitonic_stage<4>(c); bitonic_stage<2>(c); bitonic_stage<1>(c);
#pragma unroll
            for (int k = 0; k < 16; ++k) { sl[p][k] = c[k]; lidx[p * 16 + k] = (unsigned)decode_key(__float_as_uint(c[k]) & 127u); }
        }
        float w[16];
#pragma unroll
        for (int k = 0; k < 16; ++k) w[k] = -INFINITY;
#pragma unroll
        for (int i = 0; i < 16; ++i)
#pragma unroll
            for (int j = 0; j < 16; ++j)
                if ((i + 1) * (j + 1) <= 16) { const float v = sl[0][i] + sl[1][j]; ins16(w, __uint_as_float((__float_as_uint(v) & ~255u) | (unsigned)(i * 16 + j))); }
        float e[16], sum = 0.f;
#pragma unroll
        for (int k = 0; k < 16; ++k) { e[k] = expf(w[k] - w[0]); sum += e[k]; }
        const float inv = 1.0f / sum;
        int ide[8]; float gte[8];
#pragma unroll
        for (int k = 0; k < 8; ++k) {
            float wa = w[k], wb = w[8 + k], ea = e[k], eb = e[8 + k];
            asm volatile("" : "+v"(wa), "+v"(wb), "+v"(ea), "+v"(eb));
            const float wv = hi ? wb : wa;
            const unsigned pl = __float_as_uint(wv) & 255u;
            ide[k] = (int)(lidx[pl >> 4] * 128u + lidx[16 + (pl & 15u)]);
            gte[k] = (hi ? eb : ea) * inv;
        }
        int* ep = eid + (size_t)t * 128 + h * 16 + hi * 8; float* gp = gate + (size_t)t * 128 + h * 16 + hi * 8;
        *(int4*)ep = make_int4(ide[0], ide[1], ide[2], ide[3]); *(int4*)(ep + 4) = make_int4(ide[4], ide[5], ide[6], ide[7]);
        *(float4*)gp = make_float4(gte[0], gte[1], gte[2], gte[3]); *(float4*)(gp + 4) = make_float4(gte[4], gte[5], gte[6], gte[7]);
    }
}

typedef float f32x4_t __attribute__((ext_vector_type(4)));
typedef __bf16 bf16x2v __attribute__((ext_vector_type(2)));
__device__ __forceinline__ float dot2bf(unsigned a, unsigned b, float c) { return __builtin_amdgcn_fdot2_f32_bf16(__builtin_bit_cast(bf16x2v, a), __builtin_bit_cast(bf16x2v, b), c, false); }
__device__ __forceinline__ void cnt_gt(int& cnt, unsigned a, unsigned b) { asm("v_cmp_gt_u32_e32 vcc, %1, %2\n\tv_addc_co_u32_e32 %0, vcc, 0, %0, vcc" : "+v"(cnt) : "v"(a), "v"(b) : "vcc"); }
__device__ __forceinline__ void cnt_eq(int& cnt, unsigned a, unsigned b) { asm("v_cmp_eq_u32_e32 vcc, %1, %2\n\tv_addc_co_u32_e32 %0, vcc, 0, %0, vcc" : "+v"(cnt) : "v"(a), "v"(b) : "vcc"); }
__device__ __forceinline__ unsigned flag_gt(unsigned a, unsigned b) { unsigned r; asm("v_cmp_gt_u32_e32 vcc, %1, %2\n\tv_cndmask_b32_e64 %0, 0, 1, vcc" : "=v"(r) : "v"(a), "v"(b) : "vcc"); return r; }
__device__ __forceinline__ unsigned flag_eq(unsigned a, unsigned b) { unsigned r; asm("v_cmp_eq_u32_e32 vcc, %1, %2\n\tv_cndmask_b32_e64 %0, 0, 1, vcc" : "=v"(r) : "v"(a), "v"(b) : "vcc"); return r; }
__device__ __forceinline__ void cnt_ge(int& cnt, unsigned key, unsigned cand) { asm("v_cmp_ge_u32_e32 vcc, %1, %2\n\tv_addc_co_u32_e32 %0, vcc, 0, %0, vcc" : "+v"(cnt) : "v"(key), "v"(cand) : "vcc"); }

template <int CTRL, int RM> __device__ __forceinline__ unsigned dpp0(unsigned v) { return (unsigned)__builtin_amdgcn_update_dpp(0, (int)v, CTRL, RM, 0xf, false); }
template <int CTRL> __device__ __forceinline__ unsigned dppf(unsigned v) { return (unsigned)__builtin_amdgcn_update_dpp(-1, (int)v, CTRL, 0xf, 0xf, false); }
__device__ __forceinline__ unsigned wave_sum_u_dpp(unsigned v) {
    v += dpp0<0xB1, 0xf>(v); v += dpp0<0x4E, 0xf>(v); v += dpp0<0x141, 0xf>(v); v += dpp0<0x140, 0xf>(v);
    return (unsigned)__builtin_amdgcn_readlane((int)v, 0) + (unsigned)__builtin_amdgcn_readlane((int)v, 16) + (unsigned)__builtin_amdgcn_readlane((int)v, 32) + (unsigned)__builtin_amdgcn_readlane((int)v, 48);
}
__device__ __forceinline__ unsigned wave_min_u_dpp(unsigned v) {
    unsigned t;
    t = dppf<0xB1>(v); v = t < v ? t : v; t = dppf<0x4E>(v); v = t < v ? t : v; t = dppf<0x141>(v); v = t < v ? t : v; t = dppf<0x140>(v); v = t < v ? t : v;
    const unsigned a = (unsigned)__builtin_amdgcn_readlane((int)v, 0), b = (unsigned)__builtin_amdgcn_readlane((int)v, 16), c = (unsigned)__builtin_amdgcn_readlane((int)v, 32), d = (unsigned)__builtin_amdgcn_readlane((int)v, 48);
    const unsigned ab = a < b ? a : b, cd = c < d ? c : d; return ab < cd ? ab : cd;
}
__device__ __forceinline__ unsigned wave_incl_scan_u_dpp(unsigned v) {
    v += dpp0<0x111, 0xf>(v); v += dpp0<0x112, 0xf>(v); v += dpp0<0x114, 0xf>(v); v += dpp0<0x118, 0xf>(v);
    v += dpp0<0x142, 0xa>(v);
    v += dpp0<0x143, 0xc>(v);
    return v;
}
typedef __attribute__((address_space(3))) unsigned lds_u32;
template <int SHIFT> __device__ __forceinline__ unsigned radix_pass(const unsigned (&key)[64], unsigned pre, lds_u32* hist, int lane, int& need, int jlim, unsigned L) {
    typedef unsigned u32x4v __attribute__((ext_vector_type(4)));
    typedef __attribute__((address_space(3))) u32x4v lds_u32x4;
    const int fl = 63 - lane;
    { const u32x4v z4 = {0u, 0u, 0u, 0u};
#pragma unroll
      for (int i = 0; i < 8; ++i) ((lds_u32x4*)(hist + fl * 32))[i] = z4; }
    const unsigned hb = (unsigned)(size_t)hist + 4u * (unsigned)(lane & 7);
    const unsigned one = 1u;
    asm volatile("" ::: "memory");
#pragma unroll
    for (int j4 = 0; j4 < 16; ++j4) {
        if (4 * j4 <= jlim) {
            bool grp = true;
            if (SHIFT <= 8) {
                const bool any = ((key[4 * j4] >> (SHIFT + 8)) == pre) | ((key[4 * j4 + 1] >> (SHIFT + 8)) == pre) | ((key[4 * j4 + 2] >> (SHIFT + 8)) == pre) | ((key[4 * j4 + 3] >> (SHIFT + 8)) == pre);
                grp = __ballot(any) != 0ull;
            }
            if (grp) {
#pragma unroll
                for (int e = 0; e < 4; ++e) { const int j = 4 * j4 + e;
                    const unsigned addr = hb + (((key[j] >> SHIFT) & 255u) << 5);
                    unsigned long long sv;
                    if (SHIFT == 24) asm volatile("v_cmp_ge_u32_e32 vcc, %1, %2\n\ts_and_saveexec_b64 %0, vcc\n\tds_add_u32 %3, %4\n\ts_mov_b64 exec, %0" : "=&s"(sv) : "v"(key[j]), "v"(L), "v"(addr), "v"(one) : "vcc", "memory");
                    else { const unsigned t = key[j] >> ((SHIFT + 8) & 31);
                        asm volatile("v_cmp_eq_u32_e32 vcc, %1, %2\n\ts_and_saveexec_b64 %0, vcc\n\tds_add_u32 %3, %4\n\ts_mov_b64 exec, %0" : "=&s"(sv) : "v"(t), "v"(pre), "v"(addr), "v"(one) : "vcc", "memory"); }
                }
            }
        }
    }
    asm volatile("s_waitcnt lgkmcnt(0)" ::: "memory");
    unsigned dsum[4]; unsigned sumL = 0u;
#pragma unroll
    for (int i = 0; i < 4; ++i) { const u32x4v v0 = ((const lds_u32x4*)(hist + fl * 32))[2 * i], v1 = ((const lds_u32x4*)(hist + fl * 32))[2 * i + 1];
        dsum[i] = ((v0.x + v0.y) + (v0.z + v0.w)) + ((v1.x + v1.y) + (v1.z + v1.w)); sumL += dsum[i]; }
    const unsigned incl = wave_incl_scan_u_dpp(sumL);
    const unsigned above = incl - sumL;
    const bool own = (above < (unsigned)need) && ((unsigned)need <= above + sumL);
    const int owner = __ffsll((long long)__ballot(own)) - 1;
    unsigned acc = above; int sel = -1; unsigned cab = 0u;
#pragma unroll
    for (int i = 3; i >= 0; --i) { const unsigned c = dsum[i]; const bool hit = (sel < 0) && (acc + c >= (unsigned)need); cab = hit ? acc : cab; sel = hit ? i : sel; acc += c; }
    const int ow = owner < 0 ? 0 : owner;
    const unsigned digit = (unsigned)__builtin_amdgcn_readlane(sel, ow) + (unsigned)(4 * (63 - ow));
    need -= (int)__builtin_amdgcn_readlane((int)cab, ow);
    return digit;
}
#ifndef TS_SEL
#define TS_SEL 0
#endif
#define ITS_B() do { if (TS_SEL >= 20 && TS_SEL <= 25 && WV_ == 0 && LANEID() == 0) ((volatile __attribute__((address_space(3))) unsigned long long*)((__attribute__((address_space(3))) unsigned char*)lds + 147456 - 16 - 32))[0] = __builtin_amdgcn_s_memrealtime(); } while (0)
#define ITS_E(k) do { if ((k) == TS_SEL && WV_ == 0 && LANEID() == 0) { volatile __attribute__((address_space(3))) unsigned long long* w_ = (volatile __attribute__((address_space(3))) unsigned long long*)((__attribute__((address_space(3))) unsigned char*)lds + 147456 - 16 - 32); w_[1] += __builtin_amdgcn_s_memrealtime() - w_[0]; } } while (0)
__device__ void index_fast_phase(int WV_, const bf16* P, unsigned char* mask, float* kmean, float* scratch_all, unsigned* qctr, unsigned char* lds) {
    const int tid = LTID(WV_), lane = tid & 63, wave = tid >> 6, bid = LBID(), G = LGRID();
    float* s_part = (float*)lds;
    ITS_B();
    for (int k = bid; k < 256; k += G) {
        const int b = k >> 6, h = (k >> 4) & 3, blk = k & 15;
        const bf16* kp = P + (size_t)(b * S_ + blk * 256 + wave * 32) * NP + C_KC + h * 64 + lane;
        float a = 0.f;
#pragma unroll 8
        for (int j = 0; j < 32; ++j) a += bf2f(kp[(size_t)j * NP]);
        __syncthreads();
        s_part[wave * 64 + lane] = a;
        __syncthreads();
        if (tid < 64) { float s = 0.f;
#pragma unroll
            for (int w = 0; w < 8; ++w) s += s_part[w * 64 + tid];
            kmean[((b * 4 + h) * 16 + blk) * 64 + tid] = s * (1.0f / 256.0f); }
    }
    ITS_E(22);
    float* scr = scratch_all + (size_t)bid * (16 * 4096);
    const int lq = lane & 15, g4 = lane >> 4;
    volatile __attribute__((address_space(3))) unsigned* qslot = (volatile __attribute__((address_space(3))) unsigned*)((__attribute__((address_space(3))) unsigned char*)lds + 69632);
    unsigned ticket = (unsigned)bid;
    for (;;) {
        if (ticket >= 1024u) break;
        const int ui = (int)ticket;
        unsigned nticket = 0u;
        if (tid == 0) nticket = (unsigned)G + __hip_atomic_fetch_add(qctr, 1u, __ATOMIC_RELAXED, __HIP_MEMORY_SCOPE_AGENT);
        const int b = ui >> 8, k = ui & 255, tile = (b & 1) ? 255 - k : k, q0 = tile * 16;
        const bf16* Pb = P + (size_t)b * S_ * NP;
        const int ntiles = tile + 1;
        ITS_B();
        bf16x8_t qf[8]; float wi[8];
        { const bf16* qp = Pb + (size_t)(q0 + lq) * NP + C_QI + 8 * g4;
#pragma unroll
          for (int h = 0; h < 8; ++h) qf[h] = *(const bf16x8_t*)(qp + 32 * h);
          const uint4 wv = *(const uint4*)(Pb + (size_t)(q0 + lq) * NP + C_WI); unpack8(wv, wi); }
        bf16x8_t qch, qcl;
        { typedef unsigned u32x4_t __attribute__((ext_vector_type(4)));
          float qc[8];
#pragma unroll
          for (int i = 0; i < 8; ++i) qc[i] = 0.f;
#pragma unroll
          for (int h = 0; h < 8; ++h) { const u32x4_t w4 = __builtin_bit_cast(u32x4_t, qf[h]);
#pragma unroll
              for (int i = 0; i < 4; ++i) { qc[2 * i] += wi[h] * __uint_as_float(w4[i] << 16); qc[2 * i + 1] += wi[h] * __uint_as_float(w4[i] & 0xffff0000u); } }
          u32x4_t hi4, lo4;
#pragma unroll
          for (int i = 0; i < 4; ++i) { const unsigned hw = cvtpk(qc[2 * i], qc[2 * i + 1]); hi4[i] = hw;
              lo4[i] = cvtpk(qc[2 * i] - __uint_as_float(hw << 16), qc[2 * i + 1] - __uint_as_float(hw & 0xffff0000u)); }
          qch = __builtin_bit_cast(bf16x8_t, hi4); qcl = __builtin_bit_cast(bf16x8_t, lo4); }
        {
            bf16x8_t afn = *(const bf16x8_t*)(Pb + (size_t)((wave < ntiles ? wave : 0) * 16 + lq) * NP + C_KI + 8 * g4);
            for (int kt = wave; kt < ntiles; kt += NWAVE) {
                const bf16x8_t af = afn;
                { const int ktn = (kt + NWAVE < ntiles) ? kt + NWAVE : kt; afn = *(const bf16x8_t*)(Pb + (size_t)(ktn * 16 + lq) * NP + C_KI + 8 * g4); }
                f32x4_t a[8];
                const f32x4_t z = {0.f, 0.f, 0.f, 0.f};
#pragma unroll
                for (int h = 0; h < 8; ++h) a[h] = __builtin_amdgcn_mfma_f32_16x16x32_bf16(af, qf[h], z, 0, 0, 0);
                f32x4_t sc = __builtin_amdgcn_mfma_f32_16x16x32_bf16(af, qch, z, 0, 0, 0);
                sc = __builtin_amdgcn_mfma_f32_16x16x32_bf16(af, qcl, sc, 0, 0, 0);
                __builtin_amdgcn_sched_barrier(0);
#pragma unroll
                for (int h = 0; h < 8; ++h)
#pragma unroll
                    for (int r = 0; r < 4; ++r) sc[r] = __builtin_fmaf(__builtin_fabsf(a[h][r]), wi[h], sc[r]);
#pragma unroll
                for (int r = 0; r < 4; ++r) { sc[r] *= 0.03125f; if (sc[r] == 0.f) sc[r] = 0.f; }
                *(f32x4_t*)(scr + (size_t)lq * 4096 + kt * 16 + 4 * g4) = sc;
            }
        }
        __threadfence_block();
        __syncthreads();
        __threadfence_block();
        ITS_E(20); ITS_B();
        lds_u32* hist = (lds_u32*)((__attribute__((address_space(3))) unsigned char*)lds + 2048) + wave * 2048;
#pragma unroll 1
        for (int qi = 0; qi < 2; ++qi) {
            const int ql = 2 * wave + qi, q = q0 + ql;
            const float* row = scr + (size_t)ql * 4096 + lane;
            const int qrel = q - lane * 64;
            const int jlim = __builtin_amdgcn_readfirstlane(q >> 6);
            const int jmax = (q - lane) >> 6;
            unsigned wlo = 0u, whi = 0u;
            if (q + 1 > 256) {
                unsigned key[64];
#pragma unroll
                for (int j4 = 0; j4 < 16; ++j4) {
                    if (4 * j4 <= jlim) {
#pragma unroll
                        for (int e = 0; e < 4; ++e) key[4 * j4 + e] = __float_as_uint(row[64 * (4 * j4 + e)]);
                    } else {
#pragma unroll
                        for (int e = 0; e < 4; ++e) key[4 * j4 + e] = 0x7fffffffu;
                    }
                }
                unsigned t0 = 0u, t1 = 0u, t2 = 0u, t3 = 0u;
#pragma unroll
                for (int j4 = 0; j4 < 16; ++j4) {
                    if (4 * j4 <= jlim) {
#pragma unroll
                        for (int e = 0; e < 4; ++e) { const int j = 4 * j4 + e; const unsigned u = key[j];
                            const unsigned t = u ^ ((unsigned)((int)u >> 31) | 0x80000000u); const unsigned inval = (unsigned)((jmax - j) >> 31); const unsigned x = t & ~inval; key[j] = x;
                            unsigned n1, n2, n3;
                            asm("v_med3_u32 %0, %1, %2, %3" : "=v"(n3) : "v"(t2), "v"(t3), "v"(x));
                            asm("v_med3_u32 %0, %1, %2, %3" : "=v"(n2) : "v"(t1), "v"(t2), "v"(x));
                            asm("v_med3_u32 %0, %1, %2, %3" : "=v"(n1) : "v"(t0), "v"(t1), "v"(x));
                            t0 = t0 > x ? t0 : x; t1 = n1; t2 = n2; t3 = n3; }
                    } else {
#pragma unroll
                        for (int e = 0; e < 4; ++e) key[4 * j4 + e] = 0u;
                    }
                }
                unsigned L = wave_min_u_dpp(t3);
                L = L > 1u ? L : 1u;
                ITS_E(23); ITS_B();
                int need = 256;
                const unsigned d1 = radix_pass<24>(key, 0u, hist, lane, need, jlim, L);
                const unsigned d2 = radix_pass<16>(key, d1, hist, lane, need, jlim, L);
                const unsigned d3 = radix_pass<8>(key, (d1 << 8) | d2, hist, lane, need, jlim, L);
                const unsigned d4 = radix_pass<0>(key, (d1 << 16) | (d2 << 8) | d3, hist, lane, need, jlim, L);
                const unsigned prefix = (d1 << 24) | (d2 << 16) | (d3 << 8) | d4;
                ITS_E(24); ITS_B();
                int ceq = 0;
#pragma unroll
                for (int j = 0; j < 64; ++j) cnt_eq(ceq, key[j], prefix);
                ceq = (int)wave_sum_u_dpp((unsigned)ceq);
                int X = 4096;
                if (ceq != need) {
                    int X0 = 0;
#pragma unroll 1
                    for (int bit = 11; bit >= 0; --bit) {
                        const int c = X0 | (1 << bit);
                        int cnt = 0; const int crel = (c - lane + 63) >> 6;
#pragma unroll
                        for (int j = 0; j < 64; ++j) cnt_eq(cnt, (key[j] ^ prefix) | ~(unsigned)((j - crel) >> 31), 0u);
                        cnt = wave_sum_i(cnt);
                        if (cnt < need) X0 = c;
                    }
                    X = X0 + 1;
                }
                const int xrel = (X - lane + 63) >> 6;
#pragma unroll
                for (int j4 = 0; j4 < 16; ++j4) {
                    if (4 * j4 <= jlim) {
#pragma unroll
                        for (int e = 0; e < 4; ++e) { const int j = 4 * j4 + e;
                            const bool sel = (key[j] > prefix) || (key[j] == prefix && j < xrel);
                            const unsigned long long bm = __ballot(sel);
                            asm("v_writelane_b32 %0, %1, %2" : "+v"(wlo) : "s"((unsigned)bm), "n"(j));
                            asm("v_writelane_b32 %0, %1, %2" : "+v"(whi) : "s"((unsigned)(bm >> 32)), "n"(j)); }
                    }
                }
            } else {
#pragma unroll
                for (int j = 0; j < 32; ++j) { wlo |= (~(unsigned)((qrel - j) >> 31) & 1u) << j; whi |= (~(unsigned)((qrel - 32 - j) >> 31) & 1u) << j; }
            }
            ((uint2*)(mask + (size_t)(b * S_ + q) * 512))[lane] = make_uint2(wlo, whi);
            ITS_E(25); ITS_B();
        }
        ITS_E(21);
        if (tid == 0) qslot[0] = nticket;
        __syncthreads();
        ticket = qslot[0];
    }
}

constexpr int MG_P = 72;
constexpr int MG_TILE_BYTES = 128 * MG_P * 2;
__device__ void merge_fast_phase(int WV_, const bf16* P, const bf16* ys, const bf16* wbt  , bf16* merged, unsigned char* lds) {
    const int tid = LTID(WV_), lane = tid & 63, wave = tid >> 6, r32 = lane & 31, hi = lane >> 5, wt = wave & 3, wd = wave >> 2;
    const int srow0 = tid >> 3, sch = tid & 7;
    for (int tile = LBID(); tile < 1024; tile += LGRID()) {
        const int tok0 = (tile >> 3) * 128, d0 = (tile & 7) * 128;
        f32x16_t mer[2], acc[2];
#pragma unroll
        for (int r = 0; r < 16; ++r) { mer[0][r] = 0.f; mer[1][r] = 0.f; acc[0][r] = 0.f; acc[1][r] = 0.f; }
        uint4 RW00, RW01, RW10, RW11, RY00, RY01, RY10, RY11, RG0, RG1, RG2, RG3;
        bf16* gl = (bf16*)(lds + 4 * MG_TILE_BYTES);
        const int grow = tid >> 4, gch = tid & 15;
#define MG_GLOAD(st_, R_) do { const int n_ = (st_) >> 2, kc_ = (st_) & 3; \
            RW##R_##0 = *(const uint4*)(wbt + ((size_t)n_ * 1024 + d0 + srow0) * 256 + kc_ * 64 + sch * 8); \
            RW##R_##1 = *(const uint4*)(wbt + ((size_t)n_ * 1024 + d0 + srow0 + 64) * 256 + kc_ * 64 + sch * 8); \
            RY##R_##0 = *(const uint4*)(ys + (size_t)(tok0 + srow0) * 1024 + n_ * 256 + kc_ * 64 + sch * 8); \
            RY##R_##1 = *(const uint4*)(ys + (size_t)(tok0 + srow0 + 64) * 1024 + n_ * 256 + kc_ * 64 + sch * 8); } while (0)
#define MG_SSTORE(buf_, R_) do { bf16* wl_ = (bf16*)(lds + (buf_) * 2 * MG_TILE_BYTES); bf16* yl_ = (bf16*)(lds + (buf_) * 2 * MG_TILE_BYTES + MG_TILE_BYTES); \
            *(uint4*)(wl_ + srow0 * MG_P + sch * 8) = RW##R_##0; *(uint4*)(wl_ + (srow0 + 64) * MG_P + sch * 8) = RW##R_##1; \
            *(uint4*)(yl_ + srow0 * MG_P + sch * 8) = RY##R_##0; *(uint4*)(yl_ + (srow0 + 64) * MG_P + sch * 8) = RY##R_##1; } while (0)
        __syncthreads();
        MG_GLOAD(0, 0); MG_GLOAD(1, 1);
        MG_SSTORE(0, 0);
        __syncthreads();
#define MG_STAGE(PAR_, OTH_) do { const int buf = PAR_; \
            if (st + 2 < 16) MG_GLOAD(st + 2, PAR_); \
            if ((st & 3) == 1) { const bf16* gsrc = P + (size_t)(tok0 + grow) * NP + C_G + (st >> 2) * 1024 + d0 + gch * 8; \
                RG0 = *(const uint4*)gsrc; RG1 = *(const uint4*)(gsrc + (size_t)32 * NP); RG2 = *(const uint4*)(gsrc + (size_t)64 * NP); RG3 = *(const uint4*)(gsrc + (size_t)96 * NP); } \
            const bf16* wl = (const bf16*)(lds + buf * 2 * MG_TILE_BYTES); const bf16* yl = (const bf16*)(lds + buf * 2 * MG_TILE_BYTES + MG_TILE_BYTES); \
            _Pragma("unroll") for (int ks = 0; ks < 4; ++ks) { \
                const bf16x8_t bq = *(const bf16x8_t*)(yl + (32 * wt + r32) * MG_P + 16 * ks + 8 * hi); \
                const bf16x8_t a0 = *(const bf16x8_t*)(wl + (64 * wd + r32) * MG_P + 16 * ks + 8 * hi); \
                const bf16x8_t a1 = *(const bf16x8_t*)(wl + (64 * wd + 32 + r32) * MG_P + 16 * ks + 8 * hi); \
                acc[0] = __builtin_amdgcn_mfma_f32_32x32x16_bf16(a0, bq, acc[0], 0, 0, 0); \
                acc[1] = __builtin_amdgcn_mfma_f32_32x32x16_bf16(a1, bq, acc[1], 0, 0, 0); } \
            if ((st & 3) == 3) { \
                const int n = st >> 2; \
                const bf16* gp = gl + (32 * wt + r32) * 136 + 64 * wd + 4 * hi; (void)n; \
                _Pragma("unroll") for (int dt = 0; dt < 2; ++dt) \
                _Pragma("unroll") for (int g = 0; g < 4; ++g) { \
                        const uint2 gv = *(const uint2*)(gp + 32 * dt + 8 * g); \
                        const float g0 = __uint_as_float(gv.x << 16), g1 = __uint_as_float(gv.x & 0xffff0000u), g2 = __uint_as_float(gv.y << 16), g3 = __uint_as_float(gv.y & 0xffff0000u); \
                        mer[dt][4 * g + 0] += acc[dt][4 * g + 0] * g0; \
                        mer[dt][4 * g + 1] += acc[dt][4 * g + 1] * g1; \
                        mer[dt][4 * g + 2] += acc[dt][4 * g + 2] * g2; \
                        mer[dt][4 * g + 3] += acc[dt][4 * g + 3] * g3; } \
                _Pragma("unroll") for (int r = 0; r < 16; ++r) { acc[0][r] = 0.f; acc[1][r] = 0.f; } } \
            if (st + 1 < 16) MG_SSTORE(OTH_, OTH_); \
            if ((st & 3) == 2) { *(uint4*)(gl + grow * 136 + gch * 8) = RG0; *(uint4*)(gl + (grow + 32) * 136 + gch * 8) = RG1; *(uint4*)(gl + (grow + 64) * 136 + gch * 8) = RG2; *(uint4*)(gl + (grow + 96) * 136 + gch * 8) = RG3; } \
            __syncthreads(); } while (0)
#pragma unroll 1
        for (int st2 = 0; st2 < 16; st2 += 2) { { const int st = st2; MG_STAGE(0, 1); } { const int st = st2 + 1; MG_STAGE(1, 0); } }
#undef MG_STAGE
#undef MG_GLOAD
#undef MG_SSTORE
        bf16* mp = merged + (size_t)(tok0 + 32 * wt + r32) * 1024 + d0 + 64 * wd + 4 * hi;
#pragma unroll
        for (int dt = 0; dt < 2; ++dt)
#pragma unroll
            for (int g = 0; g < 4; ++g)
                *(uint2*)(mp + 32 * dt + 8 * g) = make_uint2(cvtpk(mer[dt][4 * g], mer[dt][4 * g + 1]), cvtpk(mer[dt][4 * g + 2], mer[dt][4 * g + 3]));
    }
}
#define LAS __attribute__((address_space(3)))
#define XB_TMO      128
#define XB_XCNT(j)  (256  + 64 * (j))
#define XB_XSUB(j)  (1280 + 64 * (j))
#define XB_XGEN(j)  (2304 + 64 * (j))
#define XB_TOP      3328
#define XB_TOPGEN   3392
#define XCD_BAR_WORDS 3456
#define XB_SPIN_CAP (1u << 18)

__device__ __forceinline__ unsigned xb_ld(unsigned* p)              { return __hip_atomic_load(p, __ATOMIC_RELAXED, __HIP_MEMORY_SCOPE_AGENT); }
__device__ __forceinline__ unsigned xb_add(unsigned* p, unsigned v) { return __hip_atomic_fetch_add(p, v, __ATOMIC_RELAXED, __HIP_MEMORY_SCOPE_AGENT); }
__device__ __forceinline__ unsigned xb_xcc_id() { return (unsigned)__builtin_amdgcn_s_getreg((3 << 11) | 20) & 0xFu; }
#define XB_SPIN(cond, bar) do { unsigned _sp = 0; while (cond) { __builtin_amdgcn_s_sleep(1); \
    if ((++_sp & 255u) == 0u) { if (xb_ld(&(bar)[XB_TMO])) break; if (_sp > XB_SPIN_CAP) { atomicAdd(&(bar)[XB_TMO], 1u); break; } } } } while (0)

struct XcdBarrier {
    unsigned* bar; unsigned x;
    volatile LAS unsigned* st;
};

__device__ __forceinline__ XcdBarrier xcd_barrier_post(unsigned* bar, volatile LAS unsigned* st) {
    XcdBarrier b; b.bar = bar; b.x = xb_xcc_id(); b.st = st;
    if (threadIdx.x == 0) (void)xb_add(&bar[XB_XCNT(b.x)], 1u);
    return b;
}
__device__ __forceinline__ void xcd_barrier_complete(unsigned* bar, unsigned x, unsigned& nloc, unsigned& nx) {
    const unsigned G = gridDim.x * gridDim.y * gridDim.z;
    unsigned sum, cnt, mine, sp = 0u;
    for (;;) {
        sum = 0u; cnt = 0u; mine = 0u;
#pragma unroll
        for (unsigned j = 0; j < 16; ++j) { const unsigned c = xb_ld(&bar[XB_XCNT(j)]); sum += c; cnt += (c > 0u) ? 1u : 0u; mine = (j == x) ? c : mine; }
        if (sum == G) break;
        __builtin_amdgcn_s_sleep(1);
        if ((++sp & 255u) == 0u) { if (xb_ld(&bar[XB_TMO])) break; if (sp > XB_SPIN_CAP) { atomicAdd(&bar[XB_TMO], 1u); break; } }
    }
    nloc = mine > 0u ? mine : 1u; nx = cnt > 0u ? cnt : 1u;
}

__device__ __forceinline__ void xcd_barrier(const XcdBarrier& b, int wv_) {
    asm volatile("s_waitcnt vmcnt(0)" ::: "memory");
    __syncthreads();
    if (wv_ == 0 && LANEID() == 0) {
        unsigned* bar = b.bar;
        __builtin_amdgcn_s_waitcnt(0);
        unsigned nloc = b.st[0], nx = b.st[1];
        if (nloc == 0u) { xcd_barrier_complete(bar, b.x, nloc, nx); b.st[0] = nloc; b.st[1] = nx; }
        const unsigned old = xb_add(&bar[XB_XSUB(b.x)], 1u);
        const unsigned gen = old / nloc;
        if (old + 1u == (gen + 1u) * nloc) {
            __builtin_amdgcn_fence(__ATOMIC_RELEASE, "agent");
            asm volatile("s_waitcnt vmcnt(0)" ::: "memory");
            const unsigned og = xb_add(&bar[XB_TOP], 1u);
            const unsigned tg = og / nx;
            if (og + 1u == (tg + 1u) * nx) xb_add(&bar[XB_TOPGEN], 1u);
            else XB_SPIN(xb_ld(&bar[XB_TOPGEN]) == tg, bar);
            __builtin_amdgcn_fence(__ATOMIC_ACQUIRE, "agent");
            xb_add(&bar[XB_XGEN(b.x)], 1u);
            asm volatile("s_waitcnt vmcnt(0)" ::: "memory");
        } else {
            XB_SPIN(xb_ld(&bar[XB_XGEN(b.x)]) == gen, bar);
            __builtin_amdgcn_fence(__ATOMIC_ACQUIRE, "agent");
            asm volatile("s_waitcnt vmcnt(0)" ::: "memory");
        }
    }
    __syncthreads();
}

enum { PH_PRO = 0, PH_GIN, PH_INDEX, PH_ATTN, PH_MERGE, PH_GOUT, PH_LN1, PH_GQ, PH_ROUTE, PH_PEER };
template <int PH> __device__ __forceinline__ void run_phase(int WV_, const Params& p_unused, int l, unsigned char* lds_raw) {
    size_t kaoff_ = 0; asm volatile("" : "+s"(kaoff_));
    typedef const __attribute__((address_space(4))) char* kaptr_t;
    const __attribute__((address_space(4))) Params& p = *(const __attribute__((address_space(4))) Params*)((kaptr_t)__builtin_amdgcn_kernarg_segment_ptr() + kaoff_);
    float* sm = (float*)lds_raw;
    size_t wsoff_ = 0; asm volatile("" : "+s"(wsoff_));
    unsigned char* ws = p.ws + wsoff_;
    float* hbuf = p.out;
    bf16* hb = (bf16*)(ws + WS_HB);
    bf16* P = (bf16*)(ws + WS_P);
    bf16* ys = (bf16*)(ws + WS_YS);
    bf16* mrg = (bf16*)(ws + WS_MRG);
    float* mix = (float*)(ws + WS_MIX);
    float* qb = (float*)(ws + WS_Q);
    unsigned char* mask = ws + WS_MASK;
    int* eid = (int*)(ws + WS_EID);
    float* gate = (float*)(ws + WS_GATE);
    float* kmean = (float*)(ws + WS_KMEAN);
    const float* hin = (l == 0) ? p.in[0] : hbuf;
    if (PH == PH_PRO) { Params pc; for (int i = 0; i < 13; ++i) pc.in[i] = p.in[i]; pc.out = p.out; pc.ws = ws;
        prologue_phase(WV_, pc, sm); convert_tables(WV_, pc);
        for (int i = LBID() * NTHR + LTID(WV_); i < DEPTH_ * 8 * 2 * 128 * 64 / 4; i += LGRID() * NTHR) { const float4 v = ((const float4*)p.in[8])[i]; ((uint2*)(ws + WS_SKB))[i] = make_uint2(pk2(v.x, v.y), pk2(v.z, v.w)); } if (LBID() < 2) build_unit_table((unsigned*)(ws + WS_CTL) + 1024, LBID() * NTHR + LTID(WV_)); }
    else if (PH == PH_GIN) {
        pg8::Gemm g{hb, (const bf16*)(ws + WS_WIN_T + l * WIN_T_BYTES), T_, NP, 1024};
        pg8::StaticOrder S; S.init(T_, NP, (int)LGRID(), (int)LBID());
        pg8::EpiBf16Sig E{P, NP, C_G};
        pg8::gemm_phase<pg8::EpiBf16Sig, pg8::StaticOrder, true, true>(WV_, (PG8_LAS unsigned char*)lds_raw, g, S, E);
    }
    else if (PH == PH_INDEX) index_fast_phase(WV_, P, mask, kmean, (float*)(ws + WS_YS), (unsigned*)(ws + WS_CTL) + 64 * l + 16, lds_raw);
    else if (PH == PH_ATTN) attn_fast_phase(WV_, P, mask, kmean, p.in[4] + l * 4, ys, (const unsigned*)(ws + WS_CTL) + 1024, (unsigned*)(ws + WS_CTL) + 64 * l, lds_raw);
    else if (PH == PH_MERGE) merge_fast_phase(WV_, P, ys, (const bf16*)(ws + WS_WBR_T) + (size_t)l * 4 * 1024 * 256, mrg, lds_raw);
    else if (PH == PH_GOUT) {
        pg8::Gemm g{mrg, (const bf16*)(ws + WS_WOUT_T) + (size_t)l * 1024 * 1024, T_, 1024, 1024};
        pg8::StaticOrder S; S.init(T_, 1024, (int)LGRID(), (int)LBID());
        pg8::EpiResY E{hin, hbuf, hb, (float*)(ws + WS_STATS) + (size_t)l * T_ * 2, ALPHA};
        pg8::gemm_phase<pg8::EpiResY, pg8::StaticOrder, true, true>(WV_, (PG8_LAS unsigned char*)lds_raw, g, S, E);
    }
    else if (PH == PH_GQ) {
        pg8::Gemm g{hb, (const bf16*)(ws + WS_WQ_T) + (size_t)l * 1024 * 1024, T_, 1024, 1024};
        pg8::StaticOrder S; S.init(T_, 1024, (int)LGRID(), (int)LBID());
        pg8::EpiLnFold E{(bf16*)qb, (const float*)(ws + WS_STATS) + (size_t)l * T_ * 2, (const float*)(ws + WS_COLS) + l * 2048, (const float*)(ws + WS_COLS) + l * 2048 + 1024, LN_EPS};
        pg8::gemm_phase<pg8::EpiLnFold, pg8::StaticOrder, true, true>(WV_, (PG8_LAS unsigned char*)lds_raw, g, S, E);
        pg8::Unit u0;
        if (LGRID() == 256 && S.next(0, u0)) {
            asm volatile("s_waitcnt vmcnt(0)" ::: "memory"); __syncthreads();
            route_fast_phase(WV_, (const bf16*)qb, (const bf16*)(ws + WS_SKB) + (size_t)l * 8 * 2 * 128 * 64, eid, gate, lds_raw, u0.pm, u0.pn);
        }
    }
    else if (PH == PH_ROUTE) { if (LGRID() != 256) route_fast_phase(WV_, (const bf16*)qb, (const bf16*)(ws + WS_SKB) + (size_t)l * 8 * 2 * 128 * 64, eid, gate, lds_raw); }
    else peer_fast_phase(WV_, hbuf, hb, eid, gate, ws + WS_UV + (size_t)l * 24 * MiB, p.in[5] + l * 1024, p.in[6] + l * 1024, p.in[11] + l * 1024, p.in[12] + l * 1024, lds_raw);
}

constexpr int CW_BAR = 4096;
constexpr int LDS_BARST = LDS_BYTES - 16;
__global__ void __launch_bounds__(NTHR, 2) mk_fwd(Params p) {
    extern __shared__ __attribute__((aligned(16))) unsigned char lds_raw[];
    cg::grid_group grid = cg::this_grid();
    const int WV_ = __builtin_amdgcn_readfirstlane((int)threadIdx.x >> 6);
    { volatile LAS unsigned* bst0 = (volatile LAS unsigned*)((LAS unsigned char*)lds_raw + LDS_BARST); if (threadIdx.x < 4) bst0[threadIdx.x] = 0u; }
    __syncthreads();
    volatile LAS unsigned* bst = (volatile LAS unsigned*)((LAS unsigned char*)lds_raw + LDS_BARST);
    { uint4* z = (uint4*)p.ws; const uint4 z4 = make_uint4(0u, 0u, 0u, 0u);
      for (unsigned i = (unsigned)LBID() * NTHR + (unsigned)LTID(WV_); i < (unsigned)(2 * MiB / 16); i += (unsigned)LGRID() * NTHR) z[i] = z4; }
    grid.sync();
    (void)xcd_barrier_post((unsigned*)(p.ws + WS_CTL) + CW_BAR, bst);
#define GRID_BAR() do { XcdBarrier b_; b_.bar = (unsigned*)(p.ws + WS_CTL) + CW_BAR; b_.x = xb_xcc_id(); b_.st = (volatile LAS unsigned*)((LAS unsigned char*)lds_raw + LDS_BARST); xcd_barrier(b_, WV_); } while (0)
    run_phase<PH_PRO>(WV_, p, 0, lds_raw);
    GRID_BAR();
#pragma unroll 1
    for (int l = 0; l < DEPTH_; ++l) {
        run_phase<PH_GIN>(WV_, p, l, lds_raw); GRID_BAR();
        run_phase<PH_INDEX>(WV_, p, l, lds_raw); GRID_BAR();
        run_phase<PH_ATTN>(WV_, p, l, lds_raw); GRID_BAR();
        run_phase<PH_MERGE>(WV_, p, l, lds_raw); GRID_BAR();
        run_phase<PH_GOUT>(WV_, p, l, lds_raw); GRID_BAR();
        run_phase<PH_GQ>(WV_, p, l, lds_raw); if (LGRID() != 256) { GRID_BAR(); run_phase<PH_ROUTE>(WV_, p, l, lds_raw); } GRID_BAR();
        run_phase<PH_PEER>(WV_, p, l, lds_raw); if (l + 1 < DEPTH_) GRID_BAR();
    }
}

extern "C" void kernel_launch(void* const* d_in, const int* in_sizes, int n_in, void* d_out, int out_size, void* d_ws, size_t ws_size, hipStream_t stream) {
    if (n_in != 13 || ws_size < WS_END) { fprintf(stderr, "kernel_launch: unexpected n_in %d / ws_size %zu; nothing launched\n", n_in, ws_size); return; }
    static int grid_blocks = 0;
    if (grid_blocks == 0) {
        int dev = 0, cus = 0, per_cu = 0;
        (void)hipGetDevice(&dev);
        (void)hipDeviceGetAttribute(&cus, hipDeviceAttributeMultiprocessorCount, dev);
        (void)hipFuncSetAttribute((const void*)mk_fwd, hipFuncAttributeMaxDynamicSharedMemorySize, LDS_BYTES);
        (void)hipOccupancyMaxActiveBlocksPerMultiprocessor(&per_cu, (const void*)mk_fwd, NTHR, LDS_BYTES);
        if (per_cu < 1) fprintf(stderr, "kernel_launch: occupancy query reports %d\n", per_cu);
        grid_blocks = cus;
    }
    Params p{};
    for (int i = 0; i < 13; ++i) p.in[i] = (const float*)d_in[i];
    p.out = (float*)d_out; p.ws = (unsigned char*)d_ws;
    void* args[] = {&p};
    hipError_t e = hipLaunchCooperativeKernel((const void*)mk_fwd, dim3(grid_blocks), dim3(NTHR), args, LDS_BYTES, stream);
    if (e != hipSuccess) fprintf(stderr, "cooperative launch failed: %s (grid %d)\n", hipGetErrorString(e), grid_blocks);
}
```

```cpp
#include <hip/hip_runtime.h>
#include <cstdio>
#include <cstdint>
#include <hip/hip_cooperative_groups.h>
namespace cg = cooperative_groups;

__device__ __forceinline__ int LANEID() { int l; asm volatile("v_mbcnt_lo_u32_b32 %0, -1, 0\n\tv_mbcnt_hi_u32_b32 %0, -1, %0" : "=v"(l)); return l; }
__device__ __forceinline__ int LTID(int wv) { return (wv << 6) | LANEID(); }
__device__ __forceinline__ int LBID() { int t = blockIdx.x; asm volatile("" : "+s"(t)); return t; }
__device__ __forceinline__ int LGRID() { int t = gridDim.x; asm volatile("" : "+s"(t)); return t; }
namespace pg8 {
#define PG8_LAS __attribute__((address_space(3)))
typedef unsigned short bf16_t;
typedef short bf16x8 __attribute__((ext_vector_type(8)));
typedef float f32x4 __attribute__((ext_vector_type(4)));
typedef unsigned u32x4 __attribute__((ext_vector_type(4)));
constexpr int BM = 256, BK = 64, HALF = 128, HTB = HALF * BK * 2  , STAGE_BYTES = 8 * HTB, NXCD = 8, WGM = 8;

__host__ __device__ __forceinline__ int lds_byte(int r, int c) { const int st = (r >> 4) * 2 + (c >> 5), rr = r & 15, cc = c & 31, ob = rr * 64 + cc * 2; return st * 1024 + (ob ^ (((ob >> 9) & 1) << 5)); }
__host__ __device__ __forceinline__ void stage_rc(int b, int& R, int& C) { const int st = b / 1024, sb = b % 1024, swz = sb ^ (((sb >> 9) & 1) << 5); R = (st >> 1) * 16 + swz / 64; C = (st & 1) * 32 + (swz % 64) / 2; }
__host__ __device__ __forceinline__ int perm32(int rho) { const int n = rho >> 4, i = rho & 15; return 8 * (i >> 2) + 4 * n + (i & 3); }

struct Unit { int pm, pn; };
struct Gemm { const bf16_t* A; const bf16_t* Bt; int M, N, K; };

struct StaticOrder {
    int nM, nN, nwg, G, c;
    __host__ __device__ void init(int M, int N, int G_, int c_) { nM = M / BM; nN = N / BM; nwg = nM * nN; G = G_; c = c_; }
    __host__ __device__ bool next(int i, Unit& u) const {
        const long L = (long)i * G + c; if (L >= nwg) return false;
        int wgid = (int)L; { const int q = nwg / NXCD, r = nwg % NXCD, xcd = wgid % NXCD, off = wgid / NXCD; wgid = (xcd < r ? xcd * (q + 1) : r * (q + 1) + (xcd - r) * q) + off; }
        const int nig = WGM * nN, gid = wgid / nig, fm = gid * WGM, gsz = (nM - fm) < WGM ? (nM - fm) : WGM;
        u.pm = fm + ((wgid % nig) % gsz); u.pn = (wgid % nig) / gsz; return true;
    }
    __device__ __forceinline__ void a_ready(const Unit&) const {}
    __device__ __forceinline__ void done(const Unit&) const {}
};

__device__ __forceinline__ unsigned cvt_pk_bf16(float lo, float hi) { unsigned r; asm volatile("v_cvt_pk_bf16_f32 %0, %1, %2" : "=v"(r) : "v"(lo), "v"(hi)); return r; }
typedef float f32x2 __attribute__((ext_vector_type(2)));
__device__ __forceinline__ f32x2 gelu_pk(f32x2 v) {
    const f32x2 av = __builtin_elementwise_abs(v), d = av * 0.2316418882f + 1.0f;
    f32x2 t; t.x = __builtin_amdgcn_rcpf(d.x); t.y = __builtin_amdgcn_rcpf(d.y);
    f32x2 q = t * 0.5307027145f + (-0.7265760135f); q = q * t + 0.7107068705f; q = q * t + (-0.142248368f); q = q * t + 0.127414796f; q = q * t;
    const f32x2 s = (v * v) * (-0.72134752044f);
    f32x2 e; e.x = __builtin_amdgcn_exp2f(s.x); e.y = __builtin_amdgcn_exp2f(s.y);
    const f32x2 m = v * (q * e), r = v - m;
    f32x2 o; o.x = v.x < 0.f ? m.x : r.x; o.y = v.y < 0.f ? m.y : r.y; return o;
}

template <int ACT  > struct EpiBf16 {
    static constexpr bool PERM = true, AFTER_DRAIN = false; static_assert(ACT == 0 || ACT == 1, "EpiBf16: ACT is 0 (none) or 1 (gelu_pk)");
    bf16_t* O; int ldc; const float* bias; int split_cols; size_t split_stride; float scale0;
    __device__ __forceinline__ void operator()(const f32x4 (&acc)[2][2][4][2], const Unit& u, int wr, int wc, int fr, int fq) const {
        { int ln_ = LANEID(); asm volatile("" : "+v"(ln_)); fr = ln_ & 15; fq = ln_ >> 4; }
        const int row0 = u.pm * BM + wr * 64 + fr; int colt = u.pn * BM; bf16_t* base = O;
        float sc = 1.f; if (split_cols) { const int t = colt / split_cols; base += (size_t)t * split_stride; colt -= t * split_cols; if (t == 0) sc = scale0; }
        const int col0 = colt + wc * 32 + 8 * fq, bcol0 = u.pn * BM + wc * 32 + 8 * fq;
        f32x4 bv[2][2];
#pragma unroll
        for (int bj = 0; bj < 2; ++bj)
#pragma unroll
            for (int n = 0; n < 2; ++n) bv[bj][n] = bias ? *(const f32x4*)(bias + bcol0 + bj * HALF + 4 * n) : (f32x4){0.f, 0.f, 0.f, 0.f};
#pragma unroll
        for (int ai = 0; ai < 2; ++ai)
#pragma unroll
            for (int m = 0; m < 4; ++m) { bf16_t* rowp = base + (size_t)(row0 + ai * HALF + m * 16) * ldc + col0;
#pragma unroll
                for (int bj = 0; bj < 2; ++bj) { f32x4 v0 = acc[ai][bj][m][0] + bv[bj][0], v1 = acc[ai][bj][m][1] + bv[bj][1];
                    if (ACT == 1) { f32x2 a = gelu_pk((f32x2){v0[0], v0[1]}), b = gelu_pk((f32x2){v0[2], v0[3]}), c = gelu_pk((f32x2){v1[0], v1[1]}), d = gelu_pk((f32x2){v1[2], v1[3]});
                        v0 = (f32x4){a.x, a.y, b.x, b.y}; v1 = (f32x4){c.x, c.y, d.x, d.y}; }
                    v0 = v0 * sc; v1 = v1 * sc; u32x4 w; w.x = cvt_pk_bf16(v0[0], v0[1]); w.y = cvt_pk_bf16(v0[2], v0[3]); w.z = cvt_pk_bf16(v1[0], v1[1]); w.w = cvt_pk_bf16(v1[2], v1[3]);
                    *(u32x4*)(rowp + bj * HALF) = w; } }
    }
};
template <class Epi, class Sched, bool ALIGN_EPI = false, bool SP2 = false>
__device__ __forceinline__ void gemm_phase(int WV_, PG8_LAS unsigned char* lds, const Gemm g, const Sched& S, const Epi& E) {
    const int tid = LTID(WV_), wid = __builtin_amdgcn_readfirstlane(tid >> 6), lane = tid & 63, wr = wid >> 2, wc = wid & 3, fr = lane & 15, fq = lane >> 4;
    const int K = g.K, nt = K / BK;
    unsigned voffA[2], voffB[2];
#pragma unroll
    for (int i = 0; i < 2; ++i) { int R, C; stage_rc(tid * 16 + i * 8192, R, C); const int Rb = Epi::PERM ? ((R & ~31) + perm32(R & 31)) : R;
        voffA[i] = (unsigned)(R * K + C) * 2u; voffB[i] = (unsigned)(Rb * K + C) * 2u; }
    const size_t kstep = (size_t)(BK * 2);
    const size_t hstep = (size_t)HALF * K * 2;
    const size_t tstep = 2 * hstep;
    const unsigned ldsw = (unsigned)wid * 1024u;
    const int aoff = lds_byte(wr * 64 + fr, fq * 8), boff = lds_byte(wc * 32 + fr, fq * 8);
#define PG8_SA(b, h) (((b) * 2 + (h)) * HTB)
#define PG8_SB(b, h) ((4 + (b) * 2 + (h)) * HTB)
#define PG8_STAGE(bufoff, gbase, voff) do { _Pragma("unroll") for (int _i = 0; _i < 2; ++_i) \
        __builtin_amdgcn_global_load_lds((const unsigned*)((const char*)(gbase) + (voff)[_i]), (PG8_LAS unsigned*)(lds + (bufoff) + ldsw + _i * 8192), 16, 0, 0); } while (0)
#define PG8_LDA(dst, b, h) do { _Pragma("unroll") for (int m = 0; m < 4; ++m) _Pragma("unroll") for (int k = 0; k < 2; ++k) dst[m][k] = *(const PG8_LAS bf16x8*)(lds + PG8_SA(b, h) + aoff + m * 2048 + k * 1024); } while (0)
#define PG8_LDB(dst, b, h) do { _Pragma("unroll") for (int n = 0; n < 2; ++n) _Pragma("unroll") for (int k = 0; k < 2; ++k) dst[n][k] = *(const PG8_LAS bf16x8*)(lds + PG8_SB(b, h) + boff + n * 2048 + k * 1024); } while (0)
#define PG8_MMA(ai, bj, At, Bt) do { __builtin_amdgcn_s_setprio(1); _Pragma("unroll") for (int m = 0; m < 4; ++m) _Pragma("unroll") for (int n = 0; n < 2; ++n) _Pragma("unroll") for (int k = 0; k < 2; ++k) \
        acc[ai][bj][m][n] = __builtin_amdgcn_mfma_f32_16x16x32_bf16(Bt[n][k], At[m][k], acc[ai][bj][m][n], 0, 0, 0); __builtin_amdgcn_s_setprio(0); } while (0)
#define PG8_WAIT_V(n) asm volatile("s_waitcnt vmcnt(" #n ")" ::: "memory")
#define PG8_WAIT_L(n) asm volatile("s_waitcnt lgkmcnt(" #n ")" ::: "memory")
#define PG8_BAR __builtin_amdgcn_s_barrier()
#define PG8_SCHED __builtin_amdgcn_sched_barrier(0)
    Unit cur, nxt; int ui = 0;
    if (!S.next(0, cur)) return;
    f32x4 acc[2][2][4][2];
#pragma unroll
    for (int a = 0; a < 2; ++a)
#pragma unroll
        for (int b = 0; b < 2; ++b)
#pragma unroll
            for (int m = 0; m < 4; ++m)
#pragma unroll
                for (int n = 0; n < 2; ++n) acc[a][b][m][n] = (f32x4){0.f, 0.f, 0.f, 0.f};
    bf16x8 At[4][2], B0[2][2], B1[2][2];
    const char* cA = (const char*)g.A + (size_t)cur.pm * tstep; const char* cB = (const char*)g.Bt + (size_t)cur.pn * tstep;
    S.a_ready(cur);
    if constexpr (SP2) {
        PG8_STAGE(PG8_SB(0, 0), cB, voffB); PG8_STAGE(PG8_SB(0, 1), cB + hstep, voffB); PG8_STAGE(PG8_SA(0, 0), cA, voffA); PG8_STAGE(PG8_SA(0, 1), cA + hstep, voffA);
        if (wr == 1) PG8_BAR;
        PG8_WAIT_V(2); PG8_BAR;
        PG8_STAGE(PG8_SB(1, 0), cB + kstep, voffB); PG8_STAGE(PG8_SA(1, 0), cA + kstep, voffA); PG8_STAGE(PG8_SB(1, 1), cB + hstep + kstep, voffB);
        PG8_WAIT_V(6); PG8_BAR;
    } else {
        PG8_STAGE(PG8_SB(0, 0), cB, voffB); PG8_STAGE(PG8_SA(0, 0), cA, voffA); PG8_STAGE(PG8_SB(0, 1), cB + hstep, voffB); PG8_STAGE(PG8_SA(0, 1), cA + hstep, voffA);
        if (wr == 1) PG8_BAR;
        PG8_WAIT_V(4); PG8_BAR;
        PG8_STAGE(PG8_SB(1, 0), cB + kstep, voffB); PG8_STAGE(PG8_SA(1, 0), cA + kstep, voffA); PG8_STAGE(PG8_SB(1, 1), cB + hstep + kstep, voffB);
        PG8_WAIT_V(6); PG8_BAR;
    }
    for (;;) {
        const bool has_next = S.next(ui + 1, nxt);
        const char* nA = has_next ? (const char*)g.A + (size_t)nxt.pm * tstep : cA; const char* nB = has_next ? (const char*)g.Bt + (size_t)nxt.pn * tstep : cB;
        for (int t = 0; t < nt; t += 2) {
            const bool last = (t == nt - 2);
            const char* a1 = cA + (size_t)(t + 1) * kstep;
            const char* a2 = last ? nA : cA + (size_t)(t + 2) * kstep; const char* b2 = last ? nB : cB + (size_t)(t + 2) * kstep;
            const char* a3 = a2 + kstep; const char* b3 = b2 + kstep;
            if (last && has_next) S.a_ready(nxt);
            if constexpr (SP2) {
            PG8_LDB(B0, 0, 0); PG8_LDB(B1, 0, 1); PG8_SCHED; PG8_LDA(At, 0, 0); PG8_STAGE(PG8_SA(1, 1), a1 + hstep, voffA);
            PG8_WAIT_V(8); PG8_WAIT_L(0); PG8_BAR; PG8_MMA(0, 0, At, B0); PG8_MMA(0, 1, At, B1); PG8_BAR; PG8_SCHED;
            PG8_LDA(At, 0, 1); PG8_STAGE(PG8_SB(0, 0), b2, voffB); PG8_STAGE(PG8_SB(0, 1), b2 + hstep, voffB); PG8_STAGE(PG8_SA(0, 0), a2, voffA);
            PG8_WAIT_V(8); PG8_WAIT_L(0); PG8_BAR; PG8_MMA(1, 0, At, B0); PG8_MMA(1, 1, At, B1); PG8_BAR; PG8_SCHED;
            PG8_LDB(B0, 1, 0); PG8_LDB(B1, 1, 1); PG8_SCHED; PG8_LDA(At, 1, 0); PG8_STAGE(PG8_SA(0, 1), a2 + hstep, voffA);
            PG8_WAIT_V(8); PG8_WAIT_L(0); PG8_BAR; PG8_MMA(0, 0, At, B0); PG8_MMA(0, 1, At, B1); PG8_BAR; PG8_SCHED;
            PG8_LDA(At, 1, 1); PG8_STAGE(PG8_SB(1, 0), b3, voffB); PG8_STAGE(PG8_SB(1, 1), b3 + hstep, voffB); PG8_STAGE(PG8_SA(1, 0), a3, voffA);
            PG8_WAIT_V(8); PG8_WAIT_L(0); PG8_BAR; PG8_MMA(1, 0, At, B0); PG8_MMA(1, 1, At, B1); PG8_BAR; PG8_SCHED;
            } else {
            PG8_LDB(B0, 0, 0); PG8_SCHED; PG8_LDA(At, 0, 0); PG8_STAGE(PG8_SA(1, 1), a1 + hstep, voffA);
            PG8_WAIT_L(8); PG8_BAR; PG8_WAIT_L(0); PG8_MMA(0, 0, At, B0); PG8_BAR; PG8_SCHED;
            PG8_LDB(B1, 0, 1); PG8_STAGE(PG8_SB(0, 0), b2, voffB);
            PG8_BAR; PG8_WAIT_L(0); PG8_MMA(0, 1, At, B1); PG8_BAR;
            PG8_LDA(At, 0, 1); PG8_STAGE(PG8_SA(0, 0), a2, voffA);
            PG8_BAR; PG8_WAIT_L(0); PG8_MMA(1, 0, At, B0); PG8_BAR; PG8_SCHED;
            PG8_STAGE(PG8_SB(0, 1), b2 + hstep, voffB);
            PG8_WAIT_V(6); PG8_BAR; PG8_MMA(1, 1, At, B1); PG8_BAR;
            PG8_LDB(B0, 1, 0); PG8_SCHED; PG8_LDA(At, 1, 0); PG8_STAGE(PG8_SA(0, 1), a2 + hstep, voffA);
            PG8_WAIT_L(8); PG8_BAR; PG8_WAIT_L(0); PG8_MMA(0, 0, At, B0); PG8_BAR; PG8_SCHED;
            PG8_LDB(B1, 1, 1); PG8_STAGE(PG8_SB(1, 0), b3, voffB);
            PG8_BAR; PG8_WAIT_L(0); PG8_MMA(0, 1, At, B1); PG8_BAR;
            PG8_LDA(At, 1, 1); PG8_STAGE(PG8_SA(1, 0), a3, voffA);
            PG8_BAR; PG8_WAIT_L(0); PG8_MMA(1, 0, At, B0); PG8_BAR; PG8_SCHED;
            PG8_STAGE(PG8_SB(1, 1), b3 + hstep, voffB);
            PG8_WAIT_V(6); PG8_BAR; PG8_MMA(1, 1, At, B1); PG8_BAR;
            }
        }
        if constexpr (ALIGN_EPI) { if (wr == 0) PG8_BAR; }
        if constexpr (!Epi::AFTER_DRAIN) { E(acc, cur, wr, wc, fr, fq); S.done(cur); }
        if (!has_next) break;
#pragma unroll
        for (int a = 0; a < 2; ++a)
#pragma unroll
            for (int b = 0; b < 2; ++b)
#pragma unroll
                for (int m = 0; m < 4; ++m)
#pragma unroll
                    for (int n = 0; n < 2; ++n) acc[a][b][m][n] = (f32x4){0.f, 0.f, 0.f, 0.f};
        cur = nxt; cA = nA; cB = nB; ++ui;
        if constexpr (ALIGN_EPI) { if (wr == 1) PG8_BAR; }
    }
    PG8_WAIT_V(0);
    if constexpr (!ALIGN_EPI) { if (wr == 0) PG8_BAR; }
    PG8_BAR;
    if constexpr (Epi::AFTER_DRAIN) { E.fused(acc, cur, wr, wc, fr, fq, lds, wid, lane); S.done(cur); }
#undef PG8_SA
#undef PG8_SB
#undef PG8_STAGE
#undef PG8_LDA
#undef PG8_LDB
#undef PG8_MMA
#undef PG8_WAIT_V
#undef PG8_WAIT_L
#undef PG8_BAR
#undef PG8_SCHED
}
}
namespace pg8 {
struct EpiF32 {
    static constexpr bool PERM = false, AFTER_DRAIN = false;
    float* O; int ldc;
    __device__ __forceinline__ void operator()(const f32x4 (&acc)[2][2][4][2], const Unit& u, int wr, int wc, int fr, int fq) const {
        { int ln_ = LANEID(); asm volatile("" : "+v"(ln_)); fr = ln_ & 15; fq = ln_ >> 4; }
        const int row0 = u.pm * BM + wr * 64 + fr, col0 = u.pn * BM + wc * 32 + 4 * fq;
#pragma unroll
        for (int ai = 0; ai < 2; ++ai)
#pragma unroll
            for (int m = 0; m < 4; ++m) { float* rowp = O + (size_t)(row0 + ai * HALF + m * 16) * ldc + col0;
#pragma unroll
                for (int bj = 0; bj < 2; ++bj)
#pragma unroll
                    for (int n = 0; n < 2; ++n) *(f32x4*)(rowp + bj * HALF + n * 16) = acc[ai][bj][m][n]; }
    }
};
struct EpiResY {
    static constexpr bool PERM = false, AFTER_DRAIN = false;
    const float* hin; float* yout; bf16_t* yb; float* stats; float alpha;
    __device__ __forceinline__ void operator()(const f32x4 (&acc)[2][2][4][2], const Unit& u, int wr, int wc, int fr, int fq) const {
        { int ln_ = LANEID(); asm volatile("" : "+v"(ln_)); fr = ln_ & 15; fq = ln_ >> 4; }
        const int row0 = u.pm * BM + wr * 64 + fr, col0 = u.pn * BM + wc * 32 + 4 * fq;
#pragma unroll
        for (int ai = 0; ai < 2; ++ai)
#pragma unroll
            for (int m = 0; m < 4; ++m) {
                const int row = row0 + ai * HALF + m * 16;
                float s = 0.f, s2 = 0.f;
#pragma unroll
                for (int bj = 0; bj < 2; ++bj)
#pragma unroll
                    for (int n = 0; n < 2; ++n) {
                        const size_t off = (size_t)row * 1024 + col0 + bj * HALF + n * 16;
                        const f32x4 hv = *(const f32x4*)(hin + off);
                        const f32x4 y = hv * alpha + acc[ai][bj][m][n];
                        *(f32x4*)(yout + off) = y;
                        typedef unsigned u32x2v __attribute__((ext_vector_type(2)));
                        u32x2v w; w.x = cvt_pk_bf16(y[0], y[1]); w.y = cvt_pk_bf16(y[2], y[3]);
                        *(u32x2v*)(yb + off) = w;
                        s += (y[0] + y[1]) + (y[2] + y[3]); s2 += (y[0] * y[0] + y[1] * y[1]) + (y[2] * y[2] + y[3] * y[3]);
                    }
                s += __shfl_xor(s, 16); s += __shfl_xor(s, 32); s2 += __shfl_xor(s2, 16); s2 += __shfl_xor(s2, 32);
                if (fq == 0) { atomicAdd(stats + 2 * (size_t)row, s); atomicAdd(stats + 2 * (size_t)row + 1, s2); }
            }
    }
};
struct EpiLnFold {
    static constexpr bool PERM = true, AFTER_DRAIN = false;
    bf16_t* O; const float* stats; const float* colsum; const float* colbias; float eps;
    __device__ __forceinline__ void operator()(const f32x4 (&acc)[2][2][4][2], const Unit& u, int wr, int wc, int fr, int fq) const {
        { int ln_ = LANEID(); asm volatile("" : "+v"(ln_)); fr = ln_ & 15; fq = ln_ >> 4; }
        const int row0 = u.pm * BM + wr * 64 + fr, col0 = u.pn * BM + wc * 32 + 8 * fq;
        f32x4 cs[2][2], cb[2][2];
#pragma unroll
        for (int bj = 0; bj < 2; ++bj)
#pragma unroll
            for (int n = 0; n < 2; ++n) { cs[bj][n] = *(const f32x4*)(colsum + col0 + bj * HALF + 4 * n); cb[bj][n] = *(const f32x4*)(colbias + col0 + bj * HALF + 4 * n); }
#pragma unroll
        for (int ai = 0; ai < 2; ++ai)
#pragma unroll
            for (int m = 0; m < 4; ++m) {
                const int row = row0 + ai * HALF + m * 16;
                const float sm_ = stats[2 * (size_t)row], sq_ = stats[2 * (size_t)row + 1];
                const float mean = sm_ * (1.0f / 1024.0f);
                const float rstd = 1.0f / sqrtf(fmaxf(sq_ * (1.0f / 1024.0f) - mean * mean, 0.f) + eps);
                bf16_t* rowp = O + (size_t)row * 1024 + col0;
#pragma unroll
                for (int bj = 0; bj < 2; ++bj) {
                    const f32x4 v0 = (acc[ai][bj][m][0] - cs[bj][0] * mean) * rstd + cb[bj][0], v1 = (acc[ai][bj][m][1] - cs[bj][1] * mean) * rstd + cb[bj][1];
                    u32x4 w; w.x = cvt_pk_bf16(v0[0], v0[1]); w.y = cvt_pk_bf16(v0[2], v0[3]); w.z = cvt_pk_bf16(v1[0], v1[1]); w.w = cvt_pk_bf16(v1[2], v1[3]);
                    *(u32x4*)(rowp + bj * HALF) = w;
                }
            }
    }
};
__device__ __forceinline__ unsigned cvt_pk_bf16_t(float lo, float hi) { unsigned r; asm volatile("s_nop 0\n\tv_cvt_pk_bf16_f32 %0, %1, %2" : "=v"(r) : "v"(lo), "v"(hi)); return r; }
struct EpiBf16Sig {
    static constexpr bool PERM = true, AFTER_DRAIN = false;
    bf16_t* O; int ldc; int sig_col0;
    __device__ __forceinline__ void operator()(const f32x4 (&acc)[2][2][4][2], const Unit& u, int wr, int wc, int fr, int fq) const {
        { int ln_ = LANEID(); asm volatile("" : "+v"(ln_)); fr = ln_ & 15; fq = ln_ >> 4; }
        const int row0 = u.pm * BM + wr * 64 + fr; const int col0 = u.pn * BM + wc * 32 + 8 * fq;
#pragma unroll
        for (int bj = 0; bj < 2; ++bj) {
            if (col0 + bj * HALF >= sig_col0) {
#pragma unroll
                for (int ai = 0; ai < 2; ++ai)
#pragma unroll
                    for (int m = 0; m < 4; ++m) { bf16_t* rowp = O + (size_t)(row0 + ai * HALF + m * 16) * ldc + col0;
                        f32x4 v0 = acc[ai][bj][m][0], v1 = acc[ai][bj][m][1];
#pragma unroll
                        for (int e = 0; e < 4; ++e) { v0[e] = __builtin_amdgcn_rcpf(1.f + __builtin_amdgcn_exp2f(-1.44269504f * v0[e])); v1[e] = __builtin_amdgcn_rcpf(1.f + __builtin_amdgcn_exp2f(-1.44269504f * v1[e])); }
                        u32x4 w; w.x = cvt_pk_bf16_t(v0[0], v0[1]); w.y = cvt_pk_bf16_t(v0[2], v0[3]); w.z = cvt_pk_bf16_t(v1[0], v1[1]); w.w = cvt_pk_bf16_t(v1[2], v1[3]);
                        *(u32x4*)(rowp + bj * HALF) = w; }
            } else {
#pragma unroll
                for (int ai = 0; ai < 2; ++ai)
#pragma unroll
                    for (int m = 0; m < 4; ++m) { bf16_t* rowp = O + (size_t)(row0 + ai * HALF + m * 16) * ldc + col0;
                        const f32x4 v0 = acc[ai][bj][m][0], v1 = acc[ai][bj][m][1];
                        u32x4 w; w.x = cvt_pk_bf16(v0[0], v0[1]); w.y = cvt_pk_bf16(v0[2], v0[3]); w.z = cvt_pk_bf16(v1[0], v1[1]); w.w = cvt_pk_bf16(v1[2], v1[3]);
                        *(u32x4*)(rowp + bj * HALF) = w; }
            }
        }
    }
};
}

typedef unsigned short bf16;
constexpr int T_ = 16384, S_ = 4096, NBATCH = 4, D_ = 1024, NCOL = 6824, NP = 6912, DEPTH_ = 2;
constexpr int C_QA = 0, C_KA = 256, C_VA = 320, C_QI = 384, C_KI = 640, C_WI = 672, C_QB = 680, C_KB = 936, C_VB = 1064,
              C_QC = 1192, C_KC = 1448, C_VC = 1704, C_QD = 1960, C_KD = 2216, C_VD = 2472, C_G = 2728;
constexpr int NTHR = 512, NWAVE = 8;
constexpr float ALPHA = 1.41421356237309515f;
constexpr float LN_EPS = 1e-5f;
constexpr size_t MiB = 1u << 20;
constexpr size_t WS_STATS = 1 * MiB  , WS_COLS = 1 * MiB + 512 * 1024  ;
constexpr size_t WS_CTL = 0, WS_WIN_T = 2 * MiB, WS_WOUT_T = 30 * MiB, WS_WQ_T = 34 * MiB, WS_WBR_T = 38 * MiB, WS_HB = 42 * MiB,
                 WS_P = 74 * MiB, WS_MIX = 74 * MiB  , WS_Q = 138 * MiB  , WS_YS = 290 * MiB, WS_MRG = 322 * MiB,
                 WS_MASK = 354 * MiB, WS_EID = 362 * MiB, WS_GATE = 370 * MiB, WS_KMEAN = 378 * MiB, WS_SKB = 379 * MiB, WS_UV = 380 * MiB, WS_END = 508 * MiB;
constexpr size_t WIN_T_BYTES = (size_t)NP * 1024 * 2;
constexpr int LDS_BYTES = 144 * 1024;

struct Params { const float* in[13]; float* out; unsigned char* ws; };

__device__ __forceinline__ float bf2f(bf16 v) { return __uint_as_float((unsigned)v << 16); }
__device__ __forceinline__ unsigned f2bf(float f) { unsigned u = __float_as_uint(f); return (u + 0x7fffu + ((u >> 16) & 1u)) >> 16; }
__device__ __forceinline__ unsigned pk2(float lo, float hi) { return f2bf(lo) | (f2bf(hi) << 16); }
__device__ __forceinline__ void unpack8(const uint4 v, float* o) {
    o[0] = __uint_as_float(v.x << 16); o[1] = __uint_as_float(v.x & 0xffff0000u); o[2] = __uint_as_float(v.y << 16); o[3] = __uint_as_float(v.y & 0xffff0000u);
    o[4] = __uint_as_float(v.z << 16); o[5] = __uint_as_float(v.z & 0xffff0000u); o[6] = __uint_as_float(v.w << 16); o[7] = __uint_as_float(v.w & 0xffff0000u);
}
__device__ __forceinline__ float wave_sum(float v) {
#pragma unroll
    for (int o = 32; o > 0; o >>= 1) v += __shfl_xor(v, o);
    return v;
}
__device__ __forceinline__ float wave_max(float v) {
#pragma unroll
    for (int o = 32; o > 0; o >>= 1) v = fmaxf(v, __shfl_xor(v, o));
    return v;
}
__device__ __forceinline__ int wave_sum_i(int v) {
#pragma unroll
    for (int o = 32; o > 0; o >>= 1) v += __shfl_xor(v, o);
    return v;
}
__device__ __forceinline__ float logsig(float x) { return fminf(x, 0.f) - log1pf(expf(-fabsf(x))); }

__device__ void transpose_items(int WV_, const float* W, int K, int N, bf16* WT, float* sm, int item0, int nitems_total, int item_stride,
                                const float* rs_g = nullptr, const float* rs_b = nullptr, float* colsum = nullptr, float* colbias = nullptr) {
    const int tid = LTID(WV_);
    const int nkb = K / 64, nnb = (N + 63) / 64;
    for (int it = item0; it < nkb * nnb; it += item_stride) {
        const int kb = it % nkb, nb = it / nkb, k0 = kb * 64, n0 = nb * 64;
        __syncthreads();
        for (int e = tid; e < 64 * 64; e += NTHR) { const int kk = e >> 6, nn = e & 63; sm[kk * 65 + nn] = (n0 + nn < N) ? W[(size_t)(k0 + kk) * N + n0 + nn] : 0.f; }
        __syncthreads();
        if (rs_g) {
            if (tid < 64) { float cs = 0.f, cb = 0.f;
                for (int kk = 0; kk < 64; ++kk) { const float w = sm[kk * 65 + tid]; cs += w * rs_g[k0 + kk]; cb += w * rs_b[k0 + kk]; }
                atomicAdd(colsum + n0 + tid, cs); atomicAdd(colbias + n0 + tid, cb); }
            __syncthreads();
            for (int e = tid; e < 64 * 64; e += NTHR) { const int kk = e >> 6, nn = e & 63; sm[kk * 65 + nn] *= rs_g[k0 + kk]; }
            __syncthreads();
        }
        { const int nn = tid >> 3, c = tid & 7;
          if (n0 + nn < N) { uint4 o; o.x = pk2(sm[(8 * c + 0) * 65 + nn], sm[(8 * c + 1) * 65 + nn]); o.y = pk2(sm[(8 * c + 2) * 65 + nn], sm[(8 * c + 3) * 65 + nn]);
              o.z = pk2(sm[(8 * c + 4) * 65 + nn], sm[(8 * c + 5) * 65 + nn]); o.w = pk2(sm[(8 * c + 6) * 65 + nn], sm[(8 * c + 7) * 65 + nn]);
              *(uint4*)(WT + (size_t)(n0 + nn) * K + k0 + 8 * c) = o; } }
    }
    __syncthreads();
}
constexpr int TI_WIN = 16 * ((NCOL + 63) / 64), TI_SQ = 256, TI_LAYER = TI_WIN + 3 * TI_SQ;
#define TITEM_DECODE(it_, W_, WT_, K_, N_, k0_, n0_, fold_, l_) do { \
        l_ = (it_) / TI_LAYER; const int r_ = (it_) - l_ * TI_LAYER; \
        const int kind_ = r_ < TI_WIN ? 0 : (r_ < TI_WIN + TI_SQ ? 1 : (r_ < TI_WIN + 2 * TI_SQ ? 2 : 3)); \
        const int q_ = r_ - (kind_ == 0 ? 0 : TI_WIN + (kind_ - 1) * TI_SQ); \
        fold_ = kind_ == 2; K_ = kind_ == 3 ? 256 : 1024; N_ = kind_ == 0 ? NCOL : 1024; \
        k0_ = kind_ == 3 ? (q_ & 3) * 64 : (q_ & 15) * 64; n0_ = kind_ == 3 ? ((q_ & 63) >> 2) * 64 : (q_ >> 4) * 64; \
        const int nbr_ = q_ >> 6; \
        W_ = kind_ == 0 ? pin1 + (size_t)l_ * 1024 * NCOL : kind_ == 1 ? pin3 + (size_t)l_ * 1024 * 1024 : kind_ == 2 ? pin7 + (size_t)l_ * 1024 * 1024 : pin2 + ((size_t)l_ * 4 + nbr_) * 256 * 1024; \
        WT_ = kind_ == 0 ? (bf16*)(ws + WS_WIN_T + l_ * WIN_T_BYTES) : kind_ == 1 ? (bf16*)(ws + WS_WOUT_T) + (size_t)l_ * 1024 * 1024 : kind_ == 2 ? (bf16*)(ws + WS_WQ_T) + (size_t)l_ * 1024 * 1024 \
              : (bf16*)(ws + WS_WBR_T) + ((size_t)l_ * 4 + nbr_) * 1024 * 256; } while (0)
__device__ __forceinline__ void titem_finish(bf16* WT, int K, int N, int k0, int n0, const float* rs_g, const float* rs_b, float* colsum, float* colbias, float* sm, int tid) {
    if (rs_g) {
        if (tid < 64) { float cs = 0.f, cb = 0.f;
            for (int kk = 0; kk < 64; ++kk) { const float w = sm[kk * 65 + tid]; cs += w * rs_g[k0 + kk]; cb += w * rs_b[k0 + kk]; }
            atomicAdd(colsum + n0 + tid, cs); atomicAdd(colbias + n0 + tid, cb); }
        __syncthreads();
        for (int e = tid; e < 64 * 64; e += NTHR) { const int kk = e >> 6, nn = e & 63; sm[kk * 65 + nn] *= rs_g[k0 + kk]; }
        __syncthreads();
    }
    { const int nn = tid >> 3, c = tid & 7;
      if (n0 + nn < N) { uint4 o; o.x = pk2(sm[(8 * c + 0) * 65 + nn], sm[(8 * c + 1) * 65 + nn]); o.y = pk2(sm[(8 * c + 2) * 65 + nn], sm[(8 * c + 3) * 65 + nn]);
          o.z = pk2(sm[(8 * c + 4) * 65 + nn], sm[(8 * c + 5) * 65 + nn]); o.w = pk2(sm[(8 * c + 6) * 65 + nn], sm[(8 * c + 7) * 65 + nn]);
          *(uint4*)(WT + (size_t)(n0 + nn) * K + k0 + 8 * c) = o; } }
}
__device__ void prologue_phase(int WV_, const Params& p, float* sm) {
    const int tid = LTID(WV_), B = LBID(), G = LGRID();
    unsigned char* ws = p.ws;
    float* sm1 = sm + 64 * 65;
    const float* pin1 = p.in[1]; const float* pin2 = p.in[2]; const float* pin3 = p.in[3]; const float* pin7 = p.in[7]; const float* pin5 = p.in[5]; const float* pin6 = p.in[6];
    asm volatile("" : "+s"(pin1), "+s"(pin2), "+s"(pin3), "+s"(pin7), "+s"(pin5), "+s"(pin6));
    const int kk0 = tid >> 4, c4 = tid & 15;
    for (int it = B; it < DEPTH_ * TI_LAYER; it += 2 * G) {
        const int it2 = it + G; const bool has2 = it2 < DEPTH_ * TI_LAYER;
        const float* Wa; const float* Wb; bf16* WTa; bf16* WTb; int Ka, Na, k0a, n0a, la, Kb, Nb, k0b, n0b, lb; bool fa, fb;
        TITEM_DECODE(it, Wa, WTa, Ka, Na, k0a, n0a, fa, la);
        { const int itb = has2 ? it2 : it; TITEM_DECODE(itb, Wb, WTb, Kb, Nb, k0b, n0b, fb, lb); }
        const float4 z4 = make_float4(0.f, 0.f, 0.f, 0.f);
        const bool ina = n0a + 4 * c4 < Na, inb = n0b + 4 * c4 < Nb;
        float4 a0 = z4, a1 = z4, b0 = z4, b1 = z4;
        if (ina) { a0 = *(const float4*)(Wa + (size_t)(k0a + kk0) * Na + n0a + 4 * c4); a1 = *(const float4*)(Wa + (size_t)(k0a + kk0 + 32) * Na + n0a + 4 * c4); }
        if (inb) { b0 = *(const float4*)(Wb + (size_t)(k0b + kk0) * Nb + n0b + 4 * c4); b1 = *(const float4*)(Wb + (size_t)(k0b + kk0 + 32) * Nb + n0b + 4 * c4); }
        __syncthreads();
        { float* d = sm + kk0 * 65 + 4 * c4; d[0] = a0.x; d[1] = a0.y; d[2] = a0.z; d[3] = a0.w; d += 32 * 65; d[0] = a1.x; d[1] = a1.y; d[2] = a1.z; d[3] = a1.w; }
        { float* d = sm1 + kk0 * 65 + 4 * c4; d[0] = b0.x; d[1] = b0.y; d[2] = b0.z; d[3] = b0.w; d += 32 * 65; d[0] = b1.x; d[1] = b1.y; d[2] = b1.z; d[3] = b1.w; }
        __syncthreads();
        titem_finish(WTa, Ka, Na, k0a, n0a, fa ? pin5 + la * 1024 : nullptr, pin6 + la * 1024, (float*)(ws + WS_COLS) + la * 2048, (float*)(ws + WS_COLS) + la * 2048 + 1024, sm, tid);
        if (has2) titem_finish(WTb, Kb, Nb, k0b, n0b, fb ? pin5 + lb * 1024 : nullptr, pin6 + lb * 1024, (float*)(ws + WS_COLS) + lb * 2048, (float*)(ws + WS_COLS) + lb * 2048 + 1024, sm1, tid);
    }
    __syncthreads();
    for (int l = 0; l < DEPTH_; ++l) {
        bf16* win_t = (bf16*)(ws + WS_WIN_T + l * WIN_T_BYTES);
        for (int i = B * NTHR + tid; i < (NP - NCOL) * 1024 / 8; i += G * NTHR) ((uint4*)(win_t + (size_t)NCOL * 1024))[i] = make_uint4(0u, 0u, 0u, 0u);
    }
    const float4* x4 = (const float4*)p.in[0]; uint2* hb2 = (uint2*)(ws + WS_HB);
    for (size_t i = (size_t)B * NTHR + tid; i < (size_t)T_ * 1024 / 4; i += (size_t)G * NTHR) { const float4 v = x4[i]; hb2[i] = make_uint2(pk2(v.x, v.y), pk2(v.z, v.w)); }
}

__device__ __forceinline__ void ln_row(float4 (&v)[4], const float* g, const float* bb, float* orow, bf16* obrow, int lane) {
    float s = 0.f;
#pragma unroll
    for (int j = 0; j < 4; ++j) s += (v[j].x + v[j].y) + (v[j].z + v[j].w);
    const float mean = wave_sum(s) * (1.0f / 1024.0f);
    float s2 = 0.f;
#pragma unroll
    for (int j = 0; j < 4; ++j) { v[j].x -= mean; v[j].y -= mean; v[j].z -= mean; v[j].w -= mean; s2 += (v[j].x * v[j].x + v[j].y * v[j].y) + (v[j].z * v[j].z + v[j].w * v[j].w); }
    const float rstd = 1.0f / sqrtf(wave_sum(s2) * (1.0f / 1024.0f) + LN_EPS);
#pragma unroll
    for (int j = 0; j < 4; ++j) {
        const float4 gg = ((const float4*)g)[j * 64 + lane], b4 = ((const float4*)bb)[j * 64 + lane];
        float4 o; o.x = v[j].x * rstd * gg.x + b4.x; o.y = v[j].y * rstd * gg.y + b4.y; o.z = v[j].z * rstd * gg.z + b4.z; o.w = v[j].w * rstd * gg.w + b4.w;
        ((float4*)orow)[j * 64 + lane] = o;
        ((uint2*)obrow)[j * 64 + lane] = make_uint2(pk2(o.x, o.y), pk2(o.z, o.w));
    }
}
__device__ void ln1_phase(int WV_, const float* hin, const float* add, const float* g, const float* bb, float* hout, bf16* hb) {
    const int lane = LTID(WV_) & 63, wave = LTID(WV_) >> 6;
    for (int row = LBID() * NWAVE + wave; row < T_; row += LGRID() * NWAVE) {
        float4 v[4];
#pragma unroll
        for (int j = 0; j < 4; ++j) {
            const float4 a = ((const float4*)(hin + (size_t)row * 1024))[j * 64 + lane], m = ((const float4*)(add + (size_t)row * 1024))[j * 64 + lane];
            v[j].x = ALPHA * a.x + m.x; v[j].y = ALPHA * a.y + m.y; v[j].z = ALPHA * a.z + m.z; v[j].w = ALPHA * a.w + m.w;
        }
        ln_row(v, g, bb, hout + (size_t)row * 1024, hb + (size_t)row * 1024, lane);
    }
}


typedef short bf16x8_t __attribute__((ext_vector_type(8)));
typedef float f32x16_t __attribute__((ext_vector_type(16)));
typedef float f32x2_t __attribute__((ext_vector_type(2)));
typedef __bf16 bf16x2_t __attribute__((ext_vector_type(2)));
__device__ __forceinline__ unsigned cvtpk(float lo, float hi) { f32x2_t v = {lo, hi}; bf16x2_t b = __builtin_convertvector(v, bf16x2_t); return __builtin_bit_cast(unsigned, b); }
__device__ __forceinline__ int crow(int r, int hi) { return (r & 3) + 8 * (r >> 2) + 4 * hi; }
__device__ __forceinline__ float xlane32(float v) { return __shfl_xor(v, 32); }
__device__ __forceinline__ float vmax(float a, float b) { float r; asm("v_max_f32_e32 %0, %1, %2" : "=v"(r) : "v"(a), "v"(b)); return r; }
__device__ __forceinline__ float vmin(float a, float b) { float r; asm("v_min_f32_e32 %0, %1, %2" : "=v"(r) : "v"(a), "v"(b)); return r; }
__device__ __forceinline__ float vmax3(float a, float b, float c) { float r; asm("v_max3_f32 %0, %1, %2, %3" : "=v"(r) : "v"(a), "v"(b), "v"(c)); return r; }

constexpr int AT_KP = 72, AT_VP = 96;
constexpr int AT_KS = 0, AT_KS_BYTES = 64 * AT_KP * 2;
constexpr int AT_VT = 2 * AT_KS_BYTES, AT_VT_BYTES = 64 * AT_VP * 2;
constexpr int AT_KM = AT_VT + 2 * AT_VT_BYTES;
constexpr int AT_MISC = AT_KM + 32 * AT_KP * 2;
constexpr float LOG2E = 1.4426950408889634f;

__device__ __forceinline__ unsigned mk_unit(int kind, int b, int x, int y) { return ((unsigned)kind << 30) | ((unsigned)b << 28) | ((unsigned)x << 8) | (unsigned)y; }
__device__ void build_unit_table(unsigned* tab, int i) {
    int n = 0; unsigned res = 0u;
#pragma unroll 1
    for (int c = 64; c >= 1; --c) {
        if (i >= n && i < n + 4) res = mk_unit(0, i - n, 0, c - 1);
        n += 4;
        if ((c & 3) == 0) { if (i >= n && i < n + 16) { const int j = i - n; res = mk_unit(2, j >> 2, j & 3, c / 4 - 1); } n += 16; }
    }
    if (i < 512) tab[i] = res;
}

template <int kind> __device__ __forceinline__ void attn_unit(int WV_, const bf16* P, const unsigned char* mask, const float* kmean, const float* sinks, bf16* ys,
                                unsigned char* lds, int b, int ux, int uy) {
    int tid_ = LTID(WV_); asm volatile("" : "+v"(tid_));
    const int tid = tid_, lane = tid & 63, wave = __builtin_amdgcn_readfirstlane(tid >> 6), r32 = lane & 31, hi = lane >> 5;
    bf16* s_km = (bf16*)(lds + AT_KM);
    const int skey = tid >> 3, sc = tid & 7;
    {
        const bf16* Pb = P + (size_t)b * S_ * NP;
        int q0w, qcol, kcol, vcol, ycol, kt_hi, kt_lo; float slope2 = 0.f, sink2 = 0.f;
        if (kind == 0) { const int head = wave >> 1; q0w = uy * 64 + (wave & 1) * 32; qcol = C_QA + head * 64; kcol = C_KA; vcol = C_VA; ycol = head * 64;
            slope2 = exp2f(-8.0f * (float)(3 * head + 1) / 12.0f) * LOG2E; kt_hi = uy; kt_lo = 0; }
        else if (kind == 1) { const int hq = ux * 2 + (wave >> 2); q0w = uy * 128 + (wave & 3) * 32; qcol = C_QB + hq * 64; kcol = C_KB + ux * 64; vcol = C_VB + ux * 64; ycol = 256 + hq * 64;
            slope2 = exp2f(-8.0f * (float)(3 * hq + 2) / 12.0f) * LOG2E; sink2 = sinks[hq] * LOG2E; kt_hi = 2 * uy + 1; kt_lo = (2 * uy - 2 > 0) ? 2 * uy - 2 : 0; }
        else if (kind == 2) { q0w = uy * 256 + wave * 32; qcol = C_QC + ux * 64; kcol = C_KC + ux * 64; vcol = C_VC + ux * 64; ycol = 512 + ux * 64;
            slope2 = exp2f(-8.0f * (float)(3 * ux + 3) / 12.0f) * LOG2E; kt_hi = 4 * uy + 3; kt_lo = 0; }
        else { q0w = uy * 256 + wave * 32; qcol = C_QD + ux * 64; kcol = C_KD + ux * 64; vcol = C_VD + ux * 64; ycol = 768 + ux * 64; kt_hi = 4 * uy + 3; kt_lo = 0; }
        const int qpos = q0w + r32;
        bf16x8_t qf[4];
        { const bf16* qp = Pb + (size_t)qpos * NP + qcol + 8 * hi;
#pragma unroll
          for (int ks = 0; ks < 4; ++ks) qf[ks] = *(const bf16x8_t*)(qp + 16 * ks); }
        {
            const float qs = (kind == 3) ? 0.125f : 0.125f * LOG2E;
            typedef unsigned u32x4_t __attribute__((ext_vector_type(4)));
#pragma unroll
            for (int ks = 0; ks < 4; ++ks) { u32x4_t w = __builtin_bit_cast(u32x4_t, qf[ks]);
#pragma unroll
                for (int i = 0; i < 4; ++i) w[i] = cvtpk(__uint_as_float(w[i] << 16) * qs, __uint_as_float(w[i] & 0xffff0000u) * qs);
                qf[ks] = __builtin_bit_cast(bf16x8_t, w); }
        }
        float sb[16];
#pragma unroll
        for (int r = 0; r < 16; ++r) sb[r] = slope2 * (float)((r & 3) + 8 * (r >> 2));
        unsigned bm = 0u;
        if (kind == 2) {
            const int own = uy;
            for (int e = tid; e < 32 * 64; e += NTHR) { const int row = e >> 6, d = e & 63; s_km[row * AT_KP + d] = (row < 16) ? (bf16)f2bf(kmean[((b * 4 + ux) * 16 + row) * 64 + d]) : (bf16)0; }
            __syncthreads();
            f32x16_t gacc;
#pragma unroll
            for (int r = 0; r < 16; ++r) gacc[r] = 0.f;
#pragma unroll
            for (int ks = 0; ks < 4; ++ks) { const bf16x8_t a = *(const bf16x8_t*)(s_km + r32 * AT_KP + 16 * ks + 8 * hi); gacc = __builtin_amdgcn_mfma_f32_32x32x16_bf16(a, qf[ks], gacc, 0, 0, 0); }
            float gt[16];
#pragma unroll
            for (int r = 0; r < 8; ++r) { const float mine = gacc[r], other = xlane32(mine); const int bi = crow(r, 0);
                gt[bi] = hi ? other : mine; gt[bi + 4] = hi ? mine : other; }
#pragma unroll
            for (int n = 0; n < 16; ++n) if (n >= own) gt[n] = -INFINITY;
#pragma unroll
            for (int rep = 0; rep < 3; ++rep) {
                float mx = -INFINITY;
#pragma unroll
                for (int n = 0; n < 16; ++n) mx = fmaxf(mx, gt[n]);
                bool done = !(mx > -INFINITY);
#pragma unroll
                for (int n = 0; n < 16; ++n) { const bool hit = !done && gt[n] == mx; if (hit) { bm |= 1u << n; gt[n] = -INFINITY; done = true; } }
            }
        }
        f32x16_t o0, o1;
#pragma unroll
        for (int r = 0; r < 16; ++r) { o0[r] = 0.f; o1[r] = 0.f; }
        float m_run = -INFINITY, l_run = 0.f, carry = 0.f;
        const bf16* kg = Pb + (size_t)skey * NP + kcol + sc * 8;
        const bf16* vg = Pb + (size_t)skey * NP + vcol + sc * 8;
        uint4 rk = *(const uint4*)(kg + (size_t)kt_hi * 64 * NP), rv = *(const uint4*)(vg + (size_t)kt_hi * 64 * NP);
        int buf = 0;
        { bf16* ks_ = (bf16*)(lds + AT_KS); bf16* vt_ = (bf16*)(lds + AT_VT);
          *(uint4*)(ks_ + skey * AT_KP + sc * 8) = rk;
          *(uint4*)(vt_ + skey * AT_VP + sc * 8) = rv; }
        __syncthreads();
        bool wave_done = false;
        uint2 mw_next = make_uint2(0u, 0u);
        if (kind == 0) mw_next = *(const uint2*)(mask + (size_t)(b * S_ + qpos) * 512 + kt_hi * 8);
        for (int kt = kt_hi; kt >= kt_lo; --kt) {
            const bool more = kt > kt_lo;
            const uint2 mw = mw_next;
            if (kind == 0 && more) mw_next = *(const uint2*)(mask + (size_t)(b * S_ + qpos) * 512 + (kt - 1) * 8);
            if (more) { rk = *(const uint4*)(kg + (size_t)(kt - 1) * 64 * NP); rv = *(const uint4*)(vg + (size_t)(kt - 1) * 64 * NP); }
            const bf16* ks_ = (const bf16*)(lds + AT_KS + buf * AT_KS_BYTES);
            const bf16* vt_ = (const bf16*)(lds + AT_VT + buf * AT_VT_BYTES);
            bool active = (kt * 64 <= q0w + 31) && !wave_done;
            if (kind == 1) active = active && (kt * 64 + 63 >= q0w - 127);
            if (active) {
                const int kbase = kt * 64 + 4 * hi;
                f32x16_t p0, p1;
                if (kind != 3) {
                    const float cb = slope2 * (float)(kbase - qpos), cb1 = cb + 32.0f * slope2;
#pragma unroll
                    for (int r = 0; r < 16; ++r) { p0[r] = cb + sb[r]; p1[r] = cb1 + sb[r]; }
                } else {
#pragma unroll
                    for (int r = 0; r < 16; ++r) { p0[r] = 0.f; p1[r] = 0.f; }
                }
#pragma unroll
                for (int ks = 0; ks < 4; ++ks) {
                    const bf16x8_t a0 = *(const bf16x8_t*)(ks_ + r32 * AT_KP + 16 * ks + 8 * hi);
                    const bf16x8_t a1 = *(const bf16x8_t*)(ks_ + (32 + r32) * AT_KP + 16 * ks + 8 * hi);
                    p0 = __builtin_amdgcn_mfma_f32_32x32x16_bf16(a0, qf[ks], p0, 0, 0, 0);
                    p1 = __builtin_amdgcn_mfma_f32_32x32x16_bf16(a1, qf[ks], p1, 0, 0, 0);
                }
                if (kind != 3) {
                    float mx = -INFINITY;
                    if (kind == 0) {
                        const unsigned w0 = mw.x >> (4 * hi), w1 = mw.y >> (4 * hi);
#pragma unroll
                        for (int r = 0; r < 16; ++r) { const int off = (r & 3) + 8 * (r >> 2);
                            p0[r] = (w0 & (1u << off)) ? p0[r] : -INFINITY; p1[r] = (w1 & (1u << off)) ? p1[r] : -INFINITY; mx = vmax3(mx, p0[r], p1[r]); }
                    } else if (kind == 1) {
                        const int rel = qpos - kbase;
#pragma unroll
                        for (int r = 0; r < 16; ++r) { const int off = (r & 3) + 8 * (r >> 2);
                            p0[r] = ((unsigned)(rel - off) < 128u) ? p0[r] : -INFINITY; p1[r] = ((unsigned)(rel - off - 32) < 128u) ? p1[r] : -INFINITY; mx = vmax3(mx, p0[r], p1[r]); }
                    } else {
                        if ((kt >> 2) == uy) {
                            const int rel = qpos - kbase;
#pragma unroll
                            for (int r = 0; r < 16; ++r) { const int off = (r & 3) + 8 * (r >> 2);
                                p0[r] = (off <= rel) ? p0[r] : -INFINITY; p1[r] = (off + 32 <= rel) ? p1[r] : -INFINITY; mx = vmax3(mx, p0[r], p1[r]); }
                        } else {
                            const bool tile_ok = ((bm >> (kt >> 2)) & 1u) != 0u;
#pragma unroll
                            for (int r = 0; r < 16; ++r) { p0[r] = tile_ok ? p0[r] : -INFINITY; p1[r] = tile_ok ? p1[r] : -INFINITY; mx = vmax3(mx, p0[r], p1[r]); }
                        }
                    }
                    mx = vmax(mx, xlane32(mx));
                    const float m_new = vmax(m_run, mx);
                    const float m_safe = (m_new == -INFINITY) ? 0.f : m_new;
                    p0 = p0 - m_safe; p1 = p1 - m_safe;
#pragma unroll
                    for (int r = 0; r < 16; ++r) { p0[r] = __builtin_amdgcn_exp2f(p0[r]); p1[r] = __builtin_amdgcn_exp2f(p1[r]); }
                    float ls;
                    { typedef float f32x8_t __attribute__((ext_vector_type(8))); typedef float f32x4v_t __attribute__((ext_vector_type(4)));
                      const f32x16_t t16 = p0 + p1; const f32x8_t t8 = t16.lo + t16.hi; const f32x4v_t t4 = t8.lo + t8.hi; const f32x2_t t2 = t4.lo + t4.hi; ls = t2.x + t2.y; }
                    if (__any(m_new > m_run)) {
                        const float alpha = __builtin_amdgcn_exp2f(m_run - m_safe);
                        l_run *= alpha;
                        o0 = o0 * alpha; o1 = o1 * alpha;
                    }
                    l_run += ls; m_run = m_new;
                } else {
                    float run = carry;
#define SB_HALF(PX, KOFF) do { \
                    float lk[16]; \
                    _Pragma("unroll") for (int r = 0; r < 16; ++r) { \
                        const int off = (r & 3) + 8 * (r >> 2); \
                        const bool v = (kbase + off + (KOFF)) < qpos; \
                        const float z = PX[r]; \
                        const float t = 0.6931471805599453f * __builtin_amdgcn_logf(1.0f + __builtin_amdgcn_exp2f(-LOG2E * fabsf(z))); \
                        lk[r] = v ? (fminf(-z, 0.f) - t) : 0.f; \
                        PX[r] = v ? (fminf(z, 0.f) - t) : -INFINITY; } \
                    _Pragma("unroll") for (int g = 3; g >= 0; --g) { \
                        const float G = (lk[4 * g] + lk[4 * g + 1]) + (lk[4 * g + 2] + lk[4 * g + 3]); \
                        const float PG = xlane32(G); \
                        float la = run + (hi ? 0.f : PG); \
                        run += G + PG; \
                        PX[4 * g + 3] += la; la += lk[4 * g + 3]; PX[4 * g + 2] += la; la += lk[4 * g + 2]; PX[4 * g + 1] += la; la += lk[4 * g + 1]; PX[4 * g] += la; } \
                    _Pragma("unroll") for (int r = 0; r < 16; ++r) PX[r] = __builtin_amdgcn_exp2f(LOG2E * PX[r]); } while (0)
                    SB_HALF(p1, 32);
                    SB_HALF(p0, 0);
#undef SB_HALF
                    carry = run;
                }
                unsigned pw[16];
#pragma unroll
                for (int j = 0; j < 8; ++j) { pw[j] = cvtpk(p0[2 * j], p0[2 * j + 1]); pw[8 + j] = cvtpk(p1[2 * j], p1[2 * j + 1]); }
#pragma unroll
                for (int s = 0; s < 4; ++s) {
                    bf16x8_t pb; { const unsigned* q = pw + 4 * s; typedef unsigned u32x4_t __attribute__((ext_vector_type(4))); u32x4_t t4 = {q[0], q[1], q[2], q[3]}; pb = __builtin_bit_cast(bf16x8_t, t4); }
#pragma unroll
                    for (int dt = 0; dt < 2; ++dt) {
                        typedef short s16x4_t __attribute__((ext_vector_type(4)));
                        typedef __attribute__((address_space(3))) s16x4_t lds_s16x4;
                        const int gi_ = lane & 15;
                        const bf16* vp = vt_ + (16 * s + 4 * hi + (gi_ >> 2)) * AT_VP + 32 * dt + 16 * ((lane >> 4) & 1) + 4 * (gi_ & 3);
                        const s16x4_t lo = __builtin_amdgcn_ds_read_tr16_b64_v4i16((lds_s16x4*)vp), hi4 = __builtin_amdgcn_ds_read_tr16_b64_v4i16((lds_s16x4*)(vp + 8 * AT_VP));
                        const bf16x8_t va = {lo[0], lo[1], lo[2], lo[3], hi4[0], hi4[1], hi4[2], hi4[3]};
                        if (dt == 0) o0 = __builtin_amdgcn_mfma_f32_32x32x16_bf16(va, pb, o0, 0, 0, 0);
                        else         o1 = __builtin_amdgcn_mfma_f32_32x32x16_bf16(va, pb, o1, 0, 0, 0);
                    }
                }
            }
            if (kind == 3) {
                const float cm = carry;
                if (__all(cm < -110.0f) || !(kt * 64 <= q0w + 31) ) { if (__all(cm < -110.0f)) wave_done = true; }
            }
            if (more) {
                bf16* ksn = (bf16*)(lds + AT_KS + (buf ^ 1) * AT_KS_BYTES); bf16* vtn = (bf16*)(lds + AT_VT + (buf ^ 1) * AT_VT_BYTES);
                *(uint4*)(ksn + skey * AT_KP + sc * 8) = rk;
                *(uint4*)(vtn + skey * AT_VP + sc * 8) = rv;
            }
            if (kind == 3) { if (__syncthreads_and(wave_done ? 1 : 0)) break; }
            else __syncthreads();
            buf ^= 1;
        }
        float inv;
        if (kind == 3) inv = 1.0f;
        else {
            float lt = l_run + xlane32(l_run);
            if (kind == 1) { const float mf = fmaxf(m_run, sink2); const float sc2 = exp2f(m_run - mf); lt = lt * sc2 + exp2f(sink2 - mf); inv = sc2 / lt; }
            else inv = 1.0f / lt;
        }
        bf16* yp = ys + (size_t)(b * S_ + qpos) * 1024 + ycol + 4 * hi;
#pragma unroll
        for (int g = 0; g < 4; ++g) {
            *(uint2*)(yp + 8 * g) = make_uint2(cvtpk(o0[4 * g] * inv, o0[4 * g + 1] * inv), cvtpk(o0[4 * g + 2] * inv, o0[4 * g + 3] * inv));
            *(uint2*)(yp + 32 + 8 * g) = make_uint2(cvtpk(o1[4 * g] * inv, o1[4 * g + 1] * inv), cvtpk(o1[4 * g + 2] * inv, o1[4 * g + 3] * inv));
        }
    }
}
__device__ void attn_fast_phase(int WV_, const bf16* P, const unsigned char* mask, const float* kmean, const float* sinks, bf16* ys,
                                const unsigned* utab, unsigned* counter, unsigned char* lds) {
    volatile unsigned* s_unit = (volatile unsigned*)(lds + AT_MISC);
    for (;;) {
        __syncthreads();
        if (LTID(WV_) == 0) s_unit[0] = atomicAdd(counter, 1u);
        __syncthreads();
        const unsigned ui = s_unit[0];
        if (ui >= 512u) break;
        const unsigned ue = utab[ui];
        const int kind = (int)(ue >> 30), b = (int)((ue >> 28) & 3u), ux = (int)((ue >> 8) & 255u), uy = (int)(ue & 255u);
        if (kind == 0) attn_unit<0>(WV_, P, mask, kmean, sinks, ys, lds, b, ux, uy);
        else attn_unit<2>(WV_, P, mask, kmean, sinks, ys, lds, b, ux, uy);
    }
    for (int u = LBID(); u < 256; u += LGRID()) { __syncthreads(); attn_unit<3>(WV_, P, mask, kmean, sinks, ys, lds, u >> 6, (u >> 4) & 3, u & 15); }
    for (int u = LBID(); u < 256; u += LGRID()) { __syncthreads(); attn_unit<1>(WV_, P, mask, kmean, sinks, ys, lds, u >> 6, (u >> 5) & 1, u & 31); }
}

constexpr float U_SCALE = 128.0f, V_SCALE = 48.0f;
constexpr int ROW6 = 1536;
typedef float v32f_t __attribute__((ext_vector_type(32)));
typedef unsigned v6u_t __attribute__((ext_vector_type(6)));
typedef unsigned u32x4a8_t __attribute__((ext_vector_type(4), aligned(8)));
__device__ __forceinline__ float rdlane_f(float v, int l) { return __builtin_bit_cast(float, __builtin_amdgcn_readlane(__builtin_bit_cast(int, v), l)); }
__device__ __forceinline__ unsigned q_e2m3(float v) {
    const float a = fminf(fabsf(v), 7.5f);
    unsigned code;
    if (a < 1.0f) code = (unsigned)rintf(a * 8.0f);
    else if (a < 2.0f) code = 8u + (unsigned)rintf((a - 1.0f) * 8.0f);
    else if (a < 4.0f) code = 16u + (unsigned)rintf((a - 2.0f) * 4.0f);
    else code = 24u + (unsigned)rintf((a - 4.0f) * 2.0f);
    return code | (v < 0.f ? 32u : 0u);
}
__device__ __forceinline__ void cvt_chunk6(const float4 (&a)[8], float sc, unsigned (&w)[6]) {
#pragma unroll
    for (int d = 0; d < 6; ++d) w[d] = 0u;
#pragma unroll
    for (int q4 = 0; q4 < 8; ++q4) {
        const float av[4] = {a[q4].x, a[q4].y, a[q4].z, a[q4].w};
#pragma unroll
        for (int e = 0; e < 4; ++e) { const int idx = q4 * 4 + e, bit = 6 * idx, d = bit >> 5, sft = bit & 31; const unsigned code = q_e2m3(av[e] * sc);
            w[d] |= code << sft; if (sft > 26) w[d + 1] |= code >> (32 - sft); }
    }
}
__device__ void convert_tables(int WV_, const Params& p) {
    const size_t nchunk = (size_t)DEPTH_ * 16384 * 2 * 32;
    const size_t stride = (size_t)LGRID() * NTHR;
    for (size_t i = (size_t)LBID() * NTHR + LTID(WV_); i < nchunk; i += 2 * stride) {
        const size_t i2 = i + stride; const bool has2 = i2 < nchunk; const size_t j2 = has2 ? i2 : i;
        const int c0 = (int)(i & 31), uv0 = (int)((i >> 5) & 1); const size_t le0 = i >> 6;
        const int c1 = (int)(j2 & 31), uv1 = (int)((j2 >> 5) & 1); const size_t le1 = j2 >> 6;
        const float* src0 = (uv0 ? p.in[10] : p.in[9]) + le0 * 1024 + c0 * 32;
        const float* src1 = (uv1 ? p.in[10] : p.in[9]) + le1 * 1024 + c1 * 32;
        float4 a0[8], a1[8];
#pragma unroll
        for (int q4 = 0; q4 < 8; ++q4) a0[q4] = ((const float4*)src0)[q4];
#pragma unroll
        for (int q4 = 0; q4 < 8; ++q4) a1[q4] = ((const float4*)src1)[q4];
        unsigned w0[6], w1[6];
        cvt_chunk6(a0, uv0 ? V_SCALE : U_SCALE, w0);
        cvt_chunk6(a1, uv1 ? V_SCALE : U_SCALE, w1);
        uint2* dst0 = (uint2*)(p.ws + WS_UV + le0 * ROW6 + uv0 * 768 + c0 * 24);
        dst0[0] = make_uint2(w0[0], w0[1]); dst0[1] = make_uint2(w0[2], w0[3]); dst0[2] = make_uint2(w0[4], w0[5]);
        if (has2) { uint2* dst1 = (uint2*)(p.ws + WS_UV + le1 * ROW6 + uv1 * 768 + c1 * 24);
            dst1[0] = make_uint2(w1[0], w1[1]); dst1[1] = make_uint2(w1[2], w1[3]); dst1[2] = make_uint2(w1[4], w1[5]); }
    }
}
__device__ __forceinline__ v6u_t ld_pk6(const unsigned char* ptr) {
    const uint2 a = ((const uint2*)ptr)[0], b = ((const uint2*)ptr)[1], c = ((const uint2*)ptr)[2];
    const v6u_t pk = {a.x, a.y, b.x, b.y, c.x, c.y};
    return pk;
}
__device__ void peer_fast_phase(int WV_, float* h, bf16* hb, const int* eid, const float* gate, const unsigned char* uv, const float* g1, const float* b1, const float* g, const float* bb, unsigned char* lds) {
    const int tid = LTID(WV_), lane = tid & 63, wave = tid >> 6, l32 = lane & 31, hi = lane >> 5;
    float* pl = (float*)(lds + wave * 16384);
    unsigned char* raw = lds + wave * 16384 + 4096 + lane * 24;
    for (int t = LBID() * NWAVE + wave; t < T_; t += LGRID() * NWAVE) {
        float* hr = h + (size_t)t * 1024 + l32 * 32;
        float x[32], acc[32];
#pragma unroll
        for (int q4 = 0; q4 < 8; ++q4) { const float4 a = ((const float4*)hr)[q4]; x[4 * q4] = a.x; x[4 * q4 + 1] = a.y; x[4 * q4 + 2] = a.z; x[4 * q4 + 3] = a.w; }
        {
            float s = 0.f;
#pragma unroll
            for (int i = 0; i < 32; ++i) s += x[i];
#pragma unroll
            for (int o = 16; o > 0; o >>= 1) s += __shfl_xor(s, o);
            const float mean = s * (1.0f / 1024.0f);
            float s2 = 0.f;
#pragma unroll
            for (int i = 0; i < 32; ++i) { x[i] -= mean; s2 += x[i] * x[i]; }
#pragma unroll
            for (int o = 16; o > 0; o >>= 1) s2 += __shfl_xor(s2, o);
            const float rstd = 1.0f / sqrtf(s2 * (1.0f / 1024.0f) + LN_EPS);
#pragma unroll
            for (int q4 = 0; q4 < 8; ++q4) { const float4 gg = ((const float4*)(g1 + l32 * 32))[q4], cc = ((const float4*)(b1 + l32 * 32))[q4];
                x[4 * q4] = x[4 * q4] * rstd * gg.x + cc.x; x[4 * q4 + 1] = x[4 * q4 + 1] * rstd * gg.y + cc.y; x[4 * q4 + 2] = x[4 * q4 + 2] * rstd * gg.z + cc.z; x[4 * q4 + 3] = x[4 * q4 + 3] * rstd * gg.w + cc.w; }
        }
#pragma unroll
        for (int i = 0; i < 32; ++i) acc[i] = 0.f;
#pragma unroll 1
        for (int batch = 0; batch < 4; ++batch) {
            const int my_eid = eid[(size_t)t * 128 + batch * 32 + l32];
            const float my_gate = gate[(size_t)t * 128 + batch * 32 + l32];
#pragma unroll 1
            for (int grp = 0; grp < 2; ++grp) {
                { u32x4a8_t pa[8]; uint2 pc[8];
#pragma unroll
                  for (int i = 0; i < 8; ++i) { const int id = __shfl(my_eid, 2 * (grp * 8 + i) + hi); const unsigned char* rp = uv + (size_t)id * ROW6 + l32 * 24; pa[i] = *(const u32x4a8_t*)rp; pc[i] = *(const uint2*)(rp + 16); }
#pragma unroll
                  for (int i = 0; i < 8; ++i) { uint2* wp = (uint2*)(raw + i * 1536); wp[0] = make_uint2(pa[i].x, pa[i].y); wp[1] = make_uint2(pa[i].z, pa[i].w); wp[2] = pc[i]; } }
#pragma unroll 1
                for (int i = 0; i < 8; ++i) {
                    const uint2* rp = (const uint2*)(raw + i * 1536); const uint2 a = rp[0], b = rp[1], c = rp[2];
                    const v6u_t pk6 = {a.x, a.y, b.x, b.y, c.x, c.y}; const v32f_t f = __builtin_amdgcn_cvt_scalef32_pk32_f32_fp6(pk6, 1.0f);
                    f32x2_t dv0 = {0.f, 0.f}, dv1 = {0.f, 0.f};
#pragma unroll
                    for (int j = 0; j < 8; ++j) { const f32x2_t fa = {f[2 * j], f[2 * j + 1]}, fb = {f[16 + 2 * j], f[17 + 2 * j]}, xa = {x[2 * j], x[2 * j + 1]}, xb = {x[16 + 2 * j], x[17 + 2 * j]};
                        dv0 = fa * xa + dv0; dv1 = fb * xb + dv1; }
                    pl[(2 * (grp * 8 + i) + hi) * 32 + l32] = (dv0.x + dv0.y) + (dv1.x + dv1.y);
                }
            }
            float d;
            { const float4* pr = (const float4*)(pl + l32 * 32); float4 s4 = pr[0];
#pragma unroll
              for (int i = 1; i < 8; ++i) { const float4 v = pr[i]; s4.x += v.x; s4.y += v.y; s4.z += v.z; s4.w += v.w; }
              d = ((s4.x + s4.y) + (s4.z + s4.w)) * (1.0f / U_SCALE); }
            const float hv = 0.5f * d * (1.0f + erff(d * 0.70710678118654752f)) * my_gate * (1.0f / V_SCALE);
#pragma unroll 1
            for (int grp = 0; grp < 2; ++grp) {
                { u32x4a8_t pa[8]; uint2 pc[8];
#pragma unroll
                  for (int i = 0; i < 8; ++i) { const int id = __shfl(my_eid, 2 * (grp * 8 + i) + hi); const unsigned char* rp = uv + (size_t)id * ROW6 + 768 + l32 * 24; pa[i] = *(const u32x4a8_t*)rp; pc[i] = *(const uint2*)(rp + 16); }
#pragma unroll
                  for (int i = 0; i < 8; ++i) { uint2* wp = (uint2*)(raw + i * 1536); wp[0] = make_uint2(pa[i].x, pa[i].y); wp[1] = make_uint2(pa[i].z, pa[i].w); wp[2] = pc[i]; } }
#pragma unroll 1
                for (int i = 0; i < 8; ++i) {
                    const float c = __shfl(hv, 2 * (grp * 8 + i) + hi);
                    const uint2* rp = (const uint2*)(raw + i * 1536); const uint2 a = rp[0], b = rp[1], cc = rp[2];
                    const v6u_t pk6 = {a.x, a.y, b.x, b.y, cc.x, cc.y}; const v32f_t f = __builtin_amdgcn_cvt_scalef32_pk32_f32_fp6(pk6, 1.0f);
                    const f32x2_t c2 = {c, c};
#pragma unroll
                    for (int j = 0; j < 16; ++j) { const f32x2_t fj = {f[2 * j], f[2 * j + 1]}; f32x2_t aj = {acc[2 * j], acc[2 * j + 1]}; aj = fj * c2 + aj; acc[2 * j] = aj.x; acc[2 * j + 1] = aj.y; }
                }
            }
        }
        float y[32], s = 0.f;
#pragma unroll
        for (int i = 0; i < 32; ++i) { acc[i] += __shfl_xor(acc[i], 32); y[i] = ALPHA * x[i] + acc[i]; s += y[i]; }
#pragma unroll
        for (int o = 16; o > 0; o >>= 1) s += __shfl_xor(s, o);
        const float mean = s * (1.0f / 1024.0f);
        float s2 = 0.f;
#pragma unroll
        for (int i = 0; i < 32; ++i) { y[i] -= mean; s2 += y[i] * y[i]; }
#pragma unroll
        for (int o = 16; o > 0; o >>= 1) s2 += __shfl_xor(s2, o);
        const float rstd = 1.0f / sqrtf(s2 * (1.0f / 1024.0f) + LN_EPS);
        float o[16];
#pragma unroll
        for (int q4 = 0; q4 < 4; ++q4) {
            const float4 gg = ((const float4*)(g + l32 * 32 + hi * 16))[q4], cc = ((const float4*)(bb + l32 * 32 + hi * 16))[q4];
            float ya[4], yb2[4];
#pragma unroll
            for (int e = 0; e < 4; ++e) { ya[e] = y[4 * q4 + e]; yb2[e] = y[16 + 4 * q4 + e]; }
            asm volatile("" : "+v"(ya[0]), "+v"(ya[1]), "+v"(ya[2]), "+v"(ya[3]), "+v"(yb2[0]), "+v"(yb2[1]), "+v"(yb2[2]), "+v"(yb2[3]));
            const float y0 = hi ? yb2[0] : ya[0], y1 = hi ? yb2[1] : ya[1], y2 = hi ? yb2[2] : ya[2], y3 = hi ? yb2[3] : ya[3];
            o[4 * q4] = y0 * rstd * gg.x + cc.x; o[4 * q4 + 1] = y1 * rstd * gg.y + cc.y; o[4 * q4 + 2] = y2 * rstd * gg.z + cc.z; o[4 * q4 + 3] = y3 * rstd * gg.w + cc.w;
            ((float4*)(hr + hi * 16))[q4] = make_float4(o[4 * q4], o[4 * q4 + 1], o[4 * q4 + 2], o[4 * q4 + 3]);
        }
        uint4* hbp = (uint4*)(hb + (size_t)t * 1024 + l32 * 32 + hi * 16);
        hbp[0] = make_uint4(pk2(o[0], o[1]), pk2(o[2], o[3]), pk2(o[4], o[5]), pk2(o[6], o[7]));
        hbp[1] = make_uint4(pk2(o[8], o[9]), pk2(o[10], o[11]), pk2(o[12], o[13]), pk2(o[14], o[15]));
    }
}

__device__ __forceinline__ float pack_pl(float v, unsigned pl) { return __uint_as_float((__float_as_uint(v) & ~127u) | pl); }
__device__ __forceinline__ void ins16(float (&s)[16], float x) {
#pragma unroll
    for (int k = 15; k >= 1; --k) s[k] = __builtin_amdgcn_fmed3f(s[k - 1], x, s[k]);
    s[0] = vmax(s[0], x);
}
template <int D> __device__ __forceinline__ void bitonic_stage(float (&c)[16]) {
#pragma unroll
    for (int i = 0; i < 16; ++i) if ((i & D) == 0) { const float a = vmax(c[i], c[i + D]), b = vmin(c[i], c[i + D]); c[i] = a; c[i + D] = b; }
}
__device__ __forceinline__ int decode_key(unsigned pl) { return (int)(32u * ((pl >> 4) & 3u) + (pl & 3u) + 8u * ((pl >> 2) & 3u) + 4u * ((pl >> 6) & 1u)); }
__device__ void route_fast_phase(int WV_, const bf16* qb, const bf16* skb  , int* eid, float* gate, unsigned char* lds, int pm = -1, int pn = 0) {
    const int tid = LTID(WV_), lane = tid & 63, wave = tid >> 6, r32 = lane & 31, hi = lane >> 5;
    unsigned* lidx = (unsigned*)lds + wave * (64 * 33) + lane * 33;
    const int u_first = (pm >= 0) ? 0 : LBID() * NWAVE + wave, u_end = (pm >= 0) ? 2 : (T_ / 32) * 8, u_step = (pm >= 0) ? 1 : LGRID() * NWAVE;
    for (int unit = u_first; unit < u_end; unit += u_step) {
        const int h = (pm >= 0) ? 2 * pn + unit : (unit & 7), t = ((pm >= 0) ? 8 * pm + wave : (unit >> 3)) * 32 + r32;
        float sl[2][16];
#pragma unroll
        for (int p = 0; p < 2; ++p) {
            bf16x8_t qf[4];
            { const bf16* qp = qb + (size_t)t * 1024 + h * 128 + p * 64 + 8 * hi;
#pragma unroll
              for (int ks = 0; ks < 4; ++ks) qf[ks] = *(const bf16x8_t*)(qp + 16 * ks); }
            float s[16];
#pragma unroll
            for (int k = 0; k < 16; ++k) s[k] = -INFINITY;
            const bf16* skp = skb + ((size_t)(h * 2 + p) * 128 + r32) * 64 + 8 * hi;
#pragma unroll
            for (int kt = 0; kt < 4; ++kt) {
                f32x16_t acc;
#pragma unroll
                for (int r = 0; r < 16; ++r) acc[r] = 0.f;
#pragma unroll
                for (int ks = 0; ks < 4; ++ks) { const bf16x8_t a = *(const bf16x8_t*)(skp + (size_t)kt * 32 * 64 + 16 * ks); acc = __builtin_amdgcn_mfma_f32_32x32x16_bf16(a, qf[ks], acc, 0, 0, 0); }
#pragma unroll
                for (int r = 0; r < 16; ++r) ins16(s, pack_pl(acc[r], (unsigned)(kt * 16 + r)));
            }
            const unsigned hb = (unsigned)hi << 6;
#pragma unroll
            for (int k = 0; k < 16; ++k) s[k] = __uint_as_float(__float_as_uint(s[k]) | hb);
            float c[16];
#pragma unroll
            for (int k = 0; k < 16; ++k) c[k] = vmax(s[k], __shfl_xor(s[15 - k], 32));
            bitonic_stage<8>(c); bitonic_stage<4>(c); bitonic_stage<2>(c); bitonic_stage<1>(c);
#pragma unroll
            for (int k = 0; k < 16; ++k) { sl[p][k] = c[k]; lidx[p * 16 + k] = (unsigned)decode_key(__float_as_uint(c[k]) & 127u); }
        }
        float w[16];
#pragma unroll
        for (int k = 0; k < 16; ++k) w[k] = -INFINITY;
#pragma unroll
        for (int i = 0; i < 16; ++i)
#pragma unroll
            for (int j = 0; j < 16; ++j)
                if ((i + 1) * (j + 1) <= 16) { const float v = sl[0][i] + sl[1][j]; ins16(w, __uint_as_float((__float_as_uint(v) & ~255u) | (unsigned)(i * 16 + j))); }
        float e[16], sum = 0.f;
#pragma unroll
        for (int k = 0; k < 16; ++k) { e[k] = expf(w[k] - w[0]); sum += e[k]; }
        const float inv = 1.0f / sum;
        int ide[8]; float gte[8];
#pragma unroll
        for (int k = 0; k < 8; ++k) {
            float wa = w[k], wb = w[8 + k], ea = e[k], eb = e[8 + k];
            asm volatile("" : "+v"(wa), "+v"(wb), "+v"(ea), "+v"(eb));
            const float wv = hi ? wb : wa;
            const unsigned pl = __float_as_uint(wv) & 255u;
            ide[k] = (int)(lidx[pl >> 4] * 128u + lidx[16 + (pl & 15u)]);
            gte[k] = (hi ? eb : ea) * inv;
        }
        int* ep = eid + (size_t)t * 128 + h * 16 + hi * 8; float* gp = gate + (size_t)t * 128 + h * 16 + hi * 8;
        *(int4*)ep = make_int4(ide[0], ide[1], ide[2], ide[3]); *(int4*)(ep + 4) = make_int4(ide[4], ide[5], ide[6], ide[7]);
        *(float4*)gp = make_float4(gte[0], gte[1], gte[2], gte[3]); *(float4*)(gp + 4) = make_float4(gte[4], gte[5], gte[6], gte[7]);
    }
}

typedef float f32x4_t __attribute__((ext_vector_type(4)));
typedef __bf16 bf16x2v __attribute__((ext_vector_type(2)));
__device__ __forceinline__ float dot2bf(unsigned a, unsigned b, float c) { return __builtin_amdgcn_fdot2_f32_bf16(__builtin_bit_cast(bf16x2v, a), __builtin_bit_cast(bf16x2v, b), c, false); }
__device__ __forceinline__ void cnt_gt(int& cnt, unsigned a, unsigned b) { asm("v_cmp_gt_u32_e32 vcc, %1, %2\n\tv_addc_co_u32_e32 %0, vcc, 0, %0, vcc" : "+v"(cnt) : "v"(a), "v"(b) : "vcc"); }
__device__ __forceinline__ void cnt_eq(int& cnt, unsigned a, unsigned b) { asm("v_cmp_eq_u32_e32 vcc, %1, %2\n\tv_addc_co_u32_e32 %0, vcc, 0, %0, vcc" : "+v"(cnt) : "v"(a), "v"(b) : "vcc"); }
__device__ __forceinline__ unsigned flag_gt(unsigned a, unsigned b) { unsigned r; asm("v_cmp_gt_u32_e32 vcc, %1, %2\n\tv_cndmask_b32_e64 %0, 0, 1, vcc" : "=v"(r) : "v"(a), "v"(b) : "vcc"); return r; }
__device__ __forceinline__ unsigned flag_eq(unsigned a, unsigned b) { unsigned r; asm("v_cmp_eq_u32_e32 vcc, %1, %2\n\tv_cndmask_b32_e64 %0, 0, 1, vcc" : "=v"(r) : "v"(a), "v"(b) : "vcc"); return r; }
__device__ __forceinline__ void cnt_ge(int& cnt, unsigned key, unsigned cand) { asm("v_cmp_ge_u32_e32 vcc, %1, %2\n\tv_addc_co_u32_e32 %0, vcc, 0, %0, vcc" : "+v"(cnt) : "v"(key), "v"(cand) : "vcc"); }

template <int CTRL, int RM> __device__ __forceinline__ unsigned dpp0(unsigned v) { return (unsigned)__builtin_amdgcn_update_dpp(0, (int)v, CTRL, RM, 0xf, false); }
template <int CTRL> __device__ __forceinline__ unsigned dppf(unsigned v) { return (unsigned)__builtin_amdgcn_update_dpp(-1, (int)v, CTRL, 0xf, 0xf, false); }
__device__ __forceinline__ unsigned wave_sum_u_dpp(unsigned v) {
    v += dpp0<0xB1, 0xf>(v); v += dpp0<0x4E, 0xf>(v); v += dpp0<0x141, 0xf>(v); v += dpp0<0x140, 0xf>(v);
    return (unsigned)__builtin_amdgcn_readlane((int)v, 0) + (unsigned)__builtin_amdgcn_readlane((int)v, 16) + (unsigned)__builtin_amdgcn_readlane((int)v, 32) + (unsigned)__builtin_amdgcn_readlane((int)v, 48);
}
__device__ __forceinline__ unsigned wave_min_u_dpp(unsigned v) {
    unsigned t;
    t = dppf<0xB1>(v); v = t < v ? t : v; t = dppf<0x4E>(v); v = t < v ? t : v; t = dppf<0x141>(v); v = t < v ? t : v; t = dppf<0x140>(v); v = t < v ? t : v;
    const unsigned a = (unsigned)__builtin_amdgcn_readlane((int)v, 0), b = (unsigned)__builtin_amdgcn_readlane((int)v, 16), c = (unsigned)__builtin_amdgcn_readlane((int)v, 32), d = (unsigned)__builtin_amdgcn_readlane((int)v, 48);
    const unsigned ab = a < b ? a : b, cd = c < d ? c : d; return ab < cd ? ab : cd;
}
__device__ __forceinline__ unsigned wave_incl_scan_u_dpp(unsigned v) {
    v += dpp0<0x111, 0xf>(v); v += dpp0<0x112, 0xf>(v); v += dpp0<0x114, 0xf>(v); v += dpp0<0x118, 0xf>(v);
    v += dpp0<0x142, 0xa>(v);
    v += dpp0<0x143, 0xc>(v);
    return v;
}
typedef __attribute__((address_space(3))) unsigned lds_u32;
template <int SHIFT> __device__ __forceinline__ unsigned radix_pass(const unsigned (&key)[64], unsigned pre, lds_u32* hist, int lane, int& need, int jlim, unsigned L) {
    typedef unsigned u32x4v __attribute__((ext_vector_type(4)));
    typedef __attribute__((address_space(3))) u32x4v lds_u32x4;
    const int fl = 63 - lane;
    { const u32x4v z4 = {0u, 0u, 0u, 0u};
#pragma unroll
      for (int i = 0; i < 8; ++i) ((lds_u32x4*)(hist + fl * 32))[i] = z4; }
    const unsigned hb = (unsigned)(size_t)hist + 4u * (unsigned)(lane & 7);
    const unsigned one = 1u;
    asm volatile("" ::: "memory");
#pragma unroll
    for (int j4 = 0; j4 < 16; ++j4) {
        if (4 * j4 <= jlim) {
            bool grp = true;
            if (SHIFT <= 8) {
                const bool any = ((key[4 * j4] >> (SHIFT + 8)) == pre) | ((key[4 * j4 + 1] >> (SHIFT + 8)) == pre) | ((key[4 * j4 + 2] >> (SHIFT + 8)) == pre) | ((key[4 * j4 + 3] >> (SHIFT + 8)) == pre);
                grp = __ballot(any) != 0ull;
            }
            if (grp) {
#pragma unroll
                for (int e = 0; e < 4; ++e) { const int j = 4 * j4 + e;
                    const unsigned addr = hb + (((key[j] >> SHIFT) & 255u) << 5);
                    unsigned long long sv;
                    if (SHIFT == 24) asm volatile("v_cmp_ge_u32_e32 vcc, %1, %2\n\ts_and_saveexec_b64 %0, vcc\n\tds_add_u32 %3, %4\n\ts_mov_b64 exec, %0" : "=&s"(sv) : "v"(key[j]), "v"(L), "v"(addr), "v"(one) : "vcc", "memory");
                    else { const unsigned t = key[j] >> ((SHIFT + 8) & 31);
                        asm volatile("v_cmp_eq_u32_e32 vcc, %1, %2\n\ts_and_saveexec_b64 %0, vcc\n\tds_add_u32 %3, %4\n\ts_mov_b64 exec, %0" : "=&s"(sv) : "v"(t), "v"(pre), "v"(addr), "v"(one) : "vcc", "memory"); }
                }
            }
        }
    }
    asm volatile("s_waitcnt lgkmcnt(0)" ::: "memory");
    unsigned dsum[4]; unsigned sumL = 0u;
#pragma unroll
    for (int i = 0; i < 4; ++i) { const u32x4v v0 = ((const lds_u32x4*)(hist + fl * 32))[2 * i], v1 = ((const lds_u32x4*)(hist + fl * 32))[2 * i + 1];
        dsum[i] = ((v0.x + v0.y) + (v0.z + v0.w)) + ((v1.x + v1.y) + (v1.z + v1.w)); sumL += dsum[i]; }
    const unsigned incl = wave_incl_scan_u_dpp(sumL);
    const unsigned above = incl - sumL;
    const bool own = (above < (unsigned)need) && ((unsigned)need <= above + sumL);
    const int owner = __ffsll((long long)__ballot(own)) - 1;
    unsigned acc = above; int sel = -1; unsigned cab = 0u;
#pragma unroll
    for (int i = 3; i >= 0; --i) { const unsigned c = dsum[i]; const bool hit = (sel < 0) && (acc + c >= (unsigned)need); cab = hit ? acc : cab; sel = hit ? i : sel; acc += c; }
    const int ow = owner < 0 ? 0 : owner;
    const unsigned digit = (unsigned)__builtin_amdgcn_readlane(sel, ow) + (unsigned)(4 * (63 - ow));
    need -= (int)__builtin_amdgcn_readlane((int)cab, ow);
    return digit;
}
#ifndef TS_SEL
#define TS_SEL 0
#endif
#define ITS_B() do { if (TS_SEL >= 20 && TS_SEL <= 25 && WV_ == 0 && LANEID() == 0) ((volatile __attribute__((address_space(3))) unsigned long long*)((__attribute__((address_space(3))) unsigned char*)lds + 147456 - 16 - 32))[0] = __builtin_amdgcn_s_memrealtime(); } while (0)
#define ITS_E(k) do { if ((k) == TS_SEL && WV_ == 0 && LANEID() == 0) { volatile __attribute__((address_space(3))) unsigned long long* w_ = (volatile __attribute__((address_space(3))) unsigned long long*)((__attribute__((address_space(3))) unsigned char*)lds + 147456 - 16 - 32); w_[1] += __builtin_amdgcn_s_memrealtime() - w_[0]; } } while (0)
__device__ void index_fast_phase(int WV_, const bf16* P, unsigned char* mask, float* kmean, float* scratch_all, unsigned* qctr, unsigned char* lds) {
    const int tid = LTID(WV_), lane = tid & 63, wave = tid >> 6, bid = LBID(), G = LGRID();
    float* s_part = (float*)lds;
    ITS_B();
    for (int k = bid; k < 256; k += G) {
        const int b = k >> 6, h = (k >> 4) & 3, blk = k & 15;
        const bf16* kp = P + (size_t)(b * S_ + blk * 256 + wave * 32) * NP + C_KC + h * 64 + lane;
        float a = 0.f;
#pragma unroll 8
        for (int j = 0; j < 32; ++j) a += bf2f(kp[(size_t)j * NP]);
        __syncthreads();
        s_part[wave * 64 + lane] = a;
        __syncthreads();
        if (tid < 64) { float s = 0.f;
#pragma unroll
            for (int w = 0; w < 8; ++w) s += s_part[w * 64 + tid];
            kmean[((b * 4 + h) * 16 + blk) * 64 + tid] = s * (1.0f / 256.0f); }
    }
    ITS_E(22);
    constexpr int IDX_PITCH = 4096 + 32;
    float* scr = scratch_all + (size_t)bid * (16 * IDX_PITCH);
    const int lq = lane & 15, g4 = lane >> 4;
    for (int ui = bid; ui < 1024; ui += G) {
        const int b = ui >> 8, k = ui & 255, tile = (b & 1) ? 255 - k : k, q0 = tile * 16;
        const bf16* Pb = P + (size_t)b * S_ * NP;
        const int ntiles = tile + 1;
        ITS_B();
        bf16x8_t qf[8]; float wi[8];
        { const bf16* qp = Pb + (size_t)(q0 + lq) * NP + C_QI + 8 * g4;
#pragma unroll
          for (int h = 0; h < 8; ++h) qf[h] = *(const bf16x8_t*)(qp + 32 * h);
          const uint4 wv = *(const uint4*)(Pb + (size_t)(q0 + lq) * NP + C_WI); unpack8(wv, wi); }
        bf16x8_t qch, qcl;
        { typedef unsigned u32x4_t __attribute__((ext_vector_type(4)));
          float qc[8];
#pragma unroll
          for (int i = 0; i < 8; ++i) qc[i] = 0.f;
#pragma unroll
          for (int h = 0; h < 8; ++h) { const u32x4_t w4 = __builtin_bit_cast(u32x4_t, qf[h]);
#pragma unroll
              for (int i = 0; i < 4; ++i) { qc[2 * i] += wi[h] * __uint_as_float(w4[i] << 16); qc[2 * i + 1] += wi[h] * __uint_as_float(w4[i] & 0xffff0000u); } }
          u32x4_t hi4, lo4;
#pragma unroll
          for (int i = 0; i < 4; ++i) { const unsigned hw = cvtpk(qc[2 * i], qc[2 * i + 1]); hi4[i] = hw;
              lo4[i] = cvtpk(qc[2 * i] - __uint_as_float(hw << 16), qc[2 * i + 1] - __uint_as_float(hw & 0xffff0000u)); }
          qch = __builtin_bit_cast(bf16x8_t, hi4); qcl = __builtin_bit_cast(bf16x8_t, lo4); }
        {
            bf16x8_t afn = *(const bf16x8_t*)(Pb + (size_t)((wave < ntiles ? wave : 0) * 16 + lq) * NP + C_KI + 8 * g4);
            for (int kt = wave; kt < ntiles; kt += NWAVE) {
                const bf16x8_t af = afn;
                { const int ktn = (kt + NWAVE < ntiles) ? kt + NWAVE : kt; afn = *(const bf16x8_t*)(Pb + (size_t)(ktn * 16 + lq) * NP + C_KI + 8 * g4); }
                f32x4_t a[8];
                const f32x4_t z = {0.f, 0.f, 0.f, 0.f};
#pragma unroll
                for (int h = 0; h < 8; ++h) a[h] = __builtin_amdgcn_mfma_f32_16x16x32_bf16(af, qf[h], z, 0, 0, 0);
                f32x4_t sc = __builtin_amdgcn_mfma_f32_16x16x32_bf16(af, qch, z, 0, 0, 0);
                sc = __builtin_amdgcn_mfma_f32_16x16x32_bf16(af, qcl, sc, 0, 0, 0);
                __builtin_amdgcn_sched_barrier(0);
#pragma unroll
                for (int h = 0; h < 8; ++h)
#pragma unroll
                    for (int r = 0; r < 4; ++r) sc[r] = __builtin_fmaf(__builtin_fabsf(a[h][r]), wi[h], sc[r]);
#pragma unroll
                for (int r = 0; r < 4; ++r) { sc[r] *= 0.03125f; if (sc[r] == 0.f) sc[r] = 0.f; }
                *(f32x4_t*)(scr + (size_t)lq * IDX_PITCH + kt * 16 + 4 * g4) = sc;
            }
        }
        __threadfence_block();
        __syncthreads();
        __threadfence_block();
        ITS_E(20); ITS_B();
        lds_u32* hist = (lds_u32*)((__attribute__((address_space(3))) unsigned char*)lds + 2048) + wave * 2048;
#pragma unroll 1
        for (int qi = 0; qi < 2; ++qi) {
            const int ql = 2 * wave + qi, q = q0 + ql;
            const float* row = scr + (size_t)ql * IDX_PITCH + lane;
            const int qrel = q - lane * 64;
            const int jlim = __builtin_amdgcn_readfirstlane(q >> 6);
            const int jmax = (q - lane) >> 6;
            unsigned wlo = 0u, whi = 0u;
            if (q + 1 > 256) {
                unsigned key[64];
#pragma unroll
                for (int j4 = 0; j4 < 16; ++j4) {
                    if (4 * j4 <= jlim) {
#pragma unroll
                        for (int e = 0; e < 4; ++e) key[4 * j4 + e] = __float_as_uint(row[64 * (4 * j4 + e)]);
                    } else {
#pragma unroll
                        for (int e = 0; e < 4; ++e) key[4 * j4 + e] = 0x7fffffffu;
                    }
                }
                unsigned t0 = 0u, t1 = 0u, t2 = 0u, t3 = 0u;
#pragma unroll
                for (int j4 = 0; j4 < 16; ++j4) {
                    if (4 * j4 <= jlim) {
#pragma unroll
                        for (int e = 0; e < 4; ++e) { const int j = 4 * j4 + e; const unsigned u = key[j];
                            const unsigned t = u ^ ((unsigned)((int)u >> 31) | 0x80000000u); const unsigned inval = (unsigned)((jmax - j) >> 31); const unsigned x = t & ~inval; key[j] = x;
                            unsigned n1, n2, n3;
                            asm("v_med3_u32 %0, %1, %2, %3" : "=v"(n3) : "v"(t2), "v"(t3), "v"(x));
                            asm("v_med3_u32 %0, %1, %2, %3" : "=v"(n2) : "v"(t1), "v"(t2), "v"(x));
                            asm("v_med3_u32 %0, %1, %2, %3" : "=v"(n1) : "v"(t0), "v"(t1), "v"(x));
                            t0 = t0 > x ? t0 : x; t1 = n1; t2 = n2; t3 = n3; }
                    } else {
#pragma unroll
                        for (int e = 0; e < 4; ++e) key[4 * j4 + e] = 0u;
                    }
                }
                unsigned L = wave_min_u_dpp(t3);
                L = L > 1u ? L : 1u;
                ITS_E(23); ITS_B();
                int need = 256;
                const unsigned d1 = radix_pass<24>(key, 0u, hist, lane, need, jlim, L);
                const unsigned d2 = radix_pass<16>(key, d1, hist, lane, need, jlim, L);
                const unsigned d3 = radix_pass<8>(key, (d1 << 8) | d2, hist, lane, need, jlim, L);
                const unsigned d4 = radix_pass<0>(key, (d1 << 16) | (d2 << 8) | d3, hist, lane, need, jlim, L);
                const unsigned prefix = (d1 << 24) | (d2 << 16) | (d3 << 8) | d4;
                ITS_E(24); ITS_B();
                int ceq = 0;
#pragma unroll
                for (int j = 0; j < 64; ++j) cnt_eq(ceq, key[j], prefix);
                ceq = (int)wave_sum_u_dpp((unsigned)ceq);
                int X = 4096;
                if (ceq != need) {
                    int X0 = 0;
#pragma unroll 1
                    for (int bit = 11; bit >= 0; --bit) {
                        const int c = X0 | (1 << bit);
                        int cnt = 0; const int crel = (c - lane + 63) >> 6;
#pragma unroll
                        for (int j = 0; j < 64; ++j) cnt_eq(cnt, (key[j] ^ prefix) | ~(unsigned)((j - crel) >> 31), 0u);
                        cnt = wave_sum_i(cnt);
                        if (cnt < need) X0 = c;
                    }
                    X = X0 + 1;
                }
                const int xrel = (X - lane + 63) >> 6;
#pragma unroll
                for (int j4 = 0; j4 < 16; ++j4) {
                    if (4 * j4 <= jlim) {
#pragma unroll
                        for (int e = 0; e < 4; ++e) { const int j = 4 * j4 + e;
                            const bool sel = (key[j] > prefix) || (key[j] == prefix && j < xrel);
                            const unsigned long long bm = __ballot(sel);
                            asm("v_writelane_b32 %0, %1, %2" : "+v"(wlo) : "s"((unsigned)bm), "n"(j));
                            asm("v_writelane_b32 %0, %1, %2" : "+v"(whi) : "s"((unsigned)(bm >> 32)), "n"(j)); }
                    }
                }
            } else {
#pragma unroll
                for (int j = 0; j < 32; ++j) { wlo |= (~(unsigned)((qrel - j) >> 31) & 1u) << j; whi |= (~(unsigned)((qrel - 32 - j) >> 31) & 1u) << j; }
            }
            ((uint2*)(mask + (size_t)(b * S_ + q) * 512))[lane] = make_uint2(wlo, whi);
            ITS_E(25); ITS_B();
        }
        ITS_E(21);
        __syncthreads();
    }
}

constexpr int MG_P = 72;
constexpr int MG_TILE_BYTES = 128 * MG_P * 2;
__device__ void merge_fast_phase(int WV_, const bf16* P, const bf16* ys, const bf16* wbt  , bf16* merged, unsigned char* lds) {
    const int tid = LTID(WV_), lane = tid & 63, wave = tid >> 6, r32 = lane & 31, hi = lane >> 5, wt = wave & 3, wd = wave >> 2;
    const int srow0 = tid >> 3, sch = tid & 7;
    for (int tile = LBID(); tile < 1024; tile += LGRID()) {
        const int tok0 = (tile >> 3) * 128, d0 = (tile & 7) * 128;
        f32x16_t mer[2], acc[2];
#pragma unroll
        for (int r = 0; r < 16; ++r) { mer[0][r] = 0.f; mer[1][r] = 0.f; acc[0][r] = 0.f; acc[1][r] = 0.f; }
        uint4 RW00, RW01, RW10, RW11, RY00, RY01, RY10, RY11, RG0, RG1, RG2, RG3;
        bf16* gl = (bf16*)(lds + 4 * MG_TILE_BYTES);
        const int grow = tid >> 4, gch = tid & 15;
#define MG_GLOAD(st_, R_) do { const int n_ = (st_) >> 2, kc_ = (st_) & 3; \
            RW##R_##0 = *(const uint4*)(wbt + ((size_t)n_ * 1024 + d0 + srow0) * 256 + kc_ * 64 + sch * 8); \
            RW##R_##1 = *(const uint4*)(wbt + ((size_t)n_ * 1024 + d0 + srow0 + 64) * 256 + kc_ * 64 + sch * 8); \
            RY##R_##0 = *(const uint4*)(ys + (size_t)(tok0 + srow0) * 1024 + n_ * 256 + kc_ * 64 + sch * 8); \
            RY##R_##1 = *(const uint4*)(ys + (size_t)(tok0 + srow0 + 64) * 1024 + n_ * 256 + kc_ * 64 + sch * 8); } while (0)
#define MG_SSTORE(buf_, R_) do { bf16* wl_ = (bf16*)(lds + (buf_) * 2 * MG_TILE_BYTES); bf16* yl_ = (bf16*)(lds + (buf_) * 2 * MG_TILE_BYTES + MG_TILE_BYTES); \
            *(uint4*)(wl_ + srow0 * MG_P + sch * 8) = RW##R_##0; *(uint4*)(wl_ + (srow0 + 64) * MG_P + sch * 8) = RW##R_##1; \
            *(uint4*)(yl_ + srow0 * MG_P + sch * 8) = RY##R_##0; *(uint4*)(yl_ + (srow0 + 64) * MG_P + sch * 8) = RY##R_##1; } while (0)
        __syncthreads();
        MG_GLOAD(0, 0); MG_GLOAD(1, 1);
        MG_SSTORE(0, 0);
        __syncthreads();
#define MG_STAGE(PAR_, OTH_) do { const int buf = PAR_; \
            if (st + 2 < 16) MG_GLOAD(st + 2, PAR_); \
            if ((st & 3) == 1) { const bf16* gsrc = P + (size_t)(tok0 + grow) * NP + C_G + (st >> 2) * 1024 + d0 + gch * 8; \
                RG0 = *(const uint4*)gsrc; RG1 = *(const uint4*)(gsrc + (size_t)32 * NP); RG2 = *(const uint4*)(gsrc + (size_t)64 * NP); RG3 = *(const uint4*)(gsrc + (size_t)96 * NP); } \
            const bf16* wl = (const bf16*)(lds + buf * 2 * MG_TILE_BYTES); const bf16* yl = (const bf16*)(lds + buf * 2 * MG_TILE_BYTES + MG_TILE_BYTES); \
            _Pragma("unroll") for (int ks = 0; ks < 4; ++ks) { \
                const bf16x8_t bq = *(const bf16x8_t*)(yl + (32 * wt + r32) * MG_P + 16 * ks + 8 * hi); \
                const bf16x8_t a0 = *(const bf16x8_t*)(wl + (64 * wd + r32) * MG_P + 16 * ks + 8 * hi); \
                const bf16x8_t a1 = *(const bf16x8_t*)(wl + (64 * wd + 32 + r32) * MG_P + 16 * ks + 8 * hi); \
                acc[0] = __builtin_amdgcn_mfma_f32_32x32x16_bf16(a0, bq, acc[0], 0, 0, 0); \
                acc[1] = __builtin_amdgcn_mfma_f32_32x32x16_bf16(a1, bq, acc[1], 0, 0, 0); } \
            if ((st & 3) == 3) { \
                const int n = st >> 2; \
                const bf16* gp = gl + (32 * wt + r32) * 136 + 64 * wd + 4 * hi; (void)n; \
                _Pragma("unroll") for (int dt = 0; dt < 2; ++dt) \
                _Pragma("unroll") for (int g = 0; g < 4; ++g) { \
                        const uint2 gv = *(const uint2*)(gp + 32 * dt + 8 * g); \
                        const float g0 = __uint_as_float(gv.x << 16), g1 = __uint_as_float(gv.x & 0xffff0000u), g2 = __uint_as_float(gv.y << 16), g3 = __uint_as_float(gv.y & 0xffff0000u); \
                        mer[dt][4 * g + 0] += acc[dt][4 * g + 0] * g0; \
                        mer[dt][4 * g + 1] += acc[dt][4 * g + 1] * g1; \
                        mer[dt][4 * g + 2] += acc[dt][4 * g + 2] * g2; \
                        mer[dt][4 * g + 3] += acc[dt][4 * g + 3] * g3; } \
                _Pragma("unroll") for (int r = 0; r < 16; ++r) { acc[0][r] = 0.f; acc[1][r] = 0.f; } } \
            if (st + 1 < 16) MG_SSTORE(OTH_, OTH_); \
            if ((st & 3) == 2) { *(uint4*)(gl + grow * 136 + gch * 8) = RG0; *(uint4*)(gl + (grow + 32) * 136 + gch * 8) = RG1; *(uint4*)(gl + (grow + 64) * 136 + gch * 8) = RG2; *(uint4*)(gl + (grow + 96) * 136 + gch * 8) = RG3; } \
            __syncthreads(); } while (0)
#pragma unroll 1
        for (int st2 = 0; st2 < 16; st2 += 2) { { const int st = st2; MG_STAGE(0, 1); } { const int st = st2 + 1; MG_STAGE(1, 0); } }
#undef MG_STAGE
#undef MG_GLOAD
#undef MG_SSTORE
        bf16* mp = merged + (size_t)(tok0 + 32 * wt + r32) * 1024 + d0 + 64 * wd + 4 * hi;
#pragma unroll
        for (int dt = 0; dt < 2; ++dt)
#pragma unroll
            for (int g = 0; g < 4; ++g)
                *(uint2*)(mp + 32 * dt + 8 * g) = make_uint2(cvtpk(mer[dt][4 * g], mer[dt][4 * g + 1]), cvtpk(mer[dt][4 * g + 2], mer[dt][4 * g + 3]));
    }
}
#define LAS __attribute__((address_space(3)))
#define XB_TMO      128
#define XB_XCNT(j)  (256  + 64 * (j))
#define XB_XSUB(j)  (1280 + 64 * (j))
#define XB_XGEN(j)  (2304 + 64 * (j))
#define XB_TOP      3328
#define XB_TOPGEN   3392
#define XCD_BAR_WORDS 3456
#define XB_SPIN_CAP (1u << 18)

__device__ __forceinline__ unsigned xb_ld(unsigned* p)              { return __hip_atomic_load(p, __ATOMIC_RELAXED, __HIP_MEMORY_SCOPE_AGENT); }
__device__ __forceinline__ unsigned xb_add(unsigned* p, unsigned v) { return __hip_atomic_fetch_add(p, v, __ATOMIC_RELAXED, __HIP_MEMORY_SCOPE_AGENT); }
__device__ __forceinline__ unsigned xb_xcc_id() { return (unsigned)__builtin_amdgcn_s_getreg((3 << 11) | 20) & 0xFu; }
#define XB_SPIN(cond, bar) do { unsigned _sp = 0; while (cond) { __builtin_amdgcn_s_sleep(1); \
    if ((++_sp & 255u) == 0u) { if (xb_ld(&(bar)[XB_TMO])) break; if (_sp > XB_SPIN_CAP) { atomicAdd(&(bar)[XB_TMO], 1u); break; } } } } while (0)

struct XcdBarrier {
    unsigned* bar; unsigned x;
    volatile LAS unsigned* st;
};

__device__ __forceinline__ XcdBarrier xcd_barrier_post(unsigned* bar, volatile LAS unsigned* st) {
    XcdBarrier b; b.bar = bar; b.x = xb_xcc_id(); b.st = st;
    if (threadIdx.x == 0) (void)xb_add(&bar[XB_XCNT(b.x)], 1u);
    return b;
}
__device__ __forceinline__ void xcd_barrier_complete(unsigned* bar, unsigned x, unsigned& nloc, unsigned& nx) {
    const unsigned G = gridDim.x * gridDim.y * gridDim.z;
    unsigned sum, cnt, mine, sp = 0u;
    for (;;) {
        sum = 0u; cnt = 0u; mine = 0u;
#pragma unroll
        for (unsigned j = 0; j < 16; ++j) { const unsigned c = xb_ld(&bar[XB_XCNT(j)]); sum += c; cnt += (c > 0u) ? 1u : 0u; mine = (j == x) ? c : mine; }
        if (sum == G) break;
        __builtin_amdgcn_s_sleep(1);
        if ((++sp & 255u) == 0u) { if (xb_ld(&bar[XB_TMO])) break; if (sp > XB_SPIN_CAP) { atomicAdd(&bar[XB_TMO], 1u); break; } }
    }
    nloc = mine > 0u ? mine : 1u; nx = cnt > 0u ? cnt : 1u;
}

__device__ __forceinline__ void xcd_barrier(const XcdBarrier& b, int wv_) {
    asm volatile("s_waitcnt vmcnt(0)" ::: "memory");
    __syncthreads();
    if (wv_ == 0 && LANEID() == 0) {
        unsigned* bar = b.bar;
        __builtin_amdgcn_s_waitcnt(0);
        unsigned nloc = b.st[0], nx = b.st[1];
        if (nloc == 0u) { xcd_barrier_complete(bar, b.x, nloc, nx); b.st[0] = nloc; b.st[1] = nx; }
        const unsigned old = xb_add(&bar[XB_XSUB(b.x)], 1u);
        const unsigned gen = old / nloc;
        if (old + 1u == (gen + 1u) * nloc) {
            __builtin_amdgcn_fence(__ATOMIC_RELEASE, "agent");
            asm volatile("s_waitcnt vmcnt(0)" ::: "memory");
            const unsigned og = xb_add(&bar[XB_TOP], 1u);
            const unsigned tg = og / nx;
            if (og + 1u == (tg + 1u) * nx) xb_add(&bar[XB_TOPGEN], 1u);
            else XB_SPIN(xb_ld(&bar[XB_TOPGEN]) == tg, bar);
            __builtin_amdgcn_fence(__ATOMIC_ACQUIRE, "agent");
            xb_add(&bar[XB_XGEN(b.x)], 1u);
            asm volatile("s_waitcnt vmcnt(0)" ::: "memory");
        } else {
            XB_SPIN(xb_ld(&bar[XB_XGEN(b.x)]) == gen, bar);
            __builtin_amdgcn_fence(__ATOMIC_ACQUIRE, "agent");
            asm volatile("s_waitcnt vmcnt(0)" ::: "memory");
        }
    }
    __syncthreads();
}

enum { PH_PRO = 0, PH_GIN, PH_INDEX, PH_ATTN, PH_MERGE, PH_GOUT, PH_LN1, PH_GQ, PH_ROUTE, PH_PEER };
template <int PH> __device__ __forceinline__ void run_phase(int WV_, const Params& p_unused, int l, unsigned char* lds_raw) {
    size_t kaoff_ = 0; asm volatile("" : "+s"(kaoff_));
    typedef const __attribute__((address_space(4))) char* kaptr_t;
    const __attribute__((address_space(4))) Params& p = *(const __attribute__((address_space(4))) Params*)((kaptr_t)__builtin_amdgcn_kernarg_segment_ptr() + kaoff_);
    float* sm = (float*)lds_raw;
    size_t wsoff_ = 0; asm volatile("" : "+s"(wsoff_));
    unsigned char* ws = p.ws + wsoff_;
    float* hbuf = p.out;
    bf16* hb = (bf16*)(ws + WS_HB);
    bf16* P = (bf16*)(ws + WS_P);
    bf16* ys = (bf16*)(ws + WS_YS);
    bf16* mrg = (bf16*)(ws + WS_MRG);
    float* mix = (float*)(ws + WS_MIX);
    float* qb = (float*)(ws + WS_Q);
    unsigned char* mask = ws + WS_MASK;
    int* eid = (int*)(ws + WS_EID);
    float* gate = (float*)(ws + WS_GATE);
    float* kmean = (float*)(ws + WS_KMEAN);
    const float* hin = (l == 0) ? p.in[0] : hbuf;
    if (PH == PH_PRO) { Params pc; for (int i = 0; i < 13; ++i) pc.in[i] = p.in[i]; pc.out = p.out; pc.ws = ws;
        prologue_phase(WV_, pc, sm); convert_tables(WV_, pc);
        for (int i = LBID() * NTHR + LTID(WV_); i < DEPTH_ * 8 * 2 * 128 * 64 / 4; i += LGRID() * NTHR) { const float4 v = ((const float4*)p.in[8])[i]; ((uint2*)(ws + WS_SKB))[i] = make_uint2(pk2(v.x, v.y), pk2(v.z, v.w)); } if (LBID() < 2) build_unit_table((unsigned*)(ws + WS_CTL) + 1024, LBID() * NTHR + LTID(WV_)); }
    else if (PH == PH_GIN) {
        pg8::Gemm g{hb, (const bf16*)(ws + WS_WIN_T + l * WIN_T_BYTES), T_, NP, 1024};
        pg8::StaticOrder S; S.init(T_, NP, (int)LGRID(), (int)LBID());
        pg8::EpiBf16Sig E{P, NP, C_G};
        pg8::gemm_phase<pg8::EpiBf16Sig, pg8::StaticOrder, true, true>(WV_, (PG8_LAS unsigned char*)lds_raw, g, S, E);
    }
    else if (PH == PH_INDEX) index_fast_phase(WV_, P, mask, kmean, (float*)(ws + WS_UV + 48 * MiB), (unsigned*)(ws + WS_CTL) + 64 * l + 16, lds_raw);
    else if (PH == PH_ATTN) attn_fast_phase(WV_, P, mask, kmean, p.in[4] + l * 4, ys, (const unsigned*)(ws + WS_CTL) + 1024, (unsigned*)(ws + WS_CTL) + 64 * l, lds_raw);
    else if (PH == PH_MERGE) merge_fast_phase(WV_, P, ys, (const bf16*)(ws + WS_WBR_T) + (size_t)l * 4 * 1024 * 256, mrg, lds_raw);
    else if (PH == PH_GOUT) {
        pg8::Gemm g{mrg, (const bf16*)(ws + WS_WOUT_T) + (size_t)l * 1024 * 1024, T_, 1024, 1024};
        pg8::StaticOrder S; S.init(T_, 1024, (int)LGRID(), (int)LBID());
        pg8::EpiResY E{hin, hbuf, hb, (float*)(ws + WS_STATS) + (size_t)l * T_ * 2, ALPHA};
        pg8::gemm_phase<pg8::EpiResY, pg8::StaticOrder, true, true>(WV_, (PG8_LAS unsigned char*)lds_raw, g, S, E);
    }
    else if (PH == PH_GQ) {
        pg8::Gemm g{hb, (const bf16*)(ws + WS_WQ_T) + (size_t)l * 1024 * 1024, T_, 1024, 1024};
        pg8::StaticOrder S; S.init(T_, 1024, (int)LGRID(), (int)LBID());
        pg8::EpiLnFold E{(bf16*)qb, (const float*)(ws + WS_STATS) + (size_t)l * T_ * 2, (const float*)(ws + WS_COLS) + l * 2048, (const float*)(ws + WS_COLS) + l * 2048 + 1024, LN_EPS};
        pg8::gemm_phase<pg8::EpiLnFold, pg8::StaticOrder, true, true>(WV_, (PG8_LAS unsigned char*)lds_raw, g, S, E);
        pg8::Unit u0;
        if (LGRID() == 256 && S.next(0, u0)) {
            asm volatile("s_waitcnt vmcnt(0)" ::: "memory"); __syncthreads();
            route_fast_phase(WV_, (const bf16*)qb, (const bf16*)(ws + WS_SKB) + (size_t)l * 8 * 2 * 128 * 64, eid, gate, lds_raw, u0.pm, u0.pn);
        }
    }
    else if (PH == PH_ROUTE) { if (LGRID() != 256) route_fast_phase(WV_, (const bf16*)qb, (const bf16*)(ws + WS_SKB) + (size_t)l * 8 * 2 * 128 * 64, eid, gate, lds_raw); }
    else peer_fast_phase(WV_, hbuf, hb, eid, gate, ws + WS_UV + (size_t)l * 24 * MiB, p.in[5] + l * 1024, p.in[6] + l * 1024, p.in[11] + l * 1024, p.in[12] + l * 1024, lds_raw);
}

constexpr int CW_BAR = 4096;
constexpr int LDS_BARST = LDS_BYTES - 16;
__global__ void __launch_bounds__(NTHR, 2) mk_fwd(Params p) {
    extern __shared__ __attribute__((aligned(16))) unsigned char lds_raw[];
    cg::grid_group grid = cg::this_grid();
    const int WV_ = __builtin_amdgcn_readfirstlane((int)threadIdx.x >> 6);
    { volatile LAS unsigned* bst0 = (volatile LAS unsigned*)((LAS unsigned char*)lds_raw + LDS_BARST); if (threadIdx.x < 4) bst0[threadIdx.x] = 0u; }
    __syncthreads();
    volatile LAS unsigned* bst = (volatile LAS unsigned*)((LAS unsigned char*)lds_raw + LDS_BARST);
    { uint4* z = (uint4*)p.ws; const uint4 z4 = make_uint4(0u, 0u, 0u, 0u);
      for (unsigned i = (unsigned)LBID() * NTHR + (unsigned)LTID(WV_); i < (unsigned)(2 * MiB / 16); i += (unsigned)LGRID() * NTHR) z[i] = z4; }
    grid.sync();
    (void)xcd_barrier_post((unsigned*)(p.ws + WS_CTL) + CW_BAR, bst);
#define GRID_BAR() do { XcdBarrier b_; b_.bar = (unsigned*)(p.ws + WS_CTL) + CW_BAR; b_.x = xb_xcc_id(); b_.st = (volatile LAS unsigned*)((LAS unsigned char*)lds_raw + LDS_BARST); xcd_barrier(b_, WV_); } while (0)
    run_phase<PH_PRO>(WV_, p, 0, lds_raw);
    GRID_BAR();
#pragma unroll 1
    for (int l = 0; l < DEPTH_; ++l) {
        run_phase<PH_GIN>(WV_, p, l, lds_raw); GRID_BAR();
        run_phase<PH_INDEX>(WV_, p, l, lds_raw); GRID_BAR();
        run_phase<PH_ATTN>(WV_, p, l, lds_raw); GRID_BAR();
        run_phase<PH_MERGE>(WV_, p, l, lds_raw); GRID_BAR();
        run_phase<PH_GOUT>(WV_, p, l, lds_raw); GRID_BAR();
        run_phase<PH_GQ>(WV_, p, l, lds_raw); if (LGRID() != 256) { GRID_BAR(); run_phase<PH_ROUTE>(WV_, p, l, lds_raw); } GRID_BAR();
        run_phase<PH_PEER>(WV_, p, l, lds_raw); if (l + 1 < DEPTH_) GRID_BAR();
    }
}

extern "C" void kernel_launch(void* const* d_in, const int* in_sizes, int n_in, void* d_out, int out_size, void* d_ws, size_t ws_size, hipStream_t stream) {
    if (n_in != 13 || ws_size < WS_END) { fprintf(stderr, "kernel_launch: unexpected n_in %d / ws_size %zu; nothing launched\n", n_in, ws_size); return; }
    static int grid_blocks = 0;
    if (grid_blocks == 0) {
        int dev = 0, cus = 0, per_cu = 0;
        (void)hipGetDevice(&dev);
        (void)hipDeviceGetAttribute(&cus, hipDeviceAttributeMultiprocessorCount, dev);
        (void)hipFuncSetAttribute((const void*)mk_fwd, hipFuncAttributeMaxDynamicSharedMemorySize, LDS_BYTES);
        (void)hipOccupancyMaxActiveBlocksPerMultiprocessor(&per_cu, (const void*)mk_fwd, NTHR, LDS_BYTES);
        if (per_cu < 1) fprintf(stderr, "kernel_launch: occupancy query reports %d\n", per_cu);
        grid_blocks = cus;
    }
    Params p{};
    for (int i = 0; i < 13; ++i) p.in[i] = (const float*)d_in[i];
    p.out = (float*)d_out; p.ws = (unsigned char*)d_ws;
    void* args[] = {&p};
    hipError_t e = hipLaunchCooperativeKernel((const void*)mk_fwd, dim3(grid_blocks), dim3(NTHR), args, LDS_BYTES, stream);
    if (e != hipSuccess) fprintf(stderr, "cooperative launch failed: %s (grid %d)\n", hipGetErrorString(e), grid_blocks);
}
```

```cpp
#include <hip/hip_runtime.h>
#include <cstdio>
#include <cstdint>
#include <hip/hip_cooperative_groups.h>
namespace cg = cooperative_groups;

__device__ __forceinline__ int LANEID() { int l; asm volatile("v_mbcnt_lo_u32_b32 %0, -1, 0\n\tv_mbcnt_hi_u32_b32 %0, -1, %0" : "=v"(l)); return l; }
__device__ __forceinline__ int LTID(int wv) { return (wv << 6) | LANEID(); }
__device__ __forceinline__ int LBID() { int t = blockIdx.x; asm volatile("" : "+s"(t)); return t; }
__device__ __forceinline__ int LGRID() { int t = gridDim.x; asm volatile("" : "+s"(t)); return t; }
namespace pg8 {
#define PG8_LAS __attribute__((address_space(3)))
typedef unsigned short bf16_t;
typedef short bf16x8 __attribute__((ext_vector_type(8)));
typedef float f32x4 __attribute__((ext_vector_type(4)));
typedef unsigned u32x4 __attribute__((ext_vector_type(4)));
constexpr int BM = 256, BK = 64, HALF = 128, HTB = HALF * BK * 2  , STAGE_BYTES = 8 * HTB, NXCD = 8, WGM = 8;

__host__ __device__ __forceinline__ int lds_byte(int r, int c) { const int st = (r >> 4) * 2 + (c >> 5), rr = r & 15, cc = c & 31, ob = rr * 64 + cc * 2; return st * 1024 + (ob ^ (((ob >> 9) & 1) << 5)); }
__host__ __device__ __forceinline__ void stage_rc(int b, int& R, int& C) { const int st = b / 1024, sb = b % 1024, swz = sb ^ (((sb >> 9) & 1) << 5); R = (st >> 1) * 16 + swz / 64; C = (st & 1) * 32 + (swz % 64) / 2; }
__host__ __device__ __forceinline__ int perm32(int rho) { const int n = rho >> 4, i = rho & 15; return 8 * (i >> 2) + 4 * n + (i & 3); }

struct Unit { int pm, pn; };
struct Gemm { const bf16_t* A; const bf16_t* Bt; int M, N, K; };

struct StaticOrder {
    int nM, nN, nwg, G, c;
    __host__ __device__ void init(int M, int N, int G_, int c_) { nM = M / BM; nN = N / BM; nwg = nM * nN; G = G_; c = c_; }
    __host__ __device__ bool next(int i, Unit& u) const {
        const long L = (long)i * G + c; if (L >= nwg) return false;
        int wgid = (int)L; { const int q = nwg / NXCD, r = nwg % NXCD, xcd = wgid % NXCD, off = wgid / NXCD; wgid = (xcd < r ? xcd * (q + 1) : r * (q + 1) + (xcd - r) * q) + off; }
        const int nig = WGM * nN, gid = wgid / nig, fm = gid * WGM, gsz = (nM - fm) < WGM ? (nM - fm) : WGM;
        u.pm = fm + ((wgid % nig) % gsz); u.pn = (wgid % nig) / gsz; return true;
    }
    __device__ __forceinline__ void a_ready(const Unit&) const {}
    __device__ __forceinline__ void done(const Unit&) const {}
};

__device__ __forceinline__ unsigned cvt_pk_bf16(float lo, float hi) { unsigned r; asm volatile("v_cvt_pk_bf16_f32 %0, %1, %2" : "=v"(r) : "v"(lo), "v"(hi)); return r; }
typedef float f32x2 __attribute__((ext_vector_type(2)));
__device__ __forceinline__ f32x2 gelu_pk(f32x2 v) {
    const f32x2 av = __builtin_elementwise_abs(v), d = av * 0.2316418882f + 1.0f;
    f32x2 t; t.x = __builtin_amdgcn_rcpf(d.x); t.y = __builtin_amdgcn_rcpf(d.y);
    f32x2 q = t * 0.5307027145f + (-0.7265760135f); q = q * t + 0.7107068705f; q = q * t + (-0.142248368f); q = q * t + 0.127414796f; q = q * t;
    const f32x2 s = (v * v) * (-0.72134752044f);
    f32x2 e; e.x = __builtin_amdgcn_exp2f(s.x); e.y = __builtin_amdgcn_exp2f(s.y);
    const f32x2 m = v * (q * e), r = v - m;
    f32x2 o; o.x = v.x < 0.f ? m.x : r.x; o.y = v.y < 0.f ? m.y : r.y; return o;
}

template <int ACT  > struct EpiBf16 {
    static constexpr bool PERM = true, AFTER_DRAIN = false; static_assert(ACT == 0 || ACT == 1, "EpiBf16: ACT is 0 (none) or 1 (gelu_pk)");
    bf16_t* O; int ldc; const float* bias; int split_cols; size_t split_stride; float scale0;
    __device__ __forceinline__ void operator()(const f32x4 (&acc)[2][2][4][2], const Unit& u, int wr, int wc, int fr, int fq) const {
        { int ln_ = LANEID(); asm volatile("" : "+v"(ln_)); fr = ln_ & 15; fq = ln_ >> 4; }
        const int row0 = u.pm * BM + wr * 64 + fr; int colt = u.pn * BM; bf16_t* base = O;
        float sc = 1.f; if (split_cols) { const int t = colt / split_cols; base += (size_t)t * split_stride; colt -= t * split_cols; if (t == 0) sc = scale0; }
        const int col0 = colt + wc * 32 + 8 * fq, bcol0 = u.pn * BM + wc * 32 + 8 * fq;
        f32x4 bv[2][2];
#pragma unroll
        for (int bj = 0; bj < 2; ++bj)
#pragma unroll
            for (int n = 0; n < 2; ++n) bv[bj][n] = bias ? *(const f32x4*)(bias + bcol0 + bj * HALF + 4 * n) : (f32x4){0.f, 0.f, 0.f, 0.f};
#pragma unroll
        for (int ai = 0; ai < 2; ++ai)
#pragma unroll
            for (int m = 0; m < 4; ++m) { bf16_t* rowp = base + (size_t)(row0 + ai * HALF + m * 16) * ldc + col0;
#pragma unroll
                for (int bj = 0; bj < 2; ++bj) { f32x4 v0 = acc[ai][bj][m][0] + bv[bj][0], v1 = acc[ai][bj][m][1] + bv[bj][1];
                    if (ACT == 1) { f32x2 a = gelu_pk((f32x2){v0[0], v0[1]}), b = gelu_pk((f32x2){v0[2], v0[3]}), c = gelu_pk((f32x2){v1[0], v1[1]}), d = gelu_pk((f32x2){v1[2], v1[3]});
                        v0 = (f32x4){a.x, a.y, b.x, b.y}; v1 = (f32x4){c.x, c.y, d.x, d.y}; }
                    v0 = v0 * sc; v1 = v1 * sc; u32x4 w; w.x = cvt_pk_bf16(v0[0], v0[1]); w.y = cvt_pk_bf16(v0[2], v0[3]); w.z = cvt_pk_bf16(v1[0], v1[1]); w.w = cvt_pk_bf16(v1[2], v1[3]);
                    *(u32x4*)(rowp + bj * HALF) = w; } }
    }
};
template <class Epi, class Sched, bool ALIGN_EPI = false, bool SP2 = false>
__device__ __forceinline__ void gemm_phase(int WV_, PG8_LAS unsigned char* lds, const Gemm g, const Sched& S, const Epi& E) {
    const int tid = LTID(WV_), wid = __builtin_amdgcn_readfirstlane(tid >> 6), lane = tid & 63, wr = wid >> 2, wc = wid & 3, fr = lane & 15, fq = lane >> 4;
    const int K = g.K, nt = K / BK;
    unsigned voffA[2], voffB[2];
#pragma unroll
    for (int i = 0; i < 2; ++i) { int R, C; stage_rc(tid * 16 + i * 8192, R, C); const int Rb = Epi::PERM ? ((R & ~31) + perm32(R & 31)) : R;
        voffA[i] = (unsigned)(R * K + C) * 2u; voffB[i] = (unsigned)(Rb * K + C) * 2u; }
    const size_t kstep = (size_t)(BK * 2);
    const size_t hstep = (size_t)HALF * K * 2;
    const size_t tstep = 2 * hstep;
    const unsigned ldsw = (unsigned)wid * 1024u;
    const int aoff = lds_byte(wr * 64 + fr, fq * 8), boff = lds_byte(wc * 32 + fr, fq * 8);
#define PG8_SA(b, h) (((b) * 2 + (h)) * HTB)
#define PG8_SB(b, h) ((4 + (b) * 2 + (h)) * HTB)
#define PG8_STAGE(bufoff, gbase, voff) do { _Pragma("unroll") for (int _i = 0; _i < 2; ++_i) \
        __builtin_amdgcn_global_load_lds((const unsigned*)((const char*)(gbase) + (voff)[_i]), (PG8_LAS unsigned*)(lds + (bufoff) + ldsw + _i * 8192), 16, 0, 0); } while (0)
#define PG8_LDA(dst, b, h) do { _Pragma("unroll") for (int m = 0; m < 4; ++m) _Pragma("unroll") for (int k = 0; k < 2; ++k) dst[m][k] = *(const PG8_LAS bf16x8*)(lds + PG8_SA(b, h) + aoff + m * 2048 + k * 1024); } while (0)
#define PG8_LDB(dst, b, h) do { _Pragma("unroll") for (int n = 0; n < 2; ++n) _Pragma("unroll") for (int k = 0; k < 2; ++k) dst[n][k] = *(const PG8_LAS bf16x8*)(lds + PG8_SB(b, h) + boff + n * 2048 + k * 1024); } while (0)
#define PG8_MMA(ai, bj, At, Bt) do { __builtin_amdgcn_s_setprio(1); _Pragma("unroll") for (int m = 0; m < 4; ++m) _Pragma("unroll") for (int n = 0; n < 2; ++n) _Pragma("unroll") for (int k = 0; k < 2; ++k) \
        acc[ai][bj][m][n] = __builtin_amdgcn_mfma_f32_16x16x32_bf16(Bt[n][k], At[m][k], acc[ai][bj][m][n], 0, 0, 0); __builtin_amdgcn_s_setprio(0); } while (0)
#define PG8_WAIT_V(n) asm volatile("s_waitcnt vmcnt(" #n ")" ::: "memory")
#define PG8_WAIT_L(n) asm volatile("s_waitcnt lgkmcnt(" #n ")" ::: "memory")
#define PG8_BAR __builtin_amdgcn_s_barrier()
#define PG8_SCHED __builtin_amdgcn_sched_barrier(0)
    Unit cur, nxt; int ui = 0;
    if (!S.next(0, cur)) return;
    f32x4 acc[2][2][4][2];
#pragma unroll
    for (int a = 0; a < 2; ++a)
#pragma unroll
        for (int b = 0; b < 2; ++b)
#pragma unroll
            for (int m = 0; m < 4; ++m)
#pragma unroll
                for (int n = 0; n < 2; ++n) acc[a][b][m][n] = (f32x4){0.f, 0.f, 0.f, 0.f};
    bf16x8 At[4][2], B0[2][2], B1[2][2];
    const char* cA = (const char*)g.A + (size_t)cur.pm * tstep; const char* cB = (const char*)g.Bt + (size_t)cur.pn * tstep;
    S.a_ready(cur);
    if constexpr (SP2) {
        PG8_STAGE(PG8_SB(0, 0), cB, voffB); PG8_STAGE(PG8_SB(0, 1), cB + hstep, voffB); PG8_STAGE(PG8_SA(0, 0), cA, voffA); PG8_STAGE(PG8_SA(0, 1), cA + hstep, voffA);
        if (wr == 1) PG8_BAR;
        PG8_WAIT_V(2); PG8_BAR;
        PG8_STAGE(PG8_SB(1, 0), cB + kstep, voffB); PG8_STAGE(PG8_SA(1, 0), cA + kstep, voffA); PG8_STAGE(PG8_SB(1, 1), cB + hstep + kstep, voffB);
        PG8_WAIT_V(6); PG8_BAR;
    } else {
        PG8_STAGE(PG8_SB(0, 0), cB, voffB); PG8_STAGE(PG8_SA(0, 0), cA, voffA); PG8_STAGE(PG8_SB(0, 1), cB + hstep, voffB); PG8_STAGE(PG8_SA(0, 1), cA + hstep, voffA);
        if (wr == 1) PG8_BAR;
        PG8_WAIT_V(4); PG8_BAR;
        PG8_STAGE(PG8_SB(1, 0), cB + kstep, voffB); PG8_STAGE(PG8_SA(1, 0), cA + kstep, voffA); PG8_STAGE(PG8_SB(1, 1), cB + hstep + kstep, voffB);
        PG8_WAIT_V(6); PG8_BAR;
    }
    for (;;) {
        const bool has_next = S.next(ui + 1, nxt);
        const char* nA = has_next ? (const char*)g.A + (size_t)nxt.pm * tstep : cA; const char* nB = has_next ? (const char*)g.Bt + (size_t)nxt.pn * tstep : cB;
        for (int t = 0; t < nt; t += 2) {
            const bool last = (t == nt - 2);
            const char* a1 = cA + (size_t)(t + 1) * kstep;
            const char* a2 = last ? nA : cA + (size_t)(t + 2) * kstep; const char* b2 = last ? nB : cB + (size_t)(t + 2) * kstep;
            const char* a3 = a2 + kstep; const char* b3 = b2 + kstep;
            if (last && has_next) S.a_ready(nxt);
            if constexpr (SP2) {
            PG8_LDB(B0, 0, 0); PG8_LDB(B1, 0, 1); PG8_SCHED; PG8_LDA(At, 0, 0); PG8_STAGE(PG8_SA(1, 1), a1 + hstep, voffA);
            PG8_WAIT_V(8); PG8_WAIT_L(0); PG8_BAR; PG8_MMA(0, 0, At, B0); PG8_MMA(0, 1, At, B1); PG8_BAR; PG8_SCHED;
            PG8_LDA(At, 0, 1); PG8_STAGE(PG8_SB(0, 0), b2, voffB); PG8_STAGE(PG8_SB(0, 1), b2 + hstep, voffB); PG8_STAGE(PG8_SA(0, 0), a2, voffA);
            PG8_WAIT_V(8); PG8_WAIT_L(0); PG8_BAR; PG8_MMA(1, 0, At, B0); PG8_MMA(1, 1, At, B1); PG8_BAR; PG8_SCHED;
            PG8_LDB(B0, 1, 0); PG8_LDB(B1, 1, 1); PG8_SCHED; PG8_LDA(At, 1, 0); PG8_STAGE(PG8_SA(0, 1), a2 + hstep, voffA);
            PG8_WAIT_V(8); PG8_WAIT_L(0); PG8_BAR; PG8_MMA(0, 0, At, B0); PG8_MMA(0, 1, At, B1); PG8_BAR; PG8_SCHED;
            PG8_LDA(At, 1, 1); PG8_STAGE(PG8_SB(1, 0), b3, voffB); PG8_STAGE(PG8_SB(1, 1), b3 + hstep, voffB); PG8_STAGE(PG8_SA(1, 0), a3, voffA);
            PG8_WAIT_V(8); PG8_WAIT_L(0); PG8_BAR; PG8_MMA(1, 0, At, B0); PG8_MMA(1, 1, At, B1); PG8_BAR; PG8_SCHED;
            } else {
            PG8_LDB(B0, 0, 0); PG8_SCHED; PG8_LDA(At, 0, 0); PG8_STAGE(PG8_SA(1, 1), a1 + hstep, voffA);
            PG8_WAIT_L(8); PG8_BAR; PG8_WAIT_L(0); PG8_MMA(0, 0, At, B0); PG8_BAR; PG8_SCHED;
            PG8_LDB(B1, 0, 1); PG8_STAGE(PG8_SB(0, 0), b2, voffB);
            PG8_BAR; PG8_WAIT_L(0); PG8_MMA(0, 1, At, B1); PG8_BAR;
            PG8_LDA(At, 0, 1); PG8_STAGE(PG8_SA(0, 0), a2, voffA);
            PG8_BAR; PG8_WAIT_L(0); PG8_MMA(1, 0, At, B0); PG8_BAR; PG8_SCHED;
            PG8_STAGE(PG8_SB(0, 1), b2 + hstep, voffB);
            PG8_WAIT_V(6); PG8_BAR; PG8_MMA(1, 1, At, B1); PG8_BAR;
            PG8_LDB(B0, 1, 0); PG8_SCHED; PG8_LDA(At, 1, 0); PG8_STAGE(PG8_SA(0, 1), a2 + hstep, voffA);
            PG8_WAIT_L(8); PG8_BAR; PG8_WAIT_L(0); PG8_MMA(0, 0, At, B0); PG8_BAR; PG8_SCHED;
            PG8_LDB(B1, 1, 1); PG8_STAGE(PG8_SB(1, 0), b3, voffB);
            PG8_BAR; PG8_WAIT_L(0); PG8_MMA(0, 1, At, B1); PG8_BAR;
            PG8_LDA(At, 1, 1); PG8_STAGE(PG8_SA(1, 0), a3, voffA);
            PG8_BAR; PG8_WAIT_L(0); PG8_MMA(1, 0, At, B0); PG8_BAR; PG8_SCHED;
            PG8_STAGE(PG8_SB(1, 1), b3 + hstep, voffB);
            PG8_WAIT_V(6); PG8_BAR; PG8_MMA(1, 1, At, B1); PG8_BAR;
            }
        }
        if constexpr (ALIGN_EPI) { if (wr == 0) PG8_BAR; }
        if constexpr (!Epi::AFTER_DRAIN) { E(acc, cur, wr, wc, fr, fq); S.done(cur); }
        if (!has_next) break;
#pragma unroll
        for (int a = 0; a < 2; ++a)
#pragma unroll
            for (int b = 0; b < 2; ++b)
#pragma unroll
                for (int m = 0; m < 4; ++m)
#pragma unroll
                    for (int n = 0; n < 2; ++n) acc[a][b][m][n] = (f32x4){0.f, 0.f, 0.f, 0.f};
        cur = nxt; cA = nA; cB = nB; ++ui;
        if constexpr (ALIGN_EPI) { if (wr == 1) PG8_BAR; }
    }
    PG8_WAIT_V(0);
    if constexpr (!ALIGN_EPI) { if (wr == 0) PG8_BAR; }
    PG8_BAR;
    if constexpr (Epi::AFTER_DRAIN) { E.fused(acc, cur, wr, wc, fr, fq, lds, wid, lane); S.done(cur); }
#undef PG8_SA
#undef PG8_SB
#undef PG8_STAGE
#undef PG8_LDA
#undef PG8_LDB
#undef PG8_MMA
#undef PG8_WAIT_V
#undef PG8_WAIT_L
#undef PG8_BAR
#undef PG8_SCHED
}
}
namespace pg8 {
struct EpiF32 {
    static constexpr bool PERM = false, AFTER_DRAIN = false;
    float* O; int ldc;
    __device__ __forceinline__ void operator()(const f32x4 (&acc)[2][2][4][2], const Unit& u, int wr, int wc, int fr, int fq) const {
        { int ln_ = LANEID(); asm volatile("" : "+v"(ln_)); fr = ln_ & 15; fq = ln_ >> 4; }
        const int row0 = u.pm * BM + wr * 64 + fr, col0 = u.pn * BM + wc * 32 + 4 * fq;
#pragma unroll
        for (int ai = 0; ai < 2; ++ai)
#pragma unroll
            for (int m = 0; m < 4; ++m) { float* rowp = O + (size_t)(row0 + ai * HALF + m * 16) * ldc + col0;
#pragma unroll
                for (int bj = 0; bj < 2; ++bj)
#pragma unroll
                    for (int n = 0; n < 2; ++n) *(f32x4*)(rowp + bj * HALF + n * 16) = acc[ai][bj][m][n]; }
    }
};
struct EpiResY {
    static constexpr bool PERM = false, AFTER_DRAIN = false;
    const float* hin; float* yout; bf16_t* yb; float* stats; float alpha;
    __device__ __forceinline__ void operator()(const f32x4 (&acc)[2][2][4][2], const Unit& u, int wr, int wc, int fr, int fq) const {
        { int ln_ = LANEID(); asm volatile("" : "+v"(ln_)); fr = ln_ & 15; fq = ln_ >> 4; }
        const int row0 = u.pm * BM + wr * 64 + fr, col0 = u.pn * BM + wc * 32 + 4 * fq;
#pragma unroll
        for (int ai = 0; ai < 2; ++ai)
#pragma unroll
            for (int m = 0; m < 4; ++m) {
                const int row = row0 + ai * HALF + m * 16;
                float s = 0.f, s2 = 0.f;
#pragma unroll
                for (int bj = 0; bj < 2; ++bj)
#pragma unroll
                    for (int n = 0; n < 2; ++n) {
                        const size_t off = (size_t)row * 1024 + col0 + bj * HALF + n * 16;
                        const f32x4 hv = *(const f32x4*)(hin + off);
                        const f32x4 y = hv * alpha + acc[ai][bj][m][n];
                        *(f32x4*)(yout + off) = y;
                        typedef unsigned u32x2v __attribute__((ext_vector_type(2)));
                        u32x2v w; w.x = cvt_pk_bf16(y[0], y[1]); w.y = cvt_pk_bf16(y[2], y[3]);
                        *(u32x2v*)(yb + off) = w;
                        s += (y[0] + y[1]) + (y[2] + y[3]); s2 += (y[0] * y[0] + y[1] * y[1]) + (y[2] * y[2] + y[3] * y[3]);
                    }
                s += __shfl_xor(s, 16); s += __shfl_xor(s, 32); s2 += __shfl_xor(s2, 16); s2 += __shfl_xor(s2, 32);
                if (fq == 0) { atomicAdd(stats + 2 * (size_t)row, s); atomicAdd(stats + 2 * (size_t)row + 1, s2); }
            }
    }
};
struct EpiLnFold {
    static constexpr bool PERM = true, AFTER_DRAIN = false;
    bf16_t* O; const float* stats; const float* colsum; const float* colbias; float eps;
    __device__ __forceinline__ void operator()(const f32x4 (&acc)[2][2][4][2], const Unit& u, int wr, int wc, int fr, int fq) const {
        { int ln_ = LANEID(); asm volatile("" : "+v"(ln_)); fr = ln_ & 15; fq = ln_ >> 4; }
        const int row0 = u.pm * BM + wr * 64 + fr, col0 = u.pn * BM + wc * 32 + 8 * fq;
        f32x4 cs[2][2], cb[2][2];
#pragma unroll
        for (int bj = 0; bj < 2; ++bj)
#pragma unroll
            for (int n = 0; n < 2; ++n) { cs[bj][n] = *(const f32x4*)(colsum + col0 + bj * HALF + 4 * n); cb[bj][n] = *(const f32x4*)(colbias + col0 + bj * HALF + 4 * n); }
#pragma unroll
        for (int ai = 0; ai < 2; ++ai)
#pragma unroll
            for (int m = 0; m < 4; ++m) {
                const int row = row0 + ai * HALF + m * 16;
                const float sm_ = stats[2 * (size_t)row], sq_ = stats[2 * (size_t)row + 1];
                const float mean = sm_ * (1.0f / 1024.0f);
                const float rstd = 1.0f / sqrtf(fmaxf(sq_ * (1.0f / 1024.0f) - mean * mean, 0.f) + eps);
                bf16_t* rowp = O + (size_t)row * 1024 + col0;
#pragma unroll
                for (int bj = 0; bj < 2; ++bj) {
                    const f32x4 v0 = (acc[ai][bj][m][0] - cs[bj][0] * mean) * rstd + cb[bj][0], v1 = (acc[ai][bj][m][1] - cs[bj][1] * mean) * rstd + cb[bj][1];
                    u32x4 w; w.x = cvt_pk_bf16(v0[0], v0[1]); w.y = cvt_pk_bf16(v0[2], v0[3]); w.z = cvt_pk_bf16(v1[0], v1[1]); w.w = cvt_pk_bf16(v1[2], v1[3]);
                    *(u32x4*)(rowp + bj * HALF) = w;
                }
            }
    }
};
__device__ __forceinline__ unsigned cvt_pk_bf16_t(float lo, float hi) { unsigned r; asm volatile("s_nop 0\n\tv_cvt_pk_bf16_f32 %0, %1, %2" : "=v"(r) : "v"(lo), "v"(hi)); return r; }
struct EpiBf16Sig {
    static constexpr bool PERM = true, AFTER_DRAIN = false;
    bf16_t* O; int ldc; int sig_col0;
    __device__ __forceinline__ void operator()(const f32x4 (&acc)[2][2][4][2], const Unit& u, int wr, int wc, int fr, int fq) const {
        { int ln_ = LANEID(); asm volatile("" : "+v"(ln_)); fr = ln_ & 15; fq = ln_ >> 4; }
        const int row0 = u.pm * BM + wr * 64 + fr; const int col0 = u.pn * BM + wc * 32 + 8 * fq;
#pragma unroll
        for (int bj = 0; bj < 2; ++bj) {
            if (col0 + bj * HALF >= sig_col0) {
#pragma unroll
                for (int ai = 0; ai < 2; ++ai)
#pragma unroll
                    for (int m = 0; m < 4; ++m) { bf16_t* rowp = O + (size_t)(row0 + ai * HALF + m * 16) * ldc + col0;
                        f32x4 v0 = acc[ai][bj][m][0], v1 = acc[ai][bj][m][1];
#pragma unroll
                        for (int e = 0; e < 4; ++e) { v0[e] = __builtin_amdgcn_rcpf(1.f + __builtin_amdgcn_exp2f(-1.44269504f * v0[e])); v1[e] = __builtin_amdgcn_rcpf(1.f + __builtin_amdgcn_exp2f(-1.44269504f * v1[e])); }
                        u32x4 w; w.x = cvt_pk_bf16_t(v0[0], v0[1]); w.y = cvt_pk_bf16_t(v0[2], v0[3]); w.z = cvt_pk_bf16_t(v1[0], v1[1]); w.w = cvt_pk_bf16_t(v1[2], v1[3]);
                        *(u32x4*)(rowp + bj * HALF) = w; }
            } else {
#pragma unroll
                for (int ai = 0; ai < 2; ++ai)
#pragma unroll
                    for (int m = 0; m < 4; ++m) { bf16_t* rowp = O + (size_t)(row0 + ai * HALF + m * 16) * ldc + col0;
                        const f32x4 v0 = acc[ai][bj][m][0], v1 = acc[ai][bj][m][1];
                        u32x4 w; w.x = cvt_pk_bf16(v0[0], v0[1]); w.y = cvt_pk_bf16(v0[2], v0[3]); w.z = cvt_pk_bf16(v1[0], v1[1]); w.w = cvt_pk_bf16(v1[2], v1[3]);
                        *(u32x4*)(rowp + bj * HALF) = w; }
            }
        }
    }
};
}

typedef unsigned short bf16;
constexpr int T_ = 16384, S_ = 4096, NBATCH = 4, D_ = 1024, NCOL = 6824, NP = 6912, DEPTH_ = 2;
constexpr int C_QA = 0, C_KA = 256, C_VA = 320, C_QI = 384, C_KI = 640, C_WI = 672, C_QB = 680, C_KB = 936, C_VB = 1064,
              C_QC = 1192, C_KC = 1448, C_VC = 1704, C_QD = 1960, C_KD = 2216, C_VD = 2472, C_G = 2728;
constexpr int NTHR = 512, NWAVE = 8;
constexpr float ALPHA = 1.41421356237309515f;
constexpr float LN_EPS = 1e-5f;
constexpr size_t MiB = 1u << 20;
constexpr size_t WS_STATS = 1 * MiB  , WS_COLS = 1 * MiB + 512 * 1024  ;
constexpr size_t WS_CTL = 0, WS_WIN_T = 2 * MiB, WS_WOUT_T = 30 * MiB, WS_WQ_T = 34 * MiB, WS_WBR_T = 38 * MiB, WS_HB = 42 * MiB,
                 WS_P = 74 * MiB, WS_MIX = 74 * MiB  , WS_Q = 138 * MiB  , WS_YS = 290 * MiB, WS_MRG = 322 * MiB,
                 WS_MASK = 354 * MiB, WS_EID = 362 * MiB, WS_GATE = 370 * MiB, WS_KMEAN = 378 * MiB, WS_SKB = 379 * MiB, WS_UV = 380 * MiB, WS_END = 508 * MiB;
constexpr size_t WIN_T_BYTES = (size_t)NP * 1024 * 2;
constexpr int LDS_BYTES = 144 * 1024;

struct Params { const float* in[13]; float* out; unsigned char* ws; };

__device__ __forceinline__ float bf2f(bf16 v) { return __uint_as_float((unsigned)v << 16); }
__device__ __forceinline__ unsigned f2bf(float f) { unsigned u = __float_as_uint(f); return (u + 0x7fffu + ((u >> 16) & 1u)) >> 16; }
__device__ __forceinline__ unsigned pk2(float lo, float hi) { return f2bf(lo) | (f2bf(hi) << 16); }
__device__ __forceinline__ void unpack8(const uint4 v, float* o) {
    o[0] = __uint_as_float(v.x << 16); o[1] = __uint_as_float(v.x & 0xffff0000u); o[2] = __uint_as_float(v.y << 16); o[3] = __uint_as_float(v.y & 0xffff0000u);
    o[4] = __uint_as_float(v.z << 16); o[5] = __uint_as_float(v.z & 0xffff0000u); o[6] = __uint_as_float(v.w << 16); o[7] = __uint_as_float(v.w & 0xffff0000u);
}
__device__ __forceinline__ float wave_sum(float v) {
#pragma unroll
    for (int o = 32; o > 0; o >>= 1) v += __shfl_xor(v, o);
    return v;
}
__device__ __forceinline__ float wave_max(float v) {
#pragma unroll
    for (int o = 32; o > 0; o >>= 1) v = fmaxf(v, __shfl_xor(v, o));
    return v;
}
__device__ __forceinline__ int wave_sum_i(int v) {
#pragma unroll
    for (int o = 32; o > 0; o >>= 1) v += __shfl_xor(v, o);
    return v;
}
__device__ __forceinline__ float logsig(float x) { return fminf(x, 0.f) - log1pf(expf(-fabsf(x))); }

__device__ void transpose_items(int WV_, const float* W, int K, int N, bf16* WT, float* sm, int item0, int nitems_total, int item_stride,
                                const float* rs_g = nullptr, const float* rs_b = nullptr, float* colsum = nullptr, float* colbias = nullptr) {
    const int tid = LTID(WV_);
    const int nkb = K / 64, nnb = (N + 63) / 64;
    for (int it = item0; it < nkb * nnb; it += item_stride) {
        const int kb = it % nkb, nb = it / nkb, k0 = kb * 64, n0 = nb * 64;
        __syncthreads();
        for (int e = tid; e < 64 * 64; e += NTHR) { const int kk = e >> 6, nn = e & 63; sm[kk * 65 + nn] = (n0 + nn < N) ? W[(size_t)(k0 + kk) * N + n0 + nn] : 0.f; }
        __syncthreads();
        if (rs_g) {
            if (tid < 64) { float cs = 0.f, cb = 0.f;
                for (int kk = 0; kk < 64; ++kk) { const float w = sm[kk * 65 + tid]; cs += w * rs_g[k0 + kk]; cb += w * rs_b[k0 + kk]; }
                atomicAdd(colsum + n0 + tid, cs); atomicAdd(colbias + n0 + tid, cb); }
            __syncthreads();
            for (int e = tid; e < 64 * 64; e += NTHR) { const int kk = e >> 6, nn = e & 63; sm[kk * 65 + nn] *= rs_g[k0 + kk]; }
            __syncthreads();
        }
        { const int nn = tid >> 3, c = tid & 7;
          if (n0 + nn < N) { uint4 o; o.x = pk2(sm[(8 * c + 0) * 65 + nn], sm[(8 * c + 1) * 65 + nn]); o.y = pk2(sm[(8 * c + 2) * 65 + nn], sm[(8 * c + 3) * 65 + nn]);
              o.z = pk2(sm[(8 * c + 4) * 65 + nn], sm[(8 * c + 5) * 65 + nn]); o.w = pk2(sm[(8 * c + 6) * 65 + nn], sm[(8 * c + 7) * 65 + nn]);
              *(uint4*)(WT + (size_t)(n0 + nn) * K + k0 + 8 * c) = o; } }
    }
    __syncthreads();
}
constexpr int TI_WIN = 16 * ((NCOL + 63) / 64), TI_SQ = 256, TI_LAYER = TI_WIN + 3 * TI_SQ;
#define TITEM_DECODE(it_, W_, WT_, K_, N_, k0_, n0_, fold_, l_) do { \
        l_ = (it_) / TI_LAYER; const int r_ = (it_) - l_ * TI_LAYER; \
        const int kind_ = r_ < TI_WIN ? 0 : (r_ < TI_WIN + TI_SQ ? 1 : (r_ < TI_WIN + 2 * TI_SQ ? 2 : 3)); \
        const int q_ = r_ - (kind_ == 0 ? 0 : TI_WIN + (kind_ - 1) * TI_SQ); \
        fold_ = kind_ == 2; K_ = kind_ == 3 ? 256 : 1024; N_ = kind_ == 0 ? NCOL : 1024; \
        k0_ = kind_ == 3 ? (q_ & 3) * 64 : (q_ & 15) * 64; n0_ = kind_ == 3 ? ((q_ & 63) >> 2) * 64 : (q_ >> 4) * 64; \
        const int nbr_ = q_ >> 6; \
        W_ = kind_ == 0 ? pin1 + (size_t)l_ * 1024 * NCOL : kind_ == 1 ? pin3 + (size_t)l_ * 1024 * 1024 : kind_ == 2 ? pin7 + (size_t)l_ * 1024 * 1024 : pin2 + ((size_t)l_ * 4 + nbr_) * 256 * 1024; \
        WT_ = kind_ == 0 ? (bf16*)(ws + WS_WIN_T + l_ * WIN_T_BYTES) : kind_ == 1 ? (bf16*)(ws + WS_WOUT_T) + (size_t)l_ * 1024 * 1024 : kind_ == 2 ? (bf16*)(ws + WS_WQ_T) + (size_t)l_ * 1024 * 1024 \
              : (bf16*)(ws + WS_WBR_T) + ((size_t)l_ * 4 + nbr_) * 1024 * 256; } while (0)
__device__ __forceinline__ void titem_finish(bf16* WT, int K, int N, int k0, int n0, const float* rs_g, const float* rs_b, float* colsum, float* colbias, float* sm, int tid) {
    if (rs_g) {
        if (tid < 64) { float cs = 0.f, cb = 0.f;
            for (int kk = 0; kk < 64; ++kk) { const float w = sm[kk * 65 + tid]; cs += w * rs_g[k0 + kk]; cb += w * rs_b[k0 + kk]; }
            atomicAdd(colsum + n0 + tid, cs); atomicAdd(colbias + n0 + tid, cb); }
        __syncthreads();
        for (int e = tid; e < 64 * 64; e += NTHR) { const int kk = e >> 6, nn = e & 63; sm[kk * 65 + nn] *= rs_g[k0 + kk]; }
        __syncthreads();
    }
    { const int nn = tid >> 3, c = tid & 7;
      if (n0 + nn < N) { uint4 o; o.x = pk2(sm[(8 * c + 0) * 65 + nn], sm[(8 * c + 1) * 65 + nn]); o.y = pk2(sm[(8 * c + 2) * 65 + nn], sm[(8 * c + 3) * 65 + nn]);
          o.z = pk2(sm[(8 * c + 4) * 65 + nn], sm[(8 * c + 5) * 65 + nn]); o.w = pk2(sm[(8 * c + 6) * 65 + nn], sm[(8 * c + 7) * 65 + nn]);
          *(uint4*)(WT + (size_t)(n0 + nn) * K + k0 + 8 * c) = o; } }
}
__device__ void prologue_phase(int WV_, const Params& p, float* sm) {
    const int tid = LTID(WV_), B = LBID(), G = LGRID();
    unsigned char* ws = p.ws;
    float* sm1 = sm + 64 * 65;
    const float* pin1 = p.in[1]; const float* pin2 = p.in[2]; const float* pin3 = p.in[3]; const float* pin7 = p.in[7]; const float* pin5 = p.in[5]; const float* pin6 = p.in[6];
    asm volatile("" : "+s"(pin1), "+s"(pin2), "+s"(pin3), "+s"(pin7), "+s"(pin5), "+s"(pin6));
    const int kk0 = tid >> 4, c4 = tid & 15;
    for (int it = B; it < DEPTH_ * TI_LAYER; it += 2 * G) {
        const int it2 = it + G; const bool has2 = it2 < DEPTH_ * TI_LAYER;
        const float* Wa; const float* Wb; bf16* WTa; bf16* WTb; int Ka, Na, k0a, n0a, la, Kb, Nb, k0b, n0b, lb; bool fa, fb;
        TITEM_DECODE(it, Wa, WTa, Ka, Na, k0a, n0a, fa, la);
        { const int itb = has2 ? it2 : it; TITEM_DECODE(itb, Wb, WTb, Kb, Nb, k0b, n0b, fb, lb); }
        const float4 z4 = make_float4(0.f, 0.f, 0.f, 0.f);
        const bool ina = n0a + 4 * c4 < Na, inb = n0b + 4 * c4 < Nb;
        float4 a0 = z4, a1 = z4, b0 = z4, b1 = z4;
        if (ina) { a0 = *(const float4*)(Wa + (size_t)(k0a + kk0) * Na + n0a + 4 * c4); a1 = *(const float4*)(Wa + (size_t)(k0a + kk0 + 32) * Na + n0a + 4 * c4); }
        if (inb) { b0 = *(const float4*)(Wb + (size_t)(k0b + kk0) * Nb + n0b + 4 * c4); b1 = *(const float4*)(Wb + (size_t)(k0b + kk0 + 32) * Nb + n0b + 4 * c4); }
        __syncthreads();
        { float* d = sm + kk0 * 65 + 4 * c4; d[0] = a0.x; d[1] = a0.y; d[2] = a0.z; d[3] = a0.w; d += 32 * 65; d[0] = a1.x; d[1] = a1.y; d[2] = a1.z; d[3] = a1.w; }
        { float* d = sm1 + kk0 * 65 + 4 * c4; d[0] = b0.x; d[1] = b0.y; d[2] = b0.z; d[3] = b0.w; d += 32 * 65; d[0] = b1.x; d[1] = b1.y; d[2] = b1.z; d[3] = b1.w; }
        __syncthreads();
        titem_finish(WTa, Ka, Na, k0a, n0a, fa ? pin5 + la * 1024 : nullptr, pin6 + la * 1024, (float*)(ws + WS_COLS) + la * 2048, (float*)(ws + WS_COLS) + la * 2048 + 1024, sm, tid);
        if (has2) titem_finish(WTb, Kb, Nb, k0b, n0b, fb ? pin5 + lb * 1024 : nullptr, pin6 + lb * 1024, (float*)(ws + WS_COLS) + lb * 2048, (float*)(ws + WS_COLS) + lb * 2048 + 1024, sm1, tid);
    }
    __syncthreads();
    for (int l = 0; l < DEPTH_; ++l) {
        bf16* win_t = (bf16*)(ws + WS_WIN_T + l * WIN_T_BYTES);
        for (int i = B * NTHR + tid; i < (NP - NCOL) * 1024 / 8; i += G * NTHR) ((uint4*)(win_t + (size_t)NCOL * 1024))[i] = make_uint4(0u, 0u, 0u, 0u);
    }
    const float4* x4 = (const float4*)p.in[0]; uint2* hb2 = (uint2*)(ws + WS_HB);
    for (size_t i = (size_t)B * NTHR + tid; i < (size_t)T_ * 1024 / 4; i += (size_t)G * NTHR) { const float4 v = x4[i]; hb2[i] = make_uint2(pk2(v.x, v.y), pk2(v.z, v.w)); }
}

__device__ __forceinline__ void ln_row(float4 (&v)[4], const float* g, const float* bb, float* orow, bf16* obrow, int lane) {
    float s = 0.f;
#pragma unroll
    for (int j = 0; j < 4; ++j) s += (v[j].x + v[j].y) + (v[j].z + v[j].w);
    const float mean = wave_sum(s) * (1.0f / 1024.0f);
    float s2 = 0.f;
#pragma unroll
    for (int j = 0; j < 4; ++j) { v[j].x -= mean; v[j].y -= mean; v[j].z -= mean; v[j].w -= mean; s2 += (v[j].x * v[j].x + v[j].y * v[j].y) + (v[j].z * v[j].z + v[j].w * v[j].w); }
    const float rstd = 1.0f / sqrtf(wave_sum(s2) * (1.0f / 1024.0f) + LN_EPS);
#pragma unroll
    for (int j = 0; j < 4; ++j) {
        const float4 gg = ((const float4*)g)[j * 64 + lane], b4 = ((const float4*)bb)[j * 64 + lane];
        float4 o; o.x = v[j].x * rstd * gg.x + b4.x; o.y = v[j].y * rstd * gg.y + b4.y; o.z = v[j].z * rstd * gg.z + b4.z; o.w = v[j].w * rstd * gg.w + b4.w;
        ((float4*)orow)[j * 64 + lane] = o;
        ((uint2*)obrow)[j * 64 + lane] = make_uint2(pk2(o.x, o.y), pk2(o.z, o.w));
    }
}
__device__ void ln1_phase(int WV_, const float* hin, const float* add, const float* g, const float* bb, float* hout, bf16* hb) {
    const int lane = LTID(WV_) & 63, wave = LTID(WV_) >> 6;
    for (int row = LBID() * NWAVE + wave; row < T_; row += LGRID() * NWAVE) {
        float4 v[4];
#pragma unroll
        for (int j = 0; j < 4; ++j) {
            const float4 a = ((const float4*)(hin + (size_t)row * 1024))[j * 64 + lane], m = ((const float4*)(add + (size_t)row * 1024))[j * 64 + lane];
            v[j].x = ALPHA * a.x + m.x; v[j].y = ALPHA * a.y + m.y; v[j].z = ALPHA * a.z + m.z; v[j].w = ALPHA * a.w + m.w;
        }
        ln_row(v, g, bb, hout + (size_t)row * 1024, hb + (size_t)row * 1024, lane);
    }
}


typedef short bf16x8_t __attribute__((ext_vector_type(8)));
typedef float f32x16_t __attribute__((ext_vector_type(16)));
typedef float f32x2_t __attribute__((ext_vector_type(2)));
typedef __bf16 bf16x2_t __attribute__((ext_vector_type(2)));
__device__ __forceinline__ unsigned cvtpk(float lo, float hi) { f32x2_t v = {lo, hi}; bf16x2_t b = __builtin_convertvector(v, bf16x2_t); return __builtin_bit_cast(unsigned, b); }
__device__ __forceinline__ int crow(int r, int hi) { return (r & 3) + 8 * (r >> 2) + 4 * hi; }
__device__ __forceinline__ float xlane32(float v) { return __shfl_xor(v, 32); }
__device__ __forceinline__ float vmax(float a, float b) { float r; asm("v_max_f32_e32 %0, %1, %2" : "=v"(r) : "v"(a), "v"(b)); return r; }
__device__ __forceinline__ float vmin(float a, float b) { float r; asm("v_min_f32_e32 %0, %1, %2" : "=v"(r) : "v"(a), "v"(b)); return r; }
__device__ __forceinline__ float vmax3(float a, float b, float c) { float r; asm("v_max3_f32 %0, %1, %2, %3" : "=v"(r) : "v"(a), "v"(b), "v"(c)); return r; }

constexpr int AT_KP = 72, AT_VP = 96;
constexpr int AT_KS = 0, AT_KS_BYTES = 64 * AT_KP * 2;
constexpr int AT_VT = 2 * AT_KS_BYTES, AT_VT_BYTES = 64 * AT_VP * 2;
constexpr int AT_KM = AT_VT + 2 * AT_VT_BYTES;
constexpr int AT_MISC = AT_KM + 32 * AT_KP * 2;
constexpr float LOG2E = 1.4426950408889634f;

__device__ __forceinline__ unsigned mk_unit(int kind, int b, int x, int y) { return ((unsigned)kind << 30) | ((unsigned)b << 28) | ((unsigned)x << 8) | (unsigned)y; }
__device__ void build_unit_table(unsigned* tab, int i) {
    int n = 0; unsigned res = 0u;
#pragma unroll 1
    for (int c = 64; c >= 1; --c) {
        if (i >= n && i < n + 4) res = mk_unit(0, i - n, 0, c - 1);
        n += 4;
        if ((c & 3) == 0) { if (i >= n && i < n + 16) { const int j = i - n; res = mk_unit(2, j >> 2, j & 3, c / 4 - 1); } n += 16; }
    }
    if (i < 512) tab[i] = res;
}

template <int kind> __device__ __forceinline__ void attn_unit(int WV_, const bf16* P, const unsigned char* mask, const float* kmean, const float* sinks, bf16* ys,
                                unsigned char* lds, int b, int ux, int uy) {
    int tid_ = LTID(WV_); asm volatile("" : "+v"(tid_));
    const int tid = tid_, lane = tid & 63, wave = __builtin_amdgcn_readfirstlane(tid >> 6), r32 = lane & 31, hi = lane >> 5;
    bf16* s_km = (bf16*)(lds + AT_KM);
    const int skey = tid >> 3, sc = tid & 7;
    {
        const bf16* Pb = P + (size_t)b * S_ * NP;
        int q0w, qcol, kcol, vcol, ycol, kt_hi, kt_lo; float slope2 = 0.f, sink2 = 0.f;
        if (kind == 0) { const int head = wave >> 1; q0w = uy * 64 + (wave & 1) * 32; qcol = C_QA + head * 64; kcol = C_KA; vcol = C_VA; ycol = head * 64;
            slope2 = exp2f(-8.0f * (float)(3 * head + 1) / 12.0f) * LOG2E; kt_hi = uy; kt_lo = 0; }
        else if (kind == 1) { const int hq = ux * 2 + (wave >> 2); q0w = uy * 128 + (wave & 3) * 32; qcol = C_QB + hq * 64; kcol = C_KB + ux * 64; vcol = C_VB + ux * 64; ycol = 256 + hq * 64;
            slope2 = exp2f(-8.0f * (float)(3 * hq + 2) / 12.0f) * LOG2E; sink2 = sinks[hq] * LOG2E; kt_hi = 2 * uy + 1; kt_lo = (2 * uy - 2 > 0) ? 2 * uy - 2 : 0; }
        else if (kind == 2) { q0w = uy * 256 + wave * 32; qcol = C_QC + ux * 64; kcol = C_KC + ux * 64; vcol = C_VC + ux * 64; ycol = 512 + ux * 64;
            slope2 = exp2f(-8.0f * (float)(3 * ux + 3) / 12.0f) * LOG2E; kt_hi = 4 * uy + 3; kt_lo = 0; }
        else { q0w = uy * 256 + wave * 32; qcol = C_QD + ux * 64; kcol = C_KD + ux * 64; vcol = C_VD + ux * 64; ycol = 768 + ux * 64; kt_hi = 4 * uy + 3; kt_lo = 0; }
        const int qpos = q0w + r32;
        bf16x8_t qf[4];
        { const bf16* qp = Pb + (size_t)qpos * NP + qcol + 8 * hi;
#pragma unroll
          for (int ks = 0; ks < 4; ++ks) qf[ks] = *(const bf16x8_t*)(qp + 16 * ks); }
        {
            const float qs = (kind == 3) ? 0.125f : 0.125f * LOG2E;
            typedef unsigned u32x4_t __attribute__((ext_vector_type(4)));
#pragma unroll
            for (int ks = 0; ks < 4; ++ks) { u32x4_t w = __builtin_bit_cast(u32x4_t, qf[ks]);
#pragma unroll
                for (int i = 0; i < 4; ++i) w[i] = cvtpk(__uint_as_float(w[i] << 16) * qs, __uint_as_float(w[i] & 0xffff0000u) * qs);
                qf[ks] = __builtin_bit_cast(bf16x8_t, w); }
        }
        float sb[16];
#pragma unroll
        for (int r = 0; r < 16; ++r) sb[r] = slope2 * (float)((r & 3) + 8 * (r >> 2));
        unsigned bm = 0u;
        if (kind == 2) {
            const int own = uy;
            for (int e = tid; e < 32 * 64; e += NTHR) { const int row = e >> 6, d = e & 63; s_km[row * AT_KP + d] = (row < 16) ? (bf16)f2bf(kmean[((b * 4 + ux) * 16 + row) * 64 + d]) : (bf16)0; }
            __syncthreads();
            f32x16_t gacc;
#pragma unroll
            for (int r = 0; r < 16; ++r) gacc[r] = 0.f;
#pragma unroll
            for (int ks = 0; ks < 4; ++ks) { const bf16x8_t a = *(const bf16x8_t*)(s_km + r32 * AT_KP + 16 * ks + 8 * hi); gacc = __builtin_amdgcn_mfma_f32_32x32x16_bf16(a, qf[ks], gacc, 0, 0, 0); }
            float gt[16];
#pragma unroll
            for (int r = 0; r < 8; ++r) { const float mine = gacc[r], other = xlane32(mine); const int bi = crow(r, 0);
                gt[bi] = hi ? other : mine; gt[bi + 4] = hi ? mine : other; }
#pragma unroll
            for (int n = 0; n < 16; ++n) if (n >= own) gt[n] = -INFINITY;
#pragma unroll
            for (int rep = 0; rep < 3; ++rep) {
                float mx = -INFINITY;
#pragma unroll
                for (int n = 0; n < 16; ++n) mx = fmaxf(mx, gt[n]);
                bool done = !(mx > -INFINITY);
#pragma unroll
                for (int n = 0; n < 16; ++n) { const bool hit = !done && gt[n] == mx; if (hit) { bm |= 1u << n; gt[n] = -INFINITY; done = true; } }
            }
        }
        f32x16_t o0, o1;
#pragma unroll
        for (int r = 0; r < 16; ++r) { o0[r] = 0.f; o1[r] = 0.f; }
        float m_run = -INFINITY, l_run = 0.f, carry = 0.f;
        const bf16* kg = Pb + (size_t)skey * NP + kcol + sc * 8;
        const bf16* vg = Pb + (size_t)skey * NP + vcol + sc * 8;
        uint4 rk = *(const uint4*)(kg + (size_t)kt_hi * 64 * NP), rv = *(const uint4*)(vg + (size_t)kt_hi * 64 * NP);
        int buf = 0;
        { bf16* ks_ = (bf16*)(lds + AT_KS); bf16* vt_ = (bf16*)(lds + AT_VT);
          *(uint4*)(ks_ + skey * AT_KP + sc * 8) = rk;
          *(uint4*)(vt_ + skey * AT_VP + sc * 8) = rv; }
        __syncthreads();
        bool wave_done = false;
        uint2 mw_next = make_uint2(0u, 0u);
        if (kind == 0) mw_next = *(const uint2*)(mask + (size_t)(b * S_ + qpos) * 512 + kt_hi * 8);
        for (int kt = kt_hi; kt >= kt_lo; --kt) {
            const bool more = kt > kt_lo;
            const uint2 mw = mw_next;
            if (kind == 0 && more) mw_next = *(const uint2*)(mask + (size_t)(b * S_ + qpos) * 512 + (kt - 1) * 8);
            if (more) { rk = *(const uint4*)(kg + (size_t)(kt - 1) * 64 * NP); rv = *(const uint4*)(vg + (size_t)(kt - 1) * 64 * NP); }
            const bf16* ks_ = (const bf16*)(lds + AT_KS + buf * AT_KS_BYTES);
            const bf16* vt_ = (const bf16*)(lds + AT_VT + buf * AT_VT_BYTES);
            bool active = (kt * 64 <= q0w + 31) && !wave_done;
            if (kind == 1) active = active && (kt * 64 + 63 >= q0w - 127);
            if (active) {
                const int kbase = kt * 64 + 4 * hi;
                f32x16_t p0, p1;
                if (kind != 3) {
                    const float cb = slope2 * (float)(kbase - qpos), cb1 = cb + 32.0f * slope2;
#pragma unroll
                    for (int r = 0; r < 16; ++r) { p0[r] = cb + sb[r]; p1[r] = cb1 + sb[r]; }
                } else {
#pragma unroll
                    for (int r = 0; r < 16; ++r) { p0[r] = 0.f; p1[r] = 0.f; }
                }
#pragma unroll
                for (int ks = 0; ks < 4; ++ks) {
                    const bf16x8_t a0 = *(const bf16x8_t*)(ks_ + r32 * AT_KP + 16 * ks + 8 * hi);
                    const bf16x8_t a1 = *(const bf16x8_t*)(ks_ + (32 + r32) * AT_KP + 16 * ks + 8 * hi);
                    p0 = __builtin_amdgcn_mfma_f32_32x32x16_bf16(a0, qf[ks], p0, 0, 0, 0);
                    p1 = __builtin_amdgcn_mfma_f32_32x32x16_bf16(a1, qf[ks], p1, 0, 0, 0);
                }
                if (kind != 3) {
                    float mx = -INFINITY;
                    if (kind == 0) {
                        const unsigned w0 = mw.x >> (4 * hi), w1 = mw.y >> (4 * hi);
#pragma unroll
                        for (int r = 0; r < 16; ++r) { const int off = (r & 3) + 8 * (r >> 2);
                            p0[r] = (w0 & (1u << off)) ? p0[r] : -INFINITY; p1[r] = (w1 & (1u << off)) ? p1[r] : -INFINITY; mx = vmax3(mx, p0[r], p1[r]); }
                    } else if (kind == 1) {
                        const int rel = qpos - kbase;
#pragma unroll
                        for (int r = 0; r < 16; ++r) { const int off = (r & 3) + 8 * (r >> 2);
                            p0[r] = ((unsigned)(rel - off) < 128u) ? p0[r] : -INFINITY; p1[r] = ((unsigned)(rel - off - 32) < 128u) ? p1[r] : -INFINITY; mx = vmax3(mx, p0[r], p1[r]); }
                    } else {
                        if ((kt >> 2) == uy) {
                            const int rel = qpos - kbase;
#pragma unroll
                            for (int r = 0; r < 16; ++r) { const int off = (r & 3) + 8 * (r >> 2);
                                p0[r] = (off <= rel) ? p0[r] : -INFINITY; p1[r] = (off + 32 <= rel) ? p1[r] : -INFINITY; mx = vmax3(mx, p0[r], p1[r]); }
                        } else {
                            const bool tile_ok = ((bm >> (kt >> 2)) & 1u) != 0u;
#pragma unroll
                            for (int r = 0; r < 16; ++r) { p0[r] = tile_ok ? p0[r] : -INFINITY; p1[r] = tile_ok ? p1[r] : -INFINITY; mx = vmax3(mx, p0[r], p1[r]); }
                        }
                    }
                    mx = vmax(mx, xlane32(mx));
                    const float m_new = vmax(m_run, mx);
                    const float m_safe = (m_new == -INFINITY) ? 0.f : m_new;
                    p0 = p0 - m_safe; p1 = p1 - m_safe;
#pragma unroll
                    for (int r = 0; r < 16; ++r) { p0[r] = __builtin_amdgcn_exp2f(p0[r]); p1[r] = __builtin_amdgcn_exp2f(p1[r]); }
                    float ls;
                    { typedef float f32x8_t __attribute__((ext_vector_type(8))); typedef float f32x4v_t __attribute__((ext_vector_type(4)));
                      const f32x16_t t16 = p0 + p1; const f32x8_t t8 = t16.lo + t16.hi; const f32x4v_t t4 = t8.lo + t8.hi; const f32x2_t t2 = t4.lo + t4.hi; ls = t2.x + t2.y; }
                    if (__any(m_new > m_run)) {
                        const float alpha = __builtin_amdgcn_exp2f(m_run - m_safe);
                        l_run *= alpha;
                        o0 = o0 * alpha; o1 = o1 * alpha;
                    }
                    l_run += ls; m_run = m_new;
                } else {
                    float run = carry;
#define SB_HALF(PX, KOFF) do { \
                    float lk[16]; \
                    _Pragma("unroll") for (int r = 0; r < 16; ++r) { \
                        const int off = (r & 3) + 8 * (r >> 2); \
                        const bool v = (kbase + off + (KOFF)) < qpos; \
                        const float z = PX[r]; \
                        const float t = 0.6931471805599453f * __builtin_amdgcn_logf(1.0f + __builtin_amdgcn_exp2f(-LOG2E * fabsf(z))); \
                        lk[r] = v ? (fminf(-z, 0.f) - t) : 0.f; \
                        PX[r] = v ? (fminf(z, 0.f) - t) : -INFINITY; } \
                    _Pragma("unroll") for (int g = 3; g >= 0; --g) { \
                        const float G = (lk[4 * g] + lk[4 * g + 1]) + (lk[4 * g + 2] + lk[4 * g + 3]); \
                        const float PG = xlane32(G); \
                        float la = run + (hi ? 0.f : PG); \
                        run += G + PG; \
                        PX[4 * g + 3] += la; la += lk[4 * g + 3]; PX[4 * g + 2] += la; la += lk[4 * g + 2]; PX[4 * g + 1] += la; la += lk[4 * g + 1]; PX[4 * g] += la; } \
                    _Pragma("unroll") for (int r = 0; r < 16; ++r) PX[r] = __builtin_amdgcn_exp2f(LOG2E * PX[r]); } while (0)
                    SB_HALF(p1, 32);
                    SB_HALF(p0, 0);
#undef SB_HALF
                    carry = run;
                }
                unsigned pw[16];
#pragma unroll
                for (int j = 0; j < 8; ++j) { pw[j] = cvtpk(p0[2 * j], p0[2 * j + 1]); pw[8 + j] = cvtpk(p1[2 * j], p1[2 * j + 1]); }
#pragma unroll
                for (int s = 0; s < 4; ++s) {
                    bf16x8_t pb; { const unsigned* q = pw + 4 * s; typedef unsigned u32x4_t __attribute__((ext_vector_type(4))); u32x4_t t4 = {q[0], q[1], q[2], q[3]}; pb = __builtin_bit_cast(bf16x8_t, t4); }
#pragma unroll
                    for (int dt = 0; dt < 2; ++dt) {
                        typedef short s16x4_t __attribute__((ext_vector_type(4)));
                        typedef __attribute__((address_space(3))) s16x4_t lds_s16x4;
                        const int gi_ = lane & 15;
                        const bf16* vp = vt_ + (16 * s + 4 * hi + (gi_ >> 2)) * AT_VP + 32 * dt + 16 * ((lane >> 4) & 1) + 4 * (gi_ & 3);
                        const s16x4_t lo = __builtin_amdgcn_ds_read_tr16_b64_v4i16((lds_s16x4*)vp), hi4 = __builtin_amdgcn_ds_read_tr16_b64_v4i16((lds_s16x4*)(vp + 8 * AT_VP));
                        const bf16x8_t va = {lo[0], lo[1], lo[2], lo[3], hi4[0], hi4[1], hi4[2], hi4[3]};
                        if (dt == 0) o0 = __builtin_amdgcn_mfma_f32_32x32x16_bf16(va, pb, o0, 0, 0, 0);
                        else         o1 = __builtin_amdgcn_mfma_f32_32x32x16_bf16(va, pb, o1, 0, 0, 0);
                    }
                }
            }
            if (kind == 3) {
                const float cm = carry;
                if (__all(cm < -110.0f) || !(kt * 64 <= q0w + 31) ) { if (__all(cm < -110.0f)) wave_done = true; }
            }
            if (more) {
                bf16* ksn = (bf16*)(lds + AT_KS + (buf ^ 1) * AT_KS_BYTES); bf16* vtn = (bf16*)(lds + AT_VT + (buf ^ 1) * AT_VT_BYTES);
                *(uint4*)(ksn + skey * AT_KP + sc * 8) = rk;
                *(uint4*)(vtn + skey * AT_VP + sc * 8) = rv;
            }
            if (kind == 3) { if (__syncthreads_and(wave_done ? 1 : 0)) break; }
            else __syncthreads();
            buf ^= 1;
        }
        float inv;
        if (kind == 3) inv = 1.0f;
        else {
            float lt = l_run + xlane32(l_run);
            if (kind == 1) { const float mf = fmaxf(m_run, sink2); const float sc2 = exp2f(m_run - mf); lt = lt * sc2 + exp2f(sink2 - mf); inv = sc2 / lt; }
            else inv = 1.0f / lt;
        }
        bf16* yp = ys + (size_t)(b * S_ + qpos) * 1024 + ycol + 4 * hi;
#pragma unroll
        for (int g = 0; g < 4; ++g) {
            *(uint2*)(yp + 8 * g) = make_uint2(cvtpk(o0[4 * g] * inv, o0[4 * g + 1] * inv), cvtpk(o0[4 * g + 2] * inv, o0[4 * g + 3] * inv));
            *(uint2*)(yp + 32 + 8 * g) = make_uint2(cvtpk(o1[4 * g] * inv, o1[4 * g + 1] * inv), cvtpk(o1[4 * g + 2] * inv, o1[4 * g + 3] * inv));
        }
    }
}
__device__ void attn_fast_phase(int WV_, const bf16* P, const unsigned char* mask, const float* kmean, const float* sinks, bf16* ys,
                                const unsigned* utab, unsigned* counter, unsigned char* lds) {
    volatile unsigned* s_unit = (volatile unsigned*)(lds + AT_MISC);
    for (;;) {
        __syncthreads();
        if (LTID(WV_) == 0) s_unit[0] = atomicAdd(counter, 1u);
        __syncthreads();
        const unsigned ui = s_unit[0];
        if (ui >= 512u) break;
        const unsigned ue = utab[ui];
        const int kind = (int)(ue >> 30), b = (int)((ue >> 28) & 3u), ux = (int)((ue >> 8) & 255u), uy = (int)(ue & 255u);
        if (kind == 0) attn_unit<0>(WV_, P, mask, kmean, sinks, ys, lds, b, ux, uy);
        else attn_unit<2>(WV_, P, mask, kmean, sinks, ys, lds, b, ux, uy);
    }
    for (int u = LBID(); u < 256; u += LGRID()) { __syncthreads(); attn_unit<3>(WV_, P, mask, kmean, sinks, ys, lds, u >> 6, (u >> 4) & 3, u & 15); }
    for (int u = LBID(); u < 256; u += LGRID()) { __syncthreads(); attn_unit<1>(WV_, P, mask, kmean, sinks, ys, lds, u >> 6, (u >> 5) & 1, u & 31); }
}

constexpr float U_SCALE = 128.0f, V_SCALE = 48.0f;
constexpr int ROW6 = 1536;
typedef float v32f_t __attribute__((ext_vector_type(32)));
typedef unsigned v6u_t __attribute__((ext_vector_type(6)));
typedef unsigned u32x4a8_t __attribute__((ext_vector_type(4), aligned(8)));
__device__ __forceinline__ float rdlane_f(float v, int l) { return __builtin_bit_cast(float, __builtin_amdgcn_readlane(__builtin_bit_cast(int, v), l)); }
__device__ __forceinline__ unsigned q_e2m3(float v) {
    const float a = fminf(fabsf(v), 7.5f);
    unsigned code;
    if (a < 1.0f) code = (unsigned)rintf(a * 8.0f);
    else if (a < 2.0f) code = 8u + (unsigned)rintf((a - 1.0f) * 8.0f);
    else if (a < 4.0f) code = 16u + (unsigned)rintf((a - 2.0f) * 4.0f);
    else code = 24u + (unsigned)rintf((a - 4.0f) * 2.0f);
    return code | (v < 0.f ? 32u : 0u);
}
__device__ __forceinline__ void cvt_chunk6(const float4 (&a)[8], float sc, unsigned (&w)[6]) {
#pragma unroll
    for (int d = 0; d < 6; ++d) w[d] = 0u;
#pragma unroll
    for (int q4 = 0; q4 < 8; ++q4) {
        const float av[4] = {a[q4].x, a[q4].y, a[q4].z, a[q4].w};
#pragma unroll
        for (int e = 0; e < 4; ++e) { const int idx = q4 * 4 + e, bit = 6 * idx, d = bit >> 5, sft = bit & 31; const unsigned code = q_e2m3(av[e] * sc);
            w[d] |= code << sft; if (sft > 26) w[d + 1] |= code >> (32 - sft); }
    }
}
__device__ void convert_tables(int WV_, const Params& p) {
    const size_t nchunk = (size_t)DEPTH_ * 16384 * 2 * 32;
    const size_t stride = (size_t)LGRID() * NTHR;
    for (size_t i = (size_t)LBID() * NTHR + LTID(WV_); i < nchunk; i += 2 * stride) {
        const size_t i2 = i + stride; const bool has2 = i2 < nchunk; const size_t j2 = has2 ? i2 : i;
        const int c0 = (int)(i & 31), uv0 = (int)((i >> 5) & 1); const size_t le0 = i >> 6;
        const int c1 = (int)(j2 & 31), uv1 = (int)((j2 >> 5) & 1); const size_t le1 = j2 >> 6;
        const float* src0 = (uv0 ? p.in[10] : p.in[9]) + le0 * 1024 + c0 * 32;
        const float* src1 = (uv1 ? p.in[10] : p.in[9]) + le1 * 1024 + c1 * 32;
        float4 a0[8], a1[8];
#pragma unroll
        for (int q4 = 0; q4 < 8; ++q4) a0[q4] = ((const float4*)src0)[q4];
#pragma unroll
        for (int q4 = 0; q4 < 8; ++q4) a1[q4] = ((const float4*)src1)[q4];
        unsigned w0[6], w1[6];
        cvt_chunk6(a0, uv0 ? V_SCALE : U_SCALE, w0);
        cvt_chunk6(a1, uv1 ? V_SCALE : U_SCALE, w1);
        uint2* dst0 = (uint2*)(p.ws + WS_UV + le0 * ROW6 + uv0 * 768 + c0 * 24);
        dst0[0] = make_uint2(w0[0], w0[1]); dst0[1] = make_uint2(w0[2], w0[3]); dst0[2] = make_uint2(w0[4], w0[5]);
        if (has2) { uint2* dst1 = (uint2*)(p.ws + WS_UV + le1 * ROW6 + uv1 * 768 + c1 * 24);
            dst1[0] = make_uint2(w1[0], w1[1]); dst1[1] = make_uint2(w1[2], w1[3]); dst1[2] = make_uint2(w1[4], w1[5]); }
    }
}
__device__ __forceinline__ v6u_t ld_pk6(const unsigned char* ptr) {
    const uint2 a = ((const uint2*)ptr)[0], b = ((const uint2*)ptr)[1], c = ((const uint2*)ptr)[2];
    const v6u_t pk = {a.x, a.y, b.x, b.y, c.x, c.y};
    return pk;
}
__device__ void peer_fast_phase(int WV_, float* h, bf16* hb, const int* eid, const float* gate, const unsigned char* uv, const float* g1, const float* b1, const float* g, const float* bb, unsigned char* lds) {
    const int tid = LTID(WV_), lane = tid & 63, wave = tid >> 6, l32 = lane & 31, hi = lane >> 5;
    float* pl = (float*)(lds + wave * 16384);
    unsigned char* raw = lds + wave * 16384 + 4096 + lane * 24;
    for (int t = LBID() * NWAVE + wave; t < T_; t += LGRID() * NWAVE) {
        float* hr = h + (size_t)t * 1024 + l32 * 32;
        float x[32], acc[32];
#pragma unroll
        for (int q4 = 0; q4 < 8; ++q4) { const float4 a = ((const float4*)hr)[q4]; x[4 * q4] = a.x; x[4 * q4 + 1] = a.y; x[4 * q4 + 2] = a.z; x[4 * q4 + 3] = a.w; }
        {
            float s = 0.f;
#pragma unroll
            for (int i = 0; i < 32; ++i) s += x[i];
#pragma unroll
            for (int o = 16; o > 0; o >>= 1) s += __shfl_xor(s, o);
            const float mean = s * (1.0f / 1024.0f);
            float s2 = 0.f;
#pragma unroll
            for (int i = 0; i < 32; ++i) { x[i] -= mean; s2 += x[i] * x[i]; }
#pragma unroll
            for (int o = 16; o > 0; o >>= 1) s2 += __shfl_xor(s2, o);
            const float rstd = 1.0f / sqrtf(s2 * (1.0f / 1024.0f) + LN_EPS);
#pragma unroll
            for (int q4 = 0; q4 < 8; ++q4) { const float4 gg = ((const float4*)(g1 + l32 * 32))[q4], cc = ((const float4*)(b1 + l32 * 32))[q4];
                x[4 * q4] = x[4 * q4] * rstd * gg.x + cc.x; x[4 * q4 + 1] = x[4 * q4 + 1] * rstd * gg.y + cc.y; x[4 * q4 + 2] = x[4 * q4 + 2] * rstd * gg.z + cc.z; x[4 * q4 + 3] = x[4 * q4 + 3] * rstd * gg.w + cc.w; }
        }
#pragma unroll
        for (int i = 0; i < 32; ++i) acc[i] = 0.f;
#pragma unroll 1
        for (int batch = 0; batch < 4; ++batch) {
            const int my_eid = eid[(size_t)t * 128 + batch * 32 + l32];
            const float my_gate = gate[(size_t)t * 128 + batch * 32 + l32];
#pragma unroll 1
            for (int grp = 0; grp < 2; ++grp) {
                { u32x4a8_t pa[8]; uint2 pc[8];
#pragma unroll
                  for (int i = 0; i < 8; ++i) { const int id = __shfl(my_eid, 2 * (grp * 8 + i) + hi); const unsigned char* rp = uv + (size_t)id * ROW6 + l32 * 24; pa[i] = *(const u32x4a8_t*)rp; pc[i] = *(const uint2*)(rp + 16); }
#pragma unroll
                  for (int i = 0; i < 8; ++i) { uint2* wp = (uint2*)(raw + i * 1536); wp[0] = make_uint2(pa[i].x, pa[i].y); wp[1] = make_uint2(pa[i].z, pa[i].w); wp[2] = pc[i]; } }
#pragma unroll 1
                for (int i = 0; i < 8; ++i) {
                    const uint2* rp = (const uint2*)(raw + i * 1536); const uint2 a = rp[0], b = rp[1], c = rp[2];
                    const v6u_t pk6 = {a.x, a.y, b.x, b.y, c.x, c.y}; const v32f_t f = __builtin_amdgcn_cvt_scalef32_pk32_f32_fp6(pk6, 1.0f);
                    f32x2_t dv0 = {0.f, 0.f}, dv1 = {0.f, 0.f};
#pragma unroll
                    for (int j = 0; j < 8; ++j) { const f32x2_t fa = {f[2 * j], f[2 * j + 1]}, fb = {f[16 + 2 * j], f[17 + 2 * j]}, xa = {x[2 * j], x[2 * j + 1]}, xb = {x[16 + 2 * j], x[17 + 2 * j]};
                        dv0 = fa * xa + dv0; dv1 = fb * xb + dv1; }
                    pl[(2 * (grp * 8 + i) + hi) * 32 + l32] = (dv0.x + dv0.y) + (dv1.x + dv1.y);
                }
            }
            float d;
            { const float4* pr = (const float4*)(pl + l32 * 32); float4 s4 = pr[0];
#pragma unroll
              for (int i = 1; i < 8; ++i) { const float4 v = pr[i]; s4.x += v.x; s4.y += v.y; s4.z += v.z; s4.w += v.w; }
              d = ((s4.x + s4.y) + (s4.z + s4.w)) * (1.0f / U_SCALE); }
            const float hv = 0.5f * d * (1.0f + erff(d * 0.70710678118654752f)) * my_gate * (1.0f / V_SCALE);
#pragma unroll 1
            for (int grp = 0; grp < 2; ++grp) {
                { u32x4a8_t pa[8]; uint2 pc[8];
#pragma unroll
                  for (int i = 0; i < 8; ++i) { const int id = __shfl(my_eid, 2 * (grp * 8 + i) + hi); const unsigned char* rp = uv + (size_t)id * ROW6 + 768 + l32 * 24; pa[i] = *(const u32x4a8_t*)rp; pc[i] = *(const uint2*)(rp + 16); }
#pragma unroll
                  for (int i = 0; i < 8; ++i) { uint2* wp = (uint2*)(raw + i * 1536); wp[0] = make_uint2(pa[i].x, pa[i].y); wp[1] = make_uint2(pa[i].z, pa[i].w); wp[2] = pc[i]; } }
#pragma unroll 1
                for (int i = 0; i < 8; ++i) {
                    const float c = __shfl(hv, 2 * (grp * 8 + i) + hi);
                    const uint2* rp = (const uint2*)(raw + i * 1536); const uint2 a = rp[0], b = rp[1], cc = rp[2];
                    const v6u_t pk6 = {a.x, a.y, b.x, b.y, cc.x, cc.y}; const v32f_t f = __builtin_amdgcn_cvt_scalef32_pk32_f32_fp6(pk6, 1.0f);
                    const f32x2_t c2 = {c, c};
#pragma unroll
                    for (int j = 0; j < 16; ++j) { const f32x2_t fj = {f[2 * j], f[2 * j + 1]}; f32x2_t aj = {acc[2 * j], acc[2 * j + 1]}; aj = fj * c2 + aj; acc[2 * j] = aj.x; acc[2 * j + 1] = aj.y; }
                }
            }
        }
        float y[32], s = 0.f;
#pragma unroll
        for (int i = 0; i < 32; ++i) { acc[i] += __shfl_xor(acc[i], 32); y[i] = ALPHA * x[i] + acc[i]; s += y[i]; }
#pragma unroll
        for (int o = 16; o > 0; o >>= 1) s += __shfl_xor(s, o);
        const float mean = s * (1.0f / 1024.0f);
        float s2 = 0.f;
#pragma unroll
        for (int i = 0; i < 32; ++i) { y[i] -= mean; s2 += y[i] * y[i]; }
#pragma unroll
        for (int o = 16; o > 0; o >>= 1) s2 += __shfl_xor(s2, o);
        const float rstd = 1.0f / sqrtf(s2 * (1.0f / 1024.0f) + LN_EPS);
        float o[16];
#pragma unroll
        for (int q4 = 0; q4 < 4; ++q4) {
            const float4 gg = ((const float4*)(g + l32 * 32 + hi * 16))[q4], cc = ((const float4*)(bb + l32 * 32 + hi * 16))[q4];
            float ya[4], yb2[4];
#pragma unroll
            for (int e = 0; e < 4; ++e) { ya[e] = y[4 * q4 + e]; yb2[e] = y[16 + 4 * q4 + e]; }
            asm volatile("" : "+v"(ya[0]), "+v"(ya[1]), "+v"(ya[2]), "+v"(ya[3]), "+v"(yb2[0]), "+v"(yb2[1]), "+v"(yb2[2]), "+v"(yb2[3]));
            const float y0 = hi ? yb2[0] : ya[0], y1 = hi ? yb2[1] : ya[1], y2 = hi ? yb2[2] : ya[2], y3 = hi ? yb2[3] : ya[3];
            o[4 * q4] = y0 * rstd * gg.x + cc.x; o[4 * q4 + 1] = y1 * rstd * gg.y + cc.y; o[4 * q4 + 2] = y2 * rstd * gg.z + cc.z; o[4 * q4 + 3] = y3 * rstd * gg.w + cc.w;
            ((float4*)(hr + hi * 16))[q4] = make_float4(o[4 * q4], o[4 * q4 + 1], o[4 * q4 + 2], o[4 * q4 + 3]);
        }
        uint4* hbp = (uint4*)(hb + (size_t)t * 1024 + l32 * 32 + hi * 16);
        hbp[0] = make_uint4(pk2(o[0], o[1]), pk2(o[2], o[3]), pk2(o[4], o[5]), pk2(o[6], o[7]));
        hbp[1] = make_uint4(pk2(o[8], o[9]), pk2(o[10], o[11]), pk2(o[12], o[13]), pk2(o[14], o[15]));
    }
}

__device__ __forceinline__ float pack_pl(float v, unsigned pl) { return __uint_as_float((__float_as_uint(v) & ~127u) | pl); }
__device__ __forceinline__ void ins16(float (&s)[16], float x) {
#pragma unroll
    for (int k = 15; k >= 1; --k) s[k] = __builtin_amdgcn_fmed3f(s[k - 1], x, s[k]);
    s[0] = vmax(s[0], x);
}
template <int D> __device__ __forceinline__ void bitonic_stage(float (&c)[16]) {
#pragma unroll
    for (int i = 0; i < 16; ++i) if ((i & D) == 0) { const float a = vmax(c[i], c[i + D]), b = vmin(c[i], c[i + D]); c[i] = a; c[i + D] = b; }
}
__device__ __forceinline__ int decode_key(unsigned pl) { return (int)(32u * ((pl >> 4) & 3u) + (pl & 3u) + 8u * ((pl >> 2) & 3u) + 4u * ((pl >> 6) & 1u)); }
__device__ void route_fast_phase(int WV_, const bf16* qb, const bf16* skb  , int* eid, float* gate, unsigned char* lds, int pm = -1, int pn = 0) {
    const int tid = LTID(WV_), lane = tid & 63, wave = tid >> 6, r32 = lane & 31, hi = lane >> 5;
    unsigned* lidx = (unsigned*)lds + wave * (64 * 33) + lane * 33;
    const int u_first = (pm >= 0) ? 0 : LBID() * NWAVE + wave, u_end = (pm >= 0) ? 2 : (T_ / 32) * 8, u_step = (pm >= 0) ? 1 : LGRID() * NWAVE;
    for (int unit = u_first; unit < u_end; unit += u_step) {
        const int h = (pm >= 0) ? 2 * pn + unit : (unit & 7), t = ((pm >= 0) ? 8 * pm + wave : (unit >> 3)) * 32 + r32;
        float sl[2][16];
#pragma unroll
        for (int p = 0; p < 2; ++p) {
            bf16x8_t qf[4];
            { const bf16* qp = qb + (size_t)t * 1024 + h * 128 + p * 64 + 8 * hi;
#pragma unroll
              for (int ks = 0; ks < 4; ++ks) qf[ks] = *(const bf16x8_t*)(qp + 16 * ks); }
            float s[16];
#pragma unroll
            for (int k = 0; k < 16; ++k) s[k] = -INFINITY;
            const bf16* skp = skb + ((size_t)(h * 2 + p) * 128 + r32) * 64 + 8 * hi;
#pragma unroll
            for (int kt = 0; kt < 4; ++kt) {
                f32x16_t acc;
#pragma unroll
                for (int r = 0; r < 16; ++r) acc[r] = 0.f;
#pragma unroll
                for (int ks = 0; ks < 4; ++ks) { const bf16x8_t a = *(const bf16x8_t*)(skp + (size_t)kt * 32 * 64 + 16 * ks); acc = __builtin_amdgcn_mfma_f32_32x32x16_bf16(a, qf[ks], acc, 0, 0, 0); }
#pragma unroll
                for (int r = 0; r < 16; ++r) ins16(s, pack_pl(acc[r], (unsigned)(kt * 16 + r)));
            }
            const unsigned hb = (unsigned)hi << 6;
#pragma unroll
            for (int k = 0; k < 16; ++k) s[k] = __uint_as_float(__float_as_uint(s[k]) | hb);
            float c[16];
#pragma unroll
            for (int k = 0; k < 16; ++k) c[k] = vmax(s[k], __shfl_xor(s[15 - k], 32));
            bitonic_stage<8>(c); bitonic_stage<4>(c); bitonic_stage<2>(c); bitonic_stage<1>(c);
#pragma unroll
            for (int k = 0; k < 16; ++k) { sl[p][k] = c[k]; lidx[p * 16 + k] = (unsigned)decode_key(__float_as_uint(c[k]) & 127u); }
        }
        float w[16];
#pragma unroll
        for (int k = 0; k < 16; ++k) w[k] = -INFINITY;
#pragma unroll
        for (int i = 0; i < 16; ++i)
#pragma unroll
            for (int j = 0; j < 16; ++j)
                if ((i + 1) * (j + 1) <= 16) { const float v = sl[0][i] + sl[1][j]; ins16(w, __uint_as_float((__float_as_uint(v) & ~255u) | (unsigned)(i * 16 + j))); }
        float e[16], sum = 0.f;
#pragma unroll
        for (int k = 0; k < 16; ++k) { e[k] = expf(w[k] - w[0]); sum += e[k]; }
        const float inv = 1.0f / sum;
        int ide[8]; float gte[8];
#pragma unroll
        for (int k = 0; k < 8; ++k) {
            float wa = w[k], wb = w[8 + k], ea = e[k], eb = e[8 + k];
            asm volatile("" : "+v"(wa), "+v"(wb), "+v"(ea), "+v"(eb));
            const float wv = hi ? wb : wa;
            const unsigned pl = __float_as_uint(wv) & 255u;
            ide[k] = (int)(lidx[pl >> 4] * 128u + lidx[16 + (pl & 15u)]);
            gte[k] = (hi ? eb : ea) * inv;
        }
        int* ep = eid + (size_t)t * 128 + h * 16 + hi * 8; float* gp = gate + (size_t)t * 128 + h * 16 + hi * 8;
        *(int4*)ep = make_int4(ide[0], ide[1], ide[2], ide[3]); *(int4*)(ep + 4) = make_int4(ide[4], ide[5], ide[6], ide[7]);
        *(float4*)gp = make_float4(gte[0], gte[1], gte[2], gte[3]); *(float4*)(gp + 4) = make_float4(gte[4], gte[5], gte[6], gte[7]);
    }
}

typedef float f32x4_t __attribute__((ext_vector_type(4)));
typedef __bf16 bf16x2v __attribute__((ext_vector_type(2)));
__device__ __forceinline__ float dot2bf(unsigned a, unsigned b, float c) { return __builtin_amdgcn_fdot2_f32_bf16(__builtin_bit_cast(bf16x2v, a), __builtin_bit_cast(bf16x2v, b), c, false); }
__device__ __forceinline__ void cnt_gt(int& cnt, unsigned a, unsigned b) { asm("v_cmp_gt_u32_e32 vcc, %1, %2\n\tv_addc_co_u32_e32 %0, vcc, 0, %0, vcc" : "+v"(cnt) : "v"(a), "v"(b) : "vcc"); }
__device__ __forceinline__ void cnt_eq(int& cnt, unsigned a, unsigned b) { asm("v_cmp_eq_u32_e32 vcc, %1, %2\n\tv_addc_co_u32_e32 %0, vcc, 0, %0, vcc" : "+v"(cnt) : "v"(a), "v"(b) : "vcc"); }
__device__ __forceinline__ unsigned flag_gt(unsigned a, unsigned b) { unsigned r; asm("v_cmp_gt_u32_e32 vcc, %1, %2\n\tv_cndmask_b32_e64 %0, 0, 1, vcc" : "=v"(r) : "v"(a), "v"(b) : "vcc"); return r; }
__device__ __forceinline__ unsigned flag_eq(unsigned a, unsigned b) { unsigned r; asm("v_cmp_eq_u32_e32 vcc, %1, %2\n\tv_cndmask_b32_e64 %0, 0, 1, vcc" : "=v"(r) : "v"(a), "v"(b) : "vcc"); return r; }
__device__ __forceinline__ void cnt_ge(int& cnt, unsigned key, unsigned cand) { asm("v_cmp_ge_u32_e32 vcc, %1, %2\n\tv_addc_co_u32_e32 %0, vcc, 0, %0, vcc" : "+v"(cnt) : "v"(key), "v"(cand) : "vcc"); }

template <int CTRL, int RM> __device__ __forceinline__ unsigned dpp0(unsigned v) { return (unsigned)__builtin_amdgcn_update_dpp(0, (int)v, CTRL, RM, 0xf, false); }
template <int CTRL> __device__ __forceinline__ unsigned dppf(unsigned v) { return (unsigned)__builtin_amdgcn_update_dpp(-1, (int)v, CTRL, 0xf, 0xf, false); }
__device__ __forceinline__ unsigned wave_sum_u_dpp(unsigned v) {
    v += dpp0<0xB1, 0xf>(v); v += dpp0<0x4E, 0xf>(v); v += dpp0<0x141, 0xf>(v); v += dpp0<0x140, 0xf>(v);
    return (unsigned)__builtin_amdgcn_readlane((int)v, 0) + (unsigned)__builtin_amdgcn_readlane((int)v, 16) + (unsigned)__builtin_amdgcn_readlane((int)v, 32) + (unsigned)__builtin_amdgcn_readlane((int)v, 48);
}
__device__ __forceinline__ unsigned wave_min_u_dpp(unsigned v) {
    unsigned t;
    t = dppf<0xB1>(v); v = t < v ? t : v; t = dppf<0x4E>(v); v = t < v ? t : v; t = dppf<0x141>(v); v = t < v ? t : v; t = dppf<0x140>(v); v = t < v ? t : v;
    const unsigned a = (unsigned)__builtin_amdgcn_readlane((int)v, 0), b = (unsigned)__builtin_amdgcn_readlane((int)v, 16), c = (unsigned)__builtin_amdgcn_readlane((int)v, 32), d = (unsigned)__builtin_amdgcn_readlane((int)v, 48);
    const unsigned ab = a < b ? a : b, cd = c < d ? c : d; return ab < cd ? ab : cd;
}
__device__ __forceinline__ unsigned wave_incl_scan_u_dpp(unsigned v) {
    v += dpp0<0x111, 0xf>(v); v += dpp0<0x112, 0xf>(v); v += dpp0<0x114, 0xf>(v); v += dpp0<0x118, 0xf>(v);
    v += dpp0<0x142, 0xa>(v);
    v += dpp0<0x143, 0xc>(v);
    return v;
}
typedef __attribute__((address_space(3))) unsigned lds_u32;
template <int SHIFT> __device__ __forceinline__ unsigned radix_pass(const unsigned (&key)[64], unsigned pre, lds_u32* hist, int lane, int& need, int jlim, unsigned L) {
    typedef unsigned u32x4v __attribute__((ext_vector_type(4)));
    typedef __attribute__((address_space(3))) u32x4v lds_u32x4;
    const int fl = 63 - lane;
    { const u32x4v z4 = {0u, 0u, 0u, 0u};
#pragma unroll
      for (int i = 0; i < 8; ++i) ((lds_u32x4*)(hist + fl * 32))[i] = z4; }
    const unsigned hb = (unsigned)(size_t)hist + 4u * (unsigned)(lane & 7);
    const unsigned one = 1u;
    asm volatile("" ::: "memory");
#pragma unroll
    for (int j4 = 0; j4 < 16; ++j4) {
        if (4 * j4 <= jlim) {
            bool grp = true;
            if (SHIFT <= 8) {
                const bool any = ((key[4 * j4] >> (SHIFT + 8)) == pre) | ((key[4 * j4 + 1] >> (SHIFT + 8)) == pre) | ((key[4 * j4 + 2] >> (SHIFT + 8)) == pre) | ((key[4 * j4 + 3] >> (SHIFT + 8)) == pre);
                grp = __ballot(any) != 0ull;
            }
            if (grp) {
#pragma unroll
                for (int e = 0; e < 4; ++e) { const int j = 4 * j4 + e;
                    const unsigned addr = hb + (((key[j] >> SHIFT) & 255u) << 5);
                    unsigned long long sv;
                    if (SHIFT == 24) asm volatile("v_cmp_ge_u32_e32 vcc, %1, %2\n\ts_and_saveexec_b64 %0, vcc\n\tds_add_u32 %3, %4\n\ts_mov_b64 exec, %0" : "=&s"(sv) : "v"(key[j]), "v"(L), "v"(addr), "v"(one) : "vcc", "memory");
                    else { const unsigned t = key[j] >> ((SHIFT + 8) & 31);
                        asm volatile("v_cmp_eq_u32_e32 vcc, %1, %2\n\ts_and_saveexec_b64 %0, vcc\n\tds_add_u32 %3, %4\n\ts_mov_b64 exec, %0" : "=&s"(sv) : "v"(t), "v"(pre), "v"(addr), "v"(one) : "vcc", "memory"); }
                }
            }
        }
    }
    asm volatile("s_waitcnt lgkmcnt(0)" ::: "memory");
    unsigned dsum[4]; unsigned sumL = 0u;
#pragma unroll
    for (int i = 0; i < 4; ++i) { const u32x4v v0 = ((const lds_u32x4*)(hist + fl * 32))[2 * i], v1 = ((const lds_u32x4*)(hist + fl * 32))[2 * i + 1];
        dsum[i] = ((v0.x + v0.y) + (v0.z + v0.w)) + ((v1.x + v1.y) + (v1.z + v1.w)); sumL += dsum[i]; }
    const unsigned incl = wave_incl_scan_u_dpp(sumL);
    const unsigned above = incl - sumL;
    const bool own = (above < (unsigned)need) && ((unsigned)need <= above + sumL);
    const int owner = __ffsll((long long)__ballot(own)) - 1;
    unsigned acc = above; int sel = -1; unsigned cab = 0u;
#pragma unroll
    for (int i = 3; i >= 0; --i) { const unsigned c = dsum[i]; const bool hit = (sel < 0) && (acc + c >= (unsigned)need); cab = hit ? acc : cab; sel = hit ? i : sel; acc += c; }
    const int ow = owner < 0 ? 0 : owner;
    const unsigned digit = (unsigned)__builtin_amdgcn_readlane(sel, ow) + (unsigned)(4 * (63 - ow));
    need -= (int)__builtin_amdgcn_readlane((int)cab, ow);
    return digit;
}

__device__ __forceinline__ void idx_select(const unsigned (&key)[64], unsigned t3, int jlim, lds_u32* hist, int lane, uint2* mrow) {
        unsigned wlo = 0u, whi = 0u;
        unsigned L = wave_min_u_dpp(t3);
        L = L > 1u ? L : 1u;

        int need = 256;
        const unsigned d1 = radix_pass<24>(key, 0u, hist, lane, need, jlim, L);
        const unsigned d2 = radix_pass<16>(key, d1, hist, lane, need, jlim, L);
        const unsigned d3 = radix_pass<8>(key, (d1 << 8) | d2, hist, lane, need, jlim, L);
        const unsigned d4 = radix_pass<0>(key, (d1 << 16) | (d2 << 8) | d3, hist, lane, need, jlim, L);
        const unsigned prefix = (d1 << 24) | (d2 << 16) | (d3 << 8) | d4;

        int ceq = 0;
#pragma unroll
        for (int j = 0; j < 64; ++j) cnt_eq(ceq, key[j], prefix);
        ceq = (int)wave_sum_u_dpp((unsigned)ceq);
        int X = 4096;
        if (ceq != need) {
            int X0 = 0;
#pragma unroll 1
            for (int bit = 11; bit >= 0; --bit) {
                const int c = X0 | (1 << bit);
                int cnt = 0; const int crel = (c - lane + 63) >> 6;
#pragma unroll
                for (int j = 0; j < 64; ++j) cnt_eq(cnt, (key[j] ^ prefix) | ~(unsigned)((j - crel) >> 31), 0u);
                cnt = wave_sum_i(cnt);
                if (cnt < need) X0 = c;
            }
            X = X0 + 1;
        }
        const int xrel = (X - lane + 63) >> 6;
#pragma unroll
        for (int j4 = 0; j4 < 16; ++j4) {
            if (4 * j4 <= jlim) {
#pragma unroll
                for (int e = 0; e < 4; ++e) { const int j = 4 * j4 + e;
                    const bool sel = (key[j] > prefix) || (key[j] == prefix && j < xrel);
                    const unsigned long long bm = __ballot(sel);
                    asm("v_writelane_b32 %0, %1, %2" : "+v"(wlo) : "s"((unsigned)bm), "n"(j));
                    asm("v_writelane_b32 %0, %1, %2" : "+v"(whi) : "s"((unsigned)(bm >> 32)), "n"(j)); }
            }
        }
        mrow[lane] = make_uint2(wlo, whi);
}
#ifndef TS_SEL
#define TS_SEL 0
#endif
#define ITS_B() do { if (TS_SEL >= 20 && TS_SEL <= 25 && WV_ == 0 && LANEID() == 0) ((volatile __attribute__((address_space(3))) unsigned long long*)((__attribute__((address_space(3))) unsigned char*)lds + 147456 - 16 - 32))[0] = __builtin_amdgcn_s_memrealtime(); } while (0)
#define ITS_E(k) do { if ((k) == TS_SEL && WV_ == 0 && LANEID() == 0) { volatile __attribute__((address_space(3))) unsigned long long* w_ = (volatile __attribute__((address_space(3))) unsigned long long*)((__attribute__((address_space(3))) unsigned char*)lds + 147456 - 16 - 32); w_[1] += __builtin_amdgcn_s_memrealtime() - w_[0]; } } while (0)
__device__ void index_fast_phase(int WV_, const bf16* P, unsigned char* mask, float* kmean, float* scratch_all, unsigned* qctr, unsigned char* lds) {
    const int tid = LTID(WV_), lane = tid & 63, wave = tid >> 6, bid = LBID(), G = LGRID();
    float* s_part = (float*)lds;
    ITS_B();
    for (int k = bid; k < 256; k += G) {
        const int b = k >> 6, h = (k >> 4) & 3, blk = k & 15;
        const bf16* kp = P + (size_t)(b * S_ + blk * 256 + wave * 32) * NP + C_KC + h * 64 + lane;
        float a = 0.f;
#pragma unroll 8
        for (int j = 0; j < 32; ++j) a += bf2f(kp[(size_t)j * NP]);
        __syncthreads();
        s_part[wave * 64 + lane] = a;
        __syncthreads();
        if (tid < 64) { float s = 0.f;
#pragma unroll
            for (int w = 0; w < 8; ++w) s += s_part[w * 64 + tid];
            kmean[((b * 4 + h) * 16 + blk) * 64 + tid] = s * (1.0f / 256.0f); }
    }
    ITS_E(22);
    constexpr int IDX_CP = 512 + 4;
    constexpr int IDX_PITCH = 4096 + 32;
    float* scr = scratch_all + (size_t)bid * (16 * IDX_PITCH);
    const int lq = lane & 15, g4 = lane >> 4;
    for (int ui = bid; ui < 1024; ui += G) {
        const int b = ui >> 8, k = ui & 255, tile = (b & 1) ? 255 - k : k, q0 = tile * 16;
        const bf16* Pb = P + (size_t)b * S_ * NP;
        const int ntiles = tile + 1;
        int lane_o = LANEID(); asm volatile("" : "+v"(lane_o));
        const int lane = lane_o, lq = lane & 15, g4 = lane >> 4;
        const int wave = WV_;
        const int qA = q0 + 2 * wave, qB = qA + 1;
        uint2* mrowA = (uint2*)(mask + (size_t)(b * S_ + qA) * 512); uint2* mrowB = (uint2*)(mask + (size_t)(b * S_ + qB) * 512);
        if (tile < 16) {
            unsigned wlo = 0u, whi = 0u, xlo = 0u, xhi = 0u; const int ra = qA - lane * 64, rb = qB - lane * 64;
#pragma unroll
            for (int j = 0; j < 32; ++j) { wlo |= (~(unsigned)((ra - j) >> 31) & 1u) << j; whi |= (~(unsigned)((ra - 32 - j) >> 31) & 1u) << j;
                                           xlo |= (~(unsigned)((rb - j) >> 31) & 1u) << j; xhi |= (~(unsigned)((rb - 32 - j) >> 31) & 1u) << j; }
            mrowA[lane] = make_uint2(wlo, whi); mrowB[lane] = make_uint2(xlo, xhi);
            continue;
        }
        bf16x8_t qf[8]; float wi[8];
        { const bf16* qp = Pb + (size_t)(q0 + lq) * NP + C_QI + 8 * g4;
#pragma unroll
          for (int h = 0; h < 8; ++h) qf[h] = *(const bf16x8_t*)(qp + 32 * h);
          const uint4 wv = *(const uint4*)(Pb + (size_t)(q0 + lq) * NP + C_WI); unpack8(wv, wi); }
        bf16x8_t qch, qcl;
        { typedef unsigned u32x4_t __attribute__((ext_vector_type(4)));
          float qc[8];
#pragma unroll
          for (int i = 0; i < 8; ++i) qc[i] = 0.f;
#pragma unroll
          for (int h = 0; h < 8; ++h) { const u32x4_t w4 = __builtin_bit_cast(u32x4_t, qf[h]);
#pragma unroll
              for (int i = 0; i < 4; ++i) { qc[2 * i] += wi[h] * __uint_as_float(w4[i] << 16); qc[2 * i + 1] += wi[h] * __uint_as_float(w4[i] & 0xffff0000u); } }
          u32x4_t hi4, lo4;
#pragma unroll
          for (int i = 0; i < 4; ++i) { const unsigned hw = cvtpk(qc[2 * i], qc[2 * i + 1]); hi4[i] = hw;
              lo4[i] = cvtpk(qc[2 * i] - __uint_as_float(hw << 16), qc[2 * i + 1] - __uint_as_float(hw & 0xffff0000u)); }
          qch = __builtin_bit_cast(bf16x8_t, hi4); qcl = __builtin_bit_cast(bf16x8_t, lo4); }
        typedef __attribute__((address_space(3))) bf16x8_t lds_bf16x8;
        lds_bf16x8* qops = (lds_bf16x8*)((__attribute__((address_space(3))) unsigned char*)lds + 102656);
        if (wave == 0) {
#pragma unroll
            for (int h = 0; h < 8; ++h) qops[h * 64 + lane] = qf[h];
            qops[8 * 64 + lane] = qch; qops[9 * 64 + lane] = qcl; }
        __syncthreads();
        float* cb = (float*)(lds + 69632);
        const int jlim = q0 >> 6;
        const int jmaxA = (qA - lane) >> 6, jmaxB = (qB - lane) >> 6;
        unsigned keyA[64], keyB[64];
        unsigned a0 = 0u, a1 = 0u, a2 = 0u, a3 = 0u, b0 = 0u, b1 = 0u, b2 = 0u, b3 = 0u;
        const bf16* kbase = Pb + (size_t)lq * NP + C_KI + 8 * g4;
        bf16x8_t nxt = *(const bf16x8_t*)(kbase + (size_t)(wave < ntiles ? wave : 0) * 16 * NP);
#pragma unroll
        for (int c = 0; c < 8; ++c) {
            if (32 * c < ntiles) {
#pragma unroll
                for (int j = 0; j < 4; ++j) {
                    const int kt = 32 * c + wave + 8 * j;
                    const bf16x8_t af = nxt;
                    { const int k = kt + 8; const int kc = k < ntiles ? k : 0; nxt = *(const bf16x8_t*)(kbase + (size_t)kc * 16 * NP); }
                    if (kt < ntiles) {
                        const f32x4_t z = {0.f, 0.f, 0.f, 0.f};
                        f32x4_t sc = __builtin_amdgcn_mfma_f32_16x16x32_bf16(af, qops[8 * 64 + lane], z, 0, 0, 0);
                        sc = __builtin_amdgcn_mfma_f32_16x16x32_bf16(af, qops[9 * 64 + lane], sc, 0, 0, 0);
#pragma unroll
                        for (int hh = 0; hh < 2; ++hh) {
                            f32x4_t a[4];
#pragma unroll
                            for (int h = 0; h < 4; ++h) a[h] = __builtin_amdgcn_mfma_f32_16x16x32_bf16(af, qops[(4 * hh + h) * 64 + lane], z, 0, 0, 0);
#pragma unroll
                            for (int h = 0; h < 4; ++h)
#pragma unroll
                                for (int r = 0; r < 4; ++r) sc[r] = __builtin_fmaf(__builtin_fabsf(a[h][r]), wi[4 * hh + h], sc[r]);
                        }
#pragma unroll
                        for (int r = 0; r < 4; ++r) { sc[r] *= 0.03125f; if (sc[r] == 0.f) sc[r] = 0.f; }
                        *(f32x4_t*)(cb + lq * IDX_CP + (wave + 8 * j) * 16 + 4 * g4) = sc;
                    }
                }
                __syncthreads();
#pragma unroll
                for (int js = 0; js < 8; ++js) {
                    const int slot = 8 * c + js;
                    if (slot <= jlim) {
                        const unsigned ua = __float_as_uint(cb[(2 * wave) * IDX_CP + 64 * js + lane]), ub = __float_as_uint(cb[(2 * wave + 1) * IDX_CP + 64 * js + lane]);
                        const unsigned xa = (ua ^ ((unsigned)((int)ua >> 31) | 0x80000000u)) & ~(unsigned)((jmaxA - slot) >> 31);
                        const unsigned xb = (ub ^ ((unsigned)((int)ub >> 31) | 0x80000000u)) & ~(unsigned)((jmaxB - slot) >> 31);
                        keyA[slot] = xa; keyB[slot] = xb;
                        unsigned n1, n2, n3;
                        asm("v_med3_u32 %0, %1, %2, %3" : "=v"(n3) : "v"(a2), "v"(a3), "v"(xa));
                        asm("v_med3_u32 %0, %1, %2, %3" : "=v"(n2) : "v"(a1), "v"(a2), "v"(xa));
                        asm("v_med3_u32 %0, %1, %2, %3" : "=v"(n1) : "v"(a0), "v"(a1), "v"(xa));
                        a0 = a0 > xa ? a0 : xa; a1 = n1; a2 = n2; a3 = n3;
                        asm("v_med3_u32 %0, %1, %2, %3" : "=v"(n3) : "v"(b2), "v"(b3), "v"(xb));
                        asm("v_med3_u32 %0, %1, %2, %3" : "=v"(n2) : "v"(b1), "v"(b2), "v"(xb));
                        asm("v_med3_u32 %0, %1, %2, %3" : "=v"(n1) : "v"(b0), "v"(b1), "v"(xb));
                        b0 = b0 > xb ? b0 : xb; b1 = n1; b2 = n2; b3 = n3;
                    } else { keyA[slot] = 0u; keyB[slot] = 0u; }
                }
                __syncthreads();
            } else {
#pragma unroll
                for (int js = 0; js < 8; ++js) { keyA[8 * c + js] = 0u; keyB[8 * c + js] = 0u; }
            }
        }
        lds_u32* hist = (lds_u32*)((__attribute__((address_space(3))) unsigned char*)lds + 2048) + wave * 2048;
        idx_select(keyA, a3, jlim, hist, lane, mrowA);
        idx_select(keyB, b3, jlim, hist, lane, mrowB);
        __syncthreads();
    }
}

constexpr int MG_P = 72;
constexpr int MG_TILE_BYTES = 128 * MG_P * 2;
__device__ void merge_fast_phase(int WV_, const bf16* P, const bf16* ys, const bf16* wbt  , bf16* merged, unsigned char* lds) {
    const int tid = LTID(WV_), lane = tid & 63, wave = tid >> 6, r32 = lane & 31, hi = lane >> 5, wt = wave & 3, wd = wave >> 2;
    const int srow0 = tid >> 3, sch = tid & 7;
    for (int tile = LBID(); tile < 1024; tile += LGRID()) {
        const int tok0 = (tile >> 3) * 128, d0 = (tile & 7) * 128;
        f32x16_t mer[2], acc[2];
#pragma unroll
        for (int r = 0; r < 16; ++r) { mer[0][r] = 0.f; mer[1][r] = 0.f; acc[0][r] = 0.f; acc[1][r] = 0.f; }
        uint4 RW00, RW01, RW10, RW11, RY00, RY01, RY10, RY11, RG0, RG1, RG2, RG3;
        bf16* gl = (bf16*)(lds + 4 * MG_TILE_BYTES);
        const int grow = tid >> 4, gch = tid & 15;
#define MG_GLOAD(st_, R_) do { const int n_ = (st_) >> 2, kc_ = (st_) & 3; \
            RW##R_##0 = *(const uint4*)(wbt + ((size_t)n_ * 1024 + d0 + srow0) * 256 + kc_ * 64 + sch * 8); \
            RW##R_##1 = *(const uint4*)(wbt + ((size_t)n_ * 1024 + d0 + srow0 + 64) * 256 + kc_ * 64 + sch * 8); \
            RY##R_##0 = *(const uint4*)(ys + (size_t)(tok0 + srow0) * 1024 + n_ * 256 + kc_ * 64 + sch * 8); \
            RY##R_##1 = *(const uint4*)(ys + (size_t)(tok0 + srow0 + 64) * 1024 + n_ * 256 + kc_ * 64 + sch * 8); } while (0)
#define MG_SSTORE(buf_, R_) do { bf16* wl_ = (bf16*)(lds + (buf_) * 2 * MG_TILE_BYTES); bf16* yl_ = (bf16*)(lds + (buf_) * 2 * MG_TILE_BYTES + MG_TILE_BYTES); \
            *(uint4*)(wl_ + srow0 * MG_P + sch * 8) = RW##R_##0; *(uint4*)(wl_ + (srow0 + 64) * MG_P + sch * 8) = RW##R_##1; \
            *(uint4*)(yl_ + srow0 * MG_P + sch * 8) = RY##R_##0; *(uint4*)(yl_ + (srow0 + 64) * MG_P + sch * 8) = RY##R_##1; } while (0)
        __syncthreads();
        MG_GLOAD(0, 0); MG_GLOAD(1, 1);
        MG_SSTORE(0, 0);
        __syncthreads();
#define MG_STAGE(PAR_, OTH_) do { const int buf = PAR_; \
            if (st + 2 < 16) MG_GLOAD(st + 2, PAR_); \
            if ((st & 3) == 1) { const bf16* gsrc = P + (size_t)(tok0 + grow) * NP + C_G + (st >> 2) * 1024 + d0 + gch * 8; \
                RG0 = *(const uint4*)gsrc; RG1 = *(const uint4*)(gsrc + (size_t)32 * NP); RG2 = *(const uint4*)(gsrc + (size_t)64 * NP); RG3 = *(const uint4*)(gsrc + (size_t)96 * NP); } \
            const bf16* wl = (const bf16*)(lds + buf * 2 * MG_TILE_BYTES); const bf16* yl = (const bf16*)(lds + buf * 2 * MG_TILE_BYTES + MG_TILE_BYTES); \
            _Pragma("unroll") for (int ks = 0; ks < 4; ++ks) { \
                const bf16x8_t bq = *(const bf16x8_t*)(yl + (32 * wt + r32) * MG_P + 16 * ks + 8 * hi); \
                const bf16x8_t a0 = *(const bf16x8_t*)(wl + (64 * wd + r32) * MG_P + 16 * ks + 8 * hi); \
                const bf16x8_t a1 = *(const bf16x8_t*)(wl + (64 * wd + 32 + r32) * MG_P + 16 * ks + 8 * hi); \
                acc[0] = __builtin_amdgcn_mfma_f32_32x32x16_bf16(a0, bq, acc[0], 0, 0, 0); \
                acc[1] = __builtin_amdgcn_mfma_f32_32x32x16_bf16(a1, bq, acc[1], 0, 0, 0); } \
            if ((st & 3) == 3) { \
                const int n = st >> 2; \
                const bf16* gp = gl + (32 * wt + r32) * 136 + 64 * wd + 4 * hi; (void)n; \
                _Pragma("unroll") for (int dt = 0; dt < 2; ++dt) \
                _Pragma("unroll") for (int g = 0; g < 4; ++g) { \
                        const uint2 gv = *(const uint2*)(gp + 32 * dt + 8 * g); \
                        const float g0 = __uint_as_float(gv.x << 16), g1 = __uint_as_float(gv.x & 0xffff0000u), g2 = __uint_as_float(gv.y << 16), g3 = __uint_as_float(gv.y & 0xffff0000u); \
                        mer[dt][4 * g + 0] += acc[dt][4 * g + 0] * g0; \
                        mer[dt][4 * g + 1] += acc[dt][4 * g + 1] * g1; \
                        mer[dt][4 * g + 2] += acc[dt][4 * g + 2] * g2; \
                        mer[dt][4 * g + 3] += acc[dt][4 * g + 3] * g3; } \
                _Pragma("unroll") for (int r = 0; r < 16; ++r) { acc[0][r] = 0.f; acc[1][r] = 0.f; } } \
            if (st + 1 < 16) MG_SSTORE(OTH_, OTH_); \
            if ((st & 3) == 2) { *(uint4*)(gl + grow * 136 + gch * 8) = RG0; *(uint4*)(gl + (grow + 32) * 136 + gch * 8) = RG1; *(uint4*)(gl + (grow + 64) * 136 + gch * 8) = RG2; *(uint4*)(gl + (grow + 96) * 136 + gch * 8) = RG3; } \
            __syncthreads(); } while (0)
#pragma unroll 1
        for (int st2 = 0; st2 < 16; st2 += 2) { { const int st = st2; MG_STAGE(0, 1); } { const int st = st2 + 1; MG_STAGE(1, 0); } }
#undef MG_STAGE
#undef MG_GLOAD
#undef MG_SSTORE
        bf16* mp = merged + (size_t)(tok0 + 32 * wt + r32) * 1024 + d0 + 64 * wd + 4 * hi;
#pragma unroll
        for (int dt = 0; dt < 2; ++dt)
#pragma unroll
            for (int g = 0; g < 4; ++g)
                *(uint2*)(mp + 32 * dt + 8 * g) = make_uint2(cvtpk(mer[dt][4 * g], mer[dt][4 * g + 1]), cvtpk(mer[dt][4 * g + 2], mer[dt][4 * g + 3]));
    }
}
#define LAS __attribute__((address_space(3)))
#define XB_TMO      128
#define XB_XCNT(j)  (256  + 64 * (j))
#define XB_XSUB(j)  (1280 + 64 * (j))
#define XB_XGEN(j)  (2304 + 64 * (j))
#define XB_TOP      3328
#define XB_TOPGEN   3392
#define XCD_BAR_WORDS 3456
#define XB_SPIN_CAP (1u << 18)

__device__ __forceinline__ unsigned xb_ld(unsigned* p)              { return __hip_atomic_load(p, __ATOMIC_RELAXED, __HIP_MEMORY_SCOPE_AGENT); }
__device__ __forceinline__ unsigned xb_add(unsigned* p, unsigned v) { return __hip_atomic_fetch_add(p, v, __ATOMIC_RELAXED, __HIP_MEMORY_SCOPE_AGENT); }
__device__ __forceinline__ unsigned xb_xcc_id() { return (unsigned)__builtin_amdgcn_s_getreg((3 << 11) | 20) & 0xFu; }
#define XB_SPIN(cond, bar) do { unsigned _sp = 0; while (cond) { __builtin_amdgcn_s_sleep(1); \
    if ((++_sp & 255u) == 0u) { if (xb_ld(&(bar)[XB_TMO])) break; if (_sp > XB_SPIN_CAP) { atomicAdd(&(bar)[XB_TMO], 1u); break; } } } } while (0)

struct XcdBarrier {
    unsigned* bar; unsigned x;
    volatile LAS unsigned* st;
};

__device__ __forceinline__ XcdBarrier xcd_barrier_post(unsigned* bar, volatile LAS unsigned* st) {
    XcdBarrier b; b.bar = bar; b.x = xb_xcc_id(); b.st = st;
    if (threadIdx.x == 0) (void)xb_add(&bar[XB_XCNT(b.x)], 1u);
    return b;
}
__device__ __forceinline__ void xcd_barrier_complete(unsigned* bar, unsigned x, unsigned& nloc, unsigned& nx) {
    const unsigned G = gridDim.x * gridDim.y * gridDim.z;
    unsigned sum, cnt, mine, sp = 0u;
    for (;;) {
        sum = 0u; cnt = 0u; mine = 0u;
#pragma unroll
        for (unsigned j = 0; j < 16; ++j) { const unsigned c = xb_ld(&bar[XB_XCNT(j)]); sum += c; cnt += (c > 0u) ? 1u : 0u; mine = (j == x) ? c : mine; }
        if (sum == G) break;
        __builtin_amdgcn_s_sleep(1);
        if ((++sp & 255u) == 0u) { if (xb_ld(&bar[XB_TMO])) break; if (sp > XB_SPIN_CAP) { atomicAdd(&bar[XB_TMO], 1u); break; } }
    }
    nloc = mine > 0u ? mine : 1u; nx = cnt > 0u ? cnt : 1u;
}

__device__ __forceinline__ void xcd_barrier(const XcdBarrier& b, int wv_) {
    asm volatile("s_waitcnt vmcnt(0)" ::: "memory");
    __syncthreads();
    if (wv_ == 0 && LANEID() == 0) {
        unsigned* bar = b.bar;
        __builtin_amdgcn_s_waitcnt(0);
        unsigned nloc = b.st[0], nx = b.st[1];
        if (nloc == 0u) { xcd_barrier_complete(bar, b.x, nloc, nx); b.st[0] = nloc; b.st[1] = nx; }
        const unsigned old = xb_add(&bar[XB_XSUB(b.x)], 1u);
        const unsigned gen = old / nloc;
        if (old + 1u == (gen + 1u) * nloc) {
            __builtin_amdgcn_fence(__ATOMIC_RELEASE, "agent");
            asm volatile("s_waitcnt vmcnt(0)" ::: "memory");
            const unsigned og = xb_add(&bar[XB_TOP], 1u);
            const unsigned tg = og / nx;
            if (og + 1u == (tg + 1u) * nx) xb_add(&bar[XB_TOPGEN], 1u);
            else XB_SPIN(xb_ld(&bar[XB_TOPGEN]) == tg, bar);
            __builtin_amdgcn_fence(__ATOMIC_ACQUIRE, "agent");
            xb_add(&bar[XB_XGEN(b.x)], 1u);
            asm volatile("s_waitcnt vmcnt(0)" ::: "memory");
        } else {
            XB_SPIN(xb_ld(&bar[XB_XGEN(b.x)]) == gen, bar);
            __builtin_amdgcn_fence(__ATOMIC_ACQUIRE, "agent");
            asm volatile("s_waitcnt vmcnt(0)" ::: "memory");
        }
    }
    __syncthreads();
}

enum { PH_PRO = 0, PH_GIN, PH_INDEX, PH_ATTN, PH_MERGE, PH_GOUT, PH_LN1, PH_GQ, PH_ROUTE, PH_PEER };
template <int PH> __device__ __forceinline__ void run_phase(int WV_, const Params& p_unused, int l, unsigned char* lds_raw) {
    size_t kaoff_ = 0; asm volatile("" : "+s"(kaoff_));
    typedef const __attribute__((address_space(4))) char* kaptr_t;
    const __attribute__((address_space(4))) Params& p = *(const __attribute__((address_space(4))) Params*)((kaptr_t)__builtin_amdgcn_kernarg_segment_ptr() + kaoff_);
    float* sm = (float*)lds_raw;
    size_t wsoff_ = 0; asm volatile("" : "+s"(wsoff_));
    unsigned char* ws = p.ws + wsoff_;
    float* hbuf = p.out;
    bf16* hb = (bf16*)(ws + WS_HB);
    bf16* P = (bf16*)(ws + WS_P);
    bf16* ys = (bf16*)(ws + WS_YS);
    bf16* mrg = (bf16*)(ws + WS_MRG);
    float* mix = (float*)(ws + WS_MIX);
    float* qb = (float*)(ws + WS_Q);
    unsigned char* mask = ws + WS_MASK;
    int* eid = (int*)(ws + WS_EID);
    float* gate = (float*)(ws + WS_GATE);
    float* kmean = (float*)(ws + WS_KMEAN);
    const float* hin = (l == 0) ? p.in[0] : hbuf;
    if (PH == PH_PRO) { Params pc; for (int i = 0; i < 13; ++i) pc.in[i] = p.in[i]; pc.out = p.out; pc.ws = ws;
        prologue_phase(WV_, pc, sm); convert_tables(WV_, pc);
        for (int i = LBID() * NTHR + LTID(WV_); i < DEPTH_ * 8 * 2 * 128 * 64 / 4; i += LGRID() * NTHR) { const float4 v = ((const float4*)p.in[8])[i]; ((uint2*)(ws + WS_SKB))[i] = make_uint2(pk2(v.x, v.y), pk2(v.z, v.w)); } if (LBID() < 2) build_unit_table((unsigned*)(ws + WS_CTL) + 1024, LBID() * NTHR + LTID(WV_)); }
    else if (PH == PH_GIN) {
        pg8::Gemm g{hb, (const bf16*)(ws + WS_WIN_T + l * WIN_T_BYTES), T_, NP, 1024};
        pg8::StaticOrder S; S.init(T_, NP, (int)LGRID(), (int)LBID());
        pg8::EpiBf16Sig E{P, NP, C_G};
        pg8::gemm_phase<pg8::EpiBf16Sig, pg8::StaticOrder, true, true>(WV_, (PG8_LAS unsigned char*)lds_raw, g, S, E);
    }
    else if (PH == PH_INDEX) index_fast_phase(WV_, P, mask, kmean, (float*)(ws + WS_UV + 48 * MiB), (unsigned*)(ws + WS_CTL) + 64 * l + 16, lds_raw);
    else if (PH == PH_ATTN) attn_fast_phase(WV_, P, mask, kmean, p.in[4] + l * 4, ys, (const unsigned*)(ws + WS_CTL) + 1024, (unsigned*)(ws + WS_CTL) + 64 * l, lds_raw);
    else if (PH == PH_MERGE) merge_fast_phase(WV_, P, ys, (const bf16*)(ws + WS_WBR_T) + (size_t)l * 4 * 1024 * 256, mrg, lds_raw);
    else if (PH == PH_GOUT) {
        pg8::Gemm g{mrg, (const bf16*)(ws + WS_WOUT_T) + (size_t)l * 1024 * 1024, T_, 1024, 1024};
        pg8::StaticOrder S; S.init(T_, 1024, (int)LGRID(), (int)LBID());
        pg8::EpiResY E{hin, hbuf, hb, (float*)(ws + WS_STATS) + (size_t)l * T_ * 2, ALPHA};
        pg8::gemm_phase<pg8::EpiResY, pg8::StaticOrder, true, true>(WV_, (PG8_LAS unsigned char*)lds_raw, g, S, E);
    }
    else if (PH == PH_GQ) {
        pg8::Gemm g{hb, (const bf16*)(ws + WS_WQ_T) + (size_t)l * 1024 * 1024, T_, 1024, 1024};
        pg8::StaticOrder S; S.init(T_, 1024, (int)LGRID(), (int)LBID());
        pg8::EpiLnFold E{(bf16*)qb, (const float*)(ws + WS_STATS) + (size_t)l * T_ * 2, (const float*)(ws + WS_COLS) + l * 2048, (const float*)(ws + WS_COLS) + l * 2048 + 1024, LN_EPS};
        pg8::gemm_phase<pg8::EpiLnFold, pg8::StaticOrder, true, true>(WV_, (PG8_LAS unsigned char*)lds_raw, g, S, E);
        pg8::Unit u0;
        if (LGRID() == 256 && S.next(0, u0)) {
            asm volatile("s_waitcnt vmcnt(0)" ::: "memory"); __syncthreads();
            route_fast_phase(WV_, (const bf16*)qb, (const bf16*)(ws + WS_SKB) + (size_t)l * 8 * 2 * 128 * 64, eid, gate, lds_raw, u0.pm, u0.pn);
        }
    }
    else if (PH == PH_ROUTE) { if (LGRID() != 256) route_fast_phase(WV_, (const bf16*)qb, (const bf16*)(ws + WS_SKB) + (size_t)l * 8 * 2 * 128 * 64, eid, gate, lds_raw); }
    else peer_fast_phase(WV_, hbuf, hb, eid, gate, ws + WS_UV + (size_t)l * 24 * MiB, p.in[5] + l * 1024, p.in[6] + l * 1024, p.in[11] + l * 1024, p.in[12] + l * 1024, lds_raw);
}

constexpr int CW_BAR = 4096;
constexpr int LDS_BARST = LDS_BYTES - 16;
__global__ void __launch_bounds__(NTHR, 2) mk_fwd(Params p) {
    extern __shared__ __attribute__((aligned(16))) unsigned char lds_raw[];
    cg::grid_group grid = cg::this_grid();
    const int WV_ = __builtin_amdgcn_readfirstlane((int)threadIdx.x >> 6);
    { volatile LAS unsigned* bst0 = (volatile LAS unsigned*)((LAS unsigned char*)lds_raw + LDS_BARST); if (threadIdx.x < 4) bst0[threadIdx.x] = 0u; }
    __syncthreads();
    volatile LAS unsigned* bst = (volatile LAS unsigned*)((LAS unsigned char*)lds_raw + LDS_BARST);
    { uint4* z = (uint4*)p.ws; const uint4 z4 = make_uint4(0u, 0u, 0u, 0u);
      for (unsigned i = (unsigned)LBID() * NTHR + (unsigned)LTID(WV_); i < (unsigned)(2 * MiB / 16); i += (unsigned)LGRID() * NTHR) z[i] = z4; }
    grid.sync();
    (void)xcd_barrier_post((unsigned*)(p.ws + WS_CTL) + CW_BAR, bst);
#define GRID_BAR() do { XcdBarrier b_; b_.bar = (unsigned*)(p.ws + WS_CTL) + CW_BAR; b_.x = xb_xcc_id(); b_.st = (volatile LAS unsigned*)((LAS unsigned char*)lds_raw + LDS_BARST); xcd_barrier(b_, WV_); } while (0)
    run_phase<PH_PRO>(WV_, p, 0, lds_raw);
    GRID_BAR();
#pragma unroll 1
    for (int l = 0; l < DEPTH_; ++l) {
        run_phase<PH_GIN>(WV_, p, l, lds_raw); GRID_BAR();
        run_phase<PH_INDEX>(WV_, p, l, lds_raw); GRID_BAR();
        run_phase<PH_ATTN>(WV_, p, l, lds_raw); GRID_BAR();
        run_phase<PH_MERGE>(WV_, p, l, lds_raw); GRID_BAR();
        run_phase<PH_GOUT>(WV_, p, l, lds_raw); GRID_BAR();
        run_phase<PH_GQ>(WV_, p, l, lds_raw); if (LGRID() != 256) { GRID_BAR(); run_phase<PH_ROUTE>(WV_, p, l, lds_raw); } GRID_BAR();
        run_phase<PH_PEER>(WV_, p, l, lds_raw); if (l + 1 < DEPTH_) GRID_BAR();
    }
}

extern "C" void kernel_launch(void* const* d_in, const int* in_sizes, int n_in, void* d_out, int out_size, void* d_ws, size_t ws_size, hipStream_t stream) {
    if (n_in != 13 || ws_size < WS_END) { fprintf(stderr, "kernel_launch: unexpected n_in %d / ws_size %zu; nothing launched\n", n_in, ws_size); return; }
    static int grid_blocks = 0;
    if (grid_blocks == 0) {
        int dev = 0, cus = 0, per_cu = 0;
        (void)hipGetDevice(&dev);
        (void)hipDeviceGetAttribute(&cus, hipDeviceAttributeMultiprocessorCount, dev);
        (void)hipFuncSetAttribute((const void*)mk_fwd, hipFuncAttributeMaxDynamicSharedMemorySize, LDS_BYTES);
        (void)hipOccupancyMaxActiveBlocksPerMultiprocessor(&per_cu, (const void*)mk_fwd, NTHR, LDS_BYTES);
        if (per_cu < 1) fprintf(stderr, "kernel_launch: occupancy query reports %d\n", per_cu);
        grid_blocks = cus;
    }
    Params p{};
    for (int i = 0; i < 13; ++i) p.in[i] = (const float*)d_in[i];
    p.out = (float*)d_out; p.ws = (unsigned char*)d_ws;
    void* args[] = {&p};
    hipError_t e = hipLaunchCooperativeKernel((const void*)mk_fwd, dim3(grid_blocks), dim3(NTHR), args, LDS_BYTES, stream);
    if (e != hipSuccess) fprintf(stderr, "cooperative launch failed: %s (grid %d)\n", hipGetErrorString(e), grid_blocks);
}
```

```cpp
#include <hip/hip_runtime.h>
#include <cstdio>
#include <cstdint>
#include <hip/hip_cooperative_groups.h>
namespace cg = cooperative_groups;

__device__ __forceinline__ int LANEID() { int l; asm volatile("v_mbcnt_lo_u32_b32 %0, -1, 0\n\tv_mbcnt_hi_u32_b32 %0, -1, %0" : "=v"(l)); return l; }
__device__ __forceinline__ int LTID(int wv) { return (wv << 6) | LANEID(); }
__device__ __forceinline__ int LBID() { int t = blockIdx.x; asm volatile("" : "+s"(t)); return t; }
__device__ __forceinline__ int LGRID() { int t = gridDim.x; asm volatile("" : "+s"(t)); return t; }
namespace pg8 {
#define PG8_LAS __attribute__((address_space(3)))
typedef unsigned short bf16_t;
typedef short bf16x8 __attribute__((ext_vector_type(8)));
typedef float f32x4 __attribute__((ext_vector_type(4)));
typedef unsigned u32x4 __attribute__((ext_vector_type(4)));
constexpr int BM = 256, BK = 64, HALF = 128, HTB = HALF * BK * 2  , STAGE_BYTES = 8 * HTB, NXCD = 8, WGM = 8;

__host__ __device__ __forceinline__ int lds_byte(int r, int c) { const int st = (r >> 4) * 2 + (c >> 5), rr = r & 15, cc = c & 31, ob = rr * 64 + cc * 2; return st * 1024 + (ob ^ (((ob >> 9) & 1) << 5)); }
__host__ __device__ __forceinline__ void stage_rc(int b, int& R, int& C) { const int st = b / 1024, sb = b % 1024, swz = sb ^ (((sb >> 9) & 1) << 5); R = (st >> 1) * 16 + swz / 64; C = (st & 1) * 32 + (swz % 64) / 2; }
__host__ __device__ __forceinline__ int perm32(int rho) { const int n = rho >> 4, i = rho & 15; return 8 * (i >> 2) + 4 * n + (i & 3); }

struct Unit { int pm, pn; };
struct Gemm { const bf16_t* A; const bf16_t* Bt; int M, N, K; };

struct StaticOrder {
    int nM, nN, nwg, G, c;
    __host__ __device__ void init(int M, int N, int G_, int c_) { nM = M / BM; nN = N / BM; nwg = nM * nN; G = G_; c = c_; }
    __host__ __device__ bool next(int i, Unit& u) const {
        const long L = (long)i * G + c; if (L >= nwg) return false;
        int wgid = (int)L; { const int q = nwg / NXCD, r = nwg % NXCD, xcd = wgid % NXCD, off = wgid / NXCD; wgid = (xcd < r ? xcd * (q + 1) : r * (q + 1) + (xcd - r) * q) + off; }
        const int nig = WGM * nN, gid = wgid / nig, fm = gid * WGM, gsz = (nM - fm) < WGM ? (nM - fm) : WGM;
        u.pm = fm + ((wgid % nig) % gsz); u.pn = (wgid % nig) / gsz; return true;
    }
    __device__ __forceinline__ void a_ready(const Unit&) const {}
    __device__ __forceinline__ void done(const Unit&) const {}
};

__device__ __forceinline__ unsigned cvt_pk_bf16(float lo, float hi) { unsigned r; asm volatile("v_cvt_pk_bf16_f32 %0, %1, %2" : "=v"(r) : "v"(lo), "v"(hi)); return r; }
typedef float f32x2 __attribute__((ext_vector_type(2)));
__device__ __forceinline__ f32x2 gelu_pk(f32x2 v) {
    const f32x2 av = __builtin_elementwise_abs(v), d = av * 0.2316418882f + 1.0f;
    f32x2 t; t.x = __builtin_amdgcn_rcpf(d.x); t.y = __builtin_amdgcn_rcpf(d.y);
    f32x2 q = t * 0.5307027145f + (-0.7265760135f); q = q * t + 0.7107068705f; q = q * t + (-0.142248368f); q = q * t + 0.127414796f; q = q * t;
    const f32x2 s = (v * v) * (-0.72134752044f);
    f32x2 e; e.x = __builtin_amdgcn_exp2f(s.x); e.y = __builtin_amdgcn_exp2f(s.y);
    const f32x2 m = v * (q * e), r = v - m;
    f32x2 o; o.x = v.x < 0.f ? m.x : r.x; o.y = v.y < 0.f ? m.y : r.y; return o;
}

template <int ACT  > struct EpiBf16 {
    static constexpr bool PERM = true, AFTER_DRAIN = false; static_assert(ACT == 0 || ACT == 1, "EpiBf16: ACT is 0 (none) or 1 (gelu_pk)");
    bf16_t* O; int ldc; const float* bias; int split_cols; size_t split_stride; float scale0;
    __device__ __forceinline__ void operator()(const f32x4 (&acc)[2][2][4][2], const Unit& u, int wr, int wc, int fr, int fq) const {
        { int ln_ = LANEID(); asm volatile("" : "+v"(ln_)); fr = ln_ & 15; fq = ln_ >> 4; }
        const int row0 = u.pm * BM + wr * 64 + fr; int colt = u.pn * BM; bf16_t* base = O;
        float sc = 1.f; if (split_cols) { const int t = colt / split_cols; base += (size_t)t * split_stride; colt -= t * split_cols; if (t == 0) sc = scale0; }
        const int col0 = colt + wc * 32 + 8 * fq, bcol0 = u.pn * BM + wc * 32 + 8 * fq;
        f32x4 bv[2][2];
#pragma unroll
        for (int bj = 0; bj < 2; ++bj)
#pragma unroll
            for (int n = 0; n < 2; ++n) bv[bj][n] = bias ? *(const f32x4*)(bias + bcol0 + bj * HALF + 4 * n) : (f32x4){0.f, 0.f, 0.f, 0.f};
#pragma unroll
        for (int ai = 0; ai < 2; ++ai)
#pragma unroll
            for (int m = 0; m < 4; ++m) { bf16_t* rowp = base + (size_t)(row0 + ai * HALF + m * 16) * ldc + col0;
#pragma unroll
                for (int bj = 0; bj < 2; ++bj) { f32x4 v0 = acc[ai][bj][m][0] + bv[bj][0], v1 = acc[ai][bj][m][1] + bv[bj][1];
                    if (ACT == 1) { f32x2 a = gelu_pk((f32x2){v0[0], v0[1]}), b = gelu_pk((f32x2){v0[2], v0[3]}), c = gelu_pk((f32x2){v1[0], v1[1]}), d = gelu_pk((f32x2){v1[2], v1[3]});
                        v0 = (f32x4){a.x, a.y, b.x, b.y}; v1 = (f32x4){c.x, c.y, d.x, d.y}; }
                    v0 = v0 * sc; v1 = v1 * sc; u32x4 w; w.x = cvt_pk_bf16(v0[0], v0[1]); w.y = cvt_pk_bf16(v0[2], v0[3]); w.z = cvt_pk_bf16(v1[0], v1[1]); w.w = cvt_pk_bf16(v1[2], v1[3]);
                    *(u32x4*)(rowp + bj * HALF) = w; } }
    }
};
template <class Epi, class Sched, bool ALIGN_EPI = false, bool SP2 = false>
__device__ __forceinline__ void gemm_phase(int WV_, PG8_LAS unsigned char* lds, const Gemm g, const Sched& S, const Epi& E) {
    const int tid = LTID(WV_), wid = __builtin_amdgcn_readfirstlane(tid >> 6), lane = tid & 63, wr = wid >> 2, wc = wid & 3, fr = lane & 15, fq = lane >> 4;
    const int K = g.K, nt = K / BK;
    unsigned voffA[2], voffB[2];
#pragma unroll
    for (int i = 0; i < 2; ++i) { int R, C; stage_rc(tid * 16 + i * 8192, R, C); const int Rb = Epi::PERM ? ((R & ~31) + perm32(R & 31)) : R;
        voffA[i] = (unsigned)(R * K + C) * 2u; voffB[i] = (unsigned)(Rb * K + C) * 2u; }
    const size_t kstep = (size_t)(BK * 2);
    const size_t hstep = (size_t)HALF * K * 2;
    const size_t tstep = 2 * hstep;
    const unsigned ldsw = (unsigned)wid * 1024u;
    const int aoff = lds_byte(wr * 64 + fr, fq * 8), boff = lds_byte(wc * 32 + fr, fq * 8);
#define PG8_SA(b, h) (((b) * 2 + (h)) * HTB)
#define PG8_SB(b, h) ((4 + (b) * 2 + (h)) * HTB)
#define PG8_STAGE(bufoff, gbase, voff) do { _Pragma("unroll") for (int _i = 0; _i < 2; ++_i) \
        __builtin_amdgcn_global_load_lds((const unsigned*)((const char*)(gbase) + (voff)[_i]), (PG8_LAS unsigned*)(lds + (bufoff) + ldsw + _i * 8192), 16, 0, 0); } while (0)
#define PG8_LDA(dst, b, h) do { _Pragma("unroll") for (int m = 0; m < 4; ++m) _Pragma("unroll") for (int k = 0; k < 2; ++k) dst[m][k] = *(const PG8_LAS bf16x8*)(lds + PG8_SA(b, h) + aoff + m * 2048 + k * 1024); } while (0)
#define PG8_LDB(dst, b, h) do { _Pragma("unroll") for (int n = 0; n < 2; ++n) _Pragma("unroll") for (int k = 0; k < 2; ++k) dst[n][k] = *(const PG8_LAS bf16x8*)(lds + PG8_SB(b, h) + boff + n * 2048 + k * 1024); } while (0)
#define PG8_MMA(ai, bj, At, Bt) do { __builtin_amdgcn_s_setprio(1); _Pragma("unroll") for (int m = 0; m < 4; ++m) _Pragma("unroll") for (int n = 0; n < 2; ++n) _Pragma("unroll") for (int k = 0; k < 2; ++k) \
        acc[ai][bj][m][n] = __builtin_amdgcn_mfma_f32_16x16x32_bf16(Bt[n][k], At[m][k], acc[ai][bj][m][n], 0, 0, 0); __builtin_amdgcn_s_setprio(0); } while (0)
#define PG8_WAIT_V(n) asm volatile("s_waitcnt vmcnt(" #n ")" ::: "memory")
#define PG8_WAIT_L(n) asm volatile("s_waitcnt lgkmcnt(" #n ")" ::: "memory")
#define PG8_BAR __builtin_amdgcn_s_barrier()
#define PG8_SCHED __builtin_amdgcn_sched_barrier(0)
    Unit cur, nxt; int ui = 0;
    if (!S.next(0, cur)) return;
    f32x4 acc[2][2][4][2];
#pragma unroll
    for (int a = 0; a < 2; ++a)
#pragma unroll
        for (int b = 0; b < 2; ++b)
#pragma unroll
            for (int m = 0; m < 4; ++m)
#pragma unroll
                for (int n = 0; n < 2; ++n) acc[a][b][m][n] = (f32x4){0.f, 0.f, 0.f, 0.f};
    bf16x8 At[4][2], B0[2][2], B1[2][2];
    const char* cA = (const char*)g.A + (size_t)cur.pm * tstep; const char* cB = (const char*)g.Bt + (size_t)cur.pn * tstep;
    S.a_ready(cur);
    if constexpr (SP2) {
        PG8_STAGE(PG8_SB(0, 0), cB, voffB); PG8_STAGE(PG8_SB(0, 1), cB + hstep, voffB); PG8_STAGE(PG8_SA(0, 0), cA, voffA); PG8_STAGE(PG8_SA(0, 1), cA + hstep, voffA);
        if (wr == 1) PG8_BAR;
        PG8_WAIT_V(2); PG8_BAR;
        PG8_STAGE(PG8_SB(1, 0), cB + kstep, voffB); PG8_STAGE(PG8_SA(1, 0), cA + kstep, voffA); PG8_STAGE(PG8_SB(1, 1), cB + hstep + kstep, voffB);
        PG8_WAIT_V(6); PG8_BAR;
    } else {
        PG8_STAGE(PG8_SB(0, 0), cB, voffB); PG8_STAGE(PG8_SA(0, 0), cA, voffA); PG8_STAGE(PG8_SB(0, 1), cB + hstep, voffB); PG8_STAGE(PG8_SA(0, 1), cA + hstep, voffA);
        if (wr == 1) PG8_BAR;
        PG8_WAIT_V(4); PG8_BAR;
        PG8_STAGE(PG8_SB(1, 0), cB + kstep, voffB); PG8_STAGE(PG8_SA(1, 0), cA + kstep, voffA); PG8_STAGE(PG8_SB(1, 1), cB + hstep + kstep, voffB);
        PG8_WAIT_V(6); PG8_BAR;
    }
    for (;;) {
        const bool has_next = S.next(ui + 1, nxt);
        const char* nA = has_next ? (const char*)g.A + (size_t)nxt.pm * tstep : cA; const char* nB = has_next ? (const char*)g.Bt + (size_t)nxt.pn * tstep : cB;
        for (int t = 0; t < nt; t += 2) {
            const bool last = (t == nt - 2);
            const char* a1 = cA + (size_t)(t + 1) * kstep;
            const char* a2 = last ? nA : cA + (size_t)(t + 2) * kstep; const char* b2 = last ? nB : cB + (size_t)(t + 2) * kstep;
            const char* a3 = a2 + kstep; const char* b3 = b2 + kstep;
            if (last && has_next) S.a_ready(nxt);
            if constexpr (SP2) {
            PG8_LDB(B0, 0, 0); PG8_LDB(B1, 0, 1); PG8_SCHED; PG8_LDA(At, 0, 0); PG8_STAGE(PG8_SA(1, 1), a1 + hstep, voffA);
            PG8_WAIT_V(8); PG8_WAIT_L(0); PG8_BAR; PG8_MMA(0, 0, At, B0); PG8_MMA(0, 1, At, B1); PG8_BAR; PG8_SCHED;
            PG8_LDA(At, 0, 1); PG8_STAGE(PG8_SB(0, 0), b2, voffB); PG8_STAGE(PG8_SB(0, 1), b2 + hstep, voffB); PG8_STAGE(PG8_SA(0, 0), a2, voffA);
            PG8_WAIT_V(8); PG8_WAIT_L(0); PG8_BAR; PG8_MMA(1, 0, At, B0); PG8_MMA(1, 1, At, B1); PG8_BAR; PG8_SCHED;
            PG8_LDB(B0, 1, 0); PG8_LDB(B1, 1, 1); PG8_SCHED; PG8_LDA(At, 1, 0); PG8_STAGE(PG8_SA(0, 1), a2 + hstep, voffA);
            PG8_WAIT_V(8); PG8_WAIT_L(0); PG8_BAR; PG8_MMA(0, 0, At, B0); PG8_MMA(0, 1, At, B1); PG8_BAR; PG8_SCHED;
            PG8_LDA(At, 1, 1); PG8_STAGE(PG8_SB(1, 0), b3, voffB); PG8_STAGE(PG8_SB(1, 1), b3 + hstep, voffB); PG8_STAGE(PG8_SA(1, 0), a3, voffA);
            PG8_WAIT_V(8); PG8_WAIT_L(0); PG8_BAR; PG8_MMA(1, 0, At, B0); PG8_MMA(1, 1, At, B1); PG8_BAR; PG8_SCHED;
            } else {
            PG8_LDB(B0, 0, 0); PG8_SCHED; PG8_LDA(At, 0, 0); PG8_STAGE(PG8_SA(1, 1), a1 + hstep, voffA);
            PG8_WAIT_L(8); PG8_BAR; PG8_WAIT_L(0); PG8_MMA(0, 0, At, B0); PG8_BAR; PG8_SCHED;
            PG8_LDB(B1, 0, 1); PG8_STAGE(PG8_SB(0, 0), b2, voffB);
            PG8_BAR; PG8_WAIT_L(0); PG8_MMA(0, 1, At, B1); PG8_BAR;
            PG8_LDA(At, 0, 1); PG8_STAGE(PG8_SA(0, 0), a2, voffA);
            PG8_BAR; PG8_WAIT_L(0); PG8_MMA(1, 0, At, B0); PG8_BAR; PG8_SCHED;
            PG8_STAGE(PG8_SB(0, 1), b2 + hstep, voffB);
            PG8_WAIT_V(6); PG8_BAR; PG8_MMA(1, 1, At, B1); PG8_BAR;
            PG8_LDB(B0, 1, 0); PG8_SCHED; PG8_LDA(At, 1, 0); PG8_STAGE(PG8_SA(0, 1), a2 + hstep, voffA);
            PG8_WAIT_L(8); PG8_BAR; PG8_WAIT_L(0); PG8_MMA(0, 0, At, B0); PG8_BAR; PG8_SCHED;
            PG8_LDB(B1, 1, 1); PG8_STAGE(PG8_SB(1, 0), b3, voffB);
            PG8_BAR; PG8_WAIT_L(0); PG8_MMA(0, 1, At, B1); PG8_BAR;
            PG8_LDA(At, 1, 1); PG8_STAGE(PG8_SA(1, 0), a3, voffA);
            PG8_BAR; PG8_WAIT_L(0); PG8_MMA(1, 0, At, B0); PG8_BAR; PG8_SCHED;
            PG8_STAGE(PG8_SB(1, 1), b3 + hstep, voffB);
            PG8_WAIT_V(6); PG8_BAR; PG8_MMA(1, 1, At, B1); PG8_BAR;
            }
        }
        if constexpr (ALIGN_EPI) { if (wr == 0) PG8_BAR; }
        if constexpr (!Epi::AFTER_DRAIN) { E(acc, cur, wr, wc, fr, fq); S.done(cur); }
        if (!has_next) break;
#pragma unroll
        for (int a = 0; a < 2; ++a)
#pragma unroll
            for (int b = 0; b < 2; ++b)
#pragma unroll
                for (int m = 0; m < 4; ++m)
#pragma unroll
                    for (int n = 0; n < 2; ++n) acc[a][b][m][n] = (f32x4){0.f, 0.f, 0.f, 0.f};
        cur = nxt; cA = nA; cB = nB; ++ui;
        if constexpr (ALIGN_EPI) { if (wr == 1) PG8_BAR; }
    }
    PG8_WAIT_V(0);
    if constexpr (!ALIGN_EPI) { if (wr == 0) PG8_BAR; }
    PG8_BAR;
    if constexpr (Epi::AFTER_DRAIN) { E.fused(acc, cur, wr, wc, fr, fq, lds, wid, lane); S.done(cur); }
#undef PG8_SA
#undef PG8_SB
#undef PG8_STAGE
#undef PG8_LDA
#undef PG8_LDB
#undef PG8_MMA
#undef PG8_WAIT_V
#undef PG8_WAIT_L
#undef PG8_BAR
#undef PG8_SCHED
}
}
namespace pg8 {
struct EpiF32 {
    static constexpr bool PERM = false, AFTER_DRAIN = false;
    float* O; int ldc;
    __device__ __forceinline__ void operator()(const f32x4 (&acc)[2][2][4][2], const Unit& u, int wr, int wc, int fr, int fq) const {
        { int ln_ = LANEID(); asm volatile("" : "+v"(ln_)); fr = ln_ & 15; fq = ln_ >> 4; }
        const int row0 = u.pm * BM + wr * 64 + fr, col0 = u.pn * BM + wc * 32 + 4 * fq;
#pragma unroll
        for (int ai = 0; ai < 2; ++ai)
#pragma unroll
            for (int m = 0; m < 4; ++m) { float* rowp = O + (size_t)(row0 + ai * HALF + m * 16) * ldc + col0;
#pragma unroll
                for (int bj = 0; bj < 2; ++bj)
#pragma unroll
                    for (int n = 0; n < 2; ++n) *(f32x4*)(rowp + bj * HALF + n * 16) = acc[ai][bj][m][n]; }
    }
};
struct EpiResY {
    static constexpr bool PERM = false, AFTER_DRAIN = false;
    const float* hin; const bf16_t* hinb; bf16_t* yb; float* stats; float alpha;
    __device__ __forceinline__ void operator()(const f32x4 (&acc)[2][2][4][2], const Unit& u, int wr, int wc, int fr, int fq) const {
        { int ln_ = LANEID(); asm volatile("" : "+v"(ln_)); fr = ln_ & 15; fq = ln_ >> 4; }
        const int row0 = u.pm * BM + wr * 64 + fr, col0 = u.pn * BM + wc * 32 + 4 * fq;
#pragma unroll
        for (int ai = 0; ai < 2; ++ai)
#pragma unroll
            for (int m = 0; m < 4; ++m) {
                const int row = row0 + ai * HALF + m * 16;
                float s = 0.f, s2 = 0.f;
#pragma unroll
                for (int bj = 0; bj < 2; ++bj)
#pragma unroll
                    for (int n = 0; n < 2; ++n) {
                        const size_t off = (size_t)row * 1024 + col0 + bj * HALF + n * 16;
                        f32x4 hv;
                        if (hin) hv = *(const f32x4*)(hin + off);
                        else { typedef unsigned u32x2r __attribute__((ext_vector_type(2))); const u32x2r hw = *(const u32x2r*)(hinb + off);
                            hv[0] = __uint_as_float(hw.x << 16); hv[1] = __uint_as_float(hw.x & 0xffff0000u); hv[2] = __uint_as_float(hw.y << 16); hv[3] = __uint_as_float(hw.y & 0xffff0000u); }
                        const f32x4 y = hv * alpha + acc[ai][bj][m][n];
                        typedef unsigned u32x2v __attribute__((ext_vector_type(2)));
                        u32x2v w; w.x = cvt_pk_bf16(y[0], y[1]); w.y = cvt_pk_bf16(y[2], y[3]);
                        *(u32x2v*)(yb + off) = w;
                        s += (y[0] + y[1]) + (y[2] + y[3]); s2 += (y[0] * y[0] + y[1] * y[1]) + (y[2] * y[2] + y[3] * y[3]);
                    }
                s += __shfl_xor(s, 16); s += __shfl_xor(s, 32); s2 += __shfl_xor(s2, 16); s2 += __shfl_xor(s2, 32);
                if (fq == 0) { atomicAdd(stats + 2 * (size_t)row, s); atomicAdd(stats + 2 * (size_t)row + 1, s2); }
            }
    }
};
struct EpiLnFold {
    static constexpr bool PERM = true, AFTER_DRAIN = false;
    bf16_t* O; const float* stats; const float* colsum; const float* colbias; float eps;
    __device__ __forceinline__ void operator()(const f32x4 (&acc)[2][2][4][2], const Unit& u, int wr, int wc, int fr, int fq) const {
        { int ln_ = LANEID(); asm volatile("" : "+v"(ln_)); fr = ln_ & 15; fq = ln_ >> 4; }
        const int row0 = u.pm * BM + wr * 64 + fr, col0 = u.pn * BM + wc * 32 + 8 * fq;
        f32x4 cs[2][2], cb[2][2];
#pragma unroll
        for (int bj = 0; bj < 2; ++bj)
#pragma unroll
            for (int n = 0; n < 2; ++n) { cs[bj][n] = *(const f32x4*)(colsum + col0 + bj * HALF + 4 * n); cb[bj][n] = *(const f32x4*)(colbias + col0 + bj * HALF + 4 * n); }
#pragma unroll
        for (int ai = 0; ai < 2; ++ai)
#pragma unroll
            for (int m = 0; m < 4; ++m) {
                const int row = row0 + ai * HALF + m * 16;
                const float sm_ = stats[2 * (size_t)row], sq_ = stats[2 * (size_t)row + 1];
                const float mean = sm_ * (1.0f / 1024.0f);
                const float rstd = 1.0f / sqrtf(fmaxf(sq_ * (1.0f / 1024.0f) - mean * mean, 0.f) + eps);
                bf16_t* rowp = O + (size_t)row * 1024 + col0;
#pragma unroll
                for (int bj = 0; bj < 2; ++bj) {
                    const f32x4 v0 = (acc[ai][bj][m][0] - cs[bj][0] * mean) * rstd + cb[bj][0], v1 = (acc[ai][bj][m][1] - cs[bj][1] * mean) * rstd + cb[bj][1];
                    u32x4 w; w.x = cvt_pk_bf16(v0[0], v0[1]); w.y = cvt_pk_bf16(v0[2], v0[3]); w.z = cvt_pk_bf16(v1[0], v1[1]); w.w = cvt_pk_bf16(v1[2], v1[3]);
                    *(u32x4*)(rowp + bj * HALF) = w;
                }
            }
    }
};
__device__ __forceinline__ unsigned cvt_pk_bf16_t(float lo, float hi) { unsigned r; asm volatile("s_nop 0\n\tv_cvt_pk_bf16_f32 %0, %1, %2" : "=v"(r) : "v"(lo), "v"(hi)); return r; }
struct EpiBf16Sig {
    static constexpr bool PERM = true, AFTER_DRAIN = false;
    bf16_t* O; int ldc; int sig_col0;
    __device__ __forceinline__ void operator()(const f32x4 (&acc)[2][2][4][2], const Unit& u, int wr, int wc, int fr, int fq) const {
        { int ln_ = LANEID(); asm volatile("" : "+v"(ln_)); fr = ln_ & 15; fq = ln_ >> 4; }
        const int row0 = u.pm * BM + wr * 64 + fr; const int col0 = u.pn * BM + wc * 32 + 8 * fq;
#pragma unroll
        for (int bj = 0; bj < 2; ++bj) {
            if (col0 + bj * HALF >= sig_col0) {
#pragma unroll
                for (int ai = 0; ai < 2; ++ai)
#pragma unroll
                    for (int m = 0; m < 4; ++m) { bf16_t* rowp = O + (size_t)(row0 + ai * HALF + m * 16) * ldc + col0;
                        f32x4 v0 = acc[ai][bj][m][0], v1 = acc[ai][bj][m][1];
#pragma unroll
                        for (int e = 0; e < 4; ++e) { v0[e] = __builtin_amdgcn_rcpf(1.f + __builtin_amdgcn_exp2f(-1.44269504f * v0[e])); v1[e] = __builtin_amdgcn_rcpf(1.f + __builtin_amdgcn_exp2f(-1.44269504f * v1[e])); }
                        u32x4 w; w.x = cvt_pk_bf16_t(v0[0], v0[1]); w.y = cvt_pk_bf16_t(v0[2], v0[3]); w.z = cvt_pk_bf16_t(v1[0], v1[1]); w.w = cvt_pk_bf16_t(v1[2], v1[3]);
                        *(u32x4*)(rowp + bj * HALF) = w; }
            } else {
#pragma unroll
                for (int ai = 0; ai < 2; ++ai)
#pragma unroll
                    for (int m = 0; m < 4; ++m) { bf16_t* rowp = O + (size_t)(row0 + ai * HALF + m * 16) * ldc + col0;
                        const f32x4 v0 = acc[ai][bj][m][0], v1 = acc[ai][bj][m][1];
                        u32x4 w; w.x = cvt_pk_bf16(v0[0], v0[1]); w.y = cvt_pk_bf16(v0[2], v0[3]); w.z = cvt_pk_bf16(v1[0], v1[1]); w.w = cvt_pk_bf16(v1[2], v1[3]);
                        *(u32x4*)(rowp + bj * HALF) = w; }
            }
        }
    }
};
}

typedef unsigned short bf16;
constexpr int T_ = 16384, S_ = 4096, NBATCH = 4, D_ = 1024, NCOL = 6824, NP = 6912, DEPTH_ = 2;
constexpr int C_QA = 0, C_KA = 256, C_VA = 320, C_QI = 384, C_KI = 640, C_WI = 672, C_QB = 680, C_KB = 936, C_VB = 1064,
              C_QC = 1192, C_KC = 1448, C_VC = 1704, C_QD = 1960, C_KD = 2216, C_VD = 2472, C_G = 2728;
constexpr int NTHR = 512, NWAVE = 8;
constexpr float ALPHA = 1.41421356237309515f;
constexpr float LN_EPS = 1e-5f;
constexpr size_t MiB = 1u << 20;
constexpr size_t WS_STATS = 1 * MiB  , WS_COLS = 1 * MiB + 512 * 1024  ;
constexpr size_t WS_CTL = 0, WS_WIN_T = 2 * MiB, WS_WOUT_T = 30 * MiB, WS_WQ_T = 34 * MiB, WS_WBR_T = 38 * MiB, WS_HB = 42 * MiB,
                 WS_P = 74 * MiB, WS_MIX = 74 * MiB  , WS_Q = 138 * MiB  , WS_YS = 290 * MiB, WS_MRG = 322 * MiB,
                 WS_MASK = 354 * MiB, WS_EID = 362 * MiB, WS_GATE = 370 * MiB, WS_KMEAN = 378 * MiB, WS_SKB = 379 * MiB, WS_UV = 380 * MiB, WS_END = 508 * MiB;
constexpr size_t WIN_T_BYTES = (size_t)NP * 1024 * 2;
constexpr int LDS_BYTES = 144 * 1024;

struct Params { const float* in[13]; float* out; unsigned char* ws; };

__device__ __forceinline__ float bf2f(bf16 v) { return __uint_as_float((unsigned)v << 16); }
__device__ __forceinline__ unsigned f2bf(float f) { unsigned u = __float_as_uint(f); return (u + 0x7fffu + ((u >> 16) & 1u)) >> 16; }
__device__ __forceinline__ unsigned pk2(float lo, float hi) { return f2bf(lo) | (f2bf(hi) << 16); }
__device__ __forceinline__ void unpack8(const uint4 v, float* o) {
    o[0] = __uint_as_float(v.x << 16); o[1] = __uint_as_float(v.x & 0xffff0000u); o[2] = __uint_as_float(v.y << 16); o[3] = __uint_as_float(v.y & 0xffff0000u);
    o[4] = __uint_as_float(v.z << 16); o[5] = __uint_as_float(v.z & 0xffff0000u); o[6] = __uint_as_float(v.w << 16); o[7] = __uint_as_float(v.w & 0xffff0000u);
}
__device__ __forceinline__ float wave_sum(float v) {
#pragma unroll
    for (int o = 32; o > 0; o >>= 1) v += __shfl_xor(v, o);
    return v;
}
__device__ __forceinline__ float wave_max(float v) {
#pragma unroll
    for (int o = 32; o > 0; o >>= 1) v = fmaxf(v, __shfl_xor(v, o));
    return v;
}
__device__ __forceinline__ int wave_sum_i(int v) {
#pragma unroll
    for (int o = 32; o > 0; o >>= 1) v += __shfl_xor(v, o);
    return v;
}
__device__ __forceinline__ float logsig(float x) { return fminf(x, 0.f) - log1pf(expf(-fabsf(x))); }

__device__ void transpose_items(int WV_, const float* W, int K, int N, bf16* WT, float* sm, int item0, int nitems_total, int item_stride,
                                const float* rs_g = nullptr, const float* rs_b = nullptr, float* colsum = nullptr, float* colbias = nullptr) {
    const int tid = LTID(WV_);
    const int nkb = K / 64, nnb = (N + 63) / 64;
    for (int it = item0; it < nkb * nnb; it += item_stride) {
        const int kb = it % nkb, nb = it / nkb, k0 = kb * 64, n0 = nb * 64;
        __syncthreads();
        for (int e = tid; e < 64 * 64; e += NTHR) { const int kk = e >> 6, nn = e & 63; sm[kk * 65 + nn] = (n0 + nn < N) ? W[(size_t)(k0 + kk) * N + n0 + nn] : 0.f; }
        __syncthreads();
        if (rs_g) {
            if (tid < 64) { float cs = 0.f, cb = 0.f;
                for (int kk = 0; kk < 64; ++kk) { const float w = sm[kk * 65 + tid]; cs += w * rs_g[k0 + kk]; cb += w * rs_b[k0 + kk]; }
                atomicAdd(colsum + n0 + tid, cs); atomicAdd(colbias + n0 + tid, cb); }
            __syncthreads();
            for (int e = tid; e < 64 * 64; e += NTHR) { const int kk = e >> 6, nn = e & 63; sm[kk * 65 + nn] *= rs_g[k0 + kk]; }
            __syncthreads();
        }
        { const int nn = tid >> 3, c = tid & 7;
          if (n0 + nn < N) { uint4 o; o.x = pk2(sm[(8 * c + 0) * 65 + nn], sm[(8 * c + 1) * 65 + nn]); o.y = pk2(sm[(8 * c + 2) * 65 + nn], sm[(8 * c + 3) * 65 + nn]);
              o.z = pk2(sm[(8 * c + 4) * 65 + nn], sm[(8 * c + 5) * 65 + nn]); o.w = pk2(sm[(8 * c + 6) * 65 + nn], sm[(8 * c + 7) * 65 + nn]);
              *(uint4*)(WT + (size_t)(n0 + nn) * K + k0 + 8 * c) = o; } }
    }
    __syncthreads();
}
constexpr int TI_WIN = 16 * ((NCOL + 63) / 64), TI_SQ = 256, TI_LAYER = TI_WIN + 3 * TI_SQ;
#define TITEM_DECODE(it_, W_, WT_, K_, N_, k0_, n0_, fold_, l_) do { \
        l_ = (it_) / TI_LAYER; const int r_ = (it_) - l_ * TI_LAYER; \
        const int kind_ = r_ < TI_WIN ? 0 : (r_ < TI_WIN + TI_SQ ? 1 : (r_ < TI_WIN + 2 * TI_SQ ? 2 : 3)); \
        const int q_ = r_ - (kind_ == 0 ? 0 : TI_WIN + (kind_ - 1) * TI_SQ); \
        fold_ = kind_ == 2; K_ = kind_ == 3 ? 256 : 1024; N_ = kind_ == 0 ? NCOL : 1024; \
        k0_ = kind_ == 3 ? (q_ & 3) * 64 : (q_ & 15) * 64; n0_ = kind_ == 3 ? ((q_ & 63) >> 2) * 64 : (q_ >> 4) * 64; \
        const int nbr_ = q_ >> 6; \
        W_ = kind_ == 0 ? pin1 + (size_t)l_ * 1024 * NCOL : kind_ == 1 ? pin3 + (size_t)l_ * 1024 * 1024 : kind_ == 2 ? pin7 + (size_t)l_ * 1024 * 1024 : pin2 + ((size_t)l_ * 4 + nbr_) * 256 * 1024; \
        WT_ = kind_ == 0 ? (bf16*)(ws + WS_WIN_T + l_ * WIN_T_BYTES) : kind_ == 1 ? (bf16*)(ws + WS_WOUT_T) + (size_t)l_ * 1024 * 1024 : kind_ == 2 ? (bf16*)(ws + WS_WQ_T) + (size_t)l_ * 1024 * 1024 \
              : (bf16*)(ws + WS_WBR_T) + ((size_t)l_ * 4 + nbr_) * 1024 * 256; } while (0)
__device__ __forceinline__ void titem_finish(bf16* WT, int K, int N, int k0, int n0, const float* rs_g, const float* rs_b, float* colsum, float* colbias, float* sm, int tid) {
    if (rs_g) {
        if (tid < 64) { float cs = 0.f, cb = 0.f;
            for (int kk = 0; kk < 64; ++kk) { const float w = sm[kk * 65 + tid]; cs += w * rs_g[k0 + kk]; cb += w * rs_b[k0 + kk]; }
            atomicAdd(colsum + n0 + tid, cs); atomicAdd(colbias + n0 + tid, cb); }
        __syncthreads();
        for (int e = tid; e < 64 * 64; e += NTHR) { const int kk = e >> 6, nn = e & 63; sm[kk * 65 + nn] *= rs_g[k0 + kk]; }
        __syncthreads();
    }
    { const int nn = tid >> 3, c = tid & 7;
      if (n0 + nn < N) { uint4 o; o.x = pk2(sm[(8 * c + 0) * 65 + nn], sm[(8 * c + 1) * 65 + nn]); o.y = pk2(sm[(8 * c + 2) * 65 + nn], sm[(8 * c + 3) * 65 + nn]);
          o.z = pk2(sm[(8 * c + 4) * 65 + nn], sm[(8 * c + 5) * 65 + nn]); o.w = pk2(sm[(8 * c + 6) * 65 + nn], sm[(8 * c + 7) * 65 + nn]);
          *(uint4*)(WT + (size_t)(n0 + nn) * K + k0 + 8 * c) = o; } }
}
__device__ void prologue_phase(int WV_, const Params& p, float* sm) {
    const int tid = LTID(WV_), B = LBID(), G = LGRID();
    unsigned char* ws = p.ws;
    float* sm1 = sm + 64 * 65;
    const float* pin1 = p.in[1]; const float* pin2 = p.in[2]; const float* pin3 = p.in[3]; const float* pin7 = p.in[7]; const float* pin5 = p.in[5]; const float* pin6 = p.in[6];
    asm volatile("" : "+s"(pin1), "+s"(pin2), "+s"(pin3), "+s"(pin7), "+s"(pin5), "+s"(pin6));
    const int kk0 = tid >> 4, c4 = tid & 15;
    for (int it = B; it < DEPTH_ * TI_LAYER; it += 2 * G) {
        const int it2 = it + G; const bool has2 = it2 < DEPTH_ * TI_LAYER;
        const float* Wa; const float* Wb; bf16* WTa; bf16* WTb; int Ka, Na, k0a, n0a, la, Kb, Nb, k0b, n0b, lb; bool fa, fb;
        TITEM_DECODE(it, Wa, WTa, Ka, Na, k0a, n0a, fa, la);
        { const int itb = has2 ? it2 : it; TITEM_DECODE(itb, Wb, WTb, Kb, Nb, k0b, n0b, fb, lb); }
        const float4 z4 = make_float4(0.f, 0.f, 0.f, 0.f);
        const bool ina = n0a + 4 * c4 < Na, inb = n0b + 4 * c4 < Nb;
        float4 a0 = z4, a1 = z4, b0 = z4, b1 = z4;
        if (ina) { a0 = *(const float4*)(Wa + (size_t)(k0a + kk0) * Na + n0a + 4 * c4); a1 = *(const float4*)(Wa + (size_t)(k0a + kk0 + 32) * Na + n0a + 4 * c4); }
        if (inb) { b0 = *(const float4*)(Wb + (size_t)(k0b + kk0) * Nb + n0b + 4 * c4); b1 = *(const float4*)(Wb + (size_t)(k0b + kk0 + 32) * Nb + n0b + 4 * c4); }
        __syncthreads();
        { float* d = sm + kk0 * 65 + 4 * c4; d[0] = a0.x; d[1] = a0.y; d[2] = a0.z; d[3] = a0.w; d += 32 * 65; d[0] = a1.x; d[1] = a1.y; d[2] = a1.z; d[3] = a1.w; }
        { float* d = sm1 + kk0 * 65 + 4 * c4; d[0] = b0.x; d[1] = b0.y; d[2] = b0.z; d[3] = b0.w; d += 32 * 65; d[0] = b1.x; d[1] = b1.y; d[2] = b1.z; d[3] = b1.w; }
        __syncthreads();
        titem_finish(WTa, Ka, Na, k0a, n0a, fa ? pin5 + la * 1024 : nullptr, pin6 + la * 1024, (float*)(ws + WS_COLS) + la * 2048, (float*)(ws + WS_COLS) + la * 2048 + 1024, sm, tid);
        if (has2) titem_finish(WTb, Kb, Nb, k0b, n0b, fb ? pin5 + lb * 1024 : nullptr, pin6 + lb * 1024, (float*)(ws + WS_COLS) + lb * 2048, (float*)(ws + WS_COLS) + lb * 2048 + 1024, sm1, tid);
    }
    __syncthreads();
    for (int l = 0; l < DEPTH_; ++l) {
        bf16* win_t = (bf16*)(ws + WS_WIN_T + l * WIN_T_BYTES);
        for (int i = B * NTHR + tid; i < (NP - NCOL) * 1024 / 8; i += G * NTHR) ((uint4*)(win_t + (size_t)NCOL * 1024))[i] = make_uint4(0u, 0u, 0u, 0u);
    }
    const float4* x4 = (const float4*)p.in[0]; uint2* hb2 = (uint2*)(ws + WS_HB);
    for (size_t i = (size_t)B * NTHR + tid; i < (size_t)T_ * 1024 / 4; i += (size_t)G * NTHR) { const float4 v = x4[i]; hb2[i] = make_uint2(pk2(v.x, v.y), pk2(v.z, v.w)); }
}

__device__ __forceinline__ void ln_row(float4 (&v)[4], const float* g, const float* bb, float* orow, bf16* obrow, int lane) {
    float s = 0.f;
#pragma unroll
    for (int j = 0; j < 4; ++j) s += (v[j].x + v[j].y) + (v[j].z + v[j].w);
    const float mean = wave_sum(s) * (1.0f / 1024.0f);
    float s2 = 0.f;
#pragma unroll
    for (int j = 0; j < 4; ++j) { v[j].x -= mean; v[j].y -= mean; v[j].z -= mean; v[j].w -= mean; s2 += (v[j].x * v[j].x + v[j].y * v[j].y) + (v[j].z * v[j].z + v[j].w * v[j].w); }
    const float rstd = 1.0f / sqrtf(wave_sum(s2) * (1.0f / 1024.0f) + LN_EPS);
#pragma unroll
    for (int j = 0; j < 4; ++j) {
        const float4 gg = ((const float4*)g)[j * 64 + lane], b4 = ((const float4*)bb)[j * 64 + lane];
        float4 o; o.x = v[j].x * rstd * gg.x + b4.x; o.y = v[j].y * rstd * gg.y + b4.y; o.z = v[j].z * rstd * gg.z + b4.z; o.w = v[j].w * rstd * gg.w + b4.w;
        ((float4*)orow)[j * 64 + lane] = o;
        ((uint2*)obrow)[j * 64 + lane] = make_uint2(pk2(o.x, o.y), pk2(o.z, o.w));
    }
}
__device__ void ln1_phase(int WV_, const float* hin, const float* add, const float* g, const float* bb, float* hout, bf16* hb) {
    const int lane = LTID(WV_) & 63, wave = LTID(WV_) >> 6;
    for (int row = LBID() * NWAVE + wave; row < T_; row += LGRID() * NWAVE) {
        float4 v[4];
#pragma unroll
        for (int j = 0; j < 4; ++j) {
            const float4 a = ((const float4*)(hin + (size_t)row * 1024))[j * 64 + lane], m = ((const float4*)(add + (size_t)row * 1024))[j * 64 + lane];
            v[j].x = ALPHA * a.x + m.x; v[j].y = ALPHA * a.y + m.y; v[j].z = ALPHA * a.z + m.z; v[j].w = ALPHA * a.w + m.w;
        }
        ln_row(v, g, bb, hout + (size_t)row * 1024, hb + (size_t)row * 1024, lane);
    }
}


typedef short bf16x8_t __attribute__((ext_vector_type(8)));
typedef float f32x16_t __attribute__((ext_vector_type(16)));
typedef float f32x2_t __attribute__((ext_vector_type(2)));
typedef __bf16 bf16x2_t __attribute__((ext_vector_type(2)));
__device__ __forceinline__ unsigned cvtpk(float lo, float hi) { f32x2_t v = {lo, hi}; bf16x2_t b = __builtin_convertvector(v, bf16x2_t); return __builtin_bit_cast(unsigned, b); }
__device__ __forceinline__ int crow(int r, int hi) { return (r & 3) + 8 * (r >> 2) + 4 * hi; }
__device__ __forceinline__ float xlane32(float v) { return __shfl_xor(v, 32); }
__device__ __forceinline__ float vmax(float a, float b) { float r; asm("v_max_f32_e32 %0, %1, %2" : "=v"(r) : "v"(a), "v"(b)); return r; }
__device__ __forceinline__ float vmin(float a, float b) { float r; asm("v_min_f32_e32 %0, %1, %2" : "=v"(r) : "v"(a), "v"(b)); return r; }
__device__ __forceinline__ float vmax3(float a, float b, float c) { float r; asm("v_max3_f32 %0, %1, %2, %3" : "=v"(r) : "v"(a), "v"(b), "v"(c)); return r; }

constexpr int AT_KP = 72, AT_VP = 96;
constexpr int AT_KS = 0, AT_KS_BYTES = 64 * AT_KP * 2;
constexpr int AT_VT = 2 * AT_KS_BYTES, AT_VT_BYTES = 64 * AT_VP * 2;
constexpr int AT_KM = AT_VT + 2 * AT_VT_BYTES;
constexpr int AT_MISC = AT_KM + 32 * AT_KP * 2;
constexpr float LOG2E = 1.4426950408889634f;

__device__ __forceinline__ unsigned mk_unit(int kind, int b, int x, int y) { return ((unsigned)kind << 30) | ((unsigned)b << 28) | ((unsigned)x << 8) | (unsigned)y; }
__device__ void build_unit_table(unsigned* tab, int i) {
    int n = 0; unsigned res = 0u;
#pragma unroll 1
    for (int c = 64; c >= 1; --c) {
        if (i >= n && i < n + 4) res = mk_unit(0, i - n, 0, c - 1);
        n += 4;
        if ((c & 3) == 0) { if (i >= n && i < n + 16) { const int j = i - n; res = mk_unit(2, j >> 2, j & 3, c / 4 - 1); } n += 16; }
    }
    if (i < 512) tab[i] = res;
}

template <int kind> __device__ __forceinline__ void attn_unit(int WV_, const bf16* P, const unsigned char* mask, const float* kmean, const float* sinks, bf16* ys,
                                unsigned char* lds, int b, int ux, int uy) {
    int tid_ = LTID(WV_); asm volatile("" : "+v"(tid_));
    const int tid = tid_, lane = tid & 63, wave = __builtin_amdgcn_readfirstlane(tid >> 6), r32 = lane & 31, hi = lane >> 5;
    bf16* s_km = (bf16*)(lds + AT_KM);
    const int skey = tid >> 3, sc = tid & 7;
    {
        const bf16* Pb = P + (size_t)b * S_ * NP;
        int q0w, qcol, kcol, vcol, ycol, kt_hi, kt_lo; float slope2 = 0.f, sink2 = 0.f;
        if (kind == 0) { const int head = wave >> 1; q0w = uy * 64 + (wave & 1) * 32; qcol = C_QA + head * 64; kcol = C_KA; vcol = C_VA; ycol = head * 64;
            slope2 = exp2f(-8.0f * (float)(3 * head + 1) / 12.0f) * LOG2E; kt_hi = uy; kt_lo = 0; }
        else if (kind == 1) { const int hq = ux * 2 + (wave >> 2); q0w = uy * 128 + (wave & 3) * 32; qcol = C_QB + hq * 64; kcol = C_KB + ux * 64; vcol = C_VB + ux * 64; ycol = 256 + hq * 64;
            slope2 = exp2f(-8.0f * (float)(3 * hq + 2) / 12.0f) * LOG2E; sink2 = sinks[hq] * LOG2E; kt_hi = 2 * uy + 1; kt_lo = (2 * uy - 2 > 0) ? 2 * uy - 2 : 0; }
        else if (kind == 2) { q0w = uy * 256 + wave * 32; qcol = C_QC + ux * 64; kcol = C_KC + ux * 64; vcol = C_VC + ux * 64; ycol = 512 + ux * 64;
            slope2 = exp2f(-8.0f * (float)(3 * ux + 3) / 12.0f) * LOG2E; kt_hi = 4 * uy + 3; kt_lo = 0; }
        else { q0w = uy * 256 + wave * 32; qcol = C_QD + ux * 64; kcol = C_KD + ux * 64; vcol = C_VD + ux * 64; ycol = 768 + ux * 64; kt_hi = 4 * uy + 3; kt_lo = 0; }
        const int qpos = q0w + r32;
        bf16x8_t qf[4];
        { const bf16* qp = Pb + (size_t)qpos * NP + qcol + 8 * hi;
#pragma unroll
          for (int ks = 0; ks < 4; ++ks) qf[ks] = *(const bf16x8_t*)(qp + 16 * ks); }
        {
            const float qs = (kind == 3) ? 0.125f : 0.125f * LOG2E;
            typedef unsigned u32x4_t __attribute__((ext_vector_type(4)));
#pragma unroll
            for (int ks = 0; ks < 4; ++ks) { u32x4_t w = __builtin_bit_cast(u32x4_t, qf[ks]);
#pragma unroll
                for (int i = 0; i < 4; ++i) w[i] = cvtpk(__uint_as_float(w[i] << 16) * qs, __uint_as_float(w[i] & 0xffff0000u) * qs);
                qf[ks] = __builtin_bit_cast(bf16x8_t, w); }
        }
        float sb[16];
#pragma unroll
        for (int r = 0; r < 16; ++r) sb[r] = slope2 * (float)((r & 3) + 8 * (r >> 2));
        unsigned bm = 0u;
        if (kind == 2) {
            const int own = uy;
            for (int e = tid; e < 32 * 64; e += NTHR) { const int row = e >> 6, d = e & 63; s_km[row * AT_KP + d] = (row < 16) ? (bf16)f2bf(kmean[((b * 4 + ux) * 16 + row) * 64 + d]) : (bf16)0; }
            __syncthreads();
            f32x16_t gacc;
#pragma unroll
            for (int r = 0; r < 16; ++r) gacc[r] = 0.f;
#pragma unroll
            for (int ks = 0; ks < 4; ++ks) { const bf16x8_t a = *(const bf16x8_t*)(s_km + r32 * AT_KP + 16 * ks + 8 * hi); gacc = __builtin_amdgcn_mfma_f32_32x32x16_bf16(a, qf[ks], gacc, 0, 0, 0); }
            float gt[16];
#pragma unroll
            for (int r = 0; r < 8; ++r) { const float mine = gacc[r], other = xlane32(mine); const int bi = crow(r, 0);
                gt[bi] = hi ? other : mine; gt[bi + 4] = hi ? mine : other; }
#pragma unroll
            for (int n = 0; n < 16; ++n) if (n >= own) gt[n] = -INFINITY;
#pragma unroll
            for (int rep = 0; rep < 3; ++rep) {
                float mx = -INFINITY;
#pragma unroll
                for (int n = 0; n < 16; ++n) mx = fmaxf(mx, gt[n]);
                bool done = !(mx > -INFINITY);
#pragma unroll
                for (int n = 0; n < 16; ++n) { const bool hit = !done && gt[n] == mx; if (hit) { bm |= 1u << n; gt[n] = -INFINITY; done = true; } }
            }
        }
        f32x16_t o0, o1;
#pragma unroll
        for (int r = 0; r < 16; ++r) { o0[r] = 0.f; o1[r] = 0.f; }
        float m_run = -INFINITY, l_run = 0.f, carry = 0.f;
        const bf16* kg = Pb + (size_t)skey * NP + kcol + sc * 8;
        const bf16* vg = Pb + (size_t)skey * NP + vcol + sc * 8;
        uint4 rk = *(const uint4*)(kg + (size_t)kt_hi * 64 * NP), rv = *(const uint4*)(vg + (size_t)kt_hi * 64 * NP);
        int buf = 0;
        { bf16* ks_ = (bf16*)(lds + AT_KS); bf16* vt_ = (bf16*)(lds + AT_VT);
          *(uint4*)(ks_ + skey * AT_KP + sc * 8) = rk;
          *(uint4*)(vt_ + skey * AT_VP + sc * 8) = rv; }
        __syncthreads();
        bool wave_done = false;
        uint2 mw_next = make_uint2(0u, 0u);
        if (kind == 0) mw_next = *(const uint2*)(mask + (size_t)(b * S_ + qpos) * 512 + kt_hi * 8);
        for (int kt = kt_hi; kt >= kt_lo; --kt) {
            const bool more = kt > kt_lo;
            const uint2 mw = mw_next;
            if (kind == 0 && more) mw_next = *(const uint2*)(mask + (size_t)(b * S_ + qpos) * 512 + (kt - 1) * 8);
            if (more) { rk = *(const uint4*)(kg + (size_t)(kt - 1) * 64 * NP); rv = *(const uint4*)(vg + (size_t)(kt - 1) * 64 * NP); }
            const bf16* ks_ = (const bf16*)(lds + AT_KS + buf * AT_KS_BYTES);
            const bf16* vt_ = (const bf16*)(lds + AT_VT + buf * AT_VT_BYTES);
            bool active = (kt * 64 <= q0w + 31) && !wave_done;
            if (kind == 1) active = active && (kt * 64 + 63 >= q0w - 127);
            if (active) {
                const int kbase = kt * 64 + 4 * hi;
                f32x16_t p0, p1;
                if (kind != 3) {
                    const float cb = slope2 * (float)(kbase - qpos), cb1 = cb + 32.0f * slope2;
#pragma unroll
                    for (int r = 0; r < 16; ++r) { p0[r] = cb + sb[r]; p1[r] = cb1 + sb[r]; }
                } else {
#pragma unroll
                    for (int r = 0; r < 16; ++r) { p0[r] = 0.f; p1[r] = 0.f; }
                }
#pragma unroll
                for (int ks = 0; ks < 4; ++ks) {
                    const bf16x8_t a0 = *(const bf16x8_t*)(ks_ + r32 * AT_KP + 16 * ks + 8 * hi);
                    const bf16x8_t a1 = *(const bf16x8_t*)(ks_ + (32 + r32) * AT_KP + 16 * ks + 8 * hi);
                    p0 = __builtin_amdgcn_mfma_f32_32x32x16_bf16(a0, qf[ks], p0, 0, 0, 0);
                    p1 = __builtin_amdgcn_mfma_f32_32x32x16_bf16(a1, qf[ks], p1, 0, 0, 0);
                }
                if (kind != 3) {
                    float mx = -INFINITY;
                    if (kind == 0) {
                        const unsigned w0 = mw.x >> (4 * hi), w1 = mw.y >> (4 * hi);
#pragma unroll
                        for (int r = 0; r < 16; ++r) { const int off = (r & 3) + 8 * (r >> 2);
                            p0[r] = (w0 & (1u << off)) ? p0[r] : -INFINITY; p1[r] = (w1 & (1u << off)) ? p1[r] : -INFINITY; mx = vmax3(mx, p0[r], p1[r]); }
                    } else if (kind == 1) {
                        const int rel = qpos - kbase;
#pragma unroll
                        for (int r = 0; r < 16; ++r) { const int off = (r & 3) + 8 * (r >> 2);
                            p0[r] = ((unsigned)(rel - off) < 128u) ? p0[r] : -INFINITY; p1[r] = ((unsigned)(rel - off - 32) < 128u) ? p1[r] : -INFINITY; mx = vmax3(mx, p0[r], p1[r]); }
                    } else {
                        if ((kt >> 2) == uy) {
                            const int rel = qpos - kbase;
#pragma unroll
                            for (int r = 0; r < 16; ++r) { const int off = (r & 3) + 8 * (r >> 2);
                                p0[r] = (off <= rel) ? p0[r] : -INFINITY; p1[r] = (off + 32 <= rel) ? p1[r] : -INFINITY; mx = vmax3(mx, p0[r], p1[r]); }
                        } else {
                            const bool tile_ok = ((bm >> (kt >> 2)) & 1u) != 0u;
#pragma unroll
                            for (int r = 0; r < 16; ++r) { p0[r] = tile_ok ? p0[r] : -INFINITY; p1[r] = tile_ok ? p1[r] : -INFINITY; mx = vmax3(mx, p0[r], p1[r]); }
                        }
                    }
                    mx = vmax(mx, xlane32(mx));
                    const float m_new = vmax(m_run, mx);
                    const float m_safe = (m_new == -INFINITY) ? 0.f : m_new;
                    p0 = p0 - m_safe; p1 = p1 - m_safe;
#pragma unroll
                    for (int r = 0; r < 16; ++r) { p0[r] = __builtin_amdgcn_exp2f(p0[r]); p1[r] = __builtin_amdgcn_exp2f(p1[r]); }
                    float ls;
                    { typedef float f32x8_t __attribute__((ext_vector_type(8))); typedef float f32x4v_t __attribute__((ext_vector_type(4)));
                      const f32x16_t t16 = p0 + p1; const f32x8_t t8 = t16.lo + t16.hi; const f32x4v_t t4 = t8.lo + t8.hi; const f32x2_t t2 = t4.lo + t4.hi; ls = t2.x + t2.y; }
                    if (__any(m_new > m_run)) {
                        const float alpha = __builtin_amdgcn_exp2f(m_run - m_safe);
                        l_run *= alpha;
                        o0 = o0 * alpha; o1 = o1 * alpha;
                    }
                    l_run += ls; m_run = m_new;
                } else {
                    float run = carry;
#define SB_HALF(PX, KOFF) do { \
                    float lk[16]; \
                    _Pragma("unroll") for (int r = 0; r < 16; ++r) { \
                        const int off = (r & 3) + 8 * (r >> 2); \
                        const bool v = (kbase + off + (KOFF)) < qpos; \
                        const float z = PX[r]; \
                        const float t = 0.6931471805599453f * __builtin_amdgcn_logf(1.0f + __builtin_amdgcn_exp2f(-LOG2E * fabsf(z))); \
                        lk[r] = v ? (fminf(-z, 0.f) - t) : 0.f; \
                        PX[r] = v ? (fminf(z, 0.f) - t) : -INFINITY; } \
                    _Pragma("unroll") for (int g = 3; g >= 0; --g) { \
                        const float G = (lk[4 * g] + lk[4 * g + 1]) + (lk[4 * g + 2] + lk[4 * g + 3]); \
                        const float PG = xlane32(G); \
                        float la = run + (hi ? 0.f : PG); \
                        run += G + PG; \
                        PX[4 * g + 3] += la; la += lk[4 * g + 3]; PX[4 * g + 2] += la; la += lk[4 * g + 2]; PX[4 * g + 1] += la; la += lk[4 * g + 1]; PX[4 * g] += la; } \
                    _Pragma("unroll") for (int r = 0; r < 16; ++r) PX[r] = __builtin_amdgcn_exp2f(LOG2E * PX[r]); } while (0)
                    SB_HALF(p1, 32);
                    SB_HALF(p0, 0);
#undef SB_HALF
                    carry = run;
                }
                unsigned pw[16];
#pragma unroll
                for (int j = 0; j < 8; ++j) { pw[j] = cvtpk(p0[2 * j], p0[2 * j + 1]); pw[8 + j] = cvtpk(p1[2 * j], p1[2 * j + 1]); }
#pragma unroll
                for (int s = 0; s < 4; ++s) {
                    bf16x8_t pb; { const unsigned* q = pw + 4 * s; typedef unsigned u32x4_t __attribute__((ext_vector_type(4))); u32x4_t t4 = {q[0], q[1], q[2], q[3]}; pb = __builtin_bit_cast(bf16x8_t, t4); }
#pragma unroll
                    for (int dt = 0; dt < 2; ++dt) {
                        typedef short s16x4_t __attribute__((ext_vector_type(4)));
                        typedef __attribute__((address_space(3))) s16x4_t lds_s16x4;
                        const int gi_ = lane & 15;
                        const bf16* vp = vt_ + (16 * s + 4 * hi + (gi_ >> 2)) * AT_VP + 32 * dt + 16 * ((lane >> 4) & 1) + 4 * (gi_ & 3);
                        const s16x4_t lo = __builtin_amdgcn_ds_read_tr16_b64_v4i16((lds_s16x4*)vp), hi4 = __builtin_amdgcn_ds_read_tr16_b64_v4i16((lds_s16x4*)(vp + 8 * AT_VP));
                        const bf16x8_t va = {lo[0], lo[1], lo[2], lo[3], hi4[0], hi4[1], hi4[2], hi4[3]};
                        if (dt == 0) o0 = __builtin_amdgcn_mfma_f32_32x32x16_bf16(va, pb, o0, 0, 0, 0);
                        else         o1 = __builtin_amdgcn_mfma_f32_32x32x16_bf16(va, pb, o1, 0, 0, 0);
                    }
                }
            }
            if (kind == 3) {
                const float cm = carry;
                if (__all(cm < -110.0f) || !(kt * 64 <= q0w + 31) ) { if (__all(cm < -110.0f)) wave_done = true; }
            }
            if (more) {
                bf16* ksn = (bf16*)(lds + AT_KS + (buf ^ 1) * AT_KS_BYTES); bf16* vtn = (bf16*)(lds + AT_VT + (buf ^ 1) * AT_VT_BYTES);
                *(uint4*)(ksn + skey * AT_KP + sc * 8) = rk;
                *(uint4*)(vtn + skey * AT_VP + sc * 8) = rv;
            }
            if (kind == 3) { if (__syncthreads_and(wave_done ? 1 : 0)) break; }
            else __syncthreads();
            buf ^= 1;
        }
        float inv;
        if (kind == 3) inv = 1.0f;
        else {
            float lt = l_run + xlane32(l_run);
            if (kind == 1) { const float mf = fmaxf(m_run, sink2); const float sc2 = exp2f(m_run - mf); lt = lt * sc2 + exp2f(sink2 - mf); inv = sc2 / lt; }
            else inv = 1.0f / lt;
        }
        bf16* yp = ys + (size_t)(b * S_ + qpos) * 1024 + ycol + 4 * hi;
#pragma unroll
        for (int g = 0; g < 4; ++g) {
            *(uint2*)(yp + 8 * g) = make_uint2(cvtpk(o0[4 * g] * inv, o0[4 * g + 1] * inv), cvtpk(o0[4 * g + 2] * inv, o0[4 * g + 3] * inv));
            *(uint2*)(yp + 32 + 8 * g) = make_uint2(cvtpk(o1[4 * g] * inv, o1[4 * g + 1] * inv), cvtpk(o1[4 * g + 2] * inv, o1[4 * g + 3] * inv));
        }
    }
}
__device__ void attn_fast_phase(int WV_, const bf16* P, const unsigned char* mask, const float* kmean, const float* sinks, bf16* ys,
                                const unsigned* utab, unsigned* counter, unsigned char* lds) {
    volatile unsigned* s_unit = (volatile unsigned*)(lds + AT_MISC);
    for (;;) {
        __syncthreads();
        if (LTID(WV_) == 0) s_unit[0] = atomicAdd(counter, 1u);
        __syncthreads();
        const unsigned ui = s_unit[0];
        if (ui >= 512u) break;
        const unsigned ue = utab[ui];
        const int kind = (int)(ue >> 30), b = (int)((ue >> 28) & 3u), ux = (int)((ue >> 8) & 255u), uy = (int)(ue & 255u);
        if (kind == 0) attn_unit<0>(WV_, P, mask, kmean, sinks, ys, lds, b, ux, uy);
        else attn_unit<2>(WV_, P, mask, kmean, sinks, ys, lds, b, ux, uy);
    }
    for (int u = LBID(); u < 256; u += LGRID()) { __syncthreads(); attn_unit<3>(WV_, P, mask, kmean, sinks, ys, lds, u >> 6, (u >> 4) & 3, u & 15); }
    for (int u = LBID(); u < 256; u += LGRID()) { __syncthreads(); attn_unit<1>(WV_, P, mask, kmean, sinks, ys, lds, u >> 6, (u >> 5) & 1, u & 31); }
}

constexpr float U_SCALE = 128.0f, V_SCALE = 48.0f;
constexpr int ROW6 = 1536;
typedef float v32f_t __attribute__((ext_vector_type(32)));
typedef unsigned v6u_t __attribute__((ext_vector_type(6)));
typedef unsigned u32x4a8_t __attribute__((ext_vector_type(4), aligned(8)));
__device__ __forceinline__ float rdlane_f(float v, int l) { return __builtin_bit_cast(float, __builtin_amdgcn_readlane(__builtin_bit_cast(int, v), l)); }
__device__ __forceinline__ unsigned q_e2m3(float v) {
    const float a = fminf(fabsf(v), 7.5f);
    unsigned code;
    if (a < 1.0f) code = (unsigned)rintf(a * 8.0f);
    else if (a < 2.0f) code = 8u + (unsigned)rintf((a - 1.0f) * 8.0f);
    else if (a < 4.0f) code = 16u + (unsigned)rintf((a - 2.0f) * 4.0f);
    else code = 24u + (unsigned)rintf((a - 4.0f) * 2.0f);
    return code | (v < 0.f ? 32u : 0u);
}
__device__ __forceinline__ void cvt_chunk6(const float4 (&a)[8], float sc, unsigned (&w)[6]) {
#pragma unroll
    for (int d = 0; d < 6; ++d) w[d] = 0u;
#pragma unroll
    for (int q4 = 0; q4 < 8; ++q4) {
        const float av[4] = {a[q4].x, a[q4].y, a[q4].z, a[q4].w};
#pragma unroll
        for (int e = 0; e < 4; ++e) { const int idx = q4 * 4 + e, bit = 6 * idx, d = bit >> 5, sft = bit & 31; const unsigned code = q_e2m3(av[e] * sc);
            w[d] |= code << sft; if (sft > 26) w[d + 1] |= code >> (32 - sft); }
    }
}
__device__ void convert_tables(int WV_, const Params& p) {
    const size_t nchunk = (size_t)DEPTH_ * 16384 * 2 * 32;
    const size_t stride = (size_t)LGRID() * NTHR;
    for (size_t i = (size_t)LBID() * NTHR + LTID(WV_); i < nchunk; i += 2 * stride) {
        const size_t i2 = i + stride; const bool has2 = i2 < nchunk; const size_t j2 = has2 ? i2 : i;
        const int c0 = (int)(i & 31), uv0 = (int)((i >> 5) & 1); const size_t le0 = i >> 6;
        const int c1 = (int)(j2 & 31), uv1 = (int)((j2 >> 5) & 1); const size_t le1 = j2 >> 6;
        const float* src0 = (uv0 ? p.in[10] : p.in[9]) + le0 * 1024 + c0 * 32;
        const float* src1 = (uv1 ? p.in[10] : p.in[9]) + le1 * 1024 + c1 * 32;
        float4 a0[8], a1[8];
#pragma unroll
        for (int q4 = 0; q4 < 8; ++q4) a0[q4] = ((const float4*)src0)[q4];
#pragma unroll
        for (int q4 = 0; q4 < 8; ++q4) a1[q4] = ((const float4*)src1)[q4];
        unsigned w0[6], w1[6];
        cvt_chunk6(a0, uv0 ? V_SCALE : U_SCALE, w0);
        cvt_chunk6(a1, uv1 ? V_SCALE : U_SCALE, w1);
        uint2* dst0 = (uint2*)(p.ws + WS_UV + le0 * ROW6 + uv0 * 768 + c0 * 24);
        dst0[0] = make_uint2(w0[0], w0[1]); dst0[1] = make_uint2(w0[2], w0[3]); dst0[2] = make_uint2(w0[4], w0[5]);
        if (has2) { uint2* dst1 = (uint2*)(p.ws + WS_UV + le1 * ROW6 + uv1 * 768 + c1 * 24);
            dst1[0] = make_uint2(w1[0], w1[1]); dst1[1] = make_uint2(w1[2], w1[3]); dst1[2] = make_uint2(w1[4], w1[5]); }
    }
}
__device__ __forceinline__ v6u_t ld_pk6(const unsigned char* ptr) {
    const uint2 a = ((const uint2*)ptr)[0], b = ((const uint2*)ptr)[1], c = ((const uint2*)ptr)[2];
    const v6u_t pk = {a.x, a.y, b.x, b.y, c.x, c.y};
    return pk;
}
__device__ void peer_fast_phase(int WV_, float* h, bf16* hb, const int* eid, const float* gate, const unsigned char* uv, const float* g1, const float* b1, const float* g, const float* bb, unsigned char* lds) {
    const int tid = LTID(WV_), lane = tid & 63, wave = tid >> 6, l32 = lane & 31, hi = lane >> 5;
    float* pl = (float*)(lds + wave * 16384);
    unsigned char* raw = lds + wave * 16384 + 4096 + lane * 24;
    for (int t = LBID() * NWAVE + wave; t < T_; t += LGRID() * NWAVE) {
        float* hr = h + (size_t)t * 1024 + l32 * 32;
        float x[32], acc[32];
#pragma unroll
        for (int q4 = 0; q4 < 4; ++q4) { const uint4 a = ((const uint4*)(hb + (size_t)t * 1024 + l32 * 32))[q4];
            x[8 * q4] = __uint_as_float(a.x << 16); x[8 * q4 + 1] = __uint_as_float(a.x & 0xffff0000u); x[8 * q4 + 2] = __uint_as_float(a.y << 16); x[8 * q4 + 3] = __uint_as_float(a.y & 0xffff0000u);
            x[8 * q4 + 4] = __uint_as_float(a.z << 16); x[8 * q4 + 5] = __uint_as_float(a.z & 0xffff0000u); x[8 * q4 + 6] = __uint_as_float(a.w << 16); x[8 * q4 + 7] = __uint_as_float(a.w & 0xffff0000u); }
        {
            float s = 0.f;
#pragma unroll
            for (int i = 0; i < 32; ++i) s += x[i];
#pragma unroll
            for (int o = 16; o > 0; o >>= 1) s += __shfl_xor(s, o);
            const float mean = s * (1.0f / 1024.0f);
            float s2 = 0.f;
#pragma unroll
            for (int i = 0; i < 32; ++i) { x[i] -= mean; s2 += x[i] * x[i]; }
#pragma unroll
            for (int o = 16; o > 0; o >>= 1) s2 += __shfl_xor(s2, o);
            const float rstd = 1.0f / sqrtf(s2 * (1.0f / 1024.0f) + LN_EPS);
#pragma unroll
            for (int q4 = 0; q4 < 8; ++q4) { const float4 gg = ((const float4*)(g1 + l32 * 32))[q4], cc = ((const float4*)(b1 + l32 * 32))[q4];
                x[4 * q4] = x[4 * q4] * rstd * gg.x + cc.x; x[4 * q4 + 1] = x[4 * q4 + 1] * rstd * gg.y + cc.y; x[4 * q4 + 2] = x[4 * q4 + 2] * rstd * gg.z + cc.z; x[4 * q4 + 3] = x[4 * q4 + 3] * rstd * gg.w + cc.w; }
        }
#pragma unroll
        for (int i = 0; i < 32; ++i) acc[i] = 0.f;
#pragma unroll 1
        for (int batch = 0; batch < 4; ++batch) {
            const int my_eid = eid[(size_t)t * 128 + batch * 32 + l32];
            const float my_gate = gate[(size_t)t * 128 + batch * 32 + l32];
#pragma unroll 1
            for (int grp = 0; grp < 2; ++grp) {
                { u32x4a8_t pa[8]; uint2 pc[8];
#pragma unroll
                  for (int i = 0; i < 8; ++i) { const int id = __shfl(my_eid, 2 * (grp * 8 + i) + hi); const unsigned char* rp = uv + (size_t)id * ROW6 + l32 * 24; pa[i] = *(const u32x4a8_t*)rp; pc[i] = *(const uint2*)(rp + 16); }
#pragma unroll
                  for (int i = 0; i < 8; ++i) { uint2* wp = (uint2*)(raw + i * 1536); wp[0] = make_uint2(pa[i].x, pa[i].y); wp[1] = make_uint2(pa[i].z, pa[i].w); wp[2] = pc[i]; } }
#pragma unroll 1
                for (int i = 0; i < 8; ++i) {
                    const uint2* rp = (const uint2*)(raw + i * 1536); const uint2 a = rp[0], b = rp[1], c = rp[2];
                    const v6u_t pk6 = {a.x, a.y, b.x, b.y, c.x, c.y}; const v32f_t f = __builtin_amdgcn_cvt_scalef32_pk32_f32_fp6(pk6, 1.0f);
                    f32x2_t dv0 = {0.f, 0.f}, dv1 = {0.f, 0.f};
#pragma unroll
                    for (int j = 0; j < 8; ++j) { const f32x2_t fa = {f[2 * j], f[2 * j + 1]}, fb = {f[16 + 2 * j], f[17 + 2 * j]}, xa = {x[2 * j], x[2 * j + 1]}, xb = {x[16 + 2 * j], x[17 + 2 * j]};
                        dv0 = fa * xa + dv0; dv1 = fb * xb + dv1; }
                    pl[(2 * (grp * 8 + i) + hi) * 32 + l32] = (dv0.x + dv0.y) + (dv1.x + dv1.y);
                }
            }
            float d;
            { const float4* pr = (const float4*)(pl + l32 * 32); float4 s4 = pr[0];
#pragma unroll
              for (int i = 1; i < 8; ++i) { const float4 v = pr[i]; s4.x += v.x; s4.y += v.y; s4.z += v.z; s4.w += v.w; }
              d = ((s4.x + s4.y) + (s4.z + s4.w)) * (1.0f / U_SCALE); }
            const float hv = 0.5f * d * (1.0f + erff(d * 0.70710678118654752f)) * my_gate * (1.0f / V_SCALE);
#pragma unroll 1
            for (int grp = 0; grp < 2; ++grp) {
                { u32x4a8_t pa[8]; uint2 pc[8];
#pragma unroll
                  for (int i = 0; i < 8; ++i) { const int id = __shfl(my_eid, 2 * (grp * 8 + i) + hi); const unsigned char* rp = uv + (size_t)id * ROW6 + 768 + l32 * 24; pa[i] = *(const u32x4a8_t*)rp; pc[i] = *(const uint2*)(rp + 16); }
#pragma unroll
                  for (int i = 0; i < 8; ++i) { uint2* wp = (uint2*)(raw + i * 1536); wp[0] = make_uint2(pa[i].x, pa[i].y); wp[1] = make_uint2(pa[i].z, pa[i].w); wp[2] = pc[i]; } }
#pragma unroll 1
                for (int i = 0; i < 8; ++i) {
                    const float c = __shfl(hv, 2 * (grp * 8 + i) + hi);
                    const uint2* rp = (const uint2*)(raw + i * 1536); const uint2 a = rp[0], b = rp[1], cc = rp[2];
                    const v6u_t pk6 = {a.x, a.y, b.x, b.y, cc.x, cc.y}; const v32f_t f = __builtin_amdgcn_cvt_scalef32_pk32_f32_fp6(pk6, 1.0f);
                    const f32x2_t c2 = {c, c};
#pragma unroll
                    for (int j = 0; j < 16; ++j) { const f32x2_t fj = {f[2 * j], f[2 * j + 1]}; f32x2_t aj = {acc[2 * j], acc[2 * j + 1]}; aj = fj * c2 + aj; acc[2 * j] = aj.x; acc[2 * j + 1] = aj.y; }
                }
            }
        }
        float y[32], s = 0.f;
#pragma unroll
        for (int i = 0; i < 32; ++i) { acc[i] += __shfl_xor(acc[i], 32); y[i] = ALPHA * x[i] + acc[i]; s += y[i]; }
#pragma unroll
        for (int o = 16; o > 0; o >>= 1) s += __shfl_xor(s, o);
        const float mean = s * (1.0f / 1024.0f);
        float s2 = 0.f;
#pragma unroll
        for (int i = 0; i < 32; ++i) { y[i] -= mean; s2 += y[i] * y[i]; }
#pragma unroll
        for (int o = 16; o > 0; o >>= 1) s2 += __shfl_xor(s2, o);
        const float rstd = 1.0f / sqrtf(s2 * (1.0f / 1024.0f) + LN_EPS);
        float o[16];
#pragma unroll
        for (int q4 = 0; q4 < 4; ++q4) {
            const float4 gg = ((const float4*)(g + l32 * 32 + hi * 16))[q4], cc = ((const float4*)(bb + l32 * 32 + hi * 16))[q4];
            float ya[4], yb2[4];
#pragma unroll
            for (int e = 0; e < 4; ++e) { ya[e] = y[4 * q4 + e]; yb2[e] = y[16 + 4 * q4 + e]; }
            asm volatile("" : "+v"(ya[0]), "+v"(ya[1]), "+v"(ya[2]), "+v"(ya[3]), "+v"(yb2[0]), "+v"(yb2[1]), "+v"(yb2[2]), "+v"(yb2[3]));
            const float y0 = hi ? yb2[0] : ya[0], y1 = hi ? yb2[1] : ya[1], y2 = hi ? yb2[2] : ya[2], y3 = hi ? yb2[3] : ya[3];
            o[4 * q4] = y0 * rstd * gg.x + cc.x; o[4 * q4 + 1] = y1 * rstd * gg.y + cc.y; o[4 * q4 + 2] = y2 * rstd * gg.z + cc.z; o[4 * q4 + 3] = y3 * rstd * gg.w + cc.w;
            if (h) ((float4*)(hr + hi * 16))[q4] = make_float4(o[4 * q4], o[4 * q4 + 1], o[4 * q4 + 2], o[4 * q4 + 3]);
        }
        uint4* hbp = (uint4*)(hb + (size_t)t * 1024 + l32 * 32 + hi * 16);
        hbp[0] = make_uint4(pk2(o[0], o[1]), pk2(o[2], o[3]), pk2(o[4], o[5]), pk2(o[6], o[7]));
        hbp[1] = make_uint4(pk2(o[8], o[9]), pk2(o[10], o[11]), pk2(o[12], o[13]), pk2(o[14], o[15]));
    }
}

__device__ __forceinline__ float pack_pl(float v, unsigned pl) { return __uint_as_float((__float_as_uint(v) & ~127u) | pl); }
__device__ __forceinline__ void ins16(float (&s)[16], float x) {
#pragma unroll
    for (int k = 15; k >= 1; --k) s[k] = __builtin_amdgcn_fmed3f(s[k - 1], x, s[k]);
    s[0] = vmax(s[0], x);
}
template <int D> __device__ __forceinline__ void bitonic_stage(float (&c)[16]) {
#pragma unroll
    for (int i = 0; i < 16; ++i) if ((i & D) == 0) { const float a = vmax(c[i], c[i + D]), b = vmin(c[i], c[i + D]); c[i] = a; c[i + D] = b; }
}
__device__ __forceinline__ int decode_key(unsigned pl) { return (int)(32u * ((pl >> 4) & 3u) + (pl & 3u) + 8u * ((pl >> 2) & 3u) + 4u * ((pl >> 6) & 1u)); }
__device__ void route_fast_phase(int WV_, const bf16* qb, const bf16* skb  , int* eid, float* gate, unsigned char* lds, int pm = -1, int pn = 0) {
    const int tid = LTID(WV_), lane = tid & 63, wave = tid >> 6, r32 = lane & 31, hi = lane >> 5;
    unsigned* lidx = (unsigned*)lds + wave * (64 * 33) + lane * 33;
    const int u_first = (pm >= 0) ? 0 : LBID() * NWAVE + wave, u_end = (pm >= 0) ? 2 : (T_ / 32) * 8, u_step = (pm >= 0) ? 1 : LGRID() * NWAVE;
    for (int unit = u_first; unit < u_end; unit += u_step) {
        const int h = (pm >= 0) ? 2 * pn + unit : (unit & 7), t = ((pm >= 0) ? 8 * pm + wave : (unit >> 3)) * 32 + r32;
        float sl[2][16];
#pragma unroll
        for (int p = 0; p < 2; ++p) {
            bf16x8_t qf[4];
            { const bf16* qp = qb + (size_t)t * 1024 + h * 128 + p * 64 + 8 * hi;
#pragma unroll
              for (int ks = 0; ks < 4; ++ks) qf[ks] = *(const bf16x8_t*)(qp + 16 * ks); }
            float s[16];
#pragma unroll
            for (int k = 0; k < 16; ++k) s[k] = -INFINITY;
            const bf16* skp = skb + ((size_t)(h * 2 + p) * 128 + r32) * 64 + 8 * hi;
#pragma unroll
            for (int kt = 0; kt < 4; ++kt) {
                f32x16_t acc;
#pragma unroll
                for (int r = 0; r < 16; ++r) acc[r] = 0.f;
#pragma unroll
                for (int ks = 0; ks < 4; ++ks) { const bf16x8_t a = *(const bf16x8_t*)(skp + (size_t)kt * 32 * 64 + 16 * ks); acc = __builtin_amdgcn_mfma_f32_32x32x16_bf16(a, qf[ks], acc, 0, 0, 0); }
#pragma unroll
                for (int r = 0; r < 16; ++r) ins16(s, pack_pl(acc[r], (unsigned)(kt * 16 + r)));
            }
            const unsigned hb = (unsigned)hi << 6;
#pragma unroll
            for (int k = 0; k < 16; ++k) s[k] = __uint_as_float(__float_as_uint(s[k]) | hb);
            float c[16];
#pragma unroll
            for (int k = 0; k < 16; ++k) c[k] = vmax(s[k], __shfl_xor(s[15 - k], 32));
            bitonic_stage<8>(c); bitonic_stage<4>(c); bitonic_stage<2>(c); bitonic_stage<1>(c);
#pragma unroll
            for (int k = 0; k < 16; ++k) { sl[p][k] = c[k]; lidx[p * 16 + k] = (unsigned)decode_key(__float_as_uint(c[k]) & 127u); }
        }
        float w[16];
#pragma unroll
        for (int k = 0; k < 16; ++k) w[k] = -INFINITY;
#pragma unroll
        for (int i = 0; i < 16; ++i)
#pragma unroll
            for (int j = 0; j < 16; ++j)
                if ((i + 1) * (j + 1) <= 16) { const float v = sl[0][i] + sl[1][j]; ins16(w, __uint_as_float((__float_as_uint(v) & ~255u) | (unsigned)(i * 16 + j))); }
        float e[16], sum = 0.f;
#pragma unroll
        for (int k = 0; k < 16; ++k) { e[k] = expf(w[k] - w[0]); sum += e[k]; }
        const float inv = 1.0f / sum;
        int ide[8]; float gte[8];
#pragma unroll
        for (int k = 0; k < 8; ++k) {
            float wa = w[k], wb = w[8 + k], ea = e[k], eb = e[8 + k];
            asm volatile("" : "+v"(wa), "+v"(wb), "+v"(ea), "+v"(eb));
            const float wv = hi ? wb : wa;
            const unsigned pl = __float_as_uint(wv) & 255u;
            ide[k] = (int)(lidx[pl >> 4] * 128u + lidx[16 + (pl & 15u)]);
            gte[k] = (hi ? eb : ea) * inv;
        }
        int* ep = eid + (size_t)t * 128 + h * 16 + hi * 8; float* gp = gate + (size_t)t * 128 + h * 16 + hi * 8;
        *(int4*)ep = make_int4(ide[0], ide[1], ide[2], ide[3]); *(int4*)(ep + 4) = make_int4(ide[4], ide[5], ide[6], ide[7]);
        *(float4*)gp = make_float4(gte[0], gte[1], gte[2], gte[3]); *(float4*)(gp + 4) = make_float4(gte[4], gte[5], gte[6], gte[7]);
    }
}

typedef float f32x4_t __attribute__((ext_vector_type(4)));
typedef __bf16 bf16x2v __attribute__((ext_vector_type(2)));
__device__ __forceinline__ float dot2bf(unsigned a, unsigned b, float c) { return __builtin_amdgcn_fdot2_f32_bf16(__builtin_bit_cast(bf16x2v, a), __builtin_bit_cast(bf16x2v, b), c, false); }
__device__ __forceinline__ void cnt_gt(int& cnt, unsigned a, unsigned b) { asm("v_cmp_gt_u32_e32 vcc, %1, %2\n\tv_addc_co_u32_e32 %0, vcc, 0, %0, vcc" : "+v"(cnt) : "v"(a), "v"(b) : "vcc"); }
__device__ __forceinline__ void cnt_eq(int& cnt, unsigned a, unsigned b) { asm("v_cmp_eq_u32_e32 vcc, %1, %2\n\tv_addc_co_u32_e32 %0, vcc, 0, %0, vcc" : "+v"(cnt) : "v"(a), "v"(b) : "vcc"); }
__device__ __forceinline__ unsigned flag_gt(unsigned a, unsigned b) { unsigned r; asm("v_cmp_gt_u32_e32 vcc, %1, %2\n\tv_cndmask_b32_e64 %0, 0, 1, vcc" : "=v"(r) : "v"(a), "v"(b) : "vcc"); return r; }
__device__ __forceinline__ unsigned flag_eq(unsigned a, unsigned b) { unsigned r; asm("v_cmp_eq_u32_e32 vcc, %1, %2\n\tv_cndmask_b32_e64 %0, 0, 1, vcc" : "=v"(r) : "v"(a), "v"(b) : "vcc"); return r; }
__device__ __forceinline__ void cnt_ge(int& cnt, unsigned key, unsigned cand) { asm("v_cmp_ge_u32_e32 vcc, %1, %2\n\tv_addc_co_u32_e32 %0, vcc, 0, %0, vcc" : "+v"(cnt) : "v"(key), "v"(cand) : "vcc"); }

template <int CTRL, int RM> __device__ __forceinline__ unsigned dpp0(unsigned v) { return (unsigned)__builtin_amdgcn_update_dpp(0, (int)v, CTRL, RM, 0xf, false); }
template <int CTRL> __device__ __forceinline__ unsigned dppf(unsigned v) { return (unsigned)__builtin_amdgcn_update_dpp(-1, (int)v, CTRL, 0xf, 0xf, false); }
__device__ __forceinline__ unsigned wave_sum_u_dpp(unsigned v) {
    v += dpp0<0xB1, 0xf>(v); v += dpp0<0x4E, 0xf>(v); v += dpp0<0x141, 0xf>(v); v += dpp0<0x140, 0xf>(v);
    return (unsigned)__builtin_amdgcn_readlane((int)v, 0) + (unsigned)__builtin_amdgcn_readlane((int)v, 16) + (unsigned)__builtin_amdgcn_readlane((int)v, 32) + (unsigned)__builtin_amdgcn_readlane((int)v, 48);
}
__device__ __forceinline__ unsigned wave_min_u_dpp(unsigned v) {
    unsigned t;
    t = dppf<0xB1>(v); v = t < v ? t : v; t = dppf<0x4E>(v); v = t < v ? t : v; t = dppf<0x141>(v); v = t < v ? t : v; t = dppf<0x140>(v); v = t < v ? t : v;
    const unsigned a = (unsigned)__builtin_amdgcn_readlane((int)v, 0), b = (unsigned)__builtin_amdgcn_readlane((int)v, 16), c = (unsigned)__builtin_amdgcn_readlane((int)v, 32), d = (unsigned)__builtin_amdgcn_readlane((int)v, 48);
    const unsigned ab = a < b ? a : b, cd = c < d ? c : d; return ab < cd ? ab : cd;
}
__device__ __forceinline__ unsigned wave_incl_scan_u_dpp(unsigned v) {
    v += dpp0<0x111, 0xf>(v); v += dpp0<0x112, 0xf>(v); v += dpp0<0x114, 0xf>(v); v += dpp0<0x118, 0xf>(v);
    v += dpp0<0x142, 0xa>(v);
    v += dpp0<0x143, 0xc>(v);
    return v;
}
typedef __attribute__((address_space(3))) unsigned lds_u32;
template <int SHIFT> __device__ __forceinline__ unsigned radix_pass(const unsigned (&key)[64], unsigned pre, lds_u32* hist, int lane, int& need, int jlim, unsigned L) {
    typedef unsigned u32x4v __attribute__((ext_vector_type(4)));
    typedef __attribute__((address_space(3))) u32x4v lds_u32x4;
    const int fl = 63 - lane;
    { const u32x4v z4 = {0u, 0u, 0u, 0u};
#pragma unroll
      for (int i = 0; i < 8; ++i) ((lds_u32x4*)(hist + fl * 32))[i] = z4; }
    const unsigned hb = (unsigned)(size_t)hist + 4u * (unsigned)(lane & 7);
    const unsigned one = 1u;
    asm volatile("" ::: "memory");
#pragma unroll
    for (int j4 = 0; j4 < 16; ++j4) {
        if (4 * j4 <= jlim) {
            bool grp = true;
            if (SHIFT <= 8) {
                const bool any = ((key[4 * j4] >> (SHIFT + 8)) == pre) | ((key[4 * j4 + 1] >> (SHIFT + 8)) == pre) | ((key[4 * j4 + 2] >> (SHIFT + 8)) == pre) | ((key[4 * j4 + 3] >> (SHIFT + 8)) == pre);
                grp = __ballot(any) != 0ull;
            }
            if (grp) {
#pragma unroll
                for (int e = 0; e < 4; ++e) { const int j = 4 * j4 + e;
                    const unsigned addr = hb + (((key[j] >> SHIFT) & 255u) << 5);
                    unsigned long long sv;
                    if (SHIFT == 24) asm volatile("v_cmp_ge_u32_e32 vcc, %1, %2\n\ts_and_saveexec_b64 %0, vcc\n\tds_add_u32 %3, %4\n\ts_mov_b64 exec, %0" : "=&s"(sv) : "v"(key[j]), "v"(L), "v"(addr), "v"(one) : "vcc", "memory");
                    else { const unsigned t = key[j] >> ((SHIFT + 8) & 31);
                        asm volatile("v_cmp_eq_u32_e32 vcc, %1, %2\n\ts_and_saveexec_b64 %0, vcc\n\tds_add_u32 %3, %4\n\ts_mov_b64 exec, %0" : "=&s"(sv) : "v"(t), "v"(pre), "v"(addr), "v"(one) : "vcc", "memory"); }
                }
            }
        }
    }
    asm volatile("s_waitcnt lgkmcnt(0)" ::: "memory");
    unsigned dsum[4]; unsigned sumL = 0u;
#pragma unroll
    for (int i = 0; i < 4; ++i) { const u32x4v v0 = ((const lds_u32x4*)(hist + fl * 32))[2 * i], v1 = ((const lds_u32x4*)(hist + fl * 32))[2 * i + 1];
        dsum[i] = ((v0.x + v0.y) + (v0.z + v0.w)) + ((v1.x + v1.y) + (v1.z + v1.w)); sumL += dsum[i]; }
    const unsigned incl = wave_incl_scan_u_dpp(sumL);
    const unsigned above = incl - sumL;
    const bool own = (above < (unsigned)need) && ((unsigned)need <= above + sumL);
    const int owner = __ffsll((long long)__ballot(own)) - 1;
    unsigned acc = above; int sel = -1; unsigned cab = 0u;
#pragma unroll
    for (int i = 3; i >= 0; --i) { const unsigned c = dsum[i]; const bool hit = (sel < 0) && (acc + c >= (unsigned)need); cab = hit ? acc : cab; sel = hit ? i : sel; acc += c; }
    const int ow = owner < 0 ? 0 : owner;
    const unsigned digit = (unsigned)__builtin_amdgcn_readlane(sel, ow) + (unsigned)(4 * (63 - ow));
    need -= (int)__builtin_amdgcn_readlane((int)cab, ow);
    return digit;
}

__device__ __forceinline__ void idx_select(const unsigned (&key)[64], unsigned t3, int jlim, lds_u32* hist, int lane, uint2* mrow) {
        unsigned wlo = 0u, whi = 0u;
        unsigned L = wave_min_u_dpp(t3);
        L = L > 1u ? L : 1u;

        int need = 256;
        const unsigned d1 = radix_pass<24>(key, 0u, hist, lane, need, jlim, L);
        const unsigned d2 = radix_pass<16>(key, d1, hist, lane, need, jlim, L);
        const unsigned d3 = radix_pass<8>(key, (d1 << 8) | d2, hist, lane, need, jlim, L);
        const unsigned d4 = radix_pass<0>(key, (d1 << 16) | (d2 << 8) | d3, hist, lane, need, jlim, L);
        const unsigned prefix = (d1 << 24) | (d2 << 16) | (d3 << 8) | d4;

        int ceq = 0;
#pragma unroll
        for (int j = 0; j < 64; ++j) cnt_eq(ceq, key[j], prefix);
        ceq = (int)wave_sum_u_dpp((unsigned)ceq);
        int X = 4096;
        if (ceq != need) {
            int X0 = 0;
#pragma unroll 1
            for (int bit = 11; bit >= 0; --bit) {
                const int c = X0 | (1 << bit);
                int cnt = 0; const int crel = (c - lane + 63) >> 6;
#pragma unroll
                for (int j = 0; j < 64; ++j) cnt_eq(cnt, (key[j] ^ prefix) | ~(unsigned)((j - crel) >> 31), 0u);
                cnt = wave_sum_i(cnt);
                if (cnt < need) X0 = c;
            }
            X = X0 + 1;
        }
        const int xrel = (X - lane + 63) >> 6;
#pragma unroll
        for (int j4 = 0; j4 < 16; ++j4) {
            if (4 * j4 <= jlim) {
#pragma unroll
                for (int e = 0; e < 4; ++e) { const int j = 4 * j4 + e;
                    const bool sel = (key[j] > prefix) || (key[j] == prefix && j < xrel);
                    const unsigned long long bm = __ballot(sel);
                    asm("v_writelane_b32 %0, %1, %2" : "+v"(wlo) : "s"((unsigned)bm), "n"(j));
                    asm("v_writelane_b32 %0, %1, %2" : "+v"(whi) : "s"((unsigned)(bm >> 32)), "n"(j)); }
            }
        }
        mrow[lane] = make_uint2(wlo, whi);
}
#ifndef TS_SEL
#define TS_SEL 0
#endif
#define ITS_B() do { if (TS_SEL >= 20 && TS_SEL <= 25 && WV_ == 0 && LANEID() == 0) ((volatile __attribute__((address_space(3))) unsigned long long*)((__attribute__((address_space(3))) unsigned char*)lds + 147456 - 16 - 32))[0] = __builtin_amdgcn_s_memrealtime(); } while (0)
#define ITS_E(k) do { if ((k) == TS_SEL && WV_ == 0 && LANEID() == 0) { volatile __attribute__((address_space(3))) unsigned long long* w_ = (volatile __attribute__((address_space(3))) unsigned long long*)((__attribute__((address_space(3))) unsigned char*)lds + 147456 - 16 - 32); w_[1] += __builtin_amdgcn_s_memrealtime() - w_[0]; } } while (0)
__device__ void index_fast_phase(int WV_, const bf16* P, unsigned char* mask, float* kmean, float* scratch_all, unsigned* qctr, unsigned char* lds) {
    const int tid = LTID(WV_), lane = tid & 63, wave = tid >> 6, bid = LBID(), G = LGRID();
    float* s_part = (float*)lds;
    ITS_B();
    for (int k = bid; k < 256; k += G) {
        const int b = k >> 6, h = (k >> 4) & 3, blk = k & 15;
        const bf16* kp = P + (size_t)(b * S_ + blk * 256 + wave * 32) * NP + C_KC + h * 64 + lane;
        float a = 0.f;
#pragma unroll 8
        for (int j = 0; j < 32; ++j) a += bf2f(kp[(size_t)j * NP]);
        __syncthreads();
        s_part[wave * 64 + lane] = a;
        __syncthreads();
        if (tid < 64) { float s = 0.f;
#pragma unroll
            for (int w = 0; w < 8; ++w) s += s_part[w * 64 + tid];
            kmean[((b * 4 + h) * 16 + blk) * 64 + tid] = s * (1.0f / 256.0f); }
    }
    ITS_E(22);
    constexpr int IDX_CP = 512 + 4;
    constexpr int IDX_PITCH = 4096 + 32;
    float* scr = scratch_all + (size_t)bid * (16 * IDX_PITCH);
    const int lq = lane & 15, g4 = lane >> 4;
    for (int ui = bid; ui < 1024; ui += G) {
        const int b = ui >> 8, k = ui & 255, tile = (b & 1) ? 255 - k : k, q0 = tile * 16;
        const bf16* Pb = P + (size_t)b * S_ * NP;
        const int ntiles = tile + 1;
        int lane_o = LANEID(); asm volatile("" : "+v"(lane_o));
        const int lane = lane_o, lq = lane & 15, g4 = lane >> 4;
        const int wave = WV_;
        const int qA = q0 + 2 * wave, qB = qA + 1;
        uint2* mrowA = (uint2*)(mask + (size_t)(b * S_ + qA) * 512); uint2* mrowB = (uint2*)(mask + (size_t)(b * S_ + qB) * 512);
        if (tile < 16) {
            unsigned wlo = 0u, whi = 0u, xlo = 0u, xhi = 0u; const int ra = qA - lane * 64, rb = qB - lane * 64;
#pragma unroll
            for (int j = 0; j < 32; ++j) { wlo |= (~(unsigned)((ra - j) >> 31) & 1u) << j; whi |= (~(unsigned)((ra - 32 - j) >> 31) & 1u) << j;
                                           xlo |= (~(unsigned)((rb - j) >> 31) & 1u) << j; xhi |= (~(unsigned)((rb - 32 - j) >> 31) & 1u) << j; }
            mrowA[lane] = make_uint2(wlo, whi); mrowB[lane] = make_uint2(xlo, xhi);
            continue;
        }
        bf16x8_t qf[8]; float wi[8];
        { const bf16* qp = Pb + (size_t)(q0 + lq) * NP + C_QI + 8 * g4;
#pragma unroll
          for (int h = 0; h < 8; ++h) qf[h] = *(const bf16x8_t*)(qp + 32 * h);
          const uint4 wv = *(const uint4*)(Pb + (size_t)(q0 + lq) * NP + C_WI); unpack8(wv, wi); }
        bf16x8_t qch, qcl;
        { typedef unsigned u32x4_t __attribute__((ext_vector_type(4)));
          float qc[8];
#pragma unroll
          for (int i = 0; i < 8; ++i) qc[i] = 0.f;
#pragma unroll
          for (int h = 0; h < 8; ++h) { const u32x4_t w4 = __builtin_bit_cast(u32x4_t, qf[h]);
#pragma unroll
              for (int i = 0; i < 4; ++i) { qc[2 * i] += wi[h] * __uint_as_float(w4[i] << 16); qc[2 * i + 1] += wi[h] * __uint_as_float(w4[i] & 0xffff0000u); } }
          u32x4_t hi4, lo4;
#pragma unroll
          for (int i = 0; i < 4; ++i) { const unsigned hw = cvtpk(qc[2 * i], qc[2 * i + 1]); hi4[i] = hw;
              lo4[i] = cvtpk(qc[2 * i] - __uint_as_float(hw << 16), qc[2 * i + 1] - __uint_as_float(hw & 0xffff0000u)); }
          qch = __builtin_bit_cast(bf16x8_t, hi4); qcl = __builtin_bit_cast(bf16x8_t, lo4); }
        typedef __attribute__((address_space(3))) bf16x8_t lds_bf16x8;
        lds_bf16x8* qops = (lds_bf16x8*)((__attribute__((address_space(3))) unsigned char*)lds + 102656);
        if (wave == 0) {
#pragma unroll
            for (int h = 0; h < 8; ++h) qops[h * 64 + lane] = qf[h];
            qops[8 * 64 + lane] = qch; qops[9 * 64 + lane] = qcl; }
        __syncthreads();
        float* cb = (float*)(lds + 69632);
        const int jlim = q0 >> 6;
        const int jmaxA = (qA - lane) >> 6, jmaxB = (qB - lane) >> 6;
        unsigned keyA[64], keyB[64];
        unsigned a0 = 0u, a1 = 0u, a2 = 0u, a3 = 0u, b0 = 0u, b1 = 0u, b2 = 0u, b3 = 0u;
        const bf16* kbase = Pb + (size_t)lq * NP + C_KI + 8 * g4;
        bf16x8_t nxt = *(const bf16x8_t*)(kbase + (size_t)(wave < ntiles ? wave : 0) * 16 * NP);
#pragma unroll
        for (int c = 0; c < 8; ++c) {
            if (32 * c < ntiles) {
#pragma unroll
                for (int j = 0; j < 4; ++j) {
                    const int kt = 32 * c + wave + 8 * j;
                    const bf16x8_t af = nxt;
                    { const int k = kt + 8; const int kc = k < ntiles ? k : 0; nxt = *(const bf16x8_t*)(kbase + (size_t)kc * 16 * NP); }
                    if (kt < ntiles) {
                        const f32x4_t z = {0.f, 0.f, 0.f, 0.f};
                        f32x4_t sc = __builtin_amdgcn_mfma_f32_16x16x32_bf16(af, qops[8 * 64 + lane], z, 0, 0, 0);
                        sc = __builtin_amdgcn_mfma_f32_16x16x32_bf16(af, qops[9 * 64 + lane], sc, 0, 0, 0);
#pragma unroll
                        for (int hh = 0; hh < 2; ++hh) {
                            f32x4_t a[4];
#pragma unroll
                            for (int h = 0; h < 4; ++h) a[h] = __builtin_amdgcn_mfma_f32_16x16x32_bf16(af, qops[(4 * hh + h) * 64 + lane], z, 0, 0, 0);
#pragma unroll
                            for (int h = 0; h < 4; ++h)
#pragma unroll
                                for (int r = 0; r < 4; ++r) sc[r] = __builtin_fmaf(__builtin_fabsf(a[h][r]), wi[4 * hh + h], sc[r]);
                        }
#pragma unroll
                        for (int r = 0; r < 4; ++r) { sc[r] *= 0.03125f; if (sc[r] == 0.f) sc[r] = 0.f; }
                        *(f32x4_t*)(cb + lq * IDX_CP + (wave + 8 * j) * 16 + 4 * g4) = sc;
                    }
                }
                __syncthreads();
#pragma unroll
                for (int js = 0; js < 8; ++js) {
                    const int slot = 8 * c + js;
                    if (slot <= jlim) {
                        const unsigned ua = __float_as_uint(cb[(2 * wave) * IDX_CP + 64 * js + lane]), ub = __float_as_uint(cb[(2 * wave + 1) * IDX_CP + 64 * js + lane]);
                        const unsigned xa = (ua ^ ((unsigned)((int)ua >> 31) | 0x80000000u)) & ~(unsigned)((jmaxA - slot) >> 31);
                        const unsigned xb = (ub ^ ((unsigned)((int)ub >> 31) | 0x80000000u)) & ~(unsigned)((jmaxB - slot) >> 31);
                        keyA[slot] = xa; keyB[slot] = xb;
                        unsigned n1, n2, n3;
                        asm("v_med3_u32 %0, %1, %2, %3" : "=v"(n3) : "v"(a2), "v"(a3), "v"(xa));
                        asm("v_med3_u32 %0, %1, %2, %3" : "=v"(n2) : "v"(a1), "v"(a2), "v"(xa));
                        asm("v_med3_u32 %0, %1, %2, %3" : "=v"(n1) : "v"(a0), "v"(a1), "v"(xa));
                        a0 = a0 > xa ? a0 : xa; a1 = n1; a2 = n2; a3 = n3;
                        asm("v_med3_u32 %0, %1, %2, %3" : "=v"(n3) : "v"(b2), "v"(b3), "v"(xb));
                        asm("v_med3_u32 %0, %1, %2, %3" : "=v"(n2) : "v"(b1), "v"(b2), "v"(xb));
                        asm("v_med3_u32 %0, %1, %2, %3" : "=v"(n1) : "v"(b0), "v"(b1), "v"(xb));
                        b0 = b0 > xb ? b0 : xb; b1 = n1; b2 = n2; b3 = n3;
                    } else { keyA[slot] = 0u; keyB[slot] = 0u; }
                }
                __syncthreads();
            } else {
#pragma unroll
                for (int js = 0; js < 8; ++js) { keyA[8 * c + js] = 0u; keyB[8 * c + js] = 0u; }
            }
        }
        lds_u32* hist = (lds_u32*)((__attribute__((address_space(3))) unsigned char*)lds + 2048) + wave * 2048;
        idx_select(keyA, a3, jlim, hist, lane, mrowA);
        idx_select(keyB, b3, jlim, hist, lane, mrowB);
        __syncthreads();
    }
}

constexpr int MG_P = 72;
constexpr int MG_TILE_BYTES = 128 * MG_P * 2;
__device__ void merge_fast_phase(int WV_, const bf16* P, const bf16* ys, const bf16* wbt  , bf16* merged, unsigned char* lds) {
    const int tid = LTID(WV_), lane = tid & 63, wave = tid >> 6, r32 = lane & 31, hi = lane >> 5, wt = wave & 3, wd = wave >> 2;
    const int srow0 = tid >> 3, sch = tid & 7;
    for (int tile = LBID(); tile < 1024; tile += LGRID()) {
        const int tok0 = (tile >> 3) * 128, d0 = (tile & 7) * 128;
        f32x16_t mer[2], acc[2];
#pragma unroll
        for (int r = 0; r < 16; ++r) { mer[0][r] = 0.f; mer[1][r] = 0.f; acc[0][r] = 0.f; acc[1][r] = 0.f; }
        uint4 RW00, RW01, RW10, RW11, RY00, RY01, RY10, RY11, RG0, RG1, RG2, RG3;
        bf16* gl = (bf16*)(lds + 4 * MG_TILE_BYTES);
        const int grow = tid >> 4, gch = tid & 15;
#define MG_GLOAD(st_, R_) do { const int n_ = (st_) >> 2, kc_ = (st_) & 3; \
            RW##R_##0 = *(const uint4*)(wbt + ((size_t)n_ * 1024 + d0 + srow0) * 256 + kc_ * 64 + sch * 8); \
            RW##R_##1 = *(const uint4*)(wbt + ((size_t)n_ * 1024 + d0 + srow0 + 64) * 256 + kc_ * 64 + sch * 8); \
            RY##R_##0 = *(const uint4*)(ys + (size_t)(tok0 + srow0) * 1024 + n_ * 256 + kc_ * 64 + sch * 8); \
            RY##R_##1 = *(const uint4*)(ys + (size_t)(tok0 + srow0 + 64) * 1024 + n_ * 256 + kc_ * 64 + sch * 8); } while (0)
#define MG_SSTORE(buf_, R_) do { bf16* wl_ = (bf16*)(lds + (buf_) * 2 * MG_TILE_BYTES); bf16* yl_ = (bf16*)(lds + (buf_) * 2 * MG_TILE_BYTES + MG_TILE_BYTES); \
            *(uint4*)(wl_ + srow0 * MG_P + sch * 8) = RW##R_##0; *(uint4*)(wl_ + (srow0 + 64) * MG_P + sch * 8) = RW##R_##1; \
            *(uint4*)(yl_ + srow0 * MG_P + sch * 8) = RY##R_##0; *(uint4*)(yl_ + (srow0 + 64) * MG_P + sch * 8) = RY##R_##1; } while (0)
        __syncthreads();
        MG_GLOAD(0, 0); MG_GLOAD(1, 1);
        MG_SSTORE(0, 0);
        __syncthreads();
#define MG_STAGE(PAR_, OTH_) do { const int buf = PAR_; \
            if (st + 2 < 16) MG_GLOAD(st + 2, PAR_); \
            if ((st & 3) == 1) { const bf16* gsrc = P + (size_t)(tok0 + grow) * NP + C_G + (st >> 2) * 1024 + d0 + gch * 8; \
                RG0 = *(const uint4*)gsrc; RG1 = *(const uint4*)(gsrc + (size_t)32 * NP); RG2 = *(const uint4*)(gsrc + (size_t)64 * NP); RG3 = *(const uint4*)(gsrc + (size_t)96 * NP); } \
            const bf16* wl = (const bf16*)(lds + buf * 2 * MG_TILE_BYTES); const bf16* yl = (const bf16*)(lds + buf * 2 * MG_TILE_BYTES + MG_TILE_BYTES); \
            _Pragma("unroll") for (int ks = 0; ks < 4; ++ks) { \
                const bf16x8_t bq = *(const bf16x8_t*)(yl + (32 * wt + r32) * MG_P + 16 * ks + 8 * hi); \
                const bf16x8_t a0 = *(const bf16x8_t*)(wl + (64 * wd + r32) * MG_P + 16 * ks + 8 * hi); \
                const bf16x8_t a1 = *(const bf16x8_t*)(wl + (64 * wd + 32 + r32) * MG_P + 16 * ks + 8 * hi); \
                acc[0] = __builtin_amdgcn_mfma_f32_32x32x16_bf16(a0, bq, acc[0], 0, 0, 0); \
                acc[1] = __builtin_amdgcn_mfma_f32_32x32x16_bf16(a1, bq, acc[1], 0, 0, 0); } \
            if ((st & 3) == 3) { \
                const int n = st >> 2; \
                const bf16* gp = gl + (32 * wt + r32) * 136 + 64 * wd + 4 * hi; (void)n; \
                _Pragma("unroll") for (int dt = 0; dt < 2; ++dt) \
                _Pragma("unroll") for (int g = 0; g < 4; ++g) { \
                        const uint2 gv = *(const uint2*)(gp + 32 * dt + 8 * g); \
                        const float g0 = __uint_as_float(gv.x << 16), g1 = __uint_as_float(gv.x & 0xffff0000u), g2 = __uint_as_float(gv.y << 16), g3 = __uint_as_float(gv.y & 0xffff0000u); \
                        mer[dt][4 * g + 0] += acc[dt][4 * g + 0] * g0; \
                        mer[dt][4 * g + 1] += acc[dt][4 * g + 1] * g1; \
                        mer[dt][4 * g + 2] += acc[dt][4 * g + 2] * g2; \
                        mer[dt][4 * g + 3] += acc[dt][4 * g + 3] * g3; } \
                _Pragma("unroll") for (int r = 0; r < 16; ++r) { acc[0][r] = 0.f; acc[1][r] = 0.f; } } \
            if (st + 1 < 16) MG_SSTORE(OTH_, OTH_); \
            if ((st & 3) == 2) { *(uint4*)(gl + grow * 136 + gch * 8) = RG0; *(uint4*)(gl + (grow + 32) * 136 + gch * 8) = RG1; *(uint4*)(gl + (grow + 64) * 136 + gch * 8) = RG2; *(uint4*)(gl + (grow + 96) * 136 + gch * 8) = RG3; } \
            __syncthreads(); } while (0)
#pragma unroll 1
        for (int st2 = 0; st2 < 16; st2 += 2) { { const int st = st2; MG_STAGE(0, 1); } { const int st = st2 + 1; MG_STAGE(1, 0); } }
#undef MG_STAGE
#undef MG_GLOAD
#undef MG_SSTORE
        bf16* mp = merged + (size_t)(tok0 + 32 * wt + r32) * 1024 + d0 + 64 * wd + 4 * hi;
#pragma unroll
        for (int dt = 0; dt < 2; ++dt)
#pragma unroll
            for (int g = 0; g < 4; ++g)
                *(uint2*)(mp + 32 * dt + 8 * g) = make_uint2(cvtpk(mer[dt][4 * g], mer[dt][4 * g + 1]), cvtpk(mer[dt][4 * g + 2], mer[dt][4 * g + 3]));
    }
}
#define LAS __attribute__((address_space(3)))
#define XB_TMO      128
#define XB_XCNT(j)  (256  + 64 * (j))
#define XB_XSUB(j)  (1280 + 64 * (j))
#define XB_XGEN(j)  (2304 + 64 * (j))
#define XB_TOP      3328
#define XB_TOPGEN   3392
#define XCD_BAR_WORDS 3456
#define XB_SPIN_CAP (1u << 18)

__device__ __forceinline__ unsigned xb_ld(unsigned* p)              { return __hip_atomic_load(p, __ATOMIC_RELAXED, __HIP_MEMORY_SCOPE_AGENT); }
__device__ __forceinline__ unsigned xb_add(unsigned* p, unsigned v) { return __hip_atomic_fetch_add(p, v, __ATOMIC_RELAXED, __HIP_MEMORY_SCOPE_AGENT); }
__device__ __forceinline__ unsigned xb_xcc_id() { return (unsigned)__builtin_amdgcn_s_getreg((3 << 11) | 20) & 0xFu; }
#define XB_SPIN(cond, bar) do { unsigned _sp = 0; while (cond) { __builtin_amdgcn_s_sleep(1); \
    if ((++_sp & 255u) == 0u) { if (xb_ld(&(bar)[XB_TMO])) break; if (_sp > XB_SPIN_CAP) { atomicAdd(&(bar)[XB_TMO], 1u); break; } } } } while (0)

struct XcdBarrier {
    unsigned* bar; unsigned x;
    volatile LAS unsigned* st;
};

__device__ __forceinline__ XcdBarrier xcd_barrier_post(unsigned* bar, volatile LAS unsigned* st) {
    XcdBarrier b; b.bar = bar; b.x = xb_xcc_id(); b.st = st;
    if (threadIdx.x == 0) (void)xb_add(&bar[XB_XCNT(b.x)], 1u);
    return b;
}
__device__ __forceinline__ void xcd_barrier_complete(unsigned* bar, unsigned x, unsigned& nloc, unsigned& nx) {
    const unsigned G = gridDim.x * gridDim.y * gridDim.z;
    unsigned sum, cnt, mine, sp = 0u;
    for (;;) {
        sum = 0u; cnt = 0u; mine = 0u;
#pragma unroll
        for (unsigned j = 0; j < 16; ++j) { const unsigned c = xb_ld(&bar[XB_XCNT(j)]); sum += c; cnt += (c > 0u) ? 1u : 0u; mine = (j == x) ? c : mine; }
        if (sum == G) break;
        __builtin_amdgcn_s_sleep(1);
        if ((++sp & 255u) == 0u) { if (xb_ld(&bar[XB_TMO])) break; if (sp > XB_SPIN_CAP) { atomicAdd(&bar[XB_TMO], 1u); break; } }
    }
    nloc = mine > 0u ? mine : 1u; nx = cnt > 0u ? cnt : 1u;
}

__device__ __forceinline__ void xcd_barrier(const XcdBarrier& b, int wv_) {
    asm volatile("s_waitcnt vmcnt(0)" ::: "memory");
    __syncthreads();
    if (wv_ == 0 && LANEID() == 0) {
        unsigned* bar = b.bar;
        __builtin_amdgcn_s_waitcnt(0);
        unsigned nloc = b.st[0], nx = b.st[1];
        if (nloc == 0u) { xcd_barrier_complete(bar, b.x, nloc, nx); b.st[0] = nloc; b.st[1] = nx; }
        const unsigned old = xb_add(&bar[XB_XSUB(b.x)], 1u);
        const unsigned gen = old / nloc;
        if (old + 1u == (gen + 1u) * nloc) {
            __builtin_amdgcn_fence(__ATOMIC_RELEASE, "agent");
            asm volatile("s_waitcnt vmcnt(0)" ::: "memory");
            const unsigned og = xb_add(&bar[XB_TOP], 1u);
            const unsigned tg = og / nx;
            if (og + 1u == (tg + 1u) * nx) xb_add(&bar[XB_TOPGEN], 1u);
            else XB_SPIN(xb_ld(&bar[XB_TOPGEN]) == tg, bar);
            __builtin_amdgcn_fence(__ATOMIC_ACQUIRE, "agent");
            xb_add(&bar[XB_XGEN(b.x)], 1u);
            asm volatile("s_waitcnt vmcnt(0)" ::: "memory");
        } else {
            XB_SPIN(xb_ld(&bar[XB_XGEN(b.x)]) == gen, bar);
            __builtin_amdgcn_fence(__ATOMIC_ACQUIRE, "agent");
            asm volatile("s_waitcnt vmcnt(0)" ::: "memory");
        }
    }
    __syncthreads();
}

enum { PH_PRO = 0, PH_GIN, PH_INDEX, PH_ATTN, PH_MERGE, PH_GOUT, PH_LN1, PH_GQ, PH_ROUTE, PH_PEER };
template <int PH> __device__ __forceinline__ void run_phase(int WV_, const Params& p_unused, int l, unsigned char* lds_raw) {
    size_t kaoff_ = 0; asm volatile("" : "+s"(kaoff_));
    typedef const __attribute__((address_space(4))) char* kaptr_t;
    const __attribute__((address_space(4))) Params& p = *(const __attribute__((address_space(4))) Params*)((kaptr_t)__builtin_amdgcn_kernarg_segment_ptr() + kaoff_);
    float* sm = (float*)lds_raw;
    size_t wsoff_ = 0; asm volatile("" : "+s"(wsoff_));
    unsigned char* ws = p.ws + wsoff_;
    float* hbuf = p.out;
    bf16* hb = (bf16*)(ws + WS_HB);
    bf16* P = (bf16*)(ws + WS_P);
    bf16* ys = (bf16*)(ws + WS_YS);
    bf16* mrg = (bf16*)(ws + WS_MRG);
    float* mix = (float*)(ws + WS_MIX);
    float* qb = (float*)(ws + WS_Q);
    unsigned char* mask = ws + WS_MASK;
    int* eid = (int*)(ws + WS_EID);
    float* gate = (float*)(ws + WS_GATE);
    float* kmean = (float*)(ws + WS_KMEAN);
    const float* hin = (l == 0) ? p.in[0] : hbuf;
    if (PH == PH_PRO) { Params pc; for (int i = 0; i < 13; ++i) pc.in[i] = p.in[i]; pc.out = p.out; pc.ws = ws;
        prologue_phase(WV_, pc, sm); convert_tables(WV_, pc);
        for (int i = LBID() * NTHR + LTID(WV_); i < DEPTH_ * 8 * 2 * 128 * 64 / 4; i += LGRID() * NTHR) { const float4 v = ((const float4*)p.in[8])[i]; ((uint2*)(ws + WS_SKB))[i] = make_uint2(pk2(v.x, v.y), pk2(v.z, v.w)); } if (LBID() < 2) build_unit_table((unsigned*)(ws + WS_CTL) + 1024, LBID() * NTHR + LTID(WV_)); }
    else if (PH == PH_GIN) {
        pg8::Gemm g{hb, (const bf16*)(ws + WS_WIN_T + l * WIN_T_BYTES), T_, NP, 1024};
        pg8::StaticOrder S; S.init(T_, NP, (int)LGRID(), (int)LBID());
        pg8::EpiBf16Sig E{P, NP, C_G};
        pg8::gemm_phase<pg8::EpiBf16Sig, pg8::StaticOrder, true, true>(WV_, (PG8_LAS unsigned char*)lds_raw, g, S, E);
    }
    else if (PH == PH_INDEX) index_fast_phase(WV_, P, mask, kmean, (float*)(ws + WS_UV + 48 * MiB), (unsigned*)(ws + WS_CTL) + 64 * l + 16, lds_raw);
    else if (PH == PH_ATTN) attn_fast_phase(WV_, P, mask, kmean, p.in[4] + l * 4, ys, (const unsigned*)(ws + WS_CTL) + 1024, (unsigned*)(ws + WS_CTL) + 64 * l, lds_raw);
    else if (PH == PH_MERGE) merge_fast_phase(WV_, P, ys, (const bf16*)(ws + WS_WBR_T) + (size_t)l * 4 * 1024 * 256, mrg, lds_raw);
    else if (PH == PH_GOUT) {
        pg8::Gemm g{mrg, (const bf16*)(ws + WS_WOUT_T) + (size_t)l * 1024 * 1024, T_, 1024, 1024};
        pg8::StaticOrder S; S.init(T_, 1024, (int)LGRID(), (int)LBID());
        pg8::EpiResY E{l == 0 ? hin : nullptr, hb, hb, (float*)(ws + WS_STATS) + (size_t)l * T_ * 2, ALPHA};
        pg8::gemm_phase<pg8::EpiResY, pg8::StaticOrder, true, true>(WV_, (PG8_LAS unsigned char*)lds_raw, g, S, E);
    }
    else if (PH == PH_GQ) {
        pg8::Gemm g{hb, (const bf16*)(ws + WS_WQ_T) + (size_t)l * 1024 * 1024, T_, 1024, 1024};
        pg8::StaticOrder S; S.init(T_, 1024, (int)LGRID(), (int)LBID());
        pg8::EpiLnFold E{(bf16*)qb, (const float*)(ws + WS_STATS) + (size_t)l * T_ * 2, (const float*)(ws + WS_COLS) + l * 2048, (const float*)(ws + WS_COLS) + l * 2048 + 1024, LN_EPS};
        pg8::gemm_phase<pg8::EpiLnFold, pg8::StaticOrder, true, true>(WV_, (PG8_LAS unsigned char*)lds_raw, g, S, E);
        pg8::Unit u0;
        if (LGRID() == 256 && S.next(0, u0)) {
            asm volatile("s_waitcnt vmcnt(0)" ::: "memory"); __syncthreads();
            route_fast_phase(WV_, (const bf16*)qb, (const bf16*)(ws + WS_SKB) + (size_t)l * 8 * 2 * 128 * 64, eid, gate, lds_raw, u0.pm, u0.pn);
        }
    }
    else if (PH == PH_ROUTE) { if (LGRID() != 256) route_fast_phase(WV_, (const bf16*)qb, (const bf16*)(ws + WS_SKB) + (size_t)l * 8 * 2 * 128 * 64, eid, gate, lds_raw); }
    else peer_fast_phase(WV_, (l + 1 == DEPTH_) ? hbuf : nullptr, hb, eid, gate, ws + WS_UV + (size_t)l * 24 * MiB, p.in[5] + l * 1024, p.in[6] + l * 1024, p.in[11] + l * 1024, p.in[12] + l * 1024, lds_raw);
}

constexpr int CW_BAR = 4096;
constexpr int LDS_BARST = LDS_BYTES - 16;
__global__ void __launch_bounds__(NTHR, 2) mk_fwd(Params p) {
    extern __shared__ __attribute__((aligned(16))) unsigned char lds_raw[];
    cg::grid_group grid = cg::this_grid();
    const int WV_ = __builtin_amdgcn_readfirstlane((int)threadIdx.x >> 6);
    { volatile LAS unsigned* bst0 = (volatile LAS unsigned*)((LAS unsigned char*)lds_raw + LDS_BARST); if (threadIdx.x < 4) bst0[threadIdx.x] = 0u; }
    __syncthreads();
    volatile LAS unsigned* bst = (volatile LAS unsigned*)((LAS unsigned char*)lds_raw + LDS_BARST);
    { uint4* z = (uint4*)p.ws; const uint4 z4 = make_uint4(0u, 0u, 0u, 0u);
      for (unsigned i = (unsigned)LBID() * NTHR + (unsigned)LTID(WV_); i < (unsigned)(2 * MiB / 16); i += (unsigned)LGRID() * NTHR) z[i] = z4; }
    grid.sync();
    (void)xcd_barrier_post((unsigned*)(p.ws + WS_CTL) + CW_BAR, bst);
#define GRID_BAR() do { XcdBarrier b_; b_.bar = (unsigned*)(p.ws + WS_CTL) + CW_BAR; b_.x = xb_xcc_id(); b_.st = (volatile LAS unsigned*)((LAS unsigned char*)lds_raw + LDS_BARST); xcd_barrier(b_, WV_); } while (0)
    run_phase<PH_PRO>(WV_, p, 0, lds_raw);
    GRID_BAR();
#pragma unroll 1
    for (int l = 0; l < DEPTH_; ++l) {
        run_phase<PH_GIN>(WV_, p, l, lds_raw); GRID_BAR();
        run_phase<PH_INDEX>(WV_, p, l, lds_raw); GRID_BAR();
        run_phase<PH_ATTN>(WV_, p, l, lds_raw); GRID_BAR();
        run_phase<PH_MERGE>(WV_, p, l, lds_raw); GRID_BAR();
        run_phase<PH_GOUT>(WV_, p, l, lds_raw); GRID_BAR();
        run_phase<PH_GQ>(WV_, p, l, lds_raw); if (LGRID() != 256) { GRID_BAR(); run_phase<PH_ROUTE>(WV_, p, l, lds_raw); } GRID_BAR();
        run_phase<PH_PEER>(WV_, p, l, lds_raw); if (l + 1 < DEPTH_) GRID_BAR();
    }
}

extern "C" void kernel_launch(void* const* d_in, const int* in_sizes, int n_in, void* d_out, int out_size, void* d_ws, size_t ws_size, hipStream_t stream) {
    if (n_in != 13 || ws_size < WS_END) { fprintf(stderr, "kernel_launch: unexpected n_in %d / ws_size %zu; nothing launched\n", n_in, ws_size); return; }
    static int grid_blocks = 0;
    if (grid_blocks == 0) {
        int dev = 0, cus = 0, per_cu = 0;
        (void)hipGetDevice(&dev);
        (void)hipDeviceGetAttribute(&cus, hipDeviceAttributeMultiprocessorCount, dev);
        (void)hipFuncSetAttribute((const void*)mk_fwd, hipFuncAttributeMaxDynamicSharedMemorySize, LDS_BYTES);
        (void)hipOccupancyMaxActiveBlocksPerMultiprocessor(&per_cu, (const void*)mk_fwd, NTHR, LDS_BYTES);
        if (per_cu < 1) fprintf(stderr, "kernel_launch: occupancy query reports %d\n", per_cu);
        grid_blocks = cus;
    }
    Params p{};
    for (int i = 0; i < 13; ++i) p.in[i] = (const float*)d_in[i];
    p.out = (float*)d_out; p.ws = (unsigned char*)d_ws;
    void* args[] = {&p};
    hipError_t e = hipLaunchCooperativeKernel((const void*)mk_fwd, dim3(grid_blocks), dim3(NTHR), args, LDS_BYTES, stream);
    if (e != hipSuccess) fprintf(stderr, "cooperative launch failed: %s (grid %d)\n", hipGetErrorString(e), grid_blocks);
}
```

```cpp
#include <hip/hip_runtime.h>
#include <cstdio>
#include <cstdint>
#include <hip/hip_cooperative_groups.h>
namespace cg = cooperative_groups;

__device__ __forceinline__ int LANEID() { int l; asm volatile("v_mbcnt_lo_u32_b32 %0, -1, 0\n\tv_mbcnt_hi_u32_b32 %0, -1, %0" : "=v"(l)); return l; }
__device__ __forceinline__ int LTID(int wv) { return (wv << 6) | LANEID(); }
__device__ __forceinline__ int LBID() { int t = blockIdx.x; asm volatile("" : "+s"(t)); return t; }
__device__ __forceinline__ int LGRID() { int t = gridDim.x; asm volatile("" : "+s"(t)); return t; }
namespace pg8 {
#define PG8_LAS __attribute__((address_space(3)))
typedef unsigned short bf16_t;
typedef short bf16x8 __attribute__((ext_vector_type(8)));
typedef float f32x4 __attribute__((ext_vector_type(4)));
typedef unsigned u32x4 __attribute__((ext_vector_type(4)));
constexpr int BM = 256, BK = 64, HALF = 128, HTB = HALF * BK * 2  , STAGE_BYTES = 8 * HTB, NXCD = 8, WGM = 8;

__host__ __device__ __forceinline__ int lds_byte(int r, int c) { const int st = (r >> 4) * 2 + (c >> 5), rr = r & 15, cc = c & 31, ob = rr * 64 + cc * 2; return st * 1024 + (ob ^ (((ob >> 9) & 1) << 5)); }
__host__ __device__ __forceinline__ void stage_rc(int b, int& R, int& C) { const int st = b / 1024, sb = b % 1024, swz = sb ^ (((sb >> 9) & 1) << 5); R = (st >> 1) * 16 + swz / 64; C = (st & 1) * 32 + (swz % 64) / 2; }
__host__ __device__ __forceinline__ int perm32(int rho) { const int n = rho >> 4, i = rho & 15; return 8 * (i >> 2) + 4 * n + (i & 3); }

struct Unit { int pm, pn; };
struct Gemm { const bf16_t* A; const bf16_t* Bt; int M, N, K; };

struct StaticOrder {
    int nM, nN, nwg, G, c;
    __host__ __device__ void init(int M, int N, int G_, int c_) { nM = M / BM; nN = N / BM; nwg = nM * nN; G = G_; c = c_; }
    __host__ __device__ bool next(int i, Unit& u) const {
        const long L = (long)i * G + c; if (L >= nwg) return false;
        int wgid = (int)L; { const int q = nwg / NXCD, r = nwg % NXCD, xcd = wgid % NXCD, off = wgid / NXCD; wgid = (xcd < r ? xcd * (q + 1) : r * (q + 1) + (xcd - r) * q) + off; }
        const int nig = WGM * nN, gid = wgid / nig, fm = gid * WGM, gsz = (nM - fm) < WGM ? (nM - fm) : WGM;
        u.pm = fm + ((wgid % nig) % gsz); u.pn = (wgid % nig) / gsz; return true;
    }
    __device__ __forceinline__ void a_ready(const Unit&) const {}
    __device__ __forceinline__ void done(const Unit&) const {}
};

__device__ __forceinline__ unsigned cvt_pk_bf16(float lo, float hi) { unsigned r; asm volatile("v_cvt_pk_bf16_f32 %0, %1, %2" : "=v"(r) : "v"(lo), "v"(hi)); return r; }
typedef float f32x2 __attribute__((ext_vector_type(2)));
__device__ __forceinline__ f32x2 gelu_pk(f32x2 v) {
    const f32x2 av = __builtin_elementwise_abs(v), d = av * 0.2316418882f + 1.0f;
    f32x2 t; t.x = __builtin_amdgcn_rcpf(d.x); t.y = __builtin_amdgcn_rcpf(d.y);
    f32x2 q = t * 0.5307027145f + (-0.7265760135f); q = q * t + 0.7107068705f; q = q * t + (-0.142248368f); q = q * t + 0.127414796f; q = q * t;
    const f32x2 s = (v * v) * (-0.72134752044f);
    f32x2 e; e.x = __builtin_amdgcn_exp2f(s.x); e.y = __builtin_amdgcn_exp2f(s.y);
    const f32x2 m = v * (q * e), r = v - m;
    f32x2 o; o.x = v.x < 0.f ? m.x : r.x; o.y = v.y < 0.f ? m.y : r.y; return o;
}

template <int ACT  > struct EpiBf16 {
    static constexpr bool PERM = true, AFTER_DRAIN = false; static_assert(ACT == 0 || ACT == 1, "EpiBf16: ACT is 0 (none) or 1 (gelu_pk)");
    bf16_t* O; int ldc; const float* bias; int split_cols; size_t split_stride; float scale0;
    __device__ __forceinline__ void operator()(const f32x4 (&acc)[2][2][4][2], const Unit& u, int wr, int wc, int fr, int fq) const {
        { int ln_ = LANEID(); asm volatile("" : "+v"(ln_)); fr = ln_ & 15; fq = ln_ >> 4; }
        const int row0 = u.pm * BM + wr * 64 + fr; int colt = u.pn * BM; bf16_t* base = O;
        float sc = 1.f; if (split_cols) { const int t = colt / split_cols; base += (size_t)t * split_stride; colt -= t * split_cols; if (t == 0) sc = scale0; }
        const int col0 = colt + wc * 32 + 8 * fq, bcol0 = u.pn * BM + wc * 32 + 8 * fq;
        f32x4 bv[2][2];
#pragma unroll
        for (int bj = 0; bj < 2; ++bj)
#pragma unroll
            for (int n = 0; n < 2; ++n) bv[bj][n] = bias ? *(const f32x4*)(bias + bcol0 + bj * HALF + 4 * n) : (f32x4){0.f, 0.f, 0.f, 0.f};
#pragma unroll
        for (int ai = 0; ai < 2; ++ai)
#pragma unroll
            for (int m = 0; m < 4; ++m) { bf16_t* rowp = base + (size_t)(row0 + ai * HALF + m * 16) * ldc + col0;
#pragma unroll
                for (int bj = 0; bj < 2; ++bj) { f32x4 v0 = acc[ai][bj][m][0] + bv[bj][0], v1 = acc[ai][bj][m][1] + bv[bj][1];
                    if (ACT == 1) { f32x2 a = gelu_pk((f32x2){v0[0], v0[1]}), b = gelu_pk((f32x2){v0[2], v0[3]}), c = gelu_pk((f32x2){v1[0], v1[1]}), d = gelu_pk((f32x2){v1[2], v1[3]});
                        v0 = (f32x4){a.x, a.y, b.x, b.y}; v1 = (f32x4){c.x, c.y, d.x, d.y}; }
                    v0 = v0 * sc; v1 = v1 * sc; u32x4 w; w.x = cvt_pk_bf16(v0[0], v0[1]); w.y = cvt_pk_bf16(v0[2], v0[3]); w.z = cvt_pk_bf16(v1[0], v1[1]); w.w = cvt_pk_bf16(v1[2], v1[3]);
                    *(u32x4*)(rowp + bj * HALF) = w; } }
    }
};
template <class Epi, class Sched, bool ALIGN_EPI = false, bool SP2 = false>
__device__ __forceinline__ void gemm_phase(int WV_, PG8_LAS unsigned char* lds, const Gemm g, const Sched& S, const Epi& E) {
    const int tid = LTID(WV_), wid = __builtin_amdgcn_readfirstlane(tid >> 6), lane = tid & 63, wr = wid >> 2, wc = wid & 3, fr = lane & 15, fq = lane >> 4;
    const int K = g.K, nt = K / BK;
    unsigned voffA[2], voffB[2];
#pragma unroll
    for (int i = 0; i < 2; ++i) { int R, C; stage_rc(tid * 16 + i * 8192, R, C); const int Rb = Epi::PERM ? ((R & ~31) + perm32(R & 31)) : R;
        voffA[i] = (unsigned)(R * K + C) * 2u; voffB[i] = (unsigned)(Rb * K + C) * 2u; }
    const size_t kstep = (size_t)(BK * 2);
    const size_t hstep = (size_t)HALF * K * 2;
    const size_t tstep = 2 * hstep;
    const unsigned ldsw = (unsigned)wid * 1024u;
    const int aoff = lds_byte(wr * 64 + fr, fq * 8), boff = lds_byte(wc * 32 + fr, fq * 8);
#define PG8_SA(b, h) (((b) * 2 + (h)) * HTB)
#define PG8_SB(b, h) ((4 + (b) * 2 + (h)) * HTB)
#define PG8_STAGE(bufoff, gbase, voff) do { _Pragma("unroll") for (int _i = 0; _i < 2; ++_i) \
        __builtin_amdgcn_global_load_lds((const unsigned*)((const char*)(gbase) + (voff)[_i]), (PG8_LAS unsigned*)(lds + (bufoff) + ldsw + _i * 8192), 16, 0, 0); } while (0)
#define PG8_LDA(dst, b, h) do { _Pragma("unroll") for (int m = 0; m < 4; ++m) _Pragma("unroll") for (int k = 0; k < 2; ++k) dst[m][k] = *(const PG8_LAS bf16x8*)(lds + PG8_SA(b, h) + aoff + m * 2048 + k * 1024); } while (0)
#define PG8_LDB(dst, b, h) do { _Pragma("unroll") for (int n = 0; n < 2; ++n) _Pragma("unroll") for (int k = 0; k < 2; ++k) dst[n][k] = *(const PG8_LAS bf16x8*)(lds + PG8_SB(b, h) + boff + n * 2048 + k * 1024); } while (0)
#define PG8_MMA(ai, bj, At, Bt) do { __builtin_amdgcn_s_setprio(1); _Pragma("unroll") for (int m = 0; m < 4; ++m) _Pragma("unroll") for (int n = 0; n < 2; ++n) _Pragma("unroll") for (int k = 0; k < 2; ++k) \
        acc[ai][bj][m][n] = __builtin_amdgcn_mfma_f32_16x16x32_bf16(Bt[n][k], At[m][k], acc[ai][bj][m][n], 0, 0, 0); __builtin_amdgcn_s_setprio(0); } while (0)
#define PG8_WAIT_V(n) asm volatile("s_waitcnt vmcnt(" #n ")" ::: "memory")
#define PG8_WAIT_L(n) asm volatile("s_waitcnt lgkmcnt(" #n ")" ::: "memory")
#define PG8_BAR __builtin_amdgcn_s_barrier()
#define PG8_SCHED __builtin_amdgcn_sched_barrier(0)
    Unit cur, nxt; int ui = 0;
    if (!S.next(0, cur)) return;
    f32x4 acc[2][2][4][2];
#pragma unroll
    for (int a = 0; a < 2; ++a)
#pragma unroll
        for (int b = 0; b < 2; ++b)
#pragma unroll
            for (int m = 0; m < 4; ++m)
#pragma unroll
                for (int n = 0; n < 2; ++n) acc[a][b][m][n] = (f32x4){0.f, 0.f, 0.f, 0.f};
    bf16x8 At[4][2], B0[2][2], B1[2][2];
    const char* cA = (const char*)g.A + (size_t)cur.pm * tstep; const char* cB = (const char*)g.Bt + (size_t)cur.pn * tstep;
    S.a_ready(cur);
    if constexpr (SP2) {
        PG8_STAGE(PG8_SB(0, 0), cB, voffB); PG8_STAGE(PG8_SB(0, 1), cB + hstep, voffB); PG8_STAGE(PG8_SA(0, 0), cA, voffA); PG8_STAGE(PG8_SA(0, 1), cA + hstep, voffA);
        if (wr == 1) PG8_BAR;
        PG8_WAIT_V(2); PG8_BAR;
        PG8_STAGE(PG8_SB(1, 0), cB + kstep, voffB); PG8_STAGE(PG8_SA(1, 0), cA + kstep, voffA); PG8_STAGE(PG8_SB(1, 1), cB + hstep + kstep, voffB);
        PG8_WAIT_V(6); PG8_BAR;
    } else {
        PG8_STAGE(PG8_SB(0, 0), cB, voffB); PG8_STAGE(PG8_SA(0, 0), cA, voffA); PG8_STAGE(PG8_SB(0, 1), cB + hstep, voffB); PG8_STAGE(PG8_SA(0, 1), cA + hstep, voffA);
        if (wr == 1) PG8_BAR;
        PG8_WAIT_V(4); PG8_BAR;
        PG8_STAGE(PG8_SB(1, 0), cB + kstep, voffB); PG8_STAGE(PG8_SA(1, 0), cA + kstep, voffA); PG8_STAGE(PG8_SB(1, 1), cB + hstep + kstep, voffB);
        PG8_WAIT_V(6); PG8_BAR;
    }
    for (;;) {
        const bool has_next = S.next(ui + 1, nxt);
        const char* nA = has_next ? (const char*)g.A + (size_t)nxt.pm * tstep : cA; const char* nB = has_next ? (const char*)g.Bt + (size_t)nxt.pn * tstep : cB;
        for (int t = 0; t < nt; t += 2) {
            const bool last = (t == nt - 2);
            const char* a1 = cA + (size_t)(t + 1) * kstep;
            const char* a2 = last ? nA : cA + (size_t)(t + 2) * kstep; const char* b2 = last ? nB : cB + (size_t)(t + 2) * kstep;
            const char* a3 = a2 + kstep; const char* b3 = b2 + kstep;
            if (last && has_next) S.a_ready(nxt);
            if constexpr (SP2) {
            PG8_LDB(B0, 0, 0); PG8_LDB(B1, 0, 1); PG8_SCHED; PG8_LDA(At, 0, 0); PG8_STAGE(PG8_SA(1, 1), a1 + hstep, voffA);
            PG8_WAIT_V(8); PG8_WAIT_L(0); PG8_BAR; PG8_MMA(0, 0, At, B0); PG8_MMA(0, 1, At, B1); PG8_BAR; PG8_SCHED;
            PG8_LDA(At, 0, 1); PG8_STAGE(PG8_SB(0, 0), b2, voffB); PG8_STAGE(PG8_SB(0, 1), b2 + hstep, voffB); PG8_STAGE(PG8_SA(0, 0), a2, voffA);
            PG8_WAIT_V(8); PG8_WAIT_L(0); PG8_BAR; PG8_MMA(1, 0, At, B0); PG8_MMA(1, 1, At, B1); PG8_BAR; PG8_SCHED;
            PG8_LDB(B0, 1, 0); PG8_LDB(B1, 1, 1); PG8_SCHED; PG8_LDA(At, 1, 0); PG8_STAGE(PG8_SA(0, 1), a2 + hstep, voffA);
            PG8_WAIT_V(8); PG8_WAIT_L(0); PG8_BAR; PG8_MMA(0, 0, At, B0); PG8_MMA(0, 1, At, B1); PG8_BAR; PG8_SCHED;
            PG8_LDA(At, 1, 1); PG8_STAGE(PG8_SB(1, 0), b3, voffB); PG8_STAGE(PG8_SB(1, 1), b3 + hstep, voffB); PG8_STAGE(PG8_SA(1, 0), a3, voffA);
            PG8_WAIT_V(8); PG8_WAIT_L(0); PG8_BAR; PG8_MMA(1, 0, At, B0); PG8_MMA(1, 1, At, B1); PG8_BAR; PG8_SCHED;
            } else {
            PG8_LDB(B0, 0, 0); PG8_SCHED; PG8_LDA(At, 0, 0); PG8_STAGE(PG8_SA(1, 1), a1 + hstep, voffA);
            PG8_WAIT_L(8); PG8_BAR; PG8_WAIT_L(0); PG8_MMA(0, 0, At, B0); PG8_BAR; PG8_SCHED;
            PG8_LDB(B1, 0, 1); PG8_STAGE(PG8_SB(0, 0), b2, voffB);
            PG8_BAR; PG8_WAIT_L(0); PG8_MMA(0, 1, At, B1); PG8_BAR;
            PG8_LDA(At, 0, 1); PG8_STAGE(PG8_SA(0, 0), a2, voffA);
            PG8_BAR; PG8_WAIT_L(0); PG8_MMA(1, 0, At, B0); PG8_BAR; PG8_SCHED;
            PG8_STAGE(PG8_SB(0, 1), b2 + hstep, voffB);
            PG8_WAIT_V(6); PG8_BAR; PG8_MMA(1, 1, At, B1); PG8_BAR;
            PG8_LDB(B0, 1, 0); PG8_SCHED; PG8_LDA(At, 1, 0); PG8_STAGE(PG8_SA(0, 1), a2 + hstep, voffA);
            PG8_WAIT_L(8); PG8_BAR; PG8_WAIT_L(0); PG8_MMA(0, 0, At, B0); PG8_BAR; PG8_SCHED;
            PG8_LDB(B1, 1, 1); PG8_STAGE(PG8_SB(1, 0), b3, voffB);
            PG8_BAR; PG8_WAIT_L(0); PG8_MMA(0, 1, At, B1); PG8_BAR;
            PG8_LDA(At, 1, 1); PG8_STAGE(PG8_SA(1, 0), a3, voffA);
            PG8_BAR; PG8_WAIT_L(0); PG8_MMA(1, 0, At, B0); PG8_BAR; PG8_SCHED;
            PG8_STAGE(PG8_SB(1, 1), b3 + hstep, voffB);
            PG8_WAIT_V(6); PG8_BAR; PG8_MMA(1, 1, At, B1); PG8_BAR;
            }
        }
        if constexpr (ALIGN_EPI) { if (wr == 0) PG8_BAR; }
        if constexpr (!Epi::AFTER_DRAIN) { E(acc, cur, wr, wc, fr, fq); S.done(cur); }
        if (!has_next) break;
#pragma unroll
        for (int a = 0; a < 2; ++a)
#pragma unroll
            for (int b = 0; b < 2; ++b)
#pragma unroll
                for (int m = 0; m < 4; ++m)
#pragma unroll
                    for (int n = 0; n < 2; ++n) acc[a][b][m][n] = (f32x4){0.f, 0.f, 0.f, 0.f};
        cur = nxt; cA = nA; cB = nB; ++ui;
        if constexpr (ALIGN_EPI) { if (wr == 1) PG8_BAR; }
    }
    PG8_WAIT_V(0);
    if constexpr (!ALIGN_EPI) { if (wr == 0) PG8_BAR; }
    PG8_BAR;
    if constexpr (Epi::AFTER_DRAIN) { E.fused(acc, cur, wr, wc, fr, fq, lds, wid, lane); S.done(cur); }
#undef PG8_SA
#undef PG8_SB
#undef PG8_STAGE
#undef PG8_LDA
#undef PG8_LDB
#undef PG8_MMA
#undef PG8_WAIT_V
#undef PG8_WAIT_L
#undef PG8_BAR
#undef PG8_SCHED
}
}
namespace pg8 {
struct EpiF32 {
    static constexpr bool PERM = false, AFTER_DRAIN = false;
    float* O; int ldc;
    __device__ __forceinline__ void operator()(const f32x4 (&acc)[2][2][4][2], const Unit& u, int wr, int wc, int fr, int fq) const {
        { int ln_ = LANEID(); asm volatile("" : "+v"(ln_)); fr = ln_ & 15; fq = ln_ >> 4; }
        const int row0 = u.pm * BM + wr * 64 + fr, col0 = u.pn * BM + wc * 32 + 4 * fq;
#pragma unroll
        for (int ai = 0; ai < 2; ++ai)
#pragma unroll
            for (int m = 0; m < 4; ++m) { float* rowp = O + (size_t)(row0 + ai * HALF + m * 16) * ldc + col0;
#pragma unroll
                for (int bj = 0; bj < 2; ++bj)
#pragma unroll
                    for (int n = 0; n < 2; ++n) *(f32x4*)(rowp + bj * HALF + n * 16) = acc[ai][bj][m][n]; }
    }
};
struct EpiResY {
    static constexpr bool PERM = false, AFTER_DRAIN = false;
    const float* hin; const bf16_t* hinb; bf16_t* yb; float* stats; float alpha;
    __device__ __forceinline__ void operator()(const f32x4 (&acc)[2][2][4][2], const Unit& u, int wr, int wc, int fr, int fq) const {
        { int ln_ = LANEID(); asm volatile("" : "+v"(ln_)); fr = ln_ & 15; fq = ln_ >> 4; }
        const int row0 = u.pm * BM + wr * 64 + fr, col0 = u.pn * BM + wc * 32 + 4 * fq;
#pragma unroll
        for (int ai = 0; ai < 2; ++ai)
#pragma unroll
            for (int m = 0; m < 4; ++m) {
                const int row = row0 + ai * HALF + m * 16;
                float s = 0.f, s2 = 0.f;
#pragma unroll
                for (int bj = 0; bj < 2; ++bj)
#pragma unroll
                    for (int n = 0; n < 2; ++n) {
                        const size_t off = (size_t)row * 1024 + col0 + bj * HALF + n * 16;
                        f32x4 hv;
                        if (hin) hv = *(const f32x4*)(hin + off);
                        else { typedef unsigned u32x2r __attribute__((ext_vector_type(2))); const u32x2r hw = *(const u32x2r*)(hinb + off);
                            hv[0] = __uint_as_float(hw.x << 16); hv[1] = __uint_as_float(hw.x & 0xffff0000u); hv[2] = __uint_as_float(hw.y << 16); hv[3] = __uint_as_float(hw.y & 0xffff0000u); }
                        const f32x4 y = hv * alpha + acc[ai][bj][m][n];
                        typedef unsigned u32x2v __attribute__((ext_vector_type(2)));
                        u32x2v w; w.x = cvt_pk_bf16(y[0], y[1]); w.y = cvt_pk_bf16(y[2], y[3]);
                        *(u32x2v*)(yb + off) = w;
                        s += (y[0] + y[1]) + (y[2] + y[3]); s2 += (y[0] * y[0] + y[1] * y[1]) + (y[2] * y[2] + y[3] * y[3]);
                    }
                s += __shfl_xor(s, 16); s += __shfl_xor(s, 32); s2 += __shfl_xor(s2, 16); s2 += __shfl_xor(s2, 32);
                if (fq == 0) { atomicAdd(stats + 2 * (size_t)row, s); atomicAdd(stats + 2 * (size_t)row + 1, s2); }
            }
    }
};
struct EpiLnFold {
    static constexpr bool PERM = true, AFTER_DRAIN = false;
    bf16_t* O; const float* stats; const float* colsum; const float* colbias; float eps;
    __device__ __forceinline__ void operator()(const f32x4 (&acc)[2][2][4][2], const Unit& u, int wr, int wc, int fr, int fq) const {
        { int ln_ = LANEID(); asm volatile("" : "+v"(ln_)); fr = ln_ & 15; fq = ln_ >> 4; }
        const int row0 = u.pm * BM + wr * 64 + fr, col0 = u.pn * BM + wc * 32 + 8 * fq;
        f32x4 cs[2][2], cb[2][2];
#pragma unroll
        for (int bj = 0; bj < 2; ++bj)
#pragma unroll
            for (int n = 0; n < 2; ++n) { cs[bj][n] = *(const f32x4*)(colsum + col0 + bj * HALF + 4 * n); cb[bj][n] = *(const f32x4*)(colbias + col0 + bj * HALF + 4 * n); }
#pragma unroll
        for (int ai = 0; ai < 2; ++ai)
#pragma unroll
            for (int m = 0; m < 4; ++m) {
                const int row = row0 + ai * HALF + m * 16;
                const float sm_ = stats[2 * (size_t)row], sq_ = stats[2 * (size_t)row + 1];
                const float mean = sm_ * (1.0f / 1024.0f);
                const float rstd = 1.0f / sqrtf(fmaxf(sq_ * (1.0f / 1024.0f) - mean * mean, 0.f) + eps);
                bf16_t* rowp = O + (size_t)row * 1024 + col0;
#pragma unroll
                for (int bj = 0; bj < 2; ++bj) {
                    const f32x4 v0 = (acc[ai][bj][m][0] - cs[bj][0] * mean) * rstd + cb[bj][0], v1 = (acc[ai][bj][m][1] - cs[bj][1] * mean) * rstd + cb[bj][1];
                    u32x4 w; w.x = cvt_pk_bf16(v0[0], v0[1]); w.y = cvt_pk_bf16(v0[2], v0[3]); w.z = cvt_pk_bf16(v1[0], v1[1]); w.w = cvt_pk_bf16(v1[2], v1[3]);
                    *(u32x4*)(rowp + bj * HALF) = w;
                }
            }
    }
};
__device__ __forceinline__ unsigned cvt_pk_bf16_t(float lo, float hi) { unsigned r; asm volatile("s_nop 0\n\tv_cvt_pk_bf16_f32 %0, %1, %2" : "=v"(r) : "v"(lo), "v"(hi)); return r; }
struct EpiBf16Sig {
    static constexpr bool PERM = true, AFTER_DRAIN = false;
    bf16_t* O; int ldc; int sig_col0;
    __device__ __forceinline__ void operator()(const f32x4 (&acc)[2][2][4][2], const Unit& u, int wr, int wc, int fr, int fq) const {
        { int ln_ = LANEID(); asm volatile("" : "+v"(ln_)); fr = ln_ & 15; fq = ln_ >> 4; }
        const int row0 = u.pm * BM + wr * 64 + fr; const int col0 = u.pn * BM + wc * 32 + 8 * fq;
#pragma unroll
        for (int bj = 0; bj < 2; ++bj) {
            if (col0 + bj * HALF >= sig_col0) {
#pragma unroll
                for (int ai = 0; ai < 2; ++ai)
#pragma unroll
                    for (int m = 0; m < 4; ++m) { bf16_t* rowp = O + (size_t)(row0 + ai * HALF + m * 16) * ldc + col0;
                        f32x4 v0 = acc[ai][bj][m][0], v1 = acc[ai][bj][m][1];
#pragma unroll
                        for (int e = 0; e < 4; ++e) { v0[e] = __builtin_amdgcn_rcpf(1.f + __builtin_amdgcn_exp2f(-1.44269504f * v0[e])); v1[e] = __builtin_amdgcn_rcpf(1.f + __builtin_amdgcn_exp2f(-1.44269504f * v1[e])); }
                        u32x4 w; w.x = cvt_pk_bf16_t(v0[0], v0[1]); w.y = cvt_pk_bf16_t(v0[2], v0[3]); w.z = cvt_pk_bf16_t(v1[0], v1[1]); w.w = cvt_pk_bf16_t(v1[2], v1[3]);
                        *(u32x4*)(rowp + bj * HALF) = w; }
            } else {
#pragma unroll
                for (int ai = 0; ai < 2; ++ai)
#pragma unroll
                    for (int m = 0; m < 4; ++m) { bf16_t* rowp = O + (size_t)(row0 + ai * HALF + m * 16) * ldc + col0;
                        const f32x4 v0 = acc[ai][bj][m][0], v1 = acc[ai][bj][m][1];
                        u32x4 w; w.x = cvt_pk_bf16(v0[0], v0[1]); w.y = cvt_pk_bf16(v0[2], v0[3]); w.z = cvt_pk_bf16(v1[0], v1[1]); w.w = cvt_pk_bf16(v1[2], v1[3]);
                        *(u32x4*)(rowp + bj * HALF) = w; }
            }
        }
    }
};
}

typedef unsigned short bf16;
constexpr int T_ = 16384, S_ = 4096, NBATCH = 4, D_ = 1024, NCOL = 6824, NP = 6912, DEPTH_ = 2;
constexpr int C_QA = 0, C_KA = 256, C_VA = 320, C_QI = 384, C_KI = 640, C_WI = 672, C_QB = 680, C_KB = 936, C_VB = 1064,
              C_QC = 1192, C_KC = 1448, C_VC = 1704, C_QD = 1960, C_KD = 2216, C_VD = 2472, C_G = 2728;
constexpr int NTHR = 512, NWAVE = 8;
constexpr float ALPHA = 1.41421356237309515f;
constexpr float LN_EPS = 1e-5f;
constexpr size_t MiB = 1u << 20;
constexpr size_t WS_STATS = 1 * MiB  , WS_COLS = 1 * MiB + 512 * 1024  ;
constexpr size_t WS_CTL = 0, WS_WIN_T = 2 * MiB, WS_WOUT_T = 30 * MiB, WS_WQ_T = 34 * MiB, WS_WBR_T = 38 * MiB, WS_HB = 42 * MiB,
                 WS_P = 74 * MiB, WS_MIX = 74 * MiB  , WS_Q = 138 * MiB  , WS_YS = 290 * MiB, WS_MRG = 322 * MiB,
                 WS_MASK = 354 * MiB, WS_EID = 362 * MiB, WS_GATE = 370 * MiB, WS_KMEAN = 378 * MiB, WS_SKB = 379 * MiB, WS_UV = 380 * MiB, WS_END = 508 * MiB;
constexpr size_t WIN_T_BYTES = (size_t)NP * 1024 * 2;
constexpr int LDS_BYTES = 144 * 1024;

struct Params { const float* in[13]; float* out; unsigned char* ws; };

__device__ __forceinline__ float bf2f(bf16 v) { return __uint_as_float((unsigned)v << 16); }
__device__ __forceinline__ unsigned f2bf(float f) { unsigned u = __float_as_uint(f); return (u + 0x7fffu + ((u >> 16) & 1u)) >> 16; }
__device__ __forceinline__ unsigned pk2(float lo, float hi) { return f2bf(lo) | (f2bf(hi) << 16); }
__device__ __forceinline__ void unpack8(const uint4 v, float* o) {
    o[0] = __uint_as_float(v.x << 16); o[1] = __uint_as_float(v.x & 0xffff0000u); o[2] = __uint_as_float(v.y << 16); o[3] = __uint_as_float(v.y & 0xffff0000u);
    o[4] = __uint_as_float(v.z << 16); o[5] = __uint_as_float(v.z & 0xffff0000u); o[6] = __uint_as_float(v.w << 16); o[7] = __uint_as_float(v.w & 0xffff0000u);
}
__device__ __forceinline__ float wave_sum(float v) {
#pragma unroll
    for (int o = 32; o > 0; o >>= 1) v += __shfl_xor(v, o);
    return v;
}
__device__ __forceinline__ float wave_max(float v) {
#pragma unroll
    for (int o = 32; o > 0; o >>= 1) v = fmaxf(v, __shfl_xor(v, o));
    return v;
}
__device__ __forceinline__ int wave_sum_i(int v) {
#pragma unroll
    for (int o = 32; o > 0; o >>= 1) v += __shfl_xor(v, o);
    return v;
}
__device__ __forceinline__ float logsig(float x) { return fminf(x, 0.f) - log1pf(expf(-fabsf(x))); }

__device__ void transpose_items(int WV_, const float* W, int K, int N, bf16* WT, float* sm, int item0, int nitems_total, int item_stride,
                                const float* rs_g = nullptr, const float* rs_b = nullptr, float* colsum = nullptr, float* colbias = nullptr) {
    const int tid = LTID(WV_);
    const int nkb = K / 64, nnb = (N + 63) / 64;
    for (int it = item0; it < nkb * nnb; it += item_stride) {
        const int kb = it % nkb, nb = it / nkb, k0 = kb * 64, n0 = nb * 64;
        __syncthreads();
        for (int e = tid; e < 64 * 64; e += NTHR) { const int kk = e >> 6, nn = e & 63; sm[kk * 65 + nn] = (n0 + nn < N) ? W[(size_t)(k0 + kk) * N + n0 + nn] : 0.f; }
        __syncthreads();
        if (rs_g) {
            if (tid < 64) { float cs = 0.f, cb = 0.f;
                for (int kk = 0; kk < 64; ++kk) { const float w = sm[kk * 65 + tid]; cs += w * rs_g[k0 + kk]; cb += w * rs_b[k0 + kk]; }
                atomicAdd(colsum + n0 + tid, cs); atomicAdd(colbias + n0 + tid, cb); }
            __syncthreads();
            for (int e = tid; e < 64 * 64; e += NTHR) { const int kk = e >> 6, nn = e & 63; sm[kk * 65 + nn] *= rs_g[k0 + kk]; }
            __syncthreads();
        }
        { const int nn = tid >> 3, c = tid & 7;
          if (n0 + nn < N) { uint4 o; o.x = pk2(sm[(8 * c + 0) * 65 + nn], sm[(8 * c + 1) * 65 + nn]); o.y = pk2(sm[(8 * c + 2) * 65 + nn], sm[(8 * c + 3) * 65 + nn]);
              o.z = pk2(sm[(8 * c + 4) * 65 + nn], sm[(8 * c + 5) * 65 + nn]); o.w = pk2(sm[(8 * c + 6) * 65 + nn], sm[(8 * c + 7) * 65 + nn]);
              *(uint4*)(WT + (size_t)(n0 + nn) * K + k0 + 8 * c) = o; } }
    }
    __syncthreads();
}
constexpr int TI_WIN = 16 * ((NCOL + 63) / 64), TI_SQ = 256, TI_LAYER = TI_WIN + 3 * TI_SQ;
#define TITEM_DECODE(it_, W_, WT_, K_, N_, k0_, n0_, fold_, l_) do { \
        l_ = (it_) / TI_LAYER; const int r_ = (it_) - l_ * TI_LAYER; \
        const int kind_ = r_ < TI_WIN ? 0 : (r_ < TI_WIN + TI_SQ ? 1 : (r_ < TI_WIN + 2 * TI_SQ ? 2 : 3)); \
        const int q_ = r_ - (kind_ == 0 ? 0 : TI_WIN + (kind_ - 1) * TI_SQ); \
        fold_ = kind_ == 2; K_ = kind_ == 3 ? 256 : 1024; N_ = kind_ == 0 ? NCOL : 1024; \
        k0_ = kind_ == 3 ? (q_ & 3) * 64 : (q_ & 15) * 64; n0_ = kind_ == 3 ? ((q_ & 63) >> 2) * 64 : (q_ >> 4) * 64; \
        const int nbr_ = q_ >> 6; \
        W_ = kind_ == 0 ? pin1 + (size_t)l_ * 1024 * NCOL : kind_ == 1 ? pin3 + (size_t)l_ * 1024 * 1024 : kind_ == 2 ? pin7 + (size_t)l_ * 1024 * 1024 : pin2 + ((size_t)l_ * 4 + nbr_) * 256 * 1024; \
        WT_ = kind_ == 0 ? (bf16*)(ws + WS_WIN_T + l_ * WIN_T_BYTES) : kind_ == 1 ? (bf16*)(ws + WS_WOUT_T) + (size_t)l_ * 1024 * 1024 : kind_ == 2 ? (bf16*)(ws + WS_WQ_T) + (size_t)l_ * 1024 * 1024 \
              : (bf16*)(ws + WS_WBR_T) + ((size_t)l_ * 4 + nbr_) * 1024 * 256; } while (0)
__device__ __forceinline__ void titem_finish(bf16* WT, int K, int N, int k0, int n0, const float* rs_g, const float* rs_b, float* colsum, float* colbias, float* sm, int tid) {
    if (rs_g) {
        if (tid < 64) { float cs = 0.f, cb = 0.f;
            for (int kk = 0; kk < 64; ++kk) { const float w = sm[kk * 65 + tid]; cs += w * rs_g[k0 + kk]; cb += w * rs_b[k0 + kk]; }
            atomicAdd(colsum + n0 + tid, cs); atomicAdd(colbias + n0 + tid, cb); }
        __syncthreads();
        for (int e = tid; e < 64 * 64; e += NTHR) { const int kk = e >> 6, nn = e & 63; sm[kk * 65 + nn] *= rs_g[k0 + kk]; }
        __syncthreads();
    }
    { const int nn = tid >> 3, c = tid & 7;
      if (n0 + nn < N) { uint4 o; o.x = pk2(sm[(8 * c + 0) * 65 + nn], sm[(8 * c + 1) * 65 + nn]); o.y = pk2(sm[(8 * c + 2) * 65 + nn], sm[(8 * c + 3) * 65 + nn]);
          o.z = pk2(sm[(8 * c + 4) * 65 + nn], sm[(8 * c + 5) * 65 + nn]); o.w = pk2(sm[(8 * c + 6) * 65 + nn], sm[(8 * c + 7) * 65 + nn]);
          *(uint4*)(WT + (size_t)(n0 + nn) * K + k0 + 8 * c) = o; } }
}
__device__ void prologue_phase(int WV_, const Params& p, float* sm) {
    const int tid = LTID(WV_), B = LBID(), G = LGRID();
    unsigned char* ws = p.ws;
    float* sm1 = sm + 64 * 65;
    const float* pin1 = p.in[1]; const float* pin2 = p.in[2]; const float* pin3 = p.in[3]; const float* pin7 = p.in[7]; const float* pin5 = p.in[5]; const float* pin6 = p.in[6];
    asm volatile("" : "+s"(pin1), "+s"(pin2), "+s"(pin3), "+s"(pin7), "+s"(pin5), "+s"(pin6));
    const int kk0 = tid >> 4, c4 = tid & 15;
    for (int it = B; it < DEPTH_ * TI_LAYER; it += 2 * G) {
        const int it2 = it + G; const bool has2 = it2 < DEPTH_ * TI_LAYER;
        const float* Wa; const float* Wb; bf16* WTa; bf16* WTb; int Ka, Na, k0a, n0a, la, Kb, Nb, k0b, n0b, lb; bool fa, fb;
        TITEM_DECODE(it, Wa, WTa, Ka, Na, k0a, n0a, fa, la);
        { const int itb = has2 ? it2 : it; TITEM_DECODE(itb, Wb, WTb, Kb, Nb, k0b, n0b, fb, lb); }
        const float4 z4 = make_float4(0.f, 0.f, 0.f, 0.f);
        const bool ina = n0a + 4 * c4 < Na, inb = n0b + 4 * c4 < Nb;
        float4 a0 = z4, a1 = z4, b0 = z4, b1 = z4;
        if (ina) { a0 = *(const float4*)(Wa + (size_t)(k0a + kk0) * Na + n0a + 4 * c4); a1 = *(const float4*)(Wa + (size_t)(k0a + kk0 + 32) * Na + n0a + 4 * c4); }
        if (inb) { b0 = *(const float4*)(Wb + (size_t)(k0b + kk0) * Nb + n0b + 4 * c4); b1 = *(const float4*)(Wb + (size_t)(k0b + kk0 + 32) * Nb + n0b + 4 * c4); }
        __syncthreads();
        { float* d = sm + kk0 * 65 + 4 * c4; d[0] = a0.x; d[1] = a0.y; d[2] = a0.z; d[3] = a0.w; d += 32 * 65; d[0] = a1.x; d[1] = a1.y; d[2] = a1.z; d[3] = a1.w; }
        { float* d = sm1 + kk0 * 65 + 4 * c4; d[0] = b0.x; d[1] = b0.y; d[2] = b0.z; d[3] = b0.w; d += 32 * 65; d[0] = b1.x; d[1] = b1.y; d[2] = b1.z; d[3] = b1.w; }
        __syncthreads();
        titem_finish(WTa, Ka, Na, k0a, n0a, fa ? pin5 + la * 1024 : nullptr, pin6 + la * 1024, (float*)(ws + WS_COLS) + la * 2048, (float*)(ws + WS_COLS) + la * 2048 + 1024, sm, tid);
        if (has2) titem_finish(WTb, Kb, Nb, k0b, n0b, fb ? pin5 + lb * 1024 : nullptr, pin6 + lb * 1024, (float*)(ws + WS_COLS) + lb * 2048, (float*)(ws + WS_COLS) + lb * 2048 + 1024, sm1, tid);
    }
    __syncthreads();
    for (int l = 0; l < DEPTH_; ++l) {
        bf16* win_t = (bf16*)(ws + WS_WIN_T + l * WIN_T_BYTES);
        for (int i = B * NTHR + tid; i < (NP - NCOL) * 1024 / 8; i += G * NTHR) ((uint4*)(win_t + (size_t)NCOL * 1024))[i] = make_uint4(0u, 0u, 0u, 0u);
    }
    const float4* x4 = (const float4*)p.in[0]; uint2* hb2 = (uint2*)(ws + WS_HB);
    for (size_t i = (size_t)B * NTHR + tid; i < (size_t)T_ * 1024 / 4; i += (size_t)G * NTHR) { const float4 v = x4[i]; hb2[i] = make_uint2(pk2(v.x, v.y), pk2(v.z, v.w)); }
}

__device__ __forceinline__ void ln_row(float4 (&v)[4], const float* g, const float* bb, float* orow, bf16* obrow, int lane) {
    float s = 0.f;
#pragma unroll
    for (int j = 0; j < 4; ++j) s += (v[j].x + v[j].y) + (v[j].z + v[j].w);
    const float mean = wave_sum(s) * (1.0f / 1024.0f);
    float s2 = 0.f;
#pragma unroll
    for (int j = 0; j < 4; ++j) { v[j].x -= mean; v[j].y -= mean; v[j].z -= mean; v[j].w -= mean; s2 += (v[j].x * v[j].x + v[j].y * v[j].y) + (v[j].z * v[j].z + v[j].w * v[j].w); }
    const float rstd = 1.0f / sqrtf(wave_sum(s2) * (1.0f / 1024.0f) + LN_EPS);
#pragma unroll
    for (int j = 0; j < 4; ++j) {
        const float4 gg = ((const float4*)g)[j * 64 + lane], b4 = ((const float4*)bb)[j * 64 + lane];
        float4 o; o.x = v[j].x * rstd * gg.x + b4.x; o.y = v[j].y * rstd * gg.y + b4.y; o.z = v[j].z * rstd * gg.z + b4.z; o.w = v[j].w * rstd * gg.w + b4.w;
        ((float4*)orow)[j * 64 + lane] = o;
        ((uint2*)obrow)[j * 64 + lane] = make_uint2(pk2(o.x, o.y), pk2(o.z, o.w));
    }
}
__device__ void ln1_phase(int WV_, const float* hin, const float* add, const float* g, const float* bb, float* hout, bf16* hb) {
    const int lane = LTID(WV_) & 63, wave = LTID(WV_) >> 6;
    for (int row = LBID() * NWAVE + wave; row < T_; row += LGRID() * NWAVE) {
        float4 v[4];
#pragma unroll
        for (int j = 0; j < 4; ++j) {
            const float4 a = ((const float4*)(hin + (size_t)row * 1024))[j * 64 + lane], m = ((const float4*)(add + (size_t)row * 1024))[j * 64 + lane];
            v[j].x = ALPHA * a.x + m.x; v[j].y = ALPHA * a.y + m.y; v[j].z = ALPHA * a.z + m.z; v[j].w = ALPHA * a.w + m.w;
        }
        ln_row(v, g, bb, hout + (size_t)row * 1024, hb + (size_t)row * 1024, lane);
    }
}


typedef short bf16x8_t __attribute__((ext_vector_type(8)));
typedef float f32x16_t __attribute__((ext_vector_type(16)));
typedef float f32x2_t __attribute__((ext_vector_type(2)));
typedef __bf16 bf16x2_t __attribute__((ext_vector_type(2)));
__device__ __forceinline__ unsigned cvtpk(float lo, float hi) { f32x2_t v = {lo, hi}; bf16x2_t b = __builtin_convertvector(v, bf16x2_t); return __builtin_bit_cast(unsigned, b); }
__device__ __forceinline__ int crow(int r, int hi) { return (r & 3) + 8 * (r >> 2) + 4 * hi; }
__device__ __forceinline__ float xlane32(float v) { return __shfl_xor(v, 32); }
__device__ __forceinline__ float vmax(float a, float b) { float r; asm("v_max_f32_e32 %0, %1, %2" : "=v"(r) : "v"(a), "v"(b)); return r; }
__device__ __forceinline__ float vmin(float a, float b) { float r; asm("v_min_f32_e32 %0, %1, %2" : "=v"(r) : "v"(a), "v"(b)); return r; }
__device__ __forceinline__ float vmax3(float a, float b, float c) { float r; asm("v_max3_f32 %0, %1, %2, %3" : "=v"(r) : "v"(a), "v"(b), "v"(c)); return r; }

constexpr int AT_KP = 72, AT_VP = 96;
constexpr int AT_KS = 0, AT_KS_BYTES = 64 * AT_KP * 2;
constexpr int AT_VT = 2 * AT_KS_BYTES, AT_VT_BYTES = 64 * AT_VP * 2;
constexpr int AT_KM = AT_VT + 2 * AT_VT_BYTES;
constexpr int AT_MISC = AT_KM + 32 * AT_KP * 2;
constexpr float LOG2E = 1.4426950408889634f;

__device__ __forceinline__ unsigned mk_unit(int kind, int b, int x, int y) { return ((unsigned)kind << 30) | ((unsigned)b << 28) | ((unsigned)x << 8) | (unsigned)y; }
__device__ void build_unit_table(unsigned* tab, int i) {
    int n = 0; unsigned res = 0u;
#pragma unroll 1
    for (int c = 64; c >= 1; --c) {
        if (i >= n && i < n + 4) res = mk_unit(0, i - n, 0, c - 1);
        n += 4;
        if ((c & 3) == 0) { if (i >= n && i < n + 16) { const int j = i - n; res = mk_unit(2, j >> 2, j & 3, c / 4 - 1); } n += 16; }
    }
    if (i < 512) tab[i] = res;
}

template <int kind> __device__ __forceinline__ void attn_unit(int WV_, const bf16* P, const unsigned char* mask, const float* kmean, const float* sinks, bf16* ys,
                                unsigned char* lds, int b, int ux, int uy) {
    int tid_ = LTID(WV_); asm volatile("" : "+v"(tid_));
    const int tid = tid_, lane = tid & 63, wave = __builtin_amdgcn_readfirstlane(tid >> 6), r32 = lane & 31, hi = lane >> 5;
    bf16* s_km = (bf16*)(lds + AT_KM);
    const int skey = tid >> 3, sc = tid & 7;
    {
        const bf16* Pb = P + (size_t)b * S_ * NP;
        int q0w, qcol, kcol, vcol, ycol, kt_hi, kt_lo; float slope2 = 0.f, sink2 = 0.f;
        if (kind == 0) { const int head = wave >> 1; q0w = uy * 64 + (wave & 1) * 32; qcol = C_QA + head * 64; kcol = C_KA; vcol = C_VA; ycol = head * 64;
            slope2 = exp2f(-8.0f * (float)(3 * head + 1) / 12.0f) * LOG2E; kt_hi = uy; kt_lo = 0; }
        else if (kind == 1) { const int hq = ux * 2 + (wave >> 2); q0w = uy * 128 + (wave & 3) * 32; qcol = C_QB + hq * 64; kcol = C_KB + ux * 64; vcol = C_VB + ux * 64; ycol = 256 + hq * 64;
            slope2 = exp2f(-8.0f * (float)(3 * hq + 2) / 12.0f) * LOG2E; sink2 = sinks[hq] * LOG2E; kt_hi = 2 * uy + 1; kt_lo = (2 * uy - 2 > 0) ? 2 * uy - 2 : 0; }
        else if (kind == 2) { q0w = uy * 256 + wave * 32; qcol = C_QC + ux * 64; kcol = C_KC + ux * 64; vcol = C_VC + ux * 64; ycol = 512 + ux * 64;
            slope2 = exp2f(-8.0f * (float)(3 * ux + 3) / 12.0f) * LOG2E; kt_hi = 4 * uy + 3; kt_lo = 0; }
        else { q0w = uy * 256 + wave * 32; qcol = C_QD + ux * 64; kcol = C_KD + ux * 64; vcol = C_VD + ux * 64; ycol = 768 + ux * 64; kt_hi = 4 * uy + 3; kt_lo = 0; }
        const int qpos = q0w + r32;
        bf16x8_t qf[4];
        { const bf16* qp = Pb + (size_t)qpos * NP + qcol + 8 * hi;
#pragma unroll
          for (int ks = 0; ks < 4; ++ks) qf[ks] = *(const bf16x8_t*)(qp + 16 * ks); }
        {
            const float qs = (kind == 3) ? 0.125f : 0.125f * LOG2E;
            typedef unsigned u32x4_t __attribute__((ext_vector_type(4)));
#pragma unroll
            for (int ks = 0; ks < 4; ++ks) { u32x4_t w = __builtin_bit_cast(u32x4_t, qf[ks]);
#pragma unroll
                for (int i = 0; i < 4; ++i) w[i] = cvtpk(__uint_as_float(w[i] << 16) * qs, __uint_as_float(w[i] & 0xffff0000u) * qs);
                qf[ks] = __builtin_bit_cast(bf16x8_t, w); }
        }
        float sb[16];
#pragma unroll
        for (int r = 0; r < 16; ++r) sb[r] = slope2 * (float)((r & 3) + 8 * (r >> 2));
        unsigned bm = 0u;
        if (kind == 2) {
            const int own = uy;
            for (int e = tid; e < 32 * 64; e += NTHR) { const int row = e >> 6, d = e & 63; s_km[row * AT_KP + d] = (row < 16) ? (bf16)f2bf(kmean[((b * 4 + ux) * 16 + row) * 64 + d]) : (bf16)0; }
            __syncthreads();
            f32x16_t gacc;
#pragma unroll
            for (int r = 0; r < 16; ++r) gacc[r] = 0.f;
#pragma unroll
            for (int ks = 0; ks < 4; ++ks) { const bf16x8_t a = *(const bf16x8_t*)(s_km + r32 * AT_KP + 16 * ks + 8 * hi); gacc = __builtin_amdgcn_mfma_f32_32x32x16_bf16(a, qf[ks], gacc, 0, 0, 0); }
            float gt[16];
#pragma unroll
            for (int r = 0; r < 8; ++r) { const float mine = gacc[r], other = xlane32(mine); const int bi = crow(r, 0);
                gt[bi] = hi ? other : mine; gt[bi + 4] = hi ? mine : other; }
#pragma unroll
            for (int n = 0; n < 16; ++n) if (n >= own) gt[n] = -INFINITY;
#pragma unroll
            for (int rep = 0; rep < 3; ++rep) {
                float mx = -INFINITY;
#pragma unroll
                for (int n = 0; n < 16; ++n) mx = fmaxf(mx, gt[n]);
                bool done = !(mx > -INFINITY);
#pragma unroll
                for (int n = 0; n < 16; ++n) { const bool hit = !done && gt[n] == mx; if (hit) { bm |= 1u << n; gt[n] = -INFINITY; done = true; } }
            }
        }
        f32x16_t o0, o1;
#pragma unroll
        for (int r = 0; r < 16; ++r) { o0[r] = 0.f; o1[r] = 0.f; }
        float m_run = -INFINITY, l_run = 0.f, carry = 0.f;
        const bf16* kg = Pb + (size_t)skey * NP + kcol + sc * 8;
        const bf16* vg = Pb + (size_t)skey * NP + vcol + sc * 8;
        uint4 rk = *(const uint4*)(kg + (size_t)kt_hi * 64 * NP), rv = *(const uint4*)(vg + (size_t)kt_hi * 64 * NP);
        int buf = 0;
        { bf16* ks_ = (bf16*)(lds + AT_KS); bf16* vt_ = (bf16*)(lds + AT_VT);
          *(uint4*)(ks_ + skey * AT_KP + sc * 8) = rk;
          *(uint4*)(vt_ + skey * AT_VP + sc * 8) = rv; }
        __syncthreads();
        bool wave_done = false;
        uint2 mw_next = make_uint2(0u, 0u);
        if (kind == 0) mw_next = *(const uint2*)(mask + (size_t)(b * S_ + qpos) * 512 + kt_hi * 8);
        for (int kt = kt_hi; kt >= kt_lo; --kt) {
            const bool more = kt > kt_lo;
            const uint2 mw = mw_next;
            if (kind == 0 && more) mw_next = *(const uint2*)(mask + (size_t)(b * S_ + qpos) * 512 + (kt - 1) * 8);
            if (more) { rk = *(const uint4*)(kg + (size_t)(kt - 1) * 64 * NP); rv = *(const uint4*)(vg + (size_t)(kt - 1) * 64 * NP); }
            const bf16* ks_ = (const bf16*)(lds + AT_KS + buf * AT_KS_BYTES);
            const bf16* vt_ = (const bf16*)(lds + AT_VT + buf * AT_VT_BYTES);
            bool active = (kt * 64 <= q0w + 31) && !wave_done;
            if (kind == 1) active = active && (kt * 64 + 63 >= q0w - 127);
            if (active) {
                const int kbase = kt * 64 + 4 * hi;
                f32x16_t p0, p1;
                if (kind != 3) {
                    const float cb = slope2 * (float)(kbase - qpos), cb1 = cb + 32.0f * slope2;
#pragma unroll
                    for (int r = 0; r < 16; ++r) { p0[r] = cb + sb[r]; p1[r] = cb1 + sb[r]; }
                } else {
#pragma unroll
                    for (int r = 0; r < 16; ++r) { p0[r] = 0.f; p1[r] = 0.f; }
                }
#pragma unroll
                for (int ks = 0; ks < 4; ++ks) {
                    const bf16x8_t a0 = *(const bf16x8_t*)(ks_ + r32 * AT_KP + 16 * ks + 8 * hi);
                    const bf16x8_t a1 = *(const bf16x8_t*)(ks_ + (32 + r32) * AT_KP + 16 * ks + 8 * hi);
                    p0 = __builtin_amdgcn_mfma_f32_32x32x16_bf16(a0, qf[ks], p0, 0, 0, 0);
                    p1 = __builtin_amdgcn_mfma_f32_32x32x16_bf16(a1, qf[ks], p1, 0, 0, 0);
                }
                if (kind != 3) {
                    float mx = -INFINITY;
                    if (kind == 0) {
                        const unsigned w0 = mw.x >> (4 * hi), w1 = mw.y >> (4 * hi);
#pragma unroll
                        for (int r = 0; r < 16; ++r) { const int off = (r & 3) + 8 * (r >> 2);
                            p0[r] = (w0 & (1u << off)) ? p0[r] : -INFINITY; p1[r] = (w1 & (1u << off)) ? p1[r] : -INFINITY; mx = vmax3(mx, p0[r], p1[r]); }
                    } else if (kind == 1) {
                        const int rel = qpos - kbase;
#pragma unroll
                        for (int r = 0; r < 16; ++r) { const int off = (r & 3) + 8 * (r >> 2);
                            p0[r] = ((unsigned)(rel - off) < 128u) ? p0[r] : -INFINITY; p1[r] = ((unsigned)(rel - off - 32) < 128u) ? p1[r] : -INFINITY; mx = vmax3(mx, p0[r], p1[r]); }
                    } else {
                        if ((kt >> 2) == uy) {
                            const int rel = qpos - kbase;
#pragma unroll
                            for (int r = 0; r < 16; ++r) { const int off = (r & 3) + 8 * (r >> 2);
                                p0[r] = (off <= rel) ? p0[r] : -INFINITY; p1[r] = (off + 32 <= rel) ? p1[r] : -INFINITY; mx = vmax3(mx, p0[r], p1[r]); }
                        } else {
                            const bool tile_ok = ((bm >> (kt >> 2)) & 1u) != 0u;
#pragma unroll
                            for (int r = 0; r < 16; ++r) { p0[r] = tile_ok ? p0[r] : -INFINITY; p1[r] = tile_ok ? p1[r] : -INFINITY; mx = vmax3(mx, p0[r], p1[r]); }
                        }
                    }
                    mx = vmax(mx, xlane32(mx));
                    const float m_new = vmax(m_run, mx);
                    const float m_safe = (m_new == -INFINITY) ? 0.f : m_new;
                    p0 = p0 - m_safe; p1 = p1 - m_safe;
#pragma unroll
                    for (int r = 0; r < 16; ++r) { p0[r] = __builtin_amdgcn_exp2f(p0[r]); p1[r] = __builtin_amdgcn_exp2f(p1[r]); }
                    float ls;
                    { typedef float f32x8_t __attribute__((ext_vector_type(8))); typedef float f32x4v_t __attribute__((ext_vector_type(4)));
                      const f32x16_t t16 = p0 + p1; const f32x8_t t8 = t16.lo + t16.hi; const f32x4v_t t4 = t8.lo + t8.hi; const f32x2_t t2 = t4.lo + t4.hi; ls = t2.x + t2.y; }
                    if (__any(m_new > m_run)) {
                        const float alpha = __builtin_amdgcn_exp2f(m_run - m_safe);
                        l_run *= alpha;
                        o0 = o0 * alpha; o1 = o1 * alpha;
                    }
                    l_run += ls; m_run = m_new;
                } else {
                    float run = carry;
#define SB_HALF(PX, KOFF) do { \
                    float lk[16]; \
                    _Pragma("unroll") for (int r = 0; r < 16; ++r) { \
                        const int off = (r & 3) + 8 * (r >> 2); \
                        const bool v = (kbase + off + (KOFF)) < qpos; \
                        const float z = PX[r]; \
                        const float t = 0.6931471805599453f * __builtin_amdgcn_logf(1.0f + __builtin_amdgcn_exp2f(-LOG2E * fabsf(z))); \
                        lk[r] = v ? (fminf(-z, 0.f) - t) : 0.f; \
                        PX[r] = v ? (fminf(z, 0.f) - t) : -INFINITY; } \
                    _Pragma("unroll") for (int g = 3; g >= 0; --g) { \
                        const float G = (lk[4 * g] + lk[4 * g + 1]) + (lk[4 * g + 2] + lk[4 * g + 3]); \
                        const float PG = xlane32(G); \
                        float la = run + (hi ? 0.f : PG); \
                        run += G + PG; \
                        PX[4 * g + 3] += la; la += lk[4 * g + 3]; PX[4 * g + 2] += la; la += lk[4 * g + 2]; PX[4 * g + 1] += la; la += lk[4 * g + 1]; PX[4 * g] += la; } \
                    _Pragma("unroll") for (int r = 0; r < 16; ++r) PX[r] = __builtin_amdgcn_exp2f(LOG2E * PX[r]); } while (0)
                    SB_HALF(p1, 32);
                    SB_HALF(p0, 0);
#undef SB_HALF
                    carry = run;
                }
                unsigned pw[16];
#pragma unroll
                for (int j = 0; j < 8; ++j) { pw[j] = cvtpk(p0[2 * j], p0[2 * j + 1]); pw[8 + j] = cvtpk(p1[2 * j], p1[2 * j + 1]); }
#pragma unroll
                for (int s = 0; s < 4; ++s) {
                    bf16x8_t pb; { const unsigned* q = pw + 4 * s; typedef unsigned u32x4_t __attribute__((ext_vector_type(4))); u32x4_t t4 = {q[0], q[1], q[2], q[3]}; pb = __builtin_bit_cast(bf16x8_t, t4); }
#pragma unroll
                    for (int dt = 0; dt < 2; ++dt) {
                        typedef short s16x4_t __attribute__((ext_vector_type(4)));
                        typedef __attribute__((address_space(3))) s16x4_t lds_s16x4;
                        const int gi_ = lane & 15;
                        const bf16* vp = vt_ + (16 * s + 4 * hi + (gi_ >> 2)) * AT_VP + 32 * dt + 16 * ((lane >> 4) & 1) + 4 * (gi_ & 3);
                        const s16x4_t lo = __builtin_amdgcn_ds_read_tr16_b64_v4i16((lds_s16x4*)vp), hi4 = __builtin_amdgcn_ds_read_tr16_b64_v4i16((lds_s16x4*)(vp + 8 * AT_VP));
                        const bf16x8_t va = {lo[0], lo[1], lo[2], lo[3], hi4[0], hi4[1], hi4[2], hi4[3]};
                        if (dt == 0) o0 = __builtin_amdgcn_mfma_f32_32x32x16_bf16(va, pb, o0, 0, 0, 0);
                        else         o1 = __builtin_amdgcn_mfma_f32_32x32x16_bf16(va, pb, o1, 0, 0, 0);
                    }
                }
            }
            if (kind == 3) {
                const float cm = carry;
                if (__all(cm < -110.0f) || !(kt * 64 <= q0w + 31) ) { if (__all(cm < -110.0f)) wave_done = true; }
            }
            if (more) {
                bf16* ksn = (bf16*)(lds + AT_KS + (buf ^ 1) * AT_KS_BYTES); bf16* vtn = (bf16*)(lds + AT_VT + (buf ^ 1) * AT_VT_BYTES);
                *(uint4*)(ksn + skey * AT_KP + sc * 8) = rk;
                *(uint4*)(vtn + skey * AT_VP + sc * 8) = rv;
            }
            if (kind == 3) { if (__syncthreads_and(wave_done ? 1 : 0)) break; }
            else __syncthreads();
            buf ^= 1;
        }
        float inv;
        if (kind == 3) inv = 1.0f;
        else {
            float lt = l_run + xlane32(l_run);
            if (kind == 1) { const float mf = fmaxf(m_run, sink2); const float sc2 = exp2f(m_run - mf); lt = lt * sc2 + exp2f(sink2 - mf); inv = sc2 / lt; }
            else inv = 1.0f / lt;
        }
        bf16* yp = ys + (size_t)(b * S_ + qpos) * 1024 + ycol + 4 * hi;
#pragma unroll
        for (int g = 0; g < 4; ++g) {
            *(uint2*)(yp + 8 * g) = make_uint2(cvtpk(o0[4 * g] * inv, o0[4 * g + 1] * inv), cvtpk(o0[4 * g + 2] * inv, o0[4 * g + 3] * inv));
            *(uint2*)(yp + 32 + 8 * g) = make_uint2(cvtpk(o1[4 * g] * inv, o1[4 * g + 1] * inv), cvtpk(o1[4 * g + 2] * inv, o1[4 * g + 3] * inv));
        }
    }
}
__device__ void attn_fast_phase(int WV_, const bf16* P, const unsigned char* mask, const float* kmean, const float* sinks, bf16* ys,
                                const unsigned* utab, unsigned* counter, unsigned char* lds) {
    volatile unsigned* s_unit = (volatile unsigned*)(lds + AT_MISC);
    for (;;) {
        __syncthreads();
        if (LTID(WV_) == 0) s_unit[0] = atomicAdd(counter, 1u);
        __syncthreads();
        const unsigned ui = s_unit[0];
        if (ui >= 512u) break;
        const unsigned ue = utab[ui];
        const int kind = (int)(ue >> 30), b = (int)((ue >> 28) & 3u), ux = (int)((ue >> 8) & 255u), uy = (int)(ue & 255u);
        if (kind == 0) attn_unit<0>(WV_, P, mask, kmean, sinks, ys, lds, b, ux, uy);
        else attn_unit<2>(WV_, P, mask, kmean, sinks, ys, lds, b, ux, uy);
    }
    for (int u = LBID(); u < 256; u += LGRID()) { __syncthreads(); attn_unit<3>(WV_, P, mask, kmean, sinks, ys, lds, u >> 6, (u >> 4) & 3, u & 15); }
    for (int u = LBID(); u < 256; u += LGRID()) { __syncthreads(); attn_unit<1>(WV_, P, mask, kmean, sinks, ys, lds, u >> 6, (u >> 5) & 1, u & 31); }
}

constexpr float U_SCALE = 128.0f, V_SCALE = 48.0f;
constexpr int ROW6 = 1536;
typedef float v32f_t __attribute__((ext_vector_type(32)));
typedef unsigned v6u_t __attribute__((ext_vector_type(6)));
typedef unsigned u32x4a8_t __attribute__((ext_vector_type(4), aligned(8)));
__device__ __forceinline__ float rdlane_f(float v, int l) { return __builtin_bit_cast(float, __builtin_amdgcn_readlane(__builtin_bit_cast(int, v), l)); }
__device__ __forceinline__ unsigned q_e2m3(float v) {
    const float a = fminf(fabsf(v), 7.5f);
    unsigned code;
    if (a < 1.0f) code = (unsigned)rintf(a * 8.0f);
    else if (a < 2.0f) code = 8u + (unsigned)rintf((a - 1.0f) * 8.0f);
    else if (a < 4.0f) code = 16u + (unsigned)rintf((a - 2.0f) * 4.0f);
    else code = 24u + (unsigned)rintf((a - 4.0f) * 2.0f);
    return code | (v < 0.f ? 32u : 0u);
}
__device__ __forceinline__ void cvt_chunk6(const float4 (&a)[8], float sc, unsigned (&w)[6]) {
#pragma unroll
    for (int d = 0; d < 6; ++d) w[d] = 0u;
#pragma unroll
    for (int q4 = 0; q4 < 8; ++q4) {
        const float av[4] = {a[q4].x, a[q4].y, a[q4].z, a[q4].w};
#pragma unroll
        for (int e = 0; e < 4; ++e) { const int idx = q4 * 4 + e, bit = 6 * idx, d = bit >> 5, sft = bit & 31; const unsigned code = q_e2m3(av[e] * sc);
            w[d] |= code << sft; if (sft > 26) w[d + 1] |= code >> (32 - sft); }
    }
}
__device__ void convert_tables(int WV_, const Params& p) {
    const size_t nchunk = (size_t)DEPTH_ * 16384 * 2 * 32;
    const size_t stride = (size_t)LGRID() * NTHR;
    for (size_t i = (size_t)LBID() * NTHR + LTID(WV_); i < nchunk; i += 2 * stride) {
        const size_t i2 = i + stride; const bool has2 = i2 < nchunk; const size_t j2 = has2 ? i2 : i;
        const int c0 = (int)(i & 31), uv0 = (int)((i >> 5) & 1); const size_t le0 = i >> 6;
        const int c1 = (int)(j2 & 31), uv1 = (int)((j2 >> 5) & 1); const size_t le1 = j2 >> 6;
        const float* src0 = (uv0 ? p.in[10] : p.in[9]) + le0 * 1024 + c0 * 32;
        const float* src1 = (uv1 ? p.in[10] : p.in[9]) + le1 * 1024 + c1 * 32;
        float4 a0[8], a1[8];
#pragma unroll
        for (int q4 = 0; q4 < 8; ++q4) a0[q4] = ((const float4*)src0)[q4];
#pragma unroll
        for (int q4 = 0; q4 < 8; ++q4) a1[q4] = ((const float4*)src1)[q4];
        unsigned w0[6], w1[6];
        cvt_chunk6(a0, uv0 ? V_SCALE : U_SCALE, w0);
        cvt_chunk6(a1, uv1 ? V_SCALE : U_SCALE, w1);
        uint2* dst0 = (uint2*)(p.ws + WS_UV + le0 * ROW6 + uv0 * 768 + c0 * 24);
        dst0[0] = make_uint2(w0[0], w0[1]); dst0[1] = make_uint2(w0[2], w0[3]); dst0[2] = make_uint2(w0[4], w0[5]);
        if (has2) { uint2* dst1 = (uint2*)(p.ws + WS_UV + le1 * ROW6 + uv1 * 768 + c1 * 24);
            dst1[0] = make_uint2(w1[0], w1[1]); dst1[1] = make_uint2(w1[2], w1[3]); dst1[2] = make_uint2(w1[4], w1[5]); }
    }
}
__device__ __forceinline__ v6u_t ld_pk6(const unsigned char* ptr) {
    const uint2 a = ((const uint2*)ptr)[0], b = ((const uint2*)ptr)[1], c = ((const uint2*)ptr)[2];
    const v6u_t pk = {a.x, a.y, b.x, b.y, c.x, c.y};
    return pk;
}
__device__ void peer_fast_phase(int WV_, float* h, bf16* hb, const int* eid, const float* gate, const unsigned char* uv, const float* g1, const float* b1, const float* g, const float* bb, unsigned char* lds) {
    const int tid = LTID(WV_), lane = tid & 63, wave = tid >> 6, l32 = lane & 31, hi = lane >> 5;
    float* pl = (float*)(lds + wave * 16384);
    unsigned char* raw = lds + wave * 16384 + 4096 + lane * 24;
    for (int t = LBID() * NWAVE + wave; t < T_; t += LGRID() * NWAVE) {
        float* hr = h + (size_t)t * 1024 + l32 * 32;
        float x[32], acc[32];
#pragma unroll
        for (int q4 = 0; q4 < 4; ++q4) { const uint4 a = ((const uint4*)(hb + (size_t)t * 1024 + l32 * 32))[q4];
            x[8 * q4] = __uint_as_float(a.x << 16); x[8 * q4 + 1] = __uint_as_float(a.x & 0xffff0000u); x[8 * q4 + 2] = __uint_as_float(a.y << 16); x[8 * q4 + 3] = __uint_as_float(a.y & 0xffff0000u);
            x[8 * q4 + 4] = __uint_as_float(a.z << 16); x[8 * q4 + 5] = __uint_as_float(a.z & 0xffff0000u); x[8 * q4 + 6] = __uint_as_float(a.w << 16); x[8 * q4 + 7] = __uint_as_float(a.w & 0xffff0000u); }
        {
            float s = 0.f;
#pragma unroll
            for (int i = 0; i < 32; ++i) s += x[i];
#pragma unroll
            for (int o = 16; o > 0; o >>= 1) s += __shfl_xor(s, o);
            const float mean = s * (1.0f / 1024.0f);
            float s2 = 0.f;
#pragma unroll
            for (int i = 0; i < 32; ++i) { x[i] -= mean; s2 += x[i] * x[i]; }
#pragma unroll
            for (int o = 16; o > 0; o >>= 1) s2 += __shfl_xor(s2, o);
            const float rstd = 1.0f / sqrtf(s2 * (1.0f / 1024.0f) + LN_EPS);
#pragma unroll
            for (int q4 = 0; q4 < 8; ++q4) { const float4 gg = ((const float4*)(g1 + l32 * 32))[q4], cc = ((const float4*)(b1 + l32 * 32))[q4];
                x[4 * q4] = x[4 * q4] * rstd * gg.x + cc.x; x[4 * q4 + 1] = x[4 * q4 + 1] * rstd * gg.y + cc.y; x[4 * q4 + 2] = x[4 * q4 + 2] * rstd * gg.z + cc.z; x[4 * q4 + 3] = x[4 * q4 + 3] * rstd * gg.w + cc.w; }
        }
#pragma unroll
        for (int i = 0; i < 32; ++i) acc[i] = 0.f;
#pragma unroll 1
        for (int batch = 0; batch < 4; ++batch) {
            const int my_eid = eid[(size_t)t * 128 + batch * 32 + l32];
            const float my_gate = gate[(size_t)t * 128 + batch * 32 + l32];
#pragma unroll 1
            for (int grp = 0; grp < 2; ++grp) {
                { u32x4a8_t pa[8]; uint2 pc[8];
#pragma unroll
                  for (int i = 0; i < 8; ++i) { const int id = __shfl(my_eid, 2 * (grp * 8 + i) + hi); const unsigned char* rp = uv + (size_t)id * ROW6 + l32 * 24; pa[i] = *(const u32x4a8_t*)rp; pc[i] = *(const uint2*)(rp + 16); }
#pragma unroll
                  for (int i = 0; i < 8; ++i) { uint2* wp = (uint2*)(raw + i * 1536); wp[0] = make_uint2(pa[i].x, pa[i].y); wp[1] = make_uint2(pa[i].z, pa[i].w); wp[2] = pc[i]; } }
#pragma unroll 1
                for (int i = 0; i < 8; ++i) {
                    const uint2* rp = (const uint2*)(raw + i * 1536); const uint2 a = rp[0], b = rp[1], c = rp[2];
                    const v6u_t pk6 = {a.x, a.y, b.x, b.y, c.x, c.y}; const v32f_t f = __builtin_amdgcn_cvt_scalef32_pk32_f32_fp6(pk6, 1.0f);
                    f32x2_t dv0 = {0.f, 0.f}, dv1 = {0.f, 0.f};
#pragma unroll
                    for (int j = 0; j < 8; ++j) { const f32x2_t fa = {f[2 * j], f[2 * j + 1]}, fb = {f[16 + 2 * j], f[17 + 2 * j]}, xa = {x[2 * j], x[2 * j + 1]}, xb = {x[16 + 2 * j], x[17 + 2 * j]};
                        dv0 = fa * xa + dv0; dv1 = fb * xb + dv1; }
                    pl[(2 * (grp * 8 + i) + hi) * 32 + l32] = (dv0.x + dv0.y) + (dv1.x + dv1.y);
                }
            }
            float d;
            { const float4* pr = (const float4*)(pl + l32 * 32); float4 s4 = pr[0];
#pragma unroll
              for (int i = 1; i < 8; ++i) { const float4 v = pr[i]; s4.x += v.x; s4.y += v.y; s4.z += v.z; s4.w += v.w; }
              d = ((s4.x + s4.y) + (s4.z + s4.w)) * (1.0f / U_SCALE); }
            const float hv = 0.5f * d * (1.0f + erff(d * 0.70710678118654752f)) * my_gate * (1.0f / V_SCALE);
#pragma unroll 1
            for (int grp = 0; grp < 2; ++grp) {
                { u32x4a8_t pa[8]; uint2 pc[8];
#pragma unroll
                  for (int i = 0; i < 8; ++i) { const int id = __shfl(my_eid, 2 * (grp * 8 + i) + hi); const unsigned char* rp = uv + (size_t)id * ROW6 + 768 + l32 * 24; pa[i] = *(const u32x4a8_t*)rp; pc[i] = *(const uint2*)(rp + 16); }
#pragma unroll
                  for (int i = 0; i < 8; ++i) { uint2* wp = (uint2*)(raw + i * 1536); wp[0] = make_uint2(pa[i].x, pa[i].y); wp[1] = make_uint2(pa[i].z, pa[i].w); wp[2] = pc[i]; } }
#pragma unroll 1
                for (int i = 0; i < 8; ++i) {
                    const float c = __shfl(hv, 2 * (grp * 8 + i) + hi);
                    const uint2* rp = (const uint2*)(raw + i * 1536); const uint2 a = rp[0], b = rp[1], cc = rp[2];
                    const v6u_t pk6 = {a.x, a.y, b.x, b.y, cc.x, cc.y}; const v32f_t f = __builtin_amdgcn_cvt_scalef32_pk32_f32_fp6(pk6, 1.0f);
                    const f32x2_t c2 = {c, c};
#pragma unroll
                    for (int j = 0; j < 16; ++j) { const f32x2_t fj = {f[2 * j], f[2 * j + 1]}; f32x2_t aj = {acc[2 * j], acc[2 * j + 1]}; aj = fj * c2 + aj; acc[2 * j] = aj.x; acc[2 * j + 1] = aj.y; }
                }
            }
        }
        float y[32], s = 0.f;
#pragma unroll
        for (int i = 0; i < 32; ++i) { acc[i] += __shfl_xor(acc[i], 32); y[i] = ALPHA * x[i] + acc[i]; s += y[i]; }
#pragma unroll
        for (int o = 16; o > 0; o >>= 1) s += __shfl_xor(s, o);
        const float mean = s * (1.0f / 1024.0f);
        float s2 = 0.f;
#pragma unroll
        for (int i = 0; i < 32; ++i) { y[i] -= mean; s2 += y[i] * y[i]; }
#pragma unroll
        for (int o = 16; o > 0; o >>= 1) s2 += __shfl_xor(s2, o);
        const float rstd = 1.0f / sqrtf(s2 * (1.0f / 1024.0f) + LN_EPS);
        float o[16];
#pragma unroll
        for (int q4 = 0; q4 < 4; ++q4) {
            const float4 gg = ((const float4*)(g + l32 * 32 + hi * 16))[q4], cc = ((const float4*)(bb + l32 * 32 + hi * 16))[q4];
            float ya[4], yb2[4];
#pragma unroll
            for (int e = 0; e < 4; ++e) { ya[e] = y[4 * q4 + e]; yb2[e] = y[16 + 4 * q4 + e]; }
            asm volatile("" : "+v"(ya[0]), "+v"(ya[1]), "+v"(ya[2]), "+v"(ya[3]), "+v"(yb2[0]), "+v"(yb2[1]), "+v"(yb2[2]), "+v"(yb2[3]));
            const float y0 = hi ? yb2[0] : ya[0], y1 = hi ? yb2[1] : ya[1], y2 = hi ? yb2[2] : ya[2], y3 = hi ? yb2[3] : ya[3];
            o[4 * q4] = y0 * rstd * gg.x + cc.x; o[4 * q4 + 1] = y1 * rstd * gg.y + cc.y; o[4 * q4 + 2] = y2 * rstd * gg.z + cc.z; o[4 * q4 + 3] = y3 * rstd * gg.w + cc.w;
            if (h) ((float4*)(hr + hi * 16))[q4] = make_float4(o[4 * q4], o[4 * q4 + 1], o[4 * q4 + 2], o[4 * q4 + 3]);
        }
        uint4* hbp = (uint4*)(hb + (size_t)t * 1024 + l32 * 32 + hi * 16);
        hbp[0] = make_uint4(pk2(o[0], o[1]), pk2(o[2], o[3]), pk2(o[4], o[5]), pk2(o[6], o[7]));
        hbp[1] = make_uint4(pk2(o[8], o[9]), pk2(o[10], o[11]), pk2(o[12], o[13]), pk2(o[14], o[15]));
    }
}

__device__ __forceinline__ float pack_pl(float v, unsigned pl) { return __uint_as_float((__float_as_uint(v) & ~127u) | pl); }
__device__ __forceinline__ void ins16(float (&s)[16], float x) {
#pragma unroll
    for (int k = 15; k >= 1; --k) s[k] = __builtin_amdgcn_fmed3f(s[k - 1], x, s[k]);
    s[0] = vmax(s[0], x);
}
template <int D> __device__ __forceinline__ void bitonic_stage(float (&c)[16]) {
#pragma unroll
    for (int i = 0; i < 16; ++i) if ((i & D) == 0) { const float a = vmax(c[i], c[i + D]), b = vmin(c[i], c[i + D]); c[i] = a; c[i + D] = b; }
}
__device__ __forceinline__ int decode_key(unsigned pl) { return (int)(32u * ((pl >> 4) & 3u) + (pl & 3u) + 8u * ((pl >> 2) & 3u) + 4u * ((pl >> 6) & 1u)); }
__device__ void route_fast_phase(int WV_, const bf16* qb, const bf16* skb  , int* eid, float* gate, unsigned char* lds, int pm = -1, int pn = 0) {
    const int tid = LTID(WV_), lane = tid & 63, wave = tid >> 6, r32 = lane & 31, hi = lane >> 5;
    unsigned* lidx = (unsigned*)lds + wave * (64 * 33) + lane * 33;
    const int u_first = (pm >= 0) ? 0 : LBID() * NWAVE + wave, u_end = (pm >= 0) ? 2 : (T_ / 32) * 8, u_step = (pm >= 0) ? 1 : LGRID() * NWAVE;
    for (int unit = u_first; unit < u_end; unit += u_step) {
        const int h = (pm >= 0) ? 2 * pn + unit : (unit & 7), t = ((pm >= 0) ? 8 * pm + wave : (unit >> 3)) * 32 + r32;
        float sl[2][16];
#pragma unroll
        for (int p = 0; p < 2; ++p) {
            bf16x8_t qf[4];
            { const bf16* qp = qb + (size_t)t * 1024 + h * 128 + p * 64 + 8 * hi;
#pragma unroll
              for (int ks = 0; ks < 4; ++ks) qf[ks] = *(const bf16x8_t*)(qp + 16 * ks); }
            float s[16];
#pragma unroll
            for (int k = 0; k < 16; ++k) s[k] = -INFINITY;
            const bf16* skp = skb + ((size_t)(h * 2 + p) * 128 + r32) * 64 + 8 * hi;
#pragma unroll
            for (int kt = 0; kt < 4; ++kt) {
                f32x16_t acc;
#pragma unroll
                for (int r = 0; r < 16; ++r) acc[r] = 0.f;
#pragma unroll
                for (int ks = 0; ks < 4; ++ks) { const bf16x8_t a = *(const bf16x8_t*)(skp + (size_t)kt * 32 * 64 + 16 * ks); acc = __builtin_amdgcn_mfma_f32_32x32x16_bf16(a, qf[ks], acc, 0, 0, 0); }
#pragma unroll
                for (int r = 0; r < 16; ++r) ins16(s, pack_pl(acc[r], (unsigned)(kt * 16 + r)));
            }
            const unsigned hb = (unsigned)hi << 6;
#pragma unroll
            for (int k = 0; k < 16; ++k) s[k] = __uint_as_float(__float_as_uint(s[k]) | hb);
            float c[16];
#pragma unroll
            for (int k = 0; k < 16; ++k) c[k] = vmax(s[k], __shfl_xor(s[15 - k], 32));
            bitonic_stage<8>(c); bitonic_stage<4>(c); bitonic_stage<2>(c); bitonic_stage<1>(c);
#pragma unroll
            for (int k = 0; k < 16; ++k) { sl[p][k] = c[k]; lidx[p * 16 + k] = (unsigned)decode_key(__float_as_uint(c[k]) & 127u); }
        }
        float w[16];
#pragma unroll
        for (int k = 0; k < 16; ++k) w[k] = -INFINITY;
#pragma unroll
        for (int i = 0; i < 16; ++i)
#pragma unroll
            for (int j = 0; j < 16; ++j)
                if ((i + 1) * (j + 1) <= 16) { const float v = sl[0][i] + sl[1][j]; ins16(w, __uint_as_float((__float_as_uint(v) & ~255u) | (unsigned)(i * 16 + j))); }
        float e[16], sum = 0.f;
#pragma unroll
        for (int k = 0; k < 16; ++k) { e[k] = expf(w[k] - w[0]); sum += e[k]; }
        const float inv = 1.0f / sum;
        int ide[8]; float gte[8];
#pragma unroll
        for (int k = 0; k < 8; ++k) {
            float wa = w[k], wb = w[8 + k], ea = e[k], eb = e[8 + k];
            asm volatile("" : "+v"(wa), "+v"(wb), "+v"(ea), "+v"(eb));
            const float wv = hi ? wb : wa;
            const unsigned pl = __float_as_uint(wv) & 255u;
            ide[k] = (int)(lidx[pl >> 4] * 128u + lidx[16 + (pl & 15u)]);
            gte[k] = (hi ? eb : ea) * inv;
        }
        int* ep = eid + (size_t)t * 128 + h * 16 + hi * 8; float* gp = gate + (size_t)t * 128 + h * 16 + hi * 8;
        *(int4*)ep = make_int4(ide[0], ide[1], ide[2], ide[3]); *(int4*)(ep + 4) = make_int4(ide[4], ide[5], ide[6], ide[7]);
        *(float4*)gp = make_float4(gte[0], gte[1], gte[2], gte[3]); *(float4*)(gp + 4) = make_float4(gte[4], gte[5], gte[6], gte[7]);
    }
}

typedef float f32x4_t __attribute__((ext_vector_type(4)));
typedef __bf16 bf16x2v __attribute__((ext_vector_type(2)));
__device__ __forceinline__ float dot2bf(unsigned a, unsigned b, float c) { return __builtin_amdgcn_fdot2_f32_bf16(__builtin_bit_cast(bf16x2v, a), __builtin_bit_cast(bf16x2v, b), c, false); }
__device__ __forceinline__ void cnt_gt(int& cnt, unsigned a, unsigned b) { asm("v_cmp_gt_u32_e32 vcc, %1, %2\n\tv_addc_co_u32_e32 %0, vcc, 0, %0, vcc" : "+v"(cnt) : "v"(a), "v"(b) : "vcc"); }
__device__ __forceinline__ void cnt_eq(int& cnt, unsigned a, unsigned b) { asm("v_cmp_eq_u32_e32 vcc, %1, %2\n\tv_addc_co_u32_e32 %0, vcc, 0, %0, vcc" : "+v"(cnt) : "v"(a), "v"(b) : "vcc"); }
__device__ __forceinline__ unsigned flag_gt(unsigned a, unsigned b) { unsigned r; asm("v_cmp_gt_u32_e32 vcc, %1, %2\n\tv_cndmask_b32_e64 %0, 0, 1, vcc" : "=v"(r) : "v"(a), "v"(b) : "vcc"); return r; }
__device__ __forceinline__ unsigned flag_eq(unsigned a, unsigned b) { unsigned r; asm("v_cmp_eq_u32_e32 vcc, %1, %2\n\tv_cndmask_b32_e64 %0, 0, 1, vcc" : "=v"(r) : "v"(a), "v"(b) : "vcc"); return r; }
__device__ __forceinline__ void cnt_ge(int& cnt, unsigned key, unsigned cand) { asm("v_cmp_ge_u32_e32 vcc, %1, %2\n\tv_addc_co_u32_e32 %0, vcc, 0, %0, vcc" : "+v"(cnt) : "v"(key), "v"(cand) : "vcc"); }

template <int CTRL, int RM> __device__ __forceinline__ unsigned dpp0(unsigned v) { return (unsigned)__builtin_amdgcn_update_dpp(0, (int)v, CTRL, RM, 0xf, false); }
template <int CTRL> __device__ __forceinline__ unsigned dppf(unsigned v) { return (unsigned)__builtin_amdgcn_update_dpp(-1, (int)v, CTRL, 0xf, 0xf, false); }
__device__ __forceinline__ unsigned wave_sum_u_dpp(unsigned v) {
    v += dpp0<0xB1, 0xf>(v); v += dpp0<0x4E, 0xf>(v); v += dpp0<0x141, 0xf>(v); v += dpp0<0x140, 0xf>(v);
    return (unsigned)__builtin_amdgcn_readlane((int)v, 0) + (unsigned)__builtin_amdgcn_readlane((int)v, 16) + (unsigned)__builtin_amdgcn_readlane((int)v, 32) + (unsigned)__builtin_amdgcn_readlane((int)v, 48);
}
__device__ __forceinline__ unsigned wave_min_u_dpp(unsigned v) {
    unsigned t;
    t = dppf<0xB1>(v); v = t < v ? t : v; t = dppf<0x4E>(v); v = t < v ? t : v; t = dppf<0x141>(v); v = t < v ? t : v; t = dppf<0x140>(v); v = t < v ? t : v;
    const unsigned a = (unsigned)__builtin_amdgcn_readlane((int)v, 0), b = (unsigned)__builtin_amdgcn_readlane((int)v, 16), c = (unsigned)__builtin_amdgcn_readlane((int)v, 32), d = (unsigned)__builtin_amdgcn_readlane((int)v, 48);
    const unsigned ab = a < b ? a : b, cd = c < d ? c : d; return ab < cd ? ab : cd;
}
__device__ __forceinline__ unsigned wave_incl_scan_u_dpp(unsigned v) {
    v += dpp0<0x111, 0xf>(v); v += dpp0<0x112, 0xf>(v); v += dpp0<0x114, 0xf>(v); v += dpp0<0x118, 0xf>(v);
    v += dpp0<0x142, 0xa>(v);
    v += dpp0<0x143, 0xc>(v);
    return v;
}
typedef __attribute__((address_space(3))) unsigned lds_u32;
template <int SHIFT> __device__ __forceinline__ unsigned radix_pass(const unsigned (&key)[64], unsigned pre, lds_u32* hist, int lane, int& need, int jlim, unsigned L) {
    typedef unsigned u32x4v __attribute__((ext_vector_type(4)));
    typedef __attribute__((address_space(3))) u32x4v lds_u32x4;
    const int fl = 63 - lane;
    { const u32x4v z4 = {0u, 0u, 0u, 0u};
#pragma unroll
      for (int i = 0; i < 8; ++i) ((lds_u32x4*)(hist + fl * 32))[i] = z4; }
    const unsigned hb = (unsigned)(size_t)hist + 4u * (unsigned)(lane & 7);
    const unsigned one = 1u;
    asm volatile("" ::: "memory");
#pragma unroll
    for (int j4 = 0; j4 < 16; ++j4) {
        if (4 * j4 <= jlim) {
            bool grp = true;
            if (SHIFT <= 8) {
                const bool any = ((key[4 * j4] >> (SHIFT + 8)) == pre) | ((key[4 * j4 + 1] >> (SHIFT + 8)) == pre) | ((key[4 * j4 + 2] >> (SHIFT + 8)) == pre) | ((key[4 * j4 + 3] >> (SHIFT + 8)) == pre);
                grp = __ballot(any) != 0ull;
            }
            if (grp) {
#pragma unroll
                for (int e = 0; e < 4; ++e) { const int j = 4 * j4 + e;
                    const unsigned addr = hb + (((key[j] >> SHIFT) & 255u) << 5);
                    unsigned long long sv;
                    if (SHIFT == 24) asm volatile("v_cmp_ge_u32_e32 vcc, %1, %2\n\ts_and_saveexec_b64 %0, vcc\n\tds_add_u32 %3, %4\n\ts_mov_b64 exec, %0" : "=&s"(sv) : "v"(key[j]), "v"(L), "v"(addr), "v"(one) : "vcc", "memory");
                    else { const unsigned t = key[j] >> ((SHIFT + 8) & 31);
                        asm volatile("v_cmp_eq_u32_e32 vcc, %1, %2\n\ts_and_saveexec_b64 %0, vcc\n\tds_add_u32 %3, %4\n\ts_mov_b64 exec, %0" : "=&s"(sv) : "v"(t), "v"(pre), "v"(addr), "v"(one) : "vcc", "memory"); }
                }
            }
        }
    }
    asm volatile("s_waitcnt lgkmcnt(0)" ::: "memory");
    unsigned dsum[4]; unsigned sumL = 0u;
#pragma unroll
    for (int i = 0; i < 4; ++i) { const u32x4v v0 = ((const lds_u32x4*)(hist + fl * 32))[2 * i], v1 = ((const lds_u32x4*)(hist + fl * 32))[2 * i + 1];
        dsum[i] = ((v0.x + v0.y) + (v0.z + v0.w)) + ((v1.x + v1.y) + (v1.z + v1.w)); sumL += dsum[i]; }
    const unsigned incl = wave_incl_scan_u_dpp(sumL);
    const unsigned above = incl - sumL;
    const bool own = (above < (unsigned)need) && ((unsigned)need <= above + sumL);
    const int owner = __ffsll((long long)__ballot(own)) - 1;
    unsigned acc = above; int sel = -1; unsigned cab = 0u;
#pragma unroll
    for (int i = 3; i >= 0; --i) { const unsigned c = dsum[i]; const bool hit = (sel < 0) && (acc + c >= (unsigned)need); cab = hit ? acc : cab; sel = hit ? i : sel; acc += c; }
    const int ow = owner < 0 ? 0 : owner;
    const unsigned digit = (unsigned)__builtin_amdgcn_readlane(sel, ow) + (unsigned)(4 * (63 - ow));
    need -= (int)__builtin_amdgcn_readlane((int)cab, ow);
    return digit;
}

__device__ __forceinline__ void idx_select(const unsigned (&key)[64], unsigned t3, int jlim, lds_u32* hist, int lane, uint2* mrow) {
        unsigned wlo = 0u, whi = 0u;
        unsigned L = wave_min_u_dpp(t3);
        L = L > 1u ? L : 1u;

        int need = 256;
        const unsigned d1 = radix_pass<24>(key, 0u, hist, lane, need, jlim, L);
        const unsigned d2 = radix_pass<16>(key, d1, hist, lane, need, jlim, L);
        const unsigned d3 = radix_pass<8>(key, (d1 << 8) | d2, hist, lane, need, jlim, L);
        const unsigned d4 = radix_pass<0>(key, (d1 << 16) | (d2 << 8) | d3, hist, lane, need, jlim, L);
        const unsigned prefix = (d1 << 24) | (d2 << 16) | (d3 << 8) | d4;

        int ceq = 0;
#pragma unroll
        for (int j = 0; j < 64; ++j) cnt_eq(ceq, key[j], prefix);
        ceq = (int)wave_sum_u_dpp((unsigned)ceq);
        int X = 4096;
        if (ceq != need) {
            int X0 = 0;
#pragma unroll 1
            for (int bit = 11; bit >= 0; --bit) {
                const int c = X0 | (1 << bit);
                int cnt = 0; const int crel = (c - lane + 63) >> 6;
#pragma unroll
                for (int j = 0; j < 64; ++j) cnt_eq(cnt, (key[j] ^ prefix) | ~(unsigned)((j - crel) >> 31), 0u);
                cnt = wave_sum_i(cnt);
                if (cnt < need) X0 = c;
            }
            X = X0 + 1;
        }
        const int xrel = (X - lane + 63) >> 6;
#pragma unroll
        for (int j4 = 0; j4 < 16; ++j4) {
            if (4 * j4 <= jlim) {
#pragma unroll
                for (int e = 0; e < 4; ++e) { const int j = 4 * j4 + e;
                    const bool sel = (key[j] > prefix) || (key[j] == prefix && j < xrel);
                    const unsigned long long bm = __ballot(sel);
                    asm("v_writelane_b32 %0, %1, %2" : "+v"(wlo) : "s"((unsigned)bm), "n"(j));
                    asm("v_writelane_b32 %0, %1, %2" : "+v"(whi) : "s"((unsigned)(bm >> 32)), "n"(j)); }
            }
        }
        mrow[lane] = make_uint2(wlo, whi);
}
#ifndef TS_SEL
#define TS_SEL 0
#endif
#define ITS_B() do { if (TS_SEL >= 20 && TS_SEL <= 25 && WV_ == 0 && LANEID() == 0) ((volatile __attribute__((address_space(3))) unsigned long long*)((__attribute__((address_space(3))) unsigned char*)lds + 147456 - 16 - 32))[0] = __builtin_amdgcn_s_memrealtime(); } while (0)
#define ITS_E(k) do { if ((k) == TS_SEL && WV_ == 0 && LANEID() == 0) { volatile __attribute__((address_space(3))) unsigned long long* w_ = (volatile __attribute__((address_space(3))) unsigned long long*)((__attribute__((address_space(3))) unsigned char*)lds + 147456 - 16 - 32); w_[1] += __builtin_amdgcn_s_memrealtime() - w_[0]; } } while (0)
__device__ void index_fast_phase(int WV_, const bf16* P, unsigned char* mask, float* kmean, float* scratch_all, unsigned* qctr, unsigned char* lds) {
    const int tid = LTID(WV_), lane = tid & 63, wave = tid >> 6, bid = LBID(), G = LGRID();
    float* s_part = (float*)lds;
    ITS_B();
    for (int k = bid; k < 256; k += G) {
        const int b = k >> 6, h = (k >> 4) & 3, blk = k & 15;
        const bf16* kp = P + (size_t)(b * S_ + blk * 256 + wave * 32) * NP + C_KC + h * 64 + lane;
        float a = 0.f;
#pragma unroll 8
        for (int j = 0; j < 32; ++j) a += bf2f(kp[(size_t)j * NP]);
        __syncthreads();
        s_part[wave * 64 + lane] = a;
        __syncthreads();
        if (tid < 64) { float s = 0.f;
#pragma unroll
            for (int w = 0; w < 8; ++w) s += s_part[w * 64 + tid];
            kmean[((b * 4 + h) * 16 + blk) * 64 + tid] = s * (1.0f / 256.0f); }
    }
    ITS_E(22);
    constexpr int IDX_CP = 512 + 4;
    constexpr int IDX_PITCH = 4096 + 32;
    float* scr = scratch_all + (size_t)bid * (16 * IDX_PITCH);
    const int lq = lane & 15, g4 = lane >> 4;
    for (int ui = bid; ui < 1024; ui += G) {
        const int b = ui >> 8, k = ui & 255, tile = (b & 1) ? 255 - k : k, q0 = tile * 16;
        const bf16* Pb = P + (size_t)b * S_ * NP;
        const int ntiles = tile + 1;
        int lane_o = LANEID(); asm volatile("" : "+v"(lane_o));
        const int lane = lane_o, lq = lane & 15, g4 = lane >> 4;
        const int wave = WV_;
        const int qA = q0 + 2 * wave, qB = qA + 1;
        uint2* mrowA = (uint2*)(mask + (size_t)(b * S_ + qA) * 512); uint2* mrowB = (uint2*)(mask + (size_t)(b * S_ + qB) * 512);
        if (tile < 16) {
            unsigned wlo = 0u, whi = 0u, xlo = 0u, xhi = 0u; const int ra = qA - lane * 64, rb = qB - lane * 64;
#pragma unroll
            for (int j = 0; j < 32; ++j) { wlo |= (~(unsigned)((ra - j) >> 31) & 1u) << j; whi |= (~(unsigned)((ra - 32 - j) >> 31) & 1u) << j;
                                           xlo |= (~(unsigned)((rb - j) >> 31) & 1u) << j; xhi |= (~(unsigned)((rb - 32 - j) >> 31) & 1u) << j; }
            mrowA[lane] = make_uint2(wlo, whi); mrowB[lane] = make_uint2(xlo, xhi);
            continue;
        }
        bf16x8_t qf[8]; float wi[8];
        { const bf16* qp = Pb + (size_t)(q0 + lq) * NP + C_QI + 8 * g4;
#pragma unroll
          for (int h = 0; h < 8; ++h) qf[h] = *(const bf16x8_t*)(qp + 32 * h);
          const uint4 wv = *(const uint4*)(Pb + (size_t)(q0 + lq) * NP + C_WI); unpack8(wv, wi); }
        bf16x8_t qch, qcl;
        { typedef unsigned u32x4_t __attribute__((ext_vector_type(4)));
          float qc[8];
#pragma unroll
          for (int i = 0; i < 8; ++i) qc[i] = 0.f;
#pragma unroll
          for (int h = 0; h < 8; ++h) { const u32x4_t w4 = __builtin_bit_cast(u32x4_t, qf[h]);
#pragma unroll
              for (int i = 0; i < 4; ++i) { qc[2 * i] += wi[h] * __uint_as_float(w4[i] << 16); qc[2 * i + 1] += wi[h] * __uint_as_float(w4[i] & 0xffff0000u); } }
          u32x4_t hi4, lo4;
#pragma unroll
          for (int i = 0; i < 4; ++i) { const unsigned hw = cvtpk(qc[2 * i], qc[2 * i + 1]); hi4[i] = hw;
              lo4[i] = cvtpk(qc[2 * i] - __uint_as_float(hw << 16), qc[2 * i + 1] - __uint_as_float(hw & 0xffff0000u)); }
          qch = __builtin_bit_cast(bf16x8_t, hi4); qcl = __builtin_bit_cast(bf16x8_t, lo4); }
        typedef __attribute__((address_space(3))) bf16x8_t lds_bf16x8;
        lds_bf16x8* qops = (lds_bf16x8*)((__attribute__((address_space(3))) unsigned char*)lds + 102656);
        if (wave == 0) {
#pragma unroll
            for (int h = 0; h < 8; ++h) qops[h * 64 + lane] = qf[h];
            qops[8 * 64 + lane] = qch; qops[9 * 64 + lane] = qcl; }
        __syncthreads();
        float* cb0 = (float*)(lds + 69632); float* cb1 = (float*)(lds + 112896);
        const int jlim = q0 >> 6;
        const int jmaxA = (qA - lane) >> 6, jmaxB = (qB - lane) >> 6;
        unsigned keyA[64], keyB[64];
        unsigned a0 = 0u, a1 = 0u, a2 = 0u, a3 = 0u, b0 = 0u, b1 = 0u, b2 = 0u, b3 = 0u;
        const bf16* kbase = Pb + (size_t)lq * NP + C_KI + 8 * g4;
        bf16x8_t nxt = *(const bf16x8_t*)(kbase + (size_t)(wave < ntiles ? wave : 0) * 16 * NP);
#pragma unroll
        for (int c = 0; c < 8; ++c) {
            if (32 * c < ntiles) {
                float* cb = (c & 1) ? cb1 : cb0;
#pragma unroll
                for (int j = 0; j < 4; ++j) {
                    const int kt = 32 * c + wave + 8 * j;
                    const bf16x8_t af = nxt;
                    { const int k = kt + 8; const int kc = k < ntiles ? k : 0; nxt = *(const bf16x8_t*)(kbase + (size_t)kc * 16 * NP); }
                    if (kt < ntiles) {
                        const f32x4_t z = {0.f, 0.f, 0.f, 0.f};
                        f32x4_t sc = __builtin_amdgcn_mfma_f32_16x16x32_bf16(af, qops[8 * 64 + lane], z, 0, 0, 0);
                        sc = __builtin_amdgcn_mfma_f32_16x16x32_bf16(af, qops[9 * 64 + lane], sc, 0, 0, 0);
#pragma unroll
                        for (int hh = 0; hh < 2; ++hh) {
                            f32x4_t a[4];
#pragma unroll
                            for (int h = 0; h < 4; ++h) a[h] = __builtin_amdgcn_mfma_f32_16x16x32_bf16(af, qops[(4 * hh + h) * 64 + lane], z, 0, 0, 0);
#pragma unroll
                            for (int h = 0; h < 4; ++h)
#pragma unroll
                                for (int r = 0; r < 4; ++r) sc[r] = __builtin_fmaf(__builtin_fabsf(a[h][r]), wi[4 * hh + h], sc[r]);
                        }
#pragma unroll
                        for (int r = 0; r < 4; ++r) { sc[r] *= 0.03125f; if (sc[r] == 0.f) sc[r] = 0.f; }
                        *(f32x4_t*)(cb + lq * IDX_CP + (wave + 8 * j) * 16 + 4 * g4) = sc;
                    }
                }
                __syncthreads();
#pragma unroll
                for (int js = 0; js < 8; ++js) {
                    const int slot = 8 * c + js;
                    if (slot <= jlim) {
                        const unsigned ua = __float_as_uint(cb[(2 * wave) * IDX_CP + 64 * js + lane]), ub = __float_as_uint(cb[(2 * wave + 1) * IDX_CP + 64 * js + lane]);
                        const unsigned xa = (ua ^ ((unsigned)((int)ua >> 31) | 0x80000000u)) & ~(unsigned)((jmaxA - slot) >> 31);
                        const unsigned xb = (ub ^ ((unsigned)((int)ub >> 31) | 0x80000000u)) & ~(unsigned)((jmaxB - slot) >> 31);
                        keyA[slot] = xa; keyB[slot] = xb;
                        unsigned n1, n2, n3;
                        asm("v_med3_u32 %0, %1, %2, %3" : "=v"(n3) : "v"(a2), "v"(a3), "v"(xa));
                        asm("v_med3_u32 %0, %1, %2, %3" : "=v"(n2) : "v"(a1), "v"(a2), "v"(xa));
                        asm("v_med3_u32 %0, %1, %2, %3" : "=v"(n1) : "v"(a0), "v"(a1), "v"(xa));
                        a0 = a0 > xa ? a0 : xa; a1 = n1; a2 = n2; a3 = n3;
                        asm("v_med3_u32 %0, %1, %2, %3" : "=v"(n3) : "v"(b2), "v"(b3), "v"(xb));
                        asm("v_med3_u32 %0, %1, %2, %3" : "=v"(n2) : "v"(b1), "v"(b2), "v"(xb));
                        asm("v_med3_u32 %0, %1, %2, %3" : "=v"(n1) : "v"(b0), "v"(b1), "v"(xb));
                        b0 = b0 > xb ? b0 : xb; b1 = n1; b2 = n2; b3 = n3;
                    } else { keyA[slot] = 0u; keyB[slot] = 0u; }
                }
            } else {
#pragma unroll
                for (int js = 0; js < 8; ++js) { keyA[8 * c + js] = 0u; keyB[8 * c + js] = 0u; }
            }
        }
        lds_u32* hist = (lds_u32*)((__attribute__((address_space(3))) unsigned char*)lds + 2048) + wave * 2048;
        idx_select(keyA, a3, jlim, hist, lane, mrowA);
        idx_select(keyB, b3, jlim, hist, lane, mrowB);
        __syncthreads();
    }
}

constexpr int MG_P = 72;
constexpr int MG_TILE_BYTES = 128 * MG_P * 2;
__device__ void merge_fast_phase(int WV_, const bf16* P, const bf16* ys, const bf16* wbt  , bf16* merged, unsigned char* lds) {
    const int tid = LTID(WV_), lane = tid & 63, wave = tid >> 6, r32 = lane & 31, hi = lane >> 5, wt = wave & 3, wd = wave >> 2;
    const int srow0 = tid >> 3, sch = tid & 7;
    for (int tile = LBID(); tile < 1024; tile += LGRID()) {
        const int tok0 = (tile >> 3) * 128, d0 = (tile & 7) * 128;
        f32x16_t mer[2], acc[2];
#pragma unroll
        for (int r = 0; r < 16; ++r) { mer[0][r] = 0.f; mer[1][r] = 0.f; acc[0][r] = 0.f; acc[1][r] = 0.f; }
        uint4 RW00, RW01, RW10, RW11, RY00, RY01, RY10, RY11, RG0, RG1, RG2, RG3;
        bf16* gl = (bf16*)(lds + 4 * MG_TILE_BYTES);
        const int grow = tid >> 4, gch = tid & 15;
#define MG_GLOAD(st_, R_) do { const int n_ = (st_) >> 2, kc_ = (st_) & 3; \
            RW##R_##0 = *(const uint4*)(wbt + ((size_t)n_ * 1024 + d0 + srow0) * 256 + kc_ * 64 + sch * 8); \
            RW##R_##1 = *(const uint4*)(wbt + ((size_t)n_ * 1024 + d0 + srow0 + 64) * 256 + kc_ * 64 + sch * 8); \
            RY##R_##0 = *(const uint4*)(ys + (size_t)(tok0 + srow0) * 1024 + n_ * 256 + kc_ * 64 + sch * 8); \
            RY##R_##1 = *(const uint4*)(ys + (size_t)(tok0 + srow0 + 64) * 1024 + n_ * 256 + kc_ * 64 + sch * 8); } while (0)
#define MG_SSTORE(buf_, R_) do { bf16* wl_ = (bf16*)(lds + (buf_) * 2 * MG_TILE_BYTES); bf16* yl_ = (bf16*)(lds + (buf_) * 2 * MG_TILE_BYTES + MG_TILE_BYTES); \
            *(uint4*)(wl_ + srow0 * MG_P + sch * 8) = RW##R_##0; *(uint4*)(wl_ + (srow0 + 64) * MG_P + sch * 8) = RW##R_##1; \
            *(uint4*)(yl_ + srow0 * MG_P + sch * 8) = RY##R_##0; *(uint4*)(yl_ + (srow0 + 64) * MG_P + sch * 8) = RY##R_##1; } while (0)
        __syncthreads();
        MG_GLOAD(0, 0); MG_GLOAD(1, 1);
        MG_SSTORE(0, 0);
        __syncthreads();
#define MG_STAGE(PAR_, OTH_) do { const int buf = PAR_; \
            if (st + 2 < 16) MG_GLOAD(st + 2, PAR_); \
            if ((st & 3) == 1) { const bf16* gsrc = P + (size_t)(tok0 + grow) * NP + C_G + (st >> 2) * 1024 + d0 + gch * 8; \
                RG0 = *(const uint4*)gsrc; RG1 = *(const uint4*)(gsrc + (size_t)32 * NP); RG2 = *(const uint4*)(gsrc + (size_t)64 * NP); RG3 = *(const uint4*)(gsrc + (size_t)96 * NP); } \
            const bf16* wl = (const bf16*)(lds + buf * 2 * MG_TILE_BYTES); const bf16* yl = (const bf16*)(lds + buf * 2 * MG_TILE_BYTES + MG_TILE_BYTES); \
            _Pragma("unroll") for (int ks = 0; ks < 4; ++ks) { \
                const bf16x8_t bq = *(const bf16x8_t*)(yl + (32 * wt + r32) * MG_P + 16 * ks + 8 * hi); \
                const bf16x8_t a0 = *(const bf16x8_t*)(wl + (64 * wd + r32) * MG_P + 16 * ks + 8 * hi); \
                const bf16x8_t a1 = *(const bf16x8_t*)(wl + (64 * wd + 32 + r32) * MG_P + 16 * ks + 8 * hi); \
                acc[0] = __builtin_amdgcn_mfma_f32_32x32x16_bf16(a0, bq, acc[0], 0, 0, 0); \
                acc[1] = __builtin_amdgcn_mfma_f32_32x32x16_bf16(a1, bq, acc[1], 0, 0, 0); } \
            if ((st & 3) == 3) { \
                const int n = st >> 2; \
                const bf16* gp = gl + (32 * wt + r32) * 136 + 64 * wd + 4 * hi; (void)n; \
                _Pragma("unroll") for (int dt = 0; dt < 2; ++dt) \
                _Pragma("unroll") for (int g = 0; g < 4; ++g) { \
                        const uint2 gv = *(const uint2*)(gp + 32 * dt + 8 * g); \
                        const float g0 = __uint_as_float(gv.x << 16), g1 = __uint_as_float(gv.x & 0xffff0000u), g2 = __uint_as_float(gv.y << 16), g3 = __uint_as_float(gv.y & 0xffff0000u); \
                        mer[dt][4 * g + 0] += acc[dt][4 * g + 0] * g0; \
                        mer[dt][4 * g + 1] += acc[dt][4 * g + 1] * g1; \
                        mer[dt][4 * g + 2] += acc[dt][4 * g + 2] * g2; \
                        mer[dt][4 * g + 3] += acc[dt][4 * g + 3] * g3; } \
                _Pragma("unroll") for (int r = 0; r < 16; ++r) { acc[0][r] = 0.f; acc[1][r] = 0.f; } } \
            if (st + 1 < 16) MG_SSTORE(OTH_, OTH_); \
            if ((st & 3) == 2) { *(uint4*)(gl + grow * 136 + gch * 8) = RG0; *(uint4*)(gl + (grow + 32) * 136 + gch * 8) = RG1; *(uint4*)(gl + (grow + 64) * 136 + gch * 8) = RG2; *(uint4*)(gl + (grow + 96) * 136 + gch * 8) = RG3; } \
            __syncthreads(); } while (0)
#pragma unroll 1
        for (int st2 = 0; st2 < 16; st2 += 2) { { const int st = st2; MG_STAGE(0, 1); } { const int st = st2 + 1; MG_STAGE(1, 0); } }
#undef MG_STAGE
#undef MG_GLOAD
#undef MG_SSTORE
        bf16* mp = merged + (size_t)(tok0 + 32 * wt + r32) * 1024 + d0 + 64 * wd + 4 * hi;
#pragma unroll
        for (int dt = 0; dt < 2; ++dt)
#pragma unroll
            for (int g = 0; g < 4; ++g)
                *(uint2*)(mp + 32 * dt + 8 * g) = make_uint2(cvtpk(mer[dt][4 * g], mer[dt][4 * g + 1]), cvtpk(mer[dt][4 * g + 2], mer[dt][4 * g + 3]));
    }
}
#define LAS __attribute__((address_space(3)))
#define XB_TMO      128
#define XB_XCNT(j)  (256  + 64 * (j))
#define XB_XSUB(j)  (1280 + 64 * (j))
#define XB_XGEN(j)  (2304 + 64 * (j))
#define XB_TOP      3328
#define XB_TOPGEN   3392
#define XCD_BAR_WORDS 3456
#define XB_SPIN_CAP (1u << 18)

__device__ __forceinline__ unsigned xb_ld(unsigned* p)              { return __hip_atomic_load(p, __ATOMIC_RELAXED, __HIP_MEMORY_SCOPE_AGENT); }
__device__ __forceinline__ unsigned xb_add(unsigned* p, unsigned v) { return __hip_atomic_fetch_add(p, v, __ATOMIC_RELAXED, __HIP_MEMORY_SCOPE_AGENT); }
__device__ __forceinline__ unsigned xb_xcc_id() { return (unsigned)__builtin_amdgcn_s_getreg((3 << 11) | 20) & 0xFu; }
#define XB_SPIN(cond, bar) do { unsigned _sp = 0; while (cond) { __builtin_amdgcn_s_sleep(1); \
    if ((++_sp & 255u) == 0u) { if (xb_ld(&(bar)[XB_TMO])) break; if (_sp > XB_SPIN_CAP) { atomicAdd(&(bar)[XB_TMO], 1u); break; } } } } while (0)

struct XcdBarrier {
    unsigned* bar; unsigned x;
    volatile LAS unsigned* st;
};

__device__ __forceinline__ XcdBarrier xcd_barrier_post(unsigned* bar, volatile LAS unsigned* st) {
    XcdBarrier b; b.bar = bar; b.x = xb_xcc_id(); b.st = st;
    if (threadIdx.x == 0) (void)xb_add(&bar[XB_XCNT(b.x)], 1u);
    return b;
}
__device__ __forceinline__ void xcd_barrier_complete(unsigned* bar, unsigned x, unsigned& nloc, unsigned& nx) {
    const unsigned G = gridDim.x * gridDim.y * gridDim.z;
    unsigned sum, cnt, mine, sp = 0u;
    for (;;) {
        sum = 0u; cnt = 0u; mine = 0u;
#pragma unroll
        for (unsigned j = 0; j < 16; ++j) { const unsigned c = xb_ld(&bar[XB_XCNT(j)]); sum += c; cnt += (c > 0u) ? 1u : 0u; mine = (j == x) ? c : mine; }
        if (sum == G) break;
        __builtin_amdgcn_s_sleep(1);
        if ((++sp & 255u) == 0u) { if (xb_ld(&bar[XB_TMO])) break; if (sp > XB_SPIN_CAP) { atomicAdd(&bar[XB_TMO], 1u); break; } }
    }
    nloc = mine > 0u ? mine : 1u; nx = cnt > 0u ? cnt : 1u;
}

__device__ __forceinline__ void xcd_barrier(const XcdBarrier& b, int wv_) {
    asm volatile("s_waitcnt vmcnt(0)" ::: "memory");
    __syncthreads();
    if (wv_ == 0 && LANEID() == 0) {
        unsigned* bar = b.bar;
        __builtin_amdgcn_s_waitcnt(0);
        unsigned nloc = b.st[0], nx = b.st[1];
        if (nloc == 0u) { xcd_barrier_complete(bar, b.x, nloc, nx); b.st[0] = nloc; b.st[1] = nx; }
        const unsigned old = xb_add(&bar[XB_XSUB(b.x)], 1u);
        const unsigned gen = old / nloc;
        if (old + 1u == (gen + 1u) * nloc) {
            __builtin_amdgcn_fence(__ATOMIC_RELEASE, "agent");
            asm volatile("s_waitcnt vmcnt(0)" ::: "memory");
            const unsigned og = xb_add(&bar[XB_TOP], 1u);
            const unsigned tg = og / nx;
            if (og + 1u == (tg + 1u) * nx) xb_add(&bar[XB_TOPGEN], 1u);
            else XB_SPIN(xb_ld(&bar[XB_TOPGEN]) == tg, bar);
            __builtin_amdgcn_fence(__ATOMIC_ACQUIRE, "agent");
            xb_add(&bar[XB_XGEN(b.x)], 1u);
            asm volatile("s_waitcnt vmcnt(0)" ::: "memory");
        } else {
            XB_SPIN(xb_ld(&bar[XB_XGEN(b.x)]) == gen, bar);
            __builtin_amdgcn_fence(__ATOMIC_ACQUIRE, "agent");
            asm volatile("s_waitcnt vmcnt(0)" ::: "memory");
        }
    }
    __syncthreads();
}

enum { PH_PRO = 0, PH_GIN, PH_INDEX, PH_ATTN, PH_MERGE, PH_GOUT, PH_LN1, PH_GQ, PH_ROUTE, PH_PEER };
template <int PH> __device__ __forceinline__ void run_phase(int WV_, const Params& p_unused, int l, unsigned char* lds_raw) {
    size_t kaoff_ = 0; asm volatile("" : "+s"(kaoff_));
    typedef const __attribute__((address_space(4))) char* kaptr_t;
    const __attribute__((address_space(4))) Params& p = *(const __attribute__((address_space(4))) Params*)((kaptr_t)__builtin_amdgcn_kernarg_segment_ptr() + kaoff_);
    float* sm = (float*)lds_raw;
    size_t wsoff_ = 0; asm volatile("" : "+s"(wsoff_));
    unsigned char* ws = p.ws + wsoff_;
    float* hbuf = p.out;
    bf16* hb = (bf16*)(ws + WS_HB);
    bf16* P = (bf16*)(ws + WS_P);
    bf16* ys = (bf16*)(ws + WS_YS);
    bf16* mrg = (bf16*)(ws + WS_MRG);
    float* mix = (float*)(ws + WS_MIX);
    float* qb = (float*)(ws + WS_Q);
    unsigned char* mask = ws + WS_MASK;
    int* eid = (int*)(ws + WS_EID);
    float* gate = (float*)(ws + WS_GATE);
    float* kmean = (float*)(ws + WS_KMEAN);
    const float* hin = (l == 0) ? p.in[0] : hbuf;
    if (PH == PH_PRO) { Params pc; for (int i = 0; i < 13; ++i) pc.in[i] = p.in[i]; pc.out = p.out; pc.ws = ws;
        prologue_phase(WV_, pc, sm); convert_tables(WV_, pc);
        for (int i = LBID() * NTHR + LTID(WV_); i < DEPTH_ * 8 * 2 * 128 * 64 / 4; i += LGRID() * NTHR) { const float4 v = ((const float4*)p.in[8])[i]; ((uint2*)(ws + WS_SKB))[i] = make_uint2(pk2(v.x, v.y), pk2(v.z, v.w)); } if (LBID() < 2) build_unit_table((unsigned*)(ws + WS_CTL) + 1024, LBID() * NTHR + LTID(WV_)); }
    else if (PH == PH_GIN) {
        pg8::Gemm g{hb, (const bf16*)(ws + WS_WIN_T + l * WIN_T_BYTES), T_, NP, 1024};
        pg8::StaticOrder S; S.init(T_, NP, (int)LGRID(), (int)LBID());
        pg8::EpiBf16Sig E{P, NP, C_G};
        pg8::gemm_phase<pg8::EpiBf16Sig, pg8::StaticOrder, true, true>(WV_, (PG8_LAS unsigned char*)lds_raw, g, S, E);
    }
    else if (PH == PH_INDEX) index_fast_phase(WV_, P, mask, kmean, (float*)(ws + WS_UV + 48 * MiB), (unsigned*)(ws + WS_CTL) + 64 * l + 16, lds_raw);
    else if (PH == PH_ATTN) attn_fast_phase(WV_, P, mask, kmean, p.in[4] + l * 4, ys, (const unsigned*)(ws + WS_CTL) + 1024, (unsigned*)(ws + WS_CTL) + 64 * l, lds_raw);
    else if (PH == PH_MERGE) merge_fast_phase(WV_, P, ys, (const bf16*)(ws + WS_WBR_T) + (size_t)l * 4 * 1024 * 256, mrg, lds_raw);
    else if (PH == PH_GOUT) {
        pg8::Gemm g{mrg, (const bf16*)(ws + WS_WOUT_T) + (size_t)l * 1024 * 1024, T_, 1024, 1024};
        pg8::StaticOrder S; S.init(T_, 1024, (int)LGRID(), (int)LBID());
        pg8::EpiResY E{l == 0 ? hin : nullptr, hb, hb, (float*)(ws + WS_STATS) + (size_t)l * T_ * 2, ALPHA};
        pg8::gemm_phase<pg8::EpiResY, pg8::StaticOrder, true, true>(WV_, (PG8_LAS unsigned char*)lds_raw, g, S, E);
    }
    else if (PH == PH_GQ) {
        pg8::Gemm g{hb, (const bf16*)(ws + WS_WQ_T) + (size_t)l * 1024 * 1024, T_, 1024, 1024};
        pg8::StaticOrder S; S.init(T_, 1024, (int)LGRID(), (int)LBID());
        pg8::EpiLnFold E{(bf16*)qb, (const float*)(ws + WS_STATS) + (size_t)l * T_ * 2, (const float*)(ws + WS_COLS) + l * 2048, (const float*)(ws + WS_COLS) + l * 2048 + 1024, LN_EPS};
        pg8::gemm_phase<pg8::EpiLnFold, pg8::StaticOrder, true, true>(WV_, (PG8_LAS unsigned char*)lds_raw, g, S, E);
        pg8::Unit u0;
        if (LGRID() == 256 && S.next(0, u0)) {
            asm volatile("s_waitcnt vmcnt(0)" ::: "memory"); __syncthreads();
            route_fast_phase(WV_, (const bf16*)qb, (const bf16*)(ws + WS_SKB) + (size_t)l * 8 * 2 * 128 * 64, eid, gate, lds_raw, u0.pm, u0.pn);
        }
    }
    else if (PH == PH_ROUTE) { if (LGRID() != 256) route_fast_phase(WV_, (const bf16*)qb, (const bf16*)(ws + WS_SKB) + (size_t)l * 8 * 2 * 128 * 64, eid, gate, lds_raw); }
    else peer_fast_phase(WV_, (l + 1 == DEPTH_) ? hbuf : nullptr, hb, eid, gate, ws + WS_UV + (size_t)l * 24 * MiB, p.in[5] + l * 1024, p.in[6] + l * 1024, p.in[11] + l * 1024, p.in[12] + l * 1024, lds_raw);
}

constexpr int CW_BAR = 4096;
constexpr int LDS_BARST = LDS_BYTES - 16;
__global__ void __launch_bounds__(NTHR, 2) mk_fwd(Params p) {
    extern __shared__ __attribute__((aligned(16))) unsigned char lds_raw[];
    cg::grid_group grid = cg::this_grid();
    const int WV_ = __builtin_amdgcn_readfirstlane((int)threadIdx.x >> 6);
    { volatile LAS unsigned* bst0 = (volatile LAS unsigned*)((LAS unsigned char*)lds_raw + LDS_BARST); if (threadIdx.x < 4) bst0[threadIdx.x] = 0u; }
    __syncthreads();
    volatile LAS unsigned* bst = (volatile LAS unsigned*)((LAS unsigned char*)lds_raw + LDS_BARST);
    { uint4* z = (uint4*)p.ws; const uint4 z4 = make_uint4(0u, 0u, 0u, 0u);
      for (unsigned i = (unsigned)LBID() * NTHR + (unsigned)LTID(WV_); i < (unsigned)(2 * MiB / 16); i += (unsigned)LGRID() * NTHR) z[i] = z4; }
    grid.sync();
    (void)xcd_barrier_post((unsigned*)(p.ws + WS_CTL) + CW_BAR, bst);
#define GRID_BAR() do { XcdBarrier b_; b_.bar = (unsigned*)(p.ws + WS_CTL) + CW_BAR; b_.x = xb_xcc_id(); b_.st = (volatile LAS unsigned*)((LAS unsigned char*)lds_raw + LDS_BARST); xcd_barrier(b_, WV_); } while (0)
    run_phase<PH_PRO>(WV_, p, 0, lds_raw);
    GRID_BAR();
#pragma unroll 1
    for (int l = 0; l < DEPTH_; ++l) {
        run_phase<PH_GIN>(WV_, p, l, lds_raw); GRID_BAR();
        run_phase<PH_INDEX>(WV_, p, l, lds_raw); GRID_BAR();
        run_phase<PH_ATTN>(WV_, p, l, lds_raw); GRID_BAR();
        run_phase<PH_MERGE>(WV_, p, l, lds_raw); GRID_BAR();
        run_phase<PH_GOUT>(WV_, p, l, lds_raw); GRID_BAR();
        run_phase<PH_GQ>(WV_, p, l, lds_raw); if (LGRID() != 256) { GRID_BAR(); run_phase<PH_ROUTE>(WV_, p, l, lds_raw); } GRID_BAR();
        run_phase<PH_PEER>(WV_, p, l, lds_raw); if (l + 1 < DEPTH_) GRID_BAR();
    }
}

extern "C" void kernel_launch(void* const* d_in, const int* in_sizes, int n_in, void* d_out, int out_size, void* d_ws, size_t ws_size, hipStream_t stream) {
    if (n_in != 13 || ws_size < WS_END) { fprintf(stderr, "kernel_launch: unexpected n_in %d / ws_size %zu; nothing launched\n", n_in, ws_size); return; }
    static int grid_blocks = 0;
    if (grid_blocks == 0) {
        int dev = 0, cus = 0, per_cu = 0;
        (void)hipGetDevice(&dev);
        (void)hipDeviceGetAttribute(&cus, hipDeviceAttributeMultiprocessorCount, dev);
        (void)hipFuncSetAttribute((const void*)mk_fwd, hipFuncAttributeMaxDynamicSharedMemorySize, LDS_BYTES);
        (void)hipOccupancyMaxActiveBlocksPerMultiprocessor(&per_cu, (const void*)mk_fwd, NTHR, LDS_BYTES);
        if (per_cu < 1) fprintf(stderr, "kernel_launch: occupancy query reports %d\n", per_cu);
        grid_blocks = cus;
    }
    Params p{};
    for (int i = 0; i < 13; ++i) p.in[i] = (const float*)d_in[i];
    p.out = (float*)d_out; p.ws = (unsigned char*)d_ws;
    void* args[] = {&p};
    hipError_t e = hipLaunchCooperativeKernel((const void*)mk_fwd, dim3(grid_blocks), dim3(NTHR), args, LDS_BYTES, stream);
    if (e != hipSuccess) fprintf(stderr, "cooperative launch failed: %s (grid %d)\n", hipGetErrorString(e), grid_blocks);
}
```

```cpp
#include <hip/hip_runtime.h>
#include <cstdio>
#include <cstdint>
#include <hip/hip_cooperative_groups.h>
namespace cg = cooperative_groups;

__device__ __forceinline__ int LANEID() { int l; asm volatile("v_mbcnt_lo_u32_b32 %0, -1, 0\n\tv_mbcnt_hi_u32_b32 %0, -1, %0" : "=v"(l)); return l; }
__device__ __forceinline__ int LTID(int wv) { return (wv << 6) | LANEID(); }
__device__ __forceinline__ int LBID() { int t = blockIdx.x; asm volatile("" : "+s"(t)); return t; }
__device__ __forceinline__ int LGRID() { int t = gridDim.x; asm volatile("" : "+s"(t)); return t; }
namespace pg8 {
#define PG8_LAS __attribute__((address_space(3)))
typedef unsigned short bf16_t;
typedef short bf16x8 __attribute__((ext_vector_type(8)));
typedef float f32x4 __attribute__((ext_vector_type(4)));
typedef unsigned u32x4 __attribute__((ext_vector_type(4)));
constexpr int BM = 256, BK = 64, HALF = 128, HTB = HALF * BK * 2  , STAGE_BYTES = 8 * HTB, NXCD = 8, WGM = 8;

__host__ __device__ __forceinline__ int lds_byte(int r, int c) { const int st = (r >> 4) * 2 + (c >> 5), rr = r & 15, cc = c & 31, ob = rr * 64 + cc * 2; return st * 1024 + (ob ^ (((ob >> 9) & 1) << 5)); }
__host__ __device__ __forceinline__ void stage_rc(int b, int& R, int& C) { const int st = b / 1024, sb = b % 1024, swz = sb ^ (((sb >> 9) & 1) << 5); R = (st >> 1) * 16 + swz / 64; C = (st & 1) * 32 + (swz % 64) / 2; }
__host__ __device__ __forceinline__ int perm32(int rho) { const int n = rho >> 4, i = rho & 15; return 8 * (i >> 2) + 4 * n + (i & 3); }

struct Unit { int pm, pn; };
struct Gemm { const bf16_t* A; const bf16_t* Bt; int M, N, K; };

struct StaticOrder {
    int nM, nN, nwg, G, c;
    __host__ __device__ void init(int M, int N, int G_, int c_) { nM = M / BM; nN = N / BM; nwg = nM * nN; G = G_; c = c_; }
    __host__ __device__ bool next(int i, Unit& u) const {
        const long L = (long)i * G + c; if (L >= nwg) return false;
        int wgid = (int)L; { const int q = nwg / NXCD, r = nwg % NXCD, xcd = wgid % NXCD, off = wgid / NXCD; wgid = (xcd < r ? xcd * (q + 1) : r * (q + 1) + (xcd - r) * q) + off; }
        const int nig = WGM * nN, gid = wgid / nig, fm = gid * WGM, gsz = (nM - fm) < WGM ? (nM - fm) : WGM;
        u.pm = fm + ((wgid % nig) % gsz); u.pn = (wgid % nig) / gsz; return true;
    }
    __device__ __forceinline__ void a_ready(const Unit&) const {}
    __device__ __forceinline__ void done(const Unit&) const {}
};

__device__ __forceinline__ unsigned cvt_pk_bf16(float lo, float hi) { unsigned r; asm volatile("v_cvt_pk_bf16_f32 %0, %1, %2" : "=v"(r) : "v"(lo), "v"(hi)); return r; }
typedef float f32x2 __attribute__((ext_vector_type(2)));
__device__ __forceinline__ f32x2 gelu_pk(f32x2 v) {
    const f32x2 av = __builtin_elementwise_abs(v), d = av * 0.2316418882f + 1.0f;
    f32x2 t; t.x = __builtin_amdgcn_rcpf(d.x); t.y = __builtin_amdgcn_rcpf(d.y);
    f32x2 q = t * 0.5307027145f + (-0.7265760135f); q = q * t + 0.7107068705f; q = q * t + (-0.142248368f); q = q * t + 0.127414796f; q = q * t;
    const f32x2 s = (v * v) * (-0.72134752044f);
    f32x2 e; e.x = __builtin_amdgcn_exp2f(s.x); e.y = __builtin_amdgcn_exp2f(s.y);
    const f32x2 m = v * (q * e), r = v - m;
    f32x2 o; o.x = v.x < 0.f ? m.x : r.x; o.y = v.y < 0.f ? m.y : r.y; return o;
}

template <int ACT  > struct EpiBf16 {
    static constexpr bool PERM = true, AFTER_DRAIN = false; static_assert(ACT == 0 || ACT == 1, "EpiBf16: ACT is 0 (none) or 1 (gelu_pk)");
    bf16_t* O; int ldc; const float* bias; int split_cols; size_t split_stride; float scale0;
    __device__ __forceinline__ void operator()(const f32x4 (&acc)[2][2][4][2], const Unit& u, int wr, int wc, int fr, int fq) const {
        { int ln_ = LANEID(); asm volatile("" : "+v"(ln_)); fr = ln_ & 15; fq = ln_ >> 4; }
        const int row0 = u.pm * BM + wr * 64 + fr; int colt = u.pn * BM; bf16_t* base = O;
        float sc = 1.f; if (split_cols) { const int t = colt / split_cols; base += (size_t)t * split_stride; colt -= t * split_cols; if (t == 0) sc = scale0; }
        const int col0 = colt + wc * 32 + 8 * fq, bcol0 = u.pn * BM + wc * 32 + 8 * fq;
        f32x4 bv[2][2];
#pragma unroll
        for (int bj = 0; bj < 2; ++bj)
#pragma unroll
            for (int n = 0; n < 2; ++n) bv[bj][n] = bias ? *(const f32x4*)(bias + bcol0 + bj * HALF + 4 * n) : (f32x4){0.f, 0.f, 0.f, 0.f};
#pragma unroll
        for (int ai = 0; ai < 2; ++ai)
#pragma unroll
            for (int m = 0; m < 4; ++m) { bf16_t* rowp = base + (size_t)(row0 + ai * HALF + m * 16) * ldc + col0;
#pragma unroll
                for (int bj = 0; bj < 2; ++bj) { f32x4 v0 = acc[ai][bj][m][0] + bv[bj][0], v1 = acc[ai][bj][m][1] + bv[bj][1];
                    if (ACT == 1) { f32x2 a = gelu_pk((f32x2){v0[0], v0[1]}), b = gelu_pk((f32x2){v0[2], v0[3]}), c = gelu_pk((f32x2){v1[0], v1[1]}), d = gelu_pk((f32x2){v1[2], v1[3]});
                        v0 = (f32x4){a.x, a.y, b.x, b.y}; v1 = (f32x4){c.x, c.y, d.x, d.y}; }
                    v0 = v0 * sc; v1 = v1 * sc; u32x4 w; w.x = cvt_pk_bf16(v0[0], v0[1]); w.y = cvt_pk_bf16(v0[2], v0[3]); w.z = cvt_pk_bf16(v1[0], v1[1]); w.w = cvt_pk_bf16(v1[2], v1[3]);
                    *(u32x4*)(rowp + bj * HALF) = w; } }
    }
};
template <class Epi, class Sched, bool ALIGN_EPI = false, bool SP2 = false>
__device__ __forceinline__ void gemm_phase(int WV_, PG8_LAS unsigned char* lds, const Gemm g, const Sched& S, const Epi& E) {
    const int tid = LTID(WV_), wid = __builtin_amdgcn_readfirstlane(tid >> 6), lane = tid & 63, wr = wid >> 2, wc = wid & 3, fr = lane & 15, fq = lane >> 4;
    const int K = g.K, nt = K / BK;
    unsigned voffA[2], voffB[2];
#pragma unroll
    for (int i = 0; i < 2; ++i) { int R, C; stage_rc(tid * 16 + i * 8192, R, C); const int Rb = Epi::PERM ? ((R & ~31) + perm32(R & 31)) : R;
        voffA[i] = (unsigned)(R * K + C) * 2u; voffB[i] = (unsigned)(Rb * K + C) * 2u; }
    const size_t kstep = (size_t)(BK * 2);
    const size_t hstep = (size_t)HALF * K * 2;
    const size_t tstep = 2 * hstep;
    const unsigned ldsw = (unsigned)wid * 1024u;
    const int aoff = lds_byte(wr * 64 + fr, fq * 8), boff = lds_byte(wc * 32 + fr, fq * 8);
#define PG8_SA(b, h) (((b) * 2 + (h)) * HTB)
#define PG8_SB(b, h) ((4 + (b) * 2 + (h)) * HTB)
#define PG8_STAGE(bufoff, gbase, voff) do { _Pragma("unroll") for (int _i = 0; _i < 2; ++_i) \
        __builtin_amdgcn_global_load_lds((const unsigned*)((const char*)(gbase) + (voff)[_i]), (PG8_LAS unsigned*)(lds + (bufoff) + ldsw + _i * 8192), 16, 0, 0); } while (0)
#define PG8_LDA(dst, b, h) do { _Pragma("unroll") for (int m = 0; m < 4; ++m) _Pragma("unroll") for (int k = 0; k < 2; ++k) dst[m][k] = *(const PG8_LAS bf16x8*)(lds + PG8_SA(b, h) + aoff + m * 2048 + k * 1024); } while (0)
#define PG8_LDB(dst, b, h) do { _Pragma("unroll") for (int n = 0; n < 2; ++n) _Pragma("unroll") for (int k = 0; k < 2; ++k) dst[n][k] = *(const PG8_LAS bf16x8*)(lds + PG8_SB(b, h) + boff + n * 2048 + k * 1024); } while (0)
#define PG8_MMA(ai, bj, At, Bt) do { __builtin_amdgcn_s_setprio(1); _Pragma("unroll") for (int m = 0; m < 4; ++m) _Pragma("unroll") for (int n = 0; n < 2; ++n) _Pragma("unroll") for (int k = 0; k < 2; ++k) \
        acc[ai][bj][m][n] = __builtin_amdgcn_mfma_f32_16x16x32_bf16(Bt[n][k], At[m][k], acc[ai][bj][m][n], 0, 0, 0); __builtin_amdgcn_s_setprio(0); } while (0)
#define PG8_WAIT_V(n) asm volatile("s_waitcnt vmcnt(" #n ")" ::: "memory")
#define PG8_WAIT_L(n) asm volatile("s_waitcnt lgkmcnt(" #n ")" ::: "memory")
#define PG8_BAR __builtin_amdgcn_s_barrier()
#define PG8_SCHED __builtin_amdgcn_sched_barrier(0)
    Unit cur, nxt; int ui = 0;
    if (!S.next(0, cur)) return;
    f32x4 acc[2][2][4][2];
#pragma unroll
    for (int a = 0; a < 2; ++a)
#pragma unroll
        for (int b = 0; b < 2; ++b)
#pragma unroll
            for (int m = 0; m < 4; ++m)
#pragma unroll
                for (int n = 0; n < 2; ++n) acc[a][b][m][n] = (f32x4){0.f, 0.f, 0.f, 0.f};
    bf16x8 At[4][2], B0[2][2], B1[2][2];
    const char* cA = (const char*)g.A + (size_t)cur.pm * tstep; const char* cB = (const char*)g.Bt + (size_t)cur.pn * tstep;
    S.a_ready(cur);
    if constexpr (SP2) {
        PG8_STAGE(PG8_SB(0, 0), cB, voffB); PG8_STAGE(PG8_SB(0, 1), cB + hstep, voffB); PG8_STAGE(PG8_SA(0, 0), cA, voffA); PG8_STAGE(PG8_SA(0, 1), cA + hstep, voffA);
        if (wr == 1) PG8_BAR;
        PG8_WAIT_V(2); PG8_BAR;
        PG8_STAGE(PG8_SB(1, 0), cB + kstep, voffB); PG8_STAGE(PG8_SA(1, 0), cA + kstep, voffA); PG8_STAGE(PG8_SB(1, 1), cB + hstep + kstep, voffB);
        PG8_WAIT_V(6); PG8_BAR;
    } else {
        PG8_STAGE(PG8_SB(0, 0), cB, voffB); PG8_STAGE(PG8_SA(0, 0), cA, voffA); PG8_STAGE(PG8_SB(0, 1), cB + hstep, voffB); PG8_STAGE(PG8_SA(0, 1), cA + hstep, voffA);
        if (wr == 1) PG8_BAR;
        PG8_WAIT_V(4); PG8_BAR;
        PG8_STAGE(PG8_SB(1, 0), cB + kstep, voffB); PG8_STAGE(PG8_SA(1, 0), cA + kstep, voffA); PG8_STAGE(PG8_SB(1, 1), cB + hstep + kstep, voffB);
        PG8_WAIT_V(6); PG8_BAR;
    }
    for (;;) {
        const bool has_next = S.next(ui + 1, nxt);
        const char* nA = has_next ? (const char*)g.A + (size_t)nxt.pm * tstep : cA; const char* nB = has_next ? (const char*)g.Bt + (size_t)nxt.pn * tstep : cB;
        for (int t = 0; t < nt; t += 2) {
            const bool last = (t == nt - 2);
            const char* a1 = cA + (size_t)(t + 1) * kstep;
            const char* a2 = last ? nA : cA + (size_t)(t + 2) * kstep; const char* b2 = last ? nB : cB + (size_t)(t + 2) * kstep;
            const char* a3 = a2 + kstep; const char* b3 = b2 + kstep;
            if (last && has_next) S.a_ready(nxt);
            if constexpr (SP2) {
            PG8_LDB(B0, 0, 0); PG8_LDB(B1, 0, 1); PG8_SCHED; PG8_LDA(At, 0, 0); PG8_STAGE(PG8_SA(1, 1), a1 + hstep, voffA);
            PG8_WAIT_V(8); PG8_WAIT_L(0); PG8_BAR; PG8_MMA(0, 0, At, B0); PG8_MMA(0, 1, At, B1); PG8_BAR; PG8_SCHED;
            PG8_LDA(At, 0, 1); PG8_STAGE(PG8_SB(0, 0), b2, voffB); PG8_STAGE(PG8_SB(0, 1), b2 + hstep, voffB); PG8_STAGE(PG8_SA(0, 0), a2, voffA);
            PG8_WAIT_V(8); PG8_WAIT_L(0); PG8_BAR; PG8_MMA(1, 0, At, B0); PG8_MMA(1, 1, At, B1); PG8_BAR; PG8_SCHED;
            PG8_LDB(B0, 1, 0); PG8_LDB(B1, 1, 1); PG8_SCHED; PG8_LDA(At, 1, 0); PG8_STAGE(PG8_SA(0, 1), a2 + hstep, voffA);
            PG8_WAIT_V(8); PG8_WAIT_L(0); PG8_BAR; PG8_MMA(0, 0, At, B0); PG8_MMA(0, 1, At, B1); PG8_BAR; PG8_SCHED;
            PG8_LDA(At, 1, 1); PG8_STAGE(PG8_SB(1, 0), b3, voffB); PG8_STAGE(PG8_SB(1, 1), b3 + hstep, voffB); PG8_STAGE(PG8_SA(1, 0), a3, voffA);
            PG8_WAIT_V(8); PG8_WAIT_L(0); PG8_BAR; PG8_MMA(1, 0, At, B0); PG8_MMA(1, 1, At, B1); PG8_BAR; PG8_SCHED;
            } else {
            PG8_LDB(B0, 0, 0); PG8_SCHED; PG8_LDA(At, 0, 0); PG8_STAGE(PG8_SA(1, 1), a1 + hstep, voffA);
            PG8_WAIT_L(8); PG8_BAR; PG8_WAIT_L(0); PG8_MMA(0, 0, At, B0); PG8_BAR; PG8_SCHED;
            PG8_LDB(B1, 0, 1); PG8_STAGE(PG8_SB(0, 0), b2, voffB);
            PG8_BAR; PG8_WAIT_L(0); PG8_MMA(0, 1, At, B1); PG8_BAR;
            PG8_LDA(At, 0, 1); PG8_STAGE(PG8_SA(0, 0), a2, voffA);
            PG8_BAR; PG8_WAIT_L(0); PG8_MMA(1, 0, At, B0); PG8_BAR; PG8_SCHED;
            PG8_STAGE(PG8_SB(0, 1), b2 + hstep, voffB);
            PG8_WAIT_V(6); PG8_BAR; PG8_MMA(1, 1, At, B1); PG8_BAR;
            PG8_LDB(B0, 1, 0); PG8_SCHED; PG8_LDA(At, 1, 0); PG8_STAGE(PG8_SA(0, 1), a2 + hstep, voffA);
            PG8_WAIT_L(8); PG8_BAR; PG8_WAIT_L(0); PG8_MMA(0, 0, At, B0); PG8_BAR; PG8_SCHED;
            PG8_LDB(B1, 1, 1); PG8_STAGE(PG8_SB(1, 0), b3, voffB);
            PG8_BAR; PG8_WAIT_L(0); PG8_MMA(0, 1, At, B1); PG8_BAR;
            PG8_LDA(At, 1, 1); PG8_STAGE(PG8_SA(1, 0), a3, voffA);
            PG8_BAR; PG8_WAIT_L(0); PG8_MMA(1, 0, At, B0); PG8_BAR; PG8_SCHED;
            PG8_STAGE(PG8_SB(1, 1), b3 + hstep, voffB);
            PG8_WAIT_V(6); PG8_BAR; PG8_MMA(1, 1, At, B1); PG8_BAR;
            }
        }
        if constexpr (ALIGN_EPI) { if (wr == 0) PG8_BAR; }
        if constexpr (!Epi::AFTER_DRAIN) { E(acc, cur, wr, wc, fr, fq); S.done(cur); }
        if (!has_next) break;
#pragma unroll
        for (int a = 0; a < 2; ++a)
#pragma unroll
            for (int b = 0; b < 2; ++b)
#pragma unroll
                for (int m = 0; m < 4; ++m)
#pragma unroll
                    for (int n = 0; n < 2; ++n) acc[a][b][m][n] = (f32x4){0.f, 0.f, 0.f, 0.f};
        cur = nxt; cA = nA; cB = nB; ++ui;
        if constexpr (ALIGN_EPI) { if (wr == 1) PG8_BAR; }
    }
    PG8_WAIT_V(0);
    if constexpr (!ALIGN_EPI) { if (wr == 0) PG8_BAR; }
    PG8_BAR;
    if constexpr (Epi::AFTER_DRAIN) { E.fused(acc, cur, wr, wc, fr, fq, lds, wid, lane); S.done(cur); }
#undef PG8_SA
#undef PG8_SB
#undef PG8_STAGE
#undef PG8_LDA
#undef PG8_LDB
#undef PG8_MMA
#undef PG8_WAIT_V
#undef PG8_WAIT_L
#undef PG8_BAR
#undef PG8_SCHED
}
}
namespace pg8 {
struct EpiF32 {
    static constexpr bool PERM = false, AFTER_DRAIN = false;
    float* O; int ldc;
    __device__ __forceinline__ void operator()(const f32x4 (&acc)[2][2][4][2], const Unit& u, int wr, int wc, int fr, int fq) const {
        { int ln_ = LANEID(); asm volatile("" : "+v"(ln_)); fr = ln_ & 15; fq = ln_ >> 4; }
        const int row0 = u.pm * BM + wr * 64 + fr, col0 = u.pn * BM + wc * 32 + 4 * fq;
#pragma unroll
        for (int ai = 0; ai < 2; ++ai)
#pragma unroll
            for (int m = 0; m < 4; ++m) { float* rowp = O + (size_t)(row0 + ai * HALF + m * 16) * ldc + col0;
#pragma unroll
                for (int bj = 0; bj < 2; ++bj)
#pragma unroll
                    for (int n = 0; n < 2; ++n) *(f32x4*)(rowp + bj * HALF + n * 16) = acc[ai][bj][m][n]; }
    }
};
struct EpiResY {
    static constexpr bool PERM = false, AFTER_DRAIN = false;
    const float* hin; const bf16_t* hinb; bf16_t* yb; float* stats; float alpha;
    __device__ __forceinline__ void operator()(const f32x4 (&acc)[2][2][4][2], const Unit& u, int wr, int wc, int fr, int fq) const {
        { int ln_ = LANEID(); asm volatile("" : "+v"(ln_)); fr = ln_ & 15; fq = ln_ >> 4; }
        const int row0 = u.pm * BM + wr * 64 + fr, col0 = u.pn * BM + wc * 32 + 4 * fq;
#pragma unroll
        for (int ai = 0; ai < 2; ++ai)
#pragma unroll
            for (int m = 0; m < 4; ++m) {
                const int row = row0 + ai * HALF + m * 16;
                float s = 0.f, s2 = 0.f;
#pragma unroll
                for (int bj = 0; bj < 2; ++bj)
#pragma unroll
                    for (int n = 0; n < 2; ++n) {
                        const size_t off = (size_t)row * 1024 + col0 + bj * HALF + n * 16;
                        f32x4 hv;
                        if (hin) hv = *(const f32x4*)(hin + off);
                        else { typedef unsigned u32x2r __attribute__((ext_vector_type(2))); const u32x2r hw = *(const u32x2r*)(hinb + off);
                            hv[0] = __uint_as_float(hw.x << 16); hv[1] = __uint_as_float(hw.x & 0xffff0000u); hv[2] = __uint_as_float(hw.y << 16); hv[3] = __uint_as_float(hw.y & 0xffff0000u); }
                        const f32x4 y = hv * alpha + acc[ai][bj][m][n];
                        typedef unsigned u32x2v __attribute__((ext_vector_type(2)));
                        u32x2v w; w.x = cvt_pk_bf16(y[0], y[1]); w.y = cvt_pk_bf16(y[2], y[3]);
                        *(u32x2v*)(yb + off) = w;
                        s += (y[0] + y[1]) + (y[2] + y[3]); s2 += (y[0] * y[0] + y[1] * y[1]) + (y[2] * y[2] + y[3] * y[3]);
                    }
                s += __shfl_xor(s, 16); s += __shfl_xor(s, 32); s2 += __shfl_xor(s2, 16); s2 += __shfl_xor(s2, 32);
                if (fq == 0) { atomicAdd(stats + 2 * (size_t)row, s); atomicAdd(stats + 2 * (size_t)row + 1, s2); }
            }
    }
};
struct EpiLnFold {
    static constexpr bool PERM = true, AFTER_DRAIN = false;
    bf16_t* O; const float* stats; const float* colsum; const float* colbias; float eps;
    __device__ __forceinline__ void operator()(const f32x4 (&acc)[2][2][4][2], const Unit& u, int wr, int wc, int fr, int fq) const {
        { int ln_ = LANEID(); asm volatile("" : "+v"(ln_)); fr = ln_ & 15; fq = ln_ >> 4; }
        const int row0 = u.pm * BM + wr * 64 + fr, col0 = u.pn * BM + wc * 32 + 8 * fq;
        f32x4 cs[2][2], cb[2][2];
#pragma unroll
        for (int bj = 0; bj < 2; ++bj)
#pragma unroll
            for (int n = 0; n < 2; ++n) { cs[bj][n] = *(const f32x4*)(colsum + col0 + bj * HALF + 4 * n); cb[bj][n] = *(const f32x4*)(colbias + col0 + bj * HALF + 4 * n); }
#pragma unroll
        for (int ai = 0; ai < 2; ++ai)
#pragma unroll
            for (int m = 0; m < 4; ++m) {
                const int row = row0 + ai * HALF + m * 16;
                const float sm_ = stats[2 * (size_t)row], sq_ = stats[2 * (size_t)row + 1];
                const float mean = sm_ * (1.0f / 1024.0f);
                const float rstd = 1.0f / sqrtf(fmaxf(sq_ * (1.0f / 1024.0f) - mean * mean, 0.f) + eps);
                bf16_t* rowp = O + (size_t)row * 1024 + col0;
#pragma unroll
                for (int bj = 0; bj < 2; ++bj) {
                    const f32x4 v0 = (acc[ai][bj][m][0] - cs[bj][0] * mean) * rstd + cb[bj][0], v1 = (acc[ai][bj][m][1] - cs[bj][1] * mean) * rstd + cb[bj][1];
                    u32x4 w; w.x = cvt_pk_bf16(v0[0], v0[1]); w.y = cvt_pk_bf16(v0[2], v0[3]); w.z = cvt_pk_bf16(v1[0], v1[1]); w.w = cvt_pk_bf16(v1[2], v1[3]);
                    *(u32x4*)(rowp + bj * HALF) = w;
                }
            }
    }
};
__device__ __forceinline__ unsigned cvt_pk_bf16_t(float lo, float hi) { unsigned r; asm volatile("s_nop 0\n\tv_cvt_pk_bf16_f32 %0, %1, %2" : "=v"(r) : "v"(lo), "v"(hi)); return r; }
struct EpiBf16Sig {
    static constexpr bool PERM = true, AFTER_DRAIN = false;
    bf16_t* O; int ldc; int sig_col0; unsigned char* G8;
    __device__ __forceinline__ void operator()(const f32x4 (&acc)[2][2][4][2], const Unit& u, int wr, int wc, int fr, int fq) const {
        { int ln_ = LANEID(); asm volatile("" : "+v"(ln_)); fr = ln_ & 15; fq = ln_ >> 4; }
        const int row0 = u.pm * BM + wr * 64 + fr; const int col0 = u.pn * BM + wc * 32 + 8 * fq;
#pragma unroll
        for (int bj = 0; bj < 2; ++bj) {
            if (col0 + bj * HALF >= sig_col0) {
                { const int gc = col0 + bj * HALF - sig_col0;
                  if (gc < 4096) {
#pragma unroll
                    for (int ai = 0; ai < 2; ++ai)
#pragma unroll
                        for (int m = 0; m < 4; ++m) {
                            f32x4 v0 = acc[ai][bj][m][0], v1 = acc[ai][bj][m][1];
#pragma unroll
                            for (int e = 0; e < 4; ++e) { v0[e] = __builtin_amdgcn_rcpf(1.f + __builtin_amdgcn_exp2f(-1.44269504f * v0[e])); v1[e] = __builtin_amdgcn_rcpf(1.f + __builtin_amdgcn_exp2f(-1.44269504f * v1[e])); }
                            int w0 = __builtin_amdgcn_cvt_pk_fp8_f32(v0[0], v0[1], 0, false); w0 = __builtin_amdgcn_cvt_pk_fp8_f32(v0[2], v0[3], w0, true);
                            int w1 = __builtin_amdgcn_cvt_pk_fp8_f32(v1[0], v1[1], 0, false); w1 = __builtin_amdgcn_cvt_pk_fp8_f32(v1[2], v1[3], w1, true);
                            typedef int i32x2v __attribute__((ext_vector_type(2)));
                            i32x2v w; w.x = w0; w.y = w1;
                            *(i32x2v*)(G8 + (size_t)(row0 + ai * HALF + m * 16) * 4096 + gc) = w; }
                  } }
            } else {
#pragma unroll
                for (int ai = 0; ai < 2; ++ai)
#pragma unroll
                    for (int m = 0; m < 4; ++m) { bf16_t* rowp = O + (size_t)(row0 + ai * HALF + m * 16) * ldc + col0;
                        const f32x4 v0 = acc[ai][bj][m][0], v1 = acc[ai][bj][m][1];
                        u32x4 w; w.x = cvt_pk_bf16(v0[0], v0[1]); w.y = cvt_pk_bf16(v0[2], v0[3]); w.z = cvt_pk_bf16(v1[0], v1[1]); w.w = cvt_pk_bf16(v1[2], v1[3]);
                        *(u32x4*)(rowp + bj * HALF) = w; }
            }
        }
    }
};
}

typedef unsigned short bf16;
constexpr int T_ = 16384, S_ = 4096, NBATCH = 4, D_ = 1024, NCOL = 6824, NP = 6912, DEPTH_ = 2;
constexpr int C_QA = 0, C_KA = 256, C_VA = 320, C_QI = 384, C_KI = 640, C_WI = 672, C_QB = 680, C_KB = 936, C_VB = 1064,
              C_QC = 1192, C_KC = 1448, C_VC = 1704, C_QD = 1960, C_KD = 2216, C_VD = 2472, C_G = 2728;
constexpr int NTHR = 512, NWAVE = 8;
constexpr float ALPHA = 1.41421356237309515f;
constexpr float LN_EPS = 1e-5f;
constexpr size_t MiB = 1u << 20;
constexpr size_t WS_STATS = 1 * MiB  , WS_COLS = 1 * MiB + 512 * 1024  ;
constexpr size_t WS_CTL = 0, WS_WIN_T = 2 * MiB, WS_WOUT_T = 30 * MiB, WS_WQ_T = 34 * MiB, WS_WBR_T = 38 * MiB, WS_HB = 42 * MiB,
                 WS_P = 74 * MiB, WS_MIX = 74 * MiB  , WS_Q = 138 * MiB  , WS_G8 = 428 * MiB  , WS_YS = 290 * MiB, WS_MRG = 322 * MiB,
                 WS_MASK = 354 * MiB, WS_EID = 362 * MiB, WS_GATE = 370 * MiB, WS_KMEAN = 378 * MiB, WS_SKB = 379 * MiB, WS_UV = 380 * MiB, WS_END = 508 * MiB;
constexpr size_t WIN_T_BYTES = (size_t)NP * 1024 * 2;
constexpr int LDS_BYTES = 144 * 1024;

struct Params { const float* in[13]; float* out; unsigned char* ws; };

__device__ __forceinline__ float bf2f(bf16 v) { return __uint_as_float((unsigned)v << 16); }
__device__ __forceinline__ unsigned f2bf(float f) { unsigned u = __float_as_uint(f); return (u + 0x7fffu + ((u >> 16) & 1u)) >> 16; }
__device__ __forceinline__ unsigned pk2(float lo, float hi) { return f2bf(lo) | (f2bf(hi) << 16); }
__device__ __forceinline__ void unpack8(const uint4 v, float* o) {
    o[0] = __uint_as_float(v.x << 16); o[1] = __uint_as_float(v.x & 0xffff0000u); o[2] = __uint_as_float(v.y << 16); o[3] = __uint_as_float(v.y & 0xffff0000u);
    o[4] = __uint_as_float(v.z << 16); o[5] = __uint_as_float(v.z & 0xffff0000u); o[6] = __uint_as_float(v.w << 16); o[7] = __uint_as_float(v.w & 0xffff0000u);
}
__device__ __forceinline__ float wave_sum(float v) {
#pragma unroll
    for (int o = 32; o > 0; o >>= 1) v += __shfl_xor(v, o);
    return v;
}
__device__ __forceinline__ float wave_max(float v) {
#pragma unroll
    for (int o = 32; o > 0; o >>= 1) v = fmaxf(v, __shfl_xor(v, o));
    return v;
}
__device__ __forceinline__ int wave_sum_i(int v) {
#pragma unroll
    for (int o = 32; o > 0; o >>= 1) v += __shfl_xor(v, o);
    return v;
}
__device__ __forceinline__ float logsig(float x) { return fminf(x, 0.f) - log1pf(expf(-fabsf(x))); }

__device__ void transpose_items(int WV_, const float* W, int K, int N, bf16* WT, float* sm, int item0, int nitems_total, int item_stride,
                                const float* rs_g = nullptr, const float* rs_b = nullptr, float* colsum = nullptr, float* colbias = nullptr) {
    const int tid = LTID(WV_);
    const int nkb = K / 64, nnb = (N + 63) / 64;
    for (int it = item0; it < nkb * nnb; it += item_stride) {
        const int kb = it % nkb, nb = it / nkb, k0 = kb * 64, n0 = nb * 64;
        __syncthreads();
        for (int e = tid; e < 64 * 64; e += NTHR) { const int kk = e >> 6, nn = e & 63; sm[kk * 65 + nn] = (n0 + nn < N) ? W[(size_t)(k0 + kk) * N + n0 + nn] : 0.f; }
        __syncthreads();
        if (rs_g) {
            if (tid < 64) { float cs = 0.f, cb = 0.f;
                for (int kk = 0; kk < 64; ++kk) { const float w = sm[kk * 65 + tid]; cs += w * rs_g[k0 + kk]; cb += w * rs_b[k0 + kk]; }
                atomicAdd(colsum + n0 + tid, cs); atomicAdd(colbias + n0 + tid, cb); }
            __syncthreads();
            for (int e = tid; e < 64 * 64; e += NTHR) { const int kk = e >> 6, nn = e & 63; sm[kk * 65 + nn] *= rs_g[k0 + kk]; }
            __syncthreads();
        }
        { const int nn = tid >> 3, c = tid & 7;
          if (n0 + nn < N) { uint4 o; o.x = pk2(sm[(8 * c + 0) * 65 + nn], sm[(8 * c + 1) * 65 + nn]); o.y = pk2(sm[(8 * c + 2) * 65 + nn], sm[(8 * c + 3) * 65 + nn]);
              o.z = pk2(sm[(8 * c + 4) * 65 + nn], sm[(8 * c + 5) * 65 + nn]); o.w = pk2(sm[(8 * c + 6) * 65 + nn], sm[(8 * c + 7) * 65 + nn]);
              *(uint4*)(WT + (size_t)(n0 + nn) * K + k0 + 8 * c) = o; } }
    }
    __syncthreads();
}
constexpr int TI_WIN = 16 * ((NCOL + 63) / 64), TI_SQ = 256, TI_LAYER = TI_WIN + 3 * TI_SQ;
#define TITEM_DECODE(it_, W_, WT_, K_, N_, k0_, n0_, fold_, l_) do { \
        l_ = (it_) / TI_LAYER; const int r_ = (it_) - l_ * TI_LAYER; \
        const int kind_ = r_ < TI_WIN ? 0 : (r_ < TI_WIN + TI_SQ ? 1 : (r_ < TI_WIN + 2 * TI_SQ ? 2 : 3)); \
        const int q_ = r_ - (kind_ == 0 ? 0 : TI_WIN + (kind_ - 1) * TI_SQ); \
        fold_ = kind_ == 2; K_ = kind_ == 3 ? 256 : 1024; N_ = kind_ == 0 ? NCOL : 1024; \
        k0_ = kind_ == 3 ? (q_ & 3) * 64 : (q_ & 15) * 64; n0_ = kind_ == 3 ? ((q_ & 63) >> 2) * 64 : (q_ >> 4) * 64; \
        const int nbr_ = q_ >> 6; \
        W_ = kind_ == 0 ? pin1 + (size_t)l_ * 1024 * NCOL : kind_ == 1 ? pin3 + (size_t)l_ * 1024 * 1024 : kind_ == 2 ? pin7 + (size_t)l_ * 1024 * 1024 : pin2 + ((size_t)l_ * 4 + nbr_) * 256 * 1024; \
        WT_ = kind_ == 0 ? (bf16*)(ws + WS_WIN_T + l_ * WIN_T_BYTES) : kind_ == 1 ? (bf16*)(ws + WS_WOUT_T) + (size_t)l_ * 1024 * 1024 : kind_ == 2 ? (bf16*)(ws + WS_WQ_T) + (size_t)l_ * 1024 * 1024 \
              : (bf16*)(ws + WS_WBR_T) + ((size_t)l_ * 4 + nbr_) * 1024 * 256; } while (0)
__device__ __forceinline__ void titem_finish(bf16* WT, int K, int N, int k0, int n0, const float* rs_g, const float* rs_b, float* colsum, float* colbias, float* sm, int tid) {
    if (rs_g) {
        if (tid < 64) { float cs = 0.f, cb = 0.f;
            for (int kk = 0; kk < 64; ++kk) { const float w = sm[kk * 65 + tid]; cs += w * rs_g[k0 + kk]; cb += w * rs_b[k0 + kk]; }
            atomicAdd(colsum + n0 + tid, cs); atomicAdd(colbias + n0 + tid, cb); }
        __syncthreads();
        for (int e = tid; e < 64 * 64; e += NTHR) { const int kk = e >> 6, nn = e & 63; sm[kk * 65 + nn] *= rs_g[k0 + kk]; }
        __syncthreads();
    }
    { const int nn = tid >> 3, c = tid & 7;
      if (n0 + nn < N) { uint4 o; o.x = pk2(sm[(8 * c + 0) * 65 + nn], sm[(8 * c + 1) * 65 + nn]); o.y = pk2(sm[(8 * c + 2) * 65 + nn], sm[(8 * c + 3) * 65 + nn]);
          o.z = pk2(sm[(8 * c + 4) * 65 + nn], sm[(8 * c + 5) * 65 + nn]); o.w = pk2(sm[(8 * c + 6) * 65 + nn], sm[(8 * c + 7) * 65 + nn]);
          *(uint4*)(WT + (size_t)(n0 + nn) * K + k0 + 8 * c) = o; } }
}
__device__ void prologue_phase(int WV_, const Params& p, float* sm) {
    const int tid = LTID(WV_), B = LBID(), G = LGRID();
    unsigned char* ws = p.ws;
    float* sm1 = sm + 64 * 65;
    const float* pin1 = p.in[1]; const float* pin2 = p.in[2]; const float* pin3 = p.in[3]; const float* pin7 = p.in[7]; const float* pin5 = p.in[5]; const float* pin6 = p.in[6];
    asm volatile("" : "+s"(pin1), "+s"(pin2), "+s"(pin3), "+s"(pin7), "+s"(pin5), "+s"(pin6));
    const int kk0 = tid >> 4, c4 = tid & 15;
    for (int it = B; it < DEPTH_ * TI_LAYER; it += 2 * G) {
        const int it2 = it + G; const bool has2 = it2 < DEPTH_ * TI_LAYER;
        const float* Wa; const float* Wb; bf16* WTa; bf16* WTb; int Ka, Na, k0a, n0a, la, Kb, Nb, k0b, n0b, lb; bool fa, fb;
        TITEM_DECODE(it, Wa, WTa, Ka, Na, k0a, n0a, fa, la);
        { const int itb = has2 ? it2 : it; TITEM_DECODE(itb, Wb, WTb, Kb, Nb, k0b, n0b, fb, lb); }
        const float4 z4 = make_float4(0.f, 0.f, 0.f, 0.f);
        const bool ina = n0a + 4 * c4 < Na, inb = n0b + 4 * c4 < Nb;
        float4 a0 = z4, a1 = z4, b0 = z4, b1 = z4;
        if (ina) { a0 = *(const float4*)(Wa + (size_t)(k0a + kk0) * Na + n0a + 4 * c4); a1 = *(const float4*)(Wa + (size_t)(k0a + kk0 + 32) * Na + n0a + 4 * c4); }
        if (inb) { b0 = *(const float4*)(Wb + (size_t)(k0b + kk0) * Nb + n0b + 4 * c4); b1 = *(const float4*)(Wb + (size_t)(k0b + kk0 + 32) * Nb + n0b + 4 * c4); }
        __syncthreads();
        { float* d = sm + kk0 * 65 + 4 * c4; d[0] = a0.x; d[1] = a0.y; d[2] = a0.z; d[3] = a0.w; d += 32 * 65; d[0] = a1.x; d[1] = a1.y; d[2] = a1.z; d[3] = a1.w; }
        { float* d = sm1 + kk0 * 65 + 4 * c4; d[0] = b0.x; d[1] = b0.y; d[2] = b0.z; d[3] = b0.w; d += 32 * 65; d[0] = b1.x; d[1] = b1.y; d[2] = b1.z; d[3] = b1.w; }
        __syncthreads();
        titem_finish(WTa, Ka, Na, k0a, n0a, fa ? pin5 + la * 1024 : nullptr, pin6 + la * 1024, (float*)(ws + WS_COLS) + la * 2048, (float*)(ws + WS_COLS) + la * 2048 + 1024, sm, tid);
        if (has2) titem_finish(WTb, Kb, Nb, k0b, n0b, fb ? pin5 + lb * 1024 : nullptr, pin6 + lb * 1024, (float*)(ws + WS_COLS) + lb * 2048, (float*)(ws + WS_COLS) + lb * 2048 + 1024, sm1, tid);
    }
    __syncthreads();
    for (int l = 0; l < DEPTH_; ++l) {
        bf16* win_t = (bf16*)(ws + WS_WIN_T + l * WIN_T_BYTES);
        for (int i = B * NTHR + tid; i < (NP - NCOL) * 1024 / 8; i += G * NTHR) ((uint4*)(win_t + (size_t)NCOL * 1024))[i] = make_uint4(0u, 0u, 0u, 0u);
    }
    const float4* x4 = (const float4*)p.in[0]; uint2* hb2 = (uint2*)(ws + WS_HB);
    for (size_t i = (size_t)B * NTHR + tid; i < (size_t)T_ * 1024 / 4; i += (size_t)G * NTHR) { const float4 v = x4[i]; hb2[i] = make_uint2(pk2(v.x, v.y), pk2(v.z, v.w)); }
}

__device__ __forceinline__ void ln_row(float4 (&v)[4], const float* g, const float* bb, float* orow, bf16* obrow, int lane) {
    float s = 0.f;
#pragma unroll
    for (int j = 0; j < 4; ++j) s += (v[j].x + v[j].y) + (v[j].z + v[j].w);
    const float mean = wave_sum(s) * (1.0f / 1024.0f);
    float s2 = 0.f;
#pragma unroll
    for (int j = 0; j < 4; ++j) { v[j].x -= mean; v[j].y -= mean; v[j].z -= mean; v[j].w -= mean; s2 += (v[j].x * v[j].x + v[j].y * v[j].y) + (v[j].z * v[j].z + v[j].w * v[j].w); }
    const float rstd = 1.0f / sqrtf(wave_sum(s2) * (1.0f / 1024.0f) + LN_EPS);
#pragma unroll
    for (int j = 0; j < 4; ++j) {
        const float4 gg = ((const float4*)g)[j * 64 + lane], b4 = ((const float4*)bb)[j * 64 + lane];
        float4 o; o.x = v[j].x * rstd * gg.x + b4.x; o.y = v[j].y * rstd * gg.y + b4.y; o.z = v[j].z * rstd * gg.z + b4.z; o.w = v[j].w * rstd * gg.w + b4.w;
        ((float4*)orow)[j * 64 + lane] = o;
        ((uint2*)obrow)[j * 64 + lane] = make_uint2(pk2(o.x, o.y), pk2(o.z, o.w));
    }
}
__device__ void ln1_phase(int WV_, const float* hin, const float* add, const float* g, const float* bb, float* hout, bf16* hb) {
    const int lane = LTID(WV_) & 63, wave = LTID(WV_) >> 6;
    for (int row = LBID() * NWAVE + wave; row < T_; row += LGRID() * NWAVE) {
        float4 v[4];
#pragma unroll
        for (int j = 0; j < 4; ++j) {
            const float4 a = ((const float4*)(hin + (size_t)row * 1024))[j * 64 + lane], m = ((const float4*)(add + (size_t)row * 1024))[j * 64 + lane];
            v[j].x = ALPHA * a.x + m.x; v[j].y = ALPHA * a.y + m.y; v[j].z = ALPHA * a.z + m.z; v[j].w = ALPHA * a.w + m.w;
        }
        ln_row(v, g, bb, hout + (size_t)row * 1024, hb + (size_t)row * 1024, lane);
    }
}


typedef short bf16x8_t __attribute__((ext_vector_type(8)));
typedef float f32x16_t __attribute__((ext_vector_type(16)));
typedef float f32x2_t __attribute__((ext_vector_type(2)));
typedef __bf16 bf16x2_t __attribute__((ext_vector_type(2)));
__device__ __forceinline__ unsigned cvtpk(float lo, float hi) { f32x2_t v = {lo, hi}; bf16x2_t b = __builtin_convertvector(v, bf16x2_t); return __builtin_bit_cast(unsigned, b); }
__device__ __forceinline__ int crow(int r, int hi) { return (r & 3) + 8 * (r >> 2) + 4 * hi; }
__device__ __forceinline__ float xlane32(float v) { return __shfl_xor(v, 32); }
__device__ __forceinline__ float vmax(float a, float b) { float r; asm("v_max_f32_e32 %0, %1, %2" : "=v"(r) : "v"(a), "v"(b)); return r; }
__device__ __forceinline__ float vmin(float a, float b) { float r; asm("v_min_f32_e32 %0, %1, %2" : "=v"(r) : "v"(a), "v"(b)); return r; }
__device__ __forceinline__ float vmax3(float a, float b, float c) { float r; asm("v_max3_f32 %0, %1, %2, %3" : "=v"(r) : "v"(a), "v"(b), "v"(c)); return r; }

constexpr int AT_KP = 72, AT_VP = 96;
constexpr int AT_KS = 0, AT_KS_BYTES = 64 * AT_KP * 2;
constexpr int AT_VT = 2 * AT_KS_BYTES, AT_VT_BYTES = 64 * AT_VP * 2;
constexpr int AT_KM = AT_VT + 2 * AT_VT_BYTES;
constexpr int AT_MISC = AT_KM + 32 * AT_KP * 2;
constexpr float LOG2E = 1.4426950408889634f;

__device__ __forceinline__ unsigned mk_unit(int kind, int b, int x, int y) { return ((unsigned)kind << 30) | ((unsigned)b << 28) | ((unsigned)x << 8) | (unsigned)y; }
__device__ void build_unit_table(unsigned* tab, int i) {
    int n = 0; unsigned res = 0u;
#pragma unroll 1
    for (int c = 64; c >= 1; --c) {
        if (i >= n && i < n + 4) res = mk_unit(0, i - n, 0, c - 1);
        n += 4;
        if ((c & 3) == 0) { if (i >= n && i < n + 16) { const int j = i - n; res = mk_unit(2, j >> 2, j & 3, c / 4 - 1); } n += 16; }
    }
    if (i < 512) tab[i] = res;
}

template <int kind> __device__ __forceinline__ void attn_unit(int WV_, const bf16* P, const unsigned char* mask, const float* kmean, const float* sinks, bf16* ys,
                                unsigned char* lds, int b, int ux, int uy) {
    int tid_ = LTID(WV_); asm volatile("" : "+v"(tid_));
    const int tid = tid_, lane = tid & 63, wave = __builtin_amdgcn_readfirstlane(tid >> 6), r32 = lane & 31, hi = lane >> 5;
    bf16* s_km = (bf16*)(lds + AT_KM);
    const int skey = tid >> 3, sc = tid & 7;
    {
        const bf16* Pb = P + (size_t)b * S_ * NP;
        int q0w, qcol, kcol, vcol, ycol, kt_hi, kt_lo; float slope2 = 0.f, sink2 = 0.f;
        if (kind == 0) { const int head = wave >> 1; q0w = uy * 64 + (wave & 1) * 32; qcol = C_QA + head * 64; kcol = C_KA; vcol = C_VA; ycol = head * 64;
            slope2 = exp2f(-8.0f * (float)(3 * head + 1) / 12.0f) * LOG2E; kt_hi = uy; kt_lo = 0; }
        else if (kind == 1) { const int hq = ux * 2 + (wave >> 2); q0w = uy * 128 + (wave & 3) * 32; qcol = C_QB + hq * 64; kcol = C_KB + ux * 64; vcol = C_VB + ux * 64; ycol = 256 + hq * 64;
            slope2 = exp2f(-8.0f * (float)(3 * hq + 2) / 12.0f) * LOG2E; sink2 = sinks[hq] * LOG2E; kt_hi = 2 * uy + 1; kt_lo = (2 * uy - 2 > 0) ? 2 * uy - 2 : 0; }
        else if (kind == 2) { q0w = uy * 256 + wave * 32; qcol = C_QC + ux * 64; kcol = C_KC + ux * 64; vcol = C_VC + ux * 64; ycol = 512 + ux * 64;
            slope2 = exp2f(-8.0f * (float)(3 * ux + 3) / 12.0f) * LOG2E; kt_hi = 4 * uy + 3; kt_lo = 0; }
        else { q0w = uy * 256 + wave * 32; qcol = C_QD + ux * 64; kcol = C_KD + ux * 64; vcol = C_VD + ux * 64; ycol = 768 + ux * 64; kt_hi = 4 * uy + 3; kt_lo = 0; }
        const int qpos = q0w + r32;
        bf16x8_t qf[4];
        { const bf16* qp = Pb + (size_t)qpos * NP + qcol + 8 * hi;
#pragma unroll
          for (int ks = 0; ks < 4; ++ks) qf[ks] = *(const bf16x8_t*)(qp + 16 * ks); }
        {
            const float qs = (kind == 3) ? 0.125f : 0.125f * LOG2E;
            typedef unsigned u32x4_t __attribute__((ext_vector_type(4)));
#pragma unroll
            for (int ks = 0; ks < 4; ++ks) { u32x4_t w = __builtin_bit_cast(u32x4_t, qf[ks]);
#pragma unroll
                for (int i = 0; i < 4; ++i) w[i] = cvtpk(__uint_as_float(w[i] << 16) * qs, __uint_as_float(w[i] & 0xffff0000u) * qs);
                qf[ks] = __builtin_bit_cast(bf16x8_t, w); }
        }
        float sb[16];
#pragma unroll
        for (int r = 0; r < 16; ++r) sb[r] = slope2 * (float)((r & 3) + 8 * (r >> 2));
        unsigned bm = 0u;
        if (kind == 2) {
            const int own = uy;
            for (int e = tid; e < 32 * 64; e += NTHR) { const int row = e >> 6, d = e & 63; s_km[row * AT_KP + d] = (row < 16) ? (bf16)f2bf(kmean[((b * 4 + ux) * 16 + row) * 64 + d]) : (bf16)0; }
            __syncthreads();
            f32x16_t gacc;
#pragma unroll
            for (int r = 0; r < 16; ++r) gacc[r] = 0.f;
#pragma unroll
            for (int ks = 0; ks < 4; ++ks) { const bf16x8_t a = *(const bf16x8_t*)(s_km + r32 * AT_KP + 16 * ks + 8 * hi); gacc = __builtin_amdgcn_mfma_f32_32x32x16_bf16(a, qf[ks], gacc, 0, 0, 0); }
            float gt[16];
#pragma unroll
            for (int r = 0; r < 8; ++r) { const float mine = gacc[r], other = xlane32(mine); const int bi = crow(r, 0);
                gt[bi] = hi ? other : mine; gt[bi + 4] = hi ? mine : other; }
#pragma unroll
            for (int n = 0; n < 16; ++n) if (n >= own) gt[n] = -INFINITY;
#pragma unroll
            for (int rep = 0; rep < 3; ++rep) {
                float mx = -INFINITY;
#pragma unroll
                for (int n = 0; n < 16; ++n) mx = fmaxf(mx, gt[n]);
                bool done = !(mx > -INFINITY);
#pragma unroll
                for (int n = 0; n < 16; ++n) { const bool hit = !done && gt[n] == mx; if (hit) { bm |= 1u << n; gt[n] = -INFINITY; done = true; } }
            }
        }
        f32x16_t o0, o1;
#pragma unroll
        for (int r = 0; r < 16; ++r) { o0[r] = 0.f; o1[r] = 0.f; }
        float m_run = -INFINITY, l_run = 0.f, carry = 0.f;
        const bf16* kg = Pb + (size_t)skey * NP + kcol + sc * 8;
        const bf16* vg = Pb + (size_t)skey * NP + vcol + sc * 8;
        uint4 rk = *(const uint4*)(kg + (size_t)kt_hi * 64 * NP), rv = *(const uint4*)(vg + (size_t)kt_hi * 64 * NP);
        int buf = 0;
        { bf16* ks_ = (bf16*)(lds + AT_KS); bf16* vt_ = (bf16*)(lds + AT_VT);
          *(uint4*)(ks_ + skey * AT_KP + sc * 8) = rk;
          *(uint4*)(vt_ + skey * AT_VP + sc * 8) = rv; }
        __syncthreads();
        bool wave_done = false;
        uint2 mw_next = make_uint2(0u, 0u);
        if (kind == 0) mw_next = *(const uint2*)(mask + (size_t)(b * S_ + qpos) * 512 + kt_hi * 8);
        for (int kt = kt_hi; kt >= kt_lo; --kt) {
            const bool more = kt > kt_lo;
            const uint2 mw = mw_next;
            if (kind == 0 && more) mw_next = *(const uint2*)(mask + (size_t)(b * S_ + qpos) * 512 + (kt - 1) * 8);
            if (more) { rk = *(const uint4*)(kg + (size_t)(kt - 1) * 64 * NP); rv = *(const uint4*)(vg + (size_t)(kt - 1) * 64 * NP); }
            const bf16* ks_ = (const bf16*)(lds + AT_KS + buf * AT_KS_BYTES);
            const bf16* vt_ = (const bf16*)(lds + AT_VT + buf * AT_VT_BYTES);
            bool active = (kt * 64 <= q0w + 31) && !wave_done;
            if (kind == 1) active = active && (kt * 64 + 63 >= q0w - 127);
            if (active) {
                const int kbase = kt * 64 + 4 * hi;
                f32x16_t p0, p1;
                if (kind != 3) {
                    const float cb = slope2 * (float)(kbase - qpos), cb1 = cb + 32.0f * slope2;
#pragma unroll
                    for (int r = 0; r < 16; ++r) { p0[r] = cb + sb[r]; p1[r] = cb1 + sb[r]; }
                } else {
#pragma unroll
                    for (int r = 0; r < 16; ++r) { p0[r] = 0.f; p1[r] = 0.f; }
                }
#pragma unroll
                for (int ks = 0; ks < 4; ++ks) {
                    const bf16x8_t a0 = *(const bf16x8_t*)(ks_ + r32 * AT_KP + 16 * ks + 8 * hi);
                    const bf16x8_t a1 = *(const bf16x8_t*)(ks_ + (32 + r32) * AT_KP + 16 * ks + 8 * hi);
                    p0 = __builtin_amdgcn_mfma_f32_32x32x16_bf16(a0, qf[ks], p0, 0, 0, 0);
                    p1 = __builtin_amdgcn_mfma_f32_32x32x16_bf16(a1, qf[ks], p1, 0, 0, 0);
                }
                if (kind != 3) {
                    float mx = -INFINITY;
                    if (kind == 0) {
                        const unsigned w0 = mw.x >> (4 * hi), w1 = mw.y >> (4 * hi);
#pragma unroll
                        for (int r = 0; r < 16; ++r) { const int off = (r & 3) + 8 * (r >> 2);
                            p0[r] = (w0 & (1u << off)) ? p0[r] : -INFINITY; p1[r] = (w1 & (1u << off)) ? p1[r] : -INFINITY; mx = vmax3(mx, p0[r], p1[r]); }
                    } else if (kind == 1) {
                        const int rel = qpos - kbase;
#pragma unroll
                        for (int r = 0; r < 16; ++r) { const int off = (r & 3) + 8 * (r >> 2);
                            p0[r] = ((unsigned)(rel - off) < 128u) ? p0[r] : -INFINITY; p1[r] = ((unsigned)(rel - off - 32) < 128u) ? p1[r] : -INFINITY; mx = vmax3(mx, p0[r], p1[r]); }
                    } else {
                        if ((kt >> 2) == uy) {
                            const int rel = qpos - kbase;
#pragma unroll
                            for (int r = 0; r < 16; ++r) { const int off = (r & 3) + 8 * (r >> 2);
                                p0[r] = (off <= rel) ? p0[r] : -INFINITY; p1[r] = (off + 32 <= rel) ? p1[r] : -INFINITY; mx = vmax3(mx, p0[r], p1[r]); }
                        } else {
                            const bool tile_ok = ((bm >> (kt >> 2)) & 1u) != 0u;
#pragma unroll
                            for (int r = 0; r < 16; ++r) { p0[r] = tile_ok ? p0[r] : -INFINITY; p1[r] = tile_ok ? p1[r] : -INFINITY; mx = vmax3(mx, p0[r], p1[r]); }
                        }
                    }
                    mx = vmax(mx, xlane32(mx));
                    const float m_new = vmax(m_run, mx);
                    const float m_safe = (m_new == -INFINITY) ? 0.f : m_new;
                    p0 = p0 - m_safe; p1 = p1 - m_safe;
#pragma unroll
                    for (int r = 0; r < 16; ++r) { p0[r] = __builtin_amdgcn_exp2f(p0[r]); p1[r] = __builtin_amdgcn_exp2f(p1[r]); }
                    float ls;
                    { typedef float f32x8_t __attribute__((ext_vector_type(8))); typedef float f32x4v_t __attribute__((ext_vector_type(4)));
                      const f32x16_t t16 = p0 + p1; const f32x8_t t8 = t16.lo + t16.hi; const f32x4v_t t4 = t8.lo + t8.hi; const f32x2_t t2 = t4.lo + t4.hi; ls = t2.x + t2.y; }
                    if (__any(m_new > m_run)) {
                        const float alpha = __builtin_amdgcn_exp2f(m_run - m_safe);
                        l_run *= alpha;
                        o0 = o0 * alpha; o1 = o1 * alpha;
                    }
                    l_run += ls; m_run = m_new;
                } else {
                    float run = carry;
#define SB_HALF(PX, KOFF) do { \
                    float lk[16]; \
                    _Pragma("unroll") for (int r = 0; r < 16; ++r) { \
                        const int off = (r & 3) + 8 * (r >> 2); \
                        const bool v = (kbase + off + (KOFF)) < qpos; \
                        const float z = PX[r]; \
                        const float t = 0.6931471805599453f * __builtin_amdgcn_logf(1.0f + __builtin_amdgcn_exp2f(-LOG2E * fabsf(z))); \
                        lk[r] = v ? (fminf(-z, 0.f) - t) : 0.f; \
                        PX[r] = v ? (fminf(z, 0.f) - t) : -INFINITY; } \
                    _Pragma("unroll") for (int g = 3; g >= 0; --g) { \
                        const float G = (lk[4 * g] + lk[4 * g + 1]) + (lk[4 * g + 2] + lk[4 * g + 3]); \
                        const float PG = xlane32(G); \
                        float la = run + (hi ? 0.f : PG); \
                        run += G + PG; \
                        PX[4 * g + 3] += la; la += lk[4 * g + 3]; PX[4 * g + 2] += la; la += lk[4 * g + 2]; PX[4 * g + 1] += la; la += lk[4 * g + 1]; PX[4 * g] += la; } \
                    _Pragma("unroll") for (int r = 0; r < 16; ++r) PX[r] = __builtin_amdgcn_exp2f(LOG2E * PX[r]); } while (0)
                    SB_HALF(p1, 32);
                    SB_HALF(p0, 0);
#undef SB_HALF
                    carry = run;
                }
                unsigned pw[16];
#pragma unroll
                for (int j = 0; j < 8; ++j) { pw[j] = cvtpk(p0[2 * j], p0[2 * j + 1]); pw[8 + j] = cvtpk(p1[2 * j], p1[2 * j + 1]); }
#pragma unroll
                for (int s = 0; s < 4; ++s) {
                    bf16x8_t pb; { const unsigned* q = pw + 4 * s; typedef unsigned u32x4_t __attribute__((ext_vector_type(4))); u32x4_t t4 = {q[0], q[1], q[2], q[3]}; pb = __builtin_bit_cast(bf16x8_t, t4); }
#pragma unroll
                    for (int dt = 0; dt < 2; ++dt) {
                        typedef short s16x4_t __attribute__((ext_vector_type(4)));
                        typedef __attribute__((address_space(3))) s16x4_t lds_s16x4;
                        const int gi_ = lane & 15;
                        const bf16* vp = vt_ + (16 * s + 4 * hi + (gi_ >> 2)) * AT_VP + 32 * dt + 16 * ((lane >> 4) & 1) + 4 * (gi_ & 3);
                        const s16x4_t lo = __builtin_amdgcn_ds_read_tr16_b64_v4i16((lds_s16x4*)vp), hi4 = __builtin_amdgcn_ds_read_tr16_b64_v4i16((lds_s16x4*)(vp + 8 * AT_VP));
                        const bf16x8_t va = {lo[0], lo[1], lo[2], lo[3], hi4[0], hi4[1], hi4[2], hi4[3]};
                        if (dt == 0) o0 = __builtin_amdgcn_mfma_f32_32x32x16_bf16(va, pb, o0, 0, 0, 0);
                        else         o1 = __builtin_amdgcn_mfma_f32_32x32x16_bf16(va, pb, o1, 0, 0, 0);
                    }
                }
            }
            if (kind == 3) {
                const float cm = carry;
                if (__all(cm < -110.0f) || !(kt * 64 <= q0w + 31) ) { if (__all(cm < -110.0f)) wave_done = true; }
            }
            if (more) {
                bf16* ksn = (bf16*)(lds + AT_KS + (buf ^ 1) * AT_KS_BYTES); bf16* vtn = (bf16*)(lds + AT_VT + (buf ^ 1) * AT_VT_BYTES);
                *(uint4*)(ksn + skey * AT_KP + sc * 8) = rk;
                *(uint4*)(vtn + skey * AT_VP + sc * 8) = rv;
            }
            if (kind == 3) { if (__syncthreads_and(wave_done ? 1 : 0)) break; }
            else __syncthreads();
            buf ^= 1;
        }
        float inv;
        if (kind == 3) inv = 1.0f;
        else {
            float lt = l_run + xlane32(l_run);
            if (kind == 1) { const float mf = fmaxf(m_run, sink2); const float sc2 = exp2f(m_run - mf); lt = lt * sc2 + exp2f(sink2 - mf); inv = sc2 / lt; }
            else inv = 1.0f / lt;
        }
        bf16* yp = ys + (size_t)(b * S_ + qpos) * 1024 + ycol + 4 * hi;
#pragma unroll
        for (int g = 0; g < 4; ++g) {
            *(uint2*)(yp + 8 * g) = make_uint2(cvtpk(o0[4 * g] * inv, o0[4 * g + 1] * inv), cvtpk(o0[4 * g + 2] * inv, o0[4 * g + 3] * inv));
            *(uint2*)(yp + 32 + 8 * g) = make_uint2(cvtpk(o1[4 * g] * inv, o1[4 * g + 1] * inv), cvtpk(o1[4 * g + 2] * inv, o1[4 * g + 3] * inv));
        }
    }
}
__device__ void attn_fast_phase(int WV_, const bf16* P, const unsigned char* mask, const float* kmean, const float* sinks, bf16* ys,
                                const unsigned* utab, unsigned* counter, unsigned char* lds) {
    volatile unsigned* s_unit = (volatile unsigned*)(lds + AT_MISC);
    for (;;) {
        __syncthreads();
        if (LTID(WV_) == 0) s_unit[0] = atomicAdd(counter, 1u);
        __syncthreads();
        const unsigned ui = s_unit[0];
        if (ui >= 512u) break;
        const unsigned ue = utab[ui];
        const int kind = (int)(ue >> 30), b = (int)((ue >> 28) & 3u), ux = (int)((ue >> 8) & 255u), uy = (int)(ue & 255u);
        if (kind == 0) attn_unit<0>(WV_, P, mask, kmean, sinks, ys, lds, b, ux, uy);
        else attn_unit<2>(WV_, P, mask, kmean, sinks, ys, lds, b, ux, uy);
    }
    for (int u = LBID(); u < 256; u += LGRID()) { __syncthreads(); attn_unit<3>(WV_, P, mask, kmean, sinks, ys, lds, u >> 6, (u >> 4) & 3, u & 15); }
    for (int u = LBID(); u < 256; u += LGRID()) { __syncthreads(); attn_unit<1>(WV_, P, mask, kmean, sinks, ys, lds, u >> 6, (u >> 5) & 1, u & 31); }
}

constexpr float U_SCALE = 128.0f, V_SCALE = 48.0f;
constexpr int ROW6 = 1536;
typedef float v32f_t __attribute__((ext_vector_type(32)));
typedef unsigned v6u_t __attribute__((ext_vector_type(6)));
typedef unsigned u32x4a8_t __attribute__((ext_vector_type(4), aligned(8)));
__device__ __forceinline__ float rdlane_f(float v, int l) { return __builtin_bit_cast(float, __builtin_amdgcn_readlane(__builtin_bit_cast(int, v), l)); }
__device__ __forceinline__ unsigned q_e2m3(float v) {
    const float a = fminf(fabsf(v), 7.5f);
    unsigned code;
    if (a < 1.0f) code = (unsigned)rintf(a * 8.0f);
    else if (a < 2.0f) code = 8u + (unsigned)rintf((a - 1.0f) * 8.0f);
    else if (a < 4.0f) code = 16u + (unsigned)rintf((a - 2.0f) * 4.0f);
    else code = 24u + (unsigned)rintf((a - 4.0f) * 2.0f);
    return code | (v < 0.f ? 32u : 0u);
}
__device__ __forceinline__ void cvt_chunk6(const float4 (&a)[8], float sc, unsigned (&w)[6]) {
#pragma unroll
    for (int d = 0; d < 6; ++d) w[d] = 0u;
#pragma unroll
    for (int q4 = 0; q4 < 8; ++q4) {
        const float av[4] = {a[q4].x, a[q4].y, a[q4].z, a[q4].w};
#pragma unroll
        for (int e = 0; e < 4; ++e) { const int idx = q4 * 4 + e, bit = 6 * idx, d = bit >> 5, sft = bit & 31; const unsigned code = q_e2m3(av[e] * sc);
            w[d] |= code << sft; if (sft > 26) w[d + 1] |= code >> (32 - sft); }
    }
}
__device__ void convert_tables(int WV_, const Params& p) {
    const size_t nchunk = (size_t)DEPTH_ * 16384 * 2 * 32;
    const size_t stride = (size_t)LGRID() * NTHR;
    for (size_t i = (size_t)LBID() * NTHR + LTID(WV_); i < nchunk; i += 2 * stride) {
        const size_t i2 = i + stride; const bool has2 = i2 < nchunk; const size_t j2 = has2 ? i2 : i;
        const int c0 = (int)(i & 31), uv0 = (int)((i >> 5) & 1); const size_t le0 = i >> 6;
        const int c1 = (int)(j2 & 31), uv1 = (int)((j2 >> 5) & 1); const size_t le1 = j2 >> 6;
        const float* src0 = (uv0 ? p.in[10] : p.in[9]) + le0 * 1024 + c0 * 32;
        const float* src1 = (uv1 ? p.in[10] : p.in[9]) + le1 * 1024 + c1 * 32;
        float4 a0[8], a1[8];
#pragma unroll
        for (int q4 = 0; q4 < 8; ++q4) a0[q4] = ((const float4*)src0)[q4];
#pragma unroll
        for (int q4 = 0; q4 < 8; ++q4) a1[q4] = ((const float4*)src1)[q4];
        unsigned w0[6], w1[6];
        cvt_chunk6(a0, uv0 ? V_SCALE : U_SCALE, w0);
        cvt_chunk6(a1, uv1 ? V_SCALE : U_SCALE, w1);
        uint2* dst0 = (uint2*)(p.ws + WS_UV + le0 * ROW6 + uv0 * 768 + c0 * 24);
        dst0[0] = make_uint2(w0[0], w0[1]); dst0[1] = make_uint2(w0[2], w0[3]); dst0[2] = make_uint2(w0[4], w0[5]);
        if (has2) { uint2* dst1 = (uint2*)(p.ws + WS_UV + le1 * ROW6 + uv1 * 768 + c1 * 24);
            dst1[0] = make_uint2(w1[0], w1[1]); dst1[1] = make_uint2(w1[2], w1[3]); dst1[2] = make_uint2(w1[4], w1[5]); }
    }
}
__device__ __forceinline__ v6u_t ld_pk6(const unsigned char* ptr) {
    const uint2 a = ((const uint2*)ptr)[0], b = ((const uint2*)ptr)[1], c = ((const uint2*)ptr)[2];
    const v6u_t pk = {a.x, a.y, b.x, b.y, c.x, c.y};
    return pk;
}
__device__ void peer_fast_phase(int WV_, float* h, bf16* hb, const int* eid, const float* gate, const unsigned char* uv, const float* g1, const float* b1, const float* g, const float* bb, unsigned char* lds) {
    const int tid = LTID(WV_), lane = tid & 63, wave = tid >> 6, l32 = lane & 31, hi = lane >> 5;
    float* pl = (float*)(lds + wave * 16384);
    unsigned char* raw = lds + wave * 16384 + 4096 + lane * 24;
    for (int t = LBID() * NWAVE + wave; t < T_; t += LGRID() * NWAVE) {
        float* hr = h + (size_t)t * 1024 + l32 * 32;
        float x[32], acc[32];
#pragma unroll
        for (int q4 = 0; q4 < 4; ++q4) { const uint4 a = ((const uint4*)(hb + (size_t)t * 1024 + l32 * 32))[q4];
            x[8 * q4] = __uint_as_float(a.x << 16); x[8 * q4 + 1] = __uint_as_float(a.x & 0xffff0000u); x[8 * q4 + 2] = __uint_as_float(a.y << 16); x[8 * q4 + 3] = __uint_as_float(a.y & 0xffff0000u);
            x[8 * q4 + 4] = __uint_as_float(a.z << 16); x[8 * q4 + 5] = __uint_as_float(a.z & 0xffff0000u); x[8 * q4 + 6] = __uint_as_float(a.w << 16); x[8 * q4 + 7] = __uint_as_float(a.w & 0xffff0000u); }
        {
            float s = 0.f;
#pragma unroll
            for (int i = 0; i < 32; ++i) s += x[i];
#pragma unroll
            for (int o = 16; o > 0; o >>= 1) s += __shfl_xor(s, o);
            const float mean = s * (1.0f / 1024.0f);
            float s2 = 0.f;
#pragma unroll
            for (int i = 0; i < 32; ++i) { x[i] -= mean; s2 += x[i] * x[i]; }
#pragma unroll
            for (int o = 16; o > 0; o >>= 1) s2 += __shfl_xor(s2, o);
            const float rstd = 1.0f / sqrtf(s2 * (1.0f / 1024.0f) + LN_EPS);
#pragma unroll
            for (int q4 = 0; q4 < 8; ++q4) { const float4 gg = ((const float4*)(g1 + l32 * 32))[q4], cc = ((const float4*)(b1 + l32 * 32))[q4];
                x[4 * q4] = x[4 * q4] * rstd * gg.x + cc.x; x[4 * q4 + 1] = x[4 * q4 + 1] * rstd * gg.y + cc.y; x[4 * q4 + 2] = x[4 * q4 + 2] * rstd * gg.z + cc.z; x[4 * q4 + 3] = x[4 * q4 + 3] * rstd * gg.w + cc.w; }
        }
#pragma unroll
        for (int i = 0; i < 32; ++i) acc[i] = 0.f;
#pragma unroll 1
        for (int batch = 0; batch < 4; ++batch) {
            const int my_eid = eid[(size_t)t * 128 + batch * 32 + l32];
            const float my_gate = gate[(size_t)t * 128 + batch * 32 + l32];
#pragma unroll 1
            for (int grp = 0; grp < 2; ++grp) {
                { u32x4a8_t pa[8]; uint2 pc[8];
#pragma unroll
                  for (int i = 0; i < 8; ++i) { const int id = __shfl(my_eid, 2 * (grp * 8 + i) + hi); const unsigned char* rp = uv + (size_t)id * ROW6 + l32 * 24; pa[i] = *(const u32x4a8_t*)rp; pc[i] = *(const uint2*)(rp + 16); }
#pragma unroll
                  for (int i = 0; i < 8; ++i) { uint2* wp = (uint2*)(raw + i * 1536); wp[0] = make_uint2(pa[i].x, pa[i].y); wp[1] = make_uint2(pa[i].z, pa[i].w); wp[2] = pc[i]; } }
#pragma unroll 1
                for (int i = 0; i < 8; ++i) {
                    const uint2* rp = (const uint2*)(raw + i * 1536); const uint2 a = rp[0], b = rp[1], c = rp[2];
                    const v6u_t pk6 = {a.x, a.y, b.x, b.y, c.x, c.y}; const v32f_t f = __builtin_amdgcn_cvt_scalef32_pk32_f32_fp6(pk6, 1.0f);
                    f32x2_t dv0 = {0.f, 0.f}, dv1 = {0.f, 0.f};
#pragma unroll
                    for (int j = 0; j < 8; ++j) { const f32x2_t fa = {f[2 * j], f[2 * j + 1]}, fb = {f[16 + 2 * j], f[17 + 2 * j]}, xa = {x[2 * j], x[2 * j + 1]}, xb = {x[16 + 2 * j], x[17 + 2 * j]};
                        dv0 = fa * xa + dv0; dv1 = fb * xb + dv1; }
                    pl[(2 * (grp * 8 + i) + hi) * 32 + l32] = (dv0.x + dv0.y) + (dv1.x + dv1.y);
                }
            }
            float d;
            { const float4* pr = (const float4*)(pl + l32 * 32); float4 s4 = pr[0];
#pragma unroll
              for (int i = 1; i < 8; ++i) { const float4 v = pr[i]; s4.x += v.x; s4.y += v.y; s4.z += v.z; s4.w += v.w; }
              d = ((s4.x + s4.y) + (s4.z + s4.w)) * (1.0f / U_SCALE); }
            const float hv = 0.5f * d * (1.0f + erff(d * 0.70710678118654752f)) * my_gate * (1.0f / V_SCALE);
#pragma unroll 1
            for (int grp = 0; grp < 2; ++grp) {
                { u32x4a8_t pa[8]; uint2 pc[8];
#pragma unroll
                  for (int i = 0; i < 8; ++i) { const int id = __shfl(my_eid, 2 * (grp * 8 + i) + hi); const unsigned char* rp = uv + (size_t)id * ROW6 + 768 + l32 * 24; pa[i] = *(const u32x4a8_t*)rp; pc[i] = *(const uint2*)(rp + 16); }
#pragma unroll
                  for (int i = 0; i < 8; ++i) { uint2* wp = (uint2*)(raw + i * 1536); wp[0] = make_uint2(pa[i].x, pa[i].y); wp[1] = make_uint2(pa[i].z, pa[i].w); wp[2] = pc[i]; } }
#pragma unroll 1
                for (int i = 0; i < 8; ++i) {
                    const float c = __shfl(hv, 2 * (grp * 8 + i) + hi);
                    const uint2* rp = (const uint2*)(raw + i * 1536); const uint2 a = rp[0], b = rp[1], cc = rp[2];
                    const v6u_t pk6 = {a.x, a.y, b.x, b.y, cc.x, cc.y}; const v32f_t f = __builtin_amdgcn_cvt_scalef32_pk32_f32_fp6(pk6, 1.0f);
                    const f32x2_t c2 = {c, c};
#pragma unroll
                    for (int j = 0; j < 16; ++j) { const f32x2_t fj = {f[2 * j], f[2 * j + 1]}; f32x2_t aj = {acc[2 * j], acc[2 * j + 1]}; aj = fj * c2 + aj; acc[2 * j] = aj.x; acc[2 * j + 1] = aj.y; }
                }
            }
        }
        float y[32], s = 0.f;
#pragma unroll
        for (int i = 0; i < 32; ++i) { acc[i] += __shfl_xor(acc[i], 32); y[i] = ALPHA * x[i] + acc[i]; s += y[i]; }
#pragma unroll
        for (int o = 16; o > 0; o >>= 1) s += __shfl_xor(s, o);
        const float mean = s * (1.0f / 1024.0f);
        float s2 = 0.f;
#pragma unroll
        for (int i = 0; i < 32; ++i) { y[i] -= mean; s2 += y[i] * y[i]; }
#pragma unroll
        for (int o = 16; o > 0; o >>= 1) s2 += __shfl_xor(s2, o);
        const float rstd = 1.0f / sqrtf(s2 * (1.0f / 1024.0f) + LN_EPS);
        float o[16];
#pragma unroll
        for (int q4 = 0; q4 < 4; ++q4) {
            const float4 gg = ((const float4*)(g + l32 * 32 + hi * 16))[q4], cc = ((const float4*)(bb + l32 * 32 + hi * 16))[q4];
            float ya[4], yb2[4];
#pragma unroll
            for (int e = 0; e < 4; ++e) { ya[e] = y[4 * q4 + e]; yb2[e] = y[16 + 4 * q4 + e]; }
            asm volatile("" : "+v"(ya[0]), "+v"(ya[1]), "+v"(ya[2]), "+v"(ya[3]), "+v"(yb2[0]), "+v"(yb2[1]), "+v"(yb2[2]), "+v"(yb2[3]));
            const float y0 = hi ? yb2[0] : ya[0], y1 = hi ? yb2[1] : ya[1], y2 = hi ? yb2[2] : ya[2], y3 = hi ? yb2[3] : ya[3];
            o[4 * q4] = y0 * rstd * gg.x + cc.x; o[4 * q4 + 1] = y1 * rstd * gg.y + cc.y; o[4 * q4 + 2] = y2 * rstd * gg.z + cc.z; o[4 * q4 + 3] = y3 * rstd * gg.w + cc.w;
            if (h) ((float4*)(hr + hi * 16))[q4] = make_float4(o[4 * q4], o[4 * q4 + 1], o[4 * q4 + 2], o[4 * q4 + 3]);
        }
        uint4* hbp = (uint4*)(hb + (size_t)t * 1024 + l32 * 32 + hi * 16);
        hbp[0] = make_uint4(pk2(o[0], o[1]), pk2(o[2], o[3]), pk2(o[4], o[5]), pk2(o[6], o[7]));
        hbp[1] = make_uint4(pk2(o[8], o[9]), pk2(o[10], o[11]), pk2(o[12], o[13]), pk2(o[14], o[15]));
    }
}

__device__ __forceinline__ float pack_pl(float v, unsigned pl) { return __uint_as_float((__float_as_uint(v) & ~127u) | pl); }
__device__ __forceinline__ void ins16(float (&s)[16], float x) {
#pragma unroll
    for (int k = 15; k >= 1; --k) s[k] = __builtin_amdgcn_fmed3f(s[k - 1], x, s[k]);
    s[0] = vmax(s[0], x);
}
template <int D> __device__ __forceinline__ void bitonic_stage(float (&c)[16]) {
#pragma unroll
    for (int i = 0; i < 16; ++i) if ((i & D) == 0) { const float a = vmax(c[i], c[i + D]), b = vmin(c[i], c[i + D]); c[i] = a; c[i + D] = b; }
}
__device__ __forceinline__ int decode_key(unsigned pl) { return (int)(32u * ((pl >> 4) & 3u) + (pl & 3u) + 8u * ((pl >> 2) & 3u) + 4u * ((pl >> 6) & 1u)); }
__device__ void route_fast_phase(int WV_, const bf16* qb, const bf16* skb  , int* eid, float* gate, unsigned char* lds, int pm = -1, int pn = 0) {
    const int tid = LTID(WV_), lane = tid & 63, wave = tid >> 6, r32 = lane & 31, hi = lane >> 5;
    unsigned* lidx = (unsigned*)lds + wave * (64 * 33) + lane * 33;
    const int u_first = (pm >= 0) ? 0 : LBID() * NWAVE + wave, u_end = (pm >= 0) ? 2 : (T_ / 32) * 8, u_step = (pm >= 0) ? 1 : LGRID() * NWAVE;
    for (int unit = u_first; unit < u_end; unit += u_step) {
        const int h = (pm >= 0) ? 2 * pn + unit : (unit & 7), t = ((pm >= 0) ? 8 * pm + wave : (unit >> 3)) * 32 + r32;
        float sl[2][16];
#pragma unroll
        for (int p = 0; p < 2; ++p) {
            bf16x8_t qf[4];
            { const bf16* qp = qb + (size_t)t * 1024 + h * 128 + p * 64 + 8 * hi;
#pragma unroll
              for (int ks = 0; ks < 4; ++ks) qf[ks] = *(const bf16x8_t*)(qp + 16 * ks); }
            float s[16];
#pragma unroll
            for (int k = 0; k < 16; ++k) s[k] = -INFINITY;
            const bf16* skp = skb + ((size_t)(h * 2 + p) * 128 + r32) * 64 + 8 * hi;
#pragma unroll
            for (int kt = 0; kt < 4; ++kt) {
                f32x16_t acc;
#pragma unroll
                for (int r = 0; r < 16; ++r) acc[r] = 0.f;
#pragma unroll
                for (int ks = 0; ks < 4; ++ks) { const bf16x8_t a = *(const bf16x8_t*)(skp + (size_t)kt * 32 * 64 + 16 * ks); acc = __builtin_amdgcn_mfma_f32_32x32x16_bf16(a, qf[ks], acc, 0, 0, 0); }
#pragma unroll
                for (int r = 0; r < 16; ++r) ins16(s, pack_pl(acc[r], (unsigned)(kt * 16 + r)));
            }
            const unsigned hb = (unsigned)hi << 6;
#pragma unroll
            for (int k = 0; k < 16; ++k) s[k] = __uint_as_float(__float_as_uint(s[k]) | hb);
            float c[16];
#pragma unroll
            for (int k = 0; k < 16; ++k) c[k] = vmax(s[k], __shfl_xor(s[15 - k], 32));
            bitonic_stage<8>(c); bitonic_stage<4>(c); bitonic_stage<2>(c); bitonic_stage<1>(c);
#pragma unroll
            for (int k = 0; k < 16; ++k) { sl[p][k] = c[k]; lidx[p * 16 + k] = (unsigned)decode_key(__float_as_uint(c[k]) & 127u); }
        }
        float w[16];
#pragma unroll
        for (int k = 0; k < 16; ++k) w[k] = -INFINITY;
#pragma unroll
        for (int i = 0; i < 16; ++i)
#pragma unroll
            for (int j = 0; j < 16; ++j)
                if ((i + 1) * (j + 1) <= 16) { const float v = sl[0][i] + sl[1][j]; ins16(w, __uint_as_float((__float_as_uint(v) & ~255u) | (unsigned)(i * 16 + j))); }
        float e[16], sum = 0.f;
#pragma unroll
        for (int k = 0; k < 16; ++k) { e[k] = expf(w[k] - w[0]); sum += e[k]; }
        const float inv = 1.0f / sum;
        int ide[8]; float gte[8];
#pragma unroll
        for (int k = 0; k < 8; ++k) {
            float wa = w[k], wb = w[8 + k], ea = e[k], eb = e[8 + k];
            asm volatile("" : "+v"(wa), "+v"(wb), "+v"(ea), "+v"(eb));
            const float wv = hi ? wb : wa;
            const unsigned pl = __float_as_uint(wv) & 255u;
            ide[k] = (int)(lidx[pl >> 4] * 128u + lidx[16 + (pl & 15u)]);
            gte[k] = (hi ? eb : ea) * inv;
        }
        int* ep = eid + (size_t)t * 128 + h * 16 + hi * 8; float* gp = gate + (size_t)t * 128 + h * 16 + hi * 8;
        *(int4*)ep = make_int4(ide[0], ide[1], ide[2], ide[3]); *(int4*)(ep + 4) = make_int4(ide[4], ide[5], ide[6], ide[7]);
        *(float4*)gp = make_float4(gte[0], gte[1], gte[2], gte[3]); *(float4*)(gp + 4) = make_float4(gte[4], gte[5], gte[6], gte[7]);
    }
}

typedef float f32x4_t __attribute__((ext_vector_type(4)));
typedef __bf16 bf16x2v __attribute__((ext_vector_type(2)));
__device__ __forceinline__ float dot2bf(unsigned a, unsigned b, float c) { return __builtin_amdgcn_fdot2_f32_bf16(__builtin_bit_cast(bf16x2v, a), __builtin_bit_cast(bf16x2v, b), c, false); }
__device__ __forceinline__ void cnt_gt(int& cnt, unsigned a, unsigned b) { asm("v_cmp_gt_u32_e32 vcc, %1, %2\n\tv_addc_co_u32_e32 %0, vcc, 0, %0, vcc" : "+v"(cnt) : "v"(a), "v"(b) : "vcc"); }
__device__ __forceinline__ void cnt_eq(int& cnt, unsigned a, unsigned b) { asm("v_cmp_eq_u32_e32 vcc, %1, %2\n\tv_addc_co_u32_e32 %0, vcc, 0, %0, vcc" : "+v"(cnt) : "v"(a), "v"(b) : "vcc"); }
__device__ __forceinline__ unsigned flag_gt(unsigned a, unsigned b) { unsigned r; asm("v_cmp_gt_u32_e32 vcc, %1, %2\n\tv_cndmask_b32_e64 %0, 0, 1, vcc" : "=v"(r) : "v"(a), "v"(b) : "vcc"); return r; }
__device__ __forceinline__ unsigned flag_eq(unsigned a, unsigned b) { unsigned r; asm("v_cmp_eq_u32_e32 vcc, %1, %2\n\tv_cndmask_b32_e64 %0, 0, 1, vcc" : "=v"(r) : "v"(a), "v"(b) : "vcc"); return r; }
__device__ __forceinline__ void cnt_ge(int& cnt, unsigned key, unsigned cand) { asm("v_cmp_ge_u32_e32 vcc, %1, %2\n\tv_addc_co_u32_e32 %0, vcc, 0, %0, vcc" : "+v"(cnt) : "v"(key), "v"(cand) : "vcc"); }

template <int CTRL, int RM> __device__ __forceinline__ unsigned dpp0(unsigned v) { return (unsigned)__builtin_amdgcn_update_dpp(0, (int)v, CTRL, RM, 0xf, false); }
template <int CTRL> __device__ __forceinline__ unsigned dppf(unsigned v) { return (unsigned)__builtin_amdgcn_update_dpp(-1, (int)v, CTRL, 0xf, 0xf, false); }
__device__ __forceinline__ unsigned wave_sum_u_dpp(unsigned v) {
    v += dpp0<0xB1, 0xf>(v); v += dpp0<0x4E, 0xf>(v); v += dpp0<0x141, 0xf>(v); v += dpp0<0x140, 0xf>(v);
    return (unsigned)__builtin_amdgcn_readlane((int)v, 0) + (unsigned)__builtin_amdgcn_readlane((int)v, 16) + (unsigned)__builtin_amdgcn_readlane((int)v, 32) + (unsigned)__builtin_amdgcn_readlane((int)v, 48);
}
__device__ __forceinline__ unsigned wave_min_u_dpp(unsigned v) {
    unsigned t;
    t = dppf<0xB1>(v); v = t < v ? t : v; t = dppf<0x4E>(v); v = t < v ? t : v; t = dppf<0x141>(v); v = t < v ? t : v; t = dppf<0x140>(v); v = t < v ? t : v;
    const unsigned a = (unsigned)__builtin_amdgcn_readlane((int)v, 0), b = (unsigned)__builtin_amdgcn_readlane((int)v, 16), c = (unsigned)__builtin_amdgcn_readlane((int)v, 32), d = (unsigned)__builtin_amdgcn_readlane((int)v, 48);
    const unsigned ab = a < b ? a : b, cd = c < d ? c : d; return ab < cd ? ab : cd;
}
__device__ __forceinline__ unsigned wave_incl_scan_u_dpp(unsigned v) {
    v += dpp0<0x111, 0xf>(v); v += dpp0<0x112, 0xf>(v); v += dpp0<0x114, 0xf>(v); v += dpp0<0x118, 0xf>(v);
    v += dpp0<0x142, 0xa>(v);
    v += dpp0<0x143, 0xc>(v);
    return v;
}
typedef __attribute__((address_space(3))) unsigned lds_u32;
template <int SHIFT> __device__ __forceinline__ unsigned radix_pass(const unsigned (&key)[64], unsigned pre, lds_u32* hist, int lane, int& need, int jlim, unsigned L) {
    typedef unsigned u32x4v __attribute__((ext_vector_type(4)));
    typedef __attribute__((address_space(3))) u32x4v lds_u32x4;
    const int fl = 63 - lane;
    { const u32x4v z4 = {0u, 0u, 0u, 0u};
#pragma unroll
      for (int i = 0; i < 8; ++i) ((lds_u32x4*)(hist + fl * 32))[i] = z4; }
    const unsigned hb = (unsigned)(size_t)hist + 4u * (unsigned)(lane & 7);
    const unsigned one = 1u;
    asm volatile("" ::: "memory");
#pragma unroll
    for (int j4 = 0; j4 < 16; ++j4) {
        if (4 * j4 <= jlim) {
            bool grp = true;
            if (SHIFT <= 8) {
                const bool any = ((key[4 * j4] >> (SHIFT + 8)) == pre) | ((key[4 * j4 + 1] >> (SHIFT + 8)) == pre) | ((key[4 * j4 + 2] >> (SHIFT + 8)) == pre) | ((key[4 * j4 + 3] >> (SHIFT + 8)) == pre);
                grp = __ballot(any) != 0ull;
            }
            if (grp) {
#pragma unroll
                for (int e = 0; e < 4; ++e) { const int j = 4 * j4 + e;
                    const unsigned addr = hb + (((key[j] >> SHIFT) & 255u) << 5);
                    unsigned long long sv;
                    if (SHIFT == 24) asm volatile("v_cmp_ge_u32_e32 vcc, %1, %2\n\ts_and_saveexec_b64 %0, vcc\n\tds_add_u32 %3, %4\n\ts_mov_b64 exec, %0" : "=&s"(sv) : "v"(key[j]), "v"(L), "v"(addr), "v"(one) : "vcc", "memory");
                    else { const unsigned t = key[j] >> ((SHIFT + 8) & 31);
                        asm volatile("v_cmp_eq_u32_e32 vcc, %1, %2\n\ts_and_saveexec_b64 %0, vcc\n\tds_add_u32 %3, %4\n\ts_mov_b64 exec, %0" : "=&s"(sv) : "v"(t), "v"(pre), "v"(addr), "v"(one) : "vcc", "memory"); }
                }
            }
        }
    }
    asm volatile("s_waitcnt lgkmcnt(0)" ::: "memory");
    unsigned dsum[4]; unsigned sumL = 0u;
#pragma unroll
    for (int i = 0; i < 4; ++i) { const u32x4v v0 = ((const lds_u32x4*)(hist + fl * 32))[2 * i], v1 = ((const lds_u32x4*)(hist + fl * 32))[2 * i + 1];
        dsum[i] = ((v0.x + v0.y) + (v0.z + v0.w)) + ((v1.x + v1.y) + (v1.z + v1.w)); sumL += dsum[i]; }
    const unsigned incl = wave_incl_scan_u_dpp(sumL);
    const unsigned above = incl - sumL;
    const bool own = (above < (unsigned)need) && ((unsigned)need <= above + sumL);
    const int owner = __ffsll((long long)__ballot(own)) - 1;
    unsigned acc = above; int sel = -1; unsigned cab = 0u;
#pragma unroll
    for (int i = 3; i >= 0; --i) { const unsigned c = dsum[i]; const bool hit = (sel < 0) && (acc + c >= (unsigned)need); cab = hit ? acc : cab; sel = hit ? i : sel; acc += c; }
    const int ow = owner < 0 ? 0 : owner;
    const unsigned digit = (unsigned)__builtin_amdgcn_readlane(sel, ow) + (unsigned)(4 * (63 - ow));
    need -= (int)__builtin_amdgcn_readlane((int)cab, ow);
    return digit;
}

__device__ __forceinline__ void idx_select(const unsigned (&key)[64], unsigned t3, int jlim, lds_u32* hist, int lane, uint2* mrow) {
        unsigned wlo = 0u, whi = 0u;
        unsigned L = wave_min_u_dpp(t3);
        L = L > 1u ? L : 1u;

        int need = 256;
        const unsigned d1 = radix_pass<24>(key, 0u, hist, lane, need, jlim, L);
        const unsigned d2 = radix_pass<16>(key, d1, hist, lane, need, jlim, L);
        const unsigned d3 = radix_pass<8>(key, (d1 << 8) | d2, hist, lane, need, jlim, L);
        const unsigned d4 = radix_pass<0>(key, (d1 << 16) | (d2 << 8) | d3, hist, lane, need, jlim, L);
        const unsigned prefix = (d1 << 24) | (d2 << 16) | (d3 << 8) | d4;

        int ceq = 0;
#pragma unroll
        for (int j = 0; j < 64; ++j) cnt_eq(ceq, key[j], prefix);
        ceq = (int)wave_sum_u_dpp((unsigned)ceq);
        int X = 4096;
        if (ceq != need) {
            int X0 = 0;
#pragma unroll 1
            for (int bit = 11; bit >= 0; --bit) {
                const int c = X0 | (1 << bit);
                int cnt = 0; const int crel = (c - lane + 63) >> 6;
#pragma unroll
                for (int j = 0; j < 64; ++j) cnt_eq(cnt, (key[j] ^ prefix) | ~(unsigned)((j - crel) >> 31), 0u);
                cnt = wave_sum_i(cnt);
                if (cnt < need) X0 = c;
            }
            X = X0 + 1;
        }
        const int xrel = (X - lane + 63) >> 6;
#pragma unroll
        for (int j4 = 0; j4 < 16; ++j4) {
            if (4 * j4 <= jlim) {
#pragma unroll
                for (int e = 0; e < 4; ++e) { const int j = 4 * j4 + e;
                    const bool sel = (key[j] > prefix) || (key[j] == prefix && j < xrel);
                    const unsigned long long bm = __ballot(sel);
                    asm("v_writelane_b32 %0, %1, %2" : "+v"(wlo) : "s"((unsigned)bm), "n"(j));
                    asm("v_writelane_b32 %0, %1, %2" : "+v"(whi) : "s"((unsigned)(bm >> 32)), "n"(j)); }
            }
        }
        mrow[lane] = make_uint2(wlo, whi);
}
#ifndef TS_SEL
#define TS_SEL 0
#endif
#define ITS_B() do { if (TS_SEL >= 20 && TS_SEL <= 25 && WV_ == 0 && LANEID() == 0) ((volatile __attribute__((address_space(3))) unsigned long long*)((__attribute__((address_space(3))) unsigned char*)lds + 147456 - 16 - 32))[0] = __builtin_amdgcn_s_memrealtime(); } while (0)
#define ITS_E(k) do { if ((k) == TS_SEL && WV_ == 0 && LANEID() == 0) { volatile __attribute__((address_space(3))) unsigned long long* w_ = (volatile __attribute__((address_space(3))) unsigned long long*)((__attribute__((address_space(3))) unsigned char*)lds + 147456 - 16 - 32); w_[1] += __builtin_amdgcn_s_memrealtime() - w_[0]; } } while (0)
__device__ void index_fast_phase(int WV_, const bf16* P, unsigned char* mask, float* kmean, float* scratch_all, unsigned* qctr, unsigned char* lds) {
    const int tid = LTID(WV_), lane = tid & 63, wave = tid >> 6, bid = LBID(), G = LGRID();
    float* s_part = (float*)lds;
    ITS_B();
    for (int k = bid; k < 256; k += G) {
        const int b = k >> 6, h = (k >> 4) & 3, blk = k & 15;
        const bf16* kp = P + (size_t)(b * S_ + blk * 256 + wave * 32) * NP + C_KC + h * 64 + lane;
        float a = 0.f;
#pragma unroll 8
        for (int j = 0; j < 32; ++j) a += bf2f(kp[(size_t)j * NP]);
        __syncthreads();
        s_part[wave * 64 + lane] = a;
        __syncthreads();
        if (tid < 64) { float s = 0.f;
#pragma unroll
            for (int w = 0; w < 8; ++w) s += s_part[w * 64 + tid];
            kmean[((b * 4 + h) * 16 + blk) * 64 + tid] = s * (1.0f / 256.0f); }
    }
    ITS_E(22);
    constexpr int IDX_CP = 512 + 4;
    constexpr int IDX_PITCH = 4096 + 32;
    float* scr = scratch_all + (size_t)bid * (16 * IDX_PITCH);
    const int lq = lane & 15, g4 = lane >> 4;
    for (int ui = bid; ui < 1024; ui += G) {
        const int b = ui >> 8, k = ui & 255, tile = (b & 1) ? 255 - k : k, q0 = tile * 16;
        const bf16* Pb = P + (size_t)b * S_ * NP;
        const int ntiles = tile + 1;
        int lane_o = LANEID(); asm volatile("" : "+v"(lane_o));
        const int lane = lane_o, lq = lane & 15, g4 = lane >> 4;
        const int wave = WV_;
        const int qA = q0 + 2 * wave, qB = qA + 1;
        uint2* mrowA = (uint2*)(mask + (size_t)(b * S_ + qA) * 512); uint2* mrowB = (uint2*)(mask + (size_t)(b * S_ + qB) * 512);
        if (tile < 16) {
            unsigned wlo = 0u, whi = 0u, xlo = 0u, xhi = 0u; const int ra = qA - lane * 64, rb = qB - lane * 64;
#pragma unroll
            for (int j = 0; j < 32; ++j) { wlo |= (~(unsigned)((ra - j) >> 31) & 1u) << j; whi |= (~(unsigned)((ra - 32 - j) >> 31) & 1u) << j;
                                           xlo |= (~(unsigned)((rb - j) >> 31) & 1u) << j; xhi |= (~(unsigned)((rb - 32 - j) >> 31) & 1u) << j; }
            mrowA[lane] = make_uint2(wlo, whi); mrowB[lane] = make_uint2(xlo, xhi);
            continue;
        }
        bf16x8_t qf[8]; float wi[8];
        { const bf16* qp = Pb + (size_t)(q0 + lq) * NP + C_QI + 8 * g4;
#pragma unroll
          for (int h = 0; h < 8; ++h) qf[h] = *(const bf16x8_t*)(qp + 32 * h);
          const uint4 wv = *(const uint4*)(Pb + (size_t)(q0 + lq) * NP + C_WI); unpack8(wv, wi); }
        bf16x8_t qch, qcl;
        { typedef unsigned u32x4_t __attribute__((ext_vector_type(4)));
          float qc[8];
#pragma unroll
          for (int i = 0; i < 8; ++i) qc[i] = 0.f;
#pragma unroll
          for (int h = 0; h < 8; ++h) { const u32x4_t w4 = __builtin_bit_cast(u32x4_t, qf[h]);
#pragma unroll
              for (int i = 0; i < 4; ++i) { qc[2 * i] += wi[h] * __uint_as_float(w4[i] << 16); qc[2 * i + 1] += wi[h] * __uint_as_float(w4[i] & 0xffff0000u); } }
          u32x4_t hi4, lo4;
#pragma unroll
          for (int i = 0; i < 4; ++i) { const unsigned hw = cvtpk(qc[2 * i], qc[2 * i + 1]); hi4[i] = hw;
              lo4[i] = cvtpk(qc[2 * i] - __uint_as_float(hw << 16), qc[2 * i + 1] - __uint_as_float(hw & 0xffff0000u)); }
          qch = __builtin_bit_cast(bf16x8_t, hi4); qcl = __builtin_bit_cast(bf16x8_t, lo4); }
        typedef __attribute__((address_space(3))) bf16x8_t lds_bf16x8;
        lds_bf16x8* qops = (lds_bf16x8*)((__attribute__((address_space(3))) unsigned char*)lds + 102656);
        if (wave == 0) {
#pragma unroll
            for (int h = 0; h < 8; ++h) qops[h * 64 + lane] = qf[h];
            qops[8 * 64 + lane] = qch; qops[9 * 64 + lane] = qcl; }
        __syncthreads();
        float* cb0 = (float*)(lds + 69632); float* cb1 = (float*)(lds + 112896);
        const int jlim = q0 >> 6;
        const int jmaxA = (qA - lane) >> 6, jmaxB = (qB - lane) >> 6;
        unsigned keyA[64], keyB[64];
        unsigned a0 = 0u, a1 = 0u, a2 = 0u, a3 = 0u, b0 = 0u, b1 = 0u, b2 = 0u, b3 = 0u;
        const bf16* kbase = Pb + (size_t)lq * NP + C_KI + 8 * g4;
        bf16x8_t nxt = *(const bf16x8_t*)(kbase + (size_t)(wave < ntiles ? wave : 0) * 16 * NP);
#pragma unroll
        for (int c = 0; c < 8; ++c) {
            if (32 * c < ntiles) {
                float* cb = (c & 1) ? cb1 : cb0;
#pragma unroll
                for (int j = 0; j < 4; ++j) {
                    const int kt = 32 * c + wave + 8 * j;
                    const bf16x8_t af = nxt;
                    { const int k = kt + 8; const int kc = k < ntiles ? k : 0; nxt = *(const bf16x8_t*)(kbase + (size_t)kc * 16 * NP); }
                    if (kt < ntiles) {
                        const f32x4_t z = {0.f, 0.f, 0.f, 0.f};
                        f32x4_t sc = __builtin_amdgcn_mfma_f32_16x16x32_bf16(af, qops[8 * 64 + lane], z, 0, 0, 0);
                        sc = __builtin_amdgcn_mfma_f32_16x16x32_bf16(af, qops[9 * 64 + lane], sc, 0, 0, 0);
#pragma unroll
                        for (int hh = 0; hh < 2; ++hh) {
                            f32x4_t a[4];
#pragma unroll
                            for (int h = 0; h < 4; ++h) a[h] = __builtin_amdgcn_mfma_f32_16x16x32_bf16(af, qops[(4 * hh + h) * 64 + lane], z, 0, 0, 0);
#pragma unroll
                            for (int h = 0; h < 4; ++h)
#pragma unroll
                                for (int r = 0; r < 4; ++r) sc[r] = __builtin_fmaf(__builtin_fabsf(a[h][r]), wi[4 * hh + h], sc[r]);
                        }
#pragma unroll
                        for (int r = 0; r < 4; ++r) { sc[r] *= 0.03125f; if (sc[r] == 0.f) sc[r] = 0.f; }
                        *(f32x4_t*)(cb + lq * IDX_CP + (wave + 8 * j) * 16 + 4 * g4) = sc;
                    }
                }
                __syncthreads();
#pragma unroll
                for (int js = 0; js < 8; ++js) {
                    const int slot = 8 * c + js;
                    if (slot <= jlim) {
                        const unsigned ua = __float_as_uint(cb[(2 * wave) * IDX_CP + 64 * js + lane]), ub = __float_as_uint(cb[(2 * wave + 1) * IDX_CP + 64 * js + lane]);
                        const unsigned xa = (ua ^ ((unsigned)((int)ua >> 31) | 0x80000000u)) & ~(unsigned)((jmaxA - slot) >> 31);
                        const unsigned xb = (ub ^ ((unsigned)((int)ub >> 31) | 0x80000000u)) & ~(unsigned)((jmaxB - slot) >> 31);
                        keyA[slot] = xa; keyB[slot] = xb;
                        unsigned n1, n2, n3;
                        asm("v_med3_u32 %0, %1, %2, %3" : "=v"(n3) : "v"(a2), "v"(a3), "v"(xa));
                        asm("v_med3_u32 %0, %1, %2, %3" : "=v"(n2) : "v"(a1), "v"(a2), "v"(xa));
                        asm("v_med3_u32 %0, %1, %2, %3" : "=v"(n1) : "v"(a0), "v"(a1), "v"(xa));
                        a0 = a0 > xa ? a0 : xa; a1 = n1; a2 = n2; a3 = n3;
                        asm("v_med3_u32 %0, %1, %2, %3" : "=v"(n3) : "v"(b2), "v"(b3), "v"(xb));
                        asm("v_med3_u32 %0, %1, %2, %3" : "=v"(n2) : "v"(b1), "v"(b2), "v"(xb));
                        asm("v_med3_u32 %0, %1, %2, %3" : "=v"(n1) : "v"(b0), "v"(b1), "v"(xb));
                        b0 = b0 > xb ? b0 : xb; b1 = n1; b2 = n2; b3 = n3;
                    } else { keyA[slot] = 0u; keyB[slot] = 0u; }
                }
            } else {
#pragma unroll
                for (int js = 0; js < 8; ++js) { keyA[8 * c + js] = 0u; keyB[8 * c + js] = 0u; }
            }
        }
        lds_u32* hist = (lds_u32*)((__attribute__((address_space(3))) unsigned char*)lds + 2048) + wave * 2048;
        idx_select(keyA, a3, jlim, hist, lane, mrowA);
        idx_select(keyB, b3, jlim, hist, lane, mrowB);
        __syncthreads();
    }
}

constexpr int MG_P = 72;
constexpr int MG_TILE_BYTES = 128 * MG_P * 2;
__device__ void merge_fast_phase(int WV_, const unsigned char* G8, const bf16* ys, const bf16* wbt  , bf16* merged, unsigned char* lds) {
    const int tid = LTID(WV_), lane = tid & 63, wave = tid >> 6, r32 = lane & 31, hi = lane >> 5, wt = wave & 3, wd = wave >> 2;
    const int srow0 = tid >> 3, sch = tid & 7;
    for (int tile = LBID(); tile < 1024; tile += LGRID()) {
        const int tok0 = (tile >> 3) * 128, d0 = (tile & 7) * 128;
        f32x16_t mer[2], acc[2];
#pragma unroll
        for (int r = 0; r < 16; ++r) { mer[0][r] = 0.f; mer[1][r] = 0.f; acc[0][r] = 0.f; acc[1][r] = 0.f; }
        uint4 RW00, RW01, RW10, RW11, RY00, RY01, RY10, RY11, RG0, RG1;
        unsigned char* gl = lds + 4 * MG_TILE_BYTES;
        const int grow = tid >> 3, gch = tid & 7;
#define MG_GLOAD(st_, R_) do { const int n_ = (st_) >> 2, kc_ = (st_) & 3; \
            RW##R_##0 = *(const uint4*)(wbt + ((size_t)n_ * 1024 + d0 + srow0) * 256 + kc_ * 64 + sch * 8); \
            RW##R_##1 = *(const uint4*)(wbt + ((size_t)n_ * 1024 + d0 + srow0 + 64) * 256 + kc_ * 64 + sch * 8); \
            RY##R_##0 = *(const uint4*)(ys + (size_t)(tok0 + srow0) * 1024 + n_ * 256 + kc_ * 64 + sch * 8); \
            RY##R_##1 = *(const uint4*)(ys + (size_t)(tok0 + srow0 + 64) * 1024 + n_ * 256 + kc_ * 64 + sch * 8); } while (0)
#define MG_SSTORE(buf_, R_) do { bf16* wl_ = (bf16*)(lds + (buf_) * 2 * MG_TILE_BYTES); bf16* yl_ = (bf16*)(lds + (buf_) * 2 * MG_TILE_BYTES + MG_TILE_BYTES); \
            *(uint4*)(wl_ + srow0 * MG_P + sch * 8) = RW##R_##0; *(uint4*)(wl_ + (srow0 + 64) * MG_P + sch * 8) = RW##R_##1; \
            *(uint4*)(yl_ + srow0 * MG_P + sch * 8) = RY##R_##0; *(uint4*)(yl_ + (srow0 + 64) * MG_P + sch * 8) = RY##R_##1; } while (0)
        __syncthreads();
        MG_GLOAD(0, 0); MG_GLOAD(1, 1);
        MG_SSTORE(0, 0);
        __syncthreads();
#define MG_STAGE(PAR_, OTH_) do { const int buf = PAR_; \
            if (st + 2 < 16) MG_GLOAD(st + 2, PAR_); \
            if ((st & 3) == 1) { const unsigned char* gsrc = G8 + (size_t)(tok0 + grow) * 4096 + (st >> 2) * 1024 + d0 + gch * 16; \
                RG0 = *(const uint4*)gsrc; RG1 = *(const uint4*)(gsrc + (size_t)64 * 4096); } \
            const bf16* wl = (const bf16*)(lds + buf * 2 * MG_TILE_BYTES); const bf16* yl = (const bf16*)(lds + buf * 2 * MG_TILE_BYTES + MG_TILE_BYTES); \
            _Pragma("unroll") for (int ks = 0; ks < 4; ++ks) { \
                const bf16x8_t bq = *(const bf16x8_t*)(yl + (32 * wt + r32) * MG_P + 16 * ks + 8 * hi); \
                const bf16x8_t a0 = *(const bf16x8_t*)(wl + (64 * wd + r32) * MG_P + 16 * ks + 8 * hi); \
                const bf16x8_t a1 = *(const bf16x8_t*)(wl + (64 * wd + 32 + r32) * MG_P + 16 * ks + 8 * hi); \
                acc[0] = __builtin_amdgcn_mfma_f32_32x32x16_bf16(a0, bq, acc[0], 0, 0, 0); \
                acc[1] = __builtin_amdgcn_mfma_f32_32x32x16_bf16(a1, bq, acc[1], 0, 0, 0); } \
            if ((st & 3) == 3) { \
                const int n = st >> 2; \
                const unsigned char* gp = gl + (32 * wt + r32) * 144 + 64 * wd + 4 * hi; (void)n; \
                _Pragma("unroll") for (int dt = 0; dt < 2; ++dt) \
                _Pragma("unroll") for (int g = 0; g < 4; ++g) { \
                        const int gv = *(const int*)(gp + 32 * dt + 8 * g); \
                        mer[dt][4 * g + 0] += acc[dt][4 * g + 0] * __builtin_amdgcn_cvt_f32_fp8(gv, 0); \
                        mer[dt][4 * g + 1] += acc[dt][4 * g + 1] * __builtin_amdgcn_cvt_f32_fp8(gv, 1); \
                        mer[dt][4 * g + 2] += acc[dt][4 * g + 2] * __builtin_amdgcn_cvt_f32_fp8(gv, 2); \
                        mer[dt][4 * g + 3] += acc[dt][4 * g + 3] * __builtin_amdgcn_cvt_f32_fp8(gv, 3); } \
                _Pragma("unroll") for (int r = 0; r < 16; ++r) { acc[0][r] = 0.f; acc[1][r] = 0.f; } } \
            if (st + 1 < 16) MG_SSTORE(OTH_, OTH_); \
            if ((st & 3) == 2) { *(uint4*)(gl + grow * 144 + gch * 16) = RG0; *(uint4*)(gl + (grow + 64) * 144 + gch * 16) = RG1; } \
            __syncthreads(); } while (0)
#pragma unroll 1
        for (int st2 = 0; st2 < 16; st2 += 2) { { const int st = st2; MG_STAGE(0, 1); } { const int st = st2 + 1; MG_STAGE(1, 0); } }
#undef MG_STAGE
#undef MG_GLOAD
#undef MG_SSTORE
        bf16* mp = merged + (size_t)(tok0 + 32 * wt + r32) * 1024 + d0 + 64 * wd + 4 * hi;
#pragma unroll
        for (int dt = 0; dt < 2; ++dt)
#pragma unroll
            for (int g = 0; g < 4; ++g)
                *(uint2*)(mp + 32 * dt + 8 * g) = make_uint2(cvtpk(mer[dt][4 * g], mer[dt][4 * g + 1]), cvtpk(mer[dt][4 * g + 2], mer[dt][4 * g + 3]));
    }
}
#define LAS __attribute__((address_space(3)))
#define XB_TMO      128
#define XB_XCNT(j)  (256  + 64 * (j))
#define XB_XSUB(j)  (1280 + 64 * (j))
#define XB_XGEN(j)  (2304 + 64 * (j))
#define XB_TOP      3328
#define XB_TOPGEN   3392
#define XCD_BAR_WORDS 3456
#define XB_SPIN_CAP (1u << 18)

__device__ __forceinline__ unsigned xb_ld(unsigned* p)              { return __hip_atomic_load(p, __ATOMIC_RELAXED, __HIP_MEMORY_SCOPE_AGENT); }
__device__ __forceinline__ unsigned xb_add(unsigned* p, unsigned v) { return __hip_atomic_fetch_add(p, v, __ATOMIC_RELAXED, __HIP_MEMORY_SCOPE_AGENT); }
__device__ __forceinline__ unsigned xb_xcc_id() { return (unsigned)__builtin_amdgcn_s_getreg((3 << 11) | 20) & 0xFu; }
#define XB_SPIN(cond, bar) do { unsigned _sp = 0; while (cond) { __builtin_amdgcn_s_sleep(1); \
    if ((++_sp & 255u) == 0u) { if (xb_ld(&(bar)[XB_TMO])) break; if (_sp > XB_SPIN_CAP) { atomicAdd(&(bar)[XB_TMO], 1u); break; } } } } while (0)

struct XcdBarrier {
    unsigned* bar; unsigned x;
    volatile LAS unsigned* st;
};

__device__ __forceinline__ XcdBarrier xcd_barrier_post(unsigned* bar, volatile LAS unsigned* st) {
    XcdBarrier b; b.bar = bar; b.x = xb_xcc_id(); b.st = st;
    if (threadIdx.x == 0) (void)xb_add(&bar[XB_XCNT(b.x)], 1u);
    return b;
}
__device__ __forceinline__ void xcd_barrier_complete(unsigned* bar, unsigned x, unsigned& nloc, unsigned& nx) {
    const unsigned G = gridDim.x * gridDim.y * gridDim.z;
    unsigned sum, cnt, mine, sp = 0u;
    for (;;) {
        sum = 0u; cnt = 0u; mine = 0u;
#pragma unroll
        for (unsigned j = 0; j < 16; ++j) { const unsigned c = xb_ld(&bar[XB_XCNT(j)]); sum += c; cnt += (c > 0u) ? 1u : 0u; mine = (j == x) ? c : mine; }
        if (sum == G) break;
        __builtin_amdgcn_s_sleep(1);
        if ((++sp & 255u) == 0u) { if (xb_ld(&bar[XB_TMO])) break; if (sp > XB_SPIN_CAP) { atomicAdd(&bar[XB_TMO], 1u); break; } }
    }
    nloc = mine > 0u ? mine : 1u; nx = cnt > 0u ? cnt : 1u;
}

__device__ __forceinline__ void xcd_barrier(const XcdBarrier& b, int wv_) {
    asm volatile("s_waitcnt vmcnt(0)" ::: "memory");
    __syncthreads();
    if (wv_ == 0 && LANEID() == 0) {
        unsigned* bar = b.bar;
        __builtin_amdgcn_s_waitcnt(0);
        unsigned nloc = b.st[0], nx = b.st[1];
        if (nloc == 0u) { xcd_barrier_complete(bar, b.x, nloc, nx); b.st[0] = nloc; b.st[1] = nx; }
        const unsigned old = xb_add(&bar[XB_XSUB(b.x)], 1u);
        const unsigned gen = old / nloc;
        if (old + 1u == (gen + 1u) * nloc) {
            __builtin_amdgcn_fence(__ATOMIC_RELEASE, "agent");
            asm volatile("s_waitcnt vmcnt(0)" ::: "memory");
            const unsigned og = xb_add(&bar[XB_TOP], 1u);
            const unsigned tg = og / nx;
            if (og + 1u == (tg + 1u) * nx) xb_add(&bar[XB_TOPGEN], 1u);
            else XB_SPIN(xb_ld(&bar[XB_TOPGEN]) == tg, bar);
            __builtin_amdgcn_fence(__ATOMIC_ACQUIRE, "agent");
            xb_add(&bar[XB_XGEN(b.x)], 1u);
            asm volatile("s_waitcnt vmcnt(0)" ::: "memory");
        } else {
            XB_SPIN(xb_ld(&bar[XB_XGEN(b.x)]) == gen, bar);
            __builtin_amdgcn_fence(__ATOMIC_ACQUIRE, "agent");
            asm volatile("s_waitcnt vmcnt(0)" ::: "memory");
        }
    }
    __syncthreads();
}

enum { PH_PRO = 0, PH_GIN, PH_INDEX, PH_ATTN, PH_MERGE, PH_GOUT, PH_LN1, PH_GQ, PH_ROUTE, PH_PEER };
template <int PH> __device__ __forceinline__ void run_phase(int WV_, const Params& p_unused, int l, unsigned char* lds_raw) {
    size_t kaoff_ = 0; asm volatile("" : "+s"(kaoff_));
    typedef const __attribute__((address_space(4))) char* kaptr_t;
    const __attribute__((address_space(4))) Params& p = *(const __attribute__((address_space(4))) Params*)((kaptr_t)__builtin_amdgcn_kernarg_segment_ptr() + kaoff_);
    float* sm = (float*)lds_raw;
    size_t wsoff_ = 0; asm volatile("" : "+s"(wsoff_));
    unsigned char* ws = p.ws + wsoff_;
    float* hbuf = p.out;
    bf16* hb = (bf16*)(ws + WS_HB);
    bf16* P = (bf16*)(ws + WS_P);
    bf16* ys = (bf16*)(ws + WS_YS);
    bf16* mrg = (bf16*)(ws + WS_MRG);
    float* mix = (float*)(ws + WS_MIX);
    float* qb = (float*)(ws + WS_Q);
    unsigned char* mask = ws + WS_MASK;
    int* eid = (int*)(ws + WS_EID);
    float* gate = (float*)(ws + WS_GATE);
    float* kmean = (float*)(ws + WS_KMEAN);
    const float* hin = (l == 0) ? p.in[0] : hbuf;
    if (PH == PH_PRO) { Params pc; for (int i = 0; i < 13; ++i) pc.in[i] = p.in[i]; pc.out = p.out; pc.ws = ws;
        prologue_phase(WV_, pc, sm); convert_tables(WV_, pc);
        for (int i = LBID() * NTHR + LTID(WV_); i < DEPTH_ * 8 * 2 * 128 * 64 / 4; i += LGRID() * NTHR) { const float4 v = ((const float4*)p.in[8])[i]; ((uint2*)(ws + WS_SKB))[i] = make_uint2(pk2(v.x, v.y), pk2(v.z, v.w)); } if (LBID() < 2) build_unit_table((unsigned*)(ws + WS_CTL) + 1024, LBID() * NTHR + LTID(WV_)); }
    else if (PH == PH_GIN) {
        pg8::Gemm g{hb, (const bf16*)(ws + WS_WIN_T + l * WIN_T_BYTES), T_, NP, 1024};
        pg8::StaticOrder S; S.init(T_, NP, (int)LGRID(), (int)LBID());
        pg8::EpiBf16Sig E{P, NP, C_G, ws + WS_G8};
        pg8::gemm_phase<pg8::EpiBf16Sig, pg8::StaticOrder, true, true>(WV_, (PG8_LAS unsigned char*)lds_raw, g, S, E);
    }
    else if (PH == PH_INDEX) index_fast_phase(WV_, P, mask, kmean, (float*)(ws + WS_UV + 48 * MiB), (unsigned*)(ws + WS_CTL) + 64 * l + 16, lds_raw);
    else if (PH == PH_ATTN) attn_fast_phase(WV_, P, mask, kmean, p.in[4] + l * 4, ys, (const unsigned*)(ws + WS_CTL) + 1024, (unsigned*)(ws + WS_CTL) + 64 * l, lds_raw);
    else if (PH == PH_MERGE) merge_fast_phase(WV_, ws + WS_G8, ys, (const bf16*)(ws + WS_WBR_T) + (size_t)l * 4 * 1024 * 256, mrg, lds_raw);
    else if (PH == PH_GOUT) {
        pg8::Gemm g{mrg, (const bf16*)(ws + WS_WOUT_T) + (size_t)l * 1024 * 1024, T_, 1024, 1024};
        pg8::StaticOrder S; S.init(T_, 1024, (int)LGRID(), (int)LBID());
        pg8::EpiResY E{l == 0 ? hin : nullptr, hb, hb, (float*)(ws + WS_STATS) + (size_t)l * T_ * 2, ALPHA};
        pg8::gemm_phase<pg8::EpiResY, pg8::StaticOrder, true, true>(WV_, (PG8_LAS unsigned char*)lds_raw, g, S, E);
    }
    else if (PH == PH_GQ) {
        pg8::Gemm g{hb, (const bf16*)(ws + WS_WQ_T) + (size_t)l * 1024 * 1024, T_, 1024, 1024};
        pg8::StaticOrder S; S.init(T_, 1024, (int)LGRID(), (int)LBID());
        pg8::EpiLnFold E{(bf16*)qb, (const float*)(ws + WS_STATS) + (size_t)l * T_ * 2, (const float*)(ws + WS_COLS) + l * 2048, (const float*)(ws + WS_COLS) + l * 2048 + 1024, LN_EPS};
        pg8::gemm_phase<pg8::EpiLnFold, pg8::StaticOrder, true, true>(WV_, (PG8_LAS unsigned char*)lds_raw, g, S, E);
        pg8::Unit u0;
        if (LGRID() == 256 && S.next(0, u0)) {
            asm volatile("s_waitcnt vmcnt(0)" ::: "memory"); __syncthreads();
            route_fast_phase(WV_, (const bf16*)qb, (const bf16*)(ws + WS_SKB) + (size_t)l * 8 * 2 * 128 * 64, eid, gate, lds_raw, u0.pm, u0.pn);
        }
    }
    else if (PH == PH_ROUTE) { if (LGRID() != 256) route_fast_phase(WV_, (const bf16*)qb, (const bf16*)(ws + WS_SKB) + (size_t)l * 8 * 2 * 128 * 64, eid, gate, lds_raw); }
    else peer_fast_phase(WV_, (l + 1 == DEPTH_) ? hbuf : nullptr, hb, eid, gate, ws + WS_UV + (size_t)l * 24 * MiB, p.in[5] + l * 1024, p.in[6] + l * 1024, p.in[11] + l * 1024, p.in[12] + l * 1024, lds_raw);
}

constexpr int CW_BAR = 4096;
constexpr int LDS_BARST = LDS_BYTES - 16;
__global__ void __launch_bounds__(NTHR, 2) mk_fwd(Params p) {
    extern __shared__ __attribute__((aligned(16))) unsigned char lds_raw[];
    cg::grid_group grid = cg::this_grid();
    const int WV_ = __builtin_amdgcn_readfirstlane((int)threadIdx.x >> 6);
    { volatile LAS unsigned* bst0 = (volatile LAS unsigned*)((LAS unsigned char*)lds_raw + LDS_BARST); if (threadIdx.x < 4) bst0[threadIdx.x] = 0u; }
    __syncthreads();
    volatile LAS unsigned* bst = (volatile LAS unsigned*)((LAS unsigned char*)lds_raw + LDS_BARST);
    { uint4* z = (uint4*)p.ws; const uint4 z4 = make_uint4(0u, 0u, 0u, 0u);
      for (unsigned i = (unsigned)LBID() * NTHR + (unsigned)LTID(WV_); i < (unsigned)(2 * MiB / 16); i += (unsigned)LGRID() * NTHR) z[i] = z4; }
    grid.sync();
    (void)xcd_barrier_post((unsigned*)(p.ws + WS_CTL) + CW_BAR, bst);
#define GRID_BAR() do { XcdBarrier b_; b_.bar = (unsigned*)(p.ws + WS_CTL) + CW_BAR; b_.x = xb_xcc_id(); b_.st = (volatile LAS unsigned*)((LAS unsigned char*)lds_raw + LDS_BARST); xcd_barrier(b_, WV_); } while (0)
    run_phase<PH_PRO>(WV_, p, 0, lds_raw);
    GRID_BAR();
#pragma unroll 1
    for (int l = 0; l < DEPTH_; ++l) {
        run_phase<PH_GIN>(WV_, p, l, lds_raw); GRID_BAR();
        run_phase<PH_INDEX>(WV_, p, l, lds_raw); GRID_BAR();
        run_phase<PH_ATTN>(WV_, p, l, lds_raw); GRID_BAR();
        run_phase<PH_MERGE>(WV_, p, l, lds_raw); GRID_BAR();
        run_phase<PH_GOUT>(WV_, p, l, lds_raw); GRID_BAR();
        run_phase<PH_GQ>(WV_, p, l, lds_raw); if (LGRID() != 256) { GRID_BAR(); run_phase<PH_ROUTE>(WV_, p, l, lds_raw); } GRID_BAR();
        run_phase<PH_PEER>(WV_, p, l, lds_raw); if (l + 1 < DEPTH_) GRID_BAR();
    }
}

extern "C" void kernel_launch(void* const* d_in, const int* in_sizes, int n_in, void* d_out, int out_size, void* d_ws, size_t ws_size, hipStream_t stream) {
    if (n_in != 13 || ws_size < WS_END) { fprintf(stderr, "kernel_launch: unexpected n_in %d / ws_size %zu; nothing launched\n", n_in, ws_size); return; }
    static int grid_blocks = 0;
    if (grid_blocks == 0) {
        int dev = 0, cus = 0, per_cu = 0;
        (void)hipGetDevice(&dev);
        (void)hipDeviceGetAttribute(&cus, hipDeviceAttributeMultiprocessorCount, dev);
        (void)hipFuncSetAttribute((const void*)mk_fwd, hipFuncAttributeMaxDynamicSharedMemorySize, LDS_BYTES);
        (void)hipOccupancyMaxActiveBlocksPerMultiprocessor(&per_cu, (const void*)mk_fwd, NTHR, LDS_BYTES);
        if (per_cu < 1) fprintf(stderr, "kernel_launch: occupancy query reports %d\n", per_cu);
        grid_blocks = cus;
    }
    Params p{};
    for (int i = 0; i < 13; ++i) p.in[i] = (const float*)d_in[i];
    p.out = (float*)d_out; p.ws = (unsigned char*)d_ws;
    void* args[] = {&p};
    hipError_t e = hipLaunchCooperativeKernel((const void*)mk_fwd, dim3(grid_blocks), dim3(NTHR), args, LDS_BYTES, stream);
    if (e != hipSuccess) fprintf(stderr, "cooperative launch failed: %s (grid %d)\n", hipGetErrorString(e), grid_blocks);
}
```

```cpp
#include <hip/hip_runtime.h>
#include <cstdio>
#include <cstdint>
#include <hip/hip_cooperative_groups.h>
namespace cg = cooperative_groups;

__device__ __forceinline__ int LANEID() { int l; asm volatile("v_mbcnt_lo_u32_b32 %0, -1, 0\n\tv_mbcnt_hi_u32_b32 %0, -1, %0" : "=v"(l)); return l; }
__device__ __forceinline__ int LTID(int wv) { return (wv << 6) | LANEID(); }
__device__ __forceinline__ int LBID() { int t = blockIdx.x; asm volatile("" : "+s"(t)); return t; }
__device__ __forceinline__ int LGRID() { int t = gridDim.x; asm volatile("" : "+s"(t)); return t; }
namespace pg8 {
#define PG8_LAS __attribute__((address_space(3)))
typedef unsigned short bf16_t;
typedef short bf16x8 __attribute__((ext_vector_type(8)));
typedef float f32x4 __attribute__((ext_vector_type(4)));
typedef unsigned u32x4 __attribute__((ext_vector_type(4)));
constexpr int BM = 256, BK = 64, HALF = 128, HTB = HALF * BK * 2  , STAGE_BYTES = 8 * HTB, NXCD = 8, WGM = 8;

__host__ __device__ __forceinline__ int lds_byte(int r, int c) { const int st = (r >> 4) * 2 + (c >> 5), rr = r & 15, cc = c & 31, ob = rr * 64 + cc * 2; return st * 1024 + (ob ^ (((ob >> 9) & 1) << 5)); }
__host__ __device__ __forceinline__ void stage_rc(int b, int& R, int& C) { const int st = b / 1024, sb = b % 1024, swz = sb ^ (((sb >> 9) & 1) << 5); R = (st >> 1) * 16 + swz / 64; C = (st & 1) * 32 + (swz % 64) / 2; }
__host__ __device__ __forceinline__ int perm32(int rho) { const int n = rho >> 4, i = rho & 15; return 8 * (i >> 2) + 4 * n + (i & 3); }

struct Unit { int pm, pn; };
struct Gemm { const bf16_t* A; const bf16_t* Bt; int M, N, K; };

struct StaticOrder {
    int nM, nN, nwg, G, c;
    __host__ __device__ void init(int M, int N, int G_, int c_) { nM = M / BM; nN = N / BM; nwg = nM * nN; G = G_; c = c_; }
    __host__ __device__ bool next(int i, Unit& u) const {
        const long L = (long)i * G + c; if (L >= nwg) return false;
        int wgid = (int)L; { const int q = nwg / NXCD, r = nwg % NXCD, xcd = wgid % NXCD, off = wgid / NXCD; wgid = (xcd < r ? xcd * (q + 1) : r * (q + 1) + (xcd - r) * q) + off; }
        const int nig = WGM * nN, gid = wgid / nig, fm = gid * WGM, gsz = (nM - fm) < WGM ? (nM - fm) : WGM;
        u.pm = fm + ((wgid % nig) % gsz); u.pn = (wgid % nig) / gsz; return true;
    }
    __device__ __forceinline__ void a_ready(const Unit&) const {}
    __device__ __forceinline__ void done(const Unit&) const {}
};

__device__ __forceinline__ unsigned cvt_pk_bf16(float lo, float hi) { unsigned r; asm volatile("v_cvt_pk_bf16_f32 %0, %1, %2" : "=v"(r) : "v"(lo), "v"(hi)); return r; }
typedef float f32x2 __attribute__((ext_vector_type(2)));
__device__ __forceinline__ f32x2 gelu_pk(f32x2 v) {
    const f32x2 av = __builtin_elementwise_abs(v), d = av * 0.2316418882f + 1.0f;
    f32x2 t; t.x = __builtin_amdgcn_rcpf(d.x); t.y = __builtin_amdgcn_rcpf(d.y);
    f32x2 q = t * 0.5307027145f + (-0.7265760135f); q = q * t + 0.7107068705f; q = q * t + (-0.142248368f); q = q * t + 0.127414796f; q = q * t;
    const f32x2 s = (v * v) * (-0.72134752044f);
    f32x2 e; e.x = __builtin_amdgcn_exp2f(s.x); e.y = __builtin_amdgcn_exp2f(s.y);
    const f32x2 m = v * (q * e), r = v - m;
    f32x2 o; o.x = v.x < 0.f ? m.x : r.x; o.y = v.y < 0.f ? m.y : r.y; return o;
}

template <int ACT  > struct EpiBf16 {
    static constexpr bool PERM = true, AFTER_DRAIN = false; static_assert(ACT == 0 || ACT == 1, "EpiBf16: ACT is 0 (none) or 1 (gelu_pk)");
    bf16_t* O; int ldc; const float* bias; int split_cols; size_t split_stride; float scale0;
    __device__ __forceinline__ void operator()(const f32x4 (&acc)[2][2][4][2], const Unit& u, int wr, int wc, int fr, int fq) const {
        { int ln_ = LANEID(); asm volatile("" : "+v"(ln_)); fr = ln_ & 15; fq = ln_ >> 4; }
        const int row0 = u.pm * BM + wr * 64 + fr; int colt = u.pn * BM; bf16_t* base = O;
        float sc = 1.f; if (split_cols) { const int t = colt / split_cols; base += (size_t)t * split_stride; colt -= t * split_cols; if (t == 0) sc = scale0; }
        const int col0 = colt + wc * 32 + 8 * fq, bcol0 = u.pn * BM + wc * 32 + 8 * fq;
        f32x4 bv[2][2];
#pragma unroll
        for (int bj = 0; bj < 2; ++bj)
#pragma unroll
            for (int n = 0; n < 2; ++n) bv[bj][n] = bias ? *(const f32x4*)(bias + bcol0 + bj * HALF + 4 * n) : (f32x4){0.f, 0.f, 0.f, 0.f};
#pragma unroll
        for (int ai = 0; ai < 2; ++ai)
#pragma unroll
            for (int m = 0; m < 4; ++m) { bf16_t* rowp = base + (size_t)(row0 + ai * HALF + m * 16) * ldc + col0;
#pragma unroll
                for (int bj = 0; bj < 2; ++bj) { f32x4 v0 = acc[ai][bj][m][0] + bv[bj][0], v1 = acc[ai][bj][m][1] + bv[bj][1];
                    if (ACT == 1) { f32x2 a = gelu_pk((f32x2){v0[0], v0[1]}), b = gelu_pk((f32x2){v0[2], v0[3]}), c = gelu_pk((f32x2){v1[0], v1[1]}), d = gelu_pk((f32x2){v1[2], v1[3]});
                        v0 = (f32x4){a.x, a.y, b.x, b.y}; v1 = (f32x4){c.x, c.y, d.x, d.y}; }
                    v0 = v0 * sc; v1 = v1 * sc; u32x4 w; w.x = cvt_pk_bf16(v0[0], v0[1]); w.y = cvt_pk_bf16(v0[2], v0[3]); w.z = cvt_pk_bf16(v1[0], v1[1]); w.w = cvt_pk_bf16(v1[2], v1[3]);
                    *(u32x4*)(rowp + bj * HALF) = w; } }
    }
};
template <class Epi, class Sched, bool ALIGN_EPI = false, bool SP2 = false>
__device__ __forceinline__ void gemm_phase(int WV_, PG8_LAS unsigned char* lds, const Gemm g, const Sched& S, const Epi& E) {
    const int tid = LTID(WV_), wid = __builtin_amdgcn_readfirstlane(tid >> 6), lane = tid & 63, wr = wid >> 2, wc = wid & 3, fr = lane & 15, fq = lane >> 4;
    const int K = g.K, nt = K / BK;
    unsigned voffA[2], voffB[2];
#pragma unroll
    for (int i = 0; i < 2; ++i) { int R, C; stage_rc(tid * 16 + i * 8192, R, C); const int Rb = Epi::PERM ? ((R & ~31) + perm32(R & 31)) : R;
        voffA[i] = (unsigned)(R * K + C) * 2u; voffB[i] = (unsigned)(Rb * K + C) * 2u; }
    const size_t kstep = (size_t)(BK * 2);
    const size_t hstep = (size_t)HALF * K * 2;
    const size_t tstep = 2 * hstep;
    const unsigned ldsw = (unsigned)wid * 1024u;
    const int aoff = lds_byte(wr * 64 + fr, fq * 8), boff = lds_byte(wc * 32 + fr, fq * 8);
#define PG8_SA(b, h) (((b) * 2 + (h)) * HTB)
#define PG8_SB(b, h) ((4 + (b) * 2 + (h)) * HTB)
#define PG8_STAGE(bufoff, gbase, voff) do { _Pragma("unroll") for (int _i = 0; _i < 2; ++_i) \
        __builtin_amdgcn_global_load_lds((const unsigned*)((const char*)(gbase) + (voff)[_i]), (PG8_LAS unsigned*)(lds + (bufoff) + ldsw + _i * 8192), 16, 0, 0); } while (0)
#define PG8_LDA(dst, b, h) do { _Pragma("unroll") for (int m = 0; m < 4; ++m) _Pragma("unroll") for (int k = 0; k < 2; ++k) dst[m][k] = *(const PG8_LAS bf16x8*)(lds + PG8_SA(b, h) + aoff + m * 2048 + k * 1024); } while (0)
#define PG8_LDB(dst, b, h) do { _Pragma("unroll") for (int n = 0; n < 2; ++n) _Pragma("unroll") for (int k = 0; k < 2; ++k) dst[n][k] = *(const PG8_LAS bf16x8*)(lds + PG8_SB(b, h) + boff + n * 2048 + k * 1024); } while (0)
#define PG8_MMA(ai, bj, At, Bt) do { __builtin_amdgcn_s_setprio(1); _Pragma("unroll") for (int m = 0; m < 4; ++m) _Pragma("unroll") for (int n = 0; n < 2; ++n) _Pragma("unroll") for (int k = 0; k < 2; ++k) \
        acc[ai][bj][m][n] = __builtin_amdgcn_mfma_f32_16x16x32_bf16(Bt[n][k], At[m][k], acc[ai][bj][m][n], 0, 0, 0); __builtin_amdgcn_s_setprio(0); } while (0)
#define PG8_WAIT_V(n) asm volatile("s_waitcnt vmcnt(" #n ")" ::: "memory")
#define PG8_WAIT_L(n) asm volatile("s_waitcnt lgkmcnt(" #n ")" ::: "memory")
#define PG8_BAR __builtin_amdgcn_s_barrier()
#define PG8_SCHED __builtin_amdgcn_sched_barrier(0)
    Unit cur, nxt; int ui = 0;
    if (!S.next(0, cur)) return;
    f32x4 acc[2][2][4][2];
#pragma unroll
    for (int a = 0; a < 2; ++a)
#pragma unroll
        for (int b = 0; b < 2; ++b)
#pragma unroll
            for (int m = 0; m < 4; ++m)
#pragma unroll
                for (int n = 0; n < 2; ++n) acc[a][b][m][n] = (f32x4){0.f, 0.f, 0.f, 0.f};
    bf16x8 At[4][2], B0[2][2], B1[2][2];
    const char* cA = (const char*)g.A + (size_t)cur.pm * tstep; const char* cB = (const char*)g.Bt + (size_t)cur.pn * tstep;
    S.a_ready(cur);
    if constexpr (SP2) {
        PG8_STAGE(PG8_SB(0, 0), cB, voffB); PG8_STAGE(PG8_SB(0, 1), cB + hstep, voffB); PG8_STAGE(PG8_SA(0, 0), cA, voffA); PG8_STAGE(PG8_SA(0, 1), cA + hstep, voffA);
        if (wr == 1) PG8_BAR;
        PG8_WAIT_V(2); PG8_BAR;
        PG8_STAGE(PG8_SB(1, 0), cB + kstep, voffB); PG8_STAGE(PG8_SA(1, 0), cA + kstep, voffA); PG8_STAGE(PG8_SB(1, 1), cB + hstep + kstep, voffB);
        PG8_WAIT_V(6); PG8_BAR;
    } else {
        PG8_STAGE(PG8_SB(0, 0), cB, voffB); PG8_STAGE(PG8_SA(0, 0), cA, voffA); PG8_STAGE(PG8_SB(0, 1), cB + hstep, voffB); PG8_STAGE(PG8_SA(0, 1), cA + hstep, voffA);
        if (wr == 1) PG8_BAR;
        PG8_WAIT_V(4); PG8_BAR;
        PG8_STAGE(PG8_SB(1, 0), cB + kstep, voffB); PG8_STAGE(PG8_SA(1, 0), cA + kstep, voffA); PG8_STAGE(PG8_SB(1, 1), cB + hstep + kstep, voffB);
        PG8_WAIT_V(6); PG8_BAR;
    }
    for (;;) {
        const bool has_next = S.next(ui + 1, nxt);
        const char* nA = has_next ? (const char*)g.A + (size_t)nxt.pm * tstep : cA; const char* nB = has_next ? (const char*)g.Bt + (size_t)nxt.pn * tstep : cB;
        for (int t = 0; t < nt; t += 2) {
            const bool last = (t == nt - 2);
            const char* a1 = cA + (size_t)(t + 1) * kstep;
            const char* a2 = last ? nA : cA + (size_t)(t + 2) * kstep; const char* b2 = last ? nB : cB + (size_t)(t + 2) * kstep;
            const char* a3 = a2 + kstep; const char* b3 = b2 + kstep;
            if (last && has_next) S.a_ready(nxt);
            if constexpr (SP2) {
            PG8_LDB(B0, 0, 0); PG8_LDB(B1, 0, 1); PG8_SCHED; PG8_LDA(At, 0, 0); PG8_STAGE(PG8_SA(1, 1), a1 + hstep, voffA);
            PG8_WAIT_V(8); PG8_WAIT_L(0); PG8_BAR; PG8_MMA(0, 0, At, B0); PG8_MMA(0, 1, At, B1); PG8_BAR; PG8_SCHED;
            PG8_LDA(At, 0, 1); PG8_STAGE(PG8_SB(0, 0), b2, voffB); PG8_STAGE(PG8_SB(0, 1), b2 + hstep, voffB); PG8_STAGE(PG8_SA(0, 0), a2, voffA);
            PG8_WAIT_V(8); PG8_WAIT_L(0); PG8_BAR; PG8_MMA(1, 0, At, B0); PG8_MMA(1, 1, At, B1); PG8_BAR; PG8_SCHED;
            PG8_LDB(B0, 1, 0); PG8_LDB(B1, 1, 1); PG8_SCHED; PG8_LDA(At, 1, 0); PG8_STAGE(PG8_SA(0, 1), a2 + hstep, voffA);
            PG8_WAIT_V(8); PG8_WAIT_L(0); PG8_BAR; PG8_MMA(0, 0, At, B0); PG8_MMA(0, 1, At, B1); PG8_BAR; PG8_SCHED;
            PG8_LDA(At, 1, 1); PG8_STAGE(PG8_SB(1, 0), b3, voffB); PG8_STAGE(PG8_SB(1, 1), b3 + hstep, voffB); PG8_STAGE(PG8_SA(1, 0), a3, voffA);
            PG8_WAIT_V(8); PG8_WAIT_L(0); PG8_BAR; PG8_MMA(1, 0, At, B0); PG8_MMA(1, 1, At, B1); PG8_BAR; PG8_SCHED;
            } else {
            PG8_LDB(B0, 0, 0); PG8_SCHED; PG8_LDA(At, 0, 0); PG8_STAGE(PG8_SA(1, 1), a1 + hstep, voffA);
            PG8_WAIT_L(8); PG8_BAR; PG8_WAIT_L(0); PG8_MMA(0, 0, At, B0); PG8_BAR; PG8_SCHED;
            PG8_LDB(B1, 0, 1); PG8_STAGE(PG8_SB(0, 0), b2, voffB);
            PG8_BAR; PG8_WAIT_L(0); PG8_MMA(0, 1, At, B1); PG8_BAR;
            PG8_LDA(At, 0, 1); PG8_STAGE(PG8_SA(0, 0), a2, voffA);
            PG8_BAR; PG8_WAIT_L(0); PG8_MMA(1, 0, At, B0); PG8_BAR; PG8_SCHED;
            PG8_STAGE(PG8_SB(0, 1), b2 + hstep, voffB);
            PG8_WAIT_V(6); PG8_BAR; PG8_MMA(1, 1, At, B1); PG8_BAR;
            PG8_LDB(B0, 1, 0); PG8_SCHED; PG8_LDA(At, 1, 0); PG8_STAGE(PG8_SA(0, 1), a2 + hstep, voffA);
            PG8_WAIT_L(8); PG8_BAR; PG8_WAIT_L(0); PG8_MMA(0, 0, At, B0); PG8_BAR; PG8_SCHED;
            PG8_LDB(B1, 1, 1); PG8_STAGE(PG8_SB(1, 0), b3, voffB);
            PG8_BAR; PG8_WAIT_L(0); PG8_MMA(0, 1, At, B1); PG8_BAR;
            PG8_LDA(At, 1, 1); PG8_STAGE(PG8_SA(1, 0), a3, voffA);
            PG8_BAR; PG8_WAIT_L(0); PG8_MMA(1, 0, At, B0); PG8_BAR; PG8_SCHED;
            PG8_STAGE(PG8_SB(1, 1), b3 + hstep, voffB);
            PG8_WAIT_V(6); PG8_BAR; PG8_MMA(1, 1, At, B1); PG8_BAR;
            }
        }
        if constexpr (ALIGN_EPI) { if (wr == 0) PG8_BAR; }
        if constexpr (!Epi::AFTER_DRAIN) { E(acc, cur, wr, wc, fr, fq); S.done(cur); }
        if (!has_next) break;
#pragma unroll
        for (int a = 0; a < 2; ++a)
#pragma unroll
            for (int b = 0; b < 2; ++b)
#pragma unroll
                for (int m = 0; m < 4; ++m)
#pragma unroll
                    for (int n = 0; n < 2; ++n) acc[a][b][m][n] = (f32x4){0.f, 0.f, 0.f, 0.f};
        cur = nxt; cA = nA; cB = nB; ++ui;
        if constexpr (ALIGN_EPI) { if (wr == 1) PG8_BAR; }
    }
    PG8_WAIT_V(0);
    if constexpr (!ALIGN_EPI) { if (wr == 0) PG8_BAR; }
    PG8_BAR;
    if constexpr (Epi::AFTER_DRAIN) { E.fused(acc, cur, wr, wc, fr, fq, lds, wid, lane); S.done(cur); }
#undef PG8_SA
#undef PG8_SB
#undef PG8_STAGE
#undef PG8_LDA
#undef PG8_LDB
#undef PG8_MMA
#undef PG8_WAIT_V
#undef PG8_WAIT_L
#undef PG8_BAR
#undef PG8_SCHED
}
}
namespace pg8 {
struct EpiF32 {
    static constexpr bool PERM = false, AFTER_DRAIN = false;
    float* O; int ldc;
    __device__ __forceinline__ void operator()(const f32x4 (&acc)[2][2][4][2], const Unit& u, int wr, int wc, int fr, int fq) const {
        { int ln_ = LANEID(); asm volatile("" : "+v"(ln_)); fr = ln_ & 15; fq = ln_ >> 4; }
        const int row0 = u.pm * BM + wr * 64 + fr, col0 = u.pn * BM + wc * 32 + 4 * fq;
#pragma unroll
        for (int ai = 0; ai < 2; ++ai)
#pragma unroll
            for (int m = 0; m < 4; ++m) { float* rowp = O + (size_t)(row0 + ai * HALF + m * 16) * ldc + col0;
#pragma unroll
                for (int bj = 0; bj < 2; ++bj)
#pragma unroll
                    for (int n = 0; n < 2; ++n) *(f32x4*)(rowp + bj * HALF + n * 16) = acc[ai][bj][m][n]; }
    }
};
struct EpiResY {
    static constexpr bool PERM = false, AFTER_DRAIN = false;
    const float* hin; const bf16_t* hinb; bf16_t* yb; float* stats; float alpha;
    __device__ __forceinline__ void operator()(const f32x4 (&acc)[2][2][4][2], const Unit& u, int wr, int wc, int fr, int fq) const {
        { int ln_ = LANEID(); asm volatile("" : "+v"(ln_)); fr = ln_ & 15; fq = ln_ >> 4; }
        const int row0 = u.pm * BM + wr * 64 + fr, col0 = u.pn * BM + wc * 32 + 4 * fq;
#pragma unroll
        for (int ai = 0; ai < 2; ++ai)
#pragma unroll
            for (int m = 0; m < 4; ++m) {
                const int row = row0 + ai * HALF + m * 16;
                float s = 0.f, s2 = 0.f;
#pragma unroll
                for (int bj = 0; bj < 2; ++bj)
#pragma unroll
                    for (int n = 0; n < 2; ++n) {
                        const size_t off = (size_t)row * 1024 + col0 + bj * HALF + n * 16;
                        f32x4 hv;
                        if (hin) hv = *(const f32x4*)(hin + off);
                        else { typedef unsigned u32x2r __attribute__((ext_vector_type(2))); const u32x2r hw = *(const u32x2r*)(hinb + off);
                            hv[0] = __uint_as_float(hw.x << 16); hv[1] = __uint_as_float(hw.x & 0xffff0000u); hv[2] = __uint_as_float(hw.y << 16); hv[3] = __uint_as_float(hw.y & 0xffff0000u); }
                        const f32x4 y = hv * alpha + acc[ai][bj][m][n];
                        typedef unsigned u32x2v __attribute__((ext_vector_type(2)));
                        u32x2v w; w.x = cvt_pk_bf16(y[0], y[1]); w.y = cvt_pk_bf16(y[2], y[3]);
                        *(u32x2v*)(yb + off) = w;
                        s += (y[0] + y[1]) + (y[2] + y[3]); s2 += (y[0] * y[0] + y[1] * y[1]) + (y[2] * y[2] + y[3] * y[3]);
                    }
                s += __shfl_xor(s, 16); s += __shfl_xor(s, 32); s2 += __shfl_xor(s2, 16); s2 += __shfl_xor(s2, 32);
                if (fq == 0) { atomicAdd(stats + 2 * (size_t)row, s); atomicAdd(stats + 2 * (size_t)row + 1, s2); }
            }
    }
};
struct EpiLnFold {
    static constexpr bool PERM = true, AFTER_DRAIN = false;
    bf16_t* O; const float* stats; const float* colsum; const float* colbias; float eps;
    __device__ __forceinline__ void operator()(const f32x4 (&acc)[2][2][4][2], const Unit& u, int wr, int wc, int fr, int fq) const {
        { int ln_ = LANEID(); asm volatile("" : "+v"(ln_)); fr = ln_ & 15; fq = ln_ >> 4; }
        const int row0 = u.pm * BM + wr * 64 + fr, col0 = u.pn * BM + wc * 32 + 8 * fq;
        f32x4 cs[2][2], cb[2][2];
#pragma unroll
        for (int bj = 0; bj < 2; ++bj)
#pragma unroll
            for (int n = 0; n < 2; ++n) { cs[bj][n] = *(const f32x4*)(colsum + col0 + bj * HALF + 4 * n); cb[bj][n] = *(const f32x4*)(colbias + col0 + bj * HALF + 4 * n); }
#pragma unroll
        for (int ai = 0; ai < 2; ++ai)
#pragma unroll
            for (int m = 0; m < 4; ++m) {
                const int row = row0 + ai * HALF + m * 16;
                const float sm_ = stats[2 * (size_t)row], sq_ = stats[2 * (size_t)row + 1];
                const float mean = sm_ * (1.0f / 1024.0f);
                const float rstd = 1.0f / sqrtf(fmaxf(sq_ * (1.0f / 1024.0f) - mean * mean, 0.f) + eps);
                bf16_t* rowp = O + (size_t)row * 1024 + col0;
#pragma unroll
                for (int bj = 0; bj < 2; ++bj) {
                    const f32x4 v0 = (acc[ai][bj][m][0] - cs[bj][0] * mean) * rstd + cb[bj][0], v1 = (acc[ai][bj][m][1] - cs[bj][1] * mean) * rstd + cb[bj][1];
                    u32x4 w; w.x = cvt_pk_bf16(v0[0], v0[1]); w.y = cvt_pk_bf16(v0[2], v0[3]); w.z = cvt_pk_bf16(v1[0], v1[1]); w.w = cvt_pk_bf16(v1[2], v1[3]);
                    *(u32x4*)(rowp + bj * HALF) = w;
                }
            }
    }
};
__device__ __forceinline__ unsigned cvt_pk_bf16_t(float lo, float hi) { unsigned r; asm volatile("s_nop 0\n\tv_cvt_pk_bf16_f32 %0, %1, %2" : "=v"(r) : "v"(lo), "v"(hi)); return r; }
struct EpiBf16Sig {
    static constexpr bool PERM = true, AFTER_DRAIN = false;
    bf16_t* O; int ldc; int sig_col0; unsigned char* G8;
    __device__ __forceinline__ void operator()(const f32x4 (&acc)[2][2][4][2], const Unit& u, int wr, int wc, int fr, int fq) const {
        { int ln_ = LANEID(); asm volatile("" : "+v"(ln_)); fr = ln_ & 15; fq = ln_ >> 4; }
        const int row0 = u.pm * BM + wr * 64 + fr; const int col0 = u.pn * BM + wc * 32 + 8 * fq;
#pragma unroll
        for (int bj = 0; bj < 2; ++bj) {
            if (col0 + bj * HALF >= sig_col0) {
                { const int gc = col0 + bj * HALF - sig_col0;
                  if (gc < 4096) {
#pragma unroll
                    for (int ai = 0; ai < 2; ++ai)
#pragma unroll
                        for (int m = 0; m < 4; ++m) {
                            f32x4 v0 = acc[ai][bj][m][0], v1 = acc[ai][bj][m][1];
#pragma unroll
                            for (int e = 0; e < 4; ++e) { v0[e] = __builtin_amdgcn_rcpf(1.f + __builtin_amdgcn_exp2f(-1.44269504f * v0[e])); v1[e] = __builtin_amdgcn_rcpf(1.f + __builtin_amdgcn_exp2f(-1.44269504f * v1[e])); }
                            int w0 = __builtin_amdgcn_cvt_pk_fp8_f32(v0[0], v0[1], 0, false); w0 = __builtin_amdgcn_cvt_pk_fp8_f32(v0[2], v0[3], w0, true);
                            int w1 = __builtin_amdgcn_cvt_pk_fp8_f32(v1[0], v1[1], 0, false); w1 = __builtin_amdgcn_cvt_pk_fp8_f32(v1[2], v1[3], w1, true);
                            typedef int i32x2v __attribute__((ext_vector_type(2)));
                            i32x2v w; w.x = w0; w.y = w1;
                            *(i32x2v*)(G8 + (size_t)(row0 + ai * HALF + m * 16) * 4096 + gc) = w; }
                  } }
            } else {
#pragma unroll
                for (int ai = 0; ai < 2; ++ai)
#pragma unroll
                    for (int m = 0; m < 4; ++m) { bf16_t* rowp = O + (size_t)(row0 + ai * HALF + m * 16) * ldc + col0;
                        const f32x4 v0 = acc[ai][bj][m][0], v1 = acc[ai][bj][m][1];
                        u32x4 w; w.x = cvt_pk_bf16(v0[0], v0[1]); w.y = cvt_pk_bf16(v0[2], v0[3]); w.z = cvt_pk_bf16(v1[0], v1[1]); w.w = cvt_pk_bf16(v1[2], v1[3]);
                        *(u32x4*)(rowp + bj * HALF) = w; }
            }
        }
    }
};
}

typedef unsigned short bf16;
constexpr int T_ = 16384, S_ = 4096, NBATCH = 4, D_ = 1024, NCOL = 6824, NP = 6912, DEPTH_ = 2;
constexpr int C_QA = 0, C_KA = 256, C_VA = 320, C_QI = 384, C_KI = 640, C_WI = 672, C_QB = 680, C_KB = 936, C_VB = 1064,
              C_QC = 1192, C_KC = 1448, C_VC = 1704, C_QD = 1960, C_KD = 2216, C_VD = 2472, C_G = 2728;
constexpr int NTHR = 512, NWAVE = 8;
constexpr float ALPHA = 1.41421356237309515f;
constexpr float LN_EPS = 1e-5f;
constexpr size_t MiB = 1u << 20;
constexpr size_t WS_STATS = 1 * MiB  , WS_COLS = 1 * MiB + 512 * 1024  ;
constexpr size_t WS_CTL = 0, WS_WIN_T = 2 * MiB, WS_WOUT_T = 30 * MiB, WS_WQ_T = 34 * MiB, WS_WBR_T = 38 * MiB, WS_HB = 42 * MiB,
                 WS_P = 74 * MiB, WS_MIX = 74 * MiB  , WS_Q = 138 * MiB  , WS_G8 = 428 * MiB  , WS_YS = 290 * MiB, WS_MRG = 322 * MiB,
                 WS_MASK = 354 * MiB, WS_EID = 362 * MiB, WS_GATE = 370 * MiB, WS_KMEAN = 378 * MiB, WS_SKB = 379 * MiB, WS_UV = 380 * MiB, WS_END = 508 * MiB;
constexpr size_t WIN_T_BYTES = (size_t)NP * 1024 * 2;
constexpr int LDS_BYTES = 144 * 1024;

struct Params { const float* in[13]; float* out; unsigned char* ws; };

__device__ __forceinline__ float bf2f(bf16 v) { return __uint_as_float((unsigned)v << 16); }
__device__ __forceinline__ unsigned f2bf(float f) { unsigned u = __float_as_uint(f); return (u + 0x7fffu + ((u >> 16) & 1u)) >> 16; }
__device__ __forceinline__ unsigned pk2(float lo, float hi) { return f2bf(lo) | (f2bf(hi) << 16); }
__device__ __forceinline__ void unpack8(const uint4 v, float* o) {
    o[0] = __uint_as_float(v.x << 16); o[1] = __uint_as_float(v.x & 0xffff0000u); o[2] = __uint_as_float(v.y << 16); o[3] = __uint_as_float(v.y & 0xffff0000u);
    o[4] = __uint_as_float(v.z << 16); o[5] = __uint_as_float(v.z & 0xffff0000u); o[6] = __uint_as_float(v.w << 16); o[7] = __uint_as_float(v.w & 0xffff0000u);
}
__device__ __forceinline__ float wave_sum(float v) {
#pragma unroll
    for (int o = 32; o > 0; o >>= 1) v += __shfl_xor(v, o);
    return v;
}
__device__ __forceinline__ float wave_max(float v) {
#pragma unroll
    for (int o = 32; o > 0; o >>= 1) v = fmaxf(v, __shfl_xor(v, o));
    return v;
}
__device__ __forceinline__ int wave_sum_i(int v) {
#pragma unroll
    for (int o = 32; o > 0; o >>= 1) v += __shfl_xor(v, o);
    return v;
}
__device__ __forceinline__ float logsig(float x) { return fminf(x, 0.f) - log1pf(expf(-fabsf(x))); }

__device__ void transpose_items(int WV_, const float* W, int K, int N, bf16* WT, float* sm, int item0, int nitems_total, int item_stride,
                                const float* rs_g = nullptr, const float* rs_b = nullptr, float* colsum = nullptr, float* colbias = nullptr) {
    const int tid = LTID(WV_);
    const int nkb = K / 64, nnb = (N + 63) / 64;
    for (int it = item0; it < nkb * nnb; it += item_stride) {
        const int kb = it % nkb, nb = it / nkb, k0 = kb * 64, n0 = nb * 64;
        __syncthreads();
        for (int e = tid; e < 64 * 64; e += NTHR) { const int kk = e >> 6, nn = e & 63; sm[kk * 65 + nn] = (n0 + nn < N) ? W[(size_t)(k0 + kk) * N + n0 + nn] : 0.f; }
        __syncthreads();
        if (rs_g) {
            if (tid < 64) { float cs = 0.f, cb = 0.f;
                for (int kk = 0; kk < 64; ++kk) { const float w = sm[kk * 65 + tid]; cs += w * rs_g[k0 + kk]; cb += w * rs_b[k0 + kk]; }
                atomicAdd(colsum + n0 + tid, cs); atomicAdd(colbias + n0 + tid, cb); }
            __syncthreads();
            for (int e = tid; e < 64 * 64; e += NTHR) { const int kk = e >> 6, nn = e & 63; sm[kk * 65 + nn] *= rs_g[k0 + kk]; }
            __syncthreads();
        }
        { const int nn = tid >> 3, c = tid & 7;
          if (n0 + nn < N) { uint4 o; o.x = pk2(sm[(8 * c + 0) * 65 + nn], sm[(8 * c + 1) * 65 + nn]); o.y = pk2(sm[(8 * c + 2) * 65 + nn], sm[(8 * c + 3) * 65 + nn]);
              o.z = pk2(sm[(8 * c + 4) * 65 + nn], sm[(8 * c + 5) * 65 + nn]); o.w = pk2(sm[(8 * c + 6) * 65 + nn], sm[(8 * c + 7) * 65 + nn]);
              *(uint4*)(WT + (size_t)(n0 + nn) * K + k0 + 8 * c) = o; } }
    }
    __syncthreads();
}
constexpr int TI_WIN = 16 * ((NCOL + 63) / 64), TI_SQ = 256, TI_LAYER = TI_WIN + 3 * TI_SQ;
#define TITEM_DECODE(it_, W_, WT_, K_, N_, k0_, n0_, fold_, l_) do { \
        l_ = (it_) / TI_LAYER; const int r_ = (it_) - l_ * TI_LAYER; \
        const int kind_ = r_ < TI_WIN ? 0 : (r_ < TI_WIN + TI_SQ ? 1 : (r_ < TI_WIN + 2 * TI_SQ ? 2 : 3)); \
        const int q_ = r_ - (kind_ == 0 ? 0 : TI_WIN + (kind_ - 1) * TI_SQ); \
        fold_ = kind_ == 2; K_ = kind_ == 3 ? 256 : 1024; N_ = kind_ == 0 ? NCOL : 1024; \
        k0_ = kind_ == 3 ? (q_ & 3) * 64 : (q_ & 15) * 64; n0_ = kind_ == 3 ? ((q_ & 63) >> 2) * 64 : (q_ >> 4) * 64; \
        const int nbr_ = q_ >> 6; \
        W_ = kind_ == 0 ? pin1 + (size_t)l_ * 1024 * NCOL : kind_ == 1 ? pin3 + (size_t)l_ * 1024 * 1024 : kind_ == 2 ? pin7 + (size_t)l_ * 1024 * 1024 : pin2 + ((size_t)l_ * 4 + nbr_) * 256 * 1024; \
        WT_ = kind_ == 0 ? (bf16*)(ws + WS_WIN_T + l_ * WIN_T_BYTES) : kind_ == 1 ? (bf16*)(ws + WS_WOUT_T) + (size_t)l_ * 1024 * 1024 : kind_ == 2 ? (bf16*)(ws + WS_WQ_T) + (size_t)l_ * 1024 * 1024 \
              : (bf16*)(ws + WS_WBR_T) + ((size_t)l_ * 4 + nbr_) * 1024 * 256; } while (0)
__device__ __forceinline__ void titem_finish(bf16* WT, int K, int N, int k0, int n0, const float* rs_g, const float* rs_b, float* colsum, float* colbias, float* sm, int tid) {
    if (rs_g) {
        if (tid < 64) { float cs = 0.f, cb = 0.f;
            for (int kk = 0; kk < 64; ++kk) { const float w = sm[kk * 65 + tid]; cs += w * rs_g[k0 + kk]; cb += w * rs_b[k0 + kk]; }
            atomicAdd(colsum + n0 + tid, cs); atomicAdd(colbias + n0 + tid, cb); }
        __syncthreads();
        for (int e = tid; e < 64 * 64; e += NTHR) { const int kk = e >> 6, nn = e & 63; sm[kk * 65 + nn] *= rs_g[k0 + kk]; }
        __syncthreads();
    }
    { const int nn = tid >> 3, c = tid & 7;
      if (n0 + nn < N) { uint4 o; o.x = pk2(sm[(8 * c + 0) * 65 + nn], sm[(8 * c + 1) * 65 + nn]); o.y = pk2(sm[(8 * c + 2) * 65 + nn], sm[(8 * c + 3) * 65 + nn]);
          o.z = pk2(sm[(8 * c + 4) * 65 + nn], sm[(8 * c + 5) * 65 + nn]); o.w = pk2(sm[(8 * c + 6) * 65 + nn], sm[(8 * c + 7) * 65 + nn]);
          *(uint4*)(WT + (size_t)(n0 + nn) * K + k0 + 8 * c) = o; } }
}
__device__ void prologue_phase(int WV_, const Params& p, float* sm) {
    const int tid = LTID(WV_), B = LBID(), G = LGRID();
    unsigned char* ws = p.ws;
    float* sm1 = sm + 64 * 65;
    const float* pin1 = p.in[1]; const float* pin2 = p.in[2]; const float* pin3 = p.in[3]; const float* pin7 = p.in[7]; const float* pin5 = p.in[5]; const float* pin6 = p.in[6];
    asm volatile("" : "+s"(pin1), "+s"(pin2), "+s"(pin3), "+s"(pin7), "+s"(pin5), "+s"(pin6));
    const int kk0 = tid >> 4, c4 = tid & 15;
    for (int it = B; it < DEPTH_ * TI_LAYER; it += 2 * G) {
        const int it2 = it + G; const bool has2 = it2 < DEPTH_ * TI_LAYER;
        const float* Wa; const float* Wb; bf16* WTa; bf16* WTb; int Ka, Na, k0a, n0a, la, Kb, Nb, k0b, n0b, lb; bool fa, fb;
        TITEM_DECODE(it, Wa, WTa, Ka, Na, k0a, n0a, fa, la);
        { const int itb = has2 ? it2 : it; TITEM_DECODE(itb, Wb, WTb, Kb, Nb, k0b, n0b, fb, lb); }
        const float4 z4 = make_float4(0.f, 0.f, 0.f, 0.f);
        const bool ina = n0a + 4 * c4 < Na, inb = n0b + 4 * c4 < Nb;
        float4 a0 = z4, a1 = z4, b0 = z4, b1 = z4;
        if (ina) { a0 = *(const float4*)(Wa + (size_t)(k0a + kk0) * Na + n0a + 4 * c4); a1 = *(const float4*)(Wa + (size_t)(k0a + kk0 + 32) * Na + n0a + 4 * c4); }
        if (inb) { b0 = *(const float4*)(Wb + (size_t)(k0b + kk0) * Nb + n0b + 4 * c4); b1 = *(const float4*)(Wb + (size_t)(k0b + kk0 + 32) * Nb + n0b + 4 * c4); }
        __syncthreads();
        { float* d = sm + kk0 * 65 + 4 * c4; d[0] = a0.x; d[1] = a0.y; d[2] = a0.z; d[3] = a0.w; d += 32 * 65; d[0] = a1.x; d[1] = a1.y; d[2] = a1.z; d[3] = a1.w; }
        { float* d = sm1 + kk0 * 65 + 4 * c4; d[0] = b0.x; d[1] = b0.y; d[2] = b0.z; d[3] = b0.w; d += 32 * 65; d[0] = b1.x; d[1] = b1.y; d[2] = b1.z; d[3] = b1.w; }
        __syncthreads();
        titem_finish(WTa, Ka, Na, k0a, n0a, fa ? pin5 + la * 1024 : nullptr, pin6 + la * 1024, (float*)(ws + WS_COLS) + la * 2048, (float*)(ws + WS_COLS) + la * 2048 + 1024, sm, tid);
        if (has2) titem_finish(WTb, Kb, Nb, k0b, n0b, fb ? pin5 + lb * 1024 : nullptr, pin6 + lb * 1024, (float*)(ws + WS_COLS) + lb * 2048, (float*)(ws + WS_COLS) + lb * 2048 + 1024, sm1, tid);
    }
    __syncthreads();
    for (int l = 0; l < DEPTH_; ++l) {
        bf16* win_t = (bf16*)(ws + WS_WIN_T + l * WIN_T_BYTES);
        for (int i = B * NTHR + tid; i < (NP - NCOL) * 1024 / 8; i += G * NTHR) ((uint4*)(win_t + (size_t)NCOL * 1024))[i] = make_uint4(0u, 0u, 0u, 0u);
    }
    const float4* x4 = (const float4*)p.in[0]; uint2* hb2 = (uint2*)(ws + WS_HB);
    for (size_t i = (size_t)B * NTHR + tid; i < (size_t)T_ * 1024 / 4; i += (size_t)G * NTHR) { const float4 v = x4[i]; hb2[i] = make_uint2(pk2(v.x, v.y), pk2(v.z, v.w)); }
}

__device__ __forceinline__ void ln_row(float4 (&v)[4], const float* g, const float* bb, float* orow, bf16* obrow, int lane) {
    float s = 0.f;
#pragma unroll
    for (int j = 0; j < 4; ++j) s += (v[j].x + v[j].y) + (v[j].z + v[j].w);
    const float mean = wave_sum(s) * (1.0f / 1024.0f);
    float s2 = 0.f;
#pragma unroll
    for (int j = 0; j < 4; ++j) { v[j].x -= mean; v[j].y -= mean; v[j].z -= mean; v[j].w -= mean; s2 += (v[j].x * v[j].x + v[j].y * v[j].y) + (v[j].z * v[j].z + v[j].w * v[j].w); }
    const float rstd = 1.0f / sqrtf(wave_sum(s2) * (1.0f / 1024.0f) + LN_EPS);
#pragma unroll
    for (int j = 0; j < 4; ++j) {
        const float4 gg = ((const float4*)g)[j * 64 + lane], b4 = ((const float4*)bb)[j * 64 + lane];
        float4 o; o.x = v[j].x * rstd * gg.x + b4.x; o.y = v[j].y * rstd * gg.y + b4.y; o.z = v[j].z * rstd * gg.z + b4.z; o.w = v[j].w * rstd * gg.w + b4.w;
        ((float4*)orow)[j * 64 + lane] = o;
        ((uint2*)obrow)[j * 64 + lane] = make_uint2(pk2(o.x, o.y), pk2(o.z, o.w));
    }
}
__device__ void ln1_phase(int WV_, const float* hin, const float* add, const float* g, const float* bb, float* hout, bf16* hb) {
    const int lane = LTID(WV_) & 63, wave = LTID(WV_) >> 6;
    for (int row = LBID() * NWAVE + wave; row < T_; row += LGRID() * NWAVE) {
        float4 v[4];
#pragma unroll
        for (int j = 0; j < 4; ++j) {
            const float4 a = ((const float4*)(hin + (size_t)row * 1024))[j * 64 + lane], m = ((const float4*)(add + (size_t)row * 1024))[j * 64 + lane];
            v[j].x = ALPHA * a.x + m.x; v[j].y = ALPHA * a.y + m.y; v[j].z = ALPHA * a.z + m.z; v[j].w = ALPHA * a.w + m.w;
        }
        ln_row(v, g, bb, hout + (size_t)row * 1024, hb + (size_t)row * 1024, lane);
    }
}


typedef short bf16x8_t __attribute__((ext_vector_type(8)));
typedef float f32x16_t __attribute__((ext_vector_type(16)));
typedef float f32x2_t __attribute__((ext_vector_type(2)));
typedef __bf16 bf16x2_t __attribute__((ext_vector_type(2)));
__device__ __forceinline__ unsigned cvtpk(float lo, float hi) { f32x2_t v = {lo, hi}; bf16x2_t b = __builtin_convertvector(v, bf16x2_t); return __builtin_bit_cast(unsigned, b); }
__device__ __forceinline__ int crow(int r, int hi) { return (r & 3) + 8 * (r >> 2) + 4 * hi; }
__device__ __forceinline__ float xlane32(float v) { return __shfl_xor(v, 32); }
__device__ __forceinline__ float vmax(float a, float b) { float r; asm("v_max_f32_e32 %0, %1, %2" : "=v"(r) : "v"(a), "v"(b)); return r; }
__device__ __forceinline__ float vmin(float a, float b) { float r; asm("v_min_f32_e32 %0, %1, %2" : "=v"(r) : "v"(a), "v"(b)); return r; }
__device__ __forceinline__ float vmax3(float a, float b, float c) { float r; asm("v_max3_f32 %0, %1, %2, %3" : "=v"(r) : "v"(a), "v"(b), "v"(c)); return r; }

constexpr int AT_KP = 72, AT_VP = 96;
constexpr int AT_KS = 0, AT_KS_BYTES = 64 * AT_KP * 2;
constexpr int AT_VT = 2 * AT_KS_BYTES, AT_VT_BYTES = 64 * AT_VP * 2;
constexpr int AT_KM = AT_VT + 2 * AT_VT_BYTES;
constexpr int AT_MISC = AT_KM + 32 * AT_KP * 2;
constexpr float LOG2E = 1.4426950408889634f;

__device__ __forceinline__ unsigned mk_unit(int kind, int b, int x, int y) { return ((unsigned)kind << 30) | ((unsigned)b << 28) | ((unsigned)x << 8) | (unsigned)y; }
__device__ void build_unit_table(unsigned* tab, int i) {
    int n = 0; unsigned res = 0u;
#pragma unroll 1
    for (int c = 64; c >= 1; --c) {
        if (i >= n && i < n + 4) res = mk_unit(0, i - n, 0, c - 1);
        n += 4;
        if ((c & 3) == 0) { if (i >= n && i < n + 16) { const int j = i - n; res = mk_unit(2, j >> 2, j & 3, c / 4 - 1); } n += 16; }
    }
    if (i < 512) tab[i] = res;
}

template <int kind> __device__ __forceinline__ void attn_unit(int WV_, const bf16* P, const unsigned char* mask, const float* kmean, const float* sinks, bf16* ys,
                                unsigned char* lds, int b, int ux, int uy) {
    int tid_ = LTID(WV_); asm volatile("" : "+v"(tid_));
    const int tid = tid_, lane = tid & 63, wave = __builtin_amdgcn_readfirstlane(tid >> 6), r32 = lane & 31, hi = lane >> 5;
    bf16* s_km = (bf16*)(lds + AT_KM);
    const int skey = tid >> 3, sc = tid & 7;
    {
        const bf16* Pb = P + (size_t)b * S_ * NP;
        int q0w, qcol, kcol, vcol, ycol, kt_hi, kt_lo; float slope2 = 0.f, sink2 = 0.f;
        if (kind == 0) { const int head = wave >> 1; q0w = uy * 64 + (wave & 1) * 32; qcol = C_QA + head * 64; kcol = C_KA; vcol = C_VA; ycol = head * 64;
            slope2 = exp2f(-8.0f * (float)(3 * head + 1) / 12.0f) * LOG2E; kt_hi = uy; kt_lo = 0; }
        else if (kind == 1) { const int hq = ux * 2 + (wave >> 2); q0w = uy * 128 + (wave & 3) * 32; qcol = C_QB + hq * 64; kcol = C_KB + ux * 64; vcol = C_VB + ux * 64; ycol = 256 + hq * 64;
            slope2 = exp2f(-8.0f * (float)(3 * hq + 2) / 12.0f) * LOG2E; sink2 = sinks[hq] * LOG2E; kt_hi = 2 * uy + 1; kt_lo = (2 * uy - 2 > 0) ? 2 * uy - 2 : 0; }
        else if (kind == 2) { q0w = uy * 256 + wave * 32; qcol = C_QC + ux * 64; kcol = C_KC + ux * 64; vcol = C_VC + ux * 64; ycol = 512 + ux * 64;
            slope2 = exp2f(-8.0f * (float)(3 * ux + 3) / 12.0f) * LOG2E; kt_hi = 4 * uy + 3; kt_lo = 0; }
        else { q0w = uy * 256 + wave * 32; qcol = C_QD + ux * 64; kcol = C_KD + ux * 64; vcol = C_VD + ux * 64; ycol = 768 + ux * 64; kt_hi = 4 * uy + 3; kt_lo = 0; }
        const int qpos = q0w + r32;
        bf16x8_t qf[4];
        { const bf16* qp = Pb + (size_t)qpos * NP + qcol + 8 * hi;
#pragma unroll
          for (int ks = 0; ks < 4; ++ks) qf[ks] = *(const bf16x8_t*)(qp + 16 * ks); }
        {
            const float qs = (kind == 3) ? 0.125f : 0.125f * LOG2E;
            typedef unsigned u32x4_t __attribute__((ext_vector_type(4)));
#pragma unroll
            for (int ks = 0; ks < 4; ++ks) { u32x4_t w = __builtin_bit_cast(u32x4_t, qf[ks]);
#pragma unroll
                for (int i = 0; i < 4; ++i) w[i] = cvtpk(__uint_as_float(w[i] << 16) * qs, __uint_as_float(w[i] & 0xffff0000u) * qs);
                qf[ks] = __builtin_bit_cast(bf16x8_t, w); }
        }
        float sb[16];
#pragma unroll
        for (int r = 0; r < 16; ++r) sb[r] = slope2 * (float)((r & 3) + 8 * (r >> 2));
        unsigned bm = 0u;
        if (kind == 2) {
            const int own = uy;
            for (int e = tid; e < 32 * 64; e += NTHR) { const int row = e >> 6, d = e & 63; s_km[row * AT_KP + d] = (row < 16) ? (bf16)f2bf(kmean[((b * 4 + ux) * 16 + row) * 64 + d]) : (bf16)0; }
            __syncthreads();
            f32x16_t gacc;
#pragma unroll
            for (int r = 0; r < 16; ++r) gacc[r] = 0.f;
#pragma unroll
            for (int ks = 0; ks < 4; ++ks) { const bf16x8_t a = *(const bf16x8_t*)(s_km + r32 * AT_KP + 16 * ks + 8 * hi); gacc = __builtin_amdgcn_mfma_f32_32x32x16_bf16(a, qf[ks], gacc, 0, 0, 0); }
            float gt[16];
#pragma unroll
            for (int r = 0; r < 8; ++r) { const float mine = gacc[r], other = xlane32(mine); const int bi = crow(r, 0);
                gt[bi] = hi ? other : mine; gt[bi + 4] = hi ? mine : other; }
#pragma unroll
            for (int n = 0; n < 16; ++n) if (n >= own) gt[n] = -INFINITY;
#pragma unroll
            for (int rep = 0; rep < 3; ++rep) {
                float mx = -INFINITY;
#pragma unroll
                for (int n = 0; n < 16; ++n) mx = fmaxf(mx, gt[n]);
                bool done = !(mx > -INFINITY);
#pragma unroll
                for (int n = 0; n < 16; ++n) { const bool hit = !done && gt[n] == mx; if (hit) { bm |= 1u << n; gt[n] = -INFINITY; done = true; } }
            }
        }
        f32x16_t o0, o1;
#pragma unroll
        for (int r = 0; r < 16; ++r) { o0[r] = 0.f; o1[r] = 0.f; }
        float m_run = -INFINITY, l_run = 0.f, carry = 0.f;
        const bf16* kg = Pb + (size_t)skey * NP + kcol + sc * 8;
        const bf16* vg = Pb + (size_t)skey * NP + vcol + sc * 8;
        uint4 rk = *(const uint4*)(kg + (size_t)kt_hi * 64 * NP), rv = *(const uint4*)(vg + (size_t)kt_hi * 64 * NP);
        int buf = 0;
        { bf16* ks_ = (bf16*)(lds + AT_KS); bf16* vt_ = (bf16*)(lds + AT_VT);
          *(uint4*)(ks_ + skey * AT_KP + sc * 8) = rk;
          *(uint4*)(vt_ + skey * AT_VP + sc * 8) = rv; }
        __syncthreads();
        bool wave_done = false;
        uint2 mw_next = make_uint2(0u, 0u);
        if (kind == 0) mw_next = *(const uint2*)(mask + (size_t)(b * S_ + qpos) * 512 + kt_hi * 8);
        for (int kt = kt_hi; kt >= kt_lo; --kt) {
            const bool more = kt > kt_lo;
            const uint2 mw = mw_next;
            if (kind == 0 && more) mw_next = *(const uint2*)(mask + (size_t)(b * S_ + qpos) * 512 + (kt - 1) * 8);
            if (more) { rk = *(const uint4*)(kg + (size_t)(kt - 1) * 64 * NP); rv = *(const uint4*)(vg + (size_t)(kt - 1) * 64 * NP); }
            const bf16* ks_ = (const bf16*)(lds + AT_KS + buf * AT_KS_BYTES);
            const bf16* vt_ = (const bf16*)(lds + AT_VT + buf * AT_VT_BYTES);
            bool active = (kt * 64 <= q0w + 31) && !wave_done;
            if (kind == 1) active = active && (kt * 64 + 63 >= q0w - 127);
            if (active) {
                const int kbase = kt * 64 + 4 * hi;
                f32x16_t p0, p1;
                if (kind != 3) {
                    const float cb = slope2 * (float)(kbase - qpos), cb1 = cb + 32.0f * slope2;
#pragma unroll
                    for (int r = 0; r < 16; ++r) { p0[r] = cb + sb[r]; p1[r] = cb1 + sb[r]; }
                } else {
#pragma unroll
                    for (int r = 0; r < 16; ++r) { p0[r] = 0.f; p1[r] = 0.f; }
                }
#pragma unroll
                for (int ks = 0; ks < 4; ++ks) {
                    const bf16x8_t a0 = *(const bf16x8_t*)(ks_ + r32 * AT_KP + 16 * ks + 8 * hi);
                    const bf16x8_t a1 = *(const bf16x8_t*)(ks_ + (32 + r32) * AT_KP + 16 * ks + 8 * hi);
                    p0 = __builtin_amdgcn_mfma_f32_32x32x16_bf16(a0, qf[ks], p0, 0, 0, 0);
                    p1 = __builtin_amdgcn_mfma_f32_32x32x16_bf16(a1, qf[ks], p1, 0, 0, 0);
                }
                if (kind != 3) {
                    float mx = -INFINITY;
                    if (kind == 0) {
                        const unsigned w0 = mw.x >> (4 * hi), w1 = mw.y >> (4 * hi);
#pragma unroll
                        for (int r = 0; r < 16; ++r) { const int off = (r & 3) + 8 * (r >> 2);
                            p0[r] = (w0 & (1u << off)) ? p0[r] : -INFINITY; p1[r] = (w1 & (1u << off)) ? p1[r] : -INFINITY; mx = vmax3(mx, p0[r], p1[r]); }
                    } else if (kind == 1) {
                        const int rel = qpos - kbase;
#pragma unroll
                        for (int r = 0; r < 16; ++r) { const int off = (r & 3) + 8 * (r >> 2);
                            p0[r] = ((unsigned)(rel - off) < 128u) ? p0[r] : -INFINITY; p1[r] = ((unsigned)(rel - off - 32) < 128u) ? p1[r] : -INFINITY; mx = vmax3(mx, p0[r], p1[r]); }
                    } else {
                        if ((kt >> 2) == uy) {
                            const int rel = qpos - kbase;
#pragma unroll
                            for (int r = 0; r < 16; ++r) { const int off = (r & 3) + 8 * (r >> 2);
                                p0[r] = (off <= rel) ? p0[r] : -INFINITY; p1[r] = (off + 32 <= rel) ? p1[r] : -INFINITY; mx = vmax3(mx, p0[r], p1[r]); }
                        } else {
                            const bool tile_ok = ((bm >> (kt >> 2)) & 1u) != 0u;
#pragma unroll
                            for (int r = 0; r < 16; ++r) { p0[r] = tile_ok ? p0[r] : -INFINITY; p1[r] = tile_ok ? p1[r] : -INFINITY; mx = vmax3(mx, p0[r], p1[r]); }
                        }
                    }
                    mx = vmax(mx, xlane32(mx));
                    const float m_new = vmax(m_run, mx);
                    const float m_safe = (m_new == -INFINITY) ? 0.f : m_new;
                    p0 = p0 - m_safe; p1 = p1 - m_safe;
#pragma unroll
                    for (int r = 0; r < 16; ++r) { p0[r] = __builtin_amdgcn_exp2f(p0[r]); p1[r] = __builtin_amdgcn_exp2f(p1[r]); }
                    float ls;
                    { typedef float f32x8_t __attribute__((ext_vector_type(8))); typedef float f32x4v_t __attribute__((ext_vector_type(4)));
                      const f32x16_t t16 = p0 + p1; const f32x8_t t8 = t16.lo + t16.hi; const f32x4v_t t4 = t8.lo + t8.hi; const f32x2_t t2 = t4.lo + t4.hi; ls = t2.x + t2.y; }
                    if (__any(m_new > m_run)) {
                        const float alpha = __builtin_amdgcn_exp2f(m_run - m_safe);
                        l_run *= alpha;
                        o0 = o0 * alpha; o1 = o1 * alpha;
                    }
                    l_run += ls; m_run = m_new;
                } else {
                    float run = carry;
#define SB_HALF(PX, KOFF) do { \
                    float lk[16]; \
                    _Pragma("unroll") for (int r = 0; r < 16; ++r) { \
                        const int off = (r & 3) + 8 * (r >> 2); \
                        const bool v = (kbase + off + (KOFF)) < qpos; \
                        const float z = PX[r]; \
                        const float t = 0.6931471805599453f * __builtin_amdgcn_logf(1.0f + __builtin_amdgcn_exp2f(-LOG2E * fabsf(z))); \
                        lk[r] = v ? (fminf(-z, 0.f) - t) : 0.f; \
                        PX[r] = v ? (fminf(z, 0.f) - t) : -INFINITY; } \
                    _Pragma("unroll") for (int g = 3; g >= 0; --g) { \
                        const float G = (lk[4 * g] + lk[4 * g + 1]) + (lk[4 * g + 2] + lk[4 * g + 3]); \
                        const float PG = xlane32(G); \
                        float la = run + (hi ? 0.f : PG); \
                        run += G + PG; \
                        PX[4 * g + 3] += la; la += lk[4 * g + 3]; PX[4 * g + 2] += la; la += lk[4 * g + 2]; PX[4 * g + 1] += la; la += lk[4 * g + 1]; PX[4 * g] += la; } \
                    _Pragma("unroll") for (int r = 0; r < 16; ++r) PX[r] = __builtin_amdgcn_exp2f(LOG2E * PX[r]); } while (0)
                    SB_HALF(p1, 32);
                    SB_HALF(p0, 0);
#undef SB_HALF
                    carry = run;
                }
                unsigned pw[16];
#pragma unroll
                for (int j = 0; j < 8; ++j) { pw[j] = cvtpk(p0[2 * j], p0[2 * j + 1]); pw[8 + j] = cvtpk(p1[2 * j], p1[2 * j + 1]); }
#pragma unroll
                for (int s = 0; s < 4; ++s) {
                    bf16x8_t pb; { const unsigned* q = pw + 4 * s; typedef unsigned u32x4_t __attribute__((ext_vector_type(4))); u32x4_t t4 = {q[0], q[1], q[2], q[3]}; pb = __builtin_bit_cast(bf16x8_t, t4); }
#pragma unroll
                    for (int dt = 0; dt < 2; ++dt) {
                        typedef short s16x4_t __attribute__((ext_vector_type(4)));
                        typedef __attribute__((address_space(3))) s16x4_t lds_s16x4;
                        const int gi_ = lane & 15;
                        const bf16* vp = vt_ + (16 * s + 4 * hi + (gi_ >> 2)) * AT_VP + 32 * dt + 16 * ((lane >> 4) & 1) + 4 * (gi_ & 3);
                        const s16x4_t lo = __builtin_amdgcn_ds_read_tr16_b64_v4i16((lds_s16x4*)vp), hi4 = __builtin_amdgcn_ds_read_tr16_b64_v4i16((lds_s16x4*)(vp + 8 * AT_VP));
                        const bf16x8_t va = {lo[0], lo[1], lo[2], lo[3], hi4[0], hi4[1], hi4[2], hi4[3]};
                        if (dt == 0) o0 = __builtin_amdgcn_mfma_f32_32x32x16_bf16(va, pb, o0, 0, 0, 0);
                        else         o1 = __builtin_amdgcn_mfma_f32_32x32x16_bf16(va, pb, o1, 0, 0, 0);
                    }
                }
            }
            if (kind == 3) {
                const float cm = carry;
                if (__all(cm < -110.0f) || !(kt * 64 <= q0w + 31) ) { if (__all(cm < -110.0f)) wave_done = true; }
            }
            if (more) {
                bf16* ksn = (bf16*)(lds + AT_KS + (buf ^ 1) * AT_KS_BYTES); bf16* vtn = (bf16*)(lds + AT_VT + (buf ^ 1) * AT_VT_BYTES);
                *(uint4*)(ksn + skey * AT_KP + sc * 8) = rk;
                *(uint4*)(vtn + skey * AT_VP + sc * 8) = rv;
            }
            if (kind == 3) { if (__syncthreads_and(wave_done ? 1 : 0)) break; }
            else __syncthreads();
            buf ^= 1;
        }
        float inv;
        if (kind == 3) inv = 1.0f;
        else {
            float lt = l_run + xlane32(l_run);
            if (kind == 1) { const float mf = fmaxf(m_run, sink2); const float sc2 = exp2f(m_run - mf); lt = lt * sc2 + exp2f(sink2 - mf); inv = sc2 / lt; }
            else inv = 1.0f / lt;
        }
        bf16* yp = ys + (size_t)(b * S_ + qpos) * 1024 + ycol + 4 * hi;
#pragma unroll
        for (int g = 0; g < 4; ++g) {
            *(uint2*)(yp + 8 * g) = make_uint2(cvtpk(o0[4 * g] * inv, o0[4 * g + 1] * inv), cvtpk(o0[4 * g + 2] * inv, o0[4 * g + 3] * inv));
            *(uint2*)(yp + 32 + 8 * g) = make_uint2(cvtpk(o1[4 * g] * inv, o1[4 * g + 1] * inv), cvtpk(o1[4 * g + 2] * inv, o1[4 * g + 3] * inv));
        }
    }
}
__device__ void attn_fast_phase(int WV_, const bf16* P, const unsigned char* mask, const float* kmean, const float* sinks, bf16* ys,
                                const unsigned* utab, unsigned* counter, unsigned char* lds) {
    volatile unsigned* s_unit = (volatile unsigned*)(lds + AT_MISC);
    for (;;) {
        __syncthreads();
        if (LTID(WV_) == 0) s_unit[0] = atomicAdd(counter, 1u);
        __syncthreads();
        const unsigned ui = s_unit[0];
        if (ui >= 512u) break;
        const unsigned ue = utab[ui];
        const int kind = (int)(ue >> 30), b = (int)((ue >> 28) & 3u), ux = (int)((ue >> 8) & 255u), uy = (int)(ue & 255u);
        if (kind == 0) attn_unit<0>(WV_, P, mask, kmean, sinks, ys, lds, b, ux, uy);
        else attn_unit<2>(WV_, P, mask, kmean, sinks, ys, lds, b, ux, uy);
    }
    for (int u = LBID(); u < 256; u += LGRID()) { __syncthreads(); attn_unit<3>(WV_, P, mask, kmean, sinks, ys, lds, u >> 6, (u >> 4) & 3, u & 15); }
    for (int u = LBID(); u < 256; u += LGRID()) { __syncthreads(); attn_unit<1>(WV_, P, mask, kmean, sinks, ys, lds, u >> 6, (u >> 5) & 1, u & 31); }
}

constexpr float U_SCALE = 128.0f, V_SCALE = 48.0f;
constexpr int ROW6 = 1536;
typedef float v32f_t __attribute__((ext_vector_type(32)));
typedef unsigned v6u_t __attribute__((ext_vector_type(6)));
typedef unsigned u32x4a8_t __attribute__((ext_vector_type(4), aligned(8)));
__device__ __forceinline__ float rdlane_f(float v, int l) { return __builtin_bit_cast(float, __builtin_amdgcn_readlane(__builtin_bit_cast(int, v), l)); }
__device__ __forceinline__ unsigned q_e2m3(float v) {
    const float a = fminf(fabsf(v), 7.5f);
    unsigned code;
    if (a < 1.0f) code = (unsigned)rintf(a * 8.0f);
    else if (a < 2.0f) code = 8u + (unsigned)rintf((a - 1.0f) * 8.0f);
    else if (a < 4.0f) code = 16u + (unsigned)rintf((a - 2.0f) * 4.0f);
    else code = 24u + (unsigned)rintf((a - 4.0f) * 2.0f);
    return code | (v < 0.f ? 32u : 0u);
}
__device__ __forceinline__ void cvt_chunk6(const float4 (&a)[8], float sc, unsigned (&w)[6]) {
#pragma unroll
    for (int d = 0; d < 6; ++d) w[d] = 0u;
#pragma unroll
    for (int q4 = 0; q4 < 8; ++q4) {
        const float av[4] = {a[q4].x, a[q4].y, a[q4].z, a[q4].w};
#pragma unroll
        for (int e = 0; e < 4; ++e) { const int idx = q4 * 4 + e, bit = 6 * idx, d = bit >> 5, sft = bit & 31; const unsigned code = q_e2m3(av[e] * sc);
            w[d] |= code << sft; if (sft > 26) w[d + 1] |= code >> (32 - sft); }
    }
}
__device__ void convert_tables(int WV_, const Params& p) {
    const size_t nchunk = (size_t)DEPTH_ * 16384 * 2 * 32;
    const size_t stride = (size_t)LGRID() * NTHR;
    for (size_t i = (size_t)LBID() * NTHR + LTID(WV_); i < nchunk; i += 2 * stride) {
        const size_t i2 = i + stride; const bool has2 = i2 < nchunk; const size_t j2 = has2 ? i2 : i;
        const int c0 = (int)(i & 31), uv0 = (int)((i >> 5) & 1); const size_t le0 = i >> 6;
        const int c1 = (int)(j2 & 31), uv1 = (int)((j2 >> 5) & 1); const size_t le1 = j2 >> 6;
        const float* src0 = (uv0 ? p.in[10] : p.in[9]) + le0 * 1024 + c0 * 32;
        const float* src1 = (uv1 ? p.in[10] : p.in[9]) + le1 * 1024 + c1 * 32;
        float4 a0[8], a1[8];
#pragma unroll
        for (int q4 = 0; q4 < 8; ++q4) a0[q4] = ((const float4*)src0)[q4];
#pragma unroll
        for (int q4 = 0; q4 < 8; ++q4) a1[q4] = ((const float4*)src1)[q4];
        unsigned w0[6], w1[6];
        cvt_chunk6(a0, uv0 ? V_SCALE : U_SCALE, w0);
        cvt_chunk6(a1, uv1 ? V_SCALE : U_SCALE, w1);
        uint2* dst0 = (uint2*)(p.ws + WS_UV + le0 * ROW6 + uv0 * 768 + c0 * 24);
        dst0[0] = make_uint2(w0[0], w0[1]); dst0[1] = make_uint2(w0[2], w0[3]); dst0[2] = make_uint2(w0[4], w0[5]);
        if (has2) { uint2* dst1 = (uint2*)(p.ws + WS_UV + le1 * ROW6 + uv1 * 768 + c1 * 24);
            dst1[0] = make_uint2(w1[0], w1[1]); dst1[1] = make_uint2(w1[2], w1[3]); dst1[2] = make_uint2(w1[4], w1[5]); }
    }
}
__device__ __forceinline__ v6u_t ld_pk6(const unsigned char* ptr) {
    const uint2 a = ((const uint2*)ptr)[0], b = ((const uint2*)ptr)[1], c = ((const uint2*)ptr)[2];
    const v6u_t pk = {a.x, a.y, b.x, b.y, c.x, c.y};
    return pk;
}
__device__ void peer_fast_phase(int WV_, float* h, bf16* hb, const int* eid, const float* gate, const unsigned char* uv, const float* g1, const float* b1, const float* g, const float* bb, unsigned char* lds) {
    const int tid = LTID(WV_), lane = tid & 63, wave = tid >> 6, l32 = lane & 31, hi = lane >> 5;
    float* pl = (float*)(lds + wave * 16384);
    unsigned char* raw = lds + wave * 16384 + 4096 + lane * 24;
    for (int t = LBID() * NWAVE + wave; t < T_; t += LGRID() * NWAVE) {
        float* hr = h + (size_t)t * 1024 + l32 * 32;
        float x[32], acc[32];
#pragma unroll
        for (int q4 = 0; q4 < 4; ++q4) { const uint4 a = ((const uint4*)(hb + (size_t)t * 1024 + l32 * 32))[q4];
            x[8 * q4] = __uint_as_float(a.x << 16); x[8 * q4 + 1] = __uint_as_float(a.x & 0xffff0000u); x[8 * q4 + 2] = __uint_as_float(a.y << 16); x[8 * q4 + 3] = __uint_as_float(a.y & 0xffff0000u);
            x[8 * q4 + 4] = __uint_as_float(a.z << 16); x[8 * q4 + 5] = __uint_as_float(a.z & 0xffff0000u); x[8 * q4 + 6] = __uint_as_float(a.w << 16); x[8 * q4 + 7] = __uint_as_float(a.w & 0xffff0000u); }
        {
            float s = 0.f;
#pragma unroll
            for (int i = 0; i < 32; ++i) s += x[i];
#pragma unroll
            for (int o = 16; o > 0; o >>= 1) s += __shfl_xor(s, o);
            const float mean = s * (1.0f / 1024.0f);
            float s2 = 0.f;
#pragma unroll
            for (int i = 0; i < 32; ++i) { x[i] -= mean; s2 += x[i] * x[i]; }
#pragma unroll
            for (int o = 16; o > 0; o >>= 1) s2 += __shfl_xor(s2, o);
            const float rstd = 1.0f / sqrtf(s2 * (1.0f / 1024.0f) + LN_EPS);
#pragma unroll
            for (int q4 = 0; q4 < 8; ++q4) { const float4 gg = ((const float4*)(g1 + l32 * 32))[q4], cc = ((const float4*)(b1 + l32 * 32))[q4];
                x[4 * q4] = x[4 * q4] * rstd * gg.x + cc.x; x[4 * q4 + 1] = x[4 * q4 + 1] * rstd * gg.y + cc.y; x[4 * q4 + 2] = x[4 * q4 + 2] * rstd * gg.z + cc.z; x[4 * q4 + 3] = x[4 * q4 + 3] * rstd * gg.w + cc.w; }
        }
#pragma unroll
        for (int i = 0; i < 32; ++i) acc[i] = 0.f;
#pragma unroll 1
        for (int batch = 0; batch < 4; ++batch) {
            const int my_eid = eid[(size_t)t * 128 + batch * 32 + l32];
            const float my_gate = gate[(size_t)t * 128 + batch * 32 + l32];
#pragma unroll 1
            for (int grp = 0; grp < 2; ++grp) {
                { u32x4a8_t pa[8]; uint2 pc[8];
#pragma unroll
                  for (int i = 0; i < 8; ++i) { const int id = __shfl(my_eid, 2 * (grp * 8 + i) + hi); const unsigned char* rp = uv + (size_t)id * ROW6 + l32 * 24; pa[i] = *(const u32x4a8_t*)rp; pc[i] = *(const uint2*)(rp + 16); }
#pragma unroll
                  for (int i = 0; i < 8; ++i) { uint2* wp = (uint2*)(raw + i * 1536); wp[0] = make_uint2(pa[i].x, pa[i].y); wp[1] = make_uint2(pa[i].z, pa[i].w); wp[2] = pc[i]; } }
#pragma unroll 1
                for (int i = 0; i < 8; ++i) {
                    const uint2* rp = (const uint2*)(raw + i * 1536); const uint2 a = rp[0], b = rp[1], c = rp[2];
                    const v6u_t pk6 = {a.x, a.y, b.x, b.y, c.x, c.y}; const v32f_t f = __builtin_amdgcn_cvt_scalef32_pk32_f32_fp6(pk6, 1.0f);
                    f32x2_t dv0 = {0.f, 0.f}, dv1 = {0.f, 0.f};
#pragma unroll
                    for (int j = 0; j < 8; ++j) { const f32x2_t fa = {f[2 * j], f[2 * j + 1]}, fb = {f[16 + 2 * j], f[17 + 2 * j]}, xa = {x[2 * j], x[2 * j + 1]}, xb = {x[16 + 2 * j], x[17 + 2 * j]};
                        dv0 = fa * xa + dv0; dv1 = fb * xb + dv1; }
                    pl[(2 * (grp * 8 + i) + hi) * 32 + l32] = (dv0.x + dv0.y) + (dv1.x + dv1.y);
                }
            }
            float d;
            { const float4* pr = (const float4*)(pl + l32 * 32); float4 s4 = pr[0];
#pragma unroll
              for (int i = 1; i < 8; ++i) { const float4 v = pr[i]; s4.x += v.x; s4.y += v.y; s4.z += v.z; s4.w += v.w; }
              d = ((s4.x + s4.y) + (s4.z + s4.w)) * (1.0f / U_SCALE); }
            const float hv = 0.5f * d * (1.0f + erff(d * 0.70710678118654752f)) * my_gate * (1.0f / V_SCALE);
#pragma unroll 1
            for (int grp = 0; grp < 2; ++grp) {
                { u32x4a8_t pa[8]; uint2 pc[8];
#pragma unroll
                  for (int i = 0; i < 8; ++i) { const int id = __shfl(my_eid, 2 * (grp * 8 + i) + hi); const unsigned char* rp = uv + (size_t)id * ROW6 + 768 + l32 * 24; pa[i] = *(const u32x4a8_t*)rp; pc[i] = *(const uint2*)(rp + 16); }
#pragma unroll
                  for (int i = 0; i < 8; ++i) { uint2* wp = (uint2*)(raw + i * 1536); wp[0] = make_uint2(pa[i].x, pa[i].y); wp[1] = make_uint2(pa[i].z, pa[i].w); wp[2] = pc[i]; } }
#pragma unroll 1
                for (int i = 0; i < 8; ++i) {
                    const float c = __shfl(hv, 2 * (grp * 8 + i) + hi);
                    const uint2* rp = (const uint2*)(raw + i * 1536); const uint2 a = rp[0], b = rp[1], cc = rp[2];
                    const v6u_t pk6 = {a.x, a.y, b.x, b.y, cc.x, cc.y}; const v32f_t f = __builtin_amdgcn_cvt_scalef32_pk32_f32_fp6(pk6, 1.0f);
                    const f32x2_t c2 = {c, c};
#pragma unroll
                    for (int j = 0; j < 16; ++j) { const f32x2_t fj = {f[2 * j], f[2 * j + 1]}; f32x2_t aj = {acc[2 * j], acc[2 * j + 1]}; aj = fj * c2 + aj; acc[2 * j] = aj.x; acc[2 * j + 1] = aj.y; }
                }
            }
        }
        float y[32], s = 0.f;
#pragma unroll
        for (int i = 0; i < 32; ++i) { acc[i] += __shfl_xor(acc[i], 32); y[i] = ALPHA * x[i] + acc[i]; s += y[i]; }
#pragma unroll
        for (int o = 16; o > 0; o >>= 1) s += __shfl_xor(s, o);
        const float mean = s * (1.0f / 1024.0f);
        float s2 = 0.f;
#pragma unroll
        for (int i = 0; i < 32; ++i) { y[i] -= mean; s2 += y[i] * y[i]; }
#pragma unroll
        for (int o = 16; o > 0; o >>= 1) s2 += __shfl_xor(s2, o);
        const float rstd = 1.0f / sqrtf(s2 * (1.0f / 1024.0f) + LN_EPS);
        float o[16];
#pragma unroll
        for (int q4 = 0; q4 < 4; ++q4) {
            const float4 gg = ((const float4*)(g + l32 * 32 + hi * 16))[q4], cc = ((const float4*)(bb + l32 * 32 + hi * 16))[q4];
            float ya[4], yb2[4];
#pragma unroll
            for (int e = 0; e < 4; ++e) { ya[e] = y[4 * q4 + e]; yb2[e] = y[16 + 4 * q4 + e]; }
            asm volatile("" : "+v"(ya[0]), "+v"(ya[1]), "+v"(ya[2]), "+v"(ya[3]), "+v"(yb2[0]), "+v"(yb2[1]), "+v"(yb2[2]), "+v"(yb2[3]));
            const float y0 = hi ? yb2[0] : ya[0], y1 = hi ? yb2[1] : ya[1], y2 = hi ? yb2[2] : ya[2], y3 = hi ? yb2[3] : ya[3];
            o[4 * q4] = y0 * rstd * gg.x + cc.x; o[4 * q4 + 1] = y1 * rstd * gg.y + cc.y; o[4 * q4 + 2] = y2 * rstd * gg.z + cc.z; o[4 * q4 + 3] = y3 * rstd * gg.w + cc.w;
            if (h) ((float4*)(hr + hi * 16))[q4] = make_float4(o[4 * q4], o[4 * q4 + 1], o[4 * q4 + 2], o[4 * q4 + 3]);
        }
        uint4* hbp = (uint4*)(hb + (size_t)t * 1024 + l32 * 32 + hi * 16);
        hbp[0] = make_uint4(pk2(o[0], o[1]), pk2(o[2], o[3]), pk2(o[4], o[5]), pk2(o[6], o[7]));
        hbp[1] = make_uint4(pk2(o[8], o[9]), pk2(o[10], o[11]), pk2(o[12], o[13]), pk2(o[14], o[15]));
    }
}

__device__ __forceinline__ float pack_pl(float v, unsigned pl) { return __uint_as_float((__float_as_uint(v) & ~127u) | pl); }
__device__ __forceinline__ void ins16(float (&s)[16], float x) {
#pragma unroll
    for (int k = 15; k >= 1; --k) s[k] = __builtin_amdgcn_fmed3f(s[k - 1], x, s[k]);
    s[0] = vmax(s[0], x);
}
template <int D> __device__ __forceinline__ void bitonic_stage(float (&c)[16]) {
#pragma unroll
    for (int i = 0; i < 16; ++i) if ((i & D) == 0) { const float a = vmax(c[i], c[i + D]), b = vmin(c[i], c[i + D]); c[i] = a; c[i + D] = b; }
}
__device__ __forceinline__ int decode_key(unsigned pl) { return (int)(32u * ((pl >> 4) & 3u) + (pl & 3u) + 8u * ((pl >> 2) & 3u) + 4u * ((pl >> 6) & 1u)); }
__device__ void route_fast_phase(int WV_, const bf16* qb, const bf16* skb  , int* eid, float* gate, unsigned char* lds, int pm = -1, int pn = 0) {
    const int tid = LTID(WV_), lane = tid & 63, wave = tid >> 6, r32 = lane & 31, hi = lane >> 5;
    unsigned* lidx = (unsigned*)lds + wave * (64 * 33) + lane * 33;
    const int u_first = (pm >= 0) ? 0 : LBID() * NWAVE + wave, u_end = (pm >= 0) ? 2 : (T_ / 32) * 8, u_step = (pm >= 0) ? 1 : LGRID() * NWAVE;
    for (int unit = u_first; unit < u_end; unit += u_step) {
        const int h = (pm >= 0) ? 2 * pn + unit : (unit & 7), t = ((pm >= 0) ? 8 * pm + wave : (unit >> 3)) * 32 + r32;
        float sl[2][16];
#pragma unroll
        for (int p = 0; p < 2; ++p) {
            bf16x8_t qf[4];
            { const bf16* qp = qb + (size_t)t * 1024 + h * 128 + p * 64 + 8 * hi;
#pragma unroll
              for (int ks = 0; ks < 4; ++ks) qf[ks] = *(const bf16x8_t*)(qp + 16 * ks); }
            float s[16];
#pragma unroll
            for (int k = 0; k < 16; ++k) s[k] = -INFINITY;
            const bf16* skp = skb + ((size_t)(h * 2 + p) * 128 + r32) * 64 + 8 * hi;
#pragma unroll
            for (int kt = 0; kt < 4; ++kt) {
                f32x16_t acc;
#pragma unroll
                for (int r = 0; r < 16; ++r) acc[r] = 0.f;
#pragma unroll
                for (int ks = 0; ks < 4; ++ks) { const bf16x8_t a = *(const bf16x8_t*)(skp + (size_t)kt * 32 * 64 + 16 * ks); acc = __builtin_amdgcn_mfma_f32_32x32x16_bf16(a, qf[ks], acc, 0, 0, 0); }
#pragma unroll
                for (int r = 0; r < 16; ++r) ins16(s, pack_pl(acc[r], (unsigned)(kt * 16 + r)));
            }
            const unsigned hb = (unsigned)hi << 6;
#pragma unroll
            for (int k = 0; k < 16; ++k) s[k] = __uint_as_float(__float_as_uint(s[k]) | hb);
            float c[16];
#pragma unroll
            for (int k = 0; k < 16; ++k) c[k] = vmax(s[k], __shfl_xor(s[15 - k], 32));
            bitonic_stage<8>(c); bitonic_stage<4>(c); bitonic_stage<2>(c); bitonic_stage<1>(c);
#pragma unroll
            for (int k = 0; k < 16; ++k) { sl[p][k] = c[k]; lidx[p * 16 + k] = (unsigned)decode_key(__float_as_uint(c[k]) & 127u); }
        }
        float w[16];
#pragma unroll
        for (int k = 0; k < 16; ++k) w[k] = -INFINITY;
#pragma unroll
        for (int i = 0; i < 16; ++i)
#pragma unroll
            for (int j = 0; j < 16; ++j)
                if ((i + 1) * (j + 1) <= 16) { const float v = sl[0][i] + sl[1][j]; ins16(w, __uint_as_float((__float_as_uint(v) & ~255u) | (unsigned)(i * 16 + j))); }
        float e[16], sum = 0.f;
#pragma unroll
        for (int k = 0; k < 16; ++k) { e[k] = expf(w[k] - w[0]); sum += e[k]; }
        const float inv = 1.0f / sum;
        int ide[8]; float gte[8];
#pragma unroll
        for (int k = 0; k < 8; ++k) {
            float wa = w[k], wb = w[8 + k], ea = e[k], eb = e[8 + k];
            asm volatile("" : "+v"(wa), "+v"(wb), "+v"(ea), "+v"(eb));
            const float wv = hi ? wb : wa;
            const unsigned pl = __float_as_uint(wv) & 255u;
            ide[k] = (int)(lidx[pl >> 4] * 128u + lidx[16 + (pl & 15u)]);
            gte[k] = (hi ? eb : ea) * inv;
        }
        int* ep = eid + (size_t)t * 128 + h * 16 + hi * 8; float* gp = gate + (size_t)t * 128 + h * 16 + hi * 8;
        *(int4*)ep = make_int4(ide[0], ide[1], ide[2], ide[3]); *(int4*)(ep + 4) = make_int4(ide[4], ide[5], ide[6], ide[7]);
        *(float4*)gp = make_float4(gte[0], gte[1], gte[2], gte[3]); *(float4*)(gp + 4) = make_float4(gte[4], gte[5], gte[6], gte[7]);
    }
}
#ifndef TS_SEL
#define TS_SEL 0
#endif
#define ITS_B() do { if (TS_SEL >= 20 && TS_SEL <= 40 && WV_ == 0 && LANEID() == 0) ((volatile __attribute__((address_space(3))) unsigned long long*)((__attribute__((address_space(3))) unsigned char*)lds + 147456 - 16 - 32))[0] = __builtin_amdgcn_s_memrealtime(); } while (0)
#define ITS_E(k) do { if ((k) == TS_SEL && WV_ == 0 && LANEID() == 0) { volatile __attribute__((address_space(3))) unsigned long long* w_ = (volatile __attribute__((address_space(3))) unsigned long long*)((__attribute__((address_space(3))) unsigned char*)lds + 147456 - 16 - 32); w_[1] += __builtin_amdgcn_s_memrealtime() - w_[0]; } } while (0)

typedef float f32x4_t __attribute__((ext_vector_type(4)));
typedef __bf16 bf16x2v __attribute__((ext_vector_type(2)));
__device__ __forceinline__ float dot2bf(unsigned a, unsigned b, float c) { return __builtin_amdgcn_fdot2_f32_bf16(__builtin_bit_cast(bf16x2v, a), __builtin_bit_cast(bf16x2v, b), c, false); }
__device__ __forceinline__ void cnt_gt(int& cnt, unsigned a, unsigned b) { asm("v_cmp_gt_u32_e32 vcc, %1, %2\n\tv_addc_co_u32_e32 %0, vcc, 0, %0, vcc" : "+v"(cnt) : "v"(a), "v"(b) : "vcc"); }
__device__ __forceinline__ void cnt_eq(int& cnt, unsigned a, unsigned b) { asm("v_cmp_eq_u32_e32 vcc, %1, %2\n\tv_addc_co_u32_e32 %0, vcc, 0, %0, vcc" : "+v"(cnt) : "v"(a), "v"(b) : "vcc"); }
__device__ __forceinline__ unsigned flag_gt(unsigned a, unsigned b) { unsigned r; asm("v_cmp_gt_u32_e32 vcc, %1, %2\n\tv_cndmask_b32_e64 %0, 0, 1, vcc" : "=v"(r) : "v"(a), "v"(b) : "vcc"); return r; }
__device__ __forceinline__ unsigned flag_eq(unsigned a, unsigned b) { unsigned r; asm("v_cmp_eq_u32_e32 vcc, %1, %2\n\tv_cndmask_b32_e64 %0, 0, 1, vcc" : "=v"(r) : "v"(a), "v"(b) : "vcc"); return r; }
__device__ __forceinline__ void cnt_ge(int& cnt, unsigned key, unsigned cand) { asm("v_cmp_ge_u32_e32 vcc, %1, %2\n\tv_addc_co_u32_e32 %0, vcc, 0, %0, vcc" : "+v"(cnt) : "v"(key), "v"(cand) : "vcc"); }

template <int CTRL, int RM> __device__ __forceinline__ unsigned dpp0(unsigned v) { return (unsigned)__builtin_amdgcn_update_dpp(0, (int)v, CTRL, RM, 0xf, false); }
template <int CTRL> __device__ __forceinline__ unsigned dppf(unsigned v) { return (unsigned)__builtin_amdgcn_update_dpp(-1, (int)v, CTRL, 0xf, 0xf, false); }
__device__ __forceinline__ unsigned wave_sum_u_dpp(unsigned v) {
    v += dpp0<0xB1, 0xf>(v); v += dpp0<0x4E, 0xf>(v); v += dpp0<0x141, 0xf>(v); v += dpp0<0x140, 0xf>(v);
    return (unsigned)__builtin_amdgcn_readlane((int)v, 0) + (unsigned)__builtin_amdgcn_readlane((int)v, 16) + (unsigned)__builtin_amdgcn_readlane((int)v, 32) + (unsigned)__builtin_amdgcn_readlane((int)v, 48);
}
__device__ __forceinline__ unsigned wave_min_u_dpp(unsigned v) {
    unsigned t;
    t = dppf<0xB1>(v); v = t < v ? t : v; t = dppf<0x4E>(v); v = t < v ? t : v; t = dppf<0x141>(v); v = t < v ? t : v; t = dppf<0x140>(v); v = t < v ? t : v;
    const unsigned a = (unsigned)__builtin_amdgcn_readlane((int)v, 0), b = (unsigned)__builtin_amdgcn_readlane((int)v, 16), c = (unsigned)__builtin_amdgcn_readlane((int)v, 32), d = (unsigned)__builtin_amdgcn_readlane((int)v, 48);
    const unsigned ab = a < b ? a : b, cd = c < d ? c : d; return ab < cd ? ab : cd;
}
__device__ __forceinline__ unsigned wave_incl_scan_u_dpp(unsigned v) {
    v += dpp0<0x111, 0xf>(v); v += dpp0<0x112, 0xf>(v); v += dpp0<0x114, 0xf>(v); v += dpp0<0x118, 0xf>(v);
    v += dpp0<0x142, 0xa>(v);
    v += dpp0<0x143, 0xc>(v);
    return v;
}
typedef __attribute__((address_space(3))) unsigned lds_u32;
template <int SHIFT> __device__ __forceinline__ unsigned radix_pass(const unsigned (&key)[64], unsigned pre, lds_u32* hist, int lane, int& need, int jlim, unsigned L) {
    typedef unsigned u32x4v __attribute__((ext_vector_type(4)));
    typedef __attribute__((address_space(3))) u32x4v lds_u32x4;
    const int fl = 63 - lane;
    { const u32x4v z4 = {0u, 0u, 0u, 0u};
      ((lds_u32x4*)(hist + fl * 8))[0] = z4; ((lds_u32x4*)(hist + fl * 8))[1] = z4; }
    const unsigned hb = (unsigned)(size_t)hist + 4u * (unsigned)(lane & 1);
    const unsigned one = 1u;
    asm volatile("" ::: "memory");
#pragma unroll
    for (int j4 = 0; j4 < 16; ++j4) {
        if (4 * j4 <= jlim) {
            unsigned long long c0, c1, c2, c3, sv; unsigned t0, t1, t2, t3;
            if (SHIFT == 24)
                asm volatile(
                    "v_cmp_ge_u32_e64 %0, %9, %13\n\tv_cmp_ge_u32_e64 %1, %10, %13\n\tv_cmp_ge_u32_e64 %2, %11, %13\n\tv_cmp_ge_u32_e64 %3, %12, %13\n\t"
                    "v_lshrrev_b32_e32 %5, 24, %9\n\tv_lshrrev_b32_e32 %6, 24, %10\n\tv_lshrrev_b32_e32 %7, 24, %11\n\tv_lshrrev_b32_e32 %8, 24, %12\n\t"
                    "v_lshl_add_u32 %5, %5, 3, %14\n\tv_lshl_add_u32 %6, %6, 3, %14\n\tv_lshl_add_u32 %7, %7, 3, %14\n\tv_lshl_add_u32 %8, %8, 3, %14\n\t"
                    "s_mov_b64 %4, exec\n\t"
                    "s_mov_b64 exec, %0\n\tds_add_u32 %5, %15\n\ts_mov_b64 exec, %1\n\tds_add_u32 %6, %15\n\ts_mov_b64 exec, %2\n\tds_add_u32 %7, %15\n\ts_mov_b64 exec, %3\n\tds_add_u32 %8, %15\n\t"
                    "s_mov_b64 exec, %4"
                    : "=&s"(c0), "=&s"(c1), "=&s"(c2), "=&s"(c3), "=&s"(sv), "=&v"(t0), "=&v"(t1), "=&v"(t2), "=&v"(t3)
                    : "v"(key[4 * j4]), "v"(key[4 * j4 + 1]), "v"(key[4 * j4 + 2]), "v"(key[4 * j4 + 3]), "v"(L), "v"(hb), "v"(one) : "memory");
            else
                asm volatile(
                    "v_lshrrev_b32_e32 %5, %16, %9\n\tv_lshrrev_b32_e32 %6, %16, %10\n\tv_lshrrev_b32_e32 %7, %16, %11\n\tv_lshrrev_b32_e32 %8, %16, %12\n\t"
                    "v_cmp_eq_u32_e64 %0, %5, %13\n\tv_cmp_eq_u32_e64 %1, %6, %13\n\tv_cmp_eq_u32_e64 %2, %7, %13\n\tv_cmp_eq_u32_e64 %3, %8, %13\n\t"
                    "s_or_b64 %4, %0, %1\n\ts_or_b64 %4, %4, %2\n\ts_or_b64 %4, %4, %3\n\t"
                    "s_cbranch_scc0 .Lrxskip%=\n\t"
                    "v_bfe_u32 %5, %9, %17, 8\n\tv_bfe_u32 %6, %10, %17, 8\n\tv_bfe_u32 %7, %11, %17, 8\n\tv_bfe_u32 %8, %12, %17, 8\n\t"
                    "v_lshl_add_u32 %5, %5, 3, %14\n\tv_lshl_add_u32 %6, %6, 3, %14\n\tv_lshl_add_u32 %7, %7, 3, %14\n\tv_lshl_add_u32 %8, %8, 3, %14\n\t"
                    "s_mov_b64 %4, exec\n\t"
                    "s_mov_b64 exec, %0\n\tds_add_u32 %5, %15\n\ts_mov_b64 exec, %1\n\tds_add_u32 %6, %15\n\ts_mov_b64 exec, %2\n\tds_add_u32 %7, %15\n\ts_mov_b64 exec, %3\n\tds_add_u32 %8, %15\n\t"
                    "s_mov_b64 exec, %4\n"
                    ".Lrxskip%=:"
                    : "=&s"(c0), "=&s"(c1), "=&s"(c2), "=&s"(c3), "=&s"(sv), "=&v"(t0), "=&v"(t1), "=&v"(t2), "=&v"(t3)
                    : "v"(key[4 * j4]), "v"(key[4 * j4 + 1]), "v"(key[4 * j4 + 2]), "v"(key[4 * j4 + 3]), "v"(pre), "v"(hb), "v"(one), "n"((SHIFT + 8) & 31), "n"(SHIFT) : "memory", "scc");
        }
    }
    asm volatile("s_waitcnt lgkmcnt(0)" ::: "memory");
    unsigned dsum[4]; unsigned sumL = 0u;
    { const u32x4v v0 = ((const lds_u32x4*)(hist + fl * 8))[0], v1 = ((const lds_u32x4*)(hist + fl * 8))[1];
      dsum[0] = v0.x + v0.y; dsum[1] = v0.z + v0.w; dsum[2] = v1.x + v1.y; dsum[3] = v1.z + v1.w; sumL = (dsum[0] + dsum[1]) + (dsum[2] + dsum[3]); }
    const unsigned incl = wave_incl_scan_u_dpp(sumL);
    const unsigned above = incl - sumL;
    const bool own = (above < (unsigned)need) && ((unsigned)need <= above + sumL);
    const int owner = __ffsll((long long)__ballot(own)) - 1;
    unsigned acc = above; int sel = -1; unsigned cab = 0u;
#pragma unroll
    for (int i = 3; i >= 0; --i) { const unsigned c = dsum[i]; const bool hit = (sel < 0) && (acc + c >= (unsigned)need); cab = hit ? acc : cab; sel = hit ? i : sel; acc += c; }
    const int ow = owner < 0 ? 0 : owner;
    const unsigned digit = (unsigned)__builtin_amdgcn_readlane(sel, ow) + (unsigned)(4 * (63 - ow));
    need -= (int)__builtin_amdgcn_readlane((int)cab, ow);
    return digit;
}

__device__ __forceinline__ void idx_select(const unsigned (&key)[64], unsigned t3, int jlim, lds_u32* hist, int lane, uint2* mrow, int WV_, unsigned char* lds) {
        unsigned wlo = 0u, whi = 0u;
        unsigned L = wave_min_u_dpp(t3);
        L = L > 1u ? L : 1u;

        int need = 256;
        ITS_E(34); ITS_B();
        const unsigned d1 = radix_pass<24>(key, 0u, hist, lane, need, jlim, L);
        ITS_E(30); ITS_B();
        const unsigned d2 = radix_pass<16>(key, d1, hist, lane, need, jlim, L);
        ITS_E(31); ITS_B();
        const unsigned d3 = radix_pass<8>(key, (d1 << 8) | d2, hist, lane, need, jlim, L);
        const unsigned d4 = radix_pass<0>(key, (d1 << 16) | (d2 << 8) | d3, hist, lane, need, jlim, L);
        const unsigned prefix = (d1 << 24) | (d2 << 16) | (d3 << 8) | d4;
        ITS_E(32); ITS_B();

        int ceq = 0;
#pragma unroll
        for (int j = 0; j < 64; ++j) cnt_eq(ceq, key[j], prefix);
        ceq = (int)wave_sum_u_dpp((unsigned)ceq);
        int X = 4096;
        if (ceq != need) {
            int X0 = 0;
#pragma unroll 1
            for (int bit = 11; bit >= 0; --bit) {
                const int c = X0 | (1 << bit);
                int cnt = 0; const int crel = (c - lane + 63) >> 6;
#pragma unroll
                for (int j = 0; j < 64; ++j) cnt_eq(cnt, (key[j] ^ prefix) | ~(unsigned)((j - crel) >> 31), 0u);
                cnt = wave_sum_i(cnt);
                if (cnt < need) X0 = c;
            }
            X = X0 + 1;
        }
        const int xrel = (X - lane + 63) >> 6;
#pragma unroll
        for (int j4 = 0; j4 < 16; ++j4) {
            if (4 * j4 <= jlim) {
#pragma unroll
                for (int e = 0; e < 4; ++e) { const int j = 4 * j4 + e;
                    const bool sel = (key[j] > prefix) || (key[j] == prefix && j < xrel);
                    const unsigned long long bm = __ballot(sel);
                    asm("v_writelane_b32 %0, %1, %2" : "+v"(wlo) : "s"((unsigned)bm), "n"(j));
                    asm("v_writelane_b32 %0, %1, %2" : "+v"(whi) : "s"((unsigned)(bm >> 32)), "n"(j)); }
            }
        }
        mrow[lane] = make_uint2(wlo, whi);
        ITS_E(33); ITS_B();
}
__device__ void index_fast_phase(int WV_, const bf16* P, unsigned char* mask, float* kmean, float* scratch_all, unsigned* qctr, unsigned char* lds) {
    const int tid = LTID(WV_), lane = tid & 63, wave = tid >> 6, bid = LBID(), G = LGRID();
    float* s_part = (float*)lds;
    ITS_B();
    for (int k = bid; k < 256; k += G) {
        const int b = k >> 6, h = (k >> 4) & 3, blk = k & 15;
        const bf16* kp = P + (size_t)(b * S_ + blk * 256 + wave * 32) * NP + C_KC + h * 64 + lane;
        float a = 0.f;
#pragma unroll 8
        for (int j = 0; j < 32; ++j) a += bf2f(kp[(size_t)j * NP]);
        __syncthreads();
        s_part[wave * 64 + lane] = a;
        __syncthreads();
        if (tid < 64) { float s = 0.f;
#pragma unroll
            for (int w = 0; w < 8; ++w) s += s_part[w * 64 + tid];
            kmean[((b * 4 + h) * 16 + blk) * 64 + tid] = s * (1.0f / 256.0f); }
    }
    ITS_E(22);
    constexpr int IDX_CP = 512 + 4;
    constexpr int IDX_PITCH = 4096 + 32;
    float* scr = scratch_all + (size_t)bid * (16 * IDX_PITCH);
    const int lq = lane & 15, g4 = lane >> 4;
    for (int ui = bid; ui < 1024; ui += G) {
        const int b = ui >> 8, k = ui & 255, tile = (b & 1) ? 255 - k : k, q0 = tile * 16;
        const bf16* Pb = P + (size_t)b * S_ * NP;
        const int ntiles = tile + 1;
        int lane_o = LANEID(); asm volatile("" : "+v"(lane_o));
        const int lane = lane_o, lq = lane & 15, g4 = lane >> 4;
        const int wave = WV_;
        const int qA = q0 + 2 * wave, qB = qA + 1;
        uint2* mrowA = (uint2*)(mask + (size_t)(b * S_ + qA) * 512); uint2* mrowB = (uint2*)(mask + (size_t)(b * S_ + qB) * 512);
        if (tile < 16) {
            unsigned wlo = 0u, whi = 0u, xlo = 0u, xhi = 0u; const int ra = qA - lane * 64, rb = qB - lane * 64;
#pragma unroll
            for (int j = 0; j < 32; ++j) { wlo |= (~(unsigned)((ra - j) >> 31) & 1u) << j; whi |= (~(unsigned)((ra - 32 - j) >> 31) & 1u) << j;
                                           xlo |= (~(unsigned)((rb - j) >> 31) & 1u) << j; xhi |= (~(unsigned)((rb - 32 - j) >> 31) & 1u) << j; }
            mrowA[lane] = make_uint2(wlo, whi); mrowB[lane] = make_uint2(xlo, xhi);
            continue;
        }
        ITS_B();
        bf16x8_t qf[8]; float wi[8];
        { const bf16* qp = Pb + (size_t)(q0 + lq) * NP + C_QI + 8 * g4;
#pragma unroll
          for (int h = 0; h < 8; ++h) qf[h] = *(const bf16x8_t*)(qp + 32 * h);
          const uint4 wv = *(const uint4*)(Pb + (size_t)(q0 + lq) * NP + C_WI); unpack8(wv, wi); }
        bf16x8_t qch, qcl;
        { typedef unsigned u32x4_t __attribute__((ext_vector_type(4)));
          float qc[8];
#pragma unroll
          for (int i = 0; i < 8; ++i) qc[i] = 0.f;
#pragma unroll
          for (int h = 0; h < 8; ++h) { const u32x4_t w4 = __builtin_bit_cast(u32x4_t, qf[h]);
#pragma unroll
              for (int i = 0; i < 4; ++i) { qc[2 * i] += wi[h] * __uint_as_float(w4[i] << 16); qc[2 * i + 1] += wi[h] * __uint_as_float(w4[i] & 0xffff0000u); } }
          u32x4_t hi4, lo4;
#pragma unroll
          for (int i = 0; i < 4; ++i) { const unsigned hw = cvtpk(qc[2 * i], qc[2 * i + 1]); hi4[i] = hw;
              lo4[i] = cvtpk(qc[2 * i] - __uint_as_float(hw << 16), qc[2 * i + 1] - __uint_as_float(hw & 0xffff0000u)); }
          qch = __builtin_bit_cast(bf16x8_t, hi4); qcl = __builtin_bit_cast(bf16x8_t, lo4); }
        typedef __attribute__((address_space(3))) bf16x8_t lds_bf16x8;
        lds_bf16x8* qops = (lds_bf16x8*)((__attribute__((address_space(3))) unsigned char*)lds + 102656);
        if (wave == 0) {
#pragma unroll
            for (int h = 0; h < 8; ++h) qops[h * 64 + lane] = qf[h];
            qops[8 * 64 + lane] = qch; qops[9 * 64 + lane] = qcl; }
        __syncthreads();
        ITS_E(20); ITS_B();
        float* cb0 = (float*)(lds + 69632); float* cb1 = (float*)(lds + 112896);
        const int jlim = q0 >> 6;
        const int jmaxA = (qA - lane) >> 6, jmaxB = (qB - lane) >> 6;
        unsigned keyA[64], keyB[64];
        unsigned a0 = 0u, a1 = 0u, a2 = 0u, a3 = 0u, b0 = 0u, b1 = 0u, b2 = 0u, b3 = 0u;
        const bf16* kbase = Pb + (size_t)lq * NP + C_KI + 8 * g4;
        bf16x8_t nxt = *(const bf16x8_t*)(kbase + (size_t)(wave < ntiles ? wave : 0) * 16 * NP);
#pragma unroll
        for (int c = 0; c < 8; ++c) {
            if (32 * c < ntiles) {
                float* cb = (c & 1) ? cb1 : cb0;
#pragma unroll
                for (int j = 0; j < 4; ++j) {
                    const int kt = 32 * c + wave + 8 * j;
                    const bf16x8_t af = nxt;
                    { const int k = kt + 8; const int kc = k < ntiles ? k : 0; nxt = *(const bf16x8_t*)(kbase + (size_t)kc * 16 * NP); }
                    if (kt < ntiles) {
                        const f32x4_t z = {0.f, 0.f, 0.f, 0.f};
                        f32x4_t sc = __builtin_amdgcn_mfma_f32_16x16x32_bf16(af, qops[8 * 64 + lane], z, 0, 0, 0);
                        sc = __builtin_amdgcn_mfma_f32_16x16x32_bf16(af, qops[9 * 64 + lane], sc, 0, 0, 0);
#pragma unroll
                        for (int hh = 0; hh < 2; ++hh) {
                            f32x4_t a[4];
#pragma unroll
                            for (int h = 0; h < 4; ++h) a[h] = __builtin_amdgcn_mfma_f32_16x16x32_bf16(af, qops[(4 * hh + h) * 64 + lane], z, 0, 0, 0);
#pragma unroll
                            for (int h = 0; h < 4; ++h)
#pragma unroll
                                for (int r = 0; r < 4; ++r) sc[r] = __builtin_fmaf(__builtin_fabsf(a[h][r]), wi[4 * hh + h], sc[r]);
                        }
#pragma unroll
                        for (int r = 0; r < 4; ++r) { sc[r] *= 0.03125f; if (sc[r] == 0.f) sc[r] = 0.f; }
                        *(f32x4_t*)(cb + lq * IDX_CP + (wave + 8 * j) * 16 + 4 * g4) = sc;
                    }
                }
                __syncthreads();
#pragma unroll
                for (int js = 0; js < 8; ++js) {
                    const int slot = 8 * c + js;
                    if (slot <= jlim) {
                        const unsigned ua = __float_as_uint(cb[(2 * wave) * IDX_CP + 64 * js + lane]), ub = __float_as_uint(cb[(2 * wave + 1) * IDX_CP + 64 * js + lane]);
                        const unsigned xa = (ua ^ ((unsigned)((int)ua >> 31) | 0x80000000u)) & ~(unsigned)((jmaxA - slot) >> 31);
                        const unsigned xb = (ub ^ ((unsigned)((int)ub >> 31) | 0x80000000u)) & ~(unsigned)((jmaxB - slot) >> 31);
                        keyA[slot] = xa; keyB[slot] = xb;
                        unsigned n1, n2, n3;
                        asm("v_med3_u32 %0, %1, %2, %3" : "=v"(n3) : "v"(a2), "v"(a3), "v"(xa));
                        asm("v_med3_u32 %0, %1, %2, %3" : "=v"(n2) : "v"(a1), "v"(a2), "v"(xa));
                        asm("v_med3_u32 %0, %1, %2, %3" : "=v"(n1) : "v"(a0), "v"(a1), "v"(xa));
                        a0 = a0 > xa ? a0 : xa; a1 = n1; a2 = n2; a3 = n3;
                        asm("v_med3_u32 %0, %1, %2, %3" : "=v"(n3) : "v"(b2), "v"(b3), "v"(xb));
                        asm("v_med3_u32 %0, %1, %2, %3" : "=v"(n2) : "v"(b1), "v"(b2), "v"(xb));
                        asm("v_med3_u32 %0, %1, %2, %3" : "=v"(n1) : "v"(b0), "v"(b1), "v"(xb));
                        b0 = b0 > xb ? b0 : xb; b1 = n1; b2 = n2; b3 = n3;
                    } else { keyA[slot] = 0u; keyB[slot] = 0u; }
                }
            } else {
#pragma unroll
                for (int js = 0; js < 8; ++js) { keyA[8 * c + js] = 0u; keyB[8 * c + js] = 0u; }
            }
        }
        lds_u32* hist = (lds_u32*)((__attribute__((address_space(3))) unsigned char*)lds + 2048) + wave * 2048;
        ITS_E(23); ITS_B();
        idx_select(keyA, a3, jlim, hist, lane, mrowA, WV_, lds);
        ITS_E(24); ITS_B();
        idx_select(keyB, b3, jlim, hist, lane, mrowB, WV_, lds);
        ITS_E(25); ITS_B();
        __syncthreads();
    }
}

constexpr int MG_P = 72;
constexpr int MG_TILE_BYTES = 128 * MG_P * 2;
__device__ void merge_fast_phase(int WV_, const unsigned char* G8, const bf16* ys, const bf16* wbt  , bf16* merged, unsigned char* lds) {
    const int tid = LTID(WV_), lane = tid & 63, wave = tid >> 6, r32 = lane & 31, hi = lane >> 5, wt = wave & 3, wd = wave >> 2;
    const int srow0 = tid >> 3, sch = tid & 7;
    for (int tile = LBID(); tile < 1024; tile += LGRID()) {
        const int tok0 = (tile >> 3) * 128, d0 = (tile & 7) * 128;
        f32x16_t mer[2], acc[2];
#pragma unroll
        for (int r = 0; r < 16; ++r) { mer[0][r] = 0.f; mer[1][r] = 0.f; acc[0][r] = 0.f; acc[1][r] = 0.f; }
        uint4 RW00, RW01, RW10, RW11, RY00, RY01, RY10, RY11, RG0, RG1;
        unsigned char* gl = lds + 4 * MG_TILE_BYTES;
        const int grow = tid >> 3, gch = tid & 7;
#define MG_GLOAD(st_, R_) do { const int n_ = (st_) >> 2, kc_ = (st_) & 3; \
            RW##R_##0 = *(const uint4*)(wbt + ((size_t)n_ * 1024 + d0 + srow0) * 256 + kc_ * 64 + sch * 8); \
            RW##R_##1 = *(const uint4*)(wbt + ((size_t)n_ * 1024 + d0 + srow0 + 64) * 256 + kc_ * 64 + sch * 8); \
            RY##R_##0 = *(const uint4*)(ys + (size_t)(tok0 + srow0) * 1024 + n_ * 256 + kc_ * 64 + sch * 8); \
            RY##R_##1 = *(const uint4*)(ys + (size_t)(tok0 + srow0 + 64) * 1024 + n_ * 256 + kc_ * 64 + sch * 8); } while (0)
#define MG_SSTORE(buf_, R_) do { bf16* wl_ = (bf16*)(lds + (buf_) * 2 * MG_TILE_BYTES); bf16* yl_ = (bf16*)(lds + (buf_) * 2 * MG_TILE_BYTES + MG_TILE_BYTES); \
            *(uint4*)(wl_ + srow0 * MG_P + sch * 8) = RW##R_##0; *(uint4*)(wl_ + (srow0 + 64) * MG_P + sch * 8) = RW##R_##1; \
            *(uint4*)(yl_ + srow0 * MG_P + sch * 8) = RY##R_##0; *(uint4*)(yl_ + (srow0 + 64) * MG_P + sch * 8) = RY##R_##1; } while (0)
        __syncthreads();
        MG_GLOAD(0, 0); MG_GLOAD(1, 1);
        MG_SSTORE(0, 0);
        __syncthreads();
#define MG_STAGE(PAR_, OTH_) do { const int buf = PAR_; \
            if (st + 2 < 16) MG_GLOAD(st + 2, PAR_); \
            if ((st & 3) == 1) { const unsigned char* gsrc = G8 + (size_t)(tok0 + grow) * 4096 + (st >> 2) * 1024 + d0 + gch * 16; \
                RG0 = *(const uint4*)gsrc; RG1 = *(const uint4*)(gsrc + (size_t)64 * 4096); } \
            const bf16* wl = (const bf16*)(lds + buf * 2 * MG_TILE_BYTES); const bf16* yl = (const bf16*)(lds + buf * 2 * MG_TILE_BYTES + MG_TILE_BYTES); \
            _Pragma("unroll") for (int ks = 0; ks < 4; ++ks) { \
                const bf16x8_t bq = *(const bf16x8_t*)(yl + (32 * wt + r32) * MG_P + 16 * ks + 8 * hi); \
                const bf16x8_t a0 = *(const bf16x8_t*)(wl + (64 * wd + r32) * MG_P + 16 * ks + 8 * hi); \
                const bf16x8_t a1 = *(const bf16x8_t*)(wl + (64 * wd + 32 + r32) * MG_P + 16 * ks + 8 * hi); \
                acc[0] = __builtin_amdgcn_mfma_f32_32x32x16_bf16(a0, bq, acc[0], 0, 0, 0); \
                acc[1] = __builtin_amdgcn_mfma_f32_32x32x16_bf16(a1, bq, acc[1], 0, 0, 0); } \
            if ((st & 3) == 3) { \
                const int n = st >> 2; \
                const unsigned char* gp = gl + (32 * wt + r32) * 144 + 64 * wd + 4 * hi; (void)n; \
                _Pragma("unroll") for (int dt = 0; dt < 2; ++dt) \
                _Pragma("unroll") for (int g = 0; g < 4; ++g) { \
                        const int gv = *(const int*)(gp + 32 * dt + 8 * g); \
                        mer[dt][4 * g + 0] += acc[dt][4 * g + 0] * __builtin_amdgcn_cvt_f32_fp8(gv, 0); \
                        mer[dt][4 * g + 1] += acc[dt][4 * g + 1] * __builtin_amdgcn_cvt_f32_fp8(gv, 1); \
                        mer[dt][4 * g + 2] += acc[dt][4 * g + 2] * __builtin_amdgcn_cvt_f32_fp8(gv, 2); \
                        mer[dt][4 * g + 3] += acc[dt][4 * g + 3] * __builtin_amdgcn_cvt_f32_fp8(gv, 3); } \
                _Pragma("unroll") for (int r = 0; r < 16; ++r) { acc[0][r] = 0.f; acc[1][r] = 0.f; } } \
            if (st + 1 < 16) MG_SSTORE(OTH_, OTH_); \
            if ((st & 3) == 2) { *(uint4*)(gl + grow * 144 + gch * 16) = RG0; *(uint4*)(gl + (grow + 64) * 144 + gch * 16) = RG1; } \
            __syncthreads(); } while (0)
#pragma unroll 1
        for (int st2 = 0; st2 < 16; st2 += 2) { { const int st = st2; MG_STAGE(0, 1); } { const int st = st2 + 1; MG_STAGE(1, 0); } }
#undef MG_STAGE
#undef MG_GLOAD
#undef MG_SSTORE
        bf16* mp = merged + (size_t)(tok0 + 32 * wt + r32) * 1024 + d0 + 64 * wd + 4 * hi;
#pragma unroll
        for (int dt = 0; dt < 2; ++dt)
#pragma unroll
            for (int g = 0; g < 4; ++g)
                *(uint2*)(mp + 32 * dt + 8 * g) = make_uint2(cvtpk(mer[dt][4 * g], mer[dt][4 * g + 1]), cvtpk(mer[dt][4 * g + 2], mer[dt][4 * g + 3]));
    }
}
#define LAS __attribute__((address_space(3)))
#define XB_TMO      128
#define XB_XCNT(j)  (256  + 64 * (j))
#define XB_XSUB(j)  (1280 + 64 * (j))
#define XB_XGEN(j)  (2304 + 64 * (j))
#define XB_TOP      3328
#define XB_TOPGEN   3392
#define XCD_BAR_WORDS 3456
#define XB_SPIN_CAP (1u << 18)

__device__ __forceinline__ unsigned xb_ld(unsigned* p)              { return __hip_atomic_load(p, __ATOMIC_RELAXED, __HIP_MEMORY_SCOPE_AGENT); }
__device__ __forceinline__ unsigned xb_add(unsigned* p, unsigned v) { return __hip_atomic_fetch_add(p, v, __ATOMIC_RELAXED, __HIP_MEMORY_SCOPE_AGENT); }
__device__ __forceinline__ unsigned xb_xcc_id() { return (unsigned)__builtin_amdgcn_s_getreg((3 << 11) | 20) & 0xFu; }
#define XB_SPIN(cond, bar) do { unsigned _sp = 0; while (cond) { __builtin_amdgcn_s_sleep(1); \
    if ((++_sp & 255u) == 0u) { if (xb_ld(&(bar)[XB_TMO])) break; if (_sp > XB_SPIN_CAP) { atomicAdd(&(bar)[XB_TMO], 1u); break; } } } } while (0)

struct XcdBarrier {
    unsigned* bar; unsigned x;
    volatile LAS unsigned* st;
};

__device__ __forceinline__ XcdBarrier xcd_barrier_post(unsigned* bar, volatile LAS unsigned* st) {
    XcdBarrier b; b.bar = bar; b.x = xb_xcc_id(); b.st = st;
    if (threadIdx.x == 0) (void)xb_add(&bar[XB_XCNT(b.x)], 1u);
    return b;
}
__device__ __forceinline__ void xcd_barrier_complete(unsigned* bar, unsigned x, unsigned& nloc, unsigned& nx) {
    const unsigned G = gridDim.x * gridDim.y * gridDim.z;
    unsigned sum, cnt, mine, sp = 0u;
    for (;;) {
        sum = 0u; cnt = 0u; mine = 0u;
#pragma unroll
        for (unsigned j = 0; j < 16; ++j) { const unsigned c = xb_ld(&bar[XB_XCNT(j)]); sum += c; cnt += (c > 0u) ? 1u : 0u; mine = (j == x) ? c : mine; }
        if (sum == G) break;
        __builtin_amdgcn_s_sleep(1);
        if ((++sp & 255u) == 0u) { if (xb_ld(&bar[XB_TMO])) break; if (sp > XB_SPIN_CAP) { atomicAdd(&bar[XB_TMO], 1u); break; } }
    }
    nloc = mine > 0u ? mine : 1u; nx = cnt > 0u ? cnt : 1u;
}

__device__ __forceinline__ void xcd_barrier(const XcdBarrier& b, int wv_) {
    asm volatile("s_waitcnt vmcnt(0)" ::: "memory");
    __syncthreads();
    if (wv_ == 0 && LANEID() == 0) {
        unsigned* bar = b.bar;
        __builtin_amdgcn_s_waitcnt(0);
        unsigned nloc = b.st[0], nx = b.st[1];
        if (nloc == 0u) { xcd_barrier_complete(bar, b.x, nloc, nx); b.st[0] = nloc; b.st[1] = nx; }
        const unsigned old = xb_add(&bar[XB_XSUB(b.x)], 1u);
        const unsigned gen = old / nloc;
        if (old + 1u == (gen + 1u) * nloc) {
            __builtin_amdgcn_fence(__ATOMIC_RELEASE, "agent");
            asm volatile("s_waitcnt vmcnt(0)" ::: "memory");
            const unsigned og = xb_add(&bar[XB_TOP], 1u);
            const unsigned tg = og / nx;
            if (og + 1u == (tg + 1u) * nx) xb_add(&bar[XB_TOPGEN], 1u);
            else XB_SPIN(xb_ld(&bar[XB_TOPGEN]) == tg, bar);
            __builtin_amdgcn_fence(__ATOMIC_ACQUIRE, "agent");
            xb_add(&bar[XB_XGEN(b.x)], 1u);
            asm volatile("s_waitcnt vmcnt(0)" ::: "memory");
        } else {
            XB_SPIN(xb_ld(&bar[XB_XGEN(b.x)]) == gen, bar);
            __builtin_amdgcn_fence(__ATOMIC_ACQUIRE, "agent");
            asm volatile("s_waitcnt vmcnt(0)" ::: "memory");
        }
    }
    __syncthreads();
}

enum { PH_PRO = 0, PH_GIN, PH_INDEX, PH_ATTN, PH_MERGE, PH_GOUT, PH_LN1, PH_GQ, PH_ROUTE, PH_PEER };
template <int PH> __device__ __forceinline__ void run_phase(int WV_, const Params& p_unused, int l, unsigned char* lds_raw) {
    size_t kaoff_ = 0; asm volatile("" : "+s"(kaoff_));
    typedef const __attribute__((address_space(4))) char* kaptr_t;
    const __attribute__((address_space(4))) Params& p = *(const __attribute__((address_space(4))) Params*)((kaptr_t)__builtin_amdgcn_kernarg_segment_ptr() + kaoff_);
    float* sm = (float*)lds_raw;
    size_t wsoff_ = 0; asm volatile("" : "+s"(wsoff_));
    unsigned char* ws = p.ws + wsoff_;
    float* hbuf = p.out;
    bf16* hb = (bf16*)(ws + WS_HB);
    bf16* P = (bf16*)(ws + WS_P);
    bf16* ys = (bf16*)(ws + WS_YS);
    bf16* mrg = (bf16*)(ws + WS_MRG);
    float* mix = (float*)(ws + WS_MIX);
    float* qb = (float*)(ws + WS_Q);
    unsigned char* mask = ws + WS_MASK;
    int* eid = (int*)(ws + WS_EID);
    float* gate = (float*)(ws + WS_GATE);
    float* kmean = (float*)(ws + WS_KMEAN);
    const float* hin = (l == 0) ? p.in[0] : hbuf;
    if (PH == PH_PRO) { Params pc; for (int i = 0; i < 13; ++i) pc.in[i] = p.in[i]; pc.out = p.out; pc.ws = ws;
        prologue_phase(WV_, pc, sm); convert_tables(WV_, pc);
        for (int i = LBID() * NTHR + LTID(WV_); i < DEPTH_ * 8 * 2 * 128 * 64 / 4; i += LGRID() * NTHR) { const float4 v = ((const float4*)p.in[8])[i]; ((uint2*)(ws + WS_SKB))[i] = make_uint2(pk2(v.x, v.y), pk2(v.z, v.w)); } if (LBID() < 2) build_unit_table((unsigned*)(ws + WS_CTL) + 1024, LBID() * NTHR + LTID(WV_)); }
    else if (PH == PH_GIN) {
        pg8::Gemm g{hb, (const bf16*)(ws + WS_WIN_T + l * WIN_T_BYTES), T_, NP, 1024};
        pg8::StaticOrder S; S.init(T_, NP, (int)LGRID(), (int)LBID());
        pg8::EpiBf16Sig E{P, NP, C_G, ws + WS_G8};
        pg8::gemm_phase<pg8::EpiBf16Sig, pg8::StaticOrder, true, true>(WV_, (PG8_LAS unsigned char*)lds_raw, g, S, E);
    }
    else if (PH == PH_INDEX) index_fast_phase(WV_, P, mask, kmean, (float*)(ws + WS_UV + 48 * MiB), (unsigned*)(ws + WS_CTL) + 64 * l + 16, lds_raw);
    else if (PH == PH_ATTN) attn_fast_phase(WV_, P, mask, kmean, p.in[4] + l * 4, ys, (const unsigned*)(ws + WS_CTL) + 1024, (unsigned*)(ws + WS_CTL) + 64 * l, lds_raw);
    else if (PH == PH_MERGE) merge_fast_phase(WV_, ws + WS_G8, ys, (const bf16*)(ws + WS_WBR_T) + (size_t)l * 4 * 1024 * 256, mrg, lds_raw);
    else if (PH == PH_GOUT) {
        pg8::Gemm g{mrg, (const bf16*)(ws + WS_WOUT_T) + (size_t)l * 1024 * 1024, T_, 1024, 1024};
        pg8::StaticOrder S; S.init(T_, 1024, (int)LGRID(), (int)LBID());
        pg8::EpiResY E{l == 0 ? hin : nullptr, hb, hb, (float*)(ws + WS_STATS) + (size_t)l * T_ * 2, ALPHA};
        pg8::gemm_phase<pg8::EpiResY, pg8::StaticOrder, true, true>(WV_, (PG8_LAS unsigned char*)lds_raw, g, S, E);
    }
    else if (PH == PH_GQ) {
        pg8::Gemm g{hb, (const bf16*)(ws + WS_WQ_T) + (size_t)l * 1024 * 1024, T_, 1024, 1024};
        pg8::StaticOrder S; S.init(T_, 1024, (int)LGRID(), (int)LBID());
        pg8::EpiLnFold E{(bf16*)qb, (const float*)(ws + WS_STATS) + (size_t)l * T_ * 2, (const float*)(ws + WS_COLS) + l * 2048, (const float*)(ws + WS_COLS) + l * 2048 + 1024, LN_EPS};
        pg8::gemm_phase<pg8::EpiLnFold, pg8::StaticOrder, true, true>(WV_, (PG8_LAS unsigned char*)lds_raw, g, S, E);
        pg8::Unit u0;
        if (LGRID() == 256 && S.next(0, u0)) {
            asm volatile("s_waitcnt vmcnt(0)" ::: "memory"); __syncthreads();
            route_fast_phase(WV_, (const bf16*)qb, (const bf16*)(ws + WS_SKB) + (size_t)l * 8 * 2 * 128 * 64, eid, gate, lds_raw, u0.pm, u0.pn);
        }
    }
    else if (PH == PH_ROUTE) { if (LGRID() != 256) route_fast_phase(WV_, (const bf16*)qb, (const bf16*)(ws + WS_SKB) + (size_t)l * 8 * 2 * 128 * 64, eid, gate, lds_raw); }
    else peer_fast_phase(WV_, (l + 1 == DEPTH_) ? hbuf : nullptr, hb, eid, gate, ws + WS_UV + (size_t)l * 24 * MiB, p.in[5] + l * 1024, p.in[6] + l * 1024, p.in[11] + l * 1024, p.in[12] + l * 1024, lds_raw);
}

constexpr int CW_BAR = 4096;
constexpr int LDS_BARST = LDS_BYTES - 16;
__global__ void __launch_bounds__(NTHR, 2) mk_fwd(Params p) {
    extern __shared__ __attribute__((aligned(16))) unsigned char lds_raw[];
    cg::grid_group grid = cg::this_grid();
    const int WV_ = __builtin_amdgcn_readfirstlane((int)threadIdx.x >> 6);
    { volatile LAS unsigned* bst0 = (volatile LAS unsigned*)((LAS unsigned char*)lds_raw + LDS_BARST); if (threadIdx.x < 4) bst0[threadIdx.x] = 0u; }
    __syncthreads();
    volatile LAS unsigned* bst = (volatile LAS unsigned*)((LAS unsigned char*)lds_raw + LDS_BARST);
    { uint4* z = (uint4*)p.ws; const uint4 z4 = make_uint4(0u, 0u, 0u, 0u);
      for (unsigned i = (unsigned)LBID() * NTHR + (unsigned)LTID(WV_); i < (unsigned)(2 * MiB / 16); i += (unsigned)LGRID() * NTHR) z[i] = z4; }
    grid.sync();
    (void)xcd_barrier_post((unsigned*)(p.ws + WS_CTL) + CW_BAR, bst);
#define GRID_BAR() do { XcdBarrier b_; b_.bar = (unsigned*)(p.ws + WS_CTL) + CW_BAR; b_.x = xb_xcc_id(); b_.st = (volatile LAS unsigned*)((LAS unsigned char*)lds_raw + LDS_BARST); xcd_barrier(b_, WV_); } while (0)
    run_phase<PH_PRO>(WV_, p, 0, lds_raw);
    GRID_BAR();
#pragma unroll 1
    for (int l = 0; l < DEPTH_; ++l) {
        run_phase<PH_GIN>(WV_, p, l, lds_raw); GRID_BAR();
        run_phase<PH_INDEX>(WV_, p, l, lds_raw); GRID_BAR();
        run_phase<PH_ATTN>(WV_, p, l, lds_raw); GRID_BAR();
        run_phase<PH_MERGE>(WV_, p, l, lds_raw); GRID_BAR();
        run_phase<PH_GOUT>(WV_, p, l, lds_raw); GRID_BAR();
        run_phase<PH_GQ>(WV_, p, l, lds_raw); if (LGRID() != 256) { GRID_BAR(); run_phase<PH_ROUTE>(WV_, p, l, lds_raw); } GRID_BAR();
        run_phase<PH_PEER>(WV_, p, l, lds_raw); if (l + 1 < DEPTH_) GRID_BAR();
    }
}

extern "C" void kernel_launch(void* const* d_in, const int* in_sizes, int n_in, void* d_out, int out_size, void* d_ws, size_t ws_size, hipStream_t stream) {
    if (n_in != 13 || ws_size < WS_END) { fprintf(stderr, "kernel_launch: unexpected n_in %d / ws_size %zu; nothing launched\n", n_in, ws_size); return; }
    static int grid_blocks = 0;
    if (grid_blocks == 0) {
        int dev = 0, cus = 0, per_cu = 0;
        (void)hipGetDevice(&dev);
        (void)hipDeviceGetAttribute(&cus, hipDeviceAttributeMultiprocessorCount, dev);
        (void)hipFuncSetAttribute((const void*)mk_fwd, hipFuncAttributeMaxDynamicSharedMemorySize, LDS_BYTES);
        (void)hipOccupancyMaxActiveBlocksPerMultiprocessor(&per_cu, (const void*)mk_fwd, NTHR, LDS_BYTES);
        if (per_cu < 1) fprintf(stderr, "kernel_launch: occupancy query reports %d\n", per_cu);
        grid_blocks = cus;
    }
    Params p{};
    for (int i = 0; i < 13; ++i) p.in[i] = (const float*)d_in[i];
    p.out = (float*)d_out; p.ws = (unsigned char*)d_ws;
    void* args[] = {&p};
    hipError_t e = hipLaunchCooperativeKernel((const void*)mk_fwd, dim3(grid_blocks), dim3(NTHR), args, LDS_BYTES, stream);
    if (e != hipSuccess) fprintf(stderr, "cooperative launch failed: %s (grid %d)\n", hipGetErrorString(e), grid_blocks);
}
```

```cpp
#include <hip/hip_runtime.h>
#include <cstdio>
#include <cstdint>
#include <hip/hip_cooperative_groups.h>
namespace cg = cooperative_groups;

__device__ __forceinline__ int LANEID() { int l; asm volatile("v_mbcnt_lo_u32_b32 %0, -1, 0\n\tv_mbcnt_hi_u32_b32 %0, -1, %0" : "=v"(l)); return l; }
__device__ __forceinline__ int LTID(int wv) { return (wv << 6) | LANEID(); }
__device__ __forceinline__ int LBID() { int t = blockIdx.x; asm volatile("" : "+s"(t)); return t; }
__device__ __forceinline__ int LGRID() { int t = gridDim.x; asm volatile("" : "+s"(t)); return t; }
namespace pg8 {
#define PG8_LAS __attribute__((address_space(3)))
typedef unsigned short bf16_t;
typedef short bf16x8 __attribute__((ext_vector_type(8)));
typedef float f32x4 __attribute__((ext_vector_type(4)));
typedef unsigned u32x4 __attribute__((ext_vector_type(4)));
constexpr int BM = 256, BK = 64, HALF = 128, HTB = HALF * BK * 2  , STAGE_BYTES = 8 * HTB, NXCD = 8, WGM = 8;

__host__ __device__ __forceinline__ int lds_byte(int r, int c) { const int st = (r >> 4) * 2 + (c >> 5), rr = r & 15, cc = c & 31, ob = rr * 64 + cc * 2; return st * 1024 + (ob ^ (((ob >> 9) & 1) << 5)); }
__host__ __device__ __forceinline__ void stage_rc(int b, int& R, int& C) { const int st = b / 1024, sb = b % 1024, swz = sb ^ (((sb >> 9) & 1) << 5); R = (st >> 1) * 16 + swz / 64; C = (st & 1) * 32 + (swz % 64) / 2; }
__host__ __device__ __forceinline__ int perm32(int rho) { const int n = rho >> 4, i = rho & 15; return 8 * (i >> 2) + 4 * n + (i & 3); }

struct Unit { int pm, pn; };
struct Gemm { const bf16_t* A; const bf16_t* Bt; int M, N, K; };

struct StaticOrder {
    int nM, nN, nwg, G, c;
    __host__ __device__ void init(int M, int N, int G_, int c_) { nM = M / BM; nN = N / BM; nwg = nM * nN; G = G_; c = c_; }
    __host__ __device__ bool next(int i, Unit& u) const {
        const long L = (long)i * G + c; if (L >= nwg) return false;
        int wgid = (int)L; { const int q = nwg / NXCD, r = nwg % NXCD, xcd = wgid % NXCD, off = wgid / NXCD; wgid = (xcd < r ? xcd * (q + 1) : r * (q + 1) + (xcd - r) * q) + off; }
        const int nig = WGM * nN, gid = wgid / nig, fm = gid * WGM, gsz = (nM - fm) < WGM ? (nM - fm) : WGM;
        u.pm = fm + ((wgid % nig) % gsz); u.pn = (wgid % nig) / gsz; return true;
    }
    __device__ __forceinline__ void a_ready(const Unit&) const {}
    __device__ __forceinline__ void done(const Unit&) const {}
};

__device__ __forceinline__ unsigned cvt_pk_bf16(float lo, float hi) { unsigned r; asm volatile("v_cvt_pk_bf16_f32 %0, %1, %2" : "=v"(r) : "v"(lo), "v"(hi)); return r; }
typedef float f32x2 __attribute__((ext_vector_type(2)));
__device__ __forceinline__ f32x2 gelu_pk(f32x2 v) {
    const f32x2 av = __builtin_elementwise_abs(v), d = av * 0.2316418882f + 1.0f;
    f32x2 t; t.x = __builtin_amdgcn_rcpf(d.x); t.y = __builtin_amdgcn_rcpf(d.y);
    f32x2 q = t * 0.5307027145f + (-0.7265760135f); q = q * t + 0.7107068705f; q = q * t + (-0.142248368f); q = q * t + 0.127414796f; q = q * t;
    const f32x2 s = (v * v) * (-0.72134752044f);
    f32x2 e; e.x = __builtin_amdgcn_exp2f(s.x); e.y = __builtin_amdgcn_exp2f(s.y);
    const f32x2 m = v * (q * e), r = v - m;
    f32x2 o; o.x = v.x < 0.f ? m.x : r.x; o.y = v.y < 0.f ? m.y : r.y; return o;
}

template <int ACT  > struct EpiBf16 {
    static constexpr bool PERM = true, AFTER_DRAIN = false; static_assert(ACT == 0 || ACT == 1, "EpiBf16: ACT is 0 (none) or 1 (gelu_pk)");
    bf16_t* O; int ldc; const float* bias; int split_cols; size_t split_stride; float scale0;
    __device__ __forceinline__ void operator()(const f32x4 (&acc)[2][2][4][2], const Unit& u, int wr, int wc, int fr, int fq) const {
        { int ln_ = LANEID(); asm volatile("" : "+v"(ln_)); fr = ln_ & 15; fq = ln_ >> 4; }
        const int row0 = u.pm * BM + wr * 64 + fr; int colt = u.pn * BM; bf16_t* base = O;
        float sc = 1.f; if (split_cols) { const int t = colt / split_cols; base += (size_t)t * split_stride; colt -= t * split_cols; if (t == 0) sc = scale0; }
        const int col0 = colt + wc * 32 + 8 * fq, bcol0 = u.pn * BM + wc * 32 + 8 * fq;
        f32x4 bv[2][2];
#pragma unroll
        for (int bj = 0; bj < 2; ++bj)
#pragma unroll
            for (int n = 0; n < 2; ++n) bv[bj][n] = bias ? *(const f32x4*)(bias + bcol0 + bj * HALF + 4 * n) : (f32x4){0.f, 0.f, 0.f, 0.f};
#pragma unroll
        for (int ai = 0; ai < 2; ++ai)
#pragma unroll
            for (int m = 0; m < 4; ++m) { bf16_t* rowp = base + (size_t)(row0 + ai * HALF + m * 16) * ldc + col0;
#pragma unroll
                for (int bj = 0; bj < 2; ++bj) { f32x4 v0 = acc[ai][bj][m][0] + bv[bj][0], v1 = acc[ai][bj][m][1] + bv[bj][1];
                    if (ACT == 1) { f32x2 a = gelu_pk((f32x2){v0[0], v0[1]}), b = gelu_pk((f32x2){v0[2], v0[3]}), c = gelu_pk((f32x2){v1[0], v1[1]}), d = gelu_pk((f32x2){v1[2], v1[3]});
                        v0 = (f32x4){a.x, a.y, b.x, b.y}; v1 = (f32x4){c.x, c.y, d.x, d.y}; }
                    v0 = v0 * sc; v1 = v1 * sc; u32x4 w; w.x = cvt_pk_bf16(v0[0], v0[1]); w.y = cvt_pk_bf16(v0[2], v0[3]); w.z = cvt_pk_bf16(v1[0], v1[1]); w.w = cvt_pk_bf16(v1[2], v1[3]);
                    *(u32x4*)(rowp + bj * HALF) = w; } }
    }
};
template <class Epi, class Sched, bool ALIGN_EPI = false, bool SP2 = false>
__device__ __forceinline__ void gemm_phase(int WV_, PG8_LAS unsigned char* lds, const Gemm g, const Sched& S, const Epi& E) {
    const int tid = LTID(WV_), wid = __builtin_amdgcn_readfirstlane(tid >> 6), lane = tid & 63, wr = wid >> 2, wc = wid & 3, fr = lane & 15, fq = lane >> 4;
    const int K = g.K, nt = K / BK;
    unsigned voffA[2], voffB[2];
#pragma unroll
    for (int i = 0; i < 2; ++i) { int R, C; stage_rc(tid * 16 + i * 8192, R, C); const int Rb = Epi::PERM ? ((R & ~31) + perm32(R & 31)) : R;
        voffA[i] = (unsigned)(R * K + C) * 2u; voffB[i] = (unsigned)(Rb * K + C) * 2u; }
    const size_t kstep = (size_t)(BK * 2);
    const size_t hstep = (size_t)HALF * K * 2;
    const size_t tstep = 2 * hstep;
    const unsigned ldsw = (unsigned)wid * 1024u;
    const int aoff = lds_byte(wr * 64 + fr, fq * 8), boff = lds_byte(wc * 32 + fr, fq * 8);
#define PG8_SA(b, h) (((b) * 2 + (h)) * HTB)
#define PG8_SB(b, h) ((4 + (b) * 2 + (h)) * HTB)
#define PG8_STAGE(bufoff, gbase, voff) do { _Pragma("unroll") for (int _i = 0; _i < 2; ++_i) \
        __builtin_amdgcn_global_load_lds((const unsigned*)((const char*)(gbase) + (voff)[_i]), (PG8_LAS unsigned*)(lds + (bufoff) + ldsw + _i * 8192), 16, 0, 0); } while (0)
#define PG8_LDA(dst, b, h) do { _Pragma("unroll") for (int m = 0; m < 4; ++m) _Pragma("unroll") for (int k = 0; k < 2; ++k) dst[m][k] = *(const PG8_LAS bf16x8*)(lds + PG8_SA(b, h) + aoff + m * 2048 + k * 1024); } while (0)
#define PG8_LDB(dst, b, h) do { _Pragma("unroll") for (int n = 0; n < 2; ++n) _Pragma("unroll") for (int k = 0; k < 2; ++k) dst[n][k] = *(const PG8_LAS bf16x8*)(lds + PG8_SB(b, h) + boff + n * 2048 + k * 1024); } while (0)
#define PG8_MMA(ai, bj, At, Bt) do { __builtin_amdgcn_s_setprio(1); _Pragma("unroll") for (int m = 0; m < 4; ++m) _Pragma("unroll") for (int n = 0; n < 2; ++n) _Pragma("unroll") for (int k = 0; k < 2; ++k) \
        acc[ai][bj][m][n] = __builtin_amdgcn_mfma_f32_16x16x32_bf16(Bt[n][k], At[m][k], acc[ai][bj][m][n], 0, 0, 0); __builtin_amdgcn_s_setprio(0); } while (0)
#define PG8_WAIT_V(n) asm volatile("s_waitcnt vmcnt(" #n ")" ::: "memory")
#define PG8_WAIT_L(n) asm volatile("s_waitcnt lgkmcnt(" #n ")" ::: "memory")
#define PG8_BAR __builtin_amdgcn_s_barrier()
#define PG8_SCHED __builtin_amdgcn_sched_barrier(0)
    Unit cur, nxt; int ui = 0;
    if (!S.next(0, cur)) return;
    f32x4 acc[2][2][4][2];
#pragma unroll
    for (int a = 0; a < 2; ++a)
#pragma unroll
        for (int b = 0; b < 2; ++b)
#pragma unroll
            for (int m = 0; m < 4; ++m)
#pragma unroll
                for (int n = 0; n < 2; ++n) acc[a][b][m][n] = (f32x4){0.f, 0.f, 0.f, 0.f};
    bf16x8 At[4][2], B0[2][2], B1[2][2];
    const char* cA = (const char*)g.A + (size_t)cur.pm * tstep; const char* cB = (const char*)g.Bt + (size_t)cur.pn * tstep;
    S.a_ready(cur);
    if constexpr (SP2) {
        PG8_STAGE(PG8_SB(0, 0), cB, voffB); PG8_STAGE(PG8_SB(0, 1), cB + hstep, voffB); PG8_STAGE(PG8_SA(0, 0), cA, voffA); PG8_STAGE(PG8_SA(0, 1), cA + hstep, voffA);
        if (wr == 1) PG8_BAR;
        PG8_WAIT_V(2); PG8_BAR;
        PG8_STAGE(PG8_SB(1, 0), cB + kstep, voffB); PG8_STAGE(PG8_SA(1, 0), cA + kstep, voffA); PG8_STAGE(PG8_SB(1, 1), cB + hstep + kstep, voffB);
        PG8_WAIT_V(6); PG8_BAR;
    } else {
        PG8_STAGE(PG8_SB(0, 0), cB, voffB); PG8_STAGE(PG8_SA(0, 0), cA, voffA); PG8_STAGE(PG8_SB(0, 1), cB + hstep, voffB); PG8_STAGE(PG8_SA(0, 1), cA + hstep, voffA);
        if (wr == 1) PG8_BAR;
        PG8_WAIT_V(4); PG8_BAR;
        PG8_STAGE(PG8_SB(1, 0), cB + kstep, voffB); PG8_STAGE(PG8_SA(1, 0), cA + kstep, voffA); PG8_STAGE(PG8_SB(1, 1), cB + hstep + kstep, voffB);
        PG8_WAIT_V(6); PG8_BAR;
    }
    for (;;) {
        const bool has_next = S.next(ui + 1, nxt);
        const char* nA = has_next ? (const char*)g.A + (size_t)nxt.pm * tstep : cA; const char* nB = has_next ? (const char*)g.Bt + (size_t)nxt.pn * tstep : cB;
        for (int t = 0; t < nt; t += 2) {
            const bool last = (t == nt - 2);
            const char* a1 = cA + (size_t)(t + 1) * kstep;
            const char* a2 = last ? nA : cA + (size_t)(t + 2) * kstep; const char* b2 = last ? nB : cB + (size_t)(t + 2) * kstep;
            const char* a3 = a2 + kstep; const char* b3 = b2 + kstep;
            if (last && has_next) S.a_ready(nxt);
            if constexpr (SP2) {
            PG8_LDB(B0, 0, 0); PG8_LDB(B1, 0, 1); PG8_SCHED; PG8_LDA(At, 0, 0); PG8_STAGE(PG8_SA(1, 1), a1 + hstep, voffA);
            PG8_WAIT_V(8); PG8_WAIT_L(0); PG8_BAR; PG8_MMA(0, 0, At, B0); PG8_MMA(0, 1, At, B1); PG8_BAR; PG8_SCHED;
            PG8_LDA(At, 0, 1); PG8_STAGE(PG8_SB(0, 0), b2, voffB); PG8_STAGE(PG8_SB(0, 1), b2 + hstep, voffB); PG8_STAGE(PG8_SA(0, 0), a2, voffA);
            PG8_WAIT_V(8); PG8_WAIT_L(0); PG8_BAR; PG8_MMA(1, 0, At, B0); PG8_MMA(1, 1, At, B1); PG8_BAR; PG8_SCHED;
            PG8_LDB(B0, 1, 0); PG8_LDB(B1, 1, 1); PG8_SCHED; PG8_LDA(At, 1, 0); PG8_STAGE(PG8_SA(0, 1), a2 + hstep, voffA);
            PG8_WAIT_V(8); PG8_WAIT_L(0); PG8_BAR; PG8_MMA(0, 0, At, B0); PG8_MMA(0, 1, At, B1); PG8_BAR; PG8_SCHED;
            PG8_LDA(At, 1, 1); PG8_STAGE(PG8_SB(1, 0), b3, voffB); PG8_STAGE(PG8_SB(1, 1), b3 + hstep, voffB); PG8_STAGE(PG8_SA(1, 0), a3, voffA);
            PG8_WAIT_V(8); PG8_WAIT_L(0); PG8_BAR; PG8_MMA(1, 0, At, B0); PG8_MMA(1, 1, At, B1); PG8_BAR; PG8_SCHED;
            } else {
            PG8_LDB(B0, 0, 0); PG8_SCHED; PG8_LDA(At, 0, 0); PG8_STAGE(PG8_SA(1, 1), a1 + hstep, voffA);
            PG8_WAIT_L(8); PG8_BAR; PG8_WAIT_L(0); PG8_MMA(0, 0, At, B0); PG8_BAR; PG8_SCHED;
            PG8_LDB(B1, 0, 1); PG8_STAGE(PG8_SB(0, 0), b2, voffB);
            PG8_BAR; PG8_WAIT_L(0); PG8_MMA(0, 1, At, B1); PG8_BAR;
            PG8_LDA(At, 0, 1); PG8_STAGE(PG8_SA(0, 0), a2, voffA);
            PG8_BAR; PG8_WAIT_L(0); PG8_MMA(1, 0, At, B0); PG8_BAR; PG8_SCHED;
            PG8_STAGE(PG8_SB(0, 1), b2 + hstep, voffB);
            PG8_WAIT_V(6); PG8_BAR; PG8_MMA(1, 1, At, B1); PG8_BAR;
            PG8_LDB(B0, 1, 0); PG8_SCHED; PG8_LDA(At, 1, 0); PG8_STAGE(PG8_SA(0, 1), a2 + hstep, voffA);
            PG8_WAIT_L(8); PG8_BAR; PG8_WAIT_L(0); PG8_MMA(0, 0, At, B0); PG8_BAR; PG8_SCHED;
            PG8_LDB(B1, 1, 1); PG8_STAGE(PG8_SB(1, 0), b3, voffB);
            PG8_BAR; PG8_WAIT_L(0); PG8_MMA(0, 1, At, B1); PG8_BAR;
            PG8_LDA(At, 1, 1); PG8_STAGE(PG8_SA(1, 0), a3, voffA);
            PG8_BAR; PG8_WAIT_L(0); PG8_MMA(1, 0, At, B0); PG8_BAR; PG8_SCHED;
            PG8_STAGE(PG8_SB(1, 1), b3 + hstep, voffB);
            PG8_WAIT_V(6); PG8_BAR; PG8_MMA(1, 1, At, B1); PG8_BAR;
            }
        }
        if constexpr (ALIGN_EPI) { if (wr == 0) PG8_BAR; }
        if constexpr (!Epi::AFTER_DRAIN) { E(acc, cur, wr, wc, fr, fq); S.done(cur); }
        if (!has_next) break;
#pragma unroll
        for (int a = 0; a < 2; ++a)
#pragma unroll
            for (int b = 0; b < 2; ++b)
#pragma unroll
                for (int m = 0; m < 4; ++m)
#pragma unroll
                    for (int n = 0; n < 2; ++n) acc[a][b][m][n] = (f32x4){0.f, 0.f, 0.f, 0.f};
        cur = nxt; cA = nA; cB = nB; ++ui;
        if constexpr (ALIGN_EPI) { if (wr == 1) PG8_BAR; }
    }
    PG8_WAIT_V(0);
    if constexpr (!ALIGN_EPI) { if (wr == 0) PG8_BAR; }
    PG8_BAR;
    if constexpr (Epi::AFTER_DRAIN) { E.fused(acc, cur, wr, wc, fr, fq, lds, wid, lane); S.done(cur); }
#undef PG8_SA
#undef PG8_SB
#undef PG8_STAGE
#undef PG8_LDA
#undef PG8_LDB
#undef PG8_MMA
#undef PG8_WAIT_V
#undef PG8_WAIT_L
#undef PG8_BAR
#undef PG8_SCHED
}
}
namespace pg8 {
struct EpiF32 {
    static constexpr bool PERM = false, AFTER_DRAIN = false;
    float* O; int ldc;
    __device__ __forceinline__ void operator()(const f32x4 (&acc)[2][2][4][2], const Unit& u, int wr, int wc, int fr, int fq) const {
        { int ln_ = LANEID(); asm volatile("" : "+v"(ln_)); fr = ln_ & 15; fq = ln_ >> 4; }
        const int row0 = u.pm * BM + wr * 64 + fr, col0 = u.pn * BM + wc * 32 + 4 * fq;
#pragma unroll
        for (int ai = 0; ai < 2; ++ai)
#pragma unroll
            for (int m = 0; m < 4; ++m) { float* rowp = O + (size_t)(row0 + ai * HALF + m * 16) * ldc + col0;
#pragma unroll
                for (int bj = 0; bj < 2; ++bj)
#pragma unroll
                    for (int n = 0; n < 2; ++n) *(f32x4*)(rowp + bj * HALF + n * 16) = acc[ai][bj][m][n]; }
    }
};
struct EpiResY {
    static constexpr bool PERM = false, AFTER_DRAIN = false;
    const float* hin; const bf16_t* hinb; bf16_t* yb; float* stats; float alpha;
    __device__ __forceinline__ void operator()(const f32x4 (&acc)[2][2][4][2], const Unit& u, int wr, int wc, int fr, int fq) const {
        { int ln_ = LANEID(); asm volatile("" : "+v"(ln_)); fr = ln_ & 15; fq = ln_ >> 4; }
        const int row0 = u.pm * BM + wr * 64 + fr, col0 = u.pn * BM + wc * 32 + 4 * fq;
#pragma unroll
        for (int ai = 0; ai < 2; ++ai)
#pragma unroll
            for (int m = 0; m < 4; ++m) {
                const int row = row0 + ai * HALF + m * 16;
                float s = 0.f, s2 = 0.f;
#pragma unroll
                for (int bj = 0; bj < 2; ++bj)
#pragma unroll
                    for (int n = 0; n < 2; ++n) {
                        const size_t off = (size_t)row * 1024 + col0 + bj * HALF + n * 16;
                        f32x4 hv;
                        if (hin) hv = *(const f32x4*)(hin + off);
                        else { typedef unsigned u32x2r __attribute__((ext_vector_type(2))); const u32x2r hw = *(const u32x2r*)(hinb + off);
                            hv[0] = __uint_as_float(hw.x << 16); hv[1] = __uint_as_float(hw.x & 0xffff0000u); hv[2] = __uint_as_float(hw.y << 16); hv[3] = __uint_as_float(hw.y & 0xffff0000u); }
                        const f32x4 y = hv * alpha + acc[ai][bj][m][n];
                        typedef unsigned u32x2v __attribute__((ext_vector_type(2)));
                        u32x2v w; w.x = cvt_pk_bf16(y[0], y[1]); w.y = cvt_pk_bf16(y[2], y[3]);
                        *(u32x2v*)(yb + off) = w;
                        s += (y[0] + y[1]) + (y[2] + y[3]); s2 += (y[0] * y[0] + y[1] * y[1]) + (y[2] * y[2] + y[3] * y[3]);
                    }
                s += __shfl_xor(s, 16); s += __shfl_xor(s, 32); s2 += __shfl_xor(s2, 16); s2 += __shfl_xor(s2, 32);
                if (fq == 0) { atomicAdd(stats + 2 * (size_t)row, s); atomicAdd(stats + 2 * (size_t)row + 1, s2); }
            }
    }
};
struct EpiLnFold {
    static constexpr bool PERM = true, AFTER_DRAIN = false;
    bf16_t* O; const float* stats; const float* colsum; const float* colbias; float eps;
    __device__ __forceinline__ void operator()(const f32x4 (&acc)[2][2][4][2], const Unit& u, int wr, int wc, int fr, int fq) const {
        { int ln_ = LANEID(); asm volatile("" : "+v"(ln_)); fr = ln_ & 15; fq = ln_ >> 4; }
        const int row0 = u.pm * BM + wr * 64 + fr, col0 = u.pn * BM + wc * 32 + 8 * fq;
        f32x4 cs[2][2], cb[2][2];
#pragma unroll
        for (int bj = 0; bj < 2; ++bj)
#pragma unroll
            for (int n = 0; n < 2; ++n) { cs[bj][n] = *(const f32x4*)(colsum + col0 + bj * HALF + 4 * n); cb[bj][n] = *(const f32x4*)(colbias + col0 + bj * HALF + 4 * n); }
#pragma unroll
        for (int ai = 0; ai < 2; ++ai)
#pragma unroll
            for (int m = 0; m < 4; ++m) {
                const int row = row0 + ai * HALF + m * 16;
                const float sm_ = stats[2 * (size_t)row], sq_ = stats[2 * (size_t)row + 1];
                const float mean = sm_ * (1.0f / 1024.0f);
                const float rstd = 1.0f / sqrtf(fmaxf(sq_ * (1.0f / 1024.0f) - mean * mean, 0.f) + eps);
                bf16_t* rowp = O + (size_t)row * 1024 + col0;
#pragma unroll
                for (int bj = 0; bj < 2; ++bj) {
                    const f32x4 v0 = (acc[ai][bj][m][0] - cs[bj][0] * mean) * rstd + cb[bj][0], v1 = (acc[ai][bj][m][1] - cs[bj][1] * mean) * rstd + cb[bj][1];
                    u32x4 w; w.x = cvt_pk_bf16(v0[0], v0[1]); w.y = cvt_pk_bf16(v0[2], v0[3]); w.z = cvt_pk_bf16(v1[0], v1[1]); w.w = cvt_pk_bf16(v1[2], v1[3]);
                    *(u32x4*)(rowp + bj * HALF) = w;
                }
            }
    }
};
__device__ __forceinline__ unsigned cvt_pk_bf16_t(float lo, float hi) { unsigned r; asm volatile("s_nop 0\n\tv_cvt_pk_bf16_f32 %0, %1, %2" : "=v"(r) : "v"(lo), "v"(hi)); return r; }
struct EpiBf16Sig {
    static constexpr bool PERM = true, AFTER_DRAIN = false;
    bf16_t* O; int ldc; int sig_col0; unsigned char* G8;
    __device__ __forceinline__ void operator()(const f32x4 (&acc)[2][2][4][2], const Unit& u, int wr, int wc, int fr, int fq) const {
        { int ln_ = LANEID(); asm volatile("" : "+v"(ln_)); fr = ln_ & 15; fq = ln_ >> 4; }
        const int row0 = u.pm * BM + wr * 64 + fr; const int col0 = u.pn * BM + wc * 32 + 8 * fq;
#pragma unroll
        for (int bj = 0; bj < 2; ++bj) {
            if (col0 + bj * HALF >= sig_col0) {
                { const int gc = col0 + bj * HALF - sig_col0;
                  if (gc < 4096) {
#pragma unroll
                    for (int ai = 0; ai < 2; ++ai)
#pragma unroll
                        for (int m = 0; m < 4; ++m) {
                            f32x4 v0 = acc[ai][bj][m][0], v1 = acc[ai][bj][m][1];
#pragma unroll
                            for (int e = 0; e < 4; ++e) { v0[e] = __builtin_amdgcn_rcpf(1.f + __builtin_amdgcn_exp2f(-1.44269504f * v0[e])); v1[e] = __builtin_amdgcn_rcpf(1.f + __builtin_amdgcn_exp2f(-1.44269504f * v1[e])); }
                            int w0 = __builtin_amdgcn_cvt_pk_fp8_f32(v0[0], v0[1], 0, false); w0 = __builtin_amdgcn_cvt_pk_fp8_f32(v0[2], v0[3], w0, true);
                            int w1 = __builtin_amdgcn_cvt_pk_fp8_f32(v1[0], v1[1], 0, false); w1 = __builtin_amdgcn_cvt_pk_fp8_f32(v1[2], v1[3], w1, true);
                            typedef int i32x2v __attribute__((ext_vector_type(2)));
                            i32x2v w; w.x = w0; w.y = w1;
                            *(i32x2v*)(G8 + (size_t)(row0 + ai * HALF + m * 16) * 4096 + gc) = w; }
                  } }
            } else {
#pragma unroll
                for (int ai = 0; ai < 2; ++ai)
#pragma unroll
                    for (int m = 0; m < 4; ++m) { bf16_t* rowp = O + (size_t)(row0 + ai * HALF + m * 16) * ldc + col0;
                        const f32x4 v0 = acc[ai][bj][m][0], v1 = acc[ai][bj][m][1];
                        u32x4 w; w.x = cvt_pk_bf16(v0[0], v0[1]); w.y = cvt_pk_bf16(v0[2], v0[3]); w.z = cvt_pk_bf16(v1[0], v1[1]); w.w = cvt_pk_bf16(v1[2], v1[3]);
                        *(u32x4*)(rowp + bj * HALF) = w; }
            }
        }
    }
};
}

typedef unsigned short bf16;
constexpr int T_ = 16384, S_ = 4096, NBATCH = 4, D_ = 1024, NCOL = 6824, NP = 6912, DEPTH_ = 2;
constexpr int C_QA = 0, C_KA = 256, C_VA = 320, C_QI = 384, C_KI = 640, C_WI = 672, C_QB = 680, C_KB = 936, C_VB = 1064,
              C_QC = 1192, C_KC = 1448, C_VC = 1704, C_QD = 1960, C_KD = 2216, C_VD = 2472, C_G = 2728;
constexpr int NTHR = 512, NWAVE = 8;
constexpr float ALPHA = 1.41421356237309515f;
constexpr float LN_EPS = 1e-5f;
constexpr size_t MiB = 1u << 20;
constexpr size_t WS_STATS = 1 * MiB  , WS_COLS = 1 * MiB + 512 * 1024  ;
constexpr size_t WS_CTL = 0, WS_WIN_T = 2 * MiB, WS_WOUT_T = 30 * MiB, WS_WQ_T = 34 * MiB, WS_WBR_T = 38 * MiB, WS_HB = 42 * MiB,
                 WS_P = 74 * MiB, WS_MIX = 74 * MiB  , WS_Q = 138 * MiB  , WS_G8 = 428 * MiB  , WS_YS = 290 * MiB, WS_MRG = 322 * MiB,
                 WS_MASK = 354 * MiB, WS_EID = 362 * MiB, WS_GATE = 370 * MiB, WS_KMEAN = 378 * MiB, WS_SKB = 379 * MiB, WS_UV = 380 * MiB, WS_END = 508 * MiB;
constexpr size_t WIN_T_BYTES = (size_t)NP * 1024 * 2;
constexpr int LDS_BYTES = 144 * 1024;

struct Params { const float* in[13]; float* out; unsigned char* ws; };

__device__ __forceinline__ float bf2f(bf16 v) { return __uint_as_float((unsigned)v << 16); }
__device__ __forceinline__ unsigned f2bf(float f) { unsigned u = __float_as_uint(f); return (u + 0x7fffu + ((u >> 16) & 1u)) >> 16; }
__device__ __forceinline__ unsigned pk2(float lo, float hi) { return f2bf(lo) | (f2bf(hi) << 16); }
__device__ __forceinline__ void unpack8(const uint4 v, float* o) {
    o[0] = __uint_as_float(v.x << 16); o[1] = __uint_as_float(v.x & 0xffff0000u); o[2] = __uint_as_float(v.y << 16); o[3] = __uint_as_float(v.y & 0xffff0000u);
    o[4] = __uint_as_float(v.z << 16); o[5] = __uint_as_float(v.z & 0xffff0000u); o[6] = __uint_as_float(v.w << 16); o[7] = __uint_as_float(v.w & 0xffff0000u);
}
__device__ __forceinline__ float wave_sum(float v) {
#pragma unroll
    for (int o = 32; o > 0; o >>= 1) v += __shfl_xor(v, o);
    return v;
}
__device__ __forceinline__ float wave_max(float v) {
#pragma unroll
    for (int o = 32; o > 0; o >>= 1) v = fmaxf(v, __shfl_xor(v, o));
    return v;
}
__device__ __forceinline__ int wave_sum_i(int v) {
#pragma unroll
    for (int o = 32; o > 0; o >>= 1) v += __shfl_xor(v, o);
    return v;
}
__device__ __forceinline__ float logsig(float x) { return fminf(x, 0.f) - log1pf(expf(-fabsf(x))); }

__device__ void transpose_items(int WV_, const float* W, int K, int N, bf16* WT, float* sm, int item0, int nitems_total, int item_stride,
                                const float* rs_g = nullptr, const float* rs_b = nullptr, float* colsum = nullptr, float* colbias = nullptr) {
    const int tid = LTID(WV_);
    const int nkb = K / 64, nnb = (N + 63) / 64;
    for (int it = item0; it < nkb * nnb; it += item_stride) {
        const int kb = it % nkb, nb = it / nkb, k0 = kb * 64, n0 = nb * 64;
        __syncthreads();
        for (int e = tid; e < 64 * 64; e += NTHR) { const int kk = e >> 6, nn = e & 63; sm[kk * 65 + nn] = (n0 + nn < N) ? W[(size_t)(k0 + kk) * N + n0 + nn] : 0.f; }
        __syncthreads();
        if (rs_g) {
            if (tid < 64) { float cs = 0.f, cb = 0.f;
                for (int kk = 0; kk < 64; ++kk) { const float w = sm[kk * 65 + tid]; cs += w * rs_g[k0 + kk]; cb += w * rs_b[k0 + kk]; }
                atomicAdd(colsum + n0 + tid, cs); atomicAdd(colbias + n0 + tid, cb); }
            __syncthreads();
            for (int e = tid; e < 64 * 64; e += NTHR) { const int kk = e >> 6, nn = e & 63; sm[kk * 65 + nn] *= rs_g[k0 + kk]; }
            __syncthreads();
        }
        { const int nn = tid >> 3, c = tid & 7;
          if (n0 + nn < N) { uint4 o; o.x = pk2(sm[(8 * c + 0) * 65 + nn], sm[(8 * c + 1) * 65 + nn]); o.y = pk2(sm[(8 * c + 2) * 65 + nn], sm[(8 * c + 3) * 65 + nn]);
              o.z = pk2(sm[(8 * c + 4) * 65 + nn], sm[(8 * c + 5) * 65 + nn]); o.w = pk2(sm[(8 * c + 6) * 65 + nn], sm[(8 * c + 7) * 65 + nn]);
              *(uint4*)(WT + (size_t)(n0 + nn) * K + k0 + 8 * c) = o; } }
    }
    __syncthreads();
}
constexpr int TI_WIN = 16 * ((NCOL + 63) / 64), TI_SQ = 256, TI_LAYER = TI_WIN + 3 * TI_SQ;
#define TITEM_DECODE(it_, W_, WT_, K_, N_, k0_, n0_, fold_, l_) do { \
        l_ = (it_) / TI_LAYER; const int r_ = (it_) - l_ * TI_LAYER; \
        const int kind_ = r_ < TI_WIN ? 0 : (r_ < TI_WIN + TI_SQ ? 1 : (r_ < TI_WIN + 2 * TI_SQ ? 2 : 3)); \
        const int q_ = r_ - (kind_ == 0 ? 0 : TI_WIN + (kind_ - 1) * TI_SQ); \
        fold_ = kind_ == 2; K_ = kind_ == 3 ? 256 : 1024; N_ = kind_ == 0 ? NCOL : 1024; \
        k0_ = kind_ == 3 ? (q_ & 3) * 64 : (q_ & 15) * 64; n0_ = kind_ == 3 ? ((q_ & 63) >> 2) * 64 : (q_ >> 4) * 64; \
        const int nbr_ = q_ >> 6; \
        W_ = kind_ == 0 ? pin1 + (size_t)l_ * 1024 * NCOL : kind_ == 1 ? pin3 + (size_t)l_ * 1024 * 1024 : kind_ == 2 ? pin7 + (size_t)l_ * 1024 * 1024 : pin2 + ((size_t)l_ * 4 + nbr_) * 256 * 1024; \
        WT_ = kind_ == 0 ? (bf16*)(ws + WS_WIN_T + l_ * WIN_T_BYTES) : kind_ == 1 ? (bf16*)(ws + WS_WOUT_T) + (size_t)l_ * 1024 * 1024 : kind_ == 2 ? (bf16*)(ws + WS_WQ_T) + (size_t)l_ * 1024 * 1024 \
              : (bf16*)(ws + WS_WBR_T) + ((size_t)l_ * 4 + nbr_) * 1024 * 256; } while (0)
__device__ __forceinline__ void titem_finish(bf16* WT, int K, int N, int k0, int n0, const float* rs_g, const float* rs_b, float* colsum, float* colbias, float* sm, int tid) {
    if (rs_g) {
        if (tid < 64) { float cs = 0.f, cb = 0.f;
            for (int kk = 0; kk < 64; ++kk) { const float w = sm[kk * 65 + tid]; cs += w * rs_g[k0 + kk]; cb += w * rs_b[k0 + kk]; }
            atomicAdd(colsum + n0 + tid, cs); atomicAdd(colbias + n0 + tid, cb); }
        __syncthreads();
        for (int e = tid; e < 64 * 64; e += NTHR) { const int kk = e >> 6, nn = e & 63; sm[kk * 65 + nn] *= rs_g[k0 + kk]; }
        __syncthreads();
    }
    { const int nn = tid >> 3, c = tid & 7;
      if (n0 + nn < N) { uint4 o; o.x = pk2(sm[(8 * c + 0) * 65 + nn], sm[(8 * c + 1) * 65 + nn]); o.y = pk2(sm[(8 * c + 2) * 65 + nn], sm[(8 * c + 3) * 65 + nn]);
          o.z = pk2(sm[(8 * c + 4) * 65 + nn], sm[(8 * c + 5) * 65 + nn]); o.w = pk2(sm[(8 * c + 6) * 65 + nn], sm[(8 * c + 7) * 65 + nn]);
          *(uint4*)(WT + (size_t)(n0 + nn) * K + k0 + 8 * c) = o; } }
}
__device__ void prologue_phase(int WV_, const Params& p, float* sm) {
    const int tid = LTID(WV_), B = LBID(), G = LGRID();
    unsigned char* ws = p.ws;
    float* sm1 = sm + 64 * 65;
    const float* pin1 = p.in[1]; const float* pin2 = p.in[2]; const float* pin3 = p.in[3]; const float* pin7 = p.in[7]; const float* pin5 = p.in[5]; const float* pin6 = p.in[6];
    asm volatile("" : "+s"(pin1), "+s"(pin2), "+s"(pin3), "+s"(pin7), "+s"(pin5), "+s"(pin6));
    const int kk0 = tid >> 4, c4 = tid & 15;
    for (int it = B; it < DEPTH_ * TI_LAYER; it += 2 * G) {
        const int it2 = it + G; const bool has2 = it2 < DEPTH_ * TI_LAYER;
        const float* Wa; const float* Wb; bf16* WTa; bf16* WTb; int Ka, Na, k0a, n0a, la, Kb, Nb, k0b, n0b, lb; bool fa, fb;
        TITEM_DECODE(it, Wa, WTa, Ka, Na, k0a, n0a, fa, la);
        { const int itb = has2 ? it2 : it; TITEM_DECODE(itb, Wb, WTb, Kb, Nb, k0b, n0b, fb, lb); }
        const float4 z4 = make_float4(0.f, 0.f, 0.f, 0.f);
        const bool ina = n0a + 4 * c4 < Na, inb = n0b + 4 * c4 < Nb;
        float4 a0 = z4, a1 = z4, b0 = z4, b1 = z4;
        if (ina) { a0 = *(const float4*)(Wa + (size_t)(k0a + kk0) * Na + n0a + 4 * c4); a1 = *(const float4*)(Wa + (size_t)(k0a + kk0 + 32) * Na + n0a + 4 * c4); }
        if (inb) { b0 = *(const float4*)(Wb + (size_t)(k0b + kk0) * Nb + n0b + 4 * c4); b1 = *(const float4*)(Wb + (size_t)(k0b + kk0 + 32) * Nb + n0b + 4 * c4); }
        __syncthreads();
        { float* d = sm + kk0 * 65 + 4 * c4; d[0] = a0.x; d[1] = a0.y; d[2] = a0.z; d[3] = a0.w; d += 32 * 65; d[0] = a1.x; d[1] = a1.y; d[2] = a1.z; d[3] = a1.w; }
        { float* d = sm1 + kk0 * 65 + 4 * c4; d[0] = b0.x; d[1] = b0.y; d[2] = b0.z; d[3] = b0.w; d += 32 * 65; d[0] = b1.x; d[1] = b1.y; d[2] = b1.z; d[3] = b1.w; }
        __syncthreads();
        titem_finish(WTa, Ka, Na, k0a, n0a, fa ? pin5 + la * 1024 : nullptr, pin6 + la * 1024, (float*)(ws + WS_COLS) + la * 2048, (float*)(ws + WS_COLS) + la * 2048 + 1024, sm, tid);
        if (has2) titem_finish(WTb, Kb, Nb, k0b, n0b, fb ? pin5 + lb * 1024 : nullptr, pin6 + lb * 1024, (float*)(ws + WS_COLS) + lb * 2048, (float*)(ws + WS_COLS) + lb * 2048 + 1024, sm1, tid);
    }
    __syncthreads();
    for (int l = 0; l < DEPTH_; ++l) {
        bf16* win_t = (bf16*)(ws + WS_WIN_T + l * WIN_T_BYTES);
        for (int i = B * NTHR + tid; i < (NP - NCOL) * 1024 / 8; i += G * NTHR) ((uint4*)(win_t + (size_t)NCOL * 1024))[i] = make_uint4(0u, 0u, 0u, 0u);
    }
    const float4* x4 = (const float4*)p.in[0]; uint2* hb2 = (uint2*)(ws + WS_HB);
    for (size_t i = (size_t)B * NTHR + tid; i < (size_t)T_ * 1024 / 4; i += (size_t)G * NTHR) { const float4 v = x4[i]; hb2[i] = make_uint2(pk2(v.x, v.y), pk2(v.z, v.w)); }
}

__device__ __forceinline__ void ln_row(float4 (&v)[4], const float* g, const float* bb, float* orow, bf16* obrow, int lane) {
    float s = 0.f;
#pragma unroll
    for (int j = 0; j < 4; ++j) s += (v[j].x + v[j].y) + (v[j].z + v[j].w);
    const float mean = wave_sum(s) * (1.0f / 1024.0f);
    float s2 = 0.f;
#pragma unroll
    for (int j = 0; j < 4; ++j) { v[j].x -= mean; v[j].y -= mean; v[j].z -= mean; v[j].w -= mean; s2 += (v[j].x * v[j].x + v[j].y * v[j].y) + (v[j].z * v[j].z + v[j].w * v[j].w); }
    const float rstd = 1.0f / sqrtf(wave_sum(s2) * (1.0f / 1024.0f) + LN_EPS);
#pragma unroll
    for (int j = 0; j < 4; ++j) {
        const float4 gg = ((const float4*)g)[j * 64 + lane], b4 = ((const float4*)bb)[j * 64 + lane];
        float4 o; o.x = v[j].x * rstd * gg.x + b4.x; o.y = v[j].y * rstd * gg.y + b4.y; o.z = v[j].z * rstd * gg.z + b4.z; o.w = v[j].w * rstd * gg.w + b4.w;
        ((float4*)orow)[j * 64 + lane] = o;
        ((uint2*)obrow)[j * 64 + lane] = make_uint2(pk2(o.x, o.y), pk2(o.z, o.w));
    }
}
__device__ void ln1_phase(int WV_, const float* hin, const float* add, const float* g, const float* bb, float* hout, bf16* hb) {
    const int lane = LTID(WV_) & 63, wave = LTID(WV_) >> 6;
    for (int row = LBID() * NWAVE + wave; row < T_; row += LGRID() * NWAVE) {
        float4 v[4];
#pragma unroll
        for (int j = 0; j < 4; ++j) {
            const float4 a = ((const float4*)(hin + (size_t)row * 1024))[j * 64 + lane], m = ((const float4*)(add + (size_t)row * 1024))[j * 64 + lane];
            v[j].x = ALPHA * a.x + m.x; v[j].y = ALPHA * a.y + m.y; v[j].z = ALPHA * a.z + m.z; v[j].w = ALPHA * a.w + m.w;
        }
        ln_row(v, g, bb, hout + (size_t)row * 1024, hb + (size_t)row * 1024, lane);
    }
}


typedef short bf16x8_t __attribute__((ext_vector_type(8)));
typedef float f32x16_t __attribute__((ext_vector_type(16)));
typedef float f32x2_t __attribute__((ext_vector_type(2)));
typedef __bf16 bf16x2_t __attribute__((ext_vector_type(2)));
__device__ __forceinline__ unsigned cvtpk(float lo, float hi) { f32x2_t v = {lo, hi}; bf16x2_t b = __builtin_convertvector(v, bf16x2_t); return __builtin_bit_cast(unsigned, b); }
__device__ __forceinline__ int crow(int r, int hi) { return (r & 3) + 8 * (r >> 2) + 4 * hi; }
__device__ __forceinline__ float xlane32(float v) { return __shfl_xor(v, 32); }
__device__ __forceinline__ float vmax(float a, float b) { float r; asm("v_max_f32_e32 %0, %1, %2" : "=v"(r) : "v"(a), "v"(b)); return r; }
__device__ __forceinline__ float vmin(float a, float b) { float r; asm("v_min_f32_e32 %0, %1, %2" : "=v"(r) : "v"(a), "v"(b)); return r; }
__device__ __forceinline__ float vmax3(float a, float b, float c) { float r; asm("v_max3_f32 %0, %1, %2, %3" : "=v"(r) : "v"(a), "v"(b), "v"(c)); return r; }

constexpr int AT_KP = 72, AT_VP = 96;
constexpr int AT_KS = 0, AT_KS_BYTES = 64 * AT_KP * 2;
constexpr int AT_VT = 2 * AT_KS_BYTES, AT_VT_BYTES = 64 * AT_VP * 2;
constexpr int AT_KM = AT_VT + 2 * AT_VT_BYTES;
constexpr int AT_MISC = AT_KM + 32 * AT_KP * 2;
constexpr float LOG2E = 1.4426950408889634f;

__device__ __forceinline__ unsigned mk_unit(int kind, int b, int x, int y) { return ((unsigned)kind << 30) | ((unsigned)b << 28) | ((unsigned)x << 8) | (unsigned)y; }
__device__ void build_unit_table(unsigned* tab, int i) {
    int n = 0; unsigned res = 0u;
#pragma unroll 1
    for (int c = 64; c >= 1; --c) {
        if (i >= n && i < n + 4) res = mk_unit(0, i - n, 0, c - 1);
        n += 4;
        if ((c & 3) == 0) { if (i >= n && i < n + 16) { const int j = i - n; res = mk_unit(2, j >> 2, j & 3, c / 4 - 1); } n += 16; }
    }
    if (i < 512) tab[i] = res;
}

template <int kind> __device__ __forceinline__ void attn_unit(int WV_, const bf16* P, const unsigned char* mask, const float* kmean, const float* sinks, bf16* ys,
                                unsigned char* lds, int b, int ux, int uy) {
    int tid_ = LTID(WV_); asm volatile("" : "+v"(tid_));
    const int tid = tid_, lane = tid & 63, wave = __builtin_amdgcn_readfirstlane(tid >> 6), r32 = lane & 31, hi = lane >> 5;
    bf16* s_km = (bf16*)(lds + AT_KM);
    const int skey = tid >> 3, sc = tid & 7;
    {
        const bf16* Pb = P + (size_t)b * S_ * NP;
        int q0w, qcol, kcol, vcol, ycol, kt_hi, kt_lo; float slope2 = 0.f, sink2 = 0.f;
        if (kind == 0) { const int head = wave >> 1; q0w = uy * 64 + (wave & 1) * 32; qcol = C_QA + head * 64; kcol = C_KA; vcol = C_VA; ycol = head * 64;
            slope2 = exp2f(-8.0f * (float)(3 * head + 1) / 12.0f) * LOG2E; kt_hi = uy; kt_lo = 0; }
        else if (kind == 1) { const int hq = ux * 2 + (wave >> 2); q0w = uy * 128 + (wave & 3) * 32; qcol = C_QB + hq * 64; kcol = C_KB + ux * 64; vcol = C_VB + ux * 64; ycol = 256 + hq * 64;
            slope2 = exp2f(-8.0f * (float)(3 * hq + 2) / 12.0f) * LOG2E; sink2 = sinks[hq] * LOG2E; kt_hi = 2 * uy + 1; kt_lo = (2 * uy - 2 > 0) ? 2 * uy - 2 : 0; }
        else if (kind == 2) { q0w = uy * 256 + wave * 32; qcol = C_QC + ux * 64; kcol = C_KC + ux * 64; vcol = C_VC + ux * 64; ycol = 512 + ux * 64;
            slope2 = exp2f(-8.0f * (float)(3 * ux + 3) / 12.0f) * LOG2E; kt_hi = 4 * uy + 3; kt_lo = 0; }
        else { q0w = uy * 256 + wave * 32; qcol = C_QD + ux * 64; kcol = C_KD + ux * 64; vcol = C_VD + ux * 64; ycol = 768 + ux * 64; kt_hi = 4 * uy + 3; kt_lo = 0; }
        const int qpos = q0w + r32;
        bf16x8_t qf[4];
        { const bf16* qp = Pb + (size_t)qpos * NP + qcol + 8 * hi;
#pragma unroll
          for (int ks = 0; ks < 4; ++ks) qf[ks] = *(const bf16x8_t*)(qp + 16 * ks); }
        {
            const float qs = (kind == 3) ? 0.125f : 0.125f * LOG2E;
            typedef unsigned u32x4_t __attribute__((ext_vector_type(4)));
#pragma unroll
            for (int ks = 0; ks < 4; ++ks) { u32x4_t w = __builtin_bit_cast(u32x4_t, qf[ks]);
#pragma unroll
                for (int i = 0; i < 4; ++i) w[i] = cvtpk(__uint_as_float(w[i] << 16) * qs, __uint_as_float(w[i] & 0xffff0000u) * qs);
                qf[ks] = __builtin_bit_cast(bf16x8_t, w); }
        }
        float sb[16];
#pragma unroll
        for (int r = 0; r < 16; ++r) sb[r] = slope2 * (float)((r & 3) + 8 * (r >> 2));
        unsigned bm = 0u;
        if (kind == 2) {
            const int own = uy;
            for (int e = tid; e < 32 * 64; e += NTHR) { const int row = e >> 6, d = e & 63; s_km[row * AT_KP + d] = (row < 16) ? (bf16)f2bf(kmean[((b * 4 + ux) * 16 + row) * 64 + d]) : (bf16)0; }
            __syncthreads();
            f32x16_t gacc;
#pragma unroll
            for (int r = 0; r < 16; ++r) gacc[r] = 0.f;
#pragma unroll
            for (int ks = 0; ks < 4; ++ks) { const bf16x8_t a = *(const bf16x8_t*)(s_km + r32 * AT_KP + 16 * ks + 8 * hi); gacc = __builtin_amdgcn_mfma_f32_32x32x16_bf16(a, qf[ks], gacc, 0, 0, 0); }
            float gt[16];
#pragma unroll
            for (int r = 0; r < 8; ++r) { const float mine = gacc[r], other = xlane32(mine); const int bi = crow(r, 0);
                gt[bi] = hi ? other : mine; gt[bi + 4] = hi ? mine : other; }
#pragma unroll
            for (int n = 0; n < 16; ++n) if (n >= own) gt[n] = -INFINITY;
#pragma unroll
            for (int rep = 0; rep < 3; ++rep) {
                float mx = -INFINITY;
#pragma unroll
                for (int n = 0; n < 16; ++n) mx = fmaxf(mx, gt[n]);
                bool done = !(mx > -INFINITY);
#pragma unroll
                for (int n = 0; n < 16; ++n) { const bool hit = !done && gt[n] == mx; if (hit) { bm |= 1u << n; gt[n] = -INFINITY; done = true; } }
            }
        }
        f32x16_t o0, o1;
#pragma unroll
        for (int r = 0; r < 16; ++r) { o0[r] = 0.f; o1[r] = 0.f; }
        float m_run = -INFINITY, l_run = 0.f, carry = 0.f;
        const bf16* kg = Pb + (size_t)skey * NP + kcol + sc * 8;
        const bf16* vg = Pb + (size_t)skey * NP + vcol + sc * 8;
        uint4 rk = *(const uint4*)(kg + (size_t)kt_hi * 64 * NP), rv = *(const uint4*)(vg + (size_t)kt_hi * 64 * NP);
        int buf = 0;
        { bf16* ks_ = (bf16*)(lds + AT_KS); bf16* vt_ = (bf16*)(lds + AT_VT);
          *(uint4*)(ks_ + skey * AT_KP + sc * 8) = rk;
          *(uint4*)(vt_ + skey * AT_VP + sc * 8) = rv; }
        __syncthreads();
        bool wave_done = false;
        uint2 mw_next = make_uint2(0u, 0u);
        if (kind == 0) mw_next = *(const uint2*)(mask + (size_t)(b * S_ + qpos) * 512 + kt_hi * 8);
        for (int kt = kt_hi; kt >= kt_lo; --kt) {
            const bool more = kt > kt_lo;
            const uint2 mw = mw_next;
            if (kind == 0 && more) mw_next = *(const uint2*)(mask + (size_t)(b * S_ + qpos) * 512 + (kt - 1) * 8);
            if (more) { rk = *(const uint4*)(kg + (size_t)(kt - 1) * 64 * NP); rv = *(const uint4*)(vg + (size_t)(kt - 1) * 64 * NP); }
            const bf16* ks_ = (const bf16*)(lds + AT_KS + buf * AT_KS_BYTES);
            const bf16* vt_ = (const bf16*)(lds + AT_VT + buf * AT_VT_BYTES);
            bool active = (kt * 64 <= q0w + 31) && !wave_done;
            if (kind == 1) active = active && (kt * 64 + 63 >= q0w - 127);
            if (active) {
                const int kbase = kt * 64 + 4 * hi;
                f32x16_t p0, p1;
                if (kind != 3) {
                    const float cb = slope2 * (float)(kbase - qpos), cb1 = cb + 32.0f * slope2;
#pragma unroll
                    for (int r = 0; r < 16; ++r) { p0[r] = cb + sb[r]; p1[r] = cb1 + sb[r]; }
                } else {
#pragma unroll
                    for (int r = 0; r < 16; ++r) { p0[r] = 0.f; p1[r] = 0.f; }
                }
#pragma unroll
                for (int ks = 0; ks < 4; ++ks) {
                    const bf16x8_t a0 = *(const bf16x8_t*)(ks_ + r32 * AT_KP + 16 * ks + 8 * hi);
                    const bf16x8_t a1 = *(const bf16x8_t*)(ks_ + (32 + r32) * AT_KP + 16 * ks + 8 * hi);
                    p0 = __builtin_amdgcn_mfma_f32_32x32x16_bf16(a0, qf[ks], p0, 0, 0, 0);
                    p1 = __builtin_amdgcn_mfma_f32_32x32x16_bf16(a1, qf[ks], p1, 0, 0, 0);
                }
                if (kind != 3) {
                    float mx = -INFINITY;
                    if (kind == 0) {
                        const unsigned w0 = mw.x >> (4 * hi), w1 = mw.y >> (4 * hi);
#pragma unroll
                        for (int r = 0; r < 16; ++r) { const int off = (r & 3) + 8 * (r >> 2);
                            p0[r] = (w0 & (1u << off)) ? p0[r] : -INFINITY; p1[r] = (w1 & (1u << off)) ? p1[r] : -INFINITY; mx = vmax3(mx, p0[r], p1[r]); }
                    } else if (kind == 1) {
                        const int rel = qpos - kbase;
#pragma unroll
                        for (int r = 0; r < 16; ++r) { const int off = (r & 3) + 8 * (r >> 2);
                            p0[r] = ((unsigned)(rel - off) < 128u) ? p0[r] : -INFINITY; p1[r] = ((unsigned)(rel - off - 32) < 128u) ? p1[r] : -INFINITY; mx = vmax3(mx, p0[r], p1[r]); }
                    } else {
                        if ((kt >> 2) == uy) {
                            const int rel = qpos - kbase;
#pragma unroll
                            for (int r = 0; r < 16; ++r) { const int off = (r & 3) + 8 * (r >> 2);
                                p0[r] = (off <= rel) ? p0[r] : -INFINITY; p1[r] = (off + 32 <= rel) ? p1[r] : -INFINITY; mx = vmax3(mx, p0[r], p1[r]); }
                        } else {
                            const bool tile_ok = ((bm >> (kt >> 2)) & 1u) != 0u;
#pragma unroll
                            for (int r = 0; r < 16; ++r) { p0[r] = tile_ok ? p0[r] : -INFINITY; p1[r] = tile_ok ? p1[r] : -INFINITY; mx = vmax3(mx, p0[r], p1[r]); }
                        }
                    }
                    mx = vmax(mx, xlane32(mx));
                    const float m_new = vmax(m_run, mx);
                    const float m_safe = (m_new == -INFINITY) ? 0.f : m_new;
                    p0 = p0 - m_safe; p1 = p1 - m_safe;
#pragma unroll
                    for (int r = 0; r < 16; ++r) { p0[r] = __builtin_amdgcn_exp2f(p0[r]); p1[r] = __builtin_amdgcn_exp2f(p1[r]); }
                    float ls;
                    { typedef float f32x8_t __attribute__((ext_vector_type(8))); typedef float f32x4v_t __attribute__((ext_vector_type(4)));
                      const f32x16_t t16 = p0 + p1; const f32x8_t t8 = t16.lo + t16.hi; const f32x4v_t t4 = t8.lo + t8.hi; const f32x2_t t2 = t4.lo + t4.hi; ls = t2.x + t2.y; }
                    if (__any(m_new > m_run)) {
                        const float alpha = __builtin_amdgcn_exp2f(m_run - m_safe);
                        l_run *= alpha;
                        o0 = o0 * alpha; o1 = o1 * alpha;
                    }
                    l_run += ls; m_run = m_new;
                } else {
                    float run = carry;
#define SB_HALF(PX, KOFF) do { \
                    float lk[16]; \
                    _Pragma("unroll") for (int r = 0; r < 16; ++r) { \
                        const int off = (r & 3) + 8 * (r >> 2); \
                        const bool v = (kbase + off + (KOFF)) < qpos; \
                        const float z = PX[r]; \
                        const float t = 0.6931471805599453f * __builtin_amdgcn_logf(1.0f + __builtin_amdgcn_exp2f(-LOG2E * fabsf(z))); \
                        lk[r] = v ? (fminf(-z, 0.f) - t) : 0.f; \
                        PX[r] = v ? (fminf(z, 0.f) - t) : -INFINITY; } \
                    _Pragma("unroll") for (int g = 3; g >= 0; --g) { \
                        const float G = (lk[4 * g] + lk[4 * g + 1]) + (lk[4 * g + 2] + lk[4 * g + 3]); \
                        const float PG = xlane32(G); \
                        float la = run + (hi ? 0.f : PG); \
                        run += G + PG; \
                        PX[4 * g + 3] += la; la += lk[4 * g + 3]; PX[4 * g + 2] += la; la += lk[4 * g + 2]; PX[4 * g + 1] += la; la += lk[4 * g + 1]; PX[4 * g] += la; } \
                    _Pragma("unroll") for (int r = 0; r < 16; ++r) PX[r] = __builtin_amdgcn_exp2f(LOG2E * PX[r]); } while (0)
                    SB_HALF(p1, 32);
                    SB_HALF(p0, 0);
#undef SB_HALF
                    carry = run;
                }
                unsigned pw[16];
#pragma unroll
                for (int j = 0; j < 8; ++j) { pw[j] = cvtpk(p0[2 * j], p0[2 * j + 1]); pw[8 + j] = cvtpk(p1[2 * j], p1[2 * j + 1]); }
#pragma unroll
                for (int s = 0; s < 4; ++s) {
                    bf16x8_t pb; { const unsigned* q = pw + 4 * s; typedef unsigned u32x4_t __attribute__((ext_vector_type(4))); u32x4_t t4 = {q[0], q[1], q[2], q[3]}; pb = __builtin_bit_cast(bf16x8_t, t4); }
#pragma unroll
                    for (int dt = 0; dt < 2; ++dt) {
                        typedef short s16x4_t __attribute__((ext_vector_type(4)));
                        typedef __attribute__((address_space(3))) s16x4_t lds_s16x4;
                        const int gi_ = lane & 15;
                        const bf16* vp = vt_ + (16 * s + 4 * hi + (gi_ >> 2)) * AT_VP + 32 * dt + 16 * ((lane >> 4) & 1) + 4 * (gi_ & 3);
                        const s16x4_t lo = __builtin_amdgcn_ds_read_tr16_b64_v4i16((lds_s16x4*)vp), hi4 = __builtin_amdgcn_ds_read_tr16_b64_v4i16((lds_s16x4*)(vp + 8 * AT_VP));
                        const bf16x8_t va = {lo[0], lo[1], lo[2], lo[3], hi4[0], hi4[1], hi4[2], hi4[3]};
                        if (dt == 0) o0 = __builtin_amdgcn_mfma_f32_32x32x16_bf16(va, pb, o0, 0, 0, 0);
                        else         o1 = __builtin_amdgcn_mfma_f32_32x32x16_bf16(va, pb, o1, 0, 0, 0);
                    }
                }
            }
            if (kind == 3) {
                const float cm = carry;
                if (__all(cm < -110.0f) || !(kt * 64 <= q0w + 31) ) { if (__all(cm < -110.0f)) wave_done = true; }
            }
            if (more) {
                bf16* ksn = (bf16*)(lds + AT_KS + (buf ^ 1) * AT_KS_BYTES); bf16* vtn = (bf16*)(lds + AT_VT + (buf ^ 1) * AT_VT_BYTES);
                *(uint4*)(ksn + skey * AT_KP + sc * 8) = rk;
                *(uint4*)(vtn + skey * AT_VP + sc * 8) = rv;
            }
            if (kind == 3) { if (__syncthreads_and(wave_done ? 1 : 0)) break; }
            else __syncthreads();
            buf ^= 1;
        }
        float inv;
        if (kind == 3) inv = 1.0f;
        else {
            float lt = l_run + xlane32(l_run);
            if (kind == 1) { const float mf = fmaxf(m_run, sink2); const float sc2 = exp2f(m_run - mf); lt = lt * sc2 + exp2f(sink2 - mf); inv = sc2 / lt; }
            else inv = 1.0f / lt;
        }
        bf16* yp = ys + (size_t)(b * S_ + qpos) * 1024 + ycol + 4 * hi;
#pragma unroll
        for (int g = 0; g < 4; ++g) {
            *(uint2*)(yp + 8 * g) = make_uint2(cvtpk(o0[4 * g] * inv, o0[4 * g + 1] * inv), cvtpk(o0[4 * g + 2] * inv, o0[4 * g + 3] * inv));
            *(uint2*)(yp + 32 + 8 * g) = make_uint2(cvtpk(o1[4 * g] * inv, o1[4 * g + 1] * inv), cvtpk(o1[4 * g + 2] * inv, o1[4 * g + 3] * inv));
        }
    }
}
__device__ void attn_fast_phase(int WV_, const bf16* P, const unsigned char* mask, const float* kmean, const float* sinks, bf16* ys,
                                const unsigned* utab, unsigned* counter, unsigned char* lds) {
    volatile unsigned* s_unit = (volatile unsigned*)(lds + AT_MISC);
    for (;;) {
        __syncthreads();
        if (LTID(WV_) == 0) s_unit[0] = atomicAdd(counter, 1u);
        __syncthreads();
        const unsigned ui = s_unit[0];
        if (ui >= 512u) break;
        const unsigned ue = utab[ui];
        const int kind = (int)(ue >> 30), b = (int)((ue >> 28) & 3u), ux = (int)((ue >> 8) & 255u), uy = (int)(ue & 255u);
        if (kind == 0) attn_unit<0>(WV_, P, mask, kmean, sinks, ys, lds, b, ux, uy);
        else attn_unit<2>(WV_, P, mask, kmean, sinks, ys, lds, b, ux, uy);
    }
    for (int u = LBID(); u < 256; u += LGRID()) { __syncthreads(); attn_unit<3>(WV_, P, mask, kmean, sinks, ys, lds, u >> 6, (u >> 4) & 3, u & 15); }
    for (int u = LBID(); u < 256; u += LGRID()) { __syncthreads(); attn_unit<1>(WV_, P, mask, kmean, sinks, ys, lds, u >> 6, (u >> 5) & 1, u & 31); }
}

constexpr float U_SCALE = 128.0f, V_SCALE = 48.0f;
constexpr int ROW6 = 1536;
typedef float v32f_t __attribute__((ext_vector_type(32)));
typedef unsigned v6u_t __attribute__((ext_vector_type(6)));
typedef unsigned u32x4a8_t __attribute__((ext_vector_type(4), aligned(8)));
__device__ __forceinline__ float rdlane_f(float v, int l) { return __builtin_bit_cast(float, __builtin_amdgcn_readlane(__builtin_bit_cast(int, v), l)); }
__device__ __forceinline__ unsigned q_e2m3(float v) {
    const float a = fminf(fabsf(v), 7.5f);
    unsigned code;
    if (a < 1.0f) code = (unsigned)rintf(a * 8.0f);
    else if (a < 2.0f) code = 8u + (unsigned)rintf((a - 1.0f) * 8.0f);
    else if (a < 4.0f) code = 16u + (unsigned)rintf((a - 2.0f) * 4.0f);
    else code = 24u + (unsigned)rintf((a - 4.0f) * 2.0f);
    return code | (v < 0.f ? 32u : 0u);
}
__device__ __forceinline__ void cvt_chunk6(const float4 (&a)[8], float sc, unsigned (&w)[6]) {
#pragma unroll
    for (int d = 0; d < 6; ++d) w[d] = 0u;
#pragma unroll
    for (int q4 = 0; q4 < 8; ++q4) {
        const float av[4] = {a[q4].x, a[q4].y, a[q4].z, a[q4].w};
#pragma unroll
        for (int e = 0; e < 4; ++e) { const int idx = q4 * 4 + e, bit = 6 * idx, d = bit >> 5, sft = bit & 31; const unsigned code = q_e2m3(av[e] * sc);
            w[d] |= code << sft; if (sft > 26) w[d + 1] |= code >> (32 - sft); }
    }
}
__device__ void convert_tables(int WV_, const Params& p) {
    const size_t nchunk = (size_t)DEPTH_ * 16384 * 2 * 32;
    const size_t stride = (size_t)LGRID() * NTHR;
    for (size_t i = (size_t)LBID() * NTHR + LTID(WV_); i < nchunk; i += 2 * stride) {
        const size_t i2 = i + stride; const bool has2 = i2 < nchunk; const size_t j2 = has2 ? i2 : i;
        const int c0 = (int)(i & 31), uv0 = (int)((i >> 5) & 1); const size_t le0 = i >> 6;
        const int c1 = (int)(j2 & 31), uv1 = (int)((j2 >> 5) & 1); const size_t le1 = j2 >> 6;
        const float* src0 = (uv0 ? p.in[10] : p.in[9]) + le0 * 1024 + c0 * 32;
        const float* src1 = (uv1 ? p.in[10] : p.in[9]) + le1 * 1024 + c1 * 32;
        float4 a0[8], a1[8];
#pragma unroll
        for (int q4 = 0; q4 < 8; ++q4) a0[q4] = ((const float4*)src0)[q4];
#pragma unroll
        for (int q4 = 0; q4 < 8; ++q4) a1[q4] = ((const float4*)src1)[q4];
        unsigned w0[6], w1[6];
        cvt_chunk6(a0, uv0 ? V_SCALE : U_SCALE, w0);
        cvt_chunk6(a1, uv1 ? V_SCALE : U_SCALE, w1);
        uint2* dst0 = (uint2*)(p.ws + WS_UV + le0 * ROW6 + uv0 * 768 + c0 * 24);
        dst0[0] = make_uint2(w0[0], w0[1]); dst0[1] = make_uint2(w0[2], w0[3]); dst0[2] = make_uint2(w0[4], w0[5]);
        if (has2) { uint2* dst1 = (uint2*)(p.ws + WS_UV + le1 * ROW6 + uv1 * 768 + c1 * 24);
            dst1[0] = make_uint2(w1[0], w1[1]); dst1[1] = make_uint2(w1[2], w1[3]); dst1[2] = make_uint2(w1[4], w1[5]); }
    }
}
__device__ __forceinline__ v6u_t ld_pk6(const unsigned char* ptr) {
    const uint2 a = ((const uint2*)ptr)[0], b = ((const uint2*)ptr)[1], c = ((const uint2*)ptr)[2];
    const v6u_t pk = {a.x, a.y, b.x, b.y, c.x, c.y};
    return pk;
}
__device__ void peer_fast_phase(int WV_, float* h, bf16* hb, const int* eid, const float* gate, const unsigned char* uv, const float* g1, const float* b1, const float* g, const float* bb, unsigned char* lds) {
    const int tid = LTID(WV_), lane = tid & 63, wave = tid >> 6, l32 = lane & 31, hi = lane >> 5;
    float* pl = (float*)(lds + wave * 16384);
    unsigned char* raw = lds + wave * 16384 + 4096 + lane * 24;
    for (int t = LBID() * NWAVE + wave; t < T_; t += LGRID() * NWAVE) {
        float* hr = h + (size_t)t * 1024 + l32 * 32;
        float x[32], acc[32];
#pragma unroll
        for (int q4 = 0; q4 < 4; ++q4) { const uint4 a = ((const uint4*)(hb + (size_t)t * 1024 + l32 * 32))[q4];
            x[8 * q4] = __uint_as_float(a.x << 16); x[8 * q4 + 1] = __uint_as_float(a.x & 0xffff0000u); x[8 * q4 + 2] = __uint_as_float(a.y << 16); x[8 * q4 + 3] = __uint_as_float(a.y & 0xffff0000u);
            x[8 * q4 + 4] = __uint_as_float(a.z << 16); x[8 * q4 + 5] = __uint_as_float(a.z & 0xffff0000u); x[8 * q4 + 6] = __uint_as_float(a.w << 16); x[8 * q4 + 7] = __uint_as_float(a.w & 0xffff0000u); }
        {
            float s = 0.f;
#pragma unroll
            for (int i = 0; i < 32; ++i) s += x[i];
#pragma unroll
            for (int o = 16; o > 0; o >>= 1) s += __shfl_xor(s, o);
            const float mean = s * (1.0f / 1024.0f);
            float s2 = 0.f;
#pragma unroll
            for (int i = 0; i < 32; ++i) { x[i] -= mean; s2 += x[i] * x[i]; }
#pragma unroll
            for (int o = 16; o > 0; o >>= 1) s2 += __shfl_xor(s2, o);
            const float rstd = 1.0f / sqrtf(s2 * (1.0f / 1024.0f) + LN_EPS);
#pragma unroll
            for (int q4 = 0; q4 < 8; ++q4) { const float4 gg = ((const float4*)(g1 + l32 * 32))[q4], cc = ((const float4*)(b1 + l32 * 32))[q4];
                x[4 * q4] = x[4 * q4] * rstd * gg.x + cc.x; x[4 * q4 + 1] = x[4 * q4 + 1] * rstd * gg.y + cc.y; x[4 * q4 + 2] = x[4 * q4 + 2] * rstd * gg.z + cc.z; x[4 * q4 + 3] = x[4 * q4 + 3] * rstd * gg.w + cc.w; }
        }
#pragma unroll
        for (int i = 0; i < 32; ++i) acc[i] = 0.f;
#pragma unroll 1
        for (int batch = 0; batch < 4; ++batch) {
            const int my_eid = eid[(size_t)t * 128 + batch * 32 + l32];
            const float my_gate = gate[(size_t)t * 128 + batch * 32 + l32];
#pragma unroll 1
            for (int grp = 0; grp < 2; ++grp) {
                { u32x4a8_t pa[8]; uint2 pc[8];
#pragma unroll
                  for (int i = 0; i < 8; ++i) { const int id = __shfl(my_eid, 2 * (grp * 8 + i) + hi); const unsigned char* rp = uv + (size_t)id * ROW6 + l32 * 24; pa[i] = *(const u32x4a8_t*)rp; pc[i] = *(const uint2*)(rp + 16); }
#pragma unroll
                  for (int i = 0; i < 8; ++i) { uint2* wp = (uint2*)(raw + i * 1536); wp[0] = make_uint2(pa[i].x, pa[i].y); wp[1] = make_uint2(pa[i].z, pa[i].w); wp[2] = pc[i]; } }
#pragma unroll 1
                for (int i = 0; i < 8; ++i) {
                    const uint2* rp = (const uint2*)(raw + i * 1536); const uint2 a = rp[0], b = rp[1], c = rp[2];
                    const v6u_t pk6 = {a.x, a.y, b.x, b.y, c.x, c.y}; const v32f_t f = __builtin_amdgcn_cvt_scalef32_pk32_f32_fp6(pk6, 1.0f);
                    f32x2_t dv0 = {0.f, 0.f}, dv1 = {0.f, 0.f};
#pragma unroll
                    for (int j = 0; j < 8; ++j) { const f32x2_t fa = {f[2 * j], f[2 * j + 1]}, fb = {f[16 + 2 * j], f[17 + 2 * j]}, xa = {x[2 * j], x[2 * j + 1]}, xb = {x[16 + 2 * j], x[17 + 2 * j]};
                        dv0 = fa * xa + dv0; dv1 = fb * xb + dv1; }
                    pl[(2 * (grp * 8 + i) + hi) * 32 + l32] = (dv0.x + dv0.y) + (dv1.x + dv1.y);
                }
            }
            float d;
            { const float4* pr = (const float4*)(pl + l32 * 32); float4 s4 = pr[0];
#pragma unroll
              for (int i = 1; i < 8; ++i) { const float4 v = pr[i]; s4.x += v.x; s4.y += v.y; s4.z += v.z; s4.w += v.w; }
              d = ((s4.x + s4.y) + (s4.z + s4.w)) * (1.0f / U_SCALE); }
            const float hv = 0.5f * d * (1.0f + erff(d * 0.70710678118654752f)) * my_gate * (1.0f / V_SCALE);
#pragma unroll 1
            for (int grp = 0; grp < 2; ++grp) {
                { u32x4a8_t pa[8]; uint2 pc[8];
#pragma unroll
                  for (int i = 0; i < 8; ++i) { const int id = __shfl(my_eid, 2 * (grp * 8 + i) + hi); const unsigned char* rp = uv + (size_t)id * ROW6 + 768 + l32 * 24; pa[i] = *(const u32x4a8_t*)rp; pc[i] = *(const uint2*)(rp + 16); }
#pragma unroll
                  for (int i = 0; i < 8; ++i) { uint2* wp = (uint2*)(raw + i * 1536); wp[0] = make_uint2(pa[i].x, pa[i].y); wp[1] = make_uint2(pa[i].z, pa[i].w); wp[2] = pc[i]; } }
#pragma unroll 1
                for (int i = 0; i < 8; ++i) {
                    const float c = __shfl(hv, 2 * (grp * 8 + i) + hi);
                    const uint2* rp = (const uint2*)(raw + i * 1536); const uint2 a = rp[0], b = rp[1], cc = rp[2];
                    const v6u_t pk6 = {a.x, a.y, b.x, b.y, cc.x, cc.y}; const v32f_t f = __builtin_amdgcn_cvt_scalef32_pk32_f32_fp6(pk6, 1.0f);
                    const f32x2_t c2 = {c, c};
#pragma unroll
                    for (int j = 0; j < 16; ++j) { const f32x2_t fj = {f[2 * j], f[2 * j + 1]}; f32x2_t aj = {acc[2 * j], acc[2 * j + 1]}; aj = fj * c2 + aj; acc[2 * j] = aj.x; acc[2 * j + 1] = aj.y; }
                }
            }
        }
        float y[32], s = 0.f;
#pragma unroll
        for (int i = 0; i < 32; ++i) { acc[i] += __shfl_xor(acc[i], 32); y[i] = ALPHA * x[i] + acc[i]; s += y[i]; }
#pragma unroll
        for (int o = 16; o > 0; o >>= 1) s += __shfl_xor(s, o);
        const float mean = s * (1.0f / 1024.0f);
        float s2 = 0.f;
#pragma unroll
        for (int i = 0; i < 32; ++i) { y[i] -= mean; s2 += y[i] * y[i]; }
#pragma unroll
        for (int o = 16; o > 0; o >>= 1) s2 += __shfl_xor(s2, o);
        const float rstd = 1.0f / sqrtf(s2 * (1.0f / 1024.0f) + LN_EPS);
        float o[16];
#pragma unroll
        for (int q4 = 0; q4 < 4; ++q4) {
            const float4 gg = ((const float4*)(g + l32 * 32 + hi * 16))[q4], cc = ((const float4*)(bb + l32 * 32 + hi * 16))[q4];
            float ya[4], yb2[4];
#pragma unroll
            for (int e = 0; e < 4; ++e) { ya[e] = y[4 * q4 + e]; yb2[e] = y[16 + 4 * q4 + e]; }
            asm volatile("" : "+v"(ya[0]), "+v"(ya[1]), "+v"(ya[2]), "+v"(ya[3]), "+v"(yb2[0]), "+v"(yb2[1]), "+v"(yb2[2]), "+v"(yb2[3]));
            const float y0 = hi ? yb2[0] : ya[0], y1 = hi ? yb2[1] : ya[1], y2 = hi ? yb2[2] : ya[2], y3 = hi ? yb2[3] : ya[3];
            o[4 * q4] = y0 * rstd * gg.x + cc.x; o[4 * q4 + 1] = y1 * rstd * gg.y + cc.y; o[4 * q4 + 2] = y2 * rstd * gg.z + cc.z; o[4 * q4 + 3] = y3 * rstd * gg.w + cc.w;
            if (h) ((float4*)(hr + hi * 16))[q4] = make_float4(o[4 * q4], o[4 * q4 + 1], o[4 * q4 + 2], o[4 * q4 + 3]);
        }
        uint4* hbp = (uint4*)(hb + (size_t)t * 1024 + l32 * 32 + hi * 16);
        hbp[0] = make_uint4(pk2(o[0], o[1]), pk2(o[2], o[3]), pk2(o[4], o[5]), pk2(o[6], o[7]));
        hbp[1] = make_uint4(pk2(o[8], o[9]), pk2(o[10], o[11]), pk2(o[12], o[13]), pk2(o[14], o[15]));
    }
}

__device__ __forceinline__ float pack_pl(float v, unsigned pl) { return __uint_as_float((__float_as_uint(v) & ~127u) | pl); }
__device__ __forceinline__ void ins16(float (&s)[16], float x) {
#pragma unroll
    for (int k = 15; k >= 1; --k) s[k] = __builtin_amdgcn_fmed3f(s[k - 1], x, s[k]);
    s[0] = vmax(s[0], x);
}
template <int D> __device__ __forceinline__ void bitonic_stage(float (&c)[16]) {
#pragma unroll
    for (int i = 0; i < 16; ++i) if ((i & D) == 0) { const float a = vmax(c[i], c[i + D]), b = vmin(c[i], c[i + D]); c[i] = a; c[i + D] = b; }
}
__device__ __forceinline__ int decode_key(unsigned pl) { return (int)(32u * ((pl >> 4) & 3u) + (pl & 3u) + 8u * ((pl >> 2) & 3u) + 4u * ((pl >> 6) & 1u)); }
__device__ void route_fast_phase(int WV_, const bf16* qb, const bf16* skb  , int* eid, float* gate, unsigned char* lds, int pm = -1, int pn = 0) {
    const int tid = LTID(WV_), lane = tid & 63, wave = tid >> 6, r32 = lane & 31, hi = lane >> 5;
    unsigned* lidx = (unsigned*)lds + wave * (64 * 33) + lane * 33;
    const int u_first = (pm >= 0) ? 0 : LBID() * NWAVE + wave, u_end = (pm >= 0) ? 2 : (T_ / 32) * 8, u_step = (pm >= 0) ? 1 : LGRID() * NWAVE;
    for (int unit = u_first; unit < u_end; unit += u_step) {
        const int h = (pm >= 0) ? 2 * pn + unit : (unit & 7), t = ((pm >= 0) ? 8 * pm + wave : (unit >> 3)) * 32 + r32;
        float sl[2][16];
#pragma unroll
        for (int p = 0; p < 2; ++p) {
            bf16x8_t qf[4];
            { const bf16* qp = qb + (size_t)t * 1024 + h * 128 + p * 64 + 8 * hi;
#pragma unroll
              for (int ks = 0; ks < 4; ++ks) qf[ks] = *(const bf16x8_t*)(qp + 16 * ks); }
            float s[16];
#pragma unroll
            for (int k = 0; k < 16; ++k) s[k] = -INFINITY;
            const bf16* skp = skb + ((size_t)(h * 2 + p) * 128 + r32) * 64 + 8 * hi;
#pragma unroll
            for (int kt = 0; kt < 4; ++kt) {
                f32x16_t acc;
#pragma unroll
                for (int r = 0; r < 16; ++r) acc[r] = 0.f;
#pragma unroll
                for (int ks = 0; ks < 4; ++ks) { const bf16x8_t a = *(const bf16x8_t*)(skp + (size_t)kt * 32 * 64 + 16 * ks); acc = __builtin_amdgcn_mfma_f32_32x32x16_bf16(a, qf[ks], acc, 0, 0, 0); }
#pragma unroll
                for (int r = 0; r < 16; ++r) ins16(s, pack_pl(acc[r], (unsigned)(kt * 16 + r)));
            }
            const unsigned hb = (unsigned)hi << 6;
#pragma unroll
            for (int k = 0; k < 16; ++k) s[k] = __uint_as_float(__float_as_uint(s[k]) | hb);
            float c[16];
#pragma unroll
            for (int k = 0; k < 16; ++k) c[k] = vmax(s[k], __shfl_xor(s[15 - k], 32));
            bitonic_stage<8>(c); bitonic_stage<4>(c); bitonic_stage<2>(c); bitonic_stage<1>(c);
#pragma unroll
            for (int k = 0; k < 16; ++k) { sl[p][k] = c[k]; lidx[p * 16 + k] = (unsigned)decode_key(__float_as_uint(c[k]) & 127u); }
        }
        float w[16];
#pragma unroll
        for (int k = 0; k < 16; ++k) w[k] = -INFINITY;
#pragma unroll
        for (int i = 0; i < 16; ++i)
#pragma unroll
            for (int j = 0; j < 16; ++j)
                if ((i + 1) * (j + 1) <= 16) { const float v = sl[0][i] + sl[1][j]; ins16(w, __uint_as_float((__float_as_uint(v) & ~255u) | (unsigned)(i * 16 + j))); }
        float e[16], sum = 0.f;
#pragma unroll
        for (int k = 0; k < 16; ++k) { e[k] = expf(w[k] - w[0]); sum += e[k]; }
        const float inv = 1.0f / sum;
        int ide[8]; float gte[8];
#pragma unroll
        for (int k = 0; k < 8; ++k) {
            float wa = w[k], wb = w[8 + k], ea = e[k], eb = e[8 + k];
            asm volatile("" : "+v"(wa), "+v"(wb), "+v"(ea), "+v"(eb));
            const float wv = hi ? wb : wa;
            const unsigned pl = __float_as_uint(wv) & 255u;
            ide[k] = (int)(lidx[pl >> 4] * 128u + lidx[16 + (pl & 15u)]);
            gte[k] = (hi ? eb : ea) * inv;
        }
        int* ep = eid + (size_t)t * 128 + h * 16 + hi * 8; float* gp = gate + (size_t)t * 128 + h * 16 + hi * 8;
        *(int4*)ep = make_int4(ide[0], ide[1], ide[2], ide[3]); *(int4*)(ep + 4) = make_int4(ide[4], ide[5], ide[6], ide[7]);
        *(float4*)gp = make_float4(gte[0], gte[1], gte[2], gte[3]); *(float4*)(gp + 4) = make_float4(gte[4], gte[5], gte[6], gte[7]);
    }
}
#ifndef TS_SEL
#define TS_SEL 0
#endif
#define ITS_B() do { if (TS_SEL >= 20 && TS_SEL <= 40 && WV_ == 0 && LANEID() == 0) ((volatile __attribute__((address_space(3))) unsigned long long*)((__attribute__((address_space(3))) unsigned char*)lds + 147456 - 16 - 32))[0] = __builtin_amdgcn_s_memrealtime(); } while (0)
#define ITS_E(k) do { if ((k) == TS_SEL && WV_ == 0 && LANEID() == 0) { volatile __attribute__((address_space(3))) unsigned long long* w_ = (volatile __attribute__((address_space(3))) unsigned long long*)((__attribute__((address_space(3))) unsigned char*)lds + 147456 - 16 - 32); w_[1] += __builtin_amdgcn_s_memrealtime() - w_[0]; } } while (0)

typedef float f32x4_t __attribute__((ext_vector_type(4)));
typedef __bf16 bf16x2v __attribute__((ext_vector_type(2)));
__device__ __forceinline__ float dot2bf(unsigned a, unsigned b, float c) { return __builtin_amdgcn_fdot2_f32_bf16(__builtin_bit_cast(bf16x2v, a), __builtin_bit_cast(bf16x2v, b), c, false); }
__device__ __forceinline__ void cnt_gt(int& cnt, unsigned a, unsigned b) { asm("v_cmp_gt_u32_e32 vcc, %1, %2\n\tv_addc_co_u32_e32 %0, vcc, 0, %0, vcc" : "+v"(cnt) : "v"(a), "v"(b) : "vcc"); }
__device__ __forceinline__ void cnt_eq(int& cnt, unsigned a, unsigned b) { asm("v_cmp_eq_u32_e32 vcc, %1, %2\n\tv_addc_co_u32_e32 %0, vcc, 0, %0, vcc" : "+v"(cnt) : "v"(a), "v"(b) : "vcc"); }
__device__ __forceinline__ unsigned flag_gt(unsigned a, unsigned b) { unsigned r; asm("v_cmp_gt_u32_e32 vcc, %1, %2\n\tv_cndmask_b32_e64 %0, 0, 1, vcc" : "=v"(r) : "v"(a), "v"(b) : "vcc"); return r; }
__device__ __forceinline__ unsigned flag_eq(unsigned a, unsigned b) { unsigned r; asm("v_cmp_eq_u32_e32 vcc, %1, %2\n\tv_cndmask_b32_e64 %0, 0, 1, vcc" : "=v"(r) : "v"(a), "v"(b) : "vcc"); return r; }
__device__ __forceinline__ void cnt_ge(int& cnt, unsigned key, unsigned cand) { asm("v_cmp_ge_u32_e32 vcc, %1, %2\n\tv_addc_co_u32_e32 %0, vcc, 0, %0, vcc" : "+v"(cnt) : "v"(key), "v"(cand) : "vcc"); }

template <int CTRL, int RM> __device__ __forceinline__ unsigned dpp0(unsigned v) { return (unsigned)__builtin_amdgcn_update_dpp(0, (int)v, CTRL, RM, 0xf, false); }
template <int CTRL> __device__ __forceinline__ unsigned dppf(unsigned v) { return (unsigned)__builtin_amdgcn_update_dpp(-1, (int)v, CTRL, 0xf, 0xf, false); }
__device__ __forceinline__ unsigned wave_sum_u_dpp(unsigned v) {
    v += dpp0<0xB1, 0xf>(v); v += dpp0<0x4E, 0xf>(v); v += dpp0<0x141, 0xf>(v); v += dpp0<0x140, 0xf>(v);
    return (unsigned)__builtin_amdgcn_readlane((int)v, 0) + (unsigned)__builtin_amdgcn_readlane((int)v, 16) + (unsigned)__builtin_amdgcn_readlane((int)v, 32) + (unsigned)__builtin_amdgcn_readlane((int)v, 48);
}
__device__ __forceinline__ unsigned wave_min_u_dpp(unsigned v) {
    unsigned t;
    t = dppf<0xB1>(v); v = t < v ? t : v; t = dppf<0x4E>(v); v = t < v ? t : v; t = dppf<0x141>(v); v = t < v ? t : v; t = dppf<0x140>(v); v = t < v ? t : v;
    const unsigned a = (unsigned)__builtin_amdgcn_readlane((int)v, 0), b = (unsigned)__builtin_amdgcn_readlane((int)v, 16), c = (unsigned)__builtin_amdgcn_readlane((int)v, 32), d = (unsigned)__builtin_amdgcn_readlane((int)v, 48);
    const unsigned ab = a < b ? a : b, cd = c < d ? c : d; return ab < cd ? ab : cd;
}
__device__ __forceinline__ unsigned wave_incl_scan_u_dpp(unsigned v) {
    v += dpp0<0x111, 0xf>(v); v += dpp0<0x112, 0xf>(v); v += dpp0<0x114, 0xf>(v); v += dpp0<0x118, 0xf>(v);
    v += dpp0<0x142, 0xa>(v);
    v += dpp0<0x143, 0xc>(v);
    return v;
}
typedef __attribute__((address_space(3))) unsigned lds_u32;
template <int SHIFT> __device__ __forceinline__ unsigned radix_pass(const unsigned (&key)[64], unsigned pre, lds_u32* hist, int lane, int& need, int jlim, unsigned L) {
    typedef unsigned u32x4v __attribute__((ext_vector_type(4)));
    typedef __attribute__((address_space(3))) u32x4v lds_u32x4;
    const int fl = 63 - lane;
    { const u32x4v z4 = {0u, 0u, 0u, 0u};
      ((lds_u32x4*)(hist + fl * 4))[0] = z4; }
    const unsigned hb = (unsigned)(size_t)hist;
    const unsigned one = 1u;
    asm volatile("" ::: "memory");
#pragma unroll
    for (int j4 = 0; j4 < 16; ++j4) {
        if (4 * j4 <= jlim) {
            unsigned long long c0, c1, c2, c3, sv; unsigned t0, t1, t2, t3;
            if (SHIFT == 24)
                asm volatile(
                    "v_cmp_ge_u32_e64 %0, %9, %13\n\tv_cmp_ge_u32_e64 %1, %10, %13\n\tv_cmp_ge_u32_e64 %2, %11, %13\n\tv_cmp_ge_u32_e64 %3, %12, %13\n\t"
                    "v_lshrrev_b32_e32 %5, 24, %9\n\tv_lshrrev_b32_e32 %6, 24, %10\n\tv_lshrrev_b32_e32 %7, 24, %11\n\tv_lshrrev_b32_e32 %8, 24, %12\n\t"
                    "v_lshl_add_u32 %5, %5, 2, %14\n\tv_lshl_add_u32 %6, %6, 2, %14\n\tv_lshl_add_u32 %7, %7, 2, %14\n\tv_lshl_add_u32 %8, %8, 2, %14\n\t"
                    "s_mov_b64 %4, exec\n\t"
                    "s_mov_b64 exec, %0\n\tds_add_u32 %5, %15\n\ts_mov_b64 exec, %1\n\tds_add_u32 %6, %15\n\ts_mov_b64 exec, %2\n\tds_add_u32 %7, %15\n\ts_mov_b64 exec, %3\n\tds_add_u32 %8, %15\n\t"
                    "s_mov_b64 exec, %4"
                    : "=&s"(c0), "=&s"(c1), "=&s"(c2), "=&s"(c3), "=&s"(sv), "=&v"(t0), "=&v"(t1), "=&v"(t2), "=&v"(t3)
                    : "v"(key[4 * j4]), "v"(key[4 * j4 + 1]), "v"(key[4 * j4 + 2]), "v"(key[4 * j4 + 3]), "v"(L), "v"(hb), "v"(one) : "memory");
            else
                asm volatile(
                    "v_lshrrev_b32_e32 %5, %16, %9\n\tv_lshrrev_b32_e32 %6, %16, %10\n\tv_lshrrev_b32_e32 %7, %16, %11\n\tv_lshrrev_b32_e32 %8, %16, %12\n\t"
                    "v_cmp_eq_u32_e64 %0, %5, %13\n\tv_cmp_eq_u32_e64 %1, %6, %13\n\tv_cmp_eq_u32_e64 %2, %7, %13\n\tv_cmp_eq_u32_e64 %3, %8, %13\n\t"
                    "s_or_b64 %4, %0, %1\n\ts_or_b64 %4, %4, %2\n\ts_or_b64 %4, %4, %3\n\t"
                    "s_cbranch_scc0 .Lrxskip%=\n\t"
                    "v_bfe_u32 %5, %9, %17, 8\n\tv_bfe_u32 %6, %10, %17, 8\n\tv_bfe_u32 %7, %11, %17, 8\n\tv_bfe_u32 %8, %12, %17, 8\n\t"
                    "v_lshl_add_u32 %5, %5, 2, %14\n\tv_lshl_add_u32 %6, %6, 2, %14\n\tv_lshl_add_u32 %7, %7, 2, %14\n\tv_lshl_add_u32 %8, %8, 2, %14\n\t"
                    "s_mov_b64 %4, exec\n\t"
                    "s_mov_b64 exec, %0\n\tds_add_u32 %5, %15\n\ts_mov_b64 exec, %1\n\tds_add_u32 %6, %15\n\ts_mov_b64 exec, %2\n\tds_add_u32 %7, %15\n\ts_mov_b64 exec, %3\n\tds_add_u32 %8, %15\n\t"
                    "s_mov_b64 exec, %4\n"
                    ".Lrxskip%=:"
                    : "=&s"(c0), "=&s"(c1), "=&s"(c2), "=&s"(c3), "=&s"(sv), "=&v"(t0), "=&v"(t1), "=&v"(t2), "=&v"(t3)
                    : "v"(key[4 * j4]), "v"(key[4 * j4 + 1]), "v"(key[4 * j4 + 2]), "v"(key[4 * j4 + 3]), "v"(pre), "v"(hb), "v"(one), "n"((SHIFT + 8) & 31), "n"(SHIFT) : "memory", "scc");
        }
    }
    asm volatile("s_waitcnt lgkmcnt(0)" ::: "memory");
    unsigned dsum[4]; unsigned sumL = 0u;
    { const u32x4v v0 = ((const lds_u32x4*)(hist + fl * 4))[0];
      dsum[0] = v0.x; dsum[1] = v0.y; dsum[2] = v0.z; dsum[3] = v0.w; sumL = (dsum[0] + dsum[1]) + (dsum[2] + dsum[3]); }
    const unsigned incl = wave_incl_scan_u_dpp(sumL);
    const unsigned above = incl - sumL;
    const bool own = (above < (unsigned)need) && ((unsigned)need <= above + sumL);
    const int owner = __ffsll((long long)__ballot(own)) - 1;
    unsigned acc = above; int sel = -1; unsigned cab = 0u;
#pragma unroll
    for (int i = 3; i >= 0; --i) { const unsigned c = dsum[i]; const bool hit = (sel < 0) && (acc + c >= (unsigned)need); cab = hit ? acc : cab; sel = hit ? i : sel; acc += c; }
    const int ow = owner < 0 ? 0 : owner;
    const unsigned digit = (unsigned)__builtin_amdgcn_readlane(sel, ow) + (unsigned)(4 * (63 - ow));
    need -= (int)__builtin_amdgcn_readlane((int)cab, ow);
    return digit;
}

__device__ __forceinline__ void idx_select(const unsigned (&key)[64], unsigned t3, int jlim, lds_u32* hist, int lane, uint2* mrow, int WV_, unsigned char* lds) {
        unsigned wlo = 0u, whi = 0u;
        unsigned L = wave_min_u_dpp(t3);
        L = L > 1u ? L : 1u;

        int need = 256;
        ITS_E(34); ITS_B();
        const unsigned d1 = radix_pass<24>(key, 0u, hist, lane, need, jlim, L);
        ITS_E(30); ITS_B();
        const unsigned d2 = radix_pass<16>(key, d1, hist, lane, need, jlim, L);
        ITS_E(31); ITS_B();
        const unsigned d3 = radix_pass<8>(key, (d1 << 8) | d2, hist, lane, need, jlim, L);
        const unsigned d4 = radix_pass<0>(key, (d1 << 16) | (d2 << 8) | d3, hist, lane, need, jlim, L);
        const unsigned prefix = (d1 << 24) | (d2 << 16) | (d3 << 8) | d4;
        ITS_E(32); ITS_B();

        int ceq = 0;
#pragma unroll
        for (int j = 0; j < 64; ++j) cnt_eq(ceq, key[j], prefix);
        ceq = (int)wave_sum_u_dpp((unsigned)ceq);
        int X = 4096;
        if (ceq != need) {
            int X0 = 0;
#pragma unroll 1
            for (int bit = 11; bit >= 0; --bit) {
                const int c = X0 | (1 << bit);
                int cnt = 0; const int crel = (c - lane + 63) >> 6;
#pragma unroll
                for (int j = 0; j < 64; ++j) cnt_eq(cnt, (key[j] ^ prefix) | ~(unsigned)((j - crel) >> 31), 0u);
                cnt = wave_sum_i(cnt);
                if (cnt < need) X0 = c;
            }
            X = X0 + 1;
        }
        const int xrel = (X - lane + 63) >> 6;
#pragma unroll
        for (int j4 = 0; j4 < 16; ++j4) {
            if (4 * j4 <= jlim) {
#pragma unroll
                for (int e = 0; e < 4; ++e) { const int j = 4 * j4 + e;
                    const bool sel = (key[j] > prefix) || (key[j] == prefix && j < xrel);
                    const unsigned long long bm = __ballot(sel);
                    asm("v_writelane_b32 %0, %1, %2" : "+v"(wlo) : "s"((unsigned)bm), "n"(j));
                    asm("v_writelane_b32 %0, %1, %2" : "+v"(whi) : "s"((unsigned)(bm >> 32)), "n"(j)); }
            }
        }
        mrow[lane] = make_uint2(wlo, whi);
        ITS_E(33); ITS_B();
}
__device__ void index_fast_phase(int WV_, const bf16* P, unsigned char* mask, float* kmean, float* scratch_all, unsigned* qctr, unsigned char* lds) {
    const int tid = LTID(WV_), lane = tid & 63, wave = tid >> 6, bid = LBID(), G = LGRID();
    float* s_part = (float*)lds;
    ITS_B();
    for (int k = bid; k < 256; k += G) {
        const int b = k >> 6, h = (k >> 4) & 3, blk = k & 15;
        const bf16* kp = P + (size_t)(b * S_ + blk * 256 + wave * 32) * NP + C_KC + h * 64 + lane;
        float a = 0.f;
#pragma unroll 8
        for (int j = 0; j < 32; ++j) a += bf2f(kp[(size_t)j * NP]);
        __syncthreads();
        s_part[wave * 64 + lane] = a;
        __syncthreads();
        if (tid < 64) { float s = 0.f;
#pragma unroll
            for (int w = 0; w < 8; ++w) s += s_part[w * 64 + tid];
            kmean[((b * 4 + h) * 16 + blk) * 64 + tid] = s * (1.0f / 256.0f); }
    }
    ITS_E(22);
    constexpr int IDX_CP = 512 + 4;
    constexpr int IDX_PITCH = 4096 + 32;
    float* scr = scratch_all + (size_t)bid * (16 * IDX_PITCH);
    const int lq = lane & 15, g4 = lane >> 4;
    for (int ui = bid; ui < 1024; ui += G) {
        const int b = ui >> 8, k = ui & 255, tile = (b & 1) ? 255 - k : k, q0 = tile * 16;
        const bf16* Pb = P + (size_t)b * S_ * NP;
        const int ntiles = tile + 1;
        int lane_o = LANEID(); asm volatile("" : "+v"(lane_o));
        const int lane = lane_o, lq = lane & 15, g4 = lane >> 4;
        const int wave = WV_;
        const int qA = q0 + 2 * wave, qB = qA + 1;
        uint2* mrowA = (uint2*)(mask + (size_t)(b * S_ + qA) * 512); uint2* mrowB = (uint2*)(mask + (size_t)(b * S_ + qB) * 512);
        if (tile < 16) {
            unsigned wlo = 0u, whi = 0u, xlo = 0u, xhi = 0u; const int ra = qA - lane * 64, rb = qB - lane * 64;
#pragma unroll
            for (int j = 0; j < 32; ++j) { wlo |= (~(unsigned)((ra - j) >> 31) & 1u) << j; whi |= (~(unsigned)((ra - 32 - j) >> 31) & 1u) << j;
                                           xlo |= (~(unsigned)((rb - j) >> 31) & 1u) << j; xhi |= (~(unsigned)((rb - 32 - j) >> 31) & 1u) << j; }
            mrowA[lane] = make_uint2(wlo, whi); mrowB[lane] = make_uint2(xlo, xhi);
            continue;
        }
        ITS_B();
        bf16x8_t qf[8]; float wi[8];
        { const bf16* qp = Pb + (size_t)(q0 + lq) * NP + C_QI + 8 * g4;
#pragma unroll
          for (int h = 0; h < 8; ++h) qf[h] = *(const bf16x8_t*)(qp + 32 * h);
          const uint4 wv = *(const uint4*)(Pb + (size_t)(q0 + lq) * NP + C_WI); unpack8(wv, wi); }
        bf16x8_t qch, qcl;
        { typedef unsigned u32x4_t __attribute__((ext_vector_type(4)));
          float qc[8];
#pragma unroll
          for (int i = 0; i < 8; ++i) qc[i] = 0.f;
#pragma unroll
          for (int h = 0; h < 8; ++h) { const u32x4_t w4 = __builtin_bit_cast(u32x4_t, qf[h]);
#pragma unroll
              for (int i = 0; i < 4; ++i) { qc[2 * i] += wi[h] * __uint_as_float(w4[i] << 16); qc[2 * i + 1] += wi[h] * __uint_as_float(w4[i] & 0xffff0000u); } }
          u32x4_t hi4, lo4;
#pragma unroll
          for (int i = 0; i < 4; ++i) { const unsigned hw = cvtpk(qc[2 * i], qc[2 * i + 1]); hi4[i] = hw;
              lo4[i] = cvtpk(qc[2 * i] - __uint_as_float(hw << 16), qc[2 * i + 1] - __uint_as_float(hw & 0xffff0000u)); }
          qch = __builtin_bit_cast(bf16x8_t, hi4); qcl = __builtin_bit_cast(bf16x8_t, lo4); }
        typedef __attribute__((address_space(3))) bf16x8_t lds_bf16x8;
        lds_bf16x8* qops = (lds_bf16x8*)((__attribute__((address_space(3))) unsigned char*)lds + 102656);
        if (wave == 0) {
#pragma unroll
            for (int h = 0; h < 8; ++h) qops[h * 64 + lane] = qf[h];
            qops[8 * 64 + lane] = qch; qops[9 * 64 + lane] = qcl; }
        __syncthreads();
        ITS_E(20); ITS_B();
        float* cb0 = (float*)(lds + 69632); float* cb1 = (float*)(lds + 112896);
        const int jlim = q0 >> 6;
        const int jmaxA = (qA - lane) >> 6, jmaxB = (qB - lane) >> 6;
        unsigned keyA[64], keyB[64];
        unsigned a0 = 0u, a1 = 0u, a2 = 0u, a3 = 0u, b0 = 0u, b1 = 0u, b2 = 0u, b3 = 0u;
        const bf16* kbase = Pb + (size_t)lq * NP + C_KI + 8 * g4;
        bf16x8_t nxt = *(const bf16x8_t*)(kbase + (size_t)(wave < ntiles ? wave : 0) * 16 * NP);
#pragma unroll
        for (int c = 0; c < 8; ++c) {
            if (32 * c < ntiles) {
                float* cb = (c & 1) ? cb1 : cb0;
#pragma unroll
                for (int j = 0; j < 4; ++j) {
                    const int kt = 32 * c + wave + 8 * j;
                    const bf16x8_t af = nxt;
                    { const int k = kt + 8; const int kc = k < ntiles ? k : 0; nxt = *(const bf16x8_t*)(kbase + (size_t)kc * 16 * NP); }
                    if (kt < ntiles) {
                        const f32x4_t z = {0.f, 0.f, 0.f, 0.f};
                        f32x4_t sc = __builtin_amdgcn_mfma_f32_16x16x32_bf16(af, qops[8 * 64 + lane], z, 0, 0, 0);
                        sc = __builtin_amdgcn_mfma_f32_16x16x32_bf16(af, qops[9 * 64 + lane], sc, 0, 0, 0);
#pragma unroll
                        for (int hh = 0; hh < 2; ++hh) {
                            f32x4_t a[4];
#pragma unroll
                            for (int h = 0; h < 4; ++h) a[h] = __builtin_amdgcn_mfma_f32_16x16x32_bf16(af, qops[(4 * hh + h) * 64 + lane], z, 0, 0, 0);
#pragma unroll
                            for (int h = 0; h < 4; ++h)
#pragma unroll
                                for (int r = 0; r < 4; ++r) sc[r] = __builtin_fmaf(__builtin_fabsf(a[h][r]), wi[4 * hh + h], sc[r]);
                        }
#pragma unroll
                        for (int r = 0; r < 4; ++r) { sc[r] *= 0.03125f; if (sc[r] == 0.f) sc[r] = 0.f; }
                        *(f32x4_t*)(cb + lq * IDX_CP + (wave + 8 * j) * 16 + 4 * g4) = sc;
                    }
                }
                __syncthreads();
#pragma unroll
                for (int js = 0; js < 8; ++js) {
                    const int slot = 8 * c + js;
                    if (slot <= jlim) {
                        const unsigned ua = __float_as_uint(cb[(2 * wave) * IDX_CP + 64 * js + lane]), ub = __float_as_uint(cb[(2 * wave + 1) * IDX_CP + 64 * js + lane]);
                        const unsigned xa = (ua ^ ((unsigned)((int)ua >> 31) | 0x80000000u)) & ~(unsigned)((jmaxA - slot) >> 31);
                        const unsigned xb = (ub ^ ((unsigned)((int)ub >> 31) | 0x80000000u)) & ~(unsigned)((jmaxB - slot) >> 31);
                        keyA[slot] = xa; keyB[slot] = xb;
                        unsigned n1, n2, n3;
                        asm("v_med3_u32 %0, %1, %2, %3" : "=v"(n3) : "v"(a2), "v"(a3), "v"(xa));
                        asm("v_med3_u32 %0, %1, %2, %3" : "=v"(n2) : "v"(a1), "v"(a2), "v"(xa));
                        asm("v_med3_u32 %0, %1, %2, %3" : "=v"(n1) : "v"(a0), "v"(a1), "v"(xa));
                        a0 = a0 > xa ? a0 : xa; a1 = n1; a2 = n2; a3 = n3;
                        asm("v_med3_u32 %0, %1, %2, %3" : "=v"(n3) : "v"(b2), "v"(b3), "v"(xb));
                        asm("v_med3_u32 %0, %1, %2, %3" : "=v"(n2) : "v"(b1), "v"(b2), "v"(xb));
                        asm("v_med3_u32 %0, %1, %2, %3" : "=v"(n1) : "v"(b0), "v"(b1), "v"(xb));
                        b0 = b0 > xb ? b0 : xb; b1 = n1; b2 = n2; b3 = n3;
                    } else { keyA[slot] = 0u; keyB[slot] = 0u; }
                }
            } else {
#pragma unroll
                for (int js = 0; js < 8; ++js) { keyA[8 * c + js] = 0u; keyB[8 * c + js] = 0u; }
            }
        }
        lds_u32* hist = (lds_u32*)((__attribute__((address_space(3))) unsigned char*)lds + 2048) + wave * 2048;
        ITS_E(23); ITS_B();
        idx_select(keyA, a3, jlim, hist, lane, mrowA, WV_, lds);
        ITS_E(24); ITS_B();
        idx_select(keyB, b3, jlim, hist, lane, mrowB, WV_, lds);
        ITS_E(25); ITS_B();
        __syncthreads();
    }
}

constexpr int MG_P = 72;
constexpr int MG_TILE_BYTES = 128 * MG_P * 2;
__device__ void merge_fast_phase(int WV_, const unsigned char* G8, const bf16* ys, const bf16* wbt  , bf16* merged, unsigned char* lds) {
    const int tid = LTID(WV_), lane = tid & 63, wave = tid >> 6, r32 = lane & 31, hi = lane >> 5, wt = wave & 3, wd = wave >> 2;
    const int srow0 = tid >> 3, sch = tid & 7;
    for (int tile = LBID(); tile < 1024; tile += LGRID()) {
        const int tok0 = (tile >> 3) * 128, d0 = (tile & 7) * 128;
        f32x16_t mer[2], acc[2];
#pragma unroll
        for (int r = 0; r < 16; ++r) { mer[0][r] = 0.f; mer[1][r] = 0.f; acc[0][r] = 0.f; acc[1][r] = 0.f; }
        uint4 RW00, RW01, RW10, RW11, RY00, RY01, RY10, RY11, RG0, RG1;
        unsigned char* gl = lds + 4 * MG_TILE_BYTES;
        const int grow = tid >> 3, gch = tid & 7;
#define MG_GLOAD(st_, R_) do { const int n_ = (st_) >> 2, kc_ = (st_) & 3; \
            RW##R_##0 = *(const uint4*)(wbt + ((size_t)n_ * 1024 + d0 + srow0) * 256 + kc_ * 64 + sch * 8); \
            RW##R_##1 = *(const uint4*)(wbt + ((size_t)n_ * 1024 + d0 + srow0 + 64) * 256 + kc_ * 64 + sch * 8); \
            RY##R_##0 = *(const uint4*)(ys + (size_t)(tok0 + srow0) * 1024 + n_ * 256 + kc_ * 64 + sch * 8); \
            RY##R_##1 = *(const uint4*)(ys + (size_t)(tok0 + srow0 + 64) * 1024 + n_ * 256 + kc_ * 64 + sch * 8); } while (0)
#define MG_SSTORE(buf_, R_) do { bf16* wl_ = (bf16*)(lds + (buf_) * 2 * MG_TILE_BYTES); bf16* yl_ = (bf16*)(lds + (buf_) * 2 * MG_TILE_BYTES + MG_TILE_BYTES); \
            *(uint4*)(wl_ + srow0 * MG_P + sch * 8) = RW##R_##0; *(uint4*)(wl_ + (srow0 + 64) * MG_P + sch * 8) = RW##R_##1; \
            *(uint4*)(yl_ + srow0 * MG_P + sch * 8) = RY##R_##0; *(uint4*)(yl_ + (srow0 + 64) * MG_P + sch * 8) = RY##R_##1; } while (0)
        __syncthreads();
        MG_GLOAD(0, 0); MG_GLOAD(1, 1);
        MG_SSTORE(0, 0);
        __syncthreads();
#define MG_STAGE(PAR_, OTH_) do { const int buf = PAR_; \
            if (st + 2 < 16) MG_GLOAD(st + 2, PAR_); \
            if ((st & 3) == 1) { const unsigned char* gsrc = G8 + (size_t)(tok0 + grow) * 4096 + (st >> 2) * 1024 + d0 + gch * 16; \
                RG0 = *(const uint4*)gsrc; RG1 = *(const uint4*)(gsrc + (size_t)64 * 4096); } \
            const bf16* wl = (const bf16*)(lds + buf * 2 * MG_TILE_BYTES); const bf16* yl = (const bf16*)(lds + buf * 2 * MG_TILE_BYTES + MG_TILE_BYTES); \
            _Pragma("unroll") for (int ks = 0; ks < 4; ++ks) { \
                const bf16x8_t bq = *(const bf16x8_t*)(yl + (32 * wt + r32) * MG_P + 16 * ks + 8 * hi); \
                const bf16x8_t a0 = *(const bf16x8_t*)(wl + (64 * wd + r32) * MG_P + 16 * ks + 8 * hi); \
                const bf16x8_t a1 = *(const bf16x8_t*)(wl + (64 * wd + 32 + r32) * MG_P + 16 * ks + 8 * hi); \
                acc[0] = __builtin_amdgcn_mfma_f32_32x32x16_bf16(a0, bq, acc[0], 0, 0, 0); \
                acc[1] = __builtin_amdgcn_mfma_f32_32x32x16_bf16(a1, bq, acc[1], 0, 0, 0); } \
            if ((st & 3) == 3) { \
                const int n = st >> 2; \
                const unsigned char* gp = gl + (32 * wt + r32) * 144 + 64 * wd + 4 * hi; (void)n; \
                _Pragma("unroll") for (int dt = 0; dt < 2; ++dt) \
                _Pragma("unroll") for (int g = 0; g < 4; ++g) { \
                        const int gv = *(const int*)(gp + 32 * dt + 8 * g); \
                        mer[dt][4 * g + 0] += acc[dt][4 * g + 0] * __builtin_amdgcn_cvt_f32_fp8(gv, 0); \
                        mer[dt][4 * g + 1] += acc[dt][4 * g + 1] * __builtin_amdgcn_cvt_f32_fp8(gv, 1); \
                        mer[dt][4 * g + 2] += acc[dt][4 * g + 2] * __builtin_amdgcn_cvt_f32_fp8(gv, 2); \
                        mer[dt][4 * g + 3] += acc[dt][4 * g + 3] * __builtin_amdgcn_cvt_f32_fp8(gv, 3); } \
                _Pragma("unroll") for (int r = 0; r < 16; ++r) { acc[0][r] = 0.f; acc[1][r] = 0.f; } } \
            if (st + 1 < 16) MG_SSTORE(OTH_, OTH_); \
            if ((st & 3) == 2) { *(uint4*)(gl + grow * 144 + gch * 16) = RG0; *(uint4*)(gl + (grow + 64) * 144 + gch * 16) = RG1; } \
            __syncthreads(); } while (0)
#pragma unroll 1
        for (int st2 = 0; st2 < 16; st2 += 2) { { const int st = st2; MG_STAGE(0, 1); } { const int st = st2 + 1; MG_STAGE(1, 0); } }
#undef MG_STAGE
#undef MG_GLOAD
#undef MG_SSTORE
        bf16* mp = merged + (size_t)(tok0 + 32 * wt + r32) * 1024 + d0 + 64 * wd + 4 * hi;
#pragma unroll
        for (int dt = 0; dt < 2; ++dt)
#pragma unroll
            for (int g = 0; g < 4; ++g)
                *(uint2*)(mp + 32 * dt + 8 * g) = make_uint2(cvtpk(mer[dt][4 * g], mer[dt][4 * g + 1]), cvtpk(mer[dt][4 * g + 2], mer[dt][4 * g + 3]));
    }
}
#define LAS __attribute__((address_space(3)))
#define XB_TMO      128
#define XB_XCNT(j)  (256  + 64 * (j))
#define XB_XSUB(j)  (1280 + 64 * (j))
#define XB_XGEN(j)  (2304 + 64 * (j))
#define XB_TOP      3328
#define XB_TOPGEN   3392
#define XCD_BAR_WORDS 3456
#define XB_SPIN_CAP (1u << 18)

__device__ __forceinline__ unsigned xb_ld(unsigned* p)              { return __hip_atomic_load(p, __ATOMIC_RELAXED, __HIP_MEMORY_SCOPE_AGENT); }
__device__ __forceinline__ unsigned xb_add(unsigned* p, unsigned v) { return __hip_atomic_fetch_add(p, v, __ATOMIC_RELAXED, __HIP_MEMORY_SCOPE_AGENT); }
__device__ __forceinline__ unsigned xb_xcc_id() { return (unsigned)__builtin_amdgcn_s_getreg((3 << 11) | 20) & 0xFu; }
#define XB_SPIN(cond, bar) do { unsigned _sp = 0; while (cond) { __builtin_amdgcn_s_sleep(1); \
    if ((++_sp & 255u) == 0u) { if (xb_ld(&(bar)[XB_TMO])) break; if (_sp > XB_SPIN_CAP) { atomicAdd(&(bar)[XB_TMO], 1u); break; } } } } while (0)

struct XcdBarrier {
    unsigned* bar; unsigned x;
    volatile LAS unsigned* st;
};

__device__ __forceinline__ XcdBarrier xcd_barrier_post(unsigned* bar, volatile LAS unsigned* st) {
    XcdBarrier b; b.bar = bar; b.x = xb_xcc_id(); b.st = st;
    if (threadIdx.x == 0) (void)xb_add(&bar[XB_XCNT(b.x)], 1u);
    return b;
}
__device__ __forceinline__ void xcd_barrier_complete(unsigned* bar, unsigned x, unsigned& nloc, unsigned& nx) {
    const unsigned G = gridDim.x * gridDim.y * gridDim.z;
    unsigned sum, cnt, mine, sp = 0u;
    for (;;) {
        sum = 0u; cnt = 0u; mine = 0u;
#pragma unroll
        for (unsigned j = 0; j < 16; ++j) { const unsigned c = xb_ld(&bar[XB_XCNT(j)]); sum += c; cnt += (c > 0u) ? 1u : 0u; mine = (j == x) ? c : mine; }
        if (sum == G) break;
        __builtin_amdgcn_s_sleep(1);
        if ((++sp & 255u) == 0u) { if (xb_ld(&bar[XB_TMO])) break; if (sp > XB_SPIN_CAP) { atomicAdd(&bar[XB_TMO], 1u); break; } }
    }
    nloc = mine > 0u ? mine : 1u; nx = cnt > 0u ? cnt : 1u;
}

__device__ __forceinline__ void xcd_barrier(const XcdBarrier& b, int wv_) {
    asm volatile("s_waitcnt vmcnt(0)" ::: "memory");
    __syncthreads();
    if (wv_ == 0 && LANEID() == 0) {
        unsigned* bar = b.bar;
        __builtin_amdgcn_s_waitcnt(0);
        unsigned nloc = b.st[0], nx = b.st[1];
        if (nloc == 0u) { xcd_barrier_complete(bar, b.x, nloc, nx); b.st[0] = nloc; b.st[1] = nx; }
        const unsigned old = xb_add(&bar[XB_XSUB(b.x)], 1u);
        const unsigned gen = old / nloc;
        if (old + 1u == (gen + 1u) * nloc) {
            __builtin_amdgcn_fence(__ATOMIC_RELEASE, "agent");
            asm volatile("s_waitcnt vmcnt(0)" ::: "memory");
            const unsigned og = xb_add(&bar[XB_TOP], 1u);
            const unsigned tg = og / nx;
            if (og + 1u == (tg + 1u) * nx) xb_add(&bar[XB_TOPGEN], 1u);
            else XB_SPIN(xb_ld(&bar[XB_TOPGEN]) == tg, bar);
            __builtin_amdgcn_fence(__ATOMIC_ACQUIRE, "agent");
            xb_add(&bar[XB_XGEN(b.x)], 1u);
            asm volatile("s_waitcnt vmcnt(0)" ::: "memory");
        } else {
            XB_SPIN(xb_ld(&bar[XB_XGEN(b.x)]) == gen, bar);
            __builtin_amdgcn_fence(__ATOMIC_ACQUIRE, "agent");
            asm volatile("s_waitcnt vmcnt(0)" ::: "memory");
        }
    }
    __syncthreads();
}

enum { PH_PRO = 0, PH_GIN, PH_INDEX, PH_ATTN, PH_MERGE, PH_GOUT, PH_LN1, PH_GQ, PH_ROUTE, PH_PEER };
template <int PH> __device__ __forceinline__ void run_phase(int WV_, const Params& p_unused, int l, unsigned char* lds_raw) {
    size_t kaoff_ = 0; asm volatile("" : "+s"(kaoff_));
    typedef const __attribute__((address_space(4))) char* kaptr_t;
    const __attribute__((address_space(4))) Params& p = *(const __attribute__((address_space(4))) Params*)((kaptr_t)__builtin_amdgcn_kernarg_segment_ptr() + kaoff_);
    float* sm = (float*)lds_raw;
    size_t wsoff_ = 0; asm volatile("" : "+s"(wsoff_));
    unsigned char* ws = p.ws + wsoff_;
    float* hbuf = p.out;
    bf16* hb = (bf16*)(ws + WS_HB);
    bf16* P = (bf16*)(ws + WS_P);
    bf16* ys = (bf16*)(ws + WS_YS);
    bf16* mrg = (bf16*)(ws + WS_MRG);
    float* mix = (float*)(ws + WS_MIX);
    float* qb = (float*)(ws + WS_Q);
    unsigned char* mask = ws + WS_MASK;
    int* eid = (int*)(ws + WS_EID);
    float* gate = (float*)(ws + WS_GATE);
    float* kmean = (float*)(ws + WS_KMEAN);
    const float* hin = (l == 0) ? p.in[0] : hbuf;
    if (PH == PH_PRO) { Params pc; for (int i = 0; i < 13; ++i) pc.in[i] = p.in[i]; pc.out = p.out; pc.ws = ws;
        prologue_phase(WV_, pc, sm); convert_tables(WV_, pc);
        for (int i = LBID() * NTHR + LTID(WV_); i < DEPTH_ * 8 * 2 * 128 * 64 / 4; i += LGRID() * NTHR) { const float4 v = ((const float4*)p.in[8])[i]; ((uint2*)(ws + WS_SKB))[i] = make_uint2(pk2(v.x, v.y), pk2(v.z, v.w)); } if (LBID() < 2) build_unit_table((unsigned*)(ws + WS_CTL) + 1024, LBID() * NTHR + LTID(WV_)); }
    else if (PH == PH_GIN) {
        pg8::Gemm g{hb, (const bf16*)(ws + WS_WIN_T + l * WIN_T_BYTES), T_, NP, 1024};
        pg8::StaticOrder S; S.init(T_, NP, (int)LGRID(), (int)LBID());
        pg8::EpiBf16Sig E{P, NP, C_G, ws + WS_G8};
        pg8::gemm_phase<pg8::EpiBf16Sig, pg8::StaticOrder, true, true>(WV_, (PG8_LAS unsigned char*)lds_raw, g, S, E);
    }
    else if (PH == PH_INDEX) index_fast_phase(WV_, P, mask, kmean, (float*)(ws + WS_UV + 48 * MiB), (unsigned*)(ws + WS_CTL) + 64 * l + 16, lds_raw);
    else if (PH == PH_ATTN) attn_fast_phase(WV_, P, mask, kmean, p.in[4] + l * 4, ys, (const unsigned*)(ws + WS_CTL) + 1024, (unsigned*)(ws + WS_CTL) + 64 * l, lds_raw);
    else if (PH == PH_MERGE) merge_fast_phase(WV_, ws + WS_G8, ys, (const bf16*)(ws + WS_WBR_T) + (size_t)l * 4 * 1024 * 256, mrg, lds_raw);
    else if (PH == PH_GOUT) {
        pg8::Gemm g{mrg, (const bf16*)(ws + WS_WOUT_T) + (size_t)l * 1024 * 1024, T_, 1024, 1024};
        pg8::StaticOrder S; S.init(T_, 1024, (int)LGRID(), (int)LBID());
        pg8::EpiResY E{l == 0 ? hin : nullptr, hb, hb, (float*)(ws + WS_STATS) + (size_t)l * T_ * 2, ALPHA};
        pg8::gemm_phase<pg8::EpiResY, pg8::StaticOrder, true, true>(WV_, (PG8_LAS unsigned char*)lds_raw, g, S, E);
    }
    else if (PH == PH_GQ) {
        pg8::Gemm g{hb, (const bf16*)(ws + WS_WQ_T) + (size_t)l * 1024 * 1024, T_, 1024, 1024};
        pg8::StaticOrder S; S.init(T_, 1024, (int)LGRID(), (int)LBID());
        pg8::EpiLnFold E{(bf16*)qb, (const float*)(ws + WS_STATS) + (size_t)l * T_ * 2, (const float*)(ws + WS_COLS) + l * 2048, (const float*)(ws + WS_COLS) + l * 2048 + 1024, LN_EPS};
        pg8::gemm_phase<pg8::EpiLnFold, pg8::StaticOrder, true, true>(WV_, (PG8_LAS unsigned char*)lds_raw, g, S, E);
        pg8::Unit u0;
        if (LGRID() == 256 && S.next(0, u0)) {
            asm volatile("s_waitcnt vmcnt(0)" ::: "memory"); __syncthreads();
            route_fast_phase(WV_, (const bf16*)qb, (const bf16*)(ws + WS_SKB) + (size_t)l * 8 * 2 * 128 * 64, eid, gate, lds_raw, u0.pm, u0.pn);
        }
    }
    else if (PH == PH_ROUTE) { if (LGRID() != 256) route_fast_phase(WV_, (const bf16*)qb, (const bf16*)(ws + WS_SKB) + (size_t)l * 8 * 2 * 128 * 64, eid, gate, lds_raw); }
    else peer_fast_phase(WV_, (l + 1 == DEPTH_) ? hbuf : nullptr, hb, eid, gate, ws + WS_UV + (size_t)l * 24 * MiB, p.in[5] + l * 1024, p.in[6] + l * 1024, p.in[11] + l * 1024, p.in[12] + l * 1024, lds_raw);
}

constexpr int CW_BAR = 4096;
constexpr int LDS_BARST = LDS_BYTES - 16;
__global__ void __launch_bounds__(NTHR, 2) mk_fwd(Params p) {
    extern __shared__ __attribute__((aligned(16))) unsigned char lds_raw[];
    cg::grid_group grid = cg::this_grid();
    const int WV_ = __builtin_amdgcn_readfirstlane((int)threadIdx.x >> 6);
    { volatile LAS unsigned* bst0 = (volatile LAS unsigned*)((LAS unsigned char*)lds_raw + LDS_BARST); if (threadIdx.x < 4) bst0[threadIdx.x] = 0u; }
    __syncthreads();
    volatile LAS unsigned* bst = (volatile LAS unsigned*)((LAS unsigned char*)lds_raw + LDS_BARST);
    { uint4* z = (uint4*)p.ws; const uint4 z4 = make_uint4(0u, 0u, 0u, 0u);
      for (unsigned i = (unsigned)LBID() * NTHR + (unsigned)LTID(WV_); i < (unsigned)(2 * MiB / 16); i += (unsigned)LGRID() * NTHR) z[i] = z4; }
    grid.sync();
    (void)xcd_barrier_post((unsigned*)(p.ws + WS_CTL) + CW_BAR, bst);
#define GRID_BAR() do { XcdBarrier b_; b_.bar = (unsigned*)(p.ws + WS_CTL) + CW_BAR; b_.x = xb_xcc_id(); b_.st = (volatile LAS unsigned*)((LAS unsigned char*)lds_raw + LDS_BARST); xcd_barrier(b_, WV_); } while (0)
    run_phase<PH_PRO>(WV_, p, 0, lds_raw);
    GRID_BAR();
#pragma unroll 1
    for (int l = 0; l < DEPTH_; ++l) {
        run_phase<PH_GIN>(WV_, p, l, lds_raw); GRID_BAR();
        run_phase<PH_INDEX>(WV_, p, l, lds_raw); GRID_BAR();
        run_phase<PH_ATTN>(WV_, p, l, lds_raw); GRID_BAR();
        run_phase<PH_MERGE>(WV_, p, l, lds_raw); GRID_BAR();
        run_phase<PH_GOUT>(WV_, p, l, lds_raw); GRID_BAR();
        run_phase<PH_GQ>(WV_, p, l, lds_raw); if (LGRID() != 256) { GRID_BAR(); run_phase<PH_ROUTE>(WV_, p, l, lds_raw); } GRID_BAR();
        run_phase<PH_PEER>(WV_, p, l, lds_raw); if (l + 1 < DEPTH_) GRID_BAR();
    }
}

extern "C" void kernel_launch(void* const* d_in, const int* in_sizes, int n_in, void* d_out, int out_size, void* d_ws, size_t ws_size, hipStream_t stream) {
    if (n_in != 13 || ws_size < WS_END) { fprintf(stderr, "kernel_launch: unexpected n_in %d / ws_size %zu; nothing launched\n", n_in, ws_size); return; }
    static int grid_blocks = 0;
    if (grid_blocks == 0) {
        int dev = 0, cus = 0, per_cu = 0;
        (void)hipGetDevice(&dev);
        (void)hipDeviceGetAttribute(&cus, hipDeviceAttributeMultiprocessorCount, dev);
        (void)hipFuncSetAttribute((const void*)mk_fwd, hipFuncAttributeMaxDynamicSharedMemorySize, LDS_BYTES);
        (void)hipOccupancyMaxActiveBlocksPerMultiprocessor(&per_cu, (const void*)mk_fwd, NTHR, LDS_BYTES);
        if (per_cu < 1) fprintf(stderr, "kernel_launch: occupancy query reports %d\n", per_cu);
        grid_blocks = cus;
    }
    Params p{};
    for (int i = 0; i < 13; ++i) p.in[i] = (const float*)d_in[i];
    p.out = (float*)d_out; p.ws = (unsigned char*)d_ws;
    void* args[] = {&p};
    hipError_t e = hipLaunchCooperativeKernel((const void*)mk_fwd, dim3(grid_blocks), dim3(NTHR), args, LDS_BYTES, stream);
    if (e != hipSuccess) fprintf(stderr, "cooperative launch failed: %s (grid %d)\n", hipGetErrorString(e), grid_blocks);
}
```

```cpp
#include <hip/hip_runtime.h>
#include <cstdio>
#include <cstdint>
#include <hip/hip_cooperative_groups.h>
namespace cg = cooperative_groups;

__device__ __forceinline__ int LANEID() { int l; asm volatile("v_mbcnt_lo_u32_b32 %0, -1, 0\n\tv_mbcnt_hi_u32_b32 %0, -1, %0" : "=v"(l)); return l; }
__device__ __forceinline__ int LTID(int wv) { return (wv << 6) | LANEID(); }
__device__ __forceinline__ int LBID() { int t = blockIdx.x; asm volatile("" : "+s"(t)); return t; }
__device__ __forceinline__ int LGRID() { int t = gridDim.x; asm volatile("" : "+s"(t)); return t; }
namespace pg8 {
#define PG8_LAS __attribute__((address_space(3)))
typedef unsigned short bf16_t;
typedef short bf16x8 __attribute__((ext_vector_type(8)));
typedef float f32x4 __attribute__((ext_vector_type(4)));
typedef unsigned u32x4 __attribute__((ext_vector_type(4)));
constexpr int BM = 256, BK = 64, HALF = 128, HTB = HALF * BK * 2  , STAGE_BYTES = 8 * HTB, NXCD = 8, WGM = 8;

__host__ __device__ __forceinline__ int lds_byte(int r, int c) { const int st = (r >> 4) * 2 + (c >> 5), rr = r & 15, cc = c & 31, ob = rr * 64 + cc * 2; return st * 1024 + (ob ^ (((ob >> 9) & 1) << 5)); }
__host__ __device__ __forceinline__ void stage_rc(int b, int& R, int& C) { const int st = b / 1024, sb = b % 1024, swz = sb ^ (((sb >> 9) & 1) << 5); R = (st >> 1) * 16 + swz / 64; C = (st & 1) * 32 + (swz % 64) / 2; }
__host__ __device__ __forceinline__ int perm32(int rho) { const int n = rho >> 4, i = rho & 15; return 8 * (i >> 2) + 4 * n + (i & 3); }

struct Unit { int pm, pn; };
struct Gemm { const bf16_t* A; const bf16_t* Bt; int M, N, K; };

struct StaticOrder {
    int nM, nN, nwg, G, c;
    __host__ __device__ void init(int M, int N, int G_, int c_) { nM = M / BM; nN = N / BM; nwg = nM * nN; G = G_; c = c_; }
    __host__ __device__ bool next(int i, Unit& u) const {
        const long L = (long)i * G + c; if (L >= nwg) return false;
        int wgid = (int)L; { const int q = nwg / NXCD, r = nwg % NXCD, xcd = wgid % NXCD, off = wgid / NXCD; wgid = (xcd < r ? xcd * (q + 1) : r * (q + 1) + (xcd - r) * q) + off; }
        const int nig = WGM * nN, gid = wgid / nig, fm = gid * WGM, gsz = (nM - fm) < WGM ? (nM - fm) : WGM;
        u.pm = fm + ((wgid % nig) % gsz); u.pn = (wgid % nig) / gsz; return true;
    }
    __device__ __forceinline__ void a_ready(const Unit&) const {}
    __device__ __forceinline__ void done(const Unit&) const {}
};

__device__ __forceinline__ unsigned cvt_pk_bf16(float lo, float hi) { unsigned r; asm volatile("v_cvt_pk_bf16_f32 %0, %1, %2" : "=v"(r) : "v"(lo), "v"(hi)); return r; }
typedef float f32x2 __attribute__((ext_vector_type(2)));
__device__ __forceinline__ f32x2 gelu_pk(f32x2 v) {
    const f32x2 av = __builtin_elementwise_abs(v), d = av * 0.2316418882f + 1.0f;
    f32x2 t; t.x = __builtin_amdgcn_rcpf(d.x); t.y = __builtin_amdgcn_rcpf(d.y);
    f32x2 q = t * 0.5307027145f + (-0.7265760135f); q = q * t + 0.7107068705f; q = q * t + (-0.142248368f); q = q * t + 0.127414796f; q = q * t;
    const f32x2 s = (v * v) * (-0.72134752044f);
    f32x2 e; e.x = __builtin_amdgcn_exp2f(s.x); e.y = __builtin_amdgcn_exp2f(s.y);
    const f32x2 m = v * (q * e), r = v - m;
    f32x2 o; o.x = v.x < 0.f ? m.x : r.x; o.y = v.y < 0.f ? m.y : r.y; return o;
}

template <int ACT  > struct EpiBf16 {
    static constexpr bool PERM = true, AFTER_DRAIN = false; static_assert(ACT == 0 || ACT == 1, "EpiBf16: ACT is 0 (none) or 1 (gelu_pk)");
    bf16_t* O; int ldc; const float* bias; int split_cols; size_t split_stride; float scale0;
    __device__ __forceinline__ void operator()(const f32x4 (&acc)[2][2][4][2], const Unit& u, int wr, int wc, int fr, int fq) const {
        { int ln_ = LANEID(); asm volatile("" : "+v"(ln_)); fr = ln_ & 15; fq = ln_ >> 4; }
        const int row0 = u.pm * BM + wr * 64 + fr; int colt = u.pn * BM; bf16_t* base = O;
        float sc = 1.f; if (split_cols) { const int t = colt / split_cols; base += (size_t)t * split_stride; colt -= t * split_cols; if (t == 0) sc = scale0; }
        const int col0 = colt + wc * 32 + 8 * fq, bcol0 = u.pn * BM + wc * 32 + 8 * fq;
        f32x4 bv[2][2];
#pragma unroll
        for (int bj = 0; bj < 2; ++bj)
#pragma unroll
            for (int n = 0; n < 2; ++n) bv[bj][n] = bias ? *(const f32x4*)(bias + bcol0 + bj * HALF + 4 * n) : (f32x4){0.f, 0.f, 0.f, 0.f};
#pragma unroll
        for (int ai = 0; ai < 2; ++ai)
#pragma unroll
            for (int m = 0; m < 4; ++m) { bf16_t* rowp = base + (size_t)(row0 + ai * HALF + m * 16) * ldc + col0;
#pragma unroll
                for (int bj = 0; bj < 2; ++bj) { f32x4 v0 = acc[ai][bj][m][0] + bv[bj][0], v1 = acc[ai][bj][m][1] + bv[bj][1];
                    if (ACT == 1) { f32x2 a = gelu_pk((f32x2){v0[0], v0[1]}), b = gelu_pk((f32x2){v0[2], v0[3]}), c = gelu_pk((f32x2){v1[0], v1[1]}), d = gelu_pk((f32x2){v1[2], v1[3]});
                        v0 = (f32x4){a.x, a.y, b.x, b.y}; v1 = (f32x4){c.x, c.y, d.x, d.y}; }
                    v0 = v0 * sc; v1 = v1 * sc; u32x4 w; w.x = cvt_pk_bf16(v0[0], v0[1]); w.y = cvt_pk_bf16(v0[2], v0[3]); w.z = cvt_pk_bf16(v1[0], v1[1]); w.w = cvt_pk_bf16(v1[2], v1[3]);
                    *(u32x4*)(rowp + bj * HALF) = w; } }
    }
};
template <class Epi, class Sched, bool ALIGN_EPI = false, bool SP2 = false>
__device__ __forceinline__ void gemm_phase(int WV_, PG8_LAS unsigned char* lds, const Gemm g, const Sched& S, const Epi& E) {
    const int tid = LTID(WV_), wid = __builtin_amdgcn_readfirstlane(tid >> 6), lane = tid & 63, wr = wid >> 2, wc = wid & 3, fr = lane & 15, fq = lane >> 4;
    const int K = g.K, nt = K / BK;
    unsigned voffA[2], voffB[2];
#pragma unroll
    for (int i = 0; i < 2; ++i) { int R, C; stage_rc(tid * 16 + i * 8192, R, C); const int Rb = Epi::PERM ? ((R & ~31) + perm32(R & 31)) : R;
        voffA[i] = (unsigned)(R * K + C) * 2u; voffB[i] = (unsigned)(Rb * K + C) * 2u; }
    const size_t kstep = (size_t)(BK * 2);
    const size_t hstep = (size_t)HALF * K * 2;
    const size_t tstep = 2 * hstep;
    const unsigned ldsw = (unsigned)wid * 1024u;
    const int aoff = lds_byte(wr * 64 + fr, fq * 8), boff = lds_byte(wc * 32 + fr, fq * 8);
#define PG8_SA(b, h) (((b) * 2 + (h)) * HTB)
#define PG8_SB(b, h) ((4 + (b) * 2 + (h)) * HTB)
#define PG8_STAGE(bufoff, gbase, voff) do { _Pragma("unroll") for (int _i = 0; _i < 2; ++_i) \
        __builtin_amdgcn_global_load_lds((const unsigned*)((const char*)(gbase) + (voff)[_i]), (PG8_LAS unsigned*)(lds + (bufoff) + ldsw + _i * 8192), 16, 0, 0); } while (0)
#define PG8_LDA(dst, b, h) do { _Pragma("unroll") for (int m = 0; m < 4; ++m) _Pragma("unroll") for (int k = 0; k < 2; ++k) dst[m][k] = *(const PG8_LAS bf16x8*)(lds + PG8_SA(b, h) + aoff + m * 2048 + k * 1024); } while (0)
#define PG8_LDB(dst, b, h) do { _Pragma("unroll") for (int n = 0; n < 2; ++n) _Pragma("unroll") for (int k = 0; k < 2; ++k) dst[n][k] = *(const PG8_LAS bf16x8*)(lds + PG8_SB(b, h) + boff + n * 2048 + k * 1024); } while (0)
#define PG8_MMA(ai, bj, At, Bt) do { __builtin_amdgcn_s_setprio(1); _Pragma("unroll") for (int m = 0; m < 4; ++m) _Pragma("unroll") for (int n = 0; n < 2; ++n) _Pragma("unroll") for (int k = 0; k < 2; ++k) \
        acc[ai][bj][m][n] = __builtin_amdgcn_mfma_f32_16x16x32_bf16(Bt[n][k], At[m][k], acc[ai][bj][m][n], 0, 0, 0); __builtin_amdgcn_s_setprio(0); } while (0)
#define PG8_WAIT_V(n) asm volatile("s_waitcnt vmcnt(" #n ")" ::: "memory")
#define PG8_WAIT_L(n) asm volatile("s_waitcnt lgkmcnt(" #n ")" ::: "memory")
#define PG8_BAR __builtin_amdgcn_s_barrier()
#define PG8_SCHED __builtin_amdgcn_sched_barrier(0)
    Unit cur, nxt; int ui = 0;
    if (!S.next(0, cur)) return;
    f32x4 acc[2][2][4][2];
#pragma unroll
    for (int a = 0; a < 2; ++a)
#pragma unroll
        for (int b = 0; b < 2; ++b)
#pragma unroll
            for (int m = 0; m < 4; ++m)
#pragma unroll
                for (int n = 0; n < 2; ++n) acc[a][b][m][n] = (f32x4){0.f, 0.f, 0.f, 0.f};
    bf16x8 At[4][2], B0[2][2], B1[2][2];
    const char* cA = (const char*)g.A + (size_t)cur.pm * tstep; const char* cB = (const char*)g.Bt + (size_t)cur.pn * tstep;
    S.a_ready(cur);
    if constexpr (SP2) {
        PG8_STAGE(PG8_SB(0, 0), cB, voffB); PG8_STAGE(PG8_SB(0, 1), cB + hstep, voffB); PG8_STAGE(PG8_SA(0, 0), cA, voffA); PG8_STAGE(PG8_SA(0, 1), cA + hstep, voffA);
        if (wr == 1) PG8_BAR;
        PG8_WAIT_V(2); PG8_BAR;
        PG8_STAGE(PG8_SB(1, 0), cB + kstep, voffB); PG8_STAGE(PG8_SA(1, 0), cA + kstep, voffA); PG8_STAGE(PG8_SB(1, 1), cB + hstep + kstep, voffB);
        PG8_WAIT_V(6); PG8_BAR;
    } else {
        PG8_STAGE(PG8_SB(0, 0), cB, voffB); PG8_STAGE(PG8_SA(0, 0), cA, voffA); PG8_STAGE(PG8_SB(0, 1), cB + hstep, voffB); PG8_STAGE(PG8_SA(0, 1), cA + hstep, voffA);
        if (wr == 1) PG8_BAR;
        PG8_WAIT_V(4); PG8_BAR;
        PG8_STAGE(PG8_SB(1, 0), cB + kstep, voffB); PG8_STAGE(PG8_SA(1, 0), cA + kstep, voffA); PG8_STAGE(PG8_SB(1, 1), cB + hstep + kstep, voffB);
        PG8_WAIT_V(6); PG8_BAR;
    }
    for (;;) {
        const bool has_next = S.next(ui + 1, nxt);
        const char* nA = has_next ? (const char*)g.A + (size_t)nxt.pm * tstep : cA; const char* nB = has_next ? (const char*)g.Bt + (size_t)nxt.pn * tstep : cB;
        for (int t = 0; t < nt; t += 2) {
            const bool last = (t == nt - 2);
            const char* a1 = cA + (size_t)(t + 1) * kstep;
            const char* a2 = last ? nA : cA + (size_t)(t + 2) * kstep; const char* b2 = last ? nB : cB + (size_t)(t + 2) * kstep;
            const char* a3 = a2 + kstep; const char* b3 = b2 + kstep;
            if (last && has_next) S.a_ready(nxt);
            if constexpr (SP2) {
            PG8_LDB(B0, 0, 0); PG8_LDB(B1, 0, 1); PG8_SCHED; PG8_LDA(At, 0, 0); PG8_STAGE(PG8_SA(1, 1), a1 + hstep, voffA);
            PG8_WAIT_V(8); PG8_WAIT_L(0); PG8_BAR; PG8_MMA(0, 0, At, B0); PG8_MMA(0, 1, At, B1); PG8_BAR; PG8_SCHED;
            PG8_LDA(At, 0, 1); PG8_STAGE(PG8_SB(0, 0), b2, voffB); PG8_STAGE(PG8_SB(0, 1), b2 + hstep, voffB); PG8_STAGE(PG8_SA(0, 0), a2, voffA);
            PG8_WAIT_V(8); PG8_WAIT_L(0); PG8_BAR; PG8_MMA(1, 0, At, B0); PG8_MMA(1, 1, At, B1); PG8_BAR; PG8_SCHED;
            PG8_LDB(B0, 1, 0); PG8_LDB(B1, 1, 1); PG8_SCHED; PG8_LDA(At, 1, 0); PG8_STAGE(PG8_SA(0, 1), a2 + hstep, voffA);
            PG8_WAIT_V(8); PG8_WAIT_L(0); PG8_BAR; PG8_MMA(0, 0, At, B0); PG8_MMA(0, 1, At, B1); PG8_BAR; PG8_SCHED;
            PG8_LDA(At, 1, 1); PG8_STAGE(PG8_SB(1, 0), b3, voffB); PG8_STAGE(PG8_SB(1, 1), b3 + hstep, voffB); PG8_STAGE(PG8_SA(1, 0), a3, voffA);
            PG8_WAIT_V(8); PG8_WAIT_L(0); PG8_BAR; PG8_MMA(1, 0, At, B0); PG8_MMA(1, 1, At, B1); PG8_BAR; PG8_SCHED;
            } else {
            PG8_LDB(B0, 0, 0); PG8_SCHED; PG8_LDA(At, 0, 0); PG8_STAGE(PG8_SA(1, 1), a1 + hstep, voffA);
            PG8_WAIT_L(8); PG8_BAR; PG8_WAIT_L(0); PG8_MMA(0, 0, At, B0); PG8_BAR; PG8_SCHED;
            PG8_LDB(B1, 0, 1); PG8_STAGE(PG8_SB(0, 0), b2, voffB);
            PG8_BAR; PG8_WAIT_L(0); PG8_MMA(0, 1, At, B1); PG8_BAR;
            PG8_LDA(At, 0, 1); PG8_STAGE(PG8_SA(0, 0), a2, voffA);
            PG8_BAR; PG8_WAIT_L(0); PG8_MMA(1, 0, At, B0); PG8_BAR; PG8_SCHED;
            PG8_STAGE(PG8_SB(0, 1), b2 + hstep, voffB);
            PG8_WAIT_V(6); PG8_BAR; PG8_MMA(1, 1, At, B1); PG8_BAR;
            PG8_LDB(B0, 1, 0); PG8_SCHED; PG8_LDA(At, 1, 0); PG8_STAGE(PG8_SA(0, 1), a2 + hstep, voffA);
            PG8_WAIT_L(8); PG8_BAR; PG8_WAIT_L(0); PG8_MMA(0, 0, At, B0); PG8_BAR; PG8_SCHED;
            PG8_LDB(B1, 1, 1); PG8_STAGE(PG8_SB(1, 0), b3, voffB);
            PG8_BAR; PG8_WAIT_L(0); PG8_MMA(0, 1, At, B1); PG8_BAR;
            PG8_LDA(At, 1, 1); PG8_STAGE(PG8_SA(1, 0), a3, voffA);
            PG8_BAR; PG8_WAIT_L(0); PG8_MMA(1, 0, At, B0); PG8_BAR; PG8_SCHED;
            PG8_STAGE(PG8_SB(1, 1), b3 + hstep, voffB);
            PG8_WAIT_V(6); PG8_BAR; PG8_MMA(1, 1, At, B1); PG8_BAR;
            }
        }
        if constexpr (ALIGN_EPI) { if (wr == 0) PG8_BAR; }
        if constexpr (!Epi::AFTER_DRAIN) { E(acc, cur, wr, wc, fr, fq); S.done(cur); }
        if (!has_next) break;
#pragma unroll
        for (int a = 0; a < 2; ++a)
#pragma unroll
            for (int b = 0; b < 2; ++b)
#pragma unroll
                for (int m = 0; m < 4; ++m)
#pragma unroll
                    for (int n = 0; n < 2; ++n) acc[a][b][m][n] = (f32x4){0.f, 0.f, 0.f, 0.f};
        cur = nxt; cA = nA; cB = nB; ++ui;
        if constexpr (ALIGN_EPI) { if (wr == 1) PG8_BAR; }
    }
    PG8_WAIT_V(0);
    if constexpr (!ALIGN_EPI) { if (wr == 0) PG8_BAR; }
    PG8_BAR;
    if constexpr (Epi::AFTER_DRAIN) { E.fused(acc, cur, wr, wc, fr, fq, lds, wid, lane); S.done(cur); }
#undef PG8_SA
#undef PG8_SB
#undef PG8_STAGE
#undef PG8_LDA
#undef PG8_LDB
#undef PG8_MMA
#undef PG8_WAIT_V
#undef PG8_WAIT_L
#undef PG8_BAR
#undef PG8_SCHED
}
}
namespace pg8 {
struct EpiF32 {
    static constexpr bool PERM = false, AFTER_DRAIN = false;
    float* O; int ldc;
    __device__ __forceinline__ void operator()(const f32x4 (&acc)[2][2][4][2], const Unit& u, int wr, int wc, int fr, int fq) const {
        { int ln_ = LANEID(); asm volatile("" : "+v"(ln_)); fr = ln_ & 15; fq = ln_ >> 4; }
        const int row0 = u.pm * BM + wr * 64 + fr, col0 = u.pn * BM + wc * 32 + 4 * fq;
#pragma unroll
        for (int ai = 0; ai < 2; ++ai)
#pragma unroll
            for (int m = 0; m < 4; ++m) { float* rowp = O + (size_t)(row0 + ai * HALF + m * 16) * ldc + col0;
#pragma unroll
                for (int bj = 0; bj < 2; ++bj)
#pragma unroll
                    for (int n = 0; n < 2; ++n) *(f32x4*)(rowp + bj * HALF + n * 16) = acc[ai][bj][m][n]; }
    }
};
struct EpiResY {
    static constexpr bool PERM = false, AFTER_DRAIN = false;
    const float* hin; const bf16_t* hinb; bf16_t* yb; float* stats; float alpha;
    __device__ __forceinline__ void operator()(const f32x4 (&acc)[2][2][4][2], const Unit& u, int wr, int wc, int fr, int fq) const {
        { int ln_ = LANEID(); asm volatile("" : "+v"(ln_)); fr = ln_ & 15; fq = ln_ >> 4; }
        const int row0 = u.pm * BM + wr * 64 + fr, col0 = u.pn * BM + wc * 32 + 4 * fq;
#pragma unroll
        for (int ai = 0; ai < 2; ++ai)
#pragma unroll
            for (int m = 0; m < 4; ++m) {
                const int row = row0 + ai * HALF + m * 16;
                float s = 0.f, s2 = 0.f;
#pragma unroll
                for (int bj = 0; bj < 2; ++bj)
#pragma unroll
                    for (int n = 0; n < 2; ++n) {
                        const size_t off = (size_t)row * 1024 + col0 + bj * HALF + n * 16;
                        f32x4 hv;
                        if (hin) hv = *(const f32x4*)(hin + off);
                        else { typedef unsigned u32x2r __attribute__((ext_vector_type(2))); const u32x2r hw = *(const u32x2r*)(hinb + off);
                            hv[0] = __uint_as_float(hw.x << 16); hv[1] = __uint_as_float(hw.x & 0xffff0000u); hv[2] = __uint_as_float(hw.y << 16); hv[3] = __uint_as_float(hw.y & 0xffff0000u); }
                        const f32x4 y = hv * alpha + acc[ai][bj][m][n];
                        typedef unsigned u32x2v __attribute__((ext_vector_type(2)));
                        u32x2v w; w.x = cvt_pk_bf16(y[0], y[1]); w.y = cvt_pk_bf16(y[2], y[3]);
                        *(u32x2v*)(yb + off) = w;
                        s += (y[0] + y[1]) + (y[2] + y[3]); s2 += (y[0] * y[0] + y[1] * y[1]) + (y[2] * y[2] + y[3] * y[3]);
                    }
                s += __shfl_xor(s, 16); s += __shfl_xor(s, 32); s2 += __shfl_xor(s2, 16); s2 += __shfl_xor(s2, 32);
                if (fq == 0) { atomicAdd(stats + 2 * (size_t)row, s); atomicAdd(stats + 2 * (size_t)row + 1, s2); }
            }
    }
};
struct EpiLnFold {
    static constexpr bool PERM = true, AFTER_DRAIN = false;
    bf16_t* O; const float* stats; const float* colsum; const float* colbias; float eps;
    __device__ __forceinline__ void operator()(const f32x4 (&acc)[2][2][4][2], const Unit& u, int wr, int wc, int fr, int fq) const {
        { int ln_ = LANEID(); asm volatile("" : "+v"(ln_)); fr = ln_ & 15; fq = ln_ >> 4; }
        const int row0 = u.pm * BM + wr * 64 + fr, col0 = u.pn * BM + wc * 32 + 8 * fq;
        f32x4 cs[2][2], cb[2][2];
#pragma unroll
        for (int bj = 0; bj < 2; ++bj)
#pragma unroll
            for (int n = 0; n < 2; ++n) { cs[bj][n] = *(const f32x4*)(colsum + col0 + bj * HALF + 4 * n); cb[bj][n] = *(const f32x4*)(colbias + col0 + bj * HALF + 4 * n); }
#pragma unroll
        for (int ai = 0; ai < 2; ++ai)
#pragma unroll
            for (int m = 0; m < 4; ++m) {
                const int row = row0 + ai * HALF + m * 16;
                const float sm_ = stats[2 * (size_t)row], sq_ = stats[2 * (size_t)row + 1];
                const float mean = sm_ * (1.0f / 1024.0f);
                const float rstd = 1.0f / sqrtf(fmaxf(sq_ * (1.0f / 1024.0f) - mean * mean, 0.f) + eps);
                bf16_t* rowp = O + (size_t)row * 1024 + col0;
#pragma unroll
                for (int bj = 0; bj < 2; ++bj) {
                    const f32x4 v0 = (acc[ai][bj][m][0] - cs[bj][0] * mean) * rstd + cb[bj][0], v1 = (acc[ai][bj][m][1] - cs[bj][1] * mean) * rstd + cb[bj][1];
                    u32x4 w; w.x = cvt_pk_bf16(v0[0], v0[1]); w.y = cvt_pk_bf16(v0[2], v0[3]); w.z = cvt_pk_bf16(v1[0], v1[1]); w.w = cvt_pk_bf16(v1[2], v1[3]);
                    *(u32x4*)(rowp + bj * HALF) = w;
                }
            }
    }
};
__device__ __forceinline__ unsigned cvt_pk_bf16_t(float lo, float hi) { unsigned r; asm volatile("s_nop 0\n\tv_cvt_pk_bf16_f32 %0, %1, %2" : "=v"(r) : "v"(lo), "v"(hi)); return r; }
struct EpiBf16Sig {
    static constexpr bool PERM = true, AFTER_DRAIN = false;
    bf16_t* O; int ldc; int sig_col0; unsigned char* G8;
    __device__ __forceinline__ void operator()(const f32x4 (&acc)[2][2][4][2], const Unit& u, int wr, int wc, int fr, int fq) const {
        { int ln_ = LANEID(); asm volatile("" : "+v"(ln_)); fr = ln_ & 15; fq = ln_ >> 4; }
        const int row0 = u.pm * BM + wr * 64 + fr; const int col0 = u.pn * BM + wc * 32 + 8 * fq;
#pragma unroll
        for (int bj = 0; bj < 2; ++bj) {
            if (col0 + bj * HALF >= sig_col0) {
                { const int gc = col0 + bj * HALF - sig_col0;
                  if (gc < 4096) {
#pragma unroll
                    for (int ai = 0; ai < 2; ++ai)
#pragma unroll
                        for (int m = 0; m < 4; ++m) {
                            f32x4 v0 = acc[ai][bj][m][0], v1 = acc[ai][bj][m][1];
#pragma unroll
                            for (int e = 0; e < 4; ++e) { v0[e] = __builtin_amdgcn_rcpf(1.f + __builtin_amdgcn_exp2f(-1.44269504f * v0[e])); v1[e] = __builtin_amdgcn_rcpf(1.f + __builtin_amdgcn_exp2f(-1.44269504f * v1[e])); }
                            int w0 = __builtin_amdgcn_cvt_pk_fp8_f32(v0[0], v0[1], 0, false); w0 = __builtin_amdgcn_cvt_pk_fp8_f32(v0[2], v0[3], w0, true);
                            int w1 = __builtin_amdgcn_cvt_pk_fp8_f32(v1[0], v1[1], 0, false); w1 = __builtin_amdgcn_cvt_pk_fp8_f32(v1[2], v1[3], w1, true);
                            typedef int i32x2v __attribute__((ext_vector_type(2)));
                            i32x2v w; w.x = w0; w.y = w1;
                            *(i32x2v*)(G8 + (size_t)(row0 + ai * HALF + m * 16) * 4096 + gc) = w; }
                  } }
            } else {
#pragma unroll
                for (int ai = 0; ai < 2; ++ai)
#pragma unroll
                    for (int m = 0; m < 4; ++m) { bf16_t* rowp = O + (size_t)(row0 + ai * HALF + m * 16) * ldc + col0;
                        const f32x4 v0 = acc[ai][bj][m][0], v1 = acc[ai][bj][m][1];
                        u32x4 w; w.x = cvt_pk_bf16(v0[0], v0[1]); w.y = cvt_pk_bf16(v0[2], v0[3]); w.z = cvt_pk_bf16(v1[0], v1[1]); w.w = cvt_pk_bf16(v1[2], v1[3]);
                        *(u32x4*)(rowp + bj * HALF) = w; }
            }
        }
    }
};
}

typedef unsigned short bf16;
constexpr int T_ = 16384, S_ = 4096, NBATCH = 4, D_ = 1024, NCOL = 6824, NP = 6912, DEPTH_ = 2;
constexpr int C_QA = 0, C_KA = 256, C_VA = 320, C_QI = 384, C_KI = 640, C_WI = 672, C_QB = 680, C_KB = 936, C_VB = 1064,
              C_QC = 1192, C_KC = 1448, C_VC = 1704, C_QD = 1960, C_KD = 2216, C_VD = 2472, C_G = 2728;
constexpr int NTHR = 512, NWAVE = 8;
constexpr float ALPHA = 1.41421356237309515f;
constexpr float LN_EPS = 1e-5f;
constexpr size_t MiB = 1u << 20;
constexpr size_t WS_STATS = 1 * MiB  , WS_COLS = 1 * MiB + 512 * 1024  ;
constexpr size_t WS_CTL = 0, WS_WIN_T = 2 * MiB, WS_WOUT_T = 30 * MiB, WS_WQ_T = 34 * MiB, WS_WBR_T = 38 * MiB, WS_HB = 42 * MiB,
                 WS_P = 74 * MiB, WS_MIX = 74 * MiB  , WS_Q = 138 * MiB  , WS_G8 = 428 * MiB  , WS_YS = 290 * MiB, WS_MRG = 322 * MiB,
                 WS_MASK = 354 * MiB, WS_EID = 362 * MiB, WS_GATE = 370 * MiB, WS_KMEAN = 378 * MiB, WS_SKB = 379 * MiB, WS_UV = 380 * MiB, WS_END = 508 * MiB;
constexpr size_t WIN_T_BYTES = (size_t)NP * 1024 * 2;
constexpr int LDS_BYTES = 144 * 1024;

struct Params { const float* in[13]; float* out; unsigned char* ws; };

__device__ __forceinline__ float bf2f(bf16 v) { return __uint_as_float((unsigned)v << 16); }
__device__ __forceinline__ unsigned f2bf(float f) { unsigned u = __float_as_uint(f); return (u + 0x7fffu + ((u >> 16) & 1u)) >> 16; }
__device__ __forceinline__ unsigned pk2(float lo, float hi) { return f2bf(lo) | (f2bf(hi) << 16); }
__device__ __forceinline__ void unpack8(const uint4 v, float* o) {
    o[0] = __uint_as_float(v.x << 16); o[1] = __uint_as_float(v.x & 0xffff0000u); o[2] = __uint_as_float(v.y << 16); o[3] = __uint_as_float(v.y & 0xffff0000u);
    o[4] = __uint_as_float(v.z << 16); o[5] = __uint_as_float(v.z & 0xffff0000u); o[6] = __uint_as_float(v.w << 16); o[7] = __uint_as_float(v.w & 0xffff0000u);
}
__device__ __forceinline__ float wave_sum(float v) {
#pragma unroll
    for (int o = 32; o > 0; o >>= 1) v += __shfl_xor(v, o);
    return v;
}
__device__ __forceinline__ float wave_max(float v) {
#pragma unroll
    for (int o = 32; o > 0; o >>= 1) v = fmaxf(v, __shfl_xor(v, o));
    return v;
}
__device__ __forceinline__ int wave_sum_i(int v) {
#pragma unroll
    for (int o = 32; o > 0; o >>= 1) v += __shfl_xor(v, o);
    return v;
}
__device__ __forceinline__ float logsig(float x) { return fminf(x, 0.f) - log1pf(expf(-fabsf(x))); }

__device__ void transpose_items(int WV_, const float* W, int K, int N, bf16* WT, float* sm, int item0, int nitems_total, int item_stride,
                                const float* rs_g = nullptr, const float* rs_b = nullptr, float* colsum = nullptr, float* colbias = nullptr) {
    const int tid = LTID(WV_);
    const int nkb = K / 64, nnb = (N + 63) / 64;
    for (int it = item0; it < nkb * nnb; it += item_stride) {
        const int kb = it % nkb, nb = it / nkb, k0 = kb * 64, n0 = nb * 64;
        __syncthreads();
        for (int e = tid; e < 64 * 64; e += NTHR) { const int kk = e >> 6, nn = e & 63; sm[kk * 65 + nn] = (n0 + nn < N) ? W[(size_t)(k0 + kk) * N + n0 + nn] : 0.f; }
        __syncthreads();
        if (rs_g) {
            if (tid < 64) { float cs = 0.f, cb = 0.f;
                for (int kk = 0; kk < 64; ++kk) { const float w = sm[kk * 65 + tid]; cs += w * rs_g[k0 + kk]; cb += w * rs_b[k0 + kk]; }
                atomicAdd(colsum + n0 + tid, cs); atomicAdd(colbias + n0 + tid, cb); }
            __syncthreads();
            for (int e = tid; e < 64 * 64; e += NTHR) { const int kk = e >> 6, nn = e & 63; sm[kk * 65 + nn] *= rs_g[k0 + kk]; }
            __syncthreads();
        }
        { const int nn = tid >> 3, c = tid & 7;
          if (n0 + nn < N) { uint4 o; o.x = pk2(sm[(8 * c + 0) * 65 + nn], sm[(8 * c + 1) * 65 + nn]); o.y = pk2(sm[(8 * c + 2) * 65 + nn], sm[(8 * c + 3) * 65 + nn]);
              o.z = pk2(sm[(8 * c + 4) * 65 + nn], sm[(8 * c + 5) * 65 + nn]); o.w = pk2(sm[(8 * c + 6) * 65 + nn], sm[(8 * c + 7) * 65 + nn]);
              *(uint4*)(WT + (size_t)(n0 + nn) * K + k0 + 8 * c) = o; } }
    }
    __syncthreads();
}
constexpr int TI_WIN = 16 * ((NCOL + 63) / 64), TI_SQ = 256, TI_LAYER = TI_WIN + 3 * TI_SQ;
#define TITEM_DECODE(it_, W_, WT_, K_, N_, k0_, n0_, fold_, l_) do { \
        l_ = (it_) / TI_LAYER; const int r_ = (it_) - l_ * TI_LAYER; \
        const int kind_ = r_ < TI_WIN ? 0 : (r_ < TI_WIN + TI_SQ ? 1 : (r_ < TI_WIN + 2 * TI_SQ ? 2 : 3)); \
        const int q_ = r_ - (kind_ == 0 ? 0 : TI_WIN + (kind_ - 1) * TI_SQ); \
        fold_ = kind_ == 2; K_ = kind_ == 3 ? 256 : 1024; N_ = kind_ == 0 ? NCOL : 1024; \
        k0_ = kind_ == 3 ? (q_ & 3) * 64 : (q_ & 15) * 64; n0_ = kind_ == 3 ? ((q_ & 63) >> 2) * 64 : (q_ >> 4) * 64; \
        const int nbr_ = q_ >> 6; \
        W_ = kind_ == 0 ? pin1 + (size_t)l_ * 1024 * NCOL : kind_ == 1 ? pin3 + (size_t)l_ * 1024 * 1024 : kind_ == 2 ? pin7 + (size_t)l_ * 1024 * 1024 : pin2 + ((size_t)l_ * 4 + nbr_) * 256 * 1024; \
        WT_ = kind_ == 0 ? (bf16*)(ws + WS_WIN_T + l_ * WIN_T_BYTES) : kind_ == 1 ? (bf16*)(ws + WS_WOUT_T) + (size_t)l_ * 1024 * 1024 : kind_ == 2 ? (bf16*)(ws + WS_WQ_T) + (size_t)l_ * 1024 * 1024 \
              : (bf16*)(ws + WS_WBR_T) + ((size_t)l_ * 4 + nbr_) * 1024 * 256; } while (0)
__device__ __forceinline__ void titem_finish(bf16* WT, int K, int N, int k0, int n0, const float* rs_g, const float* rs_b, float* colsum, float* colbias, float* sm, int tid) {
    if (rs_g) {
        if (tid < 64) { float cs = 0.f, cb = 0.f;
            for (int kk = 0; kk < 64; ++kk) { const float w = sm[kk * 65 + tid]; cs += w * rs_g[k0 + kk]; cb += w * rs_b[k0 + kk]; }
            atomicAdd(colsum + n0 + tid, cs); atomicAdd(colbias + n0 + tid, cb); }
        __syncthreads();
        for (int e = tid; e < 64 * 64; e += NTHR) { const int kk = e >> 6, nn = e & 63; sm[kk * 65 + nn] *= rs_g[k0 + kk]; }
        __syncthreads();
    }
    { const int nn = tid >> 3, c = tid & 7;
      if (n0 + nn < N) { uint4 o; o.x = pk2(sm[(8 * c + 0) * 65 + nn], sm[(8 * c + 1) * 65 + nn]); o.y = pk2(sm[(8 * c + 2) * 65 + nn], sm[(8 * c + 3) * 65 + nn]);
          o.z = pk2(sm[(8 * c + 4) * 65 + nn], sm[(8 * c + 5) * 65 + nn]); o.w = pk2(sm[(8 * c + 6) * 65 + nn], sm[(8 * c + 7) * 65 + nn]);
          *(uint4*)(WT + (size_t)(n0 + nn) * K + k0 + 8 * c) = o; } }
}
__device__ void prologue_phase(int WV_, const Params& p, float* sm) {
    const int tid = LTID(WV_), B = LBID(), G = LGRID();
    unsigned char* ws = p.ws;
    float* sm1 = sm + 64 * 65;
    const float* pin1 = p.in[1]; const float* pin2 = p.in[2]; const float* pin3 = p.in[3]; const float* pin7 = p.in[7]; const float* pin5 = p.in[5]; const float* pin6 = p.in[6];
    asm volatile("" : "+s"(pin1), "+s"(pin2), "+s"(pin3), "+s"(pin7), "+s"(pin5), "+s"(pin6));
    const int kk0 = tid >> 4, c4 = tid & 15;
    for (int it = B; it < DEPTH_ * TI_LAYER; it += 2 * G) {
        const int it2 = it + G; const bool has2 = it2 < DEPTH_ * TI_LAYER;
        const float* Wa; const float* Wb; bf16* WTa; bf16* WTb; int Ka, Na, k0a, n0a, la, Kb, Nb, k0b, n0b, lb; bool fa, fb;
        TITEM_DECODE(it, Wa, WTa, Ka, Na, k0a, n0a, fa, la);
        { const int itb = has2 ? it2 : it; TITEM_DECODE(itb, Wb, WTb, Kb, Nb, k0b, n0b, fb, lb); }
        const float4 z4 = make_float4(0.f, 0.f, 0.f, 0.f);
        const bool ina = n0a + 4 * c4 < Na, inb = n0b + 4 * c4 < Nb;
        float4 a0 = z4, a1 = z4, b0 = z4, b1 = z4;
        if (ina) { a0 = *(const float4*)(Wa + (size_t)(k0a + kk0) * Na + n0a + 4 * c4); a1 = *(const float4*)(Wa + (size_t)(k0a + kk0 + 32) * Na + n0a + 4 * c4); }
        if (inb) { b0 = *(const float4*)(Wb + (size_t)(k0b + kk0) * Nb + n0b + 4 * c4); b1 = *(const float4*)(Wb + (size_t)(k0b + kk0 + 32) * Nb + n0b + 4 * c4); }
        __syncthreads();
        { float* d = sm + kk0 * 65 + 4 * c4; d[0] = a0.x; d[1] = a0.y; d[2] = a0.z; d[3] = a0.w; d += 32 * 65; d[0] = a1.x; d[1] = a1.y; d[2] = a1.z; d[3] = a1.w; }
        { float* d = sm1 + kk0 * 65 + 4 * c4; d[0] = b0.x; d[1] = b0.y; d[2] = b0.z; d[3] = b0.w; d += 32 * 65; d[0] = b1.x; d[1] = b1.y; d[2] = b1.z; d[3] = b1.w; }
        __syncthreads();
        titem_finish(WTa, Ka, Na, k0a, n0a, fa ? pin5 + la * 1024 : nullptr, pin6 + la * 1024, (float*)(ws + WS_COLS) + la * 2048, (float*)(ws + WS_COLS) + la * 2048 + 1024, sm, tid);
        if (has2) titem_finish(WTb, Kb, Nb, k0b, n0b, fb ? pin5 + lb * 1024 : nullptr, pin6 + lb * 1024, (float*)(ws + WS_COLS) + lb * 2048, (float*)(ws + WS_COLS) + lb * 2048 + 1024, sm1, tid);
    }
    __syncthreads();
    for (int l = 0; l < DEPTH_; ++l) {
        bf16* win_t = (bf16*)(ws + WS_WIN_T + l * WIN_T_BYTES);
        for (int i = B * NTHR + tid; i < (NP - NCOL) * 1024 / 8; i += G * NTHR) ((uint4*)(win_t + (size_t)NCOL * 1024))[i] = make_uint4(0u, 0u, 0u, 0u);
    }
    const float4* x4 = (const float4*)p.in[0]; uint2* hb2 = (uint2*)(ws + WS_HB);
    for (size_t i = (size_t)B * NTHR + tid; i < (size_t)T_ * 1024 / 4; i += (size_t)G * NTHR) { const float4 v = x4[i]; hb2[i] = make_uint2(pk2(v.x, v.y), pk2(v.z, v.w)); }
}

__device__ __forceinline__ void ln_row(float4 (&v)[4], const float* g, const float* bb, float* orow, bf16* obrow, int lane) {
    float s = 0.f;
#pragma unroll
    for (int j = 0; j < 4; ++j) s += (v[j].x + v[j].y) + (v[j].z + v[j].w);
    const float mean = wave_sum(s) * (1.0f / 1024.0f);
    float s2 = 0.f;
#pragma unroll
    for (int j = 0; j < 4; ++j) { v[j].x -= mean; v[j].y -= mean; v[j].z -= mean; v[j].w -= mean; s2 += (v[j].x * v[j].x + v[j].y * v[j].y) + (v[j].z * v[j].z + v[j].w * v[j].w); }
    const float rstd = 1.0f / sqrtf(wave_sum(s2) * (1.0f / 1024.0f) + LN_EPS);
#pragma unroll
    for (int j = 0; j < 4; ++j) {
        const float4 gg = ((const float4*)g)[j * 64 + lane], b4 = ((const float4*)bb)[j * 64 + lane];
        float4 o; o.x = v[j].x * rstd * gg.x + b4.x; o.y = v[j].y * rstd * gg.y + b4.y; o.z = v[j].z * rstd * gg.z + b4.z; o.w = v[j].w * rstd * gg.w + b4.w;
        ((float4*)orow)[j * 64 + lane] = o;
        ((uint2*)obrow)[j * 64 + lane] = make_uint2(pk2(o.x, o.y), pk2(o.z, o.w));
    }
}
__device__ void ln1_phase(int WV_, const float* hin, const float* add, const float* g, const float* bb, float* hout, bf16* hb) {
    const int lane = LTID(WV_) & 63, wave = LTID(WV_) >> 6;
    for (int row = LBID() * NWAVE + wave; row < T_; row += LGRID() * NWAVE) {
        float4 v[4];
#pragma unroll
        for (int j = 0; j < 4; ++j) {
            const float4 a = ((const float4*)(hin + (size_t)row * 1024))[j * 64 + lane], m = ((const float4*)(add + (size_t)row * 1024))[j * 64 + lane];
            v[j].x = ALPHA * a.x + m.x; v[j].y = ALPHA * a.y + m.y; v[j].z = ALPHA * a.z + m.z; v[j].w = ALPHA * a.w + m.w;
        }
        ln_row(v, g, bb, hout + (size_t)row * 1024, hb + (size_t)row * 1024, lane);
    }
}


typedef short bf16x8_t __attribute__((ext_vector_type(8)));
typedef float f32x16_t __attribute__((ext_vector_type(16)));
typedef float f32x2_t __attribute__((ext_vector_type(2)));
typedef __bf16 bf16x2_t __attribute__((ext_vector_type(2)));
__device__ __forceinline__ unsigned cvtpk(float lo, float hi) { f32x2_t v = {lo, hi}; bf16x2_t b = __builtin_convertvector(v, bf16x2_t); return __builtin_bit_cast(unsigned, b); }
__device__ __forceinline__ int crow(int r, int hi) { return (r & 3) + 8 * (r >> 2) + 4 * hi; }
__device__ __forceinline__ float xlane32(float v) { return __shfl_xor(v, 32); }
__device__ __forceinline__ float vmax(float a, float b) { float r; asm("v_max_f32_e32 %0, %1, %2" : "=v"(r) : "v"(a), "v"(b)); return r; }
__device__ __forceinline__ float vmin(float a, float b) { float r; asm("v_min_f32_e32 %0, %1, %2" : "=v"(r) : "v"(a), "v"(b)); return r; }
__device__ __forceinline__ float vmax3(float a, float b, float c) { float r; asm("v_max3_f32 %0, %1, %2, %3" : "=v"(r) : "v"(a), "v"(b), "v"(c)); return r; }

constexpr int AT_KP = 72, AT_VP = 96;
constexpr int AT_KS = 0, AT_KS_BYTES = 64 * AT_KP * 2;
constexpr int AT_VT = 2 * AT_KS_BYTES, AT_VT_BYTES = 64 * AT_VP * 2;
constexpr int AT_KM = AT_VT + 2 * AT_VT_BYTES;
constexpr int AT_MISC = AT_KM + 32 * AT_KP * 2;
constexpr float LOG2E = 1.4426950408889634f;

__device__ __forceinline__ unsigned mk_unit(int kind, int b, int x, int y) { return ((unsigned)kind << 30) | ((unsigned)b << 28) | ((unsigned)x << 8) | (unsigned)y; }
__device__ void build_unit_table(unsigned* tab, int i) {
    int n = 0; unsigned res = 0u;
#pragma unroll 1
    for (int c = 64; c >= 1; --c) {
        if (i >= n && i < n + 4) res = mk_unit(0, i - n, 0, c - 1);
        n += 4;
        if ((c & 3) == 0) { if (i >= n && i < n + 16) { const int j = i - n; res = mk_unit(2, j >> 2, j & 3, c / 4 - 1); } n += 16; }
    }
    if (i < 512) tab[i] = res;
}

template <int kind> __device__ __forceinline__ void attn_unit(int WV_, const bf16* P, const unsigned char* mask, const float* kmean, const float* sinks, bf16* ys,
                                unsigned char* lds, int b, int ux, int uy) {
    int tid_ = LTID(WV_); asm volatile("" : "+v"(tid_));
    const int tid = tid_, lane = tid & 63, wave = __builtin_amdgcn_readfirstlane(tid >> 6), r32 = lane & 31, hi = lane >> 5;
    bf16* s_km = (bf16*)(lds + AT_KM);
    const int skey = tid >> 3, sc = tid & 7;
    {
        const bf16* Pb = P + (size_t)b * S_ * NP;
        int q0w, qcol, kcol, vcol, ycol, kt_hi, kt_lo; float slope2 = 0.f, sink2 = 0.f;
        if (kind == 0) { const int head = wave >> 1; q0w = uy * 64 + (wave & 1) * 32; qcol = C_QA + head * 64; kcol = C_KA; vcol = C_VA; ycol = head * 64;
            slope2 = exp2f(-8.0f * (float)(3 * head + 1) / 12.0f) * LOG2E; kt_hi = uy; kt_lo = 0; }
        else if (kind == 1) { const int hq = ux * 2 + (wave >> 2); q0w = uy * 128 + (wave & 3) * 32; qcol = C_QB + hq * 64; kcol = C_KB + ux * 64; vcol = C_VB + ux * 64; ycol = 256 + hq * 64;
            slope2 = exp2f(-8.0f * (float)(3 * hq + 2) / 12.0f) * LOG2E; sink2 = sinks[hq] * LOG2E; kt_hi = 2 * uy + 1; kt_lo = (2 * uy - 2 > 0) ? 2 * uy - 2 : 0; }
        else if (kind == 2) { q0w = uy * 256 + wave * 32; qcol = C_QC + ux * 64; kcol = C_KC + ux * 64; vcol = C_VC + ux * 64; ycol = 512 + ux * 64;
            slope2 = exp2f(-8.0f * (float)(3 * ux + 3) / 12.0f) * LOG2E; kt_hi = 4 * uy + 3; kt_lo = 0; }
        else { q0w = uy * 256 + wave * 32; qcol = C_QD + ux * 64; kcol = C_KD + ux * 64; vcol = C_VD + ux * 64; ycol = 768 + ux * 64; kt_hi = 4 * uy + 3; kt_lo = 0; }
        const int qpos = q0w + r32;
        bf16x8_t qf[4];
        { const bf16* qp = Pb + (size_t)qpos * NP + qcol + 8 * hi;
#pragma unroll
          for (int ks = 0; ks < 4; ++ks) qf[ks] = *(const bf16x8_t*)(qp + 16 * ks); }
        {
            const float qs = (kind == 3) ? 0.125f : 0.125f * LOG2E;
            typedef unsigned u32x4_t __attribute__((ext_vector_type(4)));
#pragma unroll
            for (int ks = 0; ks < 4; ++ks) { u32x4_t w = __builtin_bit_cast(u32x4_t, qf[ks]);
#pragma unroll
                for (int i = 0; i < 4; ++i) w[i] = cvtpk(__uint_as_float(w[i] << 16) * qs, __uint_as_float(w[i] & 0xffff0000u) * qs);
                qf[ks] = __builtin_bit_cast(bf16x8_t, w); }
        }
        float sb[16];
#pragma unroll
        for (int r = 0; r < 16; ++r) sb[r] = slope2 * (float)((r & 3) + 8 * (r >> 2));
        unsigned bm = 0u;
        if (kind == 2) {
            const int own = uy;
            for (int e = tid; e < 32 * 64; e += NTHR) { const int row = e >> 6, d = e & 63; s_km[row * AT_KP + d] = (row < 16) ? (bf16)f2bf(kmean[((b * 4 + ux) * 16 + row) * 64 + d]) : (bf16)0; }
            __syncthreads();
            f32x16_t gacc;
#pragma unroll
            for (int r = 0; r < 16; ++r) gacc[r] = 0.f;
#pragma unroll
            for (int ks = 0; ks < 4; ++ks) { const bf16x8_t a = *(const bf16x8_t*)(s_km + r32 * AT_KP + 16 * ks + 8 * hi); gacc = __builtin_amdgcn_mfma_f32_32x32x16_bf16(a, qf[ks], gacc, 0, 0, 0); }
            float gt[16];
#pragma unroll
            for (int r = 0; r < 8; ++r) { const float mine = gacc[r], other = xlane32(mine); const int bi = crow(r, 0);
                gt[bi] = hi ? other : mine; gt[bi + 4] = hi ? mine : other; }
#pragma unroll
            for (int n = 0; n < 16; ++n) if (n >= own) gt[n] = -INFINITY;
#pragma unroll
            for (int rep = 0; rep < 3; ++rep) {
                float mx = -INFINITY;
#pragma unroll
                for (int n = 0; n < 16; ++n) mx = fmaxf(mx, gt[n]);
                bool done = !(mx > -INFINITY);
#pragma unroll
                for (int n = 0; n < 16; ++n) { const bool hit = !done && gt[n] == mx; if (hit) { bm |= 1u << n; gt[n] = -INFINITY; done = true; } }
            }
        }
        f32x16_t o0, o1;
#pragma unroll
        for (int r = 0; r < 16; ++r) { o0[r] = 0.f; o1[r] = 0.f; }
        float m_run = -INFINITY, l_run = 0.f, carry = 0.f;
        const bf16* kg = Pb + (size_t)skey * NP + kcol + sc * 8;
        const bf16* vg = Pb + (size_t)skey * NP + vcol + sc * 8;
        uint4 rk = *(const uint4*)(kg + (size_t)kt_hi * 64 * NP), rv = *(const uint4*)(vg + (size_t)kt_hi * 64 * NP);
        int buf = 0;
        { bf16* ks_ = (bf16*)(lds + AT_KS); bf16* vt_ = (bf16*)(lds + AT_VT);
          *(uint4*)(ks_ + skey * AT_KP + sc * 8) = rk;
          *(uint4*)(vt_ + skey * AT_VP + sc * 8) = rv; }
        __syncthreads();
        bool wave_done = false;
        uint2 mw_next = make_uint2(0u, 0u);
        if (kind == 0) mw_next = *(const uint2*)(mask + (size_t)(b * S_ + qpos) * 512 + kt_hi * 8);
        for (int kt = kt_hi; kt >= kt_lo; --kt) {
            const bool more = kt > kt_lo;
            const uint2 mw = mw_next;
            if (kind == 0 && more) mw_next = *(const uint2*)(mask + (size_t)(b * S_ + qpos) * 512 + (kt - 1) * 8);
            if (more) { rk = *(const uint4*)(kg + (size_t)(kt - 1) * 64 * NP); rv = *(const uint4*)(vg + (size_t)(kt - 1) * 64 * NP); }
            const bf16* ks_ = (const bf16*)(lds + AT_KS + buf * AT_KS_BYTES);
            const bf16* vt_ = (const bf16*)(lds + AT_VT + buf * AT_VT_BYTES);
            bool active = (kt * 64 <= q0w + 31) && !wave_done;
            if (kind == 1) active = active && (kt * 64 + 63 >= q0w - 127);
            if (active) {
                const int kbase = kt * 64 + 4 * hi;
                f32x16_t p0, p1;
                if (kind != 3) {
                    const float cb = slope2 * (float)(kbase - qpos), cb1 = cb + 32.0f * slope2;
#pragma unroll
                    for (int r = 0; r < 16; ++r) { p0[r] = cb + sb[r]; p1[r] = cb1 + sb[r]; }
                } else {
#pragma unroll
                    for (int r = 0; r < 16; ++r) { p0[r] = 0.f; p1[r] = 0.f; }
                }
#pragma unroll
                for (int ks = 0; ks < 4; ++ks) {
                    const bf16x8_t a0 = *(const bf16x8_t*)(ks_ + r32 * AT_KP + 16 * ks + 8 * hi);
                    const bf16x8_t a1 = *(const bf16x8_t*)(ks_ + (32 + r32) * AT_KP + 16 * ks + 8 * hi);
                    p0 = __builtin_amdgcn_mfma_f32_32x32x16_bf16(a0, qf[ks], p0, 0, 0, 0);
                    p1 = __builtin_amdgcn_mfma_f32_32x32x16_bf16(a1, qf[ks], p1, 0, 0, 0);
                }
                if (kind != 3) {
                    float mx = -INFINITY;
                    if (kind == 0) {
                        const unsigned w0 = mw.x >> (4 * hi), w1 = mw.y >> (4 * hi);
#pragma unroll
                        for (int r = 0; r < 16; ++r) { const int off = (r & 3) + 8 * (r >> 2);
                            p0[r] = (w0 & (1u << off)) ? p0[r] : -INFINITY; p1[r] = (w1 & (1u << off)) ? p1[r] : -INFINITY; mx = vmax3(mx, p0[r], p1[r]); }
                    } else if (kind == 1) {
                        const int rel = qpos - kbase;
#pragma unroll
                        for (int r = 0; r < 16; ++r) { const int off = (r & 3) + 8 * (r >> 2);
                            p0[r] = ((unsigned)(rel - off) < 128u) ? p0[r] : -INFINITY; p1[r] = ((unsigned)(rel - off - 32) < 128u) ? p1[r] : -INFINITY; mx = vmax3(mx, p0[r], p1[r]); }
                    } else {
                        if ((kt >> 2) == uy) {
                            const int rel = qpos - kbase;
#pragma unroll
                            for (int r = 0; r < 16; ++r) { const int off = (r & 3) + 8 * (r >> 2);
                                p0[r] = (off <= rel) ? p0[r] : -INFINITY; p1[r] = (off + 32 <= rel) ? p1[r] : -INFINITY; mx = vmax3(mx, p0[r], p1[r]); }
                        } else {
                            const bool tile_ok = ((bm >> (kt >> 2)) & 1u) != 0u;
#pragma unroll
                            for (int r = 0; r < 16; ++r) { p0[r] = tile_ok ? p0[r] : -INFINITY; p1[r] = tile_ok ? p1[r] : -INFINITY; mx = vmax3(mx, p0[r], p1[r]); }
                        }
                    }
                    mx = vmax(mx, xlane32(mx));
                    const float m_new = vmax(m_run, mx);
                    const float m_safe = (m_new == -INFINITY) ? 0.f : m_new;
                    p0 = p0 - m_safe; p1 = p1 - m_safe;
#pragma unroll
                    for (int r = 0; r < 16; ++r) { p0[r] = __builtin_amdgcn_exp2f(p0[r]); p1[r] = __builtin_amdgcn_exp2f(p1[r]); }
                    float ls;
                    { typedef float f32x8_t __attribute__((ext_vector_type(8))); typedef float f32x4v_t __attribute__((ext_vector_type(4)));
                      const f32x16_t t16 = p0 + p1; const f32x8_t t8 = t16.lo + t16.hi; const f32x4v_t t4 = t8.lo + t8.hi; const f32x2_t t2 = t4.lo + t4.hi; ls = t2.x + t2.y; }
                    if (__any(m_new > m_run)) {
                        const float alpha = __builtin_amdgcn_exp2f(m_run - m_safe);
                        l_run *= alpha;
                        o0 = o0 * alpha; o1 = o1 * alpha;
                    }
                    l_run += ls; m_run = m_new;
                } else {
                    float run = carry;
#define SB_HALF(PX, KOFF) do { \
                    float lk[16]; \
                    _Pragma("unroll") for (int r = 0; r < 16; ++r) { \
                        const int off = (r & 3) + 8 * (r >> 2); \
                        const bool v = (kbase + off + (KOFF)) < qpos; \
                        const float z = PX[r]; \
                        const float t = 0.6931471805599453f * __builtin_amdgcn_logf(1.0f + __builtin_amdgcn_exp2f(-LOG2E * fabsf(z))); \
                        lk[r] = v ? (fminf(-z, 0.f) - t) : 0.f; \
                        PX[r] = v ? (fminf(z, 0.f) - t) : -INFINITY; } \
                    _Pragma("unroll") for (int g = 3; g >= 0; --g) { \
                        const float G = (lk[4 * g] + lk[4 * g + 1]) + (lk[4 * g + 2] + lk[4 * g + 3]); \
                        const float PG = xlane32(G); \
                        float la = run + (hi ? 0.f : PG); \
                        run += G + PG; \
                        PX[4 * g + 3] += la; la += lk[4 * g + 3]; PX[4 * g + 2] += la; la += lk[4 * g + 2]; PX[4 * g + 1] += la; la += lk[4 * g + 1]; PX[4 * g] += la; } \
                    _Pragma("unroll") for (int r = 0; r < 16; ++r) PX[r] = __builtin_amdgcn_exp2f(LOG2E * PX[r]); } while (0)
                    SB_HALF(p1, 32);
                    SB_HALF(p0, 0);
#undef SB_HALF
                    carry = run;
                }
                unsigned pw[16];
#pragma unroll
                for (int j = 0; j < 8; ++j) { pw[j] = cvtpk(p0[2 * j], p0[2 * j + 1]); pw[8 + j] = cvtpk(p1[2 * j], p1[2 * j + 1]); }
#pragma unroll
                for (int s = 0; s < 4; ++s) {
                    bf16x8_t pb; { const unsigned* q = pw + 4 * s; typedef unsigned u32x4_t __attribute__((ext_vector_type(4))); u32x4_t t4 = {q[0], q[1], q[2], q[3]}; pb = __builtin_bit_cast(bf16x8_t, t4); }
#pragma unroll
                    for (int dt = 0; dt < 2; ++dt) {
                        typedef short s16x4_t __attribute__((ext_vector_type(4)));
                        typedef __attribute__((address_space(3))) s16x4_t lds_s16x4;
                        const int gi_ = lane & 15;
                        const bf16* vp = vt_ + (16 * s + 4 * hi + (gi_ >> 2)) * AT_VP + 32 * dt + 16 * ((lane >> 4) & 1) + 4 * (gi_ & 3);
                        const s16x4_t lo = __builtin_amdgcn_ds_read_tr16_b64_v4i16((lds_s16x4*)vp), hi4 = __builtin_amdgcn_ds_read_tr16_b64_v4i16((lds_s16x4*)(vp + 8 * AT_VP));
                        const bf16x8_t va = {lo[0], lo[1], lo[2], lo[3], hi4[0], hi4[1], hi4[2], hi4[3]};
                        if (dt == 0) o0 = __builtin_amdgcn_mfma_f32_32x32x16_bf16(va, pb, o0, 0, 0, 0);
                        else         o1 = __builtin_amdgcn_mfma_f32_32x32x16_bf16(va, pb, o1, 0, 0, 0);
                    }
                }
            }
            if (kind == 3) {
                const float cm = carry;
                if (__all(cm < -110.0f) || !(kt * 64 <= q0w + 31) ) { if (__all(cm < -110.0f)) wave_done = true; }
            }
            if (more) {
                bf16* ksn = (bf16*)(lds + AT_KS + (buf ^ 1) * AT_KS_BYTES); bf16* vtn = (bf16*)(lds + AT_VT + (buf ^ 1) * AT_VT_BYTES);
                *(uint4*)(ksn + skey * AT_KP + sc * 8) = rk;
                *(uint4*)(vtn + skey * AT_VP + sc * 8) = rv;
            }
            if (kind == 3) { if (__syncthreads_and(wave_done ? 1 : 0)) break; }
            else __syncthreads();
            buf ^= 1;
        }
        float inv;
        if (kind == 3) inv = 1.0f;
        else {
            float lt = l_run + xlane32(l_run);
            if (kind == 1) { const float mf = fmaxf(m_run, sink2); const float sc2 = exp2f(m_run - mf); lt = lt * sc2 + exp2f(sink2 - mf); inv = sc2 / lt; }
            else inv = 1.0f / lt;
        }
        bf16* yp = ys + (size_t)(b * S_ + qpos) * 1024 + ycol + 4 * hi;
#pragma unroll
        for (int g = 0; g < 4; ++g) {
            *(uint2*)(yp + 8 * g) = make_uint2(cvtpk(o0[4 * g] * inv, o0[4 * g + 1] * inv), cvtpk(o0[4 * g + 2] * inv, o0[4 * g + 3] * inv));
            *(uint2*)(yp + 32 + 8 * g) = make_uint2(cvtpk(o1[4 * g] * inv, o1[4 * g + 1] * inv), cvtpk(o1[4 * g + 2] * inv, o1[4 * g + 3] * inv));
        }
    }
}
__device__ void attn_fast_phase(int WV_, const bf16* P, const unsigned char* mask, const float* kmean, const float* sinks, bf16* ys,
                                const unsigned* utab, unsigned* counter, unsigned char* lds) {
    volatile unsigned* s_unit = (volatile unsigned*)(lds + AT_MISC);
    for (;;) {
        __syncthreads();
        if (LTID(WV_) == 0) s_unit[0] = atomicAdd(counter, 1u);
        __syncthreads();
        const unsigned ui = s_unit[0];
        if (ui >= 512u) break;
        const unsigned ue = utab[ui];
        const int kind = (int)(ue >> 30), b = (int)((ue >> 28) & 3u), ux = (int)((ue >> 8) & 255u), uy = (int)(ue & 255u);
        if (kind == 0) attn_unit<0>(WV_, P, mask, kmean, sinks, ys, lds, b, ux, uy);
        else attn_unit<2>(WV_, P, mask, kmean, sinks, ys, lds, b, ux, uy);
    }
    for (int u = LBID(); u < 256; u += LGRID()) { __syncthreads(); attn_unit<3>(WV_, P, mask, kmean, sinks, ys, lds, u >> 6, (u >> 4) & 3, u & 15); }
    for (int u = LBID(); u < 256; u += LGRID()) { __syncthreads(); attn_unit<1>(WV_, P, mask, kmean, sinks, ys, lds, u >> 6, (u >> 5) & 1, u & 31); }
}

constexpr float U_SCALE = 128.0f, V_SCALE = 48.0f;
constexpr int ROW6 = 1536;
typedef float v32f_t __attribute__((ext_vector_type(32)));
typedef unsigned v6u_t __attribute__((ext_vector_type(6)));
typedef unsigned u32x4a8_t __attribute__((ext_vector_type(4), aligned(8)));
__device__ __forceinline__ float rdlane_f(float v, int l) { return __builtin_bit_cast(float, __builtin_amdgcn_readlane(__builtin_bit_cast(int, v), l)); }
__device__ __forceinline__ unsigned q_e2m3(float v) {
    const float a = fminf(fabsf(v), 7.5f);
    unsigned code;
    if (a < 1.0f) code = (unsigned)rintf(a * 8.0f);
    else if (a < 2.0f) code = 8u + (unsigned)rintf((a - 1.0f) * 8.0f);
    else if (a < 4.0f) code = 16u + (unsigned)rintf((a - 2.0f) * 4.0f);
    else code = 24u + (unsigned)rintf((a - 4.0f) * 2.0f);
    return code | (v < 0.f ? 32u : 0u);
}
__device__ __forceinline__ void cvt_chunk6(const float4 (&a)[8], float sc, unsigned (&w)[6]) {
#pragma unroll
    for (int d = 0; d < 6; ++d) w[d] = 0u;
#pragma unroll
    for (int q4 = 0; q4 < 8; ++q4) {
        const float av[4] = {a[q4].x, a[q4].y, a[q4].z, a[q4].w};
#pragma unroll
        for (int e = 0; e < 4; ++e) { const int idx = q4 * 4 + e, bit = 6 * idx, d = bit >> 5, sft = bit & 31; const unsigned code = q_e2m3(av[e] * sc);
            w[d] |= code << sft; if (sft > 26) w[d + 1] |= code >> (32 - sft); }
    }
}
__device__ void convert_tables(int WV_, const Params& p) {
    const size_t nchunk = (size_t)DEPTH_ * 16384 * 2 * 32;
    const size_t stride = (size_t)LGRID() * NTHR;
    for (size_t i = (size_t)LBID() * NTHR + LTID(WV_); i < nchunk; i += 2 * stride) {
        const size_t i2 = i + stride; const bool has2 = i2 < nchunk; const size_t j2 = has2 ? i2 : i;
        const int c0 = (int)(i & 31), uv0 = (int)((i >> 5) & 1); const size_t le0 = i >> 6;
        const int c1 = (int)(j2 & 31), uv1 = (int)((j2 >> 5) & 1); const size_t le1 = j2 >> 6;
        const float* src0 = (uv0 ? p.in[10] : p.in[9]) + le0 * 1024 + c0 * 32;
        const float* src1 = (uv1 ? p.in[10] : p.in[9]) + le1 * 1024 + c1 * 32;
        float4 a0[8], a1[8];
#pragma unroll
        for (int q4 = 0; q4 < 8; ++q4) a0[q4] = ((const float4*)src0)[q4];
#pragma unroll
        for (int q4 = 0; q4 < 8; ++q4) a1[q4] = ((const float4*)src1)[q4];
        unsigned w0[6], w1[6];
        cvt_chunk6(a0, uv0 ? V_SCALE : U_SCALE, w0);
        cvt_chunk6(a1, uv1 ? V_SCALE : U_SCALE, w1);
        uint2* dst0 = (uint2*)(p.ws + WS_UV + le0 * ROW6 + uv0 * 768 + c0 * 24);
        dst0[0] = make_uint2(w0[0], w0[1]); dst0[1] = make_uint2(w0[2], w0[3]); dst0[2] = make_uint2(w0[4], w0[5]);
        if (has2) { uint2* dst1 = (uint2*)(p.ws + WS_UV + le1 * ROW6 + uv1 * 768 + c1 * 24);
            dst1[0] = make_uint2(w1[0], w1[1]); dst1[1] = make_uint2(w1[2], w1[3]); dst1[2] = make_uint2(w1[4], w1[5]); }
    }
}
__device__ __forceinline__ v6u_t ld_pk6(const unsigned char* ptr) {
    const uint2 a = ((const uint2*)ptr)[0], b = ((const uint2*)ptr)[1], c = ((const uint2*)ptr)[2];
    const v6u_t pk = {a.x, a.y, b.x, b.y, c.x, c.y};
    return pk;
}
__device__ void peer_fast_phase(int WV_, float* h, bf16* hb, const int* eid, const float* gate, const unsigned char* uv, const float* g1, const float* b1, const float* g, const float* bb, unsigned char* lds) {
    const int tid = LTID(WV_), lane = tid & 63, wave = tid >> 6, l32 = lane & 31, hi = lane >> 5;
    float* pl = (float*)(lds + wave * 16384);
    unsigned char* raw = lds + wave * 16384 + 4096 + lane * 24;
    for (int t = LBID() * NWAVE + wave; t < T_; t += LGRID() * NWAVE) {
        float* hr = h + (size_t)t * 1024 + l32 * 32;
        float x[32], acc[32];
#pragma unroll
        for (int q4 = 0; q4 < 4; ++q4) { const uint4 a = ((const uint4*)(hb + (size_t)t * 1024 + l32 * 32))[q4];
            x[8 * q4] = __uint_as_float(a.x << 16); x[8 * q4 + 1] = __uint_as_float(a.x & 0xffff0000u); x[8 * q4 + 2] = __uint_as_float(a.y << 16); x[8 * q4 + 3] = __uint_as_float(a.y & 0xffff0000u);
            x[8 * q4 + 4] = __uint_as_float(a.z << 16); x[8 * q4 + 5] = __uint_as_float(a.z & 0xffff0000u); x[8 * q4 + 6] = __uint_as_float(a.w << 16); x[8 * q4 + 7] = __uint_as_float(a.w & 0xffff0000u); }
        {
            float s = 0.f;
#pragma unroll
            for (int i = 0; i < 32; ++i) s += x[i];
#pragma unroll
            for (int o = 16; o > 0; o >>= 1) s += __shfl_xor(s, o);
            const float mean = s * (1.0f / 1024.0f);
            float s2 = 0.f;
#pragma unroll
            for (int i = 0; i < 32; ++i) { x[i] -= mean; s2 += x[i] * x[i]; }
#pragma unroll
            for (int o = 16; o > 0; o >>= 1) s2 += __shfl_xor(s2, o);
            const float rstd = 1.0f / sqrtf(s2 * (1.0f / 1024.0f) + LN_EPS);
#pragma unroll
            for (int q4 = 0; q4 < 8; ++q4) { const float4 gg = ((const float4*)(g1 + l32 * 32))[q4], cc = ((const float4*)(b1 + l32 * 32))[q4];
                x[4 * q4] = x[4 * q4] * rstd * gg.x + cc.x; x[4 * q4 + 1] = x[4 * q4 + 1] * rstd * gg.y + cc.y; x[4 * q4 + 2] = x[4 * q4 + 2] * rstd * gg.z + cc.z; x[4 * q4 + 3] = x[4 * q4 + 3] * rstd * gg.w + cc.w; }
        }
#pragma unroll
        for (int i = 0; i < 32; ++i) acc[i] = 0.f;
#pragma unroll 1
        for (int batch = 0; batch < 4; ++batch) {
            const int my_eid = eid[(size_t)t * 128 + batch * 32 + l32];
            const float my_gate = gate[(size_t)t * 128 + batch * 32 + l32];
#pragma unroll 1
            for (int grp = 0; grp < 2; ++grp) {
                { u32x4a8_t pa[8]; uint2 pc[8];
#pragma unroll
                  for (int i = 0; i < 8; ++i) { const int id = __shfl(my_eid, 2 * (grp * 8 + i) + hi); const unsigned char* rp = uv + (size_t)id * ROW6 + l32 * 24; pa[i] = *(const u32x4a8_t*)rp; pc[i] = *(const uint2*)(rp + 16); }
#pragma unroll
                  for (int i = 0; i < 8; ++i) { uint2* wp = (uint2*)(raw + i * 1536); wp[0] = make_uint2(pa[i].x, pa[i].y); wp[1] = make_uint2(pa[i].z, pa[i].w); wp[2] = pc[i]; } }
#pragma unroll 1
                for (int i = 0; i < 8; ++i) {
                    const uint2* rp = (const uint2*)(raw + i * 1536); const uint2 a = rp[0], b = rp[1], c = rp[2];
                    const v6u_t pk6 = {a.x, a.y, b.x, b.y, c.x, c.y}; const v32f_t f = __builtin_amdgcn_cvt_scalef32_pk32_f32_fp6(pk6, 1.0f);
                    f32x2_t dv0 = {0.f, 0.f}, dv1 = {0.f, 0.f};
#pragma unroll
                    for (int j = 0; j < 8; ++j) { const f32x2_t fa = {f[2 * j], f[2 * j + 1]}, fb = {f[16 + 2 * j], f[17 + 2 * j]}, xa = {x[2 * j], x[2 * j + 1]}, xb = {x[16 + 2 * j], x[17 + 2 * j]};
                        dv0 = fa * xa + dv0; dv1 = fb * xb + dv1; }
                    pl[(2 * (grp * 8 + i) + hi) * 32 + l32] = (dv0.x + dv0.y) + (dv1.x + dv1.y);
                }
            }
            float d;
            { const float4* pr = (const float4*)(pl + l32 * 32); float4 s4 = pr[0];
#pragma unroll
              for (int i = 1; i < 8; ++i) { const float4 v = pr[i]; s4.x += v.x; s4.y += v.y; s4.z += v.z; s4.w += v.w; }
              d = ((s4.x + s4.y) + (s4.z + s4.w)) * (1.0f / U_SCALE); }
            const float hv = 0.5f * d * (1.0f + erff(d * 0.70710678118654752f)) * my_gate * (1.0f / V_SCALE);
#pragma unroll 1
            for (int grp = 0; grp < 2; ++grp) {
                { u32x4a8_t pa[8]; uint2 pc[8];
#pragma unroll
                  for (int i = 0; i < 8; ++i) { const int id = __shfl(my_eid, 2 * (grp * 8 + i) + hi); const unsigned char* rp = uv + (size_t)id * ROW6 + 768 + l32 * 24; pa[i] = *(const u32x4a8_t*)rp; pc[i] = *(const uint2*)(rp + 16); }
#pragma unroll
                  for (int i = 0; i < 8; ++i) { uint2* wp = (uint2*)(raw + i * 1536); wp[0] = make_uint2(pa[i].x, pa[i].y); wp[1] = make_uint2(pa[i].z, pa[i].w); wp[2] = pc[i]; } }
#pragma unroll 1
                for (int i = 0; i < 8; ++i) {
                    const float c = __shfl(hv, 2 * (grp * 8 + i) + hi);
                    const uint2* rp = (const uint2*)(raw + i * 1536); const uint2 a = rp[0], b = rp[1], cc = rp[2];
                    const v6u_t pk6 = {a.x, a.y, b.x, b.y, cc.x, cc.y}; const v32f_t f = __builtin_amdgcn_cvt_scalef32_pk32_f32_fp6(pk6, 1.0f);
                    const f32x2_t c2 = {c, c};
#pragma unroll
                    for (int j = 0; j < 16; ++j) { const f32x2_t fj = {f[2 * j], f[2 * j + 1]}; f32x2_t aj = {acc[2 * j], acc[2 * j + 1]}; aj = fj * c2 + aj; acc[2 * j] = aj.x; acc[2 * j + 1] = aj.y; }
                }
            }
        }
        float y[32], s = 0.f;
#pragma unroll
        for (int i = 0; i < 32; ++i) { acc[i] += __shfl_xor(acc[i], 32); y[i] = ALPHA * x[i] + acc[i]; s += y[i]; }
#pragma unroll
        for (int o = 16; o > 0; o >>= 1) s += __shfl_xor(s, o);
        const float mean = s * (1.0f / 1024.0f);
        float s2 = 0.f;
#pragma unroll
        for (int i = 0; i < 32; ++i) { y[i] -= mean; s2 += y[i] * y[i]; }
#pragma unroll
        for (int o = 16; o > 0; o >>= 1) s2 += __shfl_xor(s2, o);
        const float rstd = 1.0f / sqrtf(s2 * (1.0f / 1024.0f) + LN_EPS);
        float o[16];
#pragma unroll
        for (int q4 = 0; q4 < 4; ++q4) {
            const float4 gg = ((const float4*)(g + l32 * 32 + hi * 16))[q4], cc = ((const float4*)(bb + l32 * 32 + hi * 16))[q4];
            float ya[4], yb2[4];
#pragma unroll
            for (int e = 0; e < 4; ++e) { ya[e] = y[4 * q4 + e]; yb2[e] = y[16 + 4 * q4 + e]; }
            asm volatile("" : "+v"(ya[0]), "+v"(ya[1]), "+v"(ya[2]), "+v"(ya[3]), "+v"(yb2[0]), "+v"(yb2[1]), "+v"(yb2[2]), "+v"(yb2[3]));
            const float y0 = hi ? yb2[0] : ya[0], y1 = hi ? yb2[1] : ya[1], y2 = hi ? yb2[2] : ya[2], y3 = hi ? yb2[3] : ya[3];
            o[4 * q4] = y0 * rstd * gg.x + cc.x; o[4 * q4 + 1] = y1 * rstd * gg.y + cc.y; o[4 * q4 + 2] = y2 * rstd * gg.z + cc.z; o[4 * q4 + 3] = y3 * rstd * gg.w + cc.w;
            if (h) ((float4*)(hr + hi * 16))[q4] = make_float4(o[4 * q4], o[4 * q4 + 1], o[4 * q4 + 2], o[4 * q4 + 3]);
        }
        uint4* hbp = (uint4*)(hb + (size_t)t * 1024 + l32 * 32 + hi * 16);
        hbp[0] = make_uint4(pk2(o[0], o[1]), pk2(o[2], o[3]), pk2(o[4], o[5]), pk2(o[6], o[7]));
        hbp[1] = make_uint4(pk2(o[8], o[9]), pk2(o[10], o[11]), pk2(o[12], o[13]), pk2(o[14], o[15]));
    }
}

__device__ __forceinline__ float pack_pl(float v, unsigned pl) { return __uint_as_float((__float_as_uint(v) & ~127u) | pl); }
__device__ __forceinline__ void ins16(float (&s)[16], float x) {
#pragma unroll
    for (int k = 15; k >= 1; --k) s[k] = __builtin_amdgcn_fmed3f(s[k - 1], x, s[k]);
    s[0] = vmax(s[0], x);
}
template <int D> __device__ __forceinline__ void bitonic_stage(float (&c)[16]) {
#pragma unroll
    for (int i = 0; i < 16; ++i) if ((i & D) == 0) { const float a = vmax(c[i], c[i + D]), b = vmin(c[i], c[i + D]); c[i] = a; c[i + D] = b; }
}
__device__ __forceinline__ int decode_key(unsigned pl) { return (int)(32u * ((pl >> 4) & 3u) + (pl & 3u) + 8u * ((pl >> 2) & 3u) + 4u * ((pl >> 6) & 1u)); }
__device__ void route_fast_phase(int WV_, const bf16* qb, const bf16* skb  , int* eid, float* gate, unsigned char* lds, int pm = -1, int pn = 0) {
    const int tid = LTID(WV_), lane = tid & 63, wave = tid >> 6, r32 = lane & 31, hi = lane >> 5;
    unsigned* lidx = (unsigned*)lds + wave * (64 * 33) + lane * 33;
    const int u_first = (pm >= 0) ? 0 : LBID() * NWAVE + wave, u_end = (pm >= 0) ? 2 : (T_ / 32) * 8, u_step = (pm >= 0) ? 1 : LGRID() * NWAVE;
    for (int unit = u_first; unit < u_end; unit += u_step) {
        const int h = (pm >= 0) ? 2 * pn + unit : (unit & 7), t = ((pm >= 0) ? 8 * pm + wave : (unit >> 3)) * 32 + r32;
        float sl[2][16];
#pragma unroll
        for (int p = 0; p < 2; ++p) {
            bf16x8_t qf[4];
            { const bf16* qp = qb + (size_t)t * 1024 + h * 128 + p * 64 + 8 * hi;
#pragma unroll
              for (int ks = 0; ks < 4; ++ks) qf[ks] = *(const bf16x8_t*)(qp + 16 * ks); }
            float s[16];
#pragma unroll
            for (int k = 0; k < 16; ++k) s[k] = -INFINITY;
            const bf16* skp = skb + ((size_t)(h * 2 + p) * 128 + r32) * 64 + 8 * hi;
#pragma unroll
            for (int kt = 0; kt < 4; ++kt) {
                f32x16_t acc;
#pragma unroll
                for (int r = 0; r < 16; ++r) acc[r] = 0.f;
#pragma unroll
                for (int ks = 0; ks < 4; ++ks) { const bf16x8_t a = *(const bf16x8_t*)(skp + (size_t)kt * 32 * 64 + 16 * ks); acc = __builtin_amdgcn_mfma_f32_32x32x16_bf16(a, qf[ks], acc, 0, 0, 0); }
#pragma unroll
                for (int r = 0; r < 16; ++r) ins16(s, pack_pl(acc[r], (unsigned)(kt * 16 + r)));
            }
            const unsigned hb = (unsigned)hi << 6;
#pragma unroll
            for (int k = 0; k < 16; ++k) s[k] = __uint_as_float(__float_as_uint(s[k]) | hb);
            float c[16];
#pragma unroll
            for (int k = 0; k < 16; ++k) c[k] = vmax(s[k], __shfl_xor(s[15 - k], 32));
            bitonic_stage<8>(c); bitonic_stage<4>(c); bitonic_stage<2>(c); bitonic_stage<1>(c);
#pragma unroll
            for (int k = 0; k < 16; ++k) { sl[p][k] = c[k]; lidx[p * 16 + k] = (unsigned)decode_key(__float_as_uint(c[k]) & 127u); }
        }
        float w[16];
#pragma unroll
        for (int k = 0; k < 16; ++k) w[k] = -INFINITY;
#pragma unroll
        for (int i = 0; i < 16; ++i)
#pragma unroll
            for (int j = 0; j < 16; ++j)
                if ((i + 1) * (j + 1) <= 16) { const float v = sl[0][i] + sl[1][j]; ins16(w, __uint_as_float((__float_as_uint(v) & ~255u) | (unsigned)(i * 16 + j))); }
        float e[16], sum = 0.f;
#pragma unroll
        for (int k = 0; k < 16; ++k) { e[k] = expf(w[k] - w[0]); sum += e[k]; }
        const float inv = 1.0f / sum;
        int ide[8]; float gte[8];
#pragma unroll
        for (int k = 0; k < 8; ++k) {
            float wa = w[k], wb = w[8 + k], ea = e[k], eb = e[8 + k];
            asm volatile("" : "+v"(wa), "+v"(wb), "+v"(ea), "+v"(eb));
            const float wv = hi ? wb : wa;
            const unsigned pl = __float_as_uint(wv) & 255u;
            ide[k] = (int)(lidx[pl >> 4] * 128u + lidx[16 + (pl & 15u)]);
            gte[k] = (hi ? eb : ea) * inv;
        }
        int* ep = eid + (size_t)t * 128 + h * 16 + hi * 8; float* gp = gate + (size_t)t * 128 + h * 16 + hi * 8;
        *(int4*)ep = make_int4(ide[0], ide[1], ide[2], ide[3]); *(int4*)(ep + 4) = make_int4(ide[4], ide[5], ide[6], ide[7]);
        *(float4*)gp = make_float4(gte[0], gte[1], gte[2], gte[3]); *(float4*)(gp + 4) = make_float4(gte[4], gte[5], gte[6], gte[7]);
    }
}
#ifndef TS_SEL
#define TS_SEL 0
#endif
#define ITS_B() do { if (TS_SEL >= 20 && TS_SEL <= 40 && WV_ == 0 && LANEID() == 0) ((volatile __attribute__((address_space(3))) unsigned long long*)((__attribute__((address_space(3))) unsigned char*)lds + 147456 - 16 - 32))[0] = __builtin_amdgcn_s_memrealtime(); } while (0)
#define ITS_E(k) do { if ((k) == TS_SEL && WV_ == 0 && LANEID() == 0) { volatile __attribute__((address_space(3))) unsigned long long* w_ = (volatile __attribute__((address_space(3))) unsigned long long*)((__attribute__((address_space(3))) unsigned char*)lds + 147456 - 16 - 32); w_[1] += __builtin_amdgcn_s_memrealtime() - w_[0]; } } while (0)

typedef float f32x4_t __attribute__((ext_vector_type(4)));
typedef __bf16 bf16x2v __attribute__((ext_vector_type(2)));
__device__ __forceinline__ float dot2bf(unsigned a, unsigned b, float c) { return __builtin_amdgcn_fdot2_f32_bf16(__builtin_bit_cast(bf16x2v, a), __builtin_bit_cast(bf16x2v, b), c, false); }
__device__ __forceinline__ void cnt_gt(int& cnt, unsigned a, unsigned b) { asm("v_cmp_gt_u32_e32 vcc, %1, %2\n\tv_addc_co_u32_e32 %0, vcc, 0, %0, vcc" : "+v"(cnt) : "v"(a), "v"(b) : "vcc"); }
__device__ __forceinline__ void cnt_eq(int& cnt, unsigned a, unsigned b) { asm("v_cmp_eq_u32_e32 vcc, %1, %2\n\tv_addc_co_u32_e32 %0, vcc, 0, %0, vcc" : "+v"(cnt) : "v"(a), "v"(b) : "vcc"); }
__device__ __forceinline__ unsigned flag_gt(unsigned a, unsigned b) { unsigned r; asm("v_cmp_gt_u32_e32 vcc, %1, %2\n\tv_cndmask_b32_e64 %0, 0, 1, vcc" : "=v"(r) : "v"(a), "v"(b) : "vcc"); return r; }
__device__ __forceinline__ unsigned flag_eq(unsigned a, unsigned b) { unsigned r; asm("v_cmp_eq_u32_e32 vcc, %1, %2\n\tv_cndmask_b32_e64 %0, 0, 1, vcc" : "=v"(r) : "v"(a), "v"(b) : "vcc"); return r; }
__device__ __forceinline__ void cnt_ge(int& cnt, unsigned key, unsigned cand) { asm("v_cmp_ge_u32_e32 vcc, %1, %2\n\tv_addc_co_u32_e32 %0, vcc, 0, %0, vcc" : "+v"(cnt) : "v"(key), "v"(cand) : "vcc"); }

template <int CTRL, int RM> __device__ __forceinline__ unsigned dpp0(unsigned v) { return (unsigned)__builtin_amdgcn_update_dpp(0, (int)v, CTRL, RM, 0xf, false); }
template <int CTRL> __device__ __forceinline__ unsigned dppf(unsigned v) { return (unsigned)__builtin_amdgcn_update_dpp(-1, (int)v, CTRL, 0xf, 0xf, false); }
__device__ __forceinline__ unsigned wave_sum_u_dpp(unsigned v) {
    v += dpp0<0xB1, 0xf>(v); v += dpp0<0x4E, 0xf>(v); v += dpp0<0x141, 0xf>(v); v += dpp0<0x140, 0xf>(v);
    return (unsigned)__builtin_amdgcn_readlane((int)v, 0) + (unsigned)__builtin_amdgcn_readlane((int)v, 16) + (unsigned)__builtin_amdgcn_readlane((int)v, 32) + (unsigned)__builtin_amdgcn_readlane((int)v, 48);
}
__device__ __forceinline__ unsigned wave_min_u_dpp(unsigned v) {
    unsigned t;
    t = dppf<0xB1>(v); v = t < v ? t : v; t = dppf<0x4E>(v); v = t < v ? t : v; t = dppf<0x141>(v); v = t < v ? t : v; t = dppf<0x140>(v); v = t < v ? t : v;
    const unsigned a = (unsigned)__builtin_amdgcn_readlane((int)v, 0), b = (unsigned)__builtin_amdgcn_readlane((int)v, 16), c = (unsigned)__builtin_amdgcn_readlane((int)v, 32), d = (unsigned)__builtin_amdgcn_readlane((int)v, 48);
    const unsigned ab = a < b ? a : b, cd = c < d ? c : d; return ab < cd ? ab : cd;
}
__device__ __forceinline__ unsigned wave_incl_scan_u_dpp(unsigned v) {
    v += dpp0<0x111, 0xf>(v); v += dpp0<0x112, 0xf>(v); v += dpp0<0x114, 0xf>(v); v += dpp0<0x118, 0xf>(v);
    v += dpp0<0x142, 0xa>(v);
    v += dpp0<0x143, 0xc>(v);
    return v;
}
typedef __attribute__((address_space(3))) unsigned lds_u32;
template <int SHIFT> __device__ __forceinline__ unsigned radix_pass(const unsigned (&key)[64], unsigned pre, lds_u32* hist, int lane, int& need, int jlim, unsigned L) {
    typedef unsigned u32x4v __attribute__((ext_vector_type(4)));
    typedef __attribute__((address_space(3))) u32x4v lds_u32x4;
    const int fl = 63 - lane;
    { const u32x4v z4 = {0u, 0u, 0u, 0u};
      ((lds_u32x4*)(hist + fl * 4))[0] = z4; }
    const unsigned hb = (unsigned)(size_t)hist;
    const unsigned one = 1u;
    asm volatile("" ::: "memory");
#pragma unroll
    for (int j4 = 0; j4 < 16; ++j4) {
        if (4 * j4 <= jlim) {
            unsigned long long c0, c1, c2, c3, sv; unsigned t0, t1, t2, t3;
            if (SHIFT == 24)
                asm volatile(
                    "v_cmp_ge_u32_e64 %0, %9, %13\n\tv_cmp_ge_u32_e64 %1, %10, %13\n\tv_cmp_ge_u32_e64 %2, %11, %13\n\tv_cmp_ge_u32_e64 %3, %12, %13\n\t"
                    "v_lshrrev_b32_e32 %5, 24, %9\n\tv_lshrrev_b32_e32 %6, 24, %10\n\tv_lshrrev_b32_e32 %7, 24, %11\n\tv_lshrrev_b32_e32 %8, 24, %12\n\t"
                    "v_lshl_add_u32 %5, %5, 2, %14\n\tv_lshl_add_u32 %6, %6, 2, %14\n\tv_lshl_add_u32 %7, %7, 2, %14\n\tv_lshl_add_u32 %8, %8, 2, %14\n\t"
                    "s_mov_b64 %4, exec\n\t"
                    "s_mov_b64 exec, %0\n\tds_add_u32 %5, %15\n\ts_mov_b64 exec, %1\n\tds_add_u32 %6, %15\n\ts_mov_b64 exec, %2\n\tds_add_u32 %7, %15\n\ts_mov_b64 exec, %3\n\tds_add_u32 %8, %15\n\t"
                    "s_mov_b64 exec, %4"
                    : "=&s"(c0), "=&s"(c1), "=&s"(c2), "=&s"(c3), "=&s"(sv), "=&v"(t0), "=&v"(t1), "=&v"(t2), "=&v"(t3)
                    : "v"(key[4 * j4]), "v"(key[4 * j4 + 1]), "v"(key[4 * j4 + 2]), "v"(key[4 * j4 + 3]), "v"(L), "v"(hb), "v"(one) : "memory");
            else
                asm volatile(
                    "v_lshrrev_b32_e32 %5, %16, %9\n\tv_lshrrev_b32_e32 %6, %16, %10\n\tv_lshrrev_b32_e32 %7, %16, %11\n\tv_lshrrev_b32_e32 %8, %16, %12\n\t"
                    "v_cmp_eq_u32_e64 %0, %5, %13\n\tv_cmp_eq_u32_e64 %1, %6, %13\n\tv_cmp_eq_u32_e64 %2, %7, %13\n\tv_cmp_eq_u32_e64 %3, %8, %13\n\t"
                    "s_or_b64 %4, %0, %1\n\ts_or_b64 %4, %4, %2\n\ts_or_b64 %4, %4, %3\n\t"
                    "s_cbranch_scc0 .Lrxskip%=\n\t"
                    "v_bfe_u32 %5, %9, %17, 8\n\tv_bfe_u32 %6, %10, %17, 8\n\tv_bfe_u32 %7, %11, %17, 8\n\tv_bfe_u32 %8, %12, %17, 8\n\t"
                    "v_lshl_add_u32 %5, %5, 2, %14\n\tv_lshl_add_u32 %6, %6, 2, %14\n\tv_lshl_add_u32 %7, %7, 2, %14\n\tv_lshl_add_u32 %8, %8, 2, %14\n\t"
                    "s_mov_b64 %4, exec\n\t"
                    "s_mov_b64 exec, %0\n\tds_add_u32 %5, %15\n\ts_mov_b64 exec, %1\n\tds_add_u32 %6, %15\n\ts_mov_b64 exec, %2\n\tds_add_u32 %7, %15\n\ts_mov_b64 exec, %3\n\tds_add_u32 %8, %15\n\t"
                    "s_mov_b64 exec, %4\n"
                    ".Lrxskip%=:"
                    : "=&s"(c0), "=&s"(c1), "=&s"(c2), "=&s"(c3), "=&s"(sv), "=&v"(t0), "=&v"(t1), "=&v"(t2), "=&v"(t3)
                    : "v"(key[4 * j4]), "v"(key[4 * j4 + 1]), "v"(key[4 * j4 + 2]), "v"(key[4 * j4 + 3]), "v"(pre), "v"(hb), "v"(one), "n"((SHIFT + 8) & 31), "n"(SHIFT) : "memory", "scc");
        }
    }
    asm volatile("s_waitcnt lgkmcnt(0)" ::: "memory");
    unsigned dsum[4]; unsigned sumL = 0u;
    { const u32x4v v0 = ((const lds_u32x4*)(hist + fl * 4))[0];
      dsum[0] = v0.x; dsum[1] = v0.y; dsum[2] = v0.z; dsum[3] = v0.w; sumL = (dsum[0] + dsum[1]) + (dsum[2] + dsum[3]); }
    const unsigned incl = wave_incl_scan_u_dpp(sumL);
    const unsigned above = incl - sumL;
    const bool own = (above < (unsigned)need) && ((unsigned)need <= above + sumL);
    const int owner = __ffsll((long long)__ballot(own)) - 1;
    unsigned acc = above; int sel = -1; unsigned cab = 0u;
#pragma unroll
    for (int i = 3; i >= 0; --i) { const unsigned c = dsum[i]; const bool hit = (sel < 0) && (acc + c >= (unsigned)need); cab = hit ? acc : cab; sel = hit ? i : sel; acc += c; }
    const int ow = owner < 0 ? 0 : owner;
    const unsigned digit = (unsigned)__builtin_amdgcn_readlane(sel, ow) + (unsigned)(4 * (63 - ow));
    need -= (int)__builtin_amdgcn_readlane((int)cab, ow);
    return digit;
}

__device__ __forceinline__ void idx_select(const unsigned (&key)[64], unsigned t3, int jlim, lds_u32* hist, int lane, uint2* mrow, int WV_, unsigned char* lds) {
        unsigned wlo = 0u, whi = 0u;
        unsigned L = wave_min_u_dpp(t3);
        L = L > 1u ? L : 1u;

        int need = 256;
        ITS_E(34); ITS_B();
        const unsigned d1 = radix_pass<24>(key, 0u, hist, lane, need, jlim, L);
        ITS_E(30); ITS_B();
        const unsigned d2 = radix_pass<16>(key, d1, hist, lane, need, jlim, L);
        ITS_E(31); ITS_B();
        const unsigned d3 = radix_pass<8>(key, (d1 << 8) | d2, hist, lane, need, jlim, L);
        const unsigned d4 = radix_pass<0>(key, (d1 << 16) | (d2 << 8) | d3, hist, lane, need, jlim, L);
        const unsigned prefix = (d1 << 24) | (d2 << 16) | (d3 << 8) | d4;
        ITS_E(32); ITS_B();

        int ceq = 0;
#pragma unroll
        for (int j4 = 0; j4 < 16; ++j4) if (4 * j4 <= jlim) { cnt_eq(ceq, key[4 * j4], prefix); cnt_eq(ceq, key[4 * j4 + 1], prefix); cnt_eq(ceq, key[4 * j4 + 2], prefix); cnt_eq(ceq, key[4 * j4 + 3], prefix); }
        ceq = (int)wave_sum_u_dpp((unsigned)ceq);
        int X = 4096;
        if (ceq != need) {
            int X0 = 0;
#pragma unroll 1
            for (int bit = 11; bit >= 0; --bit) {
                const int c = X0 | (1 << bit);
                int cnt = 0; const int crel = (c - lane + 63) >> 6;
#pragma unroll
                for (int j = 0; j < 64; ++j) cnt_eq(cnt, (key[j] ^ prefix) | ~(unsigned)((j - crel) >> 31), 0u);
                cnt = wave_sum_i(cnt);
                if (cnt < need) X0 = c;
            }
            X = X0 + 1;
        }
        const int xrel = (X - lane + 63) >> 6;
#pragma unroll
        for (int j4 = 0; j4 < 16; ++j4) {
            if (4 * j4 <= jlim) {
#pragma unroll
                for (int e = 0; e < 4; ++e) { const int j = 4 * j4 + e;
                    const bool sel = (key[j] > prefix) || (key[j] == prefix && j < xrel);
                    const unsigned long long bm = __ballot(sel);
                    asm("v_writelane_b32 %0, %1, %2" : "+v"(wlo) : "s"((unsigned)bm), "n"(j));
                    asm("v_writelane_b32 %0, %1, %2" : "+v"(whi) : "s"((unsigned)(bm >> 32)), "n"(j)); }
            }
        }
        mrow[lane] = make_uint2(wlo, whi);
        ITS_E(33); ITS_B();
}
__device__ void index_fast_phase(int WV_, const bf16* P, unsigned char* mask, float* kmean, float* scratch_all, unsigned* qctr, unsigned char* lds) {
    const int tid = LTID(WV_), lane = tid & 63, wave = tid >> 6, bid = LBID(), G = LGRID();
    float* s_part = (float*)lds;
    ITS_B();
    for (int k = bid; k < 256; k += G) {
        const int b = k >> 6, h = (k >> 4) & 3, blk = k & 15;
        const bf16* kp = P + (size_t)(b * S_ + blk * 256 + wave * 32) * NP + C_KC + h * 64 + lane;
        float a = 0.f;
#pragma unroll 8
        for (int j = 0; j < 32; ++j) a += bf2f(kp[(size_t)j * NP]);
        __syncthreads();
        s_part[wave * 64 + lane] = a;
        __syncthreads();
        if (tid < 64) { float s = 0.f;
#pragma unroll
            for (int w = 0; w < 8; ++w) s += s_part[w * 64 + tid];
            kmean[((b * 4 + h) * 16 + blk) * 64 + tid] = s * (1.0f / 256.0f); }
    }
    ITS_E(22);
    constexpr int IDX_CP = 512 + 4;
    constexpr int IDX_PITCH = 4096 + 32;
    float* scr = scratch_all + (size_t)bid * (16 * IDX_PITCH);
    const int lq = lane & 15, g4 = lane >> 4;
    for (int ui = bid; ui < 1024; ui += G) {
        const int b = ui >> 8, k = ui & 255, tile = (b & 1) ? 255 - k : k, q0 = tile * 16;
        const bf16* Pb = P + (size_t)b * S_ * NP;
        const int ntiles = tile + 1;
        int lane_o = LANEID(); asm volatile("" : "+v"(lane_o));
        const int lane = lane_o, lq = lane & 15, g4 = lane >> 4;
        const int wave = WV_;
        const int qA = q0 + 2 * wave, qB = qA + 1;
        uint2* mrowA = (uint2*)(mask + (size_t)(b * S_ + qA) * 512); uint2* mrowB = (uint2*)(mask + (size_t)(b * S_ + qB) * 512);
        if (tile < 16) {
            unsigned wlo = 0u, whi = 0u, xlo = 0u, xhi = 0u; const int ra = qA - lane * 64, rb = qB - lane * 64;
#pragma unroll
            for (int j = 0; j < 32; ++j) { wlo |= (~(unsigned)((ra - j) >> 31) & 1u) << j; whi |= (~(unsigned)((ra - 32 - j) >> 31) & 1u) << j;
                                           xlo |= (~(unsigned)((rb - j) >> 31) & 1u) << j; xhi |= (~(unsigned)((rb - 32 - j) >> 31) & 1u) << j; }
            mrowA[lane] = make_uint2(wlo, whi); mrowB[lane] = make_uint2(xlo, xhi);
            continue;
        }
        ITS_B();
        bf16x8_t qf[8]; float wi[8];
        { const bf16* qp = Pb + (size_t)(q0 + lq) * NP + C_QI + 8 * g4;
#pragma unroll
          for (int h = 0; h < 8; ++h) qf[h] = *(const bf16x8_t*)(qp + 32 * h);
          const uint4 wv = *(const uint4*)(Pb + (size_t)(q0 + lq) * NP + C_WI); unpack8(wv, wi); }
        bf16x8_t qch, qcl;
        { typedef unsigned u32x4_t __attribute__((ext_vector_type(4)));
          float qc[8];
#pragma unroll
          for (int i = 0; i < 8; ++i) qc[i] = 0.f;
#pragma unroll
          for (int h = 0; h < 8; ++h) { const u32x4_t w4 = __builtin_bit_cast(u32x4_t, qf[h]);
#pragma unroll
              for (int i = 0; i < 4; ++i) { qc[2 * i] += wi[h] * __uint_as_float(w4[i] << 16); qc[2 * i + 1] += wi[h] * __uint_as_float(w4[i] & 0xffff0000u); } }
          u32x4_t hi4, lo4;
#pragma unroll
          for (int i = 0; i < 4; ++i) { const unsigned hw = cvtpk(qc[2 * i], qc[2 * i + 1]); hi4[i] = hw;
              lo4[i] = cvtpk(qc[2 * i] - __uint_as_float(hw << 16), qc[2 * i + 1] - __uint_as_float(hw & 0xffff0000u)); }
          qch = __builtin_bit_cast(bf16x8_t, hi4); qcl = __builtin_bit_cast(bf16x8_t, lo4); }
        typedef __attribute__((address_space(3))) bf16x8_t lds_bf16x8;
        lds_bf16x8* qops = (lds_bf16x8*)((__attribute__((address_space(3))) unsigned char*)lds + 102656);
        if (wave == 0) {
#pragma unroll
            for (int h = 0; h < 8; ++h) qops[h * 64 + lane] = qf[h];
            qops[8 * 64 + lane] = qch; qops[9 * 64 + lane] = qcl; }
        __syncthreads();
        ITS_E(20); ITS_B();
        float* cb0 = (float*)(lds + 69632); float* cb1 = (float*)(lds + 112896);
        const int jlim = q0 >> 6;
        const int jmaxA = (qA - lane) >> 6, jmaxB = (qB - lane) >> 6;
        unsigned keyA[64], keyB[64];
        unsigned a0 = 0u, a1 = 0u, a2 = 0u, a3 = 0u, b0 = 0u, b1 = 0u, b2 = 0u, b3 = 0u;
        const bf16* kbase = Pb + (size_t)lq * NP + C_KI + 8 * g4;
        bf16x8_t nxt = *(const bf16x8_t*)(kbase + (size_t)(wave < ntiles ? wave : 0) * 16 * NP);
#pragma unroll
        for (int c = 0; c < 8; ++c) {
            if (32 * c < ntiles) {
                float* cb = (c & 1) ? cb1 : cb0;
#pragma unroll
                for (int j = 0; j < 4; ++j) {
                    const int kt = 32 * c + wave + 8 * j;
                    const bf16x8_t af = nxt;
                    { const int k = kt + 8; const int kc = k < ntiles ? k : 0; nxt = *(const bf16x8_t*)(kbase + (size_t)kc * 16 * NP); }
                    if (kt < ntiles) {
                        const f32x4_t z = {0.f, 0.f, 0.f, 0.f};
                        f32x4_t sc = __builtin_amdgcn_mfma_f32_16x16x32_bf16(af, qops[8 * 64 + lane], z, 0, 0, 0);
                        sc = __builtin_amdgcn_mfma_f32_16x16x32_bf16(af, qops[9 * 64 + lane], sc, 0, 0, 0);
#pragma unroll
                        for (int hh = 0; hh < 2; ++hh) {
                            f32x4_t a[4];
#pragma unroll
                            for (int h = 0; h < 4; ++h) a[h] = __builtin_amdgcn_mfma_f32_16x16x32_bf16(af, qops[(4 * hh + h) * 64 + lane], z, 0, 0, 0);
#pragma unroll
                            for (int h = 0; h < 4; ++h)
#pragma unroll
                                for (int r = 0; r < 4; ++r) sc[r] = __builtin_fmaf(__builtin_fabsf(a[h][r]), wi[4 * hh + h], sc[r]);
                        }
#pragma unroll
                        for (int r = 0; r < 4; ++r) { sc[r] *= 0.03125f; if (sc[r] == 0.f) sc[r] = 0.f; }
                        *(f32x4_t*)(cb + lq * IDX_CP + (wave + 8 * j) * 16 + 4 * g4) = sc;
                    }
                }
                __syncthreads();
#pragma unroll
                for (int js = 0; js < 8; ++js) {
                    const int slot = 8 * c + js;
                    if (slot <= jlim) {
                        const unsigned ua = __float_as_uint(cb[(2 * wave) * IDX_CP + 64 * js + lane]), ub = __float_as_uint(cb[(2 * wave + 1) * IDX_CP + 64 * js + lane]);
                        const unsigned xa = (ua ^ ((unsigned)((int)ua >> 31) | 0x80000000u)) & ~(unsigned)((jmaxA - slot) >> 31);
                        const unsigned xb = (ub ^ ((unsigned)((int)ub >> 31) | 0x80000000u)) & ~(unsigned)((jmaxB - slot) >> 31);
                        keyA[slot] = xa; keyB[slot] = xb;
                        unsigned n1, n2, n3;
                        asm("v_med3_u32 %0, %1, %2, %3" : "=v"(n3) : "v"(a2), "v"(a3), "v"(xa));
                        asm("v_med3_u32 %0, %1, %2, %3" : "=v"(n2) : "v"(a1), "v"(a2), "v"(xa));
                        asm("v_med3_u32 %0, %1, %2, %3" : "=v"(n1) : "v"(a0), "v"(a1), "v"(xa));
                        a0 = a0 > xa ? a0 : xa; a1 = n1; a2 = n2; a3 = n3;
                        asm("v_med3_u32 %0, %1, %2, %3" : "=v"(n3) : "v"(b2), "v"(b3), "v"(xb));
                        asm("v_med3_u32 %0, %1, %2, %3" : "=v"(n2) : "v"(b1), "v"(b2), "v"(xb));
                        asm("v_med3_u32 %0, %1, %2, %3" : "=v"(n1) : "v"(b0), "v"(b1), "v"(xb));
                        b0 = b0 > xb ? b0 : xb; b1 = n1; b2 = n2; b3 = n3;
                    } else { keyA[slot] = 0u; keyB[slot] = 0u; }
                }
            } else {
#pragma unroll
                for (int js = 0; js < 8; ++js) { keyA[8 * c + js] = 0u; keyB[8 * c + js] = 0u; }
            }
        }
        lds_u32* hist = (lds_u32*)((__attribute__((address_space(3))) unsigned char*)lds + 2048) + wave * 2048;
        ITS_E(23); ITS_B();
        idx_select(keyA, a3, jlim, hist, lane, mrowA, WV_, lds);
        ITS_E(24); ITS_B();
        idx_select(keyB, b3, jlim, hist, lane, mrowB, WV_, lds);
        ITS_E(25); ITS_B();
        __syncthreads();
    }
}

constexpr int MG_P = 72;
constexpr int MG_TILE_BYTES = 128 * MG_P * 2;
__device__ void merge_fast_phase(int WV_, const unsigned char* G8, const bf16* ys, const bf16* wbt  , bf16* merged, unsigned char* lds) {
    const int tid = LTID(WV_), lane = tid & 63, wave = tid >> 6, r32 = lane & 31, hi = lane >> 5, wt = wave & 3, wd = wave >> 2;
    const int srow0 = tid >> 3, sch = tid & 7;
    for (int tile = LBID(); tile < 1024; tile += LGRID()) {
        const int tok0 = (tile >> 3) * 128, d0 = (tile & 7) * 128;
        f32x16_t mer[2], acc[2];
#pragma unroll
        for (int r = 0; r < 16; ++r) { mer[0][r] = 0.f; mer[1][r] = 0.f; acc[0][r] = 0.f; acc[1][r] = 0.f; }
        uint4 RW00, RW01, RW10, RW11, RY00, RY01, RY10, RY11, RG0, RG1;
        unsigned char* gl = lds + 4 * MG_TILE_BYTES;
        const int grow = tid >> 3, gch = tid & 7;
#define MG_GLOAD(st_, R_) do { const int n_ = (st_) >> 2, kc_ = (st_) & 3; \
            RW##R_##0 = *(const uint4*)(wbt + ((size_t)n_ * 1024 + d0 + srow0) * 256 + kc_ * 64 + sch * 8); \
            RW##R_##1 = *(const uint4*)(wbt + ((size_t)n_ * 1024 + d0 + srow0 + 64) * 256 + kc_ * 64 + sch * 8); \
            RY##R_##0 = *(const uint4*)(ys + (size_t)(tok0 + srow0) * 1024 + n_ * 256 + kc_ * 64 + sch * 8); \
            RY##R_##1 = *(const uint4*)(ys + (size_t)(tok0 + srow0 + 64) * 1024 + n_ * 256 + kc_ * 64 + sch * 8); } while (0)
#define MG_SSTORE(buf_, R_) do { bf16* wl_ = (bf16*)(lds + (buf_) * 2 * MG_TILE_BYTES); bf16* yl_ = (bf16*)(lds + (buf_) * 2 * MG_TILE_BYTES + MG_TILE_BYTES); \
            *(uint4*)(wl_ + srow0 * MG_P + sch * 8) = RW##R_##0; *(uint4*)(wl_ + (srow0 + 64) * MG_P + sch * 8) = RW##R_##1; \
            *(uint4*)(yl_ + srow0 * MG_P + sch * 8) = RY##R_##0; *(uint4*)(yl_ + (srow0 + 64) * MG_P + sch * 8) = RY##R_##1; } while (0)
        __syncthreads();
        MG_GLOAD(0, 0); MG_GLOAD(1, 1);
        MG_SSTORE(0, 0);
        __syncthreads();
#define MG_STAGE(PAR_, OTH_) do { const int buf = PAR_; \
            if (st + 2 < 16) MG_GLOAD(st + 2, PAR_); \
            if ((st & 3) == 1) { const unsigned char* gsrc = G8 + (size_t)(tok0 + grow) * 4096 + (st >> 2) * 1024 + d0 + gch * 16; \
                RG0 = *(const uint4*)gsrc; RG1 = *(const uint4*)(gsrc + (size_t)64 * 4096); } \
            const bf16* wl = (const bf16*)(lds + buf * 2 * MG_TILE_BYTES); const bf16* yl = (const bf16*)(lds + buf * 2 * MG_TILE_BYTES + MG_TILE_BYTES); \
            _Pragma("unroll") for (int ks = 0; ks < 4; ++ks) { \
                const bf16x8_t bq = *(const bf16x8_t*)(yl + (32 * wt + r32) * MG_P + 16 * ks + 8 * hi); \
                const bf16x8_t a0 = *(const bf16x8_t*)(wl + (64 * wd + r32) * MG_P + 16 * ks + 8 * hi); \
                const bf16x8_t a1 = *(const bf16x8_t*)(wl + (64 * wd + 32 + r32) * MG_P + 16 * ks + 8 * hi); \
                acc[0] = __builtin_amdgcn_mfma_f32_32x32x16_bf16(a0, bq, acc[0], 0, 0, 0); \
                acc[1] = __builtin_amdgcn_mfma_f32_32x32x16_bf16(a1, bq, acc[1], 0, 0, 0); } \
            if ((st & 3) == 3) { \
                const int n = st >> 2; \
                const unsigned char* gp = gl + (32 * wt + r32) * 144 + 64 * wd + 4 * hi; (void)n; \
                _Pragma("unroll") for (int dt = 0; dt < 2; ++dt) \
                _Pragma("unroll") for (int g = 0; g < 4; ++g) { \
                        const int gv = *(const int*)(gp + 32 * dt + 8 * g); \
                        mer[dt][4 * g + 0] += acc[dt][4 * g + 0] * __builtin_amdgcn_cvt_f32_fp8(gv, 0); \
                        mer[dt][4 * g + 1] += acc[dt][4 * g + 1] * __builtin_amdgcn_cvt_f32_fp8(gv, 1); \
                        mer[dt][4 * g + 2] += acc[dt][4 * g + 2] * __builtin_amdgcn_cvt_f32_fp8(gv, 2); \
                        mer[dt][4 * g + 3] += acc[dt][4 * g + 3] * __builtin_amdgcn_cvt_f32_fp8(gv, 3); } \
                _Pragma("unroll") for (int r = 0; r < 16; ++r) { acc[0][r] = 0.f; acc[1][r] = 0.f; } } \
            if (st + 1 < 16) MG_SSTORE(OTH_, OTH_); \
            if ((st & 3) == 2) { *(uint4*)(gl + grow * 144 + gch * 16) = RG0; *(uint4*)(gl + (grow + 64) * 144 + gch * 16) = RG1; } \
            __syncthreads(); } while (0)
#pragma unroll 1
        for (int st2 = 0; st2 < 16; st2 += 2) { { const int st = st2; MG_STAGE(0, 1); } { const int st = st2 + 1; MG_STAGE(1, 0); } }
#undef MG_STAGE
#undef MG_GLOAD
#undef MG_SSTORE
        bf16* mp = merged + (size_t)(tok0 + 32 * wt + r32) * 1024 + d0 + 64 * wd + 4 * hi;
#pragma unroll
        for (int dt = 0; dt < 2; ++dt)
#pragma unroll
            for (int g = 0; g < 4; ++g)
                *(uint2*)(mp + 32 * dt + 8 * g) = make_uint2(cvtpk(mer[dt][4 * g], mer[dt][4 * g + 1]), cvtpk(mer[dt][4 * g + 2], mer[dt][4 * g + 3]));
    }
}
#define LAS __attribute__((address_space(3)))
#define XB_TMO      128
#define XB_XCNT(j)  (256  + 64 * (j))
#define XB_XSUB(j)  (1280 + 64 * (j))
#define XB_XGEN(j)  (2304 + 64 * (j))
#define XB_TOP      3328
#define XB_TOPGEN   3392
#define XCD_BAR_WORDS 3456
#define XB_SPIN_CAP (1u << 18)

__device__ __forceinline__ unsigned xb_ld(unsigned* p)              { return __hip_atomic_load(p, __ATOMIC_RELAXED, __HIP_MEMORY_SCOPE_AGENT); }
__device__ __forceinline__ unsigned xb_add(unsigned* p, unsigned v) { return __hip_atomic_fetch_add(p, v, __ATOMIC_RELAXED, __HIP_MEMORY_SCOPE_AGENT); }
__device__ __forceinline__ unsigned xb_xcc_id() { return (unsigned)__builtin_amdgcn_s_getreg((3 << 11) | 20) & 0xFu; }
#define XB_SPIN(cond, bar) do { unsigned _sp = 0; while (cond) { __builtin_amdgcn_s_sleep(1); \
    if ((++_sp & 255u) == 0u) { if (xb_ld(&(bar)[XB_TMO])) break; if (_sp > XB_SPIN_CAP) { atomicAdd(&(bar)[XB_TMO], 1u); break; } } } } while (0)

struct XcdBarrier {
    unsigned* bar; unsigned x;
    volatile LAS unsigned* st;
};

__device__ __forceinline__ XcdBarrier xcd_barrier_post(unsigned* bar, volatile LAS unsigned* st) {
    XcdBarrier b; b.bar = bar; b.x = xb_xcc_id(); b.st = st;
    if (threadIdx.x == 0) (void)xb_add(&bar[XB_XCNT(b.x)], 1u);
    return b;
}
__device__ __forceinline__ void xcd_barrier_complete(unsigned* bar, unsigned x, unsigned& nloc, unsigned& nx) {
    const unsigned G = gridDim.x * gridDim.y * gridDim.z;
    unsigned sum, cnt, mine, sp = 0u;
    for (;;) {
        sum = 0u; cnt = 0u; mine = 0u;
#pragma unroll
        for (unsigned j = 0; j < 16; ++j) { const unsigned c = xb_ld(&bar[XB_XCNT(j)]); sum += c; cnt += (c > 0u) ? 1u : 0u; mine = (j == x) ? c : mine; }
        if (sum == G) break;
        __builtin_amdgcn_s_sleep(1);
        if ((++sp & 255u) == 0u) { if (xb_ld(&bar[XB_TMO])) break; if (sp > XB_SPIN_CAP) { atomicAdd(&bar[XB_TMO], 1u); break; } }
    }
    nloc = mine > 0u ? mine : 1u; nx = cnt > 0u ? cnt : 1u;
}

__device__ __forceinline__ void xcd_barrier(const XcdBarrier& b, int wv_) {
    asm volatile("s_waitcnt vmcnt(0)" ::: "memory");
    __syncthreads();
    if (wv_ == 0 && LANEID() == 0) {
        unsigned* bar = b.bar;
        __builtin_amdgcn_s_waitcnt(0);
        unsigned nloc = b.st[0], nx = b.st[1];
        if (nloc == 0u) { xcd_barrier_complete(bar, b.x, nloc, nx); b.st[0] = nloc; b.st[1] = nx; }
        const unsigned old = xb_add(&bar[XB_XSUB(b.x)], 1u);
        const unsigned gen = old / nloc;
        if (old + 1u == (gen + 1u) * nloc) {
            __builtin_amdgcn_fence(__ATOMIC_RELEASE, "agent");
            asm volatile("s_waitcnt vmcnt(0)" ::: "memory");
            const unsigned og = xb_add(&bar[XB_TOP], 1u);
            const unsigned tg = og / nx;
            if (og + 1u == (tg + 1u) * nx) xb_add(&bar[XB_TOPGEN], 1u);
            else XB_SPIN(xb_ld(&bar[XB_TOPGEN]) == tg, bar);
            __builtin_amdgcn_fence(__ATOMIC_ACQUIRE, "agent");
            xb_add(&bar[XB_XGEN(b.x)], 1u);
            asm volatile("s_waitcnt vmcnt(0)" ::: "memory");
        } else {
            XB_SPIN(xb_ld(&bar[XB_XGEN(b.x)]) == gen, bar);
            __builtin_amdgcn_fence(__ATOMIC_ACQUIRE, "agent");
            asm volatile("s_waitcnt vmcnt(0)" ::: "memory");
        }
    }
    __syncthreads();
}

enum { PH_PRO = 0, PH_GIN, PH_INDEX, PH_ATTN, PH_MERGE, PH_GOUT, PH_LN1, PH_GQ, PH_ROUTE, PH_PEER };
template <int PH> __device__ __forceinline__ void run_phase(int WV_, const Params& p_unused, int l, unsigned char* lds_raw) {
    size_t kaoff_ = 0; asm volatile("" : "+s"(kaoff_));
    typedef const __attribute__((address_space(4))) char* kaptr_t;
    const __attribute__((address_space(4))) Params& p = *(const __attribute__((address_space(4))) Params*)((kaptr_t)__builtin_amdgcn_kernarg_segment_ptr() + kaoff_);
    float* sm = (float*)lds_raw;
    size_t wsoff_ = 0; asm volatile("" : "+s"(wsoff_));
    unsigned char* ws = p.ws + wsoff_;
    float* hbuf = p.out;
    bf16* hb = (bf16*)(ws + WS_HB);
    bf16* P = (bf16*)(ws + WS_P);
    bf16* ys = (bf16*)(ws + WS_YS);
    bf16* mrg = (bf16*)(ws + WS_MRG);
    float* mix = (float*)(ws + WS_MIX);
    float* qb = (float*)(ws + WS_Q);
    unsigned char* mask = ws + WS_MASK;
    int* eid = (int*)(ws + WS_EID);
    float* gate = (float*)(ws + WS_GATE);
    float* kmean = (float*)(ws + WS_KMEAN);
    const float* hin = (l == 0) ? p.in[0] : hbuf;
    if (PH == PH_PRO) { Params pc; for (int i = 0; i < 13; ++i) pc.in[i] = p.in[i]; pc.out = p.out; pc.ws = ws;
        prologue_phase(WV_, pc, sm); convert_tables(WV_, pc);
        for (int i = LBID() * NTHR + LTID(WV_); i < DEPTH_ * 8 * 2 * 128 * 64 / 4; i += LGRID() * NTHR) { const float4 v = ((const float4*)p.in[8])[i]; ((uint2*)(ws + WS_SKB))[i] = make_uint2(pk2(v.x, v.y), pk2(v.z, v.w)); } if (LBID() < 2) build_unit_table((unsigned*)(ws + WS_CTL) + 1024, LBID() * NTHR + LTID(WV_)); }
    else if (PH == PH_GIN) {
        pg8::Gemm g{hb, (const bf16*)(ws + WS_WIN_T + l * WIN_T_BYTES), T_, NP, 1024};
        pg8::StaticOrder S; S.init(T_, NP, (int)LGRID(), (int)LBID());
        pg8::EpiBf16Sig E{P, NP, C_G, ws + WS_G8};
        pg8::gemm_phase<pg8::EpiBf16Sig, pg8::StaticOrder, true, true>(WV_, (PG8_LAS unsigned char*)lds_raw, g, S, E);
    }
    else if (PH == PH_INDEX) index_fast_phase(WV_, P, mask, kmean, (float*)(ws + WS_UV + 48 * MiB), (unsigned*)(ws + WS_CTL) + 64 * l + 16, lds_raw);
    else if (PH == PH_ATTN) attn_fast_phase(WV_, P, mask, kmean, p.in[4] + l * 4, ys, (const unsigned*)(ws + WS_CTL) + 1024, (unsigned*)(ws + WS_CTL) + 64 * l, lds_raw);
    else if (PH == PH_MERGE) merge_fast_phase(WV_, ws + WS_G8, ys, (const bf16*)(ws + WS_WBR_T) + (size_t)l * 4 * 1024 * 256, mrg, lds_raw);
    else if (PH == PH_GOUT) {
        pg8::Gemm g{mrg, (const bf16*)(ws + WS_WOUT_T) + (size_t)l * 1024 * 1024, T_, 1024, 1024};
        pg8::StaticOrder S; S.init(T_, 1024, (int)LGRID(), (int)LBID());
        pg8::EpiResY E{l == 0 ? hin : nullptr, hb, hb, (float*)(ws + WS_STATS) + (size_t)l * T_ * 2, ALPHA};
        pg8::gemm_phase<pg8::EpiResY, pg8::StaticOrder, true, true>(WV_, (PG8_LAS unsigned char*)lds_raw, g, S, E);
    }
    else if (PH == PH_GQ) {
        pg8::Gemm g{hb, (const bf16*)(ws + WS_WQ_T) + (size_t)l * 1024 * 1024, T_, 1024, 1024};
        pg8::StaticOrder S; S.init(T_, 1024, (int)LGRID(), (int)LBID());
        pg8::EpiLnFold E{(bf16*)qb, (const float*)(ws + WS_STATS) + (size_t)l * T_ * 2, (const float*)(ws + WS_COLS) + l * 2048, (const float*)(ws + WS_COLS) + l * 2048 + 1024, LN_EPS};
        pg8::gemm_phase<pg8::EpiLnFold, pg8::StaticOrder, true, true>(WV_, (PG8_LAS unsigned char*)lds_raw, g, S, E);
        pg8::Unit u0;
        if (LGRID() == 256 && S.next(0, u0)) {
            asm volatile("s_waitcnt vmcnt(0)" ::: "memory"); __syncthreads();
            route_fast_phase(WV_, (const bf16*)qb, (const bf16*)(ws + WS_SKB) + (size_t)l * 8 * 2 * 128 * 64, eid, gate, lds_raw, u0.pm, u0.pn);
        }
    }
    else if (PH == PH_ROUTE) { if (LGRID() != 256) route_fast_phase(WV_, (const bf16*)qb, (const bf16*)(ws + WS_SKB) + (size_t)l * 8 * 2 * 128 * 64, eid, gate, lds_raw); }
    else peer_fast_phase(WV_, (l + 1 == DEPTH_) ? hbuf : nullptr, hb, eid, gate, ws + WS_UV + (size_t)l * 24 * MiB, p.in[5] + l * 1024, p.in[6] + l * 1024, p.in[11] + l * 1024, p.in[12] + l * 1024, lds_raw);
}

constexpr int CW_BAR = 4096;
constexpr int LDS_BARST = LDS_BYTES - 16;
__global__ void __launch_bounds__(NTHR, 2) mk_fwd(Params p) {
    extern __shared__ __attribute__((aligned(16))) unsigned char lds_raw[];
    cg::grid_group grid = cg::this_grid();
    const int WV_ = __builtin_amdgcn_readfirstlane((int)threadIdx.x >> 6);
    { volatile LAS unsigned* bst0 = (volatile LAS unsigned*)((LAS unsigned char*)lds_raw + LDS_BARST); if (threadIdx.x < 4) bst0[threadIdx.x] = 0u; }
    __syncthreads();
    volatile LAS unsigned* bst = (volatile LAS unsigned*)((LAS unsigned char*)lds_raw + LDS_BARST);
    { uint4* z = (uint4*)p.ws; const uint4 z4 = make_uint4(0u, 0u, 0u, 0u);
      for (unsigned i = (unsigned)LBID() * NTHR + (unsigned)LTID(WV_); i < (unsigned)(2 * MiB / 16); i += (unsigned)LGRID() * NTHR) z[i] = z4; }
    grid.sync();
    (void)xcd_barrier_post((unsigned*)(p.ws + WS_CTL) + CW_BAR, bst);
#define GRID_BAR() do { XcdBarrier b_; b_.bar = (unsigned*)(p.ws + WS_CTL) + CW_BAR; b_.x = xb_xcc_id(); b_.st = (volatile LAS unsigned*)((LAS unsigned char*)lds_raw + LDS_BARST); xcd_barrier(b_, WV_); } while (0)
    run_phase<PH_PRO>(WV_, p, 0, lds_raw);
    GRID_BAR();
#pragma unroll 1
    for (int l = 0; l < DEPTH_; ++l) {
        run_phase<PH_GIN>(WV_, p, l, lds_raw); GRID_BAR();
        run_phase<PH_INDEX>(WV_, p, l, lds_raw); GRID_BAR();
        run_phase<PH_ATTN>(WV_, p, l, lds_raw); GRID_BAR();
        run_phase<PH_MERGE>(WV_, p, l, lds_raw); GRID_BAR();
        run_phase<PH_GOUT>(WV_, p, l, lds_raw); GRID_BAR();
        run_phase<PH_GQ>(WV_, p, l, lds_raw); if (LGRID() != 256) { GRID_BAR(); run_phase<PH_ROUTE>(WV_, p, l, lds_raw); } GRID_BAR();
        run_phase<PH_PEER>(WV_, p, l, lds_raw); if (l + 1 < DEPTH_) GRID_BAR();
    }
}

extern "C" void kernel_launch(void* const* d_in, const int* in_sizes, int n_in, void* d_out, int out_size, void* d_ws, size_t ws_size, hipStream_t stream) {
    if (n_in != 13 || ws_size < WS_END) { fprintf(stderr, "kernel_launch: unexpected n_in %d / ws_size %zu; nothing launched\n", n_in, ws_size); return; }
    static int grid_blocks = 0;
    if (grid_blocks == 0) {
        int dev = 0, cus = 0, per_cu = 0;
        (void)hipGetDevice(&dev);
        (void)hipDeviceGetAttribute(&cus, hipDeviceAttributeMultiprocessorCount, dev);
        (void)hipFuncSetAttribute((const void*)mk_fwd, hipFuncAttributeMaxDynamicSharedMemorySize, LDS_BYTES);
        (void)hipOccupancyMaxActiveBlocksPerMultiprocessor(&per_cu, (const void*)mk_fwd, NTHR, LDS_BYTES);
        if (per_cu < 1) fprintf(stderr, "kernel_launch: occupancy query reports %d\n", per_cu);
        grid_blocks = cus;
    }
    Params p{};
    for (int i = 0; i < 13; ++i) p.in[i] = (const float*)d_in[i];
    p.out = (float*)d_out; p.ws = (unsigned char*)d_ws;
    void* args[] = {&p};
    hipError_t e = hipLaunchCooperativeKernel((const void*)mk_fwd, dim3(grid_blocks), dim3(NTHR), args, LDS_BYTES, stream);
    if (e != hipSuccess) fprintf(stderr, "cooperative launch failed: %s (grid %d)\n", hipGetErrorString(e), grid_blocks);
}
```

```cpp
#include <hip/hip_runtime.h>
#include <cstdio>
#include <cstdint>
#include <hip/hip_cooperative_groups.h>
namespace cg = cooperative_groups;

__device__ __forceinline__ int LANEID() { int l; asm volatile("v_mbcnt_lo_u32_b32 %0, -1, 0\n\tv_mbcnt_hi_u32_b32 %0, -1, %0" : "=v"(l)); return l; }
__device__ __forceinline__ int LTID(int wv) { return (wv << 6) | LANEID(); }
__device__ __forceinline__ int LBID() { int t = blockIdx.x; asm volatile("" : "+s"(t)); return t; }
__device__ __forceinline__ int LGRID() { int t = gridDim.x; asm volatile("" : "+s"(t)); return t; }
namespace pg8 {
#define PG8_LAS __attribute__((address_space(3)))
typedef unsigned short bf16_t;
typedef short bf16x8 __attribute__((ext_vector_type(8)));
typedef float f32x4 __attribute__((ext_vector_type(4)));
typedef unsigned u32x4 __attribute__((ext_vector_type(4)));
constexpr int BM = 256, BK = 64, HALF = 128, HTB = HALF * BK * 2  , STAGE_BYTES = 8 * HTB, NXCD = 8, WGM = 8;

__host__ __device__ __forceinline__ int lds_byte(int r, int c) { const int st = (r >> 4) * 2 + (c >> 5), rr = r & 15, cc = c & 31, ob = rr * 64 + cc * 2; return st * 1024 + (ob ^ (((ob >> 9) & 1) << 5)); }
__host__ __device__ __forceinline__ void stage_rc(int b, int& R, int& C) { const int st = b / 1024, sb = b % 1024, swz = sb ^ (((sb >> 9) & 1) << 5); R = (st >> 1) * 16 + swz / 64; C = (st & 1) * 32 + (swz % 64) / 2; }
__host__ __device__ __forceinline__ int perm32(int rho) { const int n = rho >> 4, i = rho & 15; return 8 * (i >> 2) + 4 * n + (i & 3); }

struct Unit { int pm, pn; };
struct Gemm { const bf16_t* A; const bf16_t* Bt; int M, N, K; };

struct StaticOrder {
    int nM, nN, nwg, G, c;
    __host__ __device__ void init(int M, int N, int G_, int c_) { nM = M / BM; nN = N / BM; nwg = nM * nN; G = G_; c = c_; }
    __host__ __device__ bool next(int i, Unit& u) const {
        const long L = (long)i * G + c; if (L >= nwg) return false;
        int wgid = (int)L; { const int q = nwg / NXCD, r = nwg % NXCD, xcd = wgid % NXCD, off = wgid / NXCD; wgid = (xcd < r ? xcd * (q + 1) : r * (q + 1) + (xcd - r) * q) + off; }
        const int nig = WGM * nN, gid = wgid / nig, fm = gid * WGM, gsz = (nM - fm) < WGM ? (nM - fm) : WGM;
        u.pm = fm + ((wgid % nig) % gsz); u.pn = (wgid % nig) / gsz; return true;
    }
    __device__ __forceinline__ void a_ready(const Unit&) const {}
    __device__ __forceinline__ void done(const Unit&) const {}
};

__device__ __forceinline__ unsigned cvt_pk_bf16(float lo, float hi) { unsigned r; asm volatile("v_cvt_pk_bf16_f32 %0, %1, %2" : "=v"(r) : "v"(lo), "v"(hi)); return r; }
typedef float f32x2 __attribute__((ext_vector_type(2)));
__device__ __forceinline__ f32x2 gelu_pk(f32x2 v) {
    const f32x2 av = __builtin_elementwise_abs(v), d = av * 0.2316418882f + 1.0f;
    f32x2 t; t.x = __builtin_amdgcn_rcpf(d.x); t.y = __builtin_amdgcn_rcpf(d.y);
    f32x2 q = t * 0.5307027145f + (-0.7265760135f); q = q * t + 0.7107068705f; q = q * t + (-0.142248368f); q = q * t + 0.127414796f; q = q * t;
    const f32x2 s = (v * v) * (-0.72134752044f);
    f32x2 e; e.x = __builtin_amdgcn_exp2f(s.x); e.y = __builtin_amdgcn_exp2f(s.y);
    const f32x2 m = v * (q * e), r = v - m;
    f32x2 o; o.x = v.x < 0.f ? m.x : r.x; o.y = v.y < 0.f ? m.y : r.y; return o;
}

template <int ACT  > struct EpiBf16 {
    static constexpr bool PERM = true, AFTER_DRAIN = false; static_assert(ACT == 0 || ACT == 1, "EpiBf16: ACT is 0 (none) or 1 (gelu_pk)");
    bf16_t* O; int ldc; const float* bias; int split_cols; size_t split_stride; float scale0;
    __device__ __forceinline__ void operator()(const f32x4 (&acc)[2][2][4][2], const Unit& u, int wr, int wc, int fr, int fq) const {
        { int ln_ = LANEID(); asm volatile("" : "+v"(ln_)); fr = ln_ & 15; fq = ln_ >> 4; }
        const int row0 = u.pm * BM + wr * 64 + fr; int colt = u.pn * BM; bf16_t* base = O;
        float sc = 1.f; if (split_cols) { const int t = colt / split_cols; base += (size_t)t * split_stride; colt -= t * split_cols; if (t == 0) sc = scale0; }
        const int col0 = colt + wc * 32 + 8 * fq, bcol0 = u.pn * BM + wc * 32 + 8 * fq;
        f32x4 bv[2][2];
#pragma unroll
        for (int bj = 0; bj < 2; ++bj)
#pragma unroll
            for (int n = 0; n < 2; ++n) bv[bj][n] = bias ? *(const f32x4*)(bias + bcol0 + bj * HALF + 4 * n) : (f32x4){0.f, 0.f, 0.f, 0.f};
#pragma unroll
        for (int ai = 0; ai < 2; ++ai)
#pragma unroll
            for (int m = 0; m < 4; ++m) { bf16_t* rowp = base + (size_t)(row0 + ai * HALF + m * 16) * ldc + col0;
#pragma unroll
                for (int bj = 0; bj < 2; ++bj) { f32x4 v0 = acc[ai][bj][m][0] + bv[bj][0], v1 = acc[ai][bj][m][1] + bv[bj][1];
                    if (ACT == 1) { f32x2 a = gelu_pk((f32x2){v0[0], v0[1]}), b = gelu_pk((f32x2){v0[2], v0[3]}), c = gelu_pk((f32x2){v1[0], v1[1]}), d = gelu_pk((f32x2){v1[2], v1[3]});
                        v0 = (f32x4){a.x, a.y, b.x, b.y}; v1 = (f32x4){c.x, c.y, d.x, d.y}; }
                    v0 = v0 * sc; v1 = v1 * sc; u32x4 w; w.x = cvt_pk_bf16(v0[0], v0[1]); w.y = cvt_pk_bf16(v0[2], v0[3]); w.z = cvt_pk_bf16(v1[0], v1[1]); w.w = cvt_pk_bf16(v1[2], v1[3]);
                    *(u32x4*)(rowp + bj * HALF) = w; } }
    }
};
template <class Epi, class Sched, bool ALIGN_EPI = false, bool SP2 = false>
__device__ __forceinline__ void gemm_phase(int WV_, PG8_LAS unsigned char* lds, const Gemm g, const Sched& S, const Epi& E) {
    const int tid = LTID(WV_), wid = __builtin_amdgcn_readfirstlane(tid >> 6), lane = tid & 63, wr = wid >> 2, wc = wid & 3, fr = lane & 15, fq = lane >> 4;
    const int K = g.K, nt = K / BK;
    unsigned voffA[2], voffB[2];
#pragma unroll
    for (int i = 0; i < 2; ++i) { int R, C; stage_rc(tid * 16 + i * 8192, R, C); const int Rb = Epi::PERM ? ((R & ~31) + perm32(R & 31)) : R;
        voffA[i] = (unsigned)(R * K + C) * 2u; voffB[i] = (unsigned)(Rb * K + C) * 2u; }
    const size_t kstep = (size_t)(BK * 2);
    const size_t hstep = (size_t)HALF * K * 2;
    const size_t tstep = 2 * hstep;
    const unsigned ldsw = (unsigned)wid * 1024u;
    const int aoff = lds_byte(wr * 64 + fr, fq * 8), boff = lds_byte(wc * 32 + fr, fq * 8);
#define PG8_SA(b, h) (((b) * 2 + (h)) * HTB)
#define PG8_SB(b, h) ((4 + (b) * 2 + (h)) * HTB)
#define PG8_STAGE(bufoff, gbase, voff) do { _Pragma("unroll") for (int _i = 0; _i < 2; ++_i) \
        __builtin_amdgcn_global_load_lds((const unsigned*)((const char*)(gbase) + (voff)[_i]), (PG8_LAS unsigned*)(lds + (bufoff) + ldsw + _i * 8192), 16, 0, 0); } while (0)
#define PG8_LDA(dst, b, h) do { _Pragma("unroll") for (int m = 0; m < 4; ++m) _Pragma("unroll") for (int k = 0; k < 2; ++k) dst[m][k] = *(const PG8_LAS bf16x8*)(lds + PG8_SA(b, h) + aoff + m * 2048 + k * 1024); } while (0)
#define PG8_LDB(dst, b, h) do { _Pragma("unroll") for (int n = 0; n < 2; ++n) _Pragma("unroll") for (int k = 0; k < 2; ++k) dst[n][k] = *(const PG8_LAS bf16x8*)(lds + PG8_SB(b, h) + boff + n * 2048 + k * 1024); } while (0)
#define PG8_MMA(ai, bj, At, Bt) do { __builtin_amdgcn_s_setprio(1); _Pragma("unroll") for (int m = 0; m < 4; ++m) _Pragma("unroll") for (int n = 0; n < 2; ++n) _Pragma("unroll") for (int k = 0; k < 2; ++k) \
        acc[ai][bj][m][n] = __builtin_amdgcn_mfma_f32_16x16x32_bf16(Bt[n][k], At[m][k], acc[ai][bj][m][n], 0, 0, 0); __builtin_amdgcn_s_setprio(0); } while (0)
#define PG8_WAIT_V(n) asm volatile("s_waitcnt vmcnt(" #n ")" ::: "memory")
#define PG8_WAIT_L(n) asm volatile("s_waitcnt lgkmcnt(" #n ")" ::: "memory")
#define PG8_BAR __builtin_amdgcn_s_barrier()
#define PG8_SCHED __builtin_amdgcn_sched_barrier(0)
    Unit cur, nxt; int ui = 0;
    if (!S.next(0, cur)) return;
    f32x4 acc[2][2][4][2];
#pragma unroll
    for (int a = 0; a < 2; ++a)
#pragma unroll
        for (int b = 0; b < 2; ++b)
#pragma unroll
            for (int m = 0; m < 4; ++m)
#pragma unroll
                for (int n = 0; n < 2; ++n) acc[a][b][m][n] = (f32x4){0.f, 0.f, 0.f, 0.f};
    bf16x8 At[4][2], B0[2][2], B1[2][2];
    const char* cA = (const char*)g.A + (size_t)cur.pm * tstep; const char* cB = (const char*)g.Bt + (size_t)cur.pn * tstep;
    S.a_ready(cur);
    if constexpr (SP2) {
        PG8_STAGE(PG8_SB(0, 0), cB, voffB); PG8_STAGE(PG8_SB(0, 1), cB + hstep, voffB); PG8_STAGE(PG8_SA(0, 0), cA, voffA); PG8_STAGE(PG8_SA(0, 1), cA + hstep, voffA);
        if (wr == 1) PG8_BAR;
        PG8_WAIT_V(2); PG8_BAR;
        PG8_STAGE(PG8_SB(1, 0), cB + kstep, voffB); PG8_STAGE(PG8_SA(1, 0), cA + kstep, voffA); PG8_STAGE(PG8_SB(1, 1), cB + hstep + kstep, voffB);
        PG8_WAIT_V(6); PG8_BAR;
    } else {
        PG8_STAGE(PG8_SB(0, 0), cB, voffB); PG8_STAGE(PG8_SA(0, 0), cA, voffA); PG8_STAGE(PG8_SB(0, 1), cB + hstep, voffB); PG8_STAGE(PG8_SA(0, 1), cA + hstep, voffA);
        if (wr == 1) PG8_BAR;
        PG8_WAIT_V(4); PG8_BAR;
        PG8_STAGE(PG8_SB(1, 0), cB + kstep, voffB); PG8_STAGE(PG8_SA(1, 0), cA + kstep, voffA); PG8_STAGE(PG8_SB(1, 1), cB + hstep + kstep, voffB);
        PG8_WAIT_V(6); PG8_BAR;
    }
    for (;;) {
        const bool has_next = S.next(ui + 1, nxt);
        const char* nA = has_next ? (const char*)g.A + (size_t)nxt.pm * tstep : cA; const char* nB = has_next ? (const char*)g.Bt + (size_t)nxt.pn * tstep : cB;
        for (int t = 0; t < nt; t += 2) {
            const bool last = (t == nt - 2);
            const char* a1 = cA + (size_t)(t + 1) * kstep;
            const char* a2 = last ? nA : cA + (size_t)(t + 2) * kstep; const char* b2 = last ? nB : cB + (size_t)(t + 2) * kstep;
            const char* a3 = a2 + kstep; const char* b3 = b2 + kstep;
            if (last && has_next) S.a_ready(nxt);
            if constexpr (SP2) {
            PG8_LDB(B0, 0, 0); PG8_LDB(B1, 0, 1); PG8_SCHED; PG8_LDA(At, 0, 0); PG8_STAGE(PG8_SA(1, 1), a1 + hstep, voffA);
            PG8_WAIT_V(8); PG8_WAIT_L(0); PG8_BAR; PG8_MMA(0, 0, At, B0); PG8_MMA(0, 1, At, B1); PG8_BAR; PG8_SCHED;
            PG8_LDA(At, 0, 1); PG8_STAGE(PG8_SB(0, 0), b2, voffB); PG8_STAGE(PG8_SB(0, 1), b2 + hstep, voffB); PG8_STAGE(PG8_SA(0, 0), a2, voffA);
            PG8_WAIT_V(8); PG8_WAIT_L(0); PG8_BAR; PG8_MMA(1, 0, At, B0); PG8_MMA(1, 1, At, B1); PG8_BAR; PG8_SCHED;
            PG8_LDB(B0, 1, 0); PG8_LDB(B1, 1, 1); PG8_SCHED; PG8_LDA(At, 1, 0); PG8_STAGE(PG8_SA(0, 1), a2 + hstep, voffA);
            PG8_WAIT_V(8); PG8_WAIT_L(0); PG8_BAR; PG8_MMA(0, 0, At, B0); PG8_MMA(0, 1, At, B1); PG8_BAR; PG8_SCHED;
            PG8_LDA(At, 1, 1); PG8_STAGE(PG8_SB(1, 0), b3, voffB); PG8_STAGE(PG8_SB(1, 1), b3 + hstep, voffB); PG8_STAGE(PG8_SA(1, 0), a3, voffA);
            PG8_WAIT_V(8); PG8_WAIT_L(0); PG8_BAR; PG8_MMA(1, 0, At, B0); PG8_MMA(1, 1, At, B1); PG8_BAR; PG8_SCHED;
            } else {
            PG8_LDB(B0, 0, 0); PG8_SCHED; PG8_LDA(At, 0, 0); PG8_STAGE(PG8_SA(1, 1), a1 + hstep, voffA);
            PG8_WAIT_L(8); PG8_BAR; PG8_WAIT_L(0); PG8_MMA(0, 0, At, B0); PG8_BAR; PG8_SCHED;
            PG8_LDB(B1, 0, 1); PG8_STAGE(PG8_SB(0, 0), b2, voffB);
            PG8_BAR; PG8_WAIT_L(0); PG8_MMA(0, 1, At, B1); PG8_BAR;
            PG8_LDA(At, 0, 1); PG8_STAGE(PG8_SA(0, 0), a2, voffA);
            PG8_BAR; PG8_WAIT_L(0); PG8_MMA(1, 0, At, B0); PG8_BAR; PG8_SCHED;
            PG8_STAGE(PG8_SB(0, 1), b2 + hstep, voffB);
            PG8_WAIT_V(6); PG8_BAR; PG8_MMA(1, 1, At, B1); PG8_BAR;
            PG8_LDB(B0, 1, 0); PG8_SCHED; PG8_LDA(At, 1, 0); PG8_STAGE(PG8_SA(0, 1), a2 + hstep, voffA);
            PG8_WAIT_L(8); PG8_BAR; PG8_WAIT_L(0); PG8_MMA(0, 0, At, B0); PG8_BAR; PG8_SCHED;
            PG8_LDB(B1, 1, 1); PG8_STAGE(PG8_SB(1, 0), b3, voffB);
            PG8_BAR; PG8_WAIT_L(0); PG8_MMA(0, 1, At, B1); PG8_BAR;
            PG8_LDA(At, 1, 1); PG8_STAGE(PG8_SA(1, 0), a3, voffA);
            PG8_BAR; PG8_WAIT_L(0); PG8_MMA(1, 0, At, B0); PG8_BAR; PG8_SCHED;
            PG8_STAGE(PG8_SB(1, 1), b3 + hstep, voffB);
            PG8_WAIT_V(6); PG8_BAR; PG8_MMA(1, 1, At, B1); PG8_BAR;
            }
        }
        if constexpr (ALIGN_EPI) { if (wr == 0) PG8_BAR; }
        if constexpr (!Epi::AFTER_DRAIN) { E(acc, cur, wr, wc, fr, fq); S.done(cur); }
        if (!has_next) break;
#pragma unroll
        for (int a = 0; a < 2; ++a)
#pragma unroll
            for (int b = 0; b < 2; ++b)
#pragma unroll
                for (int m = 0; m < 4; ++m)
#pragma unroll
                    for (int n = 0; n < 2; ++n) acc[a][b][m][n] = (f32x4){0.f, 0.f, 0.f, 0.f};
        cur = nxt; cA = nA; cB = nB; ++ui;
        if constexpr (ALIGN_EPI) { if (wr == 1) PG8_BAR; }
    }
    PG8_WAIT_V(0);
    if constexpr (!ALIGN_EPI) { if (wr == 0) PG8_BAR; }
    PG8_BAR;
    if constexpr (Epi::AFTER_DRAIN) { E.fused(acc, cur, wr, wc, fr, fq, lds, wid, lane); S.done(cur); }
#undef PG8_SA
#undef PG8_SB
#undef PG8_STAGE
#undef PG8_LDA
#undef PG8_LDB
#undef PG8_MMA
#undef PG8_WAIT_V
#undef PG8_WAIT_L
#undef PG8_BAR
#undef PG8_SCHED
}
}
namespace pg8 {
struct EpiF32 {
    static constexpr bool PERM = false, AFTER_DRAIN = false;
    float* O; int ldc;
    __device__ __forceinline__ void operator()(const f32x4 (&acc)[2][2][4][2], const Unit& u, int wr, int wc, int fr, int fq) const {
        { int ln_ = LANEID(); asm volatile("" : "+v"(ln_)); fr = ln_ & 15; fq = ln_ >> 4; }
        const int row0 = u.pm * BM + wr * 64 + fr, col0 = u.pn * BM + wc * 32 + 4 * fq;
#pragma unroll
        for (int ai = 0; ai < 2; ++ai)
#pragma unroll
            for (int m = 0; m < 4; ++m) { float* rowp = O + (size_t)(row0 + ai * HALF + m * 16) * ldc + col0;
#pragma unroll
                for (int bj = 0; bj < 2; ++bj)
#pragma unroll
                    for (int n = 0; n < 2; ++n) *(f32x4*)(rowp + bj * HALF + n * 16) = acc[ai][bj][m][n]; }
    }
};
struct EpiResY {
    static constexpr bool PERM = false, AFTER_DRAIN = false;
    const float* hin; const bf16_t* hinb; bf16_t* yb; float* stats; float alpha;
    __device__ __forceinline__ void operator()(const f32x4 (&acc)[2][2][4][2], const Unit& u, int wr, int wc, int fr, int fq) const {
        { int ln_ = LANEID(); asm volatile("" : "+v"(ln_)); fr = ln_ & 15; fq = ln_ >> 4; }
        const int row0 = u.pm * BM + wr * 64 + fr, col0 = u.pn * BM + wc * 32 + 4 * fq;
#pragma unroll
        for (int ai = 0; ai < 2; ++ai)
#pragma unroll
            for (int m = 0; m < 4; ++m) {
                const int row = row0 + ai * HALF + m * 16;
                float s = 0.f, s2 = 0.f;
#pragma unroll
                for (int bj = 0; bj < 2; ++bj)
#pragma unroll
                    for (int n = 0; n < 2; ++n) {
                        const size_t off = (size_t)row * 1024 + col0 + bj * HALF + n * 16;
                        f32x4 hv;
                        if (hin) hv = *(const f32x4*)(hin + off);
                        else { typedef unsigned u32x2r __attribute__((ext_vector_type(2))); const u32x2r hw = *(const u32x2r*)(hinb + off);
                            hv[0] = __uint_as_float(hw.x << 16); hv[1] = __uint_as_float(hw.x & 0xffff0000u); hv[2] = __uint_as_float(hw.y << 16); hv[3] = __uint_as_float(hw.y & 0xffff0000u); }
                        const f32x4 y = hv * alpha + acc[ai][bj][m][n];
                        typedef unsigned u32x2v __attribute__((ext_vector_type(2)));
                        u32x2v w; w.x = cvt_pk_bf16(y[0], y[1]); w.y = cvt_pk_bf16(y[2], y[3]);
                        *(u32x2v*)(yb + off) = w;
                        s += (y[0] + y[1]) + (y[2] + y[3]); s2 += (y[0] * y[0] + y[1] * y[1]) + (y[2] * y[2] + y[3] * y[3]);
                    }
                s += __shfl_xor(s, 16); s += __shfl_xor(s, 32); s2 += __shfl_xor(s2, 16); s2 += __shfl_xor(s2, 32);
                if (fq == 0) { atomicAdd(stats + 2 * (size_t)row, s); atomicAdd(stats + 2 * (size_t)row + 1, s2); }
            }
    }
};
struct EpiLnFold {
    static constexpr bool PERM = true, AFTER_DRAIN = false;
    bf16_t* O; const float* stats; const float* colsum; const float* colbias; float eps;
    __device__ __forceinline__ void operator()(const f32x4 (&acc)[2][2][4][2], const Unit& u, int wr, int wc, int fr, int fq) const {
        { int ln_ = LANEID(); asm volatile("" : "+v"(ln_)); fr = ln_ & 15; fq = ln_ >> 4; }
        const int row0 = u.pm * BM + wr * 64 + fr, col0 = u.pn * BM + wc * 32 + 8 * fq;
        f32x4 cs[2][2], cb[2][2];
#pragma unroll
        for (int bj = 0; bj < 2; ++bj)
#pragma unroll
            for (int n = 0; n < 2; ++n) { cs[bj][n] = *(const f32x4*)(colsum + col0 + bj * HALF + 4 * n); cb[bj][n] = *(const f32x4*)(colbias + col0 + bj * HALF + 4 * n); }
#pragma unroll
        for (int ai = 0; ai < 2; ++ai)
#pragma unroll
            for (int m = 0; m < 4; ++m) {
                const int row = row0 + ai * HALF + m * 16;
                const float sm_ = stats[2 * (size_t)row], sq_ = stats[2 * (size_t)row + 1];
                const float mean = sm_ * (1.0f / 1024.0f);
                const float rstd = 1.0f / sqrtf(fmaxf(sq_ * (1.0f / 1024.0f) - mean * mean, 0.f) + eps);
                bf16_t* rowp = O + (size_t)row * 1024 + col0;
#pragma unroll
                for (int bj = 0; bj < 2; ++bj) {
                    const f32x4 v0 = (acc[ai][bj][m][0] - cs[bj][0] * mean) * rstd + cb[bj][0], v1 = (acc[ai][bj][m][1] - cs[bj][1] * mean) * rstd + cb[bj][1];
                    u32x4 w; w.x = cvt_pk_bf16(v0[0], v0[1]); w.y = cvt_pk_bf16(v0[2], v0[3]); w.z = cvt_pk_bf16(v1[0], v1[1]); w.w = cvt_pk_bf16(v1[2], v1[3]);
                    *(u32x4*)(rowp + bj * HALF) = w;
                }
            }
    }
};
__device__ __forceinline__ unsigned cvt_pk_bf16_t(float lo, float hi) { unsigned r; asm volatile("s_nop 0\n\tv_cvt_pk_bf16_f32 %0, %1, %2" : "=v"(r) : "v"(lo), "v"(hi)); return r; }
struct EpiBf16Sig {
    static constexpr bool PERM = true, AFTER_DRAIN = false;
    bf16_t* O; int ldc; int sig_col0; unsigned char* G8;
    __device__ __forceinline__ void operator()(const f32x4 (&acc)[2][2][4][2], const Unit& u, int wr, int wc, int fr, int fq) const {
        { int ln_ = LANEID(); asm volatile("" : "+v"(ln_)); fr = ln_ & 15; fq = ln_ >> 4; }
        const int row0 = u.pm * BM + wr * 64 + fr; const int col0 = u.pn * BM + wc * 32 + 8 * fq;
#pragma unroll
        for (int bj = 0; bj < 2; ++bj) {
            if (col0 + bj * HALF >= sig_col0) {
                { const int gc = col0 + bj * HALF - sig_col0;
                  if (gc < 4096) {
#pragma unroll
                    for (int ai = 0; ai < 2; ++ai)
#pragma unroll
                        for (int m = 0; m < 4; ++m) {
                            f32x4 v0 = acc[ai][bj][m][0], v1 = acc[ai][bj][m][1];
#pragma unroll
                            for (int e = 0; e < 4; ++e) { v0[e] = __builtin_amdgcn_rcpf(1.f + __builtin_amdgcn_exp2f(-1.44269504f * v0[e])); v1[e] = __builtin_amdgcn_rcpf(1.f + __builtin_amdgcn_exp2f(-1.44269504f * v1[e])); }
                            int w0 = __builtin_amdgcn_cvt_pk_fp8_f32(v0[0], v0[1], 0, false); w0 = __builtin_amdgcn_cvt_pk_fp8_f32(v0[2], v0[3], w0, true);
                            int w1 = __builtin_amdgcn_cvt_pk_fp8_f32(v1[0], v1[1], 0, false); w1 = __builtin_amdgcn_cvt_pk_fp8_f32(v1[2], v1[3], w1, true);
                            typedef int i32x2v __attribute__((ext_vector_type(2)));
                            i32x2v w; w.x = w0; w.y = w1;
                            *(i32x2v*)(G8 + (size_t)(row0 + ai * HALF + m * 16) * 4096 + gc) = w; }
                  } }
            } else {
#pragma unroll
                for (int ai = 0; ai < 2; ++ai)
#pragma unroll
                    for (int m = 0; m < 4; ++m) { bf16_t* rowp = O + (size_t)(row0 + ai * HALF + m * 16) * ldc + col0;
                        const f32x4 v0 = acc[ai][bj][m][0], v1 = acc[ai][bj][m][1];
                        u32x4 w; w.x = cvt_pk_bf16(v0[0], v0[1]); w.y = cvt_pk_bf16(v0[2], v0[3]); w.z = cvt_pk_bf16(v1[0], v1[1]); w.w = cvt_pk_bf16(v1[2], v1[3]);
                        *(u32x4*)(rowp + bj * HALF) = w; }
            }
        }
    }
};
}

typedef unsigned short bf16;
constexpr int T_ = 16384, S_ = 4096, NBATCH = 4, D_ = 1024, NCOL = 6824, NP = 6912, DEPTH_ = 2;
constexpr int C_QA = 0, C_KA = 256, C_VA = 320, C_QI = 384, C_KI = 640, C_WI = 672, C_QB = 680, C_KB = 936, C_VB = 1064,
              C_QC = 1192, C_KC = 1448, C_VC = 1704, C_QD = 1960, C_KD = 2216, C_VD = 2472, C_G = 2728;
constexpr int NTHR = 512, NWAVE = 8;
constexpr float ALPHA = 1.41421356237309515f;
constexpr float LN_EPS = 1e-5f;
constexpr size_t MiB = 1u << 20;
constexpr size_t WS_STATS = 1 * MiB  , WS_COLS = 1 * MiB + 512 * 1024  ;
constexpr size_t WS_CTL = 0, WS_WIN_T = 2 * MiB, WS_WOUT_T = 30 * MiB, WS_WQ_T = 34 * MiB, WS_WBR_T = 38 * MiB, WS_HB = 42 * MiB,
                 WS_P = 74 * MiB, WS_MIX = 74 * MiB  , WS_Q = 138 * MiB  , WS_G8 = 428 * MiB  , WS_YS = 290 * MiB, WS_MRG = 322 * MiB,
                 WS_MASK = 354 * MiB, WS_EID = 362 * MiB, WS_GATE = 370 * MiB, WS_KMEAN = 378 * MiB, WS_SKB = 379 * MiB, WS_UV = 380 * MiB, WS_END = 508 * MiB;
constexpr size_t WIN_T_BYTES = (size_t)NP * 1024 * 2;
constexpr int LDS_BYTES = 144 * 1024;

struct Params { const float* in[13]; float* out; unsigned char* ws; };

__device__ __forceinline__ float bf2f(bf16 v) { return __uint_as_float((unsigned)v << 16); }
__device__ __forceinline__ unsigned f2bf(float f) { unsigned u = __float_as_uint(f); return (u + 0x7fffu + ((u >> 16) & 1u)) >> 16; }
__device__ __forceinline__ unsigned pk2(float lo, float hi) { return f2bf(lo) | (f2bf(hi) << 16); }
__device__ __forceinline__ void unpack8(const uint4 v, float* o) {
    o[0] = __uint_as_float(v.x << 16); o[1] = __uint_as_float(v.x & 0xffff0000u); o[2] = __uint_as_float(v.y << 16); o[3] = __uint_as_float(v.y & 0xffff0000u);
    o[4] = __uint_as_float(v.z << 16); o[5] = __uint_as_float(v.z & 0xffff0000u); o[6] = __uint_as_float(v.w << 16); o[7] = __uint_as_float(v.w & 0xffff0000u);
}
__device__ __forceinline__ float wave_sum(float v) {
#pragma unroll
    for (int o = 32; o > 0; o >>= 1) v += __shfl_xor(v, o);
    return v;
}
__device__ __forceinline__ float wave_max(float v) {
#pragma unroll
    for (int o = 32; o > 0; o >>= 1) v = fmaxf(v, __shfl_xor(v, o));
    return v;
}
__device__ __forceinline__ int wave_sum_i(int v) {
#pragma unroll
    for (int o = 32; o > 0; o >>= 1) v += __shfl_xor(v, o);
    return v;
}
__device__ __forceinline__ float logsig(float x) { return fminf(x, 0.f) - log1pf(expf(-fabsf(x))); }

__device__ void transpose_items(int WV_, const float* W, int K, int N, bf16* WT, float* sm, int item0, int nitems_total, int item_stride,
                                const float* rs_g = nullptr, const float* rs_b = nullptr, float* colsum = nullptr, float* colbias = nullptr) {
    const int tid = LTID(WV_);
    const int nkb = K / 64, nnb = (N + 63) / 64;
    for (int it = item0; it < nkb * nnb; it += item_stride) {
        const int kb = it % nkb, nb = it / nkb, k0 = kb * 64, n0 = nb * 64;
        __syncthreads();
        for (int e = tid; e < 64 * 64; e += NTHR) { const int kk = e >> 6, nn = e & 63; sm[kk * 65 + nn] = (n0 + nn < N) ? W[(size_t)(k0 + kk) * N + n0 + nn] : 0.f; }
        __syncthreads();
        if (rs_g) {
            if (tid < 64) { float cs = 0.f, cb = 0.f;
                for (int kk = 0; kk < 64; ++kk) { const float w = sm[kk * 65 + tid]; cs += w * rs_g[k0 + kk]; cb += w * rs_b[k0 + kk]; }
                atomicAdd(colsum + n0 + tid, cs); atomicAdd(colbias + n0 + tid, cb); }
            __syncthreads();
            for (int e = tid; e < 64 * 64; e += NTHR) { const int kk = e >> 6, nn = e & 63; sm[kk * 65 + nn] *= rs_g[k0 + kk]; }
            __syncthreads();
        }
        { const int nn = tid >> 3, c = tid & 7;
          if (n0 + nn < N) { uint4 o; o.x = pk2(sm[(8 * c + 0) * 65 + nn], sm[(8 * c + 1) * 65 + nn]); o.y = pk2(sm[(8 * c + 2) * 65 + nn], sm[(8 * c + 3) * 65 + nn]);
              o.z = pk2(sm[(8 * c + 4) * 65 + nn], sm[(8 * c + 5) * 65 + nn]); o.w = pk2(sm[(8 * c + 6) * 65 + nn], sm[(8 * c + 7) * 65 + nn]);
              *(uint4*)(WT + (size_t)(n0 + nn) * K + k0 + 8 * c) = o; } }
    }
    __syncthreads();
}
constexpr int TI_WIN = 16 * ((NCOL + 63) / 64), TI_SQ = 256, TI_LAYER = TI_WIN + 3 * TI_SQ;
#define TITEM_DECODE(it_, W_, WT_, K_, N_, k0_, n0_, fold_, l_) do { \
        l_ = (it_) / TI_LAYER; const int r_ = (it_) - l_ * TI_LAYER; \
        const int kind_ = r_ < TI_WIN ? 0 : (r_ < TI_WIN + TI_SQ ? 1 : (r_ < TI_WIN + 2 * TI_SQ ? 2 : 3)); \
        const int q_ = r_ - (kind_ == 0 ? 0 : TI_WIN + (kind_ - 1) * TI_SQ); \
        fold_ = kind_ == 2; K_ = kind_ == 3 ? 256 : 1024; N_ = kind_ == 0 ? NCOL : 1024; \
        k0_ = kind_ == 3 ? (q_ & 3) * 64 : (q_ & 15) * 64; n0_ = kind_ == 3 ? ((q_ & 63) >> 2) * 64 : (q_ >> 4) * 64; \
        const int nbr_ = q_ >> 6; \
        W_ = kind_ == 0 ? pin1 + (size_t)l_ * 1024 * NCOL : kind_ == 1 ? pin3 + (size_t)l_ * 1024 * 1024 : kind_ == 2 ? pin7 + (size_t)l_ * 1024 * 1024 : pin2 + ((size_t)l_ * 4 + nbr_) * 256 * 1024; \
        WT_ = kind_ == 0 ? (bf16*)(ws + WS_WIN_T + l_ * WIN_T_BYTES) : kind_ == 1 ? (bf16*)(ws + WS_WOUT_T) + (size_t)l_ * 1024 * 1024 : kind_ == 2 ? (bf16*)(ws + WS_WQ_T) + (size_t)l_ * 1024 * 1024 \
              : (bf16*)(ws + WS_WBR_T) + ((size_t)l_ * 4 + nbr_) * 1024 * 256; } while (0)
__device__ __forceinline__ void titem_finish(bf16* WT, int K, int N, int k0, int n0, const float* rs_g, const float* rs_b, float* colsum, float* colbias, float* sm, int tid) {
    if (rs_g) {
        if (tid < 64) { float cs = 0.f, cb = 0.f;
            for (int kk = 0; kk < 64; ++kk) { const float w = sm[kk * 65 + tid]; cs += w * rs_g[k0 + kk]; cb += w * rs_b[k0 + kk]; }
            atomicAdd(colsum + n0 + tid, cs); atomicAdd(colbias + n0 + tid, cb); }
        __syncthreads();
        for (int e = tid; e < 64 * 64; e += NTHR) { const int kk = e >> 6, nn = e & 63; sm[kk * 65 + nn] *= rs_g[k0 + kk]; }
        __syncthreads();
    }
    { const int nn = tid >> 3, c = tid & 7;
      if (n0 + nn < N) { uint4 o; o.x = pk2(sm[(8 * c + 0) * 65 + nn], sm[(8 * c + 1) * 65 + nn]); o.y = pk2(sm[(8 * c + 2) * 65 + nn], sm[(8 * c + 3) * 65 + nn]);
          o.z = pk2(sm[(8 * c + 4) * 65 + nn], sm[(8 * c + 5) * 65 + nn]); o.w = pk2(sm[(8 * c + 6) * 65 + nn], sm[(8 * c + 7) * 65 + nn]);
          *(uint4*)(WT + (size_t)(n0 + nn) * K + k0 + 8 * c) = o; } }
}
__device__ void prologue_phase(int WV_, const Params& p, float* sm) {
    const int tid = LTID(WV_), B = LBID(), G = LGRID();
    unsigned char* ws = p.ws;
    float* sm1 = sm + 64 * 65;
    const float* pin1 = p.in[1]; const float* pin2 = p.in[2]; const float* pin3 = p.in[3]; const float* pin7 = p.in[7]; const float* pin5 = p.in[5]; const float* pin6 = p.in[6];
    asm volatile("" : "+s"(pin1), "+s"(pin2), "+s"(pin3), "+s"(pin7), "+s"(pin5), "+s"(pin6));
    const int kk0 = tid >> 4, c4 = tid & 15;
    for (int it = B; it < DEPTH_ * TI_LAYER; it += 2 * G) {
        const int it2 = it + G; const bool has2 = it2 < DEPTH_ * TI_LAYER;
        const float* Wa; const float* Wb; bf16* WTa; bf16* WTb; int Ka, Na, k0a, n0a, la, Kb, Nb, k0b, n0b, lb; bool fa, fb;
        TITEM_DECODE(it, Wa, WTa, Ka, Na, k0a, n0a, fa, la);
        { const int itb = has2 ? it2 : it; TITEM_DECODE(itb, Wb, WTb, Kb, Nb, k0b, n0b, fb, lb); }
        const float4 z4 = make_float4(0.f, 0.f, 0.f, 0.f);
        const bool ina = n0a + 4 * c4 < Na, inb = n0b + 4 * c4 < Nb;
        float4 a0 = z4, a1 = z4, b0 = z4, b1 = z4;
        if (ina) { a0 = *(const float4*)(Wa + (size_t)(k0a + kk0) * Na + n0a + 4 * c4); a1 = *(const float4*)(Wa + (size_t)(k0a + kk0 + 32) * Na + n0a + 4 * c4); }
        if (inb) { b0 = *(const float4*)(Wb + (size_t)(k0b + kk0) * Nb + n0b + 4 * c4); b1 = *(const float4*)(Wb + (size_t)(k0b + kk0 + 32) * Nb + n0b + 4 * c4); }
        __syncthreads();
        { float* d = sm + kk0 * 65 + 4 * c4; d[0] = a0.x; d[1] = a0.y; d[2] = a0.z; d[3] = a0.w; d += 32 * 65; d[0] = a1.x; d[1] = a1.y; d[2] = a1.z; d[3] = a1.w; }
        { float* d = sm1 + kk0 * 65 + 4 * c4; d[0] = b0.x; d[1] = b0.y; d[2] = b0.z; d[3] = b0.w; d += 32 * 65; d[0] = b1.x; d[1] = b1.y; d[2] = b1.z; d[3] = b1.w; }
        __syncthreads();
        titem_finish(WTa, Ka, Na, k0a, n0a, fa ? pin5 + la * 1024 : nullptr, pin6 + la * 1024, (float*)(ws + WS_COLS) + la * 2048, (float*)(ws + WS_COLS) + la * 2048 + 1024, sm, tid);
        if (has2) titem_finish(WTb, Kb, Nb, k0b, n0b, fb ? pin5 + lb * 1024 : nullptr, pin6 + lb * 1024, (float*)(ws + WS_COLS) + lb * 2048, (float*)(ws + WS_COLS) + lb * 2048 + 1024, sm1, tid);
    }
    __syncthreads();
    for (int l = 0; l < DEPTH_; ++l) {
        bf16* win_t = (bf16*)(ws + WS_WIN_T + l * WIN_T_BYTES);
        for (int i = B * NTHR + tid; i < (NP - NCOL) * 1024 / 8; i += G * NTHR) ((uint4*)(win_t + (size_t)NCOL * 1024))[i] = make_uint4(0u, 0u, 0u, 0u);
    }
    const float4* x4 = (const float4*)p.in[0]; uint2* hb2 = (uint2*)(ws + WS_HB);
    for (size_t i = (size_t)B * NTHR + tid; i < (size_t)T_ * 1024 / 4; i += (size_t)G * NTHR) { const float4 v = x4[i]; hb2[i] = make_uint2(pk2(v.x, v.y), pk2(v.z, v.w)); }
}

__device__ __forceinline__ void ln_row(float4 (&v)[4], const float* g, const float* bb, float* orow, bf16* obrow, int lane) {
    float s = 0.f;
#pragma unroll
    for (int j = 0; j < 4; ++j) s += (v[j].x + v[j].y) + (v[j].z + v[j].w);
    const float mean = wave_sum(s) * (1.0f / 1024.0f);
    float s2 = 0.f;
#pragma unroll
    for (int j = 0; j < 4; ++j) { v[j].x -= mean; v[j].y -= mean; v[j].z -= mean; v[j].w -= mean; s2 += (v[j].x * v[j].x + v[j].y * v[j].y) + (v[j].z * v[j].z + v[j].w * v[j].w); }
    const float rstd = 1.0f / sqrtf(wave_sum(s2) * (1.0f / 1024.0f) + LN_EPS);
#pragma unroll
    for (int j = 0; j < 4; ++j) {
        const float4 gg = ((const float4*)g)[j * 64 + lane], b4 = ((const float4*)bb)[j * 64 + lane];
        float4 o; o.x = v[j].x * rstd * gg.x + b4.x; o.y = v[j].y * rstd * gg.y + b4.y; o.z = v[j].z * rstd * gg.z + b4.z; o.w = v[j].w * rstd * gg.w + b4.w;
        ((float4*)orow)[j * 64 + lane] = o;
        ((uint2*)obrow)[j * 64 + lane] = make_uint2(pk2(o.x, o.y), pk2(o.z, o.w));
    }
}
__device__ void ln1_phase(int WV_, const float* hin, const float* add, const float* g, const float* bb, float* hout, bf16* hb) {
    const int lane = LTID(WV_) & 63, wave = LTID(WV_) >> 6;
    for (int row = LBID() * NWAVE + wave; row < T_; row += LGRID() * NWAVE) {
        float4 v[4];
#pragma unroll
        for (int j = 0; j < 4; ++j) {
            const float4 a = ((const float4*)(hin + (size_t)row * 1024))[j * 64 + lane], m = ((const float4*)(add + (size_t)row * 1024))[j * 64 + lane];
            v[j].x = ALPHA * a.x + m.x; v[j].y = ALPHA * a.y + m.y; v[j].z = ALPHA * a.z + m.z; v[j].w = ALPHA * a.w + m.w;
        }
        ln_row(v, g, bb, hout + (size_t)row * 1024, hb + (size_t)row * 1024, lane);
    }
}


typedef short bf16x8_t __attribute__((ext_vector_type(8)));
typedef float f32x16_t __attribute__((ext_vector_type(16)));
typedef float f32x2_t __attribute__((ext_vector_type(2)));
typedef __bf16 bf16x2_t __attribute__((ext_vector_type(2)));
__device__ __forceinline__ unsigned cvtpk(float lo, float hi) { f32x2_t v = {lo, hi}; bf16x2_t b = __builtin_convertvector(v, bf16x2_t); return __builtin_bit_cast(unsigned, b); }
__device__ __forceinline__ int crow(int r, int hi) { return (r & 3) + 8 * (r >> 2) + 4 * hi; }
__device__ __forceinline__ float xlane32(float v) { return __shfl_xor(v, 32); }
__device__ __forceinline__ float vmax(float a, float b) { float r; asm("v_max_f32_e32 %0, %1, %2" : "=v"(r) : "v"(a), "v"(b)); return r; }
__device__ __forceinline__ float vmin(float a, float b) { float r; asm("v_min_f32_e32 %0, %1, %2" : "=v"(r) : "v"(a), "v"(b)); return r; }
__device__ __forceinline__ float vmax3(float a, float b, float c) { float r; asm("v_max3_f32 %0, %1, %2, %3" : "=v"(r) : "v"(a), "v"(b), "v"(c)); return r; }

constexpr int AT_KP = 72, AT_VP = 96;
constexpr int AT_KS = 0, AT_KS_BYTES = 64 * AT_KP * 2;
constexpr int AT_VT = 2 * AT_KS_BYTES, AT_VT_BYTES = 64 * AT_VP * 2;
constexpr int AT_KM = AT_VT + 2 * AT_VT_BYTES;
constexpr int AT_MISC = AT_KM + 32 * AT_KP * 2;
constexpr float LOG2E = 1.4426950408889634f;

__device__ __forceinline__ unsigned mk_unit(int kind, int b, int x, int y) { return ((unsigned)kind << 30) | ((unsigned)b << 28) | ((unsigned)x << 8) | (unsigned)y; }
__device__ void build_unit_table(unsigned* tab, int i) {
    int n = 0; unsigned res = 0u;
#pragma unroll 1
    for (int c = 64; c >= 1; --c) {
        if (i >= n && i < n + 4) res = mk_unit(0, i - n, 0, c - 1);
        n += 4;
        if ((c & 3) == 0) { if (i >= n && i < n + 16) { const int j = i - n; res = mk_unit(2, j >> 2, j & 3, c / 4 - 1); } n += 16; }
    }
    if (i < 512) tab[i] = res;
}

template <int kind> __device__ __forceinline__ void attn_unit(int WV_, const bf16* P, const unsigned char* mask, const float* kmean, const float* sinks, bf16* ys,
                                unsigned char* lds, int b, int ux, int uy) {
    int tid_ = LTID(WV_); asm volatile("" : "+v"(tid_));
    const int tid = tid_, lane = tid & 63, wave = __builtin_amdgcn_readfirstlane(tid >> 6), r32 = lane & 31, hi = lane >> 5;
    bf16* s_km = (bf16*)(lds + AT_KM);
    const int skey = tid >> 3, sc = tid & 7;
    {
        const bf16* Pb = P + (size_t)b * S_ * NP;
        int q0w, qcol, kcol, vcol, ycol, kt_hi, kt_lo; float slope2 = 0.f, sink2 = 0.f;
        if (kind == 0) { const int head = wave >> 1; q0w = uy * 64 + (wave & 1) * 32; qcol = C_QA + head * 64; kcol = C_KA; vcol = C_VA; ycol = head * 64;
            slope2 = exp2f(-8.0f * (float)(3 * head + 1) / 12.0f) * LOG2E; kt_hi = uy; kt_lo = 0; }
        else if (kind == 1) { const int hq = ux * 2 + (wave >> 2); q0w = uy * 128 + (wave & 3) * 32; qcol = C_QB + hq * 64; kcol = C_KB + ux * 64; vcol = C_VB + ux * 64; ycol = 256 + hq * 64;
            slope2 = exp2f(-8.0f * (float)(3 * hq + 2) / 12.0f) * LOG2E; sink2 = sinks[hq] * LOG2E; kt_hi = 2 * uy + 1; kt_lo = (2 * uy - 2 > 0) ? 2 * uy - 2 : 0; }
        else if (kind == 2) { q0w = uy * 256 + wave * 32; qcol = C_QC + ux * 64; kcol = C_KC + ux * 64; vcol = C_VC + ux * 64; ycol = 512 + ux * 64;
            slope2 = exp2f(-8.0f * (float)(3 * ux + 3) / 12.0f) * LOG2E; kt_hi = 4 * uy + 3; kt_lo = 0; }
        else { q0w = uy * 256 + wave * 32; qcol = C_QD + ux * 64; kcol = C_KD + ux * 64; vcol = C_VD + ux * 64; ycol = 768 + ux * 64; kt_hi = 4 * uy + 3; kt_lo = 0; }
        const int qpos = q0w + r32;
        bf16x8_t qf[4];
        { const bf16* qp = Pb + (size_t)qpos * NP + qcol + 8 * hi;
#pragma unroll
          for (int ks = 0; ks < 4; ++ks) qf[ks] = *(const bf16x8_t*)(qp + 16 * ks); }
        {
            const float qs = (kind == 3) ? 0.125f : 0.125f * LOG2E;
            typedef unsigned u32x4_t __attribute__((ext_vector_type(4)));
#pragma unroll
            for (int ks = 0; ks < 4; ++ks) { u32x4_t w = __builtin_bit_cast(u32x4_t, qf[ks]);
#pragma unroll
                for (int i = 0; i < 4; ++i) w[i] = cvtpk(__uint_as_float(w[i] << 16) * qs, __uint_as_float(w[i] & 0xffff0000u) * qs);
                qf[ks] = __builtin_bit_cast(bf16x8_t, w); }
        }
        float sb[16];
#pragma unroll
        for (int r = 0; r < 16; ++r) sb[r] = slope2 * (float)((r & 3) + 8 * (r >> 2));
        unsigned bm = 0u;
        if (kind == 2) {
            const int own = uy;
            for (int e = tid; e < 32 * 64; e += NTHR) { const int row = e >> 6, d = e & 63; s_km[row * AT_KP + d] = (row < 16) ? (bf16)f2bf(kmean[((b * 4 + ux) * 16 + row) * 64 + d]) : (bf16)0; }
            __syncthreads();
            f32x16_t gacc;
#pragma unroll
            for (int r = 0; r < 16; ++r) gacc[r] = 0.f;
#pragma unroll
            for (int ks = 0; ks < 4; ++ks) { const bf16x8_t a = *(const bf16x8_t*)(s_km + r32 * AT_KP + 16 * ks + 8 * hi); gacc = __builtin_amdgcn_mfma_f32_32x32x16_bf16(a, qf[ks], gacc, 0, 0, 0); }
            float gt[16];
#pragma unroll
            for (int r = 0; r < 8; ++r) { const float mine = gacc[r], other = xlane32(mine); const int bi = crow(r, 0);
                gt[bi] = hi ? other : mine; gt[bi + 4] = hi ? mine : other; }
#pragma unroll
            for (int n = 0; n < 16; ++n) if (n >= own) gt[n] = -INFINITY;
#pragma unroll
            for (int rep = 0; rep < 3; ++rep) {
                float mx = -INFINITY;
#pragma unroll
                for (int n = 0; n < 16; ++n) mx = fmaxf(mx, gt[n]);
                bool done = !(mx > -INFINITY);
#pragma unroll
                for (int n = 0; n < 16; ++n) { const bool hit = !done && gt[n] == mx; if (hit) { bm |= 1u << n; gt[n] = -INFINITY; done = true; } }
            }
        }
        f32x16_t o0, o1;
#pragma unroll
        for (int r = 0; r < 16; ++r) { o0[r] = 0.f; o1[r] = 0.f; }
        float m_run = -INFINITY, l_run = 0.f, carry = 0.f;
        const bf16* kg = Pb + (size_t)skey * NP + kcol + sc * 8;
        const bf16* vg = Pb + (size_t)skey * NP + vcol + sc * 8;
        uint4 rk = *(const uint4*)(kg + (size_t)kt_hi * 64 * NP), rv = *(const uint4*)(vg + (size_t)kt_hi * 64 * NP);
        int buf = 0;
        { bf16* ks_ = (bf16*)(lds + AT_KS); bf16* vt_ = (bf16*)(lds + AT_VT);
          *(uint4*)(ks_ + skey * AT_KP + sc * 8) = rk;
          *(uint4*)(vt_ + skey * AT_VP + sc * 8) = rv; }
        __syncthreads();
        bool wave_done = false;
        uint2 mw_next = make_uint2(0u, 0u);
        if (kind == 0) mw_next = *(const uint2*)(mask + (size_t)(b * S_ + qpos) * 512 + kt_hi * 8);
        for (int kt = kt_hi; kt >= kt_lo; --kt) {
            const bool more = kt > kt_lo;
            const uint2 mw = mw_next;
            if (kind == 0 && more) mw_next = *(const uint2*)(mask + (size_t)(b * S_ + qpos) * 512 + (kt - 1) * 8);
            if (more) { rk = *(const uint4*)(kg + (size_t)(kt - 1) * 64 * NP); rv = *(const uint4*)(vg + (size_t)(kt - 1) * 64 * NP); }
            const bf16* ks_ = (const bf16*)(lds + AT_KS + buf * AT_KS_BYTES);
            const bf16* vt_ = (const bf16*)(lds + AT_VT + buf * AT_VT_BYTES);
            bool active = (kt * 64 <= q0w + 31) && !wave_done;
            if (kind == 1) active = active && (kt * 64 + 63 >= q0w - 127);
            if (active) {
                const int kbase = kt * 64 + 4 * hi;
                f32x16_t p0, p1;
                if (kind != 3) {
                    const float cb = slope2 * (float)(kbase - qpos), cb1 = cb + 32.0f * slope2;
#pragma unroll
                    for (int r = 0; r < 16; ++r) { p0[r] = cb + sb[r]; p1[r] = cb1 + sb[r]; }
                } else {
#pragma unroll
                    for (int r = 0; r < 16; ++r) { p0[r] = 0.f; p1[r] = 0.f; }
                }
#pragma unroll
                for (int ks = 0; ks < 4; ++ks) {
                    const bf16x8_t a0 = *(const bf16x8_t*)(ks_ + r32 * AT_KP + 16 * ks + 8 * hi);
                    const bf16x8_t a1 = *(const bf16x8_t*)(ks_ + (32 + r32) * AT_KP + 16 * ks + 8 * hi);
                    p0 = __builtin_amdgcn_mfma_f32_32x32x16_bf16(a0, qf[ks], p0, 0, 0, 0);
                    p1 = __builtin_amdgcn_mfma_f32_32x32x16_bf16(a1, qf[ks], p1, 0, 0, 0);
                }
                if (kind != 3) {
                    float mx = -INFINITY;
                    if (kind == 0) {
                        const unsigned w0 = mw.x >> (4 * hi), w1 = mw.y >> (4 * hi);
#pragma unroll
                        for (int r = 0; r < 16; ++r) { const int off = (r & 3) + 8 * (r >> 2);
                            p0[r] = (w0 & (1u << off)) ? p0[r] : -INFINITY; p1[r] = (w1 & (1u << off)) ? p1[r] : -INFINITY; mx = vmax3(mx, p0[r], p1[r]); }
                    } else if (kind == 1) {
                        const int rel = qpos - kbase;
#pragma unroll
                        for (int r = 0; r < 16; ++r) { const int off = (r & 3) + 8 * (r >> 2);
                            p0[r] = ((unsigned)(rel - off) < 128u) ? p0[r] : -INFINITY; p1[r] = ((unsigned)(rel - off - 32) < 128u) ? p1[r] : -INFINITY; mx = vmax3(mx, p0[r], p1[r]); }
                    } else {
                        if ((kt >> 2) == uy) {
                            const int rel = qpos - kbase;
#pragma unroll
                            for (int r = 0; r < 16; ++r) { const int off = (r & 3) + 8 * (r >> 2);
                                p0[r] = (off <= rel) ? p0[r] : -INFINITY; p1[r] = (off + 32 <= rel) ? p1[r] : -INFINITY; mx = vmax3(mx, p0[r], p1[r]); }
                        } else {
                            const bool tile_ok = ((bm >> (kt >> 2)) & 1u) != 0u;
#pragma unroll
                            for (int r = 0; r < 16; ++r) { p0[r] = tile_ok ? p0[r] : -INFINITY; p1[r] = tile_ok ? p1[r] : -INFINITY; mx = vmax3(mx, p0[r], p1[r]); }
                        }
                    }
                    mx = vmax(mx, xlane32(mx));
                    const float m_new = vmax(m_run, mx);
                    const float m_safe = (m_new == -INFINITY) ? 0.f : m_new;
                    p0 = p0 - m_safe; p1 = p1 - m_safe;
#pragma unroll
                    for (int r = 0; r < 16; ++r) { p0[r] = __builtin_amdgcn_exp2f(p0[r]); p1[r] = __builtin_amdgcn_exp2f(p1[r]); }
                    float ls;
                    { typedef float f32x8_t __attribute__((ext_vector_type(8))); typedef float f32x4v_t __attribute__((ext_vector_type(4)));
                      const f32x16_t t16 = p0 + p1; const f32x8_t t8 = t16.lo + t16.hi; const f32x4v_t t4 = t8.lo + t8.hi; const f32x2_t t2 = t4.lo + t4.hi; ls = t2.x + t2.y; }
                    if (__any(m_new > m_run)) {
                        const float alpha = __builtin_amdgcn_exp2f(m_run - m_safe);
                        l_run *= alpha;
                        o0 = o0 * alpha; o1 = o1 * alpha;
                    }
                    l_run += ls; m_run = m_new;
                } else {
                    float run = carry;
#define SB_HALF(PX, KOFF) do { \
                    float lk[16]; \
                    _Pragma("unroll") for (int r = 0; r < 16; ++r) { \
                        const int off = (r & 3) + 8 * (r >> 2); \
                        const bool v = (kbase + off + (KOFF)) < qpos; \
                        const float z = PX[r]; \
                        const float t = 0.6931471805599453f * __builtin_amdgcn_logf(1.0f + __builtin_amdgcn_exp2f(-LOG2E * fabsf(z))); \
                        lk[r] = v ? (fminf(-z, 0.f) - t) : 0.f; \
                        PX[r] = v ? (fminf(z, 0.f) - t) : -INFINITY; } \
                    _Pragma("unroll") for (int g = 3; g >= 0; --g) { \
                        const float G = (lk[4 * g] + lk[4 * g + 1]) + (lk[4 * g + 2] + lk[4 * g + 3]); \
                        const float PG = xlane32(G); \
                        float la = run + (hi ? 0.f : PG); \
                        run += G + PG; \
                        PX[4 * g + 3] += la; la += lk[4 * g + 3]; PX[4 * g + 2] += la; la += lk[4 * g + 2]; PX[4 * g + 1] += la; la += lk[4 * g + 1]; PX[4 * g] += la; } \
                    _Pragma("unroll") for (int r = 0; r < 16; ++r) PX[r] = __builtin_amdgcn_exp2f(LOG2E * PX[r]); } while (0)
                    SB_HALF(p1, 32);
                    SB_HALF(p0, 0);
#undef SB_HALF
                    carry = run;
                }
                unsigned pw[16];
#pragma unroll
                for (int j = 0; j < 8; ++j) { pw[j] = cvtpk(p0[2 * j], p0[2 * j + 1]); pw[8 + j] = cvtpk(p1[2 * j], p1[2 * j + 1]); }
#pragma unroll
                for (int s = 0; s < 4; ++s) {
                    bf16x8_t pb; { const unsigned* q = pw + 4 * s; typedef unsigned u32x4_t __attribute__((ext_vector_type(4))); u32x4_t t4 = {q[0], q[1], q[2], q[3]}; pb = __builtin_bit_cast(bf16x8_t, t4); }
#pragma unroll
                    for (int dt = 0; dt < 2; ++dt) {
                        typedef short s16x4_t __attribute__((ext_vector_type(4)));
                        typedef __attribute__((address_space(3))) s16x4_t lds_s16x4;
                        const int gi_ = lane & 15;
                        const bf16* vp = vt_ + (16 * s + 4 * hi + (gi_ >> 2)) * AT_VP + 32 * dt + 16 * ((lane >> 4) & 1) + 4 * (gi_ & 3);
                        const s16x4_t lo = __builtin_amdgcn_ds_read_tr16_b64_v4i16((lds_s16x4*)vp), hi4 = __builtin_amdgcn_ds_read_tr16_b64_v4i16((lds_s16x4*)(vp + 8 * AT_VP));
                        const bf16x8_t va = {lo[0], lo[1], lo[2], lo[3], hi4[0], hi4[1], hi4[2], hi4[3]};
                        if (dt == 0) o0 = __builtin_amdgcn_mfma_f32_32x32x16_bf16(va, pb, o0, 0, 0, 0);
                        else         o1 = __builtin_amdgcn_mfma_f32_32x32x16_bf16(va, pb, o1, 0, 0, 0);
                    }
                }
            }
            if (kind == 3) {
                const float cm = carry;
                if (__all(cm < -110.0f) || !(kt * 64 <= q0w + 31) ) { if (__all(cm < -110.0f)) wave_done = true; }
            }
            if (more) {
                bf16* ksn = (bf16*)(lds + AT_KS + (buf ^ 1) * AT_KS_BYTES); bf16* vtn = (bf16*)(lds + AT_VT + (buf ^ 1) * AT_VT_BYTES);
                *(uint4*)(ksn + skey * AT_KP + sc * 8) = rk;
                *(uint4*)(vtn + skey * AT_VP + sc * 8) = rv;
            }
            if (kind == 3) { if (__syncthreads_and(wave_done ? 1 : 0)) break; }
            else __syncthreads();
            buf ^= 1;
        }
        float inv;
        if (kind == 3) inv = 1.0f;
        else {
            float lt = l_run + xlane32(l_run);
            if (kind == 1) { const float mf = fmaxf(m_run, sink2); const float sc2 = exp2f(m_run - mf); lt = lt * sc2 + exp2f(sink2 - mf); inv = sc2 / lt; }
            else inv = 1.0f / lt;
        }
        bf16* yp = ys + (size_t)(b * S_ + qpos) * 1024 + ycol + 4 * hi;
#pragma unroll
        for (int g = 0; g < 4; ++g) {
            *(uint2*)(yp + 8 * g) = make_uint2(cvtpk(o0[4 * g] * inv, o0[4 * g + 1] * inv), cvtpk(o0[4 * g + 2] * inv, o0[4 * g + 3] * inv));
            *(uint2*)(yp + 32 + 8 * g) = make_uint2(cvtpk(o1[4 * g] * inv, o1[4 * g + 1] * inv), cvtpk(o1[4 * g + 2] * inv, o1[4 * g + 3] * inv));
        }
    }
}
__device__ void attn_fast_phase(int WV_, const bf16* P, const unsigned char* mask, const float* kmean, const float* sinks, bf16* ys,
                                const unsigned* utab, unsigned* counter, unsigned char* lds) {
    volatile unsigned* s_unit = (volatile unsigned*)(lds + AT_MISC);
    for (;;) {
        __syncthreads();
        if (LTID(WV_) == 0) s_unit[0] = atomicAdd(counter, 1u);
        __syncthreads();
        const unsigned ui = s_unit[0];
        if (ui >= 512u) break;
        const unsigned ue = utab[ui];
        const int kind = (int)(ue >> 30), b = (int)((ue >> 28) & 3u), ux = (int)((ue >> 8) & 255u), uy = (int)(ue & 255u);
        if (kind == 0) attn_unit<0>(WV_, P, mask, kmean, sinks, ys, lds, b, ux, uy);
        else attn_unit<2>(WV_, P, mask, kmean, sinks, ys, lds, b, ux, uy);
    }
    for (int u = LBID(); u < 256; u += LGRID()) { __syncthreads(); attn_unit<3>(WV_, P, mask, kmean, sinks, ys, lds, u >> 6, (u >> 4) & 3, u & 15); }
    for (int u = LBID(); u < 256; u += LGRID()) { __syncthreads(); attn_unit<1>(WV_, P, mask, kmean, sinks, ys, lds, u >> 6, (u >> 5) & 1, u & 31); }
}

constexpr float U_SCALE = 128.0f, V_SCALE = 48.0f;
constexpr int ROW6 = 1536;
typedef float v32f_t __attribute__((ext_vector_type(32)));
typedef unsigned v6u_t __attribute__((ext_vector_type(6)));
typedef unsigned u32x4a8_t __attribute__((ext_vector_type(4), aligned(8)));
__device__ __forceinline__ float rdlane_f(float v, int l) { return __builtin_bit_cast(float, __builtin_amdgcn_readlane(__builtin_bit_cast(int, v), l)); }
__device__ __forceinline__ unsigned q_e2m3(float v) {
    const float a = fminf(fabsf(v), 7.5f);
    unsigned code;
    if (a < 1.0f) code = (unsigned)rintf(a * 8.0f);
    else if (a < 2.0f) code = 8u + (unsigned)rintf((a - 1.0f) * 8.0f);
    else if (a < 4.0f) code = 16u + (unsigned)rintf((a - 2.0f) * 4.0f);
    else code = 24u + (unsigned)rintf((a - 4.0f) * 2.0f);
    return code | (v < 0.f ? 32u : 0u);
}
__device__ __forceinline__ void cvt_chunk6(const float4 (&a)[8], float sc, unsigned (&w)[6]) {
#pragma unroll
    for (int d = 0; d < 6; ++d) w[d] = 0u;
#pragma unroll
    for (int q4 = 0; q4 < 8; ++q4) {
        const float av[4] = {a[q4].x, a[q4].y, a[q4].z, a[q4].w};
#pragma unroll
        for (int e = 0; e < 4; ++e) { const int idx = q4 * 4 + e, bit = 6 * idx, d = bit >> 5, sft = bit & 31; const unsigned code = q_e2m3(av[e] * sc);
            w[d] |= code << sft; if (sft > 26) w[d + 1] |= code >> (32 - sft); }
    }
}
__device__ void convert_tables(int WV_, const Params& p) {
    const size_t nchunk = (size_t)DEPTH_ * 16384 * 2 * 32;
    const size_t stride = (size_t)LGRID() * NTHR;
    for (size_t i = (size_t)LBID() * NTHR + LTID(WV_); i < nchunk; i += 2 * stride) {
        const size_t i2 = i + stride; const bool has2 = i2 < nchunk; const size_t j2 = has2 ? i2 : i;
        const int c0 = (int)(i & 31), uv0 = (int)((i >> 5) & 1); const size_t le0 = i >> 6;
        const int c1 = (int)(j2 & 31), uv1 = (int)((j2 >> 5) & 1); const size_t le1 = j2 >> 6;
        const float* src0 = (uv0 ? p.in[10] : p.in[9]) + le0 * 1024 + c0 * 32;
        const float* src1 = (uv1 ? p.in[10] : p.in[9]) + le1 * 1024 + c1 * 32;
        float4 a0[8], a1[8];
#pragma unroll
        for (int q4 = 0; q4 < 8; ++q4) a0[q4] = ((const float4*)src0)[q4];
#pragma unroll
        for (int q4 = 0; q4 < 8; ++q4) a1[q4] = ((const float4*)src1)[q4];
        unsigned w0[6], w1[6];
        cvt_chunk6(a0, uv0 ? V_SCALE : U_SCALE, w0);
        cvt_chunk6(a1, uv1 ? V_SCALE : U_SCALE, w1);
        uint2* dst0 = (uint2*)(p.ws + WS_UV + le0 * ROW6 + uv0 * 768 + c0 * 24);
        dst0[0] = make_uint2(w0[0], w0[1]); dst0[1] = make_uint2(w0[2], w0[3]); dst0[2] = make_uint2(w0[4], w0[5]);
        if (has2) { uint2* dst1 = (uint2*)(p.ws + WS_UV + le1 * ROW6 + uv1 * 768 + c1 * 24);
            dst1[0] = make_uint2(w1[0], w1[1]); dst1[1] = make_uint2(w1[2], w1[3]); dst1[2] = make_uint2(w1[4], w1[5]); }
    }
}
__device__ __forceinline__ v6u_t ld_pk6(const unsigned char* ptr) {
    const uint2 a = ((const uint2*)ptr)[0], b = ((const uint2*)ptr)[1], c = ((const uint2*)ptr)[2];
    const v6u_t pk = {a.x, a.y, b.x, b.y, c.x, c.y};
    return pk;
}
__device__ void peer_fast_phase(int WV_, float* h, bf16* hb, const int* eid, const float* gate, const unsigned char* uv, const float* g1, const float* b1, const float* g, const float* bb, unsigned char* lds) {
    const int tid = LTID(WV_), lane = tid & 63, wave = tid >> 6, l32 = lane & 31, hi = lane >> 5;
    float* pl = (float*)(lds + wave * 16384);
    unsigned char* raw = lds + wave * 16384 + 4096 + lane * 24;
    for (int t = LBID() * NWAVE + wave; t < T_; t += LGRID() * NWAVE) {
        float* hr = h + (size_t)t * 1024 + l32 * 32;
        float x[32], acc[32];
#pragma unroll
        for (int q4 = 0; q4 < 4; ++q4) { const uint4 a = ((const uint4*)(hb + (size_t)t * 1024 + l32 * 32))[q4];
            x[8 * q4] = __uint_as_float(a.x << 16); x[8 * q4 + 1] = __uint_as_float(a.x & 0xffff0000u); x[8 * q4 + 2] = __uint_as_float(a.y << 16); x[8 * q4 + 3] = __uint_as_float(a.y & 0xffff0000u);
            x[8 * q4 + 4] = __uint_as_float(a.z << 16); x[8 * q4 + 5] = __uint_as_float(a.z & 0xffff0000u); x[8 * q4 + 6] = __uint_as_float(a.w << 16); x[8 * q4 + 7] = __uint_as_float(a.w & 0xffff0000u); }
        {
            float s = 0.f;
#pragma unroll
            for (int i = 0; i < 32; ++i) s += x[i];
#pragma unroll
            for (int o = 16; o > 0; o >>= 1) s += __shfl_xor(s, o);
            const float mean = s * (1.0f / 1024.0f);
            float s2 = 0.f;
#pragma unroll
            for (int i = 0; i < 32; ++i) { x[i] -= mean; s2 += x[i] * x[i]; }
#pragma unroll
            for (int o = 16; o > 0; o >>= 1) s2 += __shfl_xor(s2, o);
            const float rstd = 1.0f / sqrtf(s2 * (1.0f / 1024.0f) + LN_EPS);
#pragma unroll
            for (int q4 = 0; q4 < 8; ++q4) { const float4 gg = ((const float4*)(g1 + l32 * 32))[q4], cc = ((const float4*)(b1 + l32 * 32))[q4];
                x[4 * q4] = x[4 * q4] * rstd * gg.x + cc.x; x[4 * q4 + 1] = x[4 * q4 + 1] * rstd * gg.y + cc.y; x[4 * q4 + 2] = x[4 * q4 + 2] * rstd * gg.z + cc.z; x[4 * q4 + 3] = x[4 * q4 + 3] * rstd * gg.w + cc.w; }
        }
#pragma unroll
        for (int i = 0; i < 32; ++i) acc[i] = 0.f;
#pragma unroll 1
        for (int batch = 0; batch < 4; ++batch) {
            const int my_eid = eid[(size_t)t * 128 + batch * 32 + l32];
            const float my_gate = gate[(size_t)t * 128 + batch * 32 + l32];
#pragma unroll 1
            for (int grp = 0; grp < 2; ++grp) {
                { u32x4a8_t pa[8]; uint2 pc[8];
#pragma unroll
                  for (int i = 0; i < 8; ++i) { const int id = __shfl(my_eid, 2 * (grp * 8 + i) + hi); const unsigned char* rp = uv + (size_t)id * ROW6 + l32 * 24; pa[i] = *(const u32x4a8_t*)rp; pc[i] = *(const uint2*)(rp + 16); }
#pragma unroll
                  for (int i = 0; i < 8; ++i) { uint2* wp = (uint2*)(raw + i * 1536); wp[0] = make_uint2(pa[i].x, pa[i].y); wp[1] = make_uint2(pa[i].z, pa[i].w); wp[2] = pc[i]; } }
#pragma unroll 1
                for (int i = 0; i < 8; ++i) {
                    const uint2* rp = (const uint2*)(raw + i * 1536); const uint2 a = rp[0], b = rp[1], c = rp[2];
                    const v6u_t pk6 = {a.x, a.y, b.x, b.y, c.x, c.y}; const v32f_t f = __builtin_amdgcn_cvt_scalef32_pk32_f32_fp6(pk6, 1.0f);
                    f32x2_t dv0 = {0.f, 0.f}, dv1 = {0.f, 0.f};
#pragma unroll
                    for (int j = 0; j < 8; ++j) { const f32x2_t fa = {f[2 * j], f[2 * j + 1]}, fb = {f[16 + 2 * j], f[17 + 2 * j]}, xa = {x[2 * j], x[2 * j + 1]}, xb = {x[16 + 2 * j], x[17 + 2 * j]};
                        dv0 = fa * xa + dv0; dv1 = fb * xb + dv1; }
                    pl[(2 * (grp * 8 + i) + hi) * 32 + l32] = (dv0.x + dv0.y) + (dv1.x + dv1.y);
                }
            }
            float d;
            { const float4* pr = (const float4*)(pl + l32 * 32); float4 s4 = pr[0];
#pragma unroll
              for (int i = 1; i < 8; ++i) { const float4 v = pr[i]; s4.x += v.x; s4.y += v.y; s4.z += v.z; s4.w += v.w; }
              d = ((s4.x + s4.y) + (s4.z + s4.w)) * (1.0f / U_SCALE); }
            const float hv = 0.5f * d * (1.0f + erff(d * 0.70710678118654752f)) * my_gate * (1.0f / V_SCALE);
#pragma unroll 1
            for (int grp = 0; grp < 2; ++grp) {
                { u32x4a8_t pa[8]; uint2 pc[8];
#pragma unroll
                  for (int i = 0; i < 8; ++i) { const int id = __shfl(my_eid, 2 * (grp * 8 + i) + hi); const unsigned char* rp = uv + (size_t)id * ROW6 + 768 + l32 * 24; pa[i] = *(const u32x4a8_t*)rp; pc[i] = *(const uint2*)(rp + 16); }
#pragma unroll
                  for (int i = 0; i < 8; ++i) { uint2* wp = (uint2*)(raw + i * 1536); wp[0] = make_uint2(pa[i].x, pa[i].y); wp[1] = make_uint2(pa[i].z, pa[i].w); wp[2] = pc[i]; } }
#pragma unroll 1
                for (int i = 0; i < 8; ++i) {
                    const float c = __shfl(hv, 2 * (grp * 8 + i) + hi);
                    const uint2* rp = (const uint2*)(raw + i * 1536); const uint2 a = rp[0], b = rp[1], cc = rp[2];
                    const v6u_t pk6 = {a.x, a.y, b.x, b.y, cc.x, cc.y}; const v32f_t f = __builtin_amdgcn_cvt_scalef32_pk32_f32_fp6(pk6, 1.0f);
                    const f32x2_t c2 = {c, c};
#pragma unroll
                    for (int j = 0; j < 16; ++j) { const f32x2_t fj = {f[2 * j], f[2 * j + 1]}; f32x2_t aj = {acc[2 * j], acc[2 * j + 1]}; aj = fj * c2 + aj; acc[2 * j] = aj.x; acc[2 * j + 1] = aj.y; }
                }
            }
        }
        float y[32], s = 0.f;
#pragma unroll
        for (int i = 0; i < 32; ++i) { acc[i] += __shfl_xor(acc[i], 32); y[i] = ALPHA * x[i] + acc[i]; s += y[i]; }
#pragma unroll
        for (int o = 16; o > 0; o >>= 1) s += __shfl_xor(s, o);
        const float mean = s * (1.0f / 1024.0f);
        float s2 = 0.f;
#pragma unroll
        for (int i = 0; i < 32; ++i) { y[i] -= mean; s2 += y[i] * y[i]; }
#pragma unroll
        for (int o = 16; o > 0; o >>= 1) s2 += __shfl_xor(s2, o);
        const float rstd = 1.0f / sqrtf(s2 * (1.0f / 1024.0f) + LN_EPS);
        float o[16];
#pragma unroll
        for (int q4 = 0; q4 < 4; ++q4) {
            const float4 gg = ((const float4*)(g + l32 * 32 + hi * 16))[q4], cc = ((const float4*)(bb + l32 * 32 + hi * 16))[q4];
            float ya[4], yb2[4];
#pragma unroll
            for (int e = 0; e < 4; ++e) { ya[e] = y[4 * q4 + e]; yb2[e] = y[16 + 4 * q4 + e]; }
            asm volatile("" : "+v"(ya[0]), "+v"(ya[1]), "+v"(ya[2]), "+v"(ya[3]), "+v"(yb2[0]), "+v"(yb2[1]), "+v"(yb2[2]), "+v"(yb2[3]));
            const float y0 = hi ? yb2[0] : ya[0], y1 = hi ? yb2[1] : ya[1], y2 = hi ? yb2[2] : ya[2], y3 = hi ? yb2[3] : ya[3];
            o[4 * q4] = y0 * rstd * gg.x + cc.x; o[4 * q4 + 1] = y1 * rstd * gg.y + cc.y; o[4 * q4 + 2] = y2 * rstd * gg.z + cc.z; o[4 * q4 + 3] = y3 * rstd * gg.w + cc.w;
            if (h) ((float4*)(hr + hi * 16))[q4] = make_float4(o[4 * q4], o[4 * q4 + 1], o[4 * q4 + 2], o[4 * q4 + 3]);
        }
        uint4* hbp = (uint4*)(hb + (size_t)t * 1024 + l32 * 32 + hi * 16);
        hbp[0] = make_uint4(pk2(o[0], o[1]), pk2(o[2], o[3]), pk2(o[4], o[5]), pk2(o[6], o[7]));
        hbp[1] = make_uint4(pk2(o[8], o[9]), pk2(o[10], o[11]), pk2(o[12], o[13]), pk2(o[14], o[15]));
    }
}

__device__ __forceinline__ float pack_pl(float v, unsigned pl) { return __uint_as_float((__float_as_uint(v) & ~127u) | pl); }
__device__ __forceinline__ void ins16(float (&s)[16], float x) {
#pragma unroll
    for (int k = 15; k >= 1; --k) s[k] = __builtin_amdgcn_fmed3f(s[k - 1], x, s[k]);
    s[0] = vmax(s[0], x);
}
template <int D> __device__ __forceinline__ void bitonic_stage(float (&c)[16]) {
#pragma unroll
    for (int i = 0; i < 16; ++i) if ((i & D) == 0) { const float a = vmax(c[i], c[i + D]), b = vmin(c[i], c[i + D]); c[i] = a; c[i + D] = b; }
}
__device__ __forceinline__ int decode_key(unsigned pl) { return (int)(32u * ((pl >> 4) & 3u) + (pl & 3u) + 8u * ((pl >> 2) & 3u) + 4u * ((pl >> 6) & 1u)); }
__device__ void route_fast_phase(int WV_, const bf16* qb, const bf16* skb  , int* eid, float* gate, unsigned char* lds, int pm = -1, int pn = 0) {
    const int tid = LTID(WV_), lane = tid & 63, wave = tid >> 6, r32 = lane & 31, hi = lane >> 5;
    unsigned* lidx = (unsigned*)lds + wave * (64 * 33) + lane * 33;
    const int u_first = (pm >= 0) ? 0 : LBID() * NWAVE + wave, u_end = (pm >= 0) ? 2 : (T_ / 32) * 8, u_step = (pm >= 0) ? 1 : LGRID() * NWAVE;
    for (int unit = u_first; unit < u_end; unit += u_step) {
        const int h = (pm >= 0) ? 2 * pn + unit : (unit & 7), t = ((pm >= 0) ? 8 * pm + wave : (unit >> 3)) * 32 + r32;
        float sl[2][16];
#pragma unroll
        for (int p = 0; p < 2; ++p) {
            bf16x8_t qf[4];
            { const bf16* qp = qb + (size_t)t * 1024 + h * 128 + p * 64 + 8 * hi;
#pragma unroll
              for (int ks = 0; ks < 4; ++ks) qf[ks] = *(const bf16x8_t*)(qp + 16 * ks); }
            float s[16];
#pragma unroll
            for (int k = 0; k < 16; ++k) s[k] = -INFINITY;
            const bf16* skp = skb + ((size_t)(h * 2 + p) * 128 + r32) * 64 + 8 * hi;
#pragma unroll
            for (int kt = 0; kt < 4; ++kt) {
                f32x16_t acc;
#pragma unroll
                for (int r = 0; r < 16; ++r) acc[r] = 0.f;
#pragma unroll
                for (int ks = 0; ks < 4; ++ks) { const bf16x8_t a = *(const bf16x8_t*)(skp + (size_t)kt * 32 * 64 + 16 * ks); acc = __builtin_amdgcn_mfma_f32_32x32x16_bf16(a, qf[ks], acc, 0, 0, 0); }
#pragma unroll
                for (int r = 0; r < 16; ++r) ins16(s, pack_pl(acc[r], (unsigned)(kt * 16 + r)));
            }
            const unsigned hb = (unsigned)hi << 6;
#pragma unroll
            for (int k = 0; k < 16; ++k) s[k] = __uint_as_float(__float_as_uint(s[k]) | hb);
            float c[16];
#pragma unroll
            for (int k = 0; k < 16; ++k) c[k] = vmax(s[k], __shfl_xor(s[15 - k], 32));
            bitonic_stage<8>(c); bitonic_stage<4>(c); bitonic_stage<2>(c); bitonic_stage<1>(c);
#pragma unroll
            for (int k = 0; k < 16; ++k) { sl[p][k] = c[k]; lidx[p * 16 + k] = (unsigned)decode_key(__float_as_uint(c[k]) & 127u); }
        }
        float w[16];
#pragma unroll
        for (int k = 0; k < 16; ++k) w[k] = -INFINITY;
#pragma unroll
        for (int i = 0; i < 16; ++i)
#pragma unroll
            for (int j = 0; j < 16; ++j)
                if ((i + 1) * (j + 1) <= 16) { const float v = sl[0][i] + sl[1][j]; ins16(w, __uint_as_float((__float_as_uint(v) & ~255u) | (unsigned)(i * 16 + j))); }
        float e[16], sum = 0.f;
#pragma unroll
        for (int k = 0; k < 16; ++k) { e[k] = __builtin_amdgcn_exp2f((w[k] - w[0]) * 1.44269504f); sum += e[k]; }
        const float inv = 1.0f / sum;
        int ide[8]; float gte[8];
#pragma unroll
        for (int k = 0; k < 8; ++k) {
            float wa = w[k], wb = w[8 + k], ea = e[k], eb = e[8 + k];
            asm volatile("" : "+v"(wa), "+v"(wb), "+v"(ea), "+v"(eb));
            const float wv = hi ? wb : wa;
            const unsigned pl = __float_as_uint(wv) & 255u;
            ide[k] = (int)(lidx[pl >> 4] * 128u + lidx[16 + (pl & 15u)]);
            gte[k] = (hi ? eb : ea) * inv;
        }
        int* ep = eid + (size_t)t * 128 + h * 16 + hi * 8; float* gp = gate + (size_t)t * 128 + h * 16 + hi * 8;
        *(int4*)ep = make_int4(ide[0], ide[1], ide[2], ide[3]); *(int4*)(ep + 4) = make_int4(ide[4], ide[5], ide[6], ide[7]);
        *(float4*)gp = make_float4(gte[0], gte[1], gte[2], gte[3]); *(float4*)(gp + 4) = make_float4(gte[4], gte[5], gte[6], gte[7]);
    }
}
#ifndef TS_SEL
#define TS_SEL 0
#endif
#define ITS_B() do { if (TS_SEL >= 20 && TS_SEL <= 40 && WV_ == 0 && LANEID() == 0) ((volatile __attribute__((address_space(3))) unsigned long long*)((__attribute__((address_space(3))) unsigned char*)lds + 147456 - 16 - 32))[0] = __builtin_amdgcn_s_memrealtime(); } while (0)
#define ITS_E(k) do { if ((k) == TS_SEL && WV_ == 0 && LANEID() == 0) { volatile __attribute__((address_space(3))) unsigned long long* w_ = (volatile __attribute__((address_space(3))) unsigned long long*)((__attribute__((address_space(3))) unsigned char*)lds + 147456 - 16 - 32); w_[1] += __builtin_amdgcn_s_memrealtime() - w_[0]; } } while (0)

typedef float f32x4_t __attribute__((ext_vector_type(4)));
typedef __bf16 bf16x2v __attribute__((ext_vector_type(2)));
__device__ __forceinline__ float dot2bf(unsigned a, unsigned b, float c) { return __builtin_amdgcn_fdot2_f32_bf16(__builtin_bit_cast(bf16x2v, a), __builtin_bit_cast(bf16x2v, b), c, false); }
__device__ __forceinline__ void cnt_gt(int& cnt, unsigned a, unsigned b) { asm("v_cmp_gt_u32_e32 vcc, %1, %2\n\tv_addc_co_u32_e32 %0, vcc, 0, %0, vcc" : "+v"(cnt) : "v"(a), "v"(b) : "vcc"); }
__device__ __forceinline__ void cnt_eq(int& cnt, unsigned a, unsigned b) { asm("v_cmp_eq_u32_e32 vcc, %1, %2\n\tv_addc_co_u32_e32 %0, vcc, 0, %0, vcc" : "+v"(cnt) : "v"(a), "v"(b) : "vcc"); }
__device__ __forceinline__ unsigned flag_gt(unsigned a, unsigned b) { unsigned r; asm("v_cmp_gt_u32_e32 vcc, %1, %2\n\tv_cndmask_b32_e64 %0, 0, 1, vcc" : "=v"(r) : "v"(a), "v"(b) : "vcc"); return r; }
__device__ __forceinline__ unsigned flag_eq(unsigned a, unsigned b) { unsigned r; asm("v_cmp_eq_u32_e32 vcc, %1, %2\n\tv_cndmask_b32_e64 %0, 0, 1, vcc" : "=v"(r) : "v"(a), "v"(b) : "vcc"); return r; }
__device__ __forceinline__ void cnt_ge(int& cnt, unsigned key, unsigned cand) { asm("v_cmp_ge_u32_e32 vcc, %1, %2\n\tv_addc_co_u32_e32 %0, vcc, 0, %0, vcc" : "+v"(cnt) : "v"(key), "v"(cand) : "vcc"); }

template <int CTRL, int RM> __device__ __forceinline__ unsigned dpp0(unsigned v) { return (unsigned)__builtin_amdgcn_update_dpp(0, (int)v, CTRL, RM, 0xf, false); }
template <int CTRL> __device__ __forceinline__ unsigned dppf(unsigned v) { return (unsigned)__builtin_amdgcn_update_dpp(-1, (int)v, CTRL, 0xf, 0xf, false); }
__device__ __forceinline__ unsigned wave_sum_u_dpp(unsigned v) {
    v += dpp0<0xB1, 0xf>(v); v += dpp0<0x4E, 0xf>(v); v += dpp0<0x141, 0xf>(v); v += dpp0<0x140, 0xf>(v);
    return (unsigned)__builtin_amdgcn_readlane((int)v, 0) + (unsigned)__builtin_amdgcn_readlane((int)v, 16) + (unsigned)__builtin_amdgcn_readlane((int)v, 32) + (unsigned)__builtin_amdgcn_readlane((int)v, 48);
}
__device__ __forceinline__ unsigned wave_min_u_dpp(unsigned v) {
    unsigned t;
    t = dppf<0xB1>(v); v = t < v ? t : v; t = dppf<0x4E>(v); v = t < v ? t : v; t = dppf<0x141>(v); v = t < v ? t : v; t = dppf<0x140>(v); v = t < v ? t : v;
    const unsigned a = (unsigned)__builtin_amdgcn_readlane((int)v, 0), b = (unsigned)__builtin_amdgcn_readlane((int)v, 16), c = (unsigned)__builtin_amdgcn_readlane((int)v, 32), d = (unsigned)__builtin_amdgcn_readlane((int)v, 48);
    const unsigned ab = a < b ? a : b, cd = c < d ? c : d; return ab < cd ? ab : cd;
}
__device__ __forceinline__ unsigned wave_incl_scan_u_dpp(unsigned v) {
    v += dpp0<0x111, 0xf>(v); v += dpp0<0x112, 0xf>(v); v += dpp0<0x114, 0xf>(v); v += dpp0<0x118, 0xf>(v);
    v += dpp0<0x142, 0xa>(v);
    v += dpp0<0x143, 0xc>(v);
    return v;
}
typedef __attribute__((address_space(3))) unsigned lds_u32;
template <int SHIFT> __device__ __forceinline__ unsigned radix_pass(const unsigned (&key)[64], unsigned pre, lds_u32* hist, int lane, int& need, int jlim, unsigned L) {
    typedef unsigned u32x4v __attribute__((ext_vector_type(4)));
    typedef __attribute__((address_space(3))) u32x4v lds_u32x4;
    const int fl = 63 - lane;
    { const u32x4v z4 = {0u, 0u, 0u, 0u};
      ((lds_u32x4*)(hist + fl * 4))[0] = z4; }
    const unsigned hb = (unsigned)(size_t)hist;
    const unsigned one = 1u;
    asm volatile("" ::: "memory");
#pragma unroll
    for (int j4 = 0; j4 < 16; ++j4) {
        if (4 * j4 <= jlim) {
            unsigned long long c0, c1, c2, c3, sv; unsigned t0, t1, t2, t3;
            if (SHIFT == 24)
                asm volatile(
                    "v_cmp_ge_u32_e64 %0, %9, %13\n\tv_cmp_ge_u32_e64 %1, %10, %13\n\tv_cmp_ge_u32_e64 %2, %11, %13\n\tv_cmp_ge_u32_e64 %3, %12, %13\n\t"
                    "v_lshrrev_b32_e32 %5, 24, %9\n\tv_lshrrev_b32_e32 %6, 24, %10\n\tv_lshrrev_b32_e32 %7, 24, %11\n\tv_lshrrev_b32_e32 %8, 24, %12\n\t"
                    "v_lshl_add_u32 %5, %5, 2, %14\n\tv_lshl_add_u32 %6, %6, 2, %14\n\tv_lshl_add_u32 %7, %7, 2, %14\n\tv_lshl_add_u32 %8, %8, 2, %14\n\t"
                    "s_mov_b64 %4, exec\n\t"
                    "s_mov_b64 exec, %0\n\tds_add_u32 %5, %15\n\ts_mov_b64 exec, %1\n\tds_add_u32 %6, %15\n\ts_mov_b64 exec, %2\n\tds_add_u32 %7, %15\n\ts_mov_b64 exec, %3\n\tds_add_u32 %8, %15\n\t"
                    "s_mov_b64 exec, %4"
                    : "=&s"(c0), "=&s"(c1), "=&s"(c2), "=&s"(c3), "=&s"(sv), "=&v"(t0), "=&v"(t1), "=&v"(t2), "=&v"(t3)
                    : "v"(key[4 * j4]), "v"(key[4 * j4 + 1]), "v"(key[4 * j4 + 2]), "v"(key[4 * j4 + 3]), "v"(L), "v"(hb), "v"(one) : "memory");
            else
                asm volatile(
                    "v_lshrrev_b32_e32 %5, %16, %9\n\tv_lshrrev_b32_e32 %6, %16, %10\n\tv_lshrrev_b32_e32 %7, %16, %11\n\tv_lshrrev_b32_e32 %8, %16, %12\n\t"
                    "v_cmp_eq_u32_e64 %0, %5, %13\n\tv_cmp_eq_u32_e64 %1, %6, %13\n\tv_cmp_eq_u32_e64 %2, %7, %13\n\tv_cmp_eq_u32_e64 %3, %8, %13\n\t"
                    "s_or_b64 %4, %0, %1\n\ts_or_b64 %4, %4, %2\n\ts_or_b64 %4, %4, %3\n\t"
                    "s_cbranch_scc0 .Lrxskip%=\n\t"
                    "v_bfe_u32 %5, %9, %17, 8\n\tv_bfe_u32 %6, %10, %17, 8\n\tv_bfe_u32 %7, %11, %17, 8\n\tv_bfe_u32 %8, %12, %17, 8\n\t"
                    "v_lshl_add_u32 %5, %5, 2, %14\n\tv_lshl_add_u32 %6, %6, 2, %14\n\tv_lshl_add_u32 %7, %7, 2, %14\n\tv_lshl_add_u32 %8, %8, 2, %14\n\t"
                    "s_mov_b64 %4, exec\n\t"
                    "s_mov_b64 exec, %0\n\tds_add_u32 %5, %15\n\ts_mov_b64 exec, %1\n\tds_add_u32 %6, %15\n\ts_mov_b64 exec, %2\n\tds_add_u32 %7, %15\n\ts_mov_b64 exec, %3\n\tds_add_u32 %8, %15\n\t"
                    "s_mov_b64 exec, %4\n"
                    ".Lrxskip%=:"
                    : "=&s"(c0), "=&s"(c1), "=&s"(c2), "=&s"(c3), "=&s"(sv), "=&v"(t0), "=&v"(t1), "=&v"(t2), "=&v"(t3)
                    : "v"(key[4 * j4]), "v"(key[4 * j4 + 1]), "v"(key[4 * j4 + 2]), "v"(key[4 * j4 + 3]), "v"(pre), "v"(hb), "v"(one), "n"((SHIFT + 8) & 31), "n"(SHIFT) : "memory", "scc");
        }
    }
    asm volatile("s_waitcnt lgkmcnt(0)" ::: "memory");
    unsigned dsum[4]; unsigned sumL = 0u;
    { const u32x4v v0 = ((const lds_u32x4*)(hist + fl * 4))[0];
      dsum[0] = v0.x; dsum[1] = v0.y; dsum[2] = v0.z; dsum[3] = v0.w; sumL = (dsum[0] + dsum[1]) + (dsum[2] + dsum[3]); }
    const unsigned incl = wave_incl_scan_u_dpp(sumL);
    const unsigned above = incl - sumL;
    const bool own = (above < (unsigned)need) && ((unsigned)need <= above + sumL);
    const int owner = __ffsll((long long)__ballot(own)) - 1;
    unsigned acc = above; int sel = -1; unsigned cab = 0u;
#pragma unroll
    for (int i = 3; i >= 0; --i) { const unsigned c = dsum[i]; const bool hit = (sel < 0) && (acc + c >= (unsigned)need); cab = hit ? acc : cab; sel = hit ? i : sel; acc += c; }
    const int ow = owner < 0 ? 0 : owner;
    const unsigned digit = (unsigned)__builtin_amdgcn_readlane(sel, ow) + (unsigned)(4 * (63 - ow));
    need -= (int)__builtin_amdgcn_readlane((int)cab, ow);
    return digit;
}

__device__ __forceinline__ void idx_select(const unsigned (&key)[64], unsigned t3, int jlim, lds_u32* hist, int lane, uint2* mrow, int WV_, unsigned char* lds) {
        unsigned wlo = 0u, whi = 0u;
        unsigned L = wave_min_u_dpp(t3);
        L = L > 1u ? L : 1u;

        int need = 256;
        ITS_E(34); ITS_B();
        const unsigned d1 = radix_pass<24>(key, 0u, hist, lane, need, jlim, L);
        ITS_E(30); ITS_B();
        const unsigned d2 = radix_pass<16>(key, d1, hist, lane, need, jlim, L);
        ITS_E(31); ITS_B();
        const unsigned d3 = radix_pass<8>(key, (d1 << 8) | d2, hist, lane, need, jlim, L);
        const unsigned d4 = radix_pass<0>(key, (d1 << 16) | (d2 << 8) | d3, hist, lane, need, jlim, L);
        const unsigned prefix = (d1 << 24) | (d2 << 16) | (d3 << 8) | d4;
        ITS_E(32); ITS_B();

        int ceq = 0;
#pragma unroll
        for (int j4 = 0; j4 < 16; ++j4) if (4 * j4 <= jlim) { cnt_eq(ceq, key[4 * j4], prefix); cnt_eq(ceq, key[4 * j4 + 1], prefix); cnt_eq(ceq, key[4 * j4 + 2], prefix); cnt_eq(ceq, key[4 * j4 + 3], prefix); }
        ceq = (int)wave_sum_u_dpp((unsigned)ceq);
        int X = 4096;
        if (ceq != need) {
            int X0 = 0;
#pragma unroll 1
            for (int bit = 11; bit >= 0; --bit) {
                const int c = X0 | (1 << bit);
                int cnt = 0; const int crel = (c - lane + 63) >> 6;
#pragma unroll
                for (int j = 0; j < 64; ++j) cnt_eq(cnt, (key[j] ^ prefix) | ~(unsigned)((j - crel) >> 31), 0u);
                cnt = wave_sum_i(cnt);
                if (cnt < need) X0 = c;
            }
            X = X0 + 1;
        }
        const int xrel = (X - lane + 63) >> 6;
#pragma unroll
        for (int j4 = 0; j4 < 16; ++j4) {
            if (4 * j4 <= jlim) {
#pragma unroll
                for (int e = 0; e < 4; ++e) { const int j = 4 * j4 + e;
                    const bool sel = (key[j] > prefix) || (key[j] == prefix && j < xrel);
                    const unsigned long long bm = __ballot(sel);
                    asm("v_writelane_b32 %0, %1, %2" : "+v"(wlo) : "s"((unsigned)bm), "n"(j));
                    asm("v_writelane_b32 %0, %1, %2" : "+v"(whi) : "s"((unsigned)(bm >> 32)), "n"(j)); }
            }
        }
        mrow[lane] = make_uint2(wlo, whi);
        ITS_E(33); ITS_B();
}
__device__ void index_fast_phase(int WV_, const bf16* P, unsigned char* mask, float* kmean, float* scratch_all, unsigned* qctr, unsigned char* lds) {
    const int tid = LTID(WV_), lane = tid & 63, wave = tid >> 6, bid = LBID(), G = LGRID();
    float* s_part = (float*)lds;
    ITS_B();
    for (int k = bid; k < 256; k += G) {
        const int b = k >> 6, h = (k >> 4) & 3, blk = k & 15;
        const bf16* kp = P + (size_t)(b * S_ + blk * 256 + wave * 32) * NP + C_KC + h * 64 + lane;
        float a = 0.f;
#pragma unroll 8
        for (int j = 0; j < 32; ++j) a += bf2f(kp[(size_t)j * NP]);
        __syncthreads();
        s_part[wave * 64 + lane] = a;
        __syncthreads();
        if (tid < 64) { float s = 0.f;
#pragma unroll
            for (int w = 0; w < 8; ++w) s += s_part[w * 64 + tid];
            kmean[((b * 4 + h) * 16 + blk) * 64 + tid] = s * (1.0f / 256.0f); }
    }
    ITS_E(22);
    constexpr int IDX_CP = 512 + 4;
    constexpr int IDX_PITCH = 4096 + 32;
    float* scr = scratch_all + (size_t)bid * (16 * IDX_PITCH);
    const int lq = lane & 15, g4 = lane >> 4;
    for (int ui = bid; ui < 1024; ui += G) {
        const int b = ui >> 8, k = ui & 255, tile = (b & 1) ? 255 - k : k, q0 = tile * 16;
        const bf16* Pb = P + (size_t)b * S_ * NP;
        const int ntiles = tile + 1;
        int lane_o = LANEID(); asm volatile("" : "+v"(lane_o));
        const int lane = lane_o, lq = lane & 15, g4 = lane >> 4;
        const int wave = WV_;
        const int qA = q0 + 2 * wave, qB = qA + 1;
        uint2* mrowA = (uint2*)(mask + (size_t)(b * S_ + qA) * 512); uint2* mrowB = (uint2*)(mask + (size_t)(b * S_ + qB) * 512);
        if (tile < 16) {
            unsigned wlo = 0u, whi = 0u, xlo = 0u, xhi = 0u; const int ra = qA - lane * 64, rb = qB - lane * 64;
#pragma unroll
            for (int j = 0; j < 32; ++j) { wlo |= (~(unsigned)((ra - j) >> 31) & 1u) << j; whi |= (~(unsigned)((ra - 32 - j) >> 31) & 1u) << j;
                                           xlo |= (~(unsigned)((rb - j) >> 31) & 1u) << j; xhi |= (~(unsigned)((rb - 32 - j) >> 31) & 1u) << j; }
            mrowA[lane] = make_uint2(wlo, whi); mrowB[lane] = make_uint2(xlo, xhi);
            continue;
        }
        ITS_B();
        bf16x8_t qf[8]; float wi[8];
        { const bf16* qp = Pb + (size_t)(q0 + lq) * NP + C_QI + 8 * g4;
#pragma unroll
          for (int h = 0; h < 8; ++h) qf[h] = *(const bf16x8_t*)(qp + 32 * h);
          const uint4 wv = *(const uint4*)(Pb + (size_t)(q0 + lq) * NP + C_WI); unpack8(wv, wi); }
        bf16x8_t qch, qcl;
        { typedef unsigned u32x4_t __attribute__((ext_vector_type(4)));
          float qc[8];
#pragma unroll
          for (int i = 0; i < 8; ++i) qc[i] = 0.f;
#pragma unroll
          for (int h = 0; h < 8; ++h) { const u32x4_t w4 = __builtin_bit_cast(u32x4_t, qf[h]);
#pragma unroll
              for (int i = 0; i < 4; ++i) { qc[2 * i] += wi[h] * __uint_as_float(w4[i] << 16); qc[2 * i + 1] += wi[h] * __uint_as_float(w4[i] & 0xffff0000u); } }
          u32x4_t hi4, lo4;
#pragma unroll
          for (int i = 0; i < 4; ++i) { const unsigned hw = cvtpk(qc[2 * i], qc[2 * i + 1]); hi4[i] = hw;
              lo4[i] = cvtpk(qc[2 * i] - __uint_as_float(hw << 16), qc[2 * i + 1] - __uint_as_float(hw & 0xffff0000u)); }
          qch = __builtin_bit_cast(bf16x8_t, hi4); qcl = __builtin_bit_cast(bf16x8_t, lo4); }
        typedef __attribute__((address_space(3))) bf16x8_t lds_bf16x8;
        lds_bf16x8* qops = (lds_bf16x8*)((__attribute__((address_space(3))) unsigned char*)lds + 102656);
        if (wave == 0) {
#pragma unroll
            for (int h = 0; h < 8; ++h) qops[h * 64 + lane] = qf[h];
            qops[8 * 64 + lane] = qch; qops[9 * 64 + lane] = qcl; }
        __syncthreads();
        ITS_E(20); ITS_B();
        float* cb0 = (float*)(lds + 69632); float* cb1 = (float*)(lds + 112896);
        const int jlim = q0 >> 6;
        const int jmaxA = (qA - lane) >> 6, jmaxB = (qB - lane) >> 6;
        unsigned keyA[64], keyB[64];
        unsigned a0 = 0u, a1 = 0u, a2 = 0u, a3 = 0u, b0 = 0u, b1 = 0u, b2 = 0u, b3 = 0u;
        const bf16* kbase = Pb + (size_t)lq * NP + C_KI + 8 * g4;
        bf16x8_t nxt = *(const bf16x8_t*)(kbase + (size_t)(wave < ntiles ? wave : 0) * 16 * NP);
#pragma unroll
        for (int c = 0; c < 8; ++c) {
            if (32 * c < ntiles) {
                float* cb = (c & 1) ? cb1 : cb0;
#pragma unroll
                for (int j = 0; j < 4; ++j) {
                    const int kt = 32 * c + wave + 8 * j;
                    const bf16x8_t af = nxt;
                    { const int k = kt + 8; const int kc = k < ntiles ? k : 0; nxt = *(const bf16x8_t*)(kbase + (size_t)kc * 16 * NP); }
                    if (kt < ntiles) {
                        const f32x4_t z = {0.f, 0.f, 0.f, 0.f};
                        f32x4_t sc = __builtin_amdgcn_mfma_f32_16x16x32_bf16(af, qops[8 * 64 + lane], z, 0, 0, 0);
                        sc = __builtin_amdgcn_mfma_f32_16x16x32_bf16(af, qops[9 * 64 + lane], sc, 0, 0, 0);
#pragma unroll
                        for (int hh = 0; hh < 2; ++hh) {
                            f32x4_t a[4];
#pragma unroll
                            for (int h = 0; h < 4; ++h) a[h] = __builtin_amdgcn_mfma_f32_16x16x32_bf16(af, qops[(4 * hh + h) * 64 + lane], z, 0, 0, 0);
#pragma unroll
                            for (int h = 0; h < 4; ++h)
#pragma unroll
                                for (int r = 0; r < 4; ++r) sc[r] = __builtin_fmaf(__builtin_fabsf(a[h][r]), wi[4 * hh + h], sc[r]);
                        }
#pragma unroll
                        for (int r = 0; r < 4; ++r) { sc[r] *= 0.03125f; if (sc[r] == 0.f) sc[r] = 0.f; }
                        *(f32x4_t*)(cb + lq * IDX_CP + (wave + 8 * j) * 16 + 4 * g4) = sc;
                    }
                }
                __syncthreads();
#pragma unroll
                for (int js = 0; js < 8; ++js) {
                    const int slot = 8 * c + js;
                    if (slot <= jlim) {
                        const unsigned ua = __float_as_uint(cb[(2 * wave) * IDX_CP + 64 * js + lane]), ub = __float_as_uint(cb[(2 * wave + 1) * IDX_CP + 64 * js + lane]);
                        const unsigned xa = (ua ^ ((unsigned)((int)ua >> 31) | 0x80000000u)) & ~(unsigned)((jmaxA - slot) >> 31);
                        const unsigned xb = (ub ^ ((unsigned)((int)ub >> 31) | 0x80000000u)) & ~(unsigned)((jmaxB - slot) >> 31);
                        keyA[slot] = xa; keyB[slot] = xb;
                        unsigned n1, n2, n3;
                        asm("v_med3_u32 %0, %1, %2, %3" : "=v"(n3) : "v"(a2), "v"(a3), "v"(xa));
                        asm("v_med3_u32 %0, %1, %2, %3" : "=v"(n2) : "v"(a1), "v"(a2), "v"(xa));
                        asm("v_med3_u32 %0, %1, %2, %3" : "=v"(n1) : "v"(a0), "v"(a1), "v"(xa));
                        a0 = a0 > xa ? a0 : xa; a1 = n1; a2 = n2; a3 = n3;
                        asm("v_med3_u32 %0, %1, %2, %3" : "=v"(n3) : "v"(b2), "v"(b3), "v"(xb));
                        asm("v_med3_u32 %0, %1, %2, %3" : "=v"(n2) : "v"(b1), "v"(b2), "v"(xb));
                        asm("v_med3_u32 %0, %1, %2, %3" : "=v"(n1) : "v"(b0), "v"(b1), "v"(xb));
                        b0 = b0 > xb ? b0 : xb; b1 = n1; b2 = n2; b3 = n3;
                    } else { keyA[slot] = 0u; keyB[slot] = 0u; }
                }
            } else {
#pragma unroll
                for (int js = 0; js < 8; ++js) { keyA[8 * c + js] = 0u; keyB[8 * c + js] = 0u; }
            }
        }
        lds_u32* hist = (lds_u32*)((__attribute__((address_space(3))) unsigned char*)lds + 2048) + wave * 2048;
        ITS_E(23); ITS_B();
        idx_select(keyA, a3, jlim, hist, lane, mrowA, WV_, lds);
        ITS_E(24); ITS_B();
        idx_select(keyB, b3, jlim, hist, lane, mrowB, WV_, lds);
        ITS_E(25); ITS_B();
        __syncthreads();
    }
}

constexpr int MG_P = 72;
constexpr int MG_TILE_BYTES = 128 * MG_P * 2;
__device__ void merge_fast_phase(int WV_, const unsigned char* G8, const bf16* ys, const bf16* wbt  , bf16* merged, unsigned char* lds) {
    const int tid = LTID(WV_), lane = tid & 63, wave = tid >> 6, r32 = lane & 31, hi = lane >> 5, wt = wave & 3, wd = wave >> 2;
    const int srow0 = tid >> 3, sch = tid & 7;
    for (int tile = LBID(); tile < 1024; tile += LGRID()) {
        const int tok0 = (tile >> 3) * 128, d0 = (tile & 7) * 128;
        f32x16_t mer[2], acc[2];
#pragma unroll
        for (int r = 0; r < 16; ++r) { mer[0][r] = 0.f; mer[1][r] = 0.f; acc[0][r] = 0.f; acc[1][r] = 0.f; }
        uint4 RW00, RW01, RW10, RW11, RY00, RY01, RY10, RY11, RG0, RG1;
        unsigned char* gl = lds + 4 * MG_TILE_BYTES;
        const int grow = tid >> 3, gch = tid & 7;
#define MG_GLOAD(st_, R_) do { const int n_ = (st_) >> 2, kc_ = (st_) & 3; \
            RW##R_##0 = *(const uint4*)(wbt + ((size_t)n_ * 1024 + d0 + srow0) * 256 + kc_ * 64 + sch * 8); \
            RW##R_##1 = *(const uint4*)(wbt + ((size_t)n_ * 1024 + d0 + srow0 + 64) * 256 + kc_ * 64 + sch * 8); \
            RY##R_##0 = *(const uint4*)(ys + (size_t)(tok0 + srow0) * 1024 + n_ * 256 + kc_ * 64 + sch * 8); \
            RY##R_##1 = *(const uint4*)(ys + (size_t)(tok0 + srow0 + 64) * 1024 + n_ * 256 + kc_ * 64 + sch * 8); } while (0)
#define MG_SSTORE(buf_, R_) do { bf16* wl_ = (bf16*)(lds + (buf_) * 2 * MG_TILE_BYTES); bf16* yl_ = (bf16*)(lds + (buf_) * 2 * MG_TILE_BYTES + MG_TILE_BYTES); \
            *(uint4*)(wl_ + srow0 * MG_P + sch * 8) = RW##R_##0; *(uint4*)(wl_ + (srow0 + 64) * MG_P + sch * 8) = RW##R_##1; \
            *(uint4*)(yl_ + srow0 * MG_P + sch * 8) = RY##R_##0; *(uint4*)(yl_ + (srow0 + 64) * MG_P + sch * 8) = RY##R_##1; } while (0)
        __syncthreads();
        MG_GLOAD(0, 0); MG_GLOAD(1, 1);
        MG_SSTORE(0, 0);
        __syncthreads();
#define MG_STAGE(PAR_, OTH_) do { const int buf = PAR_; \
            if (st + 2 < 16) MG_GLOAD(st + 2, PAR_); \
            if ((st & 3) == 1) { const unsigned char* gsrc = G8 + (size_t)(tok0 + grow) * 4096 + (st >> 2) * 1024 + d0 + gch * 16; \
                RG0 = *(const uint4*)gsrc; RG1 = *(const uint4*)(gsrc + (size_t)64 * 4096); } \
            const bf16* wl = (const bf16*)(lds + buf * 2 * MG_TILE_BYTES); const bf16* yl = (const bf16*)(lds + buf * 2 * MG_TILE_BYTES + MG_TILE_BYTES); \
            _Pragma("unroll") for (int ks = 0; ks < 4; ++ks) { \
                const bf16x8_t bq = *(const bf16x8_t*)(yl + (32 * wt + r32) * MG_P + 16 * ks + 8 * hi); \
                const bf16x8_t a0 = *(const bf16x8_t*)(wl + (64 * wd + r32) * MG_P + 16 * ks + 8 * hi); \
                const bf16x8_t a1 = *(const bf16x8_t*)(wl + (64 * wd + 32 + r32) * MG_P + 16 * ks + 8 * hi); \
                acc[0] = __builtin_amdgcn_mfma_f32_32x32x16_bf16(a0, bq, acc[0], 0, 0, 0); \
                acc[1] = __builtin_amdgcn_mfma_f32_32x32x16_bf16(a1, bq, acc[1], 0, 0, 0); } \
            if ((st & 3) == 3) { \
                const int n = st >> 2; \
                const unsigned char* gp = gl + (32 * wt + r32) * 144 + 64 * wd + 4 * hi; (void)n; \
                _Pragma("unroll") for (int dt = 0; dt < 2; ++dt) \
                _Pragma("unroll") for (int g = 0; g < 4; ++g) { \
                        const int gv = *(const int*)(gp + 32 * dt + 8 * g); \
                        mer[dt][4 * g + 0] += acc[dt][4 * g + 0] * __builtin_amdgcn_cvt_f32_fp8(gv, 0); \
                        mer[dt][4 * g + 1] += acc[dt][4 * g + 1] * __builtin_amdgcn_cvt_f32_fp8(gv, 1); \
                        mer[dt][4 * g + 2] += acc[dt][4 * g + 2] * __builtin_amdgcn_cvt_f32_fp8(gv, 2); \
                        mer[dt][4 * g + 3] += acc[dt][4 * g + 3] * __builtin_amdgcn_cvt_f32_fp8(gv, 3); } \
                _Pragma("unroll") for (int r = 0; r < 16; ++r) { acc[0][r] = 0.f; acc[1][r] = 0.f; } } \
            if (st + 1 < 16) MG_SSTORE(OTH_, OTH_); \
            if ((st & 3) == 2) { *(uint4*)(gl + grow * 144 + gch * 16) = RG0; *(uint4*)(gl + (grow + 64) * 144 + gch * 16) = RG1; } \
            __syncthreads(); } while (0)
#pragma unroll 1
        for (int st2 = 0; st2 < 16; st2 += 2) { { const int st = st2; MG_STAGE(0, 1); } { const int st = st2 + 1; MG_STAGE(1, 0); } }
#undef MG_STAGE
#undef MG_GLOAD
#undef MG_SSTORE
        bf16* mp = merged + (size_t)(tok0 + 32 * wt + r32) * 1024 + d0 + 64 * wd + 4 * hi;
#pragma unroll
        for (int dt = 0; dt < 2; ++dt)
#pragma unroll
            for (int g = 0; g < 4; ++g)
                *(uint2*)(mp + 32 * dt + 8 * g) = make_uint2(cvtpk(mer[dt][4 * g], mer[dt][4 * g + 1]), cvtpk(mer[dt][4 * g + 2], mer[dt][4 * g + 3]));
    }
}
#define LAS __attribute__((address_space(3)))
#define XB_TMO      128
#define XB_XCNT(j)  (256  + 64 * (j))
#define XB_XSUB(j)  (1280 + 64 * (j))
#define XB_XGEN(j)  (2304 + 64 * (j))
#define XB_TOP      3328
#define XB_TOPGEN   3392
#define XCD_BAR_WORDS 3456
#define XB_SPIN_CAP (1u << 18)

__device__ __forceinline__ unsigned xb_ld(unsigned* p)              { return __hip_atomic_load(p, __ATOMIC_RELAXED, __HIP_MEMORY_SCOPE_AGENT); }
__device__ __forceinline__ unsigned xb_add(unsigned* p, unsigned v) { return __hip_atomic_fetch_add(p, v, __ATOMIC_RELAXED, __HIP_MEMORY_SCOPE_AGENT); }
__device__ __forceinline__ unsigned xb_xcc_id() { return (unsigned)__builtin_amdgcn_s_getreg((3 << 11) | 20) & 0xFu; }
#define XB_SPIN(cond, bar) do { unsigned _sp = 0; while (cond) { __builtin_amdgcn_s_sleep(1); \
    if ((++_sp & 255u) == 0u) { if (xb_ld(&(bar)[XB_TMO])) break; if (_sp > XB_SPIN_CAP) { atomicAdd(&(bar)[XB_TMO], 1u); break; } } } } while (0)

struct XcdBarrier {
    unsigned* bar; unsigned x;
    volatile LAS unsigned* st;
};

__device__ __forceinline__ XcdBarrier xcd_barrier_post(unsigned* bar, volatile LAS unsigned* st) {
    XcdBarrier b; b.bar = bar; b.x = xb_xcc_id(); b.st = st;
    if (threadIdx.x == 0) (void)xb_add(&bar[XB_XCNT(b.x)], 1u);
    return b;
}
__device__ __forceinline__ void xcd_barrier_complete(unsigned* bar, unsigned x, unsigned& nloc, unsigned& nx) {
    const unsigned G = gridDim.x * gridDim.y * gridDim.z;
    unsigned sum, cnt, mine, sp = 0u;
    for (;;) {
        sum = 0u; cnt = 0u; mine = 0u;
#pragma unroll
        for (unsigned j = 0; j < 16; ++j) { const unsigned c = xb_ld(&bar[XB_XCNT(j)]); sum += c; cnt += (c > 0u) ? 1u : 0u; mine = (j == x) ? c : mine; }
        if (sum == G) break;
        __builtin_amdgcn_s_sleep(1);
        if ((++sp & 255u) == 0u) { if (xb_ld(&bar[XB_TMO])) break; if (sp > XB_SPIN_CAP) { atomicAdd(&bar[XB_TMO], 1u); break; } }
    }
    nloc = mine > 0u ? mine : 1u; nx = cnt > 0u ? cnt : 1u;
}

__device__ __forceinline__ void xcd_barrier(const XcdBarrier& b, int wv_) {
    asm volatile("s_waitcnt vmcnt(0)" ::: "memory");
    __syncthreads();
    if (wv_ == 0 && LANEID() == 0) {
        unsigned* bar = b.bar;
        __builtin_amdgcn_s_waitcnt(0);
        unsigned nloc = b.st[0], nx = b.st[1];
        if (nloc == 0u) { xcd_barrier_complete(bar, b.x, nloc, nx); b.st[0] = nloc; b.st[1] = nx; }
        const unsigned old = xb_add(&bar[XB_XSUB(b.x)], 1u);
        const unsigned gen = old / nloc;
        if (old + 1u == (gen + 1u) * nloc) {
            __builtin_amdgcn_fence(__ATOMIC_RELEASE, "agent");
            asm volatile("s_waitcnt vmcnt(0)" ::: "memory");
            const unsigned og = xb_add(&bar[XB_TOP], 1u);
            const unsigned tg = og / nx;
            if (og + 1u == (tg + 1u) * nx) xb_add(&bar[XB_TOPGEN], 1u);
            else XB_SPIN(xb_ld(&bar[XB_TOPGEN]) == tg, bar);
            __builtin_amdgcn_fence(__ATOMIC_ACQUIRE, "agent");
            xb_add(&bar[XB_XGEN(b.x)], 1u);
            asm volatile("s_waitcnt vmcnt(0)" ::: "memory");
        } else {
            XB_SPIN(xb_ld(&bar[XB_XGEN(b.x)]) == gen, bar);
            __builtin_amdgcn_fence(__ATOMIC_ACQUIRE, "agent");
            asm volatile("s_waitcnt vmcnt(0)" ::: "memory");
        }
    }
    __syncthreads();
}

enum { PH_PRO = 0, PH_GIN, PH_INDEX, PH_ATTN, PH_MERGE, PH_GOUT, PH_LN1, PH_GQ, PH_ROUTE, PH_PEER };
template <int PH> __device__ __forceinline__ void run_phase(int WV_, const Params& p_unused, int l, unsigned char* lds_raw) {
    size_t kaoff_ = 0; asm volatile("" : "+s"(kaoff_));
    typedef const __attribute__((address_space(4))) char* kaptr_t;
    const __attribute__((address_space(4))) Params& p = *(const __attribute__((address_space(4))) Params*)((kaptr_t)__builtin_amdgcn_kernarg_segment_ptr() + kaoff_);
    float* sm = (float*)lds_raw;
    size_t wsoff_ = 0; asm volatile("" : "+s"(wsoff_));
    unsigned char* ws = p.ws + wsoff_;
    float* hbuf = p.out;
    bf16* hb = (bf16*)(ws + WS_HB);
    bf16* P = (bf16*)(ws + WS_P);
    bf16* ys = (bf16*)(ws + WS_YS);
    bf16* mrg = (bf16*)(ws + WS_MRG);
    float* mix = (float*)(ws + WS_MIX);
    float* qb = (float*)(ws + WS_Q);
    unsigned char* mask = ws + WS_MASK;
    int* eid = (int*)(ws + WS_EID);
    float* gate = (float*)(ws + WS_GATE);
    float* kmean = (float*)(ws + WS_KMEAN);
    const float* hin = (l == 0) ? p.in[0] : hbuf;
    if (PH == PH_PRO) { Params pc; for (int i = 0; i < 13; ++i) pc.in[i] = p.in[i]; pc.out = p.out; pc.ws = ws;
        prologue_phase(WV_, pc, sm); convert_tables(WV_, pc);
        for (int i = LBID() * NTHR + LTID(WV_); i < DEPTH_ * 8 * 2 * 128 * 64 / 4; i += LGRID() * NTHR) { const float4 v = ((const float4*)p.in[8])[i]; ((uint2*)(ws + WS_SKB))[i] = make_uint2(pk2(v.x, v.y), pk2(v.z, v.w)); } if (LBID() < 2) build_unit_table((unsigned*)(ws + WS_CTL) + 1024, LBID() * NTHR + LTID(WV_)); }
    else if (PH == PH_GIN) {
        pg8::Gemm g{hb, (const bf16*)(ws + WS_WIN_T + l * WIN_T_BYTES), T_, NP, 1024};
        pg8::StaticOrder S; S.init(T_, NP, (int)LGRID(), (int)LBID());
        pg8::EpiBf16Sig E{P, NP, C_G, ws + WS_G8};
        pg8::gemm_phase<pg8::EpiBf16Sig, pg8::StaticOrder, true, true>(WV_, (PG8_LAS unsigned char*)lds_raw, g, S, E);
    }
    else if (PH == PH_INDEX) index_fast_phase(WV_, P, mask, kmean, (float*)(ws + WS_UV + 48 * MiB), (unsigned*)(ws + WS_CTL) + 64 * l + 16, lds_raw);
    else if (PH == PH_ATTN) attn_fast_phase(WV_, P, mask, kmean, p.in[4] + l * 4, ys, (const unsigned*)(ws + WS_CTL) + 1024, (unsigned*)(ws + WS_CTL) + 64 * l, lds_raw);
    else if (PH == PH_MERGE) merge_fast_phase(WV_, ws + WS_G8, ys, (const bf16*)(ws + WS_WBR_T) + (size_t)l * 4 * 1024 * 256, mrg, lds_raw);
    else if (PH == PH_GOUT) {
        pg8::Gemm g{mrg, (const bf16*)(ws + WS_WOUT_T) + (size_t)l * 1024 * 1024, T_, 1024, 1024};
        pg8::StaticOrder S; S.init(T_, 1024, (int)LGRID(), (int)LBID());
        pg8::EpiResY E{l == 0 ? hin : nullptr, hb, hb, (float*)(ws + WS_STATS) + (size_t)l * T_ * 2, ALPHA};
        pg8::gemm_phase<pg8::EpiResY, pg8::StaticOrder, true, true>(WV_, (PG8_LAS unsigned char*)lds_raw, g, S, E);
    }
    else if (PH == PH_GQ) {
        pg8::Gemm g{hb, (const bf16*)(ws + WS_WQ_T) + (size_t)l * 1024 * 1024, T_, 1024, 1024};
        pg8::StaticOrder S; S.init(T_, 1024, (int)LGRID(), (int)LBID());
        pg8::EpiLnFold E{(bf16*)qb, (const float*)(ws + WS_STATS) + (size_t)l * T_ * 2, (const float*)(ws + WS_COLS) + l * 2048, (const float*)(ws + WS_COLS) + l * 2048 + 1024, LN_EPS};
        pg8::gemm_phase<pg8::EpiLnFold, pg8::StaticOrder, true, true>(WV_, (PG8_LAS unsigned char*)lds_raw, g, S, E);
        pg8::Unit u0;
        if (LGRID() == 256 && S.next(0, u0)) {
            asm volatile("s_waitcnt vmcnt(0)" ::: "memory"); __syncthreads();
            route_fast_phase(WV_, (const bf16*)qb, (const bf16*)(ws + WS_SKB) + (size_t)l * 8 * 2 * 128 * 64, eid, gate, lds_raw, u0.pm, u0.pn);
        }
    }
    else if (PH == PH_ROUTE) { if (LGRID() != 256) route_fast_phase(WV_, (const bf16*)qb, (const bf16*)(ws + WS_SKB) + (size_t)l * 8 * 2 * 128 * 64, eid, gate, lds_raw); }
    else peer_fast_phase(WV_, (l + 1 == DEPTH_) ? hbuf : nullptr, hb, eid, gate, ws + WS_UV + (size_t)l * 24 * MiB, p.in[5] + l * 1024, p.in[6] + l * 1024, p.in[11] + l * 1024, p.in[12] + l * 1024, lds_raw);
}

constexpr int CW_BAR = 4096;
constexpr int LDS_BARST = LDS_BYTES - 16;
__global__ void __launch_bounds__(NTHR, 2) mk_fwd(Params p) {
    extern __shared__ __attribute__((aligned(16))) unsigned char lds_raw[];
    cg::grid_group grid = cg::this_grid();
    const int WV_ = __builtin_amdgcn_readfirstlane((int)threadIdx.x >> 6);
    { volatile LAS unsigned* bst0 = (volatile LAS unsigned*)((LAS unsigned char*)lds_raw + LDS_BARST); if (threadIdx.x < 4) bst0[threadIdx.x] = 0u; }
    __syncthreads();
    volatile LAS unsigned* bst = (volatile LAS unsigned*)((LAS unsigned char*)lds_raw + LDS_BARST);
    { uint4* z = (uint4*)p.ws; const uint4 z4 = make_uint4(0u, 0u, 0u, 0u);
      for (unsigned i = (unsigned)LBID() * NTHR + (unsigned)LTID(WV_); i < (unsigned)(2 * MiB / 16); i += (unsigned)LGRID() * NTHR) z[i] = z4; }
    grid.sync();
    (void)xcd_barrier_post((unsigned*)(p.ws + WS_CTL) + CW_BAR, bst);
#define GRID_BAR() do { XcdBarrier b_; b_.bar = (unsigned*)(p.ws + WS_CTL) + CW_BAR; b_.x = xb_xcc_id(); b_.st = (volatile LAS unsigned*)((LAS unsigned char*)lds_raw + LDS_BARST); xcd_barrier(b_, WV_); } while (0)
    run_phase<PH_PRO>(WV_, p, 0, lds_raw);
    GRID_BAR();
#pragma unroll 1
    for (int l = 0; l < DEPTH_; ++l) {
        run_phase<PH_GIN>(WV_, p, l, lds_raw); GRID_BAR();
        run_phase<PH_INDEX>(WV_, p, l, lds_raw); GRID_BAR();
        run_phase<PH_ATTN>(WV_, p, l, lds_raw); GRID_BAR();
        run_phase<PH_MERGE>(WV_, p, l, lds_raw); GRID_BAR();
        run_phase<PH_GOUT>(WV_, p, l, lds_raw); GRID_BAR();
        run_phase<PH_GQ>(WV_, p, l, lds_raw); if (LGRID() != 256) { GRID_BAR(); run_phase<PH_ROUTE>(WV_, p, l, lds_raw); } GRID_BAR();
        run_phase<PH_PEER>(WV_, p, l, lds_raw); if (l + 1 < DEPTH_) GRID_BAR();
    }
}

extern "C" void kernel_launch(void* const* d_in, const int* in_sizes, int n_in, void* d_out, int out_size, void* d_ws, size_t ws_size, hipStream_t stream) {
    if (n_in != 13 || ws_size < WS_END) { fprintf(stderr, "kernel_launch: unexpected n_in %d / ws_size %zu; nothing launched\n", n_in, ws_size); return; }
    static int grid_blocks = 0;
    if (grid_blocks == 0) {
        int dev = 0, cus = 0, per_cu = 0;
        (void)hipGetDevice(&dev);
        (void)hipDeviceGetAttribute(&cus, hipDeviceAttributeMultiprocessorCount, dev);
        (void)hipFuncSetAttribute((const void*)mk_fwd, hipFuncAttributeMaxDynamicSharedMemorySize, LDS_BYTES);
        (void)hipOccupancyMaxActiveBlocksPerMultiprocessor(&per_cu, (const void*)mk_fwd, NTHR, LDS_BYTES);
        if (per_cu < 1) fprintf(stderr, "kernel_launch: occupancy query reports %d\n", per_cu);
        grid_blocks = cus;
    }
    Params p{};
    for (int i = 0; i < 13; ++i) p.in[i] = (const float*)d_in[i];
    p.out = (float*)d_out; p.ws = (unsigned char*)d_ws;
    void* args[] = {&p};
    hipError_t e = hipLaunchCooperativeKernel((const void*)mk_fwd, dim3(grid_blocks), dim3(NTHR), args, LDS_BYTES, stream);
    if (e != hipSuccess) fprintf(stderr, "cooperative launch failed: %s (grid %d)\n", hipGetErrorString(e), grid_blocks);
}
```

```cpp
#include <hip/hip_runtime.h>
#include <cstdio>
#include <cstdint>
#include <hip/hip_cooperative_groups.h>
namespace cg = cooperative_groups;

__device__ __forceinline__ int LANEID() { int l; asm volatile("v_mbcnt_lo_u32_b32 %0, -1, 0\n\tv_mbcnt_hi_u32_b32 %0, -1, %0" : "=v"(l)); return l; }
__device__ __forceinline__ int LTID(int wv) { return (wv << 6) | LANEID(); }
__device__ __forceinline__ int LBID() { int t = blockIdx.x; asm volatile("" : "+s"(t)); return t; }
__device__ __forceinline__ int LGRID() { int t = gridDim.x; asm volatile("" : "+s"(t)); return t; }
namespace pg8 {
#define PG8_LAS __attribute__((address_space(3)))
typedef unsigned short bf16_t;
typedef short bf16x8 __attribute__((ext_vector_type(8)));
typedef float f32x4 __attribute__((ext_vector_type(4)));
typedef unsigned u32x4 __attribute__((ext_vector_type(4)));
constexpr int BM = 256, BK = 64, HALF = 128, HTB = HALF * BK * 2  , STAGE_BYTES = 8 * HTB, NXCD = 8, WGM = 8;

__host__ __device__ __forceinline__ int lds_byte(int r, int c) { const int st = (r >> 4) * 2 + (c >> 5), rr = r & 15, cc = c & 31, ob = rr * 64 + cc * 2; return st * 1024 + (ob ^ (((ob >> 9) & 1) << 5)); }
__host__ __device__ __forceinline__ void stage_rc(int b, int& R, int& C) { const int st = b / 1024, sb = b % 1024, swz = sb ^ (((sb >> 9) & 1) << 5); R = (st >> 1) * 16 + swz / 64; C = (st & 1) * 32 + (swz % 64) / 2; }
__host__ __device__ __forceinline__ int perm32(int rho) { const int n = rho >> 4, i = rho & 15; return 8 * (i >> 2) + 4 * n + (i & 3); }

struct Unit { int pm, pn; };
struct Gemm { const bf16_t* A; const bf16_t* Bt; int M, N, K; };

struct StaticOrder {
    int nM, nN, nwg, G, c;
    __host__ __device__ void init(int M, int N, int G_, int c_) { nM = M / BM; nN = N / BM; nwg = nM * nN; G = G_; c = c_; }
    __host__ __device__ bool next(int i, Unit& u) const {
        const long L = (long)i * G + c; if (L >= nwg) return false;
        int wgid = (int)L; { const int q = nwg / NXCD, r = nwg % NXCD, xcd = wgid % NXCD, off = wgid / NXCD; wgid = (xcd < r ? xcd * (q + 1) : r * (q + 1) + (xcd - r) * q) + off; }
        const int nig = WGM * nN, gid = wgid / nig, fm = gid * WGM, gsz = (nM - fm) < WGM ? (nM - fm) : WGM;
        u.pm = fm + ((wgid % nig) % gsz); u.pn = (wgid % nig) / gsz; return true;
    }
    __device__ __forceinline__ void a_ready(const Unit&) const {}
    __device__ __forceinline__ void done(const Unit&) const {}
};

__device__ __forceinline__ unsigned cvt_pk_bf16(float lo, float hi) { unsigned r; asm volatile("v_cvt_pk_bf16_f32 %0, %1, %2" : "=v"(r) : "v"(lo), "v"(hi)); return r; }
typedef float f32x2 __attribute__((ext_vector_type(2)));
__device__ __forceinline__ f32x2 gelu_pk(f32x2 v) {
    const f32x2 av = __builtin_elementwise_abs(v), d = av * 0.2316418882f + 1.0f;
    f32x2 t; t.x = __builtin_amdgcn_rcpf(d.x); t.y = __builtin_amdgcn_rcpf(d.y);
    f32x2 q = t * 0.5307027145f + (-0.7265760135f); q = q * t + 0.7107068705f; q = q * t + (-0.142248368f); q = q * t + 0.127414796f; q = q * t;
    const f32x2 s = (v * v) * (-0.72134752044f);
    f32x2 e; e.x = __builtin_amdgcn_exp2f(s.x); e.y = __builtin_amdgcn_exp2f(s.y);
    const f32x2 m = v * (q * e), r = v - m;
    f32x2 o; o.x = v.x < 0.f ? m.x : r.x; o.y = v.y < 0.f ? m.y : r.y; return o;
}

template <int ACT  > struct EpiBf16 {
    static constexpr bool PERM = true, AFTER_DRAIN = false; static_assert(ACT == 0 || ACT == 1, "EpiBf16: ACT is 0 (none) or 1 (gelu_pk)");
    bf16_t* O; int ldc; const float* bias; int split_cols; size_t split_stride; float scale0;
    __device__ __forceinline__ void operator()(const f32x4 (&acc)[2][2][4][2], const Unit& u, int wr, int wc, int fr, int fq) const {
        { int ln_ = LANEID(); asm volatile("" : "+v"(ln_)); fr = ln_ & 15; fq = ln_ >> 4; }
        const int row0 = u.pm * BM + wr * 64 + fr; int colt = u.pn * BM; bf16_t* base = O;
        float sc = 1.f; if (split_cols) { const int t = colt / split_cols; base += (size_t)t * split_stride; colt -= t * split_cols; if (t == 0) sc = scale0; }
        const int col0 = colt + wc * 32 + 8 * fq, bcol0 = u.pn * BM + wc * 32 + 8 * fq;
        f32x4 bv[2][2];
#pragma unroll
        for (int bj = 0; bj < 2; ++bj)
#pragma unroll
            for (int n = 0; n < 2; ++n) bv[bj][n] = bias ? *(const f32x4*)(bias + bcol0 + bj * HALF + 4 * n) : (f32x4){0.f, 0.f, 0.f, 0.f};
#pragma unroll
        for (int ai = 0; ai < 2; ++ai)
#pragma unroll
            for (int m = 0; m < 4; ++m) { bf16_t* rowp = base + (size_t)(row0 + ai * HALF + m * 16) * ldc + col0;
#pragma unroll
                for (int bj = 0; bj < 2; ++bj) { f32x4 v0 = acc[ai][bj][m][0] + bv[bj][0], v1 = acc[ai][bj][m][1] + bv[bj][1];
                    if (ACT == 1) { f32x2 a = gelu_pk((f32x2){v0[0], v0[1]}), b = gelu_pk((f32x2){v0[2], v0[3]}), c = gelu_pk((f32x2){v1[0], v1[1]}), d = gelu_pk((f32x2){v1[2], v1[3]});
                        v0 = (f32x4){a.x, a.y, b.x, b.y}; v1 = (f32x4){c.x, c.y, d.x, d.y}; }
                    v0 = v0 * sc; v1 = v1 * sc; u32x4 w; w.x = cvt_pk_bf16(v0[0], v0[1]); w.y = cvt_pk_bf16(v0[2], v0[3]); w.z = cvt_pk_bf16(v1[0], v1[1]); w.w = cvt_pk_bf16(v1[2], v1[3]);
                    *(u32x4*)(rowp + bj * HALF) = w; } }
    }
};
template <class Epi, class Sched, bool ALIGN_EPI = false, bool SP2 = false>
__device__ __forceinline__ void gemm_phase(int WV_, PG8_LAS unsigned char* lds, const Gemm g, const Sched& S, const Epi& E) {
    const int tid = LTID(WV_), wid = __builtin_amdgcn_readfirstlane(tid >> 6), lane = tid & 63, wr = wid >> 2, wc = wid & 3, fr = lane & 15, fq = lane >> 4;
    const int K = g.K, nt = K / BK;
    unsigned voffA[2], voffB[2];
#pragma unroll
    for (int i = 0; i < 2; ++i) { int R, C; stage_rc(tid * 16 + i * 8192, R, C); const int Rb = Epi::PERM ? ((R & ~31) + perm32(R & 31)) : R;
        voffA[i] = (unsigned)(R * K + C) * 2u; voffB[i] = (unsigned)(Rb * K + C) * 2u; }
    const size_t kstep = (size_t)(BK * 2);
    const size_t hstep = (size_t)HALF * K * 2;
    const size_t tstep = 2 * hstep;
    const unsigned ldsw = (unsigned)wid * 1024u;
    const int aoff = lds_byte(wr * 64 + fr, fq * 8), boff = lds_byte(wc * 32 + fr, fq * 8);
#define PG8_SA(b, h) (((b) * 2 + (h)) * HTB)
#define PG8_SB(b, h) ((4 + (b) * 2 + (h)) * HTB)
#define PG8_STAGE(bufoff, gbase, voff) do { _Pragma("unroll") for (int _i = 0; _i < 2; ++_i) \
        __builtin_amdgcn_global_load_lds((const unsigned*)((const char*)(gbase) + (voff)[_i]), (PG8_LAS unsigned*)(lds + (bufoff) + ldsw + _i * 8192), 16, 0, 0); } while (0)
#define PG8_LDA(dst, b, h) do { _Pragma("unroll") for (int m = 0; m < 4; ++m) _Pragma("unroll") for (int k = 0; k < 2; ++k) dst[m][k] = *(const PG8_LAS bf16x8*)(lds + PG8_SA(b, h) + aoff + m * 2048 + k * 1024); } while (0)
#define PG8_LDB(dst, b, h) do { _Pragma("unroll") for (int n = 0; n < 2; ++n) _Pragma("unroll") for (int k = 0; k < 2; ++k) dst[n][k] = *(const PG8_LAS bf16x8*)(lds + PG8_SB(b, h) + boff + n * 2048 + k * 1024); } while (0)
#define PG8_MMA(ai, bj, At, Bt) do { __builtin_amdgcn_s_setprio(1); _Pragma("unroll") for (int m = 0; m < 4; ++m) _Pragma("unroll") for (int n = 0; n < 2; ++n) _Pragma("unroll") for (int k = 0; k < 2; ++k) \
        acc[ai][bj][m][n] = __builtin_amdgcn_mfma_f32_16x16x32_bf16(Bt[n][k], At[m][k], acc[ai][bj][m][n], 0, 0, 0); __builtin_amdgcn_s_setprio(0); } while (0)
#define PG8_WAIT_V(n) asm volatile("s_waitcnt vmcnt(" #n ")" ::: "memory")
#define PG8_WAIT_L(n) asm volatile("s_waitcnt lgkmcnt(" #n ")" ::: "memory")
#define PG8_BAR __builtin_amdgcn_s_barrier()
#define PG8_SCHED __builtin_amdgcn_sched_barrier(0)
    Unit cur, nxt; int ui = 0;
    if (!S.next(0, cur)) return;
    f32x4 acc[2][2][4][2];
#pragma unroll
    for (int a = 0; a < 2; ++a)
#pragma unroll
        for (int b = 0; b < 2; ++b)
#pragma unroll
            for (int m = 0; m < 4; ++m)
#pragma unroll
                for (int n = 0; n < 2; ++n) acc[a][b][m][n] = (f32x4){0.f, 0.f, 0.f, 0.f};
    bf16x8 At[4][2], B0[2][2], B1[2][2];
    const char* cA = (const char*)g.A + (size_t)cur.pm * tstep; const char* cB = (const char*)g.Bt + (size_t)cur.pn * tstep;
    S.a_ready(cur);
    if constexpr (SP2) {
        PG8_STAGE(PG8_SB(0, 0), cB, voffB); PG8_STAGE(PG8_SB(0, 1), cB + hstep, voffB); PG8_STAGE(PG8_SA(0, 0), cA, voffA); PG8_STAGE(PG8_SA(0, 1), cA + hstep, voffA);
        if (wr == 1) PG8_BAR;
        PG8_WAIT_V(2); PG8_BAR;
        PG8_STAGE(PG8_SB(1, 0), cB + kstep, voffB); PG8_STAGE(PG8_SA(1, 0), cA + kstep, voffA); PG8_STAGE(PG8_SB(1, 1), cB + hstep + kstep, voffB);
        PG8_WAIT_V(6); PG8_BAR;
    } else {
        PG8_STAGE(PG8_SB(0, 0), cB, voffB); PG8_STAGE(PG8_SA(0, 0), cA, voffA); PG8_STAGE(PG8_SB(0, 1), cB + hstep, voffB); PG8_STAGE(PG8_SA(0, 1), cA + hstep, voffA);
        if (wr == 1) PG8_BAR;
        PG8_WAIT_V(4); PG8_BAR;
        PG8_STAGE(PG8_SB(1, 0), cB + kstep, voffB); PG8_STAGE(PG8_SA(1, 0), cA + kstep, voffA); PG8_STAGE(PG8_SB(1, 1), cB + hstep + kstep, voffB);
        PG8_WAIT_V(6); PG8_BAR;
    }
    for (;;) {
        const bool has_next = S.next(ui + 1, nxt);
        const char* nA = has_next ? (const char*)g.A + (size_t)nxt.pm * tstep : cA; const char* nB = has_next ? (const char*)g.Bt + (size_t)nxt.pn * tstep : cB;
        for (int t = 0; t < nt; t += 2) {
            const bool last = (t == nt - 2);
            const char* a1 = cA + (size_t)(t + 1) * kstep;
            const char* a2 = last ? nA : cA + (size_t)(t + 2) * kstep; const char* b2 = last ? nB : cB + (size_t)(t + 2) * kstep;
            const char* a3 = a2 + kstep; const char* b3 = b2 + kstep;
            if (last && has_next) S.a_ready(nxt);
            if constexpr (SP2) {
            PG8_LDB(B0, 0, 0); PG8_LDB(B1, 0, 1); PG8_SCHED; PG8_LDA(At, 0, 0); PG8_STAGE(PG8_SA(1, 1), a1 + hstep, voffA);
            PG8_WAIT_V(8); PG8_WAIT_L(0); PG8_BAR; PG8_MMA(0, 0, At, B0); PG8_MMA(0, 1, At, B1); PG8_BAR; PG8_SCHED;
            PG8_LDA(At, 0, 1); PG8_STAGE(PG8_SB(0, 0), b2, voffB); PG8_STAGE(PG8_SB(0, 1), b2 + hstep, voffB); PG8_STAGE(PG8_SA(0, 0), a2, voffA);
            PG8_WAIT_V(8); PG8_WAIT_L(0); PG8_BAR; PG8_MMA(1, 0, At, B0); PG8_MMA(1, 1, At, B1); PG8_BAR; PG8_SCHED;
            PG8_LDB(B0, 1, 0); PG8_LDB(B1, 1, 1); PG8_SCHED; PG8_LDA(At, 1, 0); PG8_STAGE(PG8_SA(0, 1), a2 + hstep, voffA);
            PG8_WAIT_V(8); PG8_WAIT_L(0); PG8_BAR; PG8_MMA(0, 0, At, B0); PG8_MMA(0, 1, At, B1); PG8_BAR; PG8_SCHED;
            PG8_LDA(At, 1, 1); PG8_STAGE(PG8_SB(1, 0), b3, voffB); PG8_STAGE(PG8_SB(1, 1), b3 + hstep, voffB); PG8_STAGE(PG8_SA(1, 0), a3, voffA);
            PG8_WAIT_V(8); PG8_WAIT_L(0); PG8_BAR; PG8_MMA(1, 0, At, B0); PG8_MMA(1, 1, At, B1); PG8_BAR; PG8_SCHED;
            } else {
            PG8_LDB(B0, 0, 0); PG8_SCHED; PG8_LDA(At, 0, 0); PG8_STAGE(PG8_SA(1, 1), a1 + hstep, voffA);
            PG8_WAIT_L(8); PG8_BAR; PG8_WAIT_L(0); PG8_MMA(0, 0, At, B0); PG8_BAR; PG8_SCHED;
            PG8_LDB(B1, 0, 1); PG8_STAGE(PG8_SB(0, 0), b2, voffB);
            PG8_BAR; PG8_WAIT_L(0); PG8_MMA(0, 1, At, B1); PG8_BAR;
            PG8_LDA(At, 0, 1); PG8_STAGE(PG8_SA(0, 0), a2, voffA);
            PG8_BAR; PG8_WAIT_L(0); PG8_MMA(1, 0, At, B0); PG8_BAR; PG8_SCHED;
            PG8_STAGE(PG8_SB(0, 1), b2 + hstep, voffB);
            PG8_WAIT_V(6); PG8_BAR; PG8_MMA(1, 1, At, B1); PG8_BAR;
            PG8_LDB(B0, 1, 0); PG8_SCHED; PG8_LDA(At, 1, 0); PG8_STAGE(PG8_SA(0, 1), a2 + hstep, voffA);
            PG8_WAIT_L(8); PG8_BAR; PG8_WAIT_L(0); PG8_MMA(0, 0, At, B0); PG8_BAR; PG8_SCHED;
            PG8_LDB(B1, 1, 1); PG8_STAGE(PG8_SB(1, 0), b3, voffB);
            PG8_BAR; PG8_WAIT_L(0); PG8_MMA(0, 1, At, B1); PG8_BAR;
            PG8_LDA(At, 1, 1); PG8_STAGE(PG8_SA(1, 0), a3, voffA);
            PG8_BAR; PG8_WAIT_L(0); PG8_MMA(1, 0, At, B0); PG8_BAR; PG8_SCHED;
            PG8_STAGE(PG8_SB(1, 1), b3 + hstep, voffB);
            PG8_WAIT_V(6); PG8_BAR; PG8_MMA(1, 1, At, B1); PG8_BAR;
            }
        }
        if constexpr (ALIGN_EPI) { if (wr == 0) PG8_BAR; }
        if constexpr (!Epi::AFTER_DRAIN) { E(acc, cur, wr, wc, fr, fq); S.done(cur); }
        if (!has_next) break;
#pragma unroll
        for (int a = 0; a < 2; ++a)
#pragma unroll
            for (int b = 0; b < 2; ++b)
#pragma unroll
                for (int m = 0; m < 4; ++m)
#pragma unroll
                    for (int n = 0; n < 2; ++n) acc[a][b][m][n] = (f32x4){0.f, 0.f, 0.f, 0.f};
        cur = nxt; cA = nA; cB = nB; ++ui;
        if constexpr (ALIGN_EPI) { if (wr == 1) PG8_BAR; }
    }
    PG8_WAIT_V(0);
    if constexpr (!ALIGN_EPI) { if (wr == 0) PG8_BAR; }
    PG8_BAR;
    if constexpr (Epi::AFTER_DRAIN) { E.fused(acc, cur, wr, wc, fr, fq, lds, wid, lane); S.done(cur); }
#undef PG8_SA
#undef PG8_SB
#undef PG8_STAGE
#undef PG8_LDA
#undef PG8_LDB
#undef PG8_MMA
#undef PG8_WAIT_V
#undef PG8_WAIT_L
#undef PG8_BAR
#undef PG8_SCHED
}
}
namespace pg8 {
struct EpiF32 {
    static constexpr bool PERM = false, AFTER_DRAIN = false;
    float* O; int ldc;
    __device__ __forceinline__ void operator()(const f32x4 (&acc)[2][2][4][2], const Unit& u, int wr, int wc, int fr, int fq) const {
        { int ln_ = LANEID(); asm volatile("" : "+v"(ln_)); fr = ln_ & 15; fq = ln_ >> 4; }
        const int row0 = u.pm * BM + wr * 64 + fr, col0 = u.pn * BM + wc * 32 + 4 * fq;
#pragma unroll
        for (int ai = 0; ai < 2; ++ai)
#pragma unroll
            for (int m = 0; m < 4; ++m) { float* rowp = O + (size_t)(row0 + ai * HALF + m * 16) * ldc + col0;
#pragma unroll
                for (int bj = 0; bj < 2; ++bj)
#pragma unroll
                    for (int n = 0; n < 2; ++n) *(f32x4*)(rowp + bj * HALF + n * 16) = acc[ai][bj][m][n]; }
    }
};
struct EpiResY {
    static constexpr bool PERM = false, AFTER_DRAIN = false;
    const float* hin; const bf16_t* hinb; bf16_t* yb; float* stats; float alpha;
    __device__ __forceinline__ void operator()(const f32x4 (&acc)[2][2][4][2], const Unit& u, int wr, int wc, int fr, int fq) const {
        { int ln_ = LANEID(); asm volatile("" : "+v"(ln_)); fr = ln_ & 15; fq = ln_ >> 4; }
        const int row0 = u.pm * BM + wr * 64 + fr, col0 = u.pn * BM + wc * 32 + 4 * fq;
#pragma unroll
        for (int ai = 0; ai < 2; ++ai)
#pragma unroll
            for (int m = 0; m < 4; ++m) {
                const int row = row0 + ai * HALF + m * 16;
                float s = 0.f, s2 = 0.f;
#pragma unroll
                for (int bj = 0; bj < 2; ++bj)
#pragma unroll
                    for (int n = 0; n < 2; ++n) {
                        const size_t off = (size_t)row * 1024 + col0 + bj * HALF + n * 16;
                        f32x4 hv;
                        if (hin) hv = *(const f32x4*)(hin + off);
                        else { typedef unsigned u32x2r __attribute__((ext_vector_type(2))); const u32x2r hw = *(const u32x2r*)(hinb + off);
                            hv[0] = __uint_as_float(hw.x << 16); hv[1] = __uint_as_float(hw.x & 0xffff0000u); hv[2] = __uint_as_float(hw.y << 16); hv[3] = __uint_as_float(hw.y & 0xffff0000u); }
                        const f32x4 y = hv * alpha + acc[ai][bj][m][n];
                        typedef unsigned u32x2v __attribute__((ext_vector_type(2)));
                        u32x2v w; w.x = cvt_pk_bf16(y[0], y[1]); w.y = cvt_pk_bf16(y[2], y[3]);
                        *(u32x2v*)(yb + off) = w;
                        s += (y[0] + y[1]) + (y[2] + y[3]); s2 += (y[0] * y[0] + y[1] * y[1]) + (y[2] * y[2] + y[3] * y[3]);
                    }
                s += __shfl_xor(s, 16); s += __shfl_xor(s, 32); s2 += __shfl_xor(s2, 16); s2 += __shfl_xor(s2, 32);
                if (fq == 0) { atomicAdd(stats + 2 * (size_t)row, s); atomicAdd(stats + 2 * (size_t)row + 1, s2); }
            }
    }
};
struct EpiLnFold {
    static constexpr bool PERM = true, AFTER_DRAIN = false;
    bf16_t* O; const float* stats; const float* colsum; const float* colbias; float eps;
    __device__ __forceinline__ void operator()(const f32x4 (&acc)[2][2][4][2], const Unit& u, int wr, int wc, int fr, int fq) const {
        { int ln_ = LANEID(); asm volatile("" : "+v"(ln_)); fr = ln_ & 15; fq = ln_ >> 4; }
        const int row0 = u.pm * BM + wr * 64 + fr, col0 = u.pn * BM + wc * 32 + 8 * fq;
        f32x4 cs[2][2], cb[2][2];
#pragma unroll
        for (int bj = 0; bj < 2; ++bj)
#pragma unroll
            for (int n = 0; n < 2; ++n) { cs[bj][n] = *(const f32x4*)(colsum + col0 + bj * HALF + 4 * n); cb[bj][n] = *(const f32x4*)(colbias + col0 + bj * HALF + 4 * n); }
#pragma unroll
        for (int ai = 0; ai < 2; ++ai)
#pragma unroll
            for (int m = 0; m < 4; ++m) {
                const int row = row0 + ai * HALF + m * 16;
                const float sm_ = stats[2 * (size_t)row], sq_ = stats[2 * (size_t)row + 1];
                const float mean = sm_ * (1.0f / 1024.0f);
                const float rstd = 1.0f / sqrtf(fmaxf(sq_ * (1.0f / 1024.0f) - mean * mean, 0.f) + eps);
                bf16_t* rowp = O + (size_t)row * 1024 + col0;
#pragma unroll
                for (int bj = 0; bj < 2; ++bj) {
                    const f32x4 v0 = (acc[ai][bj][m][0] - cs[bj][0] * mean) * rstd + cb[bj][0], v1 = (acc[ai][bj][m][1] - cs[bj][1] * mean) * rstd + cb[bj][1];
                    u32x4 w; w.x = cvt_pk_bf16(v0[0], v0[1]); w.y = cvt_pk_bf16(v0[2], v0[3]); w.z = cvt_pk_bf16(v1[0], v1[1]); w.w = cvt_pk_bf16(v1[2], v1[3]);
                    *(u32x4*)(rowp + bj * HALF) = w;
                }
            }
    }
};
__device__ __forceinline__ unsigned cvt_pk_bf16_t(float lo, float hi) { unsigned r; asm volatile("s_nop 0\n\tv_cvt_pk_bf16_f32 %0, %1, %2" : "=v"(r) : "v"(lo), "v"(hi)); return r; }
struct EpiBf16Sig {
    static constexpr bool PERM = true, AFTER_DRAIN = false;
    bf16_t* O; int ldc; int sig_col0; unsigned char* G8;
    __device__ __forceinline__ void operator()(const f32x4 (&acc)[2][2][4][2], const Unit& u, int wr, int wc, int fr, int fq) const {
        { int ln_ = LANEID(); asm volatile("" : "+v"(ln_)); fr = ln_ & 15; fq = ln_ >> 4; }
        const int row0 = u.pm * BM + wr * 64 + fr; const int col0 = u.pn * BM + wc * 32 + 8 * fq;
#pragma unroll
        for (int bj = 0; bj < 2; ++bj) {
            if (col0 + bj * HALF >= sig_col0) {
                { const int gc = col0 + bj * HALF - sig_col0;
                  if (gc < 4096) {
#pragma unroll
                    for (int ai = 0; ai < 2; ++ai)
#pragma unroll
                        for (int m = 0; m < 4; ++m) {
                            f32x4 v0 = acc[ai][bj][m][0], v1 = acc[ai][bj][m][1];
#pragma unroll
                            for (int e = 0; e < 4; ++e) { v0[e] = __builtin_amdgcn_rcpf(1.f + __builtin_amdgcn_exp2f(-1.44269504f * v0[e])); v1[e] = __builtin_amdgcn_rcpf(1.f + __builtin_amdgcn_exp2f(-1.44269504f * v1[e])); }
                            int w0 = __builtin_amdgcn_cvt_pk_fp8_f32(v0[0], v0[1], 0, false); w0 = __builtin_amdgcn_cvt_pk_fp8_f32(v0[2], v0[3], w0, true);
                            int w1 = __builtin_amdgcn_cvt_pk_fp8_f32(v1[0], v1[1], 0, false); w1 = __builtin_amdgcn_cvt_pk_fp8_f32(v1[2], v1[3], w1, true);
                            typedef int i32x2v __attribute__((ext_vector_type(2)));
                            i32x2v w; w.x = w0; w.y = w1;
                            *(i32x2v*)(G8 + (size_t)(row0 + ai * HALF + m * 16) * 4096 + gc) = w; }
                  } }
            } else {
#pragma unroll
                for (int ai = 0; ai < 2; ++ai)
#pragma unroll
                    for (int m = 0; m < 4; ++m) { bf16_t* rowp = O + (size_t)(row0 + ai * HALF + m * 16) * ldc + col0;
                        const f32x4 v0 = acc[ai][bj][m][0], v1 = acc[ai][bj][m][1];
                        u32x4 w; w.x = cvt_pk_bf16(v0[0], v0[1]); w.y = cvt_pk_bf16(v0[2], v0[3]); w.z = cvt_pk_bf16(v1[0], v1[1]); w.w = cvt_pk_bf16(v1[2], v1[3]);
                        *(u32x4*)(rowp + bj * HALF) = w; }
            }
        }
    }
};
}

typedef unsigned short bf16;
constexpr int T_ = 16384, S_ = 4096, NBATCH = 4, D_ = 1024, NCOL = 6824, NP = 6912, DEPTH_ = 2;
constexpr int C_QA = 0, C_KA = 256, C_VA = 320, C_QI = 384, C_KI = 640, C_WI = 672, C_QB = 680, C_KB = 936, C_VB = 1064,
              C_QC = 1192, C_KC = 1448, C_VC = 1704, C_QD = 1960, C_KD = 2216, C_VD = 2472, C_G = 2728;
constexpr int NTHR = 512, NWAVE = 8;
constexpr float ALPHA = 1.41421356237309515f;
constexpr float LN_EPS = 1e-5f;
constexpr size_t MiB = 1u << 20;
constexpr size_t WS_STATS = 1 * MiB  , WS_COLS = 1 * MiB + 512 * 1024  ;
constexpr size_t WS_CTL = 0, WS_WIN_T = 2 * MiB, WS_WOUT_T = 30 * MiB, WS_WQ_T = 34 * MiB, WS_WBR_T = 38 * MiB, WS_HB = 42 * MiB,
                 WS_P = 74 * MiB, WS_MIX = 74 * MiB  , WS_Q = 138 * MiB  , WS_G8 = 428 * MiB  , WS_YS = 290 * MiB, WS_MRG = 322 * MiB,
                 WS_MASK = 354 * MiB, WS_EID = 362 * MiB, WS_GATE = 370 * MiB, WS_KMEAN = 378 * MiB, WS_SKB = 379 * MiB, WS_UV = 380 * MiB, WS_END = 508 * MiB;
constexpr size_t WIN_T_BYTES = (size_t)NP * 1024 * 2;
constexpr int LDS_BYTES = 144 * 1024;

struct Params { const float* in[13]; float* out; unsigned char* ws; };

__device__ __forceinline__ float bf2f(bf16 v) { return __uint_as_float((unsigned)v << 16); }
__device__ __forceinline__ unsigned f2bf(float f) { unsigned u = __float_as_uint(f); return (u + 0x7fffu + ((u >> 16) & 1u)) >> 16; }
__device__ __forceinline__ unsigned pk2(float lo, float hi) { return f2bf(lo) | (f2bf(hi) << 16); }
__device__ __forceinline__ void unpack8(const uint4 v, float* o) {
    o[0] = __uint_as_float(v.x << 16); o[1] = __uint_as_float(v.x & 0xffff0000u); o[2] = __uint_as_float(v.y << 16); o[3] = __uint_as_float(v.y & 0xffff0000u);
    o[4] = __uint_as_float(v.z << 16); o[5] = __uint_as_float(v.z & 0xffff0000u); o[6] = __uint_as_float(v.w << 16); o[7] = __uint_as_float(v.w & 0xffff0000u);
}
__device__ __forceinline__ float wave_sum(float v) {
#pragma unroll
    for (int o = 32; o > 0; o >>= 1) v += __shfl_xor(v, o);
    return v;
}
__device__ __forceinline__ float wave_max(float v) {
#pragma unroll
    for (int o = 32; o > 0; o >>= 1) v = fmaxf(v, __shfl_xor(v, o));
    return v;
}
__device__ __forceinline__ int wave_sum_i(int v) {
#pragma unroll
    for (int o = 32; o > 0; o >>= 1) v += __shfl_xor(v, o);
    return v;
}
__device__ __forceinline__ float logsig(float x) { return fminf(x, 0.f) - log1pf(expf(-fabsf(x))); }

__device__ void transpose_items(int WV_, const float* W, int K, int N, bf16* WT, float* sm, int item0, int nitems_total, int item_stride,
                                const float* rs_g = nullptr, const float* rs_b = nullptr, float* colsum = nullptr, float* colbias = nullptr) {
    const int tid = LTID(WV_);
    const int nkb = K / 64, nnb = (N + 63) / 64;
    for (int it = item0; it < nkb * nnb; it += item_stride) {
        const int kb = it % nkb, nb = it / nkb, k0 = kb * 64, n0 = nb * 64;
        __syncthreads();
        for (int e = tid; e < 64 * 64; e += NTHR) { const int kk = e >> 6, nn = e & 63; sm[kk * 65 + nn] = (n0 + nn < N) ? W[(size_t)(k0 + kk) * N + n0 + nn] : 0.f; }
        __syncthreads();
        if (rs_g) {
            if (tid < 64) { float cs = 0.f, cb = 0.f;
                for (int kk = 0; kk < 64; ++kk) { const float w = sm[kk * 65 + tid]; cs += w * rs_g[k0 + kk]; cb += w * rs_b[k0 + kk]; }
                atomicAdd(colsum + n0 + tid, cs); atomicAdd(colbias + n0 + tid, cb); }
            __syncthreads();
            for (int e = tid; e < 64 * 64; e += NTHR) { const int kk = e >> 6, nn = e & 63; sm[kk * 65 + nn] *= rs_g[k0 + kk]; }
            __syncthreads();
        }
        { const int nn = tid >> 3, c = tid & 7;
          if (n0 + nn < N) { uint4 o; o.x = pk2(sm[(8 * c + 0) * 65 + nn], sm[(8 * c + 1) * 65 + nn]); o.y = pk2(sm[(8 * c + 2) * 65 + nn], sm[(8 * c + 3) * 65 + nn]);
              o.z = pk2(sm[(8 * c + 4) * 65 + nn], sm[(8 * c + 5) * 65 + nn]); o.w = pk2(sm[(8 * c + 6) * 65 + nn], sm[(8 * c + 7) * 65 + nn]);
              *(uint4*)(WT + (size_t)(n0 + nn) * K + k0 + 8 * c) = o; } }
    }
    __syncthreads();
}
constexpr int TI_WIN = 16 * ((NCOL + 63) / 64), TI_SQ = 256, TI_LAYER = TI_WIN + 3 * TI_SQ;
#define TITEM_DECODE(it_, W_, WT_, K_, N_, k0_, n0_, fold_, l_) do { \
        l_ = (it_) / TI_LAYER; const int r_ = (it_) - l_ * TI_LAYER; \
        const int kind_ = r_ < TI_WIN ? 0 : (r_ < TI_WIN + TI_SQ ? 1 : (r_ < TI_WIN + 2 * TI_SQ ? 2 : 3)); \
        const int q_ = r_ - (kind_ == 0 ? 0 : TI_WIN + (kind_ - 1) * TI_SQ); \
        fold_ = kind_ == 2; K_ = kind_ == 3 ? 256 : 1024; N_ = kind_ == 0 ? NCOL : 1024; \
        k0_ = kind_ == 3 ? (q_ & 3) * 64 : (q_ & 15) * 64; n0_ = kind_ == 3 ? ((q_ & 63) >> 2) * 64 : (q_ >> 4) * 64; \
        const int nbr_ = q_ >> 6; \
        W_ = kind_ == 0 ? pin1 + (size_t)l_ * 1024 * NCOL : kind_ == 1 ? pin3 + (size_t)l_ * 1024 * 1024 : kind_ == 2 ? pin7 + (size_t)l_ * 1024 * 1024 : pin2 + ((size_t)l_ * 4 + nbr_) * 256 * 1024; \
        WT_ = kind_ == 0 ? (bf16*)(ws + WS_WIN_T + l_ * WIN_T_BYTES) : kind_ == 1 ? (bf16*)(ws + WS_WOUT_T) + (size_t)l_ * 1024 * 1024 : kind_ == 2 ? (bf16*)(ws + WS_WQ_T) + (size_t)l_ * 1024 * 1024 \
              : (bf16*)(ws + WS_WBR_T) + ((size_t)l_ * 4 + nbr_) * 1024 * 256; } while (0)
__device__ __forceinline__ void titem_finish(bf16* WT, int K, int N, int k0, int n0, const float* rs_g, const float* rs_b, float* colsum, float* colbias, float* sm, int tid) {
    if (rs_g) {
        if (tid < 64) { float cs = 0.f, cb = 0.f;
            for (int kk = 0; kk < 64; ++kk) { const float w = sm[kk * 65 + tid]; cs += w * rs_g[k0 + kk]; cb += w * rs_b[k0 + kk]; }
            atomicAdd(colsum + n0 + tid, cs); atomicAdd(colbias + n0 + tid, cb); }
        __syncthreads();
        for (int e = tid; e < 64 * 64; e += NTHR) { const int kk = e >> 6, nn = e & 63; sm[kk * 65 + nn] *= rs_g[k0 + kk]; }
        __syncthreads();
    }
    { const int nn = tid >> 3, c = tid & 7;
      if (n0 + nn < N) { uint4 o; o.x = pk2(sm[(8 * c + 0) * 65 + nn], sm[(8 * c + 1) * 65 + nn]); o.y = pk2(sm[(8 * c + 2) * 65 + nn], sm[(8 * c + 3) * 65 + nn]);
          o.z = pk2(sm[(8 * c + 4) * 65 + nn], sm[(8 * c + 5) * 65 + nn]); o.w = pk2(sm[(8 * c + 6) * 65 + nn], sm[(8 * c + 7) * 65 + nn]);
          *(uint4*)(WT + (size_t)(n0 + nn) * K + k0 + 8 * c) = o; } }
}
__device__ void prologue_phase(int WV_, const Params& p, float* sm) {
    const int tid = LTID(WV_), B = LBID(), G = LGRID();
    unsigned char* ws = p.ws;
    float* sm1 = sm + 64 * 65;
    const float* pin1 = p.in[1]; const float* pin2 = p.in[2]; const float* pin3 = p.in[3]; const float* pin7 = p.in[7]; const float* pin5 = p.in[5]; const float* pin6 = p.in[6];
    asm volatile("" : "+s"(pin1), "+s"(pin2), "+s"(pin3), "+s"(pin7), "+s"(pin5), "+s"(pin6));
    const int kk0 = tid >> 4, c4 = tid & 15;
    for (int it = B; it < DEPTH_ * TI_LAYER; it += 2 * G) {
        const int it2 = it + G; const bool has2 = it2 < DEPTH_ * TI_LAYER;
        const float* Wa; const float* Wb; bf16* WTa; bf16* WTb; int Ka, Na, k0a, n0a, la, Kb, Nb, k0b, n0b, lb; bool fa, fb;
        TITEM_DECODE(it, Wa, WTa, Ka, Na, k0a, n0a, fa, la);
        { const int itb = has2 ? it2 : it; TITEM_DECODE(itb, Wb, WTb, Kb, Nb, k0b, n0b, fb, lb); }
        const float4 z4 = make_float4(0.f, 0.f, 0.f, 0.f);
        const bool ina = n0a + 4 * c4 < Na, inb = n0b + 4 * c4 < Nb;
        float4 a0 = z4, a1 = z4, b0 = z4, b1 = z4;
        if (ina) { a0 = *(const float4*)(Wa + (size_t)(k0a + kk0) * Na + n0a + 4 * c4); a1 = *(const float4*)(Wa + (size_t)(k0a + kk0 + 32) * Na + n0a + 4 * c4); }
        if (inb) { b0 = *(const float4*)(Wb + (size_t)(k0b + kk0) * Nb + n0b + 4 * c4); b1 = *(const float4*)(Wb + (size_t)(k0b + kk0 + 32) * Nb + n0b + 4 * c4); }
        __syncthreads();
        { float* d = sm + kk0 * 65 + 4 * c4; d[0] = a0.x; d[1] = a0.y; d[2] = a0.z; d[3] = a0.w; d += 32 * 65; d[0] = a1.x; d[1] = a1.y; d[2] = a1.z; d[3] = a1.w; }
        { float* d = sm1 + kk0 * 65 + 4 * c4; d[0] = b0.x; d[1] = b0.y; d[2] = b0.z; d[3] = b0.w; d += 32 * 65; d[0] = b1.x; d[1] = b1.y; d[2] = b1.z; d[3] = b1.w; }
        __syncthreads();
        titem_finish(WTa, Ka, Na, k0a, n0a, fa ? pin5 + la * 1024 : nullptr, pin6 + la * 1024, (float*)(ws + WS_COLS) + la * 2048, (float*)(ws + WS_COLS) + la * 2048 + 1024, sm, tid);
        if (has2) titem_finish(WTb, Kb, Nb, k0b, n0b, fb ? pin5 + lb * 1024 : nullptr, pin6 + lb * 1024, (float*)(ws + WS_COLS) + lb * 2048, (float*)(ws + WS_COLS) + lb * 2048 + 1024, sm1, tid);
    }
    __syncthreads();
    for (int l = 0; l < DEPTH_; ++l) {
        bf16* win_t = (bf16*)(ws + WS_WIN_T + l * WIN_T_BYTES);
        for (int i = B * NTHR + tid; i < (NP - NCOL) * 1024 / 8; i += G * NTHR) ((uint4*)(win_t + (size_t)NCOL * 1024))[i] = make_uint4(0u, 0u, 0u, 0u);
    }
    const float4* x4 = (const float4*)p.in[0]; uint2* hb2 = (uint2*)(ws + WS_HB);
    for (size_t i = (size_t)B * NTHR + tid; i < (size_t)T_ * 1024 / 4; i += (size_t)G * NTHR) { const float4 v = x4[i]; hb2[i] = make_uint2(pk2(v.x, v.y), pk2(v.z, v.w)); }
}

__device__ __forceinline__ void ln_row(float4 (&v)[4], const float* g, const float* bb, float* orow, bf16* obrow, int lane) {
    float s = 0.f;
#pragma unroll
    for (int j = 0; j < 4; ++j) s += (v[j].x + v[j].y) + (v[j].z + v[j].w);
    const float mean = wave_sum(s) * (1.0f / 1024.0f);
    float s2 = 0.f;
#pragma unroll
    for (int j = 0; j < 4; ++j) { v[j].x -= mean; v[j].y -= mean; v[j].z -= mean; v[j].w -= mean; s2 += (v[j].x * v[j].x + v[j].y * v[j].y) + (v[j].z * v[j].z + v[j].w * v[j].w); }
    const float rstd = 1.0f / sqrtf(wave_sum(s2) * (1.0f / 1024.0f) + LN_EPS);
#pragma unroll
    for (int j = 0; j < 4; ++j) {
        const float4 gg = ((const float4*)g)[j * 64 + lane], b4 = ((const float4*)bb)[j * 64 + lane];
        float4 o; o.x = v[j].x * rstd * gg.x + b4.x; o.y = v[j].y * rstd * gg.y + b4.y; o.z = v[j].z * rstd * gg.z + b4.z; o.w = v[j].w * rstd * gg.w + b4.w;
        ((float4*)orow)[j * 64 + lane] = o;
        ((uint2*)obrow)[j * 64 + lane] = make_uint2(pk2(o.x, o.y), pk2(o.z, o.w));
    }
}
__device__ void ln1_phase(int WV_, const float* hin, const float* add, const float* g, const float* bb, float* hout, bf16* hb) {
    const int lane = LTID(WV_) & 63, wave = LTID(WV_) >> 6;
    for (int row = LBID() * NWAVE + wave; row < T_; row += LGRID() * NWAVE) {
        float4 v[4];
#pragma unroll
        for (int j = 0; j < 4; ++j) {
            const float4 a = ((const float4*)(hin + (size_t)row * 1024))[j * 64 + lane], m = ((const float4*)(add + (size_t)row * 1024))[j * 64 + lane];
            v[j].x = ALPHA * a.x + m.x; v[j].y = ALPHA * a.y + m.y; v[j].z = ALPHA * a.z + m.z; v[j].w = ALPHA * a.w + m.w;
        }
        ln_row(v, g, bb, hout + (size_t)row * 1024, hb + (size_t)row * 1024, lane);
    }
}


typedef short bf16x8_t __attribute__((ext_vector_type(8)));
typedef float f32x16_t __attribute__((ext_vector_type(16)));
typedef float f32x2_t __attribute__((ext_vector_type(2)));
typedef __bf16 bf16x2_t __attribute__((ext_vector_type(2)));
__device__ __forceinline__ unsigned cvtpk(float lo, float hi) { f32x2_t v = {lo, hi}; bf16x2_t b = __builtin_convertvector(v, bf16x2_t); return __builtin_bit_cast(unsigned, b); }
__device__ __forceinline__ int crow(int r, int hi) { return (r & 3) + 8 * (r >> 2) + 4 * hi; }
__device__ __forceinline__ float xlane32(float v) { return __shfl_xor(v, 32); }
__device__ __forceinline__ float vmax(float a, float b) { float r; asm("v_max_f32_e32 %0, %1, %2" : "=v"(r) : "v"(a), "v"(b)); return r; }
__device__ __forceinline__ float vmin(float a, float b) { float r; asm("v_min_f32_e32 %0, %1, %2" : "=v"(r) : "v"(a), "v"(b)); return r; }
__device__ __forceinline__ float vmax3(float a, float b, float c) { float r; asm("v_max3_f32 %0, %1, %2, %3" : "=v"(r) : "v"(a), "v"(b), "v"(c)); return r; }

constexpr int AT_KP = 72, AT_VP = 96;
constexpr int AT_KS = 0, AT_KS_BYTES = 64 * AT_KP * 2;
constexpr int AT_VT = 2 * AT_KS_BYTES, AT_VT_BYTES = 64 * AT_VP * 2;
constexpr int AT_KM = AT_VT + 2 * AT_VT_BYTES;
constexpr int AT_MISC = AT_KM + 32 * AT_KP * 2;
constexpr float LOG2E = 1.4426950408889634f;

__device__ __forceinline__ unsigned mk_unit(int kind, int b, int x, int y) { return ((unsigned)kind << 30) | ((unsigned)b << 28) | ((unsigned)x << 8) | (unsigned)y; }
__device__ void build_unit_table(unsigned* tab, int i) {
    int n = 0; unsigned res = 0u;
#pragma unroll 1
    for (int c = 64; c >= 1; --c) {
        if (i >= n && i < n + 4) res = mk_unit(0, i - n, 0, c - 1);
        n += 4;
        if ((c & 3) == 0) { if (i >= n && i < n + 16) { const int j = i - n; res = mk_unit(2, j >> 2, j & 3, c / 4 - 1); } n += 16; }
    }
    if (i < 512) tab[i] = res;
}

template <int kind> __device__ __forceinline__ void attn_unit(int WV_, const bf16* P, const unsigned char* mask, const float* kmean, const float* sinks, bf16* ys,
                                unsigned char* lds, int b, int ux, int uy) {
    int tid_ = LTID(WV_); asm volatile("" : "+v"(tid_));
    const int tid = tid_, lane = tid & 63, wave = __builtin_amdgcn_readfirstlane(tid >> 6), r32 = lane & 31, hi = lane >> 5;
    bf16* s_km = (bf16*)(lds + AT_KM);
    const int skey = tid >> 3, sc = tid & 7;
    {
        const bf16* Pb = P + (size_t)b * S_ * NP;
        int q0w, qcol, kcol, vcol, ycol, kt_hi, kt_lo; float slope2 = 0.f, sink2 = 0.f;
        if (kind == 0) { const int head = wave >> 1; q0w = uy * 64 + (wave & 1) * 32; qcol = C_QA + head * 64; kcol = C_KA; vcol = C_VA; ycol = head * 64;
            slope2 = exp2f(-8.0f * (float)(3 * head + 1) / 12.0f) * LOG2E; kt_hi = uy; kt_lo = 0; }
        else if (kind == 1) { const int hq = ux * 2 + (wave >> 2); q0w = uy * 128 + (wave & 3) * 32; qcol = C_QB + hq * 64; kcol = C_KB + ux * 64; vcol = C_VB + ux * 64; ycol = 256 + hq * 64;
            slope2 = exp2f(-8.0f * (float)(3 * hq + 2) / 12.0f) * LOG2E; sink2 = sinks[hq] * LOG2E; kt_hi = 2 * uy + 1; kt_lo = (2 * uy - 2 > 0) ? 2 * uy - 2 : 0; }
        else if (kind == 2) { q0w = uy * 256 + wave * 32; qcol = C_QC + ux * 64; kcol = C_KC + ux * 64; vcol = C_VC + ux * 64; ycol = 512 + ux * 64;
            slope2 = exp2f(-8.0f * (float)(3 * ux + 3) / 12.0f) * LOG2E; kt_hi = 4 * uy + 3; kt_lo = 0; }
        else { q0w = uy * 256 + wave * 32; qcol = C_QD + ux * 64; kcol = C_KD + ux * 64; vcol = C_VD + ux * 64; ycol = 768 + ux * 64; kt_hi = 4 * uy + 3; kt_lo = 0; }
        const int qpos = q0w + r32;
        bf16x8_t qf[4];
        { const bf16* qp = Pb + (size_t)qpos * NP + qcol + 8 * hi;
#pragma unroll
          for (int ks = 0; ks < 4; ++ks) qf[ks] = *(const bf16x8_t*)(qp + 16 * ks); }
        {
            const float qs = (kind == 3) ? 0.125f : 0.125f * LOG2E;
            typedef unsigned u32x4_t __attribute__((ext_vector_type(4)));
#pragma unroll
            for (int ks = 0; ks < 4; ++ks) { u32x4_t w = __builtin_bit_cast(u32x4_t, qf[ks]);
#pragma unroll
                for (int i = 0; i < 4; ++i) w[i] = cvtpk(__uint_as_float(w[i] << 16) * qs, __uint_as_float(w[i] & 0xffff0000u) * qs);
                qf[ks] = __builtin_bit_cast(bf16x8_t, w); }
        }
        float sb[16];
#pragma unroll
        for (int r = 0; r < 16; ++r) sb[r] = slope2 * (float)((r & 3) + 8 * (r >> 2));
        unsigned bm = 0u;
        if (kind == 2) {
            const int own = uy;
            for (int e = tid; e < 32 * 64; e += NTHR) { const int row = e >> 6, d = e & 63; s_km[row * AT_KP + d] = (row < 16) ? (bf16)f2bf(kmean[((b * 4 + ux) * 16 + row) * 64 + d]) : (bf16)0; }
            __syncthreads();
            f32x16_t gacc;
#pragma unroll
            for (int r = 0; r < 16; ++r) gacc[r] = 0.f;
#pragma unroll
            for (int ks = 0; ks < 4; ++ks) { const bf16x8_t a = *(const bf16x8_t*)(s_km + r32 * AT_KP + 16 * ks + 8 * hi); gacc = __builtin_amdgcn_mfma_f32_32x32x16_bf16(a, qf[ks], gacc, 0, 0, 0); }
            float gt[16];
#pragma unroll
            for (int r = 0; r < 8; ++r) { const float mine = gacc[r], other = xlane32(mine); const int bi = crow(r, 0);
                gt[bi] = hi ? other : mine; gt[bi + 4] = hi ? mine : other; }
#pragma unroll
            for (int n = 0; n < 16; ++n) if (n >= own) gt[n] = -INFINITY;
#pragma unroll
            for (int rep = 0; rep < 3; ++rep) {
                float mx = -INFINITY;
#pragma unroll
                for (int n = 0; n < 16; ++n) mx = fmaxf(mx, gt[n]);
                bool done = !(mx > -INFINITY);
#pragma unroll
                for (int n = 0; n < 16; ++n) { const bool hit = !done && gt[n] == mx; if (hit) { bm |= 1u << n; gt[n] = -INFINITY; done = true; } }
            }
        }
        f32x16_t o0, o1;
#pragma unroll
        for (int r = 0; r < 16; ++r) { o0[r] = 0.f; o1[r] = 0.f; }
        float m_run = -INFINITY, l_run = 0.f, carry = 0.f;
        const bf16* kg = Pb + (size_t)skey * NP + kcol + sc * 8;
        const bf16* vg = Pb + (size_t)skey * NP + vcol + sc * 8;
        uint4 rk = *(const uint4*)(kg + (size_t)kt_hi * 64 * NP), rv = *(const uint4*)(vg + (size_t)kt_hi * 64 * NP);
        int buf = 0;
        { bf16* ks_ = (bf16*)(lds + AT_KS); bf16* vt_ = (bf16*)(lds + AT_VT);
          *(uint4*)(ks_ + skey * AT_KP + sc * 8) = rk;
          *(uint4*)(vt_ + skey * AT_VP + sc * 8) = rv; }
        __syncthreads();
        bool wave_done = false;
        uint2 mw_next = make_uint2(0u, 0u);
        if (kind == 0) mw_next = *(const uint2*)(mask + (size_t)(b * S_ + qpos) * 512 + kt_hi * 8);
        for (int kt = kt_hi; kt >= kt_lo; --kt) {
            const bool more = kt > kt_lo;
            const uint2 mw = mw_next;
            if (kind == 0 && more) mw_next = *(const uint2*)(mask + (size_t)(b * S_ + qpos) * 512 + (kt - 1) * 8);
            if (more) { rk = *(const uint4*)(kg + (size_t)(kt - 1) * 64 * NP); rv = *(const uint4*)(vg + (size_t)(kt - 1) * 64 * NP); }
            const bf16* ks_ = (const bf16*)(lds + AT_KS + buf * AT_KS_BYTES);
            const bf16* vt_ = (const bf16*)(lds + AT_VT + buf * AT_VT_BYTES);
            bool active = (kt * 64 <= q0w + 31) && !wave_done;
            if (kind == 1) active = active && (kt * 64 + 63 >= q0w - 127);
            if (active) {
                const int kbase = kt * 64 + 4 * hi;
                f32x16_t p0, p1;
                if (kind != 3) {
                    const float cb = slope2 * (float)(kbase - qpos), cb1 = cb + 32.0f * slope2;
#pragma unroll
                    for (int r = 0; r < 16; ++r) { p0[r] = cb + sb[r]; p1[r] = cb1 + sb[r]; }
                } else {
#pragma unroll
                    for (int r = 0; r < 16; ++r) { p0[r] = 0.f; p1[r] = 0.f; }
                }
#pragma unroll
                for (int ks = 0; ks < 4; ++ks) {
                    const bf16x8_t a0 = *(const bf16x8_t*)(ks_ + r32 * AT_KP + 16 * ks + 8 * hi);
                    const bf16x8_t a1 = *(const bf16x8_t*)(ks_ + (32 + r32) * AT_KP + 16 * ks + 8 * hi);
                    p0 = __builtin_amdgcn_mfma_f32_32x32x16_bf16(a0, qf[ks], p0, 0, 0, 0);
                    p1 = __builtin_amdgcn_mfma_f32_32x32x16_bf16(a1, qf[ks], p1, 0, 0, 0);
                }
                if (kind != 3) {
                    float mx = -INFINITY;
                    if (kind == 0) {
                        const unsigned w0 = mw.x >> (4 * hi), w1 = mw.y >> (4 * hi);
#pragma unroll
                        for (int r = 0; r < 16; ++r) { const int off = (r & 3) + 8 * (r >> 2);
                            p0[r] = (w0 & (1u << off)) ? p0[r] : -INFINITY; p1[r] = (w1 & (1u << off)) ? p1[r] : -INFINITY; mx = vmax3(mx, p0[r], p1[r]); }
                    } else if (kind == 1) {
                        const int rel = qpos - kbase;
#pragma unroll
                        for (int r = 0; r < 16; ++r) { const int off = (r & 3) + 8 * (r >> 2);
                            p0[r] = ((unsigned)(rel - off) < 128u) ? p0[r] : -INFINITY; p1[r] = ((unsigned)(rel - off - 32) < 128u) ? p1[r] : -INFINITY; mx = vmax3(mx, p0[r], p1[r]); }
                    } else {
                        if ((kt >> 2) == uy) {
                            const int rel = qpos - kbase;
#pragma unroll
                            for (int r = 0; r < 16; ++r) { const int off = (r & 3) + 8 * (r >> 2);
                                p0[r] = (off <= rel) ? p0[r] : -INFINITY; p1[r] = (off + 32 <= rel) ? p1[r] : -INFINITY; mx = vmax3(mx, p0[r], p1[r]); }
                        } else {
                            const bool tile_ok = ((bm >> (kt >> 2)) & 1u) != 0u;
#pragma unroll
                            for (int r = 0; r < 16; ++r) { p0[r] = tile_ok ? p0[r] : -INFINITY; p1[r] = tile_ok ? p1[r] : -INFINITY; mx = vmax3(mx, p0[r], p1[r]); }
                        }
                    }
                    mx = vmax(mx, xlane32(mx));
                    const float m_new = vmax(m_run, mx);
                    const float m_safe = (m_new == -INFINITY) ? 0.f : m_new;
                    p0 = p0 - m_safe; p1 = p1 - m_safe;
#pragma unroll
                    for (int r = 0; r < 16; ++r) { p0[r] = __builtin_amdgcn_exp2f(p0[r]); p1[r] = __builtin_amdgcn_exp2f(p1[r]); }
                    float ls;
                    { typedef float f32x8_t __attribute__((ext_vector_type(8))); typedef float f32x4v_t __attribute__((ext_vector_type(4)));
                      const f32x16_t t16 = p0 + p1; const f32x8_t t8 = t16.lo + t16.hi; const f32x4v_t t4 = t8.lo + t8.hi; const f32x2_t t2 = t4.lo + t4.hi; ls = t2.x + t2.y; }
                    if (__any(m_new > m_run)) {
                        const float alpha = __builtin_amdgcn_exp2f(m_run - m_safe);
                        l_run *= alpha;
                        o0 = o0 * alpha; o1 = o1 * alpha;
                    }
                    l_run += ls; m_run = m_new;
                } else {
                    float run = carry;
#define SB_HALF(PX, KOFF) do { \
                    float lk[16]; \
                    _Pragma("unroll") for (int r = 0; r < 16; ++r) { \
                        const int off = (r & 3) + 8 * (r >> 2); \
                        const bool v = (kbase + off + (KOFF)) < qpos; \
                        const float z = PX[r]; \
                        const float t = 0.6931471805599453f * __builtin_amdgcn_logf(1.0f + __builtin_amdgcn_exp2f(-LOG2E * fabsf(z))); \
                        lk[r] = v ? (fminf(-z, 0.f) - t) : 0.f; \
                        PX[r] = v ? (fminf(z, 0.f) - t) : -INFINITY; } \
                    _Pragma("unroll") for (int g = 3; g >= 0; --g) { \
                        const float G = (lk[4 * g] + lk[4 * g + 1]) + (lk[4 * g + 2] + lk[4 * g + 3]); \
                        const float PG = xlane32(G); \
                        float la = run + (hi ? 0.f : PG); \
                        run += G + PG; \
                        PX[4 * g + 3] += la; la += lk[4 * g + 3]; PX[4 * g + 2] += la; la += lk[4 * g + 2]; PX[4 * g + 1] += la; la += lk[4 * g + 1]; PX[4 * g] += la; } \
                    _Pragma("unroll") for (int r = 0; r < 16; ++r) PX[r] = __builtin_amdgcn_exp2f(LOG2E * PX[r]); } while (0)
                    SB_HALF(p1, 32);
                    SB_HALF(p0, 0);
#undef SB_HALF
                    carry = run;
                }
                unsigned pw[16];
#pragma unroll
                for (int j = 0; j < 8; ++j) { pw[j] = cvtpk(p0[2 * j], p0[2 * j + 1]); pw[8 + j] = cvtpk(p1[2 * j], p1[2 * j + 1]); }
#pragma unroll
                for (int s = 0; s < 4; ++s) {
                    bf16x8_t pb; { const unsigned* q = pw + 4 * s; typedef unsigned u32x4_t __attribute__((ext_vector_type(4))); u32x4_t t4 = {q[0], q[1], q[2], q[3]}; pb = __builtin_bit_cast(bf16x8_t, t4); }
#pragma unroll
                    for (int dt = 0; dt < 2; ++dt) {
                        typedef short s16x4_t __attribute__((ext_vector_type(4)));
                        typedef __attribute__((address_space(3))) s16x4_t lds_s16x4;
                        const int gi_ = lane & 15;
                        const bf16* vp = vt_ + (16 * s + 4 * hi + (gi_ >> 2)) * AT_VP + 32 * dt + 16 * ((lane >> 4) & 1) + 4 * (gi_ & 3);
                        const s16x4_t lo = __builtin_amdgcn_ds_read_tr16_b64_v4i16((lds_s16x4*)vp), hi4 = __builtin_amdgcn_ds_read_tr16_b64_v4i16((lds_s16x4*)(vp + 8 * AT_VP));
                        const bf16x8_t va = {lo[0], lo[1], lo[2], lo[3], hi4[0], hi4[1], hi4[2], hi4[3]};
                        if (dt == 0) o0 = __builtin_amdgcn_mfma_f32_32x32x16_bf16(va, pb, o0, 0, 0, 0);
                        else         o1 = __builtin_amdgcn_mfma_f32_32x32x16_bf16(va, pb, o1, 0, 0, 0);
                    }
                }
            }
            if (kind == 3) {
                const float cm = carry;
                if (__all(cm < -110.0f) || !(kt * 64 <= q0w + 31) ) { if (__all(cm < -110.0f)) wave_done = true; }
            }
            if (more) {
                bf16* ksn = (bf16*)(lds + AT_KS + (buf ^ 1) * AT_KS_BYTES); bf16* vtn = (bf16*)(lds + AT_VT + (buf ^ 1) * AT_VT_BYTES);
                *(uint4*)(ksn + skey * AT_KP + sc * 8) = rk;
                *(uint4*)(vtn + skey * AT_VP + sc * 8) = rv;
            }
            if (kind == 3) { if (__syncthreads_and(wave_done ? 1 : 0)) break; }
            else __syncthreads();
            buf ^= 1;
        }
        float inv;
        if (kind == 3) inv = 1.0f;
        else {
            float lt = l_run + xlane32(l_run);
            if (kind == 1) { const float mf = fmaxf(m_run, sink2); const float sc2 = exp2f(m_run - mf); lt = lt * sc2 + exp2f(sink2 - mf); inv = sc2 / lt; }
            else inv = 1.0f / lt;
        }
        bf16* yp = ys + (size_t)(b * S_ + qpos) * 1024 + ycol + 4 * hi;
#pragma unroll
        for (int g = 0; g < 4; ++g) {
            *(uint2*)(yp + 8 * g) = make_uint2(cvtpk(o0[4 * g] * inv, o0[4 * g + 1] * inv), cvtpk(o0[4 * g + 2] * inv, o0[4 * g + 3] * inv));
            *(uint2*)(yp + 32 + 8 * g) = make_uint2(cvtpk(o1[4 * g] * inv, o1[4 * g + 1] * inv), cvtpk(o1[4 * g + 2] * inv, o1[4 * g + 3] * inv));
        }
    }
}
__device__ void attn_fast_phase(int WV_, const bf16* P, const unsigned char* mask, const float* kmean, const float* sinks, bf16* ys,
                                const unsigned* utab, unsigned* counter, unsigned char* lds) {
    volatile unsigned* s_unit = (volatile unsigned*)(lds + AT_MISC);
    for (;;) {
        __syncthreads();
        if (LTID(WV_) == 0) s_unit[0] = atomicAdd(counter, 1u);
        __syncthreads();
        const unsigned ui = s_unit[0];
        if (ui >= 512u) break;
        const unsigned ue = utab[ui];
        const int kind = (int)(ue >> 30), b = (int)((ue >> 28) & 3u), ux = (int)((ue >> 8) & 255u), uy = (int)(ue & 255u);
        if (kind == 0) attn_unit<0>(WV_, P, mask, kmean, sinks, ys, lds, b, ux, uy);
        else attn_unit<2>(WV_, P, mask, kmean, sinks, ys, lds, b, ux, uy);
    }
    for (int u = LBID(); u < 256; u += LGRID()) { __syncthreads(); attn_unit<3>(WV_, P, mask, kmean, sinks, ys, lds, u >> 6, (u >> 4) & 3, u & 15); }
    for (int u = LBID(); u < 256; u += LGRID()) { __syncthreads(); attn_unit<1>(WV_, P, mask, kmean, sinks, ys, lds, u >> 6, (u >> 5) & 1, u & 31); }
}

constexpr float U_SCALE = 128.0f, V_SCALE = 48.0f;
constexpr int ROW6 = 1536;
typedef float v32f_t __attribute__((ext_vector_type(32)));
typedef unsigned v6u_t __attribute__((ext_vector_type(6)));
typedef unsigned u32x4a8_t __attribute__((ext_vector_type(4), aligned(8)));
__device__ __forceinline__ float rdlane_f(float v, int l) { return __builtin_bit_cast(float, __builtin_amdgcn_readlane(__builtin_bit_cast(int, v), l)); }
__device__ __forceinline__ unsigned q_e2m3(float v) {
    const float a = fminf(fabsf(v), 7.5f);
    unsigned code;
    if (a < 1.0f) code = (unsigned)rintf(a * 8.0f);
    else if (a < 2.0f) code = 8u + (unsigned)rintf((a - 1.0f) * 8.0f);
    else if (a < 4.0f) code = 16u + (unsigned)rintf((a - 2.0f) * 4.0f);
    else code = 24u + (unsigned)rintf((a - 4.0f) * 2.0f);
    return code | (v < 0.f ? 32u : 0u);
}
__device__ __forceinline__ void cvt_chunk6(const float4 (&a)[8], float sc, unsigned (&w)[6]) {
#pragma unroll
    for (int d = 0; d < 6; ++d) w[d] = 0u;
#pragma unroll
    for (int q4 = 0; q4 < 8; ++q4) {
        const float av[4] = {a[q4].x, a[q4].y, a[q4].z, a[q4].w};
#pragma unroll
        for (int e = 0; e < 4; ++e) { const int idx = q4 * 4 + e, bit = 6 * idx, d = bit >> 5, sft = bit & 31; const unsigned code = q_e2m3(av[e] * sc);
            w[d] |= code << sft; if (sft > 26) w[d + 1] |= code >> (32 - sft); }
    }
}
__device__ void convert_tables(int WV_, const Params& p) {
    const size_t nchunk = (size_t)DEPTH_ * 16384 * 2 * 32;
    const size_t stride = (size_t)LGRID() * NTHR;
    for (size_t i = (size_t)LBID() * NTHR + LTID(WV_); i < nchunk; i += 2 * stride) {
        const size_t i2 = i + stride; const bool has2 = i2 < nchunk; const size_t j2 = has2 ? i2 : i;
        const int c0 = (int)(i & 31), uv0 = (int)((i >> 5) & 1); const size_t le0 = i >> 6;
        const int c1 = (int)(j2 & 31), uv1 = (int)((j2 >> 5) & 1); const size_t le1 = j2 >> 6;
        const float* src0 = (uv0 ? p.in[10] : p.in[9]) + le0 * 1024 + c0 * 32;
        const float* src1 = (uv1 ? p.in[10] : p.in[9]) + le1 * 1024 + c1 * 32;
        float4 a0[8], a1[8];
#pragma unroll
        for (int q4 = 0; q4 < 8; ++q4) a0[q4] = ((const float4*)src0)[q4];
#pragma unroll
        for (int q4 = 0; q4 < 8; ++q4) a1[q4] = ((const float4*)src1)[q4];
        unsigned w0[6], w1[6];
        cvt_chunk6(a0, uv0 ? V_SCALE : U_SCALE, w0);
        cvt_chunk6(a1, uv1 ? V_SCALE : U_SCALE, w1);
        uint2* dst0 = (uint2*)(p.ws + WS_UV + le0 * ROW6 + uv0 * 768 + c0 * 24);
        dst0[0] = make_uint2(w0[0], w0[1]); dst0[1] = make_uint2(w0[2], w0[3]); dst0[2] = make_uint2(w0[4], w0[5]);
        if (has2) { uint2* dst1 = (uint2*)(p.ws + WS_UV + le1 * ROW6 + uv1 * 768 + c1 * 24);
            dst1[0] = make_uint2(w1[0], w1[1]); dst1[1] = make_uint2(w1[2], w1[3]); dst1[2] = make_uint2(w1[4], w1[5]); }
    }
}
__device__ __forceinline__ v6u_t ld_pk6(const unsigned char* ptr) {
    const uint2 a = ((const uint2*)ptr)[0], b = ((const uint2*)ptr)[1], c = ((const uint2*)ptr)[2];
    const v6u_t pk = {a.x, a.y, b.x, b.y, c.x, c.y};
    return pk;
}
__device__ void peer_fast_phase(int WV_, float* h, bf16* hb, const int* eid, const float* gate, const unsigned char* uv, const float* g1, const float* b1, const float* g, const float* bb, unsigned char* lds) {
    const int tid = LTID(WV_), lane = tid & 63, wave = tid >> 6, l32 = lane & 31, hi = lane >> 5;
    float* pl = (float*)(lds + wave * 16384);
    unsigned char* raw = lds + wave * 16384 + 4096 + lane * 24;
    for (int t = LBID() * NWAVE + wave; t < T_; t += LGRID() * NWAVE) {
        float* hr = h + (size_t)t * 1024 + l32 * 32;
        float x[32], acc[32];
#pragma unroll
        for (int q4 = 0; q4 < 4; ++q4) { const uint4 a = ((const uint4*)(hb + (size_t)t * 1024 + l32 * 32))[q4];
            x[8 * q4] = __uint_as_float(a.x << 16); x[8 * q4 + 1] = __uint_as_float(a.x & 0xffff0000u); x[8 * q4 + 2] = __uint_as_float(a.y << 16); x[8 * q4 + 3] = __uint_as_float(a.y & 0xffff0000u);
            x[8 * q4 + 4] = __uint_as_float(a.z << 16); x[8 * q4 + 5] = __uint_as_float(a.z & 0xffff0000u); x[8 * q4 + 6] = __uint_as_float(a.w << 16); x[8 * q4 + 7] = __uint_as_float(a.w & 0xffff0000u); }
        {
            float s = 0.f;
#pragma unroll
            for (int i = 0; i < 32; ++i) s += x[i];
#pragma unroll
            for (int o = 16; o > 0; o >>= 1) s += __shfl_xor(s, o);
            const float mean = s * (1.0f / 1024.0f);
            float s2 = 0.f;
#pragma unroll
            for (int i = 0; i < 32; ++i) { x[i] -= mean; s2 += x[i] * x[i]; }
#pragma unroll
            for (int o = 16; o > 0; o >>= 1) s2 += __shfl_xor(s2, o);
            const float rstd = 1.0f / sqrtf(s2 * (1.0f / 1024.0f) + LN_EPS);
#pragma unroll
            for (int q4 = 0; q4 < 8; ++q4) { const float4 gg = ((const float4*)(g1 + l32 * 32))[q4], cc = ((const float4*)(b1 + l32 * 32))[q4];
                x[4 * q4] = x[4 * q4] * rstd * gg.x + cc.x; x[4 * q4 + 1] = x[4 * q4 + 1] * rstd * gg.y + cc.y; x[4 * q4 + 2] = x[4 * q4 + 2] * rstd * gg.z + cc.z; x[4 * q4 + 3] = x[4 * q4 + 3] * rstd * gg.w + cc.w; }
        }
#pragma unroll
        for (int i = 0; i < 32; ++i) acc[i] = 0.f;
#pragma unroll 1
        for (int batch = 0; batch < 4; ++batch) {
            const int my_eid = eid[(size_t)t * 128 + batch * 32 + l32];
            const float my_gate = gate[(size_t)t * 128 + batch * 32 + l32];
#pragma unroll 1
            for (int grp = 0; grp < 2; ++grp) {
                { u32x4a8_t pa[8]; uint2 pc[8];
#pragma unroll
                  for (int i = 0; i < 8; ++i) { const int id = __shfl(my_eid, 2 * (grp * 8 + i) + hi); const unsigned char* rp = uv + (size_t)id * ROW6 + l32 * 24; pa[i] = *(const u32x4a8_t*)rp; pc[i] = *(const uint2*)(rp + 16); }
#pragma unroll
                  for (int i = 0; i < 8; ++i) { uint2* wp = (uint2*)(raw + i * 1536); wp[0] = make_uint2(pa[i].x, pa[i].y); wp[1] = make_uint2(pa[i].z, pa[i].w); wp[2] = pc[i]; } }
#pragma unroll 1
                for (int i = 0; i < 8; ++i) {
                    const uint2* rp = (const uint2*)(raw + i * 1536); const uint2 a = rp[0], b = rp[1], c = rp[2];
                    const v6u_t pk6 = {a.x, a.y, b.x, b.y, c.x, c.y}; const v32f_t f = __builtin_amdgcn_cvt_scalef32_pk32_f32_fp6(pk6, 1.0f);
                    f32x2_t dv0 = {0.f, 0.f}, dv1 = {0.f, 0.f};
#pragma unroll
                    for (int j = 0; j < 8; ++j) { const f32x2_t fa = {f[2 * j], f[2 * j + 1]}, fb = {f[16 + 2 * j], f[17 + 2 * j]}, xa = {x[2 * j], x[2 * j + 1]}, xb = {x[16 + 2 * j], x[17 + 2 * j]};
                        dv0 = fa * xa + dv0; dv1 = fb * xb + dv1; }
                    pl[(2 * (grp * 8 + i) + hi) * 32 + l32] = (dv0.x + dv0.y) + (dv1.x + dv1.y);
                }
            }
            float d;
            { const float4* pr = (const float4*)(pl + l32 * 32); float4 s4 = pr[0];
#pragma unroll
              for (int i = 1; i < 8; ++i) { const float4 v = pr[i]; s4.x += v.x; s4.y += v.y; s4.z += v.z; s4.w += v.w; }
              d = ((s4.x + s4.y) + (s4.z + s4.w)) * (1.0f / U_SCALE); }
            const float hv = 0.5f * d * (1.0f + erff(d * 0.70710678118654752f)) * my_gate * (1.0f / V_SCALE);
#pragma unroll 1
            for (int grp = 0; grp < 2; ++grp) {
                { u32x4a8_t pa[8]; uint2 pc[8];
#pragma unroll
                  for (int i = 0; i < 8; ++i) { const int id = __shfl(my_eid, 2 * (grp * 8 + i) + hi); const unsigned char* rp = uv + (size_t)id * ROW6 + 768 + l32 * 24; pa[i] = *(const u32x4a8_t*)rp; pc[i] = *(const uint2*)(rp + 16); }
#pragma unroll
                  for (int i = 0; i < 8; ++i) { uint2* wp = (uint2*)(raw + i * 1536); wp[0] = make_uint2(pa[i].x, pa[i].y); wp[1] = make_uint2(pa[i].z, pa[i].w); wp[2] = pc[i]; } }
#pragma unroll 1
                for (int i = 0; i < 8; ++i) {
                    const float c = __shfl(hv, 2 * (grp * 8 + i) + hi);
                    const uint2* rp = (const uint2*)(raw + i * 1536); const uint2 a = rp[0], b = rp[1], cc = rp[2];
                    const v6u_t pk6 = {a.x, a.y, b.x, b.y, cc.x, cc.y}; const v32f_t f = __builtin_amdgcn_cvt_scalef32_pk32_f32_fp6(pk6, 1.0f);
                    const f32x2_t c2 = {c, c};
#pragma unroll
                    for (int j = 0; j < 16; ++j) { const f32x2_t fj = {f[2 * j], f[2 * j + 1]}; f32x2_t aj = {acc[2 * j], acc[2 * j + 1]}; aj = fj * c2 + aj; acc[2 * j] = aj.x; acc[2 * j + 1] = aj.y; }
                }
            }
        }
        float y[32], s = 0.f;
#pragma unroll
        for (int i = 0; i < 32; ++i) { acc[i] += __shfl_xor(acc[i], 32); y[i] = ALPHA * x[i] + acc[i]; s += y[i]; }
#pragma unroll
        for (int o = 16; o > 0; o >>= 1) s += __shfl_xor(s, o);
        const float mean = s * (1.0f / 1024.0f);
        float s2 = 0.f;
#pragma unroll
        for (int i = 0; i < 32; ++i) { y[i] -= mean; s2 += y[i] * y[i]; }
#pragma unroll
        for (int o = 16; o > 0; o >>= 1) s2 += __shfl_xor(s2, o);
        const float rstd = 1.0f / sqrtf(s2 * (1.0f / 1024.0f) + LN_EPS);
        float o[16];
#pragma unroll
        for (int q4 = 0; q4 < 4; ++q4) {
            const float4 gg = ((const float4*)(g + l32 * 32 + hi * 16))[q4], cc = ((const float4*)(bb + l32 * 32 + hi * 16))[q4];
            float ya[4], yb2[4];
#pragma unroll
            for (int e = 0; e < 4; ++e) { ya[e] = y[4 * q4 + e]; yb2[e] = y[16 + 4 * q4 + e]; }
            asm volatile("" : "+v"(ya[0]), "+v"(ya[1]), "+v"(ya[2]), "+v"(ya[3]), "+v"(yb2[0]), "+v"(yb2[1]), "+v"(yb2[2]), "+v"(yb2[3]));
            const float y0 = hi ? yb2[0] : ya[0], y1 = hi ? yb2[1] : ya[1], y2 = hi ? yb2[2] : ya[2], y3 = hi ? yb2[3] : ya[3];
            o[4 * q4] = y0 * rstd * gg.x + cc.x; o[4 * q4 + 1] = y1 * rstd * gg.y + cc.y; o[4 * q4 + 2] = y2 * rstd * gg.z + cc.z; o[4 * q4 + 3] = y3 * rstd * gg.w + cc.w;
            if (h) ((float4*)(hr + hi * 16))[q4] = make_float4(o[4 * q4], o[4 * q4 + 1], o[4 * q4 + 2], o[4 * q4 + 3]);
        }
        uint4* hbp = (uint4*)(hb + (size_t)t * 1024 + l32 * 32 + hi * 16);
        hbp[0] = make_uint4(pk2(o[0], o[1]), pk2(o[2], o[3]), pk2(o[4], o[5]), pk2(o[6], o[7]));
        hbp[1] = make_uint4(pk2(o[8], o[9]), pk2(o[10], o[11]), pk2(o[12], o[13]), pk2(o[14], o[15]));
    }
}

__device__ __forceinline__ float pack_pl(float v, unsigned pl) { return __uint_as_float((__float_as_uint(v) & ~127u) | pl); }
__device__ __forceinline__ void ins16(float (&s)[16], float x) {
#pragma unroll
    for (int k = 15; k >= 1; --k) s[k] = __builtin_amdgcn_fmed3f(s[k - 1], x, s[k]);
    s[0] = vmax(s[0], x);
}
template <int D> __device__ __forceinline__ void bitonic_stage(float (&c)[16]) {
#pragma unroll
    for (int i = 0; i < 16; ++i) if ((i & D) == 0) { const float a = vmax(c[i], c[i + D]), b = vmin(c[i], c[i + D]); c[i] = a; c[i + D] = b; }
}
__device__ __forceinline__ int decode_key(unsigned pl) { return (int)(32u * ((pl >> 4) & 3u) + (pl & 3u) + 8u * ((pl >> 2) & 3u) + 4u * ((pl >> 6) & 1u)); }
__device__ void route_fast_phase(int WV_, const bf16* qb, const bf16* skb  , int* eid, float* gate, unsigned char* lds, int pm = -1, int pn = 0) {
    const int tid = LTID(WV_), lane = tid & 63, wave = tid >> 6, r32 = lane & 31, hi = lane >> 5;
    unsigned* lidx = (unsigned*)lds + wave * (64 * 33) + lane * 33;
    const int u_first = (pm >= 0) ? 0 : LBID() * NWAVE + wave, u_end = (pm >= 0) ? 2 : (T_ / 32) * 8, u_step = (pm >= 0) ? 1 : LGRID() * NWAVE;
    for (int unit = u_first; unit < u_end; unit += u_step) {
        const int h = (pm >= 0) ? 2 * pn + unit : (unit & 7), t = ((pm >= 0) ? 8 * pm + wave : (unit >> 3)) * 32 + r32;
        float sl[2][16];
#pragma unroll
        for (int p = 0; p < 2; ++p) {
            bf16x8_t qf[4];
            { const bf16* qp = qb + (size_t)t * 1024 + h * 128 + p * 64 + 8 * hi;
#pragma unroll
              for (int ks = 0; ks < 4; ++ks) qf[ks] = *(const bf16x8_t*)(qp + 16 * ks); }
            float s[16];
#pragma unroll
            for (int k = 0; k < 16; ++k) s[k] = -INFINITY;
            const bf16* skp = skb + ((size_t)(h * 2 + p) * 128 + r32) * 64 + 8 * hi;
#pragma unroll
            for (int kt = 0; kt < 4; ++kt) {
                f32x16_t acc;
#pragma unroll
                for (int r = 0; r < 16; ++r) acc[r] = 0.f;
#pragma unroll
                for (int ks = 0; ks < 4; ++ks) { const bf16x8_t a = *(const bf16x8_t*)(skp + (size_t)kt * 32 * 64 + 16 * ks); acc = __builtin_amdgcn_mfma_f32_32x32x16_bf16(a, qf[ks], acc, 0, 0, 0); }
#pragma unroll
                for (int r = 0; r < 16; ++r) ins16(s, pack_pl(acc[r], (unsigned)(kt * 16 + r)));
            }
            const unsigned hb = (unsigned)hi << 6;
#pragma unroll
            for (int k = 0; k < 16; ++k) s[k] = __uint_as_float(__float_as_uint(s[k]) | hb);
            float c[16];
#pragma unroll
            for (int k = 0; k < 16; ++k) c[k] = vmax(s[k], __shfl_xor(s[15 - k], 32));
            bitonic_stage<8>(c); bitonic_stage<4>(c); bitonic_stage<2>(c); bitonic_stage<1>(c);
#pragma unroll
            for (int k = 0; k < 16; ++k) { sl[p][k] = c[k]; lidx[p * 16 + k] = (unsigned)decode_key(__float_as_uint(c[k]) & 127u); }
        }
        float w[16];
#pragma unroll
        for (int k = 0; k < 16; ++k) w[k] = -INFINITY;
#pragma unroll
        for (int i = 0; i < 16; ++i)
#pragma unroll
            for (int j = 0; j < 16; ++j)
                if ((i + 1) * (j + 1) <= 16) { const float v = sl[0][i] + sl[1][j]; ins16(w, __uint_as_float((__float_as_uint(v) & ~255u) | (unsigned)(i * 16 + j))); }
        float e[16], sum = 0.f;
#pragma unroll
        for (int k = 0; k < 16; ++k) { e[k] = __builtin_amdgcn_exp2f((w[k] - w[0]) * 1.44269504f); sum += e[k]; }
        const float inv = 1.0f / sum;
        int ide[8]; float gte[8];
#pragma unroll
        for (int k = 0; k < 8; ++k) {
            float wa = w[k], wb = w[8 + k], ea = e[k], eb = e[8 + k];
            asm volatile("" : "+v"(wa), "+v"(wb), "+v"(ea), "+v"(eb));
            const float wv = hi ? wb : wa;
            const unsigned pl = __float_as_uint(wv) & 255u;
            ide[k] = (int)(lidx[pl >> 4] * 128u + lidx[16 + (pl & 15u)]);
            gte[k] = (hi ? eb : ea) * inv;
        }
        int* ep = eid + (size_t)t * 128 + h * 16 + hi * 8; float* gp = gate + (size_t)t * 128 + h * 16 + hi * 8;
        *(int4*)ep = make_int4(ide[0], ide[1], ide[2], ide[3]); *(int4*)(ep + 4) = make_int4(ide[4], ide[5], ide[6], ide[7]);
        *(float4*)gp = make_float4(gte[0], gte[1], gte[2], gte[3]); *(float4*)(gp + 4) = make_float4(gte[4], gte[5], gte[6], gte[7]);
    }
}
#ifndef TS_SEL
#define TS_SEL 0
#endif
#define ITS_B() do { if (TS_SEL >= 20 && TS_SEL <= 40 && WV_ == 0 && LANEID() == 0) ((volatile __attribute__((address_space(3))) unsigned long long*)((__attribute__((address_space(3))) unsigned char*)lds + 147456 - 16 - 32))[0] = __builtin_amdgcn_s_memrealtime(); } while (0)
#define ITS_E(k) do { if ((k) == TS_SEL && WV_ == 0 && LANEID() == 0) { volatile __attribute__((address_space(3))) unsigned long long* w_ = (volatile __attribute__((address_space(3))) unsigned long long*)((__attribute__((address_space(3))) unsigned char*)lds + 147456 - 16 - 32); w_[1] += __builtin_amdgcn_s_memrealtime() - w_[0]; } } while (0)

typedef float f32x4_t __attribute__((ext_vector_type(4)));
typedef __bf16 bf16x2v __attribute__((ext_vector_type(2)));
__device__ __forceinline__ float dot2bf(unsigned a, unsigned b, float c) { return __builtin_amdgcn_fdot2_f32_bf16(__builtin_bit_cast(bf16x2v, a), __builtin_bit_cast(bf16x2v, b), c, false); }
__device__ __forceinline__ void cnt_gt(int& cnt, unsigned a, unsigned b) { asm("v_cmp_gt_u32_e32 vcc, %1, %2\n\tv_addc_co_u32_e32 %0, vcc, 0, %0, vcc" : "+v"(cnt) : "v"(a), "v"(b) : "vcc"); }
__device__ __forceinline__ void cnt_eq(int& cnt, unsigned a, unsigned b) { asm("v_cmp_eq_u32_e32 vcc, %1, %2\n\tv_addc_co_u32_e32 %0, vcc, 0, %0, vcc" : "+v"(cnt) : "v"(a), "v"(b) : "vcc"); }
__device__ __forceinline__ unsigned flag_gt(unsigned a, unsigned b) { unsigned r; asm("v_cmp_gt_u32_e32 vcc, %1, %2\n\tv_cndmask_b32_e64 %0, 0, 1, vcc" : "=v"(r) : "v"(a), "v"(b) : "vcc"); return r; }
__device__ __forceinline__ unsigned flag_eq(unsigned a, unsigned b) { unsigned r; asm("v_cmp_eq_u32_e32 vcc, %1, %2\n\tv_cndmask_b32_e64 %0, 0, 1, vcc" : "=v"(r) : "v"(a), "v"(b) : "vcc"); return r; }
__device__ __forceinline__ void cnt_ge(int& cnt, unsigned key, unsigned cand) { asm("v_cmp_ge_u32_e32 vcc, %1, %2\n\tv_addc_co_u32_e32 %0, vcc, 0, %0, vcc" : "+v"(cnt) : "v"(key), "v"(cand) : "vcc"); }

template <int CTRL, int RM> __device__ __forceinline__ unsigned dpp0(unsigned v) { return (unsigned)__builtin_amdgcn_update_dpp(0, (int)v, CTRL, RM, 0xf, false); }
template <int CTRL> __device__ __forceinline__ unsigned dppf(unsigned v) { return (unsigned)__builtin_amdgcn_update_dpp(-1, (int)v, CTRL, 0xf, 0xf, false); }
__device__ __forceinline__ unsigned wave_sum_u_dpp(unsigned v) {
    v += dpp0<0xB1, 0xf>(v); v += dpp0<0x4E, 0xf>(v); v += dpp0<0x141, 0xf>(v); v += dpp0<0x140, 0xf>(v);
    return (unsigned)__builtin_amdgcn_readlane((int)v, 0) + (unsigned)__builtin_amdgcn_readlane((int)v, 16) + (unsigned)__builtin_amdgcn_readlane((int)v, 32) + (unsigned)__builtin_amdgcn_readlane((int)v, 48);
}
__device__ __forceinline__ unsigned wave_min_u_dpp(unsigned v) {
    unsigned t;
    t = dppf<0xB1>(v); v = t < v ? t : v; t = dppf<0x4E>(v); v = t < v ? t : v; t = dppf<0x141>(v); v = t < v ? t : v; t = dppf<0x140>(v); v = t < v ? t : v;
    const unsigned a = (unsigned)__builtin_amdgcn_readlane((int)v, 0), b = (unsigned)__builtin_amdgcn_readlane((int)v, 16), c = (unsigned)__builtin_amdgcn_readlane((int)v, 32), d = (unsigned)__builtin_amdgcn_readlane((int)v, 48);
    const unsigned ab = a < b ? a : b, cd = c < d ? c : d; return ab < cd ? ab : cd;
}
__device__ __forceinline__ unsigned wave_incl_scan_u_dpp(unsigned v) {
    v += dpp0<0x111, 0xf>(v); v += dpp0<0x112, 0xf>(v); v += dpp0<0x114, 0xf>(v); v += dpp0<0x118, 0xf>(v);
    v += dpp0<0x142, 0xa>(v);
    v += dpp0<0x143, 0xc>(v);
    return v;
}
typedef __attribute__((address_space(3))) unsigned lds_u32;
template <int SHIFT> __device__ __forceinline__ unsigned radix_pass(const unsigned (&key)[64], unsigned pre, lds_u32* hist, int lane, int& need, int jlim, unsigned L, unsigned& cntsel) {
    typedef unsigned u32x4v __attribute__((ext_vector_type(4)));
    typedef __attribute__((address_space(3))) u32x4v lds_u32x4;
    const int fl = 63 - lane;
    { const u32x4v z4 = {0u, 0u, 0u, 0u};
      ((lds_u32x4*)(hist + fl * 4))[0] = z4; }
    const unsigned hb = (unsigned)(size_t)hist;
    const unsigned one = 1u;
    asm volatile("" ::: "memory");
#pragma unroll
    for (int j4 = 0; j4 < 16; ++j4) {
        if (4 * j4 <= jlim) {
            unsigned long long c0, c1, c2, c3, sv; unsigned t0, t1, t2, t3;
            if (SHIFT == 24)
                asm volatile(
                    "v_cmp_ge_u32_e64 %0, %9, %13\n\tv_cmp_ge_u32_e64 %1, %10, %13\n\tv_cmp_ge_u32_e64 %2, %11, %13\n\tv_cmp_ge_u32_e64 %3, %12, %13\n\t"
                    "v_lshrrev_b32_e32 %5, 24, %9\n\tv_lshrrev_b32_e32 %6, 24, %10\n\tv_lshrrev_b32_e32 %7, 24, %11\n\tv_lshrrev_b32_e32 %8, 24, %12\n\t"
                    "v_lshl_add_u32 %5, %5, 2, %14\n\tv_lshl_add_u32 %6, %6, 2, %14\n\tv_lshl_add_u32 %7, %7, 2, %14\n\tv_lshl_add_u32 %8, %8, 2, %14\n\t"
                    "s_mov_b64 %4, exec\n\t"
                    "s_mov_b64 exec, %0\n\tds_add_u32 %5, %15\n\ts_mov_b64 exec, %1\n\tds_add_u32 %6, %15\n\ts_mov_b64 exec, %2\n\tds_add_u32 %7, %15\n\ts_mov_b64 exec, %3\n\tds_add_u32 %8, %15\n\t"
                    "s_mov_b64 exec, %4"
                    : "=&s"(c0), "=&s"(c1), "=&s"(c2), "=&s"(c3), "=&s"(sv), "=&v"(t0), "=&v"(t1), "=&v"(t2), "=&v"(t3)
                    : "v"(key[4 * j4]), "v"(key[4 * j4 + 1]), "v"(key[4 * j4 + 2]), "v"(key[4 * j4 + 3]), "v"(L), "v"(hb), "v"(one) : "memory");
            else
                asm volatile(
                    "v_lshrrev_b32_e32 %5, %16, %9\n\tv_lshrrev_b32_e32 %6, %16, %10\n\tv_lshrrev_b32_e32 %7, %16, %11\n\tv_lshrrev_b32_e32 %8, %16, %12\n\t"
                    "v_cmp_eq_u32_e64 %0, %5, %13\n\tv_cmp_eq_u32_e64 %1, %6, %13\n\tv_cmp_eq_u32_e64 %2, %7, %13\n\tv_cmp_eq_u32_e64 %3, %8, %13\n\t"
                    "s_or_b64 %4, %0, %1\n\ts_or_b64 %4, %4, %2\n\ts_or_b64 %4, %4, %3\n\t"
                    "s_cbranch_scc0 .Lrxskip%=\n\t"
                    "v_bfe_u32 %5, %9, %17, 8\n\tv_bfe_u32 %6, %10, %17, 8\n\tv_bfe_u32 %7, %11, %17, 8\n\tv_bfe_u32 %8, %12, %17, 8\n\t"
                    "v_lshl_add_u32 %5, %5, 2, %14\n\tv_lshl_add_u32 %6, %6, 2, %14\n\tv_lshl_add_u32 %7, %7, 2, %14\n\tv_lshl_add_u32 %8, %8, 2, %14\n\t"
                    "s_mov_b64 %4, exec\n\t"
                    "s_mov_b64 exec, %0\n\tds_add_u32 %5, %15\n\ts_mov_b64 exec, %1\n\tds_add_u32 %6, %15\n\ts_mov_b64 exec, %2\n\tds_add_u32 %7, %15\n\ts_mov_b64 exec, %3\n\tds_add_u32 %8, %15\n\t"
                    "s_mov_b64 exec, %4\n"
                    ".Lrxskip%=:"
                    : "=&s"(c0), "=&s"(c1), "=&s"(c2), "=&s"(c3), "=&s"(sv), "=&v"(t0), "=&v"(t1), "=&v"(t2), "=&v"(t3)
                    : "v"(key[4 * j4]), "v"(key[4 * j4 + 1]), "v"(key[4 * j4 + 2]), "v"(key[4 * j4 + 3]), "v"(pre), "v"(hb), "v"(one), "n"((SHIFT + 8) & 31), "n"(SHIFT) : "memory", "scc");
        }
    }
    asm volatile("s_waitcnt lgkmcnt(0)" ::: "memory");
    unsigned dsum[4]; unsigned sumL = 0u;
    { const u32x4v v0 = ((const lds_u32x4*)(hist + fl * 4))[0];
      dsum[0] = v0.x; dsum[1] = v0.y; dsum[2] = v0.z; dsum[3] = v0.w; sumL = (dsum[0] + dsum[1]) + (dsum[2] + dsum[3]); }
    const unsigned incl = wave_incl_scan_u_dpp(sumL);
    const unsigned above = incl - sumL;
    const bool own = (above < (unsigned)need) && ((unsigned)need <= above + sumL);
    const int owner = __ffsll((long long)__ballot(own)) - 1;
    unsigned acc = above; int sel = -1; unsigned cab = 0u;
    unsigned csel = 0u;
#pragma unroll
    for (int i = 3; i >= 0; --i) { const unsigned c = dsum[i]; const bool hit = (sel < 0) && (acc + c >= (unsigned)need); cab = hit ? acc : cab; csel = hit ? c : csel; sel = hit ? i : sel; acc += c; }
    const int ow = owner < 0 ? 0 : owner;
    const unsigned digit = (unsigned)__builtin_amdgcn_readlane(sel, ow) + (unsigned)(4 * (63 - ow));
    need -= (int)__builtin_amdgcn_readlane((int)cab, ow);
    cntsel = (unsigned)__builtin_amdgcn_readlane((int)csel, ow);
    return digit;
}

__device__ __forceinline__ void idx_select(const unsigned (&key)[64], unsigned t3, int jlim, lds_u32* hist, int lane, uint2* mrow, int WV_, unsigned char* lds) {
        unsigned wlo = 0u, whi = 0u;
        unsigned L = wave_min_u_dpp(t3);
        L = L > 1u ? L : 1u;

        int need = 256;
        ITS_E(34); ITS_B();
        unsigned cs; bool fin;
        const unsigned d1 = radix_pass<24>(key, 0u, hist, lane, need, jlim, L, cs);
        unsigned prefix = d1 << 24; fin = cs == (unsigned)need;
        if (fin) prefix = prefix > L ? prefix : L;
        if (!fin) {
            const unsigned d2 = radix_pass<16>(key, d1, hist, lane, need, jlim, L, cs);
            prefix |= d2 << 16; fin = cs == (unsigned)need;
            if (!fin) {
                const unsigned d3 = radix_pass<8>(key, (d1 << 8) | d2, hist, lane, need, jlim, L, cs);
                prefix |= d3 << 8; fin = cs == (unsigned)need;
                if (!fin) { const unsigned d4 = radix_pass<0>(key, (d1 << 16) | (d2 << 8) | d3, hist, lane, need, jlim, L, cs); prefix |= d4; }
            }
        }
        int ceq = 0;
        if (!fin)
#pragma unroll
        for (int j4 = 0; j4 < 16; ++j4) if (4 * j4 <= jlim) { cnt_eq(ceq, key[4 * j4], prefix); cnt_eq(ceq, key[4 * j4 + 1], prefix); cnt_eq(ceq, key[4 * j4 + 2], prefix); cnt_eq(ceq, key[4 * j4 + 3], prefix); }
        ceq = (int)wave_sum_u_dpp((unsigned)ceq);
        int X = 4096;
        if (!fin && ceq != need) {
            int X0 = 0;
#pragma unroll 1
            for (int bit = 11; bit >= 0; --bit) {
                const int c = X0 | (1 << bit);
                int cnt = 0; const int crel = (c - lane + 63) >> 6;
#pragma unroll
                for (int j = 0; j < 64; ++j) cnt_eq(cnt, (key[j] ^ prefix) | ~(unsigned)((j - crel) >> 31), 0u);
                cnt = wave_sum_i(cnt);
                if (cnt < need) X0 = c;
            }
            X = X0 + 1;
        }
        const int xrel = (X - lane + 63) >> 6;
#pragma unroll
        for (int j4 = 0; j4 < 16; ++j4) {
            if (4 * j4 <= jlim) {
#pragma unroll
                for (int e = 0; e < 4; ++e) { const int j = 4 * j4 + e;
                    const bool sel = (key[j] > prefix) || (key[j] == prefix && j < xrel);
                    const unsigned long long bm = __ballot(sel);
                    asm("v_writelane_b32 %0, %1, %2" : "+v"(wlo) : "s"((unsigned)bm), "n"(j));
                    asm("v_writelane_b32 %0, %1, %2" : "+v"(whi) : "s"((unsigned)(bm >> 32)), "n"(j)); }
            }
        }
        mrow[lane] = make_uint2(wlo, whi);
        ITS_E(33); ITS_B();
}
__device__ void index_fast_phase(int WV_, const bf16* P, unsigned char* mask, float* kmean, float* scratch_all, unsigned* qctr, unsigned char* lds) {
    const int tid = LTID(WV_), lane = tid & 63, wave = tid >> 6, bid = LBID(), G = LGRID();
    float* s_part = (float*)lds;
    ITS_B();
    for (int k = bid; k < 256; k += G) {
        const int b = k >> 6, h = (k >> 4) & 3, blk = k & 15;
        const bf16* kp = P + (size_t)(b * S_ + blk * 256 + wave * 32) * NP + C_KC + h * 64 + lane;
        float a = 0.f;
#pragma unroll 8
        for (int j = 0; j < 32; ++j) a += bf2f(kp[(size_t)j * NP]);
        __syncthreads();
        s_part[wave * 64 + lane] = a;
        __syncthreads();
        if (tid < 64) { float s = 0.f;
#pragma unroll
            for (int w = 0; w < 8; ++w) s += s_part[w * 64 + tid];
            kmean[((b * 4 + h) * 16 + blk) * 64 + tid] = s * (1.0f / 256.0f); }
    }
    ITS_E(22);
    constexpr int IDX_CP = 512 + 4;
    constexpr int IDX_PITCH = 4096 + 32;
    float* scr = scratch_all + (size_t)bid * (16 * IDX_PITCH);
    const int lq = lane & 15, g4 = lane >> 4;
    for (int ui = bid; ui < 1024; ui += G) {
        const int b = ui >> 8, k = ui & 255, tile = (b & 1) ? 255 - k : k, q0 = tile * 16;
        const bf16* Pb = P + (size_t)b * S_ * NP;
        const int ntiles = tile + 1;
        int lane_o = LANEID(); asm volatile("" : "+v"(lane_o));
        const int lane = lane_o, lq = lane & 15, g4 = lane >> 4;
        const int wave = WV_;
        const int qA = q0 + 2 * wave, qB = qA + 1;
        uint2* mrowA = (uint2*)(mask + (size_t)(b * S_ + qA) * 512); uint2* mrowB = (uint2*)(mask + (size_t)(b * S_ + qB) * 512);
        if (tile < 16) {
            unsigned wlo = 0u, whi = 0u, xlo = 0u, xhi = 0u; const int ra = qA - lane * 64, rb = qB - lane * 64;
#pragma unroll
            for (int j = 0; j < 32; ++j) { wlo |= (~(unsigned)((ra - j) >> 31) & 1u) << j; whi |= (~(unsigned)((ra - 32 - j) >> 31) & 1u) << j;
                                           xlo |= (~(unsigned)((rb - j) >> 31) & 1u) << j; xhi |= (~(unsigned)((rb - 32 - j) >> 31) & 1u) << j; }
            mrowA[lane] = make_uint2(wlo, whi); mrowB[lane] = make_uint2(xlo, xhi);
            continue;
        }
        ITS_B();
        bf16x8_t qf[8]; float wi[8];
        { const bf16* qp = Pb + (size_t)(q0 + lq) * NP + C_QI + 8 * g4;
#pragma unroll
          for (int h = 0; h < 8; ++h) qf[h] = *(const bf16x8_t*)(qp + 32 * h);
          const uint4 wv = *(const uint4*)(Pb + (size_t)(q0 + lq) * NP + C_WI); unpack8(wv, wi); }
        bf16x8_t qch, qcl;
        { typedef unsigned u32x4_t __attribute__((ext_vector_type(4)));
          float qc[8];
#pragma unroll
          for (int i = 0; i < 8; ++i) qc[i] = 0.f;
#pragma unroll
          for (int h = 0; h < 8; ++h) { const u32x4_t w4 = __builtin_bit_cast(u32x4_t, qf[h]);
#pragma unroll
              for (int i = 0; i < 4; ++i) { qc[2 * i] += wi[h] * __uint_as_float(w4[i] << 16); qc[2 * i + 1] += wi[h] * __uint_as_float(w4[i] & 0xffff0000u); } }
          u32x4_t hi4, lo4;
#pragma unroll
          for (int i = 0; i < 4; ++i) { const unsigned hw = cvtpk(qc[2 * i], qc[2 * i + 1]); hi4[i] = hw;
              lo4[i] = cvtpk(qc[2 * i] - __uint_as_float(hw << 16), qc[2 * i + 1] - __uint_as_float(hw & 0xffff0000u)); }
          qch = __builtin_bit_cast(bf16x8_t, hi4); qcl = __builtin_bit_cast(bf16x8_t, lo4); }
        typedef __attribute__((address_space(3))) bf16x8_t lds_bf16x8;
        lds_bf16x8* qops = (lds_bf16x8*)((__attribute__((address_space(3))) unsigned char*)lds + 102656);
        if (wave == 0) {
#pragma unroll
            for (int h = 0; h < 8; ++h) qops[h * 64 + lane] = qf[h];
            qops[8 * 64 + lane] = qch; qops[9 * 64 + lane] = qcl; }
        __syncthreads();
        ITS_E(20); ITS_B();
        float* cb0 = (float*)(lds + 69632); float* cb1 = (float*)(lds + 112896);
        const int jlim = q0 >> 6;
        const int jmaxA = (qA - lane) >> 6, jmaxB = (qB - lane) >> 6;
        unsigned keyA[64], keyB[64];
        unsigned a0 = 0u, a1 = 0u, a2 = 0u, a3 = 0u, b0 = 0u, b1 = 0u, b2 = 0u, b3 = 0u;
        const bf16* kbase = Pb + (size_t)lq * NP + C_KI + 8 * g4;
        bf16x8_t nxt = *(const bf16x8_t*)(kbase + (size_t)(wave < ntiles ? wave : 0) * 16 * NP);
#pragma unroll
        for (int c = 0; c < 8; ++c) {
            if (32 * c < ntiles) {
                float* cb = (c & 1) ? cb1 : cb0;
#pragma unroll
                for (int j = 0; j < 4; ++j) {
                    const int kt = 32 * c + wave + 8 * j;
                    const bf16x8_t af = nxt;
                    { const int k = kt + 8; const int kc = k < ntiles ? k : 0; nxt = *(const bf16x8_t*)(kbase + (size_t)kc * 16 * NP); }
                    if (kt < ntiles) {
                        const f32x4_t z = {0.f, 0.f, 0.f, 0.f};
                        f32x4_t sc = __builtin_amdgcn_mfma_f32_16x16x32_bf16(af, qops[8 * 64 + lane], z, 0, 0, 0);
                        sc = __builtin_amdgcn_mfma_f32_16x16x32_bf16(af, qops[9 * 64 + lane], sc, 0, 0, 0);
#pragma unroll
                        for (int hh = 0; hh < 2; ++hh) {
                            f32x4_t a[4];
#pragma unroll
                            for (int h = 0; h < 4; ++h) a[h] = __builtin_amdgcn_mfma_f32_16x16x32_bf16(af, qops[(4 * hh + h) * 64 + lane], z, 0, 0, 0);
#pragma unroll
                            for (int h = 0; h < 4; ++h)
#pragma unroll
                                for (int r = 0; r < 4; ++r) sc[r] = __builtin_fmaf(__builtin_fabsf(a[h][r]), wi[4 * hh + h], sc[r]);
                        }
#pragma unroll
                        for (int r = 0; r < 4; ++r) { sc[r] *= 0.03125f; if (sc[r] == 0.f) sc[r] = 0.f; }
                        *(f32x4_t*)(cb + lq * IDX_CP + (wave + 8 * j) * 16 + 4 * g4) = sc;
                    }
                }
                __syncthreads();
#pragma unroll
                for (int js = 0; js < 8; ++js) {
                    const int slot = 8 * c + js;
                    if (slot <= jlim) {
                        const unsigned ua = __float_as_uint(cb[(2 * wave) * IDX_CP + 64 * js + lane]), ub = __float_as_uint(cb[(2 * wave + 1) * IDX_CP + 64 * js + lane]);
                        const unsigned xa = (ua ^ ((unsigned)((int)ua >> 31) | 0x80000000u)) & ~(unsigned)((jmaxA - slot) >> 31);
                        const unsigned xb = (ub ^ ((unsigned)((int)ub >> 31) | 0x80000000u)) & ~(unsigned)((jmaxB - slot) >> 31);
                        keyA[slot] = xa; keyB[slot] = xb;
                        unsigned n1, n2, n3;
                        asm("v_med3_u32 %0, %1, %2, %3" : "=v"(n3) : "v"(a2), "v"(a3), "v"(xa));
                        asm("v_med3_u32 %0, %1, %2, %3" : "=v"(n2) : "v"(a1), "v"(a2), "v"(xa));
                        asm("v_med3_u32 %0, %1, %2, %3" : "=v"(n1) : "v"(a0), "v"(a1), "v"(xa));
                        a0 = a0 > xa ? a0 : xa; a1 = n1; a2 = n2; a3 = n3;
                        asm("v_med3_u32 %0, %1, %2, %3" : "=v"(n3) : "v"(b2), "v"(b3), "v"(xb));
                        asm("v_med3_u32 %0, %1, %2, %3" : "=v"(n2) : "v"(b1), "v"(b2), "v"(xb));
                        asm("v_med3_u32 %0, %1, %2, %3" : "=v"(n1) : "v"(b0), "v"(b1), "v"(xb));
                        b0 = b0 > xb ? b0 : xb; b1 = n1; b2 = n2; b3 = n3;
                    } else { keyA[slot] = 0u; keyB[slot] = 0u; }
                }
            } else {
#pragma unroll
                for (int js = 0; js < 8; ++js) { keyA[8 * c + js] = 0u; keyB[8 * c + js] = 0u; }
            }
        }
        lds_u32* hist = (lds_u32*)((__attribute__((address_space(3))) unsigned char*)lds + 2048) + wave * 2048;
        ITS_E(23); ITS_B();
        idx_select(keyA, a3, jlim, hist, lane, mrowA, WV_, lds);
        ITS_E(24); ITS_B();
        idx_select(keyB, b3, jlim, hist, lane, mrowB, WV_, lds);
        ITS_E(25); ITS_B();
        __syncthreads();
    }
}

constexpr int MG_P = 72;
constexpr int MG_TILE_BYTES = 128 * MG_P * 2;
__device__ void merge_fast_phase(int WV_, const unsigned char* G8, const bf16* ys, const bf16* wbt  , bf16* merged, unsigned char* lds) {
    const int tid = LTID(WV_), lane = tid & 63, wave = tid >> 6, r32 = lane & 31, hi = lane >> 5, wt = wave & 3, wd = wave >> 2;
    const int srow0 = tid >> 3, sch = tid & 7;
    for (int tile = LBID(); tile < 1024; tile += LGRID()) {
        const int tok0 = (tile >> 3) * 128, d0 = (tile & 7) * 128;
        f32x16_t mer[2], acc[2];
#pragma unroll
        for (int r = 0; r < 16; ++r) { mer[0][r] = 0.f; mer[1][r] = 0.f; acc[0][r] = 0.f; acc[1][r] = 0.f; }
        uint4 RW00, RW01, RW10, RW11, RY00, RY01, RY10, RY11, RG0, RG1;
        unsigned char* gl = lds + 4 * MG_TILE_BYTES;
        const int grow = tid >> 3, gch = tid & 7;
#define MG_GLOAD(st_, R_) do { const int n_ = (st_) >> 2, kc_ = (st_) & 3; \
            RW##R_##0 = *(const uint4*)(wbt + ((size_t)n_ * 1024 + d0 + srow0) * 256 + kc_ * 64 + sch * 8); \
            RW##R_##1 = *(const uint4*)(wbt + ((size_t)n_ * 1024 + d0 + srow0 + 64) * 256 + kc_ * 64 + sch * 8); \
            RY##R_##0 = *(const uint4*)(ys + (size_t)(tok0 + srow0) * 1024 + n_ * 256 + kc_ * 64 + sch * 8); \
            RY##R_##1 = *(const uint4*)(ys + (size_t)(tok0 + srow0 + 64) * 1024 + n_ * 256 + kc_ * 64 + sch * 8); } while (0)
#define MG_SSTORE(buf_, R_) do { bf16* wl_ = (bf16*)(lds + (buf_) * 2 * MG_TILE_BYTES); bf16* yl_ = (bf16*)(lds + (buf_) * 2 * MG_TILE_BYTES + MG_TILE_BYTES); \
            *(uint4*)(wl_ + srow0 * MG_P + sch * 8) = RW##R_##0; *(uint4*)(wl_ + (srow0 + 64) * MG_P + sch * 8) = RW##R_##1; \
            *(uint4*)(yl_ + srow0 * MG_P + sch * 8) = RY##R_##0; *(uint4*)(yl_ + (srow0 + 64) * MG_P + sch * 8) = RY##R_##1; } while (0)
        __syncthreads();
        MG_GLOAD(0, 0); MG_GLOAD(1, 1);
        MG_SSTORE(0, 0);
        __syncthreads();
#define MG_STAGE(PAR_, OTH_) do { const int buf = PAR_; \
            if (st + 2 < 16) MG_GLOAD(st + 2, PAR_); \
            if ((st & 3) == 1) { const unsigned char* gsrc = G8 + (size_t)(tok0 + grow) * 4096 + (st >> 2) * 1024 + d0 + gch * 16; \
                RG0 = *(const uint4*)gsrc; RG1 = *(const uint4*)(gsrc + (size_t)64 * 4096); } \
            const bf16* wl = (const bf16*)(lds + buf * 2 * MG_TILE_BYTES); const bf16* yl = (const bf16*)(lds + buf * 2 * MG_TILE_BYTES + MG_TILE_BYTES); \
            _Pragma("unroll") for (int ks = 0; ks < 4; ++ks) { \
                const bf16x8_t bq = *(const bf16x8_t*)(yl + (32 * wt + r32) * MG_P + 16 * ks + 8 * hi); \
                const bf16x8_t a0 = *(const bf16x8_t*)(wl + (64 * wd + r32) * MG_P + 16 * ks + 8 * hi); \
                const bf16x8_t a1 = *(const bf16x8_t*)(wl + (64 * wd + 32 + r32) * MG_P + 16 * ks + 8 * hi); \
                acc[0] = __builtin_amdgcn_mfma_f32_32x32x16_bf16(a0, bq, acc[0], 0, 0, 0); \
                acc[1] = __builtin_amdgcn_mfma_f32_32x32x16_bf16(a1, bq, acc[1], 0, 0, 0); } \
            if ((st & 3) == 3) { \
                const int n = st >> 2; \
                const unsigned char* gp = gl + (32 * wt + r32) * 144 + 64 * wd + 4 * hi; (void)n; \
                _Pragma("unroll") for (int dt = 0; dt < 2; ++dt) \
                _Pragma("unroll") for (int g = 0; g < 4; ++g) { \
                        const int gv = *(const int*)(gp + 32 * dt + 8 * g); \
                        mer[dt][4 * g + 0] += acc[dt][4 * g + 0] * __builtin_amdgcn_cvt_f32_fp8(gv, 0); \
                        mer[dt][4 * g + 1] += acc[dt][4 * g + 1] * __builtin_amdgcn_cvt_f32_fp8(gv, 1); \
                        mer[dt][4 * g + 2] += acc[dt][4 * g + 2] * __builtin_amdgcn_cvt_f32_fp8(gv, 2); \
                        mer[dt][4 * g + 3] += acc[dt][4 * g + 3] * __builtin_amdgcn_cvt_f32_fp8(gv, 3); } \
                _Pragma("unroll") for (int r = 0; r < 16; ++r) { acc[0][r] = 0.f; acc[1][r] = 0.f; } } \
            if (st + 1 < 16) MG_SSTORE(OTH_, OTH_); \
            if ((st & 3) == 2) { *(uint4*)(gl + grow * 144 + gch * 16) = RG0; *(uint4*)(gl + (grow + 64) * 144 + gch * 16) = RG1; } \
            __syncthreads(); } while (0)
#pragma unroll 1
        for (int st2 = 0; st2 < 16; st2 += 2) { { const int st = st2; MG_STAGE(0, 1); } { const int st = st2 + 1; MG_STAGE(1, 0); } }
#undef MG_STAGE
#undef MG_GLOAD
#undef MG_SSTORE
        bf16* mp = merged + (size_t)(tok0 + 32 * wt + r32) * 1024 + d0 + 64 * wd + 4 * hi;
#pragma unroll
        for (int dt = 0; dt < 2; ++dt)
#pragma unroll
            for (int g = 0; g < 4; ++g)
                *(uint2*)(mp + 32 * dt + 8 * g) = make_uint2(cvtpk(mer[dt][4 * g], mer[dt][4 * g + 1]), cvtpk(mer[dt][4 * g + 2], mer[dt][4 * g + 3]));
    }
}
#define LAS __attribute__((address_space(3)))
#define XB_TMO      128
#define XB_XCNT(j)  (256  + 64 * (j))
#define XB_XSUB(j)  (1280 + 64 * (j))
#define XB_XGEN(j)  (2304 + 64 * (j))
#define XB_TOP      3328
#define XB_TOPGEN   3392
#define XCD_BAR_WORDS 3456
#define XB_SPIN_CAP (1u << 18)

__device__ __forceinline__ unsigned xb_ld(unsigned* p)              { return __hip_atomic_load(p, __ATOMIC_RELAXED, __HIP_MEMORY_SCOPE_AGENT); }
__device__ __forceinline__ unsigned xb_add(unsigned* p, unsigned v) { return __hip_atomic_fetch_add(p, v, __ATOMIC_RELAXED, __HIP_MEMORY_SCOPE_AGENT); }
__device__ __forceinline__ unsigned xb_xcc_id() { return (unsigned)__builtin_amdgcn_s_getreg((3 << 11) | 20) & 0xFu; }
#define XB_SPIN(cond, bar) do { unsigned _sp = 0; while (cond) { __builtin_amdgcn_s_sleep(1); \
    if ((++_sp & 255u) == 0u) { if (xb_ld(&(bar)[XB_TMO])) break; if (_sp > XB_SPIN_CAP) { atomicAdd(&(bar)[XB_TMO], 1u); break; } } } } while (0)

struct XcdBarrier {
    unsigned* bar; unsigned x;
    volatile LAS unsigned* st;
};

__device__ __forceinline__ XcdBarrier xcd_barrier_post(unsigned* bar, volatile LAS unsigned* st) {
    XcdBarrier b; b.bar = bar; b.x = xb_xcc_id(); b.st = st;
    if (threadIdx.x == 0) (void)xb_add(&bar[XB_XCNT(b.x)], 1u);
    return b;
}
__device__ __forceinline__ void xcd_barrier_complete(unsigned* bar, unsigned x, unsigned& nloc, unsigned& nx) {
    const unsigned G = gridDim.x * gridDim.y * gridDim.z;
    unsigned sum, cnt, mine, sp = 0u;
    for (;;) {
        sum = 0u; cnt = 0u; mine = 0u;
#pragma unroll
        for (unsigned j = 0; j < 16; ++j) { const unsigned c = xb_ld(&bar[XB_XCNT(j)]); sum += c; cnt += (c > 0u) ? 1u : 0u; mine = (j == x) ? c : mine; }
        if (sum == G) break;
        __builtin_amdgcn_s_sleep(1);
        if ((++sp & 255u) == 0u) { if (xb_ld(&bar[XB_TMO])) break; if (sp > XB_SPIN_CAP) { atomicAdd(&bar[XB_TMO], 1u); break; } }
    }
    nloc = mine > 0u ? mine : 1u; nx = cnt > 0u ? cnt : 1u;
}

__device__ __forceinline__ void xcd_barrier(const XcdBarrier& b, int wv_) {
    asm volatile("s_waitcnt vmcnt(0)" ::: "memory");
    __syncthreads();
    if (wv_ == 0 && LANEID() == 0) {
        unsigned* bar = b.bar;
        __builtin_amdgcn_s_waitcnt(0);
        unsigned nloc = b.st[0], nx = b.st[1];
        if (nloc == 0u) { xcd_barrier_complete(bar, b.x, nloc, nx); b.st[0] = nloc; b.st[1] = nx; }
        const unsigned old = xb_add(&bar[XB_XSUB(b.x)], 1u);
        const unsigned gen = old / nloc;
        if (old + 1u == (gen + 1u) * nloc) {
            __builtin_amdgcn_fence(__ATOMIC_RELEASE, "agent");
            asm volatile("s_waitcnt vmcnt(0)" ::: "memory");
            const unsigned og = xb_add(&bar[XB_TOP], 1u);
            const unsigned tg = og / nx;
            if (og + 1u == (tg + 1u) * nx) xb_add(&bar[XB_TOPGEN], 1u);
            else XB_SPIN(xb_ld(&bar[XB_TOPGEN]) == tg, bar);
            __builtin_amdgcn_fence(__ATOMIC_ACQUIRE, "agent");
            xb_add(&bar[XB_XGEN(b.x)], 1u);
            asm volatile("s_waitcnt vmcnt(0)" ::: "memory");
        } else {
            XB_SPIN(xb_ld(&bar[XB_XGEN(b.x)]) == gen, bar);
            __builtin_amdgcn_fence(__ATOMIC_ACQUIRE, "agent");
            asm volatile("s_waitcnt vmcnt(0)" ::: "memory");
        }
    }
    __syncthreads();
}

enum { PH_PRO = 0, PH_GIN, PH_INDEX, PH_ATTN, PH_MERGE, PH_GOUT, PH_LN1, PH_GQ, PH_ROUTE, PH_PEER };
template <int PH> __device__ __forceinline__ void run_phase(int WV_, const Params& p_unused, int l, unsigned char* lds_raw) {
    size_t kaoff_ = 0; asm volatile("" : "+s"(kaoff_));
    typedef const __attribute__((address_space(4))) char* kaptr_t;
    const __attribute__((address_space(4))) Params& p = *(const __attribute__((address_space(4))) Params*)((kaptr_t)__builtin_amdgcn_kernarg_segment_ptr() + kaoff_);
    float* sm = (float*)lds_raw;
    size_t wsoff_ = 0; asm volatile("" : "+s"(wsoff_));
    unsigned char* ws = p.ws + wsoff_;
    float* hbuf = p.out;
    bf16* hb = (bf16*)(ws + WS_HB);
    bf16* P = (bf16*)(ws + WS_P);
    bf16* ys = (bf16*)(ws + WS_YS);
    bf16* mrg = (bf16*)(ws + WS_MRG);
    float* mix = (float*)(ws + WS_MIX);
    float* qb = (float*)(ws + WS_Q);
    unsigned char* mask = ws + WS_MASK;
    int* eid = (int*)(ws + WS_EID);
    float* gate = (float*)(ws + WS_GATE);
    float* kmean = (float*)(ws + WS_KMEAN);
    const float* hin = (l == 0) ? p.in[0] : hbuf;
    if (PH == PH_PRO) { Params pc; for (int i = 0; i < 13; ++i) pc.in[i] = p.in[i]; pc.out = p.out; pc.ws = ws;
        prologue_phase(WV_, pc, sm); convert_tables(WV_, pc);
        for (int i = LBID() * NTHR + LTID(WV_); i < DEPTH_ * 8 * 2 * 128 * 64 / 4; i += LGRID() * NTHR) { const float4 v = ((const float4*)p.in[8])[i]; ((uint2*)(ws + WS_SKB))[i] = make_uint2(pk2(v.x, v.y), pk2(v.z, v.w)); } if (LBID() < 2) build_unit_table((unsigned*)(ws + WS_CTL) + 1024, LBID() * NTHR + LTID(WV_)); }
    else if (PH == PH_GIN) {
        pg8::Gemm g{hb, (const bf16*)(ws + WS_WIN_T + l * WIN_T_BYTES), T_, NP, 1024};
        pg8::StaticOrder S; S.init(T_, NP, (int)LGRID(), (int)LBID());
        pg8::EpiBf16Sig E{P, NP, C_G, ws + WS_G8};
        pg8::gemm_phase<pg8::EpiBf16Sig, pg8::StaticOrder, true, true>(WV_, (PG8_LAS unsigned char*)lds_raw, g, S, E);
    }
    else if (PH == PH_INDEX) index_fast_phase(WV_, P, mask, kmean, (float*)(ws + WS_UV + 48 * MiB), (unsigned*)(ws + WS_CTL) + 64 * l + 16, lds_raw);
    else if (PH == PH_ATTN) attn_fast_phase(WV_, P, mask, kmean, p.in[4] + l * 4, ys, (const unsigned*)(ws + WS_CTL) + 1024, (unsigned*)(ws + WS_CTL) + 64 * l, lds_raw);
    else if (PH == PH_MERGE) merge_fast_phase(WV_, ws + WS_G8, ys, (const bf16*)(ws + WS_WBR_T) + (size_t)l * 4 * 1024 * 256, mrg, lds_raw);
    else if (PH == PH_GOUT) {
        pg8::Gemm g{mrg, (const bf16*)(ws + WS_WOUT_T) + (size_t)l * 1024 * 1024, T_, 1024, 1024};
        pg8::StaticOrder S; S.init(T_, 1024, (int)LGRID(), (int)LBID());
        pg8::EpiResY E{l == 0 ? hin : nullptr, hb, hb, (float*)(ws + WS_STATS) + (size_t)l * T_ * 2, ALPHA};
        pg8::gemm_phase<pg8::EpiResY, pg8::StaticOrder, true, true>(WV_, (PG8_LAS unsigned char*)lds_raw, g, S, E);
    }
    else if (PH == PH_GQ) {
        pg8::Gemm g{hb, (const bf16*)(ws + WS_WQ_T) + (size_t)l * 1024 * 1024, T_, 1024, 1024};
        pg8::StaticOrder S; S.init(T_, 1024, (int)LGRID(), (int)LBID());
        pg8::EpiLnFold E{(bf16*)qb, (const float*)(ws + WS_STATS) + (size_t)l * T_ * 2, (const float*)(ws + WS_COLS) + l * 2048, (const float*)(ws + WS_COLS) + l * 2048 + 1024, LN_EPS};
        pg8::gemm_phase<pg8::EpiLnFold, pg8::StaticOrder, true, true>(WV_, (PG8_LAS unsigned char*)lds_raw, g, S, E);
        pg8::Unit u0;
        if (LGRID() == 256 && S.next(0, u0)) {
            asm volatile("s_waitcnt vmcnt(0)" ::: "memory"); __syncthreads();
            route_fast_phase(WV_, (const bf16*)qb, (const bf16*)(ws + WS_SKB) + (size_t)l * 8 * 2 * 128 * 64, eid, gate, lds_raw, u0.pm, u0.pn);
        }
    }
    else if (PH == PH_ROUTE) { if (LGRID() != 256) route_fast_phase(WV_, (const bf16*)qb, (const bf16*)(ws + WS_SKB) + (size_t)l * 8 * 2 * 128 * 64, eid, gate, lds_raw); }
    else peer_fast_phase(WV_, (l + 1 == DEPTH_) ? hbuf : nullptr, hb, eid, gate, ws + WS_UV + (size_t)l * 24 * MiB, p.in[5] + l * 1024, p.in[6] + l * 1024, p.in[11] + l * 1024, p.in[12] + l * 1024, lds_raw);
}

constexpr int CW_BAR = 4096;
constexpr int LDS_BARST = LDS_BYTES - 16;
__global__ void __launch_bounds__(NTHR, 2) mk_fwd(Params p) {
    extern __shared__ __attribute__((aligned(16))) unsigned char lds_raw[];
    cg::grid_group grid = cg::this_grid();
    const int WV_ = __builtin_amdgcn_readfirstlane((int)threadIdx.x >> 6);
    { volatile LAS unsigned* bst0 = (volatile LAS unsigned*)((LAS unsigned char*)lds_raw + LDS_BARST); if (threadIdx.x < 4) bst0[threadIdx.x] = 0u; }
    __syncthreads();
    volatile LAS unsigned* bst = (volatile LAS unsigned*)((LAS unsigned char*)lds_raw + LDS_BARST);
    { uint4* z = (uint4*)p.ws; const uint4 z4 = make_uint4(0u, 0u, 0u, 0u);
      for (unsigned i = (unsigned)LBID() * NTHR + (unsigned)LTID(WV_); i < (unsigned)(2 * MiB / 16); i += (unsigned)LGRID() * NTHR) z[i] = z4; }
    grid.sync();
    (void)xcd_barrier_post((unsigned*)(p.ws + WS_CTL) + CW_BAR, bst);
#define GRID_BAR() do { XcdBarrier b_; b_.bar = (unsigned*)(p.ws + WS_CTL) + CW_BAR; b_.x = xb_xcc_id(); b_.st = (volatile LAS unsigned*)((LAS unsigned char*)lds_raw + LDS_BARST); xcd_barrier(b_, WV_); } while (0)
    run_phase<PH_PRO>(WV_, p, 0, lds_raw);
    GRID_BAR();
#pragma unroll 1
    for (int l = 0; l < DEPTH_; ++l) {
        run_phase<PH_GIN>(WV_, p, l, lds_raw); GRID_BAR();
        run_phase<PH_INDEX>(WV_, p, l, lds_raw); GRID_BAR();
        run_phase<PH_ATTN>(WV_, p, l, lds_raw); GRID_BAR();
        run_phase<PH_MERGE>(WV_, p, l, lds_raw); GRID_BAR();
        run_phase<PH_GOUT>(WV_, p, l, lds_raw); GRID_BAR();
        run_phase<PH_GQ>(WV_, p, l, lds_raw); if (LGRID() != 256) { GRID_BAR(); run_phase<PH_ROUTE>(WV_, p, l, lds_raw); } GRID_BAR();
        run_phase<PH_PEER>(WV_, p, l, lds_raw); if (l + 1 < DEPTH_) GRID_BAR();
    }
}

extern "C" void kernel_launch(void* const* d_in, const int* in_sizes, int n_in, void* d_out, int out_size, void* d_ws, size_t ws_size, hipStream_t stream) {
    if (n_in != 13 || ws_size < WS_END) { fprintf(stderr, "kernel_launch: unexpected n_in %d / ws_size %zu; nothing launched\n", n_in, ws_size); return; }
    static int grid_blocks = 0;
    if (grid_blocks == 0) {
        int dev = 0, cus = 0, per_cu = 0;
        (void)hipGetDevice(&dev);
        (void)hipDeviceGetAttribute(&cus, hipDeviceAttributeMultiprocessorCount, dev);
        (void)hipFuncSetAttribute((const void*)mk_fwd, hipFuncAttributeMaxDynamicSharedMemorySize, LDS_BYTES);
        (void)hipOccupancyMaxActiveBlocksPerMultiprocessor(&per_cu, (const void*)mk_fwd, NTHR, LDS_BYTES);
        if (per_cu < 1) fprintf(stderr, "kernel_launch: occupancy query reports %d\n", per_cu);
        grid_blocks = cus;
    }
    Params p{};
    for (int i = 0; i < 13; ++i) p.in[i] = (const float*)d_in[i];
    p.out = (float*)d_out; p.ws = (unsigned char*)d_ws;
    void* args[] = {&p};
    hipError_t e = hipLaunchCooperativeKernel((const void*)mk_fwd, dim3(grid_blocks), dim3(NTHR), args, LDS_BYTES, stream);
    if (e != hipSuccess) fprintf(stderr, "cooperative launch failed: %s (grid %d)\n", hipGetErrorString(e), grid_blocks);
}
```

```cpp
#include <hip/hip_runtime.h>
#include <cstdio>
#include <cstdint>
#include <hip/hip_cooperative_groups.h>
namespace cg = cooperative_groups;

__device__ __forceinline__ int LANEID() { int l; asm volatile("v_mbcnt_lo_u32_b32 %0, -1, 0\n\tv_mbcnt_hi_u32_b32 %0, -1, %0" : "=v"(l)); return l; }
__device__ __forceinline__ int LTID(int wv) { return (wv << 6) | LANEID(); }
__device__ __forceinline__ int LBID() { int t = blockIdx.x; asm volatile("" : "+s"(t)); return t; }
__device__ __forceinline__ int LGRID() { int t = gridDim.x; asm volatile("" : "+s"(t)); return t; }
namespace pg8 {
#define PG8_LAS __attribute__((address_space(3)))
typedef unsigned short bf16_t;
typedef short bf16x8 __attribute__((ext_vector_type(8)));
typedef float f32x4 __attribute__((ext_vector_type(4)));
typedef unsigned u32x4 __attribute__((ext_vector_type(4)));
constexpr int BM = 256, BK = 64, HALF = 128, HTB = HALF * BK * 2  , STAGE_BYTES = 8 * HTB, NXCD = 8, WGM = 8;

__host__ __device__ __forceinline__ int lds_byte(int r, int c) { const int st = (r >> 4) * 2 + (c >> 5), rr = r & 15, cc = c & 31, ob = rr * 64 + cc * 2; return st * 1024 + (ob ^ (((ob >> 9) & 1) << 5)); }
__host__ __device__ __forceinline__ void stage_rc(int b, int& R, int& C) { const int st = b / 1024, sb = b % 1024, swz = sb ^ (((sb >> 9) & 1) << 5); R = (st >> 1) * 16 + swz / 64; C = (st & 1) * 32 + (swz % 64) / 2; }
__host__ __device__ __forceinline__ int perm32(int rho) { const int n = rho >> 4, i = rho & 15; return 8 * (i >> 2) + 4 * n + (i & 3); }

struct Unit { int pm, pn; };
struct Gemm { const bf16_t* A; const bf16_t* Bt; int M, N, K; };

struct StaticOrder {
    int nM, nN, nwg, G, c;
    __host__ __device__ void init(int M, int N, int G_, int c_) { nM = M / BM; nN = N / BM; nwg = nM * nN; G = G_; c = c_; }
    __host__ __device__ bool next(int i, Unit& u) const {
        const long L = (long)i * G + c; if (L >= nwg) return false;
        int wgid = (int)L; { const int q = nwg / NXCD, r = nwg % NXCD, xcd = wgid % NXCD, off = wgid / NXCD; wgid = (xcd < r ? xcd * (q + 1) : r * (q + 1) + (xcd - r) * q) + off; }
        const int nig = WGM * nN, gid = wgid / nig, fm = gid * WGM, gsz = (nM - fm) < WGM ? (nM - fm) : WGM;
        u.pm = fm + ((wgid % nig) % gsz); u.pn = (wgid % nig) / gsz; return true;
    }
    __device__ __forceinline__ void a_ready(const Unit&) const {}
    __device__ __forceinline__ void done(const Unit&) const {}
};

__device__ __forceinline__ unsigned cvt_pk_bf16(float lo, float hi) { unsigned r; asm volatile("v_cvt_pk_bf16_f32 %0, %1, %2" : "=v"(r) : "v"(lo), "v"(hi)); return r; }
typedef float f32x2 __attribute__((ext_vector_type(2)));
__device__ __forceinline__ f32x2 gelu_pk(f32x2 v) {
    const f32x2 av = __builtin_elementwise_abs(v), d = av * 0.2316418882f + 1.0f;
    f32x2 t; t.x = __builtin_amdgcn_rcpf(d.x); t.y = __builtin_amdgcn_rcpf(d.y);
    f32x2 q = t * 0.5307027145f + (-0.7265760135f); q = q * t + 0.7107068705f; q = q * t + (-0.142248368f); q = q * t + 0.127414796f; q = q * t;
    const f32x2 s = (v * v) * (-0.72134752044f);
    f32x2 e; e.x = __builtin_amdgcn_exp2f(s.x); e.y = __builtin_amdgcn_exp2f(s.y);
    const f32x2 m = v * (q * e), r = v - m;
    f32x2 o; o.x = v.x < 0.f ? m.x : r.x; o.y = v.y < 0.f ? m.y : r.y; return o;
}

template <int ACT  > struct EpiBf16 {
    static constexpr bool PERM = true, AFTER_DRAIN = false; static_assert(ACT == 0 || ACT == 1, "EpiBf16: ACT is 0 (none) or 1 (gelu_pk)");
    bf16_t* O; int ldc; const float* bias; int split_cols; size_t split_stride; float scale0;
    __device__ __forceinline__ void operator()(const f32x4 (&acc)[2][2][4][2], const Unit& u, int wr, int wc, int fr, int fq) const {
        { int ln_ = LANEID(); asm volatile("" : "+v"(ln_)); fr = ln_ & 15; fq = ln_ >> 4; }
        const int row0 = u.pm * BM + wr * 64 + fr; int colt = u.pn * BM; bf16_t* base = O;
        float sc = 1.f; if (split_cols) { const int t = colt / split_cols; base += (size_t)t * split_stride; colt -= t * split_cols; if (t == 0) sc = scale0; }
        const int col0 = colt + wc * 32 + 8 * fq, bcol0 = u.pn * BM + wc * 32 + 8 * fq;
        f32x4 bv[2][2];
#pragma unroll
        for (int bj = 0; bj < 2; ++bj)
#pragma unroll
            for (int n = 0; n < 2; ++n) bv[bj][n] = bias ? *(const f32x4*)(bias + bcol0 + bj * HALF + 4 * n) : (f32x4){0.f, 0.f, 0.f, 0.f};
#pragma unroll
        for (int ai = 0; ai < 2; ++ai)
#pragma unroll
            for (int m = 0; m < 4; ++m) { bf16_t* rowp = base + (size_t)(row0 + ai * HALF + m * 16) * ldc + col0;
#pragma unroll
                for (int bj = 0; bj < 2; ++bj) { f32x4 v0 = acc[ai][bj][m][0] + bv[bj][0], v1 = acc[ai][bj][m][1] + bv[bj][1];
                    if (ACT == 1) { f32x2 a = gelu_pk((f32x2){v0[0], v0[1]}), b = gelu_pk((f32x2){v0[2], v0[3]}), c = gelu_pk((f32x2){v1[0], v1[1]}), d = gelu_pk((f32x2){v1[2], v1[3]});
                        v0 = (f32x4){a.x, a.y, b.x, b.y}; v1 = (f32x4){c.x, c.y, d.x, d.y}; }
                    v0 = v0 * sc; v1 = v1 * sc; u32x4 w; w.x = cvt_pk_bf16(v0[0], v0[1]); w.y = cvt_pk_bf16(v0[2], v0[3]); w.z = cvt_pk_bf16(v1[0], v1[1]); w.w = cvt_pk_bf16(v1[2], v1[3]);
                    *(u32x4*)(rowp + bj * HALF) = w; } }
    }
};
template <class Epi, class Sched, bool ALIGN_EPI = false, bool SP2 = false>
__device__ __forceinline__ void gemm_phase(int WV_, PG8_LAS unsigned char* lds, const Gemm g, const Sched& S, const Epi& E) {
    const int tid = LTID(WV_), wid = __builtin_amdgcn_readfirstlane(tid >> 6), lane = tid & 63, wr = wid >> 2, wc = wid & 3, fr = lane & 15, fq = lane >> 4;
    const int K = g.K, nt = K / BK;
    unsigned voffA[2], voffB[2];
#pragma unroll
    for (int i = 0; i < 2; ++i) { int R, C; stage_rc(tid * 16 + i * 8192, R, C); const int Rb = Epi::PERM ? ((R & ~31) + perm32(R & 31)) : R;
        voffA[i] = (unsigned)(R * K + C) * 2u; voffB[i] = (unsigned)(Rb * K + C) * 2u; }
    const size_t kstep = (size_t)(BK * 2);
    const size_t hstep = (size_t)HALF * K * 2;
    const size_t tstep = 2 * hstep;
    const unsigned ldsw = (unsigned)wid * 1024u;
    const int aoff = lds_byte(wr * 64 + fr, fq * 8), boff = lds_byte(wc * 32 + fr, fq * 8);
#define PG8_SA(b, h) (((b) * 2 + (h)) * HTB)
#define PG8_SB(b, h) ((4 + (b) * 2 + (h)) * HTB)
#define PG8_STAGE(bufoff, gbase, voff) do { _Pragma("unroll") for (int _i = 0; _i < 2; ++_i) \
        __builtin_amdgcn_global_load_lds((const unsigned*)((const char*)(gbase) + (voff)[_i]), (PG8_LAS unsigned*)(lds + (bufoff) + ldsw + _i * 8192), 16, 0, 0); } while (0)
#define PG8_LDA(dst, b, h) do { _Pragma("unroll") for (int m = 0; m < 4; ++m) _Pragma("unroll") for (int k = 0; k < 2; ++k) dst[m][k] = *(const PG8_LAS bf16x8*)(lds + PG8_SA(b, h) + aoff + m * 2048 + k * 1024); } while (0)
#define PG8_LDB(dst, b, h) do { _Pragma("unroll") for (int n = 0; n < 2; ++n) _Pragma("unroll") for (int k = 0; k < 2; ++k) dst[n][k] = *(const PG8_LAS bf16x8*)(lds + PG8_SB(b, h) + boff + n * 2048 + k * 1024); } while (0)
#define PG8_MMA(ai, bj, At, Bt) do { __builtin_amdgcn_s_setprio(1); _Pragma("unroll") for (int m = 0; m < 4; ++m) _Pragma("unroll") for (int n = 0; n < 2; ++n) _Pragma("unroll") for (int k = 0; k < 2; ++k) \
        acc[ai][bj][m][n] = __builtin_amdgcn_mfma_f32_16x16x32_bf16(Bt[n][k], At[m][k], acc[ai][bj][m][n], 0, 0, 0); __builtin_amdgcn_s_setprio(0); } while (0)
#define PG8_WAIT_V(n) asm volatile("s_waitcnt vmcnt(" #n ")" ::: "memory")
#define PG8_WAIT_L(n) asm volatile("s_waitcnt lgkmcnt(" #n ")" ::: "memory")
#define PG8_BAR __builtin_amdgcn_s_barrier()
#define PG8_SCHED __builtin_amdgcn_sched_barrier(0)
    Unit cur, nxt; int ui = 0;
    if (!S.next(0, cur)) return;
    f32x4 acc[2][2][4][2];
#pragma unroll
    for (int a = 0; a < 2; ++a)
#pragma unroll
        for (int b = 0; b < 2; ++b)
#pragma unroll
            for (int m = 0; m < 4; ++m)
#pragma unroll
                for (int n = 0; n < 2; ++n) acc[a][b][m][n] = (f32x4){0.f, 0.f, 0.f, 0.f};
    bf16x8 At[4][2], B0[2][2], B1[2][2];
    const char* cA = (const char*)g.A + (size_t)cur.pm * tstep; const char* cB = (const char*)g.Bt + (size_t)cur.pn * tstep;
    S.a_ready(cur);
    if constexpr (SP2) {
        PG8_STAGE(PG8_SB(0, 0), cB, voffB); PG8_STAGE(PG8_SB(0, 1), cB + hstep, voffB); PG8_STAGE(PG8_SA(0, 0), cA, voffA); PG8_STAGE(PG8_SA(0, 1), cA + hstep, voffA);
        if (wr == 1) PG8_BAR;
        PG8_WAIT_V(2); PG8_BAR;
        PG8_STAGE(PG8_SB(1, 0), cB + kstep, voffB); PG8_STAGE(PG8_SA(1, 0), cA + kstep, voffA); PG8_STAGE(PG8_SB(1, 1), cB + hstep + kstep, voffB);
        PG8_WAIT_V(6); PG8_BAR;
    } else {
        PG8_STAGE(PG8_SB(0, 0), cB, voffB); PG8_STAGE(PG8_SA(0, 0), cA, voffA); PG8_STAGE(PG8_SB(0, 1), cB + hstep, voffB); PG8_STAGE(PG8_SA(0, 1), cA + hstep, voffA);
        if (wr == 1) PG8_BAR;
        PG8_WAIT_V(4); PG8_BAR;
        PG8_STAGE(PG8_SB(1, 0), cB + kstep, voffB); PG8_STAGE(PG8_SA(1, 0), cA + kstep, voffA); PG8_STAGE(PG8_SB(1, 1), cB + hstep + kstep, voffB);
        PG8_WAIT_V(6); PG8_BAR;
    }
    for (;;) {
        const bool has_next = S.next(ui + 1, nxt);
        const char* nA = has_next ? (const char*)g.A + (size_t)nxt.pm * tstep : cA; const char* nB = has_next ? (const char*)g.Bt + (size_t)nxt.pn * tstep : cB;
        for (int t = 0; t < nt; t += 2) {
            const bool last = (t == nt - 2);
            const char* a1 = cA + (size_t)(t + 1) * kstep;
            const char* a2 = last ? nA : cA + (size_t)(t + 2) * kstep; const char* b2 = last ? nB : cB + (size_t)(t + 2) * kstep;
            const char* a3 = a2 + kstep; const char* b3 = b2 + kstep;
            if (last && has_next) S.a_ready(nxt);
            if constexpr (SP2) {
            PG8_LDB(B0, 0, 0); PG8_LDB(B1, 0, 1); PG8_SCHED; PG8_LDA(At, 0, 0); PG8_STAGE(PG8_SA(1, 1), a1 + hstep, voffA);
            PG8_WAIT_V(8); PG8_WAIT_L(0); PG8_BAR; PG8_MMA(0, 0, At, B0); PG8_MMA(0, 1, At, B1); PG8_BAR; PG8_SCHED;
            PG8_LDA(At, 0, 1); PG8_STAGE(PG8_SB(0, 0), b2, voffB); PG8_STAGE(PG8_SB(0, 1), b2 + hstep, voffB); PG8_STAGE(PG8_SA(0, 0), a2, voffA);
            PG8_WAIT_V(8); PG8_WAIT_L(0); PG8_BAR; PG8_MMA(1, 0, At, B0); PG8_MMA(1, 1, At, B1); PG8_BAR; PG8_SCHED;
            PG8_LDB(B0, 1, 0); PG8_LDB(B1, 1, 1); PG8_SCHED; PG8_LDA(At, 1, 0); PG8_STAGE(PG8_SA(0, 1), a2 + hstep, voffA);
            PG8_WAIT_V(8); PG8_WAIT_L(0); PG8_BAR; PG8_MMA(0, 0, At, B0); PG8_MMA(0, 1, At, B1); PG8_BAR; PG8_SCHED;
            PG8_LDA(At, 1, 1); PG8_STAGE(PG8_SB(1, 0), b3, voffB); PG8_STAGE(PG8_SB(1, 1), b3 + hstep, voffB); PG8_STAGE(PG8_SA(1, 0), a3, voffA);
            PG8_WAIT_V(8); PG8_WAIT_L(0); PG8_BAR; PG8_MMA(1, 0, At, B0); PG8_MMA(1, 1, At, B1); PG8_BAR; PG8_SCHED;
            } else {
            PG8_LDB(B0, 0, 0); PG8_SCHED; PG8_LDA(At, 0, 0); PG8_STAGE(PG8_SA(1, 1), a1 + hstep, voffA);
            PG8_WAIT_L(8); PG8_BAR; PG8_WAIT_L(0); PG8_MMA(0, 0, At, B0); PG8_BAR; PG8_SCHED;
            PG8_LDB(B1, 0, 1); PG8_STAGE(PG8_SB(0, 0), b2, voffB);
            PG8_BAR; PG8_WAIT_L(0); PG8_MMA(0, 1, At, B1); PG8_BAR;
            PG8_LDA(At, 0, 1); PG8_STAGE(PG8_SA(0, 0), a2, voffA);
            PG8_BAR; PG8_WAIT_L(0); PG8_MMA(1, 0, At, B0); PG8_BAR; PG8_SCHED;
            PG8_STAGE(PG8_SB(0, 1), b2 + hstep, voffB);
            PG8_WAIT_V(6); PG8_BAR; PG8_MMA(1, 1, At, B1); PG8_BAR;
            PG8_LDB(B0, 1, 0); PG8_SCHED; PG8_LDA(At, 1, 0); PG8_STAGE(PG8_SA(0, 1), a2 + hstep, voffA);
            PG8_WAIT_L(8); PG8_BAR; PG8_WAIT_L(0); PG8_MMA(0, 0, At, B0); PG8_BAR; PG8_SCHED;
            PG8_LDB(B1, 1, 1); PG8_STAGE(PG8_SB(1, 0), b3, voffB);
            PG8_BAR; PG8_WAIT_L(0); PG8_MMA(0, 1, At, B1); PG8_BAR;
            PG8_LDA(At, 1, 1); PG8_STAGE(PG8_SA(1, 0), a3, voffA);
            PG8_BAR; PG8_WAIT_L(0); PG8_MMA(1, 0, At, B0); PG8_BAR; PG8_SCHED;
            PG8_STAGE(PG8_SB(1, 1), b3 + hstep, voffB);
            PG8_WAIT_V(6); PG8_BAR; PG8_MMA(1, 1, At, B1); PG8_BAR;
            }
        }
        if constexpr (ALIGN_EPI) { if (wr == 0) PG8_BAR; }
        if constexpr (!Epi::AFTER_DRAIN) { E(acc, cur, wr, wc, fr, fq); S.done(cur); }
        if (!has_next) break;
#pragma unroll
        for (int a = 0; a < 2; ++a)
#pragma unroll
            for (int b = 0; b < 2; ++b)
#pragma unroll
                for (int m = 0; m < 4; ++m)
#pragma unroll
                    for (int n = 0; n < 2; ++n) acc[a][b][m][n] = (f32x4){0.f, 0.f, 0.f, 0.f};
        cur = nxt; cA = nA; cB = nB; ++ui;
        if constexpr (ALIGN_EPI) { if (wr == 1) PG8_BAR; }
    }
    PG8_WAIT_V(0);
    if constexpr (!ALIGN_EPI) { if (wr == 0) PG8_BAR; }
    PG8_BAR;
    if constexpr (Epi::AFTER_DRAIN) { E.fused(acc, cur, wr, wc, fr, fq, lds, wid, lane); S.done(cur); }
#undef PG8_SA
#undef PG8_SB
#undef PG8_STAGE
#undef PG8_LDA
#undef PG8_LDB
#undef PG8_MMA
#undef PG8_WAIT_V
#undef PG8_WAIT_L
#undef PG8_BAR
#undef PG8_SCHED
}
}
namespace pg8 {
struct EpiF32 {
    static constexpr bool PERM = false, AFTER_DRAIN = false;
    float* O; int ldc;
    __device__ __forceinline__ void operator()(const f32x4 (&acc)[2][2][4][2], const Unit& u, int wr, int wc, int fr, int fq) const {
        { int ln_ = LANEID(); asm volatile("" : "+v"(ln_)); fr = ln_ & 15; fq = ln_ >> 4; }
        const int row0 = u.pm * BM + wr * 64 + fr, col0 = u.pn * BM + wc * 32 + 4 * fq;
#pragma unroll
        for (int ai = 0; ai < 2; ++ai)
#pragma unroll
            for (int m = 0; m < 4; ++m) { float* rowp = O + (size_t)(row0 + ai * HALF + m * 16) * ldc + col0;
#pragma unroll
                for (int bj = 0; bj < 2; ++bj)
#pragma unroll
                    for (int n = 0; n < 2; ++n) *(f32x4*)(rowp + bj * HALF + n * 16) = acc[ai][bj][m][n]; }
    }
};
struct EpiResY {
    static constexpr bool PERM = false, AFTER_DRAIN = false;
    const float* hin; const bf16_t* hinb; bf16_t* yb; float* stats; float alpha;
    __device__ __forceinline__ void operator()(const f32x4 (&acc)[2][2][4][2], const Unit& u, int wr, int wc, int fr, int fq) const {
        { int ln_ = LANEID(); asm volatile("" : "+v"(ln_)); fr = ln_ & 15; fq = ln_ >> 4; }
        const int row0 = u.pm * BM + wr * 64 + fr, col0 = u.pn * BM + wc * 32 + 4 * fq;
#pragma unroll
        for (int ai = 0; ai < 2; ++ai)
#pragma unroll
            for (int m = 0; m < 4; ++m) {
                const int row = row0 + ai * HALF + m * 16;
                float s = 0.f, s2 = 0.f;
#pragma unroll
                for (int bj = 0; bj < 2; ++bj)
#pragma unroll
                    for (int n = 0; n < 2; ++n) {
                        const size_t off = (size_t)row * 1024 + col0 + bj * HALF + n * 16;
                        f32x4 hv;
                        if (hin) hv = *(const f32x4*)(hin + off);
                        else { typedef unsigned u32x2r __attribute__((ext_vector_type(2))); const u32x2r hw = *(const u32x2r*)(hinb + off);
                            hv[0] = __uint_as_float(hw.x << 16); hv[1] = __uint_as_float(hw.x & 0xffff0000u); hv[2] = __uint_as_float(hw.y << 16); hv[3] = __uint_as_float(hw.y & 0xffff0000u); }
                        const f32x4 y = hv * alpha + acc[ai][bj][m][n];
                        typedef unsigned u32x2v __attribute__((ext_vector_type(2)));
                        u32x2v w; w.x = cvt_pk_bf16(y[0], y[1]); w.y = cvt_pk_bf16(y[2], y[3]);
                        *(u32x2v*)(yb + off) = w;
                        s += (y[0] + y[1]) + (y[2] + y[3]); s2 += (y[0] * y[0] + y[1] * y[1]) + (y[2] * y[2] + y[3] * y[3]);
                    }
                s += __shfl_xor(s, 16); s += __shfl_xor(s, 32); s2 += __shfl_xor(s2, 16); s2 += __shfl_xor(s2, 32);
                if (fq == 0) { atomicAdd(stats + 2 * (size_t)row, s); atomicAdd(stats + 2 * (size_t)row + 1, s2); }
            }
    }
};
struct EpiLnFold {
    static constexpr bool PERM = true, AFTER_DRAIN = false;
    bf16_t* O; const float* stats; const float* colsum; const float* colbias; float eps;
    __device__ __forceinline__ void operator()(const f32x4 (&acc)[2][2][4][2], const Unit& u, int wr, int wc, int fr, int fq) const {
        { int ln_ = LANEID(); asm volatile("" : "+v"(ln_)); fr = ln_ & 15; fq = ln_ >> 4; }
        const int row0 = u.pm * BM + wr * 64 + fr, col0 = u.pn * BM + wc * 32 + 8 * fq;
        f32x4 cs[2][2], cb[2][2];
#pragma unroll
        for (int bj = 0; bj < 2; ++bj)
#pragma unroll
            for (int n = 0; n < 2; ++n) { cs[bj][n] = *(const f32x4*)(colsum + col0 + bj * HALF + 4 * n); cb[bj][n] = *(const f32x4*)(colbias + col0 + bj * HALF + 4 * n); }
#pragma unroll
        for (int ai = 0; ai < 2; ++ai)
#pragma unroll
            for (int m = 0; m < 4; ++m) {
                const int row = row0 + ai * HALF + m * 16;
                const float sm_ = stats[2 * (size_t)row], sq_ = stats[2 * (size_t)row + 1];
                const float mean = sm_ * (1.0f / 1024.0f);
                const float rstd = 1.0f / sqrtf(fmaxf(sq_ * (1.0f / 1024.0f) - mean * mean, 0.f) + eps);
                bf16_t* rowp = O + (size_t)row * 1024 + col0;
#pragma unroll
                for (int bj = 0; bj < 2; ++bj) {
                    const f32x4 v0 = (acc[ai][bj][m][0] - cs[bj][0] * mean) * rstd + cb[bj][0], v1 = (acc[ai][bj][m][1] - cs[bj][1] * mean) * rstd + cb[bj][1];
                    u32x4 w; w.x = cvt_pk_bf16(v0[0], v0[1]); w.y = cvt_pk_bf16(v0[2], v0[3]); w.z = cvt_pk_bf16(v1[0], v1[1]); w.w = cvt_pk_bf16(v1[2], v1[3]);
                    *(u32x4*)(rowp + bj * HALF) = w;
                }
            }
    }
};
__device__ __forceinline__ unsigned cvt_pk_bf16_t(float lo, float hi) { unsigned r; asm volatile("s_nop 0\n\tv_cvt_pk_bf16_f32 %0, %1, %2" : "=v"(r) : "v"(lo), "v"(hi)); return r; }
struct EpiBf16Sig {
    static constexpr bool PERM = true, AFTER_DRAIN = false;
    bf16_t* O; int ldc; int sig_col0; unsigned char* G8;
    __device__ __forceinline__ void operator()(const f32x4 (&acc)[2][2][4][2], const Unit& u, int wr, int wc, int fr, int fq) const {
        { int ln_ = LANEID(); asm volatile("" : "+v"(ln_)); fr = ln_ & 15; fq = ln_ >> 4; }
        const int row0 = u.pm * BM + wr * 64 + fr; const int col0 = u.pn * BM + wc * 32 + 8 * fq;
#pragma unroll
        for (int bj = 0; bj < 2; ++bj) {
            if (col0 + bj * HALF >= sig_col0) {
                { const int gc = col0 + bj * HALF - sig_col0;
                  if (gc < 4096) {
#pragma unroll
                    for (int ai = 0; ai < 2; ++ai)
#pragma unroll
                        for (int m = 0; m < 4; ++m) {
                            f32x4 v0 = acc[ai][bj][m][0], v1 = acc[ai][bj][m][1];
#pragma unroll
                            for (int e = 0; e < 4; ++e) { v0[e] = __builtin_amdgcn_rcpf(1.f + __builtin_amdgcn_exp2f(-1.44269504f * v0[e])); v1[e] = __builtin_amdgcn_rcpf(1.f + __builtin_amdgcn_exp2f(-1.44269504f * v1[e])); }
                            int w0 = __builtin_amdgcn_cvt_pk_fp8_f32(v0[0], v0[1], 0, false); w0 = __builtin_amdgcn_cvt_pk_fp8_f32(v0[2], v0[3], w0, true);
                            int w1 = __builtin_amdgcn_cvt_pk_fp8_f32(v1[0], v1[1], 0, false); w1 = __builtin_amdgcn_cvt_pk_fp8_f32(v1[2], v1[3], w1, true);
                            typedef int i32x2v __attribute__((ext_vector_type(2)));
                            i32x2v w; w.x = w0; w.y = w1;
                            *(i32x2v*)(G8 + (size_t)(row0 + ai * HALF + m * 16) * 4096 + gc) = w; }
                  } }
            } else {
#pragma unroll
                for (int ai = 0; ai < 2; ++ai)
#pragma unroll
                    for (int m = 0; m < 4; ++m) { bf16_t* rowp = O + (size_t)(row0 + ai * HALF + m * 16) * ldc + col0;
                        const f32x4 v0 = acc[ai][bj][m][0], v1 = acc[ai][bj][m][1];
                        u32x4 w; w.x = cvt_pk_bf16(v0[0], v0[1]); w.y = cvt_pk_bf16(v0[2], v0[3]); w.z = cvt_pk_bf16(v1[0], v1[1]); w.w = cvt_pk_bf16(v1[2], v1[3]);
                        *(u32x4*)(rowp + bj * HALF) = w; }
            }
        }
    }
};
}

typedef unsigned short bf16;
constexpr int T_ = 16384, S_ = 4096, NBATCH = 4, D_ = 1024, NCOL = 6824, NP = 6912, DEPTH_ = 2;
constexpr int C_QA = 0, C_KA = 256, C_VA = 320, C_QI = 384, C_KI = 640, C_WI = 672, C_QB = 680, C_KB = 936, C_VB = 1064,
              C_QC = 1192, C_KC = 1448, C_VC = 1704, C_QD = 1960, C_KD = 2216, C_VD = 2472, C_G = 2728;
constexpr int NTHR = 512, NWAVE = 8;
constexpr float ALPHA = 1.41421356237309515f;
constexpr float LN_EPS = 1e-5f;
constexpr size_t MiB = 1u << 20;
constexpr size_t WS_STATS = 1 * MiB  , WS_COLS = 1 * MiB + 512 * 1024  ;
constexpr size_t WS_CTL = 0, WS_WIN_T = 2 * MiB, WS_WOUT_T = 30 * MiB, WS_WQ_T = 34 * MiB, WS_WBR_T = 38 * MiB, WS_HB = 42 * MiB,
                 WS_P = 74 * MiB, WS_MIX = 74 * MiB  , WS_Q = 138 * MiB  , WS_G8 = 428 * MiB  , WS_YS = 290 * MiB, WS_MRG = 322 * MiB,
                 WS_MASK = 354 * MiB, WS_EID = 362 * MiB, WS_GATE = 370 * MiB, WS_KMEAN = 378 * MiB, WS_SKB = 379 * MiB, WS_UV = 380 * MiB, WS_END = 508 * MiB;
constexpr size_t WIN_T_BYTES = (size_t)NP * 1024 * 2;
constexpr int LDS_BYTES = 144 * 1024;

struct Params { const float* in[13]; float* out; unsigned char* ws; };

__device__ __forceinline__ float bf2f(bf16 v) { return __uint_as_float((unsigned)v << 16); }
__device__ __forceinline__ unsigned f2bf(float f) { unsigned u = __float_as_uint(f); return (u + 0x7fffu + ((u >> 16) & 1u)) >> 16; }
__device__ __forceinline__ unsigned pk2(float lo, float hi) { return f2bf(lo) | (f2bf(hi) << 16); }
__device__ __forceinline__ void unpack8(const uint4 v, float* o) {
    o[0] = __uint_as_float(v.x << 16); o[1] = __uint_as_float(v.x & 0xffff0000u); o[2] = __uint_as_float(v.y << 16); o[3] = __uint_as_float(v.y & 0xffff0000u);
    o[4] = __uint_as_float(v.z << 16); o[5] = __uint_as_float(v.z & 0xffff0000u); o[6] = __uint_as_float(v.w << 16); o[7] = __uint_as_float(v.w & 0xffff0000u);
}
__device__ __forceinline__ float wave_sum(float v) {
#pragma unroll
    for (int o = 32; o > 0; o >>= 1) v += __shfl_xor(v, o);
    return v;
}
__device__ __forceinline__ float wave_max(float v) {
#pragma unroll
    for (int o = 32; o > 0; o >>= 1) v = fmaxf(v, __shfl_xor(v, o));
    return v;
}
__device__ __forceinline__ int wave_sum_i(int v) {
#pragma unroll
    for (int o = 32; o > 0; o >>= 1) v += __shfl_xor(v, o);
    return v;
}
__device__ __forceinline__ float logsig(float x) { return fminf(x, 0.f) - log1pf(expf(-fabsf(x))); }

__device__ void transpose_items(int WV_, const float* W, int K, int N, bf16* WT, float* sm, int item0, int nitems_total, int item_stride,
                                const float* rs_g = nullptr, const float* rs_b = nullptr, float* colsum = nullptr, float* colbias = nullptr) {
    const int tid = LTID(WV_);
    const int nkb = K / 64, nnb = (N + 63) / 64;
    for (int it = item0; it < nkb * nnb; it += item_stride) {
        const int kb = it % nkb, nb = it / nkb, k0 = kb * 64, n0 = nb * 64;
        __syncthreads();
        for (int e = tid; e < 64 * 64; e += NTHR) { const int kk = e >> 6, nn = e & 63; sm[kk * 65 + nn] = (n0 + nn < N) ? W[(size_t)(k0 + kk) * N + n0 + nn] : 0.f; }
        __syncthreads();
        if (rs_g) {
            if (tid < 64) { float cs = 0.f, cb = 0.f;
                for (int kk = 0; kk < 64; ++kk) { const float w = sm[kk * 65 + tid]; cs += w * rs_g[k0 + kk]; cb += w * rs_b[k0 + kk]; }
                atomicAdd(colsum + n0 + tid, cs); atomicAdd(colbias + n0 + tid, cb); }
            __syncthreads();
            for (int e = tid; e < 64 * 64; e += NTHR) { const int kk = e >> 6, nn = e & 63; sm[kk * 65 + nn] *= rs_g[k0 + kk]; }
            __syncthreads();
        }
        { const int nn = tid >> 3, c = tid & 7;
          if (n0 + nn < N) { uint4 o; o.x = pk2(sm[(8 * c + 0) * 65 + nn], sm[(8 * c + 1) * 65 + nn]); o.y = pk2(sm[(8 * c + 2) * 65 + nn], sm[(8 * c + 3) * 65 + nn]);
              o.z = pk2(sm[(8 * c + 4) * 65 + nn], sm[(8 * c + 5) * 65 + nn]); o.w = pk2(sm[(8 * c + 6) * 65 + nn], sm[(8 * c + 7) * 65 + nn]);
              *(uint4*)(WT + (size_t)(n0 + nn) * K + k0 + 8 * c) = o; } }
    }
    __syncthreads();
}
constexpr int TI_WIN = 16 * ((NCOL + 63) / 64), TI_SQ = 256, TI_LAYER = TI_WIN + 3 * TI_SQ;
#define TITEM_DECODE(it_, W_, WT_, K_, N_, k0_, n0_, fold_, l_) do { \
        l_ = (it_) / TI_LAYER; const int r_ = (it_) - l_ * TI_LAYER; \
        const int kind_ = r_ < TI_WIN ? 0 : (r_ < TI_WIN + TI_SQ ? 1 : (r_ < TI_WIN + 2 * TI_SQ ? 2 : 3)); \
        const int q_ = r_ - (kind_ == 0 ? 0 : TI_WIN + (kind_ - 1) * TI_SQ); \
        fold_ = kind_ == 2; K_ = kind_ == 3 ? 256 : 1024; N_ = kind_ == 0 ? NCOL : 1024; \
        k0_ = kind_ == 3 ? (q_ & 3) * 64 : (q_ & 15) * 64; n0_ = kind_ == 3 ? ((q_ & 63) >> 2) * 64 : (q_ >> 4) * 64; \
        const int nbr_ = q_ >> 6; \
        W_ = kind_ == 0 ? pin1 + (size_t)l_ * 1024 * NCOL : kind_ == 1 ? pin3 + (size_t)l_ * 1024 * 1024 : kind_ == 2 ? pin7 + (size_t)l_ * 1024 * 1024 : pin2 + ((size_t)l_ * 4 + nbr_) * 256 * 1024; \
        WT_ = kind_ == 0 ? (bf16*)(ws + WS_WIN_T + l_ * WIN_T_BYTES) : kind_ == 1 ? (bf16*)(ws + WS_WOUT_T) + (size_t)l_ * 1024 * 1024 : kind_ == 2 ? (bf16*)(ws + WS_WQ_T) + (size_t)l_ * 1024 * 1024 \
              : (bf16*)(ws + WS_WBR_T) + ((size_t)l_ * 4 + nbr_) * 1024 * 256; } while (0)
__device__ __forceinline__ void titem_finish(bf16* WT, int K, int N, int k0, int n0, const float* rs_g, const float* rs_b, float* colsum, float* colbias, float* sm, int tid) {
    if (rs_g) {
        if (tid < 64) { float cs = 0.f, cb = 0.f;
            for (int kk = 0; kk < 64; ++kk) { const float w = sm[kk * 65 + tid]; cs += w * rs_g[k0 + kk]; cb += w * rs_b[k0 + kk]; }
            atomicAdd(colsum + n0 + tid, cs); atomicAdd(colbias + n0 + tid, cb); }
        __syncthreads();
        for (int e = tid; e < 64 * 64; e += NTHR) { const int kk = e >> 6, nn = e & 63; sm[kk * 65 + nn] *= rs_g[k0 + kk]; }
        __syncthreads();
    }
    { const int nn = tid >> 3, c = tid & 7;
      if (n0 + nn < N) { uint4 o; o.x = pk2(sm[(8 * c + 0) * 65 + nn], sm[(8 * c + 1) * 65 + nn]); o.y = pk2(sm[(8 * c + 2) * 65 + nn], sm[(8 * c + 3) * 65 + nn]);
          o.z = pk2(sm[(8 * c + 4) * 65 + nn], sm[(8 * c + 5) * 65 + nn]); o.w = pk2(sm[(8 * c + 6) * 65 + nn], sm[(8 * c + 7) * 65 + nn]);
          *(uint4*)(WT + (size_t)(n0 + nn) * K + k0 + 8 * c) = o; } }
}
__device__ void prologue_phase(int WV_, const Params& p, float* sm) {
    const int tid = LTID(WV_), B = LBID(), G = LGRID();
    unsigned char* ws = p.ws;
    float* sm1 = sm + 64 * 65;
    const float* pin1 = p.in[1]; const float* pin2 = p.in[2]; const float* pin3 = p.in[3]; const float* pin7 = p.in[7]; const float* pin5 = p.in[5]; const float* pin6 = p.in[6];
    asm volatile("" : "+s"(pin1), "+s"(pin2), "+s"(pin3), "+s"(pin7), "+s"(pin5), "+s"(pin6));
    const int kk0 = tid >> 4, c4 = tid & 15;
    for (int it = B; it < DEPTH_ * TI_LAYER; it += 2 * G) {
        const int it2 = it + G; const bool has2 = it2 < DEPTH_ * TI_LAYER;
        const float* Wa; const float* Wb; bf16* WTa; bf16* WTb; int Ka, Na, k0a, n0a, la, Kb, Nb, k0b, n0b, lb; bool fa, fb;
        TITEM_DECODE(it, Wa, WTa, Ka, Na, k0a, n0a, fa, la);
        { const int itb = has2 ? it2 : it; TITEM_DECODE(itb, Wb, WTb, Kb, Nb, k0b, n0b, fb, lb); }
        const float4 z4 = make_float4(0.f, 0.f, 0.f, 0.f);
        const bool ina = n0a + 4 * c4 < Na, inb = n0b + 4 * c4 < Nb;
        float4 a0 = z4, a1 = z4, b0 = z4, b1 = z4;
        if (ina) { a0 = *(const float4*)(Wa + (size_t)(k0a + kk0) * Na + n0a + 4 * c4); a1 = *(const float4*)(Wa + (size_t)(k0a + kk0 + 32) * Na + n0a + 4 * c4); }
        if (inb) { b0 = *(const float4*)(Wb + (size_t)(k0b + kk0) * Nb + n0b + 4 * c4); b1 = *(const float4*)(Wb + (size_t)(k0b + kk0 + 32) * Nb + n0b + 4 * c4); }
        __syncthreads();
        { float* d = sm + kk0 * 65 + 4 * c4; d[0] = a0.x; d[1] = a0.y; d[2] = a0.z; d[3] = a0.w; d += 32 * 65; d[0] = a1.x; d[1] = a1.y; d[2] = a1.z; d[3] = a1.w; }
        { float* d = sm1 + kk0 * 65 + 4 * c4; d[0] = b0.x; d[1] = b0.y; d[2] = b0.z; d[3] = b0.w; d += 32 * 65; d[0] = b1.x; d[1] = b1.y; d[2] = b1.z; d[3] = b1.w; }
        __syncthreads();
        titem_finish(WTa, Ka, Na, k0a, n0a, fa ? pin5 + la * 1024 : nullptr, pin6 + la * 1024, (float*)(ws + WS_COLS) + la * 2048, (float*)(ws + WS_COLS) + la * 2048 + 1024, sm, tid);
        if (has2) titem_finish(WTb, Kb, Nb, k0b, n0b, fb ? pin5 + lb * 1024 : nullptr, pin6 + lb * 1024, (float*)(ws + WS_COLS) + lb * 2048, (float*)(ws + WS_COLS) + lb * 2048 + 1024, sm1, tid);
    }
    __syncthreads();
    for (int l = 0; l < DEPTH_; ++l) {
        bf16* win_t = (bf16*)(ws + WS_WIN_T + l * WIN_T_BYTES);
        for (int i = B * NTHR + tid; i < (NP - NCOL) * 1024 / 8; i += G * NTHR) ((uint4*)(win_t + (size_t)NCOL * 1024))[i] = make_uint4(0u, 0u, 0u, 0u);
    }
    const float4* x4 = (const float4*)p.in[0]; uint2* hb2 = (uint2*)(ws + WS_HB);
    for (size_t i = (size_t)B * NTHR + tid; i < (size_t)T_ * 1024 / 4; i += (size_t)G * NTHR) { const float4 v = x4[i]; hb2[i] = make_uint2(pk2(v.x, v.y), pk2(v.z, v.w)); }
}

__device__ __forceinline__ void ln_row(float4 (&v)[4], const float* g, const float* bb, float* orow, bf16* obrow, int lane) {
    float s = 0.f;
#pragma unroll
    for (int j = 0; j < 4; ++j) s += (v[j].x + v[j].y) + (v[j].z + v[j].w);
    const float mean = wave_sum(s) * (1.0f / 1024.0f);
    float s2 = 0.f;
#pragma unroll
    for (int j = 0; j < 4; ++j) { v[j].x -= mean; v[j].y -= mean; v[j].z -= mean; v[j].w -= mean; s2 += (v[j].x * v[j].x + v[j].y * v[j].y) + (v[j].z * v[j].z + v[j].w * v[j].w); }
    const float rstd = 1.0f / sqrtf(wave_sum(s2) * (1.0f / 1024.0f) + LN_EPS);
#pragma unroll
    for (int j = 0; j < 4; ++j) {
        const float4 gg = ((const float4*)g)[j * 64 + lane], b4 = ((const float4*)bb)[j * 64 + lane];
        float4 o; o.x = v[j].x * rstd * gg.x + b4.x; o.y = v[j].y * rstd * gg.y + b4.y; o.z = v[j].z * rstd * gg.z + b4.z; o.w = v[j].w * rstd * gg.w + b4.w;
        ((float4*)orow)[j * 64 + lane] = o;
        ((uint2*)obrow)[j * 64 + lane] = make_uint2(pk2(o.x, o.y), pk2(o.z, o.w));
    }
}
__device__ void ln1_phase(int WV_, const float* hin, const float* add, const float* g, const float* bb, float* hout, bf16* hb) {
    const int lane = LTID(WV_) & 63, wave = LTID(WV_) >> 6;
    for (int row = LBID() * NWAVE + wave; row < T_; row += LGRID() * NWAVE) {
        float4 v[4];
#pragma unroll
        for (int j = 0; j < 4; ++j) {
            const float4 a = ((const float4*)(hin + (size_t)row * 1024))[j * 64 + lane], m = ((const float4*)(add + (size_t)row * 1024))[j * 64 + lane];
            v[j].x = ALPHA * a.x + m.x; v[j].y = ALPHA * a.y + m.y; v[j].z = ALPHA * a.z + m.z; v[j].w = ALPHA * a.w + m.w;
        }
        ln_row(v, g, bb, hout + (size_t)row * 1024, hb + (size_t)row * 1024, lane);
    }
}


typedef short bf16x8_t __attribute__((ext_vector_type(8)));
typedef float f32x16_t __attribute__((ext_vector_type(16)));
typedef float f32x2_t __attribute__((ext_vector_type(2)));
typedef __bf16 bf16x2_t __attribute__((ext_vector_type(2)));
__device__ __forceinline__ unsigned cvtpk(float lo, float hi) { f32x2_t v = {lo, hi}; bf16x2_t b = __builtin_convertvector(v, bf16x2_t); return __builtin_bit_cast(unsigned, b); }
__device__ __forceinline__ int crow(int r, int hi) { return (r & 3) + 8 * (r >> 2) + 4 * hi; }
__device__ __forceinline__ float xlane32(float v) { return __shfl_xor(v, 32); }
__device__ __forceinline__ float vmax(float a, float b) { float r; asm("v_max_f32_e32 %0, %1, %2" : "=v"(r) : "v"(a), "v"(b)); return r; }
__device__ __forceinline__ float vmin(float a, float b) { float r; asm("v_min_f32_e32 %0, %1, %2" : "=v"(r) : "v"(a), "v"(b)); return r; }
__device__ __forceinline__ float vmax3(float a, float b, float c) { float r; asm("v_max3_f32 %0, %1, %2, %3" : "=v"(r) : "v"(a), "v"(b), "v"(c)); return r; }

constexpr int AT_KP = 72, AT_VP = 96;
constexpr int AT_KS = 0, AT_KS_BYTES = 64 * AT_KP * 2;
constexpr int AT_VT = 2 * AT_KS_BYTES, AT_VT_BYTES = 64 * AT_VP * 2;
constexpr int AT_KM = AT_VT + 2 * AT_VT_BYTES;
constexpr int AT_MISC = AT_KM + 32 * AT_KP * 2;
constexpr float LOG2E = 1.4426950408889634f;

__device__ __forceinline__ unsigned mk_unit(int kind, int b, int x, int y) { return ((unsigned)kind << 30) | ((unsigned)b << 28) | ((unsigned)x << 8) | (unsigned)y; }
__device__ void build_unit_table(unsigned* tab, int i) {
    int n = 0; unsigned res = 0u;
#pragma unroll 1
    for (int c = 64; c >= 1; --c) {
        if (i >= n && i < n + 4) res = mk_unit(0, i - n, 0, c - 1);
        n += 4;
        if ((c & 3) == 0) { if (i >= n && i < n + 16) { const int j = i - n; res = mk_unit(2, j >> 2, j & 3, c / 4 - 1); } n += 16; }
    }
    if (i < 512) tab[i] = res;
}

template <int kind> __device__ __forceinline__ void attn_unit(int WV_, const bf16* P, const unsigned char* mask, const float* kmean, const float* sinks, bf16* ys,
                                unsigned char* lds, int b, int ux, int uy) {
    int tid_ = LTID(WV_); asm volatile("" : "+v"(tid_));
    const int tid = tid_, lane = tid & 63, wave = __builtin_amdgcn_readfirstlane(tid >> 6), r32 = lane & 31, hi = lane >> 5;
    bf16* s_km = (bf16*)(lds + AT_KM);
    const int skey = tid >> 3, sc = tid & 7;
    {
        const bf16* Pb = P + (size_t)b * S_ * NP;
        int q0w, qcol, kcol, vcol, ycol, kt_hi, kt_lo; float slope2 = 0.f, sink2 = 0.f;
        if (kind == 0) { const int head = wave >> 1; q0w = uy * 64 + (wave & 1) * 32; qcol = C_QA + head * 64; kcol = C_KA; vcol = C_VA; ycol = head * 64;
            slope2 = exp2f(-8.0f * (float)(3 * head + 1) / 12.0f) * LOG2E; kt_hi = uy; kt_lo = 0; }
        else if (kind == 1) { const int hq = ux * 2 + (wave >> 2); q0w = uy * 128 + (wave & 3) * 32; qcol = C_QB + hq * 64; kcol = C_KB + ux * 64; vcol = C_VB + ux * 64; ycol = 256 + hq * 64;
            slope2 = exp2f(-8.0f * (float)(3 * hq + 2) / 12.0f) * LOG2E; sink2 = sinks[hq] * LOG2E; kt_hi = 2 * uy + 1; kt_lo = (2 * uy - 2 > 0) ? 2 * uy - 2 : 0; }
        else if (kind == 2) { q0w = uy * 256 + wave * 32; qcol = C_QC + ux * 64; kcol = C_KC + ux * 64; vcol = C_VC + ux * 64; ycol = 512 + ux * 64;
            slope2 = exp2f(-8.0f * (float)(3 * ux + 3) / 12.0f) * LOG2E; kt_hi = 4 * uy + 3; kt_lo = 0; }
        else { q0w = uy * 256 + wave * 32; qcol = C_QD + ux * 64; kcol = C_KD + ux * 64; vcol = C_VD + ux * 64; ycol = 768 + ux * 64; kt_hi = 4 * uy + 3; kt_lo = 0; }
        const int qpos = q0w + r32;
        bf16x8_t qf[4];
        { const bf16* qp = Pb + (size_t)qpos * NP + qcol + 8 * hi;
#pragma unroll
          for (int ks = 0; ks < 4; ++ks) qf[ks] = *(const bf16x8_t*)(qp + 16 * ks); }
        {
            const float qs = (kind == 3) ? 0.125f : 0.125f * LOG2E;
            typedef unsigned u32x4_t __attribute__((ext_vector_type(4)));
#pragma unroll
            for (int ks = 0; ks < 4; ++ks) { u32x4_t w = __builtin_bit_cast(u32x4_t, qf[ks]);
#pragma unroll
                for (int i = 0; i < 4; ++i) w[i] = cvtpk(__uint_as_float(w[i] << 16) * qs, __uint_as_float(w[i] & 0xffff0000u) * qs);
                qf[ks] = __builtin_bit_cast(bf16x8_t, w); }
        }
        float sb[16];
#pragma unroll
        for (int r = 0; r < 16; ++r) sb[r] = slope2 * (float)((r & 3) + 8 * (r >> 2));
        unsigned bm = 0u;
        if (kind == 2) {
            const int own = uy;
            for (int e = tid; e < 32 * 64; e += NTHR) { const int row = e >> 6, d = e & 63; s_km[row * AT_KP + d] = (row < 16) ? (bf16)f2bf(kmean[((b * 4 + ux) * 16 + row) * 64 + d]) : (bf16)0; }
            __syncthreads();
            f32x16_t gacc;
#pragma unroll
            for (int r = 0; r < 16; ++r) gacc[r] = 0.f;
#pragma unroll
            for (int ks = 0; ks < 4; ++ks) { const bf16x8_t a = *(const bf16x8_t*)(s_km + r32 * AT_KP + 16 * ks + 8 * hi); gacc = __builtin_amdgcn_mfma_f32_32x32x16_bf16(a, qf[ks], gacc, 0, 0, 0); }
            float gt[16];
#pragma unroll
            for (int r = 0; r < 8; ++r) { const float mine = gacc[r], other = xlane32(mine); const int bi = crow(r, 0);
                gt[bi] = hi ? other : mine; gt[bi + 4] = hi ? mine : other; }
#pragma unroll
            for (int n = 0; n < 16; ++n) if (n >= own) gt[n] = -INFINITY;
#pragma unroll
            for (int rep = 0; rep < 3; ++rep) {
                float mx = -INFINITY;
#pragma unroll
                for (int n = 0; n < 16; ++n) mx = fmaxf(mx, gt[n]);
                bool done = !(mx > -INFINITY);
#pragma unroll
                for (int n = 0; n < 16; ++n) { const bool hit = !done && gt[n] == mx; if (hit) { bm |= 1u << n; gt[n] = -INFINITY; done = true; } }
            }
        }
        f32x16_t o0, o1;
#pragma unroll
        for (int r = 0; r < 16; ++r) { o0[r] = 0.f; o1[r] = 0.f; }
        float m_run = -INFINITY, l_run = 0.f, carry = 0.f;
        const bf16* kg = Pb + (size_t)skey * NP + kcol + sc * 8;
        const bf16* vg = Pb + (size_t)skey * NP + vcol + sc * 8;
        uint4 rk = *(const uint4*)(kg + (size_t)kt_hi * 64 * NP), rv = *(const uint4*)(vg + (size_t)kt_hi * 64 * NP);
        int buf = 0;
        { bf16* ks_ = (bf16*)(lds + AT_KS); bf16* vt_ = (bf16*)(lds + AT_VT);
          *(uint4*)(ks_ + skey * AT_KP + sc * 8) = rk;
          *(uint4*)(vt_ + skey * AT_VP + sc * 8) = rv; }
        __syncthreads();
        bool wave_done = false;
        uint2 mw_next = make_uint2(0u, 0u);
        if (kind == 0) mw_next = *(const uint2*)(mask + (size_t)(b * S_ + qpos) * 512 + kt_hi * 8);
        for (int kt = kt_hi; kt >= kt_lo; --kt) {
            const bool more = kt > kt_lo;
            const uint2 mw = mw_next;
            if (kind == 0 && more) mw_next = *(const uint2*)(mask + (size_t)(b * S_ + qpos) * 512 + (kt - 1) * 8);
            if (more) { rk = *(const uint4*)(kg + (size_t)(kt - 1) * 64 * NP); rv = *(const uint4*)(vg + (size_t)(kt - 1) * 64 * NP); }
            const bf16* ks_ = (const bf16*)(lds + AT_KS + buf * AT_KS_BYTES);
            const bf16* vt_ = (const bf16*)(lds + AT_VT + buf * AT_VT_BYTES);
            bool active = (kt * 64 <= q0w + 31) && !wave_done;
            if (kind == 1) active = active && (kt * 64 + 63 >= q0w - 127);
            if (active) {
                const int kbase = kt * 64 + 4 * hi;
                f32x16_t p0, p1;
                if (kind != 3) {
                    const float cb = slope2 * (float)(kbase - qpos), cb1 = cb + 32.0f * slope2;
#pragma unroll
                    for (int r = 0; r < 16; ++r) { p0[r] = cb + sb[r]; p1[r] = cb1 + sb[r]; }
                } else {
#pragma unroll
                    for (int r = 0; r < 16; ++r) { p0[r] = 0.f; p1[r] = 0.f; }
                }
#pragma unroll
                for (int ks = 0; ks < 4; ++ks) {
                    const bf16x8_t a0 = *(const bf16x8_t*)(ks_ + r32 * AT_KP + 16 * ks + 8 * hi);
                    const bf16x8_t a1 = *(const bf16x8_t*)(ks_ + (32 + r32) * AT_KP + 16 * ks + 8 * hi);
                    p0 = __builtin_amdgcn_mfma_f32_32x32x16_bf16(a0, qf[ks], p0, 0, 0, 0);
                    p1 = __builtin_amdgcn_mfma_f32_32x32x16_bf16(a1, qf[ks], p1, 0, 0, 0);
                }
                if (kind != 3) {
                    float mx = -INFINITY;
                    if (kind == 0) {
                        const unsigned w0 = mw.x >> (4 * hi), w1 = mw.y >> (4 * hi);
#pragma unroll
                        for (int r = 0; r < 16; ++r) { const int off = (r & 3) + 8 * (r >> 2);
                            p0[r] = (w0 & (1u << off)) ? p0[r] : -INFINITY; p1[r] = (w1 & (1u << off)) ? p1[r] : -INFINITY; mx = vmax3(mx, p0[r], p1[r]); }
                    } else if (kind == 1) {
                        const int rel = qpos - kbase;
#pragma unroll
                        for (int r = 0; r < 16; ++r) { const int off = (r & 3) + 8 * (r >> 2);
                            p0[r] = ((unsigned)(rel - off) < 128u) ? p0[r] : -INFINITY; p1[r] = ((unsigned)(rel - off - 32) < 128u) ? p1[r] : -INFINITY; mx = vmax3(mx, p0[r], p1[r]); }
                    } else {
                        if ((kt >> 2) == uy) {
                            const int rel = qpos - kbase;
#pragma unroll
                            for (int r = 0; r < 16; ++r) { const int off = (r & 3) + 8 * (r >> 2);
                                p0[r] = (off <= rel) ? p0[r] : -INFINITY; p1[r] = (off + 32 <= rel) ? p1[r] : -INFINITY; mx = vmax3(mx, p0[r], p1[r]); }
                        } else {
                            const bool tile_ok = ((bm >> (kt >> 2)) & 1u) != 0u;
#pragma unroll
                            for (int r = 0; r < 16; ++r) { p0[r] = tile_ok ? p0[r] : -INFINITY; p1[r] = tile_ok ? p1[r] : -INFINITY; mx = vmax3(mx, p0[r], p1[r]); }
                        }
                    }
                    mx = vmax(mx, xlane32(mx));
                    const float m_new = vmax(m_run, mx);
                    const float m_safe = (m_new == -INFINITY) ? 0.f : m_new;
                    p0 = p0 - m_safe; p1 = p1 - m_safe;
#pragma unroll
                    for (int r = 0; r < 16; ++r) { p0[r] = __builtin_amdgcn_exp2f(p0[r]); p1[r] = __builtin_amdgcn_exp2f(p1[r]); }
                    float ls;
                    { typedef float f32x8_t __attribute__((ext_vector_type(8))); typedef float f32x4v_t __attribute__((ext_vector_type(4)));
                      const f32x16_t t16 = p0 + p1; const f32x8_t t8 = t16.lo + t16.hi; const f32x4v_t t4 = t8.lo + t8.hi; const f32x2_t t2 = t4.lo + t4.hi; ls = t2.x + t2.y; }
                    if (__any(m_new > m_run)) {
                        const float alpha = __builtin_amdgcn_exp2f(m_run - m_safe);
                        l_run *= alpha;
                        o0 = o0 * alpha; o1 = o1 * alpha;
                    }
                    l_run += ls; m_run = m_new;
                } else {
                    float run = carry;
#define SB_HALF(PX, KOFF) do { \
                    float lk[16]; \
                    _Pragma("unroll") for (int r = 0; r < 16; ++r) { \
                        const int off = (r & 3) + 8 * (r >> 2); \
                        const bool v = (kbase + off + (KOFF)) < qpos; \
                        const float z = PX[r]; \
                        const float t = 0.6931471805599453f * __builtin_amdgcn_logf(1.0f + __builtin_amdgcn_exp2f(-LOG2E * fabsf(z))); \
                        lk[r] = v ? (fminf(-z, 0.f) - t) : 0.f; \
                        PX[r] = v ? (fminf(z, 0.f) - t) : -INFINITY; } \
                    _Pragma("unroll") for (int g = 3; g >= 0; --g) { \
                        const float G = (lk[4 * g] + lk[4 * g + 1]) + (lk[4 * g + 2] + lk[4 * g + 3]); \
                        const float PG = xlane32(G); \
                        float la = run + (hi ? 0.f : PG); \
                        run += G + PG; \
                        PX[4 * g + 3] += la; la += lk[4 * g + 3]; PX[4 * g + 2] += la; la += lk[4 * g + 2]; PX[4 * g + 1] += la; la += lk[4 * g + 1]; PX[4 * g] += la; } \
                    _Pragma("unroll") for (int r = 0; r < 16; ++r) PX[r] = __builtin_amdgcn_exp2f(LOG2E * PX[r]); } while (0)
                    SB_HALF(p1, 32);
                    SB_HALF(p0, 0);
#undef SB_HALF
                    carry = run;
                }
                unsigned pw[16];
#pragma unroll
                for (int j = 0; j < 8; ++j) { pw[j] = cvtpk(p0[2 * j], p0[2 * j + 1]); pw[8 + j] = cvtpk(p1[2 * j], p1[2 * j + 1]); }
#pragma unroll
                for (int s = 0; s < 4; ++s) {
                    bf16x8_t pb; { const unsigned* q = pw + 4 * s; typedef unsigned u32x4_t __attribute__((ext_vector_type(4))); u32x4_t t4 = {q[0], q[1], q[2], q[3]}; pb = __builtin_bit_cast(bf16x8_t, t4); }
#pragma unroll
                    for (int dt = 0; dt < 2; ++dt) {
                        typedef short s16x4_t __attribute__((ext_vector_type(4)));
                        typedef __attribute__((address_space(3))) s16x4_t lds_s16x4;
                        const int gi_ = lane & 15;
                        const bf16* vp = vt_ + (16 * s + 4 * hi + (gi_ >> 2)) * AT_VP + 32 * dt + 16 * ((lane >> 4) & 1) + 4 * (gi_ & 3);
                        const s16x4_t lo = __builtin_amdgcn_ds_read_tr16_b64_v4i16((lds_s16x4*)vp), hi4 = __builtin_amdgcn_ds_read_tr16_b64_v4i16((lds_s16x4*)(vp + 8 * AT_VP));
                        const bf16x8_t va = {lo[0], lo[1], lo[2], lo[3], hi4[0], hi4[1], hi4[2], hi4[3]};
                        if (dt == 0) o0 = __builtin_amdgcn_mfma_f32_32x32x16_bf16(va, pb, o0, 0, 0, 0);
                        else         o1 = __builtin_amdgcn_mfma_f32_32x32x16_bf16(va, pb, o1, 0, 0, 0);
                    }
                }
            }
            if (kind == 3) {
                const float cm = carry;
                if (__all(cm < -110.0f) || !(kt * 64 <= q0w + 31) ) { if (__all(cm < -110.0f)) wave_done = true; }
            }
            if (more) {
                bf16* ksn = (bf16*)(lds + AT_KS + (buf ^ 1) * AT_KS_BYTES); bf16* vtn = (bf16*)(lds + AT_VT + (buf ^ 1) * AT_VT_BYTES);
                *(uint4*)(ksn + skey * AT_KP + sc * 8) = rk;
                *(uint4*)(vtn + skey * AT_VP + sc * 8) = rv;
            }
            if (kind == 3) { if (__syncthreads_and(wave_done ? 1 : 0)) break; }
            else __syncthreads();
            buf ^= 1;
        }
        float inv;
        if (kind == 3) inv = 1.0f;
        else {
            float lt = l_run + xlane32(l_run);
            if (kind == 1) { const float mf = fmaxf(m_run, sink2); const float sc2 = exp2f(m_run - mf); lt = lt * sc2 + exp2f(sink2 - mf); inv = sc2 / lt; }
            else inv = 1.0f / lt;
        }
        bf16* yp = ys + (size_t)(b * S_ + qpos) * 1024 + ycol + 4 * hi;
#pragma unroll
        for (int g = 0; g < 4; ++g) {
            *(uint2*)(yp + 8 * g) = make_uint2(cvtpk(o0[4 * g] * inv, o0[4 * g + 1] * inv), cvtpk(o0[4 * g + 2] * inv, o0[4 * g + 3] * inv));
            *(uint2*)(yp + 32 + 8 * g) = make_uint2(cvtpk(o1[4 * g] * inv, o1[4 * g + 1] * inv), cvtpk(o1[4 * g + 2] * inv, o1[4 * g + 3] * inv));
        }
    }
}
__device__ void attn_fast_phase(int WV_, const bf16* P, const unsigned char* mask, const float* kmean, const float* sinks, bf16* ys,
                                const unsigned* utab, unsigned* counter, unsigned char* lds) {
    volatile unsigned* s_unit = (volatile unsigned*)(lds + AT_MISC);
    for (;;) {
        __syncthreads();
        if (LTID(WV_) == 0) s_unit[0] = atomicAdd(counter, 1u);
        __syncthreads();
        const unsigned ui = s_unit[0];
        if (ui >= 512u) break;
        const unsigned ue = utab[ui];
        const int kind = (int)(ue >> 30), b = (int)((ue >> 28) & 3u), ux = (int)((ue >> 8) & 255u), uy = (int)(ue & 255u);
        if (kind == 0) attn_unit<0>(WV_, P, mask, kmean, sinks, ys, lds, b, ux, uy);
        else attn_unit<2>(WV_, P, mask, kmean, sinks, ys, lds, b, ux, uy);
    }
    for (int u = LBID(); u < 256; u += LGRID()) { __syncthreads(); attn_unit<3>(WV_, P, mask, kmean, sinks, ys, lds, u >> 6, (u >> 4) & 3, u & 15); }
    for (int u = LBID(); u < 256; u += LGRID()) { __syncthreads(); attn_unit<1>(WV_, P, mask, kmean, sinks, ys, lds, u >> 6, (u >> 5) & 1, u & 31); }
}

constexpr float U_SCALE = 128.0f, V_SCALE = 48.0f;
constexpr int ROW6 = 1536;
typedef float v32f_t __attribute__((ext_vector_type(32)));
typedef unsigned v6u_t __attribute__((ext_vector_type(6)));
typedef unsigned u32x4a8_t __attribute__((ext_vector_type(4), aligned(8)));
__device__ __forceinline__ float rdlane_f(float v, int l) { return __builtin_bit_cast(float, __builtin_amdgcn_readlane(__builtin_bit_cast(int, v), l)); }
__device__ __forceinline__ unsigned q_e2m3(float v) {
    const float a = fminf(fabsf(v), 7.5f);
    unsigned code;
    if (a < 1.0f) code = (unsigned)rintf(a * 8.0f);
    else if (a < 2.0f) code = 8u + (unsigned)rintf((a - 1.0f) * 8.0f);
    else if (a < 4.0f) code = 16u + (unsigned)rintf((a - 2.0f) * 4.0f);
    else code = 24u + (unsigned)rintf((a - 4.0f) * 2.0f);
    return code | (v < 0.f ? 32u : 0u);
}
__device__ __forceinline__ void cvt_chunk6(const float4 (&a)[8], float sc, unsigned (&w)[6]) {
#pragma unroll
    for (int d = 0; d < 6; ++d) w[d] = 0u;
#pragma unroll
    for (int q4 = 0; q4 < 8; ++q4) {
        const float av[4] = {a[q4].x, a[q4].y, a[q4].z, a[q4].w};
#pragma unroll
        for (int e = 0; e < 4; ++e) { const int idx = q4 * 4 + e, bit = 6 * idx, d = bit >> 5, sft = bit & 31; const unsigned code = q_e2m3(av[e] * sc);
            w[d] |= code << sft; if (sft > 26) w[d + 1] |= code >> (32 - sft); }
    }
}
__device__ void convert_tables(int WV_, const Params& p) {
    const size_t nchunk = (size_t)DEPTH_ * 16384 * 2 * 32;
    const size_t stride = (size_t)LGRID() * NTHR;
    for (size_t i = (size_t)LBID() * NTHR + LTID(WV_); i < nchunk; i += 2 * stride) {
        const size_t i2 = i + stride; const bool has2 = i2 < nchunk; const size_t j2 = has2 ? i2 : i;
        const int c0 = (int)(i & 31), uv0 = (int)((i >> 5) & 1); const size_t le0 = i >> 6;
        const int c1 = (int)(j2 & 31), uv1 = (int)((j2 >> 5) & 1); const size_t le1 = j2 >> 6;
        const float* src0 = (uv0 ? p.in[10] : p.in[9]) + le0 * 1024 + c0 * 32;
        const float* src1 = (uv1 ? p.in[10] : p.in[9]) + le1 * 1024 + c1 * 32;
        float4 a0[8], a1[8];
#pragma unroll
        for (int q4 = 0; q4 < 8; ++q4) a0[q4] = ((const float4*)src0)[q4];
#pragma unroll
        for (int q4 = 0; q4 < 8; ++q4) a1[q4] = ((const float4*)src1)[q4];
        unsigned w0[6], w1[6];
        cvt_chunk6(a0, uv0 ? V_SCALE : U_SCALE, w0);
        cvt_chunk6(a1, uv1 ? V_SCALE : U_SCALE, w1);
        uint2* dst0 = (uint2*)(p.ws + WS_UV + le0 * ROW6 + uv0 * 768 + c0 * 24);
        dst0[0] = make_uint2(w0[0], w0[1]); dst0[1] = make_uint2(w0[2], w0[3]); dst0[2] = make_uint2(w0[4], w0[5]);
        if (has2) { uint2* dst1 = (uint2*)(p.ws + WS_UV + le1 * ROW6 + uv1 * 768 + c1 * 24);
            dst1[0] = make_uint2(w1[0], w1[1]); dst1[1] = make_uint2(w1[2], w1[3]); dst1[2] = make_uint2(w1[4], w1[5]); }
    }
}
__device__ __forceinline__ v6u_t ld_pk6(const unsigned char* ptr) {
    const uint2 a = ((const uint2*)ptr)[0], b = ((const uint2*)ptr)[1], c = ((const uint2*)ptr)[2];
    const v6u_t pk = {a.x, a.y, b.x, b.y, c.x, c.y};
    return pk;
}
__device__ void peer_fast_phase(int WV_, float* h, bf16* hb, const int* eid, const float* gate, const unsigned char* uv, const float* g1, const float* b1, const float* g, const float* bb, unsigned char* lds) {
    const int tid = LTID(WV_), lane = tid & 63, wave = tid >> 6, l32 = lane & 31, hi = lane >> 5;
    float* pl = (float*)(lds + wave * 16384);
    unsigned char* raw = lds + wave * 16384 + 4096 + lane * 24;
    for (int t = LBID() * NWAVE + wave; t < T_; t += LGRID() * NWAVE) {
        float* hr = h + (size_t)t * 1024 + l32 * 32;
        float x[32], acc[32];
#pragma unroll
        for (int q4 = 0; q4 < 4; ++q4) { const uint4 a = ((const uint4*)(hb + (size_t)t * 1024 + l32 * 32))[q4];
            x[8 * q4] = __uint_as_float(a.x << 16); x[8 * q4 + 1] = __uint_as_float(a.x & 0xffff0000u); x[8 * q4 + 2] = __uint_as_float(a.y << 16); x[8 * q4 + 3] = __uint_as_float(a.y & 0xffff0000u);
            x[8 * q4 + 4] = __uint_as_float(a.z << 16); x[8 * q4 + 5] = __uint_as_float(a.z & 0xffff0000u); x[8 * q4 + 6] = __uint_as_float(a.w << 16); x[8 * q4 + 7] = __uint_as_float(a.w & 0xffff0000u); }
        {
            float s = 0.f;
#pragma unroll
            for (int i = 0; i < 32; ++i) s += x[i];
#pragma unroll
            for (int o = 16; o > 0; o >>= 1) s += __shfl_xor(s, o);
            const float mean = s * (1.0f / 1024.0f);
            float s2 = 0.f;
#pragma unroll
            for (int i = 0; i < 32; ++i) { x[i] -= mean; s2 += x[i] * x[i]; }
#pragma unroll
            for (int o = 16; o > 0; o >>= 1) s2 += __shfl_xor(s2, o);
            const float rstd = 1.0f / sqrtf(s2 * (1.0f / 1024.0f) + LN_EPS);
#pragma unroll
            for (int q4 = 0; q4 < 8; ++q4) { const float4 gg = ((const float4*)(g1 + l32 * 32))[q4], cc = ((const float4*)(b1 + l32 * 32))[q4];
                x[4 * q4] = x[4 * q4] * rstd * gg.x + cc.x; x[4 * q4 + 1] = x[4 * q4 + 1] * rstd * gg.y + cc.y; x[4 * q4 + 2] = x[4 * q4 + 2] * rstd * gg.z + cc.z; x[4 * q4 + 3] = x[4 * q4 + 3] * rstd * gg.w + cc.w; }
        }
#pragma unroll
        for (int i = 0; i < 32; ++i) acc[i] = 0.f;
#pragma unroll 1
        for (int batch = 0; batch < 4; ++batch) {
            const int my_eid = eid[(size_t)t * 128 + batch * 32 + l32];
            const float my_gate = gate[(size_t)t * 128 + batch * 32 + l32];
#pragma unroll 1
            for (int grp = 0; grp < 2; ++grp) {
                { u32x4a8_t pa[8]; uint2 pc[8];
#pragma unroll
                  for (int i = 0; i < 8; ++i) { const int id = __shfl(my_eid, 2 * (grp * 8 + i) + hi); const unsigned char* rp = uv + (size_t)id * ROW6 + l32 * 24; pa[i] = *(const u32x4a8_t*)rp; pc[i] = *(const uint2*)(rp + 16); }
#pragma unroll
                  for (int i = 0; i < 8; ++i) { uint2* wp = (uint2*)(raw + i * 1536); wp[0] = make_uint2(pa[i].x, pa[i].y); wp[1] = make_uint2(pa[i].z, pa[i].w); wp[2] = pc[i]; } }
#pragma unroll 1
                for (int i = 0; i < 8; ++i) {
                    const uint2* rp = (const uint2*)(raw + i * 1536); const uint2 a = rp[0], b = rp[1], c = rp[2];
                    const v6u_t pk6 = {a.x, a.y, b.x, b.y, c.x, c.y}; const v32f_t f = __builtin_amdgcn_cvt_scalef32_pk32_f32_fp6(pk6, 1.0f);
                    f32x2_t dv0 = {0.f, 0.f}, dv1 = {0.f, 0.f};
#pragma unroll
                    for (int j = 0; j < 8; ++j) { const f32x2_t fa = {f[2 * j], f[2 * j + 1]}, fb = {f[16 + 2 * j], f[17 + 2 * j]}, xa = {x[2 * j], x[2 * j + 1]}, xb = {x[16 + 2 * j], x[17 + 2 * j]};
                        dv0 = fa * xa + dv0; dv1 = fb * xb + dv1; }
                    pl[(2 * (grp * 8 + i) + hi) * 32 + l32] = (dv0.x + dv0.y) + (dv1.x + dv1.y);
                }
            }
            float d;
            { const float4* pr = (const float4*)(pl + l32 * 32); float4 s4 = pr[0];
#pragma unroll
              for (int i = 1; i < 8; ++i) { const float4 v = pr[i]; s4.x += v.x; s4.y += v.y; s4.z += v.z; s4.w += v.w; }
              d = ((s4.x + s4.y) + (s4.z + s4.w)) * (1.0f / U_SCALE); }
            const float hv = 0.5f * d * (1.0f + erff(d * 0.70710678118654752f)) * my_gate * (1.0f / V_SCALE);
#pragma unroll 1
            for (int grp = 0; grp < 2; ++grp) {
                { u32x4a8_t pa[8]; uint2 pc[8];
#pragma unroll
                  for (int i = 0; i < 8; ++i) { const int id = __shfl(my_eid, 2 * (grp * 8 + i) + hi); const unsigned char* rp = uv + (size_t)id * ROW6 + 768 + l32 * 24; pa[i] = *(const u32x4a8_t*)rp; pc[i] = *(const uint2*)(rp + 16); }
#pragma unroll
                  for (int i = 0; i < 8; ++i) { uint2* wp = (uint2*)(raw + i * 1536); wp[0] = make_uint2(pa[i].x, pa[i].y); wp[1] = make_uint2(pa[i].z, pa[i].w); wp[2] = pc[i]; } }
#pragma unroll 1
                for (int i = 0; i < 8; ++i) {
                    const float c = __shfl(hv, 2 * (grp * 8 + i) + hi);
                    const uint2* rp = (const uint2*)(raw + i * 1536); const uint2 a = rp[0], b = rp[1], cc = rp[2];
                    const v6u_t pk6 = {a.x, a.y, b.x, b.y, cc.x, cc.y}; const v32f_t f = __builtin_amdgcn_cvt_scalef32_pk32_f32_fp6(pk6, 1.0f);
                    const f32x2_t c2 = {c, c};
#pragma unroll
                    for (int j = 0; j < 16; ++j) { const f32x2_t fj = {f[2 * j], f[2 * j + 1]}; f32x2_t aj = {acc[2 * j], acc[2 * j + 1]}; aj = fj * c2 + aj; acc[2 * j] = aj.x; acc[2 * j + 1] = aj.y; }
                }
            }
        }
        float y[32], s = 0.f;
#pragma unroll
        for (int i = 0; i < 32; ++i) { acc[i] += __shfl_xor(acc[i], 32); y[i] = ALPHA * x[i] + acc[i]; s += y[i]; }
#pragma unroll
        for (int o = 16; o > 0; o >>= 1) s += __shfl_xor(s, o);
        const float mean = s * (1.0f / 1024.0f);
        float s2 = 0.f;
#pragma unroll
        for (int i = 0; i < 32; ++i) { y[i] -= mean; s2 += y[i] * y[i]; }
#pragma unroll
        for (int o = 16; o > 0; o >>= 1) s2 += __shfl_xor(s2, o);
        const float rstd = 1.0f / sqrtf(s2 * (1.0f / 1024.0f) + LN_EPS);
        float o[16];
#pragma unroll
        for (int q4 = 0; q4 < 4; ++q4) {
            const float4 gg = ((const float4*)(g + l32 * 32 + hi * 16))[q4], cc = ((const float4*)(bb + l32 * 32 + hi * 16))[q4];
            float ya[4], yb2[4];
#pragma unroll
            for (int e = 0; e < 4; ++e) { ya[e] = y[4 * q4 + e]; yb2[e] = y[16 + 4 * q4 + e]; }
            asm volatile("" : "+v"(ya[0]), "+v"(ya[1]), "+v"(ya[2]), "+v"(ya[3]), "+v"(yb2[0]), "+v"(yb2[1]), "+v"(yb2[2]), "+v"(yb2[3]));
            const float y0 = hi ? yb2[0] : ya[0], y1 = hi ? yb2[1] : ya[1], y2 = hi ? yb2[2] : ya[2], y3 = hi ? yb2[3] : ya[3];
            o[4 * q4] = y0 * rstd * gg.x + cc.x; o[4 * q4 + 1] = y1 * rstd * gg.y + cc.y; o[4 * q4 + 2] = y2 * rstd * gg.z + cc.z; o[4 * q4 + 3] = y3 * rstd * gg.w + cc.w;
            if (h) ((float4*)(hr + hi * 16))[q4] = make_float4(o[4 * q4], o[4 * q4 + 1], o[4 * q4 + 2], o[4 * q4 + 3]);
        }
        uint4* hbp = (uint4*)(hb + (size_t)t * 1024 + l32 * 32 + hi * 16);
        hbp[0] = make_uint4(pk2(o[0], o[1]), pk2(o[2], o[3]), pk2(o[4], o[5]), pk2(o[6], o[7]));
        hbp[1] = make_uint4(pk2(o[8], o[9]), pk2(o[10], o[11]), pk2(o[12], o[13]), pk2(o[14], o[15]));
    }
}

__device__ __forceinline__ float pack_pl(float v, unsigned pl) { return __uint_as_float((__float_as_uint(v) & ~127u) | pl); }
__device__ __forceinline__ void ins16(float (&s)[16], float x) {
#pragma unroll
    for (int k = 15; k >= 1; --k) s[k] = __builtin_amdgcn_fmed3f(s[k - 1], x, s[k]);
    s[0] = vmax(s[0], x);
}
template <int D> __device__ __forceinline__ void bitonic_stage(float (&c)[16]) {
#pragma unroll
    for (int i = 0; i < 16; ++i) if ((i & D) == 0) { const float a = vmax(c[i], c[i + D]), b = vmin(c[i], c[i + D]); c[i] = a; c[i + D] = b; }
}
__device__ __forceinline__ int decode_key(unsigned pl) { return (int)(32u * ((pl >> 4) & 3u) + (pl & 3u) + 8u * ((pl >> 2) & 3u) + 4u * ((pl >> 6) & 1u)); }
__device__ void route_fast_phase(int WV_, const bf16* qb, const bf16* skb  , int* eid, float* gate, unsigned char* lds, int pm = -1, int pn = 0) {
    const int tid = LTID(WV_), lane = tid & 63, wave = tid >> 6, r32 = lane & 31, hi = lane >> 5;
    unsigned* lidx = (unsigned*)lds + wave * (64 * 33) + lane * 33;
    const int u_first = (pm >= 0) ? 0 : LBID() * NWAVE + wave, u_end = (pm >= 0) ? 2 : (T_ / 32) * 8, u_step = (pm >= 0) ? 1 : LGRID() * NWAVE;
    for (int unit = u_first; unit < u_end; unit += u_step) {
        const int h = (pm >= 0) ? 2 * pn + unit : (unit & 7), t = ((pm >= 0) ? 8 * pm + wave : (unit >> 3)) * 32 + r32;
        float sl[2][16];
#pragma unroll
        for (int p = 0; p < 2; ++p) {
            bf16x8_t qf[4];
            { const bf16* qp = qb + (size_t)t * 1024 + h * 128 + p * 64 + 8 * hi;
#pragma unroll
              for (int ks = 0; ks < 4; ++ks) qf[ks] = *(const bf16x8_t*)(qp + 16 * ks); }
            float s[16];
#pragma unroll
            for (int k = 0; k < 16; ++k) s[k] = -INFINITY;
            const bf16* skp = skb + ((size_t)(h * 2 + p) * 128 + r32) * 64 + 8 * hi;
#pragma unroll
            for (int kt = 0; kt < 4; ++kt) {
                f32x16_t acc;
#pragma unroll
                for (int r = 0; r < 16; ++r) acc[r] = 0.f;
#pragma unroll
                for (int ks = 0; ks < 4; ++ks) { const bf16x8_t a = *(const bf16x8_t*)(skp + (size_t)kt * 32 * 64 + 16 * ks); acc = __builtin_amdgcn_mfma_f32_32x32x16_bf16(a, qf[ks], acc, 0, 0, 0); }
#pragma unroll
                for (int r = 0; r < 16; ++r) ins16(s, pack_pl(acc[r], (unsigned)(kt * 16 + r)));
            }
            const unsigned hb = (unsigned)hi << 6;
#pragma unroll
            for (int k = 0; k < 16; ++k) s[k] = __uint_as_float(__float_as_uint(s[k]) | hb);
            float c[16];
#pragma unroll
            for (int k = 0; k < 16; ++k) c[k] = vmax(s[k], __shfl_xor(s[15 - k], 32));
            bitonic_stage<8>(c); bitonic_stage<4>(c); bitonic_stage<2>(c); bitonic_stage<1>(c);
#pragma unroll
            for (int k = 0; k < 16; ++k) { sl[p][k] = c[k]; lidx[p * 16 + k] = (unsigned)decode_key(__float_as_uint(c[k]) & 127u); }
        }
        float w[16];
#pragma unroll
        for (int k = 0; k < 16; ++k) w[k] = -INFINITY;
#pragma unroll
        for (int i = 0; i < 16; ++i)
#pragma unroll
            for (int j = 0; j < 16; ++j)
                if ((i + 1) * (j + 1) <= 16) { const float v = sl[0][i] + sl[1][j]; ins16(w, __uint_as_float((__float_as_uint(v) & ~255u) | (unsigned)(i * 16 + j))); }
        float e[16], sum = 0.f;
#pragma unroll
        for (int k = 0; k < 16; ++k) { e[k] = __builtin_amdgcn_exp2f((w[k] - w[0]) * 1.44269504f); sum += e[k]; }
        const float inv = 1.0f / sum;
        int ide[8]; float gte[8];
#pragma unroll
        for (int k = 0; k < 8; ++k) {
            float wa = w[k], wb = w[8 + k], ea = e[k], eb = e[8 + k];
            asm volatile("" : "+v"(wa), "+v"(wb), "+v"(ea), "+v"(eb));
            const float wv = hi ? wb : wa;
            const unsigned pl = __float_as_uint(wv) & 255u;
            ide[k] = (int)(lidx[pl >> 4] * 128u + lidx[16 + (pl & 15u)]);
            gte[k] = (hi ? eb : ea) * inv;
        }
        int* ep = eid + (size_t)t * 128 + h * 16 + hi * 8; float* gp = gate + (size_t)t * 128 + h * 16 + hi * 8;
        *(int4*)ep = make_int4(ide[0], ide[1], ide[2], ide[3]); *(int4*)(ep + 4) = make_int4(ide[4], ide[5], ide[6], ide[7]);
        *(float4*)gp = make_float4(gte[0], gte[1], gte[2], gte[3]); *(float4*)(gp + 4) = make_float4(gte[4], gte[5], gte[6], gte[7]);
    }
}
#ifndef TS_SEL
#define TS_SEL 0
#endif
#define ITS_B() do { if (TS_SEL >= 20 && TS_SEL <= 40 && WV_ == 0 && LANEID() == 0) ((volatile __attribute__((address_space(3))) unsigned long long*)((__attribute__((address_space(3))) unsigned char*)lds + 147456 - 16 - 32))[0] = __builtin_amdgcn_s_memrealtime(); } while (0)
#define ITS_E(k) do { if ((k) == TS_SEL && WV_ == 0 && LANEID() == 0) { volatile __attribute__((address_space(3))) unsigned long long* w_ = (volatile __attribute__((address_space(3))) unsigned long long*)((__attribute__((address_space(3))) unsigned char*)lds + 147456 - 16 - 32); w_[1] += __builtin_amdgcn_s_memrealtime() - w_[0]; } } while (0)

typedef float f32x4_t __attribute__((ext_vector_type(4)));
typedef __bf16 bf16x2v __attribute__((ext_vector_type(2)));
__device__ __forceinline__ float dot2bf(unsigned a, unsigned b, float c) { return __builtin_amdgcn_fdot2_f32_bf16(__builtin_bit_cast(bf16x2v, a), __builtin_bit_cast(bf16x2v, b), c, false); }
__device__ __forceinline__ void cnt_gt(int& cnt, unsigned a, unsigned b) { asm("v_cmp_gt_u32_e32 vcc, %1, %2\n\tv_addc_co_u32_e32 %0, vcc, 0, %0, vcc" : "+v"(cnt) : "v"(a), "v"(b) : "vcc"); }
__device__ __forceinline__ void cnt_eq(int& cnt, unsigned a, unsigned b) { asm("v_cmp_eq_u32_e32 vcc, %1, %2\n\tv_addc_co_u32_e32 %0, vcc, 0, %0, vcc" : "+v"(cnt) : "v"(a), "v"(b) : "vcc"); }
__device__ __forceinline__ unsigned flag_gt(unsigned a, unsigned b) { unsigned r; asm("v_cmp_gt_u32_e32 vcc, %1, %2\n\tv_cndmask_b32_e64 %0, 0, 1, vcc" : "=v"(r) : "v"(a), "v"(b) : "vcc"); return r; }
__device__ __forceinline__ unsigned flag_eq(unsigned a, unsigned b) { unsigned r; asm("v_cmp_eq_u32_e32 vcc, %1, %2\n\tv_cndmask_b32_e64 %0, 0, 1, vcc" : "=v"(r) : "v"(a), "v"(b) : "vcc"); return r; }
__device__ __forceinline__ void cnt_ge(int& cnt, unsigned key, unsigned cand) { asm("v_cmp_ge_u32_e32 vcc, %1, %2\n\tv_addc_co_u32_e32 %0, vcc, 0, %0, vcc" : "+v"(cnt) : "v"(key), "v"(cand) : "vcc"); }

template <int CTRL, int RM> __device__ __forceinline__ unsigned dpp0(unsigned v) { return (unsigned)__builtin_amdgcn_update_dpp(0, (int)v, CTRL, RM, 0xf, false); }
template <int CTRL> __device__ __forceinline__ unsigned dppf(unsigned v) { return (unsigned)__builtin_amdgcn_update_dpp(-1, (int)v, CTRL, 0xf, 0xf, false); }
__device__ __forceinline__ unsigned wave_sum_u_dpp(unsigned v) {
    v += dpp0<0xB1, 0xf>(v); v += dpp0<0x4E, 0xf>(v); v += dpp0<0x141, 0xf>(v); v += dpp0<0x140, 0xf>(v);
    return (unsigned)__builtin_amdgcn_readlane((int)v, 0) + (unsigned)__builtin_amdgcn_readlane((int)v, 16) + (unsigned)__builtin_amdgcn_readlane((int)v, 32) + (unsigned)__builtin_amdgcn_readlane((int)v, 48);
}
__device__ __forceinline__ unsigned wave_min_u_dpp(unsigned v) {
    unsigned t;
    t = dppf<0xB1>(v); v = t < v ? t : v; t = dppf<0x4E>(v); v = t < v ? t : v; t = dppf<0x141>(v); v = t < v ? t : v; t = dppf<0x140>(v); v = t < v ? t : v;
    const unsigned a = (unsigned)__builtin_amdgcn_readlane((int)v, 0), b = (unsigned)__builtin_amdgcn_readlane((int)v, 16), c = (unsigned)__builtin_amdgcn_readlane((int)v, 32), d = (unsigned)__builtin_amdgcn_readlane((int)v, 48);
    const unsigned ab = a < b ? a : b, cd = c < d ? c : d; return ab < cd ? ab : cd;
}
__device__ __forceinline__ unsigned wave_incl_scan_u_dpp(unsigned v) {
    v += dpp0<0x111, 0xf>(v); v += dpp0<0x112, 0xf>(v); v += dpp0<0x114, 0xf>(v); v += dpp0<0x118, 0xf>(v);
    v += dpp0<0x142, 0xa>(v);
    v += dpp0<0x143, 0xc>(v);
    return v;
}
typedef __attribute__((address_space(3))) unsigned lds_u32;
template <int SHIFT> __device__ __forceinline__ unsigned radix_pass(const unsigned (&key)[64], unsigned pre, lds_u32* hist, int lane, int& need, int jlim, unsigned L, unsigned& cntsel) {
    typedef unsigned u32x4v __attribute__((ext_vector_type(4)));
    typedef __attribute__((address_space(3))) u32x4v lds_u32x4;
    const int fl = 63 - lane;
    { const u32x4v z4 = {0u, 0u, 0u, 0u};
      ((lds_u32x4*)(hist + fl * 4))[0] = z4; }
    const unsigned hb = (unsigned)(size_t)hist;
    const unsigned one = 1u;
    asm volatile("" ::: "memory");
#pragma unroll
    for (int j4 = 0; j4 < 16; ++j4) {
        if (4 * j4 <= jlim) {
            unsigned long long c0, c1, c2, c3, sv; unsigned t0, t1, t2, t3;
            if (SHIFT == 24)
                asm volatile(
                    "v_cmp_ge_u32_e64 %0, %9, %13\n\tv_cmp_ge_u32_e64 %1, %10, %13\n\tv_cmp_ge_u32_e64 %2, %11, %13\n\tv_cmp_ge_u32_e64 %3, %12, %13\n\t"
                    "v_lshrrev_b32_e32 %5, 24, %9\n\tv_lshrrev_b32_e32 %6, 24, %10\n\tv_lshrrev_b32_e32 %7, 24, %11\n\tv_lshrrev_b32_e32 %8, 24, %12\n\t"
                    "v_lshl_add_u32 %5, %5, 2, %14\n\tv_lshl_add_u32 %6, %6, 2, %14\n\tv_lshl_add_u32 %7, %7, 2, %14\n\tv_lshl_add_u32 %8, %8, 2, %14\n\t"
                    "s_mov_b64 %4, exec\n\t"
                    "s_mov_b64 exec, %0\n\tds_add_u32 %5, %15\n\ts_mov_b64 exec, %1\n\tds_add_u32 %6, %15\n\ts_mov_b64 exec, %2\n\tds_add_u32 %7, %15\n\ts_mov_b64 exec, %3\n\tds_add_u32 %8, %15\n\t"
                    "s_mov_b64 exec, %4"
                    : "=&s"(c0), "=&s"(c1), "=&s"(c2), "=&s"(c3), "=&s"(sv), "=&v"(t0), "=&v"(t1), "=&v"(t2), "=&v"(t3)
                    : "v"(key[4 * j4]), "v"(key[4 * j4 + 1]), "v"(key[4 * j4 + 2]), "v"(key[4 * j4 + 3]), "v"(L), "v"(hb), "v"(one) : "memory");
            else
                asm volatile(
                    "v_lshrrev_b32_e32 %5, %16, %9\n\tv_lshrrev_b32_e32 %6, %16, %10\n\tv_lshrrev_b32_e32 %7, %16, %11\n\tv_lshrrev_b32_e32 %8, %16, %12\n\t"
                    "v_cmp_eq_u32_e64 %0, %5, %13\n\tv_cmp_eq_u32_e64 %1, %6, %13\n\tv_cmp_eq_u32_e64 %2, %7, %13\n\tv_cmp_eq_u32_e64 %3, %8, %13\n\t"
                    "s_or_b64 %4, %0, %1\n\ts_or_b64 %4, %4, %2\n\ts_or_b64 %4, %4, %3\n\t"
                    "s_cbranch_scc0 .Lrxskip%=\n\t"
                    "v_bfe_u32 %5, %9, %17, 8\n\tv_bfe_u32 %6, %10, %17, 8\n\tv_bfe_u32 %7, %11, %17, 8\n\tv_bfe_u32 %8, %12, %17, 8\n\t"
                    "v_lshl_add_u32 %5, %5, 2, %14\n\tv_lshl_add_u32 %6, %6, 2, %14\n\tv_lshl_add_u32 %7, %7, 2, %14\n\tv_lshl_add_u32 %8, %8, 2, %14\n\t"
                    "s_mov_b64 %4, exec\n\t"
                    "s_mov_b64 exec, %0\n\tds_add_u32 %5, %15\n\ts_mov_b64 exec, %1\n\tds_add_u32 %6, %15\n\ts_mov_b64 exec, %2\n\tds_add_u32 %7, %15\n\ts_mov_b64 exec, %3\n\tds_add_u32 %8, %15\n\t"
                    "s_mov_b64 exec, %4\n"
                    ".Lrxskip%=:"
                    : "=&s"(c0), "=&s"(c1), "=&s"(c2), "=&s"(c3), "=&s"(sv), "=&v"(t0), "=&v"(t1), "=&v"(t2), "=&v"(t3)
                    : "v"(key[4 * j4]), "v"(key[4 * j4 + 1]), "v"(key[4 * j4 + 2]), "v"(key[4 * j4 + 3]), "v"(pre), "v"(hb), "v"(one), "n"((SHIFT + 8) & 31), "n"(SHIFT) : "memory", "scc");
        }
    }
    asm volatile("s_waitcnt lgkmcnt(0)" ::: "memory");
    unsigned dsum[4]; unsigned sumL = 0u;
    { const u32x4v v0 = ((const lds_u32x4*)(hist + fl * 4))[0];
      dsum[0] = v0.x; dsum[1] = v0.y; dsum[2] = v0.z; dsum[3] = v0.w; sumL = (dsum[0] + dsum[1]) + (dsum[2] + dsum[3]); }
    const unsigned incl = wave_incl_scan_u_dpp(sumL);
    const unsigned above = incl - sumL;
    const bool own = (above < (unsigned)need) && ((unsigned)need <= above + sumL);
    const int owner = __ffsll((long long)__ballot(own)) - 1;
    unsigned acc = above; int sel = -1; unsigned cab = 0u;
    unsigned csel = 0u;
#pragma unroll
    for (int i = 3; i >= 0; --i) { const unsigned c = dsum[i]; const bool hit = (sel < 0) && (acc + c >= (unsigned)need); cab = hit ? acc : cab; csel = hit ? c : csel; sel = hit ? i : sel; acc += c; }
    const int ow = owner < 0 ? 0 : owner;
    const unsigned digit = (unsigned)__builtin_amdgcn_readlane(sel, ow) + (unsigned)(4 * (63 - ow));
    need -= (int)__builtin_amdgcn_readlane((int)cab, ow);
    cntsel = (unsigned)__builtin_amdgcn_readlane((int)csel, ow);
    return digit;
}

__device__ __forceinline__ void idx_select(const unsigned (&key)[64], unsigned t3, int jlim, lds_u32* hist, int lane, uint2* mrow, int WV_, unsigned char* lds) {
        unsigned wlo = 0u, whi = 0u;
        unsigned L = wave_min_u_dpp(t3);
        L = L > 1u ? L : 1u;

        int need = 256;
        ITS_E(34); ITS_B();
        unsigned cs; bool fin;
        const unsigned d1 = radix_pass<24>(key, 0u, hist, lane, need, jlim, L, cs);
        unsigned prefix = d1 << 24; fin = cs == (unsigned)need;
        if (fin) prefix = prefix > L ? prefix : L;
        if (!fin) {
            const unsigned d2 = radix_pass<16>(key, d1, hist, lane, need, jlim, L, cs);
            prefix |= d2 << 16; fin = cs == (unsigned)need;
            if (!fin) {
                const unsigned d3 = radix_pass<8>(key, (d1 << 8) | d2, hist, lane, need, jlim, L, cs);
                prefix |= d3 << 8; fin = cs == (unsigned)need;
                if (!fin) { const unsigned d4 = radix_pass<0>(key, (d1 << 16) | (d2 << 8) | d3, hist, lane, need, jlim, L, cs); prefix |= d4; }
            }
        }
        int ceq = 0;
        if (!fin)
#pragma unroll
        for (int j4 = 0; j4 < 16; ++j4) if (4 * j4 <= jlim) { cnt_eq(ceq, key[4 * j4], prefix); cnt_eq(ceq, key[4 * j4 + 1], prefix); cnt_eq(ceq, key[4 * j4 + 2], prefix); cnt_eq(ceq, key[4 * j4 + 3], prefix); }
        ceq = (int)wave_sum_u_dpp((unsigned)ceq);
        int X = 4096;
        if (!fin && ceq != need) {
            int X0 = 0;
#pragma unroll 1
            for (int bit = 11; bit >= 0; --bit) {
                const int c = X0 | (1 << bit);
                int cnt = 0; const int crel = (c - lane + 63) >> 6;
#pragma unroll
                for (int j = 0; j < 64; ++j) cnt_eq(cnt, (key[j] ^ prefix) | ~(unsigned)((j - crel) >> 31), 0u);
                cnt = wave_sum_i(cnt);
                if (cnt < need) X0 = c;
            }
            X = X0 + 1;
        }
        const int xrel = (X - lane + 63) >> 6;
#pragma unroll
        for (int j4 = 0; j4 < 16; ++j4) {
            if (4 * j4 <= jlim) {
#pragma unroll
                for (int e = 0; e < 4; ++e) { const int j = 4 * j4 + e;
                    const bool sel = (key[j] > prefix) || (key[j] == prefix && j < xrel);
                    const unsigned long long bm = __ballot(sel);
                    asm("v_writelane_b32 %0, %1, %2" : "+v"(wlo) : "s"((unsigned)bm), "n"(j));
                    asm("v_writelane_b32 %0, %1, %2" : "+v"(whi) : "s"((unsigned)(bm >> 32)), "n"(j)); }
            }
        }
        mrow[lane] = make_uint2(wlo, whi);
        ITS_E(33); ITS_B();
}
__device__ void index_fast_phase(int WV_, const bf16* P, unsigned char* mask, float* kmean, float* scratch_all, unsigned* qctr, unsigned char* lds) {
    const int tid = LTID(WV_), lane = tid & 63, wave = tid >> 6, bid = LBID(), G = LGRID();
    float* s_part = (float*)lds;
    ITS_B();
    for (int k = bid; k < 256; k += G) {
        const int b = k >> 6, h = (k >> 4) & 3, blk = k & 15;
        float* sp = (float*)(lds + 69632);
        { const int rg = lane >> 3, c = lane & 7;
          const bf16* kp = P + (size_t)(b * S_ + blk * 256 + wave * 32 + rg) * NP + C_KC + h * 64 + c * 8;
          uint4 kv[4];
#pragma unroll
          for (int j = 0; j < 4; ++j) kv[j] = *(const uint4*)(kp + (size_t)(8 * j) * NP);
          float acc8[8];
#pragma unroll
          for (int e = 0; e < 8; ++e) acc8[e] = 0.f;
#pragma unroll
          for (int j = 0; j < 4; ++j) { float t[8]; unpack8(kv[j], t);
#pragma unroll
              for (int e = 0; e < 8; ++e) acc8[e] += t[e]; }
          __syncthreads();
          float4* dst = (float4*)(sp + (wave * 8 + rg) * 64 + c * 8);
          dst[0] = make_float4(acc8[0], acc8[1], acc8[2], acc8[3]); dst[1] = make_float4(acc8[4], acc8[5], acc8[6], acc8[7]); }
        __syncthreads();
        if (tid < 64) { float s = 0.f;
#pragma unroll 16
            for (int r = 0; r < 64; ++r) s += sp[r * 64 + tid];
            kmean[((b * 4 + h) * 16 + blk) * 64 + tid] = s * (1.0f / 256.0f); }
    }
    ITS_E(22);
    constexpr int IDX_CP = 512 + 4;
    constexpr int IDX_PITCH = 4096 + 32;
    float* scr = scratch_all + (size_t)bid * (16 * IDX_PITCH);
    const int lq = lane & 15, g4 = lane >> 4;
    for (int ui = bid; ui < 1024; ui += G) {
        const int b = ui >> 8, k = ui & 255, tile = (b & 1) ? 255 - k : k, q0 = tile * 16;
        const bf16* Pb = P + (size_t)b * S_ * NP;
        const int ntiles = tile + 1;
        int lane_o = LANEID(); asm volatile("" : "+v"(lane_o));
        const int lane = lane_o, lq = lane & 15, g4 = lane >> 4;
        const int wave = WV_;
        const int qA = q0 + 2 * wave, qB = qA + 1;
        uint2* mrowA = (uint2*)(mask + (size_t)(b * S_ + qA) * 512); uint2* mrowB = (uint2*)(mask + (size_t)(b * S_ + qB) * 512);
        if (tile < 16) {
            unsigned wlo = 0u, whi = 0u, xlo = 0u, xhi = 0u; const int ra = qA - lane * 64, rb = qB - lane * 64;
#pragma unroll
            for (int j = 0; j < 32; ++j) { wlo |= (~(unsigned)((ra - j) >> 31) & 1u) << j; whi |= (~(unsigned)((ra - 32 - j) >> 31) & 1u) << j;
                                           xlo |= (~(unsigned)((rb - j) >> 31) & 1u) << j; xhi |= (~(unsigned)((rb - 32 - j) >> 31) & 1u) << j; }
            mrowA[lane] = make_uint2(wlo, whi); mrowB[lane] = make_uint2(xlo, xhi);
            continue;
        }
        ITS_B();
        bf16x8_t qf[8]; float wi[8];
        { const bf16* qp = Pb + (size_t)(q0 + lq) * NP + C_QI + 8 * g4;
#pragma unroll
          for (int h = 0; h < 8; ++h) qf[h] = *(const bf16x8_t*)(qp + 32 * h);
          const uint4 wv = *(const uint4*)(Pb + (size_t)(q0 + lq) * NP + C_WI); unpack8(wv, wi); }
        bf16x8_t qch, qcl;
        { typedef unsigned u32x4_t __attribute__((ext_vector_type(4)));
          float qc[8];
#pragma unroll
          for (int i = 0; i < 8; ++i) qc[i] = 0.f;
#pragma unroll
          for (int h = 0; h < 8; ++h) { const u32x4_t w4 = __builtin_bit_cast(u32x4_t, qf[h]);
#pragma unroll
              for (int i = 0; i < 4; ++i) { qc[2 * i] += wi[h] * __uint_as_float(w4[i] << 16); qc[2 * i + 1] += wi[h] * __uint_as_float(w4[i] & 0xffff0000u); } }
          u32x4_t hi4, lo4;
#pragma unroll
          for (int i = 0; i < 4; ++i) { const unsigned hw = cvtpk(qc[2 * i], qc[2 * i + 1]); hi4[i] = hw;
              lo4[i] = cvtpk(qc[2 * i] - __uint_as_float(hw << 16), qc[2 * i + 1] - __uint_as_float(hw & 0xffff0000u)); }
          qch = __builtin_bit_cast(bf16x8_t, hi4); qcl = __builtin_bit_cast(bf16x8_t, lo4); }
        typedef __attribute__((address_space(3))) bf16x8_t lds_bf16x8;
        lds_bf16x8* qops = (lds_bf16x8*)((__attribute__((address_space(3))) unsigned char*)lds + 102656);
        if (wave == 0) {
#pragma unroll
            for (int h = 0; h < 8; ++h) qops[h * 64 + lane] = qf[h];
            qops[8 * 64 + lane] = qch; qops[9 * 64 + lane] = qcl; }
        __syncthreads();
        ITS_E(20); ITS_B();
        float* cb0 = (float*)(lds + 69632); float* cb1 = (float*)(lds + 112896);
        const int jlim = q0 >> 6;
        const int jmaxA = (qA - lane) >> 6, jmaxB = (qB - lane) >> 6;
        unsigned keyA[64], keyB[64];
        unsigned a0 = 0u, a1 = 0u, a2 = 0u, a3 = 0u, b0 = 0u, b1 = 0u, b2 = 0u, b3 = 0u;
        const bf16* kbase = Pb + (size_t)lq * NP + C_KI + 8 * g4;
        bf16x8_t nxt = *(const bf16x8_t*)(kbase + (size_t)(wave < ntiles ? wave : 0) * 16 * NP);
#pragma unroll
        for (int c = 0; c < 8; ++c) {
            if (32 * c < ntiles) {
                float* cb = (c & 1) ? cb1 : cb0;
#pragma unroll
                for (int j = 0; j < 4; ++j) {
                    const int kt = 32 * c + wave + 8 * j;
                    const bf16x8_t af = nxt;
                    { const int k = kt + 8; const int kc = k < ntiles ? k : 0; nxt = *(const bf16x8_t*)(kbase + (size_t)kc * 16 * NP); }
                    if (kt < ntiles) {
                        const f32x4_t z = {0.f, 0.f, 0.f, 0.f};
                        f32x4_t sc = __builtin_amdgcn_mfma_f32_16x16x32_bf16(af, qops[8 * 64 + lane], z, 0, 0, 0);
                        sc = __builtin_amdgcn_mfma_f32_16x16x32_bf16(af, qops[9 * 64 + lane], sc, 0, 0, 0);
#pragma unroll
                        for (int hh = 0; hh < 2; ++hh) {
                            f32x4_t a[4];
#pragma unroll
                            for (int h = 0; h < 4; ++h) a[h] = __builtin_amdgcn_mfma_f32_16x16x32_bf16(af, qops[(4 * hh + h) * 64 + lane], z, 0, 0, 0);
#pragma unroll
                            for (int h = 0; h < 4; ++h)
#pragma unroll
                                for (int r = 0; r < 4; ++r) sc[r] = __builtin_fmaf(__builtin_fabsf(a[h][r]), wi[4 * hh + h], sc[r]);
                        }
#pragma unroll
                        for (int r = 0; r < 4; ++r) { sc[r] *= 0.03125f; if (sc[r] == 0.f) sc[r] = 0.f; }
                        *(f32x4_t*)(cb + lq * IDX_CP + (wave + 8 * j) * 16 + 4 * g4) = sc;
                    }
                }
                __syncthreads();
#pragma unroll
                for (int js = 0; js < 8; ++js) {
                    const int slot = 8 * c + js;
                    if (slot <= jlim) {
                        const unsigned ua = __float_as_uint(cb[(2 * wave) * IDX_CP + 64 * js + lane]), ub = __float_as_uint(cb[(2 * wave + 1) * IDX_CP + 64 * js + lane]);
                        const unsigned xa = (ua ^ ((unsigned)((int)ua >> 31) | 0x80000000u)) & ~(unsigned)((jmaxA - slot) >> 31);
                        const unsigned xb = (ub ^ ((unsigned)((int)ub >> 31) | 0x80000000u)) & ~(unsigned)((jmaxB - slot) >> 31);
                        keyA[slot] = xa; keyB[slot] = xb;
                        unsigned n1, n2, n3;
                        asm("v_med3_u32 %0, %1, %2, %3" : "=v"(n3) : "v"(a2), "v"(a3), "v"(xa));
                        asm("v_med3_u32 %0, %1, %2, %3" : "=v"(n2) : "v"(a1), "v"(a2), "v"(xa));
                        asm("v_med3_u32 %0, %1, %2, %3" : "=v"(n1) : "v"(a0), "v"(a1), "v"(xa));
                        a0 = a0 > xa ? a0 : xa; a1 = n1; a2 = n2; a3 = n3;
                        asm("v_med3_u32 %0, %1, %2, %3" : "=v"(n3) : "v"(b2), "v"(b3), "v"(xb));
                        asm("v_med3_u32 %0, %1, %2, %3" : "=v"(n2) : "v"(b1), "v"(b2), "v"(xb));
                        asm("v_med3_u32 %0, %1, %2, %3" : "=v"(n1) : "v"(b0), "v"(b1), "v"(xb));
                        b0 = b0 > xb ? b0 : xb; b1 = n1; b2 = n2; b3 = n3;
                    } else { keyA[slot] = 0u; keyB[slot] = 0u; }
                }
            } else {
#pragma unroll
                for (int js = 0; js < 8; ++js) { keyA[8 * c + js] = 0u; keyB[8 * c + js] = 0u; }
            }
        }
        lds_u32* hist = (lds_u32*)((__attribute__((address_space(3))) unsigned char*)lds + 2048) + wave * 2048;
        ITS_E(23); ITS_B();
        idx_select(keyA, a3, jlim, hist, lane, mrowA, WV_, lds);
        ITS_E(24); ITS_B();
        idx_select(keyB, b3, jlim, hist, lane, mrowB, WV_, lds);
        ITS_E(25); ITS_B();
        __syncthreads();
    }
}

constexpr int MG_P = 72;
constexpr int MG_TILE_BYTES = 128 * MG_P * 2;
__device__ void merge_fast_phase(int WV_, const unsigned char* G8, const bf16* ys, const bf16* wbt  , bf16* merged, unsigned char* lds) {
    const int tid = LTID(WV_), lane = tid & 63, wave = tid >> 6, r32 = lane & 31, hi = lane >> 5, wt = wave & 3, wd = wave >> 2;
    const int srow0 = tid >> 3, sch = tid & 7;
    for (int tile = LBID(); tile < 1024; tile += LGRID()) {
        const int tok0 = (tile >> 3) * 128, d0 = (tile & 7) * 128;
        f32x16_t mer[2], acc[2];
#pragma unroll
        for (int r = 0; r < 16; ++r) { mer[0][r] = 0.f; mer[1][r] = 0.f; acc[0][r] = 0.f; acc[1][r] = 0.f; }
        uint4 RW00, RW01, RW10, RW11, RY00, RY01, RY10, RY11, RG0, RG1;
        unsigned char* gl = lds + 4 * MG_TILE_BYTES;
        const int grow = tid >> 3, gch = tid & 7;
#define MG_GLOAD(st_, R_) do { const int n_ = (st_) >> 2, kc_ = (st_) & 3; \
            RW##R_##0 = *(const uint4*)(wbt + ((size_t)n_ * 1024 + d0 + srow0) * 256 + kc_ * 64 + sch * 8); \
            RW##R_##1 = *(const uint4*)(wbt + ((size_t)n_ * 1024 + d0 + srow0 + 64) * 256 + kc_ * 64 + sch * 8); \
            RY##R_##0 = *(const uint4*)(ys + (size_t)(tok0 + srow0) * 1024 + n_ * 256 + kc_ * 64 + sch * 8); \
            RY##R_##1 = *(const uint4*)(ys + (size_t)(tok0 + srow0 + 64) * 1024 + n_ * 256 + kc_ * 64 + sch * 8); } while (0)
#define MG_SSTORE(buf_, R_) do { bf16* wl_ = (bf16*)(lds + (buf_) * 2 * MG_TILE_BYTES); bf16* yl_ = (bf16*)(lds + (buf_) * 2 * MG_TILE_BYTES + MG_TILE_BYTES); \
            *(uint4*)(wl_ + srow0 * MG_P + sch * 8) = RW##R_##0; *(uint4*)(wl_ + (srow0 + 64) * MG_P + sch * 8) = RW##R_##1; \
            *(uint4*)(yl_ + srow0 * MG_P + sch * 8) = RY##R_##0; *(uint4*)(yl_ + (srow0 + 64) * MG_P + sch * 8) = RY##R_##1; } while (0)
        __syncthreads();
        MG_GLOAD(0, 0); MG_GLOAD(1, 1);
        MG_SSTORE(0, 0);
        __syncthreads();
#define MG_STAGE(PAR_, OTH_) do { const int buf = PAR_; \
            if (st + 2 < 16) MG_GLOAD(st + 2, PAR_); \
            if ((st & 3) == 1) { const unsigned char* gsrc = G8 + (size_t)(tok0 + grow) * 4096 + (st >> 2) * 1024 + d0 + gch * 16; \
                RG0 = *(const uint4*)gsrc; RG1 = *(const uint4*)(gsrc + (size_t)64 * 4096); } \
            const bf16* wl = (const bf16*)(lds + buf * 2 * MG_TILE_BYTES); const bf16* yl = (const bf16*)(lds + buf * 2 * MG_TILE_BYTES + MG_TILE_BYTES); \
            _Pragma("unroll") for (int ks = 0; ks < 4; ++ks) { \
                const bf16x8_t bq = *(const bf16x8_t*)(yl + (32 * wt + r32) * MG_P + 16 * ks + 8 * hi); \
                const bf16x8_t a0 = *(const bf16x8_t*)(wl + (64 * wd + r32) * MG_P + 16 * ks + 8 * hi); \
                const bf16x8_t a1 = *(const bf16x8_t*)(wl + (64 * wd + 32 + r32) * MG_P + 16 * ks + 8 * hi); \
                acc[0] = __builtin_amdgcn_mfma_f32_32x32x16_bf16(a0, bq, acc[0], 0, 0, 0); \
                acc[1] = __builtin_amdgcn_mfma_f32_32x32x16_bf16(a1, bq, acc[1], 0, 0, 0); } \
            if ((st & 3) == 3) { \
                const int n = st >> 2; \
                const unsigned char* gp = gl + (32 * wt + r32) * 144 + 64 * wd + 4 * hi; (void)n; \
                _Pragma("unroll") for (int dt = 0; dt < 2; ++dt) \
                _Pragma("unroll") for (int g = 0; g < 4; ++g) { \
                        const int gv = *(const int*)(gp + 32 * dt + 8 * g); \
                        mer[dt][4 * g + 0] += acc[dt][4 * g + 0] * __builtin_amdgcn_cvt_f32_fp8(gv, 0); \
                        mer[dt][4 * g + 1] += acc[dt][4 * g + 1] * __builtin_amdgcn_cvt_f32_fp8(gv, 1); \
                        mer[dt][4 * g + 2] += acc[dt][4 * g + 2] * __builtin_amdgcn_cvt_f32_fp8(gv, 2); \
                        mer[dt][4 * g + 3] += acc[dt][4 * g + 3] * __builtin_amdgcn_cvt_f32_fp8(gv, 3); } \
                _Pragma("unroll") for (int r = 0; r < 16; ++r) { acc[0][r] = 0.f; acc[1][r] = 0.f; } } \
            if (st + 1 < 16) MG_SSTORE(OTH_, OTH_); \
            if ((st & 3) == 2) { *(uint4*)(gl + grow * 144 + gch * 16) = RG0; *(uint4*)(gl + (grow + 64) * 144 + gch * 16) = RG1; } \
            __syncthreads(); } while (0)
#pragma unroll 1
        for (int st2 = 0; st2 < 16; st2 += 2) { { const int st = st2; MG_STAGE(0, 1); } { const int st = st2 + 1; MG_STAGE(1, 0); } }
#undef MG_STAGE
#undef MG_GLOAD
#undef MG_SSTORE
        bf16* mp = merged + (size_t)(tok0 + 32 * wt + r32) * 1024 + d0 + 64 * wd + 4 * hi;
#pragma unroll
        for (int dt = 0; dt < 2; ++dt)
#pragma unroll
            for (int g = 0; g < 4; ++g)
                *(uint2*)(mp + 32 * dt + 8 * g) = make_uint2(cvtpk(mer[dt][4 * g], mer[dt][4 * g + 1]), cvtpk(mer[dt][4 * g + 2], mer[dt][4 * g + 3]));
    }
}
#define LAS __attribute__((address_space(3)))
#define XB_TMO      128
#define XB_XCNT(j)  (256  + 64 * (j))
#define XB_XSUB(j)  (1280 + 64 * (j))
#define XB_XGEN(j)  (2304 + 64 * (j))
#define XB_TOP      3328
#define XB_TOPGEN   3392
#define XCD_BAR_WORDS 3456
#define XB_SPIN_CAP (1u << 18)

__device__ __forceinline__ unsigned xb_ld(unsigned* p)              { return __hip_atomic_load(p, __ATOMIC_RELAXED, __HIP_MEMORY_SCOPE_AGENT); }
__device__ __forceinline__ unsigned xb_add(unsigned* p, unsigned v) { return __hip_atomic_fetch_add(p, v, __ATOMIC_RELAXED, __HIP_MEMORY_SCOPE_AGENT); }
__device__ __forceinline__ unsigned xb_xcc_id() { return (unsigned)__builtin_amdgcn_s_getreg((3 << 11) | 20) & 0xFu; }
#define XB_SPIN(cond, bar) do { unsigned _sp = 0; while (cond) { __builtin_amdgcn_s_sleep(1); \
    if ((++_sp & 255u) == 0u) { if (xb_ld(&(bar)[XB_TMO])) break; if (_sp > XB_SPIN_CAP) { atomicAdd(&(bar)[XB_TMO], 1u); break; } } } } while (0)

struct XcdBarrier {
    unsigned* bar; unsigned x;
    volatile LAS unsigned* st;
};

__device__ __forceinline__ XcdBarrier xcd_barrier_post(unsigned* bar, volatile LAS unsigned* st) {
    XcdBarrier b; b.bar = bar; b.x = xb_xcc_id(); b.st = st;
    if (threadIdx.x == 0) (void)xb_add(&bar[XB_XCNT(b.x)], 1u);
    return b;
}
__device__ __forceinline__ void xcd_barrier_complete(unsigned* bar, unsigned x, unsigned& nloc, unsigned& nx) {
    const unsigned G = gridDim.x * gridDim.y * gridDim.z;
    unsigned sum, cnt, mine, sp = 0u;
    for (;;) {
        sum = 0u; cnt = 0u; mine = 0u;
#pragma unroll
        for (unsigned j = 0; j < 16; ++j) { const unsigned c = xb_ld(&bar[XB_XCNT(j)]); sum += c; cnt += (c > 0u) ? 1u : 0u; mine = (j == x) ? c : mine; }
        if (sum == G) break;
        __builtin_amdgcn_s_sleep(1);
        if ((++sp & 255u) == 0u) { if (xb_ld(&bar[XB_TMO])) break; if (sp > XB_SPIN_CAP) { atomicAdd(&bar[XB_TMO], 1u); break; } }
    }
    nloc = mine > 0u ? mine : 1u; nx = cnt > 0u ? cnt : 1u;
}

__device__ __forceinline__ void xcd_barrier(const XcdBarrier& b, int wv_) {
    asm volatile("s_waitcnt vmcnt(0)" ::: "memory");
    __syncthreads();
    if (wv_ == 0 && LANEID() == 0) {
        unsigned* bar = b.bar;
        __builtin_amdgcn_s_waitcnt(0);
        unsigned nloc = b.st[0], nx = b.st[1];
        if (nloc == 0u) { xcd_barrier_complete(bar, b.x, nloc, nx); b.st[0] = nloc; b.st[1] = nx; }
        const unsigned old = xb_add(&bar[XB_XSUB(b.x)], 1u);
        const unsigned gen = old / nloc;
        if (old + 1u == (gen + 1u) * nloc) {
            __builtin_amdgcn_fence(__ATOMIC_RELEASE, "agent");
            asm volatile("s_waitcnt vmcnt(0)" ::: "memory");
            const unsigned og = xb_add(&bar[XB_TOP], 1u);
            const unsigned tg = og / nx;
            if (og + 1u == (tg + 1u) * nx) xb_add(&bar[XB_TOPGEN], 1u);
            else XB_SPIN(xb_ld(&bar[XB_TOPGEN]) == tg, bar);
            __builtin_amdgcn_fence(__ATOMIC_ACQUIRE, "agent");
            xb_add(&bar[XB_XGEN(b.x)], 1u);
            asm volatile("s_waitcnt vmcnt(0)" ::: "memory");
        } else {
            XB_SPIN(xb_ld(&bar[XB_XGEN(b.x)]) == gen, bar);
            __builtin_amdgcn_fence(__ATOMIC_ACQUIRE, "agent");
            asm volatile("s_waitcnt vmcnt(0)" ::: "memory");
        }
    }
    __syncthreads();
}

enum { PH_PRO = 0, PH_GIN, PH_INDEX, PH_ATTN, PH_MERGE, PH_GOUT, PH_LN1, PH_GQ, PH_ROUTE, PH_PEER };
template <int PH> __device__ __forceinline__ void run_phase(int WV_, const Params& p_unused, int l, unsigned char* lds_raw) {
    size_t kaoff_ = 0; asm volatile("" : "+s"(kaoff_));
    typedef const __attribute__((address_space(4))) char* kaptr_t;
    const __attribute__((address_space(4))) Params& p = *(const __attribute__((address_space(4))) Params*)((kaptr_t)__builtin_amdgcn_kernarg_segment_ptr() + kaoff_);
    float* sm = (float*)lds_raw;
    size_t wsoff_ = 0; asm volatile("" : "+s"(wsoff_));
    unsigned char* ws = p.ws + wsoff_;
    float* hbuf = p.out;
    bf16* hb = (bf16*)(ws + WS_HB);
    bf16* P = (bf16*)(ws + WS_P);
    bf16* ys = (bf16*)(ws + WS_YS);
    bf16* mrg = (bf16*)(ws + WS_MRG);
    float* mix = (float*)(ws + WS_MIX);
    float* qb = (float*)(ws + WS_Q);
    unsigned char* mask = ws + WS_MASK;
    int* eid = (int*)(ws + WS_EID);
    float* gate = (float*)(ws + WS_GATE);
    float* kmean = (float*)(ws + WS_KMEAN);
    const float* hin = (l == 0) ? p.in[0] : hbuf;
    if (PH == PH_PRO) { Params pc; for (int i = 0; i < 13; ++i) pc.in[i] = p.in[i]; pc.out = p.out; pc.ws = ws;
        prologue_phase(WV_, pc, sm); convert_tables(WV_, pc);
        for (int i = LBID() * NTHR + LTID(WV_); i < DEPTH_ * 8 * 2 * 128 * 64 / 4; i += LGRID() * NTHR) { const float4 v = ((const float4*)p.in[8])[i]; ((uint2*)(ws + WS_SKB))[i] = make_uint2(pk2(v.x, v.y), pk2(v.z, v.w)); } if (LBID() < 2) build_unit_table((unsigned*)(ws + WS_CTL) + 1024, LBID() * NTHR + LTID(WV_)); }
    else if (PH == PH_GIN) {
        pg8::Gemm g{hb, (const bf16*)(ws + WS_WIN_T + l * WIN_T_BYTES), T_, NP, 1024};
        pg8::StaticOrder S; S.init(T_, NP, (int)LGRID(), (int)LBID());
        pg8::EpiBf16Sig E{P, NP, C_G, ws + WS_G8};
        pg8::gemm_phase<pg8::EpiBf16Sig, pg8::StaticOrder, true, true>(WV_, (PG8_LAS unsigned char*)lds_raw, g, S, E);
    }
    else if (PH == PH_INDEX) index_fast_phase(WV_, P, mask, kmean, (float*)(ws + WS_UV + 48 * MiB), (unsigned*)(ws + WS_CTL) + 64 * l + 16, lds_raw);
    else if (PH == PH_ATTN) attn_fast_phase(WV_, P, mask, kmean, p.in[4] + l * 4, ys, (const unsigned*)(ws + WS_CTL) + 1024, (unsigned*)(ws + WS_CTL) + 64 * l, lds_raw);
    else if (PH == PH_MERGE) merge_fast_phase(WV_, ws + WS_G8, ys, (const bf16*)(ws + WS_WBR_T) + (size_t)l * 4 * 1024 * 256, mrg, lds_raw);
    else if (PH == PH_GOUT) {
        pg8::Gemm g{mrg, (const bf16*)(ws + WS_WOUT_T) + (size_t)l * 1024 * 1024, T_, 1024, 1024};
        pg8::StaticOrder S; S.init(T_, 1024, (int)LGRID(), (int)LBID());
        pg8::EpiResY E{l == 0 ? hin : nullptr, hb, hb, (float*)(ws + WS_STATS) + (size_t)l * T_ * 2, ALPHA};
        pg8::gemm_phase<pg8::EpiResY, pg8::StaticOrder, true, true>(WV_, (PG8_LAS unsigned char*)lds_raw, g, S, E);
    }
    else if (PH == PH_GQ) {
        pg8::Gemm g{hb, (const bf16*)(ws + WS_WQ_T) + (size_t)l * 1024 * 1024, T_, 1024, 1024};
        pg8::StaticOrder S; S.init(T_, 1024, (int)LGRID(), (int)LBID());
        pg8::EpiLnFold E{(bf16*)qb, (const float*)(ws + WS_STATS) + (size_t)l * T_ * 2, (const float*)(ws + WS_COLS) + l * 2048, (const float*)(ws + WS_COLS) + l * 2048 + 1024, LN_EPS};
        pg8::gemm_phase<pg8::EpiLnFold, pg8::StaticOrder, true, true>(WV_, (PG8_LAS unsigned char*)lds_raw, g, S, E);
        pg8::Unit u0;
        if (LGRID() == 256 && S.next(0, u0)) {
            asm volatile("s_waitcnt vmcnt(0)" ::: "memory"); __syncthreads();
            route_fast_phase(WV_, (const bf16*)qb, (const bf16*)(ws + WS_SKB) + (size_t)l * 8 * 2 * 128 * 64, eid, gate, lds_raw, u0.pm, u0.pn);
        }
    }
    else if (PH == PH_ROUTE) { if (LGRID() != 256) route_fast_phase(WV_, (const bf16*)qb, (const bf16*)(ws + WS_SKB) + (size_t)l * 8 * 2 * 128 * 64, eid, gate, lds_raw); }
    else peer_fast_phase(WV_, (l + 1 == DEPTH_) ? hbuf : nullptr, hb, eid, gate, ws + WS_UV + (size_t)l * 24 * MiB, p.in[5] + l * 1024, p.in[6] + l * 1024, p.in[11] + l * 1024, p.in[12] + l * 1024, lds_raw);
}

constexpr int CW_BAR = 4096;
constexpr int LDS_BARST = LDS_BYTES - 16;
__global__ void __launch_bounds__(NTHR, 2) mk_fwd(Params p) {
    extern __shared__ __attribute__((aligned(16))) unsigned char lds_raw[];
    cg::grid_group grid = cg::this_grid();
    const int WV_ = __builtin_amdgcn_readfirstlane((int)threadIdx.x >> 6);
    { volatile LAS unsigned* bst0 = (volatile LAS unsigned*)((LAS unsigned char*)lds_raw + LDS_BARST); if (threadIdx.x < 4) bst0[threadIdx.x] = 0u; }
    __syncthreads();
    volatile LAS unsigned* bst = (volatile LAS unsigned*)((LAS unsigned char*)lds_raw + LDS_BARST);
    { uint4* z = (uint4*)p.ws; const uint4 z4 = make_uint4(0u, 0u, 0u, 0u);
      for (unsigned i = (unsigned)LBID() * NTHR + (unsigned)LTID(WV_); i < (unsigned)(2 * MiB / 16); i += (unsigned)LGRID() * NTHR) z[i] = z4; }
    grid.sync();
    (void)xcd_barrier_post((unsigned*)(p.ws + WS_CTL) + CW_BAR, bst);
#define GRID_BAR() do { XcdBarrier b_; b_.bar = (unsigned*)(p.ws + WS_CTL) + CW_BAR; b_.x = xb_xcc_id(); b_.st = (volatile LAS unsigned*)((LAS unsigned char*)lds_raw + LDS_BARST); xcd_barrier(b_, WV_); } while (0)
    run_phase<PH_PRO>(WV_, p, 0, lds_raw);
    GRID_BAR();
#pragma unroll 1
    for (int l = 0; l < DEPTH_; ++l) {
        run_phase<PH_GIN>(WV_, p, l, lds_raw); GRID_BAR();
        run_phase<PH_INDEX>(WV_, p, l, lds_raw); GRID_BAR();
        run_phase<PH_ATTN>(WV_, p, l, lds_raw); GRID_BAR();
        run_phase<PH_MERGE>(WV_, p, l, lds_raw); GRID_BAR();
        run_phase<PH_GOUT>(WV_, p, l, lds_raw); GRID_BAR();
        run_phase<PH_GQ>(WV_, p, l, lds_raw); if (LGRID() != 256) { GRID_BAR(); run_phase<PH_ROUTE>(WV_, p, l, lds_raw); } GRID_BAR();
        run_phase<PH_PEER>(WV_, p, l, lds_raw); if (l + 1 < DEPTH_) GRID_BAR();
    }
}

extern "C" void kernel_launch(void* const* d_in, const int* in_sizes, int n_in, void* d_out, int out_size, void* d_ws, size_t ws_size, hipStream_t stream) {
    if (n_in != 13 || ws_size < WS_END) { fprintf(stderr, "kernel_launch: unexpected n_in %d / ws_size %zu; nothing launched\n", n_in, ws_size); return; }
    static int grid_blocks = 0;
    if (grid_blocks == 0) {
        int dev = 0, cus = 0, per_cu = 0;
        (void)hipGetDevice(&dev);
        (void)hipDeviceGetAttribute(&cus, hipDeviceAttributeMultiprocessorCount, dev);
        (void)hipFuncSetAttribute((const void*)mk_fwd, hipFuncAttributeMaxDynamicSharedMemorySize, LDS_BYTES);
        (void)hipOccupancyMaxActiveBlocksPerMultiprocessor(&per_cu, (const void*)mk_fwd, NTHR, LDS_BYTES);
        if (per_cu < 1) fprintf(stderr, "kernel_launch: occupancy query reports %d\n", per_cu);
        grid_blocks = cus;
    }
    Params p{};
    for (int i = 0; i < 13; ++i) p.in[i] = (const float*)d_in[i];
    p.out = (float*)d_out; p.ws = (unsigned char*)d_ws;
    void* args[] = {&p};
    hipError_t e = hipLaunchCooperativeKernel((const void*)mk_fwd, dim3(grid_blocks), dim3(NTHR), args, LDS_BYTES, stream);
    if (e != hipSuccess) fprintf(stderr, "cooperative launch failed: %s (grid %d)\n", hipGetErrorString(e), grid_blocks);
}
```

```cpp
#include <hip/hip_runtime.h>
#include <cstdio>
#include <cstdint>
#include <hip/hip_cooperative_groups.h>
namespace cg = cooperative_groups;

__device__ __forceinline__ int LANEID() { int l; asm volatile("v_mbcnt_lo_u32_b32 %0, -1, 0\n\tv_mbcnt_hi_u32_b32 %0, -1, %0" : "=v"(l)); return l; }
__device__ __forceinline__ int LTID(int wv) { return (wv << 6) | LANEID(); }
__device__ __forceinline__ int LBID() { int t = blockIdx.x; asm volatile("" : "+s"(t)); return t; }
__device__ __forceinline__ int LGRID() { int t = gridDim.x; asm volatile("" : "+s"(t)); return t; }
namespace pg8 {
#define PG8_LAS __attribute__((address_space(3)))
typedef unsigned short bf16_t;
typedef short bf16x8 __attribute__((ext_vector_type(8)));
typedef float f32x4 __attribute__((ext_vector_type(4)));
typedef unsigned u32x4 __attribute__((ext_vector_type(4)));
constexpr int BM = 256, BK = 64, HALF = 128, HTB = HALF * BK * 2  , STAGE_BYTES = 8 * HTB, NXCD = 8, WGM = 8;

__host__ __device__ __forceinline__ int lds_byte(int r, int c) { const int st = (r >> 4) * 2 + (c >> 5), rr = r & 15, cc = c & 31, ob = rr * 64 + cc * 2; return st * 1024 + (ob ^ (((ob >> 9) & 1) << 5)); }
__host__ __device__ __forceinline__ void stage_rc(int b, int& R, int& C) { const int st = b / 1024, sb = b % 1024, swz = sb ^ (((sb >> 9) & 1) << 5); R = (st >> 1) * 16 + swz / 64; C = (st & 1) * 32 + (swz % 64) / 2; }
__host__ __device__ __forceinline__ int perm32(int rho) { const int n = rho >> 4, i = rho & 15; return 8 * (i >> 2) + 4 * n + (i & 3); }

struct Unit { int pm, pn; };
struct Gemm { const bf16_t* A; const bf16_t* Bt; int M, N, K; };

struct StaticOrder {
    int nM, nN, nwg, G, c;
    __host__ __device__ void init(int M, int N, int G_, int c_) { nM = M / BM; nN = N / BM; nwg = nM * nN; G = G_; c = c_; }
    __host__ __device__ bool next(int i, Unit& u) const {
        const long L = (long)i * G + c; if (L >= nwg) return false;
        int wgid = (int)L; { const int q = nwg / NXCD, r = nwg % NXCD, xcd = wgid % NXCD, off = wgid / NXCD; wgid = (xcd < r ? xcd * (q + 1) : r * (q + 1) + (xcd - r) * q) + off; }
        const int nig = WGM * nN, gid = wgid / nig, fm = gid * WGM, gsz = (nM - fm) < WGM ? (nM - fm) : WGM;
        u.pm = fm + ((wgid % nig) % gsz); u.pn = (wgid % nig) / gsz; return true;
    }
    __device__ __forceinline__ void a_ready(const Unit&) const {}
    __device__ __forceinline__ void done(const Unit&) const {}
};

__device__ __forceinline__ unsigned cvt_pk_bf16(float lo, float hi) { unsigned r; asm volatile("v_cvt_pk_bf16_f32 %0, %1, %2" : "=v"(r) : "v"(lo), "v"(hi)); return r; }
typedef float f32x2 __attribute__((ext_vector_type(2)));
__device__ __forceinline__ f32x2 gelu_pk(f32x2 v) {
    const f32x2 av = __builtin_elementwise_abs(v), d = av * 0.2316418882f + 1.0f;
    f32x2 t; t.x = __builtin_amdgcn_rcpf(d.x); t.y = __builtin_amdgcn_rcpf(d.y);
    f32x2 q = t * 0.5307027145f + (-0.7265760135f); q = q * t + 0.7107068705f; q = q * t + (-0.142248368f); q = q * t + 0.127414796f; q = q * t;
    const f32x2 s = (v * v) * (-0.72134752044f);
    f32x2 e; e.x = __builtin_amdgcn_exp2f(s.x); e.y = __builtin_amdgcn_exp2f(s.y);
    const f32x2 m = v * (q * e), r = v - m;
    f32x2 o; o.x = v.x < 0.f ? m.x : r.x; o.y = v.y < 0.f ? m.y : r.y; return o;
}

template <int ACT  > struct EpiBf16 {
    static constexpr bool PERM = true, AFTER_DRAIN = false; static_assert(ACT == 0 || ACT == 1, "EpiBf16: ACT is 0 (none) or 1 (gelu_pk)");
    bf16_t* O; int ldc; const float* bias; int split_cols; size_t split_stride; float scale0;
    __device__ __forceinline__ void operator()(const f32x4 (&acc)[2][2][4][2], const Unit& u, int wr, int wc, int fr, int fq) const {
        { int ln_ = LANEID(); asm volatile("" : "+v"(ln_)); fr = ln_ & 15; fq = ln_ >> 4; }
        const int row0 = u.pm * BM + wr * 64 + fr; int colt = u.pn * BM; bf16_t* base = O;
        float sc = 1.f; if (split_cols) { const int t = colt / split_cols; base += (size_t)t * split_stride; colt -= t * split_cols; if (t == 0) sc = scale0; }
        const int col0 = colt + wc * 32 + 8 * fq, bcol0 = u.pn * BM + wc * 32 + 8 * fq;
        f32x4 bv[2][2];
#pragma unroll
        for (int bj = 0; bj < 2; ++bj)
#pragma unroll
            for (int n = 0; n < 2; ++n) bv[bj][n] = bias ? *(const f32x4*)(bias + bcol0 + bj * HALF + 4 * n) : (f32x4){0.f, 0.f, 0.f, 0.f};
#pragma unroll
        for (int ai = 0; ai < 2; ++ai)
#pragma unroll
            for (int m = 0; m < 4; ++m) { bf16_t* rowp = base + (size_t)(row0 + ai * HALF + m * 16) * ldc + col0;
#pragma unroll
                for (int bj = 0; bj < 2; ++bj) { f32x4 v0 = acc[ai][bj][m][0] + bv[bj][0], v1 = acc[ai][bj][m][1] + bv[bj][1];
                    if (ACT == 1) { f32x2 a = gelu_pk((f32x2){v0[0], v0[1]}), b = gelu_pk((f32x2){v0[2], v0[3]}), c = gelu_pk((f32x2){v1[0], v1[1]}), d = gelu_pk((f32x2){v1[2], v1[3]});
                        v0 = (f32x4){a.x, a.y, b.x, b.y}; v1 = (f32x4){c.x, c.y, d.x, d.y}; }
                    v0 = v0 * sc; v1 = v1 * sc; u32x4 w; w.x = cvt_pk_bf16(v0[0], v0[1]); w.y = cvt_pk_bf16(v0[2], v0[3]); w.z = cvt_pk_bf16(v1[0], v1[1]); w.w = cvt_pk_bf16(v1[2], v1[3]);
                    *(u32x4*)(rowp + bj * HALF) = w; } }
    }
};
template <class Epi, class Sched, bool ALIGN_EPI = false, bool SP2 = false>
__device__ __forceinline__ void gemm_phase(int WV_, PG8_LAS unsigned char* lds, const Gemm g, const Sched& S, const Epi& E) {
    const int tid = LTID(WV_), wid = __builtin_amdgcn_readfirstlane(tid >> 6), lane = tid & 63, wr = wid >> 2, wc = wid & 3, fr = lane & 15, fq = lane >> 4;
    const int K = g.K, nt = K / BK;
    unsigned voffA[2], voffB[2];
#pragma unroll
    for (int i = 0; i < 2; ++i) { int R, C; stage_rc(tid * 16 + i * 8192, R, C); const int Rb = Epi::PERM ? ((R & ~31) + perm32(R & 31)) : R;
        voffA[i] = (unsigned)(R * K + C) * 2u; voffB[i] = (unsigned)(Rb * K + C) * 2u; }
    const size_t kstep = (size_t)(BK * 2);
    const size_t hstep = (size_t)HALF * K * 2;
    const size_t tstep = 2 * hstep;
    const unsigned ldsw = (unsigned)wid * 1024u;
    const int aoff = lds_byte(wr * 64 + fr, fq * 8), boff = lds_byte(wc * 32 + fr, fq * 8);
#define PG8_SA(b, h) (((b) * 2 + (h)) * HTB)
#define PG8_SB(b, h) ((4 + (b) * 2 + (h)) * HTB)
#define PG8_STAGE(bufoff, gbase, voff) do { _Pragma("unroll") for (int _i = 0; _i < 2; ++_i) \
        __builtin_amdgcn_global_load_lds((const unsigned*)((const char*)(gbase) + (voff)[_i]), (PG8_LAS unsigned*)(lds + (bufoff) + ldsw + _i * 8192), 16, 0, 0); } while (0)
#define PG8_LDA(dst, b, h) do { _Pragma("unroll") for (int m = 0; m < 4; ++m) _Pragma("unroll") for (int k = 0; k < 2; ++k) dst[m][k] = *(const PG8_LAS bf16x8*)(lds + PG8_SA(b, h) + aoff + m * 2048 + k * 1024); } while (0)
#define PG8_LDB(dst, b, h) do { _Pragma("unroll") for (int n = 0; n < 2; ++n) _Pragma("unroll") for (int k = 0; k < 2; ++k) dst[n][k] = *(const PG8_LAS bf16x8*)(lds + PG8_SB(b, h) + boff + n * 2048 + k * 1024); } while (0)
#define PG8_MMA(ai, bj, At, Bt) do { __builtin_amdgcn_s_setprio(1); _Pragma("unroll") for (int m = 0; m < 4; ++m) _Pragma("unroll") for (int n = 0; n < 2; ++n) _Pragma("unroll") for (int k = 0; k < 2; ++k) \
        acc[ai][bj][m][n] = __builtin_amdgcn_mfma_f32_16x16x32_bf16(Bt[n][k], At[m][k], acc[ai][bj][m][n], 0, 0, 0); __builtin_amdgcn_s_setprio(0); } while (0)
#define PG8_WAIT_V(n) asm volatile("s_waitcnt vmcnt(" #n ")" ::: "memory")
#define PG8_WAIT_L(n) asm volatile("s_waitcnt lgkmcnt(" #n ")" ::: "memory")
#define PG8_BAR __builtin_amdgcn_s_barrier()
#define PG8_SCHED __builtin_amdgcn_sched_barrier(0)
    Unit cur, nxt; int ui = 0;
    if (!S.next(0, cur)) return;
    f32x4 acc[2][2][4][2];
#pragma unroll
    for (int a = 0; a < 2; ++a)
#pragma unroll
        for (int b = 0; b < 2; ++b)
#pragma unroll
            for (int m = 0; m < 4; ++m)
#pragma unroll
                for (int n = 0; n < 2; ++n) acc[a][b][m][n] = (f32x4){0.f, 0.f, 0.f, 0.f};
    bf16x8 At[4][2], B0[2][2], B1[2][2];
    const char* cA = (const char*)g.A + (size_t)cur.pm * tstep; const char* cB = (const char*)g.Bt + (size_t)cur.pn * tstep;
    S.a_ready(cur);
    if constexpr (SP2) {
        PG8_STAGE(PG8_SB(0, 0), cB, voffB); PG8_STAGE(PG8_SB(0, 1), cB + hstep, voffB); PG8_STAGE(PG8_SA(0, 0), cA, voffA); PG8_STAGE(PG8_SA(0, 1), cA + hstep, voffA);
        if (wr == 1) PG8_BAR;
        PG8_WAIT_V(2); PG8_BAR;
        PG8_STAGE(PG8_SB(1, 0), cB + kstep, voffB); PG8_STAGE(PG8_SA(1, 0), cA + kstep, voffA); PG8_STAGE(PG8_SB(1, 1), cB + hstep + kstep, voffB);
        PG8_WAIT_V(6); PG8_BAR;
    } else {
        PG8_STAGE(PG8_SB(0, 0), cB, voffB); PG8_STAGE(PG8_SA(0, 0), cA, voffA); PG8_STAGE(PG8_SB(0, 1), cB + hstep, voffB); PG8_STAGE(PG8_SA(0, 1), cA + hstep, voffA);
        if (wr == 1) PG8_BAR;
        PG8_WAIT_V(4); PG8_BAR;
        PG8_STAGE(PG8_SB(1, 0), cB + kstep, voffB); PG8_STAGE(PG8_SA(1, 0), cA + kstep, voffA); PG8_STAGE(PG8_SB(1, 1), cB + hstep + kstep, voffB);
        PG8_WAIT_V(6); PG8_BAR;
    }
    for (;;) {
        const bool has_next = S.next(ui + 1, nxt);
        const char* nA = has_next ? (const char*)g.A + (size_t)nxt.pm * tstep : cA; const char* nB = has_next ? (const char*)g.Bt + (size_t)nxt.pn * tstep : cB;
        for (int t = 0; t < nt; t += 2) {
            const bool last = (t == nt - 2);
            const char* a1 = cA + (size_t)(t + 1) * kstep;
            const char* a2 = last ? nA : cA + (size_t)(t + 2) * kstep; const char* b2 = last ? nB : cB + (size_t)(t + 2) * kstep;
            const char* a3 = a2 + kstep; const char* b3 = b2 + kstep;
            if (last && has_next) S.a_ready(nxt);
            if constexpr (SP2) {
            PG8_LDB(B0, 0, 0); PG8_LDB(B1, 0, 1); PG8_SCHED; PG8_LDA(At, 0, 0); PG8_STAGE(PG8_SA(1, 1), a1 + hstep, voffA);
            PG8_WAIT_V(8); PG8_WAIT_L(0); PG8_BAR; PG8_MMA(0, 0, At, B0); PG8_MMA(0, 1, At, B1); PG8_BAR; PG8_SCHED;
            PG8_LDA(At, 0, 1); PG8_STAGE(PG8_SB(0, 0), b2, voffB); PG8_STAGE(PG8_SB(0, 1), b2 + hstep, voffB); PG8_STAGE(PG8_SA(0, 0), a2, voffA);
            PG8_WAIT_V(8); PG8_WAIT_L(0); PG8_BAR; PG8_MMA(1, 0, At, B0); PG8_MMA(1, 1, At, B1); PG8_BAR; PG8_SCHED;
            PG8_LDB(B0, 1, 0); PG8_LDB(B1, 1, 1); PG8_SCHED; PG8_LDA(At, 1, 0); PG8_STAGE(PG8_SA(0, 1), a2 + hstep, voffA);
            PG8_WAIT_V(8); PG8_WAIT_L(0); PG8_BAR; PG8_MMA(0, 0, At, B0); PG8_MMA(0, 1, At, B1); PG8_BAR; PG8_SCHED;
            PG8_LDA(At, 1, 1); PG8_STAGE(PG8_SB(1, 0), b3, voffB); PG8_STAGE(PG8_SB(1, 1), b3 + hstep, voffB); PG8_STAGE(PG8_SA(1, 0), a3, voffA);
            PG8_WAIT_V(8); PG8_WAIT_L(0); PG8_BAR; PG8_MMA(1, 0, At, B0); PG8_MMA(1, 1, At, B1); PG8_BAR; PG8_SCHED;
            } else {
            PG8_LDB(B0, 0, 0); PG8_SCHED; PG8_LDA(At, 0, 0); PG8_STAGE(PG8_SA(1, 1), a1 + hstep, voffA);
            PG8_WAIT_L(8); PG8_BAR; PG8_WAIT_L(0); PG8_MMA(0, 0, At, B0); PG8_BAR; PG8_SCHED;
            PG8_LDB(B1, 0, 1); PG8_STAGE(PG8_SB(0, 0), b2, voffB);
            PG8_BAR; PG8_WAIT_L(0); PG8_MMA(0, 1, At, B1); PG8_BAR;
            PG8_LDA(At, 0, 1); PG8_STAGE(PG8_SA(0, 0), a2, voffA);
            PG8_BAR; PG8_WAIT_L(0); PG8_MMA(1, 0, At, B0); PG8_BAR; PG8_SCHED;
            PG8_STAGE(PG8_SB(0, 1), b2 + hstep, voffB);
            PG8_WAIT_V(6); PG8_BAR; PG8_MMA(1, 1, At, B1); PG8_BAR;
            PG8_LDB(B0, 1, 0); PG8_SCHED; PG8_LDA(At, 1, 0); PG8_STAGE(PG8_SA(0, 1), a2 + hstep, voffA);
            PG8_WAIT_L(8); PG8_BAR; PG8_WAIT_L(0); PG8_MMA(0, 0, At, B0); PG8_BAR; PG8_SCHED;
            PG8_LDB(B1, 1, 1); PG8_STAGE(PG8_SB(1, 0), b3, voffB);
            PG8_BAR; PG8_WAIT_L(0); PG8_MMA(0, 1, At, B1); PG8_BAR;
            PG8_LDA(At, 1, 1); PG8_STAGE(PG8_SA(1, 0), a3, voffA);
            PG8_BAR; PG8_WAIT_L(0); PG8_MMA(1, 0, At, B0); PG8_BAR; PG8_SCHED;
            PG8_STAGE(PG8_SB(1, 1), b3 + hstep, voffB);
            PG8_WAIT_V(6); PG8_BAR; PG8_MMA(1, 1, At, B1); PG8_BAR;
            }
        }
        if constexpr (ALIGN_EPI) { if (wr == 0) PG8_BAR; }
        if constexpr (!Epi::AFTER_DRAIN) { E(acc, cur, wr, wc, fr, fq); S.done(cur); }
        if (!has_next) break;
#pragma unroll
        for (int a = 0; a < 2; ++a)
#pragma unroll
            for (int b = 0; b < 2; ++b)
#pragma unroll
                for (int m = 0; m < 4; ++m)
#pragma unroll
                    for (int n = 0; n < 2; ++n) acc[a][b][m][n] = (f32x4){0.f, 0.f, 0.f, 0.f};
        cur = nxt; cA = nA; cB = nB; ++ui;
        if constexpr (ALIGN_EPI) { if (wr == 1) PG8_BAR; }
    }
    PG8_WAIT_V(0);
    if constexpr (!ALIGN_EPI) { if (wr == 0) PG8_BAR; }
    PG8_BAR;
    if constexpr (Epi::AFTER_DRAIN) { E.fused(acc, cur, wr, wc, fr, fq, lds, wid, lane); S.done(cur); }
#undef PG8_SA
#undef PG8_SB
#undef PG8_STAGE
#undef PG8_LDA
#undef PG8_LDB
#undef PG8_MMA
#undef PG8_WAIT_V
#undef PG8_WAIT_L
#undef PG8_BAR
#undef PG8_SCHED
}
}
namespace pg8 {
struct EpiF32 {
    static constexpr bool PERM = false, AFTER_DRAIN = false;
    float* O; int ldc;
    __device__ __forceinline__ void operator()(const f32x4 (&acc)[2][2][4][2], const Unit& u, int wr, int wc, int fr, int fq) const {
        { int ln_ = LANEID(); asm volatile("" : "+v"(ln_)); fr = ln_ & 15; fq = ln_ >> 4; }
        const int row0 = u.pm * BM + wr * 64 + fr, col0 = u.pn * BM + wc * 32 + 4 * fq;
#pragma unroll
        for (int ai = 0; ai < 2; ++ai)
#pragma unroll
            for (int m = 0; m < 4; ++m) { float* rowp = O + (size_t)(row0 + ai * HALF + m * 16) * ldc + col0;
#pragma unroll
                for (int bj = 0; bj < 2; ++bj)
#pragma unroll
                    for (int n = 0; n < 2; ++n) *(f32x4*)(rowp + bj * HALF + n * 16) = acc[ai][bj][m][n]; }
    }
};
struct EpiResY {
    static constexpr bool PERM = false, AFTER_DRAIN = false;
    const float* hin; const bf16_t* hinb; bf16_t* yb; float* stats; float alpha;
    __device__ __forceinline__ void operator()(const f32x4 (&acc)[2][2][4][2], const Unit& u, int wr, int wc, int fr, int fq) const {
        { int ln_ = LANEID(); asm volatile("" : "+v"(ln_)); fr = ln_ & 15; fq = ln_ >> 4; }
        const int row0 = u.pm * BM + wr * 64 + fr, col0 = u.pn * BM + wc * 32 + 4 * fq;
#pragma unroll
        for (int ai = 0; ai < 2; ++ai)
#pragma unroll
            for (int m = 0; m < 4; ++m) {
                const int row = row0 + ai * HALF + m * 16;
                float s = 0.f, s2 = 0.f;
#pragma unroll
                for (int bj = 0; bj < 2; ++bj)
#pragma unroll
                    for (int n = 0; n < 2; ++n) {
                        const size_t off = (size_t)row * 1024 + col0 + bj * HALF + n * 16;
                        f32x4 hv;
                        if (hin) hv = *(const f32x4*)(hin + off);
                        else { typedef unsigned u32x2r __attribute__((ext_vector_type(2))); const u32x2r hw = *(const u32x2r*)(hinb + off);
                            hv[0] = __uint_as_float(hw.x << 16); hv[1] = __uint_as_float(hw.x & 0xffff0000u); hv[2] = __uint_as_float(hw.y << 16); hv[3] = __uint_as_float(hw.y & 0xffff0000u); }
                        const f32x4 y = hv * alpha + acc[ai][bj][m][n];
                        typedef unsigned u32x2v __attribute__((ext_vector_type(2)));
                        u32x2v w; w.x = cvt_pk_bf16(y[0], y[1]); w.y = cvt_pk_bf16(y[2], y[3]);
                        *(u32x2v*)(yb + off) = w;
                        s += (y[0] + y[1]) + (y[2] + y[3]); s2 += (y[0] * y[0] + y[1] * y[1]) + (y[2] * y[2] + y[3] * y[3]);
                    }
                s += __shfl_xor(s, 16); s += __shfl_xor(s, 32); s2 += __shfl_xor(s2, 16); s2 += __shfl_xor(s2, 32);
                if (fq == 0) { atomicAdd(stats + 2 * (size_t)row, s); atomicAdd(stats + 2 * (size_t)row + 1, s2); }
            }
    }
};
struct EpiLnFold {
    static constexpr bool PERM = true, AFTER_DRAIN = false;
    bf16_t* O; const float* stats; const float* colsum; const float* colbias; float eps;
    __device__ __forceinline__ void operator()(const f32x4 (&acc)[2][2][4][2], const Unit& u, int wr, int wc, int fr, int fq) const {
        { int ln_ = LANEID(); asm volatile("" : "+v"(ln_)); fr = ln_ & 15; fq = ln_ >> 4; }
        const int row0 = u.pm * BM + wr * 64 + fr, col0 = u.pn * BM + wc * 32 + 8 * fq;
        f32x4 cs[2][2], cb[2][2];
#pragma unroll
        for (int bj = 0; bj < 2; ++bj)
#pragma unroll
            for (int n = 0; n < 2; ++n) { cs[bj][n] = *(const f32x4*)(colsum + col0 + bj * HALF + 4 * n); cb[bj][n] = *(const f32x4*)(colbias + col0 + bj * HALF + 4 * n); }
#pragma unroll
        for (int ai = 0; ai < 2; ++ai)
#pragma unroll
            for (int m = 0; m < 4; ++m) {
                const int row = row0 + ai * HALF + m * 16;
                const float sm_ = stats[2 * (size_t)row], sq_ = stats[2 * (size_t)row + 1];
                const float mean = sm_ * (1.0f / 1024.0f);
                const float rstd = 1.0f / sqrtf(fmaxf(sq_ * (1.0f / 1024.0f) - mean * mean, 0.f) + eps);
                bf16_t* rowp = O + (size_t)row * 1024 + col0;
#pragma unroll
                for (int bj = 0; bj < 2; ++bj) {
                    const f32x4 v0 = (acc[ai][bj][m][0] - cs[bj][0] * mean) * rstd + cb[bj][0], v1 = (acc[ai][bj][m][1] - cs[bj][1] * mean) * rstd + cb[bj][1];
                    u32x4 w; w.x = cvt_pk_bf16(v0[0], v0[1]); w.y = cvt_pk_bf16(v0[2], v0[3]); w.z = cvt_pk_bf16(v1[0], v1[1]); w.w = cvt_pk_bf16(v1[2], v1[3]);
                    *(u32x4*)(rowp + bj * HALF) = w;
                }
            }
    }
};
__device__ __forceinline__ unsigned cvt_pk_bf16_t(float lo, float hi) { unsigned r; asm volatile("s_nop 0\n\tv_cvt_pk_bf16_f32 %0, %1, %2" : "=v"(r) : "v"(lo), "v"(hi)); return r; }
struct EpiBf16Sig {
    static constexpr bool PERM = true, AFTER_DRAIN = false;
    bf16_t* O; int ldc; int sig_col0; unsigned char* G8;
    __device__ __forceinline__ void operator()(const f32x4 (&acc)[2][2][4][2], const Unit& u, int wr, int wc, int fr, int fq) const {
        { int ln_ = LANEID(); asm volatile("" : "+v"(ln_)); fr = ln_ & 15; fq = ln_ >> 4; }
        const int row0 = u.pm * BM + wr * 64 + fr; const int col0 = u.pn * BM + wc * 32 + 8 * fq;
#pragma unroll
        for (int bj = 0; bj < 2; ++bj) {
            if (col0 + bj * HALF >= sig_col0) {
                { const int gc = col0 + bj * HALF - sig_col0;
                  if (gc < 4096) {
#pragma unroll
                    for (int ai = 0; ai < 2; ++ai)
#pragma unroll
                        for (int m = 0; m < 4; ++m) {
                            f32x4 v0 = acc[ai][bj][m][0], v1 = acc[ai][bj][m][1];
#pragma unroll
                            for (int e = 0; e < 4; ++e) { v0[e] = __builtin_amdgcn_rcpf(1.f + __builtin_amdgcn_exp2f(-1.44269504f * v0[e])); v1[e] = __builtin_amdgcn_rcpf(1.f + __builtin_amdgcn_exp2f(-1.44269504f * v1[e])); }
                            int w0 = __builtin_amdgcn_cvt_pk_fp8_f32(v0[0], v0[1], 0, false); w0 = __builtin_amdgcn_cvt_pk_fp8_f32(v0[2], v0[3], w0, true);
                            int w1 = __builtin_amdgcn_cvt_pk_fp8_f32(v1[0], v1[1], 0, false); w1 = __builtin_amdgcn_cvt_pk_fp8_f32(v1[2], v1[3], w1, true);
                            typedef int i32x2v __attribute__((ext_vector_type(2)));
                            i32x2v w; w.x = w0; w.y = w1;
                            *(i32x2v*)(G8 + (size_t)(row0 + ai * HALF + m * 16) * 4096 + gc) = w; }
                  } }
            } else {
#pragma unroll
                for (int ai = 0; ai < 2; ++ai)
#pragma unroll
                    for (int m = 0; m < 4; ++m) { bf16_t* rowp = O + (size_t)(row0 + ai * HALF + m * 16) * ldc + col0;
                        const f32x4 v0 = acc[ai][bj][m][0], v1 = acc[ai][bj][m][1];
                        u32x4 w; w.x = cvt_pk_bf16(v0[0], v0[1]); w.y = cvt_pk_bf16(v0[2], v0[3]); w.z = cvt_pk_bf16(v1[0], v1[1]); w.w = cvt_pk_bf16(v1[2], v1[3]);
                        *(u32x4*)(rowp + bj * HALF) = w; }
            }
        }
    }
};
}

typedef unsigned short bf16;
constexpr int T_ = 16384, S_ = 4096, NBATCH = 4, D_ = 1024, NCOL = 6824, NP = 6912, DEPTH_ = 2;
constexpr int C_QA = 0, C_KA = 256, C_VA = 320, C_QI = 384, C_KI = 640, C_WI = 672, C_QB = 680, C_KB = 936, C_VB = 1064,
              C_QC = 1192, C_KC = 1448, C_VC = 1704, C_QD = 1960, C_KD = 2216, C_VD = 2472, C_G = 2728;
constexpr int NTHR = 512, NWAVE = 8;
constexpr float ALPHA = 1.41421356237309515f;
constexpr float LN_EPS = 1e-5f;
constexpr size_t MiB = 1u << 20;
constexpr size_t WS_STATS = 1 * MiB  , WS_COLS = 1 * MiB + 512 * 1024  ;
constexpr size_t WS_CTL = 0, WS_WIN_T = 2 * MiB, WS_WOUT_T = 30 * MiB, WS_WQ_T = 34 * MiB, WS_WBR_T = 38 * MiB, WS_HB = 42 * MiB,
                 WS_P = 74 * MiB, WS_MIX = 74 * MiB  , WS_Q = 138 * MiB  , WS_G8 = 428 * MiB  , WS_YS = 290 * MiB, WS_MRG = 322 * MiB,
                 WS_MASK = 354 * MiB, WS_EID = 362 * MiB, WS_GATE = 370 * MiB, WS_KMEAN = 378 * MiB, WS_SKB = 379 * MiB, WS_UV = 380 * MiB, WS_END = 508 * MiB;
constexpr size_t WIN_T_BYTES = (size_t)NP * 1024 * 2;
constexpr int LDS_BYTES = 144 * 1024;

struct Params { const float* in[13]; float* out; unsigned char* ws; };

__device__ __forceinline__ float bf2f(bf16 v) { return __uint_as_float((unsigned)v << 16); }
__device__ __forceinline__ unsigned f2bf(float f) { unsigned u = __float_as_uint(f); return (u + 0x7fffu + ((u >> 16) & 1u)) >> 16; }
__device__ __forceinline__ unsigned pk2(float lo, float hi) { return f2bf(lo) | (f2bf(hi) << 16); }
__device__ __forceinline__ void unpack8(const uint4 v, float* o) {
    o[0] = __uint_as_float(v.x << 16); o[1] = __uint_as_float(v.x & 0xffff0000u); o[2] = __uint_as_float(v.y << 16); o[3] = __uint_as_float(v.y & 0xffff0000u);
    o[4] = __uint_as_float(v.z << 16); o[5] = __uint_as_float(v.z & 0xffff0000u); o[6] = __uint_as_float(v.w << 16); o[7] = __uint_as_float(v.w & 0xffff0000u);
}
__device__ __forceinline__ float wave_sum(float v) {
#pragma unroll
    for (int o = 32; o > 0; o >>= 1) v += __shfl_xor(v, o);
    return v;
}
__device__ __forceinline__ float wave_max(float v) {
#pragma unroll
    for (int o = 32; o > 0; o >>= 1) v = fmaxf(v, __shfl_xor(v, o));
    return v;
}
__device__ __forceinline__ int wave_sum_i(int v) {
#pragma unroll
    for (int o = 32; o > 0; o >>= 1) v += __shfl_xor(v, o);
    return v;
}
__device__ __forceinline__ float logsig(float x) { return fminf(x, 0.f) - log1pf(expf(-fabsf(x))); }

__device__ void transpose_items(int WV_, const float* W, int K, int N, bf16* WT, float* sm, int item0, int nitems_total, int item_stride,
                                const float* rs_g = nullptr, const float* rs_b = nullptr, float* colsum = nullptr, float* colbias = nullptr) {
    const int tid = LTID(WV_);
    const int nkb = K / 64, nnb = (N + 63) / 64;
    for (int it = item0; it < nkb * nnb; it += item_stride) {
        const int kb = it % nkb, nb = it / nkb, k0 = kb * 64, n0 = nb * 64;
        __syncthreads();
        for (int e = tid; e < 64 * 64; e += NTHR) { const int kk = e >> 6, nn = e & 63; sm[kk * 65 + nn] = (n0 + nn < N) ? W[(size_t)(k0 + kk) * N + n0 + nn] : 0.f; }
        __syncthreads();
        if (rs_g) {
            if (tid < 64) { float cs = 0.f, cb = 0.f;
                for (int kk = 0; kk < 64; ++kk) { const float w = sm[kk * 65 + tid]; cs += w * rs_g[k0 + kk]; cb += w * rs_b[k0 + kk]; }
                atomicAdd(colsum + n0 + tid, cs); atomicAdd(colbias + n0 + tid, cb); }
            __syncthreads();
            for (int e = tid; e < 64 * 64; e += NTHR) { const int kk = e >> 6, nn = e & 63; sm[kk * 65 + nn] *= rs_g[k0 + kk]; }
            __syncthreads();
        }
        { const int nn = tid >> 3, c = tid & 7;
          if (n0 + nn < N) { uint4 o; o.x = pk2(sm[(8 * c + 0) * 65 + nn], sm[(8 * c + 1) * 65 + nn]); o.y = pk2(sm[(8 * c + 2) * 65 + nn], sm[(8 * c + 3) * 65 + nn]);
              o.z = pk2(sm[(8 * c + 4) * 65 + nn], sm[(8 * c + 5) * 65 + nn]); o.w = pk2(sm[(8 * c + 6) * 65 + nn], sm[(8 * c + 7) * 65 + nn]);
              *(uint4*)(WT + (size_t)(n0 + nn) * K + k0 + 8 * c) = o; } }
    }
    __syncthreads();
}
constexpr int TI_WIN = 16 * ((NCOL + 63) / 64), TI_SQ = 256, TI_LAYER = TI_WIN + 3 * TI_SQ;
#define TITEM_DECODE(it_, W_, WT_, K_, N_, k0_, n0_, fold_, l_) do { \
        l_ = (it_) / TI_LAYER; const int r_ = (it_) - l_ * TI_LAYER; \
        const int kind_ = r_ < TI_WIN ? 0 : (r_ < TI_WIN + TI_SQ ? 1 : (r_ < TI_WIN + 2 * TI_SQ ? 2 : 3)); \
        const int q_ = r_ - (kind_ == 0 ? 0 : TI_WIN + (kind_ - 1) * TI_SQ); \
        fold_ = kind_ == 2; K_ = kind_ == 3 ? 256 : 1024; N_ = kind_ == 0 ? NCOL : 1024; \
        k0_ = kind_ == 3 ? (q_ & 3) * 64 : (q_ & 15) * 64; n0_ = kind_ == 3 ? ((q_ & 63) >> 2) * 64 : (q_ >> 4) * 64; \
        const int nbr_ = q_ >> 6; \
        W_ = kind_ == 0 ? pin1 + (size_t)l_ * 1024 * NCOL : kind_ == 1 ? pin3 + (size_t)l_ * 1024 * 1024 : kind_ == 2 ? pin7 + (size_t)l_ * 1024 * 1024 : pin2 + ((size_t)l_ * 4 + nbr_) * 256 * 1024; \
        WT_ = kind_ == 0 ? (bf16*)(ws + WS_WIN_T + l_ * WIN_T_BYTES) : kind_ == 1 ? (bf16*)(ws + WS_WOUT_T) + (size_t)l_ * 1024 * 1024 : kind_ == 2 ? (bf16*)(ws + WS_WQ_T) + (size_t)l_ * 1024 * 1024 \
              : (bf16*)(ws + WS_WBR_T) + ((size_t)l_ * 4 + nbr_) * 1024 * 256; } while (0)
__device__ __forceinline__ void titem_finish(bf16* WT, int K, int N, int k0, int n0, const float* rs_g, const float* rs_b, float* colsum, float* colbias, float* sm, int tid) {
    if (rs_g) {
        if (tid < 64) { float cs = 0.f, cb = 0.f;
            for (int kk = 0; kk < 64; ++kk) { const float w = sm[kk * 65 + tid]; cs += w * rs_g[k0 + kk]; cb += w * rs_b[k0 + kk]; }
            atomicAdd(colsum + n0 + tid, cs); atomicAdd(colbias + n0 + tid, cb); }
        __syncthreads();
        for (int e = tid; e < 64 * 64; e += NTHR) { const int kk = e >> 6, nn = e & 63; sm[kk * 65 + nn] *= rs_g[k0 + kk]; }
        __syncthreads();
    }
    { const int nn = tid >> 3, c = tid & 7;
      if (n0 + nn < N) { uint4 o; o.x = pk2(sm[(8 * c + 0) * 65 + nn], sm[(8 * c + 1) * 65 + nn]); o.y = pk2(sm[(8 * c + 2) * 65 + nn], sm[(8 * c + 3) * 65 + nn]);
          o.z = pk2(sm[(8 * c + 4) * 65 + nn], sm[(8 * c + 5) * 65 + nn]); o.w = pk2(sm[(8 * c + 6) * 65 + nn], sm[(8 * c + 7) * 65 + nn]);
          *(uint4*)(WT + (size_t)(n0 + nn) * K + k0 + 8 * c) = o; } }
}
__device__ void prologue_phase(int WV_, const Params& p, float* sm) {
    const int tid = LTID(WV_), B = LBID(), G = LGRID();
    unsigned char* ws = p.ws;
    float* sm1 = sm + 64 * 65;
    const float* pin1 = p.in[1]; const float* pin2 = p.in[2]; const float* pin3 = p.in[3]; const float* pin7 = p.in[7]; const float* pin5 = p.in[5]; const float* pin6 = p.in[6];
    asm volatile("" : "+s"(pin1), "+s"(pin2), "+s"(pin3), "+s"(pin7), "+s"(pin5), "+s"(pin6));
    const int kk0 = tid >> 4, c4 = tid & 15;
    for (int it = B; it < DEPTH_ * TI_LAYER; it += 2 * G) {
        const int it2 = it + G; const bool has2 = it2 < DEPTH_ * TI_LAYER;
        const float* Wa; const float* Wb; bf16* WTa; bf16* WTb; int Ka, Na, k0a, n0a, la, Kb, Nb, k0b, n0b, lb; bool fa, fb;
        TITEM_DECODE(it, Wa, WTa, Ka, Na, k0a, n0a, fa, la);
        { const int itb = has2 ? it2 : it; TITEM_DECODE(itb, Wb, WTb, Kb, Nb, k0b, n0b, fb, lb); }
        const float4 z4 = make_float4(0.f, 0.f, 0.f, 0.f);
        const bool ina = n0a + 4 * c4 < Na, inb = n0b + 4 * c4 < Nb;
        float4 a0 = z4, a1 = z4, b0 = z4, b1 = z4;
        if (ina) { a0 = *(const float4*)(Wa + (size_t)(k0a + kk0) * Na + n0a + 4 * c4); a1 = *(const float4*)(Wa + (size_t)(k0a + kk0 + 32) * Na + n0a + 4 * c4); }
        if (inb) { b0 = *(const float4*)(Wb + (size_t)(k0b + kk0) * Nb + n0b + 4 * c4); b1 = *(const float4*)(Wb + (size_t)(k0b + kk0 + 32) * Nb + n0b + 4 * c4); }
        __syncthreads();
        { float* d = sm + kk0 * 65 + 4 * c4; d[0] = a0.x; d[1] = a0.y; d[2] = a0.z; d[3] = a0.w; d += 32 * 65; d[0] = a1.x; d[1] = a1.y; d[2] = a1.z; d[3] = a1.w; }
        { float* d = sm1 + kk0 * 65 + 4 * c4; d[0] = b0.x; d[1] = b0.y; d[2] = b0.z; d[3] = b0.w; d += 32 * 65; d[0] = b1.x; d[1] = b1.y; d[2] = b1.z; d[3] = b1.w; }
        __syncthreads();
        titem_finish(WTa, Ka, Na, k0a, n0a, fa ? pin5 + la * 1024 : nullptr, pin6 + la * 1024, (float*)(ws + WS_COLS) + la * 2048, (float*)(ws + WS_COLS) + la * 2048 + 1024, sm, tid);
        if (has2) titem_finish(WTb, Kb, Nb, k0b, n0b, fb ? pin5 + lb * 1024 : nullptr, pin6 + lb * 1024, (float*)(ws + WS_COLS) + lb * 2048, (float*)(ws + WS_COLS) + lb * 2048 + 1024, sm1, tid);
    }
    __syncthreads();
    for (int l = 0; l < DEPTH_; ++l) {
        bf16* win_t = (bf16*)(ws + WS_WIN_T + l * WIN_T_BYTES);
        for (int i = B * NTHR + tid; i < (NP - NCOL) * 1024 / 8; i += G * NTHR) ((uint4*)(win_t + (size_t)NCOL * 1024))[i] = make_uint4(0u, 0u, 0u, 0u);
    }
    const float4* x4 = (const float4*)p.in[0]; uint2* hb2 = (uint2*)(ws + WS_HB);
    for (size_t i = (size_t)B * NTHR + tid; i < (size_t)T_ * 1024 / 4; i += (size_t)G * NTHR) { const float4 v = x4[i]; hb2[i] = make_uint2(pk2(v.x, v.y), pk2(v.z, v.w)); }
}

__device__ __forceinline__ void ln_row(float4 (&v)[4], const float* g, const float* bb, float* orow, bf16* obrow, int lane) {
    float s = 0.f;
#pragma unroll
    for (int j = 0; j < 4; ++j) s += (v[j].x + v[j].y) + (v[j].z + v[j].w);
    const float mean = wave_sum(s) * (1.0f / 1024.0f);
    float s2 = 0.f;
#pragma unroll
    for (int j = 0; j < 4; ++j) { v[j].x -= mean; v[j].y -= mean; v[j].z -= mean; v[j].w -= mean; s2 += (v[j].x * v[j].x + v[j].y * v[j].y) + (v[j].z * v[j].z + v[j].w * v[j].w); }
    const float rstd = 1.0f / sqrtf(wave_sum(s2) * (1.0f / 1024.0f) + LN_EPS);
#pragma unroll
    for (int j = 0; j < 4; ++j) {
        const float4 gg = ((const float4*)g)[j * 64 + lane], b4 = ((const float4*)bb)[j * 64 + lane];
        float4 o; o.x = v[j].x * rstd * gg.x + b4.x; o.y = v[j].y * rstd * gg.y + b4.y; o.z = v[j].z * rstd * gg.z + b4.z; o.w = v[j].w * rstd * gg.w + b4.w;
        ((float4*)orow)[j * 64 + lane] = o;
        ((uint2*)obrow)[j * 64 + lane] = make_uint2(pk2(o.x, o.y), pk2(o.z, o.w));
    }
}
__device__ void ln1_phase(int WV_, const float* hin, const float* add, const float* g, const float* bb, float* hout, bf16* hb) {
    const int lane = LTID(WV_) & 63, wave = LTID(WV_) >> 6;
    for (int row = LBID() * NWAVE + wave; row < T_; row += LGRID() * NWAVE) {
        float4 v[4];
#pragma unroll
        for (int j = 0; j < 4; ++j) {
            const float4 a = ((const float4*)(hin + (size_t)row * 1024))[j * 64 + lane], m = ((const float4*)(add + (size_t)row * 1024))[j * 64 + lane];
            v[j].x = ALPHA * a.x + m.x; v[j].y = ALPHA * a.y + m.y; v[j].z = ALPHA * a.z + m.z; v[j].w = ALPHA * a.w + m.w;
        }
        ln_row(v, g, bb, hout + (size_t)row * 1024, hb + (size_t)row * 1024, lane);
    }
}


typedef short bf16x8_t __attribute__((ext_vector_type(8)));
typedef float f32x16_t __attribute__((ext_vector_type(16)));
typedef float f32x2_t __attribute__((ext_vector_type(2)));
typedef __bf16 bf16x2_t __attribute__((ext_vector_type(2)));
__device__ __forceinline__ unsigned cvtpk(float lo, float hi) { f32x2_t v = {lo, hi}; bf16x2_t b = __builtin_convertvector(v, bf16x2_t); return __builtin_bit_cast(unsigned, b); }
__device__ __forceinline__ int crow(int r, int hi) { return (r & 3) + 8 * (r >> 2) + 4 * hi; }
__device__ __forceinline__ float xlane32(float v) { return __shfl_xor(v, 32); }
__device__ __forceinline__ float vmax(float a, float b) { float r; asm("v_max_f32_e32 %0, %1, %2" : "=v"(r) : "v"(a), "v"(b)); return r; }
__device__ __forceinline__ float vmin(float a, float b) { float r; asm("v_min_f32_e32 %0, %1, %2" : "=v"(r) : "v"(a), "v"(b)); return r; }
__device__ __forceinline__ float vmax3(float a, float b, float c) { float r; asm("v_max3_f32 %0, %1, %2, %3" : "=v"(r) : "v"(a), "v"(b), "v"(c)); return r; }

constexpr int AT_KP = 72, AT_VP = 96;
constexpr int AT_KS = 0, AT_KS_BYTES = 64 * AT_KP * 2;
constexpr int AT_VT = 2 * AT_KS_BYTES, AT_VT_BYTES = 64 * AT_VP * 2;
constexpr int AT_KM = AT_VT + 2 * AT_VT_BYTES;
constexpr int AT_MISC = AT_KM + 32 * AT_KP * 2;
constexpr float LOG2E = 1.4426950408889634f;

__device__ __forceinline__ unsigned mk_unit(int kind, int b, int x, int y) { return ((unsigned)kind << 30) | ((unsigned)b << 28) | ((unsigned)x << 8) | (unsigned)y; }
__device__ void build_unit_table(unsigned* tab, int i) {
    int n = 0; unsigned res = 0u;
#pragma unroll 1
    for (int c = 64; c >= 1; --c) {
        if (i >= n && i < n + 4) res = mk_unit(0, i - n, 0, c - 1);
        n += 4;
        if ((c & 3) == 0) { if (i >= n && i < n + 16) { const int j = i - n; res = mk_unit(2, j >> 2, j & 3, c / 4 - 1); } n += 16; }
    }
    if (i < 512) tab[i] = res;
}

template <int kind> __device__ __forceinline__ void attn_unit(int WV_, const bf16* P, const unsigned char* mask, const float* kmean, const float* sinks, bf16* ys,
                                unsigned char* lds, int b, int ux, int uy) {
    int tid_ = LTID(WV_); asm volatile("" : "+v"(tid_));
    const int tid = tid_, lane = tid & 63, wave = __builtin_amdgcn_readfirstlane(tid >> 6), r32 = lane & 31, hi = lane >> 5;
    bf16* s_km = (bf16*)(lds + AT_KM);
    const int skey = tid >> 3, sc = tid & 7;
    {
        const bf16* Pb = P + (size_t)b * S_ * NP;
        int q0w, qcol, kcol, vcol, ycol, kt_hi, kt_lo; float slope2 = 0.f, sink2 = 0.f;
        if (kind == 0) { const int head = wave >> 1; q0w = uy * 64 + (wave & 1) * 32; qcol = C_QA + head * 64; kcol = C_KA; vcol = C_VA; ycol = head * 64;
            slope2 = exp2f(-8.0f * (float)(3 * head + 1) / 12.0f) * LOG2E; kt_hi = uy; kt_lo = 0; }
        else if (kind == 1) { const int hq = ux * 2 + (wave >> 2); q0w = uy * 128 + (wave & 3) * 32; qcol = C_QB + hq * 64; kcol = C_KB + ux * 64; vcol = C_VB + ux * 64; ycol = 256 + hq * 64;
            slope2 = exp2f(-8.0f * (float)(3 * hq + 2) / 12.0f) * LOG2E; sink2 = sinks[hq] * LOG2E; kt_hi = 2 * uy + 1; kt_lo = (2 * uy - 2 > 0) ? 2 * uy - 2 : 0; }
        else if (kind == 2) { q0w = uy * 256 + wave * 32; qcol = C_QC + ux * 64; kcol = C_KC + ux * 64; vcol = C_VC + ux * 64; ycol = 512 + ux * 64;
            slope2 = exp2f(-8.0f * (float)(3 * ux + 3) / 12.0f) * LOG2E; kt_hi = 4 * uy + 3; kt_lo = 0; }
        else { q0w = uy * 256 + wave * 32; qcol = C_QD + ux * 64; kcol = C_KD + ux * 64; vcol = C_VD + ux * 64; ycol = 768 + ux * 64; kt_hi = 4 * uy + 3; kt_lo = 0; }
        const int qpos = q0w + r32;
        bf16x8_t qf[4];
        { const bf16* qp = Pb + (size_t)qpos * NP + qcol + 8 * hi;
#pragma unroll
          for (int ks = 0; ks < 4; ++ks) qf[ks] = *(const bf16x8_t*)(qp + 16 * ks); }
        {
            const float qs = (kind == 3) ? 0.125f : 0.125f * LOG2E;
            typedef unsigned u32x4_t __attribute__((ext_vector_type(4)));
#pragma unroll
            for (int ks = 0; ks < 4; ++ks) { u32x4_t w = __builtin_bit_cast(u32x4_t, qf[ks]);
#pragma unroll
                for (int i = 0; i < 4; ++i) w[i] = cvtpk(__uint_as_float(w[i] << 16) * qs, __uint_as_float(w[i] & 0xffff0000u) * qs);
                qf[ks] = __builtin_bit_cast(bf16x8_t, w); }
        }
        float sb[16];
#pragma unroll
        for (int r = 0; r < 16; ++r) sb[r] = slope2 * (float)((r & 3) + 8 * (r >> 2));
        unsigned bm = 0u;
        if (kind == 2) {
            const int own = uy;
            for (int e = tid; e < 32 * 64; e += NTHR) { const int row = e >> 6, d = e & 63; s_km[row * AT_KP + d] = (row < 16) ? (bf16)f2bf(kmean[((b * 4 + ux) * 16 + row) * 64 + d]) : (bf16)0; }
            __syncthreads();
            f32x16_t gacc;
#pragma unroll
            for (int r = 0; r < 16; ++r) gacc[r] = 0.f;
#pragma unroll
            for (int ks = 0; ks < 4; ++ks) { const bf16x8_t a = *(const bf16x8_t*)(s_km + r32 * AT_KP + 16 * ks + 8 * hi); gacc = __builtin_amdgcn_mfma_f32_32x32x16_bf16(a, qf[ks], gacc, 0, 0, 0); }
            float gt[16];
#pragma unroll
            for (int r = 0; r < 8; ++r) { const float mine = gacc[r], other = xlane32(mine); const int bi = crow(r, 0);
                gt[bi] = hi ? other : mine; gt[bi + 4] = hi ? mine : other; }
#pragma unroll
            for (int n = 0; n < 16; ++n) if (n >= own) gt[n] = -INFINITY;
#pragma unroll
            for (int rep = 0; rep < 3; ++rep) {
                float mx = -INFINITY;
#pragma unroll
                for (int n = 0; n < 16; ++n) mx = fmaxf(mx, gt[n]);
                bool done = !(mx > -INFINITY);
#pragma unroll
                for (int n = 0; n < 16; ++n) { const bool hit = !done && gt[n] == mx; if (hit) { bm |= 1u << n; gt[n] = -INFINITY; done = true; } }
            }
        }
        f32x16_t o0, o1;
#pragma unroll
        for (int r = 0; r < 16; ++r) { o0[r] = 0.f; o1[r] = 0.f; }
        float m_run = -INFINITY, l_run = 0.f, carry = 0.f;
        const bf16* kg = Pb + (size_t)skey * NP + kcol + sc * 8;
        const bf16* vg = Pb + (size_t)skey * NP + vcol + sc * 8;
        uint4 rk = *(const uint4*)(kg + (size_t)kt_hi * 64 * NP), rv = *(const uint4*)(vg + (size_t)kt_hi * 64 * NP);
        int buf = 0;
        { bf16* ks_ = (bf16*)(lds + AT_KS); bf16* vt_ = (bf16*)(lds + AT_VT);
          *(uint4*)(ks_ + skey * AT_KP + sc * 8) = rk;
          *(uint4*)(vt_ + skey * AT_VP + sc * 8) = rv; }
        __syncthreads();
        bool wave_done = false;
        uint2 mw_next = make_uint2(0u, 0u);
        if (kind == 0) mw_next = *(const uint2*)(mask + (size_t)(b * S_ + qpos) * 512 + kt_hi * 8);
        for (int kt = kt_hi; kt >= kt_lo; --kt) {
            const bool more = kt > kt_lo;
            const uint2 mw = mw_next;
            if (kind == 0 && more) mw_next = *(const uint2*)(mask + (size_t)(b * S_ + qpos) * 512 + (kt - 1) * 8);
            if (more) { rk = *(const uint4*)(kg + (size_t)(kt - 1) * 64 * NP); rv = *(const uint4*)(vg + (size_t)(kt - 1) * 64 * NP); }
            const bf16* ks_ = (const bf16*)(lds + AT_KS + buf * AT_KS_BYTES);
            const bf16* vt_ = (const bf16*)(lds + AT_VT + buf * AT_VT_BYTES);
            bool active = (kt * 64 <= q0w + 31) && !wave_done;
            if (kind == 1) active = active && (kt * 64 + 63 >= q0w - 127);
            if (active) {
                const int kbase = kt * 64 + 4 * hi;
                f32x16_t p0, p1;
                if (kind != 3) {
                    const float cb = slope2 * (float)(kbase - qpos), cb1 = cb + 32.0f * slope2;
#pragma unroll
                    for (int r = 0; r < 16; ++r) { p0[r] = cb + sb[r]; p1[r] = cb1 + sb[r]; }
                } else {
#pragma unroll
                    for (int r = 0; r < 16; ++r) { p0[r] = 0.f; p1[r] = 0.f; }
                }
#pragma unroll
                for (int ks = 0; ks < 4; ++ks) {
                    const bf16x8_t a0 = *(const bf16x8_t*)(ks_ + r32 * AT_KP + 16 * ks + 8 * hi);
                    const bf16x8_t a1 = *(const bf16x8_t*)(ks_ + (32 + r32) * AT_KP + 16 * ks + 8 * hi);
                    p0 = __builtin_amdgcn_mfma_f32_32x32x16_bf16(a0, qf[ks], p0, 0, 0, 0);
                    p1 = __builtin_amdgcn_mfma_f32_32x32x16_bf16(a1, qf[ks], p1, 0, 0, 0);
                }
                if (kind != 3) {
                    float mx = -INFINITY;
                    if (kind == 0) {
                        const unsigned w0 = mw.x >> (4 * hi), w1 = mw.y >> (4 * hi);
#pragma unroll
                        for (int r = 0; r < 16; ++r) { const int off = (r & 3) + 8 * (r >> 2);
                            p0[r] = (w0 & (1u << off)) ? p0[r] : -INFINITY; p1[r] = (w1 & (1u << off)) ? p1[r] : -INFINITY; mx = vmax3(mx, p0[r], p1[r]); }
                    } else if (kind == 1) {
                        const int rel = qpos - kbase;
#pragma unroll
                        for (int r = 0; r < 16; ++r) { const int off = (r & 3) + 8 * (r >> 2);
                            p0[r] = ((unsigned)(rel - off) < 128u) ? p0[r] : -INFINITY; p1[r] = ((unsigned)(rel - off - 32) < 128u) ? p1[r] : -INFINITY; mx = vmax3(mx, p0[r], p1[r]); }
                    } else {
                        if ((kt >> 2) == uy) {
                            const int rel = qpos - kbase;
#pragma unroll
                            for (int r = 0; r < 16; ++r) { const int off = (r & 3) + 8 * (r >> 2);
                                p0[r] = (off <= rel) ? p0[r] : -INFINITY; p1[r] = (off + 32 <= rel) ? p1[r] : -INFINITY; mx = vmax3(mx, p0[r], p1[r]); }
                        } else {
                            const bool tile_ok = ((bm >> (kt >> 2)) & 1u) != 0u;
#pragma unroll
                            for (int r = 0; r < 16; ++r) { p0[r] = tile_ok ? p0[r] : -INFINITY; p1[r] = tile_ok ? p1[r] : -INFINITY; mx = vmax3(mx, p0[r], p1[r]); }
                        }
                    }
                    mx = vmax(mx, xlane32(mx));
                    const float m_new = vmax(m_run, mx);
                    const float m_safe = (m_new == -INFINITY) ? 0.f : m_new;
                    p0 = p0 - m_safe; p1 = p1 - m_safe;
#pragma unroll
                    for (int r = 0; r < 16; ++r) { p0[r] = __builtin_amdgcn_exp2f(p0[r]); p1[r] = __builtin_amdgcn_exp2f(p1[r]); }
                    float ls;
                    { typedef float f32x8_t __attribute__((ext_vector_type(8))); typedef float f32x4v_t __attribute__((ext_vector_type(4)));
                      const f32x16_t t16 = p0 + p1; const f32x8_t t8 = t16.lo + t16.hi; const f32x4v_t t4 = t8.lo + t8.hi; const f32x2_t t2 = t4.lo + t4.hi; ls = t2.x + t2.y; }
                    if (__any(m_new > m_run)) {
                        const float alpha = __builtin_amdgcn_exp2f(m_run - m_safe);
                        l_run *= alpha;
                        o0 = o0 * alpha; o1 = o1 * alpha;
                    }
                    l_run += ls; m_run = m_new;
                } else {
                    float run = carry;
#define SB_HALF(PX, KOFF) do { \
                    float lk[16]; \
                    _Pragma("unroll") for (int r = 0; r < 16; ++r) { \
                        const int off = (r & 3) + 8 * (r >> 2); \
                        const bool v = (kbase + off + (KOFF)) < qpos; \
                        const float z = PX[r]; \
                        const float t = 0.6931471805599453f * __builtin_amdgcn_logf(1.0f + __builtin_amdgcn_exp2f(-LOG2E * fabsf(z))); \
                        lk[r] = v ? (fminf(-z, 0.f) - t) : 0.f; \
                        PX[r] = v ? (fminf(z, 0.f) - t) : -INFINITY; } \
                    _Pragma("unroll") for (int g = 3; g >= 0; --g) { \
                        const float G = (lk[4 * g] + lk[4 * g + 1]) + (lk[4 * g + 2] + lk[4 * g + 3]); \
                        const float PG = xlane32(G); \
                        float la = run + (hi ? 0.f : PG); \
                        run += G + PG; \
                        PX[4 * g + 3] += la; la += lk[4 * g + 3]; PX[4 * g + 2] += la; la += lk[4 * g + 2]; PX[4 * g + 1] += la; la += lk[4 * g + 1]; PX[4 * g] += la; } \
                    _Pragma("unroll") for (int r = 0; r < 16; ++r) PX[r] = __builtin_amdgcn_exp2f(LOG2E * PX[r]); } while (0)
                    SB_HALF(p1, 32);
                    SB_HALF(p0, 0);
#undef SB_HALF
                    carry = run;
                }
                unsigned pw[16];
#pragma unroll
                for (int j = 0; j < 8; ++j) { pw[j] = cvtpk(p0[2 * j], p0[2 * j + 1]); pw[8 + j] = cvtpk(p1[2 * j], p1[2 * j + 1]); }
#pragma unroll
                for (int s = 0; s < 4; ++s) {
                    bf16x8_t pb; { const unsigned* q = pw + 4 * s; typedef unsigned u32x4_t __attribute__((ext_vector_type(4))); u32x4_t t4 = {q[0], q[1], q[2], q[3]}; pb = __builtin_bit_cast(bf16x8_t, t4); }
#pragma unroll
                    for (int dt = 0; dt < 2; ++dt) {
                        typedef short s16x4_t __attribute__((ext_vector_type(4)));
                        typedef __attribute__((address_space(3))) s16x4_t lds_s16x4;
                        const int gi_ = lane & 15;
                        const bf16* vp = vt_ + (16 * s + 4 * hi + (gi_ >> 2)) * AT_VP + 32 * dt + 16 * ((lane >> 4) & 1) + 4 * (gi_ & 3);
                        const s16x4_t lo = __builtin_amdgcn_ds_read_tr16_b64_v4i16((lds_s16x4*)vp), hi4 = __builtin_amdgcn_ds_read_tr16_b64_v4i16((lds_s16x4*)(vp + 8 * AT_VP));
                        const bf16x8_t va = {lo[0], lo[1], lo[2], lo[3], hi4[0], hi4[1], hi4[2], hi4[3]};
                        if (dt == 0) o0 = __builtin_amdgcn_mfma_f32_32x32x16_bf16(va, pb, o0, 0, 0, 0);
                        else         o1 = __builtin_amdgcn_mfma_f32_32x32x16_bf16(va, pb, o1, 0, 0, 0);
                    }
                }
            }
            if (kind == 3) {
                const float cm = carry;
                if (__all(cm < -110.0f) || !(kt * 64 <= q0w + 31) ) { if (__all(cm < -110.0f)) wave_done = true; }
            }
            if (more) {
                bf16* ksn = (bf16*)(lds + AT_KS + (buf ^ 1) * AT_KS_BYTES); bf16* vtn = (bf16*)(lds + AT_VT + (buf ^ 1) * AT_VT_BYTES);
                *(uint4*)(ksn + skey * AT_KP + sc * 8) = rk;
                *(uint4*)(vtn + skey * AT_VP + sc * 8) = rv;
            }
            if (kind == 3) { if (__syncthreads_and(wave_done ? 1 : 0)) break; }
            else __syncthreads();
            buf ^= 1;
        }
        float inv;
        if (kind == 3) inv = 1.0f;
        else {
            float lt = l_run + xlane32(l_run);
            if (kind == 1) { const float mf = fmaxf(m_run, sink2); const float sc2 = exp2f(m_run - mf); lt = lt * sc2 + exp2f(sink2 - mf); inv = sc2 / lt; }
            else inv = 1.0f / lt;
        }
        bf16* yp = ys + (size_t)(b * S_ + qpos) * 1024 + ycol + 4 * hi;
#pragma unroll
        for (int g = 0; g < 4; ++g) {
            *(uint2*)(yp + 8 * g) = make_uint2(cvtpk(o0[4 * g] * inv, o0[4 * g + 1] * inv), cvtpk(o0[4 * g + 2] * inv, o0[4 * g + 3] * inv));
            *(uint2*)(yp + 32 + 8 * g) = make_uint2(cvtpk(o1[4 * g] * inv, o1[4 * g + 1] * inv), cvtpk(o1[4 * g + 2] * inv, o1[4 * g + 3] * inv));
        }
    }
}
__device__ void attn_fast_phase(int WV_, const bf16* P, const unsigned char* mask, const float* kmean, const float* sinks, bf16* ys,
                                const unsigned* utab, unsigned* counter, unsigned char* lds) {
    volatile unsigned* s_unit = (volatile unsigned*)(lds + AT_MISC);
    for (;;) {
        __syncthreads();
        if (LTID(WV_) == 0) s_unit[0] = atomicAdd(counter, 1u);
        __syncthreads();
        const unsigned ui = s_unit[0];
        if (ui >= 512u) break;
        const unsigned ue = utab[ui];
        const int kind = (int)(ue >> 30), b = (int)((ue >> 28) & 3u), ux = (int)((ue >> 8) & 255u), uy = (int)(ue & 255u);
        if (kind == 0) attn_unit<0>(WV_, P, mask, kmean, sinks, ys, lds, b, ux, uy);
        else attn_unit<2>(WV_, P, mask, kmean, sinks, ys, lds, b, ux, uy);
    }
    for (int u = LBID(); u < 256; u += LGRID()) { __syncthreads(); attn_unit<3>(WV_, P, mask, kmean, sinks, ys, lds, u >> 6, (u >> 4) & 3, u & 15); }
    for (int u = LBID(); u < 256; u += LGRID()) { __syncthreads(); attn_unit<1>(WV_, P, mask, kmean, sinks, ys, lds, u >> 6, (u >> 5) & 1, u & 31); }
}

constexpr float U_SCALE = 128.0f, V_SCALE = 48.0f;
constexpr int ROW6 = 1536;
typedef float v32f_t __attribute__((ext_vector_type(32)));
typedef unsigned v6u_t __attribute__((ext_vector_type(6)));
typedef unsigned u32x4a8_t __attribute__((ext_vector_type(4), aligned(8)));
__device__ __forceinline__ float rdlane_f(float v, int l) { return __builtin_bit_cast(float, __builtin_amdgcn_readlane(__builtin_bit_cast(int, v), l)); }
__device__ __forceinline__ unsigned q_e2m3(float v) {
    const float a = fminf(fabsf(v), 7.5f);
    unsigned code;
    if (a < 1.0f) code = (unsigned)rintf(a * 8.0f);
    else if (a < 2.0f) code = 8u + (unsigned)rintf((a - 1.0f) * 8.0f);
    else if (a < 4.0f) code = 16u + (unsigned)rintf((a - 2.0f) * 4.0f);
    else code = 24u + (unsigned)rintf((a - 4.0f) * 2.0f);
    return code | (v < 0.f ? 32u : 0u);
}
__device__ __forceinline__ void cvt_chunk6(const float4 (&a)[8], float sc, unsigned (&w)[6]) {
#pragma unroll
    for (int d = 0; d < 6; ++d) w[d] = 0u;
#pragma unroll
    for (int q4 = 0; q4 < 8; ++q4) {
        const float av[4] = {a[q4].x, a[q4].y, a[q4].z, a[q4].w};
#pragma unroll
        for (int e = 0; e < 4; ++e) { const int idx = q4 * 4 + e, bit = 6 * idx, d = bit >> 5, sft = bit & 31; const unsigned code = q_e2m3(av[e] * sc);
            w[d] |= code << sft; if (sft > 26) w[d + 1] |= code >> (32 - sft); }
    }
}
__device__ void convert_tables(int WV_, const Params& p) {
    const size_t nchunk = (size_t)DEPTH_ * 16384 * 2 * 32;
    const size_t stride = (size_t)LGRID() * NTHR;
    for (size_t i = (size_t)LBID() * NTHR + LTID(WV_); i < nchunk; i += 2 * stride) {
        const size_t i2 = i + stride; const bool has2 = i2 < nchunk; const size_t j2 = has2 ? i2 : i;
        const int c0 = (int)(i & 31), uv0 = (int)((i >> 5) & 1); const size_t le0 = i >> 6;
        const int c1 = (int)(j2 & 31), uv1 = (int)((j2 >> 5) & 1); const size_t le1 = j2 >> 6;
        const float* src0 = (uv0 ? p.in[10] : p.in[9]) + le0 * 1024 + c0 * 32;
        const float* src1 = (uv1 ? p.in[10] : p.in[9]) + le1 * 1024 + c1 * 32;
        float4 a0[8], a1[8];
#pragma unroll
        for (int q4 = 0; q4 < 8; ++q4) a0[q4] = ((const float4*)src0)[q4];
#pragma unroll
        for (int q4 = 0; q4 < 8; ++q4) a1[q4] = ((const float4*)src1)[q4];
        unsigned w0[6], w1[6];
        cvt_chunk6(a0, uv0 ? V_SCALE : U_SCALE, w0);
        cvt_chunk6(a1, uv1 ? V_SCALE : U_SCALE, w1);
        uint2* dst0 = (uint2*)(p.ws + WS_UV + le0 * ROW6 + uv0 * 768 + c0 * 24);
        dst0[0] = make_uint2(w0[0], w0[1]); dst0[1] = make_uint2(w0[2], w0[3]); dst0[2] = make_uint2(w0[4], w0[5]);
        if (has2) { uint2* dst1 = (uint2*)(p.ws + WS_UV + le1 * ROW6 + uv1 * 768 + c1 * 24);
            dst1[0] = make_uint2(w1[0], w1[1]); dst1[1] = make_uint2(w1[2], w1[3]); dst1[2] = make_uint2(w1[4], w1[5]); }
    }
}
__device__ __forceinline__ v6u_t ld_pk6(const unsigned char* ptr) {
    const uint2 a = ((const uint2*)ptr)[0], b = ((const uint2*)ptr)[1], c = ((const uint2*)ptr)[2];
    const v6u_t pk = {a.x, a.y, b.x, b.y, c.x, c.y};
    return pk;
}
__device__ void peer_fast_phase(int WV_, float* h, bf16* hb, const int* eid, const float* gate, const unsigned char* uv, const float* g1, const float* b1, const float* g, const float* bb, unsigned char* lds) {
    const int tid = LTID(WV_), lane = tid & 63, wave = tid >> 6, l32 = lane & 31, hi = lane >> 5;
    float* pl = (float*)(lds + wave * 16384);
    unsigned char* raw = lds + wave * 16384 + 4096 + lane * 24;
    for (int t = LBID() * NWAVE + wave; t < T_; t += LGRID() * NWAVE) {
        float* hr = h + (size_t)t * 1024 + l32 * 32;
        float x[32], acc[32];
#pragma unroll
        for (int q4 = 0; q4 < 4; ++q4) { const uint4 a = ((const uint4*)(hb + (size_t)t * 1024 + l32 * 32))[q4];
            x[8 * q4] = __uint_as_float(a.x << 16); x[8 * q4 + 1] = __uint_as_float(a.x & 0xffff0000u); x[8 * q4 + 2] = __uint_as_float(a.y << 16); x[8 * q4 + 3] = __uint_as_float(a.y & 0xffff0000u);
            x[8 * q4 + 4] = __uint_as_float(a.z << 16); x[8 * q4 + 5] = __uint_as_float(a.z & 0xffff0000u); x[8 * q4 + 6] = __uint_as_float(a.w << 16); x[8 * q4 + 7] = __uint_as_float(a.w & 0xffff0000u); }
        {
            float s = 0.f;
#pragma unroll
            for (int i = 0; i < 32; ++i) s += x[i];
#pragma unroll
            for (int o = 16; o > 0; o >>= 1) s += __shfl_xor(s, o);
            const float mean = s * (1.0f / 1024.0f);
            float s2 = 0.f;
#pragma unroll
            for (int i = 0; i < 32; ++i) { x[i] -= mean; s2 += x[i] * x[i]; }
#pragma unroll
            for (int o = 16; o > 0; o >>= 1) s2 += __shfl_xor(s2, o);
            const float rstd = 1.0f / sqrtf(s2 * (1.0f / 1024.0f) + LN_EPS);
#pragma unroll
            for (int q4 = 0; q4 < 8; ++q4) { const float4 gg = ((const float4*)(g1 + l32 * 32))[q4], cc = ((const float4*)(b1 + l32 * 32))[q4];
                x[4 * q4] = x[4 * q4] * rstd * gg.x + cc.x; x[4 * q4 + 1] = x[4 * q4 + 1] * rstd * gg.y + cc.y; x[4 * q4 + 2] = x[4 * q4 + 2] * rstd * gg.z + cc.z; x[4 * q4 + 3] = x[4 * q4 + 3] * rstd * gg.w + cc.w; }
        }
#pragma unroll
        for (int i = 0; i < 32; ++i) acc[i] = 0.f;
#pragma unroll 1
        for (int batch = 0; batch < 4; ++batch) {
            const int my_eid = eid[(size_t)t * 128 + batch * 32 + l32];
            const float my_gate = gate[(size_t)t * 128 + batch * 32 + l32];
#pragma unroll 1
            for (int grp = 0; grp < 2; ++grp) {
                { u32x4a8_t pa[8]; uint2 pc[8];
#pragma unroll
                  for (int i = 0; i < 8; ++i) { const int id = __shfl(my_eid, 2 * (grp * 8 + i) + hi); const unsigned char* rp = uv + (size_t)id * ROW6 + l32 * 24; pa[i] = *(const u32x4a8_t*)rp; pc[i] = *(const uint2*)(rp + 16); }
#pragma unroll
                  for (int i = 0; i < 8; ++i) { uint2* wp = (uint2*)(raw + i * 1536); wp[0] = make_uint2(pa[i].x, pa[i].y); wp[1] = make_uint2(pa[i].z, pa[i].w); wp[2] = pc[i]; } }
#pragma unroll 1
                for (int i = 0; i < 8; ++i) {
                    const uint2* rp = (const uint2*)(raw + i * 1536); const uint2 a = rp[0], b = rp[1], c = rp[2];
                    const v6u_t pk6 = {a.x, a.y, b.x, b.y, c.x, c.y}; const v32f_t f = __builtin_amdgcn_cvt_scalef32_pk32_f32_fp6(pk6, 1.0f);
                    f32x2_t dv0 = {0.f, 0.f}, dv1 = {0.f, 0.f};
#pragma unroll
                    for (int j = 0; j < 8; ++j) { const f32x2_t fa = {f[2 * j], f[2 * j + 1]}, fb = {f[16 + 2 * j], f[17 + 2 * j]}, xa = {x[2 * j], x[2 * j + 1]}, xb = {x[16 + 2 * j], x[17 + 2 * j]};
                        dv0 = fa * xa + dv0; dv1 = fb * xb + dv1; }
                    pl[(2 * (grp * 8 + i) + hi) * 32 + l32] = (dv0.x + dv0.y) + (dv1.x + dv1.y);
                }
            }
            float d;
            { const float4* pr = (const float4*)(pl + l32 * 32); float4 s4 = pr[0];
#pragma unroll
              for (int i = 1; i < 8; ++i) { const float4 v = pr[i]; s4.x += v.x; s4.y += v.y; s4.z += v.z; s4.w += v.w; }
              d = ((s4.x + s4.y) + (s4.z + s4.w)) * (1.0f / U_SCALE); }
            const float hv = 0.5f * d * (1.0f + erff(d * 0.70710678118654752f)) * my_gate * (1.0f / V_SCALE);
#pragma unroll 1
            for (int grp = 0; grp < 2; ++grp) {
                { u32x4a8_t pa[8]; uint2 pc[8];
#pragma unroll
                  for (int i = 0; i < 8; ++i) { const int id = __shfl(my_eid, 2 * (grp * 8 + i) + hi); const unsigned char* rp = uv + (size_t)id * ROW6 + 768 + l32 * 24; pa[i] = *(const u32x4a8_t*)rp; pc[i] = *(const uint2*)(rp + 16); }
#pragma unroll
                  for (int i = 0; i < 8; ++i) { uint2* wp = (uint2*)(raw + i * 1536); wp[0] = make_uint2(pa[i].x, pa[i].y); wp[1] = make_uint2(pa[i].z, pa[i].w); wp[2] = pc[i]; } }
#pragma unroll 1
                for (int i = 0; i < 8; ++i) {
                    const float c = __shfl(hv, 2 * (grp * 8 + i) + hi);
                    const uint2* rp = (const uint2*)(raw + i * 1536); const uint2 a = rp[0], b = rp[1], cc = rp[2];
                    const v6u_t pk6 = {a.x, a.y, b.x, b.y, cc.x, cc.y}; const v32f_t f = __builtin_amdgcn_cvt_scalef32_pk32_f32_fp6(pk6, 1.0f);
                    const f32x2_t c2 = {c, c};
#pragma unroll
                    for (int j = 0; j < 16; ++j) { const f32x2_t fj = {f[2 * j], f[2 * j + 1]}; f32x2_t aj = {acc[2 * j], acc[2 * j + 1]}; aj = fj * c2 + aj; acc[2 * j] = aj.x; acc[2 * j + 1] = aj.y; }
                }
            }
        }
        float y[32], s = 0.f;
#pragma unroll
        for (int i = 0; i < 32; ++i) { acc[i] += __shfl_xor(acc[i], 32); y[i] = ALPHA * x[i] + acc[i]; s += y[i]; }
#pragma unroll
        for (int o = 16; o > 0; o >>= 1) s += __shfl_xor(s, o);
        const float mean = s * (1.0f / 1024.0f);
        float s2 = 0.f;
#pragma unroll
        for (int i = 0; i < 32; ++i) { y[i] -= mean; s2 += y[i] * y[i]; }
#pragma unroll
        for (int o = 16; o > 0; o >>= 1) s2 += __shfl_xor(s2, o);
        const float rstd = 1.0f / sqrtf(s2 * (1.0f / 1024.0f) + LN_EPS);
        float o[16];
#pragma unroll
        for (int q4 = 0; q4 < 4; ++q4) {
            const float4 gg = ((const float4*)(g + l32 * 32 + hi * 16))[q4], cc = ((const float4*)(bb + l32 * 32 + hi * 16))[q4];
            float ya[4], yb2[4];
#pragma unroll
            for (int e = 0; e < 4; ++e) { ya[e] = y[4 * q4 + e]; yb2[e] = y[16 + 4 * q4 + e]; }
            asm volatile("" : "+v"(ya[0]), "+v"(ya[1]), "+v"(ya[2]), "+v"(ya[3]), "+v"(yb2[0]), "+v"(yb2[1]), "+v"(yb2[2]), "+v"(yb2[3]));
            const float y0 = hi ? yb2[0] : ya[0], y1 = hi ? yb2[1] : ya[1], y2 = hi ? yb2[2] : ya[2], y3 = hi ? yb2[3] : ya[3];
            o[4 * q4] = y0 * rstd * gg.x + cc.x; o[4 * q4 + 1] = y1 * rstd * gg.y + cc.y; o[4 * q4 + 2] = y2 * rstd * gg.z + cc.z; o[4 * q4 + 3] = y3 * rstd * gg.w + cc.w;
            if (h) ((float4*)(hr + hi * 16))[q4] = make_float4(o[4 * q4], o[4 * q4 + 1], o[4 * q4 + 2], o[4 * q4 + 3]);
        }
        uint4* hbp = (uint4*)(hb + (size_t)t * 1024 + l32 * 32 + hi * 16);
        hbp[0] = make_uint4(pk2(o[0], o[1]), pk2(o[2], o[3]), pk2(o[4], o[5]), pk2(o[6], o[7]));
        hbp[1] = make_uint4(pk2(o[8], o[9]), pk2(o[10], o[11]), pk2(o[12], o[13]), pk2(o[14], o[15]));
    }
}

__device__ __forceinline__ float pack_pl(float v, unsigned pl) { return __uint_as_float((__float_as_uint(v) & ~127u) | pl); }
__device__ __forceinline__ void ins16(float (&s)[16], float x) {
#pragma unroll
    for (int k = 15; k >= 1; --k) s[k] = __builtin_amdgcn_fmed3f(s[k - 1], x, s[k]);
    s[0] = vmax(s[0], x);
}
template <int D> __device__ __forceinline__ void bitonic_stage(float (&c)[16]) {
#pragma unroll
    for (int i = 0; i < 16; ++i) if ((i & D) == 0) { const float a = vmax(c[i], c[i + D]), b = vmin(c[i], c[i + D]); c[i] = a; c[i + D] = b; }
}
__device__ __forceinline__ int decode_key(unsigned pl) { return (int)(32u * ((pl >> 4) & 3u) + (pl & 3u) + 8u * ((pl >> 2) & 3u) + 4u * ((pl >> 6) & 1u)); }
__device__ void route_fast_phase(int WV_, const bf16* qb, const bf16* skb  , int* eid, float* gate, unsigned char* lds, int pm = -1, int pn = 0) {
    const int tid = LTID(WV_), lane = tid & 63, wave = tid >> 6, r32 = lane & 31, hi = lane >> 5;
    unsigned* lidx = (unsigned*)lds + wave * (64 * 33) + lane * 33;
    const int u_first = (pm >= 0) ? 0 : LBID() * NWAVE + wave, u_end = (pm >= 0) ? 2 : (T_ / 32) * 8, u_step = (pm >= 0) ? 1 : LGRID() * NWAVE;
    for (int unit = u_first; unit < u_end; unit += u_step) {
        const int h = (pm >= 0) ? 2 * pn + unit : (unit & 7), t = ((pm >= 0) ? 8 * pm + wave : (unit >> 3)) * 32 + r32;
        float sl[2][16];
#pragma unroll
        for (int p = 0; p < 2; ++p) {
            bf16x8_t qf[4];
            { const bf16* qp = qb + (size_t)t * 1024 + h * 128 + p * 64 + 8 * hi;
#pragma unroll
              for (int ks = 0; ks < 4; ++ks) qf[ks] = *(const bf16x8_t*)(qp + 16 * ks); }
            float s[16];
#pragma unroll
            for (int k = 0; k < 16; ++k) s[k] = -INFINITY;
            const bf16* skp = skb + ((size_t)(h * 2 + p) * 128 + r32) * 64 + 8 * hi;
#pragma unroll
            for (int kt = 0; kt < 4; ++kt) {
                f32x16_t acc;
#pragma unroll
                for (int r = 0; r < 16; ++r) acc[r] = 0.f;
#pragma unroll
                for (int ks = 0; ks < 4; ++ks) { const bf16x8_t a = *(const bf16x8_t*)(skp + (size_t)kt * 32 * 64 + 16 * ks); acc = __builtin_amdgcn_mfma_f32_32x32x16_bf16(a, qf[ks], acc, 0, 0, 0); }
#pragma unroll
                for (int r = 0; r < 16; ++r) ins16(s, pack_pl(acc[r], (unsigned)(kt * 16 + r)));
            }
            const unsigned hb = (unsigned)hi << 6;
#pragma unroll
            for (int k = 0; k < 16; ++k) s[k] = __uint_as_float(__float_as_uint(s[k]) | hb);
            float c[16];
#pragma unroll
            for (int k = 0; k < 16; ++k) c[k] = vmax(s[k], __shfl_xor(s[15 - k], 32));
            bitonic_stage<8>(c); bitonic_stage<4>(c); bitonic_stage<2>(c); bitonic_stage<1>(c);
#pragma unroll
            for (int k = 0; k < 16; ++k) { sl[p][k] = c[k]; lidx[p * 16 + k] = (unsigned)decode_key(__float_as_uint(c[k]) & 127u); }
        }
        float w[16];
#pragma unroll
        for (int k = 0; k < 16; ++k) w[k] = -INFINITY;
#pragma unroll
        for (int i = 0; i < 16; ++i)
#pragma unroll
            for (int j = 0; j < 16; ++j)
                if ((i + 1) * (j + 1) <= 16) { const float v = sl[0][i] + sl[1][j]; ins16(w, __uint_as_float((__float_as_uint(v) & ~255u) | (unsigned)(i * 16 + j))); }
        float e[16], sum = 0.f;
#pragma unroll
        for (int k = 0; k < 16; ++k) { e[k] = __builtin_amdgcn_exp2f((w[k] - w[0]) * 1.44269504f); sum += e[k]; }
        const float inv = 1.0f / sum;
        int ide[8]; float gte[8];
#pragma unroll
        for (int k = 0; k < 8; ++k) {
            float wa = w[k], wb = w[8 + k], ea = e[k], eb = e[8 + k];
            asm volatile("" : "+v"(wa), "+v"(wb), "+v"(ea), "+v"(eb));
            const float wv = hi ? wb : wa;
            const unsigned pl = __float_as_uint(wv) & 255u;
            ide[k] = (int)(lidx[pl >> 4] * 128u + lidx[16 + (pl & 15u)]);
            gte[k] = (hi ? eb : ea) * inv;
        }
        int* ep = eid + (size_t)t * 128 + h * 16 + hi * 8; float* gp = gate + (size_t)t * 128 + h * 16 + hi * 8;
        *(int4*)ep = make_int4(ide[0], ide[1], ide[2], ide[3]); *(int4*)(ep + 4) = make_int4(ide[4], ide[5], ide[6], ide[7]);
        *(float4*)gp = make_float4(gte[0], gte[1], gte[2], gte[3]); *(float4*)(gp + 4) = make_float4(gte[4], gte[5], gte[6], gte[7]);
    }
}
#ifndef TS_SEL
#define TS_SEL 0
#endif
#define ITS_B() do { if (TS_SEL >= 20 && TS_SEL <= 40 && WV_ == 0 && LANEID() == 0) ((volatile __attribute__((address_space(3))) unsigned long long*)((__attribute__((address_space(3))) unsigned char*)lds + 147456 - 16 - 32))[0] = __builtin_amdgcn_s_memrealtime(); } while (0)
#define ITS_E(k) do { if ((k) == TS_SEL && WV_ == 0 && LANEID() == 0) { volatile __attribute__((address_space(3))) unsigned long long* w_ = (volatile __attribute__((address_space(3))) unsigned long long*)((__attribute__((address_space(3))) unsigned char*)lds + 147456 - 16 - 32); w_[1] += __builtin_amdgcn_s_memrealtime() - w_[0]; } } while (0)

typedef float f32x4_t __attribute__((ext_vector_type(4)));
typedef __bf16 bf16x2v __attribute__((ext_vector_type(2)));
__device__ __forceinline__ float dot2bf(unsigned a, unsigned b, float c) { return __builtin_amdgcn_fdot2_f32_bf16(__builtin_bit_cast(bf16x2v, a), __builtin_bit_cast(bf16x2v, b), c, false); }
__device__ __forceinline__ void cnt_gt(int& cnt, unsigned a, unsigned b) { asm("v_cmp_gt_u32_e32 vcc, %1, %2\n\tv_addc_co_u32_e32 %0, vcc, 0, %0, vcc" : "+v"(cnt) : "v"(a), "v"(b) : "vcc"); }
__device__ __forceinline__ void cnt_eq(int& cnt, unsigned a, unsigned b) { asm("v_cmp_eq_u32_e32 vcc, %1, %2\n\tv_addc_co_u32_e32 %0, vcc, 0, %0, vcc" : "+v"(cnt) : "v"(a), "v"(b) : "vcc"); }
__device__ __forceinline__ unsigned flag_gt(unsigned a, unsigned b) { unsigned r; asm("v_cmp_gt_u32_e32 vcc, %1, %2\n\tv_cndmask_b32_e64 %0, 0, 1, vcc" : "=v"(r) : "v"(a), "v"(b) : "vcc"); return r; }
__device__ __forceinline__ unsigned flag_eq(unsigned a, unsigned b) { unsigned r; asm("v_cmp_eq_u32_e32 vcc, %1, %2\n\tv_cndmask_b32_e64 %0, 0, 1, vcc" : "=v"(r) : "v"(a), "v"(b) : "vcc"); return r; }
__device__ __forceinline__ void cnt_ge(int& cnt, unsigned key, unsigned cand) { asm("v_cmp_ge_u32_e32 vcc, %1, %2\n\tv_addc_co_u32_e32 %0, vcc, 0, %0, vcc" : "+v"(cnt) : "v"(key), "v"(cand) : "vcc"); }

template <int CTRL, int RM> __device__ __forceinline__ unsigned dpp0(unsigned v) { return (unsigned)__builtin_amdgcn_update_dpp(0, (int)v, CTRL, RM, 0xf, false); }
template <int CTRL> __device__ __forceinline__ unsigned dppf(unsigned v) { return (unsigned)__builtin_amdgcn_update_dpp(-1, (int)v, CTRL, 0xf, 0xf, false); }
__device__ __forceinline__ unsigned wave_sum_u_dpp(unsigned v) {
    v += dpp0<0xB1, 0xf>(v); v += dpp0<0x4E, 0xf>(v); v += dpp0<0x141, 0xf>(v); v += dpp0<0x140, 0xf>(v);
    return (unsigned)__builtin_amdgcn_readlane((int)v, 0) + (unsigned)__builtin_amdgcn_readlane((int)v, 16) + (unsigned)__builtin_amdgcn_readlane((int)v, 32) + (unsigned)__builtin_amdgcn_readlane((int)v, 48);
}
__device__ __forceinline__ unsigned wave_min_u_dpp(unsigned v) {
    unsigned t;
    t = dppf<0xB1>(v); v = t < v ? t : v; t = dppf<0x4E>(v); v = t < v ? t : v; t = dppf<0x141>(v); v = t < v ? t : v; t = dppf<0x140>(v); v = t < v ? t : v;
    const unsigned a = (unsigned)__builtin_amdgcn_readlane((int)v, 0), b = (unsigned)__builtin_amdgcn_readlane((int)v, 16), c = (unsigned)__builtin_amdgcn_readlane((int)v, 32), d = (unsigned)__builtin_amdgcn_readlane((int)v, 48);
    const unsigned ab = a < b ? a : b, cd = c < d ? c : d; return ab < cd ? ab : cd;
}
__device__ __forceinline__ unsigned wave_incl_scan_u_dpp(unsigned v) {
    v += dpp0<0x111, 0xf>(v); v += dpp0<0x112, 0xf>(v); v += dpp0<0x114, 0xf>(v); v += dpp0<0x118, 0xf>(v);
    v += dpp0<0x142, 0xa>(v);
    v += dpp0<0x143, 0xc>(v);
    return v;
}
typedef __attribute__((address_space(3))) unsigned lds_u32;
template <int SHIFT> __device__ __forceinline__ unsigned radix_pass(const unsigned (&key)[64], unsigned pre, lds_u32* hist, int lane, int& need, int jlim, unsigned L, unsigned& cntsel) {
    typedef unsigned u32x4v __attribute__((ext_vector_type(4)));
    typedef __attribute__((address_space(3))) u32x4v lds_u32x4;
    const int fl = 63 - lane;
    { const u32x4v z4 = {0u, 0u, 0u, 0u};
      ((lds_u32x4*)(hist + fl * 4))[0] = z4; }
    const unsigned hb = (unsigned)(size_t)hist;
    const unsigned one = 1u;
    asm volatile("" ::: "memory");
#pragma unroll
    for (int j4 = 0; j4 < 16; ++j4) {
        if (4 * j4 <= jlim) {
            unsigned long long c0, c1, c2, c3, sv; unsigned t0, t1, t2, t3;
            if (SHIFT == 24)
                asm volatile(
                    "v_cmp_ge_u32_e64 %0, %9, %13\n\tv_cmp_ge_u32_e64 %1, %10, %13\n\tv_cmp_ge_u32_e64 %2, %11, %13\n\tv_cmp_ge_u32_e64 %3, %12, %13\n\t"
                    "v_lshrrev_b32_e32 %5, 24, %9\n\tv_lshrrev_b32_e32 %6, 24, %10\n\tv_lshrrev_b32_e32 %7, 24, %11\n\tv_lshrrev_b32_e32 %8, 24, %12\n\t"
                    "v_lshl_add_u32 %5, %5, 2, %14\n\tv_lshl_add_u32 %6, %6, 2, %14\n\tv_lshl_add_u32 %7, %7, 2, %14\n\tv_lshl_add_u32 %8, %8, 2, %14\n\t"
                    "s_mov_b64 %4, exec\n\t"
                    "s_mov_b64 exec, %0\n\tds_add_u32 %5, %15\n\ts_mov_b64 exec, %1\n\tds_add_u32 %6, %15\n\ts_mov_b64 exec, %2\n\tds_add_u32 %7, %15\n\ts_mov_b64 exec, %3\n\tds_add_u32 %8, %15\n\t"
                    "s_mov_b64 exec, %4"
                    : "=&s"(c0), "=&s"(c1), "=&s"(c2), "=&s"(c3), "=&s"(sv), "=&v"(t0), "=&v"(t1), "=&v"(t2), "=&v"(t3)
                    : "v"(key[4 * j4]), "v"(key[4 * j4 + 1]), "v"(key[4 * j4 + 2]), "v"(key[4 * j4 + 3]), "v"(L), "v"(hb), "v"(one) : "memory");
            else
                asm volatile(
                    "v_lshrrev_b32_e32 %5, %16, %9\n\tv_lshrrev_b32_e32 %6, %16, %10\n\tv_lshrrev_b32_e32 %7, %16, %11\n\tv_lshrrev_b32_e32 %8, %16, %12\n\t"
                    "v_cmp_eq_u32_e64 %0, %5, %13\n\tv_cmp_eq_u32_e64 %1, %6, %13\n\tv_cmp_eq_u32_e64 %2, %7, %13\n\tv_cmp_eq_u32_e64 %3, %8, %13\n\t"
                    "s_or_b64 %4, %0, %1\n\ts_or_b64 %4, %4, %2\n\ts_or_b64 %4, %4, %3\n\t"
                    "s_cbranch_scc0 .Lrxskip%=\n\t"
                    "v_bfe_u32 %5, %9, %17, 8\n\tv_bfe_u32 %6, %10, %17, 8\n\tv_bfe_u32 %7, %11, %17, 8\n\tv_bfe_u32 %8, %12, %17, 8\n\t"
                    "v_lshl_add_u32 %5, %5, 2, %14\n\tv_lshl_add_u32 %6, %6, 2, %14\n\tv_lshl_add_u32 %7, %7, 2, %14\n\tv_lshl_add_u32 %8, %8, 2, %14\n\t"
                    "s_mov_b64 %4, exec\n\t"
                    "s_mov_b64 exec, %0\n\tds_add_u32 %5, %15\n\ts_mov_b64 exec, %1\n\tds_add_u32 %6, %15\n\ts_mov_b64 exec, %2\n\tds_add_u32 %7, %15\n\ts_mov_b64 exec, %3\n\tds_add_u32 %8, %15\n\t"
                    "s_mov_b64 exec, %4\n"
                    ".Lrxskip%=:"
                    : "=&s"(c0), "=&s"(c1), "=&s"(c2), "=&s"(c3), "=&s"(sv), "=&v"(t0), "=&v"(t1), "=&v"(t2), "=&v"(t3)
                    : "v"(key[4 * j4]), "v"(key[4 * j4 + 1]), "v"(key[4 * j4 + 2]), "v"(key[4 * j4 + 3]), "v"(pre), "v"(hb), "v"(one), "n"((SHIFT + 8) & 31), "n"(SHIFT) : "memory", "scc");
        }
    }
    asm volatile("s_waitcnt lgkmcnt(0)" ::: "memory");
    unsigned dsum[4]; unsigned sumL = 0u;
    { const u32x4v v0 = ((const lds_u32x4*)(hist + fl * 4))[0];
      dsum[0] = v0.x; dsum[1] = v0.y; dsum[2] = v0.z; dsum[3] = v0.w; sumL = (dsum[0] + dsum[1]) + (dsum[2] + dsum[3]); }
    const unsigned incl = wave_incl_scan_u_dpp(sumL);
    const unsigned above = incl - sumL;
    const bool own = (above < (unsigned)need) && ((unsigned)need <= above + sumL);
    const int owner = __ffsll((long long)__ballot(own)) - 1;
    unsigned acc = above; int sel = -1; unsigned cab = 0u;
    unsigned csel = 0u;
#pragma unroll
    for (int i = 3; i >= 0; --i) { const unsigned c = dsum[i]; const bool hit = (sel < 0) && (acc + c >= (unsigned)need); cab = hit ? acc : cab; csel = hit ? c : csel; sel = hit ? i : sel; acc += c; }
    const int ow = owner < 0 ? 0 : owner;
    const unsigned digit = (unsigned)__builtin_amdgcn_readlane(sel, ow) + (unsigned)(4 * (63 - ow));
    need -= (int)__builtin_amdgcn_readlane((int)cab, ow);
    cntsel = (unsigned)__builtin_amdgcn_readlane((int)csel, ow);
    return digit;
}

__device__ __forceinline__ void idx_select(const unsigned (&key)[64], unsigned t3, int jlim, lds_u32* hist, int lane, uint2* mrow, int WV_, unsigned char* lds) {
        unsigned wlo = 0u, whi = 0u;
        unsigned L = wave_min_u_dpp(t3);
        L = L > 1u ? L : 1u;

        int need = 256;
        ITS_E(34); ITS_B();
        unsigned cs; bool fin;
        const unsigned d1 = radix_pass<24>(key, 0u, hist, lane, need, jlim, L, cs);
        unsigned prefix = d1 << 24; fin = cs == (unsigned)need;
        if (fin) prefix = prefix > L ? prefix : L;
        if (!fin) {
            const unsigned d2 = radix_pass<16>(key, d1, hist, lane, need, jlim, L, cs);
            prefix |= d2 << 16; fin = cs == (unsigned)need;
            if (!fin) {
                const unsigned d3 = radix_pass<8>(key, (d1 << 8) | d2, hist, lane, need, jlim, L, cs);
                prefix |= d3 << 8; fin = cs == (unsigned)need;
                if (!fin) { const unsigned d4 = radix_pass<0>(key, (d1 << 16) | (d2 << 8) | d3, hist, lane, need, jlim, L, cs); prefix |= d4; }
            }
        }
        int ceq = 0;
        if (!fin)
#pragma unroll
        for (int j4 = 0; j4 < 16; ++j4) if (4 * j4 <= jlim) { cnt_eq(ceq, key[4 * j4], prefix); cnt_eq(ceq, key[4 * j4 + 1], prefix); cnt_eq(ceq, key[4 * j4 + 2], prefix); cnt_eq(ceq, key[4 * j4 + 3], prefix); }
        ceq = (int)wave_sum_u_dpp((unsigned)ceq);
        int X = 4096;
        if (!fin && ceq != need) {
            int X0 = 0;
#pragma unroll 1
            for (int bit = 11; bit >= 0; --bit) {
                const int c = X0 | (1 << bit);
                int cnt = 0; const int crel = (c - lane + 63) >> 6;
#pragma unroll
                for (int j = 0; j < 64; ++j) cnt_eq(cnt, (key[j] ^ prefix) | ~(unsigned)((j - crel) >> 31), 0u);
                cnt = wave_sum_i(cnt);
                if (cnt < need) X0 = c;
            }
            X = X0 + 1;
        }
        const int xrel = (X - lane + 63) >> 6;
#pragma unroll
        for (int j4 = 0; j4 < 16; ++j4) {
            if (4 * j4 <= jlim) {
#pragma unroll
                for (int e = 0; e < 4; ++e) { const int j = 4 * j4 + e;
                    const bool sel = (key[j] > prefix) || (key[j] == prefix && j < xrel);
                    const unsigned long long bm = __ballot(sel);
                    asm("v_writelane_b32 %0, %1, %2" : "+v"(wlo) : "s"((unsigned)bm), "n"(j));
                    asm("v_writelane_b32 %0, %1, %2" : "+v"(whi) : "s"((unsigned)(bm >> 32)), "n"(j)); }
            }
        }
        mrow[lane] = make_uint2(wlo, whi);
        ITS_E(33); ITS_B();
}
__device__ void index_fast_phase(int WV_, const bf16* P, unsigned char* mask, float* kmean, float* scratch_all, unsigned* qctr, unsigned char* lds) {
    const int tid = LTID(WV_), lane = tid & 63, wave = tid >> 6, bid = LBID(), G = LGRID();
    float* s_part = (float*)lds;
    ITS_B();
    for (int k = bid; k < 256; k += G) {
        const int b = k >> 6, h = (k >> 4) & 3, blk = k & 15;
        float* sp = (float*)(lds + 69632);
        { const int rg = lane >> 3, c = lane & 7;
          const bf16* kp = P + (size_t)(b * S_ + blk * 256 + wave * 32 + rg) * NP + C_KC + h * 64 + c * 8;
          uint4 kv[4];
#pragma unroll
          for (int j = 0; j < 4; ++j) kv[j] = *(const uint4*)(kp + (size_t)(8 * j) * NP);
          float acc8[8];
#pragma unroll
          for (int e = 0; e < 8; ++e) acc8[e] = 0.f;
#pragma unroll
          for (int j = 0; j < 4; ++j) { float t[8]; unpack8(kv[j], t);
#pragma unroll
              for (int e = 0; e < 8; ++e) acc8[e] += t[e]; }
          __syncthreads();
          float4* dst = (float4*)(sp + (wave * 8 + rg) * 64 + c * 8);
          dst[0] = make_float4(acc8[0], acc8[1], acc8[2], acc8[3]); dst[1] = make_float4(acc8[4], acc8[5], acc8[6], acc8[7]); }
        __syncthreads();
        if (tid < 64) { float s = 0.f;
#pragma unroll 16
            for (int r = 0; r < 64; ++r) s += sp[r * 64 + tid];
            kmean[((b * 4 + h) * 16 + blk) * 64 + tid] = s * (1.0f / 256.0f); }
    }
    ITS_E(22);
    constexpr int IDX_CP = 512 + 4;
    constexpr int IDX_PITCH = 4096 + 32;
    float* scr = scratch_all + (size_t)bid * (16 * IDX_PITCH);
    const int lq = lane & 15, g4 = lane >> 4;
    for (int ui = bid; ui < 1024; ui += G) {
        const int b = ui >> 8, k = ui & 255, tile = (b & 1) ? 255 - k : k, q0 = tile * 16;
        const bf16* Pb = P + (size_t)b * S_ * NP;
        const int ntiles = tile + 1;
        int lane_o = LANEID(); asm volatile("" : "+v"(lane_o));
        const int lane = lane_o, lq = lane & 15, g4 = lane >> 4;
        const int wave = WV_;
        const int qA = q0 + 2 * wave, qB = qA + 1;
        uint2* mrowA = (uint2*)(mask + (size_t)(b * S_ + qA) * 512); uint2* mrowB = (uint2*)(mask + (size_t)(b * S_ + qB) * 512);
        if (tile < 16) {
            unsigned wlo = 0u, whi = 0u, xlo = 0u, xhi = 0u; const int ra = qA - lane * 64, rb = qB - lane * 64;
#pragma unroll
            for (int j = 0; j < 32; ++j) { wlo |= (~(unsigned)((ra - j) >> 31) & 1u) << j; whi |= (~(unsigned)((ra - 32 - j) >> 31) & 1u) << j;
                                           xlo |= (~(unsigned)((rb - j) >> 31) & 1u) << j; xhi |= (~(unsigned)((rb - 32 - j) >> 31) & 1u) << j; }
            mrowA[lane] = make_uint2(wlo, whi); mrowB[lane] = make_uint2(xlo, xhi);
            continue;
        }
        ITS_B();
        bf16x8_t qf[8]; float wi[8];
        { const bf16* qp = Pb + (size_t)(q0 + lq) * NP + C_QI + 8 * g4;
#pragma unroll
          for (int h = 0; h < 8; ++h) qf[h] = *(const bf16x8_t*)(qp + 32 * h);
          const uint4 wv = *(const uint4*)(Pb + (size_t)(q0 + lq) * NP + C_WI); unpack8(wv, wi); }
        bf16x8_t qch, qcl;
        { typedef unsigned u32x4_t __attribute__((ext_vector_type(4)));
          float qc[8];
#pragma unroll
          for (int i = 0; i < 8; ++i) qc[i] = 0.f;
#pragma unroll
          for (int h = 0; h < 8; ++h) { const u32x4_t w4 = __builtin_bit_cast(u32x4_t, qf[h]);
#pragma unroll
              for (int i = 0; i < 4; ++i) { qc[2 * i] += wi[h] * __uint_as_float(w4[i] << 16); qc[2 * i + 1] += wi[h] * __uint_as_float(w4[i] & 0xffff0000u); } }
          u32x4_t hi4, lo4;
#pragma unroll
          for (int i = 0; i < 4; ++i) { const unsigned hw = cvtpk(qc[2 * i], qc[2 * i + 1]); hi4[i] = hw;
              lo4[i] = cvtpk(qc[2 * i] - __uint_as_float(hw << 16), qc[2 * i + 1] - __uint_as_float(hw & 0xffff0000u)); }
          qch = __builtin_bit_cast(bf16x8_t, hi4); qcl = __builtin_bit_cast(bf16x8_t, lo4); }
        typedef __attribute__((address_space(3))) bf16x8_t lds_bf16x8;
        lds_bf16x8* qops = (lds_bf16x8*)((__attribute__((address_space(3))) unsigned char*)lds + 102656);
        if (wave == 0) {
#pragma unroll
            for (int h = 0; h < 8; ++h) qops[h * 64 + lane] = qf[h];
            qops[8 * 64 + lane] = qch; qops[9 * 64 + lane] = qcl; }
        __syncthreads();
        ITS_E(20); ITS_B();
        float* cb0 = (float*)(lds + 69632); float* cb1 = (float*)(lds + 112896);
        const int jlim = q0 >> 6;
        const int jmaxA = (qA - lane) >> 6, jmaxB = (qB - lane) >> 6;
        unsigned keyA[64], keyB[64];
        unsigned a0 = 0u, a1 = 0u, a2 = 0u, a3 = 0u, b0 = 0u, b1 = 0u, b2 = 0u, b3 = 0u;
        const bf16* kbase = Pb + (size_t)lq * NP + C_KI + 8 * g4;
        bf16x8_t nxt = *(const bf16x8_t*)(kbase + (size_t)(wave < ntiles ? wave : 0) * 16 * NP);
#pragma unroll
        for (int c = 0; c < 8; ++c) {
            if (32 * c < ntiles) {
                float* cb = (c & 1) ? cb1 : cb0;
#pragma unroll
                for (int j = 0; j < 4; ++j) {
                    const int kt = 32 * c + wave + 8 * j;
                    const bf16x8_t af = nxt;
                    { const int k = kt + 8; const int kc = k < ntiles ? k : 0; nxt = *(const bf16x8_t*)(kbase + (size_t)kc * 16 * NP); }
                    if (kt < ntiles) {
                        const f32x4_t z = {0.f, 0.f, 0.f, 0.f};
                        f32x4_t sc = __builtin_amdgcn_mfma_f32_16x16x32_bf16(af, qops[8 * 64 + lane], z, 0, 0, 0);
                        sc = __builtin_amdgcn_mfma_f32_16x16x32_bf16(af, qops[9 * 64 + lane], sc, 0, 0, 0);
#pragma unroll
                        for (int hh = 0; hh < 2; ++hh) {
                            f32x4_t a[4];
#pragma unroll
                            for (int h = 0; h < 4; ++h) a[h] = __builtin_amdgcn_mfma_f32_16x16x32_bf16(af, qops[(4 * hh + h) * 64 + lane], z, 0, 0, 0);
#pragma unroll
                            for (int h = 0; h < 4; ++h)
#pragma unroll
                                for (int r = 0; r < 4; ++r) sc[r] = __builtin_fmaf(__builtin_fabsf(a[h][r]), wi[4 * hh + h], sc[r]);
                        }
#pragma unroll
                        for (int r = 0; r < 4; ++r) { sc[r] *= 0.03125f; if (sc[r] == 0.f) sc[r] = 0.f; }
                        *(f32x4_t*)(cb + lq * IDX_CP + (wave + 8 * j) * 16 + 4 * g4) = sc;
                    }
                }
                __syncthreads();
#pragma unroll
                for (int js = 0; js < 8; ++js) {
                    const int slot = 8 * c + js;
                    if (slot <= jlim) {
                        const unsigned ua = __float_as_uint(cb[(2 * wave) * IDX_CP + 64 * js + lane]), ub = __float_as_uint(cb[(2 * wave + 1) * IDX_CP + 64 * js + lane]);
                        const unsigned xa = (ua ^ ((unsigned)((int)ua >> 31) | 0x80000000u)) & ~(unsigned)((jmaxA - slot) >> 31);
                        const unsigned xb = (ub ^ ((unsigned)((int)ub >> 31) | 0x80000000u)) & ~(unsigned)((jmaxB - slot) >> 31);
                        keyA[slot] = xa; keyB[slot] = xb;
                        unsigned n1, n2, n3;
                        asm("v_med3_u32 %0, %1, %2, %3" : "=v"(n3) : "v"(a2), "v"(a3), "v"(xa));
                        asm("v_med3_u32 %0, %1, %2, %3" : "=v"(n2) : "v"(a1), "v"(a2), "v"(xa));
                        asm("v_med3_u32 %0, %1, %2, %3" : "=v"(n1) : "v"(a0), "v"(a1), "v"(xa));
                        a0 = a0 > xa ? a0 : xa; a1 = n1; a2 = n2; a3 = n3;
                        asm("v_med3_u32 %0, %1, %2, %3" : "=v"(n3) : "v"(b2), "v"(b3), "v"(xb));
                        asm("v_med3_u32 %0, %1, %2, %3" : "=v"(n2) : "v"(b1), "v"(b2), "v"(xb));
                        asm("v_med3_u32 %0, %1, %2, %3" : "=v"(n1) : "v"(b0), "v"(b1), "v"(xb));
                        b0 = b0 > xb ? b0 : xb; b1 = n1; b2 = n2; b3 = n3;
                    } else { keyA[slot] = 0u; keyB[slot] = 0u; }
                }
            } else {
#pragma unroll
                for (int js = 0; js < 8; ++js) { keyA[8 * c + js] = 0u; keyB[8 * c + js] = 0u; }
            }
        }
        lds_u32* hist = (lds_u32*)((__attribute__((address_space(3))) unsigned char*)lds + 2048) + wave * 2048;
        ITS_E(23); ITS_B();
        idx_select(keyA, a3, jlim, hist, lane, mrowA, WV_, lds);
        ITS_E(24); ITS_B();
        idx_select(keyB, b3, jlim, hist, lane, mrowB, WV_, lds);
        ITS_E(25); ITS_B();
    }
}

constexpr int MG_P = 72;
constexpr int MG_TILE_BYTES = 128 * MG_P * 2;
__device__ void merge_fast_phase(int WV_, const unsigned char* G8, const bf16* ys, const bf16* wbt  , bf16* merged, unsigned char* lds) {
    const int tid = LTID(WV_), lane = tid & 63, wave = tid >> 6, r32 = lane & 31, hi = lane >> 5, wt = wave & 3, wd = wave >> 2;
    const int srow0 = tid >> 3, sch = tid & 7;
    for (int tile = LBID(); tile < 1024; tile += LGRID()) {
        const int tok0 = (tile >> 3) * 128, d0 = (tile & 7) * 128;
        f32x16_t mer[2], acc[2];
#pragma unroll
        for (int r = 0; r < 16; ++r) { mer[0][r] = 0.f; mer[1][r] = 0.f; acc[0][r] = 0.f; acc[1][r] = 0.f; }
        uint4 RW00, RW01, RW10, RW11, RY00, RY01, RY10, RY11, RG0, RG1;
        unsigned char* gl = lds + 4 * MG_TILE_BYTES;
        const int grow = tid >> 3, gch = tid & 7;
#define MG_GLOAD(st_, R_) do { const int n_ = (st_) >> 2, kc_ = (st_) & 3; \
            RW##R_##0 = *(const uint4*)(wbt + ((size_t)n_ * 1024 + d0 + srow0) * 256 + kc_ * 64 + sch * 8); \
            RW##R_##1 = *(const uint4*)(wbt + ((size_t)n_ * 1024 + d0 + srow0 + 64) * 256 + kc_ * 64 + sch * 8); \
            RY##R_##0 = *(const uint4*)(ys + (size_t)(tok0 + srow0) * 1024 + n_ * 256 + kc_ * 64 + sch * 8); \
            RY##R_##1 = *(const uint4*)(ys + (size_t)(tok0 + srow0 + 64) * 1024 + n_ * 256 + kc_ * 64 + sch * 8); } while (0)
#define MG_SSTORE(buf_, R_) do { bf16* wl_ = (bf16*)(lds + (buf_) * 2 * MG_TILE_BYTES); bf16* yl_ = (bf16*)(lds + (buf_) * 2 * MG_TILE_BYTES + MG_TILE_BYTES); \
            *(uint4*)(wl_ + srow0 * MG_P + sch * 8) = RW##R_##0; *(uint4*)(wl_ + (srow0 + 64) * MG_P + sch * 8) = RW##R_##1; \
            *(uint4*)(yl_ + srow0 * MG_P + sch * 8) = RY##R_##0; *(uint4*)(yl_ + (srow0 + 64) * MG_P + sch * 8) = RY##R_##1; } while (0)
        __syncthreads();
        MG_GLOAD(0, 0); MG_GLOAD(1, 1);
        MG_SSTORE(0, 0);
        __syncthreads();
#define MG_STAGE(PAR_, OTH_) do { const int buf = PAR_; \
            if (st + 2 < 16) MG_GLOAD(st + 2, PAR_); \
            if ((st & 3) == 1) { const unsigned char* gsrc = G8 + (size_t)(tok0 + grow) * 4096 + (st >> 2) * 1024 + d0 + gch * 16; \
                RG0 = *(const uint4*)gsrc; RG1 = *(const uint4*)(gsrc + (size_t)64 * 4096); } \
            const bf16* wl = (const bf16*)(lds + buf * 2 * MG_TILE_BYTES); const bf16* yl = (const bf16*)(lds + buf * 2 * MG_TILE_BYTES + MG_TILE_BYTES); \
            _Pragma("unroll") for (int ks = 0; ks < 4; ++ks) { \
                const bf16x8_t bq = *(const bf16x8_t*)(yl + (32 * wt + r32) * MG_P + 16 * ks + 8 * hi); \
                const bf16x8_t a0 = *(const bf16x8_t*)(wl + (64 * wd + r32) * MG_P + 16 * ks + 8 * hi); \
                const bf16x8_t a1 = *(const bf16x8_t*)(wl + (64 * wd + 32 + r32) * MG_P + 16 * ks + 8 * hi); \
                acc[0] = __builtin_amdgcn_mfma_f32_32x32x16_bf16(a0, bq, acc[0], 0, 0, 0); \
                acc[1] = __builtin_amdgcn_mfma_f32_32x32x16_bf16(a1, bq, acc[1], 0, 0, 0); } \
            if ((st & 3) == 3) { \
                const int n = st >> 2; \
                const unsigned char* gp = gl + (32 * wt + r32) * 144 + 64 * wd + 4 * hi; (void)n; \
                _Pragma("unroll") for (int dt = 0; dt < 2; ++dt) \
                _Pragma("unroll") for (int g = 0; g < 4; ++g) { \
                        const int gv = *(const int*)(gp + 32 * dt + 8 * g); \
                        mer[dt][4 * g + 0] += acc[dt][4 * g + 0] * __builtin_amdgcn_cvt_f32_fp8(gv, 0); \
                        mer[dt][4 * g + 1] += acc[dt][4 * g + 1] * __builtin_amdgcn_cvt_f32_fp8(gv, 1); \
                        mer[dt][4 * g + 2] += acc[dt][4 * g + 2] * __builtin_amdgcn_cvt_f32_fp8(gv, 2); \
                        mer[dt][4 * g + 3] += acc[dt][4 * g + 3] * __builtin_amdgcn_cvt_f32_fp8(gv, 3); } \
                _Pragma("unroll") for (int r = 0; r < 16; ++r) { acc[0][r] = 0.f; acc[1][r] = 0.f; } } \
            if (st + 1 < 16) MG_SSTORE(OTH_, OTH_); \
            if ((st & 3) == 2) { *(uint4*)(gl + grow * 144 + gch * 16) = RG0; *(uint4*)(gl + (grow + 64) * 144 + gch * 16) = RG1; } \
            __syncthreads(); } while (0)
#pragma unroll 1
        for (int st2 = 0; st2 < 16; st2 += 2) { { const int st = st2; MG_STAGE(0, 1); } { const int st = st2 + 1; MG_STAGE(1, 0); } }
#undef MG_STAGE
#undef MG_GLOAD
#undef MG_SSTORE
        bf16* mp = merged + (size_t)(tok0 + 32 * wt + r32) * 1024 + d0 + 64 * wd + 4 * hi;
#pragma unroll
        for (int dt = 0; dt < 2; ++dt)
#pragma unroll
            for (int g = 0; g < 4; ++g)
                *(uint2*)(mp + 32 * dt + 8 * g) = make_uint2(cvtpk(mer[dt][4 * g], mer[dt][4 * g + 1]), cvtpk(mer[dt][4 * g + 2], mer[dt][4 * g + 3]));
    }
}
#define LAS __attribute__((address_space(3)))
#define XB_TMO      128
#define XB_XCNT(j)  (256  + 64 * (j))
#define XB_XSUB(j)  (1280 + 64 * (j))
#define XB_XGEN(j)  (2304 + 64 * (j))
#define XB_TOP      3328
#define XB_TOPGEN   3392
#define XCD_BAR_WORDS 3456
#define XB_SPIN_CAP (1u << 18)

__device__ __forceinline__ unsigned xb_ld(unsigned* p)              { return __hip_atomic_load(p, __ATOMIC_RELAXED, __HIP_MEMORY_SCOPE_AGENT); }
__device__ __forceinline__ unsigned xb_add(unsigned* p, unsigned v) { return __hip_atomic_fetch_add(p, v, __ATOMIC_RELAXED, __HIP_MEMORY_SCOPE_AGENT); }
__device__ __forceinline__ unsigned xb_xcc_id() { return (unsigned)__builtin_amdgcn_s_getreg((3 << 11) | 20) & 0xFu; }
#define XB_SPIN(cond, bar) do { unsigned _sp = 0; while (cond) { __builtin_amdgcn_s_sleep(1); \
    if ((++_sp & 255u) == 0u) { if (xb_ld(&(bar)[XB_TMO])) break; if (_sp > XB_SPIN_CAP) { atomicAdd(&(bar)[XB_TMO], 1u); break; } } } } while (0)

struct XcdBarrier {
    unsigned* bar; unsigned x;
    volatile LAS unsigned* st;
};

__device__ __forceinline__ XcdBarrier xcd_barrier_post(unsigned* bar, volatile LAS unsigned* st) {
    XcdBarrier b; b.bar = bar; b.x = xb_xcc_id(); b.st = st;
    if (threadIdx.x == 0) (void)xb_add(&bar[XB_XCNT(b.x)], 1u);
    return b;
}
__device__ __forceinline__ void xcd_barrier_complete(unsigned* bar, unsigned x, unsigned& nloc, unsigned& nx) {
    const unsigned G = gridDim.x * gridDim.y * gridDim.z;
    unsigned sum, cnt, mine, sp = 0u;
    for (;;) {
        sum = 0u; cnt = 0u; mine = 0u;
#pragma unroll
        for (unsigned j = 0; j < 16; ++j) { const unsigned c = xb_ld(&bar[XB_XCNT(j)]); sum += c; cnt += (c > 0u) ? 1u : 0u; mine = (j == x) ? c : mine; }
        if (sum == G) break;
        __builtin_amdgcn_s_sleep(1);
        if ((++sp & 255u) == 0u) { if (xb_ld(&bar[XB_TMO])) break; if (sp > XB_SPIN_CAP) { atomicAdd(&bar[XB_TMO], 1u); break; } }
    }
    nloc = mine > 0u ? mine : 1u; nx = cnt > 0u ? cnt : 1u;
}

__device__ __forceinline__ void xcd_barrier(const XcdBarrier& b, int wv_) {
    asm volatile("s_waitcnt vmcnt(0)" ::: "memory");
    __syncthreads();
    if (wv_ == 0 && LANEID() == 0) {
        unsigned* bar = b.bar;
        __builtin_amdgcn_s_waitcnt(0);
        unsigned nloc = b.st[0], nx = b.st[1];
        if (nloc == 0u) { xcd_barrier_complete(bar, b.x, nloc, nx); b.st[0] = nloc; b.st[1] = nx; }
        const unsigned old = xb_add(&bar[XB_XSUB(b.x)], 1u);
        const unsigned gen = old / nloc;
        if (old + 1u == (gen + 1u) * nloc) {
            __builtin_amdgcn_fence(__ATOMIC_RELEASE, "agent");
            asm volatile("s_waitcnt vmcnt(0)" ::: "memory");
            const unsigned og = xb_add(&bar[XB_TOP], 1u);
            const unsigned tg = og / nx;
            if (og + 1u == (tg + 1u) * nx) xb_add(&bar[XB_TOPGEN], 1u);
            else XB_SPIN(xb_ld(&bar[XB_TOPGEN]) == tg, bar);
            __builtin_amdgcn_fence(__ATOMIC_ACQUIRE, "agent");
            xb_add(&bar[XB_XGEN(b.x)], 1u);
            asm volatile("s_waitcnt vmcnt(0)" ::: "memory");
        } else {
            XB_SPIN(xb_ld(&bar[XB_XGEN(b.x)]) == gen, bar);
            __builtin_amdgcn_fence(__ATOMIC_ACQUIRE, "agent");
            asm volatile("s_waitcnt vmcnt(0)" ::: "memory");
        }
    }
    __syncthreads();
}

enum { PH_PRO = 0, PH_GIN, PH_INDEX, PH_ATTN, PH_MERGE, PH_GOUT, PH_LN1, PH_GQ, PH_ROUTE, PH_PEER };
template <int PH> __device__ __forceinline__ void run_phase(int WV_, const Params& p_unused, int l, unsigned char* lds_raw) {
    size_t kaoff_ = 0; asm volatile("" : "+s"(kaoff_));
    typedef const __attribute__((address_space(4))) char* kaptr_t;
    const __attribute__((address_space(4))) Params& p = *(const __attribute__((address_space(4))) Params*)((kaptr_t)__builtin_amdgcn_kernarg_segment_ptr() + kaoff_);
    float* sm = (float*)lds_raw;
    size_t wsoff_ = 0; asm volatile("" : "+s"(wsoff_));
    unsigned char* ws = p.ws + wsoff_;
    float* hbuf = p.out;
    bf16* hb = (bf16*)(ws + WS_HB);
    bf16* P = (bf16*)(ws + WS_P);
    bf16* ys = (bf16*)(ws + WS_YS);
    bf16* mrg = (bf16*)(ws + WS_MRG);
    float* mix = (float*)(ws + WS_MIX);
    float* qb = (float*)(ws + WS_Q);
    unsigned char* mask = ws + WS_MASK;
    int* eid = (int*)(ws + WS_EID);
    float* gate = (float*)(ws + WS_GATE);
    float* kmean = (float*)(ws + WS_KMEAN);
    const float* hin = (l == 0) ? p.in[0] : hbuf;
    if (PH == PH_PRO) { Params pc; for (int i = 0; i < 13; ++i) pc.in[i] = p.in[i]; pc.out = p.out; pc.ws = ws;
        prologue_phase(WV_, pc, sm); convert_tables(WV_, pc);
        for (int i = LBID() * NTHR + LTID(WV_); i < DEPTH_ * 8 * 2 * 128 * 64 / 4; i += LGRID() * NTHR) { const float4 v = ((const float4*)p.in[8])[i]; ((uint2*)(ws + WS_SKB))[i] = make_uint2(pk2(v.x, v.y), pk2(v.z, v.w)); } if (LBID() < 2) build_unit_table((unsigned*)(ws + WS_CTL) + 1024, LBID() * NTHR + LTID(WV_)); }
    else if (PH == PH_GIN) {
        pg8::Gemm g{hb, (const bf16*)(ws + WS_WIN_T + l * WIN_T_BYTES), T_, NP, 1024};
        pg8::StaticOrder S; S.init(T_, NP, (int)LGRID(), (int)LBID());
        pg8::EpiBf16Sig E{P, NP, C_G, ws + WS_G8};
        pg8::gemm_phase<pg8::EpiBf16Sig, pg8::StaticOrder, true, true>(WV_, (PG8_LAS unsigned char*)lds_raw, g, S, E);
    }
    else if (PH == PH_INDEX) index_fast_phase(WV_, P, mask, kmean, (float*)(ws + WS_UV + 48 * MiB), (unsigned*)(ws + WS_CTL) + 64 * l + 16, lds_raw);
    else if (PH == PH_ATTN) attn_fast_phase(WV_, P, mask, kmean, p.in[4] + l * 4, ys, (const unsigned*)(ws + WS_CTL) + 1024, (unsigned*)(ws + WS_CTL) + 64 * l, lds_raw);
    else if (PH == PH_MERGE) merge_fast_phase(WV_, ws + WS_G8, ys, (const bf16*)(ws + WS_WBR_T) + (size_t)l * 4 * 1024 * 256, mrg, lds_raw);
    else if (PH == PH_GOUT) {
        pg8::Gemm g{mrg, (const bf16*)(ws + WS_WOUT_T) + (size_t)l * 1024 * 1024, T_, 1024, 1024};
        pg8::StaticOrder S; S.init(T_, 1024, (int)LGRID(), (int)LBID());
        pg8::EpiResY E{l == 0 ? hin : nullptr, hb, hb, (float*)(ws + WS_STATS) + (size_t)l * T_ * 2, ALPHA};
        pg8::gemm_phase<pg8::EpiResY, pg8::StaticOrder, true, true>(WV_, (PG8_LAS unsigned char*)lds_raw, g, S, E);
    }
    else if (PH == PH_GQ) {
        pg8::Gemm g{hb, (const bf16*)(ws + WS_WQ_T) + (size_t)l * 1024 * 1024, T_, 1024, 1024};
        pg8::StaticOrder S; S.init(T_, 1024, (int)LGRID(), (int)LBID());
        pg8::EpiLnFold E{(bf16*)qb, (const float*)(ws + WS_STATS) + (size_t)l * T_ * 2, (const float*)(ws + WS_COLS) + l * 2048, (const float*)(ws + WS_COLS) + l * 2048 + 1024, LN_EPS};
        pg8::gemm_phase<pg8::EpiLnFold, pg8::StaticOrder, true, true>(WV_, (PG8_LAS unsigned char*)lds_raw, g, S, E);
        pg8::Unit u0;
        if (LGRID() == 256 && S.next(0, u0)) {
            asm volatile("s_waitcnt vmcnt(0)" ::: "memory"); __syncthreads();
            route_fast_phase(WV_, (const bf16*)qb, (const bf16*)(ws + WS_SKB) + (size_t)l * 8 * 2 * 128 * 64, eid, gate, lds_raw, u0.pm, u0.pn);
        }
    }
    else if (PH == PH_ROUTE) { if (LGRID() != 256) route_fast_phase(WV_, (const bf16*)qb, (const bf16*)(ws + WS_SKB) + (size_t)l * 8 * 2 * 128 * 64, eid, gate, lds_raw); }
    else peer_fast_phase(WV_, (l + 1 == DEPTH_) ? hbuf : nullptr, hb, eid, gate, ws + WS_UV + (size_t)l * 24 * MiB, p.in[5] + l * 1024, p.in[6] + l * 1024, p.in[11] + l * 1024, p.in[12] + l * 1024, lds_raw);
}

constexpr int CW_BAR = 4096;
constexpr int LDS_BARST = LDS_BYTES - 16;
__global__ void __launch_bounds__(NTHR, 2) mk_fwd(Params p) {
    extern __shared__ __attribute__((aligned(16))) unsigned char lds_raw[];
    cg::grid_group grid = cg::this_grid();
    const int WV_ = __builtin_amdgcn_readfirstlane((int)threadIdx.x >> 6);
    { volatile LAS unsigned* bst0 = (volatile LAS unsigned*)((LAS unsigned char*)lds_raw + LDS_BARST); if (threadIdx.x < 4) bst0[threadIdx.x] = 0u; }
    __syncthreads();
    volatile LAS unsigned* bst = (volatile LAS unsigned*)((LAS unsigned char*)lds_raw + LDS_BARST);
    { uint4* z = (uint4*)p.ws; const uint4 z4 = make_uint4(0u, 0u, 0u, 0u);
      for (unsigned i = (unsigned)LBID() * NTHR + (unsigned)LTID(WV_); i < (unsigned)(2 * MiB / 16); i += (unsigned)LGRID() * NTHR) z[i] = z4; }
    grid.sync();
    (void)xcd_barrier_post((unsigned*)(p.ws + WS_CTL) + CW_BAR, bst);
#define GRID_BAR() do { XcdBarrier b_; b_.bar = (unsigned*)(p.ws + WS_CTL) + CW_BAR; b_.x = xb_xcc_id(); b_.st = (volatile LAS unsigned*)((LAS unsigned char*)lds_raw + LDS_BARST); xcd_barrier(b_, WV_); } while (0)
    run_phase<PH_PRO>(WV_, p, 0, lds_raw);
    GRID_BAR();
#pragma unroll 1
    for (int l = 0; l < DEPTH_; ++l) {
        run_phase<PH_GIN>(WV_, p, l, lds_raw); GRID_BAR();
        run_phase<PH_INDEX>(WV_, p, l, lds_raw); GRID_BAR();
        run_phase<PH_ATTN>(WV_, p, l, lds_raw); GRID_BAR();
        run_phase<PH_MERGE>(WV_, p, l, lds_raw); GRID_BAR();
        run_phase<PH_GOUT>(WV_, p, l, lds_raw); GRID_BAR();
        run_phase<PH_GQ>(WV_, p, l, lds_raw); if (LGRID() != 256) { GRID_BAR(); run_phase<PH_ROUTE>(WV_, p, l, lds_raw); } GRID_BAR();
        run_phase<PH_PEER>(WV_, p, l, lds_raw); if (l + 1 < DEPTH_) GRID_BAR();
    }
}

extern "C" void kernel_launch(void* const* d_in, const int* in_sizes, int n_in, void* d_out, int out_size, void* d_ws, size_t ws_size, hipStream_t stream) {
    if (n_in != 13 || ws_size < WS_END) { fprintf(stderr, "kernel_launch: unexpected n_in %d / ws_size %zu; nothing launched\n", n_in, ws_size); return; }
    static int grid_blocks = 0;
    if (grid_blocks == 0) {
        int dev = 0, cus = 0, per_cu = 0;
        (void)hipGetDevice(&dev);
        (void)hipDeviceGetAttribute(&cus, hipDeviceAttributeMultiprocessorCount, dev);
        (void)hipFuncSetAttribute((const void*)mk_fwd, hipFuncAttributeMaxDynamicSharedMemorySize, LDS_BYTES);
        (void)hipOccupancyMaxActiveBlocksPerMultiprocessor(&per_cu, (const void*)mk_fwd, NTHR, LDS_BYTES);
        if (per_cu < 1) fprintf(stderr, "kernel_launch: occupancy query reports %d\n", per_cu);
        grid_blocks = cus;
    }
    Params p{};
    for (int i = 0; i < 13; ++i) p.in[i] = (const float*)d_in[i];
    p.out = (float*)d_out; p.ws = (unsigned char*)d_ws;
    void* args[] = {&p};
    hipError_t e = hipLaunchCooperativeKernel((const void*)mk_fwd, dim3(grid_blocks), dim3(NTHR), args, LDS_BYTES, stream);
    if (e != hipSuccess) fprintf(stderr, "cooperative launch failed: %s (grid %d)\n", hipGetErrorString(e), grid_blocks);
}
```

```cpp
#include <hip/hip_runtime.h>
#include <cstdio>
#include <cstdint>
#include <hip/hip_cooperative_groups.h>
namespace cg = cooperative_groups;

__device__ __forceinline__ int LANEID() { int l; asm volatile("v_mbcnt_lo_u32_b32 %0, -1, 0\n\tv_mbcnt_hi_u32_b32 %0, -1, %0" : "=v"(l)); return l; }
__device__ __forceinline__ int LTID(int wv) { return (wv << 6) | LANEID(); }
__device__ __forceinline__ int LBID() { int t = blockIdx.x; asm volatile("" : "+s"(t)); return t; }
__device__ __forceinline__ int LGRID() { int t = gridDim.x; asm volatile("" : "+s"(t)); return t; }
namespace pg8 {
#define PG8_LAS __attribute__((address_space(3)))
typedef unsigned short bf16_t;
typedef short bf16x8 __attribute__((ext_vector_type(8)));
typedef float f32x4 __attribute__((ext_vector_type(4)));
typedef unsigned u32x4 __attribute__((ext_vector_type(4)));
constexpr int BM = 256, BK = 64, HALF = 128, HTB = HALF * BK * 2  , STAGE_BYTES = 8 * HTB, NXCD = 8, WGM = 8;

__host__ __device__ __forceinline__ int lds_byte(int r, int c) { const int st = (r >> 4) * 2 + (c >> 5), rr = r & 15, cc = c & 31, ob = rr * 64 + cc * 2; return st * 1024 + (ob ^ (((ob >> 9) & 1) << 5)); }
__host__ __device__ __forceinline__ void stage_rc(int b, int& R, int& C) { const int st = b / 1024, sb = b % 1024, swz = sb ^ (((sb >> 9) & 1) << 5); R = (st >> 1) * 16 + swz / 64; C = (st & 1) * 32 + (swz % 64) / 2; }
__host__ __device__ __forceinline__ int perm32(int rho) { const int n = rho >> 4, i = rho & 15; return 8 * (i >> 2) + 4 * n + (i & 3); }

struct Unit { int pm, pn; };
struct Gemm { const bf16_t* A; const bf16_t* Bt; int M, N, K; };

struct StaticOrder {
    int nM, nN, nwg, G, c;
    __host__ __device__ void init(int M, int N, int G_, int c_) { nM = M / BM; nN = N / BM; nwg = nM * nN; G = G_; c = c_; }
    __host__ __device__ bool next(int i, Unit& u) const {
        const long L = (long)i * G + c; if (L >= nwg) return false;
        int wgid = (int)L; { const int q = nwg / NXCD, r = nwg % NXCD, xcd = wgid % NXCD, off = wgid / NXCD; wgid = (xcd < r ? xcd * (q + 1) : r * (q + 1) + (xcd - r) * q) + off; }
        const int nig = WGM * nN, gid = wgid / nig, fm = gid * WGM, gsz = (nM - fm) < WGM ? (nM - fm) : WGM;
        u.pm = fm + ((wgid % nig) % gsz); u.pn = (wgid % nig) / gsz; return true;
    }
    __device__ __forceinline__ void a_ready(const Unit&) const {}
    __device__ __forceinline__ void done(const Unit&) const {}
};

__device__ __forceinline__ unsigned cvt_pk_bf16(float lo, float hi) { unsigned r; asm volatile("v_cvt_pk_bf16_f32 %0, %1, %2" : "=v"(r) : "v"(lo), "v"(hi)); return r; }
typedef float f32x2 __attribute__((ext_vector_type(2)));
__device__ __forceinline__ f32x2 gelu_pk(f32x2 v) {
    const f32x2 av = __builtin_elementwise_abs(v), d = av * 0.2316418882f + 1.0f;
    f32x2 t; t.x = __builtin_amdgcn_rcpf(d.x); t.y = __builtin_amdgcn_rcpf(d.y);
    f32x2 q = t * 0.5307027145f + (-0.7265760135f); q = q * t + 0.7107068705f; q = q * t + (-0.142248368f); q = q * t + 0.127414796f; q = q * t;
    const f32x2 s = (v * v) * (-0.72134752044f);
    f32x2 e; e.x = __builtin_amdgcn_exp2f(s.x); e.y = __builtin_amdgcn_exp2f(s.y);
    const f32x2 m = v * (q * e), r = v - m;
    f32x2 o; o.x = v.x < 0.f ? m.x : r.x; o.y = v.y < 0.f ? m.y : r.y; return o;
}

template <int ACT  > struct EpiBf16 {
    static constexpr bool PERM = true, AFTER_DRAIN = false; static_assert(ACT == 0 || ACT == 1, "EpiBf16: ACT is 0 (none) or 1 (gelu_pk)");
    bf16_t* O; int ldc; const float* bias; int split_cols; size_t split_stride; float scale0;
    __device__ __forceinline__ void operator()(const f32x4 (&acc)[2][2][4][2], const Unit& u, int wr, int wc, int fr, int fq) const {
        { int ln_ = LANEID(); asm volatile("" : "+v"(ln_)); fr = ln_ & 15; fq = ln_ >> 4; }
        const int row0 = u.pm * BM + wr * 64 + fr; int colt = u.pn * BM; bf16_t* base = O;
        float sc = 1.f; if (split_cols) { const int t = colt / split_cols; base += (size_t)t * split_stride; colt -= t * split_cols; if (t == 0) sc = scale0; }
        const int col0 = colt + wc * 32 + 8 * fq, bcol0 = u.pn * BM + wc * 32 + 8 * fq;
        f32x4 bv[2][2];
#pragma unroll
        for (int bj = 0; bj < 2; ++bj)
#pragma unroll
            for (int n = 0; n < 2; ++n) bv[bj][n] = bias ? *(const f32x4*)(bias + bcol0 + bj * HALF + 4 * n) : (f32x4){0.f, 0.f, 0.f, 0.f};
#pragma unroll
        for (int ai = 0; ai < 2; ++ai)
#pragma unroll
            for (int m = 0; m < 4; ++m) { bf16_t* rowp = base + (size_t)(row0 + ai * HALF + m * 16) * ldc + col0;
#pragma unroll
                for (int bj = 0; bj < 2; ++bj) { f32x4 v0 = acc[ai][bj][m][0] + bv[bj][0], v1 = acc[ai][bj][m][1] + bv[bj][1];
                    if (ACT == 1) { f32x2 a = gelu_pk((f32x2){v0[0], v0[1]}), b = gelu_pk((f32x2){v0[2], v0[3]}), c = gelu_pk((f32x2){v1[0], v1[1]}), d = gelu_pk((f32x2){v1[2], v1[3]});
                        v0 = (f32x4){a.x, a.y, b.x, b.y}; v1 = (f32x4){c.x, c.y, d.x, d.y}; }
                    v0 = v0 * sc; v1 = v1 * sc; u32x4 w; w.x = cvt_pk_bf16(v0[0], v0[1]); w.y = cvt_pk_bf16(v0[2], v0[3]); w.z = cvt_pk_bf16(v1[0], v1[1]); w.w = cvt_pk_bf16(v1[2], v1[3]);
                    *(u32x4*)(rowp + bj * HALF) = w; } }
    }
};
template <class Epi, class Sched, bool ALIGN_EPI = false, bool SP2 = false>
__device__ __forceinline__ void gemm_phase(int WV_, PG8_LAS unsigned char* lds, const Gemm g, const Sched& S, const Epi& E) {
    const int tid = LTID(WV_), wid = __builtin_amdgcn_readfirstlane(tid >> 6), lane = tid & 63, wr = wid >> 2, wc = wid & 3, fr = lane & 15, fq = lane >> 4;
    const int K = g.K, nt = K / BK;
    unsigned voffA[2], voffB[2];
#pragma unroll
    for (int i = 0; i < 2; ++i) { int R, C; stage_rc(tid * 16 + i * 8192, R, C); const int Rb = Epi::PERM ? ((R & ~31) + perm32(R & 31)) : R;
        voffA[i] = (unsigned)(R * K + C) * 2u; voffB[i] = (unsigned)(Rb * K + C) * 2u; }
    const size_t kstep = (size_t)(BK * 2);
    const size_t hstep = (size_t)HALF * K * 2;
    const size_t tstep = 2 * hstep;
    const unsigned ldsw = (unsigned)wid * 1024u;
    const int aoff = lds_byte(wr * 64 + fr, fq * 8), boff = lds_byte(wc * 32 + fr, fq * 8);
#define PG8_SA(b, h) (((b) * 2 + (h)) * HTB)
#define PG8_SB(b, h) ((4 + (b) * 2 + (h)) * HTB)
#define PG8_STAGE(bufoff, gbase, voff) do { _Pragma("unroll") for (int _i = 0; _i < 2; ++_i) \
        __builtin_amdgcn_global_load_lds((const unsigned*)((const char*)(gbase) + (voff)[_i]), (PG8_LAS unsigned*)(lds + (bufoff) + ldsw + _i * 8192), 16, 0, 0); } while (0)
#define PG8_LDA(dst, b, h) do { _Pragma("unroll") for (int m = 0; m < 4; ++m) _Pragma("unroll") for (int k = 0; k < 2; ++k) dst[m][k] = *(const PG8_LAS bf16x8*)(lds + PG8_SA(b, h) + aoff + m * 2048 + k * 1024); } while (0)
#define PG8_LDB(dst, b, h) do { _Pragma("unroll") for (int n = 0; n < 2; ++n) _Pragma("unroll") for (int k = 0; k < 2; ++k) dst[n][k] = *(const PG8_LAS bf16x8*)(lds + PG8_SB(b, h) + boff + n * 2048 + k * 1024); } while (0)
#define PG8_MMA(ai, bj, At, Bt) do { __builtin_amdgcn_s_setprio(1); _Pragma("unroll") for (int m = 0; m < 4; ++m) _Pragma("unroll") for (int n = 0; n < 2; ++n) _Pragma("unroll") for (int k = 0; k < 2; ++k) \
        acc[ai][bj][m][n] = __builtin_amdgcn_mfma_f32_16x16x32_bf16(Bt[n][k], At[m][k], acc[ai][bj][m][n], 0, 0, 0); __builtin_amdgcn_s_setprio(0); } while (0)
#define PG8_WAIT_V(n) asm volatile("s_waitcnt vmcnt(" #n ")" ::: "memory")
#define PG8_WAIT_L(n) asm volatile("s_waitcnt lgkmcnt(" #n ")" ::: "memory")
#define PG8_BAR __builtin_amdgcn_s_barrier()
#define PG8_SCHED __builtin_amdgcn_sched_barrier(0)
    Unit cur, nxt; int ui = 0;
    if (!S.next(0, cur)) return;
    f32x4 acc[2][2][4][2];
#pragma unroll
    for (int a = 0; a < 2; ++a)
#pragma unroll
        for (int b = 0; b < 2; ++b)
#pragma unroll
            for (int m = 0; m < 4; ++m)
#pragma unroll
                for (int n = 0; n < 2; ++n) acc[a][b][m][n] = (f32x4){0.f, 0.f, 0.f, 0.f};
    bf16x8 At[4][2], B0[2][2], B1[2][2];
    const char* cA = (const char*)g.A + (size_t)cur.pm * tstep; const char* cB = (const char*)g.Bt + (size_t)cur.pn * tstep;
    S.a_ready(cur);
    if constexpr (SP2) {
        PG8_STAGE(PG8_SB(0, 0), cB, voffB); PG8_STAGE(PG8_SB(0, 1), cB + hstep, voffB); PG8_STAGE(PG8_SA(0, 0), cA, voffA); PG8_STAGE(PG8_SA(0, 1), cA + hstep, voffA);
        if (wr == 1) PG8_BAR;
        PG8_WAIT_V(2); PG8_BAR;
        PG8_STAGE(PG8_SB(1, 0), cB + kstep, voffB); PG8_STAGE(PG8_SA(1, 0), cA + kstep, voffA); PG8_STAGE(PG8_SB(1, 1), cB + hstep + kstep, voffB);
        PG8_WAIT_V(6); PG8_BAR;
    } else {
        PG8_STAGE(PG8_SB(0, 0), cB, voffB); PG8_STAGE(PG8_SA(0, 0), cA, voffA); PG8_STAGE(PG8_SB(0, 1), cB + hstep, voffB); PG8_STAGE(PG8_SA(0, 1), cA + hstep, voffA);
        if (wr == 1) PG8_BAR;
        PG8_WAIT_V(4); PG8_BAR;
        PG8_STAGE(PG8_SB(1, 0), cB + kstep, voffB); PG8_STAGE(PG8_SA(1, 0), cA + kstep, voffA); PG8_STAGE(PG8_SB(1, 1), cB + hstep + kstep, voffB);
        PG8_WAIT_V(6); PG8_BAR;
    }
    for (;;) {
        const bool has_next = S.next(ui + 1, nxt);
        const char* nA = has_next ? (const char*)g.A + (size_t)nxt.pm * tstep : cA; const char* nB = has_next ? (const char*)g.Bt + (size_t)nxt.pn * tstep : cB;
        for (int t = 0; t < nt; t += 2) {
            const bool last = (t == nt - 2);
            const char* a1 = cA + (size_t)(t + 1) * kstep;
            const char* a2 = last ? nA : cA + (size_t)(t + 2) * kstep; const char* b2 = last ? nB : cB + (size_t)(t + 2) * kstep;
            const char* a3 = a2 + kstep; const char* b3 = b2 + kstep;
            if (last && has_next) S.a_ready(nxt);
            if constexpr (SP2) {
            PG8_LDB(B0, 0, 0); PG8_LDB(B1, 0, 1); PG8_SCHED; PG8_LDA(At, 0, 0); PG8_STAGE(PG8_SA(1, 1), a1 + hstep, voffA);
            PG8_WAIT_V(8); PG8_WAIT_L(0); PG8_BAR; PG8_MMA(0, 0, At, B0); PG8_MMA(0, 1, At, B1); PG8_BAR; PG8_SCHED;
            PG8_LDA(At, 0, 1); PG8_STAGE(PG8_SB(0, 0), b2, voffB); PG8_STAGE(PG8_SB(0, 1), b2 + hstep, voffB); PG8_STAGE(PG8_SA(0, 0), a2, voffA);
            PG8_WAIT_V(8); PG8_WAIT_L(0); PG8_BAR; PG8_MMA(1, 0, At, B0); PG8_MMA(1, 1, At, B1); PG8_BAR; PG8_SCHED;
            PG8_LDB(B0, 1, 0); PG8_LDB(B1, 1, 1); PG8_SCHED; PG8_LDA(At, 1, 0); PG8_STAGE(PG8_SA(0, 1), a2 + hstep, voffA);
            PG8_WAIT_V(8); PG8_WAIT_L(0); PG8_BAR; PG8_MMA(0, 0, At, B0); PG8_MMA(0, 1, At, B1); PG8_BAR; PG8_SCHED;
            PG8_LDA(At, 1, 1); PG8_STAGE(PG8_SB(1, 0), b3, voffB); PG8_STAGE(PG8_SB(1, 1), b3 + hstep, voffB); PG8_STAGE(PG8_SA(1, 0), a3, voffA);
            PG8_WAIT_V(8); PG8_WAIT_L(0); PG8_BAR; PG8_MMA(1, 0, At, B0); PG8_MMA(1, 1, At, B1); PG8_BAR; PG8_SCHED;
            } else {
            PG8_LDB(B0, 0, 0); PG8_SCHED; PG8_LDA(At, 0, 0); PG8_STAGE(PG8_SA(1, 1), a1 + hstep, voffA);
            PG8_WAIT_L(8); PG8_BAR; PG8_WAIT_L(0); PG8_MMA(0, 0, At, B0); PG8_BAR; PG8_SCHED;
            PG8_LDB(B1, 0, 1); PG8_STAGE(PG8_SB(0, 0), b2, voffB);
            PG8_BAR; PG8_WAIT_L(0); PG8_MMA(0, 1, At, B1); PG8_BAR;
            PG8_LDA(At, 0, 1); PG8_STAGE(PG8_SA(0, 0), a2, voffA);
            PG8_BAR; PG8_WAIT_L(0); PG8_MMA(1, 0, At, B0); PG8_BAR; PG8_SCHED;
            PG8_STAGE(PG8_SB(0, 1), b2 + hstep, voffB);
            PG8_WAIT_V(6); PG8_BAR; PG8_MMA(1, 1, At, B1); PG8_BAR;
            PG8_LDB(B0, 1, 0); PG8_SCHED; PG8_LDA(At, 1, 0); PG8_STAGE(PG8_SA(0, 1), a2 + hstep, voffA);
            PG8_WAIT_L(8); PG8_BAR; PG8_WAIT_L(0); PG8_MMA(0, 0, At, B0); PG8_BAR; PG8_SCHED;
            PG8_LDB(B1, 1, 1); PG8_STAGE(PG8_SB(1, 0), b3, voffB);
            PG8_BAR; PG8_WAIT_L(0); PG8_MMA(0, 1, At, B1); PG8_BAR;
            PG8_LDA(At, 1, 1); PG8_STAGE(PG8_SA(1, 0), a3, voffA);
            PG8_BAR; PG8_WAIT_L(0); PG8_MMA(1, 0, At, B0); PG8_BAR; PG8_SCHED;
            PG8_STAGE(PG8_SB(1, 1), b3 + hstep, voffB);
            PG8_WAIT_V(6); PG8_BAR; PG8_MMA(1, 1, At, B1); PG8_BAR;
            }
        }
        if constexpr (ALIGN_EPI) { if (wr == 0) PG8_BAR; }
        if constexpr (!Epi::AFTER_DRAIN) { E(acc, cur, wr, wc, fr, fq); S.done(cur); }
        if (!has_next) break;
#pragma unroll
        for (int a = 0; a < 2; ++a)
#pragma unroll
            for (int b = 0; b < 2; ++b)
#pragma unroll
                for (int m = 0; m < 4; ++m)
#pragma unroll
                    for (int n = 0; n < 2; ++n) acc[a][b][m][n] = (f32x4){0.f, 0.f, 0.f, 0.f};
        cur = nxt; cA = nA; cB = nB; ++ui;
        if constexpr (ALIGN_EPI) { if (wr == 1) PG8_BAR; }
    }
    PG8_WAIT_V(0);
    if constexpr (!ALIGN_EPI) { if (wr == 0) PG8_BAR; }
    PG8_BAR;
    if constexpr (Epi::AFTER_DRAIN) { E.fused(acc, cur, wr, wc, fr, fq, lds, wid, lane); S.done(cur); }
#undef PG8_SA
#undef PG8_SB
#undef PG8_STAGE
#undef PG8_LDA
#undef PG8_LDB
#undef PG8_MMA
#undef PG8_WAIT_V
#undef PG8_WAIT_L
#undef PG8_BAR
#undef PG8_SCHED
}
}
namespace pg8 {
struct EpiF32 {
    static constexpr bool PERM = false, AFTER_DRAIN = false;
    float* O; int ldc;
    __device__ __forceinline__ void operator()(const f32x4 (&acc)[2][2][4][2], const Unit& u, int wr, int wc, int fr, int fq) const {
        { int ln_ = LANEID(); asm volatile("" : "+v"(ln_)); fr = ln_ & 15; fq = ln_ >> 4; }
        const int row0 = u.pm * BM + wr * 64 + fr, col0 = u.pn * BM + wc * 32 + 4 * fq;
#pragma unroll
        for (int ai = 0; ai < 2; ++ai)
#pragma unroll
            for (int m = 0; m < 4; ++m) { float* rowp = O + (size_t)(row0 + ai * HALF + m * 16) * ldc + col0;
#pragma unroll
                for (int bj = 0; bj < 2; ++bj)
#pragma unroll
                    for (int n = 0; n < 2; ++n) *(f32x4*)(rowp + bj * HALF + n * 16) = acc[ai][bj][m][n]; }
    }
};
struct EpiResY {
    static constexpr bool PERM = false, AFTER_DRAIN = false;
    const float* hin; const bf16_t* hinb; bf16_t* yb; float* stats; float alpha;
    __device__ __forceinline__ void operator()(const f32x4 (&acc)[2][2][4][2], const Unit& u, int wr, int wc, int fr, int fq) const {
        { int ln_ = LANEID(); asm volatile("" : "+v"(ln_)); fr = ln_ & 15; fq = ln_ >> 4; }
        const int row0 = u.pm * BM + wr * 64 + fr, col0 = u.pn * BM + wc * 32 + 4 * fq;
#pragma unroll
        for (int ai = 0; ai < 2; ++ai)
#pragma unroll
            for (int m = 0; m < 4; ++m) {
                const int row = row0 + ai * HALF + m * 16;
                float s = 0.f, s2 = 0.f;
#pragma unroll
                for (int bj = 0; bj < 2; ++bj)
#pragma unroll
                    for (int n = 0; n < 2; ++n) {
                        const size_t off = (size_t)row * 1024 + col0 + bj * HALF + n * 16;
                        f32x4 hv;
                        if (hin) hv = *(const f32x4*)(hin + off);
                        else { typedef unsigned u32x2r __attribute__((ext_vector_type(2))); const u32x2r hw = *(const u32x2r*)(hinb + off);
                            hv[0] = __uint_as_float(hw.x << 16); hv[1] = __uint_as_float(hw.x & 0xffff0000u); hv[2] = __uint_as_float(hw.y << 16); hv[3] = __uint_as_float(hw.y & 0xffff0000u); }
                        const f32x4 y = hv * alpha + acc[ai][bj][m][n];
                        typedef unsigned u32x2v __attribute__((ext_vector_type(2)));
                        u32x2v w; w.x = cvt_pk_bf16(y[0], y[1]); w.y = cvt_pk_bf16(y[2], y[3]);
                        *(u32x2v*)(yb + off) = w;
                        s += (y[0] + y[1]) + (y[2] + y[3]); s2 += (y[0] * y[0] + y[1] * y[1]) + (y[2] * y[2] + y[3] * y[3]);
                    }
                s += __shfl_xor(s, 16); s += __shfl_xor(s, 32); s2 += __shfl_xor(s2, 16); s2 += __shfl_xor(s2, 32);
                if (fq == 0) { atomicAdd(stats + 2 * (size_t)row, s); atomicAdd(stats + 2 * (size_t)row + 1, s2); }
            }
    }
};
struct EpiLnFold {
    static constexpr bool PERM = true, AFTER_DRAIN = false;
    bf16_t* O; const float* stats; const float* colsum; const float* colbias; float eps;
    __device__ __forceinline__ void operator()(const f32x4 (&acc)[2][2][4][2], const Unit& u, int wr, int wc, int fr, int fq) const {
        { int ln_ = LANEID(); asm volatile("" : "+v"(ln_)); fr = ln_ & 15; fq = ln_ >> 4; }
        const int row0 = u.pm * BM + wr * 64 + fr, col0 = u.pn * BM + wc * 32 + 8 * fq;
        f32x4 cs[2][2], cb[2][2];
#pragma unroll
        for (int bj = 0; bj < 2; ++bj)
#pragma unroll
            for (int n = 0; n < 2; ++n) { cs[bj][n] = *(const f32x4*)(colsum + col0 + bj * HALF + 4 * n); cb[bj][n] = *(const f32x4*)(colbias + col0 + bj * HALF + 4 * n); }
#pragma unroll
        for (int ai = 0; ai < 2; ++ai)
#pragma unroll
            for (int m = 0; m < 4; ++m) {
                const int row = row0 + ai * HALF + m * 16;
                const float sm_ = stats[2 * (size_t)row], sq_ = stats[2 * (size_t)row + 1];
                const float mean = sm_ * (1.0f / 1024.0f);
                const float rstd = 1.0f / sqrtf(fmaxf(sq_ * (1.0f / 1024.0f) - mean * mean, 0.f) + eps);
                bf16_t* rowp = O + (size_t)row * 1024 + col0;
#pragma unroll
                for (int bj = 0; bj < 2; ++bj) {
                    const f32x4 v0 = (acc[ai][bj][m][0] - cs[bj][0] * mean) * rstd + cb[bj][0], v1 = (acc[ai][bj][m][1] - cs[bj][1] * mean) * rstd + cb[bj][1];
                    u32x4 w; w.x = cvt_pk_bf16(v0[0], v0[1]); w.y = cvt_pk_bf16(v0[2], v0[3]); w.z = cvt_pk_bf16(v1[0], v1[1]); w.w = cvt_pk_bf16(v1[2], v1[3]);
                    *(u32x4*)(rowp + bj * HALF) = w;
                }
            }
    }
};
__device__ __forceinline__ unsigned cvt_pk_bf16_t(float lo, float hi) { unsigned r; asm volatile("s_nop 0\n\tv_cvt_pk_bf16_f32 %0, %1, %2" : "=v"(r) : "v"(lo), "v"(hi)); return r; }
struct EpiBf16Sig {
    static constexpr bool PERM = true, AFTER_DRAIN = false;
    bf16_t* O; int ldc; int sig_col0; unsigned char* G8;
    __device__ __forceinline__ void operator()(const f32x4 (&acc)[2][2][4][2], const Unit& u, int wr, int wc, int fr, int fq) const {
        { int ln_ = LANEID(); asm volatile("" : "+v"(ln_)); fr = ln_ & 15; fq = ln_ >> 4; }
        const int row0 = u.pm * BM + wr * 64 + fr; const int col0 = u.pn * BM + wc * 32 + 8 * fq;
#pragma unroll
        for (int bj = 0; bj < 2; ++bj) {
            if (col0 + bj * HALF >= sig_col0) {
                { const int gc = col0 + bj * HALF - sig_col0;
                  if (gc < 4096) {
#pragma unroll
                    for (int ai = 0; ai < 2; ++ai)
#pragma unroll
                        for (int m = 0; m < 4; ++m) {
                            f32x4 v0 = acc[ai][bj][m][0], v1 = acc[ai][bj][m][1];
#pragma unroll
                            for (int e = 0; e < 4; ++e) { v0[e] = __builtin_amdgcn_rcpf(1.f + __builtin_amdgcn_exp2f(-1.44269504f * v0[e])); v1[e] = __builtin_amdgcn_rcpf(1.f + __builtin_amdgcn_exp2f(-1.44269504f * v1[e])); }
                            int w0 = __builtin_amdgcn_cvt_pk_fp8_f32(v0[0], v0[1], 0, false); w0 = __builtin_amdgcn_cvt_pk_fp8_f32(v0[2], v0[3], w0, true);
                            int w1 = __builtin_amdgcn_cvt_pk_fp8_f32(v1[0], v1[1], 0, false); w1 = __builtin_amdgcn_cvt_pk_fp8_f32(v1[2], v1[3], w1, true);
                            typedef int i32x2v __attribute__((ext_vector_type(2)));
                            i32x2v w; w.x = w0; w.y = w1;
                            *(i32x2v*)(G8 + (size_t)(row0 + ai * HALF + m * 16) * 4096 + gc) = w; }
                  } }
            } else {
#pragma unroll
                for (int ai = 0; ai < 2; ++ai)
#pragma unroll
                    for (int m = 0; m < 4; ++m) { bf16_t* rowp = O + (size_t)(row0 + ai * HALF + m * 16) * ldc + col0;
                        const f32x4 v0 = acc[ai][bj][m][0], v1 = acc[ai][bj][m][1];
                        u32x4 w; w.x = cvt_pk_bf16(v0[0], v0[1]); w.y = cvt_pk_bf16(v0[2], v0[3]); w.z = cvt_pk_bf16(v1[0], v1[1]); w.w = cvt_pk_bf16(v1[2], v1[3]);
                        *(u32x4*)(rowp + bj * HALF) = w; }
            }
        }
    }
};
}

typedef unsigned short bf16;
constexpr int T_ = 16384, S_ = 4096, NBATCH = 4, D_ = 1024, NCOL = 6824, NP = 6912, DEPTH_ = 2;
constexpr int C_QA = 0, C_KA = 256, C_VA = 320, C_QI = 384, C_KI = 640, C_WI = 672, C_QB = 680, C_KB = 936, C_VB = 1064,
              C_QC = 1192, C_KC = 1448, C_VC = 1704, C_QD = 1960, C_KD = 2216, C_VD = 2472, C_G = 2728;
constexpr int NTHR = 512, NWAVE = 8;
constexpr float ALPHA = 1.41421356237309515f;
constexpr float LN_EPS = 1e-5f;
constexpr size_t MiB = 1u << 20;
constexpr size_t WS_STATS = 1 * MiB  , WS_COLS = 1 * MiB + 512 * 1024  ;
constexpr size_t WS_CTL = 0, WS_WIN_T = 2 * MiB, WS_WOUT_T = 30 * MiB, WS_WQ_T = 34 * MiB, WS_WBR_T = 38 * MiB, WS_HB = 42 * MiB,
                 WS_P = 74 * MiB, WS_MIX = 74 * MiB  , WS_Q = 138 * MiB  , WS_G8 = 428 * MiB  , WS_YS = 290 * MiB, WS_MRG = 322 * MiB,
                 WS_MASK = 354 * MiB, WS_EID = 362 * MiB, WS_GATE = 370 * MiB, WS_KMEAN = 378 * MiB, WS_SKB = 379 * MiB, WS_UV = 380 * MiB, WS_END = 508 * MiB;
constexpr size_t WIN_T_BYTES = (size_t)NP * 1024 * 2;
constexpr int LDS_BYTES = 144 * 1024;

struct Params { const float* in[13]; float* out; unsigned char* ws; };

__device__ __forceinline__ float bf2f(bf16 v) { return __uint_as_float((unsigned)v << 16); }
__device__ __forceinline__ unsigned f2bf(float f) { unsigned u = __float_as_uint(f); return (u + 0x7fffu + ((u >> 16) & 1u)) >> 16; }
__device__ __forceinline__ unsigned pk2(float lo, float hi) { return f2bf(lo) | (f2bf(hi) << 16); }
__device__ __forceinline__ void unpack8(const uint4 v, float* o) {
    o[0] = __uint_as_float(v.x << 16); o[1] = __uint_as_float(v.x & 0xffff0000u); o[2] = __uint_as_float(v.y << 16); o[3] = __uint_as_float(v.y & 0xffff0000u);
    o[4] = __uint_as_float(v.z << 16); o[5] = __uint_as_float(v.z & 0xffff0000u); o[6] = __uint_as_float(v.w << 16); o[7] = __uint_as_float(v.w & 0xffff0000u);
}
__device__ __forceinline__ float wave_sum(float v) {
#pragma unroll
    for (int o = 32; o > 0; o >>= 1) v += __shfl_xor(v, o);
    return v;
}
__device__ __forceinline__ float wave_max(float v) {
#pragma unroll
    for (int o = 32; o > 0; o >>= 1) v = fmaxf(v, __shfl_xor(v, o));
    return v;
}
__device__ __forceinline__ int wave_sum_i(int v) {
#pragma unroll
    for (int o = 32; o > 0; o >>= 1) v += __shfl_xor(v, o);
    return v;
}
__device__ __forceinline__ float logsig(float x) { return fminf(x, 0.f) - log1pf(expf(-fabsf(x))); }

__device__ void transpose_items(int WV_, const float* W, int K, int N, bf16* WT, float* sm, int item0, int nitems_total, int item_stride,
                                const float* rs_g = nullptr, const float* rs_b = nullptr, float* colsum = nullptr, float* colbias = nullptr) {
    const int tid = LTID(WV_);
    const int nkb = K / 64, nnb = (N + 63) / 64;
    for (int it = item0; it < nkb * nnb; it += item_stride) {
        const int kb = it % nkb, nb = it / nkb, k0 = kb * 64, n0 = nb * 64;
        __syncthreads();
        for (int e = tid; e < 64 * 64; e += NTHR) { const int kk = e >> 6, nn = e & 63; sm[kk * 65 + nn] = (n0 + nn < N) ? W[(size_t)(k0 + kk) * N + n0 + nn] : 0.f; }
        __syncthreads();
        if (rs_g) {
            if (tid < 64) { float cs = 0.f, cb = 0.f;
                for (int kk = 0; kk < 64; ++kk) { const float w = sm[kk * 65 + tid]; cs += w * rs_g[k0 + kk]; cb += w * rs_b[k0 + kk]; }
                atomicAdd(colsum + n0 + tid, cs); atomicAdd(colbias + n0 + tid, cb); }
            __syncthreads();
            for (int e = tid; e < 64 * 64; e += NTHR) { const int kk = e >> 6, nn = e & 63; sm[kk * 65 + nn] *= rs_g[k0 + kk]; }
            __syncthreads();
        }
        { const int nn = tid >> 3, c = tid & 7;
          if (n0 + nn < N) { uint4 o; o.x = pk2(sm[(8 * c + 0) * 65 + nn], sm[(8 * c + 1) * 65 + nn]); o.y = pk2(sm[(8 * c + 2) * 65 + nn], sm[(8 * c + 3) * 65 + nn]);
              o.z = pk2(sm[(8 * c + 4) * 65 + nn], sm[(8 * c + 5) * 65 + nn]); o.w = pk2(sm[(8 * c + 6) * 65 + nn], sm[(8 * c + 7) * 65 + nn]);
              *(uint4*)(WT + (size_t)(n0 + nn) * K + k0 + 8 * c) = o; } }
    }
    __syncthreads();
}
constexpr int TI_WIN = 16 * ((NCOL + 63) / 64), TI_SQ = 256, TI_LAYER = TI_WIN + 3 * TI_SQ;
#define TITEM_DECODE(it_, W_, WT_, K_, N_, k0_, n0_, fold_, l_) do { \
        l_ = (it_) / TI_LAYER; const int r_ = (it_) - l_ * TI_LAYER; \
        const int kind_ = r_ < TI_WIN ? 0 : (r_ < TI_WIN + TI_SQ ? 1 : (r_ < TI_WIN + 2 * TI_SQ ? 2 : 3)); \
        const int q_ = r_ - (kind_ == 0 ? 0 : TI_WIN + (kind_ - 1) * TI_SQ); \
        fold_ = kind_ == 2; K_ = kind_ == 3 ? 256 : 1024; N_ = kind_ == 0 ? NCOL : 1024; \
        k0_ = kind_ == 3 ? (q_ & 3) * 64 : (q_ & 15) * 64; n0_ = kind_ == 3 ? ((q_ & 63) >> 2) * 64 : (q_ >> 4) * 64; \
        const int nbr_ = q_ >> 6; \
        W_ = kind_ == 0 ? pin1 + (size_t)l_ * 1024 * NCOL : kind_ == 1 ? pin3 + (size_t)l_ * 1024 * 1024 : kind_ == 2 ? pin7 + (size_t)l_ * 1024 * 1024 : pin2 + ((size_t)l_ * 4 + nbr_) * 256 * 1024; \
        WT_ = kind_ == 0 ? (bf16*)(ws + WS_WIN_T + l_ * WIN_T_BYTES) : kind_ == 1 ? (bf16*)(ws + WS_WOUT_T) + (size_t)l_ * 1024 * 1024 : kind_ == 2 ? (bf16*)(ws + WS_WQ_T) + (size_t)l_ * 1024 * 1024 \
              : (bf16*)(ws + WS_WBR_T) + ((size_t)l_ * 4 + nbr_) * 1024 * 256; } while (0)
__device__ __forceinline__ void titem_finish(bf16* WT, int K, int N, int k0, int n0, const float* rs_g, const float* rs_b, float* colsum, float* colbias, float* sm, int tid) {
    if (rs_g) {
        if (tid < 64) { float cs = 0.f, cb = 0.f;
            for (int kk = 0; kk < 64; ++kk) { const float w = sm[kk * 65 + tid]; cs += w * rs_g[k0 + kk]; cb += w * rs_b[k0 + kk]; }
            atomicAdd(colsum + n0 + tid, cs); atomicAdd(colbias + n0 + tid, cb); }
        __syncthreads();
        for (int e = tid; e < 64 * 64; e += NTHR) { const int kk = e >> 6, nn = e & 63; sm[kk * 65 + nn] *= rs_g[k0 + kk]; }
        __syncthreads();
    }
    { const int nn = tid >> 3, c = tid & 7;
      if (n0 + nn < N) { uint4 o; o.x = pk2(sm[(8 * c + 0) * 65 + nn], sm[(8 * c + 1) * 65 + nn]); o.y = pk2(sm[(8 * c + 2) * 65 + nn], sm[(8 * c + 3) * 65 + nn]);
          o.z = pk2(sm[(8 * c + 4) * 65 + nn], sm[(8 * c + 5) * 65 + nn]); o.w = pk2(sm[(8 * c + 6) * 65 + nn], sm[(8 * c + 7) * 65 + nn]);
          *(uint4*)(WT + (size_t)(n0 + nn) * K + k0 + 8 * c) = o; } }
}
__device__ void prologue_phase(int WV_, const Params& p, float* sm) {
    const int tid = LTID(WV_), B = LBID(), G = LGRID();
    unsigned char* ws = p.ws;
    float* sm1 = sm + 64 * 65;
    const float* pin1 = p.in[1]; const float* pin2 = p.in[2]; const float* pin3 = p.in[3]; const float* pin7 = p.in[7]; const float* pin5 = p.in[5]; const float* pin6 = p.in[6];
    asm volatile("" : "+s"(pin1), "+s"(pin2), "+s"(pin3), "+s"(pin7), "+s"(pin5), "+s"(pin6));
    const int kk0 = tid >> 4, c4 = tid & 15;
    for (int it = B; it < DEPTH_ * TI_LAYER; it += 2 * G) {
        const int it2 = it + G; const bool has2 = it2 < DEPTH_ * TI_LAYER;
        const float* Wa; const float* Wb; bf16* WTa; bf16* WTb; int Ka, Na, k0a, n0a, la, Kb, Nb, k0b, n0b, lb; bool fa, fb;
        TITEM_DECODE(it, Wa, WTa, Ka, Na, k0a, n0a, fa, la);
        { const int itb = has2 ? it2 : it; TITEM_DECODE(itb, Wb, WTb, Kb, Nb, k0b, n0b, fb, lb); }
        const float4 z4 = make_float4(0.f, 0.f, 0.f, 0.f);
        const bool ina = n0a + 4 * c4 < Na, inb = n0b + 4 * c4 < Nb;
        float4 a0 = z4, a1 = z4, b0 = z4, b1 = z4;
        if (ina) { a0 = *(const float4*)(Wa + (size_t)(k0a + kk0) * Na + n0a + 4 * c4); a1 = *(const float4*)(Wa + (size_t)(k0a + kk0 + 32) * Na + n0a + 4 * c4); }
        if (inb) { b0 = *(const float4*)(Wb + (size_t)(k0b + kk0) * Nb + n0b + 4 * c4); b1 = *(const float4*)(Wb + (size_t)(k0b + kk0 + 32) * Nb + n0b + 4 * c4); }
        __syncthreads();
        { float* d = sm + kk0 * 65 + 4 * c4; d[0] = a0.x; d[1] = a0.y; d[2] = a0.z; d[3] = a0.w; d += 32 * 65; d[0] = a1.x; d[1] = a1.y; d[2] = a1.z; d[3] = a1.w; }
        { float* d = sm1 + kk0 * 65 + 4 * c4; d[0] = b0.x; d[1] = b0.y; d[2] = b0.z; d[3] = b0.w; d += 32 * 65; d[0] = b1.x; d[1] = b1.y; d[2] = b1.z; d[3] = b1.w; }
        __syncthreads();
        titem_finish(WTa, Ka, Na, k0a, n0a, fa ? pin5 + la * 1024 : nullptr, pin6 + la * 1024, (float*)(ws + WS_COLS) + la * 2048, (float*)(ws + WS_COLS) + la * 2048 + 1024, sm, tid);
        if (has2) titem_finish(WTb, Kb, Nb, k0b, n0b, fb ? pin5 + lb * 1024 : nullptr, pin6 + lb * 1024, (float*)(ws + WS_COLS) + lb * 2048, (float*)(ws + WS_COLS) + lb * 2048 + 1024, sm1, tid);
    }
    __syncthreads();
    for (int l = 0; l < DEPTH_; ++l) {
        bf16* win_t = (bf16*)(ws + WS_WIN_T + l * WIN_T_BYTES);
        for (int i = B * NTHR + tid; i < (NP - NCOL) * 1024 / 8; i += G * NTHR) ((uint4*)(win_t + (size_t)NCOL * 1024))[i] = make_uint4(0u, 0u, 0u, 0u);
    }
    const float4* x4 = (const float4*)p.in[0]; uint2* hb2 = (uint2*)(ws + WS_HB);
    for (size_t i = (size_t)B * NTHR + tid; i < (size_t)T_ * 1024 / 4; i += (size_t)G * NTHR) { const float4 v = x4[i]; hb2[i] = make_uint2(pk2(v.x, v.y), pk2(v.z, v.w)); }
}

__device__ __forceinline__ void ln_row(float4 (&v)[4], const float* g, const float* bb, float* orow, bf16* obrow, int lane) {
    float s = 0.f;
#pragma unroll
    for (int j = 0; j < 4; ++j) s += (v[j].x + v[j].y) + (v[j].z + v[j].w);
    const float mean = wave_sum(s) * (1.0f / 1024.0f);
    float s2 = 0.f;
#pragma unroll
    for (int j = 0; j < 4; ++j) { v[j].x -= mean; v[j].y -= mean; v[j].z -= mean; v[j].w -= mean; s2 += (v[j].x * v[j].x + v[j].y * v[j].y) + (v[j].z * v[j].z + v[j].w * v[j].w); }
    const float rstd = 1.0f / sqrtf(wave_sum(s2) * (1.0f / 1024.0f) + LN_EPS);
#pragma unroll
    for (int j = 0; j < 4; ++j) {
        const float4 gg = ((const float4*)g)[j * 64 + lane], b4 = ((const float4*)bb)[j * 64 + lane];
        float4 o; o.x = v[j].x * rstd * gg.x + b4.x; o.y = v[j].y * rstd * gg.y + b4.y; o.z = v[j].z * rstd * gg.z + b4.z; o.w = v[j].w * rstd * gg.w + b4.w;
        ((float4*)orow)[j * 64 + lane] = o;
        ((uint2*)obrow)[j * 64 + lane] = make_uint2(pk2(o.x, o.y), pk2(o.z, o.w));
    }
}
__device__ void ln1_phase(int WV_, const float* hin, const float* add, const float* g, const float* bb, float* hout, bf16* hb) {
    const int lane = LTID(WV_) & 63, wave = LTID(WV_) >> 6;
    for (int row = LBID() * NWAVE + wave; row < T_; row += LGRID() * NWAVE) {
        float4 v[4];
#pragma unroll
        for (int j = 0; j < 4; ++j) {
            const float4 a = ((const float4*)(hin + (size_t)row * 1024))[j * 64 + lane], m = ((const float4*)(add + (size_t)row * 1024))[j * 64 + lane];
            v[j].x = ALPHA * a.x + m.x; v[j].y = ALPHA * a.y + m.y; v[j].z = ALPHA * a.z + m.z; v[j].w = ALPHA * a.w + m.w;
        }
        ln_row(v, g, bb, hout + (size_t)row * 1024, hb + (size_t)row * 1024, lane);
    }
}


typedef short bf16x8_t __attribute__((ext_vector_type(8)));
typedef float f32x16_t __attribute__((ext_vector_type(16)));
typedef float f32x2_t __attribute__((ext_vector_type(2)));
typedef __bf16 bf16x2_t __attribute__((ext_vector_type(2)));
__device__ __forceinline__ unsigned cvtpk(float lo, float hi) { f32x2_t v = {lo, hi}; bf16x2_t b = __builtin_convertvector(v, bf16x2_t); return __builtin_bit_cast(unsigned, b); }
__device__ __forceinline__ int crow(int r, int hi) { return (r & 3) + 8 * (r >> 2) + 4 * hi; }
__device__ __forceinline__ float xlane32(float v) { return __shfl_xor(v, 32); }
__device__ __forceinline__ float vmax(float a, float b) { float r; asm("v_max_f32_e32 %0, %1, %2" : "=v"(r) : "v"(a), "v"(b)); return r; }
__device__ __forceinline__ float vmin(float a, float b) { float r; asm("v_min_f32_e32 %0, %1, %2" : "=v"(r) : "v"(a), "v"(b)); return r; }
__device__ __forceinline__ float vmax3(float a, float b, float c) { float r; asm("v_max3_f32 %0, %1, %2, %3" : "=v"(r) : "v"(a), "v"(b), "v"(c)); return r; }

constexpr int AT_KP = 72, AT_VP = 96;
constexpr int AT_KS = 0, AT_KS_BYTES = 64 * AT_KP * 2;
constexpr int AT_VT = 2 * AT_KS_BYTES, AT_VT_BYTES = 64 * AT_VP * 2;
constexpr int AT_KM = AT_VT + 2 * AT_VT_BYTES;
constexpr int AT_MISC = AT_KM + 32 * AT_KP * 2;
constexpr float LOG2E = 1.4426950408889634f;

__device__ __forceinline__ unsigned mk_unit(int kind, int b, int x, int y) { return ((unsigned)kind << 30) | ((unsigned)b << 28) | ((unsigned)x << 8) | (unsigned)y; }
__device__ void build_unit_table(unsigned* tab, int i) {
    int n = 0; unsigned res = 0u;
#pragma unroll 1
    for (int c = 64; c >= 1; --c) {
        if (i >= n && i < n + 4) res = mk_unit(0, i - n, 0, c - 1);
        n += 4;
        if ((c & 3) == 0) { if (i >= n && i < n + 16) { const int j = i - n; res = mk_unit(2, j >> 2, j & 3, c / 4 - 1); } n += 16; }
    }
    if (i < 512) tab[i] = res;
}

template <int kind> __device__ __forceinline__ void attn_unit(int WV_, const bf16* P, const unsigned char* mask, const float* kmean, const float* sinks, bf16* ys,
                                unsigned char* lds, int b, int ux, int uy) {
    int tid_ = LTID(WV_); asm volatile("" : "+v"(tid_));
    const int tid = tid_, lane = tid & 63, wave = __builtin_amdgcn_readfirstlane(tid >> 6), r32 = lane & 31, hi = lane >> 5;
    bf16* s_km = (bf16*)(lds + AT_KM);
    const int skey = tid >> 3, sc = tid & 7;
    {
        const bf16* Pb = P + (size_t)b * S_ * NP;
        int q0w, qcol, kcol, vcol, ycol, kt_hi, kt_lo; float slope2 = 0.f, sink2 = 0.f;
        if (kind == 0) { const int head = wave >> 1; q0w = uy * 64 + (wave & 1) * 32; qcol = C_QA + head * 64; kcol = C_KA; vcol = C_VA; ycol = head * 64;
            slope2 = exp2f(-8.0f * (float)(3 * head + 1) / 12.0f) * LOG2E; kt_hi = uy; kt_lo = 0; }
        else if (kind == 1) { const int hq = ux * 2 + (wave >> 2); q0w = uy * 128 + (wave & 3) * 32; qcol = C_QB + hq * 64; kcol = C_KB + ux * 64; vcol = C_VB + ux * 64; ycol = 256 + hq * 64;
            slope2 = exp2f(-8.0f * (float)(3 * hq + 2) / 12.0f) * LOG2E; sink2 = sinks[hq] * LOG2E; kt_hi = 2 * uy + 1; kt_lo = (2 * uy - 2 > 0) ? 2 * uy - 2 : 0; }
        else if (kind == 2) { q0w = uy * 256 + wave * 32; qcol = C_QC + ux * 64; kcol = C_KC + ux * 64; vcol = C_VC + ux * 64; ycol = 512 + ux * 64;
            slope2 = exp2f(-8.0f * (float)(3 * ux + 3) / 12.0f) * LOG2E; kt_hi = 4 * uy + 3; kt_lo = 0; }
        else { q0w = uy * 256 + wave * 32; qcol = C_QD + ux * 64; kcol = C_KD + ux * 64; vcol = C_VD + ux * 64; ycol = 768 + ux * 64; kt_hi = 4 * uy + 3; kt_lo = 0; }
        const int qpos = q0w + r32;
        bf16x8_t qf[4];
        { const bf16* qp = Pb + (size_t)qpos * NP + qcol + 8 * hi;
#pragma unroll
          for (int ks = 0; ks < 4; ++ks) qf[ks] = *(const bf16x8_t*)(qp + 16 * ks); }
        {
            const float qs = (kind == 3) ? 0.125f : 0.125f * LOG2E;
            typedef unsigned u32x4_t __attribute__((ext_vector_type(4)));
#pragma unroll
            for (int ks = 0; ks < 4; ++ks) { u32x4_t w = __builtin_bit_cast(u32x4_t, qf[ks]);
#pragma unroll
                for (int i = 0; i < 4; ++i) w[i] = cvtpk(__uint_as_float(w[i] << 16) * qs, __uint_as_float(w[i] & 0xffff0000u) * qs);
                qf[ks] = __builtin_bit_cast(bf16x8_t, w); }
        }
        float sb[16];
#pragma unroll
        for (int r = 0; r < 16; ++r) sb[r] = slope2 * (float)((r & 3) + 8 * (r >> 2));
        unsigned bm = 0u;
        if (kind == 2) {
            const int own = uy;
            for (int e = tid; e < 32 * 64; e += NTHR) { const int row = e >> 6, d = e & 63; s_km[row * AT_KP + d] = (row < 16) ? (bf16)f2bf(kmean[((b * 4 + ux) * 16 + row) * 64 + d]) : (bf16)0; }
            __syncthreads();
            f32x16_t gacc;
#pragma unroll
            for (int r = 0; r < 16; ++r) gacc[r] = 0.f;
#pragma unroll
            for (int ks = 0; ks < 4; ++ks) { const bf16x8_t a = *(const bf16x8_t*)(s_km + r32 * AT_KP + 16 * ks + 8 * hi); gacc = __builtin_amdgcn_mfma_f32_32x32x16_bf16(a, qf[ks], gacc, 0, 0, 0); }
            float gt[16];
#pragma unroll
            for (int r = 0; r < 8; ++r) { const float mine = gacc[r], other = xlane32(mine); const int bi = crow(r, 0);
                gt[bi] = hi ? other : mine; gt[bi + 4] = hi ? mine : other; }
#pragma unroll
            for (int n = 0; n < 16; ++n) if (n >= own) gt[n] = -INFINITY;
#pragma unroll
            for (int rep = 0; rep < 3; ++rep) {
                float mx = -INFINITY;
#pragma unroll
                for (int n = 0; n < 16; ++n) mx = fmaxf(mx, gt[n]);
                bool done = !(mx > -INFINITY);
#pragma unroll
                for (int n = 0; n < 16; ++n) { const bool hit = !done && gt[n] == mx; if (hit) { bm |= 1u << n; gt[n] = -INFINITY; done = true; } }
            }
        }
        f32x16_t o0, o1;
#pragma unroll
        for (int r = 0; r < 16; ++r) { o0[r] = 0.f; o1[r] = 0.f; }
        float m_run = -INFINITY, l_run = 0.f, carry = 0.f;
        const bf16* kg = Pb + (size_t)skey * NP + kcol + sc * 8;
        const bf16* vg = Pb + (size_t)skey * NP + vcol + sc * 8;
        uint4 rk = *(const uint4*)(kg + (size_t)kt_hi * 64 * NP), rv = *(const uint4*)(vg + (size_t)kt_hi * 64 * NP);
        int buf = 0;
        { bf16* ks_ = (bf16*)(lds + AT_KS); bf16* vt_ = (bf16*)(lds + AT_VT);
          *(uint4*)(ks_ + skey * AT_KP + sc * 8) = rk;
          *(uint4*)(vt_ + skey * AT_VP + sc * 8) = rv; }
        __syncthreads();
        bool wave_done = false;
        uint2 mw_next = make_uint2(0u, 0u);
        if (kind == 0) mw_next = *(const uint2*)(mask + (size_t)(b * S_ + qpos) * 512 + kt_hi * 8);
        for (int kt = kt_hi; kt >= kt_lo; --kt) {
            const bool more = kt > kt_lo;
            const uint2 mw = mw_next;
            if (kind == 0 && more) mw_next = *(const uint2*)(mask + (size_t)(b * S_ + qpos) * 512 + (kt - 1) * 8);
            if (more) { rk = *(const uint4*)(kg + (size_t)(kt - 1) * 64 * NP); rv = *(const uint4*)(vg + (size_t)(kt - 1) * 64 * NP); }
            const bf16* ks_ = (const bf16*)(lds + AT_KS + buf * AT_KS_BYTES);
            const bf16* vt_ = (const bf16*)(lds + AT_VT + buf * AT_VT_BYTES);
            bool active = (kt * 64 <= q0w + 31) && !wave_done;
            if (kind == 1) active = active && (kt * 64 + 63 >= q0w - 127);
            if (active) {
                const int kbase = kt * 64 + 4 * hi;
                f32x16_t p0, p1;
                if (kind != 3) {
                    const float cb = slope2 * (float)(kbase - qpos), cb1 = cb + 32.0f * slope2;
#pragma unroll
                    for (int r = 0; r < 16; ++r) { p0[r] = cb + sb[r]; p1[r] = cb1 + sb[r]; }
                } else {
#pragma unroll
                    for (int r = 0; r < 16; ++r) { p0[r] = 0.f; p1[r] = 0.f; }
                }
#pragma unroll
                for (int ks = 0; ks < 4; ++ks) {
                    const bf16x8_t a0 = *(const bf16x8_t*)(ks_ + r32 * AT_KP + 16 * ks + 8 * hi);
                    const bf16x8_t a1 = *(const bf16x8_t*)(ks_ + (32 + r32) * AT_KP + 16 * ks + 8 * hi);
                    p0 = __builtin_amdgcn_mfma_f32_32x32x16_bf16(a0, qf[ks], p0, 0, 0, 0);
                    p1 = __builtin_amdgcn_mfma_f32_32x32x16_bf16(a1, qf[ks], p1, 0, 0, 0);
                }
                if (kind != 3) {
                    float mx = -INFINITY;
                    if (kind == 0) {
                        const unsigned w0 = mw.x >> (4 * hi), w1 = mw.y >> (4 * hi);
#pragma unroll
                        for (int r = 0; r < 16; ++r) { const int off = (r & 3) + 8 * (r >> 2);
                            const unsigned m0 = (unsigned)__builtin_amdgcn_sbfe((int)w0, off, 1), m1 = (unsigned)__builtin_amdgcn_sbfe((int)w1, off, 1);
                            p0[r] = __uint_as_float((__float_as_uint(p0[r]) & m0) | (0xff800000u & ~m0)); p1[r] = __uint_as_float((__float_as_uint(p1[r]) & m1) | (0xff800000u & ~m1)); mx = vmax3(mx, p0[r], p1[r]); }
                    } else if (kind == 1) {
                        const int rel = qpos - kbase;
#pragma unroll
                        for (int r = 0; r < 16; ++r) { const int off = (r & 3) + 8 * (r >> 2);
                            p0[r] = ((unsigned)(rel - off) < 128u) ? p0[r] : -INFINITY; p1[r] = ((unsigned)(rel - off - 32) < 128u) ? p1[r] : -INFINITY; mx = vmax3(mx, p0[r], p1[r]); }
                    } else {
                        if ((kt >> 2) == uy) {
                            const int rel = qpos - kbase;
#pragma unroll
                            for (int r = 0; r < 16; ++r) { const int off = (r & 3) + 8 * (r >> 2);
                                p0[r] = (off <= rel) ? p0[r] : -INFINITY; p1[r] = (off + 32 <= rel) ? p1[r] : -INFINITY; mx = vmax3(mx, p0[r], p1[r]); }
                        } else {
                            const bool tile_ok = ((bm >> (kt >> 2)) & 1u) != 0u;
#pragma unroll
                            for (int r = 0; r < 16; ++r) { p0[r] = tile_ok ? p0[r] : -INFINITY; p1[r] = tile_ok ? p1[r] : -INFINITY; mx = vmax3(mx, p0[r], p1[r]); }
                        }
                    }
                    mx = vmax(mx, xlane32(mx));
                    const float m_new = vmax(m_run, mx);
                    const float m_safe = (m_new == -INFINITY) ? 0.f : m_new;
                    p0 = p0 - m_safe; p1 = p1 - m_safe;
#pragma unroll
                    for (int r = 0; r < 16; ++r) { p0[r] = __builtin_amdgcn_exp2f(p0[r]); p1[r] = __builtin_amdgcn_exp2f(p1[r]); }
                    float ls;
                    { typedef float f32x8_t __attribute__((ext_vector_type(8))); typedef float f32x4v_t __attribute__((ext_vector_type(4)));
                      const f32x16_t t16 = p0 + p1; const f32x8_t t8 = t16.lo + t16.hi; const f32x4v_t t4 = t8.lo + t8.hi; const f32x2_t t2 = t4.lo + t4.hi; ls = t2.x + t2.y; }
                    if (__any(m_new > m_run)) {
                        const float alpha = __builtin_amdgcn_exp2f(m_run - m_safe);
                        l_run *= alpha;
                        o0 = o0 * alpha; o1 = o1 * alpha;
                    }
                    l_run += ls; m_run = m_new;
                } else {
                    float run = carry;
#define SB_HALF(PX, KOFF) do { \
                    float lk[16]; \
                    _Pragma("unroll") for (int r = 0; r < 16; ++r) { \
                        const int off = (r & 3) + 8 * (r >> 2); \
                        const bool v = (kbase + off + (KOFF)) < qpos; \
                        const float z = PX[r]; \
                        const float t = 0.6931471805599453f * __builtin_amdgcn_logf(1.0f + __builtin_amdgcn_exp2f(-LOG2E * fabsf(z))); \
                        lk[r] = v ? (fminf(-z, 0.f) - t) : 0.f; \
                        PX[r] = v ? (fminf(z, 0.f) - t) : -INFINITY; } \
                    _Pragma("unroll") for (int g = 3; g >= 0; --g) { \
                        const float G = (lk[4 * g] + lk[4 * g + 1]) + (lk[4 * g + 2] + lk[4 * g + 3]); \
                        const float PG = xlane32(G); \
                        float la = run + (hi ? 0.f : PG); \
                        run += G + PG; \
                        PX[4 * g + 3] += la; la += lk[4 * g + 3]; PX[4 * g + 2] += la; la += lk[4 * g + 2]; PX[4 * g + 1] += la; la += lk[4 * g + 1]; PX[4 * g] += la; } \
                    _Pragma("unroll") for (int r = 0; r < 16; ++r) PX[r] = __builtin_amdgcn_exp2f(LOG2E * PX[r]); } while (0)
                    SB_HALF(p1, 32);
                    SB_HALF(p0, 0);
#undef SB_HALF
                    carry = run;
                }
                unsigned pw[16];
#pragma unroll
                for (int j = 0; j < 8; ++j) { pw[j] = cvtpk(p0[2 * j], p0[2 * j + 1]); pw[8 + j] = cvtpk(p1[2 * j], p1[2 * j + 1]); }
#pragma unroll
                for (int s = 0; s < 4; ++s) {
                    bf16x8_t pb; { const unsigned* q = pw + 4 * s; typedef unsigned u32x4_t __attribute__((ext_vector_type(4))); u32x4_t t4 = {q[0], q[1], q[2], q[3]}; pb = __builtin_bit_cast(bf16x8_t, t4); }
#pragma unroll
                    for (int dt = 0; dt < 2; ++dt) {
                        typedef short s16x4_t __attribute__((ext_vector_type(4)));
                        typedef __attribute__((address_space(3))) s16x4_t lds_s16x4;
                        const int gi_ = lane & 15;
                        const bf16* vp = vt_ + (16 * s + 4 * hi + (gi_ >> 2)) * AT_VP + 32 * dt + 16 * ((lane >> 4) & 1) + 4 * (gi_ & 3);
                        const s16x4_t lo = __builtin_amdgcn_ds_read_tr16_b64_v4i16((lds_s16x4*)vp), hi4 = __builtin_amdgcn_ds_read_tr16_b64_v4i16((lds_s16x4*)(vp + 8 * AT_VP));
                        const bf16x8_t va = {lo[0], lo[1], lo[2], lo[3], hi4[0], hi4[1], hi4[2], hi4[3]};
                        if (dt == 0) o0 = __builtin_amdgcn_mfma_f32_32x32x16_bf16(va, pb, o0, 0, 0, 0);
                        else         o1 = __builtin_amdgcn_mfma_f32_32x32x16_bf16(va, pb, o1, 0, 0, 0);
                    }
                }
            }
            if (kind == 3) {
                const float cm = carry;
                if (__all(cm < -110.0f) || !(kt * 64 <= q0w + 31) ) { if (__all(cm < -110.0f)) wave_done = true; }
            }
            if (more) {
                bf16* ksn = (bf16*)(lds + AT_KS + (buf ^ 1) * AT_KS_BYTES); bf16* vtn = (bf16*)(lds + AT_VT + (buf ^ 1) * AT_VT_BYTES);
                *(uint4*)(ksn + skey * AT_KP + sc * 8) = rk;
                *(uint4*)(vtn + skey * AT_VP + sc * 8) = rv;
            }
            if (kind == 3) { if (__syncthreads_and(wave_done ? 1 : 0)) break; }
            else __syncthreads();
            buf ^= 1;
        }
        float inv;
        if (kind == 3) inv = 1.0f;
        else {
            float lt = l_run + xlane32(l_run);
            if (kind == 1) { const float mf = fmaxf(m_run, sink2); const float sc2 = exp2f(m_run - mf); lt = lt * sc2 + exp2f(sink2 - mf); inv = sc2 / lt; }
            else inv = 1.0f / lt;
        }
        bf16* yp = ys + (size_t)(b * S_ + qpos) * 1024 + ycol + 4 * hi;
#pragma unroll
        for (int g = 0; g < 4; ++g) {
            *(uint2*)(yp + 8 * g) = make_uint2(cvtpk(o0[4 * g] * inv, o0[4 * g + 1] * inv), cvtpk(o0[4 * g + 2] * inv, o0[4 * g + 3] * inv));
            *(uint2*)(yp + 32 + 8 * g) = make_uint2(cvtpk(o1[4 * g] * inv, o1[4 * g + 1] * inv), cvtpk(o1[4 * g + 2] * inv, o1[4 * g + 3] * inv));
        }
    }
}
__device__ void attn_fast_phase(int WV_, const bf16* P, const unsigned char* mask, const float* kmean, const float* sinks, bf16* ys,
                                const unsigned* utab, unsigned* counter, unsigned char* lds) {
    volatile unsigned* s_unit = (volatile unsigned*)(lds + AT_MISC);
    for (;;) {
        __syncthreads();
        if (LTID(WV_) == 0) s_unit[0] = atomicAdd(counter, 1u);
        __syncthreads();
        const unsigned ui = s_unit[0];
        if (ui >= 512u) break;
        const unsigned ue = utab[ui];
        const int kind = (int)(ue >> 30), b = (int)((ue >> 28) & 3u), ux = (int)((ue >> 8) & 255u), uy = (int)(ue & 255u);
        if (kind == 0) attn_unit<0>(WV_, P, mask, kmean, sinks, ys, lds, b, ux, uy);
        else attn_unit<2>(WV_, P, mask, kmean, sinks, ys, lds, b, ux, uy);
    }
    for (int u = LBID(); u < 256; u += LGRID()) { __syncthreads(); attn_unit<3>(WV_, P, mask, kmean, sinks, ys, lds, u >> 6, (u >> 4) & 3, u & 15); }
    for (int u = LBID(); u < 256; u += LGRID()) { __syncthreads(); attn_unit<1>(WV_, P, mask, kmean, sinks, ys, lds, u >> 6, (u >> 5) & 1, u & 31); }
}

constexpr float U_SCALE = 128.0f, V_SCALE = 48.0f;
constexpr int ROW6 = 1536;
typedef float v32f_t __attribute__((ext_vector_type(32)));
typedef unsigned v6u_t __attribute__((ext_vector_type(6)));
typedef unsigned u32x4a8_t __attribute__((ext_vector_type(4), aligned(8)));
__device__ __forceinline__ float rdlane_f(float v, int l) { return __builtin_bit_cast(float, __builtin_amdgcn_readlane(__builtin_bit_cast(int, v), l)); }
__device__ __forceinline__ unsigned q_e2m3(float v) {
    const float a = fminf(fabsf(v), 7.5f);
    unsigned code;
    if (a < 1.0f) code = (unsigned)rintf(a * 8.0f);
    else if (a < 2.0f) code = 8u + (unsigned)rintf((a - 1.0f) * 8.0f);
    else if (a < 4.0f) code = 16u + (unsigned)rintf((a - 2.0f) * 4.0f);
    else code = 24u + (unsigned)rintf((a - 4.0f) * 2.0f);
    return code | (v < 0.f ? 32u : 0u);
}
__device__ __forceinline__ void cvt_chunk6(const float4 (&a)[8], float sc, unsigned (&w)[6]) {
#pragma unroll
    for (int d = 0; d < 6; ++d) w[d] = 0u;
#pragma unroll
    for (int q4 = 0; q4 < 8; ++q4) {
        const float av[4] = {a[q4].x, a[q4].y, a[q4].z, a[q4].w};
#pragma unroll
        for (int e = 0; e < 4; ++e) { const int idx = q4 * 4 + e, bit = 6 * idx, d = bit >> 5, sft = bit & 31; const unsigned code = q_e2m3(av[e] * sc);
            w[d] |= code << sft; if (sft > 26) w[d + 1] |= code >> (32 - sft); }
    }
}
__device__ void convert_tables(int WV_, const Params& p) {
    const size_t nchunk = (size_t)DEPTH_ * 16384 * 2 * 32;
    const size_t stride = (size_t)LGRID() * NTHR;
    for (size_t i = (size_t)LBID() * NTHR + LTID(WV_); i < nchunk; i += 2 * stride) {
        const size_t i2 = i + stride; const bool has2 = i2 < nchunk; const size_t j2 = has2 ? i2 : i;
        const int c0 = (int)(i & 31), uv0 = (int)((i >> 5) & 1); const size_t le0 = i >> 6;
        const int c1 = (int)(j2 & 31), uv1 = (int)((j2 >> 5) & 1); const size_t le1 = j2 >> 6;
        const float* src0 = (uv0 ? p.in[10] : p.in[9]) + le0 * 1024 + c0 * 32;
        const float* src1 = (uv1 ? p.in[10] : p.in[9]) + le1 * 1024 + c1 * 32;
        float4 a0[8], a1[8];
#pragma unroll
        for (int q4 = 0; q4 < 8; ++q4) a0[q4] = ((const float4*)src0)[q4];
#pragma unroll
        for (int q4 = 0; q4 < 8; ++q4) a1[q4] = ((const float4*)src1)[q4];
        unsigned w0[6], w1[6];
        cvt_chunk6(a0, uv0 ? V_SCALE : U_SCALE, w0);
        cvt_chunk6(a1, uv1 ? V_SCALE : U_SCALE, w1);
        uint2* dst0 = (uint2*)(p.ws + WS_UV + le0 * ROW6 + uv0 * 768 + c0 * 24);
        dst0[0] = make_uint2(w0[0], w0[1]); dst0[1] = make_uint2(w0[2], w0[3]); dst0[2] = make_uint2(w0[4], w0[5]);
        if (has2) { uint2* dst1 = (uint2*)(p.ws + WS_UV + le1 * ROW6 + uv1 * 768 + c1 * 24);
            dst1[0] = make_uint2(w1[0], w1[1]); dst1[1] = make_uint2(w1[2], w1[3]); dst1[2] = make_uint2(w1[4], w1[5]); }
    }
}
__device__ __forceinline__ v6u_t ld_pk6(const unsigned char* ptr) {
    const uint2 a = ((const uint2*)ptr)[0], b = ((const uint2*)ptr)[1], c = ((const uint2*)ptr)[2];
    const v6u_t pk = {a.x, a.y, b.x, b.y, c.x, c.y};
    return pk;
}
__device__ void peer_fast_phase(int WV_, float* h, bf16* hb, const int* eid, const float* gate, const unsigned char* uv, const float* g1, const float* b1, const float* g, const float* bb, unsigned char* lds) {
    const int tid = LTID(WV_), lane = tid & 63, wave = tid >> 6, l32 = lane & 31, hi = lane >> 5;
    float* pl = (float*)(lds + wave * 16384);
    unsigned char* raw = lds + wave * 16384 + 4096 + lane * 24;
    for (int t = LBID() * NWAVE + wave; t < T_; t += LGRID() * NWAVE) {
        float* hr = h + (size_t)t * 1024 + l32 * 32;
        float x[32], acc[32];
#pragma unroll
        for (int q4 = 0; q4 < 4; ++q4) { const uint4 a = ((const uint4*)(hb + (size_t)t * 1024 + l32 * 32))[q4];
            x[8 * q4] = __uint_as_float(a.x << 16); x[8 * q4 + 1] = __uint_as_float(a.x & 0xffff0000u); x[8 * q4 + 2] = __uint_as_float(a.y << 16); x[8 * q4 + 3] = __uint_as_float(a.y & 0xffff0000u);
            x[8 * q4 + 4] = __uint_as_float(a.z << 16); x[8 * q4 + 5] = __uint_as_float(a.z & 0xffff0000u); x[8 * q4 + 6] = __uint_as_float(a.w << 16); x[8 * q4 + 7] = __uint_as_float(a.w & 0xffff0000u); }
        {
            float s = 0.f;
#pragma unroll
            for (int i = 0; i < 32; ++i) s += x[i];
#pragma unroll
            for (int o = 16; o > 0; o >>= 1) s += __shfl_xor(s, o);
            const float mean = s * (1.0f / 1024.0f);
            float s2 = 0.f;
#pragma unroll
            for (int i = 0; i < 32; ++i) { x[i] -= mean; s2 += x[i] * x[i]; }
#pragma unroll
            for (int o = 16; o > 0; o >>= 1) s2 += __shfl_xor(s2, o);
            const float rstd = 1.0f / sqrtf(s2 * (1.0f / 1024.0f) + LN_EPS);
#pragma unroll
            for (int q4 = 0; q4 < 8; ++q4) { const float4 gg = ((const float4*)(g1 + l32 * 32))[q4], cc = ((const float4*)(b1 + l32 * 32))[q4];
                x[4 * q4] = x[4 * q4] * rstd * gg.x + cc.x; x[4 * q4 + 1] = x[4 * q4 + 1] * rstd * gg.y + cc.y; x[4 * q4 + 2] = x[4 * q4 + 2] * rstd * gg.z + cc.z; x[4 * q4 + 3] = x[4 * q4 + 3] * rstd * gg.w + cc.w; }
        }
#pragma unroll
        for (int i = 0; i < 32; ++i) acc[i] = 0.f;
#pragma unroll 1
        for (int batch = 0; batch < 4; ++batch) {
            const int my_eid = eid[(size_t)t * 128 + batch * 32 + l32];
            const float my_gate = gate[(size_t)t * 128 + batch * 32 + l32];
#pragma unroll 1
            for (int grp = 0; grp < 2; ++grp) {
                { u32x4a8_t pa[8]; uint2 pc[8];
#pragma unroll
                  for (int i = 0; i < 8; ++i) { const int id = __shfl(my_eid, 2 * (grp * 8 + i) + hi); const unsigned char* rp = uv + (size_t)id * ROW6 + l32 * 24; pa[i] = *(const u32x4a8_t*)rp; pc[i] = *(const uint2*)(rp + 16); }
#pragma unroll
                  for (int i = 0; i < 8; ++i) { uint2* wp = (uint2*)(raw + i * 1536); wp[0] = make_uint2(pa[i].x, pa[i].y); wp[1] = make_uint2(pa[i].z, pa[i].w); wp[2] = pc[i]; } }
#pragma unroll 1
                for (int i = 0; i < 8; ++i) {
                    const uint2* rp = (const uint2*)(raw + i * 1536); const uint2 a = rp[0], b = rp[1], c = rp[2];
                    const v6u_t pk6 = {a.x, a.y, b.x, b.y, c.x, c.y}; const v32f_t f = __builtin_amdgcn_cvt_scalef32_pk32_f32_fp6(pk6, 1.0f);
                    f32x2_t dv0 = {0.f, 0.f}, dv1 = {0.f, 0.f};
#pragma unroll
                    for (int j = 0; j < 8; ++j) { const f32x2_t fa = {f[2 * j], f[2 * j + 1]}, fb = {f[16 + 2 * j], f[17 + 2 * j]}, xa = {x[2 * j], x[2 * j + 1]}, xb = {x[16 + 2 * j], x[17 + 2 * j]};
                        dv0 = fa * xa + dv0; dv1 = fb * xb + dv1; }
                    pl[(2 * (grp * 8 + i) + hi) * 32 + l32] = (dv0.x + dv0.y) + (dv1.x + dv1.y);
                }
            }
            float d;
            { const float4* pr = (const float4*)(pl + l32 * 32); float4 s4 = pr[0];
#pragma unroll
              for (int i = 1; i < 8; ++i) { const float4 v = pr[i]; s4.x += v.x; s4.y += v.y; s4.z += v.z; s4.w += v.w; }
              d = ((s4.x + s4.y) + (s4.z + s4.w)) * (1.0f / U_SCALE); }
            const float hv = 0.5f * d * (1.0f + erff(d * 0.70710678118654752f)) * my_gate * (1.0f / V_SCALE);
#pragma unroll 1
            for (int grp = 0; grp < 2; ++grp) {
                { u32x4a8_t pa[8]; uint2 pc[8];
#pragma unroll
                  for (int i = 0; i < 8; ++i) { const int id = __shfl(my_eid, 2 * (grp * 8 + i) + hi); const unsigned char* rp = uv + (size_t)id * ROW6 + 768 + l32 * 24; pa[i] = *(const u32x4a8_t*)rp; pc[i] = *(const uint2*)(rp + 16); }
#pragma unroll
                  for (int i = 0; i < 8; ++i) { uint2* wp = (uint2*)(raw + i * 1536); wp[0] = make_uint2(pa[i].x, pa[i].y); wp[1] = make_uint2(pa[i].z, pa[i].w); wp[2] = pc[i]; } }
#pragma unroll 1
                for (int i = 0; i < 8; ++i) {
                    const float c = __shfl(hv, 2 * (grp * 8 + i) + hi);
                    const uint2* rp = (const uint2*)(raw + i * 1536); const uint2 a = rp[0], b = rp[1], cc = rp[2];
                    const v6u_t pk6 = {a.x, a.y, b.x, b.y, cc.x, cc.y}; const v32f_t f = __builtin_amdgcn_cvt_scalef32_pk32_f32_fp6(pk6, 1.0f);
                    const f32x2_t c2 = {c, c};
#pragma unroll
                    for (int j = 0; j < 16; ++j) { const f32x2_t fj = {f[2 * j], f[2 * j + 1]}; f32x2_t aj = {acc[2 * j], acc[2 * j + 1]}; aj = fj * c2 + aj; acc[2 * j] = aj.x; acc[2 * j + 1] = aj.y; }
                }
            }
        }
        float y[32], s = 0.f;
#pragma unroll
        for (int i = 0; i < 32; ++i) { acc[i] += __shfl_xor(acc[i], 32); y[i] = ALPHA * x[i] + acc[i]; s += y[i]; }
#pragma unroll
        for (int o = 16; o > 0; o >>= 1) s += __shfl_xor(s, o);
        const float mean = s * (1.0f / 1024.0f);
        float s2 = 0.f;
#pragma unroll
        for (int i = 0; i < 32; ++i) { y[i] -= mean; s2 += y[i] * y[i]; }
#pragma unroll
        for (int o = 16; o > 0; o >>= 1) s2 += __shfl_xor(s2, o);
        const float rstd = 1.0f / sqrtf(s2 * (1.0f / 1024.0f) + LN_EPS);
        float o[16];
#pragma unroll
        for (int q4 = 0; q4 < 4; ++q4) {
            const float4 gg = ((const float4*)(g + l32 * 32 + hi * 16))[q4], cc = ((const float4*)(bb + l32 * 32 + hi * 16))[q4];
            float ya[4], yb2[4];
#pragma unroll
            for (int e = 0; e < 4; ++e) { ya[e] = y[4 * q4 + e]; yb2[e] = y[16 + 4 * q4 + e]; }
            asm volatile("" : "+v"(ya[0]), "+v"(ya[1]), "+v"(ya[2]), "+v"(ya[3]), "+v"(yb2[0]), "+v"(yb2[1]), "+v"(yb2[2]), "+v"(yb2[3]));
            const float y0 = hi ? yb2[0] : ya[0], y1 = hi ? yb2[1] : ya[1], y2 = hi ? yb2[2] : ya[2], y3 = hi ? yb2[3] : ya[3];
            o[4 * q4] = y0 * rstd * gg.x + cc.x; o[4 * q4 + 1] = y1 * rstd * gg.y + cc.y; o[4 * q4 + 2] = y2 * rstd * gg.z + cc.z; o[4 * q4 + 3] = y3 * rstd * gg.w + cc.w;
            if (h) ((float4*)(hr + hi * 16))[q4] = make_float4(o[4 * q4], o[4 * q4 + 1], o[4 * q4 + 2], o[4 * q4 + 3]);
        }
        uint4* hbp = (uint4*)(hb + (size_t)t * 1024 + l32 * 32 + hi * 16);
        hbp[0] = make_uint4(pk2(o[0], o[1]), pk2(o[2], o[3]), pk2(o[4], o[5]), pk2(o[6], o[7]));
        hbp[1] = make_uint4(pk2(o[8], o[9]), pk2(o[10], o[11]), pk2(o[12], o[13]), pk2(o[14], o[15]));
    }
}

__device__ __forceinline__ float pack_pl(float v, unsigned pl) { return __uint_as_float((__float_as_uint(v) & ~127u) | pl); }
__device__ __forceinline__ void ins16(float (&s)[16], float x) {
#pragma unroll
    for (int k = 15; k >= 1; --k) s[k] = __builtin_amdgcn_fmed3f(s[k - 1], x, s[k]);
    s[0] = vmax(s[0], x);
}
template <int D> __device__ __forceinline__ void bitonic_stage(float (&c)[16]) {
#pragma unroll
    for (int i = 0; i < 16; ++i) if ((i & D) == 0) { const float a = vmax(c[i], c[i + D]), b = vmin(c[i], c[i + D]); c[i] = a; c[i + D] = b; }
}
__device__ __forceinline__ int decode_key(unsigned pl) { return (int)(32u * ((pl >> 4) & 3u) + (pl & 3u) + 8u * ((pl >> 2) & 3u) + 4u * ((pl >> 6) & 1u)); }
__device__ void route_fast_phase(int WV_, const bf16* qb, const bf16* skb  , int* eid, float* gate, unsigned char* lds, int pm = -1, int pn = 0) {
    const int tid = LTID(WV_), lane = tid & 63, wave = tid >> 6, r32 = lane & 31, hi = lane >> 5;
    unsigned* lidx = (unsigned*)lds + wave * (64 * 33) + lane * 33;
    const int u_first = (pm >= 0) ? 0 : LBID() * NWAVE + wave, u_end = (pm >= 0) ? 2 : (T_ / 32) * 8, u_step = (pm >= 0) ? 1 : LGRID() * NWAVE;
    for (int unit = u_first; unit < u_end; unit += u_step) {
        const int h = (pm >= 0) ? 2 * pn + unit : (unit & 7), t = ((pm >= 0) ? 8 * pm + wave : (unit >> 3)) * 32 + r32;
        float sl[2][16];
#pragma unroll
        for (int p = 0; p < 2; ++p) {
            bf16x8_t qf[4];
            { const bf16* qp = qb + (size_t)t * 1024 + h * 128 + p * 64 + 8 * hi;
#pragma unroll
              for (int ks = 0; ks < 4; ++ks) qf[ks] = *(const bf16x8_t*)(qp + 16 * ks); }
            float s[16];
#pragma unroll
            for (int k = 0; k < 16; ++k) s[k] = -INFINITY;
            const bf16* skp = skb + ((size_t)(h * 2 + p) * 128 + r32) * 64 + 8 * hi;
#pragma unroll
            for (int kt = 0; kt < 4; ++kt) {
                f32x16_t acc;
#pragma unroll
                for (int r = 0; r < 16; ++r) acc[r] = 0.f;
#pragma unroll
                for (int ks = 0; ks < 4; ++ks) { const bf16x8_t a = *(const bf16x8_t*)(skp + (size_t)kt * 32 * 64 + 16 * ks); acc = __builtin_amdgcn_mfma_f32_32x32x16_bf16(a, qf[ks], acc, 0, 0, 0); }
#pragma unroll
                for (int r = 0; r < 16; ++r) ins16(s, pack_pl(acc[r], (unsigned)(kt * 16 + r)));
            }
            const unsigned hb = (unsigned)hi << 6;
#pragma unroll
            for (int k = 0; k < 16; ++k) s[k] = __uint_as_float(__float_as_uint(s[k]) | hb);
            float c[16];
#pragma unroll
            for (int k = 0; k < 16; ++k) c[k] = vmax(s[k], __shfl_xor(s[15 - k], 32));
            bitonic_stage<8>(c); bitonic_stage<4>(c); bitonic_stage<2>(c); bitonic_stage<1>(c);
#pragma unroll
            for (int k = 0; k < 16; ++k) { sl[p][k] = c[k]; lidx[p * 16 + k] = (unsigned)decode_key(__float_as_uint(c[k]) & 127u); }
        }
        float w[16];
#pragma unroll
        for (int k = 0; k < 16; ++k) w[k] = -INFINITY;
#pragma unroll
        for (int i = 0; i < 16; ++i)
#pragma unroll
            for (int j = 0; j < 16; ++j)
                if ((i + 1) * (j + 1) <= 16) { const float v = sl[0][i] + sl[1][j]; ins16(w, __uint_as_float((__float_as_uint(v) & ~255u) | (unsigned)(i * 16 + j))); }
        float e[16], sum = 0.f;
#pragma unroll
        for (int k = 0; k < 16; ++k) { e[k] = __builtin_amdgcn_exp2f((w[k] - w[0]) * 1.44269504f); sum += e[k]; }
        const float inv = 1.0f / sum;
        int ide[8]; float gte[8];
#pragma unroll
        for (int k = 0; k < 8; ++k) {
            float wa = w[k], wb = w[8 + k], ea = e[k], eb = e[8 + k];
            asm volatile("" : "+v"(wa), "+v"(wb), "+v"(ea), "+v"(eb));
            const float wv = hi ? wb : wa;
            const unsigned pl = __float_as_uint(wv) & 255u;
            ide[k] = (int)(lidx[pl >> 4] * 128u + lidx[16 + (pl & 15u)]);
            gte[k] = (hi ? eb : ea) * inv;
        }
        int* ep = eid + (size_t)t * 128 + h * 16 + hi * 8; float* gp = gate + (size_t)t * 128 + h * 16 + hi * 8;
        *(int4*)ep = make_int4(ide[0], ide[1], ide[2], ide[3]); *(int4*)(ep + 4) = make_int4(ide[4], ide[5], ide[6], ide[7]);
        *(float4*)gp = make_float4(gte[0], gte[1], gte[2], gte[3]); *(float4*)(gp + 4) = make_float4(gte[4], gte[5], gte[6], gte[7]);
    }
}
#ifndef TS_SEL
#define TS_SEL 0
#endif
#define ITS_B() do { if (TS_SEL >= 20 && TS_SEL <= 40 && WV_ == 0 && LANEID() == 0) ((volatile __attribute__((address_space(3))) unsigned long long*)((__attribute__((address_space(3))) unsigned char*)lds + 147456 - 16 - 32))[0] = __builtin_amdgcn_s_memrealtime(); } while (0)
#define ITS_E(k) do { if ((k) == TS_SEL && WV_ == 0 && LANEID() == 0) { volatile __attribute__((address_space(3))) unsigned long long* w_ = (volatile __attribute__((address_space(3))) unsigned long long*)((__attribute__((address_space(3))) unsigned char*)lds + 147456 - 16 - 32); w_[1] += __builtin_amdgcn_s_memrealtime() - w_[0]; } } while (0)

typedef float f32x4_t __attribute__((ext_vector_type(4)));
typedef __bf16 bf16x2v __attribute__((ext_vector_type(2)));
__device__ __forceinline__ float dot2bf(unsigned a, unsigned b, float c) { return __builtin_amdgcn_fdot2_f32_bf16(__builtin_bit_cast(bf16x2v, a), __builtin_bit_cast(bf16x2v, b), c, false); }
__device__ __forceinline__ void cnt_gt(int& cnt, unsigned a, unsigned b) { asm("v_cmp_gt_u32_e32 vcc, %1, %2\n\tv_addc_co_u32_e32 %0, vcc, 0, %0, vcc" : "+v"(cnt) : "v"(a), "v"(b) : "vcc"); }
__device__ __forceinline__ void cnt_eq(int& cnt, unsigned a, unsigned b) { asm("v_cmp_eq_u32_e32 vcc, %1, %2\n\tv_addc_co_u32_e32 %0, vcc, 0, %0, vcc" : "+v"(cnt) : "v"(a), "v"(b) : "vcc"); }
__device__ __forceinline__ unsigned flag_gt(unsigned a, unsigned b) { unsigned r; asm("v_cmp_gt_u32_e32 vcc, %1, %2\n\tv_cndmask_b32_e64 %0, 0, 1, vcc" : "=v"(r) : "v"(a), "v"(b) : "vcc"); return r; }
__device__ __forceinline__ unsigned flag_eq(unsigned a, unsigned b) { unsigned r; asm("v_cmp_eq_u32_e32 vcc, %1, %2\n\tv_cndmask_b32_e64 %0, 0, 1, vcc" : "=v"(r) : "v"(a), "v"(b) : "vcc"); return r; }
__device__ __forceinline__ void cnt_ge(int& cnt, unsigned key, unsigned cand) { asm("v_cmp_ge_u32_e32 vcc, %1, %2\n\tv_addc_co_u32_e32 %0, vcc, 0, %0, vcc" : "+v"(cnt) : "v"(key), "v"(cand) : "vcc"); }

template <int CTRL, int RM> __device__ __forceinline__ unsigned dpp0(unsigned v) { return (unsigned)__builtin_amdgcn_update_dpp(0, (int)v, CTRL, RM, 0xf, false); }
template <int CTRL> __device__ __forceinline__ unsigned dppf(unsigned v) { return (unsigned)__builtin_amdgcn_update_dpp(-1, (int)v, CTRL, 0xf, 0xf, false); }
__device__ __forceinline__ unsigned wave_sum_u_dpp(unsigned v) {
    v += dpp0<0xB1, 0xf>(v); v += dpp0<0x4E, 0xf>(v); v += dpp0<0x141, 0xf>(v); v += dpp0<0x140, 0xf>(v);
    return (unsigned)__builtin_amdgcn_readlane((int)v, 0) + (unsigned)__builtin_amdgcn_readlane((int)v, 16) + (unsigned)__builtin_amdgcn_readlane((int)v, 32) + (unsigned)__builtin_amdgcn_readlane((int)v, 48);
}
__device__ __forceinline__ unsigned wave_min_u_dpp(unsigned v) {
    unsigned t;
    t = dppf<0xB1>(v); v = t < v ? t : v; t = dppf<0x4E>(v); v = t < v ? t : v; t = dppf<0x141>(v); v = t < v ? t : v; t = dppf<0x140>(v); v = t < v ? t : v;
    const unsigned a = (unsigned)__builtin_amdgcn_readlane((int)v, 0), b = (unsigned)__builtin_amdgcn_readlane((int)v, 16), c = (unsigned)__builtin_amdgcn_readlane((int)v, 32), d = (unsigned)__builtin_amdgcn_readlane((int)v, 48);
    const unsigned ab = a < b ? a : b, cd = c < d ? c : d; return ab < cd ? ab : cd;
}
__device__ __forceinline__ unsigned wave_incl_scan_u_dpp(unsigned v) {
    v += dpp0<0x111, 0xf>(v); v += dpp0<0x112, 0xf>(v); v += dpp0<0x114, 0xf>(v); v += dpp0<0x118, 0xf>(v);
    v += dpp0<0x142, 0xa>(v);
    v += dpp0<0x143, 0xc>(v);
    return v;
}
typedef __attribute__((address_space(3))) unsigned lds_u32;
template <int SHIFT> __device__ __forceinline__ unsigned radix_pass(const unsigned (&key)[64], unsigned pre, lds_u32* hist, int lane, int& need, int jlim, unsigned L, unsigned& cntsel) {
    typedef unsigned u32x4v __attribute__((ext_vector_type(4)));
    typedef __attribute__((address_space(3))) u32x4v lds_u32x4;
    const int fl = 63 - lane;
    { const u32x4v z4 = {0u, 0u, 0u, 0u};
      ((lds_u32x4*)(hist + fl * 4))[0] = z4; }
    const unsigned hb = (unsigned)(size_t)hist;
    const unsigned one = 1u;
    asm volatile("" ::: "memory");
#pragma unroll
    for (int j4 = 0; j4 < 16; ++j4) {
        if (4 * j4 <= jlim) {
            unsigned long long c0, c1, c2, c3, sv; unsigned t0, t1, t2, t3;
            if (SHIFT == 24)
                asm volatile(
                    "v_cmp_ge_u32_e64 %0, %9, %13\n\tv_cmp_ge_u32_e64 %1, %10, %13\n\tv_cmp_ge_u32_e64 %2, %11, %13\n\tv_cmp_ge_u32_e64 %3, %12, %13\n\t"
                    "v_lshrrev_b32_e32 %5, 24, %9\n\tv_lshrrev_b32_e32 %6, 24, %10\n\tv_lshrrev_b32_e32 %7, 24, %11\n\tv_lshrrev_b32_e32 %8, 24, %12\n\t"
                    "v_lshl_add_u32 %5, %5, 2, %14\n\tv_lshl_add_u32 %6, %6, 2, %14\n\tv_lshl_add_u32 %7, %7, 2, %14\n\tv_lshl_add_u32 %8, %8, 2, %14\n\t"
                    "s_mov_b64 %4, exec\n\t"
                    "s_mov_b64 exec, %0\n\tds_add_u32 %5, %15\n\ts_mov_b64 exec, %1\n\tds_add_u32 %6, %15\n\ts_mov_b64 exec, %2\n\tds_add_u32 %7, %15\n\ts_mov_b64 exec, %3\n\tds_add_u32 %8, %15\n\t"
                    "s_mov_b64 exec, %4"
                    : "=&s"(c0), "=&s"(c1), "=&s"(c2), "=&s"(c3), "=&s"(sv), "=&v"(t0), "=&v"(t1), "=&v"(t2), "=&v"(t3)
                    : "v"(key[4 * j4]), "v"(key[4 * j4 + 1]), "v"(key[4 * j4 + 2]), "v"(key[4 * j4 + 3]), "v"(L), "v"(hb), "v"(one) : "memory");
            else
                asm volatile(
                    "v_lshrrev_b32_e32 %5, %16, %9\n\tv_lshrrev_b32_e32 %6, %16, %10\n\tv_lshrrev_b32_e32 %7, %16, %11\n\tv_lshrrev_b32_e32 %8, %16, %12\n\t"
                    "v_cmp_eq_u32_e64 %0, %5, %13\n\tv_cmp_eq_u32_e64 %1, %6, %13\n\tv_cmp_eq_u32_e64 %2, %7, %13\n\tv_cmp_eq_u32_e64 %3, %8, %13\n\t"
                    "s_or_b64 %4, %0, %1\n\ts_or_b64 %4, %4, %2\n\ts_or_b64 %4, %4, %3\n\t"
                    "s_cbranch_scc0 .Lrxskip%=\n\t"
                    "v_bfe_u32 %5, %9, %17, 8\n\tv_bfe_u32 %6, %10, %17, 8\n\tv_bfe_u32 %7, %11, %17, 8\n\tv_bfe_u32 %8, %12, %17, 8\n\t"
                    "v_lshl_add_u32 %5, %5, 2, %14\n\tv_lshl_add_u32 %6, %6, 2, %14\n\tv_lshl_add_u32 %7, %7, 2, %14\n\tv_lshl_add_u32 %8, %8, 2, %14\n\t"
                    "s_mov_b64 %4, exec\n\t"
                    "s_mov_b64 exec, %0\n\tds_add_u32 %5, %15\n\ts_mov_b64 exec, %1\n\tds_add_u32 %6, %15\n\ts_mov_b64 exec, %2\n\tds_add_u32 %7, %15\n\ts_mov_b64 exec, %3\n\tds_add_u32 %8, %15\n\t"
                    "s_mov_b64 exec, %4\n"
                    ".Lrxskip%=:"
                    : "=&s"(c0), "=&s"(c1), "=&s"(c2), "=&s"(c3), "=&s"(sv), "=&v"(t0), "=&v"(t1), "=&v"(t2), "=&v"(t3)
                    : "v"(key[4 * j4]), "v"(key[4 * j4 + 1]), "v"(key[4 * j4 + 2]), "v"(key[4 * j4 + 3]), "v"(pre), "v"(hb), "v"(one), "n"((SHIFT + 8) & 31), "n"(SHIFT) : "memory", "scc");
        }
    }
    asm volatile("s_waitcnt lgkmcnt(0)" ::: "memory");
    unsigned dsum[4]; unsigned sumL = 0u;
    { const u32x4v v0 = ((const lds_u32x4*)(hist + fl * 4))[0];
      dsum[0] = v0.x; dsum[1] = v0.y; dsum[2] = v0.z; dsum[3] = v0.w; sumL = (dsum[0] + dsum[1]) + (dsum[2] + dsum[3]); }
    const unsigned incl = wave_incl_scan_u_dpp(sumL);
    const unsigned above = incl - sumL;
    const bool own = (above < (unsigned)need) && ((unsigned)need <= above + sumL);
    const int owner = __ffsll((long long)__ballot(own)) - 1;
    unsigned acc = above; int sel = -1; unsigned cab = 0u;
    unsigned csel = 0u;
#pragma unroll
    for (int i = 3; i >= 0; --i) { const unsigned c = dsum[i]; const bool hit = (sel < 0) && (acc + c >= (unsigned)need); cab = hit ? acc : cab; csel = hit ? c : csel; sel = hit ? i : sel; acc += c; }
    const int ow = owner < 0 ? 0 : owner;
    const unsigned digit = (unsigned)__builtin_amdgcn_readlane(sel, ow) + (unsigned)(4 * (63 - ow));
    need -= (int)__builtin_amdgcn_readlane((int)cab, ow);
    cntsel = (unsigned)__builtin_amdgcn_readlane((int)csel, ow);
    return digit;
}

__device__ __forceinline__ void idx_select(const unsigned (&key)[64], unsigned t3, int jlim, lds_u32* hist, int lane, uint2* mrow, int WV_, unsigned char* lds) {
        unsigned wlo = 0u, whi = 0u;
        unsigned L = wave_min_u_dpp(t3);
        L = L > 1u ? L : 1u;

        int need = 256;
        ITS_E(34); ITS_B();
        unsigned cs; bool fin;
        const unsigned d1 = radix_pass<24>(key, 0u, hist, lane, need, jlim, L, cs);
        unsigned prefix = d1 << 24; fin = cs == (unsigned)need;
        if (fin) prefix = prefix > L ? prefix : L;
        if (!fin) {
            const unsigned d2 = radix_pass<16>(key, d1, hist, lane, need, jlim, L, cs);
            prefix |= d2 << 16; fin = cs == (unsigned)need;
            if (!fin) {
                const unsigned d3 = radix_pass<8>(key, (d1 << 8) | d2, hist, lane, need, jlim, L, cs);
                prefix |= d3 << 8; fin = cs == (unsigned)need;
                if (!fin) { const unsigned d4 = radix_pass<0>(key, (d1 << 16) | (d2 << 8) | d3, hist, lane, need, jlim, L, cs); prefix |= d4; }
            }
        }
        int ceq = 0;
        if (!fin)
#pragma unroll
        for (int j4 = 0; j4 < 16; ++j4) if (4 * j4 <= jlim) { cnt_eq(ceq, key[4 * j4], prefix); cnt_eq(ceq, key[4 * j4 + 1], prefix); cnt_eq(ceq, key[4 * j4 + 2], prefix); cnt_eq(ceq, key[4 * j4 + 3], prefix); }
        ceq = (int)wave_sum_u_dpp((unsigned)ceq);
        int X = 4096;
        if (!fin && ceq != need) {
            int X0 = 0;
#pragma unroll 1
            for (int bit = 11; bit >= 0; --bit) {
                const int c = X0 | (1 << bit);
                int cnt = 0; const int crel = (c - lane + 63) >> 6;
#pragma unroll
                for (int j = 0; j < 64; ++j) cnt_eq(cnt, (key[j] ^ prefix) | ~(unsigned)((j - crel) >> 31), 0u);
                cnt = wave_sum_i(cnt);
                if (cnt < need) X0 = c;
            }
            X = X0 + 1;
        }
        const int xrel = (X - lane + 63) >> 6;
#pragma unroll
        for (int j4 = 0; j4 < 16; ++j4) {
            if (4 * j4 <= jlim) {
#pragma unroll
                for (int e = 0; e < 4; ++e) { const int j = 4 * j4 + e;
                    const bool sel = (key[j] > prefix) || (key[j] == prefix && j < xrel);
                    const unsigned long long bm = __ballot(sel);
                    asm("v_writelane_b32 %0, %1, %2" : "+v"(wlo) : "s"((unsigned)bm), "n"(j));
                    asm("v_writelane_b32 %0, %1, %2" : "+v"(whi) : "s"((unsigned)(bm >> 32)), "n"(j)); }
            }
        }
        mrow[lane] = make_uint2(wlo, whi);
        ITS_E(33); ITS_B();
}
__device__ void index_fast_phase(int WV_, const bf16* P, unsigned char* mask, float* kmean, float* scratch_all, unsigned* qctr, unsigned char* lds) {
    const int tid = LTID(WV_), lane = tid & 63, wave = tid >> 6, bid = LBID(), G = LGRID();
    float* s_part = (float*)lds;
    ITS_B();
    for (int k = bid; k < 256; k += G) {
        const int b = k >> 6, h = (k >> 4) & 3, blk = k & 15;
        float* sp = (float*)(lds + 69632);
        { const int rg = lane >> 3, c = lane & 7;
          const bf16* kp = P + (size_t)(b * S_ + blk * 256 + wave * 32 + rg) * NP + C_KC + h * 64 + c * 8;
          uint4 kv[4];
#pragma unroll
          for (int j = 0; j < 4; ++j) kv[j] = *(const uint4*)(kp + (size_t)(8 * j) * NP);
          float acc8[8];
#pragma unroll
          for (int e = 0; e < 8; ++e) acc8[e] = 0.f;
#pragma unroll
          for (int j = 0; j < 4; ++j) { float t[8]; unpack8(kv[j], t);
#pragma unroll
              for (int e = 0; e < 8; ++e) acc8[e] += t[e]; }
          __syncthreads();
          float4* dst = (float4*)(sp + (wave * 8 + rg) * 64 + c * 8);
          dst[0] = make_float4(acc8[0], acc8[1], acc8[2], acc8[3]); dst[1] = make_float4(acc8[4], acc8[5], acc8[6], acc8[7]); }
        __syncthreads();
        if (tid < 64) { float s = 0.f;
#pragma unroll 16
            for (int r = 0; r < 64; ++r) s += sp[r * 64 + tid];
            kmean[((b * 4 + h) * 16 + blk) * 64 + tid] = s * (1.0f / 256.0f); }
    }
    ITS_E(22);
    constexpr int IDX_CP = 512 + 4;
    constexpr int IDX_PITCH = 4096 + 32;
    float* scr = scratch_all + (size_t)bid * (16 * IDX_PITCH);
    const int lq = lane & 15, g4 = lane >> 4;
    for (int ui = bid; ui < 1024; ui += G) {
        const int b = ui >> 8, k = ui & 255, tile = (b & 1) ? 255 - k : k, q0 = tile * 16;
        const bf16* Pb = P + (size_t)b * S_ * NP;
        const int ntiles = tile + 1;
        int lane_o = LANEID(); asm volatile("" : "+v"(lane_o));
        const int lane = lane_o, lq = lane & 15, g4 = lane >> 4;
        const int wave = WV_;
        const int qA = q0 + 2 * wave, qB = qA + 1;
        uint2* mrowA = (uint2*)(mask + (size_t)(b * S_ + qA) * 512); uint2* mrowB = (uint2*)(mask + (size_t)(b * S_ + qB) * 512);
        if (tile < 16) {
            unsigned wlo = 0u, whi = 0u, xlo = 0u, xhi = 0u; const int ra = qA - lane * 64, rb = qB - lane * 64;
#pragma unroll
            for (int j = 0; j < 32; ++j) { wlo |= (~(unsigned)((ra - j) >> 31) & 1u) << j; whi |= (~(unsigned)((ra - 32 - j) >> 31) & 1u) << j;
                                           xlo |= (~(unsigned)((rb - j) >> 31) & 1u) << j; xhi |= (~(unsigned)((rb - 32 - j) >> 31) & 1u) << j; }
            mrowA[lane] = make_uint2(wlo, whi); mrowB[lane] = make_uint2(xlo, xhi);
            continue;
        }
        ITS_B();
        bf16x8_t qf[8]; float wi[8];
        { const bf16* qp = Pb + (size_t)(q0 + lq) * NP + C_QI + 8 * g4;
#pragma unroll
          for (int h = 0; h < 8; ++h) qf[h] = *(const bf16x8_t*)(qp + 32 * h);
          const uint4 wv = *(const uint4*)(Pb + (size_t)(q0 + lq) * NP + C_WI); unpack8(wv, wi); }
        bf16x8_t qch, qcl;
        { typedef unsigned u32x4_t __attribute__((ext_vector_type(4)));
          float qc[8];
#pragma unroll
          for (int i = 0; i < 8; ++i) qc[i] = 0.f;
#pragma unroll
          for (int h = 0; h < 8; ++h) { const u32x4_t w4 = __builtin_bit_cast(u32x4_t, qf[h]);
#pragma unroll
              for (int i = 0; i < 4; ++i) { qc[2 * i] += wi[h] * __uint_as_float(w4[i] << 16); qc[2 * i + 1] += wi[h] * __uint_as_float(w4[i] & 0xffff0000u); } }
          u32x4_t hi4, lo4;
#pragma unroll
          for (int i = 0; i < 4; ++i) { const unsigned hw = cvtpk(qc[2 * i], qc[2 * i + 1]); hi4[i] = hw;
              lo4[i] = cvtpk(qc[2 * i] - __uint_as_float(hw << 16), qc[2 * i + 1] - __uint_as_float(hw & 0xffff0000u)); }
          qch = __builtin_bit_cast(bf16x8_t, hi4); qcl = __builtin_bit_cast(bf16x8_t, lo4); }
        typedef __attribute__((address_space(3))) bf16x8_t lds_bf16x8;
        lds_bf16x8* qops = (lds_bf16x8*)((__attribute__((address_space(3))) unsigned char*)lds + 102656);
        if (wave == 0) {
#pragma unroll
            for (int h = 0; h < 8; ++h) qops[h * 64 + lane] = qf[h];
            qops[8 * 64 + lane] = qch; qops[9 * 64 + lane] = qcl; }
        __syncthreads();
        ITS_E(20); ITS_B();
        float* cb0 = (float*)(lds + 69632); float* cb1 = (float*)(lds + 112896);
        const int jlim = q0 >> 6;
        const int jmaxA = (qA - lane) >> 6, jmaxB = (qB - lane) >> 6;
        unsigned keyA[64], keyB[64];
        unsigned a0 = 0u, a1 = 0u, a2 = 0u, a3 = 0u, b0 = 0u, b1 = 0u, b2 = 0u, b3 = 0u;
        const bf16* kbase = Pb + (size_t)lq * NP + C_KI + 8 * g4;
        bf16x8_t nxt = *(const bf16x8_t*)(kbase + (size_t)(wave < ntiles ? wave : 0) * 16 * NP);
#pragma unroll
        for (int c = 0; c < 8; ++c) {
            if (32 * c < ntiles) {
                float* cb = (c & 1) ? cb1 : cb0;
#pragma unroll
                for (int j = 0; j < 4; ++j) {
                    const int kt = 32 * c + wave + 8 * j;
                    const bf16x8_t af = nxt;
                    { const int k = kt + 8; const int kc = k < ntiles ? k : 0; nxt = *(const bf16x8_t*)(kbase + (size_t)kc * 16 * NP); }
                    if (kt < ntiles) {
                        const f32x4_t z = {0.f, 0.f, 0.f, 0.f};
                        f32x4_t sc = __builtin_amdgcn_mfma_f32_16x16x32_bf16(af, qops[8 * 64 + lane], z, 0, 0, 0);
                        sc = __builtin_amdgcn_mfma_f32_16x16x32_bf16(af, qops[9 * 64 + lane], sc, 0, 0, 0);
#pragma unroll
                        for (int hh = 0; hh < 2; ++hh) {
                            f32x4_t a[4];
#pragma unroll
                            for (int h = 0; h < 4; ++h) a[h] = __builtin_amdgcn_mfma_f32_16x16x32_bf16(af, qops[(4 * hh + h) * 64 + lane], z, 0, 0, 0);
#pragma unroll
                            for (int h = 0; h < 4; ++h)
#pragma unroll
                                for (int r = 0; r < 4; ++r) sc[r] = __builtin_fmaf(__builtin_fabsf(a[h][r]), wi[4 * hh + h], sc[r]);
                        }
#pragma unroll
                        for (int r = 0; r < 4; ++r) { sc[r] *= 0.03125f; if (sc[r] == 0.f) sc[r] = 0.f; }
                        *(f32x4_t*)(cb + lq * IDX_CP + (wave + 8 * j) * 16 + 4 * g4) = sc;
                    }
                }
                __syncthreads();
#pragma unroll
                for (int js = 0; js < 8; ++js) {
                    const int slot = 8 * c + js;
                    if (slot <= jlim) {
                        const unsigned ua = __float_as_uint(cb[(2 * wave) * IDX_CP + 64 * js + lane]), ub = __float_as_uint(cb[(2 * wave + 1) * IDX_CP + 64 * js + lane]);
                        const unsigned xa = (ua ^ ((unsigned)((int)ua >> 31) | 0x80000000u)) & ~(unsigned)((jmaxA - slot) >> 31);
                        const unsigned xb = (ub ^ ((unsigned)((int)ub >> 31) | 0x80000000u)) & ~(unsigned)((jmaxB - slot) >> 31);
                        keyA[slot] = xa; keyB[slot] = xb;
                        unsigned n1, n2, n3;
                        asm("v_med3_u32 %0, %1, %2, %3" : "=v"(n3) : "v"(a2), "v"(a3), "v"(xa));
                        asm("v_med3_u32 %0, %1, %2, %3" : "=v"(n2) : "v"(a1), "v"(a2), "v"(xa));
                        asm("v_med3_u32 %0, %1, %2, %3" : "=v"(n1) : "v"(a0), "v"(a1), "v"(xa));
                        a0 = a0 > xa ? a0 : xa; a1 = n1; a2 = n2; a3 = n3;
                        asm("v_med3_u32 %0, %1, %2, %3" : "=v"(n3) : "v"(b2), "v"(b3), "v"(xb));
                        asm("v_med3_u32 %0, %1, %2, %3" : "=v"(n2) : "v"(b1), "v"(b2), "v"(xb));
                        asm("v_med3_u32 %0, %1, %2, %3" : "=v"(n1) : "v"(b0), "v"(b1), "v"(xb));
                        b0 = b0 > xb ? b0 : xb; b1 = n1; b2 = n2; b3 = n3;
                    } else { keyA[slot] = 0u; keyB[slot] = 0u; }
                }
            } else {
#pragma unroll
                for (int js = 0; js < 8; ++js) { keyA[8 * c + js] = 0u; keyB[8 * c + js] = 0u; }
            }
        }
        lds_u32* hist = (lds_u32*)((__attribute__((address_space(3))) unsigned char*)lds + 2048) + wave * 2048;
        ITS_E(23); ITS_B();
        idx_select(keyA, a3, jlim, hist, lane, mrowA, WV_, lds);
        ITS_E(24); ITS_B();
        idx_select(keyB, b3, jlim, hist, lane, mrowB, WV_, lds);
        ITS_E(25); ITS_B();
        __syncthreads();
    }
}

constexpr int MG_P = 72;
constexpr int MG_TILE_BYTES = 128 * MG_P * 2;
__device__ void merge_fast_phase(int WV_, const unsigned char* G8, const bf16* ys, const bf16* wbt  , bf16* merged, unsigned char* lds) {
    const int tid = LTID(WV_), lane = tid & 63, wave = tid >> 6, r32 = lane & 31, hi = lane >> 5, wt = wave & 3, wd = wave >> 2;
    const int srow0 = tid >> 3, sch = tid & 7;
    for (int tile = LBID(); tile < 1024; tile += LGRID()) {
        const int tok0 = (tile >> 3) * 128, d0 = (tile & 7) * 128;
        f32x16_t mer[2], acc[2];
#pragma unroll
        for (int r = 0; r < 16; ++r) { mer[0][r] = 0.f; mer[1][r] = 0.f; acc[0][r] = 0.f; acc[1][r] = 0.f; }
        uint4 RW00, RW01, RW10, RW11, RY00, RY01, RY10, RY11, RG0, RG1;
        unsigned char* gl = lds + 4 * MG_TILE_BYTES;
        const int grow = tid >> 3, gch = tid & 7;
#define MG_GLOAD(st_, R_) do { const int n_ = (st_) >> 2, kc_ = (st_) & 3; \
            RW##R_##0 = *(const uint4*)(wbt + ((size_t)n_ * 1024 + d0 + srow0) * 256 + kc_ * 64 + sch * 8); \
            RW##R_##1 = *(const uint4*)(wbt + ((size_t)n_ * 1024 + d0 + srow0 + 64) * 256 + kc_ * 64 + sch * 8); \
            RY##R_##0 = *(const uint4*)(ys + (size_t)(tok0 + srow0) * 1024 + n_ * 256 + kc_ * 64 + sch * 8); \
            RY##R_##1 = *(const uint4*)(ys + (size_t)(tok0 + srow0 + 64) * 1024 + n_ * 256 + kc_ * 64 + sch * 8); } while (0)
#define MG_SSTORE(buf_, R_) do { bf16* wl_ = (bf16*)(lds + (buf_) * 2 * MG_TILE_BYTES); bf16* yl_ = (bf16*)(lds + (buf_) * 2 * MG_TILE_BYTES + MG_TILE_BYTES); \
            *(uint4*)(wl_ + srow0 * MG_P + sch * 8) = RW##R_##0; *(uint4*)(wl_ + (srow0 + 64) * MG_P + sch * 8) = RW##R_##1; \
            *(uint4*)(yl_ + srow0 * MG_P + sch * 8) = RY##R_##0; *(uint4*)(yl_ + (srow0 + 64) * MG_P + sch * 8) = RY##R_##1; } while (0)
        __syncthreads();
        MG_GLOAD(0, 0); MG_GLOAD(1, 1);
        MG_SSTORE(0, 0);
        __syncthreads();
#define MG_STAGE(PAR_, OTH_) do { const int buf = PAR_; \
            if (st + 2 < 16) MG_GLOAD(st + 2, PAR_); \
            if ((st & 3) == 1) { const unsigned char* gsrc = G8 + (size_t)(tok0 + grow) * 4096 + (st >> 2) * 1024 + d0 + gch * 16; \
                RG0 = *(const uint4*)gsrc; RG1 = *(const uint4*)(gsrc + (size_t)64 * 4096); } \
            const bf16* wl = (const bf16*)(lds + buf * 2 * MG_TILE_BYTES); const bf16* yl = (const bf16*)(lds + buf * 2 * MG_TILE_BYTES + MG_TILE_BYTES); \
            _Pragma("unroll") for (int ks = 0; ks < 4; ++ks) { \
                const bf16x8_t bq = *(const bf16x8_t*)(yl + (32 * wt + r32) * MG_P + 16 * ks + 8 * hi); \
                const bf16x8_t a0 = *(const bf16x8_t*)(wl + (64 * wd + r32) * MG_P + 16 * ks + 8 * hi); \
                const bf16x8_t a1 = *(const bf16x8_t*)(wl + (64 * wd + 32 + r32) * MG_P + 16 * ks + 8 * hi); \
                acc[0] = __builtin_amdgcn_mfma_f32_32x32x16_bf16(a0, bq, acc[0], 0, 0, 0); \
                acc[1] = __builtin_amdgcn_mfma_f32_32x32x16_bf16(a1, bq, acc[1], 0, 0, 0); } \
            if ((st & 3) == 3) { \
                const int n = st >> 2; \
                const unsigned char* gp = gl + (32 * wt + r32) * 144 + 64 * wd + 4 * hi; (void)n; \
                _Pragma("unroll") for (int dt = 0; dt < 2; ++dt) \
                _Pragma("unroll") for (int g = 0; g < 4; ++g) { \
                        const int gv = *(const int*)(gp + 32 * dt + 8 * g); \
                        mer[dt][4 * g + 0] += acc[dt][4 * g + 0] * __builtin_amdgcn_cvt_f32_fp8(gv, 0); \
                        mer[dt][4 * g + 1] += acc[dt][4 * g + 1] * __builtin_amdgcn_cvt_f32_fp8(gv, 1); \
                        mer[dt][4 * g + 2] += acc[dt][4 * g + 2] * __builtin_amdgcn_cvt_f32_fp8(gv, 2); \
                        mer[dt][4 * g + 3] += acc[dt][4 * g + 3] * __builtin_amdgcn_cvt_f32_fp8(gv, 3); } \
                _Pragma("unroll") for (int r = 0; r < 16; ++r) { acc[0][r] = 0.f; acc[1][r] = 0.f; } } \
            if (st + 1 < 16) MG_SSTORE(OTH_, OTH_); \
            if ((st & 3) == 2) { *(uint4*)(gl + grow * 144 + gch * 16) = RG0; *(uint4*)(gl + (grow + 64) * 144 + gch * 16) = RG1; } \
            __syncthreads(); } while (0)
#pragma unroll 1
        for (int st2 = 0; st2 < 16; st2 += 2) { { const int st = st2; MG_STAGE(0, 1); } { const int st = st2 + 1; MG_STAGE(1, 0); } }
#undef MG_STAGE
#undef MG_GLOAD
#undef MG_SSTORE
        bf16* mp = merged + (size_t)(tok0 + 32 * wt + r32) * 1024 + d0 + 64 * wd + 4 * hi;
#pragma unroll
        for (int dt = 0; dt < 2; ++dt)
#pragma unroll
            for (int g = 0; g < 4; ++g)
                *(uint2*)(mp + 32 * dt + 8 * g) = make_uint2(cvtpk(mer[dt][4 * g], mer[dt][4 * g + 1]), cvtpk(mer[dt][4 * g + 2], mer[dt][4 * g + 3]));
    }
}
#define LAS __attribute__((address_space(3)))
#define XB_TMO      128
#define XB_XCNT(j)  (256  + 64 * (j))
#define XB_XSUB(j)  (1280 + 64 * (j))
#define XB_XGEN(j)  (2304 + 64 * (j))
#define XB_TOP      3328
#define XB_TOPGEN   3392
#define XCD_BAR_WORDS 3456
#define XB_SPIN_CAP (1u << 18)

__device__ __forceinline__ unsigned xb_ld(unsigned* p)              { return __hip_atomic_load(p, __ATOMIC_RELAXED, __HIP_MEMORY_SCOPE_AGENT); }
__device__ __forceinline__ unsigned xb_add(unsigned* p, unsigned v) { return __hip_atomic_fetch_add(p, v, __ATOMIC_RELAXED, __HIP_MEMORY_SCOPE_AGENT); }
__device__ __forceinline__ unsigned xb_xcc_id() { return (unsigned)__builtin_amdgcn_s_getreg((3 << 11) | 20) & 0xFu; }
#define XB_SPIN(cond, bar) do { unsigned _sp = 0; while (cond) { __builtin_amdgcn_s_sleep(1); \
    if ((++_sp & 255u) == 0u) { if (xb_ld(&(bar)[XB_TMO])) break; if (_sp > XB_SPIN_CAP) { atomicAdd(&(bar)[XB_TMO], 1u); break; } } } } while (0)

struct XcdBarrier {
    unsigned* bar; unsigned x;
    volatile LAS unsigned* st;
};

__device__ __forceinline__ XcdBarrier xcd_barrier_post(unsigned* bar, volatile LAS unsigned* st) {
    XcdBarrier b; b.bar = bar; b.x = xb_xcc_id(); b.st = st;
    if (threadIdx.x == 0) (void)xb_add(&bar[XB_XCNT(b.x)], 1u);
    return b;
}
__device__ __forceinline__ void xcd_barrier_complete(unsigned* bar, unsigned x, unsigned& nloc, unsigned& nx) {
    const unsigned G = gridDim.x * gridDim.y * gridDim.z;
    unsigned sum, cnt, mine, sp = 0u;
    for (;;) {
        sum = 0u; cnt = 0u; mine = 0u;
#pragma unroll
        for (unsigned j = 0; j < 16; ++j) { const unsigned c = xb_ld(&bar[XB_XCNT(j)]); sum += c; cnt += (c > 0u) ? 1u : 0u; mine = (j == x) ? c : mine; }
        if (sum == G) break;
        __builtin_amdgcn_s_sleep(1);
        if ((++sp & 255u) == 0u) { if (xb_ld(&bar[XB_TMO])) break; if (sp > XB_SPIN_CAP) { atomicAdd(&bar[XB_TMO], 1u); break; } }
    }
    nloc = mine > 0u ? mine : 1u; nx = cnt > 0u ? cnt : 1u;
}

__device__ __forceinline__ void xcd_barrier(const XcdBarrier& b, int wv_) {
    asm volatile("s_waitcnt vmcnt(0)" ::: "memory");
    __syncthreads();
    if (wv_ == 0 && LANEID() == 0) {
        unsigned* bar = b.bar;
        __builtin_amdgcn_s_waitcnt(0);
        unsigned nloc = b.st[0], nx = b.st[1];
        if (nloc == 0u) { xcd_barrier_complete(bar, b.x, nloc, nx); b.st[0] = nloc; b.st[1] = nx; }
        const unsigned old = xb_add(&bar[XB_XSUB(b.x)], 1u);
        const unsigned gen = old / nloc;
        if (old + 1u == (gen + 1u) * nloc) {
            __builtin_amdgcn_fence(__ATOMIC_RELEASE, "agent");
            asm volatile("s_waitcnt vmcnt(0)" ::: "memory");
            const unsigned og = xb_add(&bar[XB_TOP], 1u);
            const unsigned tg = og / nx;
            if (og + 1u == (tg + 1u) * nx) xb_add(&bar[XB_TOPGEN], 1u);
            else XB_SPIN(xb_ld(&bar[XB_TOPGEN]) == tg, bar);
            __builtin_amdgcn_fence(__ATOMIC_ACQUIRE, "agent");
            xb_add(&bar[XB_XGEN(b.x)], 1u);
            asm volatile("s_waitcnt vmcnt(0)" ::: "memory");
        } else {
            XB_SPIN(xb_ld(&bar[XB_XGEN(b.x)]) == gen, bar);
            __builtin_amdgcn_fence(__ATOMIC_ACQUIRE, "agent");
            asm volatile("s_waitcnt vmcnt(0)" ::: "memory");
        }
    }
    __syncthreads();
}

enum { PH_PRO = 0, PH_GIN, PH_INDEX, PH_ATTN, PH_MERGE, PH_GOUT, PH_LN1, PH_GQ, PH_ROUTE, PH_PEER };
template <int PH> __device__ __forceinline__ void run_phase(int WV_, const Params& p_unused, int l, unsigned char* lds_raw) {
    size_t kaoff_ = 0; asm volatile("" : "+s"(kaoff_));
    typedef const __attribute__((address_space(4))) char* kaptr_t;
    const __attribute__((address_space(4))) Params& p = *(const __attribute__((address_space(4))) Params*)((kaptr_t)__builtin_amdgcn_kernarg_segment_ptr() + kaoff_);
    float* sm = (float*)lds_raw;
    size_t wsoff_ = 0; asm volatile("" : "+s"(wsoff_));
    unsigned char* ws = p.ws + wsoff_;
    float* hbuf = p.out;
    bf16* hb = (bf16*)(ws + WS_HB);
    bf16* P = (bf16*)(ws + WS_P);
    bf16* ys = (bf16*)(ws + WS_YS);
    bf16* mrg = (bf16*)(ws + WS_MRG);
    float* mix = (float*)(ws + WS_MIX);
    float* qb = (float*)(ws + WS_Q);
    unsigned char* mask = ws + WS_MASK;
    int* eid = (int*)(ws + WS_EID);
    float* gate = (float*)(ws + WS_GATE);
    float* kmean = (float*)(ws + WS_KMEAN);
    const float* hin = (l == 0) ? p.in[0] : hbuf;
    if (PH == PH_PRO) { Params pc; for (int i = 0; i < 13; ++i) pc.in[i] = p.in[i]; pc.out = p.out; pc.ws = ws;
        prologue_phase(WV_, pc, sm); convert_tables(WV_, pc);
        for (int i = LBID() * NTHR + LTID(WV_); i < DEPTH_ * 8 * 2 * 128 * 64 / 4; i += LGRID() * NTHR) { const float4 v = ((const float4*)p.in[8])[i]; ((uint2*)(ws + WS_SKB))[i] = make_uint2(pk2(v.x, v.y), pk2(v.z, v.w)); } if (LBID() < 2) build_unit_table((unsigned*)(ws + WS_CTL) + 1024, LBID() * NTHR + LTID(WV_)); }
    else if (PH == PH_GIN) {
        pg8::Gemm g{hb, (const bf16*)(ws + WS_WIN_T + l * WIN_T_BYTES), T_, NP, 1024};
        pg8::StaticOrder S; S.init(T_, NP, (int)LGRID(), (int)LBID());
        pg8::EpiBf16Sig E{P, NP, C_G, ws + WS_G8};
        pg8::gemm_phase<pg8::EpiBf16Sig, pg8::StaticOrder, true, true>(WV_, (PG8_LAS unsigned char*)lds_raw, g, S, E);
    }
    else if (PH == PH_INDEX) index_fast_phase(WV_, P, mask, kmean, (float*)(ws + WS_UV + 48 * MiB), (unsigned*)(ws + WS_CTL) + 64 * l + 16, lds_raw);
    else if (PH == PH_ATTN) attn_fast_phase(WV_, P, mask, kmean, p.in[4] + l * 4, ys, (const unsigned*)(ws + WS_CTL) + 1024, (unsigned*)(ws + WS_CTL) + 64 * l, lds_raw);
    else if (PH == PH_MERGE) merge_fast_phase(WV_, ws + WS_G8, ys, (const bf16*)(ws + WS_WBR_T) + (size_t)l * 4 * 1024 * 256, mrg, lds_raw);
    else if (PH == PH_GOUT) {
        pg8::Gemm g{mrg, (const bf16*)(ws + WS_WOUT_T) + (size_t)l * 1024 * 1024, T_, 1024, 1024};
        pg8::StaticOrder S; S.init(T_, 1024, (int)LGRID(), (int)LBID());
        pg8::EpiResY E{l == 0 ? hin : nullptr, hb, hb, (float*)(ws + WS_STATS) + (size_t)l * T_ * 2, ALPHA};
        pg8::gemm_phase<pg8::EpiResY, pg8::StaticOrder, true, true>(WV_, (PG8_LAS unsigned char*)lds_raw, g, S, E);
    }
    else if (PH == PH_GQ) {
        pg8::Gemm g{hb, (const bf16*)(ws + WS_WQ_T) + (size_t)l * 1024 * 1024, T_, 1024, 1024};
        pg8::StaticOrder S; S.init(T_, 1024, (int)LGRID(), (int)LBID());
        pg8::EpiLnFold E{(bf16*)qb, (const float*)(ws + WS_STATS) + (size_t)l * T_ * 2, (const float*)(ws + WS_COLS) + l * 2048, (const float*)(ws + WS_COLS) + l * 2048 + 1024, LN_EPS};
        pg8::gemm_phase<pg8::EpiLnFold, pg8::StaticOrder, true, true>(WV_, (PG8_LAS unsigned char*)lds_raw, g, S, E);
        pg8::Unit u0;
        if (LGRID() == 256 && S.next(0, u0)) {
            asm volatile("s_waitcnt vmcnt(0)" ::: "memory"); __syncthreads();
            route_fast_phase(WV_, (const bf16*)qb, (const bf16*)(ws + WS_SKB) + (size_t)l * 8 * 2 * 128 * 64, eid, gate, lds_raw, u0.pm, u0.pn);
        }
    }
    else if (PH == PH_ROUTE) { if (LGRID() != 256) route_fast_phase(WV_, (const bf16*)qb, (const bf16*)(ws + WS_SKB) + (size_t)l * 8 * 2 * 128 * 64, eid, gate, lds_raw); }
    else peer_fast_phase(WV_, (l + 1 == DEPTH_) ? hbuf : nullptr, hb, eid, gate, ws + WS_UV + (size_t)l * 24 * MiB, p.in[5] + l * 1024, p.in[6] + l * 1024, p.in[11] + l * 1024, p.in[12] + l * 1024, lds_raw);
}

constexpr int CW_BAR = 4096;
constexpr int LDS_BARST = LDS_BYTES - 16;
__global__ void __launch_bounds__(NTHR, 2) mk_fwd(Params p) {
    extern __shared__ __attribute__((aligned(16))) unsigned char lds_raw[];
    cg::grid_group grid = cg::this_grid();
    const int WV_ = __builtin_amdgcn_readfirstlane((int)threadIdx.x >> 6);
    { volatile LAS unsigned* bst0 = (volatile LAS unsigned*)((LAS unsigned char*)lds_raw + LDS_BARST); if (threadIdx.x < 4) bst0[threadIdx.x] = 0u; }
    __syncthreads();
    volatile LAS unsigned* bst = (volatile LAS unsigned*)((LAS unsigned char*)lds_raw + LDS_BARST);
    { uint4* z = (uint4*)p.ws; const uint4 z4 = make_uint4(0u, 0u, 0u, 0u);
      for (unsigned i = (unsigned)LBID() * NTHR + (unsigned)LTID(WV_); i < (unsigned)(2 * MiB / 16); i += (unsigned)LGRID() * NTHR) z[i] = z4; }
    grid.sync();
    (void)xcd_barrier_post((unsigned*)(p.ws + WS_CTL) + CW_BAR, bst);
#define GRID_BAR() do { XcdBarrier b_; b_.bar = (unsigned*)(p.ws + WS_CTL) + CW_BAR; b_.x = xb_xcc_id(); b_.st = (volatile LAS unsigned*)((LAS unsigned char*)lds_raw + LDS_BARST); xcd_barrier(b_, WV_); } while (0)
    run_phase<PH_PRO>(WV_, p, 0, lds_raw);
    GRID_BAR();
#pragma unroll 1
    for (int l = 0; l < DEPTH_; ++l) {
        run_phase<PH_GIN>(WV_, p, l, lds_raw); GRID_BAR();
        run_phase<PH_INDEX>(WV_, p, l, lds_raw); GRID_BAR();
        run_phase<PH_ATTN>(WV_, p, l, lds_raw); GRID_BAR();
        run_phase<PH_MERGE>(WV_, p, l, lds_raw); GRID_BAR();
        run_phase<PH_GOUT>(WV_, p, l, lds_raw); GRID_BAR();
        run_phase<PH_GQ>(WV_, p, l, lds_raw); if (LGRID() != 256) { GRID_BAR(); run_phase<PH_ROUTE>(WV_, p, l, lds_raw); } GRID_BAR();
        run_phase<PH_PEER>(WV_, p, l, lds_raw); if (l + 1 < DEPTH_) GRID_BAR();
    }
}

extern "C" void kernel_launch(void* const* d_in, const int* in_sizes, int n_in, void* d_out, int out_size, void* d_ws, size_t ws_size, hipStream_t stream) {
    if (n_in != 13 || ws_size < WS_END) { fprintf(stderr, "kernel_launch: unexpected n_in %d / ws_size %zu; nothing launched\n", n_in, ws_size); return; }
    static int grid_blocks = 0;
    if (grid_blocks == 0) {
        int dev = 0, cus = 0, per_cu = 0;
        (void)hipGetDevice(&dev);
        (void)hipDeviceGetAttribute(&cus, hipDeviceAttributeMultiprocessorCount, dev);
        (void)hipFuncSetAttribute((const void*)mk_fwd, hipFuncAttributeMaxDynamicSharedMemorySize, LDS_BYTES);
        (void)hipOccupancyMaxActiveBlocksPerMultiprocessor(&per_cu, (const void*)mk_fwd, NTHR, LDS_BYTES);
        if (per_cu < 1) fprintf(stderr, "kernel_launch: occupancy query reports %d\n", per_cu);
        grid_blocks = cus;
    }
    Params p{};
    for (int i = 0; i < 13; ++i) p.in[i] = (const float*)d_in[i];
    p.out = (float*)d_out; p.ws = (unsigned char*)d_ws;
    void* args[] = {&p};
    hipError_t e = hipLaunchCooperativeKernel((const void*)mk_fwd, dim3(grid_blocks), dim3(NTHR), args, LDS_BYTES, stream);
    if (e != hipSuccess) fprintf(stderr, "cooperative launch failed: %s (grid %d)\n", hipGetErrorString(e), grid_blocks);
}
```
